# Optimizing an MI355X kernel written in HIP

```python
import math
import jax
import jax.numpy as jnp
from jax import lax
import numpy as np

D_MODEL = 1024
BATCH = 8
SEQ = 4096
DEPTH = 4

GRID_W = 64
CTX_LEN = 256
N_MIXERS = 4
GROUP_W = D_MODEL // N_MIXERS
HEAD_DIM = 64
N_HEADS = GROUP_W // HEAD_DIM
CONV_W = 4
CONV_PAD = (CONV_W // 2, CONV_W - 1 - CONV_W // 2)
LRU_C = 8.0
RWKV_LORA_W = 32
RWKV_LORA_A = 32
RWKV_LORA_G = 64
RWKV_GN_EPS = 64e-5
CHUNK = 64
D_FF = 2816
N_EXPERTS = 8
TOP_K = 2
D_FF_EXPERT = 1408
MOE_BLOCK = 256
N_DENSE = (DEPTH + 1) // 2
N_MOE = DEPTH // 2
EPS = 1e-6

A_COLS = 2 * GROUP_W
B_COLS = 3 * GROUP_W + 2 * RWKV_LORA_W + 2 * RWKV_LORA_A + RWKV_LORA_G
C_COLS = 4 * GROUP_W + 4 * N_HEADS
D_COLS = 4 * GROUP_W + 4 * N_HEADS
OFF_B = A_COLS
OFF_C = OFF_B + B_COLS
OFF_D = OFF_C + C_COLS
IN_COLS = OFF_D + D_COLS

kernel_name = 'hybrid_group_diffusion_trunk'


def rms_norm(x, g):
    xf = x.astype(jnp.float32)
    y = xf * lax.rsqrt(jnp.mean(xf * xf, axis=-1, keepdims=True) + EPS)
    return (y * g.astype(jnp.float32)).astype(x.dtype)


def heads(t):
    return t.reshape(*t.shape[:-1], N_HEADS, HEAD_DIM)


def merge_heads(t):
    return t.reshape(*t.shape[:-2], GROUP_W)


def head_rms_norm(t, g):
    return merge_heads(rms_norm(heads(t), heads(g)))


def l2_normalize(t):
    t = t.astype(jnp.float32)
    return t * lax.rsqrt(jnp.sum(t * t, axis=-1, keepdims=True) + EPS)


def centred_dwconv(t, w):
    return lax.conv_general_dilated(t, w[:, None, :].astype(t.dtype), (1,), [CONV_PAD],
                                    dimension_numbers=('NWC', 'WIO', 'NWC'),
                                    feature_group_count=t.shape[-1])


def token_shift_bidir(t, mu):
    prev = jnp.pad(t[:, :-1], ((0, 0), (1, 0), (0, 0)))
    nxt = jnp.pad(t[:, 1:], ((0, 0), (0, 1), (0, 0)))
    return t + mu[0] * (prev - t) + mu[1] * (nxt - t)


def bidir_stack(t):
    return jnp.stack([t, jnp.flip(t, axis=1)], axis=0)


def flip_dir1(t):
    return jnp.stack([t[0], jnp.flip(t[1], axis=1)], axis=0)


def bidir_merge(t):
    return t[0] + jnp.flip(t[1], axis=1)


def raster_to_colmajor(t, rows):
    b, s, ch = t.shape
    return t.reshape(b, rows, GRID_W, ch).transpose(0, 2, 1, 3).reshape(b, s, ch)


def colmajor_to_raster(t, rows):
    b, s, ch = t.shape
    return t.reshape(b, GRID_W, rows, ch).transpose(0, 2, 1, 3).reshape(b, s, ch)


def to_chunks(t):
    nd, bsz, s = t.shape[:3]
    t = t.reshape(nd, bsz, s // CHUNK, CHUNK, *t.shape[3:])
    return jnp.moveaxis(jnp.moveaxis(t, 4, 3), 2, 0)


def from_chunks(t):
    nc, nd, bsz, h, l, d = t.shape
    return jnp.swapaxes(jnp.moveaxis(t, 0, 2), 3, 4).reshape(nd, bsz, nc * l, h, d)


def linear_scan(a, b, h0):
    b = b.at[:, :, 0].add(a[:, :, 0] * h0)

    def combine(lhs, rhs):
        a_l, b_l = lhs
        a_r, b_r = rhs
        return a_l * a_r, a_r * b_l + b_r

    return lax.associative_scan(combine, (a, b), axis=2)[1]


def rglru_mixer(pc, pl, conv_w, conv_b, w_a, b_a, w_x, b_x, lam, ctx_out):
    f32 = jnp.float32

    def gates(u):
        ud = bidir_stack(u.astype(f32))
        uh = heads(ud)
        r = jax.nn.sigmoid(merge_heads(jnp.einsum('dbshi,dhij->dbshj', uh, w_a)) + b_a[:, None, None])
        i = jax.nn.sigmoid(merge_heads(jnp.einsum('dbshi,dhij->dbshj', uh, w_x)) + b_x[:, None, None])
        log_a = -LRU_C * r * jax.nn.softplus(-lam)[:, None, None]
        return jnp.exp(log_a), jnp.sqrt(-jnp.expm1(2.0 * log_a)) * (i * ud)

    a_c, b_c = gates(centred_dwconv(pc[..., :GROUP_W], conv_w) + conv_b)
    h_c = linear_scan(a_c, b_c, jnp.zeros_like(b_c[:, :, 0]))
    a_l, b_l = gates(centred_dwconv(pl[..., :GROUP_W], conv_w) + conv_b)
    h_l = linear_scan(a_l, b_l, h_c[:, :, -1])
    y_l = (bidir_merge(h_l) * jax.nn.gelu(pl[..., GROUP_W:].astype(f32))).astype(pl.dtype)
    y_c = (bidir_merge(h_c) * jax.nn.gelu(pc[..., GROUP_W:].astype(f32))).astype(pc.dtype) if ctx_out else None
    return y_c, y_l


def rwkv7_scan(r, w, kk, a, k, v, s0):
    xs = tuple(jnp.moveaxis(t, 2, 0) for t in (r, w, kk, a, k, v))

    def step(s, inp):
        r_t, w_t, kk_t, a_t, k_t, v_t = inp
        sk = jnp.einsum('...vk,...k->...v', s, kk_t)
        s = (s * w_t[..., None, :] - sk[..., :, None] * (kk_t * a_t)[..., None, :]
             + v_t[..., :, None] * k_t[..., None, :])
        return s, jnp.einsum('...vk,...k->...v', s, r_t)

    s_final, ys = lax.scan(step, s0, xs)
    return jnp.moveaxis(ys, 0, 2), s_final


def rwkv7_mixer(pc, pl, mu, w_up, w0, a_up, a0, g_up, k_k, k_a, r_k, ln_g, ln_b, ctx_out):
    f32 = jnp.float32
    G = GROUP_W

    def prepare(p):
        p = token_shift_bidir(p.astype(f32), mu)
        bsz, s = p.shape[:2]
        r, k, v = p[..., :G], p[..., G:2 * G], p[..., 2 * G:3 * G]
        off = 3 * G
        xw = p[..., off:off + 2 * RWKV_LORA_W].reshape(bsz, s, 2, RWKV_LORA_W)
        off += 2 * RWKV_LORA_W
        xa = p[..., off:off + 2 * RWKV_LORA_A].reshape(bsz, s, 2, RWKV_LORA_A)
        xg = p[..., off + 2 * RWKV_LORA_A:]
        log_w = -math.exp(-0.5) * jax.nn.sigmoid(
            jnp.einsum('bsdr,drc->dbsc', jnp.tanh(xw), w_up) + w0[:, None, None])
        a = jax.nn.sigmoid(jnp.einsum('bsdr,drc->dbsc', xa, a_up) + a0[:, None, None])
        kk = l2_normalize(heads(k * k_k))
        k_mod = k * (1.0 + (a - 1.0) * k_a)
        bonus = jnp.sum(jnp.sum(heads(r * k_mod * r_k), axis=-1, keepdims=True), axis=0) * heads(v)
        g = jax.nn.sigmoid(xg) @ g_up
        ins = (bidir_stack(heads(r)), flip_dir1(heads(jnp.exp(log_w))), bidir_stack(kk),
               flip_dir1(heads(a)), flip_dir1(heads(k_mod)), bidir_stack(heads(v)))
        return ins, bonus, g

    def finish(ys, bonus, g):
        y = bidir_merge(ys)
        mean = jnp.mean(y, axis=-1, keepdims=True)
        var = jnp.mean(jnp.square(y - mean), axis=-1, keepdims=True)
        y = merge_heads((y - mean) * lax.rsqrt(var + RWKV_GN_EPS)) * ln_g + ln_b
        return (y + merge_heads(bonus)) * g

    ins_c, bonus_c, g_c = prepare(pc)
    ins_l, bonus_l, g_l = prepare(pl)
    bsz = pc.shape[0]
    s0 = jnp.zeros((2, bsz, N_HEADS, HEAD_DIM, HEAD_DIM), f32)
    ys_c, s_c = rwkv7_scan(*ins_c, s0)
    ys_l, _ = rwkv7_scan(*ins_l, s_c)
    y_l = finish(ys_l, bonus_l, g_l).astype(pl.dtype)
    y_c = finish(ys_c, bonus_c, g_c).astype(pc.dtype) if ctx_out else None
    return y_c, y_l


def mlstm_chunked(q, k, v, log_i, log_f, state):
    qc, kc, vc = to_chunks(q), to_chunks(k), to_chunks(v)
    li, lf = to_chunks(log_i), to_chunks(log_f)
    causal = jnp.tril(jnp.ones((CHUNK, CHUNK), dtype=bool))
    b = jnp.cumsum(lf, axis=-1)
    log_d = jnp.where(causal, b[..., :, None] - b[..., None, :] + li[..., None, :], -jnp.inf)
    m_intra = jnp.max(log_d, axis=-1)
    b_last = b[..., -1]
    log_end = b_last[..., None] - b + li
    qk = jnp.einsum('...ld,...sd->...ls', qc, kc)

    def step(carry, inp):
        mem, nrm, m = carry
        q_, k_, v_, qk_, ld_, mi_, b_, bl_, le_ = inp
        m_inter = b_ + m[..., None]
        m_t = jnp.maximum(m_inter, mi_)
        w_inter = jnp.exp(m_inter - m_t)
        p = jnp.exp(ld_ - m_t[..., None]) * qk_
        num = (jnp.einsum('...ls,...sd->...ld', p, v_)
               + w_inter[..., None] * jnp.einsum('...vk,...lk->...lv', mem, q_))
        den = jnp.sum(p, axis=-1) + w_inter * jnp.einsum('...k,...lk->...l', nrm, q_)
        h = num / jnp.maximum(jnp.abs(den), jnp.exp(-m_t))[..., None]
        m_new = jnp.maximum(bl_ + m, jnp.max(le_, axis=-1))
        w_prev = jnp.exp(bl_ + m - m_new)
        w_new = jnp.exp(le_ - m_new[..., None])
        mem = w_prev[..., None, None] * mem + jnp.einsum('...l,...lv,...lk->...vk', w_new, v_, k_)
        nrm = w_prev[..., None] * nrm + jnp.einsum('...l,...lk->...k', w_new, k_)
        return (mem, nrm, m_new), h

    state, hs = lax.scan(step, state, (qc, kc, vc, qk, log_d, m_intra, b, b_last, log_end))
    return from_chunks(hs), state


def mlstm_mixer(pc, pl, i_b, f_b, norm_g, rows, ctx_out):
    f32 = jnp.float32
    G = GROUP_W

    def prepare(p):
        p = p.astype(f32)
        bsz, s = p.shape[:2]
        q, k, v, o = p[..., :G], p[..., G:2 * G], p[..., 2 * G:3 * G], p[..., 3 * G:4 * G]
        gates = jnp.moveaxis(p[..., 4 * G:].reshape(bsz, s, 4, N_HEADS), 2, 0)
        log_i = gates[:2] + i_b[:, None, None]
        log_f = jax.nn.log_sigmoid(gates[2:] + f_b[:, None, None])
        ins = (bidir_stack(heads(q)), bidir_stack(heads(k) / math.sqrt(HEAD_DIM)),
               bidir_stack(heads(v)), flip_dir1(log_i), flip_dir1(log_f))
        return ins, o

    def finish(hs, o):
        return head_rms_norm(merge_heads(bidir_merge(hs)), norm_g) * jax.nn.sigmoid(o)

    ins_c, o_c = prepare(pc)
    ins_l, o_l = prepare(raster_to_colmajor(pl, rows))
    bsz = pc.shape[0]
    state0 = (jnp.zeros((2, bsz, N_HEADS, HEAD_DIM, HEAD_DIM), f32),
              jnp.zeros((2, bsz, N_HEADS, HEAD_DIM), f32),
              jnp.zeros((2, bsz, N_HEADS), f32))
    h_c, st_c = mlstm_chunked(*ins_c, state0)
    h_l, _ = mlstm_chunked(*ins_l, st_c)
    y_l = colmajor_to_raster(finish(h_l, o_l), rows).astype(pl.dtype)
    y_c = finish(h_c, o_c).astype(pc.dtype) if ctx_out else None
    return y_c, y_l


def gdn_chunked(q, k, v, log_alpha, beta, state):
    qc, kc, vc = to_chunks(q), to_chunks(k), to_chunks(v)
    la, bt = to_chunks(log_alpha), to_chunks(beta)
    incl = jnp.tril(jnp.ones((CHUNK, CHUNK), dtype=bool))
    strict = jnp.tril(jnp.ones((CHUNK, CHUNK), dtype=bool), k=-1)
    gam = jnp.cumsum(la, axis=-1)
    decay = jnp.exp(jnp.where(incl, gam[..., :, None] - gam[..., None, :], -jnp.inf))
    k_beta = kc * bt[..., None]
    lower = jnp.where(strict, jnp.einsum('...id,...jd->...ij', k_beta, kc) * decay, 0.0)
    rhs = jnp.concatenate([vc * bt[..., None], k_beta * jnp.exp(gam)[..., None]], axis=-1)
    sol = lax.linalg.triangular_solve(lower + jnp.eye(CHUNK, dtype=lower.dtype), rhs,
                                      left_side=True, lower=True, unit_diagonal=True)
    u, w = sol[..., :HEAD_DIM], sol[..., HEAD_DIM:]
    qk = jnp.einsum('...id,...jd->...ij', qc, kc) * decay
    q_dec = qc * jnp.exp(gam)[..., None]
    k_dec = kc * jnp.exp(gam[..., -1:] - gam)[..., None]
    g_last = jnp.exp(gam[..., -1])

    def step(s, inp):
        u_, w_, qk_, qd_, kd_, gl_ = inp
        v_new = u_ - jnp.einsum('...lk,...kv->...lv', w_, s)
        o = jnp.einsum('...lk,...kv->...lv', qd_, s) + jnp.einsum('...ls,...sv->...lv', qk_, v_new)
        s = gl_[..., None, None] * s + jnp.einsum('...lk,...lv->...kv', kd_, v_new)
        return s, o

    state, os_ = lax.scan(step, state, (u, w, qk, q_dec, k_dec, g_last))
    return from_chunks(os_), state


def gdn_mixer(pc, pl, conv_w, a_log, dt_bias, norm_g, rows, ctx_out):
    f32 = jnp.float32
    G = GROUP_W

    def prepare(p):
        bsz, s = p.shape[:2]
        qkv = jax.nn.silu(centred_dwconv(p[..., :3 * G], conv_w)).astype(f32)
        q = l2_normalize(heads(qkv[..., :G])) * HEAD_DIM ** -0.5
        k = l2_normalize(heads(qkv[..., G:2 * G]))
        v = heads(qkv[..., 2 * G:])
        ab = jnp.moveaxis(p[..., 4 * G:].astype(f32).reshape(bsz, s, 4, N_HEADS), 2, 0)
        log_alpha = -jnp.exp(a_log)[:, None, None] * jax.nn.softplus(ab[:2] + dt_bias[:, None, None])
        beta = jax.nn.sigmoid(ab[2:])
        ins = (bidir_stack(q), bidir_stack(k), bidir_stack(v), flip_dir1(log_alpha), flip_dir1(beta))
        return ins, p[..., 3 * G:4 * G]

    def finish(os_, gate):
        return head_rms_norm(merge_heads(bidir_merge(os_)), norm_g) * jax.nn.silu(gate.astype(f32))

    ins_c, gate_c = prepare(pc)
    ins_l, gate_l = prepare(raster_to_colmajor(pl, rows))
    bsz = pc.shape[0]
    s0 = jnp.zeros((2, bsz, N_HEADS, HEAD_DIM, HEAD_DIM), f32)
    o_c, s_c = gdn_chunked(*ins_c, s0)
    o_l, _ = gdn_chunked(*ins_l, s_c)
    y_l = colmajor_to_raster(finish(o_l, gate_l), rows).astype(pl.dtype)
    y_c = finish(o_c, gate_c).astype(pc.dtype) if ctx_out else None
    return y_c, y_l


def swiglu(h, w_gate, w_up, w_down):
    return (jax.nn.silu(h @ w_gate) * (h @ w_up)) @ w_down


def moe_swiglu(h, router, w_gate, w_up, w_down):
    t, d = h.shape
    logits = (h @ router).astype(jnp.float32)
    top_logits, top_idx = lax.top_k(logits, TOP_K)
    gate = jax.nn.softmax(top_logits, axis=-1)
    tk = t * TOP_K
    flat_e = top_idx.reshape(tk)
    flat_tok = jnp.arange(tk, dtype=jnp.int32) // TOP_K
    order = jnp.argsort(flat_e)
    se, stok, sw = flat_e[order], flat_tok[order], gate.reshape(tk)[order]
    counts = jnp.zeros((N_EXPERTS,), jnp.int32).at[flat_e].add(1)
    start = jnp.cumsum(counts) - counts
    padded = (counts + MOE_BLOCK - 1) // MOE_BLOCK * MOE_BLOCK
    pad_start = jnp.cumsum(padded) - padded
    pad_end = pad_start + padded
    pos = pad_start[se] + jnp.arange(tk, dtype=jnp.int32) - start[se]
    n_blocks = -(-tk // MOE_BLOCK) + N_EXPERTS
    buf_tok = jnp.full((n_blocks * MOE_BLOCK,), t, jnp.int32).at[pos].set(stok)
    buf_w = jnp.zeros((n_blocks * MOE_BLOCK,), h.dtype).at[pos].set(sw.astype(h.dtype))
    block_e = jnp.clip(jnp.searchsorted(pad_end, jnp.arange(n_blocks, dtype=jnp.int32) * MOE_BLOCK,
                                        side='right'), 0, N_EXPERTS - 1)
    h_pad = jnp.concatenate([h, jnp.zeros((1, d), h.dtype)], axis=0)

    def expert_block(args):
        tok, e = args
        xb = h_pad[tok]
        return (jax.nn.silu(xb @ w_gate[e]) * (xb @ w_up[e])) @ w_down[e]

    yb = lax.map(expert_block, (buf_tok.reshape(n_blocks, MOE_BLOCK), block_e))
    y = jnp.zeros((t + 1, d), h.dtype).at[buf_tok].add(yb.reshape(-1, d) * buf_w[:, None])
    return y[:t]


def setup_inputs(seed: int = 0) -> dict:
    key = jax.random.key(seed)
    keys = iter(jax.random.split(key, 64))

    def nrm(shape, scale):
        return scale * jax.random.normal(next(keys), shape, jnp.float32)

    def unif(shape, lo, hi):
        return jax.random.uniform(next(keys), shape, jnp.float32, lo, hi)

    G, H = GROUP_W, N_HEADS
    lru_p = unif((DEPTH, 2, G), 0.9, 0.999) ** (1.0 / LRU_C)
    dt = jnp.exp(unif((DEPTH, 2, H), math.log(1e-3), math.log(1e-1)))
    return {
        'x': nrm((BATCH, SEQ, D_MODEL), 1.0),
        'c': nrm((BATCH, D_MODEL), 1.0),
        'ctx': nrm((BATCH, CTX_LEN, D_MODEL), 1.0),
        'c_ctx': nrm((D_MODEL,), 1.0),
        'mod_w': nrm((DEPTH, D_MODEL, 6 * D_MODEL), 0.5 * D_MODEL ** -0.5),
        'mod_b': nrm((DEPTH, 6 * D_MODEL), 0.02),
        'norm_mix_g': 1.0 + nrm((DEPTH, D_MODEL), 0.02),
        'norm_ffn_g': 1.0 + nrm((DEPTH, D_MODEL), 0.02),
        'w_in': nrm((DEPTH, D_MODEL, IN_COLS), D_MODEL ** -0.5),
        'w_out': nrm((DEPTH, D_MODEL, D_MODEL), D_MODEL ** -0.5),
        'lru_conv_w': nrm((DEPTH, CONV_W, G), CONV_W ** -0.5),
        'lru_conv_b': nrm((DEPTH, G), 0.02),
        'lru_w_a': nrm((DEPTH, 2, H, HEAD_DIM, HEAD_DIM), HEAD_DIM ** -0.5),
        'lru_b_a': nrm((DEPTH, 2, G), 0.02),
        'lru_w_x': nrm((DEPTH, 2, H, HEAD_DIM, HEAD_DIM), HEAD_DIM ** -0.5),
        'lru_b_x': nrm((DEPTH, 2, G), 0.02),
        'lru_lambda': jnp.log(lru_p) - jnp.log1p(-lru_p),
        'rwkv_mu': unif((DEPTH, 2, B_COLS), 0.0, 0.5),
        'rwkv_w_up': nrm((DEPTH, 2, RWKV_LORA_W, G), 0.1),
        'rwkv_w0': unif((DEPTH, 2, G), -3.0, 2.0),
        'rwkv_a_up': nrm((DEPTH, 2, RWKV_LORA_A, G), 0.1),
        'rwkv_a0': nrm((DEPTH, 2, G), 0.1),
        'rwkv_g_up': nrm((DEPTH, RWKV_LORA_G, G), RWKV_LORA_G ** -0.5),
        'rwkv_k_k': 0.85 + nrm((DEPTH, G), 0.02),
        'rwkv_k_a': 1.0 + nrm((DEPTH, G), 0.02),
        'rwkv_r_k': nrm((DEPTH, G), 0.1),
        'rwkv_ln_g': 1.0 + nrm((DEPTH, G), 0.02),
        'rwkv_ln_b': nrm((DEPTH, G), 0.02),
        'mlstm_i_b': nrm((DEPTH, 2, H), 0.1),
        'mlstm_f_b': jnp.linspace(3.0, 6.0, H, dtype=jnp.float32) + nrm((DEPTH, 2, H), 0.05),
        'mlstm_norm_g': 1.0 + nrm((DEPTH, G), 0.02),
        'gdn_conv_w': nrm((DEPTH, CONV_W, 3 * G), CONV_W ** -0.5),
        'gdn_a_log': jnp.log(unif((DEPTH, 2, H), 1.0, 16.0)),
        'gdn_dt_bias': dt + jnp.log(-jnp.expm1(-dt)),
        'gdn_norm_g': 1.0 + nrm((DEPTH, G), 0.02),
        'ffn_w_gate': nrm((N_DENSE, D_MODEL, D_FF), D_MODEL ** -0.5),
        'ffn_w_up': nrm((N_DENSE, D_MODEL, D_FF), D_MODEL ** -0.5),
        'ffn_w_down': nrm((N_DENSE, D_FF, D_MODEL), D_FF ** -0.5),
        'moe_router': nrm((N_MOE, D_MODEL, N_EXPERTS), D_MODEL ** -0.5),
        'moe_w_gate': nrm((N_MOE, N_EXPERTS, D_MODEL, D_FF_EXPERT), D_MODEL ** -0.5),
        'moe_w_up': nrm((N_MOE, N_EXPERTS, D_MODEL, D_FF_EXPERT), D_MODEL ** -0.5),
        'moe_w_down': nrm((N_MOE, N_EXPERTS, D_FF_EXPERT, D_MODEL), D_FF_EXPERT ** -0.5),
        'final_norm_g': 1.0 + nrm((D_MODEL,), 0.02),
    }


def reference(x, c, ctx, c_ctx, mod_w, mod_b, norm_mix_g, norm_ffn_g, w_in, w_out,
              lru_conv_w, lru_conv_b, lru_w_a, lru_b_a, lru_w_x, lru_b_x, lru_lambda,
              rwkv_mu, rwkv_w_up, rwkv_w0, rwkv_a_up, rwkv_a0, rwkv_g_up, rwkv_k_k, rwkv_k_a,
              rwkv_r_k, rwkv_ln_g, rwkv_ln_b, mlstm_i_b, mlstm_f_b, mlstm_norm_g,
              gdn_conv_w, gdn_a_log, gdn_dt_bias, gdn_norm_g,
              ffn_w_gate, ffn_w_up, ffn_w_down, moe_router, moe_w_gate, moe_w_up, moe_w_down,
              final_norm_g):
    rows = x.shape[1] // GRID_W
    silu_c = jax.nn.silu(c)
    silu_cc = jax.nn.silu(c_ctx)
    xc = ctx
    for l in range(DEPTH):
        last = l == DEPTH - 1
        mod = silu_c @ mod_w[l] + mod_b[l]
        mod_c = silu_cc @ mod_w[l] + mod_b[l]
        sh1, sc1, gt1, sh2, sc2, gt2 = [m[:, None] for m in jnp.split(mod, 6, axis=-1)]
        csh1, csc1, cgt1, csh2, csc2, cgt2 = jnp.split(mod_c, 6, axis=-1)
        h = rms_norm(x, norm_mix_g[l]) * (1.0 + sc1) + sh1
        hc = rms_norm(xc, norm_mix_g[l]) * (1.0 + csc1) + csh1
        p = h @ w_in[l]
        pc = hc @ w_in[l]
        ya_c, ya = rglru_mixer(pc[..., :OFF_B], p[..., :OFF_B], lru_conv_w[l], lru_conv_b[l],
                               lru_w_a[l], lru_b_a[l], lru_w_x[l], lru_b_x[l], lru_lambda[l], not last)
        yb_c, yb = rwkv7_mixer(pc[..., OFF_B:OFF_C], p[..., OFF_B:OFF_C], rwkv_mu[l], rwkv_w_up[l],
                               rwkv_w0[l], rwkv_a_up[l], rwkv_a0[l], rwkv_g_up[l], rwkv_k_k[l],
                               rwkv_k_a[l], rwkv_r_k[l], rwkv_ln_g[l], rwkv_ln_b[l], not last)
        yc_c, yc = mlstm_mixer(pc[..., OFF_C:OFF_D], p[..., OFF_C:OFF_D], mlstm_i_b[l], mlstm_f_b[l],
                               mlstm_norm_g[l], rows, not last)
        yd_c, yd = gdn_mixer(pc[..., OFF_D:], p[..., OFF_D:], gdn_conv_w[l], gdn_a_log[l],
                             gdn_dt_bias[l], gdn_norm_g[l], rows, not last)
        x = x + gt1 * (jnp.concatenate([ya, yb, yc, yd], axis=-1) @ w_out[l])
        if not last:
            xc = xc + cgt1 * (jnp.concatenate([ya_c, yb_c, yc_c, yd_c], axis=-1) @ w_out[l])
        h2 = rms_norm(x, norm_ffn_g[l]) * (1.0 + sc2) + sh2
        tokens = h2.reshape(-1, D_MODEL)
        n_lat = tokens.shape[0]
        if not last:
            hc2 = rms_norm(xc, norm_ffn_g[l]) * (1.0 + csc2) + csh2
            tokens = jnp.concatenate([tokens, hc2.reshape(-1, D_MODEL)], axis=0)
        if l % 2 == 0:
            y = swiglu(tokens, ffn_w_gate[l // 2], ffn_w_up[l // 2], ffn_w_down[l // 2])
        else:
            y = moe_swiglu(tokens, moe_router[l // 2], moe_w_gate[l // 2], moe_w_up[l // 2],
                           moe_w_down[l // 2])
        x = x + gt2 * y[:n_lat].reshape(x.shape)
        if not last:
            xc = xc + cgt2 * y[n_lat:].reshape(xc.shape)
    return rms_norm(x, final_norm_g)
```

```cpp
#define MK_ONE_LAUNCH 0
#include <hip/hip_runtime.h>
#include <cstdio>
#include <cstdint>

#define GAS __attribute__((address_space(1)))
#define LAS __attribute__((address_space(3)))
typedef unsigned short bf16;
typedef unsigned v4u __attribute__((ext_vector_type(4)));
typedef unsigned v2u __attribute__((ext_vector_type(2)));
typedef float f32x4 __attribute__((ext_vector_type(4)));
typedef float f32x2 __attribute__((ext_vector_type(2)));
typedef short bf16x8 __attribute__((ext_vector_type(8)));
#define LDS_WAIT() asm volatile("s_waitcnt lgkmcnt(0)" ::: "memory")
#define VM_WAIT() asm volatile("s_waitcnt vmcnt(0)" ::: "memory")

constexpr int DM = 1024, NB = 8, SEQ = 4096, DEPTH = 4, CTXL = 256, GW = 256, HD = 64, NH = 4;
constexpr int T_LAT = NB * SEQ, T_CTX = NB * CTXL, T_ALL = T_LAT + T_CTX;
constexpr int IN_COLS = 3552, PLD = 3584;
constexpr int OFF_B = 512, OFF_C = 1472, OFF_D = 2512, B_COLS = 960;
constexpr int DFF = 2816, NE = 8, DFE = 1408;
constexpr int NCH = 68;
constexpr int NSTEP = 4352;
constexpr int MOE_MAXBLK = 280;
constexpr int NWAVES = 8, NTHR = 512;

constexpr size_t MiB = 1u << 20;
constexpr size_t WS_CTL = 0, CTL_BYTES = 1 * MiB;
constexpr size_t WS_MODV = 1 * MiB;
constexpr size_t WS_XC = 2 * MiB;
constexpr size_t WS_WIN = 10 * MiB;
constexpr size_t WS_WOUT = 17 * MiB;
constexpr size_t WS_WGU = 19 * MiB;
constexpr size_t WS_WDN = 63 * MiB;
constexpr size_t WS_HB = 85 * MiB;
constexpr size_t WS_P = 153 * MiB;
constexpr size_t WS_MIX = 391 * MiB;
constexpr size_t WS_OUTB = WS_MIX, WS_OUTC = WS_MIX + 34 * MiB, WS_OUTD = WS_MIX + 68 * MiB, WS_GQ = WS_MIX + 102 * MiB, WS_G = WS_MIX + 153 * MiB;
constexpr size_t WS_SMALL = 561 * MiB;
constexpr size_t WS_LSUM = WS_SMALL;
constexpr size_t WS_HIN = WS_SMALL + 3 * MiB;
constexpr size_t WS_ROUTE = WS_SMALL + 5 * MiB;
constexpr size_t WS_POS = WS_SMALL + 7 * MiB;
constexpr size_t WS_BONUS = WS_SMALL + 8 * MiB;
constexpr size_t WS_WGBASE = WS_SMALL + 9 * MiB;
constexpr size_t WS_TAB = WS_WGBASE + 65536;
constexpr size_t WS_END = 571 * MiB;
constexpr int CW_MOECNT = 1024;
constexpr int CW_BAR = 4096;

constexpr int LDS_BYTES = 135168;
constexpr int MISC_OFF = 131072;

__device__ __forceinline__ unsigned f2bf(float f) { unsigned u = __builtin_bit_cast(unsigned, f); return (u + 0x7fffu + ((u >> 16) & 1u)) >> 16; }
__device__ __forceinline__ unsigned pk2(float lo, float hi) { return f2bf(lo) | (f2bf(hi) << 16); }
__device__ __forceinline__ float bf2f(unsigned short v) { return __builtin_bit_cast(float, (unsigned)v << 16); }
__device__ __forceinline__ float bflo(unsigned v) { return __builtin_bit_cast(float, v << 16); }
__device__ __forceinline__ float bfhi(unsigned v) { return __builtin_bit_cast(float, v & 0xffff0000u); }
__device__ __forceinline__ float wave_sum(float v) {
#pragma unroll
    for (int o = 1; o < 64; o <<= 1) v += __shfl_xor(v, o);
    return v;
}
template <int CTRL> __device__ __forceinline__ float dpp_f(float v) { return __builtin_bit_cast(float, __builtin_amdgcn_update_dpp(0, __builtin_bit_cast(int, v), CTRL, 0xF, 0xF, true)); }
__device__ __forceinline__ float row16_sum(float v) {
    v += dpp_f<0xB1>(v);
    v += dpp_f<0x4E>(v);
    v += dpp_f<0x141>(v);
    v += dpp_f<0x140>(v);
    return v;
}
__device__ __forceinline__ float sigmoidf_(float x) { return 1.0f / (1.0f + __expf(-x)); }
__device__ __forceinline__ float softplusf_(float x) { return fmaxf(x, 0.f) + __logf(1.0f + __expf(-fabsf(x))); }
__device__ __forceinline__ float expm1f_(float x) { return x > -0.3f ? x * (1.0f + x * (0.5f + x * (0.16666667f + x * (0.041666668f + x * 0.0083333338f)))) : __expf(x) - 1.0f; }
__device__ __forceinline__ float siluf_(float x) { return x / (1.0f + __expf(-x)); }
__device__ __forceinline__ float tanhf_(float x) { const float e = __expf(2.0f * x); return 1.0f - 2.0f / (e + 1.0f); }
__device__ __forceinline__ float gelu_tanh(float x) { return 0.5f * x * (1.0f + tanhf_(0.7978845608028654f * (x + 0.044715f * x * x * x))); }
#define XB_TMO      128
#define XB_XCNT(j)  (256  + 64 * (j))
#define XB_XSUB(j)  (1280 + 64 * (j))
#define XB_XGEN(j)  (2304 + 64 * (j))
#define XB_TOP      3328
#define XB_TOPGEN   3392
#define XCD_BAR_WORDS 3456
#define XB_SPIN_CAP (1u << 18)

__device__ __forceinline__ unsigned xb_ld(unsigned* p)              { return __hip_atomic_load(p, __ATOMIC_RELAXED, __HIP_MEMORY_SCOPE_AGENT); }
__device__ __forceinline__ unsigned xb_add(unsigned* p, unsigned v) { return __hip_atomic_fetch_add(p, v, __ATOMIC_RELAXED, __HIP_MEMORY_SCOPE_AGENT); }
__device__ __forceinline__ unsigned xb_xcc_id() { return (unsigned)__builtin_amdgcn_s_getreg((3 << 11) | 20) & 0xFu; }
#define XB_SPIN(cond, bar) do { unsigned _sp = 0; while (cond) { __builtin_amdgcn_s_sleep(1); \
    if ((++_sp & 255u) == 0u) { if (xb_ld(&(bar)[XB_TMO])) break; if (_sp > XB_SPIN_CAP) { atomicAdd(&(bar)[XB_TMO], 1u); break; } } } } while (0)

struct XcdBarrier {
    unsigned* bar; unsigned x;
    volatile LAS unsigned* st;
};

__device__ __forceinline__ XcdBarrier xcd_barrier_post(unsigned* bar, volatile LAS unsigned* st) {
    XcdBarrier b; b.bar = bar; b.x = xb_xcc_id(); b.st = st;
    if (threadIdx.x == 0) (void)xb_add(&bar[XB_XCNT(b.x)], 1u);
    return b;
}
__device__ __forceinline__ void xcd_barrier_complete(unsigned* bar, unsigned x, unsigned& nloc, unsigned& nx) {
    const unsigned G = gridDim.x * gridDim.y * gridDim.z;
    unsigned sum, cnt, mine, sp = 0u;
    for (;;) {
        sum = 0u; cnt = 0u; mine = 0u;
#pragma unroll
        for (unsigned j = 0; j < 16; ++j) { const unsigned c = xb_ld(&bar[XB_XCNT(j)]); sum += c; cnt += (c > 0u) ? 1u : 0u; mine = (j == x) ? c : mine; }
        if (sum == G) break;
        __builtin_amdgcn_s_sleep(1);
        if ((++sp & 255u) == 0u) { if (xb_ld(&bar[XB_TMO])) break; if (sp > XB_SPIN_CAP) { atomicAdd(&bar[XB_TMO], 1u); break; } }
    }
    nloc = mine > 0u ? mine : 1u; nx = cnt > 0u ? cnt : 1u;
}

__device__ __forceinline__ void xcd_barrier(const XcdBarrier& b) {
    asm volatile("s_waitcnt vmcnt(0)" ::: "memory");
    __syncthreads();
    if (threadIdx.x == 0) {
        unsigned* bar = b.bar;
        __builtin_amdgcn_s_waitcnt(0);
        unsigned nloc = b.st[0], nx = b.st[1];
        if (nloc == 0u) { xcd_barrier_complete(bar, b.x, nloc, nx); b.st[0] = nloc; b.st[1] = nx; }
        const unsigned old = xb_add(&bar[XB_XSUB(b.x)], 1u);
        const unsigned gen = old / nloc;
        if (old + 1u == (gen + 1u) * nloc) {
            __builtin_amdgcn_fence(__ATOMIC_RELEASE, "agent");
            asm volatile("s_waitcnt vmcnt(0)" ::: "memory");
            const unsigned og = xb_add(&bar[XB_TOP], 1u);
            const unsigned tg = og / nx;
            if (og + 1u == (tg + 1u) * nx) xb_add(&bar[XB_TOPGEN], 1u);
            else XB_SPIN(xb_ld(&bar[XB_TOPGEN]) == tg, bar);
            __builtin_amdgcn_fence(__ATOMIC_ACQUIRE, "agent");
            xb_add(&bar[XB_XGEN(b.x)], 1u);
            asm volatile("s_waitcnt vmcnt(0)" ::: "memory");
        } else {
            XB_SPIN(xb_ld(&bar[XB_XGEN(b.x)]) == gen, bar);
            __builtin_amdgcn_fence(__ATOMIC_ACQUIRE, "agent");
            asm volatile("s_waitcnt vmcnt(0)" ::: "memory");
        }
    }
    __syncthreads();
}

namespace pg8 {
#define PG8_LAS __attribute__((address_space(3)))
typedef unsigned short bf16_t;
typedef short bf16x8 __attribute__((ext_vector_type(8)));
typedef float f32x4 __attribute__((ext_vector_type(4)));
typedef unsigned u32x4 __attribute__((ext_vector_type(4)));
constexpr int BM = 256, BK = 64, HALF = 128, HTB = HALF * BK * 2  , STAGE_BYTES = 8 * HTB, NXCD = 8, WGM = 8;

__host__ __device__ __forceinline__ int lds_byte(int r, int c) { const int st = (r >> 4) * 2 + (c >> 5), rr = r & 15, cc = c & 31, ob = rr * 64 + cc * 2; return st * 1024 + (ob ^ (((ob >> 9) & 1) << 5)); }
__host__ __device__ __forceinline__ void stage_rc(int b, int& R, int& C) { const int st = b / 1024, sb = b % 1024, swz = sb ^ (((sb >> 9) & 1) << 5); R = (st >> 1) * 16 + swz / 64; C = (st & 1) * 32 + (swz % 64) / 2; }
__host__ __device__ __forceinline__ int perm32(int rho) { const int n = rho >> 4, i = rho & 15; return 8 * (i >> 2) + 4 * n + (i & 3); }

struct Unit { int pm, pn, e; };
struct Gemm { const bf16_t* A; const bf16_t* Bt; int M, N, K; size_t estride; };

struct StaticOrder {
    int nM, nN, nwg, G, c;
    __host__ __device__ void init(int M, int N, int G_, int c_) { nM = M / BM; nN = N / BM; nwg = nM * nN; G = G_; c = c_; }
    __host__ __device__ bool next(int i, Unit& u) const {
        const long L = (long)i * G + c; if (L >= nwg) return false;
        int wgid = (int)L; { const int q = nwg / NXCD, r = nwg % NXCD, xcd = wgid % NXCD, off = wgid / NXCD; wgid = (xcd < r ? xcd * (q + 1) : r * (q + 1) + (xcd - r) * q) + off; }
        const int nig = WGM * nN, gid = wgid / nig, fm = gid * WGM, gsz = (nM - fm) < WGM ? (nM - fm) : WGM;
        u.pm = fm + ((wgid % nig) % gsz); u.pn = (wgid % nig) / gsz; u.e = 0; return true;
    }
    __device__ __forceinline__ void a_ready(const Unit&) const {}
    __device__ __forceinline__ void done(const Unit&) const {}
};
__device__ __forceinline__ unsigned cvt_pk_bf16(float lo, float hi) { unsigned r; asm volatile("v_cvt_pk_bf16_f32 %0, %1, %2" : "=v"(r) : "v"(lo), "v"(hi)); return r; }
typedef float f32x2 __attribute__((ext_vector_type(2)));
__device__ __forceinline__ f32x2 gelu_pk(f32x2 v) {
    const f32x2 av = __builtin_elementwise_abs(v), d = av * 0.2316418882f + 1.0f;
    f32x2 t; t.x = __builtin_amdgcn_rcpf(d.x); t.y = __builtin_amdgcn_rcpf(d.y);
    f32x2 q = t * 0.5307027145f + (-0.7265760135f); q = q * t + 0.7107068705f; q = q * t + (-0.142248368f); q = q * t + 0.127414796f; q = q * t;
    const f32x2 s = (v * v) * (-0.72134752044f);
    f32x2 e; e.x = __builtin_amdgcn_exp2f(s.x); e.y = __builtin_amdgcn_exp2f(s.y);
    const f32x2 m = v * (q * e), r = v - m;
    f32x2 o; o.x = v.x < 0.f ? m.x : r.x; o.y = v.y < 0.f ? m.y : r.y; return o;
}

struct EpiF32 {
    static constexpr bool PERM = false, AFTER_DRAIN = false;
    float* C; int ldc; const float* bias;
    __device__ __forceinline__ void operator()(const f32x4 (&acc)[2][2][4][2], const Unit& u, int wr, int wc, int fr, int fq) const {
        const int row0 = u.pm * BM + wr * 64 + fr, col0 = u.pn * BM + wc * 32 + 4 * fq;
        f32x4 bv[2][2];
#pragma unroll
        for (int bj = 0; bj < 2; ++bj)
#pragma unroll
            for (int n = 0; n < 2; ++n) bv[bj][n] = bias ? *(const f32x4*)(bias + col0 + bj * HALF + n * 16) : (f32x4){0.f, 0.f, 0.f, 0.f};
#pragma unroll
        for (int ai = 0; ai < 2; ++ai)
#pragma unroll
            for (int m = 0; m < 4; ++m) { float* rowp = C + (size_t)(row0 + ai * HALF + m * 16) * ldc + col0;
#pragma unroll
                for (int bj = 0; bj < 2; ++bj)
#pragma unroll
                    for (int n = 0; n < 2; ++n) *(f32x4*)(rowp + bj * HALF + n * 16) = acc[ai][bj][m][n] + bv[bj][n]; }
    }
};
template <int ACT  > struct EpiBf16 {
    static constexpr bool PERM = true, AFTER_DRAIN = false;
    bf16_t* O; int ldc; const float* bias; int split_cols; size_t split_stride;
    __device__ __forceinline__ void operator()(const f32x4 (&acc)[2][2][4][2], const Unit& u, int wr, int wc, int fr, int fq) const {
        const int row0 = u.pm * BM + wr * 64 + fr; int colt = u.pn * BM; bf16_t* base = O;
        if (split_cols) { const int t = colt / split_cols; base += (size_t)t * split_stride; colt -= t * split_cols; }
        const int col0 = colt + wc * 32 + 8 * fq, bcol0 = u.pn * BM + wc * 32 + 8 * fq;
        f32x4 bv[2][2];
#pragma unroll
        for (int bj = 0; bj < 2; ++bj)
#pragma unroll
            for (int n = 0; n < 2; ++n) bv[bj][n] = bias ? *(const f32x4*)(bias + bcol0 + bj * HALF + 4 * n) : (f32x4){0.f, 0.f, 0.f, 0.f};
#pragma unroll
        for (int ai = 0; ai < 2; ++ai)
#pragma unroll
            for (int m = 0; m < 4; ++m) { bf16_t* rowp = base + (size_t)(row0 + ai * HALF + m * 16) * ldc + col0;
#pragma unroll
                for (int bj = 0; bj < 2; ++bj) { f32x4 v0 = acc[ai][bj][m][0] + bv[bj][0], v1 = acc[ai][bj][m][1] + bv[bj][1];
                    if (ACT == 1) { f32x2 a = gelu_pk((f32x2){v0[0], v0[1]}), b = gelu_pk((f32x2){v0[2], v0[3]}), c = gelu_pk((f32x2){v1[0], v1[1]}), d = gelu_pk((f32x2){v1[2], v1[3]});
                        v0 = (f32x4){a.x, a.y, b.x, b.y}; v1 = (f32x4){c.x, c.y, d.x, d.y}; }
                    if (ACT == 2) {
#pragma unroll
                        for (int j = 0; j < 4; ++j) { v0[j] = 0.5f * v0[j] * (1.0f + erff(v0[j] * 0.70710678f)); v1[j] = 0.5f * v1[j] * (1.0f + erff(v1[j] * 0.70710678f)); } }
                    u32x4 w; w.x = cvt_pk_bf16(v0[0], v0[1]); w.y = cvt_pk_bf16(v0[2], v0[3]); w.z = cvt_pk_bf16(v1[0], v1[1]); w.w = cvt_pk_bf16(v1[2], v1[3]);
                    *(u32x4*)(rowp + bj * HALF) = w; } }
    }
};

template <class Epi, class Sched, bool STAMP = false>
__device__ __forceinline__ void gemm_phase(PG8_LAS unsigned char* lds, const Gemm g, const Sched& S, const Epi& E, unsigned long long* stamps) {
    int tid_ = threadIdx.x; asm volatile("" : "+v"(tid_));
    const int tid = tid_, wid = __builtin_amdgcn_readfirstlane(tid >> 6), lane = tid & 63, wr = wid >> 2, wc = wid & 3, fr = lane & 15, fq = lane >> 4;
    const int K = g.K, nt = K / BK;
    int ts_lo = 0, ts_hi = 0, nts = 0; const unsigned long long rt_entry = STAMP ? (unsigned long long)wall_clock64() : 0ull;
#define PG8_STAMP() do { if (STAMP && wid == 0 && nts < 64) { const unsigned long long _c = (unsigned long long)clock64(); \
        ts_lo = (lane == nts) ? (int)(unsigned)_c : ts_lo; ts_hi = (lane == nts) ? (int)(unsigned)(_c >> 32) : ts_hi; ++nts; } } while (0)
    PG8_STAMP();
    unsigned voffA[2], voffB[2];
#pragma unroll
    for (int i = 0; i < 2; ++i) { int R, C; stage_rc(tid * 16 + i * 8192, R, C); const int Rb = Epi::PERM ? ((R & ~31) + perm32(R & 31)) : R;
        voffA[i] = (unsigned)(R * K + C) * 2u; voffB[i] = (unsigned)(Rb * K + C) * 2u; }
    const size_t kstep = (size_t)(BK * 2);
    const size_t hstep = (size_t)HALF * K * 2;
    const size_t tstep = 2 * hstep;
    const unsigned ldsw = (unsigned)wid * 1024u;
    const int aoff = lds_byte(wr * 64 + fr, fq * 8), boff = lds_byte(wc * 32 + fr, fq * 8);
#define PG8_SA(b, h) (((b) * 2 + (h)) * HTB)
#define PG8_SB(b, h) ((4 + (b) * 2 + (h)) * HTB)
#define PG8_STAGE(bufoff, gbase, voff) do { _Pragma("unroll") for (int _i = 0; _i < 2; ++_i) \
        __builtin_amdgcn_global_load_lds((const unsigned*)((const char*)(gbase) + (voff)[_i]), (PG8_LAS unsigned*)(lds + (bufoff) + ldsw + _i * 8192), 16, 0, 0); } while (0)
#define PG8_LDA(dst, b, h) do { _Pragma("unroll") for (int m = 0; m < 4; ++m) _Pragma("unroll") for (int k = 0; k < 2; ++k) dst[m][k] = *(const PG8_LAS bf16x8*)(lds + PG8_SA(b, h) + aoff + m * 2048 + k * 1024); } while (0)
#define PG8_LDB(dst, b, h) do { _Pragma("unroll") for (int n = 0; n < 2; ++n) _Pragma("unroll") for (int k = 0; k < 2; ++k) dst[n][k] = *(const PG8_LAS bf16x8*)(lds + PG8_SB(b, h) + boff + n * 2048 + k * 1024); } while (0)
#define PG8_MMA(ai, bj, At, Bt) do { __builtin_amdgcn_s_setprio(1); _Pragma("unroll") for (int m = 0; m < 4; ++m) _Pragma("unroll") for (int n = 0; n < 2; ++n) _Pragma("unroll") for (int k = 0; k < 2; ++k) \
        acc[ai][bj][m][n] = __builtin_amdgcn_mfma_f32_16x16x32_bf16(Bt[n][k], At[m][k], acc[ai][bj][m][n], 0, 0, 0); __builtin_amdgcn_s_setprio(0); } while (0)
#define PG8_WAIT_V(n) asm volatile("s_waitcnt vmcnt(" #n ")" ::: "memory")
#define PG8_WAIT_L(n) asm volatile("s_waitcnt lgkmcnt(" #n ")" ::: "memory")
#define PG8_BAR __builtin_amdgcn_s_barrier()
#define PG8_SCHED __builtin_amdgcn_sched_barrier(0)
    Unit cur, nxt; int ui = 0;
    if (!S.next(0, cur)) return;
    f32x4 acc[2][2][4][2];
#pragma unroll
    for (int a = 0; a < 2; ++a)
#pragma unroll
        for (int b = 0; b < 2; ++b)
#pragma unroll
            for (int m = 0; m < 4; ++m)
#pragma unroll
                for (int n = 0; n < 2; ++n) acc[a][b][m][n] = (f32x4){0.f, 0.f, 0.f, 0.f};
    bf16x8 At[4][2], B0[2][2], B1[2][2];
    const char* cA = (const char*)g.A + (size_t)cur.pm * tstep; const char* cB = (const char*)g.Bt + (size_t)cur.pn * tstep + (size_t)cur.e * g.estride * 2;
    S.a_ready(cur);
    PG8_STAGE(PG8_SB(0, 0), cB, voffB); PG8_STAGE(PG8_SA(0, 0), cA, voffA); PG8_STAGE(PG8_SB(0, 1), cB + hstep, voffB); PG8_STAGE(PG8_SA(0, 1), cA + hstep, voffA);
    if (wr == 1) PG8_BAR;
    PG8_WAIT_V(4); PG8_BAR;
    PG8_STAGE(PG8_SB(1, 0), cB + kstep, voffB); PG8_STAGE(PG8_SA(1, 0), cA + kstep, voffA); PG8_STAGE(PG8_SB(1, 1), cB + hstep + kstep, voffB);
    PG8_WAIT_V(6); PG8_BAR;
    PG8_STAMP();
    for (;;) {
        const bool has_next = S.next(ui + 1, nxt);
        const char* nA = has_next ? (const char*)g.A + (size_t)nxt.pm * tstep : cA; const char* nB = has_next ? (const char*)g.Bt + (size_t)nxt.pn * tstep + (size_t)nxt.e * g.estride * 2 : cB;
        for (int t = 0; t < nt; t += 2) {
            const bool last = (t == nt - 2);
            const char* a1 = cA + (size_t)(t + 1) * kstep;
            const char* a2 = last ? nA : cA + (size_t)(t + 2) * kstep; const char* b2 = last ? nB : cB + (size_t)(t + 2) * kstep;
            const char* a3 = a2 + kstep; const char* b3 = b2 + kstep;
            if (last && has_next) S.a_ready(nxt);
            PG8_LDB(B0, 0, 0); PG8_SCHED; PG8_LDA(At, 0, 0); PG8_STAGE(PG8_SA(1, 1), a1 + hstep, voffA);
            PG8_WAIT_L(8); PG8_BAR; PG8_WAIT_L(0); PG8_MMA(0, 0, At, B0); PG8_BAR; PG8_SCHED;
            PG8_LDB(B1, 0, 1); PG8_STAGE(PG8_SB(0, 0), b2, voffB);
            PG8_BAR; PG8_WAIT_L(0); PG8_MMA(0, 1, At, B1); PG8_BAR;
            PG8_LDA(At, 0, 1); PG8_STAGE(PG8_SA(0, 0), a2, voffA);
            PG8_BAR; PG8_WAIT_L(0); PG8_MMA(1, 0, At, B0); PG8_BAR; PG8_SCHED;
            PG8_STAGE(PG8_SB(0, 1), b2 + hstep, voffB);
            PG8_WAIT_V(6); PG8_BAR; PG8_MMA(1, 1, At, B1); PG8_BAR;
            PG8_LDB(B0, 1, 0); PG8_SCHED; PG8_LDA(At, 1, 0); PG8_STAGE(PG8_SA(0, 1), a2 + hstep, voffA);
            PG8_WAIT_L(8); PG8_BAR; PG8_WAIT_L(0); PG8_MMA(0, 0, At, B0); PG8_BAR; PG8_SCHED;
            PG8_LDB(B1, 1, 1); PG8_STAGE(PG8_SB(1, 0), b3, voffB);
            PG8_BAR; PG8_WAIT_L(0); PG8_MMA(0, 1, At, B1); PG8_BAR;
            PG8_LDA(At, 1, 1); PG8_STAGE(PG8_SA(1, 0), a3, voffA);
            PG8_BAR; PG8_WAIT_L(0); PG8_MMA(1, 0, At, B0); PG8_BAR; PG8_SCHED;
            PG8_STAGE(PG8_SB(1, 1), b3 + hstep, voffB);
            PG8_WAIT_V(6); PG8_BAR; PG8_MMA(1, 1, At, B1); PG8_BAR;
        }
        PG8_STAMP();
        if constexpr (!Epi::AFTER_DRAIN) { E(acc, cur, wr, wc, fr, fq); S.done(cur); }
        PG8_STAMP();
        if (!has_next) break;
#pragma unroll
        for (int a = 0; a < 2; ++a)
#pragma unroll
            for (int b = 0; b < 2; ++b)
#pragma unroll
                for (int m = 0; m < 4; ++m)
#pragma unroll
                    for (int n = 0; n < 2; ++n) acc[a][b][m][n] = (f32x4){0.f, 0.f, 0.f, 0.f};
        cur = nxt; cA = nA; cB = nB; ++ui;
    }
    PG8_WAIT_V(0);
    if (wr == 0) PG8_BAR;
    PG8_BAR;
    if constexpr (Epi::AFTER_DRAIN) { E.fused(acc, cur, wr, wc, fr, fq, lds, wid, lane); S.done(cur); }
    PG8_STAMP();
    if (STAMP && wid == 0) { stamps[lane] = lane < nts ? (((unsigned long long)(unsigned)ts_hi << 32) | (unsigned)ts_lo) : 0ull;
        if (lane == 62) stamps[62] = rt_entry; if (lane == 63) stamps[63] = (unsigned long long)wall_clock64(); }
#undef PG8_STAMP
#undef PG8_SA
#undef PG8_SB
#undef PG8_STAGE
#undef PG8_LDA
#undef PG8_LDB
#undef PG8_MMA
#undef PG8_WAIT_V
#undef PG8_WAIT_L
#undef PG8_BAR
#undef PG8_SCHED
}
}
namespace pg8 {
struct EpiRes {
    static constexpr bool PERM = false, AFTER_DRAIN = false;
    const float* base_lat; const float* base_ctx; float* out_lat; float* out_ctx; const float* gvec;
    __device__ __forceinline__ void operator()(const f32x4 (&acc)[2][2][4][2], const Unit& u, int wr, int wc, int fr, int fq) const {
        const bool isctx = u.pm >= 128;
        const int prow = (isctx ? (u.pm - 128) : u.pm) * BM;
        const float* base = isctx ? base_ctx : base_lat; float* out = isctx ? out_ctx : out_lat;
        const float* gv = gvec + (size_t)(isctx ? 8 : (u.pm >> 4)) * 6144;
        const int row0 = prow + wr * 64 + fr, col0 = u.pn * BM + wc * 32 + 4 * fq;
        f32x4 gvv[2][2];
#pragma unroll
        for (int bj = 0; bj < 2; ++bj)
#pragma unroll
            for (int n = 0; n < 2; ++n) gvv[bj][n] = *(const f32x4*)(gv + col0 + bj * HALF + n * 16);
#pragma unroll
        for (int ai = 0; ai < 2; ++ai)
#pragma unroll
            for (int m = 0; m < 4; ++m) { const size_t off = (size_t)(row0 + ai * HALF + m * 16) * 1024 + col0;
#pragma unroll
                for (int bj = 0; bj < 2; ++bj)
#pragma unroll
                    for (int n = 0; n < 2; ++n) { const f32x4 b = *(const f32x4*)(base + off + bj * HALF + n * 16);
                        *(f32x4*)(out + off + bj * HALF + n * 16) = b + gvv[bj][n] * acc[ai][bj][m][n]; } }
    }
};
struct EpiSwiglu {
    static constexpr bool PERM = true, AFTER_DRAIN = false;
    bf16_t* O; int ldc;
    __device__ __forceinline__ void operator()(const f32x4 (&acc)[2][2][4][2], const Unit& u, int wr, int wc, int fr, int fq) const {
        const int row0 = u.pm * BM + wr * 64 + fr, col0 = u.pn * HALF + wc * 32 + 8 * fq;
#pragma unroll
        for (int ai = 0; ai < 2; ++ai)
#pragma unroll
            for (int m = 0; m < 4; ++m) { bf16_t* rowp = O + (size_t)(row0 + ai * HALF + m * 16) * ldc + col0;
                float h[8];
#pragma unroll
                for (int n = 0; n < 2; ++n)
#pragma unroll
                    for (int j = 0; j < 4; ++j) { const float g = acc[ai][0][m][n][j], up = acc[ai][1][m][n][j]; h[n * 4 + j] = g * __builtin_amdgcn_rcpf(1.0f + __expf(-g)) * up; }
                u32x4 w; w.x = cvt_pk_bf16(h[0], h[1]); w.y = cvt_pk_bf16(h[2], h[3]); w.z = cvt_pk_bf16(h[4], h[5]); w.w = cvt_pk_bf16(h[6], h[7]);
                *(u32x4*)rowp = w; }
    }
};
struct MoeOrder {
    int nN, G, c, nunits; const int* tab;
    __device__ void init(const int* tab_, int nN_, int G_, int c_) { tab = tab_; nN = nN_; G = G_; c = c_; nunits = tab_[0] * nN_; }
    __device__ bool next(int i, Unit& u) const {
        const int L = i * G + c; if (L >= nunits) return false;
        u.pm = L / nN; u.pn = L - u.pm * nN; u.e = tab[1 + u.pm]; return true;
    }
    __device__ __forceinline__ void a_ready(const Unit&) const {}
    __device__ __forceinline__ void done(const Unit&) const {}
};
}
enum { I_X = 0, I_C, I_CTX, I_CCTX, I_MODW, I_MODB, I_NMIXG, I_NFFNG, I_WIN, I_WOUT, I_LCW, I_LCB, I_LWA, I_LBA, I_LWX, I_LBX, I_LLAM,
       I_RMU, I_RWUP, I_RW0, I_RAUP, I_RA0, I_RGUP, I_RKK, I_RKA, I_RRK, I_RLNG, I_RLNB, I_MIB, I_MFB, I_MNG, I_GCW, I_GALOG, I_GDTB, I_GNG,
       I_FWG, I_FWU, I_FWD, I_MROUTER, I_MWG, I_MWU, I_MWD, I_FNG, N_IN };
struct Args { const float* in[N_IN]; float* out; unsigned char* ws; int ph_lo, ph_hi; };
struct Ctx {
    const float* const* in; float* out; unsigned char* ws; LAS unsigned char* lds;
    int tid, lane, wave, G, wg;
};
#define WSP(T, off) ((T*)(C.ws + (off)))

__device__ __forceinline__ int seqrow_raster(int i, int d, int b) {
    if (i < CTXL) { const int p = d ? (CTXL - 1 - i) : i; return T_LAT + b * CTXL + p; }
    const int j = i - CTXL; const int p = d ? (SEQ - 1 - j) : j; return b * SEQ + p;
}
__device__ __forceinline__ int seqrow_cm(int i, int d, int b) {
    if (i < CTXL) { const int p = d ? (CTXL - 1 - i) : i; return T_LAT + b * CTXL + p; }
    const int j = i - CTXL; const int p = d ? (SEQ - 1 - j) : j; return b * SEQ + (p & 63) * 64 + (p >> 6);
}

__device__ __forceinline__ void phase_pre(const Ctx& C) {
    LAS float* sc = (LAS float*)C.lds;
    LAS float* red = sc + 9 * 1024;
    float* modv = WSP(float, WS_MODV);
    bool filled = false;
    for (int it = C.wg; it < DEPTH * 48; it += C.G) {
        if (!filled) {
            for (int i = C.tid; i < 9 * 1024; i += NTHR) { const float v = i < 8192 ? C.in[I_C][i] : C.in[I_CCTX][i - 8192]; sc[i] = siluf_(v); }
            filled = true; __syncthreads();
        }
        const int l = it / 48, jb = it % 48, col = C.tid & 127, kg = C.tid >> 7;
        const float* W = C.in[I_MODW] + (size_t)l * 1024 * 6144 + jb * 128 + col;
        float acc[9];
#pragma unroll
        for (int r = 0; r < 9; ++r) acc[r] = 0.f;
        for (int k = kg * 256; k < kg * 256 + 256; ++k) { const float w = W[(size_t)k * 6144];
#pragma unroll
            for (int r = 0; r < 9; ++r) acc[r] += sc[r * 1024 + k] * w; }
#pragma unroll
        for (int r = 0; r < 9; ++r) red[(kg * 9 + r) * 128 + col] = acc[r];
        __syncthreads();
        for (int i = C.tid; i < 9 * 128; i += NTHR) { const int r = i >> 7, cc = i & 127;
            const float s = red[(0 * 9 + r) * 128 + cc] + red[(1 * 9 + r) * 128 + cc] + red[(2 * 9 + r) * 128 + cc] + red[(3 * 9 + r) * 128 + cc];
            modv[((size_t)l * 9 + r) * 6144 + jb * 128 + cc] = s + C.in[I_MODB][l * 6144 + jb * 128 + cc]; }
        __syncthreads();
    }
}

__device__ __forceinline__ void tr_item(const float* src, size_t ld, int k0, int ns0, bf16* dst, int drow0, int Kd, LAS float* scr, int lane, bool zero) {
    if (!zero) {
#pragma unroll 8
        for (int i = 0; i < 32; ++i) { const int kk = 2 * i + (lane >> 5); scr[kk * 33 + (lane & 31)] = src[(size_t)(k0 + kk) * ld + ns0 + (lane & 31)]; }
    }
    LDS_WAIT(); asm volatile("" ::: "memory");
    const int c = lane & 7;
#pragma unroll
    for (int j = 0; j < 4; ++j) { const int n = (lane >> 3) + 8 * j; const LAS float* s = scr + (8 * c) * 33 + n;
        v4u o; o.x = pk2(s[0 * 33], s[1 * 33]); o.y = pk2(s[2 * 33], s[3 * 33]); o.z = pk2(s[4 * 33], s[5 * 33]); o.w = pk2(s[6 * 33], s[7 * 33]);
        if (zero) o = (v4u){0u, 0u, 0u, 0u};
        *(v4u*)(dst + (size_t)(drow0 + n) * Kd + k0 + 8 * c) = o; }
    LDS_WAIT(); asm volatile("" ::: "memory");
}
__device__ __forceinline__ void convert_layer(const Ctx& C, int l) {
    LAS float* scr = (LAS float*)(C.lds + C.wave * 8704);
    const int gw = C.wg * NWAVES + C.wave, NGW = C.G * NWAVES;
    constexpr int I_IN = 16 * 112, I_OUT = 16 * 32, I_GU = 16 * 176, I_DN = 44 * 32, I_E = 16 * 88 + 22 * 32;
    const bool moe = l & 1; const int li = l >> 1;
    const int nitems = I_IN + I_OUT + (moe ? NE * I_E : (I_GU + I_DN));
    bf16* win = WSP(bf16, WS_WIN); bf16* wout = WSP(bf16, WS_WOUT); bf16* wgu = WSP(bf16, WS_WGU); bf16* wdn = WSP(bf16, WS_WDN);
    for (int it = gw; it < nitems; it += NGW) {
        int r = it;
        if (r < I_IN) { const int kb = r / 112, nb = r % 112; tr_item(C.in[I_WIN] + (size_t)l * 1024 * IN_COLS, IN_COLS, 64 * kb, 32 * nb, win, 32 * nb, 1024, scr, C.lane, nb == 111); continue; }
        r -= I_IN;
        if (r < I_OUT) { const int kb = r / 32, nb = r % 32; tr_item(C.in[I_WOUT] + (size_t)l * 1024 * 1024, 1024, 64 * kb, 32 * nb, wout, 32 * nb, 1024, scr, C.lane, false); continue; }
        r -= I_OUT;
        if (!moe) {
            if (r < I_GU) { const int kb = r / 176, nb = r % 176, tile = nb >> 3, q = nb & 7;
                const float* src = (q < 4 ? C.in[I_FWG] : C.in[I_FWU]) + (size_t)li * 1024 * DFF;
                tr_item(src, DFF, 64 * kb, tile * 128 + (q & 3) * 32, wgu, 32 * nb, 1024, scr, C.lane, false); continue; }
            r -= I_GU;
            { const int kb = r / 32, nb = r % 32; tr_item(C.in[I_FWD] + (size_t)li * DFF * 1024, 1024, 64 * kb, 32 * nb, wdn, 32 * nb, DFF, scr, C.lane, false); }
        } else {
            const int e = r / I_E; int rr = r % I_E;
            if (rr < 16 * 88) { const int kb = rr / 88, nb = rr % 88, tile = nb >> 3, q = nb & 7;
                const float* src = (q < 4 ? C.in[I_MWG] : C.in[I_MWU]) + ((size_t)li * NE + e) * 1024 * DFE;
                tr_item(src, DFE, 64 * kb, tile * 128 + (q & 3) * 32, wgu + (size_t)e * 2 * DFE * 1024, 32 * nb, 1024, scr, C.lane, false); continue; }
            rr -= 16 * 88;
            { const int kb = rr / 32, nb = rr % 32; tr_item(C.in[I_MWD] + ((size_t)li * NE + e) * DFE * 1024, 1024, 64 * kb, 32 * nb, wdn + (size_t)e * 1024 * DFE, 32 * nb, DFE, scr, C.lane, false); }
        }
    }
}

template <bool ROUTE>
__device__ __forceinline__ void norm_rows(const Ctx& C, int l, const float* xlat, const float* xctx, const float* gain, int shoff, int scoff, int nrows, int moe_li) {
    const float* modv = WSP(float, WS_MODV) + (size_t)l * 9 * 6144;
    bf16* hb = WSP(bf16, WS_HB);
    const int gw = C.wg * NWAVES + C.wave, NGW = C.G * NWAVES;
    LAS unsigned* lcnt = (LAS unsigned*)(C.lds + 65536);
    unsigned* route = WSP(unsigned, WS_ROUTE);
    if (ROUTE) { if (C.tid < 8) lcnt[C.tid] = 0u; __syncthreads(); }
    f32x4 gv[4];
#pragma unroll
    for (int j = 0; j < 4; ++j) gv[j] = *(const f32x4*)(gain + 4 * C.lane + 256 * j);
    for (int m = gw; m < nrows; m += NGW) {
        const bool isctx = m >= T_LAT;
        const float* xr = isctx ? xctx + (size_t)(m - T_LAT) * 1024 : xlat + (size_t)m * 1024;
        const float* mv = modv + (size_t)(isctx ? 8 : (m >> 12)) * 6144;
        f32x4 v[4]; float s = 0.f;
#pragma unroll
        for (int j = 0; j < 4; ++j) { v[j] = *(const f32x4*)(xr + 4 * C.lane + 256 * j); s += (v[j].x * v[j].x + v[j].y * v[j].y) + (v[j].z * v[j].z + v[j].w * v[j].w); }
        const float rs = 1.0f / sqrtf(wave_sum(s) * (1.0f / 1024.0f) + 1e-6f);
#pragma unroll
        for (int j = 0; j < 4; ++j) { const f32x4 sh = *(const f32x4*)(mv + shoff + 4 * C.lane + 256 * j), scl = *(const f32x4*)(mv + scoff + 4 * C.lane + 256 * j);
            v[j] = (v[j] * rs * gv[j]) * (scl + 1.0f) + sh;
            v2u o; o.x = pk2(v[j].x, v[j].y); o.y = pk2(v[j].z, v[j].w);
            *(v2u*)(hb + (size_t)m * 1024 + 4 * C.lane + 256 * j) = o; }
        if (ROUTE) {
            const float* rt = C.in[I_MROUTER] + (size_t)moe_li * 1024 * NE;
            float lg[8];
#pragma unroll
            for (int e = 0; e < 8; ++e) lg[e] = 0.f;
#pragma unroll
            for (int j = 0; j < 4; ++j)
#pragma unroll
                for (int q = 0; q < 4; ++q) { const int k = 4 * C.lane + 256 * j + q; const f32x4 r0 = *(const f32x4*)(rt + (size_t)k * 8), r1 = *(const f32x4*)(rt + (size_t)k * 8 + 4); const float hv = v[j][q];
                    lg[0] += hv * r0.x; lg[1] += hv * r0.y; lg[2] += hv * r0.z; lg[3] += hv * r0.w; lg[4] += hv * r1.x; lg[5] += hv * r1.y; lg[6] += hv * r1.z; lg[7] += hv * r1.w; }
#pragma unroll
            for (int e = 0; e < 8; ++e) lg[e] = wave_sum(lg[e]);
            int e0 = 0; float l0 = lg[0];
#pragma unroll
            for (int e = 1; e < 8; ++e) if (lg[e] > l0) { l0 = lg[e]; e0 = e; }
            int e1 = -1; float l1 = -3.0e38f;
#pragma unroll
            for (int e = 0; e < 8; ++e) if (e != e0 && lg[e] > l1) { l1 = lg[e]; e1 = e; }
            const float w0 = 1.0f / (1.0f + __expf(l1 - l0)), w1 = 1.0f - w0;
            if (C.lane == 0) {
                const unsigned r0 = atomicAdd((unsigned*)&lcnt[e0], 1u), r1 = atomicAdd((unsigned*)&lcnt[e1], 1u);
                v4u a; a.x = (unsigned)e0; a.y = (unsigned)e1; a.z = r0; a.w = r1;
                *(v4u*)(route + (size_t)m * 8) = a;
                v2u b; b.x = __builtin_bit_cast(unsigned, w0); b.y = __builtin_bit_cast(unsigned, w1);
                *(v2u*)(route + (size_t)m * 8 + 4) = b;
            }
        }
    }
    if (ROUTE) {
        __syncthreads();
        if (C.tid < 8) { unsigned* gc = WSP(unsigned, WS_CTL) + CW_MOECNT + 64 * moe_li; const unsigned base = atomicAdd(gc + C.tid, lcnt[C.tid]); WSP(unsigned, WS_WGBASE)[C.wg * 8 + C.tid] = base; }
    }
}
template <bool FIN>
__device__ __forceinline__ void lru_chunk(const Ctx& C, int l, int b, int c) {
    LAS float* U = (LAS float*)C.lds;
    const bf16* P = WSP(const bf16, WS_P);
    const bool isctx = c < 4; const int p0 = isctx ? c * 64 : (c - 4) * 64; const int Lp = isctx ? CTXL : SEQ; const int row0 = isctx ? T_LAT + b * CTXL : b * SEQ;
    const int ch = C.tid & 255, half = C.tid >> 8;
    {
        const float* cw = C.in[I_LCW] + (size_t)l * 4 * GW + ch; const float w0 = cw[0], w1 = cw[GW], w2 = cw[2 * GW], w3 = cw[3 * GW], cb = C.in[I_LCB][l * GW + ch];
        const int t0 = half * 32;
        auto ld = [&](int p) -> float { return (p >= 0 && p < Lp) ? bf2f(P[(size_t)(row0 + p) * PLD + ch]) : 0.f; };
        float xm2 = ld(p0 + t0 - 2), xm1 = ld(p0 + t0 - 1), x0 = ld(p0 + t0);
        for (int t = 0; t < 32; ++t) { const float xp1 = ld(p0 + t0 + t + 1); U[(t0 + t) * 256 + ch] = w0 * xm2 + w1 * xm1 + w2 * x0 + w3 * xp1 + cb; xm2 = xm1; xm1 = x0; x0 = xp1; }
    }
    __syncthreads();
    const int d = half, hd = ch >> 6, jj = ch & 63;
    const float* wa = C.in[I_LWA] + ((size_t)((l * 2 + d) * 4 + hd) * 64) * 64 + jj;
    const float* wx = C.in[I_LWX] + ((size_t)((l * 2 + d) * 4 + hd) * 64) * 64 + jj;
    const float ba = C.in[I_LBA][(l * 2 + d) * GW + ch], bx = C.in[I_LBX][(l * 2 + d) * GW + ch];
    const float sp8 = 8.0f * softplusf_(-C.in[I_LLAM][(l * 2 + d) * GW + ch]);
    const size_t sidx = ((size_t)(b * NCH + c) * 2 + d) * 256 + ch;
    float h = FIN ? WSP(const float, WS_HIN)[sidx] : 0.f, sla = 0.f;
    LAS bf16* H16 = (LAS bf16*)(U + 64 * 256) + d * 64 * 256;
    const int sgn = d ? -1 : 1;
#pragma unroll 1
    for (int g = 0; g < 4; ++g) {
        const int tstart = d ? (63 - g * 16) : g * 16;
        float ar[16], ai[16];
#pragma unroll
        for (int tt = 0; tt < 16; ++tt) { ar[tt] = 0.f; ai[tt] = 0.f; }
        const LAS float* ub = U + tstart * 256 + hd * 64;
#pragma unroll 1
        for (int i = 0; i < 64; i += 4) {
            float a4[4], x4[4];
#pragma unroll
            for (int q = 0; q < 4; ++q) { a4[q] = wa[(i + q) * 64]; x4[q] = wx[(i + q) * 64]; }
#pragma unroll
            for (int tt = 0; tt < 16; ++tt) { const f32x4 uu = *(const LAS f32x4*)(ub + sgn * tt * 256 + i);
                ar[tt] += uu.x * a4[0] + uu.y * a4[1] + uu.z * a4[2] + uu.w * a4[3];
                ai[tt] += uu.x * x4[0] + uu.y * x4[1] + uu.z * x4[2] + uu.w * x4[3]; }
        }
#pragma unroll
        for (int tt = 0; tt < 16; ++tt) {
            const int tok = tstart + sgn * tt;
            const float r = sigmoidf_(ar[tt] + ba), ig = sigmoidf_(ai[tt] + bx);
            const float la = -sp8 * r; const float a = __expf(la);
            const float bb = sqrtf(-expm1f_(2.0f * la)) * (ig * U[tok * 256 + ch]);
            h = a * h + bb; sla += la;
            if (FIN) H16[tok * 256 + ch] = (bf16)f2bf(h);
        }
    }
    if (!FIN) { float* ls = WSP(float, WS_LSUM) + sidx * 2; ls[0] = sla; ls[1] = h; __syncthreads(); return; }
    __syncthreads();
    bf16* yc = WSP(bf16, WS_HB);
    const LAS bf16* H0 = (const LAS bf16*)(U + 64 * 256); const LAS bf16* H1 = H0 + 64 * 256;
    for (int t = half * 32; t < half * 32 + 32; ++t) {
        const size_t row = (size_t)(row0 + p0 + t);
        const float gate = bf2f(P[row * PLD + 256 + ch]);
        yc[row * 1024 + ch] = (bf16)f2bf((bf2f(H0[t * 256 + ch]) + bf2f(H1[t * 256 + ch])) * gelu_tanh(gate));
    }
    __syncthreads();
}
__device__ __forceinline__ void lru_carry(const Ctx& C, int idx) {
    const int ch = idx & 255, d = (idx >> 8) & 1, b = idx >> 9;
    const float* ls = WSP(const float, WS_LSUM); float* hin = WSP(float, WS_HIN);
    float H = 0.f;
    for (int k = 0; k < NCH; ++k) {
        const int c = d ? (k < 4 ? 3 - k : NCH + 3 - k) : k;
        const size_t sidx = ((size_t)(b * NCH + c) * 2 + d) * 256 + ch;
        hin[sidx] = H;
        H = __expf(ls[sidx * 2]) * H + ls[sidx * 2 + 1];
    }
}

__device__ __forceinline__ float rw_shift(const bf16* P, int row0, int p, int Lp, int colB, float mu0, float mu1) {
    const size_t o = (size_t)(row0 + p) * PLD + OFF_B + colB;
    const float x = bf2f(P[o]);
    const float pv = p > 0 ? bf2f(P[o - PLD]) : 0.f, nx = p < Lp - 1 ? bf2f(P[o + PLD]) : 0.f;
    return x + mu0 * (pv - x) + mu1 * (nx - x);
}
__device__ __forceinline__ void rwkv_prep(const Ctx& C, int l, int b, int c) {
    LAS float* XW = (LAS float*)C.lds;
    LAS float* XA = XW + 64 * 64;
    LAS float* XG = XA + 64 * 64;
    const bf16* P = WSP(const bf16, WS_P);
    const bool isctx = c < 4; const int p0 = isctx ? c * 64 : (c - 4) * 64; const int Lp = isctx ? CTXL : SEQ; const int row0 = isctx ? T_LAT + b * CTXL : b * SEQ;
    const float* mu = C.in[I_RMU] + (size_t)l * 2 * B_COLS;
    for (int it = C.tid; it < 64 * 192; it += NTHR) {
        const int t = it / 192, ci = it % 192, colB = 768 + ci;
        const float v = rw_shift(P, row0, p0 + t, Lp, colB, mu[colB], mu[B_COLS + colB]);
        if (ci < 64) XW[t * 64 + ci] = tanhf_(v); else if (ci < 128) XA[t * 64 + ci - 64] = v; else XG[t * 64 + ci - 128] = sigmoidf_(v);
    }
    __syncthreads();
    const int ch = C.tid & 255, half = C.tid >> 8, head = ch >> 6;
    bf16* wa_out = WSP(bf16, WS_HB); bf16* g_out = WSP(bf16, WS_G); float* bonus = WSP(float, WS_BONUS);
    const float* wup = C.in[I_RWUP] + (size_t)l * 2 * 32 * GW + ch;
    const float* aup = C.in[I_RAUP] + (size_t)l * 2 * 32 * GW + ch;
    const float* gup = C.in[I_RGUP] + (size_t)l * 64 * GW + ch;
    const float w00 = C.in[I_RW0][(l * 2 + 0) * GW + ch], w01 = C.in[I_RW0][(l * 2 + 1) * GW + ch];
    const float a00 = C.in[I_RA0][(l * 2 + 0) * GW + ch], a01 = C.in[I_RA0][(l * 2 + 1) * GW + ch];
    const float k_a = C.in[I_RKA][l * GW + ch], r_k = C.in[I_RRK][l * GW + ch];
    const float mur0 = mu[ch], mur1 = mu[B_COLS + ch], muk0 = mu[256 + ch], muk1 = mu[B_COLS + 256 + ch];
#pragma unroll 1
    for (int sub = 0; sub < 2; ++sub) {
        const int t0 = half * 32 + sub * 16;
        float acc[16], av0[16], av1[16];
#pragma unroll
        for (int kind = 0; kind < 4; ++kind) {
            const int d = kind & 1; const bool isw = kind < 2;
            const float* W = (isw ? wup : aup) + (size_t)d * 32 * GW; const LAS float* X = (isw ? XW : XA) + d * 32;
#pragma unroll
            for (int t = 0; t < 16; ++t) acc[t] = 0.f;
            for (int r = 0; r < 32; r += 4) {
                const float g0 = W[(r + 0) * GW], g1 = W[(r + 1) * GW], g2 = W[(r + 2) * GW], g3 = W[(r + 3) * GW];
#pragma unroll
                for (int t = 0; t < 16; ++t) { const f32x4 x = *(const LAS f32x4*)(X + (t0 + t) * 64 + r); acc[t] += x.x * g0 + x.y * g1 + x.z * g2 + x.w * g3; }
            }
#pragma unroll
            for (int t = 0; t < 16; ++t) {
                const size_t row = (size_t)(row0 + p0 + t0 + t);
                float val;
                if (isw) val = __expf(-0.6065306597126334f * sigmoidf_(acc[t] + (d ? w01 : w00)));
                else { val = sigmoidf_(acc[t] + (d ? a01 : a00)); if (d) av1[t] = val; else av0[t] = val; }
                wa_out[row * 1024 + kind * 256 + ch] = (bf16)f2bf(val);
            }
        }
#pragma unroll
        for (int t = 0; t < 16; ++t) acc[t] = 0.f;
        for (int j = 0; j < 64; j += 4) {
            const float g0 = gup[(j + 0) * GW], g1 = gup[(j + 1) * GW], g2 = gup[(j + 2) * GW], g3 = gup[(j + 3) * GW];
#pragma unroll
            for (int t = 0; t < 16; ++t) { const f32x4 x = *(const LAS f32x4*)(XG + (t0 + t) * 64 + j); acc[t] += x.x * g0 + x.y * g1 + x.z * g2 + x.w * g3; }
        }
#pragma unroll
        for (int t = 0; t < 16; ++t) {
            const int p = p0 + t0 + t; const size_t row = (size_t)(row0 + p);
            g_out[row * 256 + ch] = (bf16)f2bf(acc[t]);
            const float rs = rw_shift(P, row0, p, Lp, ch, mur0, mur1), ks = rw_shift(P, row0, p, Lp, 256 + ch, muk0, muk1);
            const float km = ks * (1.0f + (av0[t] - 1.0f) * k_a) + ks * (1.0f + (av1[t] - 1.0f) * k_a);
            const float bs = wave_sum(rs * r_k * km);
            if (C.lane == 0) bonus[row * 4 + head] = bs;
        }
    }
    __syncthreads();
}
__device__ __forceinline__ void rwkv_scan(const Ctx& C, int l, int idx) {
    const int d = idx >> 6, b = (idx >> 3) & 7, h = (idx >> 1) & 3, half = idx & 1;
    LAS float* BUF = (LAS float*)C.lds;
    LAS float* YB = BUF + 2 * 32 * 6 * 64;
    const bf16* P = WSP(const bf16, WS_P); const bf16* WA = WSP(const bf16, WS_HB); bf16* outb = WSP(bf16, WS_OUTB) + (size_t)d * T_ALL * 256;
    const int st = C.tid >> 4, q4 = C.tid & 15, chh = h * 64 + q4 * 4;
    const float* mu = C.in[I_RMU] + (size_t)l * 2 * B_COLS;
    f32x4 mu0[3], mu1[3];
#pragma unroll
    for (int q = 0; q < 3; ++q) { mu0[q] = *(const f32x4*)(mu + q * 256 + chh); mu1[q] = *(const f32x4*)(mu + B_COLS + q * 256 + chh); }
    const f32x4 kk_w = *(const f32x4*)(C.in[I_RKK] + l * GW + chh), ka_w = *(const f32x4*)(C.in[I_RKA] + l * GW + chh);
    auto stage = [&](int nb, int bufi) {
        const int i = nb * 32 + st;
        const bool isctx = i < CTXL; const int Lp = isctx ? CTXL : SEQ; const int j = isctx ? i : i - CTXL; const int p = d ? (Lp - 1 - j) : j;
        const int row = (isctx ? T_LAT + b * CTXL : b * SEQ) + p;
        f32x4 sh[3];
#pragma unroll
        for (int q = 0; q < 3; ++q) {
            const bf16* pp = P + (size_t)row * PLD + OFF_B + q * 256 + chh;
            const v2u xc = *(const v2u*)pp; v2u xp = (v2u){0u, 0u}, xn = (v2u){0u, 0u};
            if (p > 0) xp = *(const v2u*)(pp - PLD);
            if (p < Lp - 1) xn = *(const v2u*)(pp + PLD);
            const f32x4 x = (f32x4){bflo(xc.x), bfhi(xc.x), bflo(xc.y), bfhi(xc.y)}, pv = (f32x4){bflo(xp.x), bfhi(xp.x), bflo(xp.y), bfhi(xp.y)}, nx = (f32x4){bflo(xn.x), bfhi(xn.x), bflo(xn.y), bfhi(xn.y)};
            sh[q] = x + mu0[q] * (pv - x) + mu1[q] * (nx - x);
        }
        const v2u wr_ = *(const v2u*)(WA + (size_t)row * 1024 + d * 256 + chh), ar_ = *(const v2u*)(WA + (size_t)row * 1024 + (2 + d) * 256 + chh);
        const f32x4 w = (f32x4){bflo(wr_.x), bfhi(wr_.x), bflo(wr_.y), bfhi(wr_.y)}, a = (f32x4){bflo(ar_.x), bfhi(ar_.x), bflo(ar_.y), bfhi(ar_.y)};
        f32x4 kk = sh[1] * kk_w;
        const float ss = row16_sum((kk.x * kk.x + kk.y * kk.y) + (kk.z * kk.z + kk.w * kk.w));
        kk = kk * (1.0f / sqrtf(ss + 1e-6f));
        const f32x4 km = sh[1] * ((a - 1.0f) * ka_w + 1.0f), beta = kk * a;
        LAS float* o = BUF + ((bufi * 32 + st) * 6) * 64 + q4 * 4;
        *(LAS f32x4*)(o + 0 * 64) = sh[0]; *(LAS f32x4*)(o + 1 * 64) = kk; *(LAS f32x4*)(o + 2 * 64) = w; *(LAS f32x4*)(o + 3 * 64) = beta; *(LAS f32x4*)(o + 4 * 64) = km; *(LAS f32x4*)(o + 5 * 64) = sh[2];
    };
    const int rr = C.tid >> 4, jq = C.tid & 15;
    f32x4 s = (f32x4){0.f, 0.f, 0.f, 0.f};
    constexpr int NBLK = NSTEP / 32;
    stage(0, 0);
    __syncthreads();
    for (int nb = 0; nb < NBLK; ++nb) {
        if (nb + 1 < NBLK) stage(nb + 1, (nb + 1) & 1);
        const LAS float* bb = BUF + ((nb & 1) * 32) * 6 * 64;
        LAS float* yb = YB + (nb & 1) * 1024;
#pragma unroll 4
        for (int t = 0; t < 32; ++t) {
            const LAS float* o = bb + t * 6 * 64 + jq * 4;
            const f32x4 r4 = *(const LAS f32x4*)(o), kk = *(const LAS f32x4*)(o + 64), w = *(const LAS f32x4*)(o + 128), be = *(const LAS f32x4*)(o + 192), km = *(const LAS f32x4*)(o + 256);
            const float vv = bb[t * 6 * 64 + 5 * 64 + half * 32 + rr];
            const float sk = row16_sum((s.x * kk.x + s.y * kk.y) + (s.z * kk.z + s.w * kk.w));
            s = s * w - be * sk + km * vv;
            const float y = row16_sum((s.x * r4.x + s.y * r4.y) + (s.z * r4.z + s.w * r4.w));
            if (jq == 0) yb[t * 32 + rr] = y;
        }
        __syncthreads();
        {
            const int t = C.tid >> 4, r2 = (C.tid & 15) * 2;
            const int i = nb * 32 + t; const int row = seqrow_raster(i, d, b);
            *(unsigned*)(outb + (size_t)row * 256 + h * 64 + half * 32 + r2) = pk2(yb[t * 32 + r2], yb[t * 32 + r2 + 1]);
        }
    }
    __syncthreads();
}

__device__ __forceinline__ void mlstm_scan_v0(const Ctx& C, int l, int idx) {
    const int d = idx >> 5, b = (idx >> 2) & 7, h = idx & 3, lane = C.lane, w = C.wave;
    LAS float* PN = (LAS float*)C.lds;
    LAS float* PD = PN + 2 * 8 * 64;
    const bf16* P = WSP(const bf16, WS_P); bf16* outc = WSP(bf16, WS_OUTC) + (size_t)d * T_ALL * 256;
    const float ib = C.in[I_MIB][(l * 2 + d) * NH + h], fb = C.in[I_MFB][(l * 2 + d) * NH + h];
    float Cm[8], nk[8];
#pragma unroll
    for (int k = 0; k < 8; ++k) { Cm[k] = 0.f; nk[k] = 0.f; }
    float m = 0.f;
    int row = seqrow_cm(0, d, b);
    size_t ro = (size_t)row * PLD + OFF_C;
    v4u q8 = *(const v4u*)(P + ro + h * 64 + 8 * w), k8 = *(const v4u*)(P + ro + 256 + h * 64 + 8 * w);
    unsigned short vraw = P[ro + 512 + h * 64 + lane], giraw = P[ro + 1024 + d * 4 + h], gfraw = P[ro + 1024 + 8 + d * 4 + h];
    for (int i = 0; i < NSTEP; ++i) {
        const int crow = row; const v4u cq = q8, ck = k8; const float vv = bf2f(vraw), li = bf2f(giraw) + ib, gf = bf2f(gfraw) + fb;
        if (i + 1 < NSTEP) {
            row = seqrow_cm(i + 1, d, b); ro = (size_t)row * PLD + OFF_C;
            q8 = *(const v4u*)(P + ro + h * 64 + 8 * w); k8 = *(const v4u*)(P + ro + 256 + h * 64 + 8 * w);
            vraw = P[ro + 512 + h * 64 + lane]; giraw = P[ro + 1024 + d * 4 + h]; gfraw = P[ro + 1024 + 8 + d * 4 + h];
        }
        const float lf = -softplusf_(-gf);
        const float mn = fmaxf(lf + m, li), fp = __expf(lf + m - mn), ip = __expf(li - mn);
        const float qf[8] = {bflo(cq.x), bfhi(cq.x), bflo(cq.y), bfhi(cq.y), bflo(cq.z), bfhi(cq.z), bflo(cq.w), bfhi(cq.w)};
        const float kf[8] = {bflo(ck.x), bfhi(ck.x), bflo(ck.y), bfhi(ck.y), bflo(ck.z), bfhi(ck.z), bflo(ck.w), bfhi(ck.w)};
        const float ipv = ip * vv;
        float num = 0.f, den = 0.f;
#pragma unroll
        for (int k = 0; k < 8; ++k) { const float kk = kf[k] * 0.125f; Cm[k] = fp * Cm[k] + ipv * kk; nk[k] = fp * nk[k] + ip * kk; num += Cm[k] * qf[k]; den += nk[k] * qf[k]; }
        m = mn;
        const int pb_ = i & 1;
        PN[(pb_ * 8 + w) * 64 + lane] = num; if (lane == 0) PD[pb_ * 8 + w] = den;
        __syncthreads();
        if (w == 0) {
            float ns = 0.f, ds = 0.f;
#pragma unroll
            for (int ww = 0; ww < 8; ++ww) { ns += PN[(pb_ * 8 + ww) * 64 + lane]; ds += PD[pb_ * 8 + ww]; }
            outc[(size_t)crow * 256 + h * 64 + lane] = (bf16)f2bf(ns / fmaxf(fabsf(ds), __expf(-mn)));
        }
    }
    __syncthreads();
}

__device__ __forceinline__ void gdn_prep(const Ctx& C, int l, int b, int c) {
    const bf16* P = WSP(const bf16, WS_P); bf16* gq = WSP(bf16, WS_GQ);
    const bool isctx = c < 4; const int p0 = isctx ? c * 64 : (c - 4) * 64; const int Lp = isctx ? CTXL : SEQ;
    const int lane = C.lane;
    auto rowof = [&](int p) -> int { return isctx ? (T_LAT + b * CTXL + p) : (b * SEQ + (p & 63) * 64 + (p >> 6)); };
    float cw[4][12], x[4][12];
#pragma unroll
    for (int j = 0; j < 4; ++j)
#pragma unroll
        for (int i = 0; i < 12; ++i) cw[j][i] = C.in[I_GCW][((size_t)l * 4 + j) * 768 + i * 64 + lane];
    const int tb = p0 + C.wave * 8;
    auto ldrow = [&](int p, float (&dst)[12]) {
        if (p >= 0 && p < Lp) { const size_t ro = (size_t)rowof(p) * PLD + OFF_D;
#pragma unroll
            for (int i = 0; i < 12; ++i) dst[i] = bf2f(P[ro + i * 64 + lane]); }
        else {
#pragma unroll
            for (int i = 0; i < 12; ++i) dst[i] = 0.f; }
    };
    ldrow(tb - 2, x[0]); ldrow(tb - 1, x[1]); ldrow(tb, x[2]);
#pragma unroll 1
    for (int t = 0; t < 8; ++t) {
        ldrow(tb + t + 1, x[3]);
        const size_t ro = (size_t)rowof(tb + t) * 768;
#pragma unroll
        for (int i = 0; i < 12; ++i) {
            float v = siluf_(cw[0][i] * x[0][i] + cw[1][i] * x[1][i] + cw[2][i] * x[2][i] + cw[3][i] * x[3][i]);
            if (i < 8) { const float ss = wave_sum(v * v); v *= (1.0f / sqrtf(ss + 1e-6f)) * (i < 4 ? 0.125f : 1.0f); }
            gq[ro + i * 64 + lane] = (bf16)f2bf(v);
        }
#pragma unroll
        for (int i = 0; i < 12; ++i) { x[0][i] = x[1][i]; x[1][i] = x[2][i]; x[2][i] = x[3][i]; }
    }
}
__device__ __forceinline__ void gdn_scan_v0(const Ctx& C, int l, int idx) {
    const int d = idx >> 5, b = (idx >> 2) & 7, h = idx & 3, lane = C.lane, w = C.wave;
    LAS float* PA = (LAS float*)C.lds;
    LAS float* PB = PA + 2 * 8 * 64;
    const bf16* P = WSP(const bf16, WS_P); const bf16* gq = WSP(const bf16, WS_GQ); bf16* outd = WSP(bf16, WS_OUTD) + (size_t)d * T_ALL * 256;
    const float aexp = __expf(C.in[I_GALOG][(l * 2 + d) * NH + h]), dtb = C.in[I_GDTB][(l * 2 + d) * NH + h];
    float S[8];
#pragma unroll
    for (int k = 0; k < 8; ++k) S[k] = 0.f;
    int row = seqrow_cm(0, d, b), prow = row;
    size_t rq = (size_t)row * 768, ro = (size_t)row * PLD + OFF_D + 1024;
    v4u q8 = *(const v4u*)(gq + rq + h * 64 + 8 * w), k8 = *(const v4u*)(gq + rq + 256 + h * 64 + 8 * w);
    unsigned short vraw = gq[rq + 512 + h * 64 + lane], garaw = P[ro + d * 4 + h], gbraw = P[ro + 8 + d * 4 + h];
    for (int i = 0; i < NSTEP; ++i) {
        const int crow = row; const v4u cq = q8, ck = k8; const float vv = bf2f(vraw), ga = bf2f(garaw), gb = bf2f(gbraw);
        if (i + 1 < NSTEP) {
            row = seqrow_cm(i + 1, d, b); rq = (size_t)row * 768; ro = (size_t)row * PLD + OFF_D + 1024;
            q8 = *(const v4u*)(gq + rq + h * 64 + 8 * w); k8 = *(const v4u*)(gq + rq + 256 + h * 64 + 8 * w);
            vraw = gq[rq + 512 + h * 64 + lane]; garaw = P[ro + d * 4 + h]; gbraw = P[ro + 8 + d * 4 + h];
        }
        const float alpha = __expf(-aexp * softplusf_(ga + dtb)), beta = sigmoidf_(gb);
        const float qf[8] = {bflo(cq.x), bfhi(cq.x), bflo(cq.y), bfhi(cq.y), bflo(cq.z), bfhi(cq.z), bflo(cq.w), bfhi(cq.w)};
        const float kf[8] = {bflo(ck.x), bfhi(ck.x), bflo(ck.y), bfhi(ck.y), bflo(ck.z), bfhi(ck.z), bflo(ck.w), bfhi(ck.w)};
        float ks = 0.f;
#pragma unroll
        for (int k = 0; k < 8; ++k) ks += kf[k] * S[k];
        const int pb_ = i & 1;
        PA[(pb_ * 8 + w) * 64 + lane] = ks;
        __syncthreads();
        if (w == 0 && i > 0) {
            float os = 0.f;
#pragma unroll
            for (int ww = 0; ww < 8; ++ww) os += PB[((pb_ ^ 1) * 8 + ww) * 64 + lane];
            outd[(size_t)prow * 256 + h * 64 + lane] = (bf16)f2bf(os);
        }
        float kS = 0.f;
#pragma unroll
        for (int ww = 0; ww < 8; ++ww) kS += PA[(pb_ * 8 + ww) * 64 + lane];
        const float coef = beta * (vv - alpha * kS);
        float o = 0.f;
#pragma unroll
        for (int k = 0; k < 8; ++k) { S[k] = alpha * S[k] + kf[k] * coef; o += qf[k] * S[k]; }
        PB[(pb_ * 8 + w) * 64 + lane] = o;
        prow = crow;
    }
    __syncthreads();
    if (w == 0) {
        float os = 0.f;
#pragma unroll
        for (int ww = 0; ww < 8; ++ww) os += PB[(((NSTEP - 1) & 1) * 8 + ww) * 64 + lane];
        outd[(size_t)prow * 256 + h * 64 + lane] = (bf16)f2bf(os);
    }
    __syncthreads();
}

__device__ __forceinline__ void finish_rows(const Ctx& C, int l, int nrows) {
    const bf16* P = WSP(const bf16, WS_P); bf16* yc = WSP(bf16, WS_HB);
    const bf16* ob = WSP(const bf16, WS_OUTB); const bf16* oc = WSP(const bf16, WS_OUTC); const bf16* od = WSP(const bf16, WS_OUTD);
    const bf16* gg = WSP(const bf16, WS_G); const float* bonus = WSP(const float, WS_BONUS);
    const float* mu = C.in[I_RMU] + (size_t)l * 2 * B_COLS;
    const int gw = C.wg * NWAVES + C.wave, NGW = C.G * NWAVES, lane = C.lane;
    for (int m = gw; m < nrows; m += NGW) {
        const bool isctx = m >= T_LAT; const int Lp = isctx ? CTXL : SEQ; const int p = isctx ? ((m - T_LAT) & (CTXL - 1)) : (m & (SEQ - 1)); const int row0 = m - p;
        const size_t o2 = (size_t)T_ALL * 256;
#pragma unroll
        for (int hh = 0; hh < 4; ++hh) {
            const int ch = hh * 64 + lane;
            {
                const float y = bf2f(ob[(size_t)m * 256 + ch]) + bf2f(ob[o2 + (size_t)m * 256 + ch]);
                const float mean = wave_sum(y) * (1.0f / 64.0f); const float dl = y - mean; const float var = wave_sum(dl * dl) * (1.0f / 64.0f);
                const float yn = dl * (1.0f / sqrtf(var + 64e-5f)) * C.in[I_RLNG][l * GW + ch] + C.in[I_RLNB][l * GW + ch];
                const float vs = rw_shift(P, row0, p, Lp, 512 + ch, mu[512 + ch], mu[B_COLS + 512 + ch]);
                yc[(size_t)m * 1024 + 256 + ch] = (bf16)f2bf((yn + bonus[(size_t)m * 4 + hh] * vs) * bf2f(gg[(size_t)m * 256 + ch]));
            }
            {
                const float y = bf2f(oc[(size_t)m * 256 + ch]) + bf2f(oc[o2 + (size_t)m * 256 + ch]);
                const float ms = wave_sum(y * y) * (1.0f / 64.0f);
                const float og = bf2f(P[(size_t)m * PLD + OFF_C + 768 + ch]);
                yc[(size_t)m * 1024 + 512 + ch] = (bf16)f2bf(y * (1.0f / sqrtf(ms + 1e-6f)) * C.in[I_MNG][l * GW + ch] * sigmoidf_(og));
            }
            {
                const float y = bf2f(od[(size_t)m * 256 + ch]) + bf2f(od[o2 + (size_t)m * 256 + ch]);
                const float ms = wave_sum(y * y) * (1.0f / 64.0f);
                const float g = bf2f(P[(size_t)m * PLD + OFF_D + 768 + ch]);
                yc[(size_t)m * 1024 + 768 + ch] = (bf16)f2bf(y * (1.0f / sqrtf(ms + 1e-6f)) * C.in[I_GNG][l * GW + ch] * siluf_(g));
            }
        }
    }
}
__device__ __forceinline__ void moe_scatter(const Ctx& C, int moe_li, int nrows) {
    const unsigned* gc = WSP(const unsigned, WS_CTL) + CW_MOECNT + 64 * moe_li;
    LAS int* pst = (LAS int*)C.lds;
    {
        int pe[8]; int acc = 0;
#pragma unroll
        for (int e = 0; e < NE; ++e) { const int blks = ((int)gc[e] + 255) >> 8; if (C.tid == e) pst[e] = acc * 256; acc += blks; pe[e] = acc; }
        if (C.wg == 0 && C.tid < MOE_MAXBLK) { int be = 0;
#pragma unroll
            for (int e = 0; e < NE; ++e) be += (pe[e] <= C.tid) ? 1 : 0;
            int* tab = WSP(int, WS_TAB); tab[1 + C.tid] = be < NE ? be : NE - 1; if (C.tid == 0) tab[0] = acc; }
    }
    __syncthreads();
    const unsigned* route = WSP(const unsigned, WS_ROUTE); const unsigned* wgbase = WSP(const unsigned, WS_WGBASE);
    const bf16* hb = WSP(const bf16, WS_HB); bf16* am = WSP(bf16, WS_MIX); int* pos = WSP(int, WS_POS);
    const int gw = C.wg * NWAVES + C.wave, NGW = C.G * NWAVES;
    for (int m = gw; m < nrows; m += NGW) {
        const v4u a = *(const v4u*)(route + (size_t)m * 8);
        const int e0 = (int)a.x, e1 = (int)a.y;
        const int p0 = pst[e0] + (int)wgbase[C.wg * 8 + e0] + (int)a.z, p1 = pst[e1] + (int)wgbase[C.wg * 8 + e1] + (int)a.w;
        const v4u r0 = *(const v4u*)(hb + (size_t)m * 1024 + C.lane * 8), r1 = *(const v4u*)(hb + (size_t)m * 1024 + 512 + C.lane * 8);
        *(v4u*)(am + (size_t)p0 * 1024 + C.lane * 8) = r0; *(v4u*)(am + (size_t)p0 * 1024 + 512 + C.lane * 8) = r1;
        *(v4u*)(am + (size_t)p1 * 1024 + C.lane * 8) = r0; *(v4u*)(am + (size_t)p1 * 1024 + 512 + C.lane * 8) = r1;
        if (C.lane == 0) { pos[(size_t)m * 2] = p0; pos[(size_t)m * 2 + 1] = p1; }
    }
    __syncthreads();
}
__device__ __forceinline__ void moe_combine(const Ctx& C, int l, int nrows) {
    const unsigned* route = WSP(const unsigned, WS_ROUTE); const int* pos = WSP(const int, WS_POS); const bf16* ym = WSP(const bf16, WS_MIX);
    const float* modv = WSP(const float, WS_MODV) + (size_t)l * 9 * 6144 + 5 * 1024;
    float* xc = WSP(float, WS_XC);
    const int gw = C.wg * NWAVES + C.wave, NGW = C.G * NWAVES;
    for (int m = gw; m < nrows; m += NGW) {
        const bool isctx = m >= T_LAT;
        float* xr = isctx ? xc + (size_t)(m - T_LAT) * 1024 : C.out + (size_t)m * 1024;
        const float* gv = modv + (size_t)(isctx ? 8 : (m >> 12)) * 6144;
        const int p0 = pos[(size_t)m * 2], p1 = pos[(size_t)m * 2 + 1];
        const float w0 = __builtin_bit_cast(float, route[(size_t)m * 8 + 4]), w1 = __builtin_bit_cast(float, route[(size_t)m * 8 + 5]);
#pragma unroll
        for (int j = 0; j < 4; ++j) {
            const int col = 4 * C.lane + 256 * j;
            const v2u a = *(const v2u*)(ym + (size_t)p0 * 1024 + col), b = *(const v2u*)(ym + (size_t)p1 * 1024 + col);
            const f32x4 ya = (f32x4){bflo(a.x), bfhi(a.x), bflo(a.y), bfhi(a.y)}, yb = (f32x4){bflo(b.x), bfhi(b.x), bflo(b.y), bfhi(b.y)};
            const f32x4 g = *(const f32x4*)(gv + col); f32x4 x = *(const f32x4*)(xr + col);
            x = x + g * (ya * w0 + yb * w1);
            *(f32x4*)(xr + col) = x;
        }
    }
}
__device__ __forceinline__ void final_norm(const Ctx& C) {
    const int gw = C.wg * NWAVES + C.wave, NGW = C.G * NWAVES;
    f32x4 gv[4];
#pragma unroll
    for (int j = 0; j < 4; ++j) gv[j] = *(const f32x4*)(C.in[I_FNG] + 4 * C.lane + 256 * j);
    for (int m = gw; m < T_LAT; m += NGW) {
        float* xr = C.out + (size_t)m * 1024;
        f32x4 v[4]; float s = 0.f;
#pragma unroll
        for (int j = 0; j < 4; ++j) { v[j] = *(const f32x4*)(xr + 4 * C.lane + 256 * j); s += (v[j].x * v[j].x + v[j].y * v[j].y) + (v[j].z * v[j].z + v[j].w * v[j].w); }
        const float rs = 1.0f / sqrtf(wave_sum(s) * (1.0f / 1024.0f) + 1e-6f);
#pragma unroll
        for (int j = 0; j < 4; ++j) *(f32x4*)(xr + 4 * C.lane + 256 * j) = v[j] * rs * gv[j];
    }
}

constexpr int NPH_L = 11, PH_FINAL = 1 + DEPTH * NPH_L, NPHASE = PH_FINAL + 1;
__host__ __device__ inline bool phase_exists(int ph) {
    if (ph == 0 || ph == PH_FINAL) return true;
    const int l = (ph - 1) / NPH_L, k = (ph - 1) % NPH_L;
    if (!(l & 1) && k >= 9) return false;
    return true;
}

__global__ void __launch_bounds__(NTHR, 2) fwd_kernel(Args args) {
    extern __shared__ __attribute__((aligned(16))) unsigned char lds_raw[];
    Ctx C; C.in = args.in; C.out = args.out; C.ws = args.ws; C.lds = (LAS unsigned char*)lds_raw;
    C.tid = threadIdx.x; C.lane = C.tid & 63; C.wave = __builtin_amdgcn_readfirstlane(C.tid >> 6); C.G = gridDim.x; C.wg = blockIdx.x;
    volatile LAS unsigned* MISC = (volatile LAS unsigned*)(C.lds + MISC_OFF);
    if (C.tid < 64) MISC[C.tid] = 0u;
    __syncthreads();
    const int lo = args.ph_lo, hi = args.ph_hi;
    const bool multi = (hi - lo) > 1;
    if (multi) (void)xcd_barrier_post(WSP(unsigned, WS_CTL) + CW_BAR, MISC + 8);
#ifndef PH_MASK
#define PH_MASK 0xFFFFF
#endif
#define PM(k) ((PH_MASK >> (k)) & 1)
#ifndef SK_MASK
#define SK_MASK 0xFFFF
#endif
#define SK(k) ((SK_MASK >> (k)) & 1)
#define IN(k) (lo <= (k) && (k) < hi)
#define SEAM(k) do { if (IN((k) + 1)) { XcdBarrier b2_; b2_.bar = WSP(unsigned, WS_CTL) + CW_BAR; b2_.x = xb_xcc_id(); b2_.st = (volatile LAS unsigned*)(C.lds + MISC_OFF) + 8; xcd_barrier(b2_); } } while (0)
#define FRESH() do { int t_ = threadIdx.x; asm volatile("" : "+v"(t_)); C.tid = t_; C.lane = t_ & 63; C.wave = __builtin_amdgcn_readfirstlane(t_ >> 6); } while (0)

    if (PM(13) && IN(0)) { phase_pre(C); SEAM(0); }

#pragma unroll 1
    for (int l = 0; l < DEPTH; ++l) {
        const int pb = 1 + l * NPH_L;
        if (hi <= pb || lo >= pb + NPH_L) continue;
        const bool last = (l == DEPTH - 1), moe = (l & 1);
        const int nrows = last ? T_LAT : T_ALL;
        const float* xlat = (l == 0) ? C.in[I_X] : C.out; const float* xctx = (l == 0) ? C.in[I_CTX] : WSP(const float, WS_XC);
        const float* modv = WSP(const float, WS_MODV) + (size_t)l * 9 * 6144;

        if (PM(0) && IN(pb + 0)) { FRESH();
            convert_layer(C, l);
            __syncthreads();
            FRESH(); norm_rows<false>(C, l, xlat, xctx, C.in[I_NMIXG] + l * 1024, 0, 1024, T_ALL, 0);
            SEAM(pb + 0);
        }
        if (PM(1) && IN(pb + 1)) { FRESH();
            pg8::Gemm g{WSP(const bf16, WS_HB), WSP(const bf16, WS_WIN), T_ALL, PLD, 1024, 0};
            pg8::StaticOrder S; S.init(T_ALL, PLD, C.G, C.wg);
            pg8::EpiBf16<0> E{WSP(bf16, WS_P), PLD, nullptr, 0, 0};
            pg8::gemm_phase<pg8::EpiBf16<0>, pg8::StaticOrder, false>(C.lds, g, S, E, nullptr);
            SEAM(pb + 1);
        }
        if (PM(2) && IN(pb + 2)) { FRESH();
            FRESH(); if (SK(0)) for (int u = C.wg; u < NB * NCH; u += C.G) lru_chunk<false>(C, l, u / NCH, u % NCH);
            FRESH(); if (SK(1)) for (int u = C.wg; u < NB * NCH; u += C.G) rwkv_prep(C, l, u / NCH, u % NCH);
            FRESH(); if (SK(2)) for (int u = C.wg; u < NB * NCH; u += C.G) gdn_prep(C, l, u / NCH, u % NCH);
            SEAM(pb + 2);
        }
        if (PM(3) && IN(pb + 3)) { FRESH();
            if (SK(3) && C.wg < 128) { FRESH(); rwkv_scan(C, l, C.wg); }
            else if (SK(4) && C.wg < 192) { FRESH(); mlstm_scan_v0(C, l, C.wg - 128); }
            else if (SK(5)) { FRESH(); gdn_scan_v0(C, l, C.wg - 192); }
            if (SK(6) && C.wg >= 248) lru_carry(C, (C.wg - 248) * NTHR + C.tid);
            SEAM(pb + 3);
        }
        if (PM(4) && IN(pb + 4)) { FRESH();
            for (int u = C.wg; u < NB * NCH; u += C.G) { const int b = u / NCH, c = u % NCH; if (last && c < 4) continue; if (SK(7)) lru_chunk<true>(C, l, b, c); }
            FRESH(); if (SK(8)) finish_rows(C, l, nrows);
            SEAM(pb + 4);
        }
        if (PM(5) && IN(pb + 5)) { FRESH();
            pg8::Gemm g{WSP(const bf16, WS_HB), WSP(const bf16, WS_WOUT), nrows, 1024, 1024, 0};
            pg8::StaticOrder S; S.init(nrows, 1024, C.G, C.wg);
            pg8::EpiRes E{xlat, xctx, C.out, WSP(float, WS_XC), modv + 2 * 1024};
            pg8::gemm_phase<pg8::EpiRes, pg8::StaticOrder, false>(C.lds, g, S, E, nullptr);
            SEAM(pb + 5);
        }
        if (PM(6) && IN(pb + 6)) { FRESH();
            if (moe) norm_rows<true>(C, l, C.out, WSP(const float, WS_XC), C.in[I_NFFNG] + l * 1024, 3 * 1024, 4 * 1024, nrows, l >> 1);
            else norm_rows<false>(C, l, C.out, WSP(const float, WS_XC), C.in[I_NFFNG] + l * 1024, 3 * 1024, 4 * 1024, nrows, 0);
            SEAM(pb + 6);
        }
        if (!moe) {
            if (PM(11) && IN(pb + 7)) { FRESH();
                pg8::Gemm g{WSP(const bf16, WS_HB), WSP(const bf16, WS_WGU), nrows, 2 * DFF, 1024, 0};
                pg8::StaticOrder S; S.init(nrows, 2 * DFF, C.G, C.wg);
                pg8::EpiSwiglu E{WSP(bf16, WS_P), DFF};
                pg8::gemm_phase<pg8::EpiSwiglu, pg8::StaticOrder, false>(C.lds, g, S, E, nullptr);
                SEAM(pb + 7);
            }
            if (PM(12) && IN(pb + 8)) { FRESH();
                pg8::Gemm g{WSP(const bf16, WS_P), WSP(const bf16, WS_WDN), nrows, 1024, DFF, 0};
                pg8::StaticOrder S; S.init(nrows, 1024, C.G, C.wg);
                pg8::EpiRes E{C.out, WSP(const float, WS_XC), C.out, WSP(float, WS_XC), modv + 5 * 1024};
                pg8::gemm_phase<pg8::EpiRes, pg8::StaticOrder, false>(C.lds, g, S, E, nullptr);
                SEAM(pb + 10);
            }
        } else {
            if (PM(7) && IN(pb + 7)) { FRESH(); moe_scatter(C, l >> 1, nrows); SEAM(pb + 7); }
            if (PM(8) && IN(pb + 8)) { FRESH();
                pg8::Gemm g{WSP(const bf16, WS_MIX), WSP(const bf16, WS_WGU), 0, 2 * DFE, 1024, (size_t)2 * DFE * 1024};
                pg8::MoeOrder S; S.init(WSP(const int, WS_TAB), (2 * DFE) / 256, C.G, C.wg);
                pg8::EpiSwiglu E{WSP(bf16, WS_P), DFE};
                pg8::gemm_phase<pg8::EpiSwiglu, pg8::MoeOrder, false>(C.lds, g, S, E, nullptr);
                SEAM(pb + 8);
            }
            if (PM(9) && IN(pb + 9)) { FRESH();
                pg8::Gemm g{WSP(const bf16, WS_P), WSP(const bf16, WS_WDN), 0, 1024, DFE, (size_t)1024 * DFE};
                pg8::MoeOrder S; S.init(WSP(const int, WS_TAB), 4, C.G, C.wg);
                pg8::EpiBf16<0> E{WSP(bf16, WS_MIX), 1024, nullptr, 0, 0};
                pg8::gemm_phase<pg8::EpiBf16<0>, pg8::MoeOrder, false>(C.lds, g, S, E, nullptr);
                SEAM(pb + 9);
            }
            if (PM(10) && IN(pb + 10)) { FRESH(); moe_combine(C, l, nrows); SEAM(pb + 10); }
        }
    }
    if (PM(14) && IN(PH_FINAL)) final_norm(C);
}

extern "C" void kernel_launch(void* const* d_in, const int* in_sizes, int n_in, void* d_out, int out_size, void* d_ws, size_t ws_size, hipStream_t stream) {
    static int grid = 0;
    if (grid == 0) {
        if (n_in != N_IN || in_sizes[0] != T_LAT * DM || out_size != T_LAT * DM || ws_size < WS_END) {
            fprintf(stderr, "kernel_launch: unexpected problem (n_in %d, in0 %d, out %d, ws %zu < %zu)\n", n_in, n_in > 0 ? in_sizes[0] : -1, out_size, ws_size, (size_t)WS_END); grid = -1; return; }
        int dev = 0, cus = 0, per_cu = 0;
        if (hipGetDevice(&dev) != hipSuccess || hipDeviceGetAttribute(&cus, hipDeviceAttributeMultiprocessorCount, dev) != hipSuccess) { grid = -1; return; }
        if (hipFuncSetAttribute((const void*)fwd_kernel, hipFuncAttributeMaxDynamicSharedMemorySize, LDS_BYTES) != hipSuccess) { fprintf(stderr, "kernel_launch: hipFuncSetAttribute failed\n"); grid = -1; return; }
        if (hipOccupancyMaxActiveBlocksPerMultiprocessor(&per_cu, (const void*)fwd_kernel, NTHR, LDS_BYTES) != hipSuccess || per_cu < 1) { fprintf(stderr, "kernel_launch: occupancy query says %d\n", per_cu); grid = -1; return; }
        grid = cus;
        if (grid != 256) fprintf(stderr, "kernel_launch: note: %d CUs\n", grid);
    }
    if (grid < 0) return;
    if (hipMemsetAsync((char*)d_ws + WS_CTL, 0, CTL_BYTES, stream) != hipSuccess) return;
    Args a{};
    for (int i = 0; i < N_IN; ++i) a.in[i] = (const float*)d_in[i];
    a.out = (float*)d_out; a.ws = (unsigned char*)d_ws;
#if MK_ONE_LAUNCH
    a.ph_lo = 0; a.ph_hi = NPHASE;
    hipLaunchKernelGGL(fwd_kernel, dim3(grid), dim3(NTHR), LDS_BYTES, stream, a);
#else
    for (int ph = 0; ph < NPHASE; ++ph) { if (!phase_exists(ph)) continue; a.ph_lo = ph; a.ph_hi = ph + 1; hipLaunchKernelGGL(fwd_kernel, dim3(grid), dim3(NTHR), LDS_BYTES, stream, a); }
#endif
}
```

```cpp
#define MK_ONE_LAUNCH 1
#include <hip/hip_runtime.h>
#include <cstdio>
#include <cstdint>

#define GAS __attribute__((address_space(1)))
#define LAS __attribute__((address_space(3)))
typedef unsigned short bf16;
typedef unsigned v4u __attribute__((ext_vector_type(4)));
typedef unsigned v2u __attribute__((ext_vector_type(2)));
typedef float f32x4 __attribute__((ext_vector_type(4)));
typedef float f32x2 __attribute__((ext_vector_type(2)));
typedef short bf16x8 __attribute__((ext_vector_type(8)));
#define LDS_WAIT() asm volatile("s_waitcnt lgkmcnt(0)" ::: "memory")
#define VM_WAIT() asm volatile("s_waitcnt vmcnt(0)" ::: "memory")

constexpr int DM = 1024, NB = 8, SEQ = 4096, DEPTH = 4, CTXL = 256, GW = 256, HD = 64, NH = 4;
constexpr int T_LAT = NB * SEQ, T_CTX = NB * CTXL, T_ALL = T_LAT + T_CTX;
constexpr int IN_COLS = 3552, PLD = 3584;
constexpr int OFF_B = 512, OFF_C = 1472, OFF_D = 2512, B_COLS = 960;
constexpr int DFF = 2816, NE = 8, DFE = 1408;
constexpr int NCH = 68;
constexpr int NSTEP = 4352;
constexpr int MOE_MAXBLK = 280;
constexpr int NWAVES = 8, NTHR = 512;

constexpr size_t MiB = 1u << 20;
constexpr size_t WS_CTL = 0, CTL_BYTES = 1 * MiB;
constexpr size_t WS_MODV = 1 * MiB;
constexpr size_t WS_XC = 2 * MiB;
constexpr size_t WS_WIN = 10 * MiB;
constexpr size_t WS_WOUT = 17 * MiB;
constexpr size_t WS_WGU = 19 * MiB;
constexpr size_t WS_WDN = 63 * MiB;
constexpr size_t WS_HB = 85 * MiB;
constexpr size_t WS_P = 153 * MiB;
constexpr size_t WS_MIX = 391 * MiB;
constexpr size_t WS_OUTB = WS_MIX, WS_OUTC = WS_MIX + 34 * MiB, WS_OUTD = WS_MIX + 68 * MiB, WS_GQ = WS_MIX + 102 * MiB, WS_G = WS_MIX + 153 * MiB;
constexpr size_t WS_SMALL = 561 * MiB;
constexpr size_t WS_LSUM = WS_SMALL;
constexpr size_t WS_HIN = WS_SMALL + 3 * MiB;
constexpr size_t WS_ROUTE = WS_SMALL + 5 * MiB;
constexpr size_t WS_POS = WS_SMALL + 7 * MiB;
constexpr size_t WS_BONUS = WS_SMALL + 8 * MiB;
constexpr size_t WS_WGBASE = WS_SMALL + 9 * MiB;
constexpr size_t WS_TAB = WS_WGBASE + 65536;
constexpr size_t WS_END = 571 * MiB;
constexpr int CW_MOECNT = 1024;
constexpr int CW_BAR = 4096;

constexpr int LDS_BYTES = 135168;
constexpr int MISC_OFF = 131072;

__device__ __forceinline__ unsigned f2bf(float f) { unsigned u = __builtin_bit_cast(unsigned, f); return (u + 0x7fffu + ((u >> 16) & 1u)) >> 16; }
__device__ __forceinline__ unsigned pk2(float lo, float hi) { return f2bf(lo) | (f2bf(hi) << 16); }
__device__ __forceinline__ float bf2f(unsigned short v) { return __builtin_bit_cast(float, (unsigned)v << 16); }
__device__ __forceinline__ float bflo(unsigned v) { return __builtin_bit_cast(float, v << 16); }
__device__ __forceinline__ float bfhi(unsigned v) { return __builtin_bit_cast(float, v & 0xffff0000u); }
__device__ __forceinline__ float wave_sum(float v) {
#pragma unroll
    for (int o = 1; o < 64; o <<= 1) v += __shfl_xor(v, o);
    return v;
}
template <int CTRL> __device__ __forceinline__ float dpp_f(float v) { return __builtin_bit_cast(float, __builtin_amdgcn_update_dpp(0, __builtin_bit_cast(int, v), CTRL, 0xF, 0xF, true)); }
__device__ __forceinline__ float row16_sum(float v) {
    v += dpp_f<0xB1>(v);
    v += dpp_f<0x4E>(v);
    v += dpp_f<0x141>(v);
    v += dpp_f<0x140>(v);
    return v;
}
__device__ __forceinline__ float sigmoidf_(float x) { return 1.0f / (1.0f + __expf(-x)); }
__device__ __forceinline__ float softplusf_(float x) { return fmaxf(x, 0.f) + __logf(1.0f + __expf(-fabsf(x))); }
__device__ __forceinline__ float expm1f_(float x) { return x > -0.3f ? x * (1.0f + x * (0.5f + x * (0.16666667f + x * (0.041666668f + x * 0.0083333338f)))) : __expf(x) - 1.0f; }
__device__ __forceinline__ float siluf_(float x) { return x / (1.0f + __expf(-x)); }
__device__ __forceinline__ float tanhf_(float x) { const float e = __expf(2.0f * x); return 1.0f - 2.0f / (e + 1.0f); }
__device__ __forceinline__ float gelu_tanh(float x) { return 0.5f * x * (1.0f + tanhf_(0.7978845608028654f * (x + 0.044715f * x * x * x))); }
#define XB_TMO      128
#define XB_XCNT(j)  (256  + 64 * (j))
#define XB_XSUB(j)  (1280 + 64 * (j))
#define XB_XGEN(j)  (2304 + 64 * (j))
#define XB_TOP      3328
#define XB_TOPGEN   3392
#define XCD_BAR_WORDS 3456
#define XB_SPIN_CAP (1u << 22)

__device__ __forceinline__ unsigned xb_ld(unsigned* p)              { return __hip_atomic_load(p, __ATOMIC_RELAXED, __HIP_MEMORY_SCOPE_AGENT); }
__device__ __forceinline__ unsigned xb_add(unsigned* p, unsigned v) { return __hip_atomic_fetch_add(p, v, __ATOMIC_RELAXED, __HIP_MEMORY_SCOPE_AGENT); }
__device__ __forceinline__ unsigned xb_xcc_id() { return (unsigned)__builtin_amdgcn_s_getreg((3 << 11) | 20) & 0xFu; }
#define XB_SPIN(cond, bar) do { unsigned _sp = 0; while (cond) { __builtin_amdgcn_s_sleep(1); \
    if ((++_sp & 255u) == 0u) { if (xb_ld(&(bar)[XB_TMO])) break; if (_sp > XB_SPIN_CAP) { atomicAdd(&(bar)[XB_TMO], 1u); break; } } } } while (0)

struct XcdBarrier {
    unsigned* bar; unsigned x;
    volatile LAS unsigned* st;
};

__device__ __forceinline__ XcdBarrier xcd_barrier_post(unsigned* bar, volatile LAS unsigned* st) {
    XcdBarrier b; b.bar = bar; b.x = xb_xcc_id(); b.st = st;
    if (threadIdx.x == 0) (void)xb_add(&bar[XB_XCNT(b.x)], 1u);
    return b;
}
__device__ __forceinline__ void xcd_barrier_complete(unsigned* bar, unsigned x, unsigned& nloc, unsigned& nx) {
    const unsigned G = gridDim.x * gridDim.y * gridDim.z;
    unsigned sum, cnt, mine, sp = 0u;
    for (;;) {
        sum = 0u; cnt = 0u; mine = 0u;
#pragma unroll
        for (unsigned j = 0; j < 16; ++j) { const unsigned c = xb_ld(&bar[XB_XCNT(j)]); sum += c; cnt += (c > 0u) ? 1u : 0u; mine = (j == x) ? c : mine; }
        if (sum == G) break;
        __builtin_amdgcn_s_sleep(1);
        if ((++sp & 255u) == 0u) { if (xb_ld(&bar[XB_TMO])) break; if (sp > XB_SPIN_CAP) { atomicAdd(&bar[XB_TMO], 1u); break; } }
    }
    nloc = mine > 0u ? mine : 1u; nx = cnt > 0u ? cnt : 1u;
}

__device__ __forceinline__ void xcd_barrier(const XcdBarrier& b) {
    asm volatile("s_waitcnt vmcnt(0)" ::: "memory");
    __syncthreads();
    if (threadIdx.x == 0) {
        unsigned* bar = b.bar;
        __builtin_amdgcn_s_waitcnt(0);
        unsigned nloc = b.st[0], nx = b.st[1];
        if (nloc == 0u) { xcd_barrier_complete(bar, b.x, nloc, nx); b.st[0] = nloc; b.st[1] = nx; }
        const unsigned old = xb_add(&bar[XB_XSUB(b.x)], 1u);
        const unsigned gen = old / nloc;
        if (old + 1u == (gen + 1u) * nloc) {
            __builtin_amdgcn_fence(__ATOMIC_RELEASE, "agent");
            asm volatile("s_waitcnt vmcnt(0)" ::: "memory");
            const unsigned og = xb_add(&bar[XB_TOP], 1u);
            const unsigned tg = og / nx;
            if (og + 1u == (tg + 1u) * nx) xb_add(&bar[XB_TOPGEN], 1u);
            else XB_SPIN(xb_ld(&bar[XB_TOPGEN]) == tg, bar);
            __builtin_amdgcn_fence(__ATOMIC_ACQUIRE, "agent");
            xb_add(&bar[XB_XGEN(b.x)], 1u);
            asm volatile("s_waitcnt vmcnt(0)" ::: "memory");
        } else {
            XB_SPIN(xb_ld(&bar[XB_XGEN(b.x)]) == gen, bar);
            __builtin_amdgcn_fence(__ATOMIC_ACQUIRE, "agent");
            asm volatile("s_waitcnt vmcnt(0)" ::: "memory");
        }
    }
    __syncthreads();
}

namespace pg8 {
#define PG8_LAS __attribute__((address_space(3)))
typedef unsigned short bf16_t;
typedef short bf16x8 __attribute__((ext_vector_type(8)));
typedef float f32x4 __attribute__((ext_vector_type(4)));
typedef unsigned u32x4 __attribute__((ext_vector_type(4)));
constexpr int BM = 256, BK = 64, HALF = 128, HTB = HALF * BK * 2  , STAGE_BYTES = 8 * HTB, NXCD = 8, WGM = 8;

__host__ __device__ __forceinline__ int lds_byte(int r, int c) { const int st = (r >> 4) * 2 + (c >> 5), rr = r & 15, cc = c & 31, ob = rr * 64 + cc * 2; return st * 1024 + (ob ^ (((ob >> 9) & 1) << 5)); }
__host__ __device__ __forceinline__ void stage_rc(int b, int& R, int& C) { const int st = b / 1024, sb = b % 1024, swz = sb ^ (((sb >> 9) & 1) << 5); R = (st >> 1) * 16 + swz / 64; C = (st & 1) * 32 + (swz % 64) / 2; }
__host__ __device__ __forceinline__ int perm32(int rho) { const int n = rho >> 4, i = rho & 15; return 8 * (i >> 2) + 4 * n + (i & 3); }

struct Unit { int pm, pn, e; };
struct Gemm { const bf16_t* A; const bf16_t* Bt; int M, N, K; size_t estride; };

struct StaticOrder {
    int nM, nN, nwg, G, c;
    __host__ __device__ void init(int M, int N, int G_, int c_) { nM = M / BM; nN = N / BM; nwg = nM * nN; G = G_; c = c_; }
    __host__ __device__ bool next(int i, Unit& u) const {
        const long L = (long)i * G + c; if (L >= nwg) return false;
        int wgid = (int)L; { const int q = nwg / NXCD, r = nwg % NXCD, xcd = wgid % NXCD, off = wgid / NXCD; wgid = (xcd < r ? xcd * (q + 1) : r * (q + 1) + (xcd - r) * q) + off; }
        const int nig = WGM * nN, gid = wgid / nig, fm = gid * WGM, gsz = (nM - fm) < WGM ? (nM - fm) : WGM;
        u.pm = fm + ((wgid % nig) % gsz); u.pn = (wgid % nig) / gsz; u.e = 0; return true;
    }
    __device__ __forceinline__ void a_ready(const Unit&) const {}
    __device__ __forceinline__ void done(const Unit&) const {}
};
__device__ __forceinline__ unsigned cvt_pk_bf16(float lo, float hi) { unsigned r; asm volatile("v_cvt_pk_bf16_f32 %0, %1, %2" : "=v"(r) : "v"(lo), "v"(hi)); return r; }
typedef float f32x2 __attribute__((ext_vector_type(2)));
__device__ __forceinline__ f32x2 gelu_pk(f32x2 v) {
    const f32x2 av = __builtin_elementwise_abs(v), d = av * 0.2316418882f + 1.0f;
    f32x2 t; t.x = __builtin_amdgcn_rcpf(d.x); t.y = __builtin_amdgcn_rcpf(d.y);
    f32x2 q = t * 0.5307027145f + (-0.7265760135f); q = q * t + 0.7107068705f; q = q * t + (-0.142248368f); q = q * t + 0.127414796f; q = q * t;
    const f32x2 s = (v * v) * (-0.72134752044f);
    f32x2 e; e.x = __builtin_amdgcn_exp2f(s.x); e.y = __builtin_amdgcn_exp2f(s.y);
    const f32x2 m = v * (q * e), r = v - m;
    f32x2 o; o.x = v.x < 0.f ? m.x : r.x; o.y = v.y < 0.f ? m.y : r.y; return o;
}

struct EpiF32 {
    static constexpr bool PERM = false, AFTER_DRAIN = false;
    float* C; int ldc; const float* bias;
    __device__ __forceinline__ void operator()(const f32x4 (&acc)[2][2][4][2], const Unit& u, int wr, int wc, int fr, int fq) const {
        const int row0 = u.pm * BM + wr * 64 + fr, col0 = u.pn * BM + wc * 32 + 4 * fq;
        f32x4 bv[2][2];
#pragma unroll
        for (int bj = 0; bj < 2; ++bj)
#pragma unroll
            for (int n = 0; n < 2; ++n) bv[bj][n] = bias ? *(const f32x4*)(bias + col0 + bj * HALF + n * 16) : (f32x4){0.f, 0.f, 0.f, 0.f};
#pragma unroll
        for (int ai = 0; ai < 2; ++ai)
#pragma unroll
            for (int m = 0; m < 4; ++m) { float* rowp = C + (size_t)(row0 + ai * HALF + m * 16) * ldc + col0;
#pragma unroll
                for (int bj = 0; bj < 2; ++bj)
#pragma unroll
                    for (int n = 0; n < 2; ++n) *(f32x4*)(rowp + bj * HALF + n * 16) = acc[ai][bj][m][n] + bv[bj][n]; }
    }
};
template <int ACT  > struct EpiBf16 {
    static constexpr bool PERM = true, AFTER_DRAIN = false;
    bf16_t* O; int ldc; const float* bias; int split_cols; size_t split_stride;
    __device__ __forceinline__ void operator()(const f32x4 (&acc)[2][2][4][2], const Unit& u, int wr, int wc, int fr, int fq) const {
        const int row0 = u.pm * BM + wr * 64 + fr; int colt = u.pn * BM; bf16_t* base = O;
        if (split_cols) { const int t = colt / split_cols; base += (size_t)t * split_stride; colt -= t * split_cols; }
        const int col0 = colt + wc * 32 + 8 * fq, bcol0 = u.pn * BM + wc * 32 + 8 * fq;
        f32x4 bv[2][2];
#pragma unroll
        for (int bj = 0; bj < 2; ++bj)
#pragma unroll
            for (int n = 0; n < 2; ++n) bv[bj][n] = bias ? *(const f32x4*)(bias + bcol0 + bj * HALF + 4 * n) : (f32x4){0.f, 0.f, 0.f, 0.f};
#pragma unroll
        for (int ai = 0; ai < 2; ++ai)
#pragma unroll
            for (int m = 0; m < 4; ++m) { bf16_t* rowp = base + (size_t)(row0 + ai * HALF + m * 16) * ldc + col0;
#pragma unroll
                for (int bj = 0; bj < 2; ++bj) { f32x4 v0 = acc[ai][bj][m][0] + bv[bj][0], v1 = acc[ai][bj][m][1] + bv[bj][1];
                    if (ACT == 1) { f32x2 a = gelu_pk((f32x2){v0[0], v0[1]}), b = gelu_pk((f32x2){v0[2], v0[3]}), c = gelu_pk((f32x2){v1[0], v1[1]}), d = gelu_pk((f32x2){v1[2], v1[3]});
                        v0 = (f32x4){a.x, a.y, b.x, b.y}; v1 = (f32x4){c.x, c.y, d.x, d.y}; }
                    if (ACT == 2) {
#pragma unroll
                        for (int j = 0; j < 4; ++j) { v0[j] = 0.5f * v0[j] * (1.0f + erff(v0[j] * 0.70710678f)); v1[j] = 0.5f * v1[j] * (1.0f + erff(v1[j] * 0.70710678f)); } }
                    u32x4 w; w.x = cvt_pk_bf16(v0[0], v0[1]); w.y = cvt_pk_bf16(v0[2], v0[3]); w.z = cvt_pk_bf16(v1[0], v1[1]); w.w = cvt_pk_bf16(v1[2], v1[3]);
                    *(u32x4*)(rowp + bj * HALF) = w; } }
    }
};

template <class Epi, class Sched, bool STAMP = false>
__device__ __forceinline__ void gemm_phase(PG8_LAS unsigned char* lds, const Gemm g, const Sched& S, const Epi& E, unsigned long long* stamps) {
    int tid_ = threadIdx.x; asm volatile("" : "+v"(tid_));
    const int tid = tid_, wid = __builtin_amdgcn_readfirstlane(tid >> 6), lane = tid & 63, wr = wid >> 2, wc = wid & 3, fr = lane & 15, fq = lane >> 4;
    const int K = g.K, nt = K / BK;
    int ts_lo = 0, ts_hi = 0, nts = 0; const unsigned long long rt_entry = STAMP ? (unsigned long long)wall_clock64() : 0ull;
#define PG8_STAMP() do { if (STAMP && wid == 0 && nts < 64) { const unsigned long long _c = (unsigned long long)clock64(); \
        ts_lo = (lane == nts) ? (int)(unsigned)_c : ts_lo; ts_hi = (lane == nts) ? (int)(unsigned)(_c >> 32) : ts_hi; ++nts; } } while (0)
    PG8_STAMP();
    unsigned voffA[2], voffB[2];
#pragma unroll
    for (int i = 0; i < 2; ++i) { int R, C; stage_rc(tid * 16 + i * 8192, R, C); const int Rb = Epi::PERM ? ((R & ~31) + perm32(R & 31)) : R;
        voffA[i] = (unsigned)(R * K + C) * 2u; voffB[i] = (unsigned)(Rb * K + C) * 2u; }
    const size_t kstep = (size_t)(BK * 2);
    const size_t hstep = (size_t)HALF * K * 2;
    const size_t tstep = 2 * hstep;
    const unsigned ldsw = (unsigned)wid * 1024u;
    const int aoff = lds_byte(wr * 64 + fr, fq * 8), boff = lds_byte(wc * 32 + fr, fq * 8);
#define PG8_SA(b, h) (((b) * 2 + (h)) * HTB)
#define PG8_SB(b, h) ((4 + (b) * 2 + (h)) * HTB)
#define PG8_STAGE(bufoff, gbase, voff) do { _Pragma("unroll") for (int _i = 0; _i < 2; ++_i) \
        __builtin_amdgcn_global_load_lds((const unsigned*)((const char*)(gbase) + (voff)[_i]), (PG8_LAS unsigned*)(lds + (bufoff) + ldsw + _i * 8192), 16, 0, 0); } while (0)
#define PG8_LDA(dst, b, h) do { _Pragma("unroll") for (int m = 0; m < 4; ++m) _Pragma("unroll") for (int k = 0; k < 2; ++k) dst[m][k] = *(const PG8_LAS bf16x8*)(lds + PG8_SA(b, h) + aoff + m * 2048 + k * 1024); } while (0)
#define PG8_LDB(dst, b, h) do { _Pragma("unroll") for (int n = 0; n < 2; ++n) _Pragma("unroll") for (int k = 0; k < 2; ++k) dst[n][k] = *(const PG8_LAS bf16x8*)(lds + PG8_SB(b, h) + boff + n * 2048 + k * 1024); } while (0)
#define PG8_MMA(ai, bj, At, Bt) do { __builtin_amdgcn_s_setprio(1); _Pragma("unroll") for (int m = 0; m < 4; ++m) _Pragma("unroll") for (int n = 0; n < 2; ++n) _Pragma("unroll") for (int k = 0; k < 2; ++k) \
        acc[ai][bj][m][n] = __builtin_amdgcn_mfma_f32_16x16x32_bf16(Bt[n][k], At[m][k], acc[ai][bj][m][n], 0, 0, 0); __builtin_amdgcn_s_setprio(0); } while (0)
#define PG8_WAIT_V(n) asm volatile("s_waitcnt vmcnt(" #n ")" ::: "memory")
#define PG8_WAIT_L(n) asm volatile("s_waitcnt lgkmcnt(" #n ")" ::: "memory")
#define PG8_BAR __builtin_amdgcn_s_barrier()
#define PG8_SCHED __builtin_amdgcn_sched_barrier(0)
    Unit cur, nxt; int ui = 0;
    if (!S.next(0, cur)) return;
    f32x4 acc[2][2][4][2];
#pragma unroll
    for (int a = 0; a < 2; ++a)
#pragma unroll
        for (int b = 0; b < 2; ++b)
#pragma unroll
            for (int m = 0; m < 4; ++m)
#pragma unroll
                for (int n = 0; n < 2; ++n) acc[a][b][m][n] = (f32x4){0.f, 0.f, 0.f, 0.f};
    bf16x8 At[4][2], B0[2][2], B1[2][2];
    const char* cA = (const char*)g.A + (size_t)cur.pm * tstep; const char* cB = (const char*)g.Bt + (size_t)cur.pn * tstep + (size_t)cur.e * g.estride * 2;
    S.a_ready(cur);
    PG8_STAGE(PG8_SB(0, 0), cB, voffB); PG8_STAGE(PG8_SA(0, 0), cA, voffA); PG8_STAGE(PG8_SB(0, 1), cB + hstep, voffB); PG8_STAGE(PG8_SA(0, 1), cA + hstep, voffA);
    if (wr == 1) PG8_BAR;
    PG8_WAIT_V(4); PG8_BAR;
    PG8_STAGE(PG8_SB(1, 0), cB + kstep, voffB); PG8_STAGE(PG8_SA(1, 0), cA + kstep, voffA); PG8_STAGE(PG8_SB(1, 1), cB + hstep + kstep, voffB);
    PG8_WAIT_V(6); PG8_BAR;
    PG8_STAMP();
    for (;;) {
        const bool has_next = S.next(ui + 1, nxt);
        const char* nA = has_next ? (const char*)g.A + (size_t)nxt.pm * tstep : cA; const char* nB = has_next ? (const char*)g.Bt + (size_t)nxt.pn * tstep + (size_t)nxt.e * g.estride * 2 : cB;
        for (int t = 0; t < nt; t += 2) {
            const bool last = (t == nt - 2);
            const char* a1 = cA + (size_t)(t + 1) * kstep;
            const char* a2 = last ? nA : cA + (size_t)(t + 2) * kstep; const char* b2 = last ? nB : cB + (size_t)(t + 2) * kstep;
            const char* a3 = a2 + kstep; const char* b3 = b2 + kstep;
            if (last && has_next) S.a_ready(nxt);
            PG8_LDB(B0, 0, 0); PG8_SCHED; PG8_LDA(At, 0, 0); PG8_STAGE(PG8_SA(1, 1), a1 + hstep, voffA);
            PG8_WAIT_L(8); PG8_BAR; PG8_WAIT_L(0); PG8_MMA(0, 0, At, B0); PG8_BAR; PG8_SCHED;
            PG8_LDB(B1, 0, 1); PG8_STAGE(PG8_SB(0, 0), b2, voffB);
            PG8_BAR; PG8_WAIT_L(0); PG8_MMA(0, 1, At, B1); PG8_BAR;
            PG8_LDA(At, 0, 1); PG8_STAGE(PG8_SA(0, 0), a2, voffA);
            PG8_BAR; PG8_WAIT_L(0); PG8_MMA(1, 0, At, B0); PG8_BAR; PG8_SCHED;
            PG8_STAGE(PG8_SB(0, 1), b2 + hstep, voffB);
            PG8_WAIT_V(6); PG8_BAR; PG8_MMA(1, 1, At, B1); PG8_BAR;
            PG8_LDB(B0, 1, 0); PG8_SCHED; PG8_LDA(At, 1, 0); PG8_STAGE(PG8_SA(0, 1), a2 + hstep, voffA);
            PG8_WAIT_L(8); PG8_BAR; PG8_WAIT_L(0); PG8_MMA(0, 0, At, B0); PG8_BAR; PG8_SCHED;
            PG8_LDB(B1, 1, 1); PG8_STAGE(PG8_SB(1, 0), b3, voffB);
            PG8_BAR; PG8_WAIT_L(0); PG8_MMA(0, 1, At, B1); PG8_BAR;
            PG8_LDA(At, 1, 1); PG8_STAGE(PG8_SA(1, 0), a3, voffA);
            PG8_BAR; PG8_WAIT_L(0); PG8_MMA(1, 0, At, B0); PG8_BAR; PG8_SCHED;
            PG8_STAGE(PG8_SB(1, 1), b3 + hstep, voffB);
            PG8_WAIT_V(6); PG8_BAR; PG8_MMA(1, 1, At, B1); PG8_BAR;
        }
        PG8_STAMP();
        if constexpr (!Epi::AFTER_DRAIN) { E(acc, cur, wr, wc, fr, fq); S.done(cur); }
        PG8_STAMP();
        if (!has_next) break;
#pragma unroll
        for (int a = 0; a < 2; ++a)
#pragma unroll
            for (int b = 0; b < 2; ++b)
#pragma unroll
                for (int m = 0; m < 4; ++m)
#pragma unroll
                    for (int n = 0; n < 2; ++n) acc[a][b][m][n] = (f32x4){0.f, 0.f, 0.f, 0.f};
        cur = nxt; cA = nA; cB = nB; ++ui;
    }
    PG8_WAIT_V(0);
    if (wr == 0) PG8_BAR;
    PG8_BAR;
    if constexpr (Epi::AFTER_DRAIN) { E.fused(acc, cur, wr, wc, fr, fq, lds, wid, lane); S.done(cur); }
    PG8_STAMP();
    if (STAMP && wid == 0) { stamps[lane] = lane < nts ? (((unsigned long long)(unsigned)ts_hi << 32) | (unsigned)ts_lo) : 0ull;
        if (lane == 62) stamps[62] = rt_entry; if (lane == 63) stamps[63] = (unsigned long long)wall_clock64(); }
#undef PG8_STAMP
#undef PG8_SA
#undef PG8_SB
#undef PG8_STAGE
#undef PG8_LDA
#undef PG8_LDB
#undef PG8_MMA
#undef PG8_WAIT_V
#undef PG8_WAIT_L
#undef PG8_BAR
#undef PG8_SCHED
}
}
namespace pg8 {
struct EpiRes {
    static constexpr bool PERM = false, AFTER_DRAIN = false;
    const float* base_lat; const float* base_ctx; float* out_lat; float* out_ctx; const float* gvec;
    __device__ __forceinline__ void operator()(const f32x4 (&acc)[2][2][4][2], const Unit& u, int wr, int wc, int fr, int fq) const {
        const bool isctx = u.pm >= 128;
        const int prow = (isctx ? (u.pm - 128) : u.pm) * BM;
        const float* base = isctx ? base_ctx : base_lat; float* out = isctx ? out_ctx : out_lat;
        const float* gv = gvec + (size_t)(isctx ? 8 : (u.pm >> 4)) * 6144;
        const int row0 = prow + wr * 64 + fr, col0 = u.pn * BM + wc * 32 + 4 * fq;
        f32x4 gvv[2][2];
#pragma unroll
        for (int bj = 0; bj < 2; ++bj)
#pragma unroll
            for (int n = 0; n < 2; ++n) gvv[bj][n] = *(const f32x4*)(gv + col0 + bj * HALF + n * 16);
#pragma unroll
        for (int ai = 0; ai < 2; ++ai)
#pragma unroll
            for (int m = 0; m < 4; ++m) { const size_t off = (size_t)(row0 + ai * HALF + m * 16) * 1024 + col0;
#pragma unroll
                for (int bj = 0; bj < 2; ++bj)
#pragma unroll
                    for (int n = 0; n < 2; ++n) { const f32x4 b = *(const f32x4*)(base + off + bj * HALF + n * 16);
                        *(f32x4*)(out + off + bj * HALF + n * 16) = b + gvv[bj][n] * acc[ai][bj][m][n]; } }
    }
};
struct EpiSwiglu {
    static constexpr bool PERM = true, AFTER_DRAIN = false;
    bf16_t* O; int ldc;
    __device__ __forceinline__ void operator()(const f32x4 (&acc)[2][2][4][2], const Unit& u, int wr, int wc, int fr, int fq) const {
        const int row0 = u.pm * BM + wr * 64 + fr, col0 = u.pn * HALF + wc * 32 + 8 * fq;
#pragma unroll
        for (int ai = 0; ai < 2; ++ai)
#pragma unroll
            for (int m = 0; m < 4; ++m) { bf16_t* rowp = O + (size_t)(row0 + ai * HALF + m * 16) * ldc + col0;
                float h[8];
#pragma unroll
                for (int n = 0; n < 2; ++n)
#pragma unroll
                    for (int j = 0; j < 4; ++j) { const float g = acc[ai][0][m][n][j], up = acc[ai][1][m][n][j]; h[n * 4 + j] = g * __builtin_amdgcn_rcpf(1.0f + __expf(-g)) * up; }
                u32x4 w; w.x = cvt_pk_bf16(h[0], h[1]); w.y = cvt_pk_bf16(h[2], h[3]); w.z = cvt_pk_bf16(h[4], h[5]); w.w = cvt_pk_bf16(h[6], h[7]);
                *(u32x4*)rowp = w; }
    }
};
struct MoeOrder {
    int nN, G, c, nunits; const int* tab;
    __device__ void init(const int* tab_, int nN_, int G_, int c_) { tab = tab_; nN = nN_; G = G_; c = c_; nunits = tab_[0] * nN_; }
    __device__ bool next(int i, Unit& u) const {
        const int L = i * G + c; if (L >= nunits) return false;
        u.pm = L / nN; u.pn = L - u.pm * nN; u.e = tab[1 + u.pm]; return true;
    }
    __device__ __forceinline__ void a_ready(const Unit&) const {}
    __device__ __forceinline__ void done(const Unit&) const {}
};
}
enum { I_X = 0, I_C, I_CTX, I_CCTX, I_MODW, I_MODB, I_NMIXG, I_NFFNG, I_WIN, I_WOUT, I_LCW, I_LCB, I_LWA, I_LBA, I_LWX, I_LBX, I_LLAM,
       I_RMU, I_RWUP, I_RW0, I_RAUP, I_RA0, I_RGUP, I_RKK, I_RKA, I_RRK, I_RLNG, I_RLNB, I_MIB, I_MFB, I_MNG, I_GCW, I_GALOG, I_GDTB, I_GNG,
       I_FWG, I_FWU, I_FWD, I_MROUTER, I_MWG, I_MWU, I_MWD, I_FNG, N_IN };
struct Args { const float* in[N_IN]; float* out; unsigned char* ws; int ph_lo, ph_hi; };
struct Ctx {
    const float* const* in; float* out; unsigned char* ws; LAS unsigned char* lds;
    int tid, lane, wave, G, wg;
};
#define WSP(T, off) ((T*)(C.ws + (off)))

__device__ __forceinline__ int seqrow_raster(int i, int d, int b) {
    if (i < CTXL) { const int p = d ? (CTXL - 1 - i) : i; return T_LAT + b * CTXL + p; }
    const int j = i - CTXL; const int p = d ? (SEQ - 1 - j) : j; return b * SEQ + p;
}
__device__ __forceinline__ int seqrow_cm(int i, int d, int b) {
    if (i < CTXL) { const int p = d ? (CTXL - 1 - i) : i; return T_LAT + b * CTXL + p; }
    const int j = i - CTXL; const int p = d ? (SEQ - 1 - j) : j; return b * SEQ + (p & 63) * 64 + (p >> 6);
}

__device__ __forceinline__ void phase_pre(const Ctx& C) {
    LAS float* sc = (LAS float*)C.lds;
    LAS float* red = sc + 9 * 1024;
    float* modv = WSP(float, WS_MODV);
    bool filled = false;
    for (int it = C.wg; it < DEPTH * 48; it += C.G) {
        if (!filled) {
            for (int i = C.tid; i < 9 * 1024; i += NTHR) { const float v = i < 8192 ? C.in[I_C][i] : C.in[I_CCTX][i - 8192]; sc[i] = siluf_(v); }
            filled = true; __syncthreads();
        }
        const int l = it / 48, jb = it % 48, col = C.tid & 127, kg = C.tid >> 7;
        const float* W = C.in[I_MODW] + (size_t)l * 1024 * 6144 + jb * 128 + col;
        float acc[9];
#pragma unroll
        for (int r = 0; r < 9; ++r) acc[r] = 0.f;
        for (int k = kg * 256; k < kg * 256 + 256; ++k) { const float w = W[(size_t)k * 6144];
#pragma unroll
            for (int r = 0; r < 9; ++r) acc[r] += sc[r * 1024 + k] * w; }
#pragma unroll
        for (int r = 0; r < 9; ++r) red[(kg * 9 + r) * 128 + col] = acc[r];
        __syncthreads();
        for (int i = C.tid; i < 9 * 128; i += NTHR) { const int r = i >> 7, cc = i & 127;
            const float s = red[(0 * 9 + r) * 128 + cc] + red[(1 * 9 + r) * 128 + cc] + red[(2 * 9 + r) * 128 + cc] + red[(3 * 9 + r) * 128 + cc];
            modv[((size_t)l * 9 + r) * 6144 + jb * 128 + cc] = s + C.in[I_MODB][l * 6144 + jb * 128 + cc]; }
        __syncthreads();
    }
}

__device__ __forceinline__ void tr_item(const float* src, size_t ld, int k0, int ns0, bf16* dst, int drow0, int Kd, LAS float* scr, int lane, bool zero) {
    if (!zero) {
#pragma unroll 8
        for (int i = 0; i < 32; ++i) { const int kk = 2 * i + (lane >> 5); scr[kk * 33 + (lane & 31)] = src[(size_t)(k0 + kk) * ld + ns0 + (lane & 31)]; }
    }
    LDS_WAIT(); asm volatile("" ::: "memory");
    const int c = lane & 7;
#pragma unroll
    for (int j = 0; j < 4; ++j) { const int n = (lane >> 3) + 8 * j; const LAS float* s = scr + (8 * c) * 33 + n;
        v4u o; o.x = pk2(s[0 * 33], s[1 * 33]); o.y = pk2(s[2 * 33], s[3 * 33]); o.z = pk2(s[4 * 33], s[5 * 33]); o.w = pk2(s[6 * 33], s[7 * 33]);
        if (zero) o = (v4u){0u, 0u, 0u, 0u};
        *(v4u*)(dst + (size_t)(drow0 + n) * Kd + k0 + 8 * c) = o; }
    LDS_WAIT(); asm volatile("" ::: "memory");
}
__device__ __forceinline__ void convert_layer(const Ctx& C, int l) {
    LAS float* scr = (LAS float*)(C.lds + C.wave * 8704);
    const int gw = C.wg * NWAVES + C.wave, NGW = C.G * NWAVES;
    constexpr int I_IN = 16 * 112, I_OUT = 16 * 32, I_GU = 16 * 176, I_DN = 44 * 32, I_E = 16 * 88 + 22 * 32;
    const bool moe = l & 1; const int li = l >> 1;
    const int nitems = I_IN + I_OUT + (moe ? NE * I_E : (I_GU + I_DN));
    bf16* win = WSP(bf16, WS_WIN); bf16* wout = WSP(bf16, WS_WOUT); bf16* wgu = WSP(bf16, WS_WGU); bf16* wdn = WSP(bf16, WS_WDN);
    for (int it = gw; it < nitems; it += NGW) {
        int r = it;
        if (r < I_IN) { const int kb = r / 112, nb = r % 112; tr_item(C.in[I_WIN] + (size_t)l * 1024 * IN_COLS, IN_COLS, 64 * kb, 32 * nb, win, 32 * nb, 1024, scr, C.lane, nb == 111); continue; }
        r -= I_IN;
        if (r < I_OUT) { const int kb = r / 32, nb = r % 32; tr_item(C.in[I_WOUT] + (size_t)l * 1024 * 1024, 1024, 64 * kb, 32 * nb, wout, 32 * nb, 1024, scr, C.lane, false); continue; }
        r -= I_OUT;
        if (!moe) {
            if (r < I_GU) { const int kb = r / 176, nb = r % 176, tile = nb >> 3, q = nb & 7;
                const float* src = (q < 4 ? C.in[I_FWG] : C.in[I_FWU]) + (size_t)li * 1024 * DFF;
                tr_item(src, DFF, 64 * kb, tile * 128 + (q & 3) * 32, wgu, 32 * nb, 1024, scr, C.lane, false); continue; }
            r -= I_GU;
            { const int kb = r / 32, nb = r % 32; tr_item(C.in[I_FWD] + (size_t)li * DFF * 1024, 1024, 64 * kb, 32 * nb, wdn, 32 * nb, DFF, scr, C.lane, false); }
        } else {
            const int e = r / I_E; int rr = r % I_E;
            if (rr < 16 * 88) { const int kb = rr / 88, nb = rr % 88, tile = nb >> 3, q = nb & 7;
                const float* src = (q < 4 ? C.in[I_MWG] : C.in[I_MWU]) + ((size_t)li * NE + e) * 1024 * DFE;
                tr_item(src, DFE, 64 * kb, tile * 128 + (q & 3) * 32, wgu + (size_t)e * 2 * DFE * 1024, 32 * nb, 1024, scr, C.lane, false); continue; }
            rr -= 16 * 88;
            { const int kb = rr / 32, nb = rr % 32; tr_item(C.in[I_MWD] + ((size_t)li * NE + e) * DFE * 1024, 1024, 64 * kb, 32 * nb, wdn + (size_t)e * 1024 * DFE, 32 * nb, DFE, scr, C.lane, false); }
        }
    }
}

template <bool ROUTE>
__device__ __forceinline__ void norm_rows(const Ctx& C, int l, const float* xlat, const float* xctx, const float* gain, int shoff, int scoff, int nrows, int moe_li) {
    const float* modv = WSP(float, WS_MODV) + (size_t)l * 9 * 6144;
    bf16* hb = WSP(bf16, WS_HB);
    const int gw = C.wg * NWAVES + C.wave, NGW = C.G * NWAVES;
    LAS unsigned* lcnt = (LAS unsigned*)(C.lds + 65536);
    unsigned* route = WSP(unsigned, WS_ROUTE);
    if (ROUTE) { if (C.tid < 8) lcnt[C.tid] = 0u; __syncthreads(); }
    f32x4 gv[4];
#pragma unroll
    for (int j = 0; j < 4; ++j) gv[j] = *(const f32x4*)(gain + 4 * C.lane + 256 * j);
    for (int m = gw; m < nrows; m += NGW) {
        const bool isctx = m >= T_LAT;
        const float* xr = isctx ? xctx + (size_t)(m - T_LAT) * 1024 : xlat + (size_t)m * 1024;
        const float* mv = modv + (size_t)(isctx ? 8 : (m >> 12)) * 6144;
        f32x4 v[4]; float s = 0.f;
#pragma unroll
        for (int j = 0; j < 4; ++j) { v[j] = *(const f32x4*)(xr + 4 * C.lane + 256 * j); s += (v[j].x * v[j].x + v[j].y * v[j].y) + (v[j].z * v[j].z + v[j].w * v[j].w); }
        const float rs = 1.0f / sqrtf(wave_sum(s) * (1.0f / 1024.0f) + 1e-6f);
#pragma unroll
        for (int j = 0; j < 4; ++j) { const f32x4 sh = *(const f32x4*)(mv + shoff + 4 * C.lane + 256 * j), scl = *(const f32x4*)(mv + scoff + 4 * C.lane + 256 * j);
            v[j] = (v[j] * rs * gv[j]) * (scl + 1.0f) + sh;
            v2u o; o.x = pk2(v[j].x, v[j].y); o.y = pk2(v[j].z, v[j].w);
            *(v2u*)(hb + (size_t)m * 1024 + 4 * C.lane + 256 * j) = o; }
        if (ROUTE) {
            const float* rt = C.in[I_MROUTER] + (size_t)moe_li * 1024 * NE;
            float lg[8];
#pragma unroll
            for (int e = 0; e < 8; ++e) lg[e] = 0.f;
#pragma unroll
            for (int j = 0; j < 4; ++j)
#pragma unroll
                for (int q = 0; q < 4; ++q) { const int k = 4 * C.lane + 256 * j + q; const f32x4 r0 = *(const f32x4*)(rt + (size_t)k * 8), r1 = *(const f32x4*)(rt + (size_t)k * 8 + 4); const float hv = v[j][q];
                    lg[0] += hv * r0.x; lg[1] += hv * r0.y; lg[2] += hv * r0.z; lg[3] += hv * r0.w; lg[4] += hv * r1.x; lg[5] += hv * r1.y; lg[6] += hv * r1.z; lg[7] += hv * r1.w; }
#pragma unroll
            for (int e = 0; e < 8; ++e) lg[e] = wave_sum(lg[e]);
            int e0 = 0; float l0 = lg[0];
#pragma unroll
            for (int e = 1; e < 8; ++e) if (lg[e] > l0) { l0 = lg[e]; e0 = e; }
            int e1 = -1; float l1 = -3.0e38f;
#pragma unroll
            for (int e = 0; e < 8; ++e) if (e != e0 && lg[e] > l1) { l1 = lg[e]; e1 = e; }
            const float w0 = 1.0f / (1.0f + __expf(l1 - l0)), w1 = 1.0f - w0;
            if (C.lane == 0) {
                const unsigned r0 = atomicAdd((unsigned*)&lcnt[e0], 1u), r1 = atomicAdd((unsigned*)&lcnt[e1], 1u);
                v4u a; a.x = (unsigned)e0; a.y = (unsigned)e1; a.z = r0; a.w = r1;
                *(v4u*)(route + (size_t)m * 8) = a;
                v2u b; b.x = __builtin_bit_cast(unsigned, w0); b.y = __builtin_bit_cast(unsigned, w1);
                *(v2u*)(route + (size_t)m * 8 + 4) = b;
            }
        }
    }
    if (ROUTE) {
        __syncthreads();
        if (C.tid < 8) { unsigned* gc = WSP(unsigned, WS_CTL) + CW_MOECNT + 64 * moe_li; const unsigned base = atomicAdd(gc + C.tid, lcnt[C.tid]); WSP(unsigned, WS_WGBASE)[C.wg * 8 + C.tid] = base; }
    }
}
template <bool FIN>
__device__ __forceinline__ void lru_chunk(const Ctx& C, int l, int b, int c) {
    LAS float* U = (LAS float*)C.lds;
    const bf16* P = WSP(const bf16, WS_P);
    const bool isctx = c < 4; const int p0 = isctx ? c * 64 : (c - 4) * 64; const int Lp = isctx ? CTXL : SEQ; const int row0 = isctx ? T_LAT + b * CTXL : b * SEQ;
    const int ch = C.tid & 255, half = C.tid >> 8;
    {
        const float* cw = C.in[I_LCW] + (size_t)l * 4 * GW + ch; const float w0 = cw[0], w1 = cw[GW], w2 = cw[2 * GW], w3 = cw[3 * GW], cb = C.in[I_LCB][l * GW + ch];
        const int t0 = half * 32;
        auto ld = [&](int p) -> float { return (p >= 0 && p < Lp) ? bf2f(P[(size_t)(row0 + p) * PLD + ch]) : 0.f; };
        float xm2 = ld(p0 + t0 - 2), xm1 = ld(p0 + t0 - 1), x0 = ld(p0 + t0);
        for (int t = 0; t < 32; ++t) { const float xp1 = ld(p0 + t0 + t + 1); U[(t0 + t) * 256 + ch] = w0 * xm2 + w1 * xm1 + w2 * x0 + w3 * xp1 + cb; xm2 = xm1; xm1 = x0; x0 = xp1; }
    }
    __syncthreads();
    const int d = half, hd = ch >> 6, jj = ch & 63;
    const float* wa = C.in[I_LWA] + ((size_t)((l * 2 + d) * 4 + hd) * 64) * 64 + jj;
    const float* wx = C.in[I_LWX] + ((size_t)((l * 2 + d) * 4 + hd) * 64) * 64 + jj;
    const float ba = C.in[I_LBA][(l * 2 + d) * GW + ch], bx = C.in[I_LBX][(l * 2 + d) * GW + ch];
    const float sp8 = 8.0f * softplusf_(-C.in[I_LLAM][(l * 2 + d) * GW + ch]);
    const size_t sidx = ((size_t)(b * NCH + c) * 2 + d) * 256 + ch;
    float h = FIN ? WSP(const float, WS_HIN)[sidx] : 0.f, sla = 0.f;
    LAS bf16* H16 = (LAS bf16*)(U + 64 * 256) + d * 64 * 256;
    const int sgn = d ? -1 : 1;
#pragma unroll 1
    for (int g = 0; g < 4; ++g) {
        const int tstart = d ? (63 - g * 16) : g * 16;
        float ar[16], ai[16];
#pragma unroll
        for (int tt = 0; tt < 16; ++tt) { ar[tt] = 0.f; ai[tt] = 0.f; }
        const LAS float* ub = U + tstart * 256 + hd * 64;
#pragma unroll 1
        for (int i = 0; i < 64; i += 4) {
            float a4[4], x4[4];
#pragma unroll
            for (int q = 0; q < 4; ++q) { a4[q] = wa[(i + q) * 64]; x4[q] = wx[(i + q) * 64]; }
#pragma unroll
            for (int tt = 0; tt < 16; ++tt) { const f32x4 uu = *(const LAS f32x4*)(ub + sgn * tt * 256 + i);
                ar[tt] += uu.x * a4[0] + uu.y * a4[1] + uu.z * a4[2] + uu.w * a4[3];
                ai[tt] += uu.x * x4[0] + uu.y * x4[1] + uu.z * x4[2] + uu.w * x4[3]; }
        }
#pragma unroll
        for (int tt = 0; tt < 16; ++tt) {
            const int tok = tstart + sgn * tt;
            const float r = sigmoidf_(ar[tt] + ba), ig = sigmoidf_(ai[tt] + bx);
            const float la = -sp8 * r; const float a = __expf(la);
            const float bb = sqrtf(-expm1f_(2.0f * la)) * (ig * U[tok * 256 + ch]);
            h = a * h + bb; sla += la;
            if (FIN) H16[tok * 256 + ch] = (bf16)f2bf(h);
        }
    }
    if (!FIN) { float* ls = WSP(float, WS_LSUM) + sidx * 2; ls[0] = sla; ls[1] = h; __syncthreads(); return; }
    __syncthreads();
    bf16* yc = WSP(bf16, WS_HB);
    const LAS bf16* H0 = (const LAS bf16*)(U + 64 * 256); const LAS bf16* H1 = H0 + 64 * 256;
    for (int t = half * 32; t < half * 32 + 32; ++t) {
        const size_t row = (size_t)(row0 + p0 + t);
        const float gate = bf2f(P[row * PLD + 256 + ch]);
        yc[row * 1024 + ch] = (bf16)f2bf((bf2f(H0[t * 256 + ch]) + bf2f(H1[t * 256 + ch])) * gelu_tanh(gate));
    }
    __syncthreads();
}
__device__ __forceinline__ void lru_carry(const Ctx& C, int idx) {
    const int ch = idx & 255, d = (idx >> 8) & 1, b = idx >> 9;
    const float* ls = WSP(const float, WS_LSUM); float* hin = WSP(float, WS_HIN);
    float H = 0.f;
    for (int k = 0; k < NCH; ++k) {
        const int c = d ? (k < 4 ? 3 - k : NCH + 3 - k) : k;
        const size_t sidx = ((size_t)(b * NCH + c) * 2 + d) * 256 + ch;
        hin[sidx] = H;
        H = __expf(ls[sidx * 2]) * H + ls[sidx * 2 + 1];
    }
}

__device__ __forceinline__ float rw_shift(const bf16* P, int row0, int p, int Lp, int colB, float mu0, float mu1) {
    const size_t o = (size_t)(row0 + p) * PLD + OFF_B + colB;
    const float x = bf2f(P[o]);
    const float pv = p > 0 ? bf2f(P[o - PLD]) : 0.f, nx = p < Lp - 1 ? bf2f(P[o + PLD]) : 0.f;
    return x + mu0 * (pv - x) + mu1 * (nx - x);
}
__device__ __forceinline__ void rwkv_prep(const Ctx& C, int l, int b, int c) {
    LAS float* XW = (LAS float*)C.lds;
    LAS float* XA = XW + 64 * 64;
    LAS float* XG = XA + 64 * 64;
    const bf16* P = WSP(const bf16, WS_P);
    const bool isctx = c < 4; const int p0 = isctx ? c * 64 : (c - 4) * 64; const int Lp = isctx ? CTXL : SEQ; const int row0 = isctx ? T_LAT + b * CTXL : b * SEQ;
    const float* mu = C.in[I_RMU] + (size_t)l * 2 * B_COLS;
    for (int it = C.tid; it < 64 * 192; it += NTHR) {
        const int t = it / 192, ci = it % 192, colB = 768 + ci;
        const float v = rw_shift(P, row0, p0 + t, Lp, colB, mu[colB], mu[B_COLS + colB]);
        if (ci < 64) XW[t * 64 + ci] = tanhf_(v); else if (ci < 128) XA[t * 64 + ci - 64] = v; else XG[t * 64 + ci - 128] = sigmoidf_(v);
    }
    __syncthreads();
    const int ch = C.tid & 255, half = C.tid >> 8, head = ch >> 6;
    bf16* wa_out = WSP(bf16, WS_HB); bf16* g_out = WSP(bf16, WS_G); float* bonus = WSP(float, WS_BONUS);
    const float* wup = C.in[I_RWUP] + (size_t)l * 2 * 32 * GW + ch;
    const float* aup = C.in[I_RAUP] + (size_t)l * 2 * 32 * GW + ch;
    const float* gup = C.in[I_RGUP] + (size_t)l * 64 * GW + ch;
    const float w00 = C.in[I_RW0][(l * 2 + 0) * GW + ch], w01 = C.in[I_RW0][(l * 2 + 1) * GW + ch];
    const float a00 = C.in[I_RA0][(l * 2 + 0) * GW + ch], a01 = C.in[I_RA0][(l * 2 + 1) * GW + ch];
    const float k_a = C.in[I_RKA][l * GW + ch], r_k = C.in[I_RRK][l * GW + ch];
    const float mur0 = mu[ch], mur1 = mu[B_COLS + ch], muk0 = mu[256 + ch], muk1 = mu[B_COLS + 256 + ch];
#pragma unroll 1
    for (int sub = 0; sub < 2; ++sub) {
        const int t0 = half * 32 + sub * 16;
        float acc[16], av0[16], av1[16];
#pragma unroll
        for (int kind = 0; kind < 4; ++kind) {
            const int d = kind & 1; const bool isw = kind < 2;
            const float* W = (isw ? wup : aup) + (size_t)d * 32 * GW; const LAS float* X = (isw ? XW : XA) + d * 32;
#pragma unroll
            for (int t = 0; t < 16; ++t) acc[t] = 0.f;
            for (int r = 0; r < 32; r += 4) {
                const float g0 = W[(r + 0) * GW], g1 = W[(r + 1) * GW], g2 = W[(r + 2) * GW], g3 = W[(r + 3) * GW];
#pragma unroll
                for (int t = 0; t < 16; ++t) { const f32x4 x = *(const LAS f32x4*)(X + (t0 + t) * 64 + r); acc[t] += x.x * g0 + x.y * g1 + x.z * g2 + x.w * g3; }
            }
#pragma unroll
            for (int t = 0; t < 16; ++t) {
                const size_t row = (size_t)(row0 + p0 + t0 + t);
                float val;
                if (isw) val = __expf(-0.6065306597126334f * sigmoidf_(acc[t] + (d ? w01 : w00)));
                else { val = sigmoidf_(acc[t] + (d ? a01 : a00)); if (d) av1[t] = val; else av0[t] = val; }
                wa_out[row * 1024 + kind * 256 + ch] = (bf16)f2bf(val);
            }
        }
#pragma unroll
        for (int t = 0; t < 16; ++t) acc[t] = 0.f;
        for (int j = 0; j < 64; j += 4) {
            const float g0 = gup[(j + 0) * GW], g1 = gup[(j + 1) * GW], g2 = gup[(j + 2) * GW], g3 = gup[(j + 3) * GW];
#pragma unroll
            for (int t = 0; t < 16; ++t) { const f32x4 x = *(const LAS f32x4*)(XG + (t0 + t) * 64 + j); acc[t] += x.x * g0 + x.y * g1 + x.z * g2 + x.w * g3; }
        }
#pragma unroll
        for (int t = 0; t < 16; ++t) {
            const int p = p0 + t0 + t; const size_t row = (size_t)(row0 + p);
            g_out[row * 256 + ch] = (bf16)f2bf(acc[t]);
            const float rs = rw_shift(P, row0, p, Lp, ch, mur0, mur1), ks = rw_shift(P, row0, p, Lp, 256 + ch, muk0, muk1);
            const float km = ks * (1.0f + (av0[t] - 1.0f) * k_a) + ks * (1.0f + (av1[t] - 1.0f) * k_a);
            const float bs = wave_sum(rs * r_k * km);
            if (C.lane == 0) bonus[row * 4 + head] = bs;
        }
    }
    __syncthreads();
}
__device__ __forceinline__ void rwkv_scan(const Ctx& C, int l, int idx) {
    const int d = idx >> 6, b = (idx >> 3) & 7, h = (idx >> 1) & 3, half = idx & 1;
    LAS float* BUF = (LAS float*)C.lds;
    LAS float* YB = BUF + 2 * 32 * 6 * 64;
    const bf16* P = WSP(const bf16, WS_P); const bf16* WA = WSP(const bf16, WS_HB); bf16* outb = WSP(bf16, WS_OUTB) + (size_t)d * T_ALL * 256;
    const int st = C.tid >> 4, q4 = C.tid & 15, chh = h * 64 + q4 * 4;
    const float* mu = C.in[I_RMU] + (size_t)l * 2 * B_COLS;
    f32x4 mu0[3], mu1[3];
#pragma unroll
    for (int q = 0; q < 3; ++q) { mu0[q] = *(const f32x4*)(mu + q * 256 + chh); mu1[q] = *(const f32x4*)(mu + B_COLS + q * 256 + chh); }
    const f32x4 kk_w = *(const f32x4*)(C.in[I_RKK] + l * GW + chh), ka_w = *(const f32x4*)(C.in[I_RKA] + l * GW + chh);
    auto stage = [&](int nb, int bufi) {
        const int i = nb * 32 + st;
        const bool isctx = i < CTXL; const int Lp = isctx ? CTXL : SEQ; const int j = isctx ? i : i - CTXL; const int p = d ? (Lp - 1 - j) : j;
        const int row = (isctx ? T_LAT + b * CTXL : b * SEQ) + p;
        f32x4 sh[3];
#pragma unroll
        for (int q = 0; q < 3; ++q) {
            const bf16* pp = P + (size_t)row * PLD + OFF_B + q * 256 + chh;
            const v2u xc = *(const v2u*)pp; v2u xp = (v2u){0u, 0u}, xn = (v2u){0u, 0u};
            if (p > 0) xp = *(const v2u*)(pp - PLD);
            if (p < Lp - 1) xn = *(const v2u*)(pp + PLD);
            const f32x4 x = (f32x4){bflo(xc.x), bfhi(xc.x), bflo(xc.y), bfhi(xc.y)}, pv = (f32x4){bflo(xp.x), bfhi(xp.x), bflo(xp.y), bfhi(xp.y)}, nx = (f32x4){bflo(xn.x), bfhi(xn.x), bflo(xn.y), bfhi(xn.y)};
            sh[q] = x + mu0[q] * (pv - x) + mu1[q] * (nx - x);
        }
        const v2u wr_ = *(const v2u*)(WA + (size_t)row * 1024 + d * 256 + chh), ar_ = *(const v2u*)(WA + (size_t)row * 1024 + (2 + d) * 256 + chh);
        const f32x4 w = (f32x4){bflo(wr_.x), bfhi(wr_.x), bflo(wr_.y), bfhi(wr_.y)}, a = (f32x4){bflo(ar_.x), bfhi(ar_.x), bflo(ar_.y), bfhi(ar_.y)};
        f32x4 kk = sh[1] * kk_w;
        const float ss = row16_sum((kk.x * kk.x + kk.y * kk.y) + (kk.z * kk.z + kk.w * kk.w));
        kk = kk * (1.0f / sqrtf(ss + 1e-6f));
        const f32x4 km = sh[1] * ((a - 1.0f) * ka_w + 1.0f), beta = kk * a;
        LAS float* o = BUF + ((bufi * 32 + st) * 6) * 64 + q4 * 4;
        *(LAS f32x4*)(o + 0 * 64) = sh[0]; *(LAS f32x4*)(o + 1 * 64) = kk; *(LAS f32x4*)(o + 2 * 64) = w; *(LAS f32x4*)(o + 3 * 64) = beta; *(LAS f32x4*)(o + 4 * 64) = km; *(LAS f32x4*)(o + 5 * 64) = sh[2];
    };
    const int rr = C.tid >> 4, jq = C.tid & 15;
    f32x4 s = (f32x4){0.f, 0.f, 0.f, 0.f};
    constexpr int NBLK = NSTEP / 32;
    stage(0, 0);
    __syncthreads();
    for (int nb = 0; nb < NBLK; ++nb) {
        if (nb + 1 < NBLK) stage(nb + 1, (nb + 1) & 1);
        const LAS float* bb = BUF + ((nb & 1) * 32) * 6 * 64;
        LAS float* yb = YB + (nb & 1) * 1024;
#pragma unroll 4
        for (int t = 0; t < 32; ++t) {
            const LAS float* o = bb + t * 6 * 64 + jq * 4;
            const f32x4 r4 = *(const LAS f32x4*)(o), kk = *(const LAS f32x4*)(o + 64), w = *(const LAS f32x4*)(o + 128), be = *(const LAS f32x4*)(o + 192), km = *(const LAS f32x4*)(o + 256);
            const float vv = bb[t * 6 * 64 + 5 * 64 + half * 32 + rr];
            const float sk = row16_sum((s.x * kk.x + s.y * kk.y) + (s.z * kk.z + s.w * kk.w));
            s = s * w - be * sk + km * vv;
            const float y = row16_sum((s.x * r4.x + s.y * r4.y) + (s.z * r4.z + s.w * r4.w));
            if (jq == 0) yb[t * 32 + rr] = y;
        }
        __syncthreads();
        {
            const int t = C.tid >> 4, r2 = (C.tid & 15) * 2;
            const int i = nb * 32 + t; const int row = seqrow_raster(i, d, b);
            *(unsigned*)(outb + (size_t)row * 256 + h * 64 + half * 32 + r2) = pk2(yb[t * 32 + r2], yb[t * 32 + r2 + 1]);
        }
    }
    __syncthreads();
}

__device__ __forceinline__ void mlstm_scan_v0(const Ctx& C, int l, int idx) {
    const int d = idx >> 5, b = (idx >> 2) & 7, h = idx & 3, lane = C.lane, w = C.wave;
    LAS float* PN = (LAS float*)C.lds;
    LAS float* PD = PN + 2 * 8 * 64;
    const bf16* P = WSP(const bf16, WS_P); bf16* outc = WSP(bf16, WS_OUTC) + (size_t)d * T_ALL * 256;
    const float ib = C.in[I_MIB][(l * 2 + d) * NH + h], fb = C.in[I_MFB][(l * 2 + d) * NH + h];
    float Cm[8], nk[8];
#pragma unroll
    for (int k = 0; k < 8; ++k) { Cm[k] = 0.f; nk[k] = 0.f; }
    float m = 0.f;
    int row = seqrow_cm(0, d, b);
    size_t ro = (size_t)row * PLD + OFF_C;
    v4u q8 = *(const v4u*)(P + ro + h * 64 + 8 * w), k8 = *(const v4u*)(P + ro + 256 + h * 64 + 8 * w);
    unsigned short vraw = P[ro + 512 + h * 64 + lane], giraw = P[ro + 1024 + d * 4 + h], gfraw = P[ro + 1024 + 8 + d * 4 + h];
    for (int i = 0; i < NSTEP; ++i) {
        const int crow = row; const v4u cq = q8, ck = k8; const float vv = bf2f(vraw), li = bf2f(giraw) + ib, gf = bf2f(gfraw) + fb;
        if (i + 1 < NSTEP) {
            row = seqrow_cm(i + 1, d, b); ro = (size_t)row * PLD + OFF_C;
            q8 = *(const v4u*)(P + ro + h * 64 + 8 * w); k8 = *(const v4u*)(P + ro + 256 + h * 64 + 8 * w);
            vraw = P[ro + 512 + h * 64 + lane]; giraw = P[ro + 1024 + d * 4 + h]; gfraw = P[ro + 1024 + 8 + d * 4 + h];
        }
        const float lf = -softplusf_(-gf);
        const float mn = fmaxf(lf + m, li), fp = __expf(lf + m - mn), ip = __expf(li - mn);
        const float qf[8] = {bflo(cq.x), bfhi(cq.x), bflo(cq.y), bfhi(cq.y), bflo(cq.z), bfhi(cq.z), bflo(cq.w), bfhi(cq.w)};
        const float kf[8] = {bflo(ck.x), bfhi(ck.x), bflo(ck.y), bfhi(ck.y), bflo(ck.z), bfhi(ck.z), bflo(ck.w), bfhi(ck.w)};
        const float ipv = ip * vv;
        float num = 0.f, den = 0.f;
#pragma unroll
        for (int k = 0; k < 8; ++k) { const float kk = kf[k] * 0.125f; Cm[k] = fp * Cm[k] + ipv * kk; nk[k] = fp * nk[k] + ip * kk; num += Cm[k] * qf[k]; den += nk[k] * qf[k]; }
        m = mn;
        const int pb_ = i & 1;
        PN[(pb_ * 8 + w) * 64 + lane] = num; if (lane == 0) PD[pb_ * 8 + w] = den;
        __syncthreads();
        if (w == 0) {
            float ns = 0.f, ds = 0.f;
#pragma unroll
            for (int ww = 0; ww < 8; ++ww) { ns += PN[(pb_ * 8 + ww) * 64 + lane]; ds += PD[pb_ * 8 + ww]; }
            outc[(size_t)crow * 256 + h * 64 + lane] = (bf16)f2bf(ns / fmaxf(fabsf(ds), __expf(-mn)));
        }
    }
    __syncthreads();
}

__device__ __forceinline__ void gdn_prep(const Ctx& C, int l, int b, int c) {
    const bf16* P = WSP(const bf16, WS_P); bf16* gq = WSP(bf16, WS_GQ);
    const bool isctx = c < 4; const int p0 = isctx ? c * 64 : (c - 4) * 64; const int Lp = isctx ? CTXL : SEQ;
    const int lane = C.lane;
    auto rowof = [&](int p) -> int { return isctx ? (T_LAT + b * CTXL + p) : (b * SEQ + (p & 63) * 64 + (p >> 6)); };
    float cw[4][12], x[4][12];
#pragma unroll
    for (int j = 0; j < 4; ++j)
#pragma unroll
        for (int i = 0; i < 12; ++i) cw[j][i] = C.in[I_GCW][((size_t)l * 4 + j) * 768 + i * 64 + lane];
    const int tb = p0 + C.wave * 8;
    auto ldrow = [&](int p, float (&dst)[12]) {
        if (p >= 0 && p < Lp) { const size_t ro = (size_t)rowof(p) * PLD + OFF_D;
#pragma unroll
            for (int i = 0; i < 12; ++i) dst[i] = bf2f(P[ro + i * 64 + lane]); }
        else {
#pragma unroll
            for (int i = 0; i < 12; ++i) dst[i] = 0.f; }
    };
    ldrow(tb - 2, x[0]); ldrow(tb - 1, x[1]); ldrow(tb, x[2]);
#pragma unroll 1
    for (int t = 0; t < 8; ++t) {
        ldrow(tb + t + 1, x[3]);
        const size_t ro = (size_t)rowof(tb + t) * 768;
#pragma unroll
        for (int i = 0; i < 12; ++i) {
            float v = siluf_(cw[0][i] * x[0][i] + cw[1][i] * x[1][i] + cw[2][i] * x[2][i] + cw[3][i] * x[3][i]);
            if (i < 8) { const float ss = wave_sum(v * v); v *= (1.0f / sqrtf(ss + 1e-6f)) * (i < 4 ? 0.125f : 1.0f); }
            gq[ro + i * 64 + lane] = (bf16)f2bf(v);
        }
#pragma unroll
        for (int i = 0; i < 12; ++i) { x[0][i] = x[1][i]; x[1][i] = x[2][i]; x[2][i] = x[3][i]; }
    }
}
__device__ __forceinline__ void gdn_scan_v0(const Ctx& C, int l, int idx) {
    const int d = idx >> 5, b = (idx >> 2) & 7, h = idx & 3, lane = C.lane, w = C.wave;
    LAS float* PA = (LAS float*)C.lds;
    LAS float* PB = PA + 2 * 8 * 64;
    const bf16* P = WSP(const bf16, WS_P); const bf16* gq = WSP(const bf16, WS_GQ); bf16* outd = WSP(bf16, WS_OUTD) + (size_t)d * T_ALL * 256;
    const float aexp = __expf(C.in[I_GALOG][(l * 2 + d) * NH + h]), dtb = C.in[I_GDTB][(l * 2 + d) * NH + h];
    float S[8];
#pragma unroll
    for (int k = 0; k < 8; ++k) S[k] = 0.f;
    int row = seqrow_cm(0, d, b), prow = row;
    size_t rq = (size_t)row * 768, ro = (size_t)row * PLD + OFF_D + 1024;
    v4u q8 = *(const v4u*)(gq + rq + h * 64 + 8 * w), k8 = *(const v4u*)(gq + rq + 256 + h * 64 + 8 * w);
    unsigned short vraw = gq[rq + 512 + h * 64 + lane], garaw = P[ro + d * 4 + h], gbraw = P[ro + 8 + d * 4 + h];
    for (int i = 0; i < NSTEP; ++i) {
        const int crow = row; const v4u cq = q8, ck = k8; const float vv = bf2f(vraw), ga = bf2f(garaw), gb = bf2f(gbraw);
        if (i + 1 < NSTEP) {
            row = seqrow_cm(i + 1, d, b); rq = (size_t)row * 768; ro = (size_t)row * PLD + OFF_D + 1024;
            q8 = *(const v4u*)(gq + rq + h * 64 + 8 * w); k8 = *(const v4u*)(gq + rq + 256 + h * 64 + 8 * w);
            vraw = gq[rq + 512 + h * 64 + lane]; garaw = P[ro + d * 4 + h]; gbraw = P[ro + 8 + d * 4 + h];
        }
        const float alpha = __expf(-aexp * softplusf_(ga + dtb)), beta = sigmoidf_(gb);
        const float qf[8] = {bflo(cq.x), bfhi(cq.x), bflo(cq.y), bfhi(cq.y), bflo(cq.z), bfhi(cq.z), bflo(cq.w), bfhi(cq.w)};
        const float kf[8] = {bflo(ck.x), bfhi(ck.x), bflo(ck.y), bfhi(ck.y), bflo(ck.z), bfhi(ck.z), bflo(ck.w), bfhi(ck.w)};
        float ks = 0.f;
#pragma unroll
        for (int k = 0; k < 8; ++k) ks += kf[k] * S[k];
        const int pb_ = i & 1;
        PA[(pb_ * 8 + w) * 64 + lane] = ks;
        __syncthreads();
        if (w == 0 && i > 0) {
            float os = 0.f;
#pragma unroll
            for (int ww = 0; ww < 8; ++ww) os += PB[((pb_ ^ 1) * 8 + ww) * 64 + lane];
            outd[(size_t)prow * 256 + h * 64 + lane] = (bf16)f2bf(os);
        }
        float kS = 0.f;
#pragma unroll
        for (int ww = 0; ww < 8; ++ww) kS += PA[(pb_ * 8 + ww) * 64 + lane];
        const float coef = beta * (vv - alpha * kS);
        float o = 0.f;
#pragma unroll
        for (int k = 0; k < 8; ++k) { S[k] = alpha * S[k] + kf[k] * coef; o += qf[k] * S[k]; }
        PB[(pb_ * 8 + w) * 64 + lane] = o;
        prow = crow;
    }
    __syncthreads();
    if (w == 0) {
        float os = 0.f;
#pragma unroll
        for (int ww = 0; ww < 8; ++ww) os += PB[(((NSTEP - 1) & 1) * 8 + ww) * 64 + lane];
        outd[(size_t)prow * 256 + h * 64 + lane] = (bf16)f2bf(os);
    }
    __syncthreads();
}

__device__ __forceinline__ void finish_rows(const Ctx& C, int l, int nrows) {
    const bf16* P = WSP(const bf16, WS_P); bf16* yc = WSP(bf16, WS_HB);
    const bf16* ob = WSP(const bf16, WS_OUTB); const bf16* oc = WSP(const bf16, WS_OUTC); const bf16* od = WSP(const bf16, WS_OUTD);
    const bf16* gg = WSP(const bf16, WS_G); const float* bonus = WSP(const float, WS_BONUS);
    const float* mu = C.in[I_RMU] + (size_t)l * 2 * B_COLS;
    const int gw = C.wg * NWAVES + C.wave, NGW = C.G * NWAVES, lane = C.lane;
    for (int m = gw; m < nrows; m += NGW) {
        const bool isctx = m >= T_LAT; const int Lp = isctx ? CTXL : SEQ; const int p = isctx ? ((m - T_LAT) & (CTXL - 1)) : (m & (SEQ - 1)); const int row0 = m - p;
        const size_t o2 = (size_t)T_ALL * 256;
#pragma unroll
        for (int hh = 0; hh < 4; ++hh) {
            const int ch = hh * 64 + lane;
            {
                const float y = bf2f(ob[(size_t)m * 256 + ch]) + bf2f(ob[o2 + (size_t)m * 256 + ch]);
                const float mean = wave_sum(y) * (1.0f / 64.0f); const float dl = y - mean; const float var = wave_sum(dl * dl) * (1.0f / 64.0f);
                const float yn = dl * (1.0f / sqrtf(var + 64e-5f)) * C.in[I_RLNG][l * GW + ch] + C.in[I_RLNB][l * GW + ch];
                const float vs = rw_shift(P, row0, p, Lp, 512 + ch, mu[512 + ch], mu[B_COLS + 512 + ch]);
                yc[(size_t)m * 1024 + 256 + ch] = (bf16)f2bf((yn + bonus[(size_t)m * 4 + hh] * vs) * bf2f(gg[(size_t)m * 256 + ch]));
            }
            {
                const float y = bf2f(oc[(size_t)m * 256 + ch]) + bf2f(oc[o2 + (size_t)m * 256 + ch]);
                const float ms = wave_sum(y * y) * (1.0f / 64.0f);
                const float og = bf2f(P[(size_t)m * PLD + OFF_C + 768 + ch]);
                yc[(size_t)m * 1024 + 512 + ch] = (bf16)f2bf(y * (1.0f / sqrtf(ms + 1e-6f)) * C.in[I_MNG][l * GW + ch] * sigmoidf_(og));
            }
            {
                const float y = bf2f(od[(size_t)m * 256 + ch]) + bf2f(od[o2 + (size_t)m * 256 + ch]);
                const float ms = wave_sum(y * y) * (1.0f / 64.0f);
                const float g = bf2f(P[(size_t)m * PLD + OFF_D + 768 + ch]);
                yc[(size_t)m * 1024 + 768 + ch] = (bf16)f2bf(y * (1.0f / sqrtf(ms + 1e-6f)) * C.in[I_GNG][l * GW + ch] * siluf_(g));
            }
        }
    }
}
__device__ __forceinline__ void moe_scatter(const Ctx& C, int moe_li, int nrows) {
    const unsigned* gc = WSP(const unsigned, WS_CTL) + CW_MOECNT + 64 * moe_li;
    LAS int* pst = (LAS int*)C.lds;
    {
        int pe[8]; int acc = 0;
#pragma unroll
        for (int e = 0; e < NE; ++e) { const int blks = ((int)gc[e] + 255) >> 8; if (C.tid == e) pst[e] = acc * 256; acc += blks; pe[e] = acc; }
        if (C.wg == 0 && C.tid < MOE_MAXBLK) { int be = 0;
#pragma unroll
            for (int e = 0; e < NE; ++e) be += (pe[e] <= C.tid) ? 1 : 0;
            int* tab = WSP(int, WS_TAB); tab[1 + C.tid] = be < NE ? be : NE - 1; if (C.tid == 0) tab[0] = acc; }
    }
    __syncthreads();
    const unsigned* route = WSP(const unsigned, WS_ROUTE); const unsigned* wgbase = WSP(const unsigned, WS_WGBASE);
    const bf16* hb = WSP(const bf16, WS_HB); bf16* am = WSP(bf16, WS_MIX); int* pos = WSP(int, WS_POS);
    const int gw = C.wg * NWAVES + C.wave, NGW = C.G * NWAVES;
    for (int m = gw; m < nrows; m += NGW) {
        const v4u a = *(const v4u*)(route + (size_t)m * 8);
        const int e0 = (int)a.x, e1 = (int)a.y;
        const int p0 = pst[e0] + (int)wgbase[C.wg * 8 + e0] + (int)a.z, p1 = pst[e1] + (int)wgbase[C.wg * 8 + e1] + (int)a.w;
        const v4u r0 = *(const v4u*)(hb + (size_t)m * 1024 + C.lane * 8), r1 = *(const v4u*)(hb + (size_t)m * 1024 + 512 + C.lane * 8);
        *(v4u*)(am + (size_t)p0 * 1024 + C.lane * 8) = r0; *(v4u*)(am + (size_t)p0 * 1024 + 512 + C.lane * 8) = r1;
        *(v4u*)(am + (size_t)p1 * 1024 + C.lane * 8) = r0; *(v4u*)(am + (size_t)p1 * 1024 + 512 + C.lane * 8) = r1;
        if (C.lane == 0) { pos[(size_t)m * 2] = p0; pos[(size_t)m * 2 + 1] = p1; }
    }
    __syncthreads();
}
__device__ __forceinline__ void moe_combine(const Ctx& C, int l, int nrows) {
    const unsigned* route = WSP(const unsigned, WS_ROUTE); const int* pos = WSP(const int, WS_POS); const bf16* ym = WSP(const bf16, WS_MIX);
    const float* modv = WSP(const float, WS_MODV) + (size_t)l * 9 * 6144 + 5 * 1024;
    float* xc = WSP(float, WS_XC);
    const int gw = C.wg * NWAVES + C.wave, NGW = C.G * NWAVES;
    for (int m = gw; m < nrows; m += NGW) {
        const bool isctx = m >= T_LAT;
        float* xr = isctx ? xc + (size_t)(m - T_LAT) * 1024 : C.out + (size_t)m * 1024;
        const float* gv = modv + (size_t)(isctx ? 8 : (m >> 12)) * 6144;
        const int p0 = pos[(size_t)m * 2], p1 = pos[(size_t)m * 2 + 1];
        const float w0 = __builtin_bit_cast(float, route[(size_t)m * 8 + 4]), w1 = __builtin_bit_cast(float, route[(size_t)m * 8 + 5]);
#pragma unroll
        for (int j = 0; j < 4; ++j) {
            const int col = 4 * C.lane + 256 * j;
            const v2u a = *(const v2u*)(ym + (size_t)p0 * 1024 + col), b = *(const v2u*)(ym + (size_t)p1 * 1024 + col);
            const f32x4 ya = (f32x4){bflo(a.x), bfhi(a.x), bflo(a.y), bfhi(a.y)}, yb = (f32x4){bflo(b.x), bfhi(b.x), bflo(b.y), bfhi(b.y)};
            const f32x4 g = *(const f32x4*)(gv + col); f32x4 x = *(const f32x4*)(xr + col);
            x = x + g * (ya * w0 + yb * w1);
            *(f32x4*)(xr + col) = x;
        }
    }
}
__device__ __forceinline__ void final_norm(const Ctx& C) {
    const int gw = C.wg * NWAVES + C.wave, NGW = C.G * NWAVES;
    f32x4 gv[4];
#pragma unroll
    for (int j = 0; j < 4; ++j) gv[j] = *(const f32x4*)(C.in[I_FNG] + 4 * C.lane + 256 * j);
    for (int m = gw; m < T_LAT; m += NGW) {
        float* xr = C.out + (size_t)m * 1024;
        f32x4 v[4]; float s = 0.f;
#pragma unroll
        for (int j = 0; j < 4; ++j) { v[j] = *(const f32x4*)(xr + 4 * C.lane + 256 * j); s += (v[j].x * v[j].x + v[j].y * v[j].y) + (v[j].z * v[j].z + v[j].w * v[j].w); }
        const float rs = 1.0f / sqrtf(wave_sum(s) * (1.0f / 1024.0f) + 1e-6f);
#pragma unroll
        for (int j = 0; j < 4; ++j) *(f32x4*)(xr + 4 * C.lane + 256 * j) = v[j] * rs * gv[j];
    }
}

constexpr int NPH_L = 11, PH_FINAL = 1 + DEPTH * NPH_L, NPHASE = PH_FINAL + 1;
__host__ __device__ inline bool phase_exists(int ph) {
    if (ph == 0 || ph == PH_FINAL) return true;
    const int l = (ph - 1) / NPH_L, k = (ph - 1) % NPH_L;
    if (!(l & 1) && k >= 9) return false;
    return true;
}

__global__ void __launch_bounds__(NTHR, 2) fwd_kernel(Args args) {
    extern __shared__ __attribute__((aligned(16))) unsigned char lds_raw[];
    Ctx C; C.in = args.in; C.out = args.out; C.ws = args.ws; C.lds = (LAS unsigned char*)lds_raw;
    C.tid = threadIdx.x; C.lane = C.tid & 63; C.wave = __builtin_amdgcn_readfirstlane(C.tid >> 6); C.G = gridDim.x; C.wg = blockIdx.x;
    volatile LAS unsigned* MISC = (volatile LAS unsigned*)(C.lds + MISC_OFF);
    if (C.tid < 64) MISC[C.tid] = 0u;
    __syncthreads();
    const int lo = args.ph_lo, hi = args.ph_hi;
    const bool multi = (hi - lo) > 1;
    if (multi) (void)xcd_barrier_post(WSP(unsigned, WS_CTL) + CW_BAR, MISC + 8);
#ifndef PH_MASK
#define PH_MASK 0xFFFFF
#endif
#define PM(k) ((PH_MASK >> (k)) & 1)
#ifndef SK_MASK
#define SK_MASK 0xFFFF
#endif
#define SK(k) ((SK_MASK >> (k)) & 1)
#define IN(k) (lo <= (k) && (k) < hi)
#define SEAM(k) do { if (IN((k) + 1)) { XcdBarrier b2_; b2_.bar = WSP(unsigned, WS_CTL) + CW_BAR; b2_.x = xb_xcc_id(); b2_.st = (volatile LAS unsigned*)(C.lds + MISC_OFF) + 8; xcd_barrier(b2_); } } while (0)
#define FRESH() do { int t_ = threadIdx.x; asm volatile("" : "+v"(t_)); C.tid = t_; C.lane = t_ & 63; C.wave = __builtin_amdgcn_readfirstlane(t_ >> 6); } while (0)

    if (PM(13) && IN(0)) { phase_pre(C); SEAM(0); }

#pragma unroll 1
    for (int l = 0; l < DEPTH; ++l) {
        const int pb = 1 + l * NPH_L;
        if (hi <= pb || lo >= pb + NPH_L) continue;
        const bool last = (l == DEPTH - 1), moe = (l & 1);
        const int nrows = last ? T_LAT : T_ALL;
        const float* xlat = (l == 0) ? C.in[I_X] : C.out; const float* xctx = (l == 0) ? C.in[I_CTX] : WSP(const float, WS_XC);
        const float* modv = WSP(const float, WS_MODV) + (size_t)l * 9 * 6144;

        if (PM(0) && IN(pb + 0)) { FRESH();
            convert_layer(C, l);
            __syncthreads();
            FRESH(); norm_rows<false>(C, l, xlat, xctx, C.in[I_NMIXG] + l * 1024, 0, 1024, T_ALL, 0);
            SEAM(pb + 0);
        }
        if (PM(1) && IN(pb + 1)) { FRESH();
            pg8::Gemm g{WSP(const bf16, WS_HB), WSP(const bf16, WS_WIN), T_ALL, PLD, 1024, 0};
            pg8::StaticOrder S; S.init(T_ALL, PLD, C.G, C.wg);
            pg8::EpiBf16<0> E{WSP(bf16, WS_P), PLD, nullptr, 0, 0};
            pg8::gemm_phase<pg8::EpiBf16<0>, pg8::StaticOrder, false>(C.lds, g, S, E, nullptr);
            SEAM(pb + 1);
        }
        if (PM(2) && IN(pb + 2)) { FRESH();
            FRESH(); if (SK(0)) for (int u = C.wg; u < NB * NCH; u += C.G) lru_chunk<false>(C, l, u / NCH, u % NCH);
            FRESH(); if (SK(1)) for (int u = C.wg; u < NB * NCH; u += C.G) rwkv_prep(C, l, u / NCH, u % NCH);
            FRESH(); if (SK(2)) for (int u = C.wg; u < NB * NCH; u += C.G) gdn_prep(C, l, u / NCH, u % NCH);
            SEAM(pb + 2);
        }
        if (PM(3) && IN(pb + 3)) { FRESH();
            if (SK(3) && C.wg < 128) { FRESH(); rwkv_scan(C, l, C.wg); }
            else if (SK(4) && C.wg < 192) { FRESH(); mlstm_scan_v0(C, l, C.wg - 128); }
            else if (SK(5)) { FRESH(); gdn_scan_v0(C, l, C.wg - 192); }
            if (SK(6) && C.wg >= 248) lru_carry(C, (C.wg - 248) * NTHR + C.tid);
            SEAM(pb + 3);
        }
        if (PM(4) && IN(pb + 4)) { FRESH();
            for (int u = C.wg; u < NB * NCH; u += C.G) { const int b = u / NCH, c = u % NCH; if (last && c < 4) continue; if (SK(7)) lru_chunk<true>(C, l, b, c); }
            FRESH(); if (SK(8)) finish_rows(C, l, nrows);
            SEAM(pb + 4);
        }
        if (PM(5) && IN(pb + 5)) { FRESH();
            pg8::Gemm g{WSP(const bf16, WS_HB), WSP(const bf16, WS_WOUT), nrows, 1024, 1024, 0};
            pg8::StaticOrder S; S.init(nrows, 1024, C.G, C.wg);
            pg8::EpiRes E{xlat, xctx, C.out, WSP(float, WS_XC), modv + 2 * 1024};
            pg8::gemm_phase<pg8::EpiRes, pg8::StaticOrder, false>(C.lds, g, S, E, nullptr);
            SEAM(pb + 5);
        }
        if (PM(6) && IN(pb + 6)) { FRESH();
            if (moe) norm_rows<true>(C, l, C.out, WSP(const float, WS_XC), C.in[I_NFFNG] + l * 1024, 3 * 1024, 4 * 1024, nrows, l >> 1);
            else norm_rows<false>(C, l, C.out, WSP(const float, WS_XC), C.in[I_NFFNG] + l * 1024, 3 * 1024, 4 * 1024, nrows, 0);
            SEAM(pb + 6);
        }
        if (!moe) {
            if (PM(11) && IN(pb + 7)) { FRESH();
                pg8::Gemm g{WSP(const bf16, WS_HB), WSP(const bf16, WS_WGU), nrows, 2 * DFF, 1024, 0};
                pg8::StaticOrder S; S.init(nrows, 2 * DFF, C.G, C.wg);
                pg8::EpiSwiglu E{WSP(bf16, WS_P), DFF};
                pg8::gemm_phase<pg8::EpiSwiglu, pg8::StaticOrder, false>(C.lds, g, S, E, nullptr);
                SEAM(pb + 7);
            }
            if (PM(12) && IN(pb + 8)) { FRESH();
                pg8::Gemm g{WSP(const bf16, WS_P), WSP(const bf16, WS_WDN), nrows, 1024, DFF, 0};
                pg8::StaticOrder S; S.init(nrows, 1024, C.G, C.wg);
                pg8::EpiRes E{C.out, WSP(const float, WS_XC), C.out, WSP(float, WS_XC), modv + 5 * 1024};
                pg8::gemm_phase<pg8::EpiRes, pg8::StaticOrder, false>(C.lds, g, S, E, nullptr);
                SEAM(pb + 10);
            }
        } else {
            if (PM(7) && IN(pb + 7)) { FRESH(); moe_scatter(C, l >> 1, nrows); SEAM(pb + 7); }
            if (PM(8) && IN(pb + 8)) { FRESH();
                pg8::Gemm g{WSP(const bf16, WS_MIX), WSP(const bf16, WS_WGU), 0, 2 * DFE, 1024, (size_t)2 * DFE * 1024};
                pg8::MoeOrder S; S.init(WSP(const int, WS_TAB), (2 * DFE) / 256, C.G, C.wg);
                pg8::EpiSwiglu E{WSP(bf16, WS_P), DFE};
                pg8::gemm_phase<pg8::EpiSwiglu, pg8::MoeOrder, false>(C.lds, g, S, E, nullptr);
                SEAM(pb + 8);
            }
            if (PM(9) && IN(pb + 9)) { FRESH();
                pg8::Gemm g{WSP(const bf16, WS_P), WSP(const bf16, WS_WDN), 0, 1024, DFE, (size_t)1024 * DFE};
                pg8::MoeOrder S; S.init(WSP(const int, WS_TAB), 4, C.G, C.wg);
                pg8::EpiBf16<0> E{WSP(bf16, WS_MIX), 1024, nullptr, 0, 0};
                pg8::gemm_phase<pg8::EpiBf16<0>, pg8::MoeOrder, false>(C.lds, g, S, E, nullptr);
                SEAM(pb + 9);
            }
            if (PM(10) && IN(pb + 10)) { FRESH(); moe_combine(C, l, nrows); SEAM(pb + 10); }
        }
    }
    if (PM(14) && IN(PH_FINAL)) final_norm(C);
}

extern "C" void kernel_launch(void* const* d_in, const int* in_sizes, int n_in, void* d_out, int out_size, void* d_ws, size_t ws_size, hipStream_t stream) {
    static int grid = 0;
    if (grid == 0) {
        if (n_in != N_IN || in_sizes[0] != T_LAT * DM || out_size != T_LAT * DM || ws_size < WS_END) {
            fprintf(stderr, "kernel_launch: unexpected problem (n_in %d, in0 %d, out %d, ws %zu < %zu)\n", n_in, n_in > 0 ? in_sizes[0] : -1, out_size, ws_size, (size_t)WS_END); grid = -1; return; }
        int dev = 0, cus = 0, per_cu = 0;
        if (hipGetDevice(&dev) != hipSuccess || hipDeviceGetAttribute(&cus, hipDeviceAttributeMultiprocessorCount, dev) != hipSuccess) { grid = -1; return; }
        if (hipFuncSetAttribute((const void*)fwd_kernel, hipFuncAttributeMaxDynamicSharedMemorySize, LDS_BYTES) != hipSuccess) { fprintf(stderr, "kernel_launch: hipFuncSetAttribute failed\n"); grid = -1; return; }
        if (hipOccupancyMaxActiveBlocksPerMultiprocessor(&per_cu, (const void*)fwd_kernel, NTHR, LDS_BYTES) != hipSuccess || per_cu < 1) { fprintf(stderr, "kernel_launch: occupancy query says %d\n", per_cu); grid = -1; return; }
        grid = cus;
        if (grid != 256) fprintf(stderr, "kernel_launch: note: %d CUs\n", grid);
    }
    if (grid < 0) return;
    if (hipMemsetAsync((char*)d_ws + WS_CTL, 0, CTL_BYTES, stream) != hipSuccess) return;
    Args a{};
    for (int i = 0; i < N_IN; ++i) a.in[i] = (const float*)d_in[i];
    a.out = (float*)d_out; a.ws = (unsigned char*)d_ws;
#if MK_ONE_LAUNCH
    a.ph_lo = 0; a.ph_hi = NPHASE;
    hipLaunchKernelGGL(fwd_kernel, dim3(grid), dim3(NTHR), LDS_BYTES, stream, a);
#else
    for (int ph = 0; ph < NPHASE; ++ph) { if (!phase_exists(ph)) continue; a.ph_lo = ph; a.ph_hi = ph + 1; hipLaunchKernelGGL(fwd_kernel, dim3(grid), dim3(NTHR), LDS_BYTES, stream, a); }
#endif
}
```

```cpp
#define MK_ONE_LAUNCH 1
#include <hip/hip_runtime.h>
#include <cstdio>
#include <cstdint>

#define GAS __attribute__((address_space(1)))
#define LAS __attribute__((address_space(3)))
typedef unsigned short bf16;
typedef unsigned v4u __attribute__((ext_vector_type(4)));
typedef unsigned v2u __attribute__((ext_vector_type(2)));
typedef float f32x4 __attribute__((ext_vector_type(4)));
typedef float f32x2 __attribute__((ext_vector_type(2)));
typedef short bf16x8 __attribute__((ext_vector_type(8)));
#define LDS_WAIT() asm volatile("s_waitcnt lgkmcnt(0)" ::: "memory")
#define VM_WAIT() asm volatile("s_waitcnt vmcnt(0)" ::: "memory")

constexpr int DM = 1024, NB = 8, SEQ = 4096, DEPTH = 4, CTXL = 256, GW = 256, HD = 64, NH = 4;
constexpr int T_LAT = NB * SEQ, T_CTX = NB * CTXL, T_ALL = T_LAT + T_CTX;
constexpr int IN_COLS = 3552, PLD = 3584;
constexpr int OFF_B = 512, OFF_C = 1472, OFF_D = 2512, B_COLS = 960;
constexpr int DFF = 2816, NE = 8, DFE = 1408;
constexpr int NCH = 68;
constexpr int NSTEP = 4352;
constexpr int MOE_MAXBLK = 280;
constexpr int NWAVES = 8, NTHR = 512;

constexpr size_t MiB = 1u << 20;
constexpr size_t WS_CTL = 0, CTL_BYTES = 1 * MiB;
constexpr size_t WS_MODV = 1 * MiB;
constexpr size_t WS_XC = 2 * MiB;
constexpr size_t WS_WIN = 10 * MiB;
constexpr size_t WS_WOUT = 17 * MiB;
constexpr size_t WS_WGU = 19 * MiB;
constexpr size_t WS_WDN = 63 * MiB;
constexpr size_t WS_HB = 85 * MiB;
constexpr size_t WS_P = 153 * MiB;
constexpr size_t WS_MIX = 391 * MiB;
constexpr size_t WS_OUTB = WS_MIX, WS_OUTC = WS_MIX + 34 * MiB, WS_OUTD = WS_MIX + 68 * MiB, WS_GQ = WS_MIX + 102 * MiB, WS_G = WS_MIX + 153 * MiB;
constexpr size_t WS_SMALL = 561 * MiB;
constexpr size_t WS_LSUM = WS_SMALL;
constexpr size_t WS_HIN = WS_SMALL + 3 * MiB;
constexpr size_t WS_ROUTE = WS_SMALL + 5 * MiB;
constexpr size_t WS_POS = WS_SMALL + 7 * MiB;
constexpr size_t WS_BONUS = WS_SMALL + 8 * MiB;
constexpr size_t WS_WGBASE = WS_SMALL + 9 * MiB;
constexpr size_t WS_TAB = WS_WGBASE + 65536;
constexpr size_t WS_END = 571 * MiB;
constexpr int CW_MOECNT = 1024;
constexpr int CW_BAR = 4096;

constexpr int LDS_BYTES = 135168;
constexpr int MISC_OFF = 131072;

__device__ __forceinline__ unsigned f2bf(float f) { unsigned u = __builtin_bit_cast(unsigned, f); return (u + 0x7fffu + ((u >> 16) & 1u)) >> 16; }
__device__ __forceinline__ unsigned pk2(float lo, float hi) { return f2bf(lo) | (f2bf(hi) << 16); }
__device__ __forceinline__ float bf2f(unsigned short v) { return __builtin_bit_cast(float, (unsigned)v << 16); }
__device__ __forceinline__ float bflo(unsigned v) { return __builtin_bit_cast(float, v << 16); }
__device__ __forceinline__ float bfhi(unsigned v) { return __builtin_bit_cast(float, v & 0xffff0000u); }
__device__ __forceinline__ float wave_sum(float v) {
#pragma unroll
    for (int o = 1; o < 64; o <<= 1) v += __shfl_xor(v, o);
    return v;
}
template <int CTRL> __device__ __forceinline__ float dpp_f(float v) { return __builtin_bit_cast(float, __builtin_amdgcn_update_dpp(0, __builtin_bit_cast(int, v), CTRL, 0xF, 0xF, true)); }
__device__ __forceinline__ float row16_sum(float v) {
    v += dpp_f<0xB1>(v);
    v += dpp_f<0x4E>(v);
    v += dpp_f<0x141>(v);
    v += dpp_f<0x140>(v);
    return v;
}
__device__ __forceinline__ float sigmoidf_(float x) { return 1.0f / (1.0f + __expf(-x)); }
__device__ __forceinline__ float softplusf_(float x) { return fmaxf(x, 0.f) + __logf(1.0f + __expf(-fabsf(x))); }
__device__ __forceinline__ float expm1f_(float x) { return x > -0.3f ? x * (1.0f + x * (0.5f + x * (0.16666667f + x * (0.041666668f + x * 0.0083333338f)))) : __expf(x) - 1.0f; }
__device__ __forceinline__ float siluf_(float x) { return x / (1.0f + __expf(-x)); }
__device__ __forceinline__ float tanhf_(float x) { const float e = __expf(2.0f * x); return 1.0f - 2.0f / (e + 1.0f); }
__device__ __forceinline__ float gelu_tanh(float x) { return 0.5f * x * (1.0f + tanhf_(0.7978845608028654f * (x + 0.044715f * x * x * x))); }
#define XB_TMO      128
#define XB_XCNT(j)  (256  + 64 * (j))
#define XB_XSUB(j)  (1280 + 64 * (j))
#define XB_XGEN(j)  (2304 + 64 * (j))
#define XB_TOP      3328
#define XB_TOPGEN   3392
#define XCD_BAR_WORDS 3456
#define XB_SPIN_CAP (1u << 22)

__device__ __forceinline__ unsigned xb_ld(unsigned* p)              { return __hip_atomic_load(p, __ATOMIC_RELAXED, __HIP_MEMORY_SCOPE_AGENT); }
__device__ __forceinline__ unsigned xb_add(unsigned* p, unsigned v) { return __hip_atomic_fetch_add(p, v, __ATOMIC_RELAXED, __HIP_MEMORY_SCOPE_AGENT); }
__device__ __forceinline__ unsigned xb_xcc_id() { return (unsigned)__builtin_amdgcn_s_getreg((3 << 11) | 20) & 0xFu; }
#define XB_SPIN(cond, bar) do { unsigned _sp = 0; while (cond) { __builtin_amdgcn_s_sleep(1); \
    if ((++_sp & 255u) == 0u) { if (xb_ld(&(bar)[XB_TMO])) break; if (_sp > XB_SPIN_CAP) { atomicAdd(&(bar)[XB_TMO], 1u); break; } } } } while (0)

struct XcdBarrier {
    unsigned* bar; unsigned x;
    volatile LAS unsigned* st;
};

__device__ __forceinline__ XcdBarrier xcd_barrier_post(unsigned* bar, volatile LAS unsigned* st) {
    XcdBarrier b; b.bar = bar; b.x = xb_xcc_id(); b.st = st;
    if (threadIdx.x == 0) (void)xb_add(&bar[XB_XCNT(b.x)], 1u);
    return b;
}
__device__ __forceinline__ void xcd_barrier_complete(unsigned* bar, unsigned x, unsigned& nloc, unsigned& nx) {
    const unsigned G = gridDim.x * gridDim.y * gridDim.z;
    unsigned sum, cnt, mine, sp = 0u;
    for (;;) {
        sum = 0u; cnt = 0u; mine = 0u;
#pragma unroll
        for (unsigned j = 0; j < 16; ++j) { const unsigned c = xb_ld(&bar[XB_XCNT(j)]); sum += c; cnt += (c > 0u) ? 1u : 0u; mine = (j == x) ? c : mine; }
        if (sum == G) break;
        __builtin_amdgcn_s_sleep(1);
        if ((++sp & 255u) == 0u) { if (xb_ld(&bar[XB_TMO])) break; if (sp > XB_SPIN_CAP) { atomicAdd(&bar[XB_TMO], 1u); break; } }
    }
    nloc = mine > 0u ? mine : 1u; nx = cnt > 0u ? cnt : 1u;
}

__device__ __forceinline__ void xcd_barrier(const XcdBarrier& b) {
    asm volatile("s_waitcnt vmcnt(0)" ::: "memory");
    __syncthreads();
    if (threadIdx.x == 0) {
        unsigned* bar = b.bar;
        __builtin_amdgcn_s_waitcnt(0);
        unsigned nloc = b.st[0], nx = b.st[1];
        if (nloc == 0u) { xcd_barrier_complete(bar, b.x, nloc, nx); b.st[0] = nloc; b.st[1] = nx; }
        const unsigned old = xb_add(&bar[XB_XSUB(b.x)], 1u);
        const unsigned gen = old / nloc;
        if (old + 1u == (gen + 1u) * nloc) {
            __builtin_amdgcn_fence(__ATOMIC_RELEASE, "agent");
            asm volatile("s_waitcnt vmcnt(0)" ::: "memory");
            const unsigned og = xb_add(&bar[XB_TOP], 1u);
            const unsigned tg = og / nx;
            if (og + 1u == (tg + 1u) * nx) xb_add(&bar[XB_TOPGEN], 1u);
            else XB_SPIN(xb_ld(&bar[XB_TOPGEN]) == tg, bar);
            __builtin_amdgcn_fence(__ATOMIC_ACQUIRE, "agent");
            xb_add(&bar[XB_XGEN(b.x)], 1u);
            asm volatile("s_waitcnt vmcnt(0)" ::: "memory");
        } else {
            XB_SPIN(xb_ld(&bar[XB_XGEN(b.x)]) == gen, bar);
            __builtin_amdgcn_fence(__ATOMIC_ACQUIRE, "agent");
            asm volatile("s_waitcnt vmcnt(0)" ::: "memory");
        }
    }
    __syncthreads();
}

namespace pg8 {
#define PG8_LAS __attribute__((address_space(3)))
typedef unsigned short bf16_t;
typedef short bf16x8 __attribute__((ext_vector_type(8)));
typedef float f32x4 __attribute__((ext_vector_type(4)));
typedef unsigned u32x4 __attribute__((ext_vector_type(4)));
constexpr int BM = 256, BK = 64, HALF = 128, HTB = HALF * BK * 2  , STAGE_BYTES = 8 * HTB, NXCD = 8, WGM = 8;

__host__ __device__ __forceinline__ int lds_byte(int r, int c) { const int st = (r >> 4) * 2 + (c >> 5), rr = r & 15, cc = c & 31, ob = rr * 64 + cc * 2; return st * 1024 + (ob ^ (((ob >> 9) & 1) << 5)); }
__host__ __device__ __forceinline__ void stage_rc(int b, int& R, int& C) { const int st = b / 1024, sb = b % 1024, swz = sb ^ (((sb >> 9) & 1) << 5); R = (st >> 1) * 16 + swz / 64; C = (st & 1) * 32 + (swz % 64) / 2; }
__host__ __device__ __forceinline__ int perm32(int rho) { const int n = rho >> 4, i = rho & 15; return 8 * (i >> 2) + 4 * n + (i & 3); }

struct Unit { int pm, pn, e; };
struct Gemm { const bf16_t* A; const bf16_t* Bt; int M, N, K; size_t estride; };

struct StaticOrder {
    int nM, nN, nwg, G, c;
    __host__ __device__ void init(int M, int N, int G_, int c_) { nM = M / BM; nN = N / BM; nwg = nM * nN; G = G_; c = c_; }
    __host__ __device__ bool next(int i, Unit& u) const {
        const long L = (long)i * G + c; if (L >= nwg) return false;
        int wgid = (int)L; { const int q = nwg / NXCD, r = nwg % NXCD, xcd = wgid % NXCD, off = wgid / NXCD; wgid = (xcd < r ? xcd * (q + 1) : r * (q + 1) + (xcd - r) * q) + off; }
        const int nig = WGM * nN, gid = wgid / nig, fm = gid * WGM, gsz = (nM - fm) < WGM ? (nM - fm) : WGM;
        u.pm = fm + ((wgid % nig) % gsz); u.pn = (wgid % nig) / gsz; u.e = 0; return true;
    }
    __device__ __forceinline__ void a_ready(const Unit&) const {}
    __device__ __forceinline__ void done(const Unit&) const {}
};
__device__ __forceinline__ unsigned cvt_pk_bf16(float lo, float hi) { unsigned r; asm volatile("v_cvt_pk_bf16_f32 %0, %1, %2" : "=v"(r) : "v"(lo), "v"(hi)); return r; }
typedef float f32x2 __attribute__((ext_vector_type(2)));
__device__ __forceinline__ f32x2 gelu_pk(f32x2 v) {
    const f32x2 av = __builtin_elementwise_abs(v), d = av * 0.2316418882f + 1.0f;
    f32x2 t; t.x = __builtin_amdgcn_rcpf(d.x); t.y = __builtin_amdgcn_rcpf(d.y);
    f32x2 q = t * 0.5307027145f + (-0.7265760135f); q = q * t + 0.7107068705f; q = q * t + (-0.142248368f); q = q * t + 0.127414796f; q = q * t;
    const f32x2 s = (v * v) * (-0.72134752044f);
    f32x2 e; e.x = __builtin_amdgcn_exp2f(s.x); e.y = __builtin_amdgcn_exp2f(s.y);
    const f32x2 m = v * (q * e), r = v - m;
    f32x2 o; o.x = v.x < 0.f ? m.x : r.x; o.y = v.y < 0.f ? m.y : r.y; return o;
}

struct EpiF32 {
    static constexpr bool PERM = false, AFTER_DRAIN = false;
    float* C; int ldc; const float* bias;
    __device__ __forceinline__ void operator()(const f32x4 (&acc)[2][2][4][2], const Unit& u, int wr, int wc, int fr, int fq) const {
        const int row0 = u.pm * BM + wr * 64 + fr, col0 = u.pn * BM + wc * 32 + 4 * fq;
        f32x4 bv[2][2];
#pragma unroll
        for (int bj = 0; bj < 2; ++bj)
#pragma unroll
            for (int n = 0; n < 2; ++n) bv[bj][n] = bias ? *(const f32x4*)(bias + col0 + bj * HALF + n * 16) : (f32x4){0.f, 0.f, 0.f, 0.f};
#pragma unroll
        for (int ai = 0; ai < 2; ++ai)
#pragma unroll
            for (int m = 0; m < 4; ++m) { float* rowp = C + (size_t)(row0 + ai * HALF + m * 16) * ldc + col0;
#pragma unroll
                for (int bj = 0; bj < 2; ++bj)
#pragma unroll
                    for (int n = 0; n < 2; ++n) *(f32x4*)(rowp + bj * HALF + n * 16) = acc[ai][bj][m][n] + bv[bj][n]; }
    }
};
template <int ACT  > struct EpiBf16 {
    static constexpr bool PERM = true, AFTER_DRAIN = false;
    bf16_t* O; int ldc; const float* bias; int split_cols; size_t split_stride;
    __device__ __forceinline__ void operator()(const f32x4 (&acc)[2][2][4][2], const Unit& u, int wr, int wc, int fr, int fq) const {
        const int row0 = u.pm * BM + wr * 64 + fr; int colt = u.pn * BM; bf16_t* base = O;
        if (split_cols) { const int t = colt / split_cols; base += (size_t)t * split_stride; colt -= t * split_cols; }
        const int col0 = colt + wc * 32 + 8 * fq, bcol0 = u.pn * BM + wc * 32 + 8 * fq;
        f32x4 bv[2][2];
#pragma unroll
        for (int bj = 0; bj < 2; ++bj)
#pragma unroll
            for (int n = 0; n < 2; ++n) bv[bj][n] = bias ? *(const f32x4*)(bias + bcol0 + bj * HALF + 4 * n) : (f32x4){0.f, 0.f, 0.f, 0.f};
#pragma unroll
        for (int ai = 0; ai < 2; ++ai)
#pragma unroll
            for (int m = 0; m < 4; ++m) { bf16_t* rowp = base + (size_t)(row0 + ai * HALF + m * 16) * ldc + col0;
#pragma unroll
                for (int bj = 0; bj < 2; ++bj) { f32x4 v0 = acc[ai][bj][m][0] + bv[bj][0], v1 = acc[ai][bj][m][1] + bv[bj][1];
                    if (ACT == 1) { f32x2 a = gelu_pk((f32x2){v0[0], v0[1]}), b = gelu_pk((f32x2){v0[2], v0[3]}), c = gelu_pk((f32x2){v1[0], v1[1]}), d = gelu_pk((f32x2){v1[2], v1[3]});
                        v0 = (f32x4){a.x, a.y, b.x, b.y}; v1 = (f32x4){c.x, c.y, d.x, d.y}; }
                    if (ACT == 2) {
#pragma unroll
                        for (int j = 0; j < 4; ++j) { v0[j] = 0.5f * v0[j] * (1.0f + erff(v0[j] * 0.70710678f)); v1[j] = 0.5f * v1[j] * (1.0f + erff(v1[j] * 0.70710678f)); } }
                    u32x4 w; w.x = cvt_pk_bf16(v0[0], v0[1]); w.y = cvt_pk_bf16(v0[2], v0[3]); w.z = cvt_pk_bf16(v1[0], v1[1]); w.w = cvt_pk_bf16(v1[2], v1[3]);
                    *(u32x4*)(rowp + bj * HALF) = w; } }
    }
};

template <class Epi, class Sched, bool STAMP = false>
__device__ __forceinline__ void gemm_phase(PG8_LAS unsigned char* lds, const Gemm g, const Sched& S, const Epi& E, unsigned long long* stamps) {
    int tid_ = threadIdx.x; asm volatile("" : "+v"(tid_));
    const int tid = tid_, wid = __builtin_amdgcn_readfirstlane(tid >> 6), lane = tid & 63, wr = wid >> 2, wc = wid & 3, fr = lane & 15, fq = lane >> 4;
    const int K = g.K, nt = K / BK;
    int ts_lo = 0, ts_hi = 0, nts = 0; const unsigned long long rt_entry = STAMP ? (unsigned long long)wall_clock64() : 0ull;
#define PG8_STAMP() do { if (STAMP && wid == 0 && nts < 64) { const unsigned long long _c = (unsigned long long)clock64(); \
        ts_lo = (lane == nts) ? (int)(unsigned)_c : ts_lo; ts_hi = (lane == nts) ? (int)(unsigned)(_c >> 32) : ts_hi; ++nts; } } while (0)
    PG8_STAMP();
    unsigned voffA[2], voffB[2];
#pragma unroll
    for (int i = 0; i < 2; ++i) { int R, C; stage_rc(tid * 16 + i * 8192, R, C); const int Rb = Epi::PERM ? ((R & ~31) + perm32(R & 31)) : R;
        voffA[i] = (unsigned)(R * K + C) * 2u; voffB[i] = (unsigned)(Rb * K + C) * 2u; }
    const size_t kstep = (size_t)(BK * 2);
    const size_t hstep = (size_t)HALF * K * 2;
    const size_t tstep = 2 * hstep;
    const unsigned ldsw = (unsigned)wid * 1024u;
    const int aoff = lds_byte(wr * 64 + fr, fq * 8), boff = lds_byte(wc * 32 + fr, fq * 8);
#define PG8_SA(b, h) (((b) * 2 + (h)) * HTB)
#define PG8_SB(b, h) ((4 + (b) * 2 + (h)) * HTB)
#define PG8_STAGE(bufoff, gbase, voff) do { _Pragma("unroll") for (int _i = 0; _i < 2; ++_i) \
        __builtin_amdgcn_global_load_lds((const unsigned*)((const char*)(gbase) + (voff)[_i]), (PG8_LAS unsigned*)(lds + (bufoff) + ldsw + _i * 8192), 16, 0, 0); } while (0)
#define PG8_LDA(dst, b, h) do { _Pragma("unroll") for (int m = 0; m < 4; ++m) _Pragma("unroll") for (int k = 0; k < 2; ++k) dst[m][k] = *(const PG8_LAS bf16x8*)(lds + PG8_SA(b, h) + aoff + m * 2048 + k * 1024); } while (0)
#define PG8_LDB(dst, b, h) do { _Pragma("unroll") for (int n = 0; n < 2; ++n) _Pragma("unroll") for (int k = 0; k < 2; ++k) dst[n][k] = *(const PG8_LAS bf16x8*)(lds + PG8_SB(b, h) + boff + n * 2048 + k * 1024); } while (0)
#define PG8_MMA(ai, bj, At, Bt) do { __builtin_amdgcn_s_setprio(1); _Pragma("unroll") for (int m = 0; m < 4; ++m) _Pragma("unroll") for (int n = 0; n < 2; ++n) _Pragma("unroll") for (int k = 0; k < 2; ++k) \
        acc[ai][bj][m][n] = __builtin_amdgcn_mfma_f32_16x16x32_bf16(Bt[n][k], At[m][k], acc[ai][bj][m][n], 0, 0, 0); __builtin_amdgcn_s_setprio(0); } while (0)
#define PG8_WAIT_V(n) asm volatile("s_waitcnt vmcnt(" #n ")" ::: "memory")
#define PG8_WAIT_L(n) asm volatile("s_waitcnt lgkmcnt(" #n ")" ::: "memory")
#define PG8_BAR __builtin_amdgcn_s_barrier()
#define PG8_SCHED __builtin_amdgcn_sched_barrier(0)
    Unit cur, nxt; int ui = 0;
    if (!S.next(0, cur)) return;
    f32x4 acc[2][2][4][2];
#pragma unroll
    for (int a = 0; a < 2; ++a)
#pragma unroll
        for (int b = 0; b < 2; ++b)
#pragma unroll
            for (int m = 0; m < 4; ++m)
#pragma unroll
                for (int n = 0; n < 2; ++n) acc[a][b][m][n] = (f32x4){0.f, 0.f, 0.f, 0.f};
    bf16x8 At[4][2], B0[2][2], B1[2][2];
    const char* cA = (const char*)g.A + (size_t)cur.pm * tstep; const char* cB = (const char*)g.Bt + (size_t)cur.pn * tstep + (size_t)cur.e * g.estride * 2;
    S.a_ready(cur);
    PG8_STAGE(PG8_SB(0, 0), cB, voffB); PG8_STAGE(PG8_SA(0, 0), cA, voffA); PG8_STAGE(PG8_SB(0, 1), cB + hstep, voffB); PG8_STAGE(PG8_SA(0, 1), cA + hstep, voffA);
    if (wr == 1) PG8_BAR;
    PG8_WAIT_V(4); PG8_BAR;
    PG8_STAGE(PG8_SB(1, 0), cB + kstep, voffB); PG8_STAGE(PG8_SA(1, 0), cA + kstep, voffA); PG8_STAGE(PG8_SB(1, 1), cB + hstep + kstep, voffB);
    PG8_WAIT_V(6); PG8_BAR;
    PG8_STAMP();
    for (;;) {
        const bool has_next = S.next(ui + 1, nxt);
        const char* nA = has_next ? (const char*)g.A + (size_t)nxt.pm * tstep : cA; const char* nB = has_next ? (const char*)g.Bt + (size_t)nxt.pn * tstep + (size_t)nxt.e * g.estride * 2 : cB;
        for (int t = 0; t < nt; t += 2) {
            const bool last = (t == nt - 2);
            const char* a1 = cA + (size_t)(t + 1) * kstep;
            const char* a2 = last ? nA : cA + (size_t)(t + 2) * kstep; const char* b2 = last ? nB : cB + (size_t)(t + 2) * kstep;
            const char* a3 = a2 + kstep; const char* b3 = b2 + kstep;
            if (last && has_next) S.a_ready(nxt);
            PG8_LDB(B0, 0, 0); PG8_SCHED; PG8_LDA(At, 0, 0); PG8_STAGE(PG8_SA(1, 1), a1 + hstep, voffA);
            PG8_WAIT_L(8); PG8_BAR; PG8_WAIT_L(0); PG8_MMA(0, 0, At, B0); PG8_BAR; PG8_SCHED;
            PG8_LDB(B1, 0, 1); PG8_STAGE(PG8_SB(0, 0), b2, voffB);
            PG8_BAR; PG8_WAIT_L(0); PG8_MMA(0, 1, At, B1); PG8_BAR;
            PG8_LDA(At, 0, 1); PG8_STAGE(PG8_SA(0, 0), a2, voffA);
            PG8_BAR; PG8_WAIT_L(0); PG8_MMA(1, 0, At, B0); PG8_BAR; PG8_SCHED;
            PG8_STAGE(PG8_SB(0, 1), b2 + hstep, voffB);
            PG8_WAIT_V(6); PG8_BAR; PG8_MMA(1, 1, At, B1); PG8_BAR;
            PG8_LDB(B0, 1, 0); PG8_SCHED; PG8_LDA(At, 1, 0); PG8_STAGE(PG8_SA(0, 1), a2 + hstep, voffA);
            PG8_WAIT_L(8); PG8_BAR; PG8_WAIT_L(0); PG8_MMA(0, 0, At, B0); PG8_BAR; PG8_SCHED;
            PG8_LDB(B1, 1, 1); PG8_STAGE(PG8_SB(1, 0), b3, voffB);
            PG8_BAR; PG8_WAIT_L(0); PG8_MMA(0, 1, At, B1); PG8_BAR;
            PG8_LDA(At, 1, 1); PG8_STAGE(PG8_SA(1, 0), a3, voffA);
            PG8_BAR; PG8_WAIT_L(0); PG8_MMA(1, 0, At, B0); PG8_BAR; PG8_SCHED;
            PG8_STAGE(PG8_SB(1, 1), b3 + hstep, voffB);
            PG8_WAIT_V(6); PG8_BAR; PG8_MMA(1, 1, At, B1); PG8_BAR;
        }
        PG8_STAMP();
        if constexpr (!Epi::AFTER_DRAIN) { E(acc, cur, wr, wc, fr, fq); S.done(cur); }
        PG8_STAMP();
        if (!has_next) break;
#pragma unroll
        for (int a = 0; a < 2; ++a)
#pragma unroll
            for (int b = 0; b < 2; ++b)
#pragma unroll
                for (int m = 0; m < 4; ++m)
#pragma unroll
                    for (int n = 0; n < 2; ++n) acc[a][b][m][n] = (f32x4){0.f, 0.f, 0.f, 0.f};
        cur = nxt; cA = nA; cB = nB; ++ui;
    }
    PG8_WAIT_V(0);
    if (wr == 0) PG8_BAR;
    PG8_BAR;
    if constexpr (Epi::AFTER_DRAIN) { E.fused(acc, cur, wr, wc, fr, fq, lds, wid, lane); S.done(cur); }
    PG8_STAMP();
    if (STAMP && wid == 0) { stamps[lane] = lane < nts ? (((unsigned long long)(unsigned)ts_hi << 32) | (unsigned)ts_lo) : 0ull;
        if (lane == 62) stamps[62] = rt_entry; if (lane == 63) stamps[63] = (unsigned long long)wall_clock64(); }
#undef PG8_STAMP
#undef PG8_SA
#undef PG8_SB
#undef PG8_STAGE
#undef PG8_LDA
#undef PG8_LDB
#undef PG8_MMA
#undef PG8_WAIT_V
#undef PG8_WAIT_L
#undef PG8_BAR
#undef PG8_SCHED
}
}
namespace pg8 {
struct EpiRes {
    static constexpr bool PERM = false, AFTER_DRAIN = false;
    const float* base_lat; const float* base_ctx; float* out_lat; float* out_ctx; const float* gvec;
    __device__ __forceinline__ void operator()(const f32x4 (&acc)[2][2][4][2], const Unit& u, int wr, int wc, int fr, int fq) const {
        const bool isctx = u.pm >= 128;
        const int prow = (isctx ? (u.pm - 128) : u.pm) * BM;
        const float* base = isctx ? base_ctx : base_lat; float* out = isctx ? out_ctx : out_lat;
        const float* gv = gvec + (size_t)(isctx ? 8 : (u.pm >> 4)) * 6144;
        const int row0 = prow + wr * 64 + fr, col0 = u.pn * BM + wc * 32 + 4 * fq;
        f32x4 gvv[2][2];
#pragma unroll
        for (int bj = 0; bj < 2; ++bj)
#pragma unroll
            for (int n = 0; n < 2; ++n) gvv[bj][n] = *(const f32x4*)(gv + col0 + bj * HALF + n * 16);
#pragma unroll
        for (int ai = 0; ai < 2; ++ai)
#pragma unroll
            for (int m = 0; m < 4; ++m) { const size_t off = (size_t)(row0 + ai * HALF + m * 16) * 1024 + col0;
#pragma unroll
                for (int bj = 0; bj < 2; ++bj)
#pragma unroll
                    for (int n = 0; n < 2; ++n) { const f32x4 b = *(const f32x4*)(base + off + bj * HALF + n * 16);
                        *(f32x4*)(out + off + bj * HALF + n * 16) = b + gvv[bj][n] * acc[ai][bj][m][n]; } }
    }
};
struct EpiSwiglu {
    static constexpr bool PERM = true, AFTER_DRAIN = false;
    bf16_t* O; int ldc;
    __device__ __forceinline__ void operator()(const f32x4 (&acc)[2][2][4][2], const Unit& u, int wr, int wc, int fr, int fq) const {
        const int row0 = u.pm * BM + wr * 64 + fr, col0 = u.pn * HALF + wc * 32 + 8 * fq;
#pragma unroll
        for (int ai = 0; ai < 2; ++ai)
#pragma unroll
            for (int m = 0; m < 4; ++m) { bf16_t* rowp = O + (size_t)(row0 + ai * HALF + m * 16) * ldc + col0;
                float h[8];
#pragma unroll
                for (int n = 0; n < 2; ++n)
#pragma unroll
                    for (int j = 0; j < 4; ++j) { const float g = acc[ai][0][m][n][j], up = acc[ai][1][m][n][j]; h[n * 4 + j] = g * __builtin_amdgcn_rcpf(1.0f + __expf(-g)) * up; }
                u32x4 w; w.x = cvt_pk_bf16(h[0], h[1]); w.y = cvt_pk_bf16(h[2], h[3]); w.z = cvt_pk_bf16(h[4], h[5]); w.w = cvt_pk_bf16(h[6], h[7]);
                *(u32x4*)rowp = w; }
    }
};
struct MoeOrder {
    int nN, G, c, nunits; const int* tab;
    __device__ void init(const int* tab_, int nN_, int G_, int c_) { tab = tab_; nN = nN_; G = G_; c = c_; nunits = tab_[0] * nN_; }
    __device__ bool next(int i, Unit& u) const {
        const int L = i * G + c; if (L >= nunits) return false;
        u.pm = L / nN; u.pn = L - u.pm * nN; u.e = tab[1 + u.pm]; return true;
    }
    __device__ __forceinline__ void a_ready(const Unit&) const {}
    __device__ __forceinline__ void done(const Unit&) const {}
};
}
enum { I_X = 0, I_C, I_CTX, I_CCTX, I_MODW, I_MODB, I_NMIXG, I_NFFNG, I_WIN, I_WOUT, I_LCW, I_LCB, I_LWA, I_LBA, I_LWX, I_LBX, I_LLAM,
       I_RMU, I_RWUP, I_RW0, I_RAUP, I_RA0, I_RGUP, I_RKK, I_RKA, I_RRK, I_RLNG, I_RLNB, I_MIB, I_MFB, I_MNG, I_GCW, I_GALOG, I_GDTB, I_GNG,
       I_FWG, I_FWU, I_FWD, I_MROUTER, I_MWG, I_MWU, I_MWD, I_FNG, N_IN };
struct Args { const float* in[N_IN]; float* out; unsigned char* ws; int ph_lo, ph_hi; };
struct Ctx {
    const float* const* in; float* out; unsigned char* ws; LAS unsigned char* lds;
    int tid, lane, wave, G, wg;
};
#define WSP(T, off) ((T*)(C.ws + (off)))

__device__ __forceinline__ int seqrow_raster(int i, int d, int b) {
    if (i < CTXL) { const int p = d ? (CTXL - 1 - i) : i; return T_LAT + b * CTXL + p; }
    const int j = i - CTXL; const int p = d ? (SEQ - 1 - j) : j; return b * SEQ + p;
}
__device__ __forceinline__ int seqrow_cm(int i, int d, int b) {
    if (i < CTXL) { const int p = d ? (CTXL - 1 - i) : i; return T_LAT + b * CTXL + p; }
    const int j = i - CTXL; const int p = d ? (SEQ - 1 - j) : j; return b * SEQ + (p & 63) * 64 + (p >> 6);
}

__device__ __forceinline__ void phase_pre(const Ctx& C) {
    LAS float* sc = (LAS float*)C.lds;
    LAS float* red = sc + 9 * 1024;
    float* modv = WSP(float, WS_MODV);
    bool filled = false;
    for (int it = C.wg; it < DEPTH * 48; it += C.G) {
        if (!filled) {
            for (int i = C.tid; i < 9 * 1024; i += NTHR) { const float v = i < 8192 ? C.in[I_C][i] : C.in[I_CCTX][i - 8192]; sc[i] = siluf_(v); }
            filled = true; __syncthreads();
        }
        const int l = it / 48, jb = it % 48, col = C.tid & 127, kg = C.tid >> 7;
        const float* W = C.in[I_MODW] + (size_t)l * 1024 * 6144 + jb * 128 + col;
        float acc[9];
#pragma unroll
        for (int r = 0; r < 9; ++r) acc[r] = 0.f;
        for (int k = kg * 256; k < kg * 256 + 256; ++k) { const float w = W[(size_t)k * 6144];
#pragma unroll
            for (int r = 0; r < 9; ++r) acc[r] += sc[r * 1024 + k] * w; }
#pragma unroll
        for (int r = 0; r < 9; ++r) red[(kg * 9 + r) * 128 + col] = acc[r];
        __syncthreads();
        for (int i = C.tid; i < 9 * 128; i += NTHR) { const int r = i >> 7, cc = i & 127;
            const float s = red[(0 * 9 + r) * 128 + cc] + red[(1 * 9 + r) * 128 + cc] + red[(2 * 9 + r) * 128 + cc] + red[(3 * 9 + r) * 128 + cc];
            modv[((size_t)l * 9 + r) * 6144 + jb * 128 + cc] = s + C.in[I_MODB][l * 6144 + jb * 128 + cc]; }
        __syncthreads();
    }
}

__device__ __forceinline__ void tr_item(const float* src, size_t ld, int k0, int ns0, bf16* dst, int drow0, int Kd, LAS float* scr, int lane, bool zero) {
    if (!zero) {
#pragma unroll 8
        for (int i = 0; i < 32; ++i) { const int kk = 2 * i + (lane >> 5); scr[kk * 33 + (lane & 31)] = src[(size_t)(k0 + kk) * ld + ns0 + (lane & 31)]; }
    }
    LDS_WAIT(); asm volatile("" ::: "memory");
    const int c = lane & 7;
#pragma unroll
    for (int j = 0; j < 4; ++j) { const int n = (lane >> 3) + 8 * j; const LAS float* s = scr + (8 * c) * 33 + n;
        v4u o; o.x = pk2(s[0 * 33], s[1 * 33]); o.y = pk2(s[2 * 33], s[3 * 33]); o.z = pk2(s[4 * 33], s[5 * 33]); o.w = pk2(s[6 * 33], s[7 * 33]);
        if (zero) o = (v4u){0u, 0u, 0u, 0u};
        *(v4u*)(dst + (size_t)(drow0 + n) * Kd + k0 + 8 * c) = o; }
    LDS_WAIT(); asm volatile("" ::: "memory");
}
__device__ __forceinline__ void convert_layer(const Ctx& C, int l) {
    LAS float* scr = (LAS float*)(C.lds + C.wave * 8704);
    const int gw = C.wg * NWAVES + C.wave, NGW = C.G * NWAVES;
    constexpr int I_IN = 16 * 112, I_OUT = 16 * 32, I_GU = 16 * 176, I_DN = 44 * 32, I_E = 16 * 88 + 22 * 32;
    const bool moe = l & 1; const int li = l >> 1;
    const int nitems = I_IN + I_OUT + (moe ? NE * I_E : (I_GU + I_DN));
    bf16* win = WSP(bf16, WS_WIN); bf16* wout = WSP(bf16, WS_WOUT); bf16* wgu = WSP(bf16, WS_WGU); bf16* wdn = WSP(bf16, WS_WDN);
    for (int it = gw; it < nitems; it += NGW) {
        int r = it;
        if (r < I_IN) { const int kb = r / 112, nb = r % 112; tr_item(C.in[I_WIN] + (size_t)l * 1024 * IN_COLS, IN_COLS, 64 * kb, 32 * nb, win, 32 * nb, 1024, scr, C.lane, nb == 111); continue; }
        r -= I_IN;
        if (r < I_OUT) { const int kb = r / 32, nb = r % 32; tr_item(C.in[I_WOUT] + (size_t)l * 1024 * 1024, 1024, 64 * kb, 32 * nb, wout, 32 * nb, 1024, scr, C.lane, false); continue; }
        r -= I_OUT;
        if (!moe) {
            if (r < I_GU) { const int kb = r / 176, nb = r % 176, tile = nb >> 3, q = nb & 7;
                const float* src = (q < 4 ? C.in[I_FWG] : C.in[I_FWU]) + (size_t)li * 1024 * DFF;
                tr_item(src, DFF, 64 * kb, tile * 128 + (q & 3) * 32, wgu, 32 * nb, 1024, scr, C.lane, false); continue; }
            r -= I_GU;
            { const int kb = r / 32, nb = r % 32; tr_item(C.in[I_FWD] + (size_t)li * DFF * 1024, 1024, 64 * kb, 32 * nb, wdn, 32 * nb, DFF, scr, C.lane, false); }
        } else {
            const int e = r / I_E; int rr = r % I_E;
            if (rr < 16 * 88) { const int kb = rr / 88, nb = rr % 88, tile = nb >> 3, q = nb & 7;
                const float* src = (q < 4 ? C.in[I_MWG] : C.in[I_MWU]) + ((size_t)li * NE + e) * 1024 * DFE;
                tr_item(src, DFE, 64 * kb, tile * 128 + (q & 3) * 32, wgu + (size_t)e * 2 * DFE * 1024, 32 * nb, 1024, scr, C.lane, false); continue; }
            rr -= 16 * 88;
            { const int kb = rr / 32, nb = rr % 32; tr_item(C.in[I_MWD] + ((size_t)li * NE + e) * DFE * 1024, 1024, 64 * kb, 32 * nb, wdn + (size_t)e * 1024 * DFE, 32 * nb, DFE, scr, C.lane, false); }
        }
    }
}

template <bool ROUTE>
__device__ __forceinline__ void norm_rows(const Ctx& C, int l, const float* xlat, const float* xctx, const float* gain, int shoff, int scoff, int nrows, int moe_li) {
    const float* modv = WSP(float, WS_MODV) + (size_t)l * 9 * 6144;
    bf16* hb = WSP(bf16, WS_HB);
    const int gw = C.wg * NWAVES + C.wave, NGW = C.G * NWAVES;
    LAS unsigned* lcnt = (LAS unsigned*)(C.lds + 65536);
    unsigned* route = WSP(unsigned, WS_ROUTE);
    if (ROUTE) { if (C.tid < 8) lcnt[C.tid] = 0u; __syncthreads(); }
    f32x4 gv[4];
#pragma unroll
    for (int j = 0; j < 4; ++j) gv[j] = *(const f32x4*)(gain + 4 * C.lane + 256 * j);
    for (int m = gw; m < nrows; m += NGW) {
        const bool isctx = m >= T_LAT;
        const float* xr = isctx ? xctx + (size_t)(m - T_LAT) * 1024 : xlat + (size_t)m * 1024;
        const float* mv = modv + (size_t)(isctx ? 8 : (m >> 12)) * 6144;
        f32x4 v[4]; float s = 0.f;
#pragma unroll
        for (int j = 0; j < 4; ++j) { v[j] = *(const f32x4*)(xr + 4 * C.lane + 256 * j); s += (v[j].x * v[j].x + v[j].y * v[j].y) + (v[j].z * v[j].z + v[j].w * v[j].w); }
        const float rs = 1.0f / sqrtf(wave_sum(s) * (1.0f / 1024.0f) + 1e-6f);
#pragma unroll
        for (int j = 0; j < 4; ++j) { const f32x4 sh = *(const f32x4*)(mv + shoff + 4 * C.lane + 256 * j), scl = *(const f32x4*)(mv + scoff + 4 * C.lane + 256 * j);
            v[j] = (v[j] * rs * gv[j]) * (scl + 1.0f) + sh;
            v2u o; o.x = pk2(v[j].x, v[j].y); o.y = pk2(v[j].z, v[j].w);
            *(v2u*)(hb + (size_t)m * 1024 + 4 * C.lane + 256 * j) = o; }
        if (ROUTE) {
            const float* rt = C.in[I_MROUTER] + (size_t)moe_li * 1024 * NE;
            float lg[8];
#pragma unroll
            for (int e = 0; e < 8; ++e) lg[e] = 0.f;
#pragma unroll
            for (int j = 0; j < 4; ++j)
#pragma unroll
                for (int q = 0; q < 4; ++q) { const int k = 4 * C.lane + 256 * j + q; const f32x4 r0 = *(const f32x4*)(rt + (size_t)k * 8), r1 = *(const f32x4*)(rt + (size_t)k * 8 + 4); const float hv = v[j][q];
                    lg[0] += hv * r0.x; lg[1] += hv * r0.y; lg[2] += hv * r0.z; lg[3] += hv * r0.w; lg[4] += hv * r1.x; lg[5] += hv * r1.y; lg[6] += hv * r1.z; lg[7] += hv * r1.w; }
#pragma unroll
            for (int e = 0; e < 8; ++e) lg[e] = wave_sum(lg[e]);
            int e0 = 0; float l0 = lg[0];
#pragma unroll
            for (int e = 1; e < 8; ++e) if (lg[e] > l0) { l0 = lg[e]; e0 = e; }
            int e1 = -1; float l1 = -3.0e38f;
#pragma unroll
            for (int e = 0; e < 8; ++e) if (e != e0 && lg[e] > l1) { l1 = lg[e]; e1 = e; }
            const float w0 = 1.0f / (1.0f + __expf(l1 - l0)), w1 = 1.0f - w0;
            if (C.lane == 0) {
                const unsigned r0 = atomicAdd((unsigned*)&lcnt[e0], 1u), r1 = atomicAdd((unsigned*)&lcnt[e1], 1u);
                v4u a; a.x = (unsigned)e0; a.y = (unsigned)e1; a.z = r0; a.w = r1;
                *(v4u*)(route + (size_t)m * 8) = a;
                v2u b; b.x = __builtin_bit_cast(unsigned, w0); b.y = __builtin_bit_cast(unsigned, w1);
                *(v2u*)(route + (size_t)m * 8 + 4) = b;
            }
        }
    }
    if (ROUTE) {
        __syncthreads();
        if (C.tid < 8) { unsigned* gc = WSP(unsigned, WS_CTL) + CW_MOECNT + 64 * moe_li; const unsigned base = atomicAdd(gc + C.tid, lcnt[C.tid]); WSP(unsigned, WS_WGBASE)[C.wg * 8 + C.tid] = base; }
    }
}
template <bool FIN>
__device__ __forceinline__ void lru_chunk(const Ctx& C, int l, int b, int c) {
    LAS float* U = (LAS float*)C.lds;
    const bf16* P = WSP(const bf16, WS_P);
    const bool isctx = c < 4; const int p0 = isctx ? c * 64 : (c - 4) * 64; const int Lp = isctx ? CTXL : SEQ; const int row0 = isctx ? T_LAT + b * CTXL : b * SEQ;
    const int ch = C.tid & 255, half = C.tid >> 8;
    {
        const float* cw = C.in[I_LCW] + (size_t)l * 4 * GW + ch; const float w0 = cw[0], w1 = cw[GW], w2 = cw[2 * GW], w3 = cw[3 * GW], cb = C.in[I_LCB][l * GW + ch];
        const int t0 = half * 32;
        auto ld = [&](int p) -> float { return (p >= 0 && p < Lp) ? bf2f(P[(size_t)(row0 + p) * PLD + ch]) : 0.f; };
        float xm2 = ld(p0 + t0 - 2), xm1 = ld(p0 + t0 - 1), x0 = ld(p0 + t0);
        for (int t = 0; t < 32; ++t) { const float xp1 = ld(p0 + t0 + t + 1); U[(t0 + t) * 256 + ch] = w0 * xm2 + w1 * xm1 + w2 * x0 + w3 * xp1 + cb; xm2 = xm1; xm1 = x0; x0 = xp1; }
    }
    __syncthreads();
    const int d = half, hd = ch >> 6, jj = ch & 63;
    const float* wa = C.in[I_LWA] + ((size_t)((l * 2 + d) * 4 + hd) * 64) * 64 + jj;
    const float* wx = C.in[I_LWX] + ((size_t)((l * 2 + d) * 4 + hd) * 64) * 64 + jj;
    const float ba = C.in[I_LBA][(l * 2 + d) * GW + ch], bx = C.in[I_LBX][(l * 2 + d) * GW + ch];
    const float sp8 = 8.0f * softplusf_(-C.in[I_LLAM][(l * 2 + d) * GW + ch]);
    const size_t sidx = ((size_t)(b * NCH + c) * 2 + d) * 256 + ch;
    float h = FIN ? WSP(const float, WS_HIN)[sidx] : 0.f, sla = 0.f;
    LAS bf16* H16 = (LAS bf16*)(U + 64 * 256) + d * 64 * 256;
    const int sgn = d ? -1 : 1;
#pragma unroll 1
    for (int g = 0; g < 4; ++g) {
        const int tstart = d ? (63 - g * 16) : g * 16;
        float ar[16], ai[16];
#pragma unroll
        for (int tt = 0; tt < 16; ++tt) { ar[tt] = 0.f; ai[tt] = 0.f; }
        const LAS float* ub = U + tstart * 256 + hd * 64;
#pragma unroll 1
        for (int i = 0; i < 64; i += 4) {
            float a4[4], x4[4];
#pragma unroll
            for (int q = 0; q < 4; ++q) { a4[q] = wa[(i + q) * 64]; x4[q] = wx[(i + q) * 64]; }
#pragma unroll
            for (int tt = 0; tt < 16; ++tt) { const f32x4 uu = *(const LAS f32x4*)(ub + sgn * tt * 256 + i);
                ar[tt] += uu.x * a4[0] + uu.y * a4[1] + uu.z * a4[2] + uu.w * a4[3];
                ai[tt] += uu.x * x4[0] + uu.y * x4[1] + uu.z * x4[2] + uu.w * x4[3]; }
        }
#pragma unroll
        for (int tt = 0; tt < 16; ++tt) {
            const int tok = tstart + sgn * tt;
            const float r = sigmoidf_(ar[tt] + ba), ig = sigmoidf_(ai[tt] + bx);
            const float la = -sp8 * r; const float a = __expf(la);
            const float bb = sqrtf(-expm1f_(2.0f * la)) * (ig * U[tok * 256 + ch]);
            h = a * h + bb; sla += la;
            if (FIN) H16[tok * 256 + ch] = (bf16)f2bf(h);
        }
    }
    if (!FIN) { float* ls = WSP(float, WS_LSUM) + sidx * 2; ls[0] = sla; ls[1] = h; __syncthreads(); return; }
    __syncthreads();
    bf16* yc = WSP(bf16, WS_HB);
    const LAS bf16* H0 = (const LAS bf16*)(U + 64 * 256); const LAS bf16* H1 = H0 + 64 * 256;
    for (int t = half * 32; t < half * 32 + 32; ++t) {
        const size_t row = (size_t)(row0 + p0 + t);
        const float gate = bf2f(P[row * PLD + 256 + ch]);
        yc[row * 1024 + ch] = (bf16)f2bf((bf2f(H0[t * 256 + ch]) + bf2f(H1[t * 256 + ch])) * gelu_tanh(gate));
    }
    __syncthreads();
}
__device__ __forceinline__ void lru_carry(const Ctx& C, int idx) {
    const int ch = idx & 255, d = (idx >> 8) & 1, b = idx >> 9;
    const float* ls = WSP(const float, WS_LSUM); float* hin = WSP(float, WS_HIN);
    float H = 0.f;
    for (int k = 0; k < NCH; ++k) {
        const int c = d ? (k < 4 ? 3 - k : NCH + 3 - k) : k;
        const size_t sidx = ((size_t)(b * NCH + c) * 2 + d) * 256 + ch;
        hin[sidx] = H;
        H = __expf(ls[sidx * 2]) * H + ls[sidx * 2 + 1];
    }
}

__device__ __forceinline__ float rw_shift(const bf16* P, int row0, int p, int Lp, int colB, float mu0, float mu1) {
    const size_t o = (size_t)(row0 + p) * PLD + OFF_B + colB;
    const float x = bf2f(P[o]);
    const float pv = p > 0 ? bf2f(P[o - PLD]) : 0.f, nx = p < Lp - 1 ? bf2f(P[o + PLD]) : 0.f;
    return x + mu0 * (pv - x) + mu1 * (nx - x);
}
__device__ __forceinline__ void rwkv_prep(const Ctx& C, int l, int b, int c) {
    LAS float* XW = (LAS float*)C.lds;
    LAS float* XA = XW + 64 * 64;
    LAS float* XG = XA + 64 * 64;
    const bf16* P = WSP(const bf16, WS_P);
    const bool isctx = c < 4; const int p0 = isctx ? c * 64 : (c - 4) * 64; const int Lp = isctx ? CTXL : SEQ; const int row0 = isctx ? T_LAT + b * CTXL : b * SEQ;
    const float* mu = C.in[I_RMU] + (size_t)l * 2 * B_COLS;
    for (int it = C.tid; it < 64 * 192; it += NTHR) {
        const int t = it / 192, ci = it % 192, colB = 768 + ci;
        const float v = rw_shift(P, row0, p0 + t, Lp, colB, mu[colB], mu[B_COLS + colB]);
        if (ci < 64) XW[t * 64 + ci] = tanhf_(v); else if (ci < 128) XA[t * 64 + ci - 64] = v; else XG[t * 64 + ci - 128] = sigmoidf_(v);
    }
    __syncthreads();
    const int ch = C.tid & 255, half = C.tid >> 8, head = ch >> 6;
    bf16* wa_out = WSP(bf16, WS_HB); bf16* g_out = WSP(bf16, WS_G); float* bonus = WSP(float, WS_BONUS);
    const float* wup = C.in[I_RWUP] + (size_t)l * 2 * 32 * GW + ch;
    const float* aup = C.in[I_RAUP] + (size_t)l * 2 * 32 * GW + ch;
    const float* gup = C.in[I_RGUP] + (size_t)l * 64 * GW + ch;
    const float w00 = C.in[I_RW0][(l * 2 + 0) * GW + ch], w01 = C.in[I_RW0][(l * 2 + 1) * GW + ch];
    const float a00 = C.in[I_RA0][(l * 2 + 0) * GW + ch], a01 = C.in[I_RA0][(l * 2 + 1) * GW + ch];
    const float k_a = C.in[I_RKA][l * GW + ch], r_k = C.in[I_RRK][l * GW + ch];
    const float mur0 = mu[ch], mur1 = mu[B_COLS + ch], muk0 = mu[256 + ch], muk1 = mu[B_COLS + 256 + ch];
#pragma unroll 1
    for (int sub = 0; sub < 2; ++sub) {
        const int t0 = half * 32 + sub * 16;
        float acc[16], av0[16], av1[16];
#pragma unroll
        for (int kind = 0; kind < 4; ++kind) {
            const int d = kind & 1; const bool isw = kind < 2;
            const float* W = (isw ? wup : aup) + (size_t)d * 32 * GW; const LAS float* X = (isw ? XW : XA) + d * 32;
#pragma unroll
            for (int t = 0; t < 16; ++t) acc[t] = 0.f;
            for (int r = 0; r < 32; r += 4) {
                const float g0 = W[(r + 0) * GW], g1 = W[(r + 1) * GW], g2 = W[(r + 2) * GW], g3 = W[(r + 3) * GW];
#pragma unroll
                for (int t = 0; t < 16; ++t) { const f32x4 x = *(const LAS f32x4*)(X + (t0 + t) * 64 + r); acc[t] += x.x * g0 + x.y * g1 + x.z * g2 + x.w * g3; }
            }
#pragma unroll
            for (int t = 0; t < 16; ++t) {
                const size_t row = (size_t)(row0 + p0 + t0 + t);
                float val;
                if (isw) val = __expf(-0.6065306597126334f * sigmoidf_(acc[t] + (d ? w01 : w00)));
                else { val = sigmoidf_(acc[t] + (d ? a01 : a00)); if (d) av1[t] = val; else av0[t] = val; }
                wa_out[row * 1024 + kind * 256 + ch] = (bf16)f2bf(val);
            }
        }
#pragma unroll
        for (int t = 0; t < 16; ++t) acc[t] = 0.f;
        for (int j = 0; j < 64; j += 4) {
            const float g0 = gup[(j + 0) * GW], g1 = gup[(j + 1) * GW], g2 = gup[(j + 2) * GW], g3 = gup[(j + 3) * GW];
#pragma unroll
            for (int t = 0; t < 16; ++t) { const f32x4 x = *(const LAS f32x4*)(XG + (t0 + t) * 64 + j); acc[t] += x.x * g0 + x.y * g1 + x.z * g2 + x.w * g3; }
        }
#pragma unroll
        for (int t = 0; t < 16; ++t) {
            const int p = p0 + t0 + t; const size_t row = (size_t)(row0 + p);
            g_out[row * 256 + ch] = (bf16)f2bf(acc[t]);
            const float rs = rw_shift(P, row0, p, Lp, ch, mur0, mur1), ks = rw_shift(P, row0, p, Lp, 256 + ch, muk0, muk1);
            const float km = ks * (1.0f + (av0[t] - 1.0f) * k_a) + ks * (1.0f + (av1[t] - 1.0f) * k_a);
            const float bs = wave_sum(rs * r_k * km);
            if (C.lane == 0) bonus[row * 4 + head] = bs;
        }
    }
    __syncthreads();
}
__device__ __forceinline__ void rwkv_scan(const Ctx& C, int l, int idx) {
    const int d = idx >> 6, b = (idx >> 3) & 7, h = (idx >> 1) & 3, half = idx & 1;
    LAS float* BUF = (LAS float*)C.lds;
    LAS float* YB = BUF + 2 * 32 * 6 * 64;
    const bf16* P = WSP(const bf16, WS_P); const bf16* WA = WSP(const bf16, WS_HB); bf16* outb = WSP(bf16, WS_OUTB) + (size_t)d * T_ALL * 256;
    const int st = C.tid >> 4, q4 = C.tid & 15, chh = h * 64 + q4 * 4;
    const float* mu = C.in[I_RMU] + (size_t)l * 2 * B_COLS;
    f32x4 mu0[3], mu1[3];
#pragma unroll
    for (int q = 0; q < 3; ++q) { mu0[q] = *(const f32x4*)(mu + q * 256 + chh); mu1[q] = *(const f32x4*)(mu + B_COLS + q * 256 + chh); }
    const f32x4 kk_w = *(const f32x4*)(C.in[I_RKK] + l * GW + chh), ka_w = *(const f32x4*)(C.in[I_RKA] + l * GW + chh);
    auto stage = [&](int nb, int bufi) {
        const int i = nb * 32 + st;
        const bool isctx = i < CTXL; const int Lp = isctx ? CTXL : SEQ; const int j = isctx ? i : i - CTXL; const int p = d ? (Lp - 1 - j) : j;
        const int row = (isctx ? T_LAT + b * CTXL : b * SEQ) + p;
        f32x4 sh[3];
#pragma unroll
        for (int q = 0; q < 3; ++q) {
            const bf16* pp = P + (size_t)row * PLD + OFF_B + q * 256 + chh;
            const v2u xc = *(const v2u*)pp; v2u xp = (v2u){0u, 0u}, xn = (v2u){0u, 0u};
            if (p > 0) xp = *(const v2u*)(pp - PLD);
            if (p < Lp - 1) xn = *(const v2u*)(pp + PLD);
            const f32x4 x = (f32x4){bflo(xc.x), bfhi(xc.x), bflo(xc.y), bfhi(xc.y)}, pv = (f32x4){bflo(xp.x), bfhi(xp.x), bflo(xp.y), bfhi(xp.y)}, nx = (f32x4){bflo(xn.x), bfhi(xn.x), bflo(xn.y), bfhi(xn.y)};
            sh[q] = x + mu0[q] * (pv - x) + mu1[q] * (nx - x);
        }
        const v2u wr_ = *(const v2u*)(WA + (size_t)row * 1024 + d * 256 + chh), ar_ = *(const v2u*)(WA + (size_t)row * 1024 + (2 + d) * 256 + chh);
        const f32x4 w = (f32x4){bflo(wr_.x), bfhi(wr_.x), bflo(wr_.y), bfhi(wr_.y)}, a = (f32x4){bflo(ar_.x), bfhi(ar_.x), bflo(ar_.y), bfhi(ar_.y)};
        f32x4 kk = sh[1] * kk_w;
        const float ss = row16_sum((kk.x * kk.x + kk.y * kk.y) + (kk.z * kk.z + kk.w * kk.w));
        kk = kk * (1.0f / sqrtf(ss + 1e-6f));
        const f32x4 km = sh[1] * ((a - 1.0f) * ka_w + 1.0f), beta = kk * a;
        LAS float* o = BUF + ((bufi * 32 + st) * 6) * 64 + q4 * 4;
        *(LAS f32x4*)(o + 0 * 64) = sh[0]; *(LAS f32x4*)(o + 1 * 64) = kk; *(LAS f32x4*)(o + 2 * 64) = w; *(LAS f32x4*)(o + 3 * 64) = beta; *(LAS f32x4*)(o + 4 * 64) = km; *(LAS f32x4*)(o + 5 * 64) = sh[2];
    };
    const int rr = C.tid >> 4, jq = C.tid & 15;
    f32x4 s = (f32x4){0.f, 0.f, 0.f, 0.f};
    constexpr int NBLK = NSTEP / 32;
    stage(0, 0);
    __syncthreads();
    for (int nb = 0; nb < NBLK; ++nb) {
        if (nb + 1 < NBLK) stage(nb + 1, (nb + 1) & 1);
        const LAS float* bb = BUF + ((nb & 1) * 32) * 6 * 64;
        LAS float* yb = YB + (nb & 1) * 1024;
#pragma unroll 4
        for (int t = 0; t < 32; ++t) {
            const LAS float* o = bb + t * 6 * 64 + jq * 4;
            const f32x4 r4 = *(const LAS f32x4*)(o), kk = *(const LAS f32x4*)(o + 64), w = *(const LAS f32x4*)(o + 128), be = *(const LAS f32x4*)(o + 192), km = *(const LAS f32x4*)(o + 256);
            const float vv = bb[t * 6 * 64 + 5 * 64 + half * 32 + rr];
            const float sk = row16_sum((s.x * kk.x + s.y * kk.y) + (s.z * kk.z + s.w * kk.w));
            s = s * w - be * sk + km * vv;
            const float y = row16_sum((s.x * r4.x + s.y * r4.y) + (s.z * r4.z + s.w * r4.w));
            if (jq == 0) yb[t * 32 + rr] = y;
        }
        __syncthreads();
        {
            const int t = C.tid >> 4, r2 = (C.tid & 15) * 2;
            const int i = nb * 32 + t; const int row = seqrow_raster(i, d, b);
            *(unsigned*)(outb + (size_t)row * 256 + h * 64 + half * 32 + r2) = pk2(yb[t * 32 + r2], yb[t * 32 + r2 + 1]);
        }
    }
    __syncthreads();
}

#define RAW_BARRIER() do { asm volatile("s_waitcnt lgkmcnt(0)" ::: "memory"); __builtin_amdgcn_s_barrier(); asm volatile("" ::: "memory"); } while (0)
__device__ __forceinline__ void mlstm_scan_v0(const Ctx& C, int l, int idx) {
    const int d = idx >> 5, b = (idx >> 2) & 7, h = idx & 3, lane = C.lane, w = C.wave;
    LAS float* PN = (LAS float*)C.lds;
    LAS float* PD = PN + 2 * 8 * 64;
    LAS unsigned char* SB = C.lds + 8192;
    constexpr int SBS = 3 * 4096 + 256;
    const bf16* P = WSP(const bf16, WS_P); bf16* outc = WSP(bf16, WS_OUTC) + (size_t)d * T_ALL * 256;
    const float ib = C.in[I_MIB][(l * 2 + d) * NH + h], fb = C.in[I_MFB][(l * 2 + d) * NH + h];
    const int st_ = C.tid >> 4, part = C.tid & 15;
    auto stage = [&](int nb, int bufi) {
        const int row = seqrow_cm(nb * 32 + st_, d, b);
        const size_t ro = (size_t)row * PLD + OFF_C + h * 64 + part * 4;
        LAS unsigned char* sb = SB + bufi * SBS;
        *(LAS v2u*)(sb + st_ * 128 + part * 8) = *(const v2u*)(P + ro);
        *(LAS v2u*)(sb + 4096 + st_ * 128 + part * 8) = *(const v2u*)(P + ro + 256);
        *(LAS v2u*)(sb + 8192 + st_ * 128 + part * 8) = *(const v2u*)(P + ro + 512);
        if (part == 0) { const size_t rg = (size_t)row * PLD + OFF_C + 1024;
            const float li = bf2f(P[rg + d * 4 + h]) + ib, gf = bf2f(P[rg + 8 + d * 4 + h]) + fb;
            *(LAS f32x2*)(sb + 12288 + st_ * 8) = (f32x2){li, -softplusf_(-gf)}; }
    };
    float Cm[8], nk[8];
#pragma unroll
    for (int k = 0; k < 8; ++k) { Cm[k] = 0.f; nk[k] = 0.f; }
    float m = 0.f;
    stage(0, 0);
    __syncthreads();
    for (int nb = 0; nb < NSTEP / 32; ++nb) {
        if (nb + 1 < NSTEP / 32) stage(nb + 1, (nb + 1) & 1);
        const LAS unsigned char* sb = SB + (nb & 1) * SBS;
#pragma unroll 2
        for (int t = 0; t < 32; ++t) {
            const int i = nb * 32 + t;
            const v4u cq = *(const LAS v4u*)(sb + t * 128 + w * 16), ck = *(const LAS v4u*)(sb + 4096 + t * 128 + w * 16);
            const float vv = bf2f(*(const LAS unsigned short*)(sb + 8192 + t * 128 + lane * 2));
            const f32x2 gt = *(const LAS f32x2*)(sb + 12288 + t * 8);
            const float li = gt.x, lf = gt.y;
            const float mn = fmaxf(lf + m, li), fp = __expf(lf + m - mn), ip = __expf(li - mn);
            const float qf[8] = {bflo(cq.x), bfhi(cq.x), bflo(cq.y), bfhi(cq.y), bflo(cq.z), bfhi(cq.z), bflo(cq.w), bfhi(cq.w)};
            const float kf[8] = {bflo(ck.x), bfhi(ck.x), bflo(ck.y), bfhi(ck.y), bflo(ck.z), bfhi(ck.z), bflo(ck.w), bfhi(ck.w)};
            const float ipv = ip * vv;
            float num = 0.f, den = 0.f;
#pragma unroll
            for (int k = 0; k < 8; ++k) { const float kk = kf[k] * 0.125f; Cm[k] = fp * Cm[k] + ipv * kk; nk[k] = fp * nk[k] + ip * kk; num += Cm[k] * qf[k]; den += nk[k] * qf[k]; }
            m = mn;
            const int pb_ = i & 1;
            PN[(pb_ * 8 + w) * 64 + lane] = num; if (lane == 0) PD[pb_ * 8 + w] = den;
            RAW_BARRIER();
            if (w == 0) {
                float ns = 0.f, ds = 0.f;
#pragma unroll
                for (int ww = 0; ww < 8; ++ww) { ns += PN[(pb_ * 8 + ww) * 64 + lane]; ds += PD[pb_ * 8 + ww]; }
                outc[(size_t)seqrow_cm(i, d, b) * 256 + h * 64 + lane] = (bf16)f2bf(ns / fmaxf(fabsf(ds), __expf(-mn)));
            }
        }
        __syncthreads();
    }
}

__device__ __forceinline__ void gdn_prep(const Ctx& C, int l, int b, int c) {
    const bf16* P = WSP(const bf16, WS_P); bf16* gq = WSP(bf16, WS_GQ);
    const bool isctx = c < 4; const int p0 = isctx ? c * 64 : (c - 4) * 64; const int Lp = isctx ? CTXL : SEQ;
    const int lane = C.lane;
    auto rowof = [&](int p) -> int { return isctx ? (T_LAT + b * CTXL + p) : (b * SEQ + (p & 63) * 64 + (p >> 6)); };
    float cw[4][12], x[4][12];
#pragma unroll
    for (int j = 0; j < 4; ++j)
#pragma unroll
        for (int i = 0; i < 12; ++i) cw[j][i] = C.in[I_GCW][((size_t)l * 4 + j) * 768 + i * 64 + lane];
    const int tb = p0 + C.wave * 8;
    auto ldrow = [&](int p, float (&dst)[12]) {
        if (p >= 0 && p < Lp) { const size_t ro = (size_t)rowof(p) * PLD + OFF_D;
#pragma unroll
            for (int i = 0; i < 12; ++i) dst[i] = bf2f(P[ro + i * 64 + lane]); }
        else {
#pragma unroll
            for (int i = 0; i < 12; ++i) dst[i] = 0.f; }
    };
    ldrow(tb - 2, x[0]); ldrow(tb - 1, x[1]); ldrow(tb, x[2]);
#pragma unroll 1
    for (int t = 0; t < 8; ++t) {
        ldrow(tb + t + 1, x[3]);
        const size_t ro = (size_t)rowof(tb + t) * 768;
#pragma unroll
        for (int i = 0; i < 12; ++i) {
            float v = siluf_(cw[0][i] * x[0][i] + cw[1][i] * x[1][i] + cw[2][i] * x[2][i] + cw[3][i] * x[3][i]);
            if (i < 8) { const float ss = wave_sum(v * v); v *= (1.0f / sqrtf(ss + 1e-6f)) * (i < 4 ? 0.125f : 1.0f); }
            gq[ro + i * 64 + lane] = (bf16)f2bf(v);
        }
#pragma unroll
        for (int i = 0; i < 12; ++i) { x[0][i] = x[1][i]; x[1][i] = x[2][i]; x[2][i] = x[3][i]; }
    }
}
__device__ __forceinline__ void gdn_scan_v0(const Ctx& C, int l, int idx) {
    const int d = idx >> 5, b = (idx >> 2) & 7, h = idx & 3, lane = C.lane, w = C.wave;
    LAS float* PA = (LAS float*)C.lds;
    LAS float* PB = PA + 2 * 8 * 64;
    LAS unsigned char* SB = C.lds + 8192;
    constexpr int SBS = 3 * 4096 + 256;
    const bf16* P = WSP(const bf16, WS_P); const bf16* gq = WSP(const bf16, WS_GQ); bf16* outd = WSP(bf16, WS_OUTD) + (size_t)d * T_ALL * 256;
    const float aexp = __expf(C.in[I_GALOG][(l * 2 + d) * NH + h]), dtb = C.in[I_GDTB][(l * 2 + d) * NH + h];
    const int st_ = C.tid >> 4, part = C.tid & 15;
    auto stage = [&](int nb, int bufi) {
        const int row = seqrow_cm(nb * 32 + st_, d, b);
        const size_t rq = (size_t)row * 768 + h * 64 + part * 4;
        LAS unsigned char* sb = SB + bufi * SBS;
        *(LAS v2u*)(sb + st_ * 128 + part * 8) = *(const v2u*)(gq + rq);
        *(LAS v2u*)(sb + 4096 + st_ * 128 + part * 8) = *(const v2u*)(gq + rq + 256);
        *(LAS v2u*)(sb + 8192 + st_ * 128 + part * 8) = *(const v2u*)(gq + rq + 512);
        if (part == 0) { const size_t ro = (size_t)row * PLD + OFF_D + 1024;
            const float ga = bf2f(P[ro + d * 4 + h]), gb = bf2f(P[ro + 8 + d * 4 + h]);
            *(LAS f32x2*)(sb + 12288 + st_ * 8) = (f32x2){__expf(-aexp * softplusf_(ga + dtb)), sigmoidf_(gb)}; }
    };
    float S[8];
#pragma unroll
    for (int k = 0; k < 8; ++k) S[k] = 0.f;
    stage(0, 0);
    __syncthreads();
    int prow = 0;
    for (int nb = 0; nb < NSTEP / 32; ++nb) {
        if (nb + 1 < NSTEP / 32) stage(nb + 1, (nb + 1) & 1);
        const LAS unsigned char* sb = SB + (nb & 1) * SBS;
#pragma unroll 2
        for (int t = 0; t < 32; ++t) {
            const int i = nb * 32 + t;
            const v4u cq = *(const LAS v4u*)(sb + t * 128 + w * 16), ck = *(const LAS v4u*)(sb + 4096 + t * 128 + w * 16);
            const float vv = bf2f(*(const LAS unsigned short*)(sb + 8192 + t * 128 + lane * 2));
            const f32x2 gt = *(const LAS f32x2*)(sb + 12288 + t * 8);
            const float alpha = gt.x, beta = gt.y;
            const float qf[8] = {bflo(cq.x), bfhi(cq.x), bflo(cq.y), bfhi(cq.y), bflo(cq.z), bfhi(cq.z), bflo(cq.w), bfhi(cq.w)};
            const float kf[8] = {bflo(ck.x), bfhi(ck.x), bflo(ck.y), bfhi(ck.y), bflo(ck.z), bfhi(ck.z), bflo(ck.w), bfhi(ck.w)};
            float ks = 0.f;
#pragma unroll
            for (int k = 0; k < 8; ++k) ks += kf[k] * S[k];
            const int pb_ = i & 1;
            PA[(pb_ * 8 + w) * 64 + lane] = ks;
            RAW_BARRIER();
            if (w == 0 && i > 0) {
                float os = 0.f;
#pragma unroll
                for (int ww = 0; ww < 8; ++ww) os += PB[((pb_ ^ 1) * 8 + ww) * 64 + lane];
                outd[(size_t)prow * 256 + h * 64 + lane] = (bf16)f2bf(os);
            }
            float kS = 0.f;
#pragma unroll
            for (int ww = 0; ww < 8; ++ww) kS += PA[(pb_ * 8 + ww) * 64 + lane];
            const float coef = beta * (vv - alpha * kS);
            float o = 0.f;
#pragma unroll
            for (int k = 0; k < 8; ++k) { S[k] = alpha * S[k] + kf[k] * coef; o += qf[k] * S[k]; }
            PB[(pb_ * 8 + w) * 64 + lane] = o;
            prow = seqrow_cm(i, d, b);
        }
        __syncthreads();
    }
    if (w == 0) {
        float os = 0.f;
#pragma unroll
        for (int ww = 0; ww < 8; ++ww) os += PB[(((NSTEP - 1) & 1) * 8 + ww) * 64 + lane];
        outd[(size_t)prow * 256 + h * 64 + lane] = (bf16)f2bf(os);
    }
    __syncthreads();
}

__device__ __forceinline__ void finish_rows(const Ctx& C, int l, int nrows) {
    const bf16* P = WSP(const bf16, WS_P); bf16* yc = WSP(bf16, WS_HB);
    const bf16* ob = WSP(const bf16, WS_OUTB); const bf16* oc = WSP(const bf16, WS_OUTC); const bf16* od = WSP(const bf16, WS_OUTD);
    const bf16* gg = WSP(const bf16, WS_G); const float* bonus = WSP(const float, WS_BONUS);
    const float* mu = C.in[I_RMU] + (size_t)l * 2 * B_COLS;
    const int gw = C.wg * NWAVES + C.wave, NGW = C.G * NWAVES, lane = C.lane;
    for (int m = gw; m < nrows; m += NGW) {
        const bool isctx = m >= T_LAT; const int Lp = isctx ? CTXL : SEQ; const int p = isctx ? ((m - T_LAT) & (CTXL - 1)) : (m & (SEQ - 1)); const int row0 = m - p;
        const size_t o2 = (size_t)T_ALL * 256;
#pragma unroll
        for (int hh = 0; hh < 4; ++hh) {
            const int ch = hh * 64 + lane;
            {
                const float y = bf2f(ob[(size_t)m * 256 + ch]) + bf2f(ob[o2 + (size_t)m * 256 + ch]);
                const float mean = wave_sum(y) * (1.0f / 64.0f); const float dl = y - mean; const float var = wave_sum(dl * dl) * (1.0f / 64.0f);
                const float yn = dl * (1.0f / sqrtf(var + 64e-5f)) * C.in[I_RLNG][l * GW + ch] + C.in[I_RLNB][l * GW + ch];
                const float vs = rw_shift(P, row0, p, Lp, 512 + ch, mu[512 + ch], mu[B_COLS + 512 + ch]);
                yc[(size_t)m * 1024 + 256 + ch] = (bf16)f2bf((yn + bonus[(size_t)m * 4 + hh] * vs) * bf2f(gg[(size_t)m * 256 + ch]));
            }
            {
                const float y = bf2f(oc[(size_t)m * 256 + ch]) + bf2f(oc[o2 + (size_t)m * 256 + ch]);
                const float ms = wave_sum(y * y) * (1.0f / 64.0f);
                const float og = bf2f(P[(size_t)m * PLD + OFF_C + 768 + ch]);
                yc[(size_t)m * 1024 + 512 + ch] = (bf16)f2bf(y * (1.0f / sqrtf(ms + 1e-6f)) * C.in[I_MNG][l * GW + ch] * sigmoidf_(og));
            }
            {
                const float y = bf2f(od[(size_t)m * 256 + ch]) + bf2f(od[o2 + (size_t)m * 256 + ch]);
                const float ms = wave_sum(y * y) * (1.0f / 64.0f);
                const float g = bf2f(P[(size_t)m * PLD + OFF_D + 768 + ch]);
                yc[(size_t)m * 1024 + 768 + ch] = (bf16)f2bf(y * (1.0f / sqrtf(ms + 1e-6f)) * C.in[I_GNG][l * GW + ch] * siluf_(g));
            }
        }
    }
}
__device__ __forceinline__ void moe_scatter(const Ctx& C, int moe_li, int nrows) {
    const unsigned* gc = WSP(const unsigned, WS_CTL) + CW_MOECNT + 64 * moe_li;
    LAS int* pst = (LAS int*)C.lds;
    {
        int pe[8]; int acc = 0;
#pragma unroll
        for (int e = 0; e < NE; ++e) { const int blks = ((int)gc[e] + 255) >> 8; if (C.tid == e) pst[e] = acc * 256; acc += blks; pe[e] = acc; }
        if (C.wg == 0 && C.tid < MOE_MAXBLK) { int be = 0;
#pragma unroll
            for (int e = 0; e < NE; ++e) be += (pe[e] <= C.tid) ? 1 : 0;
            int* tab = WSP(int, WS_TAB); tab[1 + C.tid] = be < NE ? be : NE - 1; if (C.tid == 0) tab[0] = acc; }
    }
    __syncthreads();
    const unsigned* route = WSP(const unsigned, WS_ROUTE); const unsigned* wgbase = WSP(const unsigned, WS_WGBASE);
    const bf16* hb = WSP(const bf16, WS_HB); bf16* am = WSP(bf16, WS_MIX); int* pos = WSP(int, WS_POS);
    const int gw = C.wg * NWAVES + C.wave, NGW = C.G * NWAVES;
    for (int m = gw; m < nrows; m += NGW) {
        const v4u a = *(const v4u*)(route + (size_t)m * 8);
        const int e0 = (int)a.x, e1 = (int)a.y;
        const int p0 = pst[e0] + (int)wgbase[C.wg * 8 + e0] + (int)a.z, p1 = pst[e1] + (int)wgbase[C.wg * 8 + e1] + (int)a.w;
        const v4u r0 = *(const v4u*)(hb + (size_t)m * 1024 + C.lane * 8), r1 = *(const v4u*)(hb + (size_t)m * 1024 + 512 + C.lane * 8);
        *(v4u*)(am + (size_t)p0 * 1024 + C.lane * 8) = r0; *(v4u*)(am + (size_t)p0 * 1024 + 512 + C.lane * 8) = r1;
        *(v4u*)(am + (size_t)p1 * 1024 + C.lane * 8) = r0; *(v4u*)(am + (size_t)p1 * 1024 + 512 + C.lane * 8) = r1;
        if (C.lane == 0) { pos[(size_t)m * 2] = p0; pos[(size_t)m * 2 + 1] = p1; }
    }
    __syncthreads();
}
__device__ __forceinline__ void moe_combine(const Ctx& C, int l, int nrows) {
    const unsigned* route = WSP(const unsigned, WS_ROUTE); const int* pos = WSP(const int, WS_POS); const bf16* ym = WSP(const bf16, WS_MIX);
    const float* modv = WSP(const float, WS_MODV) + (size_t)l * 9 * 6144 + 5 * 1024;
    float* xc = WSP(float, WS_XC);
    const int gw = C.wg * NWAVES + C.wave, NGW = C.G * NWAVES;
    for (int m = gw; m < nrows; m += NGW) {
        const bool isctx = m >= T_LAT;
        float* xr = isctx ? xc + (size_t)(m - T_LAT) * 1024 : C.out + (size_t)m * 1024;
        const float* gv = modv + (size_t)(isctx ? 8 : (m >> 12)) * 6144;
        const int p0 = pos[(size_t)m * 2], p1 = pos[(size_t)m * 2 + 1];
        const float w0 = __builtin_bit_cast(float, route[(size_t)m * 8 + 4]), w1 = __builtin_bit_cast(float, route[(size_t)m * 8 + 5]);
#pragma unroll
        for (int j = 0; j < 4; ++j) {
            const int col = 4 * C.lane + 256 * j;
            const v2u a = *(const v2u*)(ym + (size_t)p0 * 1024 + col), b = *(const v2u*)(ym + (size_t)p1 * 1024 + col);
            const f32x4 ya = (f32x4){bflo(a.x), bfhi(a.x), bflo(a.y), bfhi(a.y)}, yb = (f32x4){bflo(b.x), bfhi(b.x), bflo(b.y), bfhi(b.y)};
            const f32x4 g = *(const f32x4*)(gv + col); f32x4 x = *(const f32x4*)(xr + col);
            x = x + g * (ya * w0 + yb * w1);
            *(f32x4*)(xr + col) = x;
        }
    }
}
__device__ __forceinline__ void final_norm(const Ctx& C) {
    const int gw = C.wg * NWAVES + C.wave, NGW = C.G * NWAVES;
    f32x4 gv[4];
#pragma unroll
    for (int j = 0; j < 4; ++j) gv[j] = *(const f32x4*)(C.in[I_FNG] + 4 * C.lane + 256 * j);
    for (int m = gw; m < T_LAT; m += NGW) {
        float* xr = C.out + (size_t)m * 1024;
        f32x4 v[4]; float s = 0.f;
#pragma unroll
        for (int j = 0; j < 4; ++j) { v[j] = *(const f32x4*)(xr + 4 * C.lane + 256 * j); s += (v[j].x * v[j].x + v[j].y * v[j].y) + (v[j].z * v[j].z + v[j].w * v[j].w); }
        const float rs = 1.0f / sqrtf(wave_sum(s) * (1.0f / 1024.0f) + 1e-6f);
#pragma unroll
        for (int j = 0; j < 4; ++j) *(f32x4*)(xr + 4 * C.lane + 256 * j) = v[j] * rs * gv[j];
    }
}

constexpr int NPH_L = 11, PH_FINAL = 1 + DEPTH * NPH_L, NPHASE = PH_FINAL + 1;
__host__ __device__ inline bool phase_exists(int ph) {
    if (ph == 0 || ph == PH_FINAL) return true;
    const int l = (ph - 1) / NPH_L, k = (ph - 1) % NPH_L;
    if (!(l & 1) && k >= 9) return false;
    return true;
}

__global__ void __launch_bounds__(NTHR, 2) fwd_kernel(Args args) {
    extern __shared__ __attribute__((aligned(16))) unsigned char lds_raw[];
    Ctx C; C.in = args.in; C.out = args.out; C.ws = args.ws; C.lds = (LAS unsigned char*)lds_raw;
    C.tid = threadIdx.x; C.lane = C.tid & 63; C.wave = __builtin_amdgcn_readfirstlane(C.tid >> 6); C.G = gridDim.x; C.wg = blockIdx.x;
    volatile LAS unsigned* MISC = (volatile LAS unsigned*)(C.lds + MISC_OFF);
    if (C.tid < 64) MISC[C.tid] = 0u;
    __syncthreads();
    const int lo = args.ph_lo, hi = args.ph_hi;
    const bool multi = (hi - lo) > 1;
    if (multi) (void)xcd_barrier_post(WSP(unsigned, WS_CTL) + CW_BAR, MISC + 8);
#ifndef PH_MASK
#define PH_MASK 0xFFFFF
#endif
#define PM(k) ((PH_MASK >> (k)) & 1)
#ifndef SK_MASK
#define SK_MASK 0xFFFF
#endif
#define SK(k) ((SK_MASK >> (k)) & 1)
#ifndef REP_MASK
#define REP_MASK 0
#endif
#define NREP(k) (((REP_MASK >> (k)) & 1) ? 2 : 1)
#define IN(k) (lo <= (k) && (k) < hi)
#define SEAM(k) do { if (IN((k) + 1)) { XcdBarrier b2_; b2_.bar = WSP(unsigned, WS_CTL) + CW_BAR; b2_.x = xb_xcc_id(); b2_.st = (volatile LAS unsigned*)(C.lds + MISC_OFF) + 8; xcd_barrier(b2_); } } while (0)
#define FRESH() do { int t_ = threadIdx.x; asm volatile("" : "+v"(t_)); C.tid = t_; C.lane = t_ & 63; C.wave = __builtin_amdgcn_readfirstlane(t_ >> 6); } while (0)

    if (PM(13) && IN(0)) { phase_pre(C); SEAM(0); }

#pragma unroll 1
    for (int l = 0; l < DEPTH; ++l) {
        const int pb = 1 + l * NPH_L;
        if (hi <= pb || lo >= pb + NPH_L) continue;
        const bool last = (l == DEPTH - 1), moe = (l & 1);
        const int nrows = last ? T_LAT : T_ALL;
        const float* xlat = (l == 0) ? C.in[I_X] : C.out; const float* xctx = (l == 0) ? C.in[I_CTX] : WSP(const float, WS_XC);
        const float* modv = WSP(const float, WS_MODV) + (size_t)l * 9 * 6144;

        if (PM(0) && IN(pb + 0)) for (int rep_ = 0; rep_ < NREP(0); ++rep_) { FRESH();
            convert_layer(C, l);
            __syncthreads();
            FRESH(); norm_rows<false>(C, l, xlat, xctx, C.in[I_NMIXG] + l * 1024, 0, 1024, T_ALL, 0);
            SEAM(pb + 0);
        }
        if (PM(1) && IN(pb + 1)) for (int rep_ = 0; rep_ < NREP(1); ++rep_) { FRESH();
            pg8::Gemm g{WSP(const bf16, WS_HB), WSP(const bf16, WS_WIN), T_ALL, PLD, 1024, 0};
            pg8::StaticOrder S; S.init(T_ALL, PLD, C.G, C.wg);
            pg8::EpiBf16<0> E{WSP(bf16, WS_P), PLD, nullptr, 0, 0};
            pg8::gemm_phase<pg8::EpiBf16<0>, pg8::StaticOrder, false>(C.lds, g, S, E, nullptr);
            SEAM(pb + 1);
        }
        if (PM(2) && IN(pb + 2)) for (int rep_ = 0; rep_ < NREP(2); ++rep_) { FRESH();
            FRESH(); if (SK(0)) for (int u = C.wg; u < NB * NCH; u += C.G) lru_chunk<false>(C, l, u / NCH, u % NCH);
            FRESH(); if (SK(1)) for (int u = C.wg; u < NB * NCH; u += C.G) rwkv_prep(C, l, u / NCH, u % NCH);
            FRESH(); if (SK(2)) for (int u = C.wg; u < NB * NCH; u += C.G) gdn_prep(C, l, u / NCH, u % NCH);
            SEAM(pb + 2);
        }
        if (PM(3) && IN(pb + 3)) for (int rep_ = 0; rep_ < NREP(3); ++rep_) { FRESH();
            if (SK(3) && C.wg < 128) { FRESH(); rwkv_scan(C, l, C.wg); }
            else if (SK(4) && C.wg < 192) { FRESH(); mlstm_scan_v0(C, l, C.wg - 128); }
            else if (SK(5)) { FRESH(); gdn_scan_v0(C, l, C.wg - 192); }
            if (SK(6) && C.wg >= 248) lru_carry(C, (C.wg - 248) * NTHR + C.tid);
            SEAM(pb + 3);
        }
        if (PM(4) && IN(pb + 4)) for (int rep_ = 0; rep_ < NREP(4); ++rep_) { FRESH();
            for (int u = C.wg; u < NB * NCH; u += C.G) { const int b = u / NCH, c = u % NCH; if (last && c < 4) continue; if (SK(7)) lru_chunk<true>(C, l, b, c); }
            FRESH(); if (SK(8)) finish_rows(C, l, nrows);
            SEAM(pb + 4);
        }
        if (PM(5) && IN(pb + 5)) { FRESH();
            pg8::Gemm g{WSP(const bf16, WS_HB), WSP(const bf16, WS_WOUT), nrows, 1024, 1024, 0};
            pg8::StaticOrder S; S.init(nrows, 1024, C.G, C.wg);
            pg8::EpiRes E{xlat, xctx, C.out, WSP(float, WS_XC), modv + 2 * 1024};
            pg8::gemm_phase<pg8::EpiRes, pg8::StaticOrder, false>(C.lds, g, S, E, nullptr);
            SEAM(pb + 5);
        }
        if (PM(6) && IN(pb + 6)) { FRESH();
            if (moe) norm_rows<true>(C, l, C.out, WSP(const float, WS_XC), C.in[I_NFFNG] + l * 1024, 3 * 1024, 4 * 1024, nrows, l >> 1);
            else norm_rows<false>(C, l, C.out, WSP(const float, WS_XC), C.in[I_NFFNG] + l * 1024, 3 * 1024, 4 * 1024, nrows, 0);
            SEAM(pb + 6);
        }
        if (!moe) {
            if (PM(11) && IN(pb + 7)) { FRESH();
                pg8::Gemm g{WSP(const bf16, WS_HB), WSP(const bf16, WS_WGU), nrows, 2 * DFF, 1024, 0};
                pg8::StaticOrder S; S.init(nrows, 2 * DFF, C.G, C.wg);
                pg8::EpiSwiglu E{WSP(bf16, WS_P), DFF};
                pg8::gemm_phase<pg8::EpiSwiglu, pg8::StaticOrder, false>(C.lds, g, S, E, nullptr);
                SEAM(pb + 7);
            }
            if (PM(12) && IN(pb + 8)) { FRESH();
                pg8::Gemm g{WSP(const bf16, WS_P), WSP(const bf16, WS_WDN), nrows, 1024, DFF, 0};
                pg8::StaticOrder S; S.init(nrows, 1024, C.G, C.wg);
                pg8::EpiRes E{C.out, WSP(const float, WS_XC), C.out, WSP(float, WS_XC), modv + 5 * 1024};
                pg8::gemm_phase<pg8::EpiRes, pg8::StaticOrder, false>(C.lds, g, S, E, nullptr);
                SEAM(pb + 10);
            }
        } else {
            if (PM(7) && IN(pb + 7)) { FRESH(); moe_scatter(C, l >> 1, nrows); SEAM(pb + 7); }
            if (PM(8) && IN(pb + 8)) { FRESH();
                pg8::Gemm g{WSP(const bf16, WS_MIX), WSP(const bf16, WS_WGU), 0, 2 * DFE, 1024, (size_t)2 * DFE * 1024};
                pg8::MoeOrder S; S.init(WSP(const int, WS_TAB), (2 * DFE) / 256, C.G, C.wg);
                pg8::EpiSwiglu E{WSP(bf16, WS_P), DFE};
                pg8::gemm_phase<pg8::EpiSwiglu, pg8::MoeOrder, false>(C.lds, g, S, E, nullptr);
                SEAM(pb + 8);
            }
            if (PM(9) && IN(pb + 9)) { FRESH();
                pg8::Gemm g{WSP(const bf16, WS_P), WSP(const bf16, WS_WDN), 0, 1024, DFE, (size_t)1024 * DFE};
                pg8::MoeOrder S; S.init(WSP(const int, WS_TAB), 4, C.G, C.wg);
                pg8::EpiBf16<0> E{WSP(bf16, WS_MIX), 1024, nullptr, 0, 0};
                pg8::gemm_phase<pg8::EpiBf16<0>, pg8::MoeOrder, false>(C.lds, g, S, E, nullptr);
                SEAM(pb + 9);
            }
            if (PM(10) && IN(pb + 10)) { FRESH(); moe_combine(C, l, nrows); SEAM(pb + 10); }
        }
    }
    if (PM(14) && IN(PH_FINAL)) final_norm(C);
}

extern "C" void kernel_launch(void* const* d_in, const int* in_sizes, int n_in, void* d_out, int out_size, void* d_ws, size_t ws_size, hipStream_t stream) {
    static int grid = 0;
    if (grid == 0) {
        if (n_in != N_IN || in_sizes[0] != T_LAT * DM || out_size != T_LAT * DM || ws_size < WS_END) {
            fprintf(stderr, "kernel_launch: unexpected problem (n_in %d, in0 %d, out %d, ws %zu < %zu)\n", n_in, n_in > 0 ? in_sizes[0] : -1, out_size, ws_size, (size_t)WS_END); grid = -1; return; }
        int dev = 0, cus = 0, per_cu = 0;
        if (hipGetDevice(&dev) != hipSuccess || hipDeviceGetAttribute(&cus, hipDeviceAttributeMultiprocessorCount, dev) != hipSuccess) { grid = -1; return; }
        if (hipFuncSetAttribute((const void*)fwd_kernel, hipFuncAttributeMaxDynamicSharedMemorySize, LDS_BYTES) != hipSuccess) { fprintf(stderr, "kernel_launch: hipFuncSetAttribute failed\n"); grid = -1; return; }
        if (hipOccupancyMaxActiveBlocksPerMultiprocessor(&per_cu, (const void*)fwd_kernel, NTHR, LDS_BYTES) != hipSuccess || per_cu < 1) { fprintf(stderr, "kernel_launch: occupancy query says %d\n", per_cu); grid = -1; return; }
        grid = cus;
        if (grid != 256) fprintf(stderr, "kernel_launch: note: %d CUs\n", grid);
    }
    if (grid < 0) return;
    if (hipMemsetAsync((char*)d_ws + WS_CTL, 0, CTL_BYTES, stream) != hipSuccess) return;
    Args a{};
    for (int i = 0; i < N_IN; ++i) a.in[i] = (const float*)d_in[i];
    a.out = (float*)d_out; a.ws = (unsigned char*)d_ws;
#if MK_ONE_LAUNCH
    a.ph_lo = 0; a.ph_hi = NPHASE;
    hipLaunchKernelGGL(fwd_kernel, dim3(grid), dim3(NTHR), LDS_BYTES, stream, a);
#else
    for (int ph = 0; ph < NPHASE; ++ph) { if (!phase_exists(ph)) continue; a.ph_lo = ph; a.ph_hi = ph + 1; hipLaunchKernelGGL(fwd_kernel, dim3(grid), dim3(NTHR), LDS_BYTES, stream, a); }
#endif
}
```

```cpp
#define MK_ONE_LAUNCH 1
#include <hip/hip_runtime.h>
#include <cstdio>
#include <cstdint>

#define GAS __attribute__((address_space(1)))
#define LAS __attribute__((address_space(3)))
typedef unsigned short bf16;
typedef unsigned v4u __attribute__((ext_vector_type(4)));
typedef unsigned v2u __attribute__((ext_vector_type(2)));
typedef float f32x4 __attribute__((ext_vector_type(4)));
typedef float f32x2 __attribute__((ext_vector_type(2)));
typedef short bf16x8 __attribute__((ext_vector_type(8)));
#define LDS_WAIT() asm volatile("s_waitcnt lgkmcnt(0)" ::: "memory")
#define VM_WAIT() asm volatile("s_waitcnt vmcnt(0)" ::: "memory")

constexpr int DM = 1024, NB = 8, SEQ = 4096, DEPTH = 4, CTXL = 256, GW = 256, HD = 64, NH = 4;
constexpr int T_LAT = NB * SEQ, T_CTX = NB * CTXL, T_ALL = T_LAT + T_CTX;
constexpr int IN_COLS = 3552, PLD = 3584;
constexpr int OFF_B = 512, OFF_C = 1472, OFF_D = 2512, B_COLS = 960;
constexpr int DFF = 2816, NE = 8, DFE = 1408;
constexpr int NCH = 68;
constexpr int NSTEP = 4352;
constexpr int MOE_MAXBLK = 280;
constexpr int NWAVES = 8, NTHR = 512;

constexpr size_t MiB = 1u << 20;
constexpr size_t WS_CTL = 0, CTL_BYTES = 1 * MiB;
constexpr size_t WS_MODV = 1 * MiB;
constexpr size_t WS_XC = 2 * MiB;
constexpr size_t WS_WIN = 10 * MiB;
constexpr size_t WS_WOUT = 17 * MiB;
constexpr size_t WS_WGU = 19 * MiB;
constexpr size_t WS_WDN = 63 * MiB;
constexpr size_t WS_HB = 85 * MiB;
constexpr size_t WS_P = 153 * MiB;
constexpr size_t WS_MIX = 391 * MiB;
constexpr size_t WS_OUTB = WS_MIX, WS_OUTC = WS_MIX + 34 * MiB, WS_OUTD = WS_MIX + 68 * MiB, WS_GQ = WS_MIX + 102 * MiB, WS_G = WS_MIX + 153 * MiB;
constexpr size_t WS_SMALL = 561 * MiB;
constexpr size_t WS_LSUM = WS_SMALL;
constexpr size_t WS_HIN = WS_SMALL + 3 * MiB;
constexpr size_t WS_ROUTE = WS_SMALL + 5 * MiB;
constexpr size_t WS_POS = WS_SMALL + 7 * MiB;
constexpr size_t WS_BONUS = WS_SMALL + 8 * MiB;
constexpr size_t WS_WGBASE = WS_SMALL + 9 * MiB;
constexpr size_t WS_TAB = WS_WGBASE + 65536;
constexpr size_t WS_END = 571 * MiB;
constexpr int CW_MOECNT = 1024;
constexpr int CW_BAR = 4096;

constexpr int LDS_BYTES = 135168;
constexpr int MISC_OFF = 131072;

__device__ __forceinline__ unsigned f2bf(float f) { unsigned u = __builtin_bit_cast(unsigned, f); return (u + 0x7fffu + ((u >> 16) & 1u)) >> 16; }
__device__ __forceinline__ unsigned pk2(float lo, float hi) { return f2bf(lo) | (f2bf(hi) << 16); }
__device__ __forceinline__ float bf2f(unsigned short v) { return __builtin_bit_cast(float, (unsigned)v << 16); }
__device__ __forceinline__ float bflo(unsigned v) { return __builtin_bit_cast(float, v << 16); }
__device__ __forceinline__ float bfhi(unsigned v) { return __builtin_bit_cast(float, v & 0xffff0000u); }
__device__ __forceinline__ float wave_sum(float v) {
#pragma unroll
    for (int o = 1; o < 64; o <<= 1) v += __shfl_xor(v, o);
    return v;
}
template <int CTRL> __device__ __forceinline__ float dpp_f(float v) { return __builtin_bit_cast(float, __builtin_amdgcn_update_dpp(0, __builtin_bit_cast(int, v), CTRL, 0xF, 0xF, true)); }
__device__ __forceinline__ float row16_sum(float v) {
    v += dpp_f<0xB1>(v);
    v += dpp_f<0x4E>(v);
    v += dpp_f<0x141>(v);
    v += dpp_f<0x140>(v);
    return v;
}
__device__ __forceinline__ float sigmoidf_(float x) { return 1.0f / (1.0f + __expf(-x)); }
__device__ __forceinline__ float softplusf_(float x) { return fmaxf(x, 0.f) + __logf(1.0f + __expf(-fabsf(x))); }
__device__ __forceinline__ float expm1f_(float x) { return x > -0.3f ? x * (1.0f + x * (0.5f + x * (0.16666667f + x * (0.041666668f + x * 0.0083333338f)))) : __expf(x) - 1.0f; }
__device__ __forceinline__ float siluf_(float x) { return x / (1.0f + __expf(-x)); }
__device__ __forceinline__ float tanhf_(float x) { const float e = __expf(2.0f * x); return 1.0f - 2.0f / (e + 1.0f); }
__device__ __forceinline__ float gelu_tanh(float x) { return 0.5f * x * (1.0f + tanhf_(0.7978845608028654f * (x + 0.044715f * x * x * x))); }
#define XB_TMO      128
#define XB_XCNT(j)  (256  + 64 * (j))
#define XB_XSUB(j)  (1280 + 64 * (j))
#define XB_XGEN(j)  (2304 + 64 * (j))
#define XB_TOP      3328
#define XB_TOPGEN   3392
#define XCD_BAR_WORDS 3456
#define XB_SPIN_CAP (1u << 22)

__device__ __forceinline__ unsigned xb_ld(unsigned* p)              { return __hip_atomic_load(p, __ATOMIC_RELAXED, __HIP_MEMORY_SCOPE_AGENT); }
__device__ __forceinline__ unsigned xb_add(unsigned* p, unsigned v) { return __hip_atomic_fetch_add(p, v, __ATOMIC_RELAXED, __HIP_MEMORY_SCOPE_AGENT); }
__device__ __forceinline__ unsigned xb_xcc_id() { return (unsigned)__builtin_amdgcn_s_getreg((3 << 11) | 20) & 0xFu; }
#define XB_SPIN(cond, bar) do { unsigned _sp = 0; while (cond) { __builtin_amdgcn_s_sleep(1); \
    if ((++_sp & 255u) == 0u) { if (xb_ld(&(bar)[XB_TMO])) break; if (_sp > XB_SPIN_CAP) { atomicAdd(&(bar)[XB_TMO], 1u); break; } } } } while (0)

struct XcdBarrier {
    unsigned* bar; unsigned x;
    volatile LAS unsigned* st;
};

__device__ __forceinline__ XcdBarrier xcd_barrier_post(unsigned* bar, volatile LAS unsigned* st) {
    XcdBarrier b; b.bar = bar; b.x = xb_xcc_id(); b.st = st;
    if (threadIdx.x == 0) (void)xb_add(&bar[XB_XCNT(b.x)], 1u);
    return b;
}
__device__ __forceinline__ void xcd_barrier_complete(unsigned* bar, unsigned x, unsigned& nloc, unsigned& nx) {
    const unsigned G = gridDim.x * gridDim.y * gridDim.z;
    unsigned sum, cnt, mine, sp = 0u;
    for (;;) {
        sum = 0u; cnt = 0u; mine = 0u;
#pragma unroll
        for (unsigned j = 0; j < 16; ++j) { const unsigned c = xb_ld(&bar[XB_XCNT(j)]); sum += c; cnt += (c > 0u) ? 1u : 0u; mine = (j == x) ? c : mine; }
        if (sum == G) break;
        __builtin_amdgcn_s_sleep(1);
        if ((++sp & 255u) == 0u) { if (xb_ld(&bar[XB_TMO])) break; if (sp > XB_SPIN_CAP) { atomicAdd(&bar[XB_TMO], 1u); break; } }
    }
    nloc = mine > 0u ? mine : 1u; nx = cnt > 0u ? cnt : 1u;
}

__device__ __forceinline__ void xcd_barrier(const XcdBarrier& b) {
    asm volatile("s_waitcnt vmcnt(0)" ::: "memory");
    __syncthreads();
    if (threadIdx.x == 0) {
        unsigned* bar = b.bar;
        __builtin_amdgcn_s_waitcnt(0);
        unsigned nloc = b.st[0], nx = b.st[1];
        if (nloc == 0u) { xcd_barrier_complete(bar, b.x, nloc, nx); b.st[0] = nloc; b.st[1] = nx; }
        const unsigned old = xb_add(&bar[XB_XSUB(b.x)], 1u);
        const unsigned gen = old / nloc;
        if (old + 1u == (gen + 1u) * nloc) {
            __builtin_amdgcn_fence(__ATOMIC_RELEASE, "agent");
            asm volatile("s_waitcnt vmcnt(0)" ::: "memory");
            const unsigned og = xb_add(&bar[XB_TOP], 1u);
            const unsigned tg = og / nx;
            if (og + 1u == (tg + 1u) * nx) xb_add(&bar[XB_TOPGEN], 1u);
            else XB_SPIN(xb_ld(&bar[XB_TOPGEN]) == tg, bar);
            __builtin_amdgcn_fence(__ATOMIC_ACQUIRE, "agent");
            xb_add(&bar[XB_XGEN(b.x)], 1u);
            asm volatile("s_waitcnt vmcnt(0)" ::: "memory");
        } else {
            XB_SPIN(xb_ld(&bar[XB_XGEN(b.x)]) == gen, bar);
            __builtin_amdgcn_fence(__ATOMIC_ACQUIRE, "agent");
            asm volatile("s_waitcnt vmcnt(0)" ::: "memory");
        }
    }
    __syncthreads();
}

namespace pg8 {
#define PG8_LAS __attribute__((address_space(3)))
typedef unsigned short bf16_t;
typedef short bf16x8 __attribute__((ext_vector_type(8)));
typedef float f32x4 __attribute__((ext_vector_type(4)));
typedef unsigned u32x4 __attribute__((ext_vector_type(4)));
constexpr int BM = 256, BK = 64, HALF = 128, HTB = HALF * BK * 2  , STAGE_BYTES = 8 * HTB, NXCD = 8, WGM = 8;

__host__ __device__ __forceinline__ int lds_byte(int r, int c) { const int st = (r >> 4) * 2 + (c >> 5), rr = r & 15, cc = c & 31, ob = rr * 64 + cc * 2; return st * 1024 + (ob ^ (((ob >> 9) & 1) << 5)); }
__host__ __device__ __forceinline__ void stage_rc(int b, int& R, int& C) { const int st = b / 1024, sb = b % 1024, swz = sb ^ (((sb >> 9) & 1) << 5); R = (st >> 1) * 16 + swz / 64; C = (st & 1) * 32 + (swz % 64) / 2; }
__host__ __device__ __forceinline__ int perm32(int rho) { const int n = rho >> 4, i = rho & 15; return 8 * (i >> 2) + 4 * n + (i & 3); }

struct Unit { int pm, pn, e; };
struct Gemm { const bf16_t* A; const bf16_t* Bt; int M, N, K; size_t estride; };

struct StaticOrder {
    int nM, nN, nwg, G, c;
    __host__ __device__ void init(int M, int N, int G_, int c_) { nM = M / BM; nN = N / BM; nwg = nM * nN; G = G_; c = c_; }
    __host__ __device__ bool next(int i, Unit& u) const {
        const long L = (long)i * G + c; if (L >= nwg) return false;
        int wgid = (int)L; { const int q = nwg / NXCD, r = nwg % NXCD, xcd = wgid % NXCD, off = wgid / NXCD; wgid = (xcd < r ? xcd * (q + 1) : r * (q + 1) + (xcd - r) * q) + off; }
        const int nig = WGM * nN, gid = wgid / nig, fm = gid * WGM, gsz = (nM - fm) < WGM ? (nM - fm) : WGM;
        u.pm = fm + ((wgid % nig) % gsz); u.pn = (wgid % nig) / gsz; u.e = 0; return true;
    }
    __device__ __forceinline__ void a_ready(const Unit&) const {}
    __device__ __forceinline__ void done(const Unit&) const {}
};
__device__ __forceinline__ unsigned cvt_pk_bf16(float lo, float hi) { unsigned r; asm volatile("v_cvt_pk_bf16_f32 %0, %1, %2" : "=v"(r) : "v"(lo), "v"(hi)); return r; }
typedef float f32x2 __attribute__((ext_vector_type(2)));
__device__ __forceinline__ f32x2 gelu_pk(f32x2 v) {
    const f32x2 av = __builtin_elementwise_abs(v), d = av * 0.2316418882f + 1.0f;
    f32x2 t; t.x = __builtin_amdgcn_rcpf(d.x); t.y = __builtin_amdgcn_rcpf(d.y);
    f32x2 q = t * 0.5307027145f + (-0.7265760135f); q = q * t + 0.7107068705f; q = q * t + (-0.142248368f); q = q * t + 0.127414796f; q = q * t;
    const f32x2 s = (v * v) * (-0.72134752044f);
    f32x2 e; e.x = __builtin_amdgcn_exp2f(s.x); e.y = __builtin_amdgcn_exp2f(s.y);
    const f32x2 m = v * (q * e), r = v - m;
    f32x2 o; o.x = v.x < 0.f ? m.x : r.x; o.y = v.y < 0.f ? m.y : r.y; return o;
}

struct EpiF32 {
    static constexpr bool PERM = false, AFTER_DRAIN = false;
    float* C; int ldc; const float* bias;
    __device__ __forceinline__ void operator()(const f32x4 (&acc)[2][2][4][2], const Unit& u, int wr, int wc, int fr, int fq) const {
        const int row0 = u.pm * BM + wr * 64 + fr, col0 = u.pn * BM + wc * 32 + 4 * fq;
        f32x4 bv[2][2];
#pragma unroll
        for (int bj = 0; bj < 2; ++bj)
#pragma unroll
            for (int n = 0; n < 2; ++n) bv[bj][n] = bias ? *(const f32x4*)(bias + col0 + bj * HALF + n * 16) : (f32x4){0.f, 0.f, 0.f, 0.f};
#pragma unroll
        for (int ai = 0; ai < 2; ++ai)
#pragma unroll
            for (int m = 0; m < 4; ++m) { float* rowp = C + (size_t)(row0 + ai * HALF + m * 16) * ldc + col0;
#pragma unroll
                for (int bj = 0; bj < 2; ++bj)
#pragma unroll
                    for (int n = 0; n < 2; ++n) *(f32x4*)(rowp + bj * HALF + n * 16) = acc[ai][bj][m][n] + bv[bj][n]; }
    }
};
template <int ACT  > struct EpiBf16 {
    static constexpr bool PERM = true, AFTER_DRAIN = false;
    bf16_t* O; int ldc; const float* bias; int split_cols; size_t split_stride;
    __device__ __forceinline__ void operator()(const f32x4 (&acc)[2][2][4][2], const Unit& u, int wr, int wc, int fr, int fq) const {
        const int row0 = u.pm * BM + wr * 64 + fr; int colt = u.pn * BM; bf16_t* base = O;
        if (split_cols) { const int t = colt / split_cols; base += (size_t)t * split_stride; colt -= t * split_cols; }
        const int col0 = colt + wc * 32 + 8 * fq, bcol0 = u.pn * BM + wc * 32 + 8 * fq;
        f32x4 bv[2][2];
#pragma unroll
        for (int bj = 0; bj < 2; ++bj)
#pragma unroll
            for (int n = 0; n < 2; ++n) bv[bj][n] = bias ? *(const f32x4*)(bias + bcol0 + bj * HALF + 4 * n) : (f32x4){0.f, 0.f, 0.f, 0.f};
#pragma unroll
        for (int ai = 0; ai < 2; ++ai)
#pragma unroll
            for (int m = 0; m < 4; ++m) { bf16_t* rowp = base + (size_t)(row0 + ai * HALF + m * 16) * ldc + col0;
#pragma unroll
                for (int bj = 0; bj < 2; ++bj) { f32x4 v0 = acc[ai][bj][m][0] + bv[bj][0], v1 = acc[ai][bj][m][1] + bv[bj][1];
                    if (ACT == 1) { f32x2 a = gelu_pk((f32x2){v0[0], v0[1]}), b = gelu_pk((f32x2){v0[2], v0[3]}), c = gelu_pk((f32x2){v1[0], v1[1]}), d = gelu_pk((f32x2){v1[2], v1[3]});
                        v0 = (f32x4){a.x, a.y, b.x, b.y}; v1 = (f32x4){c.x, c.y, d.x, d.y}; }
                    if (ACT == 2) {
#pragma unroll
                        for (int j = 0; j < 4; ++j) { v0[j] = 0.5f * v0[j] * (1.0f + erff(v0[j] * 0.70710678f)); v1[j] = 0.5f * v1[j] * (1.0f + erff(v1[j] * 0.70710678f)); } }
                    u32x4 w; w.x = cvt_pk_bf16(v0[0], v0[1]); w.y = cvt_pk_bf16(v0[2], v0[3]); w.z = cvt_pk_bf16(v1[0], v1[1]); w.w = cvt_pk_bf16(v1[2], v1[3]);
                    *(u32x4*)(rowp + bj * HALF) = w; } }
    }
};

template <class Epi, class Sched, bool STAMP = false>
__device__ __forceinline__ void gemm_phase(PG8_LAS unsigned char* lds, const Gemm g, const Sched& S, const Epi& E, unsigned long long* stamps) {
    int tid_ = threadIdx.x; asm volatile("" : "+v"(tid_));
    const int tid = tid_, wid = __builtin_amdgcn_readfirstlane(tid >> 6), lane = tid & 63, wr = wid >> 2, wc = wid & 3, fr = lane & 15, fq = lane >> 4;
    const int K = g.K, nt = K / BK;
    int ts_lo = 0, ts_hi = 0, nts = 0; const unsigned long long rt_entry = STAMP ? (unsigned long long)wall_clock64() : 0ull;
#define PG8_STAMP() do { if (STAMP && wid == 0 && nts < 64) { const unsigned long long _c = (unsigned long long)clock64(); \
        ts_lo = (lane == nts) ? (int)(unsigned)_c : ts_lo; ts_hi = (lane == nts) ? (int)(unsigned)(_c >> 32) : ts_hi; ++nts; } } while (0)
    PG8_STAMP();
    unsigned voffA[2], voffB[2];
#pragma unroll
    for (int i = 0; i < 2; ++i) { int R, C; stage_rc(tid * 16 + i * 8192, R, C); const int Rb = Epi::PERM ? ((R & ~31) + perm32(R & 31)) : R;
        voffA[i] = (unsigned)(R * K + C) * 2u; voffB[i] = (unsigned)(Rb * K + C) * 2u; }
    const size_t kstep = (size_t)(BK * 2);
    const size_t hstep = (size_t)HALF * K * 2;
    const size_t tstep = 2 * hstep;
    const unsigned ldsw = (unsigned)wid * 1024u;
    const int aoff = lds_byte(wr * 64 + fr, fq * 8), boff = lds_byte(wc * 32 + fr, fq * 8);
#define PG8_SA(b, h) (((b) * 2 + (h)) * HTB)
#define PG8_SB(b, h) ((4 + (b) * 2 + (h)) * HTB)
#define PG8_STAGE(bufoff, gbase, voff) do { _Pragma("unroll") for (int _i = 0; _i < 2; ++_i) \
        __builtin_amdgcn_global_load_lds((const unsigned*)((const char*)(gbase) + (voff)[_i]), (PG8_LAS unsigned*)(lds + (bufoff) + ldsw + _i * 8192), 16, 0, 0); } while (0)
#define PG8_LDA(dst, b, h) do { _Pragma("unroll") for (int m = 0; m < 4; ++m) _Pragma("unroll") for (int k = 0; k < 2; ++k) dst[m][k] = *(const PG8_LAS bf16x8*)(lds + PG8_SA(b, h) + aoff + m * 2048 + k * 1024); } while (0)
#define PG8_LDB(dst, b, h) do { _Pragma("unroll") for (int n = 0; n < 2; ++n) _Pragma("unroll") for (int k = 0; k < 2; ++k) dst[n][k] = *(const PG8_LAS bf16x8*)(lds + PG8_SB(b, h) + boff + n * 2048 + k * 1024); } while (0)
#define PG8_MMA(ai, bj, At, Bt) do { __builtin_amdgcn_s_setprio(1); _Pragma("unroll") for (int m = 0; m < 4; ++m) _Pragma("unroll") for (int n = 0; n < 2; ++n) _Pragma("unroll") for (int k = 0; k < 2; ++k) \
        acc[ai][bj][m][n] = __builtin_amdgcn_mfma_f32_16x16x32_bf16(Bt[n][k], At[m][k], acc[ai][bj][m][n], 0, 0, 0); __builtin_amdgcn_s_setprio(0); } while (0)
#define PG8_WAIT_V(n) asm volatile("s_waitcnt vmcnt(" #n ")" ::: "memory")
#define PG8_WAIT_L(n) asm volatile("s_waitcnt lgkmcnt(" #n ")" ::: "memory")
#define PG8_BAR __builtin_amdgcn_s_barrier()
#define PG8_SCHED __builtin_amdgcn_sched_barrier(0)
    Unit cur, nxt; int ui = 0;
    if (!S.next(0, cur)) return;
    f32x4 acc[2][2][4][2];
#pragma unroll
    for (int a = 0; a < 2; ++a)
#pragma unroll
        for (int b = 0; b < 2; ++b)
#pragma unroll
            for (int m = 0; m < 4; ++m)
#pragma unroll
                for (int n = 0; n < 2; ++n) acc[a][b][m][n] = (f32x4){0.f, 0.f, 0.f, 0.f};
    bf16x8 At[4][2], B0[2][2], B1[2][2];
    const char* cA = (const char*)g.A + (size_t)cur.pm * tstep; const char* cB = (const char*)g.Bt + (size_t)cur.pn * tstep + (size_t)cur.e * g.estride * 2;
    S.a_ready(cur);
    PG8_STAGE(PG8_SB(0, 0), cB, voffB); PG8_STAGE(PG8_SA(0, 0), cA, voffA); PG8_STAGE(PG8_SB(0, 1), cB + hstep, voffB); PG8_STAGE(PG8_SA(0, 1), cA + hstep, voffA);
    if (wr == 1) PG8_BAR;
    PG8_WAIT_V(4); PG8_BAR;
    PG8_STAGE(PG8_SB(1, 0), cB + kstep, voffB); PG8_STAGE(PG8_SA(1, 0), cA + kstep, voffA); PG8_STAGE(PG8_SB(1, 1), cB + hstep + kstep, voffB);
    PG8_WAIT_V(6); PG8_BAR;
    PG8_STAMP();
    for (;;) {
        const bool has_next = S.next(ui + 1, nxt);
        const char* nA = has_next ? (const char*)g.A + (size_t)nxt.pm * tstep : cA; const char* nB = has_next ? (const char*)g.Bt + (size_t)nxt.pn * tstep + (size_t)nxt.e * g.estride * 2 : cB;
        for (int t = 0; t < nt; t += 2) {
            const bool last = (t == nt - 2);
            const char* a1 = cA + (size_t)(t + 1) * kstep;
            const char* a2 = last ? nA : cA + (size_t)(t + 2) * kstep; const char* b2 = last ? nB : cB + (size_t)(t + 2) * kstep;
            const char* a3 = a2 + kstep; const char* b3 = b2 + kstep;
            if (last && has_next) S.a_ready(nxt);
            PG8_LDB(B0, 0, 0); PG8_SCHED; PG8_LDA(At, 0, 0); PG8_STAGE(PG8_SA(1, 1), a1 + hstep, voffA);
            PG8_WAIT_L(8); PG8_BAR; PG8_WAIT_L(0); PG8_MMA(0, 0, At, B0); PG8_BAR; PG8_SCHED;
            PG8_LDB(B1, 0, 1); PG8_STAGE(PG8_SB(0, 0), b2, voffB);
            PG8_BAR; PG8_WAIT_L(0); PG8_MMA(0, 1, At, B1); PG8_BAR;
            PG8_LDA(At, 0, 1); PG8_STAGE(PG8_SA(0, 0), a2, voffA);
            PG8_BAR; PG8_WAIT_L(0); PG8_MMA(1, 0, At, B0); PG8_BAR; PG8_SCHED;
            PG8_STAGE(PG8_SB(0, 1), b2 + hstep, voffB);
            PG8_WAIT_V(6); PG8_BAR; PG8_MMA(1, 1, At, B1); PG8_BAR;
            PG8_LDB(B0, 1, 0); PG8_SCHED; PG8_LDA(At, 1, 0); PG8_STAGE(PG8_SA(0, 1), a2 + hstep, voffA);
            PG8_WAIT_L(8); PG8_BAR; PG8_WAIT_L(0); PG8_MMA(0, 0, At, B0); PG8_BAR; PG8_SCHED;
            PG8_LDB(B1, 1, 1); PG8_STAGE(PG8_SB(1, 0), b3, voffB);
            PG8_BAR; PG8_WAIT_L(0); PG8_MMA(0, 1, At, B1); PG8_BAR;
            PG8_LDA(At, 1, 1); PG8_STAGE(PG8_SA(1, 0), a3, voffA);
            PG8_BAR; PG8_WAIT_L(0); PG8_MMA(1, 0, At, B0); PG8_BAR; PG8_SCHED;
            PG8_STAGE(PG8_SB(1, 1), b3 + hstep, voffB);
            PG8_WAIT_V(6); PG8_BAR; PG8_MMA(1, 1, At, B1); PG8_BAR;
        }
        PG8_STAMP();
        if constexpr (!Epi::AFTER_DRAIN) { E(acc, cur, wr, wc, fr, fq); S.done(cur); }
        PG8_STAMP();
        if (!has_next) break;
#pragma unroll
        for (int a = 0; a < 2; ++a)
#pragma unroll
            for (int b = 0; b < 2; ++b)
#pragma unroll
                for (int m = 0; m < 4; ++m)
#pragma unroll
                    for (int n = 0; n < 2; ++n) acc[a][b][m][n] = (f32x4){0.f, 0.f, 0.f, 0.f};
        cur = nxt; cA = nA; cB = nB; ++ui;
    }
    PG8_WAIT_V(0);
    if (wr == 0) PG8_BAR;
    PG8_BAR;
    if constexpr (Epi::AFTER_DRAIN) { E.fused(acc, cur, wr, wc, fr, fq, lds, wid, lane); S.done(cur); }
    PG8_STAMP();
    if (STAMP && wid == 0) { stamps[lane] = lane < nts ? (((unsigned long long)(unsigned)ts_hi << 32) | (unsigned)ts_lo) : 0ull;
        if (lane == 62) stamps[62] = rt_entry; if (lane == 63) stamps[63] = (unsigned long long)wall_clock64(); }
#undef PG8_STAMP
#undef PG8_SA
#undef PG8_SB
#undef PG8_STAGE
#undef PG8_LDA
#undef PG8_LDB
#undef PG8_MMA
#undef PG8_WAIT_V
#undef PG8_WAIT_L
#undef PG8_BAR
#undef PG8_SCHED
}
}
namespace pg8 {
struct EpiRes {
    static constexpr bool PERM = false, AFTER_DRAIN = false;
    const float* base_lat; const float* base_ctx; float* out_lat; float* out_ctx; const float* gvec;
    __device__ __forceinline__ void operator()(const f32x4 (&acc)[2][2][4][2], const Unit& u, int wr, int wc, int fr, int fq) const {
        const bool isctx = u.pm >= 128;
        const int prow = (isctx ? (u.pm - 128) : u.pm) * BM;
        const float* base = isctx ? base_ctx : base_lat; float* out = isctx ? out_ctx : out_lat;
        const float* gv = gvec + (size_t)(isctx ? 8 : (u.pm >> 4)) * 6144;
        const int row0 = prow + wr * 64 + fr, col0 = u.pn * BM + wc * 32 + 4 * fq;
        f32x4 gvv[2][2];
#pragma unroll
        for (int bj = 0; bj < 2; ++bj)
#pragma unroll
            for (int n = 0; n < 2; ++n) gvv[bj][n] = *(const f32x4*)(gv + col0 + bj * HALF + n * 16);
#pragma unroll
        for (int ai = 0; ai < 2; ++ai)
#pragma unroll
            for (int m = 0; m < 4; ++m) { const size_t off = (size_t)(row0 + ai * HALF + m * 16) * 1024 + col0;
#pragma unroll
                for (int bj = 0; bj < 2; ++bj)
#pragma unroll
                    for (int n = 0; n < 2; ++n) { const f32x4 b = *(const f32x4*)(base + off + bj * HALF + n * 16);
                        *(f32x4*)(out + off + bj * HALF + n * 16) = b + gvv[bj][n] * acc[ai][bj][m][n]; } }
    }
};
struct EpiSwiglu {
    static constexpr bool PERM = true, AFTER_DRAIN = false;
    bf16_t* O; int ldc;
    __device__ __forceinline__ void operator()(const f32x4 (&acc)[2][2][4][2], const Unit& u, int wr, int wc, int fr, int fq) const {
        const int row0 = u.pm * BM + wr * 64 + fr, col0 = u.pn * HALF + wc * 32 + 8 * fq;
#pragma unroll
        for (int ai = 0; ai < 2; ++ai)
#pragma unroll
            for (int m = 0; m < 4; ++m) { bf16_t* rowp = O + (size_t)(row0 + ai * HALF + m * 16) * ldc + col0;
                float h[8];
#pragma unroll
                for (int n = 0; n < 2; ++n)
#pragma unroll
                    for (int j = 0; j < 4; ++j) { const float g = acc[ai][0][m][n][j], up = acc[ai][1][m][n][j]; h[n * 4 + j] = g * __builtin_amdgcn_rcpf(1.0f + __expf(-g)) * up; }
                u32x4 w; w.x = cvt_pk_bf16(h[0], h[1]); w.y = cvt_pk_bf16(h[2], h[3]); w.z = cvt_pk_bf16(h[4], h[5]); w.w = cvt_pk_bf16(h[6], h[7]);
                *(u32x4*)rowp = w; }
    }
};
struct MoeOrder {
    int nN, G, c, nunits; const int* tab;
    __device__ void init(const int* tab_, int nN_, int G_, int c_) { tab = tab_; nN = nN_; G = G_; c = c_; nunits = tab_[0] * nN_; }
    __device__ bool next(int i, Unit& u) const {
        const int L = i * G + c; if (L >= nunits) return false;
        u.pm = L / nN; u.pn = L - u.pm * nN; u.e = tab[1 + u.pm]; return true;
    }
    __device__ __forceinline__ void a_ready(const Unit&) const {}
    __device__ __forceinline__ void done(const Unit&) const {}
};
}
enum { I_X = 0, I_C, I_CTX, I_CCTX, I_MODW, I_MODB, I_NMIXG, I_NFFNG, I_WIN, I_WOUT, I_LCW, I_LCB, I_LWA, I_LBA, I_LWX, I_LBX, I_LLAM,
       I_RMU, I_RWUP, I_RW0, I_RAUP, I_RA0, I_RGUP, I_RKK, I_RKA, I_RRK, I_RLNG, I_RLNB, I_MIB, I_MFB, I_MNG, I_GCW, I_GALOG, I_GDTB, I_GNG,
       I_FWG, I_FWU, I_FWD, I_MROUTER, I_MWG, I_MWU, I_MWD, I_FNG, N_IN };
struct Args { const float* in[N_IN]; float* out; unsigned char* ws; int ph_lo, ph_hi; };
struct Ctx {
    const float* const* in; float* out; unsigned char* ws; LAS unsigned char* lds;
    int tid, lane, wave, G, wg;
};
#define WSP(T, off) ((T*)(C.ws + (off)))

__device__ __forceinline__ int seqrow_raster(int i, int d, int b) {
    if (i < CTXL) { const int p = d ? (CTXL - 1 - i) : i; return T_LAT + b * CTXL + p; }
    const int j = i - CTXL; const int p = d ? (SEQ - 1 - j) : j; return b * SEQ + p;
}
__device__ __forceinline__ int seqrow_cm(int i, int d, int b) {
    if (i < CTXL) { const int p = d ? (CTXL - 1 - i) : i; return T_LAT + b * CTXL + p; }
    const int j = i - CTXL; const int p = d ? (SEQ - 1 - j) : j; return b * SEQ + (p & 63) * 64 + (p >> 6);
}

__device__ __forceinline__ void phase_pre(const Ctx& C) {
    LAS float* sc = (LAS float*)C.lds;
    LAS float* red = sc + 9 * 1024;
    float* modv = WSP(float, WS_MODV);
    bool filled = false;
    for (int it = C.wg; it < DEPTH * 48; it += C.G) {
        if (!filled) {
            for (int i = C.tid; i < 9 * 1024; i += NTHR) { const float v = i < 8192 ? C.in[I_C][i] : C.in[I_CCTX][i - 8192]; sc[i] = siluf_(v); }
            filled = true; __syncthreads();
        }
        const int l = it / 48, jb = it % 48, col = C.tid & 127, kg = C.tid >> 7;
        const float* W = C.in[I_MODW] + (size_t)l * 1024 * 6144 + jb * 128 + col;
        float acc[9];
#pragma unroll
        for (int r = 0; r < 9; ++r) acc[r] = 0.f;
        for (int k = kg * 256; k < kg * 256 + 256; ++k) { const float w = W[(size_t)k * 6144];
#pragma unroll
            for (int r = 0; r < 9; ++r) acc[r] += sc[r * 1024 + k] * w; }
#pragma unroll
        for (int r = 0; r < 9; ++r) red[(kg * 9 + r) * 128 + col] = acc[r];
        __syncthreads();
        for (int i = C.tid; i < 9 * 128; i += NTHR) { const int r = i >> 7, cc = i & 127;
            const float s = red[(0 * 9 + r) * 128 + cc] + red[(1 * 9 + r) * 128 + cc] + red[(2 * 9 + r) * 128 + cc] + red[(3 * 9 + r) * 128 + cc];
            modv[((size_t)l * 9 + r) * 6144 + jb * 128 + cc] = s + C.in[I_MODB][l * 6144 + jb * 128 + cc]; }
        __syncthreads();
    }
}

__device__ __forceinline__ void tr_item(const float* src, size_t ld, int k0, int ns0, bf16* dst, int drow0, int Kd, LAS float* scr, int lane, bool zero) {
    if (!zero) {
#pragma unroll 8
        for (int i = 0; i < 32; ++i) { const int kk = 2 * i + (lane >> 5); scr[kk * 33 + (lane & 31)] = src[(size_t)(k0 + kk) * ld + ns0 + (lane & 31)]; }
    }
    LDS_WAIT(); asm volatile("" ::: "memory");
    const int c = lane & 7;
#pragma unroll
    for (int j = 0; j < 4; ++j) { const int n = (lane >> 3) + 8 * j; const LAS float* s = scr + (8 * c) * 33 + n;
        v4u o; o.x = pk2(s[0 * 33], s[1 * 33]); o.y = pk2(s[2 * 33], s[3 * 33]); o.z = pk2(s[4 * 33], s[5 * 33]); o.w = pk2(s[6 * 33], s[7 * 33]);
        if (zero) o = (v4u){0u, 0u, 0u, 0u};
        *(v4u*)(dst + (size_t)(drow0 + n) * Kd + k0 + 8 * c) = o; }
    LDS_WAIT(); asm volatile("" ::: "memory");
}
__device__ __forceinline__ void convert_layer(const Ctx& C, int l) {
    LAS float* scr = (LAS float*)(C.lds + C.wave * 8704);
    const int gw = C.wg * NWAVES + C.wave, NGW = C.G * NWAVES;
    constexpr int I_IN = 16 * 112, I_OUT = 16 * 32, I_GU = 16 * 176, I_DN = 44 * 32, I_E = 16 * 88 + 22 * 32;
    const bool moe = l & 1; const int li = l >> 1;
    const int nitems = I_IN + I_OUT + (moe ? NE * I_E : (I_GU + I_DN));
    bf16* win = WSP(bf16, WS_WIN); bf16* wout = WSP(bf16, WS_WOUT); bf16* wgu = WSP(bf16, WS_WGU); bf16* wdn = WSP(bf16, WS_WDN);
    for (int it = gw; it < nitems; it += NGW) {
        int r = it;
        if (r < I_IN) { const int kb = r / 112, nb = r % 112; tr_item(C.in[I_WIN] + (size_t)l * 1024 * IN_COLS, IN_COLS, 64 * kb, 32 * nb, win, 32 * nb, 1024, scr, C.lane, nb == 111); continue; }
        r -= I_IN;
        if (r < I_OUT) { const int kb = r / 32, nb = r % 32; tr_item(C.in[I_WOUT] + (size_t)l * 1024 * 1024, 1024, 64 * kb, 32 * nb, wout, 32 * nb, 1024, scr, C.lane, false); continue; }
        r -= I_OUT;
        if (!moe) {
            if (r < I_GU) { const int kb = r / 176, nb = r % 176, tile = nb >> 3, q = nb & 7;
                const float* src = (q < 4 ? C.in[I_FWG] : C.in[I_FWU]) + (size_t)li * 1024 * DFF;
                tr_item(src, DFF, 64 * kb, tile * 128 + (q & 3) * 32, wgu, 32 * nb, 1024, scr, C.lane, false); continue; }
            r -= I_GU;
            { const int kb = r / 32, nb = r % 32; tr_item(C.in[I_FWD] + (size_t)li * DFF * 1024, 1024, 64 * kb, 32 * nb, wdn, 32 * nb, DFF, scr, C.lane, false); }
        } else {
            const int e = r / I_E; int rr = r % I_E;
            if (rr < 16 * 88) { const int kb = rr / 88, nb = rr % 88, tile = nb >> 3, q = nb & 7;
                const float* src = (q < 4 ? C.in[I_MWG] : C.in[I_MWU]) + ((size_t)li * NE + e) * 1024 * DFE;
                tr_item(src, DFE, 64 * kb, tile * 128 + (q & 3) * 32, wgu + (size_t)e * 2 * DFE * 1024, 32 * nb, 1024, scr, C.lane, false); continue; }
            rr -= 16 * 88;
            { const int kb = rr / 32, nb = rr % 32; tr_item(C.in[I_MWD] + ((size_t)li * NE + e) * DFE * 1024, 1024, 64 * kb, 32 * nb, wdn + (size_t)e * 1024 * DFE, 32 * nb, DFE, scr, C.lane, false); }
        }
    }
}

template <bool ROUTE>
__device__ __forceinline__ void norm_rows(const Ctx& C, int l, const float* xlat, const float* xctx, const float* gain, int shoff, int scoff, int nrows, int moe_li) {
    const float* modv = WSP(float, WS_MODV) + (size_t)l * 9 * 6144;
    bf16* hb = WSP(bf16, WS_HB);
    const int gw = C.wg * NWAVES + C.wave, NGW = C.G * NWAVES;
    LAS unsigned* lcnt = (LAS unsigned*)(C.lds + 65536);
    unsigned* route = WSP(unsigned, WS_ROUTE);
    if (ROUTE) { if (C.tid < 8) lcnt[C.tid] = 0u; __syncthreads(); }
    f32x4 gv[4];
#pragma unroll
    for (int j = 0; j < 4; ++j) gv[j] = *(const f32x4*)(gain + 4 * C.lane + 256 * j);
    for (int m = gw; m < nrows; m += NGW) {
        const bool isctx = m >= T_LAT;
        const float* xr = isctx ? xctx + (size_t)(m - T_LAT) * 1024 : xlat + (size_t)m * 1024;
        const float* mv = modv + (size_t)(isctx ? 8 : (m >> 12)) * 6144;
        f32x4 v[4]; float s = 0.f;
#pragma unroll
        for (int j = 0; j < 4; ++j) { v[j] = *(const f32x4*)(xr + 4 * C.lane + 256 * j); s += (v[j].x * v[j].x + v[j].y * v[j].y) + (v[j].z * v[j].z + v[j].w * v[j].w); }
        const float rs = 1.0f / sqrtf(wave_sum(s) * (1.0f / 1024.0f) + 1e-6f);
#pragma unroll
        for (int j = 0; j < 4; ++j) { const f32x4 sh = *(const f32x4*)(mv + shoff + 4 * C.lane + 256 * j), scl = *(const f32x4*)(mv + scoff + 4 * C.lane + 256 * j);
            v[j] = (v[j] * rs * gv[j]) * (scl + 1.0f) + sh;
            v2u o; o.x = pk2(v[j].x, v[j].y); o.y = pk2(v[j].z, v[j].w);
            *(v2u*)(hb + (size_t)m * 1024 + 4 * C.lane + 256 * j) = o; }
        if (ROUTE) {
            const float* rt = C.in[I_MROUTER] + (size_t)moe_li * 1024 * NE;
            float lg[8];
#pragma unroll
            for (int e = 0; e < 8; ++e) lg[e] = 0.f;
#pragma unroll
            for (int j = 0; j < 4; ++j)
#pragma unroll
                for (int q = 0; q < 4; ++q) { const int k = 4 * C.lane + 256 * j + q; const f32x4 r0 = *(const f32x4*)(rt + (size_t)k * 8), r1 = *(const f32x4*)(rt + (size_t)k * 8 + 4); const float hv = v[j][q];
                    lg[0] += hv * r0.x; lg[1] += hv * r0.y; lg[2] += hv * r0.z; lg[3] += hv * r0.w; lg[4] += hv * r1.x; lg[5] += hv * r1.y; lg[6] += hv * r1.z; lg[7] += hv * r1.w; }
#pragma unroll
            for (int e = 0; e < 8; ++e) lg[e] = wave_sum(lg[e]);
            int e0 = 0; float l0 = lg[0];
#pragma unroll
            for (int e = 1; e < 8; ++e) if (lg[e] > l0) { l0 = lg[e]; e0 = e; }
            int e1 = -1; float l1 = -3.0e38f;
#pragma unroll
            for (int e = 0; e < 8; ++e) if (e != e0 && lg[e] > l1) { l1 = lg[e]; e1 = e; }
            const float w0 = 1.0f / (1.0f + __expf(l1 - l0)), w1 = 1.0f - w0;
            if (C.lane == 0) {
                const unsigned r0 = atomicAdd((unsigned*)&lcnt[e0], 1u), r1 = atomicAdd((unsigned*)&lcnt[e1], 1u);
                v4u a; a.x = (unsigned)e0; a.y = (unsigned)e1; a.z = r0; a.w = r1;
                *(v4u*)(route + (size_t)m * 8) = a;
                v2u b; b.x = __builtin_bit_cast(unsigned, w0); b.y = __builtin_bit_cast(unsigned, w1);
                *(v2u*)(route + (size_t)m * 8 + 4) = b;
            }
        }
    }
    if (ROUTE) {
        __syncthreads();
        if (C.tid < 8) { unsigned* gc = WSP(unsigned, WS_CTL) + CW_MOECNT + 64 * moe_li; const unsigned base = atomicAdd(gc + C.tid, lcnt[C.tid]); WSP(unsigned, WS_WGBASE)[C.wg * 8 + C.tid] = base; }
    }
}
template <bool FIN>
__device__ __forceinline__ void lru_chunk(const Ctx& C, int l, int b, int c) {
    LAS float* U = (LAS float*)C.lds;
    const bf16* P = WSP(const bf16, WS_P);
    const bool isctx = c < 4; const int p0 = isctx ? c * 64 : (c - 4) * 64; const int Lp = isctx ? CTXL : SEQ; const int row0 = isctx ? T_LAT + b * CTXL : b * SEQ;
    const int ch = C.tid & 255, half = C.tid >> 8;
    {
        const float* cw = C.in[I_LCW] + (size_t)l * 4 * GW + ch; const float w0 = cw[0], w1 = cw[GW], w2 = cw[2 * GW], w3 = cw[3 * GW], cb = C.in[I_LCB][l * GW + ch];
        const int t0 = half * 32;
        auto ld = [&](int p) -> float { return (p >= 0 && p < Lp) ? bf2f(P[(size_t)(row0 + p) * PLD + ch]) : 0.f; };
        float xm2 = ld(p0 + t0 - 2), xm1 = ld(p0 + t0 - 1), x0 = ld(p0 + t0);
        for (int t = 0; t < 32; ++t) { const float xp1 = ld(p0 + t0 + t + 1); U[(t0 + t) * 256 + ch] = w0 * xm2 + w1 * xm1 + w2 * x0 + w3 * xp1 + cb; xm2 = xm1; xm1 = x0; x0 = xp1; }
    }
    __syncthreads();
    const int d = half, hd = ch >> 6, jj = ch & 63;
    const float* wa = C.in[I_LWA] + ((size_t)((l * 2 + d) * 4 + hd) * 64) * 64 + jj;
    const float* wx = C.in[I_LWX] + ((size_t)((l * 2 + d) * 4 + hd) * 64) * 64 + jj;
    const float ba = C.in[I_LBA][(l * 2 + d) * GW + ch], bx = C.in[I_LBX][(l * 2 + d) * GW + ch];
    const float sp8 = 8.0f * softplusf_(-C.in[I_LLAM][(l * 2 + d) * GW + ch]);
    const size_t sidx = ((size_t)(b * NCH + c) * 2 + d) * 256 + ch;
    float h = FIN ? WSP(const float, WS_HIN)[sidx] : 0.f, sla = 0.f;
    LAS bf16* H16 = (LAS bf16*)(U + 64 * 256) + d * 64 * 256;
    const int sgn = d ? -1 : 1;
#pragma unroll 1
    for (int g = 0; g < 4; ++g) {
        const int tstart = d ? (63 - g * 16) : g * 16;
        float ar[16], ai[16];
#pragma unroll
        for (int tt = 0; tt < 16; ++tt) { ar[tt] = 0.f; ai[tt] = 0.f; }
        const LAS float* ub = U + tstart * 256 + hd * 64;
#pragma unroll 1
        for (int i = 0; i < 64; i += 4) {
            float a4[4], x4[4];
#pragma unroll
            for (int q = 0; q < 4; ++q) { a4[q] = wa[(i + q) * 64]; x4[q] = wx[(i + q) * 64]; }
#pragma unroll
            for (int tt = 0; tt < 16; ++tt) { const f32x4 uu = *(const LAS f32x4*)(ub + sgn * tt * 256 + i);
                ar[tt] += uu.x * a4[0] + uu.y * a4[1] + uu.z * a4[2] + uu.w * a4[3];
                ai[tt] += uu.x * x4[0] + uu.y * x4[1] + uu.z * x4[2] + uu.w * x4[3]; }
        }
#pragma unroll
        for (int tt = 0; tt < 16; ++tt) {
            const int tok = tstart + sgn * tt;
            const float r = sigmoidf_(ar[tt] + ba), ig = sigmoidf_(ai[tt] + bx);
            const float la = -sp8 * r; const float a = __expf(la);
            const float bb = sqrtf(-expm1f_(2.0f * la)) * (ig * U[tok * 256 + ch]);
            h = a * h + bb; sla += la;
            if (FIN) H16[tok * 256 + ch] = (bf16)f2bf(h);
        }
    }
    if (!FIN) { float* ls = WSP(float, WS_LSUM) + sidx * 2; ls[0] = sla; ls[1] = h; __syncthreads(); return; }
    __syncthreads();
    bf16* yc = WSP(bf16, WS_HB);
    const LAS bf16* H0 = (const LAS bf16*)(U + 64 * 256); const LAS bf16* H1 = H0 + 64 * 256;
    for (int t = half * 32; t < half * 32 + 32; ++t) {
        const size_t row = (size_t)(row0 + p0 + t);
        const float gate = bf2f(P[row * PLD + 256 + ch]);
        yc[row * 1024 + ch] = (bf16)f2bf((bf2f(H0[t * 256 + ch]) + bf2f(H1[t * 256 + ch])) * gelu_tanh(gate));
    }
    __syncthreads();
}
__device__ __forceinline__ void lru_carry(const Ctx& C, int idx) {
    const int ch = idx & 255, d = (idx >> 8) & 1, b = idx >> 9;
    const float* ls = WSP(const float, WS_LSUM); float* hin = WSP(float, WS_HIN);
    float H = 0.f;
    for (int k = 0; k < NCH; ++k) {
        const int c = d ? (k < 4 ? 3 - k : NCH + 3 - k) : k;
        const size_t sidx = ((size_t)(b * NCH + c) * 2 + d) * 256 + ch;
        hin[sidx] = H;
        H = __expf(ls[sidx * 2]) * H + ls[sidx * 2 + 1];
    }
}

__device__ __forceinline__ float rw_shift(const bf16* P, int row0, int p, int Lp, int colB, float mu0, float mu1) {
    const size_t o = (size_t)(row0 + p) * PLD + OFF_B + colB;
    const float x = bf2f(P[o]);
    const float pv = p > 0 ? bf2f(P[o - PLD]) : 0.f, nx = p < Lp - 1 ? bf2f(P[o + PLD]) : 0.f;
    return x + mu0 * (pv - x) + mu1 * (nx - x);
}
__device__ __forceinline__ void rwkv_prep(const Ctx& C, int l, int b, int c) {
    LAS float* XW = (LAS float*)C.lds;
    LAS float* XA = XW + 64 * 64;
    LAS float* XG = XA + 64 * 64;
    const bf16* P = WSP(const bf16, WS_P);
    const bool isctx = c < 4; const int p0 = isctx ? c * 64 : (c - 4) * 64; const int Lp = isctx ? CTXL : SEQ; const int row0 = isctx ? T_LAT + b * CTXL : b * SEQ;
    const float* mu = C.in[I_RMU] + (size_t)l * 2 * B_COLS;
    for (int it = C.tid; it < 64 * 192; it += NTHR) {
        const int t = it / 192, ci = it % 192, colB = 768 + ci;
        const float v = rw_shift(P, row0, p0 + t, Lp, colB, mu[colB], mu[B_COLS + colB]);
        if (ci < 64) XW[t * 64 + ci] = tanhf_(v); else if (ci < 128) XA[t * 64 + ci - 64] = v; else XG[t * 64 + ci - 128] = sigmoidf_(v);
    }
    __syncthreads();
    const int ch = C.tid & 255, half = C.tid >> 8, head = ch >> 6;
    bf16* wa_out = WSP(bf16, WS_HB); bf16* g_out = WSP(bf16, WS_G); float* bonus = WSP(float, WS_BONUS);
    const float* wup = C.in[I_RWUP] + (size_t)l * 2 * 32 * GW + ch;
    const float* aup = C.in[I_RAUP] + (size_t)l * 2 * 32 * GW + ch;
    const float* gup = C.in[I_RGUP] + (size_t)l * 64 * GW + ch;
    const float w00 = C.in[I_RW0][(l * 2 + 0) * GW + ch], w01 = C.in[I_RW0][(l * 2 + 1) * GW + ch];
    const float a00 = C.in[I_RA0][(l * 2 + 0) * GW + ch], a01 = C.in[I_RA0][(l * 2 + 1) * GW + ch];
    const float k_a = C.in[I_RKA][l * GW + ch], r_k = C.in[I_RRK][l * GW + ch];
    const float mur0 = mu[ch], mur1 = mu[B_COLS + ch], muk0 = mu[256 + ch], muk1 = mu[B_COLS + 256 + ch];
#pragma unroll 1
    for (int sub = 0; sub < 2; ++sub) {
        const int t0 = half * 32 + sub * 16;
        float acc[16], av0[16], av1[16];
#pragma unroll
        for (int kind = 0; kind < 4; ++kind) {
            const int d = kind & 1; const bool isw = kind < 2;
            const float* W = (isw ? wup : aup) + (size_t)d * 32 * GW; const LAS float* X = (isw ? XW : XA) + d * 32;
#pragma unroll
            for (int t = 0; t < 16; ++t) acc[t] = 0.f;
            for (int r = 0; r < 32; r += 4) {
                const float g0 = W[(r + 0) * GW], g1 = W[(r + 1) * GW], g2 = W[(r + 2) * GW], g3 = W[(r + 3) * GW];
#pragma unroll
                for (int t = 0; t < 16; ++t) { const f32x4 x = *(const LAS f32x4*)(X + (t0 + t) * 64 + r); acc[t] += x.x * g0 + x.y * g1 + x.z * g2 + x.w * g3; }
            }
#pragma unroll
            for (int t = 0; t < 16; ++t) {
                const size_t row = (size_t)(row0 + p0 + t0 + t);
                float val;
                if (isw) val = __expf(-0.6065306597126334f * sigmoidf_(acc[t] + (d ? w01 : w00)));
                else { val = sigmoidf_(acc[t] + (d ? a01 : a00)); if (d) av1[t] = val; else av0[t] = val; }
                wa_out[row * 1024 + kind * 256 + ch] = (bf16)f2bf(val);
            }
        }
#pragma unroll
        for (int t = 0; t < 16; ++t) acc[t] = 0.f;
        for (int j = 0; j < 64; j += 4) {
            const float g0 = gup[(j + 0) * GW], g1 = gup[(j + 1) * GW], g2 = gup[(j + 2) * GW], g3 = gup[(j + 3) * GW];
#pragma unroll
            for (int t = 0; t < 16; ++t) { const f32x4 x = *(const LAS f32x4*)(XG + (t0 + t) * 64 + j); acc[t] += x.x * g0 + x.y * g1 + x.z * g2 + x.w * g3; }
        }
#pragma unroll
        for (int t = 0; t < 16; ++t) {
            const int p = p0 + t0 + t; const size_t row = (size_t)(row0 + p);
            g_out[row * 256 + ch] = (bf16)f2bf(acc[t]);
            const float rs = rw_shift(P, row0, p, Lp, ch, mur0, mur1), ks = rw_shift(P, row0, p, Lp, 256 + ch, muk0, muk1);
            const float km = ks * (1.0f + (av0[t] - 1.0f) * k_a) + ks * (1.0f + (av1[t] - 1.0f) * k_a);
            const float bs = wave_sum(rs * r_k * km);
            if (C.lane == 0) bonus[row * 4 + head] = bs;
        }
    }
    __syncthreads();
}
__device__ __forceinline__ void rwkv_scan(const Ctx& C, int l, int idx) {
    const int d = idx >> 6, b = (idx >> 3) & 7, h = (idx >> 1) & 3, half = idx & 1;
    LAS float* BUF = (LAS float*)C.lds;
    LAS float* YB = BUF + 2 * 32 * 6 * 64;
    const bf16* P = WSP(const bf16, WS_P); const bf16* WA = WSP(const bf16, WS_HB); bf16* outb = WSP(bf16, WS_OUTB) + (size_t)d * T_ALL * 256;
    const int st = C.tid >> 4, q4 = C.tid & 15, chh = h * 64 + q4 * 4;
    const float* mu = C.in[I_RMU] + (size_t)l * 2 * B_COLS;
    f32x4 mu0[3], mu1[3];
#pragma unroll
    for (int q = 0; q < 3; ++q) { mu0[q] = *(const f32x4*)(mu + q * 256 + chh); mu1[q] = *(const f32x4*)(mu + B_COLS + q * 256 + chh); }
    const f32x4 kk_w = *(const f32x4*)(C.in[I_RKK] + l * GW + chh), ka_w = *(const f32x4*)(C.in[I_RKA] + l * GW + chh);
    auto stage = [&](int nb, int bufi) {
        const int i = nb * 32 + st;
        const bool isctx = i < CTXL; const int Lp = isctx ? CTXL : SEQ; const int j = isctx ? i : i - CTXL; const int p = d ? (Lp - 1 - j) : j;
        const int row = (isctx ? T_LAT + b * CTXL : b * SEQ) + p;
        f32x4 sh[3];
#pragma unroll
        for (int q = 0; q < 3; ++q) {
            const bf16* pp = P + (size_t)row * PLD + OFF_B + q * 256 + chh;
            const v2u xc = *(const v2u*)pp; v2u xp = (v2u){0u, 0u}, xn = (v2u){0u, 0u};
            if (p > 0) xp = *(const v2u*)(pp - PLD);
            if (p < Lp - 1) xn = *(const v2u*)(pp + PLD);
            const f32x4 x = (f32x4){bflo(xc.x), bfhi(xc.x), bflo(xc.y), bfhi(xc.y)}, pv = (f32x4){bflo(xp.x), bfhi(xp.x), bflo(xp.y), bfhi(xp.y)}, nx = (f32x4){bflo(xn.x), bfhi(xn.x), bflo(xn.y), bfhi(xn.y)};
            sh[q] = x + mu0[q] * (pv - x) + mu1[q] * (nx - x);
        }
        const v2u wr_ = *(const v2u*)(WA + (size_t)row * 1024 + d * 256 + chh), ar_ = *(const v2u*)(WA + (size_t)row * 1024 + (2 + d) * 256 + chh);
        const f32x4 w = (f32x4){bflo(wr_.x), bfhi(wr_.x), bflo(wr_.y), bfhi(wr_.y)}, a = (f32x4){bflo(ar_.x), bfhi(ar_.x), bflo(ar_.y), bfhi(ar_.y)};
        f32x4 kk = sh[1] * kk_w;
        const float ss = row16_sum((kk.x * kk.x + kk.y * kk.y) + (kk.z * kk.z + kk.w * kk.w));
        kk = kk * (1.0f / sqrtf(ss + 1e-6f));
        const f32x4 km = sh[1] * ((a - 1.0f) * ka_w + 1.0f), beta = kk * a;
        LAS float* o = BUF + ((bufi * 32 + st) * 6) * 64 + q4 * 4;
        *(LAS f32x4*)(o + 0 * 64) = sh[0]; *(LAS f32x4*)(o + 1 * 64) = kk; *(LAS f32x4*)(o + 2 * 64) = w; *(LAS f32x4*)(o + 3 * 64) = beta; *(LAS f32x4*)(o + 4 * 64) = km; *(LAS f32x4*)(o + 5 * 64) = sh[2];
    };
    const int rr = C.tid >> 4, jq = C.tid & 15;
    f32x4 s = (f32x4){0.f, 0.f, 0.f, 0.f};
    constexpr int NBLK = NSTEP / 32;
    stage(0, 0);
    __syncthreads();
    for (int nb = 0; nb < NBLK; ++nb) {
        if (nb + 1 < NBLK) stage(nb + 1, (nb + 1) & 1);
        const LAS float* bb = BUF + ((nb & 1) * 32) * 6 * 64;
        LAS float* yb = YB + (nb & 1) * 1024;
#pragma unroll 4
        for (int t = 0; t < 32; ++t) {
            const LAS float* o = bb + t * 6 * 64 + jq * 4;
            const f32x4 r4 = *(const LAS f32x4*)(o), kk = *(const LAS f32x4*)(o + 64), w = *(const LAS f32x4*)(o + 128), be = *(const LAS f32x4*)(o + 192), km = *(const LAS f32x4*)(o + 256);
            const float vv = bb[t * 6 * 64 + 5 * 64 + half * 32 + rr];
            const float sk = row16_sum((s.x * kk.x + s.y * kk.y) + (s.z * kk.z + s.w * kk.w));
            s = s * w - be * sk + km * vv;
            const float y = row16_sum((s.x * r4.x + s.y * r4.y) + (s.z * r4.z + s.w * r4.w));
            if (jq == 0) yb[t * 32 + rr] = y;
        }
        __syncthreads();
        {
            const int t = C.tid >> 4, r2 = (C.tid & 15) * 2;
            const int i = nb * 32 + t; const int row = seqrow_raster(i, d, b);
            *(unsigned*)(outb + (size_t)row * 256 + h * 64 + half * 32 + r2) = pk2(yb[t * 32 + r2], yb[t * 32 + r2 + 1]);
        }
    }
    __syncthreads();
}

#define RAW_BARRIER() do { asm volatile("s_waitcnt lgkmcnt(0)" ::: "memory"); __builtin_amdgcn_s_barrier(); asm volatile("" ::: "memory"); } while (0)
__device__ __forceinline__ void mlstm_scan_v0(const Ctx& C, int l, int idx) {
    const int d = idx >> 5, b = (idx >> 2) & 7, h = idx & 3, lane = C.lane, w = C.wave;
    LAS float* PN = (LAS float*)C.lds;
    LAS float* PD = PN + 2 * 8 * 64;
    LAS unsigned char* SB = C.lds + 8192;
    constexpr int SBS = 3 * 4096 + 256;
    const bf16* P = WSP(const bf16, WS_P); bf16* outc = WSP(bf16, WS_OUTC) + (size_t)d * T_ALL * 256;
    const float ib = C.in[I_MIB][(l * 2 + d) * NH + h], fb = C.in[I_MFB][(l * 2 + d) * NH + h];
    const int st_ = C.tid >> 4, part = C.tid & 15;
    auto stage = [&](int nb, int bufi) {
        const int row = seqrow_cm(nb * 32 + st_, d, b);
        const size_t ro = (size_t)row * PLD + OFF_C + h * 64 + part * 4;
        LAS unsigned char* sb = SB + bufi * SBS;
        *(LAS v2u*)(sb + st_ * 128 + part * 8) = *(const v2u*)(P + ro);
        *(LAS v2u*)(sb + 4096 + st_ * 128 + part * 8) = *(const v2u*)(P + ro + 256);
        *(LAS v2u*)(sb + 8192 + st_ * 128 + part * 8) = *(const v2u*)(P + ro + 512);
        if (part == 0) { const size_t rg = (size_t)row * PLD + OFF_C + 1024;
            const float li = bf2f(P[rg + d * 4 + h]) + ib, gf = bf2f(P[rg + 8 + d * 4 + h]) + fb;
            *(LAS f32x2*)(sb + 12288 + st_ * 8) = (f32x2){li, -softplusf_(-gf)}; }
    };
    float Cm[8], nk[8];
#pragma unroll
    for (int k = 0; k < 8; ++k) { Cm[k] = 0.f; nk[k] = 0.f; }
    float m = 0.f;
    stage(0, 0);
    __syncthreads();
    for (int nb = 0; nb < NSTEP / 32; ++nb) {
        if (nb + 1 < NSTEP / 32) stage(nb + 1, (nb + 1) & 1);
        const LAS unsigned char* sb = SB + (nb & 1) * SBS;
#pragma unroll 2
        for (int t = 0; t < 32; ++t) {
            const int i = nb * 32 + t;
            const v4u cq = *(const LAS v4u*)(sb + t * 128 + w * 16), ck = *(const LAS v4u*)(sb + 4096 + t * 128 + w * 16);
            const float vv = bf2f(*(const LAS unsigned short*)(sb + 8192 + t * 128 + lane * 2));
            const f32x2 gt = *(const LAS f32x2*)(sb + 12288 + t * 8);
            const float li = gt.x, lf = gt.y;
            const float mn = fmaxf(lf + m, li), fp = __expf(lf + m - mn), ip = __expf(li - mn);
            const float qf[8] = {bflo(cq.x), bfhi(cq.x), bflo(cq.y), bfhi(cq.y), bflo(cq.z), bfhi(cq.z), bflo(cq.w), bfhi(cq.w)};
            const float kf[8] = {bflo(ck.x), bfhi(ck.x), bflo(ck.y), bfhi(ck.y), bflo(ck.z), bfhi(ck.z), bflo(ck.w), bfhi(ck.w)};
            const float ipv = ip * vv;
            float num = 0.f, den = 0.f;
#pragma unroll
            for (int k = 0; k < 8; ++k) { const float kk = kf[k] * 0.125f; Cm[k] = fp * Cm[k] + ipv * kk; nk[k] = fp * nk[k] + ip * kk; num += Cm[k] * qf[k]; den += nk[k] * qf[k]; }
            m = mn;
            const int pb_ = i & 1;
            PN[(pb_ * 8 + w) * 64 + lane] = num; if (lane == 0) PD[pb_ * 8 + w] = den;
            RAW_BARRIER();
            if (w == 0) {
                float ns = 0.f, ds = 0.f;
#pragma unroll
                for (int ww = 0; ww < 8; ++ww) { ns += PN[(pb_ * 8 + ww) * 64 + lane]; ds += PD[pb_ * 8 + ww]; }
                outc[(size_t)seqrow_cm(i, d, b) * 256 + h * 64 + lane] = (bf16)f2bf(ns / fmaxf(fabsf(ds), __expf(-mn)));
            }
        }
        __syncthreads();
    }
}

__device__ __forceinline__ void gdn_prep(const Ctx& C, int l, int b, int c) {
    const bf16* P = WSP(const bf16, WS_P); bf16* gq = WSP(bf16, WS_GQ);
    const bool isctx = c < 4; const int p0 = isctx ? c * 64 : (c - 4) * 64; const int Lp = isctx ? CTXL : SEQ;
    const int lane = C.lane;
    auto rowof = [&](int p) -> int { return isctx ? (T_LAT + b * CTXL + p) : (b * SEQ + (p & 63) * 64 + (p >> 6)); };
    float cw[4][12], x[4][12];
#pragma unroll
    for (int j = 0; j < 4; ++j)
#pragma unroll
        for (int i = 0; i < 12; ++i) cw[j][i] = C.in[I_GCW][((size_t)l * 4 + j) * 768 + i * 64 + lane];
    const int tb = p0 + C.wave * 8;
    auto ldrow = [&](int p, float (&dst)[12]) {
        if (p >= 0 && p < Lp) { const size_t ro = (size_t)rowof(p) * PLD + OFF_D;
#pragma unroll
            for (int i = 0; i < 12; ++i) dst[i] = bf2f(P[ro + i * 64 + lane]); }
        else {
#pragma unroll
            for (int i = 0; i < 12; ++i) dst[i] = 0.f; }
    };
    ldrow(tb - 2, x[0]); ldrow(tb - 1, x[1]); ldrow(tb, x[2]);
#pragma unroll 1
    for (int t = 0; t < 8; ++t) {
        ldrow(tb + t + 1, x[3]);
        const size_t ro = (size_t)rowof(tb + t) * 768;
#pragma unroll
        for (int i = 0; i < 12; ++i) {
            float v = siluf_(cw[0][i] * x[0][i] + cw[1][i] * x[1][i] + cw[2][i] * x[2][i] + cw[3][i] * x[3][i]);
            if (i < 8) { const float ss = wave_sum(v * v); v *= (1.0f / sqrtf(ss + 1e-6f)) * (i < 4 ? 0.125f : 1.0f); }
            gq[ro + i * 64 + lane] = (bf16)f2bf(v);
        }
#pragma unroll
        for (int i = 0; i < 12; ++i) { x[0][i] = x[1][i]; x[1][i] = x[2][i]; x[2][i] = x[3][i]; }
    }
}
__device__ __forceinline__ void gdn_scan_v0(const Ctx& C, int l, int idx) {
    const int d = idx >> 5, b = (idx >> 2) & 7, h = idx & 3, lane = C.lane, w = C.wave;
    LAS float* PA = (LAS float*)C.lds;
    LAS float* PB = PA + 2 * 8 * 64;
    LAS unsigned char* SB = C.lds + 8192;
    constexpr int SBS = 3 * 4096 + 256;
    const bf16* P = WSP(const bf16, WS_P); const bf16* gq = WSP(const bf16, WS_GQ); bf16* outd = WSP(bf16, WS_OUTD) + (size_t)d * T_ALL * 256;
    const float aexp = __expf(C.in[I_GALOG][(l * 2 + d) * NH + h]), dtb = C.in[I_GDTB][(l * 2 + d) * NH + h];
    const int st_ = C.tid >> 4, part = C.tid & 15;
    auto stage = [&](int nb, int bufi) {
        const int row = seqrow_cm(nb * 32 + st_, d, b);
        const size_t rq = (size_t)row * 768 + h * 64 + part * 4;
        LAS unsigned char* sb = SB + bufi * SBS;
        *(LAS v2u*)(sb + st_ * 128 + part * 8) = *(const v2u*)(gq + rq);
        *(LAS v2u*)(sb + 4096 + st_ * 128 + part * 8) = *(const v2u*)(gq + rq + 256);
        *(LAS v2u*)(sb + 8192 + st_ * 128 + part * 8) = *(const v2u*)(gq + rq + 512);
        if (part == 0) { const size_t ro = (size_t)row * PLD + OFF_D + 1024;
            const float ga = bf2f(P[ro + d * 4 + h]), gb = bf2f(P[ro + 8 + d * 4 + h]);
            *(LAS f32x2*)(sb + 12288 + st_ * 8) = (f32x2){__expf(-aexp * softplusf_(ga + dtb)), sigmoidf_(gb)}; }
    };
    float S[8];
#pragma unroll
    for (int k = 0; k < 8; ++k) S[k] = 0.f;
    stage(0, 0);
    __syncthreads();
    int prow = 0;
    for (int nb = 0; nb < NSTEP / 32; ++nb) {
        if (nb + 1 < NSTEP / 32) stage(nb + 1, (nb + 1) & 1);
        const LAS unsigned char* sb = SB + (nb & 1) * SBS;
#pragma unroll 2
        for (int t = 0; t < 32; ++t) {
            const int i = nb * 32 + t;
            const v4u cq = *(const LAS v4u*)(sb + t * 128 + w * 16), ck = *(const LAS v4u*)(sb + 4096 + t * 128 + w * 16);
            const float vv = bf2f(*(const LAS unsigned short*)(sb + 8192 + t * 128 + lane * 2));
            const f32x2 gt = *(const LAS f32x2*)(sb + 12288 + t * 8);
            const float alpha = gt.x, beta = gt.y;
            const float qf[8] = {bflo(cq.x), bfhi(cq.x), bflo(cq.y), bfhi(cq.y), bflo(cq.z), bfhi(cq.z), bflo(cq.w), bfhi(cq.w)};
            const float kf[8] = {bflo(ck.x), bfhi(ck.x), bflo(ck.y), bfhi(ck.y), bflo(ck.z), bfhi(ck.z), bflo(ck.w), bfhi(ck.w)};
            float ks = 0.f;
#pragma unroll
            for (int k = 0; k < 8; ++k) ks += kf[k] * S[k];
            const int pb_ = i & 1;
            PA[(pb_ * 8 + w) * 64 + lane] = ks;
            RAW_BARRIER();
            if (w == 0 && i > 0) {
                float os = 0.f;
#pragma unroll
                for (int ww = 0; ww < 8; ++ww) os += PB[((pb_ ^ 1) * 8 + ww) * 64 + lane];
                outd[(size_t)prow * 256 + h * 64 + lane] = (bf16)f2bf(os);
            }
            float kS = 0.f;
#pragma unroll
            for (int ww = 0; ww < 8; ++ww) kS += PA[(pb_ * 8 + ww) * 64 + lane];
            const float coef = beta * (vv - alpha * kS);
            float o = 0.f;
#pragma unroll
            for (int k = 0; k < 8; ++k) { S[k] = alpha * S[k] + kf[k] * coef; o += qf[k] * S[k]; }
            PB[(pb_ * 8 + w) * 64 + lane] = o;
            prow = seqrow_cm(i, d, b);
        }
        __syncthreads();
    }
    if (w == 0) {
        float os = 0.f;
#pragma unroll
        for (int ww = 0; ww < 8; ++ww) os += PB[(((NSTEP - 1) & 1) * 8 + ww) * 64 + lane];
        outd[(size_t)prow * 256 + h * 64 + lane] = (bf16)f2bf(os);
    }
    __syncthreads();
}

__device__ __forceinline__ void finish_rows(const Ctx& C, int l, int nrows) {
    const bf16* P = WSP(const bf16, WS_P); bf16* yc = WSP(bf16, WS_HB);
    const bf16* ob = WSP(const bf16, WS_OUTB); const bf16* oc = WSP(const bf16, WS_OUTC); const bf16* od = WSP(const bf16, WS_OUTD);
    const bf16* gg = WSP(const bf16, WS_G); const float* bonus = WSP(const float, WS_BONUS);
    const float* mu = C.in[I_RMU] + (size_t)l * 2 * B_COLS;
    const int gw = C.wg * NWAVES + C.wave, NGW = C.G * NWAVES, lane = C.lane;
    for (int m = gw; m < nrows; m += NGW) {
        const bool isctx = m >= T_LAT; const int Lp = isctx ? CTXL : SEQ; const int p = isctx ? ((m - T_LAT) & (CTXL - 1)) : (m & (SEQ - 1)); const int row0 = m - p;
        const size_t o2 = (size_t)T_ALL * 256;
#pragma unroll
        for (int hh = 0; hh < 4; ++hh) {
            const int ch = hh * 64 + lane;
            {
                const float y = bf2f(ob[(size_t)m * 256 + ch]) + bf2f(ob[o2 + (size_t)m * 256 + ch]);
                const float mean = wave_sum(y) * (1.0f / 64.0f); const float dl = y - mean; const float var = wave_sum(dl * dl) * (1.0f / 64.0f);
                const float yn = dl * (1.0f / sqrtf(var + 64e-5f)) * C.in[I_RLNG][l * GW + ch] + C.in[I_RLNB][l * GW + ch];
                const float vs = rw_shift(P, row0, p, Lp, 512 + ch, mu[512 + ch], mu[B_COLS + 512 + ch]);
                yc[(size_t)m * 1024 + 256 + ch] = (bf16)f2bf((yn + bonus[(size_t)m * 4 + hh] * vs) * bf2f(gg[(size_t)m * 256 + ch]));
            }
            {
                const float y = bf2f(oc[(size_t)m * 256 + ch]) + bf2f(oc[o2 + (size_t)m * 256 + ch]);
                const float ms = wave_sum(y * y) * (1.0f / 64.0f);
                const float og = bf2f(P[(size_t)m * PLD + OFF_C + 768 + ch]);
                yc[(size_t)m * 1024 + 512 + ch] = (bf16)f2bf(y * (1.0f / sqrtf(ms + 1e-6f)) * C.in[I_MNG][l * GW + ch] * sigmoidf_(og));
            }
            {
                const float y = bf2f(od[(size_t)m * 256 + ch]) + bf2f(od[o2 + (size_t)m * 256 + ch]);
                const float ms = wave_sum(y * y) * (1.0f / 64.0f);
                const float g = bf2f(P[(size_t)m * PLD + OFF_D + 768 + ch]);
                yc[(size_t)m * 1024 + 768 + ch] = (bf16)f2bf(y * (1.0f / sqrtf(ms + 1e-6f)) * C.in[I_GNG][l * GW + ch] * siluf_(g));
            }
        }
    }
}
typedef bf16x8 fragb;
__device__ __forceinline__ f32x4 mfma16(fragb a, fragb b, f32x4 c) { return __builtin_amdgcn_mfma_f32_16x16x32_bf16(a, b, c, 0, 0, 0); }
__device__ __forceinline__ fragb ld_frag16(const LAS bf16* p) { return *(const LAS fragb*)p; }
__device__ __forceinline__ fragb ld_frag8x2(const LAS bf16* p0, const LAS bf16* p1) {
    const v2u a = *(const LAS v2u*)p0, b = *(const LAS v2u*)p1; v4u r; r.x = a.x; r.y = a.y; r.z = b.x; r.w = b.y; return __builtin_bit_cast(fragb, r); }
__device__ __forceinline__ fragb pack_frag(const f32x4& lo, const f32x4& hi) { v4u r; r.x = pk2(lo.x, lo.y); r.y = pk2(lo.z, lo.w); r.z = pk2(hi.x, hi.y); r.w = pk2(hi.z, hi.w); return __builtin_bit_cast(fragb, r); }
__device__ __forceinline__ float wave_incl_sum(float v, int lane) {
#pragma unroll
    for (int o = 1; o < 64; o <<= 1) { const float y = __shfl_up(v, o); if (lane >= o) v += y; }
    return v;
}
__device__ __forceinline__ float wave_incl_max(float v, int lane) {
#pragma unroll
    for (int o = 1; o < 64; o <<= 1) { const float y = __shfl_up(v, o); if (lane >= o) v = fmaxf(v, y); }
    return v;
}
constexpr int MP = 72;
__device__ __forceinline__ void mlstm_chunked(const Ctx& C, int l, int idx) {
    const int d = idx >> 5, b = (idx >> 2) & 7, h = idx & 3, lane = C.lane, w = C.wave, l15 = lane & 15, q = lane >> 4;
    const int it = w & 3, vtp = w >> 2;
    constexpr int IMG = 64 * MP * 2, BUFB = 4 * IMG + 1024, CTB = 65 * MP * 2 + 16;
    LAS unsigned char* L0 = C.lds;
    const bf16* P = WSP(const bf16, WS_P); bf16* outc = WSP(bf16, WS_OUTC) + (size_t)d * T_ALL * 256;
    const float ib = C.in[I_MIB][(l * 2 + d) * NH + h], fb = C.in[I_MFB][(l * 2 + d) * NH + h];
    const int tt = C.tid >> 3, part = C.tid & 7;
    for (int i = C.tid; i < 2 * CTB / 4; i += NTHR) ((LAS unsigned*)(L0 + 2 * BUFB))[i] = 0u;
    v4u rq, rk, rv; unsigned short rgi, rgf;
    auto gload = [&](int n) {
        const int row = seqrow_cm(n * 64 + tt, d, b);
        const bf16* pp = P + (size_t)row * PLD + OFF_C + h * 64 + 8 * part;
        rq = *(const v4u*)pp; rk = *(const v4u*)(pp + 256); rv = *(const v4u*)(pp + 512);
        const bf16* pg = P + (size_t)seqrow_cm(n * 64 + lane, d, b) * PLD + OFF_C + 1024 + d * 4 + h;
        rgi = pg[0]; rgf = pg[8];
    };
    auto images = [&](int bufi) {
        LAS unsigned char* B0 = L0 + bufi * BUFB;
        LAS bf16* Qs = (LAS bf16*)B0; LAS bf16* Ks = Qs + 64 * MP; LAS bf16* VT = Ks + 64 * MP; LAS bf16* KTw = VT + 64 * MP; LAS float* vec = (LAS float*)(B0 + 4 * IMG);
        const float li = bf2f(rgi) + ib, lf = -softplusf_(-(bf2f(rgf) + fb));
        const float bc = wave_incl_sum(lf, lane), x = li - bc, cm = wave_incl_max(x, lane);
        const float wl = __expf(x - __shfl(cm, 63)) * 0.125f;
        if (w == 0) { vec[lane] = x; vec[64 + lane] = cm; vec[128 + lane] = bc; }
        const float wmine = __shfl(wl, 8 * w + (lane >> 3));
        *(LAS v4u*)(Qs + tt * MP + 8 * part) = rq; *(LAS v4u*)(Ks + tt * MP + 8 * part) = rk;
        const unsigned vv[4] = {rv.x, rv.y, rv.z, rv.w}, kk[4] = {rk.x, rk.y, rk.z, rk.w};
#pragma unroll
        for (int e = 0; e < 4; ++e) {
            VT[(8 * part + 2 * e) * MP + tt] = (bf16)(vv[e] & 0xffffu); VT[(8 * part + 2 * e + 1) * MP + tt] = (bf16)(vv[e] >> 16);
            KTw[(8 * part + 2 * e) * MP + tt] = (bf16)f2bf(bflo(kk[e]) * wmine); KTw[(8 * part + 2 * e + 1) * MP + tt] = (bf16)f2bf(bfhi(kk[e]) * wmine);
        }
    };
    f32x4 Cst[2], nst; float m = 0.f;
    Cst[0] = Cst[1] = nst = (f32x4){0.f, 0.f, 0.f, 0.f};
    const fragb ones = __builtin_bit_cast(fragb, (v4u){0x3F803F80u, 0x3F803F80u, 0x3F803F80u, 0x3F803F80u});
    const f32x4 z4 = (f32x4){0.f, 0.f, 0.f, 0.f};
    gload(0); images(0); gload(1);
#pragma unroll 1
    for (int n = 0; n < NCH; ++n) {
        __syncthreads();
        const LAS unsigned char* B0 = L0 + (n & 1) * BUFB;
        const LAS bf16* Qs = (const LAS bf16*)B0; const LAS bf16* Ks = Qs + 64 * MP; const LAS bf16* VT = Ks + 64 * MP; const LAS bf16* KTw = VT + 64 * MP; const LAS float* vec = (const LAS float*)(B0 + 4 * IMG);
        const LAS bf16* CT = (const LAS bf16*)(L0 + 2 * BUFB + (n & 1) * CTB); LAS bf16* CTn = (LAS bf16*)(L0 + 2 * BUFB + ((n + 1) & 1) * CTB);
        fragb Qf[2]; Qf[0] = ld_frag16(Qs + (16 * it + l15) * MP + 8 * q); Qf[1] = ld_frag16(Qs + (16 * it + l15) * MP + 32 + 8 * q);
        const float cmi = vec[64 + 16 * it + l15]; const int icol = 16 * it + l15;
        f32x4 pt[4];
#pragma unroll
        for (int jt = 0; jt < 4; ++jt) {
            pt[jt] = z4;
            if (jt <= it) {
                const fragb k0 = ld_frag16(Ks + (16 * jt + l15) * MP + 8 * q), k1 = ld_frag16(Ks + (16 * jt + l15) * MP + 32 + 8 * q);
                f32x4 st = mfma16(k0, Qf[0], z4); st = mfma16(k1, Qf[1], st);
                const f32x4 xj = *(const LAS f32x4*)(vec + 16 * jt + 4 * q);
#pragma unroll
                for (int r = 0; r < 4; ++r) { const int j = 16 * jt + 4 * q + r; pt[jt][r] = (j <= icol) ? st[r] * __expf(xj[r] - cmi) * 0.125f : 0.f; }
            }
        }
        fragb Pf[2]; Pf[0] = pack_frag(pt[0], pt[1]); Pf[1] = pack_frag(pt[2], pt[3]);
        fragb Vf[2][2];
#pragma unroll
        for (int v2 = 0; v2 < 2; ++v2)
#pragma unroll
            for (int s = 0; s < 2; ++s) { const LAS bf16* vr = VT + (16 * (2 * vtp + v2) + l15) * MP + 32 * s + 4 * q; Vf[v2][s] = ld_frag8x2(vr, vr + 16); }
        f32x4 Aacc[2], R[2], as, dn;
        as = mfma16(Pf[0], ones, z4); if (it >= 2) as = mfma16(Pf[1], ones, as);
        const fragb nf0 = ld_frag16(CT + 64 * MP + 8 * q), nf1 = ld_frag16(CT + 64 * MP + 32 + 8 * q);
        dn = mfma16(Qf[0], nf0, z4); dn = mfma16(Qf[1], nf1, dn);
#pragma unroll
        for (int v2 = 0; v2 < 2; ++v2) {
            Aacc[v2] = mfma16(Pf[0], Vf[v2][0], z4); if (it >= 2) Aacc[v2] = mfma16(Pf[1], Vf[v2][1], Aacc[v2]);
            const LAS bf16* cr = CT + (16 * (2 * vtp + v2) + l15) * MP + 8 * q;
            R[v2] = mfma16(Qf[0], ld_frag16(cr), z4); R[v2] = mfma16(Qf[1], ld_frag16(cr + 32), R[v2]);
        }
        {
            const f32x4 bi = *(const LAS f32x4*)(vec + 128 + 16 * it + 4 * q), cmr = *(const LAS f32x4*)(vec + 64 + 16 * it + 4 * q);
#pragma unroll
            for (int r = 0; r < 4; ++r) {
                const float mi = bi[r] + cmr[r], minter = bi[r] + m, mt = fmaxf(minter, mi), e1 = __expf(mi - mt), e2 = __expf(minter - mt);
                const float den = e1 * as[r] + e2 * dn[r]; const float inv = 1.0f / fmaxf(fabsf(den), __expf(-mt));
                const int row = seqrow_cm(n * 64 + 16 * it + 4 * q + r, d, b);
#pragma unroll
                for (int v2 = 0; v2 < 2; ++v2) outc[(size_t)row * 256 + h * 64 + 16 * (2 * vtp + v2) + l15] = (bf16)f2bf((e1 * Aacc[v2][r] + e2 * R[v2][r]) * inv);
            }
        }
        {
            const LAS bf16* kr = KTw + (16 * it + l15) * MP + 4 * q;
            const fragb kt0 = ld_frag8x2(kr, kr + 16), kt1 = ld_frag8x2(kr + 32, kr + 48);
            const float bL = vec[128 + 63], mloc = bL + vec[64 + 63];
            const float mnew = fmaxf(bL + m, mloc), wp = __expf(bL + m - mnew), wn = __expf(mloc - mnew);
            f32x4 gk = mfma16(kt0, ones, z4); gk = mfma16(kt1, ones, gk);
            nst = nst * wp + gk * wn;
#pragma unroll
            for (int v2 = 0; v2 < 2; ++v2) {
                f32x4 G = mfma16(kt0, Vf[v2][0], z4); G = mfma16(kt1, Vf[v2][1], G);
                Cst[v2] = Cst[v2] * wp + G * wn;
                v2u o; o.x = pk2(Cst[v2].x, Cst[v2].y); o.y = pk2(Cst[v2].z, Cst[v2].w);
                *(LAS v2u*)(CTn + (16 * (2 * vtp + v2) + l15) * MP + 16 * it + 4 * q) = o;
            }
            if (vtp == 0 && l15 == 0) { v2u o; o.x = pk2(nst.x, nst.y); o.y = pk2(nst.z, nst.w); *(LAS v2u*)(CTn + 64 * MP + 16 * it + 4 * q) = o; }
            m = mnew;
        }
        if (n + 1 < NCH) { images((n + 1) & 1); if (n + 2 < NCH) gload(n + 2); }
    }
    __syncthreads();
}
__device__ __forceinline__ int fwd_row_cm(int b, int c, int t) { return c < 4 ? (T_LAT + b * CTXL + c * 64 + t) : (b * SEQ + t * 64 + (c - 4)); }
__device__ __forceinline__ bf16* blob_row(const Ctx& C, int d, int isw, int b, int c, int h, int r) {
    const int row = fwd_row_cm(b, c, r);
    if (d == 1 && isw) return WSP(bf16, WS_GQ) + (size_t)row * 768 + 512 + h * 64;
    return WSP(bf16, WS_P) + (size_t)row * PLD + OFF_D + (d * 2 + isw) * 256 + h * 64;
}
constexpr int LP = 68;
__device__ __forceinline__ void gdn_solve_units(const Ctx& C, int l) {
    const int lane = C.lane, w = C.wave, pw = w & 1, pi = w >> 1, l15 = lane & 15, q = lane >> 4;
    LAS unsigned char* B0 = C.lds + pi * 28672;
    LAS float* Lm = (LAS float*)B0;
    LAS bf16* Ks = (LAS bf16*)(B0 + 17408);
    LAS float* vec = (LAS float*)(B0 + 17408 + 9216);
    const bf16* P = WSP(const bf16, WS_P); const bf16* gq = WSP(const bf16, WS_GQ);
    const int NU = NB * NH * NCH, per = C.G * 4;
    const int trips = (NU + per - 1) / per;
#pragma unroll 1
    for (int k = 0; k < trips; ++k) {
        int u = k * per + C.wg * 4 + pi; const bool active = u < NU; if (!active) u = NU - 1;
        const int c = u % NCH, h = (u / NCH) & 3, b = u / (NCH * NH);
#pragma unroll 1
        for (int d = 0; d < 2; ++d) {
            const int n = d ? (c < 4 ? 3 - c : 71 - c) : c;
            const float aexp = __expf(C.in[I_GALOG][(l * 2 + d) * NH + h]), dtb = C.in[I_GDTB][(l * 2 + d) * NH + h];
            const int rowl = seqrow_cm(n * 64 + lane, d, b);
            const bf16* pg = P + (size_t)rowl * PLD + OFF_D + 1024 + d * 4 + h;
            const float la = -aexp * softplusf_(bf2f(pg[0]) + dtb), beta = sigmoidf_(bf2f(pg[8]));
            const float gam = wave_incl_sum(la, lane);
            if (pw == 0) { vec[lane] = beta; vec[64 + lane] = gam; }
#pragma unroll
            for (int r = 0; r < 4; ++r) { const int idx = pw * 64 + lane + 128 * r, t = idx >> 3, part = idx & 7;
                *(LAS v4u*)(Ks + t * MP + 8 * part) = *(const v4u*)(gq + (size_t)seqrow_cm(n * 64 + t, d, b) * 768 + 256 + h * 64 + 8 * part); }
            float x[64];
#pragma unroll
            for (int i = 0; i < 64; ++i) x[i] = bf2f(gq[(size_t)seqrow_cm(n * 64 + i, d, b) * 768 + (pw ? 256 : 512) + h * 64 + lane]);
            __syncthreads();
            {
                int tix = 0;
#pragma unroll
                for (int it = 0; it < 4; ++it)
#pragma unroll
                    for (int jt = 0; jt <= it; ++jt, ++tix) if ((tix & 1) == pw) {
                        f32x4 acc = (f32x4){0.f, 0.f, 0.f, 0.f};
#pragma unroll
                        for (int s = 0; s < 2; ++s) acc = mfma16(ld_frag16(Ks + (16 * it + l15) * MP + 32 * s + 8 * q), ld_frag16(Ks + (16 * jt + l15) * MP + 32 * s + 8 * q), acc);
                        const float gj = vec[64 + 16 * jt + l15];
                        const f32x4 bi = *(const LAS f32x4*)(vec + 16 * it + 4 * q), gi = *(const LAS f32x4*)(vec + 64 + 16 * it + 4 * q);
#pragma unroll
                        for (int r = 0; r < 4; ++r) { const int i = 16 * it + 4 * q + r, j = 16 * jt + l15;
                            Lm[i * LP + j] = (j < i) ? bi[r] * acc[r] * __expf(gi[r] - gj) : 0.f; }
                    }
            }
            __syncthreads();
#pragma unroll
            for (int i = 0; i < 64; ++i) {
                const float sc = pw ? vec[i] * __expf(vec[64 + i]) : vec[i];
                float a0 = x[i] * sc, a1 = 0.f;
                int roff = i * LP; if (i >= 2) asm volatile("" : "+v"(roff) : "v"(x[i - 2]));
                const LAS float* lrow = Lm + roff;
#pragma unroll
                for (int j4 = 0; j4 < i; j4 += 4) { const f32x4 lv = *(const LAS f32x4*)(lrow + j4);
                    a0 -= lv.x * x[j4]; if (j4 + 1 < i) a1 -= lv.y * x[j4 + 1]; if (j4 + 2 < i) a0 -= lv.z * x[j4 + 2]; if (j4 + 3 < i) a1 -= lv.w * x[j4 + 3]; }
                x[i] = a0 + a1;
            }
            if (active) { bf16* dst = blob_row(C, d, pw, b, c, h, lane);
#pragma unroll
                for (int g = 0; g < 8; ++g) { v4u o; o.x = pk2(x[8 * g], x[8 * g + 1]); o.y = pk2(x[8 * g + 2], x[8 * g + 3]); o.z = pk2(x[8 * g + 4], x[8 * g + 5]); o.w = pk2(x[8 * g + 6], x[8 * g + 7]);
                    *(v4u*)(dst + 8 * g) = o; } }
            __syncthreads();
        }
    }
}

__device__ __forceinline__ void gdn_chunked(const Ctx& C, int l, int idx) {
    const int d = idx >> 5, b = (idx >> 2) & 7, h = idx & 3, lane = C.lane, w = C.wave, l15 = lane & 15, q = lane >> 4;
    const int it = w & 3, vtp = w >> 2;
    constexpr int IMG = 64 * MP * 2, BUFB = 5 * IMG + 512;
    LAS unsigned char* L0 = C.lds;
    LAS bf16* VnT = (LAS bf16*)(L0 + 2 * BUFB + 2 * IMG);
    const bf16* P = WSP(const bf16, WS_P); const bf16* gq = WSP(const bf16, WS_GQ); bf16* outd = WSP(bf16, WS_OUTD) + (size_t)d * T_ALL * 256;
    const float aexp = __expf(C.in[I_GALOG][(l * 2 + d) * NH + h]), dtb = C.in[I_GDTB][(l * 2 + d) * NH + h];
    const int tt = C.tid >> 3, part = C.tid & 7;
    for (int i = C.tid; i < 2 * IMG / 4; i += NTHR) ((LAS unsigned*)(L0 + 2 * BUFB))[i] = 0u;
    v4u rq, rk, ru, rw; unsigned short rga;
    auto gload = [&](int n) {
        const int c = d ? (n < 4 ? 3 - n : 71 - n) : n;
        const bf16* pp = gq + (size_t)seqrow_cm(n * 64 + tt, d, b) * 768 + h * 64 + 8 * part;
        rq = *(const v4u*)pp; rk = *(const v4u*)(pp + 256);
        ru = *(const v4u*)(blob_row(C, d, 0, b, c, h, tt) + 8 * part); rw = *(const v4u*)(blob_row(C, d, 1, b, c, h, tt) + 8 * part);
        rga = P[(size_t)seqrow_cm(n * 64 + lane, d, b) * PLD + OFF_D + 1024 + d * 4 + h];
    };
    auto images = [&](int bufi) {
        LAS unsigned char* B0 = L0 + bufi * BUFB;
        LAS bf16* Qs = (LAS bf16*)B0; LAS bf16* Ks = Qs + 64 * MP; LAS bf16* KdT = Ks + 64 * MP; LAS bf16* Wi = KdT + 64 * MP; LAS bf16* UT = Wi + 64 * MP; LAS float* vec = (LAS float*)(B0 + 5 * IMG);
        const float la = -aexp * softplusf_(bf2f(rga) + dtb);
        const float gam = wave_incl_sum(la, lane);
        if (w == 0) vec[lane] = gam;
        const float kd = __expf(__shfl(gam, 63) - gam);
        const float kmine = __shfl(kd, 8 * w + (lane >> 3));
        *(LAS v4u*)(Qs + tt * MP + 8 * part) = rq; *(LAS v4u*)(Ks + tt * MP + 8 * part) = rk; *(LAS v4u*)(UT + tt * MP + 8 * part) = ru;
        const unsigned kk[4] = {rk.x, rk.y, rk.z, rk.w}, ww[4] = {rw.x, rw.y, rw.z, rw.w};
#pragma unroll
        for (int e = 0; e < 4; ++e) {
            KdT[(8 * part + 2 * e) * MP + tt] = (bf16)f2bf(bflo(kk[e]) * kmine); KdT[(8 * part + 2 * e + 1) * MP + tt] = (bf16)f2bf(bfhi(kk[e]) * kmine);
            Wi[(8 * part + 2 * e) * MP + tt] = (bf16)(ww[e] & 0xffffu); Wi[(8 * part + 2 * e + 1) * MP + tt] = (bf16)(ww[e] >> 16);
        }
    };
    f32x4 Sst[2]; Sst[0] = Sst[1] = (f32x4){0.f, 0.f, 0.f, 0.f};
    const f32x4 z4 = (f32x4){0.f, 0.f, 0.f, 0.f};
    gload(0); images(0); gload(1);
#pragma unroll 1
    for (int n = 0; n < NCH; ++n) {
        __syncthreads();
        const LAS unsigned char* B0 = L0 + (n & 1) * BUFB;
        const LAS bf16* Qs = (const LAS bf16*)B0; const LAS bf16* Ks = Qs + 64 * MP; const LAS bf16* KdT = Ks + 64 * MP; const LAS bf16* Wi = KdT + 64 * MP; const LAS bf16* UT = Wi + 64 * MP; const LAS float* vec = (const LAS float*)(B0 + 5 * IMG);
        const LAS bf16* ST = (const LAS bf16*)(L0 + 2 * BUFB + (n & 1) * IMG); LAS bf16* STn = (LAS bf16*)(L0 + 2 * BUFB + ((n + 1) & 1) * IMG);
        fragb Qf[2]; Qf[0] = ld_frag16(Qs + (16 * it + l15) * MP + 8 * q); Qf[1] = ld_frag16(Qs + (16 * it + l15) * MP + 32 + 8 * q);
        const float gcol = vec[16 * it + l15]; const int icol = 16 * it + l15;
        f32x4 pt[4];
#pragma unroll
        for (int jt = 0; jt < 4; ++jt) {
            pt[jt] = z4;
            if (jt <= it) {
                const fragb k0 = ld_frag16(Ks + (16 * jt + l15) * MP + 8 * q), k1 = ld_frag16(Ks + (16 * jt + l15) * MP + 32 + 8 * q);
                f32x4 st = mfma16(k0, Qf[0], z4); st = mfma16(k1, Qf[1], st);
                const f32x4 gj = *(const LAS f32x4*)(vec + 16 * jt + 4 * q);
#pragma unroll
                for (int r = 0; r < 4; ++r) { const int j = 16 * jt + 4 * q + r; pt[jt][r] = (j <= icol) ? st[r] * __expf(gcol - gj[r]) : 0.f; }
            }
        }
        fragb Pf[2]; Pf[0] = pack_frag(pt[0], pt[1]); Pf[1] = pack_frag(pt[2], pt[3]);
        const fragb Wf0 = ld_frag16(Wi + (16 * it + l15) * MP + 8 * q), Wf1 = ld_frag16(Wi + (16 * it + l15) * MP + 32 + 8 * q);
        f32x4 Ro[2];
#pragma unroll
        for (int v2 = 0; v2 < 2; ++v2) {
            const int vrow = 16 * (2 * vtp + v2) + l15;
            const fragb s0 = ld_frag16(ST + vrow * MP + 8 * q), s1 = ld_frag16(ST + vrow * MP + 32 + 8 * q);
            f32x4 ws = mfma16(Wf0, s0, z4); ws = mfma16(Wf1, s1, ws);
            Ro[v2] = mfma16(Qf[0], s0, z4); Ro[v2] = mfma16(Qf[1], s1, Ro[v2]);
            const v2u ur = *(const LAS v2u*)(UT + vrow * MP + 16 * it + 4 * q);
            v2u o; o.x = pk2(bflo(ur.x) - ws.x, bfhi(ur.x) - ws.y); o.y = pk2(bflo(ur.y) - ws.z, bfhi(ur.y) - ws.w);
            *(LAS v2u*)(VnT + vrow * MP + 16 * it + 4 * q) = o;
        }
        __syncthreads();
        {
            const f32x4 gi = *(const LAS f32x4*)(vec + 16 * it + 4 * q);
            const float gl = __expf(vec[63]);
            const LAS bf16* kr = KdT + (16 * it + l15) * MP + 4 * q;
            const fragb kt0 = ld_frag8x2(kr, kr + 16), kt1 = ld_frag8x2(kr + 32, kr + 48);
#pragma unroll
            for (int v2 = 0; v2 < 2; ++v2) {
                const int vrow = 16 * (2 * vtp + v2) + l15;
                const LAS bf16* vr = VnT + vrow * MP + 4 * q;
                const fragb n0 = ld_frag8x2(vr, vr + 16), n1 = ld_frag8x2(vr + 32, vr + 48);
                f32x4 o = mfma16(Pf[0], n0, z4); if (it >= 2) o = mfma16(Pf[1], n1, o);
#pragma unroll
                for (int r = 0; r < 4; ++r) { const int row = seqrow_cm(n * 64 + 16 * it + 4 * q + r, d, b);
                    outd[(size_t)row * 256 + h * 64 + vrow] = (bf16)f2bf(o[r] + __expf(gi[r]) * Ro[v2][r]); }
                f32x4 ns = mfma16(kt0, n0, z4); ns = mfma16(kt1, n1, ns);
                Sst[v2] = Sst[v2] * gl + ns;
                v2u so; so.x = pk2(Sst[v2].x, Sst[v2].y); so.y = pk2(Sst[v2].z, Sst[v2].w);
                *(LAS v2u*)(STn + vrow * MP + 16 * it + 4 * q) = so;
            }
        }
        if (n + 1 < NCH) { images((n + 1) & 1); if (n + 2 < NCH) gload(n + 2); }
    }
    __syncthreads();
}
__device__ __forceinline__ void moe_scatter(const Ctx& C, int moe_li, int nrows) {
    const unsigned* gc = WSP(const unsigned, WS_CTL) + CW_MOECNT + 64 * moe_li;
    LAS int* pst = (LAS int*)C.lds;
    {
        int pe[8]; int acc = 0;
#pragma unroll
        for (int e = 0; e < NE; ++e) { const int blks = ((int)gc[e] + 255) >> 8; if (C.tid == e) pst[e] = acc * 256; acc += blks; pe[e] = acc; }
        if (C.wg == 0 && C.tid < MOE_MAXBLK) { int be = 0;
#pragma unroll
            for (int e = 0; e < NE; ++e) be += (pe[e] <= C.tid) ? 1 : 0;
            int* tab = WSP(int, WS_TAB); tab[1 + C.tid] = be < NE ? be : NE - 1; if (C.tid == 0) tab[0] = acc; }
    }
    __syncthreads();
    const unsigned* route = WSP(const unsigned, WS_ROUTE); const unsigned* wgbase = WSP(const unsigned, WS_WGBASE);
    const bf16* hb = WSP(const bf16, WS_HB); bf16* am = WSP(bf16, WS_MIX); int* pos = WSP(int, WS_POS);
    const int gw = C.wg * NWAVES + C.wave, NGW = C.G * NWAVES;
    for (int m = gw; m < nrows; m += NGW) {
        const v4u a = *(const v4u*)(route + (size_t)m * 8);
        const int e0 = (int)a.x, e1 = (int)a.y;
        const int p0 = pst[e0] + (int)wgbase[C.wg * 8 + e0] + (int)a.z, p1 = pst[e1] + (int)wgbase[C.wg * 8 + e1] + (int)a.w;
        const v4u r0 = *(const v4u*)(hb + (size_t)m * 1024 + C.lane * 8), r1 = *(const v4u*)(hb + (size_t)m * 1024 + 512 + C.lane * 8);
        *(v4u*)(am + (size_t)p0 * 1024 + C.lane * 8) = r0; *(v4u*)(am + (size_t)p0 * 1024 + 512 + C.lane * 8) = r1;
        *(v4u*)(am + (size_t)p1 * 1024 + C.lane * 8) = r0; *(v4u*)(am + (size_t)p1 * 1024 + 512 + C.lane * 8) = r1;
        if (C.lane == 0) { pos[(size_t)m * 2] = p0; pos[(size_t)m * 2 + 1] = p1; }
    }
    __syncthreads();
}
__device__ __forceinline__ void moe_combine(const Ctx& C, int l, int nrows) {
    const unsigned* route = WSP(const unsigned, WS_ROUTE); const int* pos = WSP(const int, WS_POS); const bf16* ym = WSP(const bf16, WS_MIX);
    const float* modv = WSP(const float, WS_MODV) + (size_t)l * 9 * 6144 + 5 * 1024;
    float* xc = WSP(float, WS_XC);
    const int gw = C.wg * NWAVES + C.wave, NGW = C.G * NWAVES;
    for (int m = gw; m < nrows; m += NGW) {
        const bool isctx = m >= T_LAT;
        float* xr = isctx ? xc + (size_t)(m - T_LAT) * 1024 : C.out + (size_t)m * 1024;
        const float* gv = modv + (size_t)(isctx ? 8 : (m >> 12)) * 6144;
        const int p0 = pos[(size_t)m * 2], p1 = pos[(size_t)m * 2 + 1];
        const float w0 = __builtin_bit_cast(float, route[(size_t)m * 8 + 4]), w1 = __builtin_bit_cast(float, route[(size_t)m * 8 + 5]);
#pragma unroll
        for (int j = 0; j < 4; ++j) {
            const int col = 4 * C.lane + 256 * j;
            const v2u a = *(const v2u*)(ym + (size_t)p0 * 1024 + col), b = *(const v2u*)(ym + (size_t)p1 * 1024 + col);
            const f32x4 ya = (f32x4){bflo(a.x), bfhi(a.x), bflo(a.y), bfhi(a.y)}, yb = (f32x4){bflo(b.x), bfhi(b.x), bflo(b.y), bfhi(b.y)};
            const f32x4 g = *(const f32x4*)(gv + col); f32x4 x = *(const f32x4*)(xr + col);
            x = x + g * (ya * w0 + yb * w1);
            *(f32x4*)(xr + col) = x;
        }
    }
}
__device__ __forceinline__ void final_norm(const Ctx& C) {
    const int gw = C.wg * NWAVES + C.wave, NGW = C.G * NWAVES;
    f32x4 gv[4];
#pragma unroll
    for (int j = 0; j < 4; ++j) gv[j] = *(const f32x4*)(C.in[I_FNG] + 4 * C.lane + 256 * j);
    for (int m = gw; m < T_LAT; m += NGW) {
        float* xr = C.out + (size_t)m * 1024;
        f32x4 v[4]; float s = 0.f;
#pragma unroll
        for (int j = 0; j < 4; ++j) { v[j] = *(const f32x4*)(xr + 4 * C.lane + 256 * j); s += (v[j].x * v[j].x + v[j].y * v[j].y) + (v[j].z * v[j].z + v[j].w * v[j].w); }
        const float rs = 1.0f / sqrtf(wave_sum(s) * (1.0f / 1024.0f) + 1e-6f);
#pragma unroll
        for (int j = 0; j < 4; ++j) *(f32x4*)(xr + 4 * C.lane + 256 * j) = v[j] * rs * gv[j];
    }
}

constexpr int NPH_L = 12, PH_FINAL = 1 + DEPTH * NPH_L, NPHASE = PH_FINAL + 1;
__host__ __device__ inline bool phase_exists(int ph) {
    if (ph == 0 || ph == PH_FINAL) return true;
    const int l = (ph - 1) / NPH_L, k = (ph - 1) % NPH_L;
    if (!(l & 1) && k >= 10) return false;
    return true;
}
#ifndef PH_MASK
#define PH_MASK 0xFFFFFF
#endif
#define PM(k) ((PH_MASK >> (k)) & 1)
#ifndef SK_MASK
#define SK_MASK 0xFFFF
#endif
#define SK(k) ((SK_MASK >> (k)) & 1)
#ifndef REP_MASK
#define REP_MASK 0
#endif
#define NREP(k) (((REP_MASK >> (k)) & 1) ? 2 : 1)

__global__ void __launch_bounds__(NTHR, 2) fwd_kernel(Args args) {
    extern __shared__ __attribute__((aligned(16))) unsigned char lds_raw[];
    Ctx C; C.in = args.in; C.out = args.out; C.ws = args.ws; C.lds = (LAS unsigned char*)lds_raw;
    C.tid = threadIdx.x; C.lane = C.tid & 63; C.wave = __builtin_amdgcn_readfirstlane(C.tid >> 6); C.G = gridDim.x; C.wg = blockIdx.x;
    volatile LAS unsigned* MISC = (volatile LAS unsigned*)(C.lds + MISC_OFF);
    if (C.tid < 64) MISC[C.tid] = 0u;
    __syncthreads();
    const int lo = args.ph_lo, hi = args.ph_hi;
    const bool multi = (hi - lo) > 1;
    if (multi) (void)xcd_barrier_post(WSP(unsigned, WS_CTL) + CW_BAR, MISC + 8);
#define IN(k) (lo <= (k) && (k) < hi)
#define SEAM(k) do { if (IN((k) + 1)) { XcdBarrier b2_; b2_.bar = WSP(unsigned, WS_CTL) + CW_BAR; b2_.x = xb_xcc_id(); b2_.st = (volatile LAS unsigned*)(C.lds + MISC_OFF) + 8; xcd_barrier(b2_); } } while (0)
#define FRESH() do { int t_ = threadIdx.x; asm volatile("" : "+v"(t_)); C.tid = t_; C.lane = t_ & 63; C.wave = __builtin_amdgcn_readfirstlane(t_ >> 6); } while (0)
#define PHASE(bit, k) if (PM(bit) && IN(pb + (k))) for (int rep_ = 0; rep_ < NREP(bit); ++rep_)

    if (PM(20) && IN(0)) { phase_pre(C); SEAM(0); }

#pragma unroll 1
    for (int l = 0; l < DEPTH; ++l) {
        const int pb = 1 + l * NPH_L;
        if (hi <= pb || lo >= pb + NPH_L) continue;
        const bool last = (l == DEPTH - 1), moe = (l & 1);
        const int nrows = last ? T_LAT : T_ALL;
        const float* xlat = (l == 0) ? C.in[I_X] : C.out; const float* xctx = (l == 0) ? C.in[I_CTX] : WSP(const float, WS_XC);
        const float* modv = WSP(const float, WS_MODV) + (size_t)l * 9 * 6144;

        PHASE(0, 0) { FRESH();
            convert_layer(C, l);
            __syncthreads();
            FRESH(); norm_rows<false>(C, l, xlat, xctx, C.in[I_NMIXG] + l * 1024, 0, 1024, T_ALL, 0);
            SEAM(pb + 0);
        }
        PHASE(1, 1) { FRESH();
            pg8::Gemm g{WSP(const bf16, WS_HB), WSP(const bf16, WS_WIN), T_ALL, PLD, 1024, 0};
            pg8::StaticOrder S; S.init(T_ALL, PLD, C.G, C.wg);
            pg8::EpiBf16<0> E{WSP(bf16, WS_P), PLD, nullptr, 0, 0};
            pg8::gemm_phase<pg8::EpiBf16<0>, pg8::StaticOrder, false>(C.lds, g, S, E, nullptr);
            SEAM(pb + 1);
        }
        PHASE(2, 2) { FRESH();
            FRESH(); if (SK(0)) for (int u = C.wg; u < NB * NCH; u += C.G) lru_chunk<false>(C, l, u / NCH, u % NCH);
            FRESH(); if (SK(1)) for (int u = C.wg; u < NB * NCH; u += C.G) rwkv_prep(C, l, u / NCH, u % NCH);
            FRESH(); if (SK(2)) for (int u = C.wg; u < NB * NCH; u += C.G) gdn_prep(C, l, u / NCH, u % NCH);
            SEAM(pb + 2);
        }
        PHASE(3, 3) { FRESH();
            gdn_solve_units(C, l);
            SEAM(pb + 3);
        }
        PHASE(4, 4) { FRESH();
            if (SK(3) && C.wg < 128) { FRESH(); rwkv_scan(C, l, C.wg); }
            else if (SK(4) && C.wg < 192) { FRESH(); mlstm_chunked(C, l, C.wg - 128); }
            else if (SK(5)) { FRESH(); gdn_chunked(C, l, C.wg - 192); }
            if (SK(6) && C.wg >= 248) lru_carry(C, (C.wg - 248) * NTHR + C.tid);
            SEAM(pb + 4);
        }
        PHASE(5, 5) { FRESH();
            for (int u = C.wg; u < NB * NCH; u += C.G) { const int b = u / NCH, c = u % NCH; if (last && c < 4) continue; if (SK(7)) lru_chunk<true>(C, l, b, c); }
            FRESH(); if (SK(8)) finish_rows(C, l, nrows);
            SEAM(pb + 5);
        }
        if (PM(6) && IN(pb + 6)) { FRESH();
            pg8::Gemm g{WSP(const bf16, WS_HB), WSP(const bf16, WS_WOUT), nrows, 1024, 1024, 0};
            pg8::StaticOrder S; S.init(nrows, 1024, C.G, C.wg);
            pg8::EpiRes E{xlat, xctx, C.out, WSP(float, WS_XC), modv + 2 * 1024};
            pg8::gemm_phase<pg8::EpiRes, pg8::StaticOrder, false>(C.lds, g, S, E, nullptr);
            SEAM(pb + 6);
        }
        if (PM(7) && IN(pb + 7)) { FRESH();
            if (moe) norm_rows<true>(C, l, C.out, WSP(const float, WS_XC), C.in[I_NFFNG] + l * 1024, 3 * 1024, 4 * 1024, nrows, l >> 1);
            else norm_rows<false>(C, l, C.out, WSP(const float, WS_XC), C.in[I_NFFNG] + l * 1024, 3 * 1024, 4 * 1024, nrows, 0);
            SEAM(pb + 7);
        }
        if (!moe) {
            if (PM(8) && IN(pb + 8)) { FRESH();
                pg8::Gemm g{WSP(const bf16, WS_HB), WSP(const bf16, WS_WGU), nrows, 2 * DFF, 1024, 0};
                pg8::StaticOrder S; S.init(nrows, 2 * DFF, C.G, C.wg);
                pg8::EpiSwiglu E{WSP(bf16, WS_P), DFF};
                pg8::gemm_phase<pg8::EpiSwiglu, pg8::StaticOrder, false>(C.lds, g, S, E, nullptr);
                SEAM(pb + 8);
            }
            if (PM(9) && IN(pb + 9)) { FRESH();
                pg8::Gemm g{WSP(const bf16, WS_P), WSP(const bf16, WS_WDN), nrows, 1024, DFF, 0};
                pg8::StaticOrder S; S.init(nrows, 1024, C.G, C.wg);
                pg8::EpiRes E{C.out, WSP(const float, WS_XC), C.out, WSP(float, WS_XC), modv + 5 * 1024};
                pg8::gemm_phase<pg8::EpiRes, pg8::StaticOrder, false>(C.lds, g, S, E, nullptr);
                SEAM(pb + 11);
            }
        } else {
            if (PM(10) && IN(pb + 8)) { FRESH(); moe_scatter(C, l >> 1, nrows); SEAM(pb + 8); }
            if (PM(11) && IN(pb + 9)) { FRESH();
                pg8::Gemm g{WSP(const bf16, WS_MIX), WSP(const bf16, WS_WGU), 0, 2 * DFE, 1024, (size_t)2 * DFE * 1024};
                pg8::MoeOrder S; S.init(WSP(const int, WS_TAB), (2 * DFE) / 256, C.G, C.wg);
                pg8::EpiSwiglu E{WSP(bf16, WS_P), DFE};
                pg8::gemm_phase<pg8::EpiSwiglu, pg8::MoeOrder, false>(C.lds, g, S, E, nullptr);
                SEAM(pb + 9);
            }
            if (PM(12) && IN(pb + 10)) { FRESH();
                pg8::Gemm g{WSP(const bf16, WS_P), WSP(const bf16, WS_WDN), 0, 1024, DFE, (size_t)1024 * DFE};
                pg8::MoeOrder S; S.init(WSP(const int, WS_TAB), 4, C.G, C.wg);
                pg8::EpiBf16<0> E{WSP(bf16, WS_MIX), 1024, nullptr, 0, 0};
                pg8::gemm_phase<pg8::EpiBf16<0>, pg8::MoeOrder, false>(C.lds, g, S, E, nullptr);
                SEAM(pb + 10);
            }
            if (PM(13) && IN(pb + 11)) { FRESH(); moe_combine(C, l, nrows); SEAM(pb + 11); }
        }
    }
    if (PM(21) && IN(PH_FINAL)) final_norm(C);
}

extern "C" void kernel_launch(void* const* d_in, const int* in_sizes, int n_in, void* d_out, int out_size, void* d_ws, size_t ws_size, hipStream_t stream) {
    static int grid = 0;
    if (grid == 0) {
        if (n_in != N_IN || in_sizes[0] != T_LAT * DM || out_size != T_LAT * DM || ws_size < WS_END) {
            fprintf(stderr, "kernel_launch: unexpected problem (n_in %d, in0 %d, out %d, ws %zu < %zu)\n", n_in, n_in > 0 ? in_sizes[0] : -1, out_size, ws_size, (size_t)WS_END); grid = -1; return; }
        int dev = 0, cus = 0, per_cu = 0;
        if (hipGetDevice(&dev) != hipSuccess || hipDeviceGetAttribute(&cus, hipDeviceAttributeMultiprocessorCount, dev) != hipSuccess) { grid = -1; return; }
        if (hipFuncSetAttribute((const void*)fwd_kernel, hipFuncAttributeMaxDynamicSharedMemorySize, LDS_BYTES) != hipSuccess) { fprintf(stderr, "kernel_launch: hipFuncSetAttribute failed\n"); grid = -1; return; }
        if (hipOccupancyMaxActiveBlocksPerMultiprocessor(&per_cu, (const void*)fwd_kernel, NTHR, LDS_BYTES) != hipSuccess || per_cu < 1) { fprintf(stderr, "kernel_launch: occupancy query says %d\n", per_cu); grid = -1; return; }
        grid = cus;
        if (grid != 256) fprintf(stderr, "kernel_launch: note: %d CUs\n", grid);
    }
    if (grid < 0) return;
    if (hipMemsetAsync((char*)d_ws + WS_CTL, 0, CTL_BYTES, stream) != hipSuccess) return;
    Args a{};
    for (int i = 0; i < N_IN; ++i) a.in[i] = (const float*)d_in[i];
    a.out = (float*)d_out; a.ws = (unsigned char*)d_ws;
#if MK_ONE_LAUNCH
    a.ph_lo = 0; a.ph_hi = NPHASE;
    hipLaunchKernelGGL(fwd_kernel, dim3(grid), dim3(NTHR), LDS_BYTES, stream, a);
#else
    for (int ph = 0; ph < NPHASE; ++ph) { if (!phase_exists(ph)) continue; a.ph_lo = ph; a.ph_hi = ph + 1; hipLaunchKernelGGL(fwd_kernel, dim3(grid), dim3(NTHR), LDS_BYTES, stream, a); }
#endif
}
```

```cpp
#define MK_ONE_LAUNCH 1
#include <hip/hip_runtime.h>
#include <cstdio>
#include <cstdint>

#define GAS __attribute__((address_space(1)))
#define LAS __attribute__((address_space(3)))
typedef unsigned short bf16;
typedef unsigned v4u __attribute__((ext_vector_type(4)));
typedef unsigned v2u __attribute__((ext_vector_type(2)));
typedef float f32x4 __attribute__((ext_vector_type(4)));
typedef float f32x2 __attribute__((ext_vector_type(2)));
typedef short bf16x8 __attribute__((ext_vector_type(8)));
#define LDS_WAIT() asm volatile("s_waitcnt lgkmcnt(0)" ::: "memory")
#define VM_WAIT() asm volatile("s_waitcnt vmcnt(0)" ::: "memory")

constexpr int DM = 1024, NB = 8, SEQ = 4096, DEPTH = 4, CTXL = 256, GW = 256, HD = 64, NH = 4;
constexpr int T_LAT = NB * SEQ, T_CTX = NB * CTXL, T_ALL = T_LAT + T_CTX;
constexpr int IN_COLS = 3552, PLD = 3584;
constexpr int OFF_B = 512, OFF_C = 1472, OFF_D = 2512, B_COLS = 960;
constexpr int DFF = 2816, NE = 8, DFE = 1408;
constexpr int NCH = 68;
constexpr int NSTEP = 4352;
constexpr int MOE_MAXBLK = 280;
constexpr int NWAVES = 8, NTHR = 512;

constexpr size_t MiB = 1u << 20;
constexpr size_t WS_CTL = 0, CTL_BYTES = 1 * MiB;
constexpr size_t WS_MODV = 1 * MiB;
constexpr size_t WS_XC = 2 * MiB;
constexpr size_t WS_WIN = 10 * MiB;
constexpr size_t WS_WOUT = 17 * MiB;
constexpr size_t WS_WGU = 19 * MiB;
constexpr size_t WS_WDN = 63 * MiB;
constexpr size_t WS_HB = 85 * MiB;
constexpr size_t WS_P = 153 * MiB;
constexpr size_t WS_MIX = 391 * MiB;
constexpr size_t WS_OUTB = WS_MIX, WS_OUTC = WS_MIX + 34 * MiB, WS_OUTD = WS_MIX + 68 * MiB, WS_GQ = WS_MIX + 102 * MiB, WS_G = WS_MIX + 153 * MiB;
constexpr size_t WS_SMALL = 561 * MiB;
constexpr size_t WS_LSUM = WS_SMALL;
constexpr size_t WS_HIN = WS_SMALL + 3 * MiB;
constexpr size_t WS_ROUTE = WS_SMALL + 5 * MiB;
constexpr size_t WS_POS = WS_SMALL + 7 * MiB;
constexpr size_t WS_BONUS = WS_SMALL + 8 * MiB;
constexpr size_t WS_WGBASE = WS_SMALL + 9 * MiB;
constexpr size_t WS_TAB = WS_WGBASE + 65536;
constexpr size_t WS_LRUWT = WS_SMALL + 10 * MiB;
constexpr size_t WS_END = 572 * MiB;
constexpr int CW_MOECNT = 1024;
constexpr int CW_BAR = 4096;

constexpr int LDS_BYTES = 135168;
constexpr int MISC_OFF = 131072;

__device__ __forceinline__ unsigned f2bf(float f) { unsigned u = __builtin_bit_cast(unsigned, f); return (u + 0x7fffu + ((u >> 16) & 1u)) >> 16; }
__device__ __forceinline__ unsigned pk2(float lo, float hi) { return f2bf(lo) | (f2bf(hi) << 16); }
__device__ __forceinline__ float bf2f(unsigned short v) { return __builtin_bit_cast(float, (unsigned)v << 16); }
__device__ __forceinline__ float bflo(unsigned v) { return __builtin_bit_cast(float, v << 16); }
__device__ __forceinline__ float bfhi(unsigned v) { return __builtin_bit_cast(float, v & 0xffff0000u); }
__device__ __forceinline__ float wave_sum(float v) {
#pragma unroll
    for (int o = 1; o < 64; o <<= 1) v += __shfl_xor(v, o);
    return v;
}
template <int CTRL> __device__ __forceinline__ float dpp_f(float v) { return __builtin_bit_cast(float, __builtin_amdgcn_update_dpp(0, __builtin_bit_cast(int, v), CTRL, 0xF, 0xF, true)); }
__device__ __forceinline__ float row16_sum(float v) {
    v += dpp_f<0xB1>(v);
    v += dpp_f<0x4E>(v);
    v += dpp_f<0x141>(v);
    v += dpp_f<0x140>(v);
    return v;
}
__device__ __forceinline__ float sigmoidf_(float x) { return 1.0f / (1.0f + __expf(-x)); }
__device__ __forceinline__ float softplusf_(float x) { return fmaxf(x, 0.f) + __logf(1.0f + __expf(-fabsf(x))); }
__device__ __forceinline__ float expm1f_(float x) { return x > -0.3f ? x * (1.0f + x * (0.5f + x * (0.16666667f + x * (0.041666668f + x * 0.0083333338f)))) : __expf(x) - 1.0f; }
__device__ __forceinline__ float siluf_(float x) { return x / (1.0f + __expf(-x)); }
__device__ __forceinline__ float tanhf_(float x) { const float e = __expf(2.0f * x); return 1.0f - 2.0f / (e + 1.0f); }
__device__ __forceinline__ float gelu_tanh(float x) { return 0.5f * x * (1.0f + tanhf_(0.7978845608028654f * (x + 0.044715f * x * x * x))); }
#define XB_TMO      128
#define XB_XCNT(j)  (256  + 64 * (j))
#define XB_XSUB(j)  (1280 + 64 * (j))
#define XB_XGEN(j)  (2304 + 64 * (j))
#define XB_TOP      3328
#define XB_TOPGEN   3392
#define XCD_BAR_WORDS 3456
#define XB_SPIN_CAP (1u << 22)

__device__ __forceinline__ unsigned xb_ld(unsigned* p)              { return __hip_atomic_load(p, __ATOMIC_RELAXED, __HIP_MEMORY_SCOPE_AGENT); }
__device__ __forceinline__ unsigned xb_add(unsigned* p, unsigned v) { return __hip_atomic_fetch_add(p, v, __ATOMIC_RELAXED, __HIP_MEMORY_SCOPE_AGENT); }
__device__ __forceinline__ unsigned xb_xcc_id() { return (unsigned)__builtin_amdgcn_s_getreg((3 << 11) | 20) & 0xFu; }
#define XB_SPIN(cond, bar) do { unsigned _sp = 0; while (cond) { __builtin_amdgcn_s_sleep(1); \
    if ((++_sp & 255u) == 0u) { if (xb_ld(&(bar)[XB_TMO])) break; if (_sp > XB_SPIN_CAP) { atomicAdd(&(bar)[XB_TMO], 1u); break; } } } } while (0)

struct XcdBarrier {
    unsigned* bar; unsigned x;
    volatile LAS unsigned* st;
};

__device__ __forceinline__ XcdBarrier xcd_barrier_post(unsigned* bar, volatile LAS unsigned* st) {
    XcdBarrier b; b.bar = bar; b.x = xb_xcc_id(); b.st = st;
    if (threadIdx.x == 0) (void)xb_add(&bar[XB_XCNT(b.x)], 1u);
    return b;
}
__device__ __forceinline__ void xcd_barrier_complete(unsigned* bar, unsigned x, unsigned& nloc, unsigned& nx) {
    const unsigned G = gridDim.x * gridDim.y * gridDim.z;
    unsigned sum, cnt, mine, sp = 0u;
    for (;;) {
        sum = 0u; cnt = 0u; mine = 0u;
#pragma unroll
        for (unsigned j = 0; j < 16; ++j) { const unsigned c = xb_ld(&bar[XB_XCNT(j)]); sum += c; cnt += (c > 0u) ? 1u : 0u; mine = (j == x) ? c : mine; }
        if (sum == G) break;
        __builtin_amdgcn_s_sleep(1);
        if ((++sp & 255u) == 0u) { if (xb_ld(&bar[XB_TMO])) break; if (sp > XB_SPIN_CAP) { atomicAdd(&bar[XB_TMO], 1u); break; } }
    }
    nloc = mine > 0u ? mine : 1u; nx = cnt > 0u ? cnt : 1u;
}

__device__ __forceinline__ void xcd_barrier(const XcdBarrier& b) {
    asm volatile("s_waitcnt vmcnt(0)" ::: "memory");
    __syncthreads();
    if (threadIdx.x == 0) {
        unsigned* bar = b.bar;
        __builtin_amdgcn_s_waitcnt(0);
        unsigned nloc = b.st[0], nx = b.st[1];
        if (nloc == 0u) { xcd_barrier_complete(bar, b.x, nloc, nx); b.st[0] = nloc; b.st[1] = nx; }
        const unsigned old = xb_add(&bar[XB_XSUB(b.x)], 1u);
        const unsigned gen = old / nloc;
        if (old + 1u == (gen + 1u) * nloc) {
            __builtin_amdgcn_fence(__ATOMIC_RELEASE, "agent");
            asm volatile("s_waitcnt vmcnt(0)" ::: "memory");
            const unsigned og = xb_add(&bar[XB_TOP], 1u);
            const unsigned tg = og / nx;
            if (og + 1u == (tg + 1u) * nx) xb_add(&bar[XB_TOPGEN], 1u);
            else XB_SPIN(xb_ld(&bar[XB_TOPGEN]) == tg, bar);
            __builtin_amdgcn_fence(__ATOMIC_ACQUIRE, "agent");
            xb_add(&bar[XB_XGEN(b.x)], 1u);
            asm volatile("s_waitcnt vmcnt(0)" ::: "memory");
        } else {
            XB_SPIN(xb_ld(&bar[XB_XGEN(b.x)]) == gen, bar);
            __builtin_amdgcn_fence(__ATOMIC_ACQUIRE, "agent");
            asm volatile("s_waitcnt vmcnt(0)" ::: "memory");
        }
    }
    __syncthreads();
}

namespace pg8 {
#define PG8_LAS __attribute__((address_space(3)))
typedef unsigned short bf16_t;
typedef short bf16x8 __attribute__((ext_vector_type(8)));
typedef float f32x4 __attribute__((ext_vector_type(4)));
typedef unsigned u32x4 __attribute__((ext_vector_type(4)));
constexpr int BM = 256, BK = 64, HALF = 128, HTB = HALF * BK * 2  , STAGE_BYTES = 8 * HTB, NXCD = 8, WGM = 8;

__host__ __device__ __forceinline__ int lds_byte(int r, int c) { const int st = (r >> 4) * 2 + (c >> 5), rr = r & 15, cc = c & 31, ob = rr * 64 + cc * 2; return st * 1024 + (ob ^ (((ob >> 9) & 1) << 5)); }
__host__ __device__ __forceinline__ void stage_rc(int b, int& R, int& C) { const int st = b / 1024, sb = b % 1024, swz = sb ^ (((sb >> 9) & 1) << 5); R = (st >> 1) * 16 + swz / 64; C = (st & 1) * 32 + (swz % 64) / 2; }
__host__ __device__ __forceinline__ int perm32(int rho) { const int n = rho >> 4, i = rho & 15; return 8 * (i >> 2) + 4 * n + (i & 3); }

struct Unit { int pm, pn, e; };
struct Gemm { const bf16_t* A; const bf16_t* Bt; int M, N, K; size_t estride; };

struct StaticOrder {
    int nM, nN, nwg, G, c;
    __host__ __device__ void init(int M, int N, int G_, int c_) { nM = M / BM; nN = N / BM; nwg = nM * nN; G = G_; c = c_; }
    __host__ __device__ bool next(int i, Unit& u) const {
        const long L = (long)i * G + c; if (L >= nwg) return false;
        int wgid = (int)L; { const int q = nwg / NXCD, r = nwg % NXCD, xcd = wgid % NXCD, off = wgid / NXCD; wgid = (xcd < r ? xcd * (q + 1) : r * (q + 1) + (xcd - r) * q) + off; }
        const int nig = WGM * nN, gid = wgid / nig, fm = gid * WGM, gsz = (nM - fm) < WGM ? (nM - fm) : WGM;
        u.pm = fm + ((wgid % nig) % gsz); u.pn = (wgid % nig) / gsz; u.e = 0; return true;
    }
    __device__ __forceinline__ void a_ready(const Unit&) const {}
    __device__ __forceinline__ void done(const Unit&) const {}
};
__device__ __forceinline__ unsigned cvt_pk_bf16(float lo, float hi) { unsigned r; asm volatile("v_cvt_pk_bf16_f32 %0, %1, %2" : "=v"(r) : "v"(lo), "v"(hi)); return r; }
typedef float f32x2 __attribute__((ext_vector_type(2)));
__device__ __forceinline__ f32x2 gelu_pk(f32x2 v) {
    const f32x2 av = __builtin_elementwise_abs(v), d = av * 0.2316418882f + 1.0f;
    f32x2 t; t.x = __builtin_amdgcn_rcpf(d.x); t.y = __builtin_amdgcn_rcpf(d.y);
    f32x2 q = t * 0.5307027145f + (-0.7265760135f); q = q * t + 0.7107068705f; q = q * t + (-0.142248368f); q = q * t + 0.127414796f; q = q * t;
    const f32x2 s = (v * v) * (-0.72134752044f);
    f32x2 e; e.x = __builtin_amdgcn_exp2f(s.x); e.y = __builtin_amdgcn_exp2f(s.y);
    const f32x2 m = v * (q * e), r = v - m;
    f32x2 o; o.x = v.x < 0.f ? m.x : r.x; o.y = v.y < 0.f ? m.y : r.y; return o;
}

struct EpiF32 {
    static constexpr bool PERM = false, AFTER_DRAIN = false;
    float* C; int ldc; const float* bias;
    __device__ __forceinline__ void operator()(const f32x4 (&acc)[2][2][4][2], const Unit& u, int wr, int wc, int fr, int fq) const {
        const int row0 = u.pm * BM + wr * 64 + fr, col0 = u.pn * BM + wc * 32 + 4 * fq;
        f32x4 bv[2][2];
#pragma unroll
        for (int bj = 0; bj < 2; ++bj)
#pragma unroll
            for (int n = 0; n < 2; ++n) bv[bj][n] = bias ? *(const f32x4*)(bias + col0 + bj * HALF + n * 16) : (f32x4){0.f, 0.f, 0.f, 0.f};
#pragma unroll
        for (int ai = 0; ai < 2; ++ai)
#pragma unroll
            for (int m = 0; m < 4; ++m) { float* rowp = C + (size_t)(row0 + ai * HALF + m * 16) * ldc + col0;
#pragma unroll
                for (int bj = 0; bj < 2; ++bj)
#pragma unroll
                    for (int n = 0; n < 2; ++n) *(f32x4*)(rowp + bj * HALF + n * 16) = acc[ai][bj][m][n] + bv[bj][n]; }
    }
};
template <int ACT  > struct EpiBf16 {
    static constexpr bool PERM = true, AFTER_DRAIN = false;
    bf16_t* O; int ldc; const float* bias; int split_cols; size_t split_stride;
    __device__ __forceinline__ void operator()(const f32x4 (&acc)[2][2][4][2], const Unit& u, int wr, int wc, int fr, int fq) const {
        const int row0 = u.pm * BM + wr * 64 + fr; int colt = u.pn * BM; bf16_t* base = O;
        if (split_cols) { const int t = colt / split_cols; base += (size_t)t * split_stride; colt -= t * split_cols; }
        const int col0 = colt + wc * 32 + 8 * fq, bcol0 = u.pn * BM + wc * 32 + 8 * fq;
        f32x4 bv[2][2];
#pragma unroll
        for (int bj = 0; bj < 2; ++bj)
#pragma unroll
            for (int n = 0; n < 2; ++n) bv[bj][n] = bias ? *(const f32x4*)(bias + bcol0 + bj * HALF + 4 * n) : (f32x4){0.f, 0.f, 0.f, 0.f};
#pragma unroll
        for (int ai = 0; ai < 2; ++ai)
#pragma unroll
            for (int m = 0; m < 4; ++m) { bf16_t* rowp = base + (size_t)(row0 + ai * HALF + m * 16) * ldc + col0;
#pragma unroll
                for (int bj = 0; bj < 2; ++bj) { f32x4 v0 = acc[ai][bj][m][0] + bv[bj][0], v1 = acc[ai][bj][m][1] + bv[bj][1];
                    if (ACT == 1) { f32x2 a = gelu_pk((f32x2){v0[0], v0[1]}), b = gelu_pk((f32x2){v0[2], v0[3]}), c = gelu_pk((f32x2){v1[0], v1[1]}), d = gelu_pk((f32x2){v1[2], v1[3]});
                        v0 = (f32x4){a.x, a.y, b.x, b.y}; v1 = (f32x4){c.x, c.y, d.x, d.y}; }
                    if (ACT == 2) {
#pragma unroll
                        for (int j = 0; j < 4; ++j) { v0[j] = 0.5f * v0[j] * (1.0f + erff(v0[j] * 0.70710678f)); v1[j] = 0.5f * v1[j] * (1.0f + erff(v1[j] * 0.70710678f)); } }
                    u32x4 w; w.x = cvt_pk_bf16(v0[0], v0[1]); w.y = cvt_pk_bf16(v0[2], v0[3]); w.z = cvt_pk_bf16(v1[0], v1[1]); w.w = cvt_pk_bf16(v1[2], v1[3]);
                    *(u32x4*)(rowp + bj * HALF) = w; } }
    }
};

template <class Epi, class Sched, bool STAMP = false>
__device__ __forceinline__ void gemm_phase(PG8_LAS unsigned char* lds, const Gemm g, const Sched& S, const Epi& E, unsigned long long* stamps) {
    int tid_ = threadIdx.x; asm volatile("" : "+v"(tid_));
    const int tid = tid_, wid = __builtin_amdgcn_readfirstlane(tid >> 6), lane = tid & 63, wr = wid >> 2, wc = wid & 3, fr = lane & 15, fq = lane >> 4;
    const int K = g.K, nt = K / BK;
    int ts_lo = 0, ts_hi = 0, nts = 0; const unsigned long long rt_entry = STAMP ? (unsigned long long)wall_clock64() : 0ull;
#define PG8_STAMP() do { if (STAMP && wid == 0 && nts < 64) { const unsigned long long _c = (unsigned long long)clock64(); \
        ts_lo = (lane == nts) ? (int)(unsigned)_c : ts_lo; ts_hi = (lane == nts) ? (int)(unsigned)(_c >> 32) : ts_hi; ++nts; } } while (0)
    PG8_STAMP();
    unsigned voffA[2], voffB[2];
#pragma unroll
    for (int i = 0; i < 2; ++i) { int R, C; stage_rc(tid * 16 + i * 8192, R, C); const int Rb = Epi::PERM ? ((R & ~31) + perm32(R & 31)) : R;
        voffA[i] = (unsigned)(R * K + C) * 2u; voffB[i] = (unsigned)(Rb * K + C) * 2u; }
    const size_t kstep = (size_t)(BK * 2);
    const size_t hstep = (size_t)HALF * K * 2;
    const size_t tstep = 2 * hstep;
    const unsigned ldsw = (unsigned)wid * 1024u;
    const int aoff = lds_byte(wr * 64 + fr, fq * 8), boff = lds_byte(wc * 32 + fr, fq * 8);
#define PG8_SA(b, h) (((b) * 2 + (h)) * HTB)
#define PG8_SB(b, h) ((4 + (b) * 2 + (h)) * HTB)
#define PG8_STAGE(bufoff, gbase, voff) do { _Pragma("unroll") for (int _i = 0; _i < 2; ++_i) \
        __builtin_amdgcn_global_load_lds((const unsigned*)((const char*)(gbase) + (voff)[_i]), (PG8_LAS unsigned*)(lds + (bufoff) + ldsw + _i * 8192), 16, 0, 0); } while (0)
#define PG8_LDA(dst, b, h) do { _Pragma("unroll") for (int m = 0; m < 4; ++m) _Pragma("unroll") for (int k = 0; k < 2; ++k) dst[m][k] = *(const PG8_LAS bf16x8*)(lds + PG8_SA(b, h) + aoff + m * 2048 + k * 1024); } while (0)
#define PG8_LDB(dst, b, h) do { _Pragma("unroll") for (int n = 0; n < 2; ++n) _Pragma("unroll") for (int k = 0; k < 2; ++k) dst[n][k] = *(const PG8_LAS bf16x8*)(lds + PG8_SB(b, h) + boff + n * 2048 + k * 1024); } while (0)
#define PG8_MMA(ai, bj, At, Bt) do { __builtin_amdgcn_s_setprio(1); _Pragma("unroll") for (int m = 0; m < 4; ++m) _Pragma("unroll") for (int n = 0; n < 2; ++n) _Pragma("unroll") for (int k = 0; k < 2; ++k) \
        acc[ai][bj][m][n] = __builtin_amdgcn_mfma_f32_16x16x32_bf16(Bt[n][k], At[m][k], acc[ai][bj][m][n], 0, 0, 0); __builtin_amdgcn_s_setprio(0); } while (0)
#define PG8_WAIT_V(n) asm volatile("s_waitcnt vmcnt(" #n ")" ::: "memory")
#define PG8_WAIT_L(n) asm volatile("s_waitcnt lgkmcnt(" #n ")" ::: "memory")
#define PG8_BAR __builtin_amdgcn_s_barrier()
#define PG8_SCHED __builtin_amdgcn_sched_barrier(0)
    Unit cur, nxt; int ui = 0;
    if (!S.next(0, cur)) return;
    f32x4 acc[2][2][4][2];
#pragma unroll
    for (int a = 0; a < 2; ++a)
#pragma unroll
        for (int b = 0; b < 2; ++b)
#pragma unroll
            for (int m = 0; m < 4; ++m)
#pragma unroll
                for (int n = 0; n < 2; ++n) acc[a][b][m][n] = (f32x4){0.f, 0.f, 0.f, 0.f};
    bf16x8 At[4][2], B0[2][2], B1[2][2];
    const char* cA = (const char*)g.A + (size_t)cur.pm * tstep; const char* cB = (const char*)g.Bt + (size_t)cur.pn * tstep + (size_t)cur.e * g.estride * 2;
    S.a_ready(cur);
    PG8_STAGE(PG8_SB(0, 0), cB, voffB); PG8_STAGE(PG8_SA(0, 0), cA, voffA); PG8_STAGE(PG8_SB(0, 1), cB + hstep, voffB); PG8_STAGE(PG8_SA(0, 1), cA + hstep, voffA);
    if (wr == 1) PG8_BAR;
    PG8_WAIT_V(4); PG8_BAR;
    PG8_STAGE(PG8_SB(1, 0), cB + kstep, voffB); PG8_STAGE(PG8_SA(1, 0), cA + kstep, voffA); PG8_STAGE(PG8_SB(1, 1), cB + hstep + kstep, voffB);
    PG8_WAIT_V(6); PG8_BAR;
    PG8_STAMP();
    for (;;) {
        const bool has_next = S.next(ui + 1, nxt);
        const char* nA = has_next ? (const char*)g.A + (size_t)nxt.pm * tstep : cA; const char* nB = has_next ? (const char*)g.Bt + (size_t)nxt.pn * tstep + (size_t)nxt.e * g.estride * 2 : cB;
        for (int t = 0; t < nt; t += 2) {
            const bool last = (t == nt - 2);
            const char* a1 = cA + (size_t)(t + 1) * kstep;
            const char* a2 = last ? nA : cA + (size_t)(t + 2) * kstep; const char* b2 = last ? nB : cB + (size_t)(t + 2) * kstep;
            const char* a3 = a2 + kstep; const char* b3 = b2 + kstep;
            if (last && has_next) S.a_ready(nxt);
            PG8_LDB(B0, 0, 0); PG8_SCHED; PG8_LDA(At, 0, 0); PG8_STAGE(PG8_SA(1, 1), a1 + hstep, voffA);
            PG8_WAIT_L(8); PG8_BAR; PG8_WAIT_L(0); PG8_MMA(0, 0, At, B0); PG8_BAR; PG8_SCHED;
            PG8_LDB(B1, 0, 1); PG8_STAGE(PG8_SB(0, 0), b2, voffB);
            PG8_BAR; PG8_WAIT_L(0); PG8_MMA(0, 1, At, B1); PG8_BAR;
            PG8_LDA(At, 0, 1); PG8_STAGE(PG8_SA(0, 0), a2, voffA);
            PG8_BAR; PG8_WAIT_L(0); PG8_MMA(1, 0, At, B0); PG8_BAR; PG8_SCHED;
            PG8_STAGE(PG8_SB(0, 1), b2 + hstep, voffB);
            PG8_WAIT_V(6); PG8_BAR; PG8_MMA(1, 1, At, B1); PG8_BAR;
            PG8_LDB(B0, 1, 0); PG8_SCHED; PG8_LDA(At, 1, 0); PG8_STAGE(PG8_SA(0, 1), a2 + hstep, voffA);
            PG8_WAIT_L(8); PG8_BAR; PG8_WAIT_L(0); PG8_MMA(0, 0, At, B0); PG8_BAR; PG8_SCHED;
            PG8_LDB(B1, 1, 1); PG8_STAGE(PG8_SB(1, 0), b3, voffB);
            PG8_BAR; PG8_WAIT_L(0); PG8_MMA(0, 1, At, B1); PG8_BAR;
            PG8_LDA(At, 1, 1); PG8_STAGE(PG8_SA(1, 0), a3, voffA);
            PG8_BAR; PG8_WAIT_L(0); PG8_MMA(1, 0, At, B0); PG8_BAR; PG8_SCHED;
            PG8_STAGE(PG8_SB(1, 1), b3 + hstep, voffB);
            PG8_WAIT_V(6); PG8_BAR; PG8_MMA(1, 1, At, B1); PG8_BAR;
        }
        PG8_STAMP();
        if constexpr (!Epi::AFTER_DRAIN) { E(acc, cur, wr, wc, fr, fq); S.done(cur); }
        PG8_STAMP();
        if (!has_next) break;
#pragma unroll
        for (int a = 0; a < 2; ++a)
#pragma unroll
            for (int b = 0; b < 2; ++b)
#pragma unroll
                for (int m = 0; m < 4; ++m)
#pragma unroll
                    for (int n = 0; n < 2; ++n) acc[a][b][m][n] = (f32x4){0.f, 0.f, 0.f, 0.f};
        cur = nxt; cA = nA; cB = nB; ++ui;
    }
    PG8_WAIT_V(0);
    if (wr == 0) PG8_BAR;
    PG8_BAR;
    if constexpr (Epi::AFTER_DRAIN) { E.fused(acc, cur, wr, wc, fr, fq, lds, wid, lane); S.done(cur); }
    PG8_STAMP();
    if (STAMP && wid == 0) { stamps[lane] = lane < nts ? (((unsigned long long)(unsigned)ts_hi << 32) | (unsigned)ts_lo) : 0ull;
        if (lane == 62) stamps[62] = rt_entry; if (lane == 63) stamps[63] = (unsigned long long)wall_clock64(); }
#undef PG8_STAMP
#undef PG8_SA
#undef PG8_SB
#undef PG8_STAGE
#undef PG8_LDA
#undef PG8_LDB
#undef PG8_MMA
#undef PG8_WAIT_V
#undef PG8_WAIT_L
#undef PG8_BAR
#undef PG8_SCHED
}
}
namespace pg8 {
struct EpiRes {
    static constexpr bool PERM = false, AFTER_DRAIN = false;
    const float* base_lat; const float* base_ctx; float* out_lat; float* out_ctx; const float* gvec;
    __device__ __forceinline__ void operator()(const f32x4 (&acc)[2][2][4][2], const Unit& u, int wr, int wc, int fr, int fq) const {
        const bool isctx = u.pm >= 128;
        const int prow = (isctx ? (u.pm - 128) : u.pm) * BM;
        const float* base = isctx ? base_ctx : base_lat; float* out = isctx ? out_ctx : out_lat;
        const float* gv = gvec + (size_t)(isctx ? 8 : (u.pm >> 4)) * 6144;
        const int row0 = prow + wr * 64 + fr, col0 = u.pn * BM + wc * 32 + 4 * fq;
        f32x4 gvv[2][2];
#pragma unroll
        for (int bj = 0; bj < 2; ++bj)
#pragma unroll
            for (int n = 0; n < 2; ++n) gvv[bj][n] = *(const f32x4*)(gv + col0 + bj * HALF + n * 16);
#pragma unroll
        for (int ai = 0; ai < 2; ++ai)
#pragma unroll
            for (int m = 0; m < 4; ++m) { const size_t off = (size_t)(row0 + ai * HALF + m * 16) * 1024 + col0;
#pragma unroll
                for (int bj = 0; bj < 2; ++bj)
#pragma unroll
                    for (int n = 0; n < 2; ++n) { const f32x4 b = *(const f32x4*)(base + off + bj * HALF + n * 16);
                        *(f32x4*)(out + off + bj * HALF + n * 16) = b + gvv[bj][n] * acc[ai][bj][m][n]; } }
    }
};
struct EpiSwiglu {
    static constexpr bool PERM = true, AFTER_DRAIN = false;
    bf16_t* O; int ldc;
    __device__ __forceinline__ void operator()(const f32x4 (&acc)[2][2][4][2], const Unit& u, int wr, int wc, int fr, int fq) const {
        const int row0 = u.pm * BM + wr * 64 + fr, col0 = u.pn * HALF + wc * 32 + 8 * fq;
#pragma unroll
        for (int ai = 0; ai < 2; ++ai)
#pragma unroll
            for (int m = 0; m < 4; ++m) { bf16_t* rowp = O + (size_t)(row0 + ai * HALF + m * 16) * ldc + col0;
                float h[8];
#pragma unroll
                for (int n = 0; n < 2; ++n)
#pragma unroll
                    for (int j = 0; j < 4; ++j) { const float g = acc[ai][0][m][n][j], up = acc[ai][1][m][n][j]; h[n * 4 + j] = g * __builtin_amdgcn_rcpf(1.0f + __expf(-g)) * up; }
                u32x4 w; w.x = cvt_pk_bf16(h[0], h[1]); w.y = cvt_pk_bf16(h[2], h[3]); w.z = cvt_pk_bf16(h[4], h[5]); w.w = cvt_pk_bf16(h[6], h[7]);
                *(u32x4*)rowp = w; }
    }
};
struct MoeOrder {
    int nN, G, c, nunits; const int* tab;
    __device__ void init(const int* tab_, int nN_, int G_, int c_) { tab = tab_; nN = nN_; G = G_; c = c_; nunits = tab_[0] * nN_; }
    __device__ bool next(int i, Unit& u) const {
        const int L = i * G + c; if (L >= nunits) return false;
        u.pm = L / nN; u.pn = L - u.pm * nN; u.e = tab[1 + u.pm]; return true;
    }
    __device__ __forceinline__ void a_ready(const Unit&) const {}
    __device__ __forceinline__ void done(const Unit&) const {}
};
}
enum { I_X = 0, I_C, I_CTX, I_CCTX, I_MODW, I_MODB, I_NMIXG, I_NFFNG, I_WIN, I_WOUT, I_LCW, I_LCB, I_LWA, I_LBA, I_LWX, I_LBX, I_LLAM,
       I_RMU, I_RWUP, I_RW0, I_RAUP, I_RA0, I_RGUP, I_RKK, I_RKA, I_RRK, I_RLNG, I_RLNB, I_MIB, I_MFB, I_MNG, I_GCW, I_GALOG, I_GDTB, I_GNG,
       I_FWG, I_FWU, I_FWD, I_MROUTER, I_MWG, I_MWU, I_MWD, I_FNG, N_IN };
struct Args { const float* in[N_IN]; float* out; unsigned char* ws; int ph_lo, ph_hi; };
struct Ctx {
    const float* const* in; float* out; unsigned char* ws; LAS unsigned char* lds;
    int tid, lane, wave, G, wg;
};
#define WSP(T, off) ((T*)(C.ws + (off)))

__device__ __forceinline__ int seqrow_raster(int i, int d, int b) {
    if (i < CTXL) { const int p = d ? (CTXL - 1 - i) : i; return T_LAT + b * CTXL + p; }
    const int j = i - CTXL; const int p = d ? (SEQ - 1 - j) : j; return b * SEQ + p;
}
__device__ __forceinline__ int seqrow_cm(int i, int d, int b) {
    if (i < CTXL) { const int p = d ? (CTXL - 1 - i) : i; return T_LAT + b * CTXL + p; }
    const int j = i - CTXL; const int p = d ? (SEQ - 1 - j) : j; return b * SEQ + (p & 63) * 64 + (p >> 6);
}

__device__ __forceinline__ void phase_pre(const Ctx& C) {
    LAS float* sc = (LAS float*)C.lds;
    LAS float* red = sc + 9 * 1024;
    float* modv = WSP(float, WS_MODV);
    bool filled = false;
    for (int it = C.wg; it < DEPTH * 48; it += C.G) {
        if (!filled) {
            for (int i = C.tid; i < 9 * 1024; i += NTHR) { const float v = i < 8192 ? C.in[I_C][i] : C.in[I_CCTX][i - 8192]; sc[i] = siluf_(v); }
            filled = true; __syncthreads();
        }
        const int l = it / 48, jb = it % 48, col = C.tid & 127, kg = C.tid >> 7;
        const float* W = C.in[I_MODW] + (size_t)l * 1024 * 6144 + jb * 128 + col;
        float acc[9];
#pragma unroll
        for (int r = 0; r < 9; ++r) acc[r] = 0.f;
        for (int k = kg * 256; k < kg * 256 + 256; ++k) { const float w = W[(size_t)k * 6144];
#pragma unroll
            for (int r = 0; r < 9; ++r) acc[r] += sc[r * 1024 + k] * w; }
#pragma unroll
        for (int r = 0; r < 9; ++r) red[(kg * 9 + r) * 128 + col] = acc[r];
        __syncthreads();
        for (int i = C.tid; i < 9 * 128; i += NTHR) { const int r = i >> 7, cc = i & 127;
            const float s = red[(0 * 9 + r) * 128 + cc] + red[(1 * 9 + r) * 128 + cc] + red[(2 * 9 + r) * 128 + cc] + red[(3 * 9 + r) * 128 + cc];
            modv[((size_t)l * 9 + r) * 6144 + jb * 128 + cc] = s + C.in[I_MODB][l * 6144 + jb * 128 + cc]; }
        __syncthreads();
    }
}

__device__ __forceinline__ void tr_item(const float* src, size_t ld, int k0, int ns0, bf16* dst, int drow0, int Kd, LAS float* scr, int lane, bool zero) {
    if (!zero) {
#pragma unroll 8
        for (int i = 0; i < 32; ++i) { const int kk = 2 * i + (lane >> 5); scr[kk * 33 + (lane & 31)] = src[(size_t)(k0 + kk) * ld + ns0 + (lane & 31)]; }
    }
    LDS_WAIT(); asm volatile("" ::: "memory");
    const int c = lane & 7;
#pragma unroll
    for (int j = 0; j < 4; ++j) { const int n = (lane >> 3) + 8 * j; const LAS float* s = scr + (8 * c) * 33 + n;
        v4u o; o.x = pk2(s[0 * 33], s[1 * 33]); o.y = pk2(s[2 * 33], s[3 * 33]); o.z = pk2(s[4 * 33], s[5 * 33]); o.w = pk2(s[6 * 33], s[7 * 33]);
        if (zero) o = (v4u){0u, 0u, 0u, 0u};
        *(v4u*)(dst + (size_t)(drow0 + n) * Kd + k0 + 8 * c) = o; }
    LDS_WAIT(); asm volatile("" ::: "memory");
}
__device__ __forceinline__ void convert_layer(const Ctx& C, int l) {
    LAS float* scr = (LAS float*)(C.lds + C.wave * 8704);
    const int gw = C.wg * NWAVES + C.wave, NGW = C.G * NWAVES;
    constexpr int I_IN = 16 * 112, I_OUT = 16 * 32, I_GU = 16 * 176, I_DN = 44 * 32, I_E = 16 * 88 + 22 * 32;
    const bool moe = l & 1; const int li = l >> 1;
    const int nitems = I_IN + I_OUT + (moe ? NE * I_E : (I_GU + I_DN));
    bf16* win = WSP(bf16, WS_WIN); bf16* wout = WSP(bf16, WS_WOUT); bf16* wgu = WSP(bf16, WS_WGU); bf16* wdn = WSP(bf16, WS_WDN);
    {
        bf16* lw = WSP(bf16, WS_LRUWT);
        for (int k = 0; k < 2 * 2 * 4 * 4096 / (128 * NTHR); ++k) {
            const int e = k * 128 * NTHR + C.wg * NTHR + C.tid;
            if (C.wg < 128) {
            const int i = e & 63, j = (e >> 6) & 63, hd = (e >> 12) & 3, g = (e >> 14) & 1, d = e >> 15;
            const float* src = (g ? C.in[I_LWX] : C.in[I_LWA]) + ((size_t)((l * 2 + d) * 4 + hd) * 64 + i) * 64 + j;
            lw[e] = (bf16)f2bf(*src);
            }
        }
    }
    for (int it = gw; it < nitems; it += NGW) {
        int r = it;
        if (r < I_IN) { const int kb = r / 112, nb = r % 112; tr_item(C.in[I_WIN] + (size_t)l * 1024 * IN_COLS, IN_COLS, 64 * kb, 32 * nb, win, 32 * nb, 1024, scr, C.lane, nb == 111); continue; }
        r -= I_IN;
        if (r < I_OUT) { const int kb = r / 32, nb = r % 32; tr_item(C.in[I_WOUT] + (size_t)l * 1024 * 1024, 1024, 64 * kb, 32 * nb, wout, 32 * nb, 1024, scr, C.lane, false); continue; }
        r -= I_OUT;
        if (!moe) {
            if (r < I_GU) { const int kb = r / 176, nb = r % 176, tile = nb >> 3, q = nb & 7;
                const float* src = (q < 4 ? C.in[I_FWG] : C.in[I_FWU]) + (size_t)li * 1024 * DFF;
                tr_item(src, DFF, 64 * kb, tile * 128 + (q & 3) * 32, wgu, 32 * nb, 1024, scr, C.lane, false); continue; }
            r -= I_GU;
            { const int kb = r / 32, nb = r % 32; tr_item(C.in[I_FWD] + (size_t)li * DFF * 1024, 1024, 64 * kb, 32 * nb, wdn, 32 * nb, DFF, scr, C.lane, false); }
        } else {
            const int e = r / I_E; int rr = r % I_E;
            if (rr < 16 * 88) { const int kb = rr / 88, nb = rr % 88, tile = nb >> 3, q = nb & 7;
                const float* src = (q < 4 ? C.in[I_MWG] : C.in[I_MWU]) + ((size_t)li * NE + e) * 1024 * DFE;
                tr_item(src, DFE, 64 * kb, tile * 128 + (q & 3) * 32, wgu + (size_t)e * 2 * DFE * 1024, 32 * nb, 1024, scr, C.lane, false); continue; }
            rr -= 16 * 88;
            { const int kb = rr / 32, nb = rr % 32; tr_item(C.in[I_MWD] + ((size_t)li * NE + e) * DFE * 1024, 1024, 64 * kb, 32 * nb, wdn + (size_t)e * 1024 * DFE, 32 * nb, DFE, scr, C.lane, false); }
        }
    }
}

template <bool ROUTE>
__device__ __forceinline__ void norm_rows(const Ctx& C, int l, const float* xlat, const float* xctx, const float* gain, int shoff, int scoff, int nrows, int moe_li) {
    const float* modv = WSP(float, WS_MODV) + (size_t)l * 9 * 6144;
    bf16* hb = WSP(bf16, WS_HB);
    const int gw = C.wg * NWAVES + C.wave, NGW = C.G * NWAVES;
    LAS unsigned* lcnt = (LAS unsigned*)(C.lds + 65536);
    unsigned* route = WSP(unsigned, WS_ROUTE);
    if (ROUTE) { if (C.tid < 8) lcnt[C.tid] = 0u; __syncthreads(); }
    f32x4 gv[4];
#pragma unroll
    for (int j = 0; j < 4; ++j) gv[j] = *(const f32x4*)(gain + 4 * C.lane + 256 * j);
    for (int m = gw; m < nrows; m += NGW) {
        const bool isctx = m >= T_LAT;
        const float* xr = isctx ? xctx + (size_t)(m - T_LAT) * 1024 : xlat + (size_t)m * 1024;
        const float* mv = modv + (size_t)(isctx ? 8 : (m >> 12)) * 6144;
        f32x4 v[4]; float s = 0.f;
#pragma unroll
        for (int j = 0; j < 4; ++j) { v[j] = *(const f32x4*)(xr + 4 * C.lane + 256 * j); s += (v[j].x * v[j].x + v[j].y * v[j].y) + (v[j].z * v[j].z + v[j].w * v[j].w); }
        const float rs = 1.0f / sqrtf(wave_sum(s) * (1.0f / 1024.0f) + 1e-6f);
#pragma unroll
        for (int j = 0; j < 4; ++j) { const f32x4 sh = *(const f32x4*)(mv + shoff + 4 * C.lane + 256 * j), scl = *(const f32x4*)(mv + scoff + 4 * C.lane + 256 * j);
            v[j] = (v[j] * rs * gv[j]) * (scl + 1.0f) + sh;
            v2u o; o.x = pk2(v[j].x, v[j].y); o.y = pk2(v[j].z, v[j].w);
            *(v2u*)(hb + (size_t)m * 1024 + 4 * C.lane + 256 * j) = o; }
        if (ROUTE) {
            const float* rt = C.in[I_MROUTER] + (size_t)moe_li * 1024 * NE;
            float lg[8];
#pragma unroll
            for (int e = 0; e < 8; ++e) lg[e] = 0.f;
#pragma unroll
            for (int j = 0; j < 4; ++j)
#pragma unroll
                for (int q = 0; q < 4; ++q) { const int k = 4 * C.lane + 256 * j + q; const f32x4 r0 = *(const f32x4*)(rt + (size_t)k * 8), r1 = *(const f32x4*)(rt + (size_t)k * 8 + 4); const float hv = v[j][q];
                    lg[0] += hv * r0.x; lg[1] += hv * r0.y; lg[2] += hv * r0.z; lg[3] += hv * r0.w; lg[4] += hv * r1.x; lg[5] += hv * r1.y; lg[6] += hv * r1.z; lg[7] += hv * r1.w; }
#pragma unroll
            for (int e = 0; e < 8; ++e) lg[e] = wave_sum(lg[e]);
            int e0 = 0; float l0 = lg[0];
#pragma unroll
            for (int e = 1; e < 8; ++e) if (lg[e] > l0) { l0 = lg[e]; e0 = e; }
            int e1 = -1; float l1 = -3.0e38f;
#pragma unroll
            for (int e = 0; e < 8; ++e) if (e != e0 && lg[e] > l1) { l1 = lg[e]; e1 = e; }
            const float w0 = 1.0f / (1.0f + __expf(l1 - l0)), w1 = 1.0f - w0;
            if (C.lane == 0) {
                const unsigned r0 = atomicAdd((unsigned*)&lcnt[e0], 1u), r1 = atomicAdd((unsigned*)&lcnt[e1], 1u);
                v4u a; a.x = (unsigned)e0; a.y = (unsigned)e1; a.z = r0; a.w = r1;
                *(v4u*)(route + (size_t)m * 8) = a;
                v2u b; b.x = __builtin_bit_cast(unsigned, w0); b.y = __builtin_bit_cast(unsigned, w1);
                *(v2u*)(route + (size_t)m * 8 + 4) = b;
            }
        }
    }
    if (ROUTE) {
        __syncthreads();
        if (C.tid < 8) { unsigned* gc = WSP(unsigned, WS_CTL) + CW_MOECNT + 64 * moe_li; const unsigned base = atomicAdd(gc + C.tid, lcnt[C.tid]); WSP(unsigned, WS_WGBASE)[C.wg * 8 + C.tid] = base; }
    }
}
template <bool FIN>
__device__ __forceinline__ void lru_chunk(const Ctx& C, int l, int b, int c) {
    LAS float* U = (LAS float*)C.lds;
    const bf16* P = WSP(const bf16, WS_P);
    const bool isctx = c < 4; const int p0 = isctx ? c * 64 : (c - 4) * 64; const int Lp = isctx ? CTXL : SEQ; const int row0 = isctx ? T_LAT + b * CTXL : b * SEQ;
    const int ch = C.tid & 255, half = C.tid >> 8;
    {
        const float* cw = C.in[I_LCW] + (size_t)l * 4 * GW + ch; const float w0 = cw[0], w1 = cw[GW], w2 = cw[2 * GW], w3 = cw[3 * GW], cb = C.in[I_LCB][l * GW + ch];
        const int t0 = half * 32;
        auto ld = [&](int p) -> float { return (p >= 0 && p < Lp) ? bf2f(P[(size_t)(row0 + p) * PLD + ch]) : 0.f; };
        float xm2 = ld(p0 + t0 - 2), xm1 = ld(p0 + t0 - 1), x0 = ld(p0 + t0);
        for (int t = 0; t < 32; ++t) { const float xp1 = ld(p0 + t0 + t + 1); U[(t0 + t) * 256 + ch] = w0 * xm2 + w1 * xm1 + w2 * x0 + w3 * xp1 + cb; xm2 = xm1; xm1 = x0; x0 = xp1; }
    }
    __syncthreads();
    const int d = half, hd = ch >> 6, jj = ch & 63;
    const float* wa = C.in[I_LWA] + ((size_t)((l * 2 + d) * 4 + hd) * 64) * 64 + jj;
    const float* wx = C.in[I_LWX] + ((size_t)((l * 2 + d) * 4 + hd) * 64) * 64 + jj;
    const float ba = C.in[I_LBA][(l * 2 + d) * GW + ch], bx = C.in[I_LBX][(l * 2 + d) * GW + ch];
    const float sp8 = 8.0f * softplusf_(-C.in[I_LLAM][(l * 2 + d) * GW + ch]);
    const size_t sidx = ((size_t)(b * NCH + c) * 2 + d) * 256 + ch;
    float h = FIN ? WSP(const float, WS_HIN)[sidx] : 0.f, sla = 0.f;
    LAS bf16* H16 = (LAS bf16*)(U + 64 * 256) + d * 64 * 256;
    const int sgn = d ? -1 : 1;
#pragma unroll 1
    for (int g = 0; g < 4; ++g) {
        const int tstart = d ? (63 - g * 16) : g * 16;
        float ar[16], ai[16];
#pragma unroll
        for (int tt = 0; tt < 16; ++tt) { ar[tt] = 0.f; ai[tt] = 0.f; }
        const LAS float* ub = U + tstart * 256 + hd * 64;
#pragma unroll 1
        for (int i = 0; i < 64; i += 4) {
            float a4[4], x4[4];
#pragma unroll
            for (int q = 0; q < 4; ++q) { a4[q] = wa[(i + q) * 64]; x4[q] = wx[(i + q) * 64]; }
#pragma unroll
            for (int tt = 0; tt < 16; ++tt) { const f32x4 uu = *(const LAS f32x4*)(ub + sgn * tt * 256 + i);
                ar[tt] += uu.x * a4[0] + uu.y * a4[1] + uu.z * a4[2] + uu.w * a4[3];
                ai[tt] += uu.x * x4[0] + uu.y * x4[1] + uu.z * x4[2] + uu.w * x4[3]; }
        }
#pragma unroll
        for (int tt = 0; tt < 16; ++tt) {
            const int tok = tstart + sgn * tt;
            const float r = sigmoidf_(ar[tt] + ba), ig = sigmoidf_(ai[tt] + bx);
            const float la = -sp8 * r; const float a = __expf(la);
            const float bb = sqrtf(-expm1f_(2.0f * la)) * (ig * U[tok * 256 + ch]);
            h = a * h + bb; sla += la;
            if (FIN) H16[tok * 256 + ch] = (bf16)f2bf(h);
        }
    }
    if (!FIN) { float* ls = WSP(float, WS_LSUM) + sidx * 2; ls[0] = sla; ls[1] = h; __syncthreads(); return; }
    __syncthreads();
    bf16* yc = WSP(bf16, WS_HB);
    const LAS bf16* H0 = (const LAS bf16*)(U + 64 * 256); const LAS bf16* H1 = H0 + 64 * 256;
    for (int t = half * 32; t < half * 32 + 32; ++t) {
        const size_t row = (size_t)(row0 + p0 + t);
        const float gate = bf2f(P[row * PLD + 256 + ch]);
        yc[row * 1024 + ch] = (bf16)f2bf((bf2f(H0[t * 256 + ch]) + bf2f(H1[t * 256 + ch])) * gelu_tanh(gate));
    }
    __syncthreads();
}
__device__ __forceinline__ void lru_carry(const Ctx& C, int idx) {
    const int ch = idx & 255, d = (idx >> 8) & 1, b = idx >> 9;
    const float* ls = WSP(const float, WS_LSUM); float* hin = WSP(float, WS_HIN);
    float H = 0.f;
    for (int k = 0; k < NCH; ++k) {
        const int c = d ? (k < 4 ? 3 - k : NCH + 3 - k) : k;
        const size_t sidx = ((size_t)(b * NCH + c) * 2 + d) * 256 + ch;
        hin[sidx] = H;
        H = __expf(ls[sidx * 2]) * H + ls[sidx * 2 + 1];
    }
}

__device__ __forceinline__ float rw_shift(const bf16* P, int row0, int p, int Lp, int colB, float mu0, float mu1) {
    const size_t o = (size_t)(row0 + p) * PLD + OFF_B + colB;
    const float x = bf2f(P[o]);
    const float pv = p > 0 ? bf2f(P[o - PLD]) : 0.f, nx = p < Lp - 1 ? bf2f(P[o + PLD]) : 0.f;
    return x + mu0 * (pv - x) + mu1 * (nx - x);
}
__device__ __forceinline__ void rwkv_prep(const Ctx& C, int l, int b, int c) {
    LAS float* XW = (LAS float*)C.lds;
    LAS float* XA = XW + 64 * 64;
    LAS float* XG = XA + 64 * 64;
    const bf16* P = WSP(const bf16, WS_P);
    const bool isctx = c < 4; const int p0 = isctx ? c * 64 : (c - 4) * 64; const int Lp = isctx ? CTXL : SEQ; const int row0 = isctx ? T_LAT + b * CTXL : b * SEQ;
    const float* mu = C.in[I_RMU] + (size_t)l * 2 * B_COLS;
    for (int it = C.tid; it < 64 * 192; it += NTHR) {
        const int t = it / 192, ci = it % 192, colB = 768 + ci;
        const float v = rw_shift(P, row0, p0 + t, Lp, colB, mu[colB], mu[B_COLS + colB]);
        if (ci < 64) XW[t * 64 + ci] = tanhf_(v); else if (ci < 128) XA[t * 64 + ci - 64] = v; else XG[t * 64 + ci - 128] = sigmoidf_(v);
    }
    __syncthreads();
    const int ch = C.tid & 255, half = C.tid >> 8, head = ch >> 6;
    bf16* wa_out = WSP(bf16, WS_HB); bf16* g_out = WSP(bf16, WS_G); float* bonus = WSP(float, WS_BONUS);
    const float* wup = C.in[I_RWUP] + (size_t)l * 2 * 32 * GW + ch;
    const float* aup = C.in[I_RAUP] + (size_t)l * 2 * 32 * GW + ch;
    const float* gup = C.in[I_RGUP] + (size_t)l * 64 * GW + ch;
    const float w00 = C.in[I_RW0][(l * 2 + 0) * GW + ch], w01 = C.in[I_RW0][(l * 2 + 1) * GW + ch];
    const float a00 = C.in[I_RA0][(l * 2 + 0) * GW + ch], a01 = C.in[I_RA0][(l * 2 + 1) * GW + ch];
    const float k_a = C.in[I_RKA][l * GW + ch], r_k = C.in[I_RRK][l * GW + ch];
    const float mur0 = mu[ch], mur1 = mu[B_COLS + ch], muk0 = mu[256 + ch], muk1 = mu[B_COLS + 256 + ch];
#pragma unroll 1
    for (int sub = 0; sub < 2; ++sub) {
        const int t0 = half * 32 + sub * 16;
        float acc[16], av0[16], av1[16];
#pragma unroll
        for (int kind = 0; kind < 4; ++kind) {
            const int d = kind & 1; const bool isw = kind < 2;
            const float* W = (isw ? wup : aup) + (size_t)d * 32 * GW; const LAS float* X = (isw ? XW : XA) + d * 32;
#pragma unroll
            for (int t = 0; t < 16; ++t) acc[t] = 0.f;
            for (int r = 0; r < 32; r += 4) {
                const float g0 = W[(r + 0) * GW], g1 = W[(r + 1) * GW], g2 = W[(r + 2) * GW], g3 = W[(r + 3) * GW];
#pragma unroll
                for (int t = 0; t < 16; ++t) { const f32x4 x = *(const LAS f32x4*)(X + (t0 + t) * 64 + r); acc[t] += x.x * g0 + x.y * g1 + x.z * g2 + x.w * g3; }
            }
#pragma unroll
            for (int t = 0; t < 16; ++t) {
                const size_t row = (size_t)(row0 + p0 + t0 + t);
                float val;
                if (isw) val = __expf(-0.6065306597126334f * sigmoidf_(acc[t] + (d ? w01 : w00)));
                else { val = sigmoidf_(acc[t] + (d ? a01 : a00)); if (d) av1[t] = val; else av0[t] = val; }
                wa_out[row * 1024 + kind * 256 + ch] = (bf16)f2bf(val);
            }
        }
#pragma unroll
        for (int t = 0; t < 16; ++t) acc[t] = 0.f;
        for (int j = 0; j < 64; j += 4) {
            const float g0 = gup[(j + 0) * GW], g1 = gup[(j + 1) * GW], g2 = gup[(j + 2) * GW], g3 = gup[(j + 3) * GW];
#pragma unroll
            for (int t = 0; t < 16; ++t) { const f32x4 x = *(const LAS f32x4*)(XG + (t0 + t) * 64 + j); acc[t] += x.x * g0 + x.y * g1 + x.z * g2 + x.w * g3; }
        }
#pragma unroll
        for (int t = 0; t < 16; ++t) {
            const int p = p0 + t0 + t; const size_t row = (size_t)(row0 + p);
            g_out[row * 256 + ch] = (bf16)f2bf(acc[t]);
            const float rs = rw_shift(P, row0, p, Lp, ch, mur0, mur1), ks = rw_shift(P, row0, p, Lp, 256 + ch, muk0, muk1);
            const float km = ks * (1.0f + (av0[t] - 1.0f) * k_a) + ks * (1.0f + (av1[t] - 1.0f) * k_a);
            const float bs = wave_sum(rs * r_k * km);
            if (C.lane == 0) bonus[row * 4 + head] = bs;
        }
    }
    __syncthreads();
}
__device__ __forceinline__ void rwkv_scan(const Ctx& C, int l, int idx) {
    const int d = idx >> 6, b = (idx >> 3) & 7, h = (idx >> 1) & 3, half = idx & 1;
    LAS float* BUF = (LAS float*)C.lds;
    LAS float* YB = BUF + 2 * 32 * 6 * 64;
    const bf16* P = WSP(const bf16, WS_P); const bf16* WA = WSP(const bf16, WS_HB); bf16* outb = WSP(bf16, WS_OUTB) + (size_t)d * T_ALL * 256;
    const int st = C.tid >> 4, q4 = C.tid & 15, chh = h * 64 + q4 * 4;
    const float* mu = C.in[I_RMU] + (size_t)l * 2 * B_COLS;
    f32x4 mu0[3], mu1[3];
#pragma unroll
    for (int q = 0; q < 3; ++q) { mu0[q] = *(const f32x4*)(mu + q * 256 + chh); mu1[q] = *(const f32x4*)(mu + B_COLS + q * 256 + chh); }
    const f32x4 kk_w = *(const f32x4*)(C.in[I_RKK] + l * GW + chh), ka_w = *(const f32x4*)(C.in[I_RKA] + l * GW + chh);
    v2u gxc[3], gxp[3], gxn[3], gwr, gar;
    auto gload = [&](int nb) {
        const int i = nb * 32 + st;
        const bool isctx = i < CTXL; const int Lp = isctx ? CTXL : SEQ; const int j = isctx ? i : i - CTXL; const int p = d ? (Lp - 1 - j) : j;
        const int row = (isctx ? T_LAT + b * CTXL : b * SEQ) + p;
#pragma unroll
        for (int q = 0; q < 3; ++q) {
            const bf16* pp = P + (size_t)row * PLD + OFF_B + q * 256 + chh;
            gxc[q] = *(const v2u*)pp; gxp[q] = (v2u){0u, 0u}; gxn[q] = (v2u){0u, 0u};
            if (p > 0) gxp[q] = *(const v2u*)(pp - PLD);
            if (p < Lp - 1) gxn[q] = *(const v2u*)(pp + PLD);
        }
        gwr = *(const v2u*)(WA + (size_t)row * 1024 + d * 256 + chh); gar = *(const v2u*)(WA + (size_t)row * 1024 + (2 + d) * 256 + chh);
    };
    auto sfinish = [&](int bufi) {
        f32x4 sh[3];
#pragma unroll
        for (int q = 0; q < 3; ++q) {
            const f32x4 x = (f32x4){bflo(gxc[q].x), bfhi(gxc[q].x), bflo(gxc[q].y), bfhi(gxc[q].y)}, pv = (f32x4){bflo(gxp[q].x), bfhi(gxp[q].x), bflo(gxp[q].y), bfhi(gxp[q].y)}, nx = (f32x4){bflo(gxn[q].x), bfhi(gxn[q].x), bflo(gxn[q].y), bfhi(gxn[q].y)};
            sh[q] = x + mu0[q] * (pv - x) + mu1[q] * (nx - x);
        }
        const f32x4 w = (f32x4){bflo(gwr.x), bfhi(gwr.x), bflo(gwr.y), bfhi(gwr.y)}, a = (f32x4){bflo(gar.x), bfhi(gar.x), bflo(gar.y), bfhi(gar.y)};
        f32x4 kk = sh[1] * kk_w;
        const float ss = row16_sum((kk.x * kk.x + kk.y * kk.y) + (kk.z * kk.z + kk.w * kk.w));
        kk = kk * (1.0f / sqrtf(ss + 1e-6f));
        const f32x4 km = sh[1] * ((a - 1.0f) * ka_w + 1.0f), beta = kk * a;
        LAS float* o = BUF + ((bufi * 32 + st) * 6) * 64 + q4 * 4;
        *(LAS f32x4*)(o + 0 * 64) = sh[0]; *(LAS f32x4*)(o + 1 * 64) = kk; *(LAS f32x4*)(o + 2 * 64) = w; *(LAS f32x4*)(o + 3 * 64) = beta; *(LAS f32x4*)(o + 4 * 64) = km; *(LAS f32x4*)(o + 5 * 64) = sh[2];
    };
    const int rr = C.tid >> 4, jq = C.tid & 15;
    f32x4 s = (f32x4){0.f, 0.f, 0.f, 0.f};
    constexpr int NBLK = NSTEP / 32;
    gload(0); sfinish(0); gload(1);
    __syncthreads();
    for (int nb = 0; nb < NBLK; ++nb) {
        if (nb + 1 < NBLK) { sfinish((nb + 1) & 1); if (nb + 2 < NBLK) gload(nb + 2); }
        const LAS float* bb = BUF + ((nb & 1) * 32) * 6 * 64;
        LAS float* yb = YB + (nb & 1) * 1024;
        const LAS float* o0 = bb + jq * 4; const LAS float* v0 = bb + 5 * 64 + half * 32 + rr;
        f32x4 r4 = *(const LAS f32x4*)(o0), kk = *(const LAS f32x4*)(o0 + 64), wv = *(const LAS f32x4*)(o0 + 128), be = *(const LAS f32x4*)(o0 + 192), km = *(const LAS f32x4*)(o0 + 256);
        float vv = v0[0];
#pragma unroll
        for (int hb = 0; hb < 2; ++hb) {
            float ysel = 0.f;
#pragma unroll
            for (int t16 = 0; t16 < 16; ++t16) {
                const int t = hb * 16 + t16;
                const f32x4 cr = r4, ck = kk, cw = wv, cb = be, cm_ = km; const float cv = vv;
                if (t + 1 < 32) { const LAS float* o = o0 + (t + 1) * 6 * 64;
                    r4 = *(const LAS f32x4*)(o); kk = *(const LAS f32x4*)(o + 64); wv = *(const LAS f32x4*)(o + 128); be = *(const LAS f32x4*)(o + 192); km = *(const LAS f32x4*)(o + 256); vv = v0[(t + 1) * 6 * 64]; }
                const float sk = row16_sum((s.x * ck.x + s.y * ck.y) + (s.z * ck.z + s.w * ck.w));
                s = s * cw - cb * sk + cm_ * cv;
                const float y = row16_sum((s.x * cr.x + s.y * cr.y) + (s.z * cr.z + s.w * cr.w));
                ysel = (jq == t16) ? y : ysel;
            }
            yb[(hb * 16 + jq) * 32 + rr] = ysel;
        }
        __syncthreads();
        {
            const int t = C.tid >> 4, r2 = (C.tid & 15) * 2;
            const int i = nb * 32 + t; const int row = seqrow_raster(i, d, b);
            *(unsigned*)(outb + (size_t)row * 256 + h * 64 + half * 32 + r2) = pk2(yb[t * 32 + r2], yb[t * 32 + r2 + 1]);
        }
    }
    __syncthreads();
}

#define RAW_BARRIER() do { asm volatile("s_waitcnt lgkmcnt(0)" ::: "memory"); __builtin_amdgcn_s_barrier(); asm volatile("" ::: "memory"); } while (0)
__device__ __forceinline__ void mlstm_scan_v0(const Ctx& C, int l, int idx) {
    const int d = idx >> 5, b = (idx >> 2) & 7, h = idx & 3, lane = C.lane, w = C.wave;
    LAS float* PN = (LAS float*)C.lds;
    LAS float* PD = PN + 2 * 8 * 64;
    LAS unsigned char* SB = C.lds + 8192;
    constexpr int SBS = 3 * 4096 + 256;
    const bf16* P = WSP(const bf16, WS_P); bf16* outc = WSP(bf16, WS_OUTC) + (size_t)d * T_ALL * 256;
    const float ib = C.in[I_MIB][(l * 2 + d) * NH + h], fb = C.in[I_MFB][(l * 2 + d) * NH + h];
    const int st_ = C.tid >> 4, part = C.tid & 15;
    auto stage = [&](int nb, int bufi) {
        const int row = seqrow_cm(nb * 32 + st_, d, b);
        const size_t ro = (size_t)row * PLD + OFF_C + h * 64 + part * 4;
        LAS unsigned char* sb = SB + bufi * SBS;
        *(LAS v2u*)(sb + st_ * 128 + part * 8) = *(const v2u*)(P + ro);
        *(LAS v2u*)(sb + 4096 + st_ * 128 + part * 8) = *(const v2u*)(P + ro + 256);
        *(LAS v2u*)(sb + 8192 + st_ * 128 + part * 8) = *(const v2u*)(P + ro + 512);
        if (part == 0) { const size_t rg = (size_t)row * PLD + OFF_C + 1024;
            const float li = bf2f(P[rg + d * 4 + h]) + ib, gf = bf2f(P[rg + 8 + d * 4 + h]) + fb;
            *(LAS f32x2*)(sb + 12288 + st_ * 8) = (f32x2){li, -softplusf_(-gf)}; }
    };
    float Cm[8], nk[8];
#pragma unroll
    for (int k = 0; k < 8; ++k) { Cm[k] = 0.f; nk[k] = 0.f; }
    float m = 0.f;
    stage(0, 0);
    __syncthreads();
    for (int nb = 0; nb < NSTEP / 32; ++nb) {
        if (nb + 1 < NSTEP / 32) stage(nb + 1, (nb + 1) & 1);
        const LAS unsigned char* sb = SB + (nb & 1) * SBS;
#pragma unroll 2
        for (int t = 0; t < 32; ++t) {
            const int i = nb * 32 + t;
            const v4u cq = *(const LAS v4u*)(sb + t * 128 + w * 16), ck = *(const LAS v4u*)(sb + 4096 + t * 128 + w * 16);
            const float vv = bf2f(*(const LAS unsigned short*)(sb + 8192 + t * 128 + lane * 2));
            const f32x2 gt = *(const LAS f32x2*)(sb + 12288 + t * 8);
            const float li = gt.x, lf = gt.y;
            const float mn = fmaxf(lf + m, li), fp = __expf(lf + m - mn), ip = __expf(li - mn);
            const float qf[8] = {bflo(cq.x), bfhi(cq.x), bflo(cq.y), bfhi(cq.y), bflo(cq.z), bfhi(cq.z), bflo(cq.w), bfhi(cq.w)};
            const float kf[8] = {bflo(ck.x), bfhi(ck.x), bflo(ck.y), bfhi(ck.y), bflo(ck.z), bfhi(ck.z), bflo(ck.w), bfhi(ck.w)};
            const float ipv = ip * vv;
            float num = 0.f, den = 0.f;
#pragma unroll
            for (int k = 0; k < 8; ++k) { const float kk = kf[k] * 0.125f; Cm[k] = fp * Cm[k] + ipv * kk; nk[k] = fp * nk[k] + ip * kk; num += Cm[k] * qf[k]; den += nk[k] * qf[k]; }
            m = mn;
            const int pb_ = i & 1;
            PN[(pb_ * 8 + w) * 64 + lane] = num; if (lane == 0) PD[pb_ * 8 + w] = den;
            RAW_BARRIER();
            if (w == 0) {
                float ns = 0.f, ds = 0.f;
#pragma unroll
                for (int ww = 0; ww < 8; ++ww) { ns += PN[(pb_ * 8 + ww) * 64 + lane]; ds += PD[pb_ * 8 + ww]; }
                outc[(size_t)seqrow_cm(i, d, b) * 256 + h * 64 + lane] = (bf16)f2bf(ns / fmaxf(fabsf(ds), __expf(-mn)));
            }
        }
        __syncthreads();
    }
}

__device__ __forceinline__ void gdn_prep(const Ctx& C, int l, int b, int c) {
    const bf16* P = WSP(const bf16, WS_P); bf16* gq = WSP(bf16, WS_GQ);
    const bool isctx = c < 4; const int p0 = isctx ? c * 64 : (c - 4) * 64; const int Lp = isctx ? CTXL : SEQ;
    const int lane = C.lane;
    auto rowof = [&](int p) -> int { return isctx ? (T_LAT + b * CTXL + p) : (b * SEQ + (p & 63) * 64 + (p >> 6)); };
    float cw[4][12], x[4][12];
#pragma unroll
    for (int j = 0; j < 4; ++j)
#pragma unroll
        for (int i = 0; i < 12; ++i) cw[j][i] = C.in[I_GCW][((size_t)l * 4 + j) * 768 + i * 64 + lane];
    const int tb = p0 + C.wave * 8;
    auto ldrow = [&](int p, float (&dst)[12]) {
        if (p >= 0 && p < Lp) { const size_t ro = (size_t)rowof(p) * PLD + OFF_D;
#pragma unroll
            for (int i = 0; i < 12; ++i) dst[i] = bf2f(P[ro + i * 64 + lane]); }
        else {
#pragma unroll
            for (int i = 0; i < 12; ++i) dst[i] = 0.f; }
    };
    ldrow(tb - 2, x[0]); ldrow(tb - 1, x[1]); ldrow(tb, x[2]);
#pragma unroll 1
    for (int t = 0; t < 8; ++t) {
        ldrow(tb + t + 1, x[3]);
        const size_t ro = (size_t)rowof(tb + t) * 768;
#pragma unroll
        for (int i = 0; i < 12; ++i) {
            float v = siluf_(cw[0][i] * x[0][i] + cw[1][i] * x[1][i] + cw[2][i] * x[2][i] + cw[3][i] * x[3][i]);
            if (i < 8) { const float ss = wave_sum(v * v); v *= (1.0f / sqrtf(ss + 1e-6f)) * (i < 4 ? 0.125f : 1.0f); }
            gq[ro + i * 64 + lane] = (bf16)f2bf(v);
        }
#pragma unroll
        for (int i = 0; i < 12; ++i) { x[0][i] = x[1][i]; x[1][i] = x[2][i]; x[2][i] = x[3][i]; }
    }
}
__device__ __forceinline__ void gdn_scan_v0(const Ctx& C, int l, int idx) {
    const int d = idx >> 5, b = (idx >> 2) & 7, h = idx & 3, lane = C.lane, w = C.wave;
    LAS float* PA = (LAS float*)C.lds;
    LAS float* PB = PA + 2 * 8 * 64;
    LAS unsigned char* SB = C.lds + 8192;
    constexpr int SBS = 3 * 4096 + 256;
    const bf16* P = WSP(const bf16, WS_P); const bf16* gq = WSP(const bf16, WS_GQ); bf16* outd = WSP(bf16, WS_OUTD) + (size_t)d * T_ALL * 256;
    const float aexp = __expf(C.in[I_GALOG][(l * 2 + d) * NH + h]), dtb = C.in[I_GDTB][(l * 2 + d) * NH + h];
    const int st_ = C.tid >> 4, part = C.tid & 15;
    auto stage = [&](int nb, int bufi) {
        const int row = seqrow_cm(nb * 32 + st_, d, b);
        const size_t rq = (size_t)row * 768 + h * 64 + part * 4;
        LAS unsigned char* sb = SB + bufi * SBS;
        *(LAS v2u*)(sb + st_ * 128 + part * 8) = *(const v2u*)(gq + rq);
        *(LAS v2u*)(sb + 4096 + st_ * 128 + part * 8) = *(const v2u*)(gq + rq + 256);
        *(LAS v2u*)(sb + 8192 + st_ * 128 + part * 8) = *(const v2u*)(gq + rq + 512);
        if (part == 0) { const size_t ro = (size_t)row * PLD + OFF_D + 1024;
            const float ga = bf2f(P[ro + d * 4 + h]), gb = bf2f(P[ro + 8 + d * 4 + h]);
            *(LAS f32x2*)(sb + 12288 + st_ * 8) = (f32x2){__expf(-aexp * softplusf_(ga + dtb)), sigmoidf_(gb)}; }
    };
    float S[8];
#pragma unroll
    for (int k = 0; k < 8; ++k) S[k] = 0.f;
    stage(0, 0);
    __syncthreads();
    int prow = 0;
    for (int nb = 0; nb < NSTEP / 32; ++nb) {
        if (nb + 1 < NSTEP / 32) stage(nb + 1, (nb + 1) & 1);
        const LAS unsigned char* sb = SB + (nb & 1) * SBS;
#pragma unroll 2
        for (int t = 0; t < 32; ++t) {
            const int i = nb * 32 + t;
            const v4u cq = *(const LAS v4u*)(sb + t * 128 + w * 16), ck = *(const LAS v4u*)(sb + 4096 + t * 128 + w * 16);
            const float vv = bf2f(*(const LAS unsigned short*)(sb + 8192 + t * 128 + lane * 2));
            const f32x2 gt = *(const LAS f32x2*)(sb + 12288 + t * 8);
            const float alpha = gt.x, beta = gt.y;
            const float qf[8] = {bflo(cq.x), bfhi(cq.x), bflo(cq.y), bfhi(cq.y), bflo(cq.z), bfhi(cq.z), bflo(cq.w), bfhi(cq.w)};
            const float kf[8] = {bflo(ck.x), bfhi(ck.x), bflo(ck.y), bfhi(ck.y), bflo(ck.z), bfhi(ck.z), bflo(ck.w), bfhi(ck.w)};
            float ks = 0.f;
#pragma unroll
            for (int k = 0; k < 8; ++k) ks += kf[k] * S[k];
            const int pb_ = i & 1;
            PA[(pb_ * 8 + w) * 64 + lane] = ks;
            RAW_BARRIER();
            if (w == 0 && i > 0) {
                float os = 0.f;
#pragma unroll
                for (int ww = 0; ww < 8; ++ww) os += PB[((pb_ ^ 1) * 8 + ww) * 64 + lane];
                outd[(size_t)prow * 256 + h * 64 + lane] = (bf16)f2bf(os);
            }
            float kS = 0.f;
#pragma unroll
            for (int ww = 0; ww < 8; ++ww) kS += PA[(pb_ * 8 + ww) * 64 + lane];
            const float coef = beta * (vv - alpha * kS);
            float o = 0.f;
#pragma unroll
            for (int k = 0; k < 8; ++k) { S[k] = alpha * S[k] + kf[k] * coef; o += qf[k] * S[k]; }
            PB[(pb_ * 8 + w) * 64 + lane] = o;
            prow = seqrow_cm(i, d, b);
        }
        __syncthreads();
    }
    if (w == 0) {
        float os = 0.f;
#pragma unroll
        for (int ww = 0; ww < 8; ++ww) os += PB[(((NSTEP - 1) & 1) * 8 + ww) * 64 + lane];
        outd[(size_t)prow * 256 + h * 64 + lane] = (bf16)f2bf(os);
    }
    __syncthreads();
}

__device__ __forceinline__ f32x4 ld4bf(const bf16* p) { const v2u a = *(const v2u*)p; return (f32x4){bflo(a.x), bfhi(a.x), bflo(a.y), bfhi(a.y)}; }
__device__ __forceinline__ void st4bf(bf16* p, const f32x4& v) { v2u o; o.x = pk2(v.x, v.y); o.y = pk2(v.z, v.w); *(v2u*)p = o; }
__device__ __forceinline__ void finish_rows(const Ctx& C, int l, int nrows) {
    const bf16* P = WSP(const bf16, WS_P); bf16* yc = WSP(bf16, WS_HB);
    const bf16* ob = WSP(const bf16, WS_OUTB); const bf16* oc = WSP(const bf16, WS_OUTC); const bf16* od = WSP(const bf16, WS_OUTD);
    const bf16* gg = WSP(const bf16, WS_G); const float* bonus = WSP(const float, WS_BONUS);
    const float* mu = C.in[I_RMU] + (size_t)l * 2 * B_COLS;
    const int gw = C.wg * NWAVES + C.wave, NGW = C.G * NWAVES, lane = C.lane, ch = 4 * lane, hh = lane >> 4;
    const f32x4 lng = *(const f32x4*)(C.in[I_RLNG] + l * GW + ch), lnb = *(const f32x4*)(C.in[I_RLNB] + l * GW + ch);
    const f32x4 mng = *(const f32x4*)(C.in[I_MNG] + l * GW + ch), gng = *(const f32x4*)(C.in[I_GNG] + l * GW + ch);
    const f32x4 mu0 = *(const f32x4*)(mu + 512 + ch), mu1 = *(const f32x4*)(mu + B_COLS + 512 + ch);
    const size_t o2 = (size_t)T_ALL * 256;
#pragma unroll 2
    for (int m = gw; m < nrows; m += NGW) {
        const bool isctx = m >= T_LAT; const int Lp = isctx ? CTXL : SEQ; const int p = isctx ? ((m - T_LAT) & (CTXL - 1)) : (m & (SEQ - 1));
        const f32x4 yb = ld4bf(ob + (size_t)m * 256 + ch) + ld4bf(ob + o2 + (size_t)m * 256 + ch);
        const f32x4 ycv = ld4bf(oc + (size_t)m * 256 + ch) + ld4bf(oc + o2 + (size_t)m * 256 + ch);
        const f32x4 yd = ld4bf(od + (size_t)m * 256 + ch) + ld4bf(od + o2 + (size_t)m * 256 + ch);
        const bf16* pr = P + (size_t)m * PLD;
        const f32x4 xv = ld4bf(pr + OFF_B + 512 + ch);
        f32x4 pv = (f32x4){0.f, 0.f, 0.f, 0.f}, nx = pv;
        if (p > 0) pv = ld4bf(pr - PLD + OFF_B + 512 + ch);
        if (p < Lp - 1) nx = ld4bf(pr + PLD + OFF_B + 512 + ch);
        const f32x4 og = ld4bf(pr + OFF_C + 768 + ch), gd = ld4bf(pr + OFF_D + 768 + ch), gr = ld4bf(gg + (size_t)m * 256 + ch);
        const float bn = bonus[(size_t)m * 4 + hh];
        {
            const float mean = row16_sum((yb.x + yb.y) + (yb.z + yb.w)) * (1.0f / 64.0f);
            const f32x4 dl = yb - mean;
            const float var = row16_sum((dl.x * dl.x + dl.y * dl.y) + (dl.z * dl.z + dl.w * dl.w)) * (1.0f / 64.0f);
            const f32x4 yn = dl * (1.0f / sqrtf(var + 64e-5f)) * lng + lnb;
            const f32x4 vs = xv + mu0 * (pv - xv) + mu1 * (nx - xv);
            st4bf(yc + (size_t)m * 1024 + 256 + ch, (yn + vs * bn) * gr);
        }
        {
            const float ms = row16_sum((ycv.x * ycv.x + ycv.y * ycv.y) + (ycv.z * ycv.z + ycv.w * ycv.w)) * (1.0f / 64.0f);
            const f32x4 sg = (f32x4){sigmoidf_(og.x), sigmoidf_(og.y), sigmoidf_(og.z), sigmoidf_(og.w)};
            st4bf(yc + (size_t)m * 1024 + 512 + ch, ycv * (1.0f / sqrtf(ms + 1e-6f)) * mng * sg);
        }
        {
            const float ms = row16_sum((yd.x * yd.x + yd.y * yd.y) + (yd.z * yd.z + yd.w * yd.w)) * (1.0f / 64.0f);
            const f32x4 sg = (f32x4){siluf_(gd.x), siluf_(gd.y), siluf_(gd.z), siluf_(gd.w)};
            st4bf(yc + (size_t)m * 1024 + 768 + ch, yd * (1.0f / sqrtf(ms + 1e-6f)) * gng * sg);
        }
    }
}
typedef bf16x8 fragb;
__device__ __forceinline__ f32x4 mfma16(fragb a, fragb b, f32x4 c) { return __builtin_amdgcn_mfma_f32_16x16x32_bf16(a, b, c, 0, 0, 0); }
__device__ __forceinline__ fragb ld_frag16(const LAS bf16* p) { return *(const LAS fragb*)p; }
__device__ __forceinline__ fragb ld_frag8x2(const LAS bf16* p0, const LAS bf16* p1) {
    const v2u a = *(const LAS v2u*)p0, b = *(const LAS v2u*)p1; v4u r; r.x = a.x; r.y = a.y; r.z = b.x; r.w = b.y; return __builtin_bit_cast(fragb, r); }
__device__ __forceinline__ fragb pack_frag(const f32x4& lo, const f32x4& hi) { v4u r; r.x = pk2(lo.x, lo.y); r.y = pk2(lo.z, lo.w); r.z = pk2(hi.x, hi.y); r.w = pk2(hi.z, hi.w); return __builtin_bit_cast(fragb, r); }
__device__ __forceinline__ float wave_incl_sum(float v, int lane) {
#pragma unroll
    for (int o = 1; o < 64; o <<= 1) { const float y = __shfl_up(v, o); if (lane >= o) v += y; }
    return v;
}
__device__ __forceinline__ float wave_incl_max(float v, int lane) {
#pragma unroll
    for (int o = 1; o < 64; o <<= 1) { const float y = __shfl_up(v, o); if (lane >= o) v = fmaxf(v, y); }
    return v;
}
constexpr int MP = 72;
__device__ __forceinline__ void mlstm_chunked(const Ctx& C, int l, int idx) {
    const int d = idx >> 5, b = (idx >> 2) & 7, h = idx & 3, lane = C.lane, w = C.wave, l15 = lane & 15, q = lane >> 4;
    const int it = w & 3, vtp = w >> 2;
    constexpr int IMG = 64 * MP * 2, BUFB = 4 * IMG + 1024, CTB = 65 * MP * 2 + 16;
    LAS unsigned char* L0 = C.lds;
    const bf16* P = WSP(const bf16, WS_P); bf16* outc = WSP(bf16, WS_OUTC) + (size_t)d * T_ALL * 256;
    const float ib = C.in[I_MIB][(l * 2 + d) * NH + h], fb = C.in[I_MFB][(l * 2 + d) * NH + h];
    const int tt = C.tid >> 3, part = C.tid & 7;
    for (int i = C.tid; i < 2 * CTB / 4; i += NTHR) ((LAS unsigned*)(L0 + 2 * BUFB))[i] = 0u;
    v4u rq, rk, rv; unsigned short rgi, rgf;
    auto gload = [&](int n) {
        const int row = seqrow_cm(n * 64 + tt, d, b);
        const bf16* pp = P + (size_t)row * PLD + OFF_C + h * 64 + 8 * part;
        rq = *(const v4u*)pp; rk = *(const v4u*)(pp + 256); rv = *(const v4u*)(pp + 512);
        const bf16* pg = P + (size_t)seqrow_cm(n * 64 + lane, d, b) * PLD + OFF_C + 1024 + d * 4 + h;
        rgi = pg[0]; rgf = pg[8];
    };
    auto images = [&](int bufi) {
        LAS unsigned char* B0 = L0 + bufi * BUFB;
        LAS bf16* Qs = (LAS bf16*)B0; LAS bf16* Ks = Qs + 64 * MP; LAS bf16* VT = Ks + 64 * MP; LAS bf16* KTw = VT + 64 * MP; LAS float* vec = (LAS float*)(B0 + 4 * IMG);
        const float li = bf2f(rgi) + ib, lf = -softplusf_(-(bf2f(rgf) + fb));
        const float bc = wave_incl_sum(lf, lane), x = li - bc, cm = wave_incl_max(x, lane);
        const float wl = __expf(x - __shfl(cm, 63)) * 0.125f;
        if (w == 0) { vec[lane] = x; vec[64 + lane] = cm; vec[128 + lane] = bc; }
        const float wmine = __shfl(wl, 8 * w + (lane >> 3));
        *(LAS v4u*)(Qs + tt * MP + 8 * part) = rq; *(LAS v4u*)(Ks + tt * MP + 8 * part) = rk;
        const unsigned vv[4] = {rv.x, rv.y, rv.z, rv.w}, kk[4] = {rk.x, rk.y, rk.z, rk.w};
#pragma unroll
        for (int e = 0; e < 4; ++e) {
            VT[(8 * part + 2 * e) * MP + tt] = (bf16)(vv[e] & 0xffffu); VT[(8 * part + 2 * e + 1) * MP + tt] = (bf16)(vv[e] >> 16);
            KTw[(8 * part + 2 * e) * MP + tt] = (bf16)f2bf(bflo(kk[e]) * wmine); KTw[(8 * part + 2 * e + 1) * MP + tt] = (bf16)f2bf(bfhi(kk[e]) * wmine);
        }
    };
    f32x4 Cst[2], nst; float m = 0.f;
    Cst[0] = Cst[1] = nst = (f32x4){0.f, 0.f, 0.f, 0.f};
    const fragb ones = __builtin_bit_cast(fragb, (v4u){0x3F803F80u, 0x3F803F80u, 0x3F803F80u, 0x3F803F80u});
    const f32x4 z4 = (f32x4){0.f, 0.f, 0.f, 0.f};
    gload(0); images(0); gload(1);
#pragma unroll 1
    for (int n = 0; n < NCH; ++n) {
        __syncthreads();
        const LAS unsigned char* B0 = L0 + (n & 1) * BUFB;
        const LAS bf16* Qs = (const LAS bf16*)B0; const LAS bf16* Ks = Qs + 64 * MP; const LAS bf16* VT = Ks + 64 * MP; const LAS bf16* KTw = VT + 64 * MP; const LAS float* vec = (const LAS float*)(B0 + 4 * IMG);
        const LAS bf16* CT = (const LAS bf16*)(L0 + 2 * BUFB + (n & 1) * CTB); LAS bf16* CTn = (LAS bf16*)(L0 + 2 * BUFB + ((n + 1) & 1) * CTB);
        fragb Qf[2]; Qf[0] = ld_frag16(Qs + (16 * it + l15) * MP + 8 * q); Qf[1] = ld_frag16(Qs + (16 * it + l15) * MP + 32 + 8 * q);
        const float cmi = vec[64 + 16 * it + l15]; const int icol = 16 * it + l15;
        f32x4 pt[4];
#pragma unroll
        for (int jt = 0; jt < 4; ++jt) {
            pt[jt] = z4;
            if (jt <= it) {
                const fragb k0 = ld_frag16(Ks + (16 * jt + l15) * MP + 8 * q), k1 = ld_frag16(Ks + (16 * jt + l15) * MP + 32 + 8 * q);
                f32x4 st = mfma16(k0, Qf[0], z4); st = mfma16(k1, Qf[1], st);
                const f32x4 xj = *(const LAS f32x4*)(vec + 16 * jt + 4 * q);
#pragma unroll
                for (int r = 0; r < 4; ++r) { const int j = 16 * jt + 4 * q + r; pt[jt][r] = (j <= icol) ? st[r] * __expf(xj[r] - cmi) * 0.125f : 0.f; }
            }
        }
        fragb Pf[2]; Pf[0] = pack_frag(pt[0], pt[1]); Pf[1] = pack_frag(pt[2], pt[3]);
        fragb Vf[2][2];
#pragma unroll
        for (int v2 = 0; v2 < 2; ++v2)
#pragma unroll
            for (int s = 0; s < 2; ++s) { const LAS bf16* vr = VT + (16 * (2 * vtp + v2) + l15) * MP + 32 * s + 4 * q; Vf[v2][s] = ld_frag8x2(vr, vr + 16); }
        f32x4 Aacc[2], R[2], as, dn;
        as = mfma16(Pf[0], ones, z4); if (it >= 2) as = mfma16(Pf[1], ones, as);
        const fragb nf0 = ld_frag16(CT + 64 * MP + 8 * q), nf1 = ld_frag16(CT + 64 * MP + 32 + 8 * q);
        dn = mfma16(Qf[0], nf0, z4); dn = mfma16(Qf[1], nf1, dn);
#pragma unroll
        for (int v2 = 0; v2 < 2; ++v2) {
            Aacc[v2] = mfma16(Pf[0], Vf[v2][0], z4); if (it >= 2) Aacc[v2] = mfma16(Pf[1], Vf[v2][1], Aacc[v2]);
            const LAS bf16* cr = CT + (16 * (2 * vtp + v2) + l15) * MP + 8 * q;
            R[v2] = mfma16(Qf[0], ld_frag16(cr), z4); R[v2] = mfma16(Qf[1], ld_frag16(cr + 32), R[v2]);
        }
        {
            const f32x4 bi = *(const LAS f32x4*)(vec + 128 + 16 * it + 4 * q), cmr = *(const LAS f32x4*)(vec + 64 + 16 * it + 4 * q);
#pragma unroll
            for (int r = 0; r < 4; ++r) {
                const float mi = bi[r] + cmr[r], minter = bi[r] + m, mt = fmaxf(minter, mi), e1 = __expf(mi - mt), e2 = __expf(minter - mt);
                const float den = e1 * as[r] + e2 * dn[r]; const float inv = 1.0f / fmaxf(fabsf(den), __expf(-mt));
                const int row = seqrow_cm(n * 64 + 16 * it + 4 * q + r, d, b);
#pragma unroll
                for (int v2 = 0; v2 < 2; ++v2) outc[(size_t)row * 256 + h * 64 + 16 * (2 * vtp + v2) + l15] = (bf16)f2bf((e1 * Aacc[v2][r] + e2 * R[v2][r]) * inv);
            }
        }
        {
            const LAS bf16* kr = KTw + (16 * it + l15) * MP + 4 * q;
            const fragb kt0 = ld_frag8x2(kr, kr + 16), kt1 = ld_frag8x2(kr + 32, kr + 48);
            const float bL = vec[128 + 63], mloc = bL + vec[64 + 63];
            const float mnew = fmaxf(bL + m, mloc), wp = __expf(bL + m - mnew), wn = __expf(mloc - mnew);
            f32x4 gk = mfma16(kt0, ones, z4); gk = mfma16(kt1, ones, gk);
            nst = nst * wp + gk * wn;
#pragma unroll
            for (int v2 = 0; v2 < 2; ++v2) {
                f32x4 G = mfma16(kt0, Vf[v2][0], z4); G = mfma16(kt1, Vf[v2][1], G);
                Cst[v2] = Cst[v2] * wp + G * wn;
                v2u o; o.x = pk2(Cst[v2].x, Cst[v2].y); o.y = pk2(Cst[v2].z, Cst[v2].w);
                *(LAS v2u*)(CTn + (16 * (2 * vtp + v2) + l15) * MP + 16 * it + 4 * q) = o;
            }
            if (vtp == 0 && l15 == 0) { v2u o; o.x = pk2(nst.x, nst.y); o.y = pk2(nst.z, nst.w); *(LAS v2u*)(CTn + 64 * MP + 16 * it + 4 * q) = o; }
            m = mnew;
        }
        if (n + 1 < NCH) { images((n + 1) & 1); if (n + 2 < NCH) gload(n + 2); }
    }
    __syncthreads();
}
__device__ __forceinline__ int fwd_row_cm(int b, int c, int t) { return c < 4 ? (T_LAT + b * CTXL + c * 64 + t) : (b * SEQ + t * 64 + (c - 4)); }
__device__ __forceinline__ bf16* blob_row(const Ctx& C, int d, int isw, int b, int c, int h, int r) {
    const int row = fwd_row_cm(b, c, r);
    if (d == 1 && isw) return WSP(bf16, WS_GQ) + (size_t)row * 768 + 512 + h * 64;
    return WSP(bf16, WS_P) + (size_t)row * PLD + OFF_D + (d * 2 + isw) * 256 + h * 64;
}
constexpr int LP = 68;
__device__ __forceinline__ void gdn_solve_units(const Ctx& C, int l) {
    const int lane = C.lane, w = C.wave, pw = w & 1, pi = w >> 1, l15 = lane & 15, q = lane >> 4;
    LAS unsigned char* B0 = C.lds + pi * 28672;
    LAS float* Lm = (LAS float*)B0;
    LAS bf16* Ks = (LAS bf16*)(B0 + 17408);
    LAS float* vec = (LAS float*)(B0 + 17408 + 9216);
    const bf16* P = WSP(const bf16, WS_P); const bf16* gq = WSP(const bf16, WS_GQ);
    const int NU = NB * NH * NCH, per = C.G * 4;
    const int trips = (NU + per - 1) / per;
#pragma unroll 1
    for (int k = 0; k < trips; ++k) {
        int u = k * per + C.wg * 4 + pi; const bool active = u < NU; if (!active) u = NU - 1;
        const int c = u % NCH, h = (u / NCH) & 3, b = u / (NCH * NH);
#pragma unroll 1
        for (int d = 0; d < 2; ++d) {
            const int n = d ? (c < 4 ? 3 - c : 71 - c) : c;
            const float aexp = __expf(C.in[I_GALOG][(l * 2 + d) * NH + h]), dtb = C.in[I_GDTB][(l * 2 + d) * NH + h];
            const int rowl = seqrow_cm(n * 64 + lane, d, b);
            const bf16* pg = P + (size_t)rowl * PLD + OFF_D + 1024 + d * 4 + h;
            const float la = -aexp * softplusf_(bf2f(pg[0]) + dtb), beta = sigmoidf_(bf2f(pg[8]));
            const float gam = wave_incl_sum(la, lane);
            if (pw == 0) { vec[lane] = beta; vec[64 + lane] = gam; }
#pragma unroll
            for (int r = 0; r < 4; ++r) { const int idx = pw * 64 + lane + 128 * r, t = idx >> 3, part = idx & 7;
                *(LAS v4u*)(Ks + t * MP + 8 * part) = *(const v4u*)(gq + (size_t)seqrow_cm(n * 64 + t, d, b) * 768 + 256 + h * 64 + 8 * part); }
            float x[64];
#pragma unroll
            for (int i = 0; i < 64; ++i) x[i] = bf2f(gq[(size_t)seqrow_cm(n * 64 + i, d, b) * 768 + (pw ? 256 : 512) + h * 64 + lane]);
            __syncthreads();
            {
                int tix = 0;
#pragma unroll
                for (int it = 0; it < 4; ++it)
#pragma unroll
                    for (int jt = 0; jt <= it; ++jt, ++tix) if ((tix & 1) == pw) {
                        f32x4 acc = (f32x4){0.f, 0.f, 0.f, 0.f};
#pragma unroll
                        for (int s = 0; s < 2; ++s) acc = mfma16(ld_frag16(Ks + (16 * it + l15) * MP + 32 * s + 8 * q), ld_frag16(Ks + (16 * jt + l15) * MP + 32 * s + 8 * q), acc);
                        const float gj = vec[64 + 16 * jt + l15];
                        const f32x4 bi = *(const LAS f32x4*)(vec + 16 * it + 4 * q), gi = *(const LAS f32x4*)(vec + 64 + 16 * it + 4 * q);
#pragma unroll
                        for (int r = 0; r < 4; ++r) { const int i = 16 * it + 4 * q + r, j = 16 * jt + l15;
                            Lm[i * LP + j] = (j < i) ? bi[r] * acc[r] * __expf(gi[r] - gj) : 0.f; }
                    }
            }
            __syncthreads();
#pragma unroll
            for (int i = 0; i < 64; ++i) {
                const float sc = pw ? vec[i] * __expf(vec[64 + i]) : vec[i];
                float a0 = x[i] * sc, a1 = 0.f;
                int roff = i * LP; if (i >= 2) asm volatile("" : "+v"(roff) : "v"(x[i - 2]));
                const LAS float* lrow = Lm + roff;
#pragma unroll
                for (int j4 = 0; j4 < i; j4 += 4) { const f32x4 lv = *(const LAS f32x4*)(lrow + j4);
                    a0 -= lv.x * x[j4]; if (j4 + 1 < i) a1 -= lv.y * x[j4 + 1]; if (j4 + 2 < i) a0 -= lv.z * x[j4 + 2]; if (j4 + 3 < i) a1 -= lv.w * x[j4 + 3]; }
                x[i] = a0 + a1;
            }
            if (active) { bf16* dst = blob_row(C, d, pw, b, c, h, lane);
#pragma unroll
                for (int g = 0; g < 8; ++g) { v4u o; o.x = pk2(x[8 * g], x[8 * g + 1]); o.y = pk2(x[8 * g + 2], x[8 * g + 3]); o.z = pk2(x[8 * g + 4], x[8 * g + 5]); o.w = pk2(x[8 * g + 6], x[8 * g + 7]);
                    *(v4u*)(dst + 8 * g) = o; } }
            __syncthreads();
        }
    }
}

__device__ __forceinline__ void gdn_chunked(const Ctx& C, int l, int idx) {
    const int d = idx >> 5, b = (idx >> 2) & 7, h = idx & 3, lane = C.lane, w = C.wave, l15 = lane & 15, q = lane >> 4;
    const int it = w & 3, vtp = w >> 2;
    constexpr int IMG = 64 * MP * 2, BUFB = 5 * IMG + 512;
    LAS unsigned char* L0 = C.lds;
    LAS bf16* VnT = (LAS bf16*)(L0 + 2 * BUFB + 2 * IMG);
    const bf16* P = WSP(const bf16, WS_P); const bf16* gq = WSP(const bf16, WS_GQ); bf16* outd = WSP(bf16, WS_OUTD) + (size_t)d * T_ALL * 256;
    const float aexp = __expf(C.in[I_GALOG][(l * 2 + d) * NH + h]), dtb = C.in[I_GDTB][(l * 2 + d) * NH + h];
    const int tt = C.tid >> 3, part = C.tid & 7;
    for (int i = C.tid; i < 2 * IMG / 4; i += NTHR) ((LAS unsigned*)(L0 + 2 * BUFB))[i] = 0u;
    v4u rq, rk, ru, rw; unsigned short rga;
    auto gload = [&](int n) {
        const int c = d ? (n < 4 ? 3 - n : 71 - n) : n;
        const bf16* pp = gq + (size_t)seqrow_cm(n * 64 + tt, d, b) * 768 + h * 64 + 8 * part;
        rq = *(const v4u*)pp; rk = *(const v4u*)(pp + 256);
        ru = *(const v4u*)(blob_row(C, d, 0, b, c, h, tt) + 8 * part); rw = *(const v4u*)(blob_row(C, d, 1, b, c, h, tt) + 8 * part);
        rga = P[(size_t)seqrow_cm(n * 64 + lane, d, b) * PLD + OFF_D + 1024 + d * 4 + h];
    };
    auto images = [&](int bufi) {
        LAS unsigned char* B0 = L0 + bufi * BUFB;
        LAS bf16* Qs = (LAS bf16*)B0; LAS bf16* Ks = Qs + 64 * MP; LAS bf16* KdT = Ks + 64 * MP; LAS bf16* Wi = KdT + 64 * MP; LAS bf16* UT = Wi + 64 * MP; LAS float* vec = (LAS float*)(B0 + 5 * IMG);
        const float la = -aexp * softplusf_(bf2f(rga) + dtb);
        const float gam = wave_incl_sum(la, lane);
        if (w == 0) vec[lane] = gam;
        const float kd = __expf(__shfl(gam, 63) - gam);
        const float kmine = __shfl(kd, 8 * w + (lane >> 3));
        *(LAS v4u*)(Qs + tt * MP + 8 * part) = rq; *(LAS v4u*)(Ks + tt * MP + 8 * part) = rk; *(LAS v4u*)(UT + tt * MP + 8 * part) = ru;
        const unsigned kk[4] = {rk.x, rk.y, rk.z, rk.w}, ww[4] = {rw.x, rw.y, rw.z, rw.w};
#pragma unroll
        for (int e = 0; e < 4; ++e) {
            KdT[(8 * part + 2 * e) * MP + tt] = (bf16)f2bf(bflo(kk[e]) * kmine); KdT[(8 * part + 2 * e + 1) * MP + tt] = (bf16)f2bf(bfhi(kk[e]) * kmine);
            Wi[(8 * part + 2 * e) * MP + tt] = (bf16)(ww[e] & 0xffffu); Wi[(8 * part + 2 * e + 1) * MP + tt] = (bf16)(ww[e] >> 16);
        }
    };
    f32x4 Sst[2]; Sst[0] = Sst[1] = (f32x4){0.f, 0.f, 0.f, 0.f};
    const f32x4 z4 = (f32x4){0.f, 0.f, 0.f, 0.f};
    gload(0); images(0); gload(1);
#pragma unroll 1
    for (int n = 0; n < NCH; ++n) {
        __syncthreads();
        const LAS unsigned char* B0 = L0 + (n & 1) * BUFB;
        const LAS bf16* Qs = (const LAS bf16*)B0; const LAS bf16* Ks = Qs + 64 * MP; const LAS bf16* KdT = Ks + 64 * MP; const LAS bf16* Wi = KdT + 64 * MP; const LAS bf16* UT = Wi + 64 * MP; const LAS float* vec = (const LAS float*)(B0 + 5 * IMG);
        const LAS bf16* ST = (const LAS bf16*)(L0 + 2 * BUFB + (n & 1) * IMG); LAS bf16* STn = (LAS bf16*)(L0 + 2 * BUFB + ((n + 1) & 1) * IMG);
        fragb Qf[2]; Qf[0] = ld_frag16(Qs + (16 * it + l15) * MP + 8 * q); Qf[1] = ld_frag16(Qs + (16 * it + l15) * MP + 32 + 8 * q);
        const float gcol = vec[16 * it + l15]; const int icol = 16 * it + l15;
        f32x4 pt[4];
#pragma unroll
        for (int jt = 0; jt < 4; ++jt) {
            pt[jt] = z4;
            if (jt <= it) {
                const fragb k0 = ld_frag16(Ks + (16 * jt + l15) * MP + 8 * q), k1 = ld_frag16(Ks + (16 * jt + l15) * MP + 32 + 8 * q);
                f32x4 st = mfma16(k0, Qf[0], z4); st = mfma16(k1, Qf[1], st);
                const f32x4 gj = *(const LAS f32x4*)(vec + 16 * jt + 4 * q);
#pragma unroll
                for (int r = 0; r < 4; ++r) { const int j = 16 * jt + 4 * q + r; pt[jt][r] = (j <= icol) ? st[r] * __expf(gcol - gj[r]) : 0.f; }
            }
        }
        fragb Pf[2]; Pf[0] = pack_frag(pt[0], pt[1]); Pf[1] = pack_frag(pt[2], pt[3]);
        const fragb Wf0 = ld_frag16(Wi + (16 * it + l15) * MP + 8 * q), Wf1 = ld_frag16(Wi + (16 * it + l15) * MP + 32 + 8 * q);
        f32x4 Ro[2];
#pragma unroll
        for (int v2 = 0; v2 < 2; ++v2) {
            const int vrow = 16 * (2 * vtp + v2) + l15;
            const fragb s0 = ld_frag16(ST + vrow * MP + 8 * q), s1 = ld_frag16(ST + vrow * MP + 32 + 8 * q);
            f32x4 ws = mfma16(Wf0, s0, z4); ws = mfma16(Wf1, s1, ws);
            Ro[v2] = mfma16(Qf[0], s0, z4); Ro[v2] = mfma16(Qf[1], s1, Ro[v2]);
            const v2u ur = *(const LAS v2u*)(UT + vrow * MP + 16 * it + 4 * q);
            v2u o; o.x = pk2(bflo(ur.x) - ws.x, bfhi(ur.x) - ws.y); o.y = pk2(bflo(ur.y) - ws.z, bfhi(ur.y) - ws.w);
            *(LAS v2u*)(VnT + vrow * MP + 16 * it + 4 * q) = o;
        }
        __syncthreads();
        {
            const f32x4 gi = *(const LAS f32x4*)(vec + 16 * it + 4 * q);
            const float gl = __expf(vec[63]);
            const LAS bf16* kr = KdT + (16 * it + l15) * MP + 4 * q;
            const fragb kt0 = ld_frag8x2(kr, kr + 16), kt1 = ld_frag8x2(kr + 32, kr + 48);
#pragma unroll
            for (int v2 = 0; v2 < 2; ++v2) {
                const int vrow = 16 * (2 * vtp + v2) + l15;
                const LAS bf16* vr = VnT + vrow * MP + 4 * q;
                const fragb n0 = ld_frag8x2(vr, vr + 16), n1 = ld_frag8x2(vr + 32, vr + 48);
                f32x4 o = mfma16(Pf[0], n0, z4); if (it >= 2) o = mfma16(Pf[1], n1, o);
#pragma unroll
                for (int r = 0; r < 4; ++r) { const int row = seqrow_cm(n * 64 + 16 * it + 4 * q + r, d, b);
                    outd[(size_t)row * 256 + h * 64 + vrow] = (bf16)f2bf(o[r] + __expf(gi[r]) * Ro[v2][r]); }
                f32x4 ns = mfma16(kt0, n0, z4); ns = mfma16(kt1, n1, ns);
                Sst[v2] = Sst[v2] * gl + ns;
                v2u so; so.x = pk2(Sst[v2].x, Sst[v2].y); so.y = pk2(Sst[v2].z, Sst[v2].w);
                *(LAS v2u*)(STn + vrow * MP + 16 * it + 4 * q) = so;
            }
        }
        if (n + 1 < NCH) { images((n + 1) & 1); if (n + 2 < NCH) gload(n + 2); }
    }
    __syncthreads();
}
constexpr int UP = 264;
template <int CTRL> __device__ __forceinline__ float dpp_keep(float oldv, float v) { return __builtin_bit_cast(float, __builtin_amdgcn_update_dpp(__builtin_bit_cast(int, oldv), __builtin_bit_cast(int, v), CTRL, 0xF, 0xF, false)); }
template <bool REV> __device__ __forceinline__ void scan16(float& A, float& B) {
#define LRU_STEP(S) { const float Ap = dpp_keep<(REV ? 0x100 : 0x110) | S>(1.0f, A), Bp = dpp_keep<(REV ? 0x100 : 0x110) | S>(0.0f, B); B = A * Bp + B; A = A * Ap; }
    LRU_STEP(1) LRU_STEP(2) LRU_STEP(4) LRU_STEP(8)
#undef LRU_STEP
}
template <bool FIN, bool REV>
__device__ __forceinline__ void lru_wave(const Ctx& C, int l, int b, int c, int hd, LAS bf16* U16, LAS bf16* H16) {
    constexpr int d = REV ? 1 : 0;
    const int lane = C.lane, l15 = lane & 15, q = lane >> 4;
    const bf16* wt = WSP(const bf16, WS_LRUWT) + (size_t)((d * 2 + 0) * 4 + hd) * 4096;
    fragb Wa[4][2], Wx[4][2];
#pragma unroll
    for (int mt = 0; mt < 4; ++mt)
#pragma unroll
        for (int ks = 0; ks < 2; ++ks) { Wa[mt][ks] = *(const fragb*)(wt + (16 * mt + l15) * 64 + 32 * ks + 8 * q); Wx[mt][ks] = *(const fragb*)(wt + 4 * 4096 + (16 * mt + l15) * 64 + 32 * ks + 8 * q); }
    f32x4 sp4[4], hc[4], sla[4];
    const size_t sbase = ((size_t)(b * NCH + c) * 2 + d) * 256 + hd * 64;
#pragma unroll
    for (int mt = 0; mt < 4; ++mt) {
        const int ch = hd * 64 + 16 * mt + 4 * q;
        const f32x4 lam = *(const f32x4*)(C.in[I_LLAM] + (l * 2 + d) * GW + ch);
#pragma unroll
        for (int r = 0; r < 4; ++r) sp4[mt][r] = 8.0f * softplusf_(-lam[r]);
        hc[mt] = FIN ? *(const f32x4*)(WSP(const float, WS_HIN) + sbase + 16 * mt + 4 * q) : (f32x4){0.f, 0.f, 0.f, 0.f};
        sla[mt] = (f32x4){0.f, 0.f, 0.f, 0.f};
    }
    const f32x4 z4 = (f32x4){0.f, 0.f, 0.f, 0.f};
#pragma unroll 1
    for (int nti = 0; nti < 4; ++nti) {
        const int nt = REV ? 3 - nti : nti;
        const LAS bf16* urow = U16 + (16 * nt + l15) * UP + hd * 64;
        const fragb Uf0 = ld_frag16(urow + 8 * q), Uf1 = ld_frag16(urow + 32 + 8 * q);
#pragma unroll
        for (int mt = 0; mt < 4; ++mt) {
            f32x4 aa = mfma16(Wa[mt][0], Uf0, z4); aa = mfma16(Wa[mt][1], Uf1, aa);
            f32x4 ax = mfma16(Wx[mt][0], Uf0, z4); ax = mfma16(Wx[mt][1], Uf1, ax);
            const v2u ur = *(const LAS v2u*)(urow + 16 * mt + 4 * q);
            const float u4[4] = {bflo(ur.x), bfhi(ur.x), bflo(ur.y), bfhi(ur.y)};
            const f32x4 ba = *(const f32x4*)(C.in[I_LBA] + (l * 2 + d) * GW + hd * 64 + 16 * mt + 4 * q), bx = *(const f32x4*)(C.in[I_LBX] + (l * 2 + d) * GW + hd * 64 + 16 * mt + 4 * q);
            f32x4 hv;
#pragma unroll
            for (int r = 0; r < 4; ++r) {
                const float rg = sigmoidf_(aa[r] + ba[r]), ig = sigmoidf_(ax[r] + bx[r]);
                const float la = -sp4[mt][r] * rg; float A = __expf(la); float Bv = sqrtf(-expm1f_(2.0f * la)) * (ig * u4[r]);
                sla[mt][r] += la;
                scan16<REV>(A, Bv);
                const float h = A * hc[mt][r] + Bv;
                hv[r] = h;
                hc[mt][r] = __shfl(h, (lane & 48) | (REV ? 0 : 15));
            }
            if (FIN) { v2u o; o.x = pk2(hv.x, hv.y); o.y = pk2(hv.z, hv.w); *(LAS v2u*)(H16 + (size_t)d * 64 * UP + (16 * nt + l15) * UP + hd * 64 + 16 * mt + 4 * q) = o; }
        }
    }
    if (!FIN) {
        float* ls = WSP(float, WS_LSUM);
#pragma unroll
        for (int mt = 0; mt < 4; ++mt)
#pragma unroll
            for (int r = 0; r < 4; ++r) { const float st = row16_sum(sla[mt][r]); if (l15 == 0) { const size_t si = sbase + 16 * mt + 4 * q + r; ls[si * 2] = st; ls[si * 2 + 1] = hc[mt][r]; } }
    }
}
template <bool FIN>
__device__ __forceinline__ void lru_chunk_mfma(const Ctx& C, int l, int b, int c) {
    LAS bf16* U16 = (LAS bf16*)C.lds;
    LAS bf16* H16 = U16 + 64 * UP;
    const bf16* P = WSP(const bf16, WS_P);
    const bool isctx = c < 4; const int p0 = isctx ? c * 64 : (c - 4) * 64; const int Lp = isctx ? CTXL : SEQ; const int row0 = isctx ? T_LAT + b * CTXL : b * SEQ;
    {
        const int ch = C.tid & 255, half = C.tid >> 8;
        const float* cw = C.in[I_LCW] + (size_t)l * 4 * GW + ch; const float w0 = cw[0], w1 = cw[GW], w2 = cw[2 * GW], w3 = cw[3 * GW], cb = C.in[I_LCB][l * GW + ch];
        const int t0 = half * 32;
        float xs[35];
#pragma unroll
        for (int k = 0; k < 35; ++k) { const int p = p0 + t0 + k - 2; xs[k] = (p >= 0 && p < Lp) ? bf2f(P[(size_t)(row0 + p) * PLD + ch]) : 0.f; }
#pragma unroll
        for (int t = 0; t < 32; ++t) U16[(t0 + t) * UP + ch] = (bf16)f2bf(w0 * xs[t] + w1 * xs[t + 1] + w2 * xs[t + 2] + w3 * xs[t + 3] + cb);
    }
    __syncthreads();
    if (C.wave < 4) lru_wave<FIN, false>(C, l, b, c, C.wave & 3, U16, H16); else lru_wave<FIN, true>(C, l, b, c, C.wave & 3, U16, H16);
    __syncthreads();
    if (FIN) {
        bf16* yc = WSP(bf16, WS_HB);
        const LAS bf16* H1 = H16 + 64 * UP;
#pragma unroll 2
        for (int it = C.tid; it < 64 * 64; it += NTHR) {
            const int t = it >> 6, c4 = (it & 63) * 4;
            const size_t row = (size_t)(row0 + p0 + t);
            const v2u a = *(const LAS v2u*)(H16 + t * UP + c4), bq = *(const LAS v2u*)(H1 + t * UP + c4);
            const f32x4 g = ld4bf(P + row * PLD + 256 + c4);
            f32x4 y = (f32x4){bflo(a.x) + bflo(bq.x), bfhi(a.x) + bfhi(bq.x), bflo(a.y) + bflo(bq.y), bfhi(a.y) + bfhi(bq.y)};
            y.x *= gelu_tanh(g.x); y.y *= gelu_tanh(g.y); y.z *= gelu_tanh(g.z); y.w *= gelu_tanh(g.w);
            st4bf(yc + row * 1024 + c4, y);
        }
        __syncthreads();
    }
}
__device__ __forceinline__ void moe_scatter(const Ctx& C, int moe_li, int nrows) {
    const unsigned* gc = WSP(const unsigned, WS_CTL) + CW_MOECNT + 64 * moe_li;
    LAS int* pst = (LAS int*)C.lds;
    {
        int pe[8]; int acc = 0;
#pragma unroll
        for (int e = 0; e < NE; ++e) { const int blks = ((int)gc[e] + 255) >> 8; if (C.tid == e) pst[e] = acc * 256; acc += blks; pe[e] = acc; }
        if (C.wg == 0 && C.tid < MOE_MAXBLK) { int be = 0;
#pragma unroll
            for (int e = 0; e < NE; ++e) be += (pe[e] <= C.tid) ? 1 : 0;
            int* tab = WSP(int, WS_TAB); tab[1 + C.tid] = be < NE ? be : NE - 1; if (C.tid == 0) tab[0] = acc; }
    }
    __syncthreads();
    const unsigned* route = WSP(const unsigned, WS_ROUTE); const unsigned* wgbase = WSP(const unsigned, WS_WGBASE);
    const bf16* hb = WSP(const bf16, WS_HB); bf16* am = WSP(bf16, WS_MIX); int* pos = WSP(int, WS_POS);
    const int gw = C.wg * NWAVES + C.wave, NGW = C.G * NWAVES;
    for (int m = gw; m < nrows; m += NGW) {
        const v4u a = *(const v4u*)(route + (size_t)m * 8);
        const int e0 = (int)a.x, e1 = (int)a.y;
        const int p0 = pst[e0] + (int)wgbase[C.wg * 8 + e0] + (int)a.z, p1 = pst[e1] + (int)wgbase[C.wg * 8 + e1] + (int)a.w;
        const v4u r0 = *(const v4u*)(hb + (size_t)m * 1024 + C.lane * 8), r1 = *(const v4u*)(hb + (size_t)m * 1024 + 512 + C.lane * 8);
        *(v4u*)(am + (size_t)p0 * 1024 + C.lane * 8) = r0; *(v4u*)(am + (size_t)p0 * 1024 + 512 + C.lane * 8) = r1;
        *(v4u*)(am + (size_t)p1 * 1024 + C.lane * 8) = r0; *(v4u*)(am + (size_t)p1 * 1024 + 512 + C.lane * 8) = r1;
        if (C.lane == 0) { pos[(size_t)m * 2] = p0; pos[(size_t)m * 2 + 1] = p1; }
    }
    __syncthreads();
}
__device__ __forceinline__ void moe_combine(const Ctx& C, int l, int nrows) {
    const unsigned* route = WSP(const unsigned, WS_ROUTE); const int* pos = WSP(const int, WS_POS); const bf16* ym = WSP(const bf16, WS_MIX);
    const float* modv = WSP(const float, WS_MODV) + (size_t)l * 9 * 6144 + 5 * 1024;
    float* xc = WSP(float, WS_XC);
    const int gw = C.wg * NWAVES + C.wave, NGW = C.G * NWAVES;
    for (int m = gw; m < nrows; m += NGW) {
        const bool isctx = m >= T_LAT;
        float* xr = isctx ? xc + (size_t)(m - T_LAT) * 1024 : C.out + (size_t)m * 1024;
        const float* gv = modv + (size_t)(isctx ? 8 : (m >> 12)) * 6144;
        const int p0 = pos[(size_t)m * 2], p1 = pos[(size_t)m * 2 + 1];
        const float w0 = __builtin_bit_cast(float, route[(size_t)m * 8 + 4]), w1 = __builtin_bit_cast(float, route[(size_t)m * 8 + 5]);
#pragma unroll
        for (int j = 0; j < 4; ++j) {
            const int col = 4 * C.lane + 256 * j;
            const v2u a = *(const v2u*)(ym + (size_t)p0 * 1024 + col), b = *(const v2u*)(ym + (size_t)p1 * 1024 + col);
            const f32x4 ya = (f32x4){bflo(a.x), bfhi(a.x), bflo(a.y), bfhi(a.y)}, yb = (f32x4){bflo(b.x), bfhi(b.x), bflo(b.y), bfhi(b.y)};
            const f32x4 g = *(const f32x4*)(gv + col); f32x4 x = *(const f32x4*)(xr + col);
            x = x + g * (ya * w0 + yb * w1);
            *(f32x4*)(xr + col) = x;
        }
    }
}
__device__ __forceinline__ void final_norm(const Ctx& C) {
    const int gw = C.wg * NWAVES + C.wave, NGW = C.G * NWAVES;
    f32x4 gv[4];
#pragma unroll
    for (int j = 0; j < 4; ++j) gv[j] = *(const f32x4*)(C.in[I_FNG] + 4 * C.lane + 256 * j);
    for (int m = gw; m < T_LAT; m += NGW) {
        float* xr = C.out + (size_t)m * 1024;
        f32x4 v[4]; float s = 0.f;
#pragma unroll
        for (int j = 0; j < 4; ++j) { v[j] = *(const f32x4*)(xr + 4 * C.lane + 256 * j); s += (v[j].x * v[j].x + v[j].y * v[j].y) + (v[j].z * v[j].z + v[j].w * v[j].w); }
        const float rs = 1.0f / sqrtf(wave_sum(s) * (1.0f / 1024.0f) + 1e-6f);
#pragma unroll
        for (int j = 0; j < 4; ++j) *(f32x4*)(xr + 4 * C.lane + 256 * j) = v[j] * rs * gv[j];
    }
}

constexpr int NPH_L = 12, PH_FINAL = 1 + DEPTH * NPH_L, NPHASE = PH_FINAL + 1;
__host__ __device__ inline bool phase_exists(int ph) {
    if (ph == 0 || ph == PH_FINAL) return true;
    const int l = (ph - 1) / NPH_L, k = (ph - 1) % NPH_L;
    if (!(l & 1) && k >= 10) return false;
    return true;
}
#ifndef PH_MASK
#define PH_MASK 0xFFFFFF
#endif
#define PM(k) ((PH_MASK >> (k)) & 1)
#ifndef SK_MASK
#define SK_MASK 0xFFFF
#endif
#define SK(k) ((SK_MASK >> (k)) & 1)
#ifndef REP_MASK
#define REP_MASK 0
#endif
#define NREP(k) (((REP_MASK >> (k)) & 1) ? 2 : 1)

__global__ void __launch_bounds__(NTHR, 2) fwd_kernel(Args args) {
    extern __shared__ __attribute__((aligned(16))) unsigned char lds_raw[];
    Ctx C; C.in = args.in; C.out = args.out; C.ws = args.ws; C.lds = (LAS unsigned char*)lds_raw;
    C.tid = threadIdx.x; C.lane = C.tid & 63; C.wave = __builtin_amdgcn_readfirstlane(C.tid >> 6); C.G = gridDim.x; C.wg = blockIdx.x;
    volatile LAS unsigned* MISC = (volatile LAS unsigned*)(C.lds + MISC_OFF);
    if (C.tid < 64) MISC[C.tid] = 0u;
    __syncthreads();
    const int lo = args.ph_lo, hi = args.ph_hi;
    const bool multi = (hi - lo) > 1;
    if (multi) (void)xcd_barrier_post(WSP(unsigned, WS_CTL) + CW_BAR, MISC + 8);
#define IN(k) (lo <= (k) && (k) < hi)
#define SEAM(k) do { if (IN((k) + 1)) { XcdBarrier b2_; b2_.bar = WSP(unsigned, WS_CTL) + CW_BAR; b2_.x = xb_xcc_id(); b2_.st = (volatile LAS unsigned*)(C.lds + MISC_OFF) + 8; xcd_barrier(b2_); } } while (0)
#define FRESH() do { int t_ = threadIdx.x; asm volatile("" : "+v"(t_)); C.tid = t_; C.lane = t_ & 63; C.wave = __builtin_amdgcn_readfirstlane(t_ >> 6); } while (0)
#define PHASE(bit, k) if (PM(bit) && IN(pb + (k))) for (int rep_ = 0; rep_ < NREP(bit); ++rep_)

    if (PM(20) && IN(0)) { phase_pre(C); SEAM(0); }

#pragma unroll 1
    for (int l = 0; l < DEPTH; ++l) {
        const int pb = 1 + l * NPH_L;
        if (hi <= pb || lo >= pb + NPH_L) continue;
        const bool last = (l == DEPTH - 1), moe = (l & 1);
        const int nrows = last ? T_LAT : T_ALL;
        const float* xlat = (l == 0) ? C.in[I_X] : C.out; const float* xctx = (l == 0) ? C.in[I_CTX] : WSP(const float, WS_XC);
        const float* modv = WSP(const float, WS_MODV) + (size_t)l * 9 * 6144;

        PHASE(0, 0) { FRESH();
            convert_layer(C, l);
            __syncthreads();
            FRESH(); norm_rows<false>(C, l, xlat, xctx, C.in[I_NMIXG] + l * 1024, 0, 1024, T_ALL, 0);
            SEAM(pb + 0);
        }
        PHASE(1, 1) { FRESH();
            pg8::Gemm g{WSP(const bf16, WS_HB), WSP(const bf16, WS_WIN), T_ALL, PLD, 1024, 0};
            pg8::StaticOrder S; S.init(T_ALL, PLD, C.G, C.wg);
            pg8::EpiBf16<0> E{WSP(bf16, WS_P), PLD, nullptr, 0, 0};
            pg8::gemm_phase<pg8::EpiBf16<0>, pg8::StaticOrder, false>(C.lds, g, S, E, nullptr);
            SEAM(pb + 1);
        }
        PHASE(2, 2) { FRESH();
            for (int r2_ = 0; r2_ < NREP(16); ++r2_) { FRESH(); if (SK(0)) for (int u = C.wg; u < NB * NCH; u += C.G) lru_chunk_mfma<false>(C, l, u / NCH, u % NCH); }
            for (int r2_ = 0; r2_ < NREP(17); ++r2_) { FRESH(); if (SK(1)) for (int u = C.wg; u < NB * NCH; u += C.G) rwkv_prep(C, l, u / NCH, u % NCH); }
            FRESH(); if (SK(2)) for (int u = C.wg; u < NB * NCH; u += C.G) gdn_prep(C, l, u / NCH, u % NCH);
            SEAM(pb + 2);
        }
        PHASE(3, 3) { FRESH();
            gdn_solve_units(C, l);
            SEAM(pb + 3);
        }
        PHASE(4, 4) { FRESH();
            if (SK(3) && C.wg < 128) { FRESH(); rwkv_scan(C, l, C.wg); }
            else if (SK(4) && C.wg < 192) { FRESH(); mlstm_chunked(C, l, C.wg - 128); }
            else if (SK(5)) { FRESH(); gdn_chunked(C, l, C.wg - 192); }
            if (SK(6) && C.wg >= 248) lru_carry(C, (C.wg - 248) * NTHR + C.tid);
            SEAM(pb + 4);
        }
        PHASE(5, 5) { FRESH();
            for (int u = C.wg; u < NB * NCH; u += C.G) { const int b = u / NCH, c = u % NCH; if (last && c < 4) continue; if (SK(7)) lru_chunk_mfma<true>(C, l, b, c); }
            FRESH(); if (SK(8)) finish_rows(C, l, nrows);
            SEAM(pb + 5);
        }
        if (PM(6) && IN(pb + 6)) { FRESH();
            pg8::Gemm g{WSP(const bf16, WS_HB), WSP(const bf16, WS_WOUT), nrows, 1024, 1024, 0};
            pg8::StaticOrder S; S.init(nrows, 1024, C.G, C.wg);
            pg8::EpiRes E{xlat, xctx, C.out, WSP(float, WS_XC), modv + 2 * 1024};
            pg8::gemm_phase<pg8::EpiRes, pg8::StaticOrder, false>(C.lds, g, S, E, nullptr);
            SEAM(pb + 6);
        }
        if (PM(7) && IN(pb + 7)) { FRESH();
            if (moe) norm_rows<true>(C, l, C.out, WSP(const float, WS_XC), C.in[I_NFFNG] + l * 1024, 3 * 1024, 4 * 1024, nrows, l >> 1);
            else norm_rows<false>(C, l, C.out, WSP(const float, WS_XC), C.in[I_NFFNG] + l * 1024, 3 * 1024, 4 * 1024, nrows, 0);
            SEAM(pb + 7);
        }
        if (!moe) {
            if (PM(8) && IN(pb + 8)) { FRESH();
                pg8::Gemm g{WSP(const bf16, WS_HB), WSP(const bf16, WS_WGU), nrows, 2 * DFF, 1024, 0};
                pg8::StaticOrder S; S.init(nrows, 2 * DFF, C.G, C.wg);
                pg8::EpiSwiglu E{WSP(bf16, WS_P), DFF};
                pg8::gemm_phase<pg8::EpiSwiglu, pg8::StaticOrder, false>(C.lds, g, S, E, nullptr);
                SEAM(pb + 8);
            }
            if (PM(9) && IN(pb + 9)) { FRESH();
                pg8::Gemm g{WSP(const bf16, WS_P), WSP(const bf16, WS_WDN), nrows, 1024, DFF, 0};
                pg8::StaticOrder S; S.init(nrows, 1024, C.G, C.wg);
                pg8::EpiRes E{C.out, WSP(const float, WS_XC), C.out, WSP(float, WS_XC), modv + 5 * 1024};
                pg8::gemm_phase<pg8::EpiRes, pg8::StaticOrder, false>(C.lds, g, S, E, nullptr);
                SEAM(pb + 11);
            }
        } else {
            if (PM(10) && IN(pb + 8)) { FRESH(); moe_scatter(C, l >> 1, nrows); SEAM(pb + 8); }
            if (PM(11) && IN(pb + 9)) { FRESH();
                pg8::Gemm g{WSP(const bf16, WS_MIX), WSP(const bf16, WS_WGU), 0, 2 * DFE, 1024, (size_t)2 * DFE * 1024};
                pg8::MoeOrder S; S.init(WSP(const int, WS_TAB), (2 * DFE) / 256, C.G, C.wg);
                pg8::EpiSwiglu E{WSP(bf16, WS_P), DFE};
                pg8::gemm_phase<pg8::EpiSwiglu, pg8::MoeOrder, false>(C.lds, g, S, E, nullptr);
                SEAM(pb + 9);
            }
            if (PM(12) && IN(pb + 10)) { FRESH();
                pg8::Gemm g{WSP(const bf16, WS_P), WSP(const bf16, WS_WDN), 0, 1024, DFE, (size_t)1024 * DFE};
                pg8::MoeOrder S; S.init(WSP(const int, WS_TAB), 4, C.G, C.wg);
                pg8::EpiBf16<0> E{WSP(bf16, WS_MIX), 1024, nullptr, 0, 0};
                pg8::gemm_phase<pg8::EpiBf16<0>, pg8::MoeOrder, false>(C.lds, g, S, E, nullptr);
                SEAM(pb + 10);
            }
            if (PM(13) && IN(pb + 11)) { FRESH(); moe_combine(C, l, nrows); SEAM(pb + 11); }
        }
    }
    if (PM(21) && IN(PH_FINAL)) final_norm(C);
}

extern "C" void kernel_launch(void* const* d_in, const int* in_sizes, int n_in, void* d_out, int out_size, void* d_ws, size_t ws_size, hipStream_t stream) {
    static int grid = 0;
    if (grid == 0) {
        if (n_in != N_IN || in_sizes[0] != T_LAT * DM || out_size != T_LAT * DM || ws_size < WS_END) {
            fprintf(stderr, "kernel_launch: unexpected problem (n_in %d, in0 %d, out %d, ws %zu < %zu)\n", n_in, n_in > 0 ? in_sizes[0] : -1, out_size, ws_size, (size_t)WS_END); grid = -1; return; }
        int dev = 0, cus = 0, per_cu = 0;
        if (hipGetDevice(&dev) != hipSuccess || hipDeviceGetAttribute(&cus, hipDeviceAttributeMultiprocessorCount, dev) != hipSuccess) { grid = -1; return; }
        if (hipFuncSetAttribute((const void*)fwd_kernel, hipFuncAttributeMaxDynamicSharedMemorySize, LDS_BYTES) != hipSuccess) { fprintf(stderr, "kernel_launch: hipFuncSetAttribute failed\n"); grid = -1; return; }
        if (hipOccupancyMaxActiveBlocksPerMultiprocessor(&per_cu, (const void*)fwd_kernel, NTHR, LDS_BYTES) != hipSuccess || per_cu < 1) { fprintf(stderr, "kernel_launch: occupancy query says %d\n", per_cu); grid = -1; return; }
        grid = cus;
        if (grid != 256) fprintf(stderr, "kernel_launch: note: %d CUs\n", grid);
    }
    if (grid < 0) return;
    if (hipMemsetAsync((char*)d_ws + WS_CTL, 0, CTL_BYTES, stream) != hipSuccess) return;
    Args a{};
    for (int i = 0; i < N_IN; ++i) a.in[i] = (const float*)d_in[i];
    a.out = (float*)d_out; a.ws = (unsigned char*)d_ws;
#if MK_ONE_LAUNCH
    a.ph_lo = 0; a.ph_hi = NPHASE;
    hipLaunchKernelGGL(fwd_kernel, dim3(grid), dim3(NTHR), LDS_BYTES, stream, a);
#else
    for (int ph = 0; ph < NPHASE; ++ph) { if (!phase_exists(ph)) continue; a.ph_lo = ph; a.ph_hi = ph + 1; hipLaunchKernelGGL(fwd_kernel, dim3(grid), dim3(NTHR), LDS_BYTES, stream, a); }
#endif
}
```

```cpp
#define MK_ONE_LAUNCH 1
#include <hip/hip_runtime.h>
#include <cstdio>
#include <cstdint>

#define GAS __attribute__((address_space(1)))
#define LAS __attribute__((address_space(3)))
typedef unsigned short bf16;
typedef unsigned v4u __attribute__((ext_vector_type(4)));
typedef unsigned v2u __attribute__((ext_vector_type(2)));
typedef float f32x4 __attribute__((ext_vector_type(4)));
typedef float f32x2 __attribute__((ext_vector_type(2)));
typedef short bf16x8 __attribute__((ext_vector_type(8)));
#define LDS_WAIT() asm volatile("s_waitcnt lgkmcnt(0)" ::: "memory")
#define VM_WAIT() asm volatile("s_waitcnt vmcnt(0)" ::: "memory")

constexpr int DM = 1024, NB = 8, SEQ = 4096, DEPTH = 4, CTXL = 256, GW = 256, HD = 64, NH = 4;
constexpr int T_LAT = NB * SEQ, T_CTX = NB * CTXL, T_ALL = T_LAT + T_CTX;
constexpr int IN_COLS = 3552, PLD = 3584;
constexpr int OFF_B = 512, OFF_C = 1472, OFF_D = 2512, B_COLS = 960;
constexpr int DFF = 2816, NE = 8, DFE = 1408;
constexpr int NCH = 68;
constexpr int NSTEP = 4352;
constexpr int MOE_MAXBLK = 280;
constexpr int NWAVES = 8, NTHR = 512;

constexpr size_t MiB = 1u << 20;
constexpr size_t WS_CTL = 0, CTL_BYTES = 1 * MiB;
constexpr size_t WS_MODV = 1 * MiB;
constexpr size_t WS_XC = 2 * MiB;
constexpr size_t WS_WIN = 10 * MiB;
constexpr size_t WS_WOUT = 17 * MiB;
constexpr size_t WS_WGU = 19 * MiB;
constexpr size_t WS_WDN = 63 * MiB;
constexpr size_t WS_HB = 85 * MiB;
constexpr size_t WS_P = 153 * MiB;
constexpr size_t WS_MIX = 391 * MiB;
constexpr size_t WS_OUTB = WS_MIX, WS_OUTC = WS_MIX + 34 * MiB, WS_OUTD = WS_MIX + 68 * MiB, WS_GQ = WS_MIX + 102 * MiB, WS_G = WS_MIX + 153 * MiB;
constexpr size_t WS_RKV = WS_MIX + 170 * MiB;
constexpr size_t WS_SMALL = 612 * MiB;
constexpr size_t WS_LSUM = WS_SMALL;
constexpr size_t WS_HIN = WS_SMALL + 3 * MiB;
constexpr size_t WS_ROUTE = WS_SMALL + 5 * MiB;
constexpr size_t WS_POS = WS_SMALL + 7 * MiB;
constexpr size_t WS_BONUS = WS_SMALL + 8 * MiB;
constexpr size_t WS_WGBASE = WS_SMALL + 9 * MiB;
constexpr size_t WS_TAB = WS_WGBASE + 65536;
constexpr size_t WS_LRUWT = WS_SMALL + 10 * MiB;
constexpr size_t WS_RWT = WS_LRUWT + 131072;
constexpr size_t WS_RINV = WS_SMALL + 11 * MiB;
constexpr size_t WS_END = 624 * MiB;
constexpr int CW_MOECNT = 1024;
constexpr int CW_BAR = 4096;

constexpr int LDS_BYTES = 135168;
constexpr int MISC_OFF = 131072;

__device__ __forceinline__ unsigned f2bf(float f) { unsigned u = __builtin_bit_cast(unsigned, f); return (u + 0x7fffu + ((u >> 16) & 1u)) >> 16; }
__device__ __forceinline__ unsigned pk2(float lo, float hi) { return f2bf(lo) | (f2bf(hi) << 16); }
__device__ __forceinline__ float bf2f(unsigned short v) { return __builtin_bit_cast(float, (unsigned)v << 16); }
__device__ __forceinline__ float bflo(unsigned v) { return __builtin_bit_cast(float, v << 16); }
__device__ __forceinline__ float bfhi(unsigned v) { return __builtin_bit_cast(float, v & 0xffff0000u); }
__device__ __forceinline__ float wave_sum(float v) {
#pragma unroll
    for (int o = 1; o < 64; o <<= 1) v += __shfl_xor(v, o);
    return v;
}
template <int CTRL> __device__ __forceinline__ float dpp_f(float v) { return __builtin_bit_cast(float, __builtin_amdgcn_update_dpp(0, __builtin_bit_cast(int, v), CTRL, 0xF, 0xF, true)); }
__device__ __forceinline__ float row16_sum(float v) {
    v += dpp_f<0xB1>(v);
    v += dpp_f<0x4E>(v);
    v += dpp_f<0x141>(v);
    v += dpp_f<0x140>(v);
    return v;
}
__device__ __forceinline__ float sigmoidf_(float x) { return 1.0f / (1.0f + __expf(-x)); }
__device__ __forceinline__ float softplusf_(float x) { return fmaxf(x, 0.f) + __logf(1.0f + __expf(-fabsf(x))); }
__device__ __forceinline__ float expm1f_(float x) { return x > -0.3f ? x * (1.0f + x * (0.5f + x * (0.16666667f + x * (0.041666668f + x * 0.0083333338f)))) : __expf(x) - 1.0f; }
__device__ __forceinline__ float siluf_(float x) { return x / (1.0f + __expf(-x)); }
__device__ __forceinline__ float tanhf_(float x) { const float e = __expf(2.0f * x); return 1.0f - 2.0f / (e + 1.0f); }
__device__ __forceinline__ float gelu_tanh(float x) { return 0.5f * x * (1.0f + tanhf_(0.7978845608028654f * (x + 0.044715f * x * x * x))); }
#define XB_TMO      128
#define XB_XCNT(j)  (256  + 64 * (j))
#define XB_XSUB(j)  (1280 + 64 * (j))
#define XB_XGEN(j)  (2304 + 64 * (j))
#define XB_TOP      3328
#define XB_TOPGEN   3392
#define XCD_BAR_WORDS 3456
#define XB_SPIN_CAP (1u << 22)

__device__ __forceinline__ unsigned xb_ld(unsigned* p)              { return __hip_atomic_load(p, __ATOMIC_RELAXED, __HIP_MEMORY_SCOPE_AGENT); }
__device__ __forceinline__ unsigned xb_add(unsigned* p, unsigned v) { return __hip_atomic_fetch_add(p, v, __ATOMIC_RELAXED, __HIP_MEMORY_SCOPE_AGENT); }
__device__ __forceinline__ unsigned xb_xcc_id() { return (unsigned)__builtin_amdgcn_s_getreg((3 << 11) | 20) & 0xFu; }
#define XB_SPIN(cond, bar) do { unsigned _sp = 0; while (cond) { __builtin_amdgcn_s_sleep(1); \
    if ((++_sp & 255u) == 0u) { if (xb_ld(&(bar)[XB_TMO])) break; if (_sp > XB_SPIN_CAP) { atomicAdd(&(bar)[XB_TMO], 1u); break; } } } } while (0)

struct XcdBarrier {
    unsigned* bar; unsigned x;
    volatile LAS unsigned* st;
};

__device__ __forceinline__ XcdBarrier xcd_barrier_post(unsigned* bar, volatile LAS unsigned* st) {
    XcdBarrier b; b.bar = bar; b.x = xb_xcc_id(); b.st = st;
    if (threadIdx.x == 0) (void)xb_add(&bar[XB_XCNT(b.x)], 1u);
    return b;
}
__device__ __forceinline__ void xcd_barrier_complete(unsigned* bar, unsigned x, unsigned& nloc, unsigned& nx) {
    const unsigned G = gridDim.x * gridDim.y * gridDim.z;
    unsigned sum, cnt, mine, sp = 0u;
    for (;;) {
        sum = 0u; cnt = 0u; mine = 0u;
#pragma unroll
        for (unsigned j = 0; j < 16; ++j) { const unsigned c = xb_ld(&bar[XB_XCNT(j)]); sum += c; cnt += (c > 0u) ? 1u : 0u; mine = (j == x) ? c : mine; }
        if (sum == G) break;
        __builtin_amdgcn_s_sleep(1);
        if ((++sp & 255u) == 0u) { if (xb_ld(&bar[XB_TMO])) break; if (sp > XB_SPIN_CAP) { atomicAdd(&bar[XB_TMO], 1u); break; } }
    }
    nloc = mine > 0u ? mine : 1u; nx = cnt > 0u ? cnt : 1u;
}

__device__ __forceinline__ void xcd_barrier(const XcdBarrier& b) {
    asm volatile("s_waitcnt vmcnt(0)" ::: "memory");
    __syncthreads();
    if (threadIdx.x == 0) {
        unsigned* bar = b.bar;
        __builtin_amdgcn_s_waitcnt(0);
        unsigned nloc = b.st[0], nx = b.st[1];
        if (nloc == 0u) { xcd_barrier_complete(bar, b.x, nloc, nx); b.st[0] = nloc; b.st[1] = nx; }
        const unsigned old = xb_add(&bar[XB_XSUB(b.x)], 1u);
        const unsigned gen = old / nloc;
        if (old + 1u == (gen + 1u) * nloc) {
            __builtin_amdgcn_fence(__ATOMIC_RELEASE, "agent");
            asm volatile("s_waitcnt vmcnt(0)" ::: "memory");
            const unsigned og = xb_add(&bar[XB_TOP], 1u);
            const unsigned tg = og / nx;
            if (og + 1u == (tg + 1u) * nx) xb_add(&bar[XB_TOPGEN], 1u);
            else XB_SPIN(xb_ld(&bar[XB_TOPGEN]) == tg, bar);
            __builtin_amdgcn_fence(__ATOMIC_ACQUIRE, "agent");
            xb_add(&bar[XB_XGEN(b.x)], 1u);
            asm volatile("s_waitcnt vmcnt(0)" ::: "memory");
        } else {
            XB_SPIN(xb_ld(&bar[XB_XGEN(b.x)]) == gen, bar);
            __builtin_amdgcn_fence(__ATOMIC_ACQUIRE, "agent");
            asm volatile("s_waitcnt vmcnt(0)" ::: "memory");
        }
    }
    __syncthreads();
}

namespace pg8 {
#define PG8_LAS __attribute__((address_space(3)))
typedef unsigned short bf16_t;
typedef short bf16x8 __attribute__((ext_vector_type(8)));
typedef float f32x4 __attribute__((ext_vector_type(4)));
typedef unsigned u32x4 __attribute__((ext_vector_type(4)));
constexpr int BM = 256, BK = 64, HALF = 128, HTB = HALF * BK * 2  , STAGE_BYTES = 8 * HTB, NXCD = 8, WGM = 8;

__host__ __device__ __forceinline__ int lds_byte(int r, int c) { const int st = (r >> 4) * 2 + (c >> 5), rr = r & 15, cc = c & 31, ob = rr * 64 + cc * 2; return st * 1024 + (ob ^ (((ob >> 9) & 1) << 5)); }
__host__ __device__ __forceinline__ void stage_rc(int b, int& R, int& C) { const int st = b / 1024, sb = b % 1024, swz = sb ^ (((sb >> 9) & 1) << 5); R = (st >> 1) * 16 + swz / 64; C = (st & 1) * 32 + (swz % 64) / 2; }
__host__ __device__ __forceinline__ int perm32(int rho) { const int n = rho >> 4, i = rho & 15; return 8 * (i >> 2) + 4 * n + (i & 3); }

struct Unit { int pm, pn, e; };
struct Gemm { const bf16_t* A; const bf16_t* Bt; int M, N, K; size_t estride; };

struct StaticOrder {
    int nM, nN, nwg, G, c;
    __host__ __device__ void init(int M, int N, int G_, int c_) { nM = M / BM; nN = N / BM; nwg = nM * nN; G = G_; c = c_; }
    __host__ __device__ bool next(int i, Unit& u) const {
        const long L = (long)i * G + c; if (L >= nwg) return false;
        int wgid = (int)L; { const int q = nwg / NXCD, r = nwg % NXCD, xcd = wgid % NXCD, off = wgid / NXCD; wgid = (xcd < r ? xcd * (q + 1) : r * (q + 1) + (xcd - r) * q) + off; }
        const int nig = WGM * nN, gid = wgid / nig, fm = gid * WGM, gsz = (nM - fm) < WGM ? (nM - fm) : WGM;
        u.pm = fm + ((wgid % nig) % gsz); u.pn = (wgid % nig) / gsz; u.e = 0; return true;
    }
    __device__ __forceinline__ void a_ready(const Unit&) const {}
    __device__ __forceinline__ void done(const Unit&) const {}
};
__device__ __forceinline__ unsigned cvt_pk_bf16(float lo, float hi) { unsigned r; asm volatile("v_cvt_pk_bf16_f32 %0, %1, %2" : "=v"(r) : "v"(lo), "v"(hi)); return r; }
typedef float f32x2 __attribute__((ext_vector_type(2)));
__device__ __forceinline__ f32x2 gelu_pk(f32x2 v) {
    const f32x2 av = __builtin_elementwise_abs(v), d = av * 0.2316418882f + 1.0f;
    f32x2 t; t.x = __builtin_amdgcn_rcpf(d.x); t.y = __builtin_amdgcn_rcpf(d.y);
    f32x2 q = t * 0.5307027145f + (-0.7265760135f); q = q * t + 0.7107068705f; q = q * t + (-0.142248368f); q = q * t + 0.127414796f; q = q * t;
    const f32x2 s = (v * v) * (-0.72134752044f);
    f32x2 e; e.x = __builtin_amdgcn_exp2f(s.x); e.y = __builtin_amdgcn_exp2f(s.y);
    const f32x2 m = v * (q * e), r = v - m;
    f32x2 o; o.x = v.x < 0.f ? m.x : r.x; o.y = v.y < 0.f ? m.y : r.y; return o;
}

struct EpiF32 {
    static constexpr bool PERM = false, AFTER_DRAIN = false;
    float* C; int ldc; const float* bias;
    __device__ __forceinline__ void operator()(const f32x4 (&acc)[2][2][4][2], const Unit& u, int wr, int wc, int fr, int fq) const {
        const int row0 = u.pm * BM + wr * 64 + fr, col0 = u.pn * BM + wc * 32 + 4 * fq;
        f32x4 bv[2][2];
#pragma unroll
        for (int bj = 0; bj < 2; ++bj)
#pragma unroll
            for (int n = 0; n < 2; ++n) bv[bj][n] = bias ? *(const f32x4*)(bias + col0 + bj * HALF + n * 16) : (f32x4){0.f, 0.f, 0.f, 0.f};
#pragma unroll
        for (int ai = 0; ai < 2; ++ai)
#pragma unroll
            for (int m = 0; m < 4; ++m) { float* rowp = C + (size_t)(row0 + ai * HALF + m * 16) * ldc + col0;
#pragma unroll
                for (int bj = 0; bj < 2; ++bj)
#pragma unroll
                    for (int n = 0; n < 2; ++n) *(f32x4*)(rowp + bj * HALF + n * 16) = acc[ai][bj][m][n] + bv[bj][n]; }
    }
};
template <int ACT  > struct EpiBf16 {
    static constexpr bool PERM = true, AFTER_DRAIN = false;
    bf16_t* O; int ldc; const float* bias; int split_cols; size_t split_stride;
    __device__ __forceinline__ void operator()(const f32x4 (&acc)[2][2][4][2], const Unit& u, int wr, int wc, int fr, int fq) const {
        const int row0 = u.pm * BM + wr * 64 + fr; int colt = u.pn * BM; bf16_t* base = O;
        if (split_cols) { const int t = colt / split_cols; base += (size_t)t * split_stride; colt -= t * split_cols; }
        const int col0 = colt + wc * 32 + 8 * fq, bcol0 = u.pn * BM + wc * 32 + 8 * fq;
        f32x4 bv[2][2];
#pragma unroll
        for (int bj = 0; bj < 2; ++bj)
#pragma unroll
            for (int n = 0; n < 2; ++n) bv[bj][n] = bias ? *(const f32x4*)(bias + bcol0 + bj * HALF + 4 * n) : (f32x4){0.f, 0.f, 0.f, 0.f};
#pragma unroll
        for (int ai = 0; ai < 2; ++ai)
#pragma unroll
            for (int m = 0; m < 4; ++m) { bf16_t* rowp = base + (size_t)(row0 + ai * HALF + m * 16) * ldc + col0;
#pragma unroll
                for (int bj = 0; bj < 2; ++bj) { f32x4 v0 = acc[ai][bj][m][0] + bv[bj][0], v1 = acc[ai][bj][m][1] + bv[bj][1];
                    if (ACT == 1) { f32x2 a = gelu_pk((f32x2){v0[0], v0[1]}), b = gelu_pk((f32x2){v0[2], v0[3]}), c = gelu_pk((f32x2){v1[0], v1[1]}), d = gelu_pk((f32x2){v1[2], v1[3]});
                        v0 = (f32x4){a.x, a.y, b.x, b.y}; v1 = (f32x4){c.x, c.y, d.x, d.y}; }
                    if (ACT == 2) {
#pragma unroll
                        for (int j = 0; j < 4; ++j) { v0[j] = 0.5f * v0[j] * (1.0f + erff(v0[j] * 0.70710678f)); v1[j] = 0.5f * v1[j] * (1.0f + erff(v1[j] * 0.70710678f)); } }
                    u32x4 w; w.x = cvt_pk_bf16(v0[0], v0[1]); w.y = cvt_pk_bf16(v0[2], v0[3]); w.z = cvt_pk_bf16(v1[0], v1[1]); w.w = cvt_pk_bf16(v1[2], v1[3]);
                    *(u32x4*)(rowp + bj * HALF) = w; } }
    }
};

template <class Epi, class Sched, bool STAMP = false>
__device__ __forceinline__ void gemm_phase(PG8_LAS unsigned char* lds, const Gemm g, const Sched& S, const Epi& E, unsigned long long* stamps) {
    int tid_ = threadIdx.x; asm volatile("" : "+v"(tid_));
    const int tid = tid_, wid = __builtin_amdgcn_readfirstlane(tid >> 6), lane = tid & 63, wr = wid >> 2, wc = wid & 3, fr = lane & 15, fq = lane >> 4;
    const int K = g.K, nt = K / BK;
    int ts_lo = 0, ts_hi = 0, nts = 0; const unsigned long long rt_entry = STAMP ? (unsigned long long)wall_clock64() : 0ull;
#define PG8_STAMP() do { if (STAMP && wid == 0 && nts < 64) { const unsigned long long _c = (unsigned long long)clock64(); \
        ts_lo = (lane == nts) ? (int)(unsigned)_c : ts_lo; ts_hi = (lane == nts) ? (int)(unsigned)(_c >> 32) : ts_hi; ++nts; } } while (0)
    PG8_STAMP();
    unsigned voffA[2], voffB[2];
#pragma unroll
    for (int i = 0; i < 2; ++i) { int R, C; stage_rc(tid * 16 + i * 8192, R, C); const int Rb = Epi::PERM ? ((R & ~31) + perm32(R & 31)) : R;
        voffA[i] = (unsigned)(R * K + C) * 2u; voffB[i] = (unsigned)(Rb * K + C) * 2u; }
    const size_t kstep = (size_t)(BK * 2);
    const size_t hstep = (size_t)HALF * K * 2;
    const size_t tstep = 2 * hstep;
    const unsigned ldsw = (unsigned)wid * 1024u;
    const int aoff = lds_byte(wr * 64 + fr, fq * 8), boff = lds_byte(wc * 32 + fr, fq * 8);
#define PG8_SA(b, h) (((b) * 2 + (h)) * HTB)
#define PG8_SB(b, h) ((4 + (b) * 2 + (h)) * HTB)
#define PG8_STAGE(bufoff, gbase, voff) do { _Pragma("unroll") for (int _i = 0; _i < 2; ++_i) \
        __builtin_amdgcn_global_load_lds((const unsigned*)((const char*)(gbase) + (voff)[_i]), (PG8_LAS unsigned*)(lds + (bufoff) + ldsw + _i * 8192), 16, 0, 0); } while (0)
#define PG8_LDA(dst, b, h) do { _Pragma("unroll") for (int m = 0; m < 4; ++m) _Pragma("unroll") for (int k = 0; k < 2; ++k) dst[m][k] = *(const PG8_LAS bf16x8*)(lds + PG8_SA(b, h) + aoff + m * 2048 + k * 1024); } while (0)
#define PG8_LDB(dst, b, h) do { _Pragma("unroll") for (int n = 0; n < 2; ++n) _Pragma("unroll") for (int k = 0; k < 2; ++k) dst[n][k] = *(const PG8_LAS bf16x8*)(lds + PG8_SB(b, h) + boff + n * 2048 + k * 1024); } while (0)
#define PG8_MMA(ai, bj, At, Bt) do { __builtin_amdgcn_s_setprio(1); _Pragma("unroll") for (int m = 0; m < 4; ++m) _Pragma("unroll") for (int n = 0; n < 2; ++n) _Pragma("unroll") for (int k = 0; k < 2; ++k) \
        acc[ai][bj][m][n] = __builtin_amdgcn_mfma_f32_16x16x32_bf16(Bt[n][k], At[m][k], acc[ai][bj][m][n], 0, 0, 0); __builtin_amdgcn_s_setprio(0); } while (0)
#define PG8_WAIT_V(n) asm volatile("s_waitcnt vmcnt(" #n ")" ::: "memory")
#define PG8_WAIT_L(n) asm volatile("s_waitcnt lgkmcnt(" #n ")" ::: "memory")
#define PG8_BAR __builtin_amdgcn_s_barrier()
#define PG8_SCHED __builtin_amdgcn_sched_barrier(0)
    Unit cur, nxt; int ui = 0;
    if (!S.next(0, cur)) return;
    f32x4 acc[2][2][4][2];
#pragma unroll
    for (int a = 0; a < 2; ++a)
#pragma unroll
        for (int b = 0; b < 2; ++b)
#pragma unroll
            for (int m = 0; m < 4; ++m)
#pragma unroll
                for (int n = 0; n < 2; ++n) acc[a][b][m][n] = (f32x4){0.f, 0.f, 0.f, 0.f};
    bf16x8 At[4][2], B0[2][2], B1[2][2];
    const char* cA = (const char*)g.A + (size_t)cur.pm * tstep; const char* cB = (const char*)g.Bt + (size_t)cur.pn * tstep + (size_t)cur.e * g.estride * 2;
    S.a_ready(cur);
    PG8_STAGE(PG8_SB(0, 0), cB, voffB); PG8_STAGE(PG8_SA(0, 0), cA, voffA); PG8_STAGE(PG8_SB(0, 1), cB + hstep, voffB); PG8_STAGE(PG8_SA(0, 1), cA + hstep, voffA);
    if (wr == 1) PG8_BAR;
    PG8_WAIT_V(4); PG8_BAR;
    PG8_STAGE(PG8_SB(1, 0), cB + kstep, voffB); PG8_STAGE(PG8_SA(1, 0), cA + kstep, voffA); PG8_STAGE(PG8_SB(1, 1), cB + hstep + kstep, voffB);
    PG8_WAIT_V(6); PG8_BAR;
    PG8_STAMP();
    for (;;) {
        const bool has_next = S.next(ui + 1, nxt);
        const char* nA = has_next ? (const char*)g.A + (size_t)nxt.pm * tstep : cA; const char* nB = has_next ? (const char*)g.Bt + (size_t)nxt.pn * tstep + (size_t)nxt.e * g.estride * 2 : cB;
        for (int t = 0; t < nt; t += 2) {
            const bool last = (t == nt - 2);
            const char* a1 = cA + (size_t)(t + 1) * kstep;
            const char* a2 = last ? nA : cA + (size_t)(t + 2) * kstep; const char* b2 = last ? nB : cB + (size_t)(t + 2) * kstep;
            const char* a3 = a2 + kstep; const char* b3 = b2 + kstep;
            if (last && has_next) S.a_ready(nxt);
            PG8_LDB(B0, 0, 0); PG8_SCHED; PG8_LDA(At, 0, 0); PG8_STAGE(PG8_SA(1, 1), a1 + hstep, voffA);
            PG8_WAIT_L(8); PG8_BAR; PG8_WAIT_L(0); PG8_MMA(0, 0, At, B0); PG8_BAR; PG8_SCHED;
            PG8_LDB(B1, 0, 1); PG8_STAGE(PG8_SB(0, 0), b2, voffB);
            PG8_BAR; PG8_WAIT_L(0); PG8_MMA(0, 1, At, B1); PG8_BAR;
            PG8_LDA(At, 0, 1); PG8_STAGE(PG8_SA(0, 0), a2, voffA);
            PG8_BAR; PG8_WAIT_L(0); PG8_MMA(1, 0, At, B0); PG8_BAR; PG8_SCHED;
            PG8_STAGE(PG8_SB(0, 1), b2 + hstep, voffB);
            PG8_WAIT_V(6); PG8_BAR; PG8_MMA(1, 1, At, B1); PG8_BAR;
            PG8_LDB(B0, 1, 0); PG8_SCHED; PG8_LDA(At, 1, 0); PG8_STAGE(PG8_SA(0, 1), a2 + hstep, voffA);
            PG8_WAIT_L(8); PG8_BAR; PG8_WAIT_L(0); PG8_MMA(0, 0, At, B0); PG8_BAR; PG8_SCHED;
            PG8_LDB(B1, 1, 1); PG8_STAGE(PG8_SB(1, 0), b3, voffB);
            PG8_BAR; PG8_WAIT_L(0); PG8_MMA(0, 1, At, B1); PG8_BAR;
            PG8_LDA(At, 1, 1); PG8_STAGE(PG8_SA(1, 0), a3, voffA);
            PG8_BAR; PG8_WAIT_L(0); PG8_MMA(1, 0, At, B0); PG8_BAR; PG8_SCHED;
            PG8_STAGE(PG8_SB(1, 1), b3 + hstep, voffB);
            PG8_WAIT_V(6); PG8_BAR; PG8_MMA(1, 1, At, B1); PG8_BAR;
        }
        PG8_STAMP();
        if constexpr (!Epi::AFTER_DRAIN) { E(acc, cur, wr, wc, fr, fq); S.done(cur); }
        PG8_STAMP();
        if (!has_next) break;
#pragma unroll
        for (int a = 0; a < 2; ++a)
#pragma unroll
            for (int b = 0; b < 2; ++b)
#pragma unroll
                for (int m = 0; m < 4; ++m)
#pragma unroll
                    for (int n = 0; n < 2; ++n) acc[a][b][m][n] = (f32x4){0.f, 0.f, 0.f, 0.f};
        cur = nxt; cA = nA; cB = nB; ++ui;
    }
    PG8_WAIT_V(0);
    if (wr == 0) PG8_BAR;
    PG8_BAR;
    if constexpr (Epi::AFTER_DRAIN) { E.fused(acc, cur, wr, wc, fr, fq, lds, wid, lane); S.done(cur); }
    PG8_STAMP();
    if (STAMP && wid == 0) { stamps[lane] = lane < nts ? (((unsigned long long)(unsigned)ts_hi << 32) | (unsigned)ts_lo) : 0ull;
        if (lane == 62) stamps[62] = rt_entry; if (lane == 63) stamps[63] = (unsigned long long)wall_clock64(); }
#undef PG8_STAMP
#undef PG8_SA
#undef PG8_SB
#undef PG8_STAGE
#undef PG8_LDA
#undef PG8_LDB
#undef PG8_MMA
#undef PG8_WAIT_V
#undef PG8_WAIT_L
#undef PG8_BAR
#undef PG8_SCHED
}
}
namespace pg8 {
struct EpiRes {
    static constexpr bool PERM = false, AFTER_DRAIN = false;
    const float* base_lat; const float* base_ctx; float* out_lat; float* out_ctx; const float* gvec;
    __device__ __forceinline__ void operator()(const f32x4 (&acc)[2][2][4][2], const Unit& u, int wr, int wc, int fr, int fq) const {
        const bool isctx = u.pm >= 128;
        const int prow = (isctx ? (u.pm - 128) : u.pm) * BM;
        const float* base = isctx ? base_ctx : base_lat; float* out = isctx ? out_ctx : out_lat;
        const float* gv = gvec + (size_t)(isctx ? 8 : (u.pm >> 4)) * 6144;
        const int row0 = prow + wr * 64 + fr, col0 = u.pn * BM + wc * 32 + 4 * fq;
        f32x4 gvv[2][2];
#pragma unroll
        for (int bj = 0; bj < 2; ++bj)
#pragma unroll
            for (int n = 0; n < 2; ++n) gvv[bj][n] = *(const f32x4*)(gv + col0 + bj * HALF + n * 16);
#pragma unroll
        for (int ai = 0; ai < 2; ++ai)
#pragma unroll
            for (int m = 0; m < 4; ++m) { const size_t off = (size_t)(row0 + ai * HALF + m * 16) * 1024 + col0;
#pragma unroll
                for (int bj = 0; bj < 2; ++bj)
#pragma unroll
                    for (int n = 0; n < 2; ++n) { const f32x4 b = *(const f32x4*)(base + off + bj * HALF + n * 16);
                        *(f32x4*)(out + off + bj * HALF + n * 16) = b + gvv[bj][n] * acc[ai][bj][m][n]; } }
    }
};
struct EpiSwiglu {
    static constexpr bool PERM = true, AFTER_DRAIN = false;
    bf16_t* O; int ldc;
    __device__ __forceinline__ void operator()(const f32x4 (&acc)[2][2][4][2], const Unit& u, int wr, int wc, int fr, int fq) const {
        const int row0 = u.pm * BM + wr * 64 + fr, col0 = u.pn * HALF + wc * 32 + 8 * fq;
#pragma unroll
        for (int ai = 0; ai < 2; ++ai)
#pragma unroll
            for (int m = 0; m < 4; ++m) { bf16_t* rowp = O + (size_t)(row0 + ai * HALF + m * 16) * ldc + col0;
                float h[8];
#pragma unroll
                for (int n = 0; n < 2; ++n)
#pragma unroll
                    for (int j = 0; j < 4; ++j) { const float g = acc[ai][0][m][n][j], up = acc[ai][1][m][n][j]; h[n * 4 + j] = g * __builtin_amdgcn_rcpf(1.0f + __expf(-g)) * up; }
                u32x4 w; w.x = cvt_pk_bf16(h[0], h[1]); w.y = cvt_pk_bf16(h[2], h[3]); w.z = cvt_pk_bf16(h[4], h[5]); w.w = cvt_pk_bf16(h[6], h[7]);
                *(u32x4*)rowp = w; }
    }
};
struct MoeOrder {
    int nN, G, c, nunits; const int* tab;
    __device__ void init(const int* tab_, int nN_, int G_, int c_) { tab = tab_; nN = nN_; G = G_; c = c_; nunits = tab_[0] * nN_; }
    __device__ bool next(int i, Unit& u) const {
        const int L = i * G + c; if (L >= nunits) return false;
        u.pm = L / nN; u.pn = L - u.pm * nN; u.e = tab[1 + u.pm]; return true;
    }
    __device__ __forceinline__ void a_ready(const Unit&) const {}
    __device__ __forceinline__ void done(const Unit&) const {}
};
}
enum { I_X = 0, I_C, I_CTX, I_CCTX, I_MODW, I_MODB, I_NMIXG, I_NFFNG, I_WIN, I_WOUT, I_LCW, I_LCB, I_LWA, I_LBA, I_LWX, I_LBX, I_LLAM,
       I_RMU, I_RWUP, I_RW0, I_RAUP, I_RA0, I_RGUP, I_RKK, I_RKA, I_RRK, I_RLNG, I_RLNB, I_MIB, I_MFB, I_MNG, I_GCW, I_GALOG, I_GDTB, I_GNG,
       I_FWG, I_FWU, I_FWD, I_MROUTER, I_MWG, I_MWU, I_MWD, I_FNG, N_IN };
struct Args { const float* in[N_IN]; float* out; unsigned char* ws; int ph_lo, ph_hi; };
struct Ctx {
    const float* const* in; float* out; unsigned char* ws; LAS unsigned char* lds;
    int tid, lane, wave, G, wg;
};
#define WSP(T, off) ((T*)(C.ws + (off)))

__device__ __forceinline__ int seqrow_raster(int i, int d, int b) {
    if (i < CTXL) { const int p = d ? (CTXL - 1 - i) : i; return T_LAT + b * CTXL + p; }
    const int j = i - CTXL; const int p = d ? (SEQ - 1 - j) : j; return b * SEQ + p;
}
__device__ __forceinline__ int seqrow_cm(int i, int d, int b) {
    if (i < CTXL) { const int p = d ? (CTXL - 1 - i) : i; return T_LAT + b * CTXL + p; }
    const int j = i - CTXL; const int p = d ? (SEQ - 1 - j) : j; return b * SEQ + (p & 63) * 64 + (p >> 6);
}

__device__ __forceinline__ void phase_pre(const Ctx& C) {
    LAS float* sc = (LAS float*)C.lds;
    LAS float* red = sc + 9 * 1024;
    float* modv = WSP(float, WS_MODV);
    bool filled = false;
    for (int it = C.wg; it < DEPTH * 48; it += C.G) {
        if (!filled) {
            for (int i = C.tid; i < 9 * 1024; i += NTHR) { const float v = i < 8192 ? C.in[I_C][i] : C.in[I_CCTX][i - 8192]; sc[i] = siluf_(v); }
            filled = true; __syncthreads();
        }
        const int l = it / 48, jb = it % 48, col = C.tid & 127, kg = C.tid >> 7;
        const float* W = C.in[I_MODW] + (size_t)l * 1024 * 6144 + jb * 128 + col;
        float acc[9];
#pragma unroll
        for (int r = 0; r < 9; ++r) acc[r] = 0.f;
        for (int k = kg * 256; k < kg * 256 + 256; ++k) { const float w = W[(size_t)k * 6144];
#pragma unroll
            for (int r = 0; r < 9; ++r) acc[r] += sc[r * 1024 + k] * w; }
#pragma unroll
        for (int r = 0; r < 9; ++r) red[(kg * 9 + r) * 128 + col] = acc[r];
        __syncthreads();
        for (int i = C.tid; i < 9 * 128; i += NTHR) { const int r = i >> 7, cc = i & 127;
            const float s = red[(0 * 9 + r) * 128 + cc] + red[(1 * 9 + r) * 128 + cc] + red[(2 * 9 + r) * 128 + cc] + red[(3 * 9 + r) * 128 + cc];
            modv[((size_t)l * 9 + r) * 6144 + jb * 128 + cc] = s + C.in[I_MODB][l * 6144 + jb * 128 + cc]; }
        __syncthreads();
    }
}

__device__ __forceinline__ void tr_item(const float* src, size_t ld, int k0, int ns0, bf16* dst, int drow0, int Kd, LAS float* scr, int lane, bool zero) {
    if (!zero) {
#pragma unroll 8
        for (int i = 0; i < 32; ++i) { const int kk = 2 * i + (lane >> 5); scr[kk * 33 + (lane & 31)] = src[(size_t)(k0 + kk) * ld + ns0 + (lane & 31)]; }
    }
    LDS_WAIT(); asm volatile("" ::: "memory");
    const int c = lane & 7;
#pragma unroll
    for (int j = 0; j < 4; ++j) { const int n = (lane >> 3) + 8 * j; const LAS float* s = scr + (8 * c) * 33 + n;
        v4u o; o.x = pk2(s[0 * 33], s[1 * 33]); o.y = pk2(s[2 * 33], s[3 * 33]); o.z = pk2(s[4 * 33], s[5 * 33]); o.w = pk2(s[6 * 33], s[7 * 33]);
        if (zero) o = (v4u){0u, 0u, 0u, 0u};
        *(v4u*)(dst + (size_t)(drow0 + n) * Kd + k0 + 8 * c) = o; }
    LDS_WAIT(); asm volatile("" ::: "memory");
}
__device__ __forceinline__ void convert_layer(const Ctx& C, int l) {
    LAS float* scr = (LAS float*)(C.lds + C.wave * 8704);
    const int gw = C.wg * NWAVES + C.wave, NGW = C.G * NWAVES;
    constexpr int I_IN = 16 * 112, I_OUT = 16 * 32, I_GU = 16 * 176, I_DN = 44 * 32, I_E = 16 * 88 + 22 * 32;
    const bool moe = l & 1; const int li = l >> 1;
    const int nitems = I_IN + I_OUT + (moe ? NE * I_E : (I_GU + I_DN));
    bf16* win = WSP(bf16, WS_WIN); bf16* wout = WSP(bf16, WS_WOUT); bf16* wgu = WSP(bf16, WS_WGU); bf16* wdn = WSP(bf16, WS_WDN);
    {
        bf16* lw = WSP(bf16, WS_LRUWT);
        for (int k = 0; k < 2 * 2 * 4 * 4096 / (128 * NTHR); ++k) {
            const int e = k * 128 * NTHR + C.wg * NTHR + C.tid;
            if (C.wg < 128) {
            const int i = e & 63, j = (e >> 6) & 63, hd = (e >> 12) & 3, g = (e >> 14) & 1, d = e >> 15;
            const float* src = (g ? C.in[I_LWX] : C.in[I_LWA]) + ((size_t)((l * 2 + d) * 4 + hd) * 64 + i) * 64 + j;
            lw[e] = (bf16)f2bf(*src);
            }
        }
    }
    if (C.wg >= 128 && C.wg < 224) {
        bf16* rw = WSP(bf16, WS_RWT);
        const int e = (C.wg - 128) * NTHR + C.tid;
        if (e < 32768) { const int r = e & 31, ch = (e >> 5) & 255, d = (e >> 13) & 1, isa = e >> 14;
            rw[e] = (bf16)f2bf((isa ? C.in[I_RAUP] : C.in[I_RWUP])[((size_t)(l * 2 + d) * 32 + r) * GW + ch]); }
        else { const int e2 = e - 32768, j = e2 & 63, ch = e2 >> 6; rw[e] = (bf16)f2bf(C.in[I_RGUP][((size_t)l * 64 + j) * GW + ch]); }
    }
    for (int it = gw; it < nitems; it += NGW) {
        int r = it;
        if (r < I_IN) { const int kb = r / 112, nb = r % 112; tr_item(C.in[I_WIN] + (size_t)l * 1024 * IN_COLS, IN_COLS, 64 * kb, 32 * nb, win, 32 * nb, 1024, scr, C.lane, nb == 111); continue; }
        r -= I_IN;
        if (r < I_OUT) { const int kb = r / 32, nb = r % 32; tr_item(C.in[I_WOUT] + (size_t)l * 1024 * 1024, 1024, 64 * kb, 32 * nb, wout, 32 * nb, 1024, scr, C.lane, false); continue; }
        r -= I_OUT;
        if (!moe) {
            if (r < I_GU) { const int kb = r / 176, nb = r % 176, tile = nb >> 3, q = nb & 7;
                const float* src = (q < 4 ? C.in[I_FWG] : C.in[I_FWU]) + (size_t)li * 1024 * DFF;
                tr_item(src, DFF, 64 * kb, tile * 128 + (q & 3) * 32, wgu, 32 * nb, 1024, scr, C.lane, false); continue; }
            r -= I_GU;
            { const int kb = r / 32, nb = r % 32; tr_item(C.in[I_FWD] + (size_t)li * DFF * 1024, 1024, 64 * kb, 32 * nb, wdn, 32 * nb, DFF, scr, C.lane, false); }
        } else {
            const int e = r / I_E; int rr = r % I_E;
            if (rr < 16 * 88) { const int kb = rr / 88, nb = rr % 88, tile = nb >> 3, q = nb & 7;
                const float* src = (q < 4 ? C.in[I_MWG] : C.in[I_MWU]) + ((size_t)li * NE + e) * 1024 * DFE;
                tr_item(src, DFE, 64 * kb, tile * 128 + (q & 3) * 32, wgu + (size_t)e * 2 * DFE * 1024, 32 * nb, 1024, scr, C.lane, false); continue; }
            rr -= 16 * 88;
            { const int kb = rr / 32, nb = rr % 32; tr_item(C.in[I_MWD] + ((size_t)li * NE + e) * DFE * 1024, 1024, 64 * kb, 32 * nb, wdn + (size_t)e * 1024 * DFE, 32 * nb, DFE, scr, C.lane, false); }
        }
    }
}

template <bool ROUTE>
__device__ __forceinline__ void norm_rows(const Ctx& C, int l, const float* xlat, const float* xctx, const float* gain, int shoff, int scoff, int nrows, int moe_li) {
    const float* modv = WSP(float, WS_MODV) + (size_t)l * 9 * 6144;
    bf16* hb = WSP(bf16, WS_HB);
    const int gw = C.wg * NWAVES + C.wave, NGW = C.G * NWAVES;
    LAS unsigned* lcnt = (LAS unsigned*)(C.lds + 65536);
    unsigned* route = WSP(unsigned, WS_ROUTE);
    if (ROUTE) { if (C.tid < 8) lcnt[C.tid] = 0u; __syncthreads(); }
    f32x4 gv[4];
#pragma unroll
    for (int j = 0; j < 4; ++j) gv[j] = *(const f32x4*)(gain + 4 * C.lane + 256 * j);
    for (int m = gw; m < nrows; m += NGW) {
        const bool isctx = m >= T_LAT;
        const float* xr = isctx ? xctx + (size_t)(m - T_LAT) * 1024 : xlat + (size_t)m * 1024;
        const float* mv = modv + (size_t)(isctx ? 8 : (m >> 12)) * 6144;
        f32x4 v[4]; float s = 0.f;
#pragma unroll
        for (int j = 0; j < 4; ++j) { v[j] = *(const f32x4*)(xr + 4 * C.lane + 256 * j); s += (v[j].x * v[j].x + v[j].y * v[j].y) + (v[j].z * v[j].z + v[j].w * v[j].w); }
        const float rs = 1.0f / sqrtf(wave_sum(s) * (1.0f / 1024.0f) + 1e-6f);
#pragma unroll
        for (int j = 0; j < 4; ++j) { const f32x4 sh = *(const f32x4*)(mv + shoff + 4 * C.lane + 256 * j), scl = *(const f32x4*)(mv + scoff + 4 * C.lane + 256 * j);
            v[j] = (v[j] * rs * gv[j]) * (scl + 1.0f) + sh;
            v2u o; o.x = pk2(v[j].x, v[j].y); o.y = pk2(v[j].z, v[j].w);
            *(v2u*)(hb + (size_t)m * 1024 + 4 * C.lane + 256 * j) = o; }
        if (ROUTE) {
            const float* rt = C.in[I_MROUTER] + (size_t)moe_li * 1024 * NE;
            float lg[8];
#pragma unroll
            for (int e = 0; e < 8; ++e) lg[e] = 0.f;
#pragma unroll
            for (int j = 0; j < 4; ++j)
#pragma unroll
                for (int q = 0; q < 4; ++q) { const int k = 4 * C.lane + 256 * j + q; const f32x4 r0 = *(const f32x4*)(rt + (size_t)k * 8), r1 = *(const f32x4*)(rt + (size_t)k * 8 + 4); const float hv = v[j][q];
                    lg[0] += hv * r0.x; lg[1] += hv * r0.y; lg[2] += hv * r0.z; lg[3] += hv * r0.w; lg[4] += hv * r1.x; lg[5] += hv * r1.y; lg[6] += hv * r1.z; lg[7] += hv * r1.w; }
#pragma unroll
            for (int e = 0; e < 8; ++e) lg[e] = wave_sum(lg[e]);
            int e0 = 0; float l0 = lg[0];
#pragma unroll
            for (int e = 1; e < 8; ++e) if (lg[e] > l0) { l0 = lg[e]; e0 = e; }
            int e1 = -1; float l1 = -3.0e38f;
#pragma unroll
            for (int e = 0; e < 8; ++e) if (e != e0 && lg[e] > l1) { l1 = lg[e]; e1 = e; }
            const float w0 = 1.0f / (1.0f + __expf(l1 - l0)), w1 = 1.0f - w0;
            if (C.lane == 0) {
                const unsigned r0 = atomicAdd((unsigned*)&lcnt[e0], 1u), r1 = atomicAdd((unsigned*)&lcnt[e1], 1u);
                v4u a; a.x = (unsigned)e0; a.y = (unsigned)e1; a.z = r0; a.w = r1;
                *(v4u*)(route + (size_t)m * 8) = a;
                v2u b; b.x = __builtin_bit_cast(unsigned, w0); b.y = __builtin_bit_cast(unsigned, w1);
                *(v2u*)(route + (size_t)m * 8 + 4) = b;
            }
        }
    }
    if (ROUTE) {
        __syncthreads();
        if (C.tid < 8) { unsigned* gc = WSP(unsigned, WS_CTL) + CW_MOECNT + 64 * moe_li; const unsigned base = atomicAdd(gc + C.tid, lcnt[C.tid]); WSP(unsigned, WS_WGBASE)[C.wg * 8 + C.tid] = base; }
    }
}
template <bool FIN>
__device__ __forceinline__ void lru_chunk(const Ctx& C, int l, int b, int c) {
    LAS float* U = (LAS float*)C.lds;
    const bf16* P = WSP(const bf16, WS_P);
    const bool isctx = c < 4; const int p0 = isctx ? c * 64 : (c - 4) * 64; const int Lp = isctx ? CTXL : SEQ; const int row0 = isctx ? T_LAT + b * CTXL : b * SEQ;
    const int ch = C.tid & 255, half = C.tid >> 8;
    {
        const float* cw = C.in[I_LCW] + (size_t)l * 4 * GW + ch; const float w0 = cw[0], w1 = cw[GW], w2 = cw[2 * GW], w3 = cw[3 * GW], cb = C.in[I_LCB][l * GW + ch];
        const int t0 = half * 32;
        auto ld = [&](int p) -> float { return (p >= 0 && p < Lp) ? bf2f(P[(size_t)(row0 + p) * PLD + ch]) : 0.f; };
        float xm2 = ld(p0 + t0 - 2), xm1 = ld(p0 + t0 - 1), x0 = ld(p0 + t0);
        for (int t = 0; t < 32; ++t) { const float xp1 = ld(p0 + t0 + t + 1); U[(t0 + t) * 256 + ch] = w0 * xm2 + w1 * xm1 + w2 * x0 + w3 * xp1 + cb; xm2 = xm1; xm1 = x0; x0 = xp1; }
    }
    __syncthreads();
    const int d = half, hd = ch >> 6, jj = ch & 63;
    const float* wa = C.in[I_LWA] + ((size_t)((l * 2 + d) * 4 + hd) * 64) * 64 + jj;
    const float* wx = C.in[I_LWX] + ((size_t)((l * 2 + d) * 4 + hd) * 64) * 64 + jj;
    const float ba = C.in[I_LBA][(l * 2 + d) * GW + ch], bx = C.in[I_LBX][(l * 2 + d) * GW + ch];
    const float sp8 = 8.0f * softplusf_(-C.in[I_LLAM][(l * 2 + d) * GW + ch]);
    const size_t sidx = ((size_t)(b * NCH + c) * 2 + d) * 256 + ch;
    float h = FIN ? WSP(const float, WS_HIN)[sidx] : 0.f, sla = 0.f;
    LAS bf16* H16 = (LAS bf16*)(U + 64 * 256) + d * 64 * 256;
    const int sgn = d ? -1 : 1;
#pragma unroll 1
    for (int g = 0; g < 4; ++g) {
        const int tstart = d ? (63 - g * 16) : g * 16;
        float ar[16], ai[16];
#pragma unroll
        for (int tt = 0; tt < 16; ++tt) { ar[tt] = 0.f; ai[tt] = 0.f; }
        const LAS float* ub = U + tstart * 256 + hd * 64;
#pragma unroll 1
        for (int i = 0; i < 64; i += 4) {
            float a4[4], x4[4];
#pragma unroll
            for (int q = 0; q < 4; ++q) { a4[q] = wa[(i + q) * 64]; x4[q] = wx[(i + q) * 64]; }
#pragma unroll
            for (int tt = 0; tt < 16; ++tt) { const f32x4 uu = *(const LAS f32x4*)(ub + sgn * tt * 256 + i);
                ar[tt] += uu.x * a4[0] + uu.y * a4[1] + uu.z * a4[2] + uu.w * a4[3];
                ai[tt] += uu.x * x4[0] + uu.y * x4[1] + uu.z * x4[2] + uu.w * x4[3]; }
        }
#pragma unroll
        for (int tt = 0; tt < 16; ++tt) {
            const int tok = tstart + sgn * tt;
            const float r = sigmoidf_(ar[tt] + ba), ig = sigmoidf_(ai[tt] + bx);
            const float la = -sp8 * r; const float a = __expf(la);
            const float bb = sqrtf(-expm1f_(2.0f * la)) * (ig * U[tok * 256 + ch]);
            h = a * h + bb; sla += la;
            if (FIN) H16[tok * 256 + ch] = (bf16)f2bf(h);
        }
    }
    if (!FIN) { float* ls = WSP(float, WS_LSUM) + sidx * 2; ls[0] = sla; ls[1] = h; __syncthreads(); return; }
    __syncthreads();
    bf16* yc = WSP(bf16, WS_HB);
    const LAS bf16* H0 = (const LAS bf16*)(U + 64 * 256); const LAS bf16* H1 = H0 + 64 * 256;
    for (int t = half * 32; t < half * 32 + 32; ++t) {
        const size_t row = (size_t)(row0 + p0 + t);
        const float gate = bf2f(P[row * PLD + 256 + ch]);
        yc[row * 1024 + ch] = (bf16)f2bf((bf2f(H0[t * 256 + ch]) + bf2f(H1[t * 256 + ch])) * gelu_tanh(gate));
    }
    __syncthreads();
}
__device__ __forceinline__ void lru_carry(const Ctx& C, int idx) {
    const int ch = idx & 255, d = (idx >> 8) & 1, b = idx >> 9;
    const float* ls = WSP(const float, WS_LSUM); float* hin = WSP(float, WS_HIN);
    float H = 0.f;
    for (int k = 0; k < NCH; ++k) {
        const int c = d ? (k < 4 ? 3 - k : NCH + 3 - k) : k;
        const size_t sidx = ((size_t)(b * NCH + c) * 2 + d) * 256 + ch;
        hin[sidx] = H;
        H = __expf(ls[sidx * 2]) * H + ls[sidx * 2 + 1];
    }
}

__device__ __forceinline__ float rw_shift(const bf16* P, int row0, int p, int Lp, int colB, float mu0, float mu1) {
    const size_t o = (size_t)(row0 + p) * PLD + OFF_B + colB;
    const float x = bf2f(P[o]);
    const float pv = p > 0 ? bf2f(P[o - PLD]) : 0.f, nx = p < Lp - 1 ? bf2f(P[o + PLD]) : 0.f;
    return x + mu0 * (pv - x) + mu1 * (nx - x);
}
__device__ __forceinline__ void rwkv_prep(const Ctx& C, int l, int b, int c) {
    LAS float* XW = (LAS float*)C.lds;
    LAS float* XA = XW + 64 * 64;
    LAS float* XG = XA + 64 * 64;
    const bf16* P = WSP(const bf16, WS_P);
    const bool isctx = c < 4; const int p0 = isctx ? c * 64 : (c - 4) * 64; const int Lp = isctx ? CTXL : SEQ; const int row0 = isctx ? T_LAT + b * CTXL : b * SEQ;
    const float* mu = C.in[I_RMU] + (size_t)l * 2 * B_COLS;
    for (int it = C.tid; it < 64 * 192; it += NTHR) {
        const int t = it / 192, ci = it % 192, colB = 768 + ci;
        const float v = rw_shift(P, row0, p0 + t, Lp, colB, mu[colB], mu[B_COLS + colB]);
        if (ci < 64) XW[t * 64 + ci] = tanhf_(v); else if (ci < 128) XA[t * 64 + ci - 64] = v; else XG[t * 64 + ci - 128] = sigmoidf_(v);
    }
    __syncthreads();
    const int ch = C.tid & 255, half = C.tid >> 8, head = ch >> 6;
    bf16* wa_out = WSP(bf16, WS_HB); bf16* g_out = WSP(bf16, WS_G); float* bonus = WSP(float, WS_BONUS);
    const float* wup = C.in[I_RWUP] + (size_t)l * 2 * 32 * GW + ch;
    const float* aup = C.in[I_RAUP] + (size_t)l * 2 * 32 * GW + ch;
    const float* gup = C.in[I_RGUP] + (size_t)l * 64 * GW + ch;
    const float w00 = C.in[I_RW0][(l * 2 + 0) * GW + ch], w01 = C.in[I_RW0][(l * 2 + 1) * GW + ch];
    const float a00 = C.in[I_RA0][(l * 2 + 0) * GW + ch], a01 = C.in[I_RA0][(l * 2 + 1) * GW + ch];
    const float k_a = C.in[I_RKA][l * GW + ch], r_k = C.in[I_RRK][l * GW + ch];
    const float mur0 = mu[ch], mur1 = mu[B_COLS + ch], muk0 = mu[256 + ch], muk1 = mu[B_COLS + 256 + ch];
#pragma unroll 1
    for (int sub = 0; sub < 2; ++sub) {
        const int t0 = half * 32 + sub * 16;
        float acc[16], av0[16], av1[16];
#pragma unroll
        for (int kind = 0; kind < 4; ++kind) {
            const int d = kind & 1; const bool isw = kind < 2;
            const float* W = (isw ? wup : aup) + (size_t)d * 32 * GW; const LAS float* X = (isw ? XW : XA) + d * 32;
#pragma unroll
            for (int t = 0; t < 16; ++t) acc[t] = 0.f;
            for (int r = 0; r < 32; r += 4) {
                const float g0 = W[(r + 0) * GW], g1 = W[(r + 1) * GW], g2 = W[(r + 2) * GW], g3 = W[(r + 3) * GW];
#pragma unroll
                for (int t = 0; t < 16; ++t) { const f32x4 x = *(const LAS f32x4*)(X + (t0 + t) * 64 + r); acc[t] += x.x * g0 + x.y * g1 + x.z * g2 + x.w * g3; }
            }
#pragma unroll
            for (int t = 0; t < 16; ++t) {
                const size_t row = (size_t)(row0 + p0 + t0 + t);
                float val;
                if (isw) val = __expf(-0.6065306597126334f * sigmoidf_(acc[t] + (d ? w01 : w00)));
                else { val = sigmoidf_(acc[t] + (d ? a01 : a00)); if (d) av1[t] = val; else av0[t] = val; }
                wa_out[row * 1024 + kind * 256 + ch] = (bf16)f2bf(val);
            }
        }
#pragma unroll
        for (int t = 0; t < 16; ++t) acc[t] = 0.f;
        for (int j = 0; j < 64; j += 4) {
            const float g0 = gup[(j + 0) * GW], g1 = gup[(j + 1) * GW], g2 = gup[(j + 2) * GW], g3 = gup[(j + 3) * GW];
#pragma unroll
            for (int t = 0; t < 16; ++t) { const f32x4 x = *(const LAS f32x4*)(XG + (t0 + t) * 64 + j); acc[t] += x.x * g0 + x.y * g1 + x.z * g2 + x.w * g3; }
        }
#pragma unroll
        for (int t = 0; t < 16; ++t) {
            const int p = p0 + t0 + t; const size_t row = (size_t)(row0 + p);
            g_out[row * 256 + ch] = (bf16)f2bf(acc[t]);
            const float rs = rw_shift(P, row0, p, Lp, ch, mur0, mur1), ks = rw_shift(P, row0, p, Lp, 256 + ch, muk0, muk1);
            const float km = ks * (1.0f + (av0[t] - 1.0f) * k_a) + ks * (1.0f + (av1[t] - 1.0f) * k_a);
            const float bs = wave_sum(rs * r_k * km);
            if (C.lane == 0) bonus[row * 4 + head] = bs;
        }
    }
    __syncthreads();
}
__device__ __forceinline__ void rwkv_scan(const Ctx& C, int l, int idx) {
    const int d = idx >> 6, b = (idx >> 3) & 7, h = (idx >> 1) & 3, half = idx & 1;
    LAS float* BUF = (LAS float*)C.lds;
    LAS float* YB = BUF + 2 * 32 * 6 * 64;
    const bf16* P = WSP(const bf16, WS_P); const bf16* WA = WSP(const bf16, WS_HB); bf16* outb = WSP(bf16, WS_OUTB) + (size_t)d * T_ALL * 256;
    const int st = C.tid >> 4, q4 = C.tid & 15, chh = h * 64 + q4 * 4;
    const float* mu = C.in[I_RMU] + (size_t)l * 2 * B_COLS;
    f32x4 mu0[3], mu1[3];
#pragma unroll
    for (int q = 0; q < 3; ++q) { mu0[q] = *(const f32x4*)(mu + q * 256 + chh); mu1[q] = *(const f32x4*)(mu + B_COLS + q * 256 + chh); }
    const f32x4 kk_w = *(const f32x4*)(C.in[I_RKK] + l * GW + chh), ka_w = *(const f32x4*)(C.in[I_RKA] + l * GW + chh);
    v2u gxc[3], gxp[3], gxn[3], gwr, gar;
    auto gload = [&](int nb) {
        const int i = nb * 32 + st;
        const bool isctx = i < CTXL; const int Lp = isctx ? CTXL : SEQ; const int j = isctx ? i : i - CTXL; const int p = d ? (Lp - 1 - j) : j;
        const int row = (isctx ? T_LAT + b * CTXL : b * SEQ) + p;
#pragma unroll
        for (int q = 0; q < 3; ++q) {
            const bf16* pp = P + (size_t)row * PLD + OFF_B + q * 256 + chh;
            gxc[q] = *(const v2u*)pp; gxp[q] = (v2u){0u, 0u}; gxn[q] = (v2u){0u, 0u};
            if (p > 0) gxp[q] = *(const v2u*)(pp - PLD);
            if (p < Lp - 1) gxn[q] = *(const v2u*)(pp + PLD);
        }
        gwr = *(const v2u*)(WA + (size_t)row * 1024 + d * 256 + chh); gar = *(const v2u*)(WA + (size_t)row * 1024 + (2 + d) * 256 + chh);
    };
    auto sfinish = [&](int bufi) {
        f32x4 sh[3];
#pragma unroll
        for (int q = 0; q < 3; ++q) {
            const f32x4 x = (f32x4){bflo(gxc[q].x), bfhi(gxc[q].x), bflo(gxc[q].y), bfhi(gxc[q].y)}, pv = (f32x4){bflo(gxp[q].x), bfhi(gxp[q].x), bflo(gxp[q].y), bfhi(gxp[q].y)}, nx = (f32x4){bflo(gxn[q].x), bfhi(gxn[q].x), bflo(gxn[q].y), bfhi(gxn[q].y)};
            sh[q] = x + mu0[q] * (pv - x) + mu1[q] * (nx - x);
        }
        const f32x4 w = (f32x4){bflo(gwr.x), bfhi(gwr.x), bflo(gwr.y), bfhi(gwr.y)}, a = (f32x4){bflo(gar.x), bfhi(gar.x), bflo(gar.y), bfhi(gar.y)};
        f32x4 kk = sh[1] * kk_w;
        const float ss = row16_sum((kk.x * kk.x + kk.y * kk.y) + (kk.z * kk.z + kk.w * kk.w));
        kk = kk * (1.0f / sqrtf(ss + 1e-6f));
        const f32x4 km = sh[1] * ((a - 1.0f) * ka_w + 1.0f), beta = kk * a;
        LAS float* o = BUF + ((bufi * 32 + st) * 6) * 64 + q4 * 4;
        *(LAS f32x4*)(o + 0 * 64) = sh[0]; *(LAS f32x4*)(o + 1 * 64) = kk; *(LAS f32x4*)(o + 2 * 64) = w; *(LAS f32x4*)(o + 3 * 64) = beta; *(LAS f32x4*)(o + 4 * 64) = km; *(LAS f32x4*)(o + 5 * 64) = sh[2];
    };
    const int rr = C.tid >> 4, jq = C.tid & 15;
    f32x4 s = (f32x4){0.f, 0.f, 0.f, 0.f};
    constexpr int NBLK = NSTEP / 32;
    gload(0); sfinish(0); gload(1);
    __syncthreads();
    for (int nb = 0; nb < NBLK; ++nb) {
        if (nb + 1 < NBLK) { sfinish((nb + 1) & 1); if (nb + 2 < NBLK) gload(nb + 2); }
        const LAS float* bb = BUF + ((nb & 1) * 32) * 6 * 64;
        LAS float* yb = YB + (nb & 1) * 1024;
        const LAS float* o0 = bb + jq * 4; const LAS float* v0 = bb + 5 * 64 + half * 32 + rr;
        f32x4 r4 = *(const LAS f32x4*)(o0), kk = *(const LAS f32x4*)(o0 + 64), wv = *(const LAS f32x4*)(o0 + 128), be = *(const LAS f32x4*)(o0 + 192), km = *(const LAS f32x4*)(o0 + 256);
        float vv = v0[0];
#pragma unroll
        for (int hb = 0; hb < 2; ++hb) {
            float ysel = 0.f;
#pragma unroll
            for (int t16 = 0; t16 < 16; ++t16) {
                const int t = hb * 16 + t16;
                const f32x4 cr = r4, ck = kk, cw = wv, cb = be, cm_ = km; const float cv = vv;
                if (t + 1 < 32) { const LAS float* o = o0 + (t + 1) * 6 * 64;
                    r4 = *(const LAS f32x4*)(o); kk = *(const LAS f32x4*)(o + 64); wv = *(const LAS f32x4*)(o + 128); be = *(const LAS f32x4*)(o + 192); km = *(const LAS f32x4*)(o + 256); vv = v0[(t + 1) * 6 * 64]; }
                const float sk = row16_sum((s.x * ck.x + s.y * ck.y) + (s.z * ck.z + s.w * ck.w));
                s = s * cw - cb * sk + cm_ * cv;
                const float y = row16_sum((s.x * cr.x + s.y * cr.y) + (s.z * cr.z + s.w * cr.w));
                ysel = (jq == t16) ? y : ysel;
            }
            yb[(hb * 16 + jq) * 32 + rr] = ysel;
        }
        __syncthreads();
        {
            const int t = C.tid >> 4, r2 = (C.tid & 15) * 2;
            const int i = nb * 32 + t; const int row = seqrow_raster(i, d, b);
            *(unsigned*)(outb + (size_t)row * 256 + h * 64 + half * 32 + r2) = pk2(yb[t * 32 + r2], yb[t * 32 + r2 + 1]);
        }
    }
    __syncthreads();
}

#define RAW_BARRIER() do { asm volatile("s_waitcnt lgkmcnt(0)" ::: "memory"); __builtin_amdgcn_s_barrier(); asm volatile("" ::: "memory"); } while (0)
__device__ __forceinline__ void mlstm_scan_v0(const Ctx& C, int l, int idx) {
    const int d = idx >> 5, b = (idx >> 2) & 7, h = idx & 3, lane = C.lane, w = C.wave;
    LAS float* PN = (LAS float*)C.lds;
    LAS float* PD = PN + 2 * 8 * 64;
    LAS unsigned char* SB = C.lds + 8192;
    constexpr int SBS = 3 * 4096 + 256;
    const bf16* P = WSP(const bf16, WS_P); bf16* outc = WSP(bf16, WS_OUTC) + (size_t)d * T_ALL * 256;
    const float ib = C.in[I_MIB][(l * 2 + d) * NH + h], fb = C.in[I_MFB][(l * 2 + d) * NH + h];
    const int st_ = C.tid >> 4, part = C.tid & 15;
    auto stage = [&](int nb, int bufi) {
        const int row = seqrow_cm(nb * 32 + st_, d, b);
        const size_t ro = (size_t)row * PLD + OFF_C + h * 64 + part * 4;
        LAS unsigned char* sb = SB + bufi * SBS;
        *(LAS v2u*)(sb + st_ * 128 + part * 8) = *(const v2u*)(P + ro);
        *(LAS v2u*)(sb + 4096 + st_ * 128 + part * 8) = *(const v2u*)(P + ro + 256);
        *(LAS v2u*)(sb + 8192 + st_ * 128 + part * 8) = *(const v2u*)(P + ro + 512);
        if (part == 0) { const size_t rg = (size_t)row * PLD + OFF_C + 1024;
            const float li = bf2f(P[rg + d * 4 + h]) + ib, gf = bf2f(P[rg + 8 + d * 4 + h]) + fb;
            *(LAS f32x2*)(sb + 12288 + st_ * 8) = (f32x2){li, -softplusf_(-gf)}; }
    };
    float Cm[8], nk[8];
#pragma unroll
    for (int k = 0; k < 8; ++k) { Cm[k] = 0.f; nk[k] = 0.f; }
    float m = 0.f;
    stage(0, 0);
    __syncthreads();
    for (int nb = 0; nb < NSTEP / 32; ++nb) {
        if (nb + 1 < NSTEP / 32) stage(nb + 1, (nb + 1) & 1);
        const LAS unsigned char* sb = SB + (nb & 1) * SBS;
#pragma unroll 2
        for (int t = 0; t < 32; ++t) {
            const int i = nb * 32 + t;
            const v4u cq = *(const LAS v4u*)(sb + t * 128 + w * 16), ck = *(const LAS v4u*)(sb + 4096 + t * 128 + w * 16);
            const float vv = bf2f(*(const LAS unsigned short*)(sb + 8192 + t * 128 + lane * 2));
            const f32x2 gt = *(const LAS f32x2*)(sb + 12288 + t * 8);
            const float li = gt.x, lf = gt.y;
            const float mn = fmaxf(lf + m, li), fp = __expf(lf + m - mn), ip = __expf(li - mn);
            const float qf[8] = {bflo(cq.x), bfhi(cq.x), bflo(cq.y), bfhi(cq.y), bflo(cq.z), bfhi(cq.z), bflo(cq.w), bfhi(cq.w)};
            const float kf[8] = {bflo(ck.x), bfhi(ck.x), bflo(ck.y), bfhi(ck.y), bflo(ck.z), bfhi(ck.z), bflo(ck.w), bfhi(ck.w)};
            const float ipv = ip * vv;
            float num = 0.f, den = 0.f;
#pragma unroll
            for (int k = 0; k < 8; ++k) { const float kk = kf[k] * 0.125f; Cm[k] = fp * Cm[k] + ipv * kk; nk[k] = fp * nk[k] + ip * kk; num += Cm[k] * qf[k]; den += nk[k] * qf[k]; }
            m = mn;
            const int pb_ = i & 1;
            PN[(pb_ * 8 + w) * 64 + lane] = num; if (lane == 0) PD[pb_ * 8 + w] = den;
            RAW_BARRIER();
            if (w == 0) {
                float ns = 0.f, ds = 0.f;
#pragma unroll
                for (int ww = 0; ww < 8; ++ww) { ns += PN[(pb_ * 8 + ww) * 64 + lane]; ds += PD[pb_ * 8 + ww]; }
                outc[(size_t)seqrow_cm(i, d, b) * 256 + h * 64 + lane] = (bf16)f2bf(ns / fmaxf(fabsf(ds), __expf(-mn)));
            }
        }
        __syncthreads();
    }
}

__device__ __forceinline__ void gdn_prep(const Ctx& C, int l, int b, int c) {
    const bf16* P = WSP(const bf16, WS_P); bf16* gq = WSP(bf16, WS_GQ);
    const bool isctx = c < 4; const int p0 = isctx ? c * 64 : (c - 4) * 64; const int Lp = isctx ? CTXL : SEQ;
    const int lane = C.lane;
    auto rowof = [&](int p) -> int { return isctx ? (T_LAT + b * CTXL + p) : (b * SEQ + (p & 63) * 64 + (p >> 6)); };
    float cw[4][12], x[4][12];
#pragma unroll
    for (int j = 0; j < 4; ++j)
#pragma unroll
        for (int i = 0; i < 12; ++i) cw[j][i] = C.in[I_GCW][((size_t)l * 4 + j) * 768 + i * 64 + lane];
    const int tb = p0 + C.wave * 8;
    auto ldrow = [&](int p, float (&dst)[12]) {
        if (p >= 0 && p < Lp) { const size_t ro = (size_t)rowof(p) * PLD + OFF_D;
#pragma unroll
            for (int i = 0; i < 12; ++i) dst[i] = bf2f(P[ro + i * 64 + lane]); }
        else {
#pragma unroll
            for (int i = 0; i < 12; ++i) dst[i] = 0.f; }
    };
    ldrow(tb - 2, x[0]); ldrow(tb - 1, x[1]); ldrow(tb, x[2]);
#pragma unroll 1
    for (int t = 0; t < 8; ++t) {
        ldrow(tb + t + 1, x[3]);
        const size_t ro = (size_t)rowof(tb + t) * 768;
#pragma unroll
        for (int i = 0; i < 12; ++i) {
            float v = siluf_(cw[0][i] * x[0][i] + cw[1][i] * x[1][i] + cw[2][i] * x[2][i] + cw[3][i] * x[3][i]);
            if (i < 8) { const float ss = wave_sum(v * v); v *= (1.0f / sqrtf(ss + 1e-6f)) * (i < 4 ? 0.125f : 1.0f); }
            gq[ro + i * 64 + lane] = (bf16)f2bf(v);
        }
#pragma unroll
        for (int i = 0; i < 12; ++i) { x[0][i] = x[1][i]; x[1][i] = x[2][i]; x[2][i] = x[3][i]; }
    }
}
__device__ __forceinline__ void gdn_scan_v0(const Ctx& C, int l, int idx) {
    const int d = idx >> 5, b = (idx >> 2) & 7, h = idx & 3, lane = C.lane, w = C.wave;
    LAS float* PA = (LAS float*)C.lds;
    LAS float* PB = PA + 2 * 8 * 64;
    LAS unsigned char* SB = C.lds + 8192;
    constexpr int SBS = 3 * 4096 + 256;
    const bf16* P = WSP(const bf16, WS_P); const bf16* gq = WSP(const bf16, WS_GQ); bf16* outd = WSP(bf16, WS_OUTD) + (size_t)d * T_ALL * 256;
    const float aexp = __expf(C.in[I_GALOG][(l * 2 + d) * NH + h]), dtb = C.in[I_GDTB][(l * 2 + d) * NH + h];
    const int st_ = C.tid >> 4, part = C.tid & 15;
    auto stage = [&](int nb, int bufi) {
        const int row = seqrow_cm(nb * 32 + st_, d, b);
        const size_t rq = (size_t)row * 768 + h * 64 + part * 4;
        LAS unsigned char* sb = SB + bufi * SBS;
        *(LAS v2u*)(sb + st_ * 128 + part * 8) = *(const v2u*)(gq + rq);
        *(LAS v2u*)(sb + 4096 + st_ * 128 + part * 8) = *(const v2u*)(gq + rq + 256);
        *(LAS v2u*)(sb + 8192 + st_ * 128 + part * 8) = *(const v2u*)(gq + rq + 512);
        if (part == 0) { const size_t ro = (size_t)row * PLD + OFF_D + 1024;
            const float ga = bf2f(P[ro + d * 4 + h]), gb = bf2f(P[ro + 8 + d * 4 + h]);
            *(LAS f32x2*)(sb + 12288 + st_ * 8) = (f32x2){__expf(-aexp * softplusf_(ga + dtb)), sigmoidf_(gb)}; }
    };
    float S[8];
#pragma unroll
    for (int k = 0; k < 8; ++k) S[k] = 0.f;
    stage(0, 0);
    __syncthreads();
    int prow = 0;
    for (int nb = 0; nb < NSTEP / 32; ++nb) {
        if (nb + 1 < NSTEP / 32) stage(nb + 1, (nb + 1) & 1);
        const LAS unsigned char* sb = SB + (nb & 1) * SBS;
#pragma unroll 2
        for (int t = 0; t < 32; ++t) {
            const int i = nb * 32 + t;
            const v4u cq = *(const LAS v4u*)(sb + t * 128 + w * 16), ck = *(const LAS v4u*)(sb + 4096 + t * 128 + w * 16);
            const float vv = bf2f(*(const LAS unsigned short*)(sb + 8192 + t * 128 + lane * 2));
            const f32x2 gt = *(const LAS f32x2*)(sb + 12288 + t * 8);
            const float alpha = gt.x, beta = gt.y;
            const float qf[8] = {bflo(cq.x), bfhi(cq.x), bflo(cq.y), bfhi(cq.y), bflo(cq.z), bfhi(cq.z), bflo(cq.w), bfhi(cq.w)};
            const float kf[8] = {bflo(ck.x), bfhi(ck.x), bflo(ck.y), bfhi(ck.y), bflo(ck.z), bfhi(ck.z), bflo(ck.w), bfhi(ck.w)};
            float ks = 0.f;
#pragma unroll
            for (int k = 0; k < 8; ++k) ks += kf[k] * S[k];
            const int pb_ = i & 1;
            PA[(pb_ * 8 + w) * 64 + lane] = ks;
            RAW_BARRIER();
            if (w == 0 && i > 0) {
                float os = 0.f;
#pragma unroll
                for (int ww = 0; ww < 8; ++ww) os += PB[((pb_ ^ 1) * 8 + ww) * 64 + lane];
                outd[(size_t)prow * 256 + h * 64 + lane] = (bf16)f2bf(os);
            }
            float kS = 0.f;
#pragma unroll
            for (int ww = 0; ww < 8; ++ww) kS += PA[(pb_ * 8 + ww) * 64 + lane];
            const float coef = beta * (vv - alpha * kS);
            float o = 0.f;
#pragma unroll
            for (int k = 0; k < 8; ++k) { S[k] = alpha * S[k] + kf[k] * coef; o += qf[k] * S[k]; }
            PB[(pb_ * 8 + w) * 64 + lane] = o;
            prow = seqrow_cm(i, d, b);
        }
        __syncthreads();
    }
    if (w == 0) {
        float os = 0.f;
#pragma unroll
        for (int ww = 0; ww < 8; ++ww) os += PB[(((NSTEP - 1) & 1) * 8 + ww) * 64 + lane];
        outd[(size_t)prow * 256 + h * 64 + lane] = (bf16)f2bf(os);
    }
    __syncthreads();
}

__device__ __forceinline__ f32x4 ld4bf(const bf16* p) { const v2u a = *(const v2u*)p; return (f32x4){bflo(a.x), bfhi(a.x), bflo(a.y), bfhi(a.y)}; }
__device__ __forceinline__ void st4bf(bf16* p, const f32x4& v) { v2u o; o.x = pk2(v.x, v.y); o.y = pk2(v.z, v.w); *(v2u*)p = o; }
__device__ __forceinline__ void finish_rows(const Ctx& C, int l, int nrows) {
    const bf16* P = WSP(const bf16, WS_P); bf16* yc = WSP(bf16, WS_HB);
    const bf16* ob = WSP(const bf16, WS_OUTB); const bf16* oc = WSP(const bf16, WS_OUTC); const bf16* od = WSP(const bf16, WS_OUTD);
    const bf16* gg = WSP(const bf16, WS_G); const float* bonus = WSP(const float, WS_BONUS);
    const float* mu = C.in[I_RMU] + (size_t)l * 2 * B_COLS;
    const int gw = C.wg * NWAVES + C.wave, NGW = C.G * NWAVES, lane = C.lane, ch = 4 * lane, hh = lane >> 4;
    const f32x4 lng = *(const f32x4*)(C.in[I_RLNG] + l * GW + ch), lnb = *(const f32x4*)(C.in[I_RLNB] + l * GW + ch);
    const f32x4 mng = *(const f32x4*)(C.in[I_MNG] + l * GW + ch), gng = *(const f32x4*)(C.in[I_GNG] + l * GW + ch);
    const f32x4 mu0 = *(const f32x4*)(mu + 512 + ch), mu1 = *(const f32x4*)(mu + B_COLS + 512 + ch);
    const size_t o2 = (size_t)T_ALL * 256;
#pragma unroll 2
    for (int m = gw; m < nrows; m += NGW) {
        const bool isctx = m >= T_LAT; const int Lp = isctx ? CTXL : SEQ; const int p = isctx ? ((m - T_LAT) & (CTXL - 1)) : (m & (SEQ - 1));
        const f32x4 yb = ld4bf(ob + (size_t)m * 256 + ch) + ld4bf(ob + o2 + (size_t)m * 256 + ch);
        const f32x4 ycv = ld4bf(oc + (size_t)m * 256 + ch) + ld4bf(oc + o2 + (size_t)m * 256 + ch);
        const f32x4 yd = ld4bf(od + (size_t)m * 256 + ch) + ld4bf(od + o2 + (size_t)m * 256 + ch);
        const bf16* pr = P + (size_t)m * PLD;
        const f32x4 xv = ld4bf(pr + OFF_B + 512 + ch);
        f32x4 pv = (f32x4){0.f, 0.f, 0.f, 0.f}, nx = pv;
        if (p > 0) pv = ld4bf(pr - PLD + OFF_B + 512 + ch);
        if (p < Lp - 1) nx = ld4bf(pr + PLD + OFF_B + 512 + ch);
        const f32x4 og = ld4bf(pr + OFF_C + 768 + ch), gd = ld4bf(pr + OFF_D + 768 + ch), gr = ld4bf(gg + (size_t)m * 256 + ch);
        const float bn = bonus[(size_t)m * 4 + hh];
        {
            const float mean = row16_sum((yb.x + yb.y) + (yb.z + yb.w)) * (1.0f / 64.0f);
            const f32x4 dl = yb - mean;
            const float var = row16_sum((dl.x * dl.x + dl.y * dl.y) + (dl.z * dl.z + dl.w * dl.w)) * (1.0f / 64.0f);
            const f32x4 yn = dl * (1.0f / sqrtf(var + 64e-5f)) * lng + lnb;
            const f32x4 vs = xv + mu0 * (pv - xv) + mu1 * (nx - xv);
            st4bf(yc + (size_t)m * 1024 + 256 + ch, (yn + vs * bn) * gr);
        }
        {
            const float ms = row16_sum((ycv.x * ycv.x + ycv.y * ycv.y) + (ycv.z * ycv.z + ycv.w * ycv.w)) * (1.0f / 64.0f);
            const f32x4 sg = (f32x4){sigmoidf_(og.x), sigmoidf_(og.y), sigmoidf_(og.z), sigmoidf_(og.w)};
            st4bf(yc + (size_t)m * 1024 + 512 + ch, ycv * (1.0f / sqrtf(ms + 1e-6f)) * mng * sg);
        }
        {
            const float ms = row16_sum((yd.x * yd.x + yd.y * yd.y) + (yd.z * yd.z + yd.w * yd.w)) * (1.0f / 64.0f);
            const f32x4 sg = (f32x4){siluf_(gd.x), siluf_(gd.y), siluf_(gd.z), siluf_(gd.w)};
            st4bf(yc + (size_t)m * 1024 + 768 + ch, yd * (1.0f / sqrtf(ms + 1e-6f)) * gng * sg);
        }
    }
}
typedef bf16x8 fragb;
__device__ __forceinline__ f32x4 mfma16(fragb a, fragb b, f32x4 c) { return __builtin_amdgcn_mfma_f32_16x16x32_bf16(a, b, c, 0, 0, 0); }
__device__ __forceinline__ fragb ld_frag16(const LAS bf16* p) { return *(const LAS fragb*)p; }
__device__ __forceinline__ fragb ld_frag8x2(const LAS bf16* p0, const LAS bf16* p1) {
    const v2u a = *(const LAS v2u*)p0, b = *(const LAS v2u*)p1; v4u r; r.x = a.x; r.y = a.y; r.z = b.x; r.w = b.y; return __builtin_bit_cast(fragb, r); }
__device__ __forceinline__ fragb pack_frag(const f32x4& lo, const f32x4& hi) { v4u r; r.x = pk2(lo.x, lo.y); r.y = pk2(lo.z, lo.w); r.z = pk2(hi.x, hi.y); r.w = pk2(hi.z, hi.w); return __builtin_bit_cast(fragb, r); }
__device__ __forceinline__ float wave_incl_sum(float v, int lane) {
#pragma unroll
    for (int o = 1; o < 64; o <<= 1) { const float y = __shfl_up(v, o); if (lane >= o) v += y; }
    return v;
}
__device__ __forceinline__ float wave_incl_max(float v, int lane) {
#pragma unroll
    for (int o = 1; o < 64; o <<= 1) { const float y = __shfl_up(v, o); if (lane >= o) v = fmaxf(v, y); }
    return v;
}
constexpr int MP = 72;
__device__ __forceinline__ void mlstm_chunked(const Ctx& C, int l, int idx) {
    const int d = idx >> 5, b = (idx >> 2) & 7, h = idx & 3, lane = C.lane, w = C.wave, l15 = lane & 15, q = lane >> 4;
    const int it = w & 3, vtp = w >> 2;
    constexpr int IMG = 64 * MP * 2, BUFB = 4 * IMG + 1024, CTB = 65 * MP * 2 + 16;
    LAS unsigned char* L0 = C.lds;
    const bf16* P = WSP(const bf16, WS_P); bf16* outc = WSP(bf16, WS_OUTC) + (size_t)d * T_ALL * 256;
    const float ib = C.in[I_MIB][(l * 2 + d) * NH + h], fb = C.in[I_MFB][(l * 2 + d) * NH + h];
    const int tt = C.tid >> 3, part = C.tid & 7;
    for (int i = C.tid; i < 2 * CTB / 4; i += NTHR) ((LAS unsigned*)(L0 + 2 * BUFB))[i] = 0u;
    v4u rq, rk, rv; unsigned short rgi, rgf;
    auto gload = [&](int n) {
        const int row = seqrow_cm(n * 64 + tt, d, b);
        const bf16* pp = P + (size_t)row * PLD + OFF_C + h * 64 + 8 * part;
        rq = *(const v4u*)pp; rk = *(const v4u*)(pp + 256); rv = *(const v4u*)(pp + 512);
        const bf16* pg = P + (size_t)seqrow_cm(n * 64 + lane, d, b) * PLD + OFF_C + 1024 + d * 4 + h;
        rgi = pg[0]; rgf = pg[8];
    };
    auto images = [&](int bufi) {
        LAS unsigned char* B0 = L0 + bufi * BUFB;
        LAS bf16* Qs = (LAS bf16*)B0; LAS bf16* Ks = Qs + 64 * MP; LAS bf16* VT = Ks + 64 * MP; LAS bf16* KTw = VT + 64 * MP; LAS float* vec = (LAS float*)(B0 + 4 * IMG);
        const float li = bf2f(rgi) + ib, lf = -softplusf_(-(bf2f(rgf) + fb));
        const float bc = wave_incl_sum(lf, lane), x = li - bc, cm = wave_incl_max(x, lane);
        const float wl = __expf(x - __shfl(cm, 63)) * 0.125f;
        if (w == 0) { vec[lane] = x; vec[64 + lane] = cm; vec[128 + lane] = bc; }
        const float wmine = __shfl(wl, 8 * w + (lane >> 3));
        *(LAS v4u*)(Qs + tt * MP + 8 * part) = rq; *(LAS v4u*)(Ks + tt * MP + 8 * part) = rk;
        const unsigned vv[4] = {rv.x, rv.y, rv.z, rv.w}, kk[4] = {rk.x, rk.y, rk.z, rk.w};
#pragma unroll
        for (int e = 0; e < 4; ++e) {
            VT[(8 * part + 2 * e) * MP + tt] = (bf16)(vv[e] & 0xffffu); VT[(8 * part + 2 * e + 1) * MP + tt] = (bf16)(vv[e] >> 16);
            KTw[(8 * part + 2 * e) * MP + tt] = (bf16)f2bf(bflo(kk[e]) * wmine); KTw[(8 * part + 2 * e + 1) * MP + tt] = (bf16)f2bf(bfhi(kk[e]) * wmine);
        }
    };
    f32x4 Cst[2], nst; float m = 0.f;
    Cst[0] = Cst[1] = nst = (f32x4){0.f, 0.f, 0.f, 0.f};
    const fragb ones = __builtin_bit_cast(fragb, (v4u){0x3F803F80u, 0x3F803F80u, 0x3F803F80u, 0x3F803F80u});
    const f32x4 z4 = (f32x4){0.f, 0.f, 0.f, 0.f};
    gload(0); images(0); gload(1);
#pragma unroll 1
    for (int n = 0; n < NCH; ++n) {
        __syncthreads();
        const LAS unsigned char* B0 = L0 + (n & 1) * BUFB;
        const LAS bf16* Qs = (const LAS bf16*)B0; const LAS bf16* Ks = Qs + 64 * MP; const LAS bf16* VT = Ks + 64 * MP; const LAS bf16* KTw = VT + 64 * MP; const LAS float* vec = (const LAS float*)(B0 + 4 * IMG);
        const LAS bf16* CT = (const LAS bf16*)(L0 + 2 * BUFB + (n & 1) * CTB); LAS bf16* CTn = (LAS bf16*)(L0 + 2 * BUFB + ((n + 1) & 1) * CTB);
        fragb Qf[2]; Qf[0] = ld_frag16(Qs + (16 * it + l15) * MP + 8 * q); Qf[1] = ld_frag16(Qs + (16 * it + l15) * MP + 32 + 8 * q);
        const float cmi = vec[64 + 16 * it + l15]; const int icol = 16 * it + l15;
        f32x4 pt[4];
#pragma unroll
        for (int jt = 0; jt < 4; ++jt) {
            pt[jt] = z4;
            if (jt <= it) {
                const fragb k0 = ld_frag16(Ks + (16 * jt + l15) * MP + 8 * q), k1 = ld_frag16(Ks + (16 * jt + l15) * MP + 32 + 8 * q);
                f32x4 st = mfma16(k0, Qf[0], z4); st = mfma16(k1, Qf[1], st);
                const f32x4 xj = *(const LAS f32x4*)(vec + 16 * jt + 4 * q);
#pragma unroll
                for (int r = 0; r < 4; ++r) { const int j = 16 * jt + 4 * q + r; pt[jt][r] = (j <= icol) ? st[r] * __expf(xj[r] - cmi) * 0.125f : 0.f; }
            }
        }
        fragb Pf[2]; Pf[0] = pack_frag(pt[0], pt[1]); Pf[1] = pack_frag(pt[2], pt[3]);
        fragb Vf[2][2];
#pragma unroll
        for (int v2 = 0; v2 < 2; ++v2)
#pragma unroll
            for (int s = 0; s < 2; ++s) { const LAS bf16* vr = VT + (16 * (2 * vtp + v2) + l15) * MP + 32 * s + 4 * q; Vf[v2][s] = ld_frag8x2(vr, vr + 16); }
        f32x4 Aacc[2], R[2], as, dn;
        as = mfma16(Pf[0], ones, z4); if (it >= 2) as = mfma16(Pf[1], ones, as);
        const fragb nf0 = ld_frag16(CT + 64 * MP + 8 * q), nf1 = ld_frag16(CT + 64 * MP + 32 + 8 * q);
        dn = mfma16(Qf[0], nf0, z4); dn = mfma16(Qf[1], nf1, dn);
#pragma unroll
        for (int v2 = 0; v2 < 2; ++v2) {
            Aacc[v2] = mfma16(Pf[0], Vf[v2][0], z4); if (it >= 2) Aacc[v2] = mfma16(Pf[1], Vf[v2][1], Aacc[v2]);
            const LAS bf16* cr = CT + (16 * (2 * vtp + v2) + l15) * MP + 8 * q;
            R[v2] = mfma16(Qf[0], ld_frag16(cr), z4); R[v2] = mfma16(Qf[1], ld_frag16(cr + 32), R[v2]);
        }
        {
            const f32x4 bi = *(const LAS f32x4*)(vec + 128 + 16 * it + 4 * q), cmr = *(const LAS f32x4*)(vec + 64 + 16 * it + 4 * q);
#pragma unroll
            for (int r = 0; r < 4; ++r) {
                const float mi = bi[r] + cmr[r], minter = bi[r] + m, mt = fmaxf(minter, mi), e1 = __expf(mi - mt), e2 = __expf(minter - mt);
                const float den = e1 * as[r] + e2 * dn[r]; const float inv = 1.0f / fmaxf(fabsf(den), __expf(-mt));
                const int row = seqrow_cm(n * 64 + 16 * it + 4 * q + r, d, b);
#pragma unroll
                for (int v2 = 0; v2 < 2; ++v2) outc[(size_t)row * 256 + h * 64 + 16 * (2 * vtp + v2) + l15] = (bf16)f2bf((e1 * Aacc[v2][r] + e2 * R[v2][r]) * inv);
            }
        }
        {
            const LAS bf16* kr = KTw + (16 * it + l15) * MP + 4 * q;
            const fragb kt0 = ld_frag8x2(kr, kr + 16), kt1 = ld_frag8x2(kr + 32, kr + 48);
            const float bL = vec[128 + 63], mloc = bL + vec[64 + 63];
            const float mnew = fmaxf(bL + m, mloc), wp = __expf(bL + m - mnew), wn = __expf(mloc - mnew);
            f32x4 gk = mfma16(kt0, ones, z4); gk = mfma16(kt1, ones, gk);
            nst = nst * wp + gk * wn;
#pragma unroll
            for (int v2 = 0; v2 < 2; ++v2) {
                f32x4 G = mfma16(kt0, Vf[v2][0], z4); G = mfma16(kt1, Vf[v2][1], G);
                Cst[v2] = Cst[v2] * wp + G * wn;
                v2u o; o.x = pk2(Cst[v2].x, Cst[v2].y); o.y = pk2(Cst[v2].z, Cst[v2].w);
                *(LAS v2u*)(CTn + (16 * (2 * vtp + v2) + l15) * MP + 16 * it + 4 * q) = o;
            }
            if (vtp == 0 && l15 == 0) { v2u o; o.x = pk2(nst.x, nst.y); o.y = pk2(nst.z, nst.w); *(LAS v2u*)(CTn + 64 * MP + 16 * it + 4 * q) = o; }
            m = mnew;
        }
        if (n + 1 < NCH) { images((n + 1) & 1); if (n + 2 < NCH) gload(n + 2); }
    }
    __syncthreads();
}
__device__ __forceinline__ int fwd_row_cm(int b, int c, int t) { return c < 4 ? (T_LAT + b * CTXL + c * 64 + t) : (b * SEQ + t * 64 + (c - 4)); }
__device__ __forceinline__ bf16* blob_row(const Ctx& C, int d, int isw, int b, int c, int h, int r) {
    const int row = fwd_row_cm(b, c, r);
    if (d == 1 && isw) return WSP(bf16, WS_GQ) + (size_t)row * 768 + 512 + h * 64;
    return WSP(bf16, WS_P) + (size_t)row * PLD + OFF_D + (d * 2 + isw) * 256 + h * 64;
}
constexpr int LP = 68;
__device__ __forceinline__ void gdn_solve_units(const Ctx& C, int l) {
    const int lane = C.lane, w = C.wave, pw = w & 1, pi = w >> 1, l15 = lane & 15, q = lane >> 4;
    LAS unsigned char* B0 = C.lds + pi * 28672;
    LAS float* Lm = (LAS float*)B0;
    LAS bf16* Ks = (LAS bf16*)(B0 + 17408);
    LAS float* vec = (LAS float*)(B0 + 17408 + 9216);
    const bf16* P = WSP(const bf16, WS_P); const bf16* gq = WSP(const bf16, WS_GQ);
    const int NU = NB * NH * NCH, per = C.G * 4;
    const int trips = (NU + per - 1) / per;
#pragma unroll 1
    for (int k = 0; k < trips; ++k) {
        int u = k * per + C.wg * 4 + pi; const bool active = u < NU; if (!active) u = NU - 1;
        const int c = u % NCH, h = (u / NCH) & 3, b = u / (NCH * NH);
#pragma unroll 1
        for (int d = 0; d < 2; ++d) {
            const int n = d ? (c < 4 ? 3 - c : 71 - c) : c;
            const float aexp = __expf(C.in[I_GALOG][(l * 2 + d) * NH + h]), dtb = C.in[I_GDTB][(l * 2 + d) * NH + h];
            const int rowl = seqrow_cm(n * 64 + lane, d, b);
            const bf16* pg = P + (size_t)rowl * PLD + OFF_D + 1024 + d * 4 + h;
            const float la = -aexp * softplusf_(bf2f(pg[0]) + dtb), beta = sigmoidf_(bf2f(pg[8]));
            const float gam = wave_incl_sum(la, lane);
            if (pw == 0) { vec[lane] = beta; vec[64 + lane] = gam; }
#pragma unroll
            for (int r = 0; r < 4; ++r) { const int idx = pw * 64 + lane + 128 * r, t = idx >> 3, part = idx & 7;
                *(LAS v4u*)(Ks + t * MP + 8 * part) = *(const v4u*)(gq + (size_t)seqrow_cm(n * 64 + t, d, b) * 768 + 256 + h * 64 + 8 * part); }
            float x[64];
#pragma unroll
            for (int i = 0; i < 64; ++i) x[i] = bf2f(gq[(size_t)seqrow_cm(n * 64 + i, d, b) * 768 + (pw ? 256 : 512) + h * 64 + lane]);
            __syncthreads();
            {
                int tix = 0;
#pragma unroll
                for (int it = 0; it < 4; ++it)
#pragma unroll
                    for (int jt = 0; jt <= it; ++jt, ++tix) if ((tix & 1) == pw) {
                        f32x4 acc = (f32x4){0.f, 0.f, 0.f, 0.f};
#pragma unroll
                        for (int s = 0; s < 2; ++s) acc = mfma16(ld_frag16(Ks + (16 * it + l15) * MP + 32 * s + 8 * q), ld_frag16(Ks + (16 * jt + l15) * MP + 32 * s + 8 * q), acc);
                        const float gj = vec[64 + 16 * jt + l15];
                        const f32x4 bi = *(const LAS f32x4*)(vec + 16 * it + 4 * q), gi = *(const LAS f32x4*)(vec + 64 + 16 * it + 4 * q);
#pragma unroll
                        for (int r = 0; r < 4; ++r) { const int i = 16 * it + 4 * q + r, j = 16 * jt + l15;
                            Lm[i * LP + j] = (j < i) ? bi[r] * acc[r] * __expf(gi[r] - gj) : 0.f; }
                    }
            }
            __syncthreads();
#pragma unroll
            for (int i = 0; i < 64; ++i) {
                const float sc = pw ? vec[i] * __expf(vec[64 + i]) : vec[i];
                float a0 = x[i] * sc, a1 = 0.f;
                int roff = i * LP; if (i >= 2) asm volatile("" : "+v"(roff) : "v"(x[i - 2]));
                const LAS float* lrow = Lm + roff;
#pragma unroll
                for (int j4 = 0; j4 < i; j4 += 4) { const f32x4 lv = *(const LAS f32x4*)(lrow + j4);
                    a0 -= lv.x * x[j4]; if (j4 + 1 < i) a1 -= lv.y * x[j4 + 1]; if (j4 + 2 < i) a0 -= lv.z * x[j4 + 2]; if (j4 + 3 < i) a1 -= lv.w * x[j4 + 3]; }
                x[i] = a0 + a1;
            }
            if (active) { bf16* dst = blob_row(C, d, pw, b, c, h, lane);
#pragma unroll
                for (int g = 0; g < 8; ++g) { v4u o; o.x = pk2(x[8 * g], x[8 * g + 1]); o.y = pk2(x[8 * g + 2], x[8 * g + 3]); o.z = pk2(x[8 * g + 4], x[8 * g + 5]); o.w = pk2(x[8 * g + 6], x[8 * g + 7]);
                    *(v4u*)(dst + 8 * g) = o; } }
            __syncthreads();
        }
    }
}

__device__ __forceinline__ void gdn_chunked(const Ctx& C, int l, int idx) {
    const int d = idx >> 5, b = (idx >> 2) & 7, h = idx & 3, lane = C.lane, w = C.wave, l15 = lane & 15, q = lane >> 4;
    const int it = w & 3, vtp = w >> 2;
    constexpr int IMG = 64 * MP * 2, BUFB = 5 * IMG + 512;
    LAS unsigned char* L0 = C.lds;
    LAS bf16* VnT = (LAS bf16*)(L0 + 2 * BUFB + 2 * IMG);
    const bf16* P = WSP(const bf16, WS_P); const bf16* gq = WSP(const bf16, WS_GQ); bf16* outd = WSP(bf16, WS_OUTD) + (size_t)d * T_ALL * 256;
    const float aexp = __expf(C.in[I_GALOG][(l * 2 + d) * NH + h]), dtb = C.in[I_GDTB][(l * 2 + d) * NH + h];
    const int tt = C.tid >> 3, part = C.tid & 7;
    for (int i = C.tid; i < 2 * IMG / 4; i += NTHR) ((LAS unsigned*)(L0 + 2 * BUFB))[i] = 0u;
    v4u rq, rk, ru, rw; unsigned short rga;
    auto gload = [&](int n) {
        const int c = d ? (n < 4 ? 3 - n : 71 - n) : n;
        const bf16* pp = gq + (size_t)seqrow_cm(n * 64 + tt, d, b) * 768 + h * 64 + 8 * part;
        rq = *(const v4u*)pp; rk = *(const v4u*)(pp + 256);
        ru = *(const v4u*)(blob_row(C, d, 0, b, c, h, tt) + 8 * part); rw = *(const v4u*)(blob_row(C, d, 1, b, c, h, tt) + 8 * part);
        rga = P[(size_t)seqrow_cm(n * 64 + lane, d, b) * PLD + OFF_D + 1024 + d * 4 + h];
    };
    auto images = [&](int bufi) {
        LAS unsigned char* B0 = L0 + bufi * BUFB;
        LAS bf16* Qs = (LAS bf16*)B0; LAS bf16* Ks = Qs + 64 * MP; LAS bf16* KdT = Ks + 64 * MP; LAS bf16* Wi = KdT + 64 * MP; LAS bf16* UT = Wi + 64 * MP; LAS float* vec = (LAS float*)(B0 + 5 * IMG);
        const float la = -aexp * softplusf_(bf2f(rga) + dtb);
        const float gam = wave_incl_sum(la, lane);
        if (w == 0) vec[lane] = gam;
        const float kd = __expf(__shfl(gam, 63) - gam);
        const float kmine = __shfl(kd, 8 * w + (lane >> 3));
        *(LAS v4u*)(Qs + tt * MP + 8 * part) = rq; *(LAS v4u*)(Ks + tt * MP + 8 * part) = rk; *(LAS v4u*)(UT + tt * MP + 8 * part) = ru;
        const unsigned kk[4] = {rk.x, rk.y, rk.z, rk.w}, ww[4] = {rw.x, rw.y, rw.z, rw.w};
#pragma unroll
        for (int e = 0; e < 4; ++e) {
            KdT[(8 * part + 2 * e) * MP + tt] = (bf16)f2bf(bflo(kk[e]) * kmine); KdT[(8 * part + 2 * e + 1) * MP + tt] = (bf16)f2bf(bfhi(kk[e]) * kmine);
            Wi[(8 * part + 2 * e) * MP + tt] = (bf16)(ww[e] & 0xffffu); Wi[(8 * part + 2 * e + 1) * MP + tt] = (bf16)(ww[e] >> 16);
        }
    };
    f32x4 Sst[2]; Sst[0] = Sst[1] = (f32x4){0.f, 0.f, 0.f, 0.f};
    const f32x4 z4 = (f32x4){0.f, 0.f, 0.f, 0.f};
    gload(0); images(0); gload(1);
#pragma unroll 1
    for (int n = 0; n < NCH; ++n) {
        __syncthreads();
        const LAS unsigned char* B0 = L0 + (n & 1) * BUFB;
        const LAS bf16* Qs = (const LAS bf16*)B0; const LAS bf16* Ks = Qs + 64 * MP; const LAS bf16* KdT = Ks + 64 * MP; const LAS bf16* Wi = KdT + 64 * MP; const LAS bf16* UT = Wi + 64 * MP; const LAS float* vec = (const LAS float*)(B0 + 5 * IMG);
        const LAS bf16* ST = (const LAS bf16*)(L0 + 2 * BUFB + (n & 1) * IMG); LAS bf16* STn = (LAS bf16*)(L0 + 2 * BUFB + ((n + 1) & 1) * IMG);
        fragb Qf[2]; Qf[0] = ld_frag16(Qs + (16 * it + l15) * MP + 8 * q); Qf[1] = ld_frag16(Qs + (16 * it + l15) * MP + 32 + 8 * q);
        const float gcol = vec[16 * it + l15]; const int icol = 16 * it + l15;
        f32x4 pt[4];
#pragma unroll
        for (int jt = 0; jt < 4; ++jt) {
            pt[jt] = z4;
            if (jt <= it) {
                const fragb k0 = ld_frag16(Ks + (16 * jt + l15) * MP + 8 * q), k1 = ld_frag16(Ks + (16 * jt + l15) * MP + 32 + 8 * q);
                f32x4 st = mfma16(k0, Qf[0], z4); st = mfma16(k1, Qf[1], st);
                const f32x4 gj = *(const LAS f32x4*)(vec + 16 * jt + 4 * q);
#pragma unroll
                for (int r = 0; r < 4; ++r) { const int j = 16 * jt + 4 * q + r; pt[jt][r] = (j <= icol) ? st[r] * __expf(gcol - gj[r]) : 0.f; }
            }
        }
        fragb Pf[2]; Pf[0] = pack_frag(pt[0], pt[1]); Pf[1] = pack_frag(pt[2], pt[3]);
        const fragb Wf0 = ld_frag16(Wi + (16 * it + l15) * MP + 8 * q), Wf1 = ld_frag16(Wi + (16 * it + l15) * MP + 32 + 8 * q);
        f32x4 Ro[2];
#pragma unroll
        for (int v2 = 0; v2 < 2; ++v2) {
            const int vrow = 16 * (2 * vtp + v2) + l15;
            const fragb s0 = ld_frag16(ST + vrow * MP + 8 * q), s1 = ld_frag16(ST + vrow * MP + 32 + 8 * q);
            f32x4 ws = mfma16(Wf0, s0, z4); ws = mfma16(Wf1, s1, ws);
            Ro[v2] = mfma16(Qf[0], s0, z4); Ro[v2] = mfma16(Qf[1], s1, Ro[v2]);
            const v2u ur = *(const LAS v2u*)(UT + vrow * MP + 16 * it + 4 * q);
            v2u o; o.x = pk2(bflo(ur.x) - ws.x, bfhi(ur.x) - ws.y); o.y = pk2(bflo(ur.y) - ws.z, bfhi(ur.y) - ws.w);
            *(LAS v2u*)(VnT + vrow * MP + 16 * it + 4 * q) = o;
        }
        __syncthreads();
        {
            const f32x4 gi = *(const LAS f32x4*)(vec + 16 * it + 4 * q);
            const float gl = __expf(vec[63]);
            const LAS bf16* kr = KdT + (16 * it + l15) * MP + 4 * q;
            const fragb kt0 = ld_frag8x2(kr, kr + 16), kt1 = ld_frag8x2(kr + 32, kr + 48);
#pragma unroll
            for (int v2 = 0; v2 < 2; ++v2) {
                const int vrow = 16 * (2 * vtp + v2) + l15;
                const LAS bf16* vr = VnT + vrow * MP + 4 * q;
                const fragb n0 = ld_frag8x2(vr, vr + 16), n1 = ld_frag8x2(vr + 32, vr + 48);
                f32x4 o = mfma16(Pf[0], n0, z4); if (it >= 2) o = mfma16(Pf[1], n1, o);
#pragma unroll
                for (int r = 0; r < 4; ++r) { const int row = seqrow_cm(n * 64 + 16 * it + 4 * q + r, d, b);
                    outd[(size_t)row * 256 + h * 64 + vrow] = (bf16)f2bf(o[r] + __expf(gi[r]) * Ro[v2][r]); }
                f32x4 ns = mfma16(kt0, n0, z4); ns = mfma16(kt1, n1, ns);
                Sst[v2] = Sst[v2] * gl + ns;
                v2u so; so.x = pk2(Sst[v2].x, Sst[v2].y); so.y = pk2(Sst[v2].z, Sst[v2].w);
                *(LAS v2u*)(STn + vrow * MP + 16 * it + 4 * q) = so;
            }
        }
        if (n + 1 < NCH) { images((n + 1) & 1); if (n + 2 < NCH) gload(n + 2); }
    }
    __syncthreads();
}
constexpr int UP = 264;
template <int CTRL> __device__ __forceinline__ float dpp_keep(float oldv, float v) { return __builtin_bit_cast(float, __builtin_amdgcn_update_dpp(__builtin_bit_cast(int, oldv), __builtin_bit_cast(int, v), CTRL, 0xF, 0xF, false)); }
template <bool REV> __device__ __forceinline__ void scan16(float& A, float& B) {
#define LRU_STEP(S) { const float Ap = dpp_keep<(REV ? 0x100 : 0x110) | S>(1.0f, A), Bp = dpp_keep<(REV ? 0x100 : 0x110) | S>(0.0f, B); B = A * Bp + B; A = A * Ap; }
    LRU_STEP(1) LRU_STEP(2) LRU_STEP(4) LRU_STEP(8)
#undef LRU_STEP
}
template <bool FIN, bool REV>
__device__ __forceinline__ void lru_wave(const Ctx& C, int l, int b, int c, int hd, LAS bf16* U16, LAS bf16* H16) {
    constexpr int d = REV ? 1 : 0;
    const int lane = C.lane, l15 = lane & 15, q = lane >> 4;
    const bf16* wt = WSP(const bf16, WS_LRUWT) + (size_t)((d * 2 + 0) * 4 + hd) * 4096;
    fragb Wa[4][2], Wx[4][2];
#pragma unroll
    for (int mt = 0; mt < 4; ++mt)
#pragma unroll
        for (int ks = 0; ks < 2; ++ks) { Wa[mt][ks] = *(const fragb*)(wt + (16 * mt + l15) * 64 + 32 * ks + 8 * q); Wx[mt][ks] = *(const fragb*)(wt + 4 * 4096 + (16 * mt + l15) * 64 + 32 * ks + 8 * q); }
    f32x4 sp4[4], hc[4], sla[4];
    const size_t sbase = ((size_t)(b * NCH + c) * 2 + d) * 256 + hd * 64;
#pragma unroll
    for (int mt = 0; mt < 4; ++mt) {
        const int ch = hd * 64 + 16 * mt + 4 * q;
        const f32x4 lam = *(const f32x4*)(C.in[I_LLAM] + (l * 2 + d) * GW + ch);
#pragma unroll
        for (int r = 0; r < 4; ++r) sp4[mt][r] = 8.0f * softplusf_(-lam[r]);
        hc[mt] = FIN ? *(const f32x4*)(WSP(const float, WS_HIN) + sbase + 16 * mt + 4 * q) : (f32x4){0.f, 0.f, 0.f, 0.f};
        sla[mt] = (f32x4){0.f, 0.f, 0.f, 0.f};
    }
    const f32x4 z4 = (f32x4){0.f, 0.f, 0.f, 0.f};
#pragma unroll 1
    for (int nti = 0; nti < 4; ++nti) {
        const int nt = REV ? 3 - nti : nti;
        const LAS bf16* urow = U16 + (16 * nt + l15) * UP + hd * 64;
        const fragb Uf0 = ld_frag16(urow + 8 * q), Uf1 = ld_frag16(urow + 32 + 8 * q);
#pragma unroll
        for (int mt = 0; mt < 4; ++mt) {
            f32x4 aa = mfma16(Wa[mt][0], Uf0, z4); aa = mfma16(Wa[mt][1], Uf1, aa);
            f32x4 ax = mfma16(Wx[mt][0], Uf0, z4); ax = mfma16(Wx[mt][1], Uf1, ax);
            const v2u ur = *(const LAS v2u*)(urow + 16 * mt + 4 * q);
            const float u4[4] = {bflo(ur.x), bfhi(ur.x), bflo(ur.y), bfhi(ur.y)};
            const f32x4 ba = *(const f32x4*)(C.in[I_LBA] + (l * 2 + d) * GW + hd * 64 + 16 * mt + 4 * q), bx = *(const f32x4*)(C.in[I_LBX] + (l * 2 + d) * GW + hd * 64 + 16 * mt + 4 * q);
            f32x4 hv;
#pragma unroll
            for (int r = 0; r < 4; ++r) {
                const float rg = sigmoidf_(aa[r] + ba[r]), ig = sigmoidf_(ax[r] + bx[r]);
                const float la = -sp4[mt][r] * rg; float A = __expf(la); float Bv = sqrtf(-expm1f_(2.0f * la)) * (ig * u4[r]);
                sla[mt][r] += la;
                scan16<REV>(A, Bv);
                const float h = A * hc[mt][r] + Bv;
                hv[r] = h;
                hc[mt][r] = __shfl(h, (lane & 48) | (REV ? 0 : 15));
            }
            if (FIN) { v2u o; o.x = pk2(hv.x, hv.y); o.y = pk2(hv.z, hv.w); *(LAS v2u*)(H16 + (size_t)d * 64 * UP + (16 * nt + l15) * UP + hd * 64 + 16 * mt + 4 * q) = o; }
        }
    }
    if (!FIN) {
        float* ls = WSP(float, WS_LSUM);
#pragma unroll
        for (int mt = 0; mt < 4; ++mt)
#pragma unroll
            for (int r = 0; r < 4; ++r) { const float st = row16_sum(sla[mt][r]); if (l15 == 0) { const size_t si = sbase + 16 * mt + 4 * q + r; ls[si * 2] = st; ls[si * 2 + 1] = hc[mt][r]; } }
    }
}
template <bool FIN>
__device__ __forceinline__ void lru_chunk_mfma(const Ctx& C, int l, int b, int c) {
    LAS bf16* U16 = (LAS bf16*)C.lds;
    LAS bf16* H16 = U16 + 64 * UP;
    const bf16* P = WSP(const bf16, WS_P);
    const bool isctx = c < 4; const int p0 = isctx ? c * 64 : (c - 4) * 64; const int Lp = isctx ? CTXL : SEQ; const int row0 = isctx ? T_LAT + b * CTXL : b * SEQ;
    {
        const int ch = C.tid & 255, half = C.tid >> 8;
        const float* cw = C.in[I_LCW] + (size_t)l * 4 * GW + ch; const float w0 = cw[0], w1 = cw[GW], w2 = cw[2 * GW], w3 = cw[3 * GW], cb = C.in[I_LCB][l * GW + ch];
        const int t0 = half * 32;
        float xs[35];
#pragma unroll
        for (int k = 0; k < 35; ++k) { const int p = p0 + t0 + k - 2; xs[k] = (p >= 0 && p < Lp) ? bf2f(P[(size_t)(row0 + p) * PLD + ch]) : 0.f; }
#pragma unroll
        for (int t = 0; t < 32; ++t) U16[(t0 + t) * UP + ch] = (bf16)f2bf(w0 * xs[t] + w1 * xs[t + 1] + w2 * xs[t + 2] + w3 * xs[t + 3] + cb);
    }
    __syncthreads();
    if (C.wave < 4) lru_wave<FIN, false>(C, l, b, c, C.wave & 3, U16, H16); else lru_wave<FIN, true>(C, l, b, c, C.wave & 3, U16, H16);
    __syncthreads();
    if (FIN) {
        bf16* yc = WSP(bf16, WS_HB);
        const LAS bf16* H1 = H16 + 64 * UP;
#pragma unroll 2
        for (int it = C.tid; it < 64 * 64; it += NTHR) {
            const int t = it >> 6, c4 = (it & 63) * 4;
            const size_t row = (size_t)(row0 + p0 + t);
            const v2u a = *(const LAS v2u*)(H16 + t * UP + c4), bq = *(const LAS v2u*)(H1 + t * UP + c4);
            const f32x4 g = ld4bf(P + row * PLD + 256 + c4);
            f32x4 y = (f32x4){bflo(a.x) + bflo(bq.x), bfhi(a.x) + bfhi(bq.x), bflo(a.y) + bflo(bq.y), bfhi(a.y) + bfhi(bq.y)};
            y.x *= gelu_tanh(g.x); y.y *= gelu_tanh(g.y); y.z *= gelu_tanh(g.z); y.w *= gelu_tanh(g.w);
            st4bf(yc + row * 1024 + c4, y);
        }
        __syncthreads();
    }
}
constexpr int RP = 264;
__device__ __forceinline__ void rwkv_prep2(const Ctx& C, int l, int b, int c) {
    LAS bf16* RS = (LAS bf16*)C.lds;
    LAS bf16* KS = RS + 64 * RP;
    LAS bf16* XW = KS + 64 * RP;
    LAS bf16* XA = XW + 64 * MP;
    LAS bf16* XG = XA + 64 * MP;
    const bf16* P = WSP(const bf16, WS_P);
    const bool isctx = c < 4; const int p0 = isctx ? c * 64 : (c - 4) * 64; const int Lp = isctx ? CTXL : SEQ; const int row0 = isctx ? T_LAT + b * CTXL : b * SEQ;
    const float* mu = C.in[I_RMU] + (size_t)l * 2 * B_COLS;
    bf16* rkv = WSP(bf16, WS_RKV);
#pragma unroll 2
    for (int it = C.tid; it < 64 * 120; it += NTHR) {
        const int t = it / 120, c8 = (it % 120) * 8, p = p0 + t;
        const bf16* pp = P + (size_t)(row0 + p) * PLD + OFF_B + c8;
        const v4u xc = *(const v4u*)pp; v4u xp = (v4u){0u, 0u, 0u, 0u}, xn = xp;
        if (p > 0) xp = *(const v4u*)(pp - PLD);
        if (p < Lp - 1) xn = *(const v4u*)(pp + PLD);
        const f32x4 m0a = *(const f32x4*)(mu + c8), m0b = *(const f32x4*)(mu + c8 + 4), m1a = *(const f32x4*)(mu + B_COLS + c8), m1b = *(const f32x4*)(mu + B_COLS + c8 + 4);
        const unsigned xcw[4] = {xc.x, xc.y, xc.z, xc.w}, xpw[4] = {xp.x, xp.y, xp.z, xp.w}, xnw[4] = {xn.x, xn.y, xn.z, xn.w};
        float sh[8];
#pragma unroll
        for (int e = 0; e < 4; ++e) {
            const float x0 = bflo(xcw[e]), x1 = bfhi(xcw[e]);
            const float mu0_0 = e < 2 ? m0a[2 * e] : m0b[2 * e - 4], mu0_1 = e < 2 ? m0a[2 * e + 1] : m0b[2 * e - 3], mu1_0 = e < 2 ? m1a[2 * e] : m1b[2 * e - 4], mu1_1 = e < 2 ? m1a[2 * e + 1] : m1b[2 * e - 3];
            sh[2 * e] = x0 + mu0_0 * (bflo(xpw[e]) - x0) + mu1_0 * (bflo(xnw[e]) - x0);
            sh[2 * e + 1] = x1 + mu0_1 * (bfhi(xpw[e]) - x1) + mu1_1 * (bfhi(xnw[e]) - x1);
        }
        if (c8 >= 768) {
            const int ci = c8 - 768;
            if (ci < 64) {
#pragma unroll
                for (int e = 0; e < 8; ++e) sh[e] = tanhf_(sh[e]); }
            else if (ci >= 128) {
#pragma unroll
                for (int e = 0; e < 8; ++e) sh[e] = sigmoidf_(sh[e]); }
        }
        v4u o; o.x = pk2(sh[0], sh[1]); o.y = pk2(sh[2], sh[3]); o.z = pk2(sh[4], sh[5]); o.w = pk2(sh[6], sh[7]);
        if (c8 < 768) {
            *(v4u*)(rkv + (size_t)(row0 + p) * 768 + c8) = o;
            if (c8 < 256) *(LAS v4u*)(RS + t * RP + c8) = o; else if (c8 < 512) *(LAS v4u*)(KS + t * RP + c8 - 256) = o;
        } else {
            const int ci = c8 - 768;
            LAS bf16* dst = ci < 64 ? XW + t * MP + ci : (ci < 128 ? XA + t * MP + ci - 64 : XG + t * MP + ci - 128);
            *(LAS v4u*)dst = o;
        }
    }
    __syncthreads();
    const int lane = C.lane, w = C.wave, l15 = lane & 15, q = lane >> 4, hd = w & 3, ntp = w >> 2;
    const bf16* wt = WSP(const bf16, WS_RWT);
    bf16* wa_out = WSP(bf16, WS_HB); bf16* g_out = WSP(bf16, WS_G); float* bonus = WSP(float, WS_BONUS); float* rinv = WSP(float, WS_RINV);
    const f32x4 z4 = (f32x4){0.f, 0.f, 0.f, 0.f};
#pragma unroll 1
    for (int n2 = 0; n2 < 2; ++n2) {
        const int nt = 2 * ntp + n2, tok = 16 * nt + l15; const size_t row = (size_t)(row0 + p0 + tok);
        const fragb xw0 = ld_frag16(XW + tok * MP + 8 * q), xw1 = ld_frag16(XW + tok * MP + 32 + 8 * q);
        const fragb xa0 = ld_frag16(XA + tok * MP + 8 * q), xa1 = ld_frag16(XA + tok * MP + 32 + 8 * q);
        const fragb xg0 = ld_frag16(XG + tok * MP + 8 * q), xg1 = ld_frag16(XG + tok * MP + 32 + 8 * q);
        float bsum = 0.f, ksum = 0.f;
#pragma unroll
        for (int mt = 0; mt < 4; ++mt) {
            const int chl = 16 * mt + l15, ch4 = hd * 64 + 16 * mt + 4 * q;
            const bf16* wrow = wt + (size_t)(hd * 64 + chl) * 32 + 8 * q;
            const f32x4 aw0 = mfma16(*(const fragb*)(wrow), xw0, z4), aw1 = mfma16(*(const fragb*)(wrow + 256 * 32), xw1, z4);
            const f32x4 aa0 = mfma16(*(const fragb*)(wrow + 2 * 256 * 32), xa0, z4), aa1 = mfma16(*(const fragb*)(wrow + 3 * 256 * 32), xa1, z4);
            const bf16* grow = wt + 4 * 256 * 32 + (size_t)(hd * 64 + chl) * 64 + 8 * q;
            f32x4 ag = mfma16(*(const fragb*)(grow), xg0, z4); ag = mfma16(*(const fragb*)(grow + 32), xg1, ag);
            const f32x4 w00 = *(const f32x4*)(C.in[I_RW0] + (l * 2 + 0) * GW + ch4), w01 = *(const f32x4*)(C.in[I_RW0] + (l * 2 + 1) * GW + ch4);
            const f32x4 a00 = *(const f32x4*)(C.in[I_RA0] + (l * 2 + 0) * GW + ch4), a01 = *(const f32x4*)(C.in[I_RA0] + (l * 2 + 1) * GW + ch4);
            const f32x4 k_a = *(const f32x4*)(C.in[I_RKA] + l * GW + ch4), r_k = *(const f32x4*)(C.in[I_RRK] + l * GW + ch4), k_k = *(const f32x4*)(C.in[I_RKK] + l * GW + ch4);
            f32x4 wv0, wv1, av0, av1;
#pragma unroll
            for (int r = 0; r < 4; ++r) {
                wv0[r] = __expf(-0.6065306597126334f * sigmoidf_(aw0[r] + w00[r])); wv1[r] = __expf(-0.6065306597126334f * sigmoidf_(aw1[r] + w01[r]));
                av0[r] = sigmoidf_(aa0[r] + a00[r]); av1[r] = sigmoidf_(aa1[r] + a01[r]);
            }
            st4bf(wa_out + row * 1024 + 0 * 256 + ch4, wv0); st4bf(wa_out + row * 1024 + 1 * 256 + ch4, wv1);
            st4bf(wa_out + row * 1024 + 2 * 256 + ch4, av0); st4bf(wa_out + row * 1024 + 3 * 256 + ch4, av1);
            st4bf(g_out + row * 256 + ch4, ag);
            const v2u rr_ = *(const LAS v2u*)(RS + tok * RP + ch4), kr_ = *(const LAS v2u*)(KS + tok * RP + ch4);
            const f32x4 rs = (f32x4){bflo(rr_.x), bfhi(rr_.x), bflo(rr_.y), bfhi(rr_.y)}, ks = (f32x4){bflo(kr_.x), bfhi(kr_.x), bflo(kr_.y), bfhi(kr_.y)};
#pragma unroll
            for (int r = 0; r < 4; ++r) {
                const float km = ks[r] * (1.0f + (av0[r] - 1.0f) * k_a[r]) + ks[r] * (1.0f + (av1[r] - 1.0f) * k_a[r]);
                bsum += rs[r] * r_k[r] * km; const float kk = ks[r] * k_k[r]; ksum += kk * kk;
            }
        }
        bsum += __shfl_xor(bsum, 16); bsum += __shfl_xor(bsum, 32); ksum += __shfl_xor(ksum, 16); ksum += __shfl_xor(ksum, 32);
        if (q == 0) { bonus[row * 4 + hd] = bsum; rinv[row * 4 + hd] = 1.0f / sqrtf(ksum + 1e-6f); }
    }
    __syncthreads();
}
__device__ __forceinline__ void moe_scatter(const Ctx& C, int moe_li, int nrows) {
    const unsigned* gc = WSP(const unsigned, WS_CTL) + CW_MOECNT + 64 * moe_li;
    LAS int* pst = (LAS int*)C.lds;
    {
        int pe[8]; int acc = 0;
#pragma unroll
        for (int e = 0; e < NE; ++e) { const int blks = ((int)gc[e] + 255) >> 8; if (C.tid == e) pst[e] = acc * 256; acc += blks; pe[e] = acc; }
        if (C.wg == 0 && C.tid < MOE_MAXBLK) { int be = 0;
#pragma unroll
            for (int e = 0; e < NE; ++e) be += (pe[e] <= C.tid) ? 1 : 0;
            int* tab = WSP(int, WS_TAB); tab[1 + C.tid] = be < NE ? be : NE - 1; if (C.tid == 0) tab[0] = acc; }
    }
    __syncthreads();
    const unsigned* route = WSP(const unsigned, WS_ROUTE); const unsigned* wgbase = WSP(const unsigned, WS_WGBASE);
    const bf16* hb = WSP(const bf16, WS_HB); bf16* am = WSP(bf16, WS_MIX); int* pos = WSP(int, WS_POS);
    const int gw = C.wg * NWAVES + C.wave, NGW = C.G * NWAVES;
    for (int m = gw; m < nrows; m += NGW) {
        const v4u a = *(const v4u*)(route + (size_t)m * 8);
        const int e0 = (int)a.x, e1 = (int)a.y;
        const int p0 = pst[e0] + (int)wgbase[C.wg * 8 + e0] + (int)a.z, p1 = pst[e1] + (int)wgbase[C.wg * 8 + e1] + (int)a.w;
        const v4u r0 = *(const v4u*)(hb + (size_t)m * 1024 + C.lane * 8), r1 = *(const v4u*)(hb + (size_t)m * 1024 + 512 + C.lane * 8);
        *(v4u*)(am + (size_t)p0 * 1024 + C.lane * 8) = r0; *(v4u*)(am + (size_t)p0 * 1024 + 512 + C.lane * 8) = r1;
        *(v4u*)(am + (size_t)p1 * 1024 + C.lane * 8) = r0; *(v4u*)(am + (size_t)p1 * 1024 + 512 + C.lane * 8) = r1;
        if (C.lane == 0) { pos[(size_t)m * 2] = p0; pos[(size_t)m * 2 + 1] = p1; }
    }
    __syncthreads();
}
__device__ __forceinline__ void moe_combine(const Ctx& C, int l, int nrows) {
    const unsigned* route = WSP(const unsigned, WS_ROUTE); const int* pos = WSP(const int, WS_POS); const bf16* ym = WSP(const bf16, WS_MIX);
    const float* modv = WSP(const float, WS_MODV) + (size_t)l * 9 * 6144 + 5 * 1024;
    float* xc = WSP(float, WS_XC);
    const int gw = C.wg * NWAVES + C.wave, NGW = C.G * NWAVES;
    for (int m = gw; m < nrows; m += NGW) {
        const bool isctx = m >= T_LAT;
        float* xr = isctx ? xc + (size_t)(m - T_LAT) * 1024 : C.out + (size_t)m * 1024;
        const float* gv = modv + (size_t)(isctx ? 8 : (m >> 12)) * 6144;
        const int p0 = pos[(size_t)m * 2], p1 = pos[(size_t)m * 2 + 1];
        const float w0 = __builtin_bit_cast(float, route[(size_t)m * 8 + 4]), w1 = __builtin_bit_cast(float, route[(size_t)m * 8 + 5]);
#pragma unroll
        for (int j = 0; j < 4; ++j) {
            const int col = 4 * C.lane + 256 * j;
            const v2u a = *(const v2u*)(ym + (size_t)p0 * 1024 + col), b = *(const v2u*)(ym + (size_t)p1 * 1024 + col);
            const f32x4 ya = (f32x4){bflo(a.x), bfhi(a.x), bflo(a.y), bfhi(a.y)}, yb = (f32x4){bflo(b.x), bfhi(b.x), bflo(b.y), bfhi(b.y)};
            const f32x4 g = *(const f32x4*)(gv + col); f32x4 x = *(const f32x4*)(xr + col);
            x = x + g * (ya * w0 + yb * w1);
            *(f32x4*)(xr + col) = x;
        }
    }
}
__device__ __forceinline__ void final_norm(const Ctx& C) {
    const int gw = C.wg * NWAVES + C.wave, NGW = C.G * NWAVES;
    f32x4 gv[4];
#pragma unroll
    for (int j = 0; j < 4; ++j) gv[j] = *(const f32x4*)(C.in[I_FNG] + 4 * C.lane + 256 * j);
    for (int m = gw; m < T_LAT; m += NGW) {
        float* xr = C.out + (size_t)m * 1024;
        f32x4 v[4]; float s = 0.f;
#pragma unroll
        for (int j = 0; j < 4; ++j) { v[j] = *(const f32x4*)(xr + 4 * C.lane + 256 * j); s += (v[j].x * v[j].x + v[j].y * v[j].y) + (v[j].z * v[j].z + v[j].w * v[j].w); }
        const float rs = 1.0f / sqrtf(wave_sum(s) * (1.0f / 1024.0f) + 1e-6f);
#pragma unroll
        for (int j = 0; j < 4; ++j) *(f32x4*)(xr + 4 * C.lane + 256 * j) = v[j] * rs * gv[j];
    }
}

constexpr int NPH_L = 12, PH_FINAL = 1 + DEPTH * NPH_L, NPHASE = PH_FINAL + 1;
__host__ __device__ inline bool phase_exists(int ph) {
    if (ph == 0 || ph == PH_FINAL) return true;
    const int l = (ph - 1) / NPH_L, k = (ph - 1) % NPH_L;
    if (!(l & 1) && k >= 10) return false;
    return true;
}
#ifndef PH_MASK
#define PH_MASK 0xFFFFFF
#endif
#define PM(k) ((PH_MASK >> (k)) & 1)
#ifndef SK_MASK
#define SK_MASK 0xFFFF
#endif
#define SK(k) ((SK_MASK >> (k)) & 1)
#ifndef REP_MASK
#define REP_MASK 0
#endif
#define NREP(k) (((REP_MASK >> (k)) & 1) ? 2 : 1)

__global__ void __launch_bounds__(NTHR, 2) fwd_kernel(Args args) {
    extern __shared__ __attribute__((aligned(16))) unsigned char lds_raw[];
    Ctx C; C.in = args.in; C.out = args.out; C.ws = args.ws; C.lds = (LAS unsigned char*)lds_raw;
    C.tid = threadIdx.x; C.lane = C.tid & 63; C.wave = __builtin_amdgcn_readfirstlane(C.tid >> 6); C.G = gridDim.x; C.wg = blockIdx.x;
    volatile LAS unsigned* MISC = (volatile LAS unsigned*)(C.lds + MISC_OFF);
    if (C.tid < 64) MISC[C.tid] = 0u;
    __syncthreads();
    const int lo = args.ph_lo, hi = args.ph_hi;
    const bool multi = (hi - lo) > 1;
    if (multi) (void)xcd_barrier_post(WSP(unsigned, WS_CTL) + CW_BAR, MISC + 8);
#define IN(k) (lo <= (k) && (k) < hi)
#define SEAM(k) do { if (IN((k) + 1)) { XcdBarrier b2_; b2_.bar = WSP(unsigned, WS_CTL) + CW_BAR; b2_.x = xb_xcc_id(); b2_.st = (volatile LAS unsigned*)(C.lds + MISC_OFF) + 8; xcd_barrier(b2_); } } while (0)
#define FRESH() do { int t_ = threadIdx.x; asm volatile("" : "+v"(t_)); C.tid = t_; C.lane = t_ & 63; C.wave = __builtin_amdgcn_readfirstlane(t_ >> 6); } while (0)
#define PHASE(bit, k) if (PM(bit) && IN(pb + (k))) for (int rep_ = 0; rep_ < NREP(bit); ++rep_)

    if (PM(20) && IN(0)) { phase_pre(C); SEAM(0); }

#pragma unroll 1
    for (int l = 0; l < DEPTH; ++l) {
        const int pb = 1 + l * NPH_L;
        if (hi <= pb || lo >= pb + NPH_L) continue;
        const bool last = (l == DEPTH - 1), moe = (l & 1);
        const int nrows = last ? T_LAT : T_ALL;
        const float* xlat = (l == 0) ? C.in[I_X] : C.out; const float* xctx = (l == 0) ? C.in[I_CTX] : WSP(const float, WS_XC);
        const float* modv = WSP(const float, WS_MODV) + (size_t)l * 9 * 6144;

        PHASE(0, 0) { FRESH();
            convert_layer(C, l);
            __syncthreads();
            FRESH(); norm_rows<false>(C, l, xlat, xctx, C.in[I_NMIXG] + l * 1024, 0, 1024, T_ALL, 0);
            SEAM(pb + 0);
        }
        PHASE(1, 1) { FRESH();
            pg8::Gemm g{WSP(const bf16, WS_HB), WSP(const bf16, WS_WIN), T_ALL, PLD, 1024, 0};
            pg8::StaticOrder S; S.init(T_ALL, PLD, C.G, C.wg);
            pg8::EpiBf16<0> E{WSP(bf16, WS_P), PLD, nullptr, 0, 0};
            pg8::gemm_phase<pg8::EpiBf16<0>, pg8::StaticOrder, false>(C.lds, g, S, E, nullptr);
            SEAM(pb + 1);
        }
        PHASE(2, 2) { FRESH();
            for (int r2_ = 0; r2_ < NREP(16); ++r2_) { FRESH(); if (SK(0)) for (int u = C.wg; u < NB * NCH; u += C.G) lru_chunk_mfma<false>(C, l, u / NCH, u % NCH); }
            for (int r2_ = 0; r2_ < NREP(17); ++r2_) { FRESH(); if (SK(1)) for (int u = C.wg; u < NB * NCH; u += C.G) rwkv_prep2(C, l, u / NCH, u % NCH); }
            FRESH(); if (SK(2)) for (int u = C.wg; u < NB * NCH; u += C.G) gdn_prep(C, l, u / NCH, u % NCH);
            SEAM(pb + 2);
        }
        PHASE(3, 3) { FRESH();
            gdn_solve_units(C, l);
            SEAM(pb + 3);
        }
        PHASE(4, 4) { FRESH();
            if (SK(3) && C.wg < 128) { FRESH(); rwkv_scan(C, l, C.wg); }
            else if (SK(4) && C.wg < 192) { FRESH(); mlstm_chunked(C, l, C.wg - 128); }
            else if (SK(5)) { FRESH(); gdn_chunked(C, l, C.wg - 192); }
            if (SK(6) && C.wg >= 248) lru_carry(C, (C.wg - 248) * NTHR + C.tid);
            SEAM(pb + 4);
        }
        PHASE(5, 5) { FRESH();
            for (int u = C.wg; u < NB * NCH; u += C.G) { const int b = u / NCH, c = u % NCH; if (last && c < 4) continue; if (SK(7)) lru_chunk_mfma<true>(C, l, b, c); }
            FRESH(); if (SK(8)) finish_rows(C, l, nrows);
            SEAM(pb + 5);
        }
        if (PM(6) && IN(pb + 6)) { FRESH();
            pg8::Gemm g{WSP(const bf16, WS_HB), WSP(const bf16, WS_WOUT), nrows, 1024, 1024, 0};
            pg8::StaticOrder S; S.init(nrows, 1024, C.G, C.wg);
            pg8::EpiRes E{xlat, xctx, C.out, WSP(float, WS_XC), modv + 2 * 1024};
            pg8::gemm_phase<pg8::EpiRes, pg8::StaticOrder, false>(C.lds, g, S, E, nullptr);
            SEAM(pb + 6);
        }
        if (PM(7) && IN(pb + 7)) { FRESH();
            if (moe) norm_rows<true>(C, l, C.out, WSP(const float, WS_XC), C.in[I_NFFNG] + l * 1024, 3 * 1024, 4 * 1024, nrows, l >> 1);
            else norm_rows<false>(C, l, C.out, WSP(const float, WS_XC), C.in[I_NFFNG] + l * 1024, 3 * 1024, 4 * 1024, nrows, 0);
            SEAM(pb + 7);
        }
        if (!moe) {
            if (PM(8) && IN(pb + 8)) { FRESH();
                pg8::Gemm g{WSP(const bf16, WS_HB), WSP(const bf16, WS_WGU), nrows, 2 * DFF, 1024, 0};
                pg8::StaticOrder S; S.init(nrows, 2 * DFF, C.G, C.wg);
                pg8::EpiSwiglu E{WSP(bf16, WS_P), DFF};
                pg8::gemm_phase<pg8::EpiSwiglu, pg8::StaticOrder, false>(C.lds, g, S, E, nullptr);
                SEAM(pb + 8);
            }
            if (PM(9) && IN(pb + 9)) { FRESH();
                pg8::Gemm g{WSP(const bf16, WS_P), WSP(const bf16, WS_WDN), nrows, 1024, DFF, 0};
                pg8::StaticOrder S; S.init(nrows, 1024, C.G, C.wg);
                pg8::EpiRes E{C.out, WSP(const float, WS_XC), C.out, WSP(float, WS_XC), modv + 5 * 1024};
                pg8::gemm_phase<pg8::EpiRes, pg8::StaticOrder, false>(C.lds, g, S, E, nullptr);
                SEAM(pb + 11);
            }
        } else {
            if (PM(10) && IN(pb + 8)) { FRESH(); moe_scatter(C, l >> 1, nrows); SEAM(pb + 8); }
            if (PM(11) && IN(pb + 9)) { FRESH();
                pg8::Gemm g{WSP(const bf16, WS_MIX), WSP(const bf16, WS_WGU), 0, 2 * DFE, 1024, (size_t)2 * DFE * 1024};
                pg8::MoeOrder S; S.init(WSP(const int, WS_TAB), (2 * DFE) / 256, C.G, C.wg);
                pg8::EpiSwiglu E{WSP(bf16, WS_P), DFE};
                pg8::gemm_phase<pg8::EpiSwiglu, pg8::MoeOrder, false>(C.lds, g, S, E, nullptr);
                SEAM(pb + 9);
            }
            if (PM(12) && IN(pb + 10)) { FRESH();
                pg8::Gemm g{WSP(const bf16, WS_P), WSP(const bf16, WS_WDN), 0, 1024, DFE, (size_t)1024 * DFE};
                pg8::MoeOrder S; S.init(WSP(const int, WS_TAB), 4, C.G, C.wg);
                pg8::EpiBf16<0> E{WSP(bf16, WS_MIX), 1024, nullptr, 0, 0};
                pg8::gemm_phase<pg8::EpiBf16<0>, pg8::MoeOrder, false>(C.lds, g, S, E, nullptr);
                SEAM(pb + 10);
            }
            if (PM(13) && IN(pb + 11)) { FRESH(); moe_combine(C, l, nrows); SEAM(pb + 11); }
        }
    }
    if (PM(21) && IN(PH_FINAL)) final_norm(C);
}

extern "C" void kernel_launch(void* const* d_in, const int* in_sizes, int n_in, void* d_out, int out_size, void* d_ws, size_t ws_size, hipStream_t stream) {
    static int grid = 0;
    if (grid == 0) {
        if (n_in != N_IN || in_sizes[0] != T_LAT * DM || out_size != T_LAT * DM || ws_size < WS_END) {
            fprintf(stderr, "kernel_launch: unexpected problem (n_in %d, in0 %d, out %d, ws %zu < %zu)\n", n_in, n_in > 0 ? in_sizes[0] : -1, out_size, ws_size, (size_t)WS_END); grid = -1; return; }
        int dev = 0, cus = 0, per_cu = 0;
        if (hipGetDevice(&dev) != hipSuccess || hipDeviceGetAttribute(&cus, hipDeviceAttributeMultiprocessorCount, dev) != hipSuccess) { grid = -1; return; }
        if (hipFuncSetAttribute((const void*)fwd_kernel, hipFuncAttributeMaxDynamicSharedMemorySize, LDS_BYTES) != hipSuccess) { fprintf(stderr, "kernel_launch: hipFuncSetAttribute failed\n"); grid = -1; return; }
        if (hipOccupancyMaxActiveBlocksPerMultiprocessor(&per_cu, (const void*)fwd_kernel, NTHR, LDS_BYTES) != hipSuccess || per_cu < 1) { fprintf(stderr, "kernel_launch: occupancy query says %d\n", per_cu); grid = -1; return; }
        grid = cus;
        if (grid != 256) fprintf(stderr, "kernel_launch: note: %d CUs\n", grid);
    }
    if (grid < 0) return;
    if (hipMemsetAsync((char*)d_ws + WS_CTL, 0, CTL_BYTES, stream) != hipSuccess) return;
    Args a{};
    for (int i = 0; i < N_IN; ++i) a.in[i] = (const float*)d_in[i];
    a.out = (float*)d_out; a.ws = (unsigned char*)d_ws;
#if MK_ONE_LAUNCH
    a.ph_lo = 0; a.ph_hi = NPHASE;
    hipLaunchKernelGGL(fwd_kernel, dim3(grid), dim3(NTHR), LDS_BYTES, stream, a);
#else
    for (int ph = 0; ph < NPHASE; ++ph) { if (!phase_exists(ph)) continue; a.ph_lo = ph; a.ph_hi = ph + 1; hipLaunchKernelGGL(fwd_kernel, dim3(grid), dim3(NTHR), LDS_BYTES, stream, a); }
#endif
}
```

```cpp
#define MK_ONE_LAUNCH 1
#include <hip/hip_runtime.h>
#include <cstdio>
#include <cstdint>

#define GAS __attribute__((address_space(1)))
#define LAS __attribute__((address_space(3)))
typedef unsigned short bf16;
typedef unsigned v4u __attribute__((ext_vector_type(4)));
typedef unsigned v2u __attribute__((ext_vector_type(2)));
typedef float f32x4 __attribute__((ext_vector_type(4)));
typedef float f32x2 __attribute__((ext_vector_type(2)));
typedef short bf16x8 __attribute__((ext_vector_type(8)));
#define LDS_WAIT() asm volatile("s_waitcnt lgkmcnt(0)" ::: "memory")
#define VM_WAIT() asm volatile("s_waitcnt vmcnt(0)" ::: "memory")

constexpr int DM = 1024, NB = 8, SEQ = 4096, DEPTH = 4, CTXL = 256, GW = 256, HD = 64, NH = 4;
constexpr int T_LAT = NB * SEQ, T_CTX = NB * CTXL, T_ALL = T_LAT + T_CTX;
constexpr int IN_COLS = 3552, PLD = 3584;
constexpr int OFF_B = 512, OFF_C = 1472, OFF_D = 2512, B_COLS = 960;
constexpr int DFF = 2816, NE = 8, DFE = 1408;
constexpr int NCH = 68;
constexpr int NSTEP = 4352;
constexpr int MOE_MAXBLK = 280;
constexpr int NWAVES = 8, NTHR = 512;

constexpr size_t MiB = 1u << 20;
constexpr size_t WS_CTL = 0, CTL_BYTES = 1 * MiB;
constexpr size_t WS_MODV = 1 * MiB;
constexpr size_t WS_XC = 2 * MiB;
constexpr size_t WS_WIN = 10 * MiB;
constexpr size_t WS_WOUT = 17 * MiB;
constexpr size_t WS_WGU = 19 * MiB;
constexpr size_t WS_WDN = 63 * MiB;
constexpr size_t WS_HB = 85 * MiB;
constexpr size_t WS_P = 153 * MiB;
constexpr size_t WS_MIX = 391 * MiB;
constexpr size_t WS_OUTB = WS_MIX, WS_OUTC = WS_MIX + 34 * MiB, WS_OUTD = WS_MIX + 68 * MiB, WS_GQ = WS_MIX + 102 * MiB, WS_G = WS_MIX + 153 * MiB;
constexpr size_t WS_RKV = WS_MIX + 170 * MiB;
constexpr size_t WS_SMALL = 612 * MiB;
constexpr size_t WS_LSUM = WS_SMALL;
constexpr size_t WS_HIN = WS_SMALL + 3 * MiB;
constexpr size_t WS_ROUTE = WS_SMALL + 5 * MiB;
constexpr size_t WS_POS = WS_SMALL + 7 * MiB;
constexpr size_t WS_BONUS = WS_SMALL + 8 * MiB;
constexpr size_t WS_WGBASE = WS_SMALL + 9 * MiB;
constexpr size_t WS_TAB = WS_WGBASE + 65536;
constexpr size_t WS_LRUWT = WS_SMALL + 10 * MiB;
constexpr size_t WS_RWT = WS_LRUWT + 131072;
constexpr size_t WS_RINV = WS_SMALL + 11 * MiB;
constexpr size_t WS_END = 624 * MiB;
constexpr int CW_MOECNT = 1024;
constexpr int CW_BAR = 4096;

constexpr int LDS_BYTES = 135168;
constexpr int MISC_OFF = 131072;

__device__ __forceinline__ unsigned f2bf(float f) { unsigned u = __builtin_bit_cast(unsigned, f); return (u + 0x7fffu + ((u >> 16) & 1u)) >> 16; }
typedef __bf16 bf16n2 __attribute__((ext_vector_type(2)));
__device__ __forceinline__ unsigned pk2(float lo, float hi) { const f32x2 v = {lo, hi}; return __builtin_bit_cast(unsigned, __builtin_convertvector(v, bf16n2)); }
__device__ __forceinline__ unsigned f2bf1(float f) { return pk2(f, f) & 0xffffu; }
__device__ __forceinline__ float bf2f(unsigned short v) { return __builtin_bit_cast(float, (unsigned)v << 16); }
__device__ __forceinline__ float bflo(unsigned v) { return __builtin_bit_cast(float, v << 16); }
__device__ __forceinline__ float bfhi(unsigned v) { return __builtin_bit_cast(float, v & 0xffff0000u); }
__device__ __forceinline__ float wave_sum(float v) {
#pragma unroll
    for (int o = 1; o < 64; o <<= 1) v += __shfl_xor(v, o);
    return v;
}
template <int CTRL> __device__ __forceinline__ float dpp_f(float v) { return __builtin_bit_cast(float, __builtin_amdgcn_update_dpp(0, __builtin_bit_cast(int, v), CTRL, 0xF, 0xF, true)); }
__device__ __forceinline__ float row16_sum(float v) {
    v += dpp_f<0xB1>(v);
    v += dpp_f<0x4E>(v);
    v += dpp_f<0x141>(v);
    v += dpp_f<0x140>(v);
    return v;
}
__device__ __forceinline__ float sigmoidf_(float x) { return 1.0f / (1.0f + __expf(-x)); }
__device__ __forceinline__ float softplusf_(float x) { return fmaxf(x, 0.f) + __logf(1.0f + __expf(-fabsf(x))); }
__device__ __forceinline__ float expm1f_(float x) { return x > -0.3f ? x * (1.0f + x * (0.5f + x * (0.16666667f + x * (0.041666668f + x * 0.0083333338f)))) : __expf(x) - 1.0f; }
__device__ __forceinline__ float siluf_(float x) { return x / (1.0f + __expf(-x)); }
__device__ __forceinline__ float tanhf_(float x) { const float e = __expf(2.0f * x); return 1.0f - 2.0f / (e + 1.0f); }
__device__ __forceinline__ float gelu_tanh(float x) { return 0.5f * x * (1.0f + tanhf_(0.7978845608028654f * (x + 0.044715f * x * x * x))); }
#define XB_TMO      128
#define XB_XCNT(j)  (256  + 64 * (j))
#define XB_XSUB(j)  (1280 + 64 * (j))
#define XB_XGEN(j)  (2304 + 64 * (j))
#define XB_TOP      3328
#define XB_TOPGEN   3392
#define XCD_BAR_WORDS 3456
#define XB_SPIN_CAP (1u << 22)

__device__ __forceinline__ unsigned xb_ld(unsigned* p)              { return __hip_atomic_load(p, __ATOMIC_RELAXED, __HIP_MEMORY_SCOPE_AGENT); }
__device__ __forceinline__ unsigned xb_add(unsigned* p, unsigned v) { return __hip_atomic_fetch_add(p, v, __ATOMIC_RELAXED, __HIP_MEMORY_SCOPE_AGENT); }
__device__ __forceinline__ unsigned xb_xcc_id() { return (unsigned)__builtin_amdgcn_s_getreg((3 << 11) | 20) & 0xFu; }
#define XB_SPIN(cond, bar) do { unsigned _sp = 0; while (cond) { __builtin_amdgcn_s_sleep(1); \
    if ((++_sp & 255u) == 0u) { if (xb_ld(&(bar)[XB_TMO])) break; if (_sp > XB_SPIN_CAP) { atomicAdd(&(bar)[XB_TMO], 1u); break; } } } } while (0)

struct XcdBarrier {
    unsigned* bar; unsigned x;
    volatile LAS unsigned* st;
};

__device__ __forceinline__ XcdBarrier xcd_barrier_post(unsigned* bar, volatile LAS unsigned* st) {
    XcdBarrier b; b.bar = bar; b.x = xb_xcc_id(); b.st = st;
    if (threadIdx.x == 0) (void)xb_add(&bar[XB_XCNT(b.x)], 1u);
    return b;
}
__device__ __forceinline__ void xcd_barrier_complete(unsigned* bar, unsigned x, unsigned& nloc, unsigned& nx) {
    const unsigned G = gridDim.x * gridDim.y * gridDim.z;
    unsigned sum, cnt, mine, sp = 0u;
    for (;;) {
        sum = 0u; cnt = 0u; mine = 0u;
#pragma unroll
        for (unsigned j = 0; j < 16; ++j) { const unsigned c = xb_ld(&bar[XB_XCNT(j)]); sum += c; cnt += (c > 0u) ? 1u : 0u; mine = (j == x) ? c : mine; }
        if (sum == G) break;
        __builtin_amdgcn_s_sleep(1);
        if ((++sp & 255u) == 0u) { if (xb_ld(&bar[XB_TMO])) break; if (sp > XB_SPIN_CAP) { atomicAdd(&bar[XB_TMO], 1u); break; } }
    }
    nloc = mine > 0u ? mine : 1u; nx = cnt > 0u ? cnt : 1u;
}

__device__ __forceinline__ void xcd_barrier(const XcdBarrier& b) {
    asm volatile("s_waitcnt vmcnt(0)" ::: "memory");
    __syncthreads();
    if (threadIdx.x == 0) {
        unsigned* bar = b.bar;
        __builtin_amdgcn_s_waitcnt(0);
        unsigned nloc = b.st[0], nx = b.st[1];
        if (nloc == 0u) { xcd_barrier_complete(bar, b.x, nloc, nx); b.st[0] = nloc; b.st[1] = nx; }
        const unsigned old = xb_add(&bar[XB_XSUB(b.x)], 1u);
        const unsigned gen = old / nloc;
        if (old + 1u == (gen + 1u) * nloc) {
            __builtin_amdgcn_fence(__ATOMIC_RELEASE, "agent");
            asm volatile("s_waitcnt vmcnt(0)" ::: "memory");
            const unsigned og = xb_add(&bar[XB_TOP], 1u);
            const unsigned tg = og / nx;
            if (og + 1u == (tg + 1u) * nx) xb_add(&bar[XB_TOPGEN], 1u);
            else XB_SPIN(xb_ld(&bar[XB_TOPGEN]) == tg, bar);
            __builtin_amdgcn_fence(__ATOMIC_ACQUIRE, "agent");
            xb_add(&bar[XB_XGEN(b.x)], 1u);
            asm volatile("s_waitcnt vmcnt(0)" ::: "memory");
        } else {
            XB_SPIN(xb_ld(&bar[XB_XGEN(b.x)]) == gen, bar);
            __builtin_amdgcn_fence(__ATOMIC_ACQUIRE, "agent");
            asm volatile("s_waitcnt vmcnt(0)" ::: "memory");
        }
    }
    __syncthreads();
}

namespace pg8 {
#define PG8_LAS __attribute__((address_space(3)))
typedef unsigned short bf16_t;
typedef short bf16x8 __attribute__((ext_vector_type(8)));
typedef float f32x4 __attribute__((ext_vector_type(4)));
typedef unsigned u32x4 __attribute__((ext_vector_type(4)));
constexpr int BM = 256, BK = 64, HALF = 128, HTB = HALF * BK * 2  , STAGE_BYTES = 8 * HTB, NXCD = 8, WGM = 8;

__host__ __device__ __forceinline__ int lds_byte(int r, int c) { const int st = (r >> 4) * 2 + (c >> 5), rr = r & 15, cc = c & 31, ob = rr * 64 + cc * 2; return st * 1024 + (ob ^ (((ob >> 9) & 1) << 5)); }
__host__ __device__ __forceinline__ void stage_rc(int b, int& R, int& C) { const int st = b / 1024, sb = b % 1024, swz = sb ^ (((sb >> 9) & 1) << 5); R = (st >> 1) * 16 + swz / 64; C = (st & 1) * 32 + (swz % 64) / 2; }
__host__ __device__ __forceinline__ int perm32(int rho) { const int n = rho >> 4, i = rho & 15; return 8 * (i >> 2) + 4 * n + (i & 3); }

struct Unit { int pm, pn, e; };
struct Gemm { const bf16_t* A; const bf16_t* Bt; int M, N, K; size_t estride; };

struct StaticOrder {
    int nM, nN, nwg, G, c;
    __host__ __device__ void init(int M, int N, int G_, int c_) { nM = M / BM; nN = N / BM; nwg = nM * nN; G = G_; c = c_; }
    __host__ __device__ bool next(int i, Unit& u) const {
        const long L = (long)i * G + c; if (L >= nwg) return false;
        int wgid = (int)L; { const int q = nwg / NXCD, r = nwg % NXCD, xcd = wgid % NXCD, off = wgid / NXCD; wgid = (xcd < r ? xcd * (q + 1) : r * (q + 1) + (xcd - r) * q) + off; }
        const int nig = WGM * nN, gid = wgid / nig, fm = gid * WGM, gsz = (nM - fm) < WGM ? (nM - fm) : WGM;
        u.pm = fm + ((wgid % nig) % gsz); u.pn = (wgid % nig) / gsz; u.e = 0; return true;
    }
    __device__ __forceinline__ void a_ready(const Unit&) const {}
    __device__ __forceinline__ void done(const Unit&) const {}
};
__device__ __forceinline__ unsigned cvt_pk_bf16(float lo, float hi) { unsigned r; asm volatile("v_cvt_pk_bf16_f32 %0, %1, %2" : "=v"(r) : "v"(lo), "v"(hi)); return r; }
typedef float f32x2 __attribute__((ext_vector_type(2)));
__device__ __forceinline__ f32x2 gelu_pk(f32x2 v) {
    const f32x2 av = __builtin_elementwise_abs(v), d = av * 0.2316418882f + 1.0f;
    f32x2 t; t.x = __builtin_amdgcn_rcpf(d.x); t.y = __builtin_amdgcn_rcpf(d.y);
    f32x2 q = t * 0.5307027145f + (-0.7265760135f); q = q * t + 0.7107068705f; q = q * t + (-0.142248368f); q = q * t + 0.127414796f; q = q * t;
    const f32x2 s = (v * v) * (-0.72134752044f);
    f32x2 e; e.x = __builtin_amdgcn_exp2f(s.x); e.y = __builtin_amdgcn_exp2f(s.y);
    const f32x2 m = v * (q * e), r = v - m;
    f32x2 o; o.x = v.x < 0.f ? m.x : r.x; o.y = v.y < 0.f ? m.y : r.y; return o;
}

struct EpiF32 {
    static constexpr bool PERM = false, AFTER_DRAIN = false;
    float* C; int ldc; const float* bias;
    __device__ __forceinline__ void operator()(const f32x4 (&acc)[2][2][4][2], const Unit& u, int wr, int wc, int fr, int fq) const {
        const int row0 = u.pm * BM + wr * 64 + fr, col0 = u.pn * BM + wc * 32 + 4 * fq;
        f32x4 bv[2][2];
#pragma unroll
        for (int bj = 0; bj < 2; ++bj)
#pragma unroll
            for (int n = 0; n < 2; ++n) bv[bj][n] = bias ? *(const f32x4*)(bias + col0 + bj * HALF + n * 16) : (f32x4){0.f, 0.f, 0.f, 0.f};
#pragma unroll
        for (int ai = 0; ai < 2; ++ai)
#pragma unroll
            for (int m = 0; m < 4; ++m) { float* rowp = C + (size_t)(row0 + ai * HALF + m * 16) * ldc + col0;
#pragma unroll
                for (int bj = 0; bj < 2; ++bj)
#pragma unroll
                    for (int n = 0; n < 2; ++n) *(f32x4*)(rowp + bj * HALF + n * 16) = acc[ai][bj][m][n] + bv[bj][n]; }
    }
};
template <int ACT  > struct EpiBf16 {
    static constexpr bool PERM = true, AFTER_DRAIN = false;
    bf16_t* O; int ldc; const float* bias; int split_cols; size_t split_stride;
    __device__ __forceinline__ void operator()(const f32x4 (&acc)[2][2][4][2], const Unit& u, int wr, int wc, int fr, int fq) const {
        const int row0 = u.pm * BM + wr * 64 + fr; int colt = u.pn * BM; bf16_t* base = O;
        if (split_cols) { const int t = colt / split_cols; base += (size_t)t * split_stride; colt -= t * split_cols; }
        const int col0 = colt + wc * 32 + 8 * fq, bcol0 = u.pn * BM + wc * 32 + 8 * fq;
        f32x4 bv[2][2];
#pragma unroll
        for (int bj = 0; bj < 2; ++bj)
#pragma unroll
            for (int n = 0; n < 2; ++n) bv[bj][n] = bias ? *(const f32x4*)(bias + bcol0 + bj * HALF + 4 * n) : (f32x4){0.f, 0.f, 0.f, 0.f};
#pragma unroll
        for (int ai = 0; ai < 2; ++ai)
#pragma unroll
            for (int m = 0; m < 4; ++m) { bf16_t* rowp = base + (size_t)(row0 + ai * HALF + m * 16) * ldc + col0;
#pragma unroll
                for (int bj = 0; bj < 2; ++bj) { f32x4 v0 = acc[ai][bj][m][0] + bv[bj][0], v1 = acc[ai][bj][m][1] + bv[bj][1];
                    if (ACT == 1) { f32x2 a = gelu_pk((f32x2){v0[0], v0[1]}), b = gelu_pk((f32x2){v0[2], v0[3]}), c = gelu_pk((f32x2){v1[0], v1[1]}), d = gelu_pk((f32x2){v1[2], v1[3]});
                        v0 = (f32x4){a.x, a.y, b.x, b.y}; v1 = (f32x4){c.x, c.y, d.x, d.y}; }
                    if (ACT == 2) {
#pragma unroll
                        for (int j = 0; j < 4; ++j) { v0[j] = 0.5f * v0[j] * (1.0f + erff(v0[j] * 0.70710678f)); v1[j] = 0.5f * v1[j] * (1.0f + erff(v1[j] * 0.70710678f)); } }
                    u32x4 w; w.x = cvt_pk_bf16(v0[0], v0[1]); w.y = cvt_pk_bf16(v0[2], v0[3]); w.z = cvt_pk_bf16(v1[0], v1[1]); w.w = cvt_pk_bf16(v1[2], v1[3]);
                    *(u32x4*)(rowp + bj * HALF) = w; } }
    }
};

template <class Epi, class Sched, bool STAMP = false>
__device__ __forceinline__ void gemm_phase(PG8_LAS unsigned char* lds, const Gemm g, const Sched& S, const Epi& E, unsigned long long* stamps) {
    int tid_ = threadIdx.x; asm volatile("" : "+v"(tid_));
    const int tid = tid_, wid = __builtin_amdgcn_readfirstlane(tid >> 6), lane = tid & 63, wr = wid >> 2, wc = wid & 3, fr = lane & 15, fq = lane >> 4;
    const int K = g.K, nt = K / BK;
    int ts_lo = 0, ts_hi = 0, nts = 0; const unsigned long long rt_entry = STAMP ? (unsigned long long)wall_clock64() : 0ull;
#define PG8_STAMP() do { if (STAMP && wid == 0 && nts < 64) { const unsigned long long _c = (unsigned long long)clock64(); \
        ts_lo = (lane == nts) ? (int)(unsigned)_c : ts_lo; ts_hi = (lane == nts) ? (int)(unsigned)(_c >> 32) : ts_hi; ++nts; } } while (0)
    PG8_STAMP();
    unsigned voffA[2], voffB[2];
#pragma unroll
    for (int i = 0; i < 2; ++i) { int R, C; stage_rc(tid * 16 + i * 8192, R, C); const int Rb = Epi::PERM ? ((R & ~31) + perm32(R & 31)) : R;
        voffA[i] = (unsigned)(R * K + C) * 2u; voffB[i] = (unsigned)(Rb * K + C) * 2u; }
    const size_t kstep = (size_t)(BK * 2);
    const size_t hstep = (size_t)HALF * K * 2;
    const size_t tstep = 2 * hstep;
    const unsigned ldsw = (unsigned)wid * 1024u;
    const int aoff = lds_byte(wr * 64 + fr, fq * 8), boff = lds_byte(wc * 32 + fr, fq * 8);
#define PG8_SA(b, h) (((b) * 2 + (h)) * HTB)
#define PG8_SB(b, h) ((4 + (b) * 2 + (h)) * HTB)
#define PG8_STAGE(bufoff, gbase, voff) do { _Pragma("unroll") for (int _i = 0; _i < 2; ++_i) \
        __builtin_amdgcn_global_load_lds((const unsigned*)((const char*)(gbase) + (voff)[_i]), (PG8_LAS unsigned*)(lds + (bufoff) + ldsw + _i * 8192), 16, 0, 0); } while (0)
#define PG8_LDA(dst, b, h) do { _Pragma("unroll") for (int m = 0; m < 4; ++m) _Pragma("unroll") for (int k = 0; k < 2; ++k) dst[m][k] = *(const PG8_LAS bf16x8*)(lds + PG8_SA(b, h) + aoff + m * 2048 + k * 1024); } while (0)
#define PG8_LDB(dst, b, h) do { _Pragma("unroll") for (int n = 0; n < 2; ++n) _Pragma("unroll") for (int k = 0; k < 2; ++k) dst[n][k] = *(const PG8_LAS bf16x8*)(lds + PG8_SB(b, h) + boff + n * 2048 + k * 1024); } while (0)
#define PG8_MMA(ai, bj, At, Bt) do { __builtin_amdgcn_s_setprio(1); _Pragma("unroll") for (int m = 0; m < 4; ++m) _Pragma("unroll") for (int n = 0; n < 2; ++n) _Pragma("unroll") for (int k = 0; k < 2; ++k) \
        acc[ai][bj][m][n] = __builtin_amdgcn_mfma_f32_16x16x32_bf16(Bt[n][k], At[m][k], acc[ai][bj][m][n], 0, 0, 0); __builtin_amdgcn_s_setprio(0); } while (0)
#define PG8_WAIT_V(n) asm volatile("s_waitcnt vmcnt(" #n ")" ::: "memory")
#define PG8_WAIT_L(n) asm volatile("s_waitcnt lgkmcnt(" #n ")" ::: "memory")
#define PG8_BAR __builtin_amdgcn_s_barrier()
#define PG8_SCHED __builtin_amdgcn_sched_barrier(0)
    Unit cur, nxt; int ui = 0;
    if (!S.next(0, cur)) return;
    f32x4 acc[2][2][4][2];
#pragma unroll
    for (int a = 0; a < 2; ++a)
#pragma unroll
        for (int b = 0; b < 2; ++b)
#pragma unroll
            for (int m = 0; m < 4; ++m)
#pragma unroll
                for (int n = 0; n < 2; ++n) acc[a][b][m][n] = (f32x4){0.f, 0.f, 0.f, 0.f};
    bf16x8 At[4][2], B0[2][2], B1[2][2];
    const char* cA = (const char*)g.A + (size_t)cur.pm * tstep; const char* cB = (const char*)g.Bt + (size_t)cur.pn * tstep + (size_t)cur.e * g.estride * 2;
    S.a_ready(cur);
    PG8_STAGE(PG8_SB(0, 0), cB, voffB); PG8_STAGE(PG8_SA(0, 0), cA, voffA); PG8_STAGE(PG8_SB(0, 1), cB + hstep, voffB); PG8_STAGE(PG8_SA(0, 1), cA + hstep, voffA);
    if (wr == 1) PG8_BAR;
    PG8_WAIT_V(4); PG8_BAR;
    PG8_STAGE(PG8_SB(1, 0), cB + kstep, voffB); PG8_STAGE(PG8_SA(1, 0), cA + kstep, voffA); PG8_STAGE(PG8_SB(1, 1), cB + hstep + kstep, voffB);
    PG8_WAIT_V(6); PG8_BAR;
    PG8_STAMP();
    for (;;) {
        const bool has_next = S.next(ui + 1, nxt);
        const char* nA = has_next ? (const char*)g.A + (size_t)nxt.pm * tstep : cA; const char* nB = has_next ? (const char*)g.Bt + (size_t)nxt.pn * tstep + (size_t)nxt.e * g.estride * 2 : cB;
        for (int t = 0; t < nt; t += 2) {
            const bool last = (t == nt - 2);
            const char* a1 = cA + (size_t)(t + 1) * kstep;
            const char* a2 = last ? nA : cA + (size_t)(t + 2) * kstep; const char* b2 = last ? nB : cB + (size_t)(t + 2) * kstep;
            const char* a3 = a2 + kstep; const char* b3 = b2 + kstep;
            if (last && has_next) S.a_ready(nxt);
            PG8_LDB(B0, 0, 0); PG8_SCHED; PG8_LDA(At, 0, 0); PG8_STAGE(PG8_SA(1, 1), a1 + hstep, voffA);
            PG8_WAIT_L(8); PG8_BAR; PG8_WAIT_L(0); PG8_MMA(0, 0, At, B0); PG8_BAR; PG8_SCHED;
            PG8_LDB(B1, 0, 1); PG8_STAGE(PG8_SB(0, 0), b2, voffB);
            PG8_BAR; PG8_WAIT_L(0); PG8_MMA(0, 1, At, B1); PG8_BAR;
            PG8_LDA(At, 0, 1); PG8_STAGE(PG8_SA(0, 0), a2, voffA);
            PG8_BAR; PG8_WAIT_L(0); PG8_MMA(1, 0, At, B0); PG8_BAR; PG8_SCHED;
            PG8_STAGE(PG8_SB(0, 1), b2 + hstep, voffB);
            PG8_WAIT_V(6); PG8_BAR; PG8_MMA(1, 1, At, B1); PG8_BAR;
            PG8_LDB(B0, 1, 0); PG8_SCHED; PG8_LDA(At, 1, 0); PG8_STAGE(PG8_SA(0, 1), a2 + hstep, voffA);
            PG8_WAIT_L(8); PG8_BAR; PG8_WAIT_L(0); PG8_MMA(0, 0, At, B0); PG8_BAR; PG8_SCHED;
            PG8_LDB(B1, 1, 1); PG8_STAGE(PG8_SB(1, 0), b3, voffB);
            PG8_BAR; PG8_WAIT_L(0); PG8_MMA(0, 1, At, B1); PG8_BAR;
            PG8_LDA(At, 1, 1); PG8_STAGE(PG8_SA(1, 0), a3, voffA);
            PG8_BAR; PG8_WAIT_L(0); PG8_MMA(1, 0, At, B0); PG8_BAR; PG8_SCHED;
            PG8_STAGE(PG8_SB(1, 1), b3 + hstep, voffB);
            PG8_WAIT_V(6); PG8_BAR; PG8_MMA(1, 1, At, B1); PG8_BAR;
        }
        PG8_STAMP();
        if constexpr (!Epi::AFTER_DRAIN) { E(acc, cur, wr, wc, fr, fq); S.done(cur); }
        PG8_STAMP();
        if (!has_next) break;
#pragma unroll
        for (int a = 0; a < 2; ++a)
#pragma unroll
            for (int b = 0; b < 2; ++b)
#pragma unroll
                for (int m = 0; m < 4; ++m)
#pragma unroll
                    for (int n = 0; n < 2; ++n) acc[a][b][m][n] = (f32x4){0.f, 0.f, 0.f, 0.f};
        cur = nxt; cA = nA; cB = nB; ++ui;
    }
    PG8_WAIT_V(0);
    if (wr == 0) PG8_BAR;
    PG8_BAR;
    if constexpr (Epi::AFTER_DRAIN) { E.fused(acc, cur, wr, wc, fr, fq, lds, wid, lane); S.done(cur); }
    PG8_STAMP();
    if (STAMP && wid == 0) { stamps[lane] = lane < nts ? (((unsigned long long)(unsigned)ts_hi << 32) | (unsigned)ts_lo) : 0ull;
        if (lane == 62) stamps[62] = rt_entry; if (lane == 63) stamps[63] = (unsigned long long)wall_clock64(); }
#undef PG8_STAMP
#undef PG8_SA
#undef PG8_SB
#undef PG8_STAGE
#undef PG8_LDA
#undef PG8_LDB
#undef PG8_MMA
#undef PG8_WAIT_V
#undef PG8_WAIT_L
#undef PG8_BAR
#undef PG8_SCHED
}
}
namespace pg8 {
struct EpiRes {
    static constexpr bool PERM = false, AFTER_DRAIN = false;
    const float* base_lat; const float* base_ctx; float* out_lat; float* out_ctx; const float* gvec;
    __device__ __forceinline__ void operator()(const f32x4 (&acc)[2][2][4][2], const Unit& u, int wr, int wc, int fr, int fq) const {
        const bool isctx = u.pm >= 128;
        const int prow = (isctx ? (u.pm - 128) : u.pm) * BM;
        const float* base = isctx ? base_ctx : base_lat; float* out = isctx ? out_ctx : out_lat;
        const float* gv = gvec + (size_t)(isctx ? 8 : (u.pm >> 4)) * 6144;
        const int row0 = prow + wr * 64 + fr, col0 = u.pn * BM + wc * 32 + 4 * fq;
        f32x4 gvv[2][2];
#pragma unroll
        for (int bj = 0; bj < 2; ++bj)
#pragma unroll
            for (int n = 0; n < 2; ++n) gvv[bj][n] = *(const f32x4*)(gv + col0 + bj * HALF + n * 16);
#pragma unroll
        for (int ai = 0; ai < 2; ++ai)
#pragma unroll
            for (int m = 0; m < 4; ++m) { const size_t off = (size_t)(row0 + ai * HALF + m * 16) * 1024 + col0;
#pragma unroll
                for (int bj = 0; bj < 2; ++bj)
#pragma unroll
                    for (int n = 0; n < 2; ++n) { const f32x4 b = *(const f32x4*)(base + off + bj * HALF + n * 16);
                        *(f32x4*)(out + off + bj * HALF + n * 16) = b + gvv[bj][n] * acc[ai][bj][m][n]; } }
    }
};
struct EpiSwiglu {
    static constexpr bool PERM = true, AFTER_DRAIN = false;
    bf16_t* O; int ldc;
    __device__ __forceinline__ void operator()(const f32x4 (&acc)[2][2][4][2], const Unit& u, int wr, int wc, int fr, int fq) const {
        const int row0 = u.pm * BM + wr * 64 + fr, col0 = u.pn * HALF + wc * 32 + 8 * fq;
#pragma unroll
        for (int ai = 0; ai < 2; ++ai)
#pragma unroll
            for (int m = 0; m < 4; ++m) { bf16_t* rowp = O + (size_t)(row0 + ai * HALF + m * 16) * ldc + col0;
                float h[8];
#pragma unroll
                for (int n = 0; n < 2; ++n)
#pragma unroll
                    for (int j = 0; j < 4; ++j) { const float g = acc[ai][0][m][n][j], up = acc[ai][1][m][n][j]; h[n * 4 + j] = g * __builtin_amdgcn_rcpf(1.0f + __expf(-g)) * up; }
                u32x4 w; w.x = cvt_pk_bf16(h[0], h[1]); w.y = cvt_pk_bf16(h[2], h[3]); w.z = cvt_pk_bf16(h[4], h[5]); w.w = cvt_pk_bf16(h[6], h[7]);
                *(u32x4*)rowp = w; }
    }
};
struct MoeOrder {
    int nN, G, c, nunits; const int* tab;
    __device__ void init(const int* tab_, int nN_, int G_, int c_) { tab = tab_; nN = nN_; G = G_; c = c_; nunits = tab_[0] * nN_; }
    __device__ bool next(int i, Unit& u) const {
        const int L = i * G + c; if (L >= nunits) return false;
        u.pm = L / nN; u.pn = L - u.pm * nN; u.e = tab[1 + u.pm]; return true;
    }
    __device__ __forceinline__ void a_ready(const Unit&) const {}
    __device__ __forceinline__ void done(const Unit&) const {}
};
}
enum { I_X = 0, I_C, I_CTX, I_CCTX, I_MODW, I_MODB, I_NMIXG, I_NFFNG, I_WIN, I_WOUT, I_LCW, I_LCB, I_LWA, I_LBA, I_LWX, I_LBX, I_LLAM,
       I_RMU, I_RWUP, I_RW0, I_RAUP, I_RA0, I_RGUP, I_RKK, I_RKA, I_RRK, I_RLNG, I_RLNB, I_MIB, I_MFB, I_MNG, I_GCW, I_GALOG, I_GDTB, I_GNG,
       I_FWG, I_FWU, I_FWD, I_MROUTER, I_MWG, I_MWU, I_MWD, I_FNG, N_IN };
struct Args { const float* in[N_IN]; float* out; unsigned char* ws; int ph_lo, ph_hi; };
struct Ctx {
    const float* const* in; float* out; unsigned char* ws; LAS unsigned char* lds;
    int tid, lane, wave, G, wg;
};
#define WSP(T, off) ((T*)(C.ws + (off)))

__device__ __forceinline__ int seqrow_raster(int i, int d, int b) {
    if (i < CTXL) { const int p = d ? (CTXL - 1 - i) : i; return T_LAT + b * CTXL + p; }
    const int j = i - CTXL; const int p = d ? (SEQ - 1 - j) : j; return b * SEQ + p;
}
__device__ __forceinline__ int seqrow_cm(int i, int d, int b) {
    if (i < CTXL) { const int p = d ? (CTXL - 1 - i) : i; return T_LAT + b * CTXL + p; }
    const int j = i - CTXL; const int p = d ? (SEQ - 1 - j) : j; return b * SEQ + (p & 63) * 64 + (p >> 6);
}

__device__ __forceinline__ void phase_pre(const Ctx& C) {
    LAS float* sc = (LAS float*)C.lds;
    LAS float* red = sc + 9 * 1024;
    float* modv = WSP(float, WS_MODV);
    bool filled = false;
    for (int it = C.wg; it < DEPTH * 48; it += C.G) {
        if (!filled) {
            for (int i = C.tid; i < 9 * 1024; i += NTHR) { const float v = i < 8192 ? C.in[I_C][i] : C.in[I_CCTX][i - 8192]; sc[i] = siluf_(v); }
            filled = true; __syncthreads();
        }
        const int l = it / 48, jb = it % 48, col = C.tid & 127, kg = C.tid >> 7;
        const float* W = C.in[I_MODW] + (size_t)l * 1024 * 6144 + jb * 128 + col;
        float acc[9];
#pragma unroll
        for (int r = 0; r < 9; ++r) acc[r] = 0.f;
        for (int k = kg * 256; k < kg * 256 + 256; ++k) { const float w = W[(size_t)k * 6144];
#pragma unroll
            for (int r = 0; r < 9; ++r) acc[r] += sc[r * 1024 + k] * w; }
#pragma unroll
        for (int r = 0; r < 9; ++r) red[(kg * 9 + r) * 128 + col] = acc[r];
        __syncthreads();
        for (int i = C.tid; i < 9 * 128; i += NTHR) { const int r = i >> 7, cc = i & 127;
            const float s = red[(0 * 9 + r) * 128 + cc] + red[(1 * 9 + r) * 128 + cc] + red[(2 * 9 + r) * 128 + cc] + red[(3 * 9 + r) * 128 + cc];
            modv[((size_t)l * 9 + r) * 6144 + jb * 128 + cc] = s + C.in[I_MODB][l * 6144 + jb * 128 + cc]; }
        __syncthreads();
    }
}

__device__ __forceinline__ void tr_item(const float* src, size_t ld, int k0, int ns0, bf16* dst, int drow0, int Kd, LAS float* scr, int lane, bool zero) {
    if (!zero) {
#pragma unroll 8
        for (int i = 0; i < 32; ++i) { const int kk = 2 * i + (lane >> 5); scr[kk * 33 + (lane & 31)] = src[(size_t)(k0 + kk) * ld + ns0 + (lane & 31)]; }
    }
    LDS_WAIT(); asm volatile("" ::: "memory");
    const int c = lane & 7;
#pragma unroll
    for (int j = 0; j < 4; ++j) { const int n = (lane >> 3) + 8 * j; const LAS float* s = scr + (8 * c) * 33 + n;
        v4u o; o.x = pk2(s[0 * 33], s[1 * 33]); o.y = pk2(s[2 * 33], s[3 * 33]); o.z = pk2(s[4 * 33], s[5 * 33]); o.w = pk2(s[6 * 33], s[7 * 33]);
        if (zero) o = (v4u){0u, 0u, 0u, 0u};
        *(v4u*)(dst + (size_t)(drow0 + n) * Kd + k0 + 8 * c) = o; }
    LDS_WAIT(); asm volatile("" ::: "memory");
}
__device__ __forceinline__ void convert_layer(const Ctx& C, int l) {
    LAS float* scr = (LAS float*)(C.lds + C.wave * 8704);
    const int gw = C.wg * NWAVES + C.wave, NGW = C.G * NWAVES;
    constexpr int I_IN = 16 * 112, I_OUT = 16 * 32, I_GU = 16 * 176, I_DN = 44 * 32, I_E = 16 * 88 + 22 * 32;
    const bool moe = l & 1; const int li = l >> 1;
    const int nitems = I_IN + I_OUT + (moe ? NE * I_E : (I_GU + I_DN));
    bf16* win = WSP(bf16, WS_WIN); bf16* wout = WSP(bf16, WS_WOUT); bf16* wgu = WSP(bf16, WS_WGU); bf16* wdn = WSP(bf16, WS_WDN);
    {
        bf16* lw = WSP(bf16, WS_LRUWT);
        for (int k = 0; k < 2 * 2 * 4 * 4096 / (128 * NTHR); ++k) {
            const int e = k * 128 * NTHR + C.wg * NTHR + C.tid;
            if (C.wg < 128) {
            const int i = e & 63, j = (e >> 6) & 63, hd = (e >> 12) & 3, g = (e >> 14) & 1, d = e >> 15;
            const float* src = (g ? C.in[I_LWX] : C.in[I_LWA]) + ((size_t)((l * 2 + d) * 4 + hd) * 64 + i) * 64 + j;
            lw[e] = (bf16)f2bf(*src);
            }
        }
    }
    if (C.wg >= 128 && C.wg < 224) {
        bf16* rw = WSP(bf16, WS_RWT);
        const int e = (C.wg - 128) * NTHR + C.tid;
        if (e < 32768) { const int r = e & 31, ch = (e >> 5) & 255, d = (e >> 13) & 1, isa = e >> 14;
            rw[e] = (bf16)f2bf((isa ? C.in[I_RAUP] : C.in[I_RWUP])[((size_t)(l * 2 + d) * 32 + r) * GW + ch]); }
        else { const int e2 = e - 32768, j = e2 & 63, ch = e2 >> 6; rw[e] = (bf16)f2bf(C.in[I_RGUP][((size_t)l * 64 + j) * GW + ch]); }
    }
    for (int it = gw; it < nitems; it += NGW) {
        int r = it;
        if (r < I_IN) { const int kb = r / 112, nb = r % 112; tr_item(C.in[I_WIN] + (size_t)l * 1024 * IN_COLS, IN_COLS, 64 * kb, 32 * nb, win, 32 * nb, 1024, scr, C.lane, nb == 111); continue; }
        r -= I_IN;
        if (r < I_OUT) { const int kb = r / 32, nb = r % 32; tr_item(C.in[I_WOUT] + (size_t)l * 1024 * 1024, 1024, 64 * kb, 32 * nb, wout, 32 * nb, 1024, scr, C.lane, false); continue; }
        r -= I_OUT;
        if (!moe) {
            if (r < I_GU) { const int kb = r / 176, nb = r % 176, tile = nb >> 3, q = nb & 7;
                const float* src = (q < 4 ? C.in[I_FWG] : C.in[I_FWU]) + (size_t)li * 1024 * DFF;
                tr_item(src, DFF, 64 * kb, tile * 128 + (q & 3) * 32, wgu, 32 * nb, 1024, scr, C.lane, false); continue; }
            r -= I_GU;
            { const int kb = r / 32, nb = r % 32; tr_item(C.in[I_FWD] + (size_t)li * DFF * 1024, 1024, 64 * kb, 32 * nb, wdn, 32 * nb, DFF, scr, C.lane, false); }
        } else {
            const int e = r / I_E; int rr = r % I_E;
            if (rr < 16 * 88) { const int kb = rr / 88, nb = rr % 88, tile = nb >> 3, q = nb & 7;
                const float* src = (q < 4 ? C.in[I_MWG] : C.in[I_MWU]) + ((size_t)li * NE + e) * 1024 * DFE;
                tr_item(src, DFE, 64 * kb, tile * 128 + (q & 3) * 32, wgu + (size_t)e * 2 * DFE * 1024, 32 * nb, 1024, scr, C.lane, false); continue; }
            rr -= 16 * 88;
            { const int kb = rr / 32, nb = rr % 32; tr_item(C.in[I_MWD] + ((size_t)li * NE + e) * DFE * 1024, 1024, 64 * kb, 32 * nb, wdn + (size_t)e * 1024 * DFE, 32 * nb, DFE, scr, C.lane, false); }
        }
    }
}

template <bool ROUTE>
__device__ __forceinline__ void norm_rows(const Ctx& C, int l, const float* xlat, const float* xctx, const float* gain, int shoff, int scoff, int nrows, int moe_li) {
    const float* modv = WSP(float, WS_MODV) + (size_t)l * 9 * 6144;
    bf16* hb = WSP(bf16, WS_HB);
    const int gw = C.wg * NWAVES + C.wave, NGW = C.G * NWAVES;
    LAS unsigned* lcnt = (LAS unsigned*)(C.lds + 65536);
    unsigned* route = WSP(unsigned, WS_ROUTE);
    if (ROUTE) { if (C.tid < 8) lcnt[C.tid] = 0u; __syncthreads(); }
    f32x4 gv[4];
#pragma unroll
    for (int j = 0; j < 4; ++j) gv[j] = *(const f32x4*)(gain + 4 * C.lane + 256 * j);
    for (int m = gw; m < nrows; m += NGW) {
        const bool isctx = m >= T_LAT;
        const float* xr = isctx ? xctx + (size_t)(m - T_LAT) * 1024 : xlat + (size_t)m * 1024;
        const float* mv = modv + (size_t)(isctx ? 8 : (m >> 12)) * 6144;
        f32x4 v[4]; float s = 0.f;
#pragma unroll
        for (int j = 0; j < 4; ++j) { v[j] = *(const f32x4*)(xr + 4 * C.lane + 256 * j); s += (v[j].x * v[j].x + v[j].y * v[j].y) + (v[j].z * v[j].z + v[j].w * v[j].w); }
        const float rs = 1.0f / sqrtf(wave_sum(s) * (1.0f / 1024.0f) + 1e-6f);
#pragma unroll
        for (int j = 0; j < 4; ++j) { const f32x4 sh = *(const f32x4*)(mv + shoff + 4 * C.lane + 256 * j), scl = *(const f32x4*)(mv + scoff + 4 * C.lane + 256 * j);
            v[j] = (v[j] * rs * gv[j]) * (scl + 1.0f) + sh;
            v2u o; o.x = pk2(v[j].x, v[j].y); o.y = pk2(v[j].z, v[j].w);
            *(v2u*)(hb + (size_t)m * 1024 + 4 * C.lane + 256 * j) = o; }
        if (ROUTE) {
            const float* rt = C.in[I_MROUTER] + (size_t)moe_li * 1024 * NE;
            float lg[8];
#pragma unroll
            for (int e = 0; e < 8; ++e) lg[e] = 0.f;
#pragma unroll
            for (int j = 0; j < 4; ++j)
#pragma unroll
                for (int q = 0; q < 4; ++q) { const int k = 4 * C.lane + 256 * j + q; const f32x4 r0 = *(const f32x4*)(rt + (size_t)k * 8), r1 = *(const f32x4*)(rt + (size_t)k * 8 + 4); const float hv = v[j][q];
                    lg[0] += hv * r0.x; lg[1] += hv * r0.y; lg[2] += hv * r0.z; lg[3] += hv * r0.w; lg[4] += hv * r1.x; lg[5] += hv * r1.y; lg[6] += hv * r1.z; lg[7] += hv * r1.w; }
#pragma unroll
            for (int e = 0; e < 8; ++e) lg[e] = wave_sum(lg[e]);
            int e0 = 0; float l0 = lg[0];
#pragma unroll
            for (int e = 1; e < 8; ++e) if (lg[e] > l0) { l0 = lg[e]; e0 = e; }
            int e1 = -1; float l1 = -3.0e38f;
#pragma unroll
            for (int e = 0; e < 8; ++e) if (e != e0 && lg[e] > l1) { l1 = lg[e]; e1 = e; }
            const float w0 = 1.0f / (1.0f + __expf(l1 - l0)), w1 = 1.0f - w0;
            if (C.lane == 0) {
                const unsigned r0 = atomicAdd((unsigned*)&lcnt[e0], 1u), r1 = atomicAdd((unsigned*)&lcnt[e1], 1u);
                v4u a; a.x = (unsigned)e0; a.y = (unsigned)e1; a.z = r0; a.w = r1;
                *(v4u*)(route + (size_t)m * 8) = a;
                v2u b; b.x = __builtin_bit_cast(unsigned, w0); b.y = __builtin_bit_cast(unsigned, w1);
                *(v2u*)(route + (size_t)m * 8 + 4) = b;
            }
        }
    }
    if (ROUTE) {
        __syncthreads();
        if (C.tid < 8) { unsigned* gc = WSP(unsigned, WS_CTL) + CW_MOECNT + 64 * moe_li; const unsigned base = atomicAdd(gc + C.tid, lcnt[C.tid]); WSP(unsigned, WS_WGBASE)[C.wg * 8 + C.tid] = base; }
    }
}
template <bool FIN>
__device__ __forceinline__ void lru_chunk(const Ctx& C, int l, int b, int c) {
    LAS float* U = (LAS float*)C.lds;
    const bf16* P = WSP(const bf16, WS_P);
    const bool isctx = c < 4; const int p0 = isctx ? c * 64 : (c - 4) * 64; const int Lp = isctx ? CTXL : SEQ; const int row0 = isctx ? T_LAT + b * CTXL : b * SEQ;
    const int ch = C.tid & 255, half = C.tid >> 8;
    {
        const float* cw = C.in[I_LCW] + (size_t)l * 4 * GW + ch; const float w0 = cw[0], w1 = cw[GW], w2 = cw[2 * GW], w3 = cw[3 * GW], cb = C.in[I_LCB][l * GW + ch];
        const int t0 = half * 32;
        auto ld = [&](int p) -> float { return (p >= 0 && p < Lp) ? bf2f(P[(size_t)(row0 + p) * PLD + ch]) : 0.f; };
        float xm2 = ld(p0 + t0 - 2), xm1 = ld(p0 + t0 - 1), x0 = ld(p0 + t0);
        for (int t = 0; t < 32; ++t) { const float xp1 = ld(p0 + t0 + t + 1); U[(t0 + t) * 256 + ch] = w0 * xm2 + w1 * xm1 + w2 * x0 + w3 * xp1 + cb; xm2 = xm1; xm1 = x0; x0 = xp1; }
    }
    __syncthreads();
    const int d = half, hd = ch >> 6, jj = ch & 63;
    const float* wa = C.in[I_LWA] + ((size_t)((l * 2 + d) * 4 + hd) * 64) * 64 + jj;
    const float* wx = C.in[I_LWX] + ((size_t)((l * 2 + d) * 4 + hd) * 64) * 64 + jj;
    const float ba = C.in[I_LBA][(l * 2 + d) * GW + ch], bx = C.in[I_LBX][(l * 2 + d) * GW + ch];
    const float sp8 = 8.0f * softplusf_(-C.in[I_LLAM][(l * 2 + d) * GW + ch]);
    const size_t sidx = ((size_t)(b * NCH + c) * 2 + d) * 256 + ch;
    float h = FIN ? WSP(const float, WS_HIN)[sidx] : 0.f, sla = 0.f;
    LAS bf16* H16 = (LAS bf16*)(U + 64 * 256) + d * 64 * 256;
    const int sgn = d ? -1 : 1;
#pragma unroll 1
    for (int g = 0; g < 4; ++g) {
        const int tstart = d ? (63 - g * 16) : g * 16;
        float ar[16], ai[16];
#pragma unroll
        for (int tt = 0; tt < 16; ++tt) { ar[tt] = 0.f; ai[tt] = 0.f; }
        const LAS float* ub = U + tstart * 256 + hd * 64;
#pragma unroll 1
        for (int i = 0; i < 64; i += 4) {
            float a4[4], x4[4];
#pragma unroll
            for (int q = 0; q < 4; ++q) { a4[q] = wa[(i + q) * 64]; x4[q] = wx[(i + q) * 64]; }
#pragma unroll
            for (int tt = 0; tt < 16; ++tt) { const f32x4 uu = *(const LAS f32x4*)(ub + sgn * tt * 256 + i);
                ar[tt] += uu.x * a4[0] + uu.y * a4[1] + uu.z * a4[2] + uu.w * a4[3];
                ai[tt] += uu.x * x4[0] + uu.y * x4[1] + uu.z * x4[2] + uu.w * x4[3]; }
        }
#pragma unroll
        for (int tt = 0; tt < 16; ++tt) {
            const int tok = tstart + sgn * tt;
            const float r = sigmoidf_(ar[tt] + ba), ig = sigmoidf_(ai[tt] + bx);
            const float la = -sp8 * r; const float a = __expf(la);
            const float bb = sqrtf(-expm1f_(2.0f * la)) * (ig * U[tok * 256 + ch]);
            h = a * h + bb; sla += la;
            if (FIN) H16[tok * 256 + ch] = (bf16)f2bf1(h);
        }
    }
    if (!FIN) { float* ls = WSP(float, WS_LSUM) + sidx * 2; ls[0] = sla; ls[1] = h; __syncthreads(); return; }
    __syncthreads();
    bf16* yc = WSP(bf16, WS_HB);
    const LAS bf16* H0 = (const LAS bf16*)(U + 64 * 256); const LAS bf16* H1 = H0 + 64 * 256;
    for (int t = half * 32; t < half * 32 + 32; ++t) {
        const size_t row = (size_t)(row0 + p0 + t);
        const float gate = bf2f(P[row * PLD + 256 + ch]);
        yc[row * 1024 + ch] = (bf16)f2bf1((bf2f(H0[t * 256 + ch]) + bf2f(H1[t * 256 + ch])) * gelu_tanh(gate));
    }
    __syncthreads();
}
__device__ __forceinline__ void lru_carry(const Ctx& C, int idx) {
    const int ch = idx & 255, d = (idx >> 8) & 1, b = idx >> 9;
    const float* ls = WSP(const float, WS_LSUM); float* hin = WSP(float, WS_HIN);
    float H = 0.f;
    for (int k = 0; k < NCH; ++k) {
        const int c = d ? (k < 4 ? 3 - k : NCH + 3 - k) : k;
        const size_t sidx = ((size_t)(b * NCH + c) * 2 + d) * 256 + ch;
        hin[sidx] = H;
        H = __expf(ls[sidx * 2]) * H + ls[sidx * 2 + 1];
    }
}

__device__ __forceinline__ float rw_shift(const bf16* P, int row0, int p, int Lp, int colB, float mu0, float mu1) {
    const size_t o = (size_t)(row0 + p) * PLD + OFF_B + colB;
    const float x = bf2f(P[o]);
    const float pv = p > 0 ? bf2f(P[o - PLD]) : 0.f, nx = p < Lp - 1 ? bf2f(P[o + PLD]) : 0.f;
    return x + mu0 * (pv - x) + mu1 * (nx - x);
}
__device__ __forceinline__ void rwkv_prep(const Ctx& C, int l, int b, int c) {
    LAS float* XW = (LAS float*)C.lds;
    LAS float* XA = XW + 64 * 64;
    LAS float* XG = XA + 64 * 64;
    const bf16* P = WSP(const bf16, WS_P);
    const bool isctx = c < 4; const int p0 = isctx ? c * 64 : (c - 4) * 64; const int Lp = isctx ? CTXL : SEQ; const int row0 = isctx ? T_LAT + b * CTXL : b * SEQ;
    const float* mu = C.in[I_RMU] + (size_t)l * 2 * B_COLS;
    for (int it = C.tid; it < 64 * 192; it += NTHR) {
        const int t = it / 192, ci = it % 192, colB = 768 + ci;
        const float v = rw_shift(P, row0, p0 + t, Lp, colB, mu[colB], mu[B_COLS + colB]);
        if (ci < 64) XW[t * 64 + ci] = tanhf_(v); else if (ci < 128) XA[t * 64 + ci - 64] = v; else XG[t * 64 + ci - 128] = sigmoidf_(v);
    }
    __syncthreads();
    const int ch = C.tid & 255, half = C.tid >> 8, head = ch >> 6;
    bf16* wa_out = WSP(bf16, WS_HB); bf16* g_out = WSP(bf16, WS_G); float* bonus = WSP(float, WS_BONUS);
    const float* wup = C.in[I_RWUP] + (size_t)l * 2 * 32 * GW + ch;
    const float* aup = C.in[I_RAUP] + (size_t)l * 2 * 32 * GW + ch;
    const float* gup = C.in[I_RGUP] + (size_t)l * 64 * GW + ch;
    const float w00 = C.in[I_RW0][(l * 2 + 0) * GW + ch], w01 = C.in[I_RW0][(l * 2 + 1) * GW + ch];
    const float a00 = C.in[I_RA0][(l * 2 + 0) * GW + ch], a01 = C.in[I_RA0][(l * 2 + 1) * GW + ch];
    const float k_a = C.in[I_RKA][l * GW + ch], r_k = C.in[I_RRK][l * GW + ch];
    const float mur0 = mu[ch], mur1 = mu[B_COLS + ch], muk0 = mu[256 + ch], muk1 = mu[B_COLS + 256 + ch];
#pragma unroll 1
    for (int sub = 0; sub < 2; ++sub) {
        const int t0 = half * 32 + sub * 16;
        float acc[16], av0[16], av1[16];
#pragma unroll
        for (int kind = 0; kind < 4; ++kind) {
            const int d = kind & 1; const bool isw = kind < 2;
            const float* W = (isw ? wup : aup) + (size_t)d * 32 * GW; const LAS float* X = (isw ? XW : XA) + d * 32;
#pragma unroll
            for (int t = 0; t < 16; ++t) acc[t] = 0.f;
            for (int r = 0; r < 32; r += 4) {
                const float g0 = W[(r + 0) * GW], g1 = W[(r + 1) * GW], g2 = W[(r + 2) * GW], g3 = W[(r + 3) * GW];
#pragma unroll
                for (int t = 0; t < 16; ++t) { const f32x4 x = *(const LAS f32x4*)(X + (t0 + t) * 64 + r); acc[t] += x.x * g0 + x.y * g1 + x.z * g2 + x.w * g3; }
            }
#pragma unroll
            for (int t = 0; t < 16; ++t) {
                const size_t row = (size_t)(row0 + p0 + t0 + t);
                float val;
                if (isw) val = __expf(-0.6065306597126334f * sigmoidf_(acc[t] + (d ? w01 : w00)));
                else { val = sigmoidf_(acc[t] + (d ? a01 : a00)); if (d) av1[t] = val; else av0[t] = val; }
                wa_out[row * 1024 + kind * 256 + ch] = (bf16)f2bf1(val);
            }
        }
#pragma unroll
        for (int t = 0; t < 16; ++t) acc[t] = 0.f;
        for (int j = 0; j < 64; j += 4) {
            const float g0 = gup[(j + 0) * GW], g1 = gup[(j + 1) * GW], g2 = gup[(j + 2) * GW], g3 = gup[(j + 3) * GW];
#pragma unroll
            for (int t = 0; t < 16; ++t) { const f32x4 x = *(const LAS f32x4*)(XG + (t0 + t) * 64 + j); acc[t] += x.x * g0 + x.y * g1 + x.z * g2 + x.w * g3; }
        }
#pragma unroll
        for (int t = 0; t < 16; ++t) {
            const int p = p0 + t0 + t; const size_t row = (size_t)(row0 + p);
            g_out[row * 256 + ch] = (bf16)f2bf1(acc[t]);
            const float rs = rw_shift(P, row0, p, Lp, ch, mur0, mur1), ks = rw_shift(P, row0, p, Lp, 256 + ch, muk0, muk1);
            const float km = ks * (1.0f + (av0[t] - 1.0f) * k_a) + ks * (1.0f + (av1[t] - 1.0f) * k_a);
            const float bs = wave_sum(rs * r_k * km);
            if (C.lane == 0) bonus[row * 4 + head] = bs;
        }
    }
    __syncthreads();
}
__device__ __forceinline__ void rwkv_scan(const Ctx& C, int l, int idx) {
    const int d = idx >> 6, b = (idx >> 3) & 7, h = (idx >> 1) & 3, half = idx & 1;
    LAS float* BUF = (LAS float*)C.lds;
    LAS float* YB = BUF + 2 * 32 * 6 * 64;
    const bf16* P = WSP(const bf16, WS_P); const bf16* WA = WSP(const bf16, WS_HB); bf16* outb = WSP(bf16, WS_OUTB) + (size_t)d * T_ALL * 256;
    const int st = C.tid >> 4, q4 = C.tid & 15, chh = h * 64 + q4 * 4;
    const float* mu = C.in[I_RMU] + (size_t)l * 2 * B_COLS;
    f32x4 mu0[3], mu1[3];
#pragma unroll
    for (int q = 0; q < 3; ++q) { mu0[q] = *(const f32x4*)(mu + q * 256 + chh); mu1[q] = *(const f32x4*)(mu + B_COLS + q * 256 + chh); }
    const f32x4 kk_w = *(const f32x4*)(C.in[I_RKK] + l * GW + chh), ka_w = *(const f32x4*)(C.in[I_RKA] + l * GW + chh);
    v2u gxc[3], gxp[3], gxn[3], gwr, gar;
    auto gload = [&](int nb) {
        const int i = nb * 32 + st;
        const bool isctx = i < CTXL; const int Lp = isctx ? CTXL : SEQ; const int j = isctx ? i : i - CTXL; const int p = d ? (Lp - 1 - j) : j;
        const int row = (isctx ? T_LAT + b * CTXL : b * SEQ) + p;
#pragma unroll
        for (int q = 0; q < 3; ++q) {
            const bf16* pp = P + (size_t)row * PLD + OFF_B + q * 256 + chh;
            gxc[q] = *(const v2u*)pp; gxp[q] = (v2u){0u, 0u}; gxn[q] = (v2u){0u, 0u};
            if (p > 0) gxp[q] = *(const v2u*)(pp - PLD);
            if (p < Lp - 1) gxn[q] = *(const v2u*)(pp + PLD);
        }
        gwr = *(const v2u*)(WA + (size_t)row * 1024 + d * 256 + chh); gar = *(const v2u*)(WA + (size_t)row * 1024 + (2 + d) * 256 + chh);
    };
    auto sfinish = [&](int bufi) {
        f32x4 sh[3];
#pragma unroll
        for (int q = 0; q < 3; ++q) {
            const f32x4 x = (f32x4){bflo(gxc[q].x), bfhi(gxc[q].x), bflo(gxc[q].y), bfhi(gxc[q].y)}, pv = (f32x4){bflo(gxp[q].x), bfhi(gxp[q].x), bflo(gxp[q].y), bfhi(gxp[q].y)}, nx = (f32x4){bflo(gxn[q].x), bfhi(gxn[q].x), bflo(gxn[q].y), bfhi(gxn[q].y)};
            sh[q] = x + mu0[q] * (pv - x) + mu1[q] * (nx - x);
        }
        const f32x4 w = (f32x4){bflo(gwr.x), bfhi(gwr.x), bflo(gwr.y), bfhi(gwr.y)}, a = (f32x4){bflo(gar.x), bfhi(gar.x), bflo(gar.y), bfhi(gar.y)};
        f32x4 kk = sh[1] * kk_w;
        const float ss = row16_sum((kk.x * kk.x + kk.y * kk.y) + (kk.z * kk.z + kk.w * kk.w));
        kk = kk * (1.0f / sqrtf(ss + 1e-6f));
        const f32x4 km = sh[1] * ((a - 1.0f) * ka_w + 1.0f), beta = kk * a;
        LAS float* o = BUF + ((bufi * 32 + st) * 6) * 64 + q4 * 4;
        *(LAS f32x4*)(o + 0 * 64) = sh[0]; *(LAS f32x4*)(o + 1 * 64) = kk; *(LAS f32x4*)(o + 2 * 64) = w; *(LAS f32x4*)(o + 3 * 64) = beta; *(LAS f32x4*)(o + 4 * 64) = km; *(LAS f32x4*)(o + 5 * 64) = sh[2];
    };
    const int rr = C.tid >> 4, jq = C.tid & 15;
    f32x4 s = (f32x4){0.f, 0.f, 0.f, 0.f};
    constexpr int NBLK = NSTEP / 32;
    gload(0); sfinish(0); gload(1);
    __syncthreads();
    for (int nb = 0; nb < NBLK; ++nb) {
        if (nb + 1 < NBLK) { sfinish((nb + 1) & 1); if (nb + 2 < NBLK) gload(nb + 2); }
        const LAS float* bb = BUF + ((nb & 1) * 32) * 6 * 64;
        LAS float* yb = YB + (nb & 1) * 1024;
        const LAS float* o0 = bb + jq * 4; const LAS float* v0 = bb + 5 * 64 + half * 32 + rr;
        f32x4 r4 = *(const LAS f32x4*)(o0), kk = *(const LAS f32x4*)(o0 + 64), wv = *(const LAS f32x4*)(o0 + 128), be = *(const LAS f32x4*)(o0 + 192), km = *(const LAS f32x4*)(o0 + 256);
        float vv = v0[0];
#pragma unroll
        for (int hb = 0; hb < 2; ++hb) {
            float ysel = 0.f;
#pragma unroll
            for (int t16 = 0; t16 < 16; ++t16) {
                const int t = hb * 16 + t16;
                const f32x4 cr = r4, ck = kk, cw = wv, cb = be, cm_ = km; const float cv = vv;
                if (t + 1 < 32) { const LAS float* o = o0 + (t + 1) * 6 * 64;
                    r4 = *(const LAS f32x4*)(o); kk = *(const LAS f32x4*)(o + 64); wv = *(const LAS f32x4*)(o + 128); be = *(const LAS f32x4*)(o + 192); km = *(const LAS f32x4*)(o + 256); vv = v0[(t + 1) * 6 * 64]; }
                const float sk = row16_sum((s.x * ck.x + s.y * ck.y) + (s.z * ck.z + s.w * ck.w));
                s = s * cw - cb * sk + cm_ * cv;
                const float y = row16_sum((s.x * cr.x + s.y * cr.y) + (s.z * cr.z + s.w * cr.w));
                ysel = (jq == t16) ? y : ysel;
            }
            yb[(hb * 16 + jq) * 32 + rr] = ysel;
        }
        __syncthreads();
        {
            const int t = C.tid >> 4, r2 = (C.tid & 15) * 2;
            const int i = nb * 32 + t; const int row = seqrow_raster(i, d, b);
            *(unsigned*)(outb + (size_t)row * 256 + h * 64 + half * 32 + r2) = pk2(yb[t * 32 + r2], yb[t * 32 + r2 + 1]);
        }
    }
    __syncthreads();
}

#define RAW_BARRIER() do { asm volatile("s_waitcnt lgkmcnt(0)" ::: "memory"); __builtin_amdgcn_s_barrier(); asm volatile("" ::: "memory"); } while (0)
__device__ __forceinline__ void mlstm_scan_v0(const Ctx& C, int l, int idx) {
    const int d = idx >> 5, b = (idx >> 2) & 7, h = idx & 3, lane = C.lane, w = C.wave;
    LAS float* PN = (LAS float*)C.lds;
    LAS float* PD = PN + 2 * 8 * 64;
    LAS unsigned char* SB = C.lds + 8192;
    constexpr int SBS = 3 * 4096 + 256;
    const bf16* P = WSP(const bf16, WS_P); bf16* outc = WSP(bf16, WS_OUTC) + (size_t)d * T_ALL * 256;
    const float ib = C.in[I_MIB][(l * 2 + d) * NH + h], fb = C.in[I_MFB][(l * 2 + d) * NH + h];
    const int st_ = C.tid >> 4, part = C.tid & 15;
    auto stage = [&](int nb, int bufi) {
        const int row = seqrow_cm(nb * 32 + st_, d, b);
        const size_t ro = (size_t)row * PLD + OFF_C + h * 64 + part * 4;
        LAS unsigned char* sb = SB + bufi * SBS;
        *(LAS v2u*)(sb + st_ * 128 + part * 8) = *(const v2u*)(P + ro);
        *(LAS v2u*)(sb + 4096 + st_ * 128 + part * 8) = *(const v2u*)(P + ro + 256);
        *(LAS v2u*)(sb + 8192 + st_ * 128 + part * 8) = *(const v2u*)(P + ro + 512);
        if (part == 0) { const size_t rg = (size_t)row * PLD + OFF_C + 1024;
            const float li = bf2f(P[rg + d * 4 + h]) + ib, gf = bf2f(P[rg + 8 + d * 4 + h]) + fb;
            *(LAS f32x2*)(sb + 12288 + st_ * 8) = (f32x2){li, -softplusf_(-gf)}; }
    };
    float Cm[8], nk[8];
#pragma unroll
    for (int k = 0; k < 8; ++k) { Cm[k] = 0.f; nk[k] = 0.f; }
    float m = 0.f;
    stage(0, 0);
    __syncthreads();
    for (int nb = 0; nb < NSTEP / 32; ++nb) {
        if (nb + 1 < NSTEP / 32) stage(nb + 1, (nb + 1) & 1);
        const LAS unsigned char* sb = SB + (nb & 1) * SBS;
#pragma unroll 2
        for (int t = 0; t < 32; ++t) {
            const int i = nb * 32 + t;
            const v4u cq = *(const LAS v4u*)(sb + t * 128 + w * 16), ck = *(const LAS v4u*)(sb + 4096 + t * 128 + w * 16);
            const float vv = bf2f(*(const LAS unsigned short*)(sb + 8192 + t * 128 + lane * 2));
            const f32x2 gt = *(const LAS f32x2*)(sb + 12288 + t * 8);
            const float li = gt.x, lf = gt.y;
            const float mn = fmaxf(lf + m, li), fp = __expf(lf + m - mn), ip = __expf(li - mn);
            const float qf[8] = {bflo(cq.x), bfhi(cq.x), bflo(cq.y), bfhi(cq.y), bflo(cq.z), bfhi(cq.z), bflo(cq.w), bfhi(cq.w)};
            const float kf[8] = {bflo(ck.x), bfhi(ck.x), bflo(ck.y), bfhi(ck.y), bflo(ck.z), bfhi(ck.z), bflo(ck.w), bfhi(ck.w)};
            const float ipv = ip * vv;
            float num = 0.f, den = 0.f;
#pragma unroll
            for (int k = 0; k < 8; ++k) { const float kk = kf[k] * 0.125f; Cm[k] = fp * Cm[k] + ipv * kk; nk[k] = fp * nk[k] + ip * kk; num += Cm[k] * qf[k]; den += nk[k] * qf[k]; }
            m = mn;
            const int pb_ = i & 1;
            PN[(pb_ * 8 + w) * 64 + lane] = num; if (lane == 0) PD[pb_ * 8 + w] = den;
            RAW_BARRIER();
            if (w == 0) {
                float ns = 0.f, ds = 0.f;
#pragma unroll
                for (int ww = 0; ww < 8; ++ww) { ns += PN[(pb_ * 8 + ww) * 64 + lane]; ds += PD[pb_ * 8 + ww]; }
                outc[(size_t)seqrow_cm(i, d, b) * 256 + h * 64 + lane] = (bf16)f2bf1(ns / fmaxf(fabsf(ds), __expf(-mn)));
            }
        }
        __syncthreads();
    }
}

__device__ __forceinline__ void gdn_prep(const Ctx& C, int l, int b, int c) {
    const bf16* P = WSP(const bf16, WS_P); bf16* gq = WSP(bf16, WS_GQ);
    const bool isctx = c < 4; const int p0 = isctx ? c * 64 : (c - 4) * 64; const int Lp = isctx ? CTXL : SEQ;
    const int lane = C.lane;
    auto rowof = [&](int p) -> int { return isctx ? (T_LAT + b * CTXL + p) : (b * SEQ + (p & 63) * 64 + (p >> 6)); };
    float cw[4][12], x[4][12];
#pragma unroll
    for (int j = 0; j < 4; ++j)
#pragma unroll
        for (int i = 0; i < 12; ++i) cw[j][i] = C.in[I_GCW][((size_t)l * 4 + j) * 768 + i * 64 + lane];
    const int tb = p0 + C.wave * 8;
    auto ldrow = [&](int p, float (&dst)[12]) {
        if (p >= 0 && p < Lp) { const size_t ro = (size_t)rowof(p) * PLD + OFF_D;
#pragma unroll
            for (int i = 0; i < 12; ++i) dst[i] = bf2f(P[ro + i * 64 + lane]); }
        else {
#pragma unroll
            for (int i = 0; i < 12; ++i) dst[i] = 0.f; }
    };
    ldrow(tb - 2, x[0]); ldrow(tb - 1, x[1]); ldrow(tb, x[2]);
#pragma unroll 1
    for (int t = 0; t < 8; ++t) {
        ldrow(tb + t + 1, x[3]);
        const size_t ro = (size_t)rowof(tb + t) * 768;
#pragma unroll
        for (int i = 0; i < 12; ++i) {
            float v = siluf_(cw[0][i] * x[0][i] + cw[1][i] * x[1][i] + cw[2][i] * x[2][i] + cw[3][i] * x[3][i]);
            if (i < 8) { const float ss = wave_sum(v * v); v *= (1.0f / sqrtf(ss + 1e-6f)) * (i < 4 ? 0.125f : 1.0f); }
            gq[ro + i * 64 + lane] = (bf16)f2bf1(v);
        }
#pragma unroll
        for (int i = 0; i < 12; ++i) { x[0][i] = x[1][i]; x[1][i] = x[2][i]; x[2][i] = x[3][i]; }
    }
}
__device__ __forceinline__ void gdn_scan_v0(const Ctx& C, int l, int idx) {
    const int d = idx >> 5, b = (idx >> 2) & 7, h = idx & 3, lane = C.lane, w = C.wave;
    LAS float* PA = (LAS float*)C.lds;
    LAS float* PB = PA + 2 * 8 * 64;
    LAS unsigned char* SB = C.lds + 8192;
    constexpr int SBS = 3 * 4096 + 256;
    const bf16* P = WSP(const bf16, WS_P); const bf16* gq = WSP(const bf16, WS_GQ); bf16* outd = WSP(bf16, WS_OUTD) + (size_t)d * T_ALL * 256;
    const float aexp = __expf(C.in[I_GALOG][(l * 2 + d) * NH + h]), dtb = C.in[I_GDTB][(l * 2 + d) * NH + h];
    const int st_ = C.tid >> 4, part = C.tid & 15;
    auto stage = [&](int nb, int bufi) {
        const int row = seqrow_cm(nb * 32 + st_, d, b);
        const size_t rq = (size_t)row * 768 + h * 64 + part * 4;
        LAS unsigned char* sb = SB + bufi * SBS;
        *(LAS v2u*)(sb + st_ * 128 + part * 8) = *(const v2u*)(gq + rq);
        *(LAS v2u*)(sb + 4096 + st_ * 128 + part * 8) = *(const v2u*)(gq + rq + 256);
        *(LAS v2u*)(sb + 8192 + st_ * 128 + part * 8) = *(const v2u*)(gq + rq + 512);
        if (part == 0) { const size_t ro = (size_t)row * PLD + OFF_D + 1024;
            const float ga = bf2f(P[ro + d * 4 + h]), gb = bf2f(P[ro + 8 + d * 4 + h]);
            *(LAS f32x2*)(sb + 12288 + st_ * 8) = (f32x2){__expf(-aexp * softplusf_(ga + dtb)), sigmoidf_(gb)}; }
    };
    float S[8];
#pragma unroll
    for (int k = 0; k < 8; ++k) S[k] = 0.f;
    stage(0, 0);
    __syncthreads();
    int prow = 0;
    for (int nb = 0; nb < NSTEP / 32; ++nb) {
        if (nb + 1 < NSTEP / 32) stage(nb + 1, (nb + 1) & 1);
        const LAS unsigned char* sb = SB + (nb & 1) * SBS;
#pragma unroll 2
        for (int t = 0; t < 32; ++t) {
            const int i = nb * 32 + t;
            const v4u cq = *(const LAS v4u*)(sb + t * 128 + w * 16), ck = *(const LAS v4u*)(sb + 4096 + t * 128 + w * 16);
            const float vv = bf2f(*(const LAS unsigned short*)(sb + 8192 + t * 128 + lane * 2));
            const f32x2 gt = *(const LAS f32x2*)(sb + 12288 + t * 8);
            const float alpha = gt.x, beta = gt.y;
            const float qf[8] = {bflo(cq.x), bfhi(cq.x), bflo(cq.y), bfhi(cq.y), bflo(cq.z), bfhi(cq.z), bflo(cq.w), bfhi(cq.w)};
            const float kf[8] = {bflo(ck.x), bfhi(ck.x), bflo(ck.y), bfhi(ck.y), bflo(ck.z), bfhi(ck.z), bflo(ck.w), bfhi(ck.w)};
            float ks = 0.f;
#pragma unroll
            for (int k = 0; k < 8; ++k) ks += kf[k] * S[k];
            const int pb_ = i & 1;
            PA[(pb_ * 8 + w) * 64 + lane] = ks;
            RAW_BARRIER();
            if (w == 0 && i > 0) {
                float os = 0.f;
#pragma unroll
                for (int ww = 0; ww < 8; ++ww) os += PB[((pb_ ^ 1) * 8 + ww) * 64 + lane];
                outd[(size_t)prow * 256 + h * 64 + lane] = (bf16)f2bf1(os);
            }
            float kS = 0.f;
#pragma unroll
            for (int ww = 0; ww < 8; ++ww) kS += PA[(pb_ * 8 + ww) * 64 + lane];
            const float coef = beta * (vv - alpha * kS);
            float o = 0.f;
#pragma unroll
            for (int k = 0; k < 8; ++k) { S[k] = alpha * S[k] + kf[k] * coef; o += qf[k] * S[k]; }
            PB[(pb_ * 8 + w) * 64 + lane] = o;
            prow = seqrow_cm(i, d, b);
        }
        __syncthreads();
    }
    if (w == 0) {
        float os = 0.f;
#pragma unroll
        for (int ww = 0; ww < 8; ++ww) os += PB[(((NSTEP - 1) & 1) * 8 + ww) * 64 + lane];
        outd[(size_t)prow * 256 + h * 64 + lane] = (bf16)f2bf1(os);
    }
    __syncthreads();
}

__device__ __forceinline__ f32x4 ld4bf(const bf16* p) { const v2u a = *(const v2u*)p; return (f32x4){bflo(a.x), bfhi(a.x), bflo(a.y), bfhi(a.y)}; }
__device__ __forceinline__ void st4bf(bf16* p, const f32x4& v) { v2u o; o.x = pk2(v.x, v.y); o.y = pk2(v.z, v.w); *(v2u*)p = o; }
__device__ __forceinline__ void finish_rows(const Ctx& C, int l, int nrows) {
    const bf16* P = WSP(const bf16, WS_P); bf16* yc = WSP(bf16, WS_HB);
    const bf16* ob = WSP(const bf16, WS_OUTB); const bf16* oc = WSP(const bf16, WS_OUTC); const bf16* od = WSP(const bf16, WS_OUTD);
    const bf16* gg = WSP(const bf16, WS_G); const float* bonus = WSP(const float, WS_BONUS);
    const float* mu = C.in[I_RMU] + (size_t)l * 2 * B_COLS;
    const int gw = C.wg * NWAVES + C.wave, NGW = C.G * NWAVES, lane = C.lane, ch = 4 * lane, hh = lane >> 4;
    const f32x4 lng = *(const f32x4*)(C.in[I_RLNG] + l * GW + ch), lnb = *(const f32x4*)(C.in[I_RLNB] + l * GW + ch);
    const f32x4 mng = *(const f32x4*)(C.in[I_MNG] + l * GW + ch), gng = *(const f32x4*)(C.in[I_GNG] + l * GW + ch);
    const f32x4 mu0 = *(const f32x4*)(mu + 512 + ch), mu1 = *(const f32x4*)(mu + B_COLS + 512 + ch);
    const size_t o2 = (size_t)T_ALL * 256;
#pragma unroll 2
    for (int m = gw; m < nrows; m += NGW) {
        const bool isctx = m >= T_LAT; const int Lp = isctx ? CTXL : SEQ; const int p = isctx ? ((m - T_LAT) & (CTXL - 1)) : (m & (SEQ - 1));
        const f32x4 yb = ld4bf(ob + (size_t)m * 256 + ch) + ld4bf(ob + o2 + (size_t)m * 256 + ch);
        const f32x4 ycv = ld4bf(oc + (size_t)m * 256 + ch) + ld4bf(oc + o2 + (size_t)m * 256 + ch);
        const f32x4 yd = ld4bf(od + (size_t)m * 256 + ch) + ld4bf(od + o2 + (size_t)m * 256 + ch);
        const bf16* pr = P + (size_t)m * PLD;
        const f32x4 vs = ld4bf(WSP(const bf16, WS_RKV) + (size_t)m * 768 + 512 + ch);
        const f32x4 og = ld4bf(pr + OFF_C + 768 + ch), gd = ld4bf(pr + OFF_D + 768 + ch), gr = ld4bf(gg + (size_t)m * 256 + ch);
        const float bn = bonus[(size_t)m * 4 + hh];
        {
            const float mean = row16_sum((yb.x + yb.y) + (yb.z + yb.w)) * (1.0f / 64.0f);
            const f32x4 dl = yb - mean;
            const float var = row16_sum((dl.x * dl.x + dl.y * dl.y) + (dl.z * dl.z + dl.w * dl.w)) * (1.0f / 64.0f);
            const f32x4 yn = dl * (1.0f / sqrtf(var + 64e-5f)) * lng + lnb;
            st4bf(yc + (size_t)m * 1024 + 256 + ch, (yn + vs * bn) * gr);
        }
        {
            const float ms = row16_sum((ycv.x * ycv.x + ycv.y * ycv.y) + (ycv.z * ycv.z + ycv.w * ycv.w)) * (1.0f / 64.0f);
            const f32x4 sg = (f32x4){sigmoidf_(og.x), sigmoidf_(og.y), sigmoidf_(og.z), sigmoidf_(og.w)};
            st4bf(yc + (size_t)m * 1024 + 512 + ch, ycv * (1.0f / sqrtf(ms + 1e-6f)) * mng * sg);
        }
        {
            const float ms = row16_sum((yd.x * yd.x + yd.y * yd.y) + (yd.z * yd.z + yd.w * yd.w)) * (1.0f / 64.0f);
            const f32x4 sg = (f32x4){siluf_(gd.x), siluf_(gd.y), siluf_(gd.z), siluf_(gd.w)};
            st4bf(yc + (size_t)m * 1024 + 768 + ch, yd * (1.0f / sqrtf(ms + 1e-6f)) * gng * sg);
        }
    }
}
typedef bf16x8 fragb;
__device__ __forceinline__ f32x4 mfma16(fragb a, fragb b, f32x4 c) { return __builtin_amdgcn_mfma_f32_16x16x32_bf16(a, b, c, 0, 0, 0); }
__device__ __forceinline__ fragb ld_frag16(const LAS bf16* p) { return *(const LAS fragb*)p; }
__device__ __forceinline__ fragb ld_frag8x2(const LAS bf16* p0, const LAS bf16* p1) {
    const v2u a = *(const LAS v2u*)p0, b = *(const LAS v2u*)p1; v4u r; r.x = a.x; r.y = a.y; r.z = b.x; r.w = b.y; return __builtin_bit_cast(fragb, r); }
__device__ __forceinline__ fragb pack_frag(const f32x4& lo, const f32x4& hi) { v4u r; r.x = pk2(lo.x, lo.y); r.y = pk2(lo.z, lo.w); r.z = pk2(hi.x, hi.y); r.w = pk2(hi.z, hi.w); return __builtin_bit_cast(fragb, r); }
template <int CTRL, int RM, bool BC> __device__ __forceinline__ float dpp_x(float oldv, float v) { return __builtin_bit_cast(float, __builtin_amdgcn_update_dpp(__builtin_bit_cast(int, oldv), __builtin_bit_cast(int, v), CTRL, RM, 0xF, BC)); }
__device__ __forceinline__ float wave_incl_sum(float v, int lane) {
    v += dpp_x<0x111, 0xF, true>(0.f, v); v += dpp_x<0x112, 0xF, true>(0.f, v); v += dpp_x<0x114, 0xF, true>(0.f, v); v += dpp_x<0x118, 0xF, true>(0.f, v);
    v += dpp_x<0x142, 0xA, false>(0.f, v); v += dpp_x<0x143, 0xC, false>(0.f, v);
    return v;
}
__device__ __forceinline__ float wave_incl_max(float v, int lane) {
    const float ninf = -3.0e38f;
    v = fmaxf(v, dpp_x<0x111, 0xF, false>(ninf, v)); v = fmaxf(v, dpp_x<0x112, 0xF, false>(ninf, v)); v = fmaxf(v, dpp_x<0x114, 0xF, false>(ninf, v)); v = fmaxf(v, dpp_x<0x118, 0xF, false>(ninf, v));
    v = fmaxf(v, dpp_x<0x142, 0xA, false>(ninf, v)); v = fmaxf(v, dpp_x<0x143, 0xC, false>(ninf, v));
    return v;
}
constexpr int MP = 72;
__device__ __forceinline__ void mlstm_chunked(const Ctx& C, int l, int idx) {
    const int d = idx >> 5, b = (idx >> 2) & 7, h = idx & 3, lane = C.lane, w = C.wave, l15 = lane & 15, q = lane >> 4;
    const int it = w & 3, vtp = w >> 2;
    constexpr int IMG = 64 * MP * 2, BUFB = 4 * IMG + 1024, CTB = 65 * MP * 2 + 16;
    LAS unsigned char* L0 = C.lds;
    const bf16* P = WSP(const bf16, WS_P); bf16* outc = WSP(bf16, WS_OUTC) + (size_t)d * T_ALL * 256;
    const float ib = C.in[I_MIB][(l * 2 + d) * NH + h], fb = C.in[I_MFB][(l * 2 + d) * NH + h];
    const int tt = C.tid >> 3, part = C.tid & 7;
    for (int i = C.tid; i < 2 * CTB / 4; i += NTHR) ((LAS unsigned*)(L0 + 2 * BUFB))[i] = 0u;
    v4u rq, rk, rv; unsigned short rgi, rgf;
    auto gload = [&](int n) {
        const int row = seqrow_cm(n * 64 + tt, d, b);
        const bf16* pp = P + (size_t)row * PLD + OFF_C + h * 64 + 8 * part;
        rq = *(const v4u*)pp; rk = *(const v4u*)(pp + 256); rv = *(const v4u*)(pp + 512);
        const bf16* pg = P + (size_t)seqrow_cm(n * 64 + lane, d, b) * PLD + OFF_C + 1024 + d * 4 + h;
        rgi = pg[0]; rgf = pg[8];
    };
    auto images = [&](int bufi) {
        LAS unsigned char* B0 = L0 + bufi * BUFB;
        LAS bf16* Qs = (LAS bf16*)B0; LAS bf16* Ks = Qs + 64 * MP; LAS bf16* VT = Ks + 64 * MP; LAS bf16* KTw = VT + 64 * MP; LAS float* vec = (LAS float*)(B0 + 4 * IMG);
        const float li = bf2f(rgi) + ib, lf = -softplusf_(-(bf2f(rgf) + fb));
        const float bc = wave_incl_sum(lf, lane), x = li - bc, cm = wave_incl_max(x, lane);
        const float wl = __expf(x - __shfl(cm, 63)) * 0.125f;
        if (w == 0) { vec[lane] = x; vec[64 + lane] = cm; vec[128 + lane] = bc; }
        const float wmine = __shfl(wl, 8 * w + (lane >> 3));
        *(LAS v4u*)(Qs + tt * MP + 8 * part) = rq; *(LAS v4u*)(Ks + tt * MP + 8 * part) = rk;
        const unsigned vv[4] = {rv.x, rv.y, rv.z, rv.w}, kk[4] = {rk.x, rk.y, rk.z, rk.w};
#pragma unroll
        for (int e = 0; e < 4; ++e) {
            VT[(8 * part + 2 * e) * MP + tt] = (bf16)(vv[e] & 0xffffu); VT[(8 * part + 2 * e + 1) * MP + tt] = (bf16)(vv[e] >> 16);
            KTw[(8 * part + 2 * e) * MP + tt] = (bf16)f2bf1(bflo(kk[e]) * wmine); KTw[(8 * part + 2 * e + 1) * MP + tt] = (bf16)f2bf1(bfhi(kk[e]) * wmine);
        }
    };
    f32x4 Cst[2], nst; float m = 0.f;
    Cst[0] = Cst[1] = nst = (f32x4){0.f, 0.f, 0.f, 0.f};
    const fragb ones = __builtin_bit_cast(fragb, (v4u){0x3F803F80u, 0x3F803F80u, 0x3F803F80u, 0x3F803F80u});
    const f32x4 z4 = (f32x4){0.f, 0.f, 0.f, 0.f};
    gload(0); images(0); gload(1);
#pragma unroll 1
    for (int n = 0; n < NCH; ++n) {
        RAW_BARRIER();
        const LAS unsigned char* B0 = L0 + (n & 1) * BUFB;
        const LAS bf16* Qs = (const LAS bf16*)B0; const LAS bf16* Ks = Qs + 64 * MP; const LAS bf16* VT = Ks + 64 * MP; const LAS bf16* KTw = VT + 64 * MP; const LAS float* vec = (const LAS float*)(B0 + 4 * IMG);
        const LAS bf16* CT = (const LAS bf16*)(L0 + 2 * BUFB + (n & 1) * CTB); LAS bf16* CTn = (LAS bf16*)(L0 + 2 * BUFB + ((n + 1) & 1) * CTB);
        fragb Qf[2]; Qf[0] = ld_frag16(Qs + (16 * it + l15) * MP + 8 * q); Qf[1] = ld_frag16(Qs + (16 * it + l15) * MP + 32 + 8 * q);
        const float cmi = vec[64 + 16 * it + l15]; const int icol = 16 * it + l15;
        f32x4 pt[4];
#pragma unroll
        for (int jt = 0; jt < 4; ++jt) {
            pt[jt] = z4;
            if (jt <= it) {
                const fragb k0 = ld_frag16(Ks + (16 * jt + l15) * MP + 8 * q), k1 = ld_frag16(Ks + (16 * jt + l15) * MP + 32 + 8 * q);
                f32x4 st = mfma16(k0, Qf[0], z4); st = mfma16(k1, Qf[1], st);
                const f32x4 xj = *(const LAS f32x4*)(vec + 16 * jt + 4 * q);
#pragma unroll
                for (int r = 0; r < 4; ++r) { const int j = 16 * jt + 4 * q + r; pt[jt][r] = (j <= icol) ? st[r] * __expf(xj[r] - cmi) * 0.125f : 0.f; }
            }
        }
        fragb Pf[2]; Pf[0] = pack_frag(pt[0], pt[1]); Pf[1] = pack_frag(pt[2], pt[3]);
        fragb Vf[2][2];
#pragma unroll
        for (int v2 = 0; v2 < 2; ++v2)
#pragma unroll
            for (int s = 0; s < 2; ++s) { const LAS bf16* vr = VT + (16 * (2 * vtp + v2) + l15) * MP + 32 * s + 4 * q; Vf[v2][s] = ld_frag8x2(vr, vr + 16); }
        f32x4 Aacc[2], R[2], as, dn;
        as = mfma16(Pf[0], ones, z4); if (it >= 2) as = mfma16(Pf[1], ones, as);
        const fragb nf0 = ld_frag16(CT + 64 * MP + 8 * q), nf1 = ld_frag16(CT + 64 * MP + 32 + 8 * q);
        dn = mfma16(Qf[0], nf0, z4); dn = mfma16(Qf[1], nf1, dn);
#pragma unroll
        for (int v2 = 0; v2 < 2; ++v2) {
            Aacc[v2] = mfma16(Pf[0], Vf[v2][0], z4); if (it >= 2) Aacc[v2] = mfma16(Pf[1], Vf[v2][1], Aacc[v2]);
            const LAS bf16* cr = CT + (16 * (2 * vtp + v2) + l15) * MP + 8 * q;
            R[v2] = mfma16(Qf[0], ld_frag16(cr), z4); R[v2] = mfma16(Qf[1], ld_frag16(cr + 32), R[v2]);
        }
        {
            const f32x4 bi = *(const LAS f32x4*)(vec + 128 + 16 * it + 4 * q), cmr = *(const LAS f32x4*)(vec + 64 + 16 * it + 4 * q);
#pragma unroll
            for (int r = 0; r < 4; ++r) {
                const float mi = bi[r] + cmr[r], minter = bi[r] + m, mt = fmaxf(minter, mi), e1 = __expf(mi - mt), e2 = __expf(minter - mt);
                const float den = e1 * as[r] + e2 * dn[r]; const float inv = 1.0f / fmaxf(fabsf(den), __expf(-mt));
                const int row = seqrow_cm(n * 64 + 16 * it + 4 * q + r, d, b);
#pragma unroll
                for (int v2 = 0; v2 < 2; ++v2) outc[(size_t)row * 256 + h * 64 + 16 * (2 * vtp + v2) + l15] = (bf16)f2bf1((e1 * Aacc[v2][r] + e2 * R[v2][r]) * inv);
            }
        }
        {
            const LAS bf16* kr = KTw + (16 * it + l15) * MP + 4 * q;
            const fragb kt0 = ld_frag8x2(kr, kr + 16), kt1 = ld_frag8x2(kr + 32, kr + 48);
            const float bL = vec[128 + 63], mloc = bL + vec[64 + 63];
            const float mnew = fmaxf(bL + m, mloc), wp = __expf(bL + m - mnew), wn = __expf(mloc - mnew);
            f32x4 gk = mfma16(kt0, ones, z4); gk = mfma16(kt1, ones, gk);
            nst = nst * wp + gk * wn;
#pragma unroll
            for (int v2 = 0; v2 < 2; ++v2) {
                f32x4 G = mfma16(kt0, Vf[v2][0], z4); G = mfma16(kt1, Vf[v2][1], G);
                Cst[v2] = Cst[v2] * wp + G * wn;
                v2u o; o.x = pk2(Cst[v2].x, Cst[v2].y); o.y = pk2(Cst[v2].z, Cst[v2].w);
                *(LAS v2u*)(CTn + (16 * (2 * vtp + v2) + l15) * MP + 16 * it + 4 * q) = o;
            }
            if (vtp == 0 && l15 == 0) { v2u o; o.x = pk2(nst.x, nst.y); o.y = pk2(nst.z, nst.w); *(LAS v2u*)(CTn + 64 * MP + 16 * it + 4 * q) = o; }
            m = mnew;
        }
        if (n + 1 < NCH) { images((n + 1) & 1); if (n + 2 < NCH) gload(n + 2); }
    }
    __syncthreads();
}
__device__ __forceinline__ int fwd_row_cm(int b, int c, int t) { return c < 4 ? (T_LAT + b * CTXL + c * 64 + t) : (b * SEQ + t * 64 + (c - 4)); }
__device__ __forceinline__ bf16* blob_row(const Ctx& C, int d, int isw, int b, int c, int h, int r) {
    const int row = fwd_row_cm(b, c, r);
    if (d == 1 && isw) return WSP(bf16, WS_OUTD) + ((size_t)T_ALL + row) * 256 + h * 64;
    return WSP(bf16, WS_P) + (size_t)row * PLD + OFF_D + (d * 2 + isw) * 256 + h * 64;
}
constexpr int LP = 68;
__device__ __forceinline__ void gdn_solve_units(const Ctx& C, int l) {
    const int lane = C.lane, w = C.wave, pw = w & 1, pi = w >> 1, l15 = lane & 15, q = lane >> 4;
    LAS unsigned char* B0 = C.lds + pi * 28672;
    LAS float* Lm = (LAS float*)B0;
    LAS bf16* Ks = (LAS bf16*)(B0 + 17408);
    LAS float* vec = (LAS float*)(B0 + 17408 + 9216);
    const bf16* P = WSP(const bf16, WS_P); const bf16* gq = WSP(const bf16, WS_GQ);
    const int NU = NB * NH * NCH, per = C.G * 4;
    const int trips = (NU + per - 1) / per;
#pragma unroll 1
    for (int k = 0; k < trips; ++k) {
        int u = k * per + C.wg * 4 + pi; const bool active = u < NU; if (!active) u = NU - 1;
        const int c = u % NCH, h = (u / NCH) & 3, b = u / (NCH * NH);
#pragma unroll 1
        for (int d = 0; d < 2; ++d) {
            const int n = d ? (c < 4 ? 3 - c : 71 - c) : c;
            const float aexp = __expf(C.in[I_GALOG][(l * 2 + d) * NH + h]), dtb = C.in[I_GDTB][(l * 2 + d) * NH + h];
            const int rowl = seqrow_cm(n * 64 + lane, d, b);
            const bf16* pg = P + (size_t)rowl * PLD + OFF_D + 1024 + d * 4 + h;
            const float la = -aexp * softplusf_(bf2f(pg[0]) + dtb), beta = sigmoidf_(bf2f(pg[8]));
            const float gam = wave_incl_sum(la, lane);
            if (pw == 0) { vec[lane] = beta; vec[64 + lane] = gam; }
#pragma unroll
            for (int r = 0; r < 4; ++r) { const int idx = pw * 64 + lane + 128 * r, t = idx >> 3, part = idx & 7;
                *(LAS v4u*)(Ks + t * MP + 8 * part) = *(const v4u*)(gq + (size_t)seqrow_cm(n * 64 + t, d, b) * 768 + 256 + h * 64 + 8 * part); }
            float x[64];
#pragma unroll
            for (int i = 0; i < 64; ++i) x[i] = bf2f(gq[(size_t)seqrow_cm(n * 64 + i, d, b) * 768 + (pw ? 256 : 512) + h * 64 + lane]);
            __syncthreads();
            {
                int tix = 0;
#pragma unroll
                for (int it = 0; it < 4; ++it)
#pragma unroll
                    for (int jt = 0; jt <= it; ++jt, ++tix) if ((tix & 1) == pw) {
                        f32x4 acc = (f32x4){0.f, 0.f, 0.f, 0.f};
#pragma unroll
                        for (int s = 0; s < 2; ++s) acc = mfma16(ld_frag16(Ks + (16 * it + l15) * MP + 32 * s + 8 * q), ld_frag16(Ks + (16 * jt + l15) * MP + 32 * s + 8 * q), acc);
                        const float gj = vec[64 + 16 * jt + l15];
                        const f32x4 bi = *(const LAS f32x4*)(vec + 16 * it + 4 * q), gi = *(const LAS f32x4*)(vec + 64 + 16 * it + 4 * q);
#pragma unroll
                        for (int r = 0; r < 4; ++r) { const int i = 16 * it + 4 * q + r, j = 16 * jt + l15;
                            Lm[i * LP + j] = (j < i) ? bi[r] * acc[r] * __expf(gi[r] - gj) : 0.f; }
                    }
            }
            __syncthreads();
#pragma unroll
            for (int i = 0; i < 64; ++i) {
                const float sc = pw ? vec[i] * __expf(vec[64 + i]) : vec[i];
                float a0 = x[i] * sc, a1 = 0.f;
                int roff = i * LP; if (i >= 2) asm volatile("" : "+v"(roff) : "v"(x[i - 2]));
                const LAS float* lrow = Lm + roff;
#pragma unroll
                for (int j4 = 0; j4 < i; j4 += 4) { const f32x4 lv = *(const LAS f32x4*)(lrow + j4);
                    a0 -= lv.x * x[j4]; if (j4 + 1 < i) a1 -= lv.y * x[j4 + 1]; if (j4 + 2 < i) a0 -= lv.z * x[j4 + 2]; if (j4 + 3 < i) a1 -= lv.w * x[j4 + 3]; }
                x[i] = a0 + a1;
            }
            if (active) { bf16* dst = blob_row(C, d, pw, b, c, h, lane);
#pragma unroll
                for (int g = 0; g < 8; ++g) { v4u o; o.x = pk2(x[8 * g], x[8 * g + 1]); o.y = pk2(x[8 * g + 2], x[8 * g + 3]); o.z = pk2(x[8 * g + 4], x[8 * g + 5]); o.w = pk2(x[8 * g + 6], x[8 * g + 7]);
                    *(v4u*)(dst + 8 * g) = o; } }
            __syncthreads();
        }
    }
}

template <bool DRY>
__device__ __forceinline__ void gdn_chunked(const Ctx& C, int l, int idx) {
    const int d = idx >> 5, b = (idx >> 2) & 7, h = idx & 3, lane = C.lane, w = C.wave, l15 = lane & 15, q = lane >> 4;
    const int it = w & 3, vtp = w >> 2;
    constexpr int IMG = 64 * MP * 2, BUFB = 5 * IMG + 512;
    LAS unsigned char* L0 = C.lds;
    LAS bf16* VnT = (LAS bf16*)(L0 + 2 * BUFB + 2 * IMG);
    const bf16* P = WSP(const bf16, WS_P); const bf16* gq = WSP(const bf16, WS_GQ); bf16* outd = WSP(bf16, WS_OUTD) + (size_t)d * T_ALL * 256;
    const float aexp = __expf(C.in[I_GALOG][(l * 2 + d) * NH + h]), dtb = C.in[I_GDTB][(l * 2 + d) * NH + h];
    const int tt = C.tid >> 3, part = C.tid & 7;
    for (int i = C.tid; i < 2 * IMG / 4; i += NTHR) ((LAS unsigned*)(L0 + 2 * BUFB))[i] = 0u;
    v4u rq, rk, ru, rw; unsigned short rga;
    auto gload = [&](int n) {
        const int c = d ? (n < 4 ? 3 - n : 71 - n) : n;
        const bf16* pp = gq + (size_t)seqrow_cm(n * 64 + tt, d, b) * 768 + h * 64 + 8 * part;
        rq = *(const v4u*)pp; rk = *(const v4u*)(pp + 256);
        ru = *(const v4u*)(blob_row(C, d, 0, b, c, h, tt) + 8 * part); rw = *(const v4u*)(blob_row(C, d, 1, b, c, h, tt) + 8 * part);
        rga = P[(size_t)seqrow_cm(n * 64 + lane, d, b) * PLD + OFF_D + 1024 + d * 4 + h];
    };
    auto images = [&](int bufi) {
        LAS unsigned char* B0 = L0 + bufi * BUFB;
        LAS bf16* Qs = (LAS bf16*)B0; LAS bf16* Ks = Qs + 64 * MP; LAS bf16* KdT = Ks + 64 * MP; LAS bf16* Wi = KdT + 64 * MP; LAS bf16* UT = Wi + 64 * MP; LAS float* vec = (LAS float*)(B0 + 5 * IMG);
        const float la = -aexp * softplusf_(bf2f(rga) + dtb);
        const float gam = wave_incl_sum(la, lane);
        if (w == 0) vec[lane] = gam;
        const float kd = __expf(__shfl(gam, 63) - gam);
        const float kmine = __shfl(kd, 8 * w + (lane >> 3));
        *(LAS v4u*)(Qs + tt * MP + 8 * part) = rq; *(LAS v4u*)(Ks + tt * MP + 8 * part) = rk; *(LAS v4u*)(UT + tt * MP + 8 * part) = ru;
        const unsigned kk[4] = {rk.x, rk.y, rk.z, rk.w}, ww[4] = {rw.x, rw.y, rw.z, rw.w};
#pragma unroll
        for (int e = 0; e < 4; ++e) {
            KdT[(8 * part + 2 * e) * MP + tt] = (bf16)f2bf1(bflo(kk[e]) * kmine); KdT[(8 * part + 2 * e + 1) * MP + tt] = (bf16)f2bf1(bfhi(kk[e]) * kmine);
            Wi[(8 * part + 2 * e) * MP + tt] = (bf16)(ww[e] & 0xffffu); Wi[(8 * part + 2 * e + 1) * MP + tt] = (bf16)(ww[e] >> 16);
        }
    };
    f32x4 Sst[2]; Sst[0] = Sst[1] = (f32x4){0.f, 0.f, 0.f, 0.f};
    const f32x4 z4 = (f32x4){0.f, 0.f, 0.f, 0.f};
    gload(0); images(0); gload(1);
#pragma unroll 1
    for (int n = 0; n < NCH; ++n) {
        RAW_BARRIER();
        const LAS unsigned char* B0 = L0 + (n & 1) * BUFB;
        const LAS bf16* Qs = (const LAS bf16*)B0; const LAS bf16* Ks = Qs + 64 * MP; const LAS bf16* KdT = Ks + 64 * MP; const LAS bf16* Wi = KdT + 64 * MP; const LAS bf16* UT = Wi + 64 * MP; const LAS float* vec = (const LAS float*)(B0 + 5 * IMG);
        const LAS bf16* ST = (const LAS bf16*)(L0 + 2 * BUFB + (n & 1) * IMG); LAS bf16* STn = (LAS bf16*)(L0 + 2 * BUFB + ((n + 1) & 1) * IMG);
        fragb Qf[2]; Qf[0] = ld_frag16(Qs + (16 * it + l15) * MP + 8 * q); Qf[1] = ld_frag16(Qs + (16 * it + l15) * MP + 32 + 8 * q);
        const float gcol = vec[16 * it + l15]; const int icol = 16 * it + l15;
        f32x4 pt[4];
#pragma unroll
        for (int jt = 0; jt < 4; ++jt) {
            pt[jt] = z4;
            if (jt <= it) {
                const fragb k0 = ld_frag16(Ks + (16 * jt + l15) * MP + 8 * q), k1 = ld_frag16(Ks + (16 * jt + l15) * MP + 32 + 8 * q);
                f32x4 st = mfma16(k0, Qf[0], z4); st = mfma16(k1, Qf[1], st);
                const f32x4 gj = *(const LAS f32x4*)(vec + 16 * jt + 4 * q);
#pragma unroll
                for (int r = 0; r < 4; ++r) { const int j = 16 * jt + 4 * q + r; pt[jt][r] = (j <= icol) ? st[r] * __expf(gcol - gj[r]) : 0.f; }
            }
        }
        fragb Pf[2]; Pf[0] = pack_frag(pt[0], pt[1]); Pf[1] = pack_frag(pt[2], pt[3]);
        const fragb Wf0 = ld_frag16(Wi + (16 * it + l15) * MP + 8 * q), Wf1 = ld_frag16(Wi + (16 * it + l15) * MP + 32 + 8 * q);
        f32x4 Ro[2];
#pragma unroll
        for (int v2 = 0; v2 < 2; ++v2) {
            const int vrow = 16 * (2 * vtp + v2) + l15;
            const fragb s0 = ld_frag16(ST + vrow * MP + 8 * q), s1 = ld_frag16(ST + vrow * MP + 32 + 8 * q);
            f32x4 ws = mfma16(Wf0, s0, z4); ws = mfma16(Wf1, s1, ws);
            Ro[v2] = mfma16(Qf[0], s0, z4); Ro[v2] = mfma16(Qf[1], s1, Ro[v2]);
            const v2u ur = *(const LAS v2u*)(UT + vrow * MP + 16 * it + 4 * q);
            v2u o; o.x = pk2(bflo(ur.x) - ws.x, bfhi(ur.x) - ws.y); o.y = pk2(bflo(ur.y) - ws.z, bfhi(ur.y) - ws.w);
            *(LAS v2u*)(VnT + vrow * MP + 16 * it + 4 * q) = o;
        }
        RAW_BARRIER();
        {
            const f32x4 gi = *(const LAS f32x4*)(vec + 16 * it + 4 * q);
            const float gl = __expf(vec[63]);
            const LAS bf16* kr = KdT + (16 * it + l15) * MP + 4 * q;
            const fragb kt0 = ld_frag8x2(kr, kr + 16), kt1 = ld_frag8x2(kr + 32, kr + 48);
#pragma unroll
            for (int v2 = 0; v2 < 2; ++v2) {
                const int vrow = 16 * (2 * vtp + v2) + l15;
                const LAS bf16* vr = VnT + vrow * MP + 4 * q;
                const fragb n0 = ld_frag8x2(vr, vr + 16), n1 = ld_frag8x2(vr + 32, vr + 48);
                f32x4 o = mfma16(Pf[0], n0, z4); if (it >= 2) o = mfma16(Pf[1], n1, o);
#pragma unroll
                for (int r = 0; r < 4; ++r) { const int row = seqrow_cm(n * 64 + 16 * it + 4 * q + r, d, b);
                    if (!DRY) outd[(size_t)row * 256 + h * 64 + vrow] = (bf16)f2bf1(o[r] + __expf(gi[r]) * Ro[v2][r]); }
                f32x4 ns = mfma16(kt0, n0, z4); ns = mfma16(kt1, n1, ns);
                Sst[v2] = Sst[v2] * gl + ns;
                v2u so; so.x = pk2(Sst[v2].x, Sst[v2].y); so.y = pk2(Sst[v2].z, Sst[v2].w);
                *(LAS v2u*)(STn + vrow * MP + 16 * it + 4 * q) = so;
            }
        }
        if (n + 1 < NCH) { images((n + 1) & 1); if (n + 2 < NCH) gload(n + 2); }
    }
    __syncthreads();
}
constexpr int UP = 264;
template <int CTRL> __device__ __forceinline__ float dpp_keep(float oldv, float v) { return __builtin_bit_cast(float, __builtin_amdgcn_update_dpp(__builtin_bit_cast(int, oldv), __builtin_bit_cast(int, v), CTRL, 0xF, 0xF, false)); }
template <bool REV> __device__ __forceinline__ void scan16(float& A, float& B) {
#define LRU_STEP(S) { const float Ap = dpp_keep<(REV ? 0x100 : 0x110) | S>(1.0f, A), Bp = dpp_keep<(REV ? 0x100 : 0x110) | S>(0.0f, B); B = A * Bp + B; A = A * Ap; }
    LRU_STEP(1) LRU_STEP(2) LRU_STEP(4) LRU_STEP(8)
#undef LRU_STEP
}
template <bool FIN, bool REV>
__device__ __forceinline__ void lru_wave(const Ctx& C, int l, int b, int c, int hd, LAS bf16* U16, LAS bf16* H16) {
    constexpr int d = REV ? 1 : 0;
    const int lane = C.lane, l15 = lane & 15, q = lane >> 4;
    const bf16* wt = WSP(const bf16, WS_LRUWT) + (size_t)((d * 2 + 0) * 4 + hd) * 4096;
    fragb Wa[4][2], Wx[4][2];
#pragma unroll
    for (int mt = 0; mt < 4; ++mt)
#pragma unroll
        for (int ks = 0; ks < 2; ++ks) { Wa[mt][ks] = *(const fragb*)(wt + (16 * mt + l15) * 64 + 32 * ks + 8 * q); Wx[mt][ks] = *(const fragb*)(wt + 4 * 4096 + (16 * mt + l15) * 64 + 32 * ks + 8 * q); }
    f32x4 sp4[4], hc[4], sla[4];
    const size_t sbase = ((size_t)(b * NCH + c) * 2 + d) * 256 + hd * 64;
#pragma unroll
    for (int mt = 0; mt < 4; ++mt) {
        const int ch = hd * 64 + 16 * mt + 4 * q;
        const f32x4 lam = *(const f32x4*)(C.in[I_LLAM] + (l * 2 + d) * GW + ch);
#pragma unroll
        for (int r = 0; r < 4; ++r) sp4[mt][r] = 8.0f * softplusf_(-lam[r]);
        hc[mt] = FIN ? *(const f32x4*)(WSP(const float, WS_HIN) + sbase + 16 * mt + 4 * q) : (f32x4){0.f, 0.f, 0.f, 0.f};
        sla[mt] = (f32x4){0.f, 0.f, 0.f, 0.f};
    }
    const f32x4 z4 = (f32x4){0.f, 0.f, 0.f, 0.f};
#pragma unroll 1
    for (int nti = 0; nti < 4; ++nti) {
        const int nt = REV ? 3 - nti : nti;
        const LAS bf16* urow = U16 + (16 * nt + l15) * UP + hd * 64;
        const fragb Uf0 = ld_frag16(urow + 8 * q), Uf1 = ld_frag16(urow + 32 + 8 * q);
#pragma unroll
        for (int mt = 0; mt < 4; ++mt) {
            f32x4 aa = mfma16(Wa[mt][0], Uf0, z4); aa = mfma16(Wa[mt][1], Uf1, aa);
            f32x4 ax = mfma16(Wx[mt][0], Uf0, z4); ax = mfma16(Wx[mt][1], Uf1, ax);
            const v2u ur = *(const LAS v2u*)(urow + 16 * mt + 4 * q);
            const float u4[4] = {bflo(ur.x), bfhi(ur.x), bflo(ur.y), bfhi(ur.y)};
            const f32x4 ba = *(const f32x4*)(C.in[I_LBA] + (l * 2 + d) * GW + hd * 64 + 16 * mt + 4 * q), bx = *(const f32x4*)(C.in[I_LBX] + (l * 2 + d) * GW + hd * 64 + 16 * mt + 4 * q);
            f32x4 hv;
#pragma unroll
            for (int r = 0; r < 4; ++r) {
                const float rg = sigmoidf_(aa[r] + ba[r]), ig = sigmoidf_(ax[r] + bx[r]);
                const float la = -sp4[mt][r] * rg; float A = __expf(la); float Bv = sqrtf(-expm1f_(2.0f * la)) * (ig * u4[r]);
                sla[mt][r] += la;
                scan16<REV>(A, Bv);
                const float h = A * hc[mt][r] + Bv;
                hv[r] = h;
                hc[mt][r] = __shfl(h, (lane & 48) | (REV ? 0 : 15));
            }
            if (FIN) { v2u o; o.x = pk2(hv.x, hv.y); o.y = pk2(hv.z, hv.w); *(LAS v2u*)(H16 + (size_t)d * 64 * UP + (16 * nt + l15) * UP + hd * 64 + 16 * mt + 4 * q) = o; }
        }
    }
    if (!FIN) {
        float* ls = WSP(float, WS_LSUM);
#pragma unroll
        for (int mt = 0; mt < 4; ++mt)
#pragma unroll
            for (int r = 0; r < 4; ++r) { const float st = row16_sum(sla[mt][r]); if (l15 == 0) { const size_t si = sbase + 16 * mt + 4 * q + r; ls[si * 2] = st; ls[si * 2 + 1] = hc[mt][r]; } }
    }
}
template <bool FIN>
__device__ __forceinline__ void lru_chunk_mfma(const Ctx& C, int l, int b, int c) {
    LAS bf16* U16 = (LAS bf16*)C.lds;
    LAS bf16* H16 = U16 + 64 * UP;
    const bf16* P = WSP(const bf16, WS_P);
    const bool isctx = c < 4; const int p0 = isctx ? c * 64 : (c - 4) * 64; const int Lp = isctx ? CTXL : SEQ; const int row0 = isctx ? T_LAT + b * CTXL : b * SEQ;
    {
        const int ch = C.tid & 255, half = C.tid >> 8;
        const float* cw = C.in[I_LCW] + (size_t)l * 4 * GW + ch; const float w0 = cw[0], w1 = cw[GW], w2 = cw[2 * GW], w3 = cw[3 * GW], cb = C.in[I_LCB][l * GW + ch];
        const int t0 = half * 32;
        float xs[35];
#pragma unroll
        for (int k = 0; k < 35; ++k) { const int p = p0 + t0 + k - 2; xs[k] = (p >= 0 && p < Lp) ? bf2f(P[(size_t)(row0 + p) * PLD + ch]) : 0.f; }
#pragma unroll
        for (int t = 0; t < 32; ++t) U16[(t0 + t) * UP + ch] = (bf16)f2bf1(w0 * xs[t] + w1 * xs[t + 1] + w2 * xs[t + 2] + w3 * xs[t + 3] + cb);
    }
    __syncthreads();
    if (C.wave < 4) lru_wave<FIN, false>(C, l, b, c, C.wave & 3, U16, H16); else lru_wave<FIN, true>(C, l, b, c, C.wave & 3, U16, H16);
    __syncthreads();
    if (FIN) {
        bf16* yc = WSP(bf16, WS_HB);
        const LAS bf16* H1 = H16 + 64 * UP;
#pragma unroll 2
        for (int it = C.tid; it < 64 * 64; it += NTHR) {
            const int t = it >> 6, c4 = (it & 63) * 4;
            const size_t row = (size_t)(row0 + p0 + t);
            const v2u a = *(const LAS v2u*)(H16 + t * UP + c4), bq = *(const LAS v2u*)(H1 + t * UP + c4);
            const f32x4 g = ld4bf(P + row * PLD + 256 + c4);
            f32x4 y = (f32x4){bflo(a.x) + bflo(bq.x), bfhi(a.x) + bfhi(bq.x), bflo(a.y) + bflo(bq.y), bfhi(a.y) + bfhi(bq.y)};
            y.x *= gelu_tanh(g.x); y.y *= gelu_tanh(g.y); y.z *= gelu_tanh(g.z); y.w *= gelu_tanh(g.w);
            st4bf(yc + row * 1024 + c4, y);
        }
        __syncthreads();
    }
}
constexpr int RP = 264;
__device__ __forceinline__ void rwkv_prep2(const Ctx& C, int l, int b, int c) {
    LAS bf16* RS = (LAS bf16*)C.lds;
    LAS bf16* KS = RS + 64 * RP;
    LAS bf16* XW = KS + 64 * RP;
    LAS bf16* XA = XW + 64 * MP;
    LAS bf16* XG = XA + 64 * MP;
    const bf16* P = WSP(const bf16, WS_P);
    const bool isctx = c < 4; const int p0 = isctx ? c * 64 : (c - 4) * 64; const int Lp = isctx ? CTXL : SEQ; const int row0 = isctx ? T_LAT + b * CTXL : b * SEQ;
    const float* mu = C.in[I_RMU] + (size_t)l * 2 * B_COLS;
    bf16* rkv = WSP(bf16, WS_RKV);
#pragma unroll 2
    for (int it = C.tid; it < 64 * 120; it += NTHR) {
        const int t = it / 120, c8 = (it % 120) * 8, p = p0 + t;
        const bf16* pp = P + (size_t)(row0 + p) * PLD + OFF_B + c8;
        const v4u xc = *(const v4u*)pp; v4u xp = (v4u){0u, 0u, 0u, 0u}, xn = xp;
        if (p > 0) xp = *(const v4u*)(pp - PLD);
        if (p < Lp - 1) xn = *(const v4u*)(pp + PLD);
        const f32x4 m0a = *(const f32x4*)(mu + c8), m0b = *(const f32x4*)(mu + c8 + 4), m1a = *(const f32x4*)(mu + B_COLS + c8), m1b = *(const f32x4*)(mu + B_COLS + c8 + 4);
        const unsigned xcw[4] = {xc.x, xc.y, xc.z, xc.w}, xpw[4] = {xp.x, xp.y, xp.z, xp.w}, xnw[4] = {xn.x, xn.y, xn.z, xn.w};
        float sh[8];
#pragma unroll
        for (int e = 0; e < 4; ++e) {
            const float x0 = bflo(xcw[e]), x1 = bfhi(xcw[e]);
            const float mu0_0 = e < 2 ? m0a[2 * e] : m0b[2 * e - 4], mu0_1 = e < 2 ? m0a[2 * e + 1] : m0b[2 * e - 3], mu1_0 = e < 2 ? m1a[2 * e] : m1b[2 * e - 4], mu1_1 = e < 2 ? m1a[2 * e + 1] : m1b[2 * e - 3];
            sh[2 * e] = x0 + mu0_0 * (bflo(xpw[e]) - x0) + mu1_0 * (bflo(xnw[e]) - x0);
            sh[2 * e + 1] = x1 + mu0_1 * (bfhi(xpw[e]) - x1) + mu1_1 * (bfhi(xnw[e]) - x1);
        }
        if (c8 >= 768) {
            const int ci = c8 - 768;
            if (ci < 64) {
#pragma unroll
                for (int e = 0; e < 8; ++e) sh[e] = tanhf_(sh[e]); }
            else if (ci >= 128) {
#pragma unroll
                for (int e = 0; e < 8; ++e) sh[e] = sigmoidf_(sh[e]); }
        }
        v4u o; o.x = pk2(sh[0], sh[1]); o.y = pk2(sh[2], sh[3]); o.z = pk2(sh[4], sh[5]); o.w = pk2(sh[6], sh[7]);
        if (c8 < 768) {
            *(v4u*)(rkv + (size_t)(row0 + p) * 768 + c8) = o;
            if (c8 < 256) *(LAS v4u*)(RS + t * RP + c8) = o; else if (c8 < 512) *(LAS v4u*)(KS + t * RP + c8 - 256) = o;
        } else {
            const int ci = c8 - 768;
            LAS bf16* dst = ci < 64 ? XW + t * MP + ci : (ci < 128 ? XA + t * MP + ci - 64 : XG + t * MP + ci - 128);
            *(LAS v4u*)dst = o;
        }
    }
    __syncthreads();
    const int lane = C.lane, w = C.wave, l15 = lane & 15, q = lane >> 4, hd = w & 3, ntp = w >> 2;
    const bf16* wt = WSP(const bf16, WS_RWT);
    bf16* wa_out = WSP(bf16, WS_HB); bf16* g_out = WSP(bf16, WS_G); float* bonus = WSP(float, WS_BONUS); float* rinv = WSP(float, WS_RINV);
    const f32x4 z4 = (f32x4){0.f, 0.f, 0.f, 0.f};
#pragma unroll 1
    for (int n2 = 0; n2 < 2; ++n2) {
        const int nt = 2 * ntp + n2, tok = 16 * nt + l15; const size_t row = (size_t)(row0 + p0 + tok);
        const fragb xw0 = ld_frag16(XW + tok * MP + 8 * q), xw1 = ld_frag16(XW + tok * MP + 32 + 8 * q);
        const fragb xa0 = ld_frag16(XA + tok * MP + 8 * q), xa1 = ld_frag16(XA + tok * MP + 32 + 8 * q);
        const fragb xg0 = ld_frag16(XG + tok * MP + 8 * q), xg1 = ld_frag16(XG + tok * MP + 32 + 8 * q);
        float bsum = 0.f, ksum = 0.f;
#pragma unroll
        for (int mt = 0; mt < 4; ++mt) {
            const int chl = 16 * mt + l15, ch4 = hd * 64 + 16 * mt + 4 * q;
            const bf16* wrow = wt + (size_t)(hd * 64 + chl) * 32 + 8 * q;
            const f32x4 aw0 = mfma16(*(const fragb*)(wrow), xw0, z4), aw1 = mfma16(*(const fragb*)(wrow + 256 * 32), xw1, z4);
            const f32x4 aa0 = mfma16(*(const fragb*)(wrow + 2 * 256 * 32), xa0, z4), aa1 = mfma16(*(const fragb*)(wrow + 3 * 256 * 32), xa1, z4);
            const bf16* grow = wt + 4 * 256 * 32 + (size_t)(hd * 64 + chl) * 64 + 8 * q;
            f32x4 ag = mfma16(*(const fragb*)(grow), xg0, z4); ag = mfma16(*(const fragb*)(grow + 32), xg1, ag);
            const f32x4 w00 = *(const f32x4*)(C.in[I_RW0] + (l * 2 + 0) * GW + ch4), w01 = *(const f32x4*)(C.in[I_RW0] + (l * 2 + 1) * GW + ch4);
            const f32x4 a00 = *(const f32x4*)(C.in[I_RA0] + (l * 2 + 0) * GW + ch4), a01 = *(const f32x4*)(C.in[I_RA0] + (l * 2 + 1) * GW + ch4);
            const f32x4 k_a = *(const f32x4*)(C.in[I_RKA] + l * GW + ch4), r_k = *(const f32x4*)(C.in[I_RRK] + l * GW + ch4), k_k = *(const f32x4*)(C.in[I_RKK] + l * GW + ch4);
            f32x4 wv0, wv1, av0, av1;
#pragma unroll
            for (int r = 0; r < 4; ++r) {
                wv0[r] = __expf(-0.6065306597126334f * sigmoidf_(aw0[r] + w00[r])); wv1[r] = __expf(-0.6065306597126334f * sigmoidf_(aw1[r] + w01[r]));
                av0[r] = sigmoidf_(aa0[r] + a00[r]); av1[r] = sigmoidf_(aa1[r] + a01[r]);
            }
            st4bf(wa_out + row * 1024 + 0 * 256 + ch4, wv0); st4bf(wa_out + row * 1024 + 1 * 256 + ch4, wv1);
            st4bf(wa_out + row * 1024 + 2 * 256 + ch4, av0); st4bf(wa_out + row * 1024 + 3 * 256 + ch4, av1);
            st4bf(g_out + row * 256 + ch4, ag);
            const v2u rr_ = *(const LAS v2u*)(RS + tok * RP + ch4), kr_ = *(const LAS v2u*)(KS + tok * RP + ch4);
            const f32x4 rs = (f32x4){bflo(rr_.x), bfhi(rr_.x), bflo(rr_.y), bfhi(rr_.y)}, ks = (f32x4){bflo(kr_.x), bfhi(kr_.x), bflo(kr_.y), bfhi(kr_.y)};
#pragma unroll
            for (int r = 0; r < 4; ++r) {
                const float km = ks[r] * (1.0f + (av0[r] - 1.0f) * k_a[r]) + ks[r] * (1.0f + (av1[r] - 1.0f) * k_a[r]);
                bsum += rs[r] * r_k[r] * km; const float kk = ks[r] * k_k[r]; ksum += kk * kk;
            }
        }
        bsum += __shfl_xor(bsum, 16); bsum += __shfl_xor(bsum, 32); ksum += __shfl_xor(ksum, 16); ksum += __shfl_xor(ksum, 32);
        if (q == 0) { bonus[row * 4 + hd] = bsum; rinv[row * 4 + hd] = 1.0f / sqrtf(ksum + 1e-6f); }
    }
    __syncthreads();
}
__device__ __forceinline__ int fwd_row_r(int b, int c, int t) { return c < 4 ? (T_LAT + b * CTXL + c * 64 + t) : (b * SEQ + (c - 4) * 64 + t); }
__device__ __forceinline__ bf16* rw_blob_row(const Ctx& C, int d, int which, int b, int c, int h, int r) {
    const int row = fwd_row_r(b, c, r);
    if (which == 0) return WSP(bf16, WS_OUTB) + ((size_t)d * T_ALL + row) * 256 + h * 64;
    return WSP(bf16, WS_P) + (size_t)row * PLD + OFF_B + d * 256 + h * 64;
}
__device__ __forceinline__ void rwkv_solve_units(const Ctx& C, int l) {
    const int lane = C.lane, w = C.wave, pw = w & 1, pi = w >> 1, l15 = lane & 15, q = lane >> 4;
    LAS unsigned char* B0 = C.lds + pi * 28672;
    LAS bf16* Kk = (LAS bf16*)B0; LAS bf16* Bh = Kk + 64 * MP; LAS bf16* Kh = Bh + 64 * MP;
    LAS float* Lm = (LAS float*)B0; LAS bf16* Lk16 = (LAS bf16*)(B0 + 17408);
    const bf16* WA = WSP(const bf16, WS_HB); const bf16* rkv = WSP(const bf16, WS_RKV); const float* rinv = WSP(const float, WS_RINV);
    const int NU = NB * NH * NCH, per = C.G * 4;
    const int trips = (NU + per - 1) / per;
#pragma unroll 1
    for (int k = 0; k < trips; ++k) {
        int u = k * per + C.wg * 4 + pi; const bool active = u < NU; if (!active) u = NU - 1;
        const int c = u % NCH, h = (u / NCH) & 3, b = u / (NCH * NH);
        const float k_k = C.in[I_RKK][l * GW + h * 64 + lane], k_a = C.in[I_RKA][l * GW + h * 64 + lane];
#pragma unroll 1
        for (int d = 0; d < 2; ++d) {
            const int n = d ? (c < 4 ? 3 - c : 71 - c) : c;
            const float ril = rinv[(size_t)seqrow_raster(n * 64 + lane, d, b) * 4 + h];
#pragma unroll
            for (int r = 0; r < 4; ++r) { const int idx2 = pw * 64 + lane + 128 * r, t = idx2 >> 3, part = idx2 & 7; const int row = seqrow_raster(n * 64 + t, d, b);
                *(LAS v4u*)(Kk + t * MP + 8 * part) = *(const v4u*)(WA + (size_t)row * 1024 + d * 256 + h * 64 + 8 * part);
                *(LAS v4u*)(Bh + t * MP + 8 * part) = *(const v4u*)(WA + (size_t)row * 1024 + (2 + d) * 256 + h * 64 + 8 * part);
                *(LAS v4u*)(Kh + t * MP + 8 * part) = *(const v4u*)(rkv + (size_t)row * 768 + 256 + h * 64 + 8 * part); }
            __syncthreads();
            float x[64];
            if (pw == 0) {
                float cc = 1.0f;
#pragma unroll
                for (int t = 0; t < 64; ++t) {
                    const float wv = bf2f(Kk[t * MP + lane]), av = bf2f(Bh[t * MP + lane]), ks = bf2f(Kh[t * MP + lane]);
                    const float kap = ks * k_k * __shfl(ril, t);
                    const float cprev = cc; cc *= wv; const float ic = 1.0f / cc;
                    x[t] = kap * cprev;
                    Kk[t * MP + lane] = (bf16)f2bf1(x[t]); Bh[t * MP + lane] = (bf16)f2bf1(kap * av * ic); Kh[t * MP + lane] = (bf16)f2bf1(ks * (1.0f + (av - 1.0f) * k_a) * ic);
                }
            }
            __syncthreads();
            f32x4 T[10];
            {
                const LAS bf16* Bsrc = pw ? Kh : Bh;
                int tix = 0;
#pragma unroll
                for (int it = 0; it < 4; ++it)
#pragma unroll
                    for (int jt = 0; jt <= it; ++jt, ++tix) {
                        f32x4 acc = (f32x4){0.f, 0.f, 0.f, 0.f};
#pragma unroll
                        for (int s = 0; s < 2; ++s) acc = mfma16(ld_frag16(Kk + (16 * it + l15) * MP + 32 * s + 8 * q), ld_frag16(Bsrc + (16 * jt + l15) * MP + 32 * s + 8 * q), acc);
#pragma unroll
                        for (int r = 0; r < 4; ++r) { const int i = 16 * it + 4 * q + r, j = 16 * jt + l15; T[tix][r] = (j < i) ? acc[r] : 0.f; }
                    }
            }
            __syncthreads();
            {
                int tix = 0;
#pragma unroll
                for (int it = 0; it < 4; ++it)
#pragma unroll
                    for (int jt = 0; jt <= it; ++jt, ++tix)
#pragma unroll
                        for (int r = 0; r < 4; ++r) { const int i = 16 * it + 4 * q + r, j = 16 * jt + l15;
                            if (pw == 0) Lm[i * LP + j] = T[tix][r]; else Lk16[i * MP + j] = (bf16)f2bf1(T[tix][r]); }
            }
            __syncthreads();
            if (pw) {
#pragma unroll
                for (int i = 0; i < 64; ++i) x[i] = (i > lane) ? bf2f(Lk16[i * MP + lane]) : 0.f;
            }
#pragma unroll
            for (int i = 0; i < 64; ++i) {
                float a0 = x[i], a1 = 0.f;
                int roff = i * LP; if (i >= 2) asm volatile("" : "+v"(roff) : "v"(x[i - 2]));
                const LAS float* lrow = Lm + roff;
#pragma unroll
                for (int j4 = 0; j4 < i; j4 += 4) { const f32x4 lv = *(const LAS f32x4*)(lrow + j4);
                    a0 -= lv.x * x[j4]; if (j4 + 1 < i) a1 -= lv.y * x[j4 + 1]; if (j4 + 2 < i) a0 -= lv.z * x[j4 + 2]; if (j4 + 3 < i) a1 -= lv.w * x[j4 + 3]; }
                x[i] = a0 + a1;
            }
            if (active) { bf16* dst = rw_blob_row(C, d, pw, b, c, h, lane);
#pragma unroll
                for (int g = 0; g < 8; ++g) { v4u o; o.x = pk2(x[8 * g], x[8 * g + 1]); o.y = pk2(x[8 * g + 2], x[8 * g + 3]); o.z = pk2(x[8 * g + 4], x[8 * g + 5]); o.w = pk2(x[8 * g + 6], x[8 * g + 7]);
                    *(v4u*)(dst + 8 * g) = o; } }
            __syncthreads();
        }
    }
}

template <bool DRY>
__device__ __forceinline__ void rwkv_chunked(const Ctx& C, int l, int idx) {
    const int d = idx >> 5, b = (idx >> 2) & 7, h = idx & 3, lane = C.lane, w = C.wave, l15 = lane & 15, q = lane >> 4;
    const int it = w & 3, vtp = w >> 2;
    constexpr int IMG = 64 * MP * 2;
    LAS unsigned char* L0 = C.lds;
    LAS bf16* Wi = (LAS bf16*)L0; LAS bf16* Ti = Wi + 64 * MP; LAS bf16* Rh = Ti + 64 * MP; LAS bf16* Kh = Rh + 64 * MP; LAS bf16* Bh = Kh + 64 * MP;
    LAS bf16* UT = (LAS bf16*)(L0 + 11 * IMG);
    LAS float* cLv = (LAS float*)(L0 + 14 * IMG);
    const bf16* WA = WSP(const bf16, WS_HB); const bf16* rkv = WSP(const bf16, WS_RKV); const float* rinv = WSP(const float, WS_RINV);
    bf16* outb = WSP(bf16, WS_OUTB) + (size_t)d * T_ALL * 256;
    const int tt = C.tid >> 3, part = C.tid & 7;
    for (int i = C.tid; i < 2 * IMG / 4; i += NTHR) ((LAS unsigned*)(L0 + 12 * IMG))[i] = 0u;
    float kkw[8], kaw[8];
#pragma unroll
    for (int e = 0; e < 8; ++e) { kkw[e] = C.in[I_RKK][l * GW + h * 64 + 8 * w + e]; kaw[e] = C.in[I_RKA][l * GW + h * 64 + 8 * w + e]; }
    v4u gr, gk, gv, gw, ga, gbw, gbt; float gri;
    auto gload = [&](int n) {
        const int c = d ? (n < 4 ? 3 - n : 71 - n) : n;
        const int row = seqrow_raster(n * 64 + lane, d, b);
        const bf16* pr = rkv + (size_t)row * 768 + h * 64 + 8 * w;
        gr = *(const v4u*)pr; gk = *(const v4u*)(pr + 256); gv = *(const v4u*)(pr + 512);
        gw = *(const v4u*)(WA + (size_t)row * 1024 + d * 256 + h * 64 + 8 * w); ga = *(const v4u*)(WA + (size_t)row * 1024 + (2 + d) * 256 + h * 64 + 8 * w);
        gri = rinv[(size_t)row * 4 + h];
        gbw = *(const v4u*)(rw_blob_row(C, d, 0, b, c, h, tt) + 8 * part); gbt = *(const v4u*)(rw_blob_row(C, d, 1, b, c, h, tt) + 8 * part);
    };
    auto images = [&](int bufi) {
        LAS bf16* VT = (LAS bf16*)(L0 + (5 + 3 * bufi) * IMG); LAS bf16* KcT = VT + 64 * MP; LAS bf16* BcT = KcT + 64 * MP;
        const unsigned rw_[4] = {gr.x, gr.y, gr.z, gr.w}, kw_[4] = {gk.x, gk.y, gk.z, gk.w}, vw_[4] = {gv.x, gv.y, gv.z, gv.w}, ww_[4] = {gw.x, gw.y, gw.z, gw.w}, aw_[4] = {ga.x, ga.y, ga.z, ga.w};
        float rh[8], kh[8], bh[8];
#pragma unroll
        for (int e = 0; e < 8; ++e) {
            const float rs = (e & 1) ? bfhi(rw_[e >> 1]) : bflo(rw_[e >> 1]), ks = (e & 1) ? bfhi(kw_[e >> 1]) : bflo(kw_[e >> 1]);
            const float wv = (e & 1) ? bfhi(ww_[e >> 1]) : bflo(ww_[e >> 1]), av = (e & 1) ? bfhi(aw_[e >> 1]) : bflo(aw_[e >> 1]);
            const float lw = __logf(wv);
            const float cum = wave_incl_sum(lw, lane), cumL = __shfl(cum, 63);
            const float kap = ks * kkw[e] * gri, ktil = ks * (1.0f + (av - 1.0f) * kaw[e]);
            const float cf = __expf(cum), icf = __expf(-cum), dec = __expf(cumL - cum);
            rh[e] = rs * cf; kh[e] = ktil * icf; bh[e] = kap * av * icf;
            const unsigned short vraw = (e & 1) ? (unsigned short)(vw_[e >> 1] >> 16) : (unsigned short)(vw_[e >> 1] & 0xffffu);
            VT[(8 * w + e) * MP + lane] = vraw; KcT[(8 * w + e) * MP + lane] = (bf16)f2bf1(ktil * dec); BcT[(8 * w + e) * MP + lane] = (bf16)f2bf1(-(kap * av * dec));
            if (lane == 63) cLv[bufi * 64 + 8 * w + e] = __expf(cumL);
        }
        { v4u o; o.x = pk2(rh[0], rh[1]); o.y = pk2(rh[2], rh[3]); o.z = pk2(rh[4], rh[5]); o.w = pk2(rh[6], rh[7]); *(LAS v4u*)(Rh + lane * MP + 8 * w) = o; }
        { v4u o; o.x = pk2(kh[0], kh[1]); o.y = pk2(kh[2], kh[3]); o.z = pk2(kh[4], kh[5]); o.w = pk2(kh[6], kh[7]); *(LAS v4u*)(Kh + lane * MP + 8 * w) = o; }
        { v4u o; o.x = pk2(bh[0], bh[1]); o.y = pk2(bh[2], bh[3]); o.z = pk2(bh[4], bh[5]); o.w = pk2(bh[6], bh[7]); *(LAS v4u*)(Bh + lane * MP + 8 * w) = o; }
        const unsigned bw_[4] = {gbw.x, gbw.y, gbw.z, gbw.w}, bt_[4] = {gbt.x, gbt.y, gbt.z, gbt.w};
#pragma unroll
        for (int e = 0; e < 4; ++e) {
            Wi[(8 * part + 2 * e) * MP + tt] = (bf16)(bw_[e] & 0xffffu); Wi[(8 * part + 2 * e + 1) * MP + tt] = (bf16)(bw_[e] >> 16);
            Ti[(8 * part + 2 * e) * MP + tt] = (bf16)(bt_[e] & 0xffffu); Ti[(8 * part + 2 * e + 1) * MP + tt] = (bf16)(bt_[e] >> 16);
        }
    };
    f32x4 Zst[2]; Zst[0] = Zst[1] = (f32x4){0.f, 0.f, 0.f, 0.f};
    const f32x4 z4 = (f32x4){0.f, 0.f, 0.f, 0.f};
    gload(0); images(0); gload(1);
#pragma unroll 1
    for (int n = 0; n < NCH; ++n) {
        RAW_BARRIER();
        const LAS bf16* VT = (const LAS bf16*)(L0 + (5 + 3 * (n & 1)) * IMG); const LAS bf16* KcT = VT + 64 * MP; const LAS bf16* BcT = KcT + 64 * MP;
        const LAS bf16* Zi = (const LAS bf16*)(L0 + (12 + (n & 1)) * IMG); LAS bf16* Zn = (LAS bf16*)(L0 + (12 + ((n + 1) & 1)) * IMG);
        const int arow = (16 * it + l15) * MP + 8 * q;
        const fragb Wf0 = ld_frag16(Wi + arow), Wf1 = ld_frag16(Wi + arow + 32), Tf0 = ld_frag16(Ti + arow), Tf1 = ld_frag16(Ti + arow + 32), Rf0 = ld_frag16(Rh + arow), Rf1 = ld_frag16(Rh + arow + 32);
        const int icol = 16 * it + l15;
        f32x4 pk[4], pb[4];
#pragma unroll
        for (int jt = 0; jt < 4; ++jt) {
            pk[jt] = z4; pb[jt] = z4;
            if (jt <= it) {
                const int jrow = (16 * jt + l15) * MP + 8 * q;
                f32x4 sk = mfma16(ld_frag16(Kh + jrow), Rf0, z4); sk = mfma16(ld_frag16(Kh + jrow + 32), Rf1, sk);
                f32x4 sb = mfma16(ld_frag16(Bh + jrow), Rf0, z4); sb = mfma16(ld_frag16(Bh + jrow + 32), Rf1, sb);
#pragma unroll
                for (int r = 0; r < 4; ++r) { const int j = 16 * jt + 4 * q + r; pk[jt][r] = (j <= icol) ? sk[r] : 0.f; pb[jt][r] = (j <= icol) ? -sb[r] : 0.f; }
            }
        }
        fragb Pk0 = pack_frag(pk[0], pk[1]), Pk1 = pack_frag(pk[2], pk[3]), Pb0 = pack_frag(pb[0], pb[1]), Pb1 = pack_frag(pb[2], pb[3]);
        f32x4 RZ[2];
#pragma unroll
        for (int v2 = 0; v2 < 2; ++v2) {
            const int vrow = 16 * (2 * vtp + v2) + l15;
            const fragb z0 = ld_frag16(Zi + vrow * MP + 8 * q), z1 = ld_frag16(Zi + vrow * MP + 32 + 8 * q);
            f32x4 u = mfma16(Wf0, z0, z4); u = mfma16(Wf1, z1, u);
            u = mfma16(Tf0, ld_frag16(VT + vrow * MP + 8 * q), u); if (it >= 2) u = mfma16(Tf1, ld_frag16(VT + vrow * MP + 32 + 8 * q), u);
            RZ[v2] = mfma16(Rf0, z0, z4); RZ[v2] = mfma16(Rf1, z1, RZ[v2]);
            v2u o; o.x = pk2(u.x, u.y); o.y = pk2(u.z, u.w);
            *(LAS v2u*)(UT + vrow * MP + 16 * it + 4 * q) = o;
        }
        RAW_BARRIER();
        {
            const f32x4 cl4 = *(const LAS f32x4*)(cLv + (n & 1) * 64 + 16 * it + 4 * q);
            const LAS bf16* kr = KcT + (16 * it + l15) * MP + 4 * q; const LAS bf16* br = BcT + (16 * it + l15) * MP + 4 * q;
            const fragb kc0 = ld_frag8x2(kr, kr + 16), kc1 = ld_frag8x2(kr + 32, kr + 48), bc0 = ld_frag8x2(br, br + 16), bc1 = ld_frag8x2(br + 32, br + 48);
#pragma unroll
            for (int v2 = 0; v2 < 2; ++v2) {
                const int vrow = 16 * (2 * vtp + v2) + l15;
                const LAS bf16* vr = VT + vrow * MP + 4 * q; const LAS bf16* ur = UT + vrow * MP + 4 * q;
                const fragb vp0 = ld_frag8x2(vr, vr + 16), vp1 = ld_frag8x2(vr + 32, vr + 48), up0 = ld_frag8x2(ur, ur + 16), up1 = ld_frag8x2(ur + 32, ur + 48);
                f32x4 y = mfma16(Pk0, vp0, RZ[v2]); y = mfma16(Pb0, up0, y);
                if (it >= 2) { y = mfma16(Pk1, vp1, y); y = mfma16(Pb1, up1, y); }
#pragma unroll
                for (int r = 0; r < 4; ++r) { const int row = seqrow_raster(n * 64 + 16 * it + 4 * q + r, d, b); if (!DRY) outb[(size_t)row * 256 + h * 64 + vrow] = (bf16)f2bf1(y[r]); }
                f32x4 zn = mfma16(kc0, vp0, z4); zn = mfma16(kc1, vp1, zn); zn = mfma16(bc0, up0, zn); zn = mfma16(bc1, up1, zn);
                Zst[v2] = Zst[v2] * cl4 + zn;
                v2u so; so.x = pk2(Zst[v2].x, Zst[v2].y); so.y = pk2(Zst[v2].z, Zst[v2].w);
                *(LAS v2u*)(Zn + vrow * MP + 16 * it + 4 * q) = so;
            }
        }
        if (n + 1 < NCH) { images((n + 1) & 1); if (n + 2 < NCH) gload(n + 2); }
    }
    __syncthreads();
}
__device__ __forceinline__ void moe_scatter(const Ctx& C, int moe_li, int nrows) {
    const unsigned* gc = WSP(const unsigned, WS_CTL) + CW_MOECNT + 64 * moe_li;
    LAS int* pst = (LAS int*)C.lds;
    {
        int pe[8]; int acc = 0;
#pragma unroll
        for (int e = 0; e < NE; ++e) { const int blks = ((int)gc[e] + 255) >> 8; if (C.tid == e) pst[e] = acc * 256; acc += blks; pe[e] = acc; }
        if (C.wg == 0 && C.tid < MOE_MAXBLK) { int be = 0;
#pragma unroll
            for (int e = 0; e < NE; ++e) be += (pe[e] <= C.tid) ? 1 : 0;
            int* tab = WSP(int, WS_TAB); tab[1 + C.tid] = be < NE ? be : NE - 1; if (C.tid == 0) tab[0] = acc; }
    }
    __syncthreads();
    const unsigned* route = WSP(const unsigned, WS_ROUTE); const unsigned* wgbase = WSP(const unsigned, WS_WGBASE);
    const bf16* hb = WSP(const bf16, WS_HB); bf16* am = WSP(bf16, WS_MIX); int* pos = WSP(int, WS_POS);
    const int gw = C.wg * NWAVES + C.wave, NGW = C.G * NWAVES;
    for (int m = gw; m < nrows; m += NGW) {
        const v4u a = *(const v4u*)(route + (size_t)m * 8);
        const int e0 = (int)a.x, e1 = (int)a.y;
        const int p0 = pst[e0] + (int)wgbase[C.wg * 8 + e0] + (int)a.z, p1 = pst[e1] + (int)wgbase[C.wg * 8 + e1] + (int)a.w;
        const v4u r0 = *(const v4u*)(hb + (size_t)m * 1024 + C.lane * 8), r1 = *(const v4u*)(hb + (size_t)m * 1024 + 512 + C.lane * 8);
        *(v4u*)(am + (size_t)p0 * 1024 + C.lane * 8) = r0; *(v4u*)(am + (size_t)p0 * 1024 + 512 + C.lane * 8) = r1;
        *(v4u*)(am + (size_t)p1 * 1024 + C.lane * 8) = r0; *(v4u*)(am + (size_t)p1 * 1024 + 512 + C.lane * 8) = r1;
        if (C.lane == 0) { pos[(size_t)m * 2] = p0; pos[(size_t)m * 2 + 1] = p1; }
    }
    __syncthreads();
}
__device__ __forceinline__ void moe_combine(const Ctx& C, int l, int nrows) {
    const unsigned* route = WSP(const unsigned, WS_ROUTE); const int* pos = WSP(const int, WS_POS); const bf16* ym = WSP(const bf16, WS_MIX);
    const float* modv = WSP(const float, WS_MODV) + (size_t)l * 9 * 6144 + 5 * 1024;
    float* xc = WSP(float, WS_XC);
    const int gw = C.wg * NWAVES + C.wave, NGW = C.G * NWAVES;
    for (int m = gw; m < nrows; m += NGW) {
        const bool isctx = m >= T_LAT;
        float* xr = isctx ? xc + (size_t)(m - T_LAT) * 1024 : C.out + (size_t)m * 1024;
        const float* gv = modv + (size_t)(isctx ? 8 : (m >> 12)) * 6144;
        const int p0 = pos[(size_t)m * 2], p1 = pos[(size_t)m * 2 + 1];
        const float w0 = __builtin_bit_cast(float, route[(size_t)m * 8 + 4]), w1 = __builtin_bit_cast(float, route[(size_t)m * 8 + 5]);
#pragma unroll
        for (int j = 0; j < 4; ++j) {
            const int col = 4 * C.lane + 256 * j;
            const v2u a = *(const v2u*)(ym + (size_t)p0 * 1024 + col), b = *(const v2u*)(ym + (size_t)p1 * 1024 + col);
            const f32x4 ya = (f32x4){bflo(a.x), bfhi(a.x), bflo(a.y), bfhi(a.y)}, yb = (f32x4){bflo(b.x), bfhi(b.x), bflo(b.y), bfhi(b.y)};
            const f32x4 g = *(const f32x4*)(gv + col); f32x4 x = *(const f32x4*)(xr + col);
            x = x + g * (ya * w0 + yb * w1);
            *(f32x4*)(xr + col) = x;
        }
    }
}
__device__ __forceinline__ void final_norm(const Ctx& C) {
    const int gw = C.wg * NWAVES + C.wave, NGW = C.G * NWAVES;
    f32x4 gv[4];
#pragma unroll
    for (int j = 0; j < 4; ++j) gv[j] = *(const f32x4*)(C.in[I_FNG] + 4 * C.lane + 256 * j);
    for (int m = gw; m < T_LAT; m += NGW) {
        float* xr = C.out + (size_t)m * 1024;
        f32x4 v[4]; float s = 0.f;
#pragma unroll
        for (int j = 0; j < 4; ++j) { v[j] = *(const f32x4*)(xr + 4 * C.lane + 256 * j); s += (v[j].x * v[j].x + v[j].y * v[j].y) + (v[j].z * v[j].z + v[j].w * v[j].w); }
        const float rs = 1.0f / sqrtf(wave_sum(s) * (1.0f / 1024.0f) + 1e-6f);
#pragma unroll
        for (int j = 0; j < 4; ++j) *(f32x4*)(xr + 4 * C.lane + 256 * j) = v[j] * rs * gv[j];
    }
}

constexpr int NPH_L = 12, PH_FINAL = 1 + DEPTH * NPH_L, NPHASE = PH_FINAL + 1;
__host__ __device__ inline bool phase_exists(int ph) {
    if (ph == 0 || ph == PH_FINAL) return true;
    const int l = (ph - 1) / NPH_L, k = (ph - 1) % NPH_L;
    if (!(l & 1) && k >= 10) return false;
    return true;
}
#ifndef PH_MASK
#define PH_MASK 0xFFFFFF
#endif
#define PM(k) ((PH_MASK >> (k)) & 1)
#ifndef SK_MASK
#define SK_MASK 0xFFFF
#endif
#define SK(k) ((SK_MASK >> (k)) & 1)
#ifndef REP_MASK
#define REP_MASK 0
#endif
#define NREP(k) (((REP_MASK >> (k)) & 1) ? 2 : 1)

__global__ void __launch_bounds__(NTHR, 2) fwd_kernel(Args args) {
    extern __shared__ __attribute__((aligned(16))) unsigned char lds_raw[];
    Ctx C; C.in = args.in; C.out = args.out; C.ws = args.ws; C.lds = (LAS unsigned char*)lds_raw;
    C.tid = threadIdx.x; C.lane = C.tid & 63; C.wave = __builtin_amdgcn_readfirstlane(C.tid >> 6); C.G = gridDim.x; C.wg = blockIdx.x;
    volatile LAS unsigned* MISC = (volatile LAS unsigned*)(C.lds + MISC_OFF);
    if (C.tid < 64) MISC[C.tid] = 0u;
    __syncthreads();
    const int lo = args.ph_lo, hi = args.ph_hi;
    const bool multi = (hi - lo) > 1;
    if (multi) (void)xcd_barrier_post(WSP(unsigned, WS_CTL) + CW_BAR, MISC + 8);
#define IN(k) (lo <= (k) && (k) < hi)
#define SEAM(k) do { if (IN((k) + 1)) { XcdBarrier b2_; b2_.bar = WSP(unsigned, WS_CTL) + CW_BAR; b2_.x = xb_xcc_id(); b2_.st = (volatile LAS unsigned*)(C.lds + MISC_OFF) + 8; xcd_barrier(b2_); } } while (0)
#define FRESH() do { int t_ = threadIdx.x; asm volatile("" : "+v"(t_)); C.tid = t_; C.lane = t_ & 63; C.wave = __builtin_amdgcn_readfirstlane(t_ >> 6); } while (0)
#define PHASE(bit, k) if (PM(bit) && IN(pb + (k))) for (int rep_ = 0; rep_ < NREP(bit); ++rep_)

    if (PM(20) && IN(0)) { phase_pre(C); SEAM(0); }

#pragma unroll 1
    for (int l = 0; l < DEPTH; ++l) {
        const int pb = 1 + l * NPH_L;
        if (hi <= pb || lo >= pb + NPH_L) continue;
        const bool last = (l == DEPTH - 1), moe = (l & 1);
        const int nrows = last ? T_LAT : T_ALL;
        const float* xlat = (l == 0) ? C.in[I_X] : C.out; const float* xctx = (l == 0) ? C.in[I_CTX] : WSP(const float, WS_XC);
        const float* modv = WSP(const float, WS_MODV) + (size_t)l * 9 * 6144;

        PHASE(0, 0) { FRESH();
            convert_layer(C, l);
            __syncthreads();
            FRESH(); norm_rows<false>(C, l, xlat, xctx, C.in[I_NMIXG] + l * 1024, 0, 1024, T_ALL, 0);
            SEAM(pb + 0);
        }
        PHASE(1, 1) { FRESH();
            pg8::Gemm g{WSP(const bf16, WS_HB), WSP(const bf16, WS_WIN), T_ALL, PLD, 1024, 0};
            pg8::StaticOrder S; S.init(T_ALL, PLD, C.G, C.wg);
            pg8::EpiBf16<0> E{WSP(bf16, WS_P), PLD, nullptr, 0, 0};
            pg8::gemm_phase<pg8::EpiBf16<0>, pg8::StaticOrder, false>(C.lds, g, S, E, nullptr);
            SEAM(pb + 1);
        }
        PHASE(2, 2) { FRESH();
            for (int r2_ = 0; r2_ < NREP(16); ++r2_) { FRESH(); if (SK(0)) for (int u = C.wg; u < NB * NCH; u += C.G) lru_chunk_mfma<false>(C, l, u / NCH, u % NCH); }
            for (int r2_ = 0; r2_ < NREP(17); ++r2_) { FRESH(); if (SK(1)) for (int u = C.wg; u < NB * NCH; u += C.G) rwkv_prep2(C, l, u / NCH, u % NCH); }
            FRESH(); if (SK(2)) for (int u = C.wg; u < NB * NCH; u += C.G) gdn_prep(C, l, u / NCH, u % NCH);
            SEAM(pb + 2);
        }
        for (int rep34_ = 0; rep34_ < NREP(30); ++rep34_) {
        if (PM(3) && IN(pb + 3)) { FRESH();
            for (int r2_ = 0; r2_ < NREP(18); ++r2_) { FRESH(); if (SK(9)) gdn_solve_units(C, l); }
            for (int r2_ = 0; r2_ < NREP(19); ++r2_) { FRESH(); if (SK(10)) rwkv_solve_units(C, l); }
            SEAM(pb + 3);
        }
        if (PM(4) && IN(pb + 4)) { FRESH();
            if (SK(3) && C.wg < 64) { if (NREP(20) > 1) { FRESH(); rwkv_chunked<true>(C, l, C.wg); } FRESH(); rwkv_chunked<false>(C, l, C.wg); }
            else if (SK(4) && C.wg >= 128 && C.wg < 192) { for (int r2_ = 0; r2_ < NREP(21); ++r2_) { FRESH(); mlstm_chunked(C, l, C.wg - 128); } }
            else if (SK(5) && C.wg >= 192) { if (NREP(22) > 1) { FRESH(); gdn_chunked<true>(C, l, C.wg - 192); } FRESH(); gdn_chunked<false>(C, l, C.wg - 192); }
            else if (SK(6) && C.wg >= 64 && C.wg < 72) lru_carry(C, (C.wg - 64) * NTHR + C.tid);
            SEAM(pb + 4);
        }
        }
        PHASE(5, 5) { FRESH();
            for (int u = C.wg; u < NB * NCH; u += C.G) { const int b = u / NCH, c = u % NCH; if (last && c < 4) continue; if (SK(7)) lru_chunk_mfma<true>(C, l, b, c); }
            FRESH(); if (SK(8)) finish_rows(C, l, nrows);
            SEAM(pb + 5);
        }
        if (PM(6) && IN(pb + 6)) { FRESH();
            pg8::Gemm g{WSP(const bf16, WS_HB), WSP(const bf16, WS_WOUT), nrows, 1024, 1024, 0};
            pg8::StaticOrder S; S.init(nrows, 1024, C.G, C.wg);
            pg8::EpiRes E{xlat, xctx, C.out, WSP(float, WS_XC), modv + 2 * 1024};
            pg8::gemm_phase<pg8::EpiRes, pg8::StaticOrder, false>(C.lds, g, S, E, nullptr);
            SEAM(pb + 6);
        }
        if (PM(7) && IN(pb + 7)) { FRESH();
            if (moe) norm_rows<true>(C, l, C.out, WSP(const float, WS_XC), C.in[I_NFFNG] + l * 1024, 3 * 1024, 4 * 1024, nrows, l >> 1);
            else norm_rows<false>(C, l, C.out, WSP(const float, WS_XC), C.in[I_NFFNG] + l * 1024, 3 * 1024, 4 * 1024, nrows, 0);
            SEAM(pb + 7);
        }
        if (!moe) {
            if (PM(8) && IN(pb + 8)) { FRESH();
                pg8::Gemm g{WSP(const bf16, WS_HB), WSP(const bf16, WS_WGU), nrows, 2 * DFF, 1024, 0};
                pg8::StaticOrder S; S.init(nrows, 2 * DFF, C.G, C.wg);
                pg8::EpiSwiglu E{WSP(bf16, WS_P), DFF};
                pg8::gemm_phase<pg8::EpiSwiglu, pg8::StaticOrder, false>(C.lds, g, S, E, nullptr);
                SEAM(pb + 8);
            }
            if (PM(9) && IN(pb + 9)) { FRESH();
                pg8::Gemm g{WSP(const bf16, WS_P), WSP(const bf16, WS_WDN), nrows, 1024, DFF, 0};
                pg8::StaticOrder S; S.init(nrows, 1024, C.G, C.wg);
                pg8::EpiRes E{C.out, WSP(const float, WS_XC), C.out, WSP(float, WS_XC), modv + 5 * 1024};
                pg8::gemm_phase<pg8::EpiRes, pg8::StaticOrder, false>(C.lds, g, S, E, nullptr);
                SEAM(pb + 11);
            }
        } else {
            if (PM(10) && IN(pb + 8)) { FRESH(); moe_scatter(C, l >> 1, nrows); SEAM(pb + 8); }
            if (PM(11) && IN(pb + 9)) { FRESH();
                pg8::Gemm g{WSP(const bf16, WS_MIX), WSP(const bf16, WS_WGU), 0, 2 * DFE, 1024, (size_t)2 * DFE * 1024};
                pg8::MoeOrder S; S.init(WSP(const int, WS_TAB), (2 * DFE) / 256, C.G, C.wg);
                pg8::EpiSwiglu E{WSP(bf16, WS_P), DFE};
                pg8::gemm_phase<pg8::EpiSwiglu, pg8::MoeOrder, false>(C.lds, g, S, E, nullptr);
                SEAM(pb + 9);
            }
            if (PM(12) && IN(pb + 10)) { FRESH();
                pg8::Gemm g{WSP(const bf16, WS_P), WSP(const bf16, WS_WDN), 0, 1024, DFE, (size_t)1024 * DFE};
                pg8::MoeOrder S; S.init(WSP(const int, WS_TAB), 4, C.G, C.wg);
                pg8::EpiBf16<0> E{WSP(bf16, WS_MIX), 1024, nullptr, 0, 0};
                pg8::gemm_phase<pg8::EpiBf16<0>, pg8::MoeOrder, false>(C.lds, g, S, E, nullptr);
                SEAM(pb + 10);
            }
            if (PM(13) && IN(pb + 11)) { FRESH(); moe_combine(C, l, nrows); SEAM(pb + 11); }
        }
    }
    if (PM(21) && IN(PH_FINAL)) final_norm(C);
}

extern "C" void kernel_launch(void* const* d_in, const int* in_sizes, int n_in, void* d_out, int out_size, void* d_ws, size_t ws_size, hipStream_t stream) {
    static int grid = 0;
    if (grid == 0) {
        if (n_in != N_IN || in_sizes[0] != T_LAT * DM || out_size != T_LAT * DM || ws_size < WS_END) {
            fprintf(stderr, "kernel_launch: unexpected problem (n_in %d, in0 %d, out %d, ws %zu < %zu)\n", n_in, n_in > 0 ? in_sizes[0] : -1, out_size, ws_size, (size_t)WS_END); grid = -1; return; }
        int dev = 0, cus = 0, per_cu = 0;
        if (hipGetDevice(&dev) != hipSuccess || hipDeviceGetAttribute(&cus, hipDeviceAttributeMultiprocessorCount, dev) != hipSuccess) { grid = -1; return; }
        if (hipFuncSetAttribute((const void*)fwd_kernel, hipFuncAttributeMaxDynamicSharedMemorySize, LDS_BYTES) != hipSuccess) { fprintf(stderr, "kernel_launch: hipFuncSetAttribute failed\n"); grid = -1; return; }
        if (hipOccupancyMaxActiveBlocksPerMultiprocessor(&per_cu, (const void*)fwd_kernel, NTHR, LDS_BYTES) != hipSuccess || per_cu < 1) { fprintf(stderr, "kernel_launch: occupancy query says %d\n", per_cu); grid = -1; return; }
        grid = cus;
        if (grid != 256) fprintf(stderr, "kernel_launch: note: %d CUs\n", grid);
    }
    if (grid < 0) return;
    if (hipMemsetAsync((char*)d_ws + WS_CTL, 0, CTL_BYTES, stream) != hipSuccess) return;
    Args a{};
    for (int i = 0; i < N_IN; ++i) a.in[i] = (const float*)d_in[i];
    a.out = (float*)d_out; a.ws = (unsigned char*)d_ws;
#if MK_ONE_LAUNCH
    a.ph_lo = 0; a.ph_hi = NPHASE;
    hipLaunchKernelGGL(fwd_kernel, dim3(grid), dim3(NTHR), LDS_BYTES, stream, a);
#else
    for (int ph = 0; ph < NPHASE; ++ph) { if (!phase_exists(ph)) continue; a.ph_lo = ph; a.ph_hi = ph + 1; hipLaunchKernelGGL(fwd_kernel, dim3(grid), dim3(NTHR), LDS_BYTES, stream, a); }
#endif
}
```

```cpp
#define MK_ONE_LAUNCH 1
#include <hip/hip_runtime.h>
#include <cstdio>
#include <cstdint>

#define GAS __attribute__((address_space(1)))
#define LAS __attribute__((address_space(3)))
typedef unsigned short bf16;
typedef unsigned v4u __attribute__((ext_vector_type(4)));
typedef unsigned v2u __attribute__((ext_vector_type(2)));
typedef float f32x4 __attribute__((ext_vector_type(4)));
typedef float f32x2 __attribute__((ext_vector_type(2)));
typedef short bf16x8 __attribute__((ext_vector_type(8)));
#define LDS_WAIT() asm volatile("s_waitcnt lgkmcnt(0)" ::: "memory")
#define VM_WAIT() asm volatile("s_waitcnt vmcnt(0)" ::: "memory")

constexpr int DM = 1024, NB = 8, SEQ = 4096, DEPTH = 4, CTXL = 256, GW = 256, HD = 64, NH = 4;
constexpr int T_LAT = NB * SEQ, T_CTX = NB * CTXL, T_ALL = T_LAT + T_CTX;
constexpr int IN_COLS = 3552, PLD = 3584;
constexpr int OFF_B = 512, OFF_C = 1472, OFF_D = 2512, B_COLS = 960;
constexpr int DFF = 2816, NE = 8, DFE = 1408;
constexpr int NCH = 68;
constexpr int NSTEP = 4352;
constexpr int MOE_MAXBLK = 280;
constexpr int NWAVES = 8, NTHR = 512;

constexpr size_t MiB = 1u << 20;
constexpr size_t WS_CTL = 0, CTL_BYTES = 1 * MiB;
constexpr size_t WS_MODV = 1 * MiB;
constexpr size_t WS_XC = 2 * MiB;
constexpr size_t WS_WIN = 10 * MiB;
constexpr size_t WS_WOUT = 17 * MiB;
constexpr size_t WS_WGU = 19 * MiB;
constexpr size_t WS_WDN = 63 * MiB;
constexpr size_t WS_HB = 85 * MiB;
constexpr size_t WS_P = 153 * MiB;
constexpr size_t WS_MIX = 391 * MiB;
constexpr size_t WS_OUTB = WS_MIX, WS_OUTC = WS_MIX + 34 * MiB, WS_OUTD = WS_MIX + 68 * MiB, WS_GQ = WS_MIX + 102 * MiB, WS_G = WS_MIX + 153 * MiB;
constexpr size_t WS_RKV = WS_MIX + 170 * MiB;
constexpr size_t WS_SMALL = 612 * MiB;
constexpr size_t WS_LSUM = WS_SMALL;
constexpr size_t WS_HIN = WS_SMALL + 3 * MiB;
constexpr size_t WS_ROUTE = WS_SMALL + 5 * MiB;
constexpr size_t WS_POS = WS_SMALL + 7 * MiB;
constexpr size_t WS_BONUS = WS_SMALL + 8 * MiB;
constexpr size_t WS_WGBASE = WS_SMALL + 9 * MiB;
constexpr size_t WS_TAB = WS_WGBASE + 65536;
constexpr size_t WS_LRUWT = WS_SMALL + 10 * MiB;
constexpr size_t WS_RWT = WS_LRUWT + 131072;
constexpr size_t WS_RINV = WS_SMALL + 11 * MiB;
constexpr size_t WS_END = 624 * MiB;
constexpr int CW_MOECNT = 1024;
constexpr int CW_LRUQ = 2048;
constexpr int CW_BAR = 4096;

constexpr int LDS_BYTES = 135168;
constexpr int MISC_OFF = 131072;

__device__ __forceinline__ unsigned f2bf(float f) { unsigned u = __builtin_bit_cast(unsigned, f); return (u + 0x7fffu + ((u >> 16) & 1u)) >> 16; }
typedef __bf16 bf16n2 __attribute__((ext_vector_type(2)));
__device__ __forceinline__ unsigned pk2(float lo, float hi) { const f32x2 v = {lo, hi}; return __builtin_bit_cast(unsigned, __builtin_convertvector(v, bf16n2)); }
__device__ __forceinline__ unsigned f2bf1(float f) { return pk2(f, f) & 0xffffu; }
__device__ __forceinline__ float bf2f(unsigned short v) { return __builtin_bit_cast(float, (unsigned)v << 16); }
__device__ __forceinline__ float bflo(unsigned v) { return __builtin_bit_cast(float, v << 16); }
__device__ __forceinline__ float bfhi(unsigned v) { return __builtin_bit_cast(float, v & 0xffff0000u); }
__device__ __forceinline__ float wave_sum(float v) {
#pragma unroll
    for (int o = 1; o < 64; o <<= 1) v += __shfl_xor(v, o);
    return v;
}
template <int CTRL> __device__ __forceinline__ float dpp_f(float v) { return __builtin_bit_cast(float, __builtin_amdgcn_update_dpp(0, __builtin_bit_cast(int, v), CTRL, 0xF, 0xF, true)); }
__device__ __forceinline__ float row16_sum(float v) {
    v += dpp_f<0xB1>(v);
    v += dpp_f<0x4E>(v);
    v += dpp_f<0x141>(v);
    v += dpp_f<0x140>(v);
    return v;
}
__device__ __forceinline__ float sigmoidf_(float x) { return 1.0f / (1.0f + __expf(-x)); }
__device__ __forceinline__ float softplusf_(float x) { return fmaxf(x, 0.f) + __logf(1.0f + __expf(-fabsf(x))); }
__device__ __forceinline__ float expm1f_(float x) { return x > -0.3f ? x * (1.0f + x * (0.5f + x * (0.16666667f + x * (0.041666668f + x * 0.0083333338f)))) : __expf(x) - 1.0f; }
__device__ __forceinline__ float siluf_(float x) { return x / (1.0f + __expf(-x)); }
__device__ __forceinline__ float tanhf_(float x) { const float e = __expf(2.0f * x); return 1.0f - 2.0f / (e + 1.0f); }
__device__ __forceinline__ float gelu_tanh(float x) { return 0.5f * x * (1.0f + tanhf_(0.7978845608028654f * (x + 0.044715f * x * x * x))); }
__device__ __forceinline__ f32x4 ld4bf(const bf16* p) { const v2u a = *(const v2u*)p; return (f32x4){bflo(a.x), bfhi(a.x), bflo(a.y), bfhi(a.y)}; }
__device__ __forceinline__ void st4bf(bf16* p, const f32x4& v) { v2u o; o.x = pk2(v.x, v.y); o.y = pk2(v.z, v.w); *(v2u*)p = o; }
#define XB_TMO      128
#define XB_XCNT(j)  (256  + 64 * (j))
#define XB_XSUB(j)  (1280 + 64 * (j))
#define XB_XGEN(j)  (2304 + 64 * (j))
#define XB_TOP      3328
#define XB_TOPGEN   3392
#define XCD_BAR_WORDS 3456
#define XB_SPIN_CAP (1u << 22)

__device__ __forceinline__ unsigned xb_ld(unsigned* p)              { return __hip_atomic_load(p, __ATOMIC_RELAXED, __HIP_MEMORY_SCOPE_AGENT); }
__device__ __forceinline__ unsigned xb_add(unsigned* p, unsigned v) { return __hip_atomic_fetch_add(p, v, __ATOMIC_RELAXED, __HIP_MEMORY_SCOPE_AGENT); }
__device__ __forceinline__ unsigned xb_xcc_id() { return (unsigned)__builtin_amdgcn_s_getreg((3 << 11) | 20) & 0xFu; }
#define XB_SPIN(cond, bar) do { unsigned _sp = 0; while (cond) { __builtin_amdgcn_s_sleep(1); \
    if ((++_sp & 255u) == 0u) { if (xb_ld(&(bar)[XB_TMO])) break; if (_sp > XB_SPIN_CAP) { atomicAdd(&(bar)[XB_TMO], 1u); break; } } } } while (0)

struct XcdBarrier {
    unsigned* bar; unsigned x;
    volatile LAS unsigned* st;
};

__device__ __forceinline__ XcdBarrier xcd_barrier_post(unsigned* bar, volatile LAS unsigned* st) {
    XcdBarrier b; b.bar = bar; b.x = xb_xcc_id(); b.st = st;
    if (threadIdx.x == 0) (void)xb_add(&bar[XB_XCNT(b.x)], 1u);
    return b;
}
__device__ __forceinline__ void xcd_barrier_complete(unsigned* bar, unsigned x, unsigned& nloc, unsigned& nx) {
    const unsigned G = gridDim.x * gridDim.y * gridDim.z;
    unsigned sum, cnt, mine, sp = 0u;
    for (;;) {
        sum = 0u; cnt = 0u; mine = 0u;
#pragma unroll
        for (unsigned j = 0; j < 16; ++j) { const unsigned c = xb_ld(&bar[XB_XCNT(j)]); sum += c; cnt += (c > 0u) ? 1u : 0u; mine = (j == x) ? c : mine; }
        if (sum == G) break;
        __builtin_amdgcn_s_sleep(1);
        if ((++sp & 255u) == 0u) { if (xb_ld(&bar[XB_TMO])) break; if (sp > XB_SPIN_CAP) { atomicAdd(&bar[XB_TMO], 1u); break; } }
    }
    nloc = mine > 0u ? mine : 1u; nx = cnt > 0u ? cnt : 1u;
}

__device__ __forceinline__ void xcd_barrier(const XcdBarrier& b) {
    asm volatile("s_waitcnt vmcnt(0)" ::: "memory");
    __syncthreads();
    if (threadIdx.x == 0) {
        unsigned* bar = b.bar;
        __builtin_amdgcn_s_waitcnt(0);
        unsigned nloc = b.st[0], nx = b.st[1];
        if (nloc == 0u) { xcd_barrier_complete(bar, b.x, nloc, nx); b.st[0] = nloc; b.st[1] = nx; }
        const unsigned old = xb_add(&bar[XB_XSUB(b.x)], 1u);
        const unsigned gen = old / nloc;
        if (old + 1u == (gen + 1u) * nloc) {
            __builtin_amdgcn_fence(__ATOMIC_RELEASE, "agent");
            asm volatile("s_waitcnt vmcnt(0)" ::: "memory");
            const unsigned og = xb_add(&bar[XB_TOP], 1u);
            const unsigned tg = og / nx;
            if (og + 1u == (tg + 1u) * nx) xb_add(&bar[XB_TOPGEN], 1u);
            else XB_SPIN(xb_ld(&bar[XB_TOPGEN]) == tg, bar);
            __builtin_amdgcn_fence(__ATOMIC_ACQUIRE, "agent");
            xb_add(&bar[XB_XGEN(b.x)], 1u);
            asm volatile("s_waitcnt vmcnt(0)" ::: "memory");
        } else {
            XB_SPIN(xb_ld(&bar[XB_XGEN(b.x)]) == gen, bar);
            __builtin_amdgcn_fence(__ATOMIC_ACQUIRE, "agent");
            asm volatile("s_waitcnt vmcnt(0)" ::: "memory");
        }
    }
    __syncthreads();
}

namespace pg8 {
#define PG8_LAS __attribute__((address_space(3)))
typedef unsigned short bf16_t;
typedef short bf16x8 __attribute__((ext_vector_type(8)));
typedef float f32x4 __attribute__((ext_vector_type(4)));
typedef unsigned u32x4 __attribute__((ext_vector_type(4)));
constexpr int BM = 256, BK = 64, HALF = 128, HTB = HALF * BK * 2  , STAGE_BYTES = 8 * HTB, NXCD = 8, WGM = 8;

__host__ __device__ __forceinline__ int lds_byte(int r, int c) { const int st = (r >> 4) * 2 + (c >> 5), rr = r & 15, cc = c & 31, ob = rr * 64 + cc * 2; return st * 1024 + (ob ^ (((ob >> 9) & 1) << 5)); }
__host__ __device__ __forceinline__ void stage_rc(int b, int& R, int& C) { const int st = b / 1024, sb = b % 1024, swz = sb ^ (((sb >> 9) & 1) << 5); R = (st >> 1) * 16 + swz / 64; C = (st & 1) * 32 + (swz % 64) / 2; }
__host__ __device__ __forceinline__ int perm32(int rho) { const int n = rho >> 4, i = rho & 15; return 8 * (i >> 2) + 4 * n + (i & 3); }

struct Unit { int pm, pn, e; };
struct Gemm { const bf16_t* A; const bf16_t* Bt; int M, N, K; size_t estride; };

struct StaticOrder {
    int nM, nN, nwg, G, c;
    __host__ __device__ void init(int M, int N, int G_, int c_) { nM = M / BM; nN = N / BM; nwg = nM * nN; G = G_; c = c_; }
    __host__ __device__ bool next(int i, Unit& u) const {
        const long L = (long)i * G + c; if (L >= nwg) return false;
        int wgid = (int)L; { const int q = nwg / NXCD, r = nwg % NXCD, xcd = wgid % NXCD, off = wgid / NXCD; wgid = (xcd < r ? xcd * (q + 1) : r * (q + 1) + (xcd - r) * q) + off; }
        const int nig = WGM * nN, gid = wgid / nig, fm = gid * WGM, gsz = (nM - fm) < WGM ? (nM - fm) : WGM;
        u.pm = fm + ((wgid % nig) % gsz); u.pn = (wgid % nig) / gsz; u.e = 0; return true;
    }
    __device__ __forceinline__ void a_ready(const Unit&) const {}
    __device__ __forceinline__ void done(const Unit&) const {}
};
__device__ __forceinline__ unsigned cvt_pk_bf16(float lo, float hi) { unsigned r; asm volatile("v_cvt_pk_bf16_f32 %0, %1, %2" : "=v"(r) : "v"(lo), "v"(hi)); return r; }
typedef float f32x2 __attribute__((ext_vector_type(2)));
__device__ __forceinline__ f32x2 gelu_pk(f32x2 v) {
    const f32x2 av = __builtin_elementwise_abs(v), d = av * 0.2316418882f + 1.0f;
    f32x2 t; t.x = __builtin_amdgcn_rcpf(d.x); t.y = __builtin_amdgcn_rcpf(d.y);
    f32x2 q = t * 0.5307027145f + (-0.7265760135f); q = q * t + 0.7107068705f; q = q * t + (-0.142248368f); q = q * t + 0.127414796f; q = q * t;
    const f32x2 s = (v * v) * (-0.72134752044f);
    f32x2 e; e.x = __builtin_amdgcn_exp2f(s.x); e.y = __builtin_amdgcn_exp2f(s.y);
    const f32x2 m = v * (q * e), r = v - m;
    f32x2 o; o.x = v.x < 0.f ? m.x : r.x; o.y = v.y < 0.f ? m.y : r.y; return o;
}

struct EpiF32 {
    static constexpr bool PERM = false, AFTER_DRAIN = false;
    float* C; int ldc; const float* bias;
    __device__ __forceinline__ void operator()(const f32x4 (&acc)[2][2][4][2], const Unit& u, int wr, int wc, int fr, int fq) const {
        const int row0 = u.pm * BM + wr * 64 + fr, col0 = u.pn * BM + wc * 32 + 4 * fq;
        f32x4 bv[2][2];
#pragma unroll
        for (int bj = 0; bj < 2; ++bj)
#pragma unroll
            for (int n = 0; n < 2; ++n) bv[bj][n] = bias ? *(const f32x4*)(bias + col0 + bj * HALF + n * 16) : (f32x4){0.f, 0.f, 0.f, 0.f};
#pragma unroll
        for (int ai = 0; ai < 2; ++ai)
#pragma unroll
            for (int m = 0; m < 4; ++m) { float* rowp = C + (size_t)(row0 + ai * HALF + m * 16) * ldc + col0;
#pragma unroll
                for (int bj = 0; bj < 2; ++bj)
#pragma unroll
                    for (int n = 0; n < 2; ++n) *(f32x4*)(rowp + bj * HALF + n * 16) = acc[ai][bj][m][n] + bv[bj][n]; }
    }
};
template <int ACT  > struct EpiBf16 {
    static constexpr bool PERM = true, AFTER_DRAIN = false;
    bf16_t* O; int ldc; const float* bias; int split_cols; size_t split_stride;
    __device__ __forceinline__ void operator()(const f32x4 (&acc)[2][2][4][2], const Unit& u, int wr, int wc, int fr, int fq) const {
        const int row0 = u.pm * BM + wr * 64 + fr; int colt = u.pn * BM; bf16_t* base = O;
        if (split_cols) { const int t = colt / split_cols; base += (size_t)t * split_stride; colt -= t * split_cols; }
        const int col0 = colt + wc * 32 + 8 * fq, bcol0 = u.pn * BM + wc * 32 + 8 * fq;
        f32x4 bv[2][2];
#pragma unroll
        for (int bj = 0; bj < 2; ++bj)
#pragma unroll
            for (int n = 0; n < 2; ++n) bv[bj][n] = bias ? *(const f32x4*)(bias + bcol0 + bj * HALF + 4 * n) : (f32x4){0.f, 0.f, 0.f, 0.f};
#pragma unroll
        for (int ai = 0; ai < 2; ++ai)
#pragma unroll
            for (int m = 0; m < 4; ++m) { bf16_t* rowp = base + (size_t)(row0 + ai * HALF + m * 16) * ldc + col0;
#pragma unroll
                for (int bj = 0; bj < 2; ++bj) { f32x4 v0 = acc[ai][bj][m][0] + bv[bj][0], v1 = acc[ai][bj][m][1] + bv[bj][1];
                    if (ACT == 1) { f32x2 a = gelu_pk((f32x2){v0[0], v0[1]}), b = gelu_pk((f32x2){v0[2], v0[3]}), c = gelu_pk((f32x2){v1[0], v1[1]}), d = gelu_pk((f32x2){v1[2], v1[3]});
                        v0 = (f32x4){a.x, a.y, b.x, b.y}; v1 = (f32x4){c.x, c.y, d.x, d.y}; }
                    if (ACT == 2) {
#pragma unroll
                        for (int j = 0; j < 4; ++j) { v0[j] = 0.5f * v0[j] * (1.0f + erff(v0[j] * 0.70710678f)); v1[j] = 0.5f * v1[j] * (1.0f + erff(v1[j] * 0.70710678f)); } }
                    u32x4 w; w.x = cvt_pk_bf16(v0[0], v0[1]); w.y = cvt_pk_bf16(v0[2], v0[3]); w.z = cvt_pk_bf16(v1[0], v1[1]); w.w = cvt_pk_bf16(v1[2], v1[3]);
                    *(u32x4*)(rowp + bj * HALF) = w; } }
    }
};

template <class Epi, class Sched, bool STAMP = false>
__device__ __forceinline__ void gemm_phase(PG8_LAS unsigned char* lds, const Gemm g, const Sched& S, const Epi& E, unsigned long long* stamps) {
    int tid_ = threadIdx.x; asm volatile("" : "+v"(tid_));
    const int tid = tid_, wid = __builtin_amdgcn_readfirstlane(tid >> 6), lane = tid & 63, wr = wid >> 2, wc = wid & 3, fr = lane & 15, fq = lane >> 4;
    const int K = g.K, nt = K / BK;
    int ts_lo = 0, ts_hi = 0, nts = 0; const unsigned long long rt_entry = STAMP ? (unsigned long long)wall_clock64() : 0ull;
#define PG8_STAMP() do { if (STAMP && wid == 0 && nts < 64) { const unsigned long long _c = (unsigned long long)clock64(); \
        ts_lo = (lane == nts) ? (int)(unsigned)_c : ts_lo; ts_hi = (lane == nts) ? (int)(unsigned)(_c >> 32) : ts_hi; ++nts; } } while (0)
    PG8_STAMP();
    unsigned voffA[2], voffB[2];
#pragma unroll
    for (int i = 0; i < 2; ++i) { int R, C; stage_rc(tid * 16 + i * 8192, R, C); const int Rb = Epi::PERM ? ((R & ~31) + perm32(R & 31)) : R;
        voffA[i] = (unsigned)(R * K + C) * 2u; voffB[i] = (unsigned)(Rb * K + C) * 2u; }
    const size_t kstep = (size_t)(BK * 2);
    const size_t hstep = (size_t)HALF * K * 2;
    const size_t tstep = 2 * hstep;
    const unsigned ldsw = (unsigned)wid * 1024u;
    const int aoff = lds_byte(wr * 64 + fr, fq * 8), boff = lds_byte(wc * 32 + fr, fq * 8);
#define PG8_SA(b, h) (((b) * 2 + (h)) * HTB)
#define PG8_SB(b, h) ((4 + (b) * 2 + (h)) * HTB)
#define PG8_STAGE(bufoff, gbase, voff) do { _Pragma("unroll") for (int _i = 0; _i < 2; ++_i) \
        __builtin_amdgcn_global_load_lds((const unsigned*)((const char*)(gbase) + (voff)[_i]), (PG8_LAS unsigned*)(lds + (bufoff) + ldsw + _i * 8192), 16, 0, 0); } while (0)
#define PG8_LDA(dst, b, h) do { _Pragma("unroll") for (int m = 0; m < 4; ++m) _Pragma("unroll") for (int k = 0; k < 2; ++k) dst[m][k] = *(const PG8_LAS bf16x8*)(lds + PG8_SA(b, h) + aoff + m * 2048 + k * 1024); } while (0)
#define PG8_LDB(dst, b, h) do { _Pragma("unroll") for (int n = 0; n < 2; ++n) _Pragma("unroll") for (int k = 0; k < 2; ++k) dst[n][k] = *(const PG8_LAS bf16x8*)(lds + PG8_SB(b, h) + boff + n * 2048 + k * 1024); } while (0)
#define PG8_MMA(ai, bj, At, Bt) do { __builtin_amdgcn_s_setprio(1); _Pragma("unroll") for (int m = 0; m < 4; ++m) _Pragma("unroll") for (int n = 0; n < 2; ++n) _Pragma("unroll") for (int k = 0; k < 2; ++k) \
        acc[ai][bj][m][n] = __builtin_amdgcn_mfma_f32_16x16x32_bf16(Bt[n][k], At[m][k], acc[ai][bj][m][n], 0, 0, 0); __builtin_amdgcn_s_setprio(0); } while (0)
#define PG8_WAIT_V(n) asm volatile("s_waitcnt vmcnt(" #n ")" ::: "memory")
#define PG8_WAIT_L(n) asm volatile("s_waitcnt lgkmcnt(" #n ")" ::: "memory")
#define PG8_BAR __builtin_amdgcn_s_barrier()
#define PG8_SCHED __builtin_amdgcn_sched_barrier(0)
    Unit cur, nxt; int ui = 0;
    if (!S.next(0, cur)) return;
    f32x4 acc[2][2][4][2];
#pragma unroll
    for (int a = 0; a < 2; ++a)
#pragma unroll
        for (int b = 0; b < 2; ++b)
#pragma unroll
            for (int m = 0; m < 4; ++m)
#pragma unroll
                for (int n = 0; n < 2; ++n) acc[a][b][m][n] = (f32x4){0.f, 0.f, 0.f, 0.f};
    bf16x8 At[4][2], B0[2][2], B1[2][2];
    const char* cA = (const char*)g.A + (size_t)cur.pm * tstep; const char* cB = (const char*)g.Bt + (size_t)cur.pn * tstep + (size_t)cur.e * g.estride * 2;
    S.a_ready(cur);
    PG8_STAGE(PG8_SB(0, 0), cB, voffB); PG8_STAGE(PG8_SA(0, 0), cA, voffA); PG8_STAGE(PG8_SB(0, 1), cB + hstep, voffB); PG8_STAGE(PG8_SA(0, 1), cA + hstep, voffA);
    if (wr == 1) PG8_BAR;
    PG8_WAIT_V(4); PG8_BAR;
    PG8_STAGE(PG8_SB(1, 0), cB + kstep, voffB); PG8_STAGE(PG8_SA(1, 0), cA + kstep, voffA); PG8_STAGE(PG8_SB(1, 1), cB + hstep + kstep, voffB);
    PG8_WAIT_V(6); PG8_BAR;
    PG8_STAMP();
    for (;;) {
        const bool has_next = S.next(ui + 1, nxt);
        const char* nA = has_next ? (const char*)g.A + (size_t)nxt.pm * tstep : cA; const char* nB = has_next ? (const char*)g.Bt + (size_t)nxt.pn * tstep + (size_t)nxt.e * g.estride * 2 : cB;
        for (int t = 0; t < nt; t += 2) {
            const bool last = (t == nt - 2);
            const char* a1 = cA + (size_t)(t + 1) * kstep;
            const char* a2 = last ? nA : cA + (size_t)(t + 2) * kstep; const char* b2 = last ? nB : cB + (size_t)(t + 2) * kstep;
            const char* a3 = a2 + kstep; const char* b3 = b2 + kstep;
            if (last && has_next) S.a_ready(nxt);
            PG8_LDB(B0, 0, 0); PG8_SCHED; PG8_LDA(At, 0, 0); PG8_STAGE(PG8_SA(1, 1), a1 + hstep, voffA);
            PG8_WAIT_L(8); PG8_BAR; PG8_WAIT_L(0); PG8_MMA(0, 0, At, B0); PG8_BAR; PG8_SCHED;
            PG8_LDB(B1, 0, 1); PG8_STAGE(PG8_SB(0, 0), b2, voffB);
            PG8_BAR; PG8_WAIT_L(0); PG8_MMA(0, 1, At, B1); PG8_BAR;
            PG8_LDA(At, 0, 1); PG8_STAGE(PG8_SA(0, 0), a2, voffA);
            PG8_BAR; PG8_WAIT_L(0); PG8_MMA(1, 0, At, B0); PG8_BAR; PG8_SCHED;
            PG8_STAGE(PG8_SB(0, 1), b2 + hstep, voffB);
            PG8_WAIT_V(6); PG8_BAR; PG8_MMA(1, 1, At, B1); PG8_BAR;
            PG8_LDB(B0, 1, 0); PG8_SCHED; PG8_LDA(At, 1, 0); PG8_STAGE(PG8_SA(0, 1), a2 + hstep, voffA);
            PG8_WAIT_L(8); PG8_BAR; PG8_WAIT_L(0); PG8_MMA(0, 0, At, B0); PG8_BAR; PG8_SCHED;
            PG8_LDB(B1, 1, 1); PG8_STAGE(PG8_SB(1, 0), b3, voffB);
            PG8_BAR; PG8_WAIT_L(0); PG8_MMA(0, 1, At, B1); PG8_BAR;
            PG8_LDA(At, 1, 1); PG8_STAGE(PG8_SA(1, 0), a3, voffA);
            PG8_BAR; PG8_WAIT_L(0); PG8_MMA(1, 0, At, B0); PG8_BAR; PG8_SCHED;
            PG8_STAGE(PG8_SB(1, 1), b3 + hstep, voffB);
            PG8_WAIT_V(6); PG8_BAR; PG8_MMA(1, 1, At, B1); PG8_BAR;
        }
        PG8_STAMP();
        if constexpr (!Epi::AFTER_DRAIN) { E(acc, cur, wr, wc, fr, fq); S.done(cur); }
        PG8_STAMP();
        if (!has_next) break;
#pragma unroll
        for (int a = 0; a < 2; ++a)
#pragma unroll
            for (int b = 0; b < 2; ++b)
#pragma unroll
                for (int m = 0; m < 4; ++m)
#pragma unroll
                    for (int n = 0; n < 2; ++n) acc[a][b][m][n] = (f32x4){0.f, 0.f, 0.f, 0.f};
        cur = nxt; cA = nA; cB = nB; ++ui;
    }
    PG8_WAIT_V(0);
    if (wr == 0) PG8_BAR;
    PG8_BAR;
    if constexpr (Epi::AFTER_DRAIN) { E.fused(acc, cur, wr, wc, fr, fq, lds, wid, lane); S.done(cur); }
    PG8_STAMP();
    if (STAMP && wid == 0) { stamps[lane] = lane < nts ? (((unsigned long long)(unsigned)ts_hi << 32) | (unsigned)ts_lo) : 0ull;
        if (lane == 62) stamps[62] = rt_entry; if (lane == 63) stamps[63] = (unsigned long long)wall_clock64(); }
#undef PG8_STAMP
#undef PG8_SA
#undef PG8_SB
#undef PG8_STAGE
#undef PG8_LDA
#undef PG8_LDB
#undef PG8_MMA
#undef PG8_WAIT_V
#undef PG8_WAIT_L
#undef PG8_BAR
#undef PG8_SCHED
}
}
namespace pg8 {
struct EpiRes {
    static constexpr bool PERM = false, AFTER_DRAIN = false;
    const float* base_lat; const float* base_ctx; float* out_lat; float* out_ctx; const float* gvec;
    __device__ __forceinline__ void operator()(const f32x4 (&acc)[2][2][4][2], const Unit& u, int wr, int wc, int fr, int fq) const {
        const bool isctx = u.pm >= 128;
        const int prow = (isctx ? (u.pm - 128) : u.pm) * BM;
        const float* base = isctx ? base_ctx : base_lat; float* out = isctx ? out_ctx : out_lat;
        const float* gv = gvec + (size_t)(isctx ? 8 : (u.pm >> 4)) * 6144;
        const int row0 = prow + wr * 64 + fr, col0 = u.pn * BM + wc * 32 + 4 * fq;
        f32x4 gvv[2][2];
#pragma unroll
        for (int bj = 0; bj < 2; ++bj)
#pragma unroll
            for (int n = 0; n < 2; ++n) gvv[bj][n] = *(const f32x4*)(gv + col0 + bj * HALF + n * 16);
#pragma unroll
        for (int ai = 0; ai < 2; ++ai)
#pragma unroll
            for (int m = 0; m < 4; ++m) { const size_t off = (size_t)(row0 + ai * HALF + m * 16) * 1024 + col0;
#pragma unroll
                for (int bj = 0; bj < 2; ++bj)
#pragma unroll
                    for (int n = 0; n < 2; ++n) { const f32x4 b = *(const f32x4*)(base + off + bj * HALF + n * 16);
                        *(f32x4*)(out + off + bj * HALF + n * 16) = b + gvv[bj][n] * acc[ai][bj][m][n]; } }
    }
};
struct EpiSwiglu {
    static constexpr bool PERM = true, AFTER_DRAIN = false;
    bf16_t* O; int ldc;
    __device__ __forceinline__ void operator()(const f32x4 (&acc)[2][2][4][2], const Unit& u, int wr, int wc, int fr, int fq) const {
        const int row0 = u.pm * BM + wr * 64 + fr, col0 = u.pn * HALF + wc * 32 + 8 * fq;
#pragma unroll
        for (int ai = 0; ai < 2; ++ai)
#pragma unroll
            for (int m = 0; m < 4; ++m) { bf16_t* rowp = O + (size_t)(row0 + ai * HALF + m * 16) * ldc + col0;
                float h[8];
#pragma unroll
                for (int n = 0; n < 2; ++n)
#pragma unroll
                    for (int j = 0; j < 4; ++j) { const float g = acc[ai][0][m][n][j], up = acc[ai][1][m][n][j]; h[n * 4 + j] = g * __builtin_amdgcn_rcpf(1.0f + __expf(-g)) * up; }
                u32x4 w; w.x = cvt_pk_bf16(h[0], h[1]); w.y = cvt_pk_bf16(h[2], h[3]); w.z = cvt_pk_bf16(h[4], h[5]); w.w = cvt_pk_bf16(h[6], h[7]);
                *(u32x4*)rowp = w; }
    }
};
struct MoeOrder {
    int nN, G, c, nunits; const int* tab;
    __device__ void init(const int* tab_, int nN_, int G_, int c_) { tab = tab_; nN = nN_; G = G_; c = c_; nunits = tab_[0] * nN_; }
    __device__ bool next(int i, Unit& u) const {
        const int L = i * G + c; if (L >= nunits) return false;
        u.pm = L / nN; u.pn = L - u.pm * nN; u.e = tab[1 + u.pm]; return true;
    }
    __device__ __forceinline__ void a_ready(const Unit&) const {}
    __device__ __forceinline__ void done(const Unit&) const {}
};
}
enum { I_X = 0, I_C, I_CTX, I_CCTX, I_MODW, I_MODB, I_NMIXG, I_NFFNG, I_WIN, I_WOUT, I_LCW, I_LCB, I_LWA, I_LBA, I_LWX, I_LBX, I_LLAM,
       I_RMU, I_RWUP, I_RW0, I_RAUP, I_RA0, I_RGUP, I_RKK, I_RKA, I_RRK, I_RLNG, I_RLNB, I_MIB, I_MFB, I_MNG, I_GCW, I_GALOG, I_GDTB, I_GNG,
       I_FWG, I_FWU, I_FWD, I_MROUTER, I_MWG, I_MWU, I_MWD, I_FNG, N_IN };
struct Args { const float* in[N_IN]; float* out; unsigned char* ws; int ph_lo, ph_hi; };
struct Ctx {
    const float* const* in; float* out; unsigned char* ws; LAS unsigned char* lds;
    int tid, lane, wave, G, wg;
};
#define WSP(T, off) ((T*)(C.ws + (off)))

__device__ __forceinline__ int seqrow_raster(int i, int d, int b) {
    if (i < CTXL) { const int p = d ? (CTXL - 1 - i) : i; return T_LAT + b * CTXL + p; }
    const int j = i - CTXL; const int p = d ? (SEQ - 1 - j) : j; return b * SEQ + p;
}
__device__ __forceinline__ int seqrow_cm(int i, int d, int b) {
    if (i < CTXL) { const int p = d ? (CTXL - 1 - i) : i; return T_LAT + b * CTXL + p; }
    const int j = i - CTXL; const int p = d ? (SEQ - 1 - j) : j; return b * SEQ + (p & 63) * 64 + (p >> 6);
}

__device__ __forceinline__ void phase_pre(const Ctx& C) {
    LAS float* sc = (LAS float*)C.lds;
    LAS float* red = sc + 9 * 1024;
    float* modv = WSP(float, WS_MODV);
    bool filled = false;
    for (int it = C.wg; it < DEPTH * 48; it += C.G) {
        if (!filled) {
            for (int i = C.tid; i < 9 * 1024; i += NTHR) { const float v = i < 8192 ? C.in[I_C][i] : C.in[I_CCTX][i - 8192]; sc[i] = siluf_(v); }
            filled = true; __syncthreads();
        }
        const int l = it / 48, jb = it % 48, col = C.tid & 127, kg = C.tid >> 7;
        const float* W = C.in[I_MODW] + (size_t)l * 1024 * 6144 + jb * 128 + col;
        float acc[9];
#pragma unroll
        for (int r = 0; r < 9; ++r) acc[r] = 0.f;
        for (int k = kg * 256; k < kg * 256 + 256; ++k) { const float w = W[(size_t)k * 6144];
#pragma unroll
            for (int r = 0; r < 9; ++r) acc[r] += sc[r * 1024 + k] * w; }
#pragma unroll
        for (int r = 0; r < 9; ++r) red[(kg * 9 + r) * 128 + col] = acc[r];
        __syncthreads();
        for (int i = C.tid; i < 9 * 128; i += NTHR) { const int r = i >> 7, cc = i & 127;
            const float s = red[(0 * 9 + r) * 128 + cc] + red[(1 * 9 + r) * 128 + cc] + red[(2 * 9 + r) * 128 + cc] + red[(3 * 9 + r) * 128 + cc];
            modv[((size_t)l * 9 + r) * 6144 + jb * 128 + cc] = s + C.in[I_MODB][l * 6144 + jb * 128 + cc]; }
        __syncthreads();
    }
}

__device__ __forceinline__ void tr_item(const float* src, size_t ld, int k0, int ns0, bf16* dst, int drow0, int Kd, LAS float* scr, int lane, bool zero) {
    if (!zero) {
#pragma unroll 8
        for (int i = 0; i < 32; ++i) { const int kk = 2 * i + (lane >> 5); scr[kk * 33 + (lane & 31)] = src[(size_t)(k0 + kk) * ld + ns0 + (lane & 31)]; }
    }
    LDS_WAIT(); asm volatile("" ::: "memory");
    const int c = lane & 7;
#pragma unroll
    for (int j = 0; j < 4; ++j) { const int n = (lane >> 3) + 8 * j; const LAS float* s = scr + (8 * c) * 33 + n;
        v4u o; o.x = pk2(s[0 * 33], s[1 * 33]); o.y = pk2(s[2 * 33], s[3 * 33]); o.z = pk2(s[4 * 33], s[5 * 33]); o.w = pk2(s[6 * 33], s[7 * 33]);
        if (zero) o = (v4u){0u, 0u, 0u, 0u};
        *(v4u*)(dst + (size_t)(drow0 + n) * Kd + k0 + 8 * c) = o; }
    LDS_WAIT(); asm volatile("" ::: "memory");
}
__device__ __forceinline__ void convert_small(const Ctx& C, int l) {
    {
        bf16* lw = WSP(bf16, WS_LRUWT);
        for (int k = 0; k < 2 * 2 * 4 * 4096 / (128 * NTHR); ++k) {
            const int e = k * 128 * NTHR + C.wg * NTHR + C.tid;
            if (C.wg < 128) {
            const int i = e & 63, j = (e >> 6) & 63, hd = (e >> 12) & 3, g = (e >> 14) & 1, d = e >> 15;
            const float* src = (g ? C.in[I_LWX] : C.in[I_LWA]) + ((size_t)((l * 2 + d) * 4 + hd) * 64 + i) * 64 + j;
            lw[e] = (bf16)f2bf(*src);
            }
        }
    }
    if (C.wg >= 128 && C.wg < 224) {
        bf16* rw = WSP(bf16, WS_RWT);
        const int e = (C.wg - 128) * NTHR + C.tid;
        if (e < 32768) { const int r = e & 31, ch = (e >> 5) & 255, d = (e >> 13) & 1, isa = e >> 14;
            rw[e] = (bf16)f2bf((isa ? C.in[I_RAUP] : C.in[I_RWUP])[((size_t)(l * 2 + d) * 32 + r) * GW + ch]); }
        else { const int e2 = e - 32768, j = e2 & 63, ch = e2 >> 6; rw[e] = (bf16)f2bf(C.in[I_RGUP][((size_t)l * 64 + j) * GW + ch]); }
    }
}
__device__ __forceinline__ void convert_items(const Ctx& C, int l, int what, int gw, int NGW) {
    LAS float* scr = (LAS float*)(C.lds + C.wave * 8704);
    constexpr int I_IN = 16 * 112, I_OUT = 16 * 32, I_GU = 16 * 176, I_DN = 44 * 32, I_E = 16 * 88 + 22 * 32;
    const bool moe = l & 1; const int li = l >> 1;
    const int lo_it = (what & 1) ? 0 : I_IN, hi_it = (what & 2) ? I_IN + I_OUT + (moe ? NE * I_E : (I_GU + I_DN)) : I_IN;
    bf16* win = WSP(bf16, WS_WIN); bf16* wout = WSP(bf16, WS_WOUT); bf16* wgu = WSP(bf16, WS_WGU); bf16* wdn = WSP(bf16, WS_WDN);
    for (int it = lo_it + gw; it < hi_it; it += NGW) {
        int r = it;
        if (r < I_IN) { const int kb = r / 112, nb = r % 112; tr_item(C.in[I_WIN] + (size_t)l * 1024 * IN_COLS, IN_COLS, 64 * kb, 32 * nb, win, 32 * nb, 1024, scr, C.lane, nb == 111); continue; }
        r -= I_IN;
        if (r < I_OUT) { const int kb = r / 32, nb = r % 32; tr_item(C.in[I_WOUT] + (size_t)l * 1024 * 1024, 1024, 64 * kb, 32 * nb, wout, 32 * nb, 1024, scr, C.lane, false); continue; }
        r -= I_OUT;
        if (!moe) {
            if (r < I_GU) { const int kb = r / 176, nb = r % 176, tile = nb >> 3, q = nb & 7;
                const float* src = (q < 4 ? C.in[I_FWG] : C.in[I_FWU]) + (size_t)li * 1024 * DFF;
                tr_item(src, DFF, 64 * kb, tile * 128 + (q & 3) * 32, wgu, 32 * nb, 1024, scr, C.lane, false); continue; }
            r -= I_GU;
            { const int kb = r / 32, nb = r % 32; tr_item(C.in[I_FWD] + (size_t)li * DFF * 1024, 1024, 64 * kb, 32 * nb, wdn, 32 * nb, DFF, scr, C.lane, false); }
        } else {
            const int e = r / I_E; int rr = r % I_E;
            if (rr < 16 * 88) { const int kb = rr / 88, nb = rr % 88, tile = nb >> 3, q = nb & 7;
                const float* src = (q < 4 ? C.in[I_MWG] : C.in[I_MWU]) + ((size_t)li * NE + e) * 1024 * DFE;
                tr_item(src, DFE, 64 * kb, tile * 128 + (q & 3) * 32, wgu + (size_t)e * 2 * DFE * 1024, 32 * nb, 1024, scr, C.lane, false); continue; }
            rr -= 16 * 88;
            { const int kb = rr / 32, nb = rr % 32; tr_item(C.in[I_MWD] + ((size_t)li * NE + e) * DFE * 1024, 1024, 64 * kb, 32 * nb, wdn + (size_t)e * 1024 * DFE, 32 * nb, DFE, scr, C.lane, false); }
        }
    }
}

template <bool ROUTE>
__device__ __forceinline__ void norm_rows(const Ctx& C, int l, const float* xlat, const float* xctx, const float* gain, int shoff, int scoff, int nrows, int moe_li) {
    const float* modv = WSP(float, WS_MODV) + (size_t)l * 9 * 6144;
    bf16* hb = WSP(bf16, WS_HB);
    const int gw = C.wg * NWAVES + C.wave, NGW = C.G * NWAVES;
    LAS unsigned* lcnt = (LAS unsigned*)(C.lds + 65536);
    unsigned* route = WSP(unsigned, WS_ROUTE);
    if (ROUTE) { if (C.tid < 8) lcnt[C.tid] = 0u; __syncthreads(); }
    f32x4 gv[4];
#pragma unroll
    for (int j = 0; j < 4; ++j) gv[j] = *(const f32x4*)(gain + 4 * C.lane + 256 * j);
    for (int m = gw; m < nrows; m += NGW) {
        const bool isctx = m >= T_LAT;
        const float* xr = isctx ? xctx + (size_t)(m - T_LAT) * 1024 : xlat + (size_t)m * 1024;
        const float* mv = modv + (size_t)(isctx ? 8 : (m >> 12)) * 6144;
        f32x4 v[4]; float s = 0.f;
#pragma unroll
        for (int j = 0; j < 4; ++j) { v[j] = *(const f32x4*)(xr + 4 * C.lane + 256 * j); s += (v[j].x * v[j].x + v[j].y * v[j].y) + (v[j].z * v[j].z + v[j].w * v[j].w); }
        const float rs = 1.0f / sqrtf(wave_sum(s) * (1.0f / 1024.0f) + 1e-6f);
#pragma unroll
        for (int j = 0; j < 4; ++j) { const f32x4 sh = *(const f32x4*)(mv + shoff + 4 * C.lane + 256 * j), scl = *(const f32x4*)(mv + scoff + 4 * C.lane + 256 * j);
            v[j] = (v[j] * rs * gv[j]) * (scl + 1.0f) + sh;
            v2u o; o.x = pk2(v[j].x, v[j].y); o.y = pk2(v[j].z, v[j].w);
            *(v2u*)(hb + (size_t)m * 1024 + 4 * C.lane + 256 * j) = o; }
        if (ROUTE) {
            const float* rt = C.in[I_MROUTER] + (size_t)moe_li * 1024 * NE;
            float lg[8];
#pragma unroll
            for (int e = 0; e < 8; ++e) lg[e] = 0.f;
#pragma unroll
            for (int j = 0; j < 4; ++j)
#pragma unroll
                for (int q = 0; q < 4; ++q) { const int k = 4 * C.lane + 256 * j + q; const f32x4 r0 = *(const f32x4*)(rt + (size_t)k * 8), r1 = *(const f32x4*)(rt + (size_t)k * 8 + 4); const float hv = v[j][q];
                    lg[0] += hv * r0.x; lg[1] += hv * r0.y; lg[2] += hv * r0.z; lg[3] += hv * r0.w; lg[4] += hv * r1.x; lg[5] += hv * r1.y; lg[6] += hv * r1.z; lg[7] += hv * r1.w; }
#pragma unroll
            for (int e = 0; e < 8; ++e) lg[e] = wave_sum(lg[e]);
            int e0 = 0; float l0 = lg[0];
#pragma unroll
            for (int e = 1; e < 8; ++e) if (lg[e] > l0) { l0 = lg[e]; e0 = e; }
            int e1 = -1; float l1 = -3.0e38f;
#pragma unroll
            for (int e = 0; e < 8; ++e) if (e != e0 && lg[e] > l1) { l1 = lg[e]; e1 = e; }
            const float w0 = 1.0f / (1.0f + __expf(l1 - l0)), w1 = 1.0f - w0;
            if (C.lane == 0) {
                const unsigned r0 = atomicAdd((unsigned*)&lcnt[e0], 1u), r1 = atomicAdd((unsigned*)&lcnt[e1], 1u);
                v4u a; a.x = (unsigned)e0; a.y = (unsigned)e1; a.z = r0; a.w = r1;
                *(v4u*)(route + (size_t)m * 8) = a;
                v2u b; b.x = __builtin_bit_cast(unsigned, w0); b.y = __builtin_bit_cast(unsigned, w1);
                *(v2u*)(route + (size_t)m * 8 + 4) = b;
            }
        }
    }
    if (ROUTE) {
        __syncthreads();
        if (C.tid < 8) { unsigned* gc = WSP(unsigned, WS_CTL) + CW_MOECNT + 64 * moe_li; const unsigned base = atomicAdd(gc + C.tid, lcnt[C.tid]); WSP(unsigned, WS_WGBASE)[C.wg * 8 + C.tid] = base; }
    }
}
template <bool FIN>
__device__ __forceinline__ void lru_chunk(const Ctx& C, int l, int b, int c) {
    LAS float* U = (LAS float*)C.lds;
    const bf16* P = WSP(const bf16, WS_P);
    const bool isctx = c < 4; const int p0 = isctx ? c * 64 : (c - 4) * 64; const int Lp = isctx ? CTXL : SEQ; const int row0 = isctx ? T_LAT + b * CTXL : b * SEQ;
    const int ch = C.tid & 255, half = C.tid >> 8;
    {
        const float* cw = C.in[I_LCW] + (size_t)l * 4 * GW + ch; const float w0 = cw[0], w1 = cw[GW], w2 = cw[2 * GW], w3 = cw[3 * GW], cb = C.in[I_LCB][l * GW + ch];
        const int t0 = half * 32;
        auto ld = [&](int p) -> float { return (p >= 0 && p < Lp) ? bf2f(P[(size_t)(row0 + p) * PLD + ch]) : 0.f; };
        float xm2 = ld(p0 + t0 - 2), xm1 = ld(p0 + t0 - 1), x0 = ld(p0 + t0);
        for (int t = 0; t < 32; ++t) { const float xp1 = ld(p0 + t0 + t + 1); U[(t0 + t) * 256 + ch] = w0 * xm2 + w1 * xm1 + w2 * x0 + w3 * xp1 + cb; xm2 = xm1; xm1 = x0; x0 = xp1; }
    }
    __syncthreads();
    const int d = half, hd = ch >> 6, jj = ch & 63;
    const float* wa = C.in[I_LWA] + ((size_t)((l * 2 + d) * 4 + hd) * 64) * 64 + jj;
    const float* wx = C.in[I_LWX] + ((size_t)((l * 2 + d) * 4 + hd) * 64) * 64 + jj;
    const float ba = C.in[I_LBA][(l * 2 + d) * GW + ch], bx = C.in[I_LBX][(l * 2 + d) * GW + ch];
    const float sp8 = 8.0f * softplusf_(-C.in[I_LLAM][(l * 2 + d) * GW + ch]);
    const size_t sidx = ((size_t)(b * NCH + c) * 2 + d) * 256 + ch;
    float h = FIN ? WSP(const float, WS_HIN)[sidx] : 0.f, sla = 0.f;
    LAS bf16* H16 = (LAS bf16*)(U + 64 * 256) + d * 64 * 256;
    const int sgn = d ? -1 : 1;
#pragma unroll 1
    for (int g = 0; g < 4; ++g) {
        const int tstart = d ? (63 - g * 16) : g * 16;
        float ar[16], ai[16];
#pragma unroll
        for (int tt = 0; tt < 16; ++tt) { ar[tt] = 0.f; ai[tt] = 0.f; }
        const LAS float* ub = U + tstart * 256 + hd * 64;
#pragma unroll 1
        for (int i = 0; i < 64; i += 4) {
            float a4[4], x4[4];
#pragma unroll
            for (int q = 0; q < 4; ++q) { a4[q] = wa[(i + q) * 64]; x4[q] = wx[(i + q) * 64]; }
#pragma unroll
            for (int tt = 0; tt < 16; ++tt) { const f32x4 uu = *(const LAS f32x4*)(ub + sgn * tt * 256 + i);
                ar[tt] += uu.x * a4[0] + uu.y * a4[1] + uu.z * a4[2] + uu.w * a4[3];
                ai[tt] += uu.x * x4[0] + uu.y * x4[1] + uu.z * x4[2] + uu.w * x4[3]; }
        }
#pragma unroll
        for (int tt = 0; tt < 16; ++tt) {
            const int tok = tstart + sgn * tt;
            const float r = sigmoidf_(ar[tt] + ba), ig = sigmoidf_(ai[tt] + bx);
            const float la = -sp8 * r; const float a = __expf(la);
            const float bb = sqrtf(-expm1f_(2.0f * la)) * (ig * U[tok * 256 + ch]);
            h = a * h + bb; sla += la;
            if (FIN) H16[tok * 256 + ch] = (bf16)f2bf1(h);
        }
    }
    if (!FIN) { float* ls = WSP(float, WS_LSUM) + sidx * 2; ls[0] = sla; ls[1] = h; __syncthreads(); return; }
    __syncthreads();
    bf16* yc = WSP(bf16, WS_HB);
    const LAS bf16* H0 = (const LAS bf16*)(U + 64 * 256); const LAS bf16* H1 = H0 + 64 * 256;
    for (int t = half * 32; t < half * 32 + 32; ++t) {
        const size_t row = (size_t)(row0 + p0 + t);
        const float gate = bf2f(P[row * PLD + 256 + ch]);
        yc[row * 1024 + ch] = (bf16)f2bf1((bf2f(H0[t * 256 + ch]) + bf2f(H1[t * 256 + ch])) * gelu_tanh(gate));
    }
    __syncthreads();
}
__device__ __forceinline__ void lru_carry(const Ctx& C, int idx) {
    const int ch = idx & 255, d = (idx >> 8) & 1, b = idx >> 9;
    const float* ls = WSP(const float, WS_LSUM); float* hin = WSP(float, WS_HIN);
    float H = 0.f;
    for (int k = 0; k < NCH; ++k) {
        const int c = d ? (k < 4 ? 3 - k : NCH + 3 - k) : k;
        const size_t sidx = ((size_t)(b * NCH + c) * 2 + d) * 256 + ch;
        hin[sidx] = H;
        H = __expf(ls[sidx * 2]) * H + ls[sidx * 2 + 1];
    }
}

__device__ __forceinline__ float rw_shift(const bf16* P, int row0, int p, int Lp, int colB, float mu0, float mu1) {
    const size_t o = (size_t)(row0 + p) * PLD + OFF_B + colB;
    const float x = bf2f(P[o]);
    const float pv = p > 0 ? bf2f(P[o - PLD]) : 0.f, nx = p < Lp - 1 ? bf2f(P[o + PLD]) : 0.f;
    return x + mu0 * (pv - x) + mu1 * (nx - x);
}
__device__ __forceinline__ void rwkv_prep(const Ctx& C, int l, int b, int c) {
    LAS float* XW = (LAS float*)C.lds;
    LAS float* XA = XW + 64 * 64;
    LAS float* XG = XA + 64 * 64;
    const bf16* P = WSP(const bf16, WS_P);
    const bool isctx = c < 4; const int p0 = isctx ? c * 64 : (c - 4) * 64; const int Lp = isctx ? CTXL : SEQ; const int row0 = isctx ? T_LAT + b * CTXL : b * SEQ;
    const float* mu = C.in[I_RMU] + (size_t)l * 2 * B_COLS;
    for (int it = C.tid; it < 64 * 192; it += NTHR) {
        const int t = it / 192, ci = it % 192, colB = 768 + ci;
        const float v = rw_shift(P, row0, p0 + t, Lp, colB, mu[colB], mu[B_COLS + colB]);
        if (ci < 64) XW[t * 64 + ci] = tanhf_(v); else if (ci < 128) XA[t * 64 + ci - 64] = v; else XG[t * 64 + ci - 128] = sigmoidf_(v);
    }
    __syncthreads();
    const int ch = C.tid & 255, half = C.tid >> 8, head = ch >> 6;
    bf16* wa_out = WSP(bf16, WS_HB); bf16* g_out = WSP(bf16, WS_G); float* bonus = WSP(float, WS_BONUS);
    const float* wup = C.in[I_RWUP] + (size_t)l * 2 * 32 * GW + ch;
    const float* aup = C.in[I_RAUP] + (size_t)l * 2 * 32 * GW + ch;
    const float* gup = C.in[I_RGUP] + (size_t)l * 64 * GW + ch;
    const float w00 = C.in[I_RW0][(l * 2 + 0) * GW + ch], w01 = C.in[I_RW0][(l * 2 + 1) * GW + ch];
    const float a00 = C.in[I_RA0][(l * 2 + 0) * GW + ch], a01 = C.in[I_RA0][(l * 2 + 1) * GW + ch];
    const float k_a = C.in[I_RKA][l * GW + ch], r_k = C.in[I_RRK][l * GW + ch];
    const float mur0 = mu[ch], mur1 = mu[B_COLS + ch], muk0 = mu[256 + ch], muk1 = mu[B_COLS + 256 + ch];
#pragma unroll 1
    for (int sub = 0; sub < 2; ++sub) {
        const int t0 = half * 32 + sub * 16;
        float acc[16], av0[16], av1[16];
#pragma unroll
        for (int kind = 0; kind < 4; ++kind) {
            const int d = kind & 1; const bool isw = kind < 2;
            const float* W = (isw ? wup : aup) + (size_t)d * 32 * GW; const LAS float* X = (isw ? XW : XA) + d * 32;
#pragma unroll
            for (int t = 0; t < 16; ++t) acc[t] = 0.f;
            for (int r = 0; r < 32; r += 4) {
                const float g0 = W[(r + 0) * GW], g1 = W[(r + 1) * GW], g2 = W[(r + 2) * GW], g3 = W[(r + 3) * GW];
#pragma unroll
                for (int t = 0; t < 16; ++t) { const f32x4 x = *(const LAS f32x4*)(X + (t0 + t) * 64 + r); acc[t] += x.x * g0 + x.y * g1 + x.z * g2 + x.w * g3; }
            }
#pragma unroll
            for (int t = 0; t < 16; ++t) {
                const size_t row = (size_t)(row0 + p0 + t0 + t);
                float val;
                if (isw) val = __expf(-0.6065306597126334f * sigmoidf_(acc[t] + (d ? w01 : w00)));
                else { val = sigmoidf_(acc[t] + (d ? a01 : a00)); if (d) av1[t] = val; else av0[t] = val; }
                wa_out[row * 1024 + kind * 256 + ch] = (bf16)f2bf1(val);
            }
        }
#pragma unroll
        for (int t = 0; t < 16; ++t) acc[t] = 0.f;
        for (int j = 0; j < 64; j += 4) {
            const float g0 = gup[(j + 0) * GW], g1 = gup[(j + 1) * GW], g2 = gup[(j + 2) * GW], g3 = gup[(j + 3) * GW];
#pragma unroll
            for (int t = 0; t < 16; ++t) { const f32x4 x = *(const LAS f32x4*)(XG + (t0 + t) * 64 + j); acc[t] += x.x * g0 + x.y * g1 + x.z * g2 + x.w * g3; }
        }
#pragma unroll
        for (int t = 0; t < 16; ++t) {
            const int p = p0 + t0 + t; const size_t row = (size_t)(row0 + p);
            g_out[row * 256 + ch] = (bf16)f2bf1(acc[t]);
            const float rs = rw_shift(P, row0, p, Lp, ch, mur0, mur1), ks = rw_shift(P, row0, p, Lp, 256 + ch, muk0, muk1);
            const float km = ks * (1.0f + (av0[t] - 1.0f) * k_a) + ks * (1.0f + (av1[t] - 1.0f) * k_a);
            const float bs = wave_sum(rs * r_k * km);
            if (C.lane == 0) bonus[row * 4 + head] = bs;
        }
    }
    __syncthreads();
}
__device__ __forceinline__ void rwkv_scan(const Ctx& C, int l, int idx) {
    const int d = idx >> 6, b = (idx >> 3) & 7, h = (idx >> 1) & 3, half = idx & 1;
    LAS float* BUF = (LAS float*)C.lds;
    LAS float* YB = BUF + 2 * 32 * 6 * 64;
    const bf16* P = WSP(const bf16, WS_P); const bf16* WA = WSP(const bf16, WS_HB); bf16* outb = WSP(bf16, WS_OUTB) + (size_t)d * T_ALL * 256;
    const int st = C.tid >> 4, q4 = C.tid & 15, chh = h * 64 + q4 * 4;
    const float* mu = C.in[I_RMU] + (size_t)l * 2 * B_COLS;
    f32x4 mu0[3], mu1[3];
#pragma unroll
    for (int q = 0; q < 3; ++q) { mu0[q] = *(const f32x4*)(mu + q * 256 + chh); mu1[q] = *(const f32x4*)(mu + B_COLS + q * 256 + chh); }
    const f32x4 kk_w = *(const f32x4*)(C.in[I_RKK] + l * GW + chh), ka_w = *(const f32x4*)(C.in[I_RKA] + l * GW + chh);
    v2u gxc[3], gxp[3], gxn[3], gwr, gar;
    auto gload = [&](int nb) {
        const int i = nb * 32 + st;
        const bool isctx = i < CTXL; const int Lp = isctx ? CTXL : SEQ; const int j = isctx ? i : i - CTXL; const int p = d ? (Lp - 1 - j) : j;
        const int row = (isctx ? T_LAT + b * CTXL : b * SEQ) + p;
#pragma unroll
        for (int q = 0; q < 3; ++q) {
            const bf16* pp = P + (size_t)row * PLD + OFF_B + q * 256 + chh;
            gxc[q] = *(const v2u*)pp; gxp[q] = (v2u){0u, 0u}; gxn[q] = (v2u){0u, 0u};
            if (p > 0) gxp[q] = *(const v2u*)(pp - PLD);
            if (p < Lp - 1) gxn[q] = *(const v2u*)(pp + PLD);
        }
        gwr = *(const v2u*)(WA + (size_t)row * 1024 + d * 256 + chh); gar = *(const v2u*)(WA + (size_t)row * 1024 + (2 + d) * 256 + chh);
    };
    auto sfinish = [&](int bufi) {
        f32x4 sh[3];
#pragma unroll
        for (int q = 0; q < 3; ++q) {
            const f32x4 x = (f32x4){bflo(gxc[q].x), bfhi(gxc[q].x), bflo(gxc[q].y), bfhi(gxc[q].y)}, pv = (f32x4){bflo(gxp[q].x), bfhi(gxp[q].x), bflo(gxp[q].y), bfhi(gxp[q].y)}, nx = (f32x4){bflo(gxn[q].x), bfhi(gxn[q].x), bflo(gxn[q].y), bfhi(gxn[q].y)};
            sh[q] = x + mu0[q] * (pv - x) + mu1[q] * (nx - x);
        }
        const f32x4 w = (f32x4){bflo(gwr.x), bfhi(gwr.x), bflo(gwr.y), bfhi(gwr.y)}, a = (f32x4){bflo(gar.x), bfhi(gar.x), bflo(gar.y), bfhi(gar.y)};
        f32x4 kk = sh[1] * kk_w;
        const float ss = row16_sum((kk.x * kk.x + kk.y * kk.y) + (kk.z * kk.z + kk.w * kk.w));
        kk = kk * (1.0f / sqrtf(ss + 1e-6f));
        const f32x4 km = sh[1] * ((a - 1.0f) * ka_w + 1.0f), beta = kk * a;
        LAS float* o = BUF + ((bufi * 32 + st) * 6) * 64 + q4 * 4;
        *(LAS f32x4*)(o + 0 * 64) = sh[0]; *(LAS f32x4*)(o + 1 * 64) = kk; *(LAS f32x4*)(o + 2 * 64) = w; *(LAS f32x4*)(o + 3 * 64) = beta; *(LAS f32x4*)(o + 4 * 64) = km; *(LAS f32x4*)(o + 5 * 64) = sh[2];
    };
    const int rr = C.tid >> 4, jq = C.tid & 15;
    f32x4 s = (f32x4){0.f, 0.f, 0.f, 0.f};
    constexpr int NBLK = NSTEP / 32;
    gload(0); sfinish(0); gload(1);
    __syncthreads();
    for (int nb = 0; nb < NBLK; ++nb) {
        if (nb + 1 < NBLK) { sfinish((nb + 1) & 1); if (nb + 2 < NBLK) gload(nb + 2); }
        const LAS float* bb = BUF + ((nb & 1) * 32) * 6 * 64;
        LAS float* yb = YB + (nb & 1) * 1024;
        const LAS float* o0 = bb + jq * 4; const LAS float* v0 = bb + 5 * 64 + half * 32 + rr;
        f32x4 r4 = *(const LAS f32x4*)(o0), kk = *(const LAS f32x4*)(o0 + 64), wv = *(const LAS f32x4*)(o0 + 128), be = *(const LAS f32x4*)(o0 + 192), km = *(const LAS f32x4*)(o0 + 256);
        float vv = v0[0];
#pragma unroll
        for (int hb = 0; hb < 2; ++hb) {
            float ysel = 0.f;
#pragma unroll
            for (int t16 = 0; t16 < 16; ++t16) {
                const int t = hb * 16 + t16;
                const f32x4 cr = r4, ck = kk, cw = wv, cb = be, cm_ = km; const float cv = vv;
                if (t + 1 < 32) { const LAS float* o = o0 + (t + 1) * 6 * 64;
                    r4 = *(const LAS f32x4*)(o); kk = *(const LAS f32x4*)(o + 64); wv = *(const LAS f32x4*)(o + 128); be = *(const LAS f32x4*)(o + 192); km = *(const LAS f32x4*)(o + 256); vv = v0[(t + 1) * 6 * 64]; }
                const float sk = row16_sum((s.x * ck.x + s.y * ck.y) + (s.z * ck.z + s.w * ck.w));
                s = s * cw - cb * sk + cm_ * cv;
                const float y = row16_sum((s.x * cr.x + s.y * cr.y) + (s.z * cr.z + s.w * cr.w));
                ysel = (jq == t16) ? y : ysel;
            }
            yb[(hb * 16 + jq) * 32 + rr] = ysel;
        }
        __syncthreads();
        {
            const int t = C.tid >> 4, r2 = (C.tid & 15) * 2;
            const int i = nb * 32 + t; const int row = seqrow_raster(i, d, b);
            *(unsigned*)(outb + (size_t)row * 256 + h * 64 + half * 32 + r2) = pk2(yb[t * 32 + r2], yb[t * 32 + r2 + 1]);
        }
    }
    __syncthreads();
}

#define RAW_BARRIER() do { asm volatile("s_waitcnt lgkmcnt(0)" ::: "memory"); __builtin_amdgcn_s_barrier(); asm volatile("" ::: "memory"); } while (0)
__device__ __forceinline__ void mlstm_scan_v0(const Ctx& C, int l, int idx) {
    const int d = idx >> 5, b = (idx >> 2) & 7, h = idx & 3, lane = C.lane, w = C.wave;
    LAS float* PN = (LAS float*)C.lds;
    LAS float* PD = PN + 2 * 8 * 64;
    LAS unsigned char* SB = C.lds + 8192;
    constexpr int SBS = 3 * 4096 + 256;
    const bf16* P = WSP(const bf16, WS_P); bf16* outc = WSP(bf16, WS_OUTC) + (size_t)d * T_ALL * 256;
    const float ib = C.in[I_MIB][(l * 2 + d) * NH + h], fb = C.in[I_MFB][(l * 2 + d) * NH + h];
    const int st_ = C.tid >> 4, part = C.tid & 15;
    auto stage = [&](int nb, int bufi) {
        const int row = seqrow_cm(nb * 32 + st_, d, b);
        const size_t ro = (size_t)row * PLD + OFF_C + h * 64 + part * 4;
        LAS unsigned char* sb = SB + bufi * SBS;
        *(LAS v2u*)(sb + st_ * 128 + part * 8) = *(const v2u*)(P + ro);
        *(LAS v2u*)(sb + 4096 + st_ * 128 + part * 8) = *(const v2u*)(P + ro + 256);
        *(LAS v2u*)(sb + 8192 + st_ * 128 + part * 8) = *(const v2u*)(P + ro + 512);
        if (part == 0) { const size_t rg = (size_t)row * PLD + OFF_C + 1024;
            const float li = bf2f(P[rg + d * 4 + h]) + ib, gf = bf2f(P[rg + 8 + d * 4 + h]) + fb;
            *(LAS f32x2*)(sb + 12288 + st_ * 8) = (f32x2){li, -softplusf_(-gf)}; }
    };
    float Cm[8], nk[8];
#pragma unroll
    for (int k = 0; k < 8; ++k) { Cm[k] = 0.f; nk[k] = 0.f; }
    float m = 0.f;
    stage(0, 0);
    __syncthreads();
    for (int nb = 0; nb < NSTEP / 32; ++nb) {
        if (nb + 1 < NSTEP / 32) stage(nb + 1, (nb + 1) & 1);
        const LAS unsigned char* sb = SB + (nb & 1) * SBS;
#pragma unroll 2
        for (int t = 0; t < 32; ++t) {
            const int i = nb * 32 + t;
            const v4u cq = *(const LAS v4u*)(sb + t * 128 + w * 16), ck = *(const LAS v4u*)(sb + 4096 + t * 128 + w * 16);
            const float vv = bf2f(*(const LAS unsigned short*)(sb + 8192 + t * 128 + lane * 2));
            const f32x2 gt = *(const LAS f32x2*)(sb + 12288 + t * 8);
            const float li = gt.x, lf = gt.y;
            const float mn = fmaxf(lf + m, li), fp = __expf(lf + m - mn), ip = __expf(li - mn);
            const float qf[8] = {bflo(cq.x), bfhi(cq.x), bflo(cq.y), bfhi(cq.y), bflo(cq.z), bfhi(cq.z), bflo(cq.w), bfhi(cq.w)};
            const float kf[8] = {bflo(ck.x), bfhi(ck.x), bflo(ck.y), bfhi(ck.y), bflo(ck.z), bfhi(ck.z), bflo(ck.w), bfhi(ck.w)};
            const float ipv = ip * vv;
            float num = 0.f, den = 0.f;
#pragma unroll
            for (int k = 0; k < 8; ++k) { const float kk = kf[k] * 0.125f; Cm[k] = fp * Cm[k] + ipv * kk; nk[k] = fp * nk[k] + ip * kk; num += Cm[k] * qf[k]; den += nk[k] * qf[k]; }
            m = mn;
            const int pb_ = i & 1;
            PN[(pb_ * 8 + w) * 64 + lane] = num; if (lane == 0) PD[pb_ * 8 + w] = den;
            RAW_BARRIER();
            if (w == 0) {
                float ns = 0.f, ds = 0.f;
#pragma unroll
                for (int ww = 0; ww < 8; ++ww) { ns += PN[(pb_ * 8 + ww) * 64 + lane]; ds += PD[pb_ * 8 + ww]; }
                outc[(size_t)seqrow_cm(i, d, b) * 256 + h * 64 + lane] = (bf16)f2bf1(ns / fmaxf(fabsf(ds), __expf(-mn)));
            }
        }
        __syncthreads();
    }
}

__device__ __forceinline__ void gdn_prep(const Ctx& C, int l, int b, int c) {
    const bf16* P = WSP(const bf16, WS_P); bf16* gq = WSP(bf16, WS_GQ);
    const bool isctx = c < 4; const int p0 = isctx ? c * 64 : (c - 4) * 64; const int Lp = isctx ? CTXL : SEQ;
    const int ch = 4 * C.lane;
    auto rowof = [&](int p) -> int { return isctx ? (T_LAT + b * CTXL + p) : (b * SEQ + (p & 63) * 64 + (p >> 6)); };
    f32x4 cw[4][3], x[4][3];
#pragma unroll
    for (int j = 0; j < 4; ++j)
#pragma unroll
        for (int g = 0; g < 3; ++g) cw[j][g] = *(const f32x4*)(C.in[I_GCW] + ((size_t)l * 4 + j) * 768 + g * 256 + ch);
    const int tb = p0 + C.wave * 8;
    auto ldrow = [&](int p, f32x4 (&dst)[3]) {
        if (p >= 0 && p < Lp) { const bf16* pr = P + (size_t)rowof(p) * PLD + OFF_D + ch;
#pragma unroll
            for (int g = 0; g < 3; ++g) dst[g] = ld4bf(pr + g * 256); }
        else {
#pragma unroll
            for (int g = 0; g < 3; ++g) dst[g] = (f32x4){0.f, 0.f, 0.f, 0.f}; }
    };
    ldrow(tb - 2, x[0]); ldrow(tb - 1, x[1]); ldrow(tb, x[2]);
#pragma unroll
    for (int t = 0; t < 8; ++t) {
        ldrow(tb + t + 1, x[3]);
        bf16* orow = gq + (size_t)rowof(tb + t) * 768 + ch;
#pragma unroll
        for (int g = 0; g < 3; ++g) {
            f32x4 v = cw[0][g] * x[0][g] + cw[1][g] * x[1][g] + cw[2][g] * x[2][g] + cw[3][g] * x[3][g];
            v = (f32x4){siluf_(v.x), siluf_(v.y), siluf_(v.z), siluf_(v.w)};
            if (g < 2) { const float ss = row16_sum((v.x * v.x + v.y * v.y) + (v.z * v.z + v.w * v.w)); v = v * ((1.0f / sqrtf(ss + 1e-6f)) * (g == 0 ? 0.125f : 1.0f)); }
            st4bf(orow + g * 256, v);
        }
#pragma unroll
        for (int g = 0; g < 3; ++g) { x[0][g] = x[1][g]; x[1][g] = x[2][g]; x[2][g] = x[3][g]; }
    }
}
__device__ __forceinline__ void gdn_scan_v0(const Ctx& C, int l, int idx) {
    const int d = idx >> 5, b = (idx >> 2) & 7, h = idx & 3, lane = C.lane, w = C.wave;
    LAS float* PA = (LAS float*)C.lds;
    LAS float* PB = PA + 2 * 8 * 64;
    LAS unsigned char* SB = C.lds + 8192;
    constexpr int SBS = 3 * 4096 + 256;
    const bf16* P = WSP(const bf16, WS_P); const bf16* gq = WSP(const bf16, WS_GQ); bf16* outd = WSP(bf16, WS_OUTD) + (size_t)d * T_ALL * 256;
    const float aexp = __expf(C.in[I_GALOG][(l * 2 + d) * NH + h]), dtb = C.in[I_GDTB][(l * 2 + d) * NH + h];
    const int st_ = C.tid >> 4, part = C.tid & 15;
    auto stage = [&](int nb, int bufi) {
        const int row = seqrow_cm(nb * 32 + st_, d, b);
        const size_t rq = (size_t)row * 768 + h * 64 + part * 4;
        LAS unsigned char* sb = SB + bufi * SBS;
        *(LAS v2u*)(sb + st_ * 128 + part * 8) = *(const v2u*)(gq + rq);
        *(LAS v2u*)(sb + 4096 + st_ * 128 + part * 8) = *(const v2u*)(gq + rq + 256);
        *(LAS v2u*)(sb + 8192 + st_ * 128 + part * 8) = *(const v2u*)(gq + rq + 512);
        if (part == 0) { const size_t ro = (size_t)row * PLD + OFF_D + 1024;
            const float ga = bf2f(P[ro + d * 4 + h]), gb = bf2f(P[ro + 8 + d * 4 + h]);
            *(LAS f32x2*)(sb + 12288 + st_ * 8) = (f32x2){__expf(-aexp * softplusf_(ga + dtb)), sigmoidf_(gb)}; }
    };
    float S[8];
#pragma unroll
    for (int k = 0; k < 8; ++k) S[k] = 0.f;
    stage(0, 0);
    __syncthreads();
    int prow = 0;
    for (int nb = 0; nb < NSTEP / 32; ++nb) {
        if (nb + 1 < NSTEP / 32) stage(nb + 1, (nb + 1) & 1);
        const LAS unsigned char* sb = SB + (nb & 1) * SBS;
#pragma unroll 2
        for (int t = 0; t < 32; ++t) {
            const int i = nb * 32 + t;
            const v4u cq = *(const LAS v4u*)(sb + t * 128 + w * 16), ck = *(const LAS v4u*)(sb + 4096 + t * 128 + w * 16);
            const float vv = bf2f(*(const LAS unsigned short*)(sb + 8192 + t * 128 + lane * 2));
            const f32x2 gt = *(const LAS f32x2*)(sb + 12288 + t * 8);
            const float alpha = gt.x, beta = gt.y;
            const float qf[8] = {bflo(cq.x), bfhi(cq.x), bflo(cq.y), bfhi(cq.y), bflo(cq.z), bfhi(cq.z), bflo(cq.w), bfhi(cq.w)};
            const float kf[8] = {bflo(ck.x), bfhi(ck.x), bflo(ck.y), bfhi(ck.y), bflo(ck.z), bfhi(ck.z), bflo(ck.w), bfhi(ck.w)};
            float ks = 0.f;
#pragma unroll
            for (int k = 0; k < 8; ++k) ks += kf[k] * S[k];
            const int pb_ = i & 1;
            PA[(pb_ * 8 + w) * 64 + lane] = ks;
            RAW_BARRIER();
            if (w == 0 && i > 0) {
                float os = 0.f;
#pragma unroll
                for (int ww = 0; ww < 8; ++ww) os += PB[((pb_ ^ 1) * 8 + ww) * 64 + lane];
                outd[(size_t)prow * 256 + h * 64 + lane] = (bf16)f2bf1(os);
            }
            float kS = 0.f;
#pragma unroll
            for (int ww = 0; ww < 8; ++ww) kS += PA[(pb_ * 8 + ww) * 64 + lane];
            const float coef = beta * (vv - alpha * kS);
            float o = 0.f;
#pragma unroll
            for (int k = 0; k < 8; ++k) { S[k] = alpha * S[k] + kf[k] * coef; o += qf[k] * S[k]; }
            PB[(pb_ * 8 + w) * 64 + lane] = o;
            prow = seqrow_cm(i, d, b);
        }
        __syncthreads();
    }
    if (w == 0) {
        float os = 0.f;
#pragma unroll
        for (int ww = 0; ww < 8; ++ww) os += PB[(((NSTEP - 1) & 1) * 8 + ww) * 64 + lane];
        outd[(size_t)prow * 256 + h * 64 + lane] = (bf16)f2bf1(os);
    }
    __syncthreads();
}

__device__ __forceinline__ void finish_rows(const Ctx& C, int l, int nrows) {
    const bf16* P = WSP(const bf16, WS_P); bf16* yc = WSP(bf16, WS_HB);
    const bf16* ob = WSP(const bf16, WS_OUTB); const bf16* oc = WSP(const bf16, WS_OUTC); const bf16* od = WSP(const bf16, WS_OUTD);
    const bf16* gg = WSP(const bf16, WS_G); const float* bonus = WSP(const float, WS_BONUS);
    const float* mu = C.in[I_RMU] + (size_t)l * 2 * B_COLS;
    const int gw = C.wg * NWAVES + C.wave, NGW = C.G * NWAVES, lane = C.lane, ch = 4 * lane, hh = lane >> 4;
    const f32x4 lng = *(const f32x4*)(C.in[I_RLNG] + l * GW + ch), lnb = *(const f32x4*)(C.in[I_RLNB] + l * GW + ch);
    const f32x4 mng = *(const f32x4*)(C.in[I_MNG] + l * GW + ch), gng = *(const f32x4*)(C.in[I_GNG] + l * GW + ch);
    const f32x4 mu0 = *(const f32x4*)(mu + 512 + ch), mu1 = *(const f32x4*)(mu + B_COLS + 512 + ch);
    const size_t o2 = (size_t)T_ALL * 256;
#pragma unroll 2
    for (int m = gw; m < nrows; m += NGW) {
        const bool isctx = m >= T_LAT; const int Lp = isctx ? CTXL : SEQ; const int p = isctx ? ((m - T_LAT) & (CTXL - 1)) : (m & (SEQ - 1));
        const f32x4 yb = ld4bf(ob + (size_t)m * 256 + ch) + ld4bf(ob + o2 + (size_t)m * 256 + ch);
        const f32x4 ycv = ld4bf(oc + (size_t)m * 256 + ch) + ld4bf(oc + o2 + (size_t)m * 256 + ch);
        const f32x4 yd = ld4bf(od + (size_t)m * 256 + ch) + ld4bf(od + o2 + (size_t)m * 256 + ch);
        const bf16* pr = P + (size_t)m * PLD;
        const f32x4 vs = ld4bf(WSP(const bf16, WS_RKV) + (size_t)m * 768 + 512 + ch);
        const f32x4 og = ld4bf(pr + OFF_C + 768 + ch), gd = ld4bf(pr + OFF_D + 768 + ch), gr = ld4bf(gg + (size_t)m * 256 + ch);
        const float bn = bonus[(size_t)m * 4 + hh];
        *(v2u*)(yc + (size_t)m * 1024 + ch) = *(const v2u*)(pr + 256 + ch);
        {
            const float mean = row16_sum((yb.x + yb.y) + (yb.z + yb.w)) * (1.0f / 64.0f);
            const f32x4 dl = yb - mean;
            const float var = row16_sum((dl.x * dl.x + dl.y * dl.y) + (dl.z * dl.z + dl.w * dl.w)) * (1.0f / 64.0f);
            const f32x4 yn = dl * (1.0f / sqrtf(var + 64e-5f)) * lng + lnb;
            st4bf(yc + (size_t)m * 1024 + 256 + ch, (yn + vs * bn) * gr);
        }
        {
            const float ms = row16_sum((ycv.x * ycv.x + ycv.y * ycv.y) + (ycv.z * ycv.z + ycv.w * ycv.w)) * (1.0f / 64.0f);
            const f32x4 sg = (f32x4){sigmoidf_(og.x), sigmoidf_(og.y), sigmoidf_(og.z), sigmoidf_(og.w)};
            st4bf(yc + (size_t)m * 1024 + 512 + ch, ycv * (1.0f / sqrtf(ms + 1e-6f)) * mng * sg);
        }
        {
            const float ms = row16_sum((yd.x * yd.x + yd.y * yd.y) + (yd.z * yd.z + yd.w * yd.w)) * (1.0f / 64.0f);
            const f32x4 sg = (f32x4){siluf_(gd.x), siluf_(gd.y), siluf_(gd.z), siluf_(gd.w)};
            st4bf(yc + (size_t)m * 1024 + 768 + ch, yd * (1.0f / sqrtf(ms + 1e-6f)) * gng * sg);
        }
    }
}
typedef bf16x8 fragb;
__device__ __forceinline__ f32x4 mfma16(fragb a, fragb b, f32x4 c) { return __builtin_amdgcn_mfma_f32_16x16x32_bf16(a, b, c, 0, 0, 0); }
__device__ __forceinline__ fragb ld_frag16(const LAS bf16* p) { return *(const LAS fragb*)p; }
__device__ __forceinline__ fragb ld_frag8x2(const LAS bf16* p0, const LAS bf16* p1) {
    const v2u a = *(const LAS v2u*)p0, b = *(const LAS v2u*)p1; v4u r; r.x = a.x; r.y = a.y; r.z = b.x; r.w = b.y; return __builtin_bit_cast(fragb, r); }
__device__ __forceinline__ fragb pack_frag(const f32x4& lo, const f32x4& hi) { v4u r; r.x = pk2(lo.x, lo.y); r.y = pk2(lo.z, lo.w); r.z = pk2(hi.x, hi.y); r.w = pk2(hi.z, hi.w); return __builtin_bit_cast(fragb, r); }
template <int CTRL, int RM, bool BC> __device__ __forceinline__ float dpp_x(float oldv, float v) { return __builtin_bit_cast(float, __builtin_amdgcn_update_dpp(__builtin_bit_cast(int, oldv), __builtin_bit_cast(int, v), CTRL, RM, 0xF, BC)); }
__device__ __forceinline__ float wave_incl_sum(float v, int lane) {
    v += dpp_x<0x111, 0xF, true>(0.f, v); v += dpp_x<0x112, 0xF, true>(0.f, v); v += dpp_x<0x114, 0xF, true>(0.f, v); v += dpp_x<0x118, 0xF, true>(0.f, v);
    v += dpp_x<0x142, 0xA, false>(0.f, v); v += dpp_x<0x143, 0xC, false>(0.f, v);
    return v;
}
__device__ __forceinline__ float wave_incl_max(float v, int lane) {
    const float ninf = -3.0e38f;
    v = fmaxf(v, dpp_x<0x111, 0xF, false>(ninf, v)); v = fmaxf(v, dpp_x<0x112, 0xF, false>(ninf, v)); v = fmaxf(v, dpp_x<0x114, 0xF, false>(ninf, v)); v = fmaxf(v, dpp_x<0x118, 0xF, false>(ninf, v));
    v = fmaxf(v, dpp_x<0x142, 0xA, false>(ninf, v)); v = fmaxf(v, dpp_x<0x143, 0xC, false>(ninf, v));
    return v;
}
constexpr int MP = 72;
__device__ __forceinline__ void mlstm_chunked(const Ctx& C, int l, int idx) {
    const int d = idx >> 5, b = (idx >> 2) & 7, h = idx & 3, lane = C.lane, w = C.wave, l15 = lane & 15, q = lane >> 4;
    const int it = w & 3, vtp = w >> 2;
    constexpr int IMG = 64 * MP * 2, BUFB = 4 * IMG + 1024, CTB = 65 * MP * 2 + 16;
    LAS unsigned char* L0 = C.lds;
    const bf16* P = WSP(const bf16, WS_P); bf16* outc = WSP(bf16, WS_OUTC) + (size_t)d * T_ALL * 256;
    const float ib = C.in[I_MIB][(l * 2 + d) * NH + h], fb = C.in[I_MFB][(l * 2 + d) * NH + h];
    const int tt = C.tid >> 3, part = C.tid & 7;
    for (int i = C.tid; i < 2 * CTB / 4; i += NTHR) ((LAS unsigned*)(L0 + 2 * BUFB))[i] = 0u;
    v4u rq, rk, rv; unsigned short rgi, rgf;
    auto gload = [&](int n) {
        const int row = seqrow_cm(n * 64 + tt, d, b);
        const bf16* pp = P + (size_t)row * PLD + OFF_C + h * 64 + 8 * part;
        rq = *(const v4u*)pp; rk = *(const v4u*)(pp + 256); rv = *(const v4u*)(pp + 512);
        const bf16* pg = P + (size_t)seqrow_cm(n * 64 + lane, d, b) * PLD + OFF_C + 1024 + d * 4 + h;
        rgi = pg[0]; rgf = pg[8];
    };
    auto images = [&](int bufi) {
        LAS unsigned char* B0 = L0 + bufi * BUFB;
        LAS bf16* Qs = (LAS bf16*)B0; LAS bf16* Ks = Qs + 64 * MP; LAS bf16* VT = Ks + 64 * MP; LAS bf16* KTw = VT + 64 * MP; LAS float* vec = (LAS float*)(B0 + 4 * IMG);
        const float li = bf2f(rgi) + ib, lf = -softplusf_(-(bf2f(rgf) + fb));
        const float bc = wave_incl_sum(lf, lane), x = li - bc, cm = wave_incl_max(x, lane);
        const float wl = __expf(x - __shfl(cm, 63)) * 0.125f;
        if (w == 0) { vec[lane] = x; vec[64 + lane] = cm; vec[128 + lane] = bc; }
        const float wmine = __shfl(wl, 8 * w + (lane >> 3));
        *(LAS v4u*)(Qs + tt * MP + 8 * part) = rq; *(LAS v4u*)(Ks + tt * MP + 8 * part) = rk;
        const unsigned vv[4] = {rv.x, rv.y, rv.z, rv.w}, kk[4] = {rk.x, rk.y, rk.z, rk.w};
#pragma unroll
        for (int e = 0; e < 4; ++e) {
            VT[(8 * part + 2 * e) * MP + tt] = (bf16)(vv[e] & 0xffffu); VT[(8 * part + 2 * e + 1) * MP + tt] = (bf16)(vv[e] >> 16);
            KTw[(8 * part + 2 * e) * MP + tt] = (bf16)f2bf1(bflo(kk[e]) * wmine); KTw[(8 * part + 2 * e + 1) * MP + tt] = (bf16)f2bf1(bfhi(kk[e]) * wmine);
        }
    };
    f32x4 Cst[2], nst; float m = 0.f;
    Cst[0] = Cst[1] = nst = (f32x4){0.f, 0.f, 0.f, 0.f};
    const fragb ones = __builtin_bit_cast(fragb, (v4u){0x3F803F80u, 0x3F803F80u, 0x3F803F80u, 0x3F803F80u});
    const f32x4 z4 = (f32x4){0.f, 0.f, 0.f, 0.f};
    gload(0); images(0); gload(1);
#pragma unroll 1
    for (int n = 0; n < NCH; ++n) {
        RAW_BARRIER();
        const LAS unsigned char* B0 = L0 + (n & 1) * BUFB;
        const LAS bf16* Qs = (const LAS bf16*)B0; const LAS bf16* Ks = Qs + 64 * MP; const LAS bf16* VT = Ks + 64 * MP; const LAS bf16* KTw = VT + 64 * MP; const LAS float* vec = (const LAS float*)(B0 + 4 * IMG);
        const LAS bf16* CT = (const LAS bf16*)(L0 + 2 * BUFB + (n & 1) * CTB); LAS bf16* CTn = (LAS bf16*)(L0 + 2 * BUFB + ((n + 1) & 1) * CTB);
        fragb Qf[2]; Qf[0] = ld_frag16(Qs + (16 * it + l15) * MP + 8 * q); Qf[1] = ld_frag16(Qs + (16 * it + l15) * MP + 32 + 8 * q);
        const float cmi = vec[64 + 16 * it + l15]; const int icol = 16 * it + l15;
        f32x4 pt[4];
#pragma unroll
        for (int jt = 0; jt < 4; ++jt) {
            pt[jt] = z4;
            if (jt <= it) {
                const fragb k0 = ld_frag16(Ks + (16 * jt + l15) * MP + 8 * q), k1 = ld_frag16(Ks + (16 * jt + l15) * MP + 32 + 8 * q);
                f32x4 st = mfma16(k0, Qf[0], z4); st = mfma16(k1, Qf[1], st);
                const f32x4 xj = *(const LAS f32x4*)(vec + 16 * jt + 4 * q);
#pragma unroll
                for (int r = 0; r < 4; ++r) { const int j = 16 * jt + 4 * q + r; pt[jt][r] = (j <= icol) ? st[r] * __expf(xj[r] - cmi) * 0.125f : 0.f; }
            }
        }
        fragb Pf[2]; Pf[0] = pack_frag(pt[0], pt[1]); Pf[1] = pack_frag(pt[2], pt[3]);
        fragb Vf[2][2];
#pragma unroll
        for (int v2 = 0; v2 < 2; ++v2)
#pragma unroll
            for (int s = 0; s < 2; ++s) { const LAS bf16* vr = VT + (16 * (2 * vtp + v2) + l15) * MP + 32 * s + 4 * q; Vf[v2][s] = ld_frag8x2(vr, vr + 16); }
        f32x4 Aacc[2], R[2], as, dn;
        as = mfma16(Pf[0], ones, z4); if (it >= 2) as = mfma16(Pf[1], ones, as);
        const fragb nf0 = ld_frag16(CT + 64 * MP + 8 * q), nf1 = ld_frag16(CT + 64 * MP + 32 + 8 * q);
        dn = mfma16(Qf[0], nf0, z4); dn = mfma16(Qf[1], nf1, dn);
#pragma unroll
        for (int v2 = 0; v2 < 2; ++v2) {
            Aacc[v2] = mfma16(Pf[0], Vf[v2][0], z4); if (it >= 2) Aacc[v2] = mfma16(Pf[1], Vf[v2][1], Aacc[v2]);
            const LAS bf16* cr = CT + (16 * (2 * vtp + v2) + l15) * MP + 8 * q;
            R[v2] = mfma16(Qf[0], ld_frag16(cr), z4); R[v2] = mfma16(Qf[1], ld_frag16(cr + 32), R[v2]);
        }
        {
            const f32x4 bi = *(const LAS f32x4*)(vec + 128 + 16 * it + 4 * q), cmr = *(const LAS f32x4*)(vec + 64 + 16 * it + 4 * q);
#pragma unroll
            for (int r = 0; r < 4; ++r) {
                const float mi = bi[r] + cmr[r], minter = bi[r] + m, mt = fmaxf(minter, mi), e1 = __expf(mi - mt), e2 = __expf(minter - mt);
                const float den = e1 * as[r] + e2 * dn[r]; const float inv = 1.0f / fmaxf(fabsf(den), __expf(-mt));
                const int row = seqrow_cm(n * 64 + 16 * it + 4 * q + r, d, b);
#pragma unroll
                for (int v2 = 0; v2 < 2; ++v2) outc[(size_t)row * 256 + h * 64 + 16 * (2 * vtp + v2) + l15] = (bf16)f2bf1((e1 * Aacc[v2][r] + e2 * R[v2][r]) * inv);
            }
        }
        {
            const LAS bf16* kr = KTw + (16 * it + l15) * MP + 4 * q;
            const fragb kt0 = ld_frag8x2(kr, kr + 16), kt1 = ld_frag8x2(kr + 32, kr + 48);
            const float bL = vec[128 + 63], mloc = bL + vec[64 + 63];
            const float mnew = fmaxf(bL + m, mloc), wp = __expf(bL + m - mnew), wn = __expf(mloc - mnew);
            f32x4 gk = mfma16(kt0, ones, z4); gk = mfma16(kt1, ones, gk);
            nst = nst * wp + gk * wn;
#pragma unroll
            for (int v2 = 0; v2 < 2; ++v2) {
                f32x4 G = mfma16(kt0, Vf[v2][0], z4); G = mfma16(kt1, Vf[v2][1], G);
                Cst[v2] = Cst[v2] * wp + G * wn;
                v2u o; o.x = pk2(Cst[v2].x, Cst[v2].y); o.y = pk2(Cst[v2].z, Cst[v2].w);
                *(LAS v2u*)(CTn + (16 * (2 * vtp + v2) + l15) * MP + 16 * it + 4 * q) = o;
            }
            if (vtp == 0 && l15 == 0) { v2u o; o.x = pk2(nst.x, nst.y); o.y = pk2(nst.z, nst.w); *(LAS v2u*)(CTn + 64 * MP + 16 * it + 4 * q) = o; }
            m = mnew;
        }
        if (n + 1 < NCH) { images((n + 1) & 1); if (n + 2 < NCH) gload(n + 2); }
    }
    __syncthreads();
}
__device__ __forceinline__ int fwd_row_cm(int b, int c, int t) { return c < 4 ? (T_LAT + b * CTXL + c * 64 + t) : (b * SEQ + t * 64 + (c - 4)); }
__device__ __forceinline__ bf16* blob_row(const Ctx& C, int d, int isw, int b, int c, int h, int r) {
    const int row = fwd_row_cm(b, c, r);
    if (d == 1 && isw) return WSP(bf16, WS_OUTD) + ((size_t)T_ALL + row) * 256 + h * 64;
    return WSP(bf16, WS_P) + (size_t)row * PLD + OFF_D + (d * 2 + isw) * 256 + h * 64;
}
constexpr int LP = 68;
__device__ __forceinline__ void gdn_solve_units(const Ctx& C, int l) {
    const int lane = C.lane, w = C.wave, pw = w & 1, pi = w >> 1, l15 = lane & 15, q = lane >> 4;
    LAS unsigned char* B0 = C.lds + pi * 28672;
    LAS float* Lm = (LAS float*)B0;
    LAS bf16* Ks = (LAS bf16*)(B0 + 17408);
    LAS float* vec = (LAS float*)(B0 + 17408 + 9216);
    const bf16* P = WSP(const bf16, WS_P); const bf16* gq = WSP(const bf16, WS_GQ);
    const int NU = NB * NH * NCH, per = C.G * 4;
    const int trips = (NU + per - 1) / per;
#pragma unroll 1
    for (int k = 0; k < trips; ++k) {
        int u = k * per + C.wg * 4 + pi; const bool active = u < NU; if (!active) u = NU - 1;
        const int c = u % NCH, h = (u / NCH) & 3, b = u / (NCH * NH);
#pragma unroll 1
        for (int d = 0; d < 2; ++d) {
            const int n = d ? (c < 4 ? 3 - c : 71 - c) : c;
            const float aexp = __expf(C.in[I_GALOG][(l * 2 + d) * NH + h]), dtb = C.in[I_GDTB][(l * 2 + d) * NH + h];
            const int rowl = seqrow_cm(n * 64 + lane, d, b);
            const bf16* pg = P + (size_t)rowl * PLD + OFF_D + 1024 + d * 4 + h;
            const float la = -aexp * softplusf_(bf2f(pg[0]) + dtb), beta = sigmoidf_(bf2f(pg[8]));
            const float gam = wave_incl_sum(la, lane);
            if (pw == 0) { vec[lane] = beta; vec[64 + lane] = gam; }
#pragma unroll
            for (int r = 0; r < 4; ++r) { const int idx = pw * 64 + lane + 128 * r, t = idx >> 3, part = idx & 7;
                *(LAS v4u*)(Ks + t * MP + 8 * part) = *(const v4u*)(gq + (size_t)seqrow_cm(n * 64 + t, d, b) * 768 + 256 + h * 64 + 8 * part); }
            float x[64];
#pragma unroll
            for (int i = 0; i < 64; ++i) x[i] = bf2f(gq[(size_t)seqrow_cm(n * 64 + i, d, b) * 768 + (pw ? 256 : 512) + h * 64 + lane]);
            __syncthreads();
            {
                int tix = 0;
#pragma unroll
                for (int it = 0; it < 4; ++it)
#pragma unroll
                    for (int jt = 0; jt <= it; ++jt, ++tix) if ((tix & 1) == pw) {
                        f32x4 acc = (f32x4){0.f, 0.f, 0.f, 0.f};
#pragma unroll
                        for (int s = 0; s < 2; ++s) acc = mfma16(ld_frag16(Ks + (16 * it + l15) * MP + 32 * s + 8 * q), ld_frag16(Ks + (16 * jt + l15) * MP + 32 * s + 8 * q), acc);
                        const float gj = vec[64 + 16 * jt + l15];
                        const f32x4 bi = *(const LAS f32x4*)(vec + 16 * it + 4 * q), gi = *(const LAS f32x4*)(vec + 64 + 16 * it + 4 * q);
#pragma unroll
                        for (int r = 0; r < 4; ++r) { const int i = 16 * it + 4 * q + r, j = 16 * jt + l15;
                            Lm[i * LP + j] = (j < i) ? bi[r] * acc[r] * __expf(gi[r] - gj) : 0.f; }
                    }
            }
            __syncthreads();
#pragma unroll
            for (int i = 0; i < 64; ++i) {
                const float sc = pw ? vec[i] * __expf(vec[64 + i]) : vec[i];
                float a0 = x[i] * sc, a1 = 0.f;
                int roff = i * LP; if (i >= 2) asm volatile("" : "+v"(roff) : "v"(x[i - 2]));
                const LAS float* lrow = Lm + roff;
#pragma unroll
                for (int j4 = 0; j4 < i; j4 += 4) { const f32x4 lv = *(const LAS f32x4*)(lrow + j4);
                    a0 -= lv.x * x[j4]; if (j4 + 1 < i) a1 -= lv.y * x[j4 + 1]; if (j4 + 2 < i) a0 -= lv.z * x[j4 + 2]; if (j4 + 3 < i) a1 -= lv.w * x[j4 + 3]; }
                x[i] = a0 + a1;
            }
            if (active) { bf16* dst = blob_row(C, d, pw, b, c, h, lane);
#pragma unroll
                for (int g = 0; g < 8; ++g) { v4u o; o.x = pk2(x[8 * g], x[8 * g + 1]); o.y = pk2(x[8 * g + 2], x[8 * g + 3]); o.z = pk2(x[8 * g + 4], x[8 * g + 5]); o.w = pk2(x[8 * g + 6], x[8 * g + 7]);
                    *(v4u*)(dst + 8 * g) = o; } }
            __syncthreads();
        }
    }
}

template <bool DRY>
__device__ __forceinline__ void gdn_chunked(const Ctx& C, int l, int idx) {
    const int d = idx >> 5, b = (idx >> 2) & 7, h = idx & 3, lane = C.lane, w = C.wave, l15 = lane & 15, q = lane >> 4;
    const int it = w & 3, vtp = w >> 2;
    constexpr int IMG = 64 * MP * 2, BUFB = 5 * IMG + 512;
    LAS unsigned char* L0 = C.lds;
    LAS bf16* VnT = (LAS bf16*)(L0 + 2 * BUFB + 2 * IMG);
    const bf16* P = WSP(const bf16, WS_P); const bf16* gq = WSP(const bf16, WS_GQ); bf16* outd = WSP(bf16, WS_OUTD) + (size_t)d * T_ALL * 256;
    const float aexp = __expf(C.in[I_GALOG][(l * 2 + d) * NH + h]), dtb = C.in[I_GDTB][(l * 2 + d) * NH + h];
    const int tt = C.tid >> 3, part = C.tid & 7;
    for (int i = C.tid; i < 2 * IMG / 4; i += NTHR) ((LAS unsigned*)(L0 + 2 * BUFB))[i] = 0u;
    v4u rq, rk, ru, rw; unsigned short rga;
    auto gload = [&](int n) {
        const int c = d ? (n < 4 ? 3 - n : 71 - n) : n;
        const bf16* pp = gq + (size_t)seqrow_cm(n * 64 + tt, d, b) * 768 + h * 64 + 8 * part;
        rq = *(const v4u*)pp; rk = *(const v4u*)(pp + 256);
        ru = *(const v4u*)(blob_row(C, d, 0, b, c, h, tt) + 8 * part); rw = *(const v4u*)(blob_row(C, d, 1, b, c, h, tt) + 8 * part);
        rga = P[(size_t)seqrow_cm(n * 64 + lane, d, b) * PLD + OFF_D + 1024 + d * 4 + h];
    };
    auto images = [&](int bufi) {
        LAS unsigned char* B0 = L0 + bufi * BUFB;
        LAS bf16* Qs = (LAS bf16*)B0; LAS bf16* Ks = Qs + 64 * MP; LAS bf16* KdT = Ks + 64 * MP; LAS bf16* Wi = KdT + 64 * MP; LAS bf16* UT = Wi + 64 * MP; LAS float* vec = (LAS float*)(B0 + 5 * IMG);
        const float la = -aexp * softplusf_(bf2f(rga) + dtb);
        const float gam = wave_incl_sum(la, lane);
        if (w == 0) vec[lane] = gam;
        const float kd = __expf(__shfl(gam, 63) - gam);
        const float kmine = __shfl(kd, 8 * w + (lane >> 3));
        *(LAS v4u*)(Qs + tt * MP + 8 * part) = rq; *(LAS v4u*)(Ks + tt * MP + 8 * part) = rk; *(LAS v4u*)(UT + tt * MP + 8 * part) = ru;
        const unsigned kk[4] = {rk.x, rk.y, rk.z, rk.w}, ww[4] = {rw.x, rw.y, rw.z, rw.w};
#pragma unroll
        for (int e = 0; e < 4; ++e) {
            KdT[(8 * part + 2 * e) * MP + tt] = (bf16)f2bf1(bflo(kk[e]) * kmine); KdT[(8 * part + 2 * e + 1) * MP + tt] = (bf16)f2bf1(bfhi(kk[e]) * kmine);
            Wi[(8 * part + 2 * e) * MP + tt] = (bf16)(ww[e] & 0xffffu); Wi[(8 * part + 2 * e + 1) * MP + tt] = (bf16)(ww[e] >> 16);
        }
    };
    f32x4 Sst[2]; Sst[0] = Sst[1] = (f32x4){0.f, 0.f, 0.f, 0.f};
    const f32x4 z4 = (f32x4){0.f, 0.f, 0.f, 0.f};
    gload(0); images(0); gload(1);
#pragma unroll 1
    for (int n = 0; n < NCH; ++n) {
        RAW_BARRIER();
        const LAS unsigned char* B0 = L0 + (n & 1) * BUFB;
        const LAS bf16* Qs = (const LAS bf16*)B0; const LAS bf16* Ks = Qs + 64 * MP; const LAS bf16* KdT = Ks + 64 * MP; const LAS bf16* Wi = KdT + 64 * MP; const LAS bf16* UT = Wi + 64 * MP; const LAS float* vec = (const LAS float*)(B0 + 5 * IMG);
        const LAS bf16* ST = (const LAS bf16*)(L0 + 2 * BUFB + (n & 1) * IMG); LAS bf16* STn = (LAS bf16*)(L0 + 2 * BUFB + ((n + 1) & 1) * IMG);
        fragb Qf[2]; Qf[0] = ld_frag16(Qs + (16 * it + l15) * MP + 8 * q); Qf[1] = ld_frag16(Qs + (16 * it + l15) * MP + 32 + 8 * q);
        const float gcol = vec[16 * it + l15]; const int icol = 16 * it + l15;
        f32x4 pt[4];
#pragma unroll
        for (int jt = 0; jt < 4; ++jt) {
            pt[jt] = z4;
            if (jt <= it) {
                const fragb k0 = ld_frag16(Ks + (16 * jt + l15) * MP + 8 * q), k1 = ld_frag16(Ks + (16 * jt + l15) * MP + 32 + 8 * q);
                f32x4 st = mfma16(k0, Qf[0], z4); st = mfma16(k1, Qf[1], st);
                const f32x4 gj = *(const LAS f32x4*)(vec + 16 * jt + 4 * q);
#pragma unroll
                for (int r = 0; r < 4; ++r) { const int j = 16 * jt + 4 * q + r; pt[jt][r] = (j <= icol) ? st[r] * __expf(gcol - gj[r]) : 0.f; }
            }
        }
        fragb Pf[2]; Pf[0] = pack_frag(pt[0], pt[1]); Pf[1] = pack_frag(pt[2], pt[3]);
        const fragb Wf0 = ld_frag16(Wi + (16 * it + l15) * MP + 8 * q), Wf1 = ld_frag16(Wi + (16 * it + l15) * MP + 32 + 8 * q);
        f32x4 Ro[2];
#pragma unroll
        for (int v2 = 0; v2 < 2; ++v2) {
            const int vrow = 16 * (2 * vtp + v2) + l15;
            const fragb s0 = ld_frag16(ST + vrow * MP + 8 * q), s1 = ld_frag16(ST + vrow * MP + 32 + 8 * q);
            f32x4 ws = mfma16(Wf0, s0, z4); ws = mfma16(Wf1, s1, ws);
            Ro[v2] = mfma16(Qf[0], s0, z4); Ro[v2] = mfma16(Qf[1], s1, Ro[v2]);
            const v2u ur = *(const LAS v2u*)(UT + vrow * MP + 16 * it + 4 * q);
            v2u o; o.x = pk2(bflo(ur.x) - ws.x, bfhi(ur.x) - ws.y); o.y = pk2(bflo(ur.y) - ws.z, bfhi(ur.y) - ws.w);
            *(LAS v2u*)(VnT + vrow * MP + 16 * it + 4 * q) = o;
        }
        RAW_BARRIER();
        {
            const f32x4 gi = *(const LAS f32x4*)(vec + 16 * it + 4 * q);
            const float gl = __expf(vec[63]);
            const LAS bf16* kr = KdT + (16 * it + l15) * MP + 4 * q;
            const fragb kt0 = ld_frag8x2(kr, kr + 16), kt1 = ld_frag8x2(kr + 32, kr + 48);
#pragma unroll
            for (int v2 = 0; v2 < 2; ++v2) {
                const int vrow = 16 * (2 * vtp + v2) + l15;
                const LAS bf16* vr = VnT + vrow * MP + 4 * q;
                const fragb n0 = ld_frag8x2(vr, vr + 16), n1 = ld_frag8x2(vr + 32, vr + 48);
                f32x4 o = mfma16(Pf[0], n0, z4); if (it >= 2) o = mfma16(Pf[1], n1, o);
#pragma unroll
                for (int r = 0; r < 4; ++r) { const int row = seqrow_cm(n * 64 + 16 * it + 4 * q + r, d, b);
                    if (!DRY) outd[(size_t)row * 256 + h * 64 + vrow] = (bf16)f2bf1(o[r] + __expf(gi[r]) * Ro[v2][r]); }
                f32x4 ns = mfma16(kt0, n0, z4); ns = mfma16(kt1, n1, ns);
                Sst[v2] = Sst[v2] * gl + ns;
                v2u so; so.x = pk2(Sst[v2].x, Sst[v2].y); so.y = pk2(Sst[v2].z, Sst[v2].w);
                *(LAS v2u*)(STn + vrow * MP + 16 * it + 4 * q) = so;
            }
        }
        if (n + 1 < NCH) { images((n + 1) & 1); if (n + 2 < NCH) gload(n + 2); }
    }
    __syncthreads();
}
constexpr int UP = 264;
template <int CTRL> __device__ __forceinline__ float dpp_keep(float oldv, float v) { return __builtin_bit_cast(float, __builtin_amdgcn_update_dpp(__builtin_bit_cast(int, oldv), __builtin_bit_cast(int, v), CTRL, 0xF, 0xF, false)); }
template <bool REV> __device__ __forceinline__ void scan16(float& A, float& B) {
#define LRU_STEP(S) { const float Ap = dpp_keep<(REV ? 0x100 : 0x110) | S>(1.0f, A), Bp = dpp_keep<(REV ? 0x100 : 0x110) | S>(0.0f, B); B = A * Bp + B; A = A * Ap; }
    LRU_STEP(1) LRU_STEP(2) LRU_STEP(4) LRU_STEP(8)
#undef LRU_STEP
}
template <bool FIN, bool REV>
__device__ __forceinline__ void lru_wave(const Ctx& C, int l, int b, int c, int hd, LAS bf16* U16, LAS bf16* H16) {
    constexpr int d = REV ? 1 : 0;
    const int lane = C.lane, l15 = lane & 15, q = lane >> 4;
    const bf16* wt = WSP(const bf16, WS_LRUWT) + (size_t)((d * 2 + 0) * 4 + hd) * 4096;
    fragb Wa[4][2], Wx[4][2];
#pragma unroll
    for (int mt = 0; mt < 4; ++mt)
#pragma unroll
        for (int ks = 0; ks < 2; ++ks) { Wa[mt][ks] = *(const fragb*)(wt + (16 * mt + l15) * 64 + 32 * ks + 8 * q); Wx[mt][ks] = *(const fragb*)(wt + 4 * 4096 + (16 * mt + l15) * 64 + 32 * ks + 8 * q); }
    f32x4 sp4[4], hc[4], sla[4];
    const size_t sbase = ((size_t)(b * NCH + c) * 2 + d) * 256 + hd * 64;
#pragma unroll
    for (int mt = 0; mt < 4; ++mt) {
        const int ch = hd * 64 + 16 * mt + 4 * q;
        const f32x4 lam = *(const f32x4*)(C.in[I_LLAM] + (l * 2 + d) * GW + ch);
#pragma unroll
        for (int r = 0; r < 4; ++r) sp4[mt][r] = 8.0f * softplusf_(-lam[r]);
        hc[mt] = FIN ? *(const f32x4*)(WSP(const float, WS_HIN) + sbase + 16 * mt + 4 * q) : (f32x4){0.f, 0.f, 0.f, 0.f};
        sla[mt] = (f32x4){0.f, 0.f, 0.f, 0.f};
    }
    const f32x4 z4 = (f32x4){0.f, 0.f, 0.f, 0.f};
#pragma unroll 1
    for (int nti = 0; nti < 4; ++nti) {
        const int nt = REV ? 3 - nti : nti;
        const LAS bf16* urow = U16 + (16 * nt + l15) * UP + hd * 64;
        const fragb Uf0 = ld_frag16(urow + 8 * q), Uf1 = ld_frag16(urow + 32 + 8 * q);
#pragma unroll
        for (int mt = 0; mt < 4; ++mt) {
            f32x4 aa = mfma16(Wa[mt][0], Uf0, z4); aa = mfma16(Wa[mt][1], Uf1, aa);
            f32x4 ax = mfma16(Wx[mt][0], Uf0, z4); ax = mfma16(Wx[mt][1], Uf1, ax);
            const v2u ur = *(const LAS v2u*)(urow + 16 * mt + 4 * q);
            const float u4[4] = {bflo(ur.x), bfhi(ur.x), bflo(ur.y), bfhi(ur.y)};
            const f32x4 ba = *(const f32x4*)(C.in[I_LBA] + (l * 2 + d) * GW + hd * 64 + 16 * mt + 4 * q), bx = *(const f32x4*)(C.in[I_LBX] + (l * 2 + d) * GW + hd * 64 + 16 * mt + 4 * q);
            f32x4 hv;
#pragma unroll
            for (int r = 0; r < 4; ++r) {
                const float rg = sigmoidf_(aa[r] + ba[r]), ig = sigmoidf_(ax[r] + bx[r]);
                const float la = -sp4[mt][r] * rg; float A = __expf(la); float Bv = sqrtf(-expm1f_(2.0f * la)) * (ig * u4[r]);
                sla[mt][r] += la;
                scan16<REV>(A, Bv);
                const float h = A * hc[mt][r] + Bv;
                hv[r] = h;
                hc[mt][r] = __shfl(h, (lane & 48) | (REV ? 0 : 15));
            }
            if (FIN) { v2u o; o.x = pk2(hv.x, hv.y); o.y = pk2(hv.z, hv.w); *(LAS v2u*)(H16 + (size_t)d * 64 * UP + (16 * nt + l15) * UP + hd * 64 + 16 * mt + 4 * q) = o; }
        }
    }
    if (!FIN) {
        float* ls = WSP(float, WS_LSUM);
#pragma unroll
        for (int mt = 0; mt < 4; ++mt)
#pragma unroll
            for (int r = 0; r < 4; ++r) { const float st = row16_sum(sla[mt][r]); if (l15 == 0) { const size_t si = sbase + 16 * mt + 4 * q + r; ls[si * 2] = st; ls[si * 2 + 1] = hc[mt][r]; } }
    }
}
template <bool FIN>
__device__ __forceinline__ void lru_chunk_mfma(const Ctx& C, int l, int b, int c) {
    LAS bf16* U16 = (LAS bf16*)C.lds;
    LAS bf16* H16 = U16 + 64 * UP;
    const bf16* P = WSP(const bf16, WS_P);
    const bool isctx = c < 4; const int p0 = isctx ? c * 64 : (c - 4) * 64; const int Lp = isctx ? CTXL : SEQ; const int row0 = isctx ? T_LAT + b * CTXL : b * SEQ;
    {
        const int ch = C.tid & 255, half = C.tid >> 8;
        const float* cw = C.in[I_LCW] + (size_t)l * 4 * GW + ch; const float w0 = cw[0], w1 = cw[GW], w2 = cw[2 * GW], w3 = cw[3 * GW], cb = C.in[I_LCB][l * GW + ch];
        const int t0 = half * 32;
        float xs[35];
#pragma unroll
        for (int k = 0; k < 35; ++k) { const int p = p0 + t0 + k - 2; xs[k] = (p >= 0 && p < Lp) ? bf2f(P[(size_t)(row0 + p) * PLD + ch]) : 0.f; }
#pragma unroll
        for (int t = 0; t < 32; ++t) U16[(t0 + t) * UP + ch] = (bf16)f2bf1(w0 * xs[t] + w1 * xs[t + 1] + w2 * xs[t + 2] + w3 * xs[t + 3] + cb);
    }
    __syncthreads();
    if (C.wave < 4) lru_wave<FIN, false>(C, l, b, c, C.wave & 3, U16, H16); else lru_wave<FIN, true>(C, l, b, c, C.wave & 3, U16, H16);
    __syncthreads();
    if (FIN) {
        const LAS bf16* H1 = H16 + 64 * UP;
#pragma unroll 2
        for (int it = C.tid; it < 64 * 64; it += NTHR) {
            const int t = it >> 6, c4 = (it & 63) * 4;
            const size_t row = (size_t)(row0 + p0 + t);
            const v2u a = *(const LAS v2u*)(H16 + t * UP + c4), bq = *(const LAS v2u*)(H1 + t * UP + c4);
            const f32x4 g = ld4bf(P + row * PLD + 256 + c4);
            f32x4 y = (f32x4){bflo(a.x) + bflo(bq.x), bfhi(a.x) + bfhi(bq.x), bflo(a.y) + bflo(bq.y), bfhi(a.y) + bfhi(bq.y)};
            y.x *= gelu_tanh(g.x); y.y *= gelu_tanh(g.y); y.z *= gelu_tanh(g.z); y.w *= gelu_tanh(g.w);
            st4bf(WSP(bf16, WS_P) + row * PLD + 256 + c4, y);
        }
        __syncthreads();
    }
}
constexpr int RP = 264;
__device__ __forceinline__ void rwkv_prep2(const Ctx& C, int l, int b, int c) {
    LAS bf16* RS = (LAS bf16*)C.lds;
    LAS bf16* KS = RS + 64 * RP;
    LAS bf16* XW = KS + 64 * RP;
    LAS bf16* XA = XW + 64 * MP;
    LAS bf16* XG = XA + 64 * MP;
    const bf16* P = WSP(const bf16, WS_P);
    const bool isctx = c < 4; const int p0 = isctx ? c * 64 : (c - 4) * 64; const int Lp = isctx ? CTXL : SEQ; const int row0 = isctx ? T_LAT + b * CTXL : b * SEQ;
    const float* mu = C.in[I_RMU] + (size_t)l * 2 * B_COLS;
    bf16* rkv = WSP(bf16, WS_RKV);
#pragma unroll 2
    for (int it = C.tid; it < 64 * 120; it += NTHR) {
        const int t = it / 120, c8 = (it % 120) * 8, p = p0 + t;
        const bf16* pp = P + (size_t)(row0 + p) * PLD + OFF_B + c8;
        const v4u xc = *(const v4u*)pp; v4u xp = (v4u){0u, 0u, 0u, 0u}, xn = xp;
        if (p > 0) xp = *(const v4u*)(pp - PLD);
        if (p < Lp - 1) xn = *(const v4u*)(pp + PLD);
        const f32x4 m0a = *(const f32x4*)(mu + c8), m0b = *(const f32x4*)(mu + c8 + 4), m1a = *(const f32x4*)(mu + B_COLS + c8), m1b = *(const f32x4*)(mu + B_COLS + c8 + 4);
        const unsigned xcw[4] = {xc.x, xc.y, xc.z, xc.w}, xpw[4] = {xp.x, xp.y, xp.z, xp.w}, xnw[4] = {xn.x, xn.y, xn.z, xn.w};
        float sh[8];
#pragma unroll
        for (int e = 0; e < 4; ++e) {
            const float x0 = bflo(xcw[e]), x1 = bfhi(xcw[e]);
            const float mu0_0 = e < 2 ? m0a[2 * e] : m0b[2 * e - 4], mu0_1 = e < 2 ? m0a[2 * e + 1] : m0b[2 * e - 3], mu1_0 = e < 2 ? m1a[2 * e] : m1b[2 * e - 4], mu1_1 = e < 2 ? m1a[2 * e + 1] : m1b[2 * e - 3];
            sh[2 * e] = x0 + mu0_0 * (bflo(xpw[e]) - x0) + mu1_0 * (bflo(xnw[e]) - x0);
            sh[2 * e + 1] = x1 + mu0_1 * (bfhi(xpw[e]) - x1) + mu1_1 * (bfhi(xnw[e]) - x1);
        }
        if (c8 >= 768) {
            const int ci = c8 - 768;
            if (ci < 64) {
#pragma unroll
                for (int e = 0; e < 8; ++e) sh[e] = tanhf_(sh[e]); }
            else if (ci >= 128) {
#pragma unroll
                for (int e = 0; e < 8; ++e) sh[e] = sigmoidf_(sh[e]); }
        }
        v4u o; o.x = pk2(sh[0], sh[1]); o.y = pk2(sh[2], sh[3]); o.z = pk2(sh[4], sh[5]); o.w = pk2(sh[6], sh[7]);
        if (c8 < 768) {
            *(v4u*)(rkv + (size_t)(row0 + p) * 768 + c8) = o;
            if (c8 < 256) *(LAS v4u*)(RS + t * RP + c8) = o; else if (c8 < 512) *(LAS v4u*)(KS + t * RP + c8 - 256) = o;
        } else {
            const int ci = c8 - 768;
            LAS bf16* dst = ci < 64 ? XW + t * MP + ci : (ci < 128 ? XA + t * MP + ci - 64 : XG + t * MP + ci - 128);
            *(LAS v4u*)dst = o;
        }
    }
    __syncthreads();
    const int lane = C.lane, w = C.wave, l15 = lane & 15, q = lane >> 4, hd = w & 3, ntp = w >> 2;
    const bf16* wt = WSP(const bf16, WS_RWT);
    bf16* wa_out = WSP(bf16, WS_HB); bf16* g_out = WSP(bf16, WS_G); float* bonus = WSP(float, WS_BONUS); float* rinv = WSP(float, WS_RINV);
    const f32x4 z4 = (f32x4){0.f, 0.f, 0.f, 0.f};
#pragma unroll 1
    for (int n2 = 0; n2 < 2; ++n2) {
        const int nt = 2 * ntp + n2, tok = 16 * nt + l15; const size_t row = (size_t)(row0 + p0 + tok);
        const fragb xw0 = ld_frag16(XW + tok * MP + 8 * q), xw1 = ld_frag16(XW + tok * MP + 32 + 8 * q);
        const fragb xa0 = ld_frag16(XA + tok * MP + 8 * q), xa1 = ld_frag16(XA + tok * MP + 32 + 8 * q);
        const fragb xg0 = ld_frag16(XG + tok * MP + 8 * q), xg1 = ld_frag16(XG + tok * MP + 32 + 8 * q);
        float bsum = 0.f, ksum = 0.f;
#pragma unroll
        for (int mt = 0; mt < 4; ++mt) {
            const int chl = 16 * mt + l15, ch4 = hd * 64 + 16 * mt + 4 * q;
            const bf16* wrow = wt + (size_t)(hd * 64 + chl) * 32 + 8 * q;
            const f32x4 aw0 = mfma16(*(const fragb*)(wrow), xw0, z4), aw1 = mfma16(*(const fragb*)(wrow + 256 * 32), xw1, z4);
            const f32x4 aa0 = mfma16(*(const fragb*)(wrow + 2 * 256 * 32), xa0, z4), aa1 = mfma16(*(const fragb*)(wrow + 3 * 256 * 32), xa1, z4);
            const bf16* grow = wt + 4 * 256 * 32 + (size_t)(hd * 64 + chl) * 64 + 8 * q;
            f32x4 ag = mfma16(*(const fragb*)(grow), xg0, z4); ag = mfma16(*(const fragb*)(grow + 32), xg1, ag);
            const f32x4 w00 = *(const f32x4*)(C.in[I_RW0] + (l * 2 + 0) * GW + ch4), w01 = *(const f32x4*)(C.in[I_RW0] + (l * 2 + 1) * GW + ch4);
            const f32x4 a00 = *(const f32x4*)(C.in[I_RA0] + (l * 2 + 0) * GW + ch4), a01 = *(const f32x4*)(C.in[I_RA0] + (l * 2 + 1) * GW + ch4);
            const f32x4 k_a = *(const f32x4*)(C.in[I_RKA] + l * GW + ch4), r_k = *(const f32x4*)(C.in[I_RRK] + l * GW + ch4), k_k = *(const f32x4*)(C.in[I_RKK] + l * GW + ch4);
            f32x4 wv0, wv1, av0, av1;
#pragma unroll
            for (int r = 0; r < 4; ++r) {
                wv0[r] = __expf(-0.6065306597126334f * sigmoidf_(aw0[r] + w00[r])); wv1[r] = __expf(-0.6065306597126334f * sigmoidf_(aw1[r] + w01[r]));
                av0[r] = sigmoidf_(aa0[r] + a00[r]); av1[r] = sigmoidf_(aa1[r] + a01[r]);
            }
            st4bf(wa_out + row * 1024 + 0 * 256 + ch4, wv0); st4bf(wa_out + row * 1024 + 1 * 256 + ch4, wv1);
            st4bf(wa_out + row * 1024 + 2 * 256 + ch4, av0); st4bf(wa_out + row * 1024 + 3 * 256 + ch4, av1);
            st4bf(g_out + row * 256 + ch4, ag);
            const v2u rr_ = *(const LAS v2u*)(RS + tok * RP + ch4), kr_ = *(const LAS v2u*)(KS + tok * RP + ch4);
            const f32x4 rs = (f32x4){bflo(rr_.x), bfhi(rr_.x), bflo(rr_.y), bfhi(rr_.y)}, ks = (f32x4){bflo(kr_.x), bfhi(kr_.x), bflo(kr_.y), bfhi(kr_.y)};
#pragma unroll
            for (int r = 0; r < 4; ++r) {
                const float km = ks[r] * (1.0f + (av0[r] - 1.0f) * k_a[r]) + ks[r] * (1.0f + (av1[r] - 1.0f) * k_a[r]);
                bsum += rs[r] * r_k[r] * km; const float kk = ks[r] * k_k[r]; ksum += kk * kk;
            }
        }
        bsum += __shfl_xor(bsum, 16); bsum += __shfl_xor(bsum, 32); ksum += __shfl_xor(ksum, 16); ksum += __shfl_xor(ksum, 32);
        if (q == 0) { bonus[row * 4 + hd] = bsum; rinv[row * 4 + hd] = 1.0f / sqrtf(ksum + 1e-6f); }
    }
    __syncthreads();
}
__device__ __forceinline__ int fwd_row_r(int b, int c, int t) { return c < 4 ? (T_LAT + b * CTXL + c * 64 + t) : (b * SEQ + (c - 4) * 64 + t); }
__device__ __forceinline__ bf16* rw_blob_row(const Ctx& C, int d, int which, int b, int c, int h, int r) {
    const int row = fwd_row_r(b, c, r);
    if (which == 0) return WSP(bf16, WS_OUTB) + ((size_t)d * T_ALL + row) * 256 + h * 64;
    return WSP(bf16, WS_P) + (size_t)row * PLD + OFF_B + d * 256 + h * 64;
}
__device__ __forceinline__ void rwkv_solve_units(const Ctx& C, int l) {
    const int lane = C.lane, w = C.wave, pw = w & 1, pi = w >> 1, l15 = lane & 15, q = lane >> 4;
    LAS unsigned char* B0 = C.lds + pi * 28672;
    LAS bf16* Kk = (LAS bf16*)B0; LAS bf16* Bh = Kk + 64 * MP; LAS bf16* Kh = Bh + 64 * MP;
    LAS float* Lm = (LAS float*)B0; LAS bf16* Lk16 = (LAS bf16*)(B0 + 17408);
    const bf16* WA = WSP(const bf16, WS_HB); const bf16* rkv = WSP(const bf16, WS_RKV); const float* rinv = WSP(const float, WS_RINV);
    const int NU = NB * NH * NCH, per = C.G * 4;
    const int trips = (NU + per - 1) / per;
#pragma unroll 1
    for (int k = 0; k < trips; ++k) {
        int u = k * per + C.wg * 4 + pi; const bool active = u < NU; if (!active) u = NU - 1;
        const int c = u % NCH, h = (u / NCH) & 3, b = u / (NCH * NH);
        const float k_k = C.in[I_RKK][l * GW + h * 64 + lane], k_a = C.in[I_RKA][l * GW + h * 64 + lane];
#pragma unroll 1
        for (int d = 0; d < 2; ++d) {
            const int n = d ? (c < 4 ? 3 - c : 71 - c) : c;
            const float ril = rinv[(size_t)seqrow_raster(n * 64 + lane, d, b) * 4 + h];
#pragma unroll
            for (int r = 0; r < 4; ++r) { const int idx2 = pw * 64 + lane + 128 * r, t = idx2 >> 3, part = idx2 & 7; const int row = seqrow_raster(n * 64 + t, d, b);
                *(LAS v4u*)(Kk + t * MP + 8 * part) = *(const v4u*)(WA + (size_t)row * 1024 + d * 256 + h * 64 + 8 * part);
                *(LAS v4u*)(Bh + t * MP + 8 * part) = *(const v4u*)(WA + (size_t)row * 1024 + (2 + d) * 256 + h * 64 + 8 * part);
                *(LAS v4u*)(Kh + t * MP + 8 * part) = *(const v4u*)(rkv + (size_t)row * 768 + 256 + h * 64 + 8 * part); }
            __syncthreads();
            float x[64];
            if (pw == 0) {
                float cc = 1.0f;
#pragma unroll
                for (int t = 0; t < 64; ++t) {
                    const float wv = bf2f(Kk[t * MP + lane]), av = bf2f(Bh[t * MP + lane]), ks = bf2f(Kh[t * MP + lane]);
                    const float kap = ks * k_k * __shfl(ril, t);
                    const float cprev = cc; cc *= wv; const float ic = 1.0f / cc;
                    x[t] = kap * cprev;
                    Kk[t * MP + lane] = (bf16)f2bf1(x[t]); Bh[t * MP + lane] = (bf16)f2bf1(kap * av * ic); Kh[t * MP + lane] = (bf16)f2bf1(ks * (1.0f + (av - 1.0f) * k_a) * ic);
                }
            }
            __syncthreads();
            f32x4 T[10];
            {
                const LAS bf16* Bsrc = pw ? Kh : Bh;
                int tix = 0;
#pragma unroll
                for (int it = 0; it < 4; ++it)
#pragma unroll
                    for (int jt = 0; jt <= it; ++jt, ++tix) {
                        f32x4 acc = (f32x4){0.f, 0.f, 0.f, 0.f};
#pragma unroll
                        for (int s = 0; s < 2; ++s) acc = mfma16(ld_frag16(Kk + (16 * it + l15) * MP + 32 * s + 8 * q), ld_frag16(Bsrc + (16 * jt + l15) * MP + 32 * s + 8 * q), acc);
#pragma unroll
                        for (int r = 0; r < 4; ++r) { const int i = 16 * it + 4 * q + r, j = 16 * jt + l15; T[tix][r] = (j < i) ? acc[r] : 0.f; }
                    }
            }
            __syncthreads();
            {
                int tix = 0;
#pragma unroll
                for (int it = 0; it < 4; ++it)
#pragma unroll
                    for (int jt = 0; jt <= it; ++jt, ++tix)
#pragma unroll
                        for (int r = 0; r < 4; ++r) { const int i = 16 * it + 4 * q + r, j = 16 * jt + l15;
                            if (pw == 0) Lm[i * LP + j] = T[tix][r]; else Lk16[i * MP + j] = (bf16)f2bf1(T[tix][r]); }
            }
            __syncthreads();
            if (pw) {
#pragma unroll
                for (int i = 0; i < 64; ++i) x[i] = (i > lane) ? bf2f(Lk16[i * MP + lane]) : 0.f;
            }
#pragma unroll
            for (int i = 0; i < 64; ++i) {
                float a0 = x[i], a1 = 0.f;
                int roff = i * LP; if (i >= 2) asm volatile("" : "+v"(roff) : "v"(x[i - 2]));
                const LAS float* lrow = Lm + roff;
#pragma unroll
                for (int j4 = 0; j4 < i; j4 += 4) { const f32x4 lv = *(const LAS f32x4*)(lrow + j4);
                    a0 -= lv.x * x[j4]; if (j4 + 1 < i) a1 -= lv.y * x[j4 + 1]; if (j4 + 2 < i) a0 -= lv.z * x[j4 + 2]; if (j4 + 3 < i) a1 -= lv.w * x[j4 + 3]; }
                x[i] = a0 + a1;
            }
            if (active) { bf16* dst = rw_blob_row(C, d, pw, b, c, h, lane);
#pragma unroll
                for (int g = 0; g < 8; ++g) { v4u o; o.x = pk2(x[8 * g], x[8 * g + 1]); o.y = pk2(x[8 * g + 2], x[8 * g + 3]); o.z = pk2(x[8 * g + 4], x[8 * g + 5]); o.w = pk2(x[8 * g + 6], x[8 * g + 7]);
                    *(v4u*)(dst + 8 * g) = o; } }
            __syncthreads();
        }
    }
}

template <bool DRY>
__device__ __forceinline__ void rwkv_chunked(const Ctx& C, int l, int idx) {
    const int d = idx >> 5, b = (idx >> 2) & 7, h = idx & 3, lane = C.lane, w = C.wave, l15 = lane & 15, q = lane >> 4;
    const int it = w & 3, vtp = w >> 2;
    constexpr int IMG = 64 * MP * 2;
    LAS unsigned char* L0 = C.lds;
    LAS bf16* Wi = (LAS bf16*)L0; LAS bf16* Ti = Wi + 64 * MP; LAS bf16* Rh = Ti + 64 * MP; LAS bf16* Kh = Rh + 64 * MP; LAS bf16* Bh = Kh + 64 * MP;
    LAS bf16* UT = (LAS bf16*)(L0 + 11 * IMG);
    LAS float* cLv = (LAS float*)(L0 + 14 * IMG);
    const bf16* WA = WSP(const bf16, WS_HB); const bf16* rkv = WSP(const bf16, WS_RKV); const float* rinv = WSP(const float, WS_RINV);
    bf16* outb = WSP(bf16, WS_OUTB) + (size_t)d * T_ALL * 256;
    const int tt = C.tid >> 3, part = C.tid & 7;
    for (int i = C.tid; i < 2 * IMG / 4; i += NTHR) ((LAS unsigned*)(L0 + 12 * IMG))[i] = 0u;
    float kkw[8], kaw[8];
#pragma unroll
    for (int e = 0; e < 8; ++e) { kkw[e] = C.in[I_RKK][l * GW + h * 64 + 8 * w + e]; kaw[e] = C.in[I_RKA][l * GW + h * 64 + 8 * w + e]; }
    v4u gr, gk, gv, gw, ga, gbw, gbt; float gri;
    auto gload = [&](int n) {
        const int c = d ? (n < 4 ? 3 - n : 71 - n) : n;
        const int row = seqrow_raster(n * 64 + lane, d, b);
        const bf16* pr = rkv + (size_t)row * 768 + h * 64 + 8 * w;
        gr = *(const v4u*)pr; gk = *(const v4u*)(pr + 256); gv = *(const v4u*)(pr + 512);
        gw = *(const v4u*)(WA + (size_t)row * 1024 + d * 256 + h * 64 + 8 * w); ga = *(const v4u*)(WA + (size_t)row * 1024 + (2 + d) * 256 + h * 64 + 8 * w);
        gri = rinv[(size_t)row * 4 + h];
        gbw = *(const v4u*)(rw_blob_row(C, d, 0, b, c, h, tt) + 8 * part); gbt = *(const v4u*)(rw_blob_row(C, d, 1, b, c, h, tt) + 8 * part);
    };
    auto images = [&](int bufi) {
        LAS bf16* VT = (LAS bf16*)(L0 + (5 + 3 * bufi) * IMG); LAS bf16* KcT = VT + 64 * MP; LAS bf16* BcT = KcT + 64 * MP;
        const unsigned rw_[4] = {gr.x, gr.y, gr.z, gr.w}, kw_[4] = {gk.x, gk.y, gk.z, gk.w}, vw_[4] = {gv.x, gv.y, gv.z, gv.w}, ww_[4] = {gw.x, gw.y, gw.z, gw.w}, aw_[4] = {ga.x, ga.y, ga.z, ga.w};
        float rh[8], kh[8], bh[8];
#pragma unroll
        for (int e = 0; e < 8; ++e) {
            const float rs = (e & 1) ? bfhi(rw_[e >> 1]) : bflo(rw_[e >> 1]), ks = (e & 1) ? bfhi(kw_[e >> 1]) : bflo(kw_[e >> 1]);
            const float wv = (e & 1) ? bfhi(ww_[e >> 1]) : bflo(ww_[e >> 1]), av = (e & 1) ? bfhi(aw_[e >> 1]) : bflo(aw_[e >> 1]);
            const float lw = __logf(wv);
            const float cum = wave_incl_sum(lw, lane), cumL = __shfl(cum, 63);
            const float kap = ks * kkw[e] * gri, ktil = ks * (1.0f + (av - 1.0f) * kaw[e]);
            const float cf = __expf(cum), icf = __expf(-cum), dec = __expf(cumL - cum);
            rh[e] = rs * cf; kh[e] = ktil * icf; bh[e] = kap * av * icf;
            const unsigned short vraw = (e & 1) ? (unsigned short)(vw_[e >> 1] >> 16) : (unsigned short)(vw_[e >> 1] & 0xffffu);
            VT[(8 * w + e) * MP + lane] = vraw; KcT[(8 * w + e) * MP + lane] = (bf16)f2bf1(ktil * dec); BcT[(8 * w + e) * MP + lane] = (bf16)f2bf1(-(kap * av * dec));
            if (lane == 63) cLv[bufi * 64 + 8 * w + e] = __expf(cumL);
        }
        { v4u o; o.x = pk2(rh[0], rh[1]); o.y = pk2(rh[2], rh[3]); o.z = pk2(rh[4], rh[5]); o.w = pk2(rh[6], rh[7]); *(LAS v4u*)(Rh + lane * MP + 8 * w) = o; }
        { v4u o; o.x = pk2(kh[0], kh[1]); o.y = pk2(kh[2], kh[3]); o.z = pk2(kh[4], kh[5]); o.w = pk2(kh[6], kh[7]); *(LAS v4u*)(Kh + lane * MP + 8 * w) = o; }
        { v4u o; o.x = pk2(bh[0], bh[1]); o.y = pk2(bh[2], bh[3]); o.z = pk2(bh[4], bh[5]); o.w = pk2(bh[6], bh[7]); *(LAS v4u*)(Bh + lane * MP + 8 * w) = o; }
        const unsigned bw_[4] = {gbw.x, gbw.y, gbw.z, gbw.w}, bt_[4] = {gbt.x, gbt.y, gbt.z, gbt.w};
#pragma unroll
        for (int e = 0; e < 4; ++e) {
            Wi[(8 * part + 2 * e) * MP + tt] = (bf16)(bw_[e] & 0xffffu); Wi[(8 * part + 2 * e + 1) * MP + tt] = (bf16)(bw_[e] >> 16);
            Ti[(8 * part + 2 * e) * MP + tt] = (bf16)(bt_[e] & 0xffffu); Ti[(8 * part + 2 * e + 1) * MP + tt] = (bf16)(bt_[e] >> 16);
        }
    };
    f32x4 Zst[2]; Zst[0] = Zst[1] = (f32x4){0.f, 0.f, 0.f, 0.f};
    const f32x4 z4 = (f32x4){0.f, 0.f, 0.f, 0.f};
    gload(0); images(0); gload(1);
#pragma unroll 1
    for (int n = 0; n < NCH; ++n) {
        RAW_BARRIER();
        const LAS bf16* VT = (const LAS bf16*)(L0 + (5 + 3 * (n & 1)) * IMG); const LAS bf16* KcT = VT + 64 * MP; const LAS bf16* BcT = KcT + 64 * MP;
        const LAS bf16* Zi = (const LAS bf16*)(L0 + (12 + (n & 1)) * IMG); LAS bf16* Zn = (LAS bf16*)(L0 + (12 + ((n + 1) & 1)) * IMG);
        const int arow = (16 * it + l15) * MP + 8 * q;
        const fragb Wf0 = ld_frag16(Wi + arow), Wf1 = ld_frag16(Wi + arow + 32), Tf0 = ld_frag16(Ti + arow), Tf1 = ld_frag16(Ti + arow + 32), Rf0 = ld_frag16(Rh + arow), Rf1 = ld_frag16(Rh + arow + 32);
        const int icol = 16 * it + l15;
        f32x4 pk[4], pb[4];
#pragma unroll
        for (int jt = 0; jt < 4; ++jt) {
            pk[jt] = z4; pb[jt] = z4;
            if (jt <= it) {
                const int jrow = (16 * jt + l15) * MP + 8 * q;
                f32x4 sk = mfma16(ld_frag16(Kh + jrow), Rf0, z4); sk = mfma16(ld_frag16(Kh + jrow + 32), Rf1, sk);
                f32x4 sb = mfma16(ld_frag16(Bh + jrow), Rf0, z4); sb = mfma16(ld_frag16(Bh + jrow + 32), Rf1, sb);
#pragma unroll
                for (int r = 0; r < 4; ++r) { const int j = 16 * jt + 4 * q + r; pk[jt][r] = (j <= icol) ? sk[r] : 0.f; pb[jt][r] = (j <= icol) ? -sb[r] : 0.f; }
            }
        }
        fragb Pk0 = pack_frag(pk[0], pk[1]), Pk1 = pack_frag(pk[2], pk[3]), Pb0 = pack_frag(pb[0], pb[1]), Pb1 = pack_frag(pb[2], pb[3]);
        f32x4 RZ[2];
#pragma unroll
        for (int v2 = 0; v2 < 2; ++v2) {
            const int vrow = 16 * (2 * vtp + v2) + l15;
            const fragb z0 = ld_frag16(Zi + vrow * MP + 8 * q), z1 = ld_frag16(Zi + vrow * MP + 32 + 8 * q);
            f32x4 u = mfma16(Wf0, z0, z4); u = mfma16(Wf1, z1, u);
            u = mfma16(Tf0, ld_frag16(VT + vrow * MP + 8 * q), u); if (it >= 2) u = mfma16(Tf1, ld_frag16(VT + vrow * MP + 32 + 8 * q), u);
            RZ[v2] = mfma16(Rf0, z0, z4); RZ[v2] = mfma16(Rf1, z1, RZ[v2]);
            v2u o; o.x = pk2(u.x, u.y); o.y = pk2(u.z, u.w);
            *(LAS v2u*)(UT + vrow * MP + 16 * it + 4 * q) = o;
        }
        RAW_BARRIER();
        {
            const f32x4 cl4 = *(const LAS f32x4*)(cLv + (n & 1) * 64 + 16 * it + 4 * q);
            const LAS bf16* kr = KcT + (16 * it + l15) * MP + 4 * q; const LAS bf16* br = BcT + (16 * it + l15) * MP + 4 * q;
            const fragb kc0 = ld_frag8x2(kr, kr + 16), kc1 = ld_frag8x2(kr + 32, kr + 48), bc0 = ld_frag8x2(br, br + 16), bc1 = ld_frag8x2(br + 32, br + 48);
#pragma unroll
            for (int v2 = 0; v2 < 2; ++v2) {
                const int vrow = 16 * (2 * vtp + v2) + l15;
                const LAS bf16* vr = VT + vrow * MP + 4 * q; const LAS bf16* ur = UT + vrow * MP + 4 * q;
                const fragb vp0 = ld_frag8x2(vr, vr + 16), vp1 = ld_frag8x2(vr + 32, vr + 48), up0 = ld_frag8x2(ur, ur + 16), up1 = ld_frag8x2(ur + 32, ur + 48);
                f32x4 y = mfma16(Pk0, vp0, RZ[v2]); y = mfma16(Pb0, up0, y);
                if (it >= 2) { y = mfma16(Pk1, vp1, y); y = mfma16(Pb1, up1, y); }
#pragma unroll
                for (int r = 0; r < 4; ++r) { const int row = seqrow_raster(n * 64 + 16 * it + 4 * q + r, d, b); if (!DRY) outb[(size_t)row * 256 + h * 64 + vrow] = (bf16)f2bf1(y[r]); }
                f32x4 zn = mfma16(kc0, vp0, z4); zn = mfma16(kc1, vp1, zn); zn = mfma16(bc0, up0, zn); zn = mfma16(bc1, up1, zn);
                Zst[v2] = Zst[v2] * cl4 + zn;
                v2u so; so.x = pk2(Zst[v2].x, Zst[v2].y); so.y = pk2(Zst[v2].z, Zst[v2].w);
                *(LAS v2u*)(Zn + vrow * MP + 16 * it + 4 * q) = so;
            }
        }
        if (n + 1 < NCH) { images((n + 1) & 1); if (n + 2 < NCH) gload(n + 2); }
    }
    __syncthreads();
}
__device__ __forceinline__ void moe_scatter(const Ctx& C, int moe_li, int nrows) {
    const unsigned* gc = WSP(const unsigned, WS_CTL) + CW_MOECNT + 64 * moe_li;
    LAS int* pst = (LAS int*)C.lds;
    {
        int pe[8]; int acc = 0;
#pragma unroll
        for (int e = 0; e < NE; ++e) { const int blks = ((int)gc[e] + 255) >> 8; if (C.tid == e) pst[e] = acc * 256; acc += blks; pe[e] = acc; }
        if (C.wg == 0 && C.tid < MOE_MAXBLK) { int be = 0;
#pragma unroll
            for (int e = 0; e < NE; ++e) be += (pe[e] <= C.tid) ? 1 : 0;
            int* tab = WSP(int, WS_TAB); tab[1 + C.tid] = be < NE ? be : NE - 1; if (C.tid == 0) tab[0] = acc; }
    }
    __syncthreads();
    const unsigned* route = WSP(const unsigned, WS_ROUTE); const unsigned* wgbase = WSP(const unsigned, WS_WGBASE);
    const bf16* hb = WSP(const bf16, WS_HB); bf16* am = WSP(bf16, WS_MIX); int* pos = WSP(int, WS_POS);
    const int gw = C.wg * NWAVES + C.wave, NGW = C.G * NWAVES;
    for (int m = gw; m < nrows; m += NGW) {
        const v4u a = *(const v4u*)(route + (size_t)m * 8);
        const int e0 = (int)a.x, e1 = (int)a.y;
        const int p0 = pst[e0] + (int)wgbase[C.wg * 8 + e0] + (int)a.z, p1 = pst[e1] + (int)wgbase[C.wg * 8 + e1] + (int)a.w;
        const v4u r0 = *(const v4u*)(hb + (size_t)m * 1024 + C.lane * 8), r1 = *(const v4u*)(hb + (size_t)m * 1024 + 512 + C.lane * 8);
        *(v4u*)(am + (size_t)p0 * 1024 + C.lane * 8) = r0; *(v4u*)(am + (size_t)p0 * 1024 + 512 + C.lane * 8) = r1;
        *(v4u*)(am + (size_t)p1 * 1024 + C.lane * 8) = r0; *(v4u*)(am + (size_t)p1 * 1024 + 512 + C.lane * 8) = r1;
        if (C.lane == 0) { pos[(size_t)m * 2] = p0; pos[(size_t)m * 2 + 1] = p1; }
    }
    __syncthreads();
}
__device__ __forceinline__ void moe_combine(const Ctx& C, int l, int nrows) {
    const unsigned* route = WSP(const unsigned, WS_ROUTE); const int* pos = WSP(const int, WS_POS); const bf16* ym = WSP(const bf16, WS_MIX);
    const float* modv = WSP(const float, WS_MODV) + (size_t)l * 9 * 6144 + 5 * 1024;
    float* xc = WSP(float, WS_XC);
    const int gw = C.wg * NWAVES + C.wave, NGW = C.G * NWAVES;
    for (int m = gw; m < nrows; m += NGW) {
        const bool isctx = m >= T_LAT;
        float* xr = isctx ? xc + (size_t)(m - T_LAT) * 1024 : C.out + (size_t)m * 1024;
        const float* gv = modv + (size_t)(isctx ? 8 : (m >> 12)) * 6144;
        const int p0 = pos[(size_t)m * 2], p1 = pos[(size_t)m * 2 + 1];
        const float w0 = __builtin_bit_cast(float, route[(size_t)m * 8 + 4]), w1 = __builtin_bit_cast(float, route[(size_t)m * 8 + 5]);
#pragma unroll
        for (int j = 0; j < 4; ++j) {
            const int col = 4 * C.lane + 256 * j;
            const v2u a = *(const v2u*)(ym + (size_t)p0 * 1024 + col), b = *(const v2u*)(ym + (size_t)p1 * 1024 + col);
            const f32x4 ya = (f32x4){bflo(a.x), bfhi(a.x), bflo(a.y), bfhi(a.y)}, yb = (f32x4){bflo(b.x), bfhi(b.x), bflo(b.y), bfhi(b.y)};
            const f32x4 g = *(const f32x4*)(gv + col); f32x4 x = *(const f32x4*)(xr + col);
            x = x + g * (ya * w0 + yb * w1);
            *(f32x4*)(xr + col) = x;
        }
    }
}
__device__ __forceinline__ void final_norm(const Ctx& C) {
    const int gw = C.wg * NWAVES + C.wave, NGW = C.G * NWAVES;
    f32x4 gv[4];
#pragma unroll
    for (int j = 0; j < 4; ++j) gv[j] = *(const f32x4*)(C.in[I_FNG] + 4 * C.lane + 256 * j);
    for (int m = gw; m < T_LAT; m += NGW) {
        float* xr = C.out + (size_t)m * 1024;
        f32x4 v[4]; float s = 0.f;
#pragma unroll
        for (int j = 0; j < 4; ++j) { v[j] = *(const f32x4*)(xr + 4 * C.lane + 256 * j); s += (v[j].x * v[j].x + v[j].y * v[j].y) + (v[j].z * v[j].z + v[j].w * v[j].w); }
        const float rs = 1.0f / sqrtf(wave_sum(s) * (1.0f / 1024.0f) + 1e-6f);
#pragma unroll
        for (int j = 0; j < 4; ++j) *(f32x4*)(xr + 4 * C.lane + 256 * j) = v[j] * rs * gv[j];
    }
}

constexpr int NPH_L = 12, PH_FINAL = 1 + DEPTH * NPH_L, NPHASE = PH_FINAL + 1;
__host__ __device__ inline bool phase_exists(int ph) {
    if (ph == 0 || ph == PH_FINAL) return true;
    const int l = (ph - 1) / NPH_L, k = (ph - 1) % NPH_L;
    if (!(l & 1) && k >= 10) return false;
    return true;
}
#ifndef PH_MASK
#define PH_MASK 0xFFFFFF
#endif
#define PM(k) ((PH_MASK >> (k)) & 1)
#ifndef SK_MASK
#define SK_MASK 0xFFFF
#endif
#define SK(k) ((SK_MASK >> (k)) & 1)
#ifndef REP_MASK
#define REP_MASK 0
#endif
#define NREP(k) (((REP_MASK >> (k)) & 1) ? 2 : 1)

__global__ void __launch_bounds__(NTHR, 2) fwd_kernel(Args args) {
    extern __shared__ __attribute__((aligned(16))) unsigned char lds_raw[];
    Ctx C; C.in = args.in; C.out = args.out; C.ws = args.ws; C.lds = (LAS unsigned char*)lds_raw;
    C.tid = threadIdx.x; C.lane = C.tid & 63; C.wave = __builtin_amdgcn_readfirstlane(C.tid >> 6); C.G = gridDim.x; C.wg = blockIdx.x;
    volatile LAS unsigned* MISC = (volatile LAS unsigned*)(C.lds + MISC_OFF);
    if (C.tid < 64) MISC[C.tid] = 0u;
    __syncthreads();
    const int lo = args.ph_lo, hi = args.ph_hi;
    const bool multi = (hi - lo) > 1;
    if (multi) (void)xcd_barrier_post(WSP(unsigned, WS_CTL) + CW_BAR, MISC + 8);
#define IN(k) (lo <= (k) && (k) < hi)
#define SEAM(k) do { if (IN((k) + 1)) { XcdBarrier b2_; b2_.bar = WSP(unsigned, WS_CTL) + CW_BAR; b2_.x = xb_xcc_id(); b2_.st = (volatile LAS unsigned*)(C.lds + MISC_OFF) + 8; xcd_barrier(b2_); } } while (0)
#define FRESH() do { int t_ = threadIdx.x; asm volatile("" : "+v"(t_)); C.tid = t_; C.lane = t_ & 63; C.wave = __builtin_amdgcn_readfirstlane(t_ >> 6); } while (0)
#define PHASE(bit, k) if (PM(bit) && IN(pb + (k))) for (int rep_ = 0; rep_ < NREP(bit); ++rep_)

    if (PM(20) && IN(0)) { phase_pre(C); SEAM(0); }

#pragma unroll 1
    for (int l = 0; l < DEPTH; ++l) {
        const int pb = 1 + l * NPH_L;
        if (hi <= pb || lo >= pb + NPH_L) continue;
        const bool last = (l == DEPTH - 1), moe = (l & 1);
        const int nrows = last ? T_LAT : T_ALL;
        const float* xlat = (l == 0) ? C.in[I_X] : C.out; const float* xctx = (l == 0) ? C.in[I_CTX] : WSP(const float, WS_XC);
        const float* modv = WSP(const float, WS_MODV) + (size_t)l * 9 * 6144;

        PHASE(0, 0) { FRESH();
            convert_small(C, l);
            if (l == 0) { FRESH(); convert_items(C, 0, 3, C.wg * NWAVES + C.wave, C.G * NWAVES); }
            __syncthreads();
            FRESH(); norm_rows<false>(C, l, xlat, xctx, C.in[I_NMIXG] + l * 1024, 0, 1024, T_ALL, 0);
            SEAM(pb + 0);
        }
        PHASE(1, 1) { FRESH();
            pg8::Gemm g{WSP(const bf16, WS_HB), WSP(const bf16, WS_WIN), T_ALL, PLD, 1024, 0};
            pg8::StaticOrder S; S.init(T_ALL, PLD, C.G, C.wg);
            pg8::EpiBf16<0> E{WSP(bf16, WS_P), PLD, nullptr, 0, 0};
            pg8::gemm_phase<pg8::EpiBf16<0>, pg8::StaticOrder, false>(C.lds, g, S, E, nullptr);
            SEAM(pb + 1);
        }
        PHASE(2, 2) { FRESH();
            for (int r2_ = 0; r2_ < NREP(16); ++r2_) { FRESH(); if (SK(0)) for (int u = C.wg; u < NB * NCH; u += C.G) lru_chunk_mfma<false>(C, l, u / NCH, u % NCH); }
            for (int r2_ = 0; r2_ < NREP(17); ++r2_) { FRESH(); if (SK(1)) for (int u = C.wg; u < NB * NCH; u += C.G) rwkv_prep2(C, l, u / NCH, u % NCH); }
            FRESH(); if (SK(2)) for (int u = C.wg; u < NB * NCH; u += C.G) gdn_prep(C, l, u / NCH, u % NCH);
            SEAM(pb + 2);
        }
        if (PM(3) && IN(pb + 3)) { FRESH();
            if (SK(9)) gdn_solve_units(C, l);
            FRESH(); if (SK(10)) rwkv_solve_units(C, l);
            FRESH(); if (SK(6) && C.wg < 8) lru_carry(C, C.wg * NTHR + C.tid);
            SEAM(pb + 3);
        }
        if (PM(4) && IN(pb + 4)) { FRESH();
            if (SK(3) && C.wg < 64) { FRESH(); rwkv_chunked<false>(C, l, C.wg); }
            else if (SK(4) && C.wg >= 128 && C.wg < 192) { FRESH(); mlstm_chunked(C, l, C.wg - 128); }
            else if (SK(5) && C.wg >= 192) { FRESH(); gdn_chunked<false>(C, l, C.wg - 192); }
            else if (C.wg >= 64 && C.wg < 128) {
                FRESH(); if (l > 0) convert_items(C, l, 2, (C.wg - 64) * NWAVES + C.wave, 64 * NWAVES);
                if (l + 1 < DEPTH) { FRESH(); convert_items(C, l + 1, 1, (C.wg - 64) * NWAVES + C.wave, 64 * NWAVES); }
            }
            if (C.wg >= 64) {
                FRESH();
                unsigned* qh = WSP(unsigned, WS_CTL) + CW_LRUQ + 64 * l; LAS unsigned* slot = (LAS unsigned*)(C.lds + MISC_OFF + 128);
                const int nun = last ? NB * 64 : NB * NCH;
                for (;;) {
                    __syncthreads();
                    if (C.tid == 0) *slot = atomicAdd(qh, 1u);
                    __syncthreads();
                    const int u = (int)*slot;
                    if (u >= nun) break;
                    const int b = last ? (u >> 6) : (u / NCH), c = last ? 4 + (u & 63) : (u % NCH);
                    if (SK(7)) lru_chunk_mfma<true>(C, l, b, c);
                }
            }
            SEAM(pb + 4);
        }
        PHASE(5, 5) { FRESH();
            if (SK(8)) finish_rows(C, l, nrows);
            SEAM(pb + 5);
        }
        if (PM(6) && IN(pb + 6)) { FRESH();
            pg8::Gemm g{WSP(const bf16, WS_HB), WSP(const bf16, WS_WOUT), nrows, 1024, 1024, 0};
            pg8::StaticOrder S; S.init(nrows, 1024, C.G, C.wg);
            pg8::EpiRes E{xlat, xctx, C.out, WSP(float, WS_XC), modv + 2 * 1024};
            pg8::gemm_phase<pg8::EpiRes, pg8::StaticOrder, false>(C.lds, g, S, E, nullptr);
            SEAM(pb + 6);
        }
        if (PM(7) && IN(pb + 7)) { FRESH();
            if (moe) norm_rows<true>(C, l, C.out, WSP(const float, WS_XC), C.in[I_NFFNG] + l * 1024, 3 * 1024, 4 * 1024, nrows, l >> 1);
            else norm_rows<false>(C, l, C.out, WSP(const float, WS_XC), C.in[I_NFFNG] + l * 1024, 3 * 1024, 4 * 1024, nrows, 0);
            SEAM(pb + 7);
        }
        if (!moe) {
            if (PM(8) && IN(pb + 8)) { FRESH();
                pg8::Gemm g{WSP(const bf16, WS_HB), WSP(const bf16, WS_WGU), nrows, 2 * DFF, 1024, 0};
                pg8::StaticOrder S; S.init(nrows, 2 * DFF, C.G, C.wg);
                pg8::EpiSwiglu E{WSP(bf16, WS_P), DFF};
                pg8::gemm_phase<pg8::EpiSwiglu, pg8::StaticOrder, false>(C.lds, g, S, E, nullptr);
                SEAM(pb + 8);
            }
            if (PM(9) && IN(pb + 9)) { FRESH();
                pg8::Gemm g{WSP(const bf16, WS_P), WSP(const bf16, WS_WDN), nrows, 1024, DFF, 0};
                pg8::StaticOrder S; S.init(nrows, 1024, C.G, C.wg);
                pg8::EpiRes E{C.out, WSP(const float, WS_XC), C.out, WSP(float, WS_XC), modv + 5 * 1024};
                pg8::gemm_phase<pg8::EpiRes, pg8::StaticOrder, false>(C.lds, g, S, E, nullptr);
                SEAM(pb + 11);
            }
        } else {
            if (PM(10) && IN(pb + 8)) { FRESH(); moe_scatter(C, l >> 1, nrows); SEAM(pb + 8); }
            if (PM(11) && IN(pb + 9)) { FRESH();
                pg8::Gemm g{WSP(const bf16, WS_MIX), WSP(const bf16, WS_WGU), 0, 2 * DFE, 1024, (size_t)2 * DFE * 1024};
                pg8::MoeOrder S; S.init(WSP(const int, WS_TAB), (2 * DFE) / 256, C.G, C.wg);
                pg8::EpiSwiglu E{WSP(bf16, WS_P), DFE};
                pg8::gemm_phase<pg8::EpiSwiglu, pg8::MoeOrder, false>(C.lds, g, S, E, nullptr);
                SEAM(pb + 9);
            }
            if (PM(12) && IN(pb + 10)) { FRESH();
                pg8::Gemm g{WSP(const bf16, WS_P), WSP(const bf16, WS_WDN), 0, 1024, DFE, (size_t)1024 * DFE};
                pg8::MoeOrder S; S.init(WSP(const int, WS_TAB), 4, C.G, C.wg);
                pg8::EpiBf16<0> E{WSP(bf16, WS_MIX), 1024, nullptr, 0, 0};
                pg8::gemm_phase<pg8::EpiBf16<0>, pg8::MoeOrder, false>(C.lds, g, S, E, nullptr);
                SEAM(pb + 10);
            }
            if (PM(13) && IN(pb + 11)) { FRESH(); moe_combine(C, l, nrows); SEAM(pb + 11); }
        }
    }
    if (PM(21) && IN(PH_FINAL)) final_norm(C);
}

extern "C" void kernel_launch(void* const* d_in, const int* in_sizes, int n_in, void* d_out, int out_size, void* d_ws, size_t ws_size, hipStream_t stream) {
    static int grid = 0;
    if (grid == 0) {
        if (n_in != N_IN || in_sizes[0] != T_LAT * DM || out_size != T_LAT * DM || ws_size < WS_END) {
            fprintf(stderr, "kernel_launch: unexpected problem (n_in %d, in0 %d, out %d, ws %zu < %zu)\n", n_in, n_in > 0 ? in_sizes[0] : -1, out_size, ws_size, (size_t)WS_END); grid = -1; return; }
        int dev = 0, cus = 0, per_cu = 0;
        if (hipGetDevice(&dev) != hipSuccess || hipDeviceGetAttribute(&cus, hipDeviceAttributeMultiprocessorCount, dev) != hipSuccess) { grid = -1; return; }
        if (hipFuncSetAttribute((const void*)fwd_kernel, hipFuncAttributeMaxDynamicSharedMemorySize, LDS_BYTES) != hipSuccess) { fprintf(stderr, "kernel_launch: hipFuncSetAttribute failed\n"); grid = -1; return; }
        if (hipOccupancyMaxActiveBlocksPerMultiprocessor(&per_cu, (const void*)fwd_kernel, NTHR, LDS_BYTES) != hipSuccess || per_cu < 1) { fprintf(stderr, "kernel_launch: occupancy query says %d\n", per_cu); grid = -1; return; }
        grid = cus;
        if (grid != 256) fprintf(stderr, "kernel_launch: note: %d CUs\n", grid);
    }
    if (grid < 0) return;
    if (hipMemsetAsync((char*)d_ws + WS_CTL, 0, CTL_BYTES, stream) != hipSuccess) return;
    Args a{};
    for (int i = 0; i < N_IN; ++i) a.in[i] = (const float*)d_in[i];
    a.out = (float*)d_out; a.ws = (unsigned char*)d_ws;
#if MK_ONE_LAUNCH
    a.ph_lo = 0; a.ph_hi = NPHASE;
    hipLaunchKernelGGL(fwd_kernel, dim3(grid), dim3(NTHR), LDS_BYTES, stream, a);
#else
    for (int ph = 0; ph < NPHASE; ++ph) { if (!phase_exists(ph)) continue; a.ph_lo = ph; a.ph_hi = ph + 1; hipLaunchKernelGGL(fwd_kernel, dim3(grid), dim3(NTHR), LDS_BYTES, stream, a); }
#endif
}
```

```cpp
#define MK_ONE_LAUNCH 1
#include <hip/hip_runtime.h>
#include <cstdio>
#include <cstdint>

#define GAS __attribute__((address_space(1)))
#define LAS __attribute__((address_space(3)))
typedef unsigned short bf16;
typedef unsigned v4u __attribute__((ext_vector_type(4)));
typedef unsigned v2u __attribute__((ext_vector_type(2)));
typedef float f32x4 __attribute__((ext_vector_type(4)));
typedef float f32x2 __attribute__((ext_vector_type(2)));
typedef short bf16x8 __attribute__((ext_vector_type(8)));
#define LDS_WAIT() asm volatile("s_waitcnt lgkmcnt(0)" ::: "memory")
#define VM_WAIT() asm volatile("s_waitcnt vmcnt(0)" ::: "memory")

constexpr int DM = 1024, NB = 8, SEQ = 4096, DEPTH = 4, CTXL = 256, GW = 256, HD = 64, NH = 4;
constexpr int T_LAT = NB * SEQ, T_CTX = NB * CTXL, T_ALL = T_LAT + T_CTX;
constexpr int IN_COLS = 3552, PLD = 3584;
constexpr int OFF_B = 512, OFF_C = 1472, OFF_D = 2512, B_COLS = 960;
constexpr int DFF = 2816, NE = 8, DFE = 1408;
constexpr int NCH = 68;
constexpr int NSTEP = 4352;
constexpr int MOE_MAXBLK = 280;
constexpr int NWAVES = 8, NTHR = 512;

constexpr size_t MiB = 1u << 20;
constexpr size_t WS_CTL = 0, CTL_BYTES = 1 * MiB;
constexpr size_t WS_MODV = 1 * MiB;
constexpr size_t WS_XC = 2 * MiB;
constexpr size_t WS_WIN = 10 * MiB;
constexpr size_t WS_WOUT = 17 * MiB;
constexpr size_t WS_WGU = 19 * MiB;
constexpr size_t WS_WDN = 63 * MiB;
constexpr size_t WS_HB = 85 * MiB;
constexpr size_t WS_P = 153 * MiB;
constexpr size_t WS_MIX = 391 * MiB;
constexpr size_t WS_OUTB = WS_MIX, WS_OUTC = WS_MIX + 34 * MiB, WS_OUTD = WS_MIX + 68 * MiB, WS_GQ = WS_MIX + 102 * MiB, WS_G = WS_MIX + 153 * MiB;
constexpr size_t WS_RKV = WS_MIX + 170 * MiB;
constexpr size_t WS_SMALL = 612 * MiB;
constexpr size_t WS_LSUM = WS_SMALL;
constexpr size_t WS_HIN = WS_SMALL + 3 * MiB;
constexpr size_t WS_ROUTE = WS_SMALL + 5 * MiB;
constexpr size_t WS_POS = WS_SMALL + 7 * MiB;
constexpr size_t WS_BONUS = WS_SMALL + 8 * MiB;
constexpr size_t WS_WGBASE = WS_SMALL + 9 * MiB;
constexpr size_t WS_TAB = WS_WGBASE + 65536;
constexpr size_t WS_LRUWT = WS_SMALL + 10 * MiB;
constexpr size_t WS_RWT = WS_LRUWT + 131072;
constexpr size_t WS_RINV = WS_SMALL + 11 * MiB;
constexpr size_t WS_END = 624 * MiB;
constexpr int CW_MOECNT = 1024;
constexpr int CW_LRUQ = 2048;
constexpr int CW_PREPQ = 2304;
constexpr int CW_SOLVEQ = 2560;
constexpr int CW_BAR = 4096;

constexpr int LDS_BYTES = 135168;
constexpr int MISC_OFF = 131072;

__device__ __forceinline__ unsigned f2bf(float f) { unsigned u = __builtin_bit_cast(unsigned, f); return (u + 0x7fffu + ((u >> 16) & 1u)) >> 16; }
typedef __bf16 bf16n2 __attribute__((ext_vector_type(2)));
__device__ __forceinline__ unsigned pk2(float lo, float hi) { const f32x2 v = {lo, hi}; return __builtin_bit_cast(unsigned, __builtin_convertvector(v, bf16n2)); }
__device__ __forceinline__ unsigned f2bf1(float f) { return pk2(f, f) & 0xffffu; }
__device__ __forceinline__ float bf2f(unsigned short v) { return __builtin_bit_cast(float, (unsigned)v << 16); }
__device__ __forceinline__ float bflo(unsigned v) { return __builtin_bit_cast(float, v << 16); }
__device__ __forceinline__ float bfhi(unsigned v) { return __builtin_bit_cast(float, v & 0xffff0000u); }
__device__ __forceinline__ float wave_sum(float v) {
#pragma unroll
    for (int o = 1; o < 64; o <<= 1) v += __shfl_xor(v, o);
    return v;
}
template <int CTRL> __device__ __forceinline__ float dpp_f(float v) { return __builtin_bit_cast(float, __builtin_amdgcn_update_dpp(0, __builtin_bit_cast(int, v), CTRL, 0xF, 0xF, true)); }
__device__ __forceinline__ float row16_sum(float v) {
    v += dpp_f<0xB1>(v);
    v += dpp_f<0x4E>(v);
    v += dpp_f<0x141>(v);
    v += dpp_f<0x140>(v);
    return v;
}
__device__ __forceinline__ float sigmoidf_(float x) { return 1.0f / (1.0f + __expf(-x)); }
__device__ __forceinline__ float softplusf_(float x) { return fmaxf(x, 0.f) + __logf(1.0f + __expf(-fabsf(x))); }
__device__ __forceinline__ float expm1f_(float x) { return x > -0.3f ? x * (1.0f + x * (0.5f + x * (0.16666667f + x * (0.041666668f + x * 0.0083333338f)))) : __expf(x) - 1.0f; }
__device__ __forceinline__ float siluf_(float x) { return x / (1.0f + __expf(-x)); }
__device__ __forceinline__ float tanhf_(float x) { const float e = __expf(2.0f * x); return 1.0f - 2.0f / (e + 1.0f); }
__device__ __forceinline__ float gelu_tanh(float x) { return 0.5f * x * (1.0f + tanhf_(0.7978845608028654f * (x + 0.044715f * x * x * x))); }
__device__ __forceinline__ f32x4 ld4bf(const bf16* p) { const v2u a = *(const v2u*)p; return (f32x4){bflo(a.x), bfhi(a.x), bflo(a.y), bfhi(a.y)}; }
__device__ __forceinline__ void st4bf(bf16* p, const f32x4& v) { v2u o; o.x = pk2(v.x, v.y); o.y = pk2(v.z, v.w); *(v2u*)p = o; }
#define XB_TMO      128
#define XB_XCNT(j)  (256  + 64 * (j))
#define XB_XSUB(j)  (1280 + 64 * (j))
#define XB_XGEN(j)  (2304 + 64 * (j))
#define XB_TOP      3328
#define XB_TOPGEN   3392
#define XCD_BAR_WORDS 3456
#define XB_SPIN_CAP (1u << 22)

__device__ __forceinline__ unsigned xb_ld(unsigned* p)              { return __hip_atomic_load(p, __ATOMIC_RELAXED, __HIP_MEMORY_SCOPE_AGENT); }
__device__ __forceinline__ unsigned xb_add(unsigned* p, unsigned v) { return __hip_atomic_fetch_add(p, v, __ATOMIC_RELAXED, __HIP_MEMORY_SCOPE_AGENT); }
__device__ __forceinline__ unsigned xb_xcc_id() { return (unsigned)__builtin_amdgcn_s_getreg((3 << 11) | 20) & 0xFu; }
#define XB_SPIN(cond, bar) do { unsigned _sp = 0; while (cond) { __builtin_amdgcn_s_sleep(1); \
    if ((++_sp & 255u) == 0u) { if (xb_ld(&(bar)[XB_TMO])) break; if (_sp > XB_SPIN_CAP) { atomicAdd(&(bar)[XB_TMO], 1u); break; } } } } while (0)

struct XcdBarrier {
    unsigned* bar; unsigned x;
    volatile LAS unsigned* st;
};

__device__ __forceinline__ XcdBarrier xcd_barrier_post(unsigned* bar, volatile LAS unsigned* st) {
    XcdBarrier b; b.bar = bar; b.x = xb_xcc_id(); b.st = st;
    if (threadIdx.x == 0) (void)xb_add(&bar[XB_XCNT(b.x)], 1u);
    return b;
}
__device__ __forceinline__ void xcd_barrier_complete(unsigned* bar, unsigned x, unsigned& nloc, unsigned& nx) {
    const unsigned G = gridDim.x * gridDim.y * gridDim.z;
    unsigned sum, cnt, mine, sp = 0u;
    for (;;) {
        sum = 0u; cnt = 0u; mine = 0u;
#pragma unroll
        for (unsigned j = 0; j < 16; ++j) { const unsigned c = xb_ld(&bar[XB_XCNT(j)]); sum += c; cnt += (c > 0u) ? 1u : 0u; mine = (j == x) ? c : mine; }
        if (sum == G) break;
        __builtin_amdgcn_s_sleep(1);
        if ((++sp & 255u) == 0u) { if (xb_ld(&bar[XB_TMO])) break; if (sp > XB_SPIN_CAP) { atomicAdd(&bar[XB_TMO], 1u); break; } }
    }
    nloc = mine > 0u ? mine : 1u; nx = cnt > 0u ? cnt : 1u;
}

__device__ __forceinline__ void xcd_barrier(const XcdBarrier& b) {
    asm volatile("s_waitcnt vmcnt(0)" ::: "memory");
    __syncthreads();
    if (threadIdx.x == 0) {
        unsigned* bar = b.bar;
        __builtin_amdgcn_s_waitcnt(0);
        unsigned nloc = b.st[0], nx = b.st[1];
        if (nloc == 0u) { xcd_barrier_complete(bar, b.x, nloc, nx); b.st[0] = nloc; b.st[1] = nx; }
        const unsigned old = xb_add(&bar[XB_XSUB(b.x)], 1u);
        const unsigned gen = old / nloc;
        if (old + 1u == (gen + 1u) * nloc) {
            __builtin_amdgcn_fence(__ATOMIC_RELEASE, "agent");
            asm volatile("s_waitcnt vmcnt(0)" ::: "memory");
            const unsigned og = xb_add(&bar[XB_TOP], 1u);
            const unsigned tg = og / nx;
            if (og + 1u == (tg + 1u) * nx) xb_add(&bar[XB_TOPGEN], 1u);
            else XB_SPIN(xb_ld(&bar[XB_TOPGEN]) == tg, bar);
            __builtin_amdgcn_fence(__ATOMIC_ACQUIRE, "agent");
            xb_add(&bar[XB_XGEN(b.x)], 1u);
            asm volatile("s_waitcnt vmcnt(0)" ::: "memory");
        } else {
            XB_SPIN(xb_ld(&bar[XB_XGEN(b.x)]) == gen, bar);
            __builtin_amdgcn_fence(__ATOMIC_ACQUIRE, "agent");
            asm volatile("s_waitcnt vmcnt(0)" ::: "memory");
        }
    }
    __syncthreads();
}

namespace pg8 {
#define PG8_LAS __attribute__((address_space(3)))
typedef unsigned short bf16_t;
typedef short bf16x8 __attribute__((ext_vector_type(8)));
typedef float f32x4 __attribute__((ext_vector_type(4)));
typedef unsigned u32x4 __attribute__((ext_vector_type(4)));
constexpr int BM = 256, BK = 64, HALF = 128, HTB = HALF * BK * 2  , STAGE_BYTES = 8 * HTB, NXCD = 8, WGM = 8;

__host__ __device__ __forceinline__ int lds_byte(int r, int c) { const int st = (r >> 4) * 2 + (c >> 5), rr = r & 15, cc = c & 31, ob = rr * 64 + cc * 2; return st * 1024 + (ob ^ (((ob >> 9) & 1) << 5)); }
__host__ __device__ __forceinline__ void stage_rc(int b, int& R, int& C) { const int st = b / 1024, sb = b % 1024, swz = sb ^ (((sb >> 9) & 1) << 5); R = (st >> 1) * 16 + swz / 64; C = (st & 1) * 32 + (swz % 64) / 2; }
__host__ __device__ __forceinline__ int perm32(int rho) { const int n = rho >> 4, i = rho & 15; return 8 * (i >> 2) + 4 * n + (i & 3); }

struct Unit { int pm, pn, e; };
struct Gemm { const bf16_t* A; const bf16_t* Bt; int M, N, K; size_t estride; };

struct StaticOrder {
    int nM, nN, nwg, G, c;
    __host__ __device__ void init(int M, int N, int G_, int c_) { nM = M / BM; nN = N / BM; nwg = nM * nN; G = G_; c = c_; }
    __host__ __device__ bool next(int i, Unit& u) const {
        const long L = (long)i * G + c; if (L >= nwg) return false;
        int wgid = (int)L; { const int q = nwg / NXCD, r = nwg % NXCD, xcd = wgid % NXCD, off = wgid / NXCD; wgid = (xcd < r ? xcd * (q + 1) : r * (q + 1) + (xcd - r) * q) + off; }
        const int nig = WGM * nN, gid = wgid / nig, fm = gid * WGM, gsz = (nM - fm) < WGM ? (nM - fm) : WGM;
        u.pm = fm + ((wgid % nig) % gsz); u.pn = (wgid % nig) / gsz; u.e = 0; return true;
    }
    __device__ __forceinline__ void a_ready(const Unit&) const {}
    __device__ __forceinline__ void done(const Unit&) const {}
};
__device__ __forceinline__ unsigned cvt_pk_bf16(float lo, float hi) { unsigned r; asm volatile("v_cvt_pk_bf16_f32 %0, %1, %2" : "=v"(r) : "v"(lo), "v"(hi)); return r; }
typedef float f32x2 __attribute__((ext_vector_type(2)));
__device__ __forceinline__ f32x2 gelu_pk(f32x2 v) {
    const f32x2 av = __builtin_elementwise_abs(v), d = av * 0.2316418882f + 1.0f;
    f32x2 t; t.x = __builtin_amdgcn_rcpf(d.x); t.y = __builtin_amdgcn_rcpf(d.y);
    f32x2 q = t * 0.5307027145f + (-0.7265760135f); q = q * t + 0.7107068705f; q = q * t + (-0.142248368f); q = q * t + 0.127414796f; q = q * t;
    const f32x2 s = (v * v) * (-0.72134752044f);
    f32x2 e; e.x = __builtin_amdgcn_exp2f(s.x); e.y = __builtin_amdgcn_exp2f(s.y);
    const f32x2 m = v * (q * e), r = v - m;
    f32x2 o; o.x = v.x < 0.f ? m.x : r.x; o.y = v.y < 0.f ? m.y : r.y; return o;
}

struct EpiF32 {
    static constexpr bool PERM = false, AFTER_DRAIN = false;
    float* C; int ldc; const float* bias;
    __device__ __forceinline__ void operator()(const f32x4 (&acc)[2][2][4][2], const Unit& u, int wr, int wc, int fr, int fq) const {
        const int row0 = u.pm * BM + wr * 64 + fr, col0 = u.pn * BM + wc * 32 + 4 * fq;
        f32x4 bv[2][2];
#pragma unroll
        for (int bj = 0; bj < 2; ++bj)
#pragma unroll
            for (int n = 0; n < 2; ++n) bv[bj][n] = bias ? *(const f32x4*)(bias + col0 + bj * HALF + n * 16) : (f32x4){0.f, 0.f, 0.f, 0.f};
#pragma unroll
        for (int ai = 0; ai < 2; ++ai)
#pragma unroll
            for (int m = 0; m < 4; ++m) { float* rowp = C + (size_t)(row0 + ai * HALF + m * 16) * ldc + col0;
#pragma unroll
                for (int bj = 0; bj < 2; ++bj)
#pragma unroll
                    for (int n = 0; n < 2; ++n) *(f32x4*)(rowp + bj * HALF + n * 16) = acc[ai][bj][m][n] + bv[bj][n]; }
    }
};
template <int ACT  > struct EpiBf16 {
    static constexpr bool PERM = true, AFTER_DRAIN = false;
    bf16_t* O; int ldc; const float* bias; int split_cols; size_t split_stride;
    __device__ __forceinline__ void operator()(const f32x4 (&acc)[2][2][4][2], const Unit& u, int wr, int wc, int fr, int fq) const {
        const int row0 = u.pm * BM + wr * 64 + fr; int colt = u.pn * BM; bf16_t* base = O;
        if (split_cols) { const int t = colt / split_cols; base += (size_t)t * split_stride; colt -= t * split_cols; }
        const int col0 = colt + wc * 32 + 8 * fq, bcol0 = u.pn * BM + wc * 32 + 8 * fq;
        f32x4 bv[2][2];
#pragma unroll
        for (int bj = 0; bj < 2; ++bj)
#pragma unroll
            for (int n = 0; n < 2; ++n) bv[bj][n] = bias ? *(const f32x4*)(bias + bcol0 + bj * HALF + 4 * n) : (f32x4){0.f, 0.f, 0.f, 0.f};
#pragma unroll
        for (int ai = 0; ai < 2; ++ai)
#pragma unroll
            for (int m = 0; m < 4; ++m) { bf16_t* rowp = base + (size_t)(row0 + ai * HALF + m * 16) * ldc + col0;
#pragma unroll
                for (int bj = 0; bj < 2; ++bj) { f32x4 v0 = acc[ai][bj][m][0] + bv[bj][0], v1 = acc[ai][bj][m][1] + bv[bj][1];
                    if (ACT == 1) { f32x2 a = gelu_pk((f32x2){v0[0], v0[1]}), b = gelu_pk((f32x2){v0[2], v0[3]}), c = gelu_pk((f32x2){v1[0], v1[1]}), d = gelu_pk((f32x2){v1[2], v1[3]});
                        v0 = (f32x4){a.x, a.y, b.x, b.y}; v1 = (f32x4){c.x, c.y, d.x, d.y}; }
                    if (ACT == 2) {
#pragma unroll
                        for (int j = 0; j < 4; ++j) { v0[j] = 0.5f * v0[j] * (1.0f + erff(v0[j] * 0.70710678f)); v1[j] = 0.5f * v1[j] * (1.0f + erff(v1[j] * 0.70710678f)); } }
                    u32x4 w; w.x = cvt_pk_bf16(v0[0], v0[1]); w.y = cvt_pk_bf16(v0[2], v0[3]); w.z = cvt_pk_bf16(v1[0], v1[1]); w.w = cvt_pk_bf16(v1[2], v1[3]);
                    *(u32x4*)(rowp + bj * HALF) = w; } }
    }
};

template <class Epi, class Sched, bool STAMP = false>
__device__ __forceinline__ void gemm_phase(PG8_LAS unsigned char* lds, const Gemm g, const Sched& S, const Epi& E, unsigned long long* stamps) {
    int tid_ = threadIdx.x; asm volatile("" : "+v"(tid_));
    const int tid = tid_, wid = __builtin_amdgcn_readfirstlane(tid >> 6), lane = tid & 63, wr = wid >> 2, wc = wid & 3, fr = lane & 15, fq = lane >> 4;
    const int K = g.K, nt = K / BK;
    int ts_lo = 0, ts_hi = 0, nts = 0; const unsigned long long rt_entry = STAMP ? (unsigned long long)wall_clock64() : 0ull;
#define PG8_STAMP() do { if (STAMP && wid == 0 && nts < 64) { const unsigned long long _c = (unsigned long long)clock64(); \
        ts_lo = (lane == nts) ? (int)(unsigned)_c : ts_lo; ts_hi = (lane == nts) ? (int)(unsigned)(_c >> 32) : ts_hi; ++nts; } } while (0)
    PG8_STAMP();
    unsigned voffA[2], voffB[2];
#pragma unroll
    for (int i = 0; i < 2; ++i) { int R, C; stage_rc(tid * 16 + i * 8192, R, C); const int Rb = Epi::PERM ? ((R & ~31) + perm32(R & 31)) : R;
        voffA[i] = (unsigned)(R * K + C) * 2u; voffB[i] = (unsigned)(Rb * K + C) * 2u; }
    const size_t kstep = (size_t)(BK * 2);
    const size_t hstep = (size_t)HALF * K * 2;
    const size_t tstep = 2 * hstep;
    const unsigned ldsw = (unsigned)wid * 1024u;
    const int aoff = lds_byte(wr * 64 + fr, fq * 8), boff = lds_byte(wc * 32 + fr, fq * 8);
#define PG8_SA(b, h) (((b) * 2 + (h)) * HTB)
#define PG8_SB(b, h) ((4 + (b) * 2 + (h)) * HTB)
#define PG8_STAGE(bufoff, gbase, voff) do { _Pragma("unroll") for (int _i = 0; _i < 2; ++_i) \
        __builtin_amdgcn_global_load_lds((const unsigned*)((const char*)(gbase) + (voff)[_i]), (PG8_LAS unsigned*)(lds + (bufoff) + ldsw + _i * 8192), 16, 0, 0); } while (0)
#define PG8_LDA(dst, b, h) do { _Pragma("unroll") for (int m = 0; m < 4; ++m) _Pragma("unroll") for (int k = 0; k < 2; ++k) dst[m][k] = *(const PG8_LAS bf16x8*)(lds + PG8_SA(b, h) + aoff + m * 2048 + k * 1024); } while (0)
#define PG8_LDB(dst, b, h) do { _Pragma("unroll") for (int n = 0; n < 2; ++n) _Pragma("unroll") for (int k = 0; k < 2; ++k) dst[n][k] = *(const PG8_LAS bf16x8*)(lds + PG8_SB(b, h) + boff + n * 2048 + k * 1024); } while (0)
#define PG8_MMA(ai, bj, At, Bt) do { __builtin_amdgcn_s_setprio(1); _Pragma("unroll") for (int m = 0; m < 4; ++m) _Pragma("unroll") for (int n = 0; n < 2; ++n) _Pragma("unroll") for (int k = 0; k < 2; ++k) \
        acc[ai][bj][m][n] = __builtin_amdgcn_mfma_f32_16x16x32_bf16(Bt[n][k], At[m][k], acc[ai][bj][m][n], 0, 0, 0); __builtin_amdgcn_s_setprio(0); } while (0)
#define PG8_WAIT_V(n) asm volatile("s_waitcnt vmcnt(" #n ")" ::: "memory")
#define PG8_WAIT_L(n) asm volatile("s_waitcnt lgkmcnt(" #n ")" ::: "memory")
#define PG8_BAR __builtin_amdgcn_s_barrier()
#define PG8_SCHED __builtin_amdgcn_sched_barrier(0)
    Unit cur, nxt; int ui = 0;
    if (!S.next(0, cur)) return;
    f32x4 acc[2][2][4][2];
#pragma unroll
    for (int a = 0; a < 2; ++a)
#pragma unroll
        for (int b = 0; b < 2; ++b)
#pragma unroll
            for (int m = 0; m < 4; ++m)
#pragma unroll
                for (int n = 0; n < 2; ++n) acc[a][b][m][n] = (f32x4){0.f, 0.f, 0.f, 0.f};
    bf16x8 At[4][2], B0[2][2], B1[2][2];
    const char* cA = (const char*)g.A + (size_t)cur.pm * tstep; const char* cB = (const char*)g.Bt + (size_t)cur.pn * tstep + (size_t)cur.e * g.estride * 2;
    S.a_ready(cur);
    PG8_STAGE(PG8_SB(0, 0), cB, voffB); PG8_STAGE(PG8_SA(0, 0), cA, voffA); PG8_STAGE(PG8_SB(0, 1), cB + hstep, voffB); PG8_STAGE(PG8_SA(0, 1), cA + hstep, voffA);
    if (wr == 1) PG8_BAR;
    PG8_WAIT_V(4); PG8_BAR;
    PG8_STAGE(PG8_SB(1, 0), cB + kstep, voffB); PG8_STAGE(PG8_SA(1, 0), cA + kstep, voffA); PG8_STAGE(PG8_SB(1, 1), cB + hstep + kstep, voffB);
    PG8_WAIT_V(6); PG8_BAR;
    PG8_STAMP();
    for (;;) {
        const bool has_next = S.next(ui + 1, nxt);
        const char* nA = has_next ? (const char*)g.A + (size_t)nxt.pm * tstep : cA; const char* nB = has_next ? (const char*)g.Bt + (size_t)nxt.pn * tstep + (size_t)nxt.e * g.estride * 2 : cB;
        for (int t = 0; t < nt; t += 2) {
            const bool last = (t == nt - 2);
            const char* a1 = cA + (size_t)(t + 1) * kstep;
            const char* a2 = last ? nA : cA + (size_t)(t + 2) * kstep; const char* b2 = last ? nB : cB + (size_t)(t + 2) * kstep;
            const char* a3 = a2 + kstep; const char* b3 = b2 + kstep;
            if (last && has_next) S.a_ready(nxt);
            PG8_LDB(B0, 0, 0); PG8_SCHED; PG8_LDA(At, 0, 0); PG8_STAGE(PG8_SA(1, 1), a1 + hstep, voffA);
            PG8_WAIT_L(8); PG8_BAR; PG8_WAIT_L(0); PG8_MMA(0, 0, At, B0); PG8_BAR; PG8_SCHED;
            PG8_LDB(B1, 0, 1); PG8_STAGE(PG8_SB(0, 0), b2, voffB);
            PG8_BAR; PG8_WAIT_L(0); PG8_MMA(0, 1, At, B1); PG8_BAR;
            PG8_LDA(At, 0, 1); PG8_STAGE(PG8_SA(0, 0), a2, voffA);
            PG8_BAR; PG8_WAIT_L(0); PG8_MMA(1, 0, At, B0); PG8_BAR; PG8_SCHED;
            PG8_STAGE(PG8_SB(0, 1), b2 + hstep, voffB);
            PG8_WAIT_V(6); PG8_BAR; PG8_MMA(1, 1, At, B1); PG8_BAR;
            PG8_LDB(B0, 1, 0); PG8_SCHED; PG8_LDA(At, 1, 0); PG8_STAGE(PG8_SA(0, 1), a2 + hstep, voffA);
            PG8_WAIT_L(8); PG8_BAR; PG8_WAIT_L(0); PG8_MMA(0, 0, At, B0); PG8_BAR; PG8_SCHED;
            PG8_LDB(B1, 1, 1); PG8_STAGE(PG8_SB(1, 0), b3, voffB);
            PG8_BAR; PG8_WAIT_L(0); PG8_MMA(0, 1, At, B1); PG8_BAR;
            PG8_LDA(At, 1, 1); PG8_STAGE(PG8_SA(1, 0), a3, voffA);
            PG8_BAR; PG8_WAIT_L(0); PG8_MMA(1, 0, At, B0); PG8_BAR; PG8_SCHED;
            PG8_STAGE(PG8_SB(1, 1), b3 + hstep, voffB);
            PG8_WAIT_V(6); PG8_BAR; PG8_MMA(1, 1, At, B1); PG8_BAR;
        }
        PG8_STAMP();
        if constexpr (!Epi::AFTER_DRAIN) { E(acc, cur, wr, wc, fr, fq); S.done(cur); }
        PG8_STAMP();
        if (!has_next) break;
#pragma unroll
        for (int a = 0; a < 2; ++a)
#pragma unroll
            for (int b = 0; b < 2; ++b)
#pragma unroll
                for (int m = 0; m < 4; ++m)
#pragma unroll
                    for (int n = 0; n < 2; ++n) acc[a][b][m][n] = (f32x4){0.f, 0.f, 0.f, 0.f};
        cur = nxt; cA = nA; cB = nB; ++ui;
    }
    PG8_WAIT_V(0);
    if (wr == 0) PG8_BAR;
    PG8_BAR;
    if constexpr (Epi::AFTER_DRAIN) { E.fused(acc, cur, wr, wc, fr, fq, lds, wid, lane); S.done(cur); }
    PG8_STAMP();
    if (STAMP && wid == 0) { stamps[lane] = lane < nts ? (((unsigned long long)(unsigned)ts_hi << 32) | (unsigned)ts_lo) : 0ull;
        if (lane == 62) stamps[62] = rt_entry; if (lane == 63) stamps[63] = (unsigned long long)wall_clock64(); }
#undef PG8_STAMP
#undef PG8_SA
#undef PG8_SB
#undef PG8_STAGE
#undef PG8_LDA
#undef PG8_LDB
#undef PG8_MMA
#undef PG8_WAIT_V
#undef PG8_WAIT_L
#undef PG8_BAR
#undef PG8_SCHED
}
}
namespace pg8 {
struct EpiRes {
    static constexpr bool PERM = false, AFTER_DRAIN = false;
    const float* base_lat; const float* base_ctx; float* out_lat; float* out_ctx; const float* gvec;
    __device__ __forceinline__ void operator()(const f32x4 (&acc)[2][2][4][2], const Unit& u, int wr, int wc, int fr, int fq) const {
        const bool isctx = u.pm >= 128;
        const int prow = (isctx ? (u.pm - 128) : u.pm) * BM;
        const float* base = isctx ? base_ctx : base_lat; float* out = isctx ? out_ctx : out_lat;
        const float* gv = gvec + (size_t)(isctx ? 8 : (u.pm >> 4)) * 6144;
        const int row0 = prow + wr * 64 + fr, col0 = u.pn * BM + wc * 32 + 4 * fq;
        f32x4 gvv[2][2];
#pragma unroll
        for (int bj = 0; bj < 2; ++bj)
#pragma unroll
            for (int n = 0; n < 2; ++n) gvv[bj][n] = *(const f32x4*)(gv + col0 + bj * HALF + n * 16);
#pragma unroll
        for (int ai = 0; ai < 2; ++ai)
#pragma unroll
            for (int m = 0; m < 4; ++m) { const size_t off = (size_t)(row0 + ai * HALF + m * 16) * 1024 + col0;
#pragma unroll
                for (int bj = 0; bj < 2; ++bj)
#pragma unroll
                    for (int n = 0; n < 2; ++n) { const f32x4 b = *(const f32x4*)(base + off + bj * HALF + n * 16);
                        *(f32x4*)(out + off + bj * HALF + n * 16) = b + gvv[bj][n] * acc[ai][bj][m][n]; } }
    }
};
struct EpiSwiglu {
    static constexpr bool PERM = true, AFTER_DRAIN = false;
    bf16_t* O; int ldc;
    __device__ __forceinline__ void operator()(const f32x4 (&acc)[2][2][4][2], const Unit& u, int wr, int wc, int fr, int fq) const {
        const int row0 = u.pm * BM + wr * 64 + fr, col0 = u.pn * HALF + wc * 32 + 8 * fq;
#pragma unroll
        for (int ai = 0; ai < 2; ++ai)
#pragma unroll
            for (int m = 0; m < 4; ++m) { bf16_t* rowp = O + (size_t)(row0 + ai * HALF + m * 16) * ldc + col0;
                float h[8];
#pragma unroll
                for (int n = 0; n < 2; ++n)
#pragma unroll
                    for (int j = 0; j < 4; ++j) { const float g = acc[ai][0][m][n][j], up = acc[ai][1][m][n][j]; h[n * 4 + j] = g * __builtin_amdgcn_rcpf(1.0f + __expf(-g)) * up; }
                u32x4 w; w.x = cvt_pk_bf16(h[0], h[1]); w.y = cvt_pk_bf16(h[2], h[3]); w.z = cvt_pk_bf16(h[4], h[5]); w.w = cvt_pk_bf16(h[6], h[7]);
                *(u32x4*)rowp = w; }
    }
};
struct MoeOrder {
    int nN, G, c, nunits; const int* tab;
    __device__ void init(const int* tab_, int nN_, int G_, int c_) { tab = tab_; nN = nN_; G = G_; c = c_; nunits = tab_[0] * nN_; }
    __device__ bool next(int i, Unit& u) const {
        const int L = i * G + c; if (L >= nunits) return false;
        u.pm = L / nN; u.pn = L - u.pm * nN; u.e = tab[1 + u.pm]; return true;
    }
    __device__ __forceinline__ void a_ready(const Unit&) const {}
    __device__ __forceinline__ void done(const Unit&) const {}
};
}
enum { I_X = 0, I_C, I_CTX, I_CCTX, I_MODW, I_MODB, I_NMIXG, I_NFFNG, I_WIN, I_WOUT, I_LCW, I_LCB, I_LWA, I_LBA, I_LWX, I_LBX, I_LLAM,
       I_RMU, I_RWUP, I_RW0, I_RAUP, I_RA0, I_RGUP, I_RKK, I_RKA, I_RRK, I_RLNG, I_RLNB, I_MIB, I_MFB, I_MNG, I_GCW, I_GALOG, I_GDTB, I_GNG,
       I_FWG, I_FWU, I_FWD, I_MROUTER, I_MWG, I_MWU, I_MWD, I_FNG, N_IN };
struct Args { const float* in[N_IN]; float* out; unsigned char* ws; int ph_lo, ph_hi; };
struct Ctx {
    const float* const* in; float* out; unsigned char* ws; LAS unsigned char* lds;
    int tid, lane, wave, G, wg;
};
#define WSP(T, off) ((T*)(C.ws + (off)))

__device__ __forceinline__ int seqrow_raster(int i, int d, int b) {
    if (i < CTXL) { const int p = d ? (CTXL - 1 - i) : i; return T_LAT + b * CTXL + p; }
    const int j = i - CTXL; const int p = d ? (SEQ - 1 - j) : j; return b * SEQ + p;
}
__device__ __forceinline__ int seqrow_cm(int i, int d, int b) {
    if (i < CTXL) { const int p = d ? (CTXL - 1 - i) : i; return T_LAT + b * CTXL + p; }
    const int j = i - CTXL; const int p = d ? (SEQ - 1 - j) : j; return b * SEQ + (p & 63) * 64 + (p >> 6);
}

__device__ __forceinline__ void phase_pre(const Ctx& C) {
    LAS float* sc = (LAS float*)C.lds;
    LAS float* red = sc + 9 * 1024;
    float* modv = WSP(float, WS_MODV);
    bool filled = false;
    for (int it = C.wg; it < DEPTH * 48; it += C.G) {
        if (!filled) {
            for (int i = C.tid; i < 9 * 1024; i += NTHR) { const float v = i < 8192 ? C.in[I_C][i] : C.in[I_CCTX][i - 8192]; sc[i] = siluf_(v); }
            filled = true; __syncthreads();
        }
        const int l = it / 48, jb = it % 48, col = C.tid & 127, kg = C.tid >> 7;
        const float* W = C.in[I_MODW] + (size_t)l * 1024 * 6144 + jb * 128 + col;
        float acc[9];
#pragma unroll
        for (int r = 0; r < 9; ++r) acc[r] = 0.f;
        for (int k = kg * 256; k < kg * 256 + 256; ++k) { const float w = W[(size_t)k * 6144];
#pragma unroll
            for (int r = 0; r < 9; ++r) acc[r] += sc[r * 1024 + k] * w; }
#pragma unroll
        for (int r = 0; r < 9; ++r) red[(kg * 9 + r) * 128 + col] = acc[r];
        __syncthreads();
        for (int i = C.tid; i < 9 * 128; i += NTHR) { const int r = i >> 7, cc = i & 127;
            const float s = red[(0 * 9 + r) * 128 + cc] + red[(1 * 9 + r) * 128 + cc] + red[(2 * 9 + r) * 128 + cc] + red[(3 * 9 + r) * 128 + cc];
            modv[((size_t)l * 9 + r) * 6144 + jb * 128 + cc] = s + C.in[I_MODB][l * 6144 + jb * 128 + cc]; }
        __syncthreads();
    }
}

__device__ __forceinline__ void tr_item(const float* src, size_t ld, int k0, int ns0, bf16* dst, int drow0, int Kd, LAS float* scr, int lane, bool zero) {
    if (!zero) {
#pragma unroll 8
        for (int i = 0; i < 32; ++i) { const int kk = 2 * i + (lane >> 5); scr[kk * 33 + (lane & 31)] = src[(size_t)(k0 + kk) * ld + ns0 + (lane & 31)]; }
    }
    LDS_WAIT(); asm volatile("" ::: "memory");
    const int c = lane & 7;
#pragma unroll
    for (int j = 0; j < 4; ++j) { const int n = (lane >> 3) + 8 * j; const LAS float* s = scr + (8 * c) * 33 + n;
        v4u o; o.x = pk2(s[0 * 33], s[1 * 33]); o.y = pk2(s[2 * 33], s[3 * 33]); o.z = pk2(s[4 * 33], s[5 * 33]); o.w = pk2(s[6 * 33], s[7 * 33]);
        if (zero) o = (v4u){0u, 0u, 0u, 0u};
        *(v4u*)(dst + (size_t)(drow0 + n) * Kd + k0 + 8 * c) = o; }
    LDS_WAIT(); asm volatile("" ::: "memory");
}
__device__ __forceinline__ void convert_small(const Ctx& C, int l) {
    {
        bf16* lw = WSP(bf16, WS_LRUWT);
        for (int k = 0; k < 2 * 2 * 4 * 4096 / (128 * NTHR); ++k) {
            const int e = k * 128 * NTHR + C.wg * NTHR + C.tid;
            if (C.wg < 128) {
            const int i = e & 63, j = (e >> 6) & 63, hd = (e >> 12) & 3, g = (e >> 14) & 1, d = e >> 15;
            const float* src = (g ? C.in[I_LWX] : C.in[I_LWA]) + ((size_t)((l * 2 + d) * 4 + hd) * 64 + i) * 64 + j;
            lw[e] = (bf16)f2bf(*src);
            }
        }
    }
    if (C.wg >= 128 && C.wg < 224) {
        bf16* rw = WSP(bf16, WS_RWT);
        const int e = (C.wg - 128) * NTHR + C.tid;
        if (e < 32768) { const int r = e & 31, ch = (e >> 5) & 255, d = (e >> 13) & 1, isa = e >> 14;
            rw[e] = (bf16)f2bf((isa ? C.in[I_RAUP] : C.in[I_RWUP])[((size_t)(l * 2 + d) * 32 + r) * GW + ch]); }
        else { const int e2 = e - 32768, j = e2 & 63, ch = e2 >> 6; rw[e] = (bf16)f2bf(C.in[I_RGUP][((size_t)l * 64 + j) * GW + ch]); }
    }
}
__device__ __forceinline__ void convert_items(const Ctx& C, int l, int what, int gw, int NGW) {
    LAS float* scr = (LAS float*)(C.lds + C.wave * 8704);
    constexpr int I_IN = 16 * 112, I_OUT = 16 * 32, I_GU = 16 * 176, I_DN = 44 * 32, I_E = 16 * 88 + 22 * 32;
    const bool moe = l & 1; const int li = l >> 1;
    const int lo_it = (what & 1) ? 0 : I_IN, hi_it = (what & 2) ? I_IN + I_OUT + (moe ? NE * I_E : (I_GU + I_DN)) : I_IN;
    bf16* win = WSP(bf16, WS_WIN); bf16* wout = WSP(bf16, WS_WOUT); bf16* wgu = WSP(bf16, WS_WGU); bf16* wdn = WSP(bf16, WS_WDN);
    for (int it = lo_it + gw; it < hi_it; it += NGW) {
        int r = it;
        if (r < I_IN) { const int kb = r / 112, nb = r % 112; tr_item(C.in[I_WIN] + (size_t)l * 1024 * IN_COLS, IN_COLS, 64 * kb, 32 * nb, win, 32 * nb, 1024, scr, C.lane, nb == 111); continue; }
        r -= I_IN;
        if (r < I_OUT) { const int kb = r / 32, nb = r % 32; tr_item(C.in[I_WOUT] + (size_t)l * 1024 * 1024, 1024, 64 * kb, 32 * nb, wout, 32 * nb, 1024, scr, C.lane, false); continue; }
        r -= I_OUT;
        if (!moe) {
            if (r < I_GU) { const int kb = r / 176, nb = r % 176, tile = nb >> 3, q = nb & 7;
                const float* src = (q < 4 ? C.in[I_FWG] : C.in[I_FWU]) + (size_t)li * 1024 * DFF;
                tr_item(src, DFF, 64 * kb, tile * 128 + (q & 3) * 32, wgu, 32 * nb, 1024, scr, C.lane, false); continue; }
            r -= I_GU;
            { const int kb = r / 32, nb = r % 32; tr_item(C.in[I_FWD] + (size_t)li * DFF * 1024, 1024, 64 * kb, 32 * nb, wdn, 32 * nb, DFF, scr, C.lane, false); }
        } else {
            const int e = r / I_E; int rr = r % I_E;
            if (rr < 16 * 88) { const int kb = rr / 88, nb = rr % 88, tile = nb >> 3, q = nb & 7;
                const float* src = (q < 4 ? C.in[I_MWG] : C.in[I_MWU]) + ((size_t)li * NE + e) * 1024 * DFE;
                tr_item(src, DFE, 64 * kb, tile * 128 + (q & 3) * 32, wgu + (size_t)e * 2 * DFE * 1024, 32 * nb, 1024, scr, C.lane, false); continue; }
            rr -= 16 * 88;
            { const int kb = rr / 32, nb = rr % 32; tr_item(C.in[I_MWD] + ((size_t)li * NE + e) * DFE * 1024, 1024, 64 * kb, 32 * nb, wdn + (size_t)e * 1024 * DFE, 32 * nb, DFE, scr, C.lane, false); }
        }
    }
}

template <bool ROUTE>
__device__ __forceinline__ void norm_rows(const Ctx& C, int l, const float* xlat, const float* xctx, const float* gain, int shoff, int scoff, int nrows, int moe_li) {
    const float* modv = WSP(float, WS_MODV) + (size_t)l * 9 * 6144;
    bf16* hb = WSP(bf16, WS_HB);
    const int gw = C.wg * NWAVES + C.wave, NGW = C.G * NWAVES;
    LAS unsigned* lcnt = (LAS unsigned*)(C.lds + 65536);
    unsigned* route = WSP(unsigned, WS_ROUTE);
    if (ROUTE) { if (C.tid < 8) lcnt[C.tid] = 0u; __syncthreads(); }
    f32x4 gv[4];
#pragma unroll
    for (int j = 0; j < 4; ++j) gv[j] = *(const f32x4*)(gain + 4 * C.lane + 256 * j);
    for (int m = gw; m < nrows; m += NGW) {
        const bool isctx = m >= T_LAT;
        const float* xr = isctx ? xctx + (size_t)(m - T_LAT) * 1024 : xlat + (size_t)m * 1024;
        const float* mv = modv + (size_t)(isctx ? 8 : (m >> 12)) * 6144;
        f32x4 v[4]; float s = 0.f;
#pragma unroll
        for (int j = 0; j < 4; ++j) { v[j] = *(const f32x4*)(xr + 4 * C.lane + 256 * j); s += (v[j].x * v[j].x + v[j].y * v[j].y) + (v[j].z * v[j].z + v[j].w * v[j].w); }
        const float rs = 1.0f / sqrtf(wave_sum(s) * (1.0f / 1024.0f) + 1e-6f);
#pragma unroll
        for (int j = 0; j < 4; ++j) { const f32x4 sh = *(const f32x4*)(mv + shoff + 4 * C.lane + 256 * j), scl = *(const f32x4*)(mv + scoff + 4 * C.lane + 256 * j);
            v[j] = (v[j] * rs * gv[j]) * (scl + 1.0f) + sh;
            v2u o; o.x = pk2(v[j].x, v[j].y); o.y = pk2(v[j].z, v[j].w);
            *(v2u*)(hb + (size_t)m * 1024 + 4 * C.lane + 256 * j) = o; }
        if (ROUTE) {
            const float* rt = C.in[I_MROUTER] + (size_t)moe_li * 1024 * NE;
            float lg[8];
#pragma unroll
            for (int e = 0; e < 8; ++e) lg[e] = 0.f;
#pragma unroll
            for (int j = 0; j < 4; ++j)
#pragma unroll
                for (int q = 0; q < 4; ++q) { const int k = 4 * C.lane + 256 * j + q; const f32x4 r0 = *(const f32x4*)(rt + (size_t)k * 8), r1 = *(const f32x4*)(rt + (size_t)k * 8 + 4); const float hv = v[j][q];
                    lg[0] += hv * r0.x; lg[1] += hv * r0.y; lg[2] += hv * r0.z; lg[3] += hv * r0.w; lg[4] += hv * r1.x; lg[5] += hv * r1.y; lg[6] += hv * r1.z; lg[7] += hv * r1.w; }
#pragma unroll
            for (int e = 0; e < 8; ++e) lg[e] = wave_sum(lg[e]);
            int e0 = 0; float l0 = lg[0];
#pragma unroll
            for (int e = 1; e < 8; ++e) if (lg[e] > l0) { l0 = lg[e]; e0 = e; }
            int e1 = -1; float l1 = -3.0e38f;
#pragma unroll
            for (int e = 0; e < 8; ++e) if (e != e0 && lg[e] > l1) { l1 = lg[e]; e1 = e; }
            const float w0 = 1.0f / (1.0f + __expf(l1 - l0)), w1 = 1.0f - w0;
            if (C.lane == 0) {
                const unsigned r0 = atomicAdd((unsigned*)&lcnt[e0], 1u), r1 = atomicAdd((unsigned*)&lcnt[e1], 1u);
                v4u a; a.x = (unsigned)e0; a.y = (unsigned)e1; a.z = r0; a.w = r1;
                *(v4u*)(route + (size_t)m * 8) = a;
                v2u b; b.x = __builtin_bit_cast(unsigned, w0); b.y = __builtin_bit_cast(unsigned, w1);
                *(v2u*)(route + (size_t)m * 8 + 4) = b;
            }
        }
    }
    if (ROUTE) {
        __syncthreads();
        if (C.tid < 8) { unsigned* gc = WSP(unsigned, WS_CTL) + CW_MOECNT + 64 * moe_li; const unsigned base = atomicAdd(gc + C.tid, lcnt[C.tid]); WSP(unsigned, WS_WGBASE)[C.wg * 8 + C.tid] = base; }
    }
}
template <bool FIN>
__device__ __forceinline__ void lru_chunk(const Ctx& C, int l, int b, int c) {
    LAS float* U = (LAS float*)C.lds;
    const bf16* P = WSP(const bf16, WS_P);
    const bool isctx = c < 4; const int p0 = isctx ? c * 64 : (c - 4) * 64; const int Lp = isctx ? CTXL : SEQ; const int row0 = isctx ? T_LAT + b * CTXL : b * SEQ;
    const int ch = C.tid & 255, half = C.tid >> 8;
    {
        const float* cw = C.in[I_LCW] + (size_t)l * 4 * GW + ch; const float w0 = cw[0], w1 = cw[GW], w2 = cw[2 * GW], w3 = cw[3 * GW], cb = C.in[I_LCB][l * GW + ch];
        const int t0 = half * 32;
        auto ld = [&](int p) -> float { return (p >= 0 && p < Lp) ? bf2f(P[(size_t)(row0 + p) * PLD + ch]) : 0.f; };
        float xm2 = ld(p0 + t0 - 2), xm1 = ld(p0 + t0 - 1), x0 = ld(p0 + t0);
        for (int t = 0; t < 32; ++t) { const float xp1 = ld(p0 + t0 + t + 1); U[(t0 + t) * 256 + ch] = w0 * xm2 + w1 * xm1 + w2 * x0 + w3 * xp1 + cb; xm2 = xm1; xm1 = x0; x0 = xp1; }
    }
    __syncthreads();
    const int d = half, hd = ch >> 6, jj = ch & 63;
    const float* wa = C.in[I_LWA] + ((size_t)((l * 2 + d) * 4 + hd) * 64) * 64 + jj;
    const float* wx = C.in[I_LWX] + ((size_t)((l * 2 + d) * 4 + hd) * 64) * 64 + jj;
    const float ba = C.in[I_LBA][(l * 2 + d) * GW + ch], bx = C.in[I_LBX][(l * 2 + d) * GW + ch];
    const float sp8 = 8.0f * softplusf_(-C.in[I_LLAM][(l * 2 + d) * GW + ch]);
    const size_t sidx = ((size_t)(b * NCH + c) * 2 + d) * 256 + ch;
    float h = FIN ? WSP(const float, WS_HIN)[sidx] : 0.f, sla = 0.f;
    LAS bf16* H16 = (LAS bf16*)(U + 64 * 256) + d * 64 * 256;
    const int sgn = d ? -1 : 1;
#pragma unroll 1
    for (int g = 0; g < 4; ++g) {
        const int tstart = d ? (63 - g * 16) : g * 16;
        float ar[16], ai[16];
#pragma unroll
        for (int tt = 0; tt < 16; ++tt) { ar[tt] = 0.f; ai[tt] = 0.f; }
        const LAS float* ub = U + tstart * 256 + hd * 64;
#pragma unroll 1
        for (int i = 0; i < 64; i += 4) {
            float a4[4], x4[4];
#pragma unroll
            for (int q = 0; q < 4; ++q) { a4[q] = wa[(i + q) * 64]; x4[q] = wx[(i + q) * 64]; }
#pragma unroll
            for (int tt = 0; tt < 16; ++tt) { const f32x4 uu = *(const LAS f32x4*)(ub + sgn * tt * 256 + i);
                ar[tt] += uu.x * a4[0] + uu.y * a4[1] + uu.z * a4[2] + uu.w * a4[3];
                ai[tt] += uu.x * x4[0] + uu.y * x4[1] + uu.z * x4[2] + uu.w * x4[3]; }
        }
#pragma unroll
        for (int tt = 0; tt < 16; ++tt) {
            const int tok = tstart + sgn * tt;
            const float r = sigmoidf_(ar[tt] + ba), ig = sigmoidf_(ai[tt] + bx);
            const float la = -sp8 * r; const float a = __expf(la);
            const float bb = sqrtf(-expm1f_(2.0f * la)) * (ig * U[tok * 256 + ch]);
            h = a * h + bb; sla += la;
            if (FIN) H16[tok * 256 + ch] = (bf16)f2bf1(h);
        }
    }
    if (!FIN) { float* ls = WSP(float, WS_LSUM) + sidx * 2; ls[0] = sla; ls[1] = h; __syncthreads(); return; }
    __syncthreads();
    bf16* yc = WSP(bf16, WS_HB);
    const LAS bf16* H0 = (const LAS bf16*)(U + 64 * 256); const LAS bf16* H1 = H0 + 64 * 256;
    for (int t = half * 32; t < half * 32 + 32; ++t) {
        const size_t row = (size_t)(row0 + p0 + t);
        const float gate = bf2f(P[row * PLD + 256 + ch]);
        yc[row * 1024 + ch] = (bf16)f2bf1((bf2f(H0[t * 256 + ch]) + bf2f(H1[t * 256 + ch])) * gelu_tanh(gate));
    }
    __syncthreads();
}
__device__ __forceinline__ void lru_carry(const Ctx& C, int idx) {
    const int ch = idx & 255, d = (idx >> 8) & 1, b = idx >> 9;
    const float* ls = WSP(const float, WS_LSUM); float* hin = WSP(float, WS_HIN);
    float H = 0.f;
    for (int k = 0; k < NCH; ++k) {
        const int c = d ? (k < 4 ? 3 - k : NCH + 3 - k) : k;
        const size_t sidx = ((size_t)(b * NCH + c) * 2 + d) * 256 + ch;
        hin[sidx] = H;
        H = __expf(ls[sidx * 2]) * H + ls[sidx * 2 + 1];
    }
}

__device__ __forceinline__ float rw_shift(const bf16* P, int row0, int p, int Lp, int colB, float mu0, float mu1) {
    const size_t o = (size_t)(row0 + p) * PLD + OFF_B + colB;
    const float x = bf2f(P[o]);
    const float pv = p > 0 ? bf2f(P[o - PLD]) : 0.f, nx = p < Lp - 1 ? bf2f(P[o + PLD]) : 0.f;
    return x + mu0 * (pv - x) + mu1 * (nx - x);
}
__device__ __forceinline__ void rwkv_prep(const Ctx& C, int l, int b, int c) {
    LAS float* XW = (LAS float*)C.lds;
    LAS float* XA = XW + 64 * 64;
    LAS float* XG = XA + 64 * 64;
    const bf16* P = WSP(const bf16, WS_P);
    const bool isctx = c < 4; const int p0 = isctx ? c * 64 : (c - 4) * 64; const int Lp = isctx ? CTXL : SEQ; const int row0 = isctx ? T_LAT + b * CTXL : b * SEQ;
    const float* mu = C.in[I_RMU] + (size_t)l * 2 * B_COLS;
    for (int it = C.tid; it < 64 * 192; it += NTHR) {
        const int t = it / 192, ci = it % 192, colB = 768 + ci;
        const float v = rw_shift(P, row0, p0 + t, Lp, colB, mu[colB], mu[B_COLS + colB]);
        if (ci < 64) XW[t * 64 + ci] = tanhf_(v); else if (ci < 128) XA[t * 64 + ci - 64] = v; else XG[t * 64 + ci - 128] = sigmoidf_(v);
    }
    __syncthreads();
    const int ch = C.tid & 255, half = C.tid >> 8, head = ch >> 6;
    bf16* wa_out = WSP(bf16, WS_HB); bf16* g_out = WSP(bf16, WS_G); float* bonus = WSP(float, WS_BONUS);
    const float* wup = C.in[I_RWUP] + (size_t)l * 2 * 32 * GW + ch;
    const float* aup = C.in[I_RAUP] + (size_t)l * 2 * 32 * GW + ch;
    const float* gup = C.in[I_RGUP] + (size_t)l * 64 * GW + ch;
    const float w00 = C.in[I_RW0][(l * 2 + 0) * GW + ch], w01 = C.in[I_RW0][(l * 2 + 1) * GW + ch];
    const float a00 = C.in[I_RA0][(l * 2 + 0) * GW + ch], a01 = C.in[I_RA0][(l * 2 + 1) * GW + ch];
    const float k_a = C.in[I_RKA][l * GW + ch], r_k = C.in[I_RRK][l * GW + ch];
    const float mur0 = mu[ch], mur1 = mu[B_COLS + ch], muk0 = mu[256 + ch], muk1 = mu[B_COLS + 256 + ch];
#pragma unroll 1
    for (int sub = 0; sub < 2; ++sub) {
        const int t0 = half * 32 + sub * 16;
        float acc[16], av0[16], av1[16];
#pragma unroll
        for (int kind = 0; kind < 4; ++kind) {
            const int d = kind & 1; const bool isw = kind < 2;
            const float* W = (isw ? wup : aup) + (size_t)d * 32 * GW; const LAS float* X = (isw ? XW : XA) + d * 32;
#pragma unroll
            for (int t = 0; t < 16; ++t) acc[t] = 0.f;
            for (int r = 0; r < 32; r += 4) {
                const float g0 = W[(r + 0) * GW], g1 = W[(r + 1) * GW], g2 = W[(r + 2) * GW], g3 = W[(r + 3) * GW];
#pragma unroll
                for (int t = 0; t < 16; ++t) { const f32x4 x = *(const LAS f32x4*)(X + (t0 + t) * 64 + r); acc[t] += x.x * g0 + x.y * g1 + x.z * g2 + x.w * g3; }
            }
#pragma unroll
            for (int t = 0; t < 16; ++t) {
                const size_t row = (size_t)(row0 + p0 + t0 + t);
                float val;
                if (isw) val = __expf(-0.6065306597126334f * sigmoidf_(acc[t] + (d ? w01 : w00)));
                else { val = sigmoidf_(acc[t] + (d ? a01 : a00)); if (d) av1[t] = val; else av0[t] = val; }
                wa_out[row * 1024 + kind * 256 + ch] = (bf16)f2bf1(val);
            }
        }
#pragma unroll
        for (int t = 0; t < 16; ++t) acc[t] = 0.f;
        for (int j = 0; j < 64; j += 4) {
            const float g0 = gup[(j + 0) * GW], g1 = gup[(j + 1) * GW], g2 = gup[(j + 2) * GW], g3 = gup[(j + 3) * GW];
#pragma unroll
            for (int t = 0; t < 16; ++t) { const f32x4 x = *(const LAS f32x4*)(XG + (t0 + t) * 64 + j); acc[t] += x.x * g0 + x.y * g1 + x.z * g2 + x.w * g3; }
        }
#pragma unroll
        for (int t = 0; t < 16; ++t) {
            const int p = p0 + t0 + t; const size_t row = (size_t)(row0 + p);
            g_out[row * 256 + ch] = (bf16)f2bf1(acc[t]);
            const float rs = rw_shift(P, row0, p, Lp, ch, mur0, mur1), ks = rw_shift(P, row0, p, Lp, 256 + ch, muk0, muk1);
            const float km = ks * (1.0f + (av0[t] - 1.0f) * k_a) + ks * (1.0f + (av1[t] - 1.0f) * k_a);
            const float bs = wave_sum(rs * r_k * km);
            if (C.lane == 0) bonus[row * 4 + head] = bs;
        }
    }
    __syncthreads();
}
__device__ __forceinline__ void rwkv_scan(const Ctx& C, int l, int idx) {
    const int d = idx >> 6, b = (idx >> 3) & 7, h = (idx >> 1) & 3, half = idx & 1;
    LAS float* BUF = (LAS float*)C.lds;
    LAS float* YB = BUF + 2 * 32 * 6 * 64;
    const bf16* P = WSP(const bf16, WS_P); const bf16* WA = WSP(const bf16, WS_HB); bf16* outb = WSP(bf16, WS_OUTB) + (size_t)d * T_ALL * 256;
    const int st = C.tid >> 4, q4 = C.tid & 15, chh = h * 64 + q4 * 4;
    const float* mu = C.in[I_RMU] + (size_t)l * 2 * B_COLS;
    f32x4 mu0[3], mu1[3];
#pragma unroll
    for (int q = 0; q < 3; ++q) { mu0[q] = *(const f32x4*)(mu + q * 256 + chh); mu1[q] = *(const f32x4*)(mu + B_COLS + q * 256 + chh); }
    const f32x4 kk_w = *(const f32x4*)(C.in[I_RKK] + l * GW + chh), ka_w = *(const f32x4*)(C.in[I_RKA] + l * GW + chh);
    v2u gxc[3], gxp[3], gxn[3], gwr, gar;
    auto gload = [&](int nb) {
        const int i = nb * 32 + st;
        const bool isctx = i < CTXL; const int Lp = isctx ? CTXL : SEQ; const int j = isctx ? i : i - CTXL; const int p = d ? (Lp - 1 - j) : j;
        const int row = (isctx ? T_LAT + b * CTXL : b * SEQ) + p;
#pragma unroll
        for (int q = 0; q < 3; ++q) {
            const bf16* pp = P + (size_t)row * PLD + OFF_B + q * 256 + chh;
            gxc[q] = *(const v2u*)pp; gxp[q] = (v2u){0u, 0u}; gxn[q] = (v2u){0u, 0u};
            if (p > 0) gxp[q] = *(const v2u*)(pp - PLD);
            if (p < Lp - 1) gxn[q] = *(const v2u*)(pp + PLD);
        }
        gwr = *(const v2u*)(WA + (size_t)row * 1024 + d * 256 + chh); gar = *(const v2u*)(WA + (size_t)row * 1024 + (2 + d) * 256 + chh);
    };
    auto sfinish = [&](int bufi) {
        f32x4 sh[3];
#pragma unroll
        for (int q = 0; q < 3; ++q) {
            const f32x4 x = (f32x4){bflo(gxc[q].x), bfhi(gxc[q].x), bflo(gxc[q].y), bfhi(gxc[q].y)}, pv = (f32x4){bflo(gxp[q].x), bfhi(gxp[q].x), bflo(gxp[q].y), bfhi(gxp[q].y)}, nx = (f32x4){bflo(gxn[q].x), bfhi(gxn[q].x), bflo(gxn[q].y), bfhi(gxn[q].y)};
            sh[q] = x + mu0[q] * (pv - x) + mu1[q] * (nx - x);
        }
        const f32x4 w = (f32x4){bflo(gwr.x), bfhi(gwr.x), bflo(gwr.y), bfhi(gwr.y)}, a = (f32x4){bflo(gar.x), bfhi(gar.x), bflo(gar.y), bfhi(gar.y)};
        f32x4 kk = sh[1] * kk_w;
        const float ss = row16_sum((kk.x * kk.x + kk.y * kk.y) + (kk.z * kk.z + kk.w * kk.w));
        kk = kk * (1.0f / sqrtf(ss + 1e-6f));
        const f32x4 km = sh[1] * ((a - 1.0f) * ka_w + 1.0f), beta = kk * a;
        LAS float* o = BUF + ((bufi * 32 + st) * 6) * 64 + q4 * 4;
        *(LAS f32x4*)(o + 0 * 64) = sh[0]; *(LAS f32x4*)(o + 1 * 64) = kk; *(LAS f32x4*)(o + 2 * 64) = w; *(LAS f32x4*)(o + 3 * 64) = beta; *(LAS f32x4*)(o + 4 * 64) = km; *(LAS f32x4*)(o + 5 * 64) = sh[2];
    };
    const int rr = C.tid >> 4, jq = C.tid & 15;
    f32x4 s = (f32x4){0.f, 0.f, 0.f, 0.f};
    constexpr int NBLK = NSTEP / 32;
    gload(0); sfinish(0); gload(1);
    __syncthreads();
    for (int nb = 0; nb < NBLK; ++nb) {
        if (nb + 1 < NBLK) { sfinish((nb + 1) & 1); if (nb + 2 < NBLK) gload(nb + 2); }
        const LAS float* bb = BUF + ((nb & 1) * 32) * 6 * 64;
        LAS float* yb = YB + (nb & 1) * 1024;
        const LAS float* o0 = bb + jq * 4; const LAS float* v0 = bb + 5 * 64 + half * 32 + rr;
        f32x4 r4 = *(const LAS f32x4*)(o0), kk = *(const LAS f32x4*)(o0 + 64), wv = *(const LAS f32x4*)(o0 + 128), be = *(const LAS f32x4*)(o0 + 192), km = *(const LAS f32x4*)(o0 + 256);
        float vv = v0[0];
#pragma unroll
        for (int hb = 0; hb < 2; ++hb) {
            float ysel = 0.f;
#pragma unroll
            for (int t16 = 0; t16 < 16; ++t16) {
                const int t = hb * 16 + t16;
                const f32x4 cr = r4, ck = kk, cw = wv, cb = be, cm_ = km; const float cv = vv;
                if (t + 1 < 32) { const LAS float* o = o0 + (t + 1) * 6 * 64;
                    r4 = *(const LAS f32x4*)(o); kk = *(const LAS f32x4*)(o + 64); wv = *(const LAS f32x4*)(o + 128); be = *(const LAS f32x4*)(o + 192); km = *(const LAS f32x4*)(o + 256); vv = v0[(t + 1) * 6 * 64]; }
                const float sk = row16_sum((s.x * ck.x + s.y * ck.y) + (s.z * ck.z + s.w * ck.w));
                s = s * cw - cb * sk + cm_ * cv;
                const float y = row16_sum((s.x * cr.x + s.y * cr.y) + (s.z * cr.z + s.w * cr.w));
                ysel = (jq == t16) ? y : ysel;
            }
            yb[(hb * 16 + jq) * 32 + rr] = ysel;
        }
        __syncthreads();
        {
            const int t = C.tid >> 4, r2 = (C.tid & 15) * 2;
            const int i = nb * 32 + t; const int row = seqrow_raster(i, d, b);
            *(unsigned*)(outb + (size_t)row * 256 + h * 64 + half * 32 + r2) = pk2(yb[t * 32 + r2], yb[t * 32 + r2 + 1]);
        }
    }
    __syncthreads();
}

#define RAW_BARRIER() do { asm volatile("s_waitcnt lgkmcnt(0)" ::: "memory"); __builtin_amdgcn_s_barrier(); asm volatile("" ::: "memory"); } while (0)
__device__ __forceinline__ void mlstm_scan_v0(const Ctx& C, int l, int idx) {
    const int d = idx >> 5, b = (idx >> 2) & 7, h = idx & 3, lane = C.lane, w = C.wave;
    LAS float* PN = (LAS float*)C.lds;
    LAS float* PD = PN + 2 * 8 * 64;
    LAS unsigned char* SB = C.lds + 8192;
    constexpr int SBS = 3 * 4096 + 256;
    const bf16* P = WSP(const bf16, WS_P); bf16* outc = WSP(bf16, WS_OUTC) + (size_t)d * T_ALL * 256;
    const float ib = C.in[I_MIB][(l * 2 + d) * NH + h], fb = C.in[I_MFB][(l * 2 + d) * NH + h];
    const int st_ = C.tid >> 4, part = C.tid & 15;
    auto stage = [&](int nb, int bufi) {
        const int row = seqrow_cm(nb * 32 + st_, d, b);
        const size_t ro = (size_t)row * PLD + OFF_C + h * 64 + part * 4;
        LAS unsigned char* sb = SB + bufi * SBS;
        *(LAS v2u*)(sb + st_ * 128 + part * 8) = *(const v2u*)(P + ro);
        *(LAS v2u*)(sb + 4096 + st_ * 128 + part * 8) = *(const v2u*)(P + ro + 256);
        *(LAS v2u*)(sb + 8192 + st_ * 128 + part * 8) = *(const v2u*)(P + ro + 512);
        if (part == 0) { const size_t rg = (size_t)row * PLD + OFF_C + 1024;
            const float li = bf2f(P[rg + d * 4 + h]) + ib, gf = bf2f(P[rg + 8 + d * 4 + h]) + fb;
            *(LAS f32x2*)(sb + 12288 + st_ * 8) = (f32x2){li, -softplusf_(-gf)}; }
    };
    float Cm[8], nk[8];
#pragma unroll
    for (int k = 0; k < 8; ++k) { Cm[k] = 0.f; nk[k] = 0.f; }
    float m = 0.f;
    stage(0, 0);
    __syncthreads();
    for (int nb = 0; nb < NSTEP / 32; ++nb) {
        if (nb + 1 < NSTEP / 32) stage(nb + 1, (nb + 1) & 1);
        const LAS unsigned char* sb = SB + (nb & 1) * SBS;
#pragma unroll 2
        for (int t = 0; t < 32; ++t) {
            const int i = nb * 32 + t;
            const v4u cq = *(const LAS v4u*)(sb + t * 128 + w * 16), ck = *(const LAS v4u*)(sb + 4096 + t * 128 + w * 16);
            const float vv = bf2f(*(const LAS unsigned short*)(sb + 8192 + t * 128 + lane * 2));
            const f32x2 gt = *(const LAS f32x2*)(sb + 12288 + t * 8);
            const float li = gt.x, lf = gt.y;
            const float mn = fmaxf(lf + m, li), fp = __expf(lf + m - mn), ip = __expf(li - mn);
            const float qf[8] = {bflo(cq.x), bfhi(cq.x), bflo(cq.y), bfhi(cq.y), bflo(cq.z), bfhi(cq.z), bflo(cq.w), bfhi(cq.w)};
            const float kf[8] = {bflo(ck.x), bfhi(ck.x), bflo(ck.y), bfhi(ck.y), bflo(ck.z), bfhi(ck.z), bflo(ck.w), bfhi(ck.w)};
            const float ipv = ip * vv;
            float num = 0.f, den = 0.f;
#pragma unroll
            for (int k = 0; k < 8; ++k) { const float kk = kf[k] * 0.125f; Cm[k] = fp * Cm[k] + ipv * kk; nk[k] = fp * nk[k] + ip * kk; num += Cm[k] * qf[k]; den += nk[k] * qf[k]; }
            m = mn;
            const int pb_ = i & 1;
            PN[(pb_ * 8 + w) * 64 + lane] = num; if (lane == 0) PD[pb_ * 8 + w] = den;
            RAW_BARRIER();
            if (w == 0) {
                float ns = 0.f, ds = 0.f;
#pragma unroll
                for (int ww = 0; ww < 8; ++ww) { ns += PN[(pb_ * 8 + ww) * 64 + lane]; ds += PD[pb_ * 8 + ww]; }
                outc[(size_t)seqrow_cm(i, d, b) * 256 + h * 64 + lane] = (bf16)f2bf1(ns / fmaxf(fabsf(ds), __expf(-mn)));
            }
        }
        __syncthreads();
    }
}

__device__ __forceinline__ void gdn_prep(const Ctx& C, int l, int b, int c) {
    const bf16* P = WSP(const bf16, WS_P); bf16* gq = WSP(bf16, WS_GQ);
    const bool isctx = c < 4; const int p0 = isctx ? c * 64 : (c - 4) * 64; const int Lp = isctx ? CTXL : SEQ;
    const int ch = 4 * C.lane;
    auto rowof = [&](int p) -> int { return isctx ? (T_LAT + b * CTXL + p) : (b * SEQ + (p & 63) * 64 + (p >> 6)); };
    f32x4 cw[4][3], x[4][3];
#pragma unroll
    for (int j = 0; j < 4; ++j)
#pragma unroll
        for (int g = 0; g < 3; ++g) cw[j][g] = *(const f32x4*)(C.in[I_GCW] + ((size_t)l * 4 + j) * 768 + g * 256 + ch);
    const int tb = p0 + C.wave * 8;
    auto ldrow = [&](int p, f32x4 (&dst)[3]) {
        if (p >= 0 && p < Lp) { const bf16* pr = P + (size_t)rowof(p) * PLD + OFF_D + ch;
#pragma unroll
            for (int g = 0; g < 3; ++g) dst[g] = ld4bf(pr + g * 256); }
        else {
#pragma unroll
            for (int g = 0; g < 3; ++g) dst[g] = (f32x4){0.f, 0.f, 0.f, 0.f}; }
    };
    ldrow(tb - 2, x[0]); ldrow(tb - 1, x[1]); ldrow(tb, x[2]);
#pragma unroll
    for (int t = 0; t < 8; ++t) {
        ldrow(tb + t + 1, x[3]);
        bf16* orow = gq + (size_t)rowof(tb + t) * 768 + ch;
#pragma unroll
        for (int g = 0; g < 3; ++g) {
            f32x4 v = cw[0][g] * x[0][g] + cw[1][g] * x[1][g] + cw[2][g] * x[2][g] + cw[3][g] * x[3][g];
            v = (f32x4){siluf_(v.x), siluf_(v.y), siluf_(v.z), siluf_(v.w)};
            if (g < 2) { const float ss = row16_sum((v.x * v.x + v.y * v.y) + (v.z * v.z + v.w * v.w)); v = v * ((1.0f / sqrtf(ss + 1e-6f)) * (g == 0 ? 0.125f : 1.0f)); }
            st4bf(orow + g * 256, v);
        }
#pragma unroll
        for (int g = 0; g < 3; ++g) { x[0][g] = x[1][g]; x[1][g] = x[2][g]; x[2][g] = x[3][g]; }
    }
}
__device__ __forceinline__ void gdn_scan_v0(const Ctx& C, int l, int idx) {
    const int d = idx >> 5, b = (idx >> 2) & 7, h = idx & 3, lane = C.lane, w = C.wave;
    LAS float* PA = (LAS float*)C.lds;
    LAS float* PB = PA + 2 * 8 * 64;
    LAS unsigned char* SB = C.lds + 8192;
    constexpr int SBS = 3 * 4096 + 256;
    const bf16* P = WSP(const bf16, WS_P); const bf16* gq = WSP(const bf16, WS_GQ); bf16* outd = WSP(bf16, WS_OUTD) + (size_t)d * T_ALL * 256;
    const float aexp = __expf(C.in[I_GALOG][(l * 2 + d) * NH + h]), dtb = C.in[I_GDTB][(l * 2 + d) * NH + h];
    const int st_ = C.tid >> 4, part = C.tid & 15;
    auto stage = [&](int nb, int bufi) {
        const int row = seqrow_cm(nb * 32 + st_, d, b);
        const size_t rq = (size_t)row * 768 + h * 64 + part * 4;
        LAS unsigned char* sb = SB + bufi * SBS;
        *(LAS v2u*)(sb + st_ * 128 + part * 8) = *(const v2u*)(gq + rq);
        *(LAS v2u*)(sb + 4096 + st_ * 128 + part * 8) = *(const v2u*)(gq + rq + 256);
        *(LAS v2u*)(sb + 8192 + st_ * 128 + part * 8) = *(const v2u*)(gq + rq + 512);
        if (part == 0) { const size_t ro = (size_t)row * PLD + OFF_D + 1024;
            const float ga = bf2f(P[ro + d * 4 + h]), gb = bf2f(P[ro + 8 + d * 4 + h]);
            *(LAS f32x2*)(sb + 12288 + st_ * 8) = (f32x2){__expf(-aexp * softplusf_(ga + dtb)), sigmoidf_(gb)}; }
    };
    float S[8];
#pragma unroll
    for (int k = 0; k < 8; ++k) S[k] = 0.f;
    stage(0, 0);
    __syncthreads();
    int prow = 0;
    for (int nb = 0; nb < NSTEP / 32; ++nb) {
        if (nb + 1 < NSTEP / 32) stage(nb + 1, (nb + 1) & 1);
        const LAS unsigned char* sb = SB + (nb & 1) * SBS;
#pragma unroll 2
        for (int t = 0; t < 32; ++t) {
            const int i = nb * 32 + t;
            const v4u cq = *(const LAS v4u*)(sb + t * 128 + w * 16), ck = *(const LAS v4u*)(sb + 4096 + t * 128 + w * 16);
            const float vv = bf2f(*(const LAS unsigned short*)(sb + 8192 + t * 128 + lane * 2));
            const f32x2 gt = *(const LAS f32x2*)(sb + 12288 + t * 8);
            const float alpha = gt.x, beta = gt.y;
            const float qf[8] = {bflo(cq.x), bfhi(cq.x), bflo(cq.y), bfhi(cq.y), bflo(cq.z), bfhi(cq.z), bflo(cq.w), bfhi(cq.w)};
            const float kf[8] = {bflo(ck.x), bfhi(ck.x), bflo(ck.y), bfhi(ck.y), bflo(ck.z), bfhi(ck.z), bflo(ck.w), bfhi(ck.w)};
            float ks = 0.f;
#pragma unroll
            for (int k = 0; k < 8; ++k) ks += kf[k] * S[k];
            const int pb_ = i & 1;
            PA[(pb_ * 8 + w) * 64 + lane] = ks;
            RAW_BARRIER();
            if (w == 0 && i > 0) {
                float os = 0.f;
#pragma unroll
                for (int ww = 0; ww < 8; ++ww) os += PB[((pb_ ^ 1) * 8 + ww) * 64 + lane];
                outd[(size_t)prow * 256 + h * 64 + lane] = (bf16)f2bf1(os);
            }
            float kS = 0.f;
#pragma unroll
            for (int ww = 0; ww < 8; ++ww) kS += PA[(pb_ * 8 + ww) * 64 + lane];
            const float coef = beta * (vv - alpha * kS);
            float o = 0.f;
#pragma unroll
            for (int k = 0; k < 8; ++k) { S[k] = alpha * S[k] + kf[k] * coef; o += qf[k] * S[k]; }
            PB[(pb_ * 8 + w) * 64 + lane] = o;
            prow = seqrow_cm(i, d, b);
        }
        __syncthreads();
    }
    if (w == 0) {
        float os = 0.f;
#pragma unroll
        for (int ww = 0; ww < 8; ++ww) os += PB[(((NSTEP - 1) & 1) * 8 + ww) * 64 + lane];
        outd[(size_t)prow * 256 + h * 64 + lane] = (bf16)f2bf1(os);
    }
    __syncthreads();
}

__device__ __forceinline__ void finish_rows(const Ctx& C, int l, int nrows) {
    const bf16* P = WSP(const bf16, WS_P); bf16* yc = WSP(bf16, WS_HB);
    const bf16* ob = WSP(const bf16, WS_OUTB); const bf16* oc = WSP(const bf16, WS_OUTC); const bf16* od = WSP(const bf16, WS_OUTD);
    const bf16* gg = WSP(const bf16, WS_G); const float* bonus = WSP(const float, WS_BONUS);
    const float* mu = C.in[I_RMU] + (size_t)l * 2 * B_COLS;
    const int gw = C.wg * NWAVES + C.wave, NGW = C.G * NWAVES, lane = C.lane, ch = 4 * lane, hh = lane >> 4;
    const f32x4 lng = *(const f32x4*)(C.in[I_RLNG] + l * GW + ch), lnb = *(const f32x4*)(C.in[I_RLNB] + l * GW + ch);
    const f32x4 mng = *(const f32x4*)(C.in[I_MNG] + l * GW + ch), gng = *(const f32x4*)(C.in[I_GNG] + l * GW + ch);
    const f32x4 mu0 = *(const f32x4*)(mu + 512 + ch), mu1 = *(const f32x4*)(mu + B_COLS + 512 + ch);
    const size_t o2 = (size_t)T_ALL * 256;
#pragma unroll 2
    for (int m = gw; m < nrows; m += NGW) {
        const bool isctx = m >= T_LAT; const int Lp = isctx ? CTXL : SEQ; const int p = isctx ? ((m - T_LAT) & (CTXL - 1)) : (m & (SEQ - 1));
        const f32x4 yb = ld4bf(ob + (size_t)m * 256 + ch) + ld4bf(ob + o2 + (size_t)m * 256 + ch);
        const f32x4 ycv = ld4bf(oc + (size_t)m * 256 + ch) + ld4bf(oc + o2 + (size_t)m * 256 + ch);
        const f32x4 yd = ld4bf(od + (size_t)m * 256 + ch) + ld4bf(od + o2 + (size_t)m * 256 + ch);
        const bf16* pr = P + (size_t)m * PLD;
        const f32x4 vs = ld4bf(WSP(const bf16, WS_RKV) + (size_t)m * 768 + 512 + ch);
        const f32x4 og = ld4bf(pr + OFF_C + 768 + ch), gd = ld4bf(pr + OFF_D + 768 + ch), gr = ld4bf(gg + (size_t)m * 256 + ch);
        const float bn = bonus[(size_t)m * 4 + hh];
        *(v2u*)(yc + (size_t)m * 1024 + ch) = *(const v2u*)(pr + 256 + ch);
        {
            const float mean = row16_sum((yb.x + yb.y) + (yb.z + yb.w)) * (1.0f / 64.0f);
            const f32x4 dl = yb - mean;
            const float var = row16_sum((dl.x * dl.x + dl.y * dl.y) + (dl.z * dl.z + dl.w * dl.w)) * (1.0f / 64.0f);
            const f32x4 yn = dl * (1.0f / sqrtf(var + 64e-5f)) * lng + lnb;
            st4bf(yc + (size_t)m * 1024 + 256 + ch, (yn + vs * bn) * gr);
        }
        {
            const float ms = row16_sum((ycv.x * ycv.x + ycv.y * ycv.y) + (ycv.z * ycv.z + ycv.w * ycv.w)) * (1.0f / 64.0f);
            const f32x4 sg = (f32x4){sigmoidf_(og.x), sigmoidf_(og.y), sigmoidf_(og.z), sigmoidf_(og.w)};
            st4bf(yc + (size_t)m * 1024 + 512 + ch, ycv * (1.0f / sqrtf(ms + 1e-6f)) * mng * sg);
        }
        {
            const float ms = row16_sum((yd.x * yd.x + yd.y * yd.y) + (yd.z * yd.z + yd.w * yd.w)) * (1.0f / 64.0f);
            const f32x4 sg = (f32x4){siluf_(gd.x), siluf_(gd.y), siluf_(gd.z), siluf_(gd.w)};
            st4bf(yc + (size_t)m * 1024 + 768 + ch, yd * (1.0f / sqrtf(ms + 1e-6f)) * gng * sg);
        }
    }
}
typedef bf16x8 fragb;
__device__ __forceinline__ f32x4 mfma16(fragb a, fragb b, f32x4 c) { return __builtin_amdgcn_mfma_f32_16x16x32_bf16(a, b, c, 0, 0, 0); }
__device__ __forceinline__ fragb ld_frag16(const LAS bf16* p) { return *(const LAS fragb*)p; }
__device__ __forceinline__ fragb ld_frag8x2(const LAS bf16* p0, const LAS bf16* p1) {
    const v2u a = *(const LAS v2u*)p0, b = *(const LAS v2u*)p1; v4u r; r.x = a.x; r.y = a.y; r.z = b.x; r.w = b.y; return __builtin_bit_cast(fragb, r); }
__device__ __forceinline__ fragb pack_frag(const f32x4& lo, const f32x4& hi) { v4u r; r.x = pk2(lo.x, lo.y); r.y = pk2(lo.z, lo.w); r.z = pk2(hi.x, hi.y); r.w = pk2(hi.z, hi.w); return __builtin_bit_cast(fragb, r); }
template <int CTRL, int RM, bool BC> __device__ __forceinline__ float dpp_x(float oldv, float v) { return __builtin_bit_cast(float, __builtin_amdgcn_update_dpp(__builtin_bit_cast(int, oldv), __builtin_bit_cast(int, v), CTRL, RM, 0xF, BC)); }
__device__ __forceinline__ float wave_incl_sum(float v, int lane) {
    v += dpp_x<0x111, 0xF, true>(0.f, v); v += dpp_x<0x112, 0xF, true>(0.f, v); v += dpp_x<0x114, 0xF, true>(0.f, v); v += dpp_x<0x118, 0xF, true>(0.f, v);
    v += dpp_x<0x142, 0xA, false>(0.f, v); v += dpp_x<0x143, 0xC, false>(0.f, v);
    return v;
}
__device__ __forceinline__ float wave_incl_max(float v, int lane) {
    const float ninf = -3.0e38f;
    v = fmaxf(v, dpp_x<0x111, 0xF, false>(ninf, v)); v = fmaxf(v, dpp_x<0x112, 0xF, false>(ninf, v)); v = fmaxf(v, dpp_x<0x114, 0xF, false>(ninf, v)); v = fmaxf(v, dpp_x<0x118, 0xF, false>(ninf, v));
    v = fmaxf(v, dpp_x<0x142, 0xA, false>(ninf, v)); v = fmaxf(v, dpp_x<0x143, 0xC, false>(ninf, v));
    return v;
}
constexpr int MP = 72;
__device__ __forceinline__ void mlstm_chunked(const Ctx& C, int l, int idx) {
    const int d = idx >> 5, b = (idx >> 2) & 7, h = idx & 3, lane = C.lane, w = C.wave, l15 = lane & 15, q = lane >> 4;
    const int it = w & 3, vtp = w >> 2;
    constexpr int IMG = 64 * MP * 2, BUFB = 4 * IMG + 1024, CTB = 65 * MP * 2 + 16;
    LAS unsigned char* L0 = C.lds;
    const bf16* P = WSP(const bf16, WS_P); bf16* outc = WSP(bf16, WS_OUTC) + (size_t)d * T_ALL * 256;
    const float ib = C.in[I_MIB][(l * 2 + d) * NH + h], fb = C.in[I_MFB][(l * 2 + d) * NH + h];
    const int tt = C.tid >> 3, part = C.tid & 7;
    for (int i = C.tid; i < 2 * CTB / 4; i += NTHR) ((LAS unsigned*)(L0 + 2 * BUFB))[i] = 0u;
    v4u rq, rk, rv; unsigned short rgi, rgf;
    auto gload = [&](int n) {
        const int row = seqrow_cm(n * 64 + tt, d, b);
        const bf16* pp = P + (size_t)row * PLD + OFF_C + h * 64 + 8 * part;
        rq = *(const v4u*)pp; rk = *(const v4u*)(pp + 256); rv = *(const v4u*)(pp + 512);
        const bf16* pg = P + (size_t)seqrow_cm(n * 64 + lane, d, b) * PLD + OFF_C + 1024 + d * 4 + h;
        rgi = pg[0]; rgf = pg[8];
    };
    auto images = [&](int bufi) {
        LAS unsigned char* B0 = L0 + bufi * BUFB;
        LAS bf16* Qs = (LAS bf16*)B0; LAS bf16* Ks = Qs + 64 * MP; LAS bf16* VT = Ks + 64 * MP; LAS bf16* KTw = VT + 64 * MP; LAS float* vec = (LAS float*)(B0 + 4 * IMG);
        const float li = bf2f(rgi) + ib, lf = -softplusf_(-(bf2f(rgf) + fb));
        const float bc = wave_incl_sum(lf, lane), x = li - bc, cm = wave_incl_max(x, lane);
        const float wl = __expf(x - __shfl(cm, 63)) * 0.125f;
        if (w == 0) { vec[lane] = x; vec[64 + lane] = cm; vec[128 + lane] = bc; }
        const float wmine = __shfl(wl, 8 * w + (lane >> 3));
        *(LAS v4u*)(Qs + tt * MP + 8 * part) = rq; *(LAS v4u*)(Ks + tt * MP + 8 * part) = rk;
        const unsigned vv[4] = {rv.x, rv.y, rv.z, rv.w}, kk[4] = {rk.x, rk.y, rk.z, rk.w};
#pragma unroll
        for (int e = 0; e < 4; ++e) {
            VT[(8 * part + 2 * e) * MP + tt] = (bf16)(vv[e] & 0xffffu); VT[(8 * part + 2 * e + 1) * MP + tt] = (bf16)(vv[e] >> 16);
            KTw[(8 * part + 2 * e) * MP + tt] = (bf16)f2bf1(bflo(kk[e]) * wmine); KTw[(8 * part + 2 * e + 1) * MP + tt] = (bf16)f2bf1(bfhi(kk[e]) * wmine);
        }
    };
    f32x4 Cst[2], nst; float m = 0.f;
    Cst[0] = Cst[1] = nst = (f32x4){0.f, 0.f, 0.f, 0.f};
    const fragb ones = __builtin_bit_cast(fragb, (v4u){0x3F803F80u, 0x3F803F80u, 0x3F803F80u, 0x3F803F80u});
    const f32x4 z4 = (f32x4){0.f, 0.f, 0.f, 0.f};
    gload(0); images(0); gload(1);
#pragma unroll 1
    for (int n = 0; n < NCH; ++n) {
        RAW_BARRIER();
        const LAS unsigned char* B0 = L0 + (n & 1) * BUFB;
        const LAS bf16* Qs = (const LAS bf16*)B0; const LAS bf16* Ks = Qs + 64 * MP; const LAS bf16* VT = Ks + 64 * MP; const LAS bf16* KTw = VT + 64 * MP; const LAS float* vec = (const LAS float*)(B0 + 4 * IMG);
        const LAS bf16* CT = (const LAS bf16*)(L0 + 2 * BUFB + (n & 1) * CTB); LAS bf16* CTn = (LAS bf16*)(L0 + 2 * BUFB + ((n + 1) & 1) * CTB);
        fragb Qf[2]; Qf[0] = ld_frag16(Qs + (16 * it + l15) * MP + 8 * q); Qf[1] = ld_frag16(Qs + (16 * it + l15) * MP + 32 + 8 * q);
        const float cmi = vec[64 + 16 * it + l15]; const int icol = 16 * it + l15;
        f32x4 pt[4];
#pragma unroll
        for (int jt = 0; jt < 4; ++jt) {
            pt[jt] = z4;
            if (jt <= it) {
                const fragb k0 = ld_frag16(Ks + (16 * jt + l15) * MP + 8 * q), k1 = ld_frag16(Ks + (16 * jt + l15) * MP + 32 + 8 * q);
                f32x4 st = mfma16(k0, Qf[0], z4); st = mfma16(k1, Qf[1], st);
                const f32x4 xj = *(const LAS f32x4*)(vec + 16 * jt + 4 * q);
#pragma unroll
                for (int r = 0; r < 4; ++r) { const int j = 16 * jt + 4 * q + r; pt[jt][r] = (j <= icol) ? st[r] * __expf(xj[r] - cmi) * 0.125f : 0.f; }
            }
        }
        fragb Pf[2]; Pf[0] = pack_frag(pt[0], pt[1]); Pf[1] = pack_frag(pt[2], pt[3]);
        fragb Vf[2][2];
#pragma unroll
        for (int v2 = 0; v2 < 2; ++v2)
#pragma unroll
            for (int s = 0; s < 2; ++s) { const LAS bf16* vr = VT + (16 * (2 * vtp + v2) + l15) * MP + 32 * s + 4 * q; Vf[v2][s] = ld_frag8x2(vr, vr + 16); }
        f32x4 Aacc[2], R[2], as, dn;
        as = mfma16(Pf[0], ones, z4); if (it >= 2) as = mfma16(Pf[1], ones, as);
        const fragb nf0 = ld_frag16(CT + 64 * MP + 8 * q), nf1 = ld_frag16(CT + 64 * MP + 32 + 8 * q);
        dn = mfma16(Qf[0], nf0, z4); dn = mfma16(Qf[1], nf1, dn);
#pragma unroll
        for (int v2 = 0; v2 < 2; ++v2) {
            Aacc[v2] = mfma16(Pf[0], Vf[v2][0], z4); if (it >= 2) Aacc[v2] = mfma16(Pf[1], Vf[v2][1], Aacc[v2]);
            const LAS bf16* cr = CT + (16 * (2 * vtp + v2) + l15) * MP + 8 * q;
            R[v2] = mfma16(Qf[0], ld_frag16(cr), z4); R[v2] = mfma16(Qf[1], ld_frag16(cr + 32), R[v2]);
        }
        {
            const f32x4 bi = *(const LAS f32x4*)(vec + 128 + 16 * it + 4 * q), cmr = *(const LAS f32x4*)(vec + 64 + 16 * it + 4 * q);
#pragma unroll
            for (int r = 0; r < 4; ++r) {
                const float mi = bi[r] + cmr[r], minter = bi[r] + m, mt = fmaxf(minter, mi), e1 = __expf(mi - mt), e2 = __expf(minter - mt);
                const float den = e1 * as[r] + e2 * dn[r]; const float inv = 1.0f / fmaxf(fabsf(den), __expf(-mt));
                const int row = seqrow_cm(n * 64 + 16 * it + 4 * q + r, d, b);
#pragma unroll
                for (int v2 = 0; v2 < 2; ++v2) outc[(size_t)row * 256 + h * 64 + 16 * (2 * vtp + v2) + l15] = (bf16)f2bf1((e1 * Aacc[v2][r] + e2 * R[v2][r]) * inv);
            }
        }
        {
            const LAS bf16* kr = KTw + (16 * it + l15) * MP + 4 * q;
            const fragb kt0 = ld_frag8x2(kr, kr + 16), kt1 = ld_frag8x2(kr + 32, kr + 48);
            const float bL = vec[128 + 63], mloc = bL + vec[64 + 63];
            const float mnew = fmaxf(bL + m, mloc), wp = __expf(bL + m - mnew), wn = __expf(mloc - mnew);
            f32x4 gk = mfma16(kt0, ones, z4); gk = mfma16(kt1, ones, gk);
            nst = nst * wp + gk * wn;
#pragma unroll
            for (int v2 = 0; v2 < 2; ++v2) {
                f32x4 G = mfma16(kt0, Vf[v2][0], z4); G = mfma16(kt1, Vf[v2][1], G);
                Cst[v2] = Cst[v2] * wp + G * wn;
                v2u o; o.x = pk2(Cst[v2].x, Cst[v2].y); o.y = pk2(Cst[v2].z, Cst[v2].w);
                *(LAS v2u*)(CTn + (16 * (2 * vtp + v2) + l15) * MP + 16 * it + 4 * q) = o;
            }
            if (vtp == 0 && l15 == 0) { v2u o; o.x = pk2(nst.x, nst.y); o.y = pk2(nst.z, nst.w); *(LAS v2u*)(CTn + 64 * MP + 16 * it + 4 * q) = o; }
            m = mnew;
        }
        if (n + 1 < NCH) { images((n + 1) & 1); if (n + 2 < NCH) gload(n + 2); }
    }
    __syncthreads();
}
__device__ __forceinline__ int fwd_row_cm(int b, int c, int t) { return c < 4 ? (T_LAT + b * CTXL + c * 64 + t) : (b * SEQ + t * 64 + (c - 4)); }
__device__ __forceinline__ bf16* blob_row(const Ctx& C, int d, int isw, int b, int c, int h, int r) {
    const int row = fwd_row_cm(b, c, r);
    if (d == 1 && isw) return WSP(bf16, WS_OUTD) + ((size_t)T_ALL + row) * 256 + h * 64;
    return WSP(bf16, WS_P) + (size_t)row * PLD + OFF_D + (d * 2 + isw) * 256 + h * 64;
}
constexpr int LP = 68;
__device__ __forceinline__ void gdn_solve_item(const Ctx& C, int l, int item) {
    const int lane = C.lane, w = C.wave, pw = w & 1, pi = w >> 1, l15 = lane & 15, q = lane >> 4;
    LAS unsigned char* B0 = C.lds + pi * 28672;
    LAS float* Lm = (LAS float*)B0;
    LAS bf16* Ks = (LAS bf16*)(B0 + 17408);
    LAS float* vec = (LAS float*)(B0 + 17408 + 9216);
    const bf16* P = WSP(const bf16, WS_P); const bf16* gq = WSP(const bf16, WS_GQ);
    constexpr int NIT = 2 * NB * NH * NCH;
    {
        const bool active = item < NIT; if (!active) item = NIT - 1;
        const int u = item >> 1, d = item & 1;
        const int c = u % NCH, h = (u / NCH) & 3, b = u / (NCH * NH);
        {
            const int n = d ? (c < 4 ? 3 - c : 71 - c) : c;
            const float aexp = __expf(C.in[I_GALOG][(l * 2 + d) * NH + h]), dtb = C.in[I_GDTB][(l * 2 + d) * NH + h];
            const int rowl = seqrow_cm(n * 64 + lane, d, b);
            const bf16* pg = P + (size_t)rowl * PLD + OFF_D + 1024 + d * 4 + h;
            const float la = -aexp * softplusf_(bf2f(pg[0]) + dtb), beta = sigmoidf_(bf2f(pg[8]));
            const float gam = wave_incl_sum(la, lane);
            if (pw == 0) { vec[lane] = beta; vec[64 + lane] = gam; }
#pragma unroll
            for (int r = 0; r < 4; ++r) { const int idx = pw * 64 + lane + 128 * r, t = idx >> 3, part = idx & 7;
                *(LAS v4u*)(Ks + t * MP + 8 * part) = *(const v4u*)(gq + (size_t)seqrow_cm(n * 64 + t, d, b) * 768 + 256 + h * 64 + 8 * part); }
            float x[64];
#pragma unroll
            for (int i = 0; i < 64; ++i) x[i] = bf2f(gq[(size_t)seqrow_cm(n * 64 + i, d, b) * 768 + (pw ? 256 : 512) + h * 64 + lane]);
            __syncthreads();
            {
                int tix = 0;
#pragma unroll
                for (int it = 0; it < 4; ++it)
#pragma unroll
                    for (int jt = 0; jt <= it; ++jt, ++tix) if ((tix & 1) == pw) {
                        f32x4 acc = (f32x4){0.f, 0.f, 0.f, 0.f};
#pragma unroll
                        for (int s = 0; s < 2; ++s) acc = mfma16(ld_frag16(Ks + (16 * it + l15) * MP + 32 * s + 8 * q), ld_frag16(Ks + (16 * jt + l15) * MP + 32 * s + 8 * q), acc);
                        const float gj = vec[64 + 16 * jt + l15];
                        const f32x4 bi = *(const LAS f32x4*)(vec + 16 * it + 4 * q), gi = *(const LAS f32x4*)(vec + 64 + 16 * it + 4 * q);
#pragma unroll
                        for (int r = 0; r < 4; ++r) { const int i = 16 * it + 4 * q + r, j = 16 * jt + l15;
                            Lm[i * LP + j] = (j < i) ? bi[r] * acc[r] * __expf(gi[r] - gj) : 0.f; }
                    }
            }
            __syncthreads();
#pragma unroll
            for (int i = 0; i < 64; ++i) {
                const float sc = pw ? vec[i] * __expf(vec[64 + i]) : vec[i];
                float a0 = x[i] * sc, a1 = 0.f;
                int roff = i * LP; { const int dep = i < 24 ? i - 6 : (i < 40 ? i - 3 : i - 2); if (dep >= 0) asm volatile("" : "+v"(roff) : "v"(x[dep >= 0 ? dep : 0])); }
                const LAS float* lrow = Lm + roff;
#pragma unroll
                for (int j4 = 0; j4 < i; j4 += 4) { const f32x4 lv = *(const LAS f32x4*)(lrow + j4);
                    a0 -= lv.x * x[j4]; if (j4 + 1 < i) a1 -= lv.y * x[j4 + 1]; if (j4 + 2 < i) a0 -= lv.z * x[j4 + 2]; if (j4 + 3 < i) a1 -= lv.w * x[j4 + 3]; }
                x[i] = a0 + a1;
            }
            if (active) { bf16* dst = blob_row(C, d, pw, b, c, h, lane);
#pragma unroll
                for (int g = 0; g < 8; ++g) { v4u o; o.x = pk2(x[8 * g], x[8 * g + 1]); o.y = pk2(x[8 * g + 2], x[8 * g + 3]); o.z = pk2(x[8 * g + 4], x[8 * g + 5]); o.w = pk2(x[8 * g + 6], x[8 * g + 7]);
                    *(v4u*)(dst + 8 * g) = o; } }
            __syncthreads();
        }
    }
}

template <bool DRY>
__device__ __forceinline__ void gdn_chunked(const Ctx& C, int l, int idx) {
    const int d = idx >> 5, b = (idx >> 2) & 7, h = idx & 3, lane = C.lane, w = C.wave, l15 = lane & 15, q = lane >> 4;
    const int it = w & 3, vtp = w >> 2;
    constexpr int IMG = 64 * MP * 2, BUFB = 5 * IMG + 512;
    LAS unsigned char* L0 = C.lds;
    LAS bf16* VnT = (LAS bf16*)(L0 + 2 * BUFB + 2 * IMG);
    const bf16* P = WSP(const bf16, WS_P); const bf16* gq = WSP(const bf16, WS_GQ); bf16* outd = WSP(bf16, WS_OUTD) + (size_t)d * T_ALL * 256;
    const float aexp = __expf(C.in[I_GALOG][(l * 2 + d) * NH + h]), dtb = C.in[I_GDTB][(l * 2 + d) * NH + h];
    const int tt = C.tid >> 3, part = C.tid & 7;
    for (int i = C.tid; i < 2 * IMG / 4; i += NTHR) ((LAS unsigned*)(L0 + 2 * BUFB))[i] = 0u;
    v4u rq, rk, ru, rw; unsigned short rga;
    auto gload = [&](int n) {
        const int c = d ? (n < 4 ? 3 - n : 71 - n) : n;
        const bf16* pp = gq + (size_t)seqrow_cm(n * 64 + tt, d, b) * 768 + h * 64 + 8 * part;
        rq = *(const v4u*)pp; rk = *(const v4u*)(pp + 256);
        ru = *(const v4u*)(blob_row(C, d, 0, b, c, h, tt) + 8 * part); rw = *(const v4u*)(blob_row(C, d, 1, b, c, h, tt) + 8 * part);
        rga = P[(size_t)seqrow_cm(n * 64 + lane, d, b) * PLD + OFF_D + 1024 + d * 4 + h];
    };
    auto images = [&](int bufi) {
        LAS unsigned char* B0 = L0 + bufi * BUFB;
        LAS bf16* Qs = (LAS bf16*)B0; LAS bf16* Ks = Qs + 64 * MP; LAS bf16* KdT = Ks + 64 * MP; LAS bf16* Wi = KdT + 64 * MP; LAS bf16* UT = Wi + 64 * MP; LAS float* vec = (LAS float*)(B0 + 5 * IMG);
        const float la = -aexp * softplusf_(bf2f(rga) + dtb);
        const float gam = wave_incl_sum(la, lane);
        if (w == 0) vec[lane] = gam;
        const float kd = __expf(__shfl(gam, 63) - gam);
        const float kmine = __shfl(kd, 8 * w + (lane >> 3));
        *(LAS v4u*)(Qs + tt * MP + 8 * part) = rq; *(LAS v4u*)(Ks + tt * MP + 8 * part) = rk; *(LAS v4u*)(UT + tt * MP + 8 * part) = ru;
        const unsigned kk[4] = {rk.x, rk.y, rk.z, rk.w}, ww[4] = {rw.x, rw.y, rw.z, rw.w};
#pragma unroll
        for (int e = 0; e < 4; ++e) {
            KdT[(8 * part + 2 * e) * MP + tt] = (bf16)f2bf1(bflo(kk[e]) * kmine); KdT[(8 * part + 2 * e + 1) * MP + tt] = (bf16)f2bf1(bfhi(kk[e]) * kmine);
            Wi[(8 * part + 2 * e) * MP + tt] = (bf16)(ww[e] & 0xffffu); Wi[(8 * part + 2 * e + 1) * MP + tt] = (bf16)(ww[e] >> 16);
        }
    };
    f32x4 Sst[2]; Sst[0] = Sst[1] = (f32x4){0.f, 0.f, 0.f, 0.f};
    const f32x4 z4 = (f32x4){0.f, 0.f, 0.f, 0.f};
    gload(0); images(0); gload(1);
#pragma unroll 1
    for (int n = 0; n < NCH; ++n) {
        RAW_BARRIER();
        const LAS unsigned char* B0 = L0 + (n & 1) * BUFB;
        const LAS bf16* Qs = (const LAS bf16*)B0; const LAS bf16* Ks = Qs + 64 * MP; const LAS bf16* KdT = Ks + 64 * MP; const LAS bf16* Wi = KdT + 64 * MP; const LAS bf16* UT = Wi + 64 * MP; const LAS float* vec = (const LAS float*)(B0 + 5 * IMG);
        const LAS bf16* ST = (const LAS bf16*)(L0 + 2 * BUFB + (n & 1) * IMG); LAS bf16* STn = (LAS bf16*)(L0 + 2 * BUFB + ((n + 1) & 1) * IMG);
        fragb Qf[2]; Qf[0] = ld_frag16(Qs + (16 * it + l15) * MP + 8 * q); Qf[1] = ld_frag16(Qs + (16 * it + l15) * MP + 32 + 8 * q);
        const float gcol = vec[16 * it + l15]; const int icol = 16 * it + l15;
        f32x4 pt[4];
#pragma unroll
        for (int jt = 0; jt < 4; ++jt) {
            pt[jt] = z4;
            if (jt <= it) {
                const fragb k0 = ld_frag16(Ks + (16 * jt + l15) * MP + 8 * q), k1 = ld_frag16(Ks + (16 * jt + l15) * MP + 32 + 8 * q);
                f32x4 st = mfma16(k0, Qf[0], z4); st = mfma16(k1, Qf[1], st);
                const f32x4 gj = *(const LAS f32x4*)(vec + 16 * jt + 4 * q);
#pragma unroll
                for (int r = 0; r < 4; ++r) { const int j = 16 * jt + 4 * q + r; pt[jt][r] = (j <= icol) ? st[r] * __expf(gcol - gj[r]) : 0.f; }
            }
        }
        fragb Pf[2]; Pf[0] = pack_frag(pt[0], pt[1]); Pf[1] = pack_frag(pt[2], pt[3]);
        const fragb Wf0 = ld_frag16(Wi + (16 * it + l15) * MP + 8 * q), Wf1 = ld_frag16(Wi + (16 * it + l15) * MP + 32 + 8 * q);
        f32x4 Ro[2];
#pragma unroll
        for (int v2 = 0; v2 < 2; ++v2) {
            const int vrow = 16 * (2 * vtp + v2) + l15;
            const fragb s0 = ld_frag16(ST + vrow * MP + 8 * q), s1 = ld_frag16(ST + vrow * MP + 32 + 8 * q);
            f32x4 ws = mfma16(Wf0, s0, z4); ws = mfma16(Wf1, s1, ws);
            Ro[v2] = mfma16(Qf[0], s0, z4); Ro[v2] = mfma16(Qf[1], s1, Ro[v2]);
            const v2u ur = *(const LAS v2u*)(UT + vrow * MP + 16 * it + 4 * q);
            v2u o; o.x = pk2(bflo(ur.x) - ws.x, bfhi(ur.x) - ws.y); o.y = pk2(bflo(ur.y) - ws.z, bfhi(ur.y) - ws.w);
            *(LAS v2u*)(VnT + vrow * MP + 16 * it + 4 * q) = o;
        }
        RAW_BARRIER();
        {
            const f32x4 gi = *(const LAS f32x4*)(vec + 16 * it + 4 * q);
            const float gl = __expf(vec[63]);
            const LAS bf16* kr = KdT + (16 * it + l15) * MP + 4 * q;
            const fragb kt0 = ld_frag8x2(kr, kr + 16), kt1 = ld_frag8x2(kr + 32, kr + 48);
#pragma unroll
            for (int v2 = 0; v2 < 2; ++v2) {
                const int vrow = 16 * (2 * vtp + v2) + l15;
                const LAS bf16* vr = VnT + vrow * MP + 4 * q;
                const fragb n0 = ld_frag8x2(vr, vr + 16), n1 = ld_frag8x2(vr + 32, vr + 48);
                f32x4 o = mfma16(Pf[0], n0, z4); if (it >= 2) o = mfma16(Pf[1], n1, o);
#pragma unroll
                for (int r = 0; r < 4; ++r) { const int row = seqrow_cm(n * 64 + 16 * it + 4 * q + r, d, b);
                    if (!DRY) outd[(size_t)row * 256 + h * 64 + vrow] = (bf16)f2bf1(o[r] + __expf(gi[r]) * Ro[v2][r]); }
                f32x4 ns = mfma16(kt0, n0, z4); ns = mfma16(kt1, n1, ns);
                Sst[v2] = Sst[v2] * gl + ns;
                v2u so; so.x = pk2(Sst[v2].x, Sst[v2].y); so.y = pk2(Sst[v2].z, Sst[v2].w);
                *(LAS v2u*)(STn + vrow * MP + 16 * it + 4 * q) = so;
            }
        }
        if (n + 1 < NCH) { images((n + 1) & 1); if (n + 2 < NCH) gload(n + 2); }
    }
    __syncthreads();
}
constexpr int UP = 264;
template <int CTRL> __device__ __forceinline__ float dpp_keep(float oldv, float v) { return __builtin_bit_cast(float, __builtin_amdgcn_update_dpp(__builtin_bit_cast(int, oldv), __builtin_bit_cast(int, v), CTRL, 0xF, 0xF, false)); }
template <bool REV> __device__ __forceinline__ void scan16(float& A, float& B) {
#define LRU_STEP(S) { const float Ap = dpp_keep<(REV ? 0x100 : 0x110) | S>(1.0f, A), Bp = dpp_keep<(REV ? 0x100 : 0x110) | S>(0.0f, B); B = A * Bp + B; A = A * Ap; }
    LRU_STEP(1) LRU_STEP(2) LRU_STEP(4) LRU_STEP(8)
#undef LRU_STEP
}
template <bool FIN, bool REV>
__device__ __forceinline__ void lru_wave(const Ctx& C, int l, int b, int c, int hd, LAS bf16* U16, LAS bf16* H16) {
    constexpr int d = REV ? 1 : 0;
    const int lane = C.lane, l15 = lane & 15, q = lane >> 4;
    const bf16* wt = WSP(const bf16, WS_LRUWT) + (size_t)((d * 2 + 0) * 4 + hd) * 4096;
    fragb Wa[4][2], Wx[4][2];
#pragma unroll
    for (int mt = 0; mt < 4; ++mt)
#pragma unroll
        for (int ks = 0; ks < 2; ++ks) { Wa[mt][ks] = *(const fragb*)(wt + (16 * mt + l15) * 64 + 32 * ks + 8 * q); Wx[mt][ks] = *(const fragb*)(wt + 4 * 4096 + (16 * mt + l15) * 64 + 32 * ks + 8 * q); }
    f32x4 sp4[4], hc[4], sla[4];
    const size_t sbase = ((size_t)(b * NCH + c) * 2 + d) * 256 + hd * 64;
#pragma unroll
    for (int mt = 0; mt < 4; ++mt) {
        const int ch = hd * 64 + 16 * mt + 4 * q;
        const f32x4 lam = *(const f32x4*)(C.in[I_LLAM] + (l * 2 + d) * GW + ch);
#pragma unroll
        for (int r = 0; r < 4; ++r) sp4[mt][r] = 8.0f * softplusf_(-lam[r]);
        hc[mt] = FIN ? *(const f32x4*)(WSP(const float, WS_HIN) + sbase + 16 * mt + 4 * q) : (f32x4){0.f, 0.f, 0.f, 0.f};
        sla[mt] = (f32x4){0.f, 0.f, 0.f, 0.f};
    }
    const f32x4 z4 = (f32x4){0.f, 0.f, 0.f, 0.f};
#pragma unroll 1
    for (int nti = 0; nti < 4; ++nti) {
        const int nt = REV ? 3 - nti : nti;
        const LAS bf16* urow = U16 + (16 * nt + l15) * UP + hd * 64;
        const fragb Uf0 = ld_frag16(urow + 8 * q), Uf1 = ld_frag16(urow + 32 + 8 * q);
#pragma unroll
        for (int mt = 0; mt < 4; ++mt) {
            f32x4 aa = mfma16(Wa[mt][0], Uf0, z4); aa = mfma16(Wa[mt][1], Uf1, aa);
            f32x4 ax = mfma16(Wx[mt][0], Uf0, z4); ax = mfma16(Wx[mt][1], Uf1, ax);
            const v2u ur = *(const LAS v2u*)(urow + 16 * mt + 4 * q);
            const float u4[4] = {bflo(ur.x), bfhi(ur.x), bflo(ur.y), bfhi(ur.y)};
            const f32x4 ba = *(const f32x4*)(C.in[I_LBA] + (l * 2 + d) * GW + hd * 64 + 16 * mt + 4 * q), bx = *(const f32x4*)(C.in[I_LBX] + (l * 2 + d) * GW + hd * 64 + 16 * mt + 4 * q);
            f32x4 hv;
#pragma unroll
            for (int r = 0; r < 4; ++r) {
                const float rg = sigmoidf_(aa[r] + ba[r]), ig = sigmoidf_(ax[r] + bx[r]);
                const float la = -sp4[mt][r] * rg; float A = __expf(la); float Bv = sqrtf(-expm1f_(2.0f * la)) * (ig * u4[r]);
                sla[mt][r] += la;
                scan16<REV>(A, Bv);
                const float h = A * hc[mt][r] + Bv;
                hv[r] = h;
                hc[mt][r] = __shfl(h, (lane & 48) | (REV ? 0 : 15));
            }
            if (FIN) { v2u o; o.x = pk2(hv.x, hv.y); o.y = pk2(hv.z, hv.w); *(LAS v2u*)(H16 + (size_t)d * 64 * UP + (16 * nt + l15) * UP + hd * 64 + 16 * mt + 4 * q) = o; }
        }
    }
    if (!FIN) {
        float* ls = WSP(float, WS_LSUM);
#pragma unroll
        for (int mt = 0; mt < 4; ++mt)
#pragma unroll
            for (int r = 0; r < 4; ++r) { const float st = row16_sum(sla[mt][r]); if (l15 == 0) { const size_t si = sbase + 16 * mt + 4 * q + r; ls[si * 2] = st; ls[si * 2 + 1] = hc[mt][r]; } }
    }
}
template <bool FIN>
__device__ __forceinline__ void lru_chunk_mfma(const Ctx& C, int l, int b, int c) {
    LAS bf16* U16 = (LAS bf16*)C.lds;
    LAS bf16* H16 = U16 + 64 * UP;
    const bf16* P = WSP(const bf16, WS_P);
    const bool isctx = c < 4; const int p0 = isctx ? c * 64 : (c - 4) * 64; const int Lp = isctx ? CTXL : SEQ; const int row0 = isctx ? T_LAT + b * CTXL : b * SEQ;
    {
        const int ch = C.tid & 255, half = C.tid >> 8;
        const float* cw = C.in[I_LCW] + (size_t)l * 4 * GW + ch; const float w0 = cw[0], w1 = cw[GW], w2 = cw[2 * GW], w3 = cw[3 * GW], cb = C.in[I_LCB][l * GW + ch];
        const int t0 = half * 32;
        float xs[35];
#pragma unroll
        for (int k = 0; k < 35; ++k) { const int p = p0 + t0 + k - 2; xs[k] = (p >= 0 && p < Lp) ? bf2f(P[(size_t)(row0 + p) * PLD + ch]) : 0.f; }
#pragma unroll
        for (int t = 0; t < 32; ++t) U16[(t0 + t) * UP + ch] = (bf16)f2bf1(w0 * xs[t] + w1 * xs[t + 1] + w2 * xs[t + 2] + w3 * xs[t + 3] + cb);
    }
    __syncthreads();
    if (C.wave < 4) lru_wave<FIN, false>(C, l, b, c, C.wave & 3, U16, H16); else lru_wave<FIN, true>(C, l, b, c, C.wave & 3, U16, H16);
    __syncthreads();
    if (FIN) {
        const LAS bf16* H1 = H16 + 64 * UP;
#pragma unroll 2
        for (int it = C.tid; it < 64 * 64; it += NTHR) {
            const int t = it >> 6, c4 = (it & 63) * 4;
            const size_t row = (size_t)(row0 + p0 + t);
            const v2u a = *(const LAS v2u*)(H16 + t * UP + c4), bq = *(const LAS v2u*)(H1 + t * UP + c4);
            const f32x4 g = ld4bf(P + row * PLD + 256 + c4);
            f32x4 y = (f32x4){bflo(a.x) + bflo(bq.x), bfhi(a.x) + bfhi(bq.x), bflo(a.y) + bflo(bq.y), bfhi(a.y) + bfhi(bq.y)};
            y.x *= gelu_tanh(g.x); y.y *= gelu_tanh(g.y); y.z *= gelu_tanh(g.z); y.w *= gelu_tanh(g.w);
            st4bf(WSP(bf16, WS_P) + row * PLD + 256 + c4, y);
        }
        __syncthreads();
    }
}
constexpr int RP = 264;
__device__ __forceinline__ void rwkv_prep2(const Ctx& C, int l, int b, int c) {
    LAS bf16* RS = (LAS bf16*)C.lds;
    LAS bf16* KS = RS + 64 * RP;
    LAS bf16* XW = KS + 64 * RP;
    LAS bf16* XA = XW + 64 * MP;
    LAS bf16* XG = XA + 64 * MP;
    const bf16* P = WSP(const bf16, WS_P);
    const bool isctx = c < 4; const int p0 = isctx ? c * 64 : (c - 4) * 64; const int Lp = isctx ? CTXL : SEQ; const int row0 = isctx ? T_LAT + b * CTXL : b * SEQ;
    const float* mu = C.in[I_RMU] + (size_t)l * 2 * B_COLS;
    bf16* rkv = WSP(bf16, WS_RKV);
#pragma unroll 2
    for (int it = C.tid; it < 64 * 120; it += NTHR) {
        const int t = it / 120, c8 = (it % 120) * 8, p = p0 + t;
        const bf16* pp = P + (size_t)(row0 + p) * PLD + OFF_B + c8;
        const v4u xc = *(const v4u*)pp; v4u xp = (v4u){0u, 0u, 0u, 0u}, xn = xp;
        if (p > 0) xp = *(const v4u*)(pp - PLD);
        if (p < Lp - 1) xn = *(const v4u*)(pp + PLD);
        const f32x4 m0a = *(const f32x4*)(mu + c8), m0b = *(const f32x4*)(mu + c8 + 4), m1a = *(const f32x4*)(mu + B_COLS + c8), m1b = *(const f32x4*)(mu + B_COLS + c8 + 4);
        const unsigned xcw[4] = {xc.x, xc.y, xc.z, xc.w}, xpw[4] = {xp.x, xp.y, xp.z, xp.w}, xnw[4] = {xn.x, xn.y, xn.z, xn.w};
        float sh[8];
#pragma unroll
        for (int e = 0; e < 4; ++e) {
            const float x0 = bflo(xcw[e]), x1 = bfhi(xcw[e]);
            const float mu0_0 = e < 2 ? m0a[2 * e] : m0b[2 * e - 4], mu0_1 = e < 2 ? m0a[2 * e + 1] : m0b[2 * e - 3], mu1_0 = e < 2 ? m1a[2 * e] : m1b[2 * e - 4], mu1_1 = e < 2 ? m1a[2 * e + 1] : m1b[2 * e - 3];
            sh[2 * e] = x0 + mu0_0 * (bflo(xpw[e]) - x0) + mu1_0 * (bflo(xnw[e]) - x0);
            sh[2 * e + 1] = x1 + mu0_1 * (bfhi(xpw[e]) - x1) + mu1_1 * (bfhi(xnw[e]) - x1);
        }
        if (c8 >= 768) {
            const int ci = c8 - 768;
            if (ci < 64) {
#pragma unroll
                for (int e = 0; e < 8; ++e) sh[e] = tanhf_(sh[e]); }
            else if (ci >= 128) {
#pragma unroll
                for (int e = 0; e < 8; ++e) sh[e] = sigmoidf_(sh[e]); }
        }
        v4u o; o.x = pk2(sh[0], sh[1]); o.y = pk2(sh[2], sh[3]); o.z = pk2(sh[4], sh[5]); o.w = pk2(sh[6], sh[7]);
        if (c8 < 768) {
            *(v4u*)(rkv + (size_t)(row0 + p) * 768 + c8) = o;
            if (c8 < 256) *(LAS v4u*)(RS + t * RP + c8) = o; else if (c8 < 512) *(LAS v4u*)(KS + t * RP + c8 - 256) = o;
        } else {
            const int ci = c8 - 768;
            LAS bf16* dst = ci < 64 ? XW + t * MP + ci : (ci < 128 ? XA + t * MP + ci - 64 : XG + t * MP + ci - 128);
            *(LAS v4u*)dst = o;
        }
    }
    __syncthreads();
    const int lane = C.lane, w = C.wave, l15 = lane & 15, q = lane >> 4, hd = w & 3, ntp = w >> 2;
    const bf16* wt = WSP(const bf16, WS_RWT);
    bf16* wa_out = WSP(bf16, WS_HB); bf16* g_out = WSP(bf16, WS_G); float* bonus = WSP(float, WS_BONUS); float* rinv = WSP(float, WS_RINV);
    const f32x4 z4 = (f32x4){0.f, 0.f, 0.f, 0.f};
#pragma unroll 1
    for (int n2 = 0; n2 < 2; ++n2) {
        const int nt = 2 * ntp + n2, tok = 16 * nt + l15; const size_t row = (size_t)(row0 + p0 + tok);
        const fragb xw0 = ld_frag16(XW + tok * MP + 8 * q), xw1 = ld_frag16(XW + tok * MP + 32 + 8 * q);
        const fragb xa0 = ld_frag16(XA + tok * MP + 8 * q), xa1 = ld_frag16(XA + tok * MP + 32 + 8 * q);
        const fragb xg0 = ld_frag16(XG + tok * MP + 8 * q), xg1 = ld_frag16(XG + tok * MP + 32 + 8 * q);
        float bsum = 0.f, ksum = 0.f;
#pragma unroll
        for (int mt = 0; mt < 4; ++mt) {
            const int chl = 16 * mt + l15, ch4 = hd * 64 + 16 * mt + 4 * q;
            const bf16* wrow = wt + (size_t)(hd * 64 + chl) * 32 + 8 * q;
            const f32x4 aw0 = mfma16(*(const fragb*)(wrow), xw0, z4), aw1 = mfma16(*(const fragb*)(wrow + 256 * 32), xw1, z4);
            const f32x4 aa0 = mfma16(*(const fragb*)(wrow + 2 * 256 * 32), xa0, z4), aa1 = mfma16(*(const fragb*)(wrow + 3 * 256 * 32), xa1, z4);
            const bf16* grow = wt + 4 * 256 * 32 + (size_t)(hd * 64 + chl) * 64 + 8 * q;
            f32x4 ag = mfma16(*(const fragb*)(grow), xg0, z4); ag = mfma16(*(const fragb*)(grow + 32), xg1, ag);
            const f32x4 w00 = *(const f32x4*)(C.in[I_RW0] + (l * 2 + 0) * GW + ch4), w01 = *(const f32x4*)(C.in[I_RW0] + (l * 2 + 1) * GW + ch4);
            const f32x4 a00 = *(const f32x4*)(C.in[I_RA0] + (l * 2 + 0) * GW + ch4), a01 = *(const f32x4*)(C.in[I_RA0] + (l * 2 + 1) * GW + ch4);
            const f32x4 k_a = *(const f32x4*)(C.in[I_RKA] + l * GW + ch4), r_k = *(const f32x4*)(C.in[I_RRK] + l * GW + ch4), k_k = *(const f32x4*)(C.in[I_RKK] + l * GW + ch4);
            f32x4 wv0, wv1, av0, av1;
#pragma unroll
            for (int r = 0; r < 4; ++r) {
                wv0[r] = __expf(-0.6065306597126334f * sigmoidf_(aw0[r] + w00[r])); wv1[r] = __expf(-0.6065306597126334f * sigmoidf_(aw1[r] + w01[r]));
                av0[r] = sigmoidf_(aa0[r] + a00[r]); av1[r] = sigmoidf_(aa1[r] + a01[r]);
            }
            st4bf(wa_out + row * 1024 + 0 * 256 + ch4, wv0); st4bf(wa_out + row * 1024 + 1 * 256 + ch4, wv1);
            st4bf(wa_out + row * 1024 + 2 * 256 + ch4, av0); st4bf(wa_out + row * 1024 + 3 * 256 + ch4, av1);
            st4bf(g_out + row * 256 + ch4, ag);
            const v2u rr_ = *(const LAS v2u*)(RS + tok * RP + ch4), kr_ = *(const LAS v2u*)(KS + tok * RP + ch4);
            const f32x4 rs = (f32x4){bflo(rr_.x), bfhi(rr_.x), bflo(rr_.y), bfhi(rr_.y)}, ks = (f32x4){bflo(kr_.x), bfhi(kr_.x), bflo(kr_.y), bfhi(kr_.y)};
#pragma unroll
            for (int r = 0; r < 4; ++r) {
                const float km = ks[r] * (1.0f + (av0[r] - 1.0f) * k_a[r]) + ks[r] * (1.0f + (av1[r] - 1.0f) * k_a[r]);
                bsum += rs[r] * r_k[r] * km; const float kk = ks[r] * k_k[r]; ksum += kk * kk;
            }
        }
        bsum += __shfl_xor(bsum, 16); bsum += __shfl_xor(bsum, 32); ksum += __shfl_xor(ksum, 16); ksum += __shfl_xor(ksum, 32);
        if (q == 0) { bonus[row * 4 + hd] = bsum; rinv[row * 4 + hd] = 1.0f / sqrtf(ksum + 1e-6f); }
    }
    __syncthreads();
}
__device__ __forceinline__ int fwd_row_r(int b, int c, int t) { return c < 4 ? (T_LAT + b * CTXL + c * 64 + t) : (b * SEQ + (c - 4) * 64 + t); }
__device__ __forceinline__ bf16* rw_blob_row(const Ctx& C, int d, int which, int b, int c, int h, int r) {
    const int row = fwd_row_r(b, c, r);
    if (which == 0) return WSP(bf16, WS_OUTB) + ((size_t)d * T_ALL + row) * 256 + h * 64;
    return WSP(bf16, WS_P) + (size_t)row * PLD + OFF_B + d * 256 + h * 64;
}
__device__ __forceinline__ void rwkv_solve_item(const Ctx& C, int l, int item) {
    const int lane = C.lane, w = C.wave, pw = w & 1, pi = w >> 1, l15 = lane & 15, q = lane >> 4;
    LAS unsigned char* B0 = C.lds + pi * 28672;
    LAS bf16* Kk = (LAS bf16*)B0; LAS bf16* Bh = Kk + 64 * MP; LAS bf16* Kh = Bh + 64 * MP;
    LAS float* Lm = (LAS float*)B0; LAS bf16* Lk16 = (LAS bf16*)(B0 + 17408);
    const bf16* WA = WSP(const bf16, WS_HB); const bf16* rkv = WSP(const bf16, WS_RKV); const float* rinv = WSP(const float, WS_RINV);
    constexpr int NIT = 2 * NB * NH * NCH;
    {
        const bool active = item < NIT; if (!active) item = NIT - 1;
        const int u = item >> 1, d = item & 1;
        const int c = u % NCH, h = (u / NCH) & 3, b = u / (NCH * NH);
        const float k_k = C.in[I_RKK][l * GW + h * 64 + lane], k_a = C.in[I_RKA][l * GW + h * 64 + lane];
        {
            const int n = d ? (c < 4 ? 3 - c : 71 - c) : c;
            const float ril = rinv[(size_t)seqrow_raster(n * 64 + lane, d, b) * 4 + h];
#pragma unroll
            for (int r = 0; r < 4; ++r) { const int idx2 = pw * 64 + lane + 128 * r, t = idx2 >> 3, part = idx2 & 7; const int row = seqrow_raster(n * 64 + t, d, b);
                *(LAS v4u*)(Kk + t * MP + 8 * part) = *(const v4u*)(WA + (size_t)row * 1024 + d * 256 + h * 64 + 8 * part);
                *(LAS v4u*)(Bh + t * MP + 8 * part) = *(const v4u*)(WA + (size_t)row * 1024 + (2 + d) * 256 + h * 64 + 8 * part);
                *(LAS v4u*)(Kh + t * MP + 8 * part) = *(const v4u*)(rkv + (size_t)row * 768 + 256 + h * 64 + 8 * part); }
            __syncthreads();
            float x[64];
            if (pw == 0) {
                float cc = 1.0f;
#pragma unroll
                for (int t = 0; t < 64; ++t) {
                    const float wv = bf2f(Kk[t * MP + lane]), av = bf2f(Bh[t * MP + lane]), ks = bf2f(Kh[t * MP + lane]);
                    const float kap = ks * k_k * __shfl(ril, t);
                    const float cprev = cc; cc *= wv; const float ic = 1.0f / cc;
                    x[t] = kap * cprev;
                    Kk[t * MP + lane] = (bf16)f2bf1(x[t]); Bh[t * MP + lane] = (bf16)f2bf1(kap * av * ic); Kh[t * MP + lane] = (bf16)f2bf1(ks * (1.0f + (av - 1.0f) * k_a) * ic);
                }
            }
            __syncthreads();
            f32x4 T[10];
            {
                const LAS bf16* Bsrc = pw ? Kh : Bh;
                int tix = 0;
#pragma unroll
                for (int it = 0; it < 4; ++it)
#pragma unroll
                    for (int jt = 0; jt <= it; ++jt, ++tix) {
                        f32x4 acc = (f32x4){0.f, 0.f, 0.f, 0.f};
#pragma unroll
                        for (int s = 0; s < 2; ++s) acc = mfma16(ld_frag16(Kk + (16 * it + l15) * MP + 32 * s + 8 * q), ld_frag16(Bsrc + (16 * jt + l15) * MP + 32 * s + 8 * q), acc);
#pragma unroll
                        for (int r = 0; r < 4; ++r) { const int i = 16 * it + 4 * q + r, j = 16 * jt + l15; T[tix][r] = (j < i) ? acc[r] : 0.f; }
                    }
            }
            __syncthreads();
            {
                int tix = 0;
#pragma unroll
                for (int it = 0; it < 4; ++it)
#pragma unroll
                    for (int jt = 0; jt <= it; ++jt, ++tix)
#pragma unroll
                        for (int r = 0; r < 4; ++r) { const int i = 16 * it + 4 * q + r, j = 16 * jt + l15;
                            if (pw == 0) Lm[i * LP + j] = T[tix][r]; else Lk16[i * MP + j] = (bf16)f2bf1(T[tix][r]); }
            }
            __syncthreads();
            if (pw) {
#pragma unroll
                for (int i = 0; i < 64; ++i) x[i] = (i > lane) ? bf2f(Lk16[i * MP + lane]) : 0.f;
            }
#pragma unroll
            for (int i = 0; i < 64; ++i) {
                float a0 = x[i], a1 = 0.f;
                int roff = i * LP; { const int dep = i < 24 ? i - 6 : (i < 40 ? i - 3 : i - 2); if (dep >= 0) asm volatile("" : "+v"(roff) : "v"(x[dep >= 0 ? dep : 0])); }
                const LAS float* lrow = Lm + roff;
#pragma unroll
                for (int j4 = 0; j4 < i; j4 += 4) { const f32x4 lv = *(const LAS f32x4*)(lrow + j4);
                    a0 -= lv.x * x[j4]; if (j4 + 1 < i) a1 -= lv.y * x[j4 + 1]; if (j4 + 2 < i) a0 -= lv.z * x[j4 + 2]; if (j4 + 3 < i) a1 -= lv.w * x[j4 + 3]; }
                x[i] = a0 + a1;
            }
            if (active) { bf16* dst = rw_blob_row(C, d, pw, b, c, h, lane);
#pragma unroll
                for (int g = 0; g < 8; ++g) { v4u o; o.x = pk2(x[8 * g], x[8 * g + 1]); o.y = pk2(x[8 * g + 2], x[8 * g + 3]); o.z = pk2(x[8 * g + 4], x[8 * g + 5]); o.w = pk2(x[8 * g + 6], x[8 * g + 7]);
                    *(v4u*)(dst + 8 * g) = o; } }
            __syncthreads();
        }
    }
}

template <bool DRY>
__device__ __forceinline__ void rwkv_chunked(const Ctx& C, int l, int idx) {
    const int d = idx >> 5, b = (idx >> 2) & 7, h = idx & 3, lane = C.lane, w = C.wave, l15 = lane & 15, q = lane >> 4;
    const int it = w & 3, vtp = w >> 2;
    constexpr int IMG = 64 * MP * 2;
    LAS unsigned char* L0 = C.lds;
    LAS bf16* Wi = (LAS bf16*)L0; LAS bf16* Ti = Wi + 64 * MP; LAS bf16* Rh = Ti + 64 * MP; LAS bf16* Kh = Rh + 64 * MP; LAS bf16* Bh = Kh + 64 * MP;
    LAS bf16* UT = (LAS bf16*)(L0 + 11 * IMG);
    LAS float* cLv = (LAS float*)(L0 + 14 * IMG);
    const bf16* WA = WSP(const bf16, WS_HB); const bf16* rkv = WSP(const bf16, WS_RKV); const float* rinv = WSP(const float, WS_RINV);
    bf16* outb = WSP(bf16, WS_OUTB) + (size_t)d * T_ALL * 256;
    const int tt = C.tid >> 3, part = C.tid & 7;
    for (int i = C.tid; i < 2 * IMG / 4; i += NTHR) ((LAS unsigned*)(L0 + 12 * IMG))[i] = 0u;
    float kkw[8], kaw[8];
#pragma unroll
    for (int e = 0; e < 8; ++e) { kkw[e] = C.in[I_RKK][l * GW + h * 64 + 8 * w + e]; kaw[e] = C.in[I_RKA][l * GW + h * 64 + 8 * w + e]; }
    v4u gr, gk, gv, gw, ga, gbw, gbt; float gri;
    auto gload = [&](int n) {
        const int c = d ? (n < 4 ? 3 - n : 71 - n) : n;
        const int row = seqrow_raster(n * 64 + lane, d, b);
        const bf16* pr = rkv + (size_t)row * 768 + h * 64 + 8 * w;
        gr = *(const v4u*)pr; gk = *(const v4u*)(pr + 256); gv = *(const v4u*)(pr + 512);
        gw = *(const v4u*)(WA + (size_t)row * 1024 + d * 256 + h * 64 + 8 * w); ga = *(const v4u*)(WA + (size_t)row * 1024 + (2 + d) * 256 + h * 64 + 8 * w);
        gri = rinv[(size_t)row * 4 + h];
        gbw = *(const v4u*)(rw_blob_row(C, d, 0, b, c, h, tt) + 8 * part); gbt = *(const v4u*)(rw_blob_row(C, d, 1, b, c, h, tt) + 8 * part);
    };
    auto images = [&](int bufi) {
        LAS bf16* VT = (LAS bf16*)(L0 + (5 + 3 * bufi) * IMG); LAS bf16* KcT = VT + 64 * MP; LAS bf16* BcT = KcT + 64 * MP;
        const unsigned rw_[4] = {gr.x, gr.y, gr.z, gr.w}, kw_[4] = {gk.x, gk.y, gk.z, gk.w}, vw_[4] = {gv.x, gv.y, gv.z, gv.w}, ww_[4] = {gw.x, gw.y, gw.z, gw.w}, aw_[4] = {ga.x, ga.y, ga.z, ga.w};
        float rh[8], kh[8], bh[8];
#pragma unroll
        for (int e = 0; e < 8; ++e) {
            const float rs = (e & 1) ? bfhi(rw_[e >> 1]) : bflo(rw_[e >> 1]), ks = (e & 1) ? bfhi(kw_[e >> 1]) : bflo(kw_[e >> 1]);
            const float wv = (e & 1) ? bfhi(ww_[e >> 1]) : bflo(ww_[e >> 1]), av = (e & 1) ? bfhi(aw_[e >> 1]) : bflo(aw_[e >> 1]);
            const float lw = __logf(wv);
            const float cum = wave_incl_sum(lw, lane);
            const float kap = ks * kkw[e] * gri, ktil = ks * (1.0f + (av - 1.0f) * kaw[e]);
            const float cf = __expf(cum), icf = __builtin_amdgcn_rcpf(cf), cfL = __shfl(cf, 63), dec = cfL * icf;
            rh[e] = rs * cf; kh[e] = ktil * icf; bh[e] = kap * av * icf;
            const unsigned short vraw = (e & 1) ? (unsigned short)(vw_[e >> 1] >> 16) : (unsigned short)(vw_[e >> 1] & 0xffffu);
            VT[(8 * w + e) * MP + lane] = vraw; KcT[(8 * w + e) * MP + lane] = (bf16)f2bf1(ktil * dec); BcT[(8 * w + e) * MP + lane] = (bf16)f2bf1(-(kap * av * dec));
            if (lane == 63) cLv[bufi * 64 + 8 * w + e] = cfL;
        }
        { v4u o; o.x = pk2(rh[0], rh[1]); o.y = pk2(rh[2], rh[3]); o.z = pk2(rh[4], rh[5]); o.w = pk2(rh[6], rh[7]); *(LAS v4u*)(Rh + lane * MP + 8 * w) = o; }
        { v4u o; o.x = pk2(kh[0], kh[1]); o.y = pk2(kh[2], kh[3]); o.z = pk2(kh[4], kh[5]); o.w = pk2(kh[6], kh[7]); *(LAS v4u*)(Kh + lane * MP + 8 * w) = o; }
        { v4u o; o.x = pk2(bh[0], bh[1]); o.y = pk2(bh[2], bh[3]); o.z = pk2(bh[4], bh[5]); o.w = pk2(bh[6], bh[7]); *(LAS v4u*)(Bh + lane * MP + 8 * w) = o; }
        const unsigned bw_[4] = {gbw.x, gbw.y, gbw.z, gbw.w}, bt_[4] = {gbt.x, gbt.y, gbt.z, gbt.w};
#pragma unroll
        for (int e = 0; e < 4; ++e) {
            Wi[(8 * part + 2 * e) * MP + tt] = (bf16)(bw_[e] & 0xffffu); Wi[(8 * part + 2 * e + 1) * MP + tt] = (bf16)(bw_[e] >> 16);
            Ti[(8 * part + 2 * e) * MP + tt] = (bf16)(bt_[e] & 0xffffu); Ti[(8 * part + 2 * e + 1) * MP + tt] = (bf16)(bt_[e] >> 16);
        }
    };
    f32x4 Zst[2]; Zst[0] = Zst[1] = (f32x4){0.f, 0.f, 0.f, 0.f};
    const f32x4 z4 = (f32x4){0.f, 0.f, 0.f, 0.f};
    gload(0); images(0); gload(1);
#pragma unroll 1
    for (int n = 0; n < NCH; ++n) {
        RAW_BARRIER();
        const LAS bf16* VT = (const LAS bf16*)(L0 + (5 + 3 * (n & 1)) * IMG); const LAS bf16* KcT = VT + 64 * MP; const LAS bf16* BcT = KcT + 64 * MP;
        const LAS bf16* Zi = (const LAS bf16*)(L0 + (12 + (n & 1)) * IMG); LAS bf16* Zn = (LAS bf16*)(L0 + (12 + ((n + 1) & 1)) * IMG);
        const int arow = (16 * it + l15) * MP + 8 * q;
        const fragb Wf0 = ld_frag16(Wi + arow), Wf1 = ld_frag16(Wi + arow + 32), Tf0 = ld_frag16(Ti + arow), Tf1 = ld_frag16(Ti + arow + 32), Rf0 = ld_frag16(Rh + arow), Rf1 = ld_frag16(Rh + arow + 32);
        const int icol = 16 * it + l15;
        f32x4 pk[4], pb[4];
#pragma unroll
        for (int jt = 0; jt < 4; ++jt) {
            pk[jt] = z4; pb[jt] = z4;
            if (jt <= it) {
                const int jrow = (16 * jt + l15) * MP + 8 * q;
                f32x4 sk = mfma16(ld_frag16(Kh + jrow), Rf0, z4); sk = mfma16(ld_frag16(Kh + jrow + 32), Rf1, sk);
                f32x4 sb = mfma16(ld_frag16(Bh + jrow), Rf0, z4); sb = mfma16(ld_frag16(Bh + jrow + 32), Rf1, sb);
#pragma unroll
                for (int r = 0; r < 4; ++r) { const int j = 16 * jt + 4 * q + r; pk[jt][r] = (j <= icol) ? sk[r] : 0.f; pb[jt][r] = (j <= icol) ? -sb[r] : 0.f; }
            }
        }
        fragb Pk0 = pack_frag(pk[0], pk[1]), Pk1 = pack_frag(pk[2], pk[3]), Pb0 = pack_frag(pb[0], pb[1]), Pb1 = pack_frag(pb[2], pb[3]);
        f32x4 RZ[2];
#pragma unroll
        for (int v2 = 0; v2 < 2; ++v2) {
            const int vrow = 16 * (2 * vtp + v2) + l15;
            const fragb z0 = ld_frag16(Zi + vrow * MP + 8 * q), z1 = ld_frag16(Zi + vrow * MP + 32 + 8 * q);
            f32x4 u = mfma16(Wf0, z0, z4); u = mfma16(Wf1, z1, u);
            u = mfma16(Tf0, ld_frag16(VT + vrow * MP + 8 * q), u); if (it >= 2) u = mfma16(Tf1, ld_frag16(VT + vrow * MP + 32 + 8 * q), u);
            RZ[v2] = mfma16(Rf0, z0, z4); RZ[v2] = mfma16(Rf1, z1, RZ[v2]);
            v2u o; o.x = pk2(u.x, u.y); o.y = pk2(u.z, u.w);
            *(LAS v2u*)(UT + vrow * MP + 16 * it + 4 * q) = o;
        }
        RAW_BARRIER();
        {
            const f32x4 cl4 = *(const LAS f32x4*)(cLv + (n & 1) * 64 + 16 * it + 4 * q);
            const LAS bf16* kr = KcT + (16 * it + l15) * MP + 4 * q; const LAS bf16* br = BcT + (16 * it + l15) * MP + 4 * q;
            const fragb kc0 = ld_frag8x2(kr, kr + 16), kc1 = ld_frag8x2(kr + 32, kr + 48), bc0 = ld_frag8x2(br, br + 16), bc1 = ld_frag8x2(br + 32, br + 48);
#pragma unroll
            for (int v2 = 0; v2 < 2; ++v2) {
                const int vrow = 16 * (2 * vtp + v2) + l15;
                const LAS bf16* vr = VT + vrow * MP + 4 * q; const LAS bf16* ur = UT + vrow * MP + 4 * q;
                const fragb vp0 = ld_frag8x2(vr, vr + 16), vp1 = ld_frag8x2(vr + 32, vr + 48), up0 = ld_frag8x2(ur, ur + 16), up1 = ld_frag8x2(ur + 32, ur + 48);
                f32x4 y = mfma16(Pk0, vp0, RZ[v2]); y = mfma16(Pb0, up0, y);
                if (it >= 2) { y = mfma16(Pk1, vp1, y); y = mfma16(Pb1, up1, y); }
#pragma unroll
                for (int r = 0; r < 4; ++r) { const int row = seqrow_raster(n * 64 + 16 * it + 4 * q + r, d, b); if (!DRY) outb[(size_t)row * 256 + h * 64 + vrow] = (bf16)f2bf1(y[r]); }
                f32x4 zn = mfma16(kc0, vp0, z4); zn = mfma16(kc1, vp1, zn); zn = mfma16(bc0, up0, zn); zn = mfma16(bc1, up1, zn);
                Zst[v2] = Zst[v2] * cl4 + zn;
                v2u so; so.x = pk2(Zst[v2].x, Zst[v2].y); so.y = pk2(Zst[v2].z, Zst[v2].w);
                *(LAS v2u*)(Zn + vrow * MP + 16 * it + 4 * q) = so;
            }
        }
        if (n + 1 < NCH) { images((n + 1) & 1); if (n + 2 < NCH) gload(n + 2); }
    }
    __syncthreads();
}
__device__ __forceinline__ void moe_scatter(const Ctx& C, int moe_li, int nrows) {
    const unsigned* gc = WSP(const unsigned, WS_CTL) + CW_MOECNT + 64 * moe_li;
    LAS int* pst = (LAS int*)C.lds;
    {
        int pe[8]; int acc = 0;
#pragma unroll
        for (int e = 0; e < NE; ++e) { const int blks = ((int)gc[e] + 255) >> 8; if (C.tid == e) pst[e] = acc * 256; acc += blks; pe[e] = acc; }
        if (C.wg == 0 && C.tid < MOE_MAXBLK) { int be = 0;
#pragma unroll
            for (int e = 0; e < NE; ++e) be += (pe[e] <= C.tid) ? 1 : 0;
            int* tab = WSP(int, WS_TAB); tab[1 + C.tid] = be < NE ? be : NE - 1; if (C.tid == 0) tab[0] = acc; }
    }
    __syncthreads();
    const unsigned* route = WSP(const unsigned, WS_ROUTE); const unsigned* wgbase = WSP(const unsigned, WS_WGBASE);
    const bf16* hb = WSP(const bf16, WS_HB); bf16* am = WSP(bf16, WS_MIX); int* pos = WSP(int, WS_POS);
    const int gw = C.wg * NWAVES + C.wave, NGW = C.G * NWAVES;
    for (int m = gw; m < nrows; m += NGW) {
        const v4u a = *(const v4u*)(route + (size_t)m * 8);
        const int e0 = (int)a.x, e1 = (int)a.y;
        const int p0 = pst[e0] + (int)wgbase[C.wg * 8 + e0] + (int)a.z, p1 = pst[e1] + (int)wgbase[C.wg * 8 + e1] + (int)a.w;
        const v4u r0 = *(const v4u*)(hb + (size_t)m * 1024 + C.lane * 8), r1 = *(const v4u*)(hb + (size_t)m * 1024 + 512 + C.lane * 8);
        *(v4u*)(am + (size_t)p0 * 1024 + C.lane * 8) = r0; *(v4u*)(am + (size_t)p0 * 1024 + 512 + C.lane * 8) = r1;
        *(v4u*)(am + (size_t)p1 * 1024 + C.lane * 8) = r0; *(v4u*)(am + (size_t)p1 * 1024 + 512 + C.lane * 8) = r1;
        if (C.lane == 0) { pos[(size_t)m * 2] = p0; pos[(size_t)m * 2 + 1] = p1; }
    }
    __syncthreads();
}
__device__ __forceinline__ void moe_combine(const Ctx& C, int l, int nrows) {
    const unsigned* route = WSP(const unsigned, WS_ROUTE); const int* pos = WSP(const int, WS_POS); const bf16* ym = WSP(const bf16, WS_MIX);
    const float* modv = WSP(const float, WS_MODV) + (size_t)l * 9 * 6144 + 5 * 1024;
    float* xc = WSP(float, WS_XC);
    const int gw = C.wg * NWAVES + C.wave, NGW = C.G * NWAVES;
    for (int m = gw; m < nrows; m += NGW) {
        const bool isctx = m >= T_LAT;
        float* xr = isctx ? xc + (size_t)(m - T_LAT) * 1024 : C.out + (size_t)m * 1024;
        const float* gv = modv + (size_t)(isctx ? 8 : (m >> 12)) * 6144;
        const int p0 = pos[(size_t)m * 2], p1 = pos[(size_t)m * 2 + 1];
        const float w0 = __builtin_bit_cast(float, route[(size_t)m * 8 + 4]), w1 = __builtin_bit_cast(float, route[(size_t)m * 8 + 5]);
#pragma unroll
        for (int j = 0; j < 4; ++j) {
            const int col = 4 * C.lane + 256 * j;
            const v2u a = *(const v2u*)(ym + (size_t)p0 * 1024 + col), b = *(const v2u*)(ym + (size_t)p1 * 1024 + col);
            const f32x4 ya = (f32x4){bflo(a.x), bfhi(a.x), bflo(a.y), bfhi(a.y)}, yb = (f32x4){bflo(b.x), bfhi(b.x), bflo(b.y), bfhi(b.y)};
            const f32x4 g = *(const f32x4*)(gv + col); f32x4 x = *(const f32x4*)(xr + col);
            x = x + g * (ya * w0 + yb * w1);
            *(f32x4*)(xr + col) = x;
        }
    }
}
__device__ __forceinline__ void final_norm(const Ctx& C) {
    const int gw = C.wg * NWAVES + C.wave, NGW = C.G * NWAVES;
    f32x4 gv[4];
#pragma unroll
    for (int j = 0; j < 4; ++j) gv[j] = *(const f32x4*)(C.in[I_FNG] + 4 * C.lane + 256 * j);
    for (int m = gw; m < T_LAT; m += NGW) {
        float* xr = C.out + (size_t)m * 1024;
        f32x4 v[4]; float s = 0.f;
#pragma unroll
        for (int j = 0; j < 4; ++j) { v[j] = *(const f32x4*)(xr + 4 * C.lane + 256 * j); s += (v[j].x * v[j].x + v[j].y * v[j].y) + (v[j].z * v[j].z + v[j].w * v[j].w); }
        const float rs = 1.0f / sqrtf(wave_sum(s) * (1.0f / 1024.0f) + 1e-6f);
#pragma unroll
        for (int j = 0; j < 4; ++j) *(f32x4*)(xr + 4 * C.lane + 256 * j) = v[j] * rs * gv[j];
    }
}

constexpr int NPH_L = 12, PH_FINAL = 1 + DEPTH * NPH_L, NPHASE = PH_FINAL + 1;
__host__ __device__ inline bool phase_exists(int ph) {
    if (ph == 0 || ph == PH_FINAL) return true;
    const int l = (ph - 1) / NPH_L, k = (ph - 1) % NPH_L;
    if (!(l & 1) && k >= 10) return false;
    return true;
}
#ifndef PH_MASK
#define PH_MASK 0xFFFFFF
#endif
#define PM(k) ((PH_MASK >> (k)) & 1)
#ifndef SK_MASK
#define SK_MASK 0xFFFF
#endif
#define SK(k) ((SK_MASK >> (k)) & 1)
#ifndef REP_MASK
#define REP_MASK 0
#endif
#define NREP(k) (((REP_MASK >> (k)) & 1) ? 2 : 1)

__global__ void __launch_bounds__(NTHR, 2) fwd_kernel(Args args) {
    extern __shared__ __attribute__((aligned(16))) unsigned char lds_raw[];
    Ctx C; C.in = args.in; C.out = args.out; C.ws = args.ws; C.lds = (LAS unsigned char*)lds_raw;
    C.tid = threadIdx.x; C.lane = C.tid & 63; C.wave = __builtin_amdgcn_readfirstlane(C.tid >> 6); C.G = gridDim.x; C.wg = blockIdx.x;
    volatile LAS unsigned* MISC = (volatile LAS unsigned*)(C.lds + MISC_OFF);
    if (C.tid < 64) MISC[C.tid] = 0u;
    __syncthreads();
    const int lo = args.ph_lo, hi = args.ph_hi;
    const bool multi = (hi - lo) > 1;
    if (multi) (void)xcd_barrier_post(WSP(unsigned, WS_CTL) + CW_BAR, MISC + 8);
#define IN(k) (lo <= (k) && (k) < hi)
#define SEAM(k) do { if (IN((k) + 1)) { XcdBarrier b2_; b2_.bar = WSP(unsigned, WS_CTL) + CW_BAR; b2_.x = xb_xcc_id(); b2_.st = (volatile LAS unsigned*)(C.lds + MISC_OFF) + 8; xcd_barrier(b2_); } } while (0)
#define FRESH() do { int t_ = threadIdx.x; asm volatile("" : "+v"(t_)); C.tid = t_; C.lane = t_ & 63; C.wave = __builtin_amdgcn_readfirstlane(t_ >> 6); } while (0)
#define PHASE(bit, k) if (PM(bit) && IN(pb + (k))) for (int rep_ = 0; rep_ < NREP(bit); ++rep_)

    if (PM(20) && IN(0)) { phase_pre(C); SEAM(0); }

#pragma unroll 1
    for (int l = 0; l < DEPTH; ++l) {
        const int pb = 1 + l * NPH_L;
        if (hi <= pb || lo >= pb + NPH_L) continue;
        const bool last = (l == DEPTH - 1), moe = (l & 1);
        const int nrows = last ? T_LAT : T_ALL;
        const float* xlat = (l == 0) ? C.in[I_X] : C.out; const float* xctx = (l == 0) ? C.in[I_CTX] : WSP(const float, WS_XC);
        const float* modv = WSP(const float, WS_MODV) + (size_t)l * 9 * 6144;

        PHASE(0, 0) { FRESH();
            convert_small(C, l);
            if (l == 0) { FRESH(); convert_items(C, 0, 3, C.wg * NWAVES + C.wave, C.G * NWAVES); }
            __syncthreads();
            FRESH(); norm_rows<false>(C, l, xlat, xctx, C.in[I_NMIXG] + l * 1024, 0, 1024, T_ALL, 0);
            SEAM(pb + 0);
        }
        PHASE(1, 1) { FRESH();
            pg8::Gemm g{WSP(const bf16, WS_HB), WSP(const bf16, WS_WIN), T_ALL, PLD, 1024, 0};
            pg8::StaticOrder S; S.init(T_ALL, PLD, C.G, C.wg);
            pg8::EpiBf16<0> E{WSP(bf16, WS_P), PLD, nullptr, 0, 0};
            pg8::gemm_phase<pg8::EpiBf16<0>, pg8::StaticOrder, false>(C.lds, g, S, E, nullptr);
            SEAM(pb + 1);
        }
        PHASE(2, 2) { FRESH();
            unsigned* qh = WSP(unsigned, WS_CTL) + CW_PREPQ + 64 * l; LAS unsigned* slot = (LAS unsigned*)(C.lds + MISC_OFF + 128);
            for (;;) {
                __syncthreads();
                if (C.tid == 0) *slot = atomicAdd(qh, 1u);
                __syncthreads();
                const int k = (int)*slot;
                if (k >= 3 * NB * NCH) break;
                const int kind = k / (NB * NCH), u = k % (NB * NCH);
                FRESH();
                if (kind == 0) { if (SK(1)) rwkv_prep2(C, l, u / NCH, u % NCH); }
                else if (kind == 1) { if (SK(0)) lru_chunk_mfma<false>(C, l, u / NCH, u % NCH); }
                else { if (SK(2)) gdn_prep(C, l, u / NCH, u % NCH); }
            }
            SEAM(pb + 2);
        }
        if (PM(3) && IN(pb + 3)) { FRESH();
            unsigned* qh = WSP(unsigned, WS_CTL) + CW_SOLVEQ + 64 * l; LAS unsigned* slot = (LAS unsigned*)(C.lds + MISC_OFF + 128);
            constexpr int NCL = 2 * NB * NH * NCH / 4;
            for (;;) {
                __syncthreads();
                if (C.tid == 0) *slot = atomicAdd(qh, 1u);
                __syncthreads();
                const int k = (int)*slot;
                if (k >= 2 * NCL) break;
                FRESH();
                if (k < NCL) { if (SK(9)) gdn_solve_item(C, l, 4 * k + (C.wave >> 1)); }
                else { if (SK(10)) rwkv_solve_item(C, l, 4 * (k - NCL) + (C.wave >> 1)); }
            }
            FRESH(); if (SK(6) && C.wg < 8) lru_carry(C, C.wg * NTHR + C.tid);
            SEAM(pb + 3);
        }
        if (PM(4) && IN(pb + 4)) { FRESH();
            if (SK(3) && C.wg < 64) { FRESH(); rwkv_chunked<false>(C, l, C.wg); }
            else if (SK(4) && C.wg >= 128 && C.wg < 192) { FRESH(); mlstm_chunked(C, l, C.wg - 128); }
            else if (SK(5) && C.wg >= 192) { FRESH(); gdn_chunked<false>(C, l, C.wg - 192); }
            else if (C.wg >= 64 && C.wg < 128) {
                FRESH(); if (l > 0) convert_items(C, l, 2, (C.wg - 64) * NWAVES + C.wave, 64 * NWAVES);
                if (l + 1 < DEPTH) { FRESH(); convert_items(C, l + 1, 1, (C.wg - 64) * NWAVES + C.wave, 64 * NWAVES); }
            }
            if (C.wg >= 64) {
                FRESH();
                unsigned* qh = WSP(unsigned, WS_CTL) + CW_LRUQ + 64 * l; LAS unsigned* slot = (LAS unsigned*)(C.lds + MISC_OFF + 128);
                const int nun = last ? NB * 64 : NB * NCH;
                for (;;) {
                    __syncthreads();
                    if (C.tid == 0) *slot = atomicAdd(qh, 1u);
                    __syncthreads();
                    const int u = (int)*slot;
                    if (u >= nun) break;
                    const int b = last ? (u >> 6) : (u / NCH), c = last ? 4 + (u & 63) : (u % NCH);
                    if (SK(7)) lru_chunk_mfma<true>(C, l, b, c);
                }
            }
            SEAM(pb + 4);
        }
        PHASE(5, 5) { FRESH();
            if (SK(8)) finish_rows(C, l, nrows);
            SEAM(pb + 5);
        }
        if (PM(6) && IN(pb + 6)) { FRESH();
            pg8::Gemm g{WSP(const bf16, WS_HB), WSP(const bf16, WS_WOUT), nrows, 1024, 1024, 0};
            pg8::StaticOrder S; S.init(nrows, 1024, C.G, C.wg);
            pg8::EpiRes E{xlat, xctx, C.out, WSP(float, WS_XC), modv + 2 * 1024};
            pg8::gemm_phase<pg8::EpiRes, pg8::StaticOrder, false>(C.lds, g, S, E, nullptr);
            SEAM(pb + 6);
        }
        if (PM(7) && IN(pb + 7)) { FRESH();
            if (moe) norm_rows<true>(C, l, C.out, WSP(const float, WS_XC), C.in[I_NFFNG] + l * 1024, 3 * 1024, 4 * 1024, nrows, l >> 1);
            else norm_rows<false>(C, l, C.out, WSP(const float, WS_XC), C.in[I_NFFNG] + l * 1024, 3 * 1024, 4 * 1024, nrows, 0);
            SEAM(pb + 7);
        }
        if (!moe) {
            if (PM(8) && IN(pb + 8)) { FRESH();
                pg8::Gemm g{WSP(const bf16, WS_HB), WSP(const bf16, WS_WGU), nrows, 2 * DFF, 1024, 0};
                pg8::StaticOrder S; S.init(nrows, 2 * DFF, C.G, C.wg);
                pg8::EpiSwiglu E{WSP(bf16, WS_P), DFF};
                pg8::gemm_phase<pg8::EpiSwiglu, pg8::StaticOrder, false>(C.lds, g, S, E, nullptr);
                SEAM(pb + 8);
            }
            if (PM(9) && IN(pb + 9)) { FRESH();
                pg8::Gemm g{WSP(const bf16, WS_P), WSP(const bf16, WS_WDN), nrows, 1024, DFF, 0};
                pg8::StaticOrder S; S.init(nrows, 1024, C.G, C.wg);
                pg8::EpiRes E{C.out, WSP(const float, WS_XC), C.out, WSP(float, WS_XC), modv + 5 * 1024};
                pg8::gemm_phase<pg8::EpiRes, pg8::StaticOrder, false>(C.lds, g, S, E, nullptr);
                SEAM(pb + 11);
            }
        } else {
            if (PM(10) && IN(pb + 8)) { FRESH(); moe_scatter(C, l >> 1, nrows); SEAM(pb + 8); }
            if (PM(11) && IN(pb + 9)) { FRESH();
                pg8::Gemm g{WSP(const bf16, WS_MIX), WSP(const bf16, WS_WGU), 0, 2 * DFE, 1024, (size_t)2 * DFE * 1024};
                pg8::MoeOrder S; S.init(WSP(const int, WS_TAB), (2 * DFE) / 256, C.G, C.wg);
                pg8::EpiSwiglu E{WSP(bf16, WS_P), DFE};
                pg8::gemm_phase<pg8::EpiSwiglu, pg8::MoeOrder, false>(C.lds, g, S, E, nullptr);
                SEAM(pb + 9);
            }
            if (PM(12) && IN(pb + 10)) { FRESH();
                pg8::Gemm g{WSP(const bf16, WS_P), WSP(const bf16, WS_WDN), 0, 1024, DFE, (size_t)1024 * DFE};
                pg8::MoeOrder S; S.init(WSP(const int, WS_TAB), 4, C.G, C.wg);
                pg8::EpiBf16<0> E{WSP(bf16, WS_MIX), 1024, nullptr, 0, 0};
                pg8::gemm_phase<pg8::EpiBf16<0>, pg8::MoeOrder, false>(C.lds, g, S, E, nullptr);
                SEAM(pb + 10);
            }
            if (PM(13) && IN(pb + 11)) { FRESH(); moe_combine(C, l, nrows); SEAM(pb + 11); }
        }
    }
    if (PM(21) && IN(PH_FINAL)) final_norm(C);
}

extern "C" void kernel_launch(void* const* d_in, const int* in_sizes, int n_in, void* d_out, int out_size, void* d_ws, size_t ws_size, hipStream_t stream) {
    static int grid = 0;
    if (grid == 0) {
        if (n_in != N_IN || in_sizes[0] != T_LAT * DM || out_size != T_LAT * DM || ws_size < WS_END) {
            fprintf(stderr, "kernel_launch: unexpected problem (n_in %d, in0 %d, out %d, ws %zu < %zu)\n", n_in, n_in > 0 ? in_sizes[0] : -1, out_size, ws_size, (size_t)WS_END); grid = -1; return; }
        int dev = 0, cus = 0, per_cu = 0;
        if (hipGetDevice(&dev) != hipSuccess || hipDeviceGetAttribute(&cus, hipDeviceAttributeMultiprocessorCount, dev) != hipSuccess) { grid = -1; return; }
        if (hipFuncSetAttribute((const void*)fwd_kernel, hipFuncAttributeMaxDynamicSharedMemorySize, LDS_BYTES) != hipSuccess) { fprintf(stderr, "kernel_launch: hipFuncSetAttribute failed\n"); grid = -1; return; }
        if (hipOccupancyMaxActiveBlocksPerMultiprocessor(&per_cu, (const void*)fwd_kernel, NTHR, LDS_BYTES) != hipSuccess || per_cu < 1) { fprintf(stderr, "kernel_launch: occupancy query says %d\n", per_cu); grid = -1; return; }
        grid = cus;
        if (grid != 256) fprintf(stderr, "kernel_launch: note: %d CUs\n", grid);
    }
    if (grid < 0) return;
    if (hipMemsetAsync((char*)d_ws + WS_CTL, 0, CTL_BYTES, stream) != hipSuccess) return;
    Args a{};
    for (int i = 0; i < N_IN; ++i) a.in[i] = (const float*)d_in[i];
    a.out = (float*)d_out; a.ws = (unsigned char*)d_ws;
#if MK_ONE_LAUNCH
    a.ph_lo = 0; a.ph_hi = NPHASE;
    hipLaunchKernelGGL(fwd_kernel, dim3(grid), dim3(NTHR), LDS_BYTES, stream, a);
#else
    for (int ph = 0; ph < NPHASE; ++ph) { if (!phase_exists(ph)) continue; a.ph_lo = ph; a.ph_hi = ph + 1; hipLaunchKernelGGL(fwd_kernel, dim3(grid), dim3(NTHR), LDS_BYTES, stream, a); }
#endif
}
```

```cpp
#define MK_ONE_LAUNCH 1
#include <hip/hip_runtime.h>
#include <cstdio>
#include <cstdint>

#define GAS __attribute__((address_space(1)))
#define LAS __attribute__((address_space(3)))
typedef unsigned short bf16;
typedef unsigned v4u __attribute__((ext_vector_type(4)));
typedef unsigned v2u __attribute__((ext_vector_type(2)));
typedef float f32x4 __attribute__((ext_vector_type(4)));
typedef float f32x2 __attribute__((ext_vector_type(2)));
typedef short bf16x8 __attribute__((ext_vector_type(8)));
#define LDS_WAIT() asm volatile("s_waitcnt lgkmcnt(0)" ::: "memory")
#define VM_WAIT() asm volatile("s_waitcnt vmcnt(0)" ::: "memory")

constexpr int DM = 1024, NB = 8, SEQ = 4096, DEPTH = 4, CTXL = 256, GW = 256, HD = 64, NH = 4;
constexpr int T_LAT = NB * SEQ, T_CTX = NB * CTXL, T_ALL = T_LAT + T_CTX;
constexpr int IN_COLS = 3552, PLD = 3584;
constexpr int OFF_B = 512, OFF_C = 1472, OFF_D = 2512, B_COLS = 960;
constexpr int DFF = 2816, NE = 8, DFE = 1408;
constexpr int NCH = 68;
constexpr int NSTEP = 4352;
constexpr int MOE_MAXBLK = 280;
constexpr int NWAVES = 8, NTHR = 512;
#ifndef RW_VSPLIT
#define RW_VSPLIT 0
#endif

constexpr size_t MiB = 1u << 20;
constexpr size_t WS_CTL = 0, CTL_BYTES = 1 * MiB;
constexpr size_t WS_MODV = 1 * MiB;
constexpr size_t WS_XC = 2 * MiB;
constexpr size_t WS_WIN = 10 * MiB;
constexpr size_t WS_WOUT = 17 * MiB;
constexpr size_t WS_WGU = 19 * MiB;
constexpr size_t WS_WDN = 63 * MiB;
constexpr size_t WS_HB = 85 * MiB;
constexpr size_t WS_P = 153 * MiB;
constexpr size_t WS_MIX = 391 * MiB;
constexpr size_t WS_OUTB = WS_MIX, WS_OUTC = WS_MIX + 34 * MiB, WS_OUTD = WS_MIX + 68 * MiB, WS_GQ = WS_MIX + 102 * MiB, WS_G = WS_MIX + 153 * MiB;
constexpr size_t WS_RKV = WS_MIX + 170 * MiB;
constexpr size_t WS_SMALL = 612 * MiB;
constexpr size_t WS_LSUM = WS_SMALL;
constexpr size_t WS_HIN = WS_SMALL + 3 * MiB;
constexpr size_t WS_ROUTE = WS_SMALL + 5 * MiB;
constexpr size_t WS_POS = WS_SMALL + 7 * MiB;
constexpr size_t WS_BONUS = WS_SMALL + 8 * MiB;
constexpr size_t WS_WGBASE = WS_SMALL + 9 * MiB;
constexpr size_t WS_TAB = WS_WGBASE + 65536;
constexpr size_t WS_LRUWT = WS_SMALL + 10 * MiB;
constexpr size_t WS_RWT = WS_LRUWT + 131072;
constexpr size_t WS_RINV = WS_SMALL + 11 * MiB;
constexpr size_t WS_END = 624 * MiB;
constexpr int CW_MOECNT = 1024;
constexpr int CW_PREPQ = 2048;
constexpr int CW_BAR = 4096;

constexpr int LDS_BYTES = 135168;
constexpr int MISC_OFF = 131072;

__device__ __forceinline__ unsigned f2bf(float f) { unsigned u = __builtin_bit_cast(unsigned, f); return (u + 0x7fffu + ((u >> 16) & 1u)) >> 16; }
typedef __bf16 bf16n2 __attribute__((ext_vector_type(2)));
__device__ __forceinline__ unsigned pk2(float lo, float hi) { const f32x2 v = {lo, hi}; return __builtin_bit_cast(unsigned, __builtin_convertvector(v, bf16n2)); }
__device__ __forceinline__ unsigned f2bf1(float f) { return pk2(f, f) & 0xffffu; }
__device__ __forceinline__ float bf2f(unsigned short v) { return __builtin_bit_cast(float, (unsigned)v << 16); }
__device__ __forceinline__ float bflo(unsigned v) { return __builtin_bit_cast(float, v << 16); }
__device__ __forceinline__ float bfhi(unsigned v) { return __builtin_bit_cast(float, v & 0xffff0000u); }
__device__ __forceinline__ float wave_sum(float v) {
#pragma unroll
    for (int o = 1; o < 64; o <<= 1) v += __shfl_xor(v, o);
    return v;
}
template <int CTRL> __device__ __forceinline__ float dpp_f(float v) { return __builtin_bit_cast(float, __builtin_amdgcn_update_dpp(0, __builtin_bit_cast(int, v), CTRL, 0xF, 0xF, true)); }
__device__ __forceinline__ float row16_sum(float v) {
    v += dpp_f<0xB1>(v);
    v += dpp_f<0x4E>(v);
    v += dpp_f<0x141>(v);
    v += dpp_f<0x140>(v);
    return v;
}
__device__ __forceinline__ float sigmoidf_(float x) { return 1.0f / (1.0f + __expf(-x)); }
__device__ __forceinline__ float softplusf_(float x) { return fmaxf(x, 0.f) + __logf(1.0f + __expf(-fabsf(x))); }
__device__ __forceinline__ float expm1f_(float x) { return x > -0.3f ? x * (1.0f + x * (0.5f + x * (0.16666667f + x * (0.041666668f + x * 0.0083333338f)))) : __expf(x) - 1.0f; }
__device__ __forceinline__ float siluf_(float x) { return x / (1.0f + __expf(-x)); }
__device__ __forceinline__ float tanhf_(float x) { const float e = __expf(2.0f * x); return 1.0f - 2.0f / (e + 1.0f); }
__device__ __forceinline__ float gelu_tanh(float x) { return 0.5f * x * (1.0f + tanhf_(0.7978845608028654f * (x + 0.044715f * x * x * x))); }
__device__ __forceinline__ f32x4 ld4bf(const bf16* p) { const v2u a = *(const v2u*)p; return (f32x4){bflo(a.x), bfhi(a.x), bflo(a.y), bfhi(a.y)}; }
__device__ __forceinline__ void st4bf(bf16* p, const f32x4& v) { v2u o; o.x = pk2(v.x, v.y); o.y = pk2(v.z, v.w); *(v2u*)p = o; }
#define XB_TMO      128
#define XB_XCNT(j)  (256  + 64 * (j))
#define XB_XSUB(j)  (1280 + 64 * (j))
#define XB_XGEN(j)  (2304 + 64 * (j))
#define XB_TOP      3328
#define XB_TOPGEN   3392
#define XCD_BAR_WORDS 3456
#define XB_SPIN_CAP (1u << 22)

__device__ __forceinline__ unsigned xb_ld(unsigned* p)              { return __hip_atomic_load(p, __ATOMIC_RELAXED, __HIP_MEMORY_SCOPE_AGENT); }
__device__ __forceinline__ unsigned xb_add(unsigned* p, unsigned v) { return __hip_atomic_fetch_add(p, v, __ATOMIC_RELAXED, __HIP_MEMORY_SCOPE_AGENT); }
__device__ __forceinline__ unsigned xb_xcc_id() { return (unsigned)__builtin_amdgcn_s_getreg((3 << 11) | 20) & 0xFu; }
#define XB_SPIN(cond, bar) do { unsigned _sp = 0; while (cond) { __builtin_amdgcn_s_sleep(1); \
    if ((++_sp & 255u) == 0u) { if (xb_ld(&(bar)[XB_TMO])) break; if (_sp > XB_SPIN_CAP) { atomicAdd(&(bar)[XB_TMO], 1u); break; } } } } while (0)

struct XcdBarrier {
    unsigned* bar; unsigned x;
    volatile LAS unsigned* st;
};

__device__ __forceinline__ XcdBarrier xcd_barrier_post(unsigned* bar, volatile LAS unsigned* st) {
    XcdBarrier b; b.bar = bar; b.x = xb_xcc_id(); b.st = st;
    if (threadIdx.x == 0) (void)xb_add(&bar[XB_XCNT(b.x)], 1u);
    return b;
}
__device__ __forceinline__ void xcd_barrier_complete(unsigned* bar, unsigned x, unsigned& nloc, unsigned& nx) {
    const unsigned G = gridDim.x * gridDim.y * gridDim.z;
    unsigned sum, cnt, mine, sp = 0u;
    for (;;) {
        sum = 0u; cnt = 0u; mine = 0u;
#pragma unroll
        for (unsigned j = 0; j < 16; ++j) { const unsigned c = xb_ld(&bar[XB_XCNT(j)]); sum += c; cnt += (c > 0u) ? 1u : 0u; mine = (j == x) ? c : mine; }
        if (sum == G) break;
        __builtin_amdgcn_s_sleep(1);
        if ((++sp & 255u) == 0u) { if (xb_ld(&bar[XB_TMO])) break; if (sp > XB_SPIN_CAP) { atomicAdd(&bar[XB_TMO], 1u); break; } }
    }
    nloc = mine > 0u ? mine : 1u; nx = cnt > 0u ? cnt : 1u;
}

__device__ __forceinline__ void xcd_barrier(const XcdBarrier& b) {
    asm volatile("s_waitcnt vmcnt(0)" ::: "memory");
    __syncthreads();
    if (threadIdx.x == 0) {
        unsigned* bar = b.bar;
        __builtin_amdgcn_s_waitcnt(0);
        unsigned nloc = b.st[0], nx = b.st[1];
        if (nloc == 0u) { xcd_barrier_complete(bar, b.x, nloc, nx); b.st[0] = nloc; b.st[1] = nx; }
        const unsigned old = xb_add(&bar[XB_XSUB(b.x)], 1u);
        const unsigned gen = old / nloc;
        if (old + 1u == (gen + 1u) * nloc) {
            __builtin_amdgcn_fence(__ATOMIC_RELEASE, "agent");
            asm volatile("s_waitcnt vmcnt(0)" ::: "memory");
            const unsigned og = xb_add(&bar[XB_TOP], 1u);
            const unsigned tg = og / nx;
            if (og + 1u == (tg + 1u) * nx) xb_add(&bar[XB_TOPGEN], 1u);
            else XB_SPIN(xb_ld(&bar[XB_TOPGEN]) == tg, bar);
            __builtin_amdgcn_fence(__ATOMIC_ACQUIRE, "agent");
            xb_add(&bar[XB_XGEN(b.x)], 1u);
            asm volatile("s_waitcnt vmcnt(0)" ::: "memory");
        } else {
            XB_SPIN(xb_ld(&bar[XB_XGEN(b.x)]) == gen, bar);
            __builtin_amdgcn_fence(__ATOMIC_ACQUIRE, "agent");
            asm volatile("s_waitcnt vmcnt(0)" ::: "memory");
        }
    }
    __syncthreads();
}

namespace pg8 {
#define PG8_LAS __attribute__((address_space(3)))
typedef unsigned short bf16_t;
typedef short bf16x8 __attribute__((ext_vector_type(8)));
typedef float f32x4 __attribute__((ext_vector_type(4)));
typedef unsigned u32x4 __attribute__((ext_vector_type(4)));
constexpr int BM = 256, BK = 64, HALF = 128, HTB = HALF * BK * 2  , STAGE_BYTES = 8 * HTB, NXCD = 8, WGM = 8;

__host__ __device__ __forceinline__ int lds_byte(int r, int c) { const int st = (r >> 4) * 2 + (c >> 5), rr = r & 15, cc = c & 31, ob = rr * 64 + cc * 2; return st * 1024 + (ob ^ (((ob >> 9) & 1) << 5)); }
__host__ __device__ __forceinline__ void stage_rc(int b, int& R, int& C) { const int st = b / 1024, sb = b % 1024, swz = sb ^ (((sb >> 9) & 1) << 5); R = (st >> 1) * 16 + swz / 64; C = (st & 1) * 32 + (swz % 64) / 2; }
__host__ __device__ __forceinline__ int perm32(int rho) { const int n = rho >> 4, i = rho & 15; return 8 * (i >> 2) + 4 * n + (i & 3); }

struct Unit { int pm, pn, e; };
struct Gemm { const bf16_t* A; const bf16_t* Bt; int M, N, K; size_t estride; };

struct StaticOrder {
    int nM, nN, nwg, G, c;
    __host__ __device__ void init(int M, int N, int G_, int c_) { nM = M / BM; nN = N / BM; nwg = nM * nN; G = G_; c = c_; }
    __host__ __device__ bool next(int i, Unit& u) const {
        const long L = (long)i * G + c; if (L >= nwg) return false;
        int wgid = (int)L; { const int q = nwg / NXCD, r = nwg % NXCD, xcd = wgid % NXCD, off = wgid / NXCD; wgid = (xcd < r ? xcd * (q + 1) : r * (q + 1) + (xcd - r) * q) + off; }
        const int nig = WGM * nN, gid = wgid / nig, fm = gid * WGM, gsz = (nM - fm) < WGM ? (nM - fm) : WGM;
        u.pm = fm + ((wgid % nig) % gsz); u.pn = (wgid % nig) / gsz; u.e = 0; return true;
    }
    __device__ __forceinline__ void a_ready(const Unit&) const {}
    __device__ __forceinline__ void done(const Unit&) const {}
};
__device__ __forceinline__ unsigned cvt_pk_bf16(float lo, float hi) { unsigned r; asm volatile("v_cvt_pk_bf16_f32 %0, %1, %2" : "=v"(r) : "v"(lo), "v"(hi)); return r; }
typedef float f32x2 __attribute__((ext_vector_type(2)));
__device__ __forceinline__ f32x2 gelu_pk(f32x2 v) {
    const f32x2 av = __builtin_elementwise_abs(v), d = av * 0.2316418882f + 1.0f;
    f32x2 t; t.x = __builtin_amdgcn_rcpf(d.x); t.y = __builtin_amdgcn_rcpf(d.y);
    f32x2 q = t * 0.5307027145f + (-0.7265760135f); q = q * t + 0.7107068705f; q = q * t + (-0.142248368f); q = q * t + 0.127414796f; q = q * t;
    const f32x2 s = (v * v) * (-0.72134752044f);
    f32x2 e; e.x = __builtin_amdgcn_exp2f(s.x); e.y = __builtin_amdgcn_exp2f(s.y);
    const f32x2 m = v * (q * e), r = v - m;
    f32x2 o; o.x = v.x < 0.f ? m.x : r.x; o.y = v.y < 0.f ? m.y : r.y; return o;
}

struct EpiF32 {
    static constexpr bool PERM = false, AFTER_DRAIN = false;
    float* C; int ldc; const float* bias;
    __device__ __forceinline__ void operator()(const f32x4 (&acc)[2][2][4][2], const Unit& u, int wr, int wc, int fr, int fq) const {
        const int row0 = u.pm * BM + wr * 64 + fr, col0 = u.pn * BM + wc * 32 + 4 * fq;
        f32x4 bv[2][2];
#pragma unroll
        for (int bj = 0; bj < 2; ++bj)
#pragma unroll
            for (int n = 0; n < 2; ++n) bv[bj][n] = bias ? *(const f32x4*)(bias + col0 + bj * HALF + n * 16) : (f32x4){0.f, 0.f, 0.f, 0.f};
#pragma unroll
        for (int ai = 0; ai < 2; ++ai)
#pragma unroll
            for (int m = 0; m < 4; ++m) { float* rowp = C + (size_t)(row0 + ai * HALF + m * 16) * ldc + col0;
#pragma unroll
                for (int bj = 0; bj < 2; ++bj)
#pragma unroll
                    for (int n = 0; n < 2; ++n) *(f32x4*)(rowp + bj * HALF + n * 16) = acc[ai][bj][m][n] + bv[bj][n]; }
    }
};
template <int ACT  > struct EpiBf16 {
    static constexpr bool PERM = true, AFTER_DRAIN = false;
    bf16_t* O; int ldc; const float* bias; int split_cols; size_t split_stride;
    __device__ __forceinline__ void operator()(const f32x4 (&acc)[2][2][4][2], const Unit& u, int wr, int wc, int fr, int fq) const {
        const int row0 = u.pm * BM + wr * 64 + fr; int colt = u.pn * BM; bf16_t* base = O;
        if (split_cols) { const int t = colt / split_cols; base += (size_t)t * split_stride; colt -= t * split_cols; }
        const int col0 = colt + wc * 32 + 8 * fq, bcol0 = u.pn * BM + wc * 32 + 8 * fq;
        f32x4 bv[2][2];
#pragma unroll
        for (int bj = 0; bj < 2; ++bj)
#pragma unroll
            for (int n = 0; n < 2; ++n) bv[bj][n] = bias ? *(const f32x4*)(bias + bcol0 + bj * HALF + 4 * n) : (f32x4){0.f, 0.f, 0.f, 0.f};
#pragma unroll
        for (int ai = 0; ai < 2; ++ai)
#pragma unroll
            for (int m = 0; m < 4; ++m) { bf16_t* rowp = base + (size_t)(row0 + ai * HALF + m * 16) * ldc + col0;
#pragma unroll
                for (int bj = 0; bj < 2; ++bj) { f32x4 v0 = acc[ai][bj][m][0] + bv[bj][0], v1 = acc[ai][bj][m][1] + bv[bj][1];
                    if (ACT == 1) { f32x2 a = gelu_pk((f32x2){v0[0], v0[1]}), b = gelu_pk((f32x2){v0[2], v0[3]}), c = gelu_pk((f32x2){v1[0], v1[1]}), d = gelu_pk((f32x2){v1[2], v1[3]});
                        v0 = (f32x4){a.x, a.y, b.x, b.y}; v1 = (f32x4){c.x, c.y, d.x, d.y}; }
                    if (ACT == 2) {
#pragma unroll
                        for (int j = 0; j < 4; ++j) { v0[j] = 0.5f * v0[j] * (1.0f + erff(v0[j] * 0.70710678f)); v1[j] = 0.5f * v1[j] * (1.0f + erff(v1[j] * 0.70710678f)); } }
                    u32x4 w; w.x = cvt_pk_bf16(v0[0], v0[1]); w.y = cvt_pk_bf16(v0[2], v0[3]); w.z = cvt_pk_bf16(v1[0], v1[1]); w.w = cvt_pk_bf16(v1[2], v1[3]);
                    *(u32x4*)(rowp + bj * HALF) = w; } }
    }
};

template <class Epi, class Sched, bool STAMP = false>
__device__ __forceinline__ void gemm_phase(PG8_LAS unsigned char* lds, const Gemm g, const Sched& S, const Epi& E, unsigned long long* stamps) {
    int tid_ = threadIdx.x; asm volatile("" : "+v"(tid_));
    const int tid = tid_, wid = __builtin_amdgcn_readfirstlane(tid >> 6), lane = tid & 63, wr = wid >> 2, wc = wid & 3, fr = lane & 15, fq = lane >> 4;
    const int K = g.K, nt = K / BK;
    int ts_lo = 0, ts_hi = 0, nts = 0; const unsigned long long rt_entry = STAMP ? (unsigned long long)wall_clock64() : 0ull;
#define PG8_STAMP() do { if (STAMP && wid == 0 && nts < 64) { const unsigned long long _c = (unsigned long long)clock64(); \
        ts_lo = (lane == nts) ? (int)(unsigned)_c : ts_lo; ts_hi = (lane == nts) ? (int)(unsigned)(_c >> 32) : ts_hi; ++nts; } } while (0)
    PG8_STAMP();
    unsigned voffA[2], voffB[2];
#pragma unroll
    for (int i = 0; i < 2; ++i) { int R, C; stage_rc(tid * 16 + i * 8192, R, C); const int Rb = Epi::PERM ? ((R & ~31) + perm32(R & 31)) : R;
        voffA[i] = (unsigned)(R * K + C) * 2u; voffB[i] = (unsigned)(Rb * K + C) * 2u; }
    const size_t kstep = (size_t)(BK * 2);
    const size_t hstep = (size_t)HALF * K * 2;
    const size_t tstep = 2 * hstep;
    const unsigned ldsw = (unsigned)wid * 1024u;
    const int aoff = lds_byte(wr * 64 + fr, fq * 8), boff = lds_byte(wc * 32 + fr, fq * 8);
#define PG8_SA(b, h) (((b) * 2 + (h)) * HTB)
#define PG8_SB(b, h) ((4 + (b) * 2 + (h)) * HTB)
#define PG8_STAGE(bufoff, gbase, voff) do { _Pragma("unroll") for (int _i = 0; _i < 2; ++_i) \
        __builtin_amdgcn_global_load_lds((const unsigned*)((const char*)(gbase) + (voff)[_i]), (PG8_LAS unsigned*)(lds + (bufoff) + ldsw + _i * 8192), 16, 0, 0); } while (0)
#define PG8_LDA(dst, b, h) do { _Pragma("unroll") for (int m = 0; m < 4; ++m) _Pragma("unroll") for (int k = 0; k < 2; ++k) dst[m][k] = *(const PG8_LAS bf16x8*)(lds + PG8_SA(b, h) + aoff + m * 2048 + k * 1024); } while (0)
#define PG8_LDB(dst, b, h) do { _Pragma("unroll") for (int n = 0; n < 2; ++n) _Pragma("unroll") for (int k = 0; k < 2; ++k) dst[n][k] = *(const PG8_LAS bf16x8*)(lds + PG8_SB(b, h) + boff + n * 2048 + k * 1024); } while (0)
#define PG8_MMA(ai, bj, At, Bt) do { __builtin_amdgcn_s_setprio(1); _Pragma("unroll") for (int m = 0; m < 4; ++m) _Pragma("unroll") for (int n = 0; n < 2; ++n) _Pragma("unroll") for (int k = 0; k < 2; ++k) \
        acc[ai][bj][m][n] = __builtin_amdgcn_mfma_f32_16x16x32_bf16(Bt[n][k], At[m][k], acc[ai][bj][m][n], 0, 0, 0); __builtin_amdgcn_s_setprio(0); } while (0)
#define PG8_WAIT_V(n) asm volatile("s_waitcnt vmcnt(" #n ")" ::: "memory")
#define PG8_WAIT_L(n) asm volatile("s_waitcnt lgkmcnt(" #n ")" ::: "memory")
#define PG8_BAR __builtin_amdgcn_s_barrier()
#define PG8_SCHED __builtin_amdgcn_sched_barrier(0)
    Unit cur, nxt; int ui = 0;
    if (!S.next(0, cur)) return;
    f32x4 acc[2][2][4][2];
#pragma unroll
    for (int a = 0; a < 2; ++a)
#pragma unroll
        for (int b = 0; b < 2; ++b)
#pragma unroll
            for (int m = 0; m < 4; ++m)
#pragma unroll
                for (int n = 0; n < 2; ++n) acc[a][b][m][n] = (f32x4){0.f, 0.f, 0.f, 0.f};
    bf16x8 At[4][2], B0[2][2], B1[2][2];
    const char* cA = (const char*)g.A + (size_t)cur.pm * tstep; const char* cB = (const char*)g.Bt + (size_t)cur.pn * tstep + (size_t)cur.e * g.estride * 2;
    S.a_ready(cur);
    PG8_STAGE(PG8_SB(0, 0), cB, voffB); PG8_STAGE(PG8_SA(0, 0), cA, voffA); PG8_STAGE(PG8_SB(0, 1), cB + hstep, voffB); PG8_STAGE(PG8_SA(0, 1), cA + hstep, voffA);
    if (wr == 1) PG8_BAR;
    PG8_WAIT_V(4); PG8_BAR;
    PG8_STAGE(PG8_SB(1, 0), cB + kstep, voffB); PG8_STAGE(PG8_SA(1, 0), cA + kstep, voffA); PG8_STAGE(PG8_SB(1, 1), cB + hstep + kstep, voffB);
    PG8_WAIT_V(6); PG8_BAR;
    PG8_STAMP();
    for (;;) {
        const bool has_next = S.next(ui + 1, nxt);
        const char* nA = has_next ? (const char*)g.A + (size_t)nxt.pm * tstep : cA; const char* nB = has_next ? (const char*)g.Bt + (size_t)nxt.pn * tstep + (size_t)nxt.e * g.estride * 2 : cB;
        for (int t = 0; t < nt; t += 2) {
            const bool last = (t == nt - 2);
            const char* a1 = cA + (size_t)(t + 1) * kstep;
            const char* a2 = last ? nA : cA + (size_t)(t + 2) * kstep; const char* b2 = last ? nB : cB + (size_t)(t + 2) * kstep;
            const char* a3 = a2 + kstep; const char* b3 = b2 + kstep;
            if (last && has_next) S.a_ready(nxt);
            PG8_LDB(B0, 0, 0); PG8_SCHED; PG8_LDA(At, 0, 0); PG8_STAGE(PG8_SA(1, 1), a1 + hstep, voffA);
            PG8_WAIT_L(8); PG8_BAR; PG8_WAIT_L(0); PG8_MMA(0, 0, At, B0); PG8_BAR; PG8_SCHED;
            PG8_LDB(B1, 0, 1); PG8_STAGE(PG8_SB(0, 0), b2, voffB);
            PG8_BAR; PG8_WAIT_L(0); PG8_MMA(0, 1, At, B1); PG8_BAR;
            PG8_LDA(At, 0, 1); PG8_STAGE(PG8_SA(0, 0), a2, voffA);
            PG8_BAR; PG8_WAIT_L(0); PG8_MMA(1, 0, At, B0); PG8_BAR; PG8_SCHED;
            PG8_STAGE(PG8_SB(0, 1), b2 + hstep, voffB);
            PG8_WAIT_V(6); PG8_BAR; PG8_MMA(1, 1, At, B1); PG8_BAR;
            PG8_LDB(B0, 1, 0); PG8_SCHED; PG8_LDA(At, 1, 0); PG8_STAGE(PG8_SA(0, 1), a2 + hstep, voffA);
            PG8_WAIT_L(8); PG8_BAR; PG8_WAIT_L(0); PG8_MMA(0, 0, At, B0); PG8_BAR; PG8_SCHED;
            PG8_LDB(B1, 1, 1); PG8_STAGE(PG8_SB(1, 0), b3, voffB);
            PG8_BAR; PG8_WAIT_L(0); PG8_MMA(0, 1, At, B1); PG8_BAR;
            PG8_LDA(At, 1, 1); PG8_STAGE(PG8_SA(1, 0), a3, voffA);
            PG8_BAR; PG8_WAIT_L(0); PG8_MMA(1, 0, At, B0); PG8_BAR; PG8_SCHED;
            PG8_STAGE(PG8_SB(1, 1), b3 + hstep, voffB);
            PG8_WAIT_V(6); PG8_BAR; PG8_MMA(1, 1, At, B1); PG8_BAR;
        }
        PG8_STAMP();
        if constexpr (!Epi::AFTER_DRAIN) { E(acc, cur, wr, wc, fr, fq); S.done(cur); }
        PG8_STAMP();
        if (!has_next) break;
#pragma unroll
        for (int a = 0; a < 2; ++a)
#pragma unroll
            for (int b = 0; b < 2; ++b)
#pragma unroll
                for (int m = 0; m < 4; ++m)
#pragma unroll
                    for (int n = 0; n < 2; ++n) acc[a][b][m][n] = (f32x4){0.f, 0.f, 0.f, 0.f};
        cur = nxt; cA = nA; cB = nB; ++ui;
    }
    PG8_WAIT_V(0);
    if (wr == 0) PG8_BAR;
    PG8_BAR;
    if constexpr (Epi::AFTER_DRAIN) { E.fused(acc, cur, wr, wc, fr, fq, lds, wid, lane); S.done(cur); }
    PG8_STAMP();
    if (STAMP && wid == 0) { stamps[lane] = lane < nts ? (((unsigned long long)(unsigned)ts_hi << 32) | (unsigned)ts_lo) : 0ull;
        if (lane == 62) stamps[62] = rt_entry; if (lane == 63) stamps[63] = (unsigned long long)wall_clock64(); }
#undef PG8_STAMP
#undef PG8_SA
#undef PG8_SB
#undef PG8_STAGE
#undef PG8_LDA
#undef PG8_LDB
#undef PG8_MMA
#undef PG8_WAIT_V
#undef PG8_WAIT_L
#undef PG8_BAR
#undef PG8_SCHED
}
}
namespace pg8 {
struct EpiRes {
    static constexpr bool PERM = false, AFTER_DRAIN = false;
    const float* base_lat; const float* base_ctx; float* out_lat; float* out_ctx; const float* gvec;
    __device__ __forceinline__ void operator()(const f32x4 (&acc)[2][2][4][2], const Unit& u, int wr, int wc, int fr, int fq) const {
        const bool isctx = u.pm >= 128;
        const int prow = (isctx ? (u.pm - 128) : u.pm) * BM;
        const float* base = isctx ? base_ctx : base_lat; float* out = isctx ? out_ctx : out_lat;
        const float* gv = gvec + (size_t)(isctx ? 8 : (u.pm >> 4)) * 6144;
        const int row0 = prow + wr * 64 + fr, col0 = u.pn * BM + wc * 32 + 4 * fq;
        f32x4 gvv[2][2];
#pragma unroll
        for (int bj = 0; bj < 2; ++bj)
#pragma unroll
            for (int n = 0; n < 2; ++n) gvv[bj][n] = *(const f32x4*)(gv + col0 + bj * HALF + n * 16);
#pragma unroll
        for (int ai = 0; ai < 2; ++ai)
#pragma unroll
            for (int m = 0; m < 4; ++m) { const size_t off = (size_t)(row0 + ai * HALF + m * 16) * 1024 + col0;
#pragma unroll
                for (int bj = 0; bj < 2; ++bj)
#pragma unroll
                    for (int n = 0; n < 2; ++n) { const f32x4 b = *(const f32x4*)(base + off + bj * HALF + n * 16);
                        *(f32x4*)(out + off + bj * HALF + n * 16) = b + gvv[bj][n] * acc[ai][bj][m][n]; } }
    }
};
struct EpiSwiglu {
    static constexpr bool PERM = true, AFTER_DRAIN = false;
    bf16_t* O; int ldc;
    __device__ __forceinline__ void operator()(const f32x4 (&acc)[2][2][4][2], const Unit& u, int wr, int wc, int fr, int fq) const {
        const int row0 = u.pm * BM + wr * 64 + fr, col0 = u.pn * HALF + wc * 32 + 8 * fq;
#pragma unroll
        for (int ai = 0; ai < 2; ++ai)
#pragma unroll
            for (int m = 0; m < 4; ++m) { bf16_t* rowp = O + (size_t)(row0 + ai * HALF + m * 16) * ldc + col0;
                float h[8];
#pragma unroll
                for (int n = 0; n < 2; ++n)
#pragma unroll
                    for (int j = 0; j < 4; ++j) { const float g = acc[ai][0][m][n][j], up = acc[ai][1][m][n][j]; h[n * 4 + j] = g * __builtin_amdgcn_rcpf(1.0f + __expf(-g)) * up; }
                u32x4 w; w.x = cvt_pk_bf16(h[0], h[1]); w.y = cvt_pk_bf16(h[2], h[3]); w.z = cvt_pk_bf16(h[4], h[5]); w.w = cvt_pk_bf16(h[6], h[7]);
                *(u32x4*)rowp = w; }
    }
};
struct MoeOrder {
    int nN, G, c, nunits; const int* tab;
    __device__ void init(const int* tab_, int nN_, int G_, int c_) { tab = tab_; nN = nN_; G = G_; c = c_; nunits = tab_[0] * nN_; }
    __device__ bool next(int i, Unit& u) const {
        const int L = i * G + c; if (L >= nunits) return false;
        u.pm = L / nN; u.pn = L - u.pm * nN; u.e = tab[1 + u.pm]; return true;
    }
    __device__ __forceinline__ void a_ready(const Unit&) const {}
    __device__ __forceinline__ void done(const Unit&) const {}
};
}
enum { I_X = 0, I_C, I_CTX, I_CCTX, I_MODW, I_MODB, I_NMIXG, I_NFFNG, I_WIN, I_WOUT, I_LCW, I_LCB, I_LWA, I_LBA, I_LWX, I_LBX, I_LLAM,
       I_RMU, I_RWUP, I_RW0, I_RAUP, I_RA0, I_RGUP, I_RKK, I_RKA, I_RRK, I_RLNG, I_RLNB, I_MIB, I_MFB, I_MNG, I_GCW, I_GALOG, I_GDTB, I_GNG,
       I_FWG, I_FWU, I_FWD, I_MROUTER, I_MWG, I_MWU, I_MWD, I_FNG, N_IN };
struct Args { const float* in[N_IN]; float* out; unsigned char* ws; int ph_lo, ph_hi; };
struct Ctx {
    const float* const* in; float* out; unsigned char* ws; LAS unsigned char* lds;
    int tid, lane, wave, G, wg;
};
#define WSP(T, off) ((T*)(C.ws + (off)))

__device__ __forceinline__ int seqrow_raster(int i, int d, int b) {
    if (i < CTXL) { const int p = d ? (CTXL - 1 - i) : i; return T_LAT + b * CTXL + p; }
    const int j = i - CTXL; const int p = d ? (SEQ - 1 - j) : j; return b * SEQ + p;
}
__device__ __forceinline__ int seqrow_cm(int i, int d, int b) {
    if (i < CTXL) { const int p = d ? (CTXL - 1 - i) : i; return T_LAT + b * CTXL + p; }
    const int j = i - CTXL; const int p = d ? (SEQ - 1 - j) : j; return b * SEQ + (p & 63) * 64 + (p >> 6);
}

__device__ __forceinline__ void phase_pre(const Ctx& C) {
    LAS float* sc = (LAS float*)C.lds;
    LAS float* red = sc + 9 * 1024;
    float* modv = WSP(float, WS_MODV);
    bool filled = false;
    for (int it = C.wg; it < DEPTH * 48; it += C.G) {
        if (!filled) {
            for (int i = C.tid; i < 9 * 1024; i += NTHR) { const float v = i < 8192 ? C.in[I_C][i] : C.in[I_CCTX][i - 8192]; sc[i] = siluf_(v); }
            filled = true; __syncthreads();
        }
        const int l = it / 48, jb = it % 48, col = C.tid & 127, kg = C.tid >> 7;
        const float* W = C.in[I_MODW] + (size_t)l * 1024 * 6144 + jb * 128 + col;
        float acc[9];
#pragma unroll
        for (int r = 0; r < 9; ++r) acc[r] = 0.f;
        for (int k = kg * 256; k < kg * 256 + 256; ++k) { const float w = W[(size_t)k * 6144];
#pragma unroll
            for (int r = 0; r < 9; ++r) acc[r] += sc[r * 1024 + k] * w; }
#pragma unroll
        for (int r = 0; r < 9; ++r) red[(kg * 9 + r) * 128 + col] = acc[r];
        __syncthreads();
        for (int i = C.tid; i < 9 * 128; i += NTHR) { const int r = i >> 7, cc = i & 127;
            const float s = red[(0 * 9 + r) * 128 + cc] + red[(1 * 9 + r) * 128 + cc] + red[(2 * 9 + r) * 128 + cc] + red[(3 * 9 + r) * 128 + cc];
            modv[((size_t)l * 9 + r) * 6144 + jb * 128 + cc] = s + C.in[I_MODB][l * 6144 + jb * 128 + cc]; }
        __syncthreads();
    }
}

__device__ __forceinline__ void tr_item(const float* src, size_t ld, int k0, int ns0, bf16* dst, int drow0, int Kd, LAS float* scr, int lane, bool zero) {
    if (!zero) {
#pragma unroll 8
        for (int i = 0; i < 32; ++i) { const int kk = 2 * i + (lane >> 5); scr[kk * 33 + (lane & 31)] = src[(size_t)(k0 + kk) * ld + ns0 + (lane & 31)]; }
    }
    LDS_WAIT(); asm volatile("" ::: "memory");
    const int c = lane & 7;
#pragma unroll
    for (int j = 0; j < 4; ++j) { const int n = (lane >> 3) + 8 * j; const LAS float* s = scr + (8 * c) * 33 + n;
        v4u o; o.x = pk2(s[0 * 33], s[1 * 33]); o.y = pk2(s[2 * 33], s[3 * 33]); o.z = pk2(s[4 * 33], s[5 * 33]); o.w = pk2(s[6 * 33], s[7 * 33]);
        if (zero) o = (v4u){0u, 0u, 0u, 0u};
        *(v4u*)(dst + (size_t)(drow0 + n) * Kd + k0 + 8 * c) = o; }
    LDS_WAIT(); asm volatile("" ::: "memory");
}
__device__ __forceinline__ void convert_small(const Ctx& C, int l) {
    {
        bf16* lw = WSP(bf16, WS_LRUWT);
        for (int k = 0; k < 2 * 2 * 4 * 4096 / (128 * NTHR); ++k) {
            const int e = k * 128 * NTHR + C.wg * NTHR + C.tid;
            if (C.wg < 128) {
            const int i = e & 63, j = (e >> 6) & 63, hd = (e >> 12) & 3, g = (e >> 14) & 1, d = e >> 15;
            const float* src = (g ? C.in[I_LWX] : C.in[I_LWA]) + ((size_t)((l * 2 + d) * 4 + hd) * 64 + i) * 64 + j;
            lw[e] = (bf16)f2bf(*src);
            }
        }
    }
    if (C.wg >= 128 && C.wg < 224) {
        bf16* rw = WSP(bf16, WS_RWT);
        const int e = (C.wg - 128) * NTHR + C.tid;
        if (e < 32768) { const int r = e & 31, ch = (e >> 5) & 255, d = (e >> 13) & 1, isa = e >> 14;
            rw[e] = (bf16)f2bf((isa ? C.in[I_RAUP] : C.in[I_RWUP])[((size_t)(l * 2 + d) * 32 + r) * GW + ch]); }
        else { const int e2 = e - 32768, j = e2 & 63, ch = e2 >> 6; rw[e] = (bf16)f2bf(C.in[I_RGUP][((size_t)l * 64 + j) * GW + ch]); }
    }
}
__device__ __forceinline__ void convert_items(const Ctx& C, int l, int what, int gw, int NGW) {
    LAS float* scr = (LAS float*)(C.lds + C.wave * 8704);
    constexpr int I_IN = 16 * 112, I_OUT = 16 * 32, I_GU = 16 * 176, I_DN = 44 * 32, I_E = 16 * 88 + 22 * 32;
    const bool moe = l & 1; const int li = l >> 1;
    const int lo_it = (what & 1) ? 0 : I_IN, hi_it = (what & 2) ? I_IN + I_OUT + (moe ? NE * I_E : (I_GU + I_DN)) : I_IN;
    bf16* win = WSP(bf16, WS_WIN); bf16* wout = WSP(bf16, WS_WOUT); bf16* wgu = WSP(bf16, WS_WGU); bf16* wdn = WSP(bf16, WS_WDN);
    for (int it = lo_it + gw; it < hi_it; it += NGW) {
        int r = it;
        if (r < I_IN) { const int kb = r / 112, nb = r % 112; tr_item(C.in[I_WIN] + (size_t)l * 1024 * IN_COLS, IN_COLS, 64 * kb, 32 * nb, win, 32 * nb, 1024, scr, C.lane, nb == 111); continue; }
        r -= I_IN;
        if (r < I_OUT) { const int kb = r / 32, nb = r % 32; tr_item(C.in[I_WOUT] + (size_t)l * 1024 * 1024, 1024, 64 * kb, 32 * nb, wout, 32 * nb, 1024, scr, C.lane, false); continue; }
        r -= I_OUT;
        if (!moe) {
            if (r < I_GU) { const int kb = r / 176, nb = r % 176, tile = nb >> 3, q = nb & 7;
                const float* src = (q < 4 ? C.in[I_FWG] : C.in[I_FWU]) + (size_t)li * 1024 * DFF;
                tr_item(src, DFF, 64 * kb, tile * 128 + (q & 3) * 32, wgu, 32 * nb, 1024, scr, C.lane, false); continue; }
            r -= I_GU;
            { const int kb = r / 32, nb = r % 32; tr_item(C.in[I_FWD] + (size_t)li * DFF * 1024, 1024, 64 * kb, 32 * nb, wdn, 32 * nb, DFF, scr, C.lane, false); }
        } else {
            const int e = r / I_E; int rr = r % I_E;
            if (rr < 16 * 88) { const int kb = rr / 88, nb = rr % 88, tile = nb >> 3, q = nb & 7;
                const float* src = (q < 4 ? C.in[I_MWG] : C.in[I_MWU]) + ((size_t)li * NE + e) * 1024 * DFE;
                tr_item(src, DFE, 64 * kb, tile * 128 + (q & 3) * 32, wgu + (size_t)e * 2 * DFE * 1024, 32 * nb, 1024, scr, C.lane, false); continue; }
            rr -= 16 * 88;
            { const int kb = rr / 32, nb = rr % 32; tr_item(C.in[I_MWD] + ((size_t)li * NE + e) * DFE * 1024, 1024, 64 * kb, 32 * nb, wdn + (size_t)e * 1024 * DFE, 32 * nb, DFE, scr, C.lane, false); }
        }
    }
}

template <bool ROUTE>
__device__ __forceinline__ void norm_rows(const Ctx& C, int l, const float* xlat, const float* xctx, const float* gain, int shoff, int scoff, int nrows, int moe_li) {
    const float* modv = WSP(float, WS_MODV) + (size_t)l * 9 * 6144;
    bf16* hb = WSP(bf16, WS_HB);
    const int gw = C.wg * NWAVES + C.wave, NGW = C.G * NWAVES;
    LAS unsigned* lcnt = (LAS unsigned*)(C.lds + 65536);
    unsigned* route = WSP(unsigned, WS_ROUTE);
    if (ROUTE) { if (C.tid < 8) lcnt[C.tid] = 0u; __syncthreads(); }
    f32x4 gv[4];
#pragma unroll
    for (int j = 0; j < 4; ++j) gv[j] = *(const f32x4*)(gain + 4 * C.lane + 256 * j);
    for (int m = gw; m < nrows; m += NGW) {
        const bool isctx = m >= T_LAT;
        const float* xr = isctx ? xctx + (size_t)(m - T_LAT) * 1024 : xlat + (size_t)m * 1024;
        const float* mv = modv + (size_t)(isctx ? 8 : (m >> 12)) * 6144;
        f32x4 v[4]; float s = 0.f;
#pragma unroll
        for (int j = 0; j < 4; ++j) { v[j] = *(const f32x4*)(xr + 4 * C.lane + 256 * j); s += (v[j].x * v[j].x + v[j].y * v[j].y) + (v[j].z * v[j].z + v[j].w * v[j].w); }
        const float rs = 1.0f / sqrtf(wave_sum(s) * (1.0f / 1024.0f) + 1e-6f);
#pragma unroll
        for (int j = 0; j < 4; ++j) { const f32x4 sh = *(const f32x4*)(mv + shoff + 4 * C.lane + 256 * j), scl = *(const f32x4*)(mv + scoff + 4 * C.lane + 256 * j);
            v[j] = (v[j] * rs * gv[j]) * (scl + 1.0f) + sh;
            v2u o; o.x = pk2(v[j].x, v[j].y); o.y = pk2(v[j].z, v[j].w);
            *(v2u*)(hb + (size_t)m * 1024 + 4 * C.lane + 256 * j) = o; }
        if (ROUTE) {
            const float* rt = C.in[I_MROUTER] + (size_t)moe_li * 1024 * NE;
            float lg[8];
#pragma unroll
            for (int e = 0; e < 8; ++e) lg[e] = 0.f;
#pragma unroll
            for (int j = 0; j < 4; ++j)
#pragma unroll
                for (int q = 0; q < 4; ++q) { const int k = 4 * C.lane + 256 * j + q; const f32x4 r0 = *(const f32x4*)(rt + (size_t)k * 8), r1 = *(const f32x4*)(rt + (size_t)k * 8 + 4); const float hv = v[j][q];
                    lg[0] += hv * r0.x; lg[1] += hv * r0.y; lg[2] += hv * r0.z; lg[3] += hv * r0.w; lg[4] += hv * r1.x; lg[5] += hv * r1.y; lg[6] += hv * r1.z; lg[7] += hv * r1.w; }
#pragma unroll
            for (int e = 0; e < 8; ++e) lg[e] = wave_sum(lg[e]);
            int e0 = 0; float l0 = lg[0];
#pragma unroll
            for (int e = 1; e < 8; ++e) if (lg[e] > l0) { l0 = lg[e]; e0 = e; }
            int e1 = -1; float l1 = -3.0e38f;
#pragma unroll
            for (int e = 0; e < 8; ++e) if (e != e0 && lg[e] > l1) { l1 = lg[e]; e1 = e; }
            const float w0 = 1.0f / (1.0f + __expf(l1 - l0)), w1 = 1.0f - w0;
            if (C.lane == 0) {
                const unsigned r0 = atomicAdd((unsigned*)&lcnt[e0], 1u), r1 = atomicAdd((unsigned*)&lcnt[e1], 1u);
                v4u a; a.x = (unsigned)e0; a.y = (unsigned)e1; a.z = r0; a.w = r1;
                *(v4u*)(route + (size_t)m * 8) = a;
                v2u b; b.x = __builtin_bit_cast(unsigned, w0); b.y = __builtin_bit_cast(unsigned, w1);
                *(v2u*)(route + (size_t)m * 8 + 4) = b;
            }
        }
    }
    if (ROUTE) {
        __syncthreads();
        if (C.tid < 8) { unsigned* gc = WSP(unsigned, WS_CTL) + CW_MOECNT + 64 * moe_li; const unsigned base = atomicAdd(gc + C.tid, lcnt[C.tid]); WSP(unsigned, WS_WGBASE)[C.wg * 8 + C.tid] = base; }
    }
}
template <bool FIN>
__device__ __forceinline__ void lru_chunk(const Ctx& C, int l, int b, int c) {
    LAS float* U = (LAS float*)C.lds;
    const bf16* P = WSP(const bf16, WS_P);
    const bool isctx = c < 4; const int p0 = isctx ? c * 64 : (c - 4) * 64; const int Lp = isctx ? CTXL : SEQ; const int row0 = isctx ? T_LAT + b * CTXL : b * SEQ;
    const int ch = C.tid & 255, half = C.tid >> 8;
    {
        const float* cw = C.in[I_LCW] + (size_t)l * 4 * GW + ch; const float w0 = cw[0], w1 = cw[GW], w2 = cw[2 * GW], w3 = cw[3 * GW], cb = C.in[I_LCB][l * GW + ch];
        const int t0 = half * 32;
        auto ld = [&](int p) -> float { return (p >= 0 && p < Lp) ? bf2f(P[(size_t)(row0 + p) * PLD + ch]) : 0.f; };
        float xm2 = ld(p0 + t0 - 2), xm1 = ld(p0 + t0 - 1), x0 = ld(p0 + t0);
        for (int t = 0; t < 32; ++t) { const float xp1 = ld(p0 + t0 + t + 1); U[(t0 + t) * 256 + ch] = w0 * xm2 + w1 * xm1 + w2 * x0 + w3 * xp1 + cb; xm2 = xm1; xm1 = x0; x0 = xp1; }
    }
    __syncthreads();
    const int d = half, hd = ch >> 6, jj = ch & 63;
    const float* wa = C.in[I_LWA] + ((size_t)((l * 2 + d) * 4 + hd) * 64) * 64 + jj;
    const float* wx = C.in[I_LWX] + ((size_t)((l * 2 + d) * 4 + hd) * 64) * 64 + jj;
    const float ba = C.in[I_LBA][(l * 2 + d) * GW + ch], bx = C.in[I_LBX][(l * 2 + d) * GW + ch];
    const float sp8 = 8.0f * softplusf_(-C.in[I_LLAM][(l * 2 + d) * GW + ch]);
    const size_t sidx = ((size_t)(b * NCH + c) * 2 + d) * 256 + ch;
    float h = FIN ? WSP(const float, WS_HIN)[sidx] : 0.f, sla = 0.f;
    LAS bf16* H16 = (LAS bf16*)(U + 64 * 256) + d * 64 * 256;
    const int sgn = d ? -1 : 1;
#pragma unroll 1
    for (int g = 0; g < 4; ++g) {
        const int tstart = d ? (63 - g * 16) : g * 16;
        float ar[16], ai[16];
#pragma unroll
        for (int tt = 0; tt < 16; ++tt) { ar[tt] = 0.f; ai[tt] = 0.f; }
        const LAS float* ub = U + tstart * 256 + hd * 64;
#pragma unroll 1
        for (int i = 0; i < 64; i += 4) {
            float a4[4], x4[4];
#pragma unroll
            for (int q = 0; q < 4; ++q) { a4[q] = wa[(i + q) * 64]; x4[q] = wx[(i + q) * 64]; }
#pragma unroll
            for (int tt = 0; tt < 16; ++tt) { const f32x4 uu = *(const LAS f32x4*)(ub + sgn * tt * 256 + i);
                ar[tt] += uu.x * a4[0] + uu.y * a4[1] + uu.z * a4[2] + uu.w * a4[3];
                ai[tt] += uu.x * x4[0] + uu.y * x4[1] + uu.z * x4[2] + uu.w * x4[3]; }
        }
#pragma unroll
        for (int tt = 0; tt < 16; ++tt) {
            const int tok = tstart + sgn * tt;
            const float r = sigmoidf_(ar[tt] + ba), ig = sigmoidf_(ai[tt] + bx);
            const float la = -sp8 * r; const float a = __expf(la);
            const float bb = sqrtf(-expm1f_(2.0f * la)) * (ig * U[tok * 256 + ch]);
            h = a * h + bb; sla += la;
            if (FIN) H16[tok * 256 + ch] = (bf16)f2bf1(h);
        }
    }
    if (!FIN) { float* ls = WSP(float, WS_LSUM) + sidx * 2; ls[0] = sla; ls[1] = h; __syncthreads(); return; }
    __syncthreads();
    bf16* yc = WSP(bf16, WS_HB);
    const LAS bf16* H0 = (const LAS bf16*)(U + 64 * 256); const LAS bf16* H1 = H0 + 64 * 256;
    for (int t = half * 32; t < half * 32 + 32; ++t) {
        const size_t row = (size_t)(row0 + p0 + t);
        const float gate = bf2f(P[row * PLD + 256 + ch]);
        yc[row * 1024 + ch] = (bf16)f2bf1((bf2f(H0[t * 256 + ch]) + bf2f(H1[t * 256 + ch])) * gelu_tanh(gate));
    }
    __syncthreads();
}
__device__ __forceinline__ void lru_carry(const Ctx& C, int idx) {
    const int ch = idx & 255, d = (idx >> 8) & 1, b = idx >> 9;
    const float* ls = WSP(const float, WS_LSUM); float* hin = WSP(float, WS_HIN);
    float H = 0.f;
    for (int k = 0; k < NCH; ++k) {
        const int c = d ? (k < 4 ? 3 - k : NCH + 3 - k) : k;
        const size_t sidx = ((size_t)(b * NCH + c) * 2 + d) * 256 + ch;
        hin[sidx] = H;
        H = __expf(ls[sidx * 2]) * H + ls[sidx * 2 + 1];
    }
}

__device__ __forceinline__ float rw_shift(const bf16* P, int row0, int p, int Lp, int colB, float mu0, float mu1) {
    const size_t o = (size_t)(row0 + p) * PLD + OFF_B + colB;
    const float x = bf2f(P[o]);
    const float pv = p > 0 ? bf2f(P[o - PLD]) : 0.f, nx = p < Lp - 1 ? bf2f(P[o + PLD]) : 0.f;
    return x + mu0 * (pv - x) + mu1 * (nx - x);
}
__device__ __forceinline__ void rwkv_prep(const Ctx& C, int l, int b, int c) {
    LAS float* XW = (LAS float*)C.lds;
    LAS float* XA = XW + 64 * 64;
    LAS float* XG = XA + 64 * 64;
    const bf16* P = WSP(const bf16, WS_P);
    const bool isctx = c < 4; const int p0 = isctx ? c * 64 : (c - 4) * 64; const int Lp = isctx ? CTXL : SEQ; const int row0 = isctx ? T_LAT + b * CTXL : b * SEQ;
    const float* mu = C.in[I_RMU] + (size_t)l * 2 * B_COLS;
    for (int it = C.tid; it < 64 * 192; it += NTHR) {
        const int t = it / 192, ci = it % 192, colB = 768 + ci;
        const float v = rw_shift(P, row0, p0 + t, Lp, colB, mu[colB], mu[B_COLS + colB]);
        if (ci < 64) XW[t * 64 + ci] = tanhf_(v); else if (ci < 128) XA[t * 64 + ci - 64] = v; else XG[t * 64 + ci - 128] = sigmoidf_(v);
    }
    __syncthreads();
    const int ch = C.tid & 255, half = C.tid >> 8, head = ch >> 6;
    bf16* wa_out = WSP(bf16, WS_HB); bf16* g_out = WSP(bf16, WS_G); float* bonus = WSP(float, WS_BONUS);
    const float* wup = C.in[I_RWUP] + (size_t)l * 2 * 32 * GW + ch;
    const float* aup = C.in[I_RAUP] + (size_t)l * 2 * 32 * GW + ch;
    const float* gup = C.in[I_RGUP] + (size_t)l * 64 * GW + ch;
    const float w00 = C.in[I_RW0][(l * 2 + 0) * GW + ch], w01 = C.in[I_RW0][(l * 2 + 1) * GW + ch];
    const float a00 = C.in[I_RA0][(l * 2 + 0) * GW + ch], a01 = C.in[I_RA0][(l * 2 + 1) * GW + ch];
    const float k_a = C.in[I_RKA][l * GW + ch], r_k = C.in[I_RRK][l * GW + ch];
    const float mur0 = mu[ch], mur1 = mu[B_COLS + ch], muk0 = mu[256 + ch], muk1 = mu[B_COLS + 256 + ch];
#pragma unroll 1
    for (int sub = 0; sub < 2; ++sub) {
        const int t0 = half * 32 + sub * 16;
        float acc[16], av0[16], av1[16];
#pragma unroll
        for (int kind = 0; kind < 4; ++kind) {
            const int d = kind & 1; const bool isw = kind < 2;
            const float* W = (isw ? wup : aup) + (size_t)d * 32 * GW; const LAS float* X = (isw ? XW : XA) + d * 32;
#pragma unroll
            for (int t = 0; t < 16; ++t) acc[t] = 0.f;
            for (int r = 0; r < 32; r += 4) {
                const float g0 = W[(r + 0) * GW], g1 = W[(r + 1) * GW], g2 = W[(r + 2) * GW], g3 = W[(r + 3) * GW];
#pragma unroll
                for (int t = 0; t < 16; ++t) { const f32x4 x = *(const LAS f32x4*)(X + (t0 + t) * 64 + r); acc[t] += x.x * g0 + x.y * g1 + x.z * g2 + x.w * g3; }
            }
#pragma unroll
            for (int t = 0; t < 16; ++t) {
                const size_t row = (size_t)(row0 + p0 + t0 + t);
                float val;
                if (isw) val = __expf(-0.6065306597126334f * sigmoidf_(acc[t] + (d ? w01 : w00)));
                else { val = sigmoidf_(acc[t] + (d ? a01 : a00)); if (d) av1[t] = val; else av0[t] = val; }
                wa_out[row * 1024 + kind * 256 + ch] = (bf16)f2bf1(val);
            }
        }
#pragma unroll
        for (int t = 0; t < 16; ++t) acc[t] = 0.f;
        for (int j = 0; j < 64; j += 4) {
            const float g0 = gup[(j + 0) * GW], g1 = gup[(j + 1) * GW], g2 = gup[(j + 2) * GW], g3 = gup[(j + 3) * GW];
#pragma unroll
            for (int t = 0; t < 16; ++t) { const f32x4 x = *(const LAS f32x4*)(XG + (t0 + t) * 64 + j); acc[t] += x.x * g0 + x.y * g1 + x.z * g2 + x.w * g3; }
        }
#pragma unroll
        for (int t = 0; t < 16; ++t) {
            const int p = p0 + t0 + t; const size_t row = (size_t)(row0 + p);
            g_out[row * 256 + ch] = (bf16)f2bf1(acc[t]);
            const float rs = rw_shift(P, row0, p, Lp, ch, mur0, mur1), ks = rw_shift(P, row0, p, Lp, 256 + ch, muk0, muk1);
            const float km = ks * (1.0f + (av0[t] - 1.0f) * k_a) + ks * (1.0f + (av1[t] - 1.0f) * k_a);
            const float bs = wave_sum(rs * r_k * km);
            if (C.lane == 0) bonus[row * 4 + head] = bs;
        }
    }
    __syncthreads();
}
__device__ __forceinline__ void rwkv_scan(const Ctx& C, int l, int idx) {
    const int d = idx >> 6, b = (idx >> 3) & 7, h = (idx >> 1) & 3, half = idx & 1;
    LAS float* BUF = (LAS float*)C.lds;
    LAS float* YB = BUF + 2 * 32 * 6 * 64;
    const bf16* P = WSP(const bf16, WS_P); const bf16* WA = WSP(const bf16, WS_HB); bf16* outb = WSP(bf16, WS_OUTB) + (size_t)d * T_ALL * 256;
    const int st = C.tid >> 4, q4 = C.tid & 15, chh = h * 64 + q4 * 4;
    const float* mu = C.in[I_RMU] + (size_t)l * 2 * B_COLS;
    f32x4 mu0[3], mu1[3];
#pragma unroll
    for (int q = 0; q < 3; ++q) { mu0[q] = *(const f32x4*)(mu + q * 256 + chh); mu1[q] = *(const f32x4*)(mu + B_COLS + q * 256 + chh); }
    const f32x4 kk_w = *(const f32x4*)(C.in[I_RKK] + l * GW + chh), ka_w = *(const f32x4*)(C.in[I_RKA] + l * GW + chh);
    v2u gxc[3], gxp[3], gxn[3], gwr, gar;
    auto gload = [&](int nb) {
        const int i = nb * 32 + st;
        const bool isctx = i < CTXL; const int Lp = isctx ? CTXL : SEQ; const int j = isctx ? i : i - CTXL; const int p = d ? (Lp - 1 - j) : j;
        const int row = (isctx ? T_LAT + b * CTXL : b * SEQ) + p;
#pragma unroll
        for (int q = 0; q < 3; ++q) {
            const bf16* pp = P + (size_t)row * PLD + OFF_B + q * 256 + chh;
            gxc[q] = *(const v2u*)pp; gxp[q] = (v2u){0u, 0u}; gxn[q] = (v2u){0u, 0u};
            if (p > 0) gxp[q] = *(const v2u*)(pp - PLD);
            if (p < Lp - 1) gxn[q] = *(const v2u*)(pp + PLD);
        }
        gwr = *(const v2u*)(WA + (size_t)row * 1024 + d * 256 + chh); gar = *(const v2u*)(WA + (size_t)row * 1024 + (2 + d) * 256 + chh);
    };
    auto sfinish = [&](int bufi) {
        f32x4 sh[3];
#pragma unroll
        for (int q = 0; q < 3; ++q) {
            const f32x4 x = (f32x4){bflo(gxc[q].x), bfhi(gxc[q].x), bflo(gxc[q].y), bfhi(gxc[q].y)}, pv = (f32x4){bflo(gxp[q].x), bfhi(gxp[q].x), bflo(gxp[q].y), bfhi(gxp[q].y)}, nx = (f32x4){bflo(gxn[q].x), bfhi(gxn[q].x), bflo(gxn[q].y), bfhi(gxn[q].y)};
            sh[q] = x + mu0[q] * (pv - x) + mu1[q] * (nx - x);
        }
        const f32x4 w = (f32x4){bflo(gwr.x), bfhi(gwr.x), bflo(gwr.y), bfhi(gwr.y)}, a = (f32x4){bflo(gar.x), bfhi(gar.x), bflo(gar.y), bfhi(gar.y)};
        f32x4 kk = sh[1] * kk_w;
        const float ss = row16_sum((kk.x * kk.x + kk.y * kk.y) + (kk.z * kk.z + kk.w * kk.w));
        kk = kk * (1.0f / sqrtf(ss + 1e-6f));
        const f32x4 km = sh[1] * ((a - 1.0f) * ka_w + 1.0f), beta = kk * a;
        LAS float* o = BUF + ((bufi * 32 + st) * 6) * 64 + q4 * 4;
        *(LAS f32x4*)(o + 0 * 64) = sh[0]; *(LAS f32x4*)(o + 1 * 64) = kk; *(LAS f32x4*)(o + 2 * 64) = w; *(LAS f32x4*)(o + 3 * 64) = beta; *(LAS f32x4*)(o + 4 * 64) = km; *(LAS f32x4*)(o + 5 * 64) = sh[2];
    };
    const int rr = C.tid >> 4, jq = C.tid & 15;
    f32x4 s = (f32x4){0.f, 0.f, 0.f, 0.f};
    constexpr int NBLK = NSTEP / 32;
    gload(0); sfinish(0); gload(1);
    __syncthreads();
    for (int nb = 0; nb < NBLK; ++nb) {
        if (nb + 1 < NBLK) { sfinish((nb + 1) & 1); if (nb + 2 < NBLK) gload(nb + 2); }
        const LAS float* bb = BUF + ((nb & 1) * 32) * 6 * 64;
        LAS float* yb = YB + (nb & 1) * 1024;
        const LAS float* o0 = bb + jq * 4; const LAS float* v0 = bb + 5 * 64 + half * 32 + rr;
        f32x4 r4 = *(const LAS f32x4*)(o0), kk = *(const LAS f32x4*)(o0 + 64), wv = *(const LAS f32x4*)(o0 + 128), be = *(const LAS f32x4*)(o0 + 192), km = *(const LAS f32x4*)(o0 + 256);
        float vv = v0[0];
#pragma unroll
        for (int hb = 0; hb < 2; ++hb) {
            float ysel = 0.f;
#pragma unroll
            for (int t16 = 0; t16 < 16; ++t16) {
                const int t = hb * 16 + t16;
                const f32x4 cr = r4, ck = kk, cw = wv, cb = be, cm_ = km; const float cv = vv;
                if (t + 1 < 32) { const LAS float* o = o0 + (t + 1) * 6 * 64;
                    r4 = *(const LAS f32x4*)(o); kk = *(const LAS f32x4*)(o + 64); wv = *(const LAS f32x4*)(o + 128); be = *(const LAS f32x4*)(o + 192); km = *(const LAS f32x4*)(o + 256); vv = v0[(t + 1) * 6 * 64]; }
                const float sk = row16_sum((s.x * ck.x + s.y * ck.y) + (s.z * ck.z + s.w * ck.w));
                s = s * cw - cb * sk + cm_ * cv;
                const float y = row16_sum((s.x * cr.x + s.y * cr.y) + (s.z * cr.z + s.w * cr.w));
                ysel = (jq == t16) ? y : ysel;
            }
            yb[(hb * 16 + jq) * 32 + rr] = ysel;
        }
        __syncthreads();
        {
            const int t = C.tid >> 4, r2 = (C.tid & 15) * 2;
            const int i = nb * 32 + t; const int row = seqrow_raster(i, d, b);
            *(unsigned*)(outb + (size_t)row * 256 + h * 64 + half * 32 + r2) = pk2(yb[t * 32 + r2], yb[t * 32 + r2 + 1]);
        }
    }
    __syncthreads();
}

#define RAW_BARRIER() do { asm volatile("s_waitcnt lgkmcnt(0)" ::: "memory"); __builtin_amdgcn_s_barrier(); asm volatile("" ::: "memory"); } while (0)
__device__ __forceinline__ void mlstm_scan_v0(const Ctx& C, int l, int idx) {
    const int d = idx >> 5, b = (idx >> 2) & 7, h = idx & 3, lane = C.lane, w = C.wave;
    LAS float* PN = (LAS float*)C.lds;
    LAS float* PD = PN + 2 * 8 * 64;
    LAS unsigned char* SB = C.lds + 8192;
    constexpr int SBS = 3 * 4096 + 256;
    const bf16* P = WSP(const bf16, WS_P); bf16* outc = WSP(bf16, WS_OUTC) + (size_t)d * T_ALL * 256;
    const float ib = C.in[I_MIB][(l * 2 + d) * NH + h], fb = C.in[I_MFB][(l * 2 + d) * NH + h];
    const int st_ = C.tid >> 4, part = C.tid & 15;
    auto stage = [&](int nb, int bufi) {
        const int row = seqrow_cm(nb * 32 + st_, d, b);
        const size_t ro = (size_t)row * PLD + OFF_C + h * 64 + part * 4;
        LAS unsigned char* sb = SB + bufi * SBS;
        *(LAS v2u*)(sb + st_ * 128 + part * 8) = *(const v2u*)(P + ro);
        *(LAS v2u*)(sb + 4096 + st_ * 128 + part * 8) = *(const v2u*)(P + ro + 256);
        *(LAS v2u*)(sb + 8192 + st_ * 128 + part * 8) = *(const v2u*)(P + ro + 512);
        if (part == 0) { const size_t rg = (size_t)row * PLD + OFF_C + 1024;
            const float li = bf2f(P[rg + d * 4 + h]) + ib, gf = bf2f(P[rg + 8 + d * 4 + h]) + fb;
            *(LAS f32x2*)(sb + 12288 + st_ * 8) = (f32x2){li, -softplusf_(-gf)}; }
    };
    float Cm[8], nk[8];
#pragma unroll
    for (int k = 0; k < 8; ++k) { Cm[k] = 0.f; nk[k] = 0.f; }
    float m = 0.f;
    stage(0, 0);
    __syncthreads();
    for (int nb = 0; nb < NSTEP / 32; ++nb) {
        if (nb + 1 < NSTEP / 32) stage(nb + 1, (nb + 1) & 1);
        const LAS unsigned char* sb = SB + (nb & 1) * SBS;
#pragma unroll 2
        for (int t = 0; t < 32; ++t) {
            const int i = nb * 32 + t;
            const v4u cq = *(const LAS v4u*)(sb + t * 128 + w * 16), ck = *(const LAS v4u*)(sb + 4096 + t * 128 + w * 16);
            const float vv = bf2f(*(const LAS unsigned short*)(sb + 8192 + t * 128 + lane * 2));
            const f32x2 gt = *(const LAS f32x2*)(sb + 12288 + t * 8);
            const float li = gt.x, lf = gt.y;
            const float mn = fmaxf(lf + m, li), fp = __expf(lf + m - mn), ip = __expf(li - mn);
            const float qf[8] = {bflo(cq.x), bfhi(cq.x), bflo(cq.y), bfhi(cq.y), bflo(cq.z), bfhi(cq.z), bflo(cq.w), bfhi(cq.w)};
            const float kf[8] = {bflo(ck.x), bfhi(ck.x), bflo(ck.y), bfhi(ck.y), bflo(ck.z), bfhi(ck.z), bflo(ck.w), bfhi(ck.w)};
            const float ipv = ip * vv;
            float num = 0.f, den = 0.f;
#pragma unroll
            for (int k = 0; k < 8; ++k) { const float kk = kf[k] * 0.125f; Cm[k] = fp * Cm[k] + ipv * kk; nk[k] = fp * nk[k] + ip * kk; num += Cm[k] * qf[k]; den += nk[k] * qf[k]; }
            m = mn;
            const int pb_ = i & 1;
            PN[(pb_ * 8 + w) * 64 + lane] = num; if (lane == 0) PD[pb_ * 8 + w] = den;
            RAW_BARRIER();
            if (w == 0) {
                float ns = 0.f, ds = 0.f;
#pragma unroll
                for (int ww = 0; ww < 8; ++ww) { ns += PN[(pb_ * 8 + ww) * 64 + lane]; ds += PD[pb_ * 8 + ww]; }
                outc[(size_t)seqrow_cm(i, d, b) * 256 + h * 64 + lane] = (bf16)f2bf1(ns / fmaxf(fabsf(ds), __expf(-mn)));
            }
        }
        __syncthreads();
    }
}

__device__ __forceinline__ void gdn_prep(const Ctx& C, int l, int b, int c) {
    const bf16* P = WSP(const bf16, WS_P); bf16* gq = WSP(bf16, WS_GQ);
    const bool isctx = c < 4; const int p0 = isctx ? c * 64 : (c - 4) * 64; const int Lp = isctx ? CTXL : SEQ;
    const int ch = 4 * C.lane;
    auto rowof = [&](int p) -> int { return isctx ? (T_LAT + b * CTXL + p) : (b * SEQ + (p & 63) * 64 + (p >> 6)); };
    f32x4 cw[4][3], x[4][3];
#pragma unroll
    for (int j = 0; j < 4; ++j)
#pragma unroll
        for (int g = 0; g < 3; ++g) cw[j][g] = *(const f32x4*)(C.in[I_GCW] + ((size_t)l * 4 + j) * 768 + g * 256 + ch);
    const int tb = p0 + C.wave * 8;
    auto ldrow = [&](int p, f32x4 (&dst)[3]) {
        if (p >= 0 && p < Lp) { const bf16* pr = P + (size_t)rowof(p) * PLD + OFF_D + ch;
#pragma unroll
            for (int g = 0; g < 3; ++g) dst[g] = ld4bf(pr + g * 256); }
        else {
#pragma unroll
            for (int g = 0; g < 3; ++g) dst[g] = (f32x4){0.f, 0.f, 0.f, 0.f}; }
    };
    ldrow(tb - 2, x[0]); ldrow(tb - 1, x[1]); ldrow(tb, x[2]);
#pragma unroll
    for (int t = 0; t < 8; ++t) {
        ldrow(tb + t + 1, x[3]);
        bf16* orow = gq + (size_t)rowof(tb + t) * 768 + ch;
#pragma unroll
        for (int g = 0; g < 3; ++g) {
            f32x4 v = cw[0][g] * x[0][g] + cw[1][g] * x[1][g] + cw[2][g] * x[2][g] + cw[3][g] * x[3][g];
            v = (f32x4){siluf_(v.x), siluf_(v.y), siluf_(v.z), siluf_(v.w)};
            if (g < 2) { const float ss = row16_sum((v.x * v.x + v.y * v.y) + (v.z * v.z + v.w * v.w)); v = v * ((1.0f / sqrtf(ss + 1e-6f)) * (g == 0 ? 0.125f : 1.0f)); }
            st4bf(orow + g * 256, v);
        }
#pragma unroll
        for (int g = 0; g < 3; ++g) { x[0][g] = x[1][g]; x[1][g] = x[2][g]; x[2][g] = x[3][g]; }
    }
}
__device__ __forceinline__ void gdn_scan_v0(const Ctx& C, int l, int idx) {
    const int d = idx >> 5, b = (idx >> 2) & 7, h = idx & 3, lane = C.lane, w = C.wave;
    LAS float* PA = (LAS float*)C.lds;
    LAS float* PB = PA + 2 * 8 * 64;
    LAS unsigned char* SB = C.lds + 8192;
    constexpr int SBS = 3 * 4096 + 256;
    const bf16* P = WSP(const bf16, WS_P); const bf16* gq = WSP(const bf16, WS_GQ); bf16* outd = WSP(bf16, WS_OUTD) + (size_t)d * T_ALL * 256;
    const float aexp = __expf(C.in[I_GALOG][(l * 2 + d) * NH + h]), dtb = C.in[I_GDTB][(l * 2 + d) * NH + h];
    const int st_ = C.tid >> 4, part = C.tid & 15;
    auto stage = [&](int nb, int bufi) {
        const int row = seqrow_cm(nb * 32 + st_, d, b);
        const size_t rq = (size_t)row * 768 + h * 64 + part * 4;
        LAS unsigned char* sb = SB + bufi * SBS;
        *(LAS v2u*)(sb + st_ * 128 + part * 8) = *(const v2u*)(gq + rq);
        *(LAS v2u*)(sb + 4096 + st_ * 128 + part * 8) = *(const v2u*)(gq + rq + 256);
        *(LAS v2u*)(sb + 8192 + st_ * 128 + part * 8) = *(const v2u*)(gq + rq + 512);
        if (part == 0) { const size_t ro = (size_t)row * PLD + OFF_D + 1024;
            const float ga = bf2f(P[ro + d * 4 + h]), gb = bf2f(P[ro + 8 + d * 4 + h]);
            *(LAS f32x2*)(sb + 12288 + st_ * 8) = (f32x2){__expf(-aexp * softplusf_(ga + dtb)), sigmoidf_(gb)}; }
    };
    float S[8];
#pragma unroll
    for (int k = 0; k < 8; ++k) S[k] = 0.f;
    stage(0, 0);
    __syncthreads();
    int prow = 0;
    for (int nb = 0; nb < NSTEP / 32; ++nb) {
        if (nb + 1 < NSTEP / 32) stage(nb + 1, (nb + 1) & 1);
        const LAS unsigned char* sb = SB + (nb & 1) * SBS;
#pragma unroll 2
        for (int t = 0; t < 32; ++t) {
            const int i = nb * 32 + t;
            const v4u cq = *(const LAS v4u*)(sb + t * 128 + w * 16), ck = *(const LAS v4u*)(sb + 4096 + t * 128 + w * 16);
            const float vv = bf2f(*(const LAS unsigned short*)(sb + 8192 + t * 128 + lane * 2));
            const f32x2 gt = *(const LAS f32x2*)(sb + 12288 + t * 8);
            const float alpha = gt.x, beta = gt.y;
            const float qf[8] = {bflo(cq.x), bfhi(cq.x), bflo(cq.y), bfhi(cq.y), bflo(cq.z), bfhi(cq.z), bflo(cq.w), bfhi(cq.w)};
            const float kf[8] = {bflo(ck.x), bfhi(ck.x), bflo(ck.y), bfhi(ck.y), bflo(ck.z), bfhi(ck.z), bflo(ck.w), bfhi(ck.w)};
            float ks = 0.f;
#pragma unroll
            for (int k = 0; k < 8; ++k) ks += kf[k] * S[k];
            const int pb_ = i & 1;
            PA[(pb_ * 8 + w) * 64 + lane] = ks;
            RAW_BARRIER();
            if (w == 0 && i > 0) {
                float os = 0.f;
#pragma unroll
                for (int ww = 0; ww < 8; ++ww) os += PB[((pb_ ^ 1) * 8 + ww) * 64 + lane];
                outd[(size_t)prow * 256 + h * 64 + lane] = (bf16)f2bf1(os);
            }
            float kS = 0.f;
#pragma unroll
            for (int ww = 0; ww < 8; ++ww) kS += PA[(pb_ * 8 + ww) * 64 + lane];
            const float coef = beta * (vv - alpha * kS);
            float o = 0.f;
#pragma unroll
            for (int k = 0; k < 8; ++k) { S[k] = alpha * S[k] + kf[k] * coef; o += qf[k] * S[k]; }
            PB[(pb_ * 8 + w) * 64 + lane] = o;
            prow = seqrow_cm(i, d, b);
        }
        __syncthreads();
    }
    if (w == 0) {
        float os = 0.f;
#pragma unroll
        for (int ww = 0; ww < 8; ++ww) os += PB[(((NSTEP - 1) & 1) * 8 + ww) * 64 + lane];
        outd[(size_t)prow * 256 + h * 64 + lane] = (bf16)f2bf1(os);
    }
    __syncthreads();
}

__device__ __forceinline__ void finish_rows(const Ctx& C, int l, int nrows) {
    const bf16* P = WSP(const bf16, WS_P); bf16* yc = WSP(bf16, WS_HB);
    const bf16* ob = WSP(const bf16, WS_OUTB); const bf16* oc = WSP(const bf16, WS_OUTC); const bf16* od = WSP(const bf16, WS_OUTD);
    const bf16* gg = WSP(const bf16, WS_G); const float* bonus = WSP(const float, WS_BONUS);
    const float* mu = C.in[I_RMU] + (size_t)l * 2 * B_COLS;
    const int gw = C.wg * NWAVES + C.wave, NGW = C.G * NWAVES, lane = C.lane, ch = 4 * lane, hh = lane >> 4;
    const f32x4 lng = *(const f32x4*)(C.in[I_RLNG] + l * GW + ch), lnb = *(const f32x4*)(C.in[I_RLNB] + l * GW + ch);
    const f32x4 mng = *(const f32x4*)(C.in[I_MNG] + l * GW + ch), gng = *(const f32x4*)(C.in[I_GNG] + l * GW + ch);
    const f32x4 mu0 = *(const f32x4*)(mu + 512 + ch), mu1 = *(const f32x4*)(mu + B_COLS + 512 + ch);
    const size_t o2 = (size_t)T_ALL * 256;
#pragma unroll 2
    for (int m = gw; m < nrows; m += NGW) {
        const bool isctx = m >= T_LAT; const int Lp = isctx ? CTXL : SEQ; const int p = isctx ? ((m - T_LAT) & (CTXL - 1)) : (m & (SEQ - 1));
        const f32x4 yb = ld4bf(ob + (size_t)m * 256 + ch) + ld4bf(ob + o2 + (size_t)m * 256 + ch);
        const f32x4 ycv = ld4bf(oc + (size_t)m * 256 + ch) + ld4bf(oc + o2 + (size_t)m * 256 + ch);
        const f32x4 yd = ld4bf(od + (size_t)m * 256 + ch) + ld4bf(od + o2 + (size_t)m * 256 + ch);
        const bf16* pr = P + (size_t)m * PLD;
        const f32x4 vs = ld4bf(WSP(const bf16, WS_RKV) + (size_t)m * 768 + 512 + ch);
        const f32x4 og = ld4bf(pr + OFF_C + 768 + ch), gd = ld4bf(pr + OFF_D + 768 + ch), gr = ld4bf(gg + (size_t)m * 256 + ch);
        const float bn = bonus[(size_t)m * 4 + hh];
        *(v2u*)(yc + (size_t)m * 1024 + ch) = *(const v2u*)(pr + 256 + ch);
        {
            const float mean = row16_sum((yb.x + yb.y) + (yb.z + yb.w)) * (1.0f / 64.0f);
            const f32x4 dl = yb - mean;
            const float var = row16_sum((dl.x * dl.x + dl.y * dl.y) + (dl.z * dl.z + dl.w * dl.w)) * (1.0f / 64.0f);
            const f32x4 yn = dl * (1.0f / sqrtf(var + 64e-5f)) * lng + lnb;
            st4bf(yc + (size_t)m * 1024 + 256 + ch, (yn + vs * bn) * gr);
        }
        {
            const float ms = row16_sum((ycv.x * ycv.x + ycv.y * ycv.y) + (ycv.z * ycv.z + ycv.w * ycv.w)) * (1.0f / 64.0f);
            const f32x4 sg = (f32x4){sigmoidf_(og.x), sigmoidf_(og.y), sigmoidf_(og.z), sigmoidf_(og.w)};
            st4bf(yc + (size_t)m * 1024 + 512 + ch, ycv * (1.0f / sqrtf(ms + 1e-6f)) * mng * sg);
        }
        {
            const float ms = row16_sum((yd.x * yd.x + yd.y * yd.y) + (yd.z * yd.z + yd.w * yd.w)) * (1.0f / 64.0f);
            const f32x4 sg = (f32x4){siluf_(gd.x), siluf_(gd.y), siluf_(gd.z), siluf_(gd.w)};
            st4bf(yc + (size_t)m * 1024 + 768 + ch, yd * (1.0f / sqrtf(ms + 1e-6f)) * gng * sg);
        }
    }
}
typedef bf16x8 fragb;
__device__ __forceinline__ f32x4 mfma16(fragb a, fragb b, f32x4 c) { return __builtin_amdgcn_mfma_f32_16x16x32_bf16(a, b, c, 0, 0, 0); }
__device__ __forceinline__ fragb ld_frag16(const LAS bf16* p) { return *(const LAS fragb*)p; }
__device__ __forceinline__ fragb ld_frag8x2(const LAS bf16* p0, const LAS bf16* p1) {
    const v2u a = *(const LAS v2u*)p0, b = *(const LAS v2u*)p1; v4u r; r.x = a.x; r.y = a.y; r.z = b.x; r.w = b.y; return __builtin_bit_cast(fragb, r); }
__device__ __forceinline__ fragb pack_frag(const f32x4& lo, const f32x4& hi) { v4u r; r.x = pk2(lo.x, lo.y); r.y = pk2(lo.z, lo.w); r.z = pk2(hi.x, hi.y); r.w = pk2(hi.z, hi.w); return __builtin_bit_cast(fragb, r); }
template <int CTRL, int RM, bool BC> __device__ __forceinline__ float dpp_x(float oldv, float v) { return __builtin_bit_cast(float, __builtin_amdgcn_update_dpp(__builtin_bit_cast(int, oldv), __builtin_bit_cast(int, v), CTRL, RM, 0xF, BC)); }
__device__ __forceinline__ float wave_incl_sum(float v, int lane) {
    v += dpp_x<0x111, 0xF, true>(0.f, v); v += dpp_x<0x112, 0xF, true>(0.f, v); v += dpp_x<0x114, 0xF, true>(0.f, v); v += dpp_x<0x118, 0xF, true>(0.f, v);
    v += dpp_x<0x142, 0xA, false>(0.f, v); v += dpp_x<0x143, 0xC, false>(0.f, v);
    return v;
}
__device__ __forceinline__ float wave_incl_max(float v, int lane) {
    const float ninf = -3.0e38f;
    v = fmaxf(v, dpp_x<0x111, 0xF, false>(ninf, v)); v = fmaxf(v, dpp_x<0x112, 0xF, false>(ninf, v)); v = fmaxf(v, dpp_x<0x114, 0xF, false>(ninf, v)); v = fmaxf(v, dpp_x<0x118, 0xF, false>(ninf, v));
    v = fmaxf(v, dpp_x<0x142, 0xA, false>(ninf, v)); v = fmaxf(v, dpp_x<0x143, 0xC, false>(ninf, v));
    return v;
}
constexpr int MP = 72;
__device__ __forceinline__ void mlstm_chunked(const Ctx& C, int l, int idx) {
    const int d = idx >> 5, b = (idx >> 2) & 7, h = idx & 3, lane = C.lane, w = C.wave, l15 = lane & 15, q = lane >> 4;
    const int it = w & 3, vtp = w >> 2;
    constexpr int IMG = 64 * MP * 2, BUFB = 4 * IMG + 1024, CTB = 65 * MP * 2 + 16;
    LAS unsigned char* L0 = C.lds;
    const bf16* P = WSP(const bf16, WS_P); bf16* outc = WSP(bf16, WS_OUTC) + (size_t)d * T_ALL * 256;
    const float ib = C.in[I_MIB][(l * 2 + d) * NH + h], fb = C.in[I_MFB][(l * 2 + d) * NH + h];
    const int tt = C.tid >> 3, part = C.tid & 7;
    for (int i = C.tid; i < 2 * CTB / 4; i += NTHR) ((LAS unsigned*)(L0 + 2 * BUFB))[i] = 0u;
    v4u rq, rk, rv; unsigned short rgi, rgf;
    auto gload = [&](int n) {
        const int row = seqrow_cm(n * 64 + tt, d, b);
        const bf16* pp = P + (size_t)row * PLD + OFF_C + h * 64 + 8 * part;
        rq = *(const v4u*)pp; rk = *(const v4u*)(pp + 256); rv = *(const v4u*)(pp + 512);
        const bf16* pg = P + (size_t)seqrow_cm(n * 64 + lane, d, b) * PLD + OFF_C + 1024 + d * 4 + h;
        rgi = pg[0]; rgf = pg[8];
    };
    auto images = [&](int bufi) {
        LAS unsigned char* B0 = L0 + bufi * BUFB;
        LAS bf16* Qs = (LAS bf16*)B0; LAS bf16* Ks = Qs + 64 * MP; LAS bf16* VT = Ks + 64 * MP; LAS bf16* KTw = VT + 64 * MP; LAS float* vec = (LAS float*)(B0 + 4 * IMG);
        const float li = bf2f(rgi) + ib, lf = -softplusf_(-(bf2f(rgf) + fb));
        const float bc = wave_incl_sum(lf, lane), x = li - bc, cm = wave_incl_max(x, lane);
        const float wl = __expf(x - __shfl(cm, 63)) * 0.125f;
        if (w == 0) { vec[lane] = x; vec[64 + lane] = cm; vec[128 + lane] = bc; }
        const float wmine = __shfl(wl, 8 * w + (lane >> 3));
        *(LAS v4u*)(Qs + tt * MP + 8 * part) = rq; *(LAS v4u*)(Ks + tt * MP + 8 * part) = rk;
        const unsigned vv[4] = {rv.x, rv.y, rv.z, rv.w}, kk[4] = {rk.x, rk.y, rk.z, rk.w};
#pragma unroll
        for (int e = 0; e < 4; ++e) {
            VT[(8 * part + 2 * e) * MP + tt] = (bf16)(vv[e] & 0xffffu); VT[(8 * part + 2 * e + 1) * MP + tt] = (bf16)(vv[e] >> 16);
            KTw[(8 * part + 2 * e) * MP + tt] = (bf16)f2bf1(bflo(kk[e]) * wmine); KTw[(8 * part + 2 * e + 1) * MP + tt] = (bf16)f2bf1(bfhi(kk[e]) * wmine);
        }
    };
    f32x4 Cst[2], nst; float m = 0.f;
    Cst[0] = Cst[1] = nst = (f32x4){0.f, 0.f, 0.f, 0.f};
    const fragb ones = __builtin_bit_cast(fragb, (v4u){0x3F803F80u, 0x3F803F80u, 0x3F803F80u, 0x3F803F80u});
    const f32x4 z4 = (f32x4){0.f, 0.f, 0.f, 0.f};
    gload(0); images(0); gload(1);
#pragma unroll 1
    for (int n = 0; n < NCH; ++n) {
        RAW_BARRIER();
        const LAS unsigned char* B0 = L0 + (n & 1) * BUFB;
        const LAS bf16* Qs = (const LAS bf16*)B0; const LAS bf16* Ks = Qs + 64 * MP; const LAS bf16* VT = Ks + 64 * MP; const LAS bf16* KTw = VT + 64 * MP; const LAS float* vec = (const LAS float*)(B0 + 4 * IMG);
        const LAS bf16* CT = (const LAS bf16*)(L0 + 2 * BUFB + (n & 1) * CTB); LAS bf16* CTn = (LAS bf16*)(L0 + 2 * BUFB + ((n + 1) & 1) * CTB);
        fragb Qf[2]; Qf[0] = ld_frag16(Qs + (16 * it + l15) * MP + 8 * q); Qf[1] = ld_frag16(Qs + (16 * it + l15) * MP + 32 + 8 * q);
        const float cmi = vec[64 + 16 * it + l15]; const int icol = 16 * it + l15;
        f32x4 pt[4];
#pragma unroll
        for (int jt = 0; jt < 4; ++jt) {
            pt[jt] = z4;
            if (jt <= it) {
                const fragb k0 = ld_frag16(Ks + (16 * jt + l15) * MP + 8 * q), k1 = ld_frag16(Ks + (16 * jt + l15) * MP + 32 + 8 * q);
                f32x4 st = mfma16(k0, Qf[0], z4); st = mfma16(k1, Qf[1], st);
                const f32x4 xj = *(const LAS f32x4*)(vec + 16 * jt + 4 * q);
#pragma unroll
                for (int r = 0; r < 4; ++r) { const int j = 16 * jt + 4 * q + r; pt[jt][r] = (j <= icol) ? st[r] * __expf(xj[r] - cmi) * 0.125f : 0.f; }
            }
        }
        fragb Pf[2]; Pf[0] = pack_frag(pt[0], pt[1]); Pf[1] = pack_frag(pt[2], pt[3]);
        fragb Vf[2][2];
#pragma unroll
        for (int v2 = 0; v2 < 2; ++v2)
#pragma unroll
            for (int s = 0; s < 2; ++s) { const LAS bf16* vr = VT + (16 * (2 * vtp + v2) + l15) * MP + 32 * s + 4 * q; Vf[v2][s] = ld_frag8x2(vr, vr + 16); }
        f32x4 Aacc[2], R[2], as, dn;
        as = mfma16(Pf[0], ones, z4); if (it >= 2) as = mfma16(Pf[1], ones, as);
        const fragb nf0 = ld_frag16(CT + 64 * MP + 8 * q), nf1 = ld_frag16(CT + 64 * MP + 32 + 8 * q);
        dn = mfma16(Qf[0], nf0, z4); dn = mfma16(Qf[1], nf1, dn);
#pragma unroll
        for (int v2 = 0; v2 < 2; ++v2) {
            Aacc[v2] = mfma16(Pf[0], Vf[v2][0], z4); if (it >= 2) Aacc[v2] = mfma16(Pf[1], Vf[v2][1], Aacc[v2]);
            const LAS bf16* cr = CT + (16 * (2 * vtp + v2) + l15) * MP + 8 * q;
            R[v2] = mfma16(Qf[0], ld_frag16(cr), z4); R[v2] = mfma16(Qf[1], ld_frag16(cr + 32), R[v2]);
        }
        {
            const f32x4 bi = *(const LAS f32x4*)(vec + 128 + 16 * it + 4 * q), cmr = *(const LAS f32x4*)(vec + 64 + 16 * it + 4 * q);
#pragma unroll
            for (int r = 0; r < 4; ++r) {
                const float mi = bi[r] + cmr[r], minter = bi[r] + m, mt = fmaxf(minter, mi), e1 = __expf(mi - mt), e2 = __expf(minter - mt);
                const float den = e1 * as[r] + e2 * dn[r]; const float inv = 1.0f / fmaxf(fabsf(den), __expf(-mt));
                const int row = seqrow_cm(n * 64 + 16 * it + 4 * q + r, d, b);
#pragma unroll
                for (int v2 = 0; v2 < 2; ++v2) outc[(size_t)row * 256 + h * 64 + 16 * (2 * vtp + v2) + l15] = (bf16)f2bf1((e1 * Aacc[v2][r] + e2 * R[v2][r]) * inv);
            }
        }
        {
            const LAS bf16* kr = KTw + (16 * it + l15) * MP + 4 * q;
            const fragb kt0 = ld_frag8x2(kr, kr + 16), kt1 = ld_frag8x2(kr + 32, kr + 48);
            const float bL = vec[128 + 63], mloc = bL + vec[64 + 63];
            const float mnew = fmaxf(bL + m, mloc), wp = __expf(bL + m - mnew), wn = __expf(mloc - mnew);
            f32x4 gk = mfma16(kt0, ones, z4); gk = mfma16(kt1, ones, gk);
            nst = nst * wp + gk * wn;
#pragma unroll
            for (int v2 = 0; v2 < 2; ++v2) {
                f32x4 G = mfma16(kt0, Vf[v2][0], z4); G = mfma16(kt1, Vf[v2][1], G);
                Cst[v2] = Cst[v2] * wp + G * wn;
                v2u o; o.x = pk2(Cst[v2].x, Cst[v2].y); o.y = pk2(Cst[v2].z, Cst[v2].w);
                *(LAS v2u*)(CTn + (16 * (2 * vtp + v2) + l15) * MP + 16 * it + 4 * q) = o;
            }
            if (vtp == 0 && l15 == 0) { v2u o; o.x = pk2(nst.x, nst.y); o.y = pk2(nst.z, nst.w); *(LAS v2u*)(CTn + 64 * MP + 16 * it + 4 * q) = o; }
            m = mnew;
        }
        if (n + 1 < NCH) { images((n + 1) & 1); if (n + 2 < NCH) gload(n + 2); }
    }
    __syncthreads();
}
__device__ __forceinline__ int fwd_row_cm(int b, int c, int t) { return c < 4 ? (T_LAT + b * CTXL + c * 64 + t) : (b * SEQ + t * 64 + (c - 4)); }
__device__ __forceinline__ bf16* blob_row(const Ctx& C, int d, int isw, int b, int c, int h, int r) {
    const int row = fwd_row_cm(b, c, r);
    if (d == 1 && isw) return WSP(bf16, WS_OUTD) + ((size_t)T_ALL + row) * 256 + h * 64;
    return WSP(bf16, WS_P) + (size_t)row * PLD + OFF_D + (d * 2 + isw) * 256 + h * 64;
}
constexpr int LP = 68;
__device__ __forceinline__ void blocked_solve(const LAS bf16* Ln, const LAS bf16* TinvP, LAS unsigned char* XTw, f32x4 (&acc)[4][4], int l15, int q) {
    const f32x4 z4 = (f32x4){0.f, 0.f, 0.f, 0.f};
#pragma unroll
    for (int I = 0; I < 4; ++I) {
        const fragb Af = *(const LAS fragb*)(TinvP + (I * 16 + l15) * 32 + 8 * q);
        fragb A0, A1;
        if (I >= 1) A0 = ld_frag16(Ln + (16 * I + l15) * MP + 8 * q);
        if (I == 3) A1 = ld_frag16(Ln + (16 * I + l15) * MP + 32 + 8 * q);
#pragma unroll
        for (int nt = 0; nt < 4; ++nt) {
            const int crow = 16 * nt + l15; LAS unsigned char* xr = XTw + crow * 128;
            f32x4 a = acc[I][nt];
            if (I >= 1) a = mfma16(A0, *(const LAS fragb*)(xr + ((q ^ (crow & 7)) << 4)), a);
            if (I == 3) a = mfma16(A1, *(const LAS fragb*)(xr + (((4 + q) ^ (crow & 7)) << 4)), a);
            v4u bw; bw.x = pk2(a.x, a.y); bw.y = pk2(a.z, a.w); bw.z = 0u; bw.w = 0u;
            const f32x4 x = mfma16(Af, __builtin_bit_cast(fragb, bw), z4);
            acc[I][nt] = x;
            v2u o; o.x = pk2(x.x, x.y); o.y = pk2(x.z, x.w);
            *(LAS v2u*)(xr + (((2 * I + (q >> 1)) ^ (crow & 7)) << 4) + (q & 1) * 8) = o;
        }
    }
}
__device__ __forceinline__ void diag_inverses(const LAS bf16* Ln, LAS bf16* TinvP, int lane) {
    const int blk = lane >> 4, c = lane & 15;
    float x[16];
#pragma unroll
    for (int i = 0; i < 16; ++i) {
        const LAS bf16* lr = Ln + (16 * blk + i) * MP + 16 * blk;
        const v4u r0 = *(const LAS v4u*)lr, r1 = *(const LAS v4u*)(lr + 8);
        const unsigned rw[8] = {r0.x, r0.y, r0.z, r0.w, r1.x, r1.y, r1.z, r1.w};
        float s = (i == c) ? 1.0f : 0.0f;
#pragma unroll
        for (int j = 0; j < i; ++j) s += ((j & 1) ? bfhi(rw[j >> 1]) : bflo(rw[j >> 1])) * x[j];
        x[i] = s;
        TinvP[(blk * 16 + i) * 32 + 8 * (c >> 2) + (c & 3)] = (bf16)f2bf1(s);
    }
}
__device__ __forceinline__ void gdn_solve_item(const Ctx& C, int l, int item) {
    const int lane = C.lane, w = C.wave, pw = w & 1, pi = w >> 1, l15 = lane & 15, q = lane >> 4;
    LAS unsigned char* B0 = C.lds + pi * 31744;
    LAS bf16* Ln = (LAS bf16*)B0;
    LAS bf16* TinvP = (LAS bf16*)(B0 + 9216);
    LAS float* vec = (LAS float*)(B0 + 13312);
    LAS unsigned char* XT = B0 + 13824;
    LAS bf16* Ks = (LAS bf16*)XT;
    const bf16* P = WSP(const bf16, WS_P); const bf16* gq = WSP(const bf16, WS_GQ);
    const int u = item >> 1, d = item & 1;
    const int c = u % NCH, h = (u / NCH) & 3, b = u / (NCH * NH);
    const int n = d ? (c < 4 ? 3 - c : 71 - c) : c;
    const float aexp = __expf(C.in[I_GALOG][(l * 2 + d) * NH + h]), dtb = C.in[I_GDTB][(l * 2 + d) * NH + h];
    const int rowl = seqrow_cm(n * 64 + lane, d, b);
    const bf16* pg = P + (size_t)rowl * PLD + OFF_D + 1024 + d * 4 + h;
    const float la = -aexp * softplusf_(bf2f(pg[0]) + dtb), beta = sigmoidf_(bf2f(pg[8]));
    const float gam = wave_incl_sum(la, lane);
    if (pw == 0) { vec[lane] = beta; vec[64 + lane] = gam; }
#pragma unroll
    for (int r = 0; r < 4; ++r) { const int idx = pw * 64 + lane + 128 * r, t = idx >> 3, part = idx & 7;
        *(LAS v4u*)(Ks + t * MP + 8 * part) = *(const v4u*)(gq + (size_t)seqrow_cm(n * 64 + t, d, b) * 768 + 256 + h * 64 + 8 * part); }
    { LAS v4u* tz = (LAS v4u*)(B0 + 9216) + (pw * 64 + lane) * 2; tz[0] = (v4u){0u, 0u, 0u, 0u}; tz[1] = (v4u){0u, 0u, 0u, 0u}; }
    f32x4 acc[4][4];
    if (pw == 0) {
#pragma unroll
        for (int I = 0; I < 4; ++I)
#pragma unroll
            for (int r = 0; r < 4; ++r) { const bf16* vr = gq + (size_t)seqrow_cm(n * 64 + 16 * I + 4 * q + r, d, b) * 768 + 512 + h * 64 + l15;
#pragma unroll
                for (int nt = 0; nt < 4; ++nt) acc[I][nt][r] = bf2f(vr[16 * nt]); }
    }
    __syncthreads();
    {
        int tix = 0;
#pragma unroll
        for (int it = 0; it < 4; ++it)
#pragma unroll
            for (int jt = 0; jt < 4; ++jt, ++tix) if ((tix & 1) == pw) {
                f32x4 t4 = (f32x4){0.f, 0.f, 0.f, 0.f};
                if (jt <= it) {
#pragma unroll
                    for (int s = 0; s < 2; ++s) t4 = mfma16(ld_frag16(Ks + (16 * it + l15) * MP + 32 * s + 8 * q), ld_frag16(Ks + (16 * jt + l15) * MP + 32 * s + 8 * q), t4);
                    const float gj = vec[64 + 16 * jt + l15];
                    const f32x4 bi = *(const LAS f32x4*)(vec + 16 * it + 4 * q), gi = *(const LAS f32x4*)(vec + 64 + 16 * it + 4 * q);
#pragma unroll
                    for (int r = 0; r < 4; ++r) { const int i = 16 * it + 4 * q + r, j = 16 * jt + l15; t4[r] = (j < i) ? -(bi[r] * t4[r] * __expf(gi[r] - gj)) : 0.f; }
                }
#pragma unroll
                for (int r = 0; r < 4; ++r) Ln[(16 * it + 4 * q + r) * MP + 16 * jt + l15] = (bf16)f2bf1(t4[r]);
            }
    }
    {
#pragma unroll
        for (int I = 0; I < 4; ++I) {
            const f32x4 bi = *(const LAS f32x4*)(vec + 16 * I + 4 * q), gi = *(const LAS f32x4*)(vec + 64 + 16 * I + 4 * q);
#pragma unroll
            for (int r = 0; r < 4; ++r) { const float sc = pw ? bi[r] * __expf(gi[r]) : bi[r];
#pragma unroll
                for (int nt = 0; nt < 4; ++nt) acc[I][nt][r] = (pw ? bf2f(Ks[(16 * I + 4 * q + r) * MP + 16 * nt + l15]) : acc[I][nt][r]) * sc; }
        }
    }
    __syncthreads();
    if (pw == 0) diag_inverses(Ln, TinvP, lane);
    LAS unsigned char* XTw = XT + pw * 8192;
    { LAS v4u* xz = (LAS v4u*)(XTw + lane * 128);
#pragma unroll
        for (int g = 0; g < 8; ++g) xz[g] = (v4u){0u, 0u, 0u, 0u}; }
    __syncthreads();
    blocked_solve(Ln, TinvP, XTw, acc, l15, q);
    {
        bf16* dst = blob_row(C, d, pw, b, c, h, lane);
        const LAS unsigned char* xr = XTw + lane * 128;
#pragma unroll
        for (int g = 0; g < 8; ++g) *(v4u*)(dst + 8 * g) = *(const LAS v4u*)(xr + ((g ^ (lane & 7)) << 4));
    }
    __syncthreads();
}

template <bool DRY>
__device__ __forceinline__ void gdn_chunked(const Ctx& C, int l, int idx) {
    const int d = idx >> 5, b = (idx >> 2) & 7, h = idx & 3, lane = C.lane, w = C.wave, l15 = lane & 15, q = lane >> 4;
    const int it = w & 3, vtp = w >> 2;
    constexpr int IMG = 64 * MP * 2, BUFB = 5 * IMG + 512;
    LAS unsigned char* L0 = C.lds;
    LAS bf16* VnT = (LAS bf16*)(L0 + 2 * BUFB + 2 * IMG);
    const bf16* P = WSP(const bf16, WS_P); const bf16* gq = WSP(const bf16, WS_GQ); bf16* outd = WSP(bf16, WS_OUTD) + (size_t)d * T_ALL * 256;
    const float aexp = __expf(C.in[I_GALOG][(l * 2 + d) * NH + h]), dtb = C.in[I_GDTB][(l * 2 + d) * NH + h];
    const int tt = C.tid >> 3, part = C.tid & 7;
    for (int i = C.tid; i < 2 * IMG / 4; i += NTHR) ((LAS unsigned*)(L0 + 2 * BUFB))[i] = 0u;
    v4u rq, rk, ru, rw; unsigned short rga;
    auto gload = [&](int n) {
        const int c = d ? (n < 4 ? 3 - n : 71 - n) : n;
        const bf16* pp = gq + (size_t)seqrow_cm(n * 64 + tt, d, b) * 768 + h * 64 + 8 * part;
        rq = *(const v4u*)pp; rk = *(const v4u*)(pp + 256);
        ru = *(const v4u*)(blob_row(C, d, 0, b, c, h, tt) + 8 * part); rw = *(const v4u*)(blob_row(C, d, 1, b, c, h, tt) + 8 * part);
        rga = P[(size_t)seqrow_cm(n * 64 + lane, d, b) * PLD + OFF_D + 1024 + d * 4 + h];
    };
    auto images = [&](int bufi) {
        LAS unsigned char* B0 = L0 + bufi * BUFB;
        LAS bf16* Qs = (LAS bf16*)B0; LAS bf16* Ks = Qs + 64 * MP; LAS bf16* KdT = Ks + 64 * MP; LAS bf16* Wi = KdT + 64 * MP; LAS bf16* UT = Wi + 64 * MP; LAS float* vec = (LAS float*)(B0 + 5 * IMG);
        const float la = -aexp * softplusf_(bf2f(rga) + dtb);
        const float gam = wave_incl_sum(la, lane);
        if (w == 0) vec[lane] = gam;
        const float kd = __expf(__shfl(gam, 63) - gam);
        const float kmine = __shfl(kd, 8 * w + (lane >> 3));
        *(LAS v4u*)(Qs + tt * MP + 8 * part) = rq; *(LAS v4u*)(Ks + tt * MP + 8 * part) = rk; *(LAS v4u*)(UT + tt * MP + 8 * part) = ru;
        const unsigned kk[4] = {rk.x, rk.y, rk.z, rk.w}, ww[4] = {rw.x, rw.y, rw.z, rw.w};
#pragma unroll
        for (int e = 0; e < 4; ++e) {
            KdT[(8 * part + 2 * e) * MP + tt] = (bf16)f2bf1(bflo(kk[e]) * kmine); KdT[(8 * part + 2 * e + 1) * MP + tt] = (bf16)f2bf1(bfhi(kk[e]) * kmine);
            Wi[(8 * part + 2 * e) * MP + tt] = (bf16)(ww[e] & 0xffffu); Wi[(8 * part + 2 * e + 1) * MP + tt] = (bf16)(ww[e] >> 16);
        }
    };
    f32x4 Sst[2]; Sst[0] = Sst[1] = (f32x4){0.f, 0.f, 0.f, 0.f};
    const f32x4 z4 = (f32x4){0.f, 0.f, 0.f, 0.f};
    gload(0); images(0); gload(1);
#pragma unroll 1
    for (int n = 0; n < NCH; ++n) {
        RAW_BARRIER();
        const LAS unsigned char* B0 = L0 + (n & 1) * BUFB;
        const LAS bf16* Qs = (const LAS bf16*)B0; const LAS bf16* Ks = Qs + 64 * MP; const LAS bf16* KdT = Ks + 64 * MP; const LAS bf16* Wi = KdT + 64 * MP; const LAS bf16* UT = Wi + 64 * MP; const LAS float* vec = (const LAS float*)(B0 + 5 * IMG);
        const LAS bf16* ST = (const LAS bf16*)(L0 + 2 * BUFB + (n & 1) * IMG); LAS bf16* STn = (LAS bf16*)(L0 + 2 * BUFB + ((n + 1) & 1) * IMG);
        fragb Qf[2]; Qf[0] = ld_frag16(Qs + (16 * it + l15) * MP + 8 * q); Qf[1] = ld_frag16(Qs + (16 * it + l15) * MP + 32 + 8 * q);
        const float gcol = vec[16 * it + l15]; const int icol = 16 * it + l15;
        f32x4 pt[4];
#pragma unroll
        for (int jt = 0; jt < 4; ++jt) {
            pt[jt] = z4;
            if (jt <= it) {
                const fragb k0 = ld_frag16(Ks + (16 * jt + l15) * MP + 8 * q), k1 = ld_frag16(Ks + (16 * jt + l15) * MP + 32 + 8 * q);
                f32x4 st = mfma16(k0, Qf[0], z4); st = mfma16(k1, Qf[1], st);
                const f32x4 gj = *(const LAS f32x4*)(vec + 16 * jt + 4 * q);
#pragma unroll
                for (int r = 0; r < 4; ++r) { const int j = 16 * jt + 4 * q + r; pt[jt][r] = (j <= icol) ? st[r] * __expf(gcol - gj[r]) : 0.f; }
            }
        }
        fragb Pf[2]; Pf[0] = pack_frag(pt[0], pt[1]); Pf[1] = pack_frag(pt[2], pt[3]);
        const fragb Wf0 = ld_frag16(Wi + (16 * it + l15) * MP + 8 * q), Wf1 = ld_frag16(Wi + (16 * it + l15) * MP + 32 + 8 * q);
        f32x4 Ro[2];
#pragma unroll
        for (int v2 = 0; v2 < 2; ++v2) {
            const int vrow = 16 * (2 * vtp + v2) + l15;
            const fragb s0 = ld_frag16(ST + vrow * MP + 8 * q), s1 = ld_frag16(ST + vrow * MP + 32 + 8 * q);
            f32x4 ws = mfma16(Wf0, s0, z4); ws = mfma16(Wf1, s1, ws);
            Ro[v2] = mfma16(Qf[0], s0, z4); Ro[v2] = mfma16(Qf[1], s1, Ro[v2]);
            const v2u ur = *(const LAS v2u*)(UT + vrow * MP + 16 * it + 4 * q);
            v2u o; o.x = pk2(bflo(ur.x) - ws.x, bfhi(ur.x) - ws.y); o.y = pk2(bflo(ur.y) - ws.z, bfhi(ur.y) - ws.w);
            *(LAS v2u*)(VnT + vrow * MP + 16 * it + 4 * q) = o;
        }
        RAW_BARRIER();
        {
            const f32x4 gi = *(const LAS f32x4*)(vec + 16 * it + 4 * q);
            const float gl = __expf(vec[63]);
            const LAS bf16* kr = KdT + (16 * it + l15) * MP + 4 * q;
            const fragb kt0 = ld_frag8x2(kr, kr + 16), kt1 = ld_frag8x2(kr + 32, kr + 48);
#pragma unroll
            for (int v2 = 0; v2 < 2; ++v2) {
                const int vrow = 16 * (2 * vtp + v2) + l15;
                const LAS bf16* vr = VnT + vrow * MP + 4 * q;
                const fragb n0 = ld_frag8x2(vr, vr + 16), n1 = ld_frag8x2(vr + 32, vr + 48);
                f32x4 o = mfma16(Pf[0], n0, z4); if (it >= 2) o = mfma16(Pf[1], n1, o);
#pragma unroll
                for (int r = 0; r < 4; ++r) { const int row = seqrow_cm(n * 64 + 16 * it + 4 * q + r, d, b);
                    if (!DRY) outd[(size_t)row * 256 + h * 64 + vrow] = (bf16)f2bf1(o[r] + __expf(gi[r]) * Ro[v2][r]); }
                f32x4 ns = mfma16(kt0, n0, z4); ns = mfma16(kt1, n1, ns);
                Sst[v2] = Sst[v2] * gl + ns;
                v2u so; so.x = pk2(Sst[v2].x, Sst[v2].y); so.y = pk2(Sst[v2].z, Sst[v2].w);
                *(LAS v2u*)(STn + vrow * MP + 16 * it + 4 * q) = so;
            }
        }
        if (n + 1 < NCH) { images((n + 1) & 1); if (n + 2 < NCH) gload(n + 2); }
    }
    __syncthreads();
}
constexpr int UP = 264;
template <int CTRL> __device__ __forceinline__ float dpp_keep(float oldv, float v) { return __builtin_bit_cast(float, __builtin_amdgcn_update_dpp(__builtin_bit_cast(int, oldv), __builtin_bit_cast(int, v), CTRL, 0xF, 0xF, false)); }
template <bool REV> __device__ __forceinline__ void scan16(float& A, float& B) {
#define LRU_STEP(S) { const float Ap = dpp_keep<(REV ? 0x100 : 0x110) | S>(1.0f, A), Bp = dpp_keep<(REV ? 0x100 : 0x110) | S>(0.0f, B); B = A * Bp + B; A = A * Ap; }
    LRU_STEP(1) LRU_STEP(2) LRU_STEP(4) LRU_STEP(8)
#undef LRU_STEP
}
template <bool FIN, bool REV>
__device__ __forceinline__ void lru_wave(const Ctx& C, int l, int b, int c, int hd, LAS bf16* U16, LAS bf16* H16) {
    constexpr int d = REV ? 1 : 0;
    const int lane = C.lane, l15 = lane & 15, q = lane >> 4;
    const bf16* wt = WSP(const bf16, WS_LRUWT) + (size_t)((d * 2 + 0) * 4 + hd) * 4096;
    fragb Wa[4][2], Wx[4][2];
#pragma unroll
    for (int mt = 0; mt < 4; ++mt)
#pragma unroll
        for (int ks = 0; ks < 2; ++ks) { Wa[mt][ks] = *(const fragb*)(wt + (16 * mt + l15) * 64 + 32 * ks + 8 * q); Wx[mt][ks] = *(const fragb*)(wt + 4 * 4096 + (16 * mt + l15) * 64 + 32 * ks + 8 * q); }
    f32x4 sp4[4], hc[4], sla[4];
    const size_t sbase = ((size_t)(b * NCH + c) * 2 + d) * 256 + hd * 64;
#pragma unroll
    for (int mt = 0; mt < 4; ++mt) {
        const int ch = hd * 64 + 16 * mt + 4 * q;
        const f32x4 lam = *(const f32x4*)(C.in[I_LLAM] + (l * 2 + d) * GW + ch);
#pragma unroll
        for (int r = 0; r < 4; ++r) sp4[mt][r] = 8.0f * softplusf_(-lam[r]);
        hc[mt] = FIN ? *(const f32x4*)(WSP(const float, WS_HIN) + sbase + 16 * mt + 4 * q) : (f32x4){0.f, 0.f, 0.f, 0.f};
        sla[mt] = (f32x4){0.f, 0.f, 0.f, 0.f};
    }
    const f32x4 z4 = (f32x4){0.f, 0.f, 0.f, 0.f};
#pragma unroll 1
    for (int nti = 0; nti < 4; ++nti) {
        const int nt = REV ? 3 - nti : nti;
        const LAS bf16* urow = U16 + (16 * nt + l15) * UP + hd * 64;
        const fragb Uf0 = ld_frag16(urow + 8 * q), Uf1 = ld_frag16(urow + 32 + 8 * q);
#pragma unroll
        for (int mt = 0; mt < 4; ++mt) {
            f32x4 aa = mfma16(Wa[mt][0], Uf0, z4); aa = mfma16(Wa[mt][1], Uf1, aa);
            f32x4 ax = mfma16(Wx[mt][0], Uf0, z4); ax = mfma16(Wx[mt][1], Uf1, ax);
            const v2u ur = *(const LAS v2u*)(urow + 16 * mt + 4 * q);
            const float u4[4] = {bflo(ur.x), bfhi(ur.x), bflo(ur.y), bfhi(ur.y)};
            const f32x4 ba = *(const f32x4*)(C.in[I_LBA] + (l * 2 + d) * GW + hd * 64 + 16 * mt + 4 * q), bx = *(const f32x4*)(C.in[I_LBX] + (l * 2 + d) * GW + hd * 64 + 16 * mt + 4 * q);
            f32x4 hv;
#pragma unroll
            for (int r = 0; r < 4; ++r) {
                const float rg = sigmoidf_(aa[r] + ba[r]), ig = sigmoidf_(ax[r] + bx[r]);
                const float la = -sp4[mt][r] * rg; float A = __expf(la); float Bv = sqrtf(-expm1f_(2.0f * la)) * (ig * u4[r]);
                sla[mt][r] += la;
                scan16<REV>(A, Bv);
                const float h = A * hc[mt][r] + Bv;
                hv[r] = h;
                hc[mt][r] = __shfl(h, (lane & 48) | (REV ? 0 : 15));
            }
            if (FIN) { v2u o; o.x = pk2(hv.x, hv.y); o.y = pk2(hv.z, hv.w); *(LAS v2u*)(H16 + (size_t)d * 64 * UP + (16 * nt + l15) * UP + hd * 64 + 16 * mt + 4 * q) = o; }
        }
    }
    if (!FIN) {
        float* ls = WSP(float, WS_LSUM);
#pragma unroll
        for (int mt = 0; mt < 4; ++mt)
#pragma unroll
            for (int r = 0; r < 4; ++r) { const float st = row16_sum(sla[mt][r]); if (l15 == 0) { const size_t si = sbase + 16 * mt + 4 * q + r; ls[si * 2] = st; ls[si * 2 + 1] = hc[mt][r]; } }
    }
}
template <bool FIN>
__device__ __forceinline__ void lru_chunk_mfma(const Ctx& C, int l, int b, int c) {
    LAS bf16* U16 = (LAS bf16*)C.lds;
    LAS bf16* H16 = U16 + 64 * UP;
    const bf16* P = WSP(const bf16, WS_P);
    const bool isctx = c < 4; const int p0 = isctx ? c * 64 : (c - 4) * 64; const int Lp = isctx ? CTXL : SEQ; const int row0 = isctx ? T_LAT + b * CTXL : b * SEQ;
    {
        const int ch = C.tid & 255, half = C.tid >> 8;
        const float* cw = C.in[I_LCW] + (size_t)l * 4 * GW + ch; const float w0 = cw[0], w1 = cw[GW], w2 = cw[2 * GW], w3 = cw[3 * GW], cb = C.in[I_LCB][l * GW + ch];
        const int t0 = half * 32;
        float xs[35];
#pragma unroll
        for (int k = 0; k < 35; ++k) { const int p = p0 + t0 + k - 2; xs[k] = (p >= 0 && p < Lp) ? bf2f(P[(size_t)(row0 + p) * PLD + ch]) : 0.f; }
#pragma unroll
        for (int t = 0; t < 32; ++t) U16[(t0 + t) * UP + ch] = (bf16)f2bf1(w0 * xs[t] + w1 * xs[t + 1] + w2 * xs[t + 2] + w3 * xs[t + 3] + cb);
    }
    __syncthreads();
    if (C.wave < 4) lru_wave<FIN, false>(C, l, b, c, C.wave & 3, U16, H16); else lru_wave<FIN, true>(C, l, b, c, C.wave & 3, U16, H16);
    __syncthreads();
    if (FIN) {
        const LAS bf16* H1 = H16 + 64 * UP;
#pragma unroll 2
        for (int it = C.tid; it < 64 * 64; it += NTHR) {
            const int t = it >> 6, c4 = (it & 63) * 4;
            const size_t row = (size_t)(row0 + p0 + t);
            const v2u a = *(const LAS v2u*)(H16 + t * UP + c4), bq = *(const LAS v2u*)(H1 + t * UP + c4);
            const f32x4 g = ld4bf(P + row * PLD + 256 + c4);
            f32x4 y = (f32x4){bflo(a.x) + bflo(bq.x), bfhi(a.x) + bfhi(bq.x), bflo(a.y) + bflo(bq.y), bfhi(a.y) + bfhi(bq.y)};
            y.x *= gelu_tanh(g.x); y.y *= gelu_tanh(g.y); y.z *= gelu_tanh(g.z); y.w *= gelu_tanh(g.w);
            st4bf(WSP(bf16, WS_P) + row * PLD + 256 + c4, y);
        }
        __syncthreads();
    }
}
constexpr int RP = 264;
__device__ __forceinline__ void rwkv_prep2(const Ctx& C, int l, int b, int c) {
    LAS bf16* RS = (LAS bf16*)C.lds;
    LAS bf16* KS = RS + 64 * RP;
    LAS bf16* XW = KS + 64 * RP;
    LAS bf16* XA = XW + 64 * MP;
    LAS bf16* XG = XA + 64 * MP;
    const bf16* P = WSP(const bf16, WS_P);
    const bool isctx = c < 4; const int p0 = isctx ? c * 64 : (c - 4) * 64; const int Lp = isctx ? CTXL : SEQ; const int row0 = isctx ? T_LAT + b * CTXL : b * SEQ;
    const float* mu = C.in[I_RMU] + (size_t)l * 2 * B_COLS;
    bf16* rkv = WSP(bf16, WS_RKV);
#pragma unroll 2
    for (int it = C.tid; it < 64 * 120; it += NTHR) {
        const int t = it / 120, c8 = (it % 120) * 8, p = p0 + t;
        const bf16* pp = P + (size_t)(row0 + p) * PLD + OFF_B + c8;
        const v4u xc = *(const v4u*)pp; v4u xp = (v4u){0u, 0u, 0u, 0u}, xn = xp;
        if (p > 0) xp = *(const v4u*)(pp - PLD);
        if (p < Lp - 1) xn = *(const v4u*)(pp + PLD);
        const f32x4 m0a = *(const f32x4*)(mu + c8), m0b = *(const f32x4*)(mu + c8 + 4), m1a = *(const f32x4*)(mu + B_COLS + c8), m1b = *(const f32x4*)(mu + B_COLS + c8 + 4);
        const unsigned xcw[4] = {xc.x, xc.y, xc.z, xc.w}, xpw[4] = {xp.x, xp.y, xp.z, xp.w}, xnw[4] = {xn.x, xn.y, xn.z, xn.w};
        float sh[8];
#pragma unroll
        for (int e = 0; e < 4; ++e) {
            const float x0 = bflo(xcw[e]), x1 = bfhi(xcw[e]);
            const float mu0_0 = e < 2 ? m0a[2 * e] : m0b[2 * e - 4], mu0_1 = e < 2 ? m0a[2 * e + 1] : m0b[2 * e - 3], mu1_0 = e < 2 ? m1a[2 * e] : m1b[2 * e - 4], mu1_1 = e < 2 ? m1a[2 * e + 1] : m1b[2 * e - 3];
            sh[2 * e] = x0 + mu0_0 * (bflo(xpw[e]) - x0) + mu1_0 * (bflo(xnw[e]) - x0);
            sh[2 * e + 1] = x1 + mu0_1 * (bfhi(xpw[e]) - x1) + mu1_1 * (bfhi(xnw[e]) - x1);
        }
        if (c8 >= 768) {
            const int ci = c8 - 768;
            if (ci < 64) {
#pragma unroll
                for (int e = 0; e < 8; ++e) sh[e] = tanhf_(sh[e]); }
            else if (ci >= 128) {
#pragma unroll
                for (int e = 0; e < 8; ++e) sh[e] = sigmoidf_(sh[e]); }
        }
        v4u o; o.x = pk2(sh[0], sh[1]); o.y = pk2(sh[2], sh[3]); o.z = pk2(sh[4], sh[5]); o.w = pk2(sh[6], sh[7]);
        if (c8 < 768) {
            *(v4u*)(rkv + (size_t)(row0 + p) * 768 + c8) = o;
            if (c8 < 256) *(LAS v4u*)(RS + t * RP + c8) = o; else if (c8 < 512) *(LAS v4u*)(KS + t * RP + c8 - 256) = o;
        } else {
            const int ci = c8 - 768;
            LAS bf16* dst = ci < 64 ? XW + t * MP + ci : (ci < 128 ? XA + t * MP + ci - 64 : XG + t * MP + ci - 128);
            *(LAS v4u*)dst = o;
        }
    }
    __syncthreads();
    const int lane = C.lane, w = C.wave, l15 = lane & 15, q = lane >> 4, hd = w & 3, ntp = w >> 2;
    const bf16* wt = WSP(const bf16, WS_RWT);
    bf16* wa_out = WSP(bf16, WS_HB); bf16* g_out = WSP(bf16, WS_G); float* bonus = WSP(float, WS_BONUS); float* rinv = WSP(float, WS_RINV);
    const f32x4 z4 = (f32x4){0.f, 0.f, 0.f, 0.f};
#pragma unroll 1
    for (int n2 = 0; n2 < 2; ++n2) {
        const int nt = 2 * ntp + n2, tok = 16 * nt + l15; const size_t row = (size_t)(row0 + p0 + tok);
        const fragb xw0 = ld_frag16(XW + tok * MP + 8 * q), xw1 = ld_frag16(XW + tok * MP + 32 + 8 * q);
        const fragb xa0 = ld_frag16(XA + tok * MP + 8 * q), xa1 = ld_frag16(XA + tok * MP + 32 + 8 * q);
        const fragb xg0 = ld_frag16(XG + tok * MP + 8 * q), xg1 = ld_frag16(XG + tok * MP + 32 + 8 * q);
        float bsum = 0.f, ksum = 0.f;
#pragma unroll
        for (int mt = 0; mt < 4; ++mt) {
            const int chl = 16 * mt + l15, ch4 = hd * 64 + 16 * mt + 4 * q;
            const bf16* wrow = wt + (size_t)(hd * 64 + chl) * 32 + 8 * q;
            const f32x4 aw0 = mfma16(*(const fragb*)(wrow), xw0, z4), aw1 = mfma16(*(const fragb*)(wrow + 256 * 32), xw1, z4);
            const f32x4 aa0 = mfma16(*(const fragb*)(wrow + 2 * 256 * 32), xa0, z4), aa1 = mfma16(*(const fragb*)(wrow + 3 * 256 * 32), xa1, z4);
            const bf16* grow = wt + 4 * 256 * 32 + (size_t)(hd * 64 + chl) * 64 + 8 * q;
            f32x4 ag = mfma16(*(const fragb*)(grow), xg0, z4); ag = mfma16(*(const fragb*)(grow + 32), xg1, ag);
            const f32x4 w00 = *(const f32x4*)(C.in[I_RW0] + (l * 2 + 0) * GW + ch4), w01 = *(const f32x4*)(C.in[I_RW0] + (l * 2 + 1) * GW + ch4);
            const f32x4 a00 = *(const f32x4*)(C.in[I_RA0] + (l * 2 + 0) * GW + ch4), a01 = *(const f32x4*)(C.in[I_RA0] + (l * 2 + 1) * GW + ch4);
            const f32x4 k_a = *(const f32x4*)(C.in[I_RKA] + l * GW + ch4), r_k = *(const f32x4*)(C.in[I_RRK] + l * GW + ch4), k_k = *(const f32x4*)(C.in[I_RKK] + l * GW + ch4);
            f32x4 wv0, wv1, av0, av1;
#pragma unroll
            for (int r = 0; r < 4; ++r) {
                wv0[r] = __expf(-0.6065306597126334f * sigmoidf_(aw0[r] + w00[r])); wv1[r] = __expf(-0.6065306597126334f * sigmoidf_(aw1[r] + w01[r]));
                av0[r] = sigmoidf_(aa0[r] + a00[r]); av1[r] = sigmoidf_(aa1[r] + a01[r]);
            }
            st4bf(wa_out + row * 1024 + 0 * 256 + ch4, wv0); st4bf(wa_out + row * 1024 + 1 * 256 + ch4, wv1);
            st4bf(wa_out + row * 1024 + 2 * 256 + ch4, av0); st4bf(wa_out + row * 1024 + 3 * 256 + ch4, av1);
            st4bf(g_out + row * 256 + ch4, ag);
            const v2u rr_ = *(const LAS v2u*)(RS + tok * RP + ch4), kr_ = *(const LAS v2u*)(KS + tok * RP + ch4);
            const f32x4 rs = (f32x4){bflo(rr_.x), bfhi(rr_.x), bflo(rr_.y), bfhi(rr_.y)}, ks = (f32x4){bflo(kr_.x), bfhi(kr_.x), bflo(kr_.y), bfhi(kr_.y)};
#pragma unroll
            for (int r = 0; r < 4; ++r) {
                const float km = ks[r] * (1.0f + (av0[r] - 1.0f) * k_a[r]) + ks[r] * (1.0f + (av1[r] - 1.0f) * k_a[r]);
                bsum += rs[r] * r_k[r] * km; const float kk = ks[r] * k_k[r]; ksum += kk * kk;
            }
        }
        bsum += __shfl_xor(bsum, 16); bsum += __shfl_xor(bsum, 32); ksum += __shfl_xor(ksum, 16); ksum += __shfl_xor(ksum, 32);
        if (q == 0) { bonus[row * 4 + hd] = bsum; rinv[row * 4 + hd] = 1.0f / sqrtf(ksum + 1e-6f); }
    }
    __syncthreads();
}
__device__ __forceinline__ int fwd_row_r(int b, int c, int t) { return c < 4 ? (T_LAT + b * CTXL + c * 64 + t) : (b * SEQ + (c - 4) * 64 + t); }
__device__ __forceinline__ bf16* rw_blob_row(const Ctx& C, int d, int which, int b, int c, int h, int r) {
    const int row = fwd_row_r(b, c, r);
#if RW_VSPLIT
    if (which == 0) { if (d) return WSP(bf16, WS_GQ) + (size_t)row * 768 + 512 + h * 64;
                      return WSP(bf16, WS_P) + (size_t)row * PLD + OFF_B + 512 + h * 64; }
#else
    if (which == 0) return WSP(bf16, WS_OUTB) + ((size_t)d * T_ALL + row) * 256 + h * 64;
#endif
    return WSP(bf16, WS_P) + (size_t)row * PLD + OFF_B + d * 256 + h * 64;
}
__device__ __forceinline__ void rwkv_solve_item(const Ctx& C, int l, int item) {
    const int lane = C.lane, w = C.wave, pw = w & 1, pi = w >> 1, l15 = lane & 15, q = lane >> 4;
    LAS unsigned char* B0 = C.lds + pi * 31744;
    LAS bf16* Kk = (LAS bf16*)B0; LAS bf16* Bh = Kk + 64 * MP; LAS bf16* Kh = Bh + 64 * MP;
    LAS bf16* Ln = (LAS bf16*)B0;
    LAS bf16* Lk16 = (LAS bf16*)(B0 + 9216);
    LAS unsigned char* XT = B0 + 9216;
    LAS bf16* TinvP = (LAS bf16*)(B0 + 25600);
    const bf16* WA = WSP(const bf16, WS_HB); const bf16* rkv = WSP(const bf16, WS_RKV); const float* rinv = WSP(const float, WS_RINV);
    const int u = item >> 1, d = item & 1;
    const int c = u % NCH, h = (u / NCH) & 3, b = u / (NCH * NH);
    const float k_k = C.in[I_RKK][l * GW + h * 64 + lane], k_a = C.in[I_RKA][l * GW + h * 64 + lane];
    const int n = d ? (c < 4 ? 3 - c : 71 - c) : c;
    const float ril = rinv[(size_t)seqrow_raster(n * 64 + lane, d, b) * 4 + h];
#pragma unroll
    for (int r = 0; r < 4; ++r) { const int idx2 = pw * 64 + lane + 128 * r, t = idx2 >> 3, part = idx2 & 7; const int row = seqrow_raster(n * 64 + t, d, b);
        *(LAS v4u*)(Kk + t * MP + 8 * part) = *(const v4u*)(WA + (size_t)row * 1024 + d * 256 + h * 64 + 8 * part);
        *(LAS v4u*)(Bh + t * MP + 8 * part) = *(const v4u*)(WA + (size_t)row * 1024 + (2 + d) * 256 + h * 64 + 8 * part);
        *(LAS v4u*)(Kh + t * MP + 8 * part) = *(const v4u*)(rkv + (size_t)row * 768 + 256 + h * 64 + 8 * part); }
    __syncthreads();
    {
        float cc = 1.0f;
        if (pw) {
#pragma unroll
            for (int t = 0; t < 32; ++t) cc *= bf2f(Kk[t * MP + lane]);
        }
        __syncthreads();
#pragma unroll
        for (int t2 = 0; t2 < 32; ++t2) {
            const int t = pw * 32 + t2;
            const float wv = bf2f(Kk[t * MP + lane]), av = bf2f(Bh[t * MP + lane]), ks = bf2f(Kh[t * MP + lane]);
            const float kap = ks * k_k * __shfl(ril, t);
            const float cprev = cc; cc *= wv; const float ic = __builtin_amdgcn_rcpf(cc);
            Kk[t * MP + lane] = (bf16)f2bf1(kap * cprev); Bh[t * MP + lane] = (bf16)f2bf1(kap * av * ic); Kh[t * MP + lane] = (bf16)f2bf1(ks * (1.0f + (av - 1.0f) * k_a) * ic);
        }
    }
    __syncthreads();
    f32x4 acc[4][4];
    if (pw == 0) {
#pragma unroll
        for (int I = 0; I < 4; ++I)
#pragma unroll
            for (int r = 0; r < 4; ++r)
#pragma unroll
                for (int nt = 0; nt < 4; ++nt) acc[I][nt][r] = bf2f(Kk[(16 * I + 4 * q + r) * MP + 16 * nt + l15]);
    }
    f32x4 T[10];
    {
        const LAS bf16* Bsrc = pw ? Kh : Bh;
        int tix = 0;
#pragma unroll
        for (int it = 0; it < 4; ++it)
#pragma unroll
            for (int jt = 0; jt <= it; ++jt, ++tix) {
                f32x4 t4 = (f32x4){0.f, 0.f, 0.f, 0.f};
#pragma unroll
                for (int s = 0; s < 2; ++s) t4 = mfma16(ld_frag16(Kk + (16 * it + l15) * MP + 32 * s + 8 * q), ld_frag16(Bsrc + (16 * jt + l15) * MP + 32 * s + 8 * q), t4);
#pragma unroll
                for (int r = 0; r < 4; ++r) { const int i = 16 * it + 4 * q + r, j = 16 * jt + l15; T[tix][r] = (j < i) ? (pw ? t4[r] : -t4[r]) : 0.f; }
            }
    }
    __syncthreads();
    {
        int tix = 0;
#pragma unroll
        for (int it = 0; it < 4; ++it)
#pragma unroll
            for (int jt = 0; jt < 4; ++jt) {
                if (jt <= it) {
#pragma unroll
                    for (int r = 0; r < 4; ++r) (pw ? Lk16 : Ln)[(16 * it + 4 * q + r) * MP + 16 * jt + l15] = (bf16)f2bf1(T[tix][r]);
                    ++tix;
                } else if (pw == 0) {
#pragma unroll
                    for (int r = 0; r < 4; ++r) Ln[(16 * it + 4 * q + r) * MP + 16 * jt + l15] = (bf16)0;
                }
            }
        LAS v4u* tz = (LAS v4u*)(B0 + 25600) + (pw * 64 + lane) * 2; tz[0] = (v4u){0u, 0u, 0u, 0u}; tz[1] = (v4u){0u, 0u, 0u, 0u};
    }
    __syncthreads();
    if (pw) {
#pragma unroll
        for (int I = 0; I < 4; ++I)
#pragma unroll
            for (int r = 0; r < 4; ++r)
#pragma unroll
                for (int nt = 0; nt < 4; ++nt) { const int i = 16 * I + 4 * q + r, j = 16 * nt + l15; acc[I][nt][r] = (j < i && nt <= I) ? bf2f(Lk16[i * MP + j]) : 0.f; }
    } else diag_inverses(Ln, TinvP, lane);
    __syncthreads();
    LAS unsigned char* XTw = XT + pw * 8192;
    { LAS v4u* xz = (LAS v4u*)(XTw + lane * 128);
#pragma unroll
        for (int g = 0; g < 8; ++g) xz[g] = (v4u){0u, 0u, 0u, 0u}; }
    blocked_solve(Ln, TinvP, XTw, acc, l15, q);
    {
        bf16* dst = rw_blob_row(C, d, pw, b, c, h, lane);
        const LAS unsigned char* xr = XTw + lane * 128;
#pragma unroll
        for (int g = 0; g < 8; ++g) *(v4u*)(dst + 8 * g) = *(const LAS v4u*)(xr + ((g ^ (lane & 7)) << 4));
    }
    __syncthreads();
}

template <bool DRY>
__device__ __forceinline__ void rwkv_chunked(const Ctx& C, int l, int idx) {
#ifndef RW_VSPLIT
#define RW_VSPLIT 1
#endif
    constexpr int NV = RW_VSPLIT ? 1 : 2;
    const int vhalf = idx & 1, lane = C.lane, w = C.wave, l15 = lane & 15, q = lane >> 4;
    const int d = RW_VSPLIT ? idx >> 6 : idx >> 5, b = RW_VSPLIT ? (idx >> 3) & 7 : (idx >> 2) & 7, h = RW_VSPLIT ? (idx >> 1) & 3 : idx & 3;
    const int it = w & 3, vt0 = RW_VSPLIT ? 2 * vhalf + (w >> 2) : 2 * (w >> 2);
    constexpr int IMG = 64 * MP * 2;
    LAS unsigned char* L0 = C.lds;
    LAS bf16* Wi = (LAS bf16*)L0; LAS bf16* Ti = Wi + 64 * MP; LAS bf16* Rh = Ti + 64 * MP; LAS bf16* Kh = Rh + 64 * MP; LAS bf16* Bh = Kh + 64 * MP;
    LAS bf16* UT = (LAS bf16*)(L0 + 11 * IMG);
    LAS float* cLv = (LAS float*)(L0 + 14 * IMG);
    const bf16* WA = WSP(const bf16, WS_HB); const bf16* rkv = WSP(const bf16, WS_RKV); const float* rinv = WSP(const float, WS_RINV);
    bf16* outb = WSP(bf16, WS_OUTB) + (size_t)d * T_ALL * 256;
    const int tt = C.tid >> 3, part = C.tid & 7;
    for (int i = C.tid; i < 2 * IMG / 4; i += NTHR) ((LAS unsigned*)(L0 + 12 * IMG))[i] = 0u;
    float kkw[8], kaw[8];
#pragma unroll
    for (int e = 0; e < 8; ++e) { kkw[e] = C.in[I_RKK][l * GW + h * 64 + 8 * w + e]; kaw[e] = C.in[I_RKA][l * GW + h * 64 + 8 * w + e]; }
    v4u gr, gk, gv, gw, ga, gbw, gbt; float gri;
    auto gload = [&](int n) {
        const int c = d ? (n < 4 ? 3 - n : 71 - n) : n;
        const int row = seqrow_raster(n * 64 + lane, d, b);
        const bf16* pr = rkv + (size_t)row * 768 + h * 64 + 8 * w;
        gr = *(const v4u*)pr; gk = *(const v4u*)(pr + 256); gv = *(const v4u*)(pr + 512);
        gw = *(const v4u*)(WA + (size_t)row * 1024 + d * 256 + h * 64 + 8 * w); ga = *(const v4u*)(WA + (size_t)row * 1024 + (2 + d) * 256 + h * 64 + 8 * w);
        gri = rinv[(size_t)row * 4 + h];
        gbw = *(const v4u*)(rw_blob_row(C, d, 0, b, c, h, tt) + 8 * part); gbt = *(const v4u*)(rw_blob_row(C, d, 1, b, c, h, tt) + 8 * part);
    };
    auto images = [&](int bufi) {
        LAS bf16* VT = (LAS bf16*)(L0 + (5 + 3 * bufi) * IMG); LAS bf16* KcT = VT + 64 * MP; LAS bf16* BcT = KcT + 64 * MP;
        const unsigned rw_[4] = {gr.x, gr.y, gr.z, gr.w}, kw_[4] = {gk.x, gk.y, gk.z, gk.w}, vw_[4] = {gv.x, gv.y, gv.z, gv.w}, ww_[4] = {gw.x, gw.y, gw.z, gw.w}, aw_[4] = {ga.x, ga.y, ga.z, ga.w};
        float rh[8], kh[8], bh[8];
#pragma unroll
        for (int e = 0; e < 8; ++e) {
            const float rs = (e & 1) ? bfhi(rw_[e >> 1]) : bflo(rw_[e >> 1]), ks = (e & 1) ? bfhi(kw_[e >> 1]) : bflo(kw_[e >> 1]);
            const float wv = (e & 1) ? bfhi(ww_[e >> 1]) : bflo(ww_[e >> 1]), av = (e & 1) ? bfhi(aw_[e >> 1]) : bflo(aw_[e >> 1]);
            const float lw = __logf(wv);
            const float cum = wave_incl_sum(lw, lane);
            const float kap = ks * kkw[e] * gri, ktil = ks * (1.0f + (av - 1.0f) * kaw[e]);
            const float cf = __expf(cum), icf = __builtin_amdgcn_rcpf(cf), cfL = __shfl(cf, 63), dec = cfL * icf;
            rh[e] = rs * cf; kh[e] = ktil * icf; bh[e] = kap * av * icf;
            const unsigned short vraw = (e & 1) ? (unsigned short)(vw_[e >> 1] >> 16) : (unsigned short)(vw_[e >> 1] & 0xffffu);
            VT[(8 * w + e) * MP + lane] = vraw; KcT[(8 * w + e) * MP + lane] = (bf16)f2bf1(ktil * dec); BcT[(8 * w + e) * MP + lane] = (bf16)f2bf1(-(kap * av * dec));
            if (lane == 63) cLv[bufi * 64 + 8 * w + e] = cfL;
        }
        { v4u o; o.x = pk2(rh[0], rh[1]); o.y = pk2(rh[2], rh[3]); o.z = pk2(rh[4], rh[5]); o.w = pk2(rh[6], rh[7]); *(LAS v4u*)(Rh + lane * MP + 8 * w) = o; }
        { v4u o; o.x = pk2(kh[0], kh[1]); o.y = pk2(kh[2], kh[3]); o.z = pk2(kh[4], kh[5]); o.w = pk2(kh[6], kh[7]); *(LAS v4u*)(Kh + lane * MP + 8 * w) = o; }
        { v4u o; o.x = pk2(bh[0], bh[1]); o.y = pk2(bh[2], bh[3]); o.z = pk2(bh[4], bh[5]); o.w = pk2(bh[6], bh[7]); *(LAS v4u*)(Bh + lane * MP + 8 * w) = o; }
        const unsigned bw_[4] = {gbw.x, gbw.y, gbw.z, gbw.w}, bt_[4] = {gbt.x, gbt.y, gbt.z, gbt.w};
#pragma unroll
        for (int e = 0; e < 4; ++e) {
            Wi[(8 * part + 2 * e) * MP + tt] = (bf16)(bw_[e] & 0xffffu); Wi[(8 * part + 2 * e + 1) * MP + tt] = (bf16)(bw_[e] >> 16);
            Ti[(8 * part + 2 * e) * MP + tt] = (bf16)(bt_[e] & 0xffffu); Ti[(8 * part + 2 * e + 1) * MP + tt] = (bf16)(bt_[e] >> 16);
        }
    };
    f32x4 Zst[NV];
#pragma unroll
    for (int v2 = 0; v2 < NV; ++v2) Zst[v2] = (f32x4){0.f, 0.f, 0.f, 0.f};
    const f32x4 z4 = (f32x4){0.f, 0.f, 0.f, 0.f};
    gload(0); images(0); gload(1);
#pragma unroll 1
    for (int n = 0; n < NCH; ++n) {
        RAW_BARRIER();
        const LAS bf16* VT = (const LAS bf16*)(L0 + (5 + 3 * (n & 1)) * IMG); const LAS bf16* KcT = VT + 64 * MP; const LAS bf16* BcT = KcT + 64 * MP;
        const LAS bf16* Zi = (const LAS bf16*)(L0 + (12 + (n & 1)) * IMG); LAS bf16* Zn = (LAS bf16*)(L0 + (12 + ((n + 1) & 1)) * IMG);
        const int arow = (16 * it + l15) * MP + 8 * q;
        const fragb Wf0 = ld_frag16(Wi + arow), Wf1 = ld_frag16(Wi + arow + 32), Tf0 = ld_frag16(Ti + arow), Tf1 = ld_frag16(Ti + arow + 32), Rf0 = ld_frag16(Rh + arow), Rf1 = ld_frag16(Rh + arow + 32);
        const int icol = 16 * it + l15;
        f32x4 pk[4], pb[4];
#pragma unroll
        for (int jt = 0; jt < 4; ++jt) {
            pk[jt] = z4; pb[jt] = z4;
            if (jt <= it) {
                const int jrow = (16 * jt + l15) * MP + 8 * q;
                f32x4 sk = mfma16(ld_frag16(Kh + jrow), Rf0, z4); sk = mfma16(ld_frag16(Kh + jrow + 32), Rf1, sk);
                f32x4 sb = mfma16(ld_frag16(Bh + jrow), Rf0, z4); sb = mfma16(ld_frag16(Bh + jrow + 32), Rf1, sb);
#pragma unroll
                for (int r = 0; r < 4; ++r) { const int j = 16 * jt + 4 * q + r; pk[jt][r] = (j <= icol) ? sk[r] : 0.f; pb[jt][r] = (j <= icol) ? -sb[r] : 0.f; }
            }
        }
        fragb Pk0 = pack_frag(pk[0], pk[1]), Pk1 = pack_frag(pk[2], pk[3]), Pb0 = pack_frag(pb[0], pb[1]), Pb1 = pack_frag(pb[2], pb[3]);
        f32x4 RZ[NV];
#pragma unroll
        for (int v2 = 0; v2 < NV; ++v2) {
            const int vrow = 16 * (vt0 + v2) + l15;
            const fragb z0 = ld_frag16(Zi + vrow * MP + 8 * q), z1 = ld_frag16(Zi + vrow * MP + 32 + 8 * q);
            f32x4 u = mfma16(Wf0, z0, z4); u = mfma16(Wf1, z1, u);
            u = mfma16(Tf0, ld_frag16(VT + vrow * MP + 8 * q), u); if (it >= 2) u = mfma16(Tf1, ld_frag16(VT + vrow * MP + 32 + 8 * q), u);
            RZ[v2] = mfma16(Rf0, z0, z4); RZ[v2] = mfma16(Rf1, z1, RZ[v2]);
            v2u o; o.x = pk2(u.x, u.y); o.y = pk2(u.z, u.w);
            *(LAS v2u*)(UT + vrow * MP + 16 * it + 4 * q) = o;
        }
        RAW_BARRIER();
        {
            const f32x4 cl4 = *(const LAS f32x4*)(cLv + (n & 1) * 64 + 16 * it + 4 * q);
            const LAS bf16* kr = KcT + (16 * it + l15) * MP + 4 * q; const LAS bf16* br = BcT + (16 * it + l15) * MP + 4 * q;
            const fragb kc0 = ld_frag8x2(kr, kr + 16), kc1 = ld_frag8x2(kr + 32, kr + 48), bc0 = ld_frag8x2(br, br + 16), bc1 = ld_frag8x2(br + 32, br + 48);
#pragma unroll
            for (int v2 = 0; v2 < NV; ++v2) {
                const int vrow = 16 * (vt0 + v2) + l15;
                const LAS bf16* vr = VT + vrow * MP + 4 * q; const LAS bf16* ur = UT + vrow * MP + 4 * q;
                const fragb vp0 = ld_frag8x2(vr, vr + 16), vp1 = ld_frag8x2(vr + 32, vr + 48), up0 = ld_frag8x2(ur, ur + 16), up1 = ld_frag8x2(ur + 32, ur + 48);
                f32x4 y = mfma16(Pk0, vp0, RZ[v2]); y = mfma16(Pb0, up0, y);
                if (it >= 2) { y = mfma16(Pk1, vp1, y); y = mfma16(Pb1, up1, y); }
#pragma unroll
                for (int r = 0; r < 4; ++r) { const int row = seqrow_raster(n * 64 + 16 * it + 4 * q + r, d, b); if (!DRY) outb[(size_t)row * 256 + h * 64 + vrow] = (bf16)f2bf1(y[r]); }
                f32x4 zn = mfma16(kc0, vp0, z4); zn = mfma16(kc1, vp1, zn); zn = mfma16(bc0, up0, zn); zn = mfma16(bc1, up1, zn);
                Zst[v2] = Zst[v2] * cl4 + zn;
                v2u so; so.x = pk2(Zst[v2].x, Zst[v2].y); so.y = pk2(Zst[v2].z, Zst[v2].w);
                *(LAS v2u*)(Zn + vrow * MP + 16 * it + 4 * q) = so;
            }
        }
        if (n + 1 < NCH) { images((n + 1) & 1); if (n + 2 < NCH) gload(n + 2); }
    }
    __syncthreads();
}
__device__ __forceinline__ void moe_scatter(const Ctx& C, int moe_li, int nrows) {
    const unsigned* gc = WSP(const unsigned, WS_CTL) + CW_MOECNT + 64 * moe_li;
    LAS int* pst = (LAS int*)C.lds;
    {
        int pe[8]; int acc = 0;
#pragma unroll
        for (int e = 0; e < NE; ++e) { const int blks = ((int)gc[e] + 255) >> 8; if (C.tid == e) pst[e] = acc * 256; acc += blks; pe[e] = acc; }
        if (C.wg == 0 && C.tid < MOE_MAXBLK) { int be = 0;
#pragma unroll
            for (int e = 0; e < NE; ++e) be += (pe[e] <= C.tid) ? 1 : 0;
            int* tab = WSP(int, WS_TAB); tab[1 + C.tid] = be < NE ? be : NE - 1; if (C.tid == 0) tab[0] = acc; }
    }
    __syncthreads();
    const unsigned* route = WSP(const unsigned, WS_ROUTE); const unsigned* wgbase = WSP(const unsigned, WS_WGBASE);
    const bf16* hb = WSP(const bf16, WS_HB); bf16* am = WSP(bf16, WS_MIX); int* pos = WSP(int, WS_POS);
    const int gw = C.wg * NWAVES + C.wave, NGW = C.G * NWAVES;
    for (int m = gw; m < nrows; m += NGW) {
        const v4u a = *(const v4u*)(route + (size_t)m * 8);
        const int e0 = (int)a.x, e1 = (int)a.y;
        const int p0 = pst[e0] + (int)wgbase[C.wg * 8 + e0] + (int)a.z, p1 = pst[e1] + (int)wgbase[C.wg * 8 + e1] + (int)a.w;
        const v4u r0 = *(const v4u*)(hb + (size_t)m * 1024 + C.lane * 8), r1 = *(const v4u*)(hb + (size_t)m * 1024 + 512 + C.lane * 8);
        *(v4u*)(am + (size_t)p0 * 1024 + C.lane * 8) = r0; *(v4u*)(am + (size_t)p0 * 1024 + 512 + C.lane * 8) = r1;
        *(v4u*)(am + (size_t)p1 * 1024 + C.lane * 8) = r0; *(v4u*)(am + (size_t)p1 * 1024 + 512 + C.lane * 8) = r1;
        if (C.lane == 0) { pos[(size_t)m * 2] = p0; pos[(size_t)m * 2 + 1] = p1; }
    }
    __syncthreads();
}
template <int NEXT>
__device__ __forceinline__ void moe_combine(const Ctx& C, int l, int nrows) {
    const unsigned* route = WSP(const unsigned, WS_ROUTE); const int* pos = WSP(const int, WS_POS); const bf16* ym = WSP(const bf16, WS_MIX);
    const float* modv = WSP(const float, WS_MODV) + (size_t)l * 9 * 6144 + 5 * 1024;
    const float* modn = WSP(const float, WS_MODV) + (size_t)(l + 1) * 9 * 6144;
    float* xc = WSP(float, WS_XC); bf16* hb = WSP(bf16, WS_HB);
    const int gw = C.wg * NWAVES + C.wave, NGW = C.G * NWAVES;
    f32x4 gn[4];
#pragma unroll
    for (int j = 0; j < 4; ++j) gn[j] = *(const f32x4*)((NEXT == 2 ? C.in[I_FNG] : C.in[I_NMIXG] + (NEXT == 1 ? (l + 1) * 1024 : 0)) + 4 * C.lane + 256 * j);
    for (int m = gw; m < nrows; m += NGW) {
        const bool isctx = m >= T_LAT;
        float* xr = isctx ? xc + (size_t)(m - T_LAT) * 1024 : C.out + (size_t)m * 1024;
        const int mrow = isctx ? 8 : (m >> 12);
        const float* gv = modv + (size_t)mrow * 6144;
        const int p0 = pos[(size_t)m * 2], p1 = pos[(size_t)m * 2 + 1];
        const float w0 = __builtin_bit_cast(float, route[(size_t)m * 8 + 4]), w1 = __builtin_bit_cast(float, route[(size_t)m * 8 + 5]);
        f32x4 x[4]; float ss = 0.f;
#pragma unroll
        for (int j = 0; j < 4; ++j) {
            const int col = 4 * C.lane + 256 * j;
            const v2u a = *(const v2u*)(ym + (size_t)p0 * 1024 + col), b = *(const v2u*)(ym + (size_t)p1 * 1024 + col);
            const f32x4 ya = (f32x4){bflo(a.x), bfhi(a.x), bflo(a.y), bfhi(a.y)}, yb = (f32x4){bflo(b.x), bfhi(b.x), bflo(b.y), bfhi(b.y)};
            const f32x4 g = *(const f32x4*)(gv + col);
            x[j] = *(const f32x4*)(xr + col) + g * (ya * w0 + yb * w1);
            if (NEXT != 2) *(f32x4*)(xr + col) = x[j];
            ss += (x[j].x * x[j].x + x[j].y * x[j].y) + (x[j].z * x[j].z + x[j].w * x[j].w);
        }
        if (NEXT != 0) {
            const float rs = 1.0f / sqrtf(wave_sum(ss) * (1.0f / 1024.0f) + 1e-6f);
#pragma unroll
            for (int j = 0; j < 4; ++j) {
                const int col = 4 * C.lane + 256 * j;
                if (NEXT == 2) *(f32x4*)(xr + col) = x[j] * rs * gn[j];
                else { const f32x4 sh = *(const f32x4*)(modn + (size_t)mrow * 6144 + col), scl = *(const f32x4*)(modn + (size_t)mrow * 6144 + 1024 + col);
                    st4bf(hb + (size_t)m * 1024 + col, (x[j] * rs * gn[j]) * (scl + 1.0f) + sh); }
            }
        }
    }
}
__device__ __forceinline__ void final_norm(const Ctx& C) {
    const int gw = C.wg * NWAVES + C.wave, NGW = C.G * NWAVES;
    f32x4 gv[4];
#pragma unroll
    for (int j = 0; j < 4; ++j) gv[j] = *(const f32x4*)(C.in[I_FNG] + 4 * C.lane + 256 * j);
    for (int m = gw; m < T_LAT; m += NGW) {
        float* xr = C.out + (size_t)m * 1024;
        f32x4 v[4]; float s = 0.f;
#pragma unroll
        for (int j = 0; j < 4; ++j) { v[j] = *(const f32x4*)(xr + 4 * C.lane + 256 * j); s += (v[j].x * v[j].x + v[j].y * v[j].y) + (v[j].z * v[j].z + v[j].w * v[j].w); }
        const float rs = 1.0f / sqrtf(wave_sum(s) * (1.0f / 1024.0f) + 1e-6f);
#pragma unroll
        for (int j = 0; j < 4; ++j) *(f32x4*)(xr + 4 * C.lane + 256 * j) = v[j] * rs * gv[j];
    }
}

constexpr int NPH_L = 13, PH_FINAL = 1 + DEPTH * NPH_L, NPHASE = PH_FINAL + 1;
__host__ __device__ inline bool phase_exists(int ph) {
    if (ph == 0) return true;
    if (ph == PH_FINAL) return false;
    const int l = (ph - 1) / NPH_L, k = (ph - 1) % NPH_L;
    if (l >= 2 && !(l & 1) && k == 0) return false;
    if (!(l & 1) && k >= 11) return false;
    if (!RW_VSPLIT && k == 4) return false;
    return true;
}
#ifndef PH_MASK
#define PH_MASK 0xFFFFFF
#endif
#define PM(k) ((PH_MASK >> (k)) & 1)
#ifndef SK_MASK
#define SK_MASK 0xFFFF
#endif
#define SK(k) ((SK_MASK >> (k)) & 1)
#ifndef REP_MASK
#define REP_MASK 0
#endif
#define NREP(k) (((REP_MASK >> (k)) & 1) ? 2 : 1)

__global__ void __launch_bounds__(NTHR, 2) fwd_kernel(Args args) {
    extern __shared__ __attribute__((aligned(16))) unsigned char lds_raw[];
    Ctx C; C.in = args.in; C.out = args.out; C.ws = args.ws; C.lds = (LAS unsigned char*)lds_raw;
    C.tid = threadIdx.x; C.lane = C.tid & 63; C.wave = __builtin_amdgcn_readfirstlane(C.tid >> 6); C.G = gridDim.x; C.wg = blockIdx.x;
    volatile LAS unsigned* MISC = (volatile LAS unsigned*)(C.lds + MISC_OFF);
    if (C.tid < 64) MISC[C.tid] = 0u;
    __syncthreads();
    const int lo = args.ph_lo, hi = args.ph_hi;
    const bool multi = (hi - lo) > 1;
    if (multi) (void)xcd_barrier_post(WSP(unsigned, WS_CTL) + CW_BAR, MISC + 8);
#define IN(k) (lo <= (k) && (k) < hi)
#define SEAM(k) do { if (IN((k) + 1)) { XcdBarrier b2_; b2_.bar = WSP(unsigned, WS_CTL) + CW_BAR; b2_.x = xb_xcc_id(); b2_.st = (volatile LAS unsigned*)(C.lds + MISC_OFF) + 8; xcd_barrier(b2_); } } while (0)
#define FRESH() do { int t_ = threadIdx.x; asm volatile("" : "+v"(t_)); C.tid = t_; C.lane = t_ & 63; C.wave = __builtin_amdgcn_readfirstlane(t_ >> 6); } while (0)
#define PHASE(bit, k) if (PM(bit) && IN(pb + (k))) for (int rep_ = 0; rep_ < NREP(bit); ++rep_)
#define CLAIM(qh, var) __syncthreads(); if (C.tid == 0) *qslot = atomicAdd((qh), 1u); __syncthreads(); const int var = (int)*qslot;

    LAS unsigned* qslot = (LAS unsigned*)(C.lds + MISC_OFF + 128);
    if (PM(20) && IN(0)) { phase_pre(C); SEAM(0); }

#pragma unroll 1
    for (int l = 0; l < DEPTH; ++l) {
        const int pb = 1 + l * NPH_L;
        if (hi <= pb || lo >= pb + NPH_L) continue;
        const bool last = (l == DEPTH - 1), moe = (l & 1);
        const int nrows = last ? T_LAT : T_ALL;
        const float* xlat = (l == 0) ? C.in[I_X] : C.out; const float* xctx = (l == 0) ? C.in[I_CTX] : WSP(const float, WS_XC);
        const float* modv = WSP(const float, WS_MODV) + (size_t)l * 9 * 6144;
        unsigned* qbase = WSP(unsigned, WS_CTL) + CW_PREPQ + 256 * l;

        if (!(l >= 2 && !(l & 1))) PHASE(0, 0) { FRESH();
            convert_small(C, l);
            if (l == 0) { FRESH(); convert_items(C, 0, 3, C.wg * NWAVES + C.wave, C.G * NWAVES); }
            __syncthreads();
            FRESH(); norm_rows<false>(C, l, xlat, xctx, C.in[I_NMIXG] + l * 1024, 0, 1024, T_ALL, 0);
            SEAM(pb + 0);
        }
        PHASE(1, 1) { FRESH();
            pg8::Gemm g{WSP(const bf16, WS_HB), WSP(const bf16, WS_WIN), T_ALL, PLD, 1024, 0};
            pg8::StaticOrder S; S.init(T_ALL, PLD, C.G, C.wg);
            pg8::EpiBf16<0> E{WSP(bf16, WS_P), PLD, nullptr, 0, 0};
            pg8::gemm_phase<pg8::EpiBf16<0>, pg8::StaticOrder, false>(C.lds, g, S, E, nullptr);
            SEAM(pb + 1);
        }
        if (PM(2) && IN(pb + 2)) { FRESH();
            for (;;) {
                CLAIM(qbase, k)
                if (k >= 3 * NB * NCH) break;
                const int kind = k / (NB * NCH), u = k % (NB * NCH);
                FRESH();
                if (kind == 0) { if (SK(1)) rwkv_prep2(C, l, u / NCH, u % NCH); }
                else if (kind == 1) { if (SK(0)) lru_chunk_mfma<false>(C, l, u / NCH, u % NCH); }
                else { if (SK(2)) gdn_prep(C, l, u / NCH, u % NCH); }
            }
            SEAM(pb + 2);
        }
        if (PM(3) && IN(pb + 3)) { FRESH();
            constexpr int NCL = 2 * NB * NH * NCH / 4;
            for (;;) {
                CLAIM(qbase + 64, k)
                if (k >= (RW_VSPLIT ? NCL : 2 * NCL)) break;
                FRESH();
                if (k < NCL) { if (SK(9)) gdn_solve_item(C, l, 4 * k + (C.wave >> 1)); }
                else { if (SK(10)) rwkv_solve_item(C, l, 4 * (k - NCL) + (C.wave >> 1)); }
            }
            FRESH(); if (SK(6) && C.wg < 8) lru_carry(C, C.wg * NTHR + C.tid);
            SEAM(pb + (RW_VSPLIT ? 3 : 4));
        }
#if RW_VSPLIT
        if (PM(3) && IN(pb + 4)) { FRESH();
            for (;;) {
                CLAIM(qbase + 128, k)
                if (k >= 2 * NB * NH * NCH / 4) break;
                FRESH();
                if (SK(10)) rwkv_solve_item(C, l, 4 * k + (C.wave >> 1));
            }
            SEAM(pb + 4);
        }
#endif
        if (PM(4) && IN(pb + 5)) { FRESH();
            if (SK(3) && C.wg < (RW_VSPLIT ? 128 : 64)) { for (int r2_ = 0; r2_ < NREP(20); ++r2_) { FRESH(); rwkv_chunked<false>(C, l, C.wg); } }
            else if (SK(4) && C.wg >= 128 && C.wg < 192) { for (int r2_ = 0; r2_ < NREP(21); ++r2_) { FRESH(); mlstm_chunked(C, l, C.wg - 128); } }
            else if (SK(5) && C.wg >= 192) { if (NREP(22) > 1) { FRESH(); gdn_chunked<true>(C, l, C.wg - 192); } FRESH(); gdn_chunked<false>(C, l, C.wg - 192); }
            {
                FRESH();
                const int nun = last ? NB * 64 : NB * NCH;
                for (;;) {
                    CLAIM(qbase + 192, u0)
                    if (u0 >= 128 + nun) break;
                    if (u0 < 128) {
                        FRESH(); if (l > 0) convert_items(C, l, 2, u0 * NWAVES + C.wave, 128 * NWAVES);
                        if (l + 1 < DEPTH) { FRESH(); convert_items(C, l + 1, 1, u0 * NWAVES + C.wave, 128 * NWAVES); }
                    } else {
                        const int u = u0 - 128;
                        const int b = last ? (u >> 6) : (u / NCH), c = last ? 4 + (u & 63) : (u % NCH);
                        if (SK(7)) lru_chunk_mfma<true>(C, l, b, c);
                    }
                }
            }
            SEAM(pb + 5);
        }
        PHASE(5, 6) { FRESH();
            if (SK(8)) finish_rows(C, l, nrows);
            SEAM(pb + 6);
        }
        if (PM(6) && IN(pb + 7)) { FRESH();
            pg8::Gemm g{WSP(const bf16, WS_HB), WSP(const bf16, WS_WOUT), nrows, 1024, 1024, 0};
            pg8::StaticOrder S; S.init(nrows, 1024, C.G, C.wg);
            pg8::EpiRes E{xlat, xctx, C.out, WSP(float, WS_XC), modv + 2 * 1024};
            pg8::gemm_phase<pg8::EpiRes, pg8::StaticOrder, false>(C.lds, g, S, E, nullptr);
            SEAM(pb + 7);
        }
        if (PM(7) && IN(pb + 8)) { FRESH();
            if (moe) norm_rows<true>(C, l, C.out, WSP(const float, WS_XC), C.in[I_NFFNG] + l * 1024, 3 * 1024, 4 * 1024, nrows, l >> 1);
            else norm_rows<false>(C, l, C.out, WSP(const float, WS_XC), C.in[I_NFFNG] + l * 1024, 3 * 1024, 4 * 1024, nrows, 0);
            SEAM(pb + 8);
        }
        if (!moe) {
            if (PM(8) && IN(pb + 9)) { FRESH();
                pg8::Gemm g{WSP(const bf16, WS_HB), WSP(const bf16, WS_WGU), nrows, 2 * DFF, 1024, 0};
                pg8::StaticOrder S; S.init(nrows, 2 * DFF, C.G, C.wg);
                pg8::EpiSwiglu E{WSP(bf16, WS_P), DFF};
                pg8::gemm_phase<pg8::EpiSwiglu, pg8::StaticOrder, false>(C.lds, g, S, E, nullptr);
                SEAM(pb + 9);
            }
            if (PM(9) && IN(pb + 10)) { FRESH();
                pg8::Gemm g{WSP(const bf16, WS_P), WSP(const bf16, WS_WDN), nrows, 1024, DFF, 0};
                pg8::StaticOrder S; S.init(nrows, 1024, C.G, C.wg);
                pg8::EpiRes E{C.out, WSP(const float, WS_XC), C.out, WSP(float, WS_XC), modv + 5 * 1024};
                pg8::gemm_phase<pg8::EpiRes, pg8::StaticOrder, false>(C.lds, g, S, E, nullptr);
                SEAM(pb + 12);
            }
        } else {
            if (PM(10) && IN(pb + 9)) { FRESH(); moe_scatter(C, l >> 1, nrows); SEAM(pb + 9); }
            if (PM(11) && IN(pb + 10)) { FRESH();
                pg8::Gemm g{WSP(const bf16, WS_MIX), WSP(const bf16, WS_WGU), 0, 2 * DFE, 1024, (size_t)2 * DFE * 1024};
                pg8::MoeOrder S; S.init(WSP(const int, WS_TAB), (2 * DFE) / 256, C.G, C.wg);
                pg8::EpiSwiglu E{WSP(bf16, WS_P), DFE};
                pg8::gemm_phase<pg8::EpiSwiglu, pg8::MoeOrder, false>(C.lds, g, S, E, nullptr);
                SEAM(pb + 10);
            }
            if (PM(12) && IN(pb + 11)) { FRESH();
                pg8::Gemm g{WSP(const bf16, WS_P), WSP(const bf16, WS_WDN), 0, 1024, DFE, (size_t)1024 * DFE};
                pg8::MoeOrder S; S.init(WSP(const int, WS_TAB), 4, C.G, C.wg);
                pg8::EpiBf16<0> E{WSP(bf16, WS_MIX), 1024, nullptr, 0, 0};
                pg8::gemm_phase<pg8::EpiBf16<0>, pg8::MoeOrder, false>(C.lds, g, S, E, nullptr);
                SEAM(pb + 11);
            }
            if (PM(13) && IN(pb + 12)) { FRESH();
                if (last) moe_combine<2>(C, l, nrows);
                else { convert_small(C, l + 1); FRESH(); moe_combine<1>(C, l, nrows); if (IN(pb + NPH_L + 1)) { XcdBarrier b2_; b2_.bar = WSP(unsigned, WS_CTL) + CW_BAR; b2_.x = xb_xcc_id(); b2_.st = (volatile LAS unsigned*)(C.lds + MISC_OFF) + 8; xcd_barrier(b2_); } }
            }
        }
    }
}

extern "C" void kernel_launch(void* const* d_in, const int* in_sizes, int n_in, void* d_out, int out_size, void* d_ws, size_t ws_size, hipStream_t stream) {
    static int grid = 0;
    if (grid == 0) {
        if (n_in != N_IN || in_sizes[0] != T_LAT * DM || out_size != T_LAT * DM || ws_size < WS_END) {
            fprintf(stderr, "kernel_launch: unexpected problem (n_in %d, in0 %d, out %d, ws %zu < %zu)\n", n_in, n_in > 0 ? in_sizes[0] : -1, out_size, ws_size, (size_t)WS_END); grid = -1; return; }
        int dev = 0, cus = 0, per_cu = 0;
        if (hipGetDevice(&dev) != hipSuccess || hipDeviceGetAttribute(&cus, hipDeviceAttributeMultiprocessorCount, dev) != hipSuccess) { grid = -1; return; }
        if (hipFuncSetAttribute((const void*)fwd_kernel, hipFuncAttributeMaxDynamicSharedMemorySize, LDS_BYTES) != hipSuccess) { fprintf(stderr, "kernel_launch: hipFuncSetAttribute failed\n"); grid = -1; return; }
        if (hipOccupancyMaxActiveBlocksPerMultiprocessor(&per_cu, (const void*)fwd_kernel, NTHR, LDS_BYTES) != hipSuccess || per_cu < 1) { fprintf(stderr, "kernel_launch: occupancy query says %d\n", per_cu); grid = -1; return; }
        grid = cus;
        if (grid != 256) fprintf(stderr, "kernel_launch: note: %d CUs\n", grid);
    }
    if (grid < 0) return;
    if (hipMemsetAsync((char*)d_ws + WS_CTL, 0, CTL_BYTES, stream) != hipSuccess) return;
    Args a{};
    for (int i = 0; i < N_IN; ++i) a.in[i] = (const float*)d_in[i];
    a.out = (float*)d_out; a.ws = (unsigned char*)d_ws;
#if MK_ONE_LAUNCH
    a.ph_lo = 0; a.ph_hi = NPHASE;
    hipLaunchKernelGGL(fwd_kernel, dim3(grid), dim3(NTHR), LDS_BYTES, stream, a);
#else
    for (int ph = 0; ph < NPHASE; ++ph) { if (!phase_exists(ph)) continue; a.ph_lo = ph; a.ph_hi = ph + 1; hipLaunchKernelGGL(fwd_kernel, dim3(grid), dim3(NTHR), LDS_BYTES, stream, a); }
#endif
}
```

```cpp
#define MK_ONE_LAUNCH 1
#include <hip/hip_runtime.h>
#include <cstdio>
#include <cstdint>

#define GAS __attribute__((address_space(1)))
#define LAS __attribute__((address_space(3)))
typedef unsigned short bf16;
typedef unsigned v4u __attribute__((ext_vector_type(4)));
typedef unsigned v2u __attribute__((ext_vector_type(2)));
typedef float f32x4 __attribute__((ext_vector_type(4)));
typedef float f32x2 __attribute__((ext_vector_type(2)));
typedef short bf16x8 __attribute__((ext_vector_type(8)));
#define LDS_WAIT() asm volatile("s_waitcnt lgkmcnt(0)" ::: "memory")
#define VM_WAIT() asm volatile("s_waitcnt vmcnt(0)" ::: "memory")

constexpr int DM = 1024, NB = 8, SEQ = 4096, DEPTH = 4, CTXL = 256, GW = 256, HD = 64, NH = 4;
constexpr int T_LAT = NB * SEQ, T_CTX = NB * CTXL, T_ALL = T_LAT + T_CTX;
constexpr int IN_COLS = 3552, PLD = 3584;
constexpr int OFF_B = 512, OFF_C = 1472, OFF_D = 2512, B_COLS = 960;
constexpr int DFF = 2816, NE = 8, DFE = 1408;
constexpr int NCH = 68;
constexpr int NSTEP = 4352;
constexpr int MOE_MAXBLK = 280;
constexpr int NWAVES = 8, NTHR = 512;
#ifndef RW_VSPLIT
#define RW_VSPLIT 0
#endif

constexpr size_t MiB = 1u << 20;
constexpr size_t WS_CTL = 0, CTL_BYTES = 1 * MiB;
constexpr size_t WS_MODV = 1 * MiB;
constexpr size_t WS_XC = 2 * MiB;
constexpr size_t WS_WIN = 10 * MiB;
constexpr size_t WS_WOUT = 17 * MiB;
constexpr size_t WS_WGU = 19 * MiB;
constexpr size_t WS_WDN = 63 * MiB;
constexpr size_t WS_HB = 85 * MiB;
constexpr size_t WS_P = 153 * MiB;
constexpr size_t WS_MIX = 391 * MiB;
constexpr size_t WS_OUTB = WS_MIX, WS_OUTC = WS_MIX + 34 * MiB, WS_OUTD = WS_MIX + 68 * MiB, WS_GQ = WS_MIX + 102 * MiB, WS_G = WS_MIX + 153 * MiB;
constexpr size_t WS_RKV = WS_MIX + 170 * MiB;
constexpr size_t WS_SMALL = 612 * MiB;
constexpr size_t WS_LSUM = WS_SMALL;
constexpr size_t WS_HIN = WS_SMALL + 3 * MiB;
constexpr size_t WS_ROUTE = WS_SMALL + 5 * MiB;
constexpr size_t WS_POS = WS_SMALL + 7 * MiB;
constexpr size_t WS_BONUS = WS_SMALL + 8 * MiB;
constexpr size_t WS_WGBASE = WS_SMALL + 9 * MiB;
constexpr size_t WS_TAB = WS_WGBASE + 65536;
constexpr size_t WS_LRUWT = WS_SMALL + 10 * MiB;
constexpr size_t WS_RWT = WS_LRUWT + 131072;
constexpr size_t WS_RINV = WS_SMALL + 11 * MiB;
constexpr size_t WS_END = 624 * MiB;
constexpr int CW_MOECNT = 1024;
constexpr int CW_PREPQ = 2048;
constexpr int CW_BAR = 4096;

constexpr int LDS_BYTES = 135168;
constexpr int MISC_OFF = 131072;

__device__ __forceinline__ unsigned f2bf(float f) { unsigned u = __builtin_bit_cast(unsigned, f); return (u + 0x7fffu + ((u >> 16) & 1u)) >> 16; }
typedef __bf16 bf16n2 __attribute__((ext_vector_type(2)));
__device__ __forceinline__ unsigned pk2(float lo, float hi) { const f32x2 v = {lo, hi}; return __builtin_bit_cast(unsigned, __builtin_convertvector(v, bf16n2)); }
__device__ __forceinline__ unsigned f2bf1(float f) { return pk2(f, f) & 0xffffu; }
__device__ __forceinline__ float bf2f(unsigned short v) { return __builtin_bit_cast(float, (unsigned)v << 16); }
__device__ __forceinline__ float bflo(unsigned v) { return __builtin_bit_cast(float, v << 16); }
__device__ __forceinline__ float bfhi(unsigned v) { return __builtin_bit_cast(float, v & 0xffff0000u); }
__device__ __forceinline__ float wave_sum(float v) {
#pragma unroll
    for (int o = 1; o < 64; o <<= 1) v += __shfl_xor(v, o);
    return v;
}
template <int CTRL> __device__ __forceinline__ float dpp_f(float v) { return __builtin_bit_cast(float, __builtin_amdgcn_update_dpp(0, __builtin_bit_cast(int, v), CTRL, 0xF, 0xF, true)); }
__device__ __forceinline__ float row16_sum(float v) {
    v += dpp_f<0xB1>(v);
    v += dpp_f<0x4E>(v);
    v += dpp_f<0x141>(v);
    v += dpp_f<0x140>(v);
    return v;
}
__device__ __forceinline__ float sigmoidf_(float x) { return __builtin_amdgcn_rcpf(1.0f + __expf(-x)); }
__device__ __forceinline__ float softplusf_(float x) { return fmaxf(x, 0.f) + __logf(1.0f + __expf(-fabsf(x))); }
__device__ __forceinline__ float expm1f_(float x) { return x > -0.3f ? x * (1.0f + x * (0.5f + x * (0.16666667f + x * (0.041666668f + x * 0.0083333338f)))) : __expf(x) - 1.0f; }
__device__ __forceinline__ float siluf_(float x) { return x * __builtin_amdgcn_rcpf(1.0f + __expf(-x)); }
__device__ __forceinline__ float tanhf_(float x) { const float e = __expf(2.0f * x); return 1.0f - 2.0f * __builtin_amdgcn_rcpf(e + 1.0f); }
__device__ __forceinline__ float rsqrtf_(float x) { return __builtin_amdgcn_rsqf(x); }
__device__ __forceinline__ float gelu_tanh(float x) { return 0.5f * x * (1.0f + tanhf_(0.7978845608028654f * (x + 0.044715f * x * x * x))); }
__device__ __forceinline__ f32x4 ld4bf(const bf16* p) { const v2u a = *(const v2u*)p; return (f32x4){bflo(a.x), bfhi(a.x), bflo(a.y), bfhi(a.y)}; }
__device__ __forceinline__ void st4bf(bf16* p, const f32x4& v) { v2u o; o.x = pk2(v.x, v.y); o.y = pk2(v.z, v.w); *(v2u*)p = o; }
#define XB_TMO      128
#define XB_XCNT(j)  (256  + 64 * (j))
#define XB_XSUB(j)  (1280 + 64 * (j))
#define XB_XGEN(j)  (2304 + 64 * (j))
#define XB_TOP      3328
#define XB_TOPGEN   3392
#define XCD_BAR_WORDS 3456
#define XB_SPIN_CAP (1u << 22)

__device__ __forceinline__ unsigned xb_ld(unsigned* p)              { return __hip_atomic_load(p, __ATOMIC_RELAXED, __HIP_MEMORY_SCOPE_AGENT); }
__device__ __forceinline__ unsigned xb_add(unsigned* p, unsigned v) { return __hip_atomic_fetch_add(p, v, __ATOMIC_RELAXED, __HIP_MEMORY_SCOPE_AGENT); }
__device__ __forceinline__ unsigned xb_xcc_id() { return (unsigned)__builtin_amdgcn_s_getreg((3 << 11) | 20) & 0xFu; }
#define XB_SPIN(cond, bar) do { unsigned _sp = 0; while (cond) { __builtin_amdgcn_s_sleep(1); \
    if ((++_sp & 255u) == 0u) { if (xb_ld(&(bar)[XB_TMO])) break; if (_sp > XB_SPIN_CAP) { atomicAdd(&(bar)[XB_TMO], 1u); break; } } } } while (0)

struct XcdBarrier {
    unsigned* bar; unsigned x;
    volatile LAS unsigned* st;
};

__device__ __forceinline__ XcdBarrier xcd_barrier_post(unsigned* bar, volatile LAS unsigned* st) {
    XcdBarrier b; b.bar = bar; b.x = xb_xcc_id(); b.st = st;
    if (threadIdx.x == 0) (void)xb_add(&bar[XB_XCNT(b.x)], 1u);
    return b;
}
__device__ __forceinline__ void xcd_barrier_complete(unsigned* bar, unsigned x, unsigned& nloc, unsigned& nx) {
    const unsigned G = gridDim.x * gridDim.y * gridDim.z;
    unsigned sum, cnt, mine, sp = 0u;
    for (;;) {
        sum = 0u; cnt = 0u; mine = 0u;
#pragma unroll
        for (unsigned j = 0; j < 16; ++j) { const unsigned c = xb_ld(&bar[XB_XCNT(j)]); sum += c; cnt += (c > 0u) ? 1u : 0u; mine = (j == x) ? c : mine; }
        if (sum == G) break;
        __builtin_amdgcn_s_sleep(1);
        if ((++sp & 255u) == 0u) { if (xb_ld(&bar[XB_TMO])) break; if (sp > XB_SPIN_CAP) { atomicAdd(&bar[XB_TMO], 1u); break; } }
    }
    nloc = mine > 0u ? mine : 1u; nx = cnt > 0u ? cnt : 1u;
}

__device__ __forceinline__ void xcd_barrier(const XcdBarrier& b) {
    asm volatile("s_waitcnt vmcnt(0)" ::: "memory");
    __syncthreads();
    if (threadIdx.x == 0) {
        unsigned* bar = b.bar;
        __builtin_amdgcn_s_waitcnt(0);
        unsigned nloc = b.st[0], nx = b.st[1];
        if (nloc == 0u) { xcd_barrier_complete(bar, b.x, nloc, nx); b.st[0] = nloc; b.st[1] = nx; }
        const unsigned old = xb_add(&bar[XB_XSUB(b.x)], 1u);
        const unsigned gen = old / nloc;
        if (old + 1u == (gen + 1u) * nloc) {
            __builtin_amdgcn_fence(__ATOMIC_RELEASE, "agent");
            asm volatile("s_waitcnt vmcnt(0)" ::: "memory");
            const unsigned og = xb_add(&bar[XB_TOP], 1u);
            const unsigned tg = og / nx;
            if (og + 1u == (tg + 1u) * nx) xb_add(&bar[XB_TOPGEN], 1u);
            else XB_SPIN(xb_ld(&bar[XB_TOPGEN]) == tg, bar);
            __builtin_amdgcn_fence(__ATOMIC_ACQUIRE, "agent");
            xb_add(&bar[XB_XGEN(b.x)], 1u);
            asm volatile("s_waitcnt vmcnt(0)" ::: "memory");
        } else {
            XB_SPIN(xb_ld(&bar[XB_XGEN(b.x)]) == gen, bar);
            __builtin_amdgcn_fence(__ATOMIC_ACQUIRE, "agent");
            asm volatile("s_waitcnt vmcnt(0)" ::: "memory");
        }
    }
    __syncthreads();
}

namespace pg8 {
#define PG8_LAS __attribute__((address_space(3)))
typedef unsigned short bf16_t;
typedef short bf16x8 __attribute__((ext_vector_type(8)));
typedef float f32x4 __attribute__((ext_vector_type(4)));
typedef unsigned u32x4 __attribute__((ext_vector_type(4)));
constexpr int BM = 256, BK = 64, HALF = 128, HTB = HALF * BK * 2  , STAGE_BYTES = 8 * HTB, NXCD = 8, WGM = 8;

__host__ __device__ __forceinline__ int lds_byte(int r, int c) { const int st = (r >> 4) * 2 + (c >> 5), rr = r & 15, cc = c & 31, ob = rr * 64 + cc * 2; return st * 1024 + (ob ^ (((ob >> 9) & 1) << 5)); }
__host__ __device__ __forceinline__ void stage_rc(int b, int& R, int& C) { const int st = b / 1024, sb = b % 1024, swz = sb ^ (((sb >> 9) & 1) << 5); R = (st >> 1) * 16 + swz / 64; C = (st & 1) * 32 + (swz % 64) / 2; }
__host__ __device__ __forceinline__ int perm32(int rho) { const int n = rho >> 4, i = rho & 15; return 8 * (i >> 2) + 4 * n + (i & 3); }

struct Unit { int pm, pn, e; };
struct Gemm { const bf16_t* A; const bf16_t* Bt; int M, N, K; size_t estride; };

struct StaticOrder {
    int nM, nN, nwg, G, c;
    __host__ __device__ void init(int M, int N, int G_, int c_) { nM = M / BM; nN = N / BM; nwg = nM * nN; G = G_; c = c_; }
    __host__ __device__ bool next(int i, Unit& u) const {
        const long L = (long)i * G + c; if (L >= nwg) return false;
        int wgid = (int)L; { const int q = nwg / NXCD, r = nwg % NXCD, xcd = wgid % NXCD, off = wgid / NXCD; wgid = (xcd < r ? xcd * (q + 1) : r * (q + 1) + (xcd - r) * q) + off; }
        const int nig = WGM * nN, gid = wgid / nig, fm = gid * WGM, gsz = (nM - fm) < WGM ? (nM - fm) : WGM;
        u.pm = fm + ((wgid % nig) % gsz); u.pn = (wgid % nig) / gsz; u.e = 0; return true;
    }
    __device__ __forceinline__ void a_ready(const Unit&) const {}
    __device__ __forceinline__ void done(const Unit&) const {}
};
__device__ __forceinline__ unsigned cvt_pk_bf16(float lo, float hi) { unsigned r; asm volatile("v_cvt_pk_bf16_f32 %0, %1, %2" : "=v"(r) : "v"(lo), "v"(hi)); return r; }
typedef float f32x2 __attribute__((ext_vector_type(2)));
__device__ __forceinline__ f32x2 gelu_pk(f32x2 v) {
    const f32x2 av = __builtin_elementwise_abs(v), d = av * 0.2316418882f + 1.0f;
    f32x2 t; t.x = __builtin_amdgcn_rcpf(d.x); t.y = __builtin_amdgcn_rcpf(d.y);
    f32x2 q = t * 0.5307027145f + (-0.7265760135f); q = q * t + 0.7107068705f; q = q * t + (-0.142248368f); q = q * t + 0.127414796f; q = q * t;
    const f32x2 s = (v * v) * (-0.72134752044f);
    f32x2 e; e.x = __builtin_amdgcn_exp2f(s.x); e.y = __builtin_amdgcn_exp2f(s.y);
    const f32x2 m = v * (q * e), r = v - m;
    f32x2 o; o.x = v.x < 0.f ? m.x : r.x; o.y = v.y < 0.f ? m.y : r.y; return o;
}

struct EpiF32 {
    static constexpr bool PERM = false, AFTER_DRAIN = false;
    float* C; int ldc; const float* bias;
    __device__ __forceinline__ void operator()(const f32x4 (&acc)[2][2][4][2], const Unit& u, int wr, int wc, int fr, int fq) const {
        const int row0 = u.pm * BM + wr * 64 + fr, col0 = u.pn * BM + wc * 32 + 4 * fq;
        f32x4 bv[2][2];
#pragma unroll
        for (int bj = 0; bj < 2; ++bj)
#pragma unroll
            for (int n = 0; n < 2; ++n) bv[bj][n] = bias ? *(const f32x4*)(bias + col0 + bj * HALF + n * 16) : (f32x4){0.f, 0.f, 0.f, 0.f};
#pragma unroll
        for (int ai = 0; ai < 2; ++ai)
#pragma unroll
            for (int m = 0; m < 4; ++m) { float* rowp = C + (size_t)(row0 + ai * HALF + m * 16) * ldc + col0;
#pragma unroll
                for (int bj = 0; bj < 2; ++bj)
#pragma unroll
                    for (int n = 0; n < 2; ++n) *(f32x4*)(rowp + bj * HALF + n * 16) = acc[ai][bj][m][n] + bv[bj][n]; }
    }
};
template <int ACT  > struct EpiBf16 {
    static constexpr bool PERM = true, AFTER_DRAIN = false;
    bf16_t* O; int ldc; const float* bias; int split_cols; size_t split_stride;
    __device__ __forceinline__ void operator()(const f32x4 (&acc)[2][2][4][2], const Unit& u, int wr, int wc, int fr, int fq) const {
        const int row0 = u.pm * BM + wr * 64 + fr; int colt = u.pn * BM; bf16_t* base = O;
        if (split_cols) { const int t = colt / split_cols; base += (size_t)t * split_stride; colt -= t * split_cols; }
        const int col0 = colt + wc * 32 + 8 * fq, bcol0 = u.pn * BM + wc * 32 + 8 * fq;
        f32x4 bv[2][2];
#pragma unroll
        for (int bj = 0; bj < 2; ++bj)
#pragma unroll
            for (int n = 0; n < 2; ++n) bv[bj][n] = bias ? *(const f32x4*)(bias + bcol0 + bj * HALF + 4 * n) : (f32x4){0.f, 0.f, 0.f, 0.f};
#pragma unroll
        for (int ai = 0; ai < 2; ++ai)
#pragma unroll
            for (int m = 0; m < 4; ++m) { bf16_t* rowp = base + (size_t)(row0 + ai * HALF + m * 16) * ldc + col0;
#pragma unroll
                for (int bj = 0; bj < 2; ++bj) { f32x4 v0 = acc[ai][bj][m][0] + bv[bj][0], v1 = acc[ai][bj][m][1] + bv[bj][1];
                    if (ACT == 1) { f32x2 a = gelu_pk((f32x2){v0[0], v0[1]}), b = gelu_pk((f32x2){v0[2], v0[3]}), c = gelu_pk((f32x2){v1[0], v1[1]}), d = gelu_pk((f32x2){v1[2], v1[3]});
                        v0 = (f32x4){a.x, a.y, b.x, b.y}; v1 = (f32x4){c.x, c.y, d.x, d.y}; }
                    if (ACT == 2) {
#pragma unroll
                        for (int j = 0; j < 4; ++j) { v0[j] = 0.5f * v0[j] * (1.0f + erff(v0[j] * 0.70710678f)); v1[j] = 0.5f * v1[j] * (1.0f + erff(v1[j] * 0.70710678f)); } }
                    u32x4 w; w.x = cvt_pk_bf16(v0[0], v0[1]); w.y = cvt_pk_bf16(v0[2], v0[3]); w.z = cvt_pk_bf16(v1[0], v1[1]); w.w = cvt_pk_bf16(v1[2], v1[3]);
                    *(u32x4*)(rowp + bj * HALF) = w; } }
    }
};

template <class Epi, class Sched, bool STAMP = false>
__device__ __forceinline__ void gemm_phase(PG8_LAS unsigned char* lds, const Gemm g, const Sched& S, const Epi& E, unsigned long long* stamps) {
    int tid_ = threadIdx.x; asm volatile("" : "+v"(tid_));
    const int tid = tid_, wid = __builtin_amdgcn_readfirstlane(tid >> 6), lane = tid & 63, wr = wid >> 2, wc = wid & 3, fr = lane & 15, fq = lane >> 4;
    const int K = g.K, nt = K / BK;
    int ts_lo = 0, ts_hi = 0, nts = 0; const unsigned long long rt_entry = STAMP ? (unsigned long long)wall_clock64() : 0ull;
#define PG8_STAMP() do { if (STAMP && wid == 0 && nts < 64) { const unsigned long long _c = (unsigned long long)clock64(); \
        ts_lo = (lane == nts) ? (int)(unsigned)_c : ts_lo; ts_hi = (lane == nts) ? (int)(unsigned)(_c >> 32) : ts_hi; ++nts; } } while (0)
    PG8_STAMP();
    unsigned voffA[2], voffB[2];
#pragma unroll
    for (int i = 0; i < 2; ++i) { int R, C; stage_rc(tid * 16 + i * 8192, R, C); const int Rb = Epi::PERM ? ((R & ~31) + perm32(R & 31)) : R;
        voffA[i] = (unsigned)(R * K + C) * 2u; voffB[i] = (unsigned)(Rb * K + C) * 2u; }
    const size_t kstep = (size_t)(BK * 2);
    const size_t hstep = (size_t)HALF * K * 2;
    const size_t tstep = 2 * hstep;
    const unsigned ldsw = (unsigned)wid * 1024u;
    const int aoff = lds_byte(wr * 64 + fr, fq * 8), boff = lds_byte(wc * 32 + fr, fq * 8);
#define PG8_SA(b, h) (((b) * 2 + (h)) * HTB)
#define PG8_SB(b, h) ((4 + (b) * 2 + (h)) * HTB)
#define PG8_STAGE(bufoff, gbase, voff) do { _Pragma("unroll") for (int _i = 0; _i < 2; ++_i) \
        __builtin_amdgcn_global_load_lds((const unsigned*)((const char*)(gbase) + (voff)[_i]), (PG8_LAS unsigned*)(lds + (bufoff) + ldsw + _i * 8192), 16, 0, 0); } while (0)
#define PG8_LDA(dst, b, h) do { _Pragma("unroll") for (int m = 0; m < 4; ++m) _Pragma("unroll") for (int k = 0; k < 2; ++k) dst[m][k] = *(const PG8_LAS bf16x8*)(lds + PG8_SA(b, h) + aoff + m * 2048 + k * 1024); } while (0)
#define PG8_LDB(dst, b, h) do { _Pragma("unroll") for (int n = 0; n < 2; ++n) _Pragma("unroll") for (int k = 0; k < 2; ++k) dst[n][k] = *(const PG8_LAS bf16x8*)(lds + PG8_SB(b, h) + boff + n * 2048 + k * 1024); } while (0)
#define PG8_MMA(ai, bj, At, Bt) do { __builtin_amdgcn_s_setprio(1); _Pragma("unroll") for (int m = 0; m < 4; ++m) _Pragma("unroll") for (int n = 0; n < 2; ++n) _Pragma("unroll") for (int k = 0; k < 2; ++k) \
        acc[ai][bj][m][n] = __builtin_amdgcn_mfma_f32_16x16x32_bf16(Bt[n][k], At[m][k], acc[ai][bj][m][n], 0, 0, 0); __builtin_amdgcn_s_setprio(0); } while (0)
#define PG8_WAIT_V(n) asm volatile("s_waitcnt vmcnt(" #n ")" ::: "memory")
#define PG8_WAIT_L(n) asm volatile("s_waitcnt lgkmcnt(" #n ")" ::: "memory")
#define PG8_BAR __builtin_amdgcn_s_barrier()
#define PG8_SCHED __builtin_amdgcn_sched_barrier(0)
    Unit cur, nxt; int ui = 0;
    if (!S.next(0, cur)) return;
    f32x4 acc[2][2][4][2];
#pragma unroll
    for (int a = 0; a < 2; ++a)
#pragma unroll
        for (int b = 0; b < 2; ++b)
#pragma unroll
            for (int m = 0; m < 4; ++m)
#pragma unroll
                for (int n = 0; n < 2; ++n) acc[a][b][m][n] = (f32x4){0.f, 0.f, 0.f, 0.f};
    bf16x8 At[4][2], B0[2][2], B1[2][2];
    const char* cA = (const char*)g.A + (size_t)cur.pm * tstep; const char* cB = (const char*)g.Bt + (size_t)cur.pn * tstep + (size_t)cur.e * g.estride * 2;
    S.a_ready(cur);
    PG8_STAGE(PG8_SB(0, 0), cB, voffB); PG8_STAGE(PG8_SA(0, 0), cA, voffA); PG8_STAGE(PG8_SB(0, 1), cB + hstep, voffB); PG8_STAGE(PG8_SA(0, 1), cA + hstep, voffA);
    if (wr == 1) PG8_BAR;
    PG8_WAIT_V(4); PG8_BAR;
    PG8_STAGE(PG8_SB(1, 0), cB + kstep, voffB); PG8_STAGE(PG8_SA(1, 0), cA + kstep, voffA); PG8_STAGE(PG8_SB(1, 1), cB + hstep + kstep, voffB);
    PG8_WAIT_V(6); PG8_BAR;
    PG8_STAMP();
    for (;;) {
        const bool has_next = S.next(ui + 1, nxt);
        const char* nA = has_next ? (const char*)g.A + (size_t)nxt.pm * tstep : cA; const char* nB = has_next ? (const char*)g.Bt + (size_t)nxt.pn * tstep + (size_t)nxt.e * g.estride * 2 : cB;
        for (int t = 0; t < nt; t += 2) {
            const bool last = (t == nt - 2);
            const char* a1 = cA + (size_t)(t + 1) * kstep;
            const char* a2 = last ? nA : cA + (size_t)(t + 2) * kstep; const char* b2 = last ? nB : cB + (size_t)(t + 2) * kstep;
            const char* a3 = a2 + kstep; const char* b3 = b2 + kstep;
            if (last && has_next) S.a_ready(nxt);
            PG8_LDB(B0, 0, 0); PG8_SCHED; PG8_LDA(At, 0, 0); PG8_STAGE(PG8_SA(1, 1), a1 + hstep, voffA);
            PG8_WAIT_L(8); PG8_BAR; PG8_WAIT_L(0); PG8_MMA(0, 0, At, B0); PG8_BAR; PG8_SCHED;
            PG8_LDB(B1, 0, 1); PG8_STAGE(PG8_SB(0, 0), b2, voffB);
            PG8_BAR; PG8_WAIT_L(0); PG8_MMA(0, 1, At, B1); PG8_BAR;
            PG8_LDA(At, 0, 1); PG8_STAGE(PG8_SA(0, 0), a2, voffA);
            PG8_BAR; PG8_WAIT_L(0); PG8_MMA(1, 0, At, B0); PG8_BAR; PG8_SCHED;
            PG8_STAGE(PG8_SB(0, 1), b2 + hstep, voffB);
            PG8_WAIT_V(6); PG8_BAR; PG8_MMA(1, 1, At, B1); PG8_BAR;
            PG8_LDB(B0, 1, 0); PG8_SCHED; PG8_LDA(At, 1, 0); PG8_STAGE(PG8_SA(0, 1), a2 + hstep, voffA);
            PG8_WAIT_L(8); PG8_BAR; PG8_WAIT_L(0); PG8_MMA(0, 0, At, B0); PG8_BAR; PG8_SCHED;
            PG8_LDB(B1, 1, 1); PG8_STAGE(PG8_SB(1, 0), b3, voffB);
            PG8_BAR; PG8_WAIT_L(0); PG8_MMA(0, 1, At, B1); PG8_BAR;
            PG8_LDA(At, 1, 1); PG8_STAGE(PG8_SA(1, 0), a3, voffA);
            PG8_BAR; PG8_WAIT_L(0); PG8_MMA(1, 0, At, B0); PG8_BAR; PG8_SCHED;
            PG8_STAGE(PG8_SB(1, 1), b3 + hstep, voffB);
            PG8_WAIT_V(6); PG8_BAR; PG8_MMA(1, 1, At, B1); PG8_BAR;
        }
        PG8_STAMP();
        if constexpr (!Epi::AFTER_DRAIN) { E(acc, cur, wr, wc, fr, fq); S.done(cur); }
        PG8_STAMP();
        if (!has_next) break;
#pragma unroll
        for (int a = 0; a < 2; ++a)
#pragma unroll
            for (int b = 0; b < 2; ++b)
#pragma unroll
                for (int m = 0; m < 4; ++m)
#pragma unroll
                    for (int n = 0; n < 2; ++n) acc[a][b][m][n] = (f32x4){0.f, 0.f, 0.f, 0.f};
        cur = nxt; cA = nA; cB = nB; ++ui;
    }
    PG8_WAIT_V(0);
    if (wr == 0) PG8_BAR;
    PG8_BAR;
    if constexpr (Epi::AFTER_DRAIN) { E.fused(acc, cur, wr, wc, fr, fq, lds, wid, lane); S.done(cur); }
    PG8_STAMP();
    if (STAMP && wid == 0) { stamps[lane] = lane < nts ? (((unsigned long long)(unsigned)ts_hi << 32) | (unsigned)ts_lo) : 0ull;
        if (lane == 62) stamps[62] = rt_entry; if (lane == 63) stamps[63] = (unsigned long long)wall_clock64(); }
#undef PG8_STAMP
#undef PG8_SA
#undef PG8_SB
#undef PG8_STAGE
#undef PG8_LDA
#undef PG8_LDB
#undef PG8_MMA
#undef PG8_WAIT_V
#undef PG8_WAIT_L
#undef PG8_BAR
#undef PG8_SCHED
}
}
namespace pg8 {
struct EpiRes {
    static constexpr bool PERM = false, AFTER_DRAIN = false;
    const float* base_lat; const float* base_ctx; float* out_lat; float* out_ctx; const float* gvec;
    __device__ __forceinline__ void operator()(const f32x4 (&acc)[2][2][4][2], const Unit& u, int wr, int wc, int fr, int fq) const {
        const bool isctx = u.pm >= 128;
        const int prow = (isctx ? (u.pm - 128) : u.pm) * BM;
        const float* base = isctx ? base_ctx : base_lat; float* out = isctx ? out_ctx : out_lat;
        const float* gv = gvec + (size_t)(isctx ? 8 : (u.pm >> 4)) * 6144;
        const int row0 = prow + wr * 64 + fr, col0 = u.pn * BM + wc * 32 + 4 * fq;
        f32x4 gvv[2][2];
#pragma unroll
        for (int bj = 0; bj < 2; ++bj)
#pragma unroll
            for (int n = 0; n < 2; ++n) gvv[bj][n] = *(const f32x4*)(gv + col0 + bj * HALF + n * 16);
#pragma unroll
        for (int ai = 0; ai < 2; ++ai)
#pragma unroll
            for (int m = 0; m < 4; ++m) { const size_t off = (size_t)(row0 + ai * HALF + m * 16) * 1024 + col0;
#pragma unroll
                for (int bj = 0; bj < 2; ++bj)
#pragma unroll
                    for (int n = 0; n < 2; ++n) { const f32x4 b = *(const f32x4*)(base + off + bj * HALF + n * 16);
                        *(f32x4*)(out + off + bj * HALF + n * 16) = b + gvv[bj][n] * acc[ai][bj][m][n]; } }
    }
};
struct EpiSwiglu {
    static constexpr bool PERM = true, AFTER_DRAIN = false;
    bf16_t* O; int ldc;
    __device__ __forceinline__ void operator()(const f32x4 (&acc)[2][2][4][2], const Unit& u, int wr, int wc, int fr, int fq) const {
        const int row0 = u.pm * BM + wr * 64 + fr, col0 = u.pn * HALF + wc * 32 + 8 * fq;
#pragma unroll
        for (int ai = 0; ai < 2; ++ai)
#pragma unroll
            for (int m = 0; m < 4; ++m) { bf16_t* rowp = O + (size_t)(row0 + ai * HALF + m * 16) * ldc + col0;
                float h[8];
#pragma unroll
                for (int n = 0; n < 2; ++n)
#pragma unroll
                    for (int j = 0; j < 4; ++j) { const float g = acc[ai][0][m][n][j], up = acc[ai][1][m][n][j]; h[n * 4 + j] = g * __builtin_amdgcn_rcpf(1.0f + __expf(-g)) * up; }
                u32x4 w; w.x = cvt_pk_bf16(h[0], h[1]); w.y = cvt_pk_bf16(h[2], h[3]); w.z = cvt_pk_bf16(h[4], h[5]); w.w = cvt_pk_bf16(h[6], h[7]);
                *(u32x4*)rowp = w; }
    }
};
struct MoeOrder {
    int nN, G, c, nunits; const int* tab;
    __device__ void init(const int* tab_, int nN_, int G_, int c_) { tab = tab_; nN = nN_; G = G_; c = c_; nunits = tab_[0] * nN_; }
    __device__ bool next(int i, Unit& u) const {
        const int L = i * G + c; if (L >= nunits) return false;
        u.pm = L / nN; u.pn = L - u.pm * nN; u.e = tab[1 + u.pm]; return true;
    }
    __device__ __forceinline__ void a_ready(const Unit&) const {}
    __device__ __forceinline__ void done(const Unit&) const {}
};
}
enum { I_X = 0, I_C, I_CTX, I_CCTX, I_MODW, I_MODB, I_NMIXG, I_NFFNG, I_WIN, I_WOUT, I_LCW, I_LCB, I_LWA, I_LBA, I_LWX, I_LBX, I_LLAM,
       I_RMU, I_RWUP, I_RW0, I_RAUP, I_RA0, I_RGUP, I_RKK, I_RKA, I_RRK, I_RLNG, I_RLNB, I_MIB, I_MFB, I_MNG, I_GCW, I_GALOG, I_GDTB, I_GNG,
       I_FWG, I_FWU, I_FWD, I_MROUTER, I_MWG, I_MWU, I_MWD, I_FNG, N_IN };
struct Args { const float* in[N_IN]; float* out; unsigned char* ws; int ph_lo, ph_hi; };
struct Ctx {
    const float* const* in; float* out; unsigned char* ws; LAS unsigned char* lds;
    int tid, lane, wave, G, wg;
};
#define WSP(T, off) ((T*)(C.ws + (off)))

__device__ __forceinline__ int seqrow_raster(int i, int d, int b) {
    if (i < CTXL) { const int p = d ? (CTXL - 1 - i) : i; return T_LAT + b * CTXL + p; }
    const int j = i - CTXL; const int p = d ? (SEQ - 1 - j) : j; return b * SEQ + p;
}
__device__ __forceinline__ int seqrow_cm(int i, int d, int b) {
    if (i < CTXL) { const int p = d ? (CTXL - 1 - i) : i; return T_LAT + b * CTXL + p; }
    const int j = i - CTXL; const int p = d ? (SEQ - 1 - j) : j; return b * SEQ + (p & 63) * 64 + (p >> 6);
}

__device__ __forceinline__ void phase_pre(const Ctx& C) {
    LAS float* sc = (LAS float*)C.lds;
    LAS float* red = sc + 9 * 1024;
    float* modv = WSP(float, WS_MODV);
    bool filled = false;
    for (int it = C.wg; it < DEPTH * 48; it += C.G) {
        if (!filled) {
            for (int i = C.tid; i < 9 * 1024; i += NTHR) { const float v = i < 8192 ? C.in[I_C][i] : C.in[I_CCTX][i - 8192]; sc[i] = siluf_(v); }
            filled = true; __syncthreads();
        }
        const int l = it / 48, jb = it % 48, col = C.tid & 127, kg = C.tid >> 7;
        const float* W = C.in[I_MODW] + (size_t)l * 1024 * 6144 + jb * 128 + col;
        float acc[9];
#pragma unroll
        for (int r = 0; r < 9; ++r) acc[r] = 0.f;
        for (int k = kg * 256; k < kg * 256 + 256; ++k) { const float w = W[(size_t)k * 6144];
#pragma unroll
            for (int r = 0; r < 9; ++r) acc[r] += sc[r * 1024 + k] * w; }
#pragma unroll
        for (int r = 0; r < 9; ++r) red[(kg * 9 + r) * 128 + col] = acc[r];
        __syncthreads();
        for (int i = C.tid; i < 9 * 128; i += NTHR) { const int r = i >> 7, cc = i & 127;
            const float s = red[(0 * 9 + r) * 128 + cc] + red[(1 * 9 + r) * 128 + cc] + red[(2 * 9 + r) * 128 + cc] + red[(3 * 9 + r) * 128 + cc];
            modv[((size_t)l * 9 + r) * 6144 + jb * 128 + cc] = s + C.in[I_MODB][l * 6144 + jb * 128 + cc]; }
        __syncthreads();
    }
}

__device__ __forceinline__ void tr_item(const float* src, size_t ld, int k0, int ns0, bf16* dst, int drow0, int Kd, LAS float* scr, int lane, bool zero) {
    if (!zero) {
#pragma unroll 8
        for (int i = 0; i < 32; ++i) { const int kk = 2 * i + (lane >> 5); scr[kk * 33 + (lane & 31)] = src[(size_t)(k0 + kk) * ld + ns0 + (lane & 31)]; }
    }
    LDS_WAIT(); asm volatile("" ::: "memory");
    const int c = lane & 7;
#pragma unroll
    for (int j = 0; j < 4; ++j) { const int n = (lane >> 3) + 8 * j; const LAS float* s = scr + (8 * c) * 33 + n;
        v4u o; o.x = pk2(s[0 * 33], s[1 * 33]); o.y = pk2(s[2 * 33], s[3 * 33]); o.z = pk2(s[4 * 33], s[5 * 33]); o.w = pk2(s[6 * 33], s[7 * 33]);
        if (zero) o = (v4u){0u, 0u, 0u, 0u};
        *(v4u*)(dst + (size_t)(drow0 + n) * Kd + k0 + 8 * c) = o; }
    LDS_WAIT(); asm volatile("" ::: "memory");
}
__device__ __forceinline__ void convert_small(const Ctx& C, int l) {
    {
        bf16* lw = WSP(bf16, WS_LRUWT);
        for (int k = 0; k < 2 * 2 * 4 * 4096 / (128 * NTHR); ++k) {
            const int e = k * 128 * NTHR + C.wg * NTHR + C.tid;
            if (C.wg < 128) {
            const int i = e & 63, j = (e >> 6) & 63, hd = (e >> 12) & 3, g = (e >> 14) & 1, d = e >> 15;
            const float* src = (g ? C.in[I_LWX] : C.in[I_LWA]) + ((size_t)((l * 2 + d) * 4 + hd) * 64 + i) * 64 + j;
            lw[e] = (bf16)f2bf(*src);
            }
        }
    }
    if (C.wg >= 128 && C.wg < 224) {
        bf16* rw = WSP(bf16, WS_RWT);
        const int e = (C.wg - 128) * NTHR + C.tid;
        if (e < 32768) { const int r = e & 31, ch = (e >> 5) & 255, d = (e >> 13) & 1, isa = e >> 14;
            rw[e] = (bf16)f2bf((isa ? C.in[I_RAUP] : C.in[I_RWUP])[((size_t)(l * 2 + d) * 32 + r) * GW + ch]); }
        else { const int e2 = e - 32768, j = e2 & 63, ch = e2 >> 6; rw[e] = (bf16)f2bf(C.in[I_RGUP][((size_t)l * 64 + j) * GW + ch]); }
    }
}
__device__ __forceinline__ void convert_items(const Ctx& C, int l, int what, int gw, int NGW) {
    LAS float* scr = (LAS float*)(C.lds + C.wave * 8704);
    constexpr int I_IN = 16 * 112, I_OUT = 16 * 32, I_GU = 16 * 176, I_DN = 44 * 32, I_E = 16 * 88 + 22 * 32;
    const bool moe = l & 1; const int li = l >> 1;
    const int lo_it = (what & 1) ? 0 : I_IN, hi_it = (what & 2) ? I_IN + I_OUT + (moe ? NE * I_E : (I_GU + I_DN)) : I_IN;
    bf16* win = WSP(bf16, WS_WIN); bf16* wout = WSP(bf16, WS_WOUT); bf16* wgu = WSP(bf16, WS_WGU); bf16* wdn = WSP(bf16, WS_WDN);
    for (int it = lo_it + gw; it < hi_it; it += NGW) {
        int r = it;
        if (r < I_IN) { const int kb = r / 112, nb = r % 112; tr_item(C.in[I_WIN] + (size_t)l * 1024 * IN_COLS, IN_COLS, 64 * kb, 32 * nb, win, 32 * nb, 1024, scr, C.lane, nb == 111); continue; }
        r -= I_IN;
        if (r < I_OUT) { const int kb = r / 32, nb = r % 32; tr_item(C.in[I_WOUT] + (size_t)l * 1024 * 1024, 1024, 64 * kb, 32 * nb, wout, 32 * nb, 1024, scr, C.lane, false); continue; }
        r -= I_OUT;
        if (!moe) {
            if (r < I_GU) { const int kb = r / 176, nb = r % 176, tile = nb >> 3, q = nb & 7;
                const float* src = (q < 4 ? C.in[I_FWG] : C.in[I_FWU]) + (size_t)li * 1024 * DFF;
                tr_item(src, DFF, 64 * kb, tile * 128 + (q & 3) * 32, wgu, 32 * nb, 1024, scr, C.lane, false); continue; }
            r -= I_GU;
            { const int kb = r / 32, nb = r % 32; tr_item(C.in[I_FWD] + (size_t)li * DFF * 1024, 1024, 64 * kb, 32 * nb, wdn, 32 * nb, DFF, scr, C.lane, false); }
        } else {
            const int e = r / I_E; int rr = r % I_E;
            if (rr < 16 * 88) { const int kb = rr / 88, nb = rr % 88, tile = nb >> 3, q = nb & 7;
                const float* src = (q < 4 ? C.in[I_MWG] : C.in[I_MWU]) + ((size_t)li * NE + e) * 1024 * DFE;
                tr_item(src, DFE, 64 * kb, tile * 128 + (q & 3) * 32, wgu + (size_t)e * 2 * DFE * 1024, 32 * nb, 1024, scr, C.lane, false); continue; }
            rr -= 16 * 88;
            { const int kb = rr / 32, nb = rr % 32; tr_item(C.in[I_MWD] + ((size_t)li * NE + e) * DFE * 1024, 1024, 64 * kb, 32 * nb, wdn + (size_t)e * 1024 * DFE, 32 * nb, DFE, scr, C.lane, false); }
        }
    }
}

template <bool ROUTE>
__device__ __forceinline__ void norm_rows(const Ctx& C, int l, const float* xlat, const float* xctx, const float* gain, int shoff, int scoff, int nrows, int moe_li) {
    const float* modv = WSP(float, WS_MODV) + (size_t)l * 9 * 6144;
    bf16* hb = WSP(bf16, WS_HB);
    const int gw = C.wg * NWAVES + C.wave, NGW = C.G * NWAVES;
    LAS unsigned* lcnt = (LAS unsigned*)(C.lds + 65536);
    unsigned* route = WSP(unsigned, WS_ROUTE);
    if (ROUTE) { if (C.tid < 8) lcnt[C.tid] = 0u; __syncthreads(); }
    f32x4 gv[4];
#pragma unroll
    for (int j = 0; j < 4; ++j) gv[j] = *(const f32x4*)(gain + 4 * C.lane + 256 * j);
    for (int m = gw; m < nrows; m += NGW) {
        const bool isctx = m >= T_LAT;
        const float* xr = isctx ? xctx + (size_t)(m - T_LAT) * 1024 : xlat + (size_t)m * 1024;
        const float* mv = modv + (size_t)(isctx ? 8 : (m >> 12)) * 6144;
        f32x4 v[4]; float s = 0.f;
#pragma unroll
        for (int j = 0; j < 4; ++j) { v[j] = *(const f32x4*)(xr + 4 * C.lane + 256 * j); s += (v[j].x * v[j].x + v[j].y * v[j].y) + (v[j].z * v[j].z + v[j].w * v[j].w); }
        const float rs = rsqrtf_(wave_sum(s) * (1.0f / 1024.0f) + 1e-6f);
#pragma unroll
        for (int j = 0; j < 4; ++j) { const f32x4 sh = *(const f32x4*)(mv + shoff + 4 * C.lane + 256 * j), scl = *(const f32x4*)(mv + scoff + 4 * C.lane + 256 * j);
            v[j] = (v[j] * rs * gv[j]) * (scl + 1.0f) + sh;
            v2u o; o.x = pk2(v[j].x, v[j].y); o.y = pk2(v[j].z, v[j].w);
            *(v2u*)(hb + (size_t)m * 1024 + 4 * C.lane + 256 * j) = o; }
        if (ROUTE) {
            const float* rt = C.in[I_MROUTER] + (size_t)moe_li * 1024 * NE;
            float lg[8];
#pragma unroll
            for (int e = 0; e < 8; ++e) lg[e] = 0.f;
#pragma unroll
            for (int j = 0; j < 4; ++j)
#pragma unroll
                for (int q = 0; q < 4; ++q) { const int k = 4 * C.lane + 256 * j + q; const f32x4 r0 = *(const f32x4*)(rt + (size_t)k * 8), r1 = *(const f32x4*)(rt + (size_t)k * 8 + 4); const float hv = v[j][q];
                    lg[0] += hv * r0.x; lg[1] += hv * r0.y; lg[2] += hv * r0.z; lg[3] += hv * r0.w; lg[4] += hv * r1.x; lg[5] += hv * r1.y; lg[6] += hv * r1.z; lg[7] += hv * r1.w; }
#pragma unroll
            for (int e = 0; e < 8; ++e) lg[e] = wave_sum(lg[e]);
            int e0 = 0; float l0 = lg[0];
#pragma unroll
            for (int e = 1; e < 8; ++e) if (lg[e] > l0) { l0 = lg[e]; e0 = e; }
            int e1 = (e0 == 0) ? 1 : 0; float l1 = -3.0e38f;
#pragma unroll
            for (int e = 0; e < 8; ++e) if (e != e0 && lg[e] > l1) { l1 = lg[e]; e1 = e; }
            const float w0 = __builtin_amdgcn_rcpf(1.0f + __expf(l1 - l0)), w1 = 1.0f - w0;
            if (C.lane == 0) {
                const unsigned r0 = atomicAdd((unsigned*)&lcnt[e0], 1u), r1 = atomicAdd((unsigned*)&lcnt[e1], 1u);
                v4u a; a.x = (unsigned)e0; a.y = (unsigned)e1; a.z = r0; a.w = r1;
                *(v4u*)(route + (size_t)m * 8) = a;
                v2u b; b.x = __builtin_bit_cast(unsigned, w0); b.y = __builtin_bit_cast(unsigned, w1);
                *(v2u*)(route + (size_t)m * 8 + 4) = b;
            }
        }
    }
    if (ROUTE) {
        __syncthreads();
        if (C.tid < 8) { unsigned* gc = WSP(unsigned, WS_CTL) + CW_MOECNT + 64 * moe_li; const unsigned base = atomicAdd(gc + C.tid, lcnt[C.tid]); WSP(unsigned, WS_WGBASE)[C.wg * 8 + C.tid] = base; }
    }
}
template <bool FIN>
__device__ __forceinline__ void lru_chunk(const Ctx& C, int l, int b, int c) {
    LAS float* U = (LAS float*)C.lds;
    const bf16* P = WSP(const bf16, WS_P);
    const bool isctx = c < 4; const int p0 = isctx ? c * 64 : (c - 4) * 64; const int Lp = isctx ? CTXL : SEQ; const int row0 = isctx ? T_LAT + b * CTXL : b * SEQ;
    const int ch = C.tid & 255, half = C.tid >> 8;
    {
        const float* cw = C.in[I_LCW] + (size_t)l * 4 * GW + ch; const float w0 = cw[0], w1 = cw[GW], w2 = cw[2 * GW], w3 = cw[3 * GW], cb = C.in[I_LCB][l * GW + ch];
        const int t0 = half * 32;
        auto ld = [&](int p) -> float { return (p >= 0 && p < Lp) ? bf2f(P[(size_t)(row0 + p) * PLD + ch]) : 0.f; };
        float xm2 = ld(p0 + t0 - 2), xm1 = ld(p0 + t0 - 1), x0 = ld(p0 + t0);
        for (int t = 0; t < 32; ++t) { const float xp1 = ld(p0 + t0 + t + 1); U[(t0 + t) * 256 + ch] = w0 * xm2 + w1 * xm1 + w2 * x0 + w3 * xp1 + cb; xm2 = xm1; xm1 = x0; x0 = xp1; }
    }
    __syncthreads();
    const int d = half, hd = ch >> 6, jj = ch & 63;
    const float* wa = C.in[I_LWA] + ((size_t)((l * 2 + d) * 4 + hd) * 64) * 64 + jj;
    const float* wx = C.in[I_LWX] + ((size_t)((l * 2 + d) * 4 + hd) * 64) * 64 + jj;
    const float ba = C.in[I_LBA][(l * 2 + d) * GW + ch], bx = C.in[I_LBX][(l * 2 + d) * GW + ch];
    const float sp8 = 8.0f * softplusf_(-C.in[I_LLAM][(l * 2 + d) * GW + ch]);
    const size_t sidx = ((size_t)(b * NCH + c) * 2 + d) * 256 + ch;
    float h = FIN ? WSP(const float, WS_HIN)[sidx] : 0.f, sla = 0.f;
    LAS bf16* H16 = (LAS bf16*)(U + 64 * 256) + d * 64 * 256;
    const int sgn = d ? -1 : 1;
#pragma unroll 1
    for (int g = 0; g < 4; ++g) {
        const int tstart = d ? (63 - g * 16) : g * 16;
        float ar[16], ai[16];
#pragma unroll
        for (int tt = 0; tt < 16; ++tt) { ar[tt] = 0.f; ai[tt] = 0.f; }
        const LAS float* ub = U + tstart * 256 + hd * 64;
#pragma unroll 1
        for (int i = 0; i < 64; i += 4) {
            float a4[4], x4[4];
#pragma unroll
            for (int q = 0; q < 4; ++q) { a4[q] = wa[(i + q) * 64]; x4[q] = wx[(i + q) * 64]; }
#pragma unroll
            for (int tt = 0; tt < 16; ++tt) { const f32x4 uu = *(const LAS f32x4*)(ub + sgn * tt * 256 + i);
                ar[tt] += uu.x * a4[0] + uu.y * a4[1] + uu.z * a4[2] + uu.w * a4[3];
                ai[tt] += uu.x * x4[0] + uu.y * x4[1] + uu.z * x4[2] + uu.w * x4[3]; }
        }
#pragma unroll
        for (int tt = 0; tt < 16; ++tt) {
            const int tok = tstart + sgn * tt;
            const float r = sigmoidf_(ar[tt] + ba), ig = sigmoidf_(ai[tt] + bx);
            const float la = -sp8 * r; const float a = __expf(la);
            const float bb = sqrtf(-expm1f_(2.0f * la)) * (ig * U[tok * 256 + ch]);
            h = a * h + bb; sla += la;
            if (FIN) H16[tok * 256 + ch] = (bf16)f2bf1(h);
        }
    }
    if (!FIN) { float* ls = WSP(float, WS_LSUM) + sidx * 2; ls[0] = sla; ls[1] = h; __syncthreads(); return; }
    __syncthreads();
    bf16* yc = WSP(bf16, WS_HB);
    const LAS bf16* H0 = (const LAS bf16*)(U + 64 * 256); const LAS bf16* H1 = H0 + 64 * 256;
    for (int t = half * 32; t < half * 32 + 32; ++t) {
        const size_t row = (size_t)(row0 + p0 + t);
        const float gate = bf2f(P[row * PLD + 256 + ch]);
        yc[row * 1024 + ch] = (bf16)f2bf1((bf2f(H0[t * 256 + ch]) + bf2f(H1[t * 256 + ch])) * gelu_tanh(gate));
    }
    __syncthreads();
}
__device__ __forceinline__ void lru_carry(const Ctx& C, int idx) {
    const int ch = idx & 255, d = (idx >> 8) & 1, b = idx >> 9;
    const float* ls = WSP(const float, WS_LSUM); float* hin = WSP(float, WS_HIN);
    float H = 0.f;
    for (int k = 0; k < NCH; ++k) {
        const int c = d ? (k < 4 ? 3 - k : NCH + 3 - k) : k;
        const size_t sidx = ((size_t)(b * NCH + c) * 2 + d) * 256 + ch;
        hin[sidx] = H;
        H = __expf(ls[sidx * 2]) * H + ls[sidx * 2 + 1];
    }
}

__device__ __forceinline__ float rw_shift(const bf16* P, int row0, int p, int Lp, int colB, float mu0, float mu1) {
    const size_t o = (size_t)(row0 + p) * PLD + OFF_B + colB;
    const float x = bf2f(P[o]);
    const float pv = p > 0 ? bf2f(P[o - PLD]) : 0.f, nx = p < Lp - 1 ? bf2f(P[o + PLD]) : 0.f;
    return x + mu0 * (pv - x) + mu1 * (nx - x);
}
__device__ __forceinline__ void rwkv_prep(const Ctx& C, int l, int b, int c) {
    LAS float* XW = (LAS float*)C.lds;
    LAS float* XA = XW + 64 * 64;
    LAS float* XG = XA + 64 * 64;
    const bf16* P = WSP(const bf16, WS_P);
    const bool isctx = c < 4; const int p0 = isctx ? c * 64 : (c - 4) * 64; const int Lp = isctx ? CTXL : SEQ; const int row0 = isctx ? T_LAT + b * CTXL : b * SEQ;
    const float* mu = C.in[I_RMU] + (size_t)l * 2 * B_COLS;
    for (int it = C.tid; it < 64 * 192; it += NTHR) {
        const int t = it / 192, ci = it % 192, colB = 768 + ci;
        const float v = rw_shift(P, row0, p0 + t, Lp, colB, mu[colB], mu[B_COLS + colB]);
        if (ci < 64) XW[t * 64 + ci] = tanhf_(v); else if (ci < 128) XA[t * 64 + ci - 64] = v; else XG[t * 64 + ci - 128] = sigmoidf_(v);
    }
    __syncthreads();
    const int ch = C.tid & 255, half = C.tid >> 8, head = ch >> 6;
    bf16* wa_out = WSP(bf16, WS_HB); bf16* g_out = WSP(bf16, WS_G); float* bonus = WSP(float, WS_BONUS);
    const float* wup = C.in[I_RWUP] + (size_t)l * 2 * 32 * GW + ch;
    const float* aup = C.in[I_RAUP] + (size_t)l * 2 * 32 * GW + ch;
    const float* gup = C.in[I_RGUP] + (size_t)l * 64 * GW + ch;
    const float w00 = C.in[I_RW0][(l * 2 + 0) * GW + ch], w01 = C.in[I_RW0][(l * 2 + 1) * GW + ch];
    const float a00 = C.in[I_RA0][(l * 2 + 0) * GW + ch], a01 = C.in[I_RA0][(l * 2 + 1) * GW + ch];
    const float k_a = C.in[I_RKA][l * GW + ch], r_k = C.in[I_RRK][l * GW + ch];
    const float mur0 = mu[ch], mur1 = mu[B_COLS + ch], muk0 = mu[256 + ch], muk1 = mu[B_COLS + 256 + ch];
#pragma unroll 1
    for (int sub = 0; sub < 2; ++sub) {
        const int t0 = half * 32 + sub * 16;
        float acc[16], av0[16], av1[16];
#pragma unroll
        for (int kind = 0; kind < 4; ++kind) {
            const int d = kind & 1; const bool isw = kind < 2;
            const float* W = (isw ? wup : aup) + (size_t)d * 32 * GW; const LAS float* X = (isw ? XW : XA) + d * 32;
#pragma unroll
            for (int t = 0; t < 16; ++t) acc[t] = 0.f;
            for (int r = 0; r < 32; r += 4) {
                const float g0 = W[(r + 0) * GW], g1 = W[(r + 1) * GW], g2 = W[(r + 2) * GW], g3 = W[(r + 3) * GW];
#pragma unroll
                for (int t = 0; t < 16; ++t) { const f32x4 x = *(const LAS f32x4*)(X + (t0 + t) * 64 + r); acc[t] += x.x * g0 + x.y * g1 + x.z * g2 + x.w * g3; }
            }
#pragma unroll
            for (int t = 0; t < 16; ++t) {
                const size_t row = (size_t)(row0 + p0 + t0 + t);
                float val;
                if (isw) val = __expf(-0.6065306597126334f * sigmoidf_(acc[t] + (d ? w01 : w00)));
                else { val = sigmoidf_(acc[t] + (d ? a01 : a00)); if (d) av1[t] = val; else av0[t] = val; }
                wa_out[row * 1024 + kind * 256 + ch] = (bf16)f2bf1(val);
            }
        }
#pragma unroll
        for (int t = 0; t < 16; ++t) acc[t] = 0.f;
        for (int j = 0; j < 64; j += 4) {
            const float g0 = gup[(j + 0) * GW], g1 = gup[(j + 1) * GW], g2 = gup[(j + 2) * GW], g3 = gup[(j + 3) * GW];
#pragma unroll
            for (int t = 0; t < 16; ++t) { const f32x4 x = *(const LAS f32x4*)(XG + (t0 + t) * 64 + j); acc[t] += x.x * g0 + x.y * g1 + x.z * g2 + x.w * g3; }
        }
#pragma unroll
        for (int t = 0; t < 16; ++t) {
            const int p = p0 + t0 + t; const size_t row = (size_t)(row0 + p);
            g_out[row * 256 + ch] = (bf16)f2bf1(acc[t]);
            const float rs = rw_shift(P, row0, p, Lp, ch, mur0, mur1), ks = rw_shift(P, row0, p, Lp, 256 + ch, muk0, muk1);
            const float km = ks * (1.0f + (av0[t] - 1.0f) * k_a) + ks * (1.0f + (av1[t] - 1.0f) * k_a);
            const float bs = wave_sum(rs * r_k * km);
            if (C.lane == 0) bonus[row * 4 + head] = bs;
        }
    }
    __syncthreads();
}
__device__ __forceinline__ void rwkv_scan(const Ctx& C, int l, int idx) {
    const int d = idx >> 6, b = (idx >> 3) & 7, h = (idx >> 1) & 3, half = idx & 1;
    LAS float* BUF = (LAS float*)C.lds;
    LAS float* YB = BUF + 2 * 32 * 6 * 64;
    const bf16* P = WSP(const bf16, WS_P); const bf16* WA = WSP(const bf16, WS_HB); bf16* outb = WSP(bf16, WS_OUTB) + (size_t)d * T_ALL * 256;
    const int st = C.tid >> 4, q4 = C.tid & 15, chh = h * 64 + q4 * 4;
    const float* mu = C.in[I_RMU] + (size_t)l * 2 * B_COLS;
    f32x4 mu0[3], mu1[3];
#pragma unroll
    for (int q = 0; q < 3; ++q) { mu0[q] = *(const f32x4*)(mu + q * 256 + chh); mu1[q] = *(const f32x4*)(mu + B_COLS + q * 256 + chh); }
    const f32x4 kk_w = *(const f32x4*)(C.in[I_RKK] + l * GW + chh), ka_w = *(const f32x4*)(C.in[I_RKA] + l * GW + chh);
    v2u gxc[3], gxp[3], gxn[3], gwr, gar;
    auto gload = [&](int nb) {
        const int i = nb * 32 + st;
        const bool isctx = i < CTXL; const int Lp = isctx ? CTXL : SEQ; const int j = isctx ? i : i - CTXL; const int p = d ? (Lp - 1 - j) : j;
        const int row = (isctx ? T_LAT + b * CTXL : b * SEQ) + p;
#pragma unroll
        for (int q = 0; q < 3; ++q) {
            const bf16* pp = P + (size_t)row * PLD + OFF_B + q * 256 + chh;
            gxc[q] = *(const v2u*)pp; gxp[q] = (v2u){0u, 0u}; gxn[q] = (v2u){0u, 0u};
            if (p > 0) gxp[q] = *(const v2u*)(pp - PLD);
            if (p < Lp - 1) gxn[q] = *(const v2u*)(pp + PLD);
        }
        gwr = *(const v2u*)(WA + (size_t)row * 1024 + d * 256 + chh); gar = *(const v2u*)(WA + (size_t)row * 1024 + (2 + d) * 256 + chh);
    };
    auto sfinish = [&](int bufi) {
        f32x4 sh[3];
#pragma unroll
        for (int q = 0; q < 3; ++q) {
            const f32x4 x = (f32x4){bflo(gxc[q].x), bfhi(gxc[q].x), bflo(gxc[q].y), bfhi(gxc[q].y)}, pv = (f32x4){bflo(gxp[q].x), bfhi(gxp[q].x), bflo(gxp[q].y), bfhi(gxp[q].y)}, nx = (f32x4){bflo(gxn[q].x), bfhi(gxn[q].x), bflo(gxn[q].y), bfhi(gxn[q].y)};
            sh[q] = x + mu0[q] * (pv - x) + mu1[q] * (nx - x);
        }
        const f32x4 w = (f32x4){bflo(gwr.x), bfhi(gwr.x), bflo(gwr.y), bfhi(gwr.y)}, a = (f32x4){bflo(gar.x), bfhi(gar.x), bflo(gar.y), bfhi(gar.y)};
        f32x4 kk = sh[1] * kk_w;
        const float ss = row16_sum((kk.x * kk.x + kk.y * kk.y) + (kk.z * kk.z + kk.w * kk.w));
        kk = kk * rsqrtf_(ss + 1e-6f);
        const f32x4 km = sh[1] * ((a - 1.0f) * ka_w + 1.0f), beta = kk * a;
        LAS float* o = BUF + ((bufi * 32 + st) * 6) * 64 + q4 * 4;
        *(LAS f32x4*)(o + 0 * 64) = sh[0]; *(LAS f32x4*)(o + 1 * 64) = kk; *(LAS f32x4*)(o + 2 * 64) = w; *(LAS f32x4*)(o + 3 * 64) = beta; *(LAS f32x4*)(o + 4 * 64) = km; *(LAS f32x4*)(o + 5 * 64) = sh[2];
    };
    const int rr = C.tid >> 4, jq = C.tid & 15;
    f32x4 s = (f32x4){0.f, 0.f, 0.f, 0.f};
    constexpr int NBLK = NSTEP / 32;
    gload(0); sfinish(0); gload(1);
    __syncthreads();
    for (int nb = 0; nb < NBLK; ++nb) {
        if (nb + 1 < NBLK) { sfinish((nb + 1) & 1); if (nb + 2 < NBLK) gload(nb + 2); }
        const LAS float* bb = BUF + ((nb & 1) * 32) * 6 * 64;
        LAS float* yb = YB + (nb & 1) * 1024;
        const LAS float* o0 = bb + jq * 4; const LAS float* v0 = bb + 5 * 64 + half * 32 + rr;
        f32x4 r4 = *(const LAS f32x4*)(o0), kk = *(const LAS f32x4*)(o0 + 64), wv = *(const LAS f32x4*)(o0 + 128), be = *(const LAS f32x4*)(o0 + 192), km = *(const LAS f32x4*)(o0 + 256);
        float vv = v0[0];
#pragma unroll
        for (int hb = 0; hb < 2; ++hb) {
            float ysel = 0.f;
#pragma unroll
            for (int t16 = 0; t16 < 16; ++t16) {
                const int t = hb * 16 + t16;
                const f32x4 cr = r4, ck = kk, cw = wv, cb = be, cm_ = km; const float cv = vv;
                if (t + 1 < 32) { const LAS float* o = o0 + (t + 1) * 6 * 64;
                    r4 = *(const LAS f32x4*)(o); kk = *(const LAS f32x4*)(o + 64); wv = *(const LAS f32x4*)(o + 128); be = *(const LAS f32x4*)(o + 192); km = *(const LAS f32x4*)(o + 256); vv = v0[(t + 1) * 6 * 64]; }
                const float sk = row16_sum((s.x * ck.x + s.y * ck.y) + (s.z * ck.z + s.w * ck.w));
                s = s * cw - cb * sk + cm_ * cv;
                const float y = row16_sum((s.x * cr.x + s.y * cr.y) + (s.z * cr.z + s.w * cr.w));
                ysel = (jq == t16) ? y : ysel;
            }
            yb[(hb * 16 + jq) * 32 + rr] = ysel;
        }
        __syncthreads();
        {
            const int t = C.tid >> 4, r2 = (C.tid & 15) * 2;
            const int i = nb * 32 + t; const int row = seqrow_raster(i, d, b);
            *(unsigned*)(outb + (size_t)row * 256 + h * 64 + half * 32 + r2) = pk2(yb[t * 32 + r2], yb[t * 32 + r2 + 1]);
        }
    }
    __syncthreads();
}

#define RAW_BARRIER() do { asm volatile("s_waitcnt lgkmcnt(0)" ::: "memory"); __builtin_amdgcn_s_barrier(); asm volatile("" ::: "memory"); } while (0)
__device__ __forceinline__ void mlstm_scan_v0(const Ctx& C, int l, int idx) {
    const int d = idx >> 5, b = (idx >> 2) & 7, h = idx & 3, lane = C.lane, w = C.wave;
    LAS float* PN = (LAS float*)C.lds;
    LAS float* PD = PN + 2 * 8 * 64;
    LAS unsigned char* SB = C.lds + 8192;
    constexpr int SBS = 3 * 4096 + 256;
    const bf16* P = WSP(const bf16, WS_P); bf16* outc = WSP(bf16, WS_OUTC) + (size_t)d * T_ALL * 256;
    const float ib = C.in[I_MIB][(l * 2 + d) * NH + h], fb = C.in[I_MFB][(l * 2 + d) * NH + h];
    const int st_ = C.tid >> 4, part = C.tid & 15;
    auto stage = [&](int nb, int bufi) {
        const int row = seqrow_cm(nb * 32 + st_, d, b);
        const size_t ro = (size_t)row * PLD + OFF_C + h * 64 + part * 4;
        LAS unsigned char* sb = SB + bufi * SBS;
        *(LAS v2u*)(sb + st_ * 128 + part * 8) = *(const v2u*)(P + ro);
        *(LAS v2u*)(sb + 4096 + st_ * 128 + part * 8) = *(const v2u*)(P + ro + 256);
        *(LAS v2u*)(sb + 8192 + st_ * 128 + part * 8) = *(const v2u*)(P + ro + 512);
        if (part == 0) { const size_t rg = (size_t)row * PLD + OFF_C + 1024;
            const float li = bf2f(P[rg + d * 4 + h]) + ib, gf = bf2f(P[rg + 8 + d * 4 + h]) + fb;
            *(LAS f32x2*)(sb + 12288 + st_ * 8) = (f32x2){li, -softplusf_(-gf)}; }
    };
    float Cm[8], nk[8];
#pragma unroll
    for (int k = 0; k < 8; ++k) { Cm[k] = 0.f; nk[k] = 0.f; }
    float m = 0.f;
    stage(0, 0);
    __syncthreads();
    for (int nb = 0; nb < NSTEP / 32; ++nb) {
        if (nb + 1 < NSTEP / 32) stage(nb + 1, (nb + 1) & 1);
        const LAS unsigned char* sb = SB + (nb & 1) * SBS;
#pragma unroll 2
        for (int t = 0; t < 32; ++t) {
            const int i = nb * 32 + t;
            const v4u cq = *(const LAS v4u*)(sb + t * 128 + w * 16), ck = *(const LAS v4u*)(sb + 4096 + t * 128 + w * 16);
            const float vv = bf2f(*(const LAS unsigned short*)(sb + 8192 + t * 128 + lane * 2));
            const f32x2 gt = *(const LAS f32x2*)(sb + 12288 + t * 8);
            const float li = gt.x, lf = gt.y;
            const float mn = fmaxf(lf + m, li), fp = __expf(lf + m - mn), ip = __expf(li - mn);
            const float qf[8] = {bflo(cq.x), bfhi(cq.x), bflo(cq.y), bfhi(cq.y), bflo(cq.z), bfhi(cq.z), bflo(cq.w), bfhi(cq.w)};
            const float kf[8] = {bflo(ck.x), bfhi(ck.x), bflo(ck.y), bfhi(ck.y), bflo(ck.z), bfhi(ck.z), bflo(ck.w), bfhi(ck.w)};
            const float ipv = ip * vv;
            float num = 0.f, den = 0.f;
#pragma unroll
            for (int k = 0; k < 8; ++k) { const float kk = kf[k] * 0.125f; Cm[k] = fp * Cm[k] + ipv * kk; nk[k] = fp * nk[k] + ip * kk; num += Cm[k] * qf[k]; den += nk[k] * qf[k]; }
            m = mn;
            const int pb_ = i & 1;
            PN[(pb_ * 8 + w) * 64 + lane] = num; if (lane == 0) PD[pb_ * 8 + w] = den;
            RAW_BARRIER();
            if (w == 0) {
                float ns = 0.f, ds = 0.f;
#pragma unroll
                for (int ww = 0; ww < 8; ++ww) { ns += PN[(pb_ * 8 + ww) * 64 + lane]; ds += PD[pb_ * 8 + ww]; }
                outc[(size_t)seqrow_cm(i, d, b) * 256 + h * 64 + lane] = (bf16)f2bf1(ns / fmaxf(fabsf(ds), __expf(-mn)));
            }
        }
        __syncthreads();
    }
}

__device__ __forceinline__ void gdn_prep(const Ctx& C, int l, int b, int c) {
    const bf16* P = WSP(const bf16, WS_P); bf16* gq = WSP(bf16, WS_GQ);
    const bool isctx = c < 4; const int p0 = isctx ? c * 64 : (c - 4) * 64; const int Lp = isctx ? CTXL : SEQ;
    const int ch = 4 * C.lane;
    auto rowof = [&](int p) -> int { return isctx ? (T_LAT + b * CTXL + p) : (b * SEQ + (p & 63) * 64 + (p >> 6)); };
    f32x4 cw[4][3], x[4][3];
#pragma unroll
    for (int j = 0; j < 4; ++j)
#pragma unroll
        for (int g = 0; g < 3; ++g) cw[j][g] = *(const f32x4*)(C.in[I_GCW] + ((size_t)l * 4 + j) * 768 + g * 256 + ch);
    const int tb = p0 + C.wave * 8;
    auto ldrow = [&](int p, f32x4 (&dst)[3]) {
        if (p >= 0 && p < Lp) { const bf16* pr = P + (size_t)rowof(p) * PLD + OFF_D + ch;
#pragma unroll
            for (int g = 0; g < 3; ++g) dst[g] = ld4bf(pr + g * 256); }
        else {
#pragma unroll
            for (int g = 0; g < 3; ++g) dst[g] = (f32x4){0.f, 0.f, 0.f, 0.f}; }
    };
    ldrow(tb - 2, x[0]); ldrow(tb - 1, x[1]); ldrow(tb, x[2]);
#pragma unroll
    for (int t = 0; t < 8; ++t) {
        ldrow(tb + t + 1, x[3]);
        bf16* orow = gq + (size_t)rowof(tb + t) * 768 + ch;
#pragma unroll
        for (int g = 0; g < 3; ++g) {
            f32x4 v = cw[0][g] * x[0][g] + cw[1][g] * x[1][g] + cw[2][g] * x[2][g] + cw[3][g] * x[3][g];
            v = (f32x4){siluf_(v.x), siluf_(v.y), siluf_(v.z), siluf_(v.w)};
            if (g < 2) { const float ss = row16_sum((v.x * v.x + v.y * v.y) + (v.z * v.z + v.w * v.w)); v = v * (rsqrtf_(ss + 1e-6f) * (g == 0 ? 0.125f : 1.0f)); }
            st4bf(orow + g * 256, v);
        }
#pragma unroll
        for (int g = 0; g < 3; ++g) { x[0][g] = x[1][g]; x[1][g] = x[2][g]; x[2][g] = x[3][g]; }
    }
}
__device__ __forceinline__ void gdn_scan_v0(const Ctx& C, int l, int idx) {
    const int d = idx >> 5, b = (idx >> 2) & 7, h = idx & 3, lane = C.lane, w = C.wave;
    LAS float* PA = (LAS float*)C.lds;
    LAS float* PB = PA + 2 * 8 * 64;
    LAS unsigned char* SB = C.lds + 8192;
    constexpr int SBS = 3 * 4096 + 256;
    const bf16* P = WSP(const bf16, WS_P); const bf16* gq = WSP(const bf16, WS_GQ); bf16* outd = WSP(bf16, WS_OUTD) + (size_t)d * T_ALL * 256;
    const float aexp = __expf(C.in[I_GALOG][(l * 2 + d) * NH + h]), dtb = C.in[I_GDTB][(l * 2 + d) * NH + h];
    const int st_ = C.tid >> 4, part = C.tid & 15;
    auto stage = [&](int nb, int bufi) {
        const int row = seqrow_cm(nb * 32 + st_, d, b);
        const size_t rq = (size_t)row * 768 + h * 64 + part * 4;
        LAS unsigned char* sb = SB + bufi * SBS;
        *(LAS v2u*)(sb + st_ * 128 + part * 8) = *(const v2u*)(gq + rq);
        *(LAS v2u*)(sb + 4096 + st_ * 128 + part * 8) = *(const v2u*)(gq + rq + 256);
        *(LAS v2u*)(sb + 8192 + st_ * 128 + part * 8) = *(const v2u*)(gq + rq + 512);
        if (part == 0) { const size_t ro = (size_t)row * PLD + OFF_D + 1024;
            const float ga = bf2f(P[ro + d * 4 + h]), gb = bf2f(P[ro + 8 + d * 4 + h]);
            *(LAS f32x2*)(sb + 12288 + st_ * 8) = (f32x2){__expf(-aexp * softplusf_(ga + dtb)), sigmoidf_(gb)}; }
    };
    float S[8];
#pragma unroll
    for (int k = 0; k < 8; ++k) S[k] = 0.f;
    stage(0, 0);
    __syncthreads();
    int prow = 0;
    for (int nb = 0; nb < NSTEP / 32; ++nb) {
        if (nb + 1 < NSTEP / 32) stage(nb + 1, (nb + 1) & 1);
        const LAS unsigned char* sb = SB + (nb & 1) * SBS;
#pragma unroll 2
        for (int t = 0; t < 32; ++t) {
            const int i = nb * 32 + t;
            const v4u cq = *(const LAS v4u*)(sb + t * 128 + w * 16), ck = *(const LAS v4u*)(sb + 4096 + t * 128 + w * 16);
            const float vv = bf2f(*(const LAS unsigned short*)(sb + 8192 + t * 128 + lane * 2));
            const f32x2 gt = *(const LAS f32x2*)(sb + 12288 + t * 8);
            const float alpha = gt.x, beta = gt.y;
            const float qf[8] = {bflo(cq.x), bfhi(cq.x), bflo(cq.y), bfhi(cq.y), bflo(cq.z), bfhi(cq.z), bflo(cq.w), bfhi(cq.w)};
            const float kf[8] = {bflo(ck.x), bfhi(ck.x), bflo(ck.y), bfhi(ck.y), bflo(ck.z), bfhi(ck.z), bflo(ck.w), bfhi(ck.w)};
            float ks = 0.f;
#pragma unroll
            for (int k = 0; k < 8; ++k) ks += kf[k] * S[k];
            const int pb_ = i & 1;
            PA[(pb_ * 8 + w) * 64 + lane] = ks;
            RAW_BARRIER();
            if (w == 0 && i > 0) {
                float os = 0.f;
#pragma unroll
                for (int ww = 0; ww < 8; ++ww) os += PB[((pb_ ^ 1) * 8 + ww) * 64 + lane];
                outd[(size_t)prow * 256 + h * 64 + lane] = (bf16)f2bf1(os);
            }
            float kS = 0.f;
#pragma unroll
            for (int ww = 0; ww < 8; ++ww) kS += PA[(pb_ * 8 + ww) * 64 + lane];
            const float coef = beta * (vv - alpha * kS);
            float o = 0.f;
#pragma unroll
            for (int k = 0; k < 8; ++k) { S[k] = alpha * S[k] + kf[k] * coef; o += qf[k] * S[k]; }
            PB[(pb_ * 8 + w) * 64 + lane] = o;
            prow = seqrow_cm(i, d, b);
        }
        __syncthreads();
    }
    if (w == 0) {
        float os = 0.f;
#pragma unroll
        for (int ww = 0; ww < 8; ++ww) os += PB[(((NSTEP - 1) & 1) * 8 + ww) * 64 + lane];
        outd[(size_t)prow * 256 + h * 64 + lane] = (bf16)f2bf1(os);
    }
    __syncthreads();
}

__device__ __forceinline__ void finish_rows(const Ctx& C, int l, int nrows) {
    const bf16* P = WSP(const bf16, WS_P); bf16* yc = WSP(bf16, WS_HB);
    const bf16* ob = WSP(const bf16, WS_OUTB); const bf16* oc = WSP(const bf16, WS_OUTC); const bf16* od = WSP(const bf16, WS_OUTD);
    const bf16* gg = WSP(const bf16, WS_G); const float* bonus = WSP(const float, WS_BONUS);
    const float* mu = C.in[I_RMU] + (size_t)l * 2 * B_COLS;
    const int gw = C.wg * NWAVES + C.wave, NGW = C.G * NWAVES, lane = C.lane, ch = 4 * lane, hh = lane >> 4;
    const f32x4 lng = *(const f32x4*)(C.in[I_RLNG] + l * GW + ch), lnb = *(const f32x4*)(C.in[I_RLNB] + l * GW + ch);
    const f32x4 mng = *(const f32x4*)(C.in[I_MNG] + l * GW + ch), gng = *(const f32x4*)(C.in[I_GNG] + l * GW + ch);
    const f32x4 mu0 = *(const f32x4*)(mu + 512 + ch), mu1 = *(const f32x4*)(mu + B_COLS + 512 + ch);
    const size_t o2 = (size_t)T_ALL * 256;
#pragma unroll 2
    for (int m = gw; m < nrows; m += NGW) {
        const bool isctx = m >= T_LAT; const int Lp = isctx ? CTXL : SEQ; const int p = isctx ? ((m - T_LAT) & (CTXL - 1)) : (m & (SEQ - 1));
        const f32x4 yb = ld4bf(ob + (size_t)m * 256 + ch) + ld4bf(ob + o2 + (size_t)m * 256 + ch);
        const f32x4 ycv = ld4bf(oc + (size_t)m * 256 + ch) + ld4bf(oc + o2 + (size_t)m * 256 + ch);
        const f32x4 yd = ld4bf(od + (size_t)m * 256 + ch) + ld4bf(od + o2 + (size_t)m * 256 + ch);
        const bf16* pr = P + (size_t)m * PLD;
        const f32x4 vs = ld4bf(WSP(const bf16, WS_RKV) + (size_t)m * 768 + 512 + ch);
        const f32x4 og = ld4bf(pr + OFF_C + 768 + ch), gd = ld4bf(pr + OFF_D + 768 + ch), gr = ld4bf(gg + (size_t)m * 256 + ch);
        const float bn = bonus[(size_t)m * 4 + hh];
        *(v2u*)(yc + (size_t)m * 1024 + ch) = *(const v2u*)(pr + 256 + ch);
        {
            const float mean = row16_sum((yb.x + yb.y) + (yb.z + yb.w)) * (1.0f / 64.0f);
            const f32x4 dl = yb - mean;
            const float var = row16_sum((dl.x * dl.x + dl.y * dl.y) + (dl.z * dl.z + dl.w * dl.w)) * (1.0f / 64.0f);
            const f32x4 yn = dl * rsqrtf_(var + 64e-5f) * lng + lnb;
            st4bf(yc + (size_t)m * 1024 + 256 + ch, (yn + vs * bn) * gr);
        }
        {
            const float ms = row16_sum((ycv.x * ycv.x + ycv.y * ycv.y) + (ycv.z * ycv.z + ycv.w * ycv.w)) * (1.0f / 64.0f);
            const f32x4 sg = (f32x4){sigmoidf_(og.x), sigmoidf_(og.y), sigmoidf_(og.z), sigmoidf_(og.w)};
            st4bf(yc + (size_t)m * 1024 + 512 + ch, ycv * rsqrtf_(ms + 1e-6f) * mng * sg);
        }
        {
            const float ms = row16_sum((yd.x * yd.x + yd.y * yd.y) + (yd.z * yd.z + yd.w * yd.w)) * (1.0f / 64.0f);
            const f32x4 sg = (f32x4){siluf_(gd.x), siluf_(gd.y), siluf_(gd.z), siluf_(gd.w)};
            st4bf(yc + (size_t)m * 1024 + 768 + ch, yd * rsqrtf_(ms + 1e-6f) * gng * sg);
        }
    }
}
typedef bf16x8 fragb;
__device__ __forceinline__ f32x4 mfma16(fragb a, fragb b, f32x4 c) { return __builtin_amdgcn_mfma_f32_16x16x32_bf16(a, b, c, 0, 0, 0); }
__device__ __forceinline__ fragb ld_frag16(const LAS bf16* p) { return *(const LAS fragb*)p; }
__device__ __forceinline__ fragb ld_frag8x2(const LAS bf16* p0, const LAS bf16* p1) {
    const v2u a = *(const LAS v2u*)p0, b = *(const LAS v2u*)p1; v4u r; r.x = a.x; r.y = a.y; r.z = b.x; r.w = b.y; return __builtin_bit_cast(fragb, r); }
__device__ __forceinline__ fragb pack_frag(const f32x4& lo, const f32x4& hi) { v4u r; r.x = pk2(lo.x, lo.y); r.y = pk2(lo.z, lo.w); r.z = pk2(hi.x, hi.y); r.w = pk2(hi.z, hi.w); return __builtin_bit_cast(fragb, r); }
template <int CTRL, int RM, bool BC> __device__ __forceinline__ float dpp_x(float oldv, float v) { return __builtin_bit_cast(float, __builtin_amdgcn_update_dpp(__builtin_bit_cast(int, oldv), __builtin_bit_cast(int, v), CTRL, RM, 0xF, BC)); }
__device__ __forceinline__ float wave_incl_sum(float v, int lane) {
    v += dpp_x<0x111, 0xF, true>(0.f, v); v += dpp_x<0x112, 0xF, true>(0.f, v); v += dpp_x<0x114, 0xF, true>(0.f, v); v += dpp_x<0x118, 0xF, true>(0.f, v);
    v += dpp_x<0x142, 0xA, false>(0.f, v); v += dpp_x<0x143, 0xC, false>(0.f, v);
    return v;
}
__device__ __forceinline__ float wave_incl_max(float v, int lane) {
    const float ninf = -3.0e38f;
    v = fmaxf(v, dpp_x<0x111, 0xF, false>(ninf, v)); v = fmaxf(v, dpp_x<0x112, 0xF, false>(ninf, v)); v = fmaxf(v, dpp_x<0x114, 0xF, false>(ninf, v)); v = fmaxf(v, dpp_x<0x118, 0xF, false>(ninf, v));
    v = fmaxf(v, dpp_x<0x142, 0xA, false>(ninf, v)); v = fmaxf(v, dpp_x<0x143, 0xC, false>(ninf, v));
    return v;
}
constexpr int MP = 72;
__device__ __forceinline__ void mlstm_chunked(const Ctx& C, int l, int idx) {
    const int d = idx >> 5, b = (idx >> 2) & 7, h = idx & 3, lane = C.lane, w = C.wave, l15 = lane & 15, q = lane >> 4;
    const int it = w & 3, vtp = w >> 2;
    constexpr int IMG = 64 * MP * 2, BUFB = 4 * IMG + 1024, CTB = 65 * MP * 2 + 16;
    LAS unsigned char* L0 = C.lds;
    const bf16* P = WSP(const bf16, WS_P); bf16* outc = WSP(bf16, WS_OUTC) + (size_t)d * T_ALL * 256;
    const float ib = C.in[I_MIB][(l * 2 + d) * NH + h], fb = C.in[I_MFB][(l * 2 + d) * NH + h];
    const int tt = C.tid >> 3, part = C.tid & 7;
    for (int i = C.tid; i < 2 * CTB / 4; i += NTHR) ((LAS unsigned*)(L0 + 2 * BUFB))[i] = 0u;
    v4u rq, rk, rv; unsigned short rgi, rgf;
    auto gload = [&](int n) {
        const int row = seqrow_cm(n * 64 + tt, d, b);
        const bf16* pp = P + (size_t)row * PLD + OFF_C + h * 64 + 8 * part;
        rq = *(const v4u*)pp; rk = *(const v4u*)(pp + 256); rv = *(const v4u*)(pp + 512);
        const bf16* pg = P + (size_t)seqrow_cm(n * 64 + lane, d, b) * PLD + OFF_C + 1024 + d * 4 + h;
        rgi = pg[0]; rgf = pg[8];
    };
    auto images = [&](int bufi) {
        LAS unsigned char* B0 = L0 + bufi * BUFB;
        LAS bf16* Qs = (LAS bf16*)B0; LAS bf16* Ks = Qs + 64 * MP; LAS bf16* VT = Ks + 64 * MP; LAS bf16* KTw = VT + 64 * MP; LAS float* vec = (LAS float*)(B0 + 4 * IMG);
        const float li = bf2f(rgi) + ib, lf = -softplusf_(-(bf2f(rgf) + fb));
        const float bc = wave_incl_sum(lf, lane), x = li - bc, cm = wave_incl_max(x, lane);
        const float wl = __expf(x - __shfl(cm, 63)) * 0.125f;
        if (w == 0) { vec[lane] = x; vec[64 + lane] = cm; vec[128 + lane] = bc; }
        const float wmine = __shfl(wl, 8 * w + (lane >> 3));
        *(LAS v4u*)(Qs + tt * MP + 8 * part) = rq; *(LAS v4u*)(Ks + tt * MP + 8 * part) = rk;
        const unsigned vv[4] = {rv.x, rv.y, rv.z, rv.w}, kk[4] = {rk.x, rk.y, rk.z, rk.w};
#pragma unroll
        for (int e = 0; e < 4; ++e) {
            VT[(8 * part + 2 * e) * MP + tt] = (bf16)(vv[e] & 0xffffu); VT[(8 * part + 2 * e + 1) * MP + tt] = (bf16)(vv[e] >> 16);
            KTw[(8 * part + 2 * e) * MP + tt] = (bf16)f2bf1(bflo(kk[e]) * wmine); KTw[(8 * part + 2 * e + 1) * MP + tt] = (bf16)f2bf1(bfhi(kk[e]) * wmine);
        }
    };
    f32x4 Cst[2], nst; float m = 0.f;
    Cst[0] = Cst[1] = nst = (f32x4){0.f, 0.f, 0.f, 0.f};
    const fragb ones = __builtin_bit_cast(fragb, (v4u){0x3F803F80u, 0x3F803F80u, 0x3F803F80u, 0x3F803F80u});
    const f32x4 z4 = (f32x4){0.f, 0.f, 0.f, 0.f};
    gload(0); images(0); gload(1);
#pragma unroll 1
    for (int n = 0; n < NCH; ++n) {
        RAW_BARRIER();
        const LAS unsigned char* B0 = L0 + (n & 1) * BUFB;
        const LAS bf16* Qs = (const LAS bf16*)B0; const LAS bf16* Ks = Qs + 64 * MP; const LAS bf16* VT = Ks + 64 * MP; const LAS bf16* KTw = VT + 64 * MP; const LAS float* vec = (const LAS float*)(B0 + 4 * IMG);
        const LAS bf16* CT = (const LAS bf16*)(L0 + 2 * BUFB + (n & 1) * CTB); LAS bf16* CTn = (LAS bf16*)(L0 + 2 * BUFB + ((n + 1) & 1) * CTB);
        fragb Qf[2]; Qf[0] = ld_frag16(Qs + (16 * it + l15) * MP + 8 * q); Qf[1] = ld_frag16(Qs + (16 * it + l15) * MP + 32 + 8 * q);
        const float cmi = vec[64 + 16 * it + l15]; const int icol = 16 * it + l15;
        f32x4 pt[4];
#pragma unroll
        for (int jt = 0; jt < 4; ++jt) {
            pt[jt] = z4;
            if (jt <= it) {
                const fragb k0 = ld_frag16(Ks + (16 * jt + l15) * MP + 8 * q), k1 = ld_frag16(Ks + (16 * jt + l15) * MP + 32 + 8 * q);
                f32x4 st = mfma16(k0, Qf[0], z4); st = mfma16(k1, Qf[1], st);
                const f32x4 xj = *(const LAS f32x4*)(vec + 16 * jt + 4 * q);
#pragma unroll
                for (int r = 0; r < 4; ++r) { const int j = 16 * jt + 4 * q + r; pt[jt][r] = (j <= icol) ? st[r] * __expf(xj[r] - cmi) * 0.125f : 0.f; }
            }
        }
        fragb Pf[2]; Pf[0] = pack_frag(pt[0], pt[1]); Pf[1] = pack_frag(pt[2], pt[3]);
        fragb Vf[2][2];
#pragma unroll
        for (int v2 = 0; v2 < 2; ++v2)
#pragma unroll
            for (int s = 0; s < 2; ++s) { const LAS bf16* vr = VT + (16 * (2 * vtp + v2) + l15) * MP + 32 * s + 4 * q; Vf[v2][s] = ld_frag8x2(vr, vr + 16); }
        f32x4 Aacc[2], R[2], as, dn;
        as = mfma16(Pf[0], ones, z4); if (it >= 2) as = mfma16(Pf[1], ones, as);
        const fragb nf0 = ld_frag16(CT + 64 * MP + 8 * q), nf1 = ld_frag16(CT + 64 * MP + 32 + 8 * q);
        dn = mfma16(Qf[0], nf0, z4); dn = mfma16(Qf[1], nf1, dn);
#pragma unroll
        for (int v2 = 0; v2 < 2; ++v2) {
            Aacc[v2] = mfma16(Pf[0], Vf[v2][0], z4); if (it >= 2) Aacc[v2] = mfma16(Pf[1], Vf[v2][1], Aacc[v2]);
            const LAS bf16* cr = CT + (16 * (2 * vtp + v2) + l15) * MP + 8 * q;
            R[v2] = mfma16(Qf[0], ld_frag16(cr), z4); R[v2] = mfma16(Qf[1], ld_frag16(cr + 32), R[v2]);
        }
        {
            const f32x4 bi = *(const LAS f32x4*)(vec + 128 + 16 * it + 4 * q), cmr = *(const LAS f32x4*)(vec + 64 + 16 * it + 4 * q);
#pragma unroll
            for (int r = 0; r < 4; ++r) {
                const float mi = bi[r] + cmr[r], minter = bi[r] + m, mt = fmaxf(minter, mi), e1 = __expf(mi - mt), e2 = __expf(minter - mt);
                const float den = e1 * as[r] + e2 * dn[r]; const float inv = __builtin_amdgcn_rcpf(fmaxf(fabsf(den), __expf(-mt)));
                const int row = seqrow_cm(n * 64 + 16 * it + 4 * q + r, d, b);
#pragma unroll
                for (int v2 = 0; v2 < 2; ++v2) outc[(size_t)row * 256 + h * 64 + 16 * (2 * vtp + v2) + l15] = (bf16)f2bf1((e1 * Aacc[v2][r] + e2 * R[v2][r]) * inv);
            }
        }
        {
            const LAS bf16* kr = KTw + (16 * it + l15) * MP + 4 * q;
            const fragb kt0 = ld_frag8x2(kr, kr + 16), kt1 = ld_frag8x2(kr + 32, kr + 48);
            const float bL = vec[128 + 63], mloc = bL + vec[64 + 63];
            const float mnew = fmaxf(bL + m, mloc), wp = __expf(bL + m - mnew), wn = __expf(mloc - mnew);
            f32x4 gk = mfma16(kt0, ones, z4); gk = mfma16(kt1, ones, gk);
            nst = nst * wp + gk * wn;
#pragma unroll
            for (int v2 = 0; v2 < 2; ++v2) {
                f32x4 G = mfma16(kt0, Vf[v2][0], z4); G = mfma16(kt1, Vf[v2][1], G);
                Cst[v2] = Cst[v2] * wp + G * wn;
                v2u o; o.x = pk2(Cst[v2].x, Cst[v2].y); o.y = pk2(Cst[v2].z, Cst[v2].w);
                *(LAS v2u*)(CTn + (16 * (2 * vtp + v2) + l15) * MP + 16 * it + 4 * q) = o;
            }
            if (vtp == 0 && l15 == 0) { v2u o; o.x = pk2(nst.x, nst.y); o.y = pk2(nst.z, nst.w); *(LAS v2u*)(CTn + 64 * MP + 16 * it + 4 * q) = o; }
            m = mnew;
        }
        if (n + 1 < NCH) { images((n + 1) & 1); if (n + 2 < NCH) gload(n + 2); }
    }
    __syncthreads();
}
__device__ __forceinline__ int fwd_row_cm(int b, int c, int t) { return c < 4 ? (T_LAT + b * CTXL + c * 64 + t) : (b * SEQ + t * 64 + (c - 4)); }
__device__ __forceinline__ bf16* blob_row(const Ctx& C, int d, int isw, int b, int c, int h, int r) {
    const int row = fwd_row_cm(b, c, r);
    if (d == 1 && isw) return WSP(bf16, WS_OUTD) + ((size_t)T_ALL + row) * 256 + h * 64;
    return WSP(bf16, WS_P) + (size_t)row * PLD + OFF_D + (d * 2 + isw) * 256 + h * 64;
}
constexpr int LP = 68;
__device__ __forceinline__ void blocked_solve(const LAS bf16* Ln, const LAS bf16* TinvP, LAS unsigned char* XTw, f32x4 (&acc)[4][4], int l15, int q) {
    const f32x4 z4 = (f32x4){0.f, 0.f, 0.f, 0.f};
#pragma unroll
    for (int I = 0; I < 4; ++I) {
        const fragb Af = *(const LAS fragb*)(TinvP + (I * 16 + l15) * 32 + 8 * q);
        fragb A0, A1;
        if (I >= 1) A0 = ld_frag16(Ln + (16 * I + l15) * MP + 8 * q);
        if (I == 3) A1 = ld_frag16(Ln + (16 * I + l15) * MP + 32 + 8 * q);
#pragma unroll
        for (int nt = 0; nt < 4; ++nt) {
            const int crow = 16 * nt + l15; LAS unsigned char* xr = XTw + crow * 128;
            f32x4 a = acc[I][nt];
            if (I >= 1) a = mfma16(A0, *(const LAS fragb*)(xr + ((q ^ (crow & 7)) << 4)), a);
            if (I == 3) a = mfma16(A1, *(const LAS fragb*)(xr + (((4 + q) ^ (crow & 7)) << 4)), a);
            v4u bw; bw.x = pk2(a.x, a.y); bw.y = pk2(a.z, a.w); bw.z = 0u; bw.w = 0u;
            const f32x4 x = mfma16(Af, __builtin_bit_cast(fragb, bw), z4);
            acc[I][nt] = x;
            v2u o; o.x = pk2(x.x, x.y); o.y = pk2(x.z, x.w);
            *(LAS v2u*)(xr + (((2 * I + (q >> 1)) ^ (crow & 7)) << 4) + (q & 1) * 8) = o;
        }
    }
}
__device__ __forceinline__ void diag_inverses(const LAS bf16* Ln, LAS bf16* TinvP, int lane) {
    const int blk = lane >> 4, c = lane & 15;
    float x[16];
#pragma unroll
    for (int i = 0; i < 16; ++i) {
        const LAS bf16* lr = Ln + (16 * blk + i) * MP + 16 * blk;
        const v4u r0 = *(const LAS v4u*)lr, r1 = *(const LAS v4u*)(lr + 8);
        const unsigned rw[8] = {r0.x, r0.y, r0.z, r0.w, r1.x, r1.y, r1.z, r1.w};
        float s = (i == c) ? 1.0f : 0.0f;
#pragma unroll
        for (int j = 0; j < i; ++j) s += ((j & 1) ? bfhi(rw[j >> 1]) : bflo(rw[j >> 1])) * x[j];
        x[i] = s;
        TinvP[(blk * 16 + i) * 32 + 8 * (c >> 2) + (c & 3)] = (bf16)f2bf1(s);
    }
}
__device__ __forceinline__ void gdn_solve_item(const Ctx& C, int l, int item) {
    const int lane = C.lane, w = C.wave, pw = w & 1, pi = w >> 1, l15 = lane & 15, q = lane >> 4;
    LAS unsigned char* B0 = C.lds + pi * 31744;
    LAS bf16* Ln = (LAS bf16*)B0;
    LAS bf16* TinvP = (LAS bf16*)(B0 + 9216);
    LAS float* vec = (LAS float*)(B0 + 13312);
    LAS unsigned char* XT = B0 + 13824;
    LAS bf16* Ks = (LAS bf16*)XT;
    const bf16* P = WSP(const bf16, WS_P); const bf16* gq = WSP(const bf16, WS_GQ);
    const int u = item >> 1, d = item & 1;
    const int c = u % NCH, h = (u / NCH) & 3, b = u / (NCH * NH);
    const int n = d ? (c < 4 ? 3 - c : 71 - c) : c;
    const float aexp = __expf(C.in[I_GALOG][(l * 2 + d) * NH + h]), dtb = C.in[I_GDTB][(l * 2 + d) * NH + h];
    const int rowl = seqrow_cm(n * 64 + lane, d, b);
    const bf16* pg = P + (size_t)rowl * PLD + OFF_D + 1024 + d * 4 + h;
    const float la = -aexp * softplusf_(bf2f(pg[0]) + dtb), beta = sigmoidf_(bf2f(pg[8]));
    const float gam = wave_incl_sum(la, lane);
    if (pw == 0) { vec[lane] = beta; vec[64 + lane] = gam; }
#pragma unroll
    for (int r = 0; r < 4; ++r) { const int idx = pw * 64 + lane + 128 * r, t = idx >> 3, part = idx & 7;
        *(LAS v4u*)(Ks + t * MP + 8 * part) = *(const v4u*)(gq + (size_t)seqrow_cm(n * 64 + t, d, b) * 768 + 256 + h * 64 + 8 * part); }
    { LAS v4u* tz = (LAS v4u*)(B0 + 9216) + (pw * 64 + lane) * 2; tz[0] = (v4u){0u, 0u, 0u, 0u}; tz[1] = (v4u){0u, 0u, 0u, 0u}; }
    f32x4 acc[4][4];
    if (pw == 0) {
#pragma unroll
        for (int I = 0; I < 4; ++I)
#pragma unroll
            for (int r = 0; r < 4; ++r) { const bf16* vr = gq + (size_t)seqrow_cm(n * 64 + 16 * I + 4 * q + r, d, b) * 768 + 512 + h * 64 + l15;
#pragma unroll
                for (int nt = 0; nt < 4; ++nt) acc[I][nt][r] = bf2f(vr[16 * nt]); }
    }
    __syncthreads();
    {
        int tix = 0;
#pragma unroll
        for (int it = 0; it < 4; ++it)
#pragma unroll
            for (int jt = 0; jt < 4; ++jt, ++tix) if ((tix & 1) == pw) {
                f32x4 t4 = (f32x4){0.f, 0.f, 0.f, 0.f};
                if (jt <= it) {
#pragma unroll
                    for (int s = 0; s < 2; ++s) t4 = mfma16(ld_frag16(Ks + (16 * it + l15) * MP + 32 * s + 8 * q), ld_frag16(Ks + (16 * jt + l15) * MP + 32 * s + 8 * q), t4);
                    const float gj = vec[64 + 16 * jt + l15];
                    const f32x4 bi = *(const LAS f32x4*)(vec + 16 * it + 4 * q), gi = *(const LAS f32x4*)(vec + 64 + 16 * it + 4 * q);
#pragma unroll
                    for (int r = 0; r < 4; ++r) { const int i = 16 * it + 4 * q + r, j = 16 * jt + l15; t4[r] = (j < i) ? -(bi[r] * t4[r] * __expf(gi[r] - gj)) : 0.f; }
                }
#pragma unroll
                for (int r = 0; r < 4; ++r) Ln[(16 * it + 4 * q + r) * MP + 16 * jt + l15] = (bf16)f2bf1(t4[r]);
            }
    }
    {
#pragma unroll
        for (int I = 0; I < 4; ++I) {
            const f32x4 bi = *(const LAS f32x4*)(vec + 16 * I + 4 * q), gi = *(const LAS f32x4*)(vec + 64 + 16 * I + 4 * q);
#pragma unroll
            for (int r = 0; r < 4; ++r) { const float sc = pw ? bi[r] * __expf(gi[r]) : bi[r];
#pragma unroll
                for (int nt = 0; nt < 4; ++nt) acc[I][nt][r] = (pw ? bf2f(Ks[(16 * I + 4 * q + r) * MP + 16 * nt + l15]) : acc[I][nt][r]) * sc; }
        }
    }
    __syncthreads();
    if (pw == 0) diag_inverses(Ln, TinvP, lane);
    LAS unsigned char* XTw = XT + pw * 8192;
    { LAS v4u* xz = (LAS v4u*)(XTw + lane * 128);
#pragma unroll
        for (int g = 0; g < 8; ++g) xz[g] = (v4u){0u, 0u, 0u, 0u}; }
    __syncthreads();
    blocked_solve(Ln, TinvP, XTw, acc, l15, q);
    {
        bf16* dst = blob_row(C, d, pw, b, c, h, lane);
        const LAS unsigned char* xr = XTw + lane * 128;
#pragma unroll
        for (int g = 0; g < 8; ++g) *(v4u*)(dst + 8 * g) = *(const LAS v4u*)(xr + ((g ^ (lane & 7)) << 4));
    }
    __syncthreads();
}

template <bool DRY>
__device__ __forceinline__ void gdn_chunked(const Ctx& C, int l, int idx) {
    const int d = idx >> 5, b = (idx >> 2) & 7, h = idx & 3, lane = C.lane, w = C.wave, l15 = lane & 15, q = lane >> 4;
    const int it = w & 3, vtp = w >> 2;
    constexpr int IMG = 64 * MP * 2, BUFB = 5 * IMG + 512;
    LAS unsigned char* L0 = C.lds;
    LAS bf16* VnT = (LAS bf16*)(L0 + 2 * BUFB + 2 * IMG);
    const bf16* P = WSP(const bf16, WS_P); const bf16* gq = WSP(const bf16, WS_GQ); bf16* outd = WSP(bf16, WS_OUTD) + (size_t)d * T_ALL * 256;
    const float aexp = __expf(C.in[I_GALOG][(l * 2 + d) * NH + h]), dtb = C.in[I_GDTB][(l * 2 + d) * NH + h];
    const int tt = C.tid >> 3, part = C.tid & 7;
    for (int i = C.tid; i < 2 * IMG / 4; i += NTHR) ((LAS unsigned*)(L0 + 2 * BUFB))[i] = 0u;
    v4u rq, rk, ru, rw; unsigned short rga;
    auto gload = [&](int n) {
        const int c = d ? (n < 4 ? 3 - n : 71 - n) : n;
        const bf16* pp = gq + (size_t)seqrow_cm(n * 64 + tt, d, b) * 768 + h * 64 + 8 * part;
        rq = *(const v4u*)pp; rk = *(const v4u*)(pp + 256);
        ru = *(const v4u*)(blob_row(C, d, 0, b, c, h, tt) + 8 * part); rw = *(const v4u*)(blob_row(C, d, 1, b, c, h, tt) + 8 * part);
        rga = P[(size_t)seqrow_cm(n * 64 + lane, d, b) * PLD + OFF_D + 1024 + d * 4 + h];
    };
    auto images = [&](int bufi) {
        LAS unsigned char* B0 = L0 + bufi * BUFB;
        LAS bf16* Qs = (LAS bf16*)B0; LAS bf16* Ks = Qs + 64 * MP; LAS bf16* KdT = Ks + 64 * MP; LAS bf16* Wi = KdT + 64 * MP; LAS bf16* UT = Wi + 64 * MP; LAS float* vec = (LAS float*)(B0 + 5 * IMG);
        const float la = -aexp * softplusf_(bf2f(rga) + dtb);
        const float gam = wave_incl_sum(la, lane);
        if (w == 0) vec[lane] = gam;
        const float kd = __expf(__shfl(gam, 63) - gam);
        const float kmine = __shfl(kd, 8 * w + (lane >> 3));
        *(LAS v4u*)(Qs + tt * MP + 8 * part) = rq; *(LAS v4u*)(Ks + tt * MP + 8 * part) = rk; *(LAS v4u*)(UT + tt * MP + 8 * part) = ru;
        const unsigned kk[4] = {rk.x, rk.y, rk.z, rk.w}, ww[4] = {rw.x, rw.y, rw.z, rw.w};
#pragma unroll
        for (int e = 0; e < 4; ++e) {
            KdT[(8 * part + 2 * e) * MP + tt] = (bf16)f2bf1(bflo(kk[e]) * kmine); KdT[(8 * part + 2 * e + 1) * MP + tt] = (bf16)f2bf1(bfhi(kk[e]) * kmine);
            Wi[(8 * part + 2 * e) * MP + tt] = (bf16)(ww[e] & 0xffffu); Wi[(8 * part + 2 * e + 1) * MP + tt] = (bf16)(ww[e] >> 16);
        }
    };
    f32x4 Sst[2]; Sst[0] = Sst[1] = (f32x4){0.f, 0.f, 0.f, 0.f};
    const f32x4 z4 = (f32x4){0.f, 0.f, 0.f, 0.f};
    gload(0); images(0); gload(1);
#pragma unroll 1
    for (int n = 0; n < NCH; ++n) {
        RAW_BARRIER();
        const LAS unsigned char* B0 = L0 + (n & 1) * BUFB;
        const LAS bf16* Qs = (const LAS bf16*)B0; const LAS bf16* Ks = Qs + 64 * MP; const LAS bf16* KdT = Ks + 64 * MP; const LAS bf16* Wi = KdT + 64 * MP; const LAS bf16* UT = Wi + 64 * MP; const LAS float* vec = (const LAS float*)(B0 + 5 * IMG);
        const LAS bf16* ST = (const LAS bf16*)(L0 + 2 * BUFB + (n & 1) * IMG); LAS bf16* STn = (LAS bf16*)(L0 + 2 * BUFB + ((n + 1) & 1) * IMG);
        fragb Qf[2]; Qf[0] = ld_frag16(Qs + (16 * it + l15) * MP + 8 * q); Qf[1] = ld_frag16(Qs + (16 * it + l15) * MP + 32 + 8 * q);
        const float gcol = vec[16 * it + l15]; const int icol = 16 * it + l15;
        f32x4 pt[4];
#pragma unroll
        for (int jt = 0; jt < 4; ++jt) {
            pt[jt] = z4;
            if (jt <= it) {
                const fragb k0 = ld_frag16(Ks + (16 * jt + l15) * MP + 8 * q), k1 = ld_frag16(Ks + (16 * jt + l15) * MP + 32 + 8 * q);
                f32x4 st = mfma16(k0, Qf[0], z4); st = mfma16(k1, Qf[1], st);
                const f32x4 gj = *(const LAS f32x4*)(vec + 16 * jt + 4 * q);
#pragma unroll
                for (int r = 0; r < 4; ++r) { const int j = 16 * jt + 4 * q + r; pt[jt][r] = (j <= icol) ? st[r] * __expf(gcol - gj[r]) : 0.f; }
            }
        }
        fragb Pf[2]; Pf[0] = pack_frag(pt[0], pt[1]); Pf[1] = pack_frag(pt[2], pt[3]);
        const fragb Wf0 = ld_frag16(Wi + (16 * it + l15) * MP + 8 * q), Wf1 = ld_frag16(Wi + (16 * it + l15) * MP + 32 + 8 * q);
        f32x4 Ro[2];
#pragma unroll
        for (int v2 = 0; v2 < 2; ++v2) {
            const int vrow = 16 * (2 * vtp + v2) + l15;
            const fragb s0 = ld_frag16(ST + vrow * MP + 8 * q), s1 = ld_frag16(ST + vrow * MP + 32 + 8 * q);
            f32x4 ws = mfma16(Wf0, s0, z4); ws = mfma16(Wf1, s1, ws);
            Ro[v2] = mfma16(Qf[0], s0, z4); Ro[v2] = mfma16(Qf[1], s1, Ro[v2]);
            const v2u ur = *(const LAS v2u*)(UT + vrow * MP + 16 * it + 4 * q);
            v2u o; o.x = pk2(bflo(ur.x) - ws.x, bfhi(ur.x) - ws.y); o.y = pk2(bflo(ur.y) - ws.z, bfhi(ur.y) - ws.w);
            *(LAS v2u*)(VnT + vrow * MP + 16 * it + 4 * q) = o;
        }
        RAW_BARRIER();
        {
            const f32x4 gi = *(const LAS f32x4*)(vec + 16 * it + 4 * q);
            const float gl = __expf(vec[63]);
            const LAS bf16* kr = KdT + (16 * it + l15) * MP + 4 * q;
            const fragb kt0 = ld_frag8x2(kr, kr + 16), kt1 = ld_frag8x2(kr + 32, kr + 48);
#pragma unroll
            for (int v2 = 0; v2 < 2; ++v2) {
                const int vrow = 16 * (2 * vtp + v2) + l15;
                const LAS bf16* vr = VnT + vrow * MP + 4 * q;
                const fragb n0 = ld_frag8x2(vr, vr + 16), n1 = ld_frag8x2(vr + 32, vr + 48);
                f32x4 o = mfma16(Pf[0], n0, z4); if (it >= 2) o = mfma16(Pf[1], n1, o);
#pragma unroll
                for (int r = 0; r < 4; ++r) { const int row = seqrow_cm(n * 64 + 16 * it + 4 * q + r, d, b);
                    if (!DRY) outd[(size_t)row * 256 + h * 64 + vrow] = (bf16)f2bf1(o[r] + __expf(gi[r]) * Ro[v2][r]); }
                f32x4 ns = mfma16(kt0, n0, z4); ns = mfma16(kt1, n1, ns);
                Sst[v2] = Sst[v2] * gl + ns;
                v2u so; so.x = pk2(Sst[v2].x, Sst[v2].y); so.y = pk2(Sst[v2].z, Sst[v2].w);
                *(LAS v2u*)(STn + vrow * MP + 16 * it + 4 * q) = so;
            }
        }
        if (n + 1 < NCH) { images((n + 1) & 1); if (n + 2 < NCH) gload(n + 2); }
    }
    __syncthreads();
}
constexpr int UP = 264;
template <int CTRL> __device__ __forceinline__ float dpp_keep(float oldv, float v) { return __builtin_bit_cast(float, __builtin_amdgcn_update_dpp(__builtin_bit_cast(int, oldv), __builtin_bit_cast(int, v), CTRL, 0xF, 0xF, false)); }
template <bool REV> __device__ __forceinline__ void scan16(float& A, float& B) {
#define LRU_STEP(S) { const float Ap = dpp_keep<(REV ? 0x100 : 0x110) | S>(1.0f, A), Bp = dpp_keep<(REV ? 0x100 : 0x110) | S>(0.0f, B); B = A * Bp + B; A = A * Ap; }
    LRU_STEP(1) LRU_STEP(2) LRU_STEP(4) LRU_STEP(8)
#undef LRU_STEP
}
template <bool FIN, bool REV>
__device__ __forceinline__ void lru_wave(const Ctx& C, int l, int b, int c, int hd, LAS bf16* U16, LAS bf16* H16) {
    constexpr int d = REV ? 1 : 0;
    const int lane = C.lane, l15 = lane & 15, q = lane >> 4;
    const bf16* wt = WSP(const bf16, WS_LRUWT) + (size_t)((d * 2 + 0) * 4 + hd) * 4096;
    fragb Wa[4][2], Wx[4][2];
#pragma unroll
    for (int mt = 0; mt < 4; ++mt)
#pragma unroll
        for (int ks = 0; ks < 2; ++ks) { Wa[mt][ks] = *(const fragb*)(wt + (16 * mt + l15) * 64 + 32 * ks + 8 * q); Wx[mt][ks] = *(const fragb*)(wt + 4 * 4096 + (16 * mt + l15) * 64 + 32 * ks + 8 * q); }
    f32x4 sp4[4], hc[4], sla[4];
    const size_t sbase = ((size_t)(b * NCH + c) * 2 + d) * 256 + hd * 64;
#pragma unroll
    for (int mt = 0; mt < 4; ++mt) {
        const int ch = hd * 64 + 16 * mt + 4 * q;
        const f32x4 lam = *(const f32x4*)(C.in[I_LLAM] + (l * 2 + d) * GW + ch);
#pragma unroll
        for (int r = 0; r < 4; ++r) sp4[mt][r] = 8.0f * softplusf_(-lam[r]);
        hc[mt] = FIN ? *(const f32x4*)(WSP(const float, WS_HIN) + sbase + 16 * mt + 4 * q) : (f32x4){0.f, 0.f, 0.f, 0.f};
        sla[mt] = (f32x4){0.f, 0.f, 0.f, 0.f};
    }
    const f32x4 z4 = (f32x4){0.f, 0.f, 0.f, 0.f};
#pragma unroll 1
    for (int nti = 0; nti < 4; ++nti) {
        const int nt = REV ? 3 - nti : nti;
        const LAS bf16* urow = U16 + (16 * nt + l15) * UP + hd * 64;
        const fragb Uf0 = ld_frag16(urow + 8 * q), Uf1 = ld_frag16(urow + 32 + 8 * q);
#pragma unroll
        for (int mt = 0; mt < 4; ++mt) {
            f32x4 aa = mfma16(Wa[mt][0], Uf0, z4); aa = mfma16(Wa[mt][1], Uf1, aa);
            f32x4 ax = mfma16(Wx[mt][0], Uf0, z4); ax = mfma16(Wx[mt][1], Uf1, ax);
            const v2u ur = *(const LAS v2u*)(urow + 16 * mt + 4 * q);
            const float u4[4] = {bflo(ur.x), bfhi(ur.x), bflo(ur.y), bfhi(ur.y)};
            const f32x4 ba = *(const f32x4*)(C.in[I_LBA] + (l * 2 + d) * GW + hd * 64 + 16 * mt + 4 * q), bx = *(const f32x4*)(C.in[I_LBX] + (l * 2 + d) * GW + hd * 64 + 16 * mt + 4 * q);
            f32x4 hv;
#pragma unroll
            for (int r = 0; r < 4; ++r) {
                const float rg = sigmoidf_(aa[r] + ba[r]), ig = sigmoidf_(ax[r] + bx[r]);
                const float la = -sp4[mt][r] * rg; float A = __expf(la); float Bv = __builtin_amdgcn_sqrtf(-expm1f_(2.0f * la)) * (ig * u4[r]);
                sla[mt][r] += la;
                scan16<REV>(A, Bv);
                const float h = A * hc[mt][r] + Bv;
                hv[r] = h;
                hc[mt][r] = __shfl(h, (lane & 48) | (REV ? 0 : 15));
            }
            if (FIN) { v2u o; o.x = pk2(hv.x, hv.y); o.y = pk2(hv.z, hv.w); *(LAS v2u*)(H16 + (size_t)d * 64 * UP + (16 * nt + l15) * UP + hd * 64 + 16 * mt + 4 * q) = o; }
        }
    }
    if (!FIN) {
        float* ls = WSP(float, WS_LSUM);
#pragma unroll
        for (int mt = 0; mt < 4; ++mt)
#pragma unroll
            for (int r = 0; r < 4; ++r) { const float st = row16_sum(sla[mt][r]); if (l15 == 0) { const size_t si = sbase + 16 * mt + 4 * q + r; ls[si * 2] = st; ls[si * 2 + 1] = hc[mt][r]; } }
    }
}
template <bool FIN>
__device__ __forceinline__ void lru_chunk_mfma(const Ctx& C, int l, int b, int c) {
    LAS bf16* U16 = (LAS bf16*)C.lds;
    LAS bf16* H16 = U16 + 64 * UP;
    const bf16* P = WSP(const bf16, WS_P);
    const bool isctx = c < 4; const int p0 = isctx ? c * 64 : (c - 4) * 64; const int Lp = isctx ? CTXL : SEQ; const int row0 = isctx ? T_LAT + b * CTXL : b * SEQ;
    {
        const int ch = C.tid & 255, half = C.tid >> 8;
        const float* cw = C.in[I_LCW] + (size_t)l * 4 * GW + ch; const float w0 = cw[0], w1 = cw[GW], w2 = cw[2 * GW], w3 = cw[3 * GW], cb = C.in[I_LCB][l * GW + ch];
        const int t0 = half * 32;
        float xs[35];
#pragma unroll
        for (int k = 0; k < 35; ++k) { const int p = p0 + t0 + k - 2; xs[k] = (p >= 0 && p < Lp) ? bf2f(P[(size_t)(row0 + p) * PLD + ch]) : 0.f; }
#pragma unroll
        for (int t = 0; t < 32; ++t) U16[(t0 + t) * UP + ch] = (bf16)f2bf1(w0 * xs[t] + w1 * xs[t + 1] + w2 * xs[t + 2] + w3 * xs[t + 3] + cb);
    }
    __syncthreads();
    if (C.wave < 4) lru_wave<FIN, false>(C, l, b, c, C.wave & 3, U16, H16); else lru_wave<FIN, true>(C, l, b, c, C.wave & 3, U16, H16);
    __syncthreads();
    if (FIN) {
        const LAS bf16* H1 = H16 + 64 * UP;
#pragma unroll 2
        for (int it = C.tid; it < 64 * 64; it += NTHR) {
            const int t = it >> 6, c4 = (it & 63) * 4;
            const size_t row = (size_t)(row0 + p0 + t);
            const v2u a = *(const LAS v2u*)(H16 + t * UP + c4), bq = *(const LAS v2u*)(H1 + t * UP + c4);
            const f32x4 g = ld4bf(P + row * PLD + 256 + c4);
            f32x4 y = (f32x4){bflo(a.x) + bflo(bq.x), bfhi(a.x) + bfhi(bq.x), bflo(a.y) + bflo(bq.y), bfhi(a.y) + bfhi(bq.y)};
            y.x *= gelu_tanh(g.x); y.y *= gelu_tanh(g.y); y.z *= gelu_tanh(g.z); y.w *= gelu_tanh(g.w);
            st4bf(WSP(bf16, WS_P) + row * PLD + 256 + c4, y);
        }
        __syncthreads();
    }
}
constexpr int RP = 264;
__device__ __forceinline__ void rwkv_prep2(const Ctx& C, int l, int b, int c) {
    LAS bf16* RS = (LAS bf16*)C.lds;
    LAS bf16* KS = RS + 64 * RP;
    LAS bf16* XW = KS + 64 * RP;
    LAS bf16* XA = XW + 64 * MP;
    LAS bf16* XG = XA + 64 * MP;
    const bf16* P = WSP(const bf16, WS_P);
    const bool isctx = c < 4; const int p0 = isctx ? c * 64 : (c - 4) * 64; const int Lp = isctx ? CTXL : SEQ; const int row0 = isctx ? T_LAT + b * CTXL : b * SEQ;
    const float* mu = C.in[I_RMU] + (size_t)l * 2 * B_COLS;
    bf16* rkv = WSP(bf16, WS_RKV);
#pragma unroll 5
    for (int it = C.tid; it < 64 * 120; it += NTHR) {
        const int t = it / 120, c8 = (it % 120) * 8, p = p0 + t;
        const bf16* pp = P + (size_t)(row0 + p) * PLD + OFF_B + c8;
        const v4u xc = *(const v4u*)pp; v4u xp = (v4u){0u, 0u, 0u, 0u}, xn = xp;
        if (p > 0) xp = *(const v4u*)(pp - PLD);
        if (p < Lp - 1) xn = *(const v4u*)(pp + PLD);
        const f32x4 m0a = *(const f32x4*)(mu + c8), m0b = *(const f32x4*)(mu + c8 + 4), m1a = *(const f32x4*)(mu + B_COLS + c8), m1b = *(const f32x4*)(mu + B_COLS + c8 + 4);
        const unsigned xcw[4] = {xc.x, xc.y, xc.z, xc.w}, xpw[4] = {xp.x, xp.y, xp.z, xp.w}, xnw[4] = {xn.x, xn.y, xn.z, xn.w};
        float sh[8];
#pragma unroll
        for (int e = 0; e < 4; ++e) {
            const float x0 = bflo(xcw[e]), x1 = bfhi(xcw[e]);
            const float mu0_0 = e < 2 ? m0a[2 * e] : m0b[2 * e - 4], mu0_1 = e < 2 ? m0a[2 * e + 1] : m0b[2 * e - 3], mu1_0 = e < 2 ? m1a[2 * e] : m1b[2 * e - 4], mu1_1 = e < 2 ? m1a[2 * e + 1] : m1b[2 * e - 3];
            sh[2 * e] = x0 + mu0_0 * (bflo(xpw[e]) - x0) + mu1_0 * (bflo(xnw[e]) - x0);
            sh[2 * e + 1] = x1 + mu0_1 * (bfhi(xpw[e]) - x1) + mu1_1 * (bfhi(xnw[e]) - x1);
        }
        if (c8 >= 768) {
            const int ci = c8 - 768;
            if (ci < 64) {
#pragma unroll
                for (int e = 0; e < 8; ++e) sh[e] = tanhf_(sh[e]); }
            else if (ci >= 128) {
#pragma unroll
                for (int e = 0; e < 8; ++e) sh[e] = sigmoidf_(sh[e]); }
        }
        v4u o; o.x = pk2(sh[0], sh[1]); o.y = pk2(sh[2], sh[3]); o.z = pk2(sh[4], sh[5]); o.w = pk2(sh[6], sh[7]);
        if (c8 < 768) {
            *(v4u*)(rkv + (size_t)(row0 + p) * 768 + c8) = o;
            if (c8 < 256) *(LAS v4u*)(RS + t * RP + c8) = o; else if (c8 < 512) *(LAS v4u*)(KS + t * RP + c8 - 256) = o;
        } else {
            const int ci = c8 - 768;
            LAS bf16* dst = ci < 64 ? XW + t * MP + ci : (ci < 128 ? XA + t * MP + ci - 64 : XG + t * MP + ci - 128);
            *(LAS v4u*)dst = o;
        }
    }
    __syncthreads();
    const int lane = C.lane, w = C.wave, l15 = lane & 15, q = lane >> 4, hd = w & 3, ntp = w >> 2;
    const bf16* wt = WSP(const bf16, WS_RWT);
    bf16* wa_out = WSP(bf16, WS_HB); bf16* g_out = WSP(bf16, WS_G); float* bonus = WSP(float, WS_BONUS); float* rinv = WSP(float, WS_RINV);
    const f32x4 z4 = (f32x4){0.f, 0.f, 0.f, 0.f};
#pragma unroll 1
    for (int n2 = 0; n2 < 2; ++n2) {
        const int nt = 2 * ntp + n2, tok = 16 * nt + l15; const size_t row = (size_t)(row0 + p0 + tok);
        const fragb xw0 = ld_frag16(XW + tok * MP + 8 * q), xw1 = ld_frag16(XW + tok * MP + 32 + 8 * q);
        const fragb xa0 = ld_frag16(XA + tok * MP + 8 * q), xa1 = ld_frag16(XA + tok * MP + 32 + 8 * q);
        const fragb xg0 = ld_frag16(XG + tok * MP + 8 * q), xg1 = ld_frag16(XG + tok * MP + 32 + 8 * q);
        float bsum = 0.f, ksum = 0.f;
#pragma unroll
        for (int mt = 0; mt < 4; ++mt) {
            const int chl = 16 * mt + l15, ch4 = hd * 64 + 16 * mt + 4 * q;
            const bf16* wrow = wt + (size_t)(hd * 64 + chl) * 32 + 8 * q;
            const f32x4 aw0 = mfma16(*(const fragb*)(wrow), xw0, z4), aw1 = mfma16(*(const fragb*)(wrow + 256 * 32), xw1, z4);
            const f32x4 aa0 = mfma16(*(const fragb*)(wrow + 2 * 256 * 32), xa0, z4), aa1 = mfma16(*(const fragb*)(wrow + 3 * 256 * 32), xa1, z4);
            const bf16* grow = wt + 4 * 256 * 32 + (size_t)(hd * 64 + chl) * 64 + 8 * q;
            f32x4 ag = mfma16(*(const fragb*)(grow), xg0, z4); ag = mfma16(*(const fragb*)(grow + 32), xg1, ag);
            const f32x4 w00 = *(const f32x4*)(C.in[I_RW0] + (l * 2 + 0) * GW + ch4), w01 = *(const f32x4*)(C.in[I_RW0] + (l * 2 + 1) * GW + ch4);
            const f32x4 a00 = *(const f32x4*)(C.in[I_RA0] + (l * 2 + 0) * GW + ch4), a01 = *(const f32x4*)(C.in[I_RA0] + (l * 2 + 1) * GW + ch4);
            const f32x4 k_a = *(const f32x4*)(C.in[I_RKA] + l * GW + ch4), r_k = *(const f32x4*)(C.in[I_RRK] + l * GW + ch4), k_k = *(const f32x4*)(C.in[I_RKK] + l * GW + ch4);
            f32x4 wv0, wv1, av0, av1;
#pragma unroll
            for (int r = 0; r < 4; ++r) {
                wv0[r] = __expf(-0.6065306597126334f * sigmoidf_(aw0[r] + w00[r])); wv1[r] = __expf(-0.6065306597126334f * sigmoidf_(aw1[r] + w01[r]));
                av0[r] = sigmoidf_(aa0[r] + a00[r]); av1[r] = sigmoidf_(aa1[r] + a01[r]);
            }
            st4bf(wa_out + row * 1024 + 0 * 256 + ch4, wv0); st4bf(wa_out + row * 1024 + 1 * 256 + ch4, wv1);
            st4bf(wa_out + row * 1024 + 2 * 256 + ch4, av0); st4bf(wa_out + row * 1024 + 3 * 256 + ch4, av1);
            st4bf(g_out + row * 256 + ch4, ag);
            const v2u rr_ = *(const LAS v2u*)(RS + tok * RP + ch4), kr_ = *(const LAS v2u*)(KS + tok * RP + ch4);
            const f32x4 rs = (f32x4){bflo(rr_.x), bfhi(rr_.x), bflo(rr_.y), bfhi(rr_.y)}, ks = (f32x4){bflo(kr_.x), bfhi(kr_.x), bflo(kr_.y), bfhi(kr_.y)};
#pragma unroll
            for (int r = 0; r < 4; ++r) {
                const float km = ks[r] * (1.0f + (av0[r] - 1.0f) * k_a[r]) + ks[r] * (1.0f + (av1[r] - 1.0f) * k_a[r]);
                bsum += rs[r] * r_k[r] * km; const float kk = ks[r] * k_k[r]; ksum += kk * kk;
            }
        }
        bsum += __shfl_xor(bsum, 16); bsum += __shfl_xor(bsum, 32); ksum += __shfl_xor(ksum, 16); ksum += __shfl_xor(ksum, 32);
        if (q == 0) { bonus[row * 4 + hd] = bsum; rinv[row * 4 + hd] = rsqrtf_(ksum + 1e-6f); }
    }
    __syncthreads();
}
__device__ __forceinline__ int fwd_row_r(int b, int c, int t) { return c < 4 ? (T_LAT + b * CTXL + c * 64 + t) : (b * SEQ + (c - 4) * 64 + t); }
__device__ __forceinline__ bf16* rw_blob_row(const Ctx& C, int d, int which, int b, int c, int h, int r) {
    const int row = fwd_row_r(b, c, r);
#if RW_VSPLIT
    if (which == 0) { if (d) return WSP(bf16, WS_GQ) + (size_t)row * 768 + 512 + h * 64;
                      return WSP(bf16, WS_P) + (size_t)row * PLD + OFF_B + 512 + h * 64; }
#else
    if (which == 0) return WSP(bf16, WS_OUTB) + ((size_t)d * T_ALL + row) * 256 + h * 64;
#endif
    return WSP(bf16, WS_P) + (size_t)row * PLD + OFF_B + d * 256 + h * 64;
}
__device__ __forceinline__ void rwkv_solve_item(const Ctx& C, int l, int item) {
    const int lane = C.lane, w = C.wave, pw = w & 1, pi = w >> 1, l15 = lane & 15, q = lane >> 4;
    LAS unsigned char* B0 = C.lds + pi * 31744;
    LAS bf16* Kk = (LAS bf16*)B0; LAS bf16* Bh = Kk + 64 * MP; LAS bf16* Kh = Bh + 64 * MP;
    LAS bf16* Ln = (LAS bf16*)B0;
    LAS bf16* Lk16 = (LAS bf16*)(B0 + 9216);
    LAS unsigned char* XT = B0 + 9216;
    LAS bf16* TinvP = (LAS bf16*)(B0 + 25600);
    const bf16* WA = WSP(const bf16, WS_HB); const bf16* rkv = WSP(const bf16, WS_RKV); const float* rinv = WSP(const float, WS_RINV);
    const int u = item >> 1, d = item & 1;
    const int c = u % NCH, h = (u / NCH) & 3, b = u / (NCH * NH);
    const float k_k = C.in[I_RKK][l * GW + h * 64 + lane], k_a = C.in[I_RKA][l * GW + h * 64 + lane];
    const int n = d ? (c < 4 ? 3 - c : 71 - c) : c;
    const float ril = rinv[(size_t)seqrow_raster(n * 64 + lane, d, b) * 4 + h];
#pragma unroll
    for (int r = 0; r < 4; ++r) { const int idx2 = pw * 64 + lane + 128 * r, t = idx2 >> 3, part = idx2 & 7; const int row = seqrow_raster(n * 64 + t, d, b);
        *(LAS v4u*)(Kk + t * MP + 8 * part) = *(const v4u*)(WA + (size_t)row * 1024 + d * 256 + h * 64 + 8 * part);
        *(LAS v4u*)(Bh + t * MP + 8 * part) = *(const v4u*)(WA + (size_t)row * 1024 + (2 + d) * 256 + h * 64 + 8 * part);
        *(LAS v4u*)(Kh + t * MP + 8 * part) = *(const v4u*)(rkv + (size_t)row * 768 + 256 + h * 64 + 8 * part); }
    __syncthreads();
    {
        float cc = 1.0f;
        if (pw) {
#pragma unroll
            for (int t = 0; t < 32; ++t) cc *= bf2f(Kk[t * MP + lane]);
        }
        __syncthreads();
#pragma unroll
        for (int t2 = 0; t2 < 32; ++t2) {
            const int t = pw * 32 + t2;
            const float wv = bf2f(Kk[t * MP + lane]), av = bf2f(Bh[t * MP + lane]), ks = bf2f(Kh[t * MP + lane]);
            const float kap = ks * k_k * __shfl(ril, t);
            const float cprev = cc; cc *= wv; const float ic = __builtin_amdgcn_rcpf(cc);
            Kk[t * MP + lane] = (bf16)f2bf1(kap * cprev); Bh[t * MP + lane] = (bf16)f2bf1(kap * av * ic); Kh[t * MP + lane] = (bf16)f2bf1(ks * (1.0f + (av - 1.0f) * k_a) * ic);
        }
    }
    __syncthreads();
    f32x4 acc[4][4];
    if (pw == 0) {
#pragma unroll
        for (int I = 0; I < 4; ++I)
#pragma unroll
            for (int r = 0; r < 4; ++r)
#pragma unroll
                for (int nt = 0; nt < 4; ++nt) acc[I][nt][r] = bf2f(Kk[(16 * I + 4 * q + r) * MP + 16 * nt + l15]);
    }
    f32x4 T[10];
    {
        const LAS bf16* Bsrc = pw ? Kh : Bh;
        int tix = 0;
#pragma unroll
        for (int it = 0; it < 4; ++it)
#pragma unroll
            for (int jt = 0; jt <= it; ++jt, ++tix) {
                f32x4 t4 = (f32x4){0.f, 0.f, 0.f, 0.f};
#pragma unroll
                for (int s = 0; s < 2; ++s) t4 = mfma16(ld_frag16(Kk + (16 * it + l15) * MP + 32 * s + 8 * q), ld_frag16(Bsrc + (16 * jt + l15) * MP + 32 * s + 8 * q), t4);
#pragma unroll
                for (int r = 0; r < 4; ++r) { const int i = 16 * it + 4 * q + r, j = 16 * jt + l15; T[tix][r] = (j < i) ? (pw ? t4[r] : -t4[r]) : 0.f; }
            }
    }
    __syncthreads();
    {
        int tix = 0;
#pragma unroll
        for (int it = 0; it < 4; ++it)
#pragma unroll
            for (int jt = 0; jt < 4; ++jt) {
                if (jt <= it) {
#pragma unroll
                    for (int r = 0; r < 4; ++r) (pw ? Lk16 : Ln)[(16 * it + 4 * q + r) * MP + 16 * jt + l15] = (bf16)f2bf1(T[tix][r]);
                    ++tix;
                } else if (pw == 0) {
#pragma unroll
                    for (int r = 0; r < 4; ++r) Ln[(16 * it + 4 * q + r) * MP + 16 * jt + l15] = (bf16)0;
                }
            }
        LAS v4u* tz = (LAS v4u*)(B0 + 25600) + (pw * 64 + lane) * 2; tz[0] = (v4u){0u, 0u, 0u, 0u}; tz[1] = (v4u){0u, 0u, 0u, 0u};
    }
    __syncthreads();
    if (pw) {
#pragma unroll
        for (int I = 0; I < 4; ++I)
#pragma unroll
            for (int r = 0; r < 4; ++r)
#pragma unroll
                for (int nt = 0; nt < 4; ++nt) { const int i = 16 * I + 4 * q + r, j = 16 * nt + l15; acc[I][nt][r] = (j < i && nt <= I) ? bf2f(Lk16[i * MP + j]) : 0.f; }
    } else diag_inverses(Ln, TinvP, lane);
    __syncthreads();
    LAS unsigned char* XTw = XT + pw * 8192;
    { LAS v4u* xz = (LAS v4u*)(XTw + lane * 128);
#pragma unroll
        for (int g = 0; g < 8; ++g) xz[g] = (v4u){0u, 0u, 0u, 0u}; }
    blocked_solve(Ln, TinvP, XTw, acc, l15, q);
    {
        bf16* dst = rw_blob_row(C, d, pw, b, c, h, lane);
        const LAS unsigned char* xr = XTw + lane * 128;
#pragma unroll
        for (int g = 0; g < 8; ++g) *(v4u*)(dst + 8 * g) = *(const LAS v4u*)(xr + ((g ^ (lane & 7)) << 4));
    }
    __syncthreads();
}

template <bool DRY>
__device__ __forceinline__ void rwkv_chunked(const Ctx& C, int l, int idx) {
#ifndef RW_VSPLIT
#define RW_VSPLIT 1
#endif
    constexpr int NV = RW_VSPLIT ? 1 : 2;
    const int vhalf = idx & 1, lane = C.lane, w = C.wave, l15 = lane & 15, q = lane >> 4;
    const int d = RW_VSPLIT ? idx >> 6 : idx >> 5, b = RW_VSPLIT ? (idx >> 3) & 7 : (idx >> 2) & 7, h = RW_VSPLIT ? (idx >> 1) & 3 : idx & 3;
    const int it = w & 3, vt0 = RW_VSPLIT ? 2 * vhalf + (w >> 2) : 2 * (w >> 2);
    constexpr int IMG = 64 * MP * 2;
    LAS unsigned char* L0 = C.lds;
    LAS bf16* Wi = (LAS bf16*)L0; LAS bf16* Ti = Wi + 64 * MP; LAS bf16* Rh = Ti + 64 * MP; LAS bf16* Kh = Rh + 64 * MP; LAS bf16* Bh = Kh + 64 * MP;
    LAS bf16* UT = (LAS bf16*)(L0 + 11 * IMG);
    LAS float* cLv = (LAS float*)(L0 + 14 * IMG);
    const bf16* WA = WSP(const bf16, WS_HB); const bf16* rkv = WSP(const bf16, WS_RKV); const float* rinv = WSP(const float, WS_RINV);
    bf16* outb = WSP(bf16, WS_OUTB) + (size_t)d * T_ALL * 256;
    const int tt = C.tid >> 3, part = C.tid & 7;
    for (int i = C.tid; i < 2 * IMG / 4; i += NTHR) ((LAS unsigned*)(L0 + 12 * IMG))[i] = 0u;
    float kkw[8], kaw[8];
#pragma unroll
    for (int e = 0; e < 8; ++e) { kkw[e] = C.in[I_RKK][l * GW + h * 64 + 8 * w + e]; kaw[e] = C.in[I_RKA][l * GW + h * 64 + 8 * w + e]; }
    v4u gr, gk, gv, gw, ga, gbw, gbt; float gri;
    auto gload = [&](int n) {
        const int c = d ? (n < 4 ? 3 - n : 71 - n) : n;
        const int row = seqrow_raster(n * 64 + lane, d, b);
        const bf16* pr = rkv + (size_t)row * 768 + h * 64 + 8 * w;
        gr = *(const v4u*)pr; gk = *(const v4u*)(pr + 256); gv = *(const v4u*)(pr + 512);
        gw = *(const v4u*)(WA + (size_t)row * 1024 + d * 256 + h * 64 + 8 * w); ga = *(const v4u*)(WA + (size_t)row * 1024 + (2 + d) * 256 + h * 64 + 8 * w);
        gri = rinv[(size_t)row * 4 + h];
        gbw = *(const v4u*)(rw_blob_row(C, d, 0, b, c, h, tt) + 8 * part); gbt = *(const v4u*)(rw_blob_row(C, d, 1, b, c, h, tt) + 8 * part);
    };
    auto images = [&](int bufi) {
        LAS bf16* VT = (LAS bf16*)(L0 + (5 + 3 * bufi) * IMG); LAS bf16* KcT = VT + 64 * MP; LAS bf16* BcT = KcT + 64 * MP;
        const unsigned rw_[4] = {gr.x, gr.y, gr.z, gr.w}, kw_[4] = {gk.x, gk.y, gk.z, gk.w}, vw_[4] = {gv.x, gv.y, gv.z, gv.w}, ww_[4] = {gw.x, gw.y, gw.z, gw.w}, aw_[4] = {ga.x, ga.y, ga.z, ga.w};
        float rh[8], kh[8], bh[8];
#pragma unroll
        for (int e = 0; e < 8; ++e) {
            const float rs = (e & 1) ? bfhi(rw_[e >> 1]) : bflo(rw_[e >> 1]), ks = (e & 1) ? bfhi(kw_[e >> 1]) : bflo(kw_[e >> 1]);
            const float wv = (e & 1) ? bfhi(ww_[e >> 1]) : bflo(ww_[e >> 1]), av = (e & 1) ? bfhi(aw_[e >> 1]) : bflo(aw_[e >> 1]);
            const float lw = __logf(wv);
            const float cum = wave_incl_sum(lw, lane);
            const float kap = ks * kkw[e] * gri, ktil = ks * (1.0f + (av - 1.0f) * kaw[e]);
            const float cf = __expf(cum), icf = __builtin_amdgcn_rcpf(cf), cfL = __shfl(cf, 63), dec = cfL * icf;
            rh[e] = rs * cf; kh[e] = ktil * icf; bh[e] = kap * av * icf;
            const unsigned short vraw = (e & 1) ? (unsigned short)(vw_[e >> 1] >> 16) : (unsigned short)(vw_[e >> 1] & 0xffffu);
            VT[(8 * w + e) * MP + lane] = vraw; KcT[(8 * w + e) * MP + lane] = (bf16)f2bf1(ktil * dec); BcT[(8 * w + e) * MP + lane] = (bf16)f2bf1(-(kap * av * dec));
            if (lane == 63) cLv[bufi * 64 + 8 * w + e] = cfL;
        }
        { v4u o; o.x = pk2(rh[0], rh[1]); o.y = pk2(rh[2], rh[3]); o.z = pk2(rh[4], rh[5]); o.w = pk2(rh[6], rh[7]); *(LAS v4u*)(Rh + lane * MP + 8 * w) = o; }
        { v4u o; o.x = pk2(kh[0], kh[1]); o.y = pk2(kh[2], kh[3]); o.z = pk2(kh[4], kh[5]); o.w = pk2(kh[6], kh[7]); *(LAS v4u*)(Kh + lane * MP + 8 * w) = o; }
        { v4u o; o.x = pk2(bh[0], bh[1]); o.y = pk2(bh[2], bh[3]); o.z = pk2(bh[4], bh[5]); o.w = pk2(bh[6], bh[7]); *(LAS v4u*)(Bh + lane * MP + 8 * w) = o; }
        const unsigned bw_[4] = {gbw.x, gbw.y, gbw.z, gbw.w}, bt_[4] = {gbt.x, gbt.y, gbt.z, gbt.w};
#pragma unroll
        for (int e = 0; e < 4; ++e) {
            Wi[(8 * part + 2 * e) * MP + tt] = (bf16)(bw_[e] & 0xffffu); Wi[(8 * part + 2 * e + 1) * MP + tt] = (bf16)(bw_[e] >> 16);
            Ti[(8 * part + 2 * e) * MP + tt] = (bf16)(bt_[e] & 0xffffu); Ti[(8 * part + 2 * e + 1) * MP + tt] = (bf16)(bt_[e] >> 16);
        }
    };
    f32x4 Zst[NV];
#pragma unroll
    for (int v2 = 0; v2 < NV; ++v2) Zst[v2] = (f32x4){0.f, 0.f, 0.f, 0.f};
    const f32x4 z4 = (f32x4){0.f, 0.f, 0.f, 0.f};
    gload(0); images(0); gload(1);
#pragma unroll 1
    for (int n = 0; n < NCH; ++n) {
        RAW_BARRIER();
        const LAS bf16* VT = (const LAS bf16*)(L0 + (5 + 3 * (n & 1)) * IMG); const LAS bf16* KcT = VT + 64 * MP; const LAS bf16* BcT = KcT + 64 * MP;
        const LAS bf16* Zi = (const LAS bf16*)(L0 + (12 + (n & 1)) * IMG); LAS bf16* Zn = (LAS bf16*)(L0 + (12 + ((n + 1) & 1)) * IMG);
        const int arow = (16 * it + l15) * MP + 8 * q;
        const fragb Wf0 = ld_frag16(Wi + arow), Wf1 = ld_frag16(Wi + arow + 32), Tf0 = ld_frag16(Ti + arow), Tf1 = ld_frag16(Ti + arow + 32), Rf0 = ld_frag16(Rh + arow), Rf1 = ld_frag16(Rh + arow + 32);
        const int icol = 16 * it + l15;
        f32x4 pk[4], pb[4];
#pragma unroll
        for (int jt = 0; jt < 4; ++jt) {
            pk[jt] = z4; pb[jt] = z4;
            if (jt <= it) {
                const int jrow = (16 * jt + l15) * MP + 8 * q;
                f32x4 sk = mfma16(ld_frag16(Kh + jrow), Rf0, z4); sk = mfma16(ld_frag16(Kh + jrow + 32), Rf1, sk);
                f32x4 sb = mfma16(ld_frag16(Bh + jrow), Rf0, z4); sb = mfma16(ld_frag16(Bh + jrow + 32), Rf1, sb);
#pragma unroll
                for (int r = 0; r < 4; ++r) { const int j = 16 * jt + 4 * q + r; pk[jt][r] = (j <= icol) ? sk[r] : 0.f; pb[jt][r] = (j <= icol) ? -sb[r] : 0.f; }
            }
        }
        fragb Pk0 = pack_frag(pk[0], pk[1]), Pk1 = pack_frag(pk[2], pk[3]), Pb0 = pack_frag(pb[0], pb[1]), Pb1 = pack_frag(pb[2], pb[3]);
        f32x4 RZ[NV];
#pragma unroll
        for (int v2 = 0; v2 < NV; ++v2) {
            const int vrow = 16 * (vt0 + v2) + l15;
            const fragb z0 = ld_frag16(Zi + vrow * MP + 8 * q), z1 = ld_frag16(Zi + vrow * MP + 32 + 8 * q);
            f32x4 u = mfma16(Wf0, z0, z4); u = mfma16(Wf1, z1, u);
            u = mfma16(Tf0, ld_frag16(VT + vrow * MP + 8 * q), u); if (it >= 2) u = mfma16(Tf1, ld_frag16(VT + vrow * MP + 32 + 8 * q), u);
            RZ[v2] = mfma16(Rf0, z0, z4); RZ[v2] = mfma16(Rf1, z1, RZ[v2]);
            v2u o; o.x = pk2(u.x, u.y); o.y = pk2(u.z, u.w);
            *(LAS v2u*)(UT + vrow * MP + 16 * it + 4 * q) = o;
        }
        RAW_BARRIER();
        {
            const f32x4 cl4 = *(const LAS f32x4*)(cLv + (n & 1) * 64 + 16 * it + 4 * q);
            const LAS bf16* kr = KcT + (16 * it + l15) * MP + 4 * q; const LAS bf16* br = BcT + (16 * it + l15) * MP + 4 * q;
            const fragb kc0 = ld_frag8x2(kr, kr + 16), kc1 = ld_frag8x2(kr + 32, kr + 48), bc0 = ld_frag8x2(br, br + 16), bc1 = ld_frag8x2(br + 32, br + 48);
#pragma unroll
            for (int v2 = 0; v2 < NV; ++v2) {
                const int vrow = 16 * (vt0 + v2) + l15;
                const LAS bf16* vr = VT + vrow * MP + 4 * q; const LAS bf16* ur = UT + vrow * MP + 4 * q;
                const fragb vp0 = ld_frag8x2(vr, vr + 16), vp1 = ld_frag8x2(vr + 32, vr + 48), up0 = ld_frag8x2(ur, ur + 16), up1 = ld_frag8x2(ur + 32, ur + 48);
                f32x4 y = mfma16(Pk0, vp0, RZ[v2]); y = mfma16(Pb0, up0, y);
                if (it >= 2) { y = mfma16(Pk1, vp1, y); y = mfma16(Pb1, up1, y); }
#pragma unroll
                for (int r = 0; r < 4; ++r) { const int row = seqrow_raster(n * 64 + 16 * it + 4 * q + r, d, b); if (!DRY) outb[(size_t)row * 256 + h * 64 + vrow] = (bf16)f2bf1(y[r]); }
                f32x4 zn = mfma16(kc0, vp0, z4); zn = mfma16(kc1, vp1, zn); zn = mfma16(bc0, up0, zn); zn = mfma16(bc1, up1, zn);
                Zst[v2] = Zst[v2] * cl4 + zn;
                v2u so; so.x = pk2(Zst[v2].x, Zst[v2].y); so.y = pk2(Zst[v2].z, Zst[v2].w);
                *(LAS v2u*)(Zn + vrow * MP + 16 * it + 4 * q) = so;
            }
        }
        if (n + 1 < NCH) { images((n + 1) & 1); if (n + 2 < NCH) gload(n + 2); }
    }
    __syncthreads();
}
__device__ __forceinline__ void moe_scatter(const Ctx& C, int moe_li, int nrows) {
    const unsigned* gc = WSP(const unsigned, WS_CTL) + CW_MOECNT + 64 * moe_li;
    LAS int* pst = (LAS int*)C.lds;
    {
        int pe[8]; int acc = 0;
#pragma unroll
        for (int e = 0; e < NE; ++e) { const int blks = ((int)gc[e] + 255) >> 8; if (C.tid == e) pst[e] = acc * 256; acc += blks; pe[e] = acc; }
        if (C.wg == 0 && C.tid < MOE_MAXBLK) { int be = 0;
#pragma unroll
            for (int e = 0; e < NE; ++e) be += (pe[e] <= C.tid) ? 1 : 0;
            int* tab = WSP(int, WS_TAB); tab[1 + C.tid] = be < NE ? be : NE - 1; if (C.tid == 0) tab[0] = acc; }
    }
    __syncthreads();
    const unsigned* route = WSP(const unsigned, WS_ROUTE); const unsigned* wgbase = WSP(const unsigned, WS_WGBASE);
    const bf16* hb = WSP(const bf16, WS_HB); bf16* am = WSP(bf16, WS_MIX); int* pos = WSP(int, WS_POS);
    const int gw = C.wg * NWAVES + C.wave, NGW = C.G * NWAVES;
    for (int m = gw; m < nrows; m += NGW) {
        const v4u a = *(const v4u*)(route + (size_t)m * 8);
        const int e0 = (int)a.x, e1 = (int)a.y;
        const int p0 = pst[e0] + (int)wgbase[C.wg * 8 + e0] + (int)a.z, p1 = pst[e1] + (int)wgbase[C.wg * 8 + e1] + (int)a.w;
        const v4u r0 = *(const v4u*)(hb + (size_t)m * 1024 + C.lane * 8), r1 = *(const v4u*)(hb + (size_t)m * 1024 + 512 + C.lane * 8);
        *(v4u*)(am + (size_t)p0 * 1024 + C.lane * 8) = r0; *(v4u*)(am + (size_t)p0 * 1024 + 512 + C.lane * 8) = r1;
        *(v4u*)(am + (size_t)p1 * 1024 + C.lane * 8) = r0; *(v4u*)(am + (size_t)p1 * 1024 + 512 + C.lane * 8) = r1;
        if (C.lane == 0) { pos[(size_t)m * 2] = p0; pos[(size_t)m * 2 + 1] = p1; }
    }
    __syncthreads();
}
template <int NEXT>
__device__ __forceinline__ void moe_combine(const Ctx& C, int l, int nrows) {
    const unsigned* route = WSP(const unsigned, WS_ROUTE); const int* pos = WSP(const int, WS_POS); const bf16* ym = WSP(const bf16, WS_MIX);
    const float* modv = WSP(const float, WS_MODV) + (size_t)l * 9 * 6144 + 5 * 1024;
    const float* modn = WSP(const float, WS_MODV) + (size_t)(l + 1) * 9 * 6144;
    float* xc = WSP(float, WS_XC); bf16* hb = WSP(bf16, WS_HB);
    const int gw = C.wg * NWAVES + C.wave, NGW = C.G * NWAVES;
    f32x4 gn[4];
#pragma unroll
    for (int j = 0; j < 4; ++j) gn[j] = *(const f32x4*)((NEXT == 2 ? C.in[I_FNG] : C.in[I_NMIXG] + (NEXT == 1 ? (l + 1) * 1024 : 0)) + 4 * C.lane + 256 * j);
    for (int m = gw; m < nrows; m += NGW) {
        const bool isctx = m >= T_LAT;
        float* xr = isctx ? xc + (size_t)(m - T_LAT) * 1024 : C.out + (size_t)m * 1024;
        const int mrow = isctx ? 8 : (m >> 12);
        const float* gv = modv + (size_t)mrow * 6144;
        const int p0 = pos[(size_t)m * 2], p1 = pos[(size_t)m * 2 + 1];
        const float w0 = __builtin_bit_cast(float, route[(size_t)m * 8 + 4]), w1 = __builtin_bit_cast(float, route[(size_t)m * 8 + 5]);
        f32x4 x[4]; float ss = 0.f;
#pragma unroll
        for (int j = 0; j < 4; ++j) {
            const int col = 4 * C.lane + 256 * j;
            const v2u a = *(const v2u*)(ym + (size_t)p0 * 1024 + col), b = *(const v2u*)(ym + (size_t)p1 * 1024 + col);
            const f32x4 ya = (f32x4){bflo(a.x), bfhi(a.x), bflo(a.y), bfhi(a.y)}, yb = (f32x4){bflo(b.x), bfhi(b.x), bflo(b.y), bfhi(b.y)};
            const f32x4 g = *(const f32x4*)(gv + col);
            x[j] = *(const f32x4*)(xr + col) + g * (ya * w0 + yb * w1);
            if (NEXT != 2) *(f32x4*)(xr + col) = x[j];
            ss += (x[j].x * x[j].x + x[j].y * x[j].y) + (x[j].z * x[j].z + x[j].w * x[j].w);
        }
        if (NEXT != 0) {
            const float rs = rsqrtf_(wave_sum(ss) * (1.0f / 1024.0f) + 1e-6f);
#pragma unroll
            for (int j = 0; j < 4; ++j) {
                const int col = 4 * C.lane + 256 * j;
                if (NEXT == 2) *(f32x4*)(xr + col) = x[j] * rs * gn[j];
                else { const f32x4 sh = *(const f32x4*)(modn + (size_t)mrow * 6144 + col), scl = *(const f32x4*)(modn + (size_t)mrow * 6144 + 1024 + col);
                    st4bf(hb + (size_t)m * 1024 + col, (x[j] * rs * gn[j]) * (scl + 1.0f) + sh); }
            }
        }
    }
}
__device__ __forceinline__ void final_norm(const Ctx& C) {
    const int gw = C.wg * NWAVES + C.wave, NGW = C.G * NWAVES;
    f32x4 gv[4];
#pragma unroll
    for (int j = 0; j < 4; ++j) gv[j] = *(const f32x4*)(C.in[I_FNG] + 4 * C.lane + 256 * j);
    for (int m = gw; m < T_LAT; m += NGW) {
        float* xr = C.out + (size_t)m * 1024;
        f32x4 v[4]; float s = 0.f;
#pragma unroll
        for (int j = 0; j < 4; ++j) { v[j] = *(const f32x4*)(xr + 4 * C.lane + 256 * j); s += (v[j].x * v[j].x + v[j].y * v[j].y) + (v[j].z * v[j].z + v[j].w * v[j].w); }
        const float rs = rsqrtf_(wave_sum(s) * (1.0f / 1024.0f) + 1e-6f);
#pragma unroll
        for (int j = 0; j < 4; ++j) *(f32x4*)(xr + 4 * C.lane + 256 * j) = v[j] * rs * gv[j];
    }
}

constexpr int NPH_L = 13, PH_FINAL = 1 + DEPTH * NPH_L, NPHASE = PH_FINAL + 1;
__host__ __device__ inline bool phase_exists(int ph) {
    if (ph == 0) return true;
    if (ph == PH_FINAL) return false;
    const int l = (ph - 1) / NPH_L, k = (ph - 1) % NPH_L;
    if (l >= 2 && !(l & 1) && k == 0) return false;
    if (!(l & 1) && k >= 11) return false;
    if (!RW_VSPLIT && k == 4) return false;
    return true;
}
#ifndef PH_MASK
#define PH_MASK 0xFFFFFF
#endif
#define PM(k) ((PH_MASK >> (k)) & 1)
#ifndef SK_MASK
#define SK_MASK 0xFFFF
#endif
#define SK(k) ((SK_MASK >> (k)) & 1)
#ifndef REP_MASK
#define REP_MASK 0
#endif
#define NREP(k) (((REP_MASK >> (k)) & 1) ? 2 : 1)

__global__ void __launch_bounds__(NTHR, 2) fwd_kernel(Args args) {
    extern __shared__ __attribute__((aligned(16))) unsigned char lds_raw[];
    Ctx C; C.in = args.in; C.out = args.out; C.ws = args.ws; C.lds = (LAS unsigned char*)lds_raw;
    C.tid = threadIdx.x; C.lane = C.tid & 63; C.wave = __builtin_amdgcn_readfirstlane(C.tid >> 6); C.G = gridDim.x; C.wg = blockIdx.x;
    volatile LAS unsigned* MISC = (volatile LAS unsigned*)(C.lds + MISC_OFF);
    if (C.tid < 64) MISC[C.tid] = 0u;
    __syncthreads();
    const int lo = args.ph_lo, hi = args.ph_hi;
    const bool multi = (hi - lo) > 1;
    if (multi) (void)xcd_barrier_post(WSP(unsigned, WS_CTL) + CW_BAR, MISC + 8);
#define IN(k) (lo <= (k) && (k) < hi)
#define SEAM(k) do { if (IN((k) + 1)) { XcdBarrier b2_; b2_.bar = WSP(unsigned, WS_CTL) + CW_BAR; b2_.x = xb_xcc_id(); b2_.st = (volatile LAS unsigned*)(C.lds + MISC_OFF) + 8; xcd_barrier(b2_); } } while (0)
#define FRESH() do { int t_ = threadIdx.x; asm volatile("" : "+v"(t_)); C.tid = t_; C.lane = t_ & 63; C.wave = __builtin_amdgcn_readfirstlane(t_ >> 6); } while (0)
#define PHASE(bit, k) if (PM(bit) && IN(pb + (k))) for (int rep_ = 0; rep_ < NREP(bit); ++rep_)
#define CLAIM(qh, var) __syncthreads(); if (C.tid == 0) *qslot = atomicAdd((qh), 1u); __syncthreads(); const int var = (int)*qslot;

    LAS unsigned* qslot = (LAS unsigned*)(C.lds + MISC_OFF + 128);
    if (PM(20) && IN(0)) { phase_pre(C); SEAM(0); }

#pragma unroll 1
    for (int l = 0; l < DEPTH; ++l) {
        const int pb = 1 + l * NPH_L;
        if (hi <= pb || lo >= pb + NPH_L) continue;
        const bool last = (l == DEPTH - 1), moe = (l & 1);
        const int nrows = last ? T_LAT : T_ALL;
        const float* xlat = (l == 0) ? C.in[I_X] : C.out; const float* xctx = (l == 0) ? C.in[I_CTX] : WSP(const float, WS_XC);
        const float* modv = WSP(const float, WS_MODV) + (size_t)l * 9 * 6144;
        unsigned* qbase = WSP(unsigned, WS_CTL) + CW_PREPQ + 256 * l;

        if (!(l >= 2 && !(l & 1))) PHASE(0, 0) { FRESH();
            convert_small(C, l);
            if (l == 0) { FRESH(); convert_items(C, 0, 3, C.wg * NWAVES + C.wave, C.G * NWAVES); }
            __syncthreads();
            FRESH(); norm_rows<false>(C, l, xlat, xctx, C.in[I_NMIXG] + l * 1024, 0, 1024, T_ALL, 0);
            SEAM(pb + 0);
        }
        PHASE(1, 1) { FRESH();
            pg8::Gemm g{WSP(const bf16, WS_HB), WSP(const bf16, WS_WIN), T_ALL, PLD, 1024, 0};
            pg8::StaticOrder S; S.init(T_ALL, PLD, C.G, C.wg);
            pg8::EpiBf16<0> E{WSP(bf16, WS_P), PLD, nullptr, 0, 0};
            pg8::gemm_phase<pg8::EpiBf16<0>, pg8::StaticOrder, false>(C.lds, g, S, E, nullptr);
            SEAM(pb + 1);
        }
        if (PM(2) && IN(pb + 2)) for (int rep_ = 0; rep_ < NREP(2); ++rep_) { FRESH();
            for (;;) {
                CLAIM(qbase + 16 * rep_, k)
                if (k >= 3 * NB * NCH) break;
                const int kind = k / (NB * NCH), u = k % (NB * NCH);
                FRESH();
                if (kind == 0) { for (int r3_ = 0; r3_ < NREP(24); ++r3_) { FRESH(); if (SK(1)) rwkv_prep2(C, l, u / NCH, u % NCH); } }
                else if (kind == 1) { for (int r3_ = 0; r3_ < NREP(25); ++r3_) { FRESH(); if (SK(0)) lru_chunk_mfma<false>(C, l, u / NCH, u % NCH); } }
                else { for (int r3_ = 0; r3_ < NREP(26); ++r3_) { FRESH(); if (SK(2)) gdn_prep(C, l, u / NCH, u % NCH); } }
            }
            SEAM(pb + 2);
        }
        if (PM(3) && IN(pb + 3)) for (int rep_ = 0; rep_ < NREP(3); ++rep_) { FRESH();
            constexpr int NCL = 2 * NB * NH * NCH / 4;
            for (;;) {
                CLAIM(qbase + 64 + 16 * rep_, k)
                if (k >= (RW_VSPLIT ? NCL : 2 * NCL)) break;
                FRESH();
                if (k < NCL) { if (SK(9)) gdn_solve_item(C, l, 4 * k + (C.wave >> 1)); }
                else { if (SK(10)) rwkv_solve_item(C, l, 4 * (k - NCL) + (C.wave >> 1)); }
            }
            FRESH(); if (SK(6) && C.wg < 8) lru_carry(C, C.wg * NTHR + C.tid);
            SEAM(pb + (RW_VSPLIT ? 3 : 4));
        }
#if RW_VSPLIT
        if (PM(3) && IN(pb + 4)) { FRESH();
            for (;;) {
                CLAIM(qbase + 128, k)
                if (k >= 2 * NB * NH * NCH / 4) break;
                FRESH();
                if (SK(10)) rwkv_solve_item(C, l, 4 * k + (C.wave >> 1));
            }
            SEAM(pb + 4);
        }
#endif
        if (PM(4) && IN(pb + 5)) { FRESH();
            if (SK(3) && C.wg < (RW_VSPLIT ? 128 : 64)) { if (NREP(20) > 1) { FRESH(); rwkv_chunked<true>(C, l, C.wg); } FRESH(); rwkv_chunked<false>(C, l, C.wg); }
            else if (SK(4) && C.wg >= 128 && C.wg < 192) { for (int r2_ = 0; r2_ < NREP(21); ++r2_) { FRESH(); mlstm_chunked(C, l, C.wg - 128); } }
            else if (SK(5) && C.wg >= 192) { if (NREP(22) > 1) { FRESH(); gdn_chunked<true>(C, l, C.wg - 192); } FRESH(); gdn_chunked<false>(C, l, C.wg - 192); }
            {
                FRESH();
                const int nun = last ? NB * 64 : NB * NCH;
                for (;;) {
                    CLAIM(qbase + 192, u0)
                    if (u0 >= 128 + nun) break;
                    if (u0 < 128) {
                        FRESH(); if (l > 0) convert_items(C, l, 2, u0 * NWAVES + C.wave, 128 * NWAVES);
                        if (l + 1 < DEPTH) { FRESH(); convert_items(C, l + 1, 1, u0 * NWAVES + C.wave, 128 * NWAVES); }
                    } else {
                        const int u = u0 - 128;
                        const int b = last ? (u >> 6) : (u / NCH), c = last ? 4 + (u & 63) : (u % NCH);
                        if (SK(7)) lru_chunk_mfma<true>(C, l, b, c);
                    }
                }
            }
            SEAM(pb + 5);
        }
        PHASE(5, 6) { FRESH();
            if (SK(8)) finish_rows(C, l, nrows);
            SEAM(pb + 6);
        }
        if (PM(6) && IN(pb + 7)) { FRESH();
            pg8::Gemm g{WSP(const bf16, WS_HB), WSP(const bf16, WS_WOUT), nrows, 1024, 1024, 0};
            pg8::StaticOrder S; S.init(nrows, 1024, C.G, C.wg);
            pg8::EpiRes E{xlat, xctx, C.out, WSP(float, WS_XC), modv + 2 * 1024};
            pg8::gemm_phase<pg8::EpiRes, pg8::StaticOrder, false>(C.lds, g, S, E, nullptr);
            SEAM(pb + 7);
        }
        if (PM(7) && IN(pb + 8)) { FRESH();
            if (moe) norm_rows<true>(C, l, C.out, WSP(const float, WS_XC), C.in[I_NFFNG] + l * 1024, 3 * 1024, 4 * 1024, nrows, l >> 1);
            else norm_rows<false>(C, l, C.out, WSP(const float, WS_XC), C.in[I_NFFNG] + l * 1024, 3 * 1024, 4 * 1024, nrows, 0);
            SEAM(pb + 8);
        }
        if (!moe) {
            if (PM(8) && IN(pb + 9)) for (int rep_ = 0; rep_ < NREP(8); ++rep_) { FRESH();
                pg8::Gemm g{WSP(const bf16, WS_HB), WSP(const bf16, WS_WGU), nrows, 2 * DFF, 1024, 0};
                pg8::StaticOrder S; S.init(nrows, 2 * DFF, C.G, C.wg);
                pg8::EpiSwiglu E{WSP(bf16, WS_P), DFF};
                pg8::gemm_phase<pg8::EpiSwiglu, pg8::StaticOrder, false>(C.lds, g, S, E, nullptr);
                SEAM(pb + 9);
            }
            if (PM(9) && IN(pb + 10)) { FRESH();
                pg8::Gemm g{WSP(const bf16, WS_P), WSP(const bf16, WS_WDN), nrows, 1024, DFF, 0};
                pg8::StaticOrder S; S.init(nrows, 1024, C.G, C.wg);
                pg8::EpiRes E{C.out, WSP(const float, WS_XC), C.out, WSP(float, WS_XC), modv + 5 * 1024};
                pg8::gemm_phase<pg8::EpiRes, pg8::StaticOrder, false>(C.lds, g, S, E, nullptr);
                SEAM(pb + 12);
            }
        } else {
            if (PM(10) && IN(pb + 9)) { FRESH(); moe_scatter(C, l >> 1, nrows); SEAM(pb + 9); }
            if (PM(11) && IN(pb + 10)) for (int rep_ = 0; rep_ < NREP(11); ++rep_) { FRESH();
                pg8::Gemm g{WSP(const bf16, WS_MIX), WSP(const bf16, WS_WGU), 0, 2 * DFE, 1024, (size_t)2 * DFE * 1024};
                pg8::MoeOrder S; S.init(WSP(const int, WS_TAB), (2 * DFE) / 256, C.G, C.wg);
                pg8::EpiSwiglu E{WSP(bf16, WS_P), DFE};
                pg8::gemm_phase<pg8::EpiSwiglu, pg8::MoeOrder, false>(C.lds, g, S, E, nullptr);
                SEAM(pb + 10);
            }
            if (PM(12) && IN(pb + 11)) for (int rep_ = 0; rep_ < NREP(12); ++rep_) { FRESH();
                pg8::Gemm g{WSP(const bf16, WS_P), WSP(const bf16, WS_WDN), 0, 1024, DFE, (size_t)1024 * DFE};
                pg8::MoeOrder S; S.init(WSP(const int, WS_TAB), 4, C.G, C.wg);
                pg8::EpiBf16<0> E{WSP(bf16, WS_MIX), 1024, nullptr, 0, 0};
                pg8::gemm_phase<pg8::EpiBf16<0>, pg8::MoeOrder, false>(C.lds, g, S, E, nullptr);
                SEAM(pb + 11);
            }
            if (PM(13) && IN(pb + 12)) { FRESH();
                if (last) moe_combine<2>(C, l, nrows);
                else { convert_small(C, l + 1); FRESH(); moe_combine<1>(C, l, nrows); if (IN(pb + NPH_L + 1)) { XcdBarrier b2_; b2_.bar = WSP(unsigned, WS_CTL) + CW_BAR; b2_.x = xb_xcc_id(); b2_.st = (volatile LAS unsigned*)(C.lds + MISC_OFF) + 8; xcd_barrier(b2_); } }
            }
        }
    }
}

extern "C" void kernel_launch(void* const* d_in, const int* in_sizes, int n_in, void* d_out, int out_size, void* d_ws, size_t ws_size, hipStream_t stream) {
    static int grid = 0;
    if (grid == 0) {
        if (n_in != N_IN || in_sizes[0] != T_LAT * DM || out_size != T_LAT * DM || ws_size < WS_END) {
            fprintf(stderr, "kernel_launch: unexpected problem (n_in %d, in0 %d, out %d, ws %zu < %zu)\n", n_in, n_in > 0 ? in_sizes[0] : -1, out_size, ws_size, (size_t)WS_END); grid = -1; return; }
        int dev = 0, cus = 0, per_cu = 0;
        if (hipGetDevice(&dev) != hipSuccess || hipDeviceGetAttribute(&cus, hipDeviceAttributeMultiprocessorCount, dev) != hipSuccess) { grid = -1; return; }
        if (hipFuncSetAttribute((const void*)fwd_kernel, hipFuncAttributeMaxDynamicSharedMemorySize, LDS_BYTES) != hipSuccess) { fprintf(stderr, "kernel_launch: hipFuncSetAttribute failed\n"); grid = -1; return; }
        if (hipOccupancyMaxActiveBlocksPerMultiprocessor(&per_cu, (const void*)fwd_kernel, NTHR, LDS_BYTES) != hipSuccess || per_cu < 1) { fprintf(stderr, "kernel_launch: occupancy query says %d\n", per_cu); grid = -1; return; }
        grid = cus;
        if (grid != 256) fprintf(stderr, "kernel_launch: note: %d CUs\n", grid);
    }
    if (grid < 0) return;
    if (hipMemsetAsync((char*)d_ws + WS_CTL, 0, CTL_BYTES, stream) != hipSuccess) return;
    Args a{};
    for (int i = 0; i < N_IN; ++i) a.in[i] = (const float*)d_in[i];
    a.out = (float*)d_out; a.ws = (unsigned char*)d_ws;
#if MK_ONE_LAUNCH
    a.ph_lo = 0; a.ph_hi = NPHASE;
    hipLaunchKernelGGL(fwd_kernel, dim3(grid), dim3(NTHR), LDS_BYTES, stream, a);
#else
    for (int ph = 0; ph < NPHASE; ++ph) { if (!phase_exists(ph)) continue; a.ph_lo = ph; a.ph_hi = ph + 1; hipLaunchKernelGGL(fwd_kernel, dim3(grid), dim3(NTHR), LDS_BYTES, stream, a); }
#endif
}
```

```cpp
#define MK_ONE_LAUNCH 1
#include <hip/hip_runtime.h>
#include <cstdio>
#include <cstdint>

#define GAS __attribute__((address_space(1)))
#define LAS __attribute__((address_space(3)))
typedef unsigned short bf16;
typedef unsigned v4u __attribute__((ext_vector_type(4)));
typedef unsigned v2u __attribute__((ext_vector_type(2)));
typedef float f32x4 __attribute__((ext_vector_type(4)));
typedef float f32x2 __attribute__((ext_vector_type(2)));
typedef short bf16x8 __attribute__((ext_vector_type(8)));
#define LDS_WAIT() asm volatile("s_waitcnt lgkmcnt(0)" ::: "memory")
#define VM_WAIT() asm volatile("s_waitcnt vmcnt(0)" ::: "memory")

constexpr int DM = 1024, NB = 8, SEQ = 4096, DEPTH = 4, CTXL = 256, GW = 256, HD = 64, NH = 4;
constexpr int T_LAT = NB * SEQ, T_CTX = NB * CTXL, T_ALL = T_LAT + T_CTX;
constexpr int IN_COLS = 3552, PLD = 3584;
constexpr int OFF_B = 512, OFF_C = 1472, OFF_D = 2512, B_COLS = 960;
constexpr int DFF = 2816, NE = 8, DFE = 1408;
constexpr int NCH = 68;
constexpr int NSTEP = 4352;
constexpr int MOE_MAXBLK = 280;
constexpr int NWAVES = 8, NTHR = 512;
#ifndef RW_VSPLIT
#define RW_VSPLIT 0
#endif

constexpr size_t MiB = 1u << 20;
constexpr size_t WS_CTL = 0, CTL_BYTES = 1 * MiB;
constexpr size_t WS_MODV = 1 * MiB;
constexpr size_t WS_XC = 2 * MiB;
constexpr size_t WS_WIN = 10 * MiB;
constexpr size_t WS_WOUT = 17 * MiB;
constexpr size_t WS_WGU = 19 * MiB;
constexpr size_t WS_WDN = 63 * MiB;
constexpr size_t WS_HB = 85 * MiB;
constexpr size_t WS_P = 153 * MiB;
constexpr size_t WS_MIX = 391 * MiB;
constexpr size_t WS_OUTB = WS_MIX, WS_OUTC = WS_MIX + 34 * MiB, WS_OUTD = WS_MIX + 68 * MiB, WS_GQ = WS_MIX + 102 * MiB, WS_G = WS_MIX + 153 * MiB;
constexpr size_t WS_RKV = WS_MIX + 170 * MiB;
constexpr size_t WS_SMALL = 612 * MiB;
constexpr size_t WS_LSUM = WS_SMALL;
constexpr size_t WS_HIN = WS_SMALL + 3 * MiB;
constexpr size_t WS_ROUTE = WS_SMALL + 5 * MiB;
constexpr size_t WS_POS = WS_SMALL + 7 * MiB;
constexpr size_t WS_BONUS = WS_SMALL + 8 * MiB;
constexpr size_t WS_WGBASE = WS_SMALL + 9 * MiB;
constexpr size_t WS_TAB = WS_WGBASE + 65536;
constexpr size_t WS_LRUWT = WS_SMALL + 10 * MiB;
constexpr size_t WS_RWT = WS_LRUWT + 131072;
constexpr size_t WS_RINV = WS_SMALL + 11 * MiB;
constexpr size_t WS_END = 624 * MiB;
constexpr int CW_MOECNT = 1024;
constexpr int CW_PREPQ = 2048;
constexpr int CW_BAR = 4096;

constexpr int LDS_BYTES = 135168;
constexpr int MISC_OFF = 131072;

__device__ __forceinline__ unsigned f2bf(float f) { unsigned u = __builtin_bit_cast(unsigned, f); return (u + 0x7fffu + ((u >> 16) & 1u)) >> 16; }
typedef __bf16 bf16n2 __attribute__((ext_vector_type(2)));
__device__ __forceinline__ unsigned pk2(float lo, float hi) { const f32x2 v = {lo, hi}; return __builtin_bit_cast(unsigned, __builtin_convertvector(v, bf16n2)); }
__device__ __forceinline__ unsigned f2bf1(float f) { return pk2(f, f) & 0xffffu; }
__device__ __forceinline__ float bf2f(unsigned short v) { return __builtin_bit_cast(float, (unsigned)v << 16); }
__device__ __forceinline__ float bflo(unsigned v) { return __builtin_bit_cast(float, v << 16); }
__device__ __forceinline__ float bfhi(unsigned v) { return __builtin_bit_cast(float, v & 0xffff0000u); }
template <int CTRL, int RM, bool BC> __device__ __forceinline__ float dpp_x(float oldv, float v) { return __builtin_bit_cast(float, __builtin_amdgcn_update_dpp(__builtin_bit_cast(int, oldv), __builtin_bit_cast(int, v), CTRL, RM, 0xF, BC)); }
__device__ __forceinline__ float wave_sum(float v) {
    v += dpp_x<0xB1, 0xF, true>(0.f, v); v += dpp_x<0x4E, 0xF, true>(0.f, v); v += dpp_x<0x141, 0xF, true>(0.f, v); v += dpp_x<0x140, 0xF, true>(0.f, v);
    v += dpp_x<0x142, 0xA, false>(0.f, v); v += dpp_x<0x143, 0xC, false>(0.f, v);
    return __builtin_bit_cast(float, __builtin_amdgcn_readlane(__builtin_bit_cast(int, v), 63));
}
template <int CTRL> __device__ __forceinline__ float dpp_f(float v) { return __builtin_bit_cast(float, __builtin_amdgcn_update_dpp(0, __builtin_bit_cast(int, v), CTRL, 0xF, 0xF, true)); }
__device__ __forceinline__ float row16_sum(float v) {
    v += dpp_f<0xB1>(v);
    v += dpp_f<0x4E>(v);
    v += dpp_f<0x141>(v);
    v += dpp_f<0x140>(v);
    return v;
}
__device__ __forceinline__ float sigmoidf_(float x) { return __builtin_amdgcn_rcpf(1.0f + __expf(-x)); }
__device__ __forceinline__ float softplusf_(float x) { return fmaxf(x, 0.f) + __logf(1.0f + __expf(-fabsf(x))); }
__device__ __forceinline__ float expm1f_(float x) { return x > -0.3f ? x * (1.0f + x * (0.5f + x * (0.16666667f + x * (0.041666668f + x * 0.0083333338f)))) : __expf(x) - 1.0f; }
__device__ __forceinline__ float siluf_(float x) { return x * __builtin_amdgcn_rcpf(1.0f + __expf(-x)); }
__device__ __forceinline__ float tanhf_(float x) { const float e = __expf(2.0f * x); return 1.0f - 2.0f * __builtin_amdgcn_rcpf(e + 1.0f); }
__device__ __forceinline__ float rsqrtf_(float x) { return __builtin_amdgcn_rsqf(x); }
__device__ __forceinline__ float gelu_tanh(float x) { return 0.5f * x * (1.0f + tanhf_(0.7978845608028654f * (x + 0.044715f * x * x * x))); }
__device__ __forceinline__ f32x4 ld4bf(const bf16* p) { const v2u a = *(const v2u*)p; return (f32x4){bflo(a.x), bfhi(a.x), bflo(a.y), bfhi(a.y)}; }
__device__ __forceinline__ void st4bf(bf16* p, const f32x4& v) { v2u o; o.x = pk2(v.x, v.y); o.y = pk2(v.z, v.w); *(v2u*)p = o; }
#define XB_TMO      128
#define XB_XCNT(j)  (256  + 64 * (j))
#define XB_XSUB(j)  (1280 + 64 * (j))
#define XB_XGEN(j)  (2304 + 64 * (j))
#define XB_TOP      3328
#define XB_TOPGEN   3392
#define XCD_BAR_WORDS 3456
#define XB_SPIN_CAP (1u << 22)

__device__ __forceinline__ unsigned xb_ld(unsigned* p)              { return __hip_atomic_load(p, __ATOMIC_RELAXED, __HIP_MEMORY_SCOPE_AGENT); }
__device__ __forceinline__ unsigned xb_add(unsigned* p, unsigned v) { return __hip_atomic_fetch_add(p, v, __ATOMIC_RELAXED, __HIP_MEMORY_SCOPE_AGENT); }
__device__ __forceinline__ unsigned xb_xcc_id() { return (unsigned)__builtin_amdgcn_s_getreg((3 << 11) | 20) & 0xFu; }
#define XB_SPIN(cond, bar) do { unsigned _sp = 0; while (cond) { __builtin_amdgcn_s_sleep(1); \
    if ((++_sp & 255u) == 0u) { if (xb_ld(&(bar)[XB_TMO])) break; if (_sp > XB_SPIN_CAP) { atomicAdd(&(bar)[XB_TMO], 1u); break; } } } } while (0)

struct XcdBarrier {
    unsigned* bar; unsigned x;
    volatile LAS unsigned* st;
};

__device__ __forceinline__ XcdBarrier xcd_barrier_post(unsigned* bar, volatile LAS unsigned* st) {
    XcdBarrier b; b.bar = bar; b.x = xb_xcc_id(); b.st = st;
    if (threadIdx.x == 0) (void)xb_add(&bar[XB_XCNT(b.x)], 1u);
    return b;
}
__device__ __forceinline__ void xcd_barrier_complete(unsigned* bar, unsigned x, unsigned& nloc, unsigned& nx) {
    const unsigned G = gridDim.x * gridDim.y * gridDim.z;
    unsigned sum, cnt, mine, sp = 0u;
    for (;;) {
        sum = 0u; cnt = 0u; mine = 0u;
#pragma unroll
        for (unsigned j = 0; j < 16; ++j) { const unsigned c = xb_ld(&bar[XB_XCNT(j)]); sum += c; cnt += (c > 0u) ? 1u : 0u; mine = (j == x) ? c : mine; }
        if (sum == G) break;
        __builtin_amdgcn_s_sleep(1);
        if ((++sp & 255u) == 0u) { if (xb_ld(&bar[XB_TMO])) break; if (sp > XB_SPIN_CAP) { atomicAdd(&bar[XB_TMO], 1u); break; } }
    }
    nloc = mine > 0u ? mine : 1u; nx = cnt > 0u ? cnt : 1u;
}

__device__ __forceinline__ void xcd_barrier(const XcdBarrier& b) {
    asm volatile("s_waitcnt vmcnt(0)" ::: "memory");
    __syncthreads();
    if (threadIdx.x == 0) {
        unsigned* bar = b.bar;
        __builtin_amdgcn_s_waitcnt(0);
        unsigned nloc = b.st[0], nx = b.st[1];
        if (nloc == 0u) { xcd_barrier_complete(bar, b.x, nloc, nx); b.st[0] = nloc; b.st[1] = nx; }
        const unsigned old = xb_add(&bar[XB_XSUB(b.x)], 1u);
        const unsigned gen = old / nloc;
        if (old + 1u == (gen + 1u) * nloc) {
            __builtin_amdgcn_fence(__ATOMIC_RELEASE, "agent");
            asm volatile("s_waitcnt vmcnt(0)" ::: "memory");
            const unsigned og = xb_add(&bar[XB_TOP], 1u);
            const unsigned tg = og / nx;
            if (og + 1u == (tg + 1u) * nx) xb_add(&bar[XB_TOPGEN], 1u);
            else XB_SPIN(xb_ld(&bar[XB_TOPGEN]) == tg, bar);
            __builtin_amdgcn_fence(__ATOMIC_ACQUIRE, "agent");
            xb_add(&bar[XB_XGEN(b.x)], 1u);
            asm volatile("s_waitcnt vmcnt(0)" ::: "memory");
        } else {
            XB_SPIN(xb_ld(&bar[XB_XGEN(b.x)]) == gen, bar);
            __builtin_amdgcn_fence(__ATOMIC_ACQUIRE, "agent");
            asm volatile("s_waitcnt vmcnt(0)" ::: "memory");
        }
    }
    __syncthreads();
}

namespace pg8 {
#define PG8_LAS __attribute__((address_space(3)))
typedef unsigned short bf16_t;
typedef short bf16x8 __attribute__((ext_vector_type(8)));
typedef float f32x4 __attribute__((ext_vector_type(4)));
typedef unsigned u32x4 __attribute__((ext_vector_type(4)));
constexpr int BM = 256, BK = 64, HALF = 128, HTB = HALF * BK * 2  , STAGE_BYTES = 8 * HTB, NXCD = 8, WGM = 8;

__host__ __device__ __forceinline__ int lds_byte(int r, int c) { const int st = (r >> 4) * 2 + (c >> 5), rr = r & 15, cc = c & 31, ob = rr * 64 + cc * 2; return st * 1024 + (ob ^ (((ob >> 9) & 1) << 5)); }
__host__ __device__ __forceinline__ void stage_rc(int b, int& R, int& C) { const int st = b / 1024, sb = b % 1024, swz = sb ^ (((sb >> 9) & 1) << 5); R = (st >> 1) * 16 + swz / 64; C = (st & 1) * 32 + (swz % 64) / 2; }
__host__ __device__ __forceinline__ int perm32(int rho) { const int n = rho >> 4, i = rho & 15; return 8 * (i >> 2) + 4 * n + (i & 3); }

struct Unit { int pm, pn, e; };
struct Gemm { const bf16_t* A; const bf16_t* Bt; int M, N, K; size_t estride; };

struct StaticOrder {
    int nM, nN, nwg, G, c;
    __host__ __device__ void init(int M, int N, int G_, int c_) { nM = M / BM; nN = N / BM; nwg = nM * nN; G = G_; c = c_; }
    __host__ __device__ bool next(int i, Unit& u) const {
        const long L = (long)i * G + c; if (L >= nwg) return false;
        int wgid = (int)L; { const int q = nwg / NXCD, r = nwg % NXCD, xcd = wgid % NXCD, off = wgid / NXCD; wgid = (xcd < r ? xcd * (q + 1) : r * (q + 1) + (xcd - r) * q) + off; }
        const int nig = WGM * nN, gid = wgid / nig, fm = gid * WGM, gsz = (nM - fm) < WGM ? (nM - fm) : WGM;
        u.pm = fm + ((wgid % nig) % gsz); u.pn = (wgid % nig) / gsz; u.e = 0; return true;
    }
    __device__ __forceinline__ void a_ready(const Unit&) const {}
    __device__ __forceinline__ void done(const Unit&) const {}
};
__device__ __forceinline__ unsigned cvt_pk_bf16(float lo, float hi) { unsigned r; asm volatile("v_cvt_pk_bf16_f32 %0, %1, %2" : "=v"(r) : "v"(lo), "v"(hi)); return r; }
typedef float f32x2 __attribute__((ext_vector_type(2)));
__device__ __forceinline__ f32x2 gelu_pk(f32x2 v) {
    const f32x2 av = __builtin_elementwise_abs(v), d = av * 0.2316418882f + 1.0f;
    f32x2 t; t.x = __builtin_amdgcn_rcpf(d.x); t.y = __builtin_amdgcn_rcpf(d.y);
    f32x2 q = t * 0.5307027145f + (-0.7265760135f); q = q * t + 0.7107068705f; q = q * t + (-0.142248368f); q = q * t + 0.127414796f; q = q * t;
    const f32x2 s = (v * v) * (-0.72134752044f);
    f32x2 e; e.x = __builtin_amdgcn_exp2f(s.x); e.y = __builtin_amdgcn_exp2f(s.y);
    const f32x2 m = v * (q * e), r = v - m;
    f32x2 o; o.x = v.x < 0.f ? m.x : r.x; o.y = v.y < 0.f ? m.y : r.y; return o;
}

struct EpiF32 {
    static constexpr bool PERM = false, AFTER_DRAIN = false;
    float* C; int ldc; const float* bias;
    __device__ __forceinline__ void operator()(const f32x4 (&acc)[2][2][4][2], const Unit& u, int wr, int wc, int fr, int fq) const {
        const int row0 = u.pm * BM + wr * 64 + fr, col0 = u.pn * BM + wc * 32 + 4 * fq;
        f32x4 bv[2][2];
#pragma unroll
        for (int bj = 0; bj < 2; ++bj)
#pragma unroll
            for (int n = 0; n < 2; ++n) bv[bj][n] = bias ? *(const f32x4*)(bias + col0 + bj * HALF + n * 16) : (f32x4){0.f, 0.f, 0.f, 0.f};
#pragma unroll
        for (int ai = 0; ai < 2; ++ai)
#pragma unroll
            for (int m = 0; m < 4; ++m) { float* rowp = C + (size_t)(row0 + ai * HALF + m * 16) * ldc + col0;
#pragma unroll
                for (int bj = 0; bj < 2; ++bj)
#pragma unroll
                    for (int n = 0; n < 2; ++n) *(f32x4*)(rowp + bj * HALF + n * 16) = acc[ai][bj][m][n] + bv[bj][n]; }
    }
};
template <int ACT  > struct EpiBf16 {
    static constexpr bool PERM = true, AFTER_DRAIN = false;
    bf16_t* O; int ldc; const float* bias; int split_cols; size_t split_stride;
    __device__ __forceinline__ void operator()(const f32x4 (&acc)[2][2][4][2], const Unit& u, int wr, int wc, int fr, int fq) const {
        const int row0 = u.pm * BM + wr * 64 + fr; int colt = u.pn * BM; bf16_t* base = O;
        if (split_cols) { const int t = colt / split_cols; base += (size_t)t * split_stride; colt -= t * split_cols; }
        const int col0 = colt + wc * 32 + 8 * fq, bcol0 = u.pn * BM + wc * 32 + 8 * fq;
        f32x4 bv[2][2];
#pragma unroll
        for (int bj = 0; bj < 2; ++bj)
#pragma unroll
            for (int n = 0; n < 2; ++n) bv[bj][n] = bias ? *(const f32x4*)(bias + bcol0 + bj * HALF + 4 * n) : (f32x4){0.f, 0.f, 0.f, 0.f};
#pragma unroll
        for (int ai = 0; ai < 2; ++ai)
#pragma unroll
            for (int m = 0; m < 4; ++m) { bf16_t* rowp = base + (size_t)(row0 + ai * HALF + m * 16) * ldc + col0;
#pragma unroll
                for (int bj = 0; bj < 2; ++bj) { f32x4 v0 = acc[ai][bj][m][0] + bv[bj][0], v1 = acc[ai][bj][m][1] + bv[bj][1];
                    if (ACT == 1) { f32x2 a = gelu_pk((f32x2){v0[0], v0[1]}), b = gelu_pk((f32x2){v0[2], v0[3]}), c = gelu_pk((f32x2){v1[0], v1[1]}), d = gelu_pk((f32x2){v1[2], v1[3]});
                        v0 = (f32x4){a.x, a.y, b.x, b.y}; v1 = (f32x4){c.x, c.y, d.x, d.y}; }
                    if (ACT == 2) {
#pragma unroll
                        for (int j = 0; j < 4; ++j) { v0[j] = 0.5f * v0[j] * (1.0f + erff(v0[j] * 0.70710678f)); v1[j] = 0.5f * v1[j] * (1.0f + erff(v1[j] * 0.70710678f)); } }
                    u32x4 w; w.x = cvt_pk_bf16(v0[0], v0[1]); w.y = cvt_pk_bf16(v0[2], v0[3]); w.z = cvt_pk_bf16(v1[0], v1[1]); w.w = cvt_pk_bf16(v1[2], v1[3]);
                    *(u32x4*)(rowp + bj * HALF) = w; } }
    }
};

template <class Epi, class Sched, bool STAMP = false>
__device__ __forceinline__ void gemm_phase(PG8_LAS unsigned char* lds, const Gemm g, const Sched& S, const Epi& E, unsigned long long* stamps) {
    int tid_ = threadIdx.x; asm volatile("" : "+v"(tid_));
    const int tid = tid_, wid = __builtin_amdgcn_readfirstlane(tid >> 6), lane = tid & 63, wr = wid >> 2, wc = wid & 3, fr = lane & 15, fq = lane >> 4;
    const int K = g.K, nt = K / BK;
    int ts_lo = 0, ts_hi = 0, nts = 0; const unsigned long long rt_entry = STAMP ? (unsigned long long)wall_clock64() : 0ull;
#define PG8_STAMP() do { if (STAMP && wid == 0 && nts < 64) { const unsigned long long _c = (unsigned long long)clock64(); \
        ts_lo = (lane == nts) ? (int)(unsigned)_c : ts_lo; ts_hi = (lane == nts) ? (int)(unsigned)(_c >> 32) : ts_hi; ++nts; } } while (0)
    PG8_STAMP();
    unsigned voffA[2], voffB[2];
#pragma unroll
    for (int i = 0; i < 2; ++i) { int R, C; stage_rc(tid * 16 + i * 8192, R, C); const int Rb = Epi::PERM ? ((R & ~31) + perm32(R & 31)) : R;
        voffA[i] = (unsigned)(R * K + C) * 2u; voffB[i] = (unsigned)(Rb * K + C) * 2u; }
    const size_t kstep = (size_t)(BK * 2);
    const size_t hstep = (size_t)HALF * K * 2;
    const size_t tstep = 2 * hstep;
    const unsigned ldsw = (unsigned)wid * 1024u;
    const int aoff = lds_byte(wr * 64 + fr, fq * 8), boff = lds_byte(wc * 32 + fr, fq * 8);
#define PG8_SA(b, h) (((b) * 2 + (h)) * HTB)
#define PG8_SB(b, h) ((4 + (b) * 2 + (h)) * HTB)
#define PG8_STAGE(bufoff, gbase, voff) do { _Pragma("unroll") for (int _i = 0; _i < 2; ++_i) \
        __builtin_amdgcn_global_load_lds((const unsigned*)((const char*)(gbase) + (voff)[_i]), (PG8_LAS unsigned*)(lds + (bufoff) + ldsw + _i * 8192), 16, 0, 0); } while (0)
#define PG8_LDA(dst, b, h) do { _Pragma("unroll") for (int m = 0; m < 4; ++m) _Pragma("unroll") for (int k = 0; k < 2; ++k) dst[m][k] = *(const PG8_LAS bf16x8*)(lds + PG8_SA(b, h) + aoff + m * 2048 + k * 1024); } while (0)
#define PG8_LDB(dst, b, h) do { _Pragma("unroll") for (int n = 0; n < 2; ++n) _Pragma("unroll") for (int k = 0; k < 2; ++k) dst[n][k] = *(const PG8_LAS bf16x8*)(lds + PG8_SB(b, h) + boff + n * 2048 + k * 1024); } while (0)
#define PG8_MMA(ai, bj, At, Bt) do { __builtin_amdgcn_s_setprio(1); _Pragma("unroll") for (int m = 0; m < 4; ++m) _Pragma("unroll") for (int n = 0; n < 2; ++n) _Pragma("unroll") for (int k = 0; k < 2; ++k) \
        acc[ai][bj][m][n] = __builtin_amdgcn_mfma_f32_16x16x32_bf16(Bt[n][k], At[m][k], acc[ai][bj][m][n], 0, 0, 0); __builtin_amdgcn_s_setprio(0); } while (0)
#define PG8_WAIT_V(n) asm volatile("s_waitcnt vmcnt(" #n ")" ::: "memory")
#define PG8_WAIT_L(n) asm volatile("s_waitcnt lgkmcnt(" #n ")" ::: "memory")
#define PG8_BAR __builtin_amdgcn_s_barrier()
#define PG8_SCHED __builtin_amdgcn_sched_barrier(0)
    Unit cur, nxt; int ui = 0;
    if (!S.next(0, cur)) return;
    f32x4 acc[2][2][4][2];
#pragma unroll
    for (int a = 0; a < 2; ++a)
#pragma unroll
        for (int b = 0; b < 2; ++b)
#pragma unroll
            for (int m = 0; m < 4; ++m)
#pragma unroll
                for (int n = 0; n < 2; ++n) acc[a][b][m][n] = (f32x4){0.f, 0.f, 0.f, 0.f};
    bf16x8 At[4][2], B0[2][2], B1[2][2];
    const char* cA = (const char*)g.A + (size_t)cur.pm * tstep; const char* cB = (const char*)g.Bt + (size_t)cur.pn * tstep + (size_t)cur.e * g.estride * 2;
    S.a_ready(cur);
    PG8_STAGE(PG8_SB(0, 0), cB, voffB); PG8_STAGE(PG8_SA(0, 0), cA, voffA); PG8_STAGE(PG8_SB(0, 1), cB + hstep, voffB); PG8_STAGE(PG8_SA(0, 1), cA + hstep, voffA);
    if (wr == 1) PG8_BAR;
    PG8_WAIT_V(4); PG8_BAR;
    PG8_STAGE(PG8_SB(1, 0), cB + kstep, voffB); PG8_STAGE(PG8_SA(1, 0), cA + kstep, voffA); PG8_STAGE(PG8_SB(1, 1), cB + hstep + kstep, voffB);
    PG8_WAIT_V(6); PG8_BAR;
    PG8_STAMP();
    for (;;) {
        const bool has_next = S.next(ui + 1, nxt);
        const char* nA = has_next ? (const char*)g.A + (size_t)nxt.pm * tstep : cA; const char* nB = has_next ? (const char*)g.Bt + (size_t)nxt.pn * tstep + (size_t)nxt.e * g.estride * 2 : cB;
        for (int t = 0; t < nt; t += 2) {
            const bool last = (t == nt - 2);
            const char* a1 = cA + (size_t)(t + 1) * kstep;
            const char* a2 = last ? nA : cA + (size_t)(t + 2) * kstep; const char* b2 = last ? nB : cB + (size_t)(t + 2) * kstep;
            const char* a3 = a2 + kstep; const char* b3 = b2 + kstep;
            if (last && has_next) S.a_ready(nxt);
            PG8_LDB(B0, 0, 0); PG8_SCHED; PG8_LDA(At, 0, 0); PG8_STAGE(PG8_SA(1, 1), a1 + hstep, voffA);
            PG8_WAIT_L(8); PG8_BAR; PG8_WAIT_L(0); PG8_MMA(0, 0, At, B0); PG8_BAR; PG8_SCHED;
            PG8_LDB(B1, 0, 1); PG8_STAGE(PG8_SB(0, 0), b2, voffB);
            PG8_BAR; PG8_WAIT_L(0); PG8_MMA(0, 1, At, B1); PG8_BAR;
            PG8_LDA(At, 0, 1); PG8_STAGE(PG8_SA(0, 0), a2, voffA);
            PG8_BAR; PG8_WAIT_L(0); PG8_MMA(1, 0, At, B0); PG8_BAR; PG8_SCHED;
            PG8_STAGE(PG8_SB(0, 1), b2 + hstep, voffB);
            PG8_WAIT_V(6); PG8_BAR; PG8_MMA(1, 1, At, B1); PG8_BAR;
            PG8_LDB(B0, 1, 0); PG8_SCHED; PG8_LDA(At, 1, 0); PG8_STAGE(PG8_SA(0, 1), a2 + hstep, voffA);
            PG8_WAIT_L(8); PG8_BAR; PG8_WAIT_L(0); PG8_MMA(0, 0, At, B0); PG8_BAR; PG8_SCHED;
            PG8_LDB(B1, 1, 1); PG8_STAGE(PG8_SB(1, 0), b3, voffB);
            PG8_BAR; PG8_WAIT_L(0); PG8_MMA(0, 1, At, B1); PG8_BAR;
            PG8_LDA(At, 1, 1); PG8_STAGE(PG8_SA(1, 0), a3, voffA);
            PG8_BAR; PG8_WAIT_L(0); PG8_MMA(1, 0, At, B0); PG8_BAR; PG8_SCHED;
            PG8_STAGE(PG8_SB(1, 1), b3 + hstep, voffB);
            PG8_WAIT_V(6); PG8_BAR; PG8_MMA(1, 1, At, B1); PG8_BAR;
        }
        PG8_STAMP();
        if constexpr (!Epi::AFTER_DRAIN) { E(acc, cur, wr, wc, fr, fq); S.done(cur); }
        PG8_STAMP();
        if (!has_next) break;
#pragma unroll
        for (int a = 0; a < 2; ++a)
#pragma unroll
            for (int b = 0; b < 2; ++b)
#pragma unroll
                for (int m = 0; m < 4; ++m)
#pragma unroll
                    for (int n = 0; n < 2; ++n) acc[a][b][m][n] = (f32x4){0.f, 0.f, 0.f, 0.f};
        cur = nxt; cA = nA; cB = nB; ++ui;
    }
    PG8_WAIT_V(0);
    if (wr == 0) PG8_BAR;
    PG8_BAR;
    if constexpr (Epi::AFTER_DRAIN) { E.fused(acc, cur, wr, wc, fr, fq, lds, wid, lane); S.done(cur); }
    PG8_STAMP();
    if (STAMP && wid == 0) { stamps[lane] = lane < nts ? (((unsigned long long)(unsigned)ts_hi << 32) | (unsigned)ts_lo) : 0ull;
        if (lane == 62) stamps[62] = rt_entry; if (lane == 63) stamps[63] = (unsigned long long)wall_clock64(); }
#undef PG8_STAMP
#undef PG8_SA
#undef PG8_SB
#undef PG8_STAGE
#undef PG8_LDA
#undef PG8_LDB
#undef PG8_MMA
#undef PG8_WAIT_V
#undef PG8_WAIT_L
#undef PG8_BAR
#undef PG8_SCHED
}
}
namespace pg8 {
struct EpiRes {
    static constexpr bool PERM = false, AFTER_DRAIN = false;
    const float* base_lat; const float* base_ctx; float* out_lat; float* out_ctx; const float* gvec;
    __device__ __forceinline__ void operator()(const f32x4 (&acc)[2][2][4][2], const Unit& u, int wr, int wc, int fr, int fq) const {
        const bool isctx = u.pm >= 128;
        const int prow = (isctx ? (u.pm - 128) : u.pm) * BM;
        const float* base = isctx ? base_ctx : base_lat; float* out = isctx ? out_ctx : out_lat;
        const float* gv = gvec + (size_t)(isctx ? 8 : (u.pm >> 4)) * 6144;
        const int row0 = prow + wr * 64 + fr, col0 = u.pn * BM + wc * 32 + 4 * fq;
        f32x4 gvv[2][2];
#pragma unroll
        for (int bj = 0; bj < 2; ++bj)
#pragma unroll
            for (int n = 0; n < 2; ++n) gvv[bj][n] = *(const f32x4*)(gv + col0 + bj * HALF + n * 16);
#pragma unroll
        for (int ai = 0; ai < 2; ++ai)
#pragma unroll
            for (int m = 0; m < 4; ++m) { const size_t off = (size_t)(row0 + ai * HALF + m * 16) * 1024 + col0;
#pragma unroll
                for (int bj = 0; bj < 2; ++bj)
#pragma unroll
                    for (int n = 0; n < 2; ++n) { const f32x4 b = *(const f32x4*)(base + off + bj * HALF + n * 16);
                        *(f32x4*)(out + off + bj * HALF + n * 16) = b + gvv[bj][n] * acc[ai][bj][m][n]; } }
    }
};
struct EpiSwiglu {
    static constexpr bool PERM = true, AFTER_DRAIN = false;
    bf16_t* O; int ldc;
    __device__ __forceinline__ void operator()(const f32x4 (&acc)[2][2][4][2], const Unit& u, int wr, int wc, int fr, int fq) const {
        const int row0 = u.pm * BM + wr * 64 + fr, col0 = u.pn * HALF + wc * 32 + 8 * fq;
#pragma unroll
        for (int ai = 0; ai < 2; ++ai)
#pragma unroll
            for (int m = 0; m < 4; ++m) { bf16_t* rowp = O + (size_t)(row0 + ai * HALF + m * 16) * ldc + col0;
                float h[8];
#pragma unroll
                for (int n = 0; n < 2; ++n)
#pragma unroll
                    for (int j = 0; j < 4; ++j) { const float g = acc[ai][0][m][n][j], up = acc[ai][1][m][n][j]; h[n * 4 + j] = g * __builtin_amdgcn_rcpf(1.0f + __expf(-g)) * up; }
                u32x4 w; w.x = cvt_pk_bf16(h[0], h[1]); w.y = cvt_pk_bf16(h[2], h[3]); w.z = cvt_pk_bf16(h[4], h[5]); w.w = cvt_pk_bf16(h[6], h[7]);
                *(u32x4*)rowp = w; }
    }
};
struct MoeOrder {
    int nN, G, c, nunits; const int* tab;
    __device__ void init(const int* tab_, int nN_, int G_, int c_) { tab = tab_; nN = nN_; G = G_; c = c_; nunits = tab_[0] * nN_; }
    __device__ bool next(int i, Unit& u) const {
        const int L = i * G + c; if (L >= nunits) return false;
        u.pm = L / nN; u.pn = L - u.pm * nN; u.e = tab[1 + u.pm]; return true;
    }
    __device__ __forceinline__ void a_ready(const Unit&) const {}
    __device__ __forceinline__ void done(const Unit&) const {}
};
}
enum { I_X = 0, I_C, I_CTX, I_CCTX, I_MODW, I_MODB, I_NMIXG, I_NFFNG, I_WIN, I_WOUT, I_LCW, I_LCB, I_LWA, I_LBA, I_LWX, I_LBX, I_LLAM,
       I_RMU, I_RWUP, I_RW0, I_RAUP, I_RA0, I_RGUP, I_RKK, I_RKA, I_RRK, I_RLNG, I_RLNB, I_MIB, I_MFB, I_MNG, I_GCW, I_GALOG, I_GDTB, I_GNG,
       I_FWG, I_FWU, I_FWD, I_MROUTER, I_MWG, I_MWU, I_MWD, I_FNG, N_IN };
struct Args { const float* in[N_IN]; float* out; unsigned char* ws; int ph_lo, ph_hi; };
struct Ctx {
    const float* const* in; float* out; unsigned char* ws; LAS unsigned char* lds;
    int tid, lane, wave, G, wg;
};
#define WSP(T, off) ((T*)(C.ws + (off)))

__device__ __forceinline__ int seqrow_raster(int i, int d, int b) {
    if (i < CTXL) { const int p = d ? (CTXL - 1 - i) : i; return T_LAT + b * CTXL + p; }
    const int j = i - CTXL; const int p = d ? (SEQ - 1 - j) : j; return b * SEQ + p;
}
__device__ __forceinline__ int seqrow_cm(int i, int d, int b) {
    if (i < CTXL) { const int p = d ? (CTXL - 1 - i) : i; return T_LAT + b * CTXL + p; }
    const int j = i - CTXL; const int p = d ? (SEQ - 1 - j) : j; return b * SEQ + (p & 63) * 64 + (p >> 6);
}

__device__ __forceinline__ void phase_pre(const Ctx& C) {
    LAS float* sc = (LAS float*)C.lds;
    LAS float* red = sc + 9 * 1024;
    float* modv = WSP(float, WS_MODV);
    bool filled = false;
    for (int it = C.wg; it < DEPTH * 48; it += C.G) {
        if (!filled) {
            for (int i = C.tid; i < 9 * 1024; i += NTHR) { const float v = i < 8192 ? C.in[I_C][i] : C.in[I_CCTX][i - 8192]; sc[i] = siluf_(v); }
            filled = true; __syncthreads();
        }
        const int l = it / 48, jb = it % 48, col = C.tid & 127, kg = C.tid >> 7;
        const float* W = C.in[I_MODW] + (size_t)l * 1024 * 6144 + jb * 128 + col;
        float acc[9];
#pragma unroll
        for (int r = 0; r < 9; ++r) acc[r] = 0.f;
        for (int k = kg * 256; k < kg * 256 + 256; ++k) { const float w = W[(size_t)k * 6144];
#pragma unroll
            for (int r = 0; r < 9; ++r) acc[r] += sc[r * 1024 + k] * w; }
#pragma unroll
        for (int r = 0; r < 9; ++r) red[(kg * 9 + r) * 128 + col] = acc[r];
        __syncthreads();
        for (int i = C.tid; i < 9 * 128; i += NTHR) { const int r = i >> 7, cc = i & 127;
            const float s = red[(0 * 9 + r) * 128 + cc] + red[(1 * 9 + r) * 128 + cc] + red[(2 * 9 + r) * 128 + cc] + red[(3 * 9 + r) * 128 + cc];
            modv[((size_t)l * 9 + r) * 6144 + jb * 128 + cc] = s + C.in[I_MODB][l * 6144 + jb * 128 + cc]; }
        __syncthreads();
    }
}

__device__ __forceinline__ void tr_item(const float* src, size_t ld, int k0, int ns0, bf16* dst, int drow0, int Kd, LAS float* scr, int lane, bool zero) {
    if (!zero) {
#pragma unroll 8
        for (int i = 0; i < 32; ++i) { const int kk = 2 * i + (lane >> 5); scr[kk * 33 + (lane & 31)] = src[(size_t)(k0 + kk) * ld + ns0 + (lane & 31)]; }
    }
    LDS_WAIT(); asm volatile("" ::: "memory");
    const int c = lane & 7;
#pragma unroll
    for (int j = 0; j < 4; ++j) { const int n = (lane >> 3) + 8 * j; const LAS float* s = scr + (8 * c) * 33 + n;
        v4u o; o.x = pk2(s[0 * 33], s[1 * 33]); o.y = pk2(s[2 * 33], s[3 * 33]); o.z = pk2(s[4 * 33], s[5 * 33]); o.w = pk2(s[6 * 33], s[7 * 33]);
        if (zero) o = (v4u){0u, 0u, 0u, 0u};
        *(v4u*)(dst + (size_t)(drow0 + n) * Kd + k0 + 8 * c) = o; }
    LDS_WAIT(); asm volatile("" ::: "memory");
}
__device__ __forceinline__ void convert_small(const Ctx& C, int l) {
    {
        bf16* lw = WSP(bf16, WS_LRUWT);
        for (int k = 0; k < 2 * 2 * 4 * 4096 / (128 * NTHR); ++k) {
            const int e = k * 128 * NTHR + C.wg * NTHR + C.tid;
            if (C.wg < 128) {
            const int i = e & 63, j = (e >> 6) & 63, hd = (e >> 12) & 3, g = (e >> 14) & 1, d = e >> 15;
            const float* src = (g ? C.in[I_LWX] : C.in[I_LWA]) + ((size_t)((l * 2 + d) * 4 + hd) * 64 + i) * 64 + j;
            lw[e] = (bf16)f2bf(*src);
            }
        }
    }
    if (C.wg >= 128 && C.wg < 224) {
        bf16* rw = WSP(bf16, WS_RWT);
        const int e = (C.wg - 128) * NTHR + C.tid;
        if (e < 32768) { const int r = e & 31, ch = (e >> 5) & 255, d = (e >> 13) & 1, isa = e >> 14;
            rw[e] = (bf16)f2bf((isa ? C.in[I_RAUP] : C.in[I_RWUP])[((size_t)(l * 2 + d) * 32 + r) * GW + ch]); }
        else { const int e2 = e - 32768, j = e2 & 63, ch = e2 >> 6; rw[e] = (bf16)f2bf(C.in[I_RGUP][((size_t)l * 64 + j) * GW + ch]); }
    }
}
__device__ __forceinline__ void convert_items(const Ctx& C, int l, int what, int gw, int NGW) {
    LAS float* scr = (LAS float*)(C.lds + C.wave * 8704);
    constexpr int I_IN = 16 * 112, I_OUT = 16 * 32, I_GU = 16 * 176, I_DN = 44 * 32, I_E = 16 * 88 + 22 * 32;
    const bool moe = l & 1; const int li = l >> 1;
    const int lo_it = (what & 1) ? 0 : I_IN, hi_it = (what & 2) ? I_IN + I_OUT + (moe ? NE * I_E : (I_GU + I_DN)) : I_IN;
    bf16* win = WSP(bf16, WS_WIN); bf16* wout = WSP(bf16, WS_WOUT); bf16* wgu = WSP(bf16, WS_WGU); bf16* wdn = WSP(bf16, WS_WDN);
    for (int it = lo_it + gw; it < hi_it; it += NGW) {
        int r = it;
        if (r < I_IN) { const int kb = r / 112, nb = r % 112; tr_item(C.in[I_WIN] + (size_t)l * 1024 * IN_COLS, IN_COLS, 64 * kb, 32 * nb, win, 32 * nb, 1024, scr, C.lane, nb == 111); continue; }
        r -= I_IN;
        if (r < I_OUT) { const int kb = r / 32, nb = r % 32; tr_item(C.in[I_WOUT] + (size_t)l * 1024 * 1024, 1024, 64 * kb, 32 * nb, wout, 32 * nb, 1024, scr, C.lane, false); continue; }
        r -= I_OUT;
        if (!moe) {
            if (r < I_GU) { const int kb = r / 176, nb = r % 176, tile = nb >> 3, q = nb & 7;
                const float* src = (q < 4 ? C.in[I_FWG] : C.in[I_FWU]) + (size_t)li * 1024 * DFF;
                tr_item(src, DFF, 64 * kb, tile * 128 + (q & 3) * 32, wgu, 32 * nb, 1024, scr, C.lane, false); continue; }
            r -= I_GU;
            { const int kb = r / 32, nb = r % 32; tr_item(C.in[I_FWD] + (size_t)li * DFF * 1024, 1024, 64 * kb, 32 * nb, wdn, 32 * nb, DFF, scr, C.lane, false); }
        } else {
            const int e = r / I_E; int rr = r % I_E;
            if (rr < 16 * 88) { const int kb = rr / 88, nb = rr % 88, tile = nb >> 3, q = nb & 7;
                const float* src = (q < 4 ? C.in[I_MWG] : C.in[I_MWU]) + ((size_t)li * NE + e) * 1024 * DFE;
                tr_item(src, DFE, 64 * kb, tile * 128 + (q & 3) * 32, wgu + (size_t)e * 2 * DFE * 1024, 32 * nb, 1024, scr, C.lane, false); continue; }
            rr -= 16 * 88;
            { const int kb = rr / 32, nb = rr % 32; tr_item(C.in[I_MWD] + ((size_t)li * NE + e) * DFE * 1024, 1024, 64 * kb, 32 * nb, wdn + (size_t)e * 1024 * DFE, 32 * nb, DFE, scr, C.lane, false); }
        }
    }
}

template <bool ROUTE>
__device__ __forceinline__ void norm_rows(const Ctx& C, int l, const float* xlat, const float* xctx, const float* gain, int shoff, int scoff, int nrows, int moe_li) {
    const float* modv = WSP(float, WS_MODV) + (size_t)l * 9 * 6144;
    bf16* hb = WSP(bf16, WS_HB);
    const int gw = C.wg * NWAVES + C.wave, NGW = C.G * NWAVES;
    LAS unsigned* lcnt = (LAS unsigned*)(C.lds + 65536);
    unsigned* route = WSP(unsigned, WS_ROUTE);
    if (ROUTE) { if (C.tid < 8) lcnt[C.tid] = 0u; __syncthreads(); }
    f32x4 gv[4];
#pragma unroll
    for (int j = 0; j < 4; ++j) gv[j] = *(const f32x4*)(gain + 4 * C.lane + 256 * j);
    for (int m = gw; m < nrows; m += NGW) {
        const bool isctx = m >= T_LAT;
        const float* xr = isctx ? xctx + (size_t)(m - T_LAT) * 1024 : xlat + (size_t)m * 1024;
        const float* mv = modv + (size_t)(isctx ? 8 : (m >> 12)) * 6144;
        f32x4 v[4]; float s = 0.f;
#pragma unroll
        for (int j = 0; j < 4; ++j) { v[j] = *(const f32x4*)(xr + 4 * C.lane + 256 * j); s += (v[j].x * v[j].x + v[j].y * v[j].y) + (v[j].z * v[j].z + v[j].w * v[j].w); }
        const float rs = rsqrtf_(wave_sum(s) * (1.0f / 1024.0f) + 1e-6f);
#pragma unroll
        for (int j = 0; j < 4; ++j) { const f32x4 sh = *(const f32x4*)(mv + shoff + 4 * C.lane + 256 * j), scl = *(const f32x4*)(mv + scoff + 4 * C.lane + 256 * j);
            v[j] = (v[j] * rs * gv[j]) * (scl + 1.0f) + sh;
            v2u o; o.x = pk2(v[j].x, v[j].y); o.y = pk2(v[j].z, v[j].w);
            *(v2u*)(hb + (size_t)m * 1024 + 4 * C.lane + 256 * j) = o; }
        if (ROUTE) {
            const float* rt = C.in[I_MROUTER] + (size_t)moe_li * 1024 * NE;
            float lg[8];
#pragma unroll
            for (int e = 0; e < 8; ++e) lg[e] = 0.f;
#pragma unroll
            for (int j = 0; j < 4; ++j)
#pragma unroll
                for (int q = 0; q < 4; ++q) { const int k = 4 * C.lane + 256 * j + q; const f32x4 r0 = *(const f32x4*)(rt + (size_t)k * 8), r1 = *(const f32x4*)(rt + (size_t)k * 8 + 4); const float hv = v[j][q];
                    lg[0] += hv * r0.x; lg[1] += hv * r0.y; lg[2] += hv * r0.z; lg[3] += hv * r0.w; lg[4] += hv * r1.x; lg[5] += hv * r1.y; lg[6] += hv * r1.z; lg[7] += hv * r1.w; }
#pragma unroll
            for (int e = 0; e < 8; ++e) lg[e] = wave_sum(lg[e]);
            int e0 = 0; float l0 = lg[0];
#pragma unroll
            for (int e = 1; e < 8; ++e) if (lg[e] > l0) { l0 = lg[e]; e0 = e; }
            int e1 = (e0 == 0) ? 1 : 0; float l1 = -3.0e38f;
#pragma unroll
            for (int e = 0; e < 8; ++e) if (e != e0 && lg[e] > l1) { l1 = lg[e]; e1 = e; }
            const float w0 = __builtin_amdgcn_rcpf(1.0f + __expf(l1 - l0)), w1 = 1.0f - w0;
            if (C.lane == 0) {
                const unsigned r0 = atomicAdd((unsigned*)&lcnt[e0], 1u), r1 = atomicAdd((unsigned*)&lcnt[e1], 1u);
                v4u a; a.x = (unsigned)e0; a.y = (unsigned)e1; a.z = r0; a.w = r1;
                *(v4u*)(route + (size_t)m * 8) = a;
                v2u b; b.x = __builtin_bit_cast(unsigned, w0); b.y = __builtin_bit_cast(unsigned, w1);
                *(v2u*)(route + (size_t)m * 8 + 4) = b;
            }
        }
    }
    if (ROUTE) {
        __syncthreads();
        if (C.tid < 8) { unsigned* gc = WSP(unsigned, WS_CTL) + CW_MOECNT + 64 * moe_li; const unsigned base = atomicAdd(gc + C.tid, lcnt[C.tid]); WSP(unsigned, WS_WGBASE)[C.wg * 8 + C.tid] = base; }
    }
}
__device__ __forceinline__ void lru_carry(const Ctx& C, int idx) {
    const int ch = idx & 255, d = (idx >> 8) & 1, b = idx >> 9;
    const float* ls = WSP(const float, WS_LSUM); float* hin = WSP(float, WS_HIN);
    float H = 0.f;
    for (int k = 0; k < NCH; ++k) {
        const int c = d ? (k < 4 ? 3 - k : NCH + 3 - k) : k;
        const size_t sidx = ((size_t)(b * NCH + c) * 2 + d) * 256 + ch;
        hin[sidx] = H;
        H = __expf(ls[sidx * 2]) * H + ls[sidx * 2 + 1];
    }
}

#define RAW_BARRIER() do { asm volatile("s_waitcnt lgkmcnt(0)" ::: "memory"); __builtin_amdgcn_s_barrier(); asm volatile("" ::: "memory"); } while (0)
__device__ __forceinline__ void gdn_prep(const Ctx& C, int l, int b, int c) {
    const bf16* P = WSP(const bf16, WS_P); bf16* gq = WSP(bf16, WS_GQ);
    const bool isctx = c < 4; const int p0 = isctx ? c * 64 : (c - 4) * 64; const int Lp = isctx ? CTXL : SEQ;
    const int ch = 4 * C.lane;
    auto rowof = [&](int p) -> int { return isctx ? (T_LAT + b * CTXL + p) : (b * SEQ + (p & 63) * 64 + (p >> 6)); };
    f32x4 cw[4][3], x[4][3];
#pragma unroll
    for (int j = 0; j < 4; ++j)
#pragma unroll
        for (int g = 0; g < 3; ++g) cw[j][g] = *(const f32x4*)(C.in[I_GCW] + ((size_t)l * 4 + j) * 768 + g * 256 + ch);
    const int tb = p0 + C.wave * 8;
    auto ldrow = [&](int p, f32x4 (&dst)[3]) {
        if (p >= 0 && p < Lp) { const bf16* pr = P + (size_t)rowof(p) * PLD + OFF_D + ch;
#pragma unroll
            for (int g = 0; g < 3; ++g) dst[g] = ld4bf(pr + g * 256); }
        else {
#pragma unroll
            for (int g = 0; g < 3; ++g) dst[g] = (f32x4){0.f, 0.f, 0.f, 0.f}; }
    };
    ldrow(tb - 2, x[0]); ldrow(tb - 1, x[1]); ldrow(tb, x[2]);
#pragma unroll
    for (int t = 0; t < 8; ++t) {
        ldrow(tb + t + 1, x[3]);
        bf16* orow = gq + (size_t)rowof(tb + t) * 768 + ch;
#pragma unroll
        for (int g = 0; g < 3; ++g) {
            f32x4 v = cw[0][g] * x[0][g] + cw[1][g] * x[1][g] + cw[2][g] * x[2][g] + cw[3][g] * x[3][g];
            v = (f32x4){siluf_(v.x), siluf_(v.y), siluf_(v.z), siluf_(v.w)};
            if (g < 2) { const float ss = row16_sum((v.x * v.x + v.y * v.y) + (v.z * v.z + v.w * v.w)); v = v * (rsqrtf_(ss + 1e-6f) * (g == 0 ? 0.125f : 1.0f)); }
            st4bf(orow + g * 256, v);
        }
#pragma unroll
        for (int g = 0; g < 3; ++g) { x[0][g] = x[1][g]; x[1][g] = x[2][g]; x[2][g] = x[3][g]; }
    }
}
__device__ __forceinline__ void finish_rows(const Ctx& C, int l, int nrows) {
    const bf16* P = WSP(const bf16, WS_P); bf16* yc = WSP(bf16, WS_HB);
    const bf16* ob = WSP(const bf16, WS_OUTB); const bf16* oc = WSP(const bf16, WS_OUTC); const bf16* od = WSP(const bf16, WS_OUTD);
    const bf16* gg = WSP(const bf16, WS_G); const float* bonus = WSP(const float, WS_BONUS);
    const float* mu = C.in[I_RMU] + (size_t)l * 2 * B_COLS;
    const int gw = C.wg * NWAVES + C.wave, NGW = C.G * NWAVES, lane = C.lane, ch = 4 * lane, hh = lane >> 4;
    const f32x4 lng = *(const f32x4*)(C.in[I_RLNG] + l * GW + ch), lnb = *(const f32x4*)(C.in[I_RLNB] + l * GW + ch);
    const f32x4 mng = *(const f32x4*)(C.in[I_MNG] + l * GW + ch), gng = *(const f32x4*)(C.in[I_GNG] + l * GW + ch);
    const f32x4 mu0 = *(const f32x4*)(mu + 512 + ch), mu1 = *(const f32x4*)(mu + B_COLS + 512 + ch);
    const size_t o2 = (size_t)T_ALL * 256;
#pragma unroll 2
    for (int m = gw; m < nrows; m += NGW) {
        const bool isctx = m >= T_LAT; const int Lp = isctx ? CTXL : SEQ; const int p = isctx ? ((m - T_LAT) & (CTXL - 1)) : (m & (SEQ - 1));
        const f32x4 yb = ld4bf(ob + (size_t)m * 256 + ch) + ld4bf(ob + o2 + (size_t)m * 256 + ch);
        const f32x4 ycv = ld4bf(oc + (size_t)m * 256 + ch) + ld4bf(oc + o2 + (size_t)m * 256 + ch);
        const f32x4 yd = ld4bf(od + (size_t)m * 256 + ch) + ld4bf(od + o2 + (size_t)m * 256 + ch);
        const bf16* pr = P + (size_t)m * PLD;
        const f32x4 vs = ld4bf(WSP(const bf16, WS_RKV) + (size_t)m * 768 + 512 + ch);
        const f32x4 og = ld4bf(pr + OFF_C + 768 + ch), gd = ld4bf(pr + OFF_D + 768 + ch), gr = ld4bf(gg + (size_t)m * 256 + ch);
        const float bn = bonus[(size_t)m * 4 + hh];
        *(v2u*)(yc + (size_t)m * 1024 + ch) = *(const v2u*)(pr + 256 + ch);
        {
            const float mean = row16_sum((yb.x + yb.y) + (yb.z + yb.w)) * (1.0f / 64.0f);
            const f32x4 dl = yb - mean;
            const float var = row16_sum((dl.x * dl.x + dl.y * dl.y) + (dl.z * dl.z + dl.w * dl.w)) * (1.0f / 64.0f);
            const f32x4 yn = dl * rsqrtf_(var + 64e-5f) * lng + lnb;
            st4bf(yc + (size_t)m * 1024 + 256 + ch, (yn + vs * bn) * gr);
        }
        {
            const float ms = row16_sum((ycv.x * ycv.x + ycv.y * ycv.y) + (ycv.z * ycv.z + ycv.w * ycv.w)) * (1.0f / 64.0f);
            const f32x4 sg = (f32x4){sigmoidf_(og.x), sigmoidf_(og.y), sigmoidf_(og.z), sigmoidf_(og.w)};
            st4bf(yc + (size_t)m * 1024 + 512 + ch, ycv * rsqrtf_(ms + 1e-6f) * mng * sg);
        }
        {
            const float ms = row16_sum((yd.x * yd.x + yd.y * yd.y) + (yd.z * yd.z + yd.w * yd.w)) * (1.0f / 64.0f);
            const f32x4 sg = (f32x4){siluf_(gd.x), siluf_(gd.y), siluf_(gd.z), siluf_(gd.w)};
            st4bf(yc + (size_t)m * 1024 + 768 + ch, yd * rsqrtf_(ms + 1e-6f) * gng * sg);
        }
    }
}
typedef bf16x8 fragb;
__device__ __forceinline__ f32x4 mfma16(fragb a, fragb b, f32x4 c) { return __builtin_amdgcn_mfma_f32_16x16x32_bf16(a, b, c, 0, 0, 0); }
__device__ __forceinline__ fragb ld_frag16(const LAS bf16* p) { return *(const LAS fragb*)p; }
__device__ __forceinline__ fragb ld_frag8x2(const LAS bf16* p0, const LAS bf16* p1) {
    const v2u a = *(const LAS v2u*)p0, b = *(const LAS v2u*)p1; v4u r; r.x = a.x; r.y = a.y; r.z = b.x; r.w = b.y; return __builtin_bit_cast(fragb, r); }
__device__ __forceinline__ fragb pack_frag(const f32x4& lo, const f32x4& hi) { v4u r; r.x = pk2(lo.x, lo.y); r.y = pk2(lo.z, lo.w); r.z = pk2(hi.x, hi.y); r.w = pk2(hi.z, hi.w); return __builtin_bit_cast(fragb, r); }
__device__ __forceinline__ float wave_incl_sum(float v, int lane) {
    v += dpp_x<0x111, 0xF, true>(0.f, v); v += dpp_x<0x112, 0xF, true>(0.f, v); v += dpp_x<0x114, 0xF, true>(0.f, v); v += dpp_x<0x118, 0xF, true>(0.f, v);
    v += dpp_x<0x142, 0xA, false>(0.f, v); v += dpp_x<0x143, 0xC, false>(0.f, v);
    return v;
}
__device__ __forceinline__ float wave_incl_max(float v, int lane) {
    const float ninf = -3.0e38f;
    v = fmaxf(v, dpp_x<0x111, 0xF, false>(ninf, v)); v = fmaxf(v, dpp_x<0x112, 0xF, false>(ninf, v)); v = fmaxf(v, dpp_x<0x114, 0xF, false>(ninf, v)); v = fmaxf(v, dpp_x<0x118, 0xF, false>(ninf, v));
    v = fmaxf(v, dpp_x<0x142, 0xA, false>(ninf, v)); v = fmaxf(v, dpp_x<0x143, 0xC, false>(ninf, v));
    return v;
}
constexpr int MP = 72;
__device__ __forceinline__ void mlstm_chunked(const Ctx& C, int l, int idx) {
    const int d = idx >> 5, b = (idx >> 2) & 7, h = idx & 3, lane = C.lane, w = C.wave, l15 = lane & 15, q = lane >> 4;
    const int it = w & 3, vtp = w >> 2;
    constexpr int IMG = 64 * MP * 2, BUFB = 4 * IMG + 1024, CTB = 65 * MP * 2 + 16;
    LAS unsigned char* L0 = C.lds;
    const bf16* P = WSP(const bf16, WS_P); bf16* outc = WSP(bf16, WS_OUTC) + (size_t)d * T_ALL * 256;
    const float ib = C.in[I_MIB][(l * 2 + d) * NH + h], fb = C.in[I_MFB][(l * 2 + d) * NH + h];
    const int tt = C.tid >> 3, part = C.tid & 7;
    for (int i = C.tid; i < 2 * CTB / 4; i += NTHR) ((LAS unsigned*)(L0 + 2 * BUFB))[i] = 0u;
    v4u rq, rk, rv; unsigned short rgi, rgf;
    auto gload = [&](int n) {
        const int row = seqrow_cm(n * 64 + tt, d, b);
        const bf16* pp = P + (size_t)row * PLD + OFF_C + h * 64 + 8 * part;
        rq = *(const v4u*)pp; rk = *(const v4u*)(pp + 256); rv = *(const v4u*)(pp + 512);
        const bf16* pg = P + (size_t)seqrow_cm(n * 64 + lane, d, b) * PLD + OFF_C + 1024 + d * 4 + h;
        rgi = pg[0]; rgf = pg[8];
    };
    auto images = [&](int bufi) {
        LAS unsigned char* B0 = L0 + bufi * BUFB;
        LAS bf16* Qs = (LAS bf16*)B0; LAS bf16* Ks = Qs + 64 * MP; LAS bf16* VT = Ks + 64 * MP; LAS bf16* KTw = VT + 64 * MP; LAS float* vec = (LAS float*)(B0 + 4 * IMG);
        const float li = bf2f(rgi) + ib, lf = -softplusf_(-(bf2f(rgf) + fb));
        const float bc = wave_incl_sum(lf, lane), x = li - bc, cm = wave_incl_max(x, lane);
        const float wl = __expf(x - __shfl(cm, 63)) * 0.125f;
        if (w == 0) { vec[lane] = x; vec[64 + lane] = cm; vec[128 + lane] = bc; }
        const float wmine = __shfl(wl, 8 * w + (lane >> 3));
        *(LAS v4u*)(Qs + tt * MP + 8 * part) = rq; *(LAS v4u*)(Ks + tt * MP + 8 * part) = rk;
        const unsigned vv[4] = {rv.x, rv.y, rv.z, rv.w}, kk[4] = {rk.x, rk.y, rk.z, rk.w};
#pragma unroll
        for (int e = 0; e < 4; ++e) {
            VT[(8 * part + 2 * e) * MP + tt] = (bf16)(vv[e] & 0xffffu); VT[(8 * part + 2 * e + 1) * MP + tt] = (bf16)(vv[e] >> 16);
            KTw[(8 * part + 2 * e) * MP + tt] = (bf16)f2bf1(bflo(kk[e]) * wmine); KTw[(8 * part + 2 * e + 1) * MP + tt] = (bf16)f2bf1(bfhi(kk[e]) * wmine);
        }
    };
    f32x4 Cst[2], nst; float m = 0.f;
    Cst[0] = Cst[1] = nst = (f32x4){0.f, 0.f, 0.f, 0.f};
    const fragb ones = __builtin_bit_cast(fragb, (v4u){0x3F803F80u, 0x3F803F80u, 0x3F803F80u, 0x3F803F80u});
    const f32x4 z4 = (f32x4){0.f, 0.f, 0.f, 0.f};
    gload(0); images(0); gload(1);
#pragma unroll 1
    for (int n = 0; n < NCH; ++n) {
        RAW_BARRIER();
        const LAS unsigned char* B0 = L0 + (n & 1) * BUFB;
        const LAS bf16* Qs = (const LAS bf16*)B0; const LAS bf16* Ks = Qs + 64 * MP; const LAS bf16* VT = Ks + 64 * MP; const LAS bf16* KTw = VT + 64 * MP; const LAS float* vec = (const LAS float*)(B0 + 4 * IMG);
        const LAS bf16* CT = (const LAS bf16*)(L0 + 2 * BUFB + (n & 1) * CTB); LAS bf16* CTn = (LAS bf16*)(L0 + 2 * BUFB + ((n + 1) & 1) * CTB);
        fragb Qf[2]; Qf[0] = ld_frag16(Qs + (16 * it + l15) * MP + 8 * q); Qf[1] = ld_frag16(Qs + (16 * it + l15) * MP + 32 + 8 * q);
        const float cmi = vec[64 + 16 * it + l15]; const int icol = 16 * it + l15;
        f32x4 pt[4];
#pragma unroll
        for (int jt = 0; jt < 4; ++jt) {
            pt[jt] = z4;
            if (jt <= it) {
                const fragb k0 = ld_frag16(Ks + (16 * jt + l15) * MP + 8 * q), k1 = ld_frag16(Ks + (16 * jt + l15) * MP + 32 + 8 * q);
                f32x4 st = mfma16(k0, Qf[0], z4); st = mfma16(k1, Qf[1], st);
                const f32x4 xj = *(const LAS f32x4*)(vec + 16 * jt + 4 * q);
#pragma unroll
                for (int r = 0; r < 4; ++r) { const int j = 16 * jt + 4 * q + r; pt[jt][r] = (j <= icol) ? st[r] * __expf(xj[r] - cmi) * 0.125f : 0.f; }
            }
        }
        fragb Pf[2]; Pf[0] = pack_frag(pt[0], pt[1]); Pf[1] = pack_frag(pt[2], pt[3]);
        fragb Vf[2][2];
#pragma unroll
        for (int v2 = 0; v2 < 2; ++v2)
#pragma unroll
            for (int s = 0; s < 2; ++s) { const LAS bf16* vr = VT + (16 * (2 * vtp + v2) + l15) * MP + 32 * s + 4 * q; Vf[v2][s] = ld_frag8x2(vr, vr + 16); }
        f32x4 Aacc[2], R[2], as, dn;
        as = mfma16(Pf[0], ones, z4); if (it >= 2) as = mfma16(Pf[1], ones, as);
        const fragb nf0 = ld_frag16(CT + 64 * MP + 8 * q), nf1 = ld_frag16(CT + 64 * MP + 32 + 8 * q);
        dn = mfma16(Qf[0], nf0, z4); dn = mfma16(Qf[1], nf1, dn);
#pragma unroll
        for (int v2 = 0; v2 < 2; ++v2) {
            Aacc[v2] = mfma16(Pf[0], Vf[v2][0], z4); if (it >= 2) Aacc[v2] = mfma16(Pf[1], Vf[v2][1], Aacc[v2]);
            const LAS bf16* cr = CT + (16 * (2 * vtp + v2) + l15) * MP + 8 * q;
            R[v2] = mfma16(Qf[0], ld_frag16(cr), z4); R[v2] = mfma16(Qf[1], ld_frag16(cr + 32), R[v2]);
        }
        {
            const f32x4 bi = *(const LAS f32x4*)(vec + 128 + 16 * it + 4 * q), cmr = *(const LAS f32x4*)(vec + 64 + 16 * it + 4 * q);
#pragma unroll
            for (int r = 0; r < 4; ++r) {
                const float mi = bi[r] + cmr[r], minter = bi[r] + m, mt = fmaxf(minter, mi), e1 = __expf(mi - mt), e2 = __expf(minter - mt);
                const float den = e1 * as[r] + e2 * dn[r]; const float inv = __builtin_amdgcn_rcpf(fmaxf(fabsf(den), __expf(-mt)));
                const int row = seqrow_cm(n * 64 + 16 * it + 4 * q + r, d, b);
#pragma unroll
                for (int v2 = 0; v2 < 2; ++v2) outc[(size_t)row * 256 + h * 64 + 16 * (2 * vtp + v2) + l15] = (bf16)f2bf1((e1 * Aacc[v2][r] + e2 * R[v2][r]) * inv);
            }
        }
        {
            const LAS bf16* kr = KTw + (16 * it + l15) * MP + 4 * q;
            const fragb kt0 = ld_frag8x2(kr, kr + 16), kt1 = ld_frag8x2(kr + 32, kr + 48);
            const float bL = vec[128 + 63], mloc = bL + vec[64 + 63];
            const float mnew = fmaxf(bL + m, mloc), wp = __expf(bL + m - mnew), wn = __expf(mloc - mnew);
            f32x4 gk = mfma16(kt0, ones, z4); gk = mfma16(kt1, ones, gk);
            nst = nst * wp + gk * wn;
#pragma unroll
            for (int v2 = 0; v2 < 2; ++v2) {
                f32x4 G = mfma16(kt0, Vf[v2][0], z4); G = mfma16(kt1, Vf[v2][1], G);
                Cst[v2] = Cst[v2] * wp + G * wn;
                v2u o; o.x = pk2(Cst[v2].x, Cst[v2].y); o.y = pk2(Cst[v2].z, Cst[v2].w);
                *(LAS v2u*)(CTn + (16 * (2 * vtp + v2) + l15) * MP + 16 * it + 4 * q) = o;
            }
            if (vtp == 0 && l15 == 0) { v2u o; o.x = pk2(nst.x, nst.y); o.y = pk2(nst.z, nst.w); *(LAS v2u*)(CTn + 64 * MP + 16 * it + 4 * q) = o; }
            m = mnew;
        }
        if (n + 1 < NCH) { images((n + 1) & 1); if (n + 2 < NCH) gload(n + 2); }
    }
    __syncthreads();
}
__device__ __forceinline__ int fwd_row_cm(int b, int c, int t) { return c < 4 ? (T_LAT + b * CTXL + c * 64 + t) : (b * SEQ + t * 64 + (c - 4)); }
__device__ __forceinline__ bf16* blob_row(const Ctx& C, int d, int isw, int b, int c, int h, int r) {
    const int row = fwd_row_cm(b, c, r);
    if (d == 1 && isw) return WSP(bf16, WS_OUTD) + ((size_t)T_ALL + row) * 256 + h * 64;
    return WSP(bf16, WS_P) + (size_t)row * PLD + OFF_D + (d * 2 + isw) * 256 + h * 64;
}
constexpr int LP = 68;
__device__ __forceinline__ void blocked_solve(const LAS bf16* Ln, const LAS bf16* TinvP, LAS unsigned char* XTw, f32x4 (&acc)[4][4], int l15, int q) {
    const f32x4 z4 = (f32x4){0.f, 0.f, 0.f, 0.f};
#pragma unroll
    for (int I = 0; I < 4; ++I) {
        const fragb Af = *(const LAS fragb*)(TinvP + (I * 16 + l15) * 32 + 8 * q);
        fragb A0, A1;
        if (I >= 1) A0 = ld_frag16(Ln + (16 * I + l15) * MP + 8 * q);
        if (I == 3) A1 = ld_frag16(Ln + (16 * I + l15) * MP + 32 + 8 * q);
#pragma unroll
        for (int nt = 0; nt < 4; ++nt) {
            const int crow = 16 * nt + l15; LAS unsigned char* xr = XTw + crow * 128;
            f32x4 a = acc[I][nt];
            if (I >= 1) a = mfma16(A0, *(const LAS fragb*)(xr + ((q ^ (crow & 7)) << 4)), a);
            if (I == 3) a = mfma16(A1, *(const LAS fragb*)(xr + (((4 + q) ^ (crow & 7)) << 4)), a);
            v4u bw; bw.x = pk2(a.x, a.y); bw.y = pk2(a.z, a.w); bw.z = 0u; bw.w = 0u;
            const f32x4 x = mfma16(Af, __builtin_bit_cast(fragb, bw), z4);
            acc[I][nt] = x;
            v2u o; o.x = pk2(x.x, x.y); o.y = pk2(x.z, x.w);
            *(LAS v2u*)(xr + (((2 * I + (q >> 1)) ^ (crow & 7)) << 4) + (q & 1) * 8) = o;
        }
    }
}
__device__ __forceinline__ void diag_inverses(const LAS bf16* Ln, LAS bf16* TinvP, int lane) {
    const int blk = lane >> 4, c = lane & 15;
    float x[16];
#pragma unroll
    for (int i = 0; i < 16; ++i) {
        const LAS bf16* lr = Ln + (16 * blk + i) * MP + 16 * blk;
        const v4u r0 = *(const LAS v4u*)lr, r1 = *(const LAS v4u*)(lr + 8);
        const unsigned rw[8] = {r0.x, r0.y, r0.z, r0.w, r1.x, r1.y, r1.z, r1.w};
        float s = (i == c) ? 1.0f : 0.0f;
#pragma unroll
        for (int j = 0; j < i; ++j) s += ((j & 1) ? bfhi(rw[j >> 1]) : bflo(rw[j >> 1])) * x[j];
        x[i] = s;
        TinvP[(blk * 16 + i) * 32 + 8 * (c >> 2) + (c & 3)] = (bf16)f2bf1(s);
    }
}
__device__ __forceinline__ void gdn_solve_item(const Ctx& C, int l, int item) {
    const int lane = C.lane, w = C.wave, pw = w & 1, pi = w >> 1, l15 = lane & 15, q = lane >> 4;
    LAS unsigned char* B0 = C.lds + pi * 31744;
    LAS bf16* Ln = (LAS bf16*)B0;
    LAS bf16* TinvP = (LAS bf16*)(B0 + 9216);
    LAS float* vec = (LAS float*)(B0 + 13312);
    LAS unsigned char* XT = B0 + 13824;
    LAS bf16* Ks = (LAS bf16*)XT;
    const bf16* P = WSP(const bf16, WS_P); const bf16* gq = WSP(const bf16, WS_GQ);
    const int u = item >> 1, d = item & 1;
    const int c = u % NCH, h = (u / NCH) & 3, b = u / (NCH * NH);
    const int n = d ? (c < 4 ? 3 - c : 71 - c) : c;
    const float aexp = __expf(C.in[I_GALOG][(l * 2 + d) * NH + h]), dtb = C.in[I_GDTB][(l * 2 + d) * NH + h];
    const int rowl = seqrow_cm(n * 64 + lane, d, b);
    const bf16* pg = P + (size_t)rowl * PLD + OFF_D + 1024 + d * 4 + h;
    const float la = -aexp * softplusf_(bf2f(pg[0]) + dtb), beta = sigmoidf_(bf2f(pg[8]));
    const float gam = wave_incl_sum(la, lane);
    if (pw == 0) { vec[lane] = beta; vec[64 + lane] = gam; }
#pragma unroll
    for (int r = 0; r < 4; ++r) { const int idx = pw * 64 + lane + 128 * r, t = idx >> 3, part = idx & 7;
        *(LAS v4u*)(Ks + t * MP + 8 * part) = *(const v4u*)(gq + (size_t)seqrow_cm(n * 64 + t, d, b) * 768 + 256 + h * 64 + 8 * part); }
    { LAS v4u* tz = (LAS v4u*)(B0 + 9216) + (pw * 64 + lane) * 2; tz[0] = (v4u){0u, 0u, 0u, 0u}; tz[1] = (v4u){0u, 0u, 0u, 0u}; }
    f32x4 acc[4][4];
    if (pw == 0) {
#pragma unroll
        for (int I = 0; I < 4; ++I)
#pragma unroll
            for (int r = 0; r < 4; ++r) { const bf16* vr = gq + (size_t)seqrow_cm(n * 64 + 16 * I + 4 * q + r, d, b) * 768 + 512 + h * 64 + l15;
#pragma unroll
                for (int nt = 0; nt < 4; ++nt) acc[I][nt][r] = bf2f(vr[16 * nt]); }
    }
    __syncthreads();
    {
        int tix = 0;
#pragma unroll
        for (int it = 0; it < 4; ++it)
#pragma unroll
            for (int jt = 0; jt < 4; ++jt, ++tix) if ((tix & 1) == pw) {
                f32x4 t4 = (f32x4){0.f, 0.f, 0.f, 0.f};
                if (jt <= it) {
#pragma unroll
                    for (int s = 0; s < 2; ++s) t4 = mfma16(ld_frag16(Ks + (16 * it + l15) * MP + 32 * s + 8 * q), ld_frag16(Ks + (16 * jt + l15) * MP + 32 * s + 8 * q), t4);
                    const float gj = vec[64 + 16 * jt + l15];
                    const f32x4 bi = *(const LAS f32x4*)(vec + 16 * it + 4 * q), gi = *(const LAS f32x4*)(vec + 64 + 16 * it + 4 * q);
#pragma unroll
                    for (int r = 0; r < 4; ++r) { const int i = 16 * it + 4 * q + r, j = 16 * jt + l15; t4[r] = (j < i) ? -(bi[r] * t4[r] * __expf(gi[r] - gj)) : 0.f; }
                }
#pragma unroll
                for (int r = 0; r < 4; ++r) Ln[(16 * it + 4 * q + r) * MP + 16 * jt + l15] = (bf16)f2bf1(t4[r]);
            }
    }
    {
#pragma unroll
        for (int I = 0; I < 4; ++I) {
            const f32x4 bi = *(const LAS f32x4*)(vec + 16 * I + 4 * q), gi = *(const LAS f32x4*)(vec + 64 + 16 * I + 4 * q);
#pragma unroll
            for (int r = 0; r < 4; ++r) { const float sc = pw ? bi[r] * __expf(gi[r]) : bi[r];
#pragma unroll
                for (int nt = 0; nt < 4; ++nt) acc[I][nt][r] = (pw ? bf2f(Ks[(16 * I + 4 * q + r) * MP + 16 * nt + l15]) : acc[I][nt][r]) * sc; }
        }
    }
    __syncthreads();
    if (pw == 0) diag_inverses(Ln, TinvP, lane);
    LAS unsigned char* XTw = XT + pw * 8192;
    { LAS v4u* xz = (LAS v4u*)(XTw + lane * 128);
#pragma unroll
        for (int g = 0; g < 8; ++g) xz[g] = (v4u){0u, 0u, 0u, 0u}; }
    __syncthreads();
    blocked_solve(Ln, TinvP, XTw, acc, l15, q);
    {
        bf16* dst = blob_row(C, d, pw, b, c, h, lane);
        const LAS unsigned char* xr = XTw + lane * 128;
#pragma unroll
        for (int g = 0; g < 8; ++g) *(v4u*)(dst + 8 * g) = *(const LAS v4u*)(xr + ((g ^ (lane & 7)) << 4));
    }
    __syncthreads();
}

template <bool DRY>
__device__ __forceinline__ void gdn_chunked(const Ctx& C, int l, int idx) {
    const int d = idx >> 5, b = (idx >> 2) & 7, h = idx & 3, lane = C.lane, w = C.wave, l15 = lane & 15, q = lane >> 4;
    const int it = w & 3, vtp = w >> 2;
    constexpr int IMG = 64 * MP * 2, BUFB = 5 * IMG + 512;
    LAS unsigned char* L0 = C.lds;
    LAS bf16* VnT = (LAS bf16*)(L0 + 2 * BUFB + 2 * IMG);
    const bf16* P = WSP(const bf16, WS_P); const bf16* gq = WSP(const bf16, WS_GQ); bf16* outd = WSP(bf16, WS_OUTD) + (size_t)d * T_ALL * 256;
    const float aexp = __expf(C.in[I_GALOG][(l * 2 + d) * NH + h]), dtb = C.in[I_GDTB][(l * 2 + d) * NH + h];
    const int tt = C.tid >> 3, part = C.tid & 7;
    for (int i = C.tid; i < 2 * IMG / 4; i += NTHR) ((LAS unsigned*)(L0 + 2 * BUFB))[i] = 0u;
    v4u rq, rk, ru, rw; unsigned short rga;
    auto gload = [&](int n) {
        const int c = d ? (n < 4 ? 3 - n : 71 - n) : n;
        const bf16* pp = gq + (size_t)seqrow_cm(n * 64 + tt, d, b) * 768 + h * 64 + 8 * part;
        rq = *(const v4u*)pp; rk = *(const v4u*)(pp + 256);
        ru = *(const v4u*)(blob_row(C, d, 0, b, c, h, tt) + 8 * part); rw = *(const v4u*)(blob_row(C, d, 1, b, c, h, tt) + 8 * part);
        rga = P[(size_t)seqrow_cm(n * 64 + lane, d, b) * PLD + OFF_D + 1024 + d * 4 + h];
    };
    auto images = [&](int bufi) {
        LAS unsigned char* B0 = L0 + bufi * BUFB;
        LAS bf16* Qs = (LAS bf16*)B0; LAS bf16* Ks = Qs + 64 * MP; LAS bf16* KdT = Ks + 64 * MP; LAS bf16* Wi = KdT + 64 * MP; LAS bf16* UT = Wi + 64 * MP; LAS float* vec = (LAS float*)(B0 + 5 * IMG);
        const float la = -aexp * softplusf_(bf2f(rga) + dtb);
        const float gam = wave_incl_sum(la, lane);
        if (w == 0) vec[lane] = gam;
        const float kd = __expf(__shfl(gam, 63) - gam);
        const float kmine = __shfl(kd, 8 * w + (lane >> 3));
        *(LAS v4u*)(Qs + tt * MP + 8 * part) = rq; *(LAS v4u*)(Ks + tt * MP + 8 * part) = rk; *(LAS v4u*)(UT + tt * MP + 8 * part) = ru;
        const unsigned kk[4] = {rk.x, rk.y, rk.z, rk.w}, ww[4] = {rw.x, rw.y, rw.z, rw.w};
#pragma unroll
        for (int e = 0; e < 4; ++e) {
            KdT[(8 * part + 2 * e) * MP + tt] = (bf16)f2bf1(bflo(kk[e]) * kmine); KdT[(8 * part + 2 * e + 1) * MP + tt] = (bf16)f2bf1(bfhi(kk[e]) * kmine);
            Wi[(8 * part + 2 * e) * MP + tt] = (bf16)(ww[e] & 0xffffu); Wi[(8 * part + 2 * e + 1) * MP + tt] = (bf16)(ww[e] >> 16);
        }
    };
    f32x4 Sst[2]; Sst[0] = Sst[1] = (f32x4){0.f, 0.f, 0.f, 0.f};
    const f32x4 z4 = (f32x4){0.f, 0.f, 0.f, 0.f};
    gload(0); images(0); gload(1);
#pragma unroll 1
    for (int n = 0; n < NCH; ++n) {
        RAW_BARRIER();
        const LAS unsigned char* B0 = L0 + (n & 1) * BUFB;
        const LAS bf16* Qs = (const LAS bf16*)B0; const LAS bf16* Ks = Qs + 64 * MP; const LAS bf16* KdT = Ks + 64 * MP; const LAS bf16* Wi = KdT + 64 * MP; const LAS bf16* UT = Wi + 64 * MP; const LAS float* vec = (const LAS float*)(B0 + 5 * IMG);
        const LAS bf16* ST = (const LAS bf16*)(L0 + 2 * BUFB + (n & 1) * IMG); LAS bf16* STn = (LAS bf16*)(L0 + 2 * BUFB + ((n + 1) & 1) * IMG);
        fragb Qf[2]; Qf[0] = ld_frag16(Qs + (16 * it + l15) * MP + 8 * q); Qf[1] = ld_frag16(Qs + (16 * it + l15) * MP + 32 + 8 * q);
        const float gcol = vec[16 * it + l15]; const int icol = 16 * it + l15;
        f32x4 pt[4];
#pragma unroll
        for (int jt = 0; jt < 4; ++jt) {
            pt[jt] = z4;
            if (jt <= it) {
                const fragb k0 = ld_frag16(Ks + (16 * jt + l15) * MP + 8 * q), k1 = ld_frag16(Ks + (16 * jt + l15) * MP + 32 + 8 * q);
                f32x4 st = mfma16(k0, Qf[0], z4); st = mfma16(k1, Qf[1], st);
                const f32x4 gj = *(const LAS f32x4*)(vec + 16 * jt + 4 * q);
#pragma unroll
                for (int r = 0; r < 4; ++r) { const int j = 16 * jt + 4 * q + r; pt[jt][r] = (j <= icol) ? st[r] * __expf(gcol - gj[r]) : 0.f; }
            }
        }
        fragb Pf[2]; Pf[0] = pack_frag(pt[0], pt[1]); Pf[1] = pack_frag(pt[2], pt[3]);
        const fragb Wf0 = ld_frag16(Wi + (16 * it + l15) * MP + 8 * q), Wf1 = ld_frag16(Wi + (16 * it + l15) * MP + 32 + 8 * q);
        f32x4 Ro[2];
#pragma unroll
        for (int v2 = 0; v2 < 2; ++v2) {
            const int vrow = 16 * (2 * vtp + v2) + l15;
            const fragb s0 = ld_frag16(ST + vrow * MP + 8 * q), s1 = ld_frag16(ST + vrow * MP + 32 + 8 * q);
            f32x4 ws = mfma16(Wf0, s0, z4); ws = mfma16(Wf1, s1, ws);
            Ro[v2] = mfma16(Qf[0], s0, z4); Ro[v2] = mfma16(Qf[1], s1, Ro[v2]);
            const v2u ur = *(const LAS v2u*)(UT + vrow * MP + 16 * it + 4 * q);
            v2u o; o.x = pk2(bflo(ur.x) - ws.x, bfhi(ur.x) - ws.y); o.y = pk2(bflo(ur.y) - ws.z, bfhi(ur.y) - ws.w);
            *(LAS v2u*)(VnT + vrow * MP + 16 * it + 4 * q) = o;
        }
        RAW_BARRIER();
        {
            const f32x4 gi = *(const LAS f32x4*)(vec + 16 * it + 4 * q);
            const float gl = __expf(vec[63]);
            const LAS bf16* kr = KdT + (16 * it + l15) * MP + 4 * q;
            const fragb kt0 = ld_frag8x2(kr, kr + 16), kt1 = ld_frag8x2(kr + 32, kr + 48);
#pragma unroll
            for (int v2 = 0; v2 < 2; ++v2) {
                const int vrow = 16 * (2 * vtp + v2) + l15;
                const LAS bf16* vr = VnT + vrow * MP + 4 * q;
                const fragb n0 = ld_frag8x2(vr, vr + 16), n1 = ld_frag8x2(vr + 32, vr + 48);
                f32x4 o = mfma16(Pf[0], n0, z4); if (it >= 2) o = mfma16(Pf[1], n1, o);
#pragma unroll
                for (int r = 0; r < 4; ++r) { const int row = seqrow_cm(n * 64 + 16 * it + 4 * q + r, d, b);
                    if (!DRY) outd[(size_t)row * 256 + h * 64 + vrow] = (bf16)f2bf1(o[r] + __expf(gi[r]) * Ro[v2][r]); }
                f32x4 ns = mfma16(kt0, n0, z4); ns = mfma16(kt1, n1, ns);
                Sst[v2] = Sst[v2] * gl + ns;
                v2u so; so.x = pk2(Sst[v2].x, Sst[v2].y); so.y = pk2(Sst[v2].z, Sst[v2].w);
                *(LAS v2u*)(STn + vrow * MP + 16 * it + 4 * q) = so;
            }
        }
        if (n + 1 < NCH) { images((n + 1) & 1); if (n + 2 < NCH) gload(n + 2); }
    }
    __syncthreads();
}
constexpr int UP = 264;
template <int CTRL> __device__ __forceinline__ float dpp_keep(float oldv, float v) { return __builtin_bit_cast(float, __builtin_amdgcn_update_dpp(__builtin_bit_cast(int, oldv), __builtin_bit_cast(int, v), CTRL, 0xF, 0xF, false)); }
template <bool REV> __device__ __forceinline__ void scan16(float& A, float& B) {
#define LRU_STEP(S) { const float Ap = dpp_keep<(REV ? 0x100 : 0x110) | S>(1.0f, A), Bp = dpp_keep<(REV ? 0x100 : 0x110) | S>(0.0f, B); B = A * Bp + B; A = A * Ap; }
    LRU_STEP(1) LRU_STEP(2) LRU_STEP(4) LRU_STEP(8)
#undef LRU_STEP
}
template <bool FIN, bool REV>
__device__ __forceinline__ void lru_wave(const Ctx& C, int l, int b, int c, int hd, LAS bf16* U16, LAS bf16* H16) {
    constexpr int d = REV ? 1 : 0;
    const int lane = C.lane, l15 = lane & 15, q = lane >> 4;
    const bf16* wt = WSP(const bf16, WS_LRUWT) + (size_t)((d * 2 + 0) * 4 + hd) * 4096;
    fragb Wa[4][2], Wx[4][2];
#pragma unroll
    for (int mt = 0; mt < 4; ++mt)
#pragma unroll
        for (int ks = 0; ks < 2; ++ks) { Wa[mt][ks] = *(const fragb*)(wt + (16 * mt + l15) * 64 + 32 * ks + 8 * q); Wx[mt][ks] = *(const fragb*)(wt + 4 * 4096 + (16 * mt + l15) * 64 + 32 * ks + 8 * q); }
    f32x4 sp4[4], hc[4], sla[4];
    const size_t sbase = ((size_t)(b * NCH + c) * 2 + d) * 256 + hd * 64;
#pragma unroll
    for (int mt = 0; mt < 4; ++mt) {
        const int ch = hd * 64 + 16 * mt + 4 * q;
        const f32x4 lam = *(const f32x4*)(C.in[I_LLAM] + (l * 2 + d) * GW + ch);
#pragma unroll
        for (int r = 0; r < 4; ++r) sp4[mt][r] = 8.0f * softplusf_(-lam[r]);
        hc[mt] = FIN ? *(const f32x4*)(WSP(const float, WS_HIN) + sbase + 16 * mt + 4 * q) : (f32x4){0.f, 0.f, 0.f, 0.f};
        sla[mt] = (f32x4){0.f, 0.f, 0.f, 0.f};
    }
    const f32x4 z4 = (f32x4){0.f, 0.f, 0.f, 0.f};
#pragma unroll 1
    for (int nti = 0; nti < 4; ++nti) {
        const int nt = REV ? 3 - nti : nti;
        const LAS bf16* urow = U16 + (16 * nt + l15) * UP + hd * 64;
        const fragb Uf0 = ld_frag16(urow + 8 * q), Uf1 = ld_frag16(urow + 32 + 8 * q);
#pragma unroll
        for (int mt = 0; mt < 4; ++mt) {
            f32x4 aa = mfma16(Wa[mt][0], Uf0, z4); aa = mfma16(Wa[mt][1], Uf1, aa);
            f32x4 ax = mfma16(Wx[mt][0], Uf0, z4); ax = mfma16(Wx[mt][1], Uf1, ax);
            const v2u ur = *(const LAS v2u*)(urow + 16 * mt + 4 * q);
            const float u4[4] = {bflo(ur.x), bfhi(ur.x), bflo(ur.y), bfhi(ur.y)};
            const f32x4 ba = *(const f32x4*)(C.in[I_LBA] + (l * 2 + d) * GW + hd * 64 + 16 * mt + 4 * q), bx = *(const f32x4*)(C.in[I_LBX] + (l * 2 + d) * GW + hd * 64 + 16 * mt + 4 * q);
            f32x4 hv;
#pragma unroll
            for (int r = 0; r < 4; ++r) {
                const float rg = sigmoidf_(aa[r] + ba[r]), ig = sigmoidf_(ax[r] + bx[r]);
                const float la = -sp4[mt][r] * rg; float A = __expf(la); float Bv = __builtin_amdgcn_sqrtf(-expm1f_(2.0f * la)) * (ig * u4[r]);
                sla[mt][r] += la;
                scan16<REV>(A, Bv);
                const float h = A * hc[mt][r] + Bv;
                hv[r] = h;
                hc[mt][r] = __shfl(h, (lane & 48) | (REV ? 0 : 15));
            }
            if (FIN) { v2u o; o.x = pk2(hv.x, hv.y); o.y = pk2(hv.z, hv.w); *(LAS v2u*)(H16 + (size_t)d * 64 * UP + (16 * nt + l15) * UP + hd * 64 + 16 * mt + 4 * q) = o; }
        }
    }
    if (!FIN) {
        float* ls = WSP(float, WS_LSUM);
#pragma unroll
        for (int mt = 0; mt < 4; ++mt)
#pragma unroll
            for (int r = 0; r < 4; ++r) { const float st = row16_sum(sla[mt][r]); if (l15 == 0) { const size_t si = sbase + 16 * mt + 4 * q + r; ls[si * 2] = st; ls[si * 2 + 1] = hc[mt][r]; } }
    }
}
template <bool FIN>
__device__ __forceinline__ void lru_chunk_mfma(const Ctx& C, int l, int b, int c) {
    LAS bf16* U16 = (LAS bf16*)C.lds;
    LAS bf16* H16 = U16 + 64 * UP;
    const bf16* P = WSP(const bf16, WS_P);
    const bool isctx = c < 4; const int p0 = isctx ? c * 64 : (c - 4) * 64; const int Lp = isctx ? CTXL : SEQ; const int row0 = isctx ? T_LAT + b * CTXL : b * SEQ;
    {
        const int ch = C.tid & 255, half = C.tid >> 8;
        const float* cw = C.in[I_LCW] + (size_t)l * 4 * GW + ch; const float w0 = cw[0], w1 = cw[GW], w2 = cw[2 * GW], w3 = cw[3 * GW], cb = C.in[I_LCB][l * GW + ch];
        const int t0 = half * 32;
        float xs[35];
#pragma unroll
        for (int k = 0; k < 35; ++k) { const int p = p0 + t0 + k - 2; xs[k] = (p >= 0 && p < Lp) ? bf2f(P[(size_t)(row0 + p) * PLD + ch]) : 0.f; }
#pragma unroll
        for (int t = 0; t < 32; ++t) U16[(t0 + t) * UP + ch] = (bf16)f2bf1(w0 * xs[t] + w1 * xs[t + 1] + w2 * xs[t + 2] + w3 * xs[t + 3] + cb);
    }
    __syncthreads();
    if (C.wave < 4) lru_wave<FIN, false>(C, l, b, c, C.wave & 3, U16, H16); else lru_wave<FIN, true>(C, l, b, c, C.wave & 3, U16, H16);
    __syncthreads();
    if (FIN) {
        const LAS bf16* H1 = H16 + 64 * UP;
#pragma unroll 2
        for (int it = C.tid; it < 64 * 64; it += NTHR) {
            const int t = it >> 6, c4 = (it & 63) * 4;
            const size_t row = (size_t)(row0 + p0 + t);
            const v2u a = *(const LAS v2u*)(H16 + t * UP + c4), bq = *(const LAS v2u*)(H1 + t * UP + c4);
            const f32x4 g = ld4bf(P + row * PLD + 256 + c4);
            f32x4 y = (f32x4){bflo(a.x) + bflo(bq.x), bfhi(a.x) + bfhi(bq.x), bflo(a.y) + bflo(bq.y), bfhi(a.y) + bfhi(bq.y)};
            y.x *= gelu_tanh(g.x); y.y *= gelu_tanh(g.y); y.z *= gelu_tanh(g.z); y.w *= gelu_tanh(g.w);
            st4bf(WSP(bf16, WS_P) + row * PLD + 256 + c4, y);
        }
        __syncthreads();
    }
}
constexpr int RP = 264;
__device__ __forceinline__ void rwkv_prep2(const Ctx& C, int l, int b, int c) {
    LAS bf16* RS = (LAS bf16*)C.lds;
    LAS bf16* KS = RS + 64 * RP;
    LAS bf16* XW = KS + 64 * RP;
    LAS bf16* XA = XW + 64 * MP;
    LAS bf16* XG = XA + 64 * MP;
    const bf16* P = WSP(const bf16, WS_P);
    const bool isctx = c < 4; const int p0 = isctx ? c * 64 : (c - 4) * 64; const int Lp = isctx ? CTXL : SEQ; const int row0 = isctx ? T_LAT + b * CTXL : b * SEQ;
    const float* mu = C.in[I_RMU] + (size_t)l * 2 * B_COLS;
    bf16* rkv = WSP(bf16, WS_RKV);
#pragma unroll 5
    for (int it = C.tid; it < 64 * 120; it += NTHR) {
        const int t = it / 120, c8 = (it % 120) * 8, p = p0 + t;
        const bf16* pp = P + (size_t)(row0 + p) * PLD + OFF_B + c8;
        const v4u xc = *(const v4u*)pp; v4u xp = (v4u){0u, 0u, 0u, 0u}, xn = xp;
        if (p > 0) xp = *(const v4u*)(pp - PLD);
        if (p < Lp - 1) xn = *(const v4u*)(pp + PLD);
        const f32x4 m0a = *(const f32x4*)(mu + c8), m0b = *(const f32x4*)(mu + c8 + 4), m1a = *(const f32x4*)(mu + B_COLS + c8), m1b = *(const f32x4*)(mu + B_COLS + c8 + 4);
        const unsigned xcw[4] = {xc.x, xc.y, xc.z, xc.w}, xpw[4] = {xp.x, xp.y, xp.z, xp.w}, xnw[4] = {xn.x, xn.y, xn.z, xn.w};
        float sh[8];
#pragma unroll
        for (int e = 0; e < 4; ++e) {
            const float x0 = bflo(xcw[e]), x1 = bfhi(xcw[e]);
            const float mu0_0 = e < 2 ? m0a[2 * e] : m0b[2 * e - 4], mu0_1 = e < 2 ? m0a[2 * e + 1] : m0b[2 * e - 3], mu1_0 = e < 2 ? m1a[2 * e] : m1b[2 * e - 4], mu1_1 = e < 2 ? m1a[2 * e + 1] : m1b[2 * e - 3];
            sh[2 * e] = x0 + mu0_0 * (bflo(xpw[e]) - x0) + mu1_0 * (bflo(xnw[e]) - x0);
            sh[2 * e + 1] = x1 + mu0_1 * (bfhi(xpw[e]) - x1) + mu1_1 * (bfhi(xnw[e]) - x1);
        }
        if (c8 >= 768) {
            const int ci = c8 - 768;
            if (ci < 64) {
#pragma unroll
                for (int e = 0; e < 8; ++e) sh[e] = tanhf_(sh[e]); }
            else if (ci >= 128) {
#pragma unroll
                for (int e = 0; e < 8; ++e) sh[e] = sigmoidf_(sh[e]); }
        }
        v4u o; o.x = pk2(sh[0], sh[1]); o.y = pk2(sh[2], sh[3]); o.z = pk2(sh[4], sh[5]); o.w = pk2(sh[6], sh[7]);
        if (c8 < 768) {
            *(v4u*)(rkv + (size_t)(row0 + p) * 768 + c8) = o;
            if (c8 < 256) *(LAS v4u*)(RS + t * RP + c8) = o; else if (c8 < 512) *(LAS v4u*)(KS + t * RP + c8 - 256) = o;
        } else {
            const int ci = c8 - 768;
            LAS bf16* dst = ci < 64 ? XW + t * MP + ci : (ci < 128 ? XA + t * MP + ci - 64 : XG + t * MP + ci - 128);
            *(LAS v4u*)dst = o;
        }
    }
    __syncthreads();
    const int lane = C.lane, w = C.wave, l15 = lane & 15, q = lane >> 4, hd = w & 3, ntp = w >> 2;
    const bf16* wt = WSP(const bf16, WS_RWT);
    bf16* wa_out = WSP(bf16, WS_HB); bf16* g_out = WSP(bf16, WS_G); float* bonus = WSP(float, WS_BONUS); float* rinv = WSP(float, WS_RINV);
    const f32x4 z4 = (f32x4){0.f, 0.f, 0.f, 0.f};
    fragb xw0[2], xw1[2], xa0[2], xa1[2], xg0[2], xg1[2]; float bsum[2] = {0.f, 0.f}, ksum[2] = {0.f, 0.f};
#pragma unroll
    for (int n2 = 0; n2 < 2; ++n2) { const int tok = 16 * (2 * ntp + n2) + l15;
        xw0[n2] = ld_frag16(XW + tok * MP + 8 * q); xw1[n2] = ld_frag16(XW + tok * MP + 32 + 8 * q);
        xa0[n2] = ld_frag16(XA + tok * MP + 8 * q); xa1[n2] = ld_frag16(XA + tok * MP + 32 + 8 * q);
        xg0[n2] = ld_frag16(XG + tok * MP + 8 * q); xg1[n2] = ld_frag16(XG + tok * MP + 32 + 8 * q); }
#pragma unroll
    for (int mt = 0; mt < 4; ++mt) {
        const int chl = 16 * mt + l15, ch4 = hd * 64 + 16 * mt + 4 * q;
        const bf16* wrow = wt + (size_t)(hd * 64 + chl) * 32 + 8 * q;
        const bf16* grow = wt + 4 * 256 * 32 + (size_t)(hd * 64 + chl) * 64 + 8 * q;
        const fragb fw0 = *(const fragb*)(wrow), fw1 = *(const fragb*)(wrow + 256 * 32), fa0 = *(const fragb*)(wrow + 2 * 256 * 32), fa1 = *(const fragb*)(wrow + 3 * 256 * 32), fg0 = *(const fragb*)(grow), fg1 = *(const fragb*)(grow + 32);
        const f32x4 w00 = *(const f32x4*)(C.in[I_RW0] + (l * 2 + 0) * GW + ch4), w01 = *(const f32x4*)(C.in[I_RW0] + (l * 2 + 1) * GW + ch4);
        const f32x4 a00 = *(const f32x4*)(C.in[I_RA0] + (l * 2 + 0) * GW + ch4), a01 = *(const f32x4*)(C.in[I_RA0] + (l * 2 + 1) * GW + ch4);
        const f32x4 k_a = *(const f32x4*)(C.in[I_RKA] + l * GW + ch4), r_k = *(const f32x4*)(C.in[I_RRK] + l * GW + ch4), k_k = *(const f32x4*)(C.in[I_RKK] + l * GW + ch4);
#pragma unroll
        for (int n2 = 0; n2 < 2; ++n2) {
            const int tok = 16 * (2 * ntp + n2) + l15; const size_t row = (size_t)(row0 + p0 + tok);
            const f32x4 aw0 = mfma16(fw0, xw0[n2], z4), aw1 = mfma16(fw1, xw1[n2], z4), aa0 = mfma16(fa0, xa0[n2], z4), aa1 = mfma16(fa1, xa1[n2], z4);
            f32x4 ag = mfma16(fg0, xg0[n2], z4); ag = mfma16(fg1, xg1[n2], ag);
            f32x4 wv0, wv1, av0, av1;
#pragma unroll
            for (int r = 0; r < 4; ++r) {
                wv0[r] = __expf(-0.6065306597126334f * sigmoidf_(aw0[r] + w00[r])); wv1[r] = __expf(-0.6065306597126334f * sigmoidf_(aw1[r] + w01[r]));
                av0[r] = sigmoidf_(aa0[r] + a00[r]); av1[r] = sigmoidf_(aa1[r] + a01[r]);
            }
            st4bf(wa_out + row * 1024 + 0 * 256 + ch4, wv0); st4bf(wa_out + row * 1024 + 1 * 256 + ch4, wv1);
            st4bf(wa_out + row * 1024 + 2 * 256 + ch4, av0); st4bf(wa_out + row * 1024 + 3 * 256 + ch4, av1);
            st4bf(g_out + row * 256 + ch4, ag);
            const v2u rr_ = *(const LAS v2u*)(RS + tok * RP + ch4), kr_ = *(const LAS v2u*)(KS + tok * RP + ch4);
            const f32x4 rs = (f32x4){bflo(rr_.x), bfhi(rr_.x), bflo(rr_.y), bfhi(rr_.y)}, ks = (f32x4){bflo(kr_.x), bfhi(kr_.x), bflo(kr_.y), bfhi(kr_.y)};
#pragma unroll
            for (int r = 0; r < 4; ++r) {
                const float km = ks[r] * (1.0f + (av0[r] - 1.0f) * k_a[r]) + ks[r] * (1.0f + (av1[r] - 1.0f) * k_a[r]);
                bsum[n2] += rs[r] * r_k[r] * km; const float kk = ks[r] * k_k[r]; ksum[n2] += kk * kk;
            }
        }
    }
#pragma unroll
    for (int n2 = 0; n2 < 2; ++n2) {
        const size_t row = (size_t)(row0 + p0 + 16 * (2 * ntp + n2) + l15);
        float bs = bsum[n2], ks2 = ksum[n2];
        bs += __shfl_xor(bs, 16); bs += __shfl_xor(bs, 32); ks2 += __shfl_xor(ks2, 16); ks2 += __shfl_xor(ks2, 32);
        if (q == 0) { bonus[row * 4 + hd] = bs; rinv[row * 4 + hd] = rsqrtf_(ks2 + 1e-6f); }
    }
    __syncthreads();
}
__device__ __forceinline__ int fwd_row_r(int b, int c, int t) { return c < 4 ? (T_LAT + b * CTXL + c * 64 + t) : (b * SEQ + (c - 4) * 64 + t); }
__device__ __forceinline__ bf16* rw_blob_row(const Ctx& C, int d, int which, int b, int c, int h, int r) {
    const int row = fwd_row_r(b, c, r);
#if RW_VSPLIT
    if (which == 0) { if (d) return WSP(bf16, WS_GQ) + (size_t)row * 768 + 512 + h * 64;
                      return WSP(bf16, WS_P) + (size_t)row * PLD + OFF_B + 512 + h * 64; }
#else
    if (which == 0) return WSP(bf16, WS_OUTB) + ((size_t)d * T_ALL + row) * 256 + h * 64;
#endif
    return WSP(bf16, WS_P) + (size_t)row * PLD + OFF_B + d * 256 + h * 64;
}
__device__ __forceinline__ void rwkv_solve_item(const Ctx& C, int l, int item) {
    const int lane = C.lane, w = C.wave, pw = w & 1, pi = w >> 1, l15 = lane & 15, q = lane >> 4;
    LAS unsigned char* B0 = C.lds + pi * 31744;
    LAS bf16* Kk = (LAS bf16*)B0; LAS bf16* Bh = Kk + 64 * MP; LAS bf16* Kh = Bh + 64 * MP;
    LAS bf16* Ln = (LAS bf16*)B0;
    LAS bf16* Lk16 = (LAS bf16*)(B0 + 9216);
    LAS unsigned char* XT = B0 + 9216;
    LAS bf16* TinvP = (LAS bf16*)(B0 + 25600);
    const bf16* WA = WSP(const bf16, WS_HB); const bf16* rkv = WSP(const bf16, WS_RKV); const float* rinv = WSP(const float, WS_RINV);
    const int u = item >> 1, d = item & 1;
    const int c = u % NCH, h = (u / NCH) & 3, b = u / (NCH * NH);
    const float k_k = C.in[I_RKK][l * GW + h * 64 + lane], k_a = C.in[I_RKA][l * GW + h * 64 + lane];
    const int n = d ? (c < 4 ? 3 - c : 71 - c) : c;
    const float ril = rinv[(size_t)seqrow_raster(n * 64 + lane, d, b) * 4 + h];
#pragma unroll
    for (int r = 0; r < 4; ++r) { const int idx2 = pw * 64 + lane + 128 * r, t = idx2 >> 3, part = idx2 & 7; const int row = seqrow_raster(n * 64 + t, d, b);
        *(LAS v4u*)(Kk + t * MP + 8 * part) = *(const v4u*)(WA + (size_t)row * 1024 + d * 256 + h * 64 + 8 * part);
        *(LAS v4u*)(Bh + t * MP + 8 * part) = *(const v4u*)(WA + (size_t)row * 1024 + (2 + d) * 256 + h * 64 + 8 * part);
        *(LAS v4u*)(Kh + t * MP + 8 * part) = *(const v4u*)(rkv + (size_t)row * 768 + 256 + h * 64 + 8 * part); }
    __syncthreads();
    {
        float cc = 1.0f;
        if (pw) {
#pragma unroll
            for (int t = 0; t < 32; ++t) cc *= bf2f(Kk[t * MP + lane]);
        }
        __syncthreads();
#pragma unroll
        for (int t2 = 0; t2 < 32; ++t2) {
            const int t = pw * 32 + t2;
            const float wv = bf2f(Kk[t * MP + lane]), av = bf2f(Bh[t * MP + lane]), ks = bf2f(Kh[t * MP + lane]);
            const float kap = ks * k_k * __shfl(ril, t);
            const float cprev = cc; cc *= wv; const float ic = __builtin_amdgcn_rcpf(cc);
            Kk[t * MP + lane] = (bf16)f2bf1(kap * cprev); Bh[t * MP + lane] = (bf16)f2bf1(kap * av * ic); Kh[t * MP + lane] = (bf16)f2bf1(ks * (1.0f + (av - 1.0f) * k_a) * ic);
        }
    }
    __syncthreads();
    f32x4 acc[4][4];
    if (pw == 0) {
#pragma unroll
        for (int I = 0; I < 4; ++I)
#pragma unroll
            for (int r = 0; r < 4; ++r)
#pragma unroll
                for (int nt = 0; nt < 4; ++nt) acc[I][nt][r] = bf2f(Kk[(16 * I + 4 * q + r) * MP + 16 * nt + l15]);
    }
    f32x4 T[10];
    {
        const LAS bf16* Bsrc = pw ? Kh : Bh;
        int tix = 0;
#pragma unroll
        for (int it = 0; it < 4; ++it)
#pragma unroll
            for (int jt = 0; jt <= it; ++jt, ++tix) {
                f32x4 t4 = (f32x4){0.f, 0.f, 0.f, 0.f};
#pragma unroll
                for (int s = 0; s < 2; ++s) t4 = mfma16(ld_frag16(Kk + (16 * it + l15) * MP + 32 * s + 8 * q), ld_frag16(Bsrc + (16 * jt + l15) * MP + 32 * s + 8 * q), t4);
#pragma unroll
                for (int r = 0; r < 4; ++r) { const int i = 16 * it + 4 * q + r, j = 16 * jt + l15; T[tix][r] = (j < i) ? (pw ? t4[r] : -t4[r]) : 0.f; }
            }
    }
    __syncthreads();
    {
        int tix = 0;
#pragma unroll
        for (int it = 0; it < 4; ++it)
#pragma unroll
            for (int jt = 0; jt < 4; ++jt) {
                if (jt <= it) {
#pragma unroll
                    for (int r = 0; r < 4; ++r) (pw ? Lk16 : Ln)[(16 * it + 4 * q + r) * MP + 16 * jt + l15] = (bf16)f2bf1(T[tix][r]);
                    ++tix;
                } else if (pw == 0) {
#pragma unroll
                    for (int r = 0; r < 4; ++r) Ln[(16 * it + 4 * q + r) * MP + 16 * jt + l15] = (bf16)0;
                }
            }
        LAS v4u* tz = (LAS v4u*)(B0 + 25600) + (pw * 64 + lane) * 2; tz[0] = (v4u){0u, 0u, 0u, 0u}; tz[1] = (v4u){0u, 0u, 0u, 0u};
    }
    __syncthreads();
    if (pw) {
#pragma unroll
        for (int I = 0; I < 4; ++I)
#pragma unroll
            for (int r = 0; r < 4; ++r)
#pragma unroll
                for (int nt = 0; nt < 4; ++nt) { const int i = 16 * I + 4 * q + r, j = 16 * nt + l15; acc[I][nt][r] = (j < i && nt <= I) ? bf2f(Lk16[i * MP + j]) : 0.f; }
    } else diag_inverses(Ln, TinvP, lane);
    __syncthreads();
    LAS unsigned char* XTw = XT + pw * 8192;
    { LAS v4u* xz = (LAS v4u*)(XTw + lane * 128);
#pragma unroll
        for (int g = 0; g < 8; ++g) xz[g] = (v4u){0u, 0u, 0u, 0u}; }
    blocked_solve(Ln, TinvP, XTw, acc, l15, q);
    {
        bf16* dst = rw_blob_row(C, d, pw, b, c, h, lane);
        const LAS unsigned char* xr = XTw + lane * 128;
#pragma unroll
        for (int g = 0; g < 8; ++g) *(v4u*)(dst + 8 * g) = *(const LAS v4u*)(xr + ((g ^ (lane & 7)) << 4));
    }
    __syncthreads();
}

template <bool DRY>
__device__ __forceinline__ void rwkv_chunked(const Ctx& C, int l, int idx) {
#ifndef RW_VSPLIT
#define RW_VSPLIT 1
#endif
    constexpr int NV = RW_VSPLIT ? 1 : 2;
    const int vhalf = idx & 1, lane = C.lane, w = C.wave, l15 = lane & 15, q = lane >> 4;
    const int d = RW_VSPLIT ? idx >> 6 : idx >> 5, b = RW_VSPLIT ? (idx >> 3) & 7 : (idx >> 2) & 7, h = RW_VSPLIT ? (idx >> 1) & 3 : idx & 3;
    const int it = w & 3, vt0 = RW_VSPLIT ? 2 * vhalf + (w >> 2) : 2 * (w >> 2);
    constexpr int IMG = 64 * MP * 2;
    LAS unsigned char* L0 = C.lds;
    LAS bf16* Wi = (LAS bf16*)L0; LAS bf16* Ti = Wi + 64 * MP; LAS bf16* Rh = Ti + 64 * MP; LAS bf16* Kh = Rh + 64 * MP; LAS bf16* Bh = Kh + 64 * MP;
    LAS bf16* UT = (LAS bf16*)(L0 + 11 * IMG);
    LAS float* cLv = (LAS float*)(L0 + 14 * IMG);
    const bf16* WA = WSP(const bf16, WS_HB); const bf16* rkv = WSP(const bf16, WS_RKV); const float* rinv = WSP(const float, WS_RINV);
    bf16* outb = WSP(bf16, WS_OUTB) + (size_t)d * T_ALL * 256;
    const int tt = C.tid >> 3, part = C.tid & 7;
    for (int i = C.tid; i < 2 * IMG / 4; i += NTHR) ((LAS unsigned*)(L0 + 12 * IMG))[i] = 0u;
    float kkw[8], kaw[8];
#pragma unroll
    for (int e = 0; e < 8; ++e) { kkw[e] = C.in[I_RKK][l * GW + h * 64 + 8 * w + e]; kaw[e] = C.in[I_RKA][l * GW + h * 64 + 8 * w + e]; }
    v4u gr, gk, gv, gw, ga, gbw, gbt; float gri;
    auto gload = [&](int n) {
        const int c = d ? (n < 4 ? 3 - n : 71 - n) : n;
        const int row = seqrow_raster(n * 64 + lane, d, b);
        const bf16* pr = rkv + (size_t)row * 768 + h * 64 + 8 * w;
        gr = *(const v4u*)pr; gk = *(const v4u*)(pr + 256); gv = *(const v4u*)(pr + 512);
        gw = *(const v4u*)(WA + (size_t)row * 1024 + d * 256 + h * 64 + 8 * w); ga = *(const v4u*)(WA + (size_t)row * 1024 + (2 + d) * 256 + h * 64 + 8 * w);
        gri = rinv[(size_t)row * 4 + h];
        gbw = *(const v4u*)(rw_blob_row(C, d, 0, b, c, h, tt) + 8 * part); gbt = *(const v4u*)(rw_blob_row(C, d, 1, b, c, h, tt) + 8 * part);
    };
    auto images = [&](int bufi) {
        LAS bf16* VT = (LAS bf16*)(L0 + (5 + 3 * bufi) * IMG); LAS bf16* KcT = VT + 64 * MP; LAS bf16* BcT = KcT + 64 * MP;
        const unsigned rw_[4] = {gr.x, gr.y, gr.z, gr.w}, kw_[4] = {gk.x, gk.y, gk.z, gk.w}, vw_[4] = {gv.x, gv.y, gv.z, gv.w}, ww_[4] = {gw.x, gw.y, gw.z, gw.w}, aw_[4] = {ga.x, ga.y, ga.z, ga.w};
        float rh[8], kh[8], bh[8];
#pragma unroll
        for (int e = 0; e < 8; ++e) {
            const float rs = (e & 1) ? bfhi(rw_[e >> 1]) : bflo(rw_[e >> 1]), ks = (e & 1) ? bfhi(kw_[e >> 1]) : bflo(kw_[e >> 1]);
            const float wv = (e & 1) ? bfhi(ww_[e >> 1]) : bflo(ww_[e >> 1]), av = (e & 1) ? bfhi(aw_[e >> 1]) : bflo(aw_[e >> 1]);
            const float lw = __logf(wv);
            const float cum = wave_incl_sum(lw, lane);
            const float kap = ks * kkw[e] * gri, ktil = ks * (1.0f + (av - 1.0f) * kaw[e]);
            const float cf = __expf(cum), icf = __builtin_amdgcn_rcpf(cf), cfL = __shfl(cf, 63), dec = cfL * icf;
            rh[e] = rs * cf; kh[e] = ktil * icf; bh[e] = kap * av * icf;
            const unsigned short vraw = (e & 1) ? (unsigned short)(vw_[e >> 1] >> 16) : (unsigned short)(vw_[e >> 1] & 0xffffu);
            VT[(8 * w + e) * MP + lane] = vraw; KcT[(8 * w + e) * MP + lane] = (bf16)f2bf1(ktil * dec); BcT[(8 * w + e) * MP + lane] = (bf16)f2bf1(-(kap * av * dec));
            if (lane == 63) cLv[bufi * 64 + 8 * w + e] = cfL;
        }
        { v4u o; o.x = pk2(rh[0], rh[1]); o.y = pk2(rh[2], rh[3]); o.z = pk2(rh[4], rh[5]); o.w = pk2(rh[6], rh[7]); *(LAS v4u*)(Rh + lane * MP + 8 * w) = o; }
        { v4u o; o.x = pk2(kh[0], kh[1]); o.y = pk2(kh[2], kh[3]); o.z = pk2(kh[4], kh[5]); o.w = pk2(kh[6], kh[7]); *(LAS v4u*)(Kh + lane * MP + 8 * w) = o; }
        { v4u o; o.x = pk2(bh[0], bh[1]); o.y = pk2(bh[2], bh[3]); o.z = pk2(bh[4], bh[5]); o.w = pk2(bh[6], bh[7]); *(LAS v4u*)(Bh + lane * MP + 8 * w) = o; }
        const unsigned bw_[4] = {gbw.x, gbw.y, gbw.z, gbw.w}, bt_[4] = {gbt.x, gbt.y, gbt.z, gbt.w};
#pragma unroll
        for (int e = 0; e < 4; ++e) {
            Wi[(8 * part + 2 * e) * MP + tt] = (bf16)(bw_[e] & 0xffffu); Wi[(8 * part + 2 * e + 1) * MP + tt] = (bf16)(bw_[e] >> 16);
            Ti[(8 * part + 2 * e) * MP + tt] = (bf16)(bt_[e] & 0xffffu); Ti[(8 * part + 2 * e + 1) * MP + tt] = (bf16)(bt_[e] >> 16);
        }
    };
    f32x4 Zst[NV];
#pragma unroll
    for (int v2 = 0; v2 < NV; ++v2) Zst[v2] = (f32x4){0.f, 0.f, 0.f, 0.f};
    const f32x4 z4 = (f32x4){0.f, 0.f, 0.f, 0.f};
    gload(0); images(0); gload(1);
#pragma unroll 1
    for (int n = 0; n < NCH; ++n) {
        RAW_BARRIER();
        const LAS bf16* VT = (const LAS bf16*)(L0 + (5 + 3 * (n & 1)) * IMG); const LAS bf16* KcT = VT + 64 * MP; const LAS bf16* BcT = KcT + 64 * MP;
        const LAS bf16* Zi = (const LAS bf16*)(L0 + (12 + (n & 1)) * IMG); LAS bf16* Zn = (LAS bf16*)(L0 + (12 + ((n + 1) & 1)) * IMG);
        const int arow = (16 * it + l15) * MP + 8 * q;
        const fragb Wf0 = ld_frag16(Wi + arow), Wf1 = ld_frag16(Wi + arow + 32), Tf0 = ld_frag16(Ti + arow), Tf1 = ld_frag16(Ti + arow + 32), Rf0 = ld_frag16(Rh + arow), Rf1 = ld_frag16(Rh + arow + 32);
        const int icol = 16 * it + l15;
        f32x4 pk[4], pb[4];
#pragma unroll
        for (int jt = 0; jt < 4; ++jt) {
            pk[jt] = z4; pb[jt] = z4;
            if (jt <= it) {
                const int jrow = (16 * jt + l15) * MP + 8 * q;
                f32x4 sk = mfma16(ld_frag16(Kh + jrow), Rf0, z4); sk = mfma16(ld_frag16(Kh + jrow + 32), Rf1, sk);
                f32x4 sb = mfma16(ld_frag16(Bh + jrow), Rf0, z4); sb = mfma16(ld_frag16(Bh + jrow + 32), Rf1, sb);
#pragma unroll
                for (int r = 0; r < 4; ++r) { const int j = 16 * jt + 4 * q + r; pk[jt][r] = (j <= icol) ? sk[r] : 0.f; pb[jt][r] = (j <= icol) ? -sb[r] : 0.f; }
            }
        }
        fragb Pk0 = pack_frag(pk[0], pk[1]), Pk1 = pack_frag(pk[2], pk[3]), Pb0 = pack_frag(pb[0], pb[1]), Pb1 = pack_frag(pb[2], pb[3]);
        f32x4 RZ[NV];
#pragma unroll
        for (int v2 = 0; v2 < NV; ++v2) {
            const int vrow = 16 * (vt0 + v2) + l15;
            const fragb z0 = ld_frag16(Zi + vrow * MP + 8 * q), z1 = ld_frag16(Zi + vrow * MP + 32 + 8 * q);
            f32x4 u = mfma16(Wf0, z0, z4); u = mfma16(Wf1, z1, u);
            u = mfma16(Tf0, ld_frag16(VT + vrow * MP + 8 * q), u); if (it >= 2) u = mfma16(Tf1, ld_frag16(VT + vrow * MP + 32 + 8 * q), u);
            RZ[v2] = mfma16(Rf0, z0, z4); RZ[v2] = mfma16(Rf1, z1, RZ[v2]);
            v2u o; o.x = pk2(u.x, u.y); o.y = pk2(u.z, u.w);
            *(LAS v2u*)(UT + vrow * MP + 16 * it + 4 * q) = o;
        }
        RAW_BARRIER();
        {
            const f32x4 cl4 = *(const LAS f32x4*)(cLv + (n & 1) * 64 + 16 * it + 4 * q);
            const LAS bf16* kr = KcT + (16 * it + l15) * MP + 4 * q; const LAS bf16* br = BcT + (16 * it + l15) * MP + 4 * q;
            const fragb kc0 = ld_frag8x2(kr, kr + 16), kc1 = ld_frag8x2(kr + 32, kr + 48), bc0 = ld_frag8x2(br, br + 16), bc1 = ld_frag8x2(br + 32, br + 48);
#pragma unroll
            for (int v2 = 0; v2 < NV; ++v2) {
                const int vrow = 16 * (vt0 + v2) + l15;
                const LAS bf16* vr = VT + vrow * MP + 4 * q; const LAS bf16* ur = UT + vrow * MP + 4 * q;
                const fragb vp0 = ld_frag8x2(vr, vr + 16), vp1 = ld_frag8x2(vr + 32, vr + 48), up0 = ld_frag8x2(ur, ur + 16), up1 = ld_frag8x2(ur + 32, ur + 48);
                f32x4 y = mfma16(Pk0, vp0, RZ[v2]); y = mfma16(Pb0, up0, y);
                if (it >= 2) { y = mfma16(Pk1, vp1, y); y = mfma16(Pb1, up1, y); }
#pragma unroll
                for (int r = 0; r < 4; ++r) { const int row = seqrow_raster(n * 64 + 16 * it + 4 * q + r, d, b); if (!DRY) outb[(size_t)row * 256 + h * 64 + vrow] = (bf16)f2bf1(y[r]); }
                f32x4 zn = mfma16(kc0, vp0, z4); zn = mfma16(kc1, vp1, zn); zn = mfma16(bc0, up0, zn); zn = mfma16(bc1, up1, zn);
                Zst[v2] = Zst[v2] * cl4 + zn;
                v2u so; so.x = pk2(Zst[v2].x, Zst[v2].y); so.y = pk2(Zst[v2].z, Zst[v2].w);
                *(LAS v2u*)(Zn + vrow * MP + 16 * it + 4 * q) = so;
            }
        }
        if (n + 1 < NCH) { images((n + 1) & 1); if (n + 2 < NCH) gload(n + 2); }
    }
    __syncthreads();
}
__device__ __forceinline__ void moe_scatter(const Ctx& C, int moe_li, int nrows) {
    const unsigned* gc = WSP(const unsigned, WS_CTL) + CW_MOECNT + 64 * moe_li;
    LAS int* pst = (LAS int*)C.lds;
    {
        int pe[8]; int acc = 0;
#pragma unroll
        for (int e = 0; e < NE; ++e) { const int blks = ((int)gc[e] + 255) >> 8; if (C.tid == e) pst[e] = acc * 256; acc += blks; pe[e] = acc; }
        if (C.wg == 0 && C.tid < MOE_MAXBLK) { int be = 0;
#pragma unroll
            for (int e = 0; e < NE; ++e) be += (pe[e] <= C.tid) ? 1 : 0;
            int* tab = WSP(int, WS_TAB); tab[1 + C.tid] = be < NE ? be : NE - 1; if (C.tid == 0) tab[0] = acc; }
    }
    __syncthreads();
    const unsigned* route = WSP(const unsigned, WS_ROUTE); const unsigned* wgbase = WSP(const unsigned, WS_WGBASE);
    const bf16* hb = WSP(const bf16, WS_HB); bf16* am = WSP(bf16, WS_MIX); int* pos = WSP(int, WS_POS);
    const int gw = C.wg * NWAVES + C.wave, NGW = C.G * NWAVES;
    for (int m = gw; m < nrows; m += NGW) {
        const v4u a = *(const v4u*)(route + (size_t)m * 8);
        const int e0 = (int)a.x, e1 = (int)a.y;
        const int p0 = pst[e0] + (int)wgbase[C.wg * 8 + e0] + (int)a.z, p1 = pst[e1] + (int)wgbase[C.wg * 8 + e1] + (int)a.w;
        const v4u r0 = *(const v4u*)(hb + (size_t)m * 1024 + C.lane * 8), r1 = *(const v4u*)(hb + (size_t)m * 1024 + 512 + C.lane * 8);
        *(v4u*)(am + (size_t)p0 * 1024 + C.lane * 8) = r0; *(v4u*)(am + (size_t)p0 * 1024 + 512 + C.lane * 8) = r1;
        *(v4u*)(am + (size_t)p1 * 1024 + C.lane * 8) = r0; *(v4u*)(am + (size_t)p1 * 1024 + 512 + C.lane * 8) = r1;
        if (C.lane == 0) { pos[(size_t)m * 2] = p0; pos[(size_t)m * 2 + 1] = p1; }
    }
    __syncthreads();
}
template <int NEXT>
__device__ __forceinline__ void moe_combine(const Ctx& C, int l, int nrows) {
    const unsigned* route = WSP(const unsigned, WS_ROUTE); const int* pos = WSP(const int, WS_POS); const bf16* ym = WSP(const bf16, WS_MIX);
    const float* modv = WSP(const float, WS_MODV) + (size_t)l * 9 * 6144 + 5 * 1024;
    const float* modn = WSP(const float, WS_MODV) + (size_t)(l + 1) * 9 * 6144;
    float* xc = WSP(float, WS_XC); bf16* hb = WSP(bf16, WS_HB);
    const int gw = C.wg * NWAVES + C.wave, NGW = C.G * NWAVES;
    f32x4 gn[4];
#pragma unroll
    for (int j = 0; j < 4; ++j) gn[j] = *(const f32x4*)((NEXT == 2 ? C.in[I_FNG] : C.in[I_NMIXG] + (NEXT == 1 ? (l + 1) * 1024 : 0)) + 4 * C.lane + 256 * j);
    for (int m = gw; m < nrows; m += NGW) {
        const bool isctx = m >= T_LAT;
        float* xr = isctx ? xc + (size_t)(m - T_LAT) * 1024 : C.out + (size_t)m * 1024;
        const int mrow = isctx ? 8 : (m >> 12);
        const float* gv = modv + (size_t)mrow * 6144;
        const int p0 = pos[(size_t)m * 2], p1 = pos[(size_t)m * 2 + 1];
        const float w0 = __builtin_bit_cast(float, route[(size_t)m * 8 + 4]), w1 = __builtin_bit_cast(float, route[(size_t)m * 8 + 5]);
        f32x4 x[4]; float ss = 0.f;
#pragma unroll
        for (int j = 0; j < 4; ++j) {
            const int col = 4 * C.lane + 256 * j;
            const v2u a = *(const v2u*)(ym + (size_t)p0 * 1024 + col), b = *(const v2u*)(ym + (size_t)p1 * 1024 + col);
            const f32x4 ya = (f32x4){bflo(a.x), bfhi(a.x), bflo(a.y), bfhi(a.y)}, yb = (f32x4){bflo(b.x), bfhi(b.x), bflo(b.y), bfhi(b.y)};
            const f32x4 g = *(const f32x4*)(gv + col);
            x[j] = *(const f32x4*)(xr + col) + g * (ya * w0 + yb * w1);
            if (NEXT != 2) *(f32x4*)(xr + col) = x[j];
            ss += (x[j].x * x[j].x + x[j].y * x[j].y) + (x[j].z * x[j].z + x[j].w * x[j].w);
        }
        if (NEXT != 0) {
            const float rs = rsqrtf_(wave_sum(ss) * (1.0f / 1024.0f) + 1e-6f);
#pragma unroll
            for (int j = 0; j < 4; ++j) {
                const int col = 4 * C.lane + 256 * j;
                if (NEXT == 2) *(f32x4*)(xr + col) = x[j] * rs * gn[j];
                else { const f32x4 sh = *(const f32x4*)(modn + (size_t)mrow * 6144 + col), scl = *(const f32x4*)(modn + (size_t)mrow * 6144 + 1024 + col);
                    st4bf(hb + (size_t)m * 1024 + col, (x[j] * rs * gn[j]) * (scl + 1.0f) + sh); }
            }
        }
    }
}
__device__ __forceinline__ void final_norm(const Ctx& C) {
    const int gw = C.wg * NWAVES + C.wave, NGW = C.G * NWAVES;
    f32x4 gv[4];
#pragma unroll
    for (int j = 0; j < 4; ++j) gv[j] = *(const f32x4*)(C.in[I_FNG] + 4 * C.lane + 256 * j);
    for (int m = gw; m < T_LAT; m += NGW) {
        float* xr = C.out + (size_t)m * 1024;
        f32x4 v[4]; float s = 0.f;
#pragma unroll
        for (int j = 0; j < 4; ++j) { v[j] = *(const f32x4*)(xr + 4 * C.lane + 256 * j); s += (v[j].x * v[j].x + v[j].y * v[j].y) + (v[j].z * v[j].z + v[j].w * v[j].w); }
        const float rs = rsqrtf_(wave_sum(s) * (1.0f / 1024.0f) + 1e-6f);
#pragma unroll
        for (int j = 0; j < 4; ++j) *(f32x4*)(xr + 4 * C.lane + 256 * j) = v[j] * rs * gv[j];
    }
}

constexpr int NPH_L = 13, PH_FINAL = 1 + DEPTH * NPH_L, NPHASE = PH_FINAL + 1;
__host__ __device__ inline bool phase_exists(int ph) {
    if (ph == 0) return true;
    if (ph == PH_FINAL) return false;
    const int l = (ph - 1) / NPH_L, k = (ph - 1) % NPH_L;
    if (l >= 2 && !(l & 1) && k == 0) return false;
    if (!(l & 1) && k >= 11) return false;
    if (!RW_VSPLIT && k == 4) return false;
    return true;
}
#ifndef PH_MASK
#define PH_MASK 0xFFFFFF
#endif
#define PM(k) ((PH_MASK >> (k)) & 1)
#ifndef SK_MASK
#define SK_MASK 0xFFFF
#endif
#define SK(k) ((SK_MASK >> (k)) & 1)
#ifndef REP_MASK
#define REP_MASK 0
#endif
#define NREP(k) (((REP_MASK >> (k)) & 1) ? 2 : 1)

__global__ void __launch_bounds__(NTHR, 2) fwd_kernel(Args args) {
    extern __shared__ __attribute__((aligned(16))) unsigned char lds_raw[];
    Ctx C; C.in = args.in; C.out = args.out; C.ws = args.ws; C.lds = (LAS unsigned char*)lds_raw;
    C.tid = threadIdx.x; C.lane = C.tid & 63; C.wave = __builtin_amdgcn_readfirstlane(C.tid >> 6); C.G = gridDim.x; C.wg = blockIdx.x;
    volatile LAS unsigned* MISC = (volatile LAS unsigned*)(C.lds + MISC_OFF);
    if (C.tid < 64) MISC[C.tid] = 0u;
    __syncthreads();
    const int lo = args.ph_lo, hi = args.ph_hi;
    const bool multi = (hi - lo) > 1;
    if (multi) (void)xcd_barrier_post(WSP(unsigned, WS_CTL) + CW_BAR, MISC + 8);
#define IN(k) (lo <= (k) && (k) < hi)
#define SEAM(k) do { if (IN((k) + 1)) { XcdBarrier b2_; b2_.bar = WSP(unsigned, WS_CTL) + CW_BAR; b2_.x = xb_xcc_id(); b2_.st = (volatile LAS unsigned*)(C.lds + MISC_OFF) + 8; xcd_barrier(b2_); } } while (0)
#define FRESH() do { int t_ = threadIdx.x; asm volatile("" : "+v"(t_)); C.tid = t_; C.lane = t_ & 63; C.wave = __builtin_amdgcn_readfirstlane(t_ >> 6); } while (0)
#define PHASE(bit, k) if (PM(bit) && IN(pb + (k))) for (int rep_ = 0; rep_ < NREP(bit); ++rep_)
#define CLAIM(qh, var) __syncthreads(); if (C.tid == 0) *qslot = atomicAdd((qh), 1u); __syncthreads(); const int var = (int)*qslot;

    LAS unsigned* qslot = (LAS unsigned*)(C.lds + MISC_OFF + 128);
    if (PM(20) && IN(0)) { phase_pre(C); SEAM(0); }

#pragma unroll 1
    for (int l = 0; l < DEPTH; ++l) {
        const int pb = 1 + l * NPH_L;
        if (hi <= pb || lo >= pb + NPH_L) continue;
        const bool last = (l == DEPTH - 1), moe = (l & 1);
        const int nrows = last ? T_LAT : T_ALL;
        const float* xlat = (l == 0) ? C.in[I_X] : C.out; const float* xctx = (l == 0) ? C.in[I_CTX] : WSP(const float, WS_XC);
        const float* modv = WSP(const float, WS_MODV) + (size_t)l * 9 * 6144;
        unsigned* qbase = WSP(unsigned, WS_CTL) + CW_PREPQ + 256 * l;

        if (!(l >= 2 && !(l & 1))) PHASE(0, 0) { FRESH();
            convert_small(C, l);
            if (l == 0) { FRESH(); convert_items(C, 0, 3, C.wg * NWAVES + C.wave, C.G * NWAVES); }
            __syncthreads();
            FRESH(); norm_rows<false>(C, l, xlat, xctx, C.in[I_NMIXG] + l * 1024, 0, 1024, T_ALL, 0);
            SEAM(pb + 0);
        }
        PHASE(1, 1) { FRESH();
            pg8::Gemm g{WSP(const bf16, WS_HB), WSP(const bf16, WS_WIN), T_ALL, PLD, 1024, 0};
            pg8::StaticOrder S; S.init(T_ALL, PLD, C.G, C.wg);
            pg8::EpiBf16<0> E{WSP(bf16, WS_P), PLD, nullptr, 0, 0};
            pg8::gemm_phase<pg8::EpiBf16<0>, pg8::StaticOrder, false>(C.lds, g, S, E, nullptr);
            SEAM(pb + 1);
        }
        if (PM(2) && IN(pb + 2)) for (int rep_ = 0; rep_ < NREP(2); ++rep_) { FRESH();
            for (;;) {
                CLAIM(qbase + 16 * rep_, k)
                if (k >= 3 * NB * NCH) break;
                const int kind = k / (NB * NCH), u = k % (NB * NCH);
                FRESH();
                if (kind == 0) { for (int r3_ = 0; r3_ < NREP(24); ++r3_) { FRESH(); if (SK(1)) rwkv_prep2(C, l, u / NCH, u % NCH); } }
                else if (kind == 1) { for (int r3_ = 0; r3_ < NREP(25); ++r3_) { FRESH(); if (SK(0)) lru_chunk_mfma<false>(C, l, u / NCH, u % NCH); } }
                else { for (int r3_ = 0; r3_ < NREP(26); ++r3_) { FRESH(); if (SK(2)) gdn_prep(C, l, u / NCH, u % NCH); } }
            }
            SEAM(pb + 2);
        }
        if (PM(3) && IN(pb + 3)) for (int rep_ = 0; rep_ < NREP(3); ++rep_) { FRESH();
            constexpr int NCL = 2 * NB * NH * NCH / 4;
            for (;;) {
                CLAIM(qbase + 64 + 16 * rep_, k)
                if (k >= (RW_VSPLIT ? NCL : 2 * NCL)) break;
                FRESH();
                if (k < NCL) { if (SK(9)) gdn_solve_item(C, l, 4 * k + (C.wave >> 1)); }
                else { if (SK(10)) rwkv_solve_item(C, l, 4 * (k - NCL) + (C.wave >> 1)); }
            }
            FRESH(); if (SK(6) && C.wg < 8) lru_carry(C, C.wg * NTHR + C.tid);
            SEAM(pb + (RW_VSPLIT ? 3 : 4));
        }
#if RW_VSPLIT
        if (PM(3) && IN(pb + 4)) { FRESH();
            for (;;) {
                CLAIM(qbase + 128, k)
                if (k >= 2 * NB * NH * NCH / 4) break;
                FRESH();
                if (SK(10)) rwkv_solve_item(C, l, 4 * k + (C.wave >> 1));
            }
            SEAM(pb + 4);
        }
#endif
        if (PM(4) && IN(pb + 5)) { FRESH();
            if (SK(3) && C.wg < (RW_VSPLIT ? 128 : 64)) { if (NREP(20) > 1) { FRESH(); rwkv_chunked<true>(C, l, C.wg); } FRESH(); rwkv_chunked<false>(C, l, C.wg); }
            else if (SK(4) && C.wg >= 128 && C.wg < 192) { for (int r2_ = 0; r2_ < NREP(21); ++r2_) { FRESH(); mlstm_chunked(C, l, C.wg - 128); } }
            else if (SK(5) && C.wg >= 192) { if (NREP(22) > 1) { FRESH(); gdn_chunked<true>(C, l, C.wg - 192); } FRESH(); gdn_chunked<false>(C, l, C.wg - 192); }
            {
                FRESH();
                const int nun = last ? NB * 64 : NB * NCH;
                for (;;) {
                    CLAIM(qbase + 192, u0)
                    if (u0 >= 128 + nun) break;
                    if (u0 < 128) {
                        FRESH(); if (l > 0) convert_items(C, l, 2, u0 * NWAVES + C.wave, 128 * NWAVES);
                        if (l + 1 < DEPTH) { FRESH(); convert_items(C, l + 1, 1, u0 * NWAVES + C.wave, 128 * NWAVES); }
                    } else {
                        const int u = u0 - 128;
                        const int b = last ? (u >> 6) : (u / NCH), c = last ? 4 + (u & 63) : (u % NCH);
                        if (SK(7)) lru_chunk_mfma<true>(C, l, b, c);
                    }
                }
            }
            SEAM(pb + 5);
        }
        PHASE(5, 6) { FRESH();
            if (SK(8)) finish_rows(C, l, nrows);
            SEAM(pb + 6);
        }
        if (PM(6) && IN(pb + 7)) { FRESH();
            pg8::Gemm g{WSP(const bf16, WS_HB), WSP(const bf16, WS_WOUT), nrows, 1024, 1024, 0};
            pg8::StaticOrder S; S.init(nrows, 1024, C.G, C.wg);
            pg8::EpiRes E{xlat, xctx, C.out, WSP(float, WS_XC), modv + 2 * 1024};
            pg8::gemm_phase<pg8::EpiRes, pg8::StaticOrder, false>(C.lds, g, S, E, nullptr);
            SEAM(pb + 7);
        }
        if (PM(7) && IN(pb + 8)) { FRESH();
            if (moe) norm_rows<true>(C, l, C.out, WSP(const float, WS_XC), C.in[I_NFFNG] + l * 1024, 3 * 1024, 4 * 1024, nrows, l >> 1);
            else norm_rows<false>(C, l, C.out, WSP(const float, WS_XC), C.in[I_NFFNG] + l * 1024, 3 * 1024, 4 * 1024, nrows, 0);
            SEAM(pb + 8);
        }
        if (!moe) {
            if (PM(8) && IN(pb + 9)) for (int rep_ = 0; rep_ < NREP(8); ++rep_) { FRESH();
                pg8::Gemm g{WSP(const bf16, WS_HB), WSP(const bf16, WS_WGU), nrows, 2 * DFF, 1024, 0};
                pg8::StaticOrder S; S.init(nrows, 2 * DFF, C.G, C.wg);
                pg8::EpiSwiglu E{WSP(bf16, WS_P), DFF};
                pg8::gemm_phase<pg8::EpiSwiglu, pg8::StaticOrder, false>(C.lds, g, S, E, nullptr);
                SEAM(pb + 9);
            }
            if (PM(9) && IN(pb + 10)) { FRESH();
                pg8::Gemm g{WSP(const bf16, WS_P), WSP(const bf16, WS_WDN), nrows, 1024, DFF, 0};
                pg8::StaticOrder S; S.init(nrows, 1024, C.G, C.wg);
                pg8::EpiRes E{C.out, WSP(const float, WS_XC), C.out, WSP(float, WS_XC), modv + 5 * 1024};
                pg8::gemm_phase<pg8::EpiRes, pg8::StaticOrder, false>(C.lds, g, S, E, nullptr);
                SEAM(pb + 12);
            }
        } else {
            if (PM(10) && IN(pb + 9)) { FRESH(); moe_scatter(C, l >> 1, nrows); SEAM(pb + 9); }
            if (PM(11) && IN(pb + 10)) for (int rep_ = 0; rep_ < NREP(11); ++rep_) { FRESH();
                pg8::Gemm g{WSP(const bf16, WS_MIX), WSP(const bf16, WS_WGU), 0, 2 * DFE, 1024, (size_t)2 * DFE * 1024};
                pg8::MoeOrder S; S.init(WSP(const int, WS_TAB), (2 * DFE) / 256, C.G, C.wg);
                pg8::EpiSwiglu E{WSP(bf16, WS_P), DFE};
                pg8::gemm_phase<pg8::EpiSwiglu, pg8::MoeOrder, false>(C.lds, g, S, E, nullptr);
                SEAM(pb + 10);
            }
            if (PM(12) && IN(pb + 11)) for (int rep_ = 0; rep_ < NREP(12); ++rep_) { FRESH();
                pg8::Gemm g{WSP(const bf16, WS_P), WSP(const bf16, WS_WDN), 0, 1024, DFE, (size_t)1024 * DFE};
                pg8::MoeOrder S; S.init(WSP(const int, WS_TAB), 4, C.G, C.wg);
                pg8::EpiBf16<0> E{WSP(bf16, WS_MIX), 1024, nullptr, 0, 0};
                pg8::gemm_phase<pg8::EpiBf16<0>, pg8::MoeOrder, false>(C.lds, g, S, E, nullptr);
                SEAM(pb + 11);
            }
            if (PM(13) && IN(pb + 12)) { FRESH();
                if (last) moe_combine<2>(C, l, nrows);
                else { convert_small(C, l + 1); FRESH(); moe_combine<1>(C, l, nrows); if (IN(pb + NPH_L + 1)) { XcdBarrier b2_; b2_.bar = WSP(unsigned, WS_CTL) + CW_BAR; b2_.x = xb_xcc_id(); b2_.st = (volatile LAS unsigned*)(C.lds + MISC_OFF) + 8; xcd_barrier(b2_); } }
            }
        }
    }
}

extern "C" void kernel_launch(void* const* d_in, const int* in_sizes, int n_in, void* d_out, int out_size, void* d_ws, size_t ws_size, hipStream_t stream) {
    static int grid = 0;
    if (grid == 0) {
        if (n_in != N_IN || in_sizes[0] != T_LAT * DM || out_size != T_LAT * DM || ws_size < WS_END) {
            fprintf(stderr, "kernel_launch: unexpected problem (n_in %d, in0 %d, out %d, ws %zu < %zu)\n", n_in, n_in > 0 ? in_sizes[0] : -1, out_size, ws_size, (size_t)WS_END); grid = -1; return; }
        int dev = 0, cus = 0, per_cu = 0;
        if (hipGetDevice(&dev) != hipSuccess || hipDeviceGetAttribute(&cus, hipDeviceAttributeMultiprocessorCount, dev) != hipSuccess) { grid = -1; return; }
        if (hipFuncSetAttribute((const void*)fwd_kernel, hipFuncAttributeMaxDynamicSharedMemorySize, LDS_BYTES) != hipSuccess) { fprintf(stderr, "kernel_launch: hipFuncSetAttribute failed\n"); grid = -1; return; }
        if (hipOccupancyMaxActiveBlocksPerMultiprocessor(&per_cu, (const void*)fwd_kernel, NTHR, LDS_BYTES) != hipSuccess || per_cu < 1) { fprintf(stderr, "kernel_launch: occupancy query says %d\n", per_cu); grid = -1; return; }
        grid = cus;
        if (grid != 256) fprintf(stderr, "kernel_launch: note: %d CUs\n", grid);
    }
    if (grid < 0) return;
    if (hipMemsetAsync((char*)d_ws + WS_CTL, 0, CTL_BYTES, stream) != hipSuccess) return;
    Args a{};
    for (int i = 0; i < N_IN; ++i) a.in[i] = (const float*)d_in[i];
    a.out = (float*)d_out; a.ws = (unsigned char*)d_ws;
#if MK_ONE_LAUNCH
    a.ph_lo = 0; a.ph_hi = NPHASE;
    hipLaunchKernelGGL(fwd_kernel, dim3(grid), dim3(NTHR), LDS_BYTES, stream, a);
#else
    for (int ph = 0; ph < NPHASE; ++ph) { if (!phase_exists(ph)) continue; a.ph_lo = ph; a.ph_hi = ph + 1; hipLaunchKernelGGL(fwd_kernel, dim3(grid), dim3(NTHR), LDS_BYTES, stream, a); }
#endif
}
```

```cpp
#define MK_ONE_LAUNCH 1
#include <hip/hip_runtime.h>
#include <cstdio>
#include <cstdint>

#define GAS __attribute__((address_space(1)))
#define LAS __attribute__((address_space(3)))
typedef unsigned short bf16;
typedef unsigned v4u __attribute__((ext_vector_type(4)));
typedef unsigned v2u __attribute__((ext_vector_type(2)));
typedef float f32x4 __attribute__((ext_vector_type(4)));
typedef float f32x2 __attribute__((ext_vector_type(2)));
typedef short bf16x8 __attribute__((ext_vector_type(8)));
#define LDS_WAIT() asm volatile("s_waitcnt lgkmcnt(0)" ::: "memory")
#define VM_WAIT() asm volatile("s_waitcnt vmcnt(0)" ::: "memory")

constexpr int DM = 1024, NB = 8, SEQ = 4096, DEPTH = 4, CTXL = 256, GW = 256, HD = 64, NH = 4;
constexpr int T_LAT = NB * SEQ, T_CTX = NB * CTXL, T_ALL = T_LAT + T_CTX;
constexpr int IN_COLS = 3552, PLD = 3584;
constexpr int OFF_B = 512, OFF_C = 1472, OFF_D = 2512, B_COLS = 960;
constexpr int DFF = 2816, NE = 8, DFE = 1408;
constexpr int NCH = 68;
constexpr int NSTEP = 4352;
constexpr int MOE_MAXBLK = 280;
constexpr int NWAVES = 8, NTHR = 512;
#ifndef RW_VSPLIT
#define RW_VSPLIT 0
#endif

constexpr size_t MiB = 1u << 20;
constexpr size_t WS_CTL = 0, CTL_BYTES = 1 * MiB;
constexpr size_t WS_MODV = 1 * MiB;
constexpr size_t WS_XC = 2 * MiB;
constexpr size_t WS_WIN = 10 * MiB;
constexpr size_t WS_WOUT = 17 * MiB;
constexpr size_t WS_WGU = 19 * MiB;
constexpr size_t WS_WDN = 63 * MiB;
constexpr size_t WS_HB = 85 * MiB;
constexpr size_t WS_P = 153 * MiB;
constexpr size_t WS_MIX = 391 * MiB;
constexpr size_t WS_OUTB = WS_MIX, WS_OUTC = WS_MIX + 34 * MiB, WS_OUTD = WS_MIX + 68 * MiB, WS_GQ = WS_MIX + 102 * MiB, WS_G = WS_MIX + 153 * MiB;
constexpr size_t WS_RKV = WS_MIX + 170 * MiB;
constexpr size_t WS_SMALL = 612 * MiB;
constexpr size_t WS_LSUM = WS_SMALL;
constexpr size_t WS_HIN = WS_SMALL + 3 * MiB;
constexpr size_t WS_ROUTE = WS_SMALL + 5 * MiB;
constexpr size_t WS_POS = WS_SMALL + 7 * MiB;
constexpr size_t WS_BONUS = WS_SMALL + 8 * MiB;
constexpr size_t WS_WGBASE = WS_SMALL + 9 * MiB;
constexpr size_t WS_TAB = WS_WGBASE + 65536;
constexpr size_t WS_LRUWT = WS_SMALL + 10 * MiB;
constexpr size_t WS_RWT = WS_LRUWT + 131072;
constexpr size_t WS_RINV = WS_SMALL + 11 * MiB;
constexpr size_t WS_END = 624 * MiB;
constexpr int CW_MOECNT = 1024;
constexpr int CW_PREPQ = 2048;
constexpr int CW_BAR = 4096;

constexpr int LDS_BYTES = 135168;
constexpr int MISC_OFF = 131072;

__device__ __forceinline__ unsigned f2bf(float f) { unsigned u = __builtin_bit_cast(unsigned, f); return (u + 0x7fffu + ((u >> 16) & 1u)) >> 16; }
typedef __bf16 bf16n2 __attribute__((ext_vector_type(2)));
__device__ __forceinline__ unsigned pk2(float lo, float hi) { const f32x2 v = {lo, hi}; return __builtin_bit_cast(unsigned, __builtin_convertvector(v, bf16n2)); }
__device__ __forceinline__ unsigned f2bf1(float f) { return pk2(f, f) & 0xffffu; }
__device__ __forceinline__ float bf2f(unsigned short v) { return __builtin_bit_cast(float, (unsigned)v << 16); }
__device__ __forceinline__ float bflo(unsigned v) { return __builtin_bit_cast(float, v << 16); }
__device__ __forceinline__ float bfhi(unsigned v) { return __builtin_bit_cast(float, v & 0xffff0000u); }
template <int CTRL, int RM, bool BC> __device__ __forceinline__ float dpp_x(float oldv, float v) { return __builtin_bit_cast(float, __builtin_amdgcn_update_dpp(__builtin_bit_cast(int, oldv), __builtin_bit_cast(int, v), CTRL, RM, 0xF, BC)); }
__device__ __forceinline__ float wave_sum(float v) {
    v += dpp_x<0xB1, 0xF, true>(0.f, v); v += dpp_x<0x4E, 0xF, true>(0.f, v); v += dpp_x<0x141, 0xF, true>(0.f, v); v += dpp_x<0x140, 0xF, true>(0.f, v);
    v += dpp_x<0x142, 0xA, false>(0.f, v); v += dpp_x<0x143, 0xC, false>(0.f, v);
    return __builtin_bit_cast(float, __builtin_amdgcn_readlane(__builtin_bit_cast(int, v), 63));
}
template <int CTRL> __device__ __forceinline__ float dpp_f(float v) { return __builtin_bit_cast(float, __builtin_amdgcn_update_dpp(0, __builtin_bit_cast(int, v), CTRL, 0xF, 0xF, true)); }
__device__ __forceinline__ float row16_sum(float v) {
    v += dpp_f<0xB1>(v);
    v += dpp_f<0x4E>(v);
    v += dpp_f<0x141>(v);
    v += dpp_f<0x140>(v);
    return v;
}
__device__ __forceinline__ float sigmoidf_(float x) { return __builtin_amdgcn_rcpf(1.0f + __expf(-x)); }
__device__ __forceinline__ float softplusf_(float x) { return fmaxf(x, 0.f) + __logf(1.0f + __expf(-fabsf(x))); }
__device__ __forceinline__ float expm1f_(float x) { return x > -0.3f ? x * (1.0f + x * (0.5f + x * (0.16666667f + x * (0.041666668f + x * 0.0083333338f)))) : __expf(x) - 1.0f; }
__device__ __forceinline__ float siluf_(float x) { return x * __builtin_amdgcn_rcpf(1.0f + __expf(-x)); }
__device__ __forceinline__ float tanhf_(float x) { const float e = __expf(2.0f * x); return 1.0f - 2.0f * __builtin_amdgcn_rcpf(e + 1.0f); }
__device__ __forceinline__ float rsqrtf_(float x) { return __builtin_amdgcn_rsqf(x); }
__device__ __forceinline__ float gelu_tanh(float x) { return 0.5f * x * (1.0f + tanhf_(0.7978845608028654f * (x + 0.044715f * x * x * x))); }
__device__ __forceinline__ f32x4 ld4bf(const bf16* p) { const v2u a = *(const v2u*)p; return (f32x4){bflo(a.x), bfhi(a.x), bflo(a.y), bfhi(a.y)}; }
__device__ __forceinline__ void st4bf(bf16* p, const f32x4& v) { v2u o; o.x = pk2(v.x, v.y); o.y = pk2(v.z, v.w); *(v2u*)p = o; }
#define XB_TMO      128
#define XB_XCNT(j)  (256  + 64 * (j))
#define XB_XSUB(j)  (1280 + 64 * (j))
#define XB_XGEN(j)  (2304 + 64 * (j))
#define XB_TOP      3328
#define XB_TOPGEN   3392
#define XCD_BAR_WORDS 3456
#define XB_SPIN_CAP (1u << 22)

__device__ __forceinline__ unsigned xb_ld(unsigned* p)              { return __hip_atomic_load(p, __ATOMIC_RELAXED, __HIP_MEMORY_SCOPE_AGENT); }
__device__ __forceinline__ unsigned xb_add(unsigned* p, unsigned v) { return __hip_atomic_fetch_add(p, v, __ATOMIC_RELAXED, __HIP_MEMORY_SCOPE_AGENT); }
__device__ __forceinline__ unsigned xb_xcc_id() { return (unsigned)__builtin_amdgcn_s_getreg((3 << 11) | 20) & 0xFu; }
#define XB_SPIN(cond, bar) do { unsigned _sp = 0; while (cond) { __builtin_amdgcn_s_sleep(1); \
    if ((++_sp & 255u) == 0u) { if (xb_ld(&(bar)[XB_TMO])) break; if (_sp > XB_SPIN_CAP) { atomicAdd(&(bar)[XB_TMO], 1u); break; } } } } while (0)

struct XcdBarrier {
    unsigned* bar; unsigned x;
    volatile LAS unsigned* st;
};

__device__ __forceinline__ XcdBarrier xcd_barrier_post(unsigned* bar, volatile LAS unsigned* st) {
    XcdBarrier b; b.bar = bar; b.x = xb_xcc_id(); b.st = st;
    if (threadIdx.x == 0) (void)xb_add(&bar[XB_XCNT(b.x)], 1u);
    return b;
}
__device__ __forceinline__ void xcd_barrier_complete(unsigned* bar, unsigned x, unsigned& nloc, unsigned& nx) {
    const unsigned G = gridDim.x * gridDim.y * gridDim.z;
    unsigned sum, cnt, mine, sp = 0u;
    for (;;) {
        sum = 0u; cnt = 0u; mine = 0u;
#pragma unroll
        for (unsigned j = 0; j < 16; ++j) { const unsigned c = xb_ld(&bar[XB_XCNT(j)]); sum += c; cnt += (c > 0u) ? 1u : 0u; mine = (j == x) ? c : mine; }
        if (sum == G) break;
        __builtin_amdgcn_s_sleep(1);
        if ((++sp & 255u) == 0u) { if (xb_ld(&bar[XB_TMO])) break; if (sp > XB_SPIN_CAP) { atomicAdd(&bar[XB_TMO], 1u); break; } }
    }
    nloc = mine > 0u ? mine : 1u; nx = cnt > 0u ? cnt : 1u;
}

__device__ __forceinline__ void xcd_barrier(const XcdBarrier& b) {
    asm volatile("s_waitcnt vmcnt(0)" ::: "memory");
    __syncthreads();
    if (threadIdx.x == 0) {
        unsigned* bar = b.bar;
        __builtin_amdgcn_s_waitcnt(0);
        unsigned nloc = b.st[0], nx = b.st[1];
        if (nloc == 0u) { xcd_barrier_complete(bar, b.x, nloc, nx); b.st[0] = nloc; b.st[1] = nx; }
        const unsigned old = xb_add(&bar[XB_XSUB(b.x)], 1u);
        const unsigned gen = old / nloc;
        if (old + 1u == (gen + 1u) * nloc) {
            __builtin_amdgcn_fence(__ATOMIC_RELEASE, "agent");
            asm volatile("s_waitcnt vmcnt(0)" ::: "memory");
            const unsigned og = xb_add(&bar[XB_TOP], 1u);
            const unsigned tg = og / nx;
            if (og + 1u == (tg + 1u) * nx) xb_add(&bar[XB_TOPGEN], 1u);
            else XB_SPIN(xb_ld(&bar[XB_TOPGEN]) == tg, bar);
            __builtin_amdgcn_fence(__ATOMIC_ACQUIRE, "agent");
            xb_add(&bar[XB_XGEN(b.x)], 1u);
            asm volatile("s_waitcnt vmcnt(0)" ::: "memory");
        } else {
            XB_SPIN(xb_ld(&bar[XB_XGEN(b.x)]) == gen, bar);
            __builtin_amdgcn_fence(__ATOMIC_ACQUIRE, "agent");
            asm volatile("s_waitcnt vmcnt(0)" ::: "memory");
        }
    }
    __syncthreads();
}

namespace pg8 {
#define PG8_LAS __attribute__((address_space(3)))
typedef unsigned short bf16_t;
typedef short bf16x8 __attribute__((ext_vector_type(8)));
typedef float f32x4 __attribute__((ext_vector_type(4)));
typedef unsigned u32x4 __attribute__((ext_vector_type(4)));
constexpr int BM = 256, BK = 64, HALF = 128, HTB = HALF * BK * 2  , STAGE_BYTES = 8 * HTB, NXCD = 8, WGM = 8;

__host__ __device__ __forceinline__ int lds_byte(int r, int c) { const int st = (r >> 4) * 2 + (c >> 5), rr = r & 15, cc = c & 31, ob = rr * 64 + cc * 2; return st * 1024 + (ob ^ (((ob >> 9) & 1) << 5)); }
__host__ __device__ __forceinline__ void stage_rc(int b, int& R, int& C) { const int st = b / 1024, sb = b % 1024, swz = sb ^ (((sb >> 9) & 1) << 5); R = (st >> 1) * 16 + swz / 64; C = (st & 1) * 32 + (swz % 64) / 2; }
__host__ __device__ __forceinline__ int perm32(int rho) { const int n = rho >> 4, i = rho & 15; return 8 * (i >> 2) + 4 * n + (i & 3); }

struct Unit { int pm, pn, e; };
struct Gemm { const bf16_t* A; const bf16_t* Bt; int M, N, K; size_t estride; };

struct StaticOrder {
    int nM, nN, nwg, G, c;
    __host__ __device__ void init(int M, int N, int G_, int c_) { nM = M / BM; nN = N / BM; nwg = nM * nN; G = G_; c = c_; }
    __host__ __device__ bool next(int i, Unit& u) const {
        const long L = (long)i * G + c; if (L >= nwg) return false;
        int wgid = (int)L; { const int q = nwg / NXCD, r = nwg % NXCD, xcd = wgid % NXCD, off = wgid / NXCD; wgid = (xcd < r ? xcd * (q + 1) : r * (q + 1) + (xcd - r) * q) + off; }
        const int nig = WGM * nN, gid = wgid / nig, fm = gid * WGM, gsz = (nM - fm) < WGM ? (nM - fm) : WGM;
        u.pm = fm + ((wgid % nig) % gsz); u.pn = (wgid % nig) / gsz; u.e = 0; return true;
    }
    __device__ __forceinline__ void a_ready(const Unit&) const {}
    __device__ __forceinline__ void done(const Unit&) const {}
};
__device__ __forceinline__ unsigned cvt_pk_bf16(float lo, float hi) { unsigned r; asm volatile("v_cvt_pk_bf16_f32 %0, %1, %2" : "=v"(r) : "v"(lo), "v"(hi)); return r; }
typedef float f32x2 __attribute__((ext_vector_type(2)));
__device__ __forceinline__ f32x2 gelu_pk(f32x2 v) {
    const f32x2 av = __builtin_elementwise_abs(v), d = av * 0.2316418882f + 1.0f;
    f32x2 t; t.x = __builtin_amdgcn_rcpf(d.x); t.y = __builtin_amdgcn_rcpf(d.y);
    f32x2 q = t * 0.5307027145f + (-0.7265760135f); q = q * t + 0.7107068705f; q = q * t + (-0.142248368f); q = q * t + 0.127414796f; q = q * t;
    const f32x2 s = (v * v) * (-0.72134752044f);
    f32x2 e; e.x = __builtin_amdgcn_exp2f(s.x); e.y = __builtin_amdgcn_exp2f(s.y);
    const f32x2 m = v * (q * e), r = v - m;
    f32x2 o; o.x = v.x < 0.f ? m.x : r.x; o.y = v.y < 0.f ? m.y : r.y; return o;
}

struct EpiF32 {
    static constexpr bool PERM = false, AFTER_DRAIN = false;
    float* C; int ldc; const float* bias;
    __device__ __forceinline__ void operator()(const f32x4 (&acc)[2][2][4][2], const Unit& u, int wr, int wc, int fr, int fq) const {
        const int row0 = u.pm * BM + wr * 64 + fr, col0 = u.pn * BM + wc * 32 + 4 * fq;
        f32x4 bv[2][2];
#pragma unroll
        for (int bj = 0; bj < 2; ++bj)
#pragma unroll
            for (int n = 0; n < 2; ++n) bv[bj][n] = bias ? *(const f32x4*)(bias + col0 + bj * HALF + n * 16) : (f32x4){0.f, 0.f, 0.f, 0.f};
#pragma unroll
        for (int ai = 0; ai < 2; ++ai)
#pragma unroll
            for (int m = 0; m < 4; ++m) { float* rowp = C + (size_t)(row0 + ai * HALF + m * 16) * ldc + col0;
#pragma unroll
                for (int bj = 0; bj < 2; ++bj)
#pragma unroll
                    for (int n = 0; n < 2; ++n) *(f32x4*)(rowp + bj * HALF + n * 16) = acc[ai][bj][m][n] + bv[bj][n]; }
    }
};
template <int ACT  > struct EpiBf16 {
    static constexpr bool PERM = true, AFTER_DRAIN = false;
    bf16_t* O; int ldc; const float* bias; int split_cols; size_t split_stride;
    __device__ __forceinline__ void operator()(const f32x4 (&acc)[2][2][4][2], const Unit& u, int wr, int wc, int fr, int fq) const {
        const int row0 = u.pm * BM + wr * 64 + fr; int colt = u.pn * BM; bf16_t* base = O;
        if (split_cols) { const int t = colt / split_cols; base += (size_t)t * split_stride; colt -= t * split_cols; }
        const int col0 = colt + wc * 32 + 8 * fq, bcol0 = u.pn * BM + wc * 32 + 8 * fq;
        f32x4 bv[2][2];
#pragma unroll
        for (int bj = 0; bj < 2; ++bj)
#pragma unroll
            for (int n = 0; n < 2; ++n) bv[bj][n] = bias ? *(const f32x4*)(bias + bcol0 + bj * HALF + 4 * n) : (f32x4){0.f, 0.f, 0.f, 0.f};
#pragma unroll
        for (int ai = 0; ai < 2; ++ai)
#pragma unroll
            for (int m = 0; m < 4; ++m) { bf16_t* rowp = base + (size_t)(row0 + ai * HALF + m * 16) * ldc + col0;
#pragma unroll
                for (int bj = 0; bj < 2; ++bj) { f32x4 v0 = acc[ai][bj][m][0] + bv[bj][0], v1 = acc[ai][bj][m][1] + bv[bj][1];
                    if (ACT == 1) { f32x2 a = gelu_pk((f32x2){v0[0], v0[1]}), b = gelu_pk((f32x2){v0[2], v0[3]}), c = gelu_pk((f32x2){v1[0], v1[1]}), d = gelu_pk((f32x2){v1[2], v1[3]});
                        v0 = (f32x4){a.x, a.y, b.x, b.y}; v1 = (f32x4){c.x, c.y, d.x, d.y}; }
                    if (ACT == 2) {
#pragma unroll
                        for (int j = 0; j < 4; ++j) { v0[j] = 0.5f * v0[j] * (1.0f + erff(v0[j] * 0.70710678f)); v1[j] = 0.5f * v1[j] * (1.0f + erff(v1[j] * 0.70710678f)); } }
                    u32x4 w; w.x = cvt_pk_bf16(v0[0], v0[1]); w.y = cvt_pk_bf16(v0[2], v0[3]); w.z = cvt_pk_bf16(v1[0], v1[1]); w.w = cvt_pk_bf16(v1[2], v1[3]);
                    *(u32x4*)(rowp + bj * HALF) = w; } }
    }
};

template <class Epi, class Sched, bool STAMP = false>
__device__ __forceinline__ void gemm_phase(PG8_LAS unsigned char* lds, const Gemm g, const Sched& S, const Epi& E, unsigned long long* stamps) {
    int tid_ = threadIdx.x; asm volatile("" : "+v"(tid_));
    const int tid = tid_, wid = __builtin_amdgcn_readfirstlane(tid >> 6), lane = tid & 63, wr = wid >> 2, wc = wid & 3, fr = lane & 15, fq = lane >> 4;
    const int K = g.K, nt = K / BK;
    int ts_lo = 0, ts_hi = 0, nts = 0; const unsigned long long rt_entry = STAMP ? (unsigned long long)wall_clock64() : 0ull;
#define PG8_STAMP() do { if (STAMP && wid == 0 && nts < 64) { const unsigned long long _c = (unsigned long long)clock64(); \
        ts_lo = (lane == nts) ? (int)(unsigned)_c : ts_lo; ts_hi = (lane == nts) ? (int)(unsigned)(_c >> 32) : ts_hi; ++nts; } } while (0)
    PG8_STAMP();
    unsigned voffA[2], voffB[2];
#pragma unroll
    for (int i = 0; i < 2; ++i) { int R, C; stage_rc(tid * 16 + i * 8192, R, C); const int Rb = Epi::PERM ? ((R & ~31) + perm32(R & 31)) : R;
        voffA[i] = (unsigned)(R * K + C) * 2u; voffB[i] = (unsigned)(Rb * K + C) * 2u; }
    const size_t kstep = (size_t)(BK * 2);
    const size_t hstep = (size_t)HALF * K * 2;
    const size_t tstep = 2 * hstep;
    const unsigned ldsw = (unsigned)wid * 1024u;
    const int aoff = lds_byte(wr * 64 + fr, fq * 8), boff = lds_byte(wc * 32 + fr, fq * 8);
#define PG8_SA(b, h) (((b) * 2 + (h)) * HTB)
#define PG8_SB(b, h) ((4 + (b) * 2 + (h)) * HTB)
#define PG8_STAGE(bufoff, gbase, voff) do { _Pragma("unroll") for (int _i = 0; _i < 2; ++_i) \
        __builtin_amdgcn_global_load_lds((const unsigned*)((const char*)(gbase) + (voff)[_i]), (PG8_LAS unsigned*)(lds + (bufoff) + ldsw + _i * 8192), 16, 0, 0); } while (0)
#define PG8_LDA(dst, b, h) do { _Pragma("unroll") for (int m = 0; m < 4; ++m) _Pragma("unroll") for (int k = 0; k < 2; ++k) dst[m][k] = *(const PG8_LAS bf16x8*)(lds + PG8_SA(b, h) + aoff + m * 2048 + k * 1024); } while (0)
#define PG8_LDB(dst, b, h) do { _Pragma("unroll") for (int n = 0; n < 2; ++n) _Pragma("unroll") for (int k = 0; k < 2; ++k) dst[n][k] = *(const PG8_LAS bf16x8*)(lds + PG8_SB(b, h) + boff + n * 2048 + k * 1024); } while (0)
#define PG8_MMA(ai, bj, At, Bt) do { __builtin_amdgcn_s_setprio(1); _Pragma("unroll") for (int m = 0; m < 4; ++m) _Pragma("unroll") for (int n = 0; n < 2; ++n) _Pragma("unroll") for (int k = 0; k < 2; ++k) \
        acc[ai][bj][m][n] = __builtin_amdgcn_mfma_f32_16x16x32_bf16(Bt[n][k], At[m][k], acc[ai][bj][m][n], 0, 0, 0); __builtin_amdgcn_s_setprio(0); } while (0)
#define PG8_WAIT_V(n) asm volatile("s_waitcnt vmcnt(" #n ")" ::: "memory")
#define PG8_WAIT_L(n) asm volatile("s_waitcnt lgkmcnt(" #n ")" ::: "memory")
#define PG8_BAR __builtin_amdgcn_s_barrier()
#define PG8_SCHED __builtin_amdgcn_sched_barrier(0)
    Unit cur, nxt; int ui = 0;
    if (!S.next(0, cur)) return;
    f32x4 acc[2][2][4][2];
#pragma unroll
    for (int a = 0; a < 2; ++a)
#pragma unroll
        for (int b = 0; b < 2; ++b)
#pragma unroll
            for (int m = 0; m < 4; ++m)
#pragma unroll
                for (int n = 0; n < 2; ++n) acc[a][b][m][n] = (f32x4){0.f, 0.f, 0.f, 0.f};
    bf16x8 At[4][2], B0[2][2], B1[2][2];
    const char* cA = (const char*)g.A + (size_t)cur.pm * tstep; const char* cB = (const char*)g.Bt + (size_t)cur.pn * tstep + (size_t)cur.e * g.estride * 2;
    S.a_ready(cur);
    PG8_STAGE(PG8_SB(0, 0), cB, voffB); PG8_STAGE(PG8_SA(0, 0), cA, voffA); PG8_STAGE(PG8_SB(0, 1), cB + hstep, voffB); PG8_STAGE(PG8_SA(0, 1), cA + hstep, voffA);
    if (wr == 1) PG8_BAR;
    PG8_WAIT_V(4); PG8_BAR;
    PG8_STAGE(PG8_SB(1, 0), cB + kstep, voffB); PG8_STAGE(PG8_SA(1, 0), cA + kstep, voffA); PG8_STAGE(PG8_SB(1, 1), cB + hstep + kstep, voffB);
    PG8_WAIT_V(6); PG8_BAR;
    PG8_STAMP();
    for (;;) {
        const bool has_next = S.next(ui + 1, nxt);
        const char* nA = has_next ? (const char*)g.A + (size_t)nxt.pm * tstep : cA; const char* nB = has_next ? (const char*)g.Bt + (size_t)nxt.pn * tstep + (size_t)nxt.e * g.estride * 2 : cB;
        for (int t = 0; t < nt; t += 2) {
            const bool last = (t == nt - 2);
            const char* a1 = cA + (size_t)(t + 1) * kstep;
            const char* a2 = last ? nA : cA + (size_t)(t + 2) * kstep; const char* b2 = last ? nB : cB + (size_t)(t + 2) * kstep;
            const char* a3 = a2 + kstep; const char* b3 = b2 + kstep;
            if (last && has_next) S.a_ready(nxt);
            PG8_LDB(B0, 0, 0); PG8_SCHED; PG8_LDA(At, 0, 0); PG8_STAGE(PG8_SA(1, 1), a1 + hstep, voffA);
            PG8_WAIT_L(8); PG8_BAR; PG8_WAIT_L(0); PG8_MMA(0, 0, At, B0); PG8_BAR; PG8_SCHED;
            PG8_LDB(B1, 0, 1); PG8_STAGE(PG8_SB(0, 0), b2, voffB);
            PG8_BAR; PG8_WAIT_L(0); PG8_MMA(0, 1, At, B1); PG8_BAR;
            PG8_LDA(At, 0, 1); PG8_STAGE(PG8_SA(0, 0), a2, voffA);
            PG8_BAR; PG8_WAIT_L(0); PG8_MMA(1, 0, At, B0); PG8_BAR; PG8_SCHED;
            PG8_STAGE(PG8_SB(0, 1), b2 + hstep, voffB);
            PG8_WAIT_V(6); PG8_BAR; PG8_MMA(1, 1, At, B1); PG8_BAR;
            PG8_LDB(B0, 1, 0); PG8_SCHED; PG8_LDA(At, 1, 0); PG8_STAGE(PG8_SA(0, 1), a2 + hstep, voffA);
            PG8_WAIT_L(8); PG8_BAR; PG8_WAIT_L(0); PG8_MMA(0, 0, At, B0); PG8_BAR; PG8_SCHED;
            PG8_LDB(B1, 1, 1); PG8_STAGE(PG8_SB(1, 0), b3, voffB);
            PG8_BAR; PG8_WAIT_L(0); PG8_MMA(0, 1, At, B1); PG8_BAR;
            PG8_LDA(At, 1, 1); PG8_STAGE(PG8_SA(1, 0), a3, voffA);
            PG8_BAR; PG8_WAIT_L(0); PG8_MMA(1, 0, At, B0); PG8_BAR; PG8_SCHED;
            PG8_STAGE(PG8_SB(1, 1), b3 + hstep, voffB);
            PG8_WAIT_V(6); PG8_BAR; PG8_MMA(1, 1, At, B1); PG8_BAR;
        }
        PG8_STAMP();
        if constexpr (!Epi::AFTER_DRAIN) { E(acc, cur, wr, wc, fr, fq); S.done(cur); }
        PG8_STAMP();
        if (!has_next) break;
#pragma unroll
        for (int a = 0; a < 2; ++a)
#pragma unroll
            for (int b = 0; b < 2; ++b)
#pragma unroll
                for (int m = 0; m < 4; ++m)
#pragma unroll
                    for (int n = 0; n < 2; ++n) acc[a][b][m][n] = (f32x4){0.f, 0.f, 0.f, 0.f};
        cur = nxt; cA = nA; cB = nB; ++ui;
    }
    PG8_WAIT_V(0);
    if (wr == 0) PG8_BAR;
    PG8_BAR;
    if constexpr (Epi::AFTER_DRAIN) { E.fused(acc, cur, wr, wc, fr, fq, lds, wid, lane); S.done(cur); }
    PG8_STAMP();
    if (STAMP && wid == 0) { stamps[lane] = lane < nts ? (((unsigned long long)(unsigned)ts_hi << 32) | (unsigned)ts_lo) : 0ull;
        if (lane == 62) stamps[62] = rt_entry; if (lane == 63) stamps[63] = (unsigned long long)wall_clock64(); }
#undef PG8_STAMP
#undef PG8_SA
#undef PG8_SB
#undef PG8_STAGE
#undef PG8_LDA
#undef PG8_LDB
#undef PG8_MMA
#undef PG8_WAIT_V
#undef PG8_WAIT_L
#undef PG8_BAR
#undef PG8_SCHED
}
}
namespace pg8 {
struct EpiRes {
    static constexpr bool PERM = false, AFTER_DRAIN = false;
    const float* base_lat; const float* base_ctx; float* out_lat; float* out_ctx; const float* gvec;
    __device__ __forceinline__ void operator()(const f32x4 (&acc)[2][2][4][2], const Unit& u, int wr, int wc, int fr, int fq) const {
        const bool isctx = u.pm >= 128;
        const int prow = (isctx ? (u.pm - 128) : u.pm) * BM;
        const float* base = isctx ? base_ctx : base_lat; float* out = isctx ? out_ctx : out_lat;
        const float* gv = gvec + (size_t)(isctx ? 8 : (u.pm >> 4)) * 6144;
        const int row0 = prow + wr * 64 + fr, col0 = u.pn * BM + wc * 32 + 4 * fq;
        f32x4 gvv[2][2];
#pragma unroll
        for (int bj = 0; bj < 2; ++bj)
#pragma unroll
            for (int n = 0; n < 2; ++n) gvv[bj][n] = *(const f32x4*)(gv + col0 + bj * HALF + n * 16);
#pragma unroll
        for (int ai = 0; ai < 2; ++ai)
#pragma unroll
            for (int m = 0; m < 4; ++m) { const size_t off = (size_t)(row0 + ai * HALF + m * 16) * 1024 + col0;
#pragma unroll
                for (int bj = 0; bj < 2; ++bj)
#pragma unroll
                    for (int n = 0; n < 2; ++n) { const f32x4 b = *(const f32x4*)(base + off + bj * HALF + n * 16);
                        *(f32x4*)(out + off + bj * HALF + n * 16) = b + gvv[bj][n] * acc[ai][bj][m][n]; } }
    }
};
struct EpiSwiglu {
    static constexpr bool PERM = true, AFTER_DRAIN = false;
    bf16_t* O; int ldc;
    __device__ __forceinline__ void operator()(const f32x4 (&acc)[2][2][4][2], const Unit& u, int wr, int wc, int fr, int fq) const {
        const int row0 = u.pm * BM + wr * 64 + fr, col0 = u.pn * HALF + wc * 32 + 8 * fq;
#pragma unroll
        for (int ai = 0; ai < 2; ++ai)
#pragma unroll
            for (int m = 0; m < 4; ++m) { bf16_t* rowp = O + (size_t)(row0 + ai * HALF + m * 16) * ldc + col0;
                float h[8];
#pragma unroll
                for (int n = 0; n < 2; ++n)
#pragma unroll
                    for (int j = 0; j < 4; ++j) { const float g = acc[ai][0][m][n][j], up = acc[ai][1][m][n][j]; h[n * 4 + j] = g * __builtin_amdgcn_rcpf(1.0f + __expf(-g)) * up; }
                u32x4 w; w.x = cvt_pk_bf16(h[0], h[1]); w.y = cvt_pk_bf16(h[2], h[3]); w.z = cvt_pk_bf16(h[4], h[5]); w.w = cvt_pk_bf16(h[6], h[7]);
                *(u32x4*)rowp = w; }
    }
};
struct MoeOrder {
    int nN, G, c, nunits; const int* tab;
    __device__ void init(const int* tab_, int nN_, int G_, int c_) { tab = tab_; nN = nN_; G = G_; c = c_; nunits = tab_[0] * nN_; }
    __device__ bool next(int i, Unit& u) const {
        const int L = i * G + c; if (L >= nunits) return false;
        u.pm = L / nN; u.pn = L - u.pm * nN; u.e = tab[1 + u.pm]; return true;
    }
    __device__ __forceinline__ void a_ready(const Unit&) const {}
    __device__ __forceinline__ void done(const Unit&) const {}
};
}
enum { I_X = 0, I_C, I_CTX, I_CCTX, I_MODW, I_MODB, I_NMIXG, I_NFFNG, I_WIN, I_WOUT, I_LCW, I_LCB, I_LWA, I_LBA, I_LWX, I_LBX, I_LLAM,
       I_RMU, I_RWUP, I_RW0, I_RAUP, I_RA0, I_RGUP, I_RKK, I_RKA, I_RRK, I_RLNG, I_RLNB, I_MIB, I_MFB, I_MNG, I_GCW, I_GALOG, I_GDTB, I_GNG,
       I_FWG, I_FWU, I_FWD, I_MROUTER, I_MWG, I_MWU, I_MWD, I_FNG, N_IN };
struct Args { const float* in[N_IN]; float* out; unsigned char* ws; int ph_lo, ph_hi; };
struct Ctx {
    const float* const* in; float* out; unsigned char* ws; LAS unsigned char* lds;
    int tid, lane, wave, G, wg;
};
#define WSP(T, off) ((T*)(C.ws + (off)))

__device__ __forceinline__ int seqrow_raster(int i, int d, int b) {
    if (i < CTXL) { const int p = d ? (CTXL - 1 - i) : i; return T_LAT + b * CTXL + p; }
    const int j = i - CTXL; const int p = d ? (SEQ - 1 - j) : j; return b * SEQ + p;
}
__device__ __forceinline__ int seqrow_cm(int i, int d, int b) {
    if (i < CTXL) { const int p = d ? (CTXL - 1 - i) : i; return T_LAT + b * CTXL + p; }
    const int j = i - CTXL; const int p = d ? (SEQ - 1 - j) : j; return b * SEQ + (p & 63) * 64 + (p >> 6);
}

__device__ __forceinline__ void phase_pre(const Ctx& C) {
    LAS float* sc = (LAS float*)C.lds;
    LAS float* red = sc + 9 * 1024;
    float* modv = WSP(float, WS_MODV);
    bool filled = false;
    for (int it = C.wg; it < DEPTH * 48; it += C.G) {
        if (!filled) {
            for (int i = C.tid; i < 9 * 1024; i += NTHR) { const float v = i < 8192 ? C.in[I_C][i] : C.in[I_CCTX][i - 8192]; sc[i] = siluf_(v); }
            filled = true; __syncthreads();
        }
        const int l = it / 48, jb = it % 48, col = C.tid & 127, kg = C.tid >> 7;
        const float* W = C.in[I_MODW] + (size_t)l * 1024 * 6144 + jb * 128 + col;
        float acc[9];
#pragma unroll
        for (int r = 0; r < 9; ++r) acc[r] = 0.f;
        for (int k = kg * 256; k < kg * 256 + 256; ++k) { const float w = W[(size_t)k * 6144];
#pragma unroll
            for (int r = 0; r < 9; ++r) acc[r] += sc[r * 1024 + k] * w; }
#pragma unroll
        for (int r = 0; r < 9; ++r) red[(kg * 9 + r) * 128 + col] = acc[r];
        __syncthreads();
        for (int i = C.tid; i < 9 * 128; i += NTHR) { const int r = i >> 7, cc = i & 127;
            const float s = red[(0 * 9 + r) * 128 + cc] + red[(1 * 9 + r) * 128 + cc] + red[(2 * 9 + r) * 128 + cc] + red[(3 * 9 + r) * 128 + cc];
            modv[((size_t)l * 9 + r) * 6144 + jb * 128 + cc] = s + C.in[I_MODB][l * 6144 + jb * 128 + cc]; }
        __syncthreads();
    }
}

__device__ __forceinline__ void tr_item(const float* src, size_t ld, int k0, int ns0, bf16* dst, int drow0, int Kd, LAS float* scr, int lane, bool zero) {
    if (!zero) {
#pragma unroll 8
        for (int i = 0; i < 32; ++i) { const int kk = 2 * i + (lane >> 5); scr[kk * 33 + (lane & 31)] = src[(size_t)(k0 + kk) * ld + ns0 + (lane & 31)]; }
    }
    LDS_WAIT(); asm volatile("" ::: "memory");
    const int c = lane & 7;
#pragma unroll
    for (int j = 0; j < 4; ++j) { const int n = (lane >> 3) + 8 * j; const LAS float* s = scr + (8 * c) * 33 + n;
        v4u o; o.x = pk2(s[0 * 33], s[1 * 33]); o.y = pk2(s[2 * 33], s[3 * 33]); o.z = pk2(s[4 * 33], s[5 * 33]); o.w = pk2(s[6 * 33], s[7 * 33]);
        if (zero) o = (v4u){0u, 0u, 0u, 0u};
        *(v4u*)(dst + (size_t)(drow0 + n) * Kd + k0 + 8 * c) = o; }
    LDS_WAIT(); asm volatile("" ::: "memory");
}
__device__ __forceinline__ void convert_small(const Ctx& C, int l) {
    {
        bf16* lw = WSP(bf16, WS_LRUWT);
        for (int k = 0; k < 2 * 2 * 4 * 4096 / (128 * NTHR); ++k) {
            const int e = k * 128 * NTHR + C.wg * NTHR + C.tid;
            if (C.wg < 128) {
            const int i = e & 63, j = (e >> 6) & 63, hd = (e >> 12) & 3, g = (e >> 14) & 1, d = e >> 15;
            const float* src = (g ? C.in[I_LWX] : C.in[I_LWA]) + ((size_t)((l * 2 + d) * 4 + hd) * 64 + i) * 64 + j;
            lw[e] = (bf16)f2bf(*src);
            }
        }
    }
    if (C.wg >= 128 && C.wg < 224) {
        bf16* rw = WSP(bf16, WS_RWT);
        const int e = (C.wg - 128) * NTHR + C.tid;
        if (e < 32768) { const int r = e & 31, ch = (e >> 5) & 255, d = (e >> 13) & 1, isa = e >> 14;
            rw[e] = (bf16)f2bf((isa ? C.in[I_RAUP] : C.in[I_RWUP])[((size_t)(l * 2 + d) * 32 + r) * GW + ch]); }
        else { const int e2 = e - 32768, j = e2 & 63, ch = e2 >> 6; rw[e] = (bf16)f2bf(C.in[I_RGUP][((size_t)l * 64 + j) * GW + ch]); }
    }
}
__device__ __forceinline__ void convert_items(const Ctx& C, int l, int what, int gw, int NGW) {
    LAS float* scr = (LAS float*)(C.lds + C.wave * 8704);
    constexpr int I_IN = 16 * 112, I_OUT = 16 * 32, I_GU = 16 * 176, I_DN = 44 * 32, I_E = 16 * 88 + 22 * 32;
    const bool moe = l & 1; const int li = l >> 1;
    const int lo_it = (what & 1) ? 0 : I_IN, hi_it = (what & 2) ? I_IN + I_OUT + (moe ? NE * I_E : (I_GU + I_DN)) : I_IN;
    bf16* win = WSP(bf16, WS_WIN); bf16* wout = WSP(bf16, WS_WOUT); bf16* wgu = WSP(bf16, WS_WGU); bf16* wdn = WSP(bf16, WS_WDN);
    for (int it = lo_it + gw; it < hi_it; it += NGW) {
        int r = it;
        if (r < I_IN) { const int kb = r / 112, nb = r % 112; tr_item(C.in[I_WIN] + (size_t)l * 1024 * IN_COLS, IN_COLS, 64 * kb, 32 * nb, win, 32 * nb, 1024, scr, C.lane, nb == 111); continue; }
        r -= I_IN;
        if (r < I_OUT) { const int kb = r / 32, nb = r % 32; tr_item(C.in[I_WOUT] + (size_t)l * 1024 * 1024, 1024, 64 * kb, 32 * nb, wout, 32 * nb, 1024, scr, C.lane, false); continue; }
        r -= I_OUT;
        if (!moe) {
            if (r < I_GU) { const int kb = r / 176, nb = r % 176, tile = nb >> 3, q = nb & 7;
                const float* src = (q < 4 ? C.in[I_FWG] : C.in[I_FWU]) + (size_t)li * 1024 * DFF;
                tr_item(src, DFF, 64 * kb, tile * 128 + (q & 3) * 32, wgu, 32 * nb, 1024, scr, C.lane, false); continue; }
            r -= I_GU;
            { const int kb = r / 32, nb = r % 32; tr_item(C.in[I_FWD] + (size_t)li * DFF * 1024, 1024, 64 * kb, 32 * nb, wdn, 32 * nb, DFF, scr, C.lane, false); }
        } else {
            const int e = r / I_E; int rr = r % I_E;
            if (rr < 16 * 88) { const int kb = rr / 88, nb = rr % 88, tile = nb >> 3, q = nb & 7;
                const float* src = (q < 4 ? C.in[I_MWG] : C.in[I_MWU]) + ((size_t)li * NE + e) * 1024 * DFE;
                tr_item(src, DFE, 64 * kb, tile * 128 + (q & 3) * 32, wgu + (size_t)e * 2 * DFE * 1024, 32 * nb, 1024, scr, C.lane, false); continue; }
            rr -= 16 * 88;
            { const int kb = rr / 32, nb = rr % 32; tr_item(C.in[I_MWD] + ((size_t)li * NE + e) * DFE * 1024, 1024, 64 * kb, 32 * nb, wdn + (size_t)e * 1024 * DFE, 32 * nb, DFE, scr, C.lane, false); }
        }
    }
}

template <bool ROUTE>
__device__ __forceinline__ void norm_rows(const Ctx& C, int l, const float* xlat, const float* xctx, const float* gain, int shoff, int scoff, int nrows, int moe_li) {
    const float* modv = WSP(float, WS_MODV) + (size_t)l * 9 * 6144;
    bf16* hb = WSP(bf16, WS_HB);
    const int gw = C.wg * NWAVES + C.wave, NGW = C.G * NWAVES;
    LAS unsigned* lcnt = (LAS unsigned*)(C.lds + 65536);
    unsigned* route = WSP(unsigned, WS_ROUTE);
    if (ROUTE) { if (C.tid < 8) lcnt[C.tid] = 0u; __syncthreads(); }
    f32x4 gv[4];
#pragma unroll
    for (int j = 0; j < 4; ++j) gv[j] = *(const f32x4*)(gain + 4 * C.lane + 256 * j);
    for (int m = gw; m < nrows; m += NGW) {
        const bool isctx = m >= T_LAT;
        const float* xr = isctx ? xctx + (size_t)(m - T_LAT) * 1024 : xlat + (size_t)m * 1024;
        const float* mv = modv + (size_t)(isctx ? 8 : (m >> 12)) * 6144;
        f32x4 v[4]; float s = 0.f;
#pragma unroll
        for (int j = 0; j < 4; ++j) { v[j] = *(const f32x4*)(xr + 4 * C.lane + 256 * j); s += (v[j].x * v[j].x + v[j].y * v[j].y) + (v[j].z * v[j].z + v[j].w * v[j].w); }
        const float rs = rsqrtf_(wave_sum(s) * (1.0f / 1024.0f) + 1e-6f);
#pragma unroll
        for (int j = 0; j < 4; ++j) { const f32x4 sh = *(const f32x4*)(mv + shoff + 4 * C.lane + 256 * j), scl = *(const f32x4*)(mv + scoff + 4 * C.lane + 256 * j);
            v[j] = (v[j] * rs * gv[j]) * (scl + 1.0f) + sh;
            v2u o; o.x = pk2(v[j].x, v[j].y); o.y = pk2(v[j].z, v[j].w);
            *(v2u*)(hb + (size_t)m * 1024 + 4 * C.lane + 256 * j) = o; }
        if (ROUTE) {
            const float* rt = C.in[I_MROUTER] + (size_t)moe_li * 1024 * NE;
            float lg[8];
#pragma unroll
            for (int e = 0; e < 8; ++e) lg[e] = 0.f;
#pragma unroll
            for (int j = 0; j < 4; ++j)
#pragma unroll
                for (int q = 0; q < 4; ++q) { const int k = 4 * C.lane + 256 * j + q; const f32x4 r0 = *(const f32x4*)(rt + (size_t)k * 8), r1 = *(const f32x4*)(rt + (size_t)k * 8 + 4); const float hv = v[j][q];
                    lg[0] += hv * r0.x; lg[1] += hv * r0.y; lg[2] += hv * r0.z; lg[3] += hv * r0.w; lg[4] += hv * r1.x; lg[5] += hv * r1.y; lg[6] += hv * r1.z; lg[7] += hv * r1.w; }
#pragma unroll
            for (int e = 0; e < 8; ++e) lg[e] = wave_sum(lg[e]);
            int e0 = 0; float l0 = lg[0];
#pragma unroll
            for (int e = 1; e < 8; ++e) if (lg[e] > l0) { l0 = lg[e]; e0 = e; }
            int e1 = (e0 == 0) ? 1 : 0; float l1 = -3.0e38f;
#pragma unroll
            for (int e = 0; e < 8; ++e) if (e != e0 && lg[e] > l1) { l1 = lg[e]; e1 = e; }
            const float w0 = __builtin_amdgcn_rcpf(1.0f + __expf(l1 - l0)), w1 = 1.0f - w0;
            if (C.lane == 0) {
                const unsigned r0 = atomicAdd((unsigned*)&lcnt[e0], 1u), r1 = atomicAdd((unsigned*)&lcnt[e1], 1u);
                v4u a; a.x = (unsigned)e0; a.y = (unsigned)e1; a.z = r0; a.w = r1;
                *(v4u*)(route + (size_t)m * 8) = a;
                v2u b; b.x = __builtin_bit_cast(unsigned, w0); b.y = __builtin_bit_cast(unsigned, w1);
                *(v2u*)(route + (size_t)m * 8 + 4) = b;
            }
        }
    }
    if (ROUTE) {
        __syncthreads();
        if (C.tid < 8) { unsigned* gc = WSP(unsigned, WS_CTL) + CW_MOECNT + 64 * moe_li; const unsigned base = atomicAdd(gc + C.tid, lcnt[C.tid]); WSP(unsigned, WS_WGBASE)[C.wg * 8 + C.tid] = base; }
    }
}
__device__ __forceinline__ void lru_carry(const Ctx& C, int idx) {
    const int ch = idx & 255, d = (idx >> 8) & 1, b = idx >> 9;
    const float* ls = WSP(const float, WS_LSUM); float* hin = WSP(float, WS_HIN);
    float H = 0.f;
    for (int k = 0; k < NCH; ++k) {
        const int c = d ? (k < 4 ? 3 - k : NCH + 3 - k) : k;
        const size_t sidx = ((size_t)(b * NCH + c) * 2 + d) * 256 + ch;
        hin[sidx] = H;
        H = __expf(ls[sidx * 2]) * H + ls[sidx * 2 + 1];
    }
}

#define RAW_BARRIER() do { asm volatile("s_waitcnt lgkmcnt(0)" ::: "memory"); __builtin_amdgcn_s_barrier(); asm volatile("" ::: "memory"); } while (0)
__device__ __forceinline__ void gdn_prep(const Ctx& C, int l, int b, int c) {
    const bf16* P = WSP(const bf16, WS_P); bf16* gq = WSP(bf16, WS_GQ);
    const bool isctx = c < 4; const int p0 = isctx ? c * 64 : (c - 4) * 64; const int Lp = isctx ? CTXL : SEQ;
    const int ch = 4 * C.lane;
    auto rowof = [&](int p) -> int { return isctx ? (T_LAT + b * CTXL + p) : (b * SEQ + (p & 63) * 64 + (p >> 6)); };
    f32x4 cw[4][3], x[4][3];
#pragma unroll
    for (int j = 0; j < 4; ++j)
#pragma unroll
        for (int g = 0; g < 3; ++g) cw[j][g] = *(const f32x4*)(C.in[I_GCW] + ((size_t)l * 4 + j) * 768 + g * 256 + ch);
    const int tb = p0 + C.wave * 8;
    auto ldrow = [&](int p, f32x4 (&dst)[3]) {
        if (p >= 0 && p < Lp) { const bf16* pr = P + (size_t)rowof(p) * PLD + OFF_D + ch;
#pragma unroll
            for (int g = 0; g < 3; ++g) dst[g] = ld4bf(pr + g * 256); }
        else {
#pragma unroll
            for (int g = 0; g < 3; ++g) dst[g] = (f32x4){0.f, 0.f, 0.f, 0.f}; }
    };
    ldrow(tb - 2, x[0]); ldrow(tb - 1, x[1]); ldrow(tb, x[2]);
#pragma unroll
    for (int t = 0; t < 8; ++t) {
        ldrow(tb + t + 1, x[3]);
        bf16* orow = gq + (size_t)rowof(tb + t) * 768 + ch;
#pragma unroll
        for (int g = 0; g < 3; ++g) {
            f32x4 v = cw[0][g] * x[0][g] + cw[1][g] * x[1][g] + cw[2][g] * x[2][g] + cw[3][g] * x[3][g];
            v = (f32x4){siluf_(v.x), siluf_(v.y), siluf_(v.z), siluf_(v.w)};
            if (g < 2) { const float ss = row16_sum((v.x * v.x + v.y * v.y) + (v.z * v.z + v.w * v.w)); v = v * (rsqrtf_(ss + 1e-6f) * (g == 0 ? 0.125f : 1.0f)); }
            st4bf(orow + g * 256, v);
        }
#pragma unroll
        for (int g = 0; g < 3; ++g) { x[0][g] = x[1][g]; x[1][g] = x[2][g]; x[2][g] = x[3][g]; }
    }
}
__device__ __forceinline__ void finish_rows(const Ctx& C, int l, int nrows) {
    const bf16* P = WSP(const bf16, WS_P); bf16* yc = WSP(bf16, WS_HB);
    const bf16* ob = WSP(const bf16, WS_OUTB); const bf16* oc = WSP(const bf16, WS_OUTC); const bf16* od = WSP(const bf16, WS_OUTD);
    const bf16* gg = WSP(const bf16, WS_G); const float* bonus = WSP(const float, WS_BONUS);
    const float* mu = C.in[I_RMU] + (size_t)l * 2 * B_COLS;
    const int gw = C.wg * NWAVES + C.wave, NGW = C.G * NWAVES, lane = C.lane, ch = 4 * lane, hh = lane >> 4;
    const f32x4 lng = *(const f32x4*)(C.in[I_RLNG] + l * GW + ch), lnb = *(const f32x4*)(C.in[I_RLNB] + l * GW + ch);
    const f32x4 mng = *(const f32x4*)(C.in[I_MNG] + l * GW + ch), gng = *(const f32x4*)(C.in[I_GNG] + l * GW + ch);
    const f32x4 mu0 = *(const f32x4*)(mu + 512 + ch), mu1 = *(const f32x4*)(mu + B_COLS + 512 + ch);
    const size_t o2 = (size_t)T_ALL * 256;
#pragma unroll 2
    for (int m = gw; m < nrows; m += NGW) {
        const bool isctx = m >= T_LAT; const int Lp = isctx ? CTXL : SEQ; const int p = isctx ? ((m - T_LAT) & (CTXL - 1)) : (m & (SEQ - 1));
        const f32x4 yb = ld4bf(ob + (size_t)m * 256 + ch) + ld4bf(ob + o2 + (size_t)m * 256 + ch);
        const f32x4 ycv = ld4bf(oc + (size_t)m * 256 + ch) + ld4bf(oc + o2 + (size_t)m * 256 + ch);
        const f32x4 yd = ld4bf(od + (size_t)m * 256 + ch) + ld4bf(od + o2 + (size_t)m * 256 + ch);
        const bf16* pr = P + (size_t)m * PLD;
        const f32x4 vs = ld4bf(WSP(const bf16, WS_RKV) + (size_t)m * 768 + 512 + ch);
        const f32x4 og = ld4bf(pr + OFF_C + 768 + ch), gd = ld4bf(pr + OFF_D + 768 + ch), gr = ld4bf(gg + (size_t)m * 256 + ch);
        const float bn = bonus[(size_t)m * 4 + hh];
        *(v2u*)(yc + (size_t)m * 1024 + ch) = *(const v2u*)(pr + 256 + ch);
        {
            const float mean = row16_sum((yb.x + yb.y) + (yb.z + yb.w)) * (1.0f / 64.0f);
            const f32x4 dl = yb - mean;
            const float var = row16_sum((dl.x * dl.x + dl.y * dl.y) + (dl.z * dl.z + dl.w * dl.w)) * (1.0f / 64.0f);
            const f32x4 yn = dl * rsqrtf_(var + 64e-5f) * lng + lnb;
            st4bf(yc + (size_t)m * 1024 + 256 + ch, (yn + vs * bn) * gr);
        }
        {
            const float ms = row16_sum((ycv.x * ycv.x + ycv.y * ycv.y) + (ycv.z * ycv.z + ycv.w * ycv.w)) * (1.0f / 64.0f);
            const f32x4 sg = (f32x4){sigmoidf_(og.x), sigmoidf_(og.y), sigmoidf_(og.z), sigmoidf_(og.w)};
            st4bf(yc + (size_t)m * 1024 + 512 + ch, ycv * rsqrtf_(ms + 1e-6f) * mng * sg);
        }
        {
            const float ms = row16_sum((yd.x * yd.x + yd.y * yd.y) + (yd.z * yd.z + yd.w * yd.w)) * (1.0f / 64.0f);
            const f32x4 sg = (f32x4){siluf_(gd.x), siluf_(gd.y), siluf_(gd.z), siluf_(gd.w)};
            st4bf(yc + (size_t)m * 1024 + 768 + ch, yd * rsqrtf_(ms + 1e-6f) * gng * sg);
        }
    }
}
typedef bf16x8 fragb;
__device__ __forceinline__ f32x4 mfma16(fragb a, fragb b, f32x4 c) { return __builtin_amdgcn_mfma_f32_16x16x32_bf16(a, b, c, 0, 0, 0); }
__device__ __forceinline__ fragb ld_frag16(const LAS bf16* p) { return *(const LAS fragb*)p; }
__device__ __forceinline__ fragb ld_frag8x2(const LAS bf16* p0, const LAS bf16* p1) {
    const v2u a = *(const LAS v2u*)p0, b = *(const LAS v2u*)p1; v4u r; r.x = a.x; r.y = a.y; r.z = b.x; r.w = b.y; return __builtin_bit_cast(fragb, r); }
__device__ __forceinline__ fragb pack_frag(const f32x4& lo, const f32x4& hi) { v4u r; r.x = pk2(lo.x, lo.y); r.y = pk2(lo.z, lo.w); r.z = pk2(hi.x, hi.y); r.w = pk2(hi.z, hi.w); return __builtin_bit_cast(fragb, r); }
__device__ __forceinline__ float wave_incl_sum(float v, int lane) {
    v += dpp_x<0x111, 0xF, true>(0.f, v); v += dpp_x<0x112, 0xF, true>(0.f, v); v += dpp_x<0x114, 0xF, true>(0.f, v); v += dpp_x<0x118, 0xF, true>(0.f, v);
    v += dpp_x<0x142, 0xA, false>(0.f, v); v += dpp_x<0x143, 0xC, false>(0.f, v);
    return v;
}
__device__ __forceinline__ float wave_incl_max(float v, int lane) {
    const float ninf = -3.0e38f;
    v = fmaxf(v, dpp_x<0x111, 0xF, false>(ninf, v)); v = fmaxf(v, dpp_x<0x112, 0xF, false>(ninf, v)); v = fmaxf(v, dpp_x<0x114, 0xF, false>(ninf, v)); v = fmaxf(v, dpp_x<0x118, 0xF, false>(ninf, v));
    v = fmaxf(v, dpp_x<0x142, 0xA, false>(ninf, v)); v = fmaxf(v, dpp_x<0x143, 0xC, false>(ninf, v));
    return v;
}
constexpr int MP = 72;
__device__ __forceinline__ void mlstm_chunked(const Ctx& C, int l, int idx) {
    const int d = idx >> 5, b = (idx >> 2) & 7, h = idx & 3, lane = C.lane, w = C.wave, l15 = lane & 15, q = lane >> 4;
    const int it = w & 3, vtp = w >> 2;
    constexpr int IMG = 64 * MP * 2, BUFB = 4 * IMG + 1024, CTB = 65 * MP * 2 + 16;
    LAS unsigned char* L0 = C.lds;
    const bf16* P = WSP(const bf16, WS_P); bf16* outc = WSP(bf16, WS_OUTC) + (size_t)d * T_ALL * 256;
    const float ib = C.in[I_MIB][(l * 2 + d) * NH + h], fb = C.in[I_MFB][(l * 2 + d) * NH + h];
    const int tt = C.tid >> 3, part = C.tid & 7;
    for (int i = C.tid; i < 2 * CTB / 4; i += NTHR) ((LAS unsigned*)(L0 + 2 * BUFB))[i] = 0u;
    v4u rq, rk, rv; unsigned short rgi, rgf;
    auto gload = [&](int n) {
        const int row = seqrow_cm(n * 64 + tt, d, b);
        const bf16* pp = P + (size_t)row * PLD + OFF_C + h * 64 + 8 * part;
        rq = *(const v4u*)pp; rk = *(const v4u*)(pp + 256); rv = *(const v4u*)(pp + 512);
        const bf16* pg = P + (size_t)seqrow_cm(n * 64 + lane, d, b) * PLD + OFF_C + 1024 + d * 4 + h;
        rgi = pg[0]; rgf = pg[8];
    };
    auto images = [&](int bufi) {
        LAS unsigned char* B0 = L0 + bufi * BUFB;
        LAS bf16* Qs = (LAS bf16*)B0; LAS bf16* Ks = Qs + 64 * MP; LAS bf16* VT = Ks + 64 * MP; LAS bf16* KTw = VT + 64 * MP; LAS float* vec = (LAS float*)(B0 + 4 * IMG);
        const float li = bf2f(rgi) + ib, lf = -softplusf_(-(bf2f(rgf) + fb));
        const float bc = wave_incl_sum(lf, lane), x = li - bc, cm = wave_incl_max(x, lane);
        const float wl = __expf(x - __shfl(cm, 63)) * 0.125f;
        if (w == 0) { vec[lane] = x; vec[64 + lane] = cm; vec[128 + lane] = bc; }
        const float wmine = __shfl(wl, 8 * w + (lane >> 3));
        *(LAS v4u*)(Qs + tt * MP + 8 * part) = rq; *(LAS v4u*)(Ks + tt * MP + 8 * part) = rk;
        const unsigned vv[4] = {rv.x, rv.y, rv.z, rv.w}, kk[4] = {rk.x, rk.y, rk.z, rk.w};
#pragma unroll
        for (int e = 0; e < 4; ++e) {
            VT[(8 * part + 2 * e) * MP + tt] = (bf16)(vv[e] & 0xffffu); VT[(8 * part + 2 * e + 1) * MP + tt] = (bf16)(vv[e] >> 16);
            KTw[(8 * part + 2 * e) * MP + tt] = (bf16)f2bf1(bflo(kk[e]) * wmine); KTw[(8 * part + 2 * e + 1) * MP + tt] = (bf16)f2bf1(bfhi(kk[e]) * wmine);
        }
    };
    f32x4 Cst[2], nst; float m = 0.f;
    Cst[0] = Cst[1] = nst = (f32x4){0.f, 0.f, 0.f, 0.f};
    const fragb ones = __builtin_bit_cast(fragb, (v4u){0x3F803F80u, 0x3F803F80u, 0x3F803F80u, 0x3F803F80u});
    const f32x4 z4 = (f32x4){0.f, 0.f, 0.f, 0.f};
    gload(0); images(0); gload(1);
#pragma unroll 1
    for (int n = 0; n < NCH; ++n) {
        RAW_BARRIER();
        const LAS unsigned char* B0 = L0 + (n & 1) * BUFB;
        const LAS bf16* Qs = (const LAS bf16*)B0; const LAS bf16* Ks = Qs + 64 * MP; const LAS bf16* VT = Ks + 64 * MP; const LAS bf16* KTw = VT + 64 * MP; const LAS float* vec = (const LAS float*)(B0 + 4 * IMG);
        const LAS bf16* CT = (const LAS bf16*)(L0 + 2 * BUFB + (n & 1) * CTB); LAS bf16* CTn = (LAS bf16*)(L0 + 2 * BUFB + ((n + 1) & 1) * CTB);
        fragb Qf[2]; Qf[0] = ld_frag16(Qs + (16 * it + l15) * MP + 8 * q); Qf[1] = ld_frag16(Qs + (16 * it + l15) * MP + 32 + 8 * q);
        const float cmi = vec[64 + 16 * it + l15]; const int icol = 16 * it + l15;
        f32x4 pt[4];
#pragma unroll
        for (int jt = 0; jt < 4; ++jt) {
            pt[jt] = z4;
            if (jt <= it) {
                const fragb k0 = ld_frag16(Ks + (16 * jt + l15) * MP + 8 * q), k1 = ld_frag16(Ks + (16 * jt + l15) * MP + 32 + 8 * q);
                f32x4 st = mfma16(k0, Qf[0], z4); st = mfma16(k1, Qf[1], st);
                const f32x4 xj = *(const LAS f32x4*)(vec + 16 * jt + 4 * q);
#pragma unroll
                for (int r = 0; r < 4; ++r) { const int j = 16 * jt + 4 * q + r; pt[jt][r] = (j <= icol) ? st[r] * __expf(xj[r] - cmi) * 0.125f : 0.f; }
            }
        }
        fragb Pf[2]; Pf[0] = pack_frag(pt[0], pt[1]); Pf[1] = pack_frag(pt[2], pt[3]);
        fragb Vf[2][2];
#pragma unroll
        for (int v2 = 0; v2 < 2; ++v2)
#pragma unroll
            for (int s = 0; s < 2; ++s) { const LAS bf16* vr = VT + (16 * (2 * vtp + v2) + l15) * MP + 32 * s + 4 * q; Vf[v2][s] = ld_frag8x2(vr, vr + 16); }
        f32x4 Aacc[2], R[2], as, dn;
        as = mfma16(Pf[0], ones, z4); if (it >= 2) as = mfma16(Pf[1], ones, as);
        const fragb nf0 = ld_frag16(CT + 64 * MP + 8 * q), nf1 = ld_frag16(CT + 64 * MP + 32 + 8 * q);
        dn = mfma16(Qf[0], nf0, z4); dn = mfma16(Qf[1], nf1, dn);
#pragma unroll
        for (int v2 = 0; v2 < 2; ++v2) {
            Aacc[v2] = mfma16(Pf[0], Vf[v2][0], z4); if (it >= 2) Aacc[v2] = mfma16(Pf[1], Vf[v2][1], Aacc[v2]);
            const LAS bf16* cr = CT + (16 * (2 * vtp + v2) + l15) * MP + 8 * q;
            R[v2] = mfma16(Qf[0], ld_frag16(cr), z4); R[v2] = mfma16(Qf[1], ld_frag16(cr + 32), R[v2]);
        }
        {
            const f32x4 bi = *(const LAS f32x4*)(vec + 128 + 16 * it + 4 * q), cmr = *(const LAS f32x4*)(vec + 64 + 16 * it + 4 * q);
#pragma unroll
            for (int r = 0; r < 4; ++r) {
                const float mi = bi[r] + cmr[r], minter = bi[r] + m, mt = fmaxf(minter, mi), e1 = __expf(mi - mt), e2 = __expf(minter - mt);
                const float den = e1 * as[r] + e2 * dn[r]; const float inv = __builtin_amdgcn_rcpf(fmaxf(fabsf(den), __expf(-mt)));
                const int row = seqrow_cm(n * 64 + 16 * it + 4 * q + r, d, b);
#pragma unroll
                for (int v2 = 0; v2 < 2; ++v2) outc[(size_t)row * 256 + h * 64 + 16 * (2 * vtp + v2) + l15] = (bf16)f2bf1((e1 * Aacc[v2][r] + e2 * R[v2][r]) * inv);
            }
        }
        {
            const LAS bf16* kr = KTw + (16 * it + l15) * MP + 4 * q;
            const fragb kt0 = ld_frag8x2(kr, kr + 16), kt1 = ld_frag8x2(kr + 32, kr + 48);
            const float bL = vec[128 + 63], mloc = bL + vec[64 + 63];
            const float mnew = fmaxf(bL + m, mloc), wp = __expf(bL + m - mnew), wn = __expf(mloc - mnew);
            f32x4 gk = mfma16(kt0, ones, z4); gk = mfma16(kt1, ones, gk);
            nst = nst * wp + gk * wn;
#pragma unroll
            for (int v2 = 0; v2 < 2; ++v2) {
                f32x4 G = mfma16(kt0, Vf[v2][0], z4); G = mfma16(kt1, Vf[v2][1], G);
                Cst[v2] = Cst[v2] * wp + G * wn;
                v2u o; o.x = pk2(Cst[v2].x, Cst[v2].y); o.y = pk2(Cst[v2].z, Cst[v2].w);
                *(LAS v2u*)(CTn + (16 * (2 * vtp + v2) + l15) * MP + 16 * it + 4 * q) = o;
            }
            if (vtp == 0 && l15 == 0) { v2u o; o.x = pk2(nst.x, nst.y); o.y = pk2(nst.z, nst.w); *(LAS v2u*)(CTn + 64 * MP + 16 * it + 4 * q) = o; }
            m = mnew;
        }
        if (n + 1 < NCH) { images((n + 1) & 1); if (n + 2 < NCH) gload(n + 2); }
    }
    __syncthreads();
}
__device__ __forceinline__ int fwd_row_cm(int b, int c, int t) { return c < 4 ? (T_LAT + b * CTXL + c * 64 + t) : (b * SEQ + t * 64 + (c - 4)); }
__device__ __forceinline__ bf16* blob_row(const Ctx& C, int d, int isw, int b, int c, int h, int r) {
    const int row = fwd_row_cm(b, c, r);
    if (d == 1 && isw) return WSP(bf16, WS_OUTD) + ((size_t)T_ALL + row) * 256 + h * 64;
    return WSP(bf16, WS_P) + (size_t)row * PLD + OFF_D + (d * 2 + isw) * 256 + h * 64;
}
constexpr int LP = 68;
__device__ __forceinline__ void blocked_solve(const LAS bf16* Ln, const LAS bf16* TinvP, LAS unsigned char* XTw, f32x4 (&acc)[4][4], int l15, int q) {
    const f32x4 z4 = (f32x4){0.f, 0.f, 0.f, 0.f};
#pragma unroll
    for (int I = 0; I < 4; ++I) {
        const fragb Af = *(const LAS fragb*)(TinvP + (I * 16 + l15) * 32 + 8 * q);
        fragb A0, A1;
        if (I >= 1) A0 = ld_frag16(Ln + (16 * I + l15) * MP + 8 * q);
        if (I == 3) A1 = ld_frag16(Ln + (16 * I + l15) * MP + 32 + 8 * q);
#pragma unroll
        for (int nt = 0; nt < 4; ++nt) {
            const int crow = 16 * nt + l15; LAS unsigned char* xr = XTw + crow * 128;
            f32x4 a = acc[I][nt];
            if (I >= 1) a = mfma16(A0, *(const LAS fragb*)(xr + ((q ^ (crow & 7)) << 4)), a);
            if (I == 3) a = mfma16(A1, *(const LAS fragb*)(xr + (((4 + q) ^ (crow & 7)) << 4)), a);
            v4u bw; bw.x = pk2(a.x, a.y); bw.y = pk2(a.z, a.w); bw.z = 0u; bw.w = 0u;
            const f32x4 x = mfma16(Af, __builtin_bit_cast(fragb, bw), z4);
            acc[I][nt] = x;
            v2u o; o.x = pk2(x.x, x.y); o.y = pk2(x.z, x.w);
            *(LAS v2u*)(xr + (((2 * I + (q >> 1)) ^ (crow & 7)) << 4) + (q & 1) * 8) = o;
        }
    }
}
__device__ __forceinline__ void diag_inverses(const LAS bf16* Ln, LAS bf16* TinvP, int lane) {
    const int blk = lane >> 4, c = lane & 15;
    float x[16];
#pragma unroll
    for (int i = 0; i < 16; ++i) {
        const LAS bf16* lr = Ln + (16 * blk + i) * MP + 16 * blk;
        const v4u r0 = *(const LAS v4u*)lr, r1 = *(const LAS v4u*)(lr + 8);
        const unsigned rw[8] = {r0.x, r0.y, r0.z, r0.w, r1.x, r1.y, r1.z, r1.w};
        float s = (i == c) ? 1.0f : 0.0f;
#pragma unroll
        for (int j = 0; j < i; ++j) s += ((j & 1) ? bfhi(rw[j >> 1]) : bflo(rw[j >> 1])) * x[j];
        x[i] = s;
        TinvP[(blk * 16 + i) * 32 + 8 * (c >> 2) + (c & 3)] = (bf16)f2bf1(s);
    }
}
__device__ __forceinline__ void gdn_solve_item(const Ctx& C, int l, int item) {
    const int lane = C.lane, w = C.wave, pw = w & 1, pi = w >> 1, l15 = lane & 15, q = lane >> 4;
    LAS unsigned char* B0 = C.lds + pi * 31744;
    LAS bf16* Ln = (LAS bf16*)B0;
    LAS bf16* TinvP = (LAS bf16*)(B0 + 9216);
    LAS float* vec = (LAS float*)(B0 + 13312);
    LAS unsigned char* XT = B0 + 13824;
    LAS bf16* Ks = (LAS bf16*)XT;
    const bf16* P = WSP(const bf16, WS_P); const bf16* gq = WSP(const bf16, WS_GQ);
    const int u = item >> 1, d = item & 1;
    const int c = u % NCH, h = (u / NCH) & 3, b = u / (NCH * NH);
    const int n = d ? (c < 4 ? 3 - c : 71 - c) : c;
    const float aexp = __expf(C.in[I_GALOG][(l * 2 + d) * NH + h]), dtb = C.in[I_GDTB][(l * 2 + d) * NH + h];
    const int rowl = seqrow_cm(n * 64 + lane, d, b);
    const bf16* pg = P + (size_t)rowl * PLD + OFF_D + 1024 + d * 4 + h;
    const float la = -aexp * softplusf_(bf2f(pg[0]) + dtb), beta = sigmoidf_(bf2f(pg[8]));
    const float gam = wave_incl_sum(la, lane);
    if (pw == 0) { vec[lane] = beta; vec[64 + lane] = gam; }
#pragma unroll
    for (int r = 0; r < 4; ++r) { const int idx = pw * 64 + lane + 128 * r, t = idx >> 3, part = idx & 7;
        *(LAS v4u*)(Ks + t * MP + 8 * part) = *(const v4u*)(gq + (size_t)seqrow_cm(n * 64 + t, d, b) * 768 + 256 + h * 64 + 8 * part); }
    { LAS v4u* tz = (LAS v4u*)(B0 + 9216) + (pw * 64 + lane) * 2; tz[0] = (v4u){0u, 0u, 0u, 0u}; tz[1] = (v4u){0u, 0u, 0u, 0u}; }
    f32x4 acc[4][4];
    if (pw == 0) {
#pragma unroll
        for (int I = 0; I < 4; ++I)
#pragma unroll
            for (int r = 0; r < 4; ++r) { const bf16* vr = gq + (size_t)seqrow_cm(n * 64 + 16 * I + 4 * q + r, d, b) * 768 + 512 + h * 64 + l15;
#pragma unroll
                for (int nt = 0; nt < 4; ++nt) acc[I][nt][r] = bf2f(vr[16 * nt]); }
    }
    __syncthreads();
    {
        int tix = 0;
#pragma unroll
        for (int it = 0; it < 4; ++it)
#pragma unroll
            for (int jt = 0; jt < 4; ++jt, ++tix) if ((tix & 1) == pw) {
                f32x4 t4 = (f32x4){0.f, 0.f, 0.f, 0.f};
                if (jt <= it) {
#pragma unroll
                    for (int s = 0; s < 2; ++s) t4 = mfma16(ld_frag16(Ks + (16 * it + l15) * MP + 32 * s + 8 * q), ld_frag16(Ks + (16 * jt + l15) * MP + 32 * s + 8 * q), t4);
                    const float gj = vec[64 + 16 * jt + l15];
                    const f32x4 bi = *(const LAS f32x4*)(vec + 16 * it + 4 * q), gi = *(const LAS f32x4*)(vec + 64 + 16 * it + 4 * q);
#pragma unroll
                    for (int r = 0; r < 4; ++r) { const int i = 16 * it + 4 * q + r, j = 16 * jt + l15; t4[r] = (j < i) ? -(bi[r] * t4[r] * __expf(gi[r] - gj)) : 0.f; }
                }
#pragma unroll
                for (int r = 0; r < 4; ++r) Ln[(16 * it + 4 * q + r) * MP + 16 * jt + l15] = (bf16)f2bf1(t4[r]);
            }
    }
    {
#pragma unroll
        for (int I = 0; I < 4; ++I) {
            const f32x4 bi = *(const LAS f32x4*)(vec + 16 * I + 4 * q), gi = *(const LAS f32x4*)(vec + 64 + 16 * I + 4 * q);
#pragma unroll
            for (int r = 0; r < 4; ++r) { const float sc = pw ? bi[r] * __expf(gi[r]) : bi[r];
#pragma unroll
                for (int nt = 0; nt < 4; ++nt) acc[I][nt][r] = (pw ? bf2f(Ks[(16 * I + 4 * q + r) * MP + 16 * nt + l15]) : acc[I][nt][r]) * sc; }
        }
    }
    __syncthreads();
    if (pw == 0) diag_inverses(Ln, TinvP, lane);
    LAS unsigned char* XTw = XT + pw * 8192;
    { LAS v4u* xz = (LAS v4u*)(XTw + lane * 128);
#pragma unroll
        for (int g = 0; g < 8; ++g) xz[g] = (v4u){0u, 0u, 0u, 0u}; }
    __syncthreads();
    blocked_solve(Ln, TinvP, XTw, acc, l15, q);
    {
        bf16* dst = blob_row(C, d, pw, b, c, h, lane);
        const LAS unsigned char* xr = XTw + lane * 128;
#pragma unroll
        for (int g = 0; g < 8; ++g) *(v4u*)(dst + 8 * g) = *(const LAS v4u*)(xr + ((g ^ (lane & 7)) << 4));
    }
    __syncthreads();
}

template <bool DRY>
__device__ __forceinline__ void gdn_chunked(const Ctx& C, int l, int idx) {
    const int d = idx >> 5, b = (idx >> 2) & 7, h = idx & 3, lane = C.lane, w = C.wave, l15 = lane & 15, q = lane >> 4;
    const int it = w & 3, vtp = w >> 2;
    constexpr int IMG = 64 * MP * 2, BUFB = 5 * IMG + 512;
    LAS unsigned char* L0 = C.lds;
    LAS bf16* VnT = (LAS bf16*)(L0 + 2 * BUFB + 2 * IMG);
    const bf16* P = WSP(const bf16, WS_P); const bf16* gq = WSP(const bf16, WS_GQ); bf16* outd = WSP(bf16, WS_OUTD) + (size_t)d * T_ALL * 256;
    const float aexp = __expf(C.in[I_GALOG][(l * 2 + d) * NH + h]), dtb = C.in[I_GDTB][(l * 2 + d) * NH + h];
    const int tt = C.tid >> 3, part = C.tid & 7;
    for (int i = C.tid; i < 2 * IMG / 4; i += NTHR) ((LAS unsigned*)(L0 + 2 * BUFB))[i] = 0u;
    v4u rq, rk, ru, rw; unsigned short rga;
    auto gload = [&](int n) {
        const int c = d ? (n < 4 ? 3 - n : 71 - n) : n;
        const bf16* pp = gq + (size_t)seqrow_cm(n * 64 + tt, d, b) * 768 + h * 64 + 8 * part;
        rq = *(const v4u*)pp; rk = *(const v4u*)(pp + 256);
        ru = *(const v4u*)(blob_row(C, d, 0, b, c, h, tt) + 8 * part); rw = *(const v4u*)(blob_row(C, d, 1, b, c, h, tt) + 8 * part);
        rga = P[(size_t)seqrow_cm(n * 64 + lane, d, b) * PLD + OFF_D + 1024 + d * 4 + h];
    };
    auto images = [&](int bufi) {
        LAS unsigned char* B0 = L0 + bufi * BUFB;
        LAS bf16* Qs = (LAS bf16*)B0; LAS bf16* Ks = Qs + 64 * MP; LAS bf16* KdT = Ks + 64 * MP; LAS bf16* Wi = KdT + 64 * MP; LAS bf16* UT = Wi + 64 * MP; LAS float* vec = (LAS float*)(B0 + 5 * IMG);
        const float la = -aexp * softplusf_(bf2f(rga) + dtb);
        const float gam = wave_incl_sum(la, lane);
        if (w == 0) vec[lane] = gam;
        const float kd = __expf(__shfl(gam, 63) - gam);
        const float kmine = __shfl(kd, 8 * w + (lane >> 3));
        *(LAS v4u*)(Qs + tt * MP + 8 * part) = rq; *(LAS v4u*)(Ks + tt * MP + 8 * part) = rk; *(LAS v4u*)(UT + tt * MP + 8 * part) = ru;
        const unsigned kk[4] = {rk.x, rk.y, rk.z, rk.w}, ww[4] = {rw.x, rw.y, rw.z, rw.w};
#pragma unroll
        for (int e = 0; e < 4; ++e) {
            KdT[(8 * part + 2 * e) * MP + tt] = (bf16)f2bf1(bflo(kk[e]) * kmine); KdT[(8 * part + 2 * e + 1) * MP + tt] = (bf16)f2bf1(bfhi(kk[e]) * kmine);
            Wi[(8 * part + 2 * e) * MP + tt] = (bf16)(ww[e] & 0xffffu); Wi[(8 * part + 2 * e + 1) * MP + tt] = (bf16)(ww[e] >> 16);
        }
    };
    f32x4 Sst[2]; Sst[0] = Sst[1] = (f32x4){0.f, 0.f, 0.f, 0.f};
    const f32x4 z4 = (f32x4){0.f, 0.f, 0.f, 0.f};
    gload(0); images(0); gload(1);
#pragma unroll 1
    for (int n = 0; n < NCH; ++n) {
        RAW_BARRIER();
        const LAS unsigned char* B0 = L0 + (n & 1) * BUFB;
        const LAS bf16* Qs = (const LAS bf16*)B0; const LAS bf16* Ks = Qs + 64 * MP; const LAS bf16* KdT = Ks + 64 * MP; const LAS bf16* Wi = KdT + 64 * MP; const LAS bf16* UT = Wi + 64 * MP; const LAS float* vec = (const LAS float*)(B0 + 5 * IMG);
        const LAS bf16* ST = (const LAS bf16*)(L0 + 2 * BUFB + (n & 1) * IMG); LAS bf16* STn = (LAS bf16*)(L0 + 2 * BUFB + ((n + 1) & 1) * IMG);
        fragb Qf[2]; Qf[0] = ld_frag16(Qs + (16 * it + l15) * MP + 8 * q); Qf[1] = ld_frag16(Qs + (16 * it + l15) * MP + 32 + 8 * q);
        const float gcol = vec[16 * it + l15]; const int icol = 16 * it + l15;
        f32x4 pt[4];
#pragma unroll
        for (int jt = 0; jt < 4; ++jt) {
            pt[jt] = z4;
            if (jt <= it) {
                const fragb k0 = ld_frag16(Ks + (16 * jt + l15) * MP + 8 * q), k1 = ld_frag16(Ks + (16 * jt + l15) * MP + 32 + 8 * q);
                f32x4 st = mfma16(k0, Qf[0], z4); st = mfma16(k1, Qf[1], st);
                const f32x4 gj = *(const LAS f32x4*)(vec + 16 * jt + 4 * q);
#pragma unroll
                for (int r = 0; r < 4; ++r) { const int j = 16 * jt + 4 * q + r; pt[jt][r] = (j <= icol) ? st[r] * __expf(gcol - gj[r]) : 0.f; }
            }
        }
        fragb Pf[2]; Pf[0] = pack_frag(pt[0], pt[1]); Pf[1] = pack_frag(pt[2], pt[3]);
        const fragb Wf0 = ld_frag16(Wi + (16 * it + l15) * MP + 8 * q), Wf1 = ld_frag16(Wi + (16 * it + l15) * MP + 32 + 8 * q);
        f32x4 Ro[2];
#pragma unroll
        for (int v2 = 0; v2 < 2; ++v2) {
            const int vrow = 16 * (2 * vtp + v2) + l15;
            const fragb s0 = ld_frag16(ST + vrow * MP + 8 * q), s1 = ld_frag16(ST + vrow * MP + 32 + 8 * q);
            f32x4 ws = mfma16(Wf0, s0, z4); ws = mfma16(Wf1, s1, ws);
            Ro[v2] = mfma16(Qf[0], s0, z4); Ro[v2] = mfma16(Qf[1], s1, Ro[v2]);
            const v2u ur = *(const LAS v2u*)(UT + vrow * MP + 16 * it + 4 * q);
            v2u o; o.x = pk2(bflo(ur.x) - ws.x, bfhi(ur.x) - ws.y); o.y = pk2(bflo(ur.y) - ws.z, bfhi(ur.y) - ws.w);
            *(LAS v2u*)(VnT + vrow * MP + 16 * it + 4 * q) = o;
        }
        RAW_BARRIER();
        {
            const f32x4 gi = *(const LAS f32x4*)(vec + 16 * it + 4 * q);
            const float gl = __expf(vec[63]);
            const LAS bf16* kr = KdT + (16 * it + l15) * MP + 4 * q;
            const fragb kt0 = ld_frag8x2(kr, kr + 16), kt1 = ld_frag8x2(kr + 32, kr + 48);
#pragma unroll
            for (int v2 = 0; v2 < 2; ++v2) {
                const int vrow = 16 * (2 * vtp + v2) + l15;
                const LAS bf16* vr = VnT + vrow * MP + 4 * q;
                const fragb n0 = ld_frag8x2(vr, vr + 16), n1 = ld_frag8x2(vr + 32, vr + 48);
                f32x4 o = mfma16(Pf[0], n0, z4); if (it >= 2) o = mfma16(Pf[1], n1, o);
#pragma unroll
                for (int r = 0; r < 4; ++r) { const int row = seqrow_cm(n * 64 + 16 * it + 4 * q + r, d, b);
                    if (!DRY) outd[(size_t)row * 256 + h * 64 + vrow] = (bf16)f2bf1(o[r] + __expf(gi[r]) * Ro[v2][r]); }
                f32x4 ns = mfma16(kt0, n0, z4); ns = mfma16(kt1, n1, ns);
                Sst[v2] = Sst[v2] * gl + ns;
                v2u so; so.x = pk2(Sst[v2].x, Sst[v2].y); so.y = pk2(Sst[v2].z, Sst[v2].w);
                *(LAS v2u*)(STn + vrow * MP + 16 * it + 4 * q) = so;
            }
        }
        if (n + 1 < NCH) { images((n + 1) & 1); if (n + 2 < NCH) gload(n + 2); }
    }
    __syncthreads();
}
constexpr int UP = 264;
template <int CTRL> __device__ __forceinline__ float dpp_keep(float oldv, float v) { return __builtin_bit_cast(float, __builtin_amdgcn_update_dpp(__builtin_bit_cast(int, oldv), __builtin_bit_cast(int, v), CTRL, 0xF, 0xF, false)); }
template <bool REV> __device__ __forceinline__ void scan16(float& A, float& B) {
#define LRU_STEP(S) { const float Ap = dpp_keep<(REV ? 0x100 : 0x110) | S>(1.0f, A), Bp = dpp_keep<(REV ? 0x100 : 0x110) | S>(0.0f, B); B = A * Bp + B; A = A * Ap; }
    LRU_STEP(1) LRU_STEP(2) LRU_STEP(4) LRU_STEP(8)
#undef LRU_STEP
}
template <bool FIN, bool REV>
__device__ __forceinline__ void lru_wave(const Ctx& C, int l, int b, int c, int hd, LAS bf16* U16, LAS bf16* H16) {
    constexpr int d = REV ? 1 : 0;
    const int lane = C.lane, l15 = lane & 15, q = lane >> 4;
    const bf16* wt = WSP(const bf16, WS_LRUWT) + (size_t)((d * 2 + 0) * 4 + hd) * 4096;
    fragb Wa[4][2], Wx[4][2];
#pragma unroll
    for (int mt = 0; mt < 4; ++mt)
#pragma unroll
        for (int ks = 0; ks < 2; ++ks) { Wa[mt][ks] = *(const fragb*)(wt + (16 * mt + l15) * 64 + 32 * ks + 8 * q); Wx[mt][ks] = *(const fragb*)(wt + 4 * 4096 + (16 * mt + l15) * 64 + 32 * ks + 8 * q); }
    f32x4 sp4[4], hc[4], sla[4];
    const size_t sbase = ((size_t)(b * NCH + c) * 2 + d) * 256 + hd * 64;
#pragma unroll
    for (int mt = 0; mt < 4; ++mt) {
        const int ch = hd * 64 + 16 * mt + 4 * q;
        const f32x4 lam = *(const f32x4*)(C.in[I_LLAM] + (l * 2 + d) * GW + ch);
#pragma unroll
        for (int r = 0; r < 4; ++r) sp4[mt][r] = 8.0f * softplusf_(-lam[r]);
        hc[mt] = FIN ? *(const f32x4*)(WSP(const float, WS_HIN) + sbase + 16 * mt + 4 * q) : (f32x4){0.f, 0.f, 0.f, 0.f};
        sla[mt] = (f32x4){0.f, 0.f, 0.f, 0.f};
    }
    const f32x4 z4 = (f32x4){0.f, 0.f, 0.f, 0.f};
#pragma unroll 1
    for (int nti = 0; nti < 4; ++nti) {
        const int nt = REV ? 3 - nti : nti;
        const LAS bf16* urow = U16 + (16 * nt + l15) * UP + hd * 64;
        const fragb Uf0 = ld_frag16(urow + 8 * q), Uf1 = ld_frag16(urow + 32 + 8 * q);
#pragma unroll
        for (int mt = 0; mt < 4; ++mt) {
            f32x4 aa = mfma16(Wa[mt][0], Uf0, z4); aa = mfma16(Wa[mt][1], Uf1, aa);
            f32x4 ax = mfma16(Wx[mt][0], Uf0, z4); ax = mfma16(Wx[mt][1], Uf1, ax);
            const v2u ur = *(const LAS v2u*)(urow + 16 * mt + 4 * q);
            const float u4[4] = {bflo(ur.x), bfhi(ur.x), bflo(ur.y), bfhi(ur.y)};
            const f32x4 ba = *(const f32x4*)(C.in[I_LBA] + (l * 2 + d) * GW + hd * 64 + 16 * mt + 4 * q), bx = *(const f32x4*)(C.in[I_LBX] + (l * 2 + d) * GW + hd * 64 + 16 * mt + 4 * q);
            f32x4 hv;
#pragma unroll
            for (int r = 0; r < 4; ++r) {
                const float rg = sigmoidf_(aa[r] + ba[r]), ig = sigmoidf_(ax[r] + bx[r]);
                const float la = -sp4[mt][r] * rg; float A = __expf(la); float Bv = __builtin_amdgcn_sqrtf(-expm1f_(2.0f * la)) * (ig * u4[r]);
                sla[mt][r] += la;
                scan16<REV>(A, Bv);
                const float h = A * hc[mt][r] + Bv;
                hv[r] = h;
                hc[mt][r] = __shfl(h, (lane & 48) | (REV ? 0 : 15));
            }
            if (FIN) { v2u o; o.x = pk2(hv.x, hv.y); o.y = pk2(hv.z, hv.w); *(LAS v2u*)(H16 + (size_t)d * 64 * UP + (16 * nt + l15) * UP + hd * 64 + 16 * mt + 4 * q) = o; }
        }
    }
    if (!FIN) {
        float* ls = WSP(float, WS_LSUM);
#pragma unroll
        for (int mt = 0; mt < 4; ++mt)
#pragma unroll
            for (int r = 0; r < 4; ++r) { const float st = row16_sum(sla[mt][r]); if (l15 == 0) { const size_t si = sbase + 16 * mt + 4 * q + r; ls[si * 2] = st; ls[si * 2 + 1] = hc[mt][r]; } }
    }
}
template <bool FIN>
__device__ __forceinline__ void lru_chunk_mfma(const Ctx& C, int l, int b, int c) {
    LAS bf16* U16 = (LAS bf16*)C.lds;
    LAS bf16* H16 = U16 + 64 * UP;
    const bf16* P = WSP(const bf16, WS_P);
    const bool isctx = c < 4; const int p0 = isctx ? c * 64 : (c - 4) * 64; const int Lp = isctx ? CTXL : SEQ; const int row0 = isctx ? T_LAT + b * CTXL : b * SEQ;
    {
        const int ch = C.tid & 255, half = C.tid >> 8;
        const float* cw = C.in[I_LCW] + (size_t)l * 4 * GW + ch; const float w0 = cw[0], w1 = cw[GW], w2 = cw[2 * GW], w3 = cw[3 * GW], cb = C.in[I_LCB][l * GW + ch];
        const int t0 = half * 32;
        float xs[35];
#pragma unroll
        for (int k = 0; k < 35; ++k) { const int p = p0 + t0 + k - 2; xs[k] = (p >= 0 && p < Lp) ? bf2f(P[(size_t)(row0 + p) * PLD + ch]) : 0.f; }
#pragma unroll
        for (int t = 0; t < 32; ++t) U16[(t0 + t) * UP + ch] = (bf16)f2bf1(w0 * xs[t] + w1 * xs[t + 1] + w2 * xs[t + 2] + w3 * xs[t + 3] + cb);
    }
    __syncthreads();
    if (C.wave < 4) lru_wave<FIN, false>(C, l, b, c, C.wave & 3, U16, H16); else lru_wave<FIN, true>(C, l, b, c, C.wave & 3, U16, H16);
    __syncthreads();
    if (FIN) {
        const LAS bf16* H1 = H16 + 64 * UP;
#pragma unroll 2
        for (int it = C.tid; it < 64 * 64; it += NTHR) {
            const int t = it >> 6, c4 = (it & 63) * 4;
            const size_t row = (size_t)(row0 + p0 + t);
            const v2u a = *(const LAS v2u*)(H16 + t * UP + c4), bq = *(const LAS v2u*)(H1 + t * UP + c4);
            const f32x4 g = ld4bf(P + row * PLD + 256 + c4);
            f32x4 y = (f32x4){bflo(a.x) + bflo(bq.x), bfhi(a.x) + bfhi(bq.x), bflo(a.y) + bflo(bq.y), bfhi(a.y) + bfhi(bq.y)};
            y.x *= gelu_tanh(g.x); y.y *= gelu_tanh(g.y); y.z *= gelu_tanh(g.z); y.w *= gelu_tanh(g.w);
            st4bf(WSP(bf16, WS_P) + row * PLD + 256 + c4, y);
        }
        __syncthreads();
    }
}
constexpr int RP = 264;
__device__ __forceinline__ void rwkv_prep2(const Ctx& C, int l, int b, int c) {
    LAS bf16* RS = (LAS bf16*)C.lds;
    LAS bf16* KS = RS + 64 * RP;
    LAS bf16* XW = KS + 64 * RP;
    LAS bf16* XA = XW + 64 * MP;
    LAS bf16* XG = XA + 64 * MP;
    const bf16* P = WSP(const bf16, WS_P);
    const bool isctx = c < 4; const int p0 = isctx ? c * 64 : (c - 4) * 64; const int Lp = isctx ? CTXL : SEQ; const int row0 = isctx ? T_LAT + b * CTXL : b * SEQ;
    const float* mu = C.in[I_RMU] + (size_t)l * 2 * B_COLS;
    bf16* rkv = WSP(bf16, WS_RKV);
#pragma unroll 5
    for (int it = C.tid; it < 64 * 120; it += NTHR) {
        const int t = it / 120, c8 = (it % 120) * 8, p = p0 + t;
        const bf16* pp = P + (size_t)(row0 + p) * PLD + OFF_B + c8;
        const v4u xc = *(const v4u*)pp; v4u xp = (v4u){0u, 0u, 0u, 0u}, xn = xp;
        if (p > 0) xp = *(const v4u*)(pp - PLD);
        if (p < Lp - 1) xn = *(const v4u*)(pp + PLD);
        const f32x4 m0a = *(const f32x4*)(mu + c8), m0b = *(const f32x4*)(mu + c8 + 4), m1a = *(const f32x4*)(mu + B_COLS + c8), m1b = *(const f32x4*)(mu + B_COLS + c8 + 4);
        const unsigned xcw[4] = {xc.x, xc.y, xc.z, xc.w}, xpw[4] = {xp.x, xp.y, xp.z, xp.w}, xnw[4] = {xn.x, xn.y, xn.z, xn.w};
        float sh[8];
#pragma unroll
        for (int e = 0; e < 4; ++e) {
            const float x0 = bflo(xcw[e]), x1 = bfhi(xcw[e]);
            const float mu0_0 = e < 2 ? m0a[2 * e] : m0b[2 * e - 4], mu0_1 = e < 2 ? m0a[2 * e + 1] : m0b[2 * e - 3], mu1_0 = e < 2 ? m1a[2 * e] : m1b[2 * e - 4], mu1_1 = e < 2 ? m1a[2 * e + 1] : m1b[2 * e - 3];
            sh[2 * e] = x0 + mu0_0 * (bflo(xpw[e]) - x0) + mu1_0 * (bflo(xnw[e]) - x0);
            sh[2 * e + 1] = x1 + mu0_1 * (bfhi(xpw[e]) - x1) + mu1_1 * (bfhi(xnw[e]) - x1);
        }
        if (c8 >= 768) {
            const int ci = c8 - 768;
            if (ci < 64) {
#pragma unroll
                for (int e = 0; e < 8; ++e) sh[e] = tanhf_(sh[e]); }
            else if (ci >= 128) {
#pragma unroll
                for (int e = 0; e < 8; ++e) sh[e] = sigmoidf_(sh[e]); }
        }
        v4u o; o.x = pk2(sh[0], sh[1]); o.y = pk2(sh[2], sh[3]); o.z = pk2(sh[4], sh[5]); o.w = pk2(sh[6], sh[7]);
        if (c8 < 768) {
            *(v4u*)(rkv + (size_t)(row0 + p) * 768 + c8) = o;
            if (c8 < 256) *(LAS v4u*)(RS + t * RP + c8) = o; else if (c8 < 512) *(LAS v4u*)(KS + t * RP + c8 - 256) = o;
        } else {
            const int ci = c8 - 768;
            LAS bf16* dst = ci < 64 ? XW + t * MP + ci : (ci < 128 ? XA + t * MP + ci - 64 : XG + t * MP + ci - 128);
            *(LAS v4u*)dst = o;
        }
    }
    __syncthreads();
    const int lane = C.lane, w = C.wave, l15 = lane & 15, q = lane >> 4, hd = w & 3, ntp = w >> 2;
    const bf16* wt = WSP(const bf16, WS_RWT);
    bf16* wa_out = WSP(bf16, WS_HB); bf16* g_out = WSP(bf16, WS_G); float* bonus = WSP(float, WS_BONUS); float* rinv = WSP(float, WS_RINV);
    const f32x4 z4 = (f32x4){0.f, 0.f, 0.f, 0.f};
    fragb xw0[2], xw1[2], xa0[2], xa1[2], xg0[2], xg1[2]; float bsum[2] = {0.f, 0.f}, ksum[2] = {0.f, 0.f};
#pragma unroll
    for (int n2 = 0; n2 < 2; ++n2) { const int tok = 16 * (2 * ntp + n2) + l15;
        xw0[n2] = ld_frag16(XW + tok * MP + 8 * q); xw1[n2] = ld_frag16(XW + tok * MP + 32 + 8 * q);
        xa0[n2] = ld_frag16(XA + tok * MP + 8 * q); xa1[n2] = ld_frag16(XA + tok * MP + 32 + 8 * q);
        xg0[n2] = ld_frag16(XG + tok * MP + 8 * q); xg1[n2] = ld_frag16(XG + tok * MP + 32 + 8 * q); }
#pragma unroll
    for (int mt = 0; mt < 4; ++mt) {
        const int chl = 16 * mt + l15, ch4 = hd * 64 + 16 * mt + 4 * q;
        const bf16* wrow = wt + (size_t)(hd * 64 + chl) * 32 + 8 * q;
        const bf16* grow = wt + 4 * 256 * 32 + (size_t)(hd * 64 + chl) * 64 + 8 * q;
        const fragb fw0 = *(const fragb*)(wrow), fw1 = *(const fragb*)(wrow + 256 * 32), fa0 = *(const fragb*)(wrow + 2 * 256 * 32), fa1 = *(const fragb*)(wrow + 3 * 256 * 32), fg0 = *(const fragb*)(grow), fg1 = *(const fragb*)(grow + 32);
        const f32x4 w00 = *(const f32x4*)(C.in[I_RW0] + (l * 2 + 0) * GW + ch4), w01 = *(const f32x4*)(C.in[I_RW0] + (l * 2 + 1) * GW + ch4);
        const f32x4 a00 = *(const f32x4*)(C.in[I_RA0] + (l * 2 + 0) * GW + ch4), a01 = *(const f32x4*)(C.in[I_RA0] + (l * 2 + 1) * GW + ch4);
        const f32x4 k_a = *(const f32x4*)(C.in[I_RKA] + l * GW + ch4), r_k = *(const f32x4*)(C.in[I_RRK] + l * GW + ch4), k_k = *(const f32x4*)(C.in[I_RKK] + l * GW + ch4);
#pragma unroll
        for (int n2 = 0; n2 < 2; ++n2) {
            const int tok = 16 * (2 * ntp + n2) + l15; const size_t row = (size_t)(row0 + p0 + tok);
            const f32x4 aw0 = mfma16(fw0, xw0[n2], z4), aw1 = mfma16(fw1, xw1[n2], z4), aa0 = mfma16(fa0, xa0[n2], z4), aa1 = mfma16(fa1, xa1[n2], z4);
            f32x4 ag = mfma16(fg0, xg0[n2], z4); ag = mfma16(fg1, xg1[n2], ag);
            f32x4 wv0, wv1, av0, av1;
#pragma unroll
            for (int r = 0; r < 4; ++r) {
                wv0[r] = __expf(-0.6065306597126334f * sigmoidf_(aw0[r] + w00[r])); wv1[r] = __expf(-0.6065306597126334f * sigmoidf_(aw1[r] + w01[r]));
                av0[r] = sigmoidf_(aa0[r] + a00[r]); av1[r] = sigmoidf_(aa1[r] + a01[r]);
            }
            st4bf(wa_out + row * 1024 + 0 * 256 + ch4, wv0); st4bf(wa_out + row * 1024 + 1 * 256 + ch4, wv1);
            st4bf(wa_out + row * 1024 + 2 * 256 + ch4, av0); st4bf(wa_out + row * 1024 + 3 * 256 + ch4, av1);
            st4bf(g_out + row * 256 + ch4, ag);
            const v2u rr_ = *(const LAS v2u*)(RS + tok * RP + ch4), kr_ = *(const LAS v2u*)(KS + tok * RP + ch4);
            const f32x4 rs = (f32x4){bflo(rr_.x), bfhi(rr_.x), bflo(rr_.y), bfhi(rr_.y)}, ks = (f32x4){bflo(kr_.x), bfhi(kr_.x), bflo(kr_.y), bfhi(kr_.y)};
#pragma unroll
            for (int r = 0; r < 4; ++r) {
                const float km = ks[r] * (1.0f + (av0[r] - 1.0f) * k_a[r]) + ks[r] * (1.0f + (av1[r] - 1.0f) * k_a[r]);
                bsum[n2] += rs[r] * r_k[r] * km; const float kk = ks[r] * k_k[r]; ksum[n2] += kk * kk;
            }
        }
    }
#pragma unroll
    for (int n2 = 0; n2 < 2; ++n2) {
        const size_t row = (size_t)(row0 + p0 + 16 * (2 * ntp + n2) + l15);
        float bs = bsum[n2], ks2 = ksum[n2];
        bs += __shfl_xor(bs, 16); bs += __shfl_xor(bs, 32); ks2 += __shfl_xor(ks2, 16); ks2 += __shfl_xor(ks2, 32);
        if (q == 0) { bonus[row * 4 + hd] = bs; rinv[row * 4 + hd] = rsqrtf_(ks2 + 1e-6f); }
    }
    __syncthreads();
}
__device__ __forceinline__ int fwd_row_r(int b, int c, int t) { return c < 4 ? (T_LAT + b * CTXL + c * 64 + t) : (b * SEQ + (c - 4) * 64 + t); }
__device__ __forceinline__ bf16* rw_blob_row(const Ctx& C, int d, int which, int b, int c, int h, int r) {
    const int row = fwd_row_r(b, c, r);
#if RW_VSPLIT
    if (which == 0) { if (d) return WSP(bf16, WS_GQ) + (size_t)row * 768 + 512 + h * 64;
                      return WSP(bf16, WS_P) + (size_t)row * PLD + OFF_B + 512 + h * 64; }
#else
    if (which == 0) return WSP(bf16, WS_OUTB) + ((size_t)d * T_ALL + row) * 256 + h * 64;
#endif
    return WSP(bf16, WS_P) + (size_t)row * PLD + OFF_B + d * 256 + h * 64;
}
__device__ __forceinline__ void rwkv_solve_item(const Ctx& C, int l, int item) {
    const int lane = C.lane, w = C.wave, pw = w & 1, pi = w >> 1, l15 = lane & 15, q = lane >> 4;
    LAS unsigned char* B0 = C.lds + pi * 31744;
    LAS bf16* Kk = (LAS bf16*)B0; LAS bf16* Bh = Kk + 64 * MP; LAS bf16* Kh = Bh + 64 * MP;
    LAS bf16* Ln = (LAS bf16*)B0;
    LAS bf16* Lk16 = (LAS bf16*)(B0 + 9216);
    LAS unsigned char* XT = B0 + 9216;
    LAS bf16* TinvP = (LAS bf16*)(B0 + 25600);
    const bf16* WA = WSP(const bf16, WS_HB); bf16* WAw = WSP(bf16, WS_HB); const bf16* rkv = WSP(const bf16, WS_RKV); const float* rinv = WSP(const float, WS_RINV);
    const int u = item >> 1, d = item & 1;
    const int c = u % NCH, h = (u / NCH) & 3, b = u / (NCH * NH);
    const float k_k = C.in[I_RKK][l * GW + h * 64 + lane], k_a = C.in[I_RKA][l * GW + h * 64 + lane];
    const int n = d ? (c < 4 ? 3 - c : 71 - c) : c;
    const float ril = rinv[(size_t)seqrow_raster(n * 64 + lane, d, b) * 4 + h];
#pragma unroll
    for (int r = 0; r < 4; ++r) { const int idx2 = pw * 64 + lane + 128 * r, t = idx2 >> 3, part = idx2 & 7; const int row = seqrow_raster(n * 64 + t, d, b);
        *(LAS v4u*)(Kk + t * MP + 8 * part) = *(const v4u*)(WA + (size_t)row * 1024 + d * 256 + h * 64 + 8 * part);
        *(LAS v4u*)(Bh + t * MP + 8 * part) = *(const v4u*)(WA + (size_t)row * 1024 + (2 + d) * 256 + h * 64 + 8 * part);
        *(LAS v4u*)(Kh + t * MP + 8 * part) = *(const v4u*)(rkv + (size_t)row * 768 + 256 + h * 64 + 8 * part); }
    __syncthreads();
    {
        float cc = 1.0f;
        if (pw) {
#pragma unroll
            for (int t = 0; t < 32; ++t) cc *= bf2f(Kk[t * MP + lane]);
        }
        __syncthreads();
#pragma unroll
        for (int t2 = 0; t2 < 32; ++t2) {
            const int t = pw * 32 + t2;
            const float wv = bf2f(Kk[t * MP + lane]), av = bf2f(Bh[t * MP + lane]), ks = bf2f(Kh[t * MP + lane]);
            const float kap = ks * k_k * __shfl(ril, t);
            const float cprev = cc; cc *= wv; const float ic = __builtin_amdgcn_rcpf(cc);
            Kk[t * MP + lane] = (bf16)f2bf1(kap * cprev); Bh[t * MP + lane] = (bf16)f2bf1(kap * av * ic); Kh[t * MP + lane] = (bf16)f2bf1(ks * (1.0f + (av - 1.0f) * k_a) * ic);
            WAw[(size_t)seqrow_raster(n * 64 + t, d, b) * 1024 + d * 256 + h * 64 + lane] = (bf16)f2bf1(cc);
        }
    }
    __syncthreads();
    f32x4 acc[4][4];
    if (pw == 0) {
#pragma unroll
        for (int I = 0; I < 4; ++I)
#pragma unroll
            for (int r = 0; r < 4; ++r)
#pragma unroll
                for (int nt = 0; nt < 4; ++nt) acc[I][nt][r] = bf2f(Kk[(16 * I + 4 * q + r) * MP + 16 * nt + l15]);
    }
    f32x4 T[10];
    {
        const LAS bf16* Bsrc = pw ? Kh : Bh;
        int tix = 0;
#pragma unroll
        for (int it = 0; it < 4; ++it)
#pragma unroll
            for (int jt = 0; jt <= it; ++jt, ++tix) {
                f32x4 t4 = (f32x4){0.f, 0.f, 0.f, 0.f};
#pragma unroll
                for (int s = 0; s < 2; ++s) t4 = mfma16(ld_frag16(Kk + (16 * it + l15) * MP + 32 * s + 8 * q), ld_frag16(Bsrc + (16 * jt + l15) * MP + 32 * s + 8 * q), t4);
#pragma unroll
                for (int r = 0; r < 4; ++r) { const int i = 16 * it + 4 * q + r, j = 16 * jt + l15; T[tix][r] = (j < i) ? (pw ? t4[r] : -t4[r]) : 0.f; }
            }
    }
    __syncthreads();
    {
        int tix = 0;
#pragma unroll
        for (int it = 0; it < 4; ++it)
#pragma unroll
            for (int jt = 0; jt < 4; ++jt) {
                if (jt <= it) {
#pragma unroll
                    for (int r = 0; r < 4; ++r) (pw ? Lk16 : Ln)[(16 * it + 4 * q + r) * MP + 16 * jt + l15] = (bf16)f2bf1(T[tix][r]);
                    ++tix;
                } else if (pw == 0) {
#pragma unroll
                    for (int r = 0; r < 4; ++r) Ln[(16 * it + 4 * q + r) * MP + 16 * jt + l15] = (bf16)0;
                }
            }
        LAS v4u* tz = (LAS v4u*)(B0 + 25600) + (pw * 64 + lane) * 2; tz[0] = (v4u){0u, 0u, 0u, 0u}; tz[1] = (v4u){0u, 0u, 0u, 0u};
    }
    __syncthreads();
    if (pw) {
#pragma unroll
        for (int I = 0; I < 4; ++I)
#pragma unroll
            for (int r = 0; r < 4; ++r)
#pragma unroll
                for (int nt = 0; nt < 4; ++nt) { const int i = 16 * I + 4 * q + r, j = 16 * nt + l15; acc[I][nt][r] = (j < i && nt <= I) ? bf2f(Lk16[i * MP + j]) : 0.f; }
    } else diag_inverses(Ln, TinvP, lane);
    __syncthreads();
    LAS unsigned char* XTw = XT + pw * 8192;
    { LAS v4u* xz = (LAS v4u*)(XTw + lane * 128);
#pragma unroll
        for (int g = 0; g < 8; ++g) xz[g] = (v4u){0u, 0u, 0u, 0u}; }
    blocked_solve(Ln, TinvP, XTw, acc, l15, q);
    {
        bf16* dst = rw_blob_row(C, d, pw, b, c, h, lane);
        const LAS unsigned char* xr = XTw + lane * 128;
#pragma unroll
        for (int g = 0; g < 8; ++g) *(v4u*)(dst + 8 * g) = *(const LAS v4u*)(xr + ((g ^ (lane & 7)) << 4));
    }
    __syncthreads();
}

template <bool DRY>
__device__ __forceinline__ void rwkv_chunked(const Ctx& C, int l, int idx) {
#ifndef RW_VSPLIT
#define RW_VSPLIT 1
#endif
    constexpr int NV = RW_VSPLIT ? 1 : 2;
    const int vhalf = idx & 1, lane = C.lane, w = C.wave, l15 = lane & 15, q = lane >> 4;
    const int d = RW_VSPLIT ? idx >> 6 : idx >> 5, b = RW_VSPLIT ? (idx >> 3) & 7 : (idx >> 2) & 7, h = RW_VSPLIT ? (idx >> 1) & 3 : idx & 3;
    const int it = w & 3, vt0 = RW_VSPLIT ? 2 * vhalf + (w >> 2) : 2 * (w >> 2);
    constexpr int IMG = 64 * MP * 2;
    LAS unsigned char* L0 = C.lds;
    LAS bf16* Wi = (LAS bf16*)L0; LAS bf16* Ti = Wi + 64 * MP; LAS bf16* Rh = Ti + 64 * MP; LAS bf16* Kh = Rh + 64 * MP; LAS bf16* Bh = Kh + 64 * MP;
    LAS bf16* UT = (LAS bf16*)(L0 + 11 * IMG);
    LAS float* cLv = (LAS float*)(L0 + 14 * IMG);
    const bf16* WA = WSP(const bf16, WS_HB); const bf16* rkv = WSP(const bf16, WS_RKV); const float* rinv = WSP(const float, WS_RINV);
    bf16* outb = WSP(bf16, WS_OUTB) + (size_t)d * T_ALL * 256;
    const int tt = C.tid >> 3, part = C.tid & 7;
    for (int i = C.tid; i < 2 * IMG / 4; i += NTHR) ((LAS unsigned*)(L0 + 12 * IMG))[i] = 0u;
    float kkw[8], kaw[8];
#pragma unroll
    for (int e = 0; e < 8; ++e) { kkw[e] = C.in[I_RKK][l * GW + h * 64 + 8 * w + e]; kaw[e] = C.in[I_RKA][l * GW + h * 64 + 8 * w + e]; }
    v4u gr, gk, gv, gw, ga, gbw, gbt; float gri;
    auto gload = [&](int n) {
        const int c = d ? (n < 4 ? 3 - n : 71 - n) : n;
        const int row = seqrow_raster(n * 64 + lane, d, b);
        const bf16* pr = rkv + (size_t)row * 768 + h * 64 + 8 * w;
        gr = *(const v4u*)pr; gk = *(const v4u*)(pr + 256); gv = *(const v4u*)(pr + 512);
        gw = *(const v4u*)(WA + (size_t)row * 1024 + d * 256 + h * 64 + 8 * w); ga = *(const v4u*)(WA + (size_t)row * 1024 + (2 + d) * 256 + h * 64 + 8 * w);
        gri = rinv[(size_t)row * 4 + h];
        gbw = *(const v4u*)(rw_blob_row(C, d, 0, b, c, h, tt) + 8 * part); gbt = *(const v4u*)(rw_blob_row(C, d, 1, b, c, h, tt) + 8 * part);
    };
    auto images = [&](int bufi) {
        LAS bf16* VT = (LAS bf16*)(L0 + (5 + 3 * bufi) * IMG); LAS bf16* KcT = VT + 64 * MP; LAS bf16* BcT = KcT + 64 * MP;
        const unsigned rw_[4] = {gr.x, gr.y, gr.z, gr.w}, kw_[4] = {gk.x, gk.y, gk.z, gk.w}, vw_[4] = {gv.x, gv.y, gv.z, gv.w}, ww_[4] = {gw.x, gw.y, gw.z, gw.w}, aw_[4] = {ga.x, ga.y, ga.z, ga.w};
        float rh[8], kh[8], bh[8];
#pragma unroll
        for (int e = 0; e < 8; ++e) {
            const float rs = (e & 1) ? bfhi(rw_[e >> 1]) : bflo(rw_[e >> 1]), ks = (e & 1) ? bfhi(kw_[e >> 1]) : bflo(kw_[e >> 1]);
            const float wv = (e & 1) ? bfhi(ww_[e >> 1]) : bflo(ww_[e >> 1]), av = (e & 1) ? bfhi(aw_[e >> 1]) : bflo(aw_[e >> 1]);
            const float kap = ks * kkw[e] * gri, ktil = ks * (1.0f + (av - 1.0f) * kaw[e]);
            const float cf = wv, icf = __builtin_amdgcn_rcpf(cf), cfL = __builtin_bit_cast(float, __builtin_amdgcn_readlane(__builtin_bit_cast(int, cf), 63)), dec = cfL * icf;
            rh[e] = rs * cf; kh[e] = ktil * icf; bh[e] = kap * av * icf;
            const unsigned short vraw = (e & 1) ? (unsigned short)(vw_[e >> 1] >> 16) : (unsigned short)(vw_[e >> 1] & 0xffffu);
            VT[(8 * w + e) * MP + lane] = vraw; KcT[(8 * w + e) * MP + lane] = (bf16)f2bf1(ktil * dec); BcT[(8 * w + e) * MP + lane] = (bf16)f2bf1(-(kap * av * dec));
            if (lane == 63) cLv[bufi * 64 + 8 * w + e] = cfL;
        }
        { v4u o; o.x = pk2(rh[0], rh[1]); o.y = pk2(rh[2], rh[3]); o.z = pk2(rh[4], rh[5]); o.w = pk2(rh[6], rh[7]); *(LAS v4u*)(Rh + lane * MP + 8 * w) = o; }
        { v4u o; o.x = pk2(kh[0], kh[1]); o.y = pk2(kh[2], kh[3]); o.z = pk2(kh[4], kh[5]); o.w = pk2(kh[6], kh[7]); *(LAS v4u*)(Kh + lane * MP + 8 * w) = o; }
        { v4u o; o.x = pk2(bh[0], bh[1]); o.y = pk2(bh[2], bh[3]); o.z = pk2(bh[4], bh[5]); o.w = pk2(bh[6], bh[7]); *(LAS v4u*)(Bh + lane * MP + 8 * w) = o; }
        const unsigned bw_[4] = {gbw.x, gbw.y, gbw.z, gbw.w}, bt_[4] = {gbt.x, gbt.y, gbt.z, gbt.w};
#pragma unroll
        for (int e = 0; e < 4; ++e) {
            Wi[(8 * part + 2 * e) * MP + tt] = (bf16)(bw_[e] & 0xffffu); Wi[(8 * part + 2 * e + 1) * MP + tt] = (bf16)(bw_[e] >> 16);
            Ti[(8 * part + 2 * e) * MP + tt] = (bf16)(bt_[e] & 0xffffu); Ti[(8 * part + 2 * e + 1) * MP + tt] = (bf16)(bt_[e] >> 16);
        }
    };
    f32x4 Zst[NV];
#pragma unroll
    for (int v2 = 0; v2 < NV; ++v2) Zst[v2] = (f32x4){0.f, 0.f, 0.f, 0.f};
    const f32x4 z4 = (f32x4){0.f, 0.f, 0.f, 0.f};
    gload(0); images(0); gload(1);
#pragma unroll 1
    for (int n = 0; n < NCH; ++n) {
        RAW_BARRIER();
        const LAS bf16* VT = (const LAS bf16*)(L0 + (5 + 3 * (n & 1)) * IMG); const LAS bf16* KcT = VT + 64 * MP; const LAS bf16* BcT = KcT + 64 * MP;
        const LAS bf16* Zi = (const LAS bf16*)(L0 + (12 + (n & 1)) * IMG); LAS bf16* Zn = (LAS bf16*)(L0 + (12 + ((n + 1) & 1)) * IMG);
        const int arow = (16 * it + l15) * MP + 8 * q;
        const fragb Wf0 = ld_frag16(Wi + arow), Wf1 = ld_frag16(Wi + arow + 32), Tf0 = ld_frag16(Ti + arow), Tf1 = ld_frag16(Ti + arow + 32), Rf0 = ld_frag16(Rh + arow), Rf1 = ld_frag16(Rh + arow + 32);
        const int icol = 16 * it + l15;
        f32x4 pk[4], pb[4];
#pragma unroll
        for (int jt = 0; jt < 4; ++jt) {
            pk[jt] = z4; pb[jt] = z4;
            if (jt <= it) {
                const int jrow = (16 * jt + l15) * MP + 8 * q;
                f32x4 sk = mfma16(ld_frag16(Kh + jrow), Rf0, z4); sk = mfma16(ld_frag16(Kh + jrow + 32), Rf1, sk);
                f32x4 sb = mfma16(ld_frag16(Bh + jrow), Rf0, z4); sb = mfma16(ld_frag16(Bh + jrow + 32), Rf1, sb);
#pragma unroll
                for (int r = 0; r < 4; ++r) { const int j = 16 * jt + 4 * q + r; pk[jt][r] = (j <= icol) ? sk[r] : 0.f; pb[jt][r] = (j <= icol) ? -sb[r] : 0.f; }
            }
        }
        fragb Pk0 = pack_frag(pk[0], pk[1]), Pk1 = pack_frag(pk[2], pk[3]), Pb0 = pack_frag(pb[0], pb[1]), Pb1 = pack_frag(pb[2], pb[3]);
        f32x4 RZ[NV];
#pragma unroll
        for (int v2 = 0; v2 < NV; ++v2) {
            const int vrow = 16 * (vt0 + v2) + l15;
            const fragb z0 = ld_frag16(Zi + vrow * MP + 8 * q), z1 = ld_frag16(Zi + vrow * MP + 32 + 8 * q);
            f32x4 u = mfma16(Wf0, z0, z4); u = mfma16(Wf1, z1, u);
            u = mfma16(Tf0, ld_frag16(VT + vrow * MP + 8 * q), u); if (it >= 2) u = mfma16(Tf1, ld_frag16(VT + vrow * MP + 32 + 8 * q), u);
            RZ[v2] = mfma16(Rf0, z0, z4); RZ[v2] = mfma16(Rf1, z1, RZ[v2]);
            v2u o; o.x = pk2(u.x, u.y); o.y = pk2(u.z, u.w);
            *(LAS v2u*)(UT + vrow * MP + 16 * it + 4 * q) = o;
        }
        RAW_BARRIER();
        {
            const f32x4 cl4 = *(const LAS f32x4*)(cLv + (n & 1) * 64 + 16 * it + 4 * q);
            const LAS bf16* kr = KcT + (16 * it + l15) * MP + 4 * q; const LAS bf16* br = BcT + (16 * it + l15) * MP + 4 * q;
            const fragb kc0 = ld_frag8x2(kr, kr + 16), kc1 = ld_frag8x2(kr + 32, kr + 48), bc0 = ld_frag8x2(br, br + 16), bc1 = ld_frag8x2(br + 32, br + 48);
#pragma unroll
            for (int v2 = 0; v2 < NV; ++v2) {
                const int vrow = 16 * (vt0 + v2) + l15;
                const LAS bf16* vr = VT + vrow * MP + 4 * q; const LAS bf16* ur = UT + vrow * MP + 4 * q;
                const fragb vp0 = ld_frag8x2(vr, vr + 16), vp1 = ld_frag8x2(vr + 32, vr + 48), up0 = ld_frag8x2(ur, ur + 16), up1 = ld_frag8x2(ur + 32, ur + 48);
                f32x4 y = mfma16(Pk0, vp0, RZ[v2]); y = mfma16(Pb0, up0, y);
                if (it >= 2) { y = mfma16(Pk1, vp1, y); y = mfma16(Pb1, up1, y); }
#pragma unroll
                for (int r = 0; r < 4; ++r) { const int row = seqrow_raster(n * 64 + 16 * it + 4 * q + r, d, b); if (!DRY) outb[(size_t)row * 256 + h * 64 + vrow] = (bf16)f2bf1(y[r]); }
                f32x4 zn = mfma16(kc0, vp0, z4); zn = mfma16(kc1, vp1, zn); zn = mfma16(bc0, up0, zn); zn = mfma16(bc1, up1, zn);
                Zst[v2] = Zst[v2] * cl4 + zn;
                v2u so; so.x = pk2(Zst[v2].x, Zst[v2].y); so.y = pk2(Zst[v2].z, Zst[v2].w);
                *(LAS v2u*)(Zn + vrow * MP + 16 * it + 4 * q) = so;
            }
        }
        if (n + 1 < NCH) { images((n + 1) & 1); if (n + 2 < NCH) gload(n + 2); }
    }
    __syncthreads();
}
__device__ __forceinline__ void moe_scatter(const Ctx& C, int moe_li, int nrows) {
    const unsigned* gc = WSP(const unsigned, WS_CTL) + CW_MOECNT + 64 * moe_li;
    LAS int* pst = (LAS int*)C.lds;
    {
        int pe[8]; int acc = 0;
#pragma unroll
        for (int e = 0; e < NE; ++e) { const int blks = ((int)gc[e] + 255) >> 8; if (C.tid == e) pst[e] = acc * 256; acc += blks; pe[e] = acc; }
        if (C.wg == 0 && C.tid < MOE_MAXBLK) { int be = 0;
#pragma unroll
            for (int e = 0; e < NE; ++e) be += (pe[e] <= C.tid) ? 1 : 0;
            int* tab = WSP(int, WS_TAB); tab[1 + C.tid] = be < NE ? be : NE - 1; if (C.tid == 0) tab[0] = acc; }
    }
    __syncthreads();
    const unsigned* route = WSP(const unsigned, WS_ROUTE); const unsigned* wgbase = WSP(const unsigned, WS_WGBASE);
    const bf16* hb = WSP(const bf16, WS_HB); bf16* am = WSP(bf16, WS_MIX); int* pos = WSP(int, WS_POS);
    const int gw = C.wg * NWAVES + C.wave, NGW = C.G * NWAVES;
    for (int m = gw; m < nrows; m += NGW) {
        const v4u a = *(const v4u*)(route + (size_t)m * 8);
        const int e0 = (int)a.x, e1 = (int)a.y;
        const int p0 = pst[e0] + (int)wgbase[C.wg * 8 + e0] + (int)a.z, p1 = pst[e1] + (int)wgbase[C.wg * 8 + e1] + (int)a.w;
        const v4u r0 = *(const v4u*)(hb + (size_t)m * 1024 + C.lane * 8), r1 = *(const v4u*)(hb + (size_t)m * 1024 + 512 + C.lane * 8);
        *(v4u*)(am + (size_t)p0 * 1024 + C.lane * 8) = r0; *(v4u*)(am + (size_t)p0 * 1024 + 512 + C.lane * 8) = r1;
        *(v4u*)(am + (size_t)p1 * 1024 + C.lane * 8) = r0; *(v4u*)(am + (size_t)p1 * 1024 + 512 + C.lane * 8) = r1;
        if (C.lane == 0) { pos[(size_t)m * 2] = p0; pos[(size_t)m * 2 + 1] = p1; }
    }
    __syncthreads();
}
template <int NEXT>
__device__ __forceinline__ void moe_combine(const Ctx& C, int l, int nrows) {
    const unsigned* route = WSP(const unsigned, WS_ROUTE); const int* pos = WSP(const int, WS_POS); const bf16* ym = WSP(const bf16, WS_MIX);
    const float* modv = WSP(const float, WS_MODV) + (size_t)l * 9 * 6144 + 5 * 1024;
    const float* modn = WSP(const float, WS_MODV) + (size_t)(l + 1) * 9 * 6144;
    float* xc = WSP(float, WS_XC); bf16* hb = WSP(bf16, WS_HB);
    const int gw = C.wg * NWAVES + C.wave, NGW = C.G * NWAVES;
    f32x4 gn[4];
#pragma unroll
    for (int j = 0; j < 4; ++j) gn[j] = *(const f32x4*)((NEXT == 2 ? C.in[I_FNG] : C.in[I_NMIXG] + (NEXT == 1 ? (l + 1) * 1024 : 0)) + 4 * C.lane + 256 * j);
    for (int m = gw; m < nrows; m += NGW) {
        const bool isctx = m >= T_LAT;
        float* xr = isctx ? xc + (size_t)(m - T_LAT) * 1024 : C.out + (size_t)m * 1024;
        const int mrow = isctx ? 8 : (m >> 12);
        const float* gv = modv + (size_t)mrow * 6144;
        const int p0 = pos[(size_t)m * 2], p1 = pos[(size_t)m * 2 + 1];
        const float w0 = __builtin_bit_cast(float, route[(size_t)m * 8 + 4]), w1 = __builtin_bit_cast(float, route[(size_t)m * 8 + 5]);
        f32x4 x[4]; float ss = 0.f;
#pragma unroll
        for (int j = 0; j < 4; ++j) {
            const int col = 4 * C.lane + 256 * j;
            const v2u a = *(const v2u*)(ym + (size_t)p0 * 1024 + col), b = *(const v2u*)(ym + (size_t)p1 * 1024 + col);
            const f32x4 ya = (f32x4){bflo(a.x), bfhi(a.x), bflo(a.y), bfhi(a.y)}, yb = (f32x4){bflo(b.x), bfhi(b.x), bflo(b.y), bfhi(b.y)};
            const f32x4 g = *(const f32x4*)(gv + col);
            x[j] = *(const f32x4*)(xr + col) + g * (ya * w0 + yb * w1);
            if (NEXT != 2) *(f32x4*)(xr + col) = x[j];
            ss += (x[j].x * x[j].x + x[j].y * x[j].y) + (x[j].z * x[j].z + x[j].w * x[j].w);
        }
        if (NEXT != 0) {
            const float rs = rsqrtf_(wave_sum(ss) * (1.0f / 1024.0f) + 1e-6f);
#pragma unroll
            for (int j = 0; j < 4; ++j) {
                const int col = 4 * C.lane + 256 * j;
                if (NEXT == 2) *(f32x4*)(xr + col) = x[j] * rs * gn[j];
                else { const f32x4 sh = *(const f32x4*)(modn + (size_t)mrow * 6144 + col), scl = *(const f32x4*)(modn + (size_t)mrow * 6144 + 1024 + col);
                    st4bf(hb + (size_t)m * 1024 + col, (x[j] * rs * gn[j]) * (scl + 1.0f) + sh); }
            }
        }
    }
}
__device__ __forceinline__ void final_norm(const Ctx& C) {
    const int gw = C.wg * NWAVES + C.wave, NGW = C.G * NWAVES;
    f32x4 gv[4];
#pragma unroll
    for (int j = 0; j < 4; ++j) gv[j] = *(const f32x4*)(C.in[I_FNG] + 4 * C.lane + 256 * j);
    for (int m = gw; m < T_LAT; m += NGW) {
        float* xr = C.out + (size_t)m * 1024;
        f32x4 v[4]; float s = 0.f;
#pragma unroll
        for (int j = 0; j < 4; ++j) { v[j] = *(const f32x4*)(xr + 4 * C.lane + 256 * j); s += (v[j].x * v[j].x + v[j].y * v[j].y) + (v[j].z * v[j].z + v[j].w * v[j].w); }
        const float rs = rsqrtf_(wave_sum(s) * (1.0f / 1024.0f) + 1e-6f);
#pragma unroll
        for (int j = 0; j < 4; ++j) *(f32x4*)(xr + 4 * C.lane + 256 * j) = v[j] * rs * gv[j];
    }
}

constexpr int NPH_L = 13, PH_FINAL = 1 + DEPTH * NPH_L, NPHASE = PH_FINAL + 1;
__host__ __device__ inline bool phase_exists(int ph) {
    if (ph == 0) return true;
    if (ph == PH_FINAL) return false;
    const int l = (ph - 1) / NPH_L, k = (ph - 1) % NPH_L;
    if (l >= 2 && !(l & 1) && k == 0) return false;
    if (!(l & 1) && k >= 11) return false;
    if (!RW_VSPLIT && k == 4) return false;
    return true;
}
#ifndef PH_MASK
#define PH_MASK 0xFFFFFF
#endif
#define PM(k) ((PH_MASK >> (k)) & 1)
#ifndef SK_MASK
#define SK_MASK 0xFFFF
#endif
#define SK(k) ((SK_MASK >> (k)) & 1)
#ifndef REP_MASK
#define REP_MASK 0
#endif
#define NREP(k) (((REP_MASK >> (k)) & 1) ? 2 : 1)

__global__ void __launch_bounds__(NTHR, 2) fwd_kernel(Args args) {
    extern __shared__ __attribute__((aligned(16))) unsigned char lds_raw[];
    Ctx C; C.in = args.in; C.out = args.out; C.ws = args.ws; C.lds = (LAS unsigned char*)lds_raw;
    C.tid = threadIdx.x; C.lane = C.tid & 63; C.wave = __builtin_amdgcn_readfirstlane(C.tid >> 6); C.G = gridDim.x; C.wg = blockIdx.x;
    volatile LAS unsigned* MISC = (volatile LAS unsigned*)(C.lds + MISC_OFF);
    if (C.tid < 64) MISC[C.tid] = 0u;
    __syncthreads();
    const int lo = args.ph_lo, hi = args.ph_hi;
    const bool multi = (hi - lo) > 1;
    if (multi) (void)xcd_barrier_post(WSP(unsigned, WS_CTL) + CW_BAR, MISC + 8);
#define IN(k) (lo <= (k) && (k) < hi)
#define SEAM(k) do { if (IN((k) + 1)) { XcdBarrier b2_; b2_.bar = WSP(unsigned, WS_CTL) + CW_BAR; b2_.x = xb_xcc_id(); b2_.st = (volatile LAS unsigned*)(C.lds + MISC_OFF) + 8; xcd_barrier(b2_); } } while (0)
#define FRESH() do { int t_ = threadIdx.x; asm volatile("" : "+v"(t_)); C.tid = t_; C.lane = t_ & 63; C.wave = __builtin_amdgcn_readfirstlane(t_ >> 6); } while (0)
#define PHASE(bit, k) if (PM(bit) && IN(pb + (k))) for (int rep_ = 0; rep_ < NREP(bit); ++rep_)
#define CLAIM(qh, var) __syncthreads(); if (C.tid == 0) *qslot = atomicAdd((qh), 1u); __syncthreads(); const int var = (int)*qslot;

    LAS unsigned* qslot = (LAS unsigned*)(C.lds + MISC_OFF + 128);
    if (PM(20) && IN(0)) { phase_pre(C); SEAM(0); }

#pragma unroll 1
    for (int l = 0; l < DEPTH; ++l) {
        const int pb = 1 + l * NPH_L;
        if (hi <= pb || lo >= pb + NPH_L) continue;
        const bool last = (l == DEPTH - 1), moe = (l & 1);
        const int nrows = last ? T_LAT : T_ALL;
        const float* xlat = (l == 0) ? C.in[I_X] : C.out; const float* xctx = (l == 0) ? C.in[I_CTX] : WSP(const float, WS_XC);
        const float* modv = WSP(const float, WS_MODV) + (size_t)l * 9 * 6144;
        unsigned* qbase = WSP(unsigned, WS_CTL) + CW_PREPQ + 256 * l;

        if (!(l >= 2 && !(l & 1))) PHASE(0, 0) { FRESH();
            convert_small(C, l);
            if (l == 0) { FRESH(); convert_items(C, 0, 3, C.wg * NWAVES + C.wave, C.G * NWAVES); }
            __syncthreads();
            FRESH(); norm_rows<false>(C, l, xlat, xctx, C.in[I_NMIXG] + l * 1024, 0, 1024, T_ALL, 0);
            SEAM(pb + 0);
        }
        PHASE(1, 1) { FRESH();
            pg8::Gemm g{WSP(const bf16, WS_HB), WSP(const bf16, WS_WIN), T_ALL, PLD, 1024, 0};
            pg8::StaticOrder S; S.init(T_ALL, PLD, C.G, C.wg);
            pg8::EpiBf16<0> E{WSP(bf16, WS_P), PLD, nullptr, 0, 0};
            pg8::gemm_phase<pg8::EpiBf16<0>, pg8::StaticOrder, false>(C.lds, g, S, E, nullptr);
            SEAM(pb + 1);
        }
        if (PM(2) && IN(pb + 2)) for (int rep_ = 0; rep_ < NREP(2); ++rep_) { FRESH();
            for (;;) {
                CLAIM(qbase + 16 * rep_, k)
                if (k >= 3 * NB * NCH) break;
                const int kind = k / (NB * NCH), u = k % (NB * NCH);
                FRESH();
                if (kind == 0) { for (int r3_ = 0; r3_ < NREP(24); ++r3_) { FRESH(); if (SK(1)) rwkv_prep2(C, l, u / NCH, u % NCH); } }
                else if (kind == 1) { for (int r3_ = 0; r3_ < NREP(25); ++r3_) { FRESH(); if (SK(0)) lru_chunk_mfma<false>(C, l, u / NCH, u % NCH); } }
                else { for (int r3_ = 0; r3_ < NREP(26); ++r3_) { FRESH(); if (SK(2)) gdn_prep(C, l, u / NCH, u % NCH); } }
            }
            SEAM(pb + 2);
        }
        if (PM(3) && IN(pb + 3)) for (int rep_ = 0; rep_ < NREP(3); ++rep_) { FRESH();
            constexpr int NCL = 2 * NB * NH * NCH / 4;
            for (;;) {
                CLAIM(qbase + 64 + 16 * rep_, k)
                if (k >= (RW_VSPLIT ? NCL : 2 * NCL)) break;
                FRESH();
                if (k < NCL) { if (SK(9)) gdn_solve_item(C, l, 4 * k + (C.wave >> 1)); }
                else { if (SK(10)) rwkv_solve_item(C, l, 4 * (k - NCL) + (C.wave >> 1)); }
            }
            FRESH(); if (SK(6) && C.wg < 8) lru_carry(C, C.wg * NTHR + C.tid);
            SEAM(pb + (RW_VSPLIT ? 3 : 4));
        }
#if RW_VSPLIT
        if (PM(3) && IN(pb + 4)) { FRESH();
            for (;;) {
                CLAIM(qbase + 128, k)
                if (k >= 2 * NB * NH * NCH / 4) break;
                FRESH();
                if (SK(10)) rwkv_solve_item(C, l, 4 * k + (C.wave >> 1));
            }
            SEAM(pb + 4);
        }
#endif
        if (PM(4) && IN(pb + 5)) { FRESH();
            if (SK(3) && C.wg < (RW_VSPLIT ? 128 : 64)) { if (NREP(20) > 1) { FRESH(); rwkv_chunked<true>(C, l, C.wg); } FRESH(); rwkv_chunked<false>(C, l, C.wg); }
            else if (SK(4) && C.wg >= 128 && C.wg < 192) { for (int r2_ = 0; r2_ < NREP(21); ++r2_) { FRESH(); mlstm_chunked(C, l, C.wg - 128); } }
            else if (SK(5) && C.wg >= 192) { if (NREP(22) > 1) { FRESH(); gdn_chunked<true>(C, l, C.wg - 192); } FRESH(); gdn_chunked<false>(C, l, C.wg - 192); }
            {
                FRESH();
                const int nun = last ? NB * 64 : NB * NCH;
                for (;;) {
                    CLAIM(qbase + 192, u0)
                    if (u0 >= 128 + nun) break;
                    if (u0 < 128) {
                        FRESH(); if (l > 0) convert_items(C, l, 2, u0 * NWAVES + C.wave, 128 * NWAVES);
                        if (l + 1 < DEPTH) { FRESH(); convert_items(C, l + 1, 1, u0 * NWAVES + C.wave, 128 * NWAVES); }
                    } else {
                        const int u = u0 - 128;
                        const int b = last ? (u >> 6) : (u / NCH), c = last ? 4 + (u & 63) : (u % NCH);
                        if (SK(7)) lru_chunk_mfma<true>(C, l, b, c);
                    }
                }
            }
            SEAM(pb + 5);
        }
        PHASE(5, 6) { FRESH();
            if (SK(8)) finish_rows(C, l, nrows);
            SEAM(pb + 6);
        }
        if (PM(6) && IN(pb + 7)) { FRESH();
            pg8::Gemm g{WSP(const bf16, WS_HB), WSP(const bf16, WS_WOUT), nrows, 1024, 1024, 0};
            pg8::StaticOrder S; S.init(nrows, 1024, C.G, C.wg);
            pg8::EpiRes E{xlat, xctx, C.out, WSP(float, WS_XC), modv + 2 * 1024};
            pg8::gemm_phase<pg8::EpiRes, pg8::StaticOrder, false>(C.lds, g, S, E, nullptr);
            SEAM(pb + 7);
        }
        if (PM(7) && IN(pb + 8)) { FRESH();
            if (moe) norm_rows<true>(C, l, C.out, WSP(const float, WS_XC), C.in[I_NFFNG] + l * 1024, 3 * 1024, 4 * 1024, nrows, l >> 1);
            else norm_rows<false>(C, l, C.out, WSP(const float, WS_XC), C.in[I_NFFNG] + l * 1024, 3 * 1024, 4 * 1024, nrows, 0);
            SEAM(pb + 8);
        }
        if (!moe) {
            if (PM(8) && IN(pb + 9)) for (int rep_ = 0; rep_ < NREP(8); ++rep_) { FRESH();
                pg8::Gemm g{WSP(const bf16, WS_HB), WSP(const bf16, WS_WGU), nrows, 2 * DFF, 1024, 0};
                pg8::StaticOrder S; S.init(nrows, 2 * DFF, C.G, C.wg);
                pg8::EpiSwiglu E{WSP(bf16, WS_P), DFF};
                pg8::gemm_phase<pg8::EpiSwiglu, pg8::StaticOrder, false>(C.lds, g, S, E, nullptr);
                SEAM(pb + 9);
            }
            if (PM(9) && IN(pb + 10)) { FRESH();
                pg8::Gemm g{WSP(const bf16, WS_P), WSP(const bf16, WS_WDN), nrows, 1024, DFF, 0};
                pg8::StaticOrder S; S.init(nrows, 1024, C.G, C.wg);
                pg8::EpiRes E{C.out, WSP(const float, WS_XC), C.out, WSP(float, WS_XC), modv + 5 * 1024};
                pg8::gemm_phase<pg8::EpiRes, pg8::StaticOrder, false>(C.lds, g, S, E, nullptr);
                SEAM(pb + 12);
            }
        } else {
            if (PM(10) && IN(pb + 9)) { FRESH(); moe_scatter(C, l >> 1, nrows); SEAM(pb + 9); }
            if (PM(11) && IN(pb + 10)) for (int rep_ = 0; rep_ < NREP(11); ++rep_) { FRESH();
                pg8::Gemm g{WSP(const bf16, WS_MIX), WSP(const bf16, WS_WGU), 0, 2 * DFE, 1024, (size_t)2 * DFE * 1024};
                pg8::MoeOrder S; S.init(WSP(const int, WS_TAB), (2 * DFE) / 256, C.G, C.wg);
                pg8::EpiSwiglu E{WSP(bf16, WS_P), DFE};
                pg8::gemm_phase<pg8::EpiSwiglu, pg8::MoeOrder, false>(C.lds, g, S, E, nullptr);
                SEAM(pb + 10);
            }
            if (PM(12) && IN(pb + 11)) for (int rep_ = 0; rep_ < NREP(12); ++rep_) { FRESH();
                pg8::Gemm g{WSP(const bf16, WS_P), WSP(const bf16, WS_WDN), 0, 1024, DFE, (size_t)1024 * DFE};
                pg8::MoeOrder S; S.init(WSP(const int, WS_TAB), 4, C.G, C.wg);
                pg8::EpiBf16<0> E{WSP(bf16, WS_MIX), 1024, nullptr, 0, 0};
                pg8::gemm_phase<pg8::EpiBf16<0>, pg8::MoeOrder, false>(C.lds, g, S, E, nullptr);
                SEAM(pb + 11);
            }
            if (PM(13) && IN(pb + 12)) { FRESH();
                if (last) moe_combine<2>(C, l, nrows);
                else { convert_small(C, l + 1); FRESH(); moe_combine<1>(C, l, nrows); if (IN(pb + NPH_L + 1)) { XcdBarrier b2_; b2_.bar = WSP(unsigned, WS_CTL) + CW_BAR; b2_.x = xb_xcc_id(); b2_.st = (volatile LAS unsigned*)(C.lds + MISC_OFF) + 8; xcd_barrier(b2_); } }
            }
        }
    }
}

extern "C" void kernel_launch(void* const* d_in, const int* in_sizes, int n_in, void* d_out, int out_size, void* d_ws, size_t ws_size, hipStream_t stream) {
    static int grid = 0;
    if (grid == 0) {
        if (n_in != N_IN || in_sizes[0] != T_LAT * DM || out_size != T_LAT * DM || ws_size < WS_END) {
            fprintf(stderr, "kernel_launch: unexpected problem (n_in %d, in0 %d, out %d, ws %zu < %zu)\n", n_in, n_in > 0 ? in_sizes[0] : -1, out_size, ws_size, (size_t)WS_END); grid = -1; return; }
        int dev = 0, cus = 0, per_cu = 0;
        if (hipGetDevice(&dev) != hipSuccess || hipDeviceGetAttribute(&cus, hipDeviceAttributeMultiprocessorCount, dev) != hipSuccess) { grid = -1; return; }
        if (hipFuncSetAttribute((const void*)fwd_kernel, hipFuncAttributeMaxDynamicSharedMemorySize, LDS_BYTES) != hipSuccess) { fprintf(stderr, "kernel_launch: hipFuncSetAttribute failed\n"); grid = -1; return; }
        if (hipOccupancyMaxActiveBlocksPerMultiprocessor(&per_cu, (const void*)fwd_kernel, NTHR, LDS_BYTES) != hipSuccess || per_cu < 1) { fprintf(stderr, "kernel_launch: occupancy query says %d\n", per_cu); grid = -1; return; }
        grid = cus;
        if (grid != 256) fprintf(stderr, "kernel_launch: note: %d CUs\n", grid);
    }
    if (grid < 0) return;
    if (hipMemsetAsync((char*)d_ws + WS_CTL, 0, CTL_BYTES, stream) != hipSuccess) return;
    Args a{};
    for (int i = 0; i < N_IN; ++i) a.in[i] = (const float*)d_in[i];
    a.out = (float*)d_out; a.ws = (unsigned char*)d_ws;
#if MK_ONE_LAUNCH
    a.ph_lo = 0; a.ph_hi = NPHASE;
    hipLaunchKernelGGL(fwd_kernel, dim3(grid), dim3(NTHR), LDS_BYTES, stream, a);
#else
    for (int ph = 0; ph < NPHASE; ++ph) { if (!phase_exists(ph)) continue; a.ph_lo = ph; a.ph_hi = ph + 1; hipLaunchKernelGGL(fwd_kernel, dim3(grid), dim3(NTHR), LDS_BYTES, stream, a); }
#endif
}
```

```cpp
#define MK_ONE_LAUNCH 1
#include <hip/hip_runtime.h>
#include <cstdio>
#include <cstdint>

#define GAS __attribute__((address_space(1)))
#define LAS __attribute__((address_space(3)))
typedef unsigned short bf16;
typedef unsigned v4u __attribute__((ext_vector_type(4)));
typedef unsigned v2u __attribute__((ext_vector_type(2)));
typedef float f32x4 __attribute__((ext_vector_type(4)));
typedef float f32x2 __attribute__((ext_vector_type(2)));
typedef short bf16x8 __attribute__((ext_vector_type(8)));
#define LDS_WAIT() asm volatile("s_waitcnt lgkmcnt(0)" ::: "memory")
#define VM_WAIT() asm volatile("s_waitcnt vmcnt(0)" ::: "memory")

constexpr int DM = 1024, NB = 8, SEQ = 4096, DEPTH = 4, CTXL = 256, GW = 256, HD = 64, NH = 4;
constexpr int T_LAT = NB * SEQ, T_CTX = NB * CTXL, T_ALL = T_LAT + T_CTX;
constexpr int IN_COLS = 3552, PLD = 3584;
constexpr int OFF_B = 512, OFF_C = 1472, OFF_D = 2512, B_COLS = 960;
constexpr int DFF = 2816, NE = 8, DFE = 1408;
constexpr int NCH = 68;
constexpr int NSTEP = 4352;
constexpr int MOE_MAXBLK = 280;
constexpr int NWAVES = 8, NTHR = 512;
#ifndef RW_VSPLIT
#define RW_VSPLIT 0
#endif

constexpr size_t MiB = 1u << 20;
constexpr size_t WS_CTL = 0, CTL_BYTES = 1 * MiB;
constexpr size_t WS_MODV = 1 * MiB;
constexpr size_t WS_XC = 2 * MiB;
constexpr size_t WS_WIN = 10 * MiB;
constexpr size_t WS_WOUT = 17 * MiB;
constexpr size_t WS_WGU = 19 * MiB;
constexpr size_t WS_WDN = 63 * MiB;
constexpr size_t WS_HB = 85 * MiB;
constexpr size_t WS_P = 153 * MiB;
constexpr size_t WS_MIX = 391 * MiB;
constexpr size_t WS_OUTB = WS_MIX, WS_OUTC = WS_MIX + 34 * MiB, WS_OUTD = WS_MIX + 68 * MiB, WS_GQ = WS_MIX + 102 * MiB, WS_G = WS_MIX + 153 * MiB;
constexpr size_t WS_RKV = WS_MIX + 170 * MiB;
constexpr size_t WS_SMALL = 612 * MiB;
constexpr size_t WS_LSUM = WS_SMALL;
constexpr size_t WS_HIN = WS_SMALL + 3 * MiB;
constexpr size_t WS_ROUTE = WS_SMALL + 5 * MiB;
constexpr size_t WS_POS = WS_SMALL + 7 * MiB;
constexpr size_t WS_BONUS = WS_SMALL + 8 * MiB;
constexpr size_t WS_WGBASE = WS_SMALL + 9 * MiB;
constexpr size_t WS_TAB = WS_WGBASE + 65536;
constexpr size_t WS_LRUWT = WS_SMALL + 10 * MiB;
constexpr size_t WS_RWT = WS_LRUWT + 131072;
constexpr size_t WS_RINV = WS_SMALL + 11 * MiB;
constexpr size_t WS_END = 624 * MiB;
constexpr int CW_MOECNT = 1024;
constexpr int CW_PREPQ = 2048;
constexpr int CW_BAR = 4096;

constexpr int LDS_BYTES = 135168;
constexpr int MISC_OFF = 131072;

__device__ __forceinline__ unsigned f2bf(float f) { unsigned u = __builtin_bit_cast(unsigned, f); return (u + 0x7fffu + ((u >> 16) & 1u)) >> 16; }
typedef __bf16 bf16n2 __attribute__((ext_vector_type(2)));
__device__ __forceinline__ unsigned pk2(float lo, float hi) { const f32x2 v = {lo, hi}; return __builtin_bit_cast(unsigned, __builtin_convertvector(v, bf16n2)); }
__device__ __forceinline__ unsigned f2bf1(float f) { return pk2(f, f) & 0xffffu; }
__device__ __forceinline__ float bf2f(unsigned short v) { return __builtin_bit_cast(float, (unsigned)v << 16); }
__device__ __forceinline__ float bflo(unsigned v) { return __builtin_bit_cast(float, v << 16); }
__device__ __forceinline__ float bfhi(unsigned v) { return __builtin_bit_cast(float, v & 0xffff0000u); }
template <int CTRL, int RM, bool BC> __device__ __forceinline__ float dpp_x(float oldv, float v) { return __builtin_bit_cast(float, __builtin_amdgcn_update_dpp(__builtin_bit_cast(int, oldv), __builtin_bit_cast(int, v), CTRL, RM, 0xF, BC)); }
__device__ __forceinline__ float wave_sum(float v) {
    v += dpp_x<0xB1, 0xF, true>(0.f, v); v += dpp_x<0x4E, 0xF, true>(0.f, v); v += dpp_x<0x141, 0xF, true>(0.f, v); v += dpp_x<0x140, 0xF, true>(0.f, v);
    v += dpp_x<0x142, 0xA, false>(0.f, v); v += dpp_x<0x143, 0xC, false>(0.f, v);
    return __builtin_bit_cast(float, __builtin_amdgcn_readlane(__builtin_bit_cast(int, v), 63));
}
template <int CTRL> __device__ __forceinline__ float dpp_f(float v) { return __builtin_bit_cast(float, __builtin_amdgcn_update_dpp(0, __builtin_bit_cast(int, v), CTRL, 0xF, 0xF, true)); }
__device__ __forceinline__ float row16_sum(float v) {
    v += dpp_f<0xB1>(v);
    v += dpp_f<0x4E>(v);
    v += dpp_f<0x141>(v);
    v += dpp_f<0x140>(v);
    return v;
}
__device__ __forceinline__ float sigmoidf_(float x) { return __builtin_amdgcn_rcpf(1.0f + __expf(-x)); }
__device__ __forceinline__ float softplusf_(float x) { return fmaxf(x, 0.f) + __logf(1.0f + __expf(-fabsf(x))); }
__device__ __forceinline__ float expm1f_(float x) { return x > -0.3f ? x * (1.0f + x * (0.5f + x * (0.16666667f + x * (0.041666668f + x * 0.0083333338f)))) : __expf(x) - 1.0f; }
__device__ __forceinline__ float siluf_(float x) { return x * __builtin_amdgcn_rcpf(1.0f + __expf(-x)); }
__device__ __forceinline__ float tanhf_(float x) { const float e = __expf(2.0f * x); return 1.0f - 2.0f * __builtin_amdgcn_rcpf(e + 1.0f); }
__device__ __forceinline__ float rsqrtf_(float x) { return __builtin_amdgcn_rsqf(x); }
__device__ __forceinline__ float gelu_tanh(float x) { return 0.5f * x * (1.0f + tanhf_(0.7978845608028654f * (x + 0.044715f * x * x * x))); }
__device__ __forceinline__ f32x4 ld4bf(const bf16* p) { const v2u a = *(const v2u*)p; return (f32x4){bflo(a.x), bfhi(a.x), bflo(a.y), bfhi(a.y)}; }
__device__ __forceinline__ void st4bf(bf16* p, const f32x4& v) { v2u o; o.x = pk2(v.x, v.y); o.y = pk2(v.z, v.w); *(v2u*)p = o; }
#define XB_TMO      128
#define XB_XCNT(j)  (256  + 64 * (j))
#define XB_XSUB(j)  (1280 + 64 * (j))
#define XB_XGEN(j)  (2304 + 64 * (j))
#define XB_TOP      3328
#define XB_TOPGEN   3392
#define XCD_BAR_WORDS 3456
#define XB_SPIN_CAP (1u << 22)

__device__ __forceinline__ unsigned xb_ld(unsigned* p)              { return __hip_atomic_load(p, __ATOMIC_RELAXED, __HIP_MEMORY_SCOPE_AGENT); }
__device__ __forceinline__ unsigned xb_add(unsigned* p, unsigned v) { return __hip_atomic_fetch_add(p, v, __ATOMIC_RELAXED, __HIP_MEMORY_SCOPE_AGENT); }
__device__ __forceinline__ unsigned xb_xcc_id() { return (unsigned)__builtin_amdgcn_s_getreg((3 << 11) | 20) & 0xFu; }
#define XB_SPIN(cond, bar) do { unsigned _sp = 0; while (cond) { __builtin_amdgcn_s_sleep(1); \
    if ((++_sp & 255u) == 0u) { if (xb_ld(&(bar)[XB_TMO])) break; if (_sp > XB_SPIN_CAP) { atomicAdd(&(bar)[XB_TMO], 1u); break; } } } } while (0)

struct XcdBarrier {
    unsigned* bar; unsigned x;
    volatile LAS unsigned* st;
};

__device__ __forceinline__ XcdBarrier xcd_barrier_post(unsigned* bar, volatile LAS unsigned* st) {
    XcdBarrier b; b.bar = bar; b.x = xb_xcc_id(); b.st = st;
    if (threadIdx.x == 0) (void)xb_add(&bar[XB_XCNT(b.x)], 1u);
    return b;
}
__device__ __forceinline__ void xcd_barrier_complete(unsigned* bar, unsigned x, unsigned& nloc, unsigned& nx) {
    const unsigned G = gridDim.x * gridDim.y * gridDim.z;
    unsigned sum, cnt, mine, sp = 0u;
    for (;;) {
        sum = 0u; cnt = 0u; mine = 0u;
#pragma unroll
        for (unsigned j = 0; j < 16; ++j) { const unsigned c = xb_ld(&bar[XB_XCNT(j)]); sum += c; cnt += (c > 0u) ? 1u : 0u; mine = (j == x) ? c : mine; }
        if (sum == G) break;
        __builtin_amdgcn_s_sleep(1);
        if ((++sp & 255u) == 0u) { if (xb_ld(&bar[XB_TMO])) break; if (sp > XB_SPIN_CAP) { atomicAdd(&bar[XB_TMO], 1u); break; } }
    }
    nloc = mine > 0u ? mine : 1u; nx = cnt > 0u ? cnt : 1u;
}

__device__ __forceinline__ void xcd_barrier(const XcdBarrier& b) {
    asm volatile("s_waitcnt vmcnt(0)" ::: "memory");
    __syncthreads();
    if (threadIdx.x == 0) {
        unsigned* bar = b.bar;
        __builtin_amdgcn_s_waitcnt(0);
        unsigned nloc = b.st[0], nx = b.st[1];
        if (nloc == 0u) { xcd_barrier_complete(bar, b.x, nloc, nx); b.st[0] = nloc; b.st[1] = nx; }
        const unsigned old = xb_add(&bar[XB_XSUB(b.x)], 1u);
        const unsigned gen = old / nloc;
        if (old + 1u == (gen + 1u) * nloc) {
            __builtin_amdgcn_fence(__ATOMIC_RELEASE, "agent");
            asm volatile("s_waitcnt vmcnt(0)" ::: "memory");
            const unsigned og = xb_add(&bar[XB_TOP], 1u);
            const unsigned tg = og / nx;
            if (og + 1u == (tg + 1u) * nx) xb_add(&bar[XB_TOPGEN], 1u);
            else XB_SPIN(xb_ld(&bar[XB_TOPGEN]) == tg, bar);
            __builtin_amdgcn_fence(__ATOMIC_ACQUIRE, "agent");
            xb_add(&bar[XB_XGEN(b.x)], 1u);
            asm volatile("s_waitcnt vmcnt(0)" ::: "memory");
        } else {
            XB_SPIN(xb_ld(&bar[XB_XGEN(b.x)]) == gen, bar);
            __builtin_amdgcn_fence(__ATOMIC_ACQUIRE, "agent");
            asm volatile("s_waitcnt vmcnt(0)" ::: "memory");
        }
    }
    __syncthreads();
}

namespace pg8 {
#define PG8_LAS __attribute__((address_space(3)))
typedef unsigned short bf16_t;
typedef short bf16x8 __attribute__((ext_vector_type(8)));
typedef float f32x4 __attribute__((ext_vector_type(4)));
typedef unsigned u32x4 __attribute__((ext_vector_type(4)));
constexpr int BM = 256, BK = 64, HALF = 128, HTB = HALF * BK * 2  , STAGE_BYTES = 8 * HTB, NXCD = 8, WGM = 8;

__host__ __device__ __forceinline__ int lds_byte(int r, int c) { const int st = (r >> 4) * 2 + (c >> 5), rr = r & 15, cc = c & 31, ob = rr * 64 + cc * 2; return st * 1024 + (ob ^ (((ob >> 9) & 1) << 5)); }
__host__ __device__ __forceinline__ void stage_rc(int b, int& R, int& C) { const int st = b / 1024, sb = b % 1024, swz = sb ^ (((sb >> 9) & 1) << 5); R = (st >> 1) * 16 + swz / 64; C = (st & 1) * 32 + (swz % 64) / 2; }
__host__ __device__ __forceinline__ int perm32(int rho) { const int n = rho >> 4, i = rho & 15; return 8 * (i >> 2) + 4 * n + (i & 3); }

struct Unit { int pm, pn, e; };
struct Gemm { const bf16_t* A; const bf16_t* Bt; int M, N, K; size_t estride; };

struct StaticOrder {
    int nM, nN, nwg, G, c;
    __host__ __device__ void init(int M, int N, int G_, int c_) { nM = M / BM; nN = N / BM; nwg = nM * nN; G = G_; c = c_; }
    __host__ __device__ bool next(int i, Unit& u) const {
        const long L = (long)i * G + c; if (L >= nwg) return false;
        int wgid = (int)L; { const int q = nwg / NXCD, r = nwg % NXCD, xcd = wgid % NXCD, off = wgid / NXCD; wgid = (xcd < r ? xcd * (q + 1) : r * (q + 1) + (xcd - r) * q) + off; }
        const int nig = WGM * nN, gid = wgid / nig, fm = gid * WGM, gsz = (nM - fm) < WGM ? (nM - fm) : WGM;
        u.pm = fm + ((wgid % nig) % gsz); u.pn = (wgid % nig) / gsz; u.e = 0; return true;
    }
    __device__ __forceinline__ void a_ready(const Unit&) const {}
    __device__ __forceinline__ void done(const Unit&) const {}
};
__device__ __forceinline__ unsigned cvt_pk_bf16(float lo, float hi) { unsigned r; asm volatile("v_cvt_pk_bf16_f32 %0, %1, %2" : "=v"(r) : "v"(lo), "v"(hi)); return r; }
typedef float f32x2 __attribute__((ext_vector_type(2)));
__device__ __forceinline__ f32x2 gelu_pk(f32x2 v) {
    const f32x2 av = __builtin_elementwise_abs(v), d = av * 0.2316418882f + 1.0f;
    f32x2 t; t.x = __builtin_amdgcn_rcpf(d.x); t.y = __builtin_amdgcn_rcpf(d.y);
    f32x2 q = t * 0.5307027145f + (-0.7265760135f); q = q * t + 0.7107068705f; q = q * t + (-0.142248368f); q = q * t + 0.127414796f; q = q * t;
    const f32x2 s = (v * v) * (-0.72134752044f);
    f32x2 e; e.x = __builtin_amdgcn_exp2f(s.x); e.y = __builtin_amdgcn_exp2f(s.y);
    const f32x2 m = v * (q * e), r = v - m;
    f32x2 o; o.x = v.x < 0.f ? m.x : r.x; o.y = v.y < 0.f ? m.y : r.y; return o;
}

struct EpiF32 {
    static constexpr bool PERM = false, AFTER_DRAIN = false;
    float* C; int ldc; const float* bias;
    __device__ __forceinline__ void operator()(const f32x4 (&acc)[2][2][4][2], const Unit& u, int wr, int wc, int fr, int fq) const {
        const int row0 = u.pm * BM + wr * 64 + fr, col0 = u.pn * BM + wc * 32 + 4 * fq;
        f32x4 bv[2][2];
#pragma unroll
        for (int bj = 0; bj < 2; ++bj)
#pragma unroll
            for (int n = 0; n < 2; ++n) bv[bj][n] = bias ? *(const f32x4*)(bias + col0 + bj * HALF + n * 16) : (f32x4){0.f, 0.f, 0.f, 0.f};
#pragma unroll
        for (int ai = 0; ai < 2; ++ai)
#pragma unroll
            for (int m = 0; m < 4; ++m) { float* rowp = C + (size_t)(row0 + ai * HALF + m * 16) * ldc + col0;
#pragma unroll
                for (int bj = 0; bj < 2; ++bj)
#pragma unroll
                    for (int n = 0; n < 2; ++n) *(f32x4*)(rowp + bj * HALF + n * 16) = acc[ai][bj][m][n] + bv[bj][n]; }
    }
};
template <int ACT  > struct EpiBf16 {
    static constexpr bool PERM = true, AFTER_DRAIN = false;
    bf16_t* O; int ldc; const float* bias; int split_cols; size_t split_stride;
    __device__ __forceinline__ void operator()(const f32x4 (&acc)[2][2][4][2], const Unit& u, int wr, int wc, int fr, int fq) const {
        const int row0 = u.pm * BM + wr * 64 + fr; int colt = u.pn * BM; bf16_t* base = O;
        if (split_cols) { const int t = colt / split_cols; base += (size_t)t * split_stride; colt -= t * split_cols; }
        const int col0 = colt + wc * 32 + 8 * fq, bcol0 = u.pn * BM + wc * 32 + 8 * fq;
        f32x4 bv[2][2];
#pragma unroll
        for (int bj = 0; bj < 2; ++bj)
#pragma unroll
            for (int n = 0; n < 2; ++n) bv[bj][n] = bias ? *(const f32x4*)(bias + bcol0 + bj * HALF + 4 * n) : (f32x4){0.f, 0.f, 0.f, 0.f};
#pragma unroll
        for (int ai = 0; ai < 2; ++ai)
#pragma unroll
            for (int m = 0; m < 4; ++m) { bf16_t* rowp = base + (size_t)(row0 + ai * HALF + m * 16) * ldc + col0;
#pragma unroll
                for (int bj = 0; bj < 2; ++bj) { f32x4 v0 = acc[ai][bj][m][0] + bv[bj][0], v1 = acc[ai][bj][m][1] + bv[bj][1];
                    if (ACT == 1) { f32x2 a = gelu_pk((f32x2){v0[0], v0[1]}), b = gelu_pk((f32x2){v0[2], v0[3]}), c = gelu_pk((f32x2){v1[0], v1[1]}), d = gelu_pk((f32x2){v1[2], v1[3]});
                        v0 = (f32x4){a.x, a.y, b.x, b.y}; v1 = (f32x4){c.x, c.y, d.x, d.y}; }
                    if (ACT == 2) {
#pragma unroll
                        for (int j = 0; j < 4; ++j) { v0[j] = 0.5f * v0[j] * (1.0f + erff(v0[j] * 0.70710678f)); v1[j] = 0.5f * v1[j] * (1.0f + erff(v1[j] * 0.70710678f)); } }
                    u32x4 w; w.x = cvt_pk_bf16(v0[0], v0[1]); w.y = cvt_pk_bf16(v0[2], v0[3]); w.z = cvt_pk_bf16(v1[0], v1[1]); w.w = cvt_pk_bf16(v1[2], v1[3]);
                    *(u32x4*)(rowp + bj * HALF) = w; } }
    }
};

template <class Epi, class Sched, bool STAMP = false>
__device__ __forceinline__ void gemm_phase(PG8_LAS unsigned char* lds, const Gemm g, const Sched& S, const Epi& E, unsigned long long* stamps) {
    int tid_ = threadIdx.x; asm volatile("" : "+v"(tid_));
    const int tid = tid_, wid = __builtin_amdgcn_readfirstlane(tid >> 6), lane = tid & 63, wr = wid >> 2, wc = wid & 3, fr = lane & 15, fq = lane >> 4;
    const int K = g.K, nt = K / BK;
    int ts_lo = 0, ts_hi = 0, nts = 0; const unsigned long long rt_entry = STAMP ? (unsigned long long)wall_clock64() : 0ull;
#define PG8_STAMP() do { if (STAMP && wid == 0 && nts < 64) { const unsigned long long _c = (unsigned long long)clock64(); \
        ts_lo = (lane == nts) ? (int)(unsigned)_c : ts_lo; ts_hi = (lane == nts) ? (int)(unsigned)(_c >> 32) : ts_hi; ++nts; } } while (0)
    PG8_STAMP();
    unsigned voffA[2], voffB[2];
#pragma unroll
    for (int i = 0; i < 2; ++i) { int R, C; stage_rc(tid * 16 + i * 8192, R, C); const int Rb = Epi::PERM ? ((R & ~31) + perm32(R & 31)) : R;
        voffA[i] = (unsigned)(R * K + C) * 2u; voffB[i] = (unsigned)(Rb * K + C) * 2u; }
    const size_t kstep = (size_t)(BK * 2);
    const size_t hstep = (size_t)HALF * K * 2;
    const size_t tstep = 2 * hstep;
    const unsigned ldsw = (unsigned)wid * 1024u;
    const int aoff = lds_byte(wr * 64 + fr, fq * 8), boff = lds_byte(wc * 32 + fr, fq * 8);
#define PG8_SA(b, h) (((b) * 2 + (h)) * HTB)
#define PG8_SB(b, h) ((4 + (b) * 2 + (h)) * HTB)
#define PG8_STAGE(bufoff, gbase, voff) do { _Pragma("unroll") for (int _i = 0; _i < 2; ++_i) \
        __builtin_amdgcn_global_load_lds((const unsigned*)((const char*)(gbase) + (voff)[_i]), (PG8_LAS unsigned*)(lds + (bufoff) + ldsw + _i * 8192), 16, 0, 0); } while (0)
#define PG8_LDA(dst, b, h) do { _Pragma("unroll") for (int m = 0; m < 4; ++m) _Pragma("unroll") for (int k = 0; k < 2; ++k) dst[m][k] = *(const PG8_LAS bf16x8*)(lds + PG8_SA(b, h) + aoff + m * 2048 + k * 1024); } while (0)
#define PG8_LDB(dst, b, h) do { _Pragma("unroll") for (int n = 0; n < 2; ++n) _Pragma("unroll") for (int k = 0; k < 2; ++k) dst[n][k] = *(const PG8_LAS bf16x8*)(lds + PG8_SB(b, h) + boff + n * 2048 + k * 1024); } while (0)
#define PG8_MMA(ai, bj, At, Bt) do { __builtin_amdgcn_s_setprio(1); _Pragma("unroll") for (int m = 0; m < 4; ++m) _Pragma("unroll") for (int n = 0; n < 2; ++n) _Pragma("unroll") for (int k = 0; k < 2; ++k) \
        acc[ai][bj][m][n] = __builtin_amdgcn_mfma_f32_16x16x32_bf16(Bt[n][k], At[m][k], acc[ai][bj][m][n], 0, 0, 0); __builtin_amdgcn_s_setprio(0); } while (0)
#define PG8_WAIT_V(n) asm volatile("s_waitcnt vmcnt(" #n ")" ::: "memory")
#define PG8_WAIT_L(n) asm volatile("s_waitcnt lgkmcnt(" #n ")" ::: "memory")
#define PG8_BAR __builtin_amdgcn_s_barrier()
#define PG8_SCHED __builtin_amdgcn_sched_barrier(0)
    Unit cur, nxt; int ui = 0;
    if (!S.next(0, cur)) return;
    f32x4 acc[2][2][4][2];
#pragma unroll
    for (int a = 0; a < 2; ++a)
#pragma unroll
        for (int b = 0; b < 2; ++b)
#pragma unroll
            for (int m = 0; m < 4; ++m)
#pragma unroll
                for (int n = 0; n < 2; ++n) acc[a][b][m][n] = (f32x4){0.f, 0.f, 0.f, 0.f};
    bf16x8 At[4][2], B0[2][2], B1[2][2];
    const char* cA = (const char*)g.A + (size_t)cur.pm * tstep; const char* cB = (const char*)g.Bt + (size_t)cur.pn * tstep + (size_t)cur.e * g.estride * 2;
    S.a_ready(cur);
    PG8_STAGE(PG8_SB(0, 0), cB, voffB); PG8_STAGE(PG8_SA(0, 0), cA, voffA); PG8_STAGE(PG8_SB(0, 1), cB + hstep, voffB); PG8_STAGE(PG8_SA(0, 1), cA + hstep, voffA);
    if (wr == 1) PG8_BAR;
    PG8_WAIT_V(4); PG8_BAR;
    PG8_STAGE(PG8_SB(1, 0), cB + kstep, voffB); PG8_STAGE(PG8_SA(1, 0), cA + kstep, voffA); PG8_STAGE(PG8_SB(1, 1), cB + hstep + kstep, voffB);
    PG8_WAIT_V(6); PG8_BAR;
    PG8_STAMP();
    for (;;) {
        const bool has_next = S.next(ui + 1, nxt);
        const char* nA = has_next ? (const char*)g.A + (size_t)nxt.pm * tstep : cA; const char* nB = has_next ? (const char*)g.Bt + (size_t)nxt.pn * tstep + (size_t)nxt.e * g.estride * 2 : cB;
        for (int t = 0; t < nt; t += 2) {
            const bool last = (t == nt - 2);
            const char* a1 = cA + (size_t)(t + 1) * kstep;
            const char* a2 = last ? nA : cA + (size_t)(t + 2) * kstep; const char* b2 = last ? nB : cB + (size_t)(t + 2) * kstep;
            const char* a3 = a2 + kstep; const char* b3 = b2 + kstep;
            if (last && has_next) S.a_ready(nxt);
            PG8_LDB(B0, 0, 0); PG8_SCHED; PG8_LDA(At, 0, 0); PG8_STAGE(PG8_SA(1, 1), a1 + hstep, voffA);
            PG8_WAIT_L(8); PG8_BAR; PG8_WAIT_L(0); PG8_MMA(0, 0, At, B0); PG8_BAR; PG8_SCHED;
            PG8_LDB(B1, 0, 1); PG8_STAGE(PG8_SB(0, 0), b2, voffB);
            PG8_BAR; PG8_WAIT_L(0); PG8_MMA(0, 1, At, B1); PG8_BAR;
            PG8_LDA(At, 0, 1); PG8_STAGE(PG8_SA(0, 0), a2, voffA);
            PG8_BAR; PG8_WAIT_L(0); PG8_MMA(1, 0, At, B0); PG8_BAR; PG8_SCHED;
            PG8_STAGE(PG8_SB(0, 1), b2 + hstep, voffB);
            PG8_WAIT_V(6); PG8_BAR; PG8_MMA(1, 1, At, B1); PG8_BAR;
            PG8_LDB(B0, 1, 0); PG8_SCHED; PG8_LDA(At, 1, 0); PG8_STAGE(PG8_SA(0, 1), a2 + hstep, voffA);
            PG8_WAIT_L(8); PG8_BAR; PG8_WAIT_L(0); PG8_MMA(0, 0, At, B0); PG8_BAR; PG8_SCHED;
            PG8_LDB(B1, 1, 1); PG8_STAGE(PG8_SB(1, 0), b3, voffB);
            PG8_BAR; PG8_WAIT_L(0); PG8_MMA(0, 1, At, B1); PG8_BAR;
            PG8_LDA(At, 1, 1); PG8_STAGE(PG8_SA(1, 0), a3, voffA);
            PG8_BAR; PG8_WAIT_L(0); PG8_MMA(1, 0, At, B0); PG8_BAR; PG8_SCHED;
            PG8_STAGE(PG8_SB(1, 1), b3 + hstep, voffB);
            PG8_WAIT_V(6); PG8_BAR; PG8_MMA(1, 1, At, B1); PG8_BAR;
        }
        PG8_STAMP();
        if constexpr (!Epi::AFTER_DRAIN) { E(acc, cur, wr, wc, fr, fq); S.done(cur); }
        PG8_STAMP();
        if (!has_next) break;
#pragma unroll
        for (int a = 0; a < 2; ++a)
#pragma unroll
            for (int b = 0; b < 2; ++b)
#pragma unroll
                for (int m = 0; m < 4; ++m)
#pragma unroll
                    for (int n = 0; n < 2; ++n) acc[a][b][m][n] = (f32x4){0.f, 0.f, 0.f, 0.f};
        cur = nxt; cA = nA; cB = nB; ++ui;
    }
    PG8_WAIT_V(0);
    if (wr == 0) PG8_BAR;
    PG8_BAR;
    if constexpr (Epi::AFTER_DRAIN) { E.fused(acc, cur, wr, wc, fr, fq, lds, wid, lane); S.done(cur); }
    PG8_STAMP();
    if (STAMP && wid == 0) { stamps[lane] = lane < nts ? (((unsigned long long)(unsigned)ts_hi << 32) | (unsigned)ts_lo) : 0ull;
        if (lane == 62) stamps[62] = rt_entry; if (lane == 63) stamps[63] = (unsigned long long)wall_clock64(); }
#undef PG8_STAMP
#undef PG8_SA
#undef PG8_SB
#undef PG8_STAGE
#undef PG8_LDA
#undef PG8_LDB
#undef PG8_MMA
#undef PG8_WAIT_V
#undef PG8_WAIT_L
#undef PG8_BAR
#undef PG8_SCHED
}
}
namespace pg8 {
struct EpiRes {
    static constexpr bool PERM = false, AFTER_DRAIN = false;
    const float* base_lat; const float* base_ctx; float* out_lat; float* out_ctx; const float* gvec;
    __device__ __forceinline__ void operator()(const f32x4 (&acc)[2][2][4][2], const Unit& u, int wr, int wc, int fr, int fq) const {
        const bool isctx = u.pm >= 128;
        const int prow = (isctx ? (u.pm - 128) : u.pm) * BM;
        const float* base = isctx ? base_ctx : base_lat; float* out = isctx ? out_ctx : out_lat;
        const float* gv = gvec + (size_t)(isctx ? 8 : (u.pm >> 4)) * 6144;
        const int row0 = prow + wr * 64 + fr, col0 = u.pn * BM + wc * 32 + 4 * fq;
        f32x4 gvv[2][2];
#pragma unroll
        for (int bj = 0; bj < 2; ++bj)
#pragma unroll
            for (int n = 0; n < 2; ++n) gvv[bj][n] = *(const f32x4*)(gv + col0 + bj * HALF + n * 16);
#pragma unroll
        for (int ai = 0; ai < 2; ++ai)
#pragma unroll
            for (int m = 0; m < 4; ++m) { const size_t off = (size_t)(row0 + ai * HALF + m * 16) * 1024 + col0;
#pragma unroll
                for (int bj = 0; bj < 2; ++bj)
#pragma unroll
                    for (int n = 0; n < 2; ++n) { const f32x4 b = *(const f32x4*)(base + off + bj * HALF + n * 16);
                        *(f32x4*)(out + off + bj * HALF + n * 16) = b + gvv[bj][n] * acc[ai][bj][m][n]; } }
    }
};
struct EpiSwiglu {
    static constexpr bool PERM = true, AFTER_DRAIN = false;
    bf16_t* O; int ldc;
    __device__ __forceinline__ void operator()(const f32x4 (&acc)[2][2][4][2], const Unit& u, int wr, int wc, int fr, int fq) const {
        const int row0 = u.pm * BM + wr * 64 + fr, col0 = u.pn * HALF + wc * 32 + 8 * fq;
#pragma unroll
        for (int ai = 0; ai < 2; ++ai)
#pragma unroll
            for (int m = 0; m < 4; ++m) { bf16_t* rowp = O + (size_t)(row0 + ai * HALF + m * 16) * ldc + col0;
                float h[8];
#pragma unroll
                for (int n = 0; n < 2; ++n)
#pragma unroll
                    for (int j = 0; j < 4; ++j) { const float g = acc[ai][0][m][n][j], up = acc[ai][1][m][n][j]; h[n * 4 + j] = g * __builtin_amdgcn_rcpf(1.0f + __expf(-g)) * up; }
                u32x4 w; w.x = cvt_pk_bf16(h[0], h[1]); w.y = cvt_pk_bf16(h[2], h[3]); w.z = cvt_pk_bf16(h[4], h[5]); w.w = cvt_pk_bf16(h[6], h[7]);
                *(u32x4*)rowp = w; }
    }
};
struct MoeOrder {
    int nN, G, c, nunits; const int* tab;
    __device__ void init(const int* tab_, int nN_, int G_, int c_) { tab = tab_; nN = nN_; G = G_; c = c_; nunits = tab_[0] * nN_; }
    __device__ bool next(int i, Unit& u) const {
        const int L = i * G + c; if (L >= nunits) return false;
        const int q = nunits / NXCD, r = nunits % NXCD, xcd = L % NXCD, off = L / NXCD;
        const int w = (xcd < r ? xcd * (q + 1) : r * (q + 1) + (xcd - r) * q) + off;
        u.pm = w / nN; u.pn = w - u.pm * nN; u.e = tab[1 + u.pm]; return true;
    }
    __device__ __forceinline__ void a_ready(const Unit&) const {}
    __device__ __forceinline__ void done(const Unit&) const {}
};
}
enum { I_X = 0, I_C, I_CTX, I_CCTX, I_MODW, I_MODB, I_NMIXG, I_NFFNG, I_WIN, I_WOUT, I_LCW, I_LCB, I_LWA, I_LBA, I_LWX, I_LBX, I_LLAM,
       I_RMU, I_RWUP, I_RW0, I_RAUP, I_RA0, I_RGUP, I_RKK, I_RKA, I_RRK, I_RLNG, I_RLNB, I_MIB, I_MFB, I_MNG, I_GCW, I_GALOG, I_GDTB, I_GNG,
       I_FWG, I_FWU, I_FWD, I_MROUTER, I_MWG, I_MWU, I_MWD, I_FNG, N_IN };
struct Args { const float* in[N_IN]; float* out; unsigned char* ws; int ph_lo, ph_hi; };
struct Ctx {
    const float* const* in; float* out; unsigned char* ws; LAS unsigned char* lds;
    int tid, lane, wave, G, wg;
};
#define WSP(T, off) ((T*)(C.ws + (off)))

__device__ __forceinline__ int seqrow_raster(int i, int d, int b) {
    if (i < CTXL) { const int p = d ? (CTXL - 1 - i) : i; return T_LAT + b * CTXL + p; }
    const int j = i - CTXL; const int p = d ? (SEQ - 1 - j) : j; return b * SEQ + p;
}
__device__ __forceinline__ int seqrow_cm(int i, int d, int b) {
    if (i < CTXL) { const int p = d ? (CTXL - 1 - i) : i; return T_LAT + b * CTXL + p; }
    const int j = i - CTXL; const int p = d ? (SEQ - 1 - j) : j; return b * SEQ + (p & 63) * 64 + (p >> 6);
}

__device__ __forceinline__ void phase_pre(const Ctx& C) {
    LAS float* sc = (LAS float*)C.lds;
    LAS float* red = sc + 9 * 1024;
    float* modv = WSP(float, WS_MODV);
    bool filled = false;
    for (int it = C.wg; it < DEPTH * 48; it += C.G) {
        if (!filled) {
            for (int i = C.tid; i < 9 * 1024; i += NTHR) { const float v = i < 8192 ? C.in[I_C][i] : C.in[I_CCTX][i - 8192]; sc[i] = siluf_(v); }
            filled = true; __syncthreads();
        }
        const int l = it / 48, jb = it % 48, col = C.tid & 127, kg = C.tid >> 7;
        const float* W = C.in[I_MODW] + (size_t)l * 1024 * 6144 + jb * 128 + col;
        float acc[9];
#pragma unroll
        for (int r = 0; r < 9; ++r) acc[r] = 0.f;
        for (int k = kg * 256; k < kg * 256 + 256; ++k) { const float w = W[(size_t)k * 6144];
#pragma unroll
            for (int r = 0; r < 9; ++r) acc[r] += sc[r * 1024 + k] * w; }
#pragma unroll
        for (int r = 0; r < 9; ++r) red[(kg * 9 + r) * 128 + col] = acc[r];
        __syncthreads();
        for (int i = C.tid; i < 9 * 128; i += NTHR) { const int r = i >> 7, cc = i & 127;
            const float s = red[(0 * 9 + r) * 128 + cc] + red[(1 * 9 + r) * 128 + cc] + red[(2 * 9 + r) * 128 + cc] + red[(3 * 9 + r) * 128 + cc];
            modv[((size_t)l * 9 + r) * 6144 + jb * 128 + cc] = s + C.in[I_MODB][l * 6144 + jb * 128 + cc]; }
        __syncthreads();
    }
}

__device__ __forceinline__ void tr_item(const float* src, size_t ld, int k0, int ns0, bf16* dst, int drow0, int Kd, LAS float* scr, int lane, bool zero) {
    if (!zero) {
#pragma unroll 8
        for (int i = 0; i < 32; ++i) { const int kk = 2 * i + (lane >> 5); scr[kk * 33 + (lane & 31)] = src[(size_t)(k0 + kk) * ld + ns0 + (lane & 31)]; }
    }
    LDS_WAIT(); asm volatile("" ::: "memory");
    const int c = lane & 7;
#pragma unroll
    for (int j = 0; j < 4; ++j) { const int n = (lane >> 3) + 8 * j; const LAS float* s = scr + (8 * c) * 33 + n;
        v4u o; o.x = pk2(s[0 * 33], s[1 * 33]); o.y = pk2(s[2 * 33], s[3 * 33]); o.z = pk2(s[4 * 33], s[5 * 33]); o.w = pk2(s[6 * 33], s[7 * 33]);
        if (zero) o = (v4u){0u, 0u, 0u, 0u};
        *(v4u*)(dst + (size_t)(drow0 + n) * Kd + k0 + 8 * c) = o; }
    LDS_WAIT(); asm volatile("" ::: "memory");
}
__device__ __forceinline__ void convert_small(const Ctx& C, int l) {
    {
        bf16* lw = WSP(bf16, WS_LRUWT);
        for (int k = 0; k < 2 * 2 * 4 * 4096 / (128 * NTHR); ++k) {
            const int e = k * 128 * NTHR + C.wg * NTHR + C.tid;
            if (C.wg < 128) {
            const int i = e & 63, j = (e >> 6) & 63, hd = (e >> 12) & 3, g = (e >> 14) & 1, d = e >> 15;
            const float* src = (g ? C.in[I_LWX] : C.in[I_LWA]) + ((size_t)((l * 2 + d) * 4 + hd) * 64 + i) * 64 + j;
            lw[e] = (bf16)f2bf(*src);
            }
        }
    }
    if (C.wg >= 128 && C.wg < 224) {
        bf16* rw = WSP(bf16, WS_RWT);
        const int e = (C.wg - 128) * NTHR + C.tid;
        if (e < 32768) { const int r = e & 31, ch = (e >> 5) & 255, d = (e >> 13) & 1, isa = e >> 14;
            rw[e] = (bf16)f2bf((isa ? C.in[I_RAUP] : C.in[I_RWUP])[((size_t)(l * 2 + d) * 32 + r) * GW + ch]); }
        else { const int e2 = e - 32768, j = e2 & 63, ch = e2 >> 6; rw[e] = (bf16)f2bf(C.in[I_RGUP][((size_t)l * 64 + j) * GW + ch]); }
    }
}
__device__ __forceinline__ void convert_items(const Ctx& C, int l, int what, int gw, int NGW) {
    LAS float* scr = (LAS float*)(C.lds + C.wave * 8704);
    constexpr int I_IN = 16 * 112, I_OUT = 16 * 32, I_GU = 16 * 176, I_DN = 44 * 32, I_E = 16 * 88 + 22 * 32;
    const bool moe = l & 1; const int li = l >> 1;
    const int lo_it = (what & 1) ? 0 : I_IN, hi_it = (what & 2) ? I_IN + I_OUT + (moe ? NE * I_E : (I_GU + I_DN)) : I_IN;
    bf16* win = WSP(bf16, WS_WIN); bf16* wout = WSP(bf16, WS_WOUT); bf16* wgu = WSP(bf16, WS_WGU); bf16* wdn = WSP(bf16, WS_WDN);
    for (int it = lo_it + gw; it < hi_it; it += NGW) {
        int r = it;
        if (r < I_IN) { const int kb = r / 112, nb = r % 112; tr_item(C.in[I_WIN] + (size_t)l * 1024 * IN_COLS, IN_COLS, 64 * kb, 32 * nb, win, 32 * nb, 1024, scr, C.lane, nb == 111); continue; }
        r -= I_IN;
        if (r < I_OUT) { const int kb = r / 32, nb = r % 32; tr_item(C.in[I_WOUT] + (size_t)l * 1024 * 1024, 1024, 64 * kb, 32 * nb, wout, 32 * nb, 1024, scr, C.lane, false); continue; }
        r -= I_OUT;
        if (!moe) {
            if (r < I_GU) { const int kb = r / 176, nb = r % 176, tile = nb >> 3, q = nb & 7;
                const float* src = (q < 4 ? C.in[I_FWG] : C.in[I_FWU]) + (size_t)li * 1024 * DFF;
                tr_item(src, DFF, 64 * kb, tile * 128 + (q & 3) * 32, wgu, 32 * nb, 1024, scr, C.lane, false); continue; }
            r -= I_GU;
            { const int kb = r / 32, nb = r % 32; tr_item(C.in[I_FWD] + (size_t)li * DFF * 1024, 1024, 64 * kb, 32 * nb, wdn, 32 * nb, DFF, scr, C.lane, false); }
        } else {
            const int e = r / I_E; int rr = r % I_E;
            if (rr < 16 * 88) { const int kb = rr / 88, nb = rr % 88, tile = nb >> 3, q = nb & 7;
                const float* src = (q < 4 ? C.in[I_MWG] : C.in[I_MWU]) + ((size_t)li * NE + e) * 1024 * DFE;
                tr_item(src, DFE, 64 * kb, tile * 128 + (q & 3) * 32, wgu + (size_t)e * 2 * DFE * 1024, 32 * nb, 1024, scr, C.lane, false); continue; }
            rr -= 16 * 88;
            { const int kb = rr / 32, nb = rr % 32; tr_item(C.in[I_MWD] + ((size_t)li * NE + e) * DFE * 1024, 1024, 64 * kb, 32 * nb, wdn + (size_t)e * 1024 * DFE, 32 * nb, DFE, scr, C.lane, false); }
        }
    }
}

template <bool ROUTE>
__device__ __forceinline__ void norm_rows(const Ctx& C, int l, const float* xlat, const float* xctx, const float* gain, int shoff, int scoff, int nrows, int moe_li) {
    const float* modv = WSP(float, WS_MODV) + (size_t)l * 9 * 6144;
    bf16* hb = WSP(bf16, WS_HB);
    const int gw = C.wg * NWAVES + C.wave, NGW = C.G * NWAVES;
    LAS unsigned* lcnt = (LAS unsigned*)(C.lds + 65536);
    unsigned* route = WSP(unsigned, WS_ROUTE);
    if (ROUTE) { if (C.tid < 8) lcnt[C.tid] = 0u; __syncthreads(); }
    f32x4 gv[4];
#pragma unroll
    for (int j = 0; j < 4; ++j) gv[j] = *(const f32x4*)(gain + 4 * C.lane + 256 * j);
    for (int m = gw; m < nrows; m += NGW) {
        const bool isctx = m >= T_LAT;
        const float* xr = isctx ? xctx + (size_t)(m - T_LAT) * 1024 : xlat + (size_t)m * 1024;
        const float* mv = modv + (size_t)(isctx ? 8 : (m >> 12)) * 6144;
        f32x4 v[4]; float s = 0.f;
#pragma unroll
        for (int j = 0; j < 4; ++j) { v[j] = *(const f32x4*)(xr + 4 * C.lane + 256 * j); s += (v[j].x * v[j].x + v[j].y * v[j].y) + (v[j].z * v[j].z + v[j].w * v[j].w); }
        const float rs = rsqrtf_(wave_sum(s) * (1.0f / 1024.0f) + 1e-6f);
#pragma unroll
        for (int j = 0; j < 4; ++j) { const f32x4 sh = *(const f32x4*)(mv + shoff + 4 * C.lane + 256 * j), scl = *(const f32x4*)(mv + scoff + 4 * C.lane + 256 * j);
            v[j] = (v[j] * rs * gv[j]) * (scl + 1.0f) + sh;
            v2u o; o.x = pk2(v[j].x, v[j].y); o.y = pk2(v[j].z, v[j].w);
            *(v2u*)(hb + (size_t)m * 1024 + 4 * C.lane + 256 * j) = o; }
        if (ROUTE) {
            const float* rt = C.in[I_MROUTER] + (size_t)moe_li * 1024 * NE;
            float lg[8];
#pragma unroll
            for (int e = 0; e < 8; ++e) lg[e] = 0.f;
#pragma unroll
            for (int j = 0; j < 4; ++j)
#pragma unroll
                for (int q = 0; q < 4; ++q) { const int k = 4 * C.lane + 256 * j + q; const f32x4 r0 = *(const f32x4*)(rt + (size_t)k * 8), r1 = *(const f32x4*)(rt + (size_t)k * 8 + 4); const float hv = v[j][q];
                    lg[0] += hv * r0.x; lg[1] += hv * r0.y; lg[2] += hv * r0.z; lg[3] += hv * r0.w; lg[4] += hv * r1.x; lg[5] += hv * r1.y; lg[6] += hv * r1.z; lg[7] += hv * r1.w; }
#pragma unroll
            for (int e = 0; e < 8; ++e) lg[e] = wave_sum(lg[e]);
            int e0 = 0; float l0 = lg[0];
#pragma unroll
            for (int e = 1; e < 8; ++e) if (lg[e] > l0) { l0 = lg[e]; e0 = e; }
            int e1 = (e0 == 0) ? 1 : 0; float l1 = -3.0e38f;
#pragma unroll
            for (int e = 0; e < 8; ++e) if (e != e0 && lg[e] > l1) { l1 = lg[e]; e1 = e; }
            const float w0 = __builtin_amdgcn_rcpf(1.0f + __expf(l1 - l0)), w1 = 1.0f - w0;
            if (C.lane == 0) {
                const unsigned r0 = atomicAdd((unsigned*)&lcnt[e0], 1u), r1 = atomicAdd((unsigned*)&lcnt[e1], 1u);
                v4u a; a.x = (unsigned)e0; a.y = (unsigned)e1; a.z = r0; a.w = r1;
                *(v4u*)(route + (size_t)m * 8) = a;
                v2u b; b.x = __builtin_bit_cast(unsigned, w0); b.y = __builtin_bit_cast(unsigned, w1);
                *(v2u*)(route + (size_t)m * 8 + 4) = b;
            }
        }
    }
    if (ROUTE) {
        __syncthreads();
        if (C.tid < 8) { unsigned* gc = WSP(unsigned, WS_CTL) + CW_MOECNT + 64 * moe_li; const unsigned base = atomicAdd(gc + C.tid, lcnt[C.tid]); WSP(unsigned, WS_WGBASE)[C.wg * 8 + C.tid] = base; }
    }
}
__device__ __forceinline__ void lru_carry(const Ctx& C, int idx) {
    const int ch = idx & 255, d = (idx >> 8) & 1, b = idx >> 9;
    const float* ls = WSP(const float, WS_LSUM); float* hin = WSP(float, WS_HIN);
    float H = 0.f;
    for (int k = 0; k < NCH; ++k) {
        const int c = d ? (k < 4 ? 3 - k : NCH + 3 - k) : k;
        const size_t sidx = ((size_t)(b * NCH + c) * 2 + d) * 256 + ch;
        hin[sidx] = H;
        H = __expf(ls[sidx * 2]) * H + ls[sidx * 2 + 1];
    }
}

#define RAW_BARRIER() do { asm volatile("s_waitcnt lgkmcnt(0)" ::: "memory"); __builtin_amdgcn_s_barrier(); asm volatile("" ::: "memory"); } while (0)
__device__ __forceinline__ void gdn_prep(const Ctx& C, int l, int b, int c) {
    const bf16* P = WSP(const bf16, WS_P); bf16* gq = WSP(bf16, WS_GQ);
    const bool isctx = c < 4; const int p0 = isctx ? c * 64 : (c - 4) * 64; const int Lp = isctx ? CTXL : SEQ;
    const int ch = 4 * C.lane;
    auto rowof = [&](int p) -> int { return isctx ? (T_LAT + b * CTXL + p) : (b * SEQ + (p & 63) * 64 + (p >> 6)); };
    f32x4 cw[4][3], x[4][3];
#pragma unroll
    for (int j = 0; j < 4; ++j)
#pragma unroll
        for (int g = 0; g < 3; ++g) cw[j][g] = *(const f32x4*)(C.in[I_GCW] + ((size_t)l * 4 + j) * 768 + g * 256 + ch);
    const int tb = p0 + C.wave * 8;
    auto ldrow = [&](int p, f32x4 (&dst)[3]) {
        if (p >= 0 && p < Lp) { const bf16* pr = P + (size_t)rowof(p) * PLD + OFF_D + ch;
#pragma unroll
            for (int g = 0; g < 3; ++g) dst[g] = ld4bf(pr + g * 256); }
        else {
#pragma unroll
            for (int g = 0; g < 3; ++g) dst[g] = (f32x4){0.f, 0.f, 0.f, 0.f}; }
    };
    ldrow(tb - 2, x[0]); ldrow(tb - 1, x[1]); ldrow(tb, x[2]);
#pragma unroll
    for (int t = 0; t < 8; ++t) {
        ldrow(tb + t + 1, x[3]);
        bf16* orow = gq + (size_t)rowof(tb + t) * 768 + ch;
#pragma unroll
        for (int g = 0; g < 3; ++g) {
            f32x4 v = cw[0][g] * x[0][g] + cw[1][g] * x[1][g] + cw[2][g] * x[2][g] + cw[3][g] * x[3][g];
            v = (f32x4){siluf_(v.x), siluf_(v.y), siluf_(v.z), siluf_(v.w)};
            if (g < 2) { const float ss = row16_sum((v.x * v.x + v.y * v.y) + (v.z * v.z + v.w * v.w)); v = v * (rsqrtf_(ss + 1e-6f) * (g == 0 ? 0.125f : 1.0f)); }
            st4bf(orow + g * 256, v);
        }
#pragma unroll
        for (int g = 0; g < 3; ++g) { x[0][g] = x[1][g]; x[1][g] = x[2][g]; x[2][g] = x[3][g]; }
    }
}
__device__ __forceinline__ void finish_rows(const Ctx& C, int l, int nrows) {
    const bf16* P = WSP(const bf16, WS_P); bf16* yc = WSP(bf16, WS_HB);
    const bf16* ob = WSP(const bf16, WS_OUTB); const bf16* oc = WSP(const bf16, WS_OUTC); const bf16* od = WSP(const bf16, WS_OUTD);
    const bf16* gg = WSP(const bf16, WS_G); const float* bonus = WSP(const float, WS_BONUS);
    const float* mu = C.in[I_RMU] + (size_t)l * 2 * B_COLS;
    const int gw = C.wg * NWAVES + C.wave, NGW = C.G * NWAVES, lane = C.lane, ch = 4 * lane, hh = lane >> 4;
    const f32x4 lng = *(const f32x4*)(C.in[I_RLNG] + l * GW + ch), lnb = *(const f32x4*)(C.in[I_RLNB] + l * GW + ch);
    const f32x4 mng = *(const f32x4*)(C.in[I_MNG] + l * GW + ch), gng = *(const f32x4*)(C.in[I_GNG] + l * GW + ch);
    const f32x4 mu0 = *(const f32x4*)(mu + 512 + ch), mu1 = *(const f32x4*)(mu + B_COLS + 512 + ch);
    const size_t o2 = (size_t)T_ALL * 256;
#pragma unroll 2
    for (int m = gw; m < nrows; m += NGW) {
        const bool isctx = m >= T_LAT; const int Lp = isctx ? CTXL : SEQ; const int p = isctx ? ((m - T_LAT) & (CTXL - 1)) : (m & (SEQ - 1));
        const f32x4 yb = ld4bf(ob + (size_t)m * 256 + ch) + ld4bf(ob + o2 + (size_t)m * 256 + ch);
        const f32x4 ycv = ld4bf(oc + (size_t)m * 256 + ch) + ld4bf(oc + o2 + (size_t)m * 256 + ch);
        const f32x4 yd = ld4bf(od + (size_t)m * 256 + ch) + ld4bf(od + o2 + (size_t)m * 256 + ch);
        const bf16* pr = P + (size_t)m * PLD;
        const f32x4 vs = ld4bf(WSP(const bf16, WS_RKV) + (size_t)m * 768 + 512 + ch);
        const f32x4 og = ld4bf(pr + OFF_C + 768 + ch), gd = ld4bf(pr + OFF_D + 768 + ch), gr = ld4bf(gg + (size_t)m * 256 + ch);
        const float bn = bonus[(size_t)m * 4 + hh];
        *(v2u*)(yc + (size_t)m * 1024 + ch) = *(const v2u*)(pr + 256 + ch);
        {
            const float mean = row16_sum((yb.x + yb.y) + (yb.z + yb.w)) * (1.0f / 64.0f);
            const f32x4 dl = yb - mean;
            const float var = row16_sum((dl.x * dl.x + dl.y * dl.y) + (dl.z * dl.z + dl.w * dl.w)) * (1.0f / 64.0f);
            const f32x4 yn = dl * rsqrtf_(var + 64e-5f) * lng + lnb;
            st4bf(yc + (size_t)m * 1024 + 256 + ch, (yn + vs * bn) * gr);
        }
        {
            const float ms = row16_sum((ycv.x * ycv.x + ycv.y * ycv.y) + (ycv.z * ycv.z + ycv.w * ycv.w)) * (1.0f / 64.0f);
            const f32x4 sg = (f32x4){sigmoidf_(og.x), sigmoidf_(og.y), sigmoidf_(og.z), sigmoidf_(og.w)};
            st4bf(yc + (size_t)m * 1024 + 512 + ch, ycv * rsqrtf_(ms + 1e-6f) * mng * sg);
        }
        {
            const float ms = row16_sum((yd.x * yd.x + yd.y * yd.y) + (yd.z * yd.z + yd.w * yd.w)) * (1.0f / 64.0f);
            const f32x4 sg = (f32x4){siluf_(gd.x), siluf_(gd.y), siluf_(gd.z), siluf_(gd.w)};
            st4bf(yc + (size_t)m * 1024 + 768 + ch, yd * rsqrtf_(ms + 1e-6f) * gng * sg);
        }
    }
}
typedef bf16x8 fragb;
__device__ __forceinline__ f32x4 mfma16(fragb a, fragb b, f32x4 c) { return __builtin_amdgcn_mfma_f32_16x16x32_bf16(a, b, c, 0, 0, 0); }
__device__ __forceinline__ fragb ld_frag16(const LAS bf16* p) { return *(const LAS fragb*)p; }
__device__ __forceinline__ fragb ld_frag8x2(const LAS bf16* p0, const LAS bf16* p1) {
    const v2u a = *(const LAS v2u*)p0, b = *(const LAS v2u*)p1; v4u r; r.x = a.x; r.y = a.y; r.z = b.x; r.w = b.y; return __builtin_bit_cast(fragb, r); }
__device__ __forceinline__ fragb pack_frag(const f32x4& lo, const f32x4& hi) { v4u r; r.x = pk2(lo.x, lo.y); r.y = pk2(lo.z, lo.w); r.z = pk2(hi.x, hi.y); r.w = pk2(hi.z, hi.w); return __builtin_bit_cast(fragb, r); }
__device__ __forceinline__ float wave_incl_sum(float v, int lane) {
    v += dpp_x<0x111, 0xF, true>(0.f, v); v += dpp_x<0x112, 0xF, true>(0.f, v); v += dpp_x<0x114, 0xF, true>(0.f, v); v += dpp_x<0x118, 0xF, true>(0.f, v);
    v += dpp_x<0x142, 0xA, false>(0.f, v); v += dpp_x<0x143, 0xC, false>(0.f, v);
    return v;
}
__device__ __forceinline__ float wave_incl_max(float v, int lane) {
    const float ninf = -3.0e38f;
    v = fmaxf(v, dpp_x<0x111, 0xF, false>(ninf, v)); v = fmaxf(v, dpp_x<0x112, 0xF, false>(ninf, v)); v = fmaxf(v, dpp_x<0x114, 0xF, false>(ninf, v)); v = fmaxf(v, dpp_x<0x118, 0xF, false>(ninf, v));
    v = fmaxf(v, dpp_x<0x142, 0xA, false>(ninf, v)); v = fmaxf(v, dpp_x<0x143, 0xC, false>(ninf, v));
    return v;
}
constexpr int MP = 72;
__device__ __forceinline__ void mlstm_chunked(const Ctx& C, int l, int idx) {
    const int d = idx >> 5, b = (idx >> 2) & 7, h = idx & 3, lane = C.lane, w = C.wave, l15 = lane & 15, q = lane >> 4;
    const int it = w & 3, vtp = w >> 2;
    constexpr int IMG = 64 * MP * 2, BUFB = 4 * IMG + 1024, CTB = 65 * MP * 2 + 16;
    LAS unsigned char* L0 = C.lds;
    const bf16* P = WSP(const bf16, WS_P); bf16* outc = WSP(bf16, WS_OUTC) + (size_t)d * T_ALL * 256;
    const float ib = C.in[I_MIB][(l * 2 + d) * NH + h], fb = C.in[I_MFB][(l * 2 + d) * NH + h];
    const int tt = C.tid >> 3, part = C.tid & 7;
    for (int i = C.tid; i < 2 * CTB / 4; i += NTHR) ((LAS unsigned*)(L0 + 2 * BUFB))[i] = 0u;
    v4u rq, rk, rv; unsigned short rgi, rgf;
    auto gload = [&](int n) {
        const int row = seqrow_cm(n * 64 + tt, d, b);
        const bf16* pp = P + (size_t)row * PLD + OFF_C + h * 64 + 8 * part;
        rq = *(const v4u*)pp; rk = *(const v4u*)(pp + 256); rv = *(const v4u*)(pp + 512);
        const bf16* pg = P + (size_t)seqrow_cm(n * 64 + lane, d, b) * PLD + OFF_C + 1024 + d * 4 + h;
        rgi = pg[0]; rgf = pg[8];
    };
    auto images = [&](int bufi) {
        LAS unsigned char* B0 = L0 + bufi * BUFB;
        LAS bf16* Qs = (LAS bf16*)B0; LAS bf16* Ks = Qs + 64 * MP; LAS bf16* VT = Ks + 64 * MP; LAS bf16* KTw = VT + 64 * MP; LAS float* vec = (LAS float*)(B0 + 4 * IMG);
        const float li = bf2f(rgi) + ib, lf = -softplusf_(-(bf2f(rgf) + fb));
        const float bc = wave_incl_sum(lf, lane), x = li - bc, cm = wave_incl_max(x, lane);
        const float wl = __expf(x - __shfl(cm, 63)) * 0.125f;
        if (w == 0) { vec[lane] = x; vec[64 + lane] = cm; vec[128 + lane] = bc; }
        const float wmine = __shfl(wl, 8 * w + (lane >> 3));
        *(LAS v4u*)(Qs + tt * MP + 8 * part) = rq; *(LAS v4u*)(Ks + tt * MP + 8 * part) = rk;
        const unsigned vv[4] = {rv.x, rv.y, rv.z, rv.w}, kk[4] = {rk.x, rk.y, rk.z, rk.w};
#pragma unroll
        for (int e = 0; e < 4; ++e) {
            VT[(8 * part + 2 * e) * MP + tt] = (bf16)(vv[e] & 0xffffu); VT[(8 * part + 2 * e + 1) * MP + tt] = (bf16)(vv[e] >> 16);
            KTw[(8 * part + 2 * e) * MP + tt] = (bf16)f2bf1(bflo(kk[e]) * wmine); KTw[(8 * part + 2 * e + 1) * MP + tt] = (bf16)f2bf1(bfhi(kk[e]) * wmine);
        }
    };
    f32x4 Cst[2], nst; float m = 0.f;
    Cst[0] = Cst[1] = nst = (f32x4){0.f, 0.f, 0.f, 0.f};
    const fragb ones = __builtin_bit_cast(fragb, (v4u){0x3F803F80u, 0x3F803F80u, 0x3F803F80u, 0x3F803F80u});
    const f32x4 z4 = (f32x4){0.f, 0.f, 0.f, 0.f};
    gload(0); images(0); gload(1);
#pragma unroll 1
    for (int n = 0; n < NCH; ++n) {
        RAW_BARRIER();
        const LAS unsigned char* B0 = L0 + (n & 1) * BUFB;
        const LAS bf16* Qs = (const LAS bf16*)B0; const LAS bf16* Ks = Qs + 64 * MP; const LAS bf16* VT = Ks + 64 * MP; const LAS bf16* KTw = VT + 64 * MP; const LAS float* vec = (const LAS float*)(B0 + 4 * IMG);
        const LAS bf16* CT = (const LAS bf16*)(L0 + 2 * BUFB + (n & 1) * CTB); LAS bf16* CTn = (LAS bf16*)(L0 + 2 * BUFB + ((n + 1) & 1) * CTB);
        fragb Qf[2]; Qf[0] = ld_frag16(Qs + (16 * it + l15) * MP + 8 * q); Qf[1] = ld_frag16(Qs + (16 * it + l15) * MP + 32 + 8 * q);
        const float cmi = vec[64 + 16 * it + l15]; const int icol = 16 * it + l15;
        f32x4 pt[4];
#pragma unroll
        for (int jt = 0; jt < 4; ++jt) {
            pt[jt] = z4;
            if (jt <= it) {
                const fragb k0 = ld_frag16(Ks + (16 * jt + l15) * MP + 8 * q), k1 = ld_frag16(Ks + (16 * jt + l15) * MP + 32 + 8 * q);
                f32x4 st = mfma16(k0, Qf[0], z4); st = mfma16(k1, Qf[1], st);
                const f32x4 xj = *(const LAS f32x4*)(vec + 16 * jt + 4 * q);
#pragma unroll
                for (int r = 0; r < 4; ++r) { const int j = 16 * jt + 4 * q + r; pt[jt][r] = (j <= icol) ? st[r] * __expf(xj[r] - cmi) * 0.125f : 0.f; }
            }
        }
        fragb Pf[2]; Pf[0] = pack_frag(pt[0], pt[1]); Pf[1] = pack_frag(pt[2], pt[3]);
        fragb Vf[2][2];
#pragma unroll
        for (int v2 = 0; v2 < 2; ++v2)
#pragma unroll
            for (int s = 0; s < 2; ++s) { const LAS bf16* vr = VT + (16 * (2 * vtp + v2) + l15) * MP + 32 * s + 4 * q; Vf[v2][s] = ld_frag8x2(vr, vr + 16); }
        f32x4 Aacc[2], R[2], as, dn;
        as = mfma16(Pf[0], ones, z4); if (it >= 2) as = mfma16(Pf[1], ones, as);
        const fragb nf0 = ld_frag16(CT + 64 * MP + 8 * q), nf1 = ld_frag16(CT + 64 * MP + 32 + 8 * q);
        dn = mfma16(Qf[0], nf0, z4); dn = mfma16(Qf[1], nf1, dn);
#pragma unroll
        for (int v2 = 0; v2 < 2; ++v2) {
            Aacc[v2] = mfma16(Pf[0], Vf[v2][0], z4); if (it >= 2) Aacc[v2] = mfma16(Pf[1], Vf[v2][1], Aacc[v2]);
            const LAS bf16* cr = CT + (16 * (2 * vtp + v2) + l15) * MP + 8 * q;
            R[v2] = mfma16(Qf[0], ld_frag16(cr), z4); R[v2] = mfma16(Qf[1], ld_frag16(cr + 32), R[v2]);
        }
        {
            const f32x4 bi = *(const LAS f32x4*)(vec + 128 + 16 * it + 4 * q), cmr = *(const LAS f32x4*)(vec + 64 + 16 * it + 4 * q);
#pragma unroll
            for (int r = 0; r < 4; ++r) {
                const float mi = bi[r] + cmr[r], minter = bi[r] + m, mt = fmaxf(minter, mi), e1 = __expf(mi - mt), e2 = __expf(minter - mt);
                const float den = e1 * as[r] + e2 * dn[r]; const float inv = __builtin_amdgcn_rcpf(fmaxf(fabsf(den), __expf(-mt)));
                const int row = seqrow_cm(n * 64 + 16 * it + 4 * q + r, d, b);
#pragma unroll
                for (int v2 = 0; v2 < 2; ++v2) outc[(size_t)row * 256 + h * 64 + 16 * (2 * vtp + v2) + l15] = (bf16)f2bf1((e1 * Aacc[v2][r] + e2 * R[v2][r]) * inv);
            }
        }
        {
            const LAS bf16* kr = KTw + (16 * it + l15) * MP + 4 * q;
            const fragb kt0 = ld_frag8x2(kr, kr + 16), kt1 = ld_frag8x2(kr + 32, kr + 48);
            const float bL = vec[128 + 63], mloc = bL + vec[64 + 63];
            const float mnew = fmaxf(bL + m, mloc), wp = __expf(bL + m - mnew), wn = __expf(mloc - mnew);
            f32x4 gk = mfma16(kt0, ones, z4); gk = mfma16(kt1, ones, gk);
            nst = nst * wp + gk * wn;
#pragma unroll
            for (int v2 = 0; v2 < 2; ++v2) {
                f32x4 G = mfma16(kt0, Vf[v2][0], z4); G = mfma16(kt1, Vf[v2][1], G);
                Cst[v2] = Cst[v2] * wp + G * wn;
                v2u o; o.x = pk2(Cst[v2].x, Cst[v2].y); o.y = pk2(Cst[v2].z, Cst[v2].w);
                *(LAS v2u*)(CTn + (16 * (2 * vtp + v2) + l15) * MP + 16 * it + 4 * q) = o;
            }
            if (vtp == 0 && l15 == 0) { v2u o; o.x = pk2(nst.x, nst.y); o.y = pk2(nst.z, nst.w); *(LAS v2u*)(CTn + 64 * MP + 16 * it + 4 * q) = o; }
            m = mnew;
        }
        if (n + 1 < NCH) { images((n + 1) & 1); if (n + 2 < NCH) gload(n + 2); }
    }
    __syncthreads();
}
__device__ __forceinline__ int fwd_row_cm(int b, int c, int t) { return c < 4 ? (T_LAT + b * CTXL + c * 64 + t) : (b * SEQ + t * 64 + (c - 4)); }
__device__ __forceinline__ bf16* blob_row(const Ctx& C, int d, int isw, int b, int c, int h, int r) {
    const int row = fwd_row_cm(b, c, r);
    if (d == 1 && isw) return WSP(bf16, WS_OUTD) + ((size_t)T_ALL + row) * 256 + h * 64;
    return WSP(bf16, WS_P) + (size_t)row * PLD + OFF_D + (d * 2 + isw) * 256 + h * 64;
}
constexpr int LP = 68;
__device__ __forceinline__ void blocked_solve(const LAS bf16* Ln, const LAS bf16* TinvP, LAS unsigned char* XTw, f32x4 (&acc)[4][4], int l15, int q) {
    const f32x4 z4 = (f32x4){0.f, 0.f, 0.f, 0.f};
#pragma unroll
    for (int I = 0; I < 4; ++I) {
        const fragb Af = *(const LAS fragb*)(TinvP + (I * 16 + l15) * 32 + 8 * q);
        fragb A0, A1;
        if (I >= 1) A0 = ld_frag16(Ln + (16 * I + l15) * MP + 8 * q);
        if (I == 3) A1 = ld_frag16(Ln + (16 * I + l15) * MP + 32 + 8 * q);
#pragma unroll
        for (int nt = 0; nt < 4; ++nt) {
            const int crow = 16 * nt + l15; LAS unsigned char* xr = XTw + crow * 128;
            f32x4 a = acc[I][nt];
            if (I >= 1) a = mfma16(A0, *(const LAS fragb*)(xr + ((q ^ (crow & 7)) << 4)), a);
            if (I == 3) a = mfma16(A1, *(const LAS fragb*)(xr + (((4 + q) ^ (crow & 7)) << 4)), a);
            v4u bw; bw.x = pk2(a.x, a.y); bw.y = pk2(a.z, a.w); bw.z = 0u; bw.w = 0u;
            const f32x4 x = mfma16(Af, __builtin_bit_cast(fragb, bw), z4);
            acc[I][nt] = x;
            v2u o; o.x = pk2(x.x, x.y); o.y = pk2(x.z, x.w);
            *(LAS v2u*)(xr + (((2 * I + (q >> 1)) ^ (crow & 7)) << 4) + (q & 1) * 8) = o;
        }
    }
}
__device__ __forceinline__ void diag_inverses(const LAS bf16* Ln, LAS bf16* TinvP, int lane) {
    const int blk = lane >> 4, c = lane & 15;
    float x[16];
#pragma unroll
    for (int i = 0; i < 16; ++i) {
        const LAS bf16* lr = Ln + (16 * blk + i) * MP + 16 * blk;
        const v4u r0 = *(const LAS v4u*)lr, r1 = *(const LAS v4u*)(lr + 8);
        const unsigned rw[8] = {r0.x, r0.y, r0.z, r0.w, r1.x, r1.y, r1.z, r1.w};
        float s = (i == c) ? 1.0f : 0.0f;
#pragma unroll
        for (int j = 0; j < i; ++j) s += ((j & 1) ? bfhi(rw[j >> 1]) : bflo(rw[j >> 1])) * x[j];
        x[i] = s;
        TinvP[(blk * 16 + i) * 32 + 8 * (c >> 2) + (c & 3)] = (bf16)f2bf1(s);
    }
}
__device__ __forceinline__ void gdn_solve_item(const Ctx& C, int l, int item) {
    const int lane = C.lane, w = C.wave, pw = w & 1, pi = w >> 1, l15 = lane & 15, q = lane >> 4;
    LAS unsigned char* B0 = C.lds + pi * 31744;
    LAS bf16* Ln = (LAS bf16*)B0;
    LAS bf16* TinvP = (LAS bf16*)(B0 + 9216);
    LAS float* vec = (LAS float*)(B0 + 13312);
    LAS unsigned char* XT = B0 + 13824;
    LAS bf16* Ks = (LAS bf16*)XT;
    const bf16* P = WSP(const bf16, WS_P); const bf16* gq = WSP(const bf16, WS_GQ);
    const int u = item >> 1, d = item & 1;
    const int c = u % NCH, h = (u / NCH) & 3, b = u / (NCH * NH);
    const int n = d ? (c < 4 ? 3 - c : 71 - c) : c;
    const float aexp = __expf(C.in[I_GALOG][(l * 2 + d) * NH + h]), dtb = C.in[I_GDTB][(l * 2 + d) * NH + h];
    const int rowl = seqrow_cm(n * 64 + lane, d, b);
    const bf16* pg = P + (size_t)rowl * PLD + OFF_D + 1024 + d * 4 + h;
    const float la = -aexp * softplusf_(bf2f(pg[0]) + dtb), beta = sigmoidf_(bf2f(pg[8]));
    const float gam = wave_incl_sum(la, lane);
    if (pw == 0) { vec[lane] = beta; vec[64 + lane] = gam; }
#pragma unroll
    for (int r = 0; r < 4; ++r) { const int idx = pw * 64 + lane + 128 * r, t = idx >> 3, part = idx & 7;
        *(LAS v4u*)(Ks + t * MP + 8 * part) = *(const v4u*)(gq + (size_t)seqrow_cm(n * 64 + t, d, b) * 768 + 256 + h * 64 + 8 * part); }
    { LAS v4u* tz = (LAS v4u*)(B0 + 9216) + (pw * 64 + lane) * 2; tz[0] = (v4u){0u, 0u, 0u, 0u}; tz[1] = (v4u){0u, 0u, 0u, 0u}; }
    f32x4 acc[4][4];
    if (pw == 0) {
#pragma unroll
        for (int I = 0; I < 4; ++I)
#pragma unroll
            for (int r = 0; r < 4; ++r) { const bf16* vr = gq + (size_t)seqrow_cm(n * 64 + 16 * I + 4 * q + r, d, b) * 768 + 512 + h * 64 + l15;
#pragma unroll
                for (int nt = 0; nt < 4; ++nt) acc[I][nt][r] = bf2f(vr[16 * nt]); }
    }
    __syncthreads();
    {
        int tix = 0;
#pragma unroll
        for (int it = 0; it < 4; ++it)
#pragma unroll
            for (int jt = 0; jt < 4; ++jt, ++tix) if ((tix & 1) == pw) {
                f32x4 t4 = (f32x4){0.f, 0.f, 0.f, 0.f};
                if (jt <= it) {
#pragma unroll
                    for (int s = 0; s < 2; ++s) t4 = mfma16(ld_frag16(Ks + (16 * it + l15) * MP + 32 * s + 8 * q), ld_frag16(Ks + (16 * jt + l15) * MP + 32 * s + 8 * q), t4);
                    const float gj = vec[64 + 16 * jt + l15];
                    const f32x4 bi = *(const LAS f32x4*)(vec + 16 * it + 4 * q), gi = *(const LAS f32x4*)(vec + 64 + 16 * it + 4 * q);
#pragma unroll
                    for (int r = 0; r < 4; ++r) { const int i = 16 * it + 4 * q + r, j = 16 * jt + l15; t4[r] = (j < i) ? -(bi[r] * t4[r] * __expf(gi[r] - gj)) : 0.f; }
                }
#pragma unroll
                for (int r = 0; r < 4; ++r) Ln[(16 * it + 4 * q + r) * MP + 16 * jt + l15] = (bf16)f2bf1(t4[r]);
            }
    }
    {
#pragma unroll
        for (int I = 0; I < 4; ++I) {
            const f32x4 bi = *(const LAS f32x4*)(vec + 16 * I + 4 * q), gi = *(const LAS f32x4*)(vec + 64 + 16 * I + 4 * q);
#pragma unroll
            for (int r = 0; r < 4; ++r) { const float sc = pw ? bi[r] * __expf(gi[r]) : bi[r];
#pragma unroll
                for (int nt = 0; nt < 4; ++nt) acc[I][nt][r] = (pw ? bf2f(Ks[(16 * I + 4 * q + r) * MP + 16 * nt + l15]) : acc[I][nt][r]) * sc; }
        }
    }
    __syncthreads();
    if (pw == 0) diag_inverses(Ln, TinvP, lane);
    LAS unsigned char* XTw = XT + pw * 8192;
    { LAS v4u* xz = (LAS v4u*)(XTw + lane * 128);
#pragma unroll
        for (int g = 0; g < 8; ++g) xz[g] = (v4u){0u, 0u, 0u, 0u}; }
    __syncthreads();
    blocked_solve(Ln, TinvP, XTw, acc, l15, q);
    {
        bf16* dst = blob_row(C, d, pw, b, c, h, lane);
        const LAS unsigned char* xr = XTw + lane * 128;
#pragma unroll
        for (int g = 0; g < 8; ++g) *(v4u*)(dst + 8 * g) = *(const LAS v4u*)(xr + ((g ^ (lane & 7)) << 4));
    }
    __syncthreads();
}

template <bool DRY>
__device__ __forceinline__ void gdn_chunked(const Ctx& C, int l, int idx) {
    const int d = idx >> 5, b = (idx >> 2) & 7, h = idx & 3, lane = C.lane, w = C.wave, l15 = lane & 15, q = lane >> 4;
    const int it = w & 3, vtp = w >> 2;
    constexpr int IMG = 64 * MP * 2, BUFB = 5 * IMG + 512;
    LAS unsigned char* L0 = C.lds;
    LAS bf16* VnT = (LAS bf16*)(L0 + 2 * BUFB + 2 * IMG);
    const bf16* P = WSP(const bf16, WS_P); const bf16* gq = WSP(const bf16, WS_GQ); bf16* outd = WSP(bf16, WS_OUTD) + (size_t)d * T_ALL * 256;
    const float aexp = __expf(C.in[I_GALOG][(l * 2 + d) * NH + h]), dtb = C.in[I_GDTB][(l * 2 + d) * NH + h];
    const int tt = C.tid >> 3, part = C.tid & 7;
    for (int i = C.tid; i < 2 * IMG / 4; i += NTHR) ((LAS unsigned*)(L0 + 2 * BUFB))[i] = 0u;
    v4u rq, rk, ru, rw; unsigned short rga;
    auto gload = [&](int n) {
        const int c = d ? (n < 4 ? 3 - n : 71 - n) : n;
        const bf16* pp = gq + (size_t)seqrow_cm(n * 64 + tt, d, b) * 768 + h * 64 + 8 * part;
        rq = *(const v4u*)pp; rk = *(const v4u*)(pp + 256);
        ru = *(const v4u*)(blob_row(C, d, 0, b, c, h, tt) + 8 * part); rw = *(const v4u*)(blob_row(C, d, 1, b, c, h, tt) + 8 * part);
        rga = P[(size_t)seqrow_cm(n * 64 + lane, d, b) * PLD + OFF_D + 1024 + d * 4 + h];
    };
    auto images = [&](int bufi) {
        LAS unsigned char* B0 = L0 + bufi * BUFB;
        LAS bf16* Qs = (LAS bf16*)B0; LAS bf16* Ks = Qs + 64 * MP; LAS bf16* KdT = Ks + 64 * MP; LAS bf16* Wi = KdT + 64 * MP; LAS bf16* UT = Wi + 64 * MP; LAS float* vec = (LAS float*)(B0 + 5 * IMG);
        const float la = -aexp * softplusf_(bf2f(rga) + dtb);
        const float gam = wave_incl_sum(la, lane);
        if (w == 0) vec[lane] = gam;
        const float kd = __expf(__shfl(gam, 63) - gam);
        const float kmine = __shfl(kd, 8 * w + (lane >> 3));
        *(LAS v4u*)(Qs + tt * MP + 8 * part) = rq; *(LAS v4u*)(Ks + tt * MP + 8 * part) = rk; *(LAS v4u*)(UT + tt * MP + 8 * part) = ru;
        const unsigned kk[4] = {rk.x, rk.y, rk.z, rk.w}, ww[4] = {rw.x, rw.y, rw.z, rw.w};
#pragma unroll
        for (int e = 0; e < 4; ++e) {
            KdT[(8 * part + 2 * e) * MP + tt] = (bf16)f2bf1(bflo(kk[e]) * kmine); KdT[(8 * part + 2 * e + 1) * MP + tt] = (bf16)f2bf1(bfhi(kk[e]) * kmine);
            Wi[(8 * part + 2 * e) * MP + tt] = (bf16)(ww[e] & 0xffffu); Wi[(8 * part + 2 * e + 1) * MP + tt] = (bf16)(ww[e] >> 16);
        }
    };
    f32x4 Sst[2]; Sst[0] = Sst[1] = (f32x4){0.f, 0.f, 0.f, 0.f};
    const f32x4 z4 = (f32x4){0.f, 0.f, 0.f, 0.f};
    gload(0); images(0); gload(1);
#pragma unroll 1
    for (int n = 0; n < NCH; ++n) {
        RAW_BARRIER();
        const LAS unsigned char* B0 = L0 + (n & 1) * BUFB;
        const LAS bf16* Qs = (const LAS bf16*)B0; const LAS bf16* Ks = Qs + 64 * MP; const LAS bf16* KdT = Ks + 64 * MP; const LAS bf16* Wi = KdT + 64 * MP; const LAS bf16* UT = Wi + 64 * MP; const LAS float* vec = (const LAS float*)(B0 + 5 * IMG);
        const LAS bf16* ST = (const LAS bf16*)(L0 + 2 * BUFB + (n & 1) * IMG); LAS bf16* STn = (LAS bf16*)(L0 + 2 * BUFB + ((n + 1) & 1) * IMG);
        fragb Qf[2]; Qf[0] = ld_frag16(Qs + (16 * it + l15) * MP + 8 * q); Qf[1] = ld_frag16(Qs + (16 * it + l15) * MP + 32 + 8 * q);
        const float gcol = vec[16 * it + l15]; const int icol = 16 * it + l15;
        f32x4 pt[4];
#pragma unroll
        for (int jt = 0; jt < 4; ++jt) {
            pt[jt] = z4;
            if (jt <= it) {
                const fragb k0 = ld_frag16(Ks + (16 * jt + l15) * MP + 8 * q), k1 = ld_frag16(Ks + (16 * jt + l15) * MP + 32 + 8 * q);
                f32x4 st = mfma16(k0, Qf[0], z4); st = mfma16(k1, Qf[1], st);
                const f32x4 gj = *(const LAS f32x4*)(vec + 16 * jt + 4 * q);
#pragma unroll
                for (int r = 0; r < 4; ++r) { const int j = 16 * jt + 4 * q + r; pt[jt][r] = (j <= icol) ? st[r] * __expf(gcol - gj[r]) : 0.f; }
            }
        }
        fragb Pf[2]; Pf[0] = pack_frag(pt[0], pt[1]); Pf[1] = pack_frag(pt[2], pt[3]);
        const fragb Wf0 = ld_frag16(Wi + (16 * it + l15) * MP + 8 * q), Wf1 = ld_frag16(Wi + (16 * it + l15) * MP + 32 + 8 * q);
        f32x4 Ro[2];
#pragma unroll
        for (int v2 = 0; v2 < 2; ++v2) {
            const int vrow = 16 * (2 * vtp + v2) + l15;
            const fragb s0 = ld_frag16(ST + vrow * MP + 8 * q), s1 = ld_frag16(ST + vrow * MP + 32 + 8 * q);
            f32x4 ws = mfma16(Wf0, s0, z4); ws = mfma16(Wf1, s1, ws);
            Ro[v2] = mfma16(Qf[0], s0, z4); Ro[v2] = mfma16(Qf[1], s1, Ro[v2]);
            const v2u ur = *(const LAS v2u*)(UT + vrow * MP + 16 * it + 4 * q);
            v2u o; o.x = pk2(bflo(ur.x) - ws.x, bfhi(ur.x) - ws.y); o.y = pk2(bflo(ur.y) - ws.z, bfhi(ur.y) - ws.w);
            *(LAS v2u*)(VnT + vrow * MP + 16 * it + 4 * q) = o;
        }
        RAW_BARRIER();
        {
            const f32x4 gi = *(const LAS f32x4*)(vec + 16 * it + 4 * q);
            const float gl = __expf(vec[63]);
            const LAS bf16* kr = KdT + (16 * it + l15) * MP + 4 * q;
            const fragb kt0 = ld_frag8x2(kr, kr + 16), kt1 = ld_frag8x2(kr + 32, kr + 48);
#pragma unroll
            for (int v2 = 0; v2 < 2; ++v2) {
                const int vrow = 16 * (2 * vtp + v2) + l15;
                const LAS bf16* vr = VnT + vrow * MP + 4 * q;
                const fragb n0 = ld_frag8x2(vr, vr + 16), n1 = ld_frag8x2(vr + 32, vr + 48);
                f32x4 o = mfma16(Pf[0], n0, z4); if (it >= 2) o = mfma16(Pf[1], n1, o);
#pragma unroll
                for (int r = 0; r < 4; ++r) { const int row = seqrow_cm(n * 64 + 16 * it + 4 * q + r, d, b);
                    if (!DRY) outd[(size_t)row * 256 + h * 64 + vrow] = (bf16)f2bf1(o[r] + __expf(gi[r]) * Ro[v2][r]); }
                f32x4 ns = mfma16(kt0, n0, z4); ns = mfma16(kt1, n1, ns);
                Sst[v2] = Sst[v2] * gl + ns;
                v2u so; so.x = pk2(Sst[v2].x, Sst[v2].y); so.y = pk2(Sst[v2].z, Sst[v2].w);
                *(LAS v2u*)(STn + vrow * MP + 16 * it + 4 * q) = so;
            }
        }
        if (n + 1 < NCH) { images((n + 1) & 1); if (n + 2 < NCH) gload(n + 2); }
    }
    __syncthreads();
}
constexpr int UP = 264;
template <int CTRL> __device__ __forceinline__ float dpp_keep(float oldv, float v) { return __builtin_bit_cast(float, __builtin_amdgcn_update_dpp(__builtin_bit_cast(int, oldv), __builtin_bit_cast(int, v), CTRL, 0xF, 0xF, false)); }
template <bool REV> __device__ __forceinline__ void scan16(float& A, float& B) {
#define LRU_STEP(S) { const float Ap = dpp_keep<(REV ? 0x100 : 0x110) | S>(1.0f, A), Bp = dpp_keep<(REV ? 0x100 : 0x110) | S>(0.0f, B); B = A * Bp + B; A = A * Ap; }
    LRU_STEP(1) LRU_STEP(2) LRU_STEP(4) LRU_STEP(8)
#undef LRU_STEP
}
template <bool FIN, bool REV>
__device__ __forceinline__ void lru_wave(const Ctx& C, int l, int b, int c, int hd, LAS bf16* U16, LAS bf16* H16) {
    constexpr int d = REV ? 1 : 0;
    const int lane = C.lane, l15 = lane & 15, q = lane >> 4;
    const bf16* wt = WSP(const bf16, WS_LRUWT) + (size_t)((d * 2 + 0) * 4 + hd) * 4096;
    fragb Wa[4][2], Wx[4][2];
#pragma unroll
    for (int mt = 0; mt < 4; ++mt)
#pragma unroll
        for (int ks = 0; ks < 2; ++ks) { Wa[mt][ks] = *(const fragb*)(wt + (16 * mt + l15) * 64 + 32 * ks + 8 * q); Wx[mt][ks] = *(const fragb*)(wt + 4 * 4096 + (16 * mt + l15) * 64 + 32 * ks + 8 * q); }
    f32x4 sp4[4], hc[4], sla[4];
    const size_t sbase = ((size_t)(b * NCH + c) * 2 + d) * 256 + hd * 64;
#pragma unroll
    for (int mt = 0; mt < 4; ++mt) {
        const int ch = hd * 64 + 16 * mt + 4 * q;
        const f32x4 lam = *(const f32x4*)(C.in[I_LLAM] + (l * 2 + d) * GW + ch);
#pragma unroll
        for (int r = 0; r < 4; ++r) sp4[mt][r] = 8.0f * softplusf_(-lam[r]);
        hc[mt] = FIN ? *(const f32x4*)(WSP(const float, WS_HIN) + sbase + 16 * mt + 4 * q) : (f32x4){0.f, 0.f, 0.f, 0.f};
        sla[mt] = (f32x4){0.f, 0.f, 0.f, 0.f};
    }
    const f32x4 z4 = (f32x4){0.f, 0.f, 0.f, 0.f};
#pragma unroll 1
    for (int nti = 0; nti < 4; ++nti) {
        const int nt = REV ? 3 - nti : nti;
        const LAS bf16* urow = U16 + (16 * nt + l15) * UP + hd * 64;
        const fragb Uf0 = ld_frag16(urow + 8 * q), Uf1 = ld_frag16(urow + 32 + 8 * q);
#pragma unroll
        for (int mt = 0; mt < 4; ++mt) {
            f32x4 aa = mfma16(Wa[mt][0], Uf0, z4); aa = mfma16(Wa[mt][1], Uf1, aa);
            f32x4 ax = mfma16(Wx[mt][0], Uf0, z4); ax = mfma16(Wx[mt][1], Uf1, ax);
            const v2u ur = *(const LAS v2u*)(urow + 16 * mt + 4 * q);
            const float u4[4] = {bflo(ur.x), bfhi(ur.x), bflo(ur.y), bfhi(ur.y)};
            const f32x4 ba = *(const f32x4*)(C.in[I_LBA] + (l * 2 + d) * GW + hd * 64 + 16 * mt + 4 * q), bx = *(const f32x4*)(C.in[I_LBX] + (l * 2 + d) * GW + hd * 64 + 16 * mt + 4 * q);
            f32x4 hv;
#pragma unroll
            for (int r = 0; r < 4; ++r) {
                const float rg = sigmoidf_(aa[r] + ba[r]), ig = sigmoidf_(ax[r] + bx[r]);
                const float la = -sp4[mt][r] * rg; float A = __expf(la); float Bv = __builtin_amdgcn_sqrtf(-expm1f_(2.0f * la)) * (ig * u4[r]);
                sla[mt][r] += la;
                scan16<REV>(A, Bv);
                const float h = A * hc[mt][r] + Bv;
                hv[r] = h;
                hc[mt][r] = __shfl(h, (lane & 48) | (REV ? 0 : 15));
            }
            if (FIN) { v2u o; o.x = pk2(hv.x, hv.y); o.y = pk2(hv.z, hv.w); *(LAS v2u*)(H16 + (size_t)d * 64 * UP + (16 * nt + l15) * UP + hd * 64 + 16 * mt + 4 * q) = o; }
        }
    }
    if (!FIN) {
        float* ls = WSP(float, WS_LSUM);
#pragma unroll
        for (int mt = 0; mt < 4; ++mt)
#pragma unroll
            for (int r = 0; r < 4; ++r) { const float st = row16_sum(sla[mt][r]); if (l15 == 0) { const size_t si = sbase + 16 * mt + 4 * q + r; ls[si * 2] = st; ls[si * 2 + 1] = hc[mt][r]; } }
    }
}
template <bool FIN>
__device__ __forceinline__ void lru_chunk_mfma(const Ctx& C, int l, int b, int c) {
    LAS bf16* U16 = (LAS bf16*)C.lds;
    LAS bf16* H16 = U16 + 64 * UP;
    const bf16* P = WSP(const bf16, WS_P);
    const bool isctx = c < 4; const int p0 = isctx ? c * 64 : (c - 4) * 64; const int Lp = isctx ? CTXL : SEQ; const int row0 = isctx ? T_LAT + b * CTXL : b * SEQ;
    {
        const int ch = C.tid & 255, half = C.tid >> 8;
        const float* cw = C.in[I_LCW] + (size_t)l * 4 * GW + ch; const float w0 = cw[0], w1 = cw[GW], w2 = cw[2 * GW], w3 = cw[3 * GW], cb = C.in[I_LCB][l * GW + ch];
        const int t0 = half * 32;
        float xs[35];
#pragma unroll
        for (int k = 0; k < 35; ++k) { const int p = p0 + t0 + k - 2; xs[k] = (p >= 0 && p < Lp) ? bf2f(P[(size_t)(row0 + p) * PLD + ch]) : 0.f; }
#pragma unroll
        for (int t = 0; t < 32; ++t) U16[(t0 + t) * UP + ch] = (bf16)f2bf1(w0 * xs[t] + w1 * xs[t + 1] + w2 * xs[t + 2] + w3 * xs[t + 3] + cb);
    }
    __syncthreads();
    if (C.wave < 4) lru_wave<FIN, false>(C, l, b, c, C.wave & 3, U16, H16); else lru_wave<FIN, true>(C, l, b, c, C.wave & 3, U16, H16);
    __syncthreads();
    if (FIN) {
        const LAS bf16* H1 = H16 + 64 * UP;
#pragma unroll 2
        for (int it = C.tid; it < 64 * 64; it += NTHR) {
            const int t = it >> 6, c4 = (it & 63) * 4;
            const size_t row = (size_t)(row0 + p0 + t);
            const v2u a = *(const LAS v2u*)(H16 + t * UP + c4), bq = *(const LAS v2u*)(H1 + t * UP + c4);
            const f32x4 g = ld4bf(P + row * PLD + 256 + c4);
            f32x4 y = (f32x4){bflo(a.x) + bflo(bq.x), bfhi(a.x) + bfhi(bq.x), bflo(a.y) + bflo(bq.y), bfhi(a.y) + bfhi(bq.y)};
            y.x *= gelu_tanh(g.x); y.y *= gelu_tanh(g.y); y.z *= gelu_tanh(g.z); y.w *= gelu_tanh(g.w);
            st4bf(WSP(bf16, WS_P) + row * PLD + 256 + c4, y);
        }
        __syncthreads();
    }
}
constexpr int RP = 264;
__device__ __forceinline__ void rwkv_prep2(const Ctx& C, int l, int b, int c) {
    LAS bf16* RS = (LAS bf16*)C.lds;
    LAS bf16* KS = RS + 64 * RP;
    LAS bf16* XW = KS + 64 * RP;
    LAS bf16* XA = XW + 64 * MP;
    LAS bf16* XG = XA + 64 * MP;
    const bf16* P = WSP(const bf16, WS_P);
    const bool isctx = c < 4; const int p0 = isctx ? c * 64 : (c - 4) * 64; const int Lp = isctx ? CTXL : SEQ; const int row0 = isctx ? T_LAT + b * CTXL : b * SEQ;
    const float* mu = C.in[I_RMU] + (size_t)l * 2 * B_COLS;
    bf16* rkv = WSP(bf16, WS_RKV);
#pragma unroll 5
    for (int it = C.tid; it < 64 * 120; it += NTHR) {
        const int t = it / 120, c8 = (it % 120) * 8, p = p0 + t;
        const bf16* pp = P + (size_t)(row0 + p) * PLD + OFF_B + c8;
        const v4u xc = *(const v4u*)pp; v4u xp = (v4u){0u, 0u, 0u, 0u}, xn = xp;
        if (p > 0) xp = *(const v4u*)(pp - PLD);
        if (p < Lp - 1) xn = *(const v4u*)(pp + PLD);
        const f32x4 m0a = *(const f32x4*)(mu + c8), m0b = *(const f32x4*)(mu + c8 + 4), m1a = *(const f32x4*)(mu + B_COLS + c8), m1b = *(const f32x4*)(mu + B_COLS + c8 + 4);
        const unsigned xcw[4] = {xc.x, xc.y, xc.z, xc.w}, xpw[4] = {xp.x, xp.y, xp.z, xp.w}, xnw[4] = {xn.x, xn.y, xn.z, xn.w};
        float sh[8];
#pragma unroll
        for (int e = 0; e < 4; ++e) {
            const float x0 = bflo(xcw[e]), x1 = bfhi(xcw[e]);
            const float mu0_0 = e < 2 ? m0a[2 * e] : m0b[2 * e - 4], mu0_1 = e < 2 ? m0a[2 * e + 1] : m0b[2 * e - 3], mu1_0 = e < 2 ? m1a[2 * e] : m1b[2 * e - 4], mu1_1 = e < 2 ? m1a[2 * e + 1] : m1b[2 * e - 3];
            sh[2 * e] = x0 + mu0_0 * (bflo(xpw[e]) - x0) + mu1_0 * (bflo(xnw[e]) - x0);
            sh[2 * e + 1] = x1 + mu0_1 * (bfhi(xpw[e]) - x1) + mu1_1 * (bfhi(xnw[e]) - x1);
        }
        if (c8 >= 768) {
            const int ci = c8 - 768;
            if (ci < 64) {
#pragma unroll
                for (int e = 0; e < 8; ++e) sh[e] = tanhf_(sh[e]); }
            else if (ci >= 128) {
#pragma unroll
                for (int e = 0; e < 8; ++e) sh[e] = sigmoidf_(sh[e]); }
        }
        v4u o; o.x = pk2(sh[0], sh[1]); o.y = pk2(sh[2], sh[3]); o.z = pk2(sh[4], sh[5]); o.w = pk2(sh[6], sh[7]);
        if (c8 < 768) {
            *(v4u*)(rkv + (size_t)(row0 + p) * 768 + c8) = o;
            if (c8 < 256) *(LAS v4u*)(RS + t * RP + c8) = o; else if (c8 < 512) *(LAS v4u*)(KS + t * RP + c8 - 256) = o;
        } else {
            const int ci = c8 - 768;
            LAS bf16* dst = ci < 64 ? XW + t * MP + ci : (ci < 128 ? XA + t * MP + ci - 64 : XG + t * MP + ci - 128);
            *(LAS v4u*)dst = o;
        }
    }
    __syncthreads();
    const int lane = C.lane, w = C.wave, l15 = lane & 15, q = lane >> 4, hd = w & 3, ntp = w >> 2;
    const bf16* wt = WSP(const bf16, WS_RWT);
    bf16* wa_out = WSP(bf16, WS_HB); bf16* g_out = WSP(bf16, WS_G); float* bonus = WSP(float, WS_BONUS); float* rinv = WSP(float, WS_RINV);
    const f32x4 z4 = (f32x4){0.f, 0.f, 0.f, 0.f};
    fragb xw0[2], xw1[2], xa0[2], xa1[2], xg0[2], xg1[2]; float bsum[2] = {0.f, 0.f}, ksum[2] = {0.f, 0.f};
#pragma unroll
    for (int n2 = 0; n2 < 2; ++n2) { const int tok = 16 * (2 * ntp + n2) + l15;
        xw0[n2] = ld_frag16(XW + tok * MP + 8 * q); xw1[n2] = ld_frag16(XW + tok * MP + 32 + 8 * q);
        xa0[n2] = ld_frag16(XA + tok * MP + 8 * q); xa1[n2] = ld_frag16(XA + tok * MP + 32 + 8 * q);
        xg0[n2] = ld_frag16(XG + tok * MP + 8 * q); xg1[n2] = ld_frag16(XG + tok * MP + 32 + 8 * q); }
#pragma unroll
    for (int mt = 0; mt < 4; ++mt) {
        const int chl = 16 * mt + l15, ch4 = hd * 64 + 16 * mt + 4 * q;
        const bf16* wrow = wt + (size_t)(hd * 64 + chl) * 32 + 8 * q;
        const bf16* grow = wt + 4 * 256 * 32 + (size_t)(hd * 64 + chl) * 64 + 8 * q;
        const fragb fw0 = *(const fragb*)(wrow), fw1 = *(const fragb*)(wrow + 256 * 32), fa0 = *(const fragb*)(wrow + 2 * 256 * 32), fa1 = *(const fragb*)(wrow + 3 * 256 * 32), fg0 = *(const fragb*)(grow), fg1 = *(const fragb*)(grow + 32);
        const f32x4 w00 = *(const f32x4*)(C.in[I_RW0] + (l * 2 + 0) * GW + ch4), w01 = *(const f32x4*)(C.in[I_RW0] + (l * 2 + 1) * GW + ch4);
        const f32x4 a00 = *(const f32x4*)(C.in[I_RA0] + (l * 2 + 0) * GW + ch4), a01 = *(const f32x4*)(C.in[I_RA0] + (l * 2 + 1) * GW + ch4);
        const f32x4 k_a = *(const f32x4*)(C.in[I_RKA] + l * GW + ch4), r_k = *(const f32x4*)(C.in[I_RRK] + l * GW + ch4), k_k = *(const f32x4*)(C.in[I_RKK] + l * GW + ch4);
#pragma unroll
        for (int n2 = 0; n2 < 2; ++n2) {
            const int tok = 16 * (2 * ntp + n2) + l15; const size_t row = (size_t)(row0 + p0 + tok);
            const f32x4 aw0 = mfma16(fw0, xw0[n2], z4), aw1 = mfma16(fw1, xw1[n2], z4), aa0 = mfma16(fa0, xa0[n2], z4), aa1 = mfma16(fa1, xa1[n2], z4);
            f32x4 ag = mfma16(fg0, xg0[n2], z4); ag = mfma16(fg1, xg1[n2], ag);
            f32x4 wv0, wv1, av0, av1;
#pragma unroll
            for (int r = 0; r < 4; ++r) {
                wv0[r] = __expf(-0.6065306597126334f * sigmoidf_(aw0[r] + w00[r])); wv1[r] = __expf(-0.6065306597126334f * sigmoidf_(aw1[r] + w01[r]));
                av0[r] = sigmoidf_(aa0[r] + a00[r]); av1[r] = sigmoidf_(aa1[r] + a01[r]);
            }
            st4bf(wa_out + row * 1024 + 0 * 256 + ch4, wv0); st4bf(wa_out + row * 1024 + 1 * 256 + ch4, wv1);
            st4bf(wa_out + row * 1024 + 2 * 256 + ch4, av0); st4bf(wa_out + row * 1024 + 3 * 256 + ch4, av1);
            st4bf(g_out + row * 256 + ch4, ag);
            const v2u rr_ = *(const LAS v2u*)(RS + tok * RP + ch4), kr_ = *(const LAS v2u*)(KS + tok * RP + ch4);
            const f32x4 rs = (f32x4){bflo(rr_.x), bfhi(rr_.x), bflo(rr_.y), bfhi(rr_.y)}, ks = (f32x4){bflo(kr_.x), bfhi(kr_.x), bflo(kr_.y), bfhi(kr_.y)};
#pragma unroll
            for (int r = 0; r < 4; ++r) {
                const float km = ks[r] * (1.0f + (av0[r] - 1.0f) * k_a[r]) + ks[r] * (1.0f + (av1[r] - 1.0f) * k_a[r]);
                bsum[n2] += rs[r] * r_k[r] * km; const float kk = ks[r] * k_k[r]; ksum[n2] += kk * kk;
            }
        }
    }
#pragma unroll
    for (int n2 = 0; n2 < 2; ++n2) {
        const size_t row = (size_t)(row0 + p0 + 16 * (2 * ntp + n2) + l15);
        float bs = bsum[n2], ks2 = ksum[n2];
        bs += __shfl_xor(bs, 16); bs += __shfl_xor(bs, 32); ks2 += __shfl_xor(ks2, 16); ks2 += __shfl_xor(ks2, 32);
        if (q == 0) { bonus[row * 4 + hd] = bs; rinv[row * 4 + hd] = rsqrtf_(ks2 + 1e-6f); }
    }
    __syncthreads();
}
__device__ __forceinline__ int fwd_row_r(int b, int c, int t) { return c < 4 ? (T_LAT + b * CTXL + c * 64 + t) : (b * SEQ + (c - 4) * 64 + t); }
__device__ __forceinline__ bf16* rw_blob_row(const Ctx& C, int d, int which, int b, int c, int h, int r) {
    const int row = fwd_row_r(b, c, r);
#if RW_VSPLIT
    if (which == 0) { if (d) return WSP(bf16, WS_GQ) + (size_t)row * 768 + 512 + h * 64;
                      return WSP(bf16, WS_P) + (size_t)row * PLD + OFF_B + 512 + h * 64; }
#else
    if (which == 0) return WSP(bf16, WS_OUTB) + ((size_t)d * T_ALL + row) * 256 + h * 64;
#endif
    return WSP(bf16, WS_P) + (size_t)row * PLD + OFF_B + d * 256 + h * 64;
}
__device__ __forceinline__ void rwkv_solve_item(const Ctx& C, int l, int item) {
    const int lane = C.lane, w = C.wave, pw = w & 1, pi = w >> 1, l15 = lane & 15, q = lane >> 4;
    LAS unsigned char* B0 = C.lds + pi * 31744;
    LAS bf16* Kk = (LAS bf16*)B0; LAS bf16* Bh = Kk + 64 * MP; LAS bf16* Kh = Bh + 64 * MP;
    LAS bf16* Ln = (LAS bf16*)B0;
    LAS bf16* Lk16 = (LAS bf16*)(B0 + 9216);
    LAS unsigned char* XT = B0 + 9216;
    LAS bf16* TinvP = (LAS bf16*)(B0 + 25600);
    const bf16* WA = WSP(const bf16, WS_HB); bf16* WAw = WSP(bf16, WS_HB); const bf16* rkv = WSP(const bf16, WS_RKV); const float* rinv = WSP(const float, WS_RINV);
    const int u = item >> 1, d = item & 1;
    const int c = u % NCH, h = (u / NCH) & 3, b = u / (NCH * NH);
    const float k_k = C.in[I_RKK][l * GW + h * 64 + lane], k_a = C.in[I_RKA][l * GW + h * 64 + lane];
    const int n = d ? (c < 4 ? 3 - c : 71 - c) : c;
    const float ril = rinv[(size_t)seqrow_raster(n * 64 + lane, d, b) * 4 + h];
#pragma unroll
    for (int r = 0; r < 4; ++r) { const int idx2 = pw * 64 + lane + 128 * r, t = idx2 >> 3, part = idx2 & 7; const int row = seqrow_raster(n * 64 + t, d, b);
        *(LAS v4u*)(Kk + t * MP + 8 * part) = *(const v4u*)(WA + (size_t)row * 1024 + d * 256 + h * 64 + 8 * part);
        *(LAS v4u*)(Bh + t * MP + 8 * part) = *(const v4u*)(WA + (size_t)row * 1024 + (2 + d) * 256 + h * 64 + 8 * part);
        *(LAS v4u*)(Kh + t * MP + 8 * part) = *(const v4u*)(rkv + (size_t)row * 768 + 256 + h * 64 + 8 * part); }
    __syncthreads();
    {
        float cc = 1.0f;
        if (pw) {
#pragma unroll
            for (int t = 0; t < 32; ++t) cc *= bf2f(Kk[t * MP + lane]);
        }
        __syncthreads();
#pragma unroll
        for (int t2 = 0; t2 < 32; ++t2) {
            const int t = pw * 32 + t2;
            const float wv = bf2f(Kk[t * MP + lane]), av = bf2f(Bh[t * MP + lane]), ks = bf2f(Kh[t * MP + lane]);
            const float kap = ks * k_k * __shfl(ril, t);
            const float cprev = cc; cc *= wv; const float ic = __builtin_amdgcn_rcpf(cc);
            Kk[t * MP + lane] = (bf16)f2bf1(kap * cprev); Bh[t * MP + lane] = (bf16)f2bf1(kap * av * ic); Kh[t * MP + lane] = (bf16)f2bf1(ks * (1.0f + (av - 1.0f) * k_a) * ic);
            WAw[(size_t)seqrow_raster(n * 64 + t, d, b) * 1024 + d * 256 + h * 64 + lane] = (bf16)f2bf1(cc);
        }
    }
    __syncthreads();
    f32x4 acc[4][4];
    if (pw == 0) {
#pragma unroll
        for (int I = 0; I < 4; ++I)
#pragma unroll
            for (int r = 0; r < 4; ++r)
#pragma unroll
                for (int nt = 0; nt < 4; ++nt) acc[I][nt][r] = bf2f(Kk[(16 * I + 4 * q + r) * MP + 16 * nt + l15]);
    }
    f32x4 T[10];
    {
        const LAS bf16* Bsrc = pw ? Kh : Bh;
        int tix = 0;
#pragma unroll
        for (int it = 0; it < 4; ++it)
#pragma unroll
            for (int jt = 0; jt <= it; ++jt, ++tix) {
                f32x4 t4 = (f32x4){0.f, 0.f, 0.f, 0.f};
#pragma unroll
                for (int s = 0; s < 2; ++s) t4 = mfma16(ld_frag16(Kk + (16 * it + l15) * MP + 32 * s + 8 * q), ld_frag16(Bsrc + (16 * jt + l15) * MP + 32 * s + 8 * q), t4);
#pragma unroll
                for (int r = 0; r < 4; ++r) { const int i = 16 * it + 4 * q + r, j = 16 * jt + l15; T[tix][r] = (j < i) ? (pw ? t4[r] : -t4[r]) : 0.f; }
            }
    }
    __syncthreads();
    {
        int tix = 0;
#pragma unroll
        for (int it = 0; it < 4; ++it)
#pragma unroll
            for (int jt = 0; jt < 4; ++jt) {
                if (jt <= it) {
#pragma unroll
                    for (int r = 0; r < 4; ++r) (pw ? Lk16 : Ln)[(16 * it + 4 * q + r) * MP + 16 * jt + l15] = (bf16)f2bf1(T[tix][r]);
                    ++tix;
                } else if (pw == 0) {
#pragma unroll
                    for (int r = 0; r < 4; ++r) Ln[(16 * it + 4 * q + r) * MP + 16 * jt + l15] = (bf16)0;
                }
            }
        LAS v4u* tz = (LAS v4u*)(B0 + 25600) + (pw * 64 + lane) * 2; tz[0] = (v4u){0u, 0u, 0u, 0u}; tz[1] = (v4u){0u, 0u, 0u, 0u};
    }
    __syncthreads();
    if (pw) {
#pragma unroll
        for (int I = 0; I < 4; ++I)
#pragma unroll
            for (int r = 0; r < 4; ++r)
#pragma unroll
                for (int nt = 0; nt < 4; ++nt) { const int i = 16 * I + 4 * q + r, j = 16 * nt + l15; acc[I][nt][r] = (j < i && nt <= I) ? bf2f(Lk16[i * MP + j]) : 0.f; }
    } else diag_inverses(Ln, TinvP, lane);
    __syncthreads();
    LAS unsigned char* XTw = XT + pw * 8192;
    { LAS v4u* xz = (LAS v4u*)(XTw + lane * 128);
#pragma unroll
        for (int g = 0; g < 8; ++g) xz[g] = (v4u){0u, 0u, 0u, 0u}; }
    blocked_solve(Ln, TinvP, XTw, acc, l15, q);
    {
        bf16* dst = rw_blob_row(C, d, pw, b, c, h, lane);
        const LAS unsigned char* xr = XTw + lane * 128;
#pragma unroll
        for (int g = 0; g < 8; ++g) *(v4u*)(dst + 8 * g) = *(const LAS v4u*)(xr + ((g ^ (lane & 7)) << 4));
    }
    __syncthreads();
}

template <bool DRY>
__device__ __forceinline__ void rwkv_chunked(const Ctx& C, int l, int idx) {
#ifndef RW_VSPLIT
#define RW_VSPLIT 1
#endif
    constexpr int NV = RW_VSPLIT ? 1 : 2;
    const int vhalf = idx & 1, lane = C.lane, w = C.wave, l15 = lane & 15, q = lane >> 4;
    const int d = RW_VSPLIT ? idx >> 6 : idx >> 5, b = RW_VSPLIT ? (idx >> 3) & 7 : (idx >> 2) & 7, h = RW_VSPLIT ? (idx >> 1) & 3 : idx & 3;
    const int it = w & 3, vt0 = RW_VSPLIT ? 2 * vhalf + (w >> 2) : 2 * (w >> 2);
    constexpr int IMG = 64 * MP * 2;
    LAS unsigned char* L0 = C.lds;
    LAS bf16* Wi = (LAS bf16*)L0; LAS bf16* Ti = Wi + 64 * MP; LAS bf16* Rh = Ti + 64 * MP; LAS bf16* Kh = Rh + 64 * MP; LAS bf16* Bh = Kh + 64 * MP;
    LAS bf16* UT = (LAS bf16*)(L0 + 11 * IMG);
    LAS float* cLv = (LAS float*)(L0 + 14 * IMG);
    const bf16* WA = WSP(const bf16, WS_HB); const bf16* rkv = WSP(const bf16, WS_RKV); const float* rinv = WSP(const float, WS_RINV);
    bf16* outb = WSP(bf16, WS_OUTB) + (size_t)d * T_ALL * 256;
    const int tt = C.tid >> 3, part = C.tid & 7;
    for (int i = C.tid; i < 2 * IMG / 4; i += NTHR) ((LAS unsigned*)(L0 + 12 * IMG))[i] = 0u;
    float kkw[8], kaw[8];
#pragma unroll
    for (int e = 0; e < 8; ++e) { kkw[e] = C.in[I_RKK][l * GW + h * 64 + 8 * w + e]; kaw[e] = C.in[I_RKA][l * GW + h * 64 + 8 * w + e]; }
    v4u gr, gk, gv, gw, ga, gbw, gbt; float gri;
    auto gload = [&](int n) {
        const int c = d ? (n < 4 ? 3 - n : 71 - n) : n;
        const int row = seqrow_raster(n * 64 + lane, d, b);
        const bf16* pr = rkv + (size_t)row * 768 + h * 64 + 8 * w;
        gr = *(const v4u*)pr; gk = *(const v4u*)(pr + 256); gv = *(const v4u*)(pr + 512);
        gw = *(const v4u*)(WA + (size_t)row * 1024 + d * 256 + h * 64 + 8 * w); ga = *(const v4u*)(WA + (size_t)row * 1024 + (2 + d) * 256 + h * 64 + 8 * w);
        gri = rinv[(size_t)row * 4 + h];
        gbw = *(const v4u*)(rw_blob_row(C, d, 0, b, c, h, tt) + 8 * part); gbt = *(const v4u*)(rw_blob_row(C, d, 1, b, c, h, tt) + 8 * part);
    };
    auto images = [&](int bufi) {
        LAS bf16* VT = (LAS bf16*)(L0 + (5 + 3 * bufi) * IMG); LAS bf16* KcT = VT + 64 * MP; LAS bf16* BcT = KcT + 64 * MP;
        const unsigned rw_[4] = {gr.x, gr.y, gr.z, gr.w}, kw_[4] = {gk.x, gk.y, gk.z, gk.w}, vw_[4] = {gv.x, gv.y, gv.z, gv.w}, ww_[4] = {gw.x, gw.y, gw.z, gw.w}, aw_[4] = {ga.x, ga.y, ga.z, ga.w};
        float rh[8], kh[8], bh[8];
#pragma unroll
        for (int e = 0; e < 8; ++e) {
            const float rs = (e & 1) ? bfhi(rw_[e >> 1]) : bflo(rw_[e >> 1]), ks = (e & 1) ? bfhi(kw_[e >> 1]) : bflo(kw_[e >> 1]);
            const float wv = (e & 1) ? bfhi(ww_[e >> 1]) : bflo(ww_[e >> 1]), av = (e & 1) ? bfhi(aw_[e >> 1]) : bflo(aw_[e >> 1]);
            const float kap = ks * kkw[e] * gri, ktil = ks * (1.0f + (av - 1.0f) * kaw[e]);
            const float cf = wv, icf = __builtin_amdgcn_rcpf(cf), cfL = __builtin_bit_cast(float, __builtin_amdgcn_readlane(__builtin_bit_cast(int, cf), 63)), dec = cfL * icf;
            rh[e] = rs * cf; kh[e] = ktil * icf; bh[e] = kap * av * icf;
            const unsigned short vraw = (e & 1) ? (unsigned short)(vw_[e >> 1] >> 16) : (unsigned short)(vw_[e >> 1] & 0xffffu);
            VT[(8 * w + e) * MP + lane] = vraw; KcT[(8 * w + e) * MP + lane] = (bf16)f2bf1(ktil * dec); BcT[(8 * w + e) * MP + lane] = (bf16)f2bf1(-(kap * av * dec));
            if (lane == 63) cLv[bufi * 64 + 8 * w + e] = cfL;
        }
        { v4u o; o.x = pk2(rh[0], rh[1]); o.y = pk2(rh[2], rh[3]); o.z = pk2(rh[4], rh[5]); o.w = pk2(rh[6], rh[7]); *(LAS v4u*)(Rh + lane * MP + 8 * w) = o; }
        { v4u o; o.x = pk2(kh[0], kh[1]); o.y = pk2(kh[2], kh[3]); o.z = pk2(kh[4], kh[5]); o.w = pk2(kh[6], kh[7]); *(LAS v4u*)(Kh + lane * MP + 8 * w) = o; }
        { v4u o; o.x = pk2(bh[0], bh[1]); o.y = pk2(bh[2], bh[3]); o.z = pk2(bh[4], bh[5]); o.w = pk2(bh[6], bh[7]); *(LAS v4u*)(Bh + lane * MP + 8 * w) = o; }
        const unsigned bw_[4] = {gbw.x, gbw.y, gbw.z, gbw.w}, bt_[4] = {gbt.x, gbt.y, gbt.z, gbt.w};
#pragma unroll
        for (int e = 0; e < 4; ++e) {
            Wi[(8 * part + 2 * e) * MP + tt] = (bf16)(bw_[e] & 0xffffu); Wi[(8 * part + 2 * e + 1) * MP + tt] = (bf16)(bw_[e] >> 16);
            Ti[(8 * part + 2 * e) * MP + tt] = (bf16)(bt_[e] & 0xffffu); Ti[(8 * part + 2 * e + 1) * MP + tt] = (bf16)(bt_[e] >> 16);
        }
    };
    f32x4 Zst[NV];
#pragma unroll
    for (int v2 = 0; v2 < NV; ++v2) Zst[v2] = (f32x4){0.f, 0.f, 0.f, 0.f};
    const f32x4 z4 = (f32x4){0.f, 0.f, 0.f, 0.f};
    gload(0); images(0); gload(1);
#pragma unroll 1
    for (int n = 0; n < NCH; ++n) {
        RAW_BARRIER();
        const LAS bf16* VT = (const LAS bf16*)(L0 + (5 + 3 * (n & 1)) * IMG); const LAS bf16* KcT = VT + 64 * MP; const LAS bf16* BcT = KcT + 64 * MP;
        const LAS bf16* Zi = (const LAS bf16*)(L0 + (12 + (n & 1)) * IMG); LAS bf16* Zn = (LAS bf16*)(L0 + (12 + ((n + 1) & 1)) * IMG);
        const int arow = (16 * it + l15) * MP + 8 * q;
        const fragb Wf0 = ld_frag16(Wi + arow), Wf1 = ld_frag16(Wi + arow + 32), Tf0 = ld_frag16(Ti + arow), Tf1 = ld_frag16(Ti + arow + 32), Rf0 = ld_frag16(Rh + arow), Rf1 = ld_frag16(Rh + arow + 32);
        const int icol = 16 * it + l15;
        f32x4 pk[4], pb[4];
#pragma unroll
        for (int jt = 0; jt < 4; ++jt) {
            pk[jt] = z4; pb[jt] = z4;
            if (jt <= it) {
                const int jrow = (16 * jt + l15) * MP + 8 * q;
                f32x4 sk = mfma16(ld_frag16(Kh + jrow), Rf0, z4); sk = mfma16(ld_frag16(Kh + jrow + 32), Rf1, sk);
                f32x4 sb = mfma16(ld_frag16(Bh + jrow), Rf0, z4); sb = mfma16(ld_frag16(Bh + jrow + 32), Rf1, sb);
#pragma unroll
                for (int r = 0; r < 4; ++r) { const int j = 16 * jt + 4 * q + r; pk[jt][r] = (j <= icol) ? sk[r] : 0.f; pb[jt][r] = (j <= icol) ? -sb[r] : 0.f; }
            }
        }
        fragb Pk0 = pack_frag(pk[0], pk[1]), Pk1 = pack_frag(pk[2], pk[3]), Pb0 = pack_frag(pb[0], pb[1]), Pb1 = pack_frag(pb[2], pb[3]);
        f32x4 RZ[NV];
#pragma unroll
        for (int v2 = 0; v2 < NV; ++v2) {
            const int vrow = 16 * (vt0 + v2) + l15;
            const fragb z0 = ld_frag16(Zi + vrow * MP + 8 * q), z1 = ld_frag16(Zi + vrow * MP + 32 + 8 * q);
            f32x4 u = mfma16(Wf0, z0, z4); u = mfma16(Wf1, z1, u);
            u = mfma16(Tf0, ld_frag16(VT + vrow * MP + 8 * q), u); if (it >= 2) u = mfma16(Tf1, ld_frag16(VT + vrow * MP + 32 + 8 * q), u);
            RZ[v2] = mfma16(Rf0, z0, z4); RZ[v2] = mfma16(Rf1, z1, RZ[v2]);
            v2u o; o.x = pk2(u.x, u.y); o.y = pk2(u.z, u.w);
            *(LAS v2u*)(UT + vrow * MP + 16 * it + 4 * q) = o;
        }
        RAW_BARRIER();
        {
            const f32x4 cl4 = *(const LAS f32x4*)(cLv + (n & 1) * 64 + 16 * it + 4 * q);
            const LAS bf16* kr = KcT + (16 * it + l15) * MP + 4 * q; const LAS bf16* br = BcT + (16 * it + l15) * MP + 4 * q;
            const fragb kc0 = ld_frag8x2(kr, kr + 16), kc1 = ld_frag8x2(kr + 32, kr + 48), bc0 = ld_frag8x2(br, br + 16), bc1 = ld_frag8x2(br + 32, br + 48);
#pragma unroll
            for (int v2 = 0; v2 < NV; ++v2) {
                const int vrow = 16 * (vt0 + v2) + l15;
                const LAS bf16* vr = VT + vrow * MP + 4 * q; const LAS bf16* ur = UT + vrow * MP + 4 * q;
                const fragb vp0 = ld_frag8x2(vr, vr + 16), vp1 = ld_frag8x2(vr + 32, vr + 48), up0 = ld_frag8x2(ur, ur + 16), up1 = ld_frag8x2(ur + 32, ur + 48);
                f32x4 y = mfma16(Pk0, vp0, RZ[v2]); y = mfma16(Pb0, up0, y);
                if (it >= 2) { y = mfma16(Pk1, vp1, y); y = mfma16(Pb1, up1, y); }
#pragma unroll
                for (int r = 0; r < 4; ++r) { const int row = seqrow_raster(n * 64 + 16 * it + 4 * q + r, d, b); if (!DRY) outb[(size_t)row * 256 + h * 64 + vrow] = (bf16)f2bf1(y[r]); }
                f32x4 zn = mfma16(kc0, vp0, z4); zn = mfma16(kc1, vp1, zn); zn = mfma16(bc0, up0, zn); zn = mfma16(bc1, up1, zn);
                Zst[v2] = Zst[v2] * cl4 + zn;
                v2u so; so.x = pk2(Zst[v2].x, Zst[v2].y); so.y = pk2(Zst[v2].z, Zst[v2].w);
                *(LAS v2u*)(Zn + vrow * MP + 16 * it + 4 * q) = so;
            }
        }
        if (n + 1 < NCH) { images((n + 1) & 1); if (n + 2 < NCH) gload(n + 2); }
    }
    __syncthreads();
}
__device__ __forceinline__ void moe_scatter(const Ctx& C, int moe_li, int nrows) {
    const unsigned* gc = WSP(const unsigned, WS_CTL) + CW_MOECNT + 64 * moe_li;
    LAS int* pst = (LAS int*)C.lds;
    {
        int pe[8]; int acc = 0;
#pragma unroll
        for (int e = 0; e < NE; ++e) { const int blks = ((int)gc[e] + 255) >> 8; if (C.tid == e) pst[e] = acc * 256; acc += blks; pe[e] = acc; }
        if (C.wg == 0 && C.tid < MOE_MAXBLK) { int be = 0;
#pragma unroll
            for (int e = 0; e < NE; ++e) be += (pe[e] <= C.tid) ? 1 : 0;
            int* tab = WSP(int, WS_TAB); tab[1 + C.tid] = be < NE ? be : NE - 1; if (C.tid == 0) tab[0] = acc; }
    }
    __syncthreads();
    const unsigned* route = WSP(const unsigned, WS_ROUTE); const unsigned* wgbase = WSP(const unsigned, WS_WGBASE);
    const bf16* hb = WSP(const bf16, WS_HB); bf16* am = WSP(bf16, WS_MIX); int* pos = WSP(int, WS_POS);
    const int gw = C.wg * NWAVES + C.wave, NGW = C.G * NWAVES;
    for (int m = gw; m < nrows; m += NGW) {
        const v4u a = *(const v4u*)(route + (size_t)m * 8);
        const int e0 = (int)a.x, e1 = (int)a.y;
        const int p0 = pst[e0] + (int)wgbase[C.wg * 8 + e0] + (int)a.z, p1 = pst[e1] + (int)wgbase[C.wg * 8 + e1] + (int)a.w;
        const v4u r0 = *(const v4u*)(hb + (size_t)m * 1024 + C.lane * 8), r1 = *(const v4u*)(hb + (size_t)m * 1024 + 512 + C.lane * 8);
        *(v4u*)(am + (size_t)p0 * 1024 + C.lane * 8) = r0; *(v4u*)(am + (size_t)p0 * 1024 + 512 + C.lane * 8) = r1;
        *(v4u*)(am + (size_t)p1 * 1024 + C.lane * 8) = r0; *(v4u*)(am + (size_t)p1 * 1024 + 512 + C.lane * 8) = r1;
        if (C.lane == 0) { pos[(size_t)m * 2] = p0; pos[(size_t)m * 2 + 1] = p1; }
    }
    __syncthreads();
}
template <int NEXT>
__device__ __forceinline__ void moe_combine(const Ctx& C, int l, int nrows) {
    const unsigned* route = WSP(const unsigned, WS_ROUTE); const int* pos = WSP(const int, WS_POS); const bf16* ym = WSP(const bf16, WS_MIX);
    const float* modv = WSP(const float, WS_MODV) + (size_t)l * 9 * 6144 + 5 * 1024;
    const float* modn = WSP(const float, WS_MODV) + (size_t)(l + 1) * 9 * 6144;
    float* xc = WSP(float, WS_XC); bf16* hb = WSP(bf16, WS_HB);
    const int gw = C.wg * NWAVES + C.wave, NGW = C.G * NWAVES;
    f32x4 gn[4];
#pragma unroll
    for (int j = 0; j < 4; ++j) gn[j] = *(const f32x4*)((NEXT == 2 ? C.in[I_FNG] : C.in[I_NMIXG] + (NEXT == 1 ? (l + 1) * 1024 : 0)) + 4 * C.lane + 256 * j);
    for (int m = gw; m < nrows; m += NGW) {
        const bool isctx = m >= T_LAT;
        float* xr = isctx ? xc + (size_t)(m - T_LAT) * 1024 : C.out + (size_t)m * 1024;
        const int mrow = isctx ? 8 : (m >> 12);
        const float* gv = modv + (size_t)mrow * 6144;
        const int p0 = pos[(size_t)m * 2], p1 = pos[(size_t)m * 2 + 1];
        const float w0 = __builtin_bit_cast(float, route[(size_t)m * 8 + 4]), w1 = __builtin_bit_cast(float, route[(size_t)m * 8 + 5]);
        f32x4 x[4]; float ss = 0.f;
#pragma unroll
        for (int j = 0; j < 4; ++j) {
            const int col = 4 * C.lane + 256 * j;
            const v2u a = *(const v2u*)(ym + (size_t)p0 * 1024 + col), b = *(const v2u*)(ym + (size_t)p1 * 1024 + col);
            const f32x4 ya = (f32x4){bflo(a.x), bfhi(a.x), bflo(a.y), bfhi(a.y)}, yb = (f32x4){bflo(b.x), bfhi(b.x), bflo(b.y), bfhi(b.y)};
            const f32x4 g = *(const f32x4*)(gv + col);
            x[j] = *(const f32x4*)(xr + col) + g * (ya * w0 + yb * w1);
            if (NEXT != 2) *(f32x4*)(xr + col) = x[j];
            ss += (x[j].x * x[j].x + x[j].y * x[j].y) + (x[j].z * x[j].z + x[j].w * x[j].w);
        }
        if (NEXT != 0) {
            const float rs = rsqrtf_(wave_sum(ss) * (1.0f / 1024.0f) + 1e-6f);
#pragma unroll
            for (int j = 0; j < 4; ++j) {
                const int col = 4 * C.lane + 256 * j;
                if (NEXT == 2) *(f32x4*)(xr + col) = x[j] * rs * gn[j];
                else { const f32x4 sh = *(const f32x4*)(modn + (size_t)mrow * 6144 + col), scl = *(const f32x4*)(modn + (size_t)mrow * 6144 + 1024 + col);
                    st4bf(hb + (size_t)m * 1024 + col, (x[j] * rs * gn[j]) * (scl + 1.0f) + sh); }
            }
        }
    }
}
__device__ __forceinline__ void final_norm(const Ctx& C) {
    const int gw = C.wg * NWAVES + C.wave, NGW = C.G * NWAVES;
    f32x4 gv[4];
#pragma unroll
    for (int j = 0; j < 4; ++j) gv[j] = *(const f32x4*)(C.in[I_FNG] + 4 * C.lane + 256 * j);
    for (int m = gw; m < T_LAT; m += NGW) {
        float* xr = C.out + (size_t)m * 1024;
        f32x4 v[4]; float s = 0.f;
#pragma unroll
        for (int j = 0; j < 4; ++j) { v[j] = *(const f32x4*)(xr + 4 * C.lane + 256 * j); s += (v[j].x * v[j].x + v[j].y * v[j].y) + (v[j].z * v[j].z + v[j].w * v[j].w); }
        const float rs = rsqrtf_(wave_sum(s) * (1.0f / 1024.0f) + 1e-6f);
#pragma unroll
        for (int j = 0; j < 4; ++j) *(f32x4*)(xr + 4 * C.lane + 256 * j) = v[j] * rs * gv[j];
    }
}

constexpr int NPH_L = 13, PH_FINAL = 1 + DEPTH * NPH_L, NPHASE = PH_FINAL + 1;
__host__ __device__ inline bool phase_exists(int ph) {
    if (ph == 0) return true;
    if (ph == PH_FINAL) return false;
    const int l = (ph - 1) / NPH_L, k = (ph - 1) % NPH_L;
    if (l >= 2 && !(l & 1) && k == 0) return false;
    if (!(l & 1) && k >= 11) return false;
    if (!RW_VSPLIT && k == 4) return false;
    return true;
}
#ifndef PH_MASK
#define PH_MASK 0xFFFFFF
#endif
#define PM(k) ((PH_MASK >> (k)) & 1)
#ifndef SK_MASK
#define SK_MASK 0xFFFF
#endif
#define SK(k) ((SK_MASK >> (k)) & 1)
#ifndef REP_MASK
#define REP_MASK 0
#endif
#define NREP(k) (((REP_MASK >> (k)) & 1) ? 2 : 1)

__global__ void __launch_bounds__(NTHR, 2) fwd_kernel(Args args) {
    extern __shared__ __attribute__((aligned(16))) unsigned char lds_raw[];
    Ctx C; C.in = args.in; C.out = args.out; C.ws = args.ws; C.lds = (LAS unsigned char*)lds_raw;
    C.tid = threadIdx.x; C.lane = C.tid & 63; C.wave = __builtin_amdgcn_readfirstlane(C.tid >> 6); C.G = gridDim.x; C.wg = blockIdx.x;
    volatile LAS unsigned* MISC = (volatile LAS unsigned*)(C.lds + MISC_OFF);
    if (C.tid < 64) MISC[C.tid] = 0u;
    __syncthreads();
    const int lo = args.ph_lo, hi = args.ph_hi;
    const bool multi = (hi - lo) > 1;
    if (multi) (void)xcd_barrier_post(WSP(unsigned, WS_CTL) + CW_BAR, MISC + 8);
#define IN(k) (lo <= (k) && (k) < hi)
#define SEAM(k) do { if (IN((k) + 1)) { XcdBarrier b2_; b2_.bar = WSP(unsigned, WS_CTL) + CW_BAR; b2_.x = xb_xcc_id(); b2_.st = (volatile LAS unsigned*)(C.lds + MISC_OFF) + 8; xcd_barrier(b2_); } } while (0)
#define FRESH() do { int t_ = threadIdx.x; asm volatile("" : "+v"(t_)); C.tid = t_; C.lane = t_ & 63; C.wave = __builtin_amdgcn_readfirstlane(t_ >> 6); } while (0)
#define PHASE(bit, k) if (PM(bit) && IN(pb + (k))) for (int rep_ = 0; rep_ < NREP(bit); ++rep_)
#define CLAIM(qh, var) __syncthreads(); if (C.tid == 0) *qslot = atomicAdd((qh), 1u); __syncthreads(); const int var = (int)*qslot;

    LAS unsigned* qslot = (LAS unsigned*)(C.lds + MISC_OFF + 128);
    if (PM(20) && IN(0)) { phase_pre(C); SEAM(0); }

#pragma unroll 1
    for (int l = 0; l < DEPTH; ++l) {
        const int pb = 1 + l * NPH_L;
        if (hi <= pb || lo >= pb + NPH_L) continue;
        const bool last = (l == DEPTH - 1), moe = (l & 1);
        const int nrows = last ? T_LAT : T_ALL;
        const float* xlat = (l == 0) ? C.in[I_X] : C.out; const float* xctx = (l == 0) ? C.in[I_CTX] : WSP(const float, WS_XC);
        const float* modv = WSP(const float, WS_MODV) + (size_t)l * 9 * 6144;
        unsigned* qbase = WSP(unsigned, WS_CTL) + CW_PREPQ + 256 * l;

        if (!(l >= 2 && !(l & 1))) PHASE(0, 0) { FRESH();
            convert_small(C, l);
            if (l == 0) { FRESH(); convert_items(C, 0, 3, C.wg * NWAVES + C.wave, C.G * NWAVES); }
            __syncthreads();
            FRESH(); norm_rows<false>(C, l, xlat, xctx, C.in[I_NMIXG] + l * 1024, 0, 1024, T_ALL, 0);
            SEAM(pb + 0);
        }
        PHASE(1, 1) { FRESH();
            pg8::Gemm g{WSP(const bf16, WS_HB), WSP(const bf16, WS_WIN), T_ALL, PLD, 1024, 0};
            pg8::StaticOrder S; S.init(T_ALL, PLD, C.G, C.wg);
            pg8::EpiBf16<0> E{WSP(bf16, WS_P), PLD, nullptr, 0, 0};
            pg8::gemm_phase<pg8::EpiBf16<0>, pg8::StaticOrder, false>(C.lds, g, S, E, nullptr);
            SEAM(pb + 1);
        }
        if (PM(2) && IN(pb + 2)) for (int rep_ = 0; rep_ < NREP(2); ++rep_) { FRESH();
            for (;;) {
                CLAIM(qbase + 16 * rep_, k)
                if (k >= 3 * NB * NCH) break;
                const int kind = k / (NB * NCH), u = k % (NB * NCH);
                FRESH();
                if (kind == 0) { for (int r3_ = 0; r3_ < NREP(24); ++r3_) { FRESH(); if (SK(1)) rwkv_prep2(C, l, u / NCH, u % NCH); } }
                else if (kind == 1) { for (int r3_ = 0; r3_ < NREP(25); ++r3_) { FRESH(); if (SK(0)) lru_chunk_mfma<false>(C, l, u / NCH, u % NCH); } }
                else { for (int r3_ = 0; r3_ < NREP(26); ++r3_) { FRESH(); if (SK(2)) gdn_prep(C, l, u / NCH, u % NCH); } }
            }
            SEAM(pb + 2);
        }
        if (PM(3) && IN(pb + 3)) for (int rep_ = 0; rep_ < NREP(3); ++rep_) { FRESH();
            constexpr int NCL = 2 * NB * NH * NCH / 4;
            for (;;) {
                CLAIM(qbase + 64 + 16 * rep_, k)
                if (k >= (RW_VSPLIT ? NCL : 2 * NCL)) break;
                FRESH();
                if (k < NCL) { if (SK(9)) gdn_solve_item(C, l, 4 * k + (C.wave >> 1)); }
                else { if (SK(10)) rwkv_solve_item(C, l, 4 * (k - NCL) + (C.wave >> 1)); }
            }
            FRESH(); if (SK(6) && C.wg < 8) lru_carry(C, C.wg * NTHR + C.tid);
            SEAM(pb + (RW_VSPLIT ? 3 : 4));
        }
#if RW_VSPLIT
        if (PM(3) && IN(pb + 4)) { FRESH();
            for (;;) {
                CLAIM(qbase + 128, k)
                if (k >= 2 * NB * NH * NCH / 4) break;
                FRESH();
                if (SK(10)) rwkv_solve_item(C, l, 4 * k + (C.wave >> 1));
            }
            SEAM(pb + 4);
        }
#endif
        if (PM(4) && IN(pb + 5)) { FRESH();
            if (SK(3) && C.wg < (RW_VSPLIT ? 128 : 64)) { if (NREP(20) > 1) { FRESH(); rwkv_chunked<true>(C, l, C.wg); } FRESH(); rwkv_chunked<false>(C, l, C.wg); }
            else if (SK(4) && C.wg >= 128 && C.wg < 192) { for (int r2_ = 0; r2_ < NREP(21); ++r2_) { FRESH(); mlstm_chunked(C, l, C.wg - 128); } }
            else if (SK(5) && C.wg >= 192) { if (NREP(22) > 1) { FRESH(); gdn_chunked<true>(C, l, C.wg - 192); } FRESH(); gdn_chunked<false>(C, l, C.wg - 192); }
            {
                FRESH();
                const int nun = last ? NB * 64 : NB * NCH;
                for (;;) {
                    CLAIM(qbase + 192, u0)
                    if (u0 >= 128 + nun) break;
                    if (u0 < 128) {
                        FRESH(); if (l > 0) convert_items(C, l, 2, u0 * NWAVES + C.wave, 128 * NWAVES);
                        if (l + 1 < DEPTH) { FRESH(); convert_items(C, l + 1, 1, u0 * NWAVES + C.wave, 128 * NWAVES); }
                    } else {
                        const int u = u0 - 128;
                        const int b = last ? (u >> 6) : (u / NCH), c = last ? 4 + (u & 63) : (u % NCH);
                        if (SK(7)) lru_chunk_mfma<true>(C, l, b, c);
                    }
                }
            }
            SEAM(pb + 5);
        }
        PHASE(5, 6) { FRESH();
            if (SK(8)) finish_rows(C, l, nrows);
            SEAM(pb + 6);
        }
        if (PM(6) && IN(pb + 7)) { FRESH();
            pg8::Gemm g{WSP(const bf16, WS_HB), WSP(const bf16, WS_WOUT), nrows, 1024, 1024, 0};
            pg8::StaticOrder S; S.init(nrows, 1024, C.G, C.wg);
            pg8::EpiRes E{xlat, xctx, C.out, WSP(float, WS_XC), modv + 2 * 1024};
            pg8::gemm_phase<pg8::EpiRes, pg8::StaticOrder, false>(C.lds, g, S, E, nullptr);
            SEAM(pb + 7);
        }
        if (PM(7) && IN(pb + 8)) { FRESH();
            if (moe) norm_rows<true>(C, l, C.out, WSP(const float, WS_XC), C.in[I_NFFNG] + l * 1024, 3 * 1024, 4 * 1024, nrows, l >> 1);
            else norm_rows<false>(C, l, C.out, WSP(const float, WS_XC), C.in[I_NFFNG] + l * 1024, 3 * 1024, 4 * 1024, nrows, 0);
            SEAM(pb + 8);
        }
        if (!moe) {
            if (PM(8) && IN(pb + 9)) for (int rep_ = 0; rep_ < NREP(8); ++rep_) { FRESH();
                pg8::Gemm g{WSP(const bf16, WS_HB), WSP(const bf16, WS_WGU), nrows, 2 * DFF, 1024, 0};
                pg8::StaticOrder S; S.init(nrows, 2 * DFF, C.G, C.wg);
                pg8::EpiSwiglu E{WSP(bf16, WS_P), DFF};
                pg8::gemm_phase<pg8::EpiSwiglu, pg8::StaticOrder, false>(C.lds, g, S, E, nullptr);
                SEAM(pb + 9);
            }
            if (PM(9) && IN(pb + 10)) { FRESH();
                pg8::Gemm g{WSP(const bf16, WS_P), WSP(const bf16, WS_WDN), nrows, 1024, DFF, 0};
                pg8::StaticOrder S; S.init(nrows, 1024, C.G, C.wg);
                pg8::EpiRes E{C.out, WSP(const float, WS_XC), C.out, WSP(float, WS_XC), modv + 5 * 1024};
                pg8::gemm_phase<pg8::EpiRes, pg8::StaticOrder, false>(C.lds, g, S, E, nullptr);
                SEAM(pb + 12);
            }
        } else {
            if (PM(10) && IN(pb + 9)) { FRESH(); moe_scatter(C, l >> 1, nrows); SEAM(pb + 9); }
            if (PM(11) && IN(pb + 10)) for (int rep_ = 0; rep_ < NREP(11); ++rep_) { FRESH();
                pg8::Gemm g{WSP(const bf16, WS_MIX), WSP(const bf16, WS_WGU), 0, 2 * DFE, 1024, (size_t)2 * DFE * 1024};
                pg8::MoeOrder S; S.init(WSP(const int, WS_TAB), (2 * DFE) / 256, C.G, C.wg);
                pg8::EpiSwiglu E{WSP(bf16, WS_P), DFE};
                pg8::gemm_phase<pg8::EpiSwiglu, pg8::MoeOrder, false>(C.lds, g, S, E, nullptr);
                SEAM(pb + 10);
            }
            if (PM(12) && IN(pb + 11)) for (int rep_ = 0; rep_ < NREP(12); ++rep_) { FRESH();
                pg8::Gemm g{WSP(const bf16, WS_P), WSP(const bf16, WS_WDN), 0, 1024, DFE, (size_t)1024 * DFE};
                pg8::MoeOrder S; S.init(WSP(const int, WS_TAB), 4, C.G, C.wg);
                pg8::EpiBf16<0> E{WSP(bf16, WS_MIX), 1024, nullptr, 0, 0};
                pg8::gemm_phase<pg8::EpiBf16<0>, pg8::MoeOrder, false>(C.lds, g, S, E, nullptr);
                SEAM(pb + 11);
            }
            if (PM(13) && IN(pb + 12)) { FRESH();
                if (last) moe_combine<2>(C, l, nrows);
                else { convert_small(C, l + 1); FRESH(); moe_combine<1>(C, l, nrows); if (IN(pb + NPH_L + 1)) { XcdBarrier b2_; b2_.bar = WSP(unsigned, WS_CTL) + CW_BAR; b2_.x = xb_xcc_id(); b2_.st = (volatile LAS unsigned*)(C.lds + MISC_OFF) + 8; xcd_barrier(b2_); } }
            }
        }
    }
}

extern "C" void kernel_launch(void* const* d_in, const int* in_sizes, int n_in, void* d_out, int out_size, void* d_ws, size_t ws_size, hipStream_t stream) {
    static int grid = 0;
    if (grid == 0) {
        if (n_in != N_IN || in_sizes[0] != T_LAT * DM || out_size != T_LAT * DM || ws_size < WS_END) {
            fprintf(stderr, "kernel_launch: unexpected problem (n_in %d, in0 %d, out %d, ws %zu < %zu)\n", n_in, n_in > 0 ? in_sizes[0] : -1, out_size, ws_size, (size_t)WS_END); grid = -1; return; }
        int dev = 0, cus = 0, per_cu = 0;
        if (hipGetDevice(&dev) != hipSuccess || hipDeviceGetAttribute(&cus, hipDeviceAttributeMultiprocessorCount, dev) != hipSuccess) { grid = -1; return; }
        if (hipFuncSetAttribute((const void*)fwd_kernel, hipFuncAttributeMaxDynamicSharedMemorySize, LDS_BYTES) != hipSuccess) { fprintf(stderr, "kernel_launch: hipFuncSetAttribute failed\n"); grid = -1; return; }
        if (hipOccupancyMaxActiveBlocksPerMultiprocessor(&per_cu, (const void*)fwd_kernel, NTHR, LDS_BYTES) != hipSuccess || per_cu < 1) { fprintf(stderr, "kernel_launch: occupancy query says %d\n", per_cu); grid = -1; return; }
        grid = cus;
        if (grid != 256) fprintf(stderr, "kernel_launch: note: %d CUs\n", grid);
    }
    if (grid < 0) return;
    if (hipMemsetAsync((char*)d_ws + WS_CTL, 0, CTL_BYTES, stream) != hipSuccess) return;
    Args a{};
    for (int i = 0; i < N_IN; ++i) a.in[i] = (const float*)d_in[i];
    a.out = (float*)d_out; a.ws = (unsigned char*)d_ws;
#if MK_ONE_LAUNCH
    a.ph_lo = 0; a.ph_hi = NPHASE;
    hipLaunchKernelGGL(fwd_kernel, dim3(grid), dim3(NTHR), LDS_BYTES, stream, a);
#else
    for (int ph = 0; ph < NPHASE; ++ph) { if (!phase_exists(ph)) continue; a.ph_lo = ph; a.ph_hi = ph + 1; hipLaunchKernelGGL(fwd_kernel, dim3(grid), dim3(NTHR), LDS_BYTES, stream, a); }
#endif
}
```

```cpp
#define MK_ONE_LAUNCH 1
#include <hip/hip_runtime.h>
#include <cstdio>
#include <cstdint>

#define GAS __attribute__((address_space(1)))
#define LAS __attribute__((address_space(3)))
typedef unsigned short bf16;
typedef unsigned v4u __attribute__((ext_vector_type(4)));
typedef unsigned v2u __attribute__((ext_vector_type(2)));
typedef float f32x4 __attribute__((ext_vector_type(4)));
typedef float f32x2 __attribute__((ext_vector_type(2)));
typedef short bf16x8 __attribute__((ext_vector_type(8)));
#define LDS_WAIT() asm volatile("s_waitcnt lgkmcnt(0)" ::: "memory")
#define VM_WAIT() asm volatile("s_waitcnt vmcnt(0)" ::: "memory")

constexpr int DM = 1024, NB = 8, SEQ = 4096, DEPTH = 4, CTXL = 256, GW = 256, HD = 64, NH = 4;
constexpr int T_LAT = NB * SEQ, T_CTX = NB * CTXL, T_ALL = T_LAT + T_CTX;
constexpr int IN_COLS = 3552, PLD = 3584;
constexpr int OFF_B = 512, OFF_C = 1472, OFF_D = 2512, B_COLS = 960;
constexpr int DFF = 2816, NE = 8, DFE = 1408;
constexpr int NCH = 68;
constexpr int NSTEP = 4352;
constexpr int MOE_MAXBLK = 280;
constexpr int NWAVES = 8, NTHR = 512;
#ifndef RW_VSPLIT
#define RW_VSPLIT 0
#endif

constexpr size_t MiB = 1u << 20;
constexpr size_t WS_CTL = 0, CTL_BYTES = 1 * MiB;
constexpr size_t WS_MODV = 1 * MiB;
constexpr size_t WS_XC = 2 * MiB;
constexpr size_t WS_WIN = 10 * MiB;
constexpr size_t WS_WOUT = 17 * MiB;
constexpr size_t WS_WGU = 19 * MiB;
constexpr size_t WS_WDN = 63 * MiB;
constexpr size_t WS_HB = 85 * MiB;
constexpr size_t WS_P = 153 * MiB;
constexpr size_t WS_MIX = 391 * MiB;
constexpr size_t WS_OUTB = WS_MIX, WS_OUTC = WS_MIX + 34 * MiB, WS_OUTD = WS_MIX + 68 * MiB, WS_GQ = WS_MIX + 102 * MiB, WS_G = WS_MIX + 153 * MiB;
constexpr size_t WS_RKV = WS_MIX + 170 * MiB;
constexpr size_t WS_SMALL = 612 * MiB;
constexpr size_t WS_LSUM = WS_SMALL;
constexpr size_t WS_HIN = WS_SMALL + 3 * MiB;
constexpr size_t WS_ROUTE = WS_SMALL + 5 * MiB;
constexpr size_t WS_POS = WS_SMALL + 7 * MiB;
constexpr size_t WS_TOK = WS_POS + 512 * 1024;
constexpr size_t WS_BONUS = WS_SMALL + 8 * MiB;
constexpr size_t WS_WGBASE = WS_SMALL + 9 * MiB;
constexpr size_t WS_TAB = WS_WGBASE + 65536;
constexpr size_t WS_LRUWT = WS_SMALL + 10 * MiB;
constexpr size_t WS_RWT = WS_LRUWT + 131072;
constexpr size_t WS_RINV = WS_SMALL + 11 * MiB;
constexpr size_t WS_END = 624 * MiB;
constexpr int CW_MOECNT = 1024;
constexpr int CW_PREPQ = 2048;
constexpr int CW_BAR = 4096;

constexpr int LDS_BYTES = 135168;
constexpr int MISC_OFF = 131072;

__device__ __forceinline__ unsigned f2bf(float f) { unsigned u = __builtin_bit_cast(unsigned, f); return (u + 0x7fffu + ((u >> 16) & 1u)) >> 16; }
typedef __bf16 bf16n2 __attribute__((ext_vector_type(2)));
__device__ __forceinline__ unsigned pk2(float lo, float hi) { const f32x2 v = {lo, hi}; return __builtin_bit_cast(unsigned, __builtin_convertvector(v, bf16n2)); }
__device__ __forceinline__ unsigned f2bf1(float f) { return pk2(f, f) & 0xffffu; }
__device__ __forceinline__ float bf2f(unsigned short v) { return __builtin_bit_cast(float, (unsigned)v << 16); }
__device__ __forceinline__ float bflo(unsigned v) { return __builtin_bit_cast(float, v << 16); }
__device__ __forceinline__ float bfhi(unsigned v) { return __builtin_bit_cast(float, v & 0xffff0000u); }
template <int CTRL, int RM, bool BC> __device__ __forceinline__ float dpp_x(float oldv, float v) { return __builtin_bit_cast(float, __builtin_amdgcn_update_dpp(__builtin_bit_cast(int, oldv), __builtin_bit_cast(int, v), CTRL, RM, 0xF, BC)); }
__device__ __forceinline__ float wave_sum(float v) {
    v += dpp_x<0xB1, 0xF, true>(0.f, v); v += dpp_x<0x4E, 0xF, true>(0.f, v); v += dpp_x<0x141, 0xF, true>(0.f, v); v += dpp_x<0x140, 0xF, true>(0.f, v);
    v += dpp_x<0x142, 0xA, false>(0.f, v); v += dpp_x<0x143, 0xC, false>(0.f, v);
    return __builtin_bit_cast(float, __builtin_amdgcn_readlane(__builtin_bit_cast(int, v), 63));
}
template <int CTRL> __device__ __forceinline__ float dpp_f(float v) { return __builtin_bit_cast(float, __builtin_amdgcn_update_dpp(0, __builtin_bit_cast(int, v), CTRL, 0xF, 0xF, true)); }
__device__ __forceinline__ float row16_sum(float v) {
    v += dpp_f<0xB1>(v);
    v += dpp_f<0x4E>(v);
    v += dpp_f<0x141>(v);
    v += dpp_f<0x140>(v);
    return v;
}
__device__ __forceinline__ float sigmoidf_(float x) { return __builtin_amdgcn_rcpf(1.0f + __expf(-x)); }
__device__ __forceinline__ float softplusf_(float x) { return fmaxf(x, 0.f) + __logf(1.0f + __expf(-fabsf(x))); }
__device__ __forceinline__ float expm1f_(float x) { return x > -0.3f ? x * (1.0f + x * (0.5f + x * (0.16666667f + x * (0.041666668f + x * 0.0083333338f)))) : __expf(x) - 1.0f; }
__device__ __forceinline__ float siluf_(float x) { return x * __builtin_amdgcn_rcpf(1.0f + __expf(-x)); }
__device__ __forceinline__ float tanhf_(float x) { const float e = __expf(2.0f * x); return 1.0f - 2.0f * __builtin_amdgcn_rcpf(e + 1.0f); }
__device__ __forceinline__ float rsqrtf_(float x) { return __builtin_amdgcn_rsqf(x); }
__device__ __forceinline__ float gelu_tanh(float x) { return 0.5f * x * (1.0f + tanhf_(0.7978845608028654f * (x + 0.044715f * x * x * x))); }
__device__ __forceinline__ f32x4 ld4bf(const bf16* p) { const v2u a = *(const v2u*)p; return (f32x4){bflo(a.x), bfhi(a.x), bflo(a.y), bfhi(a.y)}; }
__device__ __forceinline__ void st4bf(bf16* p, const f32x4& v) { v2u o; o.x = pk2(v.x, v.y); o.y = pk2(v.z, v.w); *(v2u*)p = o; }
#define XB_TMO      128
#define XB_XCNT(j)  (256  + 64 * (j))
#define XB_XSUB(j)  (1280 + 64 * (j))
#define XB_XGEN(j)  (2304 + 64 * (j))
#define XB_TOP      3328
#define XB_TOPGEN   3392
#define XCD_BAR_WORDS 3456
#define XB_SPIN_CAP (1u << 22)

__device__ __forceinline__ unsigned xb_ld(unsigned* p)              { return __hip_atomic_load(p, __ATOMIC_RELAXED, __HIP_MEMORY_SCOPE_AGENT); }
__device__ __forceinline__ unsigned xb_add(unsigned* p, unsigned v) { return __hip_atomic_fetch_add(p, v, __ATOMIC_RELAXED, __HIP_MEMORY_SCOPE_AGENT); }
__device__ __forceinline__ unsigned xb_xcc_id() { return (unsigned)__builtin_amdgcn_s_getreg((3 << 11) | 20) & 0xFu; }
#define XB_SPIN(cond, bar) do { unsigned _sp = 0; while (cond) { __builtin_amdgcn_s_sleep(1); \
    if ((++_sp & 255u) == 0u) { if (xb_ld(&(bar)[XB_TMO])) break; if (_sp > XB_SPIN_CAP) { atomicAdd(&(bar)[XB_TMO], 1u); break; } } } } while (0)

struct XcdBarrier {
    unsigned* bar; unsigned x;
    volatile LAS unsigned* st;
};

__device__ __forceinline__ XcdBarrier xcd_barrier_post(unsigned* bar, volatile LAS unsigned* st) {
    XcdBarrier b; b.bar = bar; b.x = xb_xcc_id(); b.st = st;
    if (threadIdx.x == 0) (void)xb_add(&bar[XB_XCNT(b.x)], 1u);
    return b;
}
__device__ __forceinline__ void xcd_barrier_complete(unsigned* bar, unsigned x, unsigned& nloc, unsigned& nx) {
    const unsigned G = gridDim.x * gridDim.y * gridDim.z;
    unsigned sum, cnt, mine, sp = 0u;
    for (;;) {
        sum = 0u; cnt = 0u; mine = 0u;
#pragma unroll
        for (unsigned j = 0; j < 16; ++j) { const unsigned c = xb_ld(&bar[XB_XCNT(j)]); sum += c; cnt += (c > 0u) ? 1u : 0u; mine = (j == x) ? c : mine; }
        if (sum == G) break;
        __builtin_amdgcn_s_sleep(1);
        if ((++sp & 255u) == 0u) { if (xb_ld(&bar[XB_TMO])) break; if (sp > XB_SPIN_CAP) { atomicAdd(&bar[XB_TMO], 1u); break; } }
    }
    nloc = mine > 0u ? mine : 1u; nx = cnt > 0u ? cnt : 1u;
}

__device__ __forceinline__ void xcd_barrier(const XcdBarrier& b) {
    asm volatile("s_waitcnt vmcnt(0)" ::: "memory");
    __syncthreads();
    if (threadIdx.x == 0) {
        unsigned* bar = b.bar;
        __builtin_amdgcn_s_waitcnt(0);
        unsigned nloc = b.st[0], nx = b.st[1];
        if (nloc == 0u) { xcd_barrier_complete(bar, b.x, nloc, nx); b.st[0] = nloc; b.st[1] = nx; }
        const unsigned old = xb_add(&bar[XB_XSUB(b.x)], 1u);
        const unsigned gen = old / nloc;
        if (old + 1u == (gen + 1u) * nloc) {
            __builtin_amdgcn_fence(__ATOMIC_RELEASE, "agent");
            asm volatile("s_waitcnt vmcnt(0)" ::: "memory");
            const unsigned og = xb_add(&bar[XB_TOP], 1u);
            const unsigned tg = og / nx;
            if (og + 1u == (tg + 1u) * nx) xb_add(&bar[XB_TOPGEN], 1u);
            else XB_SPIN(xb_ld(&bar[XB_TOPGEN]) == tg, bar);
            __builtin_amdgcn_fence(__ATOMIC_ACQUIRE, "agent");
            xb_add(&bar[XB_XGEN(b.x)], 1u);
            asm volatile("s_waitcnt vmcnt(0)" ::: "memory");
        } else {
            XB_SPIN(xb_ld(&bar[XB_XGEN(b.x)]) == gen, bar);
            __builtin_amdgcn_fence(__ATOMIC_ACQUIRE, "agent");
            asm volatile("s_waitcnt vmcnt(0)" ::: "memory");
        }
    }
    __syncthreads();
}

namespace pg8 {
#define PG8_LAS __attribute__((address_space(3)))
typedef unsigned short bf16_t;
typedef short bf16x8 __attribute__((ext_vector_type(8)));
typedef float f32x4 __attribute__((ext_vector_type(4)));
typedef unsigned u32x4 __attribute__((ext_vector_type(4)));
constexpr int BM = 256, BK = 64, HALF = 128, HTB = HALF * BK * 2  , STAGE_BYTES = 8 * HTB, NXCD = 8, WGM = 8;

__host__ __device__ __forceinline__ int lds_byte(int r, int c) { const int st = (r >> 4) * 2 + (c >> 5), rr = r & 15, cc = c & 31, ob = rr * 64 + cc * 2; return st * 1024 + (ob ^ (((ob >> 9) & 1) << 5)); }
__host__ __device__ __forceinline__ void stage_rc(int b, int& R, int& C) { const int st = b / 1024, sb = b % 1024, swz = sb ^ (((sb >> 9) & 1) << 5); R = (st >> 1) * 16 + swz / 64; C = (st & 1) * 32 + (swz % 64) / 2; }
__host__ __device__ __forceinline__ int perm32(int rho) { const int n = rho >> 4, i = rho & 15; return 8 * (i >> 2) + 4 * n + (i & 3); }

struct Unit { int pm, pn, e; };
struct Gemm { const bf16_t* A; const bf16_t* Bt; int M, N, K; size_t estride; };

struct StaticOrder {
    static constexpr bool GATHER = false;
    int nM, nN, nwg, G, c;
    __host__ __device__ void init(int M, int N, int G_, int c_) { nM = M / BM; nN = N / BM; nwg = nM * nN; G = G_; c = c_; }
    __host__ __device__ bool next(int i, Unit& u) const {
        const long L = (long)i * G + c; if (L >= nwg) return false;
        int wgid = (int)L; { const int q = nwg / NXCD, r = nwg % NXCD, xcd = wgid % NXCD, off = wgid / NXCD; wgid = (xcd < r ? xcd * (q + 1) : r * (q + 1) + (xcd - r) * q) + off; }
        const int nig = WGM * nN, gid = wgid / nig, fm = gid * WGM, gsz = (nM - fm) < WGM ? (nM - fm) : WGM;
        u.pm = fm + ((wgid % nig) % gsz); u.pn = (wgid % nig) / gsz; u.e = 0; return true;
    }
    __device__ __forceinline__ void a_ready(const Unit&) const {}
    __device__ __forceinline__ void done(const Unit&) const {}
};
__device__ __forceinline__ unsigned cvt_pk_bf16(float lo, float hi) { unsigned r; asm volatile("v_cvt_pk_bf16_f32 %0, %1, %2" : "=v"(r) : "v"(lo), "v"(hi)); return r; }
typedef float f32x2 __attribute__((ext_vector_type(2)));
__device__ __forceinline__ f32x2 gelu_pk(f32x2 v) {
    const f32x2 av = __builtin_elementwise_abs(v), d = av * 0.2316418882f + 1.0f;
    f32x2 t; t.x = __builtin_amdgcn_rcpf(d.x); t.y = __builtin_amdgcn_rcpf(d.y);
    f32x2 q = t * 0.5307027145f + (-0.7265760135f); q = q * t + 0.7107068705f; q = q * t + (-0.142248368f); q = q * t + 0.127414796f; q = q * t;
    const f32x2 s = (v * v) * (-0.72134752044f);
    f32x2 e; e.x = __builtin_amdgcn_exp2f(s.x); e.y = __builtin_amdgcn_exp2f(s.y);
    const f32x2 m = v * (q * e), r = v - m;
    f32x2 o; o.x = v.x < 0.f ? m.x : r.x; o.y = v.y < 0.f ? m.y : r.y; return o;
}

struct EpiF32 {
    static constexpr bool PERM = false, AFTER_DRAIN = false;
    float* C; int ldc; const float* bias;
    __device__ __forceinline__ void operator()(const f32x4 (&acc)[2][2][4][2], const Unit& u, int wr, int wc, int fr, int fq) const {
        const int row0 = u.pm * BM + wr * 64 + fr, col0 = u.pn * BM + wc * 32 + 4 * fq;
        f32x4 bv[2][2];
#pragma unroll
        for (int bj = 0; bj < 2; ++bj)
#pragma unroll
            for (int n = 0; n < 2; ++n) bv[bj][n] = bias ? *(const f32x4*)(bias + col0 + bj * HALF + n * 16) : (f32x4){0.f, 0.f, 0.f, 0.f};
#pragma unroll
        for (int ai = 0; ai < 2; ++ai)
#pragma unroll
            for (int m = 0; m < 4; ++m) { float* rowp = C + (size_t)(row0 + ai * HALF + m * 16) * ldc + col0;
#pragma unroll
                for (int bj = 0; bj < 2; ++bj)
#pragma unroll
                    for (int n = 0; n < 2; ++n) *(f32x4*)(rowp + bj * HALF + n * 16) = acc[ai][bj][m][n] + bv[bj][n]; }
    }
};
template <int ACT  > struct EpiBf16 {
    static constexpr bool PERM = true, AFTER_DRAIN = false;
    bf16_t* O; int ldc; const float* bias; int split_cols; size_t split_stride;
    __device__ __forceinline__ void operator()(const f32x4 (&acc)[2][2][4][2], const Unit& u, int wr, int wc, int fr, int fq) const {
        const int row0 = u.pm * BM + wr * 64 + fr; int colt = u.pn * BM; bf16_t* base = O;
        if (split_cols) { const int t = colt / split_cols; base += (size_t)t * split_stride; colt -= t * split_cols; }
        const int col0 = colt + wc * 32 + 8 * fq, bcol0 = u.pn * BM + wc * 32 + 8 * fq;
        f32x4 bv[2][2];
#pragma unroll
        for (int bj = 0; bj < 2; ++bj)
#pragma unroll
            for (int n = 0; n < 2; ++n) bv[bj][n] = bias ? *(const f32x4*)(bias + bcol0 + bj * HALF + 4 * n) : (f32x4){0.f, 0.f, 0.f, 0.f};
#pragma unroll
        for (int ai = 0; ai < 2; ++ai)
#pragma unroll
            for (int m = 0; m < 4; ++m) { bf16_t* rowp = base + (size_t)(row0 + ai * HALF + m * 16) * ldc + col0;
#pragma unroll
                for (int bj = 0; bj < 2; ++bj) { f32x4 v0 = acc[ai][bj][m][0] + bv[bj][0], v1 = acc[ai][bj][m][1] + bv[bj][1];
                    if (ACT == 1) { f32x2 a = gelu_pk((f32x2){v0[0], v0[1]}), b = gelu_pk((f32x2){v0[2], v0[3]}), c = gelu_pk((f32x2){v1[0], v1[1]}), d = gelu_pk((f32x2){v1[2], v1[3]});
                        v0 = (f32x4){a.x, a.y, b.x, b.y}; v1 = (f32x4){c.x, c.y, d.x, d.y}; }
                    if (ACT == 2) {
#pragma unroll
                        for (int j = 0; j < 4; ++j) { v0[j] = 0.5f * v0[j] * (1.0f + erff(v0[j] * 0.70710678f)); v1[j] = 0.5f * v1[j] * (1.0f + erff(v1[j] * 0.70710678f)); } }
                    u32x4 w; w.x = cvt_pk_bf16(v0[0], v0[1]); w.y = cvt_pk_bf16(v0[2], v0[3]); w.z = cvt_pk_bf16(v1[0], v1[1]); w.w = cvt_pk_bf16(v1[2], v1[3]);
                    *(u32x4*)(rowp + bj * HALF) = w; } }
    }
};

template <class Epi, class Sched, bool STAMP = false>
__device__ __forceinline__ void gemm_phase(PG8_LAS unsigned char* lds, const Gemm g, const Sched& S, const Epi& E, unsigned long long* stamps) {
    int tid_ = threadIdx.x; asm volatile("" : "+v"(tid_));
    const int tid = tid_, wid = __builtin_amdgcn_readfirstlane(tid >> 6), lane = tid & 63, wr = wid >> 2, wc = wid & 3, fr = lane & 15, fq = lane >> 4;
    const int K = g.K, nt = K / BK;
    constexpr bool GATHER = Sched::GATHER;
    int ts_lo = 0, ts_hi = 0, nts = 0; const unsigned long long rt_entry = STAMP ? (unsigned long long)wall_clock64() : 0ull;
#define PG8_STAMP() do { if (STAMP && wid == 0 && nts < 64) { const unsigned long long _c = (unsigned long long)clock64(); \
        ts_lo = (lane == nts) ? (int)(unsigned)_c : ts_lo; ts_hi = (lane == nts) ? (int)(unsigned)(_c >> 32) : ts_hi; ++nts; } } while (0)
    PG8_STAMP();
    unsigned voffA[2], voffB[2]; int rowA[2];
#pragma unroll
    for (int i = 0; i < 2; ++i) { int R, C; stage_rc(tid * 16 + i * 8192, R, C); const int Rb = Epi::PERM ? ((R & ~31) + perm32(R & 31)) : R;
        rowA[i] = R; voffA[i] = GATHER ? (unsigned)C * 2u : (unsigned)(R * K + C) * 2u; voffB[i] = (unsigned)(Rb * K + C) * 2u; }
    const size_t kstep = (size_t)(BK * 2);
    const size_t hstep = (size_t)HALF * K * 2;
    const size_t tstep = 2 * hstep;
    const unsigned ldsw = (unsigned)wid * 1024u;
    const int aoff = lds_byte(wr * 64 + fr, fq * 8), boff = lds_byte(wc * 32 + fr, fq * 8);
#define PG8_SA(b, h) (((b) * 2 + (h)) * HTB)
#define PG8_SB(b, h) ((4 + (b) * 2 + (h)) * HTB)
#define PG8_STAGE(bufoff, gbase, voff) do { _Pragma("unroll") for (int _i = 0; _i < 2; ++_i) \
        __builtin_amdgcn_global_load_lds((const unsigned*)((const char*)(gbase) + (voff)[_i]), (PG8_LAS unsigned*)(lds + (bufoff) + ldsw + _i * 8192), 16, 0, 0); } while (0)
#define PG8_STAGE_A(bufoff, gbase, h, gv) do { if constexpr (GATHER) { PG8_STAGE(bufoff, gbase, (gv)[h]); } else { PG8_STAGE(bufoff, (gbase) + (h) * hstep, voffA); } } while (0)
#define PG8_TOKSLOT(s) ((PG8_LAS int*)(lds + STAGE_BYTES + 1024 + ((s) & 1) * 1024))
#define PG8_LDA(dst, b, h) do { _Pragma("unroll") for (int m = 0; m < 4; ++m) _Pragma("unroll") for (int k = 0; k < 2; ++k) dst[m][k] = *(const PG8_LAS bf16x8*)(lds + PG8_SA(b, h) + aoff + m * 2048 + k * 1024); } while (0)
#define PG8_LDB(dst, b, h) do { _Pragma("unroll") for (int n = 0; n < 2; ++n) _Pragma("unroll") for (int k = 0; k < 2; ++k) dst[n][k] = *(const PG8_LAS bf16x8*)(lds + PG8_SB(b, h) + boff + n * 2048 + k * 1024); } while (0)
#define PG8_MMA(ai, bj, At, Bt) do { __builtin_amdgcn_s_setprio(1); _Pragma("unroll") for (int m = 0; m < 4; ++m) _Pragma("unroll") for (int n = 0; n < 2; ++n) _Pragma("unroll") for (int k = 0; k < 2; ++k) \
        acc[ai][bj][m][n] = __builtin_amdgcn_mfma_f32_16x16x32_bf16(Bt[n][k], At[m][k], acc[ai][bj][m][n], 0, 0, 0); __builtin_amdgcn_s_setprio(0); } while (0)
#define PG8_WAIT_V(n) asm volatile("s_waitcnt vmcnt(" #n ")" ::: "memory")
#define PG8_WAIT_L(n) asm volatile("s_waitcnt lgkmcnt(" #n ")" ::: "memory")
#define PG8_BAR __builtin_amdgcn_s_barrier()
#define PG8_SCHED __builtin_amdgcn_sched_barrier(0)
    Unit cur, nxt; int ui = 0;
    if (!S.next(0, cur)) return;
    f32x4 acc[2][2][4][2];
#pragma unroll
    for (int a = 0; a < 2; ++a)
#pragma unroll
        for (int b = 0; b < 2; ++b)
#pragma unroll
            for (int m = 0; m < 4; ++m)
#pragma unroll
                for (int n = 0; n < 2; ++n) acc[a][b][m][n] = (f32x4){0.f, 0.f, 0.f, 0.f};
    bf16x8 At[4][2], B0[2][2], B1[2][2];
    const char* cA = (const char*)g.A + (GATHER ? (size_t)0 : (size_t)cur.pm * tstep); const char* cB = (const char*)g.Bt + (size_t)cur.pn * tstep + (size_t)cur.e * g.estride * 2;
    S.a_ready(cur);
    unsigned gcur[2][2], gnxt[2][2], gs[2][2];
    if constexpr (GATHER) {
        if (tid < 256) PG8_TOKSLOT(0)[tid] = S.tok[cur.pm * 256 + tid];
        __syncthreads();
#pragma unroll
        for (int h = 0; h < 2; ++h)
#pragma unroll
            for (int i = 0; i < 2; ++i) { gcur[h][i] = (unsigned)PG8_TOKSLOT(0)[h * HALF + rowA[i]] * (unsigned)(K * 2) + voffA[i]; gnxt[h][i] = gcur[h][i]; gs[h][i] = gcur[h][i]; }
    }
    PG8_STAGE(PG8_SB(0, 0), cB, voffB); PG8_STAGE_A(PG8_SA(0, 0), cA, 0, gcur); PG8_STAGE(PG8_SB(0, 1), cB + hstep, voffB); PG8_STAGE_A(PG8_SA(0, 1), cA, 1, gcur);
    if (wr == 1) PG8_BAR;
    PG8_WAIT_V(4); PG8_BAR;
    PG8_STAGE(PG8_SB(1, 0), cB + kstep, voffB); PG8_STAGE_A(PG8_SA(1, 0), cA + kstep, 0, gcur); PG8_STAGE(PG8_SB(1, 1), cB + hstep + kstep, voffB);
    PG8_WAIT_V(6); PG8_BAR;
    PG8_STAMP();
    for (;;) {
        const bool has_next = S.next(ui + 1, nxt);
        if constexpr (GATHER) { if (has_next && wid < 4)
            __builtin_amdgcn_global_load_lds((const unsigned*)(S.tok + nxt.pm * 256 + wid * 64 + lane), (PG8_LAS unsigned*)((PG8_LAS unsigned char*)PG8_TOKSLOT(ui + 1) + wid * 256), 4, 0, 0); }
        const char* nA = GATHER ? (const char*)g.A : has_next ? (const char*)g.A + (size_t)nxt.pm * tstep : cA; const char* nB = has_next ? (const char*)g.Bt + (size_t)nxt.pn * tstep + (size_t)nxt.e * g.estride * 2 : cB;
        for (int t = 0; t < nt; t += 2) {
            const bool last = (t == nt - 2);
            const char* a1 = cA + (size_t)(t + 1) * kstep;
            const char* a2 = last ? nA : cA + (size_t)(t + 2) * kstep; const char* b2 = last ? nB : cB + (size_t)(t + 2) * kstep;
            const char* a3 = a2 + kstep; const char* b3 = b2 + kstep;
            if (last && has_next) S.a_ready(nxt);
            if constexpr (GATHER) {
                if (last && has_next) {
#pragma unroll
                    for (int h = 0; h < 2; ++h)
#pragma unroll
                        for (int i = 0; i < 2; ++i) gnxt[h][i] = (unsigned)PG8_TOKSLOT(ui + 1)[h * HALF + rowA[i]] * (unsigned)(K * 2) + voffA[i];
                }
#pragma unroll
                for (int h = 0; h < 2; ++h)
#pragma unroll
                    for (int i = 0; i < 2; ++i) gs[h][i] = last ? gnxt[h][i] : gcur[h][i];
            }
            PG8_LDB(B0, 0, 0); PG8_SCHED; PG8_LDA(At, 0, 0); PG8_STAGE_A(PG8_SA(1, 1), a1, 1, gcur);
            PG8_WAIT_L(8); PG8_BAR; PG8_WAIT_L(0); PG8_MMA(0, 0, At, B0); PG8_BAR; PG8_SCHED;
            PG8_LDB(B1, 0, 1); PG8_STAGE(PG8_SB(0, 0), b2, voffB);
            PG8_BAR; PG8_WAIT_L(0); PG8_MMA(0, 1, At, B1); PG8_BAR;
            PG8_LDA(At, 0, 1); PG8_STAGE_A(PG8_SA(0, 0), a2, 0, gs);
            PG8_BAR; PG8_WAIT_L(0); PG8_MMA(1, 0, At, B0); PG8_BAR; PG8_SCHED;
            PG8_STAGE(PG8_SB(0, 1), b2 + hstep, voffB);
            PG8_WAIT_V(6); PG8_BAR; PG8_MMA(1, 1, At, B1); PG8_BAR;
            PG8_LDB(B0, 1, 0); PG8_SCHED; PG8_LDA(At, 1, 0); PG8_STAGE_A(PG8_SA(0, 1), a2, 1, gs);
            PG8_WAIT_L(8); PG8_BAR; PG8_WAIT_L(0); PG8_MMA(0, 0, At, B0); PG8_BAR; PG8_SCHED;
            PG8_LDB(B1, 1, 1); PG8_STAGE(PG8_SB(1, 0), b3, voffB);
            PG8_BAR; PG8_WAIT_L(0); PG8_MMA(0, 1, At, B1); PG8_BAR;
            PG8_LDA(At, 1, 1); PG8_STAGE_A(PG8_SA(1, 0), a3, 0, gs);
            PG8_BAR; PG8_WAIT_L(0); PG8_MMA(1, 0, At, B0); PG8_BAR; PG8_SCHED;
            PG8_STAGE(PG8_SB(1, 1), b3 + hstep, voffB);
            PG8_WAIT_V(6); PG8_BAR; PG8_MMA(1, 1, At, B1); PG8_BAR;
        }
        PG8_STAMP();
        if constexpr (!Epi::AFTER_DRAIN) { E(acc, cur, wr, wc, fr, fq); S.done(cur); }
        PG8_STAMP();
        if (!has_next) break;
#pragma unroll
        for (int a = 0; a < 2; ++a)
#pragma unroll
            for (int b = 0; b < 2; ++b)
#pragma unroll
                for (int m = 0; m < 4; ++m)
#pragma unroll
                    for (int n = 0; n < 2; ++n) acc[a][b][m][n] = (f32x4){0.f, 0.f, 0.f, 0.f};
        cur = nxt; cA = nA; cB = nB; ++ui;
        if constexpr (GATHER) {
#pragma unroll
            for (int h = 0; h < 2; ++h)
#pragma unroll
                for (int i = 0; i < 2; ++i) gcur[h][i] = gnxt[h][i];
        }
    }
    PG8_WAIT_V(0);
    if (wr == 0) PG8_BAR;
    PG8_BAR;
    if constexpr (Epi::AFTER_DRAIN) { E.fused(acc, cur, wr, wc, fr, fq, lds, wid, lane); S.done(cur); }
    PG8_STAMP();
    if (STAMP && wid == 0) { stamps[lane] = lane < nts ? (((unsigned long long)(unsigned)ts_hi << 32) | (unsigned)ts_lo) : 0ull;
        if (lane == 62) stamps[62] = rt_entry; if (lane == 63) stamps[63] = (unsigned long long)wall_clock64(); }
#undef PG8_STAMP
#undef PG8_SA
#undef PG8_SB
#undef PG8_STAGE
#undef PG8_STAGE_A
#undef PG8_TOKSLOT
#undef PG8_LDA
#undef PG8_LDB
#undef PG8_MMA
#undef PG8_WAIT_V
#undef PG8_WAIT_L
#undef PG8_BAR
#undef PG8_SCHED
}
}
namespace pg8 {
struct EpiRes {
    static constexpr bool PERM = false, AFTER_DRAIN = false;
    const float* base_lat; const float* base_ctx; float* out_lat; float* out_ctx; const float* gvec;
    __device__ __forceinline__ void operator()(const f32x4 (&acc)[2][2][4][2], const Unit& u, int wr, int wc, int fr, int fq) const {
        const bool isctx = u.pm >= 128;
        const int prow = (isctx ? (u.pm - 128) : u.pm) * BM;
        const float* base = isctx ? base_ctx : base_lat; float* out = isctx ? out_ctx : out_lat;
        const float* gv = gvec + (size_t)(isctx ? 8 : (u.pm >> 4)) * 6144;
        const int row0 = prow + wr * 64 + fr, col0 = u.pn * BM + wc * 32 + 4 * fq;
        f32x4 gvv[2][2];
#pragma unroll
        for (int bj = 0; bj < 2; ++bj)
#pragma unroll
            for (int n = 0; n < 2; ++n) gvv[bj][n] = *(const f32x4*)(gv + col0 + bj * HALF + n * 16);
#pragma unroll
        for (int ai = 0; ai < 2; ++ai)
#pragma unroll
            for (int m = 0; m < 4; ++m) { const size_t off = (size_t)(row0 + ai * HALF + m * 16) * 1024 + col0;
#pragma unroll
                for (int bj = 0; bj < 2; ++bj)
#pragma unroll
                    for (int n = 0; n < 2; ++n) { const f32x4 b = *(const f32x4*)(base + off + bj * HALF + n * 16);
                        *(f32x4*)(out + off + bj * HALF + n * 16) = b + gvv[bj][n] * acc[ai][bj][m][n]; } }
    }
};
struct EpiSwiglu {
    static constexpr bool PERM = true, AFTER_DRAIN = false;
    bf16_t* O; int ldc;
    __device__ __forceinline__ void operator()(const f32x4 (&acc)[2][2][4][2], const Unit& u, int wr, int wc, int fr, int fq) const {
        const int row0 = u.pm * BM + wr * 64 + fr, col0 = u.pn * HALF + wc * 32 + 8 * fq;
#pragma unroll
        for (int ai = 0; ai < 2; ++ai)
#pragma unroll
            for (int m = 0; m < 4; ++m) { bf16_t* rowp = O + (size_t)(row0 + ai * HALF + m * 16) * ldc + col0;
                float h[8];
#pragma unroll
                for (int n = 0; n < 2; ++n)
#pragma unroll
                    for (int j = 0; j < 4; ++j) { const float g = acc[ai][0][m][n][j], up = acc[ai][1][m][n][j]; h[n * 4 + j] = g * __builtin_amdgcn_rcpf(1.0f + __expf(-g)) * up; }
                u32x4 w; w.x = cvt_pk_bf16(h[0], h[1]); w.y = cvt_pk_bf16(h[2], h[3]); w.z = cvt_pk_bf16(h[4], h[5]); w.w = cvt_pk_bf16(h[6], h[7]);
                *(u32x4*)rowp = w; }
    }
};
struct MoeOrder {
    static constexpr bool GATHER = false;
    int nN, G, c, nunits; const int* tab;
    __device__ void init(const int* tab_, int nN_, int G_, int c_) { tab = tab_; nN = nN_; G = G_; c = c_; nunits = tab_[0] * nN_; }
    __device__ bool next(int i, Unit& u) const {
        const int L = i * G + c; if (L >= nunits) return false;
        const int q = nunits / NXCD, r = nunits % NXCD, xcd = L % NXCD, off = L / NXCD;
        const int w = (xcd < r ? xcd * (q + 1) : r * (q + 1) + (xcd - r) * q) + off;
        u.pm = w / nN; u.pn = w - u.pm * nN; u.e = tab[1 + u.pm]; return true;
    }
    __device__ __forceinline__ void a_ready(const Unit&) const {}
    __device__ __forceinline__ void done(const Unit&) const {}
};
struct MoeOrderG : MoeOrder { static constexpr bool GATHER = true; const int* tok; };
}
enum { I_X = 0, I_C, I_CTX, I_CCTX, I_MODW, I_MODB, I_NMIXG, I_NFFNG, I_WIN, I_WOUT, I_LCW, I_LCB, I_LWA, I_LBA, I_LWX, I_LBX, I_LLAM,
       I_RMU, I_RWUP, I_RW0, I_RAUP, I_RA0, I_RGUP, I_RKK, I_RKA, I_RRK, I_RLNG, I_RLNB, I_MIB, I_MFB, I_MNG, I_GCW, I_GALOG, I_GDTB, I_GNG,
       I_FWG, I_FWU, I_FWD, I_MROUTER, I_MWG, I_MWU, I_MWD, I_FNG, N_IN };
struct Args { const float* in[N_IN]; float* out; unsigned char* ws; int ph_lo, ph_hi; };
struct Ctx {
    const float* const* in; float* out; unsigned char* ws; LAS unsigned char* lds;
    int tid, lane, wave, G, wg;
};
#define WSP(T, off) ((T*)(C.ws + (off)))

__device__ __forceinline__ int seqrow_raster(int i, int d, int b) {
    if (i < CTXL) { const int p = d ? (CTXL - 1 - i) : i; return T_LAT + b * CTXL + p; }
    const int j = i - CTXL; const int p = d ? (SEQ - 1 - j) : j; return b * SEQ + p;
}
__device__ __forceinline__ int seqrow_cm(int i, int d, int b) {
    if (i < CTXL) { const int p = d ? (CTXL - 1 - i) : i; return T_LAT + b * CTXL + p; }
    const int j = i - CTXL; const int p = d ? (SEQ - 1 - j) : j; return b * SEQ + (p & 63) * 64 + (p >> 6);
}

__device__ __forceinline__ void phase_pre(const Ctx& C) {
    LAS float* sc = (LAS float*)C.lds;
    LAS float* red = sc + 9 * 1024;
    float* modv = WSP(float, WS_MODV);
    bool filled = false;
    for (int it = C.wg; it < DEPTH * 48; it += C.G) {
        if (!filled) {
            for (int i = C.tid; i < 9 * 1024; i += NTHR) { const float v = i < 8192 ? C.in[I_C][i] : C.in[I_CCTX][i - 8192]; sc[i] = siluf_(v); }
            filled = true; __syncthreads();
        }
        const int l = it / 48, jb = it % 48, col = C.tid & 127, kg = C.tid >> 7;
        const float* W = C.in[I_MODW] + (size_t)l * 1024 * 6144 + jb * 128 + col;
        float acc[9];
#pragma unroll
        for (int r = 0; r < 9; ++r) acc[r] = 0.f;
        for (int k = kg * 256; k < kg * 256 + 256; ++k) { const float w = W[(size_t)k * 6144];
#pragma unroll
            for (int r = 0; r < 9; ++r) acc[r] += sc[r * 1024 + k] * w; }
#pragma unroll
        for (int r = 0; r < 9; ++r) red[(kg * 9 + r) * 128 + col] = acc[r];
        __syncthreads();
        for (int i = C.tid; i < 9 * 128; i += NTHR) { const int r = i >> 7, cc = i & 127;
            const float s = red[(0 * 9 + r) * 128 + cc] + red[(1 * 9 + r) * 128 + cc] + red[(2 * 9 + r) * 128 + cc] + red[(3 * 9 + r) * 128 + cc];
            modv[((size_t)l * 9 + r) * 6144 + jb * 128 + cc] = s + C.in[I_MODB][l * 6144 + jb * 128 + cc]; }
        __syncthreads();
    }
}

__device__ __forceinline__ void tr_item(const float* src, size_t ld, int k0, int ns0, bf16* dst, int drow0, int Kd, LAS float* scr, int lane, bool zero) {
    if (!zero) {
#pragma unroll 8
        for (int i = 0; i < 32; ++i) { const int kk = 2 * i + (lane >> 5); scr[kk * 33 + (lane & 31)] = src[(size_t)(k0 + kk) * ld + ns0 + (lane & 31)]; }
    }
    LDS_WAIT(); asm volatile("" ::: "memory");
    const int c = lane & 7;
#pragma unroll
    for (int j = 0; j < 4; ++j) { const int n = (lane >> 3) + 8 * j; const LAS float* s = scr + (8 * c) * 33 + n;
        v4u o; o.x = pk2(s[0 * 33], s[1 * 33]); o.y = pk2(s[2 * 33], s[3 * 33]); o.z = pk2(s[4 * 33], s[5 * 33]); o.w = pk2(s[6 * 33], s[7 * 33]);
        if (zero) o = (v4u){0u, 0u, 0u, 0u};
        *(v4u*)(dst + (size_t)(drow0 + n) * Kd + k0 + 8 * c) = o; }
    LDS_WAIT(); asm volatile("" ::: "memory");
}
__device__ __forceinline__ void convert_small(const Ctx& C, int l) {
    {
        bf16* lw = WSP(bf16, WS_LRUWT);
        for (int k = 0; k < 2 * 2 * 4 * 4096 / (128 * NTHR); ++k) {
            const int e = k * 128 * NTHR + C.wg * NTHR + C.tid;
            if (C.wg < 128) {
            const int i = e & 63, j = (e >> 6) & 63, hd = (e >> 12) & 3, g = (e >> 14) & 1, d = e >> 15;
            const float* src = (g ? C.in[I_LWX] : C.in[I_LWA]) + ((size_t)((l * 2 + d) * 4 + hd) * 64 + i) * 64 + j;
            lw[e] = (bf16)f2bf(*src);
            }
        }
    }
    if (C.wg >= 128 && C.wg < 224) {
        bf16* rw = WSP(bf16, WS_RWT);
        const int e = (C.wg - 128) * NTHR + C.tid;
        if (e < 32768) { const int r = e & 31, ch = (e >> 5) & 255, d = (e >> 13) & 1, isa = e >> 14;
            rw[e] = (bf16)f2bf((isa ? C.in[I_RAUP] : C.in[I_RWUP])[((size_t)(l * 2 + d) * 32 + r) * GW + ch]); }
        else { const int e2 = e - 32768, j = e2 & 63, ch = e2 >> 6; rw[e] = (bf16)f2bf(C.in[I_RGUP][((size_t)l * 64 + j) * GW + ch]); }
    }
}
__device__ __forceinline__ void convert_items(const Ctx& C, int l, int what, int gw, int NGW) {
    LAS float* scr = (LAS float*)(C.lds + C.wave * 8704);
    constexpr int I_IN = 16 * 112, I_OUT = 16 * 32, I_GU = 16 * 176, I_DN = 44 * 32, I_E = 16 * 88 + 22 * 32;
    const bool moe = l & 1; const int li = l >> 1;
    const int lo_it = (what & 1) ? 0 : I_IN, hi_it = (what & 2) ? I_IN + I_OUT + (moe ? NE * I_E : (I_GU + I_DN)) : I_IN;
    bf16* win = WSP(bf16, WS_WIN); bf16* wout = WSP(bf16, WS_WOUT); bf16* wgu = WSP(bf16, WS_WGU); bf16* wdn = WSP(bf16, WS_WDN);
    for (int it = lo_it + gw; it < hi_it; it += NGW) {
        int r = it;
        if (r < I_IN) { const int kb = r / 112, nb = r % 112; tr_item(C.in[I_WIN] + (size_t)l * 1024 * IN_COLS, IN_COLS, 64 * kb, 32 * nb, win, 32 * nb, 1024, scr, C.lane, nb == 111); continue; }
        r -= I_IN;
        if (r < I_OUT) { const int kb = r / 32, nb = r % 32; tr_item(C.in[I_WOUT] + (size_t)l * 1024 * 1024, 1024, 64 * kb, 32 * nb, wout, 32 * nb, 1024, scr, C.lane, false); continue; }
        r -= I_OUT;
        if (!moe) {
            if (r < I_GU) { const int kb = r / 176, nb = r % 176, tile = nb >> 3, q = nb & 7;
                const float* src = (q < 4 ? C.in[I_FWG] : C.in[I_FWU]) + (size_t)li * 1024 * DFF;
                tr_item(src, DFF, 64 * kb, tile * 128 + (q & 3) * 32, wgu, 32 * nb, 1024, scr, C.lane, false); continue; }
            r -= I_GU;
            { const int kb = r / 32, nb = r % 32; tr_item(C.in[I_FWD] + (size_t)li * DFF * 1024, 1024, 64 * kb, 32 * nb, wdn, 32 * nb, DFF, scr, C.lane, false); }
        } else {
            const int e = r / I_E; int rr = r % I_E;
            if (rr < 16 * 88) { const int kb = rr / 88, nb = rr % 88, tile = nb >> 3, q = nb & 7;
                const float* src = (q < 4 ? C.in[I_MWG] : C.in[I_MWU]) + ((size_t)li * NE + e) * 1024 * DFE;
                tr_item(src, DFE, 64 * kb, tile * 128 + (q & 3) * 32, wgu + (size_t)e * 2 * DFE * 1024, 32 * nb, 1024, scr, C.lane, false); continue; }
            rr -= 16 * 88;
            { const int kb = rr / 32, nb = rr % 32; tr_item(C.in[I_MWD] + ((size_t)li * NE + e) * DFE * 1024, 1024, 64 * kb, 32 * nb, wdn + (size_t)e * 1024 * DFE, 32 * nb, DFE, scr, C.lane, false); }
        }
    }
}

template <bool ROUTE>
__device__ __forceinline__ void norm_rows(const Ctx& C, int l, const float* xlat, const float* xctx, const float* gain, int shoff, int scoff, int nrows, int moe_li) {
    const float* modv = WSP(float, WS_MODV) + (size_t)l * 9 * 6144;
    bf16* hb = WSP(bf16, WS_HB);
    const int gw = C.wg * NWAVES + C.wave, NGW = C.G * NWAVES;
    LAS unsigned* lcnt = (LAS unsigned*)(C.lds + 65536);
    unsigned* route = WSP(unsigned, WS_ROUTE);
    if (ROUTE) { if (C.tid < 8) lcnt[C.tid] = 0u; __syncthreads(); }
    f32x4 gv[4];
#pragma unroll
    for (int j = 0; j < 4; ++j) gv[j] = *(const f32x4*)(gain + 4 * C.lane + 256 * j);
    for (int m = gw; m < nrows; m += NGW) {
        const bool isctx = m >= T_LAT;
        const float* xr = isctx ? xctx + (size_t)(m - T_LAT) * 1024 : xlat + (size_t)m * 1024;
        const float* mv = modv + (size_t)(isctx ? 8 : (m >> 12)) * 6144;
        f32x4 v[4]; float s = 0.f;
#pragma unroll
        for (int j = 0; j < 4; ++j) { v[j] = *(const f32x4*)(xr + 4 * C.lane + 256 * j); s += (v[j].x * v[j].x + v[j].y * v[j].y) + (v[j].z * v[j].z + v[j].w * v[j].w); }
        const float rs = rsqrtf_(wave_sum(s) * (1.0f / 1024.0f) + 1e-6f);
#pragma unroll
        for (int j = 0; j < 4; ++j) { const f32x4 sh = *(const f32x4*)(mv + shoff + 4 * C.lane + 256 * j), scl = *(const f32x4*)(mv + scoff + 4 * C.lane + 256 * j);
            v[j] = (v[j] * rs * gv[j]) * (scl + 1.0f) + sh;
            v2u o; o.x = pk2(v[j].x, v[j].y); o.y = pk2(v[j].z, v[j].w);
            *(v2u*)(hb + (size_t)m * 1024 + 4 * C.lane + 256 * j) = o; }
        if (ROUTE) {
            const float* rt = C.in[I_MROUTER] + (size_t)moe_li * 1024 * NE;
            float lg[8];
#pragma unroll
            for (int e = 0; e < 8; ++e) lg[e] = 0.f;
#pragma unroll
            for (int j = 0; j < 4; ++j)
#pragma unroll
                for (int q = 0; q < 4; ++q) { const int k = 4 * C.lane + 256 * j + q; const f32x4 r0 = *(const f32x4*)(rt + (size_t)k * 8), r1 = *(const f32x4*)(rt + (size_t)k * 8 + 4); const float hv = v[j][q];
                    lg[0] += hv * r0.x; lg[1] += hv * r0.y; lg[2] += hv * r0.z; lg[3] += hv * r0.w; lg[4] += hv * r1.x; lg[5] += hv * r1.y; lg[6] += hv * r1.z; lg[7] += hv * r1.w; }
#pragma unroll
            for (int e = 0; e < 8; ++e) lg[e] = wave_sum(lg[e]);
            int e0 = 0; float l0 = lg[0];
#pragma unroll
            for (int e = 1; e < 8; ++e) if (lg[e] > l0) { l0 = lg[e]; e0 = e; }
            int e1 = (e0 == 0) ? 1 : 0; float l1 = -3.0e38f;
#pragma unroll
            for (int e = 0; e < 8; ++e) if (e != e0 && lg[e] > l1) { l1 = lg[e]; e1 = e; }
            const float w0 = __builtin_amdgcn_rcpf(1.0f + __expf(l1 - l0)), w1 = 1.0f - w0;
            if (C.lane == 0) {
                const unsigned r0 = atomicAdd((unsigned*)&lcnt[e0], 1u), r1 = atomicAdd((unsigned*)&lcnt[e1], 1u);
                v4u a; a.x = (unsigned)e0; a.y = (unsigned)e1; a.z = r0; a.w = r1;
                *(v4u*)(route + (size_t)m * 8) = a;
                v2u b; b.x = __builtin_bit_cast(unsigned, w0); b.y = __builtin_bit_cast(unsigned, w1);
                *(v2u*)(route + (size_t)m * 8 + 4) = b;
            }
        }
    }
    if (ROUTE) {
        __syncthreads();
        if (C.tid < 8) { unsigned* gc = WSP(unsigned, WS_CTL) + CW_MOECNT + 64 * moe_li; const unsigned base = atomicAdd(gc + C.tid, lcnt[C.tid]); WSP(unsigned, WS_WGBASE)[C.wg * 8 + C.tid] = base; }
    }
}
__device__ __forceinline__ void lru_carry(const Ctx& C, int idx) {
    const int ch = idx & 255, d = (idx >> 8) & 1, b = idx >> 9;
    const float* ls = WSP(const float, WS_LSUM); float* hin = WSP(float, WS_HIN);
    float H = 0.f;
    for (int k = 0; k < NCH; ++k) {
        const int c = d ? (k < 4 ? 3 - k : NCH + 3 - k) : k;
        const size_t sidx = ((size_t)(b * NCH + c) * 2 + d) * 256 + ch;
        hin[sidx] = H;
        H = __expf(ls[sidx * 2]) * H + ls[sidx * 2 + 1];
    }
}

#define RAW_BARRIER() do { asm volatile("s_waitcnt lgkmcnt(0)" ::: "memory"); __builtin_amdgcn_s_barrier(); asm volatile("" ::: "memory"); } while (0)
__device__ __forceinline__ void gdn_prep(const Ctx& C, int l, int b, int c) {
    const bf16* P = WSP(const bf16, WS_P); bf16* gq = WSP(bf16, WS_GQ);
    const bool isctx = c < 4; const int p0 = isctx ? c * 64 : (c - 4) * 64; const int Lp = isctx ? CTXL : SEQ;
    const int ch = 4 * C.lane;
    auto rowof = [&](int p) -> int { return isctx ? (T_LAT + b * CTXL + p) : (b * SEQ + (p & 63) * 64 + (p >> 6)); };
    f32x4 cw[4][3], x[4][3];
#pragma unroll
    for (int j = 0; j < 4; ++j)
#pragma unroll
        for (int g = 0; g < 3; ++g) cw[j][g] = *(const f32x4*)(C.in[I_GCW] + ((size_t)l * 4 + j) * 768 + g * 256 + ch);
    const int tb = p0 + C.wave * 8;
    auto ldrow = [&](int p, f32x4 (&dst)[3]) {
        if (p >= 0 && p < Lp) { const bf16* pr = P + (size_t)rowof(p) * PLD + OFF_D + ch;
#pragma unroll
            for (int g = 0; g < 3; ++g) dst[g] = ld4bf(pr + g * 256); }
        else {
#pragma unroll
            for (int g = 0; g < 3; ++g) dst[g] = (f32x4){0.f, 0.f, 0.f, 0.f}; }
    };
    ldrow(tb - 2, x[0]); ldrow(tb - 1, x[1]); ldrow(tb, x[2]);
#pragma unroll
    for (int t = 0; t < 8; ++t) {
        ldrow(tb + t + 1, x[3]);
        bf16* orow = gq + (size_t)rowof(tb + t) * 768 + ch;
#pragma unroll
        for (int g = 0; g < 3; ++g) {
            f32x4 v = cw[0][g] * x[0][g] + cw[1][g] * x[1][g] + cw[2][g] * x[2][g] + cw[3][g] * x[3][g];
            v = (f32x4){siluf_(v.x), siluf_(v.y), siluf_(v.z), siluf_(v.w)};
            if (g < 2) { const float ss = row16_sum((v.x * v.x + v.y * v.y) + (v.z * v.z + v.w * v.w)); v = v * (rsqrtf_(ss + 1e-6f) * (g == 0 ? 0.125f : 1.0f)); }
            st4bf(orow + g * 256, v);
        }
#pragma unroll
        for (int g = 0; g < 3; ++g) { x[0][g] = x[1][g]; x[1][g] = x[2][g]; x[2][g] = x[3][g]; }
    }
}
__device__ __forceinline__ void finish_rows(const Ctx& C, int l, int nrows) {
    const bf16* P = WSP(const bf16, WS_P); bf16* yc = WSP(bf16, WS_HB);
    const bf16* ob = WSP(const bf16, WS_OUTB); const bf16* oc = WSP(const bf16, WS_OUTC); const bf16* od = WSP(const bf16, WS_OUTD);
    const bf16* gg = WSP(const bf16, WS_G); const float* bonus = WSP(const float, WS_BONUS);
    const float* mu = C.in[I_RMU] + (size_t)l * 2 * B_COLS;
    const int gw = C.wg * NWAVES + C.wave, NGW = C.G * NWAVES, lane = C.lane, ch = 4 * lane, hh = lane >> 4;
    const f32x4 lng = *(const f32x4*)(C.in[I_RLNG] + l * GW + ch), lnb = *(const f32x4*)(C.in[I_RLNB] + l * GW + ch);
    const f32x4 mng = *(const f32x4*)(C.in[I_MNG] + l * GW + ch), gng = *(const f32x4*)(C.in[I_GNG] + l * GW + ch);
    const f32x4 mu0 = *(const f32x4*)(mu + 512 + ch), mu1 = *(const f32x4*)(mu + B_COLS + 512 + ch);
    const size_t o2 = (size_t)T_ALL * 256;
#pragma unroll 2
    for (int m = gw; m < nrows; m += NGW) {
        const bool isctx = m >= T_LAT; const int Lp = isctx ? CTXL : SEQ; const int p = isctx ? ((m - T_LAT) & (CTXL - 1)) : (m & (SEQ - 1));
        const f32x4 yb = ld4bf(ob + (size_t)m * 256 + ch) + ld4bf(ob + o2 + (size_t)m * 256 + ch);
        const f32x4 ycv = ld4bf(oc + (size_t)m * 256 + ch) + ld4bf(oc + o2 + (size_t)m * 256 + ch);
        const f32x4 yd = ld4bf(od + (size_t)m * 256 + ch) + ld4bf(od + o2 + (size_t)m * 256 + ch);
        const bf16* pr = P + (size_t)m * PLD;
        const f32x4 vs = ld4bf(WSP(const bf16, WS_RKV) + (size_t)m * 768 + 512 + ch);
        const f32x4 og = ld4bf(pr + OFF_C + 768 + ch), gd = ld4bf(pr + OFF_D + 768 + ch), gr = ld4bf(gg + (size_t)m * 256 + ch);
        const float bn = bonus[(size_t)m * 4 + hh];
        *(v2u*)(yc + (size_t)m * 1024 + ch) = *(const v2u*)(pr + 256 + ch);
        {
            const float mean = row16_sum((yb.x + yb.y) + (yb.z + yb.w)) * (1.0f / 64.0f);
            const f32x4 dl = yb - mean;
            const float var = row16_sum((dl.x * dl.x + dl.y * dl.y) + (dl.z * dl.z + dl.w * dl.w)) * (1.0f / 64.0f);
            const f32x4 yn = dl * rsqrtf_(var + 64e-5f) * lng + lnb;
            st4bf(yc + (size_t)m * 1024 + 256 + ch, (yn + vs * bn) * gr);
        }
        {
            const float ms = row16_sum((ycv.x * ycv.x + ycv.y * ycv.y) + (ycv.z * ycv.z + ycv.w * ycv.w)) * (1.0f / 64.0f);
            const f32x4 sg = (f32x4){sigmoidf_(og.x), sigmoidf_(og.y), sigmoidf_(og.z), sigmoidf_(og.w)};
            st4bf(yc + (size_t)m * 1024 + 512 + ch, ycv * rsqrtf_(ms + 1e-6f) * mng * sg);
        }
        {
            const float ms = row16_sum((yd.x * yd.x + yd.y * yd.y) + (yd.z * yd.z + yd.w * yd.w)) * (1.0f / 64.0f);
            const f32x4 sg = (f32x4){siluf_(gd.x), siluf_(gd.y), siluf_(gd.z), siluf_(gd.w)};
            st4bf(yc + (size_t)m * 1024 + 768 + ch, yd * rsqrtf_(ms + 1e-6f) * gng * sg);
        }
    }
}
typedef bf16x8 fragb;
__device__ __forceinline__ f32x4 mfma16(fragb a, fragb b, f32x4 c) { return __builtin_amdgcn_mfma_f32_16x16x32_bf16(a, b, c, 0, 0, 0); }
__device__ __forceinline__ fragb ld_frag16(const LAS bf16* p) { return *(const LAS fragb*)p; }
__device__ __forceinline__ fragb ld_frag8x2(const LAS bf16* p0, const LAS bf16* p1) {
    const v2u a = *(const LAS v2u*)p0, b = *(const LAS v2u*)p1; v4u r; r.x = a.x; r.y = a.y; r.z = b.x; r.w = b.y; return __builtin_bit_cast(fragb, r); }
__device__ __forceinline__ fragb pack_frag(const f32x4& lo, const f32x4& hi) { v4u r; r.x = pk2(lo.x, lo.y); r.y = pk2(lo.z, lo.w); r.z = pk2(hi.x, hi.y); r.w = pk2(hi.z, hi.w); return __builtin_bit_cast(fragb, r); }
__device__ __forceinline__ float wave_incl_sum(float v, int lane) {
    v += dpp_x<0x111, 0xF, true>(0.f, v); v += dpp_x<0x112, 0xF, true>(0.f, v); v += dpp_x<0x114, 0xF, true>(0.f, v); v += dpp_x<0x118, 0xF, true>(0.f, v);
    v += dpp_x<0x142, 0xA, false>(0.f, v); v += dpp_x<0x143, 0xC, false>(0.f, v);
    return v;
}
__device__ __forceinline__ float wave_incl_max(float v, int lane) {
    const float ninf = -3.0e38f;
    v = fmaxf(v, dpp_x<0x111, 0xF, false>(ninf, v)); v = fmaxf(v, dpp_x<0x112, 0xF, false>(ninf, v)); v = fmaxf(v, dpp_x<0x114, 0xF, false>(ninf, v)); v = fmaxf(v, dpp_x<0x118, 0xF, false>(ninf, v));
    v = fmaxf(v, dpp_x<0x142, 0xA, false>(ninf, v)); v = fmaxf(v, dpp_x<0x143, 0xC, false>(ninf, v));
    return v;
}
constexpr int MP = 72;
__device__ __forceinline__ void mlstm_chunked(const Ctx& C, int l, int idx) {
    const int d = idx >> 5, b = (idx >> 2) & 7, h = idx & 3, lane = C.lane, w = C.wave, l15 = lane & 15, q = lane >> 4;
    const int it = w & 3, vtp = w >> 2;
    constexpr int IMG = 64 * MP * 2, BUFB = 4 * IMG + 1024, CTB = 65 * MP * 2 + 16;
    LAS unsigned char* L0 = C.lds;
    const bf16* P = WSP(const bf16, WS_P); bf16* outc = WSP(bf16, WS_OUTC) + (size_t)d * T_ALL * 256;
    const float ib = C.in[I_MIB][(l * 2 + d) * NH + h], fb = C.in[I_MFB][(l * 2 + d) * NH + h];
    const int tt = C.tid >> 3, part = C.tid & 7;
    for (int i = C.tid; i < 2 * CTB / 4; i += NTHR) ((LAS unsigned*)(L0 + 2 * BUFB))[i] = 0u;
    v4u rq, rk, rv; unsigned short rgi, rgf;
    auto gload = [&](int n) {
        const int row = seqrow_cm(n * 64 + tt, d, b);
        const bf16* pp = P + (size_t)row * PLD + OFF_C + h * 64 + 8 * part;
        rq = *(const v4u*)pp; rk = *(const v4u*)(pp + 256); rv = *(const v4u*)(pp + 512);
        const bf16* pg = P + (size_t)seqrow_cm(n * 64 + lane, d, b) * PLD + OFF_C + 1024 + d * 4 + h;
        rgi = pg[0]; rgf = pg[8];
    };
    auto images = [&](int bufi) {
        LAS unsigned char* B0 = L0 + bufi * BUFB;
        LAS bf16* Qs = (LAS bf16*)B0; LAS bf16* Ks = Qs + 64 * MP; LAS bf16* VT = Ks + 64 * MP; LAS bf16* KTw = VT + 64 * MP; LAS float* vec = (LAS float*)(B0 + 4 * IMG);
        const float li = bf2f(rgi) + ib, lf = -softplusf_(-(bf2f(rgf) + fb));
        const float bc = wave_incl_sum(lf, lane), x = li - bc, cm = wave_incl_max(x, lane);
        const float wl = __expf(x - __shfl(cm, 63)) * 0.125f;
        if (w == 0) { vec[lane] = x; vec[64 + lane] = cm; vec[128 + lane] = bc; }
        const float wmine = __shfl(wl, 8 * w + (lane >> 3));
        *(LAS v4u*)(Qs + tt * MP + 8 * part) = rq; *(LAS v4u*)(Ks + tt * MP + 8 * part) = rk;
        const unsigned vv[4] = {rv.x, rv.y, rv.z, rv.w}, kk[4] = {rk.x, rk.y, rk.z, rk.w};
#pragma unroll
        for (int e = 0; e < 4; ++e) {
            VT[(8 * part + 2 * e) * MP + tt] = (bf16)(vv[e] & 0xffffu); VT[(8 * part + 2 * e + 1) * MP + tt] = (bf16)(vv[e] >> 16);
            KTw[(8 * part + 2 * e) * MP + tt] = (bf16)f2bf1(bflo(kk[e]) * wmine); KTw[(8 * part + 2 * e + 1) * MP + tt] = (bf16)f2bf1(bfhi(kk[e]) * wmine);
        }
    };
    f32x4 Cst[2], nst; float m = 0.f;
    Cst[0] = Cst[1] = nst = (f32x4){0.f, 0.f, 0.f, 0.f};
    const fragb ones = __builtin_bit_cast(fragb, (v4u){0x3F803F80u, 0x3F803F80u, 0x3F803F80u, 0x3F803F80u});
    const f32x4 z4 = (f32x4){0.f, 0.f, 0.f, 0.f};
    gload(0); images(0); gload(1);
#pragma unroll 1
    for (int n = 0; n < NCH; ++n) {
        RAW_BARRIER();
        const LAS unsigned char* B0 = L0 + (n & 1) * BUFB;
        const LAS bf16* Qs = (const LAS bf16*)B0; const LAS bf16* Ks = Qs + 64 * MP; const LAS bf16* VT = Ks + 64 * MP; const LAS bf16* KTw = VT + 64 * MP; const LAS float* vec = (const LAS float*)(B0 + 4 * IMG);
        const LAS bf16* CT = (const LAS bf16*)(L0 + 2 * BUFB + (n & 1) * CTB); LAS bf16* CTn = (LAS bf16*)(L0 + 2 * BUFB + ((n + 1) & 1) * CTB);
        fragb Qf[2]; Qf[0] = ld_frag16(Qs + (16 * it + l15) * MP + 8 * q); Qf[1] = ld_frag16(Qs + (16 * it + l15) * MP + 32 + 8 * q);
        const float cmi = vec[64 + 16 * it + l15]; const int icol = 16 * it + l15;
        f32x4 pt[4];
#pragma unroll
        for (int jt = 0; jt < 4; ++jt) {
            pt[jt] = z4;
            if (jt <= it) {
                const fragb k0 = ld_frag16(Ks + (16 * jt + l15) * MP + 8 * q), k1 = ld_frag16(Ks + (16 * jt + l15) * MP + 32 + 8 * q);
                f32x4 st = mfma16(k0, Qf[0], z4); st = mfma16(k1, Qf[1], st);
                const f32x4 xj = *(const LAS f32x4*)(vec + 16 * jt + 4 * q);
#pragma unroll
                for (int r = 0; r < 4; ++r) { const int j = 16 * jt + 4 * q + r; pt[jt][r] = (j <= icol) ? st[r] * __expf(xj[r] - cmi) * 0.125f : 0.f; }
            }
        }
        fragb Pf[2]; Pf[0] = pack_frag(pt[0], pt[1]); Pf[1] = pack_frag(pt[2], pt[3]);
        fragb Vf[2][2];
#pragma unroll
        for (int v2 = 0; v2 < 2; ++v2)
#pragma unroll
            for (int s = 0; s < 2; ++s) { const LAS bf16* vr = VT + (16 * (2 * vtp + v2) + l15) * MP + 32 * s + 4 * q; Vf[v2][s] = ld_frag8x2(vr, vr + 16); }
        f32x4 Aacc[2], R[2], as, dn;
        as = mfma16(Pf[0], ones, z4); if (it >= 2) as = mfma16(Pf[1], ones, as);
        const fragb nf0 = ld_frag16(CT + 64 * MP + 8 * q), nf1 = ld_frag16(CT + 64 * MP + 32 + 8 * q);
        dn = mfma16(Qf[0], nf0, z4); dn = mfma16(Qf[1], nf1, dn);
#pragma unroll
        for (int v2 = 0; v2 < 2; ++v2) {
            Aacc[v2] = mfma16(Pf[0], Vf[v2][0], z4); if (it >= 2) Aacc[v2] = mfma16(Pf[1], Vf[v2][1], Aacc[v2]);
            const LAS bf16* cr = CT + (16 * (2 * vtp + v2) + l15) * MP + 8 * q;
            R[v2] = mfma16(Qf[0], ld_frag16(cr), z4); R[v2] = mfma16(Qf[1], ld_frag16(cr + 32), R[v2]);
        }
        {
            const f32x4 bi = *(const LAS f32x4*)(vec + 128 + 16 * it + 4 * q), cmr = *(const LAS f32x4*)(vec + 64 + 16 * it + 4 * q);
#pragma unroll
            for (int r = 0; r < 4; ++r) {
                const float mi = bi[r] + cmr[r], minter = bi[r] + m, mt = fmaxf(minter, mi), e1 = __expf(mi - mt), e2 = __expf(minter - mt);
                const float den = e1 * as[r] + e2 * dn[r]; const float inv = __builtin_amdgcn_rcpf(fmaxf(fabsf(den), __expf(-mt)));
                const int row = seqrow_cm(n * 64 + 16 * it + 4 * q + r, d, b);
#pragma unroll
                for (int v2 = 0; v2 < 2; ++v2) outc[(size_t)row * 256 + h * 64 + 16 * (2 * vtp + v2) + l15] = (bf16)f2bf1((e1 * Aacc[v2][r] + e2 * R[v2][r]) * inv);
            }
        }
        {
            const LAS bf16* kr = KTw + (16 * it + l15) * MP + 4 * q;
            const fragb kt0 = ld_frag8x2(kr, kr + 16), kt1 = ld_frag8x2(kr + 32, kr + 48);
            const float bL = vec[128 + 63], mloc = bL + vec[64 + 63];
            const float mnew = fmaxf(bL + m, mloc), wp = __expf(bL + m - mnew), wn = __expf(mloc - mnew);
            f32x4 gk = mfma16(kt0, ones, z4); gk = mfma16(kt1, ones, gk);
            nst = nst * wp + gk * wn;
#pragma unroll
            for (int v2 = 0; v2 < 2; ++v2) {
                f32x4 G = mfma16(kt0, Vf[v2][0], z4); G = mfma16(kt1, Vf[v2][1], G);
                Cst[v2] = Cst[v2] * wp + G * wn;
                v2u o; o.x = pk2(Cst[v2].x, Cst[v2].y); o.y = pk2(Cst[v2].z, Cst[v2].w);
                *(LAS v2u*)(CTn + (16 * (2 * vtp + v2) + l15) * MP + 16 * it + 4 * q) = o;
            }
            if (vtp == 0 && l15 == 0) { v2u o; o.x = pk2(nst.x, nst.y); o.y = pk2(nst.z, nst.w); *(LAS v2u*)(CTn + 64 * MP + 16 * it + 4 * q) = o; }
            m = mnew;
        }
        if (n + 1 < NCH) { images((n + 1) & 1); if (n + 2 < NCH) gload(n + 2); }
    }
    __syncthreads();
}
__device__ __forceinline__ int fwd_row_cm(int b, int c, int t) { return c < 4 ? (T_LAT + b * CTXL + c * 64 + t) : (b * SEQ + t * 64 + (c - 4)); }
__device__ __forceinline__ bf16* blob_row(const Ctx& C, int d, int isw, int b, int c, int h, int r) {
    const int row = fwd_row_cm(b, c, r);
    if (d == 1 && isw) return WSP(bf16, WS_OUTD) + ((size_t)T_ALL + row) * 256 + h * 64;
    return WSP(bf16, WS_P) + (size_t)row * PLD + OFF_D + (d * 2 + isw) * 256 + h * 64;
}
constexpr int LP = 68;
__device__ __forceinline__ void blocked_solve(const LAS bf16* Ln, const LAS bf16* TinvP, LAS unsigned char* XTw, f32x4 (&acc)[4][4], int l15, int q) {
    const f32x4 z4 = (f32x4){0.f, 0.f, 0.f, 0.f};
#pragma unroll
    for (int I = 0; I < 4; ++I) {
        const fragb Af = *(const LAS fragb*)(TinvP + (I * 16 + l15) * 32 + 8 * q);
        fragb A0, A1;
        if (I >= 1) A0 = ld_frag16(Ln + (16 * I + l15) * MP + 8 * q);
        if (I == 3) A1 = ld_frag16(Ln + (16 * I + l15) * MP + 32 + 8 * q);
#pragma unroll
        for (int nt = 0; nt < 4; ++nt) {
            const int crow = 16 * nt + l15; LAS unsigned char* xr = XTw + crow * 128;
            f32x4 a = acc[I][nt];
            if (I >= 1) a = mfma16(A0, *(const LAS fragb*)(xr + ((q ^ (crow & 7)) << 4)), a);
            if (I == 3) a = mfma16(A1, *(const LAS fragb*)(xr + (((4 + q) ^ (crow & 7)) << 4)), a);
            v4u bw; bw.x = pk2(a.x, a.y); bw.y = pk2(a.z, a.w); bw.z = 0u; bw.w = 0u;
            const f32x4 x = mfma16(Af, __builtin_bit_cast(fragb, bw), z4);
            acc[I][nt] = x;
            v2u o; o.x = pk2(x.x, x.y); o.y = pk2(x.z, x.w);
            *(LAS v2u*)(xr + (((2 * I + (q >> 1)) ^ (crow & 7)) << 4) + (q & 1) * 8) = o;
        }
    }
}
__device__ __forceinline__ void diag_inverses(const LAS bf16* Ln, LAS bf16* TinvP, int lane) {
    const int blk = lane >> 4, c = lane & 15;
    float x[16];
#pragma unroll
    for (int i = 0; i < 16; ++i) {
        const LAS bf16* lr = Ln + (16 * blk + i) * MP + 16 * blk;
        const v4u r0 = *(const LAS v4u*)lr, r1 = *(const LAS v4u*)(lr + 8);
        const unsigned rw[8] = {r0.x, r0.y, r0.z, r0.w, r1.x, r1.y, r1.z, r1.w};
        float s = (i == c) ? 1.0f : 0.0f;
#pragma unroll
        for (int j = 0; j < i; ++j) s += ((j & 1) ? bfhi(rw[j >> 1]) : bflo(rw[j >> 1])) * x[j];
        x[i] = s;
        TinvP[(blk * 16 + i) * 32 + 8 * (c >> 2) + (c & 3)] = (bf16)f2bf1(s);
    }
}
__device__ __forceinline__ void gdn_solve_item(const Ctx& C, int l, int item) {
    const int lane = C.lane, w = C.wave, pw = w & 1, pi = w >> 1, l15 = lane & 15, q = lane >> 4;
    LAS unsigned char* B0 = C.lds + pi * 31744;
    LAS bf16* Ln = (LAS bf16*)B0;
    LAS bf16* TinvP = (LAS bf16*)(B0 + 9216);
    LAS float* vec = (LAS float*)(B0 + 13312);
    LAS unsigned char* XT = B0 + 13824;
    LAS bf16* Ks = (LAS bf16*)XT;
    const bf16* P = WSP(const bf16, WS_P); const bf16* gq = WSP(const bf16, WS_GQ);
    const int u = item >> 1, d = item & 1;
    const int c = u % NCH, h = (u / NCH) & 3, b = u / (NCH * NH);
    const int n = d ? (c < 4 ? 3 - c : 71 - c) : c;
    const float aexp = __expf(C.in[I_GALOG][(l * 2 + d) * NH + h]), dtb = C.in[I_GDTB][(l * 2 + d) * NH + h];
    const int rowl = seqrow_cm(n * 64 + lane, d, b);
    const bf16* pg = P + (size_t)rowl * PLD + OFF_D + 1024 + d * 4 + h;
    const float la = -aexp * softplusf_(bf2f(pg[0]) + dtb), beta = sigmoidf_(bf2f(pg[8]));
    const float gam = wave_incl_sum(la, lane);
    if (pw == 0) { vec[lane] = beta; vec[64 + lane] = gam; }
#pragma unroll
    for (int r = 0; r < 4; ++r) { const int idx = pw * 64 + lane + 128 * r, t = idx >> 3, part = idx & 7;
        *(LAS v4u*)(Ks + t * MP + 8 * part) = *(const v4u*)(gq + (size_t)seqrow_cm(n * 64 + t, d, b) * 768 + 256 + h * 64 + 8 * part); }
    { LAS v4u* tz = (LAS v4u*)(B0 + 9216) + (pw * 64 + lane) * 2; tz[0] = (v4u){0u, 0u, 0u, 0u}; tz[1] = (v4u){0u, 0u, 0u, 0u}; }
    f32x4 acc[4][4];
    if (pw == 0) {
#pragma unroll
        for (int I = 0; I < 4; ++I)
#pragma unroll
            for (int r = 0; r < 4; ++r) { const bf16* vr = gq + (size_t)seqrow_cm(n * 64 + 16 * I + 4 * q + r, d, b) * 768 + 512 + h * 64 + l15;
#pragma unroll
                for (int nt = 0; nt < 4; ++nt) acc[I][nt][r] = bf2f(vr[16 * nt]); }
    }
    __syncthreads();
    {
        int tix = 0;
#pragma unroll
        for (int it = 0; it < 4; ++it)
#pragma unroll
            for (int jt = 0; jt < 4; ++jt, ++tix) if ((tix & 1) == pw) {
                f32x4 t4 = (f32x4){0.f, 0.f, 0.f, 0.f};
                if (jt <= it) {
#pragma unroll
                    for (int s = 0; s < 2; ++s) t4 = mfma16(ld_frag16(Ks + (16 * it + l15) * MP + 32 * s + 8 * q), ld_frag16(Ks + (16 * jt + l15) * MP + 32 * s + 8 * q), t4);
                    const float gj = vec[64 + 16 * jt + l15];
                    const f32x4 bi = *(const LAS f32x4*)(vec + 16 * it + 4 * q), gi = *(const LAS f32x4*)(vec + 64 + 16 * it + 4 * q);
#pragma unroll
                    for (int r = 0; r < 4; ++r) { const int i = 16 * it + 4 * q + r, j = 16 * jt + l15; t4[r] = (j < i) ? -(bi[r] * t4[r] * __expf(gi[r] - gj)) : 0.f; }
                }
#pragma unroll
                for (int r = 0; r < 4; ++r) Ln[(16 * it + 4 * q + r) * MP + 16 * jt + l15] = (bf16)f2bf1(t4[r]);
            }
    }
    {
#pragma unroll
        for (int I = 0; I < 4; ++I) {
            const f32x4 bi = *(const LAS f32x4*)(vec + 16 * I + 4 * q), gi = *(const LAS f32x4*)(vec + 64 + 16 * I + 4 * q);
#pragma unroll
            for (int r = 0; r < 4; ++r) { const float sc = pw ? bi[r] * __expf(gi[r]) : bi[r];
#pragma unroll
                for (int nt = 0; nt < 4; ++nt) acc[I][nt][r] = (pw ? bf2f(Ks[(16 * I + 4 * q + r) * MP + 16 * nt + l15]) : acc[I][nt][r]) * sc; }
        }
    }
    __syncthreads();
    if (pw == 0) diag_inverses(Ln, TinvP, lane);
    LAS unsigned char* XTw = XT + pw * 8192;
    { LAS v4u* xz = (LAS v4u*)(XTw + lane * 128);
#pragma unroll
        for (int g = 0; g < 8; ++g) xz[g] = (v4u){0u, 0u, 0u, 0u}; }
    __syncthreads();
    blocked_solve(Ln, TinvP, XTw, acc, l15, q);
    {
        bf16* dst = blob_row(C, d, pw, b, c, h, lane);
        const LAS unsigned char* xr = XTw + lane * 128;
#pragma unroll
        for (int g = 0; g < 8; ++g) *(v4u*)(dst + 8 * g) = *(const LAS v4u*)(xr + ((g ^ (lane & 7)) << 4));
    }
    __syncthreads();
}

template <bool DRY>
__device__ __forceinline__ void gdn_chunked(const Ctx& C, int l, int idx) {
    const int d = idx >> 5, b = (idx >> 2) & 7, h = idx & 3, lane = C.lane, w = C.wave, l15 = lane & 15, q = lane >> 4;
    const int it = w & 3, vtp = w >> 2;
    constexpr int IMG = 64 * MP * 2, BUFB = 5 * IMG + 512;
    LAS unsigned char* L0 = C.lds;
    LAS bf16* VnT = (LAS bf16*)(L0 + 2 * BUFB + 2 * IMG);
    const bf16* P = WSP(const bf16, WS_P); const bf16* gq = WSP(const bf16, WS_GQ); bf16* outd = WSP(bf16, WS_OUTD) + (size_t)d * T_ALL * 256;
    const float aexp = __expf(C.in[I_GALOG][(l * 2 + d) * NH + h]), dtb = C.in[I_GDTB][(l * 2 + d) * NH + h];
    const int tt = C.tid >> 3, part = C.tid & 7;
    for (int i = C.tid; i < 2 * IMG / 4; i += NTHR) ((LAS unsigned*)(L0 + 2 * BUFB))[i] = 0u;
    v4u rq, rk, ru, rw; unsigned short rga;
    auto gload = [&](int n) {
        const int c = d ? (n < 4 ? 3 - n : 71 - n) : n;
        const bf16* pp = gq + (size_t)seqrow_cm(n * 64 + tt, d, b) * 768 + h * 64 + 8 * part;
        rq = *(const v4u*)pp; rk = *(const v4u*)(pp + 256);
        ru = *(const v4u*)(blob_row(C, d, 0, b, c, h, tt) + 8 * part); rw = *(const v4u*)(blob_row(C, d, 1, b, c, h, tt) + 8 * part);
        rga = P[(size_t)seqrow_cm(n * 64 + lane, d, b) * PLD + OFF_D + 1024 + d * 4 + h];
    };
    auto images = [&](int bufi) {
        LAS unsigned char* B0 = L0 + bufi * BUFB;
        LAS bf16* Qs = (LAS bf16*)B0; LAS bf16* Ks = Qs + 64 * MP; LAS bf16* KdT = Ks + 64 * MP; LAS bf16* Wi = KdT + 64 * MP; LAS bf16* UT = Wi + 64 * MP; LAS float* vec = (LAS float*)(B0 + 5 * IMG);
        const float la = -aexp * softplusf_(bf2f(rga) + dtb);
        const float gam = wave_incl_sum(la, lane);
        if (w == 0) vec[lane] = gam;
        const float kd = __expf(__shfl(gam, 63) - gam);
        const float kmine = __shfl(kd, 8 * w + (lane >> 3));
        *(LAS v4u*)(Qs + tt * MP + 8 * part) = rq; *(LAS v4u*)(Ks + tt * MP + 8 * part) = rk; *(LAS v4u*)(UT + tt * MP + 8 * part) = ru;
        const unsigned kk[4] = {rk.x, rk.y, rk.z, rk.w}, ww[4] = {rw.x, rw.y, rw.z, rw.w};
#pragma unroll
        for (int e = 0; e < 4; ++e) {
            KdT[(8 * part + 2 * e) * MP + tt] = (bf16)f2bf1(bflo(kk[e]) * kmine); KdT[(8 * part + 2 * e + 1) * MP + tt] = (bf16)f2bf1(bfhi(kk[e]) * kmine);
            Wi[(8 * part + 2 * e) * MP + tt] = (bf16)(ww[e] & 0xffffu); Wi[(8 * part + 2 * e + 1) * MP + tt] = (bf16)(ww[e] >> 16);
        }
    };
    f32x4 Sst[2]; Sst[0] = Sst[1] = (f32x4){0.f, 0.f, 0.f, 0.f};
    const f32x4 z4 = (f32x4){0.f, 0.f, 0.f, 0.f};
    gload(0); images(0); gload(1);
#pragma unroll 1
    for (int n = 0; n < NCH; ++n) {
        RAW_BARRIER();
        const LAS unsigned char* B0 = L0 + (n & 1) * BUFB;
        const LAS bf16* Qs = (const LAS bf16*)B0; const LAS bf16* Ks = Qs + 64 * MP; const LAS bf16* KdT = Ks + 64 * MP; const LAS bf16* Wi = KdT + 64 * MP; const LAS bf16* UT = Wi + 64 * MP; const LAS float* vec = (const LAS float*)(B0 + 5 * IMG);
        const LAS bf16* ST = (const LAS bf16*)(L0 + 2 * BUFB + (n & 1) * IMG); LAS bf16* STn = (LAS bf16*)(L0 + 2 * BUFB + ((n + 1) & 1) * IMG);
        fragb Qf[2]; Qf[0] = ld_frag16(Qs + (16 * it + l15) * MP + 8 * q); Qf[1] = ld_frag16(Qs + (16 * it + l15) * MP + 32 + 8 * q);
        const float gcol = vec[16 * it + l15]; const int icol = 16 * it + l15;
        f32x4 pt[4];
#pragma unroll
        for (int jt = 0; jt < 4; ++jt) {
            pt[jt] = z4;
            if (jt <= it) {
                const fragb k0 = ld_frag16(Ks + (16 * jt + l15) * MP + 8 * q), k1 = ld_frag16(Ks + (16 * jt + l15) * MP + 32 + 8 * q);
                f32x4 st = mfma16(k0, Qf[0], z4); st = mfma16(k1, Qf[1], st);
                const f32x4 gj = *(const LAS f32x4*)(vec + 16 * jt + 4 * q);
#pragma unroll
                for (int r = 0; r < 4; ++r) { const int j = 16 * jt + 4 * q + r; pt[jt][r] = (j <= icol) ? st[r] * __expf(gcol - gj[r]) : 0.f; }
            }
        }
        fragb Pf[2]; Pf[0] = pack_frag(pt[0], pt[1]); Pf[1] = pack_frag(pt[2], pt[3]);
        const fragb Wf0 = ld_frag16(Wi + (16 * it + l15) * MP + 8 * q), Wf1 = ld_frag16(Wi + (16 * it + l15) * MP + 32 + 8 * q);
        f32x4 Ro[2];
#pragma unroll
        for (int v2 = 0; v2 < 2; ++v2) {
            const int vrow = 16 * (2 * vtp + v2) + l15;
            const fragb s0 = ld_frag16(ST + vrow * MP + 8 * q), s1 = ld_frag16(ST + vrow * MP + 32 + 8 * q);
            f32x4 ws = mfma16(Wf0, s0, z4); ws = mfma16(Wf1, s1, ws);
            Ro[v2] = mfma16(Qf[0], s0, z4); Ro[v2] = mfma16(Qf[1], s1, Ro[v2]);
            const v2u ur = *(const LAS v2u*)(UT + vrow * MP + 16 * it + 4 * q);
            v2u o; o.x = pk2(bflo(ur.x) - ws.x, bfhi(ur.x) - ws.y); o.y = pk2(bflo(ur.y) - ws.z, bfhi(ur.y) - ws.w);
            *(LAS v2u*)(VnT + vrow * MP + 16 * it + 4 * q) = o;
        }
        RAW_BARRIER();
        {
            const f32x4 gi = *(const LAS f32x4*)(vec + 16 * it + 4 * q);
            const float gl = __expf(vec[63]);
            const LAS bf16* kr = KdT + (16 * it + l15) * MP + 4 * q;
            const fragb kt0 = ld_frag8x2(kr, kr + 16), kt1 = ld_frag8x2(kr + 32, kr + 48);
#pragma unroll
            for (int v2 = 0; v2 < 2; ++v2) {
                const int vrow = 16 * (2 * vtp + v2) + l15;
                const LAS bf16* vr = VnT + vrow * MP + 4 * q;
                const fragb n0 = ld_frag8x2(vr, vr + 16), n1 = ld_frag8x2(vr + 32, vr + 48);
                f32x4 o = mfma16(Pf[0], n0, z4); if (it >= 2) o = mfma16(Pf[1], n1, o);
#pragma unroll
                for (int r = 0; r < 4; ++r) { const int row = seqrow_cm(n * 64 + 16 * it + 4 * q + r, d, b);
                    if (!DRY) outd[(size_t)row * 256 + h * 64 + vrow] = (bf16)f2bf1(o[r] + __expf(gi[r]) * Ro[v2][r]); }
                f32x4 ns = mfma16(kt0, n0, z4); ns = mfma16(kt1, n1, ns);
                Sst[v2] = Sst[v2] * gl + ns;
                v2u so; so.x = pk2(Sst[v2].x, Sst[v2].y); so.y = pk2(Sst[v2].z, Sst[v2].w);
                *(LAS v2u*)(STn + vrow * MP + 16 * it + 4 * q) = so;
            }
        }
        if (n + 1 < NCH) { images((n + 1) & 1); if (n + 2 < NCH) gload(n + 2); }
    }
    __syncthreads();
}
constexpr int UP = 264;
template <int CTRL> __device__ __forceinline__ float dpp_keep(float oldv, float v) { return __builtin_bit_cast(float, __builtin_amdgcn_update_dpp(__builtin_bit_cast(int, oldv), __builtin_bit_cast(int, v), CTRL, 0xF, 0xF, false)); }
template <bool REV> __device__ __forceinline__ void scan16(float& A, float& B) {
#define LRU_STEP(S) { const float Ap = dpp_keep<(REV ? 0x100 : 0x110) | S>(1.0f, A), Bp = dpp_keep<(REV ? 0x100 : 0x110) | S>(0.0f, B); B = A * Bp + B; A = A * Ap; }
    LRU_STEP(1) LRU_STEP(2) LRU_STEP(4) LRU_STEP(8)
#undef LRU_STEP
}
template <bool FIN, bool REV>
__device__ __forceinline__ void lru_wave(const Ctx& C, int l, int b, int c, int hd, LAS bf16* U16, LAS bf16* H16) {
    constexpr int d = REV ? 1 : 0;
    const int lane = C.lane, l15 = lane & 15, q = lane >> 4;
    const bf16* wt = WSP(const bf16, WS_LRUWT) + (size_t)((d * 2 + 0) * 4 + hd) * 4096;
    fragb Wa[4][2], Wx[4][2];
#pragma unroll
    for (int mt = 0; mt < 4; ++mt)
#pragma unroll
        for (int ks = 0; ks < 2; ++ks) { Wa[mt][ks] = *(const fragb*)(wt + (16 * mt + l15) * 64 + 32 * ks + 8 * q); Wx[mt][ks] = *(const fragb*)(wt + 4 * 4096 + (16 * mt + l15) * 64 + 32 * ks + 8 * q); }
    f32x4 sp4[4], hc[4], sla[4];
    const size_t sbase = ((size_t)(b * NCH + c) * 2 + d) * 256 + hd * 64;
#pragma unroll
    for (int mt = 0; mt < 4; ++mt) {
        const int ch = hd * 64 + 16 * mt + 4 * q;
        const f32x4 lam = *(const f32x4*)(C.in[I_LLAM] + (l * 2 + d) * GW + ch);
#pragma unroll
        for (int r = 0; r < 4; ++r) sp4[mt][r] = 8.0f * softplusf_(-lam[r]);
        hc[mt] = FIN ? *(const f32x4*)(WSP(const float, WS_HIN) + sbase + 16 * mt + 4 * q) : (f32x4){0.f, 0.f, 0.f, 0.f};
        sla[mt] = (f32x4){0.f, 0.f, 0.f, 0.f};
    }
    const f32x4 z4 = (f32x4){0.f, 0.f, 0.f, 0.f};
#pragma unroll 1
    for (int nti = 0; nti < 4; ++nti) {
        const int nt = REV ? 3 - nti : nti;
        const LAS bf16* urow = U16 + (16 * nt + l15) * UP + hd * 64;
        const fragb Uf0 = ld_frag16(urow + 8 * q), Uf1 = ld_frag16(urow + 32 + 8 * q);
#pragma unroll
        for (int mt = 0; mt < 4; ++mt) {
            f32x4 aa = mfma16(Wa[mt][0], Uf0, z4); aa = mfma16(Wa[mt][1], Uf1, aa);
            f32x4 ax = mfma16(Wx[mt][0], Uf0, z4); ax = mfma16(Wx[mt][1], Uf1, ax);
            const v2u ur = *(const LAS v2u*)(urow + 16 * mt + 4 * q);
            const float u4[4] = {bflo(ur.x), bfhi(ur.x), bflo(ur.y), bfhi(ur.y)};
            const f32x4 ba = *(const f32x4*)(C.in[I_LBA] + (l * 2 + d) * GW + hd * 64 + 16 * mt + 4 * q), bx = *(const f32x4*)(C.in[I_LBX] + (l * 2 + d) * GW + hd * 64 + 16 * mt + 4 * q);
            f32x4 hv;
#pragma unroll
            for (int r = 0; r < 4; ++r) {
                const float rg = sigmoidf_(aa[r] + ba[r]), ig = sigmoidf_(ax[r] + bx[r]);
                const float la = -sp4[mt][r] * rg; float A = __expf(la); float Bv = __builtin_amdgcn_sqrtf(-expm1f_(2.0f * la)) * (ig * u4[r]);
                sla[mt][r] += la;
                scan16<REV>(A, Bv);
                const float h = A * hc[mt][r] + Bv;
                hv[r] = h;
                hc[mt][r] = __shfl(h, (lane & 48) | (REV ? 0 : 15));
            }
            if (FIN) { v2u o; o.x = pk2(hv.x, hv.y); o.y = pk2(hv.z, hv.w); *(LAS v2u*)(H16 + (size_t)d * 64 * UP + (16 * nt + l15) * UP + hd * 64 + 16 * mt + 4 * q) = o; }
        }
    }
    if (!FIN) {
        float* ls = WSP(float, WS_LSUM);
#pragma unroll
        for (int mt = 0; mt < 4; ++mt)
#pragma unroll
            for (int r = 0; r < 4; ++r) { const float st = row16_sum(sla[mt][r]); if (l15 == 0) { const size_t si = sbase + 16 * mt + 4 * q + r; ls[si * 2] = st; ls[si * 2 + 1] = hc[mt][r]; } }
    }
}
template <bool FIN>
__device__ __forceinline__ void lru_chunk_mfma(const Ctx& C, int l, int b, int c) {
    LAS bf16* U16 = (LAS bf16*)C.lds;
    LAS bf16* H16 = U16 + 64 * UP;
    const bf16* P = WSP(const bf16, WS_P);
    const bool isctx = c < 4; const int p0 = isctx ? c * 64 : (c - 4) * 64; const int Lp = isctx ? CTXL : SEQ; const int row0 = isctx ? T_LAT + b * CTXL : b * SEQ;
    {
        const int ch = C.tid & 255, half = C.tid >> 8;
        const float* cw = C.in[I_LCW] + (size_t)l * 4 * GW + ch; const float w0 = cw[0], w1 = cw[GW], w2 = cw[2 * GW], w3 = cw[3 * GW], cb = C.in[I_LCB][l * GW + ch];
        const int t0 = half * 32;
        float xs[35];
#pragma unroll
        for (int k = 0; k < 35; ++k) { const int p = p0 + t0 + k - 2; xs[k] = (p >= 0 && p < Lp) ? bf2f(P[(size_t)(row0 + p) * PLD + ch]) : 0.f; }
#pragma unroll
        for (int t = 0; t < 32; ++t) U16[(t0 + t) * UP + ch] = (bf16)f2bf1(w0 * xs[t] + w1 * xs[t + 1] + w2 * xs[t + 2] + w3 * xs[t + 3] + cb);
    }
    __syncthreads();
    if (C.wave < 4) lru_wave<FIN, false>(C, l, b, c, C.wave & 3, U16, H16); else lru_wave<FIN, true>(C, l, b, c, C.wave & 3, U16, H16);
    __syncthreads();
    if (FIN) {
        const LAS bf16* H1 = H16 + 64 * UP;
#pragma unroll 2
        for (int it = C.tid; it < 64 * 64; it += NTHR) {
            const int t = it >> 6, c4 = (it & 63) * 4;
            const size_t row = (size_t)(row0 + p0 + t);
            const v2u a = *(const LAS v2u*)(H16 + t * UP + c4), bq = *(const LAS v2u*)(H1 + t * UP + c4);
            const f32x4 g = ld4bf(P + row * PLD + 256 + c4);
            f32x4 y = (f32x4){bflo(a.x) + bflo(bq.x), bfhi(a.x) + bfhi(bq.x), bflo(a.y) + bflo(bq.y), bfhi(a.y) + bfhi(bq.y)};
            y.x *= gelu_tanh(g.x); y.y *= gelu_tanh(g.y); y.z *= gelu_tanh(g.z); y.w *= gelu_tanh(g.w);
            st4bf(WSP(bf16, WS_P) + row * PLD + 256 + c4, y);
        }
        __syncthreads();
    }
}
constexpr int RP = 264;
__device__ __forceinline__ void rwkv_prep2(const Ctx& C, int l, int b, int c) {
    LAS bf16* RS = (LAS bf16*)C.lds;
    LAS bf16* KS = RS + 64 * RP;
    LAS bf16* XW = KS + 64 * RP;
    LAS bf16* XA = XW + 64 * MP;
    LAS bf16* XG = XA + 64 * MP;
    const bf16* P = WSP(const bf16, WS_P);
    const bool isctx = c < 4; const int p0 = isctx ? c * 64 : (c - 4) * 64; const int Lp = isctx ? CTXL : SEQ; const int row0 = isctx ? T_LAT + b * CTXL : b * SEQ;
    const float* mu = C.in[I_RMU] + (size_t)l * 2 * B_COLS;
    bf16* rkv = WSP(bf16, WS_RKV);
#pragma unroll 5
    for (int it = C.tid; it < 64 * 120; it += NTHR) {
        const int t = it / 120, c8 = (it % 120) * 8, p = p0 + t;
        const bf16* pp = P + (size_t)(row0 + p) * PLD + OFF_B + c8;
        const v4u xc = *(const v4u*)pp; v4u xp = (v4u){0u, 0u, 0u, 0u}, xn = xp;
        if (p > 0) xp = *(const v4u*)(pp - PLD);
        if (p < Lp - 1) xn = *(const v4u*)(pp + PLD);
        const f32x4 m0a = *(const f32x4*)(mu + c8), m0b = *(const f32x4*)(mu + c8 + 4), m1a = *(const f32x4*)(mu + B_COLS + c8), m1b = *(const f32x4*)(mu + B_COLS + c8 + 4);
        const unsigned xcw[4] = {xc.x, xc.y, xc.z, xc.w}, xpw[4] = {xp.x, xp.y, xp.z, xp.w}, xnw[4] = {xn.x, xn.y, xn.z, xn.w};
        float sh[8];
#pragma unroll
        for (int e = 0; e < 4; ++e) {
            const float x0 = bflo(xcw[e]), x1 = bfhi(xcw[e]);
            const float mu0_0 = e < 2 ? m0a[2 * e] : m0b[2 * e - 4], mu0_1 = e < 2 ? m0a[2 * e + 1] : m0b[2 * e - 3], mu1_0 = e < 2 ? m1a[2 * e] : m1b[2 * e - 4], mu1_1 = e < 2 ? m1a[2 * e + 1] : m1b[2 * e - 3];
            sh[2 * e] = x0 + mu0_0 * (bflo(xpw[e]) - x0) + mu1_0 * (bflo(xnw[e]) - x0);
            sh[2 * e + 1] = x1 + mu0_1 * (bfhi(xpw[e]) - x1) + mu1_1 * (bfhi(xnw[e]) - x1);
        }
        if (c8 >= 768) {
            const int ci = c8 - 768;
            if (ci < 64) {
#pragma unroll
                for (int e = 0; e < 8; ++e) sh[e] = tanhf_(sh[e]); }
            else if (ci >= 128) {
#pragma unroll
                for (int e = 0; e < 8; ++e) sh[e] = sigmoidf_(sh[e]); }
        }
        v4u o; o.x = pk2(sh[0], sh[1]); o.y = pk2(sh[2], sh[3]); o.z = pk2(sh[4], sh[5]); o.w = pk2(sh[6], sh[7]);
        if (c8 < 768) {
            *(v4u*)(rkv + (size_t)(row0 + p) * 768 + c8) = o;
            if (c8 < 256) *(LAS v4u*)(RS + t * RP + c8) = o; else if (c8 < 512) *(LAS v4u*)(KS + t * RP + c8 - 256) = o;
        } else {
            const int ci = c8 - 768;
            LAS bf16* dst = ci < 64 ? XW + t * MP + ci : (ci < 128 ? XA + t * MP + ci - 64 : XG + t * MP + ci - 128);
            *(LAS v4u*)dst = o;
        }
    }
    __syncthreads();
    const int lane = C.lane, w = C.wave, l15 = lane & 15, q = lane >> 4, hd = w & 3, ntp = w >> 2;
    const bf16* wt = WSP(const bf16, WS_RWT);
    bf16* wa_out = WSP(bf16, WS_HB); bf16* g_out = WSP(bf16, WS_G); float* bonus = WSP(float, WS_BONUS); float* rinv = WSP(float, WS_RINV);
    const f32x4 z4 = (f32x4){0.f, 0.f, 0.f, 0.f};
    fragb xw0[2], xw1[2], xa0[2], xa1[2], xg0[2], xg1[2]; float bsum[2] = {0.f, 0.f}, ksum[2] = {0.f, 0.f};
#pragma unroll
    for (int n2 = 0; n2 < 2; ++n2) { const int tok = 16 * (2 * ntp + n2) + l15;
        xw0[n2] = ld_frag16(XW + tok * MP + 8 * q); xw1[n2] = ld_frag16(XW + tok * MP + 32 + 8 * q);
        xa0[n2] = ld_frag16(XA + tok * MP + 8 * q); xa1[n2] = ld_frag16(XA + tok * MP + 32 + 8 * q);
        xg0[n2] = ld_frag16(XG + tok * MP + 8 * q); xg1[n2] = ld_frag16(XG + tok * MP + 32 + 8 * q); }
#pragma unroll
    for (int mt = 0; mt < 4; ++mt) {
        const int chl = 16 * mt + l15, ch4 = hd * 64 + 16 * mt + 4 * q;
        const bf16* wrow = wt + (size_t)(hd * 64 + chl) * 32 + 8 * q;
        const bf16* grow = wt + 4 * 256 * 32 + (size_t)(hd * 64 + chl) * 64 + 8 * q;
        const fragb fw0 = *(const fragb*)(wrow), fw1 = *(const fragb*)(wrow + 256 * 32), fa0 = *(const fragb*)(wrow + 2 * 256 * 32), fa1 = *(const fragb*)(wrow + 3 * 256 * 32), fg0 = *(const fragb*)(grow), fg1 = *(const fragb*)(grow + 32);
        const f32x4 w00 = *(const f32x4*)(C.in[I_RW0] + (l * 2 + 0) * GW + ch4), w01 = *(const f32x4*)(C.in[I_RW0] + (l * 2 + 1) * GW + ch4);
        const f32x4 a00 = *(const f32x4*)(C.in[I_RA0] + (l * 2 + 0) * GW + ch4), a01 = *(const f32x4*)(C.in[I_RA0] + (l * 2 + 1) * GW + ch4);
        const f32x4 k_a = *(const f32x4*)(C.in[I_RKA] + l * GW + ch4), r_k = *(const f32x4*)(C.in[I_RRK] + l * GW + ch4), k_k = *(const f32x4*)(C.in[I_RKK] + l * GW + ch4);
#pragma unroll
        for (int n2 = 0; n2 < 2; ++n2) {
            const int tok = 16 * (2 * ntp + n2) + l15; const size_t row = (size_t)(row0 + p0 + tok);
            const f32x4 aw0 = mfma16(fw0, xw0[n2], z4), aw1 = mfma16(fw1, xw1[n2], z4), aa0 = mfma16(fa0, xa0[n2], z4), aa1 = mfma16(fa1, xa1[n2], z4);
            f32x4 ag = mfma16(fg0, xg0[n2], z4); ag = mfma16(fg1, xg1[n2], ag);
            f32x4 wv0, wv1, av0, av1;
#pragma unroll
            for (int r = 0; r < 4; ++r) {
                wv0[r] = __expf(-0.6065306597126334f * sigmoidf_(aw0[r] + w00[r])); wv1[r] = __expf(-0.6065306597126334f * sigmoidf_(aw1[r] + w01[r]));
                av0[r] = sigmoidf_(aa0[r] + a00[r]); av1[r] = sigmoidf_(aa1[r] + a01[r]);
            }
            st4bf(wa_out + row * 1024 + 0 * 256 + ch4, wv0); st4bf(wa_out + row * 1024 + 1 * 256 + ch4, wv1);
            st4bf(wa_out + row * 1024 + 2 * 256 + ch4, av0); st4bf(wa_out + row * 1024 + 3 * 256 + ch4, av1);
            st4bf(g_out + row * 256 + ch4, ag);
            const v2u rr_ = *(const LAS v2u*)(RS + tok * RP + ch4), kr_ = *(const LAS v2u*)(KS + tok * RP + ch4);
            const f32x4 rs = (f32x4){bflo(rr_.x), bfhi(rr_.x), bflo(rr_.y), bfhi(rr_.y)}, ks = (f32x4){bflo(kr_.x), bfhi(kr_.x), bflo(kr_.y), bfhi(kr_.y)};
#pragma unroll
            for (int r = 0; r < 4; ++r) {
                const float km = ks[r] * (1.0f + (av0[r] - 1.0f) * k_a[r]) + ks[r] * (1.0f + (av1[r] - 1.0f) * k_a[r]);
                bsum[n2] += rs[r] * r_k[r] * km; const float kk = ks[r] * k_k[r]; ksum[n2] += kk * kk;
            }
        }
    }
#pragma unroll
    for (int n2 = 0; n2 < 2; ++n2) {
        const size_t row = (size_t)(row0 + p0 + 16 * (2 * ntp + n2) + l15);
        float bs = bsum[n2], ks2 = ksum[n2];
        bs += __shfl_xor(bs, 16); bs += __shfl_xor(bs, 32); ks2 += __shfl_xor(ks2, 16); ks2 += __shfl_xor(ks2, 32);
        if (q == 0) { bonus[row * 4 + hd] = bs; rinv[row * 4 + hd] = rsqrtf_(ks2 + 1e-6f); }
    }
    __syncthreads();
}
__device__ __forceinline__ int fwd_row_r(int b, int c, int t) { return c < 4 ? (T_LAT + b * CTXL + c * 64 + t) : (b * SEQ + (c - 4) * 64 + t); }
__device__ __forceinline__ bf16* rw_blob_row(const Ctx& C, int d, int which, int b, int c, int h, int r) {
    const int row = fwd_row_r(b, c, r);
#if RW_VSPLIT
    if (which == 0) { if (d) return WSP(bf16, WS_GQ) + (size_t)row * 768 + 512 + h * 64;
                      return WSP(bf16, WS_P) + (size_t)row * PLD + OFF_B + 512 + h * 64; }
#else
    if (which == 0) return WSP(bf16, WS_OUTB) + ((size_t)d * T_ALL + row) * 256 + h * 64;
#endif
    return WSP(bf16, WS_P) + (size_t)row * PLD + OFF_B + d * 256 + h * 64;
}
__device__ __forceinline__ void rwkv_solve_item(const Ctx& C, int l, int item) {
    const int lane = C.lane, w = C.wave, pw = w & 1, pi = w >> 1, l15 = lane & 15, q = lane >> 4;
    LAS unsigned char* B0 = C.lds + pi * 31744;
    LAS bf16* Kk = (LAS bf16*)B0; LAS bf16* Bh = Kk + 64 * MP; LAS bf16* Kh = Bh + 64 * MP;
    LAS bf16* Ln = (LAS bf16*)B0;
    LAS bf16* Lk16 = (LAS bf16*)(B0 + 9216);
    LAS unsigned char* XT = B0 + 9216;
    LAS bf16* TinvP = (LAS bf16*)(B0 + 25600);
    const bf16* WA = WSP(const bf16, WS_HB); bf16* WAw = WSP(bf16, WS_HB); const bf16* rkv = WSP(const bf16, WS_RKV); const float* rinv = WSP(const float, WS_RINV);
    const int u = item >> 1, d = item & 1;
    const int c = u % NCH, h = (u / NCH) & 3, b = u / (NCH * NH);
    const float k_k = C.in[I_RKK][l * GW + h * 64 + lane], k_a = C.in[I_RKA][l * GW + h * 64 + lane];
    const int n = d ? (c < 4 ? 3 - c : 71 - c) : c;
    const float ril = rinv[(size_t)seqrow_raster(n * 64 + lane, d, b) * 4 + h];
#pragma unroll
    for (int r = 0; r < 4; ++r) { const int idx2 = pw * 64 + lane + 128 * r, t = idx2 >> 3, part = idx2 & 7; const int row = seqrow_raster(n * 64 + t, d, b);
        *(LAS v4u*)(Kk + t * MP + 8 * part) = *(const v4u*)(WA + (size_t)row * 1024 + d * 256 + h * 64 + 8 * part);
        *(LAS v4u*)(Bh + t * MP + 8 * part) = *(const v4u*)(WA + (size_t)row * 1024 + (2 + d) * 256 + h * 64 + 8 * part);
        *(LAS v4u*)(Kh + t * MP + 8 * part) = *(const v4u*)(rkv + (size_t)row * 768 + 256 + h * 64 + 8 * part); }
    __syncthreads();
    {
        float cc = 1.0f;
        if (pw) {
#pragma unroll
            for (int t = 0; t < 32; ++t) cc *= bf2f(Kk[t * MP + lane]);
        }
        __syncthreads();
#pragma unroll
        for (int t2 = 0; t2 < 32; ++t2) {
            const int t = pw * 32 + t2;
            const float wv = bf2f(Kk[t * MP + lane]), av = bf2f(Bh[t * MP + lane]), ks = bf2f(Kh[t * MP + lane]);
            const float kap = ks * k_k * __shfl(ril, t);
            const float cprev = cc; cc *= wv; const float ic = __builtin_amdgcn_rcpf(cc);
            Kk[t * MP + lane] = (bf16)f2bf1(kap * cprev); Bh[t * MP + lane] = (bf16)f2bf1(kap * av * ic); Kh[t * MP + lane] = (bf16)f2bf1(ks * (1.0f + (av - 1.0f) * k_a) * ic);
            WAw[(size_t)seqrow_raster(n * 64 + t, d, b) * 1024 + d * 256 + h * 64 + lane] = (bf16)f2bf1(cc);
        }
    }
    __syncthreads();
    f32x4 acc[4][4];
    if (pw == 0) {
#pragma unroll
        for (int I = 0; I < 4; ++I)
#pragma unroll
            for (int r = 0; r < 4; ++r)
#pragma unroll
                for (int nt = 0; nt < 4; ++nt) acc[I][nt][r] = bf2f(Kk[(16 * I + 4 * q + r) * MP + 16 * nt + l15]);
    }
    f32x4 T[10];
    {
        const LAS bf16* Bsrc = pw ? Kh : Bh;
        int tix = 0;
#pragma unroll
        for (int it = 0; it < 4; ++it)
#pragma unroll
            for (int jt = 0; jt <= it; ++jt, ++tix) {
                f32x4 t4 = (f32x4){0.f, 0.f, 0.f, 0.f};
#pragma unroll
                for (int s = 0; s < 2; ++s) t4 = mfma16(ld_frag16(Kk + (16 * it + l15) * MP + 32 * s + 8 * q), ld_frag16(Bsrc + (16 * jt + l15) * MP + 32 * s + 8 * q), t4);
#pragma unroll
                for (int r = 0; r < 4; ++r) { const int i = 16 * it + 4 * q + r, j = 16 * jt + l15; T[tix][r] = (j < i) ? (pw ? t4[r] : -t4[r]) : 0.f; }
            }
    }
    __syncthreads();
    {
        int tix = 0;
#pragma unroll
        for (int it = 0; it < 4; ++it)
#pragma unroll
            for (int jt = 0; jt < 4; ++jt) {
                if (jt <= it) {
#pragma unroll
                    for (int r = 0; r < 4; ++r) (pw ? Lk16 : Ln)[(16 * it + 4 * q + r) * MP + 16 * jt + l15] = (bf16)f2bf1(T[tix][r]);
                    ++tix;
                } else if (pw == 0) {
#pragma unroll
                    for (int r = 0; r < 4; ++r) Ln[(16 * it + 4 * q + r) * MP + 16 * jt + l15] = (bf16)0;
                }
            }
        LAS v4u* tz = (LAS v4u*)(B0 + 25600) + (pw * 64 + lane) * 2; tz[0] = (v4u){0u, 0u, 0u, 0u}; tz[1] = (v4u){0u, 0u, 0u, 0u};
    }
    __syncthreads();
    if (pw) {
#pragma unroll
        for (int I = 0; I < 4; ++I)
#pragma unroll
            for (int r = 0; r < 4; ++r)
#pragma unroll
                for (int nt = 0; nt < 4; ++nt) { const int i = 16 * I + 4 * q + r, j = 16 * nt + l15; acc[I][nt][r] = (j < i && nt <= I) ? bf2f(Lk16[i * MP + j]) : 0.f; }
    } else diag_inverses(Ln, TinvP, lane);
    __syncthreads();
    LAS unsigned char* XTw = XT + pw * 8192;
    { LAS v4u* xz = (LAS v4u*)(XTw + lane * 128);
#pragma unroll
        for (int g = 0; g < 8; ++g) xz[g] = (v4u){0u, 0u, 0u, 0u}; }
    blocked_solve(Ln, TinvP, XTw, acc, l15, q);
    {
        bf16* dst = rw_blob_row(C, d, pw, b, c, h, lane);
        const LAS unsigned char* xr = XTw + lane * 128;
#pragma unroll
        for (int g = 0; g < 8; ++g) *(v4u*)(dst + 8 * g) = *(const LAS v4u*)(xr + ((g ^ (lane & 7)) << 4));
    }
    __syncthreads();
}

template <bool DRY>
__device__ __forceinline__ void rwkv_chunked(const Ctx& C, int l, int idx) {
#ifndef RW_VSPLIT
#define RW_VSPLIT 1
#endif
    constexpr int NV = RW_VSPLIT ? 1 : 2;
    const int vhalf = idx & 1, lane = C.lane, w = C.wave, l15 = lane & 15, q = lane >> 4;
    const int d = RW_VSPLIT ? idx >> 6 : idx >> 5, b = RW_VSPLIT ? (idx >> 3) & 7 : (idx >> 2) & 7, h = RW_VSPLIT ? (idx >> 1) & 3 : idx & 3;
    const int it = w & 3, vt0 = RW_VSPLIT ? 2 * vhalf + (w >> 2) : 2 * (w >> 2);
    constexpr int IMG = 64 * MP * 2;
    LAS unsigned char* L0 = C.lds;
    LAS bf16* Wi = (LAS bf16*)L0; LAS bf16* Ti = Wi + 64 * MP; LAS bf16* Rh = Ti + 64 * MP; LAS bf16* Kh = Rh + 64 * MP; LAS bf16* Bh = Kh + 64 * MP;
    LAS bf16* UT = (LAS bf16*)(L0 + 11 * IMG);
    LAS float* cLv = (LAS float*)(L0 + 14 * IMG);
    const bf16* WA = WSP(const bf16, WS_HB); const bf16* rkv = WSP(const bf16, WS_RKV); const float* rinv = WSP(const float, WS_RINV);
    bf16* outb = WSP(bf16, WS_OUTB) + (size_t)d * T_ALL * 256;
    const int tt = C.tid >> 3, part = C.tid & 7;
    for (int i = C.tid; i < 2 * IMG / 4; i += NTHR) ((LAS unsigned*)(L0 + 12 * IMG))[i] = 0u;
    float kkw[8], kaw[8];
#pragma unroll
    for (int e = 0; e < 8; ++e) { kkw[e] = C.in[I_RKK][l * GW + h * 64 + 8 * w + e]; kaw[e] = C.in[I_RKA][l * GW + h * 64 + 8 * w + e]; }
    v4u gr, gk, gv, gw, ga, gbw, gbt; float gri;
    auto gload = [&](int n) {
        const int c = d ? (n < 4 ? 3 - n : 71 - n) : n;
        const int row = seqrow_raster(n * 64 + lane, d, b);
        const bf16* pr = rkv + (size_t)row * 768 + h * 64 + 8 * w;
        gr = *(const v4u*)pr; gk = *(const v4u*)(pr + 256); gv = *(const v4u*)(pr + 512);
        gw = *(const v4u*)(WA + (size_t)row * 1024 + d * 256 + h * 64 + 8 * w); ga = *(const v4u*)(WA + (size_t)row * 1024 + (2 + d) * 256 + h * 64 + 8 * w);
        gri = rinv[(size_t)row * 4 + h];
        gbw = *(const v4u*)(rw_blob_row(C, d, 0, b, c, h, tt) + 8 * part); gbt = *(const v4u*)(rw_blob_row(C, d, 1, b, c, h, tt) + 8 * part);
    };
    auto images = [&](int bufi) {
        LAS bf16* VT = (LAS bf16*)(L0 + (5 + 3 * bufi) * IMG); LAS bf16* KcT = VT + 64 * MP; LAS bf16* BcT = KcT + 64 * MP;
        const unsigned rw_[4] = {gr.x, gr.y, gr.z, gr.w}, kw_[4] = {gk.x, gk.y, gk.z, gk.w}, vw_[4] = {gv.x, gv.y, gv.z, gv.w}, ww_[4] = {gw.x, gw.y, gw.z, gw.w}, aw_[4] = {ga.x, ga.y, ga.z, ga.w};
        float rh[8], kh[8], bh[8];
#pragma unroll
        for (int e = 0; e < 8; ++e) {
            const float rs = (e & 1) ? bfhi(rw_[e >> 1]) : bflo(rw_[e >> 1]), ks = (e & 1) ? bfhi(kw_[e >> 1]) : bflo(kw_[e >> 1]);
            const float wv = (e & 1) ? bfhi(ww_[e >> 1]) : bflo(ww_[e >> 1]), av = (e & 1) ? bfhi(aw_[e >> 1]) : bflo(aw_[e >> 1]);
            const float kap = ks * kkw[e] * gri, ktil = ks * (1.0f + (av - 1.0f) * kaw[e]);
            const float cf = wv, icf = __builtin_amdgcn_rcpf(cf), cfL = __builtin_bit_cast(float, __builtin_amdgcn_readlane(__builtin_bit_cast(int, cf), 63)), dec = cfL * icf;
            rh[e] = rs * cf; kh[e] = ktil * icf; bh[e] = kap * av * icf;
            const unsigned short vraw = (e & 1) ? (unsigned short)(vw_[e >> 1] >> 16) : (unsigned short)(vw_[e >> 1] & 0xffffu);
            VT[(8 * w + e) * MP + lane] = vraw; KcT[(8 * w + e) * MP + lane] = (bf16)f2bf1(ktil * dec); BcT[(8 * w + e) * MP + lane] = (bf16)f2bf1(-(kap * av * dec));
            if (lane == 63) cLv[bufi * 64 + 8 * w + e] = cfL;
        }
        { v4u o; o.x = pk2(rh[0], rh[1]); o.y = pk2(rh[2], rh[3]); o.z = pk2(rh[4], rh[5]); o.w = pk2(rh[6], rh[7]); *(LAS v4u*)(Rh + lane * MP + 8 * w) = o; }
        { v4u o; o.x = pk2(kh[0], kh[1]); o.y = pk2(kh[2], kh[3]); o.z = pk2(kh[4], kh[5]); o.w = pk2(kh[6], kh[7]); *(LAS v4u*)(Kh + lane * MP + 8 * w) = o; }
        { v4u o; o.x = pk2(bh[0], bh[1]); o.y = pk2(bh[2], bh[3]); o.z = pk2(bh[4], bh[5]); o.w = pk2(bh[6], bh[7]); *(LAS v4u*)(Bh + lane * MP + 8 * w) = o; }
        const unsigned bw_[4] = {gbw.x, gbw.y, gbw.z, gbw.w}, bt_[4] = {gbt.x, gbt.y, gbt.z, gbt.w};
#pragma unroll
        for (int e = 0; e < 4; ++e) {
            Wi[(8 * part + 2 * e) * MP + tt] = (bf16)(bw_[e] & 0xffffu); Wi[(8 * part + 2 * e + 1) * MP + tt] = (bf16)(bw_[e] >> 16);
            Ti[(8 * part + 2 * e) * MP + tt] = (bf16)(bt_[e] & 0xffffu); Ti[(8 * part + 2 * e + 1) * MP + tt] = (bf16)(bt_[e] >> 16);
        }
    };
    f32x4 Zst[NV];
#pragma unroll
    for (int v2 = 0; v2 < NV; ++v2) Zst[v2] = (f32x4){0.f, 0.f, 0.f, 0.f};
    const f32x4 z4 = (f32x4){0.f, 0.f, 0.f, 0.f};
    gload(0); images(0); gload(1);
#pragma unroll 1
    for (int n = 0; n < NCH; ++n) {
        RAW_BARRIER();
        const LAS bf16* VT = (const LAS bf16*)(L0 + (5 + 3 * (n & 1)) * IMG); const LAS bf16* KcT = VT + 64 * MP; const LAS bf16* BcT = KcT + 64 * MP;
        const LAS bf16* Zi = (const LAS bf16*)(L0 + (12 + (n & 1)) * IMG); LAS bf16* Zn = (LAS bf16*)(L0 + (12 + ((n + 1) & 1)) * IMG);
        const int arow = (16 * it + l15) * MP + 8 * q;
        const fragb Wf0 = ld_frag16(Wi + arow), Wf1 = ld_frag16(Wi + arow + 32), Tf0 = ld_frag16(Ti + arow), Tf1 = ld_frag16(Ti + arow + 32), Rf0 = ld_frag16(Rh + arow), Rf1 = ld_frag16(Rh + arow + 32);
        const int icol = 16 * it + l15;
        f32x4 pk[4], pb[4];
#pragma unroll
        for (int jt = 0; jt < 4; ++jt) {
            pk[jt] = z4; pb[jt] = z4;
            if (jt <= it) {
                const int jrow = (16 * jt + l15) * MP + 8 * q;
                f32x4 sk = mfma16(ld_frag16(Kh + jrow), Rf0, z4); sk = mfma16(ld_frag16(Kh + jrow + 32), Rf1, sk);
                f32x4 sb = mfma16(ld_frag16(Bh + jrow), Rf0, z4); sb = mfma16(ld_frag16(Bh + jrow + 32), Rf1, sb);
#pragma unroll
                for (int r = 0; r < 4; ++r) { const int j = 16 * jt + 4 * q + r; pk[jt][r] = (j <= icol) ? sk[r] : 0.f; pb[jt][r] = (j <= icol) ? -sb[r] : 0.f; }
            }
        }
        fragb Pk0 = pack_frag(pk[0], pk[1]), Pk1 = pack_frag(pk[2], pk[3]), Pb0 = pack_frag(pb[0], pb[1]), Pb1 = pack_frag(pb[2], pb[3]);
        f32x4 RZ[NV];
#pragma unroll
        for (int v2 = 0; v2 < NV; ++v2) {
            const int vrow = 16 * (vt0 + v2) + l15;
            const fragb z0 = ld_frag16(Zi + vrow * MP + 8 * q), z1 = ld_frag16(Zi + vrow * MP + 32 + 8 * q);
            f32x4 u = mfma16(Wf0, z0, z4); u = mfma16(Wf1, z1, u);
            u = mfma16(Tf0, ld_frag16(VT + vrow * MP + 8 * q), u); if (it >= 2) u = mfma16(Tf1, ld_frag16(VT + vrow * MP + 32 + 8 * q), u);
            RZ[v2] = mfma16(Rf0, z0, z4); RZ[v2] = mfma16(Rf1, z1, RZ[v2]);
            v2u o; o.x = pk2(u.x, u.y); o.y = pk2(u.z, u.w);
            *(LAS v2u*)(UT + vrow * MP + 16 * it + 4 * q) = o;
        }
        RAW_BARRIER();
        {
            const f32x4 cl4 = *(const LAS f32x4*)(cLv + (n & 1) * 64 + 16 * it + 4 * q);
            const LAS bf16* kr = KcT + (16 * it + l15) * MP + 4 * q; const LAS bf16* br = BcT + (16 * it + l15) * MP + 4 * q;
            const fragb kc0 = ld_frag8x2(kr, kr + 16), kc1 = ld_frag8x2(kr + 32, kr + 48), bc0 = ld_frag8x2(br, br + 16), bc1 = ld_frag8x2(br + 32, br + 48);
#pragma unroll
            for (int v2 = 0; v2 < NV; ++v2) {
                const int vrow = 16 * (vt0 + v2) + l15;
                const LAS bf16* vr = VT + vrow * MP + 4 * q; const LAS bf16* ur = UT + vrow * MP + 4 * q;
                const fragb vp0 = ld_frag8x2(vr, vr + 16), vp1 = ld_frag8x2(vr + 32, vr + 48), up0 = ld_frag8x2(ur, ur + 16), up1 = ld_frag8x2(ur + 32, ur + 48);
                f32x4 y = mfma16(Pk0, vp0, RZ[v2]); y = mfma16(Pb0, up0, y);
                if (it >= 2) { y = mfma16(Pk1, vp1, y); y = mfma16(Pb1, up1, y); }
#pragma unroll
                for (int r = 0; r < 4; ++r) { const int row = seqrow_raster(n * 64 + 16 * it + 4 * q + r, d, b); if (!DRY) outb[(size_t)row * 256 + h * 64 + vrow] = (bf16)f2bf1(y[r]); }
                f32x4 zn = mfma16(kc0, vp0, z4); zn = mfma16(kc1, vp1, zn); zn = mfma16(bc0, up0, zn); zn = mfma16(bc1, up1, zn);
                Zst[v2] = Zst[v2] * cl4 + zn;
                v2u so; so.x = pk2(Zst[v2].x, Zst[v2].y); so.y = pk2(Zst[v2].z, Zst[v2].w);
                *(LAS v2u*)(Zn + vrow * MP + 16 * it + 4 * q) = so;
            }
        }
        if (n + 1 < NCH) { images((n + 1) & 1); if (n + 2 < NCH) gload(n + 2); }
    }
    __syncthreads();
}
__device__ __forceinline__ void moe_scatter(const Ctx& C, int moe_li, int nrows) {
    const unsigned* gc = WSP(const unsigned, WS_CTL) + CW_MOECNT + 64 * moe_li;
    LAS int* pst = (LAS int*)C.lds;
    {
        int pe[8]; int acc = 0;
#pragma unroll
        for (int e = 0; e < NE; ++e) { const int blks = ((int)gc[e] + 255) >> 8; if (C.tid == e) pst[e] = acc * 256; acc += blks; pe[e] = acc; }
        if (C.wg == 0 && C.tid < MOE_MAXBLK) { int be = 0;
#pragma unroll
            for (int e = 0; e < NE; ++e) be += (pe[e] <= C.tid) ? 1 : 0;
            int* tab = WSP(int, WS_TAB); tab[1 + C.tid] = be < NE ? be : NE - 1; if (C.tid == 0) tab[0] = acc; }
    }
    __syncthreads();
    const unsigned* route = WSP(const unsigned, WS_ROUTE); const unsigned* wgbase = WSP(const unsigned, WS_WGBASE);
    int* pos = WSP(int, WS_POS); int* tok = WSP(int, WS_TOK);
    if (C.wg < NE) { const int cnt = (int)gc[C.wg], s0 = pst[C.wg] + cnt, s1 = pst[C.wg] + (((cnt + 255) >> 8) << 8);
        for (int j = s0 + C.tid; j < s1; j += NTHR) tok[j] = 0; }
    const int m = C.wg * NWAVES + C.wave + C.lane * (C.G * NWAVES);
    if (m < nrows) {
        const v4u a = *(const v4u*)(route + (size_t)m * 8);
        const int e0 = (int)a.x, e1 = (int)a.y;
        const int p0 = pst[e0] + (int)wgbase[C.wg * 8 + e0] + (int)a.z, p1 = pst[e1] + (int)wgbase[C.wg * 8 + e1] + (int)a.w;
        pos[(size_t)m * 2] = p0; pos[(size_t)m * 2 + 1] = p1; tok[p0] = m; tok[p1] = m;
    }
    __syncthreads();
}
template <int NEXT>
__device__ __forceinline__ void moe_combine(const Ctx& C, int l, int nrows) {
    const unsigned* route = WSP(const unsigned, WS_ROUTE); const int* pos = WSP(const int, WS_POS); const bf16* ym = WSP(const bf16, WS_MIX);
    const float* modv = WSP(const float, WS_MODV) + (size_t)l * 9 * 6144 + 5 * 1024;
    const float* modn = WSP(const float, WS_MODV) + (size_t)(l + 1) * 9 * 6144;
    float* xc = WSP(float, WS_XC); bf16* hb = WSP(bf16, WS_HB);
    const int gw = C.wg * NWAVES + C.wave, NGW = C.G * NWAVES;
    f32x4 gn[4];
#pragma unroll
    for (int j = 0; j < 4; ++j) gn[j] = *(const f32x4*)((NEXT == 2 ? C.in[I_FNG] : C.in[I_NMIXG] + (NEXT == 1 ? (l + 1) * 1024 : 0)) + 4 * C.lane + 256 * j);
    for (int m = gw; m < nrows; m += NGW) {
        const bool isctx = m >= T_LAT;
        float* xr = isctx ? xc + (size_t)(m - T_LAT) * 1024 : C.out + (size_t)m * 1024;
        const int mrow = isctx ? 8 : (m >> 12);
        const float* gv = modv + (size_t)mrow * 6144;
        const int p0 = pos[(size_t)m * 2], p1 = pos[(size_t)m * 2 + 1];
        const float w0 = __builtin_bit_cast(float, route[(size_t)m * 8 + 4]), w1 = __builtin_bit_cast(float, route[(size_t)m * 8 + 5]);
        f32x4 x[4]; float ss = 0.f;
#pragma unroll
        for (int j = 0; j < 4; ++j) {
            const int col = 4 * C.lane + 256 * j;
            const v2u a = *(const v2u*)(ym + (size_t)p0 * 1024 + col), b = *(const v2u*)(ym + (size_t)p1 * 1024 + col);
            const f32x4 ya = (f32x4){bflo(a.x), bfhi(a.x), bflo(a.y), bfhi(a.y)}, yb = (f32x4){bflo(b.x), bfhi(b.x), bflo(b.y), bfhi(b.y)};
            const f32x4 g = *(const f32x4*)(gv + col);
            x[j] = *(const f32x4*)(xr + col) + g * (ya * w0 + yb * w1);
            if (NEXT != 2) *(f32x4*)(xr + col) = x[j];
            ss += (x[j].x * x[j].x + x[j].y * x[j].y) + (x[j].z * x[j].z + x[j].w * x[j].w);
        }
        if (NEXT != 0) {
            const float rs = rsqrtf_(wave_sum(ss) * (1.0f / 1024.0f) + 1e-6f);
#pragma unroll
            for (int j = 0; j < 4; ++j) {
                const int col = 4 * C.lane + 256 * j;
                if (NEXT == 2) *(f32x4*)(xr + col) = x[j] * rs * gn[j];
                else { const f32x4 sh = *(const f32x4*)(modn + (size_t)mrow * 6144 + col), scl = *(const f32x4*)(modn + (size_t)mrow * 6144 + 1024 + col);
                    st4bf(hb + (size_t)m * 1024 + col, (x[j] * rs * gn[j]) * (scl + 1.0f) + sh); }
            }
        }
    }
}
__device__ __forceinline__ void final_norm(const Ctx& C) {
    const int gw = C.wg * NWAVES + C.wave, NGW = C.G * NWAVES;
    f32x4 gv[4];
#pragma unroll
    for (int j = 0; j < 4; ++j) gv[j] = *(const f32x4*)(C.in[I_FNG] + 4 * C.lane + 256 * j);
    for (int m = gw; m < T_LAT; m += NGW) {
        float* xr = C.out + (size_t)m * 1024;
        f32x4 v[4]; float s = 0.f;
#pragma unroll
        for (int j = 0; j < 4; ++j) { v[j] = *(const f32x4*)(xr + 4 * C.lane + 256 * j); s += (v[j].x * v[j].x + v[j].y * v[j].y) + (v[j].z * v[j].z + v[j].w * v[j].w); }
        const float rs = rsqrtf_(wave_sum(s) * (1.0f / 1024.0f) + 1e-6f);
#pragma unroll
        for (int j = 0; j < 4; ++j) *(f32x4*)(xr + 4 * C.lane + 256 * j) = v[j] * rs * gv[j];
    }
}

constexpr int NPH_L = 13, PH_FINAL = 1 + DEPTH * NPH_L, NPHASE = PH_FINAL + 1;
__host__ __device__ inline bool phase_exists(int ph) {
    if (ph == 0) return true;
    if (ph == PH_FINAL) return false;
    const int l = (ph - 1) / NPH_L, k = (ph - 1) % NPH_L;
    if (l >= 2 && !(l & 1) && k == 0) return false;
    if (!(l & 1) && k >= 11) return false;
    if (!RW_VSPLIT && k == 4) return false;
    return true;
}
#ifndef PH_MASK
#define PH_MASK 0xFFFFFF
#endif
#define PM(k) ((PH_MASK >> (k)) & 1)
#ifndef SK_MASK
#define SK_MASK 0xFFFF
#endif
#define SK(k) ((SK_MASK >> (k)) & 1)
#ifndef REP_MASK
#define REP_MASK 0
#endif
#define NREP(k) (((REP_MASK >> (k)) & 1) ? 2 : 1)

__global__ void __launch_bounds__(NTHR, 2) fwd_kernel(Args args) {
    extern __shared__ __attribute__((aligned(16))) unsigned char lds_raw[];
    Ctx C; C.in = args.in; C.out = args.out; C.ws = args.ws; C.lds = (LAS unsigned char*)lds_raw;
    C.tid = threadIdx.x; C.lane = C.tid & 63; C.wave = __builtin_amdgcn_readfirstlane(C.tid >> 6); C.G = gridDim.x; C.wg = blockIdx.x;
    volatile LAS unsigned* MISC = (volatile LAS unsigned*)(C.lds + MISC_OFF);
    if (C.tid < 64) MISC[C.tid] = 0u;
    __syncthreads();
    const int lo = args.ph_lo, hi = args.ph_hi;
    const bool multi = (hi - lo) > 1;
    if (multi) (void)xcd_barrier_post(WSP(unsigned, WS_CTL) + CW_BAR, MISC + 8);
#define IN(k) (lo <= (k) && (k) < hi)
#define SEAM(k) do { if (IN((k) + 1)) { XcdBarrier b2_; b2_.bar = WSP(unsigned, WS_CTL) + CW_BAR; b2_.x = xb_xcc_id(); b2_.st = (volatile LAS unsigned*)(C.lds + MISC_OFF) + 8; xcd_barrier(b2_); } } while (0)
#define FRESH() do { int t_ = threadIdx.x; asm volatile("" : "+v"(t_)); C.tid = t_; C.lane = t_ & 63; C.wave = __builtin_amdgcn_readfirstlane(t_ >> 6); } while (0)
#define PHASE(bit, k) if (PM(bit) && IN(pb + (k))) for (int rep_ = 0; rep_ < NREP(bit); ++rep_)
#define CLAIM(qh, var) __syncthreads(); if (C.tid == 0) *qslot = atomicAdd((qh), 1u); __syncthreads(); const int var = (int)*qslot;

    LAS unsigned* qslot = (LAS unsigned*)(C.lds + MISC_OFF + 128);
    if (PM(20) && IN(0)) { phase_pre(C); SEAM(0); }

#pragma unroll 1
    for (int l = 0; l < DEPTH; ++l) {
        const int pb = 1 + l * NPH_L;
        if (hi <= pb || lo >= pb + NPH_L) continue;
        const bool last = (l == DEPTH - 1), moe = (l & 1);
        const int nrows = last ? T_LAT : T_ALL;
        const float* xlat = (l == 0) ? C.in[I_X] : C.out; const float* xctx = (l == 0) ? C.in[I_CTX] : WSP(const float, WS_XC);
        const float* modv = WSP(const float, WS_MODV) + (size_t)l * 9 * 6144;
        unsigned* qbase = WSP(unsigned, WS_CTL) + CW_PREPQ + 256 * l;

        if (!(l >= 2 && !(l & 1))) PHASE(0, 0) { FRESH();
            convert_small(C, l);
            if (l == 0) { FRESH(); convert_items(C, 0, 3, C.wg * NWAVES + C.wave, C.G * NWAVES); }
            __syncthreads();
            FRESH(); norm_rows<false>(C, l, xlat, xctx, C.in[I_NMIXG] + l * 1024, 0, 1024, T_ALL, 0);
            SEAM(pb + 0);
        }
        PHASE(1, 1) { FRESH();
            pg8::Gemm g{WSP(const bf16, WS_HB), WSP(const bf16, WS_WIN), T_ALL, PLD, 1024, 0};
            pg8::StaticOrder S; S.init(T_ALL, PLD, C.G, C.wg);
            pg8::EpiBf16<0> E{WSP(bf16, WS_P), PLD, nullptr, 0, 0};
            pg8::gemm_phase<pg8::EpiBf16<0>, pg8::StaticOrder, false>(C.lds, g, S, E, nullptr);
            SEAM(pb + 1);
        }
        if (PM(2) && IN(pb + 2)) for (int rep_ = 0; rep_ < NREP(2); ++rep_) { FRESH();
            for (;;) {
                CLAIM(qbase + 16 * rep_, k)
                if (k >= 3 * NB * NCH) break;
                const int kind = k / (NB * NCH), u = k % (NB * NCH);
                FRESH();
                if (kind == 0) { for (int r3_ = 0; r3_ < NREP(24); ++r3_) { FRESH(); if (SK(1)) rwkv_prep2(C, l, u / NCH, u % NCH); } }
                else if (kind == 1) { for (int r3_ = 0; r3_ < NREP(25); ++r3_) { FRESH(); if (SK(0)) lru_chunk_mfma<false>(C, l, u / NCH, u % NCH); } }
                else { for (int r3_ = 0; r3_ < NREP(26); ++r3_) { FRESH(); if (SK(2)) gdn_prep(C, l, u / NCH, u % NCH); } }
            }
            SEAM(pb + 2);
        }
        if (PM(3) && IN(pb + 3)) for (int rep_ = 0; rep_ < NREP(3); ++rep_) { FRESH();
            constexpr int NCL = 2 * NB * NH * NCH / 4;
            for (;;) {
                CLAIM(qbase + 64 + 16 * rep_, k)
                if (k >= (RW_VSPLIT ? NCL : 2 * NCL)) break;
                FRESH();
                if (k < NCL) { if (SK(9)) gdn_solve_item(C, l, 4 * k + (C.wave >> 1)); }
                else { if (SK(10)) rwkv_solve_item(C, l, 4 * (k - NCL) + (C.wave >> 1)); }
            }
            FRESH(); if (SK(6) && C.wg < 8) lru_carry(C, C.wg * NTHR + C.tid);
            SEAM(pb + (RW_VSPLIT ? 3 : 4));
        }
#if RW_VSPLIT
        if (PM(3) && IN(pb + 4)) { FRESH();
            for (;;) {
                CLAIM(qbase + 128, k)
                if (k >= 2 * NB * NH * NCH / 4) break;
                FRESH();
                if (SK(10)) rwkv_solve_item(C, l, 4 * k + (C.wave >> 1));
            }
            SEAM(pb + 4);
        }
#endif
        if (PM(4) && IN(pb + 5)) { FRESH();
            if (SK(3) && C.wg < (RW_VSPLIT ? 128 : 64)) { if (NREP(20) > 1) { FRESH(); rwkv_chunked<true>(C, l, C.wg); } FRESH(); rwkv_chunked<false>(C, l, C.wg); }
            else if (SK(4) && C.wg >= 128 && C.wg < 192) { for (int r2_ = 0; r2_ < NREP(21); ++r2_) { FRESH(); mlstm_chunked(C, l, C.wg - 128); } }
            else if (SK(5) && C.wg >= 192) { if (NREP(22) > 1) { FRESH(); gdn_chunked<true>(C, l, C.wg - 192); } FRESH(); gdn_chunked<false>(C, l, C.wg - 192); }
            {
                FRESH();
                const int nun = last ? NB * 64 : NB * NCH;
                for (;;) {
                    CLAIM(qbase + 192, u0)
                    if (u0 >= 128 + nun) break;
                    if (u0 < 128) {
                        FRESH(); if (l > 0) convert_items(C, l, 2, u0 * NWAVES + C.wave, 128 * NWAVES);
                        if (l + 1 < DEPTH) { FRESH(); convert_items(C, l + 1, 1, u0 * NWAVES + C.wave, 128 * NWAVES); }
                    } else {
                        const int u = u0 - 128;
                        const int b = last ? (u >> 6) : (u / NCH), c = last ? 4 + (u & 63) : (u % NCH);
                        if (SK(7)) lru_chunk_mfma<true>(C, l, b, c);
                    }
                }
            }
            SEAM(pb + 5);
        }
        PHASE(5, 6) { FRESH();
            if (SK(8)) finish_rows(C, l, nrows);
            SEAM(pb + 6);
        }
        if (PM(6) && IN(pb + 7)) { FRESH();
            pg8::Gemm g{WSP(const bf16, WS_HB), WSP(const bf16, WS_WOUT), nrows, 1024, 1024, 0};
            pg8::StaticOrder S; S.init(nrows, 1024, C.G, C.wg);
            pg8::EpiRes E{xlat, xctx, C.out, WSP(float, WS_XC), modv + 2 * 1024};
            pg8::gemm_phase<pg8::EpiRes, pg8::StaticOrder, false>(C.lds, g, S, E, nullptr);
            SEAM(pb + 7);
        }
        if (PM(7) && IN(pb + 8)) { FRESH();
            if (moe) norm_rows<true>(C, l, C.out, WSP(const float, WS_XC), C.in[I_NFFNG] + l * 1024, 3 * 1024, 4 * 1024, nrows, l >> 1);
            else norm_rows<false>(C, l, C.out, WSP(const float, WS_XC), C.in[I_NFFNG] + l * 1024, 3 * 1024, 4 * 1024, nrows, 0);
            SEAM(pb + 8);
        }
        if (!moe) {
            if (PM(8) && IN(pb + 9)) for (int rep_ = 0; rep_ < NREP(8); ++rep_) { FRESH();
                pg8::Gemm g{WSP(const bf16, WS_HB), WSP(const bf16, WS_WGU), nrows, 2 * DFF, 1024, 0};
                pg8::StaticOrder S; S.init(nrows, 2 * DFF, C.G, C.wg);
                pg8::EpiSwiglu E{WSP(bf16, WS_P), DFF};
                pg8::gemm_phase<pg8::EpiSwiglu, pg8::StaticOrder, false>(C.lds, g, S, E, nullptr);
                SEAM(pb + 9);
            }
            if (PM(9) && IN(pb + 10)) { FRESH();
                pg8::Gemm g{WSP(const bf16, WS_P), WSP(const bf16, WS_WDN), nrows, 1024, DFF, 0};
                pg8::StaticOrder S; S.init(nrows, 1024, C.G, C.wg);
                pg8::EpiRes E{C.out, WSP(const float, WS_XC), C.out, WSP(float, WS_XC), modv + 5 * 1024};
                pg8::gemm_phase<pg8::EpiRes, pg8::StaticOrder, false>(C.lds, g, S, E, nullptr);
                SEAM(pb + 12);
            }
        } else {
            if (PM(10) && IN(pb + 9)) { FRESH(); moe_scatter(C, l >> 1, nrows); SEAM(pb + 9); }
            if (PM(11) && IN(pb + 10)) for (int rep_ = 0; rep_ < NREP(11); ++rep_) { FRESH();
                pg8::Gemm g{WSP(const bf16, WS_HB), WSP(const bf16, WS_WGU), 0, 2 * DFE, 1024, (size_t)2 * DFE * 1024};
                pg8::MoeOrderG S; S.init(WSP(const int, WS_TAB), (2 * DFE) / 256, C.G, C.wg); S.tok = WSP(const int, WS_TOK);
                pg8::EpiSwiglu E{WSP(bf16, WS_P), DFE};
                pg8::gemm_phase<pg8::EpiSwiglu, pg8::MoeOrderG, false>(C.lds, g, S, E, nullptr);
                SEAM(pb + 10);
            }
            if (PM(12) && IN(pb + 11)) for (int rep_ = 0; rep_ < NREP(12); ++rep_) { FRESH();
                pg8::Gemm g{WSP(const bf16, WS_P), WSP(const bf16, WS_WDN), 0, 1024, DFE, (size_t)1024 * DFE};
                pg8::MoeOrder S; S.init(WSP(const int, WS_TAB), 4, C.G, C.wg);
                pg8::EpiBf16<0> E{WSP(bf16, WS_MIX), 1024, nullptr, 0, 0};
                pg8::gemm_phase<pg8::EpiBf16<0>, pg8::MoeOrder, false>(C.lds, g, S, E, nullptr);
                SEAM(pb + 11);
            }
            if (PM(13) && IN(pb + 12)) { FRESH();
                if (last) moe_combine<2>(C, l, nrows);
                else { convert_small(C, l + 1); FRESH(); moe_combine<1>(C, l, nrows); if (IN(pb + NPH_L + 1)) { XcdBarrier b2_; b2_.bar = WSP(unsigned, WS_CTL) + CW_BAR; b2_.x = xb_xcc_id(); b2_.st = (volatile LAS unsigned*)(C.lds + MISC_OFF) + 8; xcd_barrier(b2_); } }
            }
        }
    }
}

extern "C" void kernel_launch(void* const* d_in, const int* in_sizes, int n_in, void* d_out, int out_size, void* d_ws, size_t ws_size, hipStream_t stream) {
    static int grid = 0;
    if (grid == 0) {
        if (n_in != N_IN || in_sizes[0] != T_LAT * DM || out_size != T_LAT * DM || ws_size < WS_END) {
            fprintf(stderr, "kernel_launch: unexpected problem (n_in %d, in0 %d, out %d, ws %zu < %zu)\n", n_in, n_in > 0 ? in_sizes[0] : -1, out_size, ws_size, (size_t)WS_END); grid = -1; return; }
        int dev = 0, cus = 0, per_cu = 0;
        if (hipGetDevice(&dev) != hipSuccess || hipDeviceGetAttribute(&cus, hipDeviceAttributeMultiprocessorCount, dev) != hipSuccess) { grid = -1; return; }
        if (hipFuncSetAttribute((const void*)fwd_kernel, hipFuncAttributeMaxDynamicSharedMemorySize, LDS_BYTES) != hipSuccess) { fprintf(stderr, "kernel_launch: hipFuncSetAttribute failed\n"); grid = -1; return; }
        if (hipOccupancyMaxActiveBlocksPerMultiprocessor(&per_cu, (const void*)fwd_kernel, NTHR, LDS_BYTES) != hipSuccess || per_cu < 1) { fprintf(stderr, "kernel_launch: occupancy query says %d\n", per_cu); grid = -1; return; }
        grid = cus;
        if (grid != 256) fprintf(stderr, "kernel_launch: note: %d CUs\n", grid);
    }
    if (grid < 0) return;
    if (hipMemsetAsync((char*)d_ws + WS_CTL, 0, CTL_BYTES, stream) != hipSuccess) return;
    Args a{};
    for (int i = 0; i < N_IN; ++i) a.in[i] = (const float*)d_in[i];
    a.out = (float*)d_out; a.ws = (unsigned char*)d_ws;
#if MK_ONE_LAUNCH
    a.ph_lo = 0; a.ph_hi = NPHASE;
    hipLaunchKernelGGL(fwd_kernel, dim3(grid), dim3(NTHR), LDS_BYTES, stream, a);
#else
    for (int ph = 0; ph < NPHASE; ++ph) { if (!phase_exists(ph)) continue; a.ph_lo = ph; a.ph_hi = ph + 1; hipLaunchKernelGGL(fwd_kernel, dim3(grid), dim3(NTHR), LDS_BYTES, stream, a); }
#endif
}
```

```cpp
#define MK_ONE_LAUNCH 1
#include <hip/hip_runtime.h>
#include <cstdio>
#include <cstdint>

#define GAS __attribute__((address_space(1)))
#define LAS __attribute__((address_space(3)))
typedef unsigned short bf16;
typedef unsigned v4u __attribute__((ext_vector_type(4)));
typedef unsigned v2u __attribute__((ext_vector_type(2)));
typedef float f32x4 __attribute__((ext_vector_type(4)));
typedef float f32x2 __attribute__((ext_vector_type(2)));
typedef short bf16x8 __attribute__((ext_vector_type(8)));
#define LDS_WAIT() asm volatile("s_waitcnt lgkmcnt(0)" ::: "memory")
#define VM_WAIT() asm volatile("s_waitcnt vmcnt(0)" ::: "memory")

constexpr int DM = 1024, NB = 8, SEQ = 4096, DEPTH = 4, CTXL = 256, GW = 256, HD = 64, NH = 4;
constexpr int T_LAT = NB * SEQ, T_CTX = NB * CTXL, T_ALL = T_LAT + T_CTX;
constexpr int IN_COLS = 3552, PLD = 3584;
constexpr int OFF_B = 512, OFF_C = 1472, OFF_D = 2512, B_COLS = 960;
constexpr int DFF = 2816, NE = 8, DFE = 1408;
constexpr int NCH = 68;
constexpr int NSTEP = 4352;
constexpr int MOE_MAXBLK = 280;
constexpr int NWAVES = 8, NTHR = 512;
#ifndef RW_VSPLIT
#define RW_VSPLIT 0
#endif

constexpr size_t MiB = 1u << 20;
constexpr size_t WS_CTL = 0, CTL_BYTES = 1 * MiB;
constexpr size_t WS_MODV = 1 * MiB;
constexpr size_t WS_XC = 2 * MiB;
constexpr size_t WS_WIN = 10 * MiB;
constexpr size_t WS_WOUT = 17 * MiB;
constexpr size_t WS_WGU = 19 * MiB;
constexpr size_t WS_WDN = 63 * MiB;
constexpr size_t WS_HB = 85 * MiB;
constexpr size_t WS_P = 153 * MiB;
constexpr size_t WS_MIX = 391 * MiB;
constexpr size_t WS_OUTB = WS_MIX, WS_OUTC = WS_MIX + 34 * MiB, WS_OUTD = WS_MIX + 68 * MiB, WS_GQ = WS_MIX + 102 * MiB, WS_G = WS_MIX + 153 * MiB;
constexpr size_t WS_RKV = WS_MIX + 170 * MiB;
constexpr size_t WS_SMALL = 612 * MiB;
constexpr size_t WS_LSUM = WS_SMALL;
constexpr size_t WS_HIN = WS_SMALL + 3 * MiB;
constexpr size_t WS_ROUTE = WS_SMALL + 5 * MiB;
constexpr size_t WS_POS = WS_SMALL + 7 * MiB;
constexpr size_t WS_TOK = WS_POS + 512 * 1024;
constexpr size_t WS_BONUS = WS_SMALL + 8 * MiB;
constexpr size_t WS_WGBASE = WS_SMALL + 9 * MiB;
constexpr size_t WS_TAB = WS_WGBASE + 65536;
constexpr size_t WS_LRUWT = WS_SMALL + 10 * MiB;
constexpr size_t WS_RWT = WS_LRUWT + 131072;
constexpr size_t WS_RINV = WS_SMALL + 11 * MiB;
constexpr size_t WS_END = 624 * MiB;
constexpr int CW_MOECNT = 1024;
constexpr int CW_PREPQ = 2048;
constexpr int CW_BAR = 4096;

constexpr int LDS_BYTES = 135168;
constexpr int MISC_OFF = 131072;

__device__ __forceinline__ unsigned f2bf(float f) { unsigned u = __builtin_bit_cast(unsigned, f); return (u + 0x7fffu + ((u >> 16) & 1u)) >> 16; }
typedef __bf16 bf16n2 __attribute__((ext_vector_type(2)));
__device__ __forceinline__ unsigned pk2(float lo, float hi) { const f32x2 v = {lo, hi}; return __builtin_bit_cast(unsigned, __builtin_convertvector(v, bf16n2)); }
__device__ __forceinline__ unsigned f2bf1(float f) { return pk2(f, f) & 0xffffu; }
__device__ __forceinline__ float bf2f(unsigned short v) { return __builtin_bit_cast(float, (unsigned)v << 16); }
__device__ __forceinline__ float bflo(unsigned v) { return __builtin_bit_cast(float, v << 16); }
__device__ __forceinline__ float bfhi(unsigned v) { return __builtin_bit_cast(float, v & 0xffff0000u); }
template <int CTRL, int RM, bool BC> __device__ __forceinline__ float dpp_x(float oldv, float v) { return __builtin_bit_cast(float, __builtin_amdgcn_update_dpp(__builtin_bit_cast(int, oldv), __builtin_bit_cast(int, v), CTRL, RM, 0xF, BC)); }
__device__ __forceinline__ float wave_sum(float v) {
    v += dpp_x<0xB1, 0xF, true>(0.f, v); v += dpp_x<0x4E, 0xF, true>(0.f, v); v += dpp_x<0x141, 0xF, true>(0.f, v); v += dpp_x<0x140, 0xF, true>(0.f, v);
    v += dpp_x<0x142, 0xA, false>(0.f, v); v += dpp_x<0x143, 0xC, false>(0.f, v);
    return __builtin_bit_cast(float, __builtin_amdgcn_readlane(__builtin_bit_cast(int, v), 63));
}
template <int CTRL> __device__ __forceinline__ float dpp_f(float v) { return __builtin_bit_cast(float, __builtin_amdgcn_update_dpp(0, __builtin_bit_cast(int, v), CTRL, 0xF, 0xF, true)); }
__device__ __forceinline__ float row16_sum(float v) {
    v += dpp_f<0xB1>(v);
    v += dpp_f<0x4E>(v);
    v += dpp_f<0x141>(v);
    v += dpp_f<0x140>(v);
    return v;
}
__device__ __forceinline__ float sigmoidf_(float x) { return __builtin_amdgcn_rcpf(1.0f + __expf(-x)); }
__device__ __forceinline__ float softplusf_(float x) { return fmaxf(x, 0.f) + __logf(1.0f + __expf(-fabsf(x))); }
__device__ __forceinline__ float expm1f_(float x) { return x > -0.3f ? x * (1.0f + x * (0.5f + x * (0.16666667f + x * (0.041666668f + x * 0.0083333338f)))) : __expf(x) - 1.0f; }
__device__ __forceinline__ float siluf_(float x) { return x * __builtin_amdgcn_rcpf(1.0f + __expf(-x)); }
__device__ __forceinline__ float tanhf_(float x) { const float e = __expf(2.0f * x); return 1.0f - 2.0f * __builtin_amdgcn_rcpf(e + 1.0f); }
__device__ __forceinline__ float rsqrtf_(float x) { return __builtin_amdgcn_rsqf(x); }
__device__ __forceinline__ float gelu_tanh(float x) { return 0.5f * x * (1.0f + tanhf_(0.7978845608028654f * (x + 0.044715f * x * x * x))); }
__device__ __forceinline__ f32x4 ld4bf(const bf16* p) { const v2u a = *(const v2u*)p; return (f32x4){bflo(a.x), bfhi(a.x), bflo(a.y), bfhi(a.y)}; }
__device__ __forceinline__ void st4bf(bf16* p, const f32x4& v) { v2u o; o.x = pk2(v.x, v.y); o.y = pk2(v.z, v.w); *(v2u*)p = o; }
#define XB_TMO      128
#define XB_XCNT(j)  (256  + 64 * (j))
#define XB_XSUB(j)  (1280 + 64 * (j))
#define XB_XGEN(j)  (2304 + 64 * (j))
#define XB_TOP      3328
#define XB_TOPGEN   3392
#define XCD_BAR_WORDS 3456
#define XB_SPIN_CAP (1u << 22)

__device__ __forceinline__ unsigned xb_ld(unsigned* p)              { return __hip_atomic_load(p, __ATOMIC_RELAXED, __HIP_MEMORY_SCOPE_AGENT); }
__device__ __forceinline__ unsigned xb_add(unsigned* p, unsigned v) { return __hip_atomic_fetch_add(p, v, __ATOMIC_RELAXED, __HIP_MEMORY_SCOPE_AGENT); }
__device__ __forceinline__ unsigned xb_xcc_id() { return (unsigned)__builtin_amdgcn_s_getreg((3 << 11) | 20) & 0xFu; }
#define XB_SPIN(cond, bar) do { unsigned _sp = 0; while (cond) { __builtin_amdgcn_s_sleep(1); \
    if ((++_sp & 255u) == 0u) { if (xb_ld(&(bar)[XB_TMO])) break; if (_sp > XB_SPIN_CAP) { atomicAdd(&(bar)[XB_TMO], 1u); break; } } } } while (0)

struct XcdBarrier {
    unsigned* bar; unsigned x;
    volatile LAS unsigned* st;
};

__device__ __forceinline__ XcdBarrier xcd_barrier_post(unsigned* bar, volatile LAS unsigned* st) {
    XcdBarrier b; b.bar = bar; b.x = xb_xcc_id(); b.st = st;
    if (threadIdx.x == 0) (void)xb_add(&bar[XB_XCNT(b.x)], 1u);
    return b;
}
__device__ __forceinline__ void xcd_barrier_complete(unsigned* bar, unsigned x, unsigned& nloc, unsigned& nx) {
    const unsigned G = gridDim.x * gridDim.y * gridDim.z;
    unsigned sum, cnt, mine, sp = 0u;
    for (;;) {
        sum = 0u; cnt = 0u; mine = 0u;
#pragma unroll
        for (unsigned j = 0; j < 16; ++j) { const unsigned c = xb_ld(&bar[XB_XCNT(j)]); sum += c; cnt += (c > 0u) ? 1u : 0u; mine = (j == x) ? c : mine; }
        if (sum == G) break;
        __builtin_amdgcn_s_sleep(1);
        if ((++sp & 255u) == 0u) { if (xb_ld(&bar[XB_TMO])) break; if (sp > XB_SPIN_CAP) { atomicAdd(&bar[XB_TMO], 1u); break; } }
    }
    nloc = mine > 0u ? mine : 1u; nx = cnt > 0u ? cnt : 1u;
}

__device__ __forceinline__ void xcd_barrier(const XcdBarrier& b) {
    asm volatile("s_waitcnt vmcnt(0)" ::: "memory");
    __syncthreads();
    if (threadIdx.x == 0) {
        unsigned* bar = b.bar;
        __builtin_amdgcn_s_waitcnt(0);
        unsigned nloc = b.st[0], nx = b.st[1];
        if (nloc == 0u) { xcd_barrier_complete(bar, b.x, nloc, nx); b.st[0] = nloc; b.st[1] = nx; }
        const unsigned old = xb_add(&bar[XB_XSUB(b.x)], 1u);
        const unsigned gen = old / nloc;
        if (old + 1u == (gen + 1u) * nloc) {
            __builtin_amdgcn_fence(__ATOMIC_RELEASE, "agent");
            asm volatile("s_waitcnt vmcnt(0)" ::: "memory");
            const unsigned og = xb_add(&bar[XB_TOP], 1u);
            const unsigned tg = og / nx;
            if (og + 1u == (tg + 1u) * nx) xb_add(&bar[XB_TOPGEN], 1u);
            else XB_SPIN(xb_ld(&bar[XB_TOPGEN]) == tg, bar);
            __builtin_amdgcn_fence(__ATOMIC_ACQUIRE, "agent");
            xb_add(&bar[XB_XGEN(b.x)], 1u);
            asm volatile("s_waitcnt vmcnt(0)" ::: "memory");
        } else {
            XB_SPIN(xb_ld(&bar[XB_XGEN(b.x)]) == gen, bar);
            __builtin_amdgcn_fence(__ATOMIC_ACQUIRE, "agent");
            asm volatile("s_waitcnt vmcnt(0)" ::: "memory");
        }
    }
    __syncthreads();
}

namespace pg8 {
#define PG8_LAS __attribute__((address_space(3)))
typedef unsigned short bf16_t;
typedef short bf16x8 __attribute__((ext_vector_type(8)));
typedef float f32x4 __attribute__((ext_vector_type(4)));
typedef unsigned u32x4 __attribute__((ext_vector_type(4)));
constexpr int BM = 256, BK = 64, HALF = 128, HTB = HALF * BK * 2  , STAGE_BYTES = 8 * HTB, NXCD = 8, WGM = 8;

__host__ __device__ __forceinline__ int lds_byte(int r, int c) { const int st = (r >> 4) * 2 + (c >> 5), rr = r & 15, cc = c & 31, ob = rr * 64 + cc * 2; return st * 1024 + (ob ^ (((ob >> 9) & 1) << 5)); }
__host__ __device__ __forceinline__ void stage_rc(int b, int& R, int& C) { const int st = b / 1024, sb = b % 1024, swz = sb ^ (((sb >> 9) & 1) << 5); R = (st >> 1) * 16 + swz / 64; C = (st & 1) * 32 + (swz % 64) / 2; }
__host__ __device__ __forceinline__ int perm32(int rho) { const int n = rho >> 4, i = rho & 15; return 8 * (i >> 2) + 4 * n + (i & 3); }

struct Unit { int pm, pn, e; };
struct Gemm { const bf16_t* A; const bf16_t* Bt; int M, N, K; size_t estride; };

struct StaticOrder {
    static constexpr bool GATHER = false;
    int nM, nN, nwg, G, c;
    __host__ __device__ void init(int M, int N, int G_, int c_) { nM = M / BM; nN = N / BM; nwg = nM * nN; G = G_; c = c_; }
    __host__ __device__ bool next(int i, Unit& u) const {
        const long L = (long)i * G + c; if (L >= nwg) return false;
        int wgid = (int)L; { const int q = nwg / NXCD, r = nwg % NXCD, xcd = wgid % NXCD, off = wgid / NXCD; wgid = (xcd < r ? xcd * (q + 1) : r * (q + 1) + (xcd - r) * q) + off; }
        const int nig = WGM * nN, gid = wgid / nig, fm = gid * WGM, gsz = (nM - fm) < WGM ? (nM - fm) : WGM;
        u.pm = fm + ((wgid % nig) % gsz); u.pn = (wgid % nig) / gsz; u.e = 0; return true;
    }
    __device__ __forceinline__ void a_ready(const Unit&) const {}
    __device__ __forceinline__ void done(const Unit&) const {}
};
__device__ __forceinline__ unsigned cvt_pk_bf16(float lo, float hi) { unsigned r; asm volatile("v_cvt_pk_bf16_f32 %0, %1, %2" : "=v"(r) : "v"(lo), "v"(hi)); return r; }
typedef float f32x2 __attribute__((ext_vector_type(2)));
__device__ __forceinline__ f32x2 gelu_pk(f32x2 v) {
    const f32x2 av = __builtin_elementwise_abs(v), d = av * 0.2316418882f + 1.0f;
    f32x2 t; t.x = __builtin_amdgcn_rcpf(d.x); t.y = __builtin_amdgcn_rcpf(d.y);
    f32x2 q = t * 0.5307027145f + (-0.7265760135f); q = q * t + 0.7107068705f; q = q * t + (-0.142248368f); q = q * t + 0.127414796f; q = q * t;
    const f32x2 s = (v * v) * (-0.72134752044f);
    f32x2 e; e.x = __builtin_amdgcn_exp2f(s.x); e.y = __builtin_amdgcn_exp2f(s.y);
    const f32x2 m = v * (q * e), r = v - m;
    f32x2 o; o.x = v.x < 0.f ? m.x : r.x; o.y = v.y < 0.f ? m.y : r.y; return o;
}

struct EpiF32 {
    static constexpr bool PERM = false, AFTER_DRAIN = false;
    float* C; int ldc; const float* bias;
    __device__ __forceinline__ void operator()(const f32x4 (&acc)[2][2][4][2], const Unit& u, int wr, int wc, int fr, int fq) const {
        const int row0 = u.pm * BM + wr * 64 + fr, col0 = u.pn * BM + wc * 32 + 4 * fq;
        f32x4 bv[2][2];
#pragma unroll
        for (int bj = 0; bj < 2; ++bj)
#pragma unroll
            for (int n = 0; n < 2; ++n) bv[bj][n] = bias ? *(const f32x4*)(bias + col0 + bj * HALF + n * 16) : (f32x4){0.f, 0.f, 0.f, 0.f};
#pragma unroll
        for (int ai = 0; ai < 2; ++ai)
#pragma unroll
            for (int m = 0; m < 4; ++m) { float* rowp = C + (size_t)(row0 + ai * HALF + m * 16) * ldc + col0;
#pragma unroll
                for (int bj = 0; bj < 2; ++bj)
#pragma unroll
                    for (int n = 0; n < 2; ++n) *(f32x4*)(rowp + bj * HALF + n * 16) = acc[ai][bj][m][n] + bv[bj][n]; }
    }
};
template <int ACT  > struct EpiBf16 {
    static constexpr bool PERM = true, AFTER_DRAIN = false;
    bf16_t* O; int ldc; const float* bias; int split_cols; size_t split_stride;
    __device__ __forceinline__ void operator()(const f32x4 (&acc)[2][2][4][2], const Unit& u, int wr, int wc, int fr, int fq) const {
        const int row0 = u.pm * BM + wr * 64 + fr; int colt = u.pn * BM; bf16_t* base = O;
        if (split_cols) { const int t = colt / split_cols; base += (size_t)t * split_stride; colt -= t * split_cols; }
        const int col0 = colt + wc * 32 + 8 * fq, bcol0 = u.pn * BM + wc * 32 + 8 * fq;
        f32x4 bv[2][2];
#pragma unroll
        for (int bj = 0; bj < 2; ++bj)
#pragma unroll
            for (int n = 0; n < 2; ++n) bv[bj][n] = bias ? *(const f32x4*)(bias + bcol0 + bj * HALF + 4 * n) : (f32x4){0.f, 0.f, 0.f, 0.f};
#pragma unroll
        for (int ai = 0; ai < 2; ++ai)
#pragma unroll
            for (int m = 0; m < 4; ++m) { bf16_t* rowp = base + (size_t)(row0 + ai * HALF + m * 16) * ldc + col0;
#pragma unroll
                for (int bj = 0; bj < 2; ++bj) { f32x4 v0 = acc[ai][bj][m][0] + bv[bj][0], v1 = acc[ai][bj][m][1] + bv[bj][1];
                    if (ACT == 1) { f32x2 a = gelu_pk((f32x2){v0[0], v0[1]}), b = gelu_pk((f32x2){v0[2], v0[3]}), c = gelu_pk((f32x2){v1[0], v1[1]}), d = gelu_pk((f32x2){v1[2], v1[3]});
                        v0 = (f32x4){a.x, a.y, b.x, b.y}; v1 = (f32x4){c.x, c.y, d.x, d.y}; }
                    if (ACT == 2) {
#pragma unroll
                        for (int j = 0; j < 4; ++j) { v0[j] = 0.5f * v0[j] * (1.0f + erff(v0[j] * 0.70710678f)); v1[j] = 0.5f * v1[j] * (1.0f + erff(v1[j] * 0.70710678f)); } }
                    u32x4 w; w.x = cvt_pk_bf16(v0[0], v0[1]); w.y = cvt_pk_bf16(v0[2], v0[3]); w.z = cvt_pk_bf16(v1[0], v1[1]); w.w = cvt_pk_bf16(v1[2], v1[3]);
                    *(u32x4*)(rowp + bj * HALF) = w; } }
    }
};

template <class Epi, class Sched, bool STAMP = false>
__device__ __forceinline__ void gemm_phase(PG8_LAS unsigned char* lds, const Gemm g, const Sched& S, const Epi& E, unsigned long long* stamps) {
    int tid_ = threadIdx.x; asm volatile("" : "+v"(tid_));
    const int tid = tid_, wid = __builtin_amdgcn_readfirstlane(tid >> 6), lane = tid & 63, wr = wid >> 2, wc = wid & 3, fr = lane & 15, fq = lane >> 4;
    const int K = g.K, nt = K / BK;
    constexpr bool GATHER = Sched::GATHER;
    int ts_lo = 0, ts_hi = 0, nts = 0; const unsigned long long rt_entry = STAMP ? (unsigned long long)wall_clock64() : 0ull;
#define PG8_STAMP() do { if (STAMP && wid == 0 && nts < 64) { const unsigned long long _c = (unsigned long long)clock64(); \
        ts_lo = (lane == nts) ? (int)(unsigned)_c : ts_lo; ts_hi = (lane == nts) ? (int)(unsigned)(_c >> 32) : ts_hi; ++nts; } } while (0)
    PG8_STAMP();
    unsigned voffA[2], voffB[2]; int rowA[2];
#pragma unroll
    for (int i = 0; i < 2; ++i) { int R, C; stage_rc(tid * 16 + i * 8192, R, C); const int Rb = Epi::PERM ? ((R & ~31) + perm32(R & 31)) : R;
        rowA[i] = R; voffA[i] = GATHER ? (unsigned)C * 2u : (unsigned)(R * K + C) * 2u; voffB[i] = (unsigned)(Rb * K + C) * 2u; }
    const size_t kstep = (size_t)(BK * 2);
    const size_t hstep = (size_t)HALF * K * 2;
    const size_t tstep = 2 * hstep;
    const unsigned ldsw = (unsigned)wid * 1024u;
    const int aoff = lds_byte(wr * 64 + fr, fq * 8), boff = lds_byte(wc * 32 + fr, fq * 8);
#define PG8_SA(b, h) (((b) * 2 + (h)) * HTB)
#define PG8_SB(b, h) ((4 + (b) * 2 + (h)) * HTB)
#define PG8_STAGE(bufoff, gbase, voff) do { _Pragma("unroll") for (int _i = 0; _i < 2; ++_i) \
        __builtin_amdgcn_global_load_lds((const unsigned*)((const char*)(gbase) + (voff)[_i]), (PG8_LAS unsigned*)(lds + (bufoff) + ldsw + _i * 8192), 16, 0, 0); } while (0)
#define PG8_STAGE_A(bufoff, gbase, h, gv) do { if constexpr (GATHER) { PG8_STAGE(bufoff, gbase, (gv)[h]); } else { PG8_STAGE(bufoff, (gbase) + (h) * hstep, voffA); } } while (0)
#define PG8_TOKSLOT(s) ((PG8_LAS int*)(lds + STAGE_BYTES + 1024 + ((s) & 1) * 1024))
#define PG8_LDA(dst, b, h) do { _Pragma("unroll") for (int m = 0; m < 4; ++m) _Pragma("unroll") for (int k = 0; k < 2; ++k) dst[m][k] = *(const PG8_LAS bf16x8*)(lds + PG8_SA(b, h) + aoff + m * 2048 + k * 1024); } while (0)
#define PG8_LDB(dst, b, h) do { _Pragma("unroll") for (int n = 0; n < 2; ++n) _Pragma("unroll") for (int k = 0; k < 2; ++k) dst[n][k] = *(const PG8_LAS bf16x8*)(lds + PG8_SB(b, h) + boff + n * 2048 + k * 1024); } while (0)
#define PG8_MMA(ai, bj, At, Bt) do { __builtin_amdgcn_s_setprio(1); _Pragma("unroll") for (int m = 0; m < 4; ++m) _Pragma("unroll") for (int n = 0; n < 2; ++n) _Pragma("unroll") for (int k = 0; k < 2; ++k) \
        acc[ai][bj][m][n] = __builtin_amdgcn_mfma_f32_16x16x32_bf16(Bt[n][k], At[m][k], acc[ai][bj][m][n], 0, 0, 0); __builtin_amdgcn_s_setprio(0); } while (0)
#define PG8_WAIT_V(n) asm volatile("s_waitcnt vmcnt(" #n ")" ::: "memory")
#define PG8_WAIT_L(n) asm volatile("s_waitcnt lgkmcnt(" #n ")" ::: "memory")
#define PG8_BAR __builtin_amdgcn_s_barrier()
#define PG8_SCHED __builtin_amdgcn_sched_barrier(0)
    Unit cur, nxt; int ui = 0;
    if (!S.next(0, cur)) return;
    f32x4 acc[2][2][4][2];
#pragma unroll
    for (int a = 0; a < 2; ++a)
#pragma unroll
        for (int b = 0; b < 2; ++b)
#pragma unroll
            for (int m = 0; m < 4; ++m)
#pragma unroll
                for (int n = 0; n < 2; ++n) acc[a][b][m][n] = (f32x4){0.f, 0.f, 0.f, 0.f};
    bf16x8 At[4][2], B0[2][2], B1[2][2];
    const char* cA = (const char*)g.A + (GATHER ? (size_t)0 : (size_t)cur.pm * tstep); const char* cB = (const char*)g.Bt + (size_t)cur.pn * tstep + (size_t)cur.e * g.estride * 2;
    S.a_ready(cur);
    unsigned gcur[2][2], gnxt[2][2], gs[2][2];
    if constexpr (GATHER) {
        if (tid < 256) PG8_TOKSLOT(0)[tid] = S.tok[cur.pm * 256 + tid];
        __syncthreads();
#pragma unroll
        for (int h = 0; h < 2; ++h)
#pragma unroll
            for (int i = 0; i < 2; ++i) { gcur[h][i] = (unsigned)PG8_TOKSLOT(0)[h * HALF + rowA[i]] * (unsigned)(K * 2) + voffA[i]; gnxt[h][i] = gcur[h][i]; gs[h][i] = gcur[h][i]; }
    }
    PG8_STAGE(PG8_SB(0, 0), cB, voffB); PG8_STAGE_A(PG8_SA(0, 0), cA, 0, gcur); PG8_STAGE(PG8_SB(0, 1), cB + hstep, voffB); PG8_STAGE_A(PG8_SA(0, 1), cA, 1, gcur);
    if (wr == 1) PG8_BAR;
    PG8_WAIT_V(4); PG8_BAR;
    PG8_STAGE(PG8_SB(1, 0), cB + kstep, voffB); PG8_STAGE_A(PG8_SA(1, 0), cA + kstep, 0, gcur); PG8_STAGE(PG8_SB(1, 1), cB + hstep + kstep, voffB);
    PG8_WAIT_V(6); PG8_BAR;
    PG8_STAMP();
    for (;;) {
        const bool has_next = S.next(ui + 1, nxt);
        if constexpr (GATHER) { if (has_next && wid < 4)
            __builtin_amdgcn_global_load_lds((const unsigned*)(S.tok + nxt.pm * 256 + wid * 64 + lane), (PG8_LAS unsigned*)((PG8_LAS unsigned char*)PG8_TOKSLOT(ui + 1) + wid * 256), 4, 0, 0); }
        const char* nA = GATHER ? (const char*)g.A : has_next ? (const char*)g.A + (size_t)nxt.pm * tstep : cA; const char* nB = has_next ? (const char*)g.Bt + (size_t)nxt.pn * tstep + (size_t)nxt.e * g.estride * 2 : cB;
        for (int t = 0; t < nt; t += 2) {
            const bool last = (t == nt - 2);
            const char* a1 = cA + (size_t)(t + 1) * kstep;
            const char* a2 = last ? nA : cA + (size_t)(t + 2) * kstep; const char* b2 = last ? nB : cB + (size_t)(t + 2) * kstep;
            const char* a3 = a2 + kstep; const char* b3 = b2 + kstep;
            if (last && has_next) S.a_ready(nxt);
            if constexpr (GATHER) {
                if (last && has_next) {
#pragma unroll
                    for (int h = 0; h < 2; ++h)
#pragma unroll
                        for (int i = 0; i < 2; ++i) gnxt[h][i] = (unsigned)PG8_TOKSLOT(ui + 1)[h * HALF + rowA[i]] * (unsigned)(K * 2) + voffA[i];
                }
#pragma unroll
                for (int h = 0; h < 2; ++h)
#pragma unroll
                    for (int i = 0; i < 2; ++i) gs[h][i] = last ? gnxt[h][i] : gcur[h][i];
            }
            PG8_LDB(B0, 0, 0); PG8_SCHED; PG8_LDA(At, 0, 0); PG8_STAGE_A(PG8_SA(1, 1), a1, 1, gcur);
            PG8_WAIT_L(8); PG8_BAR; PG8_WAIT_L(0); PG8_MMA(0, 0, At, B0); PG8_BAR; PG8_SCHED;
            PG8_LDB(B1, 0, 1); PG8_STAGE(PG8_SB(0, 0), b2, voffB);
            PG8_BAR; PG8_WAIT_L(0); PG8_MMA(0, 1, At, B1); PG8_BAR;
            PG8_LDA(At, 0, 1); PG8_STAGE_A(PG8_SA(0, 0), a2, 0, gs);
            PG8_BAR; PG8_WAIT_L(0); PG8_MMA(1, 0, At, B0); PG8_BAR; PG8_SCHED;
            PG8_STAGE(PG8_SB(0, 1), b2 + hstep, voffB);
            PG8_WAIT_V(6); PG8_BAR; PG8_MMA(1, 1, At, B1); PG8_BAR;
            PG8_LDB(B0, 1, 0); PG8_SCHED; PG8_LDA(At, 1, 0); PG8_STAGE_A(PG8_SA(0, 1), a2, 1, gs);
            PG8_WAIT_L(8); PG8_BAR; PG8_WAIT_L(0); PG8_MMA(0, 0, At, B0); PG8_BAR; PG8_SCHED;
            PG8_LDB(B1, 1, 1); PG8_STAGE(PG8_SB(1, 0), b3, voffB);
            PG8_BAR; PG8_WAIT_L(0); PG8_MMA(0, 1, At, B1); PG8_BAR;
            PG8_LDA(At, 1, 1); PG8_STAGE_A(PG8_SA(1, 0), a3, 0, gs);
            PG8_BAR; PG8_WAIT_L(0); PG8_MMA(1, 0, At, B0); PG8_BAR; PG8_SCHED;
            PG8_STAGE(PG8_SB(1, 1), b3 + hstep, voffB);
            PG8_WAIT_V(6); PG8_BAR; PG8_MMA(1, 1, At, B1); PG8_BAR;
        }
        PG8_STAMP();
        if constexpr (!Epi::AFTER_DRAIN) { E(acc, cur, wr, wc, fr, fq); S.done(cur); }
        PG8_STAMP();
        if (!has_next) break;
#pragma unroll
        for (int a = 0; a < 2; ++a)
#pragma unroll
            for (int b = 0; b < 2; ++b)
#pragma unroll
                for (int m = 0; m < 4; ++m)
#pragma unroll
                    for (int n = 0; n < 2; ++n) acc[a][b][m][n] = (f32x4){0.f, 0.f, 0.f, 0.f};
        cur = nxt; cA = nA; cB = nB; ++ui;
        if constexpr (GATHER) {
#pragma unroll
            for (int h = 0; h < 2; ++h)
#pragma unroll
                for (int i = 0; i < 2; ++i) gcur[h][i] = gnxt[h][i];
        }
    }
    PG8_WAIT_V(0);
    if (wr == 0) PG8_BAR;
    PG8_BAR;
    if constexpr (Epi::AFTER_DRAIN) { E.fused(acc, cur, wr, wc, fr, fq, lds, wid, lane); S.done(cur); }
    PG8_STAMP();
    if (STAMP && wid == 0) { stamps[lane] = lane < nts ? (((unsigned long long)(unsigned)ts_hi << 32) | (unsigned)ts_lo) : 0ull;
        if (lane == 62) stamps[62] = rt_entry; if (lane == 63) stamps[63] = (unsigned long long)wall_clock64(); }
#undef PG8_STAMP
#undef PG8_SA
#undef PG8_SB
#undef PG8_STAGE
#undef PG8_STAGE_A
#undef PG8_TOKSLOT
#undef PG8_LDA
#undef PG8_LDB
#undef PG8_MMA
#undef PG8_WAIT_V
#undef PG8_WAIT_L
#undef PG8_BAR
#undef PG8_SCHED
}
}
namespace pg8 {
struct EpiRes {
    static constexpr bool PERM = false, AFTER_DRAIN = false;
    const float* base_lat; const float* base_ctx; float* out_lat; float* out_ctx; const float* gvec;
    __device__ __forceinline__ void operator()(const f32x4 (&acc)[2][2][4][2], const Unit& u, int wr, int wc, int fr, int fq) const {
        const bool isctx = u.pm >= 128;
        const int prow = (isctx ? (u.pm - 128) : u.pm) * BM;
        const float* base = isctx ? base_ctx : base_lat; float* out = isctx ? out_ctx : out_lat;
        const float* gv = gvec + (size_t)(isctx ? 8 : (u.pm >> 4)) * 6144;
        const int row0 = prow + wr * 64 + fr, col0 = u.pn * BM + wc * 32 + 4 * fq;
        f32x4 gvv[2][2];
#pragma unroll
        for (int bj = 0; bj < 2; ++bj)
#pragma unroll
            for (int n = 0; n < 2; ++n) gvv[bj][n] = *(const f32x4*)(gv + col0 + bj * HALF + n * 16);
#pragma unroll
        for (int ai = 0; ai < 2; ++ai)
#pragma unroll
            for (int m = 0; m < 4; ++m) { const size_t off = (size_t)(row0 + ai * HALF + m * 16) * 1024 + col0;
#pragma unroll
                for (int bj = 0; bj < 2; ++bj)
#pragma unroll
                    for (int n = 0; n < 2; ++n) { const f32x4 b = *(const f32x4*)(base + off + bj * HALF + n * 16);
                        *(f32x4*)(out + off + bj * HALF + n * 16) = b + gvv[bj][n] * acc[ai][bj][m][n]; } }
    }
};
struct EpiSwiglu {
    static constexpr bool PERM = true, AFTER_DRAIN = false;
    bf16_t* O; int ldc;
    __device__ __forceinline__ void operator()(const f32x4 (&acc)[2][2][4][2], const Unit& u, int wr, int wc, int fr, int fq) const {
        const int row0 = u.pm * BM + wr * 64 + fr, col0 = u.pn * HALF + wc * 32 + 8 * fq;
#pragma unroll
        for (int ai = 0; ai < 2; ++ai)
#pragma unroll
            for (int m = 0; m < 4; ++m) { bf16_t* rowp = O + (size_t)(row0 + ai * HALF + m * 16) * ldc + col0;
                float h[8];
#pragma unroll
                for (int n = 0; n < 2; ++n)
#pragma unroll
                    for (int j = 0; j < 4; ++j) { const float g = acc[ai][0][m][n][j], up = acc[ai][1][m][n][j]; h[n * 4 + j] = g * __builtin_amdgcn_rcpf(1.0f + __expf(-g)) * up; }
                u32x4 w; w.x = cvt_pk_bf16(h[0], h[1]); w.y = cvt_pk_bf16(h[2], h[3]); w.z = cvt_pk_bf16(h[4], h[5]); w.w = cvt_pk_bf16(h[6], h[7]);
                *(u32x4*)rowp = w; }
    }
};
struct MoeOrder {
    static constexpr bool GATHER = false;
    int nN, G, c, nunits; const int* tab;
    __device__ void init(const int* tab_, int nN_, int G_, int c_) { tab = tab_; nN = nN_; G = G_; c = c_; nunits = tab_[0] * nN_; }
    __device__ bool next(int i, Unit& u) const {
        const int L = i * G + c; if (L >= nunits) return false;
        const int q = nunits / NXCD, r = nunits % NXCD, xcd = L % NXCD, off = L / NXCD;
        const int w = (xcd < r ? xcd * (q + 1) : r * (q + 1) + (xcd - r) * q) + off;
        u.pm = w / nN; u.pn = w - u.pm * nN; u.e = tab[1 + u.pm]; return true;
    }
    __device__ __forceinline__ void a_ready(const Unit&) const {}
    __device__ __forceinline__ void done(const Unit&) const {}
};
struct MoeOrderG : MoeOrder { static constexpr bool GATHER = true; const int* tok; };
}
enum { I_X = 0, I_C, I_CTX, I_CCTX, I_MODW, I_MODB, I_NMIXG, I_NFFNG, I_WIN, I_WOUT, I_LCW, I_LCB, I_LWA, I_LBA, I_LWX, I_LBX, I_LLAM,
       I_RMU, I_RWUP, I_RW0, I_RAUP, I_RA0, I_RGUP, I_RKK, I_RKA, I_RRK, I_RLNG, I_RLNB, I_MIB, I_MFB, I_MNG, I_GCW, I_GALOG, I_GDTB, I_GNG,
       I_FWG, I_FWU, I_FWD, I_MROUTER, I_MWG, I_MWU, I_MWD, I_FNG, N_IN };
struct Args { const float* in[N_IN]; float* out; unsigned char* ws; int ph_lo, ph_hi; };
struct Ctx {
    const float* const* in; float* out; unsigned char* ws; LAS unsigned char* lds;
    int tid, lane, wave, G, wg;
};
#define WSP(T, off) ((T*)(C.ws + (off)))

__device__ __forceinline__ int seqrow_raster(int i, int d, int b) {
    if (i < CTXL) { const int p = d ? (CTXL - 1 - i) : i; return T_LAT + b * CTXL + p; }
    const int j = i - CTXL; const int p = d ? (SEQ - 1 - j) : j; return b * SEQ + p;
}
__device__ __forceinline__ int seqrow_cm(int i, int d, int b) {
    if (i < CTXL) { const int p = d ? (CTXL - 1 - i) : i; return T_LAT + b * CTXL + p; }
    const int j = i - CTXL; const int p = d ? (SEQ - 1 - j) : j; return b * SEQ + (p & 63) * 64 + (p >> 6);
}

__device__ __forceinline__ void phase_pre(const Ctx& C) {
    LAS float* sc = (LAS float*)C.lds;
    LAS float* red = sc + 9 * 1024;
    float* modv = WSP(float, WS_MODV);
    bool filled = false;
    for (int it = C.wg; it < DEPTH * 48; it += C.G) {
        if (!filled) {
            for (int i = C.tid; i < 9 * 1024; i += NTHR) { const float v = i < 8192 ? C.in[I_C][i] : C.in[I_CCTX][i - 8192]; sc[i] = siluf_(v); }
            filled = true; __syncthreads();
        }
        const int l = it / 48, jb = it % 48, col = C.tid & 127, kg = C.tid >> 7;
        const float* W = C.in[I_MODW] + (size_t)l * 1024 * 6144 + jb * 128 + col;
        float acc[9];
#pragma unroll
        for (int r = 0; r < 9; ++r) acc[r] = 0.f;
        for (int k = kg * 256; k < kg * 256 + 256; ++k) { const float w = W[(size_t)k * 6144];
#pragma unroll
            for (int r = 0; r < 9; ++r) acc[r] += sc[r * 1024 + k] * w; }
#pragma unroll
        for (int r = 0; r < 9; ++r) red[(kg * 9 + r) * 128 + col] = acc[r];
        __syncthreads();
        for (int i = C.tid; i < 9 * 128; i += NTHR) { const int r = i >> 7, cc = i & 127;
            const float s = red[(0 * 9 + r) * 128 + cc] + red[(1 * 9 + r) * 128 + cc] + red[(2 * 9 + r) * 128 + cc] + red[(3 * 9 + r) * 128 + cc];
            modv[((size_t)l * 9 + r) * 6144 + jb * 128 + cc] = s + C.in[I_MODB][l * 6144 + jb * 128 + cc]; }
        __syncthreads();
    }
}

__device__ __forceinline__ void tr_item(const float* src, size_t ld, int k0, int ns0, bf16* dst, int drow0, int Kd, LAS float* scr, int lane, bool zero) {
    if (!zero) {
#pragma unroll 8
        for (int i = 0; i < 32; ++i) { const int kk = 2 * i + (lane >> 5); scr[kk * 33 + (lane & 31)] = src[(size_t)(k0 + kk) * ld + ns0 + (lane & 31)]; }
    }
    LDS_WAIT(); asm volatile("" ::: "memory");
    const int c = lane & 7;
#pragma unroll
    for (int j = 0; j < 4; ++j) { const int n = (lane >> 3) + 8 * j; const LAS float* s = scr + (8 * c) * 33 + n;
        v4u o; o.x = pk2(s[0 * 33], s[1 * 33]); o.y = pk2(s[2 * 33], s[3 * 33]); o.z = pk2(s[4 * 33], s[5 * 33]); o.w = pk2(s[6 * 33], s[7 * 33]);
        if (zero) o = (v4u){0u, 0u, 0u, 0u};
        *(v4u*)(dst + (size_t)(drow0 + n) * Kd + k0 + 8 * c) = o; }
    LDS_WAIT(); asm volatile("" ::: "memory");
}
__device__ __forceinline__ void convert_small(const Ctx& C, int l) {
    {
        bf16* lw = WSP(bf16, WS_LRUWT);
        for (int k = 0; k < 2 * 2 * 4 * 4096 / (128 * NTHR); ++k) {
            const int e = k * 128 * NTHR + C.wg * NTHR + C.tid;
            if (C.wg < 128) {
            const int i = e & 63, j = (e >> 6) & 63, hd = (e >> 12) & 3, g = (e >> 14) & 1, d = e >> 15;
            const float* src = (g ? C.in[I_LWX] : C.in[I_LWA]) + ((size_t)((l * 2 + d) * 4 + hd) * 64 + i) * 64 + j;
            lw[e] = (bf16)f2bf(*src);
            }
        }
    }
    if (C.wg >= 128 && C.wg < 224) {
        bf16* rw = WSP(bf16, WS_RWT);
        const int e = (C.wg - 128) * NTHR + C.tid;
        if (e < 32768) { const int r = e & 31, ch = (e >> 5) & 255, d = (e >> 13) & 1, isa = e >> 14;
            rw[e] = (bf16)f2bf((isa ? C.in[I_RAUP] : C.in[I_RWUP])[((size_t)(l * 2 + d) * 32 + r) * GW + ch]); }
        else { const int e2 = e - 32768, j = e2 & 63, ch = e2 >> 6; rw[e] = (bf16)f2bf(C.in[I_RGUP][((size_t)l * 64 + j) * GW + ch]); }
    }
}
__device__ __forceinline__ void convert_items(const Ctx& C, int l, int what, int gw, int NGW) {
    LAS float* scr = (LAS float*)(C.lds + C.wave * 8704);
    constexpr int I_IN = 16 * 112, I_OUT = 16 * 32, I_GU = 16 * 176, I_DN = 44 * 32, I_E = 16 * 88 + 22 * 32;
    const bool moe = l & 1; const int li = l >> 1;
    const int lo_it = (what & 1) ? 0 : I_IN, hi_it = (what & 2) ? I_IN + I_OUT + (moe ? NE * I_E : (I_GU + I_DN)) : I_IN;
    bf16* win = WSP(bf16, WS_WIN); bf16* wout = WSP(bf16, WS_WOUT); bf16* wgu = WSP(bf16, WS_WGU); bf16* wdn = WSP(bf16, WS_WDN);
    for (int it = lo_it + gw; it < hi_it; it += NGW) {
        int r = it;
        if (r < I_IN) { const int kb = r / 112, nb = r % 112; tr_item(C.in[I_WIN] + (size_t)l * 1024 * IN_COLS, IN_COLS, 64 * kb, 32 * nb, win, 32 * nb, 1024, scr, C.lane, nb == 111); continue; }
        r -= I_IN;
        if (r < I_OUT) { const int kb = r / 32, nb = r % 32; tr_item(C.in[I_WOUT] + (size_t)l * 1024 * 1024, 1024, 64 * kb, 32 * nb, wout, 32 * nb, 1024, scr, C.lane, false); continue; }
        r -= I_OUT;
        if (!moe) {
            if (r < I_GU) { const int kb = r / 176, nb = r % 176, tile = nb >> 3, q = nb & 7;
                const float* src = (q < 4 ? C.in[I_FWG] : C.in[I_FWU]) + (size_t)li * 1024 * DFF;
                tr_item(src, DFF, 64 * kb, tile * 128 + (q & 3) * 32, wgu, 32 * nb, 1024, scr, C.lane, false); continue; }
            r -= I_GU;
            { const int kb = r / 32, nb = r % 32; tr_item(C.in[I_FWD] + (size_t)li * DFF * 1024, 1024, 64 * kb, 32 * nb, wdn, 32 * nb, DFF, scr, C.lane, false); }
        } else {
            const int e = r / I_E; int rr = r % I_E;
            if (rr < 16 * 88) { const int kb = rr / 88, nb = rr % 88, tile = nb >> 3, q = nb & 7;
                const float* src = (q < 4 ? C.in[I_MWG] : C.in[I_MWU]) + ((size_t)li * NE + e) * 1024 * DFE;
                tr_item(src, DFE, 64 * kb, tile * 128 + (q & 3) * 32, wgu + (size_t)e * 2 * DFE * 1024, 32 * nb, 1024, scr, C.lane, false); continue; }
            rr -= 16 * 88;
            { const int kb = rr / 32, nb = rr % 32; tr_item(C.in[I_MWD] + ((size_t)li * NE + e) * DFE * 1024, 1024, 64 * kb, 32 * nb, wdn + (size_t)e * 1024 * DFE, 32 * nb, DFE, scr, C.lane, false); }
        }
    }
}

template <bool ROUTE>
__device__ __forceinline__ void norm_rows(const Ctx& C, int l, const float* xlat, const float* xctx, const float* gain, int shoff, int scoff, int nrows, int moe_li) {
    const float* modv = WSP(float, WS_MODV) + (size_t)l * 9 * 6144;
    bf16* hb = WSP(bf16, WS_HB);
    const int gw = C.wg * NWAVES + C.wave, NGW = C.G * NWAVES;
    LAS unsigned* lcnt = (LAS unsigned*)(C.lds + 65536);
    unsigned* route = WSP(unsigned, WS_ROUTE);
    if (ROUTE) { if (C.tid < 8) lcnt[C.tid] = 0u; __syncthreads(); }
    f32x4 gv[4];
#pragma unroll
    for (int j = 0; j < 4; ++j) gv[j] = *(const f32x4*)(gain + 4 * C.lane + 256 * j);
    for (int m = gw; m < nrows; m += NGW) {
        const bool isctx = m >= T_LAT;
        const float* xr = isctx ? xctx + (size_t)(m - T_LAT) * 1024 : xlat + (size_t)m * 1024;
        const float* mv = modv + (size_t)(isctx ? 8 : (m >> 12)) * 6144;
        f32x4 v[4]; float s = 0.f;
#pragma unroll
        for (int j = 0; j < 4; ++j) { v[j] = *(const f32x4*)(xr + 4 * C.lane + 256 * j); s += (v[j].x * v[j].x + v[j].y * v[j].y) + (v[j].z * v[j].z + v[j].w * v[j].w); }
        const float rs = rsqrtf_(wave_sum(s) * (1.0f / 1024.0f) + 1e-6f);
#pragma unroll
        for (int j = 0; j < 4; ++j) { const f32x4 sh = *(const f32x4*)(mv + shoff + 4 * C.lane + 256 * j), scl = *(const f32x4*)(mv + scoff + 4 * C.lane + 256 * j);
            v[j] = (v[j] * rs * gv[j]) * (scl + 1.0f) + sh;
            v2u o; o.x = pk2(v[j].x, v[j].y); o.y = pk2(v[j].z, v[j].w);
            *(v2u*)(hb + (size_t)m * 1024 + 4 * C.lane + 256 * j) = o; }
        if (ROUTE) {
            const float* rt = C.in[I_MROUTER] + (size_t)moe_li * 1024 * NE;
            float lg[8];
#pragma unroll
            for (int e = 0; e < 8; ++e) lg[e] = 0.f;
#pragma unroll
            for (int j = 0; j < 4; ++j)
#pragma unroll
                for (int q = 0; q < 4; ++q) { const int k = 4 * C.lane + 256 * j + q; const f32x4 r0 = *(const f32x4*)(rt + (size_t)k * 8), r1 = *(const f32x4*)(rt + (size_t)k * 8 + 4); const float hv = v[j][q];
                    lg[0] += hv * r0.x; lg[1] += hv * r0.y; lg[2] += hv * r0.z; lg[3] += hv * r0.w; lg[4] += hv * r1.x; lg[5] += hv * r1.y; lg[6] += hv * r1.z; lg[7] += hv * r1.w; }
#pragma unroll
            for (int e = 0; e < 8; ++e) lg[e] = wave_sum(lg[e]);
            int e0 = 0; float l0 = lg[0];
#pragma unroll
            for (int e = 1; e < 8; ++e) if (lg[e] > l0) { l0 = lg[e]; e0 = e; }
            int e1 = (e0 == 0) ? 1 : 0; float l1 = -3.0e38f;
#pragma unroll
            for (int e = 0; e < 8; ++e) if (e != e0 && lg[e] > l1) { l1 = lg[e]; e1 = e; }
            const float w0 = __builtin_amdgcn_rcpf(1.0f + __expf(l1 - l0)), w1 = 1.0f - w0;
            if (C.lane == 0) {
                const unsigned r0 = atomicAdd((unsigned*)&lcnt[e0], 1u), r1 = atomicAdd((unsigned*)&lcnt[e1], 1u);
                v4u a; a.x = (unsigned)e0; a.y = (unsigned)e1; a.z = r0; a.w = r1;
                *(v4u*)(route + (size_t)m * 8) = a;
                v2u b; b.x = __builtin_bit_cast(unsigned, w0); b.y = __builtin_bit_cast(unsigned, w1);
                *(v2u*)(route + (size_t)m * 8 + 4) = b;
            }
        }
    }
    if (ROUTE) {
        __syncthreads();
        if (C.tid < 8) { unsigned* gc = WSP(unsigned, WS_CTL) + CW_MOECNT + 64 * moe_li; const unsigned base = atomicAdd(gc + C.tid, lcnt[C.tid]); WSP(unsigned, WS_WGBASE)[C.wg * 8 + C.tid] = base; }
    }
}
__device__ __forceinline__ void lru_carry(const Ctx& C, int idx) {
    const int ch = idx & 255, d = (idx >> 8) & 1, b = idx >> 9;
    const float* ls = WSP(const float, WS_LSUM); float* hin = WSP(float, WS_HIN);
    float H = 0.f;
    for (int k = 0; k < NCH; ++k) {
        const int c = d ? (k < 4 ? 3 - k : NCH + 3 - k) : k;
        const size_t sidx = ((size_t)(b * NCH + c) * 2 + d) * 256 + ch;
        hin[sidx] = H;
        H = __expf(ls[sidx * 2]) * H + ls[sidx * 2 + 1];
    }
}

#define RAW_BARRIER() do { asm volatile("s_waitcnt lgkmcnt(0)" ::: "memory"); __builtin_amdgcn_s_barrier(); asm volatile("" ::: "memory"); } while (0)
__device__ __forceinline__ void gdn_prep(const Ctx& C, int l, int b, int c) {
    const bf16* P = WSP(const bf16, WS_P); bf16* gq = WSP(bf16, WS_GQ);
    const bool isctx = c < 4; const int p0 = isctx ? c * 64 : (c - 4) * 64; const int Lp = isctx ? CTXL : SEQ;
    const int ch = 4 * C.lane;
    auto rowof = [&](int p) -> int { return isctx ? (T_LAT + b * CTXL + p) : (b * SEQ + (p & 63) * 64 + (p >> 6)); };
    f32x4 cw[4][3], x[4][3];
#pragma unroll
    for (int j = 0; j < 4; ++j)
#pragma unroll
        for (int g = 0; g < 3; ++g) cw[j][g] = *(const f32x4*)(C.in[I_GCW] + ((size_t)l * 4 + j) * 768 + g * 256 + ch);
    const int tb = p0 + C.wave * 8;
    auto ldrow = [&](int p, f32x4 (&dst)[3]) {
        if (p >= 0 && p < Lp) { const bf16* pr = P + (size_t)rowof(p) * PLD + OFF_D + ch;
#pragma unroll
            for (int g = 0; g < 3; ++g) dst[g] = ld4bf(pr + g * 256); }
        else {
#pragma unroll
            for (int g = 0; g < 3; ++g) dst[g] = (f32x4){0.f, 0.f, 0.f, 0.f}; }
    };
    ldrow(tb - 2, x[0]); ldrow(tb - 1, x[1]); ldrow(tb, x[2]);
#pragma unroll
    for (int t = 0; t < 8; ++t) {
        ldrow(tb + t + 1, x[3]);
        bf16* orow = gq + (size_t)rowof(tb + t) * 768 + ch;
#pragma unroll
        for (int g = 0; g < 3; ++g) {
            f32x4 v = cw[0][g] * x[0][g] + cw[1][g] * x[1][g] + cw[2][g] * x[2][g] + cw[3][g] * x[3][g];
            v = (f32x4){siluf_(v.x), siluf_(v.y), siluf_(v.z), siluf_(v.w)};
            if (g < 2) { const float ss = row16_sum((v.x * v.x + v.y * v.y) + (v.z * v.z + v.w * v.w)); v = v * (rsqrtf_(ss + 1e-6f) * (g == 0 ? 0.125f : 1.0f)); }
            st4bf(orow + g * 256, v);
        }
#pragma unroll
        for (int g = 0; g < 3; ++g) { x[0][g] = x[1][g]; x[1][g] = x[2][g]; x[2][g] = x[3][g]; }
    }
}
__device__ __forceinline__ void finish_rows(const Ctx& C, int l, int nrows) {
    const bf16* P = WSP(const bf16, WS_P); bf16* yc = WSP(bf16, WS_HB);
    const bf16* ob = WSP(const bf16, WS_OUTB); const bf16* oc = WSP(const bf16, WS_OUTC); const bf16* od = WSP(const bf16, WS_OUTD);
    const bf16* gg = WSP(const bf16, WS_G); const float* bonus = WSP(const float, WS_BONUS);
    const float* mu = C.in[I_RMU] + (size_t)l * 2 * B_COLS;
    const int gw = C.wg * NWAVES + C.wave, NGW = C.G * NWAVES, lane = C.lane, ch = 4 * lane, hh = lane >> 4;
    const f32x4 lng = *(const f32x4*)(C.in[I_RLNG] + l * GW + ch), lnb = *(const f32x4*)(C.in[I_RLNB] + l * GW + ch);
    const f32x4 mng = *(const f32x4*)(C.in[I_MNG] + l * GW + ch), gng = *(const f32x4*)(C.in[I_GNG] + l * GW + ch);
    const f32x4 mu0 = *(const f32x4*)(mu + 512 + ch), mu1 = *(const f32x4*)(mu + B_COLS + 512 + ch);
    const size_t o2 = (size_t)T_ALL * 256;
#pragma unroll 2
    for (int m = gw; m < nrows; m += NGW) {
        const bool isctx = m >= T_LAT; const int Lp = isctx ? CTXL : SEQ; const int p = isctx ? ((m - T_LAT) & (CTXL - 1)) : (m & (SEQ - 1));
        const f32x4 yb = ld4bf(ob + (size_t)m * 256 + ch) + ld4bf(ob + o2 + (size_t)m * 256 + ch);
        const f32x4 ycv = ld4bf(oc + (size_t)m * 256 + ch) + ld4bf(oc + o2 + (size_t)m * 256 + ch);
        const f32x4 yd = ld4bf(od + (size_t)m * 256 + ch) + ld4bf(od + o2 + (size_t)m * 256 + ch);
        const bf16* pr = P + (size_t)m * PLD;
        const f32x4 vs = ld4bf(WSP(const bf16, WS_RKV) + (size_t)m * 768 + 512 + ch);
        const f32x4 og = ld4bf(pr + OFF_C + 768 + ch), gd = ld4bf(pr + OFF_D + 768 + ch), gr = ld4bf(gg + (size_t)m * 256 + ch);
        const float bn = bonus[(size_t)m * 4 + hh];
        *(v2u*)(yc + (size_t)m * 1024 + ch) = *(const v2u*)(pr + 256 + ch);
        {
            const float mean = row16_sum((yb.x + yb.y) + (yb.z + yb.w)) * (1.0f / 64.0f);
            const f32x4 dl = yb - mean;
            const float var = row16_sum((dl.x * dl.x + dl.y * dl.y) + (dl.z * dl.z + dl.w * dl.w)) * (1.0f / 64.0f);
            const f32x4 yn = dl * rsqrtf_(var + 64e-5f) * lng + lnb;
            st4bf(yc + (size_t)m * 1024 + 256 + ch, (yn + vs * bn) * gr);
        }
        {
            const float ms = row16_sum((ycv.x * ycv.x + ycv.y * ycv.y) + (ycv.z * ycv.z + ycv.w * ycv.w)) * (1.0f / 64.0f);
            const f32x4 sg = (f32x4){sigmoidf_(og.x), sigmoidf_(og.y), sigmoidf_(og.z), sigmoidf_(og.w)};
            st4bf(yc + (size_t)m * 1024 + 512 + ch, ycv * rsqrtf_(ms + 1e-6f) * mng * sg);
        }
        {
            const float ms = row16_sum((yd.x * yd.x + yd.y * yd.y) + (yd.z * yd.z + yd.w * yd.w)) * (1.0f / 64.0f);
            const f32x4 sg = (f32x4){siluf_(gd.x), siluf_(gd.y), siluf_(gd.z), siluf_(gd.w)};
            st4bf(yc + (size_t)m * 1024 + 768 + ch, yd * rsqrtf_(ms + 1e-6f) * gng * sg);
        }
    }
}
typedef bf16x8 fragb;
__device__ __forceinline__ f32x4 mfma16(fragb a, fragb b, f32x4 c) { return __builtin_amdgcn_mfma_f32_16x16x32_bf16(a, b, c, 0, 0, 0); }
__device__ __forceinline__ fragb ld_frag16(const LAS bf16* p) { return *(const LAS fragb*)p; }
__device__ __forceinline__ fragb ld_frag8x2(const LAS bf16* p0, const LAS bf16* p1) {
    const v2u a = *(const LAS v2u*)p0, b = *(const LAS v2u*)p1; v4u r; r.x = a.x; r.y = a.y; r.z = b.x; r.w = b.y; return __builtin_bit_cast(fragb, r); }
__device__ __forceinline__ fragb pack_frag(const f32x4& lo, const f32x4& hi) { v4u r; r.x = pk2(lo.x, lo.y); r.y = pk2(lo.z, lo.w); r.z = pk2(hi.x, hi.y); r.w = pk2(hi.z, hi.w); return __builtin_bit_cast(fragb, r); }
__device__ __forceinline__ float wave_incl_sum(float v, int lane) {
    v += dpp_x<0x111, 0xF, true>(0.f, v); v += dpp_x<0x112, 0xF, true>(0.f, v); v += dpp_x<0x114, 0xF, true>(0.f, v); v += dpp_x<0x118, 0xF, true>(0.f, v);
    v += dpp_x<0x142, 0xA, false>(0.f, v); v += dpp_x<0x143, 0xC, false>(0.f, v);
    return v;
}
__device__ __forceinline__ float wave_incl_max(float v, int lane) {
    const float ninf = -3.0e38f;
    v = fmaxf(v, dpp_x<0x111, 0xF, false>(ninf, v)); v = fmaxf(v, dpp_x<0x112, 0xF, false>(ninf, v)); v = fmaxf(v, dpp_x<0x114, 0xF, false>(ninf, v)); v = fmaxf(v, dpp_x<0x118, 0xF, false>(ninf, v));
    v = fmaxf(v, dpp_x<0x142, 0xA, false>(ninf, v)); v = fmaxf(v, dpp_x<0x143, 0xC, false>(ninf, v));
    return v;
}
constexpr int MP = 72;
__device__ __forceinline__ void mlstm_chunked(const Ctx& C, int l, int idx) {
    const int d = idx >> 5, b = (idx >> 2) & 7, h = idx & 3, lane = C.lane, w = C.wave, l15 = lane & 15, q = lane >> 4;
    const int it = w & 3, vtp = w >> 2;
    constexpr int IMG = 64 * MP * 2, BUFB = 4 * IMG + 1024, CTB = 65 * MP * 2 + 16;
    LAS unsigned char* L0 = C.lds;
    const bf16* P = WSP(const bf16, WS_P); bf16* outc = WSP(bf16, WS_OUTC) + (size_t)d * T_ALL * 256;
    const float ib = C.in[I_MIB][(l * 2 + d) * NH + h], fb = C.in[I_MFB][(l * 2 + d) * NH + h];
    const int tt = C.tid >> 3, part = C.tid & 7;
    for (int i = C.tid; i < 2 * CTB / 4; i += NTHR) ((LAS unsigned*)(L0 + 2 * BUFB))[i] = 0u;
    v4u rq, rk, rv; unsigned short rgi, rgf;
    auto gload = [&](int n) {
        const int row = seqrow_cm(n * 64 + tt, d, b);
        const bf16* pp = P + (size_t)row * PLD + OFF_C + h * 64 + 8 * part;
        rq = *(const v4u*)pp; rk = *(const v4u*)(pp + 256); rv = *(const v4u*)(pp + 512);
        const bf16* pg = P + (size_t)seqrow_cm(n * 64 + lane, d, b) * PLD + OFF_C + 1024 + d * 4 + h;
        rgi = pg[0]; rgf = pg[8];
    };
    auto images = [&](int bufi) {
        LAS unsigned char* B0 = L0 + bufi * BUFB;
        LAS bf16* Qs = (LAS bf16*)B0; LAS bf16* Ks = Qs + 64 * MP; LAS bf16* VT = Ks + 64 * MP; LAS bf16* KTw = VT + 64 * MP; LAS float* vec = (LAS float*)(B0 + 4 * IMG);
        const float li = bf2f(rgi) + ib, lf = -softplusf_(-(bf2f(rgf) + fb));
        const float bc = wave_incl_sum(lf, lane), x = li - bc, cm = wave_incl_max(x, lane);
        const float wl = __expf(x - __shfl(cm, 63)) * 0.125f;
        if (w == 0) { vec[lane] = x; vec[64 + lane] = cm; vec[128 + lane] = bc; }
        const float wmine = __shfl(wl, 8 * w + (lane >> 3));
        *(LAS v4u*)(Qs + tt * MP + 8 * part) = rq; *(LAS v4u*)(Ks + tt * MP + 8 * part) = rk;
        const unsigned vv[4] = {rv.x, rv.y, rv.z, rv.w}, kk[4] = {rk.x, rk.y, rk.z, rk.w};
#pragma unroll
        for (int e = 0; e < 4; ++e) {
            VT[(8 * part + 2 * e) * MP + tt] = (bf16)(vv[e] & 0xffffu); VT[(8 * part + 2 * e + 1) * MP + tt] = (bf16)(vv[e] >> 16);
            KTw[(8 * part + 2 * e) * MP + tt] = (bf16)f2bf1(bflo(kk[e]) * wmine); KTw[(8 * part + 2 * e + 1) * MP + tt] = (bf16)f2bf1(bfhi(kk[e]) * wmine);
        }
    };
    f32x4 Cst[2], nst; float m = 0.f;
    Cst[0] = Cst[1] = nst = (f32x4){0.f, 0.f, 0.f, 0.f};
    const fragb ones = __builtin_bit_cast(fragb, (v4u){0x3F803F80u, 0x3F803F80u, 0x3F803F80u, 0x3F803F80u});
    const f32x4 z4 = (f32x4){0.f, 0.f, 0.f, 0.f};
    gload(0); images(0); gload(1);
#pragma unroll 1
    for (int n = 0; n < NCH; ++n) {
        RAW_BARRIER();
        const LAS unsigned char* B0 = L0 + (n & 1) * BUFB;
        const LAS bf16* Qs = (const LAS bf16*)B0; const LAS bf16* Ks = Qs + 64 * MP; const LAS bf16* VT = Ks + 64 * MP; const LAS bf16* KTw = VT + 64 * MP; const LAS float* vec = (const LAS float*)(B0 + 4 * IMG);
        const LAS bf16* CT = (const LAS bf16*)(L0 + 2 * BUFB + (n & 1) * CTB); LAS bf16* CTn = (LAS bf16*)(L0 + 2 * BUFB + ((n + 1) & 1) * CTB);
        fragb Qf[2]; Qf[0] = ld_frag16(Qs + (16 * it + l15) * MP + 8 * q); Qf[1] = ld_frag16(Qs + (16 * it + l15) * MP + 32 + 8 * q);
        const float cmi = vec[64 + 16 * it + l15]; const int icol = 16 * it + l15;
        f32x4 pt[4];
#pragma unroll
        for (int jt = 0; jt < 4; ++jt) {
            pt[jt] = z4;
            if (jt <= it) {
                const fragb k0 = ld_frag16(Ks + (16 * jt + l15) * MP + 8 * q), k1 = ld_frag16(Ks + (16 * jt + l15) * MP + 32 + 8 * q);
                f32x4 st = mfma16(k0, Qf[0], z4); st = mfma16(k1, Qf[1], st);
                const f32x4 xj = *(const LAS f32x4*)(vec + 16 * jt + 4 * q);
#pragma unroll
                for (int r = 0; r < 4; ++r) { const int j = 16 * jt + 4 * q + r; pt[jt][r] = (j <= icol) ? st[r] * __expf(xj[r] - cmi) * 0.125f : 0.f; }
            }
        }
        fragb Pf[2]; Pf[0] = pack_frag(pt[0], pt[1]); Pf[1] = pack_frag(pt[2], pt[3]);
        fragb Vf[2][2];
#pragma unroll
        for (int v2 = 0; v2 < 2; ++v2)
#pragma unroll
            for (int s = 0; s < 2; ++s) { const LAS bf16* vr = VT + (16 * (2 * vtp + v2) + l15) * MP + 32 * s + 4 * q; Vf[v2][s] = ld_frag8x2(vr, vr + 16); }
        f32x4 Aacc[2], R[2], as, dn;
        as = mfma16(Pf[0], ones, z4); if (it >= 2) as = mfma16(Pf[1], ones, as);
        const fragb nf0 = ld_frag16(CT + 64 * MP + 8 * q), nf1 = ld_frag16(CT + 64 * MP + 32 + 8 * q);
        dn = mfma16(Qf[0], nf0, z4); dn = mfma16(Qf[1], nf1, dn);
#pragma unroll
        for (int v2 = 0; v2 < 2; ++v2) {
            Aacc[v2] = mfma16(Pf[0], Vf[v2][0], z4); if (it >= 2) Aacc[v2] = mfma16(Pf[1], Vf[v2][1], Aacc[v2]);
            const LAS bf16* cr = CT + (16 * (2 * vtp + v2) + l15) * MP + 8 * q;
            R[v2] = mfma16(Qf[0], ld_frag16(cr), z4); R[v2] = mfma16(Qf[1], ld_frag16(cr + 32), R[v2]);
        }
        {
            const f32x4 bi = *(const LAS f32x4*)(vec + 128 + 16 * it + 4 * q), cmr = *(const LAS f32x4*)(vec + 64 + 16 * it + 4 * q);
#pragma unroll
            for (int r = 0; r < 4; ++r) {
                const float mi = bi[r] + cmr[r], minter = bi[r] + m, mt = fmaxf(minter, mi), e1 = __expf(mi - mt), e2 = __expf(minter - mt);
                const float den = e1 * as[r] + e2 * dn[r]; const float inv = __builtin_amdgcn_rcpf(fmaxf(fabsf(den), __expf(-mt)));
                const int row = seqrow_cm(n * 64 + 16 * it + 4 * q + r, d, b);
#pragma unroll
                for (int v2 = 0; v2 < 2; ++v2) outc[(size_t)row * 256 + h * 64 + 16 * (2 * vtp + v2) + l15] = (bf16)f2bf1((e1 * Aacc[v2][r] + e2 * R[v2][r]) * inv);
            }
        }
        {
            const LAS bf16* kr = KTw + (16 * it + l15) * MP + 4 * q;
            const fragb kt0 = ld_frag8x2(kr, kr + 16), kt1 = ld_frag8x2(kr + 32, kr + 48);
            const float bL = vec[128 + 63], mloc = bL + vec[64 + 63];
            const float mnew = fmaxf(bL + m, mloc), wp = __expf(bL + m - mnew), wn = __expf(mloc - mnew);
            f32x4 gk = mfma16(kt0, ones, z4); gk = mfma16(kt1, ones, gk);
            nst = nst * wp + gk * wn;
#pragma unroll
            for (int v2 = 0; v2 < 2; ++v2) {
                f32x4 G = mfma16(kt0, Vf[v2][0], z4); G = mfma16(kt1, Vf[v2][1], G);
                Cst[v2] = Cst[v2] * wp + G * wn;
                v2u o; o.x = pk2(Cst[v2].x, Cst[v2].y); o.y = pk2(Cst[v2].z, Cst[v2].w);
                *(LAS v2u*)(CTn + (16 * (2 * vtp + v2) + l15) * MP + 16 * it + 4 * q) = o;
            }
            if (vtp == 0 && l15 == 0) { v2u o; o.x = pk2(nst.x, nst.y); o.y = pk2(nst.z, nst.w); *(LAS v2u*)(CTn + 64 * MP + 16 * it + 4 * q) = o; }
            m = mnew;
        }
        if (n + 1 < NCH) { images((n + 1) & 1); if (n + 2 < NCH) gload(n + 2); }
    }
    __syncthreads();
}
__device__ __forceinline__ int fwd_row_cm(int b, int c, int t) { return c < 4 ? (T_LAT + b * CTXL + c * 64 + t) : (b * SEQ + t * 64 + (c - 4)); }
__device__ __forceinline__ bf16* blob_row(const Ctx& C, int d, int isw, int b, int c, int h, int r) {
    const int row = fwd_row_cm(b, c, r);
    if (d == 1 && isw) return WSP(bf16, WS_OUTD) + ((size_t)T_ALL + row) * 256 + h * 64;
    return WSP(bf16, WS_P) + (size_t)row * PLD + OFF_D + (d * 2 + isw) * 256 + h * 64;
}
constexpr int LP = 68;
__device__ __forceinline__ void blocked_solve(const LAS bf16* Ln, const LAS bf16* TinvP, LAS unsigned char* XTw, f32x4 (&acc)[4][4], int l15, int q) {
    const f32x4 z4 = (f32x4){0.f, 0.f, 0.f, 0.f};
#pragma unroll
    for (int I = 0; I < 4; ++I) {
        const fragb Af = *(const LAS fragb*)(TinvP + (I * 16 + l15) * 32 + 8 * q);
        fragb A0, A1;
        if (I >= 1) A0 = ld_frag16(Ln + (16 * I + l15) * MP + 8 * q);
        if (I == 3) A1 = ld_frag16(Ln + (16 * I + l15) * MP + 32 + 8 * q);
#pragma unroll
        for (int nt = 0; nt < 4; ++nt) {
            const int crow = 16 * nt + l15; LAS unsigned char* xr = XTw + crow * 128;
            f32x4 a = acc[I][nt];
            if (I >= 1) a = mfma16(A0, *(const LAS fragb*)(xr + ((q ^ (crow & 7)) << 4)), a);
            if (I == 3) a = mfma16(A1, *(const LAS fragb*)(xr + (((4 + q) ^ (crow & 7)) << 4)), a);
            v4u bw; bw.x = pk2(a.x, a.y); bw.y = pk2(a.z, a.w); bw.z = 0u; bw.w = 0u;
            const f32x4 x = mfma16(Af, __builtin_bit_cast(fragb, bw), z4);
            acc[I][nt] = x;
            v2u o; o.x = pk2(x.x, x.y); o.y = pk2(x.z, x.w);
            *(LAS v2u*)(xr + (((2 * I + (q >> 1)) ^ (crow & 7)) << 4) + (q & 1) * 8) = o;
        }
    }
}
__device__ __forceinline__ void diag_inverses(const LAS bf16* Ln, LAS bf16* TinvP, int lane) {
    const int blk = lane >> 4, c = lane & 15;
    float x[16];
#pragma unroll
    for (int i = 0; i < 16; ++i) {
        const LAS bf16* lr = Ln + (16 * blk + i) * MP + 16 * blk;
        const v4u r0 = *(const LAS v4u*)lr, r1 = *(const LAS v4u*)(lr + 8);
        const unsigned rw[8] = {r0.x, r0.y, r0.z, r0.w, r1.x, r1.y, r1.z, r1.w};
        float s = (i == c) ? 1.0f : 0.0f;
#pragma unroll
        for (int j = 0; j < i; ++j) s += ((j & 1) ? bfhi(rw[j >> 1]) : bflo(rw[j >> 1])) * x[j];
        x[i] = s;
        TinvP[(blk * 16 + i) * 32 + 8 * (c >> 2) + (c & 3)] = (bf16)f2bf1(s);
    }
}
__device__ __forceinline__ void gdn_solve_item(const Ctx& C, int l, int item) {
    const int lane = C.lane, w = C.wave, pw = w & 1, pi = w >> 1, l15 = lane & 15, q = lane >> 4;
    LAS unsigned char* B0 = C.lds + pi * 31744;
    LAS bf16* Ln = (LAS bf16*)B0;
    LAS bf16* TinvP = (LAS bf16*)(B0 + 9216);
    LAS float* vec = (LAS float*)(B0 + 13312);
    LAS unsigned char* XT = B0 + 13824;
    LAS bf16* Ks = (LAS bf16*)XT;
    const bf16* P = WSP(const bf16, WS_P); const bf16* gq = WSP(const bf16, WS_GQ);
    const int u = item >> 1, d = item & 1;
    const int c = u % NCH, h = (u / NCH) & 3, b = u / (NCH * NH);
    const int n = d ? (c < 4 ? 3 - c : 71 - c) : c;
    const float aexp = __expf(C.in[I_GALOG][(l * 2 + d) * NH + h]), dtb = C.in[I_GDTB][(l * 2 + d) * NH + h];
    const int rowl = seqrow_cm(n * 64 + lane, d, b);
    const bf16* pg = P + (size_t)rowl * PLD + OFF_D + 1024 + d * 4 + h;
    const float la = -aexp * softplusf_(bf2f(pg[0]) + dtb), beta = sigmoidf_(bf2f(pg[8]));
    const float gam = wave_incl_sum(la, lane);
    if (pw == 0) { vec[lane] = beta; vec[64 + lane] = gam; }
#pragma unroll
    for (int r = 0; r < 4; ++r) { const int idx = pw * 64 + lane + 128 * r, t = idx >> 3, part = idx & 7;
        *(LAS v4u*)(Ks + t * MP + 8 * part) = *(const v4u*)(gq + (size_t)seqrow_cm(n * 64 + t, d, b) * 768 + 256 + h * 64 + 8 * part); }
    { LAS v4u* tz = (LAS v4u*)(B0 + 9216) + (pw * 64 + lane) * 2; tz[0] = (v4u){0u, 0u, 0u, 0u}; tz[1] = (v4u){0u, 0u, 0u, 0u}; }
    f32x4 acc[4][4];
    if (pw == 0) {
#pragma unroll
        for (int I = 0; I < 4; ++I)
#pragma unroll
            for (int r = 0; r < 4; ++r) { const bf16* vr = gq + (size_t)seqrow_cm(n * 64 + 16 * I + 4 * q + r, d, b) * 768 + 512 + h * 64 + l15;
#pragma unroll
                for (int nt = 0; nt < 4; ++nt) acc[I][nt][r] = bf2f(vr[16 * nt]); }
    }
    __syncthreads();
    {
        int tix = 0;
#pragma unroll
        for (int it = 0; it < 4; ++it)
#pragma unroll
            for (int jt = 0; jt < 4; ++jt, ++tix) if ((tix & 1) == pw) {
                f32x4 t4 = (f32x4){0.f, 0.f, 0.f, 0.f};
                if (jt <= it) {
#pragma unroll
                    for (int s = 0; s < 2; ++s) t4 = mfma16(ld_frag16(Ks + (16 * it + l15) * MP + 32 * s + 8 * q), ld_frag16(Ks + (16 * jt + l15) * MP + 32 * s + 8 * q), t4);
                    const float gj = vec[64 + 16 * jt + l15];
                    const f32x4 bi = *(const LAS f32x4*)(vec + 16 * it + 4 * q), gi = *(const LAS f32x4*)(vec + 64 + 16 * it + 4 * q);
#pragma unroll
                    for (int r = 0; r < 4; ++r) { const int i = 16 * it + 4 * q + r, j = 16 * jt + l15; t4[r] = (j < i) ? -(bi[r] * t4[r] * __expf(gi[r] - gj)) : 0.f; }
                }
#pragma unroll
                for (int r = 0; r < 4; ++r) Ln[(16 * it + 4 * q + r) * MP + 16 * jt + l15] = (bf16)f2bf1(t4[r]);
            }
    }
    {
#pragma unroll
        for (int I = 0; I < 4; ++I) {
            const f32x4 bi = *(const LAS f32x4*)(vec + 16 * I + 4 * q), gi = *(const LAS f32x4*)(vec + 64 + 16 * I + 4 * q);
#pragma unroll
            for (int r = 0; r < 4; ++r) { const float sc = pw ? bi[r] * __expf(gi[r]) : bi[r];
#pragma unroll
                for (int nt = 0; nt < 4; ++nt) acc[I][nt][r] = (pw ? bf2f(Ks[(16 * I + 4 * q + r) * MP + 16 * nt + l15]) : acc[I][nt][r]) * sc; }
        }
    }
    __syncthreads();
    if (pw == 0) diag_inverses(Ln, TinvP, lane);
    LAS unsigned char* XTw = XT + pw * 8192;
    { LAS v4u* xz = (LAS v4u*)(XTw + lane * 128);
#pragma unroll
        for (int g = 0; g < 8; ++g) xz[g] = (v4u){0u, 0u, 0u, 0u}; }
    __syncthreads();
    blocked_solve(Ln, TinvP, XTw, acc, l15, q);
    {
        bf16* dst = blob_row(C, d, pw, b, c, h, lane);
        const LAS unsigned char* xr = XTw + lane * 128;
#pragma unroll
        for (int g = 0; g < 8; ++g) *(v4u*)(dst + 8 * g) = *(const LAS v4u*)(xr + ((g ^ (lane & 7)) << 4));
    }
    __syncthreads();
}

template <bool DRY>
__device__ __forceinline__ void gdn_chunked(const Ctx& C, int l, int idx) {
    const int d = idx >> 5, b = (idx >> 2) & 7, h = idx & 3, lane = C.lane, w = C.wave, l15 = lane & 15, q = lane >> 4;
    const int it = w & 3, vtp = w >> 2;
    constexpr int IMG = 64 * MP * 2, BUFB = 5 * IMG + 512;
    LAS unsigned char* L0 = C.lds;
    LAS bf16* VnT = (LAS bf16*)(L0 + 2 * BUFB + 2 * IMG);
    const bf16* P = WSP(const bf16, WS_P); const bf16* gq = WSP(const bf16, WS_GQ); bf16* outd = WSP(bf16, WS_OUTD) + (size_t)d * T_ALL * 256;
    const float aexp = __expf(C.in[I_GALOG][(l * 2 + d) * NH + h]), dtb = C.in[I_GDTB][(l * 2 + d) * NH + h];
    const int tt = C.tid >> 3, part = C.tid & 7;
    for (int i = C.tid; i < 2 * IMG / 4; i += NTHR) ((LAS unsigned*)(L0 + 2 * BUFB))[i] = 0u;
    v4u rq, rk, ru, rw; unsigned short rga;
    auto gload = [&](int n) {
        const int c = d ? (n < 4 ? 3 - n : 71 - n) : n;
        const bf16* pp = gq + (size_t)seqrow_cm(n * 64 + tt, d, b) * 768 + h * 64 + 8 * part;
        rq = *(const v4u*)pp; rk = *(const v4u*)(pp + 256);
        ru = *(const v4u*)(blob_row(C, d, 0, b, c, h, tt) + 8 * part); rw = *(const v4u*)(blob_row(C, d, 1, b, c, h, tt) + 8 * part);
        rga = P[(size_t)seqrow_cm(n * 64 + lane, d, b) * PLD + OFF_D + 1024 + d * 4 + h];
    };
    auto images = [&](int bufi) {
        LAS unsigned char* B0 = L0 + bufi * BUFB;
        LAS bf16* Qs = (LAS bf16*)B0; LAS bf16* Ks = Qs + 64 * MP; LAS bf16* KdT = Ks + 64 * MP; LAS bf16* Wi = KdT + 64 * MP; LAS bf16* UT = Wi + 64 * MP; LAS float* vec = (LAS float*)(B0 + 5 * IMG);
        const float la = -aexp * softplusf_(bf2f(rga) + dtb);
        const float gam = wave_incl_sum(la, lane);
        if (w == 0) vec[lane] = gam;
        const float kd = __expf(__shfl(gam, 63) - gam);
        const float kmine = __shfl(kd, 8 * w + (lane >> 3));
        *(LAS v4u*)(Qs + tt * MP + 8 * part) = rq; *(LAS v4u*)(Ks + tt * MP + 8 * part) = rk; *(LAS v4u*)(UT + tt * MP + 8 * part) = ru;
        const unsigned kk[4] = {rk.x, rk.y, rk.z, rk.w}, ww[4] = {rw.x, rw.y, rw.z, rw.w};
#pragma unroll
        for (int e = 0; e < 4; ++e) {
            KdT[(8 * part + 2 * e) * MP + tt] = (bf16)f2bf1(bflo(kk[e]) * kmine); KdT[(8 * part + 2 * e + 1) * MP + tt] = (bf16)f2bf1(bfhi(kk[e]) * kmine);
            Wi[(8 * part + 2 * e) * MP + tt] = (bf16)(ww[e] & 0xffffu); Wi[(8 * part + 2 * e + 1) * MP + tt] = (bf16)(ww[e] >> 16);
        }
    };
    f32x4 Sst[2]; Sst[0] = Sst[1] = (f32x4){0.f, 0.f, 0.f, 0.f};
    const f32x4 z4 = (f32x4){0.f, 0.f, 0.f, 0.f};
    gload(0); images(0); gload(1);
#pragma unroll 1
    for (int n = 0; n < NCH; ++n) {
        RAW_BARRIER();
        const LAS unsigned char* B0 = L0 + (n & 1) * BUFB;
        const LAS bf16* Qs = (const LAS bf16*)B0; const LAS bf16* Ks = Qs + 64 * MP; const LAS bf16* KdT = Ks + 64 * MP; const LAS bf16* Wi = KdT + 64 * MP; const LAS bf16* UT = Wi + 64 * MP; const LAS float* vec = (const LAS float*)(B0 + 5 * IMG);
        const LAS bf16* ST = (const LAS bf16*)(L0 + 2 * BUFB + (n & 1) * IMG); LAS bf16* STn = (LAS bf16*)(L0 + 2 * BUFB + ((n + 1) & 1) * IMG);
        fragb Qf[2]; Qf[0] = ld_frag16(Qs + (16 * it + l15) * MP + 8 * q); Qf[1] = ld_frag16(Qs + (16 * it + l15) * MP + 32 + 8 * q);
        const float gcol = vec[16 * it + l15]; const int icol = 16 * it + l15;
        f32x4 pt[4];
#pragma unroll
        for (int jt = 0; jt < 4; ++jt) {
            pt[jt] = z4;
            if (jt <= it) {
                const fragb k0 = ld_frag16(Ks + (16 * jt + l15) * MP + 8 * q), k1 = ld_frag16(Ks + (16 * jt + l15) * MP + 32 + 8 * q);
                f32x4 st = mfma16(k0, Qf[0], z4); st = mfma16(k1, Qf[1], st);
                const f32x4 gj = *(const LAS f32x4*)(vec + 16 * jt + 4 * q);
#pragma unroll
                for (int r = 0; r < 4; ++r) { const int j = 16 * jt + 4 * q + r; pt[jt][r] = (j <= icol) ? st[r] * __expf(gcol - gj[r]) : 0.f; }
            }
        }
        fragb Pf[2]; Pf[0] = pack_frag(pt[0], pt[1]); Pf[1] = pack_frag(pt[2], pt[3]);
        const fragb Wf0 = ld_frag16(Wi + (16 * it + l15) * MP + 8 * q), Wf1 = ld_frag16(Wi + (16 * it + l15) * MP + 32 + 8 * q);
        f32x4 Ro[2];
#pragma unroll
        for (int v2 = 0; v2 < 2; ++v2) {
            const int vrow = 16 * (2 * vtp + v2) + l15;
            const fragb s0 = ld_frag16(ST + vrow * MP + 8 * q), s1 = ld_frag16(ST + vrow * MP + 32 + 8 * q);
            f32x4 ws = mfma16(Wf0, s0, z4); ws = mfma16(Wf1, s1, ws);
            Ro[v2] = mfma16(Qf[0], s0, z4); Ro[v2] = mfma16(Qf[1], s1, Ro[v2]);
            const v2u ur = *(const LAS v2u*)(UT + vrow * MP + 16 * it + 4 * q);
            v2u o; o.x = pk2(bflo(ur.x) - ws.x, bfhi(ur.x) - ws.y); o.y = pk2(bflo(ur.y) - ws.z, bfhi(ur.y) - ws.w);
            *(LAS v2u*)(VnT + vrow * MP + 16 * it + 4 * q) = o;
        }
        RAW_BARRIER();
        {
            const f32x4 gi = *(const LAS f32x4*)(vec + 16 * it + 4 * q);
            const float gl = __expf(vec[63]);
            const LAS bf16* kr = KdT + (16 * it + l15) * MP + 4 * q;
            const fragb kt0 = ld_frag8x2(kr, kr + 16), kt1 = ld_frag8x2(kr + 32, kr + 48);
#pragma unroll
            for (int v2 = 0; v2 < 2; ++v2) {
                const int vrow = 16 * (2 * vtp + v2) + l15;
                const LAS bf16* vr = VnT + vrow * MP + 4 * q;
                const fragb n0 = ld_frag8x2(vr, vr + 16), n1 = ld_frag8x2(vr + 32, vr + 48);
                f32x4 o = mfma16(Pf[0], n0, z4); if (it >= 2) o = mfma16(Pf[1], n1, o);
#pragma unroll
                for (int r = 0; r < 4; ++r) { const int row = seqrow_cm(n * 64 + 16 * it + 4 * q + r, d, b);
                    if (!DRY) outd[(size_t)row * 256 + h * 64 + vrow] = (bf16)f2bf1(o[r] + __expf(gi[r]) * Ro[v2][r]); }
                f32x4 ns = mfma16(kt0, n0, z4); ns = mfma16(kt1, n1, ns);
                Sst[v2] = Sst[v2] * gl + ns;
                v2u so; so.x = pk2(Sst[v2].x, Sst[v2].y); so.y = pk2(Sst[v2].z, Sst[v2].w);
                *(LAS v2u*)(STn + vrow * MP + 16 * it + 4 * q) = so;
            }
        }
        if (n + 1 < NCH) { images((n + 1) & 1); if (n + 2 < NCH) gload(n + 2); }
    }
    __syncthreads();
}
constexpr int UP = 264;
template <int CTRL> __device__ __forceinline__ float dpp_keep(float oldv, float v) { return __builtin_bit_cast(float, __builtin_amdgcn_update_dpp(__builtin_bit_cast(int, oldv), __builtin_bit_cast(int, v), CTRL, 0xF, 0xF, false)); }
template <bool REV> __device__ __forceinline__ void scan16(float& A, float& B) {
#define LRU_STEP(S) { const float Ap = dpp_keep<(REV ? 0x100 : 0x110) | S>(1.0f, A), Bp = dpp_keep<(REV ? 0x100 : 0x110) | S>(0.0f, B); B = A * Bp + B; A = A * Ap; }
    LRU_STEP(1) LRU_STEP(2) LRU_STEP(4) LRU_STEP(8)
#undef LRU_STEP
}
template <bool FIN, bool REV>
__device__ __forceinline__ void lru_wave(const Ctx& C, int l, int b, int c, int hd, LAS bf16* U16, LAS bf16* H16) {
    constexpr int d = REV ? 1 : 0;
    const int lane = C.lane, l15 = lane & 15, q = lane >> 4;
    const bf16* wt = WSP(const bf16, WS_LRUWT) + (size_t)((d * 2 + 0) * 4 + hd) * 4096;
    fragb Wa[4][2], Wx[4][2];
#pragma unroll
    for (int mt = 0; mt < 4; ++mt)
#pragma unroll
        for (int ks = 0; ks < 2; ++ks) { Wa[mt][ks] = *(const fragb*)(wt + (16 * mt + l15) * 64 + 32 * ks + 8 * q); Wx[mt][ks] = *(const fragb*)(wt + 4 * 4096 + (16 * mt + l15) * 64 + 32 * ks + 8 * q); }
    f32x4 sp4[4], hc[4], sla[4];
    const size_t sbase = ((size_t)(b * NCH + c) * 2 + d) * 256 + hd * 64;
#pragma unroll
    for (int mt = 0; mt < 4; ++mt) {
        const int ch = hd * 64 + 16 * mt + 4 * q;
        const f32x4 lam = *(const f32x4*)(C.in[I_LLAM] + (l * 2 + d) * GW + ch);
#pragma unroll
        for (int r = 0; r < 4; ++r) sp4[mt][r] = 8.0f * softplusf_(-lam[r]);
        hc[mt] = FIN ? *(const f32x4*)(WSP(const float, WS_HIN) + sbase + 16 * mt + 4 * q) : (f32x4){0.f, 0.f, 0.f, 0.f};
        sla[mt] = (f32x4){0.f, 0.f, 0.f, 0.f};
    }
    const f32x4 z4 = (f32x4){0.f, 0.f, 0.f, 0.f};
#pragma unroll 1
    for (int nti = 0; nti < 4; ++nti) {
        const int nt = REV ? 3 - nti : nti;
        const LAS bf16* urow = U16 + (16 * nt + l15) * UP + hd * 64;
        const fragb Uf0 = ld_frag16(urow + 8 * q), Uf1 = ld_frag16(urow + 32 + 8 * q);
#pragma unroll
        for (int mt = 0; mt < 4; ++mt) {
            f32x4 aa = mfma16(Wa[mt][0], Uf0, z4); aa = mfma16(Wa[mt][1], Uf1, aa);
            f32x4 ax = mfma16(Wx[mt][0], Uf0, z4); ax = mfma16(Wx[mt][1], Uf1, ax);
            const v2u ur = *(const LAS v2u*)(urow + 16 * mt + 4 * q);
            const float u4[4] = {bflo(ur.x), bfhi(ur.x), bflo(ur.y), bfhi(ur.y)};
            const f32x4 ba = *(const f32x4*)(C.in[I_LBA] + (l * 2 + d) * GW + hd * 64 + 16 * mt + 4 * q), bx = *(const f32x4*)(C.in[I_LBX] + (l * 2 + d) * GW + hd * 64 + 16 * mt + 4 * q);
            f32x4 hv;
#pragma unroll
            for (int r = 0; r < 4; ++r) {
                const float rg = sigmoidf_(aa[r] + ba[r]), ig = sigmoidf_(ax[r] + bx[r]);
                const float la = -sp4[mt][r] * rg; float A = __expf(la); float Bv = __builtin_amdgcn_sqrtf(-expm1f_(2.0f * la)) * (ig * u4[r]);
                sla[mt][r] += la;
                scan16<REV>(A, Bv);
                const float h = A * hc[mt][r] + Bv;
                hv[r] = h;
                hc[mt][r] = __shfl(h, (lane & 48) | (REV ? 0 : 15));
            }
            if (FIN) { v2u o; o.x = pk2(hv.x, hv.y); o.y = pk2(hv.z, hv.w); *(LAS v2u*)(H16 + (size_t)d * 64 * UP + (16 * nt + l15) * UP + hd * 64 + 16 * mt + 4 * q) = o; }
        }
    }
    if (!FIN) {
        float* ls = WSP(float, WS_LSUM);
#pragma unroll
        for (int mt = 0; mt < 4; ++mt)
#pragma unroll
            for (int r = 0; r < 4; ++r) { const float st = row16_sum(sla[mt][r]); if (l15 == 0) { const size_t si = sbase + 16 * mt + 4 * q + r; ls[si * 2] = st; ls[si * 2 + 1] = hc[mt][r]; } }
    }
}
template <bool FIN>
__device__ __forceinline__ void lru_chunk_mfma(const Ctx& C, int l, int b, int c) {
    LAS bf16* U16 = (LAS bf16*)C.lds;
    LAS bf16* H16 = U16 + 64 * UP;
    const bf16* P = WSP(const bf16, WS_P);
    const bool isctx = c < 4; const int p0 = isctx ? c * 64 : (c - 4) * 64; const int Lp = isctx ? CTXL : SEQ; const int row0 = isctx ? T_LAT + b * CTXL : b * SEQ;
    {
        const int ch = C.tid & 255, half = C.tid >> 8;
        const float* cw = C.in[I_LCW] + (size_t)l * 4 * GW + ch; const float w0 = cw[0], w1 = cw[GW], w2 = cw[2 * GW], w3 = cw[3 * GW], cb = C.in[I_LCB][l * GW + ch];
        const int t0 = half * 32;
        float xs[35];
#pragma unroll
        for (int k = 0; k < 35; ++k) { const int p = p0 + t0 + k - 2; xs[k] = (p >= 0 && p < Lp) ? bf2f(P[(size_t)(row0 + p) * PLD + ch]) : 0.f; }
#pragma unroll
        for (int t = 0; t < 32; ++t) U16[(t0 + t) * UP + ch] = (bf16)f2bf1(w0 * xs[t] + w1 * xs[t + 1] + w2 * xs[t + 2] + w3 * xs[t + 3] + cb);
    }
    __syncthreads();
    if (C.wave < 4) lru_wave<FIN, false>(C, l, b, c, C.wave & 3, U16, H16); else lru_wave<FIN, true>(C, l, b, c, C.wave & 3, U16, H16);
    __syncthreads();
    if (FIN) {
        const LAS bf16* H1 = H16 + 64 * UP;
#pragma unroll 2
        for (int it = C.tid; it < 64 * 64; it += NTHR) {
            const int t = it >> 6, c4 = (it & 63) * 4;
            const size_t row = (size_t)(row0 + p0 + t);
            const v2u a = *(const LAS v2u*)(H16 + t * UP + c4), bq = *(const LAS v2u*)(H1 + t * UP + c4);
            const f32x4 g = ld4bf(P + row * PLD + 256 + c4);
            f32x4 y = (f32x4){bflo(a.x) + bflo(bq.x), bfhi(a.x) + bfhi(bq.x), bflo(a.y) + bflo(bq.y), bfhi(a.y) + bfhi(bq.y)};
            y.x *= gelu_tanh(g.x); y.y *= gelu_tanh(g.y); y.z *= gelu_tanh(g.z); y.w *= gelu_tanh(g.w);
            st4bf(WSP(bf16, WS_P) + row * PLD + 256 + c4, y);
        }
        __syncthreads();
    }
}
constexpr int RP = 264;
__device__ __forceinline__ void rwkv_prep2(const Ctx& C, int l, int b, int c) {
    LAS bf16* RS = (LAS bf16*)C.lds;
    LAS bf16* KS = RS + 64 * RP;
    LAS bf16* XW = KS + 64 * RP;
    LAS bf16* XA = XW + 64 * MP;
    LAS bf16* XG = XA + 64 * MP;
    const bf16* P = WSP(const bf16, WS_P);
    const bool isctx = c < 4; const int p0 = isctx ? c * 64 : (c - 4) * 64; const int Lp = isctx ? CTXL : SEQ; const int row0 = isctx ? T_LAT + b * CTXL : b * SEQ;
    const float* mu = C.in[I_RMU] + (size_t)l * 2 * B_COLS;
    bf16* rkv = WSP(bf16, WS_RKV);
#pragma unroll 5
    for (int it = C.tid; it < 64 * 120; it += NTHR) {
        const int t = it / 120, c8 = (it % 120) * 8, p = p0 + t;
        const bf16* pp = P + (size_t)(row0 + p) * PLD + OFF_B + c8;
        const v4u xc = *(const v4u*)pp; v4u xp = (v4u){0u, 0u, 0u, 0u}, xn = xp;
        if (p > 0) xp = *(const v4u*)(pp - PLD);
        if (p < Lp - 1) xn = *(const v4u*)(pp + PLD);
        const f32x4 m0a = *(const f32x4*)(mu + c8), m0b = *(const f32x4*)(mu + c8 + 4), m1a = *(const f32x4*)(mu + B_COLS + c8), m1b = *(const f32x4*)(mu + B_COLS + c8 + 4);
        const unsigned xcw[4] = {xc.x, xc.y, xc.z, xc.w}, xpw[4] = {xp.x, xp.y, xp.z, xp.w}, xnw[4] = {xn.x, xn.y, xn.z, xn.w};
        float sh[8];
#pragma unroll
        for (int e = 0; e < 4; ++e) {
            const float x0 = bflo(xcw[e]), x1 = bfhi(xcw[e]);
            const float mu0_0 = e < 2 ? m0a[2 * e] : m0b[2 * e - 4], mu0_1 = e < 2 ? m0a[2 * e + 1] : m0b[2 * e - 3], mu1_0 = e < 2 ? m1a[2 * e] : m1b[2 * e - 4], mu1_1 = e < 2 ? m1a[2 * e + 1] : m1b[2 * e - 3];
            sh[2 * e] = x0 + mu0_0 * (bflo(xpw[e]) - x0) + mu1_0 * (bflo(xnw[e]) - x0);
            sh[2 * e + 1] = x1 + mu0_1 * (bfhi(xpw[e]) - x1) + mu1_1 * (bfhi(xnw[e]) - x1);
        }
        if (c8 >= 768) {
            const int ci = c8 - 768;
            if (ci < 64) {
#pragma unroll
                for (int e = 0; e < 8; ++e) sh[e] = tanhf_(sh[e]); }
            else if (ci >= 128) {
#pragma unroll
                for (int e = 0; e < 8; ++e) sh[e] = sigmoidf_(sh[e]); }
        }
        v4u o; o.x = pk2(sh[0], sh[1]); o.y = pk2(sh[2], sh[3]); o.z = pk2(sh[4], sh[5]); o.w = pk2(sh[6], sh[7]);
        if (c8 < 768) {
            *(v4u*)(rkv + (size_t)(row0 + p) * 768 + c8) = o;
            if (c8 < 256) *(LAS v4u*)(RS + t * RP + c8) = o; else if (c8 < 512) *(LAS v4u*)(KS + t * RP + c8 - 256) = o;
        } else {
            const int ci = c8 - 768;
            LAS bf16* dst = ci < 64 ? XW + t * MP + ci : (ci < 128 ? XA + t * MP + ci - 64 : XG + t * MP + ci - 128);
            *(LAS v4u*)dst = o;
        }
    }
    __syncthreads();
    const int lane = C.lane, w = C.wave, l15 = lane & 15, q = lane >> 4, hd = w & 3, ntp = w >> 2;
    const bf16* wt = WSP(const bf16, WS_RWT);
    bf16* wa_out = WSP(bf16, WS_HB); bf16* g_out = WSP(bf16, WS_G); float* bonus = WSP(float, WS_BONUS); float* rinv = WSP(float, WS_RINV);
    const f32x4 z4 = (f32x4){0.f, 0.f, 0.f, 0.f};
    fragb xw0[2], xw1[2], xa0[2], xa1[2], xg0[2], xg1[2]; float bsum[2] = {0.f, 0.f}, ksum[2] = {0.f, 0.f};
#pragma unroll
    for (int n2 = 0; n2 < 2; ++n2) { const int tok = 16 * (2 * ntp + n2) + l15;
        xw0[n2] = ld_frag16(XW + tok * MP + 8 * q); xw1[n2] = ld_frag16(XW + tok * MP + 32 + 8 * q);
        xa0[n2] = ld_frag16(XA + tok * MP + 8 * q); xa1[n2] = ld_frag16(XA + tok * MP + 32 + 8 * q);
        xg0[n2] = ld_frag16(XG + tok * MP + 8 * q); xg1[n2] = ld_frag16(XG + tok * MP + 32 + 8 * q); }
#pragma unroll
    for (int mt = 0; mt < 4; ++mt) {
        const int chl = 16 * mt + l15, ch4 = hd * 64 + 16 * mt + 4 * q;
        const bf16* wrow = wt + (size_t)(hd * 64 + chl) * 32 + 8 * q;
        const bf16* grow = wt + 4 * 256 * 32 + (size_t)(hd * 64 + chl) * 64 + 8 * q;
        const fragb fw0 = *(const fragb*)(wrow), fw1 = *(const fragb*)(wrow + 256 * 32), fa0 = *(const fragb*)(wrow + 2 * 256 * 32), fa1 = *(const fragb*)(wrow + 3 * 256 * 32), fg0 = *(const fragb*)(grow), fg1 = *(const fragb*)(grow + 32);
        const f32x4 w00 = *(const f32x4*)(C.in[I_RW0] + (l * 2 + 0) * GW + ch4), w01 = *(const f32x4*)(C.in[I_RW0] + (l * 2 + 1) * GW + ch4);
        const f32x4 a00 = *(const f32x4*)(C.in[I_RA0] + (l * 2 + 0) * GW + ch4), a01 = *(const f32x4*)(C.in[I_RA0] + (l * 2 + 1) * GW + ch4);
        const f32x4 k_a = *(const f32x4*)(C.in[I_RKA] + l * GW + ch4), r_k = *(const f32x4*)(C.in[I_RRK] + l * GW + ch4), k_k = *(const f32x4*)(C.in[I_RKK] + l * GW + ch4);
#pragma unroll
        for (int n2 = 0; n2 < 2; ++n2) {
            const int tok = 16 * (2 * ntp + n2) + l15; const size_t row = (size_t)(row0 + p0 + tok);
            const f32x4 aw0 = mfma16(fw0, xw0[n2], z4), aw1 = mfma16(fw1, xw1[n2], z4), aa0 = mfma16(fa0, xa0[n2], z4), aa1 = mfma16(fa1, xa1[n2], z4);
            f32x4 ag = mfma16(fg0, xg0[n2], z4); ag = mfma16(fg1, xg1[n2], ag);
            f32x4 wv0, wv1, av0, av1;
#pragma unroll
            for (int r = 0; r < 4; ++r) {
                wv0[r] = __expf(-0.6065306597126334f * sigmoidf_(aw0[r] + w00[r])); wv1[r] = __expf(-0.6065306597126334f * sigmoidf_(aw1[r] + w01[r]));
                av0[r] = sigmoidf_(aa0[r] + a00[r]); av1[r] = sigmoidf_(aa1[r] + a01[r]);
            }
            st4bf(wa_out + row * 1024 + 0 * 256 + ch4, wv0); st4bf(wa_out + row * 1024 + 1 * 256 + ch4, wv1);
            st4bf(wa_out + row * 1024 + 2 * 256 + ch4, av0); st4bf(wa_out + row * 1024 + 3 * 256 + ch4, av1);
            st4bf(g_out + row * 256 + ch4, ag);
            const v2u rr_ = *(const LAS v2u*)(RS + tok * RP + ch4), kr_ = *(const LAS v2u*)(KS + tok * RP + ch4);
            const f32x4 rs = (f32x4){bflo(rr_.x), bfhi(rr_.x), bflo(rr_.y), bfhi(rr_.y)}, ks = (f32x4){bflo(kr_.x), bfhi(kr_.x), bflo(kr_.y), bfhi(kr_.y)};
#pragma unroll
            for (int r = 0; r < 4; ++r) {
                const float km = ks[r] * (1.0f + (av0[r] - 1.0f) * k_a[r]) + ks[r] * (1.0f + (av1[r] - 1.0f) * k_a[r]);
                bsum[n2] += rs[r] * r_k[r] * km; const float kk = ks[r] * k_k[r]; ksum[n2] += kk * kk;
            }
        }
    }
#pragma unroll
    for (int n2 = 0; n2 < 2; ++n2) {
        const size_t row = (size_t)(row0 + p0 + 16 * (2 * ntp + n2) + l15);
        float bs = bsum[n2], ks2 = ksum[n2];
        bs += __shfl_xor(bs, 16); bs += __shfl_xor(bs, 32); ks2 += __shfl_xor(ks2, 16); ks2 += __shfl_xor(ks2, 32);
        if (q == 0) { bonus[row * 4 + hd] = bs; rinv[row * 4 + hd] = rsqrtf_(ks2 + 1e-6f); }
    }
    __syncthreads();
}
__device__ __forceinline__ int fwd_row_r(int b, int c, int t) { return c < 4 ? (T_LAT + b * CTXL + c * 64 + t) : (b * SEQ + (c - 4) * 64 + t); }
__device__ __forceinline__ bf16* rw_blob_row(const Ctx& C, int d, int which, int b, int c, int h, int r) {
    const int row = fwd_row_r(b, c, r);
#if RW_VSPLIT
    if (which == 0) { if (d) return WSP(bf16, WS_GQ) + (size_t)row * 768 + 512 + h * 64;
                      return WSP(bf16, WS_P) + (size_t)row * PLD + OFF_B + 512 + h * 64; }
#else
    if (which == 0) return WSP(bf16, WS_OUTB) + ((size_t)d * T_ALL + row) * 256 + h * 64;
#endif
    return WSP(bf16, WS_P) + (size_t)row * PLD + OFF_B + d * 256 + h * 64;
}
__device__ __forceinline__ void rwkv_solve_item(const Ctx& C, int l, int item) {
    const int lane = C.lane, w = C.wave, pw = w & 1, pi = w >> 1, l15 = lane & 15, q = lane >> 4;
    LAS unsigned char* B0 = C.lds + pi * 31744;
    LAS bf16* Kk = (LAS bf16*)B0; LAS bf16* Bh = Kk + 64 * MP; LAS bf16* Kh = Bh + 64 * MP;
    LAS bf16* Ln = (LAS bf16*)B0;
    LAS bf16* Lk16 = (LAS bf16*)(B0 + 9216);
    LAS unsigned char* XT = B0 + 9216;
    LAS bf16* TinvP = (LAS bf16*)(B0 + 25600);
    const bf16* WA = WSP(const bf16, WS_HB); bf16* WAw = WSP(bf16, WS_HB); const bf16* rkv = WSP(const bf16, WS_RKV); const float* rinv = WSP(const float, WS_RINV);
    const int u = item >> 1, d = item & 1;
    const int c = u % NCH, h = (u / NCH) & 3, b = u / (NCH * NH);
    const float k_k = C.in[I_RKK][l * GW + h * 64 + lane], k_a = C.in[I_RKA][l * GW + h * 64 + lane];
    const int n = d ? (c < 4 ? 3 - c : 71 - c) : c;
    const float ril = rinv[(size_t)seqrow_raster(n * 64 + lane, d, b) * 4 + h];
#pragma unroll
    for (int r = 0; r < 4; ++r) { const int idx2 = pw * 64 + lane + 128 * r, t = idx2 >> 3, part = idx2 & 7; const int row = seqrow_raster(n * 64 + t, d, b);
        *(LAS v4u*)(Kk + t * MP + 8 * part) = *(const v4u*)(WA + (size_t)row * 1024 + d * 256 + h * 64 + 8 * part);
        *(LAS v4u*)(Bh + t * MP + 8 * part) = *(const v4u*)(WA + (size_t)row * 1024 + (2 + d) * 256 + h * 64 + 8 * part);
        *(LAS v4u*)(Kh + t * MP + 8 * part) = *(const v4u*)(rkv + (size_t)row * 768 + 256 + h * 64 + 8 * part); }
    __syncthreads();
    {
        float cc = 1.0f;
        if (pw) {
#pragma unroll
            for (int t = 0; t < 32; ++t) cc *= bf2f(Kk[t * MP + lane]);
        }
        __syncthreads();
#pragma unroll
        for (int t2 = 0; t2 < 32; ++t2) {
            const int t = pw * 32 + t2;
            const float wv = bf2f(Kk[t * MP + lane]), av = bf2f(Bh[t * MP + lane]), ks = bf2f(Kh[t * MP + lane]);
            const float kap = ks * k_k * __shfl(ril, t);
            const float cprev = cc; cc *= wv; const float ic = __builtin_amdgcn_rcpf(cc);
            Kk[t * MP + lane] = (bf16)f2bf1(kap * cprev); Bh[t * MP + lane] = (bf16)f2bf1(kap * av * ic); Kh[t * MP + lane] = (bf16)f2bf1(ks * (1.0f + (av - 1.0f) * k_a) * ic);
            WAw[(size_t)seqrow_raster(n * 64 + t, d, b) * 1024 + d * 256 + h * 64 + lane] = (bf16)f2bf1(cc);
        }
    }
    __syncthreads();
    f32x4 acc[4][4];
    if (pw == 0) {
#pragma unroll
        for (int I = 0; I < 4; ++I)
#pragma unroll
            for (int r = 0; r < 4; ++r)
#pragma unroll
                for (int nt = 0; nt < 4; ++nt) acc[I][nt][r] = bf2f(Kk[(16 * I + 4 * q + r) * MP + 16 * nt + l15]);
    }
    f32x4 T[10];
    {
        const LAS bf16* Bsrc = pw ? Kh : Bh;
        int tix = 0;
#pragma unroll
        for (int it = 0; it < 4; ++it)
#pragma unroll
            for (int jt = 0; jt <= it; ++jt, ++tix) {
                f32x4 t4 = (f32x4){0.f, 0.f, 0.f, 0.f};
#pragma unroll
                for (int s = 0; s < 2; ++s) t4 = mfma16(ld_frag16(Kk + (16 * it + l15) * MP + 32 * s + 8 * q), ld_frag16(Bsrc + (16 * jt + l15) * MP + 32 * s + 8 * q), t4);
#pragma unroll
                for (int r = 0; r < 4; ++r) { const int i = 16 * it + 4 * q + r, j = 16 * jt + l15; T[tix][r] = (j < i) ? (pw ? t4[r] : -t4[r]) : 0.f; }
            }
    }
    __syncthreads();
    {
        int tix = 0;
#pragma unroll
        for (int it = 0; it < 4; ++it)
#pragma unroll
            for (int jt = 0; jt < 4; ++jt) {
                if (jt <= it) {
#pragma unroll
                    for (int r = 0; r < 4; ++r) (pw ? Lk16 : Ln)[(16 * it + 4 * q + r) * MP + 16 * jt + l15] = (bf16)f2bf1(T[tix][r]);
                    ++tix;
                } else if (pw == 0) {
#pragma unroll
                    for (int r = 0; r < 4; ++r) Ln[(16 * it + 4 * q + r) * MP + 16 * jt + l15] = (bf16)0;
                }
            }
        LAS v4u* tz = (LAS v4u*)(B0 + 25600) + (pw * 64 + lane) * 2; tz[0] = (v4u){0u, 0u, 0u, 0u}; tz[1] = (v4u){0u, 0u, 0u, 0u};
    }
    __syncthreads();
    if (pw) {
#pragma unroll
        for (int I = 0; I < 4; ++I)
#pragma unroll
            for (int r = 0; r < 4; ++r)
#pragma unroll
                for (int nt = 0; nt < 4; ++nt) { const int i = 16 * I + 4 * q + r, j = 16 * nt + l15; acc[I][nt][r] = (j < i && nt <= I) ? bf2f(Lk16[i * MP + j]) : 0.f; }
    } else diag_inverses(Ln, TinvP, lane);
    __syncthreads();
    LAS unsigned char* XTw = XT + pw * 8192;
    { LAS v4u* xz = (LAS v4u*)(XTw + lane * 128);
#pragma unroll
        for (int g = 0; g < 8; ++g) xz[g] = (v4u){0u, 0u, 0u, 0u}; }
    blocked_solve(Ln, TinvP, XTw, acc, l15, q);
    {
        bf16* dst = rw_blob_row(C, d, pw, b, c, h, lane);
        const LAS unsigned char* xr = XTw + lane * 128;
#pragma unroll
        for (int g = 0; g < 8; ++g) *(v4u*)(dst + 8 * g) = *(const LAS v4u*)(xr + ((g ^ (lane & 7)) << 4));
    }
    __syncthreads();
}

template <bool DRY>
__device__ __forceinline__ void rwkv_chunked(const Ctx& C, int l, int idx) {
#ifndef RW_VSPLIT
#define RW_VSPLIT 1
#endif
    constexpr int NV = RW_VSPLIT ? 1 : 2;
    const int vhalf = idx & 1, lane = C.lane, w = C.wave, l15 = lane & 15, q = lane >> 4;
    const int d = RW_VSPLIT ? idx >> 6 : idx >> 5, b = RW_VSPLIT ? (idx >> 3) & 7 : (idx >> 2) & 7, h = RW_VSPLIT ? (idx >> 1) & 3 : idx & 3;
    const int it = w & 3, vt0 = RW_VSPLIT ? 2 * vhalf + (w >> 2) : 2 * (w >> 2);
    constexpr int IMG = 64 * MP * 2;
    LAS unsigned char* L0 = C.lds;
    LAS bf16* Wi = (LAS bf16*)L0; LAS bf16* Ti = Wi + 64 * MP; LAS bf16* Rh = Ti + 64 * MP; LAS bf16* Kh = Rh + 64 * MP; LAS bf16* Bh = Kh + 64 * MP;
    LAS bf16* UT = (LAS bf16*)(L0 + 11 * IMG);
    LAS float* cLv = (LAS float*)(L0 + 14 * IMG);
    const bf16* WA = WSP(const bf16, WS_HB); const bf16* rkv = WSP(const bf16, WS_RKV); const float* rinv = WSP(const float, WS_RINV);
    bf16* outb = WSP(bf16, WS_OUTB) + (size_t)d * T_ALL * 256;
    const int tt = C.tid >> 3, part = C.tid & 7;
    for (int i = C.tid; i < 2 * IMG / 4; i += NTHR) ((LAS unsigned*)(L0 + 12 * IMG))[i] = 0u;
    float kkw[8], kaw[8];
#pragma unroll
    for (int e = 0; e < 8; ++e) { kkw[e] = C.in[I_RKK][l * GW + h * 64 + 8 * w + e]; kaw[e] = C.in[I_RKA][l * GW + h * 64 + 8 * w + e]; }
    v4u gr, gk, gv, gw, ga, gbw, gbt; float gri;
    auto gload = [&](int n) {
        const int c = d ? (n < 4 ? 3 - n : 71 - n) : n;
        const int row = seqrow_raster(n * 64 + lane, d, b);
        const bf16* pr = rkv + (size_t)row * 768 + h * 64 + 8 * w;
        gr = *(const v4u*)pr; gk = *(const v4u*)(pr + 256); gv = *(const v4u*)(pr + 512);
        gw = *(const v4u*)(WA + (size_t)row * 1024 + d * 256 + h * 64 + 8 * w); ga = *(const v4u*)(WA + (size_t)row * 1024 + (2 + d) * 256 + h * 64 + 8 * w);
        gri = rinv[(size_t)row * 4 + h];
        gbw = *(const v4u*)(rw_blob_row(C, d, 0, b, c, h, tt) + 8 * part); gbt = *(const v4u*)(rw_blob_row(C, d, 1, b, c, h, tt) + 8 * part);
    };
    auto images = [&](int bufi) {
        LAS bf16* VT = (LAS bf16*)(L0 + (5 + 3 * bufi) * IMG); LAS bf16* KcT = VT + 64 * MP; LAS bf16* BcT = KcT + 64 * MP;
        const unsigned rw_[4] = {gr.x, gr.y, gr.z, gr.w}, kw_[4] = {gk.x, gk.y, gk.z, gk.w}, vw_[4] = {gv.x, gv.y, gv.z, gv.w}, ww_[4] = {gw.x, gw.y, gw.z, gw.w}, aw_[4] = {ga.x, ga.y, ga.z, ga.w};
        float rh[8], kh[8], bh[8];
#pragma unroll
        for (int e = 0; e < 8; ++e) {
            const float rs = (e & 1) ? bfhi(rw_[e >> 1]) : bflo(rw_[e >> 1]), ks = (e & 1) ? bfhi(kw_[e >> 1]) : bflo(kw_[e >> 1]);
            const float wv = (e & 1) ? bfhi(ww_[e >> 1]) : bflo(ww_[e >> 1]), av = (e & 1) ? bfhi(aw_[e >> 1]) : bflo(aw_[e >> 1]);
            const float kap = ks * kkw[e] * gri, ktil = ks * (1.0f + (av - 1.0f) * kaw[e]);
            const float cf = wv, icf = __builtin_amdgcn_rcpf(cf), cfL = __builtin_bit_cast(float, __builtin_amdgcn_readlane(__builtin_bit_cast(int, cf), 63)), dec = cfL * icf;
            rh[e] = rs * cf; kh[e] = ktil * icf; bh[e] = kap * av * icf;
            const unsigned short vraw = (e & 1) ? (unsigned short)(vw_[e >> 1] >> 16) : (unsigned short)(vw_[e >> 1] & 0xffffu);
            VT[(8 * w + e) * MP + lane] = vraw; KcT[(8 * w + e) * MP + lane] = (bf16)f2bf1(ktil * dec); BcT[(8 * w + e) * MP + lane] = (bf16)f2bf1(-(kap * av * dec));
            if (lane == 63) cLv[bufi * 64 + 8 * w + e] = cfL;
        }
        { v4u o; o.x = pk2(rh[0], rh[1]); o.y = pk2(rh[2], rh[3]); o.z = pk2(rh[4], rh[5]); o.w = pk2(rh[6], rh[7]); *(LAS v4u*)(Rh + lane * MP + 8 * w) = o; }
        { v4u o; o.x = pk2(kh[0], kh[1]); o.y = pk2(kh[2], kh[3]); o.z = pk2(kh[4], kh[5]); o.w = pk2(kh[6], kh[7]); *(LAS v4u*)(Kh + lane * MP + 8 * w) = o; }
        { v4u o; o.x = pk2(bh[0], bh[1]); o.y = pk2(bh[2], bh[3]); o.z = pk2(bh[4], bh[5]); o.w = pk2(bh[6], bh[7]); *(LAS v4u*)(Bh + lane * MP + 8 * w) = o; }
        const unsigned bw_[4] = {gbw.x, gbw.y, gbw.z, gbw.w}, bt_[4] = {gbt.x, gbt.y, gbt.z, gbt.w};
#pragma unroll
        for (int e = 0; e < 4; ++e) {
            Wi[(8 * part + 2 * e) * MP + tt] = (bf16)(bw_[e] & 0xffffu); Wi[(8 * part + 2 * e + 1) * MP + tt] = (bf16)(bw_[e] >> 16);
            Ti[(8 * part + 2 * e) * MP + tt] = (bf16)(bt_[e] & 0xffffu); Ti[(8 * part + 2 * e + 1) * MP + tt] = (bf16)(bt_[e] >> 16);
        }
    };
    f32x4 Zst[NV];
#pragma unroll
    for (int v2 = 0; v2 < NV; ++v2) Zst[v2] = (f32x4){0.f, 0.f, 0.f, 0.f};
    const f32x4 z4 = (f32x4){0.f, 0.f, 0.f, 0.f};
    gload(0); images(0); gload(1);
#pragma unroll 1
    for (int n = 0; n < NCH; ++n) {
        RAW_BARRIER();
        const LAS bf16* VT = (const LAS bf16*)(L0 + (5 + 3 * (n & 1)) * IMG); const LAS bf16* KcT = VT + 64 * MP; const LAS bf16* BcT = KcT + 64 * MP;
        const LAS bf16* Zi = (const LAS bf16*)(L0 + (12 + (n & 1)) * IMG); LAS bf16* Zn = (LAS bf16*)(L0 + (12 + ((n + 1) & 1)) * IMG);
        const int arow = (16 * it + l15) * MP + 8 * q;
        const fragb Wf0 = ld_frag16(Wi + arow), Wf1 = ld_frag16(Wi + arow + 32), Tf0 = ld_frag16(Ti + arow), Tf1 = ld_frag16(Ti + arow + 32), Rf0 = ld_frag16(Rh + arow), Rf1 = ld_frag16(Rh + arow + 32);
        const int icol = 16 * it + l15;
        f32x4 pk[4], pb[4];
#pragma unroll
        for (int jt = 0; jt < 4; ++jt) {
            pk[jt] = z4; pb[jt] = z4;
            if (jt <= it) {
                const int jrow = (16 * jt + l15) * MP + 8 * q;
                f32x4 sk = mfma16(ld_frag16(Kh + jrow), Rf0, z4); sk = mfma16(ld_frag16(Kh + jrow + 32), Rf1, sk);
                f32x4 sb = mfma16(ld_frag16(Bh + jrow), Rf0, z4); sb = mfma16(ld_frag16(Bh + jrow + 32), Rf1, sb);
#pragma unroll
                for (int r = 0; r < 4; ++r) { const int j = 16 * jt + 4 * q + r; pk[jt][r] = (j <= icol) ? sk[r] : 0.f; pb[jt][r] = (j <= icol) ? -sb[r] : 0.f; }
            }
        }
        fragb Pk0 = pack_frag(pk[0], pk[1]), Pk1 = pack_frag(pk[2], pk[3]), Pb0 = pack_frag(pb[0], pb[1]), Pb1 = pack_frag(pb[2], pb[3]);
        f32x4 RZ[NV];
#pragma unroll
        for (int v2 = 0; v2 < NV; ++v2) {
            const int vrow = 16 * (vt0 + v2) + l15;
            const fragb z0 = ld_frag16(Zi + vrow * MP + 8 * q), z1 = ld_frag16(Zi + vrow * MP + 32 + 8 * q);
            f32x4 u = mfma16(Wf0, z0, z4); u = mfma16(Wf1, z1, u);
            u = mfma16(Tf0, ld_frag16(VT + vrow * MP + 8 * q), u); if (it >= 2) u = mfma16(Tf1, ld_frag16(VT + vrow * MP + 32 + 8 * q), u);
            RZ[v2] = mfma16(Rf0, z0, z4); RZ[v2] = mfma16(Rf1, z1, RZ[v2]);
            v2u o; o.x = pk2(u.x, u.y); o.y = pk2(u.z, u.w);
            *(LAS v2u*)(UT + vrow * MP + 16 * it + 4 * q) = o;
        }
        RAW_BARRIER();
        {
            const f32x4 cl4 = *(const LAS f32x4*)(cLv + (n & 1) * 64 + 16 * it + 4 * q);
            const LAS bf16* kr = KcT + (16 * it + l15) * MP + 4 * q; const LAS bf16* br = BcT + (16 * it + l15) * MP + 4 * q;
            const fragb kc0 = ld_frag8x2(kr, kr + 16), kc1 = ld_frag8x2(kr + 32, kr + 48), bc0 = ld_frag8x2(br, br + 16), bc1 = ld_frag8x2(br + 32, br + 48);
#pragma unroll
            for (int v2 = 0; v2 < NV; ++v2) {
                const int vrow = 16 * (vt0 + v2) + l15;
                const LAS bf16* vr = VT + vrow * MP + 4 * q; const LAS bf16* ur = UT + vrow * MP + 4 * q;
                const fragb vp0 = ld_frag8x2(vr, vr + 16), vp1 = ld_frag8x2(vr + 32, vr + 48), up0 = ld_frag8x2(ur, ur + 16), up1 = ld_frag8x2(ur + 32, ur + 48);
                f32x4 y = mfma16(Pk0, vp0, RZ[v2]); y = mfma16(Pb0, up0, y);
                if (it >= 2) { y = mfma16(Pk1, vp1, y); y = mfma16(Pb1, up1, y); }
#pragma unroll
                for (int r = 0; r < 4; ++r) { const int row = seqrow_raster(n * 64 + 16 * it + 4 * q + r, d, b); if (!DRY) outb[(size_t)row * 256 + h * 64 + vrow] = (bf16)f2bf1(y[r]); }
                f32x4 zn = mfma16(kc0, vp0, z4); zn = mfma16(kc1, vp1, zn); zn = mfma16(bc0, up0, zn); zn = mfma16(bc1, up1, zn);
                Zst[v2] = Zst[v2] * cl4 + zn;
                v2u so; so.x = pk2(Zst[v2].x, Zst[v2].y); so.y = pk2(Zst[v2].z, Zst[v2].w);
                *(LAS v2u*)(Zn + vrow * MP + 16 * it + 4 * q) = so;
            }
        }
        if (n + 1 < NCH) { images((n + 1) & 1); if (n + 2 < NCH) gload(n + 2); }
    }
    __syncthreads();
}
__device__ __forceinline__ void moe_scatter(const Ctx& C, int moe_li, int nrows) {
    const unsigned* gc = WSP(const unsigned, WS_CTL) + CW_MOECNT + 64 * moe_li;
    LAS int* pst = (LAS int*)C.lds;
    {
        int pe[8]; int acc = 0;
#pragma unroll
        for (int e = 0; e < NE; ++e) { const int blks = ((int)gc[e] + 255) >> 8; if (C.tid == e) pst[e] = acc * 256; acc += blks; pe[e] = acc; }
        if (C.wg == 0 && C.tid < MOE_MAXBLK) { int be = 0;
#pragma unroll
            for (int e = 0; e < NE; ++e) be += (pe[e] <= C.tid) ? 1 : 0;
            int* tab = WSP(int, WS_TAB); tab[1 + C.tid] = be < NE ? be : NE - 1; if (C.tid == 0) tab[0] = acc; }
    }
    __syncthreads();
    const unsigned* route = WSP(const unsigned, WS_ROUTE); const unsigned* wgbase = WSP(const unsigned, WS_WGBASE);
    int* pos = WSP(int, WS_POS); int* tok = WSP(int, WS_TOK);
    if (C.wg < NE) { const int cnt = (int)gc[C.wg], s0 = pst[C.wg] + cnt, s1 = pst[C.wg] + (((cnt + 255) >> 8) << 8);
        for (int j = s0 + C.tid; j < s1; j += NTHR) tok[j] = 0; }
    const int m = C.wg * NWAVES + C.wave + C.lane * (C.G * NWAVES);
    if (m < nrows) {
        const v4u a = *(const v4u*)(route + (size_t)m * 8);
        const int e0 = (int)a.x, e1 = (int)a.y;
        const int p0 = pst[e0] + (int)wgbase[C.wg * 8 + e0] + (int)a.z, p1 = pst[e1] + (int)wgbase[C.wg * 8 + e1] + (int)a.w;
        pos[(size_t)m * 2] = p0; pos[(size_t)m * 2 + 1] = p1; tok[p0] = m; tok[p1] = m;
    }
    __syncthreads();
}
template <int NEXT>
__device__ __forceinline__ void moe_combine(const Ctx& C, int l, int nrows) {
    const unsigned* route = WSP(const unsigned, WS_ROUTE); const int* pos = WSP(const int, WS_POS); const bf16* ym = WSP(const bf16, WS_MIX);
    const float* modv = WSP(const float, WS_MODV) + (size_t)l * 9 * 6144 + 5 * 1024;
    const float* modn = WSP(const float, WS_MODV) + (size_t)(l + 1) * 9 * 6144;
    float* xc = WSP(float, WS_XC); bf16* hb = WSP(bf16, WS_HB);
    const int gw = C.wg * NWAVES + C.wave, NGW = C.G * NWAVES;
    f32x4 gn[4];
#pragma unroll
    for (int j = 0; j < 4; ++j) gn[j] = *(const f32x4*)((NEXT == 2 ? C.in[I_FNG] : C.in[I_NMIXG] + (NEXT == 1 ? (l + 1) * 1024 : 0)) + 4 * C.lane + 256 * j);
    for (int m = gw; m < nrows; m += NGW) {
        const bool isctx = m >= T_LAT;
        float* xr = isctx ? xc + (size_t)(m - T_LAT) * 1024 : C.out + (size_t)m * 1024;
        const int mrow = isctx ? 8 : (m >> 12);
        const float* gv = modv + (size_t)mrow * 6144;
        const int p0 = pos[(size_t)m * 2], p1 = pos[(size_t)m * 2 + 1];
        const float w0 = __builtin_bit_cast(float, route[(size_t)m * 8 + 4]), w1 = __builtin_bit_cast(float, route[(size_t)m * 8 + 5]);
        f32x4 x[4]; float ss = 0.f;
#pragma unroll
        for (int j = 0; j < 4; ++j) {
            const int col = 4 * C.lane + 256 * j;
            const v2u a = *(const v2u*)(ym + (size_t)p0 * 1024 + col), b = *(const v2u*)(ym + (size_t)p1 * 1024 + col);
            const f32x4 ya = (f32x4){bflo(a.x), bfhi(a.x), bflo(a.y), bfhi(a.y)}, yb = (f32x4){bflo(b.x), bfhi(b.x), bflo(b.y), bfhi(b.y)};
            const f32x4 g = *(const f32x4*)(gv + col);
            x[j] = *(const f32x4*)(xr + col) + g * (ya * w0 + yb * w1);
            if (NEXT != 2) *(f32x4*)(xr + col) = x[j];
            ss += (x[j].x * x[j].x + x[j].y * x[j].y) + (x[j].z * x[j].z + x[j].w * x[j].w);
        }
        if (NEXT != 0) {
            const float rs = rsqrtf_(wave_sum(ss) * (1.0f / 1024.0f) + 1e-6f);
#pragma unroll
            for (int j = 0; j < 4; ++j) {
                const int col = 4 * C.lane + 256 * j;
                if (NEXT == 2) *(f32x4*)(xr + col) = x[j] * rs * gn[j];
                else { const f32x4 sh = *(const f32x4*)(modn + (size_t)mrow * 6144 + col), scl = *(const f32x4*)(modn + (size_t)mrow * 6144 + 1024 + col);
                    st4bf(hb + (size_t)m * 1024 + col, (x[j] * rs * gn[j]) * (scl + 1.0f) + sh); }
            }
        }
    }
}
__device__ __forceinline__ void final_norm(const Ctx& C) {
    const int gw = C.wg * NWAVES + C.wave, NGW = C.G * NWAVES;
    f32x4 gv[4];
#pragma unroll
    for (int j = 0; j < 4; ++j) gv[j] = *(const f32x4*)(C.in[I_FNG] + 4 * C.lane + 256 * j);
    for (int m = gw; m < T_LAT; m += NGW) {
        float* xr = C.out + (size_t)m * 1024;
        f32x4 v[4]; float s = 0.f;
#pragma unroll
        for (int j = 0; j < 4; ++j) { v[j] = *(const f32x4*)(xr + 4 * C.lane + 256 * j); s += (v[j].x * v[j].x + v[j].y * v[j].y) + (v[j].z * v[j].z + v[j].w * v[j].w); }
        const float rs = rsqrtf_(wave_sum(s) * (1.0f / 1024.0f) + 1e-6f);
#pragma unroll
        for (int j = 0; j < 4; ++j) *(f32x4*)(xr + 4 * C.lane + 256 * j) = v[j] * rs * gv[j];
    }
}

constexpr int NPH_L = 13, PH_FINAL = 1 + DEPTH * NPH_L, NPHASE = PH_FINAL + 1;
__host__ __device__ inline bool phase_exists(int ph) {
    if (ph == 0) return true;
    if (ph == PH_FINAL) return false;
    const int l = (ph - 1) / NPH_L, k = (ph - 1) % NPH_L;
    if (l >= 2 && !(l & 1) && k == 0) return false;
    if (!(l & 1) && k >= 11) return false;
    if (!RW_VSPLIT && k == 4) return false;
    return true;
}
#ifndef PH_MASK
#define PH_MASK 0xFFFFFF
#endif
#define PM(k) ((PH_MASK >> (k)) & 1)
#ifndef SK_MASK
#define SK_MASK 0xFFFF
#endif
#define SK(k) ((SK_MASK >> (k)) & 1)
#ifndef REP_MASK
#define REP_MASK 0
#endif
#define NREP(k) (((REP_MASK >> (k)) & 1) ? 2 : 1)

__global__ void __launch_bounds__(NTHR, 2) fwd_kernel(Args args) {
    extern __shared__ __attribute__((aligned(16))) unsigned char lds_raw[];
    Ctx C; C.in = args.in; C.out = args.out; C.ws = args.ws; C.lds = (LAS unsigned char*)lds_raw;
    C.tid = threadIdx.x; C.lane = C.tid & 63; C.wave = __builtin_amdgcn_readfirstlane(C.tid >> 6); C.G = gridDim.x; C.wg = blockIdx.x;
    volatile LAS unsigned* MISC = (volatile LAS unsigned*)(C.lds + MISC_OFF);
    if (C.tid < 64) MISC[C.tid] = 0u;
    __syncthreads();
    const int lo = args.ph_lo, hi = args.ph_hi;
    const bool multi = (hi - lo) > 1;
    if (multi) (void)xcd_barrier_post(WSP(unsigned, WS_CTL) + CW_BAR, MISC + 8);
#define IN(k) (lo <= (k) && (k) < hi)
#define SEAM(k) do { if (IN((k) + 1)) { XcdBarrier b2_; b2_.bar = WSP(unsigned, WS_CTL) + CW_BAR; b2_.x = xb_xcc_id(); b2_.st = (volatile LAS unsigned*)(C.lds + MISC_OFF) + 8; xcd_barrier(b2_); } } while (0)
#define FRESH() do { int t_ = threadIdx.x; asm volatile("" : "+v"(t_)); C.tid = t_; C.lane = t_ & 63; C.wave = __builtin_amdgcn_readfirstlane(t_ >> 6); } while (0)
#define PHASE(bit, k) if (PM(bit) && IN(pb + (k))) for (int rep_ = 0; rep_ < NREP(bit); ++rep_)
#define CLAIM(qh, var) __syncthreads(); if (C.tid == 0) *qslot = atomicAdd((qh), 1u); __syncthreads(); const int var = (int)*qslot;

    LAS unsigned* qslot = (LAS unsigned*)(C.lds + MISC_OFF + 128);
    if (PM(20) && IN(0)) { phase_pre(C); SEAM(0); }

#pragma unroll 1
    for (int l = 0; l < DEPTH; ++l) {
        const int pb = 1 + l * NPH_L;
        if (hi <= pb || lo >= pb + NPH_L) continue;
        const bool last = (l == DEPTH - 1), moe = (l & 1);
        const int nrows = last ? T_LAT : T_ALL;
        const float* xlat = (l == 0) ? C.in[I_X] : C.out; const float* xctx = (l == 0) ? C.in[I_CTX] : WSP(const float, WS_XC);
        const float* modv = WSP(const float, WS_MODV) + (size_t)l * 9 * 6144;
        unsigned* qbase = WSP(unsigned, WS_CTL) + CW_PREPQ + 256 * l;

        if (!(l >= 2 && !(l & 1))) PHASE(0, 0) { FRESH();
            convert_small(C, l);
            if (l == 0) { FRESH(); convert_items(C, 0, 3, C.wg * NWAVES + C.wave, C.G * NWAVES); }
            __syncthreads();
            FRESH(); norm_rows<false>(C, l, xlat, xctx, C.in[I_NMIXG] + l * 1024, 0, 1024, T_ALL, 0);
            SEAM(pb + 0);
        }
        PHASE(1, 1) { FRESH();
            pg8::Gemm g{WSP(const bf16, WS_HB), WSP(const bf16, WS_WIN), T_ALL, PLD, 1024, 0};
            pg8::StaticOrder S; S.init(T_ALL, PLD, C.G, C.wg);
            pg8::EpiBf16<0> E{WSP(bf16, WS_P), PLD, nullptr, 0, 0};
            pg8::gemm_phase<pg8::EpiBf16<0>, pg8::StaticOrder, false>(C.lds, g, S, E, nullptr);
            SEAM(pb + 1);
        }
        if (PM(2) && IN(pb + 2)) for (int rep_ = 0; rep_ < NREP(2); ++rep_) { FRESH();
            for (;;) {
                CLAIM(qbase + 16 * rep_, k)
                if (k >= 3 * NB * NCH) break;
                const int kind = k / (NB * NCH), u = k % (NB * NCH);
                FRESH();
                if (kind == 0) { for (int r3_ = 0; r3_ < NREP(24); ++r3_) { FRESH(); if (SK(1)) rwkv_prep2(C, l, u / NCH, u % NCH); } }
                else if (kind == 1) { for (int r3_ = 0; r3_ < NREP(25); ++r3_) { FRESH(); if (SK(0)) lru_chunk_mfma<false>(C, l, u / NCH, u % NCH); } }
                else { for (int r3_ = 0; r3_ < NREP(26); ++r3_) { FRESH(); if (SK(2)) gdn_prep(C, l, u / NCH, u % NCH); } }
            }
            SEAM(pb + 2);
        }
        if (PM(3) && IN(pb + 3)) for (int rep_ = 0; rep_ < NREP(3); ++rep_) { FRESH();
            constexpr int NCL = 2 * NB * NH * NCH / 4;
            for (;;) {
                CLAIM(qbase + 64 + 16 * rep_, k)
                if (k >= NCL) break;
                FRESH();
                if (SK(10)) rwkv_solve_item(C, l, 4 * k + (C.wave >> 1));
            }
            FRESH(); if (SK(6) && C.wg < 8) lru_carry(C, C.wg * NTHR + C.tid);
            SEAM(pb + (RW_VSPLIT ? 3 : 4));
        }
#if RW_VSPLIT
        if (PM(3) && IN(pb + 4)) { FRESH();
            for (;;) {
                CLAIM(qbase + 128, k)
                if (k >= 2 * NB * NH * NCH / 4) break;
                FRESH();
                if (SK(10)) rwkv_solve_item(C, l, 4 * k + (C.wave >> 1));
            }
            SEAM(pb + 4);
        }
#endif
        if (PM(4) && IN(pb + 5)) { FRESH();
            if (C.wg >= 64) {
                constexpr int NCL = 2 * NB * NH * NCH / 4;
                for (;;) {
                    CLAIM(qbase + 128, k)
                    if (k >= NCL) break;
                    FRESH();
                    if (SK(9)) gdn_solve_item(C, l, 4 * k + (C.wave >> 1));
                }
                asm volatile("s_waitcnt vmcnt(0)" ::: "memory");
                __syncthreads();
                if (C.tid == 0) { __builtin_amdgcn_fence(__ATOMIC_RELEASE, "agent"); asm volatile("s_waitcnt vmcnt(0)" ::: "memory"); (void)xb_add(qbase + 160, 1u); }
                if (C.wg >= 192) {
                    if (C.tid == 0) { unsigned* bar_ = WSP(unsigned, WS_CTL) + CW_BAR; XB_SPIN(xb_ld(qbase + 160) < (unsigned)(C.G - 64), bar_); __builtin_amdgcn_fence(__ATOMIC_ACQUIRE, "agent"); asm volatile("s_waitcnt vmcnt(0)" ::: "memory"); }
                    __syncthreads();
                }
                FRESH();
            }
            if (SK(3) && C.wg < (RW_VSPLIT ? 128 : 64)) { if (NREP(20) > 1) { FRESH(); rwkv_chunked<true>(C, l, C.wg); } FRESH(); rwkv_chunked<false>(C, l, C.wg); }
            else if (SK(4) && C.wg >= 128 && C.wg < 192) { for (int r2_ = 0; r2_ < NREP(21); ++r2_) { FRESH(); mlstm_chunked(C, l, C.wg - 128); } }
            else if (SK(5) && C.wg >= 192) { if (NREP(22) > 1) { FRESH(); gdn_chunked<true>(C, l, C.wg - 192); } FRESH(); gdn_chunked<false>(C, l, C.wg - 192); }
            {
                FRESH();
                const int nun = last ? NB * 64 : NB * NCH;
                for (;;) {
                    CLAIM(qbase + 192, u0)
                    if (u0 >= 128 + nun) break;
                    if (u0 < 128) {
                        FRESH(); if (l > 0) convert_items(C, l, 2, u0 * NWAVES + C.wave, 128 * NWAVES);
                        if (l + 1 < DEPTH) { FRESH(); convert_items(C, l + 1, 1, u0 * NWAVES + C.wave, 128 * NWAVES); }
                    } else {
                        const int u = u0 - 128;
                        const int b = last ? (u >> 6) : (u / NCH), c = last ? 4 + (u & 63) : (u % NCH);
                        if (SK(7)) lru_chunk_mfma<true>(C, l, b, c);
                    }
                }
            }
            SEAM(pb + 5);
        }
        PHASE(5, 6) { FRESH();
            if (SK(8)) finish_rows(C, l, nrows);
            SEAM(pb + 6);
        }
        if (PM(6) && IN(pb + 7)) { FRESH();
            pg8::Gemm g{WSP(const bf16, WS_HB), WSP(const bf16, WS_WOUT), nrows, 1024, 1024, 0};
            pg8::StaticOrder S; S.init(nrows, 1024, C.G, C.wg);
            pg8::EpiRes E{xlat, xctx, C.out, WSP(float, WS_XC), modv + 2 * 1024};
            pg8::gemm_phase<pg8::EpiRes, pg8::StaticOrder, false>(C.lds, g, S, E, nullptr);
            SEAM(pb + 7);
        }
        if (PM(7) && IN(pb + 8)) { FRESH();
            if (moe) norm_rows<true>(C, l, C.out, WSP(const float, WS_XC), C.in[I_NFFNG] + l * 1024, 3 * 1024, 4 * 1024, nrows, l >> 1);
            else norm_rows<false>(C, l, C.out, WSP(const float, WS_XC), C.in[I_NFFNG] + l * 1024, 3 * 1024, 4 * 1024, nrows, 0);
            SEAM(pb + 8);
        }
        if (!moe) {
            if (PM(8) && IN(pb + 9)) for (int rep_ = 0; rep_ < NREP(8); ++rep_) { FRESH();
                pg8::Gemm g{WSP(const bf16, WS_HB), WSP(const bf16, WS_WGU), nrows, 2 * DFF, 1024, 0};
                pg8::StaticOrder S; S.init(nrows, 2 * DFF, C.G, C.wg);
                pg8::EpiSwiglu E{WSP(bf16, WS_P), DFF};
                pg8::gemm_phase<pg8::EpiSwiglu, pg8::StaticOrder, false>(C.lds, g, S, E, nullptr);
                SEAM(pb + 9);
            }
            if (PM(9) && IN(pb + 10)) { FRESH();
                pg8::Gemm g{WSP(const bf16, WS_P), WSP(const bf16, WS_WDN), nrows, 1024, DFF, 0};
                pg8::StaticOrder S; S.init(nrows, 1024, C.G, C.wg);
                pg8::EpiRes E{C.out, WSP(const float, WS_XC), C.out, WSP(float, WS_XC), modv + 5 * 1024};
                pg8::gemm_phase<pg8::EpiRes, pg8::StaticOrder, false>(C.lds, g, S, E, nullptr);
                SEAM(pb + 12);
            }
        } else {
            if (PM(10) && IN(pb + 9)) { FRESH(); moe_scatter(C, l >> 1, nrows); SEAM(pb + 9); }
            if (PM(11) && IN(pb + 10)) for (int rep_ = 0; rep_ < NREP(11); ++rep_) { FRESH();
                pg8::Gemm g{WSP(const bf16, WS_HB), WSP(const bf16, WS_WGU), 0, 2 * DFE, 1024, (size_t)2 * DFE * 1024};
                pg8::MoeOrderG S; S.init(WSP(const int, WS_TAB), (2 * DFE) / 256, C.G, C.wg); S.tok = WSP(const int, WS_TOK);
                pg8::EpiSwiglu E{WSP(bf16, WS_P), DFE};
                pg8::gemm_phase<pg8::EpiSwiglu, pg8::MoeOrderG, false>(C.lds, g, S, E, nullptr);
                SEAM(pb + 10);
            }
            if (PM(12) && IN(pb + 11)) for (int rep_ = 0; rep_ < NREP(12); ++rep_) { FRESH();
                pg8::Gemm g{WSP(const bf16, WS_P), WSP(const bf16, WS_WDN), 0, 1024, DFE, (size_t)1024 * DFE};
                pg8::MoeOrder S; S.init(WSP(const int, WS_TAB), 4, C.G, C.wg);
                pg8::EpiBf16<0> E{WSP(bf16, WS_MIX), 1024, nullptr, 0, 0};
                pg8::gemm_phase<pg8::EpiBf16<0>, pg8::MoeOrder, false>(C.lds, g, S, E, nullptr);
                SEAM(pb + 11);
            }
            if (PM(13) && IN(pb + 12)) { FRESH();
                if (last) moe_combine<2>(C, l, nrows);
                else { convert_small(C, l + 1); FRESH(); moe_combine<1>(C, l, nrows); if (IN(pb + NPH_L + 1)) { XcdBarrier b2_; b2_.bar = WSP(unsigned, WS_CTL) + CW_BAR; b2_.x = xb_xcc_id(); b2_.st = (volatile LAS unsigned*)(C.lds + MISC_OFF) + 8; xcd_barrier(b2_); } }
            }
        }
    }
}

extern "C" void kernel_launch(void* const* d_in, const int* in_sizes, int n_in, void* d_out, int out_size, void* d_ws, size_t ws_size, hipStream_t stream) {
    static int grid = 0;
    if (grid == 0) {
        if (n_in != N_IN || in_sizes[0] != T_LAT * DM || out_size != T_LAT * DM || ws_size < WS_END) {
            fprintf(stderr, "kernel_launch: unexpected problem (n_in %d, in0 %d, out %d, ws %zu < %zu)\n", n_in, n_in > 0 ? in_sizes[0] : -1, out_size, ws_size, (size_t)WS_END); grid = -1; return; }
        int dev = 0, cus = 0, per_cu = 0;
        if (hipGetDevice(&dev) != hipSuccess || hipDeviceGetAttribute(&cus, hipDeviceAttributeMultiprocessorCount, dev) != hipSuccess) { grid = -1; return; }
        if (hipFuncSetAttribute((const void*)fwd_kernel, hipFuncAttributeMaxDynamicSharedMemorySize, LDS_BYTES) != hipSuccess) { fprintf(stderr, "kernel_launch: hipFuncSetAttribute failed\n"); grid = -1; return; }
        if (hipOccupancyMaxActiveBlocksPerMultiprocessor(&per_cu, (const void*)fwd_kernel, NTHR, LDS_BYTES) != hipSuccess || per_cu < 1) { fprintf(stderr, "kernel_launch: occupancy query says %d\n", per_cu); grid = -1; return; }
        grid = cus;
        if (grid != 256) fprintf(stderr, "kernel_launch: note: %d CUs\n", grid);
    }
    if (grid < 0) return;
    if (hipMemsetAsync((char*)d_ws + WS_CTL, 0, CTL_BYTES, stream) != hipSuccess) return;
    Args a{};
    for (int i = 0; i < N_IN; ++i) a.in[i] = (const float*)d_in[i];
    a.out = (float*)d_out; a.ws = (unsigned char*)d_ws;
#if MK_ONE_LAUNCH
    a.ph_lo = 0; a.ph_hi = NPHASE;
    hipLaunchKernelGGL(fwd_kernel, dim3(grid), dim3(NTHR), LDS_BYTES, stream, a);
#else
    for (int ph = 0; ph < NPHASE; ++ph) { if (!phase_exists(ph)) continue; a.ph_lo = ph; a.ph_hi = ph + 1; hipLaunchKernelGGL(fwd_kernel, dim3(grid), dim3(NTHR), LDS_BYTES, stream, a); }
#endif
}
```

```cpp
#define MK_ONE_LAUNCH 1
#include <hip/hip_runtime.h>
#include <cstdio>
#include <cstdint>

#define GAS __attribute__((address_space(1)))
#define LAS __attribute__((address_space(3)))
typedef unsigned short bf16;
typedef unsigned v4u __attribute__((ext_vector_type(4)));
typedef unsigned v2u __attribute__((ext_vector_type(2)));
typedef float f32x4 __attribute__((ext_vector_type(4)));
typedef float f32x2 __attribute__((ext_vector_type(2)));
typedef short bf16x8 __attribute__((ext_vector_type(8)));
#define LDS_WAIT() asm volatile("s_waitcnt lgkmcnt(0)" ::: "memory")
#define VM_WAIT() asm volatile("s_waitcnt vmcnt(0)" ::: "memory")

constexpr int DM = 1024, NB = 8, SEQ = 4096, DEPTH = 4, CTXL = 256, GW = 256, HD = 64, NH = 4;
constexpr int T_LAT = NB * SEQ, T_CTX = NB * CTXL, T_ALL = T_LAT + T_CTX;
constexpr int IN_COLS = 3552, PLD = 3584;
constexpr int OFF_B = 512, OFF_C = 1472, OFF_D = 2512, B_COLS = 960;
constexpr int DFF = 2816, NE = 8, DFE = 1408;
constexpr int NCH = 68;
constexpr int NSTEP = 4352;
constexpr int MOE_MAXBLK = 280;
constexpr int NWAVES = 8, NTHR = 512;
#ifndef RW_VSPLIT
#define RW_VSPLIT 0
#endif

constexpr size_t MiB = 1u << 20;
constexpr size_t WS_CTL = 0, CTL_BYTES = 1 * MiB;
constexpr size_t WS_MODV = 1 * MiB;
constexpr size_t WS_XC = 2 * MiB;
constexpr size_t WS_WIN = 10 * MiB;
constexpr size_t WS_WOUT = 17 * MiB;
constexpr size_t WS_WGU = 19 * MiB;
constexpr size_t WS_WDN = 63 * MiB;
constexpr size_t WS_HB = 85 * MiB;
constexpr size_t WS_P = 153 * MiB;
constexpr size_t WS_MIX = 391 * MiB;
constexpr size_t WS_OUTB = WS_MIX, WS_OUTC = WS_MIX + 34 * MiB, WS_OUTD = WS_MIX + 68 * MiB, WS_GQ = WS_MIX + 102 * MiB, WS_G = WS_MIX + 153 * MiB;
constexpr size_t WS_RKV = WS_MIX + 170 * MiB;
constexpr size_t WS_SMALL = 612 * MiB;
constexpr size_t WS_ROUTE = WS_SMALL;
constexpr size_t WS_POS = WS_SMALL + 1280 * 1024;
constexpr size_t WS_TOK = WS_SMALL + 1664 * 1024;
constexpr size_t WS_BONUS = WS_SMALL + 2 * MiB;
constexpr size_t WS_RINV = WS_SMALL + 2 * MiB + 640 * 1024;
constexpr size_t WS_WGBASE = WS_SMALL + 3 * MiB + 256 * 1024;
constexpr size_t WS_TAB = WS_WGBASE + 65536;
constexpr size_t WS_LRUWT = WS_SMALL + 3 * MiB + 512 * 1024;
constexpr size_t WS_RWT = WS_LRUWT + 131072;
constexpr size_t WS_LRUH = WS_SMALL + 4 * MiB;
constexpr size_t WS_END = 633 * MiB;
constexpr int CW_MOECNT = 1024;
constexpr int CW_PREPQ = 2048;
constexpr int CW_BAR = 4096;

constexpr int LDS_BYTES = 135168;
constexpr int MISC_OFF = 131072;

__device__ __forceinline__ unsigned f2bf(float f) { unsigned u = __builtin_bit_cast(unsigned, f); return (u + 0x7fffu + ((u >> 16) & 1u)) >> 16; }
typedef __bf16 bf16n2 __attribute__((ext_vector_type(2)));
__device__ __forceinline__ unsigned pk2(float lo, float hi) { const f32x2 v = {lo, hi}; return __builtin_bit_cast(unsigned, __builtin_convertvector(v, bf16n2)); }
__device__ __forceinline__ unsigned f2bf1(float f) { return pk2(f, f) & 0xffffu; }
__device__ __forceinline__ float bf2f(unsigned short v) { return __builtin_bit_cast(float, (unsigned)v << 16); }
__device__ __forceinline__ float bflo(unsigned v) { return __builtin_bit_cast(float, v << 16); }
__device__ __forceinline__ float bfhi(unsigned v) { return __builtin_bit_cast(float, v & 0xffff0000u); }
template <int CTRL, int RM, bool BC> __device__ __forceinline__ float dpp_x(float oldv, float v) { return __builtin_bit_cast(float, __builtin_amdgcn_update_dpp(__builtin_bit_cast(int, oldv), __builtin_bit_cast(int, v), CTRL, RM, 0xF, BC)); }
__device__ __forceinline__ float wave_sum(float v) {
    v += dpp_x<0xB1, 0xF, true>(0.f, v); v += dpp_x<0x4E, 0xF, true>(0.f, v); v += dpp_x<0x141, 0xF, true>(0.f, v); v += dpp_x<0x140, 0xF, true>(0.f, v);
    v += dpp_x<0x142, 0xA, false>(0.f, v); v += dpp_x<0x143, 0xC, false>(0.f, v);
    return __builtin_bit_cast(float, __builtin_amdgcn_readlane(__builtin_bit_cast(int, v), 63));
}
template <int CTRL> __device__ __forceinline__ float dpp_f(float v) { return __builtin_bit_cast(float, __builtin_amdgcn_update_dpp(0, __builtin_bit_cast(int, v), CTRL, 0xF, 0xF, true)); }
__device__ __forceinline__ float row16_sum(float v) {
    v += dpp_f<0xB1>(v);
    v += dpp_f<0x4E>(v);
    v += dpp_f<0x141>(v);
    v += dpp_f<0x140>(v);
    return v;
}
__device__ __forceinline__ float sigmoidf_(float x) { return __builtin_amdgcn_rcpf(1.0f + __expf(-x)); }
__device__ __forceinline__ float softplusf_(float x) { return fmaxf(x, 0.f) + __logf(1.0f + __expf(-fabsf(x))); }
__device__ __forceinline__ float expm1f_(float x) { return x > -0.3f ? x * (1.0f + x * (0.5f + x * (0.16666667f + x * (0.041666668f + x * 0.0083333338f)))) : __expf(x) - 1.0f; }
__device__ __forceinline__ float siluf_(float x) { return x * __builtin_amdgcn_rcpf(1.0f + __expf(-x)); }
__device__ __forceinline__ float tanhf_(float x) { const float e = __expf(2.0f * x); return 1.0f - 2.0f * __builtin_amdgcn_rcpf(e + 1.0f); }
__device__ __forceinline__ float rsqrtf_(float x) { return __builtin_amdgcn_rsqf(x); }
__device__ __forceinline__ float gelu_tanh(float x) { return 0.5f * x * (1.0f + tanhf_(0.7978845608028654f * (x + 0.044715f * x * x * x))); }
__device__ __forceinline__ f32x4 ld4bf(const bf16* p) { const v2u a = *(const v2u*)p; return (f32x4){bflo(a.x), bfhi(a.x), bflo(a.y), bfhi(a.y)}; }
__device__ __forceinline__ void st4bf(bf16* p, const f32x4& v) { v2u o; o.x = pk2(v.x, v.y); o.y = pk2(v.z, v.w); *(v2u*)p = o; }
#define XB_TMO      128
#define XB_XCNT(j)  (256  + 64 * (j))
#define XB_XSUB(j)  (1280 + 64 * (j))
#define XB_XGEN(j)  (2304 + 64 * (j))
#define XB_TOP      3328
#define XB_TOPGEN   3392
#define XCD_BAR_WORDS 3456
#define XB_SPIN_CAP (1u << 22)

__device__ __forceinline__ unsigned xb_ld(unsigned* p)              { return __hip_atomic_load(p, __ATOMIC_RELAXED, __HIP_MEMORY_SCOPE_AGENT); }
__device__ __forceinline__ unsigned xb_add(unsigned* p, unsigned v) { return __hip_atomic_fetch_add(p, v, __ATOMIC_RELAXED, __HIP_MEMORY_SCOPE_AGENT); }
__device__ __forceinline__ unsigned xb_xcc_id() { return (unsigned)__builtin_amdgcn_s_getreg((3 << 11) | 20) & 0xFu; }
#define XB_SPIN(cond, bar) do { unsigned _sp = 0; while (cond) { __builtin_amdgcn_s_sleep(1); \
    if ((++_sp & 255u) == 0u) { if (xb_ld(&(bar)[XB_TMO])) break; if (_sp > XB_SPIN_CAP) { atomicAdd(&(bar)[XB_TMO], 1u); break; } } } } while (0)

struct XcdBarrier {
    unsigned* bar; unsigned x;
    volatile LAS unsigned* st;
};

__device__ __forceinline__ XcdBarrier xcd_barrier_post(unsigned* bar, volatile LAS unsigned* st) {
    XcdBarrier b; b.bar = bar; b.x = xb_xcc_id(); b.st = st;
    if (threadIdx.x == 0) (void)xb_add(&bar[XB_XCNT(b.x)], 1u);
    return b;
}
__device__ __forceinline__ void xcd_barrier_complete(unsigned* bar, unsigned x, unsigned& nloc, unsigned& nx) {
    const unsigned G = gridDim.x * gridDim.y * gridDim.z;
    unsigned sum, cnt, mine, sp = 0u;
    for (;;) {
        sum = 0u; cnt = 0u; mine = 0u;
#pragma unroll
        for (unsigned j = 0; j < 16; ++j) { const unsigned c = xb_ld(&bar[XB_XCNT(j)]); sum += c; cnt += (c > 0u) ? 1u : 0u; mine = (j == x) ? c : mine; }
        if (sum == G) break;
        __builtin_amdgcn_s_sleep(1);
        if ((++sp & 255u) == 0u) { if (xb_ld(&bar[XB_TMO])) break; if (sp > XB_SPIN_CAP) { atomicAdd(&bar[XB_TMO], 1u); break; } }
    }
    nloc = mine > 0u ? mine : 1u; nx = cnt > 0u ? cnt : 1u;
}

__device__ __forceinline__ void xcd_barrier(const XcdBarrier& b) {
    asm volatile("s_waitcnt vmcnt(0)" ::: "memory");
    __syncthreads();
    if (threadIdx.x == 0) {
        unsigned* bar = b.bar;
        __builtin_amdgcn_s_waitcnt(0);
        unsigned nloc = b.st[0], nx = b.st[1];
        if (nloc == 0u) { xcd_barrier_complete(bar, b.x, nloc, nx); b.st[0] = nloc; b.st[1] = nx; }
        const unsigned old = xb_add(&bar[XB_XSUB(b.x)], 1u);
        const unsigned gen = old / nloc;
        if (old + 1u == (gen + 1u) * nloc) {
            __builtin_amdgcn_fence(__ATOMIC_RELEASE, "agent");
            asm volatile("s_waitcnt vmcnt(0)" ::: "memory");
            const unsigned og = xb_add(&bar[XB_TOP], 1u);
            const unsigned tg = og / nx;
            if (og + 1u == (tg + 1u) * nx) xb_add(&bar[XB_TOPGEN], 1u);
            else XB_SPIN(xb_ld(&bar[XB_TOPGEN]) == tg, bar);
            __builtin_amdgcn_fence(__ATOMIC_ACQUIRE, "agent");
            xb_add(&bar[XB_XGEN(b.x)], 1u);
            asm volatile("s_waitcnt vmcnt(0)" ::: "memory");
        } else {
            XB_SPIN(xb_ld(&bar[XB_XGEN(b.x)]) == gen, bar);
            __builtin_amdgcn_fence(__ATOMIC_ACQUIRE, "agent");
            asm volatile("s_waitcnt vmcnt(0)" ::: "memory");
        }
    }
    __syncthreads();
}

namespace pg8 {
#define PG8_LAS __attribute__((address_space(3)))
typedef unsigned short bf16_t;
typedef short bf16x8 __attribute__((ext_vector_type(8)));
typedef float f32x4 __attribute__((ext_vector_type(4)));
typedef unsigned u32x4 __attribute__((ext_vector_type(4)));
constexpr int BM = 256, BK = 64, HALF = 128, HTB = HALF * BK * 2  , STAGE_BYTES = 8 * HTB, NXCD = 8, WGM = 8;

__host__ __device__ __forceinline__ int lds_byte(int r, int c) { const int st = (r >> 4) * 2 + (c >> 5), rr = r & 15, cc = c & 31, ob = rr * 64 + cc * 2; return st * 1024 + (ob ^ (((ob >> 9) & 1) << 5)); }
__host__ __device__ __forceinline__ void stage_rc(int b, int& R, int& C) { const int st = b / 1024, sb = b % 1024, swz = sb ^ (((sb >> 9) & 1) << 5); R = (st >> 1) * 16 + swz / 64; C = (st & 1) * 32 + (swz % 64) / 2; }
__host__ __device__ __forceinline__ int perm32(int rho) { const int n = rho >> 4, i = rho & 15; return 8 * (i >> 2) + 4 * n + (i & 3); }

struct Unit { int pm, pn, e; };
struct Gemm { const bf16_t* A; const bf16_t* Bt; int M, N, K; size_t estride; };

struct StaticOrder {
    static constexpr bool GATHER = false;
    int nM, nN, nwg, G, c;
    __host__ __device__ void init(int M, int N, int G_, int c_) { nM = M / BM; nN = N / BM; nwg = nM * nN; G = G_; c = c_; }
    __host__ __device__ bool next(int i, Unit& u) const {
        const long L = (long)i * G + c; if (L >= nwg) return false;
        int wgid = (int)L; { const int q = nwg / NXCD, r = nwg % NXCD, xcd = wgid % NXCD, off = wgid / NXCD; wgid = (xcd < r ? xcd * (q + 1) : r * (q + 1) + (xcd - r) * q) + off; }
        const int nig = WGM * nN, gid = wgid / nig, fm = gid * WGM, gsz = (nM - fm) < WGM ? (nM - fm) : WGM;
        u.pm = fm + ((wgid % nig) % gsz); u.pn = (wgid % nig) / gsz; u.e = 0; return true;
    }
    __device__ __forceinline__ void a_ready(const Unit&) const {}
    __device__ __forceinline__ void done(const Unit&) const {}
};
__device__ __forceinline__ unsigned cvt_pk_bf16(float lo, float hi) { unsigned r; asm volatile("v_cvt_pk_bf16_f32 %0, %1, %2" : "=v"(r) : "v"(lo), "v"(hi)); return r; }
typedef float f32x2 __attribute__((ext_vector_type(2)));
__device__ __forceinline__ f32x2 gelu_pk(f32x2 v) {
    const f32x2 av = __builtin_elementwise_abs(v), d = av * 0.2316418882f + 1.0f;
    f32x2 t; t.x = __builtin_amdgcn_rcpf(d.x); t.y = __builtin_amdgcn_rcpf(d.y);
    f32x2 q = t * 0.5307027145f + (-0.7265760135f); q = q * t + 0.7107068705f; q = q * t + (-0.142248368f); q = q * t + 0.127414796f; q = q * t;
    const f32x2 s = (v * v) * (-0.72134752044f);
    f32x2 e; e.x = __builtin_amdgcn_exp2f(s.x); e.y = __builtin_amdgcn_exp2f(s.y);
    const f32x2 m = v * (q * e), r = v - m;
    f32x2 o; o.x = v.x < 0.f ? m.x : r.x; o.y = v.y < 0.f ? m.y : r.y; return o;
}

struct EpiF32 {
    static constexpr bool PERM = false, AFTER_DRAIN = false;
    float* C; int ldc; const float* bias;
    __device__ __forceinline__ void operator()(const f32x4 (&acc)[2][2][4][2], const Unit& u, int wr, int wc, int fr, int fq) const {
        const int row0 = u.pm * BM + wr * 64 + fr, col0 = u.pn * BM + wc * 32 + 4 * fq;
        f32x4 bv[2][2];
#pragma unroll
        for (int bj = 0; bj < 2; ++bj)
#pragma unroll
            for (int n = 0; n < 2; ++n) bv[bj][n] = bias ? *(const f32x4*)(bias + col0 + bj * HALF + n * 16) : (f32x4){0.f, 0.f, 0.f, 0.f};
#pragma unroll
        for (int ai = 0; ai < 2; ++ai)
#pragma unroll
            for (int m = 0; m < 4; ++m) { float* rowp = C + (size_t)(row0 + ai * HALF + m * 16) * ldc + col0;
#pragma unroll
                for (int bj = 0; bj < 2; ++bj)
#pragma unroll
                    for (int n = 0; n < 2; ++n) *(f32x4*)(rowp + bj * HALF + n * 16) = acc[ai][bj][m][n] + bv[bj][n]; }
    }
};
template <int ACT  > struct EpiBf16 {
    static constexpr bool PERM = true, AFTER_DRAIN = false;
    bf16_t* O; int ldc; const float* bias; int split_cols; size_t split_stride;
    __device__ __forceinline__ void operator()(const f32x4 (&acc)[2][2][4][2], const Unit& u, int wr, int wc, int fr, int fq) const {
        const int row0 = u.pm * BM + wr * 64 + fr; int colt = u.pn * BM; bf16_t* base = O;
        if (split_cols) { const int t = colt / split_cols; base += (size_t)t * split_stride; colt -= t * split_cols; }
        const int col0 = colt + wc * 32 + 8 * fq, bcol0 = u.pn * BM + wc * 32 + 8 * fq;
        f32x4 bv[2][2];
#pragma unroll
        for (int bj = 0; bj < 2; ++bj)
#pragma unroll
            for (int n = 0; n < 2; ++n) bv[bj][n] = bias ? *(const f32x4*)(bias + bcol0 + bj * HALF + 4 * n) : (f32x4){0.f, 0.f, 0.f, 0.f};
#pragma unroll
        for (int ai = 0; ai < 2; ++ai)
#pragma unroll
            for (int m = 0; m < 4; ++m) { bf16_t* rowp = base + (size_t)(row0 + ai * HALF + m * 16) * ldc + col0;
#pragma unroll
                for (int bj = 0; bj < 2; ++bj) { f32x4 v0 = acc[ai][bj][m][0] + bv[bj][0], v1 = acc[ai][bj][m][1] + bv[bj][1];
                    if (ACT == 1) { f32x2 a = gelu_pk((f32x2){v0[0], v0[1]}), b = gelu_pk((f32x2){v0[2], v0[3]}), c = gelu_pk((f32x2){v1[0], v1[1]}), d = gelu_pk((f32x2){v1[2], v1[3]});
                        v0 = (f32x4){a.x, a.y, b.x, b.y}; v1 = (f32x4){c.x, c.y, d.x, d.y}; }
                    if (ACT == 2) {
#pragma unroll
                        for (int j = 0; j < 4; ++j) { v0[j] = 0.5f * v0[j] * (1.0f + erff(v0[j] * 0.70710678f)); v1[j] = 0.5f * v1[j] * (1.0f + erff(v1[j] * 0.70710678f)); } }
                    u32x4 w; w.x = cvt_pk_bf16(v0[0], v0[1]); w.y = cvt_pk_bf16(v0[2], v0[3]); w.z = cvt_pk_bf16(v1[0], v1[1]); w.w = cvt_pk_bf16(v1[2], v1[3]);
                    *(u32x4*)(rowp + bj * HALF) = w; } }
    }
};

template <class Epi, class Sched, bool STAMP = false>
__device__ __forceinline__ void gemm_phase(PG8_LAS unsigned char* lds, const Gemm g, const Sched& S, const Epi& E, unsigned long long* stamps) {
    int tid_ = threadIdx.x; asm volatile("" : "+v"(tid_));
    const int tid = tid_, wid = __builtin_amdgcn_readfirstlane(tid >> 6), lane = tid & 63, wr = wid >> 2, wc = wid & 3, fr = lane & 15, fq = lane >> 4;
    const int K = g.K, nt = K / BK;
    constexpr bool GATHER = Sched::GATHER;
    int ts_lo = 0, ts_hi = 0, nts = 0; const unsigned long long rt_entry = STAMP ? (unsigned long long)wall_clock64() : 0ull;
#define PG8_STAMP() do { if (STAMP && wid == 0 && nts < 64) { const unsigned long long _c = (unsigned long long)clock64(); \
        ts_lo = (lane == nts) ? (int)(unsigned)_c : ts_lo; ts_hi = (lane == nts) ? (int)(unsigned)(_c >> 32) : ts_hi; ++nts; } } while (0)
    PG8_STAMP();
    unsigned voffA[2], voffB[2]; int rowA[2];
#pragma unroll
    for (int i = 0; i < 2; ++i) { int R, C; stage_rc(tid * 16 + i * 8192, R, C); const int Rb = Epi::PERM ? ((R & ~31) + perm32(R & 31)) : R;
        rowA[i] = R; voffA[i] = GATHER ? (unsigned)C * 2u : (unsigned)(R * K + C) * 2u; voffB[i] = (unsigned)(Rb * K + C) * 2u; }
    const size_t kstep = (size_t)(BK * 2);
    const size_t hstep = (size_t)HALF * K * 2;
    const size_t tstep = 2 * hstep;
    const unsigned ldsw = (unsigned)wid * 1024u;
    const int aoff = lds_byte(wr * 64 + fr, fq * 8), boff = lds_byte(wc * 32 + fr, fq * 8);
#define PG8_SA(b, h) (((b) * 2 + (h)) * HTB)
#define PG8_SB(b, h) ((4 + (b) * 2 + (h)) * HTB)
#define PG8_STAGE(bufoff, gbase, voff) do { _Pragma("unroll") for (int _i = 0; _i < 2; ++_i) \
        __builtin_amdgcn_global_load_lds((const unsigned*)((const char*)(gbase) + (voff)[_i]), (PG8_LAS unsigned*)(lds + (bufoff) + ldsw + _i * 8192), 16, 0, 0); } while (0)
#define PG8_STAGE_A(bufoff, gbase, h, gv) do { if constexpr (GATHER) { PG8_STAGE(bufoff, gbase, (gv)[h]); } else { PG8_STAGE(bufoff, (gbase) + (h) * hstep, voffA); } } while (0)
#define PG8_TOKSLOT(s) ((PG8_LAS int*)(lds + STAGE_BYTES + 1024 + ((s) & 1) * 1024))
#define PG8_LDA(dst, b, h) do { _Pragma("unroll") for (int m = 0; m < 4; ++m) _Pragma("unroll") for (int k = 0; k < 2; ++k) dst[m][k] = *(const PG8_LAS bf16x8*)(lds + PG8_SA(b, h) + aoff + m * 2048 + k * 1024); } while (0)
#define PG8_LDB(dst, b, h) do { _Pragma("unroll") for (int n = 0; n < 2; ++n) _Pragma("unroll") for (int k = 0; k < 2; ++k) dst[n][k] = *(const PG8_LAS bf16x8*)(lds + PG8_SB(b, h) + boff + n * 2048 + k * 1024); } while (0)
#define PG8_MMA(ai, bj, At, Bt) do { __builtin_amdgcn_s_setprio(1); _Pragma("unroll") for (int m = 0; m < 4; ++m) _Pragma("unroll") for (int n = 0; n < 2; ++n) _Pragma("unroll") for (int k = 0; k < 2; ++k) \
        acc[ai][bj][m][n] = __builtin_amdgcn_mfma_f32_16x16x32_bf16(Bt[n][k], At[m][k], acc[ai][bj][m][n], 0, 0, 0); __builtin_amdgcn_s_setprio(0); } while (0)
#define PG8_WAIT_V(n) asm volatile("s_waitcnt vmcnt(" #n ")" ::: "memory")
#define PG8_WAIT_L(n) asm volatile("s_waitcnt lgkmcnt(" #n ")" ::: "memory")
#define PG8_BAR __builtin_amdgcn_s_barrier()
#define PG8_SCHED __builtin_amdgcn_sched_barrier(0)
    Unit cur, nxt; int ui = 0;
    if (!S.next(0, cur)) return;
    f32x4 acc[2][2][4][2];
#pragma unroll
    for (int a = 0; a < 2; ++a)
#pragma unroll
        for (int b = 0; b < 2; ++b)
#pragma unroll
            for (int m = 0; m < 4; ++m)
#pragma unroll
                for (int n = 0; n < 2; ++n) acc[a][b][m][n] = (f32x4){0.f, 0.f, 0.f, 0.f};
    bf16x8 At[4][2], B0[2][2], B1[2][2];
    const char* cA = (const char*)g.A + (GATHER ? (size_t)0 : (size_t)cur.pm * tstep); const char* cB = (const char*)g.Bt + (size_t)cur.pn * tstep + (size_t)cur.e * g.estride * 2;
    S.a_ready(cur);
    unsigned gcur[2][2], gnxt[2][2], gs[2][2];
    if constexpr (GATHER) {
        if (tid < 256) PG8_TOKSLOT(0)[tid] = S.tok[cur.pm * 256 + tid];
        __syncthreads();
#pragma unroll
        for (int h = 0; h < 2; ++h)
#pragma unroll
            for (int i = 0; i < 2; ++i) { gcur[h][i] = (unsigned)PG8_TOKSLOT(0)[h * HALF + rowA[i]] * (unsigned)(K * 2) + voffA[i]; gnxt[h][i] = gcur[h][i]; gs[h][i] = gcur[h][i]; }
    }
    PG8_STAGE(PG8_SB(0, 0), cB, voffB); PG8_STAGE_A(PG8_SA(0, 0), cA, 0, gcur); PG8_STAGE(PG8_SB(0, 1), cB + hstep, voffB); PG8_STAGE_A(PG8_SA(0, 1), cA, 1, gcur);
    if (wr == 1) PG8_BAR;
    PG8_WAIT_V(4); PG8_BAR;
    PG8_STAGE(PG8_SB(1, 0), cB + kstep, voffB); PG8_STAGE_A(PG8_SA(1, 0), cA + kstep, 0, gcur); PG8_STAGE(PG8_SB(1, 1), cB + hstep + kstep, voffB);
    PG8_WAIT_V(6); PG8_BAR;
    PG8_STAMP();
    for (;;) {
        const bool has_next = S.next(ui + 1, nxt);
        if constexpr (GATHER) { if (has_next && wid < 4)
            __builtin_amdgcn_global_load_lds((const unsigned*)(S.tok + nxt.pm * 256 + wid * 64 + lane), (PG8_LAS unsigned*)((PG8_LAS unsigned char*)PG8_TOKSLOT(ui + 1) + wid * 256), 4, 0, 0); }
        const char* nA = GATHER ? (const char*)g.A : has_next ? (const char*)g.A + (size_t)nxt.pm * tstep : cA; const char* nB = has_next ? (const char*)g.Bt + (size_t)nxt.pn * tstep + (size_t)nxt.e * g.estride * 2 : cB;
        for (int t = 0; t < nt; t += 2) {
            const bool last = (t == nt - 2);
            const char* a1 = cA + (size_t)(t + 1) * kstep;
            const char* a2 = last ? nA : cA + (size_t)(t + 2) * kstep; const char* b2 = last ? nB : cB + (size_t)(t + 2) * kstep;
            const char* a3 = a2 + kstep; const char* b3 = b2 + kstep;
            if (last && has_next) S.a_ready(nxt);
            if constexpr (GATHER) {
                if (last && has_next) {
#pragma unroll
                    for (int h = 0; h < 2; ++h)
#pragma unroll
                        for (int i = 0; i < 2; ++i) gnxt[h][i] = (unsigned)PG8_TOKSLOT(ui + 1)[h * HALF + rowA[i]] * (unsigned)(K * 2) + voffA[i];
                }
#pragma unroll
                for (int h = 0; h < 2; ++h)
#pragma unroll
                    for (int i = 0; i < 2; ++i) gs[h][i] = last ? gnxt[h][i] : gcur[h][i];
            }
            PG8_LDB(B0, 0, 0); PG8_SCHED; PG8_LDA(At, 0, 0); PG8_STAGE_A(PG8_SA(1, 1), a1, 1, gcur);
            PG8_WAIT_L(8); PG8_BAR; PG8_WAIT_L(0); PG8_MMA(0, 0, At, B0); PG8_BAR; PG8_SCHED;
            PG8_LDB(B1, 0, 1); PG8_STAGE(PG8_SB(0, 0), b2, voffB);
            PG8_BAR; PG8_WAIT_L(0); PG8_MMA(0, 1, At, B1); PG8_BAR;
            PG8_LDA(At, 0, 1); PG8_STAGE_A(PG8_SA(0, 0), a2, 0, gs);
            PG8_BAR; PG8_WAIT_L(0); PG8_MMA(1, 0, At, B0); PG8_BAR; PG8_SCHED;
            PG8_STAGE(PG8_SB(0, 1), b2 + hstep, voffB);
            PG8_WAIT_V(6); PG8_BAR; PG8_MMA(1, 1, At, B1); PG8_BAR;
            PG8_LDB(B0, 1, 0); PG8_SCHED; PG8_LDA(At, 1, 0); PG8_STAGE_A(PG8_SA(0, 1), a2, 1, gs);
            PG8_WAIT_L(8); PG8_BAR; PG8_WAIT_L(0); PG8_MMA(0, 0, At, B0); PG8_BAR; PG8_SCHED;
            PG8_LDB(B1, 1, 1); PG8_STAGE(PG8_SB(1, 0), b3, voffB);
            PG8_BAR; PG8_WAIT_L(0); PG8_MMA(0, 1, At, B1); PG8_BAR;
            PG8_LDA(At, 1, 1); PG8_STAGE_A(PG8_SA(1, 0), a3, 0, gs);
            PG8_BAR; PG8_WAIT_L(0); PG8_MMA(1, 0, At, B0); PG8_BAR; PG8_SCHED;
            PG8_STAGE(PG8_SB(1, 1), b3 + hstep, voffB);
            PG8_WAIT_V(6); PG8_BAR; PG8_MMA(1, 1, At, B1); PG8_BAR;
        }
        PG8_STAMP();
        if constexpr (!Epi::AFTER_DRAIN) { E(acc, cur, wr, wc, fr, fq); S.done(cur); }
        PG8_STAMP();
        if (!has_next) break;
#pragma unroll
        for (int a = 0; a < 2; ++a)
#pragma unroll
            for (int b = 0; b < 2; ++b)
#pragma unroll
                for (int m = 0; m < 4; ++m)
#pragma unroll
                    for (int n = 0; n < 2; ++n) acc[a][b][m][n] = (f32x4){0.f, 0.f, 0.f, 0.f};
        cur = nxt; cA = nA; cB = nB; ++ui;
        if constexpr (GATHER) {
#pragma unroll
            for (int h = 0; h < 2; ++h)
#pragma unroll
                for (int i = 0; i < 2; ++i) gcur[h][i] = gnxt[h][i];
        }
    }
    PG8_WAIT_V(0);
    if (wr == 0) PG8_BAR;
    PG8_BAR;
    if constexpr (Epi::AFTER_DRAIN) { E.fused(acc, cur, wr, wc, fr, fq, lds, wid, lane); S.done(cur); }
    PG8_STAMP();
    if (STAMP && wid == 0) { stamps[lane] = lane < nts ? (((unsigned long long)(unsigned)ts_hi << 32) | (unsigned)ts_lo) : 0ull;
        if (lane == 62) stamps[62] = rt_entry; if (lane == 63) stamps[63] = (unsigned long long)wall_clock64(); }
#undef PG8_STAMP
#undef PG8_SA
#undef PG8_SB
#undef PG8_STAGE
#undef PG8_STAGE_A
#undef PG8_TOKSLOT
#undef PG8_LDA
#undef PG8_LDB
#undef PG8_MMA
#undef PG8_WAIT_V
#undef PG8_WAIT_L
#undef PG8_BAR
#undef PG8_SCHED
}
}
namespace pg8 {
struct EpiRes {
    static constexpr bool PERM = false, AFTER_DRAIN = false;
    const float* base_lat; const float* base_ctx; float* out_lat; float* out_ctx; const float* gvec;
    __device__ __forceinline__ void operator()(const f32x4 (&acc)[2][2][4][2], const Unit& u, int wr, int wc, int fr, int fq) const {
        const bool isctx = u.pm >= 128;
        const int prow = (isctx ? (u.pm - 128) : u.pm) * BM;
        const float* base = isctx ? base_ctx : base_lat; float* out = isctx ? out_ctx : out_lat;
        const float* gv = gvec + (size_t)(isctx ? 8 : (u.pm >> 4)) * 6144;
        const int row0 = prow + wr * 64 + fr, col0 = u.pn * BM + wc * 32 + 4 * fq;
        f32x4 gvv[2][2];
#pragma unroll
        for (int bj = 0; bj < 2; ++bj)
#pragma unroll
            for (int n = 0; n < 2; ++n) gvv[bj][n] = *(const f32x4*)(gv + col0 + bj * HALF + n * 16);
#pragma unroll
        for (int ai = 0; ai < 2; ++ai)
#pragma unroll
            for (int m = 0; m < 4; ++m) { const size_t off = (size_t)(row0 + ai * HALF + m * 16) * 1024 + col0;
#pragma unroll
                for (int bj = 0; bj < 2; ++bj)
#pragma unroll
                    for (int n = 0; n < 2; ++n) { const f32x4 b = *(const f32x4*)(base + off + bj * HALF + n * 16);
                        *(f32x4*)(out + off + bj * HALF + n * 16) = b + gvv[bj][n] * acc[ai][bj][m][n]; } }
    }
};
struct EpiSwiglu {
    static constexpr bool PERM = true, AFTER_DRAIN = false;
    bf16_t* O; int ldc;
    __device__ __forceinline__ void operator()(const f32x4 (&acc)[2][2][4][2], const Unit& u, int wr, int wc, int fr, int fq) const {
        const int row0 = u.pm * BM + wr * 64 + fr, col0 = u.pn * HALF + wc * 32 + 8 * fq;
#pragma unroll
        for (int ai = 0; ai < 2; ++ai)
#pragma unroll
            for (int m = 0; m < 4; ++m) { bf16_t* rowp = O + (size_t)(row0 + ai * HALF + m * 16) * ldc + col0;
                float h[8];
#pragma unroll
                for (int n = 0; n < 2; ++n)
#pragma unroll
                    for (int j = 0; j < 4; ++j) { const float g = acc[ai][0][m][n][j], up = acc[ai][1][m][n][j]; h[n * 4 + j] = g * __builtin_amdgcn_rcpf(1.0f + __expf(-g)) * up; }
                u32x4 w; w.x = cvt_pk_bf16(h[0], h[1]); w.y = cvt_pk_bf16(h[2], h[3]); w.z = cvt_pk_bf16(h[4], h[5]); w.w = cvt_pk_bf16(h[6], h[7]);
                *(u32x4*)rowp = w; }
    }
};
struct MoeOrder {
    static constexpr bool GATHER = false;
    int nN, G, c, nunits; const int* tab;
    __device__ void init(const int* tab_, int nN_, int G_, int c_) { tab = tab_; nN = nN_; G = G_; c = c_; nunits = tab_[0] * nN_; }
    __device__ bool next(int i, Unit& u) const {
        const int L = i * G + c; if (L >= nunits) return false;
        const int q = nunits / NXCD, r = nunits % NXCD, xcd = L % NXCD, off = L / NXCD;
        const int w = (xcd < r ? xcd * (q + 1) : r * (q + 1) + (xcd - r) * q) + off;
        u.pm = w / nN; u.pn = w - u.pm * nN; u.e = tab[1 + u.pm]; return true;
    }
    __device__ __forceinline__ void a_ready(const Unit&) const {}
    __device__ __forceinline__ void done(const Unit&) const {}
};
struct MoeOrderG : MoeOrder { static constexpr bool GATHER = true; const int* tok; };
}
enum { I_X = 0, I_C, I_CTX, I_CCTX, I_MODW, I_MODB, I_NMIXG, I_NFFNG, I_WIN, I_WOUT, I_LCW, I_LCB, I_LWA, I_LBA, I_LWX, I_LBX, I_LLAM,
       I_RMU, I_RWUP, I_RW0, I_RAUP, I_RA0, I_RGUP, I_RKK, I_RKA, I_RRK, I_RLNG, I_RLNB, I_MIB, I_MFB, I_MNG, I_GCW, I_GALOG, I_GDTB, I_GNG,
       I_FWG, I_FWU, I_FWD, I_MROUTER, I_MWG, I_MWU, I_MWD, I_FNG, N_IN };
struct Args { const float* in[N_IN]; float* out; unsigned char* ws; int ph_lo, ph_hi; };
struct Ctx {
    const float* const* in; float* out; unsigned char* ws; LAS unsigned char* lds;
    int tid, lane, wave, G, wg;
};
#define WSP(T, off) ((T*)(C.ws + (off)))

__device__ __forceinline__ int seqrow_raster(int i, int d, int b) {
    if (i < CTXL) { const int p = d ? (CTXL - 1 - i) : i; return T_LAT + b * CTXL + p; }
    const int j = i - CTXL; const int p = d ? (SEQ - 1 - j) : j; return b * SEQ + p;
}
__device__ __forceinline__ int seqrow_cm(int i, int d, int b) {
    if (i < CTXL) { const int p = d ? (CTXL - 1 - i) : i; return T_LAT + b * CTXL + p; }
    const int j = i - CTXL; const int p = d ? (SEQ - 1 - j) : j; return b * SEQ + (p & 63) * 64 + (p >> 6);
}

__device__ __forceinline__ void phase_pre(const Ctx& C) {
    LAS float* sc = (LAS float*)C.lds;
    LAS float* red = sc + 9 * 1024;
    float* modv = WSP(float, WS_MODV);
    bool filled = false;
    for (int it = C.wg; it < DEPTH * 48; it += C.G) {
        if (!filled) {
            for (int i = C.tid; i < 9 * 1024; i += NTHR) { const float v = i < 8192 ? C.in[I_C][i] : C.in[I_CCTX][i - 8192]; sc[i] = siluf_(v); }
            filled = true; __syncthreads();
        }
        const int l = it / 48, jb = it % 48, col = C.tid & 127, kg = C.tid >> 7;
        const float* W = C.in[I_MODW] + (size_t)l * 1024 * 6144 + jb * 128 + col;
        float acc[9];
#pragma unroll
        for (int r = 0; r < 9; ++r) acc[r] = 0.f;
        for (int k = kg * 256; k < kg * 256 + 256; ++k) { const float w = W[(size_t)k * 6144];
#pragma unroll
            for (int r = 0; r < 9; ++r) acc[r] += sc[r * 1024 + k] * w; }
#pragma unroll
        for (int r = 0; r < 9; ++r) red[(kg * 9 + r) * 128 + col] = acc[r];
        __syncthreads();
        for (int i = C.tid; i < 9 * 128; i += NTHR) { const int r = i >> 7, cc = i & 127;
            const float s = red[(0 * 9 + r) * 128 + cc] + red[(1 * 9 + r) * 128 + cc] + red[(2 * 9 + r) * 128 + cc] + red[(3 * 9 + r) * 128 + cc];
            modv[((size_t)l * 9 + r) * 6144 + jb * 128 + cc] = s + C.in[I_MODB][l * 6144 + jb * 128 + cc]; }
        __syncthreads();
    }
}

__device__ __forceinline__ void tr_item(const float* src, size_t ld, int k0, int ns0, bf16* dst, int drow0, int Kd, LAS float* scr, int lane, bool zero) {
    if (!zero) {
#pragma unroll 8
        for (int i = 0; i < 32; ++i) { const int kk = 2 * i + (lane >> 5); scr[kk * 33 + (lane & 31)] = src[(size_t)(k0 + kk) * ld + ns0 + (lane & 31)]; }
    }
    LDS_WAIT(); asm volatile("" ::: "memory");
    const int c = lane & 7;
#pragma unroll
    for (int j = 0; j < 4; ++j) { const int n = (lane >> 3) + 8 * j; const LAS float* s = scr + (8 * c) * 33 + n;
        v4u o; o.x = pk2(s[0 * 33], s[1 * 33]); o.y = pk2(s[2 * 33], s[3 * 33]); o.z = pk2(s[4 * 33], s[5 * 33]); o.w = pk2(s[6 * 33], s[7 * 33]);
        if (zero) o = (v4u){0u, 0u, 0u, 0u};
        *(v4u*)(dst + (size_t)(drow0 + n) * Kd + k0 + 8 * c) = o; }
    LDS_WAIT(); asm volatile("" ::: "memory");
}
__device__ __forceinline__ void convert_small(const Ctx& C, int l) {
    {
        bf16* lw = WSP(bf16, WS_LRUWT);
        for (int k = 0; k < 2 * 2 * 4 * 4096 / (128 * NTHR); ++k) {
            const int e = k * 128 * NTHR + C.wg * NTHR + C.tid;
            if (C.wg < 128) {
            const int i = e & 63, j = (e >> 6) & 63, hd = (e >> 12) & 3, g = (e >> 14) & 1, d = e >> 15;
            const float* src = (g ? C.in[I_LWX] : C.in[I_LWA]) + ((size_t)((l * 2 + d) * 4 + hd) * 64 + i) * 64 + j;
            lw[e] = (bf16)f2bf(*src);
            }
        }
    }
    if (C.wg >= 128 && C.wg < 224) {
        bf16* rw = WSP(bf16, WS_RWT);
        const int e = (C.wg - 128) * NTHR + C.tid;
        if (e < 32768) { const int r = e & 31, ch = (e >> 5) & 255, d = (e >> 13) & 1, isa = e >> 14;
            rw[e] = (bf16)f2bf((isa ? C.in[I_RAUP] : C.in[I_RWUP])[((size_t)(l * 2 + d) * 32 + r) * GW + ch]); }
        else { const int e2 = e - 32768, j = e2 & 63, ch = e2 >> 6; rw[e] = (bf16)f2bf(C.in[I_RGUP][((size_t)l * 64 + j) * GW + ch]); }
    }
}
__device__ __forceinline__ void convert_items(const Ctx& C, int l, int what, int gw, int NGW) {
    LAS float* scr = (LAS float*)(C.lds + C.wave * 8704);
    constexpr int I_IN = 16 * 112, I_OUT = 16 * 32, I_GU = 16 * 176, I_DN = 44 * 32, I_E = 16 * 88 + 22 * 32;
    const bool moe = l & 1; const int li = l >> 1;
    const int lo_it = (what & 1) ? 0 : I_IN, hi_it = (what & 2) ? I_IN + I_OUT + (moe ? NE * I_E : (I_GU + I_DN)) : I_IN;
    bf16* win = WSP(bf16, WS_WIN); bf16* wout = WSP(bf16, WS_WOUT); bf16* wgu = WSP(bf16, WS_WGU); bf16* wdn = WSP(bf16, WS_WDN);
    for (int it = lo_it + gw; it < hi_it; it += NGW) {
        int r = it;
        if (r < I_IN) { const int kb = r / 112, nb = r % 112; tr_item(C.in[I_WIN] + (size_t)l * 1024 * IN_COLS, IN_COLS, 64 * kb, 32 * nb, win, 32 * nb, 1024, scr, C.lane, nb == 111); continue; }
        r -= I_IN;
        if (r < I_OUT) { const int kb = r / 32, nb = r % 32; tr_item(C.in[I_WOUT] + (size_t)l * 1024 * 1024, 1024, 64 * kb, 32 * nb, wout, 32 * nb, 1024, scr, C.lane, false); continue; }
        r -= I_OUT;
        if (!moe) {
            if (r < I_GU) { const int kb = r / 176, nb = r % 176, tile = nb >> 3, q = nb & 7;
                const float* src = (q < 4 ? C.in[I_FWG] : C.in[I_FWU]) + (size_t)li * 1024 * DFF;
                tr_item(src, DFF, 64 * kb, tile * 128 + (q & 3) * 32, wgu, 32 * nb, 1024, scr, C.lane, false); continue; }
            r -= I_GU;
            { const int kb = r / 32, nb = r % 32; tr_item(C.in[I_FWD] + (size_t)li * DFF * 1024, 1024, 64 * kb, 32 * nb, wdn, 32 * nb, DFF, scr, C.lane, false); }
        } else {
            const int e = r / I_E; int rr = r % I_E;
            if (rr < 16 * 88) { const int kb = rr / 88, nb = rr % 88, tile = nb >> 3, q = nb & 7;
                const float* src = (q < 4 ? C.in[I_MWG] : C.in[I_MWU]) + ((size_t)li * NE + e) * 1024 * DFE;
                tr_item(src, DFE, 64 * kb, tile * 128 + (q & 3) * 32, wgu + (size_t)e * 2 * DFE * 1024, 32 * nb, 1024, scr, C.lane, false); continue; }
            rr -= 16 * 88;
            { const int kb = rr / 32, nb = rr % 32; tr_item(C.in[I_MWD] + ((size_t)li * NE + e) * DFE * 1024, 1024, 64 * kb, 32 * nb, wdn + (size_t)e * 1024 * DFE, 32 * nb, DFE, scr, C.lane, false); }
        }
    }
}

template <bool ROUTE>
__device__ __forceinline__ void norm_rows(const Ctx& C, int l, const float* xlat, const float* xctx, const float* gain, int shoff, int scoff, int nrows, int moe_li) {
    const float* modv = WSP(float, WS_MODV) + (size_t)l * 9 * 6144;
    bf16* hb = WSP(bf16, WS_HB);
    const int gw = C.wg * NWAVES + C.wave, NGW = C.G * NWAVES;
    LAS unsigned* lcnt = (LAS unsigned*)(C.lds + 65536);
    unsigned* route = WSP(unsigned, WS_ROUTE);
    if (ROUTE) { if (C.tid < 8) lcnt[C.tid] = 0u; __syncthreads(); }
    f32x4 gv[4];
#pragma unroll
    for (int j = 0; j < 4; ++j) gv[j] = *(const f32x4*)(gain + 4 * C.lane + 256 * j);
    for (int m = gw; m < nrows; m += NGW) {
        const bool isctx = m >= T_LAT;
        const float* xr = isctx ? xctx + (size_t)(m - T_LAT) * 1024 : xlat + (size_t)m * 1024;
        const float* mv = modv + (size_t)(isctx ? 8 : (m >> 12)) * 6144;
        f32x4 v[4]; float s = 0.f;
#pragma unroll
        for (int j = 0; j < 4; ++j) { v[j] = *(const f32x4*)(xr + 4 * C.lane + 256 * j); s += (v[j].x * v[j].x + v[j].y * v[j].y) + (v[j].z * v[j].z + v[j].w * v[j].w); }
        const float rs = rsqrtf_(wave_sum(s) * (1.0f / 1024.0f) + 1e-6f);
#pragma unroll
        for (int j = 0; j < 4; ++j) { const f32x4 sh = *(const f32x4*)(mv + shoff + 4 * C.lane + 256 * j), scl = *(const f32x4*)(mv + scoff + 4 * C.lane + 256 * j);
            v[j] = (v[j] * rs * gv[j]) * (scl + 1.0f) + sh;
            v2u o; o.x = pk2(v[j].x, v[j].y); o.y = pk2(v[j].z, v[j].w);
            *(v2u*)(hb + (size_t)m * 1024 + 4 * C.lane + 256 * j) = o; }
        if (ROUTE) {
            const float* rt = C.in[I_MROUTER] + (size_t)moe_li * 1024 * NE;
            float lg[8];
#pragma unroll
            for (int e = 0; e < 8; ++e) lg[e] = 0.f;
#pragma unroll
            for (int j = 0; j < 4; ++j)
#pragma unroll
                for (int q = 0; q < 4; ++q) { const int k = 4 * C.lane + 256 * j + q; const f32x4 r0 = *(const f32x4*)(rt + (size_t)k * 8), r1 = *(const f32x4*)(rt + (size_t)k * 8 + 4); const float hv = v[j][q];
                    lg[0] += hv * r0.x; lg[1] += hv * r0.y; lg[2] += hv * r0.z; lg[3] += hv * r0.w; lg[4] += hv * r1.x; lg[5] += hv * r1.y; lg[6] += hv * r1.z; lg[7] += hv * r1.w; }
#pragma unroll
            for (int e = 0; e < 8; ++e) lg[e] = wave_sum(lg[e]);
            int e0 = 0; float l0 = lg[0];
#pragma unroll
            for (int e = 1; e < 8; ++e) if (lg[e] > l0) { l0 = lg[e]; e0 = e; }
            int e1 = (e0 == 0) ? 1 : 0; float l1 = -3.0e38f;
#pragma unroll
            for (int e = 0; e < 8; ++e) if (e != e0 && lg[e] > l1) { l1 = lg[e]; e1 = e; }
            const float w0 = __builtin_amdgcn_rcpf(1.0f + __expf(l1 - l0)), w1 = 1.0f - w0;
            if (C.lane == 0) {
                const unsigned r0 = atomicAdd((unsigned*)&lcnt[e0], 1u), r1 = atomicAdd((unsigned*)&lcnt[e1], 1u);
                v4u a; a.x = (unsigned)e0; a.y = (unsigned)e1; a.z = r0; a.w = r1;
                *(v4u*)(route + (size_t)m * 8) = a;
                v2u b; b.x = __builtin_bit_cast(unsigned, w0); b.y = __builtin_bit_cast(unsigned, w1);
                *(v2u*)(route + (size_t)m * 8 + 4) = b;
            }
        }
    }
    if (ROUTE) {
        __syncthreads();
        if (C.tid < 8) { unsigned* gc = WSP(unsigned, WS_CTL) + CW_MOECNT + 64 * moe_li; const unsigned base = atomicAdd(gc + C.tid, lcnt[C.tid]); WSP(unsigned, WS_WGBASE)[C.wg * 8 + C.tid] = base; }
    }
}
#define RAW_BARRIER() do { asm volatile("s_waitcnt lgkmcnt(0)" ::: "memory"); __builtin_amdgcn_s_barrier(); asm volatile("" ::: "memory"); } while (0)
__device__ __forceinline__ void gdn_prep(const Ctx& C, int l, int b, int c) {
    const bf16* P = WSP(const bf16, WS_P); bf16* gq = WSP(bf16, WS_GQ);
    const bool isctx = c < 4; const int p0 = isctx ? c * 64 : (c - 4) * 64; const int Lp = isctx ? CTXL : SEQ;
    const int ch = 4 * C.lane;
    auto rowof = [&](int p) -> int { return isctx ? (T_LAT + b * CTXL + p) : (b * SEQ + (p & 63) * 64 + (p >> 6)); };
    f32x4 cw[4][3], x[4][3];
#pragma unroll
    for (int j = 0; j < 4; ++j)
#pragma unroll
        for (int g = 0; g < 3; ++g) cw[j][g] = *(const f32x4*)(C.in[I_GCW] + ((size_t)l * 4 + j) * 768 + g * 256 + ch);
    const int tb = p0 + C.wave * 8;
    auto ldrow = [&](int p, f32x4 (&dst)[3]) {
        if (p >= 0 && p < Lp) { const bf16* pr = P + (size_t)rowof(p) * PLD + OFF_D + ch;
#pragma unroll
            for (int g = 0; g < 3; ++g) dst[g] = ld4bf(pr + g * 256); }
        else {
#pragma unroll
            for (int g = 0; g < 3; ++g) dst[g] = (f32x4){0.f, 0.f, 0.f, 0.f}; }
    };
    ldrow(tb - 2, x[0]); ldrow(tb - 1, x[1]); ldrow(tb, x[2]);
#pragma unroll
    for (int t = 0; t < 8; ++t) {
        ldrow(tb + t + 1, x[3]);
        bf16* orow = gq + (size_t)rowof(tb + t) * 768 + ch;
#pragma unroll
        for (int g = 0; g < 3; ++g) {
            f32x4 v = cw[0][g] * x[0][g] + cw[1][g] * x[1][g] + cw[2][g] * x[2][g] + cw[3][g] * x[3][g];
            v = (f32x4){siluf_(v.x), siluf_(v.y), siluf_(v.z), siluf_(v.w)};
            if (g < 2) { const float ss = row16_sum((v.x * v.x + v.y * v.y) + (v.z * v.z + v.w * v.w)); v = v * (rsqrtf_(ss + 1e-6f) * (g == 0 ? 0.125f : 1.0f)); }
            st4bf(orow + g * 256, v);
        }
#pragma unroll
        for (int g = 0; g < 3; ++g) { x[0][g] = x[1][g]; x[1][g] = x[2][g]; x[2][g] = x[3][g]; }
    }
}
__device__ __forceinline__ void finish_rows(const Ctx& C, int l, int nrows) {
    const bf16* P = WSP(const bf16, WS_P); bf16* yc = WSP(bf16, WS_HB);
    const bf16* ob = WSP(const bf16, WS_OUTB); const bf16* oc = WSP(const bf16, WS_OUTC); const bf16* od = WSP(const bf16, WS_OUTD);
    const bf16* gg = WSP(const bf16, WS_G); const float* bonus = WSP(const float, WS_BONUS);
    const float* mu = C.in[I_RMU] + (size_t)l * 2 * B_COLS;
    const int gw = C.wg * NWAVES + C.wave, NGW = C.G * NWAVES, lane = C.lane, ch = 4 * lane, hh = lane >> 4;
    const f32x4 lng = *(const f32x4*)(C.in[I_RLNG] + l * GW + ch), lnb = *(const f32x4*)(C.in[I_RLNB] + l * GW + ch);
    const f32x4 mng = *(const f32x4*)(C.in[I_MNG] + l * GW + ch), gng = *(const f32x4*)(C.in[I_GNG] + l * GW + ch);
    const f32x4 mu0 = *(const f32x4*)(mu + 512 + ch), mu1 = *(const f32x4*)(mu + B_COLS + 512 + ch);
    const size_t o2 = (size_t)T_ALL * 256;
#pragma unroll 2
    for (int m = gw; m < nrows; m += NGW) {
        const bool isctx = m >= T_LAT; const int Lp = isctx ? CTXL : SEQ; const int p = isctx ? ((m - T_LAT) & (CTXL - 1)) : (m & (SEQ - 1));
        const f32x4 yb = ld4bf(ob + (size_t)m * 256 + ch) + ld4bf(ob + o2 + (size_t)m * 256 + ch);
        const f32x4 ycv = ld4bf(oc + (size_t)m * 256 + ch) + ld4bf(oc + o2 + (size_t)m * 256 + ch);
        const f32x4 yd = ld4bf(od + (size_t)m * 256 + ch) + ld4bf(od + o2 + (size_t)m * 256 + ch);
        const bf16* pr = P + (size_t)m * PLD;
        const f32x4 vs = ld4bf(WSP(const bf16, WS_RKV) + (size_t)m * 768 + 512 + ch);
        const f32x4 og = ld4bf(pr + OFF_C + 768 + ch), gd = ld4bf(pr + OFF_D + 768 + ch), gr = ld4bf(gg + (size_t)m * 256 + ch);
        const float bn = bonus[(size_t)m * 4 + hh];
        *(v2u*)(yc + (size_t)m * 1024 + ch) = *(const v2u*)(pr + 256 + ch);
        {
            const float mean = row16_sum((yb.x + yb.y) + (yb.z + yb.w)) * (1.0f / 64.0f);
            const f32x4 dl = yb - mean;
            const float var = row16_sum((dl.x * dl.x + dl.y * dl.y) + (dl.z * dl.z + dl.w * dl.w)) * (1.0f / 64.0f);
            const f32x4 yn = dl * rsqrtf_(var + 64e-5f) * lng + lnb;
            st4bf(yc + (size_t)m * 1024 + 256 + ch, (yn + vs * bn) * gr);
        }
        {
            const float ms = row16_sum((ycv.x * ycv.x + ycv.y * ycv.y) + (ycv.z * ycv.z + ycv.w * ycv.w)) * (1.0f / 64.0f);
            const f32x4 sg = (f32x4){sigmoidf_(og.x), sigmoidf_(og.y), sigmoidf_(og.z), sigmoidf_(og.w)};
            st4bf(yc + (size_t)m * 1024 + 512 + ch, ycv * rsqrtf_(ms + 1e-6f) * mng * sg);
        }
        {
            const float ms = row16_sum((yd.x * yd.x + yd.y * yd.y) + (yd.z * yd.z + yd.w * yd.w)) * (1.0f / 64.0f);
            const f32x4 sg = (f32x4){siluf_(gd.x), siluf_(gd.y), siluf_(gd.z), siluf_(gd.w)};
            st4bf(yc + (size_t)m * 1024 + 768 + ch, yd * rsqrtf_(ms + 1e-6f) * gng * sg);
        }
    }
}
typedef bf16x8 fragb;
__device__ __forceinline__ f32x4 mfma16(fragb a, fragb b, f32x4 c) { return __builtin_amdgcn_mfma_f32_16x16x32_bf16(a, b, c, 0, 0, 0); }
__device__ __forceinline__ fragb ld_frag16(const LAS bf16* p) { return *(const LAS fragb*)p; }
__device__ __forceinline__ fragb ld_frag8x2(const LAS bf16* p0, const LAS bf16* p1) {
    const v2u a = *(const LAS v2u*)p0, b = *(const LAS v2u*)p1; v4u r; r.x = a.x; r.y = a.y; r.z = b.x; r.w = b.y; return __builtin_bit_cast(fragb, r); }
__device__ __forceinline__ fragb pack_frag(const f32x4& lo, const f32x4& hi) { v4u r; r.x = pk2(lo.x, lo.y); r.y = pk2(lo.z, lo.w); r.z = pk2(hi.x, hi.y); r.w = pk2(hi.z, hi.w); return __builtin_bit_cast(fragb, r); }
__device__ __forceinline__ float wave_incl_sum(float v, int lane) {
    v += dpp_x<0x111, 0xF, true>(0.f, v); v += dpp_x<0x112, 0xF, true>(0.f, v); v += dpp_x<0x114, 0xF, true>(0.f, v); v += dpp_x<0x118, 0xF, true>(0.f, v);
    v += dpp_x<0x142, 0xA, false>(0.f, v); v += dpp_x<0x143, 0xC, false>(0.f, v);
    return v;
}
__device__ __forceinline__ float wave_incl_max(float v, int lane) {
    const float ninf = -3.0e38f;
    v = fmaxf(v, dpp_x<0x111, 0xF, false>(ninf, v)); v = fmaxf(v, dpp_x<0x112, 0xF, false>(ninf, v)); v = fmaxf(v, dpp_x<0x114, 0xF, false>(ninf, v)); v = fmaxf(v, dpp_x<0x118, 0xF, false>(ninf, v));
    v = fmaxf(v, dpp_x<0x142, 0xA, false>(ninf, v)); v = fmaxf(v, dpp_x<0x143, 0xC, false>(ninf, v));
    return v;
}
constexpr int MP = 72;
__device__ __forceinline__ void mlstm_chunked(const Ctx& C, int l, int idx) {
    const int d = idx >> 5, b = (idx >> 2) & 7, h = idx & 3, lane = C.lane, w = C.wave, l15 = lane & 15, q = lane >> 4;
    const int it = w & 3, vtp = w >> 2;
    constexpr int IMG = 64 * MP * 2, BUFB = 4 * IMG + 1024, CTB = 65 * MP * 2 + 16;
    LAS unsigned char* L0 = C.lds;
    const bf16* P = WSP(const bf16, WS_P); bf16* outc = WSP(bf16, WS_OUTC) + (size_t)d * T_ALL * 256;
    const float ib = C.in[I_MIB][(l * 2 + d) * NH + h], fb = C.in[I_MFB][(l * 2 + d) * NH + h];
    const int tt = C.tid >> 3, part = C.tid & 7;
    for (int i = C.tid; i < 2 * CTB / 4; i += NTHR) ((LAS unsigned*)(L0 + 2 * BUFB))[i] = 0u;
    v4u rq, rk, rv; unsigned short rgi, rgf;
    auto gload = [&](int n) {
        const int row = seqrow_cm(n * 64 + tt, d, b);
        const bf16* pp = P + (size_t)row * PLD + OFF_C + h * 64 + 8 * part;
        rq = *(const v4u*)pp; rk = *(const v4u*)(pp + 256); rv = *(const v4u*)(pp + 512);
        const bf16* pg = P + (size_t)seqrow_cm(n * 64 + lane, d, b) * PLD + OFF_C + 1024 + d * 4 + h;
        rgi = pg[0]; rgf = pg[8];
    };
    auto images = [&](int bufi) {
        LAS unsigned char* B0 = L0 + bufi * BUFB;
        LAS bf16* Qs = (LAS bf16*)B0; LAS bf16* Ks = Qs + 64 * MP; LAS bf16* VT = Ks + 64 * MP; LAS bf16* KTw = VT + 64 * MP; LAS float* vec = (LAS float*)(B0 + 4 * IMG);
        const float li = bf2f(rgi) + ib, lf = -softplusf_(-(bf2f(rgf) + fb));
        const float bc = wave_incl_sum(lf, lane), x = li - bc, cm = wave_incl_max(x, lane);
        const float wl = __expf(x - __shfl(cm, 63)) * 0.125f;
        if (w == 0) { vec[lane] = x; vec[64 + lane] = cm; vec[128 + lane] = bc; }
        const float wmine = __shfl(wl, 8 * w + (lane >> 3));
        *(LAS v4u*)(Qs + tt * MP + 8 * part) = rq; *(LAS v4u*)(Ks + tt * MP + 8 * part) = rk;
        const unsigned vv[4] = {rv.x, rv.y, rv.z, rv.w}, kk[4] = {rk.x, rk.y, rk.z, rk.w};
#pragma unroll
        for (int e = 0; e < 4; ++e) {
            VT[(8 * part + 2 * e) * MP + tt] = (bf16)(vv[e] & 0xffffu); VT[(8 * part + 2 * e + 1) * MP + tt] = (bf16)(vv[e] >> 16);
            KTw[(8 * part + 2 * e) * MP + tt] = (bf16)f2bf1(bflo(kk[e]) * wmine); KTw[(8 * part + 2 * e + 1) * MP + tt] = (bf16)f2bf1(bfhi(kk[e]) * wmine);
        }
    };
    f32x4 Cst[2], nst; float m = 0.f;
    Cst[0] = Cst[1] = nst = (f32x4){0.f, 0.f, 0.f, 0.f};
    const fragb ones = __builtin_bit_cast(fragb, (v4u){0x3F803F80u, 0x3F803F80u, 0x3F803F80u, 0x3F803F80u});
    const f32x4 z4 = (f32x4){0.f, 0.f, 0.f, 0.f};
    gload(0); images(0); gload(1);
#pragma unroll 1
    for (int n = 0; n < NCH; ++n) {
        RAW_BARRIER();
        const LAS unsigned char* B0 = L0 + (n & 1) * BUFB;
        const LAS bf16* Qs = (const LAS bf16*)B0; const LAS bf16* Ks = Qs + 64 * MP; const LAS bf16* VT = Ks + 64 * MP; const LAS bf16* KTw = VT + 64 * MP; const LAS float* vec = (const LAS float*)(B0 + 4 * IMG);
        const LAS bf16* CT = (const LAS bf16*)(L0 + 2 * BUFB + (n & 1) * CTB); LAS bf16* CTn = (LAS bf16*)(L0 + 2 * BUFB + ((n + 1) & 1) * CTB);
        fragb Qf[2]; Qf[0] = ld_frag16(Qs + (16 * it + l15) * MP + 8 * q); Qf[1] = ld_frag16(Qs + (16 * it + l15) * MP + 32 + 8 * q);
        const float cmi = vec[64 + 16 * it + l15]; const int icol = 16 * it + l15;
        f32x4 pt[4];
#pragma unroll
        for (int jt = 0; jt < 4; ++jt) {
            pt[jt] = z4;
            if (jt <= it) {
                const fragb k0 = ld_frag16(Ks + (16 * jt + l15) * MP + 8 * q), k1 = ld_frag16(Ks + (16 * jt + l15) * MP + 32 + 8 * q);
                f32x4 st = mfma16(k0, Qf[0], z4); st = mfma16(k1, Qf[1], st);
                const f32x4 xj = *(const LAS f32x4*)(vec + 16 * jt + 4 * q);
#pragma unroll
                for (int r = 0; r < 4; ++r) { const int j = 16 * jt + 4 * q + r; pt[jt][r] = (j <= icol) ? st[r] * __expf(xj[r] - cmi) * 0.125f : 0.f; }
            }
        }
        fragb Pf[2]; Pf[0] = pack_frag(pt[0], pt[1]); Pf[1] = pack_frag(pt[2], pt[3]);
        fragb Vf[2][2];
#pragma unroll
        for (int v2 = 0; v2 < 2; ++v2)
#pragma unroll
            for (int s = 0; s < 2; ++s) { const LAS bf16* vr = VT + (16 * (2 * vtp + v2) + l15) * MP + 32 * s + 4 * q; Vf[v2][s] = ld_frag8x2(vr, vr + 16); }
        f32x4 Aacc[2], R[2], as, dn;
        as = mfma16(Pf[0], ones, z4); if (it >= 2) as = mfma16(Pf[1], ones, as);
        const fragb nf0 = ld_frag16(CT + 64 * MP + 8 * q), nf1 = ld_frag16(CT + 64 * MP + 32 + 8 * q);
        dn = mfma16(Qf[0], nf0, z4); dn = mfma16(Qf[1], nf1, dn);
#pragma unroll
        for (int v2 = 0; v2 < 2; ++v2) {
            Aacc[v2] = mfma16(Pf[0], Vf[v2][0], z4); if (it >= 2) Aacc[v2] = mfma16(Pf[1], Vf[v2][1], Aacc[v2]);
            const LAS bf16* cr = CT + (16 * (2 * vtp + v2) + l15) * MP + 8 * q;
            R[v2] = mfma16(Qf[0], ld_frag16(cr), z4); R[v2] = mfma16(Qf[1], ld_frag16(cr + 32), R[v2]);
        }
        {
            const f32x4 bi = *(const LAS f32x4*)(vec + 128 + 16 * it + 4 * q), cmr = *(const LAS f32x4*)(vec + 64 + 16 * it + 4 * q);
#pragma unroll
            for (int r = 0; r < 4; ++r) {
                const float mi = bi[r] + cmr[r], minter = bi[r] + m, mt = fmaxf(minter, mi), e1 = __expf(mi - mt), e2 = __expf(minter - mt);
                const float den = e1 * as[r] + e2 * dn[r]; const float inv = __builtin_amdgcn_rcpf(fmaxf(fabsf(den), __expf(-mt)));
                const int row = seqrow_cm(n * 64 + 16 * it + 4 * q + r, d, b);
#pragma unroll
                for (int v2 = 0; v2 < 2; ++v2) outc[(size_t)row * 256 + h * 64 + 16 * (2 * vtp + v2) + l15] = (bf16)f2bf1((e1 * Aacc[v2][r] + e2 * R[v2][r]) * inv);
            }
        }
        {
            const LAS bf16* kr = KTw + (16 * it + l15) * MP + 4 * q;
            const fragb kt0 = ld_frag8x2(kr, kr + 16), kt1 = ld_frag8x2(kr + 32, kr + 48);
            const float bL = vec[128 + 63], mloc = bL + vec[64 + 63];
            const float mnew = fmaxf(bL + m, mloc), wp = __expf(bL + m - mnew), wn = __expf(mloc - mnew);
            f32x4 gk = mfma16(kt0, ones, z4); gk = mfma16(kt1, ones, gk);
            nst = nst * wp + gk * wn;
#pragma unroll
            for (int v2 = 0; v2 < 2; ++v2) {
                f32x4 G = mfma16(kt0, Vf[v2][0], z4); G = mfma16(kt1, Vf[v2][1], G);
                Cst[v2] = Cst[v2] * wp + G * wn;
                v2u o; o.x = pk2(Cst[v2].x, Cst[v2].y); o.y = pk2(Cst[v2].z, Cst[v2].w);
                *(LAS v2u*)(CTn + (16 * (2 * vtp + v2) + l15) * MP + 16 * it + 4 * q) = o;
            }
            if (vtp == 0 && l15 == 0) { v2u o; o.x = pk2(nst.x, nst.y); o.y = pk2(nst.z, nst.w); *(LAS v2u*)(CTn + 64 * MP + 16 * it + 4 * q) = o; }
            m = mnew;
        }
        if (n + 1 < NCH) { images((n + 1) & 1); if (n + 2 < NCH) gload(n + 2); }
    }
    __syncthreads();
}
__device__ __forceinline__ int fwd_row_cm(int b, int c, int t) { return c < 4 ? (T_LAT + b * CTXL + c * 64 + t) : (b * SEQ + t * 64 + (c - 4)); }
__device__ __forceinline__ bf16* blob_row(const Ctx& C, int d, int isw, int b, int c, int h, int r) {
    const int row = fwd_row_cm(b, c, r);
    if (d == 1 && isw) return WSP(bf16, WS_OUTD) + ((size_t)T_ALL + row) * 256 + h * 64;
    return WSP(bf16, WS_P) + (size_t)row * PLD + OFF_D + (d * 2 + isw) * 256 + h * 64;
}
constexpr int LP = 68;
__device__ __forceinline__ void blocked_solve(const LAS bf16* Ln, const LAS bf16* TinvP, LAS unsigned char* XTw, f32x4 (&acc)[4][4], int l15, int q) {
    const f32x4 z4 = (f32x4){0.f, 0.f, 0.f, 0.f};
#pragma unroll
    for (int I = 0; I < 4; ++I) {
        const fragb Af = *(const LAS fragb*)(TinvP + (I * 16 + l15) * 32 + 8 * q);
        fragb A0, A1;
        if (I >= 1) A0 = ld_frag16(Ln + (16 * I + l15) * MP + 8 * q);
        if (I == 3) A1 = ld_frag16(Ln + (16 * I + l15) * MP + 32 + 8 * q);
#pragma unroll
        for (int nt = 0; nt < 4; ++nt) {
            const int crow = 16 * nt + l15; LAS unsigned char* xr = XTw + crow * 128;
            f32x4 a = acc[I][nt];
            if (I >= 1) a = mfma16(A0, *(const LAS fragb*)(xr + ((q ^ (crow & 7)) << 4)), a);
            if (I == 3) a = mfma16(A1, *(const LAS fragb*)(xr + (((4 + q) ^ (crow & 7)) << 4)), a);
            v4u bw; bw.x = pk2(a.x, a.y); bw.y = pk2(a.z, a.w); bw.z = 0u; bw.w = 0u;
            const f32x4 x = mfma16(Af, __builtin_bit_cast(fragb, bw), z4);
            acc[I][nt] = x;
            v2u o; o.x = pk2(x.x, x.y); o.y = pk2(x.z, x.w);
            *(LAS v2u*)(xr + (((2 * I + (q >> 1)) ^ (crow & 7)) << 4) + (q & 1) * 8) = o;
        }
    }
}
__device__ __forceinline__ void diag_inverses(const LAS bf16* Ln, LAS bf16* TinvP, int lane) {
    const int blk = lane >> 4, c = lane & 15;
    float x[16];
#pragma unroll
    for (int i = 0; i < 16; ++i) {
        const LAS bf16* lr = Ln + (16 * blk + i) * MP + 16 * blk;
        const v4u r0 = *(const LAS v4u*)lr, r1 = *(const LAS v4u*)(lr + 8);
        const unsigned rw[8] = {r0.x, r0.y, r0.z, r0.w, r1.x, r1.y, r1.z, r1.w};
        float s = (i == c) ? 1.0f : 0.0f;
#pragma unroll
        for (int j = 0; j < i; ++j) s += ((j & 1) ? bfhi(rw[j >> 1]) : bflo(rw[j >> 1])) * x[j];
        x[i] = s;
        TinvP[(blk * 16 + i) * 32 + 8 * (c >> 2) + (c & 3)] = (bf16)f2bf1(s);
    }
}
__device__ __forceinline__ void gdn_solve_item(const Ctx& C, int l, int item) {
    const int lane = C.lane, w = C.wave, pw = w & 1, pi = w >> 1, l15 = lane & 15, q = lane >> 4;
    LAS unsigned char* B0 = C.lds + pi * 31744;
    LAS bf16* Ln = (LAS bf16*)B0;
    LAS bf16* TinvP = (LAS bf16*)(B0 + 9216);
    LAS float* vec = (LAS float*)(B0 + 13312);
    LAS unsigned char* XT = B0 + 13824;
    LAS bf16* Ks = (LAS bf16*)XT;
    const bf16* P = WSP(const bf16, WS_P); const bf16* gq = WSP(const bf16, WS_GQ);
    const int u = item >> 1, d = item & 1;
    const int c = u % NCH, h = (u / NCH) & 3, b = u / (NCH * NH);
    const int n = d ? (c < 4 ? 3 - c : 71 - c) : c;
    const float aexp = __expf(C.in[I_GALOG][(l * 2 + d) * NH + h]), dtb = C.in[I_GDTB][(l * 2 + d) * NH + h];
    const int rowl = seqrow_cm(n * 64 + lane, d, b);
    const bf16* pg = P + (size_t)rowl * PLD + OFF_D + 1024 + d * 4 + h;
    const float la = -aexp * softplusf_(bf2f(pg[0]) + dtb), beta = sigmoidf_(bf2f(pg[8]));
    const float gam = wave_incl_sum(la, lane);
    if (pw == 0) { vec[lane] = beta; vec[64 + lane] = gam; }
#pragma unroll
    for (int r = 0; r < 4; ++r) { const int idx = pw * 64 + lane + 128 * r, t = idx >> 3, part = idx & 7;
        *(LAS v4u*)(Ks + t * MP + 8 * part) = *(const v4u*)(gq + (size_t)seqrow_cm(n * 64 + t, d, b) * 768 + 256 + h * 64 + 8 * part); }
    { LAS v4u* tz = (LAS v4u*)(B0 + 9216) + (pw * 64 + lane) * 2; tz[0] = (v4u){0u, 0u, 0u, 0u}; tz[1] = (v4u){0u, 0u, 0u, 0u}; }
    f32x4 acc[4][4];
    if (pw == 0) {
#pragma unroll
        for (int I = 0; I < 4; ++I)
#pragma unroll
            for (int r = 0; r < 4; ++r) { const bf16* vr = gq + (size_t)seqrow_cm(n * 64 + 16 * I + 4 * q + r, d, b) * 768 + 512 + h * 64 + l15;
#pragma unroll
                for (int nt = 0; nt < 4; ++nt) acc[I][nt][r] = bf2f(vr[16 * nt]); }
    }
    __syncthreads();
    {
        int tix = 0;
#pragma unroll
        for (int it = 0; it < 4; ++it)
#pragma unroll
            for (int jt = 0; jt < 4; ++jt, ++tix) if ((tix & 1) == pw) {
                f32x4 t4 = (f32x4){0.f, 0.f, 0.f, 0.f};
                if (jt <= it) {
#pragma unroll
                    for (int s = 0; s < 2; ++s) t4 = mfma16(ld_frag16(Ks + (16 * it + l15) * MP + 32 * s + 8 * q), ld_frag16(Ks + (16 * jt + l15) * MP + 32 * s + 8 * q), t4);
                    const float gj = vec[64 + 16 * jt + l15];
                    const f32x4 bi = *(const LAS f32x4*)(vec + 16 * it + 4 * q), gi = *(const LAS f32x4*)(vec + 64 + 16 * it + 4 * q);
#pragma unroll
                    for (int r = 0; r < 4; ++r) { const int i = 16 * it + 4 * q + r, j = 16 * jt + l15; t4[r] = (j < i) ? -(bi[r] * t4[r] * __expf(gi[r] - gj)) : 0.f; }
                }
#pragma unroll
                for (int r = 0; r < 4; ++r) Ln[(16 * it + 4 * q + r) * MP + 16 * jt + l15] = (bf16)f2bf1(t4[r]);
            }
    }
    {
#pragma unroll
        for (int I = 0; I < 4; ++I) {
            const f32x4 bi = *(const LAS f32x4*)(vec + 16 * I + 4 * q), gi = *(const LAS f32x4*)(vec + 64 + 16 * I + 4 * q);
#pragma unroll
            for (int r = 0; r < 4; ++r) { const float sc = pw ? bi[r] * __expf(gi[r]) : bi[r];
#pragma unroll
                for (int nt = 0; nt < 4; ++nt) acc[I][nt][r] = (pw ? bf2f(Ks[(16 * I + 4 * q + r) * MP + 16 * nt + l15]) : acc[I][nt][r]) * sc; }
        }
    }
    __syncthreads();
    if (pw == 0) diag_inverses(Ln, TinvP, lane);
    LAS unsigned char* XTw = XT + pw * 8192;
    { LAS v4u* xz = (LAS v4u*)(XTw + lane * 128);
#pragma unroll
        for (int g = 0; g < 8; ++g) xz[g] = (v4u){0u, 0u, 0u, 0u}; }
    __syncthreads();
    blocked_solve(Ln, TinvP, XTw, acc, l15, q);
    {
        bf16* dst = blob_row(C, d, pw, b, c, h, lane);
        const LAS unsigned char* xr = XTw + lane * 128;
#pragma unroll
        for (int g = 0; g < 8; ++g) *(v4u*)(dst + 8 * g) = *(const LAS v4u*)(xr + ((g ^ (lane & 7)) << 4));
    }
    __syncthreads();
}

template <bool DRY>
__device__ __forceinline__ void gdn_chunked(const Ctx& C, int l, int idx) {
    const int d = idx >> 5, b = (idx >> 2) & 7, h = idx & 3, lane = C.lane, w = C.wave, l15 = lane & 15, q = lane >> 4;
    const int it = w & 3, vtp = w >> 2;
    constexpr int IMG = 64 * MP * 2, BUFB = 5 * IMG + 512;
    LAS unsigned char* L0 = C.lds;
    LAS bf16* VnT = (LAS bf16*)(L0 + 2 * BUFB + 2 * IMG);
    const bf16* P = WSP(const bf16, WS_P); const bf16* gq = WSP(const bf16, WS_GQ); bf16* outd = WSP(bf16, WS_OUTD) + (size_t)d * T_ALL * 256;
    const float aexp = __expf(C.in[I_GALOG][(l * 2 + d) * NH + h]), dtb = C.in[I_GDTB][(l * 2 + d) * NH + h];
    const int tt = C.tid >> 3, part = C.tid & 7;
    for (int i = C.tid; i < 2 * IMG / 4; i += NTHR) ((LAS unsigned*)(L0 + 2 * BUFB))[i] = 0u;
    v4u rq, rk, ru, rw; unsigned short rga;
    auto gload = [&](int n) {
        const int c = d ? (n < 4 ? 3 - n : 71 - n) : n;
        const bf16* pp = gq + (size_t)seqrow_cm(n * 64 + tt, d, b) * 768 + h * 64 + 8 * part;
        rq = *(const v4u*)pp; rk = *(const v4u*)(pp + 256);
        ru = *(const v4u*)(blob_row(C, d, 0, b, c, h, tt) + 8 * part); rw = *(const v4u*)(blob_row(C, d, 1, b, c, h, tt) + 8 * part);
        rga = P[(size_t)seqrow_cm(n * 64 + lane, d, b) * PLD + OFF_D + 1024 + d * 4 + h];
    };
    auto images = [&](int bufi) {
        LAS unsigned char* B0 = L0 + bufi * BUFB;
        LAS bf16* Qs = (LAS bf16*)B0; LAS bf16* Ks = Qs + 64 * MP; LAS bf16* KdT = Ks + 64 * MP; LAS bf16* Wi = KdT + 64 * MP; LAS bf16* UT = Wi + 64 * MP; LAS float* vec = (LAS float*)(B0 + 5 * IMG);
        const float la = -aexp * softplusf_(bf2f(rga) + dtb);
        const float gam = wave_incl_sum(la, lane);
        if (w == 0) vec[lane] = gam;
        const float kd = __expf(__shfl(gam, 63) - gam);
        const float kmine = __shfl(kd, 8 * w + (lane >> 3));
        *(LAS v4u*)(Qs + tt * MP + 8 * part) = rq; *(LAS v4u*)(Ks + tt * MP + 8 * part) = rk; *(LAS v4u*)(UT + tt * MP + 8 * part) = ru;
        const unsigned kk[4] = {rk.x, rk.y, rk.z, rk.w}, ww[4] = {rw.x, rw.y, rw.z, rw.w};
#pragma unroll
        for (int e = 0; e < 4; ++e) {
            KdT[(8 * part + 2 * e) * MP + tt] = (bf16)f2bf1(bflo(kk[e]) * kmine); KdT[(8 * part + 2 * e + 1) * MP + tt] = (bf16)f2bf1(bfhi(kk[e]) * kmine);
            Wi[(8 * part + 2 * e) * MP + tt] = (bf16)(ww[e] & 0xffffu); Wi[(8 * part + 2 * e + 1) * MP + tt] = (bf16)(ww[e] >> 16);
        }
    };
    f32x4 Sst[2]; Sst[0] = Sst[1] = (f32x4){0.f, 0.f, 0.f, 0.f};
    const f32x4 z4 = (f32x4){0.f, 0.f, 0.f, 0.f};
    gload(0); images(0); gload(1);
#pragma unroll 1
    for (int n = 0; n < NCH; ++n) {
        RAW_BARRIER();
        const LAS unsigned char* B0 = L0 + (n & 1) * BUFB;
        const LAS bf16* Qs = (const LAS bf16*)B0; const LAS bf16* Ks = Qs + 64 * MP; const LAS bf16* KdT = Ks + 64 * MP; const LAS bf16* Wi = KdT + 64 * MP; const LAS bf16* UT = Wi + 64 * MP; const LAS float* vec = (const LAS float*)(B0 + 5 * IMG);
        const LAS bf16* ST = (const LAS bf16*)(L0 + 2 * BUFB + (n & 1) * IMG); LAS bf16* STn = (LAS bf16*)(L0 + 2 * BUFB + ((n + 1) & 1) * IMG);
        fragb Qf[2]; Qf[0] = ld_frag16(Qs + (16 * it + l15) * MP + 8 * q); Qf[1] = ld_frag16(Qs + (16 * it + l15) * MP + 32 + 8 * q);
        const float gcol = vec[16 * it + l15]; const int icol = 16 * it + l15;
        f32x4 pt[4];
#pragma unroll
        for (int jt = 0; jt < 4; ++jt) {
            pt[jt] = z4;
            if (jt <= it) {
                const fragb k0 = ld_frag16(Ks + (16 * jt + l15) * MP + 8 * q), k1 = ld_frag16(Ks + (16 * jt + l15) * MP + 32 + 8 * q);
                f32x4 st = mfma16(k0, Qf[0], z4); st = mfma16(k1, Qf[1], st);
                const f32x4 gj = *(const LAS f32x4*)(vec + 16 * jt + 4 * q);
#pragma unroll
                for (int r = 0; r < 4; ++r) { const int j = 16 * jt + 4 * q + r; pt[jt][r] = (j <= icol) ? st[r] * __expf(gcol - gj[r]) : 0.f; }
            }
        }
        fragb Pf[2]; Pf[0] = pack_frag(pt[0], pt[1]); Pf[1] = pack_frag(pt[2], pt[3]);
        const fragb Wf0 = ld_frag16(Wi + (16 * it + l15) * MP + 8 * q), Wf1 = ld_frag16(Wi + (16 * it + l15) * MP + 32 + 8 * q);
        f32x4 Ro[2];
#pragma unroll
        for (int v2 = 0; v2 < 2; ++v2) {
            const int vrow = 16 * (2 * vtp + v2) + l15;
            const fragb s0 = ld_frag16(ST + vrow * MP + 8 * q), s1 = ld_frag16(ST + vrow * MP + 32 + 8 * q);
            f32x4 ws = mfma16(Wf0, s0, z4); ws = mfma16(Wf1, s1, ws);
            Ro[v2] = mfma16(Qf[0], s0, z4); Ro[v2] = mfma16(Qf[1], s1, Ro[v2]);
            const v2u ur = *(const LAS v2u*)(UT + vrow * MP + 16 * it + 4 * q);
            v2u o; o.x = pk2(bflo(ur.x) - ws.x, bfhi(ur.x) - ws.y); o.y = pk2(bflo(ur.y) - ws.z, bfhi(ur.y) - ws.w);
            *(LAS v2u*)(VnT + vrow * MP + 16 * it + 4 * q) = o;
        }
        RAW_BARRIER();
        {
            const f32x4 gi = *(const LAS f32x4*)(vec + 16 * it + 4 * q);
            const float gl = __expf(vec[63]);
            const LAS bf16* kr = KdT + (16 * it + l15) * MP + 4 * q;
            const fragb kt0 = ld_frag8x2(kr, kr + 16), kt1 = ld_frag8x2(kr + 32, kr + 48);
#pragma unroll
            for (int v2 = 0; v2 < 2; ++v2) {
                const int vrow = 16 * (2 * vtp + v2) + l15;
                const LAS bf16* vr = VnT + vrow * MP + 4 * q;
                const fragb n0 = ld_frag8x2(vr, vr + 16), n1 = ld_frag8x2(vr + 32, vr + 48);
                f32x4 o = mfma16(Pf[0], n0, z4); if (it >= 2) o = mfma16(Pf[1], n1, o);
#pragma unroll
                for (int r = 0; r < 4; ++r) { const int row = seqrow_cm(n * 64 + 16 * it + 4 * q + r, d, b);
                    if (!DRY) outd[(size_t)row * 256 + h * 64 + vrow] = (bf16)f2bf1(o[r] + __expf(gi[r]) * Ro[v2][r]); }
                f32x4 ns = mfma16(kt0, n0, z4); ns = mfma16(kt1, n1, ns);
                Sst[v2] = Sst[v2] * gl + ns;
                v2u so; so.x = pk2(Sst[v2].x, Sst[v2].y); so.y = pk2(Sst[v2].z, Sst[v2].w);
                *(LAS v2u*)(STn + vrow * MP + 16 * it + 4 * q) = so;
            }
        }
        if (n + 1 < NCH) { images((n + 1) & 1); if (n + 2 < NCH) gload(n + 2); }
    }
    __syncthreads();
}
constexpr int UP = 264;
template <int CTRL> __device__ __forceinline__ float dpp_keep(float oldv, float v) { return __builtin_bit_cast(float, __builtin_amdgcn_update_dpp(__builtin_bit_cast(int, oldv), __builtin_bit_cast(int, v), CTRL, 0xF, 0xF, false)); }
template <bool REV> __device__ __forceinline__ void scan16(float& A, float& B) {
#define LRU_STEP(S) { const float Ap = dpp_keep<(REV ? 0x100 : 0x110) | S>(1.0f, A), Bp = dpp_keep<(REV ? 0x100 : 0x110) | S>(0.0f, B); B = A * Bp + B; A = A * Ap; }
    LRU_STEP(1) LRU_STEP(2) LRU_STEP(4) LRU_STEP(8)
#undef LRU_STEP
}
constexpr int UPC = 72;
__device__ __forceinline__ int lru_chunk_of(int d, int k) { return d ? (k < 4 ? 3 - k : NCH + 3 - k) : k; }
template <bool REV>
__device__ __forceinline__ void lru_tiles(const LAS bf16* Ud, int th, int mt, int lane, const fragb (&Wa)[2], const fragb (&Wx)[2], const f32x4& ba, const f32x4& bx, const f32x4& sp4,
                                          f32x4 (&Ac)[2], f32x4 (&Hl)[2], f32x4& Atot, f32x4& hend) {
    const int l15 = lane & 15, q = lane >> 4, edge = (lane & 48) | (REV ? 0 : 15);
    const f32x4 z4 = (f32x4){0.f, 0.f, 0.f, 0.f};
    f32x4 tA = z4, tB = z4;
#pragma unroll
    for (int i = 0; i < 2; ++i) {
        const int nt = REV ? 3 - (2 * th + i) : 2 * th + i;
        const LAS bf16* urow = Ud + (16 * nt + l15) * UPC;
        const fragb Uf0 = ld_frag16(urow + 8 * q), Uf1 = ld_frag16(urow + 32 + 8 * q);
        f32x4 aa = mfma16(Wa[0], Uf0, z4); aa = mfma16(Wa[1], Uf1, aa);
        f32x4 ax = mfma16(Wx[0], Uf0, z4); ax = mfma16(Wx[1], Uf1, ax);
        const v2u ur = *(const LAS v2u*)(urow + 16 * mt + 4 * q);
        const f32x4 u4 = (f32x4){bflo(ur.x), bfhi(ur.x), bflo(ur.y), bfhi(ur.y)};
        f32x4 la, iu, A, Bv;
#pragma unroll
        for (int r = 0; r < 4; ++r) { const float rg = sigmoidf_(aa[r] + ba[r]); iu[r] = sigmoidf_(ax[r] + bx[r]) * u4[r]; la[r] = -sp4[r] * rg; }
        const bool sm_ = la[0] > -0.15f && la[1] > -0.15f && la[2] > -0.15f && la[3] > -0.15f;
        if (__builtin_amdgcn_ballot_w64(!sm_) == 0ull) {
#pragma unroll
            for (int r = 0; r < 4; ++r) { const float x = la[r], p = x * (1.0f + x * (0.5f + x * (0.16666667f + x * (0.041666668f + x * (0.0083333338f + x * 0.0013888889f)))));
                A[r] = 1.0f + p; Bv[r] = __builtin_amdgcn_sqrtf(-p * (2.0f + p)) * iu[r]; }
        } else {
#pragma unroll
            for (int r = 0; r < 4; ++r) { A[r] = __expf(la[r]); Bv[r] = __builtin_amdgcn_sqrtf(-expm1f_(2.0f * la[r])) * iu[r]; }
        }
#pragma unroll
        for (int r = 0; r < 4; ++r) { float a_ = A[r], b_ = Bv[r]; scan16<REV>(a_, b_); A[r] = a_; Bv[r] = b_; }
        if (i == 0) {
            Ac[0] = A; Hl[0] = Bv;
#pragma unroll
            for (int r = 0; r < 4; ++r) { tA[r] = __shfl(A[r], edge); tB[r] = __shfl(Bv[r], edge); }
        } else {
            Ac[1] = A * tA; Hl[1] = A * tB + Bv;
#pragma unroll
            for (int r = 0; r < 4; ++r) { Atot[r] = __shfl(Ac[1][r], edge); hend[r] = __shfl(Hl[1][r], edge); }
        }
    }
}
__device__ __forceinline__ void lru_chain(const Ctx& C, int l, int id) {
    const int b = id >> 3, hd = (id >> 1) & 3, chalf = id & 1;
    const int lane = C.lane, l15 = lane & 15, q = lane >> 4;
    const int d = C.wave >> 2, mtl = (C.wave >> 1) & 1, th = C.wave & 1, mt = chalf * 2 + mtl;
    LAS bf16* U = (LAS bf16*)C.lds;
    LAS float* XCH = (LAS float*)(C.lds + 2 * 2 * 64 * UPC * 2);
    bf16* P = WSP(bf16, WS_P); bf16* LH = WSP(bf16, WS_LRUH) + (size_t)id * NSTEP * 32;
    const int cd = C.tid >> 8, cj = C.tid & 63, ctq = (C.tid >> 6) & 3;
    const float* cw = C.in[I_LCW] + (size_t)l * 4 * GW + hd * 64 + cj; const float w0 = cw[0], w1 = cw[GW], w2 = cw[2 * GW], w3 = cw[3 * GW], cb = C.in[I_LCB][l * GW + hd * 64 + cj];
    const bf16* wt = WSP(const bf16, WS_LRUWT) + (size_t)((d * 2 + 0) * 4 + hd) * 4096;
    fragb Wa[2], Wx[2];
#pragma unroll
    for (int ks = 0; ks < 2; ++ks) { Wa[ks] = *(const fragb*)(wt + (16 * mt + l15) * 64 + 32 * ks + 8 * q); Wx[ks] = *(const fragb*)(wt + 4 * 4096 + (16 * mt + l15) * 64 + 32 * ks + 8 * q); }
    const int ch0 = hd * 64 + 16 * mt + 4 * q;
    const f32x4 ba = *(const f32x4*)(C.in[I_LBA] + (l * 2 + d) * GW + ch0), bx = *(const f32x4*)(C.in[I_LBX] + (l * 2 + d) * GW + ch0), lam = *(const f32x4*)(C.in[I_LLAM] + (l * 2 + d) * GW + ch0);
    f32x4 sp4;
#pragma unroll
    for (int r = 0; r < 4; ++r) sp4[r] = 8.0f * softplusf_(-lam[r]);
    f32x4 s = (f32x4){0.f, 0.f, 0.f, 0.f};
    unsigned short xr[19];
#define LRU_LOADX(kk) do { const int c_ = lru_chunk_of(cd, (kk)); const bool ic_ = c_ < 4; const int p0_ = (ic_ ? c_ * 64 : (c_ - 4) * 64) + ctq * 16 - 2, Lp_ = ic_ ? CTXL : SEQ; \
        const bf16* xp_ = P + (size_t)(ic_ ? T_LAT + b * CTXL : b * SEQ) * PLD + hd * 64 + cj; \
        _Pragma("unroll") for (int i_ = 0; i_ < 19; ++i_) { const int p_ = p0_ + i_; xr[i_] = (p_ >= 0 && p_ < Lp_) ? xp_[(size_t)p_ * PLD] : (unsigned short)0; } } while (0)
#define LRU_CONV(kk) do { LAS bf16* uo_ = U + ((((kk) & 1) * 2 + cd) * 64 + ctq * 16) * UPC + cj; \
        _Pragma("unroll") for (int t_ = 0; t_ < 16; ++t_) uo_[t_ * UPC] = (bf16)f2bf1(w0 * bf2f(xr[t_]) + w1 * bf2f(xr[t_ + 1]) + w2 * bf2f(xr[t_ + 2]) + w3 * bf2f(xr[t_ + 3]) + cb); } while (0)
    LRU_LOADX(0); LRU_CONV(0); LRU_LOADX(1);
    __syncthreads();
#pragma unroll 1
    for (int k = 0; k < NCH; ++k) {
        if (k + 1 < NCH) { LRU_CONV(k + 1); if (k + 2 < NCH) LRU_LOADX(k + 2); }
        const int c = lru_chunk_of(d, k); const bool second = lru_chunk_of(1 - d, c) < k;
        const bool ic = c < 4; const size_t row0 = (size_t)(ic ? T_LAT + b * CTXL + c * 64 : b * SEQ + (c - 4) * 64);
        const bool late = (k == 2) || (k == 36);
        int tok[2]; v2u gv[2], fv[2];
#pragma unroll
        for (int i = 0; i < 2; ++i) { const int nt = d ? 3 - (2 * th + i) : 2 * th + i; tok[i] = 16 * nt + l15;
            if (second && !late) { gv[i] = *(const v2u*)(P + (row0 + tok[i]) * PLD + 256 + ch0); fv[i] = *(const v2u*)(LH + (size_t)(c * 64 + tok[i]) * 32 + 16 * mtl + 4 * q); } }
        f32x4 Ac[2], Hl[2], Atot, hend;
        const LAS bf16* Ud = U + ((k & 1) * 2 + d) * 64 * UPC;
        if (d) lru_tiles<true>(Ud, th, mt, lane, Wa, Wx, ba, bx, sp4, Ac, Hl, Atot, hend); else lru_tiles<false>(Ud, th, mt, lane, Wa, Wx, ba, bx, sp4, Ac, Hl, Atot, hend);
        LAS float* xw = XCH + (((((k & 1) * 2 + d) * 2 + mtl) * 2 + th) * 4 + q) * 8;
        if (l15 == (d ? 0 : 15)) { *(LAS f32x4*)xw = Atot; *(LAS f32x4*)(xw + 4) = hend; }
        if (late) VM_WAIT();
        RAW_BARRIER();
        if (second && late) {
#pragma unroll
            for (int i = 0; i < 2; ++i) { gv[i] = *(const v2u*)(P + (row0 + tok[i]) * PLD + 256 + ch0); fv[i] = *(const v2u*)(LH + (size_t)(c * 64 + tok[i]) * 32 + 16 * mtl + 4 * q); }
        }
        const LAS float* xr0 = XCH + (((((k & 1) * 2 + d) * 2 + mtl) * 2 + 0) * 4 + q) * 8;
        const f32x4 A0 = *(const LAS f32x4*)xr0, h0 = *(const LAS f32x4*)(xr0 + 4), A1 = *(const LAS f32x4*)(xr0 + 32), h1 = *(const LAS f32x4*)(xr0 + 36);
        const f32x4 mid = A0 * s + h0, hin = th ? mid : s;
        s = A1 * mid + h1;
#pragma unroll
        for (int i = 0; i < 2; ++i) {
            const f32x4 h = Ac[i] * hin + Hl[i];
            if (!second) { v2u o; o.x = pk2(h.x, h.y); o.y = pk2(h.z, h.w); *(v2u*)(LH + (size_t)(c * 64 + tok[i]) * 32 + 16 * mtl + 4 * q) = o; }
            else {
                const f32x4 g = (f32x4){bflo(gv[i].x), bfhi(gv[i].x), bflo(gv[i].y), bfhi(gv[i].y)};
                f32x4 y = (f32x4){h.x + bflo(fv[i].x), h.y + bfhi(fv[i].x), h.z + bflo(fv[i].y), h.w + bfhi(fv[i].y)};
                y.x *= gelu_tanh(g.x); y.y *= gelu_tanh(g.y); y.z *= gelu_tanh(g.z); y.w *= gelu_tanh(g.w);
                st4bf(P + (row0 + tok[i]) * PLD + 256 + ch0, y);
            }
        }
    }
#undef LRU_LOADX
#undef LRU_CONV
    __syncthreads();
}
constexpr int RP = 264;
__device__ __forceinline__ void rwkv_prep2(const Ctx& C, int l, int b, int c) {
    LAS bf16* RS = (LAS bf16*)C.lds;
    LAS bf16* KS = RS + 64 * RP;
    LAS bf16* XW = KS + 64 * RP;
    LAS bf16* XA = XW + 64 * MP;
    LAS bf16* XG = XA + 64 * MP;
    const bf16* P = WSP(const bf16, WS_P);
    const bool isctx = c < 4; const int p0 = isctx ? c * 64 : (c - 4) * 64; const int Lp = isctx ? CTXL : SEQ; const int row0 = isctx ? T_LAT + b * CTXL : b * SEQ;
    const float* mu = C.in[I_RMU] + (size_t)l * 2 * B_COLS;
    bf16* rkv = WSP(bf16, WS_RKV);
#pragma unroll 5
    for (int it = C.tid; it < 64 * 120; it += NTHR) {
        const int t = it / 120, c8 = (it % 120) * 8, p = p0 + t;
        const bf16* pp = P + (size_t)(row0 + p) * PLD + OFF_B + c8;
        const v4u xc = *(const v4u*)pp; v4u xp = (v4u){0u, 0u, 0u, 0u}, xn = xp;
        if (p > 0) xp = *(const v4u*)(pp - PLD);
        if (p < Lp - 1) xn = *(const v4u*)(pp + PLD);
        const f32x4 m0a = *(const f32x4*)(mu + c8), m0b = *(const f32x4*)(mu + c8 + 4), m1a = *(const f32x4*)(mu + B_COLS + c8), m1b = *(const f32x4*)(mu + B_COLS + c8 + 4);
        const unsigned xcw[4] = {xc.x, xc.y, xc.z, xc.w}, xpw[4] = {xp.x, xp.y, xp.z, xp.w}, xnw[4] = {xn.x, xn.y, xn.z, xn.w};
        float sh[8];
#pragma unroll
        for (int e = 0; e < 4; ++e) {
            const float x0 = bflo(xcw[e]), x1 = bfhi(xcw[e]);
            const float mu0_0 = e < 2 ? m0a[2 * e] : m0b[2 * e - 4], mu0_1 = e < 2 ? m0a[2 * e + 1] : m0b[2 * e - 3], mu1_0 = e < 2 ? m1a[2 * e] : m1b[2 * e - 4], mu1_1 = e < 2 ? m1a[2 * e + 1] : m1b[2 * e - 3];
            sh[2 * e] = x0 + mu0_0 * (bflo(xpw[e]) - x0) + mu1_0 * (bflo(xnw[e]) - x0);
            sh[2 * e + 1] = x1 + mu0_1 * (bfhi(xpw[e]) - x1) + mu1_1 * (bfhi(xnw[e]) - x1);
        }
        if (c8 >= 768) {
            const int ci = c8 - 768;
            if (ci < 64) {
#pragma unroll
                for (int e = 0; e < 8; ++e) sh[e] = tanhf_(sh[e]); }
            else if (ci >= 128) {
#pragma unroll
                for (int e = 0; e < 8; ++e) sh[e] = sigmoidf_(sh[e]); }
        }
        v4u o; o.x = pk2(sh[0], sh[1]); o.y = pk2(sh[2], sh[3]); o.z = pk2(sh[4], sh[5]); o.w = pk2(sh[6], sh[7]);
        if (c8 < 768) {
            *(v4u*)(rkv + (size_t)(row0 + p) * 768 + c8) = o;
            if (c8 < 256) *(LAS v4u*)(RS + t * RP + c8) = o; else if (c8 < 512) *(LAS v4u*)(KS + t * RP + c8 - 256) = o;
        } else {
            const int ci = c8 - 768;
            LAS bf16* dst = ci < 64 ? XW + t * MP + ci : (ci < 128 ? XA + t * MP + ci - 64 : XG + t * MP + ci - 128);
            *(LAS v4u*)dst = o;
        }
    }
    __syncthreads();
    const int lane = C.lane, w = C.wave, l15 = lane & 15, q = lane >> 4, hd = w & 3, ntp = w >> 2;
    const bf16* wt = WSP(const bf16, WS_RWT);
    bf16* wa_out = WSP(bf16, WS_HB); bf16* g_out = WSP(bf16, WS_G); float* bonus = WSP(float, WS_BONUS); float* rinv = WSP(float, WS_RINV);
    const f32x4 z4 = (f32x4){0.f, 0.f, 0.f, 0.f};
    fragb xw0[2], xw1[2], xa0[2], xa1[2], xg0[2], xg1[2]; float bsum[2] = {0.f, 0.f}, ksum[2] = {0.f, 0.f};
#pragma unroll
    for (int n2 = 0; n2 < 2; ++n2) { const int tok = 16 * (2 * ntp + n2) + l15;
        xw0[n2] = ld_frag16(XW + tok * MP + 8 * q); xw1[n2] = ld_frag16(XW + tok * MP + 32 + 8 * q);
        xa0[n2] = ld_frag16(XA + tok * MP + 8 * q); xa1[n2] = ld_frag16(XA + tok * MP + 32 + 8 * q);
        xg0[n2] = ld_frag16(XG + tok * MP + 8 * q); xg1[n2] = ld_frag16(XG + tok * MP + 32 + 8 * q); }
#pragma unroll
    for (int mt = 0; mt < 4; ++mt) {
        const int chl = 16 * mt + l15, ch4 = hd * 64 + 16 * mt + 4 * q;
        const bf16* wrow = wt + (size_t)(hd * 64 + chl) * 32 + 8 * q;
        const bf16* grow = wt + 4 * 256 * 32 + (size_t)(hd * 64 + chl) * 64 + 8 * q;
        const fragb fw0 = *(const fragb*)(wrow), fw1 = *(const fragb*)(wrow + 256 * 32), fa0 = *(const fragb*)(wrow + 2 * 256 * 32), fa1 = *(const fragb*)(wrow + 3 * 256 * 32), fg0 = *(const fragb*)(grow), fg1 = *(const fragb*)(grow + 32);
        const f32x4 w00 = *(const f32x4*)(C.in[I_RW0] + (l * 2 + 0) * GW + ch4), w01 = *(const f32x4*)(C.in[I_RW0] + (l * 2 + 1) * GW + ch4);
        const f32x4 a00 = *(const f32x4*)(C.in[I_RA0] + (l * 2 + 0) * GW + ch4), a01 = *(const f32x4*)(C.in[I_RA0] + (l * 2 + 1) * GW + ch4);
        const f32x4 k_a = *(const f32x4*)(C.in[I_RKA] + l * GW + ch4), r_k = *(const f32x4*)(C.in[I_RRK] + l * GW + ch4), k_k = *(const f32x4*)(C.in[I_RKK] + l * GW + ch4);
#pragma unroll
        for (int n2 = 0; n2 < 2; ++n2) {
            const int tok = 16 * (2 * ntp + n2) + l15; const size_t row = (size_t)(row0 + p0 + tok);
            const f32x4 aw0 = mfma16(fw0, xw0[n2], z4), aw1 = mfma16(fw1, xw1[n2], z4), aa0 = mfma16(fa0, xa0[n2], z4), aa1 = mfma16(fa1, xa1[n2], z4);
            f32x4 ag = mfma16(fg0, xg0[n2], z4); ag = mfma16(fg1, xg1[n2], ag);
            f32x4 wv0, wv1, av0, av1;
#pragma unroll
            for (int r = 0; r < 4; ++r) {
                wv0[r] = __expf(-0.6065306597126334f * sigmoidf_(aw0[r] + w00[r])); wv1[r] = __expf(-0.6065306597126334f * sigmoidf_(aw1[r] + w01[r]));
                av0[r] = sigmoidf_(aa0[r] + a00[r]); av1[r] = sigmoidf_(aa1[r] + a01[r]);
            }
            st4bf(wa_out + row * 1024 + 0 * 256 + ch4, wv0); st4bf(wa_out + row * 1024 + 1 * 256 + ch4, wv1);
            st4bf(wa_out + row * 1024 + 2 * 256 + ch4, av0); st4bf(wa_out + row * 1024 + 3 * 256 + ch4, av1);
            st4bf(g_out + row * 256 + ch4, ag);
            const v2u rr_ = *(const LAS v2u*)(RS + tok * RP + ch4), kr_ = *(const LAS v2u*)(KS + tok * RP + ch4);
            const f32x4 rs = (f32x4){bflo(rr_.x), bfhi(rr_.x), bflo(rr_.y), bfhi(rr_.y)}, ks = (f32x4){bflo(kr_.x), bfhi(kr_.x), bflo(kr_.y), bfhi(kr_.y)};
#pragma unroll
            for (int r = 0; r < 4; ++r) {
                const float km = ks[r] * (1.0f + (av0[r] - 1.0f) * k_a[r]) + ks[r] * (1.0f + (av1[r] - 1.0f) * k_a[r]);
                bsum[n2] += rs[r] * r_k[r] * km; const float kk = ks[r] * k_k[r]; ksum[n2] += kk * kk;
            }
        }
    }
#pragma unroll
    for (int n2 = 0; n2 < 2; ++n2) {
        const size_t row = (size_t)(row0 + p0 + 16 * (2 * ntp + n2) + l15);
        float bs = bsum[n2], ks2 = ksum[n2];
        bs += __shfl_xor(bs, 16); bs += __shfl_xor(bs, 32); ks2 += __shfl_xor(ks2, 16); ks2 += __shfl_xor(ks2, 32);
        if (q == 0) { bonus[row * 4 + hd] = bs; rinv[row * 4 + hd] = rsqrtf_(ks2 + 1e-6f); }
    }
    __syncthreads();
}
__device__ __forceinline__ int fwd_row_r(int b, int c, int t) { return c < 4 ? (T_LAT + b * CTXL + c * 64 + t) : (b * SEQ + (c - 4) * 64 + t); }
__device__ __forceinline__ bf16* rw_blob_row(const Ctx& C, int d, int which, int b, int c, int h, int r) {
    const int row = fwd_row_r(b, c, r);
#if RW_VSPLIT
    if (which == 0) { if (d) return WSP(bf16, WS_GQ) + (size_t)row * 768 + 512 + h * 64;
                      return WSP(bf16, WS_P) + (size_t)row * PLD + OFF_B + 512 + h * 64; }
#else
    if (which == 0) return WSP(bf16, WS_OUTB) + ((size_t)d * T_ALL + row) * 256 + h * 64;
#endif
    return WSP(bf16, WS_P) + (size_t)row * PLD + OFF_B + d * 256 + h * 64;
}
__device__ __forceinline__ void rwkv_solve_item(const Ctx& C, int l, int item) {
    const int lane = C.lane, w = C.wave, pw = w & 1, pi = w >> 1, l15 = lane & 15, q = lane >> 4;
    LAS unsigned char* B0 = C.lds + pi * 31744;
    LAS bf16* Kk = (LAS bf16*)B0; LAS bf16* Bh = Kk + 64 * MP; LAS bf16* Kh = Bh + 64 * MP;
    LAS bf16* Ln = (LAS bf16*)B0;
    LAS bf16* Lk16 = (LAS bf16*)(B0 + 9216);
    LAS unsigned char* XT = B0 + 9216;
    LAS bf16* TinvP = (LAS bf16*)(B0 + 25600);
    const bf16* WA = WSP(const bf16, WS_HB); bf16* WAw = WSP(bf16, WS_HB); const bf16* rkv = WSP(const bf16, WS_RKV); const float* rinv = WSP(const float, WS_RINV);
    const int u = item >> 1, d = item & 1;
    const int c = u % NCH, h = (u / NCH) & 3, b = u / (NCH * NH);
    const float k_k = C.in[I_RKK][l * GW + h * 64 + lane], k_a = C.in[I_RKA][l * GW + h * 64 + lane];
    const int n = d ? (c < 4 ? 3 - c : 71 - c) : c;
    const float ril = rinv[(size_t)seqrow_raster(n * 64 + lane, d, b) * 4 + h];
#pragma unroll
    for (int r = 0; r < 4; ++r) { const int idx2 = pw * 64 + lane + 128 * r, t = idx2 >> 3, part = idx2 & 7; const int row = seqrow_raster(n * 64 + t, d, b);
        *(LAS v4u*)(Kk + t * MP + 8 * part) = *(const v4u*)(WA + (size_t)row * 1024 + d * 256 + h * 64 + 8 * part);
        *(LAS v4u*)(Bh + t * MP + 8 * part) = *(const v4u*)(WA + (size_t)row * 1024 + (2 + d) * 256 + h * 64 + 8 * part);
        *(LAS v4u*)(Kh + t * MP + 8 * part) = *(const v4u*)(rkv + (size_t)row * 768 + 256 + h * 64 + 8 * part); }
    __syncthreads();
    {
        float cc = 1.0f;
        if (pw) {
#pragma unroll
            for (int t = 0; t < 32; ++t) cc *= bf2f(Kk[t * MP + lane]);
        }
        __syncthreads();
#pragma unroll
        for (int t2 = 0; t2 < 32; ++t2) {
            const int t = pw * 32 + t2;
            const float wv = bf2f(Kk[t * MP + lane]), av = bf2f(Bh[t * MP + lane]), ks = bf2f(Kh[t * MP + lane]);
            const float kap = ks * k_k * __shfl(ril, t);
            const float cprev = cc; cc *= wv; const float ic = __builtin_amdgcn_rcpf(cc);
            Kk[t * MP + lane] = (bf16)f2bf1(kap * cprev); Bh[t * MP + lane] = (bf16)f2bf1(kap * av * ic); Kh[t * MP + lane] = (bf16)f2bf1(ks * (1.0f + (av - 1.0f) * k_a) * ic);
            WAw[(size_t)seqrow_raster(n * 64 + t, d, b) * 1024 + d * 256 + h * 64 + lane] = (bf16)f2bf1(cc);
        }
    }
    __syncthreads();
    f32x4 acc[4][4];
    if (pw == 0) {
#pragma unroll
        for (int I = 0; I < 4; ++I)
#pragma unroll
            for (int r = 0; r < 4; ++r)
#pragma unroll
                for (int nt = 0; nt < 4; ++nt) acc[I][nt][r] = bf2f(Kk[(16 * I + 4 * q + r) * MP + 16 * nt + l15]);
    }
    f32x4 T[10];
    {
        const LAS bf16* Bsrc = pw ? Kh : Bh;
        int tix = 0;
#pragma unroll
        for (int it = 0; it < 4; ++it)
#pragma unroll
            for (int jt = 0; jt <= it; ++jt, ++tix) {
                f32x4 t4 = (f32x4){0.f, 0.f, 0.f, 0.f};
#pragma unroll
                for (int s = 0; s < 2; ++s) t4 = mfma16(ld_frag16(Kk + (16 * it + l15) * MP + 32 * s + 8 * q), ld_frag16(Bsrc + (16 * jt + l15) * MP + 32 * s + 8 * q), t4);
#pragma unroll
                for (int r = 0; r < 4; ++r) { const int i = 16 * it + 4 * q + r, j = 16 * jt + l15; T[tix][r] = (j < i) ? (pw ? t4[r] : -t4[r]) : 0.f; }
            }
    }
    __syncthreads();
    {
        int tix = 0;
#pragma unroll
        for (int it = 0; it < 4; ++it)
#pragma unroll
            for (int jt = 0; jt < 4; ++jt) {
                if (jt <= it) {
#pragma unroll
                    for (int r = 0; r < 4; ++r) (pw ? Lk16 : Ln)[(16 * it + 4 * q + r) * MP + 16 * jt + l15] = (bf16)f2bf1(T[tix][r]);
                    ++tix;
                } else if (pw == 0) {
#pragma unroll
                    for (int r = 0; r < 4; ++r) Ln[(16 * it + 4 * q + r) * MP + 16 * jt + l15] = (bf16)0;
                }
            }
        LAS v4u* tz = (LAS v4u*)(B0 + 25600) + (pw * 64 + lane) * 2; tz[0] = (v4u){0u, 0u, 0u, 0u}; tz[1] = (v4u){0u, 0u, 0u, 0u};
    }
    __syncthreads();
    if (pw) {
#pragma unroll
        for (int I = 0; I < 4; ++I)
#pragma unroll
            for (int r = 0; r < 4; ++r)
#pragma unroll
                for (int nt = 0; nt < 4; ++nt) { const int i = 16 * I + 4 * q + r, j = 16 * nt + l15; acc[I][nt][r] = (j < i && nt <= I) ? bf2f(Lk16[i * MP + j]) : 0.f; }
    } else diag_inverses(Ln, TinvP, lane);
    __syncthreads();
    LAS unsigned char* XTw = XT + pw * 8192;
    { LAS v4u* xz = (LAS v4u*)(XTw + lane * 128);
#pragma unroll
        for (int g = 0; g < 8; ++g) xz[g] = (v4u){0u, 0u, 0u, 0u}; }
    blocked_solve(Ln, TinvP, XTw, acc, l15, q);
    {
        bf16* dst = rw_blob_row(C, d, pw, b, c, h, lane);
        const LAS unsigned char* xr = XTw + lane * 128;
#pragma unroll
        for (int g = 0; g < 8; ++g) *(v4u*)(dst + 8 * g) = *(const LAS v4u*)(xr + ((g ^ (lane & 7)) << 4));
    }
    __syncthreads();
}

template <bool DRY>
__device__ __forceinline__ void rwkv_chunked(const Ctx& C, int l, int idx) {
#ifndef RW_VSPLIT
#define RW_VSPLIT 1
#endif
    constexpr int NV = RW_VSPLIT ? 1 : 2;
    const int vhalf = idx & 1, lane = C.lane, w = C.wave, l15 = lane & 15, q = lane >> 4;
    const int d = RW_VSPLIT ? idx >> 6 : idx >> 5, b = RW_VSPLIT ? (idx >> 3) & 7 : (idx >> 2) & 7, h = RW_VSPLIT ? (idx >> 1) & 3 : idx & 3;
    const int it = w & 3, vt0 = RW_VSPLIT ? 2 * vhalf + (w >> 2) : 2 * (w >> 2);
    constexpr int IMG = 64 * MP * 2;
    LAS unsigned char* L0 = C.lds;
    LAS bf16* Wi = (LAS bf16*)L0; LAS bf16* Ti = Wi + 64 * MP; LAS bf16* Rh = Ti + 64 * MP; LAS bf16* Kh = Rh + 64 * MP; LAS bf16* Bh = Kh + 64 * MP;
    LAS bf16* UT = (LAS bf16*)(L0 + 11 * IMG);
    LAS float* cLv = (LAS float*)(L0 + 14 * IMG);
    const bf16* WA = WSP(const bf16, WS_HB); const bf16* rkv = WSP(const bf16, WS_RKV); const float* rinv = WSP(const float, WS_RINV);
    bf16* outb = WSP(bf16, WS_OUTB) + (size_t)d * T_ALL * 256;
    const int tt = C.tid >> 3, part = C.tid & 7;
    for (int i = C.tid; i < 2 * IMG / 4; i += NTHR) ((LAS unsigned*)(L0 + 12 * IMG))[i] = 0u;
    float kkw[8], kaw[8];
#pragma unroll
    for (int e = 0; e < 8; ++e) { kkw[e] = C.in[I_RKK][l * GW + h * 64 + 8 * w + e]; kaw[e] = C.in[I_RKA][l * GW + h * 64 + 8 * w + e]; }
    v4u gr, gk, gv, gw, ga, gbw, gbt; float gri;
    auto gload = [&](int n) {
        const int c = d ? (n < 4 ? 3 - n : 71 - n) : n;
        const int row = seqrow_raster(n * 64 + lane, d, b);
        const bf16* pr = rkv + (size_t)row * 768 + h * 64 + 8 * w;
        gr = *(const v4u*)pr; gk = *(const v4u*)(pr + 256); gv = *(const v4u*)(pr + 512);
        gw = *(const v4u*)(WA + (size_t)row * 1024 + d * 256 + h * 64 + 8 * w); ga = *(const v4u*)(WA + (size_t)row * 1024 + (2 + d) * 256 + h * 64 + 8 * w);
        gri = rinv[(size_t)row * 4 + h];
        gbw = *(const v4u*)(rw_blob_row(C, d, 0, b, c, h, tt) + 8 * part); gbt = *(const v4u*)(rw_blob_row(C, d, 1, b, c, h, tt) + 8 * part);
    };
    auto images = [&](int bufi) {
        LAS bf16* VT = (LAS bf16*)(L0 + (5 + 3 * bufi) * IMG); LAS bf16* KcT = VT + 64 * MP; LAS bf16* BcT = KcT + 64 * MP;
        const unsigned rw_[4] = {gr.x, gr.y, gr.z, gr.w}, kw_[4] = {gk.x, gk.y, gk.z, gk.w}, vw_[4] = {gv.x, gv.y, gv.z, gv.w}, ww_[4] = {gw.x, gw.y, gw.z, gw.w}, aw_[4] = {ga.x, ga.y, ga.z, ga.w};
        float rh[8], kh[8], bh[8];
#pragma unroll
        for (int e = 0; e < 8; ++e) {
            const float rs = (e & 1) ? bfhi(rw_[e >> 1]) : bflo(rw_[e >> 1]), ks = (e & 1) ? bfhi(kw_[e >> 1]) : bflo(kw_[e >> 1]);
            const float wv = (e & 1) ? bfhi(ww_[e >> 1]) : bflo(ww_[e >> 1]), av = (e & 1) ? bfhi(aw_[e >> 1]) : bflo(aw_[e >> 1]);
            const float kap = ks * kkw[e] * gri, ktil = ks * (1.0f + (av - 1.0f) * kaw[e]);
            const float cf = wv, icf = __builtin_amdgcn_rcpf(cf), cfL = __builtin_bit_cast(float, __builtin_amdgcn_readlane(__builtin_bit_cast(int, cf), 63)), dec = cfL * icf;
            rh[e] = rs * cf; kh[e] = ktil * icf; bh[e] = kap * av * icf;
            const unsigned short vraw = (e & 1) ? (unsigned short)(vw_[e >> 1] >> 16) : (unsigned short)(vw_[e >> 1] & 0xffffu);
            VT[(8 * w + e) * MP + lane] = vraw; KcT[(8 * w + e) * MP + lane] = (bf16)f2bf1(ktil * dec); BcT[(8 * w + e) * MP + lane] = (bf16)f2bf1(-(kap * av * dec));
            if (lane == 63) cLv[bufi * 64 + 8 * w + e] = cfL;
        }
        { v4u o; o.x = pk2(rh[0], rh[1]); o.y = pk2(rh[2], rh[3]); o.z = pk2(rh[4], rh[5]); o.w = pk2(rh[6], rh[7]); *(LAS v4u*)(Rh + lane * MP + 8 * w) = o; }
        { v4u o; o.x = pk2(kh[0], kh[1]); o.y = pk2(kh[2], kh[3]); o.z = pk2(kh[4], kh[5]); o.w = pk2(kh[6], kh[7]); *(LAS v4u*)(Kh + lane * MP + 8 * w) = o; }
        { v4u o; o.x = pk2(bh[0], bh[1]); o.y = pk2(bh[2], bh[3]); o.z = pk2(bh[4], bh[5]); o.w = pk2(bh[6], bh[7]); *(LAS v4u*)(Bh + lane * MP + 8 * w) = o; }
        const unsigned bw_[4] = {gbw.x, gbw.y, gbw.z, gbw.w}, bt_[4] = {gbt.x, gbt.y, gbt.z, gbt.w};
#pragma unroll
        for (int e = 0; e < 4; ++e) {
            Wi[(8 * part + 2 * e) * MP + tt] = (bf16)(bw_[e] & 0xffffu); Wi[(8 * part + 2 * e + 1) * MP + tt] = (bf16)(bw_[e] >> 16);
            Ti[(8 * part + 2 * e) * MP + tt] = (bf16)(bt_[e] & 0xffffu); Ti[(8 * part + 2 * e + 1) * MP + tt] = (bf16)(bt_[e] >> 16);
        }
    };
    f32x4 Zst[NV];
#pragma unroll
    for (int v2 = 0; v2 < NV; ++v2) Zst[v2] = (f32x4){0.f, 0.f, 0.f, 0.f};
    const f32x4 z4 = (f32x4){0.f, 0.f, 0.f, 0.f};
    gload(0); images(0); gload(1);
#pragma unroll 1
    for (int n = 0; n < NCH; ++n) {
        RAW_BARRIER();
        const LAS bf16* VT = (const LAS bf16*)(L0 + (5 + 3 * (n & 1)) * IMG); const LAS bf16* KcT = VT + 64 * MP; const LAS bf16* BcT = KcT + 64 * MP;
        const LAS bf16* Zi = (const LAS bf16*)(L0 + (12 + (n & 1)) * IMG); LAS bf16* Zn = (LAS bf16*)(L0 + (12 + ((n + 1) & 1)) * IMG);
        const int arow = (16 * it + l15) * MP + 8 * q;
        const fragb Wf0 = ld_frag16(Wi + arow), Wf1 = ld_frag16(Wi + arow + 32), Tf0 = ld_frag16(Ti + arow), Tf1 = ld_frag16(Ti + arow + 32), Rf0 = ld_frag16(Rh + arow), Rf1 = ld_frag16(Rh + arow + 32);
        const int icol = 16 * it + l15;
        f32x4 pk[4], pb[4];
#pragma unroll
        for (int jt = 0; jt < 4; ++jt) {
            pk[jt] = z4; pb[jt] = z4;
            if (jt <= it) {
                const int jrow = (16 * jt + l15) * MP + 8 * q;
                f32x4 sk = mfma16(ld_frag16(Kh + jrow), Rf0, z4); sk = mfma16(ld_frag16(Kh + jrow + 32), Rf1, sk);
                f32x4 sb = mfma16(ld_frag16(Bh + jrow), Rf0, z4); sb = mfma16(ld_frag16(Bh + jrow + 32), Rf1, sb);
#pragma unroll
                for (int r = 0; r < 4; ++r) { const int j = 16 * jt + 4 * q + r; pk[jt][r] = (j <= icol) ? sk[r] : 0.f; pb[jt][r] = (j <= icol) ? -sb[r] : 0.f; }
            }
        }
        fragb Pk0 = pack_frag(pk[0], pk[1]), Pk1 = pack_frag(pk[2], pk[3]), Pb0 = pack_frag(pb[0], pb[1]), Pb1 = pack_frag(pb[2], pb[3]);
        f32x4 RZ[NV];
#pragma unroll
        for (int v2 = 0; v2 < NV; ++v2) {
            const int vrow = 16 * (vt0 + v2) + l15;
            const fragb z0 = ld_frag16(Zi + vrow * MP + 8 * q), z1 = ld_frag16(Zi + vrow * MP + 32 + 8 * q);
            f32x4 u = mfma16(Wf0, z0, z4); u = mfma16(Wf1, z1, u);
            u = mfma16(Tf0, ld_frag16(VT + vrow * MP + 8 * q), u); if (it >= 2) u = mfma16(Tf1, ld_frag16(VT + vrow * MP + 32 + 8 * q), u);
            RZ[v2] = mfma16(Rf0, z0, z4); RZ[v2] = mfma16(Rf1, z1, RZ[v2]);
            v2u o; o.x = pk2(u.x, u.y); o.y = pk2(u.z, u.w);
            *(LAS v2u*)(UT + vrow * MP + 16 * it + 4 * q) = o;
        }
        RAW_BARRIER();
        {
            const f32x4 cl4 = *(const LAS f32x4*)(cLv + (n & 1) * 64 + 16 * it + 4 * q);
            const LAS bf16* kr = KcT + (16 * it + l15) * MP + 4 * q; const LAS bf16* br = BcT + (16 * it + l15) * MP + 4 * q;
            const fragb kc0 = ld_frag8x2(kr, kr + 16), kc1 = ld_frag8x2(kr + 32, kr + 48), bc0 = ld_frag8x2(br, br + 16), bc1 = ld_frag8x2(br + 32, br + 48);
#pragma unroll
            for (int v2 = 0; v2 < NV; ++v2) {
                const int vrow = 16 * (vt0 + v2) + l15;
                const LAS bf16* vr = VT + vrow * MP + 4 * q; const LAS bf16* ur = UT + vrow * MP + 4 * q;
                const fragb vp0 = ld_frag8x2(vr, vr + 16), vp1 = ld_frag8x2(vr + 32, vr + 48), up0 = ld_frag8x2(ur, ur + 16), up1 = ld_frag8x2(ur + 32, ur + 48);
                f32x4 y = mfma16(Pk0, vp0, RZ[v2]); y = mfma16(Pb0, up0, y);
                if (it >= 2) { y = mfma16(Pk1, vp1, y); y = mfma16(Pb1, up1, y); }
#pragma unroll
                for (int r = 0; r < 4; ++r) { const int row = seqrow_raster(n * 64 + 16 * it + 4 * q + r, d, b); if (!DRY) outb[(size_t)row * 256 + h * 64 + vrow] = (bf16)f2bf1(y[r]); }
                f32x4 zn = mfma16(kc0, vp0, z4); zn = mfma16(kc1, vp1, zn); zn = mfma16(bc0, up0, zn); zn = mfma16(bc1, up1, zn);
                Zst[v2] = Zst[v2] * cl4 + zn;
                v2u so; so.x = pk2(Zst[v2].x, Zst[v2].y); so.y = pk2(Zst[v2].z, Zst[v2].w);
                *(LAS v2u*)(Zn + vrow * MP + 16 * it + 4 * q) = so;
            }
        }
        if (n + 1 < NCH) { images((n + 1) & 1); if (n + 2 < NCH) gload(n + 2); }
    }
    __syncthreads();
}
__device__ __forceinline__ void moe_scatter(const Ctx& C, int moe_li, int nrows) {
    const unsigned* gc = WSP(const unsigned, WS_CTL) + CW_MOECNT + 64 * moe_li;
    LAS int* pst = (LAS int*)C.lds;
    {
        int pe[8]; int acc = 0;
#pragma unroll
        for (int e = 0; e < NE; ++e) { const int blks = ((int)gc[e] + 255) >> 8; if (C.tid == e) pst[e] = acc * 256; acc += blks; pe[e] = acc; }
        if (C.wg == 0 && C.tid < MOE_MAXBLK) { int be = 0;
#pragma unroll
            for (int e = 0; e < NE; ++e) be += (pe[e] <= C.tid) ? 1 : 0;
            int* tab = WSP(int, WS_TAB); tab[1 + C.tid] = be < NE ? be : NE - 1; if (C.tid == 0) tab[0] = acc; }
    }
    __syncthreads();
    const unsigned* route = WSP(const unsigned, WS_ROUTE); const unsigned* wgbase = WSP(const unsigned, WS_WGBASE);
    int* pos = WSP(int, WS_POS); int* tok = WSP(int, WS_TOK);
    if (C.wg < NE) { const int cnt = (int)gc[C.wg], s0 = pst[C.wg] + cnt, s1 = pst[C.wg] + (((cnt + 255) >> 8) << 8);
        for (int j = s0 + C.tid; j < s1; j += NTHR) tok[j] = 0; }
    const int m = C.wg * NWAVES + C.wave + C.lane * (C.G * NWAVES);
    if (m < nrows) {
        const v4u a = *(const v4u*)(route + (size_t)m * 8);
        const int e0 = (int)a.x, e1 = (int)a.y;
        const int p0 = pst[e0] + (int)wgbase[C.wg * 8 + e0] + (int)a.z, p1 = pst[e1] + (int)wgbase[C.wg * 8 + e1] + (int)a.w;
        pos[(size_t)m * 2] = p0; pos[(size_t)m * 2 + 1] = p1; tok[p0] = m; tok[p1] = m;
    }
    __syncthreads();
}
template <int NEXT>
__device__ __forceinline__ void moe_combine(const Ctx& C, int l, int nrows) {
    const unsigned* route = WSP(const unsigned, WS_ROUTE); const int* pos = WSP(const int, WS_POS); const bf16* ym = WSP(const bf16, WS_MIX);
    const float* modv = WSP(const float, WS_MODV) + (size_t)l * 9 * 6144 + 5 * 1024;
    const float* modn = WSP(const float, WS_MODV) + (size_t)(l + 1) * 9 * 6144;
    float* xc = WSP(float, WS_XC); bf16* hb = WSP(bf16, WS_HB);
    const int gw = C.wg * NWAVES + C.wave, NGW = C.G * NWAVES;
    f32x4 gn[4];
#pragma unroll
    for (int j = 0; j < 4; ++j) gn[j] = *(const f32x4*)((NEXT == 2 ? C.in[I_FNG] : C.in[I_NMIXG] + (NEXT == 1 ? (l + 1) * 1024 : 0)) + 4 * C.lane + 256 * j);
    for (int m = gw; m < nrows; m += NGW) {
        const bool isctx = m >= T_LAT;
        float* xr = isctx ? xc + (size_t)(m - T_LAT) * 1024 : C.out + (size_t)m * 1024;
        const int mrow = isctx ? 8 : (m >> 12);
        const float* gv = modv + (size_t)mrow * 6144;
        const int p0 = pos[(size_t)m * 2], p1 = pos[(size_t)m * 2 + 1];
        const float w0 = __builtin_bit_cast(float, route[(size_t)m * 8 + 4]), w1 = __builtin_bit_cast(float, route[(size_t)m * 8 + 5]);
        f32x4 x[4]; float ss = 0.f;
#pragma unroll
        for (int j = 0; j < 4; ++j) {
            const int col = 4 * C.lane + 256 * j;
            const v2u a = *(const v2u*)(ym + (size_t)p0 * 1024 + col), b = *(const v2u*)(ym + (size_t)p1 * 1024 + col);
            const f32x4 ya = (f32x4){bflo(a.x), bfhi(a.x), bflo(a.y), bfhi(a.y)}, yb = (f32x4){bflo(b.x), bfhi(b.x), bflo(b.y), bfhi(b.y)};
            const f32x4 g = *(const f32x4*)(gv + col);
            x[j] = *(const f32x4*)(xr + col) + g * (ya * w0 + yb * w1);
            if (NEXT != 2) *(f32x4*)(xr + col) = x[j];
            ss += (x[j].x * x[j].x + x[j].y * x[j].y) + (x[j].z * x[j].z + x[j].w * x[j].w);
        }
        if (NEXT != 0) {
            const float rs = rsqrtf_(wave_sum(ss) * (1.0f / 1024.0f) + 1e-6f);
#pragma unroll
            for (int j = 0; j < 4; ++j) {
                const int col = 4 * C.lane + 256 * j;
                if (NEXT == 2) *(f32x4*)(xr + col) = x[j] * rs * gn[j];
                else { const f32x4 sh = *(const f32x4*)(modn + (size_t)mrow * 6144 + col), scl = *(const f32x4*)(modn + (size_t)mrow * 6144 + 1024 + col);
                    st4bf(hb + (size_t)m * 1024 + col, (x[j] * rs * gn[j]) * (scl + 1.0f) + sh); }
            }
        }
    }
}
__device__ __forceinline__ void final_norm(const Ctx& C) {
    const int gw = C.wg * NWAVES + C.wave, NGW = C.G * NWAVES;
    f32x4 gv[4];
#pragma unroll
    for (int j = 0; j < 4; ++j) gv[j] = *(const f32x4*)(C.in[I_FNG] + 4 * C.lane + 256 * j);
    for (int m = gw; m < T_LAT; m += NGW) {
        float* xr = C.out + (size_t)m * 1024;
        f32x4 v[4]; float s = 0.f;
#pragma unroll
        for (int j = 0; j < 4; ++j) { v[j] = *(const f32x4*)(xr + 4 * C.lane + 256 * j); s += (v[j].x * v[j].x + v[j].y * v[j].y) + (v[j].z * v[j].z + v[j].w * v[j].w); }
        const float rs = rsqrtf_(wave_sum(s) * (1.0f / 1024.0f) + 1e-6f);
#pragma unroll
        for (int j = 0; j < 4; ++j) *(f32x4*)(xr + 4 * C.lane + 256 * j) = v[j] * rs * gv[j];
    }
}

constexpr int NPH_L = 13, PH_FINAL = 1 + DEPTH * NPH_L, NPHASE = PH_FINAL + 1;
__host__ __device__ inline bool phase_exists(int ph) {
    if (ph == 0) return true;
    if (ph == PH_FINAL) return false;
    const int l = (ph - 1) / NPH_L, k = (ph - 1) % NPH_L;
    if (l >= 2 && !(l & 1) && k == 0) return false;
    if (!(l & 1) && k >= 11) return false;
    if (!RW_VSPLIT && k == 4) return false;
    return true;
}
#ifndef PH_MASK
#define PH_MASK 0xFFFFFF
#endif
#define PM(k) ((PH_MASK >> (k)) & 1)
#ifndef SK_MASK
#define SK_MASK 0xFFFF
#endif
#define SK(k) ((SK_MASK >> (k)) & 1)
#ifndef REP_MASK
#define REP_MASK 0
#endif
#define NREP(k) (((REP_MASK >> (k)) & 1) ? 2 : 1)

__global__ void __launch_bounds__(NTHR, 2) fwd_kernel(Args args) {
    extern __shared__ __attribute__((aligned(16))) unsigned char lds_raw[];
    Ctx C; C.in = args.in; C.out = args.out; C.ws = args.ws; C.lds = (LAS unsigned char*)lds_raw;
    C.tid = threadIdx.x; C.lane = C.tid & 63; C.wave = __builtin_amdgcn_readfirstlane(C.tid >> 6); C.G = gridDim.x; C.wg = blockIdx.x;
    volatile LAS unsigned* MISC = (volatile LAS unsigned*)(C.lds + MISC_OFF);
    if (C.tid < 64) MISC[C.tid] = 0u;
    __syncthreads();
    const int lo = args.ph_lo, hi = args.ph_hi;
    const bool multi = (hi - lo) > 1;
    if (multi) (void)xcd_barrier_post(WSP(unsigned, WS_CTL) + CW_BAR, MISC + 8);
#define IN(k) (lo <= (k) && (k) < hi)
#define SEAM(k) do { if (IN((k) + 1)) { XcdBarrier b2_; b2_.bar = WSP(unsigned, WS_CTL) + CW_BAR; b2_.x = xb_xcc_id(); b2_.st = (volatile LAS unsigned*)(C.lds + MISC_OFF) + 8; xcd_barrier(b2_); } } while (0)
#define FRESH() do { int t_ = threadIdx.x; asm volatile("" : "+v"(t_)); C.tid = t_; C.lane = t_ & 63; C.wave = __builtin_amdgcn_readfirstlane(t_ >> 6); } while (0)
#define PHASE(bit, k) if (PM(bit) && IN(pb + (k))) for (int rep_ = 0; rep_ < NREP(bit); ++rep_)
#define CLAIM(qh, var) __syncthreads(); if (C.tid == 0) *qslot = atomicAdd((qh), 1u); __syncthreads(); const int var = (int)*qslot;

    LAS unsigned* qslot = (LAS unsigned*)(C.lds + MISC_OFF + 128);
    if (PM(20) && IN(0)) { phase_pre(C); SEAM(0); }

#pragma unroll 1
    for (int l = 0; l < DEPTH; ++l) {
        const int pb = 1 + l * NPH_L;
        if (hi <= pb || lo >= pb + NPH_L) continue;
        const bool last = (l == DEPTH - 1), moe = (l & 1);
        const int nrows = last ? T_LAT : T_ALL;
        const float* xlat = (l == 0) ? C.in[I_X] : C.out; const float* xctx = (l == 0) ? C.in[I_CTX] : WSP(const float, WS_XC);
        const float* modv = WSP(const float, WS_MODV) + (size_t)l * 9 * 6144;
        unsigned* qbase = WSP(unsigned, WS_CTL) + CW_PREPQ + 256 * l;

        if (!(l >= 2 && !(l & 1))) PHASE(0, 0) { FRESH();
            convert_small(C, l);
            if (l == 0) { FRESH(); convert_items(C, 0, 3, C.wg * NWAVES + C.wave, C.G * NWAVES); }
            __syncthreads();
            FRESH(); norm_rows<false>(C, l, xlat, xctx, C.in[I_NMIXG] + l * 1024, 0, 1024, T_ALL, 0);
            SEAM(pb + 0);
        }
        PHASE(1, 1) { FRESH();
            pg8::Gemm g{WSP(const bf16, WS_HB), WSP(const bf16, WS_WIN), T_ALL, PLD, 1024, 0};
            pg8::StaticOrder S; S.init(T_ALL, PLD, C.G, C.wg);
            pg8::EpiBf16<0> E{WSP(bf16, WS_P), PLD, nullptr, 0, 0};
            pg8::gemm_phase<pg8::EpiBf16<0>, pg8::StaticOrder, false>(C.lds, g, S, E, nullptr);
            SEAM(pb + 1);
        }
        if (PM(2) && IN(pb + 2)) for (int rep_ = 0; rep_ < NREP(2); ++rep_) { FRESH();
            for (;;) {
                CLAIM(qbase + 16 * rep_, k)
                if (k >= 2 * NB * NCH) break;
                const int kind = k / (NB * NCH), u = k % (NB * NCH);
                FRESH();
                if (kind == 0) { for (int r3_ = 0; r3_ < NREP(24); ++r3_) { FRESH(); if (SK(1)) rwkv_prep2(C, l, u / NCH, u % NCH); } }
                else { for (int r3_ = 0; r3_ < NREP(26); ++r3_) { FRESH(); if (SK(2)) gdn_prep(C, l, u / NCH, u % NCH); } }
            }
            SEAM(pb + 2);
        }
        if (PM(3) && IN(pb + 3)) for (int rep_ = 0; rep_ < NREP(3); ++rep_) { FRESH();
            constexpr int NCL = 2 * NB * NH * NCH / 4;
            for (;;) {
                CLAIM(qbase + 64 + 16 * rep_, k)
                if (k >= NCL) break;
                FRESH();
                if (SK(10)) rwkv_solve_item(C, l, 4 * k + (C.wave >> 1));
            }
            SEAM(pb + (RW_VSPLIT ? 3 : 4));
        }
#if RW_VSPLIT
        if (PM(3) && IN(pb + 4)) { FRESH();
            for (;;) {
                CLAIM(qbase + 128, k)
                if (k >= 2 * NB * NH * NCH / 4) break;
                FRESH();
                if (SK(10)) rwkv_solve_item(C, l, 4 * k + (C.wave >> 1));
            }
            SEAM(pb + 4);
        }
#endif
        if (PM(4) && IN(pb + 5)) { FRESH();
            if (C.wg >= 64) {
                constexpr int NCL = 2 * NB * NH * NCH / 4;
                for (;;) {
                    CLAIM(qbase + 128, k)
                    if (k >= NCL) break;
                    FRESH();
                    if (SK(9)) gdn_solve_item(C, l, 4 * k + (C.wave >> 1));
                }
                asm volatile("s_waitcnt vmcnt(0)" ::: "memory");
                __syncthreads();
                if (C.tid == 0) { __builtin_amdgcn_fence(__ATOMIC_RELEASE, "agent"); asm volatile("s_waitcnt vmcnt(0)" ::: "memory"); (void)xb_add(qbase + 160, 1u); }
                if (C.wg >= 192) {
                    if (C.tid == 0) { unsigned* bar_ = WSP(unsigned, WS_CTL) + CW_BAR; XB_SPIN(xb_ld(qbase + 160) < (unsigned)(C.G - 64), bar_); __builtin_amdgcn_fence(__ATOMIC_ACQUIRE, "agent"); asm volatile("s_waitcnt vmcnt(0)" ::: "memory"); }
                    __syncthreads();
                }
                FRESH();
            }
            if (C.wg >= 64 && C.wg < 128) { if (SK(0)) lru_chain(C, l, C.wg - 64); FRESH(); }
            if (SK(3) && C.wg < (RW_VSPLIT ? 128 : 64)) { if (NREP(20) > 1) { FRESH(); rwkv_chunked<true>(C, l, C.wg); } FRESH(); rwkv_chunked<false>(C, l, C.wg); }
            else if (SK(4) && C.wg >= 128 && C.wg < 192) { for (int r2_ = 0; r2_ < NREP(21); ++r2_) { FRESH(); mlstm_chunked(C, l, C.wg - 128); } }
            else if (SK(5) && C.wg >= 192) { if (NREP(22) > 1) { FRESH(); gdn_chunked<true>(C, l, C.wg - 192); } FRESH(); gdn_chunked<false>(C, l, C.wg - 192); }
            {
                FRESH();
                const int nun = 0;
                for (;;) {
                    CLAIM(qbase + 192, u0)
                    if (u0 >= 128 + nun) break;
                    if (u0 < 128) {
                        FRESH(); if (l > 0) convert_items(C, l, 2, u0 * NWAVES + C.wave, 128 * NWAVES);
                        if (l + 1 < DEPTH) { FRESH(); convert_items(C, l + 1, 1, u0 * NWAVES + C.wave, 128 * NWAVES); }
                    }
                }
            }
            SEAM(pb + 5);
        }
        PHASE(5, 6) { FRESH();
            if (SK(8)) finish_rows(C, l, nrows);
            SEAM(pb + 6);
        }
        if (PM(6) && IN(pb + 7)) { FRESH();
            pg8::Gemm g{WSP(const bf16, WS_HB), WSP(const bf16, WS_WOUT), nrows, 1024, 1024, 0};
            pg8::StaticOrder S; S.init(nrows, 1024, C.G, C.wg);
            pg8::EpiRes E{xlat, xctx, C.out, WSP(float, WS_XC), modv + 2 * 1024};
            pg8::gemm_phase<pg8::EpiRes, pg8::StaticOrder, false>(C.lds, g, S, E, nullptr);
            SEAM(pb + 7);
        }
        if (PM(7) && IN(pb + 8)) { FRESH();
            if (moe) norm_rows<true>(C, l, C.out, WSP(const float, WS_XC), C.in[I_NFFNG] + l * 1024, 3 * 1024, 4 * 1024, nrows, l >> 1);
            else norm_rows<false>(C, l, C.out, WSP(const float, WS_XC), C.in[I_NFFNG] + l * 1024, 3 * 1024, 4 * 1024, nrows, 0);
            SEAM(pb + 8);
        }
        if (!moe) {
            if (PM(8) && IN(pb + 9)) for (int rep_ = 0; rep_ < NREP(8); ++rep_) { FRESH();
                pg8::Gemm g{WSP(const bf16, WS_HB), WSP(const bf16, WS_WGU), nrows, 2 * DFF, 1024, 0};
                pg8::StaticOrder S; S.init(nrows, 2 * DFF, C.G, C.wg);
                pg8::EpiSwiglu E{WSP(bf16, WS_P), DFF};
                pg8::gemm_phase<pg8::EpiSwiglu, pg8::StaticOrder, false>(C.lds, g, S, E, nullptr);
                SEAM(pb + 9);
            }
            if (PM(9) && IN(pb + 10)) { FRESH();
                pg8::Gemm g{WSP(const bf16, WS_P), WSP(const bf16, WS_WDN), nrows, 1024, DFF, 0};
                pg8::StaticOrder S; S.init(nrows, 1024, C.G, C.wg);
                pg8::EpiRes E{C.out, WSP(const float, WS_XC), C.out, WSP(float, WS_XC), modv + 5 * 1024};
                pg8::gemm_phase<pg8::EpiRes, pg8::StaticOrder, false>(C.lds, g, S, E, nullptr);
                SEAM(pb + 12);
            }
        } else {
            if (PM(10) && IN(pb + 9)) { FRESH(); moe_scatter(C, l >> 1, nrows); SEAM(pb + 9); }
            if (PM(11) && IN(pb + 10)) for (int rep_ = 0; rep_ < NREP(11); ++rep_) { FRESH();
                pg8::Gemm g{WSP(const bf16, WS_HB), WSP(const bf16, WS_WGU), 0, 2 * DFE, 1024, (size_t)2 * DFE * 1024};
                pg8::MoeOrderG S; S.init(WSP(const int, WS_TAB), (2 * DFE) / 256, C.G, C.wg); S.tok = WSP(const int, WS_TOK);
                pg8::EpiSwiglu E{WSP(bf16, WS_P), DFE};
                pg8::gemm_phase<pg8::EpiSwiglu, pg8::MoeOrderG, false>(C.lds, g, S, E, nullptr);
                SEAM(pb + 10);
            }
            if (PM(12) && IN(pb + 11)) for (int rep_ = 0; rep_ < NREP(12); ++rep_) { FRESH();
                pg8::Gemm g{WSP(const bf16, WS_P), WSP(const bf16, WS_WDN), 0, 1024, DFE, (size_t)1024 * DFE};
                pg8::MoeOrder S; S.init(WSP(const int, WS_TAB), 4, C.G, C.wg);
                pg8::EpiBf16<0> E{WSP(bf16, WS_MIX), 1024, nullptr, 0, 0};
                pg8::gemm_phase<pg8::EpiBf16<0>, pg8::MoeOrder, false>(C.lds, g, S, E, nullptr);
                SEAM(pb + 11);
            }
            if (PM(13) && IN(pb + 12)) { FRESH();
                if (last) moe_combine<2>(C, l, nrows);
                else { convert_small(C, l + 1); FRESH(); moe_combine<1>(C, l, nrows); if (IN(pb + NPH_L + 1)) { XcdBarrier b2_; b2_.bar = WSP(unsigned, WS_CTL) + CW_BAR; b2_.x = xb_xcc_id(); b2_.st = (volatile LAS unsigned*)(C.lds + MISC_OFF) + 8; xcd_barrier(b2_); } }
            }
        }
    }
}

extern "C" void kernel_launch(void* const* d_in, const int* in_sizes, int n_in, void* d_out, int out_size, void* d_ws, size_t ws_size, hipStream_t stream) {
    static int grid = 0;
    if (grid == 0) {
        if (n_in != N_IN || in_sizes[0] != T_LAT * DM || out_size != T_LAT * DM || ws_size < WS_END) {
            fprintf(stderr, "kernel_launch: unexpected problem (n_in %d, in0 %d, out %d, ws %zu < %zu)\n", n_in, n_in > 0 ? in_sizes[0] : -1, out_size, ws_size, (size_t)WS_END); grid = -1; return; }
        int dev = 0, cus = 0, per_cu = 0;
        if (hipGetDevice(&dev) != hipSuccess || hipDeviceGetAttribute(&cus, hipDeviceAttributeMultiprocessorCount, dev) != hipSuccess) { grid = -1; return; }
        if (hipFuncSetAttribute((const void*)fwd_kernel, hipFuncAttributeMaxDynamicSharedMemorySize, LDS_BYTES) != hipSuccess) { fprintf(stderr, "kernel_launch: hipFuncSetAttribute failed\n"); grid = -1; return; }
        if (hipOccupancyMaxActiveBlocksPerMultiprocessor(&per_cu, (const void*)fwd_kernel, NTHR, LDS_BYTES) != hipSuccess || per_cu < 1) { fprintf(stderr, "kernel_launch: occupancy query says %d\n", per_cu); grid = -1; return; }
        grid = cus;
        if (grid != 256) fprintf(stderr, "kernel_launch: note: %d CUs\n", grid);
    }
    if (grid < 0) return;
    if (hipMemsetAsync((char*)d_ws + WS_CTL, 0, CTL_BYTES, stream) != hipSuccess) return;
    Args a{};
    for (int i = 0; i < N_IN; ++i) a.in[i] = (const float*)d_in[i];
    a.out = (float*)d_out; a.ws = (unsigned char*)d_ws;
#if MK_ONE_LAUNCH
    a.ph_lo = 0; a.ph_hi = NPHASE;
    hipLaunchKernelGGL(fwd_kernel, dim3(grid), dim3(NTHR), LDS_BYTES, stream, a);
#else
    for (int ph = 0; ph < NPHASE; ++ph) { if (!phase_exists(ph)) continue; a.ph_lo = ph; a.ph_hi = ph + 1; hipLaunchKernelGGL(fwd_kernel, dim3(grid), dim3(NTHR), LDS_BYTES, stream, a); }
#endif
}
```

```cpp
#define MK_ONE_LAUNCH 1
#include <hip/hip_runtime.h>
#include <cstdio>
#include <cstdint>

#define GAS __attribute__((address_space(1)))
#define LAS __attribute__((address_space(3)))
typedef unsigned short bf16;
typedef unsigned v4u __attribute__((ext_vector_type(4)));
typedef unsigned v2u __attribute__((ext_vector_type(2)));
typedef float f32x4 __attribute__((ext_vector_type(4)));
typedef float f32x2 __attribute__((ext_vector_type(2)));
typedef short bf16x8 __attribute__((ext_vector_type(8)));
#define LDS_WAIT() asm volatile("s_waitcnt lgkmcnt(0)" ::: "memory")
#define VM_WAIT() asm volatile("s_waitcnt vmcnt(0)" ::: "memory")

constexpr int DM = 1024, NB = 8, SEQ = 4096, DEPTH = 4, CTXL = 256, GW = 256, HD = 64, NH = 4;
constexpr int T_LAT = NB * SEQ, T_CTX = NB * CTXL, T_ALL = T_LAT + T_CTX;
constexpr int IN_COLS = 3552, PLD = 3584;
constexpr int OFF_B = 512, OFF_C = 1472, OFF_D = 2512, B_COLS = 960;
constexpr int DFF = 2816, NE = 8, DFE = 1408;
constexpr int NCH = 68;
constexpr int NSTEP = 4352;
constexpr int MOE_MAXBLK = 280;
constexpr int NWAVES = 8, NTHR = 512;
#ifndef RW_VSPLIT
#define RW_VSPLIT 0
#endif

constexpr size_t MiB = 1u << 20;
constexpr size_t WS_CTL = 0, CTL_BYTES = 1 * MiB;
constexpr size_t WS_MODV = 1 * MiB;
constexpr size_t WS_XC = 2 * MiB;
constexpr size_t WS_WIN = 10 * MiB;
constexpr size_t WS_WOUT = 17 * MiB;
constexpr size_t WS_WGU = 19 * MiB;
constexpr size_t WS_WDN = 63 * MiB;
constexpr size_t WS_HB = 85 * MiB;
constexpr size_t WS_P = 153 * MiB;
constexpr size_t WS_MIX = 391 * MiB;
constexpr size_t WS_OUTB = WS_MIX, WS_OUTC = WS_MIX + 34 * MiB, WS_OUTD = WS_MIX + 68 * MiB, WS_GQ = WS_MIX + 102 * MiB, WS_G = WS_MIX + 153 * MiB;
constexpr size_t WS_RKV = WS_MIX + 170 * MiB;
constexpr size_t WS_SMALL = 612 * MiB;
constexpr size_t WS_ROUTE = WS_SMALL;
constexpr size_t WS_POS = WS_SMALL + 1280 * 1024;
constexpr size_t WS_TOK = WS_SMALL + 1664 * 1024;
constexpr size_t WS_BONUS = WS_SMALL + 2 * MiB;
constexpr size_t WS_RINV = WS_SMALL + 2 * MiB + 640 * 1024;
constexpr size_t WS_WGBASE = WS_SMALL + 3 * MiB + 256 * 1024;
constexpr size_t WS_TAB = WS_WGBASE + 65536;
constexpr size_t WS_LRUWT = WS_SMALL + 3 * MiB + 512 * 1024;
constexpr size_t WS_RWT = WS_LRUWT + 131072;
constexpr size_t WS_LRUH = WS_SMALL + 4 * MiB;
constexpr size_t WS_END = 633 * MiB;
constexpr int CW_MOECNT = 1024;
constexpr int CW_PREPQ = 2048;
constexpr int CW_BAR = 4096;

constexpr int LDS_BYTES = 135168;
constexpr int MISC_OFF = 131072;

__device__ __forceinline__ unsigned f2bf(float f) { unsigned u = __builtin_bit_cast(unsigned, f); return (u + 0x7fffu + ((u >> 16) & 1u)) >> 16; }
typedef __bf16 bf16n2 __attribute__((ext_vector_type(2)));
__device__ __forceinline__ unsigned pk2(float lo, float hi) { const f32x2 v = {lo, hi}; return __builtin_bit_cast(unsigned, __builtin_convertvector(v, bf16n2)); }
__device__ __forceinline__ unsigned f2bf1(float f) { return pk2(f, f) & 0xffffu; }
__device__ __forceinline__ float bf2f(unsigned short v) { return __builtin_bit_cast(float, (unsigned)v << 16); }
__device__ __forceinline__ float bflo(unsigned v) { return __builtin_bit_cast(float, v << 16); }
__device__ __forceinline__ float bfhi(unsigned v) { return __builtin_bit_cast(float, v & 0xffff0000u); }
template <int CTRL, int RM, bool BC> __device__ __forceinline__ float dpp_x(float oldv, float v) { return __builtin_bit_cast(float, __builtin_amdgcn_update_dpp(__builtin_bit_cast(int, oldv), __builtin_bit_cast(int, v), CTRL, RM, 0xF, BC)); }
__device__ __forceinline__ float wave_sum(float v) {
    v += dpp_x<0xB1, 0xF, true>(0.f, v); v += dpp_x<0x4E, 0xF, true>(0.f, v); v += dpp_x<0x141, 0xF, true>(0.f, v); v += dpp_x<0x140, 0xF, true>(0.f, v);
    v += dpp_x<0x142, 0xA, false>(0.f, v); v += dpp_x<0x143, 0xC, false>(0.f, v);
    return __builtin_bit_cast(float, __builtin_amdgcn_readlane(__builtin_bit_cast(int, v), 63));
}
template <int CTRL> __device__ __forceinline__ float dpp_f(float v) { return __builtin_bit_cast(float, __builtin_amdgcn_update_dpp(0, __builtin_bit_cast(int, v), CTRL, 0xF, 0xF, true)); }
__device__ __forceinline__ float row16_sum(float v) {
    v += dpp_f<0xB1>(v);
    v += dpp_f<0x4E>(v);
    v += dpp_f<0x141>(v);
    v += dpp_f<0x140>(v);
    return v;
}
__device__ __forceinline__ float sigmoidf_(float x) { return __builtin_amdgcn_rcpf(1.0f + __expf(-x)); }
__device__ __forceinline__ float softplusf_(float x) { return fmaxf(x, 0.f) + __logf(1.0f + __expf(-fabsf(x))); }
__device__ __forceinline__ float expm1f_(float x) { return x > -0.3f ? x * (1.0f + x * (0.5f + x * (0.16666667f + x * (0.041666668f + x * 0.0083333338f)))) : __expf(x) - 1.0f; }
__device__ __forceinline__ float siluf_(float x) { return x * __builtin_amdgcn_rcpf(1.0f + __expf(-x)); }
__device__ __forceinline__ float tanhf_(float x) { const float e = __expf(2.0f * x); return 1.0f - 2.0f * __builtin_amdgcn_rcpf(e + 1.0f); }
__device__ __forceinline__ float rsqrtf_(float x) { return __builtin_amdgcn_rsqf(x); }
__device__ __forceinline__ float gelu_tanh(float x) { return 0.5f * x * (1.0f + tanhf_(0.7978845608028654f * (x + 0.044715f * x * x * x))); }
__device__ __forceinline__ f32x4 ld4bf(const bf16* p) { const v2u a = *(const v2u*)p; return (f32x4){bflo(a.x), bfhi(a.x), bflo(a.y), bfhi(a.y)}; }
__device__ __forceinline__ void st4bf(bf16* p, const f32x4& v) { v2u o; o.x = pk2(v.x, v.y); o.y = pk2(v.z, v.w); *(v2u*)p = o; }
#define XB_TMO      128
#define XB_XCNT(j)  (256  + 64 * (j))
#define XB_XSUB(j)  (1280 + 64 * (j))
#define XB_XGEN(j)  (2304 + 64 * (j))
#define XB_TOP      3328
#define XB_TOPGEN   3392
#define XCD_BAR_WORDS 3456
#define XB_SPIN_CAP (1u << 22)

__device__ __forceinline__ unsigned xb_ld(unsigned* p)              { return __hip_atomic_load(p, __ATOMIC_RELAXED, __HIP_MEMORY_SCOPE_AGENT); }
__device__ __forceinline__ unsigned xb_add(unsigned* p, unsigned v) { return __hip_atomic_fetch_add(p, v, __ATOMIC_RELAXED, __HIP_MEMORY_SCOPE_AGENT); }
__device__ __forceinline__ unsigned xb_xcc_id() { return (unsigned)__builtin_amdgcn_s_getreg((3 << 11) | 20) & 0xFu; }
#define XB_SPIN(cond, bar) do { unsigned _sp = 0; while (cond) { __builtin_amdgcn_s_sleep(1); \
    if ((++_sp & 255u) == 0u) { if (xb_ld(&(bar)[XB_TMO])) break; if (_sp > XB_SPIN_CAP) { atomicAdd(&(bar)[XB_TMO], 1u); break; } } } } while (0)

struct XcdBarrier {
    unsigned* bar; unsigned x;
    volatile LAS unsigned* st;
};

__device__ __forceinline__ XcdBarrier xcd_barrier_post(unsigned* bar, volatile LAS unsigned* st) {
    XcdBarrier b; b.bar = bar; b.x = xb_xcc_id(); b.st = st;
    if (threadIdx.x == 0) (void)xb_add(&bar[XB_XCNT(b.x)], 1u);
    return b;
}
__device__ __forceinline__ void xcd_barrier_complete(unsigned* bar, unsigned x, unsigned& nloc, unsigned& nx) {
    const unsigned G = gridDim.x * gridDim.y * gridDim.z;
    unsigned sum, cnt, mine, sp = 0u;
    for (;;) {
        sum = 0u; cnt = 0u; mine = 0u;
#pragma unroll
        for (unsigned j = 0; j < 16; ++j) { const unsigned c = xb_ld(&bar[XB_XCNT(j)]); sum += c; cnt += (c > 0u) ? 1u : 0u; mine = (j == x) ? c : mine; }
        if (sum == G) break;
        __builtin_amdgcn_s_sleep(1);
        if ((++sp & 255u) == 0u) { if (xb_ld(&bar[XB_TMO])) break; if (sp > XB_SPIN_CAP) { atomicAdd(&bar[XB_TMO], 1u); break; } }
    }
    nloc = mine > 0u ? mine : 1u; nx = cnt > 0u ? cnt : 1u;
}

__device__ __forceinline__ void xcd_barrier(const XcdBarrier& b) {
    asm volatile("s_waitcnt vmcnt(0)" ::: "memory");
    __syncthreads();
    if (threadIdx.x == 0) {
        unsigned* bar = b.bar;
        __builtin_amdgcn_s_waitcnt(0);
        unsigned nloc = b.st[0], nx = b.st[1];
        if (nloc == 0u) { xcd_barrier_complete(bar, b.x, nloc, nx); b.st[0] = nloc; b.st[1] = nx; }
        const unsigned old = xb_add(&bar[XB_XSUB(b.x)], 1u);
        const unsigned gen = old / nloc;
        if (old + 1u == (gen + 1u) * nloc) {
            __builtin_amdgcn_fence(__ATOMIC_RELEASE, "agent");
            asm volatile("s_waitcnt vmcnt(0)" ::: "memory");
            const unsigned og = xb_add(&bar[XB_TOP], 1u);
            const unsigned tg = og / nx;
            if (og + 1u == (tg + 1u) * nx) xb_add(&bar[XB_TOPGEN], 1u);
            else XB_SPIN(xb_ld(&bar[XB_TOPGEN]) == tg, bar);
            __builtin_amdgcn_fence(__ATOMIC_ACQUIRE, "agent");
            xb_add(&bar[XB_XGEN(b.x)], 1u);
            asm volatile("s_waitcnt vmcnt(0)" ::: "memory");
        } else {
            XB_SPIN(xb_ld(&bar[XB_XGEN(b.x)]) == gen, bar);
            __builtin_amdgcn_fence(__ATOMIC_ACQUIRE, "agent");
            asm volatile("s_waitcnt vmcnt(0)" ::: "memory");
        }
    }
    __syncthreads();
}

namespace pg8 {
#define PG8_LAS __attribute__((address_space(3)))
typedef unsigned short bf16_t;
typedef short bf16x8 __attribute__((ext_vector_type(8)));
typedef float f32x4 __attribute__((ext_vector_type(4)));
typedef unsigned u32x4 __attribute__((ext_vector_type(4)));
constexpr int BM = 256, BK = 64, HALF = 128, HTB = HALF * BK * 2  , STAGE_BYTES = 8 * HTB, NXCD = 8, WGM = 8;

__host__ __device__ __forceinline__ int lds_byte(int r, int c) { const int st = (r >> 4) * 2 + (c >> 5), rr = r & 15, cc = c & 31, ob = rr * 64 + cc * 2; return st * 1024 + (ob ^ (((ob >> 9) & 1) << 5)); }
__host__ __device__ __forceinline__ void stage_rc(int b, int& R, int& C) { const int st = b / 1024, sb = b % 1024, swz = sb ^ (((sb >> 9) & 1) << 5); R = (st >> 1) * 16 + swz / 64; C = (st & 1) * 32 + (swz % 64) / 2; }
__host__ __device__ __forceinline__ int perm32(int rho) { const int n = rho >> 4, i = rho & 15; return 8 * (i >> 2) + 4 * n + (i & 3); }

struct Unit { int pm, pn, e; };
struct Gemm { const bf16_t* A; const bf16_t* Bt; int M, N, K; size_t estride; };

struct StaticOrder {
    static constexpr bool GATHER = false;
    int nM, nN, nwg, G, c;
    __host__ __device__ void init(int M, int N, int G_, int c_) { nM = M / BM; nN = N / BM; nwg = nM * nN; G = G_; c = c_; }
    __host__ __device__ bool next(int i, Unit& u) const {
        const long L = (long)i * G + c; if (L >= nwg) return false;
        int wgid = (int)L; { const int q = nwg / NXCD, r = nwg % NXCD, xcd = wgid % NXCD, off = wgid / NXCD; wgid = (xcd < r ? xcd * (q + 1) : r * (q + 1) + (xcd - r) * q) + off; }
        const int nig = WGM * nN, gid = wgid / nig, fm = gid * WGM, gsz = (nM - fm) < WGM ? (nM - fm) : WGM;
        u.pm = fm + ((wgid % nig) % gsz); u.pn = (wgid % nig) / gsz; u.e = 0; return true;
    }
    __device__ __forceinline__ void a_ready(const Unit&) const {}
    __device__ __forceinline__ void done(const Unit&) const {}
};
__device__ __forceinline__ unsigned cvt_pk_bf16(float lo, float hi) { unsigned r; asm volatile("v_cvt_pk_bf16_f32 %0, %1, %2" : "=v"(r) : "v"(lo), "v"(hi)); return r; }
typedef float f32x2 __attribute__((ext_vector_type(2)));
__device__ __forceinline__ f32x2 gelu_pk(f32x2 v) {
    const f32x2 av = __builtin_elementwise_abs(v), d = av * 0.2316418882f + 1.0f;
    f32x2 t; t.x = __builtin_amdgcn_rcpf(d.x); t.y = __builtin_amdgcn_rcpf(d.y);
    f32x2 q = t * 0.5307027145f + (-0.7265760135f); q = q * t + 0.7107068705f; q = q * t + (-0.142248368f); q = q * t + 0.127414796f; q = q * t;
    const f32x2 s = (v * v) * (-0.72134752044f);
    f32x2 e; e.x = __builtin_amdgcn_exp2f(s.x); e.y = __builtin_amdgcn_exp2f(s.y);
    const f32x2 m = v * (q * e), r = v - m;
    f32x2 o; o.x = v.x < 0.f ? m.x : r.x; o.y = v.y < 0.f ? m.y : r.y; return o;
}

struct EpiF32 {
    static constexpr bool PERM = false, AFTER_DRAIN = false;
    float* C; int ldc; const float* bias;
    __device__ __forceinline__ void operator()(const f32x4 (&acc)[2][2][4][2], const Unit& u, int wr, int wc, int fr, int fq) const {
        const int row0 = u.pm * BM + wr * 64 + fr, col0 = u.pn * BM + wc * 32 + 4 * fq;
        f32x4 bv[2][2];
#pragma unroll
        for (int bj = 0; bj < 2; ++bj)
#pragma unroll
            for (int n = 0; n < 2; ++n) bv[bj][n] = bias ? *(const f32x4*)(bias + col0 + bj * HALF + n * 16) : (f32x4){0.f, 0.f, 0.f, 0.f};
#pragma unroll
        for (int ai = 0; ai < 2; ++ai)
#pragma unroll
            for (int m = 0; m < 4; ++m) { float* rowp = C + (size_t)(row0 + ai * HALF + m * 16) * ldc + col0;
#pragma unroll
                for (int bj = 0; bj < 2; ++bj)
#pragma unroll
                    for (int n = 0; n < 2; ++n) *(f32x4*)(rowp + bj * HALF + n * 16) = acc[ai][bj][m][n] + bv[bj][n]; }
    }
};
template <int ACT  > struct EpiBf16 {
    static constexpr bool PERM = true, AFTER_DRAIN = false;
    bf16_t* O; int ldc; const float* bias; int split_cols; size_t split_stride;
    __device__ __forceinline__ void operator()(const f32x4 (&acc)[2][2][4][2], const Unit& u, int wr, int wc, int fr, int fq) const {
        const int row0 = u.pm * BM + wr * 64 + fr; int colt = u.pn * BM; bf16_t* base = O;
        if (split_cols) { const int t = colt / split_cols; base += (size_t)t * split_stride; colt -= t * split_cols; }
        const int col0 = colt + wc * 32 + 8 * fq, bcol0 = u.pn * BM + wc * 32 + 8 * fq;
        f32x4 bv[2][2];
#pragma unroll
        for (int bj = 0; bj < 2; ++bj)
#pragma unroll
            for (int n = 0; n < 2; ++n) bv[bj][n] = bias ? *(const f32x4*)(bias + bcol0 + bj * HALF + 4 * n) : (f32x4){0.f, 0.f, 0.f, 0.f};
#pragma unroll
        for (int ai = 0; ai < 2; ++ai)
#pragma unroll
            for (int m = 0; m < 4; ++m) { bf16_t* rowp = base + (size_t)(row0 + ai * HALF + m * 16) * ldc + col0;
#pragma unroll
                for (int bj = 0; bj < 2; ++bj) { f32x4 v0 = acc[ai][bj][m][0] + bv[bj][0], v1 = acc[ai][bj][m][1] + bv[bj][1];
                    if (ACT == 1) { f32x2 a = gelu_pk((f32x2){v0[0], v0[1]}), b = gelu_pk((f32x2){v0[2], v0[3]}), c = gelu_pk((f32x2){v1[0], v1[1]}), d = gelu_pk((f32x2){v1[2], v1[3]});
                        v0 = (f32x4){a.x, a.y, b.x, b.y}; v1 = (f32x4){c.x, c.y, d.x, d.y}; }
                    if (ACT == 2) {
#pragma unroll
                        for (int j = 0; j < 4; ++j) { v0[j] = 0.5f * v0[j] * (1.0f + erff(v0[j] * 0.70710678f)); v1[j] = 0.5f * v1[j] * (1.0f + erff(v1[j] * 0.70710678f)); } }
                    u32x4 w; w.x = cvt_pk_bf16(v0[0], v0[1]); w.y = cvt_pk_bf16(v0[2], v0[3]); w.z = cvt_pk_bf16(v1[0], v1[1]); w.w = cvt_pk_bf16(v1[2], v1[3]);
                    *(u32x4*)(rowp + bj * HALF) = w; } }
    }
};

template <class Epi, class Sched, bool STAMP = false>
__device__ __forceinline__ void gemm_phase(PG8_LAS unsigned char* lds, const Gemm g, const Sched& S, const Epi& E, unsigned long long* stamps) {
    int tid_ = threadIdx.x; asm volatile("" : "+v"(tid_));
    const int tid = tid_, wid = __builtin_amdgcn_readfirstlane(tid >> 6), lane = tid & 63, wr = wid >> 2, wc = wid & 3, fr = lane & 15, fq = lane >> 4;
    const int K = g.K, nt = K / BK;
    constexpr bool GATHER = Sched::GATHER;
    int ts_lo = 0, ts_hi = 0, nts = 0; const unsigned long long rt_entry = STAMP ? (unsigned long long)wall_clock64() : 0ull;
#define PG8_STAMP() do { if (STAMP && wid == 0 && nts < 64) { const unsigned long long _c = (unsigned long long)clock64(); \
        ts_lo = (lane == nts) ? (int)(unsigned)_c : ts_lo; ts_hi = (lane == nts) ? (int)(unsigned)(_c >> 32) : ts_hi; ++nts; } } while (0)
    PG8_STAMP();
    unsigned voffA[2], voffB[2]; int rowA[2];
#pragma unroll
    for (int i = 0; i < 2; ++i) { int R, C; stage_rc(tid * 16 + i * 8192, R, C); const int Rb = Epi::PERM ? ((R & ~31) + perm32(R & 31)) : R;
        rowA[i] = R; voffA[i] = GATHER ? (unsigned)C * 2u : (unsigned)(R * K + C) * 2u; voffB[i] = (unsigned)(Rb * K + C) * 2u; }
    const size_t kstep = (size_t)(BK * 2);
    const size_t hstep = (size_t)HALF * K * 2;
    const size_t tstep = 2 * hstep;
    const unsigned ldsw = (unsigned)wid * 1024u;
    const int aoff = lds_byte(wr * 64 + fr, fq * 8), boff = lds_byte(wc * 32 + fr, fq * 8);
#define PG8_SA(b, h) (((b) * 2 + (h)) * HTB)
#define PG8_SB(b, h) ((4 + (b) * 2 + (h)) * HTB)
#define PG8_STAGE(bufoff, gbase, voff) do { _Pragma("unroll") for (int _i = 0; _i < 2; ++_i) \
        __builtin_amdgcn_global_load_lds((const unsigned*)((const char*)(gbase) + (voff)[_i]), (PG8_LAS unsigned*)(lds + (bufoff) + ldsw + _i * 8192), 16, 0, 0); } while (0)
#define PG8_STAGE_A(bufoff, gbase, h, gv) do { if constexpr (GATHER) { PG8_STAGE(bufoff, gbase, (gv)[h]); } else { PG8_STAGE(bufoff, (gbase) + (h) * hstep, voffA); } } while (0)
#define PG8_TOKSLOT(s) ((PG8_LAS int*)(lds + STAGE_BYTES + 1024 + ((s) & 1) * 1024))
#define PG8_LDA(dst, b, h) do { _Pragma("unroll") for (int m = 0; m < 4; ++m) _Pragma("unroll") for (int k = 0; k < 2; ++k) dst[m][k] = *(const PG8_LAS bf16x8*)(lds + PG8_SA(b, h) + aoff + m * 2048 + k * 1024); } while (0)
#define PG8_LDB(dst, b, h) do { _Pragma("unroll") for (int n = 0; n < 2; ++n) _Pragma("unroll") for (int k = 0; k < 2; ++k) dst[n][k] = *(const PG8_LAS bf16x8*)(lds + PG8_SB(b, h) + boff + n * 2048 + k * 1024); } while (0)
#define PG8_MMA(ai, bj, At, Bt) do { __builtin_amdgcn_s_setprio(1); _Pragma("unroll") for (int m = 0; m < 4; ++m) _Pragma("unroll") for (int n = 0; n < 2; ++n) _Pragma("unroll") for (int k = 0; k < 2; ++k) \
        acc[ai][bj][m][n] = __builtin_amdgcn_mfma_f32_16x16x32_bf16(Bt[n][k], At[m][k], acc[ai][bj][m][n], 0, 0, 0); __builtin_amdgcn_s_setprio(0); } while (0)
#define PG8_WAIT_V(n) asm volatile("s_waitcnt vmcnt(" #n ")" ::: "memory")
#define PG8_WAIT_L(n) asm volatile("s_waitcnt lgkmcnt(" #n ")" ::: "memory")
#define PG8_BAR __builtin_amdgcn_s_barrier()
#define PG8_SCHED __builtin_amdgcn_sched_barrier(0)
    Unit cur, nxt; int ui = 0;
    if (!S.next(0, cur)) return;
    f32x4 acc[2][2][4][2];
#pragma unroll
    for (int a = 0; a < 2; ++a)
#pragma unroll
        for (int b = 0; b < 2; ++b)
#pragma unroll
            for (int m = 0; m < 4; ++m)
#pragma unroll
                for (int n = 0; n < 2; ++n) acc[a][b][m][n] = (f32x4){0.f, 0.f, 0.f, 0.f};
    bf16x8 At[4][2], B0[2][2], B1[2][2];
    const char* cA = (const char*)g.A + (GATHER ? (size_t)0 : (size_t)cur.pm * tstep); const char* cB = (const char*)g.Bt + (size_t)cur.pn * tstep + (size_t)cur.e * g.estride * 2;
    S.a_ready(cur);
    unsigned gcur[2][2], gnxt[2][2], gs[2][2];
    if constexpr (GATHER) {
        if (tid < 256) PG8_TOKSLOT(0)[tid] = S.tok[cur.pm * 256 + tid];
        __syncthreads();
#pragma unroll
        for (int h = 0; h < 2; ++h)
#pragma unroll
            for (int i = 0; i < 2; ++i) { gcur[h][i] = (unsigned)PG8_TOKSLOT(0)[h * HALF + rowA[i]] * (unsigned)(K * 2) + voffA[i]; gnxt[h][i] = gcur[h][i]; gs[h][i] = gcur[h][i]; }
    }
    PG8_STAGE(PG8_SB(0, 0), cB, voffB); PG8_STAGE_A(PG8_SA(0, 0), cA, 0, gcur); PG8_STAGE(PG8_SB(0, 1), cB + hstep, voffB); PG8_STAGE_A(PG8_SA(0, 1), cA, 1, gcur);
    if (wr == 1) PG8_BAR;
    PG8_WAIT_V(4); PG8_BAR;
    PG8_STAGE(PG8_SB(1, 0), cB + kstep, voffB); PG8_STAGE_A(PG8_SA(1, 0), cA + kstep, 0, gcur); PG8_STAGE(PG8_SB(1, 1), cB + hstep + kstep, voffB);
    PG8_WAIT_V(6); PG8_BAR;
    PG8_STAMP();
    for (;;) {
        const bool has_next = S.next(ui + 1, nxt);
        if constexpr (GATHER) { if (has_next && wid < 4)
            __builtin_amdgcn_global_load_lds((const unsigned*)(S.tok + nxt.pm * 256 + wid * 64 + lane), (PG8_LAS unsigned*)((PG8_LAS unsigned char*)PG8_TOKSLOT(ui + 1) + wid * 256), 4, 0, 0); }
        const char* nA = GATHER ? (const char*)g.A : has_next ? (const char*)g.A + (size_t)nxt.pm * tstep : cA; const char* nB = has_next ? (const char*)g.Bt + (size_t)nxt.pn * tstep + (size_t)nxt.e * g.estride * 2 : cB;
        for (int t = 0; t < nt; t += 2) {
            const bool last = (t == nt - 2);
            const char* a1 = cA + (size_t)(t + 1) * kstep;
            const char* a2 = last ? nA : cA + (size_t)(t + 2) * kstep; const char* b2 = last ? nB : cB + (size_t)(t + 2) * kstep;
            const char* a3 = a2 + kstep; const char* b3 = b2 + kstep;
            if (last && has_next) S.a_ready(nxt);
            if constexpr (GATHER) {
                if (last && has_next) {
#pragma unroll
                    for (int h = 0; h < 2; ++h)
#pragma unroll
                        for (int i = 0; i < 2; ++i) gnxt[h][i] = (unsigned)PG8_TOKSLOT(ui + 1)[h * HALF + rowA[i]] * (unsigned)(K * 2) + voffA[i];
                }
#pragma unroll
                for (int h = 0; h < 2; ++h)
#pragma unroll
                    for (int i = 0; i < 2; ++i) gs[h][i] = last ? gnxt[h][i] : gcur[h][i];
            }
            PG8_LDB(B0, 0, 0); PG8_SCHED; PG8_LDA(At, 0, 0); PG8_STAGE_A(PG8_SA(1, 1), a1, 1, gcur);
            PG8_WAIT_L(8); PG8_BAR; PG8_WAIT_L(0); PG8_MMA(0, 0, At, B0); PG8_BAR; PG8_SCHED;
            PG8_LDB(B1, 0, 1); PG8_STAGE(PG8_SB(0, 0), b2, voffB);
            PG8_BAR; PG8_WAIT_L(0); PG8_MMA(0, 1, At, B1); PG8_BAR;
            PG8_LDA(At, 0, 1); PG8_STAGE_A(PG8_SA(0, 0), a2, 0, gs);
            PG8_BAR; PG8_WAIT_L(0); PG8_MMA(1, 0, At, B0); PG8_BAR; PG8_SCHED;
            PG8_STAGE(PG8_SB(0, 1), b2 + hstep, voffB);
            PG8_WAIT_V(6); PG8_BAR; PG8_MMA(1, 1, At, B1); PG8_BAR;
            PG8_LDB(B0, 1, 0); PG8_SCHED; PG8_LDA(At, 1, 0); PG8_STAGE_A(PG8_SA(0, 1), a2, 1, gs);
            PG8_WAIT_L(8); PG8_BAR; PG8_WAIT_L(0); PG8_MMA(0, 0, At, B0); PG8_BAR; PG8_SCHED;
            PG8_LDB(B1, 1, 1); PG8_STAGE(PG8_SB(1, 0), b3, voffB);
            PG8_BAR; PG8_WAIT_L(0); PG8_MMA(0, 1, At, B1); PG8_BAR;
            PG8_LDA(At, 1, 1); PG8_STAGE_A(PG8_SA(1, 0), a3, 0, gs);
            PG8_BAR; PG8_WAIT_L(0); PG8_MMA(1, 0, At, B0); PG8_BAR; PG8_SCHED;
            PG8_STAGE(PG8_SB(1, 1), b3 + hstep, voffB);
            PG8_WAIT_V(6); PG8_BAR; PG8_MMA(1, 1, At, B1); PG8_BAR;
        }
        PG8_STAMP();
        if constexpr (!Epi::AFTER_DRAIN) { E(acc, cur, wr, wc, fr, fq); S.done(cur); }
        PG8_STAMP();
        if (!has_next) break;
#pragma unroll
        for (int a = 0; a < 2; ++a)
#pragma unroll
            for (int b = 0; b < 2; ++b)
#pragma unroll
                for (int m = 0; m < 4; ++m)
#pragma unroll
                    for (int n = 0; n < 2; ++n) acc[a][b][m][n] = (f32x4){0.f, 0.f, 0.f, 0.f};
        cur = nxt; cA = nA; cB = nB; ++ui;
        if constexpr (GATHER) {
#pragma unroll
            for (int h = 0; h < 2; ++h)
#pragma unroll
                for (int i = 0; i < 2; ++i) gcur[h][i] = gnxt[h][i];
        }
    }
    PG8_WAIT_V(0);
    if (wr == 0) PG8_BAR;
    PG8_BAR;
    if constexpr (Epi::AFTER_DRAIN) { E.fused(acc, cur, wr, wc, fr, fq, lds, wid, lane); S.done(cur); }
    PG8_STAMP();
    if (STAMP && wid == 0) { stamps[lane] = lane < nts ? (((unsigned long long)(unsigned)ts_hi << 32) | (unsigned)ts_lo) : 0ull;
        if (lane == 62) stamps[62] = rt_entry; if (lane == 63) stamps[63] = (unsigned long long)wall_clock64(); }
#undef PG8_STAMP
#undef PG8_SA
#undef PG8_SB
#undef PG8_STAGE
#undef PG8_STAGE_A
#undef PG8_TOKSLOT
#undef PG8_LDA
#undef PG8_LDB
#undef PG8_MMA
#undef PG8_WAIT_V
#undef PG8_WAIT_L
#undef PG8_BAR
#undef PG8_SCHED
}
}
namespace pg8 {
struct EpiRes {
    static constexpr bool PERM = false, AFTER_DRAIN = false;
    const float* base_lat; const float* base_ctx; float* out_lat; float* out_ctx; const float* gvec;
    __device__ __forceinline__ void operator()(const f32x4 (&acc)[2][2][4][2], const Unit& u, int wr, int wc, int fr, int fq) const {
        const bool isctx = u.pm >= 128;
        const int prow = (isctx ? (u.pm - 128) : u.pm) * BM;
        const float* base = isctx ? base_ctx : base_lat; float* out = isctx ? out_ctx : out_lat;
        const float* gv = gvec + (size_t)(isctx ? 8 : (u.pm >> 4)) * 6144;
        const int row0 = prow + wr * 64 + fr, col0 = u.pn * BM + wc * 32 + 4 * fq;
        f32x4 gvv[2][2];
#pragma unroll
        for (int bj = 0; bj < 2; ++bj)
#pragma unroll
            for (int n = 0; n < 2; ++n) gvv[bj][n] = *(const f32x4*)(gv + col0 + bj * HALF + n * 16);
#pragma unroll
        for (int ai = 0; ai < 2; ++ai)
#pragma unroll
            for (int m = 0; m < 4; ++m) { const size_t off = (size_t)(row0 + ai * HALF + m * 16) * 1024 + col0;
#pragma unroll
                for (int bj = 0; bj < 2; ++bj)
#pragma unroll
                    for (int n = 0; n < 2; ++n) { const f32x4 b = *(const f32x4*)(base + off + bj * HALF + n * 16);
                        *(f32x4*)(out + off + bj * HALF + n * 16) = b + gvv[bj][n] * acc[ai][bj][m][n]; } }
    }
};
struct EpiSwiglu {
    static constexpr bool PERM = true, AFTER_DRAIN = false;
    bf16_t* O; int ldc;
    __device__ __forceinline__ void operator()(const f32x4 (&acc)[2][2][4][2], const Unit& u, int wr, int wc, int fr, int fq) const {
        const int row0 = u.pm * BM + wr * 64 + fr, col0 = u.pn * HALF + wc * 32 + 8 * fq;
#pragma unroll
        for (int ai = 0; ai < 2; ++ai)
#pragma unroll
            for (int m = 0; m < 4; ++m) { bf16_t* rowp = O + (size_t)(row0 + ai * HALF + m * 16) * ldc + col0;
                float h[8];
#pragma unroll
                for (int n = 0; n < 2; ++n)
#pragma unroll
                    for (int j = 0; j < 4; ++j) { const float g = acc[ai][0][m][n][j], up = acc[ai][1][m][n][j]; h[n * 4 + j] = g * __builtin_amdgcn_rcpf(1.0f + __expf(-g)) * up; }
                u32x4 w; w.x = cvt_pk_bf16(h[0], h[1]); w.y = cvt_pk_bf16(h[2], h[3]); w.z = cvt_pk_bf16(h[4], h[5]); w.w = cvt_pk_bf16(h[6], h[7]);
                *(u32x4*)rowp = w; }
    }
};
struct MoeOrder {
    static constexpr bool GATHER = false;
    int nN, G, c, nunits; const int* tab;
    __device__ void init(const int* tab_, int nN_, int G_, int c_) { tab = tab_; nN = nN_; G = G_; c = c_; nunits = tab_[0] * nN_; }
    __device__ bool next(int i, Unit& u) const {
        const int L = i * G + c; if (L >= nunits) return false;
        const int q = nunits / NXCD, r = nunits % NXCD, xcd = L % NXCD, off = L / NXCD;
        const int w = (xcd < r ? xcd * (q + 1) : r * (q + 1) + (xcd - r) * q) + off;
        u.pm = w / nN; u.pn = w - u.pm * nN; u.e = tab[1 + u.pm]; return true;
    }
    __device__ __forceinline__ void a_ready(const Unit&) const {}
    __device__ __forceinline__ void done(const Unit&) const {}
};
struct MoeOrderG : MoeOrder { static constexpr bool GATHER = true; const int* tok; };
}
enum { I_X = 0, I_C, I_CTX, I_CCTX, I_MODW, I_MODB, I_NMIXG, I_NFFNG, I_WIN, I_WOUT, I_LCW, I_LCB, I_LWA, I_LBA, I_LWX, I_LBX, I_LLAM,
       I_RMU, I_RWUP, I_RW0, I_RAUP, I_RA0, I_RGUP, I_RKK, I_RKA, I_RRK, I_RLNG, I_RLNB, I_MIB, I_MFB, I_MNG, I_GCW, I_GALOG, I_GDTB, I_GNG,
       I_FWG, I_FWU, I_FWD, I_MROUTER, I_MWG, I_MWU, I_MWD, I_FNG, N_IN };
struct Args { const float* in[N_IN]; float* out; unsigned char* ws; int ph_lo, ph_hi; };
struct Ctx {
    const float* const* in; float* out; unsigned char* ws; LAS unsigned char* lds;
    int tid, lane, wave, G, wg;
};
#define WSP(T, off) ((T*)(C.ws + (off)))

__device__ __forceinline__ int seqrow_raster(int i, int d, int b) {
    if (i < CTXL) { const int p = d ? (CTXL - 1 - i) : i; return T_LAT + b * CTXL + p; }
    const int j = i - CTXL; const int p = d ? (SEQ - 1 - j) : j; return b * SEQ + p;
}
__device__ __forceinline__ int seqrow_cm(int i, int d, int b) {
    if (i < CTXL) { const int p = d ? (CTXL - 1 - i) : i; return T_LAT + b * CTXL + p; }
    const int j = i - CTXL; const int p = d ? (SEQ - 1 - j) : j; return b * SEQ + (p & 63) * 64 + (p >> 6);
}

__device__ __forceinline__ void phase_pre(const Ctx& C) {
    LAS float* sc = (LAS float*)C.lds;
    LAS float* red = sc + 9 * 1024;
    float* modv = WSP(float, WS_MODV);
    bool filled = false;
    for (int it = C.wg; it < DEPTH * 48; it += C.G) {
        if (!filled) {
            for (int i = C.tid; i < 9 * 1024; i += NTHR) { const float v = i < 8192 ? C.in[I_C][i] : C.in[I_CCTX][i - 8192]; sc[i] = siluf_(v); }
            filled = true; __syncthreads();
        }
        const int l = it / 48, jb = it % 48, col = C.tid & 127, kg = C.tid >> 7;
        const float* W = C.in[I_MODW] + (size_t)l * 1024 * 6144 + jb * 128 + col;
        float acc[9];
#pragma unroll
        for (int r = 0; r < 9; ++r) acc[r] = 0.f;
        for (int k = kg * 256; k < kg * 256 + 256; ++k) { const float w = W[(size_t)k * 6144];
#pragma unroll
            for (int r = 0; r < 9; ++r) acc[r] += sc[r * 1024 + k] * w; }
#pragma unroll
        for (int r = 0; r < 9; ++r) red[(kg * 9 + r) * 128 + col] = acc[r];
        __syncthreads();
        for (int i = C.tid; i < 9 * 128; i += NTHR) { const int r = i >> 7, cc = i & 127;
            const float s = red[(0 * 9 + r) * 128 + cc] + red[(1 * 9 + r) * 128 + cc] + red[(2 * 9 + r) * 128 + cc] + red[(3 * 9 + r) * 128 + cc];
            modv[((size_t)l * 9 + r) * 6144 + jb * 128 + cc] = s + C.in[I_MODB][l * 6144 + jb * 128 + cc]; }
        __syncthreads();
    }
}

__device__ __forceinline__ void tr_item(const float* src, size_t ld, int k0, int ns0, bf16* dst, int drow0, int Kd, LAS float* scr, int lane, bool zero) {
    if (!zero) {
#pragma unroll 8
        for (int i = 0; i < 32; ++i) { const int kk = 2 * i + (lane >> 5); scr[kk * 33 + (lane & 31)] = src[(size_t)(k0 + kk) * ld + ns0 + (lane & 31)]; }
    }
    LDS_WAIT(); asm volatile("" ::: "memory");
    const int c = lane & 7;
#pragma unroll
    for (int j = 0; j < 4; ++j) { const int n = (lane >> 3) + 8 * j; const LAS float* s = scr + (8 * c) * 33 + n;
        v4u o; o.x = pk2(s[0 * 33], s[1 * 33]); o.y = pk2(s[2 * 33], s[3 * 33]); o.z = pk2(s[4 * 33], s[5 * 33]); o.w = pk2(s[6 * 33], s[7 * 33]);
        if (zero) o = (v4u){0u, 0u, 0u, 0u};
        *(v4u*)(dst + (size_t)(drow0 + n) * Kd + k0 + 8 * c) = o; }
    LDS_WAIT(); asm volatile("" ::: "memory");
}
__device__ __forceinline__ void convert_small(const Ctx& C, int l) {
    {
        bf16* lw = WSP(bf16, WS_LRUWT);
        for (int k = 0; k < 2 * 2 * 4 * 4096 / (128 * NTHR); ++k) {
            const int e = k * 128 * NTHR + C.wg * NTHR + C.tid;
            if (C.wg < 128) {
            const int i = e & 63, j = (e >> 6) & 63, hd = (e >> 12) & 3, g = (e >> 14) & 1, d = e >> 15;
            const float* src = (g ? C.in[I_LWX] : C.in[I_LWA]) + ((size_t)((l * 2 + d) * 4 + hd) * 64 + i) * 64 + j;
            lw[e] = (bf16)f2bf(*src);
            }
        }
    }
    if (C.wg >= 128 && C.wg < 224) {
        bf16* rw = WSP(bf16, WS_RWT);
        const int e = (C.wg - 128) * NTHR + C.tid;
        if (e < 32768) { const int r = e & 31, ch = (e >> 5) & 255, d = (e >> 13) & 1, isa = e >> 14;
            rw[e] = (bf16)f2bf((isa ? C.in[I_RAUP] : C.in[I_RWUP])[((size_t)(l * 2 + d) * 32 + r) * GW + ch]); }
        else { const int e2 = e - 32768, j = e2 & 63, ch = e2 >> 6; rw[e] = (bf16)f2bf(C.in[I_RGUP][((size_t)l * 64 + j) * GW + ch]); }
    }
}
__device__ __forceinline__ void convert_items(const Ctx& C, int l, int what, int gw, int NGW) {
    LAS float* scr = (LAS float*)(C.lds + C.wave * 8704);
    constexpr int I_IN = 16 * 112, I_OUT = 16 * 32, I_GU = 16 * 176, I_DN = 44 * 32, I_E = 16 * 88 + 22 * 32;
    const bool moe = l & 1; const int li = l >> 1;
    const int lo_it = (what & 1) ? 0 : I_IN, hi_it = (what & 2) ? I_IN + I_OUT + (moe ? NE * I_E : (I_GU + I_DN)) : I_IN;
    bf16* win = WSP(bf16, WS_WIN); bf16* wout = WSP(bf16, WS_WOUT); bf16* wgu = WSP(bf16, WS_WGU); bf16* wdn = WSP(bf16, WS_WDN);
    for (int it = lo_it + gw; it < hi_it; it += NGW) {
        int r = it;
        if (r < I_IN) { const int kb = r / 112, nb = r % 112; tr_item(C.in[I_WIN] + (size_t)l * 1024 * IN_COLS, IN_COLS, 64 * kb, 32 * nb, win, 32 * nb, 1024, scr, C.lane, nb == 111); continue; }
        r -= I_IN;
        if (r < I_OUT) { const int kb = r / 32, nb = r % 32; tr_item(C.in[I_WOUT] + (size_t)l * 1024 * 1024, 1024, 64 * kb, 32 * nb, wout, 32 * nb, 1024, scr, C.lane, false); continue; }
        r -= I_OUT;
        if (!moe) {
            if (r < I_GU) { const int kb = r / 176, nb = r % 176, tile = nb >> 3, q = nb & 7;
                const float* src = (q < 4 ? C.in[I_FWG] : C.in[I_FWU]) + (size_t)li * 1024 * DFF;
                tr_item(src, DFF, 64 * kb, tile * 128 + (q & 3) * 32, wgu, 32 * nb, 1024, scr, C.lane, false); continue; }
            r -= I_GU;
            { const int kb = r / 32, nb = r % 32; tr_item(C.in[I_FWD] + (size_t)li * DFF * 1024, 1024, 64 * kb, 32 * nb, wdn, 32 * nb, DFF, scr, C.lane, false); }
        } else {
            const int e = r / I_E; int rr = r % I_E;
            if (rr < 16 * 88) { const int kb = rr / 88, nb = rr % 88, tile = nb >> 3, q = nb & 7;
                const float* src = (q < 4 ? C.in[I_MWG] : C.in[I_MWU]) + ((size_t)li * NE + e) * 1024 * DFE;
                tr_item(src, DFE, 64 * kb, tile * 128 + (q & 3) * 32, wgu + (size_t)e * 2 * DFE * 1024, 32 * nb, 1024, scr, C.lane, false); continue; }
            rr -= 16 * 88;
            { const int kb = rr / 32, nb = rr % 32; tr_item(C.in[I_MWD] + ((size_t)li * NE + e) * DFE * 1024, 1024, 64 * kb, 32 * nb, wdn + (size_t)e * 1024 * DFE, 32 * nb, DFE, scr, C.lane, false); }
        }
    }
}

template <bool ROUTE>
__device__ __forceinline__ void norm_rows(const Ctx& C, int l, const float* xlat, const float* xctx, const float* gain, int shoff, int scoff, int nrows, int moe_li) {
    const float* modv = WSP(float, WS_MODV) + (size_t)l * 9 * 6144;
    bf16* hb = WSP(bf16, WS_HB);
    const int gw = C.wg * NWAVES + C.wave, NGW = C.G * NWAVES;
    LAS unsigned* lcnt = (LAS unsigned*)(C.lds + 65536);
    unsigned* route = WSP(unsigned, WS_ROUTE);
    if (ROUTE) { if (C.tid < 8) lcnt[C.tid] = 0u; __syncthreads(); }
    f32x4 gv[4];
#pragma unroll
    for (int j = 0; j < 4; ++j) gv[j] = *(const f32x4*)(gain + 4 * C.lane + 256 * j);
    for (int m = gw; m < nrows; m += NGW) {
        const bool isctx = m >= T_LAT;
        const float* xr = isctx ? xctx + (size_t)(m - T_LAT) * 1024 : xlat + (size_t)m * 1024;
        const float* mv = modv + (size_t)(isctx ? 8 : (m >> 12)) * 6144;
        f32x4 v[4]; float s = 0.f;
#pragma unroll
        for (int j = 0; j < 4; ++j) { v[j] = *(const f32x4*)(xr + 4 * C.lane + 256 * j); s += (v[j].x * v[j].x + v[j].y * v[j].y) + (v[j].z * v[j].z + v[j].w * v[j].w); }
        const float rs = rsqrtf_(wave_sum(s) * (1.0f / 1024.0f) + 1e-6f);
#pragma unroll
        for (int j = 0; j < 4; ++j) { const f32x4 sh = *(const f32x4*)(mv + shoff + 4 * C.lane + 256 * j), scl = *(const f32x4*)(mv + scoff + 4 * C.lane + 256 * j);
            v[j] = (v[j] * rs * gv[j]) * (scl + 1.0f) + sh;
            v2u o; o.x = pk2(v[j].x, v[j].y); o.y = pk2(v[j].z, v[j].w);
            *(v2u*)(hb + (size_t)m * 1024 + 4 * C.lane + 256 * j) = o; }
        if (ROUTE) {
            const float* rt = C.in[I_MROUTER] + (size_t)moe_li * 1024 * NE;
            float lg[8];
#pragma unroll
            for (int e = 0; e < 8; ++e) lg[e] = 0.f;
#pragma unroll
            for (int j = 0; j < 4; ++j)
#pragma unroll
                for (int q = 0; q < 4; ++q) { const int k = 4 * C.lane + 256 * j + q; const f32x4 r0 = *(const f32x4*)(rt + (size_t)k * 8), r1 = *(const f32x4*)(rt + (size_t)k * 8 + 4); const float hv = v[j][q];
                    lg[0] += hv * r0.x; lg[1] += hv * r0.y; lg[2] += hv * r0.z; lg[3] += hv * r0.w; lg[4] += hv * r1.x; lg[5] += hv * r1.y; lg[6] += hv * r1.z; lg[7] += hv * r1.w; }
#pragma unroll
            for (int e = 0; e < 8; ++e) lg[e] = wave_sum(lg[e]);
            int e0 = 0; float l0 = lg[0];
#pragma unroll
            for (int e = 1; e < 8; ++e) if (lg[e] > l0) { l0 = lg[e]; e0 = e; }
            int e1 = (e0 == 0) ? 1 : 0; float l1 = -3.0e38f;
#pragma unroll
            for (int e = 0; e < 8; ++e) if (e != e0 && lg[e] > l1) { l1 = lg[e]; e1 = e; }
            const float w0 = __builtin_amdgcn_rcpf(1.0f + __expf(l1 - l0)), w1 = 1.0f - w0;
            if (C.lane == 0) {
                const unsigned r0 = atomicAdd((unsigned*)&lcnt[e0], 1u), r1 = atomicAdd((unsigned*)&lcnt[e1], 1u);
                v4u a; a.x = (unsigned)e0; a.y = (unsigned)e1; a.z = r0; a.w = r1;
                *(v4u*)(route + (size_t)m * 8) = a;
                v2u b; b.x = __builtin_bit_cast(unsigned, w0); b.y = __builtin_bit_cast(unsigned, w1);
                *(v2u*)(route + (size_t)m * 8 + 4) = b;
            }
        }
    }
    if (ROUTE) {
        __syncthreads();
        if (C.tid < 8) { unsigned* gc = WSP(unsigned, WS_CTL) + CW_MOECNT + 64 * moe_li; const unsigned base = atomicAdd(gc + C.tid, lcnt[C.tid]); WSP(unsigned, WS_WGBASE)[C.wg * 8 + C.tid] = base; }
    }
}
#define RAW_BARRIER() do { asm volatile("s_waitcnt lgkmcnt(0)" ::: "memory"); __builtin_amdgcn_s_barrier(); asm volatile("" ::: "memory"); } while (0)
__device__ __forceinline__ void gdn_prep(const Ctx& C, int l, int b, int c) {
    const bf16* P = WSP(const bf16, WS_P); bf16* gq = WSP(bf16, WS_GQ);
    const bool isctx = c < 4; const int p0 = isctx ? c * 64 : (c - 4) * 64; const int Lp = isctx ? CTXL : SEQ;
    const int ch = 4 * C.lane;
    auto rowof = [&](int p) -> int { return isctx ? (T_LAT + b * CTXL + p) : (b * SEQ + (p & 63) * 64 + (p >> 6)); };
    f32x4 cw[4][3], x[4][3];
#pragma unroll
    for (int j = 0; j < 4; ++j)
#pragma unroll
        for (int g = 0; g < 3; ++g) cw[j][g] = *(const f32x4*)(C.in[I_GCW] + ((size_t)l * 4 + j) * 768 + g * 256 + ch);
    const int tb = p0 + C.wave * 8;
    auto ldrow = [&](int p, f32x4 (&dst)[3]) {
        if (p >= 0 && p < Lp) { const bf16* pr = P + (size_t)rowof(p) * PLD + OFF_D + ch;
#pragma unroll
            for (int g = 0; g < 3; ++g) dst[g] = ld4bf(pr + g * 256); }
        else {
#pragma unroll
            for (int g = 0; g < 3; ++g) dst[g] = (f32x4){0.f, 0.f, 0.f, 0.f}; }
    };
    ldrow(tb - 2, x[0]); ldrow(tb - 1, x[1]); ldrow(tb, x[2]);
#pragma unroll
    for (int t = 0; t < 8; ++t) {
        ldrow(tb + t + 1, x[3]);
        bf16* orow = gq + (size_t)rowof(tb + t) * 768 + ch;
#pragma unroll
        for (int g = 0; g < 3; ++g) {
            f32x4 v = cw[0][g] * x[0][g] + cw[1][g] * x[1][g] + cw[2][g] * x[2][g] + cw[3][g] * x[3][g];
            v = (f32x4){siluf_(v.x), siluf_(v.y), siluf_(v.z), siluf_(v.w)};
            if (g < 2) { const float ss = row16_sum((v.x * v.x + v.y * v.y) + (v.z * v.z + v.w * v.w)); v = v * (rsqrtf_(ss + 1e-6f) * (g == 0 ? 0.125f : 1.0f)); }
            st4bf(orow + g * 256, v);
        }
#pragma unroll
        for (int g = 0; g < 3; ++g) { x[0][g] = x[1][g]; x[1][g] = x[2][g]; x[2][g] = x[3][g]; }
    }
}
__device__ __forceinline__ void finish_rows(const Ctx& C, int l, int nrows) {
    const bf16* P = WSP(const bf16, WS_P); bf16* yc = WSP(bf16, WS_HB);
    const bf16* ob = WSP(const bf16, WS_OUTB); const bf16* oc = WSP(const bf16, WS_OUTC); const bf16* od = WSP(const bf16, WS_OUTD);
    const bf16* gg = WSP(const bf16, WS_G); const float* bonus = WSP(const float, WS_BONUS);
    const float* mu = C.in[I_RMU] + (size_t)l * 2 * B_COLS;
    const int gw = C.wg * NWAVES + C.wave, NGW = C.G * NWAVES, lane = C.lane, ch = 4 * lane, hh = lane >> 4;
    const f32x4 lng = *(const f32x4*)(C.in[I_RLNG] + l * GW + ch), lnb = *(const f32x4*)(C.in[I_RLNB] + l * GW + ch);
    const f32x4 mng = *(const f32x4*)(C.in[I_MNG] + l * GW + ch), gng = *(const f32x4*)(C.in[I_GNG] + l * GW + ch);
    const f32x4 mu0 = *(const f32x4*)(mu + 512 + ch), mu1 = *(const f32x4*)(mu + B_COLS + 512 + ch);
    const size_t o2 = (size_t)T_ALL * 256;
#pragma unroll 2
    for (int m = gw; m < nrows; m += NGW) {
        const bool isctx = m >= T_LAT; const int Lp = isctx ? CTXL : SEQ; const int p = isctx ? ((m - T_LAT) & (CTXL - 1)) : (m & (SEQ - 1));
        const f32x4 yb = ld4bf(ob + (size_t)m * 256 + ch) + ld4bf(ob + o2 + (size_t)m * 256 + ch);
        const f32x4 ycv = ld4bf(oc + (size_t)m * 256 + ch) + ld4bf(oc + o2 + (size_t)m * 256 + ch);
        const f32x4 yd = ld4bf(od + (size_t)m * 256 + ch) + ld4bf(od + o2 + (size_t)m * 256 + ch);
        const bf16* pr = P + (size_t)m * PLD;
        const f32x4 vs = ld4bf(WSP(const bf16, WS_RKV) + (size_t)m * 768 + 512 + ch);
        const f32x4 og = ld4bf(pr + OFF_C + 768 + ch), gd = ld4bf(pr + OFF_D + 768 + ch), gr = ld4bf(gg + (size_t)m * 256 + ch);
        const float bn = bonus[(size_t)m * 4 + hh];
        *(v2u*)(yc + (size_t)m * 1024 + ch) = *(const v2u*)(pr + 256 + ch);
        {
            const float mean = row16_sum((yb.x + yb.y) + (yb.z + yb.w)) * (1.0f / 64.0f);
            const f32x4 dl = yb - mean;
            const float var = row16_sum((dl.x * dl.x + dl.y * dl.y) + (dl.z * dl.z + dl.w * dl.w)) * (1.0f / 64.0f);
            const f32x4 yn = dl * rsqrtf_(var + 64e-5f) * lng + lnb;
            st4bf(yc + (size_t)m * 1024 + 256 + ch, (yn + vs * bn) * gr);
        }
        {
            const float ms = row16_sum((ycv.x * ycv.x + ycv.y * ycv.y) + (ycv.z * ycv.z + ycv.w * ycv.w)) * (1.0f / 64.0f);
            const f32x4 sg = (f32x4){sigmoidf_(og.x), sigmoidf_(og.y), sigmoidf_(og.z), sigmoidf_(og.w)};
            st4bf(yc + (size_t)m * 1024 + 512 + ch, ycv * rsqrtf_(ms + 1e-6f) * mng * sg);
        }
        {
            const float ms = row16_sum((yd.x * yd.x + yd.y * yd.y) + (yd.z * yd.z + yd.w * yd.w)) * (1.0f / 64.0f);
            const f32x4 sg = (f32x4){siluf_(gd.x), siluf_(gd.y), siluf_(gd.z), siluf_(gd.w)};
            st4bf(yc + (size_t)m * 1024 + 768 + ch, yd * rsqrtf_(ms + 1e-6f) * gng * sg);
        }
    }
}
typedef bf16x8 fragb;
__device__ __forceinline__ f32x4 mfma16(fragb a, fragb b, f32x4 c) { return __builtin_amdgcn_mfma_f32_16x16x32_bf16(a, b, c, 0, 0, 0); }
__device__ __forceinline__ fragb ld_frag16(const LAS bf16* p) { return *(const LAS fragb*)p; }
__device__ __forceinline__ fragb ld_frag8x2(const LAS bf16* p0, const LAS bf16* p1) {
    const v2u a = *(const LAS v2u*)p0, b = *(const LAS v2u*)p1; v4u r; r.x = a.x; r.y = a.y; r.z = b.x; r.w = b.y; return __builtin_bit_cast(fragb, r); }
__device__ __forceinline__ fragb pack_frag(const f32x4& lo, const f32x4& hi) { v4u r; r.x = pk2(lo.x, lo.y); r.y = pk2(lo.z, lo.w); r.z = pk2(hi.x, hi.y); r.w = pk2(hi.z, hi.w); return __builtin_bit_cast(fragb, r); }
__device__ __forceinline__ float wave_incl_sum(float v, int lane) {
    v += dpp_x<0x111, 0xF, true>(0.f, v); v += dpp_x<0x112, 0xF, true>(0.f, v); v += dpp_x<0x114, 0xF, true>(0.f, v); v += dpp_x<0x118, 0xF, true>(0.f, v);
    v += dpp_x<0x142, 0xA, false>(0.f, v); v += dpp_x<0x143, 0xC, false>(0.f, v);
    return v;
}
__device__ __forceinline__ float wave_incl_max(float v, int lane) {
    const float ninf = -3.0e38f;
    v = fmaxf(v, dpp_x<0x111, 0xF, false>(ninf, v)); v = fmaxf(v, dpp_x<0x112, 0xF, false>(ninf, v)); v = fmaxf(v, dpp_x<0x114, 0xF, false>(ninf, v)); v = fmaxf(v, dpp_x<0x118, 0xF, false>(ninf, v));
    v = fmaxf(v, dpp_x<0x142, 0xA, false>(ninf, v)); v = fmaxf(v, dpp_x<0x143, 0xC, false>(ninf, v));
    return v;
}
constexpr int MP = 72;
__device__ __forceinline__ void mlstm_chunked(const Ctx& C, int l, int idx) {
    const int d = idx >> 5, b = (idx >> 2) & 7, h = idx & 3, lane = C.lane, w = C.wave, l15 = lane & 15, q = lane >> 4;
    const int it = w & 3, vtp = w >> 2;
    constexpr int IMG = 64 * MP * 2, BUFB = 4 * IMG + 1024, CTB = 65 * MP * 2 + 16;
    LAS unsigned char* L0 = C.lds;
    const bf16* P = WSP(const bf16, WS_P); bf16* outc = WSP(bf16, WS_OUTC) + (size_t)d * T_ALL * 256;
    const float ib = C.in[I_MIB][(l * 2 + d) * NH + h], fb = C.in[I_MFB][(l * 2 + d) * NH + h];
    const int tt = C.tid >> 3, part = C.tid & 7;
    for (int i = C.tid; i < 2 * CTB / 4; i += NTHR) ((LAS unsigned*)(L0 + 2 * BUFB))[i] = 0u;
    v4u rq, rk, rv; unsigned short rgi, rgf;
    auto gload = [&](int n) {
        const int row = seqrow_cm(n * 64 + tt, d, b);
        const bf16* pp = P + (size_t)row * PLD + OFF_C + h * 64 + 8 * part;
        rq = *(const v4u*)pp; rk = *(const v4u*)(pp + 256); rv = *(const v4u*)(pp + 512);
        const bf16* pg = P + (size_t)seqrow_cm(n * 64 + lane, d, b) * PLD + OFF_C + 1024 + d * 4 + h;
        rgi = pg[0]; rgf = pg[8];
    };
    auto images = [&](int bufi) {
        LAS unsigned char* B0 = L0 + bufi * BUFB;
        LAS bf16* Qs = (LAS bf16*)B0; LAS bf16* Ks = Qs + 64 * MP; LAS bf16* VT = Ks + 64 * MP; LAS bf16* KTw = VT + 64 * MP; LAS float* vec = (LAS float*)(B0 + 4 * IMG);
        const float li = bf2f(rgi) + ib, lf = -softplusf_(-(bf2f(rgf) + fb));
        const float bc = wave_incl_sum(lf, lane), x = li - bc, cm = wave_incl_max(x, lane);
        const float wl = __expf(x - __shfl(cm, 63)) * 0.125f;
        if (w == 0) { vec[lane] = x; vec[64 + lane] = cm; vec[128 + lane] = bc; }
        const float wmine = __shfl(wl, 8 * w + (lane >> 3));
        *(LAS v4u*)(Qs + tt * MP + 8 * part) = rq; *(LAS v4u*)(Ks + tt * MP + 8 * part) = rk;
        const unsigned vv[4] = {rv.x, rv.y, rv.z, rv.w}, kk[4] = {rk.x, rk.y, rk.z, rk.w};
#pragma unroll
        for (int e = 0; e < 4; ++e) {
            VT[(8 * part + 2 * e) * MP + tt] = (bf16)(vv[e] & 0xffffu); VT[(8 * part + 2 * e + 1) * MP + tt] = (bf16)(vv[e] >> 16);
            KTw[(8 * part + 2 * e) * MP + tt] = (bf16)f2bf1(bflo(kk[e]) * wmine); KTw[(8 * part + 2 * e + 1) * MP + tt] = (bf16)f2bf1(bfhi(kk[e]) * wmine);
        }
    };
    f32x4 Cst[2], nst; float m = 0.f;
    Cst[0] = Cst[1] = nst = (f32x4){0.f, 0.f, 0.f, 0.f};
    const fragb ones = __builtin_bit_cast(fragb, (v4u){0x3F803F80u, 0x3F803F80u, 0x3F803F80u, 0x3F803F80u});
    const f32x4 z4 = (f32x4){0.f, 0.f, 0.f, 0.f};
    gload(0); images(0); gload(1);
#pragma unroll 1
    for (int n = 0; n < NCH; ++n) {
        RAW_BARRIER();
        const LAS unsigned char* B0 = L0 + (n & 1) * BUFB;
        const LAS bf16* Qs = (const LAS bf16*)B0; const LAS bf16* Ks = Qs + 64 * MP; const LAS bf16* VT = Ks + 64 * MP; const LAS bf16* KTw = VT + 64 * MP; const LAS float* vec = (const LAS float*)(B0 + 4 * IMG);
        const LAS bf16* CT = (const LAS bf16*)(L0 + 2 * BUFB + (n & 1) * CTB); LAS bf16* CTn = (LAS bf16*)(L0 + 2 * BUFB + ((n + 1) & 1) * CTB);
        fragb Qf[2]; Qf[0] = ld_frag16(Qs + (16 * it + l15) * MP + 8 * q); Qf[1] = ld_frag16(Qs + (16 * it + l15) * MP + 32 + 8 * q);
        const float cmi = vec[64 + 16 * it + l15]; const int icol = 16 * it + l15;
        f32x4 pt[4];
#pragma unroll
        for (int jt = 0; jt < 4; ++jt) {
            pt[jt] = z4;
            if (jt <= it) {
                const fragb k0 = ld_frag16(Ks + (16 * jt + l15) * MP + 8 * q), k1 = ld_frag16(Ks + (16 * jt + l15) * MP + 32 + 8 * q);
                f32x4 st = mfma16(k0, Qf[0], z4); st = mfma16(k1, Qf[1], st);
                const f32x4 xj = *(const LAS f32x4*)(vec + 16 * jt + 4 * q);
#pragma unroll
                for (int r = 0; r < 4; ++r) { const int j = 16 * jt + 4 * q + r; pt[jt][r] = (j <= icol) ? st[r] * __expf(xj[r] - cmi) * 0.125f : 0.f; }
            }
        }
        fragb Pf[2]; Pf[0] = pack_frag(pt[0], pt[1]); Pf[1] = pack_frag(pt[2], pt[3]);
        fragb Vf[2][2];
#pragma unroll
        for (int v2 = 0; v2 < 2; ++v2)
#pragma unroll
            for (int s = 0; s < 2; ++s) { const LAS bf16* vr = VT + (16 * (2 * vtp + v2) + l15) * MP + 32 * s + 4 * q; Vf[v2][s] = ld_frag8x2(vr, vr + 16); }
        f32x4 Aacc[2], R[2], as, dn;
        as = mfma16(Pf[0], ones, z4); if (it >= 2) as = mfma16(Pf[1], ones, as);
        const fragb nf0 = ld_frag16(CT + 64 * MP + 8 * q), nf1 = ld_frag16(CT + 64 * MP + 32 + 8 * q);
        dn = mfma16(Qf[0], nf0, z4); dn = mfma16(Qf[1], nf1, dn);
#pragma unroll
        for (int v2 = 0; v2 < 2; ++v2) {
            Aacc[v2] = mfma16(Pf[0], Vf[v2][0], z4); if (it >= 2) Aacc[v2] = mfma16(Pf[1], Vf[v2][1], Aacc[v2]);
            const LAS bf16* cr = CT + (16 * (2 * vtp + v2) + l15) * MP + 8 * q;
            R[v2] = mfma16(Qf[0], ld_frag16(cr), z4); R[v2] = mfma16(Qf[1], ld_frag16(cr + 32), R[v2]);
        }
        {
            const f32x4 bi = *(const LAS f32x4*)(vec + 128 + 16 * it + 4 * q), cmr = *(const LAS f32x4*)(vec + 64 + 16 * it + 4 * q);
#pragma unroll
            for (int r = 0; r < 4; ++r) {
                const float mi = bi[r] + cmr[r], minter = bi[r] + m, mt = fmaxf(minter, mi), e1 = __expf(mi - mt), e2 = __expf(minter - mt);
                const float den = e1 * as[r] + e2 * dn[r]; const float inv = __builtin_amdgcn_rcpf(fmaxf(fabsf(den), __expf(-mt)));
                const int row = seqrow_cm(n * 64 + 16 * it + 4 * q + r, d, b);
#pragma unroll
                for (int v2 = 0; v2 < 2; ++v2) outc[(size_t)row * 256 + h * 64 + 16 * (2 * vtp + v2) + l15] = (bf16)f2bf1((e1 * Aacc[v2][r] + e2 * R[v2][r]) * inv);
            }
        }
        {
            const LAS bf16* kr = KTw + (16 * it + l15) * MP + 4 * q;
            const fragb kt0 = ld_frag8x2(kr, kr + 16), kt1 = ld_frag8x2(kr + 32, kr + 48);
            const float bL = vec[128 + 63], mloc = bL + vec[64 + 63];
            const float mnew = fmaxf(bL + m, mloc), wp = __expf(bL + m - mnew), wn = __expf(mloc - mnew);
            f32x4 gk = mfma16(kt0, ones, z4); gk = mfma16(kt1, ones, gk);
            nst = nst * wp + gk * wn;
#pragma unroll
            for (int v2 = 0; v2 < 2; ++v2) {
                f32x4 G = mfma16(kt0, Vf[v2][0], z4); G = mfma16(kt1, Vf[v2][1], G);
                Cst[v2] = Cst[v2] * wp + G * wn;
                v2u o; o.x = pk2(Cst[v2].x, Cst[v2].y); o.y = pk2(Cst[v2].z, Cst[v2].w);
                *(LAS v2u*)(CTn + (16 * (2 * vtp + v2) + l15) * MP + 16 * it + 4 * q) = o;
            }
            if (vtp == 0 && l15 == 0) { v2u o; o.x = pk2(nst.x, nst.y); o.y = pk2(nst.z, nst.w); *(LAS v2u*)(CTn + 64 * MP + 16 * it + 4 * q) = o; }
            m = mnew;
        }
        if (n + 1 < NCH) { images((n + 1) & 1); if (n + 2 < NCH) gload(n + 2); }
    }
    __syncthreads();
}
__device__ __forceinline__ int fwd_row_cm(int b, int c, int t) { return c < 4 ? (T_LAT + b * CTXL + c * 64 + t) : (b * SEQ + t * 64 + (c - 4)); }
__device__ __forceinline__ bf16* blob_row(const Ctx& C, int d, int isw, int b, int c, int h, int r) {
    const int row = fwd_row_cm(b, c, r);
    if (d == 1 && isw) return WSP(bf16, WS_OUTD) + ((size_t)T_ALL + row) * 256 + h * 64;
    return WSP(bf16, WS_P) + (size_t)row * PLD + OFF_D + (d * 2 + isw) * 256 + h * 64;
}
constexpr int LP = 68;
__device__ __forceinline__ void blocked_solve(const LAS bf16* Ln, const LAS bf16* TinvP, LAS unsigned char* XTw, f32x4 (&acc)[4][4], int l15, int q) {
    const f32x4 z4 = (f32x4){0.f, 0.f, 0.f, 0.f};
#pragma unroll
    for (int I = 0; I < 4; ++I) {
        const fragb Af = *(const LAS fragb*)(TinvP + (I * 16 + l15) * 32 + 8 * q);
        fragb A0, A1;
        if (I >= 1) A0 = ld_frag16(Ln + (16 * I + l15) * MP + 8 * q);
        if (I == 3) A1 = ld_frag16(Ln + (16 * I + l15) * MP + 32 + 8 * q);
#pragma unroll
        for (int nt = 0; nt < 4; ++nt) {
            const int crow = 16 * nt + l15; LAS unsigned char* xr = XTw + crow * 128;
            f32x4 a = acc[I][nt];
            if (I >= 1) a = mfma16(A0, *(const LAS fragb*)(xr + ((q ^ (crow & 7)) << 4)), a);
            if (I == 3) a = mfma16(A1, *(const LAS fragb*)(xr + (((4 + q) ^ (crow & 7)) << 4)), a);
            v4u bw; bw.x = pk2(a.x, a.y); bw.y = pk2(a.z, a.w); bw.z = 0u; bw.w = 0u;
            const f32x4 x = mfma16(Af, __builtin_bit_cast(fragb, bw), z4);
            acc[I][nt] = x;
            v2u o; o.x = pk2(x.x, x.y); o.y = pk2(x.z, x.w);
            *(LAS v2u*)(xr + (((2 * I + (q >> 1)) ^ (crow & 7)) << 4) + (q & 1) * 8) = o;
        }
    }
}
__device__ __forceinline__ void diag_inverses(const LAS bf16* Ln, LAS bf16* TinvP, int lane) {
    const int blk = lane >> 4, c = lane & 15;
    float x[16];
#pragma unroll
    for (int i = 0; i < 16; ++i) {
        const LAS bf16* lr = Ln + (16 * blk + i) * MP + 16 * blk;
        const v4u r0 = *(const LAS v4u*)lr, r1 = *(const LAS v4u*)(lr + 8);
        const unsigned rw[8] = {r0.x, r0.y, r0.z, r0.w, r1.x, r1.y, r1.z, r1.w};
        float s = (i == c) ? 1.0f : 0.0f;
#pragma unroll
        for (int j = 0; j < i; ++j) s += ((j & 1) ? bfhi(rw[j >> 1]) : bflo(rw[j >> 1])) * x[j];
        x[i] = s;
        TinvP[(blk * 16 + i) * 32 + 8 * (c >> 2) + (c & 3)] = (bf16)f2bf1(s);
    }
}
__device__ __forceinline__ void gdn_solve_item(const Ctx& C, int l, int item) {
    const int lane = C.lane, w = C.wave, pw = w & 1, pi = w >> 1, l15 = lane & 15, q = lane >> 4;
    LAS unsigned char* B0 = C.lds + pi * 31744;
    LAS bf16* Ln = (LAS bf16*)B0;
    LAS bf16* TinvP = (LAS bf16*)(B0 + 9216);
    LAS float* vec = (LAS float*)(B0 + 13312);
    LAS unsigned char* XT = B0 + 13824;
    LAS bf16* Ks = (LAS bf16*)XT;
    const bf16* P = WSP(const bf16, WS_P); const bf16* gq = WSP(const bf16, WS_GQ);
    const int u = item >> 1, d = item & 1;
    const int c = u % NCH, h = (u / NCH) & 3, b = u / (NCH * NH);
    const int n = d ? (c < 4 ? 3 - c : 71 - c) : c;
    const float aexp = __expf(C.in[I_GALOG][(l * 2 + d) * NH + h]), dtb = C.in[I_GDTB][(l * 2 + d) * NH + h];
    const int rowl = seqrow_cm(n * 64 + lane, d, b);
    const bf16* pg = P + (size_t)rowl * PLD + OFF_D + 1024 + d * 4 + h;
    const float la = -aexp * softplusf_(bf2f(pg[0]) + dtb), beta = sigmoidf_(bf2f(pg[8]));
    const float gam = wave_incl_sum(la, lane);
    if (pw == 0) { vec[lane] = beta; vec[64 + lane] = gam; }
#pragma unroll
    for (int r = 0; r < 4; ++r) { const int idx = pw * 64 + lane + 128 * r, t = idx >> 3, part = idx & 7;
        *(LAS v4u*)(Ks + t * MP + 8 * part) = *(const v4u*)(gq + (size_t)seqrow_cm(n * 64 + t, d, b) * 768 + 256 + h * 64 + 8 * part); }
    { LAS v4u* tz = (LAS v4u*)(B0 + 9216) + (pw * 64 + lane) * 2; tz[0] = (v4u){0u, 0u, 0u, 0u}; tz[1] = (v4u){0u, 0u, 0u, 0u}; }
    f32x4 acc[4][4];
    if (pw == 0) {
#pragma unroll
        for (int I = 0; I < 4; ++I)
#pragma unroll
            for (int r = 0; r < 4; ++r) { const bf16* vr = gq + (size_t)seqrow_cm(n * 64 + 16 * I + 4 * q + r, d, b) * 768 + 512 + h * 64 + l15;
#pragma unroll
                for (int nt = 0; nt < 4; ++nt) acc[I][nt][r] = bf2f(vr[16 * nt]); }
    }
    __syncthreads();
    {
        int tix = 0;
#pragma unroll
        for (int it = 0; it < 4; ++it)
#pragma unroll
            for (int jt = 0; jt < 4; ++jt, ++tix) if ((tix & 1) == pw) {
                f32x4 t4 = (f32x4){0.f, 0.f, 0.f, 0.f};
                if (jt <= it) {
#pragma unroll
                    for (int s = 0; s < 2; ++s) t4 = mfma16(ld_frag16(Ks + (16 * it + l15) * MP + 32 * s + 8 * q), ld_frag16(Ks + (16 * jt + l15) * MP + 32 * s + 8 * q), t4);
                    const float gj = vec[64 + 16 * jt + l15];
                    const f32x4 bi = *(const LAS f32x4*)(vec + 16 * it + 4 * q), gi = *(const LAS f32x4*)(vec + 64 + 16 * it + 4 * q);
#pragma unroll
                    for (int r = 0; r < 4; ++r) { const int i = 16 * it + 4 * q + r, j = 16 * jt + l15; t4[r] = (j < i) ? -(bi[r] * t4[r] * __expf(gi[r] - gj)) : 0.f; }
                }
#pragma unroll
                for (int r = 0; r < 4; ++r) Ln[(16 * it + 4 * q + r) * MP + 16 * jt + l15] = (bf16)f2bf1(t4[r]);
            }
    }
    {
#pragma unroll
        for (int I = 0; I < 4; ++I) {
            const f32x4 bi = *(const LAS f32x4*)(vec + 16 * I + 4 * q), gi = *(const LAS f32x4*)(vec + 64 + 16 * I + 4 * q);
#pragma unroll
            for (int r = 0; r < 4; ++r) { const float sc = pw ? bi[r] * __expf(gi[r]) : bi[r];
#pragma unroll
                for (int nt = 0; nt < 4; ++nt) acc[I][nt][r] = (pw ? bf2f(Ks[(16 * I + 4 * q + r) * MP + 16 * nt + l15]) : acc[I][nt][r]) * sc; }
        }
    }
    __syncthreads();
    if (pw == 0) diag_inverses(Ln, TinvP, lane);
    LAS unsigned char* XTw = XT + pw * 8192;
    { LAS v4u* xz = (LAS v4u*)(XTw + lane * 128);
#pragma unroll
        for (int g = 0; g < 8; ++g) xz[g] = (v4u){0u, 0u, 0u, 0u}; }
    __syncthreads();
    blocked_solve(Ln, TinvP, XTw, acc, l15, q);
    {
        bf16* dst = blob_row(C, d, pw, b, c, h, lane);
        const LAS unsigned char* xr = XTw + lane * 128;
#pragma unroll
        for (int g = 0; g < 8; ++g) *(v4u*)(dst + 8 * g) = *(const LAS v4u*)(xr + ((g ^ (lane & 7)) << 4));
    }
    __syncthreads();
}

template <bool DRY>
__device__ __forceinline__ void gdn_chunked(const Ctx& C, int l, int idx) {
    const int d = idx >> 5, b = (idx >> 2) & 7, h = idx & 3, lane = C.lane, w = C.wave, l15 = lane & 15, q = lane >> 4;
    const int it = w & 3, vtp = w >> 2;
    constexpr int IMG = 64 * MP * 2, BUFB = 5 * IMG + 512;
    LAS unsigned char* L0 = C.lds;
    LAS bf16* VnT = (LAS bf16*)(L0 + 2 * BUFB + 2 * IMG);
    const bf16* P = WSP(const bf16, WS_P); const bf16* gq = WSP(const bf16, WS_GQ); bf16* outd = WSP(bf16, WS_OUTD) + (size_t)d * T_ALL * 256;
    const float aexp = __expf(C.in[I_GALOG][(l * 2 + d) * NH + h]), dtb = C.in[I_GDTB][(l * 2 + d) * NH + h];
    const int tt = C.tid >> 3, part = C.tid & 7;
    for (int i = C.tid; i < 2 * IMG / 4; i += NTHR) ((LAS unsigned*)(L0 + 2 * BUFB))[i] = 0u;
    v4u rq, rk, ru, rw; unsigned short rga;
    auto gload = [&](int n) {
        const int c = d ? (n < 4 ? 3 - n : 71 - n) : n;
        const bf16* pp = gq + (size_t)seqrow_cm(n * 64 + tt, d, b) * 768 + h * 64 + 8 * part;
        rq = *(const v4u*)pp; rk = *(const v4u*)(pp + 256);
        ru = *(const v4u*)(blob_row(C, d, 0, b, c, h, tt) + 8 * part); rw = *(const v4u*)(blob_row(C, d, 1, b, c, h, tt) + 8 * part);
        rga = P[(size_t)seqrow_cm(n * 64 + lane, d, b) * PLD + OFF_D + 1024 + d * 4 + h];
    };
    auto images = [&](int bufi) {
        LAS unsigned char* B0 = L0 + bufi * BUFB;
        LAS bf16* Qs = (LAS bf16*)B0; LAS bf16* Ks = Qs + 64 * MP; LAS bf16* KdT = Ks + 64 * MP; LAS bf16* Wi = KdT + 64 * MP; LAS bf16* UT = Wi + 64 * MP; LAS float* vec = (LAS float*)(B0 + 5 * IMG);
        const float la = -aexp * softplusf_(bf2f(rga) + dtb);
        const float gam = wave_incl_sum(la, lane);
        if (w == 0) vec[lane] = gam;
        const float kd = __expf(__shfl(gam, 63) - gam);
        const float kmine = __shfl(kd, 8 * w + (lane >> 3));
        *(LAS v4u*)(Qs + tt * MP + 8 * part) = rq; *(LAS v4u*)(Ks + tt * MP + 8 * part) = rk; *(LAS v4u*)(UT + tt * MP + 8 * part) = ru;
        const unsigned kk[4] = {rk.x, rk.y, rk.z, rk.w}, ww[4] = {rw.x, rw.y, rw.z, rw.w};
#pragma unroll
        for (int e = 0; e < 4; ++e) {
            KdT[(8 * part + 2 * e) * MP + tt] = (bf16)f2bf1(bflo(kk[e]) * kmine); KdT[(8 * part + 2 * e + 1) * MP + tt] = (bf16)f2bf1(bfhi(kk[e]) * kmine);
            Wi[(8 * part + 2 * e) * MP + tt] = (bf16)(ww[e] & 0xffffu); Wi[(8 * part + 2 * e + 1) * MP + tt] = (bf16)(ww[e] >> 16);
        }
    };
    f32x4 Sst[2]; Sst[0] = Sst[1] = (f32x4){0.f, 0.f, 0.f, 0.f};
    const f32x4 z4 = (f32x4){0.f, 0.f, 0.f, 0.f};
    gload(0); images(0); gload(1);
#pragma unroll 1
    for (int n = 0; n < NCH; ++n) {
        RAW_BARRIER();
        const LAS unsigned char* B0 = L0 + (n & 1) * BUFB;
        const LAS bf16* Qs = (const LAS bf16*)B0; const LAS bf16* Ks = Qs + 64 * MP; const LAS bf16* KdT = Ks + 64 * MP; const LAS bf16* Wi = KdT + 64 * MP; const LAS bf16* UT = Wi + 64 * MP; const LAS float* vec = (const LAS float*)(B0 + 5 * IMG);
        const LAS bf16* ST = (const LAS bf16*)(L0 + 2 * BUFB + (n & 1) * IMG); LAS bf16* STn = (LAS bf16*)(L0 + 2 * BUFB + ((n + 1) & 1) * IMG);
        fragb Qf[2]; Qf[0] = ld_frag16(Qs + (16 * it + l15) * MP + 8 * q); Qf[1] = ld_frag16(Qs + (16 * it + l15) * MP + 32 + 8 * q);
        const float gcol = vec[16 * it + l15]; const int icol = 16 * it + l15;
        f32x4 pt[4];
#pragma unroll
        for (int jt = 0; jt < 4; ++jt) {
            pt[jt] = z4;
            if (jt <= it) {
                const fragb k0 = ld_frag16(Ks + (16 * jt + l15) * MP + 8 * q), k1 = ld_frag16(Ks + (16 * jt + l15) * MP + 32 + 8 * q);
                f32x4 st = mfma16(k0, Qf[0], z4); st = mfma16(k1, Qf[1], st);
                const f32x4 gj = *(const LAS f32x4*)(vec + 16 * jt + 4 * q);
#pragma unroll
                for (int r = 0; r < 4; ++r) { const int j = 16 * jt + 4 * q + r; pt[jt][r] = (j <= icol) ? st[r] * __expf(gcol - gj[r]) : 0.f; }
            }
        }
        fragb Pf[2]; Pf[0] = pack_frag(pt[0], pt[1]); Pf[1] = pack_frag(pt[2], pt[3]);
        const fragb Wf0 = ld_frag16(Wi + (16 * it + l15) * MP + 8 * q), Wf1 = ld_frag16(Wi + (16 * it + l15) * MP + 32 + 8 * q);
        f32x4 Ro[2];
#pragma unroll
        for (int v2 = 0; v2 < 2; ++v2) {
            const int vrow = 16 * (2 * vtp + v2) + l15;
            const fragb s0 = ld_frag16(ST + vrow * MP + 8 * q), s1 = ld_frag16(ST + vrow * MP + 32 + 8 * q);
            f32x4 ws = mfma16(Wf0, s0, z4); ws = mfma16(Wf1, s1, ws);
            Ro[v2] = mfma16(Qf[0], s0, z4); Ro[v2] = mfma16(Qf[1], s1, Ro[v2]);
            const v2u ur = *(const LAS v2u*)(UT + vrow * MP + 16 * it + 4 * q);
            v2u o; o.x = pk2(bflo(ur.x) - ws.x, bfhi(ur.x) - ws.y); o.y = pk2(bflo(ur.y) - ws.z, bfhi(ur.y) - ws.w);
            *(LAS v2u*)(VnT + vrow * MP + 16 * it + 4 * q) = o;
        }
        RAW_BARRIER();
        {
            const f32x4 gi = *(const LAS f32x4*)(vec + 16 * it + 4 * q);
            const float gl = __expf(vec[63]);
            const LAS bf16* kr = KdT + (16 * it + l15) * MP + 4 * q;
            const fragb kt0 = ld_frag8x2(kr, kr + 16), kt1 = ld_frag8x2(kr + 32, kr + 48);
#pragma unroll
            for (int v2 = 0; v2 < 2; ++v2) {
                const int vrow = 16 * (2 * vtp + v2) + l15;
                const LAS bf16* vr = VnT + vrow * MP + 4 * q;
                const fragb n0 = ld_frag8x2(vr, vr + 16), n1 = ld_frag8x2(vr + 32, vr + 48);
                f32x4 o = mfma16(Pf[0], n0, z4); if (it >= 2) o = mfma16(Pf[1], n1, o);
#pragma unroll
                for (int r = 0; r < 4; ++r) { const int row = seqrow_cm(n * 64 + 16 * it + 4 * q + r, d, b);
                    if (!DRY) outd[(size_t)row * 256 + h * 64 + vrow] = (bf16)f2bf1(o[r] + __expf(gi[r]) * Ro[v2][r]); }
                f32x4 ns = mfma16(kt0, n0, z4); ns = mfma16(kt1, n1, ns);
                Sst[v2] = Sst[v2] * gl + ns;
                v2u so; so.x = pk2(Sst[v2].x, Sst[v2].y); so.y = pk2(Sst[v2].z, Sst[v2].w);
                *(LAS v2u*)(STn + vrow * MP + 16 * it + 4 * q) = so;
            }
        }
        if (n + 1 < NCH) { images((n + 1) & 1); if (n + 2 < NCH) gload(n + 2); }
    }
    __syncthreads();
}
constexpr int UP = 264;
template <int CTRL> __device__ __forceinline__ float dpp_keep(float oldv, float v) { return __builtin_bit_cast(float, __builtin_amdgcn_update_dpp(__builtin_bit_cast(int, oldv), __builtin_bit_cast(int, v), CTRL, 0xF, 0xF, false)); }
template <bool REV> __device__ __forceinline__ void scan16(float& A, float& B) {
#define LRU_STEP(S) { const float Ap = dpp_keep<(REV ? 0x100 : 0x110) | S>(1.0f, A), Bp = dpp_keep<(REV ? 0x100 : 0x110) | S>(0.0f, B); B = A * Bp + B; A = A * Ap; }
    LRU_STEP(1) LRU_STEP(2) LRU_STEP(4) LRU_STEP(8)
#undef LRU_STEP
}
constexpr int UPC = 72;
__device__ __forceinline__ int lru_chunk_of(int d, int k) { return d ? (k < 4 ? 3 - k : NCH + 3 - k) : k; }
template <bool REV>
__device__ __forceinline__ void lru_tiles(const LAS bf16* Ud, int th, int mt, int lane, const fragb (&Wa)[2], const fragb (&Wx)[2], const f32x4& ba, const f32x4& bx, const f32x4& sp4,
                                          f32x4 (&Ac)[2], f32x4 (&Hl)[2], f32x4& Atot, f32x4& hend) {
    const int l15 = lane & 15, q = lane >> 4, edge = (lane & 48) | (REV ? 0 : 15);
    const f32x4 z4 = (f32x4){0.f, 0.f, 0.f, 0.f};
    f32x4 tA = z4, tB = z4;
#pragma unroll
    for (int i = 0; i < 2; ++i) {
        const int nt = REV ? 3 - (2 * th + i) : 2 * th + i;
        const LAS bf16* urow = Ud + (16 * nt + l15) * UPC;
        const fragb Uf0 = ld_frag16(urow + 8 * q), Uf1 = ld_frag16(urow + 32 + 8 * q);
        f32x4 aa = mfma16(Wa[0], Uf0, z4); aa = mfma16(Wa[1], Uf1, aa);
        f32x4 ax = mfma16(Wx[0], Uf0, z4); ax = mfma16(Wx[1], Uf1, ax);
        const v2u ur = *(const LAS v2u*)(urow + 16 * mt + 4 * q);
        const f32x4 u4 = (f32x4){bflo(ur.x), bfhi(ur.x), bflo(ur.y), bfhi(ur.y)};
        f32x4 la, iu, A, Bv;
#pragma unroll
        for (int r = 0; r < 4; ++r) { const float rg = sigmoidf_(aa[r] + ba[r]); iu[r] = sigmoidf_(ax[r] + bx[r]) * u4[r]; la[r] = -sp4[r] * rg; }
        const bool sm_ = la[0] > -0.15f && la[1] > -0.15f && la[2] > -0.15f && la[3] > -0.15f;
        if (__builtin_amdgcn_ballot_w64(!sm_) == 0ull) {
#pragma unroll
            for (int r = 0; r < 4; ++r) { const float x = la[r], p = x * (1.0f + x * (0.5f + x * (0.16666667f + x * (0.041666668f + x * (0.0083333338f + x * 0.0013888889f)))));
                A[r] = 1.0f + p; Bv[r] = __builtin_amdgcn_sqrtf(-p * (2.0f + p)) * iu[r]; }
        } else {
#pragma unroll
            for (int r = 0; r < 4; ++r) { A[r] = __expf(la[r]); Bv[r] = __builtin_amdgcn_sqrtf(-expm1f_(2.0f * la[r])) * iu[r]; }
        }
#pragma unroll
        for (int r = 0; r < 4; ++r) { float a_ = A[r], b_ = Bv[r]; scan16<REV>(a_, b_); A[r] = a_; Bv[r] = b_; }
        if (i == 0) {
            Ac[0] = A; Hl[0] = Bv;
#pragma unroll
            for (int r = 0; r < 4; ++r) { tA[r] = __shfl(A[r], edge); tB[r] = __shfl(Bv[r], edge); }
        } else {
            Ac[1] = A * tA; Hl[1] = A * tB + Bv;
#pragma unroll
            for (int r = 0; r < 4; ++r) { Atot[r] = __shfl(Ac[1][r], edge); hend[r] = __shfl(Hl[1][r], edge); }
        }
    }
}
__device__ __forceinline__ void lru_chain(const Ctx& C, int l, int id) {
    const int b = id >> 3, hd = (id >> 1) & 3, chalf = id & 1;
    const int lane = C.lane, l15 = lane & 15, q = lane >> 4;
    const int d = C.wave >> 2, mtl = (C.wave >> 1) & 1, th = C.wave & 1, mt = chalf * 2 + mtl;
    LAS bf16* U = (LAS bf16*)C.lds;
    LAS float* XCH = (LAS float*)(C.lds + 2 * 2 * 64 * UPC * 2);
    bf16* P = WSP(bf16, WS_P); bf16* LH = WSP(bf16, WS_LRUH) + (size_t)id * NSTEP * 32;
    const int cd = C.tid >> 8, cj = C.tid & 63, ctq = (C.tid >> 6) & 3;
    const float* cw = C.in[I_LCW] + (size_t)l * 4 * GW + hd * 64 + cj; const float w0 = cw[0], w1 = cw[GW], w2 = cw[2 * GW], w3 = cw[3 * GW], cb = C.in[I_LCB][l * GW + hd * 64 + cj];
    const bf16* wt = WSP(const bf16, WS_LRUWT) + (size_t)((d * 2 + 0) * 4 + hd) * 4096;
    fragb Wa[2], Wx[2];
#pragma unroll
    for (int ks = 0; ks < 2; ++ks) { Wa[ks] = *(const fragb*)(wt + (16 * mt + l15) * 64 + 32 * ks + 8 * q); Wx[ks] = *(const fragb*)(wt + 4 * 4096 + (16 * mt + l15) * 64 + 32 * ks + 8 * q); }
    const int ch0 = hd * 64 + 16 * mt + 4 * q;
    const f32x4 ba = *(const f32x4*)(C.in[I_LBA] + (l * 2 + d) * GW + ch0), bx = *(const f32x4*)(C.in[I_LBX] + (l * 2 + d) * GW + ch0), lam = *(const f32x4*)(C.in[I_LLAM] + (l * 2 + d) * GW + ch0);
    f32x4 sp4;
#pragma unroll
    for (int r = 0; r < 4; ++r) sp4[r] = 8.0f * softplusf_(-lam[r]);
    f32x4 s = (f32x4){0.f, 0.f, 0.f, 0.f};
    unsigned short xr[19];
#define LRU_LOADX(kk) do { const int c_ = lru_chunk_of(cd, (kk)); const bool ic_ = c_ < 4; const int p0_ = (ic_ ? c_ * 64 : (c_ - 4) * 64) + ctq * 16 - 2, Lp_ = ic_ ? CTXL : SEQ; \
        const bf16* xp_ = P + (size_t)(ic_ ? T_LAT + b * CTXL : b * SEQ) * PLD + hd * 64 + cj; \
        _Pragma("unroll") for (int i_ = 0; i_ < 19; ++i_) { const int p_ = p0_ + i_; xr[i_] = (p_ >= 0 && p_ < Lp_) ? xp_[(size_t)p_ * PLD] : (unsigned short)0; } } while (0)
#define LRU_CONV(kk) do { LAS bf16* uo_ = U + ((((kk) & 1) * 2 + cd) * 64 + ctq * 16) * UPC + cj; \
        _Pragma("unroll") for (int t_ = 0; t_ < 16; ++t_) uo_[t_ * UPC] = (bf16)f2bf1(w0 * bf2f(xr[t_]) + w1 * bf2f(xr[t_ + 1]) + w2 * bf2f(xr[t_ + 2]) + w3 * bf2f(xr[t_ + 3]) + cb); } while (0)
    LRU_LOADX(0); LRU_CONV(0); LRU_LOADX(1);
    __syncthreads();
#pragma unroll 1
    for (int k = 0; k < NCH; ++k) {
        if (k + 1 < NCH) { LRU_CONV(k + 1); if (k + 2 < NCH) LRU_LOADX(k + 2); }
        const int c = lru_chunk_of(d, k); const bool second = lru_chunk_of(1 - d, c) < k;
        const bool ic = c < 4; const size_t row0 = (size_t)(ic ? T_LAT + b * CTXL + c * 64 : b * SEQ + (c - 4) * 64);
        const bool late = (k == 2) || (k == 36);
        int tok[2]; v2u gv[2], fv[2];
#pragma unroll
        for (int i = 0; i < 2; ++i) { const int nt = d ? 3 - (2 * th + i) : 2 * th + i; tok[i] = 16 * nt + l15;
            if (second && !late) { gv[i] = *(const v2u*)(P + (row0 + tok[i]) * PLD + 256 + ch0); fv[i] = *(const v2u*)(LH + (size_t)(c * 64 + tok[i]) * 32 + 16 * mtl + 4 * q); } }
        f32x4 Ac[2], Hl[2], Atot, hend;
        const LAS bf16* Ud = U + ((k & 1) * 2 + d) * 64 * UPC;
        if (d) lru_tiles<true>(Ud, th, mt, lane, Wa, Wx, ba, bx, sp4, Ac, Hl, Atot, hend); else lru_tiles<false>(Ud, th, mt, lane, Wa, Wx, ba, bx, sp4, Ac, Hl, Atot, hend);
        LAS float* xw = XCH + (((((k & 1) * 2 + d) * 2 + mtl) * 2 + th) * 4 + q) * 8;
        if (l15 == (d ? 0 : 15)) { *(LAS f32x4*)xw = Atot; *(LAS f32x4*)(xw + 4) = hend; }
        if (late) VM_WAIT();
        RAW_BARRIER();
        if (second && late) {
#pragma unroll
            for (int i = 0; i < 2; ++i) { gv[i] = *(const v2u*)(P + (row0 + tok[i]) * PLD + 256 + ch0); fv[i] = *(const v2u*)(LH + (size_t)(c * 64 + tok[i]) * 32 + 16 * mtl + 4 * q); }
        }
        const LAS float* xr0 = XCH + (((((k & 1) * 2 + d) * 2 + mtl) * 2 + 0) * 4 + q) * 8;
        const f32x4 A0 = *(const LAS f32x4*)xr0, h0 = *(const LAS f32x4*)(xr0 + 4), A1 = *(const LAS f32x4*)(xr0 + 32), h1 = *(const LAS f32x4*)(xr0 + 36);
        const f32x4 mid = A0 * s + h0, hin = th ? mid : s;
        s = A1 * mid + h1;
#pragma unroll
        for (int i = 0; i < 2; ++i) {
            const f32x4 h = Ac[i] * hin + Hl[i];
            if (!second) { v2u o; o.x = pk2(h.x, h.y); o.y = pk2(h.z, h.w); *(v2u*)(LH + (size_t)(c * 64 + tok[i]) * 32 + 16 * mtl + 4 * q) = o; }
            else {
                const f32x4 g = (f32x4){bflo(gv[i].x), bfhi(gv[i].x), bflo(gv[i].y), bfhi(gv[i].y)};
                f32x4 y = (f32x4){h.x + bflo(fv[i].x), h.y + bfhi(fv[i].x), h.z + bflo(fv[i].y), h.w + bfhi(fv[i].y)};
                y.x *= gelu_tanh(g.x); y.y *= gelu_tanh(g.y); y.z *= gelu_tanh(g.z); y.w *= gelu_tanh(g.w);
                st4bf(P + (row0 + tok[i]) * PLD + 256 + ch0, y);
            }
        }
    }
#undef LRU_LOADX
#undef LRU_CONV
    __syncthreads();
}
constexpr int RP = 264;
__device__ __forceinline__ void rwkv_prep2(const Ctx& C, int l, int b, int c) {
    LAS bf16* RS = (LAS bf16*)C.lds;
    LAS bf16* KS = RS + 64 * RP;
    LAS bf16* XW = KS + 64 * RP;
    LAS bf16* XA = XW + 64 * MP;
    LAS bf16* XG = XA + 64 * MP;
    const bf16* P = WSP(const bf16, WS_P);
    const bool isctx = c < 4; const int p0 = isctx ? c * 64 : (c - 4) * 64; const int Lp = isctx ? CTXL : SEQ; const int row0 = isctx ? T_LAT + b * CTXL : b * SEQ;
    const float* mu = C.in[I_RMU] + (size_t)l * 2 * B_COLS;
    bf16* rkv = WSP(bf16, WS_RKV);
#pragma unroll 5
    for (int it = C.tid; it < 64 * 120; it += NTHR) {
        const int t = it / 120, c8 = (it % 120) * 8, p = p0 + t;
        const bf16* pp = P + (size_t)(row0 + p) * PLD + OFF_B + c8;
        const v4u xc = *(const v4u*)pp; v4u xp = (v4u){0u, 0u, 0u, 0u}, xn = xp;
        if (p > 0) xp = *(const v4u*)(pp - PLD);
        if (p < Lp - 1) xn = *(const v4u*)(pp + PLD);
        const f32x4 m0a = *(const f32x4*)(mu + c8), m0b = *(const f32x4*)(mu + c8 + 4), m1a = *(const f32x4*)(mu + B_COLS + c8), m1b = *(const f32x4*)(mu + B_COLS + c8 + 4);
        const unsigned xcw[4] = {xc.x, xc.y, xc.z, xc.w}, xpw[4] = {xp.x, xp.y, xp.z, xp.w}, xnw[4] = {xn.x, xn.y, xn.z, xn.w};
        float sh[8];
#pragma unroll
        for (int e = 0; e < 4; ++e) {
            const float x0 = bflo(xcw[e]), x1 = bfhi(xcw[e]);
            const float mu0_0 = e < 2 ? m0a[2 * e] : m0b[2 * e - 4], mu0_1 = e < 2 ? m0a[2 * e + 1] : m0b[2 * e - 3], mu1_0 = e < 2 ? m1a[2 * e] : m1b[2 * e - 4], mu1_1 = e < 2 ? m1a[2 * e + 1] : m1b[2 * e - 3];
            sh[2 * e] = x0 + mu0_0 * (bflo(xpw[e]) - x0) + mu1_0 * (bflo(xnw[e]) - x0);
            sh[2 * e + 1] = x1 + mu0_1 * (bfhi(xpw[e]) - x1) + mu1_1 * (bfhi(xnw[e]) - x1);
        }
        if (c8 >= 768) {
            const int ci = c8 - 768;
            if (ci < 64) {
#pragma unroll
                for (int e = 0; e < 8; ++e) sh[e] = tanhf_(sh[e]); }
            else if (ci >= 128) {
#pragma unroll
                for (int e = 0; e < 8; ++e) sh[e] = sigmoidf_(sh[e]); }
        }
        v4u o; o.x = pk2(sh[0], sh[1]); o.y = pk2(sh[2], sh[3]); o.z = pk2(sh[4], sh[5]); o.w = pk2(sh[6], sh[7]);
        if (c8 < 768) {
            *(v4u*)(rkv + (size_t)(row0 + p) * 768 + c8) = o;
            if (c8 < 256) *(LAS v4u*)(RS + t * RP + c8) = o; else if (c8 < 512) *(LAS v4u*)(KS + t * RP + c8 - 256) = o;
        } else {
            const int ci = c8 - 768;
            LAS bf16* dst = ci < 64 ? XW + t * MP + ci : (ci < 128 ? XA + t * MP + ci - 64 : XG + t * MP + ci - 128);
            *(LAS v4u*)dst = o;
        }
    }
    __syncthreads();
    const int lane = C.lane, w = C.wave, l15 = lane & 15, q = lane >> 4, hd = w & 3, ntp = w >> 2;
    const bf16* wt = WSP(const bf16, WS_RWT);
    bf16* wa_out = WSP(bf16, WS_HB); bf16* g_out = WSP(bf16, WS_G); float* bonus = WSP(float, WS_BONUS); float* rinv = WSP(float, WS_RINV);
    const f32x4 z4 = (f32x4){0.f, 0.f, 0.f, 0.f};
    float bsum[2] = {0.f, 0.f}, ksum[2] = {0.f, 0.f};
#pragma unroll
    for (int n2 = 0; n2 < 2; ++n2) {
        const int tok = 16 * (2 * ntp + n2) + l15; const size_t row = (size_t)(row0 + p0 + tok);
        const fragb xw0 = ld_frag16(XW + tok * MP + 8 * q), xw1 = ld_frag16(XW + tok * MP + 32 + 8 * q), xa0 = ld_frag16(XA + tok * MP + 8 * q), xa1 = ld_frag16(XA + tok * MP + 32 + 8 * q);
        const fragb xg0 = ld_frag16(XG + tok * MP + 8 * q), xg1 = ld_frag16(XG + tok * MP + 32 + 8 * q);
        unsigned ow0[8], ow1[8], oa0[8], oa1[8], og[8];
#pragma unroll
        for (int mt = 0; mt < 4; ++mt) {
            const int chl = 16 * (l15 >> 2) + 4 * mt + (l15 & 3), ch4 = hd * 64 + 16 * q + 4 * mt;
            const bf16* wrow = wt + (size_t)(hd * 64 + chl) * 32 + 8 * q;
            const bf16* grow = wt + 4 * 256 * 32 + (size_t)(hd * 64 + chl) * 64 + 8 * q;
            const fragb fw0 = *(const fragb*)(wrow), fw1 = *(const fragb*)(wrow + 256 * 32), fa0 = *(const fragb*)(wrow + 2 * 256 * 32), fa1 = *(const fragb*)(wrow + 3 * 256 * 32), fg0 = *(const fragb*)(grow), fg1 = *(const fragb*)(grow + 32);
            const f32x4 w00 = *(const f32x4*)(C.in[I_RW0] + (l * 2 + 0) * GW + ch4), w01 = *(const f32x4*)(C.in[I_RW0] + (l * 2 + 1) * GW + ch4);
            const f32x4 a00 = *(const f32x4*)(C.in[I_RA0] + (l * 2 + 0) * GW + ch4), a01 = *(const f32x4*)(C.in[I_RA0] + (l * 2 + 1) * GW + ch4);
            const f32x4 k_a = *(const f32x4*)(C.in[I_RKA] + l * GW + ch4), r_k = *(const f32x4*)(C.in[I_RRK] + l * GW + ch4), k_k = *(const f32x4*)(C.in[I_RKK] + l * GW + ch4);
            const f32x4 aw0 = mfma16(fw0, xw0, z4), aw1 = mfma16(fw1, xw1, z4), aa0 = mfma16(fa0, xa0, z4), aa1 = mfma16(fa1, xa1, z4);
            f32x4 ag = mfma16(fg0, xg0, z4); ag = mfma16(fg1, xg1, ag);
            f32x4 wv0, wv1, av0, av1;
#pragma unroll
            for (int r = 0; r < 4; ++r) {
                wv0[r] = __expf(-0.6065306597126334f * sigmoidf_(aw0[r] + w00[r])); wv1[r] = __expf(-0.6065306597126334f * sigmoidf_(aw1[r] + w01[r]));
                av0[r] = sigmoidf_(aa0[r] + a00[r]); av1[r] = sigmoidf_(aa1[r] + a01[r]);
            }
            ow0[2 * mt] = pk2(wv0[0], wv0[1]); ow0[2 * mt + 1] = pk2(wv0[2], wv0[3]); ow1[2 * mt] = pk2(wv1[0], wv1[1]); ow1[2 * mt + 1] = pk2(wv1[2], wv1[3]);
            oa0[2 * mt] = pk2(av0[0], av0[1]); oa0[2 * mt + 1] = pk2(av0[2], av0[3]); oa1[2 * mt] = pk2(av1[0], av1[1]); oa1[2 * mt + 1] = pk2(av1[2], av1[3]);
            og[2 * mt] = pk2(ag[0], ag[1]); og[2 * mt + 1] = pk2(ag[2], ag[3]);
            const v2u rr_ = *(const LAS v2u*)(RS + tok * RP + ch4), kr_ = *(const LAS v2u*)(KS + tok * RP + ch4);
            const f32x4 rs = (f32x4){bflo(rr_.x), bfhi(rr_.x), bflo(rr_.y), bfhi(rr_.y)}, ks = (f32x4){bflo(kr_.x), bfhi(kr_.x), bflo(kr_.y), bfhi(kr_.y)};
#pragma unroll
            for (int r = 0; r < 4; ++r) {
                const float km = ks[r] * (1.0f + (av0[r] - 1.0f) * k_a[r]) + ks[r] * (1.0f + (av1[r] - 1.0f) * k_a[r]);
                bsum[n2] += rs[r] * r_k[r] * km; const float kk = ks[r] * k_k[r]; ksum[n2] += kk * kk;
            }
        }
        bf16* wrow_o = wa_out + row * 1024 + hd * 64 + 16 * q;
        *(v4u*)(wrow_o) = (v4u){ow0[0], ow0[1], ow0[2], ow0[3]}; *(v4u*)(wrow_o + 8) = (v4u){ow0[4], ow0[5], ow0[6], ow0[7]};
        *(v4u*)(wrow_o + 256) = (v4u){ow1[0], ow1[1], ow1[2], ow1[3]}; *(v4u*)(wrow_o + 256 + 8) = (v4u){ow1[4], ow1[5], ow1[6], ow1[7]};
        *(v4u*)(wrow_o + 512) = (v4u){oa0[0], oa0[1], oa0[2], oa0[3]}; *(v4u*)(wrow_o + 512 + 8) = (v4u){oa0[4], oa0[5], oa0[6], oa0[7]};
        *(v4u*)(wrow_o + 768) = (v4u){oa1[0], oa1[1], oa1[2], oa1[3]}; *(v4u*)(wrow_o + 768 + 8) = (v4u){oa1[4], oa1[5], oa1[6], oa1[7]};
        bf16* grow_o = g_out + row * 256 + hd * 64 + 16 * q;
        *(v4u*)(grow_o) = (v4u){og[0], og[1], og[2], og[3]}; *(v4u*)(grow_o + 8) = (v4u){og[4], og[5], og[6], og[7]};
    }
#pragma unroll
    for (int n2 = 0; n2 < 2; ++n2) {
        const size_t row = (size_t)(row0 + p0 + 16 * (2 * ntp + n2) + l15);
        float bs = bsum[n2], ks2 = ksum[n2];
        bs += __shfl_xor(bs, 16); bs += __shfl_xor(bs, 32); ks2 += __shfl_xor(ks2, 16); ks2 += __shfl_xor(ks2, 32);
        if (q == 0) { bonus[row * 4 + hd] = bs; rinv[row * 4 + hd] = rsqrtf_(ks2 + 1e-6f); }
    }
    __syncthreads();
}
__device__ __forceinline__ int fwd_row_r(int b, int c, int t) { return c < 4 ? (T_LAT + b * CTXL + c * 64 + t) : (b * SEQ + (c - 4) * 64 + t); }
__device__ __forceinline__ bf16* rw_blob_row(const Ctx& C, int d, int which, int b, int c, int h, int r) {
    const int row = fwd_row_r(b, c, r);
#if RW_VSPLIT
    if (which == 0) { if (d) return WSP(bf16, WS_GQ) + (size_t)row * 768 + 512 + h * 64;
                      return WSP(bf16, WS_P) + (size_t)row * PLD + OFF_B + 512 + h * 64; }
#else
    if (which == 0) return WSP(bf16, WS_OUTB) + ((size_t)d * T_ALL + row) * 256 + h * 64;
#endif
    return WSP(bf16, WS_P) + (size_t)row * PLD + OFF_B + d * 256 + h * 64;
}
__device__ __forceinline__ void rwkv_solve_item(const Ctx& C, int l, int item) {
    const int lane = C.lane, w = C.wave, pw = w & 1, pi = w >> 1, l15 = lane & 15, q = lane >> 4;
    LAS unsigned char* B0 = C.lds + pi * 31744;
    LAS bf16* Kk = (LAS bf16*)B0; LAS bf16* Bh = Kk + 64 * MP; LAS bf16* Kh = Bh + 64 * MP;
    LAS bf16* Ln = (LAS bf16*)B0;
    LAS bf16* Lk16 = (LAS bf16*)(B0 + 9216);
    LAS unsigned char* XT = B0 + 9216;
    LAS bf16* TinvP = (LAS bf16*)(B0 + 25600);
    const bf16* WA = WSP(const bf16, WS_HB); bf16* WAw = WSP(bf16, WS_HB); const bf16* rkv = WSP(const bf16, WS_RKV); const float* rinv = WSP(const float, WS_RINV);
    const int u = item >> 1, d = item & 1;
    const int c = u % NCH, h = (u / NCH) & 3, b = u / (NCH * NH);
    const float k_k = C.in[I_RKK][l * GW + h * 64 + lane], k_a = C.in[I_RKA][l * GW + h * 64 + lane];
    const int n = d ? (c < 4 ? 3 - c : 71 - c) : c;
    const float ril = rinv[(size_t)seqrow_raster(n * 64 + lane, d, b) * 4 + h];
#pragma unroll
    for (int r = 0; r < 4; ++r) { const int idx2 = pw * 64 + lane + 128 * r, t = idx2 >> 3, part = idx2 & 7; const int row = seqrow_raster(n * 64 + t, d, b);
        *(LAS v4u*)(Kk + t * MP + 8 * part) = *(const v4u*)(WA + (size_t)row * 1024 + d * 256 + h * 64 + 8 * part);
        *(LAS v4u*)(Bh + t * MP + 8 * part) = *(const v4u*)(WA + (size_t)row * 1024 + (2 + d) * 256 + h * 64 + 8 * part);
        *(LAS v4u*)(Kh + t * MP + 8 * part) = *(const v4u*)(rkv + (size_t)row * 768 + 256 + h * 64 + 8 * part); }
    __syncthreads();
    {
        float cc = 1.0f;
        if (pw) {
#pragma unroll
            for (int t = 0; t < 32; ++t) cc *= bf2f(Kk[t * MP + lane]);
        }
        __syncthreads();
#pragma unroll
        for (int t2 = 0; t2 < 32; ++t2) {
            const int t = pw * 32 + t2;
            const float wv = bf2f(Kk[t * MP + lane]), av = bf2f(Bh[t * MP + lane]), ks = bf2f(Kh[t * MP + lane]);
            const float kap = ks * k_k * __shfl(ril, t);
            const float cprev = cc; cc *= wv; const float ic = __builtin_amdgcn_rcpf(cc);
            Kk[t * MP + lane] = (bf16)f2bf1(kap * cprev); Bh[t * MP + lane] = (bf16)f2bf1(kap * av * ic); Kh[t * MP + lane] = (bf16)f2bf1(ks * (1.0f + (av - 1.0f) * k_a) * ic);
            WAw[(size_t)seqrow_raster(n * 64 + t, d, b) * 1024 + d * 256 + h * 64 + lane] = (bf16)f2bf1(cc);
        }
    }
    __syncthreads();
    f32x4 acc[4][4];
    if (pw == 0) {
#pragma unroll
        for (int I = 0; I < 4; ++I)
#pragma unroll
            for (int r = 0; r < 4; ++r)
#pragma unroll
                for (int nt = 0; nt < 4; ++nt) acc[I][nt][r] = bf2f(Kk[(16 * I + 4 * q + r) * MP + 16 * nt + l15]);
    }
    f32x4 T[10];
    {
        const LAS bf16* Bsrc = pw ? Kh : Bh;
        int tix = 0;
#pragma unroll
        for (int it = 0; it < 4; ++it)
#pragma unroll
            for (int jt = 0; jt <= it; ++jt, ++tix) {
                f32x4 t4 = (f32x4){0.f, 0.f, 0.f, 0.f};
#pragma unroll
                for (int s = 0; s < 2; ++s) t4 = mfma16(ld_frag16(Kk + (16 * it + l15) * MP + 32 * s + 8 * q), ld_frag16(Bsrc + (16 * jt + l15) * MP + 32 * s + 8 * q), t4);
#pragma unroll
                for (int r = 0; r < 4; ++r) { const int i = 16 * it + 4 * q + r, j = 16 * jt + l15; T[tix][r] = (j < i) ? (pw ? t4[r] : -t4[r]) : 0.f; }
            }
    }
    __syncthreads();
    {
        int tix = 0;
#pragma unroll
        for (int it = 0; it < 4; ++it)
#pragma unroll
            for (int jt = 0; jt < 4; ++jt) {
                if (jt <= it) {
#pragma unroll
                    for (int r = 0; r < 4; ++r) (pw ? Lk16 : Ln)[(16 * it + 4 * q + r) * MP + 16 * jt + l15] = (bf16)f2bf1(T[tix][r]);
                    ++tix;
                } else if (pw == 0) {
#pragma unroll
                    for (int r = 0; r < 4; ++r) Ln[(16 * it + 4 * q + r) * MP + 16 * jt + l15] = (bf16)0;
                }
            }
        LAS v4u* tz = (LAS v4u*)(B0 + 25600) + (pw * 64 + lane) * 2; tz[0] = (v4u){0u, 0u, 0u, 0u}; tz[1] = (v4u){0u, 0u, 0u, 0u};
    }
    __syncthreads();
    if (pw) {
#pragma unroll
        for (int I = 0; I < 4; ++I)
#pragma unroll
            for (int r = 0; r < 4; ++r)
#pragma unroll
                for (int nt = 0; nt < 4; ++nt) { const int i = 16 * I + 4 * q + r, j = 16 * nt + l15; acc[I][nt][r] = (j < i && nt <= I) ? bf2f(Lk16[i * MP + j]) : 0.f; }
    } else diag_inverses(Ln, TinvP, lane);
    __syncthreads();
    LAS unsigned char* XTw = XT + pw * 8192;
    { LAS v4u* xz = (LAS v4u*)(XTw + lane * 128);
#pragma unroll
        for (int g = 0; g < 8; ++g) xz[g] = (v4u){0u, 0u, 0u, 0u}; }
    blocked_solve(Ln, TinvP, XTw, acc, l15, q);
    {
        bf16* dst = rw_blob_row(C, d, pw, b, c, h, lane);
        const LAS unsigned char* xr = XTw + lane * 128;
#pragma unroll
        for (int g = 0; g < 8; ++g) *(v4u*)(dst + 8 * g) = *(const LAS v4u*)(xr + ((g ^ (lane & 7)) << 4));
    }
    __syncthreads();
}

template <bool DRY>
__device__ __forceinline__ void rwkv_chunked(const Ctx& C, int l, int idx) {
#ifndef RW_VSPLIT
#define RW_VSPLIT 1
#endif
    constexpr int NV = RW_VSPLIT ? 1 : 2;
    const int vhalf = idx & 1, lane = C.lane, w = C.wave, l15 = lane & 15, q = lane >> 4;
    const int d = RW_VSPLIT ? idx >> 6 : idx >> 5, b = RW_VSPLIT ? (idx >> 3) & 7 : (idx >> 2) & 7, h = RW_VSPLIT ? (idx >> 1) & 3 : idx & 3;
    const int it = w & 3, vt0 = RW_VSPLIT ? 2 * vhalf + (w >> 2) : 2 * (w >> 2);
    constexpr int IMG = 64 * MP * 2;
    LAS unsigned char* L0 = C.lds;
    LAS bf16* Wi = (LAS bf16*)L0; LAS bf16* Ti = Wi + 64 * MP; LAS bf16* Rh = Ti + 64 * MP; LAS bf16* Kh = Rh + 64 * MP; LAS bf16* Bh = Kh + 64 * MP;
    LAS bf16* UT = (LAS bf16*)(L0 + 11 * IMG);
    LAS float* cLv = (LAS float*)(L0 + 14 * IMG);
    const bf16* WA = WSP(const bf16, WS_HB); const bf16* rkv = WSP(const bf16, WS_RKV); const float* rinv = WSP(const float, WS_RINV);
    bf16* outb = WSP(bf16, WS_OUTB) + (size_t)d * T_ALL * 256;
    const int tt = C.tid >> 3, part = C.tid & 7;
    for (int i = C.tid; i < 2 * IMG / 4; i += NTHR) ((LAS unsigned*)(L0 + 12 * IMG))[i] = 0u;
    float kkw[8], kaw[8];
#pragma unroll
    for (int e = 0; e < 8; ++e) { kkw[e] = C.in[I_RKK][l * GW + h * 64 + 8 * w + e]; kaw[e] = C.in[I_RKA][l * GW + h * 64 + 8 * w + e]; }
    v4u gr, gk, gv, gw, ga, gbw, gbt; float gri;
    auto gload = [&](int n) {
        const int c = d ? (n < 4 ? 3 - n : 71 - n) : n;
        const int row = seqrow_raster(n * 64 + lane, d, b);
        const bf16* pr = rkv + (size_t)row * 768 + h * 64 + 8 * w;
        gr = *(const v4u*)pr; gk = *(const v4u*)(pr + 256); gv = *(const v4u*)(pr + 512);
        gw = *(const v4u*)(WA + (size_t)row * 1024 + d * 256 + h * 64 + 8 * w); ga = *(const v4u*)(WA + (size_t)row * 1024 + (2 + d) * 256 + h * 64 + 8 * w);
        gri = rinv[(size_t)row * 4 + h];
        gbw = *(const v4u*)(rw_blob_row(C, d, 0, b, c, h, tt) + 8 * part); gbt = *(const v4u*)(rw_blob_row(C, d, 1, b, c, h, tt) + 8 * part);
    };
    auto images = [&](int bufi) {
        LAS bf16* VT = (LAS bf16*)(L0 + (5 + 3 * bufi) * IMG); LAS bf16* KcT = VT + 64 * MP; LAS bf16* BcT = KcT + 64 * MP;
        const unsigned rw_[4] = {gr.x, gr.y, gr.z, gr.w}, kw_[4] = {gk.x, gk.y, gk.z, gk.w}, vw_[4] = {gv.x, gv.y, gv.z, gv.w}, ww_[4] = {gw.x, gw.y, gw.z, gw.w}, aw_[4] = {ga.x, ga.y, ga.z, ga.w};
        float rh[8], kh[8], bh[8];
#pragma unroll
        for (int e = 0; e < 8; ++e) {
            const float rs = (e & 1) ? bfhi(rw_[e >> 1]) : bflo(rw_[e >> 1]), ks = (e & 1) ? bfhi(kw_[e >> 1]) : bflo(kw_[e >> 1]);
            const float wv = (e & 1) ? bfhi(ww_[e >> 1]) : bflo(ww_[e >> 1]), av = (e & 1) ? bfhi(aw_[e >> 1]) : bflo(aw_[e >> 1]);
            const float kap = ks * kkw[e] * gri, ktil = ks * (1.0f + (av - 1.0f) * kaw[e]);
            const float cf = wv, icf = __builtin_amdgcn_rcpf(cf), cfL = __builtin_bit_cast(float, __builtin_amdgcn_readlane(__builtin_bit_cast(int, cf), 63)), dec = cfL * icf;
            rh[e] = rs * cf; kh[e] = ktil * icf; bh[e] = kap * av * icf;
            const unsigned short vraw = (e & 1) ? (unsigned short)(vw_[e >> 1] >> 16) : (unsigned short)(vw_[e >> 1] & 0xffffu);
            VT[(8 * w + e) * MP + lane] = vraw; KcT[(8 * w + e) * MP + lane] = (bf16)f2bf1(ktil * dec); BcT[(8 * w + e) * MP + lane] = (bf16)f2bf1(-(kap * av * dec));
            if (lane == 63) cLv[bufi * 64 + 8 * w + e] = cfL;
        }
        { v4u o; o.x = pk2(rh[0], rh[1]); o.y = pk2(rh[2], rh[3]); o.z = pk2(rh[4], rh[5]); o.w = pk2(rh[6], rh[7]); *(LAS v4u*)(Rh + lane * MP + 8 * w) = o; }
        { v4u o; o.x = pk2(kh[0], kh[1]); o.y = pk2(kh[2], kh[3]); o.z = pk2(kh[4], kh[5]); o.w = pk2(kh[6], kh[7]); *(LAS v4u*)(Kh + lane * MP + 8 * w) = o; }
        { v4u o; o.x = pk2(bh[0], bh[1]); o.y = pk2(bh[2], bh[3]); o.z = pk2(bh[4], bh[5]); o.w = pk2(bh[6], bh[7]); *(LAS v4u*)(Bh + lane * MP + 8 * w) = o; }
        const unsigned bw_[4] = {gbw.x, gbw.y, gbw.z, gbw.w}, bt_[4] = {gbt.x, gbt.y, gbt.z, gbt.w};
#pragma unroll
        for (int e = 0; e < 4; ++e) {
            Wi[(8 * part + 2 * e) * MP + tt] = (bf16)(bw_[e] & 0xffffu); Wi[(8 * part + 2 * e + 1) * MP + tt] = (bf16)(bw_[e] >> 16);
            Ti[(8 * part + 2 * e) * MP + tt] = (bf16)(bt_[e] & 0xffffu); Ti[(8 * part + 2 * e + 1) * MP + tt] = (bf16)(bt_[e] >> 16);
        }
    };
    f32x4 Zst[NV];
#pragma unroll
    for (int v2 = 0; v2 < NV; ++v2) Zst[v2] = (f32x4){0.f, 0.f, 0.f, 0.f};
    const f32x4 z4 = (f32x4){0.f, 0.f, 0.f, 0.f};
    gload(0); images(0); gload(1);
#pragma unroll 1
    for (int n = 0; n < NCH; ++n) {
        RAW_BARRIER();
        const LAS bf16* VT = (const LAS bf16*)(L0 + (5 + 3 * (n & 1)) * IMG); const LAS bf16* KcT = VT + 64 * MP; const LAS bf16* BcT = KcT + 64 * MP;
        const LAS bf16* Zi = (const LAS bf16*)(L0 + (12 + (n & 1)) * IMG); LAS bf16* Zn = (LAS bf16*)(L0 + (12 + ((n + 1) & 1)) * IMG);
        const int arow = (16 * it + l15) * MP + 8 * q;
        const fragb Wf0 = ld_frag16(Wi + arow), Wf1 = ld_frag16(Wi + arow + 32), Tf0 = ld_frag16(Ti + arow), Tf1 = ld_frag16(Ti + arow + 32), Rf0 = ld_frag16(Rh + arow), Rf1 = ld_frag16(Rh + arow + 32);
        const int icol = 16 * it + l15;
        f32x4 pk[4], pb[4];
#pragma unroll
        for (int jt = 0; jt < 4; ++jt) {
            pk[jt] = z4; pb[jt] = z4;
            if (jt <= it) {
                const int jrow = (16 * jt + l15) * MP + 8 * q;
                f32x4 sk = mfma16(ld_frag16(Kh + jrow), Rf0, z4); sk = mfma16(ld_frag16(Kh + jrow + 32), Rf1, sk);
                f32x4 sb = mfma16(ld_frag16(Bh + jrow), Rf0, z4); sb = mfma16(ld_frag16(Bh + jrow + 32), Rf1, sb);
#pragma unroll
                for (int r = 0; r < 4; ++r) { const int j = 16 * jt + 4 * q + r; pk[jt][r] = (j <= icol) ? sk[r] : 0.f; pb[jt][r] = (j <= icol) ? -sb[r] : 0.f; }
            }
        }
        fragb Pk0 = pack_frag(pk[0], pk[1]), Pk1 = pack_frag(pk[2], pk[3]), Pb0 = pack_frag(pb[0], pb[1]), Pb1 = pack_frag(pb[2], pb[3]);
        f32x4 RZ[NV];
#pragma unroll
        for (int v2 = 0; v2 < NV; ++v2) {
            const int vrow = 16 * (vt0 + v2) + l15;
            const fragb z0 = ld_frag16(Zi + vrow * MP + 8 * q), z1 = ld_frag16(Zi + vrow * MP + 32 + 8 * q);
            f32x4 u = mfma16(Wf0, z0, z4); u = mfma16(Wf1, z1, u);
            u = mfma16(Tf0, ld_frag16(VT + vrow * MP + 8 * q), u); if (it >= 2) u = mfma16(Tf1, ld_frag16(VT + vrow * MP + 32 + 8 * q), u);
            RZ[v2] = mfma16(Rf0, z0, z4); RZ[v2] = mfma16(Rf1, z1, RZ[v2]);
            v2u o; o.x = pk2(u.x, u.y); o.y = pk2(u.z, u.w);
            *(LAS v2u*)(UT + vrow * MP + 16 * it + 4 * q) = o;
        }
        RAW_BARRIER();
        {
            const f32x4 cl4 = *(const LAS f32x4*)(cLv + (n & 1) * 64 + 16 * it + 4 * q);
            const LAS bf16* kr = KcT + (16 * it + l15) * MP + 4 * q; const LAS bf16* br = BcT + (16 * it + l15) * MP + 4 * q;
            const fragb kc0 = ld_frag8x2(kr, kr + 16), kc1 = ld_frag8x2(kr + 32, kr + 48), bc0 = ld_frag8x2(br, br + 16), bc1 = ld_frag8x2(br + 32, br + 48);
#pragma unroll
            for (int v2 = 0; v2 < NV; ++v2) {
                const int vrow = 16 * (vt0 + v2) + l15;
                const LAS bf16* vr = VT + vrow * MP + 4 * q; const LAS bf16* ur = UT + vrow * MP + 4 * q;
                const fragb vp0 = ld_frag8x2(vr, vr + 16), vp1 = ld_frag8x2(vr + 32, vr + 48), up0 = ld_frag8x2(ur, ur + 16), up1 = ld_frag8x2(ur + 32, ur + 48);
                f32x4 y = mfma16(Pk0, vp0, RZ[v2]); y = mfma16(Pb0, up0, y);
                if (it >= 2) { y = mfma16(Pk1, vp1, y); y = mfma16(Pb1, up1, y); }
#pragma unroll
                for (int r = 0; r < 4; ++r) { const int row = seqrow_raster(n * 64 + 16 * it + 4 * q + r, d, b); if (!DRY) outb[(size_t)row * 256 + h * 64 + vrow] = (bf16)f2bf1(y[r]); }
                f32x4 zn = mfma16(kc0, vp0, z4); zn = mfma16(kc1, vp1, zn); zn = mfma16(bc0, up0, zn); zn = mfma16(bc1, up1, zn);
                Zst[v2] = Zst[v2] * cl4 + zn;
                v2u so; so.x = pk2(Zst[v2].x, Zst[v2].y); so.y = pk2(Zst[v2].z, Zst[v2].w);
                *(LAS v2u*)(Zn + vrow * MP + 16 * it + 4 * q) = so;
            }
        }
        if (n + 1 < NCH) { images((n + 1) & 1); if (n + 2 < NCH) gload(n + 2); }
    }
    __syncthreads();
}
__device__ __forceinline__ void moe_scatter(const Ctx& C, int moe_li, int nrows) {
    const unsigned* gc = WSP(const unsigned, WS_CTL) + CW_MOECNT + 64 * moe_li;
    LAS int* pst = (LAS int*)C.lds;
    {
        int pe[8]; int acc = 0;
#pragma unroll
        for (int e = 0; e < NE; ++e) { const int blks = ((int)gc[e] + 255) >> 8; if (C.tid == e) pst[e] = acc * 256; acc += blks; pe[e] = acc; }
        if (C.wg == 0 && C.tid < MOE_MAXBLK) { int be = 0;
#pragma unroll
            for (int e = 0; e < NE; ++e) be += (pe[e] <= C.tid) ? 1 : 0;
            int* tab = WSP(int, WS_TAB); tab[1 + C.tid] = be < NE ? be : NE - 1; if (C.tid == 0) tab[0] = acc; }
    }
    __syncthreads();
    const unsigned* route = WSP(const unsigned, WS_ROUTE); const unsigned* wgbase = WSP(const unsigned, WS_WGBASE);
    int* pos = WSP(int, WS_POS); int* tok = WSP(int, WS_TOK);
    if (C.wg < NE) { const int cnt = (int)gc[C.wg], s0 = pst[C.wg] + cnt, s1 = pst[C.wg] + (((cnt + 255) >> 8) << 8);
        for (int j = s0 + C.tid; j < s1; j += NTHR) tok[j] = 0; }
    const int m = C.wg * NWAVES + C.wave + C.lane * (C.G * NWAVES);
    if (m < nrows) {
        const v4u a = *(const v4u*)(route + (size_t)m * 8);
        const int e0 = (int)a.x, e1 = (int)a.y;
        const int p0 = pst[e0] + (int)wgbase[C.wg * 8 + e0] + (int)a.z, p1 = pst[e1] + (int)wgbase[C.wg * 8 + e1] + (int)a.w;
        pos[(size_t)m * 2] = p0; pos[(size_t)m * 2 + 1] = p1; tok[p0] = m; tok[p1] = m;
    }
    __syncthreads();
}
template <int NEXT>
__device__ __forceinline__ void moe_combine(const Ctx& C, int l, int nrows) {
    const unsigned* route = WSP(const unsigned, WS_ROUTE); const int* pos = WSP(const int, WS_POS); const bf16* ym = WSP(const bf16, WS_MIX);
    const float* modv = WSP(const float, WS_MODV) + (size_t)l * 9 * 6144 + 5 * 1024;
    const float* modn = WSP(const float, WS_MODV) + (size_t)(l + 1) * 9 * 6144;
    float* xc = WSP(float, WS_XC); bf16* hb = WSP(bf16, WS_HB);
    const int gw = C.wg * NWAVES + C.wave, NGW = C.G * NWAVES;
    f32x4 gn[4];
#pragma unroll
    for (int j = 0; j < 4; ++j) gn[j] = *(const f32x4*)((NEXT == 2 ? C.in[I_FNG] : C.in[I_NMIXG] + (NEXT == 1 ? (l + 1) * 1024 : 0)) + 4 * C.lane + 256 * j);
    for (int m = gw; m < nrows; m += NGW) {
        const bool isctx = m >= T_LAT;
        float* xr = isctx ? xc + (size_t)(m - T_LAT) * 1024 : C.out + (size_t)m * 1024;
        const int mrow = isctx ? 8 : (m >> 12);
        const float* gv = modv + (size_t)mrow * 6144;
        const int p0 = pos[(size_t)m * 2], p1 = pos[(size_t)m * 2 + 1];
        const float w0 = __builtin_bit_cast(float, route[(size_t)m * 8 + 4]), w1 = __builtin_bit_cast(float, route[(size_t)m * 8 + 5]);
        f32x4 x[4]; float ss = 0.f;
#pragma unroll
        for (int j = 0; j < 4; ++j) {
            const int col = 4 * C.lane + 256 * j;
            const v2u a = *(const v2u*)(ym + (size_t)p0 * 1024 + col), b = *(const v2u*)(ym + (size_t)p1 * 1024 + col);
            const f32x4 ya = (f32x4){bflo(a.x), bfhi(a.x), bflo(a.y), bfhi(a.y)}, yb = (f32x4){bflo(b.x), bfhi(b.x), bflo(b.y), bfhi(b.y)};
            const f32x4 g = *(const f32x4*)(gv + col);
            x[j] = *(const f32x4*)(xr + col) + g * (ya * w0 + yb * w1);
            if (NEXT != 2) *(f32x4*)(xr + col) = x[j];
            ss += (x[j].x * x[j].x + x[j].y * x[j].y) + (x[j].z * x[j].z + x[j].w * x[j].w);
        }
        if (NEXT != 0) {
            const float rs = rsqrtf_(wave_sum(ss) * (1.0f / 1024.0f) + 1e-6f);
#pragma unroll
            for (int j = 0; j < 4; ++j) {
                const int col = 4 * C.lane + 256 * j;
                if (NEXT == 2) *(f32x4*)(xr + col) = x[j] * rs * gn[j];
                else { const f32x4 sh = *(const f32x4*)(modn + (size_t)mrow * 6144 + col), scl = *(const f32x4*)(modn + (size_t)mrow * 6144 + 1024 + col);
                    st4bf(hb + (size_t)m * 1024 + col, (x[j] * rs * gn[j]) * (scl + 1.0f) + sh); }
            }
        }
    }
}
__device__ __forceinline__ void final_norm(const Ctx& C) {
    const int gw = C.wg * NWAVES + C.wave, NGW = C.G * NWAVES;
    f32x4 gv[4];
#pragma unroll
    for (int j = 0; j < 4; ++j) gv[j] = *(const f32x4*)(C.in[I_FNG] + 4 * C.lane + 256 * j);
    for (int m = gw; m < T_LAT; m += NGW) {
        float* xr = C.out + (size_t)m * 1024;
        f32x4 v[4]; float s = 0.f;
#pragma unroll
        for (int j = 0; j < 4; ++j) { v[j] = *(const f32x4*)(xr + 4 * C.lane + 256 * j); s += (v[j].x * v[j].x + v[j].y * v[j].y) + (v[j].z * v[j].z + v[j].w * v[j].w); }
        const float rs = rsqrtf_(wave_sum(s) * (1.0f / 1024.0f) + 1e-6f);
#pragma unroll
        for (int j = 0; j < 4; ++j) *(f32x4*)(xr + 4 * C.lane + 256 * j) = v[j] * rs * gv[j];
    }
}

constexpr int NPH_L = 13, PH_FINAL = 1 + DEPTH * NPH_L, NPHASE = PH_FINAL + 1;
__host__ __device__ inline bool phase_exists(int ph) {
    if (ph == 0) return true;
    if (ph == PH_FINAL) return false;
    const int l = (ph - 1) / NPH_L, k = (ph - 1) % NPH_L;
    if (l >= 2 && !(l & 1) && k == 0) return false;
    if (!(l & 1) && k >= 11) return false;
    if (!RW_VSPLIT && k == 4) return false;
    return true;
}
#ifndef PH_MASK
#define PH_MASK 0xFFFFFF
#endif
#define PM(k) ((PH_MASK >> (k)) & 1)
#ifndef SK_MASK
#define SK_MASK 0xFFFF
#endif
#define SK(k) ((SK_MASK >> (k)) & 1)
#ifndef REP_MASK
#define REP_MASK 0
#endif
#define NREP(k) (((REP_MASK >> (k)) & 1) ? 2 : 1)

__global__ void __launch_bounds__(NTHR, 2) fwd_kernel(Args args) {
    extern __shared__ __attribute__((aligned(16))) unsigned char lds_raw[];
    Ctx C; C.in = args.in; C.out = args.out; C.ws = args.ws; C.lds = (LAS unsigned char*)lds_raw;
    C.tid = threadIdx.x; C.lane = C.tid & 63; C.wave = __builtin_amdgcn_readfirstlane(C.tid >> 6); C.G = gridDim.x; C.wg = blockIdx.x;
    volatile LAS unsigned* MISC = (volatile LAS unsigned*)(C.lds + MISC_OFF);
    if (C.tid < 64) MISC[C.tid] = 0u;
    __syncthreads();
    const int lo = args.ph_lo, hi = args.ph_hi;
    const bool multi = (hi - lo) > 1;
    if (multi) (void)xcd_barrier_post(WSP(unsigned, WS_CTL) + CW_BAR, MISC + 8);
#define IN(k) (lo <= (k) && (k) < hi)
#define SEAM(k) do { if (IN((k) + 1)) { XcdBarrier b2_; b2_.bar = WSP(unsigned, WS_CTL) + CW_BAR; b2_.x = xb_xcc_id(); b2_.st = (volatile LAS unsigned*)(C.lds + MISC_OFF) + 8; xcd_barrier(b2_); } } while (0)
#define FRESH() do { int t_ = threadIdx.x; asm volatile("" : "+v"(t_)); C.tid = t_; C.lane = t_ & 63; C.wave = __builtin_amdgcn_readfirstlane(t_ >> 6); } while (0)
#define PHASE(bit, k) if (PM(bit) && IN(pb + (k))) for (int rep_ = 0; rep_ < NREP(bit); ++rep_)
#define CLAIM(qh, var) __syncthreads(); if (C.tid == 0) *qslot = atomicAdd((qh), 1u); __syncthreads(); const int var = (int)*qslot;

    LAS unsigned* qslot = (LAS unsigned*)(C.lds + MISC_OFF + 128);
    if (PM(20) && IN(0)) { phase_pre(C); SEAM(0); }

#pragma unroll 1
    for (int l = 0; l < DEPTH; ++l) {
        const int pb = 1 + l * NPH_L;
        if (hi <= pb || lo >= pb + NPH_L) continue;
        const bool last = (l == DEPTH - 1), moe = (l & 1);
        const int nrows = last ? T_LAT : T_ALL;
        const float* xlat = (l == 0) ? C.in[I_X] : C.out; const float* xctx = (l == 0) ? C.in[I_CTX] : WSP(const float, WS_XC);
        const float* modv = WSP(const float, WS_MODV) + (size_t)l * 9 * 6144;
        unsigned* qbase = WSP(unsigned, WS_CTL) + CW_PREPQ + 256 * l;

        if (!(l >= 2 && !(l & 1))) PHASE(0, 0) { FRESH();
            convert_small(C, l);
            if (l == 0) { FRESH(); convert_items(C, 0, 3, C.wg * NWAVES + C.wave, C.G * NWAVES); }
            __syncthreads();
            FRESH(); norm_rows<false>(C, l, xlat, xctx, C.in[I_NMIXG] + l * 1024, 0, 1024, T_ALL, 0);
            SEAM(pb + 0);
        }
        PHASE(1, 1) { FRESH();
            pg8::Gemm g{WSP(const bf16, WS_HB), WSP(const bf16, WS_WIN), T_ALL, PLD, 1024, 0};
            pg8::StaticOrder S; S.init(T_ALL, PLD, C.G, C.wg);
            pg8::EpiBf16<0> E{WSP(bf16, WS_P), PLD, nullptr, 0, 0};
            pg8::gemm_phase<pg8::EpiBf16<0>, pg8::StaticOrder, false>(C.lds, g, S, E, nullptr);
            SEAM(pb + 1);
        }
        if (PM(2) && IN(pb + 2)) for (int rep_ = 0; rep_ < NREP(2); ++rep_) { FRESH();
            for (;;) {
                CLAIM(qbase + 16 * rep_, k)
                if (k >= 2 * NB * NCH) break;
                const int kind = k / (NB * NCH), u = k % (NB * NCH);
                FRESH();
                if (kind == 0) { for (int r3_ = 0; r3_ < NREP(24); ++r3_) { FRESH(); if (SK(1)) rwkv_prep2(C, l, u / NCH, u % NCH); } }
                else { for (int r3_ = 0; r3_ < NREP(26); ++r3_) { FRESH(); if (SK(2)) gdn_prep(C, l, u / NCH, u % NCH); } }
            }
            SEAM(pb + 2);
        }
        if (PM(3) && IN(pb + 3)) for (int rep_ = 0; rep_ < NREP(3); ++rep_) { FRESH();
            constexpr int NCL = 2 * NB * NH * NCH / 4;
            for (;;) {
                CLAIM(qbase + 64 + 16 * rep_, k)
                if (k >= NCL) break;
                FRESH();
                if (SK(10)) rwkv_solve_item(C, l, 4 * k + (C.wave >> 1));
            }
            SEAM(pb + (RW_VSPLIT ? 3 : 4));
        }
#if RW_VSPLIT
        if (PM(3) && IN(pb + 4)) { FRESH();
            for (;;) {
                CLAIM(qbase + 128, k)
                if (k >= 2 * NB * NH * NCH / 4) break;
                FRESH();
                if (SK(10)) rwkv_solve_item(C, l, 4 * k + (C.wave >> 1));
            }
            SEAM(pb + 4);
        }
#endif
        if (PM(4) && IN(pb + 5)) { FRESH();
            if (C.wg >= 64) {
                constexpr int NCL = 2 * NB * NH * NCH / 4;
                for (;;) {
                    CLAIM(qbase + 128, k)
                    if (k >= NCL) break;
                    FRESH();
                    if (SK(9)) gdn_solve_item(C, l, 4 * k + (C.wave >> 1));
                }
                asm volatile("s_waitcnt vmcnt(0)" ::: "memory");
                __syncthreads();
                if (C.tid == 0) { __builtin_amdgcn_fence(__ATOMIC_RELEASE, "agent"); asm volatile("s_waitcnt vmcnt(0)" ::: "memory"); (void)xb_add(qbase + 160, 1u); }
                if (C.wg >= 192) {
                    if (C.tid == 0) { unsigned* bar_ = WSP(unsigned, WS_CTL) + CW_BAR; XB_SPIN(xb_ld(qbase + 160) < (unsigned)(C.G - 64), bar_); __builtin_amdgcn_fence(__ATOMIC_ACQUIRE, "agent"); asm volatile("s_waitcnt vmcnt(0)" ::: "memory"); }
                    __syncthreads();
                }
                FRESH();
            }
            if (C.wg >= 64 && C.wg < 128) { if (SK(0)) lru_chain(C, l, C.wg - 64); FRESH(); }
            if (SK(3) && C.wg < (RW_VSPLIT ? 128 : 64)) { if (NREP(20) > 1) { FRESH(); rwkv_chunked<true>(C, l, C.wg); } FRESH(); rwkv_chunked<false>(C, l, C.wg); }
            else if (SK(4) && C.wg >= 128 && C.wg < 192) { for (int r2_ = 0; r2_ < NREP(21); ++r2_) { FRESH(); mlstm_chunked(C, l, C.wg - 128); } }
            else if (SK(5) && C.wg >= 192) { if (NREP(22) > 1) { FRESH(); gdn_chunked<true>(C, l, C.wg - 192); } FRESH(); gdn_chunked<false>(C, l, C.wg - 192); }
            {
                FRESH();
                const int nun = 0;
                for (;;) {
                    CLAIM(qbase + 192, u0)
                    if (u0 >= 128 + nun) break;
                    if (u0 < 128) {
                        FRESH(); if (l > 0) convert_items(C, l, 2, u0 * NWAVES + C.wave, 128 * NWAVES);
                        if (l + 1 < DEPTH) { FRESH(); convert_items(C, l + 1, 1, u0 * NWAVES + C.wave, 128 * NWAVES); }
                    }
                }
            }
            SEAM(pb + 5);
        }
        PHASE(5, 6) { FRESH();
            if (SK(8)) finish_rows(C, l, nrows);
            SEAM(pb + 6);
        }
        if (PM(6) && IN(pb + 7)) { FRESH();
            pg8::Gemm g{WSP(const bf16, WS_HB), WSP(const bf16, WS_WOUT), nrows, 1024, 1024, 0};
            pg8::StaticOrder S; S.init(nrows, 1024, C.G, C.wg);
            pg8::EpiRes E{xlat, xctx, C.out, WSP(float, WS_XC), modv + 2 * 1024};
            pg8::gemm_phase<pg8::EpiRes, pg8::StaticOrder, false>(C.lds, g, S, E, nullptr);
            SEAM(pb + 7);
        }
        if (PM(7) && IN(pb + 8)) { FRESH();
            if (moe) norm_rows<true>(C, l, C.out, WSP(const float, WS_XC), C.in[I_NFFNG] + l * 1024, 3 * 1024, 4 * 1024, nrows, l >> 1);
            else norm_rows<false>(C, l, C.out, WSP(const float, WS_XC), C.in[I_NFFNG] + l * 1024, 3 * 1024, 4 * 1024, nrows, 0);
            SEAM(pb + 8);
        }
        if (!moe) {
            if (PM(8) && IN(pb + 9)) for (int rep_ = 0; rep_ < NREP(8); ++rep_) { FRESH();
                pg8::Gemm g{WSP(const bf16, WS_HB), WSP(const bf16, WS_WGU), nrows, 2 * DFF, 1024, 0};
                pg8::StaticOrder S; S.init(nrows, 2 * DFF, C.G, C.wg);
                pg8::EpiSwiglu E{WSP(bf16, WS_P), DFF};
                pg8::gemm_phase<pg8::EpiSwiglu, pg8::StaticOrder, false>(C.lds, g, S, E, nullptr);
                SEAM(pb + 9);
            }
            if (PM(9) && IN(pb + 10)) { FRESH();
                pg8::Gemm g{WSP(const bf16, WS_P), WSP(const bf16, WS_WDN), nrows, 1024, DFF, 0};
                pg8::StaticOrder S; S.init(nrows, 1024, C.G, C.wg);
                pg8::EpiRes E{C.out, WSP(const float, WS_XC), C.out, WSP(float, WS_XC), modv + 5 * 1024};
                pg8::gemm_phase<pg8::EpiRes, pg8::StaticOrder, false>(C.lds, g, S, E, nullptr);
                SEAM(pb + 12);
            }
        } else {
            if (PM(10) && IN(pb + 9)) { FRESH(); moe_scatter(C, l >> 1, nrows); SEAM(pb + 9); }
            if (PM(11) && IN(pb + 10)) for (int rep_ = 0; rep_ < NREP(11); ++rep_) { FRESH();
                pg8::Gemm g{WSP(const bf16, WS_HB), WSP(const bf16, WS_WGU), 0, 2 * DFE, 1024, (size_t)2 * DFE * 1024};
                pg8::MoeOrderG S; S.init(WSP(const int, WS_TAB), (2 * DFE) / 256, C.G, C.wg); S.tok = WSP(const int, WS_TOK);
                pg8::EpiSwiglu E{WSP(bf16, WS_P), DFE};
                pg8::gemm_phase<pg8::EpiSwiglu, pg8::MoeOrderG, false>(C.lds, g, S, E, nullptr);
                SEAM(pb + 10);
            }
            if (PM(12) && IN(pb + 11)) for (int rep_ = 0; rep_ < NREP(12); ++rep_) { FRESH();
                pg8::Gemm g{WSP(const bf16, WS_P), WSP(const bf16, WS_WDN), 0, 1024, DFE, (size_t)1024 * DFE};
                pg8::MoeOrder S; S.init(WSP(const int, WS_TAB), 4, C.G, C.wg);
                pg8::EpiBf16<0> E{WSP(bf16, WS_MIX), 1024, nullptr, 0, 0};
                pg8::gemm_phase<pg8::EpiBf16<0>, pg8::MoeOrder, false>(C.lds, g, S, E, nullptr);
                SEAM(pb + 11);
            }
            if (PM(13) && IN(pb + 12)) { FRESH();
                if (last) moe_combine<2>(C, l, nrows);
                else { convert_small(C, l + 1); FRESH(); moe_combine<1>(C, l, nrows); if (IN(pb + NPH_L + 1)) { XcdBarrier b2_; b2_.bar = WSP(unsigned, WS_CTL) + CW_BAR; b2_.x = xb_xcc_id(); b2_.st = (volatile LAS unsigned*)(C.lds + MISC_OFF) + 8; xcd_barrier(b2_); } }
            }
        }
    }
}

extern "C" void kernel_launch(void* const* d_in, const int* in_sizes, int n_in, void* d_out, int out_size, void* d_ws, size_t ws_size, hipStream_t stream) {
    static int grid = 0;
    if (grid == 0) {
        if (n_in != N_IN || in_sizes[0] != T_LAT * DM || out_size != T_LAT * DM || ws_size < WS_END) {
            fprintf(stderr, "kernel_launch: unexpected problem (n_in %d, in0 %d, out %d, ws %zu < %zu)\n", n_in, n_in > 0 ? in_sizes[0] : -1, out_size, ws_size, (size_t)WS_END); grid = -1; return; }
        int dev = 0, cus = 0, per_cu = 0;
        if (hipGetDevice(&dev) != hipSuccess || hipDeviceGetAttribute(&cus, hipDeviceAttributeMultiprocessorCount, dev) != hipSuccess) { grid = -1; return; }
        if (hipFuncSetAttribute((const void*)fwd_kernel, hipFuncAttributeMaxDynamicSharedMemorySize, LDS_BYTES) != hipSuccess) { fprintf(stderr, "kernel_launch: hipFuncSetAttribute failed\n"); grid = -1; return; }
        if (hipOccupancyMaxActiveBlocksPerMultiprocessor(&per_cu, (const void*)fwd_kernel, NTHR, LDS_BYTES) != hipSuccess || per_cu < 1) { fprintf(stderr, "kernel_launch: occupancy query says %d\n", per_cu); grid = -1; return; }
        grid = cus;
        if (grid != 256) fprintf(stderr, "kernel_launch: note: %d CUs\n", grid);
    }
    if (grid < 0) return;
    if (hipMemsetAsync((char*)d_ws + WS_CTL, 0, CTL_BYTES, stream) != hipSuccess) return;
    Args a{};
    for (int i = 0; i < N_IN; ++i) a.in[i] = (const float*)d_in[i];
    a.out = (float*)d_out; a.ws = (unsigned char*)d_ws;
#if MK_ONE_LAUNCH
    a.ph_lo = 0; a.ph_hi = NPHASE;
    hipLaunchKernelGGL(fwd_kernel, dim3(grid), dim3(NTHR), LDS_BYTES, stream, a);
#else
    for (int ph = 0; ph < NPHASE; ++ph) { if (!phase_exists(ph)) continue; a.ph_lo = ph; a.ph_hi = ph + 1; hipLaunchKernelGGL(fwd_kernel, dim3(grid), dim3(NTHR), LDS_BYTES, stream, a); }
#endif
}
```

```cpp
#define MK_ONE_LAUNCH 1
#include <hip/hip_runtime.h>
#include <cstdio>
#include <cstdint>

#define GAS __attribute__((address_space(1)))
#define LAS __attribute__((address_space(3)))
typedef unsigned short bf16;
typedef unsigned v4u __attribute__((ext_vector_type(4)));
typedef unsigned v2u __attribute__((ext_vector_type(2)));
typedef float f32x4 __attribute__((ext_vector_type(4)));
typedef float f32x2 __attribute__((ext_vector_type(2)));
typedef short bf16x8 __attribute__((ext_vector_type(8)));
#define LDS_WAIT() asm volatile("s_waitcnt lgkmcnt(0)" ::: "memory")
#define VM_WAIT() asm volatile("s_waitcnt vmcnt(0)" ::: "memory")

constexpr int DM = 1024, NB = 8, SEQ = 4096, DEPTH = 4, CTXL = 256, GW = 256, HD = 64, NH = 4;
constexpr int T_LAT = NB * SEQ, T_CTX = NB * CTXL, T_ALL = T_LAT + T_CTX;
constexpr int IN_COLS = 3552, PLD = 3584;
constexpr int OFF_B = 512, OFF_C = 1472, OFF_D = 2512, B_COLS = 960;
constexpr int DFF = 2816, NE = 8, DFE = 1408;
constexpr int NCH = 68;
constexpr int NSTEP = 4352;
constexpr int MOE_MAXBLK = 280;
constexpr int NWAVES = 8, NTHR = 512;
#ifndef RW_VSPLIT
#define RW_VSPLIT 0
#endif

constexpr size_t MiB = 1u << 20;
constexpr size_t WS_CTL = 0, CTL_BYTES = 1 * MiB;
constexpr size_t WS_MODV = 1 * MiB;
constexpr size_t WS_XC = 2 * MiB;
constexpr size_t WS_WIN = 10 * MiB;
constexpr size_t WS_WOUT = 17 * MiB;
constexpr size_t WS_WGU = 19 * MiB;
constexpr size_t WS_WDN = 63 * MiB;
constexpr size_t WS_HB = 85 * MiB;
constexpr size_t WS_P = 153 * MiB;
constexpr size_t WS_MIX = 391 * MiB;
constexpr size_t WS_OUTB = WS_MIX, WS_OUTC = WS_MIX + 34 * MiB, WS_OUTD = WS_MIX + 68 * MiB, WS_GQ = WS_MIX + 102 * MiB, WS_G = WS_MIX + 153 * MiB;
constexpr size_t WS_RKV = WS_MIX + 170 * MiB;
constexpr size_t WS_SMALL = 612 * MiB;
constexpr size_t WS_ROUTE = WS_SMALL;
constexpr size_t WS_POS = WS_SMALL + 1280 * 1024;
constexpr size_t WS_TOK = WS_SMALL + 1664 * 1024;
constexpr size_t WS_BONUS = WS_SMALL + 2 * MiB;
constexpr size_t WS_RINV = WS_SMALL + 2 * MiB + 640 * 1024;
constexpr size_t WS_WGBASE = WS_SMALL + 3 * MiB + 256 * 1024;
constexpr size_t WS_TAB = WS_WGBASE + 65536;
constexpr size_t WS_LRUWT = WS_SMALL + 3 * MiB + 512 * 1024;
constexpr size_t WS_RWT = WS_LRUWT + 131072;
constexpr size_t WS_LRUH = WS_SMALL + 4 * MiB;
constexpr size_t WS_END = 633 * MiB;
constexpr int CW_MOECNT = 1024;
constexpr int CW_PREPQ = 2048;
constexpr int CW_BAR = 4096;

constexpr int LDS_BYTES = 135168;
constexpr int MISC_OFF = 131072;

__device__ __forceinline__ unsigned f2bf(float f) { unsigned u = __builtin_bit_cast(unsigned, f); return (u + 0x7fffu + ((u >> 16) & 1u)) >> 16; }
typedef __bf16 bf16n2 __attribute__((ext_vector_type(2)));
__device__ __forceinline__ unsigned pk2(float lo, float hi) { const f32x2 v = {lo, hi}; return __builtin_bit_cast(unsigned, __builtin_convertvector(v, bf16n2)); }
__device__ __forceinline__ unsigned f2bf1(float f) { return pk2(f, f) & 0xffffu; }
__device__ __forceinline__ float bf2f(unsigned short v) { return __builtin_bit_cast(float, (unsigned)v << 16); }
__device__ __forceinline__ float bflo(unsigned v) { return __builtin_bit_cast(float, v << 16); }
__device__ __forceinline__ float bfhi(unsigned v) { return __builtin_bit_cast(float, v & 0xffff0000u); }
template <int CTRL, int RM, bool BC> __device__ __forceinline__ float dpp_x(float oldv, float v) { return __builtin_bit_cast(float, __builtin_amdgcn_update_dpp(__builtin_bit_cast(int, oldv), __builtin_bit_cast(int, v), CTRL, RM, 0xF, BC)); }
__device__ __forceinline__ float wave_sum(float v) {
    v += dpp_x<0xB1, 0xF, true>(0.f, v); v += dpp_x<0x4E, 0xF, true>(0.f, v); v += dpp_x<0x141, 0xF, true>(0.f, v); v += dpp_x<0x140, 0xF, true>(0.f, v);
    v += dpp_x<0x142, 0xA, false>(0.f, v); v += dpp_x<0x143, 0xC, false>(0.f, v);
    return __builtin_bit_cast(float, __builtin_amdgcn_readlane(__builtin_bit_cast(int, v), 63));
}
template <int CTRL> __device__ __forceinline__ float dpp_f(float v) { return __builtin_bit_cast(float, __builtin_amdgcn_update_dpp(0, __builtin_bit_cast(int, v), CTRL, 0xF, 0xF, true)); }
__device__ __forceinline__ float row16_sum(float v) {
    v += dpp_f<0xB1>(v);
    v += dpp_f<0x4E>(v);
    v += dpp_f<0x141>(v);
    v += dpp_f<0x140>(v);
    return v;
}
__device__ __forceinline__ float sigmoidf_(float x) { return __builtin_amdgcn_rcpf(1.0f + __expf(-x)); }
__device__ __forceinline__ float softplusf_(float x) { return fmaxf(x, 0.f) + __logf(1.0f + __expf(-fabsf(x))); }
__device__ __forceinline__ float expm1f_(float x) { return x > -0.3f ? x * (1.0f + x * (0.5f + x * (0.16666667f + x * (0.041666668f + x * 0.0083333338f)))) : __expf(x) - 1.0f; }
__device__ __forceinline__ float siluf_(float x) { return x * __builtin_amdgcn_rcpf(1.0f + __expf(-x)); }
__device__ __forceinline__ float tanhf_(float x) { const float e = __expf(2.0f * x); return 1.0f - 2.0f * __builtin_amdgcn_rcpf(e + 1.0f); }
__device__ __forceinline__ float rsqrtf_(float x) { return __builtin_amdgcn_rsqf(x); }
__device__ __forceinline__ float gelu_tanh(float x) { return 0.5f * x * (1.0f + tanhf_(0.7978845608028654f * (x + 0.044715f * x * x * x))); }
__device__ __forceinline__ f32x4 ld4bf(const bf16* p) { const v2u a = *(const v2u*)p; return (f32x4){bflo(a.x), bfhi(a.x), bflo(a.y), bfhi(a.y)}; }
__device__ __forceinline__ void st4bf(bf16* p, const f32x4& v) { v2u o; o.x = pk2(v.x, v.y); o.y = pk2(v.z, v.w); *(v2u*)p = o; }
#define XB_TMO      128
#define XB_XCNT(j)  (256  + 64 * (j))
#define XB_XSUB(j)  (1280 + 64 * (j))
#define XB_XGEN(j)  (2304 + 64 * (j))
#define XB_TOP      3328
#define XB_TOPGEN   3392
#define XCD_BAR_WORDS 3456
#define XB_SPIN_CAP (1u << 22)

__device__ __forceinline__ unsigned xb_ld(unsigned* p)              { return __hip_atomic_load(p, __ATOMIC_RELAXED, __HIP_MEMORY_SCOPE_AGENT); }
__device__ __forceinline__ unsigned xb_add(unsigned* p, unsigned v) { return __hip_atomic_fetch_add(p, v, __ATOMIC_RELAXED, __HIP_MEMORY_SCOPE_AGENT); }
__device__ __forceinline__ unsigned xb_xcc_id() { return (unsigned)__builtin_amdgcn_s_getreg((3 << 11) | 20) & 0xFu; }
#define XB_SPIN(cond, bar) do { unsigned _sp = 0; while (cond) { __builtin_amdgcn_s_sleep(1); \
    if ((++_sp & 255u) == 0u) { if (xb_ld(&(bar)[XB_TMO])) break; if (_sp > XB_SPIN_CAP) { atomicAdd(&(bar)[XB_TMO], 1u); break; } } } } while (0)

struct XcdBarrier {
    unsigned* bar; unsigned x;
    volatile LAS unsigned* st;
};

__device__ __forceinline__ XcdBarrier xcd_barrier_post(unsigned* bar, volatile LAS unsigned* st) {
    XcdBarrier b; b.bar = bar; b.x = xb_xcc_id(); b.st = st;
    if (threadIdx.x == 0) (void)xb_add(&bar[XB_XCNT(b.x)], 1u);
    return b;
}
__device__ __forceinline__ void xcd_barrier_complete(unsigned* bar, unsigned x, unsigned& nloc, unsigned& nx) {
    const unsigned G = gridDim.x * gridDim.y * gridDim.z;
    unsigned sum, cnt, mine, sp = 0u;
    for (;;) {
        sum = 0u; cnt = 0u; mine = 0u;
#pragma unroll
        for (unsigned j = 0; j < 16; ++j) { const unsigned c = xb_ld(&bar[XB_XCNT(j)]); sum += c; cnt += (c > 0u) ? 1u : 0u; mine = (j == x) ? c : mine; }
        if (sum == G) break;
        __builtin_amdgcn_s_sleep(1);
        if ((++sp & 255u) == 0u) { if (xb_ld(&bar[XB_TMO])) break; if (sp > XB_SPIN_CAP) { atomicAdd(&bar[XB_TMO], 1u); break; } }
    }
    nloc = mine > 0u ? mine : 1u; nx = cnt > 0u ? cnt : 1u;
}

__device__ __forceinline__ void xcd_barrier(const XcdBarrier& b) {
    asm volatile("s_waitcnt vmcnt(0)" ::: "memory");
    __syncthreads();
    if (threadIdx.x == 0) {
        unsigned* bar = b.bar;
        __builtin_amdgcn_s_waitcnt(0);
        unsigned nloc = b.st[0], nx = b.st[1];
        if (nloc == 0u) { xcd_barrier_complete(bar, b.x, nloc, nx); b.st[0] = nloc; b.st[1] = nx; }
        const unsigned old = xb_add(&bar[XB_XSUB(b.x)], 1u);
        const unsigned gen = old / nloc;
        if (old + 1u == (gen + 1u) * nloc) {
            __builtin_amdgcn_fence(__ATOMIC_RELEASE, "agent");
            asm volatile("s_waitcnt vmcnt(0)" ::: "memory");
            const unsigned og = xb_add(&bar[XB_TOP], 1u);
            const unsigned tg = og / nx;
            if (og + 1u == (tg + 1u) * nx) xb_add(&bar[XB_TOPGEN], 1u);
            else XB_SPIN(xb_ld(&bar[XB_TOPGEN]) == tg, bar);
            __builtin_amdgcn_fence(__ATOMIC_ACQUIRE, "agent");
            xb_add(&bar[XB_XGEN(b.x)], 1u);
            asm volatile("s_waitcnt vmcnt(0)" ::: "memory");
        } else {
            XB_SPIN(xb_ld(&bar[XB_XGEN(b.x)]) == gen, bar);
            __builtin_amdgcn_fence(__ATOMIC_ACQUIRE, "agent");
            asm volatile("s_waitcnt vmcnt(0)" ::: "memory");
        }
    }
    __syncthreads();
}

namespace pg8 {
#define PG8_LAS __attribute__((address_space(3)))
typedef unsigned short bf16_t;
typedef short bf16x8 __attribute__((ext_vector_type(8)));
typedef float f32x4 __attribute__((ext_vector_type(4)));
typedef unsigned u32x4 __attribute__((ext_vector_type(4)));
constexpr int BM = 256, BK = 64, HALF = 128, HTB = HALF * BK * 2  , STAGE_BYTES = 8 * HTB, NXCD = 8, WGM = 8;

__host__ __device__ __forceinline__ int lds_byte(int r, int c) { const int st = (r >> 4) * 2 + (c >> 5), rr = r & 15, cc = c & 31, ob = rr * 64 + cc * 2; return st * 1024 + (ob ^ (((ob >> 9) & 1) << 5)); }
__host__ __device__ __forceinline__ void stage_rc(int b, int& R, int& C) { const int st = b / 1024, sb = b % 1024, swz = sb ^ (((sb >> 9) & 1) << 5); R = (st >> 1) * 16 + swz / 64; C = (st & 1) * 32 + (swz % 64) / 2; }
__host__ __device__ __forceinline__ int perm32(int rho) { const int n = rho >> 4, i = rho & 15; return 8 * (i >> 2) + 4 * n + (i & 3); }

struct Unit { int pm, pn, e; };
struct Gemm { const bf16_t* A; const bf16_t* Bt; int M, N, K; size_t estride; };

struct StaticOrder {
    static constexpr bool GATHER = false;
    int nM, nN, nwg, G, c;
    __host__ __device__ void init(int M, int N, int G_, int c_) { nM = M / BM; nN = N / BM; nwg = nM * nN; G = G_; c = c_; }
    __host__ __device__ bool next(int i, Unit& u) const {
        const long L = (long)i * G + c; if (L >= nwg) return false;
        int wgid = (int)L; { const int q = nwg / NXCD, r = nwg % NXCD, xcd = wgid % NXCD, off = wgid / NXCD; wgid = (xcd < r ? xcd * (q + 1) : r * (q + 1) + (xcd - r) * q) + off; }
        const int nig = WGM * nN, gid = wgid / nig, fm = gid * WGM, gsz = (nM - fm) < WGM ? (nM - fm) : WGM;
        u.pm = fm + ((wgid % nig) % gsz); u.pn = (wgid % nig) / gsz; u.e = 0; return true;
    }
    __device__ __forceinline__ void a_ready(const Unit&) const {}
    __device__ __forceinline__ void done(const Unit&) const {}
};
__device__ __forceinline__ unsigned cvt_pk_bf16(float lo, float hi) { unsigned r; asm volatile("v_cvt_pk_bf16_f32 %0, %1, %2" : "=v"(r) : "v"(lo), "v"(hi)); return r; }
typedef float f32x2 __attribute__((ext_vector_type(2)));
__device__ __forceinline__ f32x2 gelu_pk(f32x2 v) {
    const f32x2 av = __builtin_elementwise_abs(v), d = av * 0.2316418882f + 1.0f;
    f32x2 t; t.x = __builtin_amdgcn_rcpf(d.x); t.y = __builtin_amdgcn_rcpf(d.y);
    f32x2 q = t * 0.5307027145f + (-0.7265760135f); q = q * t + 0.7107068705f; q = q * t + (-0.142248368f); q = q * t + 0.127414796f; q = q * t;
    const f32x2 s = (v * v) * (-0.72134752044f);
    f32x2 e; e.x = __builtin_amdgcn_exp2f(s.x); e.y = __builtin_amdgcn_exp2f(s.y);
    const f32x2 m = v * (q * e), r = v - m;
    f32x2 o; o.x = v.x < 0.f ? m.x : r.x; o.y = v.y < 0.f ? m.y : r.y; return o;
}

struct EpiF32 {
    static constexpr bool PERM = false, AFTER_DRAIN = false;
    float* C; int ldc; const float* bias;
    __device__ __forceinline__ void operator()(const f32x4 (&acc)[2][2][4][2], const Unit& u, int wr, int wc, int fr, int fq) const {
        const int row0 = u.pm * BM + wr * 64 + fr, col0 = u.pn * BM + wc * 32 + 4 * fq;
        f32x4 bv[2][2];
#pragma unroll
        for (int bj = 0; bj < 2; ++bj)
#pragma unroll
            for (int n = 0; n < 2; ++n) bv[bj][n] = bias ? *(const f32x4*)(bias + col0 + bj * HALF + n * 16) : (f32x4){0.f, 0.f, 0.f, 0.f};
#pragma unroll
        for (int ai = 0; ai < 2; ++ai)
#pragma unroll
            for (int m = 0; m < 4; ++m) { float* rowp = C + (size_t)(row0 + ai * HALF + m * 16) * ldc + col0;
#pragma unroll
                for (int bj = 0; bj < 2; ++bj)
#pragma unroll
                    for (int n = 0; n < 2; ++n) *(f32x4*)(rowp + bj * HALF + n * 16) = acc[ai][bj][m][n] + bv[bj][n]; }
    }
};
template <int ACT  > struct EpiBf16 {
    static constexpr bool PERM = true, AFTER_DRAIN = false;
    bf16_t* O; int ldc; const float* bias; int split_cols; size_t split_stride;
    __device__ __forceinline__ void operator()(const f32x4 (&acc)[2][2][4][2], const Unit& u, int wr, int wc, int fr, int fq) const {
        const int row0 = u.pm * BM + wr * 64 + fr; int colt = u.pn * BM; bf16_t* base = O;
        if (split_cols) { const int t = colt / split_cols; base += (size_t)t * split_stride; colt -= t * split_cols; }
        const int col0 = colt + wc * 32 + 8 * fq, bcol0 = u.pn * BM + wc * 32 + 8 * fq;
        f32x4 bv[2][2];
#pragma unroll
        for (int bj = 0; bj < 2; ++bj)
#pragma unroll
            for (int n = 0; n < 2; ++n) bv[bj][n] = bias ? *(const f32x4*)(bias + bcol0 + bj * HALF + 4 * n) : (f32x4){0.f, 0.f, 0.f, 0.f};
#pragma unroll
        for (int ai = 0; ai < 2; ++ai)
#pragma unroll
            for (int m = 0; m < 4; ++m) { bf16_t* rowp = base + (size_t)(row0 + ai * HALF + m * 16) * ldc + col0;
#pragma unroll
                for (int bj = 0; bj < 2; ++bj) { f32x4 v0 = acc[ai][bj][m][0] + bv[bj][0], v1 = acc[ai][bj][m][1] + bv[bj][1];
                    if (ACT == 1) { f32x2 a = gelu_pk((f32x2){v0[0], v0[1]}), b = gelu_pk((f32x2){v0[2], v0[3]}), c = gelu_pk((f32x2){v1[0], v1[1]}), d = gelu_pk((f32x2){v1[2], v1[3]});
                        v0 = (f32x4){a.x, a.y, b.x, b.y}; v1 = (f32x4){c.x, c.y, d.x, d.y}; }
                    if (ACT == 2) {
#pragma unroll
                        for (int j = 0; j < 4; ++j) { v0[j] = 0.5f * v0[j] * (1.0f + erff(v0[j] * 0.70710678f)); v1[j] = 0.5f * v1[j] * (1.0f + erff(v1[j] * 0.70710678f)); } }
                    u32x4 w; w.x = cvt_pk_bf16(v0[0], v0[1]); w.y = cvt_pk_bf16(v0[2], v0[3]); w.z = cvt_pk_bf16(v1[0], v1[1]); w.w = cvt_pk_bf16(v1[2], v1[3]);
                    *(u32x4*)(rowp + bj * HALF) = w; } }
    }
};

template <class Epi, class Sched, bool STAMP = false>
__device__ __forceinline__ void gemm_phase(PG8_LAS unsigned char* lds, const Gemm g, const Sched& S, const Epi& E, unsigned long long* stamps) {
    int tid_ = threadIdx.x; asm volatile("" : "+v"(tid_));
    const int tid = tid_, wid = __builtin_amdgcn_readfirstlane(tid >> 6), lane = tid & 63, wr = wid >> 2, wc = wid & 3, fr = lane & 15, fq = lane >> 4;
    const int K = g.K, nt = K / BK;
    constexpr bool GATHER = Sched::GATHER;
    int ts_lo = 0, ts_hi = 0, nts = 0; const unsigned long long rt_entry = STAMP ? (unsigned long long)wall_clock64() : 0ull;
#define PG8_STAMP() do { if (STAMP && wid == 0 && nts < 64) { const unsigned long long _c = (unsigned long long)clock64(); \
        ts_lo = (lane == nts) ? (int)(unsigned)_c : ts_lo; ts_hi = (lane == nts) ? (int)(unsigned)(_c >> 32) : ts_hi; ++nts; } } while (0)
    PG8_STAMP();
    unsigned voffA[2], voffB[2]; int rowA[2];
#pragma unroll
    for (int i = 0; i < 2; ++i) { int R, C; stage_rc(tid * 16 + i * 8192, R, C); const int Rb = Epi::PERM ? ((R & ~31) + perm32(R & 31)) : R;
        rowA[i] = R; voffA[i] = GATHER ? (unsigned)C * 2u : (unsigned)(R * K + C) * 2u; voffB[i] = (unsigned)(Rb * K + C) * 2u; }
    const size_t kstep = (size_t)(BK * 2);
    const size_t hstep = (size_t)HALF * K * 2;
    const size_t tstep = 2 * hstep;
    const unsigned ldsw = (unsigned)wid * 1024u;
    const int aoff = lds_byte(wr * 64 + fr, fq * 8), boff = lds_byte(wc * 32 + fr, fq * 8);
#define PG8_SA(b, h) (((b) * 2 + (h)) * HTB)
#define PG8_SB(b, h) ((4 + (b) * 2 + (h)) * HTB)
#define PG8_STAGE(bufoff, gbase, voff) do { _Pragma("unroll") for (int _i = 0; _i < 2; ++_i) \
        __builtin_amdgcn_global_load_lds((const unsigned*)((const char*)(gbase) + (voff)[_i]), (PG8_LAS unsigned*)(lds + (bufoff) + ldsw + _i * 8192), 16, 0, 0); } while (0)
#define PG8_STAGE_A(bufoff, gbase, h, gv) do { if constexpr (GATHER) { PG8_STAGE(bufoff, gbase, (gv)[h]); } else { PG8_STAGE(bufoff, (gbase) + (h) * hstep, voffA); } } while (0)
#define PG8_TOKSLOT(s) ((PG8_LAS int*)(lds + STAGE_BYTES + 1024 + ((s) & 1) * 1024))
#define PG8_LDA(dst, b, h) do { _Pragma("unroll") for (int m = 0; m < 4; ++m) _Pragma("unroll") for (int k = 0; k < 2; ++k) dst[m][k] = *(const PG8_LAS bf16x8*)(lds + PG8_SA(b, h) + aoff + m * 2048 + k * 1024); } while (0)
#define PG8_LDB(dst, b, h) do { _Pragma("unroll") for (int n = 0; n < 2; ++n) _Pragma("unroll") for (int k = 0; k < 2; ++k) dst[n][k] = *(const PG8_LAS bf16x8*)(lds + PG8_SB(b, h) + boff + n * 2048 + k * 1024); } while (0)
#define PG8_MMA(ai, bj, At, Bt) do { __builtin_amdgcn_s_setprio(1); _Pragma("unroll") for (int m = 0; m < 4; ++m) _Pragma("unroll") for (int n = 0; n < 2; ++n) _Pragma("unroll") for (int k = 0; k < 2; ++k) \
        acc[ai][bj][m][n] = __builtin_amdgcn_mfma_f32_16x16x32_bf16(Bt[n][k], At[m][k], acc[ai][bj][m][n], 0, 0, 0); __builtin_amdgcn_s_setprio(0); } while (0)
#define PG8_WAIT_V(n) asm volatile("s_waitcnt vmcnt(" #n ")" ::: "memory")
#define PG8_WAIT_L(n) asm volatile("s_waitcnt lgkmcnt(" #n ")" ::: "memory")
#define PG8_BAR __builtin_amdgcn_s_barrier()
#define PG8_SCHED __builtin_amdgcn_sched_barrier(0)
    Unit cur, nxt; int ui = 0;
    if (!S.next(0, cur)) return;
    f32x4 acc[2][2][4][2];
#pragma unroll
    for (int a = 0; a < 2; ++a)
#pragma unroll
        for (int b = 0; b < 2; ++b)
#pragma unroll
            for (int m = 0; m < 4; ++m)
#pragma unroll
                for (int n = 0; n < 2; ++n) acc[a][b][m][n] = (f32x4){0.f, 0.f, 0.f, 0.f};
    bf16x8 At[4][2], B0[2][2], B1[2][2];
    const char* cA = (const char*)g.A + (GATHER ? (size_t)0 : (size_t)cur.pm * tstep); const char* cB = (const char*)g.Bt + (size_t)cur.pn * tstep + (size_t)cur.e * g.estride * 2;
    S.a_ready(cur);
    unsigned gcur[2][2], gnxt[2][2], gs[2][2];
    if constexpr (GATHER) {
        if (tid < 256) PG8_TOKSLOT(0)[tid] = S.tok[cur.pm * 256 + tid];
        __syncthreads();
#pragma unroll
        for (int h = 0; h < 2; ++h)
#pragma unroll
            for (int i = 0; i < 2; ++i) { gcur[h][i] = (unsigned)PG8_TOKSLOT(0)[h * HALF + rowA[i]] * (unsigned)(K * 2) + voffA[i]; gnxt[h][i] = gcur[h][i]; gs[h][i] = gcur[h][i]; }
    }
    PG8_STAGE(PG8_SB(0, 0), cB, voffB); PG8_STAGE_A(PG8_SA(0, 0), cA, 0, gcur); PG8_STAGE(PG8_SB(0, 1), cB + hstep, voffB); PG8_STAGE_A(PG8_SA(0, 1), cA, 1, gcur);
    if (wr == 1) PG8_BAR;
    PG8_WAIT_V(4); PG8_BAR;
    PG8_STAGE(PG8_SB(1, 0), cB + kstep, voffB); PG8_STAGE_A(PG8_SA(1, 0), cA + kstep, 0, gcur); PG8_STAGE(PG8_SB(1, 1), cB + hstep + kstep, voffB);
    PG8_WAIT_V(6); PG8_BAR;
    PG8_STAMP();
    for (;;) {
        const bool has_next = S.next(ui + 1, nxt);
        if constexpr (GATHER) { if (has_next && wid < 4)
            __builtin_amdgcn_global_load_lds((const unsigned*)(S.tok + nxt.pm * 256 + wid * 64 + lane), (PG8_LAS unsigned*)((PG8_LAS unsigned char*)PG8_TOKSLOT(ui + 1) + wid * 256), 4, 0, 0); }
        const char* nA = GATHER ? (const char*)g.A : has_next ? (const char*)g.A + (size_t)nxt.pm * tstep : cA; const char* nB = has_next ? (const char*)g.Bt + (size_t)nxt.pn * tstep + (size_t)nxt.e * g.estride * 2 : cB;
        for (int t = 0; t < nt; t += 2) {
            const bool last = (t == nt - 2);
            const char* a1 = cA + (size_t)(t + 1) * kstep;
            const char* a2 = last ? nA : cA + (size_t)(t + 2) * kstep; const char* b2 = last ? nB : cB + (size_t)(t + 2) * kstep;
            const char* a3 = a2 + kstep; const char* b3 = b2 + kstep;
            if (last && has_next) S.a_ready(nxt);
            if constexpr (GATHER) {
                if (last && has_next) {
#pragma unroll
                    for (int h = 0; h < 2; ++h)
#pragma unroll
                        for (int i = 0; i < 2; ++i) gnxt[h][i] = (unsigned)PG8_TOKSLOT(ui + 1)[h * HALF + rowA[i]] * (unsigned)(K * 2) + voffA[i];
                }
#pragma unroll
                for (int h = 0; h < 2; ++h)
#pragma unroll
                    for (int i = 0; i < 2; ++i) gs[h][i] = last ? gnxt[h][i] : gcur[h][i];
            }
            PG8_LDB(B0, 0, 0); PG8_SCHED; PG8_LDA(At, 0, 0); PG8_STAGE_A(PG8_SA(1, 1), a1, 1, gcur);
            PG8_WAIT_L(8); PG8_BAR; PG8_WAIT_L(0); PG8_MMA(0, 0, At, B0); PG8_BAR; PG8_SCHED;
            PG8_LDB(B1, 0, 1); PG8_STAGE(PG8_SB(0, 0), b2, voffB);
            PG8_BAR; PG8_WAIT_L(0); PG8_MMA(0, 1, At, B1); PG8_BAR;
            PG8_LDA(At, 0, 1); PG8_STAGE_A(PG8_SA(0, 0), a2, 0, gs);
            PG8_BAR; PG8_WAIT_L(0); PG8_MMA(1, 0, At, B0); PG8_BAR; PG8_SCHED;
            PG8_STAGE(PG8_SB(0, 1), b2 + hstep, voffB);
            PG8_WAIT_V(6); PG8_BAR; PG8_MMA(1, 1, At, B1); PG8_BAR;
            PG8_LDB(B0, 1, 0); PG8_SCHED; PG8_LDA(At, 1, 0); PG8_STAGE_A(PG8_SA(0, 1), a2, 1, gs);
            PG8_WAIT_L(8); PG8_BAR; PG8_WAIT_L(0); PG8_MMA(0, 0, At, B0); PG8_BAR; PG8_SCHED;
            PG8_LDB(B1, 1, 1); PG8_STAGE(PG8_SB(1, 0), b3, voffB);
            PG8_BAR; PG8_WAIT_L(0); PG8_MMA(0, 1, At, B1); PG8_BAR;
            PG8_LDA(At, 1, 1); PG8_STAGE_A(PG8_SA(1, 0), a3, 0, gs);
            PG8_BAR; PG8_WAIT_L(0); PG8_MMA(1, 0, At, B0); PG8_BAR; PG8_SCHED;
            PG8_STAGE(PG8_SB(1, 1), b3 + hstep, voffB);
            PG8_WAIT_V(6); PG8_BAR; PG8_MMA(1, 1, At, B1); PG8_BAR;
        }
        PG8_STAMP();
        if constexpr (!Epi::AFTER_DRAIN) { E(acc, cur, wr, wc, fr, fq); S.done(cur); }
        PG8_STAMP();
        if (!has_next) break;
#pragma unroll
        for (int a = 0; a < 2; ++a)
#pragma unroll
            for (int b = 0; b < 2; ++b)
#pragma unroll
                for (int m = 0; m < 4; ++m)
#pragma unroll
                    for (int n = 0; n < 2; ++n) acc[a][b][m][n] = (f32x4){0.f, 0.f, 0.f, 0.f};
        cur = nxt; cA = nA; cB = nB; ++ui;
        if constexpr (GATHER) {
#pragma unroll
            for (int h = 0; h < 2; ++h)
#pragma unroll
                for (int i = 0; i < 2; ++i) gcur[h][i] = gnxt[h][i];
        }
    }
    PG8_WAIT_V(0);
    if (wr == 0) PG8_BAR;
    PG8_BAR;
    if constexpr (Epi::AFTER_DRAIN) { E.fused(acc, cur, wr, wc, fr, fq, lds, wid, lane); S.done(cur); }
    PG8_STAMP();
    if (STAMP && wid == 0) { stamps[lane] = lane < nts ? (((unsigned long long)(unsigned)ts_hi << 32) | (unsigned)ts_lo) : 0ull;
        if (lane == 62) stamps[62] = rt_entry; if (lane == 63) stamps[63] = (unsigned long long)wall_clock64(); }
#undef PG8_STAMP
#undef PG8_SA
#undef PG8_SB
#undef PG8_STAGE
#undef PG8_STAGE_A
#undef PG8_TOKSLOT
#undef PG8_LDA
#undef PG8_LDB
#undef PG8_MMA
#undef PG8_WAIT_V
#undef PG8_WAIT_L
#undef PG8_BAR
#undef PG8_SCHED
}
}
namespace pg8 {
struct EpiRes {
    static constexpr bool PERM = false, AFTER_DRAIN = false;
    const float* base_lat; const float* base_ctx; float* out_lat; float* out_ctx; const float* gvec;
    __device__ __forceinline__ void operator()(const f32x4 (&acc)[2][2][4][2], const Unit& u, int wr, int wc, int fr, int fq) const {
        const bool isctx = u.pm >= 128;
        const int prow = (isctx ? (u.pm - 128) : u.pm) * BM;
        const float* base = isctx ? base_ctx : base_lat; float* out = isctx ? out_ctx : out_lat;
        const float* gv = gvec + (size_t)(isctx ? 8 : (u.pm >> 4)) * 6144;
        const int row0 = prow + wr * 64 + fr, col0 = u.pn * BM + wc * 32 + 4 * fq;
        f32x4 gvv[2][2];
#pragma unroll
        for (int bj = 0; bj < 2; ++bj)
#pragma unroll
            for (int n = 0; n < 2; ++n) gvv[bj][n] = *(const f32x4*)(gv + col0 + bj * HALF + n * 16);
#pragma unroll
        for (int ai = 0; ai < 2; ++ai)
#pragma unroll
            for (int m = 0; m < 4; ++m) { const size_t off = (size_t)(row0 + ai * HALF + m * 16) * 1024 + col0;
#pragma unroll
                for (int bj = 0; bj < 2; ++bj)
#pragma unroll
                    for (int n = 0; n < 2; ++n) { const f32x4 b = *(const f32x4*)(base + off + bj * HALF + n * 16);
                        *(f32x4*)(out + off + bj * HALF + n * 16) = b + gvv[bj][n] * acc[ai][bj][m][n]; } }
    }
};
struct EpiSwiglu {
    static constexpr bool PERM = true, AFTER_DRAIN = false;
    bf16_t* O; int ldc;
    __device__ __forceinline__ void operator()(const f32x4 (&acc)[2][2][4][2], const Unit& u, int wr, int wc, int fr, int fq) const {
        const int row0 = u.pm * BM + wr * 64 + fr, col0 = u.pn * HALF + wc * 32 + 8 * fq;
#pragma unroll
        for (int ai = 0; ai < 2; ++ai)
#pragma unroll
            for (int m = 0; m < 4; ++m) { bf16_t* rowp = O + (size_t)(row0 + ai * HALF + m * 16) * ldc + col0;
                float h[8];
#pragma unroll
                for (int n = 0; n < 2; ++n)
#pragma unroll
                    for (int j = 0; j < 4; ++j) { const float g = acc[ai][0][m][n][j], up = acc[ai][1][m][n][j]; h[n * 4 + j] = g * __builtin_amdgcn_rcpf(1.0f + __expf(-g)) * up; }
                u32x4 w; w.x = cvt_pk_bf16(h[0], h[1]); w.y = cvt_pk_bf16(h[2], h[3]); w.z = cvt_pk_bf16(h[4], h[5]); w.w = cvt_pk_bf16(h[6], h[7]);
                *(u32x4*)rowp = w; }
    }
};
struct MoeOrder {
    static constexpr bool GATHER = false;
    int nN, G, c, nunits; const int* tab;
    __device__ void init(const int* tab_, int nN_, int G_, int c_) { tab = tab_; nN = nN_; G = G_; c = c_; nunits = tab_[0] * nN_; }
    __device__ bool next(int i, Unit& u) const {
        const int L = i * G + c; if (L >= nunits) return false;
        const int q = nunits / NXCD, r = nunits % NXCD, xcd = L % NXCD, off = L / NXCD;
        const int w = (xcd < r ? xcd * (q + 1) : r * (q + 1) + (xcd - r) * q) + off;
        u.pm = w / nN; u.pn = w - u.pm * nN; u.e = tab[1 + u.pm]; return true;
    }
    __device__ __forceinline__ void a_ready(const Unit&) const {}
    __device__ __forceinline__ void done(const Unit&) const {}
};
struct MoeOrderG : MoeOrder { static constexpr bool GATHER = true; const int* tok; };
}
enum { I_X = 0, I_C, I_CTX, I_CCTX, I_MODW, I_MODB, I_NMIXG, I_NFFNG, I_WIN, I_WOUT, I_LCW, I_LCB, I_LWA, I_LBA, I_LWX, I_LBX, I_LLAM,
       I_RMU, I_RWUP, I_RW0, I_RAUP, I_RA0, I_RGUP, I_RKK, I_RKA, I_RRK, I_RLNG, I_RLNB, I_MIB, I_MFB, I_MNG, I_GCW, I_GALOG, I_GDTB, I_GNG,
       I_FWG, I_FWU, I_FWD, I_MROUTER, I_MWG, I_MWU, I_MWD, I_FNG, N_IN };
struct Args { const float* in[N_IN]; float* out; unsigned char* ws; int ph_lo, ph_hi; };
struct Ctx {
    const float* const* in; float* out; unsigned char* ws; LAS unsigned char* lds;
    int tid, lane, wave, G, wg;
};
#define WSP(T, off) ((T*)(C.ws + (off)))

__device__ __forceinline__ int seqrow_raster(int i, int d, int b) {
    if (i < CTXL) { const int p = d ? (CTXL - 1 - i) : i; return T_LAT + b * CTXL + p; }
    const int j = i - CTXL; const int p = d ? (SEQ - 1 - j) : j; return b * SEQ + p;
}
__device__ __forceinline__ int seqrow_cm(int i, int d, int b) {
    if (i < CTXL) { const int p = d ? (CTXL - 1 - i) : i; return T_LAT + b * CTXL + p; }
    const int j = i - CTXL; const int p = d ? (SEQ - 1 - j) : j; return b * SEQ + (p & 63) * 64 + (p >> 6);
}

__device__ __forceinline__ void phase_pre(const Ctx& C) {
    LAS float* sc = (LAS float*)C.lds;
    LAS float* red = sc + 9 * 1024;
    float* modv = WSP(float, WS_MODV);
    bool filled = false;
    for (int it = C.wg; it < DEPTH * 48; it += C.G) {
        if (!filled) {
            for (int i = C.tid; i < 9 * 1024; i += NTHR) { const float v = i < 8192 ? C.in[I_C][i] : C.in[I_CCTX][i - 8192]; sc[i] = siluf_(v); }
            filled = true; __syncthreads();
        }
        const int l = it / 48, jb = it % 48, col = C.tid & 127, kg = C.tid >> 7;
        const float* W = C.in[I_MODW] + (size_t)l * 1024 * 6144 + jb * 128 + col;
        float acc[9];
#pragma unroll
        for (int r = 0; r < 9; ++r) acc[r] = 0.f;
        for (int k = kg * 256; k < kg * 256 + 256; ++k) { const float w = W[(size_t)k * 6144];
#pragma unroll
            for (int r = 0; r < 9; ++r) acc[r] += sc[r * 1024 + k] * w; }
#pragma unroll
        for (int r = 0; r < 9; ++r) red[(kg * 9 + r) * 128 + col] = acc[r];
        __syncthreads();
        for (int i = C.tid; i < 9 * 128; i += NTHR) { const int r = i >> 7, cc = i & 127;
            const float s = red[(0 * 9 + r) * 128 + cc] + red[(1 * 9 + r) * 128 + cc] + red[(2 * 9 + r) * 128 + cc] + red[(3 * 9 + r) * 128 + cc];
            modv[((size_t)l * 9 + r) * 6144 + jb * 128 + cc] = s + C.in[I_MODB][l * 6144 + jb * 128 + cc]; }
        __syncthreads();
    }
}

__device__ __forceinline__ void tr_item(const float* src, size_t ld, int k0, int ns0, bf16* dst, int drow0, int Kd, LAS float* scr, int lane, bool zero) {
    if (!zero) {
#pragma unroll 8
        for (int i = 0; i < 32; ++i) { const int kk = 2 * i + (lane >> 5); scr[kk * 33 + (lane & 31)] = src[(size_t)(k0 + kk) * ld + ns0 + (lane & 31)]; }
    }
    LDS_WAIT(); asm volatile("" ::: "memory");
    const int c = lane & 7;
#pragma unroll
    for (int j = 0; j < 4; ++j) { const int n = (lane >> 3) + 8 * j; const LAS float* s = scr + (8 * c) * 33 + n;
        v4u o; o.x = pk2(s[0 * 33], s[1 * 33]); o.y = pk2(s[2 * 33], s[3 * 33]); o.z = pk2(s[4 * 33], s[5 * 33]); o.w = pk2(s[6 * 33], s[7 * 33]);
        if (zero) o = (v4u){0u, 0u, 0u, 0u};
        *(v4u*)(dst + (size_t)(drow0 + n) * Kd + k0 + 8 * c) = o; }
    LDS_WAIT(); asm volatile("" ::: "memory");
}
__device__ __forceinline__ void convert_small(const Ctx& C, int l) {
    {
        bf16* lw = WSP(bf16, WS_LRUWT);
        for (int k = 0; k < 2 * 2 * 4 * 4096 / (128 * NTHR); ++k) {
            const int e = k * 128 * NTHR + C.wg * NTHR + C.tid;
            if (C.wg < 128) {
            const int i = e & 63, j = (e >> 6) & 63, hd = (e >> 12) & 3, g = (e >> 14) & 1, d = e >> 15;
            const float* src = (g ? C.in[I_LWX] : C.in[I_LWA]) + ((size_t)((l * 2 + d) * 4 + hd) * 64 + i) * 64 + j;
            lw[e] = (bf16)f2bf(*src);
            }
        }
    }
    if (C.wg >= 128 && C.wg < 224) {
        bf16* rw = WSP(bf16, WS_RWT);
        const int e = (C.wg - 128) * NTHR + C.tid;
        if (e < 32768) { const int r = e & 31, ch = (e >> 5) & 255, d = (e >> 13) & 1, isa = e >> 14;
            rw[e] = (bf16)f2bf((isa ? C.in[I_RAUP] : C.in[I_RWUP])[((size_t)(l * 2 + d) * 32 + r) * GW + ch]); }
        else { const int e2 = e - 32768, j = e2 & 63, ch = e2 >> 6; rw[e] = (bf16)f2bf(C.in[I_RGUP][((size_t)l * 64 + j) * GW + ch]); }
    }
}
__device__ __forceinline__ void convert_items(const Ctx& C, int l, int what, int gw, int NGW) {
    LAS float* scr = (LAS float*)(C.lds + C.wave * 8704);
    constexpr int I_IN = 16 * 112, I_OUT = 16 * 32, I_GU = 16 * 176, I_DN = 44 * 32, I_E = 16 * 88 + 22 * 32;
    const bool moe = l & 1; const int li = l >> 1;
    const int lo_it = (what & 1) ? 0 : I_IN, hi_it = (what & 2) ? I_IN + I_OUT + (moe ? NE * I_E : (I_GU + I_DN)) : I_IN;
    bf16* win = WSP(bf16, WS_WIN); bf16* wout = WSP(bf16, WS_WOUT); bf16* wgu = WSP(bf16, WS_WGU); bf16* wdn = WSP(bf16, WS_WDN);
    for (int it = lo_it + gw; it < hi_it; it += NGW) {
        int r = it;
        if (r < I_IN) { const int kb = r / 112, nb = r % 112; tr_item(C.in[I_WIN] + (size_t)l * 1024 * IN_COLS, IN_COLS, 64 * kb, 32 * nb, win, 32 * nb, 1024, scr, C.lane, nb == 111); continue; }
        r -= I_IN;
        if (r < I_OUT) { const int kb = r / 32, nb = r % 32; tr_item(C.in[I_WOUT] + (size_t)l * 1024 * 1024, 1024, 64 * kb, 32 * nb, wout, 32 * nb, 1024, scr, C.lane, false); continue; }
        r -= I_OUT;
        if (!moe) {
            if (r < I_GU) { const int kb = r / 176, nb = r % 176, tile = nb >> 3, q = nb & 7;
                const float* src = (q < 4 ? C.in[I_FWG] : C.in[I_FWU]) + (size_t)li * 1024 * DFF;
                tr_item(src, DFF, 64 * kb, tile * 128 + (q & 3) * 32, wgu, 32 * nb, 1024, scr, C.lane, false); continue; }
            r -= I_GU;
            { const int kb = r / 32, nb = r % 32; tr_item(C.in[I_FWD] + (size_t)li * DFF * 1024, 1024, 64 * kb, 32 * nb, wdn, 32 * nb, DFF, scr, C.lane, false); }
        } else {
            const int e = r / I_E; int rr = r % I_E;
            if (rr < 16 * 88) { const int kb = rr / 88, nb = rr % 88, tile = nb >> 3, q = nb & 7;
                const float* src = (q < 4 ? C.in[I_MWG] : C.in[I_MWU]) + ((size_t)li * NE + e) * 1024 * DFE;
                tr_item(src, DFE, 64 * kb, tile * 128 + (q & 3) * 32, wgu + (size_t)e * 2 * DFE * 1024, 32 * nb, 1024, scr, C.lane, false); continue; }
            rr -= 16 * 88;
            { const int kb = rr / 32, nb = rr % 32; tr_item(C.in[I_MWD] + ((size_t)li * NE + e) * DFE * 1024, 1024, 64 * kb, 32 * nb, wdn + (size_t)e * 1024 * DFE, 32 * nb, DFE, scr, C.lane, false); }
        }
    }
}

template <bool ROUTE>
__device__ __forceinline__ void norm_rows(const Ctx& C, int l, const float* xlat, const float* xctx, const float* gain, int shoff, int scoff, int nrows, int moe_li) {
    const float* modv = WSP(float, WS_MODV) + (size_t)l * 9 * 6144;
    bf16* hb = WSP(bf16, WS_HB);
    const int gw = C.wg * NWAVES + C.wave, NGW = C.G * NWAVES;
    LAS unsigned* lcnt = (LAS unsigned*)(C.lds + 65536);
    unsigned* route = WSP(unsigned, WS_ROUTE);
    if (ROUTE) { if (C.tid < 8) lcnt[C.tid] = 0u; __syncthreads(); }
    f32x4 gv[4];
#pragma unroll
    for (int j = 0; j < 4; ++j) gv[j] = *(const f32x4*)(gain + 4 * C.lane + 256 * j);
    for (int m = gw; m < nrows; m += NGW) {
        const bool isctx = m >= T_LAT;
        const float* xr = isctx ? xctx + (size_t)(m - T_LAT) * 1024 : xlat + (size_t)m * 1024;
        const float* mv = modv + (size_t)(isctx ? 8 : (m >> 12)) * 6144;
        f32x4 v[4]; float s = 0.f;
#pragma unroll
        for (int j = 0; j < 4; ++j) { v[j] = *(const f32x4*)(xr + 4 * C.lane + 256 * j); s += (v[j].x * v[j].x + v[j].y * v[j].y) + (v[j].z * v[j].z + v[j].w * v[j].w); }
        const float rs = rsqrtf_(wave_sum(s) * (1.0f / 1024.0f) + 1e-6f);
#pragma unroll
        for (int j = 0; j < 4; ++j) { const f32x4 sh = *(const f32x4*)(mv + shoff + 4 * C.lane + 256 * j), scl = *(const f32x4*)(mv + scoff + 4 * C.lane + 256 * j);
            v[j] = (v[j] * rs * gv[j]) * (scl + 1.0f) + sh;
            v2u o; o.x = pk2(v[j].x, v[j].y); o.y = pk2(v[j].z, v[j].w);
            *(v2u*)(hb + (size_t)m * 1024 + 4 * C.lane + 256 * j) = o; }
        if (ROUTE) {
            const float* rt = C.in[I_MROUTER] + (size_t)moe_li * 1024 * NE;
            float lg[8];
#pragma unroll
            for (int e = 0; e < 8; ++e) lg[e] = 0.f;
#pragma unroll
            for (int j = 0; j < 4; ++j)
#pragma unroll
                for (int q = 0; q < 4; ++q) { const int k = 4 * C.lane + 256 * j + q; const f32x4 r0 = *(const f32x4*)(rt + (size_t)k * 8), r1 = *(const f32x4*)(rt + (size_t)k * 8 + 4); const float hv = v[j][q];
                    lg[0] += hv * r0.x; lg[1] += hv * r0.y; lg[2] += hv * r0.z; lg[3] += hv * r0.w; lg[4] += hv * r1.x; lg[5] += hv * r1.y; lg[6] += hv * r1.z; lg[7] += hv * r1.w; }
#pragma unroll
            for (int e = 0; e < 8; ++e) lg[e] = wave_sum(lg[e]);
            int e0 = 0; float l0 = lg[0];
#pragma unroll
            for (int e = 1; e < 8; ++e) if (lg[e] > l0) { l0 = lg[e]; e0 = e; }
            int e1 = (e0 == 0) ? 1 : 0; float l1 = -3.0e38f;
#pragma unroll
            for (int e = 0; e < 8; ++e) if (e != e0 && lg[e] > l1) { l1 = lg[e]; e1 = e; }
            const float w0 = __builtin_amdgcn_rcpf(1.0f + __expf(l1 - l0)), w1 = 1.0f - w0;
            if (C.lane == 0) {
                const unsigned r0 = atomicAdd((unsigned*)&lcnt[e0], 1u), r1 = atomicAdd((unsigned*)&lcnt[e1], 1u);
                v4u a; a.x = (unsigned)e0; a.y = (unsigned)e1; a.z = r0; a.w = r1;
                *(v4u*)(route + (size_t)m * 8) = a;
                v2u b; b.x = __builtin_bit_cast(unsigned, w0); b.y = __builtin_bit_cast(unsigned, w1);
                *(v2u*)(route + (size_t)m * 8 + 4) = b;
            }
        }
    }
    if (ROUTE) {
        __syncthreads();
        if (C.tid < 8) { unsigned* gc = WSP(unsigned, WS_CTL) + CW_MOECNT + 64 * moe_li; const unsigned base = atomicAdd(gc + C.tid, lcnt[C.tid]); WSP(unsigned, WS_WGBASE)[C.wg * 8 + C.tid] = base; }
    }
}
#define RAW_BARRIER() do { asm volatile("s_waitcnt lgkmcnt(0)" ::: "memory"); __builtin_amdgcn_s_barrier(); asm volatile("" ::: "memory"); } while (0)
__device__ __forceinline__ void gdn_prep(const Ctx& C, int l, int b, int c) {
    const bf16* P = WSP(const bf16, WS_P); bf16* gq = WSP(bf16, WS_GQ);
    const bool isctx = c < 4; const int p0 = isctx ? c * 64 : (c - 4) * 64; const int Lp = isctx ? CTXL : SEQ;
    const int ch = 4 * C.lane;
    auto rowof = [&](int p) -> int { return isctx ? (T_LAT + b * CTXL + p) : (b * SEQ + (p & 63) * 64 + (p >> 6)); };
    f32x4 cw[4][3], x[4][3];
#pragma unroll
    for (int j = 0; j < 4; ++j)
#pragma unroll
        for (int g = 0; g < 3; ++g) cw[j][g] = *(const f32x4*)(C.in[I_GCW] + ((size_t)l * 4 + j) * 768 + g * 256 + ch);
    const int tb = p0 + C.wave * 8;
    auto ldrow = [&](int p, f32x4 (&dst)[3]) {
        if (p >= 0 && p < Lp) { const bf16* pr = P + (size_t)rowof(p) * PLD + OFF_D + ch;
#pragma unroll
            for (int g = 0; g < 3; ++g) dst[g] = ld4bf(pr + g * 256); }
        else {
#pragma unroll
            for (int g = 0; g < 3; ++g) dst[g] = (f32x4){0.f, 0.f, 0.f, 0.f}; }
    };
    ldrow(tb - 2, x[0]); ldrow(tb - 1, x[1]); ldrow(tb, x[2]);
#pragma unroll
    for (int t = 0; t < 8; ++t) {
        ldrow(tb + t + 1, x[3]);
        bf16* orow = gq + (size_t)rowof(tb + t) * 768 + ch;
#pragma unroll
        for (int g = 0; g < 3; ++g) {
            f32x4 v = cw[0][g] * x[0][g] + cw[1][g] * x[1][g] + cw[2][g] * x[2][g] + cw[3][g] * x[3][g];
            v = (f32x4){siluf_(v.x), siluf_(v.y), siluf_(v.z), siluf_(v.w)};
            if (g < 2) { const float ss = row16_sum((v.x * v.x + v.y * v.y) + (v.z * v.z + v.w * v.w)); v = v * (rsqrtf_(ss + 1e-6f) * (g == 0 ? 0.125f : 1.0f)); }
            st4bf(orow + g * 256, v);
        }
#pragma unroll
        for (int g = 0; g < 3; ++g) { x[0][g] = x[1][g]; x[1][g] = x[2][g]; x[2][g] = x[3][g]; }
    }
}
__device__ __forceinline__ void finish_rows(const Ctx& C, int l, int nrows) {
    const bf16* P = WSP(const bf16, WS_P); bf16* yc = WSP(bf16, WS_HB);
    const bf16* ob = WSP(const bf16, WS_OUTB); const bf16* oc = WSP(const bf16, WS_OUTC); const bf16* od = WSP(const bf16, WS_OUTD);
    const bf16* gg = WSP(const bf16, WS_G); const float* bonus = WSP(const float, WS_BONUS);
    const float* mu = C.in[I_RMU] + (size_t)l * 2 * B_COLS;
    const int gw = C.wg * NWAVES + C.wave, NGW = C.G * NWAVES, lane = C.lane, ch = 4 * lane, hh = lane >> 4;
    const f32x4 lng = *(const f32x4*)(C.in[I_RLNG] + l * GW + ch), lnb = *(const f32x4*)(C.in[I_RLNB] + l * GW + ch);
    const f32x4 mng = *(const f32x4*)(C.in[I_MNG] + l * GW + ch), gng = *(const f32x4*)(C.in[I_GNG] + l * GW + ch);
    const f32x4 mu0 = *(const f32x4*)(mu + 512 + ch), mu1 = *(const f32x4*)(mu + B_COLS + 512 + ch);
    const size_t o2 = (size_t)T_ALL * 256;
#pragma unroll 2
    for (int m = gw; m < nrows; m += NGW) {
        const bool isctx = m >= T_LAT; const int Lp = isctx ? CTXL : SEQ; const int p = isctx ? ((m - T_LAT) & (CTXL - 1)) : (m & (SEQ - 1));
        const f32x4 yb = ld4bf(ob + (size_t)m * 256 + ch) + ld4bf(ob + o2 + (size_t)m * 256 + ch);
        const f32x4 ycv = ld4bf(oc + (size_t)m * 256 + ch) + ld4bf(oc + o2 + (size_t)m * 256 + ch);
        const f32x4 yd = ld4bf(od + (size_t)m * 256 + ch) + ld4bf(od + o2 + (size_t)m * 256 + ch);
        const bf16* pr = P + (size_t)m * PLD;
        const f32x4 vs = ld4bf(WSP(const bf16, WS_RKV) + (size_t)m * 768 + 512 + ch);
        const f32x4 og = ld4bf(pr + OFF_C + 768 + ch), gd = ld4bf(pr + OFF_D + 768 + ch), gr = ld4bf(gg + (size_t)m * 256 + ch);
        const float bn = bonus[(size_t)m * 4 + hh];
        *(v2u*)(yc + (size_t)m * 1024 + ch) = *(const v2u*)(pr + 256 + ch);
        {
            const float mean = row16_sum((yb.x + yb.y) + (yb.z + yb.w)) * (1.0f / 64.0f);
            const f32x4 dl = yb - mean;
            const float var = row16_sum((dl.x * dl.x + dl.y * dl.y) + (dl.z * dl.z + dl.w * dl.w)) * (1.0f / 64.0f);
            const f32x4 yn = dl * rsqrtf_(var + 64e-5f) * lng + lnb;
            st4bf(yc + (size_t)m * 1024 + 256 + ch, (yn + vs * bn) * gr);
        }
        {
            const float ms = row16_sum((ycv.x * ycv.x + ycv.y * ycv.y) + (ycv.z * ycv.z + ycv.w * ycv.w)) * (1.0f / 64.0f);
            const f32x4 sg = (f32x4){sigmoidf_(og.x), sigmoidf_(og.y), sigmoidf_(og.z), sigmoidf_(og.w)};
            st4bf(yc + (size_t)m * 1024 + 512 + ch, ycv * rsqrtf_(ms + 1e-6f) * mng * sg);
        }
        {
            const float ms = row16_sum((yd.x * yd.x + yd.y * yd.y) + (yd.z * yd.z + yd.w * yd.w)) * (1.0f / 64.0f);
            const f32x4 sg = (f32x4){siluf_(gd.x), siluf_(gd.y), siluf_(gd.z), siluf_(gd.w)};
            st4bf(yc + (size_t)m * 1024 + 768 + ch, yd * rsqrtf_(ms + 1e-6f) * gng * sg);
        }
    }
}
typedef bf16x8 fragb;
__device__ __forceinline__ f32x4 mfma16(fragb a, fragb b, f32x4 c) { return __builtin_amdgcn_mfma_f32_16x16x32_bf16(a, b, c, 0, 0, 0); }
__device__ __forceinline__ fragb ld_frag16(const LAS bf16* p) { return *(const LAS fragb*)p; }
__device__ __forceinline__ fragb ld_frag8x2(const LAS bf16* p0, const LAS bf16* p1) {
    const v2u a = *(const LAS v2u*)p0, b = *(const LAS v2u*)p1; v4u r; r.x = a.x; r.y = a.y; r.z = b.x; r.w = b.y; return __builtin_bit_cast(fragb, r); }
__device__ __forceinline__ fragb pack_frag(const f32x4& lo, const f32x4& hi) { v4u r; r.x = pk2(lo.x, lo.y); r.y = pk2(lo.z, lo.w); r.z = pk2(hi.x, hi.y); r.w = pk2(hi.z, hi.w); return __builtin_bit_cast(fragb, r); }
__device__ __forceinline__ float wave_incl_sum(float v, int lane) {
    v += dpp_x<0x111, 0xF, true>(0.f, v); v += dpp_x<0x112, 0xF, true>(0.f, v); v += dpp_x<0x114, 0xF, true>(0.f, v); v += dpp_x<0x118, 0xF, true>(0.f, v);
    v += dpp_x<0x142, 0xA, false>(0.f, v); v += dpp_x<0x143, 0xC, false>(0.f, v);
    return v;
}
__device__ __forceinline__ float wave_incl_max(float v, int lane) {
    const float ninf = -3.0e38f;
    v = fmaxf(v, dpp_x<0x111, 0xF, false>(ninf, v)); v = fmaxf(v, dpp_x<0x112, 0xF, false>(ninf, v)); v = fmaxf(v, dpp_x<0x114, 0xF, false>(ninf, v)); v = fmaxf(v, dpp_x<0x118, 0xF, false>(ninf, v));
    v = fmaxf(v, dpp_x<0x142, 0xA, false>(ninf, v)); v = fmaxf(v, dpp_x<0x143, 0xC, false>(ninf, v));
    return v;
}
constexpr int MP = 72;
__device__ __forceinline__ void mlstm_chunked(const Ctx& C, int l, int idx) {
    const int d = idx >> 5, b = (idx >> 2) & 7, h = idx & 3, lane = C.lane, w = C.wave, l15 = lane & 15, q = lane >> 4;
    const int it = w & 3, vtp = w >> 2;
    constexpr int IMG = 64 * MP * 2, BUFB = 4 * IMG + 1024, CTB = 65 * MP * 2 + 16;
    LAS unsigned char* L0 = C.lds;
    const bf16* P = WSP(const bf16, WS_P); bf16* outc = WSP(bf16, WS_OUTC) + (size_t)d * T_ALL * 256;
    const float ib = C.in[I_MIB][(l * 2 + d) * NH + h], fb = C.in[I_MFB][(l * 2 + d) * NH + h];
    const int tt = C.tid >> 3, part = C.tid & 7;
    for (int i = C.tid; i < 2 * CTB / 4; i += NTHR) ((LAS unsigned*)(L0 + 2 * BUFB))[i] = 0u;
    v4u rq, rk, rv; unsigned short rgi, rgf;
    auto gload = [&](int n) {
        const int row = seqrow_cm(n * 64 + tt, d, b);
        const bf16* pp = P + (size_t)row * PLD + OFF_C + h * 64 + 8 * part;
        rq = *(const v4u*)pp; rk = *(const v4u*)(pp + 256); rv = *(const v4u*)(pp + 512);
        const bf16* pg = P + (size_t)seqrow_cm(n * 64 + lane, d, b) * PLD + OFF_C + 1024 + d * 4 + h;
        rgi = pg[0]; rgf = pg[8];
    };
    auto images = [&](int bufi) {
        LAS unsigned char* B0 = L0 + bufi * BUFB;
        LAS bf16* Qs = (LAS bf16*)B0; LAS bf16* Ks = Qs + 64 * MP; LAS bf16* VT = Ks + 64 * MP; LAS bf16* KTw = VT + 64 * MP; LAS float* vec = (LAS float*)(B0 + 4 * IMG);
        const float li = bf2f(rgi) + ib, lf = -softplusf_(-(bf2f(rgf) + fb));
        const float bc = wave_incl_sum(lf, lane), x = li - bc, cm = wave_incl_max(x, lane);
        const float wl = __expf(x - __shfl(cm, 63)) * 0.125f;
        if (w == 0) { vec[lane] = x; vec[64 + lane] = cm; vec[128 + lane] = bc; }
        const float wmine = __shfl(wl, 8 * w + (lane >> 3));
        *(LAS v4u*)(Qs + tt * MP + 8 * part) = rq; *(LAS v4u*)(Ks + tt * MP + 8 * part) = rk;
        const unsigned vv[4] = {rv.x, rv.y, rv.z, rv.w}, kk[4] = {rk.x, rk.y, rk.z, rk.w};
#pragma unroll
        for (int e = 0; e < 4; ++e) {
            VT[(8 * part + 2 * e) * MP + tt] = (bf16)(vv[e] & 0xffffu); VT[(8 * part + 2 * e + 1) * MP + tt] = (bf16)(vv[e] >> 16);
            KTw[(8 * part + 2 * e) * MP + tt] = (bf16)f2bf1(bflo(kk[e]) * wmine); KTw[(8 * part + 2 * e + 1) * MP + tt] = (bf16)f2bf1(bfhi(kk[e]) * wmine);
        }
    };
    f32x4 Cst[2], nst; float m = 0.f;
    Cst[0] = Cst[1] = nst = (f32x4){0.f, 0.f, 0.f, 0.f};
    const fragb ones = __builtin_bit_cast(fragb, (v4u){0x3F803F80u, 0x3F803F80u, 0x3F803F80u, 0x3F803F80u});
    const f32x4 z4 = (f32x4){0.f, 0.f, 0.f, 0.f};
    gload(0); images(0); gload(1);
#pragma unroll 1
    for (int n = 0; n < NCH; ++n) {
        RAW_BARRIER();
        const LAS unsigned char* B0 = L0 + (n & 1) * BUFB;
        const LAS bf16* Qs = (const LAS bf16*)B0; const LAS bf16* Ks = Qs + 64 * MP; const LAS bf16* VT = Ks + 64 * MP; const LAS bf16* KTw = VT + 64 * MP; const LAS float* vec = (const LAS float*)(B0 + 4 * IMG);
        const LAS bf16* CT = (const LAS bf16*)(L0 + 2 * BUFB + (n & 1) * CTB); LAS bf16* CTn = (LAS bf16*)(L0 + 2 * BUFB + ((n + 1) & 1) * CTB);
        fragb Qf[2]; Qf[0] = ld_frag16(Qs + (16 * it + l15) * MP + 8 * q); Qf[1] = ld_frag16(Qs + (16 * it + l15) * MP + 32 + 8 * q);
        const float cmi = vec[64 + 16 * it + l15]; const int icol = 16 * it + l15;
        f32x4 pt[4];
#pragma unroll
        for (int jt = 0; jt < 4; ++jt) {
            pt[jt] = z4;
            if (jt <= it) {
                const fragb k0 = ld_frag16(Ks + (16 * jt + l15) * MP + 8 * q), k1 = ld_frag16(Ks + (16 * jt + l15) * MP + 32 + 8 * q);
                f32x4 st = mfma16(k0, Qf[0], z4); st = mfma16(k1, Qf[1], st);
                const f32x4 xj = *(const LAS f32x4*)(vec + 16 * jt + 4 * q);
#pragma unroll
                for (int r = 0; r < 4; ++r) { const int j = 16 * jt + 4 * q + r; pt[jt][r] = (j <= icol) ? st[r] * __expf(xj[r] - cmi) * 0.125f : 0.f; }
            }
        }
        fragb Pf[2]; Pf[0] = pack_frag(pt[0], pt[1]); Pf[1] = pack_frag(pt[2], pt[3]);
        fragb Vf[2][2];
#pragma unroll
        for (int v2 = 0; v2 < 2; ++v2)
#pragma unroll
            for (int s = 0; s < 2; ++s) { const LAS bf16* vr = VT + (16 * (2 * vtp + v2) + l15) * MP + 32 * s + 4 * q; Vf[v2][s] = ld_frag8x2(vr, vr + 16); }
        f32x4 Aacc[2], R[2], as, dn;
        as = mfma16(Pf[0], ones, z4); if (it >= 2) as = mfma16(Pf[1], ones, as);
        const fragb nf0 = ld_frag16(CT + 64 * MP + 8 * q), nf1 = ld_frag16(CT + 64 * MP + 32 + 8 * q);
        dn = mfma16(Qf[0], nf0, z4); dn = mfma16(Qf[1], nf1, dn);
#pragma unroll
        for (int v2 = 0; v2 < 2; ++v2) {
            Aacc[v2] = mfma16(Pf[0], Vf[v2][0], z4); if (it >= 2) Aacc[v2] = mfma16(Pf[1], Vf[v2][1], Aacc[v2]);
            const LAS bf16* cr = CT + (16 * (2 * vtp + v2) + l15) * MP + 8 * q;
            R[v2] = mfma16(Qf[0], ld_frag16(cr), z4); R[v2] = mfma16(Qf[1], ld_frag16(cr + 32), R[v2]);
        }
        {
            const f32x4 bi = *(const LAS f32x4*)(vec + 128 + 16 * it + 4 * q), cmr = *(const LAS f32x4*)(vec + 64 + 16 * it + 4 * q);
#pragma unroll
            for (int r = 0; r < 4; ++r) {
                const float mi = bi[r] + cmr[r], minter = bi[r] + m, mt = fmaxf(minter, mi), e1 = __expf(mi - mt), e2 = __expf(minter - mt);
                const float den = e1 * as[r] + e2 * dn[r]; const float inv = __builtin_amdgcn_rcpf(fmaxf(fabsf(den), __expf(-mt)));
                const int row = seqrow_cm(n * 64 + 16 * it + 4 * q + r, d, b);
#pragma unroll
                for (int v2 = 0; v2 < 2; ++v2) outc[(size_t)row * 256 + h * 64 + 16 * (2 * vtp + v2) + l15] = (bf16)f2bf1((e1 * Aacc[v2][r] + e2 * R[v2][r]) * inv);
            }
        }
        {
            const LAS bf16* kr = KTw + (16 * it + l15) * MP + 4 * q;
            const fragb kt0 = ld_frag8x2(kr, kr + 16), kt1 = ld_frag8x2(kr + 32, kr + 48);
            const float bL = vec[128 + 63], mloc = bL + vec[64 + 63];
            const float mnew = fmaxf(bL + m, mloc), wp = __expf(bL + m - mnew), wn = __expf(mloc - mnew);
            f32x4 gk = mfma16(kt0, ones, z4); gk = mfma16(kt1, ones, gk);
            nst = nst * wp + gk * wn;
#pragma unroll
            for (int v2 = 0; v2 < 2; ++v2) {
                f32x4 G = mfma16(kt0, Vf[v2][0], z4); G = mfma16(kt1, Vf[v2][1], G);
                Cst[v2] = Cst[v2] * wp + G * wn;
                v2u o; o.x = pk2(Cst[v2].x, Cst[v2].y); o.y = pk2(Cst[v2].z, Cst[v2].w);
                *(LAS v2u*)(CTn + (16 * (2 * vtp + v2) + l15) * MP + 16 * it + 4 * q) = o;
            }
            if (vtp == 0 && l15 == 0) { v2u o; o.x = pk2(nst.x, nst.y); o.y = pk2(nst.z, nst.w); *(LAS v2u*)(CTn + 64 * MP + 16 * it + 4 * q) = o; }
            m = mnew;
        }
        if (n + 1 < NCH) { images((n + 1) & 1); if (n + 2 < NCH) gload(n + 2); }
    }
    __syncthreads();
}
__device__ __forceinline__ int fwd_row_cm(int b, int c, int t) { return c < 4 ? (T_LAT + b * CTXL + c * 64 + t) : (b * SEQ + t * 64 + (c - 4)); }
__device__ __forceinline__ bf16* blob_row(const Ctx& C, int d, int isw, int b, int c, int h, int r) {
    const int row = fwd_row_cm(b, c, r);
    if (d == 1 && isw) return WSP(bf16, WS_OUTD) + ((size_t)T_ALL + row) * 256 + h * 64;
    return WSP(bf16, WS_P) + (size_t)row * PLD + OFF_D + (d * 2 + isw) * 256 + h * 64;
}
constexpr int LP = 68;
__device__ __forceinline__ void blocked_solve(const LAS bf16* Ln, const LAS bf16* TinvP, LAS unsigned char* XTw, f32x4 (&acc)[4][4], int l15, int q) {
    const f32x4 z4 = (f32x4){0.f, 0.f, 0.f, 0.f};
#pragma unroll
    for (int I = 0; I < 4; ++I) {
        const fragb Af = *(const LAS fragb*)(TinvP + (I * 16 + l15) * 32 + 8 * q);
        fragb A0, A1;
        if (I >= 1) A0 = ld_frag16(Ln + (16 * I + l15) * MP + 8 * q);
        if (I == 3) A1 = ld_frag16(Ln + (16 * I + l15) * MP + 32 + 8 * q);
#pragma unroll
        for (int nt = 0; nt < 4; ++nt) {
            const int crow = 16 * nt + l15; LAS unsigned char* xr = XTw + crow * 128;
            f32x4 a = acc[I][nt];
            if (I >= 1) a = mfma16(A0, *(const LAS fragb*)(xr + ((q ^ (crow & 7)) << 4)), a);
            if (I == 3) a = mfma16(A1, *(const LAS fragb*)(xr + (((4 + q) ^ (crow & 7)) << 4)), a);
            v4u bw; bw.x = pk2(a.x, a.y); bw.y = pk2(a.z, a.w); bw.z = 0u; bw.w = 0u;
            const f32x4 x = mfma16(Af, __builtin_bit_cast(fragb, bw), z4);
            acc[I][nt] = x;
            v2u o; o.x = pk2(x.x, x.y); o.y = pk2(x.z, x.w);
            *(LAS v2u*)(xr + (((2 * I + (q >> 1)) ^ (crow & 7)) << 4) + (q & 1) * 8) = o;
        }
    }
}
__device__ __forceinline__ void diag_inverses(const LAS bf16* Ln, LAS bf16* TinvP, int lane) {
    const int blk = lane >> 4, c = lane & 15;
    float x[16];
#pragma unroll
    for (int i = 0; i < 16; ++i) {
        const LAS bf16* lr = Ln + (16 * blk + i) * MP + 16 * blk;
        const v4u r0 = *(const LAS v4u*)lr, r1 = *(const LAS v4u*)(lr + 8);
        const unsigned rw[8] = {r0.x, r0.y, r0.z, r0.w, r1.x, r1.y, r1.z, r1.w};
        float s = (i == c) ? 1.0f : 0.0f;
#pragma unroll
        for (int j = 0; j < i; ++j) s += ((j & 1) ? bfhi(rw[j >> 1]) : bflo(rw[j >> 1])) * x[j];
        x[i] = s;
        TinvP[(blk * 16 + i) * 32 + 8 * (c >> 2) + (c & 3)] = (bf16)f2bf1(s);
    }
}
__device__ __forceinline__ void gdn_solve_item(const Ctx& C, int l, int item) {
    const int lane = C.lane, w = C.wave, pw = w & 1, pi = w >> 1, l15 = lane & 15, q = lane >> 4;
    LAS unsigned char* B0 = C.lds + pi * 31744;
    LAS bf16* Ln = (LAS bf16*)B0;
    LAS bf16* TinvP = (LAS bf16*)(B0 + 9216);
    LAS float* vec = (LAS float*)(B0 + 13312);
    LAS unsigned char* XT = B0 + 13824;
    LAS bf16* Ks = (LAS bf16*)XT;
    const bf16* P = WSP(const bf16, WS_P); const bf16* gq = WSP(const bf16, WS_GQ);
    const int u = item >> 1, d = item & 1;
    const int c = u % NCH, h = (u / NCH) & 3, b = u / (NCH * NH);
    const int n = d ? (c < 4 ? 3 - c : 71 - c) : c;
    const float aexp = __expf(C.in[I_GALOG][(l * 2 + d) * NH + h]), dtb = C.in[I_GDTB][(l * 2 + d) * NH + h];
    const int rowl = seqrow_cm(n * 64 + lane, d, b);
    const bf16* pg = P + (size_t)rowl * PLD + OFF_D + 1024 + d * 4 + h;
    const float la = -aexp * softplusf_(bf2f(pg[0]) + dtb), beta = sigmoidf_(bf2f(pg[8]));
    const float gam = wave_incl_sum(la, lane);
    if (pw == 0) { vec[lane] = beta; vec[64 + lane] = gam; }
#pragma unroll
    for (int r = 0; r < 4; ++r) { const int idx = pw * 64 + lane + 128 * r, t = idx >> 3, part = idx & 7;
        *(LAS v4u*)(Ks + t * MP + 8 * part) = *(const v4u*)(gq + (size_t)seqrow_cm(n * 64 + t, d, b) * 768 + 256 + h * 64 + 8 * part); }
    { LAS v4u* tz = (LAS v4u*)(B0 + 9216) + (pw * 64 + lane) * 2; tz[0] = (v4u){0u, 0u, 0u, 0u}; tz[1] = (v4u){0u, 0u, 0u, 0u}; }
    f32x4 acc[4][4];
    if (pw == 0) {
#pragma unroll
        for (int I = 0; I < 4; ++I)
#pragma unroll
            for (int r = 0; r < 4; ++r) { const bf16* vr = gq + (size_t)seqrow_cm(n * 64 + 16 * I + 4 * q + r, d, b) * 768 + 512 + h * 64 + l15;
#pragma unroll
                for (int nt = 0; nt < 4; ++nt) acc[I][nt][r] = bf2f(vr[16 * nt]); }
    }
    __syncthreads();
    {
        int tix = 0;
#pragma unroll
        for (int it = 0; it < 4; ++it)
#pragma unroll
            for (int jt = 0; jt < 4; ++jt, ++tix) if ((tix & 1) == pw) {
                f32x4 t4 = (f32x4){0.f, 0.f, 0.f, 0.f};
                if (jt <= it) {
#pragma unroll
                    for (int s = 0; s < 2; ++s) t4 = mfma16(ld_frag16(Ks + (16 * it + l15) * MP + 32 * s + 8 * q), ld_frag16(Ks + (16 * jt + l15) * MP + 32 * s + 8 * q), t4);
                    const float gj = vec[64 + 16 * jt + l15];
                    const f32x4 bi = *(const LAS f32x4*)(vec + 16 * it + 4 * q), gi = *(const LAS f32x4*)(vec + 64 + 16 * it + 4 * q);
#pragma unroll
                    for (int r = 0; r < 4; ++r) { const int i = 16 * it + 4 * q + r, j = 16 * jt + l15; t4[r] = (j < i) ? -(bi[r] * t4[r] * __expf(gi[r] - gj)) : 0.f; }
                }
#pragma unroll
                for (int r = 0; r < 4; ++r) Ln[(16 * it + 4 * q + r) * MP + 16 * jt + l15] = (bf16)f2bf1(t4[r]);
            }
    }
    {
#pragma unroll
        for (int I = 0; I < 4; ++I) {
            const f32x4 bi = *(const LAS f32x4*)(vec + 16 * I + 4 * q), gi = *(const LAS f32x4*)(vec + 64 + 16 * I + 4 * q);
#pragma unroll
            for (int r = 0; r < 4; ++r) { const float sc = pw ? bi[r] * __expf(gi[r]) : bi[r];
#pragma unroll
                for (int nt = 0; nt < 4; ++nt) acc[I][nt][r] = (pw ? bf2f(Ks[(16 * I + 4 * q + r) * MP + 16 * nt + l15]) : acc[I][nt][r]) * sc; }
        }
    }
    __syncthreads();
    if (pw == 0) diag_inverses(Ln, TinvP, lane);
    LAS unsigned char* XTw = XT + pw * 8192;
    { LAS v4u* xz = (LAS v4u*)(XTw + lane * 128);
#pragma unroll
        for (int g = 0; g < 8; ++g) xz[g] = (v4u){0u, 0u, 0u, 0u}; }
    __syncthreads();
    blocked_solve(Ln, TinvP, XTw, acc, l15, q);
    {
        bf16* dst = blob_row(C, d, pw, b, c, h, lane);
        const LAS unsigned char* xr = XTw + lane * 128;
#pragma unroll
        for (int g = 0; g < 8; ++g) *(v4u*)(dst + 8 * g) = *(const LAS v4u*)(xr + ((g ^ (lane & 7)) << 4));
    }
    __syncthreads();
}

template <bool DRY>
__device__ __forceinline__ void gdn_chunked(const Ctx& C, int l, int idx) {
    const int d = idx >> 5, b = (idx >> 2) & 7, h = idx & 3, lane = C.lane, w = C.wave, l15 = lane & 15, q = lane >> 4;
    const int it = w & 3, vtp = w >> 2;
    constexpr int IMG = 64 * MP * 2, BUFB = 5 * IMG + 512;
    LAS unsigned char* L0 = C.lds;
    LAS bf16* VnT = (LAS bf16*)(L0 + 2 * BUFB + 2 * IMG);
    const bf16* P = WSP(const bf16, WS_P); const bf16* gq = WSP(const bf16, WS_GQ); bf16* outd = WSP(bf16, WS_OUTD) + (size_t)d * T_ALL * 256;
    const float aexp = __expf(C.in[I_GALOG][(l * 2 + d) * NH + h]), dtb = C.in[I_GDTB][(l * 2 + d) * NH + h];
    const int tt = C.tid >> 3, part = C.tid & 7;
    for (int i = C.tid; i < 2 * IMG / 4; i += NTHR) ((LAS unsigned*)(L0 + 2 * BUFB))[i] = 0u;
    v4u rq, rk, ru, rw; unsigned short rga;
    auto gload = [&](int n) {
        const int c = d ? (n < 4 ? 3 - n : 71 - n) : n;
        const bf16* pp = gq + (size_t)seqrow_cm(n * 64 + tt, d, b) * 768 + h * 64 + 8 * part;
        rq = *(const v4u*)pp; rk = *(const v4u*)(pp + 256);
        ru = *(const v4u*)(blob_row(C, d, 0, b, c, h, tt) + 8 * part); rw = *(const v4u*)(blob_row(C, d, 1, b, c, h, tt) + 8 * part);
        rga = P[(size_t)seqrow_cm(n * 64 + lane, d, b) * PLD + OFF_D + 1024 + d * 4 + h];
    };
    auto images = [&](int bufi) {
        LAS unsigned char* B0 = L0 + bufi * BUFB;
        LAS bf16* Qs = (LAS bf16*)B0; LAS bf16* Ks = Qs + 64 * MP; LAS bf16* KdT = Ks + 64 * MP; LAS bf16* Wi = KdT + 64 * MP; LAS bf16* UT = Wi + 64 * MP; LAS float* vec = (LAS float*)(B0 + 5 * IMG);
        const float la = -aexp * softplusf_(bf2f(rga) + dtb);
        const float gam = wave_incl_sum(la, lane);
        if (w == 0) vec[lane] = gam;
        const float kd = __expf(__shfl(gam, 63) - gam);
        const float kmine = __shfl(kd, 8 * w + (lane >> 3));
        *(LAS v4u*)(Qs + tt * MP + 8 * part) = rq; *(LAS v4u*)(Ks + tt * MP + 8 * part) = rk; *(LAS v4u*)(UT + tt * MP + 8 * part) = ru;
        const unsigned kk[4] = {rk.x, rk.y, rk.z, rk.w}, ww[4] = {rw.x, rw.y, rw.z, rw.w};
#pragma unroll
        for (int e = 0; e < 4; ++e) {
            KdT[(8 * part + 2 * e) * MP + tt] = (bf16)f2bf1(bflo(kk[e]) * kmine); KdT[(8 * part + 2 * e + 1) * MP + tt] = (bf16)f2bf1(bfhi(kk[e]) * kmine);
            Wi[(8 * part + 2 * e) * MP + tt] = (bf16)(ww[e] & 0xffffu); Wi[(8 * part + 2 * e + 1) * MP + tt] = (bf16)(ww[e] >> 16);
        }
    };
    f32x4 Sst[2]; Sst[0] = Sst[1] = (f32x4){0.f, 0.f, 0.f, 0.f};
    const f32x4 z4 = (f32x4){0.f, 0.f, 0.f, 0.f};
    gload(0); images(0); gload(1);
#pragma unroll 1
    for (int n = 0; n < NCH; ++n) {
        RAW_BARRIER();
        const LAS unsigned char* B0 = L0 + (n & 1) * BUFB;
        const LAS bf16* Qs = (const LAS bf16*)B0; const LAS bf16* Ks = Qs + 64 * MP; const LAS bf16* KdT = Ks + 64 * MP; const LAS bf16* Wi = KdT + 64 * MP; const LAS bf16* UT = Wi + 64 * MP; const LAS float* vec = (const LAS float*)(B0 + 5 * IMG);
        const LAS bf16* ST = (const LAS bf16*)(L0 + 2 * BUFB + (n & 1) * IMG); LAS bf16* STn = (LAS bf16*)(L0 + 2 * BUFB + ((n + 1) & 1) * IMG);
        fragb Qf[2]; Qf[0] = ld_frag16(Qs + (16 * it + l15) * MP + 8 * q); Qf[1] = ld_frag16(Qs + (16 * it + l15) * MP + 32 + 8 * q);
        const float gcol = vec[16 * it + l15]; const int icol = 16 * it + l15;
        f32x4 pt[4];
#pragma unroll
        for (int jt = 0; jt < 4; ++jt) {
            pt[jt] = z4;
            if (jt <= it) {
                const fragb k0 = ld_frag16(Ks + (16 * jt + l15) * MP + 8 * q), k1 = ld_frag16(Ks + (16 * jt + l15) * MP + 32 + 8 * q);
                f32x4 st = mfma16(k0, Qf[0], z4); st = mfma16(k1, Qf[1], st);
                const f32x4 gj = *(const LAS f32x4*)(vec + 16 * jt + 4 * q);
#pragma unroll
                for (int r = 0; r < 4; ++r) { const int j = 16 * jt + 4 * q + r; pt[jt][r] = (j <= icol) ? st[r] * __expf(gcol - gj[r]) : 0.f; }
            }
        }
        fragb Pf[2]; Pf[0] = pack_frag(pt[0], pt[1]); Pf[1] = pack_frag(pt[2], pt[3]);
        const fragb Wf0 = ld_frag16(Wi + (16 * it + l15) * MP + 8 * q), Wf1 = ld_frag16(Wi + (16 * it + l15) * MP + 32 + 8 * q);
        f32x4 Ro[2];
#pragma unroll
        for (int v2 = 0; v2 < 2; ++v2) {
            const int vrow = 16 * (2 * vtp + v2) + l15;
            const fragb s0 = ld_frag16(ST + vrow * MP + 8 * q), s1 = ld_frag16(ST + vrow * MP + 32 + 8 * q);
            f32x4 ws = mfma16(Wf0, s0, z4); ws = mfma16(Wf1, s1, ws);
            Ro[v2] = mfma16(Qf[0], s0, z4); Ro[v2] = mfma16(Qf[1], s1, Ro[v2]);
            const v2u ur = *(const LAS v2u*)(UT + vrow * MP + 16 * it + 4 * q);
            v2u o; o.x = pk2(bflo(ur.x) - ws.x, bfhi(ur.x) - ws.y); o.y = pk2(bflo(ur.y) - ws.z, bfhi(ur.y) - ws.w);
            *(LAS v2u*)(VnT + vrow * MP + 16 * it + 4 * q) = o;
        }
        RAW_BARRIER();
        {
            const f32x4 gi = *(const LAS f32x4*)(vec + 16 * it + 4 * q);
            const float gl = __expf(vec[63]);
            const LAS bf16* kr = KdT + (16 * it + l15) * MP + 4 * q;
            const fragb kt0 = ld_frag8x2(kr, kr + 16), kt1 = ld_frag8x2(kr + 32, kr + 48);
#pragma unroll
            for (int v2 = 0; v2 < 2; ++v2) {
                const int vrow = 16 * (2 * vtp + v2) + l15;
                const LAS bf16* vr = VnT + vrow * MP + 4 * q;
                const fragb n0 = ld_frag8x2(vr, vr + 16), n1 = ld_frag8x2(vr + 32, vr + 48);
                f32x4 o = mfma16(Pf[0], n0, z4); if (it >= 2) o = mfma16(Pf[1], n1, o);
#pragma unroll
                for (int r = 0; r < 4; ++r) { const int row = seqrow_cm(n * 64 + 16 * it + 4 * q + r, d, b);
                    if (!DRY) outd[(size_t)row * 256 + h * 64 + vrow] = (bf16)f2bf1(o[r] + __expf(gi[r]) * Ro[v2][r]); }
                f32x4 ns = mfma16(kt0, n0, z4); ns = mfma16(kt1, n1, ns);
                Sst[v2] = Sst[v2] * gl + ns;
                v2u so; so.x = pk2(Sst[v2].x, Sst[v2].y); so.y = pk2(Sst[v2].z, Sst[v2].w);
                *(LAS v2u*)(STn + vrow * MP + 16 * it + 4 * q) = so;
            }
        }
        if (n + 1 < NCH) { images((n + 1) & 1); if (n + 2 < NCH) gload(n + 2); }
    }
    __syncthreads();
}
constexpr int UP = 264;
template <int CTRL> __device__ __forceinline__ float dpp_keep(float oldv, float v) { return __builtin_bit_cast(float, __builtin_amdgcn_update_dpp(__builtin_bit_cast(int, oldv), __builtin_bit_cast(int, v), CTRL, 0xF, 0xF, false)); }
template <bool REV> __device__ __forceinline__ void scan16(float& A, float& B) {
#define LRU_STEP(S) { const float Ap = dpp_keep<(REV ? 0x100 : 0x110) | S>(1.0f, A), Bp = dpp_keep<(REV ? 0x100 : 0x110) | S>(0.0f, B); B = A * Bp + B; A = A * Ap; }
    LRU_STEP(1) LRU_STEP(2) LRU_STEP(4) LRU_STEP(8)
#undef LRU_STEP
}
constexpr int UPC = 72;
__device__ __forceinline__ int lru_chunk_of(int d, int k) { return d ? (k < 4 ? 3 - k : NCH + 3 - k) : k; }
template <bool REV>
__device__ __forceinline__ void lru_tiles(const LAS bf16* Ud, int th, int mt, int lane, const fragb (&Wa)[2], const fragb (&Wx)[2], const f32x4& ba, const f32x4& bx, const f32x4& sp4,
                                          f32x4 (&Ac)[2], f32x4 (&Hl)[2], f32x4& Atot, f32x4& hend) {
    const int l15 = lane & 15, q = lane >> 4, edge = (lane & 48) | (REV ? 0 : 15);
    const f32x4 z4 = (f32x4){0.f, 0.f, 0.f, 0.f};
    f32x4 tA = z4, tB = z4;
#pragma unroll
    for (int i = 0; i < 2; ++i) {
        const int nt = REV ? 3 - (2 * th + i) : 2 * th + i;
        const LAS bf16* urow = Ud + (16 * nt + l15) * UPC;
        const fragb Uf0 = ld_frag16(urow + 8 * q), Uf1 = ld_frag16(urow + 32 + 8 * q);
        f32x4 aa = mfma16(Wa[0], Uf0, z4); aa = mfma16(Wa[1], Uf1, aa);
        f32x4 ax = mfma16(Wx[0], Uf0, z4); ax = mfma16(Wx[1], Uf1, ax);
        const v2u ur = *(const LAS v2u*)(urow + 16 * mt + 4 * q);
        const f32x4 u4 = (f32x4){bflo(ur.x), bfhi(ur.x), bflo(ur.y), bfhi(ur.y)};
        f32x4 la, iu, A, Bv;
#pragma unroll
        for (int r = 0; r < 4; ++r) { const float rg = sigmoidf_(aa[r] + ba[r]); iu[r] = sigmoidf_(ax[r] + bx[r]) * u4[r]; la[r] = -sp4[r] * rg; }
        const bool sm_ = la[0] > -0.15f && la[1] > -0.15f && la[2] > -0.15f && la[3] > -0.15f;
        if (__builtin_amdgcn_ballot_w64(!sm_) == 0ull) {
#pragma unroll
            for (int r = 0; r < 4; ++r) { const float x = la[r], p = x * (1.0f + x * (0.5f + x * (0.16666667f + x * (0.041666668f + x * (0.0083333338f + x * 0.0013888889f)))));
                A[r] = 1.0f + p; Bv[r] = __builtin_amdgcn_sqrtf(-p * (2.0f + p)) * iu[r]; }
        } else {
#pragma unroll
            for (int r = 0; r < 4; ++r) { A[r] = __expf(la[r]); Bv[r] = __builtin_amdgcn_sqrtf(-expm1f_(2.0f * la[r])) * iu[r]; }
        }
#pragma unroll
        for (int r = 0; r < 4; ++r) { float a_ = A[r], b_ = Bv[r]; scan16<REV>(a_, b_); A[r] = a_; Bv[r] = b_; }
        if (i == 0) {
            Ac[0] = A; Hl[0] = Bv;
#pragma unroll
            for (int r = 0; r < 4; ++r) { tA[r] = __shfl(A[r], edge); tB[r] = __shfl(Bv[r], edge); }
        } else {
            Ac[1] = A * tA; Hl[1] = A * tB + Bv;
#pragma unroll
            for (int r = 0; r < 4; ++r) { Atot[r] = __shfl(Ac[1][r], edge); hend[r] = __shfl(Hl[1][r], edge); }
        }
    }
}
__device__ __forceinline__ void lru_chain(const Ctx& C, int l, int id) {
    const int b = id >> 3, hd = (id >> 1) & 3, chalf = id & 1;
    const int lane = C.lane, l15 = lane & 15, q = lane >> 4;
    const int d = C.wave >> 2, mtl = (C.wave >> 1) & 1, th = C.wave & 1, mt = chalf * 2 + mtl;
    LAS bf16* U = (LAS bf16*)C.lds;
    LAS float* XCH = (LAS float*)(C.lds + 2 * 2 * 64 * UPC * 2);
    bf16* P = WSP(bf16, WS_P); bf16* LH = WSP(bf16, WS_LRUH) + (size_t)id * NSTEP * 32;
    const int cd = C.tid >> 8, cj = C.tid & 63, ctq = (C.tid >> 6) & 3;
    const float* cw = C.in[I_LCW] + (size_t)l * 4 * GW + hd * 64 + cj; const float w0 = cw[0], w1 = cw[GW], w2 = cw[2 * GW], w3 = cw[3 * GW], cb = C.in[I_LCB][l * GW + hd * 64 + cj];
    const bf16* wt = WSP(const bf16, WS_LRUWT) + (size_t)((d * 2 + 0) * 4 + hd) * 4096;
    fragb Wa[2], Wx[2];
#pragma unroll
    for (int ks = 0; ks < 2; ++ks) { Wa[ks] = *(const fragb*)(wt + (16 * mt + l15) * 64 + 32 * ks + 8 * q); Wx[ks] = *(const fragb*)(wt + 4 * 4096 + (16 * mt + l15) * 64 + 32 * ks + 8 * q); }
    const int ch0 = hd * 64 + 16 * mt + 4 * q;
    const f32x4 ba = *(const f32x4*)(C.in[I_LBA] + (l * 2 + d) * GW + ch0), bx = *(const f32x4*)(C.in[I_LBX] + (l * 2 + d) * GW + ch0), lam = *(const f32x4*)(C.in[I_LLAM] + (l * 2 + d) * GW + ch0);
    f32x4 sp4;
#pragma unroll
    for (int r = 0; r < 4; ++r) sp4[r] = 8.0f * softplusf_(-lam[r]);
    f32x4 s = (f32x4){0.f, 0.f, 0.f, 0.f};
    unsigned short xr[19];
#define LRU_LOADX(kk) do { const int c_ = lru_chunk_of(cd, (kk)); const bool ic_ = c_ < 4; const int p0_ = (ic_ ? c_ * 64 : (c_ - 4) * 64) + ctq * 16 - 2, Lp_ = ic_ ? CTXL : SEQ; \
        const bf16* xp_ = P + (size_t)(ic_ ? T_LAT + b * CTXL : b * SEQ) * PLD + hd * 64 + cj; \
        _Pragma("unroll") for (int i_ = 0; i_ < 19; ++i_) { const int p_ = p0_ + i_; xr[i_] = (p_ >= 0 && p_ < Lp_) ? xp_[(size_t)p_ * PLD] : (unsigned short)0; } } while (0)
#define LRU_CONV(kk) do { LAS bf16* uo_ = U + ((((kk) & 1) * 2 + cd) * 64 + ctq * 16) * UPC + cj; \
        _Pragma("unroll") for (int t_ = 0; t_ < 16; ++t_) uo_[t_ * UPC] = (bf16)f2bf1(w0 * bf2f(xr[t_]) + w1 * bf2f(xr[t_ + 1]) + w2 * bf2f(xr[t_ + 2]) + w3 * bf2f(xr[t_ + 3]) + cb); } while (0)
    LRU_LOADX(0); LRU_CONV(0); LRU_LOADX(1);
    __syncthreads();
#pragma unroll 1
    for (int k = 0; k < NCH; ++k) {
        if (k + 1 < NCH) { LRU_CONV(k + 1); if (k + 2 < NCH) LRU_LOADX(k + 2); }
        const int c = lru_chunk_of(d, k); const bool second = lru_chunk_of(1 - d, c) < k;
        const bool ic = c < 4; const size_t row0 = (size_t)(ic ? T_LAT + b * CTXL + c * 64 : b * SEQ + (c - 4) * 64);
        const bool late = (k == 2) || (k == 36);
        int tok[2]; v2u gv[2], fv[2];
#pragma unroll
        for (int i = 0; i < 2; ++i) { const int nt = d ? 3 - (2 * th + i) : 2 * th + i; tok[i] = 16 * nt + l15;
            if (second && !late) { gv[i] = *(const v2u*)(P + (row0 + tok[i]) * PLD + 256 + ch0); fv[i] = *(const v2u*)(LH + (size_t)(c * 64 + tok[i]) * 32 + 16 * mtl + 4 * q); } }
        f32x4 Ac[2], Hl[2], Atot, hend;
        const LAS bf16* Ud = U + ((k & 1) * 2 + d) * 64 * UPC;
        if (d) lru_tiles<true>(Ud, th, mt, lane, Wa, Wx, ba, bx, sp4, Ac, Hl, Atot, hend); else lru_tiles<false>(Ud, th, mt, lane, Wa, Wx, ba, bx, sp4, Ac, Hl, Atot, hend);
        LAS float* xw = XCH + (((((k & 1) * 2 + d) * 2 + mtl) * 2 + th) * 4 + q) * 8;
        if (l15 == (d ? 0 : 15)) { *(LAS f32x4*)xw = Atot; *(LAS f32x4*)(xw + 4) = hend; }
        if (late) VM_WAIT();
        RAW_BARRIER();
        if (second && late) {
#pragma unroll
            for (int i = 0; i < 2; ++i) { gv[i] = *(const v2u*)(P + (row0 + tok[i]) * PLD + 256 + ch0); fv[i] = *(const v2u*)(LH + (size_t)(c * 64 + tok[i]) * 32 + 16 * mtl + 4 * q); }
        }
        const LAS float* xr0 = XCH + (((((k & 1) * 2 + d) * 2 + mtl) * 2 + 0) * 4 + q) * 8;
        const f32x4 A0 = *(const LAS f32x4*)xr0, h0 = *(const LAS f32x4*)(xr0 + 4), A1 = *(const LAS f32x4*)(xr0 + 32), h1 = *(const LAS f32x4*)(xr0 + 36);
        const f32x4 mid = A0 * s + h0, hin = th ? mid : s;
        s = A1 * mid + h1;
#pragma unroll
        for (int i = 0; i < 2; ++i) {
            const f32x4 h = Ac[i] * hin + Hl[i];
            if (!second) { v2u o; o.x = pk2(h.x, h.y); o.y = pk2(h.z, h.w); *(v2u*)(LH + (size_t)(c * 64 + tok[i]) * 32 + 16 * mtl + 4 * q) = o; }
            else {
                const f32x4 g = (f32x4){bflo(gv[i].x), bfhi(gv[i].x), bflo(gv[i].y), bfhi(gv[i].y)};
                f32x4 y = (f32x4){h.x + bflo(fv[i].x), h.y + bfhi(fv[i].x), h.z + bflo(fv[i].y), h.w + bfhi(fv[i].y)};
                y.x *= gelu_tanh(g.x); y.y *= gelu_tanh(g.y); y.z *= gelu_tanh(g.z); y.w *= gelu_tanh(g.w);
                st4bf(P + (row0 + tok[i]) * PLD + 256 + ch0, y);
            }
        }
    }
#undef LRU_LOADX
#undef LRU_CONV
    __syncthreads();
}
constexpr int RP = 264;
__device__ __forceinline__ void rwkv_prep2(const Ctx& C, int l, int b, int c) {
    LAS bf16* RS = (LAS bf16*)C.lds;
    LAS bf16* KS = RS + 64 * RP;
    LAS bf16* XW = KS + 64 * RP;
    LAS bf16* XA = XW + 64 * MP;
    LAS bf16* XG = XA + 64 * MP;
    const bf16* P = WSP(const bf16, WS_P);
    const bool isctx = c < 4; const int p0 = isctx ? c * 64 : (c - 4) * 64; const int Lp = isctx ? CTXL : SEQ; const int row0 = isctx ? T_LAT + b * CTXL : b * SEQ;
    const float* mu = C.in[I_RMU] + (size_t)l * 2 * B_COLS;
    bf16* rkv = WSP(bf16, WS_RKV);
#pragma unroll 5
    for (int it = C.tid; it < 64 * 120; it += NTHR) {
        const int t = it / 120, c8 = (it % 120) * 8, p = p0 + t;
        const bf16* pp = P + (size_t)(row0 + p) * PLD + OFF_B + c8;
        const v4u xc = *(const v4u*)pp; v4u xp = (v4u){0u, 0u, 0u, 0u}, xn = xp;
        if (p > 0) xp = *(const v4u*)(pp - PLD);
        if (p < Lp - 1) xn = *(const v4u*)(pp + PLD);
        const f32x4 m0a = *(const f32x4*)(mu + c8), m0b = *(const f32x4*)(mu + c8 + 4), m1a = *(const f32x4*)(mu + B_COLS + c8), m1b = *(const f32x4*)(mu + B_COLS + c8 + 4);
        const unsigned xcw[4] = {xc.x, xc.y, xc.z, xc.w}, xpw[4] = {xp.x, xp.y, xp.z, xp.w}, xnw[4] = {xn.x, xn.y, xn.z, xn.w};
        float sh[8];
#pragma unroll
        for (int e = 0; e < 4; ++e) {
            const float x0 = bflo(xcw[e]), x1 = bfhi(xcw[e]);
            const float mu0_0 = e < 2 ? m0a[2 * e] : m0b[2 * e - 4], mu0_1 = e < 2 ? m0a[2 * e + 1] : m0b[2 * e - 3], mu1_0 = e < 2 ? m1a[2 * e] : m1b[2 * e - 4], mu1_1 = e < 2 ? m1a[2 * e + 1] : m1b[2 * e - 3];
            sh[2 * e] = x0 + mu0_0 * (bflo(xpw[e]) - x0) + mu1_0 * (bflo(xnw[e]) - x0);
            sh[2 * e + 1] = x1 + mu0_1 * (bfhi(xpw[e]) - x1) + mu1_1 * (bfhi(xnw[e]) - x1);
        }
        if (c8 >= 768) {
            const int ci = c8 - 768;
            if (ci < 64) {
#pragma unroll
                for (int e = 0; e < 8; ++e) sh[e] = tanhf_(sh[e]); }
            else if (ci >= 128) {
#pragma unroll
                for (int e = 0; e < 8; ++e) sh[e] = sigmoidf_(sh[e]); }
        }
        v4u o; o.x = pk2(sh[0], sh[1]); o.y = pk2(sh[2], sh[3]); o.z = pk2(sh[4], sh[5]); o.w = pk2(sh[6], sh[7]);
        if (c8 < 768) {
            *(v4u*)(rkv + (size_t)(row0 + p) * 768 + c8) = o;
            if (c8 < 256) *(LAS v4u*)(RS + t * RP + c8) = o; else if (c8 < 512) *(LAS v4u*)(KS + t * RP + c8 - 256) = o;
        } else {
            const int ci = c8 - 768;
            LAS bf16* dst = ci < 64 ? XW + t * MP + ci : (ci < 128 ? XA + t * MP + ci - 64 : XG + t * MP + ci - 128);
            *(LAS v4u*)dst = o;
        }
    }
    __syncthreads();
    const int lane = C.lane, w = C.wave, l15 = lane & 15, q = lane >> 4, hd = w & 3, ntp = w >> 2;
    const bf16* wt = WSP(const bf16, WS_RWT);
    bf16* wa_out = WSP(bf16, WS_HB); bf16* g_out = WSP(bf16, WS_G); float* bonus = WSP(float, WS_BONUS); float* rinv = WSP(float, WS_RINV);
    const f32x4 z4 = (f32x4){0.f, 0.f, 0.f, 0.f};
    float bsum[2] = {0.f, 0.f}, ksum[2] = {0.f, 0.f};
#pragma unroll
    for (int n2 = 0; n2 < 2; ++n2) {
        const int tok = 16 * (2 * ntp + n2) + l15; const size_t row = (size_t)(row0 + p0 + tok);
        const fragb xw0 = ld_frag16(XW + tok * MP + 8 * q), xw1 = ld_frag16(XW + tok * MP + 32 + 8 * q), xa0 = ld_frag16(XA + tok * MP + 8 * q), xa1 = ld_frag16(XA + tok * MP + 32 + 8 * q);
        const fragb xg0 = ld_frag16(XG + tok * MP + 8 * q), xg1 = ld_frag16(XG + tok * MP + 32 + 8 * q);
        unsigned ow0[8], ow1[8], oa0[8], oa1[8], og[8];
#pragma unroll
        for (int mt = 0; mt < 4; ++mt) {
            const int chl = 16 * (l15 >> 2) + 4 * mt + (l15 & 3), ch4 = hd * 64 + 16 * q + 4 * mt;
            const bf16* wrow = wt + (size_t)(hd * 64 + chl) * 32 + 8 * q;
            const bf16* grow = wt + 4 * 256 * 32 + (size_t)(hd * 64 + chl) * 64 + 8 * q;
            const fragb fw0 = *(const fragb*)(wrow), fw1 = *(const fragb*)(wrow + 256 * 32), fa0 = *(const fragb*)(wrow + 2 * 256 * 32), fa1 = *(const fragb*)(wrow + 3 * 256 * 32), fg0 = *(const fragb*)(grow), fg1 = *(const fragb*)(grow + 32);
            const f32x4 w00 = *(const f32x4*)(C.in[I_RW0] + (l * 2 + 0) * GW + ch4), w01 = *(const f32x4*)(C.in[I_RW0] + (l * 2 + 1) * GW + ch4);
            const f32x4 a00 = *(const f32x4*)(C.in[I_RA0] + (l * 2 + 0) * GW + ch4), a01 = *(const f32x4*)(C.in[I_RA0] + (l * 2 + 1) * GW + ch4);
            const f32x4 k_a = *(const f32x4*)(C.in[I_RKA] + l * GW + ch4), r_k = *(const f32x4*)(C.in[I_RRK] + l * GW + ch4), k_k = *(const f32x4*)(C.in[I_RKK] + l * GW + ch4);
            const f32x4 aw0 = mfma16(fw0, xw0, z4), aw1 = mfma16(fw1, xw1, z4), aa0 = mfma16(fa0, xa0, z4), aa1 = mfma16(fa1, xa1, z4);
            f32x4 ag = mfma16(fg0, xg0, z4); ag = mfma16(fg1, xg1, ag);
            f32x4 wv0, wv1, av0, av1;
#pragma unroll
            for (int r = 0; r < 4; ++r) {
                wv0[r] = __expf(-0.6065306597126334f * sigmoidf_(aw0[r] + w00[r])); wv1[r] = __expf(-0.6065306597126334f * sigmoidf_(aw1[r] + w01[r]));
                av0[r] = sigmoidf_(aa0[r] + a00[r]); av1[r] = sigmoidf_(aa1[r] + a01[r]);
            }
            ow0[2 * mt] = pk2(wv0[0], wv0[1]); ow0[2 * mt + 1] = pk2(wv0[2], wv0[3]); ow1[2 * mt] = pk2(wv1[0], wv1[1]); ow1[2 * mt + 1] = pk2(wv1[2], wv1[3]);
            oa0[2 * mt] = pk2(av0[0], av0[1]); oa0[2 * mt + 1] = pk2(av0[2], av0[3]); oa1[2 * mt] = pk2(av1[0], av1[1]); oa1[2 * mt + 1] = pk2(av1[2], av1[3]);
            og[2 * mt] = pk2(ag[0], ag[1]); og[2 * mt + 1] = pk2(ag[2], ag[3]);
            const v2u rr_ = *(const LAS v2u*)(RS + tok * RP + ch4), kr_ = *(const LAS v2u*)(KS + tok * RP + ch4);
            const f32x4 rs = (f32x4){bflo(rr_.x), bfhi(rr_.x), bflo(rr_.y), bfhi(rr_.y)}, ks = (f32x4){bflo(kr_.x), bfhi(kr_.x), bflo(kr_.y), bfhi(kr_.y)};
#pragma unroll
            for (int r = 0; r < 4; ++r) {
                const float km = ks[r] * (1.0f + (av0[r] - 1.0f) * k_a[r]) + ks[r] * (1.0f + (av1[r] - 1.0f) * k_a[r]);
                bsum[n2] += rs[r] * r_k[r] * km; const float kk = ks[r] * k_k[r]; ksum[n2] += kk * kk;
            }
        }
        bf16* wrow_o = wa_out + row * 1024 + hd * 64 + 16 * q;
        *(v4u*)(wrow_o) = (v4u){ow0[0], ow0[1], ow0[2], ow0[3]}; *(v4u*)(wrow_o + 8) = (v4u){ow0[4], ow0[5], ow0[6], ow0[7]};
        *(v4u*)(wrow_o + 256) = (v4u){ow1[0], ow1[1], ow1[2], ow1[3]}; *(v4u*)(wrow_o + 256 + 8) = (v4u){ow1[4], ow1[5], ow1[6], ow1[7]};
        *(v4u*)(wrow_o + 512) = (v4u){oa0[0], oa0[1], oa0[2], oa0[3]}; *(v4u*)(wrow_o + 512 + 8) = (v4u){oa0[4], oa0[5], oa0[6], oa0[7]};
        *(v4u*)(wrow_o + 768) = (v4u){oa1[0], oa1[1], oa1[2], oa1[3]}; *(v4u*)(wrow_o + 768 + 8) = (v4u){oa1[4], oa1[5], oa1[6], oa1[7]};
        bf16* grow_o = g_out + row * 256 + hd * 64 + 16 * q;
        *(v4u*)(grow_o) = (v4u){og[0], og[1], og[2], og[3]}; *(v4u*)(grow_o + 8) = (v4u){og[4], og[5], og[6], og[7]};
    }
#pragma unroll
    for (int n2 = 0; n2 < 2; ++n2) {
        const size_t row = (size_t)(row0 + p0 + 16 * (2 * ntp + n2) + l15);
        float bs = bsum[n2], ks2 = ksum[n2];
        bs += __shfl_xor(bs, 16); bs += __shfl_xor(bs, 32); ks2 += __shfl_xor(ks2, 16); ks2 += __shfl_xor(ks2, 32);
        if (q == 0) { bonus[row * 4 + hd] = bs; rinv[row * 4 + hd] = rsqrtf_(ks2 + 1e-6f); }
    }
    __syncthreads();
}
__device__ __forceinline__ int fwd_row_r(int b, int c, int t) { return c < 4 ? (T_LAT + b * CTXL + c * 64 + t) : (b * SEQ + (c - 4) * 64 + t); }
__device__ __forceinline__ bf16* rw_blob_row(const Ctx& C, int d, int which, int b, int c, int h, int r) {
    const int row = fwd_row_r(b, c, r);
#if RW_VSPLIT
    if (which == 0) { if (d) return WSP(bf16, WS_GQ) + (size_t)row * 768 + 512 + h * 64;
                      return WSP(bf16, WS_P) + (size_t)row * PLD + OFF_B + 512 + h * 64; }
#else
    if (which == 0) return WSP(bf16, WS_OUTB) + ((size_t)d * T_ALL + row) * 256 + h * 64;
#endif
    return WSP(bf16, WS_P) + (size_t)row * PLD + OFF_B + d * 256 + h * 64;
}
__device__ __forceinline__ void rwkv_solve_item(const Ctx& C, int l, int item) {
    const int lane = C.lane, w = C.wave, pw = w & 1, pi = w >> 1, l15 = lane & 15, q = lane >> 4;
    LAS unsigned char* B0 = C.lds + pi * 31744;
    LAS bf16* Kk = (LAS bf16*)B0; LAS bf16* Bh = Kk + 64 * MP; LAS bf16* Kh = Bh + 64 * MP;
    LAS bf16* Ln = (LAS bf16*)B0;
    LAS bf16* Lk16 = (LAS bf16*)(B0 + 9216);
    LAS unsigned char* XT = B0 + 9216;
    LAS bf16* TinvP = (LAS bf16*)(B0 + 25600);
    const bf16* WA = WSP(const bf16, WS_HB); bf16* WAw = WSP(bf16, WS_HB); const bf16* rkv = WSP(const bf16, WS_RKV); const float* rinv = WSP(const float, WS_RINV);
    const int u = item >> 1, d = item & 1;
    const int c = u % NCH, h = (u / NCH) & 3, b = u / (NCH * NH);
    const float k_k = C.in[I_RKK][l * GW + h * 64 + lane], k_a = C.in[I_RKA][l * GW + h * 64 + lane];
    const int n = d ? (c < 4 ? 3 - c : 71 - c) : c;
    const float ril = rinv[(size_t)seqrow_raster(n * 64 + lane, d, b) * 4 + h];
#pragma unroll
    for (int r = 0; r < 4; ++r) { const int idx2 = pw * 64 + lane + 128 * r, t = idx2 >> 3, part = idx2 & 7; const int row = seqrow_raster(n * 64 + t, d, b);
        *(LAS v4u*)(Kk + t * MP + 8 * part) = *(const v4u*)(WA + (size_t)row * 1024 + d * 256 + h * 64 + 8 * part);
        *(LAS v4u*)(Bh + t * MP + 8 * part) = *(const v4u*)(WA + (size_t)row * 1024 + (2 + d) * 256 + h * 64 + 8 * part);
        *(LAS v4u*)(Kh + t * MP + 8 * part) = *(const v4u*)(rkv + (size_t)row * 768 + 256 + h * 64 + 8 * part); }
    __syncthreads();
    {
        float cc = 1.0f;
        if (pw) {
#pragma unroll
            for (int t = 0; t < 32; ++t) cc *= bf2f(Kk[t * MP + lane]);
        }
        __syncthreads();
#pragma unroll
        for (int t2 = 0; t2 < 32; ++t2) {
            const int t = pw * 32 + t2;
            const float wv = bf2f(Kk[t * MP + lane]), av = bf2f(Bh[t * MP + lane]), ks = bf2f(Kh[t * MP + lane]);
            const float kap = ks * k_k * __shfl(ril, t);
            const float cprev = cc; cc *= wv; const float ic = __builtin_amdgcn_rcpf(cc);
            Kk[t * MP + lane] = (bf16)f2bf1(kap * cprev); Bh[t * MP + lane] = (bf16)f2bf1(kap * av * ic); Kh[t * MP + lane] = (bf16)f2bf1(ks * (1.0f + (av - 1.0f) * k_a) * ic);
            WAw[(size_t)seqrow_raster(n * 64 + t, d, b) * 1024 + d * 256 + h * 64 + lane] = (bf16)f2bf1(cc);
        }
    }
    __syncthreads();
    f32x4 acc[4][4];
    if (pw == 0) {
#pragma unroll
        for (int I = 0; I < 4; ++I)
#pragma unroll
            for (int r = 0; r < 4; ++r)
#pragma unroll
                for (int nt = 0; nt < 4; ++nt) acc[I][nt][r] = bf2f(Kk[(16 * I + 4 * q + r) * MP + 16 * nt + l15]);
    }
    f32x4 T[10];
    {
        const LAS bf16* Bsrc = pw ? Kh : Bh;
        int tix = 0;
#pragma unroll
        for (int it = 0; it < 4; ++it)
#pragma unroll
            for (int jt = 0; jt <= it; ++jt, ++tix) {
                f32x4 t4 = (f32x4){0.f, 0.f, 0.f, 0.f};
#pragma unroll
                for (int s = 0; s < 2; ++s) t4 = mfma16(ld_frag16(Kk + (16 * it + l15) * MP + 32 * s + 8 * q), ld_frag16(Bsrc + (16 * jt + l15) * MP + 32 * s + 8 * q), t4);
#pragma unroll
                for (int r = 0; r < 4; ++r) { const int i = 16 * it + 4 * q + r, j = 16 * jt + l15; T[tix][r] = (j < i) ? (pw ? t4[r] : -t4[r]) : 0.f; }
            }
    }
    __syncthreads();
    {
        int tix = 0;
#pragma unroll
        for (int it = 0; it < 4; ++it)
#pragma unroll
            for (int jt = 0; jt < 4; ++jt) {
                if (jt <= it) {
#pragma unroll
                    for (int r = 0; r < 4; ++r) (pw ? Lk16 : Ln)[(16 * it + 4 * q + r) * MP + 16 * jt + l15] = (bf16)f2bf1(T[tix][r]);
                    ++tix;
                } else if (pw == 0) {
#pragma unroll
                    for (int r = 0; r < 4; ++r) Ln[(16 * it + 4 * q + r) * MP + 16 * jt + l15] = (bf16)0;
                }
            }
        LAS v4u* tz = (LAS v4u*)(B0 + 25600) + (pw * 64 + lane) * 2; tz[0] = (v4u){0u, 0u, 0u, 0u}; tz[1] = (v4u){0u, 0u, 0u, 0u};
    }
    __syncthreads();
    if (pw) {
#pragma unroll
        for (int I = 0; I < 4; ++I)
#pragma unroll
            for (int r = 0; r < 4; ++r)
#pragma unroll
                for (int nt = 0; nt < 4; ++nt) { const int i = 16 * I + 4 * q + r, j = 16 * nt + l15; acc[I][nt][r] = (j < i && nt <= I) ? bf2f(Lk16[i * MP + j]) : 0.f; }
    } else diag_inverses(Ln, TinvP, lane);
    __syncthreads();
    LAS unsigned char* XTw = XT + pw * 8192;
    { LAS v4u* xz = (LAS v4u*)(XTw + lane * 128);
#pragma unroll
        for (int g = 0; g < 8; ++g) xz[g] = (v4u){0u, 0u, 0u, 0u}; }
    blocked_solve(Ln, TinvP, XTw, acc, l15, q);
    {
        bf16* dst = rw_blob_row(C, d, pw, b, c, h, lane);
        const LAS unsigned char* xr = XTw + lane * 128;
#pragma unroll
        for (int g = 0; g < 8; ++g) *(v4u*)(dst + 8 * g) = *(const LAS v4u*)(xr + ((g ^ (lane & 7)) << 4));
    }
    __syncthreads();
}

template <bool DRY>
__device__ __forceinline__ void rwkv_chunked(const Ctx& C, int l, int idx) {
#ifndef RW_VSPLIT
#define RW_VSPLIT 1
#endif
    constexpr int NV = RW_VSPLIT ? 1 : 2;
    const int vhalf = idx & 1, lane = C.lane, w = C.wave, l15 = lane & 15, q = lane >> 4;
    const int d = RW_VSPLIT ? idx >> 6 : idx >> 5, b = RW_VSPLIT ? (idx >> 3) & 7 : (idx >> 2) & 7, h = RW_VSPLIT ? (idx >> 1) & 3 : idx & 3;
    const int it = w & 3, vt0 = RW_VSPLIT ? 2 * vhalf + (w >> 2) : 2 * (w >> 2);
    constexpr int IMG = 64 * MP * 2;
    LAS unsigned char* L0 = C.lds;
    LAS bf16* Wi = (LAS bf16*)L0; LAS bf16* Ti = Wi + 64 * MP; LAS bf16* Rh = Ti + 64 * MP; LAS bf16* Kh = Rh + 64 * MP; LAS bf16* Bh = Kh + 64 * MP;
    LAS bf16* UT = (LAS bf16*)(L0 + 11 * IMG);
    LAS float* cLv = (LAS float*)(L0 + 14 * IMG);
    const bf16* WA = WSP(const bf16, WS_HB); const bf16* rkv = WSP(const bf16, WS_RKV); const float* rinv = WSP(const float, WS_RINV);
    bf16* outb = WSP(bf16, WS_OUTB) + (size_t)d * T_ALL * 256;
    const int tt = C.tid >> 3, part = C.tid & 7;
    for (int i = C.tid; i < 2 * IMG / 4; i += NTHR) ((LAS unsigned*)(L0 + 12 * IMG))[i] = 0u;
    float kkw[8], kaw[8];
#pragma unroll
    for (int e = 0; e < 8; ++e) { kkw[e] = C.in[I_RKK][l * GW + h * 64 + 8 * w + e]; kaw[e] = C.in[I_RKA][l * GW + h * 64 + 8 * w + e]; }
    v4u gr, gk, gv, gw, ga, gbw, gbt; float gri;
    auto gload = [&](int n) {
        const int c = d ? (n < 4 ? 3 - n : 71 - n) : n;
        const int row = seqrow_raster(n * 64 + lane, d, b);
        const bf16* pr = rkv + (size_t)row * 768 + h * 64 + 8 * w;
        gr = *(const v4u*)pr; gk = *(const v4u*)(pr + 256); gv = *(const v4u*)(pr + 512);
        gw = *(const v4u*)(WA + (size_t)row * 1024 + d * 256 + h * 64 + 8 * w); ga = *(const v4u*)(WA + (size_t)row * 1024 + (2 + d) * 256 + h * 64 + 8 * w);
        gri = rinv[(size_t)row * 4 + h];
        gbw = *(const v4u*)(rw_blob_row(C, d, 0, b, c, h, tt) + 8 * part); gbt = *(const v4u*)(rw_blob_row(C, d, 1, b, c, h, tt) + 8 * part);
    };
    auto images = [&](int bufi) {
        LAS bf16* VT = (LAS bf16*)(L0 + (5 + 3 * bufi) * IMG); LAS bf16* KcT = VT + 64 * MP; LAS bf16* BcT = KcT + 64 * MP;
        const unsigned rw_[4] = {gr.x, gr.y, gr.z, gr.w}, kw_[4] = {gk.x, gk.y, gk.z, gk.w}, vw_[4] = {gv.x, gv.y, gv.z, gv.w}, ww_[4] = {gw.x, gw.y, gw.z, gw.w}, aw_[4] = {ga.x, ga.y, ga.z, ga.w};
        float rh[8], kh[8], bh[8];
#pragma unroll
        for (int e = 0; e < 8; ++e) {
            const float rs = (e & 1) ? bfhi(rw_[e >> 1]) : bflo(rw_[e >> 1]), ks = (e & 1) ? bfhi(kw_[e >> 1]) : bflo(kw_[e >> 1]);
            const float wv = (e & 1) ? bfhi(ww_[e >> 1]) : bflo(ww_[e >> 1]), av = (e & 1) ? bfhi(aw_[e >> 1]) : bflo(aw_[e >> 1]);
            const float kap = ks * kkw[e] * gri, ktil = ks * (1.0f + (av - 1.0f) * kaw[e]);
            const float cf = wv, icf = __builtin_amdgcn_rcpf(cf), cfL = __builtin_bit_cast(float, __builtin_amdgcn_readlane(__builtin_bit_cast(int, cf), 63)), dec = cfL * icf;
            rh[e] = rs * cf; kh[e] = ktil * icf; bh[e] = kap * av * icf;
            const unsigned short vraw = (e & 1) ? (unsigned short)(vw_[e >> 1] >> 16) : (unsigned short)(vw_[e >> 1] & 0xffffu);
            VT[(8 * w + e) * MP + lane] = vraw; KcT[(8 * w + e) * MP + lane] = (bf16)f2bf1(ktil * dec); BcT[(8 * w + e) * MP + lane] = (bf16)f2bf1(-(kap * av * dec));
            if (lane == 63) cLv[bufi * 64 + 8 * w + e] = cfL;
        }
        { v4u o; o.x = pk2(rh[0], rh[1]); o.y = pk2(rh[2], rh[3]); o.z = pk2(rh[4], rh[5]); o.w = pk2(rh[6], rh[7]); *(LAS v4u*)(Rh + lane * MP + 8 * w) = o; }
        { v4u o; o.x = pk2(kh[0], kh[1]); o.y = pk2(kh[2], kh[3]); o.z = pk2(kh[4], kh[5]); o.w = pk2(kh[6], kh[7]); *(LAS v4u*)(Kh + lane * MP + 8 * w) = o; }
        { v4u o; o.x = pk2(bh[0], bh[1]); o.y = pk2(bh[2], bh[3]); o.z = pk2(bh[4], bh[5]); o.w = pk2(bh[6], bh[7]); *(LAS v4u*)(Bh + lane * MP + 8 * w) = o; }
        const unsigned bw_[4] = {gbw.x, gbw.y, gbw.z, gbw.w}, bt_[4] = {gbt.x, gbt.y, gbt.z, gbt.w};
#pragma unroll
        for (int e = 0; e < 4; ++e) {
            Wi[(8 * part + 2 * e) * MP + tt] = (bf16)(bw_[e] & 0xffffu); Wi[(8 * part + 2 * e + 1) * MP + tt] = (bf16)(bw_[e] >> 16);
            Ti[(8 * part + 2 * e) * MP + tt] = (bf16)(bt_[e] & 0xffffu); Ti[(8 * part + 2 * e + 1) * MP + tt] = (bf16)(bt_[e] >> 16);
        }
    };
    f32x4 Zst[NV];
#pragma unroll
    for (int v2 = 0; v2 < NV; ++v2) Zst[v2] = (f32x4){0.f, 0.f, 0.f, 0.f};
    const f32x4 z4 = (f32x4){0.f, 0.f, 0.f, 0.f};
    gload(0); images(0); gload(1);
#pragma unroll 1
    for (int n = 0; n < NCH; ++n) {
        RAW_BARRIER();
        const LAS bf16* VT = (const LAS bf16*)(L0 + (5 + 3 * (n & 1)) * IMG); const LAS bf16* KcT = VT + 64 * MP; const LAS bf16* BcT = KcT + 64 * MP;
        const LAS bf16* Zi = (const LAS bf16*)(L0 + (12 + (n & 1)) * IMG); LAS bf16* Zn = (LAS bf16*)(L0 + (12 + ((n + 1) & 1)) * IMG);
        const int arow = (16 * it + l15) * MP + 8 * q;
        const fragb Wf0 = ld_frag16(Wi + arow), Wf1 = ld_frag16(Wi + arow + 32), Tf0 = ld_frag16(Ti + arow), Tf1 = ld_frag16(Ti + arow + 32), Rf0 = ld_frag16(Rh + arow), Rf1 = ld_frag16(Rh + arow + 32);
        const int icol = 16 * it + l15;
        f32x4 pk[4], pb[4];
#pragma unroll
        for (int jt = 0; jt < 4; ++jt) {
            pk[jt] = z4; pb[jt] = z4;
            if (jt <= it) {
                const int jrow = (16 * jt + l15) * MP + 8 * q;
                f32x4 sk = mfma16(ld_frag16(Kh + jrow), Rf0, z4); sk = mfma16(ld_frag16(Kh + jrow + 32), Rf1, sk);
                f32x4 sb = mfma16(ld_frag16(Bh + jrow), Rf0, z4); sb = mfma16(ld_frag16(Bh + jrow + 32), Rf1, sb);
#pragma unroll
                for (int r = 0; r < 4; ++r) { const int j = 16 * jt + 4 * q + r; pk[jt][r] = (j <= icol) ? sk[r] : 0.f; pb[jt][r] = (j <= icol) ? -sb[r] : 0.f; }
            }
        }
        fragb Pk0 = pack_frag(pk[0], pk[1]), Pk1 = pack_frag(pk[2], pk[3]), Pb0 = pack_frag(pb[0], pb[1]), Pb1 = pack_frag(pb[2], pb[3]);
        f32x4 RZ[NV];
#pragma unroll
        for (int v2 = 0; v2 < NV; ++v2) {
            const int vrow = 16 * (vt0 + v2) + l15;
            const fragb z0 = ld_frag16(Zi + vrow * MP + 8 * q), z1 = ld_frag16(Zi + vrow * MP + 32 + 8 * q);
            f32x4 u = mfma16(Wf0, z0, z4); u = mfma16(Wf1, z1, u);
            u = mfma16(Tf0, ld_frag16(VT + vrow * MP + 8 * q), u); if (it >= 2) u = mfma16(Tf1, ld_frag16(VT + vrow * MP + 32 + 8 * q), u);
            RZ[v2] = mfma16(Rf0, z0, z4); RZ[v2] = mfma16(Rf1, z1, RZ[v2]);
            v2u o; o.x = pk2(u.x, u.y); o.y = pk2(u.z, u.w);
            *(LAS v2u*)(UT + vrow * MP + 16 * it + 4 * q) = o;
        }
        RAW_BARRIER();
        {
            const f32x4 cl4 = *(const LAS f32x4*)(cLv + (n & 1) * 64 + 16 * it + 4 * q);
            const LAS bf16* kr = KcT + (16 * it + l15) * MP + 4 * q; const LAS bf16* br = BcT + (16 * it + l15) * MP + 4 * q;
            const fragb kc0 = ld_frag8x2(kr, kr + 16), kc1 = ld_frag8x2(kr + 32, kr + 48), bc0 = ld_frag8x2(br, br + 16), bc1 = ld_frag8x2(br + 32, br + 48);
#pragma unroll
            for (int v2 = 0; v2 < NV; ++v2) {
                const int vrow = 16 * (vt0 + v2) + l15;
                const LAS bf16* vr = VT + vrow * MP + 4 * q; const LAS bf16* ur = UT + vrow * MP + 4 * q;
                const fragb vp0 = ld_frag8x2(vr, vr + 16), vp1 = ld_frag8x2(vr + 32, vr + 48), up0 = ld_frag8x2(ur, ur + 16), up1 = ld_frag8x2(ur + 32, ur + 48);
                f32x4 y = mfma16(Pk0, vp0, RZ[v2]); y = mfma16(Pb0, up0, y);
                if (it >= 2) { y = mfma16(Pk1, vp1, y); y = mfma16(Pb1, up1, y); }
#pragma unroll
                for (int r = 0; r < 4; ++r) { const int row = seqrow_raster(n * 64 + 16 * it + 4 * q + r, d, b); if (!DRY) outb[(size_t)row * 256 + h * 64 + vrow] = (bf16)f2bf1(y[r]); }
                f32x4 zn = mfma16(kc0, vp0, z4); zn = mfma16(kc1, vp1, zn); zn = mfma16(bc0, up0, zn); zn = mfma16(bc1, up1, zn);
                Zst[v2] = Zst[v2] * cl4 + zn;
                v2u so; so.x = pk2(Zst[v2].x, Zst[v2].y); so.y = pk2(Zst[v2].z, Zst[v2].w);
                *(LAS v2u*)(Zn + vrow * MP + 16 * it + 4 * q) = so;
            }
        }
        if (n + 1 < NCH) { images((n + 1) & 1); if (n + 2 < NCH) gload(n + 2); }
    }
    __syncthreads();
}
__device__ __forceinline__ void moe_scatter(const Ctx& C, int moe_li, int nrows) {
    const unsigned* gc = WSP(const unsigned, WS_CTL) + CW_MOECNT + 64 * moe_li;
    LAS int* pst = (LAS int*)C.lds;
    {
        int pe[8]; int acc = 0;
#pragma unroll
        for (int e = 0; e < NE; ++e) { const int blks = ((int)gc[e] + 255) >> 8; if (C.tid == e) pst[e] = acc * 256; acc += blks; pe[e] = acc; }
        if (C.wg == 0 && C.tid < MOE_MAXBLK) { int be = 0;
#pragma unroll
            for (int e = 0; e < NE; ++e) be += (pe[e] <= C.tid) ? 1 : 0;
            int* tab = WSP(int, WS_TAB); tab[1 + C.tid] = be < NE ? be : NE - 1; if (C.tid == 0) tab[0] = acc; }
    }
    __syncthreads();
    const unsigned* route = WSP(const unsigned, WS_ROUTE); const unsigned* wgbase = WSP(const unsigned, WS_WGBASE);
    int* pos = WSP(int, WS_POS); int* tok = WSP(int, WS_TOK);
    if (C.wg < NE) { const int cnt = (int)gc[C.wg], s0 = pst[C.wg] + cnt, s1 = pst[C.wg] + (((cnt + 255) >> 8) << 8);
        for (int j = s0 + C.tid; j < s1; j += NTHR) tok[j] = 0; }
    const int m = C.wg * NWAVES + C.wave + C.lane * (C.G * NWAVES);
    if (m < nrows) {
        const v4u a = *(const v4u*)(route + (size_t)m * 8);
        const int e0 = (int)a.x, e1 = (int)a.y;
        const int p0 = pst[e0] + (int)wgbase[C.wg * 8 + e0] + (int)a.z, p1 = pst[e1] + (int)wgbase[C.wg * 8 + e1] + (int)a.w;
        pos[(size_t)m * 2] = p0; pos[(size_t)m * 2 + 1] = p1; tok[p0] = m; tok[p1] = m;
    }
    __syncthreads();
}
template <int NEXT>
__device__ __forceinline__ void moe_combine(const Ctx& C, int l, int nrows) {
    const unsigned* route = WSP(const unsigned, WS_ROUTE); const int* pos = WSP(const int, WS_POS); const bf16* ym = WSP(const bf16, WS_MIX);
    const float* modv = WSP(const float, WS_MODV) + (size_t)l * 9 * 6144 + 5 * 1024;
    const float* modn = WSP(const float, WS_MODV) + (size_t)(l + 1) * 9 * 6144;
    float* xc = WSP(float, WS_XC); bf16* hb = WSP(bf16, WS_HB);
    const int gw = C.wg * NWAVES + C.wave, NGW = C.G * NWAVES;
    f32x4 gn[4];
#pragma unroll
    for (int j = 0; j < 4; ++j) gn[j] = *(const f32x4*)((NEXT == 2 ? C.in[I_FNG] : C.in[I_NMIXG] + (NEXT == 1 ? (l + 1) * 1024 : 0)) + 4 * C.lane + 256 * j);
    for (int m = gw; m < nrows; m += NGW) {
        const bool isctx = m >= T_LAT;
        float* xr = isctx ? xc + (size_t)(m - T_LAT) * 1024 : C.out + (size_t)m * 1024;
        const int mrow = isctx ? 8 : (m >> 12);
        const float* gv = modv + (size_t)mrow * 6144;
        const int p0 = pos[(size_t)m * 2], p1 = pos[(size_t)m * 2 + 1];
        const float w0 = __builtin_bit_cast(float, route[(size_t)m * 8 + 4]), w1 = __builtin_bit_cast(float, route[(size_t)m * 8 + 5]);
        f32x4 x[4]; float ss = 0.f;
#pragma unroll
        for (int j = 0; j < 4; ++j) {
            const int col = 4 * C.lane + 256 * j;
            const v2u a = *(const v2u*)(ym + (size_t)p0 * 1024 + col), b = *(const v2u*)(ym + (size_t)p1 * 1024 + col);
            const f32x4 ya = (f32x4){bflo(a.x), bfhi(a.x), bflo(a.y), bfhi(a.y)}, yb = (f32x4){bflo(b.x), bfhi(b.x), bflo(b.y), bfhi(b.y)};
            const f32x4 g = *(const f32x4*)(gv + col);
            x[j] = *(const f32x4*)(xr + col) + g * (ya * w0 + yb * w1);
            if (NEXT != 2) *(f32x4*)(xr + col) = x[j];
            ss += (x[j].x * x[j].x + x[j].y * x[j].y) + (x[j].z * x[j].z + x[j].w * x[j].w);
        }
        if (NEXT != 0) {
            const float rs = rsqrtf_(wave_sum(ss) * (1.0f / 1024.0f) + 1e-6f);
#pragma unroll
            for (int j = 0; j < 4; ++j) {
                const int col = 4 * C.lane + 256 * j;
                if (NEXT == 2) *(f32x4*)(xr + col) = x[j] * rs * gn[j];
                else { const f32x4 sh = *(const f32x4*)(modn + (size_t)mrow * 6144 + col), scl = *(const f32x4*)(modn + (size_t)mrow * 6144 + 1024 + col);
                    st4bf(hb + (size_t)m * 1024 + col, (x[j] * rs * gn[j]) * (scl + 1.0f) + sh); }
            }
        }
    }
}
__device__ __forceinline__ void final_norm(const Ctx& C) {
    const int gw = C.wg * NWAVES + C.wave, NGW = C.G * NWAVES;
    f32x4 gv[4];
#pragma unroll
    for (int j = 0; j < 4; ++j) gv[j] = *(const f32x4*)(C.in[I_FNG] + 4 * C.lane + 256 * j);
    for (int m = gw; m < T_LAT; m += NGW) {
        float* xr = C.out + (size_t)m * 1024;
        f32x4 v[4]; float s = 0.f;
#pragma unroll
        for (int j = 0; j < 4; ++j) { v[j] = *(const f32x4*)(xr + 4 * C.lane + 256 * j); s += (v[j].x * v[j].x + v[j].y * v[j].y) + (v[j].z * v[j].z + v[j].w * v[j].w); }
        const float rs = rsqrtf_(wave_sum(s) * (1.0f / 1024.0f) + 1e-6f);
#pragma unroll
        for (int j = 0; j < 4; ++j) *(f32x4*)(xr + 4 * C.lane + 256 * j) = v[j] * rs * gv[j];
    }
}

constexpr int NPH_L = 13, PH_FINAL = 1 + DEPTH * NPH_L, NPHASE = PH_FINAL + 1;
__host__ __device__ inline bool phase_exists(int ph) {
    if (ph == 0) return true;
    if (ph == PH_FINAL) return false;
    const int l = (ph - 1) / NPH_L, k = (ph - 1) % NPH_L;
    if (l >= 2 && !(l & 1) && k == 0) return false;
    if (!(l & 1) && k >= 11) return false;
    if (!RW_VSPLIT && k == 4) return false;
    return true;
}
#ifndef PH_MASK
#define PH_MASK 0xFFFFFF
#endif
#define PM(k) ((PH_MASK >> (k)) & 1)
#ifndef SK_MASK
#define SK_MASK 0xFFFF
#endif
#define SK(k) ((SK_MASK >> (k)) & 1)
#ifndef REP_MASK
#define REP_MASK 0
#endif
#define NREP(k) (((REP_MASK >> (k)) & 1) ? 2 : 1)

__global__ void __launch_bounds__(NTHR, 2) fwd_kernel(Args args) {
    extern __shared__ __attribute__((aligned(16))) unsigned char lds_raw[];
    Ctx C; C.in = args.in; C.out = args.out; C.ws = args.ws; C.lds = (LAS unsigned char*)lds_raw;
    C.tid = threadIdx.x; C.lane = C.tid & 63; C.wave = __builtin_amdgcn_readfirstlane(C.tid >> 6); C.G = gridDim.x; C.wg = blockIdx.x;
    volatile LAS unsigned* MISC = (volatile LAS unsigned*)(C.lds + MISC_OFF);
    if (C.tid < 64) MISC[C.tid] = 0u;
    __syncthreads();
    const int lo = args.ph_lo, hi = args.ph_hi;
    const bool multi = (hi - lo) > 1;
    if (multi) (void)xcd_barrier_post(WSP(unsigned, WS_CTL) + CW_BAR, MISC + 8);
#define IN(k) (lo <= (k) && (k) < hi)
#define SEAM(k) do { if (IN((k) + 1)) { XcdBarrier b2_; b2_.bar = WSP(unsigned, WS_CTL) + CW_BAR; b2_.x = xb_xcc_id(); b2_.st = (volatile LAS unsigned*)(C.lds + MISC_OFF) + 8; xcd_barrier(b2_); } } while (0)
#define FRESH() do { int t_ = threadIdx.x; asm volatile("" : "+v"(t_)); C.tid = t_; C.lane = t_ & 63; C.wave = __builtin_amdgcn_readfirstlane(t_ >> 6); } while (0)
#define PHASE(bit, k) if (PM(bit) && IN(pb + (k))) for (int rep_ = 0; rep_ < NREP(bit); ++rep_)
#define CLAIM(qh, var) __syncthreads(); if (C.tid == 0) *qslot = atomicAdd((qh), 1u); __syncthreads(); const int var = (int)*qslot;

    LAS unsigned* qslot = (LAS unsigned*)(C.lds + MISC_OFF + 128);
    constexpr int NCSL = 512;
    if (PM(20) && IN(0)) { phase_pre(C);
        for (;;) { FRESH(); CLAIM(WSP(unsigned, WS_CTL) + CW_PREPQ + 224, u0) if (u0 >= NCSL) break; FRESH(); convert_items(C, 0, 3, u0 * NWAVES + C.wave, NCSL * NWAVES); }
        SEAM(0); }

#pragma unroll 1
    for (int l = 0; l < DEPTH; ++l) {
        const int pb = 1 + l * NPH_L;
        if (hi <= pb || lo >= pb + NPH_L) continue;
        const bool last = (l == DEPTH - 1), moe = (l & 1);
        const int nrows = last ? T_LAT : T_ALL;
        const float* xlat = (l == 0) ? C.in[I_X] : C.out; const float* xctx = (l == 0) ? C.in[I_CTX] : WSP(const float, WS_XC);
        const float* modv = WSP(const float, WS_MODV) + (size_t)l * 9 * 6144;
        unsigned* qbase = WSP(unsigned, WS_CTL) + CW_PREPQ + 256 * l;

        if (!(l >= 2 && !(l & 1))) PHASE(0, 0) { FRESH();
            convert_small(C, l);
            __syncthreads();
            FRESH(); norm_rows<false>(C, l, xlat, xctx, C.in[I_NMIXG] + l * 1024, 0, 1024, T_ALL, 0);
            SEAM(pb + 0);
        }
        PHASE(1, 1) { FRESH();
            pg8::Gemm g{WSP(const bf16, WS_HB), WSP(const bf16, WS_WIN), T_ALL, PLD, 1024, 0};
            pg8::StaticOrder S; S.init(T_ALL, PLD, C.G, C.wg);
            pg8::EpiBf16<0> E{WSP(bf16, WS_P), PLD, nullptr, 0, 0};
            pg8::gemm_phase<pg8::EpiBf16<0>, pg8::StaticOrder, false>(C.lds, g, S, E, nullptr);
            SEAM(pb + 1);
        }
        if (PM(2) && IN(pb + 2)) for (int rep_ = 0; rep_ < NREP(2); ++rep_) { FRESH();
            for (;;) {
                CLAIM(qbase + 16 * rep_, k)
                if (k >= 2 * NB * NCH) break;
                const int kind = k / (NB * NCH), u = k % (NB * NCH);
                FRESH();
                if (kind == 0) { for (int r3_ = 0; r3_ < NREP(24); ++r3_) { FRESH(); if (SK(1)) rwkv_prep2(C, l, u / NCH, u % NCH); } }
                else { for (int r3_ = 0; r3_ < NREP(26); ++r3_) { FRESH(); if (SK(2)) gdn_prep(C, l, u / NCH, u % NCH); } }
            }
            SEAM(pb + 2);
        }
        if (PM(3) && IN(pb + 3)) for (int rep_ = 0; rep_ < NREP(3); ++rep_) { FRESH();
            constexpr int NCL = 2 * NB * NH * NCH / 4;
            int ncl_ = 0;
            for (;;) {
                CLAIM(qbase + 64 + 16 * rep_, k)
                if (k >= NCL) break;
                FRESH(); ++ncl_;
                if (SK(10)) rwkv_solve_item(C, l, 4 * k + (C.wave >> 1));
            }
            if (ncl_ <= 4) { const int cap_ = (l & 1) ? 1 : 3;
                for (int j_ = 0; j_ < cap_; ++j_) {
                    FRESH(); CLAIM(qbase + 192, u0)
                    if (u0 >= NCSL) break;
                    FRESH(); if (l > 0) convert_items(C, l, 2, u0 * NWAVES + C.wave, NCSL * NWAVES);
                    if (l + 1 < DEPTH) { FRESH(); convert_items(C, l + 1, 1, u0 * NWAVES + C.wave, NCSL * NWAVES); }
                }
            }
            SEAM(pb + (RW_VSPLIT ? 3 : 4));
        }
#if RW_VSPLIT
        if (PM(3) && IN(pb + 4)) { FRESH();
            for (;;) {
                CLAIM(qbase + 128, k)
                if (k >= 2 * NB * NH * NCH / 4) break;
                FRESH();
                if (SK(10)) rwkv_solve_item(C, l, 4 * k + (C.wave >> 1));
            }
            SEAM(pb + 4);
        }
#endif
        if (PM(4) && IN(pb + 5)) { FRESH();
            if (C.wg >= 64) {
                constexpr int NCL = 2 * NB * NH * NCH / 4;
                for (;;) {
                    CLAIM(qbase + 128, k)
                    if (k >= NCL) break;
                    FRESH();
                    if (SK(9)) gdn_solve_item(C, l, 4 * k + (C.wave >> 1));
                }
                asm volatile("s_waitcnt vmcnt(0)" ::: "memory");
                __syncthreads();
                if (C.tid == 0) { __builtin_amdgcn_fence(__ATOMIC_RELEASE, "agent"); asm volatile("s_waitcnt vmcnt(0)" ::: "memory"); (void)xb_add(qbase + 160, 1u); }
                if (C.wg >= 192) {
                    if (C.tid == 0) { unsigned* bar_ = WSP(unsigned, WS_CTL) + CW_BAR; XB_SPIN(xb_ld(qbase + 160) < (unsigned)(C.G - 64), bar_); __builtin_amdgcn_fence(__ATOMIC_ACQUIRE, "agent"); asm volatile("s_waitcnt vmcnt(0)" ::: "memory"); }
                    __syncthreads();
                }
                FRESH();
            }
            if (C.wg >= 64 && C.wg < 128) { if (SK(0)) lru_chain(C, l, C.wg - 64); FRESH(); }
            if (SK(3) && C.wg < (RW_VSPLIT ? 128 : 64)) { if (NREP(20) > 1) { FRESH(); rwkv_chunked<true>(C, l, C.wg); } FRESH(); rwkv_chunked<false>(C, l, C.wg); }
            else if (SK(4) && C.wg >= 128 && C.wg < 192) { for (int r2_ = 0; r2_ < NREP(21); ++r2_) { FRESH(); mlstm_chunked(C, l, C.wg - 128); } }
            else if (SK(5) && C.wg >= 192) { if (NREP(22) > 1) { FRESH(); gdn_chunked<true>(C, l, C.wg - 192); } FRESH(); gdn_chunked<false>(C, l, C.wg - 192); }
            {
                FRESH();
                const int nun = 0;
                for (;;) {
                    CLAIM(qbase + 192, u0)
                    if (u0 >= NCSL + nun) break;
                    if (u0 < NCSL) {
                        FRESH(); if (l > 0) convert_items(C, l, 2, u0 * NWAVES + C.wave, NCSL * NWAVES);
                        if (l + 1 < DEPTH) { FRESH(); convert_items(C, l + 1, 1, u0 * NWAVES + C.wave, NCSL * NWAVES); }
                    }
                }
            }
            SEAM(pb + 5);
        }
        PHASE(5, 6) { FRESH();
            if (SK(8)) finish_rows(C, l, nrows);
            SEAM(pb + 6);
        }
        if (PM(6) && IN(pb + 7)) { FRESH();
            pg8::Gemm g{WSP(const bf16, WS_HB), WSP(const bf16, WS_WOUT), nrows, 1024, 1024, 0};
            pg8::StaticOrder S; S.init(nrows, 1024, C.G, C.wg);
            pg8::EpiRes E{xlat, xctx, C.out, WSP(float, WS_XC), modv + 2 * 1024};
            pg8::gemm_phase<pg8::EpiRes, pg8::StaticOrder, false>(C.lds, g, S, E, nullptr);
            SEAM(pb + 7);
        }
        if (PM(7) && IN(pb + 8)) { FRESH();
            if (moe) norm_rows<true>(C, l, C.out, WSP(const float, WS_XC), C.in[I_NFFNG] + l * 1024, 3 * 1024, 4 * 1024, nrows, l >> 1);
            else norm_rows<false>(C, l, C.out, WSP(const float, WS_XC), C.in[I_NFFNG] + l * 1024, 3 * 1024, 4 * 1024, nrows, 0);
            SEAM(pb + 8);
        }
        if (!moe) {
            if (PM(8) && IN(pb + 9)) for (int rep_ = 0; rep_ < NREP(8); ++rep_) { FRESH();
                pg8::Gemm g{WSP(const bf16, WS_HB), WSP(const bf16, WS_WGU), nrows, 2 * DFF, 1024, 0};
                pg8::StaticOrder S; S.init(nrows, 2 * DFF, C.G, C.wg);
                pg8::EpiSwiglu E{WSP(bf16, WS_P), DFF};
                pg8::gemm_phase<pg8::EpiSwiglu, pg8::StaticOrder, false>(C.lds, g, S, E, nullptr);
                SEAM(pb + 9);
            }
            if (PM(9) && IN(pb + 10)) { FRESH();
                pg8::Gemm g{WSP(const bf16, WS_P), WSP(const bf16, WS_WDN), nrows, 1024, DFF, 0};
                pg8::StaticOrder S; S.init(nrows, 1024, C.G, C.wg);
                pg8::EpiRes E{C.out, WSP(const float, WS_XC), C.out, WSP(float, WS_XC), modv + 5 * 1024};
                pg8::gemm_phase<pg8::EpiRes, pg8::StaticOrder, false>(C.lds, g, S, E, nullptr);
                SEAM(pb + 12);
            }
        } else {
            if (PM(10) && IN(pb + 9)) { FRESH(); moe_scatter(C, l >> 1, nrows); SEAM(pb + 9); }
            if (PM(11) && IN(pb + 10)) for (int rep_ = 0; rep_ < NREP(11); ++rep_) { FRESH();
                pg8::Gemm g{WSP(const bf16, WS_HB), WSP(const bf16, WS_WGU), 0, 2 * DFE, 1024, (size_t)2 * DFE * 1024};
                pg8::MoeOrderG S; S.init(WSP(const int, WS_TAB), (2 * DFE) / 256, C.G, C.wg); S.tok = WSP(const int, WS_TOK);
                pg8::EpiSwiglu E{WSP(bf16, WS_P), DFE};
                pg8::gemm_phase<pg8::EpiSwiglu, pg8::MoeOrderG, false>(C.lds, g, S, E, nullptr);
                SEAM(pb + 10);
            }
            if (PM(12) && IN(pb + 11)) for (int rep_ = 0; rep_ < NREP(12); ++rep_) { FRESH();
                pg8::Gemm g{WSP(const bf16, WS_P), WSP(const bf16, WS_WDN), 0, 1024, DFE, (size_t)1024 * DFE};
                pg8::MoeOrder S; S.init(WSP(const int, WS_TAB), 4, C.G, C.wg);
                pg8::EpiBf16<0> E{WSP(bf16, WS_MIX), 1024, nullptr, 0, 0};
                pg8::gemm_phase<pg8::EpiBf16<0>, pg8::MoeOrder, false>(C.lds, g, S, E, nullptr);
                SEAM(pb + 11);
            }
            if (PM(13) && IN(pb + 12)) { FRESH();
                if (last) moe_combine<2>(C, l, nrows);
                else { convert_small(C, l + 1); FRESH(); moe_combine<1>(C, l, nrows); if (IN(pb + NPH_L + 1)) { XcdBarrier b2_; b2_.bar = WSP(unsigned, WS_CTL) + CW_BAR; b2_.x = xb_xcc_id(); b2_.st = (volatile LAS unsigned*)(C.lds + MISC_OFF) + 8; xcd_barrier(b2_); } }
            }
        }
    }
}

extern "C" void kernel_launch(void* const* d_in, const int* in_sizes, int n_in, void* d_out, int out_size, void* d_ws, size_t ws_size, hipStream_t stream) {
    static int grid = 0;
    if (grid == 0) {
        if (n_in != N_IN || in_sizes[0] != T_LAT * DM || out_size != T_LAT * DM || ws_size < WS_END) {
            fprintf(stderr, "kernel_launch: unexpected problem (n_in %d, in0 %d, out %d, ws %zu < %zu)\n", n_in, n_in > 0 ? in_sizes[0] : -1, out_size, ws_size, (size_t)WS_END); grid = -1; return; }
        int dev = 0, cus = 0, per_cu = 0;
        if (hipGetDevice(&dev) != hipSuccess || hipDeviceGetAttribute(&cus, hipDeviceAttributeMultiprocessorCount, dev) != hipSuccess) { grid = -1; return; }
        if (hipFuncSetAttribute((const void*)fwd_kernel, hipFuncAttributeMaxDynamicSharedMemorySize, LDS_BYTES) != hipSuccess) { fprintf(stderr, "kernel_launch: hipFuncSetAttribute failed\n"); grid = -1; return; }
        if (hipOccupancyMaxActiveBlocksPerMultiprocessor(&per_cu, (const void*)fwd_kernel, NTHR, LDS_BYTES) != hipSuccess || per_cu < 1) { fprintf(stderr, "kernel_launch: occupancy query says %d\n", per_cu); grid = -1; return; }
        grid = cus;
        if (grid != 256) fprintf(stderr, "kernel_launch: note: %d CUs\n", grid);
    }
    if (grid < 0) return;
    if (hipMemsetAsync((char*)d_ws + WS_CTL, 0, CTL_BYTES, stream) != hipSuccess) return;
    Args a{};
    for (int i = 0; i < N_IN; ++i) a.in[i] = (const float*)d_in[i];
    a.out = (float*)d_out; a.ws = (unsigned char*)d_ws;
#if MK_ONE_LAUNCH
    a.ph_lo = 0; a.ph_hi = NPHASE;
    hipLaunchKernelGGL(fwd_kernel, dim3(grid), dim3(NTHR), LDS_BYTES, stream, a);
#else
    for (int ph = 0; ph < NPHASE; ++ph) { if (!phase_exists(ph)) continue; a.ph_lo = ph; a.ph_hi = ph + 1; hipLaunchKernelGGL(fwd_kernel, dim3(grid), dim3(NTHR), LDS_BYTES, stream, a); }
#endif
}
```

```cpp
#define MK_ONE_LAUNCH 1
#include <hip/hip_runtime.h>
#include <cstdio>
#include <cstdint>

#define GAS __attribute__((address_space(1)))
#define LAS __attribute__((address_space(3)))
typedef unsigned short bf16;
typedef unsigned v4u __attribute__((ext_vector_type(4)));
typedef unsigned v2u __attribute__((ext_vector_type(2)));
typedef float f32x4 __attribute__((ext_vector_type(4)));
typedef float f32x2 __attribute__((ext_vector_type(2)));
typedef short bf16x8 __attribute__((ext_vector_type(8)));
#define LDS_WAIT() asm volatile("s_waitcnt lgkmcnt(0)" ::: "memory")
#define VM_WAIT() asm volatile("s_waitcnt vmcnt(0)" ::: "memory")

constexpr int DM = 1024, NB = 8, SEQ = 4096, DEPTH = 4, CTXL = 256, GW = 256, HD = 64, NH = 4;
constexpr int T_LAT = NB * SEQ, T_CTX = NB * CTXL, T_ALL = T_LAT + T_CTX;
constexpr int IN_COLS = 3552, PLD = 3584;
constexpr int OFF_B = 512, OFF_C = 1472, OFF_D = 2512, B_COLS = 960;
constexpr int DFF = 2816, NE = 8, DFE = 1408;
constexpr int NCH = 68;
constexpr int NSTEP = 4352;
constexpr int MOE_MAXBLK = 280;
constexpr int NWAVES = 8, NTHR = 512;
#ifndef RW_VSPLIT
#define RW_VSPLIT 0
#endif

constexpr size_t MiB = 1u << 20;
constexpr size_t WS_CTL = 0, CTL_BYTES = 1 * MiB;
constexpr size_t WS_MODV = 1 * MiB;
constexpr size_t WS_XC = 2 * MiB;
constexpr size_t WS_WIN = 10 * MiB;
constexpr size_t WS_WOUT = 17 * MiB;
constexpr size_t WS_WGU = 19 * MiB;
constexpr size_t WS_WDN = 63 * MiB;
constexpr size_t WS_HB = 85 * MiB;
constexpr size_t WS_P = 153 * MiB;
constexpr size_t WS_MIX = 391 * MiB;
constexpr size_t WS_OUTB = WS_MIX, WS_OUTC = WS_MIX + 34 * MiB, WS_OUTD = WS_MIX + 68 * MiB, WS_GQ = WS_MIX + 102 * MiB, WS_G = WS_MIX + 153 * MiB;
constexpr size_t WS_XLAST = WS_MIX + 144 * MiB;
constexpr size_t WS_RKV = WS_MIX + 170 * MiB;
constexpr size_t WS_SMALL = 612 * MiB;
constexpr size_t WS_ROUTE = WS_SMALL;
constexpr size_t WS_POS = WS_SMALL + 1280 * 1024;
constexpr size_t WS_TOK = WS_SMALL + 1664 * 1024;
constexpr size_t WS_BONUS = WS_SMALL + 2 * MiB;
constexpr size_t WS_RINV = WS_SMALL + 2 * MiB + 640 * 1024;
constexpr size_t WS_WGBASE = WS_SMALL + 3 * MiB + 256 * 1024;
constexpr size_t WS_TAB = WS_WGBASE + 65536;
constexpr size_t WS_LRUWT = WS_SMALL + 3 * MiB + 512 * 1024;
constexpr size_t WS_RWT = WS_LRUWT + 131072;
constexpr size_t WS_LRUH = WS_SMALL + 4 * MiB;
constexpr size_t WS_END = 633 * MiB;
constexpr int CW_MOECNT = 1024;
constexpr int CW_PREPQ = 2048;
constexpr int CW_BAR = 4096;

constexpr int LDS_BYTES = 135168;
constexpr int MISC_OFF = 131072;

__device__ __forceinline__ unsigned f2bf(float f) { unsigned u = __builtin_bit_cast(unsigned, f); return (u + 0x7fffu + ((u >> 16) & 1u)) >> 16; }
typedef __bf16 bf16n2 __attribute__((ext_vector_type(2)));
__device__ __forceinline__ unsigned pk2(float lo, float hi) { const f32x2 v = {lo, hi}; return __builtin_bit_cast(unsigned, __builtin_convertvector(v, bf16n2)); }
__device__ __forceinline__ unsigned f2bf1(float f) { return pk2(f, f) & 0xffffu; }
__device__ __forceinline__ float bf2f(unsigned short v) { return __builtin_bit_cast(float, (unsigned)v << 16); }
__device__ __forceinline__ float bflo(unsigned v) { return __builtin_bit_cast(float, v << 16); }
__device__ __forceinline__ float bfhi(unsigned v) { return __builtin_bit_cast(float, v & 0xffff0000u); }
template <int CTRL, int RM, bool BC> __device__ __forceinline__ float dpp_x(float oldv, float v) { return __builtin_bit_cast(float, __builtin_amdgcn_update_dpp(__builtin_bit_cast(int, oldv), __builtin_bit_cast(int, v), CTRL, RM, 0xF, BC)); }
__device__ __forceinline__ float wave_sum(float v) {
    v += dpp_x<0xB1, 0xF, true>(0.f, v); v += dpp_x<0x4E, 0xF, true>(0.f, v); v += dpp_x<0x141, 0xF, true>(0.f, v); v += dpp_x<0x140, 0xF, true>(0.f, v);
    v += dpp_x<0x142, 0xA, false>(0.f, v); v += dpp_x<0x143, 0xC, false>(0.f, v);
    return __builtin_bit_cast(float, __builtin_amdgcn_readlane(__builtin_bit_cast(int, v), 63));
}
template <int CTRL> __device__ __forceinline__ float dpp_f(float v) { return __builtin_bit_cast(float, __builtin_amdgcn_update_dpp(0, __builtin_bit_cast(int, v), CTRL, 0xF, 0xF, true)); }
__device__ __forceinline__ float row16_sum(float v) {
    v += dpp_f<0xB1>(v);
    v += dpp_f<0x4E>(v);
    v += dpp_f<0x141>(v);
    v += dpp_f<0x140>(v);
    return v;
}
__device__ __forceinline__ float sigmoidf_(float x) { return __builtin_amdgcn_rcpf(1.0f + __expf(-x)); }
__device__ __forceinline__ float softplusf_(float x) { return fmaxf(x, 0.f) + __logf(1.0f + __expf(-fabsf(x))); }
__device__ __forceinline__ float expm1f_(float x) { return x > -0.3f ? x * (1.0f + x * (0.5f + x * (0.16666667f + x * (0.041666668f + x * 0.0083333338f)))) : __expf(x) - 1.0f; }
__device__ __forceinline__ float siluf_(float x) { return x * __builtin_amdgcn_rcpf(1.0f + __expf(-x)); }
__device__ __forceinline__ float tanhf_(float x) { const float e = __expf(2.0f * x); return 1.0f - 2.0f * __builtin_amdgcn_rcpf(e + 1.0f); }
__device__ __forceinline__ float rsqrtf_(float x) { return __builtin_amdgcn_rsqf(x); }
__device__ __forceinline__ float gelu_tanh(float x) { return 0.5f * x * (1.0f + tanhf_(0.7978845608028654f * (x + 0.044715f * x * x * x))); }
__device__ __forceinline__ f32x4 ld4bf(const bf16* p) { const v2u a = *(const v2u*)p; return (f32x4){bflo(a.x), bfhi(a.x), bflo(a.y), bfhi(a.y)}; }
__device__ __forceinline__ void st4bf(bf16* p, const f32x4& v) { v2u o; o.x = pk2(v.x, v.y); o.y = pk2(v.z, v.w); *(v2u*)p = o; }
#define XB_TMO      128
#define XB_XCNT(j)  (256  + 64 * (j))
#define XB_XSUB(j)  (1280 + 64 * (j))
#define XB_XGEN(j)  (2304 + 64 * (j))
#define XB_TOP      3328
#define XB_TOPGEN   3392
#define XCD_BAR_WORDS 3456
#define XB_SPIN_CAP (1u << 22)

__device__ __forceinline__ unsigned xb_ld(unsigned* p)              { return __hip_atomic_load(p, __ATOMIC_RELAXED, __HIP_MEMORY_SCOPE_AGENT); }
__device__ __forceinline__ unsigned xb_add(unsigned* p, unsigned v) { return __hip_atomic_fetch_add(p, v, __ATOMIC_RELAXED, __HIP_MEMORY_SCOPE_AGENT); }
__device__ __forceinline__ unsigned xb_xcc_id() { return (unsigned)__builtin_amdgcn_s_getreg((3 << 11) | 20) & 0xFu; }
#define XB_SPIN(cond, bar) do { unsigned _sp = 0; while (cond) { __builtin_amdgcn_s_sleep(1); \
    if ((++_sp & 255u) == 0u) { if (xb_ld(&(bar)[XB_TMO])) break; if (_sp > XB_SPIN_CAP) { atomicAdd(&(bar)[XB_TMO], 1u); break; } } } } while (0)

struct XcdBarrier {
    unsigned* bar; unsigned x;
    volatile LAS unsigned* st;
};

__device__ __forceinline__ XcdBarrier xcd_barrier_post(unsigned* bar, volatile LAS unsigned* st) {
    XcdBarrier b; b.bar = bar; b.x = xb_xcc_id(); b.st = st;
    if (threadIdx.x == 0) (void)xb_add(&bar[XB_XCNT(b.x)], 1u);
    return b;
}
__device__ __forceinline__ void xcd_barrier_complete(unsigned* bar, unsigned x, unsigned& nloc, unsigned& nx) {
    const unsigned G = gridDim.x * gridDim.y * gridDim.z;
    unsigned sum, cnt, mine, sp = 0u;
    for (;;) {
        sum = 0u; cnt = 0u; mine = 0u;
#pragma unroll
        for (unsigned j = 0; j < 16; ++j) { const unsigned c = xb_ld(&bar[XB_XCNT(j)]); sum += c; cnt += (c > 0u) ? 1u : 0u; mine = (j == x) ? c : mine; }
        if (sum == G) break;
        __builtin_amdgcn_s_sleep(1);
        if ((++sp & 255u) == 0u) { if (xb_ld(&bar[XB_TMO])) break; if (sp > XB_SPIN_CAP) { atomicAdd(&bar[XB_TMO], 1u); break; } }
    }
    nloc = mine > 0u ? mine : 1u; nx = cnt > 0u ? cnt : 1u;
}

__device__ __forceinline__ void xcd_barrier(const XcdBarrier& b) {
    asm volatile("s_waitcnt vmcnt(0)" ::: "memory");
    __syncthreads();
    if (threadIdx.x == 0) {
        unsigned* bar = b.bar;
        __builtin_amdgcn_s_waitcnt(0);
        unsigned nloc = b.st[0], nx = b.st[1];
        if (nloc == 0u) { xcd_barrier_complete(bar, b.x, nloc, nx); b.st[0] = nloc; b.st[1] = nx; }
        const unsigned old = xb_add(&bar[XB_XSUB(b.x)], 1u);
        const unsigned gen = old / nloc;
        if (old + 1u == (gen + 1u) * nloc) {
            __builtin_amdgcn_fence(__ATOMIC_RELEASE, "agent");
            asm volatile("s_waitcnt vmcnt(0)" ::: "memory");
            const unsigned og = xb_add(&bar[XB_TOP], 1u);
            const unsigned tg = og / nx;
            if (og + 1u == (tg + 1u) * nx) xb_add(&bar[XB_TOPGEN], 1u);
            else XB_SPIN(xb_ld(&bar[XB_TOPGEN]) == tg, bar);
            __builtin_amdgcn_fence(__ATOMIC_ACQUIRE, "agent");
            xb_add(&bar[XB_XGEN(b.x)], 1u);
            asm volatile("s_waitcnt vmcnt(0)" ::: "memory");
        } else {
            XB_SPIN(xb_ld(&bar[XB_XGEN(b.x)]) == gen, bar);
            __builtin_amdgcn_fence(__ATOMIC_ACQUIRE, "agent");
            asm volatile("s_waitcnt vmcnt(0)" ::: "memory");
        }
    }
    __syncthreads();
}

namespace pg8 {
#define PG8_LAS __attribute__((address_space(3)))
typedef unsigned short bf16_t;
typedef short bf16x8 __attribute__((ext_vector_type(8)));
typedef float f32x4 __attribute__((ext_vector_type(4)));
typedef unsigned u32x4 __attribute__((ext_vector_type(4)));
constexpr int BM = 256, BK = 64, HALF = 128, HTB = HALF * BK * 2  , STAGE_BYTES = 8 * HTB, NXCD = 8, WGM = 8;

__host__ __device__ __forceinline__ int lds_byte(int r, int c) { const int st = (r >> 4) * 2 + (c >> 5), rr = r & 15, cc = c & 31, ob = rr * 64 + cc * 2; return st * 1024 + (ob ^ (((ob >> 9) & 1) << 5)); }
__host__ __device__ __forceinline__ void stage_rc(int b, int& R, int& C) { const int st = b / 1024, sb = b % 1024, swz = sb ^ (((sb >> 9) & 1) << 5); R = (st >> 1) * 16 + swz / 64; C = (st & 1) * 32 + (swz % 64) / 2; }
__host__ __device__ __forceinline__ int perm32(int rho) { const int n = rho >> 4, i = rho & 15; return 8 * (i >> 2) + 4 * n + (i & 3); }

struct Unit { int pm, pn, e; };
struct Gemm { const bf16_t* A; const bf16_t* Bt; int M, N, K; size_t estride; };

struct StaticOrder {
    static constexpr bool GATHER = false;
    int nM, nN, nwg, G, c;
    __host__ __device__ void init(int M, int N, int G_, int c_) { nM = M / BM; nN = N / BM; nwg = nM * nN; G = G_; c = c_; }
    __host__ __device__ bool next(int i, Unit& u) const {
        const long L = (long)i * G + c; if (L >= nwg) return false;
        int wgid = (int)L; { const int q = nwg / NXCD, r = nwg % NXCD, xcd = wgid % NXCD, off = wgid / NXCD; wgid = (xcd < r ? xcd * (q + 1) : r * (q + 1) + (xcd - r) * q) + off; }
        const int nig = WGM * nN, gid = wgid / nig, fm = gid * WGM, gsz = (nM - fm) < WGM ? (nM - fm) : WGM;
        u.pm = fm + ((wgid % nig) % gsz); u.pn = (wgid % nig) / gsz; u.e = 0; return true;
    }
    __device__ __forceinline__ void a_ready(const Unit&) const {}
    __device__ __forceinline__ void done(const Unit&) const {}
};
__device__ __forceinline__ unsigned cvt_pk_bf16(float lo, float hi) { unsigned r; asm volatile("v_cvt_pk_bf16_f32 %0, %1, %2" : "=v"(r) : "v"(lo), "v"(hi)); return r; }
typedef float f32x2 __attribute__((ext_vector_type(2)));
__device__ __forceinline__ f32x2 gelu_pk(f32x2 v) {
    const f32x2 av = __builtin_elementwise_abs(v), d = av * 0.2316418882f + 1.0f;
    f32x2 t; t.x = __builtin_amdgcn_rcpf(d.x); t.y = __builtin_amdgcn_rcpf(d.y);
    f32x2 q = t * 0.5307027145f + (-0.7265760135f); q = q * t + 0.7107068705f; q = q * t + (-0.142248368f); q = q * t + 0.127414796f; q = q * t;
    const f32x2 s = (v * v) * (-0.72134752044f);
    f32x2 e; e.x = __builtin_amdgcn_exp2f(s.x); e.y = __builtin_amdgcn_exp2f(s.y);
    const f32x2 m = v * (q * e), r = v - m;
    f32x2 o; o.x = v.x < 0.f ? m.x : r.x; o.y = v.y < 0.f ? m.y : r.y; return o;
}

struct EpiF32 {
    static constexpr bool PERM = false, AFTER_DRAIN = false;
    float* C; int ldc; const float* bias;
    __device__ __forceinline__ void operator()(const f32x4 (&acc)[2][2][4][2], const Unit& u, int wr, int wc, int fr, int fq) const {
        const int row0 = u.pm * BM + wr * 64 + fr, col0 = u.pn * BM + wc * 32 + 4 * fq;
        f32x4 bv[2][2];
#pragma unroll
        for (int bj = 0; bj < 2; ++bj)
#pragma unroll
            for (int n = 0; n < 2; ++n) bv[bj][n] = bias ? *(const f32x4*)(bias + col0 + bj * HALF + n * 16) : (f32x4){0.f, 0.f, 0.f, 0.f};
#pragma unroll
        for (int ai = 0; ai < 2; ++ai)
#pragma unroll
            for (int m = 0; m < 4; ++m) { float* rowp = C + (size_t)(row0 + ai * HALF + m * 16) * ldc + col0;
#pragma unroll
                for (int bj = 0; bj < 2; ++bj)
#pragma unroll
                    for (int n = 0; n < 2; ++n) *(f32x4*)(rowp + bj * HALF + n * 16) = acc[ai][bj][m][n] + bv[bj][n]; }
    }
};
template <int ACT  > struct EpiBf16 {
    static constexpr bool PERM = true, AFTER_DRAIN = false;
    bf16_t* O; int ldc; const float* bias; int split_cols; size_t split_stride;
    __device__ __forceinline__ void operator()(const f32x4 (&acc)[2][2][4][2], const Unit& u, int wr, int wc, int fr, int fq) const {
        const int row0 = u.pm * BM + wr * 64 + fr; int colt = u.pn * BM; bf16_t* base = O;
        if (split_cols) { const int t = colt / split_cols; base += (size_t)t * split_stride; colt -= t * split_cols; }
        const int col0 = colt + wc * 32 + 8 * fq, bcol0 = u.pn * BM + wc * 32 + 8 * fq;
        f32x4 bv[2][2];
#pragma unroll
        for (int bj = 0; bj < 2; ++bj)
#pragma unroll
            for (int n = 0; n < 2; ++n) bv[bj][n] = bias ? *(const f32x4*)(bias + bcol0 + bj * HALF + 4 * n) : (f32x4){0.f, 0.f, 0.f, 0.f};
#pragma unroll
        for (int ai = 0; ai < 2; ++ai)
#pragma unroll
            for (int m = 0; m < 4; ++m) { bf16_t* rowp = base + (size_t)(row0 + ai * HALF + m * 16) * ldc + col0;
#pragma unroll
                for (int bj = 0; bj < 2; ++bj) { f32x4 v0 = acc[ai][bj][m][0] + bv[bj][0], v1 = acc[ai][bj][m][1] + bv[bj][1];
                    if (ACT == 1) { f32x2 a = gelu_pk((f32x2){v0[0], v0[1]}), b = gelu_pk((f32x2){v0[2], v0[3]}), c = gelu_pk((f32x2){v1[0], v1[1]}), d = gelu_pk((f32x2){v1[2], v1[3]});
                        v0 = (f32x4){a.x, a.y, b.x, b.y}; v1 = (f32x4){c.x, c.y, d.x, d.y}; }
                    if (ACT == 2) {
#pragma unroll
                        for (int j = 0; j < 4; ++j) { v0[j] = 0.5f * v0[j] * (1.0f + erff(v0[j] * 0.70710678f)); v1[j] = 0.5f * v1[j] * (1.0f + erff(v1[j] * 0.70710678f)); } }
                    u32x4 w; w.x = cvt_pk_bf16(v0[0], v0[1]); w.y = cvt_pk_bf16(v0[2], v0[3]); w.z = cvt_pk_bf16(v1[0], v1[1]); w.w = cvt_pk_bf16(v1[2], v1[3]);
                    *(u32x4*)(rowp + bj * HALF) = w; } }
    }
};

template <class Epi, class Sched, bool STAMP = false>
__device__ __forceinline__ void gemm_phase(PG8_LAS unsigned char* lds, const Gemm g, const Sched& S, const Epi& E, unsigned long long* stamps) {
    int tid_ = threadIdx.x; asm volatile("" : "+v"(tid_));
    const int tid = tid_, wid = __builtin_amdgcn_readfirstlane(tid >> 6), lane = tid & 63, wr = wid >> 2, wc = wid & 3, fr = lane & 15, fq = lane >> 4;
    const int K = g.K, nt = K / BK;
    constexpr bool GATHER = Sched::GATHER;
    int ts_lo = 0, ts_hi = 0, nts = 0; const unsigned long long rt_entry = STAMP ? (unsigned long long)wall_clock64() : 0ull;
#define PG8_STAMP() do { if (STAMP && wid == 0 && nts < 64) { const unsigned long long _c = (unsigned long long)clock64(); \
        ts_lo = (lane == nts) ? (int)(unsigned)_c : ts_lo; ts_hi = (lane == nts) ? (int)(unsigned)(_c >> 32) : ts_hi; ++nts; } } while (0)
    PG8_STAMP();
    unsigned voffA[2], voffB[2]; int rowA[2];
#pragma unroll
    for (int i = 0; i < 2; ++i) { int R, C; stage_rc(tid * 16 + i * 8192, R, C); const int Rb = Epi::PERM ? ((R & ~31) + perm32(R & 31)) : R;
        rowA[i] = R; voffA[i] = GATHER ? (unsigned)C * 2u : (unsigned)(R * K + C) * 2u; voffB[i] = (unsigned)(Rb * K + C) * 2u; }
    const size_t kstep = (size_t)(BK * 2);
    const size_t hstep = (size_t)HALF * K * 2;
    const size_t tstep = 2 * hstep;
    const unsigned ldsw = (unsigned)wid * 1024u;
    const int aoff = lds_byte(wr * 64 + fr, fq * 8), boff = lds_byte(wc * 32 + fr, fq * 8);
#define PG8_SA(b, h) (((b) * 2 + (h)) * HTB)
#define PG8_SB(b, h) ((4 + (b) * 2 + (h)) * HTB)
#define PG8_STAGE(bufoff, gbase, voff) do { _Pragma("unroll") for (int _i = 0; _i < 2; ++_i) \
        __builtin_amdgcn_global_load_lds((const unsigned*)((const char*)(gbase) + (voff)[_i]), (PG8_LAS unsigned*)(lds + (bufoff) + ldsw + _i * 8192), 16, 0, 0); } while (0)
#define PG8_STAGE_A(bufoff, gbase, h, gv) do { if constexpr (GATHER) { PG8_STAGE(bufoff, gbase, (gv)[h]); } else { PG8_STAGE(bufoff, (gbase) + (h) * hstep, voffA); } } while (0)
#define PG8_TOKSLOT(s) ((PG8_LAS int*)(lds + STAGE_BYTES + 1024 + ((s) & 1) * 1024))
#define PG8_LDA(dst, b, h) do { _Pragma("unroll") for (int m = 0; m < 4; ++m) _Pragma("unroll") for (int k = 0; k < 2; ++k) dst[m][k] = *(const PG8_LAS bf16x8*)(lds + PG8_SA(b, h) + aoff + m * 2048 + k * 1024); } while (0)
#define PG8_LDB(dst, b, h) do { _Pragma("unroll") for (int n = 0; n < 2; ++n) _Pragma("unroll") for (int k = 0; k < 2; ++k) dst[n][k] = *(const PG8_LAS bf16x8*)(lds + PG8_SB(b, h) + boff + n * 2048 + k * 1024); } while (0)
#define PG8_MMA(ai, bj, At, Bt) do { __builtin_amdgcn_s_setprio(1); _Pragma("unroll") for (int m = 0; m < 4; ++m) _Pragma("unroll") for (int n = 0; n < 2; ++n) _Pragma("unroll") for (int k = 0; k < 2; ++k) \
        acc[ai][bj][m][n] = __builtin_amdgcn_mfma_f32_16x16x32_bf16(Bt[n][k], At[m][k], acc[ai][bj][m][n], 0, 0, 0); __builtin_amdgcn_s_setprio(0); } while (0)
#define PG8_WAIT_V(n) asm volatile("s_waitcnt vmcnt(" #n ")" ::: "memory")
#define PG8_WAIT_L(n) asm volatile("s_waitcnt lgkmcnt(" #n ")" ::: "memory")
#define PG8_BAR __builtin_amdgcn_s_barrier()
#define PG8_SCHED __builtin_amdgcn_sched_barrier(0)
    Unit cur, nxt; int ui = 0;
    if (!S.next(0, cur)) return;
    f32x4 acc[2][2][4][2];
#pragma unroll
    for (int a = 0; a < 2; ++a)
#pragma unroll
        for (int b = 0; b < 2; ++b)
#pragma unroll
            for (int m = 0; m < 4; ++m)
#pragma unroll
                for (int n = 0; n < 2; ++n) acc[a][b][m][n] = (f32x4){0.f, 0.f, 0.f, 0.f};
    bf16x8 At[4][2], B0[2][2], B1[2][2];
    const char* cA = (const char*)g.A + (GATHER ? (size_t)0 : (size_t)cur.pm * tstep); const char* cB = (const char*)g.Bt + (size_t)cur.pn * tstep + (size_t)cur.e * g.estride * 2;
    S.a_ready(cur);
    unsigned gcur[2][2], gnxt[2][2], gs[2][2];
    if constexpr (GATHER) {
        if (tid < 256) PG8_TOKSLOT(0)[tid] = S.tok[cur.pm * 256 + tid];
        __syncthreads();
#pragma unroll
        for (int h = 0; h < 2; ++h)
#pragma unroll
            for (int i = 0; i < 2; ++i) { gcur[h][i] = (unsigned)PG8_TOKSLOT(0)[h * HALF + rowA[i]] * (unsigned)(K * 2) + voffA[i]; gnxt[h][i] = gcur[h][i]; gs[h][i] = gcur[h][i]; }
    }
    PG8_STAGE(PG8_SB(0, 0), cB, voffB); PG8_STAGE_A(PG8_SA(0, 0), cA, 0, gcur); PG8_STAGE(PG8_SB(0, 1), cB + hstep, voffB); PG8_STAGE_A(PG8_SA(0, 1), cA, 1, gcur);
    if (wr == 1) PG8_BAR;
    PG8_WAIT_V(4); PG8_BAR;
    PG8_STAGE(PG8_SB(1, 0), cB + kstep, voffB); PG8_STAGE_A(PG8_SA(1, 0), cA + kstep, 0, gcur); PG8_STAGE(PG8_SB(1, 1), cB + hstep + kstep, voffB);
    PG8_WAIT_V(6); PG8_BAR;
    PG8_STAMP();
    for (;;) {
        const bool has_next = S.next(ui + 1, nxt);
        if constexpr (GATHER) { if (has_next && wid < 4)
            __builtin_amdgcn_global_load_lds((const unsigned*)(S.tok + nxt.pm * 256 + wid * 64 + lane), (PG8_LAS unsigned*)((PG8_LAS unsigned char*)PG8_TOKSLOT(ui + 1) + wid * 256), 4, 0, 0); }
        const char* nA = GATHER ? (const char*)g.A : has_next ? (const char*)g.A + (size_t)nxt.pm * tstep : cA; const char* nB = has_next ? (const char*)g.Bt + (size_t)nxt.pn * tstep + (size_t)nxt.e * g.estride * 2 : cB;
        for (int t = 0; t < nt; t += 2) {
            const bool last = (t == nt - 2);
            const char* a1 = cA + (size_t)(t + 1) * kstep;
            const char* a2 = last ? nA : cA + (size_t)(t + 2) * kstep; const char* b2 = last ? nB : cB + (size_t)(t + 2) * kstep;
            const char* a3 = a2 + kstep; const char* b3 = b2 + kstep;
            if (last && has_next) S.a_ready(nxt);
            if constexpr (GATHER) {
                if (last && has_next) {
#pragma unroll
                    for (int h = 0; h < 2; ++h)
#pragma unroll
                        for (int i = 0; i < 2; ++i) gnxt[h][i] = (unsigned)PG8_TOKSLOT(ui + 1)[h * HALF + rowA[i]] * (unsigned)(K * 2) + voffA[i];
                }
#pragma unroll
                for (int h = 0; h < 2; ++h)
#pragma unroll
                    for (int i = 0; i < 2; ++i) gs[h][i] = last ? gnxt[h][i] : gcur[h][i];
            }
            PG8_LDB(B0, 0, 0); PG8_SCHED; PG8_LDA(At, 0, 0); PG8_STAGE_A(PG8_SA(1, 1), a1, 1, gcur);
            PG8_WAIT_L(8); PG8_BAR; PG8_WAIT_L(0); PG8_MMA(0, 0, At, B0); PG8_BAR; PG8_SCHED;
            PG8_LDB(B1, 0, 1); PG8_STAGE(PG8_SB(0, 0), b2, voffB);
            PG8_BAR; PG8_WAIT_L(0); PG8_MMA(0, 1, At, B1); PG8_BAR;
            PG8_LDA(At, 0, 1); PG8_STAGE_A(PG8_SA(0, 0), a2, 0, gs);
            PG8_BAR; PG8_WAIT_L(0); PG8_MMA(1, 0, At, B0); PG8_BAR; PG8_SCHED;
            PG8_STAGE(PG8_SB(0, 1), b2 + hstep, voffB);
            PG8_WAIT_V(6); PG8_BAR; PG8_MMA(1, 1, At, B1); PG8_BAR;
            PG8_LDB(B0, 1, 0); PG8_SCHED; PG8_LDA(At, 1, 0); PG8_STAGE_A(PG8_SA(0, 1), a2, 1, gs);
            PG8_WAIT_L(8); PG8_BAR; PG8_WAIT_L(0); PG8_MMA(0, 0, At, B0); PG8_BAR; PG8_SCHED;
            PG8_LDB(B1, 1, 1); PG8_STAGE(PG8_SB(1, 0), b3, voffB);
            PG8_BAR; PG8_WAIT_L(0); PG8_MMA(0, 1, At, B1); PG8_BAR;
            PG8_LDA(At, 1, 1); PG8_STAGE_A(PG8_SA(1, 0), a3, 0, gs);
            PG8_BAR; PG8_WAIT_L(0); PG8_MMA(1, 0, At, B0); PG8_BAR; PG8_SCHED;
            PG8_STAGE(PG8_SB(1, 1), b3 + hstep, voffB);
            PG8_WAIT_V(6); PG8_BAR; PG8_MMA(1, 1, At, B1); PG8_BAR;
        }
        PG8_STAMP();
        if constexpr (!Epi::AFTER_DRAIN) { E(acc, cur, wr, wc, fr, fq); S.done(cur); }
        PG8_STAMP();
        if (!has_next) break;
#pragma unroll
        for (int a = 0; a < 2; ++a)
#pragma unroll
            for (int b = 0; b < 2; ++b)
#pragma unroll
                for (int m = 0; m < 4; ++m)
#pragma unroll
                    for (int n = 0; n < 2; ++n) acc[a][b][m][n] = (f32x4){0.f, 0.f, 0.f, 0.f};
        cur = nxt; cA = nA; cB = nB; ++ui;
        if constexpr (GATHER) {
#pragma unroll
            for (int h = 0; h < 2; ++h)
#pragma unroll
                for (int i = 0; i < 2; ++i) gcur[h][i] = gnxt[h][i];
        }
    }
    PG8_WAIT_V(0);
    if (wr == 0) PG8_BAR;
    PG8_BAR;
    if constexpr (Epi::AFTER_DRAIN) { E.fused(acc, cur, wr, wc, fr, fq, lds, wid, lane); S.done(cur); }
    PG8_STAMP();
    if (STAMP && wid == 0) { stamps[lane] = lane < nts ? (((unsigned long long)(unsigned)ts_hi << 32) | (unsigned)ts_lo) : 0ull;
        if (lane == 62) stamps[62] = rt_entry; if (lane == 63) stamps[63] = (unsigned long long)wall_clock64(); }
#undef PG8_STAMP
#undef PG8_SA
#undef PG8_SB
#undef PG8_STAGE
#undef PG8_STAGE_A
#undef PG8_TOKSLOT
#undef PG8_LDA
#undef PG8_LDB
#undef PG8_MMA
#undef PG8_WAIT_V
#undef PG8_WAIT_L
#undef PG8_BAR
#undef PG8_SCHED
}
}
namespace pg8 {
struct EpiRes {
    static constexpr bool PERM = false, AFTER_DRAIN = false;
    const void* base_lat; const float* base_ctx; void* out_lat; float* out_ctx; const float* gvec; bool base_bf, out_bf;
    __device__ __forceinline__ void operator()(const f32x4 (&acc)[2][2][4][2], const Unit& u, int wr, int wc, int fr, int fq) const {
        const bool isctx = u.pm >= 128;
        const int prow = (isctx ? (u.pm - 128) : u.pm) * BM;
        const float* base = isctx ? base_ctx : (const float*)base_lat; float* out = isctx ? out_ctx : (float*)out_lat;
        const bool bbf = !isctx && base_bf, obf = !isctx && out_bf;
        const float* gv = gvec + (size_t)(isctx ? 8 : (u.pm >> 4)) * 6144;
        const int row0 = prow + wr * 64 + fr, col0 = u.pn * BM + wc * 32 + 4 * fq;
        f32x4 gvv[2][2];
#pragma unroll
        for (int bj = 0; bj < 2; ++bj)
#pragma unroll
            for (int n = 0; n < 2; ++n) gvv[bj][n] = *(const f32x4*)(gv + col0 + bj * HALF + n * 16);
#pragma unroll
        for (int ai = 0; ai < 2; ++ai)
#pragma unroll
            for (int m = 0; m < 4; ++m) { const size_t off = (size_t)(row0 + ai * HALF + m * 16) * 1024 + col0;
#pragma unroll
                for (int bj = 0; bj < 2; ++bj)
#pragma unroll
                    for (int n = 0; n < 2; ++n) { const size_t o2 = off + bj * HALF + n * 16;
                        const f32x4 b = bbf ? ld4bf((const bf16*)base_lat + o2) : *(const f32x4*)(base + o2);
                        const f32x4 v = b + gvv[bj][n] * acc[ai][bj][m][n];
                        if (obf) st4bf((bf16*)out_lat + o2, v); else *(f32x4*)(out + o2) = v; } }
    }
};
struct EpiSwiglu {
    static constexpr bool PERM = true, AFTER_DRAIN = false;
    bf16_t* O; int ldc;
    __device__ __forceinline__ void operator()(const f32x4 (&acc)[2][2][4][2], const Unit& u, int wr, int wc, int fr, int fq) const {
        const int row0 = u.pm * BM + wr * 64 + fr, col0 = u.pn * HALF + wc * 32 + 8 * fq;
#pragma unroll
        for (int ai = 0; ai < 2; ++ai)
#pragma unroll
            for (int m = 0; m < 4; ++m) { bf16_t* rowp = O + (size_t)(row0 + ai * HALF + m * 16) * ldc + col0;
                float h[8];
#pragma unroll
                for (int n = 0; n < 2; ++n)
#pragma unroll
                    for (int j = 0; j < 4; ++j) { const float g = acc[ai][0][m][n][j], up = acc[ai][1][m][n][j]; h[n * 4 + j] = g * __builtin_amdgcn_rcpf(1.0f + __expf(-g)) * up; }
                u32x4 w; w.x = cvt_pk_bf16(h[0], h[1]); w.y = cvt_pk_bf16(h[2], h[3]); w.z = cvt_pk_bf16(h[4], h[5]); w.w = cvt_pk_bf16(h[6], h[7]);
                *(u32x4*)rowp = w; }
    }
};
struct MoeOrder {
    static constexpr bool GATHER = false;
    int nN, G, c, nunits; const int* tab;
    __device__ void init(const int* tab_, int nN_, int G_, int c_) { tab = tab_; nN = nN_; G = G_; c = c_; nunits = tab_[0] * nN_; }
    __device__ bool next(int i, Unit& u) const {
        const int L = i * G + c; if (L >= nunits) return false;
        const int q = nunits / NXCD, r = nunits % NXCD, xcd = L % NXCD, off = L / NXCD;
        const int w = (xcd < r ? xcd * (q + 1) : r * (q + 1) + (xcd - r) * q) + off;
        u.pm = w / nN; u.pn = w - u.pm * nN; u.e = tab[1 + u.pm]; return true;
    }
    __device__ __forceinline__ void a_ready(const Unit&) const {}
    __device__ __forceinline__ void done(const Unit&) const {}
};
struct MoeOrderG : MoeOrder { static constexpr bool GATHER = true; const int* tok; };
}
enum { I_X = 0, I_C, I_CTX, I_CCTX, I_MODW, I_MODB, I_NMIXG, I_NFFNG, I_WIN, I_WOUT, I_LCW, I_LCB, I_LWA, I_LBA, I_LWX, I_LBX, I_LLAM,
       I_RMU, I_RWUP, I_RW0, I_RAUP, I_RA0, I_RGUP, I_RKK, I_RKA, I_RRK, I_RLNG, I_RLNB, I_MIB, I_MFB, I_MNG, I_GCW, I_GALOG, I_GDTB, I_GNG,
       I_FWG, I_FWU, I_FWD, I_MROUTER, I_MWG, I_MWU, I_MWD, I_FNG, N_IN };
struct Args { const float* in[N_IN]; float* out; unsigned char* ws; int ph_lo, ph_hi; };
struct Ctx {
    const float* const* in; float* out; unsigned char* ws; LAS unsigned char* lds;
    int tid, lane, wave, G, wg;
};
#define WSP(T, off) ((T*)(C.ws + (off)))

__device__ __forceinline__ int seqrow_raster(int i, int d, int b) {
    if (i < CTXL) { const int p = d ? (CTXL - 1 - i) : i; return T_LAT + b * CTXL + p; }
    const int j = i - CTXL; const int p = d ? (SEQ - 1 - j) : j; return b * SEQ + p;
}
__device__ __forceinline__ int seqrow_cm(int i, int d, int b) {
    if (i < CTXL) { const int p = d ? (CTXL - 1 - i) : i; return T_LAT + b * CTXL + p; }
    const int j = i - CTXL; const int p = d ? (SEQ - 1 - j) : j; return b * SEQ + (p & 63) * 64 + (p >> 6);
}

__device__ __forceinline__ void phase_pre(const Ctx& C) {
    LAS float* sc = (LAS float*)C.lds;
    LAS float* red = sc + 9 * 1024;
    float* modv = WSP(float, WS_MODV);
    bool filled = false;
    for (int it = C.wg; it < DEPTH * 48; it += C.G) {
        if (!filled) {
            for (int i = C.tid; i < 9 * 1024; i += NTHR) { const float v = i < 8192 ? C.in[I_C][i] : C.in[I_CCTX][i - 8192]; sc[i] = siluf_(v); }
            filled = true; __syncthreads();
        }
        const int l = it / 48, jb = it % 48, col = C.tid & 127, kg = C.tid >> 7;
        const float* W = C.in[I_MODW] + (size_t)l * 1024 * 6144 + jb * 128 + col;
        float acc[9];
#pragma unroll
        for (int r = 0; r < 9; ++r) acc[r] = 0.f;
        for (int k = kg * 256; k < kg * 256 + 256; ++k) { const float w = W[(size_t)k * 6144];
#pragma unroll
            for (int r = 0; r < 9; ++r) acc[r] += sc[r * 1024 + k] * w; }
#pragma unroll
        for (int r = 0; r < 9; ++r) red[(kg * 9 + r) * 128 + col] = acc[r];
        __syncthreads();
        for (int i = C.tid; i < 9 * 128; i += NTHR) { const int r = i >> 7, cc = i & 127;
            const float s = red[(0 * 9 + r) * 128 + cc] + red[(1 * 9 + r) * 128 + cc] + red[(2 * 9 + r) * 128 + cc] + red[(3 * 9 + r) * 128 + cc];
            modv[((size_t)l * 9 + r) * 6144 + jb * 128 + cc] = s + C.in[I_MODB][l * 6144 + jb * 128 + cc]; }
        __syncthreads();
    }
}

__device__ __forceinline__ void tr_item(const float* src, size_t ld, int k0, int ns0, bf16* dst, int drow0, int Kd, LAS float* scr, int lane, bool zero) {
    if (!zero) {
#pragma unroll 8
        for (int i = 0; i < 32; ++i) { const int kk = 2 * i + (lane >> 5); scr[kk * 33 + (lane & 31)] = src[(size_t)(k0 + kk) * ld + ns0 + (lane & 31)]; }
    }
    LDS_WAIT(); asm volatile("" ::: "memory");
    const int c = lane & 7;
#pragma unroll
    for (int j = 0; j < 4; ++j) { const int n = (lane >> 3) + 8 * j; const LAS float* s = scr + (8 * c) * 33 + n;
        v4u o; o.x = pk2(s[0 * 33], s[1 * 33]); o.y = pk2(s[2 * 33], s[3 * 33]); o.z = pk2(s[4 * 33], s[5 * 33]); o.w = pk2(s[6 * 33], s[7 * 33]);
        if (zero) o = (v4u){0u, 0u, 0u, 0u};
        *(v4u*)(dst + (size_t)(drow0 + n) * Kd + k0 + 8 * c) = o; }
    LDS_WAIT(); asm volatile("" ::: "memory");
}
__device__ __forceinline__ void convert_small(const Ctx& C, int l) {
    {
        bf16* lw = WSP(bf16, WS_LRUWT);
        for (int k = 0; k < 2 * 2 * 4 * 4096 / (128 * NTHR); ++k) {
            const int e = k * 128 * NTHR + C.wg * NTHR + C.tid;
            if (C.wg < 128) {
            const int i = e & 63, j = (e >> 6) & 63, hd = (e >> 12) & 3, g = (e >> 14) & 1, d = e >> 15;
            const float* src = (g ? C.in[I_LWX] : C.in[I_LWA]) + ((size_t)((l * 2 + d) * 4 + hd) * 64 + i) * 64 + j;
            lw[e] = (bf16)f2bf(*src);
            }
        }
    }
    if (C.wg >= 128 && C.wg < 224) {
        bf16* rw = WSP(bf16, WS_RWT);
        const int e = (C.wg - 128) * NTHR + C.tid;
        if (e < 32768) { const int r = e & 31, ch = (e >> 5) & 255, d = (e >> 13) & 1, isa = e >> 14;
            rw[e] = (bf16)f2bf((isa ? C.in[I_RAUP] : C.in[I_RWUP])[((size_t)(l * 2 + d) * 32 + r) * GW + ch]); }
        else { const int e2 = e - 32768, j = e2 & 63, ch = e2 >> 6; rw[e] = (bf16)f2bf(C.in[I_RGUP][((size_t)l * 64 + j) * GW + ch]); }
    }
}
__device__ __forceinline__ void convert_items(const Ctx& C, int l, int what, int gw, int NGW) {
    LAS float* scr = (LAS float*)(C.lds + C.wave * 8704);
    constexpr int I_IN = 16 * 112, I_OUT = 16 * 32, I_GU = 16 * 176, I_DN = 44 * 32, I_E = 16 * 88 + 22 * 32;
    const bool moe = l & 1; const int li = l >> 1;
    const int lo_it = (what & 1) ? 0 : I_IN, hi_it = (what & 2) ? I_IN + I_OUT + (moe ? NE * I_E : (I_GU + I_DN)) : I_IN;
    bf16* win = WSP(bf16, WS_WIN); bf16* wout = WSP(bf16, WS_WOUT); bf16* wgu = WSP(bf16, WS_WGU); bf16* wdn = WSP(bf16, WS_WDN);
    for (int it = lo_it + gw; it < hi_it; it += NGW) {
        int r = it;
        if (r < I_IN) { const int kb = r / 112, nb = r % 112; tr_item(C.in[I_WIN] + (size_t)l * 1024 * IN_COLS, IN_COLS, 64 * kb, 32 * nb, win, 32 * nb, 1024, scr, C.lane, nb == 111); continue; }
        r -= I_IN;
        if (r < I_OUT) { const int kb = r / 32, nb = r % 32; tr_item(C.in[I_WOUT] + (size_t)l * 1024 * 1024, 1024, 64 * kb, 32 * nb, wout, 32 * nb, 1024, scr, C.lane, false); continue; }
        r -= I_OUT;
        if (!moe) {
            if (r < I_GU) { const int kb = r / 176, nb = r % 176, tile = nb >> 3, q = nb & 7;
                const float* src = (q < 4 ? C.in[I_FWG] : C.in[I_FWU]) + (size_t)li * 1024 * DFF;
                tr_item(src, DFF, 64 * kb, tile * 128 + (q & 3) * 32, wgu, 32 * nb, 1024, scr, C.lane, false); continue; }
            r -= I_GU;
            { const int kb = r / 32, nb = r % 32; tr_item(C.in[I_FWD] + (size_t)li * DFF * 1024, 1024, 64 * kb, 32 * nb, wdn, 32 * nb, DFF, scr, C.lane, false); }
        } else {
            const int e = r / I_E; int rr = r % I_E;
            if (rr < 16 * 88) { const int kb = rr / 88, nb = rr % 88, tile = nb >> 3, q = nb & 7;
                const float* src = (q < 4 ? C.in[I_MWG] : C.in[I_MWU]) + ((size_t)li * NE + e) * 1024 * DFE;
                tr_item(src, DFE, 64 * kb, tile * 128 + (q & 3) * 32, wgu + (size_t)e * 2 * DFE * 1024, 32 * nb, 1024, scr, C.lane, false); continue; }
            rr -= 16 * 88;
            { const int kb = rr / 32, nb = rr % 32; tr_item(C.in[I_MWD] + ((size_t)li * NE + e) * DFE * 1024, 1024, 64 * kb, 32 * nb, wdn + (size_t)e * 1024 * DFE, 32 * nb, DFE, scr, C.lane, false); }
        }
    }
}

template <bool ROUTE>
__device__ __forceinline__ void norm_rows(const Ctx& C, int l, const void* xlat, bool xbf, const float* xctx, const float* gain, int shoff, int scoff, int nrows, int moe_li) {
    const float* modv = WSP(float, WS_MODV) + (size_t)l * 9 * 6144;
    bf16* hb = WSP(bf16, WS_HB);
    const int gw = C.wg * NWAVES + C.wave, NGW = C.G * NWAVES;
    LAS unsigned* lcnt = (LAS unsigned*)(C.lds + 65536);
    unsigned* route = WSP(unsigned, WS_ROUTE);
    if (ROUTE) { if (C.tid < 8) lcnt[C.tid] = 0u; __syncthreads(); }
    f32x4 gv[4];
#pragma unroll
    for (int j = 0; j < 4; ++j) gv[j] = *(const f32x4*)(gain + 4 * C.lane + 256 * j);
    for (int m = gw; m < nrows; m += NGW) {
        const bool isctx = m >= T_LAT;
        const float* xr = isctx ? xctx + (size_t)(m - T_LAT) * 1024 : (const float*)xlat + (size_t)m * 1024; const bf16* xrb = (const bf16*)xlat + (size_t)m * 1024; const bool rbf = xbf && !isctx;
        const float* mv = modv + (size_t)(isctx ? 8 : (m >> 12)) * 6144;
        f32x4 v[4]; float s = 0.f;
#pragma unroll
        for (int j = 0; j < 4; ++j) { v[j] = rbf ? ld4bf(xrb + 4 * C.lane + 256 * j) : *(const f32x4*)(xr + 4 * C.lane + 256 * j); s += (v[j].x * v[j].x + v[j].y * v[j].y) + (v[j].z * v[j].z + v[j].w * v[j].w); }
        const float rs = rsqrtf_(wave_sum(s) * (1.0f / 1024.0f) + 1e-6f);
#pragma unroll
        for (int j = 0; j < 4; ++j) { const f32x4 sh = *(const f32x4*)(mv + shoff + 4 * C.lane + 256 * j), scl = *(const f32x4*)(mv + scoff + 4 * C.lane + 256 * j);
            v[j] = (v[j] * rs * gv[j]) * (scl + 1.0f) + sh;
            v2u o; o.x = pk2(v[j].x, v[j].y); o.y = pk2(v[j].z, v[j].w);
            *(v2u*)(hb + (size_t)m * 1024 + 4 * C.lane + 256 * j) = o; }
        if (ROUTE) {
            const float* rt = C.in[I_MROUTER] + (size_t)moe_li * 1024 * NE;
            float lg[8];
#pragma unroll
            for (int e = 0; e < 8; ++e) lg[e] = 0.f;
#pragma unroll
            for (int j = 0; j < 4; ++j)
#pragma unroll
                for (int q = 0; q < 4; ++q) { const int k = 4 * C.lane + 256 * j + q; const f32x4 r0 = *(const f32x4*)(rt + (size_t)k * 8), r1 = *(const f32x4*)(rt + (size_t)k * 8 + 4); const float hv = v[j][q];
                    lg[0] += hv * r0.x; lg[1] += hv * r0.y; lg[2] += hv * r0.z; lg[3] += hv * r0.w; lg[4] += hv * r1.x; lg[5] += hv * r1.y; lg[6] += hv * r1.z; lg[7] += hv * r1.w; }
#pragma unroll
            for (int e = 0; e < 8; ++e) lg[e] = wave_sum(lg[e]);
            int e0 = 0; float l0 = lg[0];
#pragma unroll
            for (int e = 1; e < 8; ++e) if (lg[e] > l0) { l0 = lg[e]; e0 = e; }
            int e1 = (e0 == 0) ? 1 : 0; float l1 = -3.0e38f;
#pragma unroll
            for (int e = 0; e < 8; ++e) if (e != e0 && lg[e] > l1) { l1 = lg[e]; e1 = e; }
            const float w0 = __builtin_amdgcn_rcpf(1.0f + __expf(l1 - l0)), w1 = 1.0f - w0;
            if (C.lane == 0) {
                const unsigned r0 = atomicAdd((unsigned*)&lcnt[e0], 1u), r1 = atomicAdd((unsigned*)&lcnt[e1], 1u);
                v4u a; a.x = (unsigned)e0; a.y = (unsigned)e1; a.z = r0; a.w = r1;
                *(v4u*)(route + (size_t)m * 8) = a;
                v2u b; b.x = __builtin_bit_cast(unsigned, w0); b.y = __builtin_bit_cast(unsigned, w1);
                *(v2u*)(route + (size_t)m * 8 + 4) = b;
            }
        }
    }
    if (ROUTE) {
        __syncthreads();
        if (C.tid < 8) { unsigned* gc = WSP(unsigned, WS_CTL) + CW_MOECNT + 64 * moe_li; const unsigned base = atomicAdd(gc + C.tid, lcnt[C.tid]); WSP(unsigned, WS_WGBASE)[C.wg * 8 + C.tid] = base; }
    }
}
#define RAW_BARRIER() do { asm volatile("s_waitcnt lgkmcnt(0)" ::: "memory"); __builtin_amdgcn_s_barrier(); asm volatile("" ::: "memory"); } while (0)
__device__ __forceinline__ void gdn_prep(const Ctx& C, int l, int b, int c) {
    const bf16* P = WSP(const bf16, WS_P); bf16* gq = WSP(bf16, WS_GQ);
    const bool isctx = c < 4; const int p0 = isctx ? c * 64 : (c - 4) * 64; const int Lp = isctx ? CTXL : SEQ;
    const int ch = 4 * C.lane;
    auto rowof = [&](int p) -> int { return isctx ? (T_LAT + b * CTXL + p) : (b * SEQ + (p & 63) * 64 + (p >> 6)); };
    f32x4 cw[4][3], x[4][3];
#pragma unroll
    for (int j = 0; j < 4; ++j)
#pragma unroll
        for (int g = 0; g < 3; ++g) cw[j][g] = *(const f32x4*)(C.in[I_GCW] + ((size_t)l * 4 + j) * 768 + g * 256 + ch);
    const int tb = p0 + C.wave * 8;
    auto ldrow = [&](int p, f32x4 (&dst)[3]) {
        if (p >= 0 && p < Lp) { const bf16* pr = P + (size_t)rowof(p) * PLD + OFF_D + ch;
#pragma unroll
            for (int g = 0; g < 3; ++g) dst[g] = ld4bf(pr + g * 256); }
        else {
#pragma unroll
            for (int g = 0; g < 3; ++g) dst[g] = (f32x4){0.f, 0.f, 0.f, 0.f}; }
    };
    ldrow(tb - 2, x[0]); ldrow(tb - 1, x[1]); ldrow(tb, x[2]);
#pragma unroll
    for (int t = 0; t < 8; ++t) {
        ldrow(tb + t + 1, x[3]);
        bf16* orow = gq + (size_t)rowof(tb + t) * 768 + ch;
#pragma unroll
        for (int g = 0; g < 3; ++g) {
            f32x4 v = cw[0][g] * x[0][g] + cw[1][g] * x[1][g] + cw[2][g] * x[2][g] + cw[3][g] * x[3][g];
            v = (f32x4){siluf_(v.x), siluf_(v.y), siluf_(v.z), siluf_(v.w)};
            if (g < 2) { const float ss = row16_sum((v.x * v.x + v.y * v.y) + (v.z * v.z + v.w * v.w)); v = v * (rsqrtf_(ss + 1e-6f) * (g == 0 ? 0.125f : 1.0f)); }
            st4bf(orow + g * 256, v);
        }
#pragma unroll
        for (int g = 0; g < 3; ++g) { x[0][g] = x[1][g]; x[1][g] = x[2][g]; x[2][g] = x[3][g]; }
    }
}
__device__ __forceinline__ void finish_rows(const Ctx& C, int l, int nrows) {
    const bf16* P = WSP(const bf16, WS_P); bf16* yc = WSP(bf16, WS_HB);
    const bf16* ob = WSP(const bf16, WS_OUTB); const bf16* oc = WSP(const bf16, WS_OUTC); const bf16* od = WSP(const bf16, WS_OUTD);
    const bf16* gg = WSP(const bf16, WS_G); const float* bonus = WSP(const float, WS_BONUS);
    const float* mu = C.in[I_RMU] + (size_t)l * 2 * B_COLS;
    const int gw = C.wg * NWAVES + C.wave, NGW = C.G * NWAVES, lane = C.lane, ch = 4 * lane, hh = lane >> 4;
    const f32x4 lng = *(const f32x4*)(C.in[I_RLNG] + l * GW + ch), lnb = *(const f32x4*)(C.in[I_RLNB] + l * GW + ch);
    const f32x4 mng = *(const f32x4*)(C.in[I_MNG] + l * GW + ch), gng = *(const f32x4*)(C.in[I_GNG] + l * GW + ch);
    const f32x4 mu0 = *(const f32x4*)(mu + 512 + ch), mu1 = *(const f32x4*)(mu + B_COLS + 512 + ch);
    const size_t o2 = (size_t)T_ALL * 256;
#pragma unroll 2
    for (int m = gw; m < nrows; m += NGW) {
        const bool isctx = m >= T_LAT; const int Lp = isctx ? CTXL : SEQ; const int p = isctx ? ((m - T_LAT) & (CTXL - 1)) : (m & (SEQ - 1));
        const f32x4 yb = ld4bf(ob + (size_t)m * 256 + ch) + ld4bf(ob + o2 + (size_t)m * 256 + ch);
        const f32x4 ycv = ld4bf(oc + (size_t)m * 256 + ch) + ld4bf(oc + o2 + (size_t)m * 256 + ch);
        const f32x4 yd = ld4bf(od + (size_t)m * 256 + ch) + ld4bf(od + o2 + (size_t)m * 256 + ch);
        const bf16* pr = P + (size_t)m * PLD;
        const f32x4 vs = ld4bf(WSP(const bf16, WS_RKV) + (size_t)m * 768 + 512 + ch);
        const f32x4 og = ld4bf(pr + OFF_C + 768 + ch), gd = ld4bf(pr + OFF_D + 768 + ch), gr = ld4bf(gg + (size_t)m * 256 + ch);
        const float bn = bonus[(size_t)m * 4 + hh];
        *(v2u*)(yc + (size_t)m * 1024 + ch) = *(const v2u*)(pr + 256 + ch);
        {
            const float mean = row16_sum((yb.x + yb.y) + (yb.z + yb.w)) * (1.0f / 64.0f);
            const f32x4 dl = yb - mean;
            const float var = row16_sum((dl.x * dl.x + dl.y * dl.y) + (dl.z * dl.z + dl.w * dl.w)) * (1.0f / 64.0f);
            const f32x4 yn = dl * rsqrtf_(var + 64e-5f) * lng + lnb;
            st4bf(yc + (size_t)m * 1024 + 256 + ch, (yn + vs * bn) * gr);
        }
        {
            const float ms = row16_sum((ycv.x * ycv.x + ycv.y * ycv.y) + (ycv.z * ycv.z + ycv.w * ycv.w)) * (1.0f / 64.0f);
            const f32x4 sg = (f32x4){sigmoidf_(og.x), sigmoidf_(og.y), sigmoidf_(og.z), sigmoidf_(og.w)};
            st4bf(yc + (size_t)m * 1024 + 512 + ch, ycv * rsqrtf_(ms + 1e-6f) * mng * sg);
        }
        {
            const float ms = row16_sum((yd.x * yd.x + yd.y * yd.y) + (yd.z * yd.z + yd.w * yd.w)) * (1.0f / 64.0f);
            const f32x4 sg = (f32x4){siluf_(gd.x), siluf_(gd.y), siluf_(gd.z), siluf_(gd.w)};
            st4bf(yc + (size_t)m * 1024 + 768 + ch, yd * rsqrtf_(ms + 1e-6f) * gng * sg);
        }
    }
}
typedef bf16x8 fragb;
__device__ __forceinline__ f32x4 mfma16(fragb a, fragb b, f32x4 c) { return __builtin_amdgcn_mfma_f32_16x16x32_bf16(a, b, c, 0, 0, 0); }
__device__ __forceinline__ fragb ld_frag16(const LAS bf16* p) { return *(const LAS fragb*)p; }
__device__ __forceinline__ fragb ld_frag8x2(const LAS bf16* p0, const LAS bf16* p1) {
    const v2u a = *(const LAS v2u*)p0, b = *(const LAS v2u*)p1; v4u r; r.x = a.x; r.y = a.y; r.z = b.x; r.w = b.y; return __builtin_bit_cast(fragb, r); }
__device__ __forceinline__ fragb pack_frag(const f32x4& lo, const f32x4& hi) { v4u r; r.x = pk2(lo.x, lo.y); r.y = pk2(lo.z, lo.w); r.z = pk2(hi.x, hi.y); r.w = pk2(hi.z, hi.w); return __builtin_bit_cast(fragb, r); }
__device__ __forceinline__ float wave_incl_sum(float v, int lane) {
    v += dpp_x<0x111, 0xF, true>(0.f, v); v += dpp_x<0x112, 0xF, true>(0.f, v); v += dpp_x<0x114, 0xF, true>(0.f, v); v += dpp_x<0x118, 0xF, true>(0.f, v);
    v += dpp_x<0x142, 0xA, false>(0.f, v); v += dpp_x<0x143, 0xC, false>(0.f, v);
    return v;
}
__device__ __forceinline__ float wave_incl_max(float v, int lane) {
    const float ninf = -3.0e38f;
    v = fmaxf(v, dpp_x<0x111, 0xF, false>(ninf, v)); v = fmaxf(v, dpp_x<0x112, 0xF, false>(ninf, v)); v = fmaxf(v, dpp_x<0x114, 0xF, false>(ninf, v)); v = fmaxf(v, dpp_x<0x118, 0xF, false>(ninf, v));
    v = fmaxf(v, dpp_x<0x142, 0xA, false>(ninf, v)); v = fmaxf(v, dpp_x<0x143, 0xC, false>(ninf, v));
    return v;
}
constexpr int MP = 72;
__device__ __forceinline__ void mlstm_chunked(const Ctx& C, int l, int idx) {
    const int d = idx >> 5, b = (idx >> 2) & 7, h = idx & 3, lane = C.lane, w = C.wave, l15 = lane & 15, q = lane >> 4;
    const int it = w & 3, vtp = w >> 2;
    constexpr int IMG = 64 * MP * 2, BUFB = 4 * IMG + 1024, CTB = 65 * MP * 2 + 16;
    LAS unsigned char* L0 = C.lds;
    const bf16* P = WSP(const bf16, WS_P); bf16* outc = WSP(bf16, WS_OUTC) + (size_t)d * T_ALL * 256;
    const float ib = C.in[I_MIB][(l * 2 + d) * NH + h], fb = C.in[I_MFB][(l * 2 + d) * NH + h];
    const int tt = C.tid >> 3, part = C.tid & 7;
    for (int i = C.tid; i < 2 * CTB / 4; i += NTHR) ((LAS unsigned*)(L0 + 2 * BUFB))[i] = 0u;
    v4u rq, rk, rv; unsigned short rgi, rgf;
    auto gload = [&](int n) {
        const int row = seqrow_cm(n * 64 + tt, d, b);
        const bf16* pp = P + (size_t)row * PLD + OFF_C + h * 64 + 8 * part;
        rq = *(const v4u*)pp; rk = *(const v4u*)(pp + 256); rv = *(const v4u*)(pp + 512);
        const bf16* pg = P + (size_t)seqrow_cm(n * 64 + lane, d, b) * PLD + OFF_C + 1024 + d * 4 + h;
        rgi = pg[0]; rgf = pg[8];
    };
    auto images = [&](int bufi) {
        LAS unsigned char* B0 = L0 + bufi * BUFB;
        LAS bf16* Qs = (LAS bf16*)B0; LAS bf16* Ks = Qs + 64 * MP; LAS bf16* VT = Ks + 64 * MP; LAS bf16* KTw = VT + 64 * MP; LAS float* vec = (LAS float*)(B0 + 4 * IMG);
        const float li = bf2f(rgi) + ib, lf = -softplusf_(-(bf2f(rgf) + fb));
        const float bc = wave_incl_sum(lf, lane), x = li - bc, cm = wave_incl_max(x, lane);
        const float wl = __expf(x - __shfl(cm, 63)) * 0.125f;
        if (w == 0) { vec[lane] = x; vec[64 + lane] = cm; vec[128 + lane] = bc; }
        const float wmine = __shfl(wl, 8 * w + (lane >> 3));
        *(LAS v4u*)(Qs + tt * MP + 8 * part) = rq; *(LAS v4u*)(Ks + tt * MP + 8 * part) = rk;
        const unsigned vv[4] = {rv.x, rv.y, rv.z, rv.w}, kk[4] = {rk.x, rk.y, rk.z, rk.w};
#pragma unroll
        for (int e = 0; e < 4; ++e) {
            VT[(8 * part + 2 * e) * MP + tt] = (bf16)(vv[e] & 0xffffu); VT[(8 * part + 2 * e + 1) * MP + tt] = (bf16)(vv[e] >> 16);
            KTw[(8 * part + 2 * e) * MP + tt] = (bf16)f2bf1(bflo(kk[e]) * wmine); KTw[(8 * part + 2 * e + 1) * MP + tt] = (bf16)f2bf1(bfhi(kk[e]) * wmine);
        }
    };
    f32x4 Cst[2], nst; float m = 0.f;
    Cst[0] = Cst[1] = nst = (f32x4){0.f, 0.f, 0.f, 0.f};
    const fragb ones = __builtin_bit_cast(fragb, (v4u){0x3F803F80u, 0x3F803F80u, 0x3F803F80u, 0x3F803F80u});
    const f32x4 z4 = (f32x4){0.f, 0.f, 0.f, 0.f};
    gload(0); images(0); gload(1);
#pragma unroll 1
    for (int n = 0; n < NCH; ++n) {
        RAW_BARRIER();
        const LAS unsigned char* B0 = L0 + (n & 1) * BUFB;
        const LAS bf16* Qs = (const LAS bf16*)B0; const LAS bf16* Ks = Qs + 64 * MP; const LAS bf16* VT = Ks + 64 * MP; const LAS bf16* KTw = VT + 64 * MP; const LAS float* vec = (const LAS float*)(B0 + 4 * IMG);
        const LAS bf16* CT = (const LAS bf16*)(L0 + 2 * BUFB + (n & 1) * CTB); LAS bf16* CTn = (LAS bf16*)(L0 + 2 * BUFB + ((n + 1) & 1) * CTB);
        fragb Qf[2]; Qf[0] = ld_frag16(Qs + (16 * it + l15) * MP + 8 * q); Qf[1] = ld_frag16(Qs + (16 * it + l15) * MP + 32 + 8 * q);
        const float cmi = vec[64 + 16 * it + l15]; const int icol = 16 * it + l15;
        f32x4 pt[4];
#pragma unroll
        for (int jt = 0; jt < 4; ++jt) {
            pt[jt] = z4;
            if (jt <= it) {
                const fragb k0 = ld_frag16(Ks + (16 * jt + l15) * MP + 8 * q), k1 = ld_frag16(Ks + (16 * jt + l15) * MP + 32 + 8 * q);
                f32x4 st = mfma16(k0, Qf[0], z4); st = mfma16(k1, Qf[1], st);
                const f32x4 xj = *(const LAS f32x4*)(vec + 16 * jt + 4 * q);
#pragma unroll
                for (int r = 0; r < 4; ++r) { const int j = 16 * jt + 4 * q + r; pt[jt][r] = (j <= icol) ? st[r] * __expf(xj[r] - cmi) * 0.125f : 0.f; }
            }
        }
        fragb Pf[2]; Pf[0] = pack_frag(pt[0], pt[1]); Pf[1] = pack_frag(pt[2], pt[3]);
        fragb Vf[2][2];
#pragma unroll
        for (int v2 = 0; v2 < 2; ++v2)
#pragma unroll
            for (int s = 0; s < 2; ++s) { const LAS bf16* vr = VT + (16 * (2 * vtp + v2) + l15) * MP + 32 * s + 4 * q; Vf[v2][s] = ld_frag8x2(vr, vr + 16); }
        f32x4 Aacc[2], R[2], as, dn;
        as = mfma16(Pf[0], ones, z4); if (it >= 2) as = mfma16(Pf[1], ones, as);
        const fragb nf0 = ld_frag16(CT + 64 * MP + 8 * q), nf1 = ld_frag16(CT + 64 * MP + 32 + 8 * q);
        dn = mfma16(Qf[0], nf0, z4); dn = mfma16(Qf[1], nf1, dn);
#pragma unroll
        for (int v2 = 0; v2 < 2; ++v2) {
            Aacc[v2] = mfma16(Pf[0], Vf[v2][0], z4); if (it >= 2) Aacc[v2] = mfma16(Pf[1], Vf[v2][1], Aacc[v2]);
            const LAS bf16* cr = CT + (16 * (2 * vtp + v2) + l15) * MP + 8 * q;
            R[v2] = mfma16(Qf[0], ld_frag16(cr), z4); R[v2] = mfma16(Qf[1], ld_frag16(cr + 32), R[v2]);
        }
        {
            const f32x4 bi = *(const LAS f32x4*)(vec + 128 + 16 * it + 4 * q), cmr = *(const LAS f32x4*)(vec + 64 + 16 * it + 4 * q);
#pragma unroll
            for (int r = 0; r < 4; ++r) {
                const float mi = bi[r] + cmr[r], minter = bi[r] + m, mt = fmaxf(minter, mi), e1 = __expf(mi - mt), e2 = __expf(minter - mt);
                const float den = e1 * as[r] + e2 * dn[r]; const float inv = __builtin_amdgcn_rcpf(fmaxf(fabsf(den), __expf(-mt)));
                const int row = seqrow_cm(n * 64 + 16 * it + 4 * q + r, d, b);
#pragma unroll
                for (int v2 = 0; v2 < 2; ++v2) outc[(size_t)row * 256 + h * 64 + 16 * (2 * vtp + v2) + l15] = (bf16)f2bf1((e1 * Aacc[v2][r] + e2 * R[v2][r]) * inv);
            }
        }
        {
            const LAS bf16* kr = KTw + (16 * it + l15) * MP + 4 * q;
            const fragb kt0 = ld_frag8x2(kr, kr + 16), kt1 = ld_frag8x2(kr + 32, kr + 48);
            const float bL = vec[128 + 63], mloc = bL + vec[64 + 63];
            const float mnew = fmaxf(bL + m, mloc), wp = __expf(bL + m - mnew), wn = __expf(mloc - mnew);
            f32x4 gk = mfma16(kt0, ones, z4); gk = mfma16(kt1, ones, gk);
            nst = nst * wp + gk * wn;
#pragma unroll
            for (int v2 = 0; v2 < 2; ++v2) {
                f32x4 G = mfma16(kt0, Vf[v2][0], z4); G = mfma16(kt1, Vf[v2][1], G);
                Cst[v2] = Cst[v2] * wp + G * wn;
                v2u o; o.x = pk2(Cst[v2].x, Cst[v2].y); o.y = pk2(Cst[v2].z, Cst[v2].w);
                *(LAS v2u*)(CTn + (16 * (2 * vtp + v2) + l15) * MP + 16 * it + 4 * q) = o;
            }
            if (vtp == 0 && l15 == 0) { v2u o; o.x = pk2(nst.x, nst.y); o.y = pk2(nst.z, nst.w); *(LAS v2u*)(CTn + 64 * MP + 16 * it + 4 * q) = o; }
            m = mnew;
        }
        if (n + 1 < NCH) { images((n + 1) & 1); if (n + 2 < NCH) gload(n + 2); }
    }
    __syncthreads();
}
__device__ __forceinline__ int fwd_row_cm(int b, int c, int t) { return c < 4 ? (T_LAT + b * CTXL + c * 64 + t) : (b * SEQ + t * 64 + (c - 4)); }
__device__ __forceinline__ bf16* blob_row(const Ctx& C, int d, int isw, int b, int c, int h, int r) {
    const int row = fwd_row_cm(b, c, r);
    if (d == 1 && isw) return WSP(bf16, WS_OUTD) + ((size_t)T_ALL + row) * 256 + h * 64;
    return WSP(bf16, WS_P) + (size_t)row * PLD + OFF_D + (d * 2 + isw) * 256 + h * 64;
}
constexpr int LP = 68;
__device__ __forceinline__ void blocked_solve(const LAS bf16* Ln, const LAS bf16* TinvP, LAS unsigned char* XTw, f32x4 (&acc)[4][4], int l15, int q) {
    const f32x4 z4 = (f32x4){0.f, 0.f, 0.f, 0.f};
#pragma unroll
    for (int I = 0; I < 4; ++I) {
        const fragb Af = *(const LAS fragb*)(TinvP + (I * 16 + l15) * 32 + 8 * q);
        fragb A0, A1;
        if (I >= 1) A0 = ld_frag16(Ln + (16 * I + l15) * MP + 8 * q);
        if (I == 3) A1 = ld_frag16(Ln + (16 * I + l15) * MP + 32 + 8 * q);
#pragma unroll
        for (int nt = 0; nt < 4; ++nt) {
            const int crow = 16 * nt + l15; LAS unsigned char* xr = XTw + crow * 128;
            f32x4 a = acc[I][nt];
            if (I >= 1) a = mfma16(A0, *(const LAS fragb*)(xr + ((q ^ (crow & 7)) << 4)), a);
            if (I == 3) a = mfma16(A1, *(const LAS fragb*)(xr + (((4 + q) ^ (crow & 7)) << 4)), a);
            v4u bw; bw.x = pk2(a.x, a.y); bw.y = pk2(a.z, a.w); bw.z = 0u; bw.w = 0u;
            const f32x4 x = mfma16(Af, __builtin_bit_cast(fragb, bw), z4);
            acc[I][nt] = x;
            v2u o; o.x = pk2(x.x, x.y); o.y = pk2(x.z, x.w);
            *(LAS v2u*)(xr + (((2 * I + (q >> 1)) ^ (crow & 7)) << 4) + (q & 1) * 8) = o;
        }
    }
}
__device__ __forceinline__ void diag_inverses(const LAS bf16* Ln, LAS bf16* TinvP, int lane) {
    const int blk = lane >> 4, c = lane & 15;
    float x[16];
#pragma unroll
    for (int i = 0; i < 16; ++i) {
        const LAS bf16* lr = Ln + (16 * blk + i) * MP + 16 * blk;
        const v4u r0 = *(const LAS v4u*)lr, r1 = *(const LAS v4u*)(lr + 8);
        const unsigned rw[8] = {r0.x, r0.y, r0.z, r0.w, r1.x, r1.y, r1.z, r1.w};
        float s = (i == c) ? 1.0f : 0.0f;
#pragma unroll
        for (int j = 0; j < i; ++j) s += ((j & 1) ? bfhi(rw[j >> 1]) : bflo(rw[j >> 1])) * x[j];
        x[i] = s;
        TinvP[(blk * 16 + i) * 32 + 8 * (c >> 2) + (c & 3)] = (bf16)f2bf1(s);
    }
}
__device__ __forceinline__ void gdn_solve_item(const Ctx& C, int l, int item) {
    const int lane = C.lane, w = C.wave, pw = w & 1, pi = w >> 1, l15 = lane & 15, q = lane >> 4;
    LAS unsigned char* B0 = C.lds + pi * 31744;
    LAS bf16* Ln = (LAS bf16*)B0;
    LAS bf16* TinvP = (LAS bf16*)(B0 + 9216);
    LAS float* vec = (LAS float*)(B0 + 13312);
    LAS unsigned char* XT = B0 + 13824;
    LAS bf16* Ks = (LAS bf16*)XT;
    const bf16* P = WSP(const bf16, WS_P); const bf16* gq = WSP(const bf16, WS_GQ);
    const int u = item >> 1, d = item & 1;
    const int c = u % NCH, h = (u / NCH) & 3, b = u / (NCH * NH);
    const int n = d ? (c < 4 ? 3 - c : 71 - c) : c;
    const float aexp = __expf(C.in[I_GALOG][(l * 2 + d) * NH + h]), dtb = C.in[I_GDTB][(l * 2 + d) * NH + h];
    const int rowl = seqrow_cm(n * 64 + lane, d, b);
    const bf16* pg = P + (size_t)rowl * PLD + OFF_D + 1024 + d * 4 + h;
    const float la = -aexp * softplusf_(bf2f(pg[0]) + dtb), beta = sigmoidf_(bf2f(pg[8]));
    const float gam = wave_incl_sum(la, lane);
    if (pw == 0) { vec[lane] = beta; vec[64 + lane] = gam; }
#pragma unroll
    for (int r = 0; r < 4; ++r) { const int idx = pw * 64 + lane + 128 * r, t = idx >> 3, part = idx & 7;
        *(LAS v4u*)(Ks + t * MP + 8 * part) = *(const v4u*)(gq + (size_t)seqrow_cm(n * 64 + t, d, b) * 768 + 256 + h * 64 + 8 * part); }
    { LAS v4u* tz = (LAS v4u*)(B0 + 9216) + (pw * 64 + lane) * 2; tz[0] = (v4u){0u, 0u, 0u, 0u}; tz[1] = (v4u){0u, 0u, 0u, 0u}; }
    f32x4 acc[4][4];
    if (pw == 0) {
#pragma unroll
        for (int I = 0; I < 4; ++I)
#pragma unroll
            for (int r = 0; r < 4; ++r) { const bf16* vr = gq + (size_t)seqrow_cm(n * 64 + 16 * I + 4 * q + r, d, b) * 768 + 512 + h * 64 + l15;
#pragma unroll
                for (int nt = 0; nt < 4; ++nt) acc[I][nt][r] = bf2f(vr[16 * nt]); }
    }
    __syncthreads();
    {
        int tix = 0;
#pragma unroll
        for (int it = 0; it < 4; ++it)
#pragma unroll
            for (int jt = 0; jt < 4; ++jt, ++tix) if ((tix & 1) == pw) {
                f32x4 t4 = (f32x4){0.f, 0.f, 0.f, 0.f};
                if (jt <= it) {
#pragma unroll
                    for (int s = 0; s < 2; ++s) t4 = mfma16(ld_frag16(Ks + (16 * it + l15) * MP + 32 * s + 8 * q), ld_frag16(Ks + (16 * jt + l15) * MP + 32 * s + 8 * q), t4);
                    const float gj = vec[64 + 16 * jt + l15];
                    const f32x4 bi = *(const LAS f32x4*)(vec + 16 * it + 4 * q), gi = *(const LAS f32x4*)(vec + 64 + 16 * it + 4 * q);
#pragma unroll
                    for (int r = 0; r < 4; ++r) { const int i = 16 * it + 4 * q + r, j = 16 * jt + l15; t4[r] = (j < i) ? -(bi[r] * t4[r] * __expf(gi[r] - gj)) : 0.f; }
                }
#pragma unroll
                for (int r = 0; r < 4; ++r) Ln[(16 * it + 4 * q + r) * MP + 16 * jt + l15] = (bf16)f2bf1(t4[r]);
            }
    }
    {
#pragma unroll
        for (int I = 0; I < 4; ++I) {
            const f32x4 bi = *(const LAS f32x4*)(vec + 16 * I + 4 * q), gi = *(const LAS f32x4*)(vec + 64 + 16 * I + 4 * q);
#pragma unroll
            for (int r = 0; r < 4; ++r) { const float sc = pw ? bi[r] * __expf(gi[r]) : bi[r];
#pragma unroll
                for (int nt = 0; nt < 4; ++nt) acc[I][nt][r] = (pw ? bf2f(Ks[(16 * I + 4 * q + r) * MP + 16 * nt + l15]) : acc[I][nt][r]) * sc; }
        }
    }
    __syncthreads();
    if (pw == 0) diag_inverses(Ln, TinvP, lane);
    LAS unsigned char* XTw = XT + pw * 8192;
    { LAS v4u* xz = (LAS v4u*)(XTw + lane * 128);
#pragma unroll
        for (int g = 0; g < 8; ++g) xz[g] = (v4u){0u, 0u, 0u, 0u}; }
    __syncthreads();
    blocked_solve(Ln, TinvP, XTw, acc, l15, q);
    {
        bf16* dst = blob_row(C, d, pw, b, c, h, lane);
        const LAS unsigned char* xr = XTw + lane * 128;
#pragma unroll
        for (int g = 0; g < 8; ++g) *(v4u*)(dst + 8 * g) = *(const LAS v4u*)(xr + ((g ^ (lane & 7)) << 4));
    }
    __syncthreads();
}

template <bool DRY>
__device__ __forceinline__ void gdn_chunked(const Ctx& C, int l, int idx) {
    const int d = idx >> 5, b = (idx >> 2) & 7, h = idx & 3, lane = C.lane, w = C.wave, l15 = lane & 15, q = lane >> 4;
    const int it = w & 3, vtp = w >> 2;
    constexpr int IMG = 64 * MP * 2, BUFB = 5 * IMG + 512;
    LAS unsigned char* L0 = C.lds;
    LAS bf16* VnT = (LAS bf16*)(L0 + 2 * BUFB + 2 * IMG);
    const bf16* P = WSP(const bf16, WS_P); const bf16* gq = WSP(const bf16, WS_GQ); bf16* outd = WSP(bf16, WS_OUTD) + (size_t)d * T_ALL * 256;
    const float aexp = __expf(C.in[I_GALOG][(l * 2 + d) * NH + h]), dtb = C.in[I_GDTB][(l * 2 + d) * NH + h];
    const int tt = C.tid >> 3, part = C.tid & 7;
    for (int i = C.tid; i < 2 * IMG / 4; i += NTHR) ((LAS unsigned*)(L0 + 2 * BUFB))[i] = 0u;
    v4u rq, rk, ru, rw; unsigned short rga;
    auto gload = [&](int n) {
        const int c = d ? (n < 4 ? 3 - n : 71 - n) : n;
        const bf16* pp = gq + (size_t)seqrow_cm(n * 64 + tt, d, b) * 768 + h * 64 + 8 * part;
        rq = *(const v4u*)pp; rk = *(const v4u*)(pp + 256);
        ru = *(const v4u*)(blob_row(C, d, 0, b, c, h, tt) + 8 * part); rw = *(const v4u*)(blob_row(C, d, 1, b, c, h, tt) + 8 * part);
        rga = P[(size_t)seqrow_cm(n * 64 + lane, d, b) * PLD + OFF_D + 1024 + d * 4 + h];
    };
    auto images = [&](int bufi) {
        LAS unsigned char* B0 = L0 + bufi * BUFB;
        LAS bf16* Qs = (LAS bf16*)B0; LAS bf16* Ks = Qs + 64 * MP; LAS bf16* KdT = Ks + 64 * MP; LAS bf16* Wi = KdT + 64 * MP; LAS bf16* UT = Wi + 64 * MP; LAS float* vec = (LAS float*)(B0 + 5 * IMG);
        const float la = -aexp * softplusf_(bf2f(rga) + dtb);
        const float gam = wave_incl_sum(la, lane);
        if (w == 0) vec[lane] = gam;
        const float kd = __expf(__shfl(gam, 63) - gam);
        const float kmine = __shfl(kd, 8 * w + (lane >> 3));
        *(LAS v4u*)(Qs + tt * MP + 8 * part) = rq; *(LAS v4u*)(Ks + tt * MP + 8 * part) = rk; *(LAS v4u*)(UT + tt * MP + 8 * part) = ru;
        const unsigned kk[4] = {rk.x, rk.y, rk.z, rk.w}, ww[4] = {rw.x, rw.y, rw.z, rw.w};
#pragma unroll
        for (int e = 0; e < 4; ++e) {
            KdT[(8 * part + 2 * e) * MP + tt] = (bf16)f2bf1(bflo(kk[e]) * kmine); KdT[(8 * part + 2 * e + 1) * MP + tt] = (bf16)f2bf1(bfhi(kk[e]) * kmine);
            Wi[(8 * part + 2 * e) * MP + tt] = (bf16)(ww[e] & 0xffffu); Wi[(8 * part + 2 * e + 1) * MP + tt] = (bf16)(ww[e] >> 16);
        }
    };
    f32x4 Sst[2]; Sst[0] = Sst[1] = (f32x4){0.f, 0.f, 0.f, 0.f};
    const f32x4 z4 = (f32x4){0.f, 0.f, 0.f, 0.f};
    gload(0); images(0); gload(1);
#pragma unroll 1
    for (int n = 0; n < NCH; ++n) {
        RAW_BARRIER();
        const LAS unsigned char* B0 = L0 + (n & 1) * BUFB;
        const LAS bf16* Qs = (const LAS bf16*)B0; const LAS bf16* Ks = Qs + 64 * MP; const LAS bf16* KdT = Ks + 64 * MP; const LAS bf16* Wi = KdT + 64 * MP; const LAS bf16* UT = Wi + 64 * MP; const LAS float* vec = (const LAS float*)(B0 + 5 * IMG);
        const LAS bf16* ST = (const LAS bf16*)(L0 + 2 * BUFB + (n & 1) * IMG); LAS bf16* STn = (LAS bf16*)(L0 + 2 * BUFB + ((n + 1) & 1) * IMG);
        fragb Qf[2]; Qf[0] = ld_frag16(Qs + (16 * it + l15) * MP + 8 * q); Qf[1] = ld_frag16(Qs + (16 * it + l15) * MP + 32 + 8 * q);
        const float gcol = vec[16 * it + l15]; const int icol = 16 * it + l15;
        f32x4 pt[4];
#pragma unroll
        for (int jt = 0; jt < 4; ++jt) {
            pt[jt] = z4;
            if (jt <= it) {
                const fragb k0 = ld_frag16(Ks + (16 * jt + l15) * MP + 8 * q), k1 = ld_frag16(Ks + (16 * jt + l15) * MP + 32 + 8 * q);
                f32x4 st = mfma16(k0, Qf[0], z4); st = mfma16(k1, Qf[1], st);
                const f32x4 gj = *(const LAS f32x4*)(vec + 16 * jt + 4 * q);
#pragma unroll
                for (int r = 0; r < 4; ++r) { const int j = 16 * jt + 4 * q + r; pt[jt][r] = (j <= icol) ? st[r] * __expf(gcol - gj[r]) : 0.f; }
            }
        }
        fragb Pf[2]; Pf[0] = pack_frag(pt[0], pt[1]); Pf[1] = pack_frag(pt[2], pt[3]);
        const fragb Wf0 = ld_frag16(Wi + (16 * it + l15) * MP + 8 * q), Wf1 = ld_frag16(Wi + (16 * it + l15) * MP + 32 + 8 * q);
        f32x4 Ro[2];
#pragma unroll
        for (int v2 = 0; v2 < 2; ++v2) {
            const int vrow = 16 * (2 * vtp + v2) + l15;
            const fragb s0 = ld_frag16(ST + vrow * MP + 8 * q), s1 = ld_frag16(ST + vrow * MP + 32 + 8 * q);
            f32x4 ws = mfma16(Wf0, s0, z4); ws = mfma16(Wf1, s1, ws);
            Ro[v2] = mfma16(Qf[0], s0, z4); Ro[v2] = mfma16(Qf[1], s1, Ro[v2]);
            const v2u ur = *(const LAS v2u*)(UT + vrow * MP + 16 * it + 4 * q);
            v2u o; o.x = pk2(bflo(ur.x) - ws.x, bfhi(ur.x) - ws.y); o.y = pk2(bflo(ur.y) - ws.z, bfhi(ur.y) - ws.w);
            *(LAS v2u*)(VnT + vrow * MP + 16 * it + 4 * q) = o;
        }
        RAW_BARRIER();
        {
            const f32x4 gi = *(const LAS f32x4*)(vec + 16 * it + 4 * q);
            const float gl = __expf(vec[63]);
            const LAS bf16* kr = KdT + (16 * it + l15) * MP + 4 * q;
            const fragb kt0 = ld_frag8x2(kr, kr + 16), kt1 = ld_frag8x2(kr + 32, kr + 48);
#pragma unroll
            for (int v2 = 0; v2 < 2; ++v2) {
                const int vrow = 16 * (2 * vtp + v2) + l15;
                const LAS bf16* vr = VnT + vrow * MP + 4 * q;
                const fragb n0 = ld_frag8x2(vr, vr + 16), n1 = ld_frag8x2(vr + 32, vr + 48);
                f32x4 o = mfma16(Pf[0], n0, z4); if (it >= 2) o = mfma16(Pf[1], n1, o);
#pragma unroll
                for (int r = 0; r < 4; ++r) { const int row = seqrow_cm(n * 64 + 16 * it + 4 * q + r, d, b);
                    if (!DRY) outd[(size_t)row * 256 + h * 64 + vrow] = (bf16)f2bf1(o[r] + __expf(gi[r]) * Ro[v2][r]); }
                f32x4 ns = mfma16(kt0, n0, z4); ns = mfma16(kt1, n1, ns);
                Sst[v2] = Sst[v2] * gl + ns;
                v2u so; so.x = pk2(Sst[v2].x, Sst[v2].y); so.y = pk2(Sst[v2].z, Sst[v2].w);
                *(LAS v2u*)(STn + vrow * MP + 16 * it + 4 * q) = so;
            }
        }
        if (n + 1 < NCH) { images((n + 1) & 1); if (n + 2 < NCH) gload(n + 2); }
    }
    __syncthreads();
}
constexpr int UP = 264;
template <int CTRL> __device__ __forceinline__ float dpp_keep(float oldv, float v) { return __builtin_bit_cast(float, __builtin_amdgcn_update_dpp(__builtin_bit_cast(int, oldv), __builtin_bit_cast(int, v), CTRL, 0xF, 0xF, false)); }
template <bool REV> __device__ __forceinline__ void scan16(float& A, float& B) {
#define LRU_STEP(S) { const float Ap = dpp_keep<(REV ? 0x100 : 0x110) | S>(1.0f, A), Bp = dpp_keep<(REV ? 0x100 : 0x110) | S>(0.0f, B); B = A * Bp + B; A = A * Ap; }
    LRU_STEP(1) LRU_STEP(2) LRU_STEP(4) LRU_STEP(8)
#undef LRU_STEP
}
constexpr int UPC = 72;
__device__ __forceinline__ int lru_chunk_of(int d, int k) { return d ? (k < 4 ? 3 - k : NCH + 3 - k) : k; }
template <bool REV>
__device__ __forceinline__ void lru_tiles(const LAS bf16* Ud, int th, int mt, int lane, const fragb (&Wa)[2], const fragb (&Wx)[2], const f32x4& ba, const f32x4& bx, const f32x4& sp4,
                                          f32x4 (&Ac)[2], f32x4 (&Hl)[2], f32x4& Atot, f32x4& hend) {
    const int l15 = lane & 15, q = lane >> 4, edge = (lane & 48) | (REV ? 0 : 15);
    const f32x4 z4 = (f32x4){0.f, 0.f, 0.f, 0.f};
    f32x4 tA = z4, tB = z4;
#pragma unroll
    for (int i = 0; i < 2; ++i) {
        const int nt = REV ? 3 - (2 * th + i) : 2 * th + i;
        const LAS bf16* urow = Ud + (16 * nt + l15) * UPC;
        const fragb Uf0 = ld_frag16(urow + 8 * q), Uf1 = ld_frag16(urow + 32 + 8 * q);
        f32x4 aa = mfma16(Wa[0], Uf0, z4); aa = mfma16(Wa[1], Uf1, aa);
        f32x4 ax = mfma16(Wx[0], Uf0, z4); ax = mfma16(Wx[1], Uf1, ax);
        const v2u ur = *(const LAS v2u*)(urow + 16 * mt + 4 * q);
        const f32x4 u4 = (f32x4){bflo(ur.x), bfhi(ur.x), bflo(ur.y), bfhi(ur.y)};
        f32x4 la, iu, A, Bv;
#pragma unroll
        for (int r = 0; r < 4; ++r) { const float rg = sigmoidf_(aa[r] + ba[r]); iu[r] = sigmoidf_(ax[r] + bx[r]) * u4[r]; la[r] = -sp4[r] * rg; }
        const bool sm_ = la[0] > -0.15f && la[1] > -0.15f && la[2] > -0.15f && la[3] > -0.15f;
        if (__builtin_amdgcn_ballot_w64(!sm_) == 0ull) {
#pragma unroll
            for (int r = 0; r < 4; ++r) { const float x = la[r], p = x * (1.0f + x * (0.5f + x * (0.16666667f + x * (0.041666668f + x * (0.0083333338f + x * 0.0013888889f)))));
                A[r] = 1.0f + p; Bv[r] = __builtin_amdgcn_sqrtf(-p * (2.0f + p)) * iu[r]; }
        } else {
#pragma unroll
            for (int r = 0; r < 4; ++r) { A[r] = __expf(la[r]); Bv[r] = __builtin_amdgcn_sqrtf(-expm1f_(2.0f * la[r])) * iu[r]; }
        }
#pragma unroll
        for (int r = 0; r < 4; ++r) { float a_ = A[r], b_ = Bv[r]; scan16<REV>(a_, b_); A[r] = a_; Bv[r] = b_; }
        if (i == 0) {
            Ac[0] = A; Hl[0] = Bv;
#pragma unroll
            for (int r = 0; r < 4; ++r) { tA[r] = __shfl(A[r], edge); tB[r] = __shfl(Bv[r], edge); }
        } else {
            Ac[1] = A * tA; Hl[1] = A * tB + Bv;
#pragma unroll
            for (int r = 0; r < 4; ++r) { Atot[r] = __shfl(Ac[1][r], edge); hend[r] = __shfl(Hl[1][r], edge); }
        }
    }
}
__device__ __forceinline__ void lru_chain(const Ctx& C, int l, int id) {
    const int b = id >> 3, hd = (id >> 1) & 3, chalf = id & 1;
    const int lane = C.lane, l15 = lane & 15, q = lane >> 4;
    const int d = C.wave >> 2, mtl = (C.wave >> 1) & 1, th = C.wave & 1, mt = chalf * 2 + mtl;
    LAS bf16* U = (LAS bf16*)C.lds;
    LAS float* XCH = (LAS float*)(C.lds + 2 * 2 * 64 * UPC * 2);
    bf16* P = WSP(bf16, WS_P); bf16* LH = WSP(bf16, WS_LRUH) + (size_t)id * NSTEP * 32;
    const int cd = C.tid >> 8, cj = C.tid & 63, ctq = (C.tid >> 6) & 3;
    const float* cw = C.in[I_LCW] + (size_t)l * 4 * GW + hd * 64 + cj; const float w0 = cw[0], w1 = cw[GW], w2 = cw[2 * GW], w3 = cw[3 * GW], cb = C.in[I_LCB][l * GW + hd * 64 + cj];
    const bf16* wt = WSP(const bf16, WS_LRUWT) + (size_t)((d * 2 + 0) * 4 + hd) * 4096;
    fragb Wa[2], Wx[2];
#pragma unroll
    for (int ks = 0; ks < 2; ++ks) { Wa[ks] = *(const fragb*)(wt + (16 * mt + l15) * 64 + 32 * ks + 8 * q); Wx[ks] = *(const fragb*)(wt + 4 * 4096 + (16 * mt + l15) * 64 + 32 * ks + 8 * q); }
    const int ch0 = hd * 64 + 16 * mt + 4 * q;
    const f32x4 ba = *(const f32x4*)(C.in[I_LBA] + (l * 2 + d) * GW + ch0), bx = *(const f32x4*)(C.in[I_LBX] + (l * 2 + d) * GW + ch0), lam = *(const f32x4*)(C.in[I_LLAM] + (l * 2 + d) * GW + ch0);
    f32x4 sp4;
#pragma unroll
    for (int r = 0; r < 4; ++r) sp4[r] = 8.0f * softplusf_(-lam[r]);
    f32x4 s = (f32x4){0.f, 0.f, 0.f, 0.f};
    unsigned short xr[19];
#define LRU_LOADX(kk) do { const int c_ = lru_chunk_of(cd, (kk)); const bool ic_ = c_ < 4; const int p0_ = (ic_ ? c_ * 64 : (c_ - 4) * 64) + ctq * 16 - 2, Lp_ = ic_ ? CTXL : SEQ; \
        const bf16* xp_ = P + (size_t)(ic_ ? T_LAT + b * CTXL : b * SEQ) * PLD + hd * 64 + cj; \
        _Pragma("unroll") for (int i_ = 0; i_ < 19; ++i_) { const int p_ = p0_ + i_; xr[i_] = (p_ >= 0 && p_ < Lp_) ? xp_[(size_t)p_ * PLD] : (unsigned short)0; } } while (0)
#define LRU_CONV(kk) do { LAS bf16* uo_ = U + ((((kk) & 1) * 2 + cd) * 64 + ctq * 16) * UPC + cj; \
        _Pragma("unroll") for (int t_ = 0; t_ < 16; ++t_) uo_[t_ * UPC] = (bf16)f2bf1(w0 * bf2f(xr[t_]) + w1 * bf2f(xr[t_ + 1]) + w2 * bf2f(xr[t_ + 2]) + w3 * bf2f(xr[t_ + 3]) + cb); } while (0)
    LRU_LOADX(0); LRU_CONV(0); LRU_LOADX(1);
    __syncthreads();
#pragma unroll 1
    for (int k = 0; k < NCH; ++k) {
        if (k + 1 < NCH) { LRU_CONV(k + 1); if (k + 2 < NCH) LRU_LOADX(k + 2); }
        const int c = lru_chunk_of(d, k); const bool second = lru_chunk_of(1 - d, c) < k;
        const bool ic = c < 4; const size_t row0 = (size_t)(ic ? T_LAT + b * CTXL + c * 64 : b * SEQ + (c - 4) * 64);
        const bool late = (k == 2) || (k == 36);
        int tok[2]; v2u gv[2], fv[2];
#pragma unroll
        for (int i = 0; i < 2; ++i) { const int nt = d ? 3 - (2 * th + i) : 2 * th + i; tok[i] = 16 * nt + l15;
            if (second && !late) { gv[i] = *(const v2u*)(P + (row0 + tok[i]) * PLD + 256 + ch0); fv[i] = *(const v2u*)(LH + (size_t)(c * 64 + tok[i]) * 32 + 16 * mtl + 4 * q); } }
        f32x4 Ac[2], Hl[2], Atot, hend;
        const LAS bf16* Ud = U + ((k & 1) * 2 + d) * 64 * UPC;
        if (d) lru_tiles<true>(Ud, th, mt, lane, Wa, Wx, ba, bx, sp4, Ac, Hl, Atot, hend); else lru_tiles<false>(Ud, th, mt, lane, Wa, Wx, ba, bx, sp4, Ac, Hl, Atot, hend);
        LAS float* xw = XCH + (((((k & 1) * 2 + d) * 2 + mtl) * 2 + th) * 4 + q) * 8;
        if (l15 == (d ? 0 : 15)) { *(LAS f32x4*)xw = Atot; *(LAS f32x4*)(xw + 4) = hend; }
        if (late) VM_WAIT();
        RAW_BARRIER();
        if (second && late) {
#pragma unroll
            for (int i = 0; i < 2; ++i) { gv[i] = *(const v2u*)(P + (row0 + tok[i]) * PLD + 256 + ch0); fv[i] = *(const v2u*)(LH + (size_t)(c * 64 + tok[i]) * 32 + 16 * mtl + 4 * q); }
        }
        const LAS float* xr0 = XCH + (((((k & 1) * 2 + d) * 2 + mtl) * 2 + 0) * 4 + q) * 8;
        const f32x4 A0 = *(const LAS f32x4*)xr0, h0 = *(const LAS f32x4*)(xr0 + 4), A1 = *(const LAS f32x4*)(xr0 + 32), h1 = *(const LAS f32x4*)(xr0 + 36);
        const f32x4 mid = A0 * s + h0, hin = th ? mid : s;
        s = A1 * mid + h1;
#pragma unroll
        for (int i = 0; i < 2; ++i) {
            const f32x4 h = Ac[i] * hin + Hl[i];
            if (!second) { v2u o; o.x = pk2(h.x, h.y); o.y = pk2(h.z, h.w); *(v2u*)(LH + (size_t)(c * 64 + tok[i]) * 32 + 16 * mtl + 4 * q) = o; }
            else {
                const f32x4 g = (f32x4){bflo(gv[i].x), bfhi(gv[i].x), bflo(gv[i].y), bfhi(gv[i].y)};
                f32x4 y = (f32x4){h.x + bflo(fv[i].x), h.y + bfhi(fv[i].x), h.z + bflo(fv[i].y), h.w + bfhi(fv[i].y)};
                y.x *= gelu_tanh(g.x); y.y *= gelu_tanh(g.y); y.z *= gelu_tanh(g.z); y.w *= gelu_tanh(g.w);
                st4bf(P + (row0 + tok[i]) * PLD + 256 + ch0, y);
            }
        }
    }
#undef LRU_LOADX
#undef LRU_CONV
    __syncthreads();
}
constexpr int RP = 264;
__device__ __forceinline__ void rwkv_prep2(const Ctx& C, int l, int b, int c) {
    LAS bf16* RS = (LAS bf16*)C.lds;
    LAS bf16* KS = RS + 64 * RP;
    LAS bf16* XW = KS + 64 * RP;
    LAS bf16* XA = XW + 64 * MP;
    LAS bf16* XG = XA + 64 * MP;
    const bf16* P = WSP(const bf16, WS_P);
    const bool isctx = c < 4; const int p0 = isctx ? c * 64 : (c - 4) * 64; const int Lp = isctx ? CTXL : SEQ; const int row0 = isctx ? T_LAT + b * CTXL : b * SEQ;
    const float* mu = C.in[I_RMU] + (size_t)l * 2 * B_COLS;
    bf16* rkv = WSP(bf16, WS_RKV);
#pragma unroll 5
    for (int it = C.tid; it < 64 * 120; it += NTHR) {
        const int t = it / 120, c8 = (it % 120) * 8, p = p0 + t;
        const bf16* pp = P + (size_t)(row0 + p) * PLD + OFF_B + c8;
        const v4u xc = *(const v4u*)pp; v4u xp = (v4u){0u, 0u, 0u, 0u}, xn = xp;
        if (p > 0) xp = *(const v4u*)(pp - PLD);
        if (p < Lp - 1) xn = *(const v4u*)(pp + PLD);
        const f32x4 m0a = *(const f32x4*)(mu + c8), m0b = *(const f32x4*)(mu + c8 + 4), m1a = *(const f32x4*)(mu + B_COLS + c8), m1b = *(const f32x4*)(mu + B_COLS + c8 + 4);
        const unsigned xcw[4] = {xc.x, xc.y, xc.z, xc.w}, xpw[4] = {xp.x, xp.y, xp.z, xp.w}, xnw[4] = {xn.x, xn.y, xn.z, xn.w};
        float sh[8];
#pragma unroll
        for (int e = 0; e < 4; ++e) {
            const float x0 = bflo(xcw[e]), x1 = bfhi(xcw[e]);
            const float mu0_0 = e < 2 ? m0a[2 * e] : m0b[2 * e - 4], mu0_1 = e < 2 ? m0a[2 * e + 1] : m0b[2 * e - 3], mu1_0 = e < 2 ? m1a[2 * e] : m1b[2 * e - 4], mu1_1 = e < 2 ? m1a[2 * e + 1] : m1b[2 * e - 3];
            sh[2 * e] = x0 + mu0_0 * (bflo(xpw[e]) - x0) + mu1_0 * (bflo(xnw[e]) - x0);
            sh[2 * e + 1] = x1 + mu0_1 * (bfhi(xpw[e]) - x1) + mu1_1 * (bfhi(xnw[e]) - x1);
        }
        if (c8 >= 768) {
            const int ci = c8 - 768;
            if (ci < 64) {
#pragma unroll
                for (int e = 0; e < 8; ++e) sh[e] = tanhf_(sh[e]); }
            else if (ci >= 128) {
#pragma unroll
                for (int e = 0; e < 8; ++e) sh[e] = sigmoidf_(sh[e]); }
        }
        v4u o; o.x = pk2(sh[0], sh[1]); o.y = pk2(sh[2], sh[3]); o.z = pk2(sh[4], sh[5]); o.w = pk2(sh[6], sh[7]);
        if (c8 < 768) {
            *(v4u*)(rkv + (size_t)(row0 + p) * 768 + c8) = o;
            if (c8 < 256) *(LAS v4u*)(RS + t * RP + c8) = o; else if (c8 < 512) *(LAS v4u*)(KS + t * RP + c8 - 256) = o;
        } else {
            const int ci = c8 - 768;
            LAS bf16* dst = ci < 64 ? XW + t * MP + ci : (ci < 128 ? XA + t * MP + ci - 64 : XG + t * MP + ci - 128);
            *(LAS v4u*)dst = o;
        }
    }
    __syncthreads();
    const int lane = C.lane, w = C.wave, l15 = lane & 15, q = lane >> 4, hd = w & 3, ntp = w >> 2;
    const bf16* wt = WSP(const bf16, WS_RWT);
    bf16* wa_out = WSP(bf16, WS_HB); bf16* g_out = WSP(bf16, WS_G); float* bonus = WSP(float, WS_BONUS); float* rinv = WSP(float, WS_RINV);
    const f32x4 z4 = (f32x4){0.f, 0.f, 0.f, 0.f};
    float bsum[2] = {0.f, 0.f}, ksum[2] = {0.f, 0.f};
#pragma unroll
    for (int n2 = 0; n2 < 2; ++n2) {
        const int tok = 16 * (2 * ntp + n2) + l15; const size_t row = (size_t)(row0 + p0 + tok);
        const fragb xw0 = ld_frag16(XW + tok * MP + 8 * q), xw1 = ld_frag16(XW + tok * MP + 32 + 8 * q), xa0 = ld_frag16(XA + tok * MP + 8 * q), xa1 = ld_frag16(XA + tok * MP + 32 + 8 * q);
        const fragb xg0 = ld_frag16(XG + tok * MP + 8 * q), xg1 = ld_frag16(XG + tok * MP + 32 + 8 * q);
        unsigned ow0[8], ow1[8], oa0[8], oa1[8], og[8];
#pragma unroll
        for (int mt = 0; mt < 4; ++mt) {
            const int chl = 16 * (l15 >> 2) + 4 * mt + (l15 & 3), ch4 = hd * 64 + 16 * q + 4 * mt;
            const bf16* wrow = wt + (size_t)(hd * 64 + chl) * 32 + 8 * q;
            const bf16* grow = wt + 4 * 256 * 32 + (size_t)(hd * 64 + chl) * 64 + 8 * q;
            const fragb fw0 = *(const fragb*)(wrow), fw1 = *(const fragb*)(wrow + 256 * 32), fa0 = *(const fragb*)(wrow + 2 * 256 * 32), fa1 = *(const fragb*)(wrow + 3 * 256 * 32), fg0 = *(const fragb*)(grow), fg1 = *(const fragb*)(grow + 32);
            const f32x4 w00 = *(const f32x4*)(C.in[I_RW0] + (l * 2 + 0) * GW + ch4), w01 = *(const f32x4*)(C.in[I_RW0] + (l * 2 + 1) * GW + ch4);
            const f32x4 a00 = *(const f32x4*)(C.in[I_RA0] + (l * 2 + 0) * GW + ch4), a01 = *(const f32x4*)(C.in[I_RA0] + (l * 2 + 1) * GW + ch4);
            const f32x4 k_a = *(const f32x4*)(C.in[I_RKA] + l * GW + ch4), r_k = *(const f32x4*)(C.in[I_RRK] + l * GW + ch4), k_k = *(const f32x4*)(C.in[I_RKK] + l * GW + ch4);
            const f32x4 aw0 = mfma16(fw0, xw0, z4), aw1 = mfma16(fw1, xw1, z4), aa0 = mfma16(fa0, xa0, z4), aa1 = mfma16(fa1, xa1, z4);
            f32x4 ag = mfma16(fg0, xg0, z4); ag = mfma16(fg1, xg1, ag);
            f32x4 wv0, wv1, av0, av1;
#pragma unroll
            for (int r = 0; r < 4; ++r) {
                wv0[r] = __expf(-0.6065306597126334f * sigmoidf_(aw0[r] + w00[r])); wv1[r] = __expf(-0.6065306597126334f * sigmoidf_(aw1[r] + w01[r]));
                av0[r] = sigmoidf_(aa0[r] + a00[r]); av1[r] = sigmoidf_(aa1[r] + a01[r]);
            }
            ow0[2 * mt] = pk2(wv0[0], wv0[1]); ow0[2 * mt + 1] = pk2(wv0[2], wv0[3]); ow1[2 * mt] = pk2(wv1[0], wv1[1]); ow1[2 * mt + 1] = pk2(wv1[2], wv1[3]);
            oa0[2 * mt] = pk2(av0[0], av0[1]); oa0[2 * mt + 1] = pk2(av0[2], av0[3]); oa1[2 * mt] = pk2(av1[0], av1[1]); oa1[2 * mt + 1] = pk2(av1[2], av1[3]);
            og[2 * mt] = pk2(ag[0], ag[1]); og[2 * mt + 1] = pk2(ag[2], ag[3]);
            const v2u rr_ = *(const LAS v2u*)(RS + tok * RP + ch4), kr_ = *(const LAS v2u*)(KS + tok * RP + ch4);
            const f32x4 rs = (f32x4){bflo(rr_.x), bfhi(rr_.x), bflo(rr_.y), bfhi(rr_.y)}, ks = (f32x4){bflo(kr_.x), bfhi(kr_.x), bflo(kr_.y), bfhi(kr_.y)};
#pragma unroll
            for (int r = 0; r < 4; ++r) {
                const float km = ks[r] * (1.0f + (av0[r] - 1.0f) * k_a[r]) + ks[r] * (1.0f + (av1[r] - 1.0f) * k_a[r]);
                bsum[n2] += rs[r] * r_k[r] * km; const float kk = ks[r] * k_k[r]; ksum[n2] += kk * kk;
            }
        }
        bf16* wrow_o = wa_out + row * 1024 + hd * 64 + 16 * q;
        *(v4u*)(wrow_o) = (v4u){ow0[0], ow0[1], ow0[2], ow0[3]}; *(v4u*)(wrow_o + 8) = (v4u){ow0[4], ow0[5], ow0[6], ow0[7]};
        *(v4u*)(wrow_o + 256) = (v4u){ow1[0], ow1[1], ow1[2], ow1[3]}; *(v4u*)(wrow_o + 256 + 8) = (v4u){ow1[4], ow1[5], ow1[6], ow1[7]};
        *(v4u*)(wrow_o + 512) = (v4u){oa0[0], oa0[1], oa0[2], oa0[3]}; *(v4u*)(wrow_o + 512 + 8) = (v4u){oa0[4], oa0[5], oa0[6], oa0[7]};
        *(v4u*)(wrow_o + 768) = (v4u){oa1[0], oa1[1], oa1[2], oa1[3]}; *(v4u*)(wrow_o + 768 + 8) = (v4u){oa1[4], oa1[5], oa1[6], oa1[7]};
        bf16* grow_o = g_out + row * 256 + hd * 64 + 16 * q;
        *(v4u*)(grow_o) = (v4u){og[0], og[1], og[2], og[3]}; *(v4u*)(grow_o + 8) = (v4u){og[4], og[5], og[6], og[7]};
    }
#pragma unroll
    for (int n2 = 0; n2 < 2; ++n2) {
        const size_t row = (size_t)(row0 + p0 + 16 * (2 * ntp + n2) + l15);
        float bs = bsum[n2], ks2 = ksum[n2];
        bs += __shfl_xor(bs, 16); bs += __shfl_xor(bs, 32); ks2 += __shfl_xor(ks2, 16); ks2 += __shfl_xor(ks2, 32);
        if (q == 0) { bonus[row * 4 + hd] = bs; rinv[row * 4 + hd] = rsqrtf_(ks2 + 1e-6f); }
    }
    __syncthreads();
}
__device__ __forceinline__ int fwd_row_r(int b, int c, int t) { return c < 4 ? (T_LAT + b * CTXL + c * 64 + t) : (b * SEQ + (c - 4) * 64 + t); }
__device__ __forceinline__ bf16* rw_blob_row(const Ctx& C, int d, int which, int b, int c, int h, int r) {
    const int row = fwd_row_r(b, c, r);
#if RW_VSPLIT
    if (which == 0) { if (d) return WSP(bf16, WS_GQ) + (size_t)row * 768 + 512 + h * 64;
                      return WSP(bf16, WS_P) + (size_t)row * PLD + OFF_B + 512 + h * 64; }
#else
    if (which == 0) return WSP(bf16, WS_OUTB) + ((size_t)d * T_ALL + row) * 256 + h * 64;
#endif
    return WSP(bf16, WS_P) + (size_t)row * PLD + OFF_B + d * 256 + h * 64;
}
__device__ __forceinline__ void rwkv_solve_item(const Ctx& C, int l, int item) {
    const int lane = C.lane, w = C.wave, pw = w & 1, pi = w >> 1, l15 = lane & 15, q = lane >> 4;
    LAS unsigned char* B0 = C.lds + pi * 31744;
    LAS bf16* Kk = (LAS bf16*)B0; LAS bf16* Bh = Kk + 64 * MP; LAS bf16* Kh = Bh + 64 * MP;
    LAS bf16* Ln = (LAS bf16*)B0;
    LAS bf16* Lk16 = (LAS bf16*)(B0 + 9216);
    LAS unsigned char* XT = B0 + 9216;
    LAS bf16* TinvP = (LAS bf16*)(B0 + 25600);
    const bf16* WA = WSP(const bf16, WS_HB); bf16* WAw = WSP(bf16, WS_HB); const bf16* rkv = WSP(const bf16, WS_RKV); const float* rinv = WSP(const float, WS_RINV);
    const int u = item >> 1, d = item & 1;
    const int c = u % NCH, h = (u / NCH) & 3, b = u / (NCH * NH);
    const float k_k = C.in[I_RKK][l * GW + h * 64 + lane], k_a = C.in[I_RKA][l * GW + h * 64 + lane];
    const int n = d ? (c < 4 ? 3 - c : 71 - c) : c;
    const float ril = rinv[(size_t)seqrow_raster(n * 64 + lane, d, b) * 4 + h];
#pragma unroll
    for (int r = 0; r < 4; ++r) { const int idx2 = pw * 64 + lane + 128 * r, t = idx2 >> 3, part = idx2 & 7; const int row = seqrow_raster(n * 64 + t, d, b);
        *(LAS v4u*)(Kk + t * MP + 8 * part) = *(const v4u*)(WA + (size_t)row * 1024 + d * 256 + h * 64 + 8 * part);
        *(LAS v4u*)(Bh + t * MP + 8 * part) = *(const v4u*)(WA + (size_t)row * 1024 + (2 + d) * 256 + h * 64 + 8 * part);
        *(LAS v4u*)(Kh + t * MP + 8 * part) = *(const v4u*)(rkv + (size_t)row * 768 + 256 + h * 64 + 8 * part); }
    __syncthreads();
    {
        float cc = 1.0f;
        if (pw) {
#pragma unroll
            for (int t = 0; t < 32; ++t) cc *= bf2f(Kk[t * MP + lane]);
        }
        __syncthreads();
#pragma unroll
        for (int t2 = 0; t2 < 32; ++t2) {
            const int t = pw * 32 + t2;
            const float wv = bf2f(Kk[t * MP + lane]), av = bf2f(Bh[t * MP + lane]), ks = bf2f(Kh[t * MP + lane]);
            const float kap = ks * k_k * __shfl(ril, t);
            const float cprev = cc; cc *= wv; const float ic = __builtin_amdgcn_rcpf(cc);
            Kk[t * MP + lane] = (bf16)f2bf1(kap * cprev); Bh[t * MP + lane] = (bf16)f2bf1(kap * av * ic); Kh[t * MP + lane] = (bf16)f2bf1(ks * (1.0f + (av - 1.0f) * k_a) * ic);
            WAw[(size_t)seqrow_raster(n * 64 + t, d, b) * 1024 + d * 256 + h * 64 + lane] = (bf16)f2bf1(cc);
        }
    }
    __syncthreads();
    f32x4 acc[4][4];
    if (pw == 0) {
#pragma unroll
        for (int I = 0; I < 4; ++I)
#pragma unroll
            for (int r = 0; r < 4; ++r)
#pragma unroll
                for (int nt = 0; nt < 4; ++nt) acc[I][nt][r] = bf2f(Kk[(16 * I + 4 * q + r) * MP + 16 * nt + l15]);
    }
    f32x4 T[10];
    {
        const LAS bf16* Bsrc = pw ? Kh : Bh;
        int tix = 0;
#pragma unroll
        for (int it = 0; it < 4; ++it)
#pragma unroll
            for (int jt = 0; jt <= it; ++jt, ++tix) {
                f32x4 t4 = (f32x4){0.f, 0.f, 0.f, 0.f};
#pragma unroll
                for (int s = 0; s < 2; ++s) t4 = mfma16(ld_frag16(Kk + (16 * it + l15) * MP + 32 * s + 8 * q), ld_frag16(Bsrc + (16 * jt + l15) * MP + 32 * s + 8 * q), t4);
#pragma unroll
                for (int r = 0; r < 4; ++r) { const int i = 16 * it + 4 * q + r, j = 16 * jt + l15; T[tix][r] = (j < i) ? (pw ? t4[r] : -t4[r]) : 0.f; }
            }
    }
    __syncthreads();
    {
        int tix = 0;
#pragma unroll
        for (int it = 0; it < 4; ++it)
#pragma unroll
            for (int jt = 0; jt < 4; ++jt) {
                if (jt <= it) {
#pragma unroll
                    for (int r = 0; r < 4; ++r) (pw ? Lk16 : Ln)[(16 * it + 4 * q + r) * MP + 16 * jt + l15] = (bf16)f2bf1(T[tix][r]);
                    ++tix;
                } else if (pw == 0) {
#pragma unroll
                    for (int r = 0; r < 4; ++r) Ln[(16 * it + 4 * q + r) * MP + 16 * jt + l15] = (bf16)0;
                }
            }
        LAS v4u* tz = (LAS v4u*)(B0 + 25600) + (pw * 64 + lane) * 2; tz[0] = (v4u){0u, 0u, 0u, 0u}; tz[1] = (v4u){0u, 0u, 0u, 0u};
    }
    __syncthreads();
    if (pw) {
#pragma unroll
        for (int I = 0; I < 4; ++I)
#pragma unroll
            for (int r = 0; r < 4; ++r)
#pragma unroll
                for (int nt = 0; nt < 4; ++nt) { const int i = 16 * I + 4 * q + r, j = 16 * nt + l15; acc[I][nt][r] = (j < i && nt <= I) ? bf2f(Lk16[i * MP + j]) : 0.f; }
    } else diag_inverses(Ln, TinvP, lane);
    __syncthreads();
    LAS unsigned char* XTw = XT + pw * 8192;
    { LAS v4u* xz = (LAS v4u*)(XTw + lane * 128);
#pragma unroll
        for (int g = 0; g < 8; ++g) xz[g] = (v4u){0u, 0u, 0u, 0u}; }
    blocked_solve(Ln, TinvP, XTw, acc, l15, q);
    {
        bf16* dst = rw_blob_row(C, d, pw, b, c, h, lane);
        const LAS unsigned char* xr = XTw + lane * 128;
#pragma unroll
        for (int g = 0; g < 8; ++g) *(v4u*)(dst + 8 * g) = *(const LAS v4u*)(xr + ((g ^ (lane & 7)) << 4));
    }
    __syncthreads();
}

template <bool DRY>
__device__ __forceinline__ void rwkv_chunked(const Ctx& C, int l, int idx) {
#ifndef RW_VSPLIT
#define RW_VSPLIT 1
#endif
    constexpr int NV = RW_VSPLIT ? 1 : 2;
    const int vhalf = idx & 1, lane = C.lane, w = C.wave, l15 = lane & 15, q = lane >> 4;
    const int d = RW_VSPLIT ? idx >> 6 : idx >> 5, b = RW_VSPLIT ? (idx >> 3) & 7 : (idx >> 2) & 7, h = RW_VSPLIT ? (idx >> 1) & 3 : idx & 3;
    const int it = w & 3, vt0 = RW_VSPLIT ? 2 * vhalf + (w >> 2) : 2 * (w >> 2);
    constexpr int IMG = 64 * MP * 2;
    LAS unsigned char* L0 = C.lds;
    LAS bf16* Wi = (LAS bf16*)L0; LAS bf16* Ti = Wi + 64 * MP; LAS bf16* Rh = Ti + 64 * MP; LAS bf16* Kh = Rh + 64 * MP; LAS bf16* Bh = Kh + 64 * MP;
    LAS bf16* UT = (LAS bf16*)(L0 + 11 * IMG);
    LAS float* cLv = (LAS float*)(L0 + 14 * IMG);
    const bf16* WA = WSP(const bf16, WS_HB); const bf16* rkv = WSP(const bf16, WS_RKV); const float* rinv = WSP(const float, WS_RINV);
    bf16* outb = WSP(bf16, WS_OUTB) + (size_t)d * T_ALL * 256;
    const int tt = C.tid >> 3, part = C.tid & 7;
    for (int i = C.tid; i < 2 * IMG / 4; i += NTHR) ((LAS unsigned*)(L0 + 12 * IMG))[i] = 0u;
    float kkw[8], kaw[8];
#pragma unroll
    for (int e = 0; e < 8; ++e) { kkw[e] = C.in[I_RKK][l * GW + h * 64 + 8 * w + e]; kaw[e] = C.in[I_RKA][l * GW + h * 64 + 8 * w + e]; }
    v4u gr, gk, gv, gw, ga, gbw, gbt; float gri;
    auto gload = [&](int n) {
        const int c = d ? (n < 4 ? 3 - n : 71 - n) : n;
        const int row = seqrow_raster(n * 64 + lane, d, b);
        const bf16* pr = rkv + (size_t)row * 768 + h * 64 + 8 * w;
        gr = *(const v4u*)pr; gk = *(const v4u*)(pr + 256); gv = *(const v4u*)(pr + 512);
        gw = *(const v4u*)(WA + (size_t)row * 1024 + d * 256 + h * 64 + 8 * w); ga = *(const v4u*)(WA + (size_t)row * 1024 + (2 + d) * 256 + h * 64 + 8 * w);
        gri = rinv[(size_t)row * 4 + h];
        gbw = *(const v4u*)(rw_blob_row(C, d, 0, b, c, h, tt) + 8 * part); gbt = *(const v4u*)(rw_blob_row(C, d, 1, b, c, h, tt) + 8 * part);
    };
    auto images = [&](int bufi) {
        LAS bf16* VT = (LAS bf16*)(L0 + (5 + 3 * bufi) * IMG); LAS bf16* KcT = VT + 64 * MP; LAS bf16* BcT = KcT + 64 * MP;
        const unsigned rw_[4] = {gr.x, gr.y, gr.z, gr.w}, kw_[4] = {gk.x, gk.y, gk.z, gk.w}, vw_[4] = {gv.x, gv.y, gv.z, gv.w}, ww_[4] = {gw.x, gw.y, gw.z, gw.w}, aw_[4] = {ga.x, ga.y, ga.z, ga.w};
        float rh[8], kh[8], bh[8];
#pragma unroll
        for (int e = 0; e < 8; ++e) {
            const float rs = (e & 1) ? bfhi(rw_[e >> 1]) : bflo(rw_[e >> 1]), ks = (e & 1) ? bfhi(kw_[e >> 1]) : bflo(kw_[e >> 1]);
            const float wv = (e & 1) ? bfhi(ww_[e >> 1]) : bflo(ww_[e >> 1]), av = (e & 1) ? bfhi(aw_[e >> 1]) : bflo(aw_[e >> 1]);
            const float kap = ks * kkw[e] * gri, ktil = ks * (1.0f + (av - 1.0f) * kaw[e]);
            const float cf = wv, icf = __builtin_amdgcn_rcpf(cf), cfL = __builtin_bit_cast(float, __builtin_amdgcn_readlane(__builtin_bit_cast(int, cf), 63)), dec = cfL * icf;
            rh[e] = rs * cf; kh[e] = ktil * icf; bh[e] = kap * av * icf;
            const unsigned short vraw = (e & 1) ? (unsigned short)(vw_[e >> 1] >> 16) : (unsigned short)(vw_[e >> 1] & 0xffffu);
            VT[(8 * w + e) * MP + lane] = vraw; KcT[(8 * w + e) * MP + lane] = (bf16)f2bf1(ktil * dec); BcT[(8 * w + e) * MP + lane] = (bf16)f2bf1(-(kap * av * dec));
            if (lane == 63) cLv[bufi * 64 + 8 * w + e] = cfL;
        }
        { v4u o; o.x = pk2(rh[0], rh[1]); o.y = pk2(rh[2], rh[3]); o.z = pk2(rh[4], rh[5]); o.w = pk2(rh[6], rh[7]); *(LAS v4u*)(Rh + lane * MP + 8 * w) = o; }
        { v4u o; o.x = pk2(kh[0], kh[1]); o.y = pk2(kh[2], kh[3]); o.z = pk2(kh[4], kh[5]); o.w = pk2(kh[6], kh[7]); *(LAS v4u*)(Kh + lane * MP + 8 * w) = o; }
        { v4u o; o.x = pk2(bh[0], bh[1]); o.y = pk2(bh[2], bh[3]); o.z = pk2(bh[4], bh[5]); o.w = pk2(bh[6], bh[7]); *(LAS v4u*)(Bh + lane * MP + 8 * w) = o; }
        const unsigned bw_[4] = {gbw.x, gbw.y, gbw.z, gbw.w}, bt_[4] = {gbt.x, gbt.y, gbt.z, gbt.w};
#pragma unroll
        for (int e = 0; e < 4; ++e) {
            Wi[(8 * part + 2 * e) * MP + tt] = (bf16)(bw_[e] & 0xffffu); Wi[(8 * part + 2 * e + 1) * MP + tt] = (bf16)(bw_[e] >> 16);
            Ti[(8 * part + 2 * e) * MP + tt] = (bf16)(bt_[e] & 0xffffu); Ti[(8 * part + 2 * e + 1) * MP + tt] = (bf16)(bt_[e] >> 16);
        }
    };
    f32x4 Zst[NV];
#pragma unroll
    for (int v2 = 0; v2 < NV; ++v2) Zst[v2] = (f32x4){0.f, 0.f, 0.f, 0.f};
    const f32x4 z4 = (f32x4){0.f, 0.f, 0.f, 0.f};
    gload(0); images(0); gload(1);
#pragma unroll 1
    for (int n = 0; n < NCH; ++n) {
        RAW_BARRIER();
        const LAS bf16* VT = (const LAS bf16*)(L0 + (5 + 3 * (n & 1)) * IMG); const LAS bf16* KcT = VT + 64 * MP; const LAS bf16* BcT = KcT + 64 * MP;
        const LAS bf16* Zi = (const LAS bf16*)(L0 + (12 + (n & 1)) * IMG); LAS bf16* Zn = (LAS bf16*)(L0 + (12 + ((n + 1) & 1)) * IMG);
        const int arow = (16 * it + l15) * MP + 8 * q;
        const fragb Wf0 = ld_frag16(Wi + arow), Wf1 = ld_frag16(Wi + arow + 32), Tf0 = ld_frag16(Ti + arow), Tf1 = ld_frag16(Ti + arow + 32), Rf0 = ld_frag16(Rh + arow), Rf1 = ld_frag16(Rh + arow + 32);
        const int icol = 16 * it + l15;
        f32x4 pk[4], pb[4];
#pragma unroll
        for (int jt = 0; jt < 4; ++jt) {
            pk[jt] = z4; pb[jt] = z4;
            if (jt <= it) {
                const int jrow = (16 * jt + l15) * MP + 8 * q;
                f32x4 sk = mfma16(ld_frag16(Kh + jrow), Rf0, z4); sk = mfma16(ld_frag16(Kh + jrow + 32), Rf1, sk);
                f32x4 sb = mfma16(ld_frag16(Bh + jrow), Rf0, z4); sb = mfma16(ld_frag16(Bh + jrow + 32), Rf1, sb);
#pragma unroll
                for (int r = 0; r < 4; ++r) { const int j = 16 * jt + 4 * q + r; pk[jt][r] = (j <= icol) ? sk[r] : 0.f; pb[jt][r] = (j <= icol) ? -sb[r] : 0.f; }
            }
        }
        fragb Pk0 = pack_frag(pk[0], pk[1]), Pk1 = pack_frag(pk[2], pk[3]), Pb0 = pack_frag(pb[0], pb[1]), Pb1 = pack_frag(pb[2], pb[3]);
        f32x4 RZ[NV];
#pragma unroll
        for (int v2 = 0; v2 < NV; ++v2) {
            const int vrow = 16 * (vt0 + v2) + l15;
            const fragb z0 = ld_frag16(Zi + vrow * MP + 8 * q), z1 = ld_frag16(Zi + vrow * MP + 32 + 8 * q);
            f32x4 u = mfma16(Wf0, z0, z4); u = mfma16(Wf1, z1, u);
            u = mfma16(Tf0, ld_frag16(VT + vrow * MP + 8 * q), u); if (it >= 2) u = mfma16(Tf1, ld_frag16(VT + vrow * MP + 32 + 8 * q), u);
            RZ[v2] = mfma16(Rf0, z0, z4); RZ[v2] = mfma16(Rf1, z1, RZ[v2]);
            v2u o; o.x = pk2(u.x, u.y); o.y = pk2(u.z, u.w);
            *(LAS v2u*)(UT + vrow * MP + 16 * it + 4 * q) = o;
        }
        RAW_BARRIER();
        {
            const f32x4 cl4 = *(const LAS f32x4*)(cLv + (n & 1) * 64 + 16 * it + 4 * q);
            const LAS bf16* kr = KcT + (16 * it + l15) * MP + 4 * q; const LAS bf16* br = BcT + (16 * it + l15) * MP + 4 * q;
            const fragb kc0 = ld_frag8x2(kr, kr + 16), kc1 = ld_frag8x2(kr + 32, kr + 48), bc0 = ld_frag8x2(br, br + 16), bc1 = ld_frag8x2(br + 32, br + 48);
#pragma unroll
            for (int v2 = 0; v2 < NV; ++v2) {
                const int vrow = 16 * (vt0 + v2) + l15;
                const LAS bf16* vr = VT + vrow * MP + 4 * q; const LAS bf16* ur = UT + vrow * MP + 4 * q;
                const fragb vp0 = ld_frag8x2(vr, vr + 16), vp1 = ld_frag8x2(vr + 32, vr + 48), up0 = ld_frag8x2(ur, ur + 16), up1 = ld_frag8x2(ur + 32, ur + 48);
                f32x4 y = mfma16(Pk0, vp0, RZ[v2]); y = mfma16(Pb0, up0, y);
                if (it >= 2) { y = mfma16(Pk1, vp1, y); y = mfma16(Pb1, up1, y); }
#pragma unroll
                for (int r = 0; r < 4; ++r) { const int row = seqrow_raster(n * 64 + 16 * it + 4 * q + r, d, b); if (!DRY) outb[(size_t)row * 256 + h * 64 + vrow] = (bf16)f2bf1(y[r]); }
                f32x4 zn = mfma16(kc0, vp0, z4); zn = mfma16(kc1, vp1, zn); zn = mfma16(bc0, up0, zn); zn = mfma16(bc1, up1, zn);
                Zst[v2] = Zst[v2] * cl4 + zn;
                v2u so; so.x = pk2(Zst[v2].x, Zst[v2].y); so.y = pk2(Zst[v2].z, Zst[v2].w);
                *(LAS v2u*)(Zn + vrow * MP + 16 * it + 4 * q) = so;
            }
        }
        if (n + 1 < NCH) { images((n + 1) & 1); if (n + 2 < NCH) gload(n + 2); }
    }
    __syncthreads();
}
__device__ __forceinline__ void moe_scatter(const Ctx& C, int moe_li, int nrows) {
    const unsigned* gc = WSP(const unsigned, WS_CTL) + CW_MOECNT + 64 * moe_li;
    LAS int* pst = (LAS int*)C.lds;
    {
        int pe[8]; int acc = 0;
#pragma unroll
        for (int e = 0; e < NE; ++e) { const int blks = ((int)gc[e] + 255) >> 8; if (C.tid == e) pst[e] = acc * 256; acc += blks; pe[e] = acc; }
        if (C.wg == 0 && C.tid < MOE_MAXBLK) { int be = 0;
#pragma unroll
            for (int e = 0; e < NE; ++e) be += (pe[e] <= C.tid) ? 1 : 0;
            int* tab = WSP(int, WS_TAB); tab[1 + C.tid] = be < NE ? be : NE - 1; if (C.tid == 0) tab[0] = acc; }
    }
    __syncthreads();
    const unsigned* route = WSP(const unsigned, WS_ROUTE); const unsigned* wgbase = WSP(const unsigned, WS_WGBASE);
    int* pos = WSP(int, WS_POS); int* tok = WSP(int, WS_TOK);
    if (C.wg < NE) { const int cnt = (int)gc[C.wg], s0 = pst[C.wg] + cnt, s1 = pst[C.wg] + (((cnt + 255) >> 8) << 8);
        for (int j = s0 + C.tid; j < s1; j += NTHR) tok[j] = 0; }
    const int m = C.wg * NWAVES + C.wave + C.lane * (C.G * NWAVES);
    if (m < nrows) {
        const v4u a = *(const v4u*)(route + (size_t)m * 8);
        const int e0 = (int)a.x, e1 = (int)a.y;
        const int p0 = pst[e0] + (int)wgbase[C.wg * 8 + e0] + (int)a.z, p1 = pst[e1] + (int)wgbase[C.wg * 8 + e1] + (int)a.w;
        pos[(size_t)m * 2] = p0; pos[(size_t)m * 2 + 1] = p1; tok[p0] = m; tok[p1] = m;
    }
    __syncthreads();
}
template <int NEXT>
__device__ __forceinline__ void moe_combine(const Ctx& C, int l, int nrows) {
    const unsigned* route = WSP(const unsigned, WS_ROUTE); const int* pos = WSP(const int, WS_POS); const bf16* ym = WSP(const bf16, WS_MIX);
    const float* modv = WSP(const float, WS_MODV) + (size_t)l * 9 * 6144 + 5 * 1024;
    const float* modn = WSP(const float, WS_MODV) + (size_t)(l + 1) * 9 * 6144;
    float* xc = WSP(float, WS_XC); bf16* hb = WSP(bf16, WS_HB);
    bf16* xlb = NEXT == 2 ? WSP(bf16, WS_XLAST) : (bf16*)C.out;
    const int gw = C.wg * NWAVES + C.wave, NGW = C.G * NWAVES;
    f32x4 gn[4];
#pragma unroll
    for (int j = 0; j < 4; ++j) gn[j] = *(const f32x4*)((NEXT == 2 ? C.in[I_FNG] : C.in[I_NMIXG] + (NEXT == 1 ? (l + 1) * 1024 : 0)) + 4 * C.lane + 256 * j);
    for (int m = gw; m < nrows; m += NGW) {
        const bool isctx = m >= T_LAT;
        float* xr = isctx ? xc + (size_t)(m - T_LAT) * 1024 : C.out + (size_t)m * 1024; bf16* xrb = xlb + (size_t)m * 1024;
        const int mrow = isctx ? 8 : (m >> 12);
        const float* gv = modv + (size_t)mrow * 6144;
        const int p0 = pos[(size_t)m * 2], p1 = pos[(size_t)m * 2 + 1];
        const float w0 = __builtin_bit_cast(float, route[(size_t)m * 8 + 4]), w1 = __builtin_bit_cast(float, route[(size_t)m * 8 + 5]);
        f32x4 x[4]; float ss = 0.f;
#pragma unroll
        for (int j = 0; j < 4; ++j) {
            const int col = 4 * C.lane + 256 * j;
            const v2u a = *(const v2u*)(ym + (size_t)p0 * 1024 + col), b = *(const v2u*)(ym + (size_t)p1 * 1024 + col);
            const f32x4 ya = (f32x4){bflo(a.x), bfhi(a.x), bflo(a.y), bfhi(a.y)}, yb = (f32x4){bflo(b.x), bfhi(b.x), bflo(b.y), bfhi(b.y)};
            const f32x4 g = *(const f32x4*)(gv + col);
            x[j] = (isctx ? *(const f32x4*)(xr + col) : ld4bf(xrb + col)) + g * (ya * w0 + yb * w1);
            if (NEXT != 2) { if (isctx) *(f32x4*)(xr + col) = x[j]; else st4bf(xrb + col, x[j]); }
            ss += (x[j].x * x[j].x + x[j].y * x[j].y) + (x[j].z * x[j].z + x[j].w * x[j].w);
        }
        if (NEXT != 0) {
            const float rs = rsqrtf_(wave_sum(ss) * (1.0f / 1024.0f) + 1e-6f);
#pragma unroll
            for (int j = 0; j < 4; ++j) {
                const int col = 4 * C.lane + 256 * j;
                if (NEXT == 2) *(f32x4*)(xr + col) = x[j] * rs * gn[j];
                else { const f32x4 sh = *(const f32x4*)(modn + (size_t)mrow * 6144 + col), scl = *(const f32x4*)(modn + (size_t)mrow * 6144 + 1024 + col);
                    st4bf(hb + (size_t)m * 1024 + col, (x[j] * rs * gn[j]) * (scl + 1.0f) + sh); }
            }
        }
    }
}
__device__ __forceinline__ void final_norm(const Ctx& C) {
    const int gw = C.wg * NWAVES + C.wave, NGW = C.G * NWAVES;
    f32x4 gv[4];
#pragma unroll
    for (int j = 0; j < 4; ++j) gv[j] = *(const f32x4*)(C.in[I_FNG] + 4 * C.lane + 256 * j);
    for (int m = gw; m < T_LAT; m += NGW) {
        float* xr = C.out + (size_t)m * 1024;
        f32x4 v[4]; float s = 0.f;
#pragma unroll
        for (int j = 0; j < 4; ++j) { v[j] = *(const f32x4*)(xr + 4 * C.lane + 256 * j); s += (v[j].x * v[j].x + v[j].y * v[j].y) + (v[j].z * v[j].z + v[j].w * v[j].w); }
        const float rs = rsqrtf_(wave_sum(s) * (1.0f / 1024.0f) + 1e-6f);
#pragma unroll
        for (int j = 0; j < 4; ++j) *(f32x4*)(xr + 4 * C.lane + 256 * j) = v[j] * rs * gv[j];
    }
}

constexpr int NPH_L = 13, PH_FINAL = 1 + DEPTH * NPH_L, NPHASE = PH_FINAL + 1;
__host__ __device__ inline bool phase_exists(int ph) {
    if (ph == 0) return true;
    if (ph == PH_FINAL) return false;
    const int l = (ph - 1) / NPH_L, k = (ph - 1) % NPH_L;
    if (l >= 2 && !(l & 1) && k == 0) return false;
    if (!(l & 1) && k >= 11) return false;
    if (!RW_VSPLIT && k == 4) return false;
    return true;
}
#ifndef PH_MASK
#define PH_MASK 0xFFFFFF
#endif
#define PM(k) ((PH_MASK >> (k)) & 1)
#ifndef SK_MASK
#define SK_MASK 0xFFFF
#endif
#define SK(k) ((SK_MASK >> (k)) & 1)
#ifndef REP_MASK
#define REP_MASK 0
#endif
#define NREP(k) (((REP_MASK >> (k)) & 1) ? 2 : 1)

__global__ void __launch_bounds__(NTHR, 2) fwd_kernel(Args args) {
    extern __shared__ __attribute__((aligned(16))) unsigned char lds_raw[];
    Ctx C; C.in = args.in; C.out = args.out; C.ws = args.ws; C.lds = (LAS unsigned char*)lds_raw;
    C.tid = threadIdx.x; C.lane = C.tid & 63; C.wave = __builtin_amdgcn_readfirstlane(C.tid >> 6); C.G = gridDim.x; C.wg = blockIdx.x;
    volatile LAS unsigned* MISC = (volatile LAS unsigned*)(C.lds + MISC_OFF);
    if (C.tid < 64) MISC[C.tid] = 0u;
    __syncthreads();
    const int lo = args.ph_lo, hi = args.ph_hi;
    const bool multi = (hi - lo) > 1;
    if (multi) (void)xcd_barrier_post(WSP(unsigned, WS_CTL) + CW_BAR, MISC + 8);
#define IN(k) (lo <= (k) && (k) < hi)
#define SEAM(k) do { if (IN((k) + 1)) { XcdBarrier b2_; b2_.bar = WSP(unsigned, WS_CTL) + CW_BAR; b2_.x = xb_xcc_id(); b2_.st = (volatile LAS unsigned*)(C.lds + MISC_OFF) + 8; xcd_barrier(b2_); } } while (0)
#define FRESH() do { int t_ = threadIdx.x; asm volatile("" : "+v"(t_)); C.tid = t_; C.lane = t_ & 63; C.wave = __builtin_amdgcn_readfirstlane(t_ >> 6); } while (0)
#define PHASE(bit, k) if (PM(bit) && IN(pb + (k))) for (int rep_ = 0; rep_ < NREP(bit); ++rep_)
#define CLAIM(qh, var) __syncthreads(); if (C.tid == 0) *qslot = atomicAdd((qh), 1u); __syncthreads(); const int var = (int)*qslot;

    LAS unsigned* qslot = (LAS unsigned*)(C.lds + MISC_OFF + 128);
    constexpr int NCSL = 512;
    if (PM(20) && IN(0)) { phase_pre(C);
        for (;;) { FRESH(); CLAIM(WSP(unsigned, WS_CTL) + CW_PREPQ + 224, u0) if (u0 >= NCSL) break; FRESH(); convert_items(C, 0, 3, u0 * NWAVES + C.wave, NCSL * NWAVES); }
        SEAM(0); }

#pragma unroll 1
    for (int l = 0; l < DEPTH; ++l) {
        const int pb = 1 + l * NPH_L;
        if (hi <= pb || lo >= pb + NPH_L) continue;
        const bool last = (l == DEPTH - 1), moe = (l & 1);
        const int nrows = last ? T_LAT : T_ALL;
        const void* xlat = (l == 0) ? (const void*)C.in[I_X] : (const void*)C.out; const bool xbf = l > 0; void* xmid = last ? (void*)WSP(bf16, WS_XLAST) : (void*)C.out;
        const float* xctx = (l == 0) ? C.in[I_CTX] : WSP(const float, WS_XC);
        const float* modv = WSP(const float, WS_MODV) + (size_t)l * 9 * 6144;
        unsigned* qbase = WSP(unsigned, WS_CTL) + CW_PREPQ + 256 * l;

        if (!(l >= 2 && !(l & 1))) PHASE(0, 0) { FRESH();
            convert_small(C, l);
            __syncthreads();
            FRESH(); norm_rows<false>(C, l, xlat, xbf, xctx, C.in[I_NMIXG] + l * 1024, 0, 1024, T_ALL, 0);
            SEAM(pb + 0);
        }
        PHASE(1, 1) { FRESH();
            pg8::Gemm g{WSP(const bf16, WS_HB), WSP(const bf16, WS_WIN), T_ALL, PLD, 1024, 0};
            pg8::StaticOrder S; S.init(T_ALL, PLD, C.G, C.wg);
            pg8::EpiBf16<0> E{WSP(bf16, WS_P), PLD, nullptr, 0, 0};
            pg8::gemm_phase<pg8::EpiBf16<0>, pg8::StaticOrder, false>(C.lds, g, S, E, nullptr);
            SEAM(pb + 1);
        }
        if (PM(2) && IN(pb + 2)) for (int rep_ = 0; rep_ < NREP(2); ++rep_) { FRESH();
            for (;;) {
                CLAIM(qbase + 16 * rep_, k)
                if (k >= 2 * NB * NCH) break;
                const int kind = k / (NB * NCH), u = k % (NB * NCH);
                FRESH();
                if (kind == 0) { for (int r3_ = 0; r3_ < NREP(24); ++r3_) { FRESH(); if (SK(1)) rwkv_prep2(C, l, u / NCH, u % NCH); } }
                else { for (int r3_ = 0; r3_ < NREP(26); ++r3_) { FRESH(); if (SK(2)) gdn_prep(C, l, u / NCH, u % NCH); } }
            }
            SEAM(pb + 2);
        }
        if (PM(3) && IN(pb + 3)) for (int rep_ = 0; rep_ < NREP(3); ++rep_) { FRESH();
            constexpr int NCL = 2 * NB * NH * NCH / 4;
            int ncl_ = 0;
            for (;;) {
                CLAIM(qbase + 64 + 16 * rep_, k)
                if (k >= NCL) break;
                FRESH(); ++ncl_;
                if (SK(10)) rwkv_solve_item(C, l, 4 * k + (C.wave >> 1));
            }
            if (ncl_ <= 4) { const int cap_ = (l & 1) ? 1 : 3;
                for (int j_ = 0; j_ < cap_; ++j_) {
                    FRESH(); CLAIM(qbase + 192, u0)
                    if (u0 >= NCSL) break;
                    FRESH(); if (l > 0) convert_items(C, l, 2, u0 * NWAVES + C.wave, NCSL * NWAVES);
                    if (l + 1 < DEPTH) { FRESH(); convert_items(C, l + 1, 1, u0 * NWAVES + C.wave, NCSL * NWAVES); }
                }
            }
            SEAM(pb + (RW_VSPLIT ? 3 : 4));
        }
#if RW_VSPLIT
        if (PM(3) && IN(pb + 4)) { FRESH();
            for (;;) {
                CLAIM(qbase + 128, k)
                if (k >= 2 * NB * NH * NCH / 4) break;
                FRESH();
                if (SK(10)) rwkv_solve_item(C, l, 4 * k + (C.wave >> 1));
            }
            SEAM(pb + 4);
        }
#endif
        if (PM(4) && IN(pb + 5)) { FRESH();
            if (C.wg >= 64) {
                constexpr int NCL = 2 * NB * NH * NCH / 4;
                for (;;) {
                    CLAIM(qbase + 128, k)
                    if (k >= NCL) break;
                    FRESH();
                    if (SK(9)) gdn_solve_item(C, l, 4 * k + (C.wave >> 1));
                }
                asm volatile("s_waitcnt vmcnt(0)" ::: "memory");
                __syncthreads();
                if (C.tid == 0) { __builtin_amdgcn_fence(__ATOMIC_RELEASE, "agent"); asm volatile("s_waitcnt vmcnt(0)" ::: "memory"); (void)xb_add(qbase + 160, 1u); }
                if (C.wg >= 192) {
                    if (C.tid == 0) { unsigned* bar_ = WSP(unsigned, WS_CTL) + CW_BAR; XB_SPIN(xb_ld(qbase + 160) < (unsigned)(C.G - 64), bar_); __builtin_amdgcn_fence(__ATOMIC_ACQUIRE, "agent"); asm volatile("s_waitcnt vmcnt(0)" ::: "memory"); }
                    __syncthreads();
                }
                FRESH();
            }
            if (C.wg >= 64 && C.wg < 128) { if (SK(0)) lru_chain(C, l, C.wg - 64); FRESH(); }
            if (SK(3) && C.wg < (RW_VSPLIT ? 128 : 64)) { if (NREP(20) > 1) { FRESH(); rwkv_chunked<true>(C, l, C.wg); } FRESH(); rwkv_chunked<false>(C, l, C.wg); }
            else if (SK(4) && C.wg >= 128 && C.wg < 192) { for (int r2_ = 0; r2_ < NREP(21); ++r2_) { FRESH(); mlstm_chunked(C, l, C.wg - 128); } }
            else if (SK(5) && C.wg >= 192) { if (NREP(22) > 1) { FRESH(); gdn_chunked<true>(C, l, C.wg - 192); } FRESH(); gdn_chunked<false>(C, l, C.wg - 192); }
            {
                FRESH();
                const int nun = 0;
                for (;;) {
                    CLAIM(qbase + 192, u0)
                    if (u0 >= NCSL + nun) break;
                    if (u0 < NCSL) {
                        FRESH(); if (l > 0) convert_items(C, l, 2, u0 * NWAVES + C.wave, NCSL * NWAVES);
                        if (l + 1 < DEPTH) { FRESH(); convert_items(C, l + 1, 1, u0 * NWAVES + C.wave, NCSL * NWAVES); }
                    }
                }
            }
            SEAM(pb + 5);
        }
        PHASE(5, 6) { FRESH();
            if (SK(8)) finish_rows(C, l, nrows);
            SEAM(pb + 6);
        }
        if (PM(6) && IN(pb + 7)) { FRESH();
            pg8::Gemm g{WSP(const bf16, WS_HB), WSP(const bf16, WS_WOUT), nrows, 1024, 1024, 0};
            pg8::StaticOrder S; S.init(nrows, 1024, C.G, C.wg);
            pg8::EpiRes E{xlat, xctx, xmid, WSP(float, WS_XC), modv + 2 * 1024, xbf, true};
            pg8::gemm_phase<pg8::EpiRes, pg8::StaticOrder, false>(C.lds, g, S, E, nullptr);
            SEAM(pb + 7);
        }
        if (PM(7) && IN(pb + 8)) { FRESH();
            if (moe) norm_rows<true>(C, l, xmid, true, WSP(const float, WS_XC), C.in[I_NFFNG] + l * 1024, 3 * 1024, 4 * 1024, nrows, l >> 1);
            else norm_rows<false>(C, l, xmid, true, WSP(const float, WS_XC), C.in[I_NFFNG] + l * 1024, 3 * 1024, 4 * 1024, nrows, 0);
            SEAM(pb + 8);
        }
        if (!moe) {
            if (PM(8) && IN(pb + 9)) for (int rep_ = 0; rep_ < NREP(8); ++rep_) { FRESH();
                pg8::Gemm g{WSP(const bf16, WS_HB), WSP(const bf16, WS_WGU), nrows, 2 * DFF, 1024, 0};
                pg8::StaticOrder S; S.init(nrows, 2 * DFF, C.G, C.wg);
                pg8::EpiSwiglu E{WSP(bf16, WS_P), DFF};
                pg8::gemm_phase<pg8::EpiSwiglu, pg8::StaticOrder, false>(C.lds, g, S, E, nullptr);
                SEAM(pb + 9);
            }
            if (PM(9) && IN(pb + 10)) { FRESH();
                pg8::Gemm g{WSP(const bf16, WS_P), WSP(const bf16, WS_WDN), nrows, 1024, DFF, 0};
                pg8::StaticOrder S; S.init(nrows, 1024, C.G, C.wg);
                pg8::EpiRes E{xmid, WSP(const float, WS_XC), xmid, WSP(float, WS_XC), modv + 5 * 1024, true, true};
                pg8::gemm_phase<pg8::EpiRes, pg8::StaticOrder, false>(C.lds, g, S, E, nullptr);
                SEAM(pb + 12);
            }
        } else {
            if (PM(10) && IN(pb + 9)) { FRESH(); moe_scatter(C, l >> 1, nrows); SEAM(pb + 9); }
            if (PM(11) && IN(pb + 10)) for (int rep_ = 0; rep_ < NREP(11); ++rep_) { FRESH();
                pg8::Gemm g{WSP(const bf16, WS_HB), WSP(const bf16, WS_WGU), 0, 2 * DFE, 1024, (size_t)2 * DFE * 1024};
                pg8::MoeOrderG S; S.init(WSP(const int, WS_TAB), (2 * DFE) / 256, C.G, C.wg); S.tok = WSP(const int, WS_TOK);
                pg8::EpiSwiglu E{WSP(bf16, WS_P), DFE};
                pg8::gemm_phase<pg8::EpiSwiglu, pg8::MoeOrderG, false>(C.lds, g, S, E, nullptr);
                SEAM(pb + 10);
            }
            if (PM(12) && IN(pb + 11)) for (int rep_ = 0; rep_ < NREP(12); ++rep_) { FRESH();
                pg8::Gemm g{WSP(const bf16, WS_P), WSP(const bf16, WS_WDN), 0, 1024, DFE, (size_t)1024 * DFE};
                pg8::MoeOrder S; S.init(WSP(const int, WS_TAB), 4, C.G, C.wg);
                pg8::EpiBf16<0> E{WSP(bf16, WS_MIX), 1024, nullptr, 0, 0};
                pg8::gemm_phase<pg8::EpiBf16<0>, pg8::MoeOrder, false>(C.lds, g, S, E, nullptr);
                SEAM(pb + 11);
            }
            if (PM(13) && IN(pb + 12)) { FRESH();
                if (last) moe_combine<2>(C, l, nrows);
                else { convert_small(C, l + 1); FRESH(); moe_combine<1>(C, l, nrows); if (IN(pb + NPH_L + 1)) { XcdBarrier b2_; b2_.bar = WSP(unsigned, WS_CTL) + CW_BAR; b2_.x = xb_xcc_id(); b2_.st = (volatile LAS unsigned*)(C.lds + MISC_OFF) + 8; xcd_barrier(b2_); } }
            }
        }
    }
}

extern "C" void kernel_launch(void* const* d_in, const int* in_sizes, int n_in, void* d_out, int out_size, void* d_ws, size_t ws_size, hipStream_t stream) {
    static int grid = 0;
    if (grid == 0) {
        if (n_in != N_IN || in_sizes[0] != T_LAT * DM || out_size != T_LAT * DM || ws_size < WS_END) {
            fprintf(stderr, "kernel_launch: unexpected problem (n_in %d, in0 %d, out %d, ws %zu < %zu)\n", n_in, n_in > 0 ? in_sizes[0] : -1, out_size, ws_size, (size_t)WS_END); grid = -1; return; }
        int dev = 0, cus = 0, per_cu = 0;
        if (hipGetDevice(&dev) != hipSuccess || hipDeviceGetAttribute(&cus, hipDeviceAttributeMultiprocessorCount, dev) != hipSuccess) { grid = -1; return; }
        if (hipFuncSetAttribute((const void*)fwd_kernel, hipFuncAttributeMaxDynamicSharedMemorySize, LDS_BYTES) != hipSuccess) { fprintf(stderr, "kernel_launch: hipFuncSetAttribute failed\n"); grid = -1; return; }
        if (hipOccupancyMaxActiveBlocksPerMultiprocessor(&per_cu, (const void*)fwd_kernel, NTHR, LDS_BYTES) != hipSuccess || per_cu < 1) { fprintf(stderr, "kernel_launch: occupancy query says %d\n", per_cu); grid = -1; return; }
        grid = cus;
        if (grid != 256) fprintf(stderr, "kernel_launch: note: %d CUs\n", grid);
    }
    if (grid < 0) return;
    if (hipMemsetAsync((char*)d_ws + WS_CTL, 0, CTL_BYTES, stream) != hipSuccess) return;
    Args a{};
    for (int i = 0; i < N_IN; ++i) a.in[i] = (const float*)d_in[i];
    a.out = (float*)d_out; a.ws = (unsigned char*)d_ws;
#if MK_ONE_LAUNCH
    a.ph_lo = 0; a.ph_hi = NPHASE;
    hipLaunchKernelGGL(fwd_kernel, dim3(grid), dim3(NTHR), LDS_BYTES, stream, a);
#else
    for (int ph = 0; ph < NPHASE; ++ph) { if (!phase_exists(ph)) continue; a.ph_lo = ph; a.ph_hi = ph + 1; hipLaunchKernelGGL(fwd_kernel, dim3(grid), dim3(NTHR), LDS_BYTES, stream, a); }
#endif
}
```

```cpp
#define MK_ONE_LAUNCH 1
#include <hip/hip_runtime.h>
#include <cstdio>
#include <cstdint>

#define GAS __attribute__((address_space(1)))
#define LAS __attribute__((address_space(3)))
typedef unsigned short bf16;
typedef unsigned v4u __attribute__((ext_vector_type(4)));
typedef unsigned v2u __attribute__((ext_vector_type(2)));
typedef float f32x4 __attribute__((ext_vector_type(4)));
typedef float f32x2 __attribute__((ext_vector_type(2)));
typedef short bf16x8 __attribute__((ext_vector_type(8)));
#define LDS_WAIT() asm volatile("s_waitcnt lgkmcnt(0)" ::: "memory")
#define VM_WAIT() asm volatile("s_waitcnt vmcnt(0)" ::: "memory")

constexpr int DM = 1024, NB = 8, SEQ = 4096, DEPTH = 4, CTXL = 256, GW = 256, HD = 64, NH = 4;
constexpr int T_LAT = NB * SEQ, T_CTX = NB * CTXL, T_ALL = T_LAT + T_CTX;
constexpr int IN_COLS = 3552, PLD = 3584;
constexpr int OFF_B = 512, OFF_C = 1472, OFF_D = 2512, B_COLS = 960;
constexpr int DFF = 2816, NE = 8, DFE = 1408;
constexpr int NCH = 68;
constexpr int NSTEP = 4352;
constexpr int MOE_MAXBLK = 280;
constexpr int NWAVES = 8, NTHR = 512;
#ifndef RW_VSPLIT
#define RW_VSPLIT 0
#endif

constexpr size_t MiB = 1u << 20;
constexpr size_t WS_CTL = 0, CTL_BYTES = 1 * MiB;
constexpr size_t WS_MODV = 1 * MiB;
constexpr size_t WS_XC = 2 * MiB;
constexpr size_t WS_WIN = 10 * MiB;
constexpr size_t WS_WOUT = 17 * MiB;
constexpr size_t WS_WGU = 19 * MiB;
constexpr size_t WS_WDN = 63 * MiB;
constexpr size_t WS_HB = 85 * MiB;
constexpr size_t WS_P = 153 * MiB;
constexpr size_t WS_MIX = 391 * MiB;
constexpr size_t WS_OUTB = WS_MIX, WS_OUTC = WS_MIX + 34 * MiB, WS_OUTD = WS_MIX + 68 * MiB, WS_GQ = WS_MIX + 102 * MiB, WS_G = WS_MIX + 153 * MiB;
constexpr size_t WS_XLAST = WS_MIX + 144 * MiB;
constexpr size_t WS_RKV = WS_MIX + 170 * MiB;
constexpr size_t WS_SMALL = 612 * MiB;
constexpr size_t WS_ROUTE = WS_SMALL;
constexpr size_t WS_POS = WS_SMALL + 1280 * 1024;
constexpr size_t WS_TOK = WS_SMALL + 1664 * 1024;
constexpr size_t WS_BONUS = WS_SMALL + 2 * MiB;
constexpr size_t WS_RINV = WS_SMALL + 2 * MiB + 640 * 1024;
constexpr size_t WS_WGBASE = WS_SMALL + 3 * MiB + 256 * 1024;
constexpr size_t WS_TAB = WS_WGBASE + 65536;
constexpr size_t WS_LRUWT = WS_SMALL + 3 * MiB + 512 * 1024;
constexpr size_t WS_RWT = WS_LRUWT + 131072;
constexpr size_t WS_LRUH = WS_SMALL + 4 * MiB;
constexpr size_t WS_END = 633 * MiB;
constexpr int CW_MOECNT = 1024;
constexpr int CW_PREPQ = 2048;
constexpr int CW_BAR = 4096;

constexpr int LDS_BYTES = 135168;
constexpr int MISC_OFF = 131072;

__device__ __forceinline__ unsigned f2bf(float f) { unsigned u = __builtin_bit_cast(unsigned, f); return (u + 0x7fffu + ((u >> 16) & 1u)) >> 16; }
typedef __bf16 bf16n2 __attribute__((ext_vector_type(2)));
__device__ __forceinline__ unsigned pk2(float lo, float hi) { const f32x2 v = {lo, hi}; return __builtin_bit_cast(unsigned, __builtin_convertvector(v, bf16n2)); }
__device__ __forceinline__ unsigned f2bf1(float f) { return pk2(f, f) & 0xffffu; }
__device__ __forceinline__ float bf2f(unsigned short v) { return __builtin_bit_cast(float, (unsigned)v << 16); }
__device__ __forceinline__ float bflo(unsigned v) { return __builtin_bit_cast(float, v << 16); }
__device__ __forceinline__ float bfhi(unsigned v) { return __builtin_bit_cast(float, v & 0xffff0000u); }
template <int CTRL, int RM, bool BC> __device__ __forceinline__ float dpp_x(float oldv, float v) { return __builtin_bit_cast(float, __builtin_amdgcn_update_dpp(__builtin_bit_cast(int, oldv), __builtin_bit_cast(int, v), CTRL, RM, 0xF, BC)); }
__device__ __forceinline__ float wave_sum(float v) {
    v += dpp_x<0xB1, 0xF, true>(0.f, v); v += dpp_x<0x4E, 0xF, true>(0.f, v); v += dpp_x<0x141, 0xF, true>(0.f, v); v += dpp_x<0x140, 0xF, true>(0.f, v);
    v += dpp_x<0x142, 0xA, false>(0.f, v); v += dpp_x<0x143, 0xC, false>(0.f, v);
    return __builtin_bit_cast(float, __builtin_amdgcn_readlane(__builtin_bit_cast(int, v), 63));
}
template <int CTRL> __device__ __forceinline__ float dpp_f(float v) { return __builtin_bit_cast(float, __builtin_amdgcn_update_dpp(0, __builtin_bit_cast(int, v), CTRL, 0xF, 0xF, true)); }
__device__ __forceinline__ float row16_sum(float v) {
    v += dpp_f<0xB1>(v);
    v += dpp_f<0x4E>(v);
    v += dpp_f<0x141>(v);
    v += dpp_f<0x140>(v);
    return v;
}
__device__ __forceinline__ float sigmoidf_(float x) { return __builtin_amdgcn_rcpf(1.0f + __expf(-x)); }
__device__ __forceinline__ float softplusf_(float x) { return fmaxf(x, 0.f) + __logf(1.0f + __expf(-fabsf(x))); }
__device__ __forceinline__ float expm1f_(float x) { return x > -0.3f ? x * (1.0f + x * (0.5f + x * (0.16666667f + x * (0.041666668f + x * 0.0083333338f)))) : __expf(x) - 1.0f; }
__device__ __forceinline__ float siluf_(float x) { return x * __builtin_amdgcn_rcpf(1.0f + __expf(-x)); }
__device__ __forceinline__ float tanhf_(float x) { const float e = __expf(2.0f * x); return 1.0f - 2.0f * __builtin_amdgcn_rcpf(e + 1.0f); }
__device__ __forceinline__ float rsqrtf_(float x) { return __builtin_amdgcn_rsqf(x); }
__device__ __forceinline__ float gelu_tanh(float x) { return 0.5f * x * (1.0f + tanhf_(0.7978845608028654f * (x + 0.044715f * x * x * x))); }
__device__ __forceinline__ f32x4 ld4bf(const bf16* p) { const v2u a = *(const v2u*)p; return (f32x4){bflo(a.x), bfhi(a.x), bflo(a.y), bfhi(a.y)}; }
__device__ __forceinline__ void st4bf(bf16* p, const f32x4& v) { v2u o; o.x = pk2(v.x, v.y); o.y = pk2(v.z, v.w); *(v2u*)p = o; }
#define XB_TMO      128
#define XB_XCNT(j)  (256  + 64 * (j))
#define XB_XSUB(j)  (1280 + 64 * (j))
#define XB_XGEN(j)  (2304 + 64 * (j))
#define XB_TOP      3328
#define XB_TOPGEN   3392
#define XCD_BAR_WORDS 3456
#define XB_SPIN_CAP (1u << 22)

__device__ __forceinline__ unsigned xb_ld(unsigned* p)              { return __hip_atomic_load(p, __ATOMIC_RELAXED, __HIP_MEMORY_SCOPE_AGENT); }
__device__ __forceinline__ unsigned xb_add(unsigned* p, unsigned v) { return __hip_atomic_fetch_add(p, v, __ATOMIC_RELAXED, __HIP_MEMORY_SCOPE_AGENT); }
__device__ __forceinline__ unsigned xb_xcc_id() { return (unsigned)__builtin_amdgcn_s_getreg((3 << 11) | 20) & 0xFu; }
#define XB_SPIN(cond, bar) do { unsigned _sp = 0; while (cond) { __builtin_amdgcn_s_sleep(1); \
    if ((++_sp & 255u) == 0u) { if (xb_ld(&(bar)[XB_TMO])) break; if (_sp > XB_SPIN_CAP) { atomicAdd(&(bar)[XB_TMO], 1u); break; } } } } while (0)

struct XcdBarrier {
    unsigned* bar; unsigned x;
    volatile LAS unsigned* st;
};

__device__ __forceinline__ XcdBarrier xcd_barrier_post(unsigned* bar, volatile LAS unsigned* st) {
    XcdBarrier b; b.bar = bar; b.x = xb_xcc_id(); b.st = st;
    if (threadIdx.x == 0) (void)xb_add(&bar[XB_XCNT(b.x)], 1u);
    return b;
}
__device__ __forceinline__ void xcd_barrier_complete(unsigned* bar, unsigned x, unsigned& nloc, unsigned& nx) {
    const unsigned G = gridDim.x * gridDim.y * gridDim.z;
    unsigned sum, cnt, mine, sp = 0u;
    for (;;) {
        sum = 0u; cnt = 0u; mine = 0u;
#pragma unroll
        for (unsigned j = 0; j < 16; ++j) { const unsigned c = xb_ld(&bar[XB_XCNT(j)]); sum += c; cnt += (c > 0u) ? 1u : 0u; mine = (j == x) ? c : mine; }
        if (sum == G) break;
        __builtin_amdgcn_s_sleep(1);
        if ((++sp & 255u) == 0u) { if (xb_ld(&bar[XB_TMO])) break; if (sp > XB_SPIN_CAP) { atomicAdd(&bar[XB_TMO], 1u); break; } }
    }
    nloc = mine > 0u ? mine : 1u; nx = cnt > 0u ? cnt : 1u;
}

__device__ __forceinline__ void xcd_barrier(const XcdBarrier& b) {
    asm volatile("s_waitcnt vmcnt(0)" ::: "memory");
    __syncthreads();
    if (threadIdx.x == 0) {
        unsigned* bar = b.bar;
        __builtin_amdgcn_s_waitcnt(0);
        unsigned nloc = b.st[0], nx = b.st[1];
        if (nloc == 0u) { xcd_barrier_complete(bar, b.x, nloc, nx); b.st[0] = nloc; b.st[1] = nx; }
        const unsigned old = xb_add(&bar[XB_XSUB(b.x)], 1u);
        const unsigned gen = old / nloc;
        if (old + 1u == (gen + 1u) * nloc) {
            __builtin_amdgcn_fence(__ATOMIC_RELEASE, "agent");
            asm volatile("s_waitcnt vmcnt(0)" ::: "memory");
            const unsigned og = xb_add(&bar[XB_TOP], 1u);
            const unsigned tg = og / nx;
            if (og + 1u == (tg + 1u) * nx) xb_add(&bar[XB_TOPGEN], 1u);
            else XB_SPIN(xb_ld(&bar[XB_TOPGEN]) == tg, bar);
            __builtin_amdgcn_fence(__ATOMIC_ACQUIRE, "agent");
            xb_add(&bar[XB_XGEN(b.x)], 1u);
            asm volatile("s_waitcnt vmcnt(0)" ::: "memory");
        } else {
            XB_SPIN(xb_ld(&bar[XB_XGEN(b.x)]) == gen, bar);
            __builtin_amdgcn_fence(__ATOMIC_ACQUIRE, "agent");
            asm volatile("s_waitcnt vmcnt(0)" ::: "memory");
        }
    }
    __syncthreads();
}

namespace pg8 {
#define PG8_LAS __attribute__((address_space(3)))
typedef unsigned short bf16_t;
typedef short bf16x8 __attribute__((ext_vector_type(8)));
typedef float f32x4 __attribute__((ext_vector_type(4)));
typedef unsigned u32x4 __attribute__((ext_vector_type(4)));
constexpr int BM = 256, BK = 64, HALF = 128, HTB = HALF * BK * 2  , STAGE_BYTES = 8 * HTB, NXCD = 8, WGM = 8;

__host__ __device__ __forceinline__ int lds_byte(int r, int c) { const int st = (r >> 4) * 2 + (c >> 5), rr = r & 15, cc = c & 31, ob = rr * 64 + cc * 2; return st * 1024 + (ob ^ (((ob >> 9) & 1) << 5)); }
__host__ __device__ __forceinline__ void stage_rc(int b, int& R, int& C) { const int st = b / 1024, sb = b % 1024, swz = sb ^ (((sb >> 9) & 1) << 5); R = (st >> 1) * 16 + swz / 64; C = (st & 1) * 32 + (swz % 64) / 2; }
__host__ __device__ __forceinline__ int perm32(int rho) { const int n = rho >> 4, i = rho & 15; return 8 * (i >> 2) + 4 * n + (i & 3); }

struct Unit { int pm, pn, e; };
struct Gemm { const bf16_t* A; const bf16_t* Bt; int M, N, K; size_t estride; };

struct StaticOrder {
    static constexpr bool GATHER = false;
    int nM, nN, nwg, G, c;
    __host__ __device__ void init(int M, int N, int G_, int c_) { nM = M / BM; nN = N / BM; nwg = nM * nN; G = G_; c = c_; }
    __host__ __device__ bool next(int i, Unit& u) const {
        const long L = (long)i * G + c; if (L >= nwg) return false;
        int wgid = (int)L; { const int q = nwg / NXCD, r = nwg % NXCD, xcd = wgid % NXCD, off = wgid / NXCD; wgid = (xcd < r ? xcd * (q + 1) : r * (q + 1) + (xcd - r) * q) + off; }
        const int nig = WGM * nN, gid = wgid / nig, fm = gid * WGM, gsz = (nM - fm) < WGM ? (nM - fm) : WGM;
        u.pm = fm + ((wgid % nig) % gsz); u.pn = (wgid % nig) / gsz; u.e = 0; return true;
    }
    __device__ __forceinline__ void a_ready(const Unit&) const {}
    __device__ __forceinline__ void done(const Unit&) const {}
};
__device__ __forceinline__ unsigned cvt_pk_bf16(float lo, float hi) { unsigned r; asm volatile("v_cvt_pk_bf16_f32 %0, %1, %2" : "=v"(r) : "v"(lo), "v"(hi)); return r; }
typedef float f32x2 __attribute__((ext_vector_type(2)));
__device__ __forceinline__ f32x2 gelu_pk(f32x2 v) {
    const f32x2 av = __builtin_elementwise_abs(v), d = av * 0.2316418882f + 1.0f;
    f32x2 t; t.x = __builtin_amdgcn_rcpf(d.x); t.y = __builtin_amdgcn_rcpf(d.y);
    f32x2 q = t * 0.5307027145f + (-0.7265760135f); q = q * t + 0.7107068705f; q = q * t + (-0.142248368f); q = q * t + 0.127414796f; q = q * t;
    const f32x2 s = (v * v) * (-0.72134752044f);
    f32x2 e; e.x = __builtin_amdgcn_exp2f(s.x); e.y = __builtin_amdgcn_exp2f(s.y);
    const f32x2 m = v * (q * e), r = v - m;
    f32x2 o; o.x = v.x < 0.f ? m.x : r.x; o.y = v.y < 0.f ? m.y : r.y; return o;
}

struct EpiF32 {
    static constexpr bool PERM = false, AFTER_DRAIN = false;
    float* C; int ldc; const float* bias;
    __device__ __forceinline__ void operator()(const f32x4 (&acc)[2][2][4][2], const Unit& u, int wr, int wc, int fr, int fq) const {
        const int row0 = u.pm * BM + wr * 64 + fr, col0 = u.pn * BM + wc * 32 + 4 * fq;
        f32x4 bv[2][2];
#pragma unroll
        for (int bj = 0; bj < 2; ++bj)
#pragma unroll
            for (int n = 0; n < 2; ++n) bv[bj][n] = bias ? *(const f32x4*)(bias + col0 + bj * HALF + n * 16) : (f32x4){0.f, 0.f, 0.f, 0.f};
#pragma unroll
        for (int ai = 0; ai < 2; ++ai)
#pragma unroll
            for (int m = 0; m < 4; ++m) { float* rowp = C + (size_t)(row0 + ai * HALF + m * 16) * ldc + col0;
#pragma unroll
                for (int bj = 0; bj < 2; ++bj)
#pragma unroll
                    for (int n = 0; n < 2; ++n) *(f32x4*)(rowp + bj * HALF + n * 16) = acc[ai][bj][m][n] + bv[bj][n]; }
    }
};
template <int ACT  > struct EpiBf16 {
    static constexpr bool PERM = true, AFTER_DRAIN = false;
    bf16_t* O; int ldc; const float* bias; int split_cols; size_t split_stride;
    __device__ __forceinline__ void operator()(const f32x4 (&acc)[2][2][4][2], const Unit& u, int wr, int wc, int fr, int fq) const {
        const int row0 = u.pm * BM + wr * 64 + fr; int colt = u.pn * BM; bf16_t* base = O;
        if (split_cols) { const int t = colt / split_cols; base += (size_t)t * split_stride; colt -= t * split_cols; }
        const int col0 = colt + wc * 32 + 8 * fq, bcol0 = u.pn * BM + wc * 32 + 8 * fq;
        f32x4 bv[2][2];
#pragma unroll
        for (int bj = 0; bj < 2; ++bj)
#pragma unroll
            for (int n = 0; n < 2; ++n) bv[bj][n] = bias ? *(const f32x4*)(bias + bcol0 + bj * HALF + 4 * n) : (f32x4){0.f, 0.f, 0.f, 0.f};
#pragma unroll
        for (int ai = 0; ai < 2; ++ai)
#pragma unroll
            for (int m = 0; m < 4; ++m) { bf16_t* rowp = base + (size_t)(row0 + ai * HALF + m * 16) * ldc + col0;
#pragma unroll
                for (int bj = 0; bj < 2; ++bj) { f32x4 v0 = acc[ai][bj][m][0] + bv[bj][0], v1 = acc[ai][bj][m][1] + bv[bj][1];
                    if (ACT == 1) { f32x2 a = gelu_pk((f32x2){v0[0], v0[1]}), b = gelu_pk((f32x2){v0[2], v0[3]}), c = gelu_pk((f32x2){v1[0], v1[1]}), d = gelu_pk((f32x2){v1[2], v1[3]});
                        v0 = (f32x4){a.x, a.y, b.x, b.y}; v1 = (f32x4){c.x, c.y, d.x, d.y}; }
                    if (ACT == 2) {
#pragma unroll
                        for (int j = 0; j < 4; ++j) { v0[j] = 0.5f * v0[j] * (1.0f + erff(v0[j] * 0.70710678f)); v1[j] = 0.5f * v1[j] * (1.0f + erff(v1[j] * 0.70710678f)); } }
                    u32x4 w; w.x = cvt_pk_bf16(v0[0], v0[1]); w.y = cvt_pk_bf16(v0[2], v0[3]); w.z = cvt_pk_bf16(v1[0], v1[1]); w.w = cvt_pk_bf16(v1[2], v1[3]);
                    *(u32x4*)(rowp + bj * HALF) = w; } }
    }
};

template <class Epi, class Sched, bool STAMP = false>
__device__ __forceinline__ void gemm_phase(PG8_LAS unsigned char* lds, const Gemm g, const Sched& S, const Epi& E, unsigned long long* stamps) {
    int tid_ = threadIdx.x; asm volatile("" : "+v"(tid_));
    const int tid = tid_, wid = __builtin_amdgcn_readfirstlane(tid >> 6), lane = tid & 63, wr = wid >> 2, wc = wid & 3, fr = lane & 15, fq = lane >> 4;
    const int K = g.K, nt = K / BK;
    constexpr bool GATHER = Sched::GATHER;
    int ts_lo = 0, ts_hi = 0, nts = 0; const unsigned long long rt_entry = STAMP ? (unsigned long long)wall_clock64() : 0ull;
#define PG8_STAMP() do { if (STAMP && wid == 0 && nts < 64) { const unsigned long long _c = (unsigned long long)clock64(); \
        ts_lo = (lane == nts) ? (int)(unsigned)_c : ts_lo; ts_hi = (lane == nts) ? (int)(unsigned)(_c >> 32) : ts_hi; ++nts; } } while (0)
    PG8_STAMP();
    unsigned voffA[2], voffB[2]; int rowA[2];
#pragma unroll
    for (int i = 0; i < 2; ++i) { int R, C; stage_rc(tid * 16 + i * 8192, R, C); const int Rb = Epi::PERM ? ((R & ~31) + perm32(R & 31)) : R;
        rowA[i] = R; voffA[i] = GATHER ? (unsigned)C * 2u : (unsigned)(R * K + C) * 2u; voffB[i] = (unsigned)(Rb * K + C) * 2u; }
    const size_t kstep = (size_t)(BK * 2);
    const size_t hstep = (size_t)HALF * K * 2;
    const size_t tstep = 2 * hstep;
    const unsigned ldsw = (unsigned)wid * 1024u;
    const int aoff = lds_byte(wr * 64 + fr, fq * 8), boff = lds_byte(wc * 32 + fr, fq * 8);
#define PG8_SA(b, h) (((b) * 2 + (h)) * HTB)
#define PG8_SB(b, h) ((4 + (b) * 2 + (h)) * HTB)
#define PG8_STAGE(bufoff, gbase, voff) do { _Pragma("unroll") for (int _i = 0; _i < 2; ++_i) \
        __builtin_amdgcn_global_load_lds((const unsigned*)((const char*)(gbase) + (voff)[_i]), (PG8_LAS unsigned*)(lds + (bufoff) + ldsw + _i * 8192), 16, 0, 0); } while (0)
#define PG8_STAGE_A(bufoff, gbase, h, gv) do { if constexpr (GATHER) { PG8_STAGE(bufoff, gbase, (gv)[h]); } else { PG8_STAGE(bufoff, (gbase) + (h) * hstep, voffA); } } while (0)
#define PG8_TOKSLOT(s) ((PG8_LAS int*)(lds + STAGE_BYTES + 1024 + ((s) & 1) * 1024))
#define PG8_LDA(dst, b, h) do { _Pragma("unroll") for (int m = 0; m < 4; ++m) _Pragma("unroll") for (int k = 0; k < 2; ++k) dst[m][k] = *(const PG8_LAS bf16x8*)(lds + PG8_SA(b, h) + aoff + m * 2048 + k * 1024); } while (0)
#define PG8_LDB(dst, b, h) do { _Pragma("unroll") for (int n = 0; n < 2; ++n) _Pragma("unroll") for (int k = 0; k < 2; ++k) dst[n][k] = *(const PG8_LAS bf16x8*)(lds + PG8_SB(b, h) + boff + n * 2048 + k * 1024); } while (0)
#define PG8_MMA(ai, bj, At, Bt) do { __builtin_amdgcn_s_setprio(1); _Pragma("unroll") for (int m = 0; m < 4; ++m) _Pragma("unroll") for (int n = 0; n < 2; ++n) _Pragma("unroll") for (int k = 0; k < 2; ++k) \
        acc[ai][bj][m][n] = __builtin_amdgcn_mfma_f32_16x16x32_bf16(Bt[n][k], At[m][k], acc[ai][bj][m][n], 0, 0, 0); __builtin_amdgcn_s_setprio(0); } while (0)
#define PG8_WAIT_V(n) asm volatile("s_waitcnt vmcnt(" #n ")" ::: "memory")
#define PG8_WAIT_L(n) asm volatile("s_waitcnt lgkmcnt(" #n ")" ::: "memory")
#define PG8_BAR __builtin_amdgcn_s_barrier()
#define PG8_SCHED __builtin_amdgcn_sched_barrier(0)
    Unit cur, nxt; int ui = 0;
    if (!S.next(0, cur)) return;
    f32x4 acc[2][2][4][2];
#pragma unroll
    for (int a = 0; a < 2; ++a)
#pragma unroll
        for (int b = 0; b < 2; ++b)
#pragma unroll
            for (int m = 0; m < 4; ++m)
#pragma unroll
                for (int n = 0; n < 2; ++n) acc[a][b][m][n] = (f32x4){0.f, 0.f, 0.f, 0.f};
    bf16x8 At[4][2], B0[2][2], B1[2][2];
    const char* cA = (const char*)g.A + (GATHER ? (size_t)0 : (size_t)cur.pm * tstep); const char* cB = (const char*)g.Bt + (size_t)cur.pn * tstep + (size_t)cur.e * g.estride * 2;
    S.a_ready(cur);
    unsigned gcur[2][2], gnxt[2][2], gs[2][2];
    if constexpr (GATHER) {
        if (tid < 256) PG8_TOKSLOT(0)[tid] = S.tok[cur.pm * 256 + tid];
        __syncthreads();
#pragma unroll
        for (int h = 0; h < 2; ++h)
#pragma unroll
            for (int i = 0; i < 2; ++i) { gcur[h][i] = (unsigned)PG8_TOKSLOT(0)[h * HALF + rowA[i]] * (unsigned)(K * 2) + voffA[i]; gnxt[h][i] = gcur[h][i]; gs[h][i] = gcur[h][i]; }
    }
    PG8_STAGE(PG8_SB(0, 0), cB, voffB); PG8_STAGE_A(PG8_SA(0, 0), cA, 0, gcur); PG8_STAGE(PG8_SB(0, 1), cB + hstep, voffB); PG8_STAGE_A(PG8_SA(0, 1), cA, 1, gcur);
    if (wr == 1) PG8_BAR;
    PG8_WAIT_V(4); PG8_BAR;
    PG8_STAGE(PG8_SB(1, 0), cB + kstep, voffB); PG8_STAGE_A(PG8_SA(1, 0), cA + kstep, 0, gcur); PG8_STAGE(PG8_SB(1, 1), cB + hstep + kstep, voffB);
    PG8_WAIT_V(6); PG8_BAR;
    PG8_STAMP();
    for (;;) {
        const bool has_next = S.next(ui + 1, nxt);
        if constexpr (GATHER) { if (has_next && wid < 4)
            __builtin_amdgcn_global_load_lds((const unsigned*)(S.tok + nxt.pm * 256 + wid * 64 + lane), (PG8_LAS unsigned*)((PG8_LAS unsigned char*)PG8_TOKSLOT(ui + 1) + wid * 256), 4, 0, 0); }
        const char* nA = GATHER ? (const char*)g.A : has_next ? (const char*)g.A + (size_t)nxt.pm * tstep : cA; const char* nB = has_next ? (const char*)g.Bt + (size_t)nxt.pn * tstep + (size_t)nxt.e * g.estride * 2 : cB;
        for (int t = 0; t < nt; t += 2) {
            const bool last = (t == nt - 2);
            const char* a1 = cA + (size_t)(t + 1) * kstep;
            const char* a2 = last ? nA : cA + (size_t)(t + 2) * kstep; const char* b2 = last ? nB : cB + (size_t)(t + 2) * kstep;
            const char* a3 = a2 + kstep; const char* b3 = b2 + kstep;
            if (last && has_next) S.a_ready(nxt);
            if constexpr (GATHER) {
                if (last && has_next) {
#pragma unroll
                    for (int h = 0; h < 2; ++h)
#pragma unroll
                        for (int i = 0; i < 2; ++i) gnxt[h][i] = (unsigned)PG8_TOKSLOT(ui + 1)[h * HALF + rowA[i]] * (unsigned)(K * 2) + voffA[i];
                }
#pragma unroll
                for (int h = 0; h < 2; ++h)
#pragma unroll
                    for (int i = 0; i < 2; ++i) gs[h][i] = last ? gnxt[h][i] : gcur[h][i];
            }
            PG8_LDB(B0, 0, 0); PG8_SCHED; PG8_LDA(At, 0, 0); PG8_STAGE_A(PG8_SA(1, 1), a1, 1, gcur);
            PG8_WAIT_L(8); PG8_BAR; PG8_WAIT_L(0); PG8_MMA(0, 0, At, B0); PG8_BAR; PG8_SCHED;
            PG8_LDB(B1, 0, 1); PG8_STAGE(PG8_SB(0, 0), b2, voffB);
            PG8_BAR; PG8_WAIT_L(0); PG8_MMA(0, 1, At, B1); PG8_BAR;
            PG8_LDA(At, 0, 1); PG8_STAGE_A(PG8_SA(0, 0), a2, 0, gs);
            PG8_BAR; PG8_WAIT_L(0); PG8_MMA(1, 0, At, B0); PG8_BAR; PG8_SCHED;
            PG8_STAGE(PG8_SB(0, 1), b2 + hstep, voffB);
            PG8_WAIT_V(6); PG8_BAR; PG8_MMA(1, 1, At, B1); PG8_BAR;
            PG8_LDB(B0, 1, 0); PG8_SCHED; PG8_LDA(At, 1, 0); PG8_STAGE_A(PG8_SA(0, 1), a2, 1, gs);
            PG8_WAIT_L(8); PG8_BAR; PG8_WAIT_L(0); PG8_MMA(0, 0, At, B0); PG8_BAR; PG8_SCHED;
            PG8_LDB(B1, 1, 1); PG8_STAGE(PG8_SB(1, 0), b3, voffB);
            PG8_BAR; PG8_WAIT_L(0); PG8_MMA(0, 1, At, B1); PG8_BAR;
            PG8_LDA(At, 1, 1); PG8_STAGE_A(PG8_SA(1, 0), a3, 0, gs);
            PG8_BAR; PG8_WAIT_L(0); PG8_MMA(1, 0, At, B0); PG8_BAR; PG8_SCHED;
            PG8_STAGE(PG8_SB(1, 1), b3 + hstep, voffB);
            PG8_WAIT_V(6); PG8_BAR; PG8_MMA(1, 1, At, B1); PG8_BAR;
        }
        PG8_STAMP();
        if constexpr (!Epi::AFTER_DRAIN) { E(acc, cur, wr, wc, fr, fq); S.done(cur); }
        PG8_STAMP();
        if (!has_next) break;
#pragma unroll
        for (int a = 0; a < 2; ++a)
#pragma unroll
            for (int b = 0; b < 2; ++b)
#pragma unroll
                for (int m = 0; m < 4; ++m)
#pragma unroll
                    for (int n = 0; n < 2; ++n) acc[a][b][m][n] = (f32x4){0.f, 0.f, 0.f, 0.f};
        cur = nxt; cA = nA; cB = nB; ++ui;
        if constexpr (GATHER) {
#pragma unroll
            for (int h = 0; h < 2; ++h)
#pragma unroll
                for (int i = 0; i < 2; ++i) gcur[h][i] = gnxt[h][i];
        }
    }
    PG8_WAIT_V(0);
    if (wr == 0) PG8_BAR;
    PG8_BAR;
    if constexpr (Epi::AFTER_DRAIN) { E.fused(acc, cur, wr, wc, fr, fq, lds, wid, lane); S.done(cur); }
    PG8_STAMP();
    if (STAMP && wid == 0) { stamps[lane] = lane < nts ? (((unsigned long long)(unsigned)ts_hi << 32) | (unsigned)ts_lo) : 0ull;
        if (lane == 62) stamps[62] = rt_entry; if (lane == 63) stamps[63] = (unsigned long long)wall_clock64(); }
#undef PG8_STAMP
#undef PG8_SA
#undef PG8_SB
#undef PG8_STAGE
#undef PG8_STAGE_A
#undef PG8_TOKSLOT
#undef PG8_LDA
#undef PG8_LDB
#undef PG8_MMA
#undef PG8_WAIT_V
#undef PG8_WAIT_L
#undef PG8_BAR
#undef PG8_SCHED
}
}
namespace pg8 {
struct EpiRes {
    static constexpr bool PERM = true, AFTER_DRAIN = false;
    const void* base_lat; const float* base_ctx; void* out_lat; float* out_ctx; const float* gvec; bool base_bf, out_bf;
    __device__ __forceinline__ void operator()(const f32x4 (&acc)[2][2][4][2], const Unit& u, int wr, int wc, int fr, int fq) const {
        const bool isctx = u.pm >= 128;
        const int prow = (isctx ? (u.pm - 128) : u.pm) * BM;
        const float* base = isctx ? base_ctx : (const float*)base_lat; float* out = isctx ? out_ctx : (float*)out_lat;
        const bool bbf = !isctx && base_bf, obf = !isctx && out_bf;
        const float* gv = gvec + (size_t)(isctx ? 8 : (u.pm >> 4)) * 6144;
        const int row0 = prow + wr * 64 + fr, col0 = u.pn * BM + wc * 32 + 8 * fq;
        f32x4 gvv[2][2];
#pragma unroll
        for (int bj = 0; bj < 2; ++bj)
#pragma unroll
            for (int n = 0; n < 2; ++n) gvv[bj][n] = *(const f32x4*)(gv + col0 + bj * HALF + 4 * n);
#pragma unroll
        for (int ai = 0; ai < 2; ++ai)
#pragma unroll
            for (int m = 0; m < 4; ++m) { const size_t off = (size_t)(row0 + ai * HALF + m * 16) * 1024 + col0;
#pragma unroll
                for (int bj = 0; bj < 2; ++bj) { const size_t o2 = off + bj * HALF;
                    f32x4 b0, b1;
                    if (bbf) { const v4u r = *(const v4u*)((const bf16*)base_lat + o2); b0 = (f32x4){bflo(r.x), bfhi(r.x), bflo(r.y), bfhi(r.y)}; b1 = (f32x4){bflo(r.z), bfhi(r.z), bflo(r.w), bfhi(r.w)}; }
                    else { b0 = *(const f32x4*)(base + o2); b1 = *(const f32x4*)(base + o2 + 4); }
                    const f32x4 v0 = b0 + gvv[bj][0] * acc[ai][bj][m][0], v1 = b1 + gvv[bj][1] * acc[ai][bj][m][1];
                    if (obf) { v4u w; w.x = pk2(v0.x, v0.y); w.y = pk2(v0.z, v0.w); w.z = pk2(v1.x, v1.y); w.w = pk2(v1.z, v1.w); *(v4u*)((bf16*)out_lat + o2) = w; }
                    else { *(f32x4*)(out + o2) = v0; *(f32x4*)(out + o2 + 4) = v1; } } }
    }
};
struct EpiSwiglu {
    static constexpr bool PERM = true, AFTER_DRAIN = false;
    bf16_t* O; int ldc;
    __device__ __forceinline__ void operator()(const f32x4 (&acc)[2][2][4][2], const Unit& u, int wr, int wc, int fr, int fq) const {
        const int row0 = u.pm * BM + wr * 64 + fr, col0 = u.pn * HALF + wc * 32 + 8 * fq;
#pragma unroll
        for (int ai = 0; ai < 2; ++ai)
#pragma unroll
            for (int m = 0; m < 4; ++m) { bf16_t* rowp = O + (size_t)(row0 + ai * HALF + m * 16) * ldc + col0;
                float h[8];
#pragma unroll
                for (int n = 0; n < 2; ++n)
#pragma unroll
                    for (int j = 0; j < 4; ++j) { const float g = acc[ai][0][m][n][j], up = acc[ai][1][m][n][j]; h[n * 4 + j] = g * __builtin_amdgcn_rcpf(1.0f + __expf(-g)) * up; }
                u32x4 w; w.x = cvt_pk_bf16(h[0], h[1]); w.y = cvt_pk_bf16(h[2], h[3]); w.z = cvt_pk_bf16(h[4], h[5]); w.w = cvt_pk_bf16(h[6], h[7]);
                *(u32x4*)rowp = w; }
    }
};
struct MoeOrder {
    static constexpr bool GATHER = false;
    int nN, G, c, nunits; const int* tab;
    __device__ void init(const int* tab_, int nN_, int G_, int c_) { tab = tab_; nN = nN_; G = G_; c = c_; nunits = tab_[0] * nN_; }
    __device__ bool next(int i, Unit& u) const {
        const int L = i * G + c; if (L >= nunits) return false;
        const int q = nunits / NXCD, r = nunits % NXCD, xcd = L % NXCD, off = L / NXCD;
        const int w = (xcd < r ? xcd * (q + 1) : r * (q + 1) + (xcd - r) * q) + off;
        u.pm = w / nN; u.pn = w - u.pm * nN; u.e = tab[1 + u.pm]; return true;
    }
    __device__ __forceinline__ void a_ready(const Unit&) const {}
    __device__ __forceinline__ void done(const Unit&) const {}
};
struct MoeOrderG : MoeOrder { static constexpr bool GATHER = true; const int* tok; };
}
enum { I_X = 0, I_C, I_CTX, I_CCTX, I_MODW, I_MODB, I_NMIXG, I_NFFNG, I_WIN, I_WOUT, I_LCW, I_LCB, I_LWA, I_LBA, I_LWX, I_LBX, I_LLAM,
       I_RMU, I_RWUP, I_RW0, I_RAUP, I_RA0, I_RGUP, I_RKK, I_RKA, I_RRK, I_RLNG, I_RLNB, I_MIB, I_MFB, I_MNG, I_GCW, I_GALOG, I_GDTB, I_GNG,
       I_FWG, I_FWU, I_FWD, I_MROUTER, I_MWG, I_MWU, I_MWD, I_FNG, N_IN };
struct Args { const float* in[N_IN]; float* out; unsigned char* ws; int ph_lo, ph_hi; };
struct Ctx {
    const float* const* in; float* out; unsigned char* ws; LAS unsigned char* lds;
    int tid, lane, wave, G, wg;
};
#define WSP(T, off) ((T*)(C.ws + (off)))

__device__ __forceinline__ int seqrow_raster(int i, int d, int b) {
    if (i < CTXL) { const int p = d ? (CTXL - 1 - i) : i; return T_LAT + b * CTXL + p; }
    const int j = i - CTXL; const int p = d ? (SEQ - 1 - j) : j; return b * SEQ + p;
}
__device__ __forceinline__ int seqrow_cm(int i, int d, int b) {
    if (i < CTXL) { const int p = d ? (CTXL - 1 - i) : i; return T_LAT + b * CTXL + p; }
    const int j = i - CTXL; const int p = d ? (SEQ - 1 - j) : j; return b * SEQ + (p & 63) * 64 + (p >> 6);
}

__device__ __forceinline__ void phase_pre(const Ctx& C) {
    LAS float* sc = (LAS float*)C.lds;
    LAS float* red = sc + 9 * 1024;
    float* modv = WSP(float, WS_MODV);
    bool filled = false;
    for (int it = C.wg; it < DEPTH * 48; it += C.G) {
        if (!filled) {
            for (int i = C.tid; i < 9 * 1024; i += NTHR) { const float v = i < 8192 ? C.in[I_C][i] : C.in[I_CCTX][i - 8192]; sc[i] = siluf_(v); }
            filled = true; __syncthreads();
        }
        const int l = it / 48, jb = it % 48, col = C.tid & 127, kg = C.tid >> 7;
        const float* W = C.in[I_MODW] + (size_t)l * 1024 * 6144 + jb * 128 + col;
        float acc[9];
#pragma unroll
        for (int r = 0; r < 9; ++r) acc[r] = 0.f;
        for (int k = kg * 256; k < kg * 256 + 256; ++k) { const float w = W[(size_t)k * 6144];
#pragma unroll
            for (int r = 0; r < 9; ++r) acc[r] += sc[r * 1024 + k] * w; }
#pragma unroll
        for (int r = 0; r < 9; ++r) red[(kg * 9 + r) * 128 + col] = acc[r];
        __syncthreads();
        for (int i = C.tid; i < 9 * 128; i += NTHR) { const int r = i >> 7, cc = i & 127;
            const float s = red[(0 * 9 + r) * 128 + cc] + red[(1 * 9 + r) * 128 + cc] + red[(2 * 9 + r) * 128 + cc] + red[(3 * 9 + r) * 128 + cc];
            modv[((size_t)l * 9 + r) * 6144 + jb * 128 + cc] = s + C.in[I_MODB][l * 6144 + jb * 128 + cc]; }
        __syncthreads();
    }
}

__device__ __forceinline__ void tr_item(const float* src, size_t ld, int k0, int ns0, bf16* dst, int drow0, int Kd, LAS float* scr, int lane, bool zero) {
    if (!zero) {
#pragma unroll 8
        for (int i = 0; i < 32; ++i) { const int kk = 2 * i + (lane >> 5); scr[kk * 33 + (lane & 31)] = src[(size_t)(k0 + kk) * ld + ns0 + (lane & 31)]; }
    }
    LDS_WAIT(); asm volatile("" ::: "memory");
    const int c = lane & 7;
#pragma unroll
    for (int j = 0; j < 4; ++j) { const int n = (lane >> 3) + 8 * j; const LAS float* s = scr + (8 * c) * 33 + n;
        v4u o; o.x = pk2(s[0 * 33], s[1 * 33]); o.y = pk2(s[2 * 33], s[3 * 33]); o.z = pk2(s[4 * 33], s[5 * 33]); o.w = pk2(s[6 * 33], s[7 * 33]);
        if (zero) o = (v4u){0u, 0u, 0u, 0u};
        *(v4u*)(dst + (size_t)(drow0 + n) * Kd + k0 + 8 * c) = o; }
    LDS_WAIT(); asm volatile("" ::: "memory");
}
__device__ __forceinline__ void convert_small(const Ctx& C, int l) {
    {
        bf16* lw = WSP(bf16, WS_LRUWT);
        for (int k = 0; k < 2 * 2 * 4 * 4096 / (128 * NTHR); ++k) {
            const int e = k * 128 * NTHR + C.wg * NTHR + C.tid;
            if (C.wg < 128) {
            const int i = e & 63, j = (e >> 6) & 63, hd = (e >> 12) & 3, g = (e >> 14) & 1, d = e >> 15;
            const float* src = (g ? C.in[I_LWX] : C.in[I_LWA]) + ((size_t)((l * 2 + d) * 4 + hd) * 64 + i) * 64 + j;
            lw[e] = (bf16)f2bf(*src);
            }
        }
    }
    if (C.wg >= 128 && C.wg < 224) {
        bf16* rw = WSP(bf16, WS_RWT);
        const int e = (C.wg - 128) * NTHR + C.tid;
        if (e < 32768) { const int r = e & 31, ch = (e >> 5) & 255, d = (e >> 13) & 1, isa = e >> 14;
            rw[e] = (bf16)f2bf((isa ? C.in[I_RAUP] : C.in[I_RWUP])[((size_t)(l * 2 + d) * 32 + r) * GW + ch]); }
        else { const int e2 = e - 32768, j = e2 & 63, ch = e2 >> 6; rw[e] = (bf16)f2bf(C.in[I_RGUP][((size_t)l * 64 + j) * GW + ch]); }
    }
}
__device__ __forceinline__ void convert_items(const Ctx& C, int l, int what, int gw, int NGW) {
    LAS float* scr = (LAS float*)(C.lds + C.wave * 8704);
    constexpr int I_IN = 16 * 112, I_OUT = 16 * 32, I_GU = 16 * 176, I_DN = 44 * 32, I_E = 16 * 88 + 22 * 32;
    const bool moe = l & 1; const int li = l >> 1;
    const int lo_it = (what & 1) ? 0 : I_IN, hi_it = (what & 2) ? I_IN + I_OUT + (moe ? NE * I_E : (I_GU + I_DN)) : I_IN;
    bf16* win = WSP(bf16, WS_WIN); bf16* wout = WSP(bf16, WS_WOUT); bf16* wgu = WSP(bf16, WS_WGU); bf16* wdn = WSP(bf16, WS_WDN);
    for (int it = lo_it + gw; it < hi_it; it += NGW) {
        int r = it;
        if (r < I_IN) { const int kb = r / 112, nb = r % 112; tr_item(C.in[I_WIN] + (size_t)l * 1024 * IN_COLS, IN_COLS, 64 * kb, 32 * nb, win, 32 * nb, 1024, scr, C.lane, nb == 111); continue; }
        r -= I_IN;
        if (r < I_OUT) { const int kb = r / 32, nb = r % 32; tr_item(C.in[I_WOUT] + (size_t)l * 1024 * 1024, 1024, 64 * kb, 32 * nb, wout, 32 * nb, 1024, scr, C.lane, false); continue; }
        r -= I_OUT;
        if (!moe) {
            if (r < I_GU) { const int kb = r / 176, nb = r % 176, tile = nb >> 3, q = nb & 7;
                const float* src = (q < 4 ? C.in[I_FWG] : C.in[I_FWU]) + (size_t)li * 1024 * DFF;
                tr_item(src, DFF, 64 * kb, tile * 128 + (q & 3) * 32, wgu, 32 * nb, 1024, scr, C.lane, false); continue; }
            r -= I_GU;
            { const int kb = r / 32, nb = r % 32; tr_item(C.in[I_FWD] + (size_t)li * DFF * 1024, 1024, 64 * kb, 32 * nb, wdn, 32 * nb, DFF, scr, C.lane, false); }
        } else {
            const int e = r / I_E; int rr = r % I_E;
            if (rr < 16 * 88) { const int kb = rr / 88, nb = rr % 88, tile = nb >> 3, q = nb & 7;
                const float* src = (q < 4 ? C.in[I_MWG] : C.in[I_MWU]) + ((size_t)li * NE + e) * 1024 * DFE;
                tr_item(src, DFE, 64 * kb, tile * 128 + (q & 3) * 32, wgu + (size_t)e * 2 * DFE * 1024, 32 * nb, 1024, scr, C.lane, false); continue; }
            rr -= 16 * 88;
            { const int kb = rr / 32, nb = rr % 32; tr_item(C.in[I_MWD] + ((size_t)li * NE + e) * DFE * 1024, 1024, 64 * kb, 32 * nb, wdn + (size_t)e * 1024 * DFE, 32 * nb, DFE, scr, C.lane, false); }
        }
    }
}

template <bool ROUTE>
__device__ __forceinline__ void norm_rows(const Ctx& C, int l, const void* xlat, bool xbf, const float* xctx, const float* gain, int shoff, int scoff, int nrows, int moe_li) {
    const float* modv = WSP(float, WS_MODV) + (size_t)l * 9 * 6144;
    bf16* hb = WSP(bf16, WS_HB);
    const int gw = C.wg * NWAVES + C.wave, NGW = C.G * NWAVES;
    LAS unsigned* lcnt = (LAS unsigned*)(C.lds + 65536);
    unsigned* route = WSP(unsigned, WS_ROUTE);
    if (ROUTE) { if (C.tid < 8) lcnt[C.tid] = 0u; __syncthreads(); }
    f32x4 gv[4];
#pragma unroll
    for (int j = 0; j < 4; ++j) gv[j] = *(const f32x4*)(gain + 4 * C.lane + 256 * j);
    for (int m = gw; m < nrows; m += NGW) {
        const bool isctx = m >= T_LAT;
        const float* xr = isctx ? xctx + (size_t)(m - T_LAT) * 1024 : (const float*)xlat + (size_t)m * 1024; const bf16* xrb = (const bf16*)xlat + (size_t)m * 1024; const bool rbf = xbf && !isctx;
        const float* mv = modv + (size_t)(isctx ? 8 : (m >> 12)) * 6144;
        f32x4 v[4]; float s = 0.f;
#pragma unroll
        for (int j = 0; j < 4; ++j) { v[j] = rbf ? ld4bf(xrb + 4 * C.lane + 256 * j) : *(const f32x4*)(xr + 4 * C.lane + 256 * j); s += (v[j].x * v[j].x + v[j].y * v[j].y) + (v[j].z * v[j].z + v[j].w * v[j].w); }
        const float rs = rsqrtf_(wave_sum(s) * (1.0f / 1024.0f) + 1e-6f);
#pragma unroll
        for (int j = 0; j < 4; ++j) { const f32x4 sh = *(const f32x4*)(mv + shoff + 4 * C.lane + 256 * j), scl = *(const f32x4*)(mv + scoff + 4 * C.lane + 256 * j);
            v[j] = (v[j] * rs * gv[j]) * (scl + 1.0f) + sh;
            v2u o; o.x = pk2(v[j].x, v[j].y); o.y = pk2(v[j].z, v[j].w);
            *(v2u*)(hb + (size_t)m * 1024 + 4 * C.lane + 256 * j) = o; }
        if (ROUTE) {
            const float* rt = C.in[I_MROUTER] + (size_t)moe_li * 1024 * NE;
            float lg[8];
#pragma unroll
            for (int e = 0; e < 8; ++e) lg[e] = 0.f;
#pragma unroll
            for (int j = 0; j < 4; ++j)
#pragma unroll
                for (int q = 0; q < 4; ++q) { const int k = 4 * C.lane + 256 * j + q; const f32x4 r0 = *(const f32x4*)(rt + (size_t)k * 8), r1 = *(const f32x4*)(rt + (size_t)k * 8 + 4); const float hv = v[j][q];
                    lg[0] += hv * r0.x; lg[1] += hv * r0.y; lg[2] += hv * r0.z; lg[3] += hv * r0.w; lg[4] += hv * r1.x; lg[5] += hv * r1.y; lg[6] += hv * r1.z; lg[7] += hv * r1.w; }
#pragma unroll
            for (int e = 0; e < 8; ++e) lg[e] = wave_sum(lg[e]);
            int e0 = 0; float l0 = lg[0];
#pragma unroll
            for (int e = 1; e < 8; ++e) if (lg[e] > l0) { l0 = lg[e]; e0 = e; }
            int e1 = (e0 == 0) ? 1 : 0; float l1 = -3.0e38f;
#pragma unroll
            for (int e = 0; e < 8; ++e) if (e != e0 && lg[e] > l1) { l1 = lg[e]; e1 = e; }
            const float w0 = __builtin_amdgcn_rcpf(1.0f + __expf(l1 - l0)), w1 = 1.0f - w0;
            if (C.lane == 0) {
                const unsigned r0 = atomicAdd((unsigned*)&lcnt[e0], 1u), r1 = atomicAdd((unsigned*)&lcnt[e1], 1u);
                v4u a; a.x = (unsigned)e0; a.y = (unsigned)e1; a.z = r0; a.w = r1;
                *(v4u*)(route + (size_t)m * 8) = a;
                v2u b; b.x = __builtin_bit_cast(unsigned, w0); b.y = __builtin_bit_cast(unsigned, w1);
                *(v2u*)(route + (size_t)m * 8 + 4) = b;
            }
        }
    }
    if (ROUTE) {
        __syncthreads();
        if (C.tid < 8) { unsigned* gc = WSP(unsigned, WS_CTL) + CW_MOECNT + 64 * moe_li; const unsigned base = atomicAdd(gc + C.tid, lcnt[C.tid]); WSP(unsigned, WS_WGBASE)[C.wg * 8 + C.tid] = base; }
    }
}
#define RAW_BARRIER() do { asm volatile("s_waitcnt lgkmcnt(0)" ::: "memory"); __builtin_amdgcn_s_barrier(); asm volatile("" ::: "memory"); } while (0)
__device__ __forceinline__ void gdn_prep(const Ctx& C, int l, int b, int c) {
    const bf16* P = WSP(const bf16, WS_P); bf16* gq = WSP(bf16, WS_GQ);
    const bool isctx = c < 4; const int p0 = isctx ? c * 64 : (c - 4) * 64; const int Lp = isctx ? CTXL : SEQ;
    const int ch = 4 * C.lane;
    auto rowof = [&](int p) -> int { return isctx ? (T_LAT + b * CTXL + p) : (b * SEQ + (p & 63) * 64 + (p >> 6)); };
    f32x4 cw[4][3], x[4][3];
#pragma unroll
    for (int j = 0; j < 4; ++j)
#pragma unroll
        for (int g = 0; g < 3; ++g) cw[j][g] = *(const f32x4*)(C.in[I_GCW] + ((size_t)l * 4 + j) * 768 + g * 256 + ch);
    const int tb = p0 + C.wave * 8;
    auto ldrow = [&](int p, f32x4 (&dst)[3]) {
        if (p >= 0 && p < Lp) { const bf16* pr = P + (size_t)rowof(p) * PLD + OFF_D + ch;
#pragma unroll
            for (int g = 0; g < 3; ++g) dst[g] = ld4bf(pr + g * 256); }
        else {
#pragma unroll
            for (int g = 0; g < 3; ++g) dst[g] = (f32x4){0.f, 0.f, 0.f, 0.f}; }
    };
    ldrow(tb - 2, x[0]); ldrow(tb - 1, x[1]); ldrow(tb, x[2]);
#pragma unroll
    for (int t = 0; t < 8; ++t) {
        ldrow(tb + t + 1, x[3]);
        bf16* orow = gq + (size_t)rowof(tb + t) * 768 + ch;
#pragma unroll
        for (int g = 0; g < 3; ++g) {
            f32x4 v = cw[0][g] * x[0][g] + cw[1][g] * x[1][g] + cw[2][g] * x[2][g] + cw[3][g] * x[3][g];
            v = (f32x4){siluf_(v.x), siluf_(v.y), siluf_(v.z), siluf_(v.w)};
            if (g < 2) { const float ss = row16_sum((v.x * v.x + v.y * v.y) + (v.z * v.z + v.w * v.w)); v = v * (rsqrtf_(ss + 1e-6f) * (g == 0 ? 0.125f : 1.0f)); }
            st4bf(orow + g * 256, v);
        }
#pragma unroll
        for (int g = 0; g < 3; ++g) { x[0][g] = x[1][g]; x[1][g] = x[2][g]; x[2][g] = x[3][g]; }
    }
}
__device__ __forceinline__ void finish_rows(const Ctx& C, int l, int nrows) {
    const bf16* P = WSP(const bf16, WS_P); bf16* yc = WSP(bf16, WS_HB);
    const bf16* ob = WSP(const bf16, WS_OUTB); const bf16* oc = WSP(const bf16, WS_OUTC); const bf16* od = WSP(const bf16, WS_OUTD);
    const bf16* gg = WSP(const bf16, WS_G); const float* bonus = WSP(const float, WS_BONUS);
    const float* mu = C.in[I_RMU] + (size_t)l * 2 * B_COLS;
    const int gw = C.wg * NWAVES + C.wave, NGW = C.G * NWAVES, lane = C.lane, ch = 4 * lane, hh = lane >> 4;
    const f32x4 lng = *(const f32x4*)(C.in[I_RLNG] + l * GW + ch), lnb = *(const f32x4*)(C.in[I_RLNB] + l * GW + ch);
    const f32x4 mng = *(const f32x4*)(C.in[I_MNG] + l * GW + ch), gng = *(const f32x4*)(C.in[I_GNG] + l * GW + ch);
    const f32x4 mu0 = *(const f32x4*)(mu + 512 + ch), mu1 = *(const f32x4*)(mu + B_COLS + 512 + ch);
    const size_t o2 = (size_t)T_ALL * 256;
#pragma unroll 2
    for (int m = gw; m < nrows; m += NGW) {
        const bool isctx = m >= T_LAT; const int Lp = isctx ? CTXL : SEQ; const int p = isctx ? ((m - T_LAT) & (CTXL - 1)) : (m & (SEQ - 1));
        const f32x4 yb = ld4bf(ob + (size_t)m * 256 + ch) + ld4bf(ob + o2 + (size_t)m * 256 + ch);
        const f32x4 ycv = ld4bf(oc + (size_t)m * 256 + ch) + ld4bf(oc + o2 + (size_t)m * 256 + ch);
        const f32x4 yd = ld4bf(od + (size_t)m * 256 + ch) + ld4bf(od + o2 + (size_t)m * 256 + ch);
        const bf16* pr = P + (size_t)m * PLD;
        const f32x4 vs = ld4bf(WSP(const bf16, WS_RKV) + (size_t)m * 768 + 512 + ch);
        const f32x4 og = ld4bf(pr + OFF_C + 768 + ch), gd = ld4bf(pr + OFF_D + 768 + ch), gr = ld4bf(gg + (size_t)m * 256 + ch);
        const float bn = bonus[(size_t)m * 4 + hh];
        *(v2u*)(yc + (size_t)m * 1024 + ch) = *(const v2u*)(pr + 256 + ch);
        {
            const float mean = row16_sum((yb.x + yb.y) + (yb.z + yb.w)) * (1.0f / 64.0f);
            const f32x4 dl = yb - mean;
            const float var = row16_sum((dl.x * dl.x + dl.y * dl.y) + (dl.z * dl.z + dl.w * dl.w)) * (1.0f / 64.0f);
            const f32x4 yn = dl * rsqrtf_(var + 64e-5f) * lng + lnb;
            st4bf(yc + (size_t)m * 1024 + 256 + ch, (yn + vs * bn) * gr);
        }
        {
            const float ms = row16_sum((ycv.x * ycv.x + ycv.y * ycv.y) + (ycv.z * ycv.z + ycv.w * ycv.w)) * (1.0f / 64.0f);
            const f32x4 sg = (f32x4){sigmoidf_(og.x), sigmoidf_(og.y), sigmoidf_(og.z), sigmoidf_(og.w)};
            st4bf(yc + (size_t)m * 1024 + 512 + ch, ycv * rsqrtf_(ms + 1e-6f) * mng * sg);
        }
        {
            const float ms = row16_sum((yd.x * yd.x + yd.y * yd.y) + (yd.z * yd.z + yd.w * yd.w)) * (1.0f / 64.0f);
            const f32x4 sg = (f32x4){siluf_(gd.x), siluf_(gd.y), siluf_(gd.z), siluf_(gd.w)};
            st4bf(yc + (size_t)m * 1024 + 768 + ch, yd * rsqrtf_(ms + 1e-6f) * gng * sg);
        }
    }
}
typedef bf16x8 fragb;
__device__ __forceinline__ f32x4 mfma16(fragb a, fragb b, f32x4 c) { return __builtin_amdgcn_mfma_f32_16x16x32_bf16(a, b, c, 0, 0, 0); }
__device__ __forceinline__ fragb ld_frag16(const LAS bf16* p) { return *(const LAS fragb*)p; }
__device__ __forceinline__ fragb ld_frag8x2(const LAS bf16* p0, const LAS bf16* p1) {
    const v2u a = *(const LAS v2u*)p0, b = *(const LAS v2u*)p1; v4u r; r.x = a.x; r.y = a.y; r.z = b.x; r.w = b.y; return __builtin_bit_cast(fragb, r); }
__device__ __forceinline__ fragb pack_frag(const f32x4& lo, const f32x4& hi) { v4u r; r.x = pk2(lo.x, lo.y); r.y = pk2(lo.z, lo.w); r.z = pk2(hi.x, hi.y); r.w = pk2(hi.z, hi.w); return __builtin_bit_cast(fragb, r); }
__device__ __forceinline__ float wave_incl_sum(float v, int lane) {
    v += dpp_x<0x111, 0xF, true>(0.f, v); v += dpp_x<0x112, 0xF, true>(0.f, v); v += dpp_x<0x114, 0xF, true>(0.f, v); v += dpp_x<0x118, 0xF, true>(0.f, v);
    v += dpp_x<0x142, 0xA, false>(0.f, v); v += dpp_x<0x143, 0xC, false>(0.f, v);
    return v;
}
__device__ __forceinline__ float wave_incl_max(float v, int lane) {
    const float ninf = -3.0e38f;
    v = fmaxf(v, dpp_x<0x111, 0xF, false>(ninf, v)); v = fmaxf(v, dpp_x<0x112, 0xF, false>(ninf, v)); v = fmaxf(v, dpp_x<0x114, 0xF, false>(ninf, v)); v = fmaxf(v, dpp_x<0x118, 0xF, false>(ninf, v));
    v = fmaxf(v, dpp_x<0x142, 0xA, false>(ninf, v)); v = fmaxf(v, dpp_x<0x143, 0xC, false>(ninf, v));
    return v;
}
constexpr int MP = 72;
__device__ __forceinline__ void mlstm_chunked(const Ctx& C, int l, int idx) {
    const int d = idx >> 5, b = (idx >> 2) & 7, h = idx & 3, lane = C.lane, w = C.wave, l15 = lane & 15, q = lane >> 4;
    const int it = w & 3, vtp = w >> 2;
    constexpr int IMG = 64 * MP * 2, BUFB = 4 * IMG + 1024, CTB = 65 * MP * 2 + 16;
    LAS unsigned char* L0 = C.lds;
    const bf16* P = WSP(const bf16, WS_P); bf16* outc = WSP(bf16, WS_OUTC) + (size_t)d * T_ALL * 256;
    const float ib = C.in[I_MIB][(l * 2 + d) * NH + h], fb = C.in[I_MFB][(l * 2 + d) * NH + h];
    const int tt = C.tid >> 3, part = C.tid & 7;
    for (int i = C.tid; i < 2 * CTB / 4; i += NTHR) ((LAS unsigned*)(L0 + 2 * BUFB))[i] = 0u;
    v4u rq, rk, rv; unsigned short rgi, rgf;
    auto gload = [&](int n) {
        const int row = seqrow_cm(n * 64 + tt, d, b);
        const bf16* pp = P + (size_t)row * PLD + OFF_C + h * 64 + 8 * part;
        rq = *(const v4u*)pp; rk = *(const v4u*)(pp + 256); rv = *(const v4u*)(pp + 512);
        const bf16* pg = P + (size_t)seqrow_cm(n * 64 + lane, d, b) * PLD + OFF_C + 1024 + d * 4 + h;
        rgi = pg[0]; rgf = pg[8];
    };
    auto images = [&](int bufi) {
        LAS unsigned char* B0 = L0 + bufi * BUFB;
        LAS bf16* Qs = (LAS bf16*)B0; LAS bf16* Ks = Qs + 64 * MP; LAS bf16* VT = Ks + 64 * MP; LAS bf16* KTw = VT + 64 * MP; LAS float* vec = (LAS float*)(B0 + 4 * IMG);
        const float li = bf2f(rgi) + ib, lf = -softplusf_(-(bf2f(rgf) + fb));
        const float bc = wave_incl_sum(lf, lane), x = li - bc, cm = wave_incl_max(x, lane);
        const float wl = __expf(x - __shfl(cm, 63)) * 0.125f;
        if (w == 0) { vec[lane] = x; vec[64 + lane] = cm; vec[128 + lane] = bc; }
        const float wmine = __shfl(wl, 8 * w + (lane >> 3));
        *(LAS v4u*)(Qs + tt * MP + 8 * part) = rq; *(LAS v4u*)(Ks + tt * MP + 8 * part) = rk;
        const unsigned vv[4] = {rv.x, rv.y, rv.z, rv.w}, kk[4] = {rk.x, rk.y, rk.z, rk.w};
#pragma unroll
        for (int e = 0; e < 4; ++e) {
            VT[(8 * part + 2 * e) * MP + tt] = (bf16)(vv[e] & 0xffffu); VT[(8 * part + 2 * e + 1) * MP + tt] = (bf16)(vv[e] >> 16);
            KTw[(8 * part + 2 * e) * MP + tt] = (bf16)f2bf1(bflo(kk[e]) * wmine); KTw[(8 * part + 2 * e + 1) * MP + tt] = (bf16)f2bf1(bfhi(kk[e]) * wmine);
        }
    };
    f32x4 Cst[2], nst; float m = 0.f;
    Cst[0] = Cst[1] = nst = (f32x4){0.f, 0.f, 0.f, 0.f};
    const fragb ones = __builtin_bit_cast(fragb, (v4u){0x3F803F80u, 0x3F803F80u, 0x3F803F80u, 0x3F803F80u});
    const f32x4 z4 = (f32x4){0.f, 0.f, 0.f, 0.f};
    gload(0); images(0); gload(1);
#pragma unroll 1
    for (int n = 0; n < NCH; ++n) {
        RAW_BARRIER();
        const LAS unsigned char* B0 = L0 + (n & 1) * BUFB;
        const LAS bf16* Qs = (const LAS bf16*)B0; const LAS bf16* Ks = Qs + 64 * MP; const LAS bf16* VT = Ks + 64 * MP; const LAS bf16* KTw = VT + 64 * MP; const LAS float* vec = (const LAS float*)(B0 + 4 * IMG);
        const LAS bf16* CT = (const LAS bf16*)(L0 + 2 * BUFB + (n & 1) * CTB); LAS bf16* CTn = (LAS bf16*)(L0 + 2 * BUFB + ((n + 1) & 1) * CTB);
        fragb Qf[2]; Qf[0] = ld_frag16(Qs + (16 * it + l15) * MP + 8 * q); Qf[1] = ld_frag16(Qs + (16 * it + l15) * MP + 32 + 8 * q);
        const float cmi = vec[64 + 16 * it + l15]; const int icol = 16 * it + l15;
        f32x4 pt[4];
#pragma unroll
        for (int jt = 0; jt < 4; ++jt) {
            pt[jt] = z4;
            if (jt <= it) {
                const fragb k0 = ld_frag16(Ks + (16 * jt + l15) * MP + 8 * q), k1 = ld_frag16(Ks + (16 * jt + l15) * MP + 32 + 8 * q);
                f32x4 st = mfma16(k0, Qf[0], z4); st = mfma16(k1, Qf[1], st);
                const f32x4 xj = *(const LAS f32x4*)(vec + 16 * jt + 4 * q);
#pragma unroll
                for (int r = 0; r < 4; ++r) { const int j = 16 * jt + 4 * q + r; pt[jt][r] = (j <= icol) ? st[r] * __expf(xj[r] - cmi) * 0.125f : 0.f; }
            }
        }
        fragb Pf[2]; Pf[0] = pack_frag(pt[0], pt[1]); Pf[1] = pack_frag(pt[2], pt[3]);
        fragb Vf[2][2];
#pragma unroll
        for (int v2 = 0; v2 < 2; ++v2)
#pragma unroll
            for (int s = 0; s < 2; ++s) { const LAS bf16* vr = VT + (16 * (2 * vtp + v2) + l15) * MP + 32 * s + 4 * q; Vf[v2][s] = ld_frag8x2(vr, vr + 16); }
        f32x4 Aacc[2], R[2], as, dn;
        as = mfma16(Pf[0], ones, z4); if (it >= 2) as = mfma16(Pf[1], ones, as);
        const fragb nf0 = ld_frag16(CT + 64 * MP + 8 * q), nf1 = ld_frag16(CT + 64 * MP + 32 + 8 * q);
        dn = mfma16(Qf[0], nf0, z4); dn = mfma16(Qf[1], nf1, dn);
#pragma unroll
        for (int v2 = 0; v2 < 2; ++v2) {
            Aacc[v2] = mfma16(Pf[0], Vf[v2][0], z4); if (it >= 2) Aacc[v2] = mfma16(Pf[1], Vf[v2][1], Aacc[v2]);
            const LAS bf16* cr = CT + (16 * (2 * vtp + v2) + l15) * MP + 8 * q;
            R[v2] = mfma16(Qf[0], ld_frag16(cr), z4); R[v2] = mfma16(Qf[1], ld_frag16(cr + 32), R[v2]);
        }
        {
            const f32x4 bi = *(const LAS f32x4*)(vec + 128 + 16 * it + 4 * q), cmr = *(const LAS f32x4*)(vec + 64 + 16 * it + 4 * q);
#pragma unroll
            for (int r = 0; r < 4; ++r) {
                const float mi = bi[r] + cmr[r], minter = bi[r] + m, mt = fmaxf(minter, mi), e1 = __expf(mi - mt), e2 = __expf(minter - mt);
                const float den = e1 * as[r] + e2 * dn[r]; const float inv = __builtin_amdgcn_rcpf(fmaxf(fabsf(den), __expf(-mt)));
                const int row = seqrow_cm(n * 64 + 16 * it + 4 * q + r, d, b);
#pragma unroll
                for (int v2 = 0; v2 < 2; ++v2) outc[(size_t)row * 256 + h * 64 + 16 * (2 * vtp + v2) + l15] = (bf16)f2bf1((e1 * Aacc[v2][r] + e2 * R[v2][r]) * inv);
            }
        }
        {
            const LAS bf16* kr = KTw + (16 * it + l15) * MP + 4 * q;
            const fragb kt0 = ld_frag8x2(kr, kr + 16), kt1 = ld_frag8x2(kr + 32, kr + 48);
            const float bL = vec[128 + 63], mloc = bL + vec[64 + 63];
            const float mnew = fmaxf(bL + m, mloc), wp = __expf(bL + m - mnew), wn = __expf(mloc - mnew);
            f32x4 gk = mfma16(kt0, ones, z4); gk = mfma16(kt1, ones, gk);
            nst = nst * wp + gk * wn;
#pragma unroll
            for (int v2 = 0; v2 < 2; ++v2) {
                f32x4 G = mfma16(kt0, Vf[v2][0], z4); G = mfma16(kt1, Vf[v2][1], G);
                Cst[v2] = Cst[v2] * wp + G * wn;
                v2u o; o.x = pk2(Cst[v2].x, Cst[v2].y); o.y = pk2(Cst[v2].z, Cst[v2].w);
                *(LAS v2u*)(CTn + (16 * (2 * vtp + v2) + l15) * MP + 16 * it + 4 * q) = o;
            }
            if (vtp == 0 && l15 == 0) { v2u o; o.x = pk2(nst.x, nst.y); o.y = pk2(nst.z, nst.w); *(LAS v2u*)(CTn + 64 * MP + 16 * it + 4 * q) = o; }
            m = mnew;
        }
        if (n + 1 < NCH) { images((n + 1) & 1); if (n + 2 < NCH) gload(n + 2); }
    }
    __syncthreads();
}
__device__ __forceinline__ int fwd_row_cm(int b, int c, int t) { return c < 4 ? (T_LAT + b * CTXL + c * 64 + t) : (b * SEQ + t * 64 + (c - 4)); }
__device__ __forceinline__ bf16* blob_row(const Ctx& C, int d, int isw, int b, int c, int h, int r) {
    const int row = fwd_row_cm(b, c, r);
    if (d == 1 && isw) return WSP(bf16, WS_OUTD) + ((size_t)T_ALL + row) * 256 + h * 64;
    return WSP(bf16, WS_P) + (size_t)row * PLD + OFF_D + (d * 2 + isw) * 256 + h * 64;
}
constexpr int LP = 68;
__device__ __forceinline__ void blocked_solve(const LAS bf16* Ln, const LAS bf16* TinvP, LAS unsigned char* XTw, f32x4 (&acc)[4][4], int l15, int q) {
    const f32x4 z4 = (f32x4){0.f, 0.f, 0.f, 0.f};
#pragma unroll
    for (int I = 0; I < 4; ++I) {
        const fragb Af = *(const LAS fragb*)(TinvP + (I * 16 + l15) * 32 + 8 * q);
        fragb A0, A1;
        if (I >= 1) A0 = ld_frag16(Ln + (16 * I + l15) * MP + 8 * q);
        if (I == 3) A1 = ld_frag16(Ln + (16 * I + l15) * MP + 32 + 8 * q);
#pragma unroll
        for (int nt = 0; nt < 4; ++nt) {
            const int crow = 16 * nt + l15; LAS unsigned char* xr = XTw + crow * 128;
            f32x4 a = acc[I][nt];
            if (I >= 1) a = mfma16(A0, *(const LAS fragb*)(xr + ((q ^ (crow & 7)) << 4)), a);
            if (I == 3) a = mfma16(A1, *(const LAS fragb*)(xr + (((4 + q) ^ (crow & 7)) << 4)), a);
            v4u bw; bw.x = pk2(a.x, a.y); bw.y = pk2(a.z, a.w); bw.z = 0u; bw.w = 0u;
            const f32x4 x = mfma16(Af, __builtin_bit_cast(fragb, bw), z4);
            acc[I][nt] = x;
            v2u o; o.x = pk2(x.x, x.y); o.y = pk2(x.z, x.w);
            *(LAS v2u*)(xr + (((2 * I + (q >> 1)) ^ (crow & 7)) << 4) + (q & 1) * 8) = o;
        }
    }
}
__device__ __forceinline__ void diag_inverses(const LAS bf16* Ln, LAS bf16* TinvP, int lane) {
    const int blk = lane >> 4, c = lane & 15;
    float x[16];
#pragma unroll
    for (int i = 0; i < 16; ++i) {
        const LAS bf16* lr = Ln + (16 * blk + i) * MP + 16 * blk;
        const v4u r0 = *(const LAS v4u*)lr, r1 = *(const LAS v4u*)(lr + 8);
        const unsigned rw[8] = {r0.x, r0.y, r0.z, r0.w, r1.x, r1.y, r1.z, r1.w};
        float s = (i == c) ? 1.0f : 0.0f;
#pragma unroll
        for (int j = 0; j < i; ++j) s += ((j & 1) ? bfhi(rw[j >> 1]) : bflo(rw[j >> 1])) * x[j];
        x[i] = s;
        TinvP[(blk * 16 + i) * 32 + 8 * (c >> 2) + (c & 3)] = (bf16)f2bf1(s);
    }
}
__device__ __forceinline__ void gdn_solve_item(const Ctx& C, int l, int item) {
    const int lane = C.lane, w = C.wave, pw = w & 1, pi = w >> 1, l15 = lane & 15, q = lane >> 4;
    LAS unsigned char* B0 = C.lds + pi * 31744;
    LAS bf16* Ln = (LAS bf16*)B0;
    LAS bf16* TinvP = (LAS bf16*)(B0 + 9216);
    LAS float* vec = (LAS float*)(B0 + 13312);
    LAS unsigned char* XT = B0 + 13824;
    LAS bf16* Ks = (LAS bf16*)XT;
    const bf16* P = WSP(const bf16, WS_P); const bf16* gq = WSP(const bf16, WS_GQ);
    const int u = item >> 1, d = item & 1;
    const int c = u % NCH, h = (u / NCH) & 3, b = u / (NCH * NH);
    const int n = d ? (c < 4 ? 3 - c : 71 - c) : c;
    const float aexp = __expf(C.in[I_GALOG][(l * 2 + d) * NH + h]), dtb = C.in[I_GDTB][(l * 2 + d) * NH + h];
    const int rowl = seqrow_cm(n * 64 + lane, d, b);
    const bf16* pg = P + (size_t)rowl * PLD + OFF_D + 1024 + d * 4 + h;
    const float la = -aexp * softplusf_(bf2f(pg[0]) + dtb), beta = sigmoidf_(bf2f(pg[8]));
    const float gam = wave_incl_sum(la, lane);
    if (pw == 0) { vec[lane] = beta; vec[64 + lane] = gam; }
#pragma unroll
    for (int r = 0; r < 4; ++r) { const int idx = pw * 64 + lane + 128 * r, t = idx >> 3, part = idx & 7;
        *(LAS v4u*)(Ks + t * MP + 8 * part) = *(const v4u*)(gq + (size_t)seqrow_cm(n * 64 + t, d, b) * 768 + 256 + h * 64 + 8 * part); }
    { LAS v4u* tz = (LAS v4u*)(B0 + 9216) + (pw * 64 + lane) * 2; tz[0] = (v4u){0u, 0u, 0u, 0u}; tz[1] = (v4u){0u, 0u, 0u, 0u}; }
    f32x4 acc[4][4];
    if (pw == 0) {
#pragma unroll
        for (int I = 0; I < 4; ++I)
#pragma unroll
            for (int r = 0; r < 4; ++r) { const bf16* vr = gq + (size_t)seqrow_cm(n * 64 + 16 * I + 4 * q + r, d, b) * 768 + 512 + h * 64 + l15;
#pragma unroll
                for (int nt = 0; nt < 4; ++nt) acc[I][nt][r] = bf2f(vr[16 * nt]); }
    }
    __syncthreads();
    {
        int tix = 0;
#pragma unroll
        for (int it = 0; it < 4; ++it)
#pragma unroll
            for (int jt = 0; jt < 4; ++jt, ++tix) if ((tix & 1) == pw) {
                f32x4 t4 = (f32x4){0.f, 0.f, 0.f, 0.f};
                if (jt <= it) {
#pragma unroll
                    for (int s = 0; s < 2; ++s) t4 = mfma16(ld_frag16(Ks + (16 * it + l15) * MP + 32 * s + 8 * q), ld_frag16(Ks + (16 * jt + l15) * MP + 32 * s + 8 * q), t4);
                    const float gj = vec[64 + 16 * jt + l15];
                    const f32x4 bi = *(const LAS f32x4*)(vec + 16 * it + 4 * q), gi = *(const LAS f32x4*)(vec + 64 + 16 * it + 4 * q);
#pragma unroll
                    for (int r = 0; r < 4; ++r) { const int i = 16 * it + 4 * q + r, j = 16 * jt + l15; t4[r] = (j < i) ? -(bi[r] * t4[r] * __expf(gi[r] - gj)) : 0.f; }
                }
#pragma unroll
                for (int r = 0; r < 4; ++r) Ln[(16 * it + 4 * q + r) * MP + 16 * jt + l15] = (bf16)f2bf1(t4[r]);
            }
    }
    {
#pragma unroll
        for (int I = 0; I < 4; ++I) {
            const f32x4 bi = *(const LAS f32x4*)(vec + 16 * I + 4 * q), gi = *(const LAS f32x4*)(vec + 64 + 16 * I + 4 * q);
#pragma unroll
            for (int r = 0; r < 4; ++r) { const float sc = pw ? bi[r] * __expf(gi[r]) : bi[r];
#pragma unroll
                for (int nt = 0; nt < 4; ++nt) acc[I][nt][r] = (pw ? bf2f(Ks[(16 * I + 4 * q + r) * MP + 16 * nt + l15]) : acc[I][nt][r]) * sc; }
        }
    }
    __syncthreads();
    if (pw == 0) diag_inverses(Ln, TinvP, lane);
    LAS unsigned char* XTw = XT + pw * 8192;
    { LAS v4u* xz = (LAS v4u*)(XTw + lane * 128);
#pragma unroll
        for (int g = 0; g < 8; ++g) xz[g] = (v4u){0u, 0u, 0u, 0u}; }
    __syncthreads();
    blocked_solve(Ln, TinvP, XTw, acc, l15, q);
    {
        bf16* dst = blob_row(C, d, pw, b, c, h, lane);
        const LAS unsigned char* xr = XTw + lane * 128;
#pragma unroll
        for (int g = 0; g < 8; ++g) *(v4u*)(dst + 8 * g) = *(const LAS v4u*)(xr + ((g ^ (lane & 7)) << 4));
    }
    __syncthreads();
}

template <bool DRY>
__device__ __forceinline__ void gdn_chunked(const Ctx& C, int l, int idx) {
    const int d = idx >> 5, b = (idx >> 2) & 7, h = idx & 3, lane = C.lane, w = C.wave, l15 = lane & 15, q = lane >> 4;
    const int it = w & 3, vtp = w >> 2;
    constexpr int IMG = 64 * MP * 2, BUFB = 5 * IMG + 512;
    LAS unsigned char* L0 = C.lds;
    LAS bf16* VnT = (LAS bf16*)(L0 + 2 * BUFB + 2 * IMG);
    const bf16* P = WSP(const bf16, WS_P); const bf16* gq = WSP(const bf16, WS_GQ); bf16* outd = WSP(bf16, WS_OUTD) + (size_t)d * T_ALL * 256;
    const float aexp = __expf(C.in[I_GALOG][(l * 2 + d) * NH + h]), dtb = C.in[I_GDTB][(l * 2 + d) * NH + h];
    const int tt = C.tid >> 3, part = C.tid & 7;
    for (int i = C.tid; i < 2 * IMG / 4; i += NTHR) ((LAS unsigned*)(L0 + 2 * BUFB))[i] = 0u;
    v4u rq, rk, ru, rw; unsigned short rga;
    auto gload = [&](int n) {
        const int c = d ? (n < 4 ? 3 - n : 71 - n) : n;
        const bf16* pp = gq + (size_t)seqrow_cm(n * 64 + tt, d, b) * 768 + h * 64 + 8 * part;
        rq = *(const v4u*)pp; rk = *(const v4u*)(pp + 256);
        ru = *(const v4u*)(blob_row(C, d, 0, b, c, h, tt) + 8 * part); rw = *(const v4u*)(blob_row(C, d, 1, b, c, h, tt) + 8 * part);
        rga = P[(size_t)seqrow_cm(n * 64 + lane, d, b) * PLD + OFF_D + 1024 + d * 4 + h];
    };
    auto images = [&](int bufi) {
        LAS unsigned char* B0 = L0 + bufi * BUFB;
        LAS bf16* Qs = (LAS bf16*)B0; LAS bf16* Ks = Qs + 64 * MP; LAS bf16* KdT = Ks + 64 * MP; LAS bf16* Wi = KdT + 64 * MP; LAS bf16* UT = Wi + 64 * MP; LAS float* vec = (LAS float*)(B0 + 5 * IMG);
        const float la = -aexp * softplusf_(bf2f(rga) + dtb);
        const float gam = wave_incl_sum(la, lane);
        if (w == 0) vec[lane] = gam;
        const float kd = __expf(__shfl(gam, 63) - gam);
        const float kmine = __shfl(kd, 8 * w + (lane >> 3));
        *(LAS v4u*)(Qs + tt * MP + 8 * part) = rq; *(LAS v4u*)(Ks + tt * MP + 8 * part) = rk; *(LAS v4u*)(UT + tt * MP + 8 * part) = ru;
        const unsigned kk[4] = {rk.x, rk.y, rk.z, rk.w}, ww[4] = {rw.x, rw.y, rw.z, rw.w};
#pragma unroll
        for (int e = 0; e < 4; ++e) {
            KdT[(8 * part + 2 * e) * MP + tt] = (bf16)f2bf1(bflo(kk[e]) * kmine); KdT[(8 * part + 2 * e + 1) * MP + tt] = (bf16)f2bf1(bfhi(kk[e]) * kmine);
            Wi[(8 * part + 2 * e) * MP + tt] = (bf16)(ww[e] & 0xffffu); Wi[(8 * part + 2 * e + 1) * MP + tt] = (bf16)(ww[e] >> 16);
        }
    };
    f32x4 Sst[2]; Sst[0] = Sst[1] = (f32x4){0.f, 0.f, 0.f, 0.f};
    const f32x4 z4 = (f32x4){0.f, 0.f, 0.f, 0.f};
    gload(0); images(0); gload(1);
#pragma unroll 1
    for (int n = 0; n < NCH; ++n) {
        RAW_BARRIER();
        const LAS unsigned char* B0 = L0 + (n & 1) * BUFB;
        const LAS bf16* Qs = (const LAS bf16*)B0; const LAS bf16* Ks = Qs + 64 * MP; const LAS bf16* KdT = Ks + 64 * MP; const LAS bf16* Wi = KdT + 64 * MP; const LAS bf16* UT = Wi + 64 * MP; const LAS float* vec = (const LAS float*)(B0 + 5 * IMG);
        const LAS bf16* ST = (const LAS bf16*)(L0 + 2 * BUFB + (n & 1) * IMG); LAS bf16* STn = (LAS bf16*)(L0 + 2 * BUFB + ((n + 1) & 1) * IMG);
        fragb Qf[2]; Qf[0] = ld_frag16(Qs + (16 * it + l15) * MP + 8 * q); Qf[1] = ld_frag16(Qs + (16 * it + l15) * MP + 32 + 8 * q);
        const float gcol = vec[16 * it + l15]; const int icol = 16 * it + l15;
        f32x4 pt[4];
#pragma unroll
        for (int jt = 0; jt < 4; ++jt) {
            pt[jt] = z4;
            if (jt <= it) {
                const fragb k0 = ld_frag16(Ks + (16 * jt + l15) * MP + 8 * q), k1 = ld_frag16(Ks + (16 * jt + l15) * MP + 32 + 8 * q);
                f32x4 st = mfma16(k0, Qf[0], z4); st = mfma16(k1, Qf[1], st);
                const f32x4 gj = *(const LAS f32x4*)(vec + 16 * jt + 4 * q);
#pragma unroll
                for (int r = 0; r < 4; ++r) { const int j = 16 * jt + 4 * q + r; pt[jt][r] = (j <= icol) ? st[r] * __expf(gcol - gj[r]) : 0.f; }
            }
        }
        fragb Pf[2]; Pf[0] = pack_frag(pt[0], pt[1]); Pf[1] = pack_frag(pt[2], pt[3]);
        const fragb Wf0 = ld_frag16(Wi + (16 * it + l15) * MP + 8 * q), Wf1 = ld_frag16(Wi + (16 * it + l15) * MP + 32 + 8 * q);
        f32x4 Ro[2];
#pragma unroll
        for (int v2 = 0; v2 < 2; ++v2) {
            const int vrow = 16 * (2 * vtp + v2) + l15;
            const fragb s0 = ld_frag16(ST + vrow * MP + 8 * q), s1 = ld_frag16(ST + vrow * MP + 32 + 8 * q);
            f32x4 ws = mfma16(Wf0, s0, z4); ws = mfma16(Wf1, s1, ws);
            Ro[v2] = mfma16(Qf[0], s0, z4); Ro[v2] = mfma16(Qf[1], s1, Ro[v2]);
            const v2u ur = *(const LAS v2u*)(UT + vrow * MP + 16 * it + 4 * q);
            v2u o; o.x = pk2(bflo(ur.x) - ws.x, bfhi(ur.x) - ws.y); o.y = pk2(bflo(ur.y) - ws.z, bfhi(ur.y) - ws.w);
            *(LAS v2u*)(VnT + vrow * MP + 16 * it + 4 * q) = o;
        }
        RAW_BARRIER();
        {
            const f32x4 gi = *(const LAS f32x4*)(vec + 16 * it + 4 * q);
            const float gl = __expf(vec[63]);
            const LAS bf16* kr = KdT + (16 * it + l15) * MP + 4 * q;
            const fragb kt0 = ld_frag8x2(kr, kr + 16), kt1 = ld_frag8x2(kr + 32, kr + 48);
#pragma unroll
            for (int v2 = 0; v2 < 2; ++v2) {
                const int vrow = 16 * (2 * vtp + v2) + l15;
                const LAS bf16* vr = VnT + vrow * MP + 4 * q;
                const fragb n0 = ld_frag8x2(vr, vr + 16), n1 = ld_frag8x2(vr + 32, vr + 48);
                f32x4 o = mfma16(Pf[0], n0, z4); if (it >= 2) o = mfma16(Pf[1], n1, o);
#pragma unroll
                for (int r = 0; r < 4; ++r) { const int row = seqrow_cm(n * 64 + 16 * it + 4 * q + r, d, b);
                    if (!DRY) outd[(size_t)row * 256 + h * 64 + vrow] = (bf16)f2bf1(o[r] + __expf(gi[r]) * Ro[v2][r]); }
                f32x4 ns = mfma16(kt0, n0, z4); ns = mfma16(kt1, n1, ns);
                Sst[v2] = Sst[v2] * gl + ns;
                v2u so; so.x = pk2(Sst[v2].x, Sst[v2].y); so.y = pk2(Sst[v2].z, Sst[v2].w);
                *(LAS v2u*)(STn + vrow * MP + 16 * it + 4 * q) = so;
            }
        }
        if (n + 1 < NCH) { images((n + 1) & 1); if (n + 2 < NCH) gload(n + 2); }
    }
    __syncthreads();
}
constexpr int UP = 264;
template <int CTRL> __device__ __forceinline__ float dpp_keep(float oldv, float v) { return __builtin_bit_cast(float, __builtin_amdgcn_update_dpp(__builtin_bit_cast(int, oldv), __builtin_bit_cast(int, v), CTRL, 0xF, 0xF, false)); }
template <bool REV> __device__ __forceinline__ void scan16(float& A, float& B) {
#define LRU_STEP(S) { const float Ap = dpp_keep<(REV ? 0x100 : 0x110) | S>(1.0f, A), Bp = dpp_keep<(REV ? 0x100 : 0x110) | S>(0.0f, B); B = A * Bp + B; A = A * Ap; }
    LRU_STEP(1) LRU_STEP(2) LRU_STEP(4) LRU_STEP(8)
#undef LRU_STEP
}
constexpr int UPC = 72;
__device__ __forceinline__ int lru_chunk_of(int d, int k) { return d ? (k < 4 ? 3 - k : NCH + 3 - k) : k; }
template <bool REV>
__device__ __forceinline__ void lru_tiles(const LAS bf16* Ud, int th, int mt, int lane, const fragb (&Wa)[2], const fragb (&Wx)[2], const f32x4& ba, const f32x4& bx, const f32x4& sp4,
                                          f32x4 (&Ac)[2], f32x4 (&Hl)[2], f32x4& Atot, f32x4& hend) {
    const int l15 = lane & 15, q = lane >> 4, edge = (lane & 48) | (REV ? 0 : 15);
    const f32x4 z4 = (f32x4){0.f, 0.f, 0.f, 0.f};
    f32x4 tA = z4, tB = z4;
#pragma unroll
    for (int i = 0; i < 2; ++i) {
        const int nt = REV ? 3 - (2 * th + i) : 2 * th + i;
        const LAS bf16* urow = Ud + (16 * nt + l15) * UPC;
        const fragb Uf0 = ld_frag16(urow + 8 * q), Uf1 = ld_frag16(urow + 32 + 8 * q);
        f32x4 aa = mfma16(Wa[0], Uf0, z4); aa = mfma16(Wa[1], Uf1, aa);
        f32x4 ax = mfma16(Wx[0], Uf0, z4); ax = mfma16(Wx[1], Uf1, ax);
        const v2u ur = *(const LAS v2u*)(urow + 16 * mt + 4 * q);
        const f32x4 u4 = (f32x4){bflo(ur.x), bfhi(ur.x), bflo(ur.y), bfhi(ur.y)};
        f32x4 la, iu, A, Bv;
#pragma unroll
        for (int r = 0; r < 4; ++r) { const float rg = sigmoidf_(aa[r] + ba[r]); iu[r] = sigmoidf_(ax[r] + bx[r]) * u4[r]; la[r] = -sp4[r] * rg; }
        const bool sm_ = la[0] > -0.15f && la[1] > -0.15f && la[2] > -0.15f && la[3] > -0.15f;
        if (__builtin_amdgcn_ballot_w64(!sm_) == 0ull) {
#pragma unroll
            for (int r = 0; r < 4; ++r) { const float x = la[r], p = x * (1.0f + x * (0.5f + x * (0.16666667f + x * (0.041666668f + x * (0.0083333338f + x * 0.0013888889f)))));
                A[r] = 1.0f + p; Bv[r] = __builtin_amdgcn_sqrtf(-p * (2.0f + p)) * iu[r]; }
        } else {
#pragma unroll
            for (int r = 0; r < 4; ++r) { A[r] = __expf(la[r]); Bv[r] = __builtin_amdgcn_sqrtf(-expm1f_(2.0f * la[r])) * iu[r]; }
        }
#pragma unroll
        for (int r = 0; r < 4; ++r) { float a_ = A[r], b_ = Bv[r]; scan16<REV>(a_, b_); A[r] = a_; Bv[r] = b_; }
        if (i == 0) {
            Ac[0] = A; Hl[0] = Bv;
#pragma unroll
            for (int r = 0; r < 4; ++r) { tA[r] = __shfl(A[r], edge); tB[r] = __shfl(Bv[r], edge); }
        } else {
            Ac[1] = A * tA; Hl[1] = A * tB + Bv;
#pragma unroll
            for (int r = 0; r < 4; ++r) { Atot[r] = __shfl(Ac[1][r], edge); hend[r] = __shfl(Hl[1][r], edge); }
        }
    }
}
__device__ __forceinline__ void lru_chain(const Ctx& C, int l, int id) {
    const int b = id >> 3, hd = (id >> 1) & 3, chalf = id & 1;
    const int lane = C.lane, l15 = lane & 15, q = lane >> 4;
    const int d = C.wave >> 2, mtl = (C.wave >> 1) & 1, th = C.wave & 1, mt = chalf * 2 + mtl;
    LAS bf16* U = (LAS bf16*)C.lds;
    LAS float* XCH = (LAS float*)(C.lds + 2 * 2 * 64 * UPC * 2);
    bf16* P = WSP(bf16, WS_P); bf16* LH = WSP(bf16, WS_LRUH) + (size_t)id * NSTEP * 32;
    const int cd = C.tid >> 8, cj = C.tid & 63, ctq = (C.tid >> 6) & 3;
    const float* cw = C.in[I_LCW] + (size_t)l * 4 * GW + hd * 64 + cj; const float w0 = cw[0], w1 = cw[GW], w2 = cw[2 * GW], w3 = cw[3 * GW], cb = C.in[I_LCB][l * GW + hd * 64 + cj];
    const bf16* wt = WSP(const bf16, WS_LRUWT) + (size_t)((d * 2 + 0) * 4 + hd) * 4096;
    fragb Wa[2], Wx[2];
#pragma unroll
    for (int ks = 0; ks < 2; ++ks) { Wa[ks] = *(const fragb*)(wt + (16 * mt + l15) * 64 + 32 * ks + 8 * q); Wx[ks] = *(const fragb*)(wt + 4 * 4096 + (16 * mt + l15) * 64 + 32 * ks + 8 * q); }
    const int ch0 = hd * 64 + 16 * mt + 4 * q;
    const f32x4 ba = *(const f32x4*)(C.in[I_LBA] + (l * 2 + d) * GW + ch0), bx = *(const f32x4*)(C.in[I_LBX] + (l * 2 + d) * GW + ch0), lam = *(const f32x4*)(C.in[I_LLAM] + (l * 2 + d) * GW + ch0);
    f32x4 sp4;
#pragma unroll
    for (int r = 0; r < 4; ++r) sp4[r] = 8.0f * softplusf_(-lam[r]);
    f32x4 s = (f32x4){0.f, 0.f, 0.f, 0.f};
    unsigned short xr[19];
#define LRU_LOADX(kk) do { const int c_ = lru_chunk_of(cd, (kk)); const bool ic_ = c_ < 4; const int p0_ = (ic_ ? c_ * 64 : (c_ - 4) * 64) + ctq * 16 - 2, Lp_ = ic_ ? CTXL : SEQ; \
        const bf16* xp_ = P + (size_t)(ic_ ? T_LAT + b * CTXL : b * SEQ) * PLD + hd * 64 + cj; \
        _Pragma("unroll") for (int i_ = 0; i_ < 19; ++i_) { const int p_ = p0_ + i_; xr[i_] = (p_ >= 0 && p_ < Lp_) ? xp_[(size_t)p_ * PLD] : (unsigned short)0; } } while (0)
#define LRU_CONV(kk) do { LAS bf16* uo_ = U + ((((kk) & 1) * 2 + cd) * 64 + ctq * 16) * UPC + cj; \
        _Pragma("unroll") for (int t_ = 0; t_ < 16; ++t_) uo_[t_ * UPC] = (bf16)f2bf1(w0 * bf2f(xr[t_]) + w1 * bf2f(xr[t_ + 1]) + w2 * bf2f(xr[t_ + 2]) + w3 * bf2f(xr[t_ + 3]) + cb); } while (0)
    LRU_LOADX(0); LRU_CONV(0); LRU_LOADX(1);
    __syncthreads();
#pragma unroll 1
    for (int k = 0; k < NCH; ++k) {
        if (k + 1 < NCH) { LRU_CONV(k + 1); if (k + 2 < NCH) LRU_LOADX(k + 2); }
        const int c = lru_chunk_of(d, k); const bool second = lru_chunk_of(1 - d, c) < k;
        const bool ic = c < 4; const size_t row0 = (size_t)(ic ? T_LAT + b * CTXL + c * 64 : b * SEQ + (c - 4) * 64);
        const bool late = (k == 2) || (k == 36);
        int tok[2]; v2u gv[2], fv[2];
#pragma unroll
        for (int i = 0; i < 2; ++i) { const int nt = d ? 3 - (2 * th + i) : 2 * th + i; tok[i] = 16 * nt + l15;
            if (second && !late) { gv[i] = *(const v2u*)(P + (row0 + tok[i]) * PLD + 256 + ch0); fv[i] = *(const v2u*)(LH + (size_t)(c * 64 + tok[i]) * 32 + 16 * mtl + 4 * q); } }
        f32x4 Ac[2], Hl[2], Atot, hend;
        const LAS bf16* Ud = U + ((k & 1) * 2 + d) * 64 * UPC;
        if (d) lru_tiles<true>(Ud, th, mt, lane, Wa, Wx, ba, bx, sp4, Ac, Hl, Atot, hend); else lru_tiles<false>(Ud, th, mt, lane, Wa, Wx, ba, bx, sp4, Ac, Hl, Atot, hend);
        LAS float* xw = XCH + (((((k & 1) * 2 + d) * 2 + mtl) * 2 + th) * 4 + q) * 8;
        if (l15 == (d ? 0 : 15)) { *(LAS f32x4*)xw = Atot; *(LAS f32x4*)(xw + 4) = hend; }
        if (late) VM_WAIT();
        RAW_BARRIER();
        if (second && late) {
#pragma unroll
            for (int i = 0; i < 2; ++i) { gv[i] = *(const v2u*)(P + (row0 + tok[i]) * PLD + 256 + ch0); fv[i] = *(const v2u*)(LH + (size_t)(c * 64 + tok[i]) * 32 + 16 * mtl + 4 * q); }
        }
        const LAS float* xr0 = XCH + (((((k & 1) * 2 + d) * 2 + mtl) * 2 + 0) * 4 + q) * 8;
        const f32x4 A0 = *(const LAS f32x4*)xr0, h0 = *(const LAS f32x4*)(xr0 + 4), A1 = *(const LAS f32x4*)(xr0 + 32), h1 = *(const LAS f32x4*)(xr0 + 36);
        const f32x4 mid = A0 * s + h0, hin = th ? mid : s;
        s = A1 * mid + h1;
#pragma unroll
        for (int i = 0; i < 2; ++i) {
            const f32x4 h = Ac[i] * hin + Hl[i];
            if (!second) { v2u o; o.x = pk2(h.x, h.y); o.y = pk2(h.z, h.w); *(v2u*)(LH + (size_t)(c * 64 + tok[i]) * 32 + 16 * mtl + 4 * q) = o; }
            else {
                const f32x4 g = (f32x4){bflo(gv[i].x), bfhi(gv[i].x), bflo(gv[i].y), bfhi(gv[i].y)};
                f32x4 y = (f32x4){h.x + bflo(fv[i].x), h.y + bfhi(fv[i].x), h.z + bflo(fv[i].y), h.w + bfhi(fv[i].y)};
                y.x *= gelu_tanh(g.x); y.y *= gelu_tanh(g.y); y.z *= gelu_tanh(g.z); y.w *= gelu_tanh(g.w);
                st4bf(P + (row0 + tok[i]) * PLD + 256 + ch0, y);
            }
        }
    }
#undef LRU_LOADX
#undef LRU_CONV
    __syncthreads();
}
constexpr int RP = 264;
__device__ __forceinline__ void rwkv_prep2(const Ctx& C, int l, int b, int c) {
    LAS bf16* RS = (LAS bf16*)C.lds;
    LAS bf16* KS = RS + 64 * RP;
    LAS bf16* XW = KS + 64 * RP;
    LAS bf16* XA = XW + 64 * MP;
    LAS bf16* XG = XA + 64 * MP;
    const bf16* P = WSP(const bf16, WS_P);
    const bool isctx = c < 4; const int p0 = isctx ? c * 64 : (c - 4) * 64; const int Lp = isctx ? CTXL : SEQ; const int row0 = isctx ? T_LAT + b * CTXL : b * SEQ;
    const float* mu = C.in[I_RMU] + (size_t)l * 2 * B_COLS;
    bf16* rkv = WSP(bf16, WS_RKV);
#pragma unroll 5
    for (int it = C.tid; it < 64 * 120; it += NTHR) {
        const int t = it / 120, c8 = (it % 120) * 8, p = p0 + t;
        const bf16* pp = P + (size_t)(row0 + p) * PLD + OFF_B + c8;
        const v4u xc = *(const v4u*)pp; v4u xp = (v4u){0u, 0u, 0u, 0u}, xn = xp;
        if (p > 0) xp = *(const v4u*)(pp - PLD);
        if (p < Lp - 1) xn = *(const v4u*)(pp + PLD);
        const f32x4 m0a = *(const f32x4*)(mu + c8), m0b = *(const f32x4*)(mu + c8 + 4), m1a = *(const f32x4*)(mu + B_COLS + c8), m1b = *(const f32x4*)(mu + B_COLS + c8 + 4);
        const unsigned xcw[4] = {xc.x, xc.y, xc.z, xc.w}, xpw[4] = {xp.x, xp.y, xp.z, xp.w}, xnw[4] = {xn.x, xn.y, xn.z, xn.w};
        float sh[8];
#pragma unroll
        for (int e = 0; e < 4; ++e) {
            const float x0 = bflo(xcw[e]), x1 = bfhi(xcw[e]);
            const float mu0_0 = e < 2 ? m0a[2 * e] : m0b[2 * e - 4], mu0_1 = e < 2 ? m0a[2 * e + 1] : m0b[2 * e - 3], mu1_0 = e < 2 ? m1a[2 * e] : m1b[2 * e - 4], mu1_1 = e < 2 ? m1a[2 * e + 1] : m1b[2 * e - 3];
            sh[2 * e] = x0 + mu0_0 * (bflo(xpw[e]) - x0) + mu1_0 * (bflo(xnw[e]) - x0);
            sh[2 * e + 1] = x1 + mu0_1 * (bfhi(xpw[e]) - x1) + mu1_1 * (bfhi(xnw[e]) - x1);
        }
        if (c8 >= 768) {
            const int ci = c8 - 768;
            if (ci < 64) {
#pragma unroll
                for (int e = 0; e < 8; ++e) sh[e] = tanhf_(sh[e]); }
            else if (ci >= 128) {
#pragma unroll
                for (int e = 0; e < 8; ++e) sh[e] = sigmoidf_(sh[e]); }
        }
        v4u o; o.x = pk2(sh[0], sh[1]); o.y = pk2(sh[2], sh[3]); o.z = pk2(sh[4], sh[5]); o.w = pk2(sh[6], sh[7]);
        if (c8 < 768) {
            *(v4u*)(rkv + (size_t)(row0 + p) * 768 + c8) = o;
            if (c8 < 256) *(LAS v4u*)(RS + t * RP + c8) = o; else if (c8 < 512) *(LAS v4u*)(KS + t * RP + c8 - 256) = o;
        } else {
            const int ci = c8 - 768;
            LAS bf16* dst = ci < 64 ? XW + t * MP + ci : (ci < 128 ? XA + t * MP + ci - 64 : XG + t * MP + ci - 128);
            *(LAS v4u*)dst = o;
        }
    }
    __syncthreads();
    const int lane = C.lane, w = C.wave, l15 = lane & 15, q = lane >> 4, hd = w & 3, ntp = w >> 2;
    const bf16* wt = WSP(const bf16, WS_RWT);
    bf16* wa_out = WSP(bf16, WS_HB); bf16* g_out = WSP(bf16, WS_G); float* bonus = WSP(float, WS_BONUS); float* rinv = WSP(float, WS_RINV);
    const f32x4 z4 = (f32x4){0.f, 0.f, 0.f, 0.f};
    float bsum[2] = {0.f, 0.f}, ksum[2] = {0.f, 0.f};
#pragma unroll
    for (int n2 = 0; n2 < 2; ++n2) {
        const int tok = 16 * (2 * ntp + n2) + l15; const size_t row = (size_t)(row0 + p0 + tok);
        const fragb xw0 = ld_frag16(XW + tok * MP + 8 * q), xw1 = ld_frag16(XW + tok * MP + 32 + 8 * q), xa0 = ld_frag16(XA + tok * MP + 8 * q), xa1 = ld_frag16(XA + tok * MP + 32 + 8 * q);
        const fragb xg0 = ld_frag16(XG + tok * MP + 8 * q), xg1 = ld_frag16(XG + tok * MP + 32 + 8 * q);
        unsigned ow0[8], ow1[8], oa0[8], oa1[8], og[8];
#pragma unroll
        for (int mt = 0; mt < 4; ++mt) {
            const int chl = 16 * (l15 >> 2) + 4 * mt + (l15 & 3), ch4 = hd * 64 + 16 * q + 4 * mt;
            const bf16* wrow = wt + (size_t)(hd * 64 + chl) * 32 + 8 * q;
            const bf16* grow = wt + 4 * 256 * 32 + (size_t)(hd * 64 + chl) * 64 + 8 * q;
            const fragb fw0 = *(const fragb*)(wrow), fw1 = *(const fragb*)(wrow + 256 * 32), fa0 = *(const fragb*)(wrow + 2 * 256 * 32), fa1 = *(const fragb*)(wrow + 3 * 256 * 32), fg0 = *(const fragb*)(grow), fg1 = *(const fragb*)(grow + 32);
            const f32x4 w00 = *(const f32x4*)(C.in[I_RW0] + (l * 2 + 0) * GW + ch4), w01 = *(const f32x4*)(C.in[I_RW0] + (l * 2 + 1) * GW + ch4);
            const f32x4 a00 = *(const f32x4*)(C.in[I_RA0] + (l * 2 + 0) * GW + ch4), a01 = *(const f32x4*)(C.in[I_RA0] + (l * 2 + 1) * GW + ch4);
            const f32x4 k_a = *(const f32x4*)(C.in[I_RKA] + l * GW + ch4), r_k = *(const f32x4*)(C.in[I_RRK] + l * GW + ch4), k_k = *(const f32x4*)(C.in[I_RKK] + l * GW + ch4);
            const f32x4 aw0 = mfma16(fw0, xw0, z4), aw1 = mfma16(fw1, xw1, z4), aa0 = mfma16(fa0, xa0, z4), aa1 = mfma16(fa1, xa1, z4);
            f32x4 ag = mfma16(fg0, xg0, z4); ag = mfma16(fg1, xg1, ag);
            f32x4 wv0, wv1, av0, av1;
#pragma unroll
            for (int r = 0; r < 4; ++r) {
                wv0[r] = __expf(-0.6065306597126334f * sigmoidf_(aw0[r] + w00[r])); wv1[r] = __expf(-0.6065306597126334f * sigmoidf_(aw1[r] + w01[r]));
                av0[r] = sigmoidf_(aa0[r] + a00[r]); av1[r] = sigmoidf_(aa1[r] + a01[r]);
            }
            ow0[2 * mt] = pk2(wv0[0], wv0[1]); ow0[2 * mt + 1] = pk2(wv0[2], wv0[3]); ow1[2 * mt] = pk2(wv1[0], wv1[1]); ow1[2 * mt + 1] = pk2(wv1[2], wv1[3]);
            oa0[2 * mt] = pk2(av0[0], av0[1]); oa0[2 * mt + 1] = pk2(av0[2], av0[3]); oa1[2 * mt] = pk2(av1[0], av1[1]); oa1[2 * mt + 1] = pk2(av1[2], av1[3]);
            og[2 * mt] = pk2(ag[0], ag[1]); og[2 * mt + 1] = pk2(ag[2], ag[3]);
            const v2u rr_ = *(const LAS v2u*)(RS + tok * RP + ch4), kr_ = *(const LAS v2u*)(KS + tok * RP + ch4);
            const f32x4 rs = (f32x4){bflo(rr_.x), bfhi(rr_.x), bflo(rr_.y), bfhi(rr_.y)}, ks = (f32x4){bflo(kr_.x), bfhi(kr_.x), bflo(kr_.y), bfhi(kr_.y)};
#pragma unroll
            for (int r = 0; r < 4; ++r) {
                const float km = ks[r] * (1.0f + (av0[r] - 1.0f) * k_a[r]) + ks[r] * (1.0f + (av1[r] - 1.0f) * k_a[r]);
                bsum[n2] += rs[r] * r_k[r] * km; const float kk = ks[r] * k_k[r]; ksum[n2] += kk * kk;
            }
        }
        bf16* wrow_o = wa_out + row * 1024 + hd * 64 + 16 * q;
        *(v4u*)(wrow_o) = (v4u){ow0[0], ow0[1], ow0[2], ow0[3]}; *(v4u*)(wrow_o + 8) = (v4u){ow0[4], ow0[5], ow0[6], ow0[7]};
        *(v4u*)(wrow_o + 256) = (v4u){ow1[0], ow1[1], ow1[2], ow1[3]}; *(v4u*)(wrow_o + 256 + 8) = (v4u){ow1[4], ow1[5], ow1[6], ow1[7]};
        *(v4u*)(wrow_o + 512) = (v4u){oa0[0], oa0[1], oa0[2], oa0[3]}; *(v4u*)(wrow_o + 512 + 8) = (v4u){oa0[4], oa0[5], oa0[6], oa0[7]};
        *(v4u*)(wrow_o + 768) = (v4u){oa1[0], oa1[1], oa1[2], oa1[3]}; *(v4u*)(wrow_o + 768 + 8) = (v4u){oa1[4], oa1[5], oa1[6], oa1[7]};
        bf16* grow_o = g_out + row * 256 + hd * 64 + 16 * q;
        *(v4u*)(grow_o) = (v4u){og[0], og[1], og[2], og[3]}; *(v4u*)(grow_o + 8) = (v4u){og[4], og[5], og[6], og[7]};
    }
#pragma unroll
    for (int n2 = 0; n2 < 2; ++n2) {
        const size_t row = (size_t)(row0 + p0 + 16 * (2 * ntp + n2) + l15);
        float bs = bsum[n2], ks2 = ksum[n2];
        bs += __shfl_xor(bs, 16); bs += __shfl_xor(bs, 32); ks2 += __shfl_xor(ks2, 16); ks2 += __shfl_xor(ks2, 32);
        if (q == 0) { bonus[row * 4 + hd] = bs; rinv[row * 4 + hd] = rsqrtf_(ks2 + 1e-6f); }
    }
    __syncthreads();
}
__device__ __forceinline__ int fwd_row_r(int b, int c, int t) { return c < 4 ? (T_LAT + b * CTXL + c * 64 + t) : (b * SEQ + (c - 4) * 64 + t); }
__device__ __forceinline__ bf16* rw_blob_row(const Ctx& C, int d, int which, int b, int c, int h, int r) {
    const int row = fwd_row_r(b, c, r);
#if RW_VSPLIT
    if (which == 0) { if (d) return WSP(bf16, WS_GQ) + (size_t)row * 768 + 512 + h * 64;
                      return WSP(bf16, WS_P) + (size_t)row * PLD + OFF_B + 512 + h * 64; }
#else
    if (which == 0) return WSP(bf16, WS_OUTB) + ((size_t)d * T_ALL + row) * 256 + h * 64;
#endif
    return WSP(bf16, WS_P) + (size_t)row * PLD + OFF_B + d * 256 + h * 64;
}
__device__ __forceinline__ void rwkv_solve_item(const Ctx& C, int l, int item) {
    const int lane = C.lane, w = C.wave, pw = w & 1, pi = w >> 1, l15 = lane & 15, q = lane >> 4;
    LAS unsigned char* B0 = C.lds + pi * 31744;
    LAS bf16* Kk = (LAS bf16*)B0; LAS bf16* Bh = Kk + 64 * MP; LAS bf16* Kh = Bh + 64 * MP;
    LAS bf16* Ln = (LAS bf16*)B0;
    LAS bf16* Lk16 = (LAS bf16*)(B0 + 9216);
    LAS unsigned char* XT = B0 + 9216;
    LAS bf16* TinvP = (LAS bf16*)(B0 + 25600);
    const bf16* WA = WSP(const bf16, WS_HB); bf16* WAw = WSP(bf16, WS_HB); const bf16* rkv = WSP(const bf16, WS_RKV); const float* rinv = WSP(const float, WS_RINV);
    const int u = item >> 1, d = item & 1;
    const int c = u % NCH, h = (u / NCH) & 3, b = u / (NCH * NH);
    const float k_k = C.in[I_RKK][l * GW + h * 64 + lane], k_a = C.in[I_RKA][l * GW + h * 64 + lane];
    const int n = d ? (c < 4 ? 3 - c : 71 - c) : c;
    const float ril = rinv[(size_t)seqrow_raster(n * 64 + lane, d, b) * 4 + h];
#pragma unroll
    for (int r = 0; r < 4; ++r) { const int idx2 = pw * 64 + lane + 128 * r, t = idx2 >> 3, part = idx2 & 7; const int row = seqrow_raster(n * 64 + t, d, b);
        *(LAS v4u*)(Kk + t * MP + 8 * part) = *(const v4u*)(WA + (size_t)row * 1024 + d * 256 + h * 64 + 8 * part);
        *(LAS v4u*)(Bh + t * MP + 8 * part) = *(const v4u*)(WA + (size_t)row * 1024 + (2 + d) * 256 + h * 64 + 8 * part);
        *(LAS v4u*)(Kh + t * MP + 8 * part) = *(const v4u*)(rkv + (size_t)row * 768 + 256 + h * 64 + 8 * part); }
    __syncthreads();
    {
        float cc = 1.0f;
        if (pw) {
#pragma unroll
            for (int t = 0; t < 32; ++t) cc *= bf2f(Kk[t * MP + lane]);
        }
        __syncthreads();
#pragma unroll
        for (int t2 = 0; t2 < 32; ++t2) {
            const int t = pw * 32 + t2;
            const float wv = bf2f(Kk[t * MP + lane]), av = bf2f(Bh[t * MP + lane]), ks = bf2f(Kh[t * MP + lane]);
            const float kap = ks * k_k * __shfl(ril, t);
            const float cprev = cc; cc *= wv; const float ic = __builtin_amdgcn_rcpf(cc);
            Kk[t * MP + lane] = (bf16)f2bf1(kap * cprev); Bh[t * MP + lane] = (bf16)f2bf1(kap * av * ic); Kh[t * MP + lane] = (bf16)f2bf1(ks * (1.0f + (av - 1.0f) * k_a) * ic);
            WAw[(size_t)seqrow_raster(n * 64 + t, d, b) * 1024 + d * 256 + h * 64 + lane] = (bf16)f2bf1(cc);
        }
    }
    __syncthreads();
    f32x4 acc[4][4];
    if (pw == 0) {
#pragma unroll
        for (int I = 0; I < 4; ++I)
#pragma unroll
            for (int r = 0; r < 4; ++r)
#pragma unroll
                for (int nt = 0; nt < 4; ++nt) acc[I][nt][r] = bf2f(Kk[(16 * I + 4 * q + r) * MP + 16 * nt + l15]);
    }
    f32x4 T[10];
    {
        const LAS bf16* Bsrc = pw ? Kh : Bh;
        int tix = 0;
#pragma unroll
        for (int it = 0; it < 4; ++it)
#pragma unroll
            for (int jt = 0; jt <= it; ++jt, ++tix) {
                f32x4 t4 = (f32x4){0.f, 0.f, 0.f, 0.f};
#pragma unroll
                for (int s = 0; s < 2; ++s) t4 = mfma16(ld_frag16(Kk + (16 * it + l15) * MP + 32 * s + 8 * q), ld_frag16(Bsrc + (16 * jt + l15) * MP + 32 * s + 8 * q), t4);
#pragma unroll
                for (int r = 0; r < 4; ++r) { const int i = 16 * it + 4 * q + r, j = 16 * jt + l15; T[tix][r] = (j < i) ? (pw ? t4[r] : -t4[r]) : 0.f; }
            }
    }
    __syncthreads();
    {
        int tix = 0;
#pragma unroll
        for (int it = 0; it < 4; ++it)
#pragma unroll
            for (int jt = 0; jt < 4; ++jt) {
                if (jt <= it) {
#pragma unroll
                    for (int r = 0; r < 4; ++r) (pw ? Lk16 : Ln)[(16 * it + 4 * q + r) * MP + 16 * jt + l15] = (bf16)f2bf1(T[tix][r]);
                    ++tix;
                } else if (pw == 0) {
#pragma unroll
                    for (int r = 0; r < 4; ++r) Ln[(16 * it + 4 * q + r) * MP + 16 * jt + l15] = (bf16)0;
                }
            }
        LAS v4u* tz = (LAS v4u*)(B0 + 25600) + (pw * 64 + lane) * 2; tz[0] = (v4u){0u, 0u, 0u, 0u}; tz[1] = (v4u){0u, 0u, 0u, 0u};
    }
    __syncthreads();
    if (pw) {
#pragma unroll
        for (int I = 0; I < 4; ++I)
#pragma unroll
            for (int r = 0; r < 4; ++r)
#pragma unroll
                for (int nt = 0; nt < 4; ++nt) { const int i = 16 * I + 4 * q + r, j = 16 * nt + l15; acc[I][nt][r] = (j < i && nt <= I) ? bf2f(Lk16[i * MP + j]) : 0.f; }
    } else diag_inverses(Ln, TinvP, lane);
    __syncthreads();
    LAS unsigned char* XTw = XT + pw * 8192;
    { LAS v4u* xz = (LAS v4u*)(XTw + lane * 128);
#pragma unroll
        for (int g = 0; g < 8; ++g) xz[g] = (v4u){0u, 0u, 0u, 0u}; }
    blocked_solve(Ln, TinvP, XTw, acc, l15, q);
    {
        bf16* dst = rw_blob_row(C, d, pw, b, c, h, lane);
        const LAS unsigned char* xr = XTw + lane * 128;
#pragma unroll
        for (int g = 0; g < 8; ++g) *(v4u*)(dst + 8 * g) = *(const LAS v4u*)(xr + ((g ^ (lane & 7)) << 4));
    }
    __syncthreads();
}

template <bool DRY>
__device__ __forceinline__ void rwkv_chunked(const Ctx& C, int l, int idx) {
#ifndef RW_VSPLIT
#define RW_VSPLIT 1
#endif
    constexpr int NV = RW_VSPLIT ? 1 : 2;
    const int vhalf = idx & 1, lane = C.lane, w = C.wave, l15 = lane & 15, q = lane >> 4;
    const int d = RW_VSPLIT ? idx >> 6 : idx >> 5, b = RW_VSPLIT ? (idx >> 3) & 7 : (idx >> 2) & 7, h = RW_VSPLIT ? (idx >> 1) & 3 : idx & 3;
    const int it = w & 3, vt0 = RW_VSPLIT ? 2 * vhalf + (w >> 2) : 2 * (w >> 2);
    constexpr int IMG = 64 * MP * 2;
    LAS unsigned char* L0 = C.lds;
    LAS bf16* Wi = (LAS bf16*)L0; LAS bf16* Ti = Wi + 64 * MP; LAS bf16* Rh = Ti + 64 * MP; LAS bf16* Kh = Rh + 64 * MP; LAS bf16* Bh = Kh + 64 * MP;
    LAS bf16* UT = (LAS bf16*)(L0 + 11 * IMG);
    LAS float* cLv = (LAS float*)(L0 + 14 * IMG);
    const bf16* WA = WSP(const bf16, WS_HB); const bf16* rkv = WSP(const bf16, WS_RKV); const float* rinv = WSP(const float, WS_RINV);
    bf16* outb = WSP(bf16, WS_OUTB) + (size_t)d * T_ALL * 256;
    const int tt = C.tid >> 3, part = C.tid & 7;
    for (int i = C.tid; i < 2 * IMG / 4; i += NTHR) ((LAS unsigned*)(L0 + 12 * IMG))[i] = 0u;
    float kkw[8], kaw[8];
#pragma unroll
    for (int e = 0; e < 8; ++e) { kkw[e] = C.in[I_RKK][l * GW + h * 64 + 8 * w + e]; kaw[e] = C.in[I_RKA][l * GW + h * 64 + 8 * w + e]; }
    v4u gr, gk, gv, gw, ga, gbw, gbt; float gri;
    auto gload = [&](int n) {
        const int c = d ? (n < 4 ? 3 - n : 71 - n) : n;
        const int row = seqrow_raster(n * 64 + lane, d, b);
        const bf16* pr = rkv + (size_t)row * 768 + h * 64 + 8 * w;
        gr = *(const v4u*)pr; gk = *(const v4u*)(pr + 256); gv = *(const v4u*)(pr + 512);
        gw = *(const v4u*)(WA + (size_t)row * 1024 + d * 256 + h * 64 + 8 * w); ga = *(const v4u*)(WA + (size_t)row * 1024 + (2 + d) * 256 + h * 64 + 8 * w);
        gri = rinv[(size_t)row * 4 + h];
        gbw = *(const v4u*)(rw_blob_row(C, d, 0, b, c, h, tt) + 8 * part); gbt = *(const v4u*)(rw_blob_row(C, d, 1, b, c, h, tt) + 8 * part);
    };
    auto images = [&](int bufi) {
        LAS bf16* VT = (LAS bf16*)(L0 + (5 + 3 * bufi) * IMG); LAS bf16* KcT = VT + 64 * MP; LAS bf16* BcT = KcT + 64 * MP;
        const unsigned rw_[4] = {gr.x, gr.y, gr.z, gr.w}, kw_[4] = {gk.x, gk.y, gk.z, gk.w}, vw_[4] = {gv.x, gv.y, gv.z, gv.w}, ww_[4] = {gw.x, gw.y, gw.z, gw.w}, aw_[4] = {ga.x, ga.y, ga.z, ga.w};
        float rh[8], kh[8], bh[8];
#pragma unroll
        for (int e = 0; e < 8; ++e) {
            const float rs = (e & 1) ? bfhi(rw_[e >> 1]) : bflo(rw_[e >> 1]), ks = (e & 1) ? bfhi(kw_[e >> 1]) : bflo(kw_[e >> 1]);
            const float wv = (e & 1) ? bfhi(ww_[e >> 1]) : bflo(ww_[e >> 1]), av = (e & 1) ? bfhi(aw_[e >> 1]) : bflo(aw_[e >> 1]);
            const float kap = ks * kkw[e] * gri, ktil = ks * (1.0f + (av - 1.0f) * kaw[e]);
            const float cf = wv, icf = __builtin_amdgcn_rcpf(cf), cfL = __builtin_bit_cast(float, __builtin_amdgcn_readlane(__builtin_bit_cast(int, cf), 63)), dec = cfL * icf;
            rh[e] = rs * cf; kh[e] = ktil * icf; bh[e] = kap * av * icf;
            const unsigned short vraw = (e & 1) ? (unsigned short)(vw_[e >> 1] >> 16) : (unsigned short)(vw_[e >> 1] & 0xffffu);
            VT[(8 * w + e) * MP + lane] = vraw; KcT[(8 * w + e) * MP + lane] = (bf16)f2bf1(ktil * dec); BcT[(8 * w + e) * MP + lane] = (bf16)f2bf1(-(kap * av * dec));
            if (lane == 63) cLv[bufi * 64 + 8 * w + e] = cfL;
        }
        { v4u o; o.x = pk2(rh[0], rh[1]); o.y = pk2(rh[2], rh[3]); o.z = pk2(rh[4], rh[5]); o.w = pk2(rh[6], rh[7]); *(LAS v4u*)(Rh + lane * MP + 8 * w) = o; }
        { v4u o; o.x = pk2(kh[0], kh[1]); o.y = pk2(kh[2], kh[3]); o.z = pk2(kh[4], kh[5]); o.w = pk2(kh[6], kh[7]); *(LAS v4u*)(Kh + lane * MP + 8 * w) = o; }
        { v4u o; o.x = pk2(bh[0], bh[1]); o.y = pk2(bh[2], bh[3]); o.z = pk2(bh[4], bh[5]); o.w = pk2(bh[6], bh[7]); *(LAS v4u*)(Bh + lane * MP + 8 * w) = o; }
        const unsigned bw_[4] = {gbw.x, gbw.y, gbw.z, gbw.w}, bt_[4] = {gbt.x, gbt.y, gbt.z, gbt.w};
#pragma unroll
        for (int e = 0; e < 4; ++e) {
            Wi[(8 * part + 2 * e) * MP + tt] = (bf16)(bw_[e] & 0xffffu); Wi[(8 * part + 2 * e + 1) * MP + tt] = (bf16)(bw_[e] >> 16);
            Ti[(8 * part + 2 * e) * MP + tt] = (bf16)(bt_[e] & 0xffffu); Ti[(8 * part + 2 * e + 1) * MP + tt] = (bf16)(bt_[e] >> 16);
        }
    };
    f32x4 Zst[NV];
#pragma unroll
    for (int v2 = 0; v2 < NV; ++v2) Zst[v2] = (f32x4){0.f, 0.f, 0.f, 0.f};
    const f32x4 z4 = (f32x4){0.f, 0.f, 0.f, 0.f};
    gload(0); images(0); gload(1);
#pragma unroll 1
    for (int n = 0; n < NCH; ++n) {
        RAW_BARRIER();
        const LAS bf16* VT = (const LAS bf16*)(L0 + (5 + 3 * (n & 1)) * IMG); const LAS bf16* KcT = VT + 64 * MP; const LAS bf16* BcT = KcT + 64 * MP;
        const LAS bf16* Zi = (const LAS bf16*)(L0 + (12 + (n & 1)) * IMG); LAS bf16* Zn = (LAS bf16*)(L0 + (12 + ((n + 1) & 1)) * IMG);
        const int arow = (16 * it + l15) * MP + 8 * q;
        const fragb Wf0 = ld_frag16(Wi + arow), Wf1 = ld_frag16(Wi + arow + 32), Tf0 = ld_frag16(Ti + arow), Tf1 = ld_frag16(Ti + arow + 32), Rf0 = ld_frag16(Rh + arow), Rf1 = ld_frag16(Rh + arow + 32);
        const int icol = 16 * it + l15;
        f32x4 pk[4], pb[4];
#pragma unroll
        for (int jt = 0; jt < 4; ++jt) {
            pk[jt] = z4; pb[jt] = z4;
            if (jt <= it) {
                const int jrow = (16 * jt + l15) * MP + 8 * q;
                f32x4 sk = mfma16(ld_frag16(Kh + jrow), Rf0, z4); sk = mfma16(ld_frag16(Kh + jrow + 32), Rf1, sk);
                f32x4 sb = mfma16(ld_frag16(Bh + jrow), Rf0, z4); sb = mfma16(ld_frag16(Bh + jrow + 32), Rf1, sb);
#pragma unroll
                for (int r = 0; r < 4; ++r) { const int j = 16 * jt + 4 * q + r; pk[jt][r] = (j <= icol) ? sk[r] : 0.f; pb[jt][r] = (j <= icol) ? -sb[r] : 0.f; }
            }
        }
        fragb Pk0 = pack_frag(pk[0], pk[1]), Pk1 = pack_frag(pk[2], pk[3]), Pb0 = pack_frag(pb[0], pb[1]), Pb1 = pack_frag(pb[2], pb[3]);
        f32x4 RZ[NV];
#pragma unroll
        for (int v2 = 0; v2 < NV; ++v2) {
            const int vrow = 16 * (vt0 + v2) + l15;
            const fragb z0 = ld_frag16(Zi + vrow * MP + 8 * q), z1 = ld_frag16(Zi + vrow * MP + 32 + 8 * q);
            f32x4 u = mfma16(Wf0, z0, z4); u = mfma16(Wf1, z1, u);
            u = mfma16(Tf0, ld_frag16(VT + vrow * MP + 8 * q), u); if (it >= 2) u = mfma16(Tf1, ld_frag16(VT + vrow * MP + 32 + 8 * q), u);
            RZ[v2] = mfma16(Rf0, z0, z4); RZ[v2] = mfma16(Rf1, z1, RZ[v2]);
            v2u o; o.x = pk2(u.x, u.y); o.y = pk2(u.z, u.w);
            *(LAS v2u*)(UT + vrow * MP + 16 * it + 4 * q) = o;
        }
        RAW_BARRIER();
        {
            const f32x4 cl4 = *(const LAS f32x4*)(cLv + (n & 1) * 64 + 16 * it + 4 * q);
            const LAS bf16* kr = KcT + (16 * it + l15) * MP + 4 * q; const LAS bf16* br = BcT + (16 * it + l15) * MP + 4 * q;
            const fragb kc0 = ld_frag8x2(kr, kr + 16), kc1 = ld_frag8x2(kr + 32, kr + 48), bc0 = ld_frag8x2(br, br + 16), bc1 = ld_frag8x2(br + 32, br + 48);
#pragma unroll
            for (int v2 = 0; v2 < NV; ++v2) {
                const int vrow = 16 * (vt0 + v2) + l15;
                const LAS bf16* vr = VT + vrow * MP + 4 * q; const LAS bf16* ur = UT + vrow * MP + 4 * q;
                const fragb vp0 = ld_frag8x2(vr, vr + 16), vp1 = ld_frag8x2(vr + 32, vr + 48), up0 = ld_frag8x2(ur, ur + 16), up1 = ld_frag8x2(ur + 32, ur + 48);
                f32x4 y = mfma16(Pk0, vp0, RZ[v2]); y = mfma16(Pb0, up0, y);
                if (it >= 2) { y = mfma16(Pk1, vp1, y); y = mfma16(Pb1, up1, y); }
#pragma unroll
                for (int r = 0; r < 4; ++r) { const int row = seqrow_raster(n * 64 + 16 * it + 4 * q + r, d, b); if (!DRY) outb[(size_t)row * 256 + h * 64 + vrow] = (bf16)f2bf1(y[r]); }
                f32x4 zn = mfma16(kc0, vp0, z4); zn = mfma16(kc1, vp1, zn); zn = mfma16(bc0, up0, zn); zn = mfma16(bc1, up1, zn);
                Zst[v2] = Zst[v2] * cl4 + zn;
                v2u so; so.x = pk2(Zst[v2].x, Zst[v2].y); so.y = pk2(Zst[v2].z, Zst[v2].w);
                *(LAS v2u*)(Zn + vrow * MP + 16 * it + 4 * q) = so;
            }
        }
        if (n + 1 < NCH) { images((n + 1) & 1); if (n + 2 < NCH) gload(n + 2); }
    }
    __syncthreads();
}
__device__ __forceinline__ void moe_scatter(const Ctx& C, int moe_li, int nrows) {
    const unsigned* gc = WSP(const unsigned, WS_CTL) + CW_MOECNT + 64 * moe_li;
    LAS int* pst = (LAS int*)C.lds;
    {
        int pe[8]; int acc = 0;
#pragma unroll
        for (int e = 0; e < NE; ++e) { const int blks = ((int)gc[e] + 255) >> 8; if (C.tid == e) pst[e] = acc * 256; acc += blks; pe[e] = acc; }
        if (C.wg == 0 && C.tid < MOE_MAXBLK) { int be = 0;
#pragma unroll
            for (int e = 0; e < NE; ++e) be += (pe[e] <= C.tid) ? 1 : 0;
            int* tab = WSP(int, WS_TAB); tab[1 + C.tid] = be < NE ? be : NE - 1; if (C.tid == 0) tab[0] = acc; }
    }
    __syncthreads();
    const unsigned* route = WSP(const unsigned, WS_ROUTE); const unsigned* wgbase = WSP(const unsigned, WS_WGBASE);
    int* pos = WSP(int, WS_POS); int* tok = WSP(int, WS_TOK);
    if (C.wg < NE) { const int cnt = (int)gc[C.wg], s0 = pst[C.wg] + cnt, s1 = pst[C.wg] + (((cnt + 255) >> 8) << 8);
        for (int j = s0 + C.tid; j < s1; j += NTHR) tok[j] = 0; }
    const int m = C.wg * NWAVES + C.wave + C.lane * (C.G * NWAVES);
    if (m < nrows) {
        const v4u a = *(const v4u*)(route + (size_t)m * 8);
        const int e0 = (int)a.x, e1 = (int)a.y;
        const int p0 = pst[e0] + (int)wgbase[C.wg * 8 + e0] + (int)a.z, p1 = pst[e1] + (int)wgbase[C.wg * 8 + e1] + (int)a.w;
        pos[(size_t)m * 2] = p0; pos[(size_t)m * 2 + 1] = p1; tok[p0] = m; tok[p1] = m;
    }
    __syncthreads();
}
template <int NEXT>
__device__ __forceinline__ void moe_combine(const Ctx& C, int l, int nrows) {
    const unsigned* route = WSP(const unsigned, WS_ROUTE); const int* pos = WSP(const int, WS_POS); const bf16* ym = WSP(const bf16, WS_MIX);
    const float* modv = WSP(const float, WS_MODV) + (size_t)l * 9 * 6144 + 5 * 1024;
    const float* modn = WSP(const float, WS_MODV) + (size_t)(l + 1) * 9 * 6144;
    float* xc = WSP(float, WS_XC); bf16* hb = WSP(bf16, WS_HB);
    bf16* xlb = NEXT == 2 ? WSP(bf16, WS_XLAST) : (bf16*)C.out;
    const int gw = C.wg * NWAVES + C.wave, NGW = C.G * NWAVES;
    f32x4 gn[4];
#pragma unroll
    for (int j = 0; j < 4; ++j) gn[j] = *(const f32x4*)((NEXT == 2 ? C.in[I_FNG] : C.in[I_NMIXG] + (NEXT == 1 ? (l + 1) * 1024 : 0)) + 4 * C.lane + 256 * j);
    for (int m = gw; m < nrows; m += NGW) {
        const bool isctx = m >= T_LAT;
        float* xr = isctx ? xc + (size_t)(m - T_LAT) * 1024 : C.out + (size_t)m * 1024; bf16* xrb = xlb + (size_t)m * 1024;
        const int mrow = isctx ? 8 : (m >> 12);
        const float* gv = modv + (size_t)mrow * 6144;
        const int p0 = pos[(size_t)m * 2], p1 = pos[(size_t)m * 2 + 1];
        const float w0 = __builtin_bit_cast(float, route[(size_t)m * 8 + 4]), w1 = __builtin_bit_cast(float, route[(size_t)m * 8 + 5]);
        f32x4 x[4]; float ss = 0.f;
#pragma unroll
        for (int j = 0; j < 4; ++j) {
            const int col = 4 * C.lane + 256 * j;
            const v2u a = *(const v2u*)(ym + (size_t)p0 * 1024 + col), b = *(const v2u*)(ym + (size_t)p1 * 1024 + col);
            const f32x4 ya = (f32x4){bflo(a.x), bfhi(a.x), bflo(a.y), bfhi(a.y)}, yb = (f32x4){bflo(b.x), bfhi(b.x), bflo(b.y), bfhi(b.y)};
            const f32x4 g = *(const f32x4*)(gv + col);
            x[j] = (isctx ? *(const f32x4*)(xr + col) : ld4bf(xrb + col)) + g * (ya * w0 + yb * w1);
            if (NEXT != 2) { if (isctx) *(f32x4*)(xr + col) = x[j]; else st4bf(xrb + col, x[j]); }
            ss += (x[j].x * x[j].x + x[j].y * x[j].y) + (x[j].z * x[j].z + x[j].w * x[j].w);
        }
        if (NEXT != 0) {
            const float rs = rsqrtf_(wave_sum(ss) * (1.0f / 1024.0f) + 1e-6f);
#pragma unroll
            for (int j = 0; j < 4; ++j) {
                const int col = 4 * C.lane + 256 * j;
                if (NEXT == 2) *(f32x4*)(xr + col) = x[j] * rs * gn[j];
                else { const f32x4 sh = *(const f32x4*)(modn + (size_t)mrow * 6144 + col), scl = *(const f32x4*)(modn + (size_t)mrow * 6144 + 1024 + col);
                    st4bf(hb + (size_t)m * 1024 + col, (x[j] * rs * gn[j]) * (scl + 1.0f) + sh); }
            }
        }
    }
}
__device__ __forceinline__ void final_norm(const Ctx& C) {
    const int gw = C.wg * NWAVES + C.wave, NGW = C.G * NWAVES;
    f32x4 gv[4];
#pragma unroll
    for (int j = 0; j < 4; ++j) gv[j] = *(const f32x4*)(C.in[I_FNG] + 4 * C.lane + 256 * j);
    for (int m = gw; m < T_LAT; m += NGW) {
        float* xr = C.out + (size_t)m * 1024;
        f32x4 v[4]; float s = 0.f;
#pragma unroll
        for (int j = 0; j < 4; ++j) { v[j] = *(const f32x4*)(xr + 4 * C.lane + 256 * j); s += (v[j].x * v[j].x + v[j].y * v[j].y) + (v[j].z * v[j].z + v[j].w * v[j].w); }
        const float rs = rsqrtf_(wave_sum(s) * (1.0f / 1024.0f) + 1e-6f);
#pragma unroll
        for (int j = 0; j < 4; ++j) *(f32x4*)(xr + 4 * C.lane + 256 * j) = v[j] * rs * gv[j];
    }
}

constexpr int NPH_L = 13, PH_FINAL = 1 + DEPTH * NPH_L, NPHASE = PH_FINAL + 1;
__host__ __device__ inline bool phase_exists(int ph) {
    if (ph == 0) return true;
    if (ph == PH_FINAL) return false;
    const int l = (ph - 1) / NPH_L, k = (ph - 1) % NPH_L;
    if (l >= 2 && !(l & 1) && k == 0) return false;
    if (!(l & 1) && k >= 11) return false;
    if (!RW_VSPLIT && k == 4) return false;
    return true;
}
#ifndef PH_MASK
#define PH_MASK 0xFFFFFF
#endif
#define PM(k) ((PH_MASK >> (k)) & 1)
#ifndef SK_MASK
#define SK_MASK 0xFFFF
#endif
#define SK(k) ((SK_MASK >> (k)) & 1)
#ifndef REP_MASK
#define REP_MASK 0
#endif
#define NREP(k) (((REP_MASK >> (k)) & 1) ? 2 : 1)

__global__ void __launch_bounds__(NTHR, 2) fwd_kernel(Args args) {
    extern __shared__ __attribute__((aligned(16))) unsigned char lds_raw[];
    Ctx C; C.in = args.in; C.out = args.out; C.ws = args.ws; C.lds = (LAS unsigned char*)lds_raw;
    C.tid = threadIdx.x; C.lane = C.tid & 63; C.wave = __builtin_amdgcn_readfirstlane(C.tid >> 6); C.G = gridDim.x; C.wg = blockIdx.x;
    volatile LAS unsigned* MISC = (volatile LAS unsigned*)(C.lds + MISC_OFF);
    if (C.tid < 64) MISC[C.tid] = 0u;
    __syncthreads();
    const int lo = args.ph_lo, hi = args.ph_hi;
    const bool multi = (hi - lo) > 1;
    if (multi) (void)xcd_barrier_post(WSP(unsigned, WS_CTL) + CW_BAR, MISC + 8);
#define IN(k) (lo <= (k) && (k) < hi)
#define SEAM(k) do { if (IN((k) + 1)) { XcdBarrier b2_; b2_.bar = WSP(unsigned, WS_CTL) + CW_BAR; b2_.x = xb_xcc_id(); b2_.st = (volatile LAS unsigned*)(C.lds + MISC_OFF) + 8; xcd_barrier(b2_); } } while (0)
#define FRESH() do { int t_ = threadIdx.x; asm volatile("" : "+v"(t_)); C.tid = t_; C.lane = t_ & 63; C.wave = __builtin_amdgcn_readfirstlane(t_ >> 6); } while (0)
#define PHASE(bit, k) if (PM(bit) && IN(pb + (k))) for (int rep_ = 0; rep_ < NREP(bit); ++rep_)
#define CLAIM(qh, var) __syncthreads(); if (C.tid == 0) *qslot = atomicAdd((qh), 1u); __syncthreads(); const int var = (int)*qslot;

    LAS unsigned* qslot = (LAS unsigned*)(C.lds + MISC_OFF + 128);
    constexpr int NCSL = 512;
    if (PM(20) && IN(0)) { phase_pre(C);
        for (;;) { FRESH(); CLAIM(WSP(unsigned, WS_CTL) + CW_PREPQ + 224, u0) if (u0 >= NCSL) break; FRESH(); convert_items(C, 0, 3, u0 * NWAVES + C.wave, NCSL * NWAVES); }
        SEAM(0); }

#pragma unroll 1
    for (int l = 0; l < DEPTH; ++l) {
        const int pb = 1 + l * NPH_L;
        if (hi <= pb || lo >= pb + NPH_L) continue;
        const bool last = (l == DEPTH - 1), moe = (l & 1);
        const int nrows = last ? T_LAT : T_ALL;
        const void* xlat = (l == 0) ? (const void*)C.in[I_X] : (const void*)C.out; const bool xbf = l > 0; void* xmid = last ? (void*)WSP(bf16, WS_XLAST) : (void*)C.out;
        const float* xctx = (l == 0) ? C.in[I_CTX] : WSP(const float, WS_XC);
        const float* modv = WSP(const float, WS_MODV) + (size_t)l * 9 * 6144;
        unsigned* qbase = WSP(unsigned, WS_CTL) + CW_PREPQ + 256 * l;

        if (!(l >= 2 && !(l & 1))) PHASE(0, 0) { FRESH();
            convert_small(C, l);
            __syncthreads();
            FRESH(); norm_rows<false>(C, l, xlat, xbf, xctx, C.in[I_NMIXG] + l * 1024, 0, 1024, T_ALL, 0);
            SEAM(pb + 0);
        }
        PHASE(1, 1) { FRESH();
            pg8::Gemm g{WSP(const bf16, WS_HB), WSP(const bf16, WS_WIN), T_ALL, PLD, 1024, 0};
            pg8::StaticOrder S; S.init(T_ALL, PLD, C.G, C.wg);
            pg8::EpiBf16<0> E{WSP(bf16, WS_P), PLD, nullptr, 0, 0};
            pg8::gemm_phase<pg8::EpiBf16<0>, pg8::StaticOrder, false>(C.lds, g, S, E, nullptr);
            SEAM(pb + 1);
        }
        if (PM(2) && IN(pb + 2)) for (int rep_ = 0; rep_ < NREP(2); ++rep_) { FRESH();
            for (;;) {
                CLAIM(qbase + 16 * rep_, k)
                if (k >= 2 * NB * NCH) break;
                const int kind = k / (NB * NCH), u = k % (NB * NCH);
                FRESH();
                if (kind == 0) { for (int r3_ = 0; r3_ < NREP(24); ++r3_) { FRESH(); if (SK(1)) rwkv_prep2(C, l, u / NCH, u % NCH); } }
                else { for (int r3_ = 0; r3_ < NREP(26); ++r3_) { FRESH(); if (SK(2)) gdn_prep(C, l, u / NCH, u % NCH); } }
            }
            SEAM(pb + 2);
        }
        if (PM(3) && IN(pb + 3)) for (int rep_ = 0; rep_ < NREP(3); ++rep_) { FRESH();
            constexpr int NCL = 2 * NB * NH * NCH / 4;
            int ncl_ = 0;
            for (;;) {
                CLAIM(qbase + 64 + 16 * rep_, k)
                if (k >= NCL) break;
                FRESH(); ++ncl_;
                if (SK(10)) rwkv_solve_item(C, l, 4 * k + (C.wave >> 1));
            }
            if (ncl_ <= 4) { const int cap_ = (l & 1) ? 1 : 3;
                for (int j_ = 0; j_ < cap_; ++j_) {
                    FRESH(); CLAIM(qbase + 192, u0)
                    if (u0 >= NCSL) break;
                    FRESH(); if (l > 0) convert_items(C, l, 2, u0 * NWAVES + C.wave, NCSL * NWAVES);
                    if (l + 1 < DEPTH) { FRESH(); convert_items(C, l + 1, 1, u0 * NWAVES + C.wave, NCSL * NWAVES); }
                }
            }
            SEAM(pb + (RW_VSPLIT ? 3 : 4));
        }
#if RW_VSPLIT
        if (PM(3) && IN(pb + 4)) { FRESH();
            for (;;) {
                CLAIM(qbase + 128, k)
                if (k >= 2 * NB * NH * NCH / 4) break;
                FRESH();
                if (SK(10)) rwkv_solve_item(C, l, 4 * k + (C.wave >> 1));
            }
            SEAM(pb + 4);
        }
#endif
        if (PM(4) && IN(pb + 5)) { FRESH();
            if (C.wg >= 64) {
                constexpr int NCL = 2 * NB * NH * NCH / 4;
                for (;;) {
                    CLAIM(qbase + 128, k)
                    if (k >= NCL) break;
                    FRESH();
                    if (SK(9)) gdn_solve_item(C, l, 4 * k + (C.wave >> 1));
                }
                asm volatile("s_waitcnt vmcnt(0)" ::: "memory");
                __syncthreads();
                if (C.tid == 0) { __builtin_amdgcn_fence(__ATOMIC_RELEASE, "agent"); asm volatile("s_waitcnt vmcnt(0)" ::: "memory"); (void)xb_add(qbase + 160, 1u); }
                if (C.wg >= 192) {
                    if (C.tid == 0) { unsigned* bar_ = WSP(unsigned, WS_CTL) + CW_BAR; XB_SPIN(xb_ld(qbase + 160) < (unsigned)(C.G - 64), bar_); __builtin_amdgcn_fence(__ATOMIC_ACQUIRE, "agent"); asm volatile("s_waitcnt vmcnt(0)" ::: "memory"); }
                    __syncthreads();
                }
                FRESH();
            }
            if (C.wg >= 64 && C.wg < 128) { if (SK(0)) lru_chain(C, l, C.wg - 64); FRESH(); }
            if (SK(3) && C.wg < (RW_VSPLIT ? 128 : 64)) { if (NREP(20) > 1) { FRESH(); rwkv_chunked<true>(C, l, C.wg); } FRESH(); rwkv_chunked<false>(C, l, C.wg); }
            else if (SK(4) && C.wg >= 128 && C.wg < 192) { for (int r2_ = 0; r2_ < NREP(21); ++r2_) { FRESH(); mlstm_chunked(C, l, C.wg - 128); } }
            else if (SK(5) && C.wg >= 192) { if (NREP(22) > 1) { FRESH(); gdn_chunked<true>(C, l, C.wg - 192); } FRESH(); gdn_chunked<false>(C, l, C.wg - 192); }
            {
                FRESH();
                const int nun = 0;
                for (;;) {
                    CLAIM(qbase + 192, u0)
                    if (u0 >= NCSL + nun) break;
                    if (u0 < NCSL) {
                        FRESH(); if (l > 0) convert_items(C, l, 2, u0 * NWAVES + C.wave, NCSL * NWAVES);
                        if (l + 1 < DEPTH) { FRESH(); convert_items(C, l + 1, 1, u0 * NWAVES + C.wave, NCSL * NWAVES); }
                    }
                }
            }
            SEAM(pb + 5);
        }
        PHASE(5, 6) { FRESH();
            if (SK(8)) finish_rows(C, l, nrows);
            SEAM(pb + 6);
        }
        if (PM(6) && IN(pb + 7)) { FRESH();
            pg8::Gemm g{WSP(const bf16, WS_HB), WSP(const bf16, WS_WOUT), nrows, 1024, 1024, 0};
            pg8::StaticOrder S; S.init(nrows, 1024, C.G, C.wg);
            pg8::EpiRes E{xlat, xctx, xmid, WSP(float, WS_XC), modv + 2 * 1024, xbf, true};
            pg8::gemm_phase<pg8::EpiRes, pg8::StaticOrder, false>(C.lds, g, S, E, nullptr);
            SEAM(pb + 7);
        }
        if (PM(7) && IN(pb + 8)) { FRESH();
            if (moe) norm_rows<true>(C, l, xmid, true, WSP(const float, WS_XC), C.in[I_NFFNG] + l * 1024, 3 * 1024, 4 * 1024, nrows, l >> 1);
            else norm_rows<false>(C, l, xmid, true, WSP(const float, WS_XC), C.in[I_NFFNG] + l * 1024, 3 * 1024, 4 * 1024, nrows, 0);
            SEAM(pb + 8);
        }
        if (!moe) {
            if (PM(8) && IN(pb + 9)) for (int rep_ = 0; rep_ < NREP(8); ++rep_) { FRESH();
                pg8::Gemm g{WSP(const bf16, WS_HB), WSP(const bf16, WS_WGU), nrows, 2 * DFF, 1024, 0};
                pg8::StaticOrder S; S.init(nrows, 2 * DFF, C.G, C.wg);
                pg8::EpiSwiglu E{WSP(bf16, WS_P), DFF};
                pg8::gemm_phase<pg8::EpiSwiglu, pg8::StaticOrder, false>(C.lds, g, S, E, nullptr);
                SEAM(pb + 9);
            }
            if (PM(9) && IN(pb + 10)) { FRESH();
                pg8::Gemm g{WSP(const bf16, WS_P), WSP(const bf16, WS_WDN), nrows, 1024, DFF, 0};
                pg8::StaticOrder S; S.init(nrows, 1024, C.G, C.wg);
                pg8::EpiRes E{xmid, WSP(const float, WS_XC), xmid, WSP(float, WS_XC), modv + 5 * 1024, true, true};
                pg8::gemm_phase<pg8::EpiRes, pg8::StaticOrder, false>(C.lds, g, S, E, nullptr);
                SEAM(pb + 12);
            }
        } else {
            if (PM(10) && IN(pb + 9)) { FRESH(); moe_scatter(C, l >> 1, nrows); SEAM(pb + 9); }
            if (PM(11) && IN(pb + 10)) for (int rep_ = 0; rep_ < NREP(11); ++rep_) { FRESH();
                pg8::Gemm g{WSP(const bf16, WS_HB), WSP(const bf16, WS_WGU), 0, 2 * DFE, 1024, (size_t)2 * DFE * 1024};
                pg8::MoeOrderG S; S.init(WSP(const int, WS_TAB), (2 * DFE) / 256, C.G, C.wg); S.tok = WSP(const int, WS_TOK);
                pg8::EpiSwiglu E{WSP(bf16, WS_P), DFE};
                pg8::gemm_phase<pg8::EpiSwiglu, pg8::MoeOrderG, false>(C.lds, g, S, E, nullptr);
                SEAM(pb + 10);
            }
            if (PM(12) && IN(pb + 11)) for (int rep_ = 0; rep_ < NREP(12); ++rep_) { FRESH();
                pg8::Gemm g{WSP(const bf16, WS_P), WSP(const bf16, WS_WDN), 0, 1024, DFE, (size_t)1024 * DFE};
                pg8::MoeOrder S; S.init(WSP(const int, WS_TAB), 4, C.G, C.wg);
                pg8::EpiBf16<0> E{WSP(bf16, WS_MIX), 1024, nullptr, 0, 0};
                pg8::gemm_phase<pg8::EpiBf16<0>, pg8::MoeOrder, false>(C.lds, g, S, E, nullptr);
                SEAM(pb + 11);
            }
            if (PM(13) && IN(pb + 12)) { FRESH();
                if (last) moe_combine<2>(C, l, nrows);
                else { convert_small(C, l + 1); FRESH(); moe_combine<1>(C, l, nrows); if (IN(pb + NPH_L + 1)) { XcdBarrier b2_; b2_.bar = WSP(unsigned, WS_CTL) + CW_BAR; b2_.x = xb_xcc_id(); b2_.st = (volatile LAS unsigned*)(C.lds + MISC_OFF) + 8; xcd_barrier(b2_); } }
            }
        }
    }
}

extern "C" void kernel_launch(void* const* d_in, const int* in_sizes, int n_in, void* d_out, int out_size, void* d_ws, size_t ws_size, hipStream_t stream) {
    static int grid = 0;
    if (grid == 0) {
        if (n_in != N_IN || in_sizes[0] != T_LAT * DM || out_size != T_LAT * DM || ws_size < WS_END) {
            fprintf(stderr, "kernel_launch: unexpected problem (n_in %d, in0 %d, out %d, ws %zu < %zu)\n", n_in, n_in > 0 ? in_sizes[0] : -1, out_size, ws_size, (size_t)WS_END); grid = -1; return; }
        int dev = 0, cus = 0, per_cu = 0;
        if (hipGetDevice(&dev) != hipSuccess || hipDeviceGetAttribute(&cus, hipDeviceAttributeMultiprocessorCount, dev) != hipSuccess) { grid = -1; return; }
        if (hipFuncSetAttribute((const void*)fwd_kernel, hipFuncAttributeMaxDynamicSharedMemorySize, LDS_BYTES) != hipSuccess) { fprintf(stderr, "kernel_launch: hipFuncSetAttribute failed\n"); grid = -1; return; }
        if (hipOccupancyMaxActiveBlocksPerMultiprocessor(&per_cu, (const void*)fwd_kernel, NTHR, LDS_BYTES) != hipSuccess || per_cu < 1) { fprintf(stderr, "kernel_launch: occupancy query says %d\n", per_cu); grid = -1; return; }
        grid = cus;
        if (grid != 256) fprintf(stderr, "kernel_launch: note: %d CUs\n", grid);
    }
    if (grid < 0) return;
    if (hipMemsetAsync((char*)d_ws + WS_CTL, 0, CTL_BYTES, stream) != hipSuccess) return;
    Args a{};
    for (int i = 0; i < N_IN; ++i) a.in[i] = (const float*)d_in[i];
    a.out = (float*)d_out; a.ws = (unsigned char*)d_ws;
#if MK_ONE_LAUNCH
    a.ph_lo = 0; a.ph_hi = NPHASE;
    hipLaunchKernelGGL(fwd_kernel, dim3(grid), dim3(NTHR), LDS_BYTES, stream, a);
#else
    for (int ph = 0; ph < NPHASE; ++ph) { if (!phase_exists(ph)) continue; a.ph_lo = ph; a.ph_hi = ph + 1; hipLaunchKernelGGL(fwd_kernel, dim3(grid), dim3(NTHR), LDS_BYTES, stream, a); }
#endif
}
```

```cpp
#define MK_ONE_LAUNCH 1
#include <hip/hip_runtime.h>
#include <cstdio>
#include <cstdint>

#define GAS __attribute__((address_space(1)))
#define LAS __attribute__((address_space(3)))
typedef unsigned short bf16;
typedef unsigned v4u __attribute__((ext_vector_type(4)));
typedef unsigned v2u __attribute__((ext_vector_type(2)));
typedef float f32x4 __attribute__((ext_vector_type(4)));
typedef float f32x2 __attribute__((ext_vector_type(2)));
typedef short bf16x8 __attribute__((ext_vector_type(8)));
#define LDS_WAIT() asm volatile("s_waitcnt lgkmcnt(0)" ::: "memory")
#define VM_WAIT() asm volatile("s_waitcnt vmcnt(0)" ::: "memory")

constexpr int DM = 1024, NB = 8, SEQ = 4096, DEPTH = 4, CTXL = 256, GW = 256, HD = 64, NH = 4;
constexpr int T_LAT = NB * SEQ, T_CTX = NB * CTXL, T_ALL = T_LAT + T_CTX;
constexpr int IN_COLS = 3552, PLD = 3584;
constexpr int OFF_B = 512, OFF_C = 1472, OFF_D = 2512, B_COLS = 960;
constexpr int DFF = 2816, NE = 8, DFE = 1408;
constexpr int NCH = 68;
constexpr int NSTEP = 4352;
constexpr int MOE_MAXBLK = 280;
constexpr int NWAVES = 8, NTHR = 512;
#ifndef RW_VSPLIT
#define RW_VSPLIT 0
#endif

constexpr size_t MiB = 1u << 20;
constexpr size_t WS_CTL = 0, CTL_BYTES = 1 * MiB;
constexpr size_t WS_MODV = 1 * MiB;
constexpr size_t WS_XC = 2 * MiB;
constexpr size_t WS_WIN = 10 * MiB;
constexpr size_t WS_WOUT = 17 * MiB;
constexpr size_t WS_WGU = 19 * MiB;
constexpr size_t WS_WDN = 63 * MiB;
constexpr size_t WS_HB = 85 * MiB;
constexpr size_t WS_P = 153 * MiB;
constexpr size_t WS_MIX = 391 * MiB;
constexpr size_t WS_OUTB = WS_MIX, WS_OUTC = WS_MIX + 34 * MiB, WS_OUTD = WS_MIX + 68 * MiB, WS_GQ = WS_MIX + 102 * MiB, WS_G = WS_MIX + 153 * MiB;
constexpr size_t WS_XLAST = WS_MIX + 144 * MiB;
constexpr size_t WS_RKV = WS_MIX + 170 * MiB;
constexpr size_t WS_SMALL = 612 * MiB;
constexpr size_t WS_ROUTE = WS_SMALL;
constexpr size_t WS_POS = WS_SMALL + 1280 * 1024;
constexpr size_t WS_TOK = WS_SMALL + 1664 * 1024;
constexpr size_t WS_BONUS = WS_SMALL + 2 * MiB;
constexpr size_t WS_RINV = WS_SMALL + 2 * MiB + 640 * 1024;
constexpr size_t WS_WGBASE = WS_SMALL + 3 * MiB + 256 * 1024;
constexpr size_t WS_TAB = WS_WGBASE + 65536;
constexpr size_t WS_LRUWT = WS_SMALL + 3 * MiB + 512 * 1024;
constexpr size_t WS_RWT = WS_LRUWT + 131072;
constexpr size_t WS_LRUH = WS_SMALL + 4 * MiB;
constexpr size_t WS_END = 633 * MiB;
constexpr int CW_MOECNT = 1024;
constexpr int CW_PREPQ = 2048;
constexpr int CW_BAR = 4096;

constexpr int LDS_BYTES = 135168;
constexpr int MISC_OFF = 131072;

__device__ __forceinline__ unsigned f2bf(float f) { unsigned u = __builtin_bit_cast(unsigned, f); return (u + 0x7fffu + ((u >> 16) & 1u)) >> 16; }
typedef __bf16 bf16n2 __attribute__((ext_vector_type(2)));
__device__ __forceinline__ unsigned pk2(float lo, float hi) { const f32x2 v = {lo, hi}; return __builtin_bit_cast(unsigned, __builtin_convertvector(v, bf16n2)); }
__device__ __forceinline__ unsigned f2bf1(float f) { return pk2(f, f) & 0xffffu; }
__device__ __forceinline__ float bf2f(unsigned short v) { return __builtin_bit_cast(float, (unsigned)v << 16); }
__device__ __forceinline__ float bflo(unsigned v) { return __builtin_bit_cast(float, v << 16); }
__device__ __forceinline__ float bfhi(unsigned v) { return __builtin_bit_cast(float, v & 0xffff0000u); }
template <int CTRL, int RM, bool BC> __device__ __forceinline__ float dpp_x(float oldv, float v) { return __builtin_bit_cast(float, __builtin_amdgcn_update_dpp(__builtin_bit_cast(int, oldv), __builtin_bit_cast(int, v), CTRL, RM, 0xF, BC)); }
__device__ __forceinline__ float wave_sum(float v) {
    v += dpp_x<0xB1, 0xF, true>(0.f, v); v += dpp_x<0x4E, 0xF, true>(0.f, v); v += dpp_x<0x141, 0xF, true>(0.f, v); v += dpp_x<0x140, 0xF, true>(0.f, v);
    v += dpp_x<0x142, 0xA, false>(0.f, v); v += dpp_x<0x143, 0xC, false>(0.f, v);
    return __builtin_bit_cast(float, __builtin_amdgcn_readlane(__builtin_bit_cast(int, v), 63));
}
template <int CTRL> __device__ __forceinline__ float dpp_f(float v) { return __builtin_bit_cast(float, __builtin_amdgcn_update_dpp(0, __builtin_bit_cast(int, v), CTRL, 0xF, 0xF, true)); }
__device__ __forceinline__ float row16_sum(float v) {
    v += dpp_f<0xB1>(v);
    v += dpp_f<0x4E>(v);
    v += dpp_f<0x141>(v);
    v += dpp_f<0x140>(v);
    return v;
}
__device__ __forceinline__ float sigmoidf_(float x) { return __builtin_amdgcn_rcpf(1.0f + __expf(-x)); }
__device__ __forceinline__ float softplusf_(float x) { return fmaxf(x, 0.f) + __logf(1.0f + __expf(-fabsf(x))); }
__device__ __forceinline__ float expm1f_(float x) { return x > -0.3f ? x * (1.0f + x * (0.5f + x * (0.16666667f + x * (0.041666668f + x * 0.0083333338f)))) : __expf(x) - 1.0f; }
__device__ __forceinline__ float siluf_(float x) { return x * __builtin_amdgcn_rcpf(1.0f + __expf(-x)); }
__device__ __forceinline__ float tanhf_(float x) { const float e = __expf(2.0f * x); return 1.0f - 2.0f * __builtin_amdgcn_rcpf(e + 1.0f); }
__device__ __forceinline__ float rsqrtf_(float x) { return __builtin_amdgcn_rsqf(x); }
__device__ __forceinline__ float gelu_tanh(float x) { return 0.5f * x * (1.0f + tanhf_(0.7978845608028654f * (x + 0.044715f * x * x * x))); }
__device__ __forceinline__ f32x4 ld4bf(const bf16* p) { const v2u a = *(const v2u*)p; return (f32x4){bflo(a.x), bfhi(a.x), bflo(a.y), bfhi(a.y)}; }
__device__ __forceinline__ void st4bf(bf16* p, const f32x4& v) { v2u o; o.x = pk2(v.x, v.y); o.y = pk2(v.z, v.w); *(v2u*)p = o; }
#define XB_TMO      128
#define XB_XCNT(j)  (256  + 64 * (j))
#define XB_XSUB(j)  (1280 + 64 * (j))
#define XB_XGEN(j)  (2304 + 64 * (j))
#define XB_TOP      3328
#define XB_TOPGEN   3392
#define XCD_BAR_WORDS 3456
#define XB_SPIN_CAP (1u << 22)

__device__ __forceinline__ unsigned xb_ld(unsigned* p)              { return __hip_atomic_load(p, __ATOMIC_RELAXED, __HIP_MEMORY_SCOPE_AGENT); }
__device__ __forceinline__ unsigned xb_add(unsigned* p, unsigned v) { return __hip_atomic_fetch_add(p, v, __ATOMIC_RELAXED, __HIP_MEMORY_SCOPE_AGENT); }
__device__ __forceinline__ unsigned xb_xcc_id() { return (unsigned)__builtin_amdgcn_s_getreg((3 << 11) | 20) & 0xFu; }
#define XB_SPIN(cond, bar) do { unsigned _sp = 0; while (cond) { __builtin_amdgcn_s_sleep(1); \
    if ((++_sp & 255u) == 0u) { if (xb_ld(&(bar)[XB_TMO])) break; if (_sp > XB_SPIN_CAP) { atomicAdd(&(bar)[XB_TMO], 1u); break; } } } } while (0)

struct XcdBarrier {
    unsigned* bar; unsigned x;
    volatile LAS unsigned* st;
};

__device__ __forceinline__ XcdBarrier xcd_barrier_post(unsigned* bar, volatile LAS unsigned* st) {
    XcdBarrier b; b.bar = bar; b.x = xb_xcc_id(); b.st = st;
    if (threadIdx.x == 0) (void)xb_add(&bar[XB_XCNT(b.x)], 1u);
    return b;
}
__device__ __forceinline__ void xcd_barrier_complete(unsigned* bar, unsigned x, unsigned& nloc, unsigned& nx) {
    const unsigned G = gridDim.x * gridDim.y * gridDim.z;
    unsigned sum, cnt, mine, sp = 0u;
    for (;;) {
        sum = 0u; cnt = 0u; mine = 0u;
#pragma unroll
        for (unsigned j = 0; j < 16; ++j) { const unsigned c = xb_ld(&bar[XB_XCNT(j)]); sum += c; cnt += (c > 0u) ? 1u : 0u; mine = (j == x) ? c : mine; }
        if (sum == G) break;
        __builtin_amdgcn_s_sleep(1);
        if ((++sp & 255u) == 0u) { if (xb_ld(&bar[XB_TMO])) break; if (sp > XB_SPIN_CAP) { atomicAdd(&bar[XB_TMO], 1u); break; } }
    }
    nloc = mine > 0u ? mine : 1u; nx = cnt > 0u ? cnt : 1u;
}

__device__ __forceinline__ void xcd_barrier(const XcdBarrier& b) {
    asm volatile("s_waitcnt vmcnt(0)" ::: "memory");
    __syncthreads();
    if (threadIdx.x == 0) {
        unsigned* bar = b.bar;
        __builtin_amdgcn_s_waitcnt(0);
        unsigned nloc = b.st[0], nx = b.st[1];
        if (nloc == 0u) { xcd_barrier_complete(bar, b.x, nloc, nx); b.st[0] = nloc; b.st[1] = nx; }
        const unsigned old = xb_add(&bar[XB_XSUB(b.x)], 1u);
        const unsigned gen = old / nloc;
        if (old + 1u == (gen + 1u) * nloc) {
            __builtin_amdgcn_fence(__ATOMIC_RELEASE, "agent");
            asm volatile("s_waitcnt vmcnt(0)" ::: "memory");
            const unsigned og = xb_add(&bar[XB_TOP], 1u);
            const unsigned tg = og / nx;
            if (og + 1u == (tg + 1u) * nx) xb_add(&bar[XB_TOPGEN], 1u);
            else XB_SPIN(xb_ld(&bar[XB_TOPGEN]) == tg, bar);
            __builtin_amdgcn_fence(__ATOMIC_ACQUIRE, "agent");
            xb_add(&bar[XB_XGEN(b.x)], 1u);
            asm volatile("s_waitcnt vmcnt(0)" ::: "memory");
        } else {
            XB_SPIN(xb_ld(&bar[XB_XGEN(b.x)]) == gen, bar);
            __builtin_amdgcn_fence(__ATOMIC_ACQUIRE, "agent");
            asm volatile("s_waitcnt vmcnt(0)" ::: "memory");
        }
    }
    __syncthreads();
}

namespace pg8 {
#define PG8_LAS __attribute__((address_space(3)))
typedef unsigned short bf16_t;
typedef short bf16x8 __attribute__((ext_vector_type(8)));
typedef float f32x4 __attribute__((ext_vector_type(4)));
typedef unsigned u32x4 __attribute__((ext_vector_type(4)));
constexpr int BM = 256, BK = 64, HALF = 128, HTB = HALF * BK * 2  , STAGE_BYTES = 8 * HTB, NXCD = 8, WGM = 8;

__host__ __device__ __forceinline__ int lds_byte(int r, int c) { const int st = (r >> 4) * 2 + (c >> 5), rr = r & 15, cc = c & 31, ob = rr * 64 + cc * 2; return st * 1024 + (ob ^ (((ob >> 9) & 1) << 5)); }
__host__ __device__ __forceinline__ void stage_rc(int b, int& R, int& C) { const int st = b / 1024, sb = b % 1024, swz = sb ^ (((sb >> 9) & 1) << 5); R = (st >> 1) * 16 + swz / 64; C = (st & 1) * 32 + (swz % 64) / 2; }
__host__ __device__ __forceinline__ int perm32(int rho) { const int n = rho >> 4, i = rho & 15; return 8 * (i >> 2) + 4 * n + (i & 3); }

struct Unit { int pm, pn, e; };
struct Gemm { const bf16_t* A; const bf16_t* Bt; int M, N, K; size_t estride; };

struct StaticOrder {
    static constexpr bool GATHER = false;
    int nM, nN, nwg, G, c;
    __host__ __device__ void init(int M, int N, int G_, int c_) { nM = M / BM; nN = N / BM; nwg = nM * nN; G = G_; c = c_; }
    __host__ __device__ bool next(int i, Unit& u) const {
        const long L = (long)i * G + c; if (L >= nwg) return false;
        int wgid = (int)L; { const int q = nwg / NXCD, r = nwg % NXCD, xcd = wgid % NXCD, off = wgid / NXCD; wgid = (xcd < r ? xcd * (q + 1) : r * (q + 1) + (xcd - r) * q) + off; }
        const int nig = WGM * nN, gid = wgid / nig, fm = gid * WGM, gsz = (nM - fm) < WGM ? (nM - fm) : WGM;
        u.pm = fm + ((wgid % nig) % gsz); u.pn = (wgid % nig) / gsz; u.e = 0; return true;
    }
    __device__ __forceinline__ void a_ready(const Unit&) const {}
    __device__ __forceinline__ void done(const Unit&) const {}
};
typedef __bf16 bf16n2_ __attribute__((ext_vector_type(2)));
__device__ __forceinline__ unsigned cvt_pk_bf16(float lo, float hi) { typedef float f2_ __attribute__((ext_vector_type(2))); const f2_ v = {lo, hi}; return __builtin_bit_cast(unsigned, __builtin_convertvector(v, bf16n2_)); }
typedef float f32x2 __attribute__((ext_vector_type(2)));
__device__ __forceinline__ f32x2 gelu_pk(f32x2 v) {
    const f32x2 av = __builtin_elementwise_abs(v), d = av * 0.2316418882f + 1.0f;
    f32x2 t; t.x = __builtin_amdgcn_rcpf(d.x); t.y = __builtin_amdgcn_rcpf(d.y);
    f32x2 q = t * 0.5307027145f + (-0.7265760135f); q = q * t + 0.7107068705f; q = q * t + (-0.142248368f); q = q * t + 0.127414796f; q = q * t;
    const f32x2 s = (v * v) * (-0.72134752044f);
    f32x2 e; e.x = __builtin_amdgcn_exp2f(s.x); e.y = __builtin_amdgcn_exp2f(s.y);
    const f32x2 m = v * (q * e), r = v - m;
    f32x2 o; o.x = v.x < 0.f ? m.x : r.x; o.y = v.y < 0.f ? m.y : r.y; return o;
}

struct EpiF32 {
    static constexpr bool PERM = false, AFTER_DRAIN = false;
    float* C; int ldc; const float* bias;
    __device__ __forceinline__ void operator()(const f32x4 (&acc)[2][2][4][2], const Unit& u, int wr, int wc, int fr, int fq) const {
        const int row0 = u.pm * BM + wr * 64 + fr, col0 = u.pn * BM + wc * 32 + 4 * fq;
        f32x4 bv[2][2];
#pragma unroll
        for (int bj = 0; bj < 2; ++bj)
#pragma unroll
            for (int n = 0; n < 2; ++n) bv[bj][n] = bias ? *(const f32x4*)(bias + col0 + bj * HALF + n * 16) : (f32x4){0.f, 0.f, 0.f, 0.f};
#pragma unroll
        for (int ai = 0; ai < 2; ++ai)
#pragma unroll
            for (int m = 0; m < 4; ++m) { float* rowp = C + (size_t)(row0 + ai * HALF + m * 16) * ldc + col0;
#pragma unroll
                for (int bj = 0; bj < 2; ++bj)
#pragma unroll
                    for (int n = 0; n < 2; ++n) *(f32x4*)(rowp + bj * HALF + n * 16) = acc[ai][bj][m][n] + bv[bj][n]; }
    }
};
template <int ACT  > struct EpiBf16 {
    static constexpr bool PERM = true, AFTER_DRAIN = false;
    bf16_t* O; int ldc; const float* bias; int split_cols; size_t split_stride;
    __device__ __forceinline__ void operator()(const f32x4 (&acc)[2][2][4][2], const Unit& u, int wr, int wc, int fr, int fq) const {
        const int row0 = u.pm * BM + wr * 64 + fr; int colt = u.pn * BM; bf16_t* base = O;
        if (split_cols) { const int t = colt / split_cols; base += (size_t)t * split_stride; colt -= t * split_cols; }
        const int col0 = colt + wc * 32 + 8 * fq, bcol0 = u.pn * BM + wc * 32 + 8 * fq;
        f32x4 bv[2][2];
#pragma unroll
        for (int bj = 0; bj < 2; ++bj)
#pragma unroll
            for (int n = 0; n < 2; ++n) bv[bj][n] = bias ? *(const f32x4*)(bias + bcol0 + bj * HALF + 4 * n) : (f32x4){0.f, 0.f, 0.f, 0.f};
#pragma unroll
        for (int ai = 0; ai < 2; ++ai)
#pragma unroll
            for (int m = 0; m < 4; ++m) { bf16_t* rowp = base + (size_t)(row0 + ai * HALF + m * 16) * ldc + col0;
#pragma unroll
                for (int bj = 0; bj < 2; ++bj) { f32x4 v0 = acc[ai][bj][m][0] + bv[bj][0], v1 = acc[ai][bj][m][1] + bv[bj][1];
                    if (ACT == 1) { f32x2 a = gelu_pk((f32x2){v0[0], v0[1]}), b = gelu_pk((f32x2){v0[2], v0[3]}), c = gelu_pk((f32x2){v1[0], v1[1]}), d = gelu_pk((f32x2){v1[2], v1[3]});
                        v0 = (f32x4){a.x, a.y, b.x, b.y}; v1 = (f32x4){c.x, c.y, d.x, d.y}; }
                    if (ACT == 2) {
#pragma unroll
                        for (int j = 0; j < 4; ++j) { v0[j] = 0.5f * v0[j] * (1.0f + erff(v0[j] * 0.70710678f)); v1[j] = 0.5f * v1[j] * (1.0f + erff(v1[j] * 0.70710678f)); } }
                    u32x4 w; w.x = cvt_pk_bf16(v0[0], v0[1]); w.y = cvt_pk_bf16(v0[2], v0[3]); w.z = cvt_pk_bf16(v1[0], v1[1]); w.w = cvt_pk_bf16(v1[2], v1[3]);
                    *(u32x4*)(rowp + bj * HALF) = w; } }
    }
};

template <class Epi, class Sched, bool STAMP = false>
__device__ __forceinline__ void gemm_phase(PG8_LAS unsigned char* lds, const Gemm g, const Sched& S, const Epi& E, unsigned long long* stamps) {
    int tid_ = threadIdx.x; asm volatile("" : "+v"(tid_));
    const int tid = tid_, wid = __builtin_amdgcn_readfirstlane(tid >> 6), lane = tid & 63, wr = wid >> 2, wc = wid & 3, fr = lane & 15, fq = lane >> 4;
    const int K = g.K, nt = K / BK;
    constexpr bool GATHER = Sched::GATHER;
    int ts_lo = 0, ts_hi = 0, nts = 0; const unsigned long long rt_entry = STAMP ? (unsigned long long)wall_clock64() : 0ull;
#define PG8_STAMP() do { if (STAMP && wid == 0 && nts < 64) { const unsigned long long _c = (unsigned long long)clock64(); \
        ts_lo = (lane == nts) ? (int)(unsigned)_c : ts_lo; ts_hi = (lane == nts) ? (int)(unsigned)(_c >> 32) : ts_hi; ++nts; } } while (0)
    PG8_STAMP();
    unsigned voffA[2], voffB[2]; int rowA[2];
#pragma unroll
    for (int i = 0; i < 2; ++i) { int R, C; stage_rc(tid * 16 + i * 8192, R, C); const int Rb = Epi::PERM ? ((R & ~31) + perm32(R & 31)) : R;
        rowA[i] = R; voffA[i] = GATHER ? (unsigned)C * 2u : (unsigned)(R * K + C) * 2u; voffB[i] = (unsigned)(Rb * K + C) * 2u; }
    const size_t kstep = (size_t)(BK * 2);
    const size_t hstep = (size_t)HALF * K * 2;
    const size_t tstep = 2 * hstep;
    const unsigned ldsw = (unsigned)wid * 1024u;
    const int aoff = lds_byte(wr * 64 + fr, fq * 8), boff = lds_byte(wc * 32 + fr, fq * 8);
#define PG8_SA(b, h) (((b) * 2 + (h)) * HTB)
#define PG8_SB(b, h) ((4 + (b) * 2 + (h)) * HTB)
#define PG8_STAGE(bufoff, gbase, voff) do { _Pragma("unroll") for (int _i = 0; _i < 2; ++_i) \
        __builtin_amdgcn_global_load_lds((const unsigned*)((const char*)(gbase) + (voff)[_i]), (PG8_LAS unsigned*)(lds + (bufoff) + ldsw + _i * 8192), 16, 0, 0); } while (0)
#define PG8_STAGE_A(bufoff, gbase, h, gv) do { if constexpr (GATHER) { PG8_STAGE(bufoff, gbase, (gv)[h]); } else { PG8_STAGE(bufoff, (gbase) + (h) * hstep, voffA); } } while (0)
#define PG8_TOKSLOT(s) ((PG8_LAS int*)(lds + STAGE_BYTES + 1024 + ((s) & 1) * 1024))
#define PG8_LDA(dst, b, h) do { _Pragma("unroll") for (int m = 0; m < 4; ++m) _Pragma("unroll") for (int k = 0; k < 2; ++k) dst[m][k] = *(const PG8_LAS bf16x8*)(lds + PG8_SA(b, h) + aoff + m * 2048 + k * 1024); } while (0)
#define PG8_LDB(dst, b, h) do { _Pragma("unroll") for (int n = 0; n < 2; ++n) _Pragma("unroll") for (int k = 0; k < 2; ++k) dst[n][k] = *(const PG8_LAS bf16x8*)(lds + PG8_SB(b, h) + boff + n * 2048 + k * 1024); } while (0)
#define PG8_MMA(ai, bj, At, Bt) do { __builtin_amdgcn_s_setprio(1); _Pragma("unroll") for (int m = 0; m < 4; ++m) _Pragma("unroll") for (int n = 0; n < 2; ++n) _Pragma("unroll") for (int k = 0; k < 2; ++k) \
        acc[ai][bj][m][n] = __builtin_amdgcn_mfma_f32_16x16x32_bf16(Bt[n][k], At[m][k], acc[ai][bj][m][n], 0, 0, 0); __builtin_amdgcn_s_setprio(0); } while (0)
#define PG8_WAIT_V(n) asm volatile("s_waitcnt vmcnt(" #n ")" ::: "memory")
#define PG8_WAIT_L(n) asm volatile("s_waitcnt lgkmcnt(" #n ")" ::: "memory")
#define PG8_BAR __builtin_amdgcn_s_barrier()
#define PG8_SCHED __builtin_amdgcn_sched_barrier(0)
    Unit cur, nxt; int ui = 0;
    if (!S.next(0, cur)) return;
    f32x4 acc[2][2][4][2];
#pragma unroll
    for (int a = 0; a < 2; ++a)
#pragma unroll
        for (int b = 0; b < 2; ++b)
#pragma unroll
            for (int m = 0; m < 4; ++m)
#pragma unroll
                for (int n = 0; n < 2; ++n) acc[a][b][m][n] = (f32x4){0.f, 0.f, 0.f, 0.f};
    bf16x8 At[4][2], B0[2][2], B1[2][2];
    const char* cA = (const char*)g.A + (GATHER ? (size_t)0 : (size_t)cur.pm * tstep); const char* cB = (const char*)g.Bt + (size_t)cur.pn * tstep + (size_t)cur.e * g.estride * 2;
    S.a_ready(cur);
    unsigned gcur[2][2], gnxt[2][2], gs[2][2];
    if constexpr (GATHER) {
        if (tid < 256) PG8_TOKSLOT(0)[tid] = S.tok[cur.pm * 256 + tid];
        __syncthreads();
#pragma unroll
        for (int h = 0; h < 2; ++h)
#pragma unroll
            for (int i = 0; i < 2; ++i) { gcur[h][i] = (unsigned)PG8_TOKSLOT(0)[h * HALF + rowA[i]] * (unsigned)(K * 2) + voffA[i]; gnxt[h][i] = gcur[h][i]; gs[h][i] = gcur[h][i]; }
    }
    PG8_STAGE(PG8_SB(0, 0), cB, voffB); PG8_STAGE_A(PG8_SA(0, 0), cA, 0, gcur); PG8_STAGE(PG8_SB(0, 1), cB + hstep, voffB); PG8_STAGE_A(PG8_SA(0, 1), cA, 1, gcur);
    if (wr == 1) PG8_BAR;
    PG8_WAIT_V(4); PG8_BAR;
    PG8_STAGE(PG8_SB(1, 0), cB + kstep, voffB); PG8_STAGE_A(PG8_SA(1, 0), cA + kstep, 0, gcur); PG8_STAGE(PG8_SB(1, 1), cB + hstep + kstep, voffB);
    PG8_WAIT_V(6); PG8_BAR;
    PG8_STAMP();
    for (;;) {
        const bool has_next = S.next(ui + 1, nxt);
        if constexpr (GATHER) { if (has_next && wid < 4)
            __builtin_amdgcn_global_load_lds((const unsigned*)(S.tok + nxt.pm * 256 + wid * 64 + lane), (PG8_LAS unsigned*)((PG8_LAS unsigned char*)PG8_TOKSLOT(ui + 1) + wid * 256), 4, 0, 0); }
        const char* nA = GATHER ? (const char*)g.A : has_next ? (const char*)g.A + (size_t)nxt.pm * tstep : cA; const char* nB = has_next ? (const char*)g.Bt + (size_t)nxt.pn * tstep + (size_t)nxt.e * g.estride * 2 : cB;
        for (int t = 0; t < nt; t += 2) {
            const bool last = (t == nt - 2);
            const char* a1 = cA + (size_t)(t + 1) * kstep;
            const char* a2 = last ? nA : cA + (size_t)(t + 2) * kstep; const char* b2 = last ? nB : cB + (size_t)(t + 2) * kstep;
            const char* a3 = a2 + kstep; const char* b3 = b2 + kstep;
            if (last && has_next) S.a_ready(nxt);
            if constexpr (GATHER) {
                if (last && has_next) {
#pragma unroll
                    for (int h = 0; h < 2; ++h)
#pragma unroll
                        for (int i = 0; i < 2; ++i) gnxt[h][i] = (unsigned)PG8_TOKSLOT(ui + 1)[h * HALF + rowA[i]] * (unsigned)(K * 2) + voffA[i];
                }
#pragma unroll
                for (int h = 0; h < 2; ++h)
#pragma unroll
                    for (int i = 0; i < 2; ++i) gs[h][i] = last ? gnxt[h][i] : gcur[h][i];
            }
            PG8_LDB(B0, 0, 0); PG8_SCHED; PG8_LDA(At, 0, 0); PG8_STAGE_A(PG8_SA(1, 1), a1, 1, gcur);
            PG8_WAIT_L(8); PG8_BAR; PG8_WAIT_L(0); PG8_MMA(0, 0, At, B0); PG8_BAR; PG8_SCHED;
            PG8_LDB(B1, 0, 1); PG8_STAGE(PG8_SB(0, 0), b2, voffB);
            PG8_BAR; PG8_WAIT_L(0); PG8_MMA(0, 1, At, B1); PG8_BAR;
            PG8_LDA(At, 0, 1); PG8_STAGE_A(PG8_SA(0, 0), a2, 0, gs);
            PG8_BAR; PG8_WAIT_L(0); PG8_MMA(1, 0, At, B0); PG8_BAR; PG8_SCHED;
            PG8_STAGE(PG8_SB(0, 1), b2 + hstep, voffB);
            PG8_WAIT_V(6); PG8_BAR; PG8_MMA(1, 1, At, B1); PG8_BAR;
            PG8_LDB(B0, 1, 0); PG8_SCHED; PG8_LDA(At, 1, 0); PG8_STAGE_A(PG8_SA(0, 1), a2, 1, gs);
            PG8_WAIT_L(8); PG8_BAR; PG8_WAIT_L(0); PG8_MMA(0, 0, At, B0); PG8_BAR; PG8_SCHED;
            PG8_LDB(B1, 1, 1); PG8_STAGE(PG8_SB(1, 0), b3, voffB);
            PG8_BAR; PG8_WAIT_L(0); PG8_MMA(0, 1, At, B1); PG8_BAR;
            PG8_LDA(At, 1, 1); PG8_STAGE_A(PG8_SA(1, 0), a3, 0, gs);
            PG8_BAR; PG8_WAIT_L(0); PG8_MMA(1, 0, At, B0); PG8_BAR; PG8_SCHED;
            PG8_STAGE(PG8_SB(1, 1), b3 + hstep, voffB);
            PG8_WAIT_V(6); PG8_BAR; PG8_MMA(1, 1, At, B1); PG8_BAR;
        }
        PG8_STAMP();
        if constexpr (!Epi::AFTER_DRAIN) { E(acc, cur, wr, wc, fr, fq); S.done(cur); }
        PG8_STAMP();
        if (!has_next) break;
#pragma unroll
        for (int a = 0; a < 2; ++a)
#pragma unroll
            for (int b = 0; b < 2; ++b)
#pragma unroll
                for (int m = 0; m < 4; ++m)
#pragma unroll
                    for (int n = 0; n < 2; ++n) acc[a][b][m][n] = (f32x4){0.f, 0.f, 0.f, 0.f};
        cur = nxt; cA = nA; cB = nB; ++ui;
        if constexpr (GATHER) {
#pragma unroll
            for (int h = 0; h < 2; ++h)
#pragma unroll
                for (int i = 0; i < 2; ++i) gcur[h][i] = gnxt[h][i];
        }
    }
    PG8_WAIT_V(0);
    if (wr == 0) PG8_BAR;
    PG8_BAR;
    if constexpr (Epi::AFTER_DRAIN) { E.fused(acc, cur, wr, wc, fr, fq, lds, wid, lane); S.done(cur); }
    PG8_STAMP();
    if (STAMP && wid == 0) { stamps[lane] = lane < nts ? (((unsigned long long)(unsigned)ts_hi << 32) | (unsigned)ts_lo) : 0ull;
        if (lane == 62) stamps[62] = rt_entry; if (lane == 63) stamps[63] = (unsigned long long)wall_clock64(); }
#undef PG8_STAMP
#undef PG8_SA
#undef PG8_SB
#undef PG8_STAGE
#undef PG8_STAGE_A
#undef PG8_TOKSLOT
#undef PG8_LDA
#undef PG8_LDB
#undef PG8_MMA
#undef PG8_WAIT_V
#undef PG8_WAIT_L
#undef PG8_BAR
#undef PG8_SCHED
}
}
namespace pg8 {
struct EpiRes {
    static constexpr bool PERM = true, AFTER_DRAIN = false;
    const void* base_lat; const float* base_ctx; void* out_lat; float* out_ctx; const float* gvec; bool base_bf, out_bf;
    __device__ __forceinline__ void operator()(const f32x4 (&acc)[2][2][4][2], const Unit& u, int wr, int wc, int fr, int fq) const {
        const bool isctx = u.pm >= 128;
        const int prow = (isctx ? (u.pm - 128) : u.pm) * BM;
        const float* base = isctx ? base_ctx : (const float*)base_lat; float* out = isctx ? out_ctx : (float*)out_lat;
        const bool bbf = !isctx && base_bf, obf = !isctx && out_bf;
        const float* gv = gvec + (size_t)(isctx ? 8 : (u.pm >> 4)) * 6144;
        const int row0 = prow + wr * 64 + fr, col0 = u.pn * BM + wc * 32 + 8 * fq;
        f32x4 gvv[2][2];
#pragma unroll
        for (int bj = 0; bj < 2; ++bj)
#pragma unroll
            for (int n = 0; n < 2; ++n) gvv[bj][n] = *(const f32x4*)(gv + col0 + bj * HALF + 4 * n);
#pragma unroll
        for (int ai = 0; ai < 2; ++ai)
#pragma unroll
            for (int m = 0; m < 4; ++m) { const size_t off = (size_t)(row0 + ai * HALF + m * 16) * 1024 + col0;
#pragma unroll
                for (int bj = 0; bj < 2; ++bj) { const size_t o2 = off + bj * HALF;
                    f32x4 b0, b1;
                    if (bbf) { const v4u r = *(const v4u*)((const bf16*)base_lat + o2); b0 = (f32x4){bflo(r.x), bfhi(r.x), bflo(r.y), bfhi(r.y)}; b1 = (f32x4){bflo(r.z), bfhi(r.z), bflo(r.w), bfhi(r.w)}; }
                    else { b0 = *(const f32x4*)(base + o2); b1 = *(const f32x4*)(base + o2 + 4); }
                    const f32x4 v0 = b0 + gvv[bj][0] * acc[ai][bj][m][0], v1 = b1 + gvv[bj][1] * acc[ai][bj][m][1];
                    if (obf) { v4u w; w.x = pk2(v0.x, v0.y); w.y = pk2(v0.z, v0.w); w.z = pk2(v1.x, v1.y); w.w = pk2(v1.z, v1.w); *(v4u*)((bf16*)out_lat + o2) = w; }
                    else { *(f32x4*)(out + o2) = v0; *(f32x4*)(out + o2 + 4) = v1; } } }
    }
};
struct EpiSwiglu {
    static constexpr bool PERM = true, AFTER_DRAIN = false;
    bf16_t* O; int ldc;
    __device__ __forceinline__ void operator()(const f32x4 (&acc)[2][2][4][2], const Unit& u, int wr, int wc, int fr, int fq) const {
        const int row0 = u.pm * BM + wr * 64 + fr, col0 = u.pn * HALF + wc * 32 + 8 * fq;
#pragma unroll
        for (int ai = 0; ai < 2; ++ai)
#pragma unroll
            for (int m = 0; m < 4; ++m) { bf16_t* rowp = O + (size_t)(row0 + ai * HALF + m * 16) * ldc + col0;
                float h[8];
#pragma unroll
                for (int n = 0; n < 2; ++n)
#pragma unroll
                    for (int j = 0; j < 4; ++j) { const float g = acc[ai][0][m][n][j], up = acc[ai][1][m][n][j]; h[n * 4 + j] = g * __builtin_amdgcn_rcpf(1.0f + __expf(-g)) * up; }
                u32x4 w; w.x = cvt_pk_bf16(h[0], h[1]); w.y = cvt_pk_bf16(h[2], h[3]); w.z = cvt_pk_bf16(h[4], h[5]); w.w = cvt_pk_bf16(h[6], h[7]);
                *(u32x4*)rowp = w; }
    }
};
struct MoeOrder {
    static constexpr bool GATHER = false;
    int nN, G, c, nunits; const int* tab;
    __device__ void init(const int* tab_, int nN_, int G_, int c_) { tab = tab_; nN = nN_; G = G_; c = c_; nunits = tab_[0] * nN_; }
    __device__ bool next(int i, Unit& u) const {
        const int L = i * G + c; if (L >= nunits) return false;
        const int q = nunits / NXCD, r = nunits % NXCD, xcd = L % NXCD, off = L / NXCD;
        const int w = (xcd < r ? xcd * (q + 1) : r * (q + 1) + (xcd - r) * q) + off;
        u.pm = w / nN; u.pn = w - u.pm * nN; u.e = tab[1 + u.pm]; return true;
    }
    __device__ __forceinline__ void a_ready(const Unit&) const {}
    __device__ __forceinline__ void done(const Unit&) const {}
};
struct MoeOrderG : MoeOrder { static constexpr bool GATHER = true; const int* tok; };
}
enum { I_X = 0, I_C, I_CTX, I_CCTX, I_MODW, I_MODB, I_NMIXG, I_NFFNG, I_WIN, I_WOUT, I_LCW, I_LCB, I_LWA, I_LBA, I_LWX, I_LBX, I_LLAM,
       I_RMU, I_RWUP, I_RW0, I_RAUP, I_RA0, I_RGUP, I_RKK, I_RKA, I_RRK, I_RLNG, I_RLNB, I_MIB, I_MFB, I_MNG, I_GCW, I_GALOG, I_GDTB, I_GNG,
       I_FWG, I_FWU, I_FWD, I_MROUTER, I_MWG, I_MWU, I_MWD, I_FNG, N_IN };
struct Args { const float* in[N_IN]; float* out; unsigned char* ws; int ph_lo, ph_hi; };
struct Ctx {
    const float* const* in; float* out; unsigned char* ws; LAS unsigned char* lds;
    int tid, lane, wave, G, wg;
};
#define WSP(T, off) ((T*)(C.ws + (off)))

__device__ __forceinline__ int seqrow_raster(int i, int d, int b) {
    if (i < CTXL) { const int p = d ? (CTXL - 1 - i) : i; return T_LAT + b * CTXL + p; }
    const int j = i - CTXL; const int p = d ? (SEQ - 1 - j) : j; return b * SEQ + p;
}
__device__ __forceinline__ int seqrow_cm(int i, int d, int b) {
    if (i < CTXL) { const int p = d ? (CTXL - 1 - i) : i; return T_LAT + b * CTXL + p; }
    const int j = i - CTXL; const int p = d ? (SEQ - 1 - j) : j; return b * SEQ + (p & 63) * 64 + (p >> 6);
}

__device__ __forceinline__ void phase_pre(const Ctx& C) {
    LAS float* sc = (LAS float*)C.lds;
    LAS float* red = sc + 9 * 1024;
    float* modv = WSP(float, WS_MODV);
    bool filled = false;
    for (int it = C.wg; it < DEPTH * 48; it += C.G) {
        if (!filled) {
            for (int i = C.tid; i < 9 * 1024; i += NTHR) { const float v = i < 8192 ? C.in[I_C][i] : C.in[I_CCTX][i - 8192]; sc[i] = siluf_(v); }
            filled = true; __syncthreads();
        }
        const int l = it / 48, jb = it % 48, col = C.tid & 127, kg = C.tid >> 7;
        const float* W = C.in[I_MODW] + (size_t)l * 1024 * 6144 + jb * 128 + col;
        float acc[9];
#pragma unroll
        for (int r = 0; r < 9; ++r) acc[r] = 0.f;
        for (int k = kg * 256; k < kg * 256 + 256; ++k) { const float w = W[(size_t)k * 6144];
#pragma unroll
            for (int r = 0; r < 9; ++r) acc[r] += sc[r * 1024 + k] * w; }
#pragma unroll
        for (int r = 0; r < 9; ++r) red[(kg * 9 + r) * 128 + col] = acc[r];
        __syncthreads();
        for (int i = C.tid; i < 9 * 128; i += NTHR) { const int r = i >> 7, cc = i & 127;
            const float s = red[(0 * 9 + r) * 128 + cc] + red[(1 * 9 + r) * 128 + cc] + red[(2 * 9 + r) * 128 + cc] + red[(3 * 9 + r) * 128 + cc];
            modv[((size_t)l * 9 + r) * 6144 + jb * 128 + cc] = s + C.in[I_MODB][l * 6144 + jb * 128 + cc]; }
        __syncthreads();
    }
}

__device__ __forceinline__ void tr_item(const float* src, size_t ld, int k0, int ns0, bf16* dst, int drow0, int Kd, LAS float* scr, int lane, bool zero) {
    if (!zero) {
#pragma unroll 8
        for (int i = 0; i < 32; ++i) { const int kk = 2 * i + (lane >> 5); scr[kk * 33 + (lane & 31)] = src[(size_t)(k0 + kk) * ld + ns0 + (lane & 31)]; }
    }
    LDS_WAIT(); asm volatile("" ::: "memory");
    const int c = lane & 7;
#pragma unroll
    for (int j = 0; j < 4; ++j) { const int n = (lane >> 3) + 8 * j; const LAS float* s = scr + (8 * c) * 33 + n;
        v4u o; o.x = pk2(s[0 * 33], s[1 * 33]); o.y = pk2(s[2 * 33], s[3 * 33]); o.z = pk2(s[4 * 33], s[5 * 33]); o.w = pk2(s[6 * 33], s[7 * 33]);
        if (zero) o = (v4u){0u, 0u, 0u, 0u};
        *(v4u*)(dst + (size_t)(drow0 + n) * Kd + k0 + 8 * c) = o; }
    LDS_WAIT(); asm volatile("" ::: "memory");
}
__device__ __forceinline__ void convert_small(const Ctx& C, int l) {
    {
        bf16* lw = WSP(bf16, WS_LRUWT);
        for (int k = 0; k < 2 * 2 * 4 * 4096 / (128 * NTHR); ++k) {
            const int e = k * 128 * NTHR + C.wg * NTHR + C.tid;
            if (C.wg < 128) {
            const int i = e & 63, j = (e >> 6) & 63, hd = (e >> 12) & 3, g = (e >> 14) & 1, d = e >> 15;
            const float* src = (g ? C.in[I_LWX] : C.in[I_LWA]) + ((size_t)((l * 2 + d) * 4 + hd) * 64 + i) * 64 + j;
            lw[e] = (bf16)f2bf(*src);
            }
        }
    }
    if (C.wg >= 128 && C.wg < 224) {
        bf16* rw = WSP(bf16, WS_RWT);
        const int e = (C.wg - 128) * NTHR + C.tid;
        if (e < 32768) { const int r = e & 31, ch = (e >> 5) & 255, d = (e >> 13) & 1, isa = e >> 14;
            rw[e] = (bf16)f2bf((isa ? C.in[I_RAUP] : C.in[I_RWUP])[((size_t)(l * 2 + d) * 32 + r) * GW + ch]); }
        else { const int e2 = e - 32768, j = e2 & 63, ch = e2 >> 6; rw[e] = (bf16)f2bf(C.in[I_RGUP][((size_t)l * 64 + j) * GW + ch]); }
    }
}
__device__ __forceinline__ void convert_items(const Ctx& C, int l, int what, int gw, int NGW) {
    LAS float* scr = (LAS float*)(C.lds + C.wave * 8704);
    constexpr int I_IN = 16 * 112, I_OUT = 16 * 32, I_GU = 16 * 176, I_DN = 44 * 32, I_E = 16 * 88 + 22 * 32;
    const bool moe = l & 1; const int li = l >> 1;
    const int lo_it = (what & 1) ? 0 : I_IN, hi_it = (what & 2) ? I_IN + I_OUT + (moe ? NE * I_E : (I_GU + I_DN)) : I_IN;
    bf16* win = WSP(bf16, WS_WIN); bf16* wout = WSP(bf16, WS_WOUT); bf16* wgu = WSP(bf16, WS_WGU); bf16* wdn = WSP(bf16, WS_WDN);
    for (int it = lo_it + gw; it < hi_it; it += NGW) {
        int r = it;
        if (r < I_IN) { const int kb = r / 112, nb = r % 112; tr_item(C.in[I_WIN] + (size_t)l * 1024 * IN_COLS, IN_COLS, 64 * kb, 32 * nb, win, 32 * nb, 1024, scr, C.lane, nb == 111); continue; }
        r -= I_IN;
        if (r < I_OUT) { const int kb = r / 32, nb = r % 32; tr_item(C.in[I_WOUT] + (size_t)l * 1024 * 1024, 1024, 64 * kb, 32 * nb, wout, 32 * nb, 1024, scr, C.lane, false); continue; }
        r -= I_OUT;
        if (!moe) {
            if (r < I_GU) { const int kb = r / 176, nb = r % 176, tile = nb >> 3, q = nb & 7;
                const float* src = (q < 4 ? C.in[I_FWG] : C.in[I_FWU]) + (size_t)li * 1024 * DFF;
                tr_item(src, DFF, 64 * kb, tile * 128 + (q & 3) * 32, wgu, 32 * nb, 1024, scr, C.lane, false); continue; }
            r -= I_GU;
            { const int kb = r / 32, nb = r % 32; tr_item(C.in[I_FWD] + (size_t)li * DFF * 1024, 1024, 64 * kb, 32 * nb, wdn, 32 * nb, DFF, scr, C.lane, false); }
        } else {
            const int e = r / I_E; int rr = r % I_E;
            if (rr < 16 * 88) { const int kb = rr / 88, nb = rr % 88, tile = nb >> 3, q = nb & 7;
                const float* src = (q < 4 ? C.in[I_MWG] : C.in[I_MWU]) + ((size_t)li * NE + e) * 1024 * DFE;
                tr_item(src, DFE, 64 * kb, tile * 128 + (q & 3) * 32, wgu + (size_t)e * 2 * DFE * 1024, 32 * nb, 1024, scr, C.lane, false); continue; }
            rr -= 16 * 88;
            { const int kb = rr / 32, nb = rr % 32; tr_item(C.in[I_MWD] + ((size_t)li * NE + e) * DFE * 1024, 1024, 64 * kb, 32 * nb, wdn + (size_t)e * 1024 * DFE, 32 * nb, DFE, scr, C.lane, false); }
        }
    }
}

template <bool ROUTE>
__device__ __forceinline__ void norm_rows(const Ctx& C, int l, const void* xlat, bool xbf, const float* xctx, const float* gain, int shoff, int scoff, int nrows, int moe_li) {
    const float* modv = WSP(float, WS_MODV) + (size_t)l * 9 * 6144;
    bf16* hb = WSP(bf16, WS_HB);
    const int gw = C.wg * NWAVES + C.wave, NGW = C.G * NWAVES;
    LAS unsigned* lcnt = (LAS unsigned*)(C.lds + 65536);
    unsigned* route = WSP(unsigned, WS_ROUTE);
    if (ROUTE) { if (C.tid < 8) lcnt[C.tid] = 0u; __syncthreads(); }
    f32x4 gv[4];
#pragma unroll
    for (int j = 0; j < 4; ++j) gv[j] = *(const f32x4*)(gain + 4 * C.lane + 256 * j);
    for (int m = gw; m < nrows; m += NGW) {
        const bool isctx = m >= T_LAT;
        const float* xr = isctx ? xctx + (size_t)(m - T_LAT) * 1024 : (const float*)xlat + (size_t)m * 1024; const bf16* xrb = (const bf16*)xlat + (size_t)m * 1024; const bool rbf = xbf && !isctx;
        const float* mv = modv + (size_t)(isctx ? 8 : (m >> 12)) * 6144;
        f32x4 v[4]; float s = 0.f;
#pragma unroll
        for (int j = 0; j < 4; ++j) { v[j] = rbf ? ld4bf(xrb + 4 * C.lane + 256 * j) : *(const f32x4*)(xr + 4 * C.lane + 256 * j); s += (v[j].x * v[j].x + v[j].y * v[j].y) + (v[j].z * v[j].z + v[j].w * v[j].w); }
        const float rs = rsqrtf_(wave_sum(s) * (1.0f / 1024.0f) + 1e-6f);
#pragma unroll
        for (int j = 0; j < 4; ++j) { const f32x4 sh = *(const f32x4*)(mv + shoff + 4 * C.lane + 256 * j), scl = *(const f32x4*)(mv + scoff + 4 * C.lane + 256 * j);
            v[j] = (v[j] * rs * gv[j]) * (scl + 1.0f) + sh;
            v2u o; o.x = pk2(v[j].x, v[j].y); o.y = pk2(v[j].z, v[j].w);
            *(v2u*)(hb + (size_t)m * 1024 + 4 * C.lane + 256 * j) = o; }
        if (ROUTE) {
            const float* rt = C.in[I_MROUTER] + (size_t)moe_li * 1024 * NE;
            float lg[8];
#pragma unroll
            for (int e = 0; e < 8; ++e) lg[e] = 0.f;
#pragma unroll
            for (int j = 0; j < 4; ++j)
#pragma unroll
                for (int q = 0; q < 4; ++q) { const int k = 4 * C.lane + 256 * j + q; const f32x4 r0 = *(const f32x4*)(rt + (size_t)k * 8), r1 = *(const f32x4*)(rt + (size_t)k * 8 + 4); const float hv = v[j][q];
                    lg[0] += hv * r0.x; lg[1] += hv * r0.y; lg[2] += hv * r0.z; lg[3] += hv * r0.w; lg[4] += hv * r1.x; lg[5] += hv * r1.y; lg[6] += hv * r1.z; lg[7] += hv * r1.w; }
#pragma unroll
            for (int e = 0; e < 8; ++e) lg[e] = wave_sum(lg[e]);
            int e0 = 0; float l0 = lg[0];
#pragma unroll
            for (int e = 1; e < 8; ++e) if (lg[e] > l0) { l0 = lg[e]; e0 = e; }
            int e1 = (e0 == 0) ? 1 : 0; float l1 = -3.0e38f;
#pragma unroll
            for (int e = 0; e < 8; ++e) if (e != e0 && lg[e] > l1) { l1 = lg[e]; e1 = e; }
            const float w0 = __builtin_amdgcn_rcpf(1.0f + __expf(l1 - l0)), w1 = 1.0f - w0;
            if (C.lane == 0) {
                const unsigned r0 = atomicAdd((unsigned*)&lcnt[e0], 1u), r1 = atomicAdd((unsigned*)&lcnt[e1], 1u);
                v4u a; a.x = (unsigned)e0; a.y = (unsigned)e1; a.z = r0; a.w = r1;
                *(v4u*)(route + (size_t)m * 8) = a;
                v2u b; b.x = __builtin_bit_cast(unsigned, w0); b.y = __builtin_bit_cast(unsigned, w1);
                *(v2u*)(route + (size_t)m * 8 + 4) = b;
            }
        }
    }
    if (ROUTE) {
        __syncthreads();
        if (C.tid < 8) { unsigned* gc = WSP(unsigned, WS_CTL) + CW_MOECNT + 64 * moe_li; const unsigned base = atomicAdd(gc + C.tid, lcnt[C.tid]); WSP(unsigned, WS_WGBASE)[C.wg * 8 + C.tid] = base; }
    }
}
#define RAW_BARRIER() do { asm volatile("s_waitcnt lgkmcnt(0)" ::: "memory"); __builtin_amdgcn_s_barrier(); asm volatile("" ::: "memory"); } while (0)
__device__ __forceinline__ void gdn_prep(const Ctx& C, int l, int b, int c) {
    const bf16* P = WSP(const bf16, WS_P); bf16* gq = WSP(bf16, WS_GQ);
    const bool isctx = c < 4; const int p0 = isctx ? c * 64 : (c - 4) * 64; const int Lp = isctx ? CTXL : SEQ;
    const int ch = 4 * C.lane;
    auto rowof = [&](int p) -> int { return isctx ? (T_LAT + b * CTXL + p) : (b * SEQ + (p & 63) * 64 + (p >> 6)); };
    f32x4 cw[4][3], x[4][3];
#pragma unroll
    for (int j = 0; j < 4; ++j)
#pragma unroll
        for (int g = 0; g < 3; ++g) cw[j][g] = *(const f32x4*)(C.in[I_GCW] + ((size_t)l * 4 + j) * 768 + g * 256 + ch);
    const int tb = p0 + C.wave * 8;
    auto ldrow = [&](int p, f32x4 (&dst)[3]) {
        if (p >= 0 && p < Lp) { const bf16* pr = P + (size_t)rowof(p) * PLD + OFF_D + ch;
#pragma unroll
            for (int g = 0; g < 3; ++g) dst[g] = ld4bf(pr + g * 256); }
        else {
#pragma unroll
            for (int g = 0; g < 3; ++g) dst[g] = (f32x4){0.f, 0.f, 0.f, 0.f}; }
    };
    ldrow(tb - 2, x[0]); ldrow(tb - 1, x[1]); ldrow(tb, x[2]);
#pragma unroll
    for (int t = 0; t < 8; ++t) {
        ldrow(tb + t + 1, x[3]);
        bf16* orow = gq + (size_t)rowof(tb + t) * 768 + ch;
#pragma unroll
        for (int g = 0; g < 3; ++g) {
            f32x4 v = cw[0][g] * x[0][g] + cw[1][g] * x[1][g] + cw[2][g] * x[2][g] + cw[3][g] * x[3][g];
            v = (f32x4){siluf_(v.x), siluf_(v.y), siluf_(v.z), siluf_(v.w)};
            if (g < 2) { const float ss = row16_sum((v.x * v.x + v.y * v.y) + (v.z * v.z + v.w * v.w)); v = v * (rsqrtf_(ss + 1e-6f) * (g == 0 ? 0.125f : 1.0f)); }
            st4bf(orow + g * 256, v);
        }
#pragma unroll
        for (int g = 0; g < 3; ++g) { x[0][g] = x[1][g]; x[1][g] = x[2][g]; x[2][g] = x[3][g]; }
    }
}
__device__ __forceinline__ void finish_rows(const Ctx& C, int l, int nrows) {
    const bf16* P = WSP(const bf16, WS_P); bf16* yc = WSP(bf16, WS_HB);
    const bf16* ob = WSP(const bf16, WS_OUTB); const bf16* oc = WSP(const bf16, WS_OUTC); const bf16* od = WSP(const bf16, WS_OUTD);
    const bf16* gg = WSP(const bf16, WS_G); const float* bonus = WSP(const float, WS_BONUS);
    const float* mu = C.in[I_RMU] + (size_t)l * 2 * B_COLS;
    const int gw = C.wg * NWAVES + C.wave, NGW = C.G * NWAVES, lane = C.lane, ch = 4 * lane, hh = lane >> 4;
    const f32x4 lng = *(const f32x4*)(C.in[I_RLNG] + l * GW + ch), lnb = *(const f32x4*)(C.in[I_RLNB] + l * GW + ch);
    const f32x4 mng = *(const f32x4*)(C.in[I_MNG] + l * GW + ch), gng = *(const f32x4*)(C.in[I_GNG] + l * GW + ch);
    const f32x4 mu0 = *(const f32x4*)(mu + 512 + ch), mu1 = *(const f32x4*)(mu + B_COLS + 512 + ch);
    const size_t o2 = (size_t)T_ALL * 256;
#pragma unroll 2
    for (int m = gw; m < nrows; m += NGW) {
        const bool isctx = m >= T_LAT; const int Lp = isctx ? CTXL : SEQ; const int p = isctx ? ((m - T_LAT) & (CTXL - 1)) : (m & (SEQ - 1));
        const f32x4 yb = ld4bf(ob + (size_t)m * 256 + ch) + ld4bf(ob + o2 + (size_t)m * 256 + ch);
        const f32x4 ycv = ld4bf(oc + (size_t)m * 256 + ch) + ld4bf(oc + o2 + (size_t)m * 256 + ch);
        const f32x4 yd = ld4bf(od + (size_t)m * 256 + ch) + ld4bf(od + o2 + (size_t)m * 256 + ch);
        const bf16* pr = P + (size_t)m * PLD;
        const f32x4 vs = ld4bf(WSP(const bf16, WS_RKV) + (size_t)m * 768 + 512 + ch);
        const f32x4 og = ld4bf(pr + OFF_C + 768 + ch), gd = ld4bf(pr + OFF_D + 768 + ch), gr = ld4bf(gg + (size_t)m * 256 + ch);
        const float bn = bonus[(size_t)m * 4 + hh];
        *(v2u*)(yc + (size_t)m * 1024 + ch) = *(const v2u*)(pr + 256 + ch);
        {
            const float mean = row16_sum((yb.x + yb.y) + (yb.z + yb.w)) * (1.0f / 64.0f);
            const f32x4 dl = yb - mean;
            const float var = row16_sum((dl.x * dl.x + dl.y * dl.y) + (dl.z * dl.z + dl.w * dl.w)) * (1.0f / 64.0f);
            const f32x4 yn = dl * rsqrtf_(var + 64e-5f) * lng + lnb;
            st4bf(yc + (size_t)m * 1024 + 256 + ch, (yn + vs * bn) * gr);
        }
        {
            const float ms = row16_sum((ycv.x * ycv.x + ycv.y * ycv.y) + (ycv.z * ycv.z + ycv.w * ycv.w)) * (1.0f / 64.0f);
            const f32x4 sg = (f32x4){sigmoidf_(og.x), sigmoidf_(og.y), sigmoidf_(og.z), sigmoidf_(og.w)};
            st4bf(yc + (size_t)m * 1024 + 512 + ch, ycv * rsqrtf_(ms + 1e-6f) * mng * sg);
        }
        {
            const float ms = row16_sum((yd.x * yd.x + yd.y * yd.y) + (yd.z * yd.z + yd.w * yd.w)) * (1.0f / 64.0f);
            const f32x4 sg = (f32x4){siluf_(gd.x), siluf_(gd.y), siluf_(gd.z), siluf_(gd.w)};
            st4bf(yc + (size_t)m * 1024 + 768 + ch, yd * rsqrtf_(ms + 1e-6f) * gng * sg);
        }
    }
}
typedef bf16x8 fragb;
__device__ __forceinline__ f32x4 mfma16(fragb a, fragb b, f32x4 c) { return __builtin_amdgcn_mfma_f32_16x16x32_bf16(a, b, c, 0, 0, 0); }
__device__ __forceinline__ fragb ld_frag16(const LAS bf16* p) { return *(const LAS fragb*)p; }
__device__ __forceinline__ fragb ld_frag8x2(const LAS bf16* p0, const LAS bf16* p1) {
    const v2u a = *(const LAS v2u*)p0, b = *(const LAS v2u*)p1; v4u r; r.x = a.x; r.y = a.y; r.z = b.x; r.w = b.y; return __builtin_bit_cast(fragb, r); }
__device__ __forceinline__ fragb pack_frag(const f32x4& lo, const f32x4& hi) { v4u r; r.x = pk2(lo.x, lo.y); r.y = pk2(lo.z, lo.w); r.z = pk2(hi.x, hi.y); r.w = pk2(hi.z, hi.w); return __builtin_bit_cast(fragb, r); }
__device__ __forceinline__ float wave_incl_sum(float v, int lane) {
    v += dpp_x<0x111, 0xF, true>(0.f, v); v += dpp_x<0x112, 0xF, true>(0.f, v); v += dpp_x<0x114, 0xF, true>(0.f, v); v += dpp_x<0x118, 0xF, true>(0.f, v);
    v += dpp_x<0x142, 0xA, false>(0.f, v); v += dpp_x<0x143, 0xC, false>(0.f, v);
    return v;
}
__device__ __forceinline__ float wave_incl_max(float v, int lane) {
    const float ninf = -3.0e38f;
    v = fmaxf(v, dpp_x<0x111, 0xF, false>(ninf, v)); v = fmaxf(v, dpp_x<0x112, 0xF, false>(ninf, v)); v = fmaxf(v, dpp_x<0x114, 0xF, false>(ninf, v)); v = fmaxf(v, dpp_x<0x118, 0xF, false>(ninf, v));
    v = fmaxf(v, dpp_x<0x142, 0xA, false>(ninf, v)); v = fmaxf(v, dpp_x<0x143, 0xC, false>(ninf, v));
    return v;
}
constexpr int MP = 72;
__device__ __forceinline__ void mlstm_chunked(const Ctx& C, int l, int idx) {
    const int d = idx >> 5, b = (idx >> 2) & 7, h = idx & 3, lane = C.lane, w = C.wave, l15 = lane & 15, q = lane >> 4;
    const int it = w & 3, vtp = w >> 2;
    constexpr int IMG = 64 * MP * 2, BUFB = 4 * IMG + 1024, CTB = 65 * MP * 2 + 16;
    LAS unsigned char* L0 = C.lds;
    const bf16* P = WSP(const bf16, WS_P); bf16* outc = WSP(bf16, WS_OUTC) + (size_t)d * T_ALL * 256;
    const float ib = C.in[I_MIB][(l * 2 + d) * NH + h], fb = C.in[I_MFB][(l * 2 + d) * NH + h];
    const int tt = C.tid >> 3, part = C.tid & 7;
    for (int i = C.tid; i < 2 * CTB / 4; i += NTHR) ((LAS unsigned*)(L0 + 2 * BUFB))[i] = 0u;
    v4u rq, rk, rv; unsigned short rgi, rgf;
    auto gload = [&](int n) {
        const int row = seqrow_cm(n * 64 + tt, d, b);
        const bf16* pp = P + (size_t)row * PLD + OFF_C + h * 64 + 8 * part;
        rq = *(const v4u*)pp; rk = *(const v4u*)(pp + 256); rv = *(const v4u*)(pp + 512);
        const bf16* pg = P + (size_t)seqrow_cm(n * 64 + lane, d, b) * PLD + OFF_C + 1024 + d * 4 + h;
        rgi = pg[0]; rgf = pg[8];
    };
    auto images = [&](int bufi) {
        LAS unsigned char* B0 = L0 + bufi * BUFB;
        LAS bf16* Qs = (LAS bf16*)B0; LAS bf16* Ks = Qs + 64 * MP; LAS bf16* VT = Ks + 64 * MP; LAS bf16* KTw = VT + 64 * MP; LAS float* vec = (LAS float*)(B0 + 4 * IMG);
        const float li = bf2f(rgi) + ib, lf = -softplusf_(-(bf2f(rgf) + fb));
        const float bc = wave_incl_sum(lf, lane), x = li - bc, cm = wave_incl_max(x, lane);
        const float wl = __expf(x - __shfl(cm, 63)) * 0.125f;
        if (w == 0) { vec[lane] = x; vec[64 + lane] = cm; vec[128 + lane] = bc; }
        const float wmine = __shfl(wl, 8 * w + (lane >> 3));
        *(LAS v4u*)(Qs + tt * MP + 8 * part) = rq; *(LAS v4u*)(Ks + tt * MP + 8 * part) = rk;
        const unsigned vv[4] = {rv.x, rv.y, rv.z, rv.w}, kk[4] = {rk.x, rk.y, rk.z, rk.w};
#pragma unroll
        for (int e = 0; e < 4; ++e) {
            VT[(8 * part + 2 * e) * MP + tt] = (bf16)(vv[e] & 0xffffu); VT[(8 * part + 2 * e + 1) * MP + tt] = (bf16)(vv[e] >> 16);
            KTw[(8 * part + 2 * e) * MP + tt] = (bf16)f2bf1(bflo(kk[e]) * wmine); KTw[(8 * part + 2 * e + 1) * MP + tt] = (bf16)f2bf1(bfhi(kk[e]) * wmine);
        }
    };
    f32x4 Cst[2], nst; float m = 0.f;
    Cst[0] = Cst[1] = nst = (f32x4){0.f, 0.f, 0.f, 0.f};
    const fragb ones = __builtin_bit_cast(fragb, (v4u){0x3F803F80u, 0x3F803F80u, 0x3F803F80u, 0x3F803F80u});
    const f32x4 z4 = (f32x4){0.f, 0.f, 0.f, 0.f};
    gload(0); images(0); gload(1);
#pragma unroll 1
    for (int n = 0; n < NCH; ++n) {
        RAW_BARRIER();
        const LAS unsigned char* B0 = L0 + (n & 1) * BUFB;
        const LAS bf16* Qs = (const LAS bf16*)B0; const LAS bf16* Ks = Qs + 64 * MP; const LAS bf16* VT = Ks + 64 * MP; const LAS bf16* KTw = VT + 64 * MP; const LAS float* vec = (const LAS float*)(B0 + 4 * IMG);
        const LAS bf16* CT = (const LAS bf16*)(L0 + 2 * BUFB + (n & 1) * CTB); LAS bf16* CTn = (LAS bf16*)(L0 + 2 * BUFB + ((n + 1) & 1) * CTB);
        fragb Qf[2]; Qf[0] = ld_frag16(Qs + (16 * it + l15) * MP + 8 * q); Qf[1] = ld_frag16(Qs + (16 * it + l15) * MP + 32 + 8 * q);
        const float cmi = vec[64 + 16 * it + l15]; const int icol = 16 * it + l15;
        f32x4 pt[4];
#pragma unroll
        for (int jt = 0; jt < 4; ++jt) {
            pt[jt] = z4;
            if (jt <= it) {
                const fragb k0 = ld_frag16(Ks + (16 * jt + l15) * MP + 8 * q), k1 = ld_frag16(Ks + (16 * jt + l15) * MP + 32 + 8 * q);
                f32x4 st = mfma16(k0, Qf[0], z4); st = mfma16(k1, Qf[1], st);
                const f32x4 xj = *(const LAS f32x4*)(vec + 16 * jt + 4 * q);
#pragma unroll
                for (int r = 0; r < 4; ++r) { const int j = 16 * jt + 4 * q + r; pt[jt][r] = (j <= icol) ? st[r] * __expf(xj[r] - cmi) * 0.125f : 0.f; }
            }
        }
        fragb Pf[2]; Pf[0] = pack_frag(pt[0], pt[1]); Pf[1] = pack_frag(pt[2], pt[3]);
        fragb Vf[2][2];
#pragma unroll
        for (int v2 = 0; v2 < 2; ++v2)
#pragma unroll
            for (int s = 0; s < 2; ++s) { const LAS bf16* vr = VT + (16 * (2 * vtp + v2) + l15) * MP + 32 * s + 4 * q; Vf[v2][s] = ld_frag8x2(vr, vr + 16); }
        f32x4 Aacc[2], R[2], as, dn;
        as = mfma16(Pf[0], ones, z4); if (it >= 2) as = mfma16(Pf[1], ones, as);
        const fragb nf0 = ld_frag16(CT + 64 * MP + 8 * q), nf1 = ld_frag16(CT + 64 * MP + 32 + 8 * q);
        dn = mfma16(Qf[0], nf0, z4); dn = mfma16(Qf[1], nf1, dn);
#pragma unroll
        for (int v2 = 0; v2 < 2; ++v2) {
            Aacc[v2] = mfma16(Pf[0], Vf[v2][0], z4); if (it >= 2) Aacc[v2] = mfma16(Pf[1], Vf[v2][1], Aacc[v2]);
            const LAS bf16* cr = CT + (16 * (2 * vtp + v2) + l15) * MP + 8 * q;
            R[v2] = mfma16(Qf[0], ld_frag16(cr), z4); R[v2] = mfma16(Qf[1], ld_frag16(cr + 32), R[v2]);
        }
        {
            const f32x4 bi = *(const LAS f32x4*)(vec + 128 + 16 * it + 4 * q), cmr = *(const LAS f32x4*)(vec + 64 + 16 * it + 4 * q);
#pragma unroll
            for (int r = 0; r < 4; ++r) {
                const float mi = bi[r] + cmr[r], minter = bi[r] + m, mt = fmaxf(minter, mi), e1 = __expf(mi - mt), e2 = __expf(minter - mt);
                const float den = e1 * as[r] + e2 * dn[r]; const float inv = __builtin_amdgcn_rcpf(fmaxf(fabsf(den), __expf(-mt)));
                const int row = seqrow_cm(n * 64 + 16 * it + 4 * q + r, d, b);
#pragma unroll
                for (int v2 = 0; v2 < 2; ++v2) outc[(size_t)row * 256 + h * 64 + 16 * (2 * vtp + v2) + l15] = (bf16)f2bf1((e1 * Aacc[v2][r] + e2 * R[v2][r]) * inv);
            }
        }
        {
            const LAS bf16* kr = KTw + (16 * it + l15) * MP + 4 * q;
            const fragb kt0 = ld_frag8x2(kr, kr + 16), kt1 = ld_frag8x2(kr + 32, kr + 48);
            const float bL = vec[128 + 63], mloc = bL + vec[64 + 63];
            const float mnew = fmaxf(bL + m, mloc), wp = __expf(bL + m - mnew), wn = __expf(mloc - mnew);
            f32x4 gk = mfma16(kt0, ones, z4); gk = mfma16(kt1, ones, gk);
            nst = nst * wp + gk * wn;
#pragma unroll
            for (int v2 = 0; v2 < 2; ++v2) {
                f32x4 G = mfma16(kt0, Vf[v2][0], z4); G = mfma16(kt1, Vf[v2][1], G);
                Cst[v2] = Cst[v2] * wp + G * wn;
                v2u o; o.x = pk2(Cst[v2].x, Cst[v2].y); o.y = pk2(Cst[v2].z, Cst[v2].w);
                *(LAS v2u*)(CTn + (16 * (2 * vtp + v2) + l15) * MP + 16 * it + 4 * q) = o;
            }
            if (vtp == 0 && l15 == 0) { v2u o; o.x = pk2(nst.x, nst.y); o.y = pk2(nst.z, nst.w); *(LAS v2u*)(CTn + 64 * MP + 16 * it + 4 * q) = o; }
            m = mnew;
        }
        if (n + 1 < NCH) { images((n + 1) & 1); if (n + 2 < NCH) gload(n + 2); }
    }
    __syncthreads();
}
__device__ __forceinline__ int fwd_row_cm(int b, int c, int t) { return c < 4 ? (T_LAT + b * CTXL + c * 64 + t) : (b * SEQ + t * 64 + (c - 4)); }
__device__ __forceinline__ bf16* blob_row(const Ctx& C, int d, int isw, int b, int c, int h, int r) {
    const int row = fwd_row_cm(b, c, r);
    if (d == 1 && isw) return WSP(bf16, WS_OUTD) + ((size_t)T_ALL + row) * 256 + h * 64;
    return WSP(bf16, WS_P) + (size_t)row * PLD + OFF_D + (d * 2 + isw) * 256 + h * 64;
}
constexpr int LP = 68;
__device__ __forceinline__ void blocked_solve(const LAS bf16* Ln, const LAS bf16* TinvP, LAS unsigned char* XTw, f32x4 (&acc)[4][4], int l15, int q) {
    const f32x4 z4 = (f32x4){0.f, 0.f, 0.f, 0.f};
#pragma unroll
    for (int I = 0; I < 4; ++I) {
        const fragb Af = *(const LAS fragb*)(TinvP + (I * 16 + l15) * 32 + 8 * q);
        fragb A0, A1;
        if (I >= 1) A0 = ld_frag16(Ln + (16 * I + l15) * MP + 8 * q);
        if (I == 3) A1 = ld_frag16(Ln + (16 * I + l15) * MP + 32 + 8 * q);
#pragma unroll
        for (int nt = 0; nt < 4; ++nt) {
            const int crow = 16 * nt + l15; LAS unsigned char* xr = XTw + crow * 128;
            f32x4 a = acc[I][nt];
            if (I >= 1) a = mfma16(A0, *(const LAS fragb*)(xr + ((q ^ (crow & 7)) << 4)), a);
            if (I == 3) a = mfma16(A1, *(const LAS fragb*)(xr + (((4 + q) ^ (crow & 7)) << 4)), a);
            v4u bw; bw.x = pk2(a.x, a.y); bw.y = pk2(a.z, a.w); bw.z = 0u; bw.w = 0u;
            const f32x4 x = mfma16(Af, __builtin_bit_cast(fragb, bw), z4);
            acc[I][nt] = x;
            v2u o; o.x = pk2(x.x, x.y); o.y = pk2(x.z, x.w);
            *(LAS v2u*)(xr + (((2 * I + (q >> 1)) ^ (crow & 7)) << 4) + (q & 1) * 8) = o;
        }
    }
}
__device__ __forceinline__ void diag_inverses(const LAS bf16* Ln, LAS bf16* TinvP, int lane) {
    const int blk = lane >> 4, c = lane & 15;
    float x[16];
#pragma unroll
    for (int i = 0; i < 16; ++i) {
        const LAS bf16* lr = Ln + (16 * blk + i) * MP + 16 * blk;
        const v4u r0 = *(const LAS v4u*)lr, r1 = *(const LAS v4u*)(lr + 8);
        const unsigned rw[8] = {r0.x, r0.y, r0.z, r0.w, r1.x, r1.y, r1.z, r1.w};
        float s = (i == c) ? 1.0f : 0.0f;
#pragma unroll
        for (int j = 0; j < i; ++j) s += ((j & 1) ? bfhi(rw[j >> 1]) : bflo(rw[j >> 1])) * x[j];
        x[i] = s;
        TinvP[(blk * 16 + i) * 32 + 8 * (c >> 2) + (c & 3)] = (bf16)f2bf1(s);
    }
}
__device__ __forceinline__ void gdn_solve_item(const Ctx& C, int l, int item) {
    const int lane = C.lane, w = C.wave, pw = w & 1, pi = w >> 1, l15 = lane & 15, q = lane >> 4;
    LAS unsigned char* B0 = C.lds + pi * 31744;
    LAS bf16* Ln = (LAS bf16*)B0;
    LAS bf16* TinvP = (LAS bf16*)(B0 + 9216);
    LAS float* vec = (LAS float*)(B0 + 13312);
    LAS unsigned char* XT = B0 + 13824;
    LAS bf16* Ks = (LAS bf16*)XT;
    const bf16* P = WSP(const bf16, WS_P); const bf16* gq = WSP(const bf16, WS_GQ);
    const int u = item >> 1, d = item & 1;
    const int c = u % NCH, h = (u / NCH) & 3, b = u / (NCH * NH);
    const int n = d ? (c < 4 ? 3 - c : 71 - c) : c;
    const float aexp = __expf(C.in[I_GALOG][(l * 2 + d) * NH + h]), dtb = C.in[I_GDTB][(l * 2 + d) * NH + h];
    const int rowl = seqrow_cm(n * 64 + lane, d, b);
    const bf16* pg = P + (size_t)rowl * PLD + OFF_D + 1024 + d * 4 + h;
    const float la = -aexp * softplusf_(bf2f(pg[0]) + dtb), beta = sigmoidf_(bf2f(pg[8]));
    const float gam = wave_incl_sum(la, lane);
    if (pw == 0) { vec[lane] = beta; vec[64 + lane] = gam; }
#pragma unroll
    for (int r = 0; r < 4; ++r) { const int idx = pw * 64 + lane + 128 * r, t = idx >> 3, part = idx & 7;
        *(LAS v4u*)(Ks + t * MP + 8 * part) = *(const v4u*)(gq + (size_t)seqrow_cm(n * 64 + t, d, b) * 768 + 256 + h * 64 + 8 * part); }
    { LAS v4u* tz = (LAS v4u*)(B0 + 9216) + (pw * 64 + lane) * 2; tz[0] = (v4u){0u, 0u, 0u, 0u}; tz[1] = (v4u){0u, 0u, 0u, 0u}; }
    f32x4 acc[4][4];
    if (pw == 0) {
#pragma unroll
        for (int I = 0; I < 4; ++I)
#pragma unroll
            for (int r = 0; r < 4; ++r) { const bf16* vr = gq + (size_t)seqrow_cm(n * 64 + 16 * I + 4 * q + r, d, b) * 768 + 512 + h * 64 + l15;
#pragma unroll
                for (int nt = 0; nt < 4; ++nt) acc[I][nt][r] = bf2f(vr[16 * nt]); }
    }
    __syncthreads();
    {
        int tix = 0;
#pragma unroll
        for (int it = 0; it < 4; ++it)
#pragma unroll
            for (int jt = 0; jt < 4; ++jt, ++tix) if ((tix & 1) == pw) {
                f32x4 t4 = (f32x4){0.f, 0.f, 0.f, 0.f};
                if (jt <= it) {
#pragma unroll
                    for (int s = 0; s < 2; ++s) t4 = mfma16(ld_frag16(Ks + (16 * it + l15) * MP + 32 * s + 8 * q), ld_frag16(Ks + (16 * jt + l15) * MP + 32 * s + 8 * q), t4);
                    const float gj = vec[64 + 16 * jt + l15];
                    const f32x4 bi = *(const LAS f32x4*)(vec + 16 * it + 4 * q), gi = *(const LAS f32x4*)(vec + 64 + 16 * it + 4 * q);
#pragma unroll
                    for (int r = 0; r < 4; ++r) { const int i = 16 * it + 4 * q + r, j = 16 * jt + l15; t4[r] = (j < i) ? -(bi[r] * t4[r] * __expf(gi[r] - gj)) : 0.f; }
                }
#pragma unroll
                for (int r = 0; r < 4; ++r) Ln[(16 * it + 4 * q + r) * MP + 16 * jt + l15] = (bf16)f2bf1(t4[r]);
            }
    }
    {
#pragma unroll
        for (int I = 0; I < 4; ++I) {
            const f32x4 bi = *(const LAS f32x4*)(vec + 16 * I + 4 * q), gi = *(const LAS f32x4*)(vec + 64 + 16 * I + 4 * q);
#pragma unroll
            for (int r = 0; r < 4; ++r) { const float sc = pw ? bi[r] * __expf(gi[r]) : bi[r];
#pragma unroll
                for (int nt = 0; nt < 4; ++nt) acc[I][nt][r] = (pw ? bf2f(Ks[(16 * I + 4 * q + r) * MP + 16 * nt + l15]) : acc[I][nt][r]) * sc; }
        }
    }
    __syncthreads();
    if (pw == 0) diag_inverses(Ln, TinvP, lane);
    LAS unsigned char* XTw = XT + pw * 8192;
    { LAS v4u* xz = (LAS v4u*)(XTw + lane * 128);
#pragma unroll
        for (int g = 0; g < 8; ++g) xz[g] = (v4u){0u, 0u, 0u, 0u}; }
    __syncthreads();
    blocked_solve(Ln, TinvP, XTw, acc, l15, q);
    {
        bf16* dst = blob_row(C, d, pw, b, c, h, lane);
        const LAS unsigned char* xr = XTw + lane * 128;
#pragma unroll
        for (int g = 0; g < 8; ++g) *(v4u*)(dst + 8 * g) = *(const LAS v4u*)(xr + ((g ^ (lane & 7)) << 4));
    }
    __syncthreads();
}

template <bool DRY>
__device__ __forceinline__ void gdn_chunked(const Ctx& C, int l, int idx) {
    const int d = idx >> 5, b = (idx >> 2) & 7, h = idx & 3, lane = C.lane, w = C.wave, l15 = lane & 15, q = lane >> 4;
    const int it = w & 3, vtp = w >> 2;
    constexpr int IMG = 64 * MP * 2, BUFB = 5 * IMG + 512;
    LAS unsigned char* L0 = C.lds;
    LAS bf16* VnT = (LAS bf16*)(L0 + 2 * BUFB + 2 * IMG);
    const bf16* P = WSP(const bf16, WS_P); const bf16* gq = WSP(const bf16, WS_GQ); bf16* outd = WSP(bf16, WS_OUTD) + (size_t)d * T_ALL * 256;
    const float aexp = __expf(C.in[I_GALOG][(l * 2 + d) * NH + h]), dtb = C.in[I_GDTB][(l * 2 + d) * NH + h];
    const int tt = C.tid >> 3, part = C.tid & 7;
    for (int i = C.tid; i < 2 * IMG / 4; i += NTHR) ((LAS unsigned*)(L0 + 2 * BUFB))[i] = 0u;
    v4u rq, rk, ru, rw; unsigned short rga;
    auto gload = [&](int n) {
        const int c = d ? (n < 4 ? 3 - n : 71 - n) : n;
        const bf16* pp = gq + (size_t)seqrow_cm(n * 64 + tt, d, b) * 768 + h * 64 + 8 * part;
        rq = *(const v4u*)pp; rk = *(const v4u*)(pp + 256);
        ru = *(const v4u*)(blob_row(C, d, 0, b, c, h, tt) + 8 * part); rw = *(const v4u*)(blob_row(C, d, 1, b, c, h, tt) + 8 * part);
        rga = P[(size_t)seqrow_cm(n * 64 + lane, d, b) * PLD + OFF_D + 1024 + d * 4 + h];
    };
    auto images = [&](int bufi) {
        LAS unsigned char* B0 = L0 + bufi * BUFB;
        LAS bf16* Qs = (LAS bf16*)B0; LAS bf16* Ks = Qs + 64 * MP; LAS bf16* KdT = Ks + 64 * MP; LAS bf16* Wi = KdT + 64 * MP; LAS bf16* UT = Wi + 64 * MP; LAS float* vec = (LAS float*)(B0 + 5 * IMG);
        const float la = -aexp * softplusf_(bf2f(rga) + dtb);
        const float gam = wave_incl_sum(la, lane);
        if (w == 0) vec[lane] = gam;
        const float kd = __expf(__shfl(gam, 63) - gam);
        const float kmine = __shfl(kd, 8 * w + (lane >> 3));
        *(LAS v4u*)(Qs + tt * MP + 8 * part) = rq; *(LAS v4u*)(Ks + tt * MP + 8 * part) = rk; *(LAS v4u*)(UT + tt * MP + 8 * part) = ru;
        const unsigned kk[4] = {rk.x, rk.y, rk.z, rk.w}, ww[4] = {rw.x, rw.y, rw.z, rw.w};
#pragma unroll
        for (int e = 0; e < 4; ++e) {
            KdT[(8 * part + 2 * e) * MP + tt] = (bf16)f2bf1(bflo(kk[e]) * kmine); KdT[(8 * part + 2 * e + 1) * MP + tt] = (bf16)f2bf1(bfhi(kk[e]) * kmine);
            Wi[(8 * part + 2 * e) * MP + tt] = (bf16)(ww[e] & 0xffffu); Wi[(8 * part + 2 * e + 1) * MP + tt] = (bf16)(ww[e] >> 16);
        }
    };
    f32x4 Sst[2]; Sst[0] = Sst[1] = (f32x4){0.f, 0.f, 0.f, 0.f};
    const f32x4 z4 = (f32x4){0.f, 0.f, 0.f, 0.f};
    gload(0); images(0); gload(1);
#pragma unroll 1
    for (int n = 0; n < NCH; ++n) {
        RAW_BARRIER();
        const LAS unsigned char* B0 = L0 + (n & 1) * BUFB;
        const LAS bf16* Qs = (const LAS bf16*)B0; const LAS bf16* Ks = Qs + 64 * MP; const LAS bf16* KdT = Ks + 64 * MP; const LAS bf16* Wi = KdT + 64 * MP; const LAS bf16* UT = Wi + 64 * MP; const LAS float* vec = (const LAS float*)(B0 + 5 * IMG);
        const LAS bf16* ST = (const LAS bf16*)(L0 + 2 * BUFB + (n & 1) * IMG); LAS bf16* STn = (LAS bf16*)(L0 + 2 * BUFB + ((n + 1) & 1) * IMG);
        fragb Qf[2]; Qf[0] = ld_frag16(Qs + (16 * it + l15) * MP + 8 * q); Qf[1] = ld_frag16(Qs + (16 * it + l15) * MP + 32 + 8 * q);
        const float gcol = vec[16 * it + l15]; const int icol = 16 * it + l15;
        f32x4 pt[4];
#pragma unroll
        for (int jt = 0; jt < 4; ++jt) {
            pt[jt] = z4;
            if (jt <= it) {
                const fragb k0 = ld_frag16(Ks + (16 * jt + l15) * MP + 8 * q), k1 = ld_frag16(Ks + (16 * jt + l15) * MP + 32 + 8 * q);
                f32x4 st = mfma16(k0, Qf[0], z4); st = mfma16(k1, Qf[1], st);
                const f32x4 gj = *(const LAS f32x4*)(vec + 16 * jt + 4 * q);
#pragma unroll
                for (int r = 0; r < 4; ++r) { const int j = 16 * jt + 4 * q + r; pt[jt][r] = (j <= icol) ? st[r] * __expf(gcol - gj[r]) : 0.f; }
            }
        }
        fragb Pf[2]; Pf[0] = pack_frag(pt[0], pt[1]); Pf[1] = pack_frag(pt[2], pt[3]);
        const fragb Wf0 = ld_frag16(Wi + (16 * it + l15) * MP + 8 * q), Wf1 = ld_frag16(Wi + (16 * it + l15) * MP + 32 + 8 * q);
        f32x4 Ro[2];
#pragma unroll
        for (int v2 = 0; v2 < 2; ++v2) {
            const int vrow = 16 * (2 * vtp + v2) + l15;
            const fragb s0 = ld_frag16(ST + vrow * MP + 8 * q), s1 = ld_frag16(ST + vrow * MP + 32 + 8 * q);
            f32x4 ws = mfma16(Wf0, s0, z4); ws = mfma16(Wf1, s1, ws);
            Ro[v2] = mfma16(Qf[0], s0, z4); Ro[v2] = mfma16(Qf[1], s1, Ro[v2]);
            const v2u ur = *(const LAS v2u*)(UT + vrow * MP + 16 * it + 4 * q);
            v2u o; o.x = pk2(bflo(ur.x) - ws.x, bfhi(ur.x) - ws.y); o.y = pk2(bflo(ur.y) - ws.z, bfhi(ur.y) - ws.w);
            *(LAS v2u*)(VnT + vrow * MP + 16 * it + 4 * q) = o;
        }
        RAW_BARRIER();
        {
            const f32x4 gi = *(const LAS f32x4*)(vec + 16 * it + 4 * q);
            const float gl = __expf(vec[63]);
            const LAS bf16* kr = KdT + (16 * it + l15) * MP + 4 * q;
            const fragb kt0 = ld_frag8x2(kr, kr + 16), kt1 = ld_frag8x2(kr + 32, kr + 48);
#pragma unroll
            for (int v2 = 0; v2 < 2; ++v2) {
                const int vrow = 16 * (2 * vtp + v2) + l15;
                const LAS bf16* vr = VnT + vrow * MP + 4 * q;
                const fragb n0 = ld_frag8x2(vr, vr + 16), n1 = ld_frag8x2(vr + 32, vr + 48);
                f32x4 o = mfma16(Pf[0], n0, z4); if (it >= 2) o = mfma16(Pf[1], n1, o);
#pragma unroll
                for (int r = 0; r < 4; ++r) { const int row = seqrow_cm(n * 64 + 16 * it + 4 * q + r, d, b);
                    if (!DRY) outd[(size_t)row * 256 + h * 64 + vrow] = (bf16)f2bf1(o[r] + __expf(gi[r]) * Ro[v2][r]); }
                f32x4 ns = mfma16(kt0, n0, z4); ns = mfma16(kt1, n1, ns);
                Sst[v2] = Sst[v2] * gl + ns;
                v2u so; so.x = pk2(Sst[v2].x, Sst[v2].y); so.y = pk2(Sst[v2].z, Sst[v2].w);
                *(LAS v2u*)(STn + vrow * MP + 16 * it + 4 * q) = so;
            }
        }
        if (n + 1 < NCH) { images((n + 1) & 1); if (n + 2 < NCH) gload(n + 2); }
    }
    __syncthreads();
}
constexpr int UP = 264;
template <int CTRL> __device__ __forceinline__ float dpp_keep(float oldv, float v) { return __builtin_bit_cast(float, __builtin_amdgcn_update_dpp(__builtin_bit_cast(int, oldv), __builtin_bit_cast(int, v), CTRL, 0xF, 0xF, false)); }
template <bool REV> __device__ __forceinline__ void scan16(float& A, float& B) {
#define LRU_STEP(S) { const float Ap = dpp_keep<(REV ? 0x100 : 0x110) | S>(1.0f, A), Bp = dpp_keep<(REV ? 0x100 : 0x110) | S>(0.0f, B); B = A * Bp + B; A = A * Ap; }
    LRU_STEP(1) LRU_STEP(2) LRU_STEP(4) LRU_STEP(8)
#undef LRU_STEP
}
constexpr int UPC = 72;
__device__ __forceinline__ int lru_chunk_of(int d, int k) { return d ? (k < 4 ? 3 - k : NCH + 3 - k) : k; }
template <bool REV>
__device__ __forceinline__ void lru_tiles(const LAS bf16* Ud, int th, int mt, int lane, const fragb (&Wa)[2], const fragb (&Wx)[2], const f32x4& ba, const f32x4& bx, const f32x4& sp4,
                                          f32x4 (&Ac)[2], f32x4 (&Hl)[2], f32x4& Atot, f32x4& hend) {
    const int l15 = lane & 15, q = lane >> 4, edge = (lane & 48) | (REV ? 0 : 15);
    const f32x4 z4 = (f32x4){0.f, 0.f, 0.f, 0.f};
    f32x4 tA = z4, tB = z4;
#pragma unroll
    for (int i = 0; i < 2; ++i) {
        const int nt = REV ? 3 - (2 * th + i) : 2 * th + i;
        const LAS bf16* urow = Ud + (16 * nt + l15) * UPC;
        const fragb Uf0 = ld_frag16(urow + 8 * q), Uf1 = ld_frag16(urow + 32 + 8 * q);
        f32x4 aa = mfma16(Wa[0], Uf0, z4); aa = mfma16(Wa[1], Uf1, aa);
        f32x4 ax = mfma16(Wx[0], Uf0, z4); ax = mfma16(Wx[1], Uf1, ax);
        const v2u ur = *(const LAS v2u*)(urow + 16 * mt + 4 * q);
        const f32x4 u4 = (f32x4){bflo(ur.x), bfhi(ur.x), bflo(ur.y), bfhi(ur.y)};
        f32x4 la, iu, A, Bv;
#pragma unroll
        for (int r = 0; r < 4; ++r) { const float rg = sigmoidf_(aa[r] + ba[r]); iu[r] = sigmoidf_(ax[r] + bx[r]) * u4[r]; la[r] = -sp4[r] * rg; }
        const bool sm_ = la[0] > -0.15f && la[1] > -0.15f && la[2] > -0.15f && la[3] > -0.15f;
        if (__builtin_amdgcn_ballot_w64(!sm_) == 0ull) {
#pragma unroll
            for (int r = 0; r < 4; ++r) { const float x = la[r], p = x * (1.0f + x * (0.5f + x * (0.16666667f + x * (0.041666668f + x * (0.0083333338f + x * 0.0013888889f)))));
                A[r] = 1.0f + p; Bv[r] = __builtin_amdgcn_sqrtf(-p * (2.0f + p)) * iu[r]; }
        } else {
#pragma unroll
            for (int r = 0; r < 4; ++r) { A[r] = __expf(la[r]); Bv[r] = __builtin_amdgcn_sqrtf(-expm1f_(2.0f * la[r])) * iu[r]; }
        }
#pragma unroll
        for (int r = 0; r < 4; ++r) { float a_ = A[r], b_ = Bv[r]; scan16<REV>(a_, b_); A[r] = a_; Bv[r] = b_; }
        if (i == 0) {
            Ac[0] = A; Hl[0] = Bv;
#pragma unroll
            for (int r = 0; r < 4; ++r) { tA[r] = __shfl(A[r], edge); tB[r] = __shfl(Bv[r], edge); }
        } else {
            Ac[1] = A * tA; Hl[1] = A * tB + Bv;
#pragma unroll
            for (int r = 0; r < 4; ++r) { Atot[r] = __shfl(Ac[1][r], edge); hend[r] = __shfl(Hl[1][r], edge); }
        }
    }
}
__device__ __forceinline__ void lru_chain(const Ctx& C, int l, int id) {
    const int b = id >> 3, hd = (id >> 1) & 3, chalf = id & 1;
    const int lane = C.lane, l15 = lane & 15, q = lane >> 4;
    const int d = C.wave >> 2, mtl = (C.wave >> 1) & 1, th = C.wave & 1, mt = chalf * 2 + mtl;
    LAS bf16* U = (LAS bf16*)C.lds;
    LAS float* XCH = (LAS float*)(C.lds + 2 * 2 * 64 * UPC * 2);
    bf16* P = WSP(bf16, WS_P); bf16* LH = WSP(bf16, WS_LRUH) + (size_t)id * NSTEP * 32;
    const int cd = C.tid >> 8, cj = C.tid & 63, ctq = (C.tid >> 6) & 3;
    const float* cw = C.in[I_LCW] + (size_t)l * 4 * GW + hd * 64 + cj; const float w0 = cw[0], w1 = cw[GW], w2 = cw[2 * GW], w3 = cw[3 * GW], cb = C.in[I_LCB][l * GW + hd * 64 + cj];
    const bf16* wt = WSP(const bf16, WS_LRUWT) + (size_t)((d * 2 + 0) * 4 + hd) * 4096;
    fragb Wa[2], Wx[2];
#pragma unroll
    for (int ks = 0; ks < 2; ++ks) { Wa[ks] = *(const fragb*)(wt + (16 * mt + l15) * 64 + 32 * ks + 8 * q); Wx[ks] = *(const fragb*)(wt + 4 * 4096 + (16 * mt + l15) * 64 + 32 * ks + 8 * q); }
    const int ch0 = hd * 64 + 16 * mt + 4 * q;
    const f32x4 ba = *(const f32x4*)(C.in[I_LBA] + (l * 2 + d) * GW + ch0), bx = *(const f32x4*)(C.in[I_LBX] + (l * 2 + d) * GW + ch0), lam = *(const f32x4*)(C.in[I_LLAM] + (l * 2 + d) * GW + ch0);
    f32x4 sp4;
#pragma unroll
    for (int r = 0; r < 4; ++r) sp4[r] = 8.0f * softplusf_(-lam[r]);
    f32x4 s = (f32x4){0.f, 0.f, 0.f, 0.f};
    unsigned short xr[19];
#define LRU_LOADX(kk) do { const int c_ = lru_chunk_of(cd, (kk)); const bool ic_ = c_ < 4; const int p0_ = (ic_ ? c_ * 64 : (c_ - 4) * 64) + ctq * 16 - 2, Lp_ = ic_ ? CTXL : SEQ; \
        const bf16* xp_ = P + (size_t)(ic_ ? T_LAT + b * CTXL : b * SEQ) * PLD + hd * 64 + cj; \
        _Pragma("unroll") for (int i_ = 0; i_ < 19; ++i_) { const int p_ = p0_ + i_; xr[i_] = (p_ >= 0 && p_ < Lp_) ? xp_[(size_t)p_ * PLD] : (unsigned short)0; } } while (0)
#define LRU_CONV(kk) do { LAS bf16* uo_ = U + ((((kk) & 1) * 2 + cd) * 64 + ctq * 16) * UPC + cj; \
        _Pragma("unroll") for (int t_ = 0; t_ < 16; ++t_) uo_[t_ * UPC] = (bf16)f2bf1(w0 * bf2f(xr[t_]) + w1 * bf2f(xr[t_ + 1]) + w2 * bf2f(xr[t_ + 2]) + w3 * bf2f(xr[t_ + 3]) + cb); } while (0)
    LRU_LOADX(0); LRU_CONV(0); LRU_LOADX(1);
    __syncthreads();
#pragma unroll 1
    for (int k = 0; k < NCH; ++k) {
        if (k + 1 < NCH) { LRU_CONV(k + 1); if (k + 2 < NCH) LRU_LOADX(k + 2); }
        const int c = lru_chunk_of(d, k); const bool second = lru_chunk_of(1 - d, c) < k;
        const bool ic = c < 4; const size_t row0 = (size_t)(ic ? T_LAT + b * CTXL + c * 64 : b * SEQ + (c - 4) * 64);
        const bool late = (k == 2) || (k == 36);
        int tok[2]; v2u gv[2], fv[2];
#pragma unroll
        for (int i = 0; i < 2; ++i) { const int nt = d ? 3 - (2 * th + i) : 2 * th + i; tok[i] = 16 * nt + l15;
            if (second && !late) { gv[i] = *(const v2u*)(P + (row0 + tok[i]) * PLD + 256 + ch0); fv[i] = *(const v2u*)(LH + (size_t)(c * 64 + tok[i]) * 32 + 16 * mtl + 4 * q); } }
        f32x4 Ac[2], Hl[2], Atot, hend;
        const LAS bf16* Ud = U + ((k & 1) * 2 + d) * 64 * UPC;
        if (d) lru_tiles<true>(Ud, th, mt, lane, Wa, Wx, ba, bx, sp4, Ac, Hl, Atot, hend); else lru_tiles<false>(Ud, th, mt, lane, Wa, Wx, ba, bx, sp4, Ac, Hl, Atot, hend);
        LAS float* xw = XCH + (((((k & 1) * 2 + d) * 2 + mtl) * 2 + th) * 4 + q) * 8;
        if (l15 == (d ? 0 : 15)) { *(LAS f32x4*)xw = Atot; *(LAS f32x4*)(xw + 4) = hend; }
        if (late) VM_WAIT();
        RAW_BARRIER();
        if (second && late) {
#pragma unroll
            for (int i = 0; i < 2; ++i) { gv[i] = *(const v2u*)(P + (row0 + tok[i]) * PLD + 256 + ch0); fv[i] = *(const v2u*)(LH + (size_t)(c * 64 + tok[i]) * 32 + 16 * mtl + 4 * q); }
        }
        const LAS float* xr0 = XCH + (((((k & 1) * 2 + d) * 2 + mtl) * 2 + 0) * 4 + q) * 8;
        const f32x4 A0 = *(const LAS f32x4*)xr0, h0 = *(const LAS f32x4*)(xr0 + 4), A1 = *(const LAS f32x4*)(xr0 + 32), h1 = *(const LAS f32x4*)(xr0 + 36);
        const f32x4 mid = A0 * s + h0, hin = th ? mid : s;
        s = A1 * mid + h1;
#pragma unroll
        for (int i = 0; i < 2; ++i) {
            const f32x4 h = Ac[i] * hin + Hl[i];
            if (!second) { v2u o; o.x = pk2(h.x, h.y); o.y = pk2(h.z, h.w); *(v2u*)(LH + (size_t)(c * 64 + tok[i]) * 32 + 16 * mtl + 4 * q) = o; }
            else {
                const f32x4 g = (f32x4){bflo(gv[i].x), bfhi(gv[i].x), bflo(gv[i].y), bfhi(gv[i].y)};
                f32x4 y = (f32x4){h.x + bflo(fv[i].x), h.y + bfhi(fv[i].x), h.z + bflo(fv[i].y), h.w + bfhi(fv[i].y)};
                y.x *= gelu_tanh(g.x); y.y *= gelu_tanh(g.y); y.z *= gelu_tanh(g.z); y.w *= gelu_tanh(g.w);
                st4bf(P + (row0 + tok[i]) * PLD + 256 + ch0, y);
            }
        }
    }
#undef LRU_LOADX
#undef LRU_CONV
    __syncthreads();
}
constexpr int RP = 264;
__device__ __forceinline__ void rwkv_prep2(const Ctx& C, int l, int b, int c) {
    LAS bf16* RS = (LAS bf16*)C.lds;
    LAS bf16* KS = RS + 64 * RP;
    LAS bf16* XW = KS + 64 * RP;
    LAS bf16* XA = XW + 64 * MP;
    LAS bf16* XG = XA + 64 * MP;
    const bf16* P = WSP(const bf16, WS_P);
    const bool isctx = c < 4; const int p0 = isctx ? c * 64 : (c - 4) * 64; const int Lp = isctx ? CTXL : SEQ; const int row0 = isctx ? T_LAT + b * CTXL : b * SEQ;
    const float* mu = C.in[I_RMU] + (size_t)l * 2 * B_COLS;
    bf16* rkv = WSP(bf16, WS_RKV);
#pragma unroll 5
    for (int it = C.tid; it < 64 * 120; it += NTHR) {
        const int t = it / 120, c8 = (it % 120) * 8, p = p0 + t;
        const bf16* pp = P + (size_t)(row0 + p) * PLD + OFF_B + c8;
        const v4u xc = *(const v4u*)pp; v4u xp = (v4u){0u, 0u, 0u, 0u}, xn = xp;
        if (p > 0) xp = *(const v4u*)(pp - PLD);
        if (p < Lp - 1) xn = *(const v4u*)(pp + PLD);
        const f32x4 m0a = *(const f32x4*)(mu + c8), m0b = *(const f32x4*)(mu + c8 + 4), m1a = *(const f32x4*)(mu + B_COLS + c8), m1b = *(const f32x4*)(mu + B_COLS + c8 + 4);
        const unsigned xcw[4] = {xc.x, xc.y, xc.z, xc.w}, xpw[4] = {xp.x, xp.y, xp.z, xp.w}, xnw[4] = {xn.x, xn.y, xn.z, xn.w};
        float sh[8];
#pragma unroll
        for (int e = 0; e < 4; ++e) {
            const float x0 = bflo(xcw[e]), x1 = bfhi(xcw[e]);
            const float mu0_0 = e < 2 ? m0a[2 * e] : m0b[2 * e - 4], mu0_1 = e < 2 ? m0a[2 * e + 1] : m0b[2 * e - 3], mu1_0 = e < 2 ? m1a[2 * e] : m1b[2 * e - 4], mu1_1 = e < 2 ? m1a[2 * e + 1] : m1b[2 * e - 3];
            sh[2 * e] = x0 + mu0_0 * (bflo(xpw[e]) - x0) + mu1_0 * (bflo(xnw[e]) - x0);
            sh[2 * e + 1] = x1 + mu0_1 * (bfhi(xpw[e]) - x1) + mu1_1 * (bfhi(xnw[e]) - x1);
        }
        if (c8 >= 768) {
            const int ci = c8 - 768;
            if (ci < 64) {
#pragma unroll
                for (int e = 0; e < 8; ++e) sh[e] = tanhf_(sh[e]); }
            else if (ci >= 128) {
#pragma unroll
                for (int e = 0; e < 8; ++e) sh[e] = sigmoidf_(sh[e]); }
        }
        v4u o; o.x = pk2(sh[0], sh[1]); o.y = pk2(sh[2], sh[3]); o.z = pk2(sh[4], sh[5]); o.w = pk2(sh[6], sh[7]);
        if (c8 < 768) {
            *(v4u*)(rkv + (size_t)(row0 + p) * 768 + c8) = o;
            if (c8 < 256) *(LAS v4u*)(RS + t * RP + c8) = o; else if (c8 < 512) *(LAS v4u*)(KS + t * RP + c8 - 256) = o;
        } else {
            const int ci = c8 - 768;
            LAS bf16* dst = ci < 64 ? XW + t * MP + ci : (ci < 128 ? XA + t * MP + ci - 64 : XG + t * MP + ci - 128);
            *(LAS v4u*)dst = o;
        }
    }
    __syncthreads();
    const int lane = C.lane, w = C.wave, l15 = lane & 15, q = lane >> 4, hd = w & 3, ntp = w >> 2;
    const bf16* wt = WSP(const bf16, WS_RWT);
    bf16* wa_out = WSP(bf16, WS_HB); bf16* g_out = WSP(bf16, WS_G); float* bonus = WSP(float, WS_BONUS); float* rinv = WSP(float, WS_RINV);
    const f32x4 z4 = (f32x4){0.f, 0.f, 0.f, 0.f};
    float bsum[2] = {0.f, 0.f}, ksum[2] = {0.f, 0.f};
#pragma unroll
    for (int n2 = 0; n2 < 2; ++n2) {
        const int tok = 16 * (2 * ntp + n2) + l15; const size_t row = (size_t)(row0 + p0 + tok);
        const fragb xw0 = ld_frag16(XW + tok * MP + 8 * q), xw1 = ld_frag16(XW + tok * MP + 32 + 8 * q), xa0 = ld_frag16(XA + tok * MP + 8 * q), xa1 = ld_frag16(XA + tok * MP + 32 + 8 * q);
        const fragb xg0 = ld_frag16(XG + tok * MP + 8 * q), xg1 = ld_frag16(XG + tok * MP + 32 + 8 * q);
        unsigned ow0[8], ow1[8], oa0[8], oa1[8], og[8];
#pragma unroll
        for (int mt = 0; mt < 4; ++mt) {
            const int chl = 16 * (l15 >> 2) + 4 * mt + (l15 & 3), ch4 = hd * 64 + 16 * q + 4 * mt;
            const bf16* wrow = wt + (size_t)(hd * 64 + chl) * 32 + 8 * q;
            const bf16* grow = wt + 4 * 256 * 32 + (size_t)(hd * 64 + chl) * 64 + 8 * q;
            const fragb fw0 = *(const fragb*)(wrow), fw1 = *(const fragb*)(wrow + 256 * 32), fa0 = *(const fragb*)(wrow + 2 * 256 * 32), fa1 = *(const fragb*)(wrow + 3 * 256 * 32), fg0 = *(const fragb*)(grow), fg1 = *(const fragb*)(grow + 32);
            const f32x4 w00 = *(const f32x4*)(C.in[I_RW0] + (l * 2 + 0) * GW + ch4), w01 = *(const f32x4*)(C.in[I_RW0] + (l * 2 + 1) * GW + ch4);
            const f32x4 a00 = *(const f32x4*)(C.in[I_RA0] + (l * 2 + 0) * GW + ch4), a01 = *(const f32x4*)(C.in[I_RA0] + (l * 2 + 1) * GW + ch4);
            const f32x4 k_a = *(const f32x4*)(C.in[I_RKA] + l * GW + ch4), r_k = *(const f32x4*)(C.in[I_RRK] + l * GW + ch4), k_k = *(const f32x4*)(C.in[I_RKK] + l * GW + ch4);
            const f32x4 aw0 = mfma16(fw0, xw0, z4), aw1 = mfma16(fw1, xw1, z4), aa0 = mfma16(fa0, xa0, z4), aa1 = mfma16(fa1, xa1, z4);
            f32x4 ag = mfma16(fg0, xg0, z4); ag = mfma16(fg1, xg1, ag);
            f32x4 wv0, wv1, av0, av1;
#pragma unroll
            for (int r = 0; r < 4; ++r) {
                wv0[r] = __expf(-0.6065306597126334f * sigmoidf_(aw0[r] + w00[r])); wv1[r] = __expf(-0.6065306597126334f * sigmoidf_(aw1[r] + w01[r]));
                av0[r] = sigmoidf_(aa0[r] + a00[r]); av1[r] = sigmoidf_(aa1[r] + a01[r]);
            }
            ow0[2 * mt] = pk2(wv0[0], wv0[1]); ow0[2 * mt + 1] = pk2(wv0[2], wv0[3]); ow1[2 * mt] = pk2(wv1[0], wv1[1]); ow1[2 * mt + 1] = pk2(wv1[2], wv1[3]);
            oa0[2 * mt] = pk2(av0[0], av0[1]); oa0[2 * mt + 1] = pk2(av0[2], av0[3]); oa1[2 * mt] = pk2(av1[0], av1[1]); oa1[2 * mt + 1] = pk2(av1[2], av1[3]);
            og[2 * mt] = pk2(ag[0], ag[1]); og[2 * mt + 1] = pk2(ag[2], ag[3]);
            const v2u rr_ = *(const LAS v2u*)(RS + tok * RP + ch4), kr_ = *(const LAS v2u*)(KS + tok * RP + ch4);
            const f32x4 rs = (f32x4){bflo(rr_.x), bfhi(rr_.x), bflo(rr_.y), bfhi(rr_.y)}, ks = (f32x4){bflo(kr_.x), bfhi(kr_.x), bflo(kr_.y), bfhi(kr_.y)};
#pragma unroll
            for (int r = 0; r < 4; ++r) {
                const float km = ks[r] * (1.0f + (av0[r] - 1.0f) * k_a[r]) + ks[r] * (1.0f + (av1[r] - 1.0f) * k_a[r]);
                bsum[n2] += rs[r] * r_k[r] * km; const float kk = ks[r] * k_k[r]; ksum[n2] += kk * kk;
            }
        }
        bf16* wrow_o = wa_out + row * 1024 + hd * 64 + 16 * q;
        *(v4u*)(wrow_o) = (v4u){ow0[0], ow0[1], ow0[2], ow0[3]}; *(v4u*)(wrow_o + 8) = (v4u){ow0[4], ow0[5], ow0[6], ow0[7]};
        *(v4u*)(wrow_o + 256) = (v4u){ow1[0], ow1[1], ow1[2], ow1[3]}; *(v4u*)(wrow_o + 256 + 8) = (v4u){ow1[4], ow1[5], ow1[6], ow1[7]};
        *(v4u*)(wrow_o + 512) = (v4u){oa0[0], oa0[1], oa0[2], oa0[3]}; *(v4u*)(wrow_o + 512 + 8) = (v4u){oa0[4], oa0[5], oa0[6], oa0[7]};
        *(v4u*)(wrow_o + 768) = (v4u){oa1[0], oa1[1], oa1[2], oa1[3]}; *(v4u*)(wrow_o + 768 + 8) = (v4u){oa1[4], oa1[5], oa1[6], oa1[7]};
        bf16* grow_o = g_out + row * 256 + hd * 64 + 16 * q;
        *(v4u*)(grow_o) = (v4u){og[0], og[1], og[2], og[3]}; *(v4u*)(grow_o + 8) = (v4u){og[4], og[5], og[6], og[7]};
    }
#pragma unroll
    for (int n2 = 0; n2 < 2; ++n2) {
        const size_t row = (size_t)(row0 + p0 + 16 * (2 * ntp + n2) + l15);
        float bs = bsum[n2], ks2 = ksum[n2];
        bs += __shfl_xor(bs, 16); bs += __shfl_xor(bs, 32); ks2 += __shfl_xor(ks2, 16); ks2 += __shfl_xor(ks2, 32);
        if (q == 0) { bonus[row * 4 + hd] = bs; rinv[row * 4 + hd] = rsqrtf_(ks2 + 1e-6f); }
    }
    __syncthreads();
}
__device__ __forceinline__ int fwd_row_r(int b, int c, int t) { return c < 4 ? (T_LAT + b * CTXL + c * 64 + t) : (b * SEQ + (c - 4) * 64 + t); }
__device__ __forceinline__ bf16* rw_blob_row(const Ctx& C, int d, int which, int b, int c, int h, int r) {
    const int row = fwd_row_r(b, c, r);
#if RW_VSPLIT
    if (which == 0) { if (d) return WSP(bf16, WS_GQ) + (size_t)row * 768 + 512 + h * 64;
                      return WSP(bf16, WS_P) + (size_t)row * PLD + OFF_B + 512 + h * 64; }
#else
    if (which == 0) return WSP(bf16, WS_OUTB) + ((size_t)d * T_ALL + row) * 256 + h * 64;
#endif
    return WSP(bf16, WS_P) + (size_t)row * PLD + OFF_B + d * 256 + h * 64;
}
__device__ __forceinline__ void rwkv_solve_item(const Ctx& C, int l, int item) {
    const int lane = C.lane, w = C.wave, pw = w & 1, pi = w >> 1, l15 = lane & 15, q = lane >> 4;
    LAS unsigned char* B0 = C.lds + pi * 31744;
    LAS bf16* Kk = (LAS bf16*)B0; LAS bf16* Bh = Kk + 64 * MP; LAS bf16* Kh = Bh + 64 * MP;
    LAS bf16* Ln = (LAS bf16*)B0;
    LAS bf16* Lk16 = (LAS bf16*)(B0 + 9216);
    LAS unsigned char* XT = B0 + 9216;
    LAS bf16* TinvP = (LAS bf16*)(B0 + 25600);
    const bf16* WA = WSP(const bf16, WS_HB); bf16* WAw = WSP(bf16, WS_HB); const bf16* rkv = WSP(const bf16, WS_RKV); const float* rinv = WSP(const float, WS_RINV);
    const int u = item >> 1, d = item & 1;
    const int c = u % NCH, h = (u / NCH) & 3, b = u / (NCH * NH);
    const float k_k = C.in[I_RKK][l * GW + h * 64 + lane], k_a = C.in[I_RKA][l * GW + h * 64 + lane];
    const int n = d ? (c < 4 ? 3 - c : 71 - c) : c;
    const float ril = rinv[(size_t)seqrow_raster(n * 64 + lane, d, b) * 4 + h];
#pragma unroll
    for (int r = 0; r < 4; ++r) { const int idx2 = pw * 64 + lane + 128 * r, t = idx2 >> 3, part = idx2 & 7; const int row = seqrow_raster(n * 64 + t, d, b);
        *(LAS v4u*)(Kk + t * MP + 8 * part) = *(const v4u*)(WA + (size_t)row * 1024 + d * 256 + h * 64 + 8 * part);
        *(LAS v4u*)(Bh + t * MP + 8 * part) = *(const v4u*)(WA + (size_t)row * 1024 + (2 + d) * 256 + h * 64 + 8 * part);
        *(LAS v4u*)(Kh + t * MP + 8 * part) = *(const v4u*)(rkv + (size_t)row * 768 + 256 + h * 64 + 8 * part); }
    __syncthreads();
    {
        float cc = 1.0f;
        if (pw) {
#pragma unroll
            for (int t = 0; t < 32; ++t) cc *= bf2f(Kk[t * MP + lane]);
        }
        __syncthreads();
#pragma unroll
        for (int t2 = 0; t2 < 32; ++t2) {
            const int t = pw * 32 + t2;
            const float wv = bf2f(Kk[t * MP + lane]), av = bf2f(Bh[t * MP + lane]), ks = bf2f(Kh[t * MP + lane]);
            const float kap = ks * k_k * __shfl(ril, t);
            const float cprev = cc; cc *= wv; const float ic = __builtin_amdgcn_rcpf(cc);
            Kk[t * MP + lane] = (bf16)f2bf1(kap * cprev); Bh[t * MP + lane] = (bf16)f2bf1(kap * av * ic); Kh[t * MP + lane] = (bf16)f2bf1(ks * (1.0f + (av - 1.0f) * k_a) * ic);
            WAw[(size_t)seqrow_raster(n * 64 + t, d, b) * 1024 + d * 256 + h * 64 + lane] = (bf16)f2bf1(cc);
        }
    }
    __syncthreads();
    f32x4 acc[4][4];
    if (pw == 0) {
#pragma unroll
        for (int I = 0; I < 4; ++I)
#pragma unroll
            for (int r = 0; r < 4; ++r)
#pragma unroll
                for (int nt = 0; nt < 4; ++nt) acc[I][nt][r] = bf2f(Kk[(16 * I + 4 * q + r) * MP + 16 * nt + l15]);
    }
    f32x4 T[10];
    {
        const LAS bf16* Bsrc = pw ? Kh : Bh;
        int tix = 0;
#pragma unroll
        for (int it = 0; it < 4; ++it)
#pragma unroll
            for (int jt = 0; jt <= it; ++jt, ++tix) {
                f32x4 t4 = (f32x4){0.f, 0.f, 0.f, 0.f};
#pragma unroll
                for (int s = 0; s < 2; ++s) t4 = mfma16(ld_frag16(Kk + (16 * it + l15) * MP + 32 * s + 8 * q), ld_frag16(Bsrc + (16 * jt + l15) * MP + 32 * s + 8 * q), t4);
#pragma unroll
                for (int r = 0; r < 4; ++r) { const int i = 16 * it + 4 * q + r, j = 16 * jt + l15; T[tix][r] = (j < i) ? (pw ? t4[r] : -t4[r]) : 0.f; }
            }
    }
    __syncthreads();
    {
        int tix = 0;
#pragma unroll
        for (int it = 0; it < 4; ++it)
#pragma unroll
            for (int jt = 0; jt < 4; ++jt) {
                if (jt <= it) {
#pragma unroll
                    for (int r = 0; r < 4; ++r) (pw ? Lk16 : Ln)[(16 * it + 4 * q + r) * MP + 16 * jt + l15] = (bf16)f2bf1(T[tix][r]);
                    ++tix;
                } else if (pw == 0) {
#pragma unroll
                    for (int r = 0; r < 4; ++r) Ln[(16 * it + 4 * q + r) * MP + 16 * jt + l15] = (bf16)0;
                }
            }
        LAS v4u* tz = (LAS v4u*)(B0 + 25600) + (pw * 64 + lane) * 2; tz[0] = (v4u){0u, 0u, 0u, 0u}; tz[1] = (v4u){0u, 0u, 0u, 0u};
    }
    __syncthreads();
    if (pw) {
#pragma unroll
        for (int I = 0; I < 4; ++I)
#pragma unroll
            for (int r = 0; r < 4; ++r)
#pragma unroll
                for (int nt = 0; nt < 4; ++nt) { const int i = 16 * I + 4 * q + r, j = 16 * nt + l15; acc[I][nt][r] = (j < i && nt <= I) ? bf2f(Lk16[i * MP + j]) : 0.f; }
    } else diag_inverses(Ln, TinvP, lane);
    __syncthreads();
    LAS unsigned char* XTw = XT + pw * 8192;
    { LAS v4u* xz = (LAS v4u*)(XTw + lane * 128);
#pragma unroll
        for (int g = 0; g < 8; ++g) xz[g] = (v4u){0u, 0u, 0u, 0u}; }
    blocked_solve(Ln, TinvP, XTw, acc, l15, q);
    {
        bf16* dst = rw_blob_row(C, d, pw, b, c, h, lane);
        const LAS unsigned char* xr = XTw + lane * 128;
#pragma unroll
        for (int g = 0; g < 8; ++g) *(v4u*)(dst + 8 * g) = *(const LAS v4u*)(xr + ((g ^ (lane & 7)) << 4));
    }
    __syncthreads();
}

template <bool DRY>
__device__ __forceinline__ void rwkv_chunked(const Ctx& C, int l, int idx) {
#ifndef RW_VSPLIT
#define RW_VSPLIT 1
#endif
    constexpr int NV = RW_VSPLIT ? 1 : 2;
    const int vhalf = idx & 1, lane = C.lane, w = C.wave, l15 = lane & 15, q = lane >> 4;
    const int d = RW_VSPLIT ? idx >> 6 : idx >> 5, b = RW_VSPLIT ? (idx >> 3) & 7 : (idx >> 2) & 7, h = RW_VSPLIT ? (idx >> 1) & 3 : idx & 3;
    const int it = w & 3, vt0 = RW_VSPLIT ? 2 * vhalf + (w >> 2) : 2 * (w >> 2);
    constexpr int IMG = 64 * MP * 2;
    LAS unsigned char* L0 = C.lds;
    LAS bf16* Wi = (LAS bf16*)L0; LAS bf16* Ti = Wi + 64 * MP; LAS bf16* Rh = Ti + 64 * MP; LAS bf16* Kh = Rh + 64 * MP; LAS bf16* Bh = Kh + 64 * MP;
    LAS bf16* UT = (LAS bf16*)(L0 + 11 * IMG);
    LAS float* cLv = (LAS float*)(L0 + 14 * IMG);
    const bf16* WA = WSP(const bf16, WS_HB); const bf16* rkv = WSP(const bf16, WS_RKV); const float* rinv = WSP(const float, WS_RINV);
    bf16* outb = WSP(bf16, WS_OUTB) + (size_t)d * T_ALL * 256;
    const int tt = C.tid >> 3, part = C.tid & 7;
    for (int i = C.tid; i < 2 * IMG / 4; i += NTHR) ((LAS unsigned*)(L0 + 12 * IMG))[i] = 0u;
    float kkw[8], kaw[8];
#pragma unroll
    for (int e = 0; e < 8; ++e) { kkw[e] = C.in[I_RKK][l * GW + h * 64 + 8 * w + e]; kaw[e] = C.in[I_RKA][l * GW + h * 64 + 8 * w + e]; }
    v4u gr, gk, gv, gw, ga, gbw, gbt; float gri;
    auto gload = [&](int n) {
        const int c = d ? (n < 4 ? 3 - n : 71 - n) : n;
        const int row = seqrow_raster(n * 64 + lane, d, b);
        const bf16* pr = rkv + (size_t)row * 768 + h * 64 + 8 * w;
        gr = *(const v4u*)pr; gk = *(const v4u*)(pr + 256); gv = *(const v4u*)(pr + 512);
        gw = *(const v4u*)(WA + (size_t)row * 1024 + d * 256 + h * 64 + 8 * w); ga = *(const v4u*)(WA + (size_t)row * 1024 + (2 + d) * 256 + h * 64 + 8 * w);
        gri = rinv[(size_t)row * 4 + h];
        gbw = *(const v4u*)(rw_blob_row(C, d, 0, b, c, h, tt) + 8 * part); gbt = *(const v4u*)(rw_blob_row(C, d, 1, b, c, h, tt) + 8 * part);
    };
    auto images = [&](int bufi) {
        LAS bf16* VT = (LAS bf16*)(L0 + (5 + 3 * bufi) * IMG); LAS bf16* KcT = VT + 64 * MP; LAS bf16* BcT = KcT + 64 * MP;
        const unsigned rw_[4] = {gr.x, gr.y, gr.z, gr.w}, kw_[4] = {gk.x, gk.y, gk.z, gk.w}, vw_[4] = {gv.x, gv.y, gv.z, gv.w}, ww_[4] = {gw.x, gw.y, gw.z, gw.w}, aw_[4] = {ga.x, ga.y, ga.z, ga.w};
        float rh[8], kh[8], bh[8];
#pragma unroll
        for (int e = 0; e < 8; ++e) {
            const float rs = (e & 1) ? bfhi(rw_[e >> 1]) : bflo(rw_[e >> 1]), ks = (e & 1) ? bfhi(kw_[e >> 1]) : bflo(kw_[e >> 1]);
            const float wv = (e & 1) ? bfhi(ww_[e >> 1]) : bflo(ww_[e >> 1]), av = (e & 1) ? bfhi(aw_[e >> 1]) : bflo(aw_[e >> 1]);
            const float kap = ks * kkw[e] * gri, ktil = ks * (1.0f + (av - 1.0f) * kaw[e]);
            const float cf = wv, icf = __builtin_amdgcn_rcpf(cf), cfL = __builtin_bit_cast(float, __builtin_amdgcn_readlane(__builtin_bit_cast(int, cf), 63)), dec = cfL * icf;
            rh[e] = rs * cf; kh[e] = ktil * icf; bh[e] = kap * av * icf;
            const unsigned short vraw = (e & 1) ? (unsigned short)(vw_[e >> 1] >> 16) : (unsigned short)(vw_[e >> 1] & 0xffffu);
            VT[(8 * w + e) * MP + lane] = vraw; KcT[(8 * w + e) * MP + lane] = (bf16)f2bf1(ktil * dec); BcT[(8 * w + e) * MP + lane] = (bf16)f2bf1(-(kap * av * dec));
            if (lane == 63) cLv[bufi * 64 + 8 * w + e] = cfL;
        }
        { v4u o; o.x = pk2(rh[0], rh[1]); o.y = pk2(rh[2], rh[3]); o.z = pk2(rh[4], rh[5]); o.w = pk2(rh[6], rh[7]); *(LAS v4u*)(Rh + lane * MP + 8 * w) = o; }
        { v4u o; o.x = pk2(kh[0], kh[1]); o.y = pk2(kh[2], kh[3]); o.z = pk2(kh[4], kh[5]); o.w = pk2(kh[6], kh[7]); *(LAS v4u*)(Kh + lane * MP + 8 * w) = o; }
        { v4u o; o.x = pk2(bh[0], bh[1]); o.y = pk2(bh[2], bh[3]); o.z = pk2(bh[4], bh[5]); o.w = pk2(bh[6], bh[7]); *(LAS v4u*)(Bh + lane * MP + 8 * w) = o; }
        const unsigned bw_[4] = {gbw.x, gbw.y, gbw.z, gbw.w}, bt_[4] = {gbt.x, gbt.y, gbt.z, gbt.w};
#pragma unroll
        for (int e = 0; e < 4; ++e) {
            Wi[(8 * part + 2 * e) * MP + tt] = (bf16)(bw_[e] & 0xffffu); Wi[(8 * part + 2 * e + 1) * MP + tt] = (bf16)(bw_[e] >> 16);
            Ti[(8 * part + 2 * e) * MP + tt] = (bf16)(bt_[e] & 0xffffu); Ti[(8 * part + 2 * e + 1) * MP + tt] = (bf16)(bt_[e] >> 16);
        }
    };
    f32x4 Zst[NV];
#pragma unroll
    for (int v2 = 0; v2 < NV; ++v2) Zst[v2] = (f32x4){0.f, 0.f, 0.f, 0.f};
    const f32x4 z4 = (f32x4){0.f, 0.f, 0.f, 0.f};
    gload(0); images(0); gload(1);
#pragma unroll 1
    for (int n = 0; n < NCH; ++n) {
        RAW_BARRIER();
        const LAS bf16* VT = (const LAS bf16*)(L0 + (5 + 3 * (n & 1)) * IMG); const LAS bf16* KcT = VT + 64 * MP; const LAS bf16* BcT = KcT + 64 * MP;
        const LAS bf16* Zi = (const LAS bf16*)(L0 + (12 + (n & 1)) * IMG); LAS bf16* Zn = (LAS bf16*)(L0 + (12 + ((n + 1) & 1)) * IMG);
        const int arow = (16 * it + l15) * MP + 8 * q;
        const fragb Wf0 = ld_frag16(Wi + arow), Wf1 = ld_frag16(Wi + arow + 32), Tf0 = ld_frag16(Ti + arow), Tf1 = ld_frag16(Ti + arow + 32), Rf0 = ld_frag16(Rh + arow), Rf1 = ld_frag16(Rh + arow + 32);
        const int icol = 16 * it + l15;
        f32x4 pk[4], pb[4];
#pragma unroll
        for (int jt = 0; jt < 4; ++jt) {
            pk[jt] = z4; pb[jt] = z4;
            if (jt <= it) {
                const int jrow = (16 * jt + l15) * MP + 8 * q;
                f32x4 sk = mfma16(ld_frag16(Kh + jrow), Rf0, z4); sk = mfma16(ld_frag16(Kh + jrow + 32), Rf1, sk);
                f32x4 sb = mfma16(ld_frag16(Bh + jrow), Rf0, z4); sb = mfma16(ld_frag16(Bh + jrow + 32), Rf1, sb);
#pragma unroll
                for (int r = 0; r < 4; ++r) { const int j = 16 * jt + 4 * q + r; pk[jt][r] = (j <= icol) ? sk[r] : 0.f; pb[jt][r] = (j <= icol) ? -sb[r] : 0.f; }
            }
        }
        fragb Pk0 = pack_frag(pk[0], pk[1]), Pk1 = pack_frag(pk[2], pk[3]), Pb0 = pack_frag(pb[0], pb[1]), Pb1 = pack_frag(pb[2], pb[3]);
        f32x4 RZ[NV];
#pragma unroll
        for (int v2 = 0; v2 < NV; ++v2) {
            const int vrow = 16 * (vt0 + v2) + l15;
            const fragb z0 = ld_frag16(Zi + vrow * MP + 8 * q), z1 = ld_frag16(Zi + vrow * MP + 32 + 8 * q);
            f32x4 u = mfma16(Wf0, z0, z4); u = mfma16(Wf1, z1, u);
            u = mfma16(Tf0, ld_frag16(VT + vrow * MP + 8 * q), u); if (it >= 2) u = mfma16(Tf1, ld_frag16(VT + vrow * MP + 32 + 8 * q), u);
            RZ[v2] = mfma16(Rf0, z0, z4); RZ[v2] = mfma16(Rf1, z1, RZ[v2]);
            v2u o; o.x = pk2(u.x, u.y); o.y = pk2(u.z, u.w);
            *(LAS v2u*)(UT + vrow * MP + 16 * it + 4 * q) = o;
        }
        RAW_BARRIER();
        {
            const f32x4 cl4 = *(const LAS f32x4*)(cLv + (n & 1) * 64 + 16 * it + 4 * q);
            const LAS bf16* kr = KcT + (16 * it + l15) * MP + 4 * q; const LAS bf16* br = BcT + (16 * it + l15) * MP + 4 * q;
            const fragb kc0 = ld_frag8x2(kr, kr + 16), kc1 = ld_frag8x2(kr + 32, kr + 48), bc0 = ld_frag8x2(br, br + 16), bc1 = ld_frag8x2(br + 32, br + 48);
#pragma unroll
            for (int v2 = 0; v2 < NV; ++v2) {
                const int vrow = 16 * (vt0 + v2) + l15;
                const LAS bf16* vr = VT + vrow * MP + 4 * q; const LAS bf16* ur = UT + vrow * MP + 4 * q;
                const fragb vp0 = ld_frag8x2(vr, vr + 16), vp1 = ld_frag8x2(vr + 32, vr + 48), up0 = ld_frag8x2(ur, ur + 16), up1 = ld_frag8x2(ur + 32, ur + 48);
                f32x4 y = mfma16(Pk0, vp0, RZ[v2]); y = mfma16(Pb0, up0, y);
                if (it >= 2) { y = mfma16(Pk1, vp1, y); y = mfma16(Pb1, up1, y); }
#pragma unroll
                for (int r = 0; r < 4; ++r) { const int row = seqrow_raster(n * 64 + 16 * it + 4 * q + r, d, b); if (!DRY) outb[(size_t)row * 256 + h * 64 + vrow] = (bf16)f2bf1(y[r]); }
                f32x4 zn = mfma16(kc0, vp0, z4); zn = mfma16(kc1, vp1, zn); zn = mfma16(bc0, up0, zn); zn = mfma16(bc1, up1, zn);
                Zst[v2] = Zst[v2] * cl4 + zn;
                v2u so; so.x = pk2(Zst[v2].x, Zst[v2].y); so.y = pk2(Zst[v2].z, Zst[v2].w);
                *(LAS v2u*)(Zn + vrow * MP + 16 * it + 4 * q) = so;
            }
        }
        if (n + 1 < NCH) { images((n + 1) & 1); if (n + 2 < NCH) gload(n + 2); }
    }
    __syncthreads();
}
__device__ __forceinline__ void moe_scatter(const Ctx& C, int moe_li, int nrows) {
    const unsigned* gc = WSP(const unsigned, WS_CTL) + CW_MOECNT + 64 * moe_li;
    LAS int* pst = (LAS int*)C.lds;
    {
        int pe[8]; int acc = 0;
#pragma unroll
        for (int e = 0; e < NE; ++e) { const int blks = ((int)gc[e] + 255) >> 8; if (C.tid == e) pst[e] = acc * 256; acc += blks; pe[e] = acc; }
        if (C.wg == 0 && C.tid < MOE_MAXBLK) { int be = 0;
#pragma unroll
            for (int e = 0; e < NE; ++e) be += (pe[e] <= C.tid) ? 1 : 0;
            int* tab = WSP(int, WS_TAB); tab[1 + C.tid] = be < NE ? be : NE - 1; if (C.tid == 0) tab[0] = acc; }
    }
    __syncthreads();
    const unsigned* route = WSP(const unsigned, WS_ROUTE); const unsigned* wgbase = WSP(const unsigned, WS_WGBASE);
    int* pos = WSP(int, WS_POS); int* tok = WSP(int, WS_TOK);
    if (C.wg < NE) { const int cnt = (int)gc[C.wg], s0 = pst[C.wg] + cnt, s1 = pst[C.wg] + (((cnt + 255) >> 8) << 8);
        for (int j = s0 + C.tid; j < s1; j += NTHR) tok[j] = 0; }
    const int m = C.wg * NWAVES + C.wave + C.lane * (C.G * NWAVES);
    if (m < nrows) {
        const v4u a = *(const v4u*)(route + (size_t)m * 8);
        const int e0 = (int)a.x, e1 = (int)a.y;
        const int p0 = pst[e0] + (int)wgbase[C.wg * 8 + e0] + (int)a.z, p1 = pst[e1] + (int)wgbase[C.wg * 8 + e1] + (int)a.w;
        pos[(size_t)m * 2] = p0; pos[(size_t)m * 2 + 1] = p1; tok[p0] = m; tok[p1] = m;
    }
    __syncthreads();
}
template <int NEXT>
__device__ __forceinline__ void moe_combine(const Ctx& C, int l, int nrows) {
    const unsigned* route = WSP(const unsigned, WS_ROUTE); const int* pos = WSP(const int, WS_POS); const bf16* ym = WSP(const bf16, WS_MIX);
    const float* modv = WSP(const float, WS_MODV) + (size_t)l * 9 * 6144 + 5 * 1024;
    const float* modn = WSP(const float, WS_MODV) + (size_t)(l + 1) * 9 * 6144;
    float* xc = WSP(float, WS_XC); bf16* hb = WSP(bf16, WS_HB);
    bf16* xlb = NEXT == 2 ? WSP(bf16, WS_XLAST) : (bf16*)C.out;
    const int gw = C.wg * NWAVES + C.wave, NGW = C.G * NWAVES;
    f32x4 gn[4];
#pragma unroll
    for (int j = 0; j < 4; ++j) gn[j] = *(const f32x4*)((NEXT == 2 ? C.in[I_FNG] : C.in[I_NMIXG] + (NEXT == 1 ? (l + 1) * 1024 : 0)) + 4 * C.lane + 256 * j);
    for (int m = gw; m < nrows; m += NGW) {
        const bool isctx = m >= T_LAT;
        float* xr = isctx ? xc + (size_t)(m - T_LAT) * 1024 : C.out + (size_t)m * 1024; bf16* xrb = xlb + (size_t)m * 1024;
        const int mrow = isctx ? 8 : (m >> 12);
        const float* gv = modv + (size_t)mrow * 6144;
        const int p0 = pos[(size_t)m * 2], p1 = pos[(size_t)m * 2 + 1];
        const float w0 = __builtin_bit_cast(float, route[(size_t)m * 8 + 4]), w1 = __builtin_bit_cast(float, route[(size_t)m * 8 + 5]);
        f32x4 x[4]; float ss = 0.f;
#pragma unroll
        for (int j = 0; j < 4; ++j) {
            const int col = 4 * C.lane + 256 * j;
            const v2u a = *(const v2u*)(ym + (size_t)p0 * 1024 + col), b = *(const v2u*)(ym + (size_t)p1 * 1024 + col);
            const f32x4 ya = (f32x4){bflo(a.x), bfhi(a.x), bflo(a.y), bfhi(a.y)}, yb = (f32x4){bflo(b.x), bfhi(b.x), bflo(b.y), bfhi(b.y)};
            const f32x4 g = *(const f32x4*)(gv + col);
            x[j] = (isctx ? *(const f32x4*)(xr + col) : ld4bf(xrb + col)) + g * (ya * w0 + yb * w1);
            if (NEXT != 2) { if (isctx) *(f32x4*)(xr + col) = x[j]; else st4bf(xrb + col, x[j]); }
            ss += (x[j].x * x[j].x + x[j].y * x[j].y) + (x[j].z * x[j].z + x[j].w * x[j].w);
        }
        if (NEXT != 0) {
            const float rs = rsqrtf_(wave_sum(ss) * (1.0f / 1024.0f) + 1e-6f);
#pragma unroll
            for (int j = 0; j < 4; ++j) {
                const int col = 4 * C.lane + 256 * j;
                if (NEXT == 2) *(f32x4*)(xr + col) = x[j] * rs * gn[j];
                else { const f32x4 sh = *(const f32x4*)(modn + (size_t)mrow * 6144 + col), scl = *(const f32x4*)(modn + (size_t)mrow * 6144 + 1024 + col);
                    st4bf(hb + (size_t)m * 1024 + col, (x[j] * rs * gn[j]) * (scl + 1.0f) + sh); }
            }
        }
    }
}
__device__ __forceinline__ void final_norm(const Ctx& C) {
    const int gw = C.wg * NWAVES + C.wave, NGW = C.G * NWAVES;
    f32x4 gv[4];
#pragma unroll
    for (int j = 0; j < 4; ++j) gv[j] = *(const f32x4*)(C.in[I_FNG] + 4 * C.lane + 256 * j);
    for (int m = gw; m < T_LAT; m += NGW) {
        float* xr = C.out + (size_t)m * 1024;
        f32x4 v[4]; float s = 0.f;
#pragma unroll
        for (int j = 0; j < 4; ++j) { v[j] = *(const f32x4*)(xr + 4 * C.lane + 256 * j); s += (v[j].x * v[j].x + v[j].y * v[j].y) + (v[j].z * v[j].z + v[j].w * v[j].w); }
        const float rs = rsqrtf_(wave_sum(s) * (1.0f / 1024.0f) + 1e-6f);
#pragma unroll
        for (int j = 0; j < 4; ++j) *(f32x4*)(xr + 4 * C.lane + 256 * j) = v[j] * rs * gv[j];
    }
}

constexpr int NPH_L = 13, PH_FINAL = 1 + DEPTH * NPH_L, NPHASE = PH_FINAL + 1;
__host__ __device__ inline bool phase_exists(int ph) {
    if (ph == 0) return true;
    if (ph == PH_FINAL) return false;
    const int l = (ph - 1) / NPH_L, k = (ph - 1) % NPH_L;
    if (l >= 2 && !(l & 1) && k == 0) return false;
    if (!(l & 1) && k >= 11) return false;
    if (!RW_VSPLIT && k == 4) return false;
    return true;
}
#ifndef PH_MASK
#define PH_MASK 0xFFFFFF
#endif
#define PM(k) ((PH_MASK >> (k)) & 1)
#ifndef SK_MASK
#define SK_MASK 0xFFFF
#endif
#define SK(k) ((SK_MASK >> (k)) & 1)
#ifndef REP_MASK
#define REP_MASK 0
#endif
#define NREP(k) (((REP_MASK >> (k)) & 1) ? 2 : 1)

__global__ void __launch_bounds__(NTHR, 2) fwd_kernel(Args args) {
    extern __shared__ __attribute__((aligned(16))) unsigned char lds_raw[];
    Ctx C; C.in = args.in; C.out = args.out; C.ws = args.ws; C.lds = (LAS unsigned char*)lds_raw;
    C.tid = threadIdx.x; C.lane = C.tid & 63; C.wave = __builtin_amdgcn_readfirstlane(C.tid >> 6); C.G = gridDim.x; C.wg = blockIdx.x;
    volatile LAS unsigned* MISC = (volatile LAS unsigned*)(C.lds + MISC_OFF);
    if (C.tid < 64) MISC[C.tid] = 0u;
    __syncthreads();
    const int lo = args.ph_lo, hi = args.ph_hi;
    const bool multi = (hi - lo) > 1;
    if (multi) (void)xcd_barrier_post(WSP(unsigned, WS_CTL) + CW_BAR, MISC + 8);
#define IN(k) (lo <= (k) && (k) < hi)
#define SEAM(k) do { if (IN((k) + 1)) { XcdBarrier b2_; b2_.bar = WSP(unsigned, WS_CTL) + CW_BAR; b2_.x = xb_xcc_id(); b2_.st = (volatile LAS unsigned*)(C.lds + MISC_OFF) + 8; xcd_barrier(b2_); } } while (0)
#define FRESH() do { int t_ = threadIdx.x; asm volatile("" : "+v"(t_)); C.tid = t_; C.lane = t_ & 63; C.wave = __builtin_amdgcn_readfirstlane(t_ >> 6); } while (0)
#define PHASE(bit, k) if (PM(bit) && IN(pb + (k))) for (int rep_ = 0; rep_ < NREP(bit); ++rep_)
#define CLAIM(qh, var) __syncthreads(); if (C.tid == 0) *qslot = atomicAdd((qh), 1u); __syncthreads(); const int var = (int)*qslot;

    LAS unsigned* qslot = (LAS unsigned*)(C.lds + MISC_OFF + 128);
    constexpr int NCSL = 512;
    if (PM(20) && IN(0)) { phase_pre(C);
        for (;;) { FRESH(); CLAIM(WSP(unsigned, WS_CTL) + CW_PREPQ + 224, u0) if (u0 >= NCSL) break; FRESH(); convert_items(C, 0, 3, u0 * NWAVES + C.wave, NCSL * NWAVES); }
        SEAM(0); }

#pragma unroll 1
    for (int l = 0; l < DEPTH; ++l) {
        const int pb = 1 + l * NPH_L;
        if (hi <= pb || lo >= pb + NPH_L) continue;
        const bool last = (l == DEPTH - 1), moe = (l & 1);
        const int nrows = last ? T_LAT : T_ALL;
        const void* xlat = (l == 0) ? (const void*)C.in[I_X] : (const void*)C.out; const bool xbf = l > 0; void* xmid = last ? (void*)WSP(bf16, WS_XLAST) : (void*)C.out;
        const float* xctx = (l == 0) ? C.in[I_CTX] : WSP(const float, WS_XC);
        const float* modv = WSP(const float, WS_MODV) + (size_t)l * 9 * 6144;
        unsigned* qbase = WSP(unsigned, WS_CTL) + CW_PREPQ + 256 * l;

        if (!(l >= 2 && !(l & 1))) PHASE(0, 0) { FRESH();
            convert_small(C, l);
            __syncthreads();
            FRESH(); norm_rows<false>(C, l, xlat, xbf, xctx, C.in[I_NMIXG] + l * 1024, 0, 1024, T_ALL, 0);
            SEAM(pb + 0);
        }
        PHASE(1, 1) { FRESH();
            pg8::Gemm g{WSP(const bf16, WS_HB), WSP(const bf16, WS_WIN), T_ALL, PLD, 1024, 0};
            pg8::StaticOrder S; S.init(T_ALL, PLD, C.G, C.wg);
            pg8::EpiBf16<0> E{WSP(bf16, WS_P), PLD, nullptr, 0, 0};
            pg8::gemm_phase<pg8::EpiBf16<0>, pg8::StaticOrder, false>(C.lds, g, S, E, nullptr);
            SEAM(pb + 1);
        }
        if (PM(2) && IN(pb + 2)) for (int rep_ = 0; rep_ < NREP(2); ++rep_) { FRESH();
            for (;;) {
                CLAIM(qbase + 16 * rep_, k)
                if (k >= 2 * NB * NCH) break;
                const int kind = k / (NB * NCH), u = k % (NB * NCH);
                FRESH();
                if (kind == 0) { for (int r3_ = 0; r3_ < NREP(24); ++r3_) { FRESH(); if (SK(1)) rwkv_prep2(C, l, u / NCH, u % NCH); } }
                else { for (int r3_ = 0; r3_ < NREP(26); ++r3_) { FRESH(); if (SK(2)) gdn_prep(C, l, u / NCH, u % NCH); } }
            }
            SEAM(pb + 2);
        }
        if (PM(3) && IN(pb + 3)) for (int rep_ = 0; rep_ < NREP(3); ++rep_) { FRESH();
            constexpr int NCL = 2 * NB * NH * NCH / 4;
            int ncl_ = 0;
            for (;;) {
                CLAIM(qbase + 64 + 16 * rep_, k)
                if (k >= NCL) break;
                FRESH(); ++ncl_;
                if (SK(10)) rwkv_solve_item(C, l, 4 * k + (C.wave >> 1));
            }
            if (ncl_ <= 4) { const int cap_ = (l & 1) ? 1 : 3;
                for (int j_ = 0; j_ < cap_; ++j_) {
                    FRESH(); CLAIM(qbase + 192, u0)
                    if (u0 >= NCSL) break;
                    FRESH(); if (l > 0) convert_items(C, l, 2, u0 * NWAVES + C.wave, NCSL * NWAVES);
                    if (l + 1 < DEPTH) { FRESH(); convert_items(C, l + 1, 1, u0 * NWAVES + C.wave, NCSL * NWAVES); }
                }
            }
            SEAM(pb + (RW_VSPLIT ? 3 : 4));
        }
#if RW_VSPLIT
        if (PM(3) && IN(pb + 4)) { FRESH();
            for (;;) {
                CLAIM(qbase + 128, k)
                if (k >= 2 * NB * NH * NCH / 4) break;
                FRESH();
                if (SK(10)) rwkv_solve_item(C, l, 4 * k + (C.wave >> 1));
            }
            SEAM(pb + 4);
        }
#endif
        if (PM(4) && IN(pb + 5)) { FRESH();
            if (C.wg >= 64) {
                constexpr int NCL = 2 * NB * NH * NCH / 4;
                for (;;) {
                    CLAIM(qbase + 128, k)
                    if (k >= NCL) break;
                    FRESH();
                    if (SK(9)) gdn_solve_item(C, l, 4 * k + (C.wave >> 1));
                }
                asm volatile("s_waitcnt vmcnt(0)" ::: "memory");
                __syncthreads();
                if (C.tid == 0) { __builtin_amdgcn_fence(__ATOMIC_RELEASE, "agent"); asm volatile("s_waitcnt vmcnt(0)" ::: "memory"); (void)xb_add(qbase + 160, 1u); }
                if (C.wg >= 192) {
                    if (C.tid == 0) { unsigned* bar_ = WSP(unsigned, WS_CTL) + CW_BAR; XB_SPIN(xb_ld(qbase + 160) < (unsigned)(C.G - 64), bar_); __builtin_amdgcn_fence(__ATOMIC_ACQUIRE, "agent"); asm volatile("s_waitcnt vmcnt(0)" ::: "memory"); }
                    __syncthreads();
                }
                FRESH();
            }
            if (C.wg >= 64 && C.wg < 128) { if (SK(0)) lru_chain(C, l, C.wg - 64); FRESH(); }
            if (SK(3) && C.wg < (RW_VSPLIT ? 128 : 64)) { if (NREP(20) > 1) { FRESH(); rwkv_chunked<true>(C, l, C.wg); } FRESH(); rwkv_chunked<false>(C, l, C.wg); }
            else if (SK(4) && C.wg >= 128 && C.wg < 192) { for (int r2_ = 0; r2_ < NREP(21); ++r2_) { FRESH(); mlstm_chunked(C, l, C.wg - 128); } }
            else if (SK(5) && C.wg >= 192) { if (NREP(22) > 1) { FRESH(); gdn_chunked<true>(C, l, C.wg - 192); } FRESH(); gdn_chunked<false>(C, l, C.wg - 192); }
            {
                FRESH();
                const int nun = 0;
                for (;;) {
                    CLAIM(qbase + 192, u0)
                    if (u0 >= NCSL + nun) break;
                    if (u0 < NCSL) {
                        FRESH(); if (l > 0) convert_items(C, l, 2, u0 * NWAVES + C.wave, NCSL * NWAVES);
                        if (l + 1 < DEPTH) { FRESH(); convert_items(C, l + 1, 1, u0 * NWAVES + C.wave, NCSL * NWAVES); }
                    }
                }
            }
            SEAM(pb + 5);
        }
        PHASE(5, 6) { FRESH();
            if (SK(8)) finish_rows(C, l, nrows);
            SEAM(pb + 6);
        }
        if (PM(6) && IN(pb + 7)) { FRESH();
            pg8::Gemm g{WSP(const bf16, WS_HB), WSP(const bf16, WS_WOUT), nrows, 1024, 1024, 0};
            pg8::StaticOrder S; S.init(nrows, 1024, C.G, C.wg);
            pg8::EpiRes E{xlat, xctx, xmid, WSP(float, WS_XC), modv + 2 * 1024, xbf, true};
            pg8::gemm_phase<pg8::EpiRes, pg8::StaticOrder, false>(C.lds, g, S, E, nullptr);
            SEAM(pb + 7);
        }
        if (PM(7) && IN(pb + 8)) { FRESH();
            if (moe) norm_rows<true>(C, l, xmid, true, WSP(const float, WS_XC), C.in[I_NFFNG] + l * 1024, 3 * 1024, 4 * 1024, nrows, l >> 1);
            else norm_rows<false>(C, l, xmid, true, WSP(const float, WS_XC), C.in[I_NFFNG] + l * 1024, 3 * 1024, 4 * 1024, nrows, 0);
            SEAM(pb + 8);
        }
        if (!moe) {
            if (PM(8) && IN(pb + 9)) for (int rep_ = 0; rep_ < NREP(8); ++rep_) { FRESH();
                pg8::Gemm g{WSP(const bf16, WS_HB), WSP(const bf16, WS_WGU), nrows, 2 * DFF, 1024, 0};
                pg8::StaticOrder S; S.init(nrows, 2 * DFF, C.G, C.wg);
                pg8::EpiSwiglu E{WSP(bf16, WS_P), DFF};
                pg8::gemm_phase<pg8::EpiSwiglu, pg8::StaticOrder, false>(C.lds, g, S, E, nullptr);
                SEAM(pb + 9);
            }
            if (PM(9) && IN(pb + 10)) { FRESH();
                pg8::Gemm g{WSP(const bf16, WS_P), WSP(const bf16, WS_WDN), nrows, 1024, DFF, 0};
                pg8::StaticOrder S; S.init(nrows, 1024, C.G, C.wg);
                pg8::EpiRes E{xmid, WSP(const float, WS_XC), xmid, WSP(float, WS_XC), modv + 5 * 1024, true, true};
                pg8::gemm_phase<pg8::EpiRes, pg8::StaticOrder, false>(C.lds, g, S, E, nullptr);
                SEAM(pb + 12);
            }
        } else {
            if (PM(10) && IN(pb + 9)) { FRESH(); moe_scatter(C, l >> 1, nrows); SEAM(pb + 9); }
            if (PM(11) && IN(pb + 10)) for (int rep_ = 0; rep_ < NREP(11); ++rep_) { FRESH();
                pg8::Gemm g{WSP(const bf16, WS_HB), WSP(const bf16, WS_WGU), 0, 2 * DFE, 1024, (size_t)2 * DFE * 1024};
                pg8::MoeOrderG S; S.init(WSP(const int, WS_TAB), (2 * DFE) / 256, C.G, C.wg); S.tok = WSP(const int, WS_TOK);
                pg8::EpiSwiglu E{WSP(bf16, WS_P), DFE};
                pg8::gemm_phase<pg8::EpiSwiglu, pg8::MoeOrderG, false>(C.lds, g, S, E, nullptr);
                SEAM(pb + 10);
            }
            if (PM(12) && IN(pb + 11)) for (int rep_ = 0; rep_ < NREP(12); ++rep_) { FRESH();
                pg8::Gemm g{WSP(const bf16, WS_P), WSP(const bf16, WS_WDN), 0, 1024, DFE, (size_t)1024 * DFE};
                pg8::MoeOrder S; S.init(WSP(const int, WS_TAB), 4, C.G, C.wg);
                pg8::EpiBf16<0> E{WSP(bf16, WS_MIX), 1024, nullptr, 0, 0};
                pg8::gemm_phase<pg8::EpiBf16<0>, pg8::MoeOrder, false>(C.lds, g, S, E, nullptr);
                SEAM(pb + 11);
            }
            if (PM(13) && IN(pb + 12)) { FRESH();
                if (last) moe_combine<2>(C, l, nrows);
                else { convert_small(C, l + 1); FRESH(); moe_combine<1>(C, l, nrows); if (IN(pb + NPH_L + 1)) { XcdBarrier b2_; b2_.bar = WSP(unsigned, WS_CTL) + CW_BAR; b2_.x = xb_xcc_id(); b2_.st = (volatile LAS unsigned*)(C.lds + MISC_OFF) + 8; xcd_barrier(b2_); } }
            }
        }
    }
}

extern "C" void kernel_launch(void* const* d_in, const int* in_sizes, int n_in, void* d_out, int out_size, void* d_ws, size_t ws_size, hipStream_t stream) {
    static int grid = 0;
    if (grid == 0) {
        if (n_in != N_IN || in_sizes[0] != T_LAT * DM || out_size != T_LAT * DM || ws_size < WS_END) {
            fprintf(stderr, "kernel_launch: unexpected problem (n_in %d, in0 %d, out %d, ws %zu < %zu)\n", n_in, n_in > 0 ? in_sizes[0] : -1, out_size, ws_size, (size_t)WS_END); grid = -1; return; }
        int dev = 0, cus = 0, per_cu = 0;
        if (hipGetDevice(&dev) != hipSuccess || hipDeviceGetAttribute(&cus, hipDeviceAttributeMultiprocessorCount, dev) != hipSuccess) { grid = -1; return; }
        if (hipFuncSetAttribute((const void*)fwd_kernel, hipFuncAttributeMaxDynamicSharedMemorySize, LDS_BYTES) != hipSuccess) { fprintf(stderr, "kernel_launch: hipFuncSetAttribute failed\n"); grid = -1; return; }
        if (hipOccupancyMaxActiveBlocksPerMultiprocessor(&per_cu, (const void*)fwd_kernel, NTHR, LDS_BYTES) != hipSuccess || per_cu < 1) { fprintf(stderr, "kernel_launch: occupancy query says %d\n", per_cu); grid = -1; return; }
        grid = cus;
        if (grid != 256) fprintf(stderr, "kernel_launch: note: %d CUs\n", grid);
    }
    if (grid < 0) return;
    if (hipMemsetAsync((char*)d_ws + WS_CTL, 0, CTL_BYTES, stream) != hipSuccess) return;
    Args a{};
    for (int i = 0; i < N_IN; ++i) a.in[i] = (const float*)d_in[i];
    a.out = (float*)d_out; a.ws = (unsigned char*)d_ws;
#if MK_ONE_LAUNCH
    a.ph_lo = 0; a.ph_hi = NPHASE;
    hipLaunchKernelGGL(fwd_kernel, dim3(grid), dim3(NTHR), LDS_BYTES, stream, a);
#else
    for (int ph = 0; ph < NPHASE; ++ph) { if (!phase_exists(ph)) continue; a.ph_lo = ph; a.ph_hi = ph + 1; hipLaunchKernelGGL(fwd_kernel, dim3(grid), dim3(NTHR), LDS_BYTES, stream, a); }
#endif
}
```

```cpp
#define MK_ONE_LAUNCH 1
#include <hip/hip_runtime.h>
#include <cstdio>
#include <cstdint>

#define GAS __attribute__((address_space(1)))
#define LAS __attribute__((address_space(3)))
typedef unsigned short bf16;
typedef unsigned v4u __attribute__((ext_vector_type(4)));
typedef unsigned v2u __attribute__((ext_vector_type(2)));
typedef float f32x4 __attribute__((ext_vector_type(4)));
typedef float f32x2 __attribute__((ext_vector_type(2)));
typedef short bf16x8 __attribute__((ext_vector_type(8)));
#define LDS_WAIT() asm volatile("s_waitcnt lgkmcnt(0)" ::: "memory")
#define VM_WAIT() asm volatile("s_waitcnt vmcnt(0)" ::: "memory")

constexpr int DM = 1024, NB = 8, SEQ = 4096, DEPTH = 4, CTXL = 256, GW = 256, HD = 64, NH = 4;
constexpr int T_LAT = NB * SEQ, T_CTX = NB * CTXL, T_ALL = T_LAT + T_CTX;
constexpr int IN_COLS = 3552, PLD = 3584;
constexpr int OFF_B = 512, OFF_C = 1472, OFF_D = 2512, B_COLS = 960;
constexpr int DFF = 2816, NE = 8, DFE = 1408;
constexpr int NCH = 68;
constexpr int NSTEP = 4352;
constexpr int MOE_MAXBLK = 280;
constexpr int NWAVES = 8, NTHR = 512;
#ifndef RW_VSPLIT
#define RW_VSPLIT 0
#endif

constexpr size_t MiB = 1u << 20;
constexpr size_t WS_CTL = 0, CTL_BYTES = 1 * MiB;
constexpr size_t WS_MODV = 1 * MiB;
constexpr size_t WS_XC = 2 * MiB;
constexpr size_t WS_WIN = 10 * MiB;
constexpr size_t WS_WOUT = 17 * MiB;
constexpr size_t WS_WGU = 19 * MiB;
constexpr size_t WS_WDN = 63 * MiB;
constexpr size_t WS_HB = 85 * MiB;
constexpr size_t WS_P = 153 * MiB;
constexpr size_t WS_MIX = 391 * MiB;
constexpr size_t WS_OUTB = WS_MIX, WS_OUTC = WS_MIX + 34 * MiB, WS_OUTD = WS_MIX + 68 * MiB, WS_GQ = WS_MIX + 102 * MiB, WS_G = WS_MIX + 153 * MiB;
constexpr size_t WS_XLAST = WS_MIX + 144 * MiB;
constexpr size_t WS_RKV = WS_MIX + 170 * MiB;
constexpr size_t WS_SMALL = 612 * MiB;
constexpr size_t WS_ROUTE = WS_SMALL;
constexpr size_t WS_POS = WS_SMALL + 1280 * 1024;
constexpr size_t WS_TOK = WS_SMALL + 1664 * 1024;
constexpr size_t WS_BONUS = WS_SMALL + 2 * MiB;
constexpr size_t WS_RINV = WS_SMALL + 2 * MiB + 640 * 1024;
constexpr size_t WS_WGBASE = WS_SMALL + 3 * MiB + 256 * 1024;
constexpr size_t WS_TAB = WS_WGBASE + 65536;
constexpr size_t WS_LRUWT = WS_SMALL + 3 * MiB + 512 * 1024;
constexpr size_t WS_RWT = WS_LRUWT + 131072;
constexpr size_t WS_LRUH = WS_SMALL + 4 * MiB;
constexpr size_t WS_END = 633 * MiB;
constexpr int CW_MOECNT = 1024;
constexpr int CW_PREPQ = 2048;
constexpr int CW_BAR = 4096;

constexpr int LDS_BYTES = 135168;
constexpr int MISC_OFF = 131072;

__device__ __forceinline__ unsigned f2bf(float f) { unsigned u = __builtin_bit_cast(unsigned, f); return (u + 0x7fffu + ((u >> 16) & 1u)) >> 16; }
typedef __bf16 bf16n2 __attribute__((ext_vector_type(2)));
__device__ __forceinline__ unsigned pk2(float lo, float hi) { const f32x2 v = {lo, hi}; return __builtin_bit_cast(unsigned, __builtin_convertvector(v, bf16n2)); }
__device__ __forceinline__ unsigned f2bf1(float f) { return pk2(f, f) & 0xffffu; }
__device__ __forceinline__ float bf2f(unsigned short v) { return __builtin_bit_cast(float, (unsigned)v << 16); }
__device__ __forceinline__ float bflo(unsigned v) { return __builtin_bit_cast(float, v << 16); }
__device__ __forceinline__ float bfhi(unsigned v) { return __builtin_bit_cast(float, v & 0xffff0000u); }
template <int CTRL, int RM, bool BC> __device__ __forceinline__ float dpp_x(float oldv, float v) { return __builtin_bit_cast(float, __builtin_amdgcn_update_dpp(__builtin_bit_cast(int, oldv), __builtin_bit_cast(int, v), CTRL, RM, 0xF, BC)); }
__device__ __forceinline__ float wave_sum(float v) {
    v += dpp_x<0xB1, 0xF, true>(0.f, v); v += dpp_x<0x4E, 0xF, true>(0.f, v); v += dpp_x<0x141, 0xF, true>(0.f, v); v += dpp_x<0x140, 0xF, true>(0.f, v);
    v += dpp_x<0x142, 0xA, false>(0.f, v); v += dpp_x<0x143, 0xC, false>(0.f, v);
    return __builtin_bit_cast(float, __builtin_amdgcn_readlane(__builtin_bit_cast(int, v), 63));
}
template <int CTRL> __device__ __forceinline__ float dpp_f(float v) { return __builtin_bit_cast(float, __builtin_amdgcn_update_dpp(0, __builtin_bit_cast(int, v), CTRL, 0xF, 0xF, true)); }
__device__ __forceinline__ float row16_sum(float v) {
    v += dpp_f<0xB1>(v);
    v += dpp_f<0x4E>(v);
    v += dpp_f<0x141>(v);
    v += dpp_f<0x140>(v);
    return v;
}
__device__ __forceinline__ float sigmoidf_(float x) { return __builtin_amdgcn_rcpf(1.0f + __expf(-x)); }
__device__ __forceinline__ float softplusf_(float x) { return fmaxf(x, 0.f) + __logf(1.0f + __expf(-fabsf(x))); }
__device__ __forceinline__ float expm1f_(float x) { return x > -0.3f ? x * (1.0f + x * (0.5f + x * (0.16666667f + x * (0.041666668f + x * 0.0083333338f)))) : __expf(x) - 1.0f; }
__device__ __forceinline__ float siluf_(float x) { return x * __builtin_amdgcn_rcpf(1.0f + __expf(-x)); }
__device__ __forceinline__ float tanhf_(float x) { const float e = __expf(2.0f * x); return 1.0f - 2.0f * __builtin_amdgcn_rcpf(e + 1.0f); }
__device__ __forceinline__ float rsqrtf_(float x) { return __builtin_amdgcn_rsqf(x); }
__device__ __forceinline__ float gelu_tanh(float x) { return 0.5f * x * (1.0f + tanhf_(0.7978845608028654f * (x + 0.044715f * x * x * x))); }
__device__ __forceinline__ f32x4 ld4bf(const bf16* p) { const v2u a = *(const v2u*)p; return (f32x4){bflo(a.x), bfhi(a.x), bflo(a.y), bfhi(a.y)}; }
__device__ __forceinline__ void st4bf(bf16* p, const f32x4& v) { v2u o; o.x = pk2(v.x, v.y); o.y = pk2(v.z, v.w); *(v2u*)p = o; }
#define XB_TMO      128
#define XB_XCNT(j)  (256  + 64 * (j))
#define XB_XSUB(j)  (1280 + 64 * (j))
#define XB_XGEN(j)  (2304 + 64 * (j))
#define XB_TOP      3328
#define XB_TOPGEN   3392
#define XCD_BAR_WORDS 3456
#define XB_SPIN_CAP (1u << 22)

__device__ __forceinline__ unsigned xb_ld(unsigned* p)              { return __hip_atomic_load(p, __ATOMIC_RELAXED, __HIP_MEMORY_SCOPE_AGENT); }
__device__ __forceinline__ unsigned xb_add(unsigned* p, unsigned v) { return __hip_atomic_fetch_add(p, v, __ATOMIC_RELAXED, __HIP_MEMORY_SCOPE_AGENT); }
__device__ __forceinline__ unsigned xb_xcc_id() { return (unsigned)__builtin_amdgcn_s_getreg((3 << 11) | 20) & 0xFu; }
#define XB_SPIN(cond, bar) do { unsigned _sp = 0; while (cond) { __builtin_amdgcn_s_sleep(1); \
    if ((++_sp & 255u) == 0u) { if (xb_ld(&(bar)[XB_TMO])) break; if (_sp > XB_SPIN_CAP) { atomicAdd(&(bar)[XB_TMO], 1u); break; } } } } while (0)

struct XcdBarrier {
    unsigned* bar; unsigned x;
    volatile LAS unsigned* st;
};

__device__ __forceinline__ XcdBarrier xcd_barrier_post(unsigned* bar, volatile LAS unsigned* st) {
    XcdBarrier b; b.bar = bar; b.x = xb_xcc_id(); b.st = st;
    if (threadIdx.x == 0) (void)xb_add(&bar[XB_XCNT(b.x)], 1u);
    return b;
}
__device__ __forceinline__ void xcd_barrier_complete(unsigned* bar, unsigned x, unsigned& nloc, unsigned& nx) {
    const unsigned G = gridDim.x * gridDim.y * gridDim.z;
    unsigned sum, cnt, mine, sp = 0u;
    for (;;) {
        sum = 0u; cnt = 0u; mine = 0u;
#pragma unroll
        for (unsigned j = 0; j < 16; ++j) { const unsigned c = xb_ld(&bar[XB_XCNT(j)]); sum += c; cnt += (c > 0u) ? 1u : 0u; mine = (j == x) ? c : mine; }
        if (sum == G) break;
        __builtin_amdgcn_s_sleep(1);
        if ((++sp & 255u) == 0u) { if (xb_ld(&bar[XB_TMO])) break; if (sp > XB_SPIN_CAP) { atomicAdd(&bar[XB_TMO], 1u); break; } }
    }
    nloc = mine > 0u ? mine : 1u; nx = cnt > 0u ? cnt : 1u;
}

__device__ __forceinline__ void xcd_barrier(const XcdBarrier& b) {
    asm volatile("s_waitcnt vmcnt(0)" ::: "memory");
    __syncthreads();
    if (threadIdx.x == 0) {
        unsigned* bar = b.bar;
        __builtin_amdgcn_s_waitcnt(0);
        unsigned nloc = b.st[0], nx = b.st[1];
        if (nloc == 0u) { xcd_barrier_complete(bar, b.x, nloc, nx); b.st[0] = nloc; b.st[1] = nx; }
        const unsigned old = xb_add(&bar[XB_XSUB(b.x)], 1u);
        const unsigned gen = old / nloc;
        if (old + 1u == (gen + 1u) * nloc) {
            __builtin_amdgcn_fence(__ATOMIC_RELEASE, "agent");
            asm volatile("s_waitcnt vmcnt(0)" ::: "memory");
            const unsigned og = xb_add(&bar[XB_TOP], 1u);
            const unsigned tg = og / nx;
            if (og + 1u == (tg + 1u) * nx) xb_add(&bar[XB_TOPGEN], 1u);
            else XB_SPIN(xb_ld(&bar[XB_TOPGEN]) == tg, bar);
            __builtin_amdgcn_fence(__ATOMIC_ACQUIRE, "agent");
            xb_add(&bar[XB_XGEN(b.x)], 1u);
            asm volatile("s_waitcnt vmcnt(0)" ::: "memory");
        } else {
            XB_SPIN(xb_ld(&bar[XB_XGEN(b.x)]) == gen, bar);
            __builtin_amdgcn_fence(__ATOMIC_ACQUIRE, "agent");
            asm volatile("s_waitcnt vmcnt(0)" ::: "memory");
        }
    }
    __syncthreads();
}

namespace pg8 {
#define PG8_LAS __attribute__((address_space(3)))
typedef unsigned short bf16_t;
typedef short bf16x8 __attribute__((ext_vector_type(8)));
typedef float f32x4 __attribute__((ext_vector_type(4)));
typedef unsigned u32x4 __attribute__((ext_vector_type(4)));
constexpr int BM = 256, BK = 64, HALF = 128, HTB = HALF * BK * 2  , STAGE_BYTES = 8 * HTB, NXCD = 8, WGM = 8;

__host__ __device__ __forceinline__ int lds_byte(int r, int c) { const int st = (r >> 4) * 2 + (c >> 5), rr = r & 15, cc = c & 31, ob = rr * 64 + cc * 2; return st * 1024 + (ob ^ (((ob >> 9) & 1) << 5)); }
__host__ __device__ __forceinline__ void stage_rc(int b, int& R, int& C) { const int st = b / 1024, sb = b % 1024, swz = sb ^ (((sb >> 9) & 1) << 5); R = (st >> 1) * 16 + swz / 64; C = (st & 1) * 32 + (swz % 64) / 2; }
__host__ __device__ __forceinline__ int perm32(int rho) { const int n = rho >> 4, i = rho & 15; return 8 * (i >> 2) + 4 * n + (i & 3); }

struct Unit { int pm, pn, e; };
struct Gemm { const bf16_t* A; const bf16_t* Bt; int M, N, K; size_t estride; };

struct StaticOrder {
    static constexpr bool GATHER = false;
    int nM, nN, nwg, G, c;
    __host__ __device__ void init(int M, int N, int G_, int c_) { nM = M / BM; nN = N / BM; nwg = nM * nN; G = G_; c = c_; }
    __host__ __device__ bool next(int i, Unit& u) const {
        const long L = (long)i * G + c; if (L >= nwg) return false;
        int wgid = (int)L; { const int q = nwg / NXCD, r = nwg % NXCD, xcd = wgid % NXCD, off = wgid / NXCD; wgid = (xcd < r ? xcd * (q + 1) : r * (q + 1) + (xcd - r) * q) + off; }
        const int nig = WGM * nN, gid = wgid / nig, fm = gid * WGM, gsz = (nM - fm) < WGM ? (nM - fm) : WGM;
        u.pm = fm + ((wgid % nig) % gsz); u.pn = (wgid % nig) / gsz; u.e = 0; return true;
    }
    __device__ __forceinline__ void a_ready(const Unit&) const {}
    __device__ __forceinline__ void done(const Unit&) const {}
};
typedef __bf16 bf16n2_ __attribute__((ext_vector_type(2)));
__device__ __forceinline__ unsigned cvt_pk_bf16(float lo, float hi) { typedef float f2_ __attribute__((ext_vector_type(2))); const f2_ v = {lo, hi}; return __builtin_bit_cast(unsigned, __builtin_convertvector(v, bf16n2_)); }
typedef float f32x2 __attribute__((ext_vector_type(2)));
__device__ __forceinline__ f32x2 gelu_pk(f32x2 v) {
    const f32x2 av = __builtin_elementwise_abs(v), d = av * 0.2316418882f + 1.0f;
    f32x2 t; t.x = __builtin_amdgcn_rcpf(d.x); t.y = __builtin_amdgcn_rcpf(d.y);
    f32x2 q = t * 0.5307027145f + (-0.7265760135f); q = q * t + 0.7107068705f; q = q * t + (-0.142248368f); q = q * t + 0.127414796f; q = q * t;
    const f32x2 s = (v * v) * (-0.72134752044f);
    f32x2 e; e.x = __builtin_amdgcn_exp2f(s.x); e.y = __builtin_amdgcn_exp2f(s.y);
    const f32x2 m = v * (q * e), r = v - m;
    f32x2 o; o.x = v.x < 0.f ? m.x : r.x; o.y = v.y < 0.f ? m.y : r.y; return o;
}

struct EpiF32 {
    static constexpr bool PERM = false, AFTER_DRAIN = false;
    float* C; int ldc; const float* bias;
    __device__ __forceinline__ void operator()(const f32x4 (&acc)[2][2][4][2], const Unit& u, int wr, int wc, int fr, int fq) const {
        const int row0 = u.pm * BM + wr * 64 + fr, col0 = u.pn * BM + wc * 32 + 4 * fq;
        f32x4 bv[2][2];
#pragma unroll
        for (int bj = 0; bj < 2; ++bj)
#pragma unroll
            for (int n = 0; n < 2; ++n) bv[bj][n] = bias ? *(const f32x4*)(bias + col0 + bj * HALF + n * 16) : (f32x4){0.f, 0.f, 0.f, 0.f};
#pragma unroll
        for (int ai = 0; ai < 2; ++ai)
#pragma unroll
            for (int m = 0; m < 4; ++m) { float* rowp = C + (size_t)(row0 + ai * HALF + m * 16) * ldc + col0;
#pragma unroll
                for (int bj = 0; bj < 2; ++bj)
#pragma unroll
                    for (int n = 0; n < 2; ++n) *(f32x4*)(rowp + bj * HALF + n * 16) = acc[ai][bj][m][n] + bv[bj][n]; }
    }
};
template <int ACT  > struct EpiBf16 {
    static constexpr bool PERM = true, AFTER_DRAIN = false;
    bf16_t* O; int ldc; const float* bias; int split_cols; size_t split_stride;
    __device__ __forceinline__ void operator()(const f32x4 (&acc)[2][2][4][2], const Unit& u, int wr, int wc, int fr, int fq) const {
        const int row0 = u.pm * BM + wr * 64 + fr; int colt = u.pn * BM; bf16_t* base = O;
        if (split_cols) { const int t = colt / split_cols; base += (size_t)t * split_stride; colt -= t * split_cols; }
        const int col0 = colt + wc * 32 + 8 * fq, bcol0 = u.pn * BM + wc * 32 + 8 * fq;
        f32x4 bv[2][2];
#pragma unroll
        for (int bj = 0; bj < 2; ++bj)
#pragma unroll
            for (int n = 0; n < 2; ++n) bv[bj][n] = bias ? *(const f32x4*)(bias + bcol0 + bj * HALF + 4 * n) : (f32x4){0.f, 0.f, 0.f, 0.f};
#pragma unroll
        for (int ai = 0; ai < 2; ++ai)
#pragma unroll
            for (int m = 0; m < 4; ++m) { bf16_t* rowp = base + (size_t)(row0 + ai * HALF + m * 16) * ldc + col0;
#pragma unroll
                for (int bj = 0; bj < 2; ++bj) { f32x4 v0 = acc[ai][bj][m][0] + bv[bj][0], v1 = acc[ai][bj][m][1] + bv[bj][1];
                    if (ACT == 1) { f32x2 a = gelu_pk((f32x2){v0[0], v0[1]}), b = gelu_pk((f32x2){v0[2], v0[3]}), c = gelu_pk((f32x2){v1[0], v1[1]}), d = gelu_pk((f32x2){v1[2], v1[3]});
                        v0 = (f32x4){a.x, a.y, b.x, b.y}; v1 = (f32x4){c.x, c.y, d.x, d.y}; }
                    if (ACT == 2) {
#pragma unroll
                        for (int j = 0; j < 4; ++j) { v0[j] = 0.5f * v0[j] * (1.0f + erff(v0[j] * 0.70710678f)); v1[j] = 0.5f * v1[j] * (1.0f + erff(v1[j] * 0.70710678f)); } }
                    u32x4 w; w.x = cvt_pk_bf16(v0[0], v0[1]); w.y = cvt_pk_bf16(v0[2], v0[3]); w.z = cvt_pk_bf16(v1[0], v1[1]); w.w = cvt_pk_bf16(v1[2], v1[3]);
                    *(u32x4*)(rowp + bj * HALF) = w; } }
    }
};

template <class Epi, class Sched, bool STAMP = false>
__device__ __forceinline__ void gemm_phase(PG8_LAS unsigned char* lds, const Gemm g, const Sched& S, const Epi& E, unsigned long long* stamps) {
    int tid_ = threadIdx.x; asm volatile("" : "+v"(tid_));
    const int tid = tid_, wid = __builtin_amdgcn_readfirstlane(tid >> 6), lane = tid & 63, wr = wid >> 2, wc = wid & 3, fr = lane & 15, fq = lane >> 4;
    const int K = g.K, nt = K / BK;
    constexpr bool GATHER = Sched::GATHER;
    int ts_lo = 0, ts_hi = 0, nts = 0; const unsigned long long rt_entry = STAMP ? (unsigned long long)wall_clock64() : 0ull;
#define PG8_STAMP() do { if (STAMP && wid == 0 && nts < 64) { const unsigned long long _c = (unsigned long long)clock64(); \
        ts_lo = (lane == nts) ? (int)(unsigned)_c : ts_lo; ts_hi = (lane == nts) ? (int)(unsigned)(_c >> 32) : ts_hi; ++nts; } } while (0)
    PG8_STAMP();
    unsigned voffA[2], voffB[2]; int rowA[2];
#pragma unroll
    for (int i = 0; i < 2; ++i) { int R, C; stage_rc(tid * 16 + i * 8192, R, C); const int Rb = Epi::PERM ? ((R & ~31) + perm32(R & 31)) : R;
        rowA[i] = R; voffA[i] = GATHER ? (unsigned)C * 2u : (unsigned)(R * K + C) * 2u; voffB[i] = (unsigned)(Rb * K + C) * 2u; }
    const size_t kstep = (size_t)(BK * 2);
    const size_t hstep = (size_t)HALF * K * 2;
    const size_t tstep = 2 * hstep;
    const unsigned ldsw = (unsigned)wid * 1024u;
    const int aoff = lds_byte(wr * 64 + fr, fq * 8), boff = lds_byte(wc * 32 + fr, fq * 8);
#define PG8_SA(b, h) (((b) * 2 + (h)) * HTB)
#define PG8_SB(b, h) ((4 + (b) * 2 + (h)) * HTB)
#define PG8_STAGE(bufoff, gbase, voff) do { _Pragma("unroll") for (int _i = 0; _i < 2; ++_i) \
        __builtin_amdgcn_global_load_lds((const unsigned*)((const char*)(gbase) + (voff)[_i]), (PG8_LAS unsigned*)(lds + (bufoff) + ldsw + _i * 8192), 16, 0, 0); } while (0)
#define PG8_STAGE_A(bufoff, gbase, h, gv) do { if constexpr (GATHER) { PG8_STAGE(bufoff, gbase, (gv)[h]); } else { PG8_STAGE(bufoff, (gbase) + (h) * hstep, voffA); } } while (0)
#define PG8_TOKSLOT(s) ((PG8_LAS int*)(lds + STAGE_BYTES + 1024 + ((s) & 1) * 1024))
#define PG8_LDA(dst, b, h) do { _Pragma("unroll") for (int m = 0; m < 4; ++m) _Pragma("unroll") for (int k = 0; k < 2; ++k) dst[m][k] = *(const PG8_LAS bf16x8*)(lds + PG8_SA(b, h) + aoff + m * 2048 + k * 1024); } while (0)
#define PG8_LDB(dst, b, h) do { _Pragma("unroll") for (int n = 0; n < 2; ++n) _Pragma("unroll") for (int k = 0; k < 2; ++k) dst[n][k] = *(const PG8_LAS bf16x8*)(lds + PG8_SB(b, h) + boff + n * 2048 + k * 1024); } while (0)
#define PG8_MMA(ai, bj, At, Bt) do { __builtin_amdgcn_s_setprio(1); _Pragma("unroll") for (int m = 0; m < 4; ++m) _Pragma("unroll") for (int n = 0; n < 2; ++n) _Pragma("unroll") for (int k = 0; k < 2; ++k) \
        acc[ai][bj][m][n] = __builtin_amdgcn_mfma_f32_16x16x32_bf16(Bt[n][k], At[m][k], acc[ai][bj][m][n], 0, 0, 0); __builtin_amdgcn_s_setprio(0); } while (0)
#define PG8_WAIT_V(n) asm volatile("s_waitcnt vmcnt(" #n ")" ::: "memory")
#define PG8_WAIT_L(n) asm volatile("s_waitcnt lgkmcnt(" #n ")" ::: "memory")
#define PG8_BAR __builtin_amdgcn_s_barrier()
#define PG8_SCHED __builtin_amdgcn_sched_barrier(0)
    Unit cur, nxt; int ui = 0;
    if (!S.next(0, cur)) return;
    f32x4 acc[2][2][4][2];
#pragma unroll
    for (int a = 0; a < 2; ++a)
#pragma unroll
        for (int b = 0; b < 2; ++b)
#pragma unroll
            for (int m = 0; m < 4; ++m)
#pragma unroll
                for (int n = 0; n < 2; ++n) acc[a][b][m][n] = (f32x4){0.f, 0.f, 0.f, 0.f};
    bf16x8 At[4][2], B0[2][2], B1[2][2];
    const char* cA = (const char*)g.A + (GATHER ? (size_t)0 : (size_t)cur.pm * tstep); const char* cB = (const char*)g.Bt + (size_t)cur.pn * tstep + (size_t)cur.e * g.estride * 2;
    S.a_ready(cur);
    unsigned gcur[2][2], gnxt[2][2], gs[2][2];
    if constexpr (GATHER) {
        if (tid < 256) PG8_TOKSLOT(0)[tid] = S.tok[cur.pm * 256 + tid];
        __syncthreads();
#pragma unroll
        for (int h = 0; h < 2; ++h)
#pragma unroll
            for (int i = 0; i < 2; ++i) { gcur[h][i] = (unsigned)PG8_TOKSLOT(0)[h * HALF + rowA[i]] * (unsigned)(K * 2) + voffA[i]; gnxt[h][i] = gcur[h][i]; gs[h][i] = gcur[h][i]; }
    }
    PG8_STAGE(PG8_SB(0, 0), cB, voffB); PG8_STAGE_A(PG8_SA(0, 0), cA, 0, gcur); PG8_STAGE(PG8_SB(0, 1), cB + hstep, voffB); PG8_STAGE_A(PG8_SA(0, 1), cA, 1, gcur);
    if (wr == 1) PG8_BAR;
    PG8_WAIT_V(4); PG8_BAR;
    PG8_STAGE(PG8_SB(1, 0), cB + kstep, voffB); PG8_STAGE_A(PG8_SA(1, 0), cA + kstep, 0, gcur); PG8_STAGE(PG8_SB(1, 1), cB + hstep + kstep, voffB);
    PG8_WAIT_V(6); PG8_BAR;
    PG8_STAMP();
    for (;;) {
        const bool has_next = S.next(ui + 1, nxt);
        if constexpr (GATHER) { if (has_next && wid < 4)
            __builtin_amdgcn_global_load_lds((const unsigned*)(S.tok + nxt.pm * 256 + wid * 64 + lane), (PG8_LAS unsigned*)((PG8_LAS unsigned char*)PG8_TOKSLOT(ui + 1) + wid * 256), 4, 0, 0); }
        const char* nA = GATHER ? (const char*)g.A : has_next ? (const char*)g.A + (size_t)nxt.pm * tstep : cA; const char* nB = has_next ? (const char*)g.Bt + (size_t)nxt.pn * tstep + (size_t)nxt.e * g.estride * 2 : cB;
        for (int t = 0; t < nt; t += 2) {
            const bool last = (t == nt - 2);
            const char* a1 = cA + (size_t)(t + 1) * kstep;
            const char* a2 = last ? nA : cA + (size_t)(t + 2) * kstep; const char* b2 = last ? nB : cB + (size_t)(t + 2) * kstep;
            const char* a3 = a2 + kstep; const char* b3 = b2 + kstep;
            if (last && has_next) S.a_ready(nxt);
            if constexpr (GATHER) {
                if (last && has_next) {
#pragma unroll
                    for (int h = 0; h < 2; ++h)
#pragma unroll
                        for (int i = 0; i < 2; ++i) gnxt[h][i] = (unsigned)PG8_TOKSLOT(ui + 1)[h * HALF + rowA[i]] * (unsigned)(K * 2) + voffA[i];
                }
#pragma unroll
                for (int h = 0; h < 2; ++h)
#pragma unroll
                    for (int i = 0; i < 2; ++i) gs[h][i] = last ? gnxt[h][i] : gcur[h][i];
            }
            PG8_LDB(B0, 0, 0); PG8_SCHED; PG8_LDA(At, 0, 0); PG8_STAGE_A(PG8_SA(1, 1), a1, 1, gcur);
            PG8_WAIT_L(8); PG8_BAR; PG8_WAIT_L(0); PG8_MMA(0, 0, At, B0); PG8_BAR; PG8_SCHED;
            PG8_LDB(B1, 0, 1); PG8_STAGE(PG8_SB(0, 0), b2, voffB);
            PG8_BAR; PG8_WAIT_L(0); PG8_MMA(0, 1, At, B1); PG8_BAR;
            PG8_LDA(At, 0, 1); PG8_STAGE_A(PG8_SA(0, 0), a2, 0, gs);
            PG8_BAR; PG8_WAIT_L(0); PG8_MMA(1, 0, At, B0); PG8_BAR; PG8_SCHED;
            PG8_STAGE(PG8_SB(0, 1), b2 + hstep, voffB);
            PG8_WAIT_V(6); PG8_BAR; PG8_MMA(1, 1, At, B1); PG8_BAR;
            PG8_LDB(B0, 1, 0); PG8_SCHED; PG8_LDA(At, 1, 0); PG8_STAGE_A(PG8_SA(0, 1), a2, 1, gs);
            PG8_WAIT_L(8); PG8_BAR; PG8_WAIT_L(0); PG8_MMA(0, 0, At, B0); PG8_BAR; PG8_SCHED;
            PG8_LDB(B1, 1, 1); PG8_STAGE(PG8_SB(1, 0), b3, voffB);
            PG8_BAR; PG8_WAIT_L(0); PG8_MMA(0, 1, At, B1); PG8_BAR;
            PG8_LDA(At, 1, 1); PG8_STAGE_A(PG8_SA(1, 0), a3, 0, gs);
            PG8_BAR; PG8_WAIT_L(0); PG8_MMA(1, 0, At, B0); PG8_BAR; PG8_SCHED;
            PG8_STAGE(PG8_SB(1, 1), b3 + hstep, voffB);
            PG8_WAIT_V(6); PG8_BAR; PG8_MMA(1, 1, At, B1); PG8_BAR;
        }
        PG8_STAMP();
        if constexpr (!Epi::AFTER_DRAIN) { E(acc, cur, wr, wc, fr, fq); S.done(cur); }
        PG8_STAMP();
        if (!has_next) break;
#pragma unroll
        for (int a = 0; a < 2; ++a)
#pragma unroll
            for (int b = 0; b < 2; ++b)
#pragma unroll
                for (int m = 0; m < 4; ++m)
#pragma unroll
                    for (int n = 0; n < 2; ++n) acc[a][b][m][n] = (f32x4){0.f, 0.f, 0.f, 0.f};
        cur = nxt; cA = nA; cB = nB; ++ui;
        if constexpr (GATHER) {
#pragma unroll
            for (int h = 0; h < 2; ++h)
#pragma unroll
                for (int i = 0; i < 2; ++i) gcur[h][i] = gnxt[h][i];
        }
    }
    PG8_WAIT_V(0);
    if (wr == 0) PG8_BAR;
    PG8_BAR;
    if constexpr (Epi::AFTER_DRAIN) { E.fused(acc, cur, wr, wc, fr, fq, lds, wid, lane); S.done(cur); }
    PG8_STAMP();
    if (STAMP && wid == 0) { stamps[lane] = lane < nts ? (((unsigned long long)(unsigned)ts_hi << 32) | (unsigned)ts_lo) : 0ull;
        if (lane == 62) stamps[62] = rt_entry; if (lane == 63) stamps[63] = (unsigned long long)wall_clock64(); }
#undef PG8_STAMP
#undef PG8_SA
#undef PG8_SB
#undef PG8_STAGE
#undef PG8_STAGE_A
#undef PG8_TOKSLOT
#undef PG8_LDA
#undef PG8_LDB
#undef PG8_MMA
#undef PG8_WAIT_V
#undef PG8_WAIT_L
#undef PG8_BAR
#undef PG8_SCHED
}
}
namespace pg8 {
struct EpiRes {
    static constexpr bool PERM = true, AFTER_DRAIN = false;
    const void* base_lat; const float* base_ctx; void* out_lat; float* out_ctx; const float* gvec; bool base_bf, out_bf;
    __device__ __forceinline__ void operator()(const f32x4 (&acc)[2][2][4][2], const Unit& u, int wr, int wc, int fr, int fq) const {
        const bool isctx = u.pm >= 128;
        const int prow = (isctx ? (u.pm - 128) : u.pm) * BM;
        const float* base = isctx ? base_ctx : (const float*)base_lat; float* out = isctx ? out_ctx : (float*)out_lat;
        const bool bbf = !isctx && base_bf, obf = !isctx && out_bf;
        const float* gv = gvec + (size_t)(isctx ? 8 : (u.pm >> 4)) * 6144;
        const int row0 = prow + wr * 64 + fr, col0 = u.pn * BM + wc * 32 + 8 * fq;
        f32x4 gvv[2][2];
#pragma unroll
        for (int bj = 0; bj < 2; ++bj)
#pragma unroll
            for (int n = 0; n < 2; ++n) gvv[bj][n] = *(const f32x4*)(gv + col0 + bj * HALF + 4 * n);
#pragma unroll
        for (int ai = 0; ai < 2; ++ai)
#pragma unroll
            for (int m = 0; m < 4; ++m) { const size_t off = (size_t)(row0 + ai * HALF + m * 16) * 1024 + col0;
#pragma unroll
                for (int bj = 0; bj < 2; ++bj) { const size_t o2 = off + bj * HALF;
                    f32x4 b0, b1;
                    if (bbf) { const v4u r = *(const v4u*)((const bf16*)base_lat + o2); b0 = (f32x4){bflo(r.x), bfhi(r.x), bflo(r.y), bfhi(r.y)}; b1 = (f32x4){bflo(r.z), bfhi(r.z), bflo(r.w), bfhi(r.w)}; }
                    else { b0 = *(const f32x4*)(base + o2); b1 = *(const f32x4*)(base + o2 + 4); }
                    const f32x4 v0 = b0 + gvv[bj][0] * acc[ai][bj][m][0], v1 = b1 + gvv[bj][1] * acc[ai][bj][m][1];
                    if (obf) { v4u w; w.x = pk2(v0.x, v0.y); w.y = pk2(v0.z, v0.w); w.z = pk2(v1.x, v1.y); w.w = pk2(v1.z, v1.w); *(v4u*)((bf16*)out_lat + o2) = w; }
                    else { *(f32x4*)(out + o2) = v0; *(f32x4*)(out + o2 + 4) = v1; } } }
    }
};
struct EpiSwiglu {
    static constexpr bool PERM = true, AFTER_DRAIN = false;
    bf16_t* O; int ldc;
    __device__ __forceinline__ void operator()(const f32x4 (&acc)[2][2][4][2], const Unit& u, int wr, int wc, int fr, int fq) const {
        const int row0 = u.pm * BM + wr * 64 + fr, col0 = u.pn * HALF + wc * 32 + 8 * fq;
#pragma unroll
        for (int ai = 0; ai < 2; ++ai)
#pragma unroll
            for (int m = 0; m < 4; ++m) { bf16_t* rowp = O + (size_t)(row0 + ai * HALF + m * 16) * ldc + col0;
                float h[8];
#pragma unroll
                for (int n = 0; n < 2; ++n)
#pragma unroll
                    for (int j = 0; j < 4; ++j) { const float g = acc[ai][0][m][n][j], up = acc[ai][1][m][n][j]; h[n * 4 + j] = g * __builtin_amdgcn_rcpf(1.0f + __expf(-g)) * up; }
                u32x4 w; w.x = cvt_pk_bf16(h[0], h[1]); w.y = cvt_pk_bf16(h[2], h[3]); w.z = cvt_pk_bf16(h[4], h[5]); w.w = cvt_pk_bf16(h[6], h[7]);
                *(u32x4*)rowp = w; }
    }
};
struct MoeOrder {
    static constexpr bool GATHER = false;
    int nN, G, c, nunits; const int* tab;
    __device__ void init(const int* tab_, int nN_, int G_, int c_) { tab = tab_; nN = nN_; G = G_; c = c_; nunits = tab_[0] * nN_; }
    __device__ bool next(int i, Unit& u) const {
        const int L = i * G + c; if (L >= nunits) return false;
        const int q = nunits / NXCD, r = nunits % NXCD, xcd = L % NXCD, off = L / NXCD;
        const int w = (xcd < r ? xcd * (q + 1) : r * (q + 1) + (xcd - r) * q) + off;
        u.pm = w / nN; u.pn = w - u.pm * nN; u.e = tab[1 + u.pm]; return true;
    }
    __device__ __forceinline__ void a_ready(const Unit&) const {}
    __device__ __forceinline__ void done(const Unit&) const {}
};
struct MoeOrderG : MoeOrder { static constexpr bool GATHER = true; const int* tok; };
}
enum { I_X = 0, I_C, I_CTX, I_CCTX, I_MODW, I_MODB, I_NMIXG, I_NFFNG, I_WIN, I_WOUT, I_LCW, I_LCB, I_LWA, I_LBA, I_LWX, I_LBX, I_LLAM,
       I_RMU, I_RWUP, I_RW0, I_RAUP, I_RA0, I_RGUP, I_RKK, I_RKA, I_RRK, I_RLNG, I_RLNB, I_MIB, I_MFB, I_MNG, I_GCW, I_GALOG, I_GDTB, I_GNG,
       I_FWG, I_FWU, I_FWD, I_MROUTER, I_MWG, I_MWU, I_MWD, I_FNG, N_IN };
struct Args { const float* in[N_IN]; float* out; unsigned char* ws; int ph_lo, ph_hi; };
struct Ctx {
    const float* const* in; float* out; unsigned char* ws; LAS unsigned char* lds;
    int tid, lane, wave, G, wg;
};
#define WSP(T, off) ((T*)(C.ws + (off)))

__device__ __forceinline__ int seqrow_raster(int i, int d, int b) {
    if (i < CTXL) { const int p = d ? (CTXL - 1 - i) : i; return T_LAT + b * CTXL + p; }
    const int j = i - CTXL; const int p = d ? (SEQ - 1 - j) : j; return b * SEQ + p;
}
__device__ __forceinline__ int seqrow_cm(int i, int d, int b) {
    if (i < CTXL) { const int p = d ? (CTXL - 1 - i) : i; return T_LAT + b * CTXL + p; }
    const int j = i - CTXL; const int p = d ? (SEQ - 1 - j) : j; return b * SEQ + (p & 63) * 64 + (p >> 6);
}

__device__ __forceinline__ void phase_pre(const Ctx& C) {
    LAS float* sc = (LAS float*)C.lds;
    LAS float* red = sc + 9 * 1024;
    float* modv = WSP(float, WS_MODV);
    bool filled = false;
    for (int it = C.wg; it < DEPTH * 48; it += C.G) {
        if (!filled) {
            for (int i = C.tid; i < 9 * 1024; i += NTHR) { const float v = i < 8192 ? C.in[I_C][i] : C.in[I_CCTX][i - 8192]; sc[i] = siluf_(v); }
            filled = true; __syncthreads();
        }
        const int l = it / 48, jb = it % 48, col = C.tid & 127, kg = C.tid >> 7;
        const float* W = C.in[I_MODW] + (size_t)l * 1024 * 6144 + jb * 128 + col;
        float acc[9];
#pragma unroll
        for (int r = 0; r < 9; ++r) acc[r] = 0.f;
        for (int k = kg * 256; k < kg * 256 + 256; ++k) { const float w = W[(size_t)k * 6144];
#pragma unroll
            for (int r = 0; r < 9; ++r) acc[r] += sc[r * 1024 + k] * w; }
#pragma unroll
        for (int r = 0; r < 9; ++r) red[(kg * 9 + r) * 128 + col] = acc[r];
        __syncthreads();
        for (int i = C.tid; i < 9 * 128; i += NTHR) { const int r = i >> 7, cc = i & 127;
            const float s = red[(0 * 9 + r) * 128 + cc] + red[(1 * 9 + r) * 128 + cc] + red[(2 * 9 + r) * 128 + cc] + red[(3 * 9 + r) * 128 + cc];
            modv[((size_t)l * 9 + r) * 6144 + jb * 128 + cc] = s + C.in[I_MODB][l * 6144 + jb * 128 + cc]; }
        __syncthreads();
    }
}

__device__ __forceinline__ void tr_item(const float* src, size_t ld, int k0, int ns0, bf16* dst, int drow0, int Kd, LAS float* scr, int lane, bool zero) {
    if (!zero) {
#pragma unroll 8
        for (int i = 0; i < 32; ++i) { const int kk = 2 * i + (lane >> 5); scr[kk * 33 + (lane & 31)] = src[(size_t)(k0 + kk) * ld + ns0 + (lane & 31)]; }
    }
    LDS_WAIT(); asm volatile("" ::: "memory");
    const int c = lane & 7;
#pragma unroll
    for (int j = 0; j < 4; ++j) { const int n = (lane >> 3) + 8 * j; const LAS float* s = scr + (8 * c) * 33 + n;
        v4u o; o.x = pk2(s[0 * 33], s[1 * 33]); o.y = pk2(s[2 * 33], s[3 * 33]); o.z = pk2(s[4 * 33], s[5 * 33]); o.w = pk2(s[6 * 33], s[7 * 33]);
        if (zero) o = (v4u){0u, 0u, 0u, 0u};
        *(v4u*)(dst + (size_t)(drow0 + n) * Kd + k0 + 8 * c) = o; }
    LDS_WAIT(); asm volatile("" ::: "memory");
}
__device__ __forceinline__ void convert_small(const Ctx& C, int l) {
    {
        bf16* lw = WSP(bf16, WS_LRUWT);
        for (int k = 0; k < 2 * 2 * 4 * 4096 / (128 * NTHR); ++k) {
            const int e = k * 128 * NTHR + C.wg * NTHR + C.tid;
            if (C.wg < 128) {
            const int i = e & 63, j = (e >> 6) & 63, hd = (e >> 12) & 3, g = (e >> 14) & 1, d = e >> 15;
            const float* src = (g ? C.in[I_LWX] : C.in[I_LWA]) + ((size_t)((l * 2 + d) * 4 + hd) * 64 + i) * 64 + j;
            lw[e] = (bf16)f2bf(*src);
            }
        }
    }
    if (C.wg >= 128 && C.wg < 224) {
        bf16* rw = WSP(bf16, WS_RWT);
        const int e = (C.wg - 128) * NTHR + C.tid;
        if (e < 32768) { const int r = e & 31, ch = (e >> 5) & 255, d = (e >> 13) & 1, isa = e >> 14;
            rw[e] = (bf16)f2bf((isa ? C.in[I_RAUP] : C.in[I_RWUP])[((size_t)(l * 2 + d) * 32 + r) * GW + ch]); }
        else { const int e2 = e - 32768, j = e2 & 63, ch = e2 >> 6; rw[e] = (bf16)f2bf(C.in[I_RGUP][((size_t)l * 64 + j) * GW + ch]); }
    }
}
__device__ __forceinline__ void convert_items(const Ctx& C, int l, int what, int gw, int NGW) {
    LAS float* scr = (LAS float*)(C.lds + C.wave * 8704);
    constexpr int I_IN = 16 * 112, I_OUT = 16 * 32, I_GU = 16 * 176, I_DN = 44 * 32, I_E = 16 * 88 + 22 * 32;
    const bool moe = l & 1; const int li = l >> 1;
    const int lo_it = (what & 1) ? 0 : I_IN, hi_it = (what & 2) ? I_IN + I_OUT + (moe ? NE * I_E : (I_GU + I_DN)) : I_IN;
    bf16* win = WSP(bf16, WS_WIN); bf16* wout = WSP(bf16, WS_WOUT); bf16* wgu = WSP(bf16, WS_WGU); bf16* wdn = WSP(bf16, WS_WDN);
    for (int it = lo_it + gw; it < hi_it; it += NGW) {
        int r = it;
        if (r < I_IN) { const int kb = r / 112, nb = r % 112; tr_item(C.in[I_WIN] + (size_t)l * 1024 * IN_COLS, IN_COLS, 64 * kb, 32 * nb, win, 32 * nb, 1024, scr, C.lane, nb == 111); continue; }
        r -= I_IN;
        if (r < I_OUT) { const int kb = r / 32, nb = r % 32; tr_item(C.in[I_WOUT] + (size_t)l * 1024 * 1024, 1024, 64 * kb, 32 * nb, wout, 32 * nb, 1024, scr, C.lane, false); continue; }
        r -= I_OUT;
        if (!moe) {
            if (r < I_GU) { const int kb = r / 176, nb = r % 176, tile = nb >> 3, q = nb & 7;
                const float* src = (q < 4 ? C.in[I_FWG] : C.in[I_FWU]) + (size_t)li * 1024 * DFF;
                tr_item(src, DFF, 64 * kb, tile * 128 + (q & 3) * 32, wgu, 32 * nb, 1024, scr, C.lane, false); continue; }
            r -= I_GU;
            { const int kb = r / 32, nb = r % 32; tr_item(C.in[I_FWD] + (size_t)li * DFF * 1024, 1024, 64 * kb, 32 * nb, wdn, 32 * nb, DFF, scr, C.lane, false); }
        } else {
            const int e = r / I_E; int rr = r % I_E;
            if (rr < 16 * 88) { const int kb = rr / 88, nb = rr % 88, tile = nb >> 3, q = nb & 7;
                const float* src = (q < 4 ? C.in[I_MWG] : C.in[I_MWU]) + ((size_t)li * NE + e) * 1024 * DFE;
                tr_item(src, DFE, 64 * kb, tile * 128 + (q & 3) * 32, wgu + (size_t)e * 2 * DFE * 1024, 32 * nb, 1024, scr, C.lane, false); continue; }
            rr -= 16 * 88;
            { const int kb = rr / 32, nb = rr % 32; tr_item(C.in[I_MWD] + ((size_t)li * NE + e) * DFE * 1024, 1024, 64 * kb, 32 * nb, wdn + (size_t)e * 1024 * DFE, 32 * nb, DFE, scr, C.lane, false); }
        }
    }
}

template <bool ROUTE>
__device__ __forceinline__ void norm_rows(const Ctx& C, int l, const void* xlat, bool xbf, const float* xctx, const float* gain, int shoff, int scoff, int nrows, int moe_li) {
    const float* modv = WSP(float, WS_MODV) + (size_t)l * 9 * 6144;
    bf16* hb = WSP(bf16, WS_HB);
    const int gw = C.wg * NWAVES + C.wave, NGW = C.G * NWAVES;
    LAS unsigned* lcnt = (LAS unsigned*)(C.lds + 65536);
    unsigned* route = WSP(unsigned, WS_ROUTE);
    if (ROUTE) { if (C.tid < 8) lcnt[C.tid] = 0u; __syncthreads(); }
    f32x4 gv[4];
#pragma unroll
    for (int j = 0; j < 4; ++j) gv[j] = *(const f32x4*)(gain + 4 * C.lane + 256 * j);
    for (int m = gw; m < nrows; m += NGW) {
        const bool isctx = m >= T_LAT;
        const float* xr = isctx ? xctx + (size_t)(m - T_LAT) * 1024 : (const float*)xlat + (size_t)m * 1024; const bf16* xrb = (const bf16*)xlat + (size_t)m * 1024; const bool rbf = xbf && !isctx;
        const float* mv = modv + (size_t)(isctx ? 8 : (m >> 12)) * 6144;
        f32x4 v[4]; float s = 0.f;
#pragma unroll
        for (int j = 0; j < 4; ++j) { v[j] = rbf ? ld4bf(xrb + 4 * C.lane + 256 * j) : *(const f32x4*)(xr + 4 * C.lane + 256 * j); s += (v[j].x * v[j].x + v[j].y * v[j].y) + (v[j].z * v[j].z + v[j].w * v[j].w); }
        const float rs = rsqrtf_(wave_sum(s) * (1.0f / 1024.0f) + 1e-6f);
#pragma unroll
        for (int j = 0; j < 4; ++j) { const f32x4 sh = *(const f32x4*)(mv + shoff + 4 * C.lane + 256 * j), scl = *(const f32x4*)(mv + scoff + 4 * C.lane + 256 * j);
            v[j] = (v[j] * rs * gv[j]) * (scl + 1.0f) + sh;
            v2u o; o.x = pk2(v[j].x, v[j].y); o.y = pk2(v[j].z, v[j].w);
            *(v2u*)(hb + (size_t)m * 1024 + 4 * C.lane + 256 * j) = o; }
        if (ROUTE) {
            const float* rt = C.in[I_MROUTER] + (size_t)moe_li * 1024 * NE;
            float lg[8];
#pragma unroll
            for (int e = 0; e < 8; ++e) lg[e] = 0.f;
#pragma unroll
            for (int j = 0; j < 4; ++j)
#pragma unroll
                for (int q = 0; q < 4; ++q) { const int k = 4 * C.lane + 256 * j + q; const f32x4 r0 = *(const f32x4*)(rt + (size_t)k * 8), r1 = *(const f32x4*)(rt + (size_t)k * 8 + 4); const float hv = v[j][q];
                    lg[0] += hv * r0.x; lg[1] += hv * r0.y; lg[2] += hv * r0.z; lg[3] += hv * r0.w; lg[4] += hv * r1.x; lg[5] += hv * r1.y; lg[6] += hv * r1.z; lg[7] += hv * r1.w; }
#pragma unroll
            for (int e = 0; e < 8; ++e) lg[e] = wave_sum(lg[e]);
            int e0 = 0; float l0 = lg[0];
#pragma unroll
            for (int e = 1; e < 8; ++e) if (lg[e] > l0) { l0 = lg[e]; e0 = e; }
            int e1 = (e0 == 0) ? 1 : 0; float l1 = -3.0e38f;
#pragma unroll
            for (int e = 0; e < 8; ++e) if (e != e0 && lg[e] > l1) { l1 = lg[e]; e1 = e; }
            const float w0 = __builtin_amdgcn_rcpf(1.0f + __expf(l1 - l0)), w1 = 1.0f - w0;
            if (C.lane == 0) {
                const unsigned r0 = atomicAdd((unsigned*)&lcnt[e0], 1u), r1 = atomicAdd((unsigned*)&lcnt[e1], 1u);
                v4u a; a.x = (unsigned)e0; a.y = (unsigned)e1; a.z = r0; a.w = r1;
                *(v4u*)(route + (size_t)m * 8) = a;
                v2u b; b.x = __builtin_bit_cast(unsigned, w0); b.y = __builtin_bit_cast(unsigned, w1);
                *(v2u*)(route + (size_t)m * 8 + 4) = b;
            }
        }
    }
    if (ROUTE) {
        __syncthreads();
        if (C.tid < 8) { unsigned* gc = WSP(unsigned, WS_CTL) + CW_MOECNT + 64 * moe_li; const unsigned base = atomicAdd(gc + C.tid, lcnt[C.tid]); WSP(unsigned, WS_WGBASE)[C.wg * 8 + C.tid] = base; }
    }
}
#define RAW_BARRIER() do { asm volatile("s_waitcnt lgkmcnt(0)" ::: "memory"); __builtin_amdgcn_s_barrier(); asm volatile("" ::: "memory"); } while (0)
__device__ __forceinline__ void gdn_prep(const Ctx& C, int l, int b, int c) {
    const bf16* P = WSP(const bf16, WS_P); bf16* gq = WSP(bf16, WS_GQ);
    const bool isctx = c < 4; const int p0 = isctx ? c * 64 : (c - 4) * 64; const int Lp = isctx ? CTXL : SEQ;
    const int ch = 4 * C.lane;
    auto rowof = [&](int p) -> int { return isctx ? (T_LAT + b * CTXL + p) : (b * SEQ + (p & 63) * 64 + (p >> 6)); };
    f32x4 cw[4][3], x[4][3];
#pragma unroll
    for (int j = 0; j < 4; ++j)
#pragma unroll
        for (int g = 0; g < 3; ++g) cw[j][g] = *(const f32x4*)(C.in[I_GCW] + ((size_t)l * 4 + j) * 768 + g * 256 + ch);
    const int tb = p0 + C.wave * 8;
    auto ldrow = [&](int p, f32x4 (&dst)[3]) {
        if (p >= 0 && p < Lp) { const bf16* pr = P + (size_t)rowof(p) * PLD + OFF_D + ch;
#pragma unroll
            for (int g = 0; g < 3; ++g) dst[g] = ld4bf(pr + g * 256); }
        else {
#pragma unroll
            for (int g = 0; g < 3; ++g) dst[g] = (f32x4){0.f, 0.f, 0.f, 0.f}; }
    };
    ldrow(tb - 2, x[0]); ldrow(tb - 1, x[1]); ldrow(tb, x[2]);
#pragma unroll
    for (int t = 0; t < 8; ++t) {
        ldrow(tb + t + 1, x[3]);
        bf16* orow = gq + (size_t)rowof(tb + t) * 768 + ch;
#pragma unroll
        for (int g = 0; g < 3; ++g) {
            f32x4 v = cw[0][g] * x[0][g] + cw[1][g] * x[1][g] + cw[2][g] * x[2][g] + cw[3][g] * x[3][g];
            v = (f32x4){siluf_(v.x), siluf_(v.y), siluf_(v.z), siluf_(v.w)};
            if (g < 2) { const float ss = row16_sum((v.x * v.x + v.y * v.y) + (v.z * v.z + v.w * v.w)); v = v * (rsqrtf_(ss + 1e-6f) * (g == 0 ? 0.125f : 1.0f)); }
            st4bf(orow + g * 256, v);
        }
#pragma unroll
        for (int g = 0; g < 3; ++g) { x[0][g] = x[1][g]; x[1][g] = x[2][g]; x[2][g] = x[3][g]; }
    }
}
__device__ __forceinline__ void finish_rows(const Ctx& C, int l, int nrows) {
    const bf16* P = WSP(const bf16, WS_P); bf16* yc = WSP(bf16, WS_HB);
    const bf16* ob = WSP(const bf16, WS_OUTB); const bf16* oc = WSP(const bf16, WS_OUTC); const bf16* od = WSP(const bf16, WS_OUTD);
    const bf16* gg = WSP(const bf16, WS_G); const float* bonus = WSP(const float, WS_BONUS);
    const float* mu = C.in[I_RMU] + (size_t)l * 2 * B_COLS;
    const int gw = C.wg * NWAVES + C.wave, NGW = C.G * NWAVES, lane = C.lane, ch = 4 * lane, hh = lane >> 4;
    const f32x4 lng = *(const f32x4*)(C.in[I_RLNG] + l * GW + ch), lnb = *(const f32x4*)(C.in[I_RLNB] + l * GW + ch);
    const f32x4 mng = *(const f32x4*)(C.in[I_MNG] + l * GW + ch), gng = *(const f32x4*)(C.in[I_GNG] + l * GW + ch);
    const f32x4 mu0 = *(const f32x4*)(mu + 512 + ch), mu1 = *(const f32x4*)(mu + B_COLS + 512 + ch);
    const size_t o2 = (size_t)T_ALL * 256;
#pragma unroll 2
    for (int m = gw; m < nrows; m += NGW) {
        const bool isctx = m >= T_LAT; const int Lp = isctx ? CTXL : SEQ; const int p = isctx ? ((m - T_LAT) & (CTXL - 1)) : (m & (SEQ - 1));
        const f32x4 yb = ld4bf(ob + (size_t)m * 256 + ch) + ld4bf(ob + o2 + (size_t)m * 256 + ch);
        const f32x4 ycv = ld4bf(oc + (size_t)m * 256 + ch) + ld4bf(oc + o2 + (size_t)m * 256 + ch);
        const f32x4 yd = ld4bf(od + (size_t)m * 256 + ch) + ld4bf(od + o2 + (size_t)m * 256 + ch);
        const bf16* pr = P + (size_t)m * PLD;
        const f32x4 vs = ld4bf(WSP(const bf16, WS_RKV) + (size_t)m * 768 + 512 + ch);
        const f32x4 og = ld4bf(pr + OFF_C + 768 + ch), gd = ld4bf(pr + OFF_D + 768 + ch), gr = ld4bf(gg + (size_t)m * 256 + ch);
        const float bn = bonus[(size_t)m * 4 + hh];
        *(v2u*)(yc + (size_t)m * 1024 + ch) = *(const v2u*)(pr + 256 + ch);
        {
            const float mean = row16_sum((yb.x + yb.y) + (yb.z + yb.w)) * (1.0f / 64.0f);
            const f32x4 dl = yb - mean;
            const float var = row16_sum((dl.x * dl.x + dl.y * dl.y) + (dl.z * dl.z + dl.w * dl.w)) * (1.0f / 64.0f);
            const f32x4 yn = dl * rsqrtf_(var + 64e-5f) * lng + lnb;
            st4bf(yc + (size_t)m * 1024 + 256 + ch, (yn + vs * bn) * gr);
        }
        {
            const float ms = row16_sum((ycv.x * ycv.x + ycv.y * ycv.y) + (ycv.z * ycv.z + ycv.w * ycv.w)) * (1.0f / 64.0f);
            const f32x4 sg = (f32x4){sigmoidf_(og.x), sigmoidf_(og.y), sigmoidf_(og.z), sigmoidf_(og.w)};
            st4bf(yc + (size_t)m * 1024 + 512 + ch, ycv * rsqrtf_(ms + 1e-6f) * mng * sg);
        }
        {
            const float ms = row16_sum((yd.x * yd.x + yd.y * yd.y) + (yd.z * yd.z + yd.w * yd.w)) * (1.0f / 64.0f);
            const f32x4 sg = (f32x4){siluf_(gd.x), siluf_(gd.y), siluf_(gd.z), siluf_(gd.w)};
            st4bf(yc + (size_t)m * 1024 + 768 + ch, yd * rsqrtf_(ms + 1e-6f) * gng * sg);
        }
    }
}
typedef bf16x8 fragb;
__device__ __forceinline__ f32x4 mfma16(fragb a, fragb b, f32x4 c) { return __builtin_amdgcn_mfma_f32_16x16x32_bf16(a, b, c, 0, 0, 0); }
__device__ __forceinline__ fragb ld_frag16(const LAS bf16* p) { return *(const LAS fragb*)p; }
__device__ __forceinline__ fragb ld_frag8x2(const LAS bf16* p0, const LAS bf16* p1) {
    const v2u a = *(const LAS v2u*)p0, b = *(const LAS v2u*)p1; v4u r; r.x = a.x; r.y = a.y; r.z = b.x; r.w = b.y; return __builtin_bit_cast(fragb, r); }
__device__ __forceinline__ fragb pack_frag(const f32x4& lo, const f32x4& hi) { v4u r; r.x = pk2(lo.x, lo.y); r.y = pk2(lo.z, lo.w); r.z = pk2(hi.x, hi.y); r.w = pk2(hi.z, hi.w); return __builtin_bit_cast(fragb, r); }
__device__ __forceinline__ float wave_incl_sum(float v, int lane) {
    v += dpp_x<0x111, 0xF, true>(0.f, v); v += dpp_x<0x112, 0xF, true>(0.f, v); v += dpp_x<0x114, 0xF, true>(0.f, v); v += dpp_x<0x118, 0xF, true>(0.f, v);
    v += dpp_x<0x142, 0xA, false>(0.f, v); v += dpp_x<0x143, 0xC, false>(0.f, v);
    return v;
}
__device__ __forceinline__ float wave_incl_max(float v, int lane) {
    const float ninf = -3.0e38f;
    v = fmaxf(v, dpp_x<0x111, 0xF, false>(ninf, v)); v = fmaxf(v, dpp_x<0x112, 0xF, false>(ninf, v)); v = fmaxf(v, dpp_x<0x114, 0xF, false>(ninf, v)); v = fmaxf(v, dpp_x<0x118, 0xF, false>(ninf, v));
    v = fmaxf(v, dpp_x<0x142, 0xA, false>(ninf, v)); v = fmaxf(v, dpp_x<0x143, 0xC, false>(ninf, v));
    return v;
}
constexpr int MP = 72;
__device__ __forceinline__ void mlstm_chunked(const Ctx& C, int l, int idx) {
    const int d = idx >> 5, b = (idx >> 2) & 7, h = idx & 3, lane = C.lane, w = C.wave, l15 = lane & 15, q = lane >> 4;
    const int it = w & 3, vtp = w >> 2;
    constexpr int IMG = 64 * MP * 2, BUFB = 4 * IMG + 1024, CTB = 65 * MP * 2 + 16;
    LAS unsigned char* L0 = C.lds;
    const bf16* P = WSP(const bf16, WS_P); bf16* outc = WSP(bf16, WS_OUTC) + (size_t)d * T_ALL * 256;
    const float ib = C.in[I_MIB][(l * 2 + d) * NH + h], fb = C.in[I_MFB][(l * 2 + d) * NH + h];
    const int tt = C.tid >> 3, part = C.tid & 7;
    for (int i = C.tid; i < 2 * CTB / 4; i += NTHR) ((LAS unsigned*)(L0 + 2 * BUFB))[i] = 0u;
    v4u rq, rk, rv; unsigned short rgi, rgf;
    auto gload = [&](int n) {
        const int row = seqrow_cm(n * 64 + tt, d, b);
        const bf16* pp = P + (size_t)row * PLD + OFF_C + h * 64 + 8 * part;
        rq = *(const v4u*)pp; rk = *(const v4u*)(pp + 256); rv = *(const v4u*)(pp + 512);
        const bf16* pg = P + (size_t)seqrow_cm(n * 64 + lane, d, b) * PLD + OFF_C + 1024 + d * 4 + h;
        rgi = pg[0]; rgf = pg[8];
    };
    auto images = [&](int bufi) {
        LAS unsigned char* B0 = L0 + bufi * BUFB;
        LAS bf16* Qs = (LAS bf16*)B0; LAS bf16* Ks = Qs + 64 * MP; LAS bf16* VT = Ks + 64 * MP; LAS bf16* KTw = VT + 64 * MP; LAS float* vec = (LAS float*)(B0 + 4 * IMG);
        const float li = bf2f(rgi) + ib, lf = -softplusf_(-(bf2f(rgf) + fb));
        const float bc = wave_incl_sum(lf, lane), x = li - bc, cm = wave_incl_max(x, lane);
        const float wl = __expf(x - __shfl(cm, 63)) * 0.125f;
        if (w == 0) { vec[lane] = x; vec[64 + lane] = cm; vec[128 + lane] = bc; }
        const float wmine = __shfl(wl, 8 * w + (lane >> 3));
        *(LAS v4u*)(Qs + tt * MP + 8 * part) = rq; *(LAS v4u*)(Ks + tt * MP + 8 * part) = rk;
        const unsigned vv[4] = {rv.x, rv.y, rv.z, rv.w}, kk[4] = {rk.x, rk.y, rk.z, rk.w};
#pragma unroll
        for (int e = 0; e < 4; ++e) {
            VT[(8 * part + 2 * e) * MP + tt] = (bf16)(vv[e] & 0xffffu); VT[(8 * part + 2 * e + 1) * MP + tt] = (bf16)(vv[e] >> 16);
            KTw[(8 * part + 2 * e) * MP + tt] = (bf16)f2bf1(bflo(kk[e]) * wmine); KTw[(8 * part + 2 * e + 1) * MP + tt] = (bf16)f2bf1(bfhi(kk[e]) * wmine);
        }
    };
    f32x4 Cst[2], nst; float m = 0.f;
    Cst[0] = Cst[1] = nst = (f32x4){0.f, 0.f, 0.f, 0.f};
    const fragb ones = __builtin_bit_cast(fragb, (v4u){0x3F803F80u, 0x3F803F80u, 0x3F803F80u, 0x3F803F80u});
    const f32x4 z4 = (f32x4){0.f, 0.f, 0.f, 0.f};
    gload(0); images(0); gload(1);
#pragma unroll 1
    for (int n = 0; n < NCH; ++n) {
        RAW_BARRIER();
        const LAS unsigned char* B0 = L0 + (n & 1) * BUFB;
        const LAS bf16* Qs = (const LAS bf16*)B0; const LAS bf16* Ks = Qs + 64 * MP; const LAS bf16* VT = Ks + 64 * MP; const LAS bf16* KTw = VT + 64 * MP; const LAS float* vec = (const LAS float*)(B0 + 4 * IMG);
        const LAS bf16* CT = (const LAS bf16*)(L0 + 2 * BUFB + (n & 1) * CTB); LAS bf16* CTn = (LAS bf16*)(L0 + 2 * BUFB + ((n + 1) & 1) * CTB);
        fragb Qf[2]; Qf[0] = ld_frag16(Qs + (16 * it + l15) * MP + 8 * q); Qf[1] = ld_frag16(Qs + (16 * it + l15) * MP + 32 + 8 * q);
        const float cmi = vec[64 + 16 * it + l15]; const int icol = 16 * it + l15;
        f32x4 pt[4];
#pragma unroll
        for (int jt = 0; jt < 4; ++jt) {
            pt[jt] = z4;
            if (jt <= it) {
                const fragb k0 = ld_frag16(Ks + (16 * jt + l15) * MP + 8 * q), k1 = ld_frag16(Ks + (16 * jt + l15) * MP + 32 + 8 * q);
                f32x4 st = mfma16(k0, Qf[0], z4); st = mfma16(k1, Qf[1], st);
                const f32x4 xj = *(const LAS f32x4*)(vec + 16 * jt + 4 * q);
#pragma unroll
                for (int r = 0; r < 4; ++r) { const int j = 16 * jt + 4 * q + r; pt[jt][r] = (j <= icol) ? st[r] * __expf(xj[r] - cmi) * 0.125f : 0.f; }
            }
        }
        fragb Pf[2]; Pf[0] = pack_frag(pt[0], pt[1]); Pf[1] = pack_frag(pt[2], pt[3]);
        fragb Vf[2][2];
#pragma unroll
        for (int v2 = 0; v2 < 2; ++v2)
#pragma unroll
            for (int s = 0; s < 2; ++s) { const LAS bf16* vr = VT + (16 * (2 * vtp + v2) + l15) * MP + 32 * s + 4 * q; Vf[v2][s] = ld_frag8x2(vr, vr + 16); }
        f32x4 Aacc[2], R[2], as, dn;
        as = mfma16(Pf[0], ones, z4); if (it >= 2) as = mfma16(Pf[1], ones, as);
        const fragb nf0 = ld_frag16(CT + 64 * MP + 8 * q), nf1 = ld_frag16(CT + 64 * MP + 32 + 8 * q);
        dn = mfma16(Qf[0], nf0, z4); dn = mfma16(Qf[1], nf1, dn);
#pragma unroll
        for (int v2 = 0; v2 < 2; ++v2) {
            Aacc[v2] = mfma16(Pf[0], Vf[v2][0], z4); if (it >= 2) Aacc[v2] = mfma16(Pf[1], Vf[v2][1], Aacc[v2]);
            const LAS bf16* cr = CT + (16 * (2 * vtp + v2) + l15) * MP + 8 * q;
            R[v2] = mfma16(Qf[0], ld_frag16(cr), z4); R[v2] = mfma16(Qf[1], ld_frag16(cr + 32), R[v2]);
        }
        {
            const f32x4 bi = *(const LAS f32x4*)(vec + 128 + 16 * it + 4 * q), cmr = *(const LAS f32x4*)(vec + 64 + 16 * it + 4 * q);
#pragma unroll
            for (int r = 0; r < 4; ++r) {
                const float mi = bi[r] + cmr[r], minter = bi[r] + m, mt = fmaxf(minter, mi), e1 = __expf(mi - mt), e2 = __expf(minter - mt);
                const float den = e1 * as[r] + e2 * dn[r]; const float inv = __builtin_amdgcn_rcpf(fmaxf(fabsf(den), __expf(-mt)));
                const int row = seqrow_cm(n * 64 + 16 * it + 4 * q + r, d, b);
#pragma unroll
                for (int v2 = 0; v2 < 2; ++v2) outc[(size_t)row * 256 + h * 64 + 16 * (2 * vtp + v2) + l15] = (bf16)f2bf1((e1 * Aacc[v2][r] + e2 * R[v2][r]) * inv);
            }
        }
        {
            const LAS bf16* kr = KTw + (16 * it + l15) * MP + 4 * q;
            const fragb kt0 = ld_frag8x2(kr, kr + 16), kt1 = ld_frag8x2(kr + 32, kr + 48);
            const float bL = vec[128 + 63], mloc = bL + vec[64 + 63];
            const float mnew = fmaxf(bL + m, mloc), wp = __expf(bL + m - mnew), wn = __expf(mloc - mnew);
            f32x4 gk = mfma16(kt0, ones, z4); gk = mfma16(kt1, ones, gk);
            nst = nst * wp + gk * wn;
#pragma unroll
            for (int v2 = 0; v2 < 2; ++v2) {
                f32x4 G = mfma16(kt0, Vf[v2][0], z4); G = mfma16(kt1, Vf[v2][1], G);
                Cst[v2] = Cst[v2] * wp + G * wn;
                v2u o; o.x = pk2(Cst[v2].x, Cst[v2].y); o.y = pk2(Cst[v2].z, Cst[v2].w);
                *(LAS v2u*)(CTn + (16 * (2 * vtp + v2) + l15) * MP + 16 * it + 4 * q) = o;
            }
            if (vtp == 0 && l15 == 0) { v2u o; o.x = pk2(nst.x, nst.y); o.y = pk2(nst.z, nst.w); *(LAS v2u*)(CTn + 64 * MP + 16 * it + 4 * q) = o; }
            m = mnew;
        }
        if (n + 1 < NCH) { images((n + 1) & 1); if (n + 2 < NCH) gload(n + 2); }
    }
    __syncthreads();
}
__device__ __forceinline__ int fwd_row_cm(int b, int c, int t) { return c < 4 ? (T_LAT + b * CTXL + c * 64 + t) : (b * SEQ + t * 64 + (c - 4)); }
__device__ __forceinline__ bf16* blob_row(const Ctx& C, int d, int isw, int b, int c, int h, int r) {
    const int row = fwd_row_cm(b, c, r);
    if (d == 1 && isw) return WSP(bf16, WS_OUTD) + ((size_t)T_ALL + row) * 256 + h * 64;
    return WSP(bf16, WS_P) + (size_t)row * PLD + OFF_D + (d * 2 + isw) * 256 + h * 64;
}
constexpr int LP = 68;
__device__ __forceinline__ void blocked_solve(const LAS bf16* Ln, const LAS bf16* TinvP, LAS unsigned char* XTw, f32x4 (&acc)[4][4], int l15, int q) {
    const f32x4 z4 = (f32x4){0.f, 0.f, 0.f, 0.f};
#pragma unroll
    for (int I = 0; I < 4; ++I) {
        const fragb Af = *(const LAS fragb*)(TinvP + (I * 16 + l15) * 32 + 8 * q);
        fragb A0, A1;
        if (I >= 1) A0 = ld_frag16(Ln + (16 * I + l15) * MP + 8 * q);
        if (I == 3) A1 = ld_frag16(Ln + (16 * I + l15) * MP + 32 + 8 * q);
#pragma unroll
        for (int nt = 0; nt < 4; ++nt) {
            const int crow = 16 * nt + l15; LAS unsigned char* xr = XTw + crow * 128;
            f32x4 a = acc[I][nt];
            if (I >= 1) a = mfma16(A0, *(const LAS fragb*)(xr + ((q ^ (crow & 7)) << 4)), a);
            if (I == 3) a = mfma16(A1, *(const LAS fragb*)(xr + (((4 + q) ^ (crow & 7)) << 4)), a);
            v4u bw; bw.x = pk2(a.x, a.y); bw.y = pk2(a.z, a.w); bw.z = 0u; bw.w = 0u;
            const f32x4 x = mfma16(Af, __builtin_bit_cast(fragb, bw), z4);
            acc[I][nt] = x;
            v2u o; o.x = pk2(x.x, x.y); o.y = pk2(x.z, x.w);
            *(LAS v2u*)(xr + (((2 * I + (q >> 1)) ^ (crow & 7)) << 4) + (q & 1) * 8) = o;
        }
    }
}
__device__ __forceinline__ void diag_inverses(const LAS bf16* Ln, LAS bf16* TinvP, int lane) {
    const int blk = lane >> 4, c = lane & 15;
    float x[16];
#pragma unroll
    for (int i = 0; i < 16; ++i) {
        const LAS bf16* lr = Ln + (16 * blk + i) * MP + 16 * blk;
        const v4u r0 = *(const LAS v4u*)lr, r1 = *(const LAS v4u*)(lr + 8);
        const unsigned rw[8] = {r0.x, r0.y, r0.z, r0.w, r1.x, r1.y, r1.z, r1.w};
        float s = (i == c) ? 1.0f : 0.0f;
#pragma unroll
        for (int j = 0; j < i; ++j) s += ((j & 1) ? bfhi(rw[j >> 1]) : bflo(rw[j >> 1])) * x[j];
        x[i] = s;
        TinvP[(blk * 16 + i) * 32 + 8 * (c >> 2) + (c & 3)] = (bf16)f2bf1(s);
    }
}
__device__ __forceinline__ void gdn_solve_item(const Ctx& C, int l, int item) {
    const int lane = C.lane, w = C.wave, pw = w & 1, pi = w >> 1, l15 = lane & 15, q = lane >> 4;
    LAS unsigned char* B0 = C.lds + pi * 31744;
    LAS bf16* Ln = (LAS bf16*)B0;
    LAS bf16* TinvP = (LAS bf16*)(B0 + 9216);
    LAS float* vec = (LAS float*)(B0 + 13312);
    LAS unsigned char* XT = B0 + 13824;
    LAS bf16* Ks = (LAS bf16*)XT;
    const bf16* P = WSP(const bf16, WS_P); const bf16* gq = WSP(const bf16, WS_GQ);
    const int u = item >> 1, d = item & 1;
    const int c = u % NCH, h = (u / NCH) & 3, b = u / (NCH * NH);
    const int n = d ? (c < 4 ? 3 - c : 71 - c) : c;
    const float aexp = __expf(C.in[I_GALOG][(l * 2 + d) * NH + h]), dtb = C.in[I_GDTB][(l * 2 + d) * NH + h];
    const int rowl = seqrow_cm(n * 64 + lane, d, b);
    const bf16* pg = P + (size_t)rowl * PLD + OFF_D + 1024 + d * 4 + h;
    const float la = -aexp * softplusf_(bf2f(pg[0]) + dtb), beta = sigmoidf_(bf2f(pg[8]));
    const float gam = wave_incl_sum(la, lane);
    if (pw == 0) { vec[lane] = beta; vec[64 + lane] = gam; }
#pragma unroll
    for (int r = 0; r < 4; ++r) { const int idx = pw * 64 + lane + 128 * r, t = idx >> 3, part = idx & 7;
        *(LAS v4u*)(Ks + t * MP + 8 * part) = *(const v4u*)(gq + (size_t)seqrow_cm(n * 64 + t, d, b) * 768 + 256 + h * 64 + 8 * part); }
    { LAS v4u* tz = (LAS v4u*)(B0 + 9216) + (pw * 64 + lane) * 2; tz[0] = (v4u){0u, 0u, 0u, 0u}; tz[1] = (v4u){0u, 0u, 0u, 0u}; }
    f32x4 acc[4][4];
    if (pw == 0) {
#pragma unroll
        for (int I = 0; I < 4; ++I)
#pragma unroll
            for (int r = 0; r < 4; ++r) { const bf16* vr = gq + (size_t)seqrow_cm(n * 64 + 16 * I + 4 * q + r, d, b) * 768 + 512 + h * 64 + l15;
#pragma unroll
                for (int nt = 0; nt < 4; ++nt) acc[I][nt][r] = bf2f(vr[16 * nt]); }
    }
    __syncthreads();
    {
        int tix = 0;
#pragma unroll
        for (int it = 0; it < 4; ++it)
#pragma unroll
            for (int jt = 0; jt < 4; ++jt, ++tix) if ((tix & 1) == pw) {
                f32x4 t4 = (f32x4){0.f, 0.f, 0.f, 0.f};
                if (jt <= it) {
#pragma unroll
                    for (int s = 0; s < 2; ++s) t4 = mfma16(ld_frag16(Ks + (16 * it + l15) * MP + 32 * s + 8 * q), ld_frag16(Ks + (16 * jt + l15) * MP + 32 * s + 8 * q), t4);
                    const float gj = vec[64 + 16 * jt + l15];
                    const f32x4 bi = *(const LAS f32x4*)(vec + 16 * it + 4 * q), gi = *(const LAS f32x4*)(vec + 64 + 16 * it + 4 * q);
#pragma unroll
                    for (int r = 0; r < 4; ++r) { const int i = 16 * it + 4 * q + r, j = 16 * jt + l15; t4[r] = (j < i) ? -(bi[r] * t4[r] * __expf(gi[r] - gj)) : 0.f; }
                }
#pragma unroll
                for (int r = 0; r < 4; ++r) Ln[(16 * it + 4 * q + r) * MP + 16 * jt + l15] = (bf16)f2bf1(t4[r]);
            }
    }
    {
#pragma unroll
        for (int I = 0; I < 4; ++I) {
            const f32x4 bi = *(const LAS f32x4*)(vec + 16 * I + 4 * q), gi = *(const LAS f32x4*)(vec + 64 + 16 * I + 4 * q);
#pragma unroll
            for (int r = 0; r < 4; ++r) { const float sc = pw ? bi[r] * __expf(gi[r]) : bi[r];
#pragma unroll
                for (int nt = 0; nt < 4; ++nt) acc[I][nt][r] = (pw ? bf2f(Ks[(16 * I + 4 * q + r) * MP + 16 * nt + l15]) : acc[I][nt][r]) * sc; }
        }
    }
    __syncthreads();
    if (pw == 0) diag_inverses(Ln, TinvP, lane);
    LAS unsigned char* XTw = XT + pw * 8192;
    { LAS v4u* xz = (LAS v4u*)(XTw + lane * 128);
#pragma unroll
        for (int g = 0; g < 8; ++g) xz[g] = (v4u){0u, 0u, 0u, 0u}; }
    __syncthreads();
    blocked_solve(Ln, TinvP, XTw, acc, l15, q);
    {
        bf16* dst = blob_row(C, d, pw, b, c, h, lane);
        const LAS unsigned char* xr = XTw + lane * 128;
#pragma unroll
        for (int g = 0; g < 8; ++g) *(v4u*)(dst + 8 * g) = *(const LAS v4u*)(xr + ((g ^ (lane & 7)) << 4));
    }
    __syncthreads();
}

template <bool DRY>
__device__ __forceinline__ void gdn_chunked(const Ctx& C, int l, int idx) {
    const int d = idx >> 5, b = (idx >> 2) & 7, h = idx & 3, lane = C.lane, w = C.wave, l15 = lane & 15, q = lane >> 4;
    const int it = w & 3, vtp = w >> 2;
    constexpr int IMG = 64 * MP * 2, BUFB = 5 * IMG + 512;
    LAS unsigned char* L0 = C.lds;
    LAS bf16* VnT = (LAS bf16*)(L0 + 2 * BUFB + 2 * IMG);
    const bf16* P = WSP(const bf16, WS_P); const bf16* gq = WSP(const bf16, WS_GQ); bf16* outd = WSP(bf16, WS_OUTD) + (size_t)d * T_ALL * 256;
    const float aexp = __expf(C.in[I_GALOG][(l * 2 + d) * NH + h]), dtb = C.in[I_GDTB][(l * 2 + d) * NH + h];
    const int tt = C.tid >> 3, part = C.tid & 7;
    for (int i = C.tid; i < 2 * IMG / 4; i += NTHR) ((LAS unsigned*)(L0 + 2 * BUFB))[i] = 0u;
    v4u rq, rk, ru, rw; unsigned short rga;
    auto gload = [&](int n) {
        const int c = d ? (n < 4 ? 3 - n : 71 - n) : n;
        const bf16* pp = gq + (size_t)seqrow_cm(n * 64 + tt, d, b) * 768 + h * 64 + 8 * part;
        rq = *(const v4u*)pp; rk = *(const v4u*)(pp + 256);
        ru = *(const v4u*)(blob_row(C, d, 0, b, c, h, tt) + 8 * part); rw = *(const v4u*)(blob_row(C, d, 1, b, c, h, tt) + 8 * part);
        rga = P[(size_t)seqrow_cm(n * 64 + lane, d, b) * PLD + OFF_D + 1024 + d * 4 + h];
    };
    auto images = [&](int bufi) {
        LAS unsigned char* B0 = L0 + bufi * BUFB;
        LAS bf16* Qs = (LAS bf16*)B0; LAS bf16* Ks = Qs + 64 * MP; LAS bf16* KdT = Ks + 64 * MP; LAS bf16* Wi = KdT + 64 * MP; LAS bf16* UT = Wi + 64 * MP; LAS float* vec = (LAS float*)(B0 + 5 * IMG);
        const float la = -aexp * softplusf_(bf2f(rga) + dtb);
        const float gam = wave_incl_sum(la, lane);
        if (w == 0) vec[lane] = gam;
        const float kd = __expf(__shfl(gam, 63) - gam);
        const float kmine = __shfl(kd, 8 * w + (lane >> 3));
        *(LAS v4u*)(Qs + tt * MP + 8 * part) = rq; *(LAS v4u*)(Ks + tt * MP + 8 * part) = rk; *(LAS v4u*)(UT + tt * MP + 8 * part) = ru;
        const unsigned kk[4] = {rk.x, rk.y, rk.z, rk.w}, ww[4] = {rw.x, rw.y, rw.z, rw.w};
#pragma unroll
        for (int e = 0; e < 4; ++e) {
            KdT[(8 * part + 2 * e) * MP + tt] = (bf16)f2bf1(bflo(kk[e]) * kmine); KdT[(8 * part + 2 * e + 1) * MP + tt] = (bf16)f2bf1(bfhi(kk[e]) * kmine);
            Wi[(8 * part + 2 * e) * MP + tt] = (bf16)(ww[e] & 0xffffu); Wi[(8 * part + 2 * e + 1) * MP + tt] = (bf16)(ww[e] >> 16);
        }
    };
    f32x4 Sst[2]; Sst[0] = Sst[1] = (f32x4){0.f, 0.f, 0.f, 0.f};
    const f32x4 z4 = (f32x4){0.f, 0.f, 0.f, 0.f};
    gload(0); images(0); gload(1);
#pragma unroll 1
    for (int n = 0; n < NCH; ++n) {
        RAW_BARRIER();
        const LAS unsigned char* B0 = L0 + (n & 1) * BUFB;
        const LAS bf16* Qs = (const LAS bf16*)B0; const LAS bf16* Ks = Qs + 64 * MP; const LAS bf16* KdT = Ks + 64 * MP; const LAS bf16* Wi = KdT + 64 * MP; const LAS bf16* UT = Wi + 64 * MP; const LAS float* vec = (const LAS float*)(B0 + 5 * IMG);
        const LAS bf16* ST = (const LAS bf16*)(L0 + 2 * BUFB + (n & 1) * IMG); LAS bf16* STn = (LAS bf16*)(L0 + 2 * BUFB + ((n + 1) & 1) * IMG);
        fragb Qf[2]; Qf[0] = ld_frag16(Qs + (16 * it + l15) * MP + 8 * q); Qf[1] = ld_frag16(Qs + (16 * it + l15) * MP + 32 + 8 * q);
        const float gcol = vec[16 * it + l15]; const int icol = 16 * it + l15;
        f32x4 pt[4];
#pragma unroll
        for (int jt = 0; jt < 4; ++jt) {
            pt[jt] = z4;
            if (jt <= it) {
                const fragb k0 = ld_frag16(Ks + (16 * jt + l15) * MP + 8 * q), k1 = ld_frag16(Ks + (16 * jt + l15) * MP + 32 + 8 * q);
                f32x4 st = mfma16(k0, Qf[0], z4); st = mfma16(k1, Qf[1], st);
                const f32x4 gj = *(const LAS f32x4*)(vec + 16 * jt + 4 * q);
#pragma unroll
                for (int r = 0; r < 4; ++r) { const int j = 16 * jt + 4 * q + r; pt[jt][r] = (j <= icol) ? st[r] * __expf(gcol - gj[r]) : 0.f; }
            }
        }
        fragb Pf[2]; Pf[0] = pack_frag(pt[0], pt[1]); Pf[1] = pack_frag(pt[2], pt[3]);
        const fragb Wf0 = ld_frag16(Wi + (16 * it + l15) * MP + 8 * q), Wf1 = ld_frag16(Wi + (16 * it + l15) * MP + 32 + 8 * q);
        f32x4 Ro[2];
#pragma unroll
        for (int v2 = 0; v2 < 2; ++v2) {
            const int vrow = 16 * (2 * vtp + v2) + l15;
            const fragb s0 = ld_frag16(ST + vrow * MP + 8 * q), s1 = ld_frag16(ST + vrow * MP + 32 + 8 * q);
            f32x4 ws = mfma16(Wf0, s0, z4); ws = mfma16(Wf1, s1, ws);
            Ro[v2] = mfma16(Qf[0], s0, z4); Ro[v2] = mfma16(Qf[1], s1, Ro[v2]);
            const v2u ur = *(const LAS v2u*)(UT + vrow * MP + 16 * it + 4 * q);
            v2u o; o.x = pk2(bflo(ur.x) - ws.x, bfhi(ur.x) - ws.y); o.y = pk2(bflo(ur.y) - ws.z, bfhi(ur.y) - ws.w);
            *(LAS v2u*)(VnT + vrow * MP + 16 * it + 4 * q) = o;
        }
        RAW_BARRIER();
        {
            const f32x4 gi = *(const LAS f32x4*)(vec + 16 * it + 4 * q);
            const float gl = __expf(vec[63]);
            const LAS bf16* kr = KdT + (16 * it + l15) * MP + 4 * q;
            const fragb kt0 = ld_frag8x2(kr, kr + 16), kt1 = ld_frag8x2(kr + 32, kr + 48);
#pragma unroll
            for (int v2 = 0; v2 < 2; ++v2) {
                const int vrow = 16 * (2 * vtp + v2) + l15;
                const LAS bf16* vr = VnT + vrow * MP + 4 * q;
                const fragb n0 = ld_frag8x2(vr, vr + 16), n1 = ld_frag8x2(vr + 32, vr + 48);
                f32x4 o = mfma16(Pf[0], n0, z4); if (it >= 2) o = mfma16(Pf[1], n1, o);
#pragma unroll
                for (int r = 0; r < 4; ++r) { const int row = seqrow_cm(n * 64 + 16 * it + 4 * q + r, d, b);
                    if (!DRY) outd[(size_t)row * 256 + h * 64 + vrow] = (bf16)f2bf1(o[r] + __expf(gi[r]) * Ro[v2][r]); }
                f32x4 ns = mfma16(kt0, n0, z4); ns = mfma16(kt1, n1, ns);
                Sst[v2] = Sst[v2] * gl + ns;
                v2u so; so.x = pk2(Sst[v2].x, Sst[v2].y); so.y = pk2(Sst[v2].z, Sst[v2].w);
                *(LAS v2u*)(STn + vrow * MP + 16 * it + 4 * q) = so;
            }
        }
        if (n + 1 < NCH) { images((n + 1) & 1); if (n + 2 < NCH) gload(n + 2); }
    }
    __syncthreads();
}
constexpr int UP = 264;
template <int CTRL> __device__ __forceinline__ float dpp_keep(float oldv, float v) { return __builtin_bit_cast(float, __builtin_amdgcn_update_dpp(__builtin_bit_cast(int, oldv), __builtin_bit_cast(int, v), CTRL, 0xF, 0xF, false)); }
template <bool REV> __device__ __forceinline__ void scan16(float& A, float& B) {
#define LRU_STEP(S) { const float Ap = dpp_keep<(REV ? 0x100 : 0x110) | S>(1.0f, A), Bp = dpp_keep<(REV ? 0x100 : 0x110) | S>(0.0f, B); B = A * Bp + B; A = A * Ap; }
    LRU_STEP(1) LRU_STEP(2) LRU_STEP(4) LRU_STEP(8)
#undef LRU_STEP
}
constexpr int UPC = 72;
__device__ __forceinline__ int lru_chunk_of(int d, int k) { return d ? (k < 4 ? 3 - k : NCH + 3 - k) : k; }
template <bool REV>
__device__ __forceinline__ void lru_tiles(const LAS bf16* Ud, int th, int mt, int lane, const fragb (&Wa)[2], const fragb (&Wx)[2], const f32x4& ba, const f32x4& bx, const f32x4& sp4,
                                          f32x4 (&Ac)[2], f32x4 (&Hl)[2], f32x4& Atot, f32x4& hend) {
    const int l15 = lane & 15, q = lane >> 4, edge = (lane & 48) | (REV ? 0 : 15);
    const f32x4 z4 = (f32x4){0.f, 0.f, 0.f, 0.f};
    f32x4 tA = z4, tB = z4;
#pragma unroll
    for (int i = 0; i < 2; ++i) {
        const int nt = REV ? 3 - (2 * th + i) : 2 * th + i;
        const LAS bf16* urow = Ud + (16 * nt + l15) * UPC;
        const fragb Uf0 = ld_frag16(urow + 8 * q), Uf1 = ld_frag16(urow + 32 + 8 * q);
        f32x4 aa = mfma16(Wa[0], Uf0, z4); aa = mfma16(Wa[1], Uf1, aa);
        f32x4 ax = mfma16(Wx[0], Uf0, z4); ax = mfma16(Wx[1], Uf1, ax);
        const v2u ur = *(const LAS v2u*)(urow + 16 * mt + 4 * q);
        const f32x4 u4 = (f32x4){bflo(ur.x), bfhi(ur.x), bflo(ur.y), bfhi(ur.y)};
        f32x4 la, iu, A, Bv;
#pragma unroll
        for (int r = 0; r < 4; ++r) { const float rg = sigmoidf_(aa[r] + ba[r]); iu[r] = sigmoidf_(ax[r] + bx[r]) * u4[r]; la[r] = -sp4[r] * rg; }
        const bool sm_ = la[0] > -0.15f && la[1] > -0.15f && la[2] > -0.15f && la[3] > -0.15f;
        if (__builtin_amdgcn_ballot_w64(!sm_) == 0ull) {
#pragma unroll
            for (int r = 0; r < 4; ++r) { const float x = la[r], p = x * (1.0f + x * (0.5f + x * (0.16666667f + x * (0.041666668f + x * (0.0083333338f + x * 0.0013888889f)))));
                A[r] = 1.0f + p; Bv[r] = __builtin_amdgcn_sqrtf(-p * (2.0f + p)) * iu[r]; }
        } else {
#pragma unroll
            for (int r = 0; r < 4; ++r) { A[r] = __expf(la[r]); Bv[r] = __builtin_amdgcn_sqrtf(-expm1f_(2.0f * la[r])) * iu[r]; }
        }
#pragma unroll
        for (int r = 0; r < 4; ++r) { float a_ = A[r], b_ = Bv[r]; scan16<REV>(a_, b_); A[r] = a_; Bv[r] = b_; }
        if (i == 0) {
            Ac[0] = A; Hl[0] = Bv;
#pragma unroll
            for (int r = 0; r < 4; ++r) { tA[r] = __shfl(A[r], edge); tB[r] = __shfl(Bv[r], edge); }
        } else {
            Ac[1] = A * tA; Hl[1] = A * tB + Bv;
#pragma unroll
            for (int r = 0; r < 4; ++r) { Atot[r] = __shfl(Ac[1][r], edge); hend[r] = __shfl(Hl[1][r], edge); }
        }
    }
}
__device__ __forceinline__ void lru_chain(const Ctx& C, int l, int id) {
    const int b = id >> 3, hd = (id >> 1) & 3, chalf = id & 1;
    const int lane = C.lane, l15 = lane & 15, q = lane >> 4;
    const int d = C.wave >> 2, mtl = (C.wave >> 1) & 1, th = C.wave & 1, mt = chalf * 2 + mtl;
    LAS bf16* U = (LAS bf16*)C.lds;
    LAS float* XCH = (LAS float*)(C.lds + 2 * 2 * 64 * UPC * 2);
    bf16* P = WSP(bf16, WS_P); bf16* LH = WSP(bf16, WS_LRUH) + (size_t)id * NSTEP * 32;
    const int cd = C.tid >> 8, cj = C.tid & 63, ctq = (C.tid >> 6) & 3;
    const float* cw = C.in[I_LCW] + (size_t)l * 4 * GW + hd * 64 + cj; const float w0 = cw[0], w1 = cw[GW], w2 = cw[2 * GW], w3 = cw[3 * GW], cb = C.in[I_LCB][l * GW + hd * 64 + cj];
    const bf16* wt = WSP(const bf16, WS_LRUWT) + (size_t)((d * 2 + 0) * 4 + hd) * 4096;
    fragb Wa[2], Wx[2];
#pragma unroll
    for (int ks = 0; ks < 2; ++ks) { Wa[ks] = *(const fragb*)(wt + (16 * mt + l15) * 64 + 32 * ks + 8 * q); Wx[ks] = *(const fragb*)(wt + 4 * 4096 + (16 * mt + l15) * 64 + 32 * ks + 8 * q); }
    const int ch0 = hd * 64 + 16 * mt + 4 * q;
    const f32x4 ba = *(const f32x4*)(C.in[I_LBA] + (l * 2 + d) * GW + ch0), bx = *(const f32x4*)(C.in[I_LBX] + (l * 2 + d) * GW + ch0), lam = *(const f32x4*)(C.in[I_LLAM] + (l * 2 + d) * GW + ch0);
    f32x4 sp4;
#pragma unroll
    for (int r = 0; r < 4; ++r) sp4[r] = 8.0f * softplusf_(-lam[r]);
    f32x4 s = (f32x4){0.f, 0.f, 0.f, 0.f};
    unsigned short xr[19];
#define LRU_LOADX(kk) do { const int c_ = lru_chunk_of(cd, (kk)); const bool ic_ = c_ < 4; const int p0_ = (ic_ ? c_ * 64 : (c_ - 4) * 64) + ctq * 16 - 2, Lp_ = ic_ ? CTXL : SEQ; \
        const bf16* xp_ = P + (size_t)(ic_ ? T_LAT + b * CTXL : b * SEQ) * PLD + hd * 64 + cj; \
        _Pragma("unroll") for (int i_ = 0; i_ < 19; ++i_) { const int p_ = p0_ + i_; xr[i_] = (p_ >= 0 && p_ < Lp_) ? xp_[(size_t)p_ * PLD] : (unsigned short)0; } } while (0)
#define LRU_CONV(kk) do { LAS bf16* uo_ = U + ((((kk) & 1) * 2 + cd) * 64 + ctq * 16) * UPC + cj; \
        _Pragma("unroll") for (int t_ = 0; t_ < 16; ++t_) uo_[t_ * UPC] = (bf16)f2bf1(w0 * bf2f(xr[t_]) + w1 * bf2f(xr[t_ + 1]) + w2 * bf2f(xr[t_ + 2]) + w3 * bf2f(xr[t_ + 3]) + cb); } while (0)
    LRU_LOADX(0); LRU_CONV(0); LRU_LOADX(1);
    __syncthreads();
#pragma unroll 1
    for (int k = 0; k < NCH; ++k) {
        if (k + 1 < NCH) { LRU_CONV(k + 1); if (k + 2 < NCH) LRU_LOADX(k + 2); }
        const int c = lru_chunk_of(d, k); const bool second = lru_chunk_of(1 - d, c) < k;
        const bool ic = c < 4; const size_t row0 = (size_t)(ic ? T_LAT + b * CTXL + c * 64 : b * SEQ + (c - 4) * 64);
        const bool late = (k == 2) || (k == 36);
        int tok[2]; v2u gv[2], fv[2];
#pragma unroll
        for (int i = 0; i < 2; ++i) { const int nt = d ? 3 - (2 * th + i) : 2 * th + i; tok[i] = 16 * nt + l15;
            if (second && !late) { gv[i] = *(const v2u*)(P + (row0 + tok[i]) * PLD + 256 + ch0); fv[i] = *(const v2u*)(LH + (size_t)(c * 64 + tok[i]) * 32 + 16 * mtl + 4 * q); } }
        f32x4 Ac[2], Hl[2], Atot, hend;
        const LAS bf16* Ud = U + ((k & 1) * 2 + d) * 64 * UPC;
        if (d) lru_tiles<true>(Ud, th, mt, lane, Wa, Wx, ba, bx, sp4, Ac, Hl, Atot, hend); else lru_tiles<false>(Ud, th, mt, lane, Wa, Wx, ba, bx, sp4, Ac, Hl, Atot, hend);
        LAS float* xw = XCH + (((((k & 1) * 2 + d) * 2 + mtl) * 2 + th) * 4 + q) * 8;
        if (l15 == (d ? 0 : 15)) { *(LAS f32x4*)xw = Atot; *(LAS f32x4*)(xw + 4) = hend; }
        if (late) VM_WAIT();
        RAW_BARRIER();
        if (second && late) {
#pragma unroll
            for (int i = 0; i < 2; ++i) { gv[i] = *(const v2u*)(P + (row0 + tok[i]) * PLD + 256 + ch0); fv[i] = *(const v2u*)(LH + (size_t)(c * 64 + tok[i]) * 32 + 16 * mtl + 4 * q); }
        }
        const LAS float* xr0 = XCH + (((((k & 1) * 2 + d) * 2 + mtl) * 2 + 0) * 4 + q) * 8;
        const f32x4 A0 = *(const LAS f32x4*)xr0, h0 = *(const LAS f32x4*)(xr0 + 4), A1 = *(const LAS f32x4*)(xr0 + 32), h1 = *(const LAS f32x4*)(xr0 + 36);
        const f32x4 mid = A0 * s + h0, hin = th ? mid : s;
        s = A1 * mid + h1;
#pragma unroll
        for (int i = 0; i < 2; ++i) {
            const f32x4 h = Ac[i] * hin + Hl[i];
            if (!second) { v2u o; o.x = pk2(h.x, h.y); o.y = pk2(h.z, h.w); *(v2u*)(LH + (size_t)(c * 64 + tok[i]) * 32 + 16 * mtl + 4 * q) = o; }
            else {
                const f32x4 g = (f32x4){bflo(gv[i].x), bfhi(gv[i].x), bflo(gv[i].y), bfhi(gv[i].y)};
                f32x4 y = (f32x4){h.x + bflo(fv[i].x), h.y + bfhi(fv[i].x), h.z + bflo(fv[i].y), h.w + bfhi(fv[i].y)};
                y.x *= gelu_tanh(g.x); y.y *= gelu_tanh(g.y); y.z *= gelu_tanh(g.z); y.w *= gelu_tanh(g.w);
                st4bf(P + (row0 + tok[i]) * PLD + 256 + ch0, y);
            }
        }
    }
#undef LRU_LOADX
#undef LRU_CONV
    __syncthreads();
}
constexpr int RP = 264;
__device__ __forceinline__ void rwkv_prep2(const Ctx& C, int l, int b, int c) {
    LAS bf16* RS = (LAS bf16*)C.lds;
    LAS bf16* KS = RS + 64 * RP;
    LAS bf16* XW = KS + 64 * RP;
    LAS bf16* XA = XW + 64 * MP;
    LAS bf16* XG = XA + 64 * MP;
    const bf16* P = WSP(const bf16, WS_P);
    const bool isctx = c < 4; const int p0 = isctx ? c * 64 : (c - 4) * 64; const int Lp = isctx ? CTXL : SEQ; const int row0 = isctx ? T_LAT + b * CTXL : b * SEQ;
    const float* mu = C.in[I_RMU] + (size_t)l * 2 * B_COLS;
    bf16* rkv = WSP(bf16, WS_RKV);
#pragma unroll 5
    for (int it = C.tid; it < 64 * 120; it += NTHR) {
        const int t = it / 120, c8 = (it % 120) * 8, p = p0 + t;
        const bf16* pp = P + (size_t)(row0 + p) * PLD + OFF_B + c8;
        const v4u xc = *(const v4u*)pp; v4u xp = (v4u){0u, 0u, 0u, 0u}, xn = xp;
        if (p > 0) xp = *(const v4u*)(pp - PLD);
        if (p < Lp - 1) xn = *(const v4u*)(pp + PLD);
        const f32x4 m0a = *(const f32x4*)(mu + c8), m0b = *(const f32x4*)(mu + c8 + 4), m1a = *(const f32x4*)(mu + B_COLS + c8), m1b = *(const f32x4*)(mu + B_COLS + c8 + 4);
        const unsigned xcw[4] = {xc.x, xc.y, xc.z, xc.w}, xpw[4] = {xp.x, xp.y, xp.z, xp.w}, xnw[4] = {xn.x, xn.y, xn.z, xn.w};
        float sh[8];
#pragma unroll
        for (int e = 0; e < 4; ++e) {
            const float x0 = bflo(xcw[e]), x1 = bfhi(xcw[e]);
            const float mu0_0 = e < 2 ? m0a[2 * e] : m0b[2 * e - 4], mu0_1 = e < 2 ? m0a[2 * e + 1] : m0b[2 * e - 3], mu1_0 = e < 2 ? m1a[2 * e] : m1b[2 * e - 4], mu1_1 = e < 2 ? m1a[2 * e + 1] : m1b[2 * e - 3];
            sh[2 * e] = x0 + mu0_0 * (bflo(xpw[e]) - x0) + mu1_0 * (bflo(xnw[e]) - x0);
            sh[2 * e + 1] = x1 + mu0_1 * (bfhi(xpw[e]) - x1) + mu1_1 * (bfhi(xnw[e]) - x1);
        }
        if (c8 >= 768) {
            const int ci = c8 - 768;
            if (ci < 64) {
#pragma unroll
                for (int e = 0; e < 8; ++e) sh[e] = tanhf_(sh[e]); }
            else if (ci >= 128) {
#pragma unroll
                for (int e = 0; e < 8; ++e) sh[e] = sigmoidf_(sh[e]); }
        }
        v4u o; o.x = pk2(sh[0], sh[1]); o.y = pk2(sh[2], sh[3]); o.z = pk2(sh[4], sh[5]); o.w = pk2(sh[6], sh[7]);
        if (c8 < 768) {
            *(v4u*)(rkv + (size_t)(row0 + p) * 768 + c8) = o;
            if (c8 < 256) *(LAS v4u*)(RS + t * RP + c8) = o; else if (c8 < 512) *(LAS v4u*)(KS + t * RP + c8 - 256) = o;
        } else {
            const int ci = c8 - 768;
            LAS bf16* dst = ci < 64 ? XW + t * MP + ci : (ci < 128 ? XA + t * MP + ci - 64 : XG + t * MP + ci - 128);
            *(LAS v4u*)dst = o;
        }
    }
    __syncthreads();
    const int lane = C.lane, w = C.wave, l15 = lane & 15, q = lane >> 4, hd = w & 3, ntp = w >> 2;
    const bf16* wt = WSP(const bf16, WS_RWT);
    bf16* wa_out = WSP(bf16, WS_HB); bf16* g_out = WSP(bf16, WS_G); float* bonus = WSP(float, WS_BONUS); float* rinv = WSP(float, WS_RINV);
    const f32x4 z4 = (f32x4){0.f, 0.f, 0.f, 0.f};
    float bsum[2] = {0.f, 0.f}, ksum[2] = {0.f, 0.f};
#pragma unroll
    for (int n2 = 0; n2 < 2; ++n2) {
        const int tok = 16 * (2 * ntp + n2) + l15; const size_t row = (size_t)(row0 + p0 + tok);
        const fragb xw0 = ld_frag16(XW + tok * MP + 8 * q), xw1 = ld_frag16(XW + tok * MP + 32 + 8 * q), xa0 = ld_frag16(XA + tok * MP + 8 * q), xa1 = ld_frag16(XA + tok * MP + 32 + 8 * q);
        const fragb xg0 = ld_frag16(XG + tok * MP + 8 * q), xg1 = ld_frag16(XG + tok * MP + 32 + 8 * q);
        unsigned ow0[8], ow1[8], oa0[8], oa1[8], og[8];
#pragma unroll
        for (int mt = 0; mt < 4; ++mt) {
            const int chl = 16 * (l15 >> 2) + 4 * mt + (l15 & 3), ch4 = hd * 64 + 16 * q + 4 * mt;
            const bf16* wrow = wt + (size_t)(hd * 64 + chl) * 32 + 8 * q;
            const bf16* grow = wt + 4 * 256 * 32 + (size_t)(hd * 64 + chl) * 64 + 8 * q;
            const fragb fw0 = *(const fragb*)(wrow), fw1 = *(const fragb*)(wrow + 256 * 32), fa0 = *(const fragb*)(wrow + 2 * 256 * 32), fa1 = *(const fragb*)(wrow + 3 * 256 * 32), fg0 = *(const fragb*)(grow), fg1 = *(const fragb*)(grow + 32);
            const f32x4 w00 = *(const f32x4*)(C.in[I_RW0] + (l * 2 + 0) * GW + ch4), w01 = *(const f32x4*)(C.in[I_RW0] + (l * 2 + 1) * GW + ch4);
            const f32x4 a00 = *(const f32x4*)(C.in[I_RA0] + (l * 2 + 0) * GW + ch4), a01 = *(const f32x4*)(C.in[I_RA0] + (l * 2 + 1) * GW + ch4);
            const f32x4 k_a = *(const f32x4*)(C.in[I_RKA] + l * GW + ch4), r_k = *(const f32x4*)(C.in[I_RRK] + l * GW + ch4), k_k = *(const f32x4*)(C.in[I_RKK] + l * GW + ch4);
            const f32x4 aw0 = mfma16(fw0, xw0, z4), aw1 = mfma16(fw1, xw1, z4), aa0 = mfma16(fa0, xa0, z4), aa1 = mfma16(fa1, xa1, z4);
            f32x4 ag = mfma16(fg0, xg0, z4); ag = mfma16(fg1, xg1, ag);
            f32x4 wv0, wv1, av0, av1;
#pragma unroll
            for (int r = 0; r < 4; ++r) {
                wv0[r] = __expf(-0.6065306597126334f * sigmoidf_(aw0[r] + w00[r])); wv1[r] = __expf(-0.6065306597126334f * sigmoidf_(aw1[r] + w01[r]));
                av0[r] = sigmoidf_(aa0[r] + a00[r]); av1[r] = sigmoidf_(aa1[r] + a01[r]);
            }
            ow0[2 * mt] = pk2(wv0[0], wv0[1]); ow0[2 * mt + 1] = pk2(wv0[2], wv0[3]); ow1[2 * mt] = pk2(wv1[0], wv1[1]); ow1[2 * mt + 1] = pk2(wv1[2], wv1[3]);
            oa0[2 * mt] = pk2(av0[0], av0[1]); oa0[2 * mt + 1] = pk2(av0[2], av0[3]); oa1[2 * mt] = pk2(av1[0], av1[1]); oa1[2 * mt + 1] = pk2(av1[2], av1[3]);
            og[2 * mt] = pk2(ag[0], ag[1]); og[2 * mt + 1] = pk2(ag[2], ag[3]);
            const v2u rr_ = *(const LAS v2u*)(RS + tok * RP + ch4), kr_ = *(const LAS v2u*)(KS + tok * RP + ch4);
            const f32x4 rs = (f32x4){bflo(rr_.x), bfhi(rr_.x), bflo(rr_.y), bfhi(rr_.y)}, ks = (f32x4){bflo(kr_.x), bfhi(kr_.x), bflo(kr_.y), bfhi(kr_.y)};
#pragma unroll
            for (int r = 0; r < 4; ++r) {
                const float km = ks[r] * (1.0f + (av0[r] - 1.0f) * k_a[r]) + ks[r] * (1.0f + (av1[r] - 1.0f) * k_a[r]);
                bsum[n2] += rs[r] * r_k[r] * km; const float kk = ks[r] * k_k[r]; ksum[n2] += kk * kk;
            }
        }
        bf16* wrow_o = wa_out + row * 1024 + hd * 64 + 16 * q;
        *(v4u*)(wrow_o) = (v4u){ow0[0], ow0[1], ow0[2], ow0[3]}; *(v4u*)(wrow_o + 8) = (v4u){ow0[4], ow0[5], ow0[6], ow0[7]};
        *(v4u*)(wrow_o + 256) = (v4u){ow1[0], ow1[1], ow1[2], ow1[3]}; *(v4u*)(wrow_o + 256 + 8) = (v4u){ow1[4], ow1[5], ow1[6], ow1[7]};
        *(v4u*)(wrow_o + 512) = (v4u){oa0[0], oa0[1], oa0[2], oa0[3]}; *(v4u*)(wrow_o + 512 + 8) = (v4u){oa0[4], oa0[5], oa0[6], oa0[7]};
        *(v4u*)(wrow_o + 768) = (v4u){oa1[0], oa1[1], oa1[2], oa1[3]}; *(v4u*)(wrow_o + 768 + 8) = (v4u){oa1[4], oa1[5], oa1[6], oa1[7]};
        bf16* grow_o = g_out + row * 256 + hd * 64 + 16 * q;
        *(v4u*)(grow_o) = (v4u){og[0], og[1], og[2], og[3]}; *(v4u*)(grow_o + 8) = (v4u){og[4], og[5], og[6], og[7]};
    }
#pragma unroll
    for (int n2 = 0; n2 < 2; ++n2) {
        const size_t row = (size_t)(row0 + p0 + 16 * (2 * ntp + n2) + l15);
        float bs = bsum[n2], ks2 = ksum[n2];
        bs += __shfl_xor(bs, 16); bs += __shfl_xor(bs, 32); ks2 += __shfl_xor(ks2, 16); ks2 += __shfl_xor(ks2, 32);
        if (q == 0) { bonus[row * 4 + hd] = bs; rinv[row * 4 + hd] = rsqrtf_(ks2 + 1e-6f); }
    }
    __syncthreads();
}
__device__ __forceinline__ int fwd_row_r(int b, int c, int t) { return c < 4 ? (T_LAT + b * CTXL + c * 64 + t) : (b * SEQ + (c - 4) * 64 + t); }
__device__ __forceinline__ bf16* rw_blob_row(const Ctx& C, int d, int which, int b, int c, int h, int r) {
    const int row = fwd_row_r(b, c, r);
#if RW_VSPLIT
    if (which == 0) { if (d) return WSP(bf16, WS_GQ) + (size_t)row * 768 + 512 + h * 64;
                      return WSP(bf16, WS_P) + (size_t)row * PLD + OFF_B + 512 + h * 64; }
#else
    if (which == 0) return WSP(bf16, WS_OUTB) + ((size_t)d * T_ALL + row) * 256 + h * 64;
#endif
    return WSP(bf16, WS_P) + (size_t)row * PLD + OFF_B + d * 256 + h * 64;
}
__device__ __forceinline__ void rwkv_solve_item(const Ctx& C, int l, int item) {
    const int lane = C.lane, w = C.wave, pw = w & 1, pi = w >> 1, l15 = lane & 15, q = lane >> 4;
    LAS unsigned char* B0 = C.lds + pi * 31744;
    LAS bf16* Kk = (LAS bf16*)B0; LAS bf16* Bh = Kk + 64 * MP; LAS bf16* Kh = Bh + 64 * MP;
    LAS bf16* Ln = (LAS bf16*)B0;
    LAS bf16* Lk16 = (LAS bf16*)(B0 + 9216);
    LAS unsigned char* XT = B0 + 9216;
    LAS bf16* TinvP = (LAS bf16*)(B0 + 25600);
    const bf16* WA = WSP(const bf16, WS_HB); bf16* WAw = WSP(bf16, WS_HB); const bf16* rkv = WSP(const bf16, WS_RKV); const float* rinv = WSP(const float, WS_RINV);
    const int u = item >> 1, d = item & 1;
    const int c = u % NCH, h = (u / NCH) & 3, b = u / (NCH * NH);
    const float k_k = C.in[I_RKK][l * GW + h * 64 + lane], k_a = C.in[I_RKA][l * GW + h * 64 + lane];
    const int n = d ? (c < 4 ? 3 - c : 71 - c) : c;
    const float ril = rinv[(size_t)seqrow_raster(n * 64 + lane, d, b) * 4 + h];
#pragma unroll
    for (int r = 0; r < 4; ++r) { const int idx2 = pw * 64 + lane + 128 * r, t = idx2 >> 3, part = idx2 & 7; const int row = seqrow_raster(n * 64 + t, d, b);
        *(LAS v4u*)(Kk + t * MP + 8 * part) = *(const v4u*)(WA + (size_t)row * 1024 + d * 256 + h * 64 + 8 * part);
        *(LAS v4u*)(Bh + t * MP + 8 * part) = *(const v4u*)(WA + (size_t)row * 1024 + (2 + d) * 256 + h * 64 + 8 * part);
        *(LAS v4u*)(Kh + t * MP + 8 * part) = *(const v4u*)(rkv + (size_t)row * 768 + 256 + h * 64 + 8 * part); }
    __syncthreads();
    {
        float cc = 1.0f;
        if (pw) {
#pragma unroll
            for (int t = 0; t < 32; ++t) cc *= bf2f(Kk[t * MP + lane]);
        }
        __syncthreads();
#pragma unroll
        for (int t2 = 0; t2 < 32; ++t2) {
            const int t = pw * 32 + t2;
            const float wv = bf2f(Kk[t * MP + lane]), av = bf2f(Bh[t * MP + lane]), ks = bf2f(Kh[t * MP + lane]);
            const float kap = ks * k_k * __shfl(ril, t);
            const float cprev = cc; cc *= wv; const float ic = __builtin_amdgcn_rcpf(cc);
            Kk[t * MP + lane] = (bf16)f2bf1(kap * cprev); Bh[t * MP + lane] = (bf16)f2bf1(kap * av * ic); Kh[t * MP + lane] = (bf16)f2bf1(ks * (1.0f + (av - 1.0f) * k_a) * ic);
            WAw[(size_t)seqrow_raster(n * 64 + t, d, b) * 1024 + d * 256 + h * 64 + lane] = (bf16)f2bf1(cc);
        }
    }
    __syncthreads();
    f32x4 acc[4][4];
    if (pw == 0) {
#pragma unroll
        for (int I = 0; I < 4; ++I)
#pragma unroll
            for (int r = 0; r < 4; ++r)
#pragma unroll
                for (int nt = 0; nt < 4; ++nt) acc[I][nt][r] = bf2f(Kk[(16 * I + 4 * q + r) * MP + 16 * nt + l15]);
    }
    f32x4 T[10];
    {
        const LAS bf16* Bsrc = pw ? Kh : Bh;
        int tix = 0;
#pragma unroll
        for (int it = 0; it < 4; ++it)
#pragma unroll
            for (int jt = 0; jt <= it; ++jt, ++tix) {
                f32x4 t4 = (f32x4){0.f, 0.f, 0.f, 0.f};
#pragma unroll
                for (int s = 0; s < 2; ++s) t4 = mfma16(ld_frag16(Kk + (16 * it + l15) * MP + 32 * s + 8 * q), ld_frag16(Bsrc + (16 * jt + l15) * MP + 32 * s + 8 * q), t4);
#pragma unroll
                for (int r = 0; r < 4; ++r) { const int i = 16 * it + 4 * q + r, j = 16 * jt + l15; T[tix][r] = (j < i) ? (pw ? t4[r] : -t4[r]) : 0.f; }
            }
    }
    __syncthreads();
    {
        int tix = 0;
#pragma unroll
        for (int it = 0; it < 4; ++it)
#pragma unroll
            for (int jt = 0; jt < 4; ++jt) {
                if (jt <= it) {
#pragma unroll
                    for (int r = 0; r < 4; ++r) (pw ? Lk16 : Ln)[(16 * it + 4 * q + r) * MP + 16 * jt + l15] = (bf16)f2bf1(T[tix][r]);
                    ++tix;
                } else if (pw == 0) {
#pragma unroll
                    for (int r = 0; r < 4; ++r) Ln[(16 * it + 4 * q + r) * MP + 16 * jt + l15] = (bf16)0;
                }
            }
        LAS v4u* tz = (LAS v4u*)(B0 + 25600) + (pw * 64 + lane) * 2; tz[0] = (v4u){0u, 0u, 0u, 0u}; tz[1] = (v4u){0u, 0u, 0u, 0u};
    }
    __syncthreads();
    if (pw) {
#pragma unroll
        for (int I = 0; I < 4; ++I)
#pragma unroll
            for (int r = 0; r < 4; ++r)
#pragma unroll
                for (int nt = 0; nt < 4; ++nt) { const int i = 16 * I + 4 * q + r, j = 16 * nt + l15; acc[I][nt][r] = (j < i && nt <= I) ? bf2f(Lk16[i * MP + j]) : 0.f; }
    } else diag_inverses(Ln, TinvP, lane);
    __syncthreads();
    LAS unsigned char* XTw = XT + pw * 8192;
    { LAS v4u* xz = (LAS v4u*)(XTw + lane * 128);
#pragma unroll
        for (int g = 0; g < 8; ++g) xz[g] = (v4u){0u, 0u, 0u, 0u}; }
    blocked_solve(Ln, TinvP, XTw, acc, l15, q);
    {
        bf16* dst = rw_blob_row(C, d, pw, b, c, h, lane);
        const LAS unsigned char* xr = XTw + lane * 128;
#pragma unroll
        for (int g = 0; g < 8; ++g) *(v4u*)(dst + 8 * g) = *(const LAS v4u*)(xr + ((g ^ (lane & 7)) << 4));
    }
    __syncthreads();
}

template <bool DRY>
__device__ __forceinline__ void rwkv_chunked(const Ctx& C, int l, int idx) {
#ifndef RW_VSPLIT
#define RW_VSPLIT 1
#endif
    constexpr int NV = RW_VSPLIT ? 1 : 2;
    const int vhalf = idx & 1, lane = C.lane, w = C.wave, l15 = lane & 15, q = lane >> 4;
    const int d = RW_VSPLIT ? idx >> 6 : idx >> 5, b = RW_VSPLIT ? (idx >> 3) & 7 : (idx >> 2) & 7, h = RW_VSPLIT ? (idx >> 1) & 3 : idx & 3;
    const int it = w & 3, vt0 = RW_VSPLIT ? 2 * vhalf + (w >> 2) : 2 * (w >> 2);
    constexpr int IMG = 64 * MP * 2;
    LAS unsigned char* L0 = C.lds;
    LAS bf16* Wi = (LAS bf16*)L0; LAS bf16* Ti = Wi + 64 * MP; LAS bf16* Rh = Ti + 64 * MP; LAS bf16* Kh = Rh + 64 * MP; LAS bf16* Bh = Kh + 64 * MP;
    LAS bf16* UT = (LAS bf16*)(L0 + 11 * IMG);
    LAS float* cLv = (LAS float*)(L0 + 14 * IMG);
    const bf16* WA = WSP(const bf16, WS_HB); const bf16* rkv = WSP(const bf16, WS_RKV); const float* rinv = WSP(const float, WS_RINV);
    bf16* outb = WSP(bf16, WS_OUTB) + (size_t)d * T_ALL * 256;
    const int tt = C.tid >> 3, part = C.tid & 7;
    for (int i = C.tid; i < 2 * IMG / 4; i += NTHR) ((LAS unsigned*)(L0 + 12 * IMG))[i] = 0u;
    float kkw[8], kaw[8];
#pragma unroll
    for (int e = 0; e < 8; ++e) { kkw[e] = C.in[I_RKK][l * GW + h * 64 + 8 * w + e]; kaw[e] = C.in[I_RKA][l * GW + h * 64 + 8 * w + e]; }
    v4u gr, gk, gv, gw, ga, gbw, gbt; float gri;
    auto gload = [&](int n) {
        const int c = d ? (n < 4 ? 3 - n : 71 - n) : n;
        const int row = seqrow_raster(n * 64 + lane, d, b);
        const bf16* pr = rkv + (size_t)row * 768 + h * 64 + 8 * w;
        gr = *(const v4u*)pr; gk = *(const v4u*)(pr + 256); gv = *(const v4u*)(pr + 512);
        gw = *(const v4u*)(WA + (size_t)row * 1024 + d * 256 + h * 64 + 8 * w); ga = *(const v4u*)(WA + (size_t)row * 1024 + (2 + d) * 256 + h * 64 + 8 * w);
        gri = rinv[(size_t)row * 4 + h];
        gbw = *(const v4u*)(rw_blob_row(C, d, 0, b, c, h, tt) + 8 * part); gbt = *(const v4u*)(rw_blob_row(C, d, 1, b, c, h, tt) + 8 * part);
    };
    auto images = [&](int bufi) {
        LAS bf16* VT = (LAS bf16*)(L0 + (5 + 3 * bufi) * IMG); LAS bf16* KcT = VT + 64 * MP; LAS bf16* BcT = KcT + 64 * MP;
        const unsigned rw_[4] = {gr.x, gr.y, gr.z, gr.w}, kw_[4] = {gk.x, gk.y, gk.z, gk.w}, vw_[4] = {gv.x, gv.y, gv.z, gv.w}, ww_[4] = {gw.x, gw.y, gw.z, gw.w}, aw_[4] = {ga.x, ga.y, ga.z, ga.w};
        float rh[8], kh[8], bh[8];
#pragma unroll
        for (int e = 0; e < 8; ++e) {
            const float rs = (e & 1) ? bfhi(rw_[e >> 1]) : bflo(rw_[e >> 1]), ks = (e & 1) ? bfhi(kw_[e >> 1]) : bflo(kw_[e >> 1]);
            const float wv = (e & 1) ? bfhi(ww_[e >> 1]) : bflo(ww_[e >> 1]), av = (e & 1) ? bfhi(aw_[e >> 1]) : bflo(aw_[e >> 1]);
            const float kap = ks * kkw[e] * gri, ktil = ks * (1.0f + (av - 1.0f) * kaw[e]);
            const float cf = wv, icf = __builtin_amdgcn_rcpf(cf), cfL = __builtin_bit_cast(float, __builtin_amdgcn_readlane(__builtin_bit_cast(int, cf), 63)), dec = cfL * icf;
            rh[e] = rs * cf; kh[e] = ktil * icf; bh[e] = kap * av * icf;
            const unsigned short vraw = (e & 1) ? (unsigned short)(vw_[e >> 1] >> 16) : (unsigned short)(vw_[e >> 1] & 0xffffu);
            VT[(8 * w + e) * MP + lane] = vraw; KcT[(8 * w + e) * MP + lane] = (bf16)f2bf1(ktil * dec); BcT[(8 * w + e) * MP + lane] = (bf16)f2bf1(-(kap * av * dec));
            if (lane == 63) cLv[bufi * 64 + 8 * w + e] = cfL;
        }
        { v4u o; o.x = pk2(rh[0], rh[1]); o.y = pk2(rh[2], rh[3]); o.z = pk2(rh[4], rh[5]); o.w = pk2(rh[6], rh[7]); *(LAS v4u*)(Rh + lane * MP + 8 * w) = o; }
        { v4u o; o.x = pk2(kh[0], kh[1]); o.y = pk2(kh[2], kh[3]); o.z = pk2(kh[4], kh[5]); o.w = pk2(kh[6], kh[7]); *(LAS v4u*)(Kh + lane * MP + 8 * w) = o; }
        { v4u o; o.x = pk2(bh[0], bh[1]); o.y = pk2(bh[2], bh[3]); o.z = pk2(bh[4], bh[5]); o.w = pk2(bh[6], bh[7]); *(LAS v4u*)(Bh + lane * MP + 8 * w) = o; }
        const unsigned bw_[4] = {gbw.x, gbw.y, gbw.z, gbw.w}, bt_[4] = {gbt.x, gbt.y, gbt.z, gbt.w};
#pragma unroll
        for (int e = 0; e < 4; ++e) {
            Wi[(8 * part + 2 * e) * MP + tt] = (bf16)(bw_[e] & 0xffffu); Wi[(8 * part + 2 * e + 1) * MP + tt] = (bf16)(bw_[e] >> 16);
            Ti[(8 * part + 2 * e) * MP + tt] = (bf16)(bt_[e] & 0xffffu); Ti[(8 * part + 2 * e + 1) * MP + tt] = (bf16)(bt_[e] >> 16);
        }
    };
    f32x4 Zst[NV];
#pragma unroll
    for (int v2 = 0; v2 < NV; ++v2) Zst[v2] = (f32x4){0.f, 0.f, 0.f, 0.f};
    const f32x4 z4 = (f32x4){0.f, 0.f, 0.f, 0.f};
    gload(0); images(0); gload(1);
#pragma unroll 1
    for (int n = 0; n < NCH; ++n) {
        RAW_BARRIER();
        const LAS bf16* VT = (const LAS bf16*)(L0 + (5 + 3 * (n & 1)) * IMG); const LAS bf16* KcT = VT + 64 * MP; const LAS bf16* BcT = KcT + 64 * MP;
        const LAS bf16* Zi = (const LAS bf16*)(L0 + (12 + (n & 1)) * IMG); LAS bf16* Zn = (LAS bf16*)(L0 + (12 + ((n + 1) & 1)) * IMG);
        const int arow = (16 * it + l15) * MP + 8 * q;
        const fragb Wf0 = ld_frag16(Wi + arow), Wf1 = ld_frag16(Wi + arow + 32), Tf0 = ld_frag16(Ti + arow), Tf1 = ld_frag16(Ti + arow + 32), Rf0 = ld_frag16(Rh + arow), Rf1 = ld_frag16(Rh + arow + 32);
        const int icol = 16 * it + l15;
        f32x4 pk[4], pb[4];
#pragma unroll
        for (int jt = 0; jt < 4; ++jt) {
            pk[jt] = z4; pb[jt] = z4;
            if (jt <= it) {
                const int jrow = (16 * jt + l15) * MP + 8 * q;
                f32x4 sk = mfma16(ld_frag16(Kh + jrow), Rf0, z4); sk = mfma16(ld_frag16(Kh + jrow + 32), Rf1, sk);
                f32x4 sb = mfma16(ld_frag16(Bh + jrow), Rf0, z4); sb = mfma16(ld_frag16(Bh + jrow + 32), Rf1, sb);
#pragma unroll
                for (int r = 0; r < 4; ++r) { const int j = 16 * jt + 4 * q + r; pk[jt][r] = (j <= icol) ? sk[r] : 0.f; pb[jt][r] = (j <= icol) ? -sb[r] : 0.f; }
            }
        }
        fragb Pk0 = pack_frag(pk[0], pk[1]), Pk1 = pack_frag(pk[2], pk[3]), Pb0 = pack_frag(pb[0], pb[1]), Pb1 = pack_frag(pb[2], pb[3]);
        f32x4 RZ[NV];
#pragma unroll
        for (int v2 = 0; v2 < NV; ++v2) {
            const int vrow = 16 * (vt0 + v2) + l15;
            const fragb z0 = ld_frag16(Zi + vrow * MP + 8 * q), z1 = ld_frag16(Zi + vrow * MP + 32 + 8 * q);
            f32x4 u = mfma16(Wf0, z0, z4); u = mfma16(Wf1, z1, u);
            u = mfma16(Tf0, ld_frag16(VT + vrow * MP + 8 * q), u); if (it >= 2) u = mfma16(Tf1, ld_frag16(VT + vrow * MP + 32 + 8 * q), u);
            RZ[v2] = mfma16(Rf0, z0, z4); RZ[v2] = mfma16(Rf1, z1, RZ[v2]);
            v2u o; o.x = pk2(u.x, u.y); o.y = pk2(u.z, u.w);
            *(LAS v2u*)(UT + vrow * MP + 16 * it + 4 * q) = o;
        }
        RAW_BARRIER();
        {
            const f32x4 cl4 = *(const LAS f32x4*)(cLv + (n & 1) * 64 + 16 * it + 4 * q);
            const LAS bf16* kr = KcT + (16 * it + l15) * MP + 4 * q; const LAS bf16* br = BcT + (16 * it + l15) * MP + 4 * q;
            const fragb kc0 = ld_frag8x2(kr, kr + 16), kc1 = ld_frag8x2(kr + 32, kr + 48), bc0 = ld_frag8x2(br, br + 16), bc1 = ld_frag8x2(br + 32, br + 48);
#pragma unroll
            for (int v2 = 0; v2 < NV; ++v2) {
                const int vrow = 16 * (vt0 + v2) + l15;
                const LAS bf16* vr = VT + vrow * MP + 4 * q; const LAS bf16* ur = UT + vrow * MP + 4 * q;
                const fragb vp0 = ld_frag8x2(vr, vr + 16), vp1 = ld_frag8x2(vr + 32, vr + 48), up0 = ld_frag8x2(ur, ur + 16), up1 = ld_frag8x2(ur + 32, ur + 48);
                f32x4 y = mfma16(Pk0, vp0, RZ[v2]); y = mfma16(Pb0, up0, y);
                if (it >= 2) { y = mfma16(Pk1, vp1, y); y = mfma16(Pb1, up1, y); }
#pragma unroll
                for (int r = 0; r < 4; ++r) { const int row = seqrow_raster(n * 64 + 16 * it + 4 * q + r, d, b); if (!DRY) outb[(size_t)row * 256 + h * 64 + vrow] = (bf16)f2bf1(y[r]); }
                f32x4 zn = mfma16(kc0, vp0, z4); zn = mfma16(kc1, vp1, zn); zn = mfma16(bc0, up0, zn); zn = mfma16(bc1, up1, zn);
                Zst[v2] = Zst[v2] * cl4 + zn;
                v2u so; so.x = pk2(Zst[v2].x, Zst[v2].y); so.y = pk2(Zst[v2].z, Zst[v2].w);
                *(LAS v2u*)(Zn + vrow * MP + 16 * it + 4 * q) = so;
            }
        }
        if (n + 1 < NCH) { images((n + 1) & 1); if (n + 2 < NCH) gload(n + 2); }
    }
    __syncthreads();
}
__device__ __forceinline__ void moe_scatter(const Ctx& C, int moe_li, int nrows) {
    const unsigned* gc = WSP(const unsigned, WS_CTL) + CW_MOECNT + 64 * moe_li;
    LAS int* pst = (LAS int*)C.lds;
    {
        int pe[8]; int acc = 0;
#pragma unroll
        for (int e = 0; e < NE; ++e) { const int blks = ((int)gc[e] + 255) >> 8; if (C.tid == e) pst[e] = acc * 256; acc += blks; pe[e] = acc; }
        if (C.wg == 0 && C.tid < MOE_MAXBLK) { int be = 0;
#pragma unroll
            for (int e = 0; e < NE; ++e) be += (pe[e] <= C.tid) ? 1 : 0;
            int* tab = WSP(int, WS_TAB); tab[1 + C.tid] = be < NE ? be : NE - 1; if (C.tid == 0) tab[0] = acc; }
    }
    __syncthreads();
    const unsigned* route = WSP(const unsigned, WS_ROUTE); const unsigned* wgbase = WSP(const unsigned, WS_WGBASE);
    int* pos = WSP(int, WS_POS); int* tok = WSP(int, WS_TOK);
    if (C.wg < NE) { const int cnt = (int)gc[C.wg], s0 = pst[C.wg] + cnt, s1 = pst[C.wg] + (((cnt + 255) >> 8) << 8);
        for (int j = s0 + C.tid; j < s1; j += NTHR) tok[j] = 0; }
    const int m = C.wg * NWAVES + C.wave + C.lane * (C.G * NWAVES);
    if (m < nrows) {
        const v4u a = *(const v4u*)(route + (size_t)m * 8);
        const int e0 = (int)a.x, e1 = (int)a.y;
        const int p0 = pst[e0] + (int)wgbase[C.wg * 8 + e0] + (int)a.z, p1 = pst[e1] + (int)wgbase[C.wg * 8 + e1] + (int)a.w;
        pos[(size_t)m * 2] = p0; pos[(size_t)m * 2 + 1] = p1; tok[p0] = m; tok[p1] = m;
    }
    __syncthreads();
}
template <int NEXT>
__device__ __forceinline__ void moe_combine(const Ctx& C, int l, int nrows) {
    const unsigned* route = WSP(const unsigned, WS_ROUTE); const int* pos = WSP(const int, WS_POS); const bf16* ym = WSP(const bf16, WS_MIX);
    const float* modv = WSP(const float, WS_MODV) + (size_t)l * 9 * 6144 + 5 * 1024;
    const float* modn = WSP(const float, WS_MODV) + (size_t)(l + 1) * 9 * 6144;
    float* xc = WSP(float, WS_XC); bf16* hb = WSP(bf16, WS_HB);
    bf16* xlb = NEXT == 2 ? WSP(bf16, WS_XLAST) : (bf16*)C.out;
    const int gw = C.wg * NWAVES + C.wave, NGW = C.G * NWAVES;
    f32x4 gn[4];
#pragma unroll
    for (int j = 0; j < 4; ++j) gn[j] = *(const f32x4*)((NEXT == 2 ? C.in[I_FNG] : C.in[I_NMIXG] + (NEXT == 1 ? (l + 1) * 1024 : 0)) + 4 * C.lane + 256 * j);
    for (int m = gw; m < nrows; m += NGW) {
        const bool isctx = m >= T_LAT;
        float* xr = isctx ? xc + (size_t)(m - T_LAT) * 1024 : C.out + (size_t)m * 1024; bf16* xrb = xlb + (size_t)m * 1024;
        const int mrow = isctx ? 8 : (m >> 12);
        const float* gv = modv + (size_t)mrow * 6144;
        const int p0 = pos[(size_t)m * 2], p1 = pos[(size_t)m * 2 + 1];
        const float w0 = __builtin_bit_cast(float, route[(size_t)m * 8 + 4]), w1 = __builtin_bit_cast(float, route[(size_t)m * 8 + 5]);
        f32x4 x[4]; float ss = 0.f;
#pragma unroll
        for (int j = 0; j < 4; ++j) {
            const int col = 4 * C.lane + 256 * j;
            const v2u a = *(const v2u*)(ym + (size_t)p0 * 1024 + col), b = *(const v2u*)(ym + (size_t)p1 * 1024 + col);
            const f32x4 ya = (f32x4){bflo(a.x), bfhi(a.x), bflo(a.y), bfhi(a.y)}, yb = (f32x4){bflo(b.x), bfhi(b.x), bflo(b.y), bfhi(b.y)};
            const f32x4 g = *(const f32x4*)(gv + col);
            x[j] = (isctx ? *(const f32x4*)(xr + col) : ld4bf(xrb + col)) + g * (ya * w0 + yb * w1);
            if (NEXT != 2) { if (isctx) *(f32x4*)(xr + col) = x[j]; else st4bf(xrb + col, x[j]); }
            ss += (x[j].x * x[j].x + x[j].y * x[j].y) + (x[j].z * x[j].z + x[j].w * x[j].w);
        }
        if (NEXT != 0) {
            const float rs = rsqrtf_(wave_sum(ss) * (1.0f / 1024.0f) + 1e-6f);
#pragma unroll
            for (int j = 0; j < 4; ++j) {
                const int col = 4 * C.lane + 256 * j;
                if (NEXT == 2) *(f32x4*)(xr + col) = x[j] * rs * gn[j];
                else { const f32x4 sh = *(const f32x4*)(modn + (size_t)mrow * 6144 + col), scl = *(const f32x4*)(modn + (size_t)mrow * 6144 + 1024 + col);
                    st4bf(hb + (size_t)m * 1024 + col, (x[j] * rs * gn[j]) * (scl + 1.0f) + sh); }
            }
        }
    }
}
__device__ __forceinline__ void final_norm(const Ctx& C) {
    const int gw = C.wg * NWAVES + C.wave, NGW = C.G * NWAVES;
    f32x4 gv[4];
#pragma unroll
    for (int j = 0; j < 4; ++j) gv[j] = *(const f32x4*)(C.in[I_FNG] + 4 * C.lane + 256 * j);
    for (int m = gw; m < T_LAT; m += NGW) {
        float* xr = C.out + (size_t)m * 1024;
        f32x4 v[4]; float s = 0.f;
#pragma unroll
        for (int j = 0; j < 4; ++j) { v[j] = *(const f32x4*)(xr + 4 * C.lane + 256 * j); s += (v[j].x * v[j].x + v[j].y * v[j].y) + (v[j].z * v[j].z + v[j].w * v[j].w); }
        const float rs = rsqrtf_(wave_sum(s) * (1.0f / 1024.0f) + 1e-6f);
#pragma unroll
        for (int j = 0; j < 4; ++j) *(f32x4*)(xr + 4 * C.lane + 256 * j) = v[j] * rs * gv[j];
    }
}

constexpr int NPH_L = 13, PH_FINAL = 1 + DEPTH * NPH_L, NPHASE = PH_FINAL + 1;
__host__ __device__ inline bool phase_exists(int ph) {
    if (ph == 0) return true;
    if (ph == PH_FINAL) return false;
    const int l = (ph - 1) / NPH_L, k = (ph - 1) % NPH_L;
    if (l >= 2 && !(l & 1) && k == 0) return false;
    if (!(l & 1) && k >= 11) return false;
    if (!RW_VSPLIT && k == 4) return false;
    return true;
}
#ifndef PH_MASK
#define PH_MASK 0xFFFFFF
#endif
#define PM(k) ((PH_MASK >> (k)) & 1)
#ifndef SK_MASK
#define SK_MASK 0xFFFF
#endif
#define SK(k) ((SK_MASK >> (k)) & 1)
#ifndef REP_MASK
#define REP_MASK 0
#endif
#define NREP(k) (((REP_MASK >> (k)) & 1) ? 2 : 1)

__global__ void __launch_bounds__(NTHR, 2) fwd_kernel(Args args) {
    extern __shared__ __attribute__((aligned(16))) unsigned char lds_raw[];
    Ctx C; C.in = args.in; C.out = args.out; C.ws = args.ws; C.lds = (LAS unsigned char*)lds_raw;
    C.tid = threadIdx.x; C.lane = C.tid & 63; C.wave = __builtin_amdgcn_readfirstlane(C.tid >> 6); C.G = gridDim.x; C.wg = blockIdx.x;
    volatile LAS unsigned* MISC = (volatile LAS unsigned*)(C.lds + MISC_OFF);
    if (C.tid < 64) MISC[C.tid] = 0u;
    __syncthreads();
    const int lo = args.ph_lo, hi = args.ph_hi;
    const bool multi = (hi - lo) > 1;
    if (multi) (void)xcd_barrier_post(WSP(unsigned, WS_CTL) + CW_BAR, MISC + 8);
#define IN(k) (lo <= (k) && (k) < hi)
#define SEAM(k) do { if (IN((k) + 1)) { XcdBarrier b2_; b2_.bar = WSP(unsigned, WS_CTL) + CW_BAR; b2_.x = xb_xcc_id(); b2_.st = (volatile LAS unsigned*)(C.lds + MISC_OFF) + 8; xcd_barrier(b2_); } } while (0)
#define FRESH() do { int t_ = threadIdx.x; asm volatile("" : "+v"(t_)); C.tid = t_; C.lane = t_ & 63; C.wave = __builtin_amdgcn_readfirstlane(t_ >> 6); } while (0)
#define PHASE(bit, k) if (PM(bit) && IN(pb + (k))) for (int rep_ = 0; rep_ < NREP(bit); ++rep_)
#define CLAIM(qh, var) __syncthreads(); if (C.tid == 0) *qslot = atomicAdd((qh), 1u); __syncthreads(); const int var = (int)*qslot;

    LAS unsigned* qslot = (LAS unsigned*)(C.lds + MISC_OFF + 128);
    constexpr int NCSL = 512;
#define CONV_QUEUES(maxn) do { int n_ = 0; \
        if (l > 0) for (; n_ < (maxn); ++n_) { FRESH(); CLAIM(qbase + 192, u0) if (u0 >= NCSL) break; FRESH(); convert_items(C, l, 2, u0 * NWAVES + C.wave, NCSL * NWAVES); } \
        if (l + 1 < DEPTH) for (; n_ < (maxn); ++n_) { FRESH(); CLAIM(qbase + 224, u0) if (u0 >= NCSL) break; FRESH(); convert_items(C, l + 1, 1, u0 * NWAVES + C.wave, NCSL * NWAVES); } } while (0)
    if (PM(20) && IN(0)) { phase_pre(C);
        for (;;) { FRESH(); CLAIM(WSP(unsigned, WS_CTL) + CW_PREPQ + 240, u0) if (u0 >= NCSL) break; FRESH(); convert_items(C, 0, 3, u0 * NWAVES + C.wave, NCSL * NWAVES); }
        SEAM(0); }

#pragma unroll 1
    for (int l = 0; l < DEPTH; ++l) {
        const int pb = 1 + l * NPH_L;
        if (hi <= pb || lo >= pb + NPH_L) continue;
        const bool last = (l == DEPTH - 1), moe = (l & 1);
        const int nrows = last ? T_LAT : T_ALL;
        const void* xlat = (l == 0) ? (const void*)C.in[I_X] : (const void*)C.out; const bool xbf = l > 0; void* xmid = last ? (void*)WSP(bf16, WS_XLAST) : (void*)C.out;
        const float* xctx = (l == 0) ? C.in[I_CTX] : WSP(const float, WS_XC);
        const float* modv = WSP(const float, WS_MODV) + (size_t)l * 9 * 6144;
        unsigned* qbase = WSP(unsigned, WS_CTL) + CW_PREPQ + 256 * l;

        if (!(l >= 2 && !(l & 1))) PHASE(0, 0) { FRESH();
            convert_small(C, l);
            __syncthreads();
            FRESH(); norm_rows<false>(C, l, xlat, xbf, xctx, C.in[I_NMIXG] + l * 1024, 0, 1024, T_ALL, 0);
            SEAM(pb + 0);
        }
        PHASE(1, 1) { FRESH();
            pg8::Gemm g{WSP(const bf16, WS_HB), WSP(const bf16, WS_WIN), T_ALL, PLD, 1024, 0};
            const int gG = (l > 0) ? C.G - 16 : C.G;
            if (C.wg < gG) {
                pg8::StaticOrder S; S.init(T_ALL, PLD, gG, C.wg);
                pg8::EpiBf16<0> E{WSP(bf16, WS_P), PLD, nullptr, 0, 0};
                pg8::gemm_phase<pg8::EpiBf16<0>, pg8::StaticOrder, false>(C.lds, g, S, E, nullptr);
                if (l > 0 && C.tid == 0) (void)xb_add(qbase + 176, 1u);
            } else {
                for (;;) { FRESH(); __syncthreads(); if (C.tid == 0) *qslot = xb_ld(qbase + 176); __syncthreads(); const unsigned fin_ = *qslot; if (fin_ != 0u) break;
                    CLAIM(qbase + 192, u0) if (u0 >= NCSL) break; FRESH(); convert_items(C, l, 2, u0 * NWAVES + C.wave, NCSL * NWAVES); }
            }
            SEAM(pb + 1);
        }
        if (PM(2) && IN(pb + 2)) for (int rep_ = 0; rep_ < NREP(2); ++rep_) { FRESH();
            for (;;) {
                CLAIM(qbase + 16 * rep_, k)
                if (k >= 2 * NB * NCH) break;
                const int kind = k / (NB * NCH), u = k % (NB * NCH);
                FRESH();
                if (kind == 0) { for (int r3_ = 0; r3_ < NREP(24); ++r3_) { FRESH(); if (SK(1)) rwkv_prep2(C, l, u / NCH, u % NCH); } }
                else { for (int r3_ = 0; r3_ < NREP(26); ++r3_) { FRESH(); if (SK(2)) gdn_prep(C, l, u / NCH, u % NCH); } }
            }
            SEAM(pb + 2);
        }
        if (PM(3) && IN(pb + 3)) for (int rep_ = 0; rep_ < NREP(3); ++rep_) { FRESH();
            constexpr int NCL = 2 * NB * NH * NCH / 4;
            int ncl_ = 0;
            for (;;) {
                CLAIM(qbase + 64 + 16 * rep_, k)
                if (k >= NCL) break;
                FRESH(); ++ncl_;
                if (SK(10)) rwkv_solve_item(C, l, 4 * k + (C.wave >> 1));
            }
            if (ncl_ <= 4) { const int cap_ = (l & 1) ? 1 : 3; CONV_QUEUES(cap_); }
            SEAM(pb + (RW_VSPLIT ? 3 : 4));
        }
#if RW_VSPLIT
        if (PM(3) && IN(pb + 4)) { FRESH();
            for (;;) {
                CLAIM(qbase + 128, k)
                if (k >= 2 * NB * NH * NCH / 4) break;
                FRESH();
                if (SK(10)) rwkv_solve_item(C, l, 4 * k + (C.wave >> 1));
            }
            SEAM(pb + 4);
        }
#endif
        if (PM(4) && IN(pb + 5)) { FRESH();
            if (C.wg >= 64) {
                constexpr int NCL = 2 * NB * NH * NCH / 4;
                for (;;) {
                    CLAIM(qbase + 128, k)
                    if (k >= NCL) break;
                    FRESH();
                    if (SK(9)) gdn_solve_item(C, l, 4 * k + (C.wave >> 1));
                }
                asm volatile("s_waitcnt vmcnt(0)" ::: "memory");
                __syncthreads();
                if (C.tid == 0) { __builtin_amdgcn_fence(__ATOMIC_RELEASE, "agent"); asm volatile("s_waitcnt vmcnt(0)" ::: "memory"); (void)xb_add(qbase + 160, 1u); }
                if (C.wg >= 192) {
                    if (C.tid == 0) { unsigned* bar_ = WSP(unsigned, WS_CTL) + CW_BAR; XB_SPIN(xb_ld(qbase + 160) < (unsigned)(C.G - 64), bar_); __builtin_amdgcn_fence(__ATOMIC_ACQUIRE, "agent"); asm volatile("s_waitcnt vmcnt(0)" ::: "memory"); }
                    __syncthreads();
                }
                FRESH();
            }
            if (C.wg >= 64 && C.wg < 128) { if (SK(0)) lru_chain(C, l, C.wg - 64); FRESH(); }
            if (SK(3) && C.wg < (RW_VSPLIT ? 128 : 64)) { if (NREP(20) > 1) { FRESH(); rwkv_chunked<true>(C, l, C.wg); } FRESH(); rwkv_chunked<false>(C, l, C.wg); }
            else if (SK(4) && C.wg >= 128 && C.wg < 192) { for (int r2_ = 0; r2_ < NREP(21); ++r2_) { FRESH(); mlstm_chunked(C, l, C.wg - 128); } }
            else if (SK(5) && C.wg >= 192) { if (NREP(22) > 1) { FRESH(); gdn_chunked<true>(C, l, C.wg - 192); } FRESH(); gdn_chunked<false>(C, l, C.wg - 192); }
            FRESH(); CONV_QUEUES(1 << 30);
            SEAM(pb + 5);
        }
        PHASE(5, 6) { FRESH();
            if (SK(8)) finish_rows(C, l, nrows);
            SEAM(pb + 6);
        }
        if (PM(6) && IN(pb + 7)) { FRESH();
            pg8::Gemm g{WSP(const bf16, WS_HB), WSP(const bf16, WS_WOUT), nrows, 1024, 1024, 0};
            pg8::StaticOrder S; S.init(nrows, 1024, C.G, C.wg);
            pg8::EpiRes E{xlat, xctx, xmid, WSP(float, WS_XC), modv + 2 * 1024, xbf, true};
            pg8::gemm_phase<pg8::EpiRes, pg8::StaticOrder, false>(C.lds, g, S, E, nullptr);
            SEAM(pb + 7);
        }
        if (PM(7) && IN(pb + 8)) { FRESH();
            if (moe) norm_rows<true>(C, l, xmid, true, WSP(const float, WS_XC), C.in[I_NFFNG] + l * 1024, 3 * 1024, 4 * 1024, nrows, l >> 1);
            else norm_rows<false>(C, l, xmid, true, WSP(const float, WS_XC), C.in[I_NFFNG] + l * 1024, 3 * 1024, 4 * 1024, nrows, 0);
            SEAM(pb + 8);
        }
        if (!moe) {
            if (PM(8) && IN(pb + 9)) for (int rep_ = 0; rep_ < NREP(8); ++rep_) { FRESH();
                pg8::Gemm g{WSP(const bf16, WS_HB), WSP(const bf16, WS_WGU), nrows, 2 * DFF, 1024, 0};
                pg8::StaticOrder S; S.init(nrows, 2 * DFF, C.G, C.wg);
                pg8::EpiSwiglu E{WSP(bf16, WS_P), DFF};
                pg8::gemm_phase<pg8::EpiSwiglu, pg8::StaticOrder, false>(C.lds, g, S, E, nullptr);
                SEAM(pb + 9);
            }
            if (PM(9) && IN(pb + 10)) { FRESH();
                pg8::Gemm g{WSP(const bf16, WS_P), WSP(const bf16, WS_WDN), nrows, 1024, DFF, 0};
                pg8::StaticOrder S; S.init(nrows, 1024, C.G, C.wg);
                pg8::EpiRes E{xmid, WSP(const float, WS_XC), xmid, WSP(float, WS_XC), modv + 5 * 1024, true, true};
                pg8::gemm_phase<pg8::EpiRes, pg8::StaticOrder, false>(C.lds, g, S, E, nullptr);
                SEAM(pb + 12);
            }
        } else {
            if (PM(10) && IN(pb + 9)) { FRESH(); moe_scatter(C, l >> 1, nrows); SEAM(pb + 9); }
            if (PM(11) && IN(pb + 10)) for (int rep_ = 0; rep_ < NREP(11); ++rep_) { FRESH();
                pg8::Gemm g{WSP(const bf16, WS_HB), WSP(const bf16, WS_WGU), 0, 2 * DFE, 1024, (size_t)2 * DFE * 1024};
                pg8::MoeOrderG S; S.init(WSP(const int, WS_TAB), (2 * DFE) / 256, C.G, C.wg); S.tok = WSP(const int, WS_TOK);
                pg8::EpiSwiglu E{WSP(bf16, WS_P), DFE};
                pg8::gemm_phase<pg8::EpiSwiglu, pg8::MoeOrderG, false>(C.lds, g, S, E, nullptr);
                SEAM(pb + 10);
            }
            if (PM(12) && IN(pb + 11)) for (int rep_ = 0; rep_ < NREP(12); ++rep_) { FRESH();
                pg8::Gemm g{WSP(const bf16, WS_P), WSP(const bf16, WS_WDN), 0, 1024, DFE, (size_t)1024 * DFE};
                pg8::MoeOrder S; S.init(WSP(const int, WS_TAB), 4, C.G, C.wg);
                pg8::EpiBf16<0> E{WSP(bf16, WS_MIX), 1024, nullptr, 0, 0};
                pg8::gemm_phase<pg8::EpiBf16<0>, pg8::MoeOrder, false>(C.lds, g, S, E, nullptr);
                SEAM(pb + 11);
            }
            if (PM(13) && IN(pb + 12)) { FRESH();
                if (last) moe_combine<2>(C, l, nrows);
                else { convert_small(C, l + 1); FRESH(); moe_combine<1>(C, l, nrows); if (IN(pb + NPH_L + 1)) { XcdBarrier b2_; b2_.bar = WSP(unsigned, WS_CTL) + CW_BAR; b2_.x = xb_xcc_id(); b2_.st = (volatile LAS unsigned*)(C.lds + MISC_OFF) + 8; xcd_barrier(b2_); } }
            }
        }
    }
}

extern "C" void kernel_launch(void* const* d_in, const int* in_sizes, int n_in, void* d_out, int out_size, void* d_ws, size_t ws_size, hipStream_t stream) {
    static int grid = 0;
    if (grid == 0) {
        if (n_in != N_IN || in_sizes[0] != T_LAT * DM || out_size != T_LAT * DM || ws_size < WS_END) {
            fprintf(stderr, "kernel_launch: unexpected problem (n_in %d, in0 %d, out %d, ws %zu < %zu)\n", n_in, n_in > 0 ? in_sizes[0] : -1, out_size, ws_size, (size_t)WS_END); grid = -1; return; }
        int dev = 0, cus = 0, per_cu = 0;
        if (hipGetDevice(&dev) != hipSuccess || hipDeviceGetAttribute(&cus, hipDeviceAttributeMultiprocessorCount, dev) != hipSuccess) { grid = -1; return; }
        if (hipFuncSetAttribute((const void*)fwd_kernel, hipFuncAttributeMaxDynamicSharedMemorySize, LDS_BYTES) != hipSuccess) { fprintf(stderr, "kernel_launch: hipFuncSetAttribute failed\n"); grid = -1; return; }
        if (hipOccupancyMaxActiveBlocksPerMultiprocessor(&per_cu, (const void*)fwd_kernel, NTHR, LDS_BYTES) != hipSuccess || per_cu < 1) { fprintf(stderr, "kernel_launch: occupancy query says %d\n", per_cu); grid = -1; return; }
        grid = cus;
        if (grid != 256) fprintf(stderr, "kernel_launch: note: %d CUs\n", grid);
    }
    if (grid < 0) return;
    if (hipMemsetAsync((char*)d_ws + WS_CTL, 0, CTL_BYTES, stream) != hipSuccess) return;
    Args a{};
    for (int i = 0; i < N_IN; ++i) a.in[i] = (const float*)d_in[i];
    a.out = (float*)d_out; a.ws = (unsigned char*)d_ws;
#if MK_ONE_LAUNCH
    a.ph_lo = 0; a.ph_hi = NPHASE;
    hipLaunchKernelGGL(fwd_kernel, dim3(grid), dim3(NTHR), LDS_BYTES, stream, a);
#else
    for (int ph = 0; ph < NPHASE; ++ph) { if (!phase_exists(ph)) continue; a.ph_lo = ph; a.ph_hi = ph + 1; hipLaunchKernelGGL(fwd_kernel, dim3(grid), dim3(NTHR), LDS_BYTES, stream, a); }
#endif
}
```

```cpp
#define MK_ONE_LAUNCH 1
#include <hip/hip_runtime.h>
#include <cstdio>
#include <cstdint>

#define GAS __attribute__((address_space(1)))
#define LAS __attribute__((address_space(3)))
typedef unsigned short bf16;
typedef unsigned v4u __attribute__((ext_vector_type(4)));
typedef unsigned v2u __attribute__((ext_vector_type(2)));
typedef float f32x4 __attribute__((ext_vector_type(4)));
typedef float f32x2 __attribute__((ext_vector_type(2)));
typedef short bf16x8 __attribute__((ext_vector_type(8)));
#define LDS_WAIT() asm volatile("s_waitcnt lgkmcnt(0)" ::: "memory")
#define VM_WAIT() asm volatile("s_waitcnt vmcnt(0)" ::: "memory")

constexpr int DM = 1024, NB = 8, SEQ = 4096, DEPTH = 4, CTXL = 256, GW = 256, HD = 64, NH = 4;
constexpr int T_LAT = NB * SEQ, T_CTX = NB * CTXL, T_ALL = T_LAT + T_CTX;
constexpr int IN_COLS = 3552, PLD = 3584;
constexpr int OFF_B = 512, OFF_C = 1472, OFF_D = 2512, B_COLS = 960;
constexpr int DFF = 2816, NE = 8, DFE = 1408;
constexpr int NCH = 68;
constexpr int NSTEP = 4352;
constexpr int MOE_MAXBLK = 280;
constexpr int NWAVES = 8, NTHR = 512;
#ifndef RW_VSPLIT
#define RW_VSPLIT 0
#endif

constexpr size_t MiB = 1u << 20;
constexpr size_t WS_CTL = 0, CTL_BYTES = 1 * MiB;
constexpr size_t WS_MODV = 1 * MiB;
constexpr size_t WS_XC = 2 * MiB;
constexpr size_t WS_WIN = 10 * MiB;
constexpr size_t WS_WOUT = 17 * MiB;
constexpr size_t WS_WGU = 19 * MiB;
constexpr size_t WS_WDN = 63 * MiB;
constexpr size_t WS_HB = 85 * MiB;
constexpr size_t WS_P = 153 * MiB;
constexpr size_t WS_MIX = 391 * MiB;
constexpr size_t WS_OUTB = WS_MIX, WS_OUTC = WS_MIX + 34 * MiB, WS_OUTD = WS_MIX + 68 * MiB, WS_GQ = WS_MIX + 102 * MiB, WS_G = WS_MIX + 153 * MiB;
constexpr size_t WS_XLAST = WS_MIX + 144 * MiB;
constexpr size_t WS_RKV = WS_MIX + 170 * MiB;
constexpr size_t WS_SMALL = 612 * MiB;
constexpr size_t WS_ROUTE = WS_SMALL;
constexpr size_t WS_POS = WS_SMALL + 1280 * 1024;
constexpr size_t WS_TOK = WS_SMALL + 1664 * 1024;
constexpr size_t WS_BONUS = WS_SMALL + 2 * MiB;
constexpr size_t WS_RINV = WS_SMALL + 2 * MiB + 640 * 1024;
constexpr size_t WS_WGBASE = WS_SMALL + 3 * MiB + 256 * 1024;
constexpr size_t WS_TAB = WS_WGBASE + 65536;
constexpr size_t WS_LRUWT = WS_SMALL + 3 * MiB + 512 * 1024;
constexpr size_t WS_RWT = WS_LRUWT + 131072;
constexpr size_t WS_LRUH = WS_SMALL + 4 * MiB;
constexpr size_t WS_END = 633 * MiB;
constexpr int CW_MOECNT = 1024;
constexpr int CW_PREPQ = 2048;
constexpr int CW_BAR = 4096;

constexpr int LDS_BYTES = 135168;
constexpr int MISC_OFF = 131072;

__device__ __forceinline__ unsigned f2bf(float f) { unsigned u = __builtin_bit_cast(unsigned, f); return (u + 0x7fffu + ((u >> 16) & 1u)) >> 16; }
typedef __bf16 bf16n2 __attribute__((ext_vector_type(2)));
__device__ __forceinline__ unsigned pk2(float lo, float hi) { const f32x2 v = {lo, hi}; return __builtin_bit_cast(unsigned, __builtin_convertvector(v, bf16n2)); }
__device__ __forceinline__ unsigned f2bf1(float f) { return pk2(f, f) & 0xffffu; }
__device__ __forceinline__ float bf2f(unsigned short v) { return __builtin_bit_cast(float, (unsigned)v << 16); }
__device__ __forceinline__ float bflo(unsigned v) { return __builtin_bit_cast(float, v << 16); }
__device__ __forceinline__ float bfhi(unsigned v) { return __builtin_bit_cast(float, v & 0xffff0000u); }
template <int CTRL, int RM, bool BC> __device__ __forceinline__ float dpp_x(float oldv, float v) { return __builtin_bit_cast(float, __builtin_amdgcn_update_dpp(__builtin_bit_cast(int, oldv), __builtin_bit_cast(int, v), CTRL, RM, 0xF, BC)); }
__device__ __forceinline__ float wave_sum(float v) {
    v += dpp_x<0xB1, 0xF, true>(0.f, v); v += dpp_x<0x4E, 0xF, true>(0.f, v); v += dpp_x<0x141, 0xF, true>(0.f, v); v += dpp_x<0x140, 0xF, true>(0.f, v);
    v += dpp_x<0x142, 0xA, false>(0.f, v); v += dpp_x<0x143, 0xC, false>(0.f, v);
    return __builtin_bit_cast(float, __builtin_amdgcn_readlane(__builtin_bit_cast(int, v), 63));
}
template <int CTRL> __device__ __forceinline__ float dpp_f(float v) { return __builtin_bit_cast(float, __builtin_amdgcn_update_dpp(0, __builtin_bit_cast(int, v), CTRL, 0xF, 0xF, true)); }
__device__ __forceinline__ float row16_sum(float v) {
    v += dpp_f<0xB1>(v);
    v += dpp_f<0x4E>(v);
    v += dpp_f<0x141>(v);
    v += dpp_f<0x140>(v);
    return v;
}
__device__ __forceinline__ float sigmoidf_(float x) { return __builtin_amdgcn_rcpf(1.0f + __expf(-x)); }
__device__ __forceinline__ float softplusf_(float x) { return fmaxf(x, 0.f) + __logf(1.0f + __expf(-fabsf(x))); }
__device__ __forceinline__ float expm1f_(float x) { return x > -0.3f ? x * (1.0f + x * (0.5f + x * (0.16666667f + x * (0.041666668f + x * 0.0083333338f)))) : __expf(x) - 1.0f; }
__device__ __forceinline__ float siluf_(float x) { return x * __builtin_amdgcn_rcpf(1.0f + __expf(-x)); }
__device__ __forceinline__ float tanhf_(float x) { const float e = __expf(2.0f * x); return 1.0f - 2.0f * __builtin_amdgcn_rcpf(e + 1.0f); }
__device__ __forceinline__ float rsqrtf_(float x) { return __builtin_amdgcn_rsqf(x); }
__device__ __forceinline__ float gelu_tanh(float x) { return 0.5f * x * (1.0f + tanhf_(0.7978845608028654f * (x + 0.044715f * x * x * x))); }
__device__ __forceinline__ f32x4 ld4bf(const bf16* p) { const v2u a = *(const v2u*)p; return (f32x4){bflo(a.x), bfhi(a.x), bflo(a.y), bfhi(a.y)}; }
__device__ __forceinline__ void st4bf(bf16* p, const f32x4& v) { v2u o; o.x = pk2(v.x, v.y); o.y = pk2(v.z, v.w); *(v2u*)p = o; }
#define XB_TMO      128
#define XB_XCNT(j)  (256  + 64 * (j))
#define XB_XSUB(j)  (1280 + 64 * (j))
#define XB_XGEN(j)  (2304 + 64 * (j))
#define XB_TOP      3328
#define XB_TOPGEN   3392
#define XCD_BAR_WORDS 3456
#define XB_SPIN_CAP (1u << 22)

__device__ __forceinline__ unsigned xb_ld(unsigned* p)              { return __hip_atomic_load(p, __ATOMIC_RELAXED, __HIP_MEMORY_SCOPE_AGENT); }
__device__ __forceinline__ unsigned xb_add(unsigned* p, unsigned v) { return __hip_atomic_fetch_add(p, v, __ATOMIC_RELAXED, __HIP_MEMORY_SCOPE_AGENT); }
__device__ __forceinline__ unsigned xb_xcc_id() { return (unsigned)__builtin_amdgcn_s_getreg((3 << 11) | 20) & 0xFu; }
#define XB_SPIN(cond, bar) do { unsigned _sp = 0; while (cond) { __builtin_amdgcn_s_sleep(1); \
    if ((++_sp & 255u) == 0u) { if (xb_ld(&(bar)[XB_TMO])) break; if (_sp > XB_SPIN_CAP) { atomicAdd(&(bar)[XB_TMO], 1u); break; } } } } while (0)

struct XcdBarrier {
    unsigned* bar; unsigned x;
    volatile LAS unsigned* st;
};

__device__ __forceinline__ XcdBarrier xcd_barrier_post(unsigned* bar, volatile LAS unsigned* st) {
    XcdBarrier b; b.bar = bar; b.x = xb_xcc_id(); b.st = st;
    if (threadIdx.x == 0) (void)xb_add(&bar[XB_XCNT(b.x)], 1u);
    return b;
}
__device__ __forceinline__ void xcd_barrier_complete(unsigned* bar, unsigned x, unsigned& nloc, unsigned& nx) {
    const unsigned G = gridDim.x * gridDim.y * gridDim.z;
    unsigned sum, cnt, mine, sp = 0u;
    for (;;) {
        sum = 0u; cnt = 0u; mine = 0u;
#pragma unroll
        for (unsigned j = 0; j < 16; ++j) { const unsigned c = xb_ld(&bar[XB_XCNT(j)]); sum += c; cnt += (c > 0u) ? 1u : 0u; mine = (j == x) ? c : mine; }
        if (sum == G) break;
        __builtin_amdgcn_s_sleep(1);
        if ((++sp & 255u) == 0u) { if (xb_ld(&bar[XB_TMO])) break; if (sp > XB_SPIN_CAP) { atomicAdd(&bar[XB_TMO], 1u); break; } }
    }
    nloc = mine > 0u ? mine : 1u; nx = cnt > 0u ? cnt : 1u;
}

__device__ __forceinline__ void xcd_barrier(const XcdBarrier& b) {
    asm volatile("s_waitcnt vmcnt(0)" ::: "memory");
    __syncthreads();
    if (threadIdx.x == 0) {
        unsigned* bar = b.bar;
        __builtin_amdgcn_s_waitcnt(0);
        unsigned nloc = b.st[0], nx = b.st[1];
        if (nloc == 0u) { xcd_barrier_complete(bar, b.x, nloc, nx); b.st[0] = nloc; b.st[1] = nx; }
        const unsigned old = xb_add(&bar[XB_XSUB(b.x)], 1u);
        const unsigned gen = old / nloc;
        if (old + 1u == (gen + 1u) * nloc) {
            __builtin_amdgcn_fence(__ATOMIC_RELEASE, "agent");
            asm volatile("s_waitcnt vmcnt(0)" ::: "memory");
            const unsigned og = xb_add(&bar[XB_TOP], 1u);
            const unsigned tg = og / nx;
            if (og + 1u == (tg + 1u) * nx) xb_add(&bar[XB_TOPGEN], 1u);
            else XB_SPIN(xb_ld(&bar[XB_TOPGEN]) == tg, bar);
            __builtin_amdgcn_fence(__ATOMIC_ACQUIRE, "agent");
            xb_add(&bar[XB_XGEN(b.x)], 1u);
            asm volatile("s_waitcnt vmcnt(0)" ::: "memory");
        } else {
            XB_SPIN(xb_ld(&bar[XB_XGEN(b.x)]) == gen, bar);
            __builtin_amdgcn_fence(__ATOMIC_ACQUIRE, "agent");
            asm volatile("s_waitcnt vmcnt(0)" ::: "memory");
        }
    }
    __syncthreads();
}

namespace pg8 {
#define PG8_LAS __attribute__((address_space(3)))
typedef unsigned short bf16_t;
typedef short bf16x8 __attribute__((ext_vector_type(8)));
typedef float f32x4 __attribute__((ext_vector_type(4)));
typedef unsigned u32x4 __attribute__((ext_vector_type(4)));
constexpr int BM = 256, BK = 64, HALF = 128, HTB = HALF * BK * 2  , STAGE_BYTES = 8 * HTB, NXCD = 8, WGM = 8;

__host__ __device__ __forceinline__ int lds_byte(int r, int c) { const int st = (r >> 4) * 2 + (c >> 5), rr = r & 15, cc = c & 31, ob = rr * 64 + cc * 2; return st * 1024 + (ob ^ (((ob >> 9) & 1) << 5)); }
__host__ __device__ __forceinline__ void stage_rc(int b, int& R, int& C) { const int st = b / 1024, sb = b % 1024, swz = sb ^ (((sb >> 9) & 1) << 5); R = (st >> 1) * 16 + swz / 64; C = (st & 1) * 32 + (swz % 64) / 2; }
__host__ __device__ __forceinline__ int perm32(int rho) { const int n = rho >> 4, i = rho & 15; return 8 * (i >> 2) + 4 * n + (i & 3); }

struct Unit { int pm, pn, e; };
struct Gemm { const bf16_t* A; const bf16_t* Bt; int M, N, K; size_t estride; };

struct StaticOrder {
    static constexpr bool GATHER = false;
    int nM, nN, nwg, G, c;
    __host__ __device__ void init(int M, int N, int G_, int c_) { nM = M / BM; nN = N / BM; nwg = nM * nN; G = G_; c = c_; }
    __host__ __device__ bool next(int i, Unit& u) const {
        const long L = (long)i * G + c; if (L >= nwg) return false;
        int wgid = (int)L; { const int q = nwg / NXCD, r = nwg % NXCD, xcd = wgid % NXCD, off = wgid / NXCD; wgid = (xcd < r ? xcd * (q + 1) : r * (q + 1) + (xcd - r) * q) + off; }
        const int nig = WGM * nN, gid = wgid / nig, fm = gid * WGM, gsz = (nM - fm) < WGM ? (nM - fm) : WGM;
        u.pm = fm + ((wgid % nig) % gsz); u.pn = (wgid % nig) / gsz; u.e = 0; return true;
    }
    __device__ __forceinline__ void a_ready(const Unit&) const {}
    __device__ __forceinline__ void done(const Unit&) const {}
};
typedef __bf16 bf16n2_ __attribute__((ext_vector_type(2)));
__device__ __forceinline__ unsigned cvt_pk_bf16(float lo, float hi) { typedef float f2_ __attribute__((ext_vector_type(2))); const f2_ v = {lo, hi}; return __builtin_bit_cast(unsigned, __builtin_convertvector(v, bf16n2_)); }
typedef float f32x2 __attribute__((ext_vector_type(2)));
__device__ __forceinline__ f32x2 gelu_pk(f32x2 v) {
    const f32x2 av = __builtin_elementwise_abs(v), d = av * 0.2316418882f + 1.0f;
    f32x2 t; t.x = __builtin_amdgcn_rcpf(d.x); t.y = __builtin_amdgcn_rcpf(d.y);
    f32x2 q = t * 0.5307027145f + (-0.7265760135f); q = q * t + 0.7107068705f; q = q * t + (-0.142248368f); q = q * t + 0.127414796f; q = q * t;
    const f32x2 s = (v * v) * (-0.72134752044f);
    f32x2 e; e.x = __builtin_amdgcn_exp2f(s.x); e.y = __builtin_amdgcn_exp2f(s.y);
    const f32x2 m = v * (q * e), r = v - m;
    f32x2 o; o.x = v.x < 0.f ? m.x : r.x; o.y = v.y < 0.f ? m.y : r.y; return o;
}

struct EpiF32 {
    static constexpr bool PERM = false, AFTER_DRAIN = false;
    float* C; int ldc; const float* bias;
    __device__ __forceinline__ void operator()(const f32x4 (&acc)[2][2][4][2], const Unit& u, int wr, int wc, int fr, int fq) const {
        const int row0 = u.pm * BM + wr * 64 + fr, col0 = u.pn * BM + wc * 32 + 4 * fq;
        f32x4 bv[2][2];
#pragma unroll
        for (int bj = 0; bj < 2; ++bj)
#pragma unroll
            for (int n = 0; n < 2; ++n) bv[bj][n] = bias ? *(const f32x4*)(bias + col0 + bj * HALF + n * 16) : (f32x4){0.f, 0.f, 0.f, 0.f};
#pragma unroll
        for (int ai = 0; ai < 2; ++ai)
#pragma unroll
            for (int m = 0; m < 4; ++m) { float* rowp = C + (size_t)(row0 + ai * HALF + m * 16) * ldc + col0;
#pragma unroll
                for (int bj = 0; bj < 2; ++bj)
#pragma unroll
                    for (int n = 0; n < 2; ++n) *(f32x4*)(rowp + bj * HALF + n * 16) = acc[ai][bj][m][n] + bv[bj][n]; }
    }
};
template <int ACT  > struct EpiBf16 {
    static constexpr bool PERM = true, AFTER_DRAIN = false;
    bf16_t* O; int ldc; const float* bias; int split_cols; size_t split_stride;
    __device__ __forceinline__ void operator()(const f32x4 (&acc)[2][2][4][2], const Unit& u, int wr, int wc, int fr, int fq) const {
        const int row0 = u.pm * BM + wr * 64 + fr; int colt = u.pn * BM; bf16_t* base = O;
        if (split_cols) { const int t = colt / split_cols; base += (size_t)t * split_stride; colt -= t * split_cols; }
        const int col0 = colt + wc * 32 + 8 * fq, bcol0 = u.pn * BM + wc * 32 + 8 * fq;
        f32x4 bv[2][2];
#pragma unroll
        for (int bj = 0; bj < 2; ++bj)
#pragma unroll
            for (int n = 0; n < 2; ++n) bv[bj][n] = bias ? *(const f32x4*)(bias + bcol0 + bj * HALF + 4 * n) : (f32x4){0.f, 0.f, 0.f, 0.f};
#pragma unroll
        for (int ai = 0; ai < 2; ++ai)
#pragma unroll
            for (int m = 0; m < 4; ++m) { bf16_t* rowp = base + (size_t)(row0 + ai * HALF + m * 16) * ldc + col0;
#pragma unroll
                for (int bj = 0; bj < 2; ++bj) { f32x4 v0 = acc[ai][bj][m][0] + bv[bj][0], v1 = acc[ai][bj][m][1] + bv[bj][1];
                    if (ACT == 1) { f32x2 a = gelu_pk((f32x2){v0[0], v0[1]}), b = gelu_pk((f32x2){v0[2], v0[3]}), c = gelu_pk((f32x2){v1[0], v1[1]}), d = gelu_pk((f32x2){v1[2], v1[3]});
                        v0 = (f32x4){a.x, a.y, b.x, b.y}; v1 = (f32x4){c.x, c.y, d.x, d.y}; }
                    if (ACT == 2) {
#pragma unroll
                        for (int j = 0; j < 4; ++j) { v0[j] = 0.5f * v0[j] * (1.0f + erff(v0[j] * 0.70710678f)); v1[j] = 0.5f * v1[j] * (1.0f + erff(v1[j] * 0.70710678f)); } }
                    u32x4 w; w.x = cvt_pk_bf16(v0[0], v0[1]); w.y = cvt_pk_bf16(v0[2], v0[3]); w.z = cvt_pk_bf16(v1[0], v1[1]); w.w = cvt_pk_bf16(v1[2], v1[3]);
                    *(u32x4*)(rowp + bj * HALF) = w; } }
    }
};

template <class Epi, class Sched, bool STAMP = false>
__device__ __forceinline__ void gemm_phase(PG8_LAS unsigned char* lds, const Gemm g, const Sched& S, const Epi& E, unsigned long long* stamps) {
    int tid_ = threadIdx.x; asm volatile("" : "+v"(tid_));
    const int tid = tid_, wid = __builtin_amdgcn_readfirstlane(tid >> 6), lane = tid & 63, wr = wid >> 2, wc = wid & 3, fr = lane & 15, fq = lane >> 4;
    const int K = g.K, nt = K / BK;
    constexpr bool GATHER = Sched::GATHER;
    int ts_lo = 0, ts_hi = 0, nts = 0; const unsigned long long rt_entry = STAMP ? (unsigned long long)wall_clock64() : 0ull;
#define PG8_STAMP() do { if (STAMP && wid == 0 && nts < 64) { const unsigned long long _c = (unsigned long long)clock64(); \
        ts_lo = (lane == nts) ? (int)(unsigned)_c : ts_lo; ts_hi = (lane == nts) ? (int)(unsigned)(_c >> 32) : ts_hi; ++nts; } } while (0)
    PG8_STAMP();
    unsigned voffA[2], voffB[2]; int rowA[2];
#pragma unroll
    for (int i = 0; i < 2; ++i) { int R, C; stage_rc(tid * 16 + i * 8192, R, C); const int Rb = Epi::PERM ? ((R & ~31) + perm32(R & 31)) : R;
        rowA[i] = R; voffA[i] = GATHER ? (unsigned)C * 2u : (unsigned)(R * K + C) * 2u; voffB[i] = (unsigned)(Rb * K + C) * 2u; }
    const size_t kstep = (size_t)(BK * 2);
    const size_t hstep = (size_t)HALF * K * 2;
    const size_t tstep = 2 * hstep;
    const unsigned ldsw = (unsigned)wid * 1024u;
    const int aoff = lds_byte(wr * 64 + fr, fq * 8), boff = lds_byte(wc * 32 + fr, fq * 8);
#define PG8_SA(b, h) (((b) * 2 + (h)) * HTB)
#define PG8_SB(b, h) ((4 + (b) * 2 + (h)) * HTB)
#define PG8_STAGE(bufoff, gbase, voff) do { _Pragma("unroll") for (int _i = 0; _i < 2; ++_i) \
        __builtin_amdgcn_global_load_lds((const unsigned*)((const char*)(gbase) + (voff)[_i]), (PG8_LAS unsigned*)(lds + (bufoff) + ldsw + _i * 8192), 16, 0, 0); } while (0)
#define PG8_STAGE_A(bufoff, gbase, h, gv) do { if constexpr (GATHER) { PG8_STAGE(bufoff, gbase, (gv)[h]); } else { PG8_STAGE(bufoff, (gbase) + (h) * hstep, voffA); } } while (0)
#define PG8_TOKSLOT(s) ((PG8_LAS int*)(lds + STAGE_BYTES + 1024 + ((s) & 1) * 1024))
#define PG8_LDA(dst, b, h) do { _Pragma("unroll") for (int m = 0; m < 4; ++m) _Pragma("unroll") for (int k = 0; k < 2; ++k) dst[m][k] = *(const PG8_LAS bf16x8*)(lds + PG8_SA(b, h) + aoff + m * 2048 + k * 1024); } while (0)
#define PG8_LDB(dst, b, h) do { _Pragma("unroll") for (int n = 0; n < 2; ++n) _Pragma("unroll") for (int k = 0; k < 2; ++k) dst[n][k] = *(const PG8_LAS bf16x8*)(lds + PG8_SB(b, h) + boff + n * 2048 + k * 1024); } while (0)
#define PG8_MMA(ai, bj, At, Bt) do { __builtin_amdgcn_s_setprio(1); _Pragma("unroll") for (int m = 0; m < 4; ++m) _Pragma("unroll") for (int n = 0; n < 2; ++n) _Pragma("unroll") for (int k = 0; k < 2; ++k) \
        acc[ai][bj][m][n] = __builtin_amdgcn_mfma_f32_16x16x32_bf16(Bt[n][k], At[m][k], acc[ai][bj][m][n], 0, 0, 0); __builtin_amdgcn_s_setprio(0); } while (0)
#define PG8_WAIT_V(n) asm volatile("s_waitcnt vmcnt(" #n ")" ::: "memory")
#define PG8_WAIT_L(n) asm volatile("s_waitcnt lgkmcnt(" #n ")" ::: "memory")
#define PG8_BAR __builtin_amdgcn_s_barrier()
#define PG8_SCHED __builtin_amdgcn_sched_barrier(0)
    Unit cur, nxt; int ui = 0;
    if (!S.next(0, cur)) return;
    f32x4 acc[2][2][4][2];
#pragma unroll
    for (int a = 0; a < 2; ++a)
#pragma unroll
        for (int b = 0; b < 2; ++b)
#pragma unroll
            for (int m = 0; m < 4; ++m)
#pragma unroll
                for (int n = 0; n < 2; ++n) acc[a][b][m][n] = (f32x4){0.f, 0.f, 0.f, 0.f};
    bf16x8 At[4][2], B0[2][2], B1[2][2];
    const char* cA = (const char*)g.A + (GATHER ? (size_t)0 : (size_t)cur.pm * tstep); const char* cB = (const char*)g.Bt + (size_t)cur.pn * tstep + (size_t)cur.e * g.estride * 2;
    S.a_ready(cur);
    unsigned gcur[2][2], gnxt[2][2], gs[2][2];
    if constexpr (GATHER) {
        if (tid < 256) PG8_TOKSLOT(0)[tid] = S.tok[cur.pm * 256 + tid];
        __syncthreads();
#pragma unroll
        for (int h = 0; h < 2; ++h)
#pragma unroll
            for (int i = 0; i < 2; ++i) { gcur[h][i] = (unsigned)PG8_TOKSLOT(0)[h * HALF + rowA[i]] * (unsigned)(K * 2) + voffA[i]; gnxt[h][i] = gcur[h][i]; gs[h][i] = gcur[h][i]; }
    }
    PG8_STAGE(PG8_SB(0, 0), cB, voffB); PG8_STAGE_A(PG8_SA(0, 0), cA, 0, gcur); PG8_STAGE(PG8_SB(0, 1), cB + hstep, voffB); PG8_STAGE_A(PG8_SA(0, 1), cA, 1, gcur);
    if (wr == 1) PG8_BAR;
    PG8_WAIT_V(4); PG8_BAR;
    PG8_STAGE(PG8_SB(1, 0), cB + kstep, voffB); PG8_STAGE_A(PG8_SA(1, 0), cA + kstep, 0, gcur); PG8_STAGE(PG8_SB(1, 1), cB + hstep + kstep, voffB);
    PG8_WAIT_V(6); PG8_BAR;
    PG8_STAMP();
    for (;;) {
        const bool has_next = S.next(ui + 1, nxt);
        if constexpr (GATHER) { if (has_next && wid < 4)
            __builtin_amdgcn_global_load_lds((const unsigned*)(S.tok + nxt.pm * 256 + wid * 64 + lane), (PG8_LAS unsigned*)((PG8_LAS unsigned char*)PG8_TOKSLOT(ui + 1) + wid * 256), 4, 0, 0); }
        const char* nA = GATHER ? (const char*)g.A : has_next ? (const char*)g.A + (size_t)nxt.pm * tstep : cA; const char* nB = has_next ? (const char*)g.Bt + (size_t)nxt.pn * tstep + (size_t)nxt.e * g.estride * 2 : cB;
        for (int t = 0; t < nt; t += 2) {
            const bool last = (t == nt - 2);
            const char* a1 = cA + (size_t)(t + 1) * kstep;
            const char* a2 = last ? nA : cA + (size_t)(t + 2) * kstep; const char* b2 = last ? nB : cB + (size_t)(t + 2) * kstep;
            const char* a3 = a2 + kstep; const char* b3 = b2 + kstep;
            if (last && has_next) S.a_ready(nxt);
            if constexpr (GATHER) {
                if (last && has_next) {
#pragma unroll
                    for (int h = 0; h < 2; ++h)
#pragma unroll
                        for (int i = 0; i < 2; ++i) gnxt[h][i] = (unsigned)PG8_TOKSLOT(ui + 1)[h * HALF + rowA[i]] * (unsigned)(K * 2) + voffA[i];
                }
#pragma unroll
                for (int h = 0; h < 2; ++h)
#pragma unroll
                    for (int i = 0; i < 2; ++i) gs[h][i] = last ? gnxt[h][i] : gcur[h][i];
            }
            PG8_LDB(B0, 0, 0); PG8_SCHED; PG8_LDA(At, 0, 0); PG8_STAGE_A(PG8_SA(1, 1), a1, 1, gcur);
            PG8_WAIT_L(8); PG8_BAR; PG8_WAIT_L(0); PG8_MMA(0, 0, At, B0); PG8_BAR; PG8_SCHED;
            PG8_LDB(B1, 0, 1); PG8_STAGE(PG8_SB(0, 0), b2, voffB);
            PG8_BAR; PG8_WAIT_L(0); PG8_MMA(0, 1, At, B1); PG8_BAR;
            PG8_LDA(At, 0, 1); PG8_STAGE_A(PG8_SA(0, 0), a2, 0, gs);
            PG8_BAR; PG8_WAIT_L(0); PG8_MMA(1, 0, At, B0); PG8_BAR; PG8_SCHED;
            PG8_STAGE(PG8_SB(0, 1), b2 + hstep, voffB);
            PG8_WAIT_V(6); PG8_BAR; PG8_MMA(1, 1, At, B1); PG8_BAR;
            PG8_LDB(B0, 1, 0); PG8_SCHED; PG8_LDA(At, 1, 0); PG8_STAGE_A(PG8_SA(0, 1), a2, 1, gs);
            PG8_WAIT_L(8); PG8_BAR; PG8_WAIT_L(0); PG8_MMA(0, 0, At, B0); PG8_BAR; PG8_SCHED;
            PG8_LDB(B1, 1, 1); PG8_STAGE(PG8_SB(1, 0), b3, voffB);
            PG8_BAR; PG8_WAIT_L(0); PG8_MMA(0, 1, At, B1); PG8_BAR;
            PG8_LDA(At, 1, 1); PG8_STAGE_A(PG8_SA(1, 0), a3, 0, gs);
            PG8_BAR; PG8_WAIT_L(0); PG8_MMA(1, 0, At, B0); PG8_BAR; PG8_SCHED;
            PG8_STAGE(PG8_SB(1, 1), b3 + hstep, voffB);
            PG8_WAIT_V(6); PG8_BAR; PG8_MMA(1, 1, At, B1); PG8_BAR;
        }
        PG8_STAMP();
        if constexpr (!Epi::AFTER_DRAIN) { E(acc, cur, wr, wc, fr, fq); S.done(cur); }
        PG8_STAMP();
        if (!has_next) break;
#pragma unroll
        for (int a = 0; a < 2; ++a)
#pragma unroll
            for (int b = 0; b < 2; ++b)
#pragma unroll
                for (int m = 0; m < 4; ++m)
#pragma unroll
                    for (int n = 0; n < 2; ++n) acc[a][b][m][n] = (f32x4){0.f, 0.f, 0.f, 0.f};
        cur = nxt; cA = nA; cB = nB; ++ui;
        if constexpr (GATHER) {
#pragma unroll
            for (int h = 0; h < 2; ++h)
#pragma unroll
                for (int i = 0; i < 2; ++i) gcur[h][i] = gnxt[h][i];
        }
    }
    PG8_WAIT_V(0);
    if (wr == 0) PG8_BAR;
    PG8_BAR;
    if constexpr (Epi::AFTER_DRAIN) { E.fused(acc, cur, wr, wc, fr, fq, lds, wid, lane); S.done(cur); }
    PG8_STAMP();
    if (STAMP && wid == 0) { stamps[lane] = lane < nts ? (((unsigned long long)(unsigned)ts_hi << 32) | (unsigned)ts_lo) : 0ull;
        if (lane == 62) stamps[62] = rt_entry; if (lane == 63) stamps[63] = (unsigned long long)wall_clock64(); }
#undef PG8_STAMP
#undef PG8_SA
#undef PG8_SB
#undef PG8_STAGE
#undef PG8_STAGE_A
#undef PG8_TOKSLOT
#undef PG8_LDA
#undef PG8_LDB
#undef PG8_MMA
#undef PG8_WAIT_V
#undef PG8_WAIT_L
#undef PG8_BAR
#undef PG8_SCHED
}
}
namespace pg8 {
struct EpiRes {
    static constexpr bool PERM = true, AFTER_DRAIN = false;
    const void* base_lat; const float* base_ctx; void* out_lat; float* out_ctx; const float* gvec; bool base_bf, out_bf;
    __device__ __forceinline__ void operator()(const f32x4 (&acc)[2][2][4][2], const Unit& u, int wr, int wc, int fr, int fq) const {
        const bool isctx = u.pm >= 128;
        const int prow = (isctx ? (u.pm - 128) : u.pm) * BM;
        const float* base = isctx ? base_ctx : (const float*)base_lat; float* out = isctx ? out_ctx : (float*)out_lat;
        const bool bbf = !isctx && base_bf, obf = !isctx && out_bf;
        const float* gv = gvec + (size_t)(isctx ? 8 : (u.pm >> 4)) * 6144;
        const int row0 = prow + wr * 64 + fr, col0 = u.pn * BM + wc * 32 + 8 * fq;
        f32x4 gvv[2][2];
#pragma unroll
        for (int bj = 0; bj < 2; ++bj)
#pragma unroll
            for (int n = 0; n < 2; ++n) gvv[bj][n] = *(const f32x4*)(gv + col0 + bj * HALF + 4 * n);
#pragma unroll
        for (int ai = 0; ai < 2; ++ai)
#pragma unroll
            for (int m = 0; m < 4; ++m) { const size_t off = (size_t)(row0 + ai * HALF + m * 16) * 1024 + col0;
#pragma unroll
                for (int bj = 0; bj < 2; ++bj) { const size_t o2 = off + bj * HALF;
                    f32x4 b0, b1;
                    if (bbf) { const v4u r = *(const v4u*)((const bf16*)base_lat + o2); b0 = (f32x4){bflo(r.x), bfhi(r.x), bflo(r.y), bfhi(r.y)}; b1 = (f32x4){bflo(r.z), bfhi(r.z), bflo(r.w), bfhi(r.w)}; }
                    else { b0 = *(const f32x4*)(base + o2); b1 = *(const f32x4*)(base + o2 + 4); }
                    const f32x4 v0 = b0 + gvv[bj][0] * acc[ai][bj][m][0], v1 = b1 + gvv[bj][1] * acc[ai][bj][m][1];
                    if (obf) { v4u w; w.x = pk2(v0.x, v0.y); w.y = pk2(v0.z, v0.w); w.z = pk2(v1.x, v1.y); w.w = pk2(v1.z, v1.w); *(v4u*)((bf16*)out_lat + o2) = w; }
                    else { *(f32x4*)(out + o2) = v0; *(f32x4*)(out + o2 + 4) = v1; } } }
    }
};
struct EpiSwiglu {
    static constexpr bool PERM = true, AFTER_DRAIN = false;
    bf16_t* O; int ldc;
    __device__ __forceinline__ void operator()(const f32x4 (&acc)[2][2][4][2], const Unit& u, int wr, int wc, int fr, int fq) const {
        const int row0 = u.pm * BM + wr * 64 + fr, col0 = u.pn * HALF + wc * 32 + 8 * fq;
#pragma unroll
        for (int ai = 0; ai < 2; ++ai)
#pragma unroll
            for (int m = 0; m < 4; ++m) { bf16_t* rowp = O + (size_t)(row0 + ai * HALF + m * 16) * ldc + col0;
                float h[8];
#pragma unroll
                for (int n = 0; n < 2; ++n)
#pragma unroll
                    for (int j = 0; j < 4; ++j) { const float g = acc[ai][0][m][n][j], up = acc[ai][1][m][n][j]; h[n * 4 + j] = g * __builtin_amdgcn_rcpf(1.0f + __expf(-g)) * up; }
                u32x4 w; w.x = cvt_pk_bf16(h[0], h[1]); w.y = cvt_pk_bf16(h[2], h[3]); w.z = cvt_pk_bf16(h[4], h[5]); w.w = cvt_pk_bf16(h[6], h[7]);
                *(u32x4*)rowp = w; }
    }
};
struct MoeOrder {
    static constexpr bool GATHER = false;
    int nN, G, c, nunits; const int* tab;
    __device__ void init(const int* tab_, int nN_, int G_, int c_) { tab = tab_; nN = nN_; G = G_; c = c_; nunits = tab_[0] * nN_; }
    __device__ bool next(int i, Unit& u) const {
        const int L = i * G + c; if (L >= nunits) return false;
        const int q = nunits / NXCD, r = nunits % NXCD, xcd = L % NXCD, off = L / NXCD;
        const int w = (xcd < r ? xcd * (q + 1) : r * (q + 1) + (xcd - r) * q) + off;
        u.pm = w / nN; u.pn = w - u.pm * nN; u.e = tab[1 + u.pm]; return true;
    }
    __device__ __forceinline__ void a_ready(const Unit&) const {}
    __device__ __forceinline__ void done(const Unit&) const {}
};
struct MoeOrderG : MoeOrder { static constexpr bool GATHER = true; const int* tok; };
}
enum { I_X = 0, I_C, I_CTX, I_CCTX, I_MODW, I_MODB, I_NMIXG, I_NFFNG, I_WIN, I_WOUT, I_LCW, I_LCB, I_LWA, I_LBA, I_LWX, I_LBX, I_LLAM,
       I_RMU, I_RWUP, I_RW0, I_RAUP, I_RA0, I_RGUP, I_RKK, I_RKA, I_RRK, I_RLNG, I_RLNB, I_MIB, I_MFB, I_MNG, I_GCW, I_GALOG, I_GDTB, I_GNG,
       I_FWG, I_FWU, I_FWD, I_MROUTER, I_MWG, I_MWU, I_MWD, I_FNG, N_IN };
struct Args { const float* in[N_IN]; float* out; unsigned char* ws; int ph_lo, ph_hi; };
struct Ctx {
    const float* const* in; float* out; unsigned char* ws; LAS unsigned char* lds;
    int tid, lane, wave, G, wg;
};
#define WSP(T, off) ((T*)(C.ws + (off)))

__device__ __forceinline__ int seqrow_raster(int i, int d, int b) {
    if (i < CTXL) { const int p = d ? (CTXL - 1 - i) : i; return T_LAT + b * CTXL + p; }
    const int j = i - CTXL; const int p = d ? (SEQ - 1 - j) : j; return b * SEQ + p;
}
__device__ __forceinline__ int seqrow_cm(int i, int d, int b) {
    if (i < CTXL) { const int p = d ? (CTXL - 1 - i) : i; return T_LAT + b * CTXL + p; }
    const int j = i - CTXL; const int p = d ? (SEQ - 1 - j) : j; return b * SEQ + (p & 63) * 64 + (p >> 6);
}

__device__ __forceinline__ void phase_pre(const Ctx& C) {
    LAS float* sc = (LAS float*)C.lds;
    LAS float* red = sc + 9 * 1024;
    float* modv = WSP(float, WS_MODV);
    bool filled = false;
    for (int it = C.wg; it < DEPTH * 48; it += C.G) {
        if (!filled) {
            for (int i = C.tid; i < 9 * 1024; i += NTHR) { const float v = i < 8192 ? C.in[I_C][i] : C.in[I_CCTX][i - 8192]; sc[i] = siluf_(v); }
            filled = true; __syncthreads();
        }
        const int l = it / 48, jb = it % 48, col = C.tid & 127, kg = C.tid >> 7;
        const float* W = C.in[I_MODW] + (size_t)l * 1024 * 6144 + jb * 128 + col;
        float acc[9];
#pragma unroll
        for (int r = 0; r < 9; ++r) acc[r] = 0.f;
        for (int k = kg * 256; k < kg * 256 + 256; ++k) { const float w = W[(size_t)k * 6144];
#pragma unroll
            for (int r = 0; r < 9; ++r) acc[r] += sc[r * 1024 + k] * w; }
#pragma unroll
        for (int r = 0; r < 9; ++r) red[(kg * 9 + r) * 128 + col] = acc[r];
        __syncthreads();
        for (int i = C.tid; i < 9 * 128; i += NTHR) { const int r = i >> 7, cc = i & 127;
            const float s = red[(0 * 9 + r) * 128 + cc] + red[(1 * 9 + r) * 128 + cc] + red[(2 * 9 + r) * 128 + cc] + red[(3 * 9 + r) * 128 + cc];
            modv[((size_t)l * 9 + r) * 6144 + jb * 128 + cc] = s + C.in[I_MODB][l * 6144 + jb * 128 + cc]; }
        __syncthreads();
    }
}

__device__ __forceinline__ void tr_item(const float* src, size_t ld, int k0, int ns0, bf16* dst, int drow0, int Kd, LAS float* scr, int lane, bool zero) {
    if (!zero) {
#pragma unroll 8
        for (int i = 0; i < 32; ++i) { const int kk = 2 * i + (lane >> 5); scr[kk * 33 + (lane & 31)] = src[(size_t)(k0 + kk) * ld + ns0 + (lane & 31)]; }
    }
    LDS_WAIT(); asm volatile("" ::: "memory");
    const int c = lane & 7;
#pragma unroll
    for (int j = 0; j < 4; ++j) { const int n = (lane >> 3) + 8 * j; const LAS float* s = scr + (8 * c) * 33 + n;
        v4u o; o.x = pk2(s[0 * 33], s[1 * 33]); o.y = pk2(s[2 * 33], s[3 * 33]); o.z = pk2(s[4 * 33], s[5 * 33]); o.w = pk2(s[6 * 33], s[7 * 33]);
        if (zero) o = (v4u){0u, 0u, 0u, 0u};
        *(v4u*)(dst + (size_t)(drow0 + n) * Kd + k0 + 8 * c) = o; }
    LDS_WAIT(); asm volatile("" ::: "memory");
}
__device__ __forceinline__ void convert_small(const Ctx& C, int l) {
    {
        bf16* lw = WSP(bf16, WS_LRUWT);
        for (int k = 0; k < 2 * 2 * 4 * 4096 / (128 * NTHR); ++k) {
            const int e = k * 128 * NTHR + C.wg * NTHR + C.tid;
            if (C.wg < 128) {
            const int i = e & 63, j = (e >> 6) & 63, hd = (e >> 12) & 3, g = (e >> 14) & 1, d = e >> 15;
            const float* src = (g ? C.in[I_LWX] : C.in[I_LWA]) + ((size_t)((l * 2 + d) * 4 + hd) * 64 + i) * 64 + j;
            lw[e] = (bf16)f2bf(*src);
            }
        }
    }
    if (C.wg >= 128 && C.wg < 224) {
        bf16* rw = WSP(bf16, WS_RWT);
        const int e = (C.wg - 128) * NTHR + C.tid;
        if (e < 32768) { const int r = e & 31, ch = (e >> 5) & 255, d = (e >> 13) & 1, isa = e >> 14;
            rw[e] = (bf16)f2bf((isa ? C.in[I_RAUP] : C.in[I_RWUP])[((size_t)(l * 2 + d) * 32 + r) * GW + ch]); }
        else { const int e2 = e - 32768, j = e2 & 63, ch = e2 >> 6; rw[e] = (bf16)f2bf(C.in[I_RGUP][((size_t)l * 64 + j) * GW + ch]); }
    }
}
__device__ __forceinline__ void convert_items(const Ctx& C, int l, int what, int gw, int NGW) {
    LAS float* scr = (LAS float*)(C.lds + C.wave * 8704);
    constexpr int I_IN = 16 * 112, I_OUT = 16 * 32, I_GU = 16 * 176, I_DN = 44 * 32, I_E = 16 * 88 + 22 * 32;
    const bool moe = l & 1; const int li = l >> 1;
    const int lo_it = (what & 1) ? 0 : I_IN, hi_it = (what & 2) ? I_IN + I_OUT + (moe ? NE * I_E : (I_GU + I_DN)) : I_IN;
    bf16* win = WSP(bf16, WS_WIN); bf16* wout = WSP(bf16, WS_WOUT); bf16* wgu = WSP(bf16, WS_WGU); bf16* wdn = WSP(bf16, WS_WDN);
    for (int it = lo_it + gw; it < hi_it; it += NGW) {
        int r = it;
        if (r < I_IN) { const int kb = r / 112, nb = r % 112; tr_item(C.in[I_WIN] + (size_t)l * 1024 * IN_COLS, IN_COLS, 64 * kb, 32 * nb, win, 32 * nb, 1024, scr, C.lane, nb == 111); continue; }
        r -= I_IN;
        if (r < I_OUT) { const int kb = r / 32, nb = r % 32; tr_item(C.in[I_WOUT] + (size_t)l * 1024 * 1024, 1024, 64 * kb, 32 * nb, wout, 32 * nb, 1024, scr, C.lane, false); continue; }
        r -= I_OUT;
        if (!moe) {
            if (r < I_GU) { const int kb = r / 176, nb = r % 176, tile = nb >> 3, q = nb & 7;
                const float* src = (q < 4 ? C.in[I_FWG] : C.in[I_FWU]) + (size_t)li * 1024 * DFF;
                tr_item(src, DFF, 64 * kb, tile * 128 + (q & 3) * 32, wgu, 32 * nb, 1024, scr, C.lane, false); continue; }
            r -= I_GU;
            { const int kb = r / 32, nb = r % 32; tr_item(C.in[I_FWD] + (size_t)li * DFF * 1024, 1024, 64 * kb, 32 * nb, wdn, 32 * nb, DFF, scr, C.lane, false); }
        } else {
            const int e = r / I_E; int rr = r % I_E;
            if (rr < 16 * 88) { const int kb = rr / 88, nb = rr % 88, tile = nb >> 3, q = nb & 7;
                const float* src = (q < 4 ? C.in[I_MWG] : C.in[I_MWU]) + ((size_t)li * NE + e) * 1024 * DFE;
                tr_item(src, DFE, 64 * kb, tile * 128 + (q & 3) * 32, wgu + (size_t)e * 2 * DFE * 1024, 32 * nb, 1024, scr, C.lane, false); continue; }
            rr -= 16 * 88;
            { const int kb = rr / 32, nb = rr % 32; tr_item(C.in[I_MWD] + ((size_t)li * NE + e) * DFE * 1024, 1024, 64 * kb, 32 * nb, wdn + (size_t)e * 1024 * DFE, 32 * nb, DFE, scr, C.lane, false); }
        }
    }
}

__device__ __forceinline__ void convert_q(const Ctx& C, int l, int kind, int gw, int NGW) {
    LAS float* scr = (LAS float*)(C.lds + C.wave * 8704);
    constexpr int I_IN = 16 * 112, I_OUT = 16 * 32, I_GU = 16 * 176, I_DN = 44 * 32, I_EGU = 16 * 88, I_EDN = 22 * 32;
    const bool moe = l & 1; const int li = l >> 1;
    bf16* win = WSP(bf16, WS_WIN); bf16* wout = WSP(bf16, WS_WOUT); bf16* wgu = WSP(bf16, WS_WGU); bf16* wdn = WSP(bf16, WS_WDN);
    const int n_it = kind == 0 ? I_OUT + (moe ? NE * I_EGU : I_GU) : kind == 1 ? (moe ? NE * I_EDN : I_DN) : I_IN;
    for (int it = gw; it < n_it; it += NGW) {
        int r = it;
        if (kind == 2) { const int kb = r / 112, nb = r % 112; tr_item(C.in[I_WIN] + (size_t)l * 1024 * IN_COLS, IN_COLS, 64 * kb, 32 * nb, win, 32 * nb, 1024, scr, C.lane, nb == 111); }
        else if (kind == 0) {
            if (r < I_OUT) { const int kb = r / 32, nb = r % 32; tr_item(C.in[I_WOUT] + (size_t)l * 1024 * 1024, 1024, 64 * kb, 32 * nb, wout, 32 * nb, 1024, scr, C.lane, false); continue; }
            r -= I_OUT;
            if (!moe) { const int kb = r / 176, nb = r % 176, tile = nb >> 3, q = nb & 7;
                const float* src = (q < 4 ? C.in[I_FWG] : C.in[I_FWU]) + (size_t)li * 1024 * DFF;
                tr_item(src, DFF, 64 * kb, tile * 128 + (q & 3) * 32, wgu, 32 * nb, 1024, scr, C.lane, false); }
            else { const int e = r / I_EGU, rr = r % I_EGU; const int kb = rr / 88, nb = rr % 88, tile = nb >> 3, q = nb & 7;
                const float* src = (q < 4 ? C.in[I_MWG] : C.in[I_MWU]) + ((size_t)li * NE + e) * 1024 * DFE;
                tr_item(src, DFE, 64 * kb, tile * 128 + (q & 3) * 32, wgu + (size_t)e * 2 * DFE * 1024, 32 * nb, 1024, scr, C.lane, false); }
        } else {
            if (!moe) { const int kb = r / 32, nb = r % 32; tr_item(C.in[I_FWD] + (size_t)li * DFF * 1024, 1024, 64 * kb, 32 * nb, wdn, 32 * nb, DFF, scr, C.lane, false); }
            else { const int e = r / I_EDN, rr = r % I_EDN; const int kb = rr / 32, nb = rr % 32;
                tr_item(C.in[I_MWD] + ((size_t)li * NE + e) * DFE * 1024, 1024, 64 * kb, 32 * nb, wdn + (size_t)e * 1024 * DFE, 32 * nb, DFE, scr, C.lane, false); }
        }
    }
}

template <bool ROUTE>
__device__ __forceinline__ void norm_rows(const Ctx& C, int l, const void* xlat, bool xbf, const float* xctx, const float* gain, int shoff, int scoff, int nrows, int moe_li) {
    const float* modv = WSP(float, WS_MODV) + (size_t)l * 9 * 6144;
    bf16* hb = WSP(bf16, WS_HB);
    const int gw = C.wg * NWAVES + C.wave, NGW = C.G * NWAVES;
    LAS unsigned* lcnt = (LAS unsigned*)(C.lds + 65536);
    unsigned* route = WSP(unsigned, WS_ROUTE);
    if (ROUTE) { if (C.tid < 8) lcnt[C.tid] = 0u; __syncthreads(); }
    f32x4 gv[4];
#pragma unroll
    for (int j = 0; j < 4; ++j) gv[j] = *(const f32x4*)(gain + 4 * C.lane + 256 * j);
    for (int m = gw; m < nrows; m += NGW) {
        const bool isctx = m >= T_LAT;
        const float* xr = isctx ? xctx + (size_t)(m - T_LAT) * 1024 : (const float*)xlat + (size_t)m * 1024; const bf16* xrb = (const bf16*)xlat + (size_t)m * 1024; const bool rbf = xbf && !isctx;
        const float* mv = modv + (size_t)(isctx ? 8 : (m >> 12)) * 6144;
        f32x4 v[4]; float s = 0.f;
#pragma unroll
        for (int j = 0; j < 4; ++j) { v[j] = rbf ? ld4bf(xrb + 4 * C.lane + 256 * j) : *(const f32x4*)(xr + 4 * C.lane + 256 * j); s += (v[j].x * v[j].x + v[j].y * v[j].y) + (v[j].z * v[j].z + v[j].w * v[j].w); }
        const float rs = rsqrtf_(wave_sum(s) * (1.0f / 1024.0f) + 1e-6f);
#pragma unroll
        for (int j = 0; j < 4; ++j) { const f32x4 sh = *(const f32x4*)(mv + shoff + 4 * C.lane + 256 * j), scl = *(const f32x4*)(mv + scoff + 4 * C.lane + 256 * j);
            v[j] = (v[j] * rs * gv[j]) * (scl + 1.0f) + sh;
            v2u o; o.x = pk2(v[j].x, v[j].y); o.y = pk2(v[j].z, v[j].w);
            *(v2u*)(hb + (size_t)m * 1024 + 4 * C.lane + 256 * j) = o; }
        if (ROUTE) {
            const float* rt = C.in[I_MROUTER] + (size_t)moe_li * 1024 * NE;
            float lg[8];
#pragma unroll
            for (int e = 0; e < 8; ++e) lg[e] = 0.f;
#pragma unroll
            for (int j = 0; j < 4; ++j)
#pragma unroll
                for (int q = 0; q < 4; ++q) { const int k = 4 * C.lane + 256 * j + q; const f32x4 r0 = *(const f32x4*)(rt + (size_t)k * 8), r1 = *(const f32x4*)(rt + (size_t)k * 8 + 4); const float hv = v[j][q];
                    lg[0] += hv * r0.x; lg[1] += hv * r0.y; lg[2] += hv * r0.z; lg[3] += hv * r0.w; lg[4] += hv * r1.x; lg[5] += hv * r1.y; lg[6] += hv * r1.z; lg[7] += hv * r1.w; }
#pragma unroll
            for (int e = 0; e < 8; ++e) lg[e] = wave_sum(lg[e]);
            int e0 = 0; float l0 = lg[0];
#pragma unroll
            for (int e = 1; e < 8; ++e) if (lg[e] > l0) { l0 = lg[e]; e0 = e; }
            int e1 = (e0 == 0) ? 1 : 0; float l1 = -3.0e38f;
#pragma unroll
            for (int e = 0; e < 8; ++e) if (e != e0 && lg[e] > l1) { l1 = lg[e]; e1 = e; }
            const float w0 = __builtin_amdgcn_rcpf(1.0f + __expf(l1 - l0)), w1 = 1.0f - w0;
            if (C.lane == 0) {
                const unsigned r0 = atomicAdd((unsigned*)&lcnt[e0], 1u), r1 = atomicAdd((unsigned*)&lcnt[e1], 1u);
                v4u a; a.x = (unsigned)e0; a.y = (unsigned)e1; a.z = r0; a.w = r1;
                *(v4u*)(route + (size_t)m * 8) = a;
                v2u b; b.x = __builtin_bit_cast(unsigned, w0); b.y = __builtin_bit_cast(unsigned, w1);
                *(v2u*)(route + (size_t)m * 8 + 4) = b;
            }
        }
    }
    if (ROUTE) {
        __syncthreads();
        if (C.tid < 8) { unsigned* gc = WSP(unsigned, WS_CTL) + CW_MOECNT + 64 * moe_li; const unsigned base = atomicAdd(gc + C.tid, lcnt[C.tid]); WSP(unsigned, WS_WGBASE)[C.wg * 8 + C.tid] = base; }
    }
}
#define RAW_BARRIER() do { asm volatile("s_waitcnt lgkmcnt(0)" ::: "memory"); __builtin_amdgcn_s_barrier(); asm volatile("" ::: "memory"); } while (0)
__device__ __forceinline__ void gdn_prep(const Ctx& C, int l, int b, int c) {
    const bf16* P = WSP(const bf16, WS_P); bf16* gq = WSP(bf16, WS_GQ);
    const bool isctx = c < 4; const int p0 = isctx ? c * 64 : (c - 4) * 64; const int Lp = isctx ? CTXL : SEQ;
    const int ch = 4 * C.lane;
    auto rowof = [&](int p) -> int { return isctx ? (T_LAT + b * CTXL + p) : (b * SEQ + (p & 63) * 64 + (p >> 6)); };
    f32x4 cw[4][3], x[4][3];
#pragma unroll
    for (int j = 0; j < 4; ++j)
#pragma unroll
        for (int g = 0; g < 3; ++g) cw[j][g] = *(const f32x4*)(C.in[I_GCW] + ((size_t)l * 4 + j) * 768 + g * 256 + ch);
    const int tb = p0 + C.wave * 8;
    auto ldrow = [&](int p, f32x4 (&dst)[3]) {
        if (p >= 0 && p < Lp) { const bf16* pr = P + (size_t)rowof(p) * PLD + OFF_D + ch;
#pragma unroll
            for (int g = 0; g < 3; ++g) dst[g] = ld4bf(pr + g * 256); }
        else {
#pragma unroll
            for (int g = 0; g < 3; ++g) dst[g] = (f32x4){0.f, 0.f, 0.f, 0.f}; }
    };
    ldrow(tb - 2, x[0]); ldrow(tb - 1, x[1]); ldrow(tb, x[2]);
#pragma unroll
    for (int t = 0; t < 8; ++t) {
        ldrow(tb + t + 1, x[3]);
        bf16* orow = gq + (size_t)rowof(tb + t) * 768 + ch;
#pragma unroll
        for (int g = 0; g < 3; ++g) {
            f32x4 v = cw[0][g] * x[0][g] + cw[1][g] * x[1][g] + cw[2][g] * x[2][g] + cw[3][g] * x[3][g];
            v = (f32x4){siluf_(v.x), siluf_(v.y), siluf_(v.z), siluf_(v.w)};
            if (g < 2) { const float ss = row16_sum((v.x * v.x + v.y * v.y) + (v.z * v.z + v.w * v.w)); v = v * (rsqrtf_(ss + 1e-6f) * (g == 0 ? 0.125f : 1.0f)); }
            st4bf(orow + g * 256, v);
        }
#pragma unroll
        for (int g = 0; g < 3; ++g) { x[0][g] = x[1][g]; x[1][g] = x[2][g]; x[2][g] = x[3][g]; }
    }
}
__device__ __forceinline__ void finish_rows(const Ctx& C, int l, int nrows) {
    const bf16* P = WSP(const bf16, WS_P); bf16* yc = WSP(bf16, WS_HB);
    const bf16* ob = WSP(const bf16, WS_OUTB); const bf16* oc = WSP(const bf16, WS_OUTC); const bf16* od = WSP(const bf16, WS_OUTD);
    const bf16* gg = WSP(const bf16, WS_G); const float* bonus = WSP(const float, WS_BONUS);
    const float* mu = C.in[I_RMU] + (size_t)l * 2 * B_COLS;
    const int gw = C.wg * NWAVES + C.wave, NGW = C.G * NWAVES, lane = C.lane, ch = 4 * lane, hh = lane >> 4;
    const f32x4 lng = *(const f32x4*)(C.in[I_RLNG] + l * GW + ch), lnb = *(const f32x4*)(C.in[I_RLNB] + l * GW + ch);
    const f32x4 mng = *(const f32x4*)(C.in[I_MNG] + l * GW + ch), gng = *(const f32x4*)(C.in[I_GNG] + l * GW + ch);
    const f32x4 mu0 = *(const f32x4*)(mu + 512 + ch), mu1 = *(const f32x4*)(mu + B_COLS + 512 + ch);
    const size_t o2 = (size_t)T_ALL * 256;
#pragma unroll 2
    for (int m = gw; m < nrows; m += NGW) {
        const bool isctx = m >= T_LAT; const int Lp = isctx ? CTXL : SEQ; const int p = isctx ? ((m - T_LAT) & (CTXL - 1)) : (m & (SEQ - 1));
        const f32x4 yb = ld4bf(ob + (size_t)m * 256 + ch) + ld4bf(ob + o2 + (size_t)m * 256 + ch);
        const f32x4 ycv = ld4bf(oc + (size_t)m * 256 + ch) + ld4bf(oc + o2 + (size_t)m * 256 + ch);
        const f32x4 yd = ld4bf(od + (size_t)m * 256 + ch) + ld4bf(od + o2 + (size_t)m * 256 + ch);
        const bf16* pr = P + (size_t)m * PLD;
        const f32x4 vs = ld4bf(WSP(const bf16, WS_RKV) + (size_t)m * 768 + 512 + ch);
        const f32x4 og = ld4bf(pr + OFF_C + 768 + ch), gd = ld4bf(pr + OFF_D + 768 + ch), gr = ld4bf(gg + (size_t)m * 256 + ch);
        const float bn = bonus[(size_t)m * 4 + hh];
        *(v2u*)(yc + (size_t)m * 1024 + ch) = *(const v2u*)(pr + 256 + ch);
        {
            const float mean = row16_sum((yb.x + yb.y) + (yb.z + yb.w)) * (1.0f / 64.0f);
            const f32x4 dl = yb - mean;
            const float var = row16_sum((dl.x * dl.x + dl.y * dl.y) + (dl.z * dl.z + dl.w * dl.w)) * (1.0f / 64.0f);
            const f32x4 yn = dl * rsqrtf_(var + 64e-5f) * lng + lnb;
            st4bf(yc + (size_t)m * 1024 + 256 + ch, (yn + vs * bn) * gr);
        }
        {
            const float ms = row16_sum((ycv.x * ycv.x + ycv.y * ycv.y) + (ycv.z * ycv.z + ycv.w * ycv.w)) * (1.0f / 64.0f);
            const f32x4 sg = (f32x4){sigmoidf_(og.x), sigmoidf_(og.y), sigmoidf_(og.z), sigmoidf_(og.w)};
            st4bf(yc + (size_t)m * 1024 + 512 + ch, ycv * rsqrtf_(ms + 1e-6f) * mng * sg);
        }
        {
            const float ms = row16_sum((yd.x * yd.x + yd.y * yd.y) + (yd.z * yd.z + yd.w * yd.w)) * (1.0f / 64.0f);
            const f32x4 sg = (f32x4){siluf_(gd.x), siluf_(gd.y), siluf_(gd.z), siluf_(gd.w)};
            st4bf(yc + (size_t)m * 1024 + 768 + ch, yd * rsqrtf_(ms + 1e-6f) * gng * sg);
        }
    }
}
typedef bf16x8 fragb;
__device__ __forceinline__ f32x4 mfma16(fragb a, fragb b, f32x4 c) { return __builtin_amdgcn_mfma_f32_16x16x32_bf16(a, b, c, 0, 0, 0); }
__device__ __forceinline__ fragb ld_frag16(const LAS bf16* p) { return *(const LAS fragb*)p; }
__device__ __forceinline__ fragb ld_frag8x2(const LAS bf16* p0, const LAS bf16* p1) {
    const v2u a = *(const LAS v2u*)p0, b = *(const LAS v2u*)p1; v4u r; r.x = a.x; r.y = a.y; r.z = b.x; r.w = b.y; return __builtin_bit_cast(fragb, r); }
__device__ __forceinline__ fragb pack_frag(const f32x4& lo, const f32x4& hi) { v4u r; r.x = pk2(lo.x, lo.y); r.y = pk2(lo.z, lo.w); r.z = pk2(hi.x, hi.y); r.w = pk2(hi.z, hi.w); return __builtin_bit_cast(fragb, r); }
__device__ __forceinline__ float wave_incl_sum(float v, int lane) {
    v += dpp_x<0x111, 0xF, true>(0.f, v); v += dpp_x<0x112, 0xF, true>(0.f, v); v += dpp_x<0x114, 0xF, true>(0.f, v); v += dpp_x<0x118, 0xF, true>(0.f, v);
    v += dpp_x<0x142, 0xA, false>(0.f, v); v += dpp_x<0x143, 0xC, false>(0.f, v);
    return v;
}
__device__ __forceinline__ float wave_incl_max(float v, int lane) {
    const float ninf = -3.0e38f;
    v = fmaxf(v, dpp_x<0x111, 0xF, false>(ninf, v)); v = fmaxf(v, dpp_x<0x112, 0xF, false>(ninf, v)); v = fmaxf(v, dpp_x<0x114, 0xF, false>(ninf, v)); v = fmaxf(v, dpp_x<0x118, 0xF, false>(ninf, v));
    v = fmaxf(v, dpp_x<0x142, 0xA, false>(ninf, v)); v = fmaxf(v, dpp_x<0x143, 0xC, false>(ninf, v));
    return v;
}
constexpr int MP = 72;
__device__ __forceinline__ void mlstm_chunked(const Ctx& C, int l, int idx) {
    const int d = idx >> 5, b = (idx >> 2) & 7, h = idx & 3, lane = C.lane, w = C.wave, l15 = lane & 15, q = lane >> 4;
    const int it = w & 3, vtp = w >> 2;
    constexpr int IMG = 64 * MP * 2, BUFB = 4 * IMG + 1024, CTB = 65 * MP * 2 + 16;
    LAS unsigned char* L0 = C.lds;
    const bf16* P = WSP(const bf16, WS_P); bf16* outc = WSP(bf16, WS_OUTC) + (size_t)d * T_ALL * 256;
    const float ib = C.in[I_MIB][(l * 2 + d) * NH + h], fb = C.in[I_MFB][(l * 2 + d) * NH + h];
    const int tt = C.tid >> 3, part = C.tid & 7;
    for (int i = C.tid; i < 2 * CTB / 4; i += NTHR) ((LAS unsigned*)(L0 + 2 * BUFB))[i] = 0u;
    v4u rq, rk, rv; unsigned short rgi, rgf;
    auto gload = [&](int n) {
        const int row = seqrow_cm(n * 64 + tt, d, b);
        const bf16* pp = P + (size_t)row * PLD + OFF_C + h * 64 + 8 * part;
        rq = *(const v4u*)pp; rk = *(const v4u*)(pp + 256); rv = *(const v4u*)(pp + 512);
        const bf16* pg = P + (size_t)seqrow_cm(n * 64 + lane, d, b) * PLD + OFF_C + 1024 + d * 4 + h;
        rgi = pg[0]; rgf = pg[8];
    };
    auto images = [&](int bufi) {
        LAS unsigned char* B0 = L0 + bufi * BUFB;
        LAS bf16* Qs = (LAS bf16*)B0; LAS bf16* Ks = Qs + 64 * MP; LAS bf16* VT = Ks + 64 * MP; LAS bf16* KTw = VT + 64 * MP; LAS float* vec = (LAS float*)(B0 + 4 * IMG);
        const float li = bf2f(rgi) + ib, lf = -softplusf_(-(bf2f(rgf) + fb));
        const float bc = wave_incl_sum(lf, lane), x = li - bc, cm = wave_incl_max(x, lane);
        const float wl = __expf(x - __shfl(cm, 63)) * 0.125f;
        if (w == 0) { vec[lane] = x; vec[64 + lane] = cm; vec[128 + lane] = bc; }
        const float wmine = __shfl(wl, 8 * w + (lane >> 3));
        *(LAS v4u*)(Qs + tt * MP + 8 * part) = rq; *(LAS v4u*)(Ks + tt * MP + 8 * part) = rk;
        const unsigned vv[4] = {rv.x, rv.y, rv.z, rv.w}, kk[4] = {rk.x, rk.y, rk.z, rk.w};
#pragma unroll
        for (int e = 0; e < 4; ++e) {
            VT[(8 * part + 2 * e) * MP + tt] = (bf16)(vv[e] & 0xffffu); VT[(8 * part + 2 * e + 1) * MP + tt] = (bf16)(vv[e] >> 16);
            KTw[(8 * part + 2 * e) * MP + tt] = (bf16)f2bf1(bflo(kk[e]) * wmine); KTw[(8 * part + 2 * e + 1) * MP + tt] = (bf16)f2bf1(bfhi(kk[e]) * wmine);
        }
    };
    f32x4 Cst[2], nst; float m = 0.f;
    Cst[0] = Cst[1] = nst = (f32x4){0.f, 0.f, 0.f, 0.f};
    const fragb ones = __builtin_bit_cast(fragb, (v4u){0x3F803F80u, 0x3F803F80u, 0x3F803F80u, 0x3F803F80u});
    const f32x4 z4 = (f32x4){0.f, 0.f, 0.f, 0.f};
    gload(0); images(0); gload(1);
#pragma unroll 1
    for (int n = 0; n < NCH; ++n) {
        RAW_BARRIER();
        const LAS unsigned char* B0 = L0 + (n & 1) * BUFB;
        const LAS bf16* Qs = (const LAS bf16*)B0; const LAS bf16* Ks = Qs + 64 * MP; const LAS bf16* VT = Ks + 64 * MP; const LAS bf16* KTw = VT + 64 * MP; const LAS float* vec = (const LAS float*)(B0 + 4 * IMG);
        const LAS bf16* CT = (const LAS bf16*)(L0 + 2 * BUFB + (n & 1) * CTB); LAS bf16* CTn = (LAS bf16*)(L0 + 2 * BUFB + ((n + 1) & 1) * CTB);
        fragb Qf[2]; Qf[0] = ld_frag16(Qs + (16 * it + l15) * MP + 8 * q); Qf[1] = ld_frag16(Qs + (16 * it + l15) * MP + 32 + 8 * q);
        const float cmi = vec[64 + 16 * it + l15]; const int icol = 16 * it + l15;
        f32x4 pt[4];
#pragma unroll
        for (int jt = 0; jt < 4; ++jt) {
            pt[jt] = z4;
            if (jt <= it) {
                const fragb k0 = ld_frag16(Ks + (16 * jt + l15) * MP + 8 * q), k1 = ld_frag16(Ks + (16 * jt + l15) * MP + 32 + 8 * q);
                f32x4 st = mfma16(k0, Qf[0], z4); st = mfma16(k1, Qf[1], st);
                const f32x4 xj = *(const LAS f32x4*)(vec + 16 * jt + 4 * q);
#pragma unroll
                for (int r = 0; r < 4; ++r) { const int j = 16 * jt + 4 * q + r; pt[jt][r] = (j <= icol) ? st[r] * __expf(xj[r] - cmi) * 0.125f : 0.f; }
            }
        }
        fragb Pf[2]; Pf[0] = pack_frag(pt[0], pt[1]); Pf[1] = pack_frag(pt[2], pt[3]);
        fragb Vf[2][2];
#pragma unroll
        for (int v2 = 0; v2 < 2; ++v2)
#pragma unroll
            for (int s = 0; s < 2; ++s) { const LAS bf16* vr = VT + (16 * (2 * vtp + v2) + l15) * MP + 32 * s + 4 * q; Vf[v2][s] = ld_frag8x2(vr, vr + 16); }
        f32x4 Aacc[2], R[2], as, dn;
        as = mfma16(Pf[0], ones, z4); if (it >= 2) as = mfma16(Pf[1], ones, as);
        const fragb nf0 = ld_frag16(CT + 64 * MP + 8 * q), nf1 = ld_frag16(CT + 64 * MP + 32 + 8 * q);
        dn = mfma16(Qf[0], nf0, z4); dn = mfma16(Qf[1], nf1, dn);
#pragma unroll
        for (int v2 = 0; v2 < 2; ++v2) {
            Aacc[v2] = mfma16(Pf[0], Vf[v2][0], z4); if (it >= 2) Aacc[v2] = mfma16(Pf[1], Vf[v2][1], Aacc[v2]);
            const LAS bf16* cr = CT + (16 * (2 * vtp + v2) + l15) * MP + 8 * q;
            R[v2] = mfma16(Qf[0], ld_frag16(cr), z4); R[v2] = mfma16(Qf[1], ld_frag16(cr + 32), R[v2]);
        }
        {
            const f32x4 bi = *(const LAS f32x4*)(vec + 128 + 16 * it + 4 * q), cmr = *(const LAS f32x4*)(vec + 64 + 16 * it + 4 * q);
#pragma unroll
            for (int r = 0; r < 4; ++r) {
                const float mi = bi[r] + cmr[r], minter = bi[r] + m, mt = fmaxf(minter, mi), e1 = __expf(mi - mt), e2 = __expf(minter - mt);
                const float den = e1 * as[r] + e2 * dn[r]; const float inv = __builtin_amdgcn_rcpf(fmaxf(fabsf(den), __expf(-mt)));
                const int row = seqrow_cm(n * 64 + 16 * it + 4 * q + r, d, b);
#pragma unroll
                for (int v2 = 0; v2 < 2; ++v2) outc[(size_t)row * 256 + h * 64 + 16 * (2 * vtp + v2) + l15] = (bf16)f2bf1((e1 * Aacc[v2][r] + e2 * R[v2][r]) * inv);
            }
        }
        {
            const LAS bf16* kr = KTw + (16 * it + l15) * MP + 4 * q;
            const fragb kt0 = ld_frag8x2(kr, kr + 16), kt1 = ld_frag8x2(kr + 32, kr + 48);
            const float bL = vec[128 + 63], mloc = bL + vec[64 + 63];
            const float mnew = fmaxf(bL + m, mloc), wp = __expf(bL + m - mnew), wn = __expf(mloc - mnew);
            f32x4 gk = mfma16(kt0, ones, z4); gk = mfma16(kt1, ones, gk);
            nst = nst * wp + gk * wn;
#pragma unroll
            for (int v2 = 0; v2 < 2; ++v2) {
                f32x4 G = mfma16(kt0, Vf[v2][0], z4); G = mfma16(kt1, Vf[v2][1], G);
                Cst[v2] = Cst[v2] * wp + G * wn;
                v2u o; o.x = pk2(Cst[v2].x, Cst[v2].y); o.y = pk2(Cst[v2].z, Cst[v2].w);
                *(LAS v2u*)(CTn + (16 * (2 * vtp + v2) + l15) * MP + 16 * it + 4 * q) = o;
            }
            if (vtp == 0 && l15 == 0) { v2u o; o.x = pk2(nst.x, nst.y); o.y = pk2(nst.z, nst.w); *(LAS v2u*)(CTn + 64 * MP + 16 * it + 4 * q) = o; }
            m = mnew;
        }
        if (n + 1 < NCH) { images((n + 1) & 1); if (n + 2 < NCH) gload(n + 2); }
    }
    __syncthreads();
}
__device__ __forceinline__ int fwd_row_cm(int b, int c, int t) { return c < 4 ? (T_LAT + b * CTXL + c * 64 + t) : (b * SEQ + t * 64 + (c - 4)); }
__device__ __forceinline__ bf16* blob_row(const Ctx& C, int d, int isw, int b, int c, int h, int r) {
    const int row = fwd_row_cm(b, c, r);
    if (d == 1 && isw) return WSP(bf16, WS_OUTD) + ((size_t)T_ALL + row) * 256 + h * 64;
    return WSP(bf16, WS_P) + (size_t)row * PLD + OFF_D + (d * 2 + isw) * 256 + h * 64;
}
constexpr int LP = 68;
__device__ __forceinline__ void blocked_solve(const LAS bf16* Ln, const LAS bf16* TinvP, LAS unsigned char* XTw, f32x4 (&acc)[4][4], int l15, int q) {
    const f32x4 z4 = (f32x4){0.f, 0.f, 0.f, 0.f};
#pragma unroll
    for (int I = 0; I < 4; ++I) {
        const fragb Af = *(const LAS fragb*)(TinvP + (I * 16 + l15) * 32 + 8 * q);
        fragb A0, A1;
        if (I >= 1) A0 = ld_frag16(Ln + (16 * I + l15) * MP + 8 * q);
        if (I == 3) A1 = ld_frag16(Ln + (16 * I + l15) * MP + 32 + 8 * q);
#pragma unroll
        for (int nt = 0; nt < 4; ++nt) {
            const int crow = 16 * nt + l15; LAS unsigned char* xr = XTw + crow * 128;
            f32x4 a = acc[I][nt];
            if (I >= 1) a = mfma16(A0, *(const LAS fragb*)(xr + ((q ^ (crow & 7)) << 4)), a);
            if (I == 3) a = mfma16(A1, *(const LAS fragb*)(xr + (((4 + q) ^ (crow & 7)) << 4)), a);
            v4u bw; bw.x = pk2(a.x, a.y); bw.y = pk2(a.z, a.w); bw.z = 0u; bw.w = 0u;
            const f32x4 x = mfma16(Af, __builtin_bit_cast(fragb, bw), z4);
            acc[I][nt] = x;
            v2u o; o.x = pk2(x.x, x.y); o.y = pk2(x.z, x.w);
            *(LAS v2u*)(xr + (((2 * I + (q >> 1)) ^ (crow & 7)) << 4) + (q & 1) * 8) = o;
        }
    }
}
__device__ __forceinline__ void diag_inverses(const LAS bf16* Ln, LAS bf16* TinvP, int lane) {
    const int blk = lane >> 4, c = lane & 15;
    float x[16];
#pragma unroll
    for (int i = 0; i < 16; ++i) {
        const LAS bf16* lr = Ln + (16 * blk + i) * MP + 16 * blk;
        const v4u r0 = *(const LAS v4u*)lr, r1 = *(const LAS v4u*)(lr + 8);
        const unsigned rw[8] = {r0.x, r0.y, r0.z, r0.w, r1.x, r1.y, r1.z, r1.w};
        float s = (i == c) ? 1.0f : 0.0f;
#pragma unroll
        for (int j = 0; j < i; ++j) s += ((j & 1) ? bfhi(rw[j >> 1]) : bflo(rw[j >> 1])) * x[j];
        x[i] = s;
        TinvP[(blk * 16 + i) * 32 + 8 * (c >> 2) + (c & 3)] = (bf16)f2bf1(s);
    }
}
__device__ __forceinline__ void gdn_solve_item(const Ctx& C, int l, int item) {
    const int lane = C.lane, w = C.wave, pw = w & 1, pi = w >> 1, l15 = lane & 15, q = lane >> 4;
    LAS unsigned char* B0 = C.lds + pi * 31744;
    LAS bf16* Ln = (LAS bf16*)B0;
    LAS bf16* TinvP = (LAS bf16*)(B0 + 9216);
    LAS float* vec = (LAS float*)(B0 + 13312);
    LAS unsigned char* XT = B0 + 13824;
    LAS bf16* Ks = (LAS bf16*)XT;
    const bf16* P = WSP(const bf16, WS_P); const bf16* gq = WSP(const bf16, WS_GQ);
    const int u = item >> 1, d = item & 1;
    const int c = u % NCH, h = (u / NCH) & 3, b = u / (NCH * NH);
    const int n = d ? (c < 4 ? 3 - c : 71 - c) : c;
    const float aexp = __expf(C.in[I_GALOG][(l * 2 + d) * NH + h]), dtb = C.in[I_GDTB][(l * 2 + d) * NH + h];
    const int rowl = seqrow_cm(n * 64 + lane, d, b);
    const bf16* pg = P + (size_t)rowl * PLD + OFF_D + 1024 + d * 4 + h;
    const float la = -aexp * softplusf_(bf2f(pg[0]) + dtb), beta = sigmoidf_(bf2f(pg[8]));
    const float gam = wave_incl_sum(la, lane);
    if (pw == 0) { vec[lane] = beta; vec[64 + lane] = gam; }
#pragma unroll
    for (int r = 0; r < 4; ++r) { const int idx = pw * 64 + lane + 128 * r, t = idx >> 3, part = idx & 7;
        *(LAS v4u*)(Ks + t * MP + 8 * part) = *(const v4u*)(gq + (size_t)seqrow_cm(n * 64 + t, d, b) * 768 + 256 + h * 64 + 8 * part); }
    { LAS v4u* tz = (LAS v4u*)(B0 + 9216) + (pw * 64 + lane) * 2; tz[0] = (v4u){0u, 0u, 0u, 0u}; tz[1] = (v4u){0u, 0u, 0u, 0u}; }
    f32x4 acc[4][4];
    if (pw == 0) {
#pragma unroll
        for (int I = 0; I < 4; ++I)
#pragma unroll
            for (int r = 0; r < 4; ++r) { const bf16* vr = gq + (size_t)seqrow_cm(n * 64 + 16 * I + 4 * q + r, d, b) * 768 + 512 + h * 64 + l15;
#pragma unroll
                for (int nt = 0; nt < 4; ++nt) acc[I][nt][r] = bf2f(vr[16 * nt]); }
    }
    __syncthreads();
    {
        int tix = 0;
#pragma unroll
        for (int it = 0; it < 4; ++it)
#pragma unroll
            for (int jt = 0; jt < 4; ++jt, ++tix) if ((tix & 1) == pw) {
                f32x4 t4 = (f32x4){0.f, 0.f, 0.f, 0.f};
                if (jt <= it) {
#pragma unroll
                    for (int s = 0; s < 2; ++s) t4 = mfma16(ld_frag16(Ks + (16 * it + l15) * MP + 32 * s + 8 * q), ld_frag16(Ks + (16 * jt + l15) * MP + 32 * s + 8 * q), t4);
                    const float gj = vec[64 + 16 * jt + l15];
                    const f32x4 bi = *(const LAS f32x4*)(vec + 16 * it + 4 * q), gi = *(const LAS f32x4*)(vec + 64 + 16 * it + 4 * q);
#pragma unroll
                    for (int r = 0; r < 4; ++r) { const int i = 16 * it + 4 * q + r, j = 16 * jt + l15; t4[r] = (j < i) ? -(bi[r] * t4[r] * __expf(gi[r] - gj)) : 0.f; }
                }
#pragma unroll
                for (int r = 0; r < 4; ++r) Ln[(16 * it + 4 * q + r) * MP + 16 * jt + l15] = (bf16)f2bf1(t4[r]);
            }
    }
    {
#pragma unroll
        for (int I = 0; I < 4; ++I) {
            const f32x4 bi = *(const LAS f32x4*)(vec + 16 * I + 4 * q), gi = *(const LAS f32x4*)(vec + 64 + 16 * I + 4 * q);
#pragma unroll
            for (int r = 0; r < 4; ++r) { const float sc = pw ? bi[r] * __expf(gi[r]) : bi[r];
#pragma unroll
                for (int nt = 0; nt < 4; ++nt) acc[I][nt][r] = (pw ? bf2f(Ks[(16 * I + 4 * q + r) * MP + 16 * nt + l15]) : acc[I][nt][r]) * sc; }
        }
    }
    __syncthreads();
    if (pw == 0) diag_inverses(Ln, TinvP, lane);
    LAS unsigned char* XTw = XT + pw * 8192;
    { LAS v4u* xz = (LAS v4u*)(XTw + lane * 128);
#pragma unroll
        for (int g = 0; g < 8; ++g) xz[g] = (v4u){0u, 0u, 0u, 0u}; }
    __syncthreads();
    blocked_solve(Ln, TinvP, XTw, acc, l15, q);
    {
        bf16* dst = blob_row(C, d, pw, b, c, h, lane);
        const LAS unsigned char* xr = XTw + lane * 128;
#pragma unroll
        for (int g = 0; g < 8; ++g) *(v4u*)(dst + 8 * g) = *(const LAS v4u*)(xr + ((g ^ (lane & 7)) << 4));
    }
    __syncthreads();
}

template <bool DRY>
__device__ __forceinline__ void gdn_chunked(const Ctx& C, int l, int idx) {
    const int d = idx >> 5, b = (idx >> 2) & 7, h = idx & 3, lane = C.lane, w = C.wave, l15 = lane & 15, q = lane >> 4;
    const int it = w & 3, vtp = w >> 2;
    constexpr int IMG = 64 * MP * 2, BUFB = 5 * IMG + 512;
    LAS unsigned char* L0 = C.lds;
    LAS bf16* VnT = (LAS bf16*)(L0 + 2 * BUFB + 2 * IMG);
    const bf16* P = WSP(const bf16, WS_P); const bf16* gq = WSP(const bf16, WS_GQ); bf16* outd = WSP(bf16, WS_OUTD) + (size_t)d * T_ALL * 256;
    const float aexp = __expf(C.in[I_GALOG][(l * 2 + d) * NH + h]), dtb = C.in[I_GDTB][(l * 2 + d) * NH + h];
    const int tt = C.tid >> 3, part = C.tid & 7;
    for (int i = C.tid; i < 2 * IMG / 4; i += NTHR) ((LAS unsigned*)(L0 + 2 * BUFB))[i] = 0u;
    v4u rq, rk, ru, rw; unsigned short rga;
    auto gload = [&](int n) {
        const int c = d ? (n < 4 ? 3 - n : 71 - n) : n;
        const bf16* pp = gq + (size_t)seqrow_cm(n * 64 + tt, d, b) * 768 + h * 64 + 8 * part;
        rq = *(const v4u*)pp; rk = *(const v4u*)(pp + 256);
        ru = *(const v4u*)(blob_row(C, d, 0, b, c, h, tt) + 8 * part); rw = *(const v4u*)(blob_row(C, d, 1, b, c, h, tt) + 8 * part);
        rga = P[(size_t)seqrow_cm(n * 64 + lane, d, b) * PLD + OFF_D + 1024 + d * 4 + h];
    };
    auto images = [&](int bufi) {
        LAS unsigned char* B0 = L0 + bufi * BUFB;
        LAS bf16* Qs = (LAS bf16*)B0; LAS bf16* Ks = Qs + 64 * MP; LAS bf16* KdT = Ks + 64 * MP; LAS bf16* Wi = KdT + 64 * MP; LAS bf16* UT = Wi + 64 * MP; LAS float* vec = (LAS float*)(B0 + 5 * IMG);
        const float la = -aexp * softplusf_(bf2f(rga) + dtb);
        const float gam = wave_incl_sum(la, lane);
        if (w == 0) vec[lane] = gam;
        const float kd = __expf(__shfl(gam, 63) - gam);
        const float kmine = __shfl(kd, 8 * w + (lane >> 3));
        *(LAS v4u*)(Qs + tt * MP + 8 * part) = rq; *(LAS v4u*)(Ks + tt * MP + 8 * part) = rk; *(LAS v4u*)(UT + tt * MP + 8 * part) = ru;
        const unsigned kk[4] = {rk.x, rk.y, rk.z, rk.w}, ww[4] = {rw.x, rw.y, rw.z, rw.w};
#pragma unroll
        for (int e = 0; e < 4; ++e) {
            KdT[(8 * part + 2 * e) * MP + tt] = (bf16)f2bf1(bflo(kk[e]) * kmine); KdT[(8 * part + 2 * e + 1) * MP + tt] = (bf16)f2bf1(bfhi(kk[e]) * kmine);
            Wi[(8 * part + 2 * e) * MP + tt] = (bf16)(ww[e] & 0xffffu); Wi[(8 * part + 2 * e + 1) * MP + tt] = (bf16)(ww[e] >> 16);
        }
    };
    f32x4 Sst[2]; Sst[0] = Sst[1] = (f32x4){0.f, 0.f, 0.f, 0.f};
    const f32x4 z4 = (f32x4){0.f, 0.f, 0.f, 0.f};
    gload(0); images(0); gload(1);
#pragma unroll 1
    for (int n = 0; n < NCH; ++n) {
        RAW_BARRIER();
        const LAS unsigned char* B0 = L0 + (n & 1) * BUFB;
        const LAS bf16* Qs = (const LAS bf16*)B0; const LAS bf16* Ks = Qs + 64 * MP; const LAS bf16* KdT = Ks + 64 * MP; const LAS bf16* Wi = KdT + 64 * MP; const LAS bf16* UT = Wi + 64 * MP; const LAS float* vec = (const LAS float*)(B0 + 5 * IMG);
        const LAS bf16* ST = (const LAS bf16*)(L0 + 2 * BUFB + (n & 1) * IMG); LAS bf16* STn = (LAS bf16*)(L0 + 2 * BUFB + ((n + 1) & 1) * IMG);
        fragb Qf[2]; Qf[0] = ld_frag16(Qs + (16 * it + l15) * MP + 8 * q); Qf[1] = ld_frag16(Qs + (16 * it + l15) * MP + 32 + 8 * q);
        const float gcol = vec[16 * it + l15]; const int icol = 16 * it + l15;
        f32x4 pt[4];
#pragma unroll
        for (int jt = 0; jt < 4; ++jt) {
            pt[jt] = z4;
            if (jt <= it) {
                const fragb k0 = ld_frag16(Ks + (16 * jt + l15) * MP + 8 * q), k1 = ld_frag16(Ks + (16 * jt + l15) * MP + 32 + 8 * q);
                f32x4 st = mfma16(k0, Qf[0], z4); st = mfma16(k1, Qf[1], st);
                const f32x4 gj = *(const LAS f32x4*)(vec + 16 * jt + 4 * q);
#pragma unroll
                for (int r = 0; r < 4; ++r) { const int j = 16 * jt + 4 * q + r; pt[jt][r] = (j <= icol) ? st[r] * __expf(gcol - gj[r]) : 0.f; }
            }
        }
        fragb Pf[2]; Pf[0] = pack_frag(pt[0], pt[1]); Pf[1] = pack_frag(pt[2], pt[3]);
        const fragb Wf0 = ld_frag16(Wi + (16 * it + l15) * MP + 8 * q), Wf1 = ld_frag16(Wi + (16 * it + l15) * MP + 32 + 8 * q);
        f32x4 Ro[2];
#pragma unroll
        for (int v2 = 0; v2 < 2; ++v2) {
            const int vrow = 16 * (2 * vtp + v2) + l15;
            const fragb s0 = ld_frag16(ST + vrow * MP + 8 * q), s1 = ld_frag16(ST + vrow * MP + 32 + 8 * q);
            f32x4 ws = mfma16(Wf0, s0, z4); ws = mfma16(Wf1, s1, ws);
            Ro[v2] = mfma16(Qf[0], s0, z4); Ro[v2] = mfma16(Qf[1], s1, Ro[v2]);
            const v2u ur = *(const LAS v2u*)(UT + vrow * MP + 16 * it + 4 * q);
            v2u o; o.x = pk2(bflo(ur.x) - ws.x, bfhi(ur.x) - ws.y); o.y = pk2(bflo(ur.y) - ws.z, bfhi(ur.y) - ws.w);
            *(LAS v2u*)(VnT + vrow * MP + 16 * it + 4 * q) = o;
        }
        RAW_BARRIER();
        {
            const f32x4 gi = *(const LAS f32x4*)(vec + 16 * it + 4 * q);
            const float gl = __expf(vec[63]);
            const LAS bf16* kr = KdT + (16 * it + l15) * MP + 4 * q;
            const fragb kt0 = ld_frag8x2(kr, kr + 16), kt1 = ld_frag8x2(kr + 32, kr + 48);
#pragma unroll
            for (int v2 = 0; v2 < 2; ++v2) {
                const int vrow = 16 * (2 * vtp + v2) + l15;
                const LAS bf16* vr = VnT + vrow * MP + 4 * q;
                const fragb n0 = ld_frag8x2(vr, vr + 16), n1 = ld_frag8x2(vr + 32, vr + 48);
                f32x4 o = mfma16(Pf[0], n0, z4); if (it >= 2) o = mfma16(Pf[1], n1, o);
#pragma unroll
                for (int r = 0; r < 4; ++r) { const int row = seqrow_cm(n * 64 + 16 * it + 4 * q + r, d, b);
                    if (!DRY) outd[(size_t)row * 256 + h * 64 + vrow] = (bf16)f2bf1(o[r] + __expf(gi[r]) * Ro[v2][r]); }
                f32x4 ns = mfma16(kt0, n0, z4); ns = mfma16(kt1, n1, ns);
                Sst[v2] = Sst[v2] * gl + ns;
                v2u so; so.x = pk2(Sst[v2].x, Sst[v2].y); so.y = pk2(Sst[v2].z, Sst[v2].w);
                *(LAS v2u*)(STn + vrow * MP + 16 * it + 4 * q) = so;
            }
        }
        if (n + 1 < NCH) { images((n + 1) & 1); if (n + 2 < NCH) gload(n + 2); }
    }
    __syncthreads();
}
constexpr int UP = 264;
template <int CTRL> __device__ __forceinline__ float dpp_keep(float oldv, float v) { return __builtin_bit_cast(float, __builtin_amdgcn_update_dpp(__builtin_bit_cast(int, oldv), __builtin_bit_cast(int, v), CTRL, 0xF, 0xF, false)); }
template <bool REV> __device__ __forceinline__ void scan16(float& A, float& B) {
#define LRU_STEP(S) { const float Ap = dpp_keep<(REV ? 0x100 : 0x110) | S>(1.0f, A), Bp = dpp_keep<(REV ? 0x100 : 0x110) | S>(0.0f, B); B = A * Bp + B; A = A * Ap; }
    LRU_STEP(1) LRU_STEP(2) LRU_STEP(4) LRU_STEP(8)
#undef LRU_STEP
}
constexpr int UPC = 72;
__device__ __forceinline__ int lru_chunk_of(int d, int k) { return d ? (k < 4 ? 3 - k : NCH + 3 - k) : k; }
template <bool REV>
__device__ __forceinline__ void lru_tiles(const LAS bf16* Ud, int th, int mt, int lane, const fragb (&Wa)[2], const fragb (&Wx)[2], const f32x4& ba, const f32x4& bx, const f32x4& sp4,
                                          f32x4 (&Ac)[2], f32x4 (&Hl)[2], f32x4& Atot, f32x4& hend) {
    const int l15 = lane & 15, q = lane >> 4, edge = (lane & 48) | (REV ? 0 : 15);
    const f32x4 z4 = (f32x4){0.f, 0.f, 0.f, 0.f};
    f32x4 tA = z4, tB = z4;
#pragma unroll
    for (int i = 0; i < 2; ++i) {
        const int nt = REV ? 3 - (2 * th + i) : 2 * th + i;
        const LAS bf16* urow = Ud + (16 * nt + l15) * UPC;
        const fragb Uf0 = ld_frag16(urow + 8 * q), Uf1 = ld_frag16(urow + 32 + 8 * q);
        f32x4 aa = mfma16(Wa[0], Uf0, z4); aa = mfma16(Wa[1], Uf1, aa);
        f32x4 ax = mfma16(Wx[0], Uf0, z4); ax = mfma16(Wx[1], Uf1, ax);
        const v2u ur = *(const LAS v2u*)(urow + 16 * mt + 4 * q);
        const f32x4 u4 = (f32x4){bflo(ur.x), bfhi(ur.x), bflo(ur.y), bfhi(ur.y)};
        f32x4 la, iu, A, Bv;
#pragma unroll
        for (int r = 0; r < 4; ++r) { const float rg = sigmoidf_(aa[r] + ba[r]); iu[r] = sigmoidf_(ax[r] + bx[r]) * u4[r]; la[r] = -sp4[r] * rg; }
        const bool sm_ = la[0] > -0.15f && la[1] > -0.15f && la[2] > -0.15f && la[3] > -0.15f;
        if (__builtin_amdgcn_ballot_w64(!sm_) == 0ull) {
#pragma unroll
            for (int r = 0; r < 4; ++r) { const float x = la[r], p = x * (1.0f + x * (0.5f + x * (0.16666667f + x * (0.041666668f + x * (0.0083333338f + x * 0.0013888889f)))));
                A[r] = 1.0f + p; Bv[r] = __builtin_amdgcn_sqrtf(-p * (2.0f + p)) * iu[r]; }
        } else {
#pragma unroll
            for (int r = 0; r < 4; ++r) { A[r] = __expf(la[r]); Bv[r] = __builtin_amdgcn_sqrtf(-expm1f_(2.0f * la[r])) * iu[r]; }
        }
#pragma unroll
        for (int r = 0; r < 4; ++r) { float a_ = A[r], b_ = Bv[r]; scan16<REV>(a_, b_); A[r] = a_; Bv[r] = b_; }
        if (i == 0) {
            Ac[0] = A; Hl[0] = Bv;
#pragma unroll
            for (int r = 0; r < 4; ++r) { tA[r] = __shfl(A[r], edge); tB[r] = __shfl(Bv[r], edge); }
        } else {
            Ac[1] = A * tA; Hl[1] = A * tB + Bv;
#pragma unroll
            for (int r = 0; r < 4; ++r) { Atot[r] = __shfl(Ac[1][r], edge); hend[r] = __shfl(Hl[1][r], edge); }
        }
    }
}
__device__ __forceinline__ void lru_chain(const Ctx& C, int l, int id) {
    const int b = id >> 3, hd = (id >> 1) & 3, chalf = id & 1;
    const int lane = C.lane, l15 = lane & 15, q = lane >> 4;
    const int d = C.wave >> 2, mtl = (C.wave >> 1) & 1, th = C.wave & 1, mt = chalf * 2 + mtl;
    LAS bf16* U = (LAS bf16*)C.lds;
    LAS float* XCH = (LAS float*)(C.lds + 2 * 2 * 64 * UPC * 2);
    bf16* P = WSP(bf16, WS_P); bf16* LH = WSP(bf16, WS_LRUH) + (size_t)id * NSTEP * 32;
    const int cd = C.tid >> 8, cj = C.tid & 63, ctq = (C.tid >> 6) & 3;
    const float* cw = C.in[I_LCW] + (size_t)l * 4 * GW + hd * 64 + cj; const float w0 = cw[0], w1 = cw[GW], w2 = cw[2 * GW], w3 = cw[3 * GW], cb = C.in[I_LCB][l * GW + hd * 64 + cj];
    const bf16* wt = WSP(const bf16, WS_LRUWT) + (size_t)((d * 2 + 0) * 4 + hd) * 4096;
    fragb Wa[2], Wx[2];
#pragma unroll
    for (int ks = 0; ks < 2; ++ks) { Wa[ks] = *(const fragb*)(wt + (16 * mt + l15) * 64 + 32 * ks + 8 * q); Wx[ks] = *(const fragb*)(wt + 4 * 4096 + (16 * mt + l15) * 64 + 32 * ks + 8 * q); }
    const int ch0 = hd * 64 + 16 * mt + 4 * q;
    const f32x4 ba = *(const f32x4*)(C.in[I_LBA] + (l * 2 + d) * GW + ch0), bx = *(const f32x4*)(C.in[I_LBX] + (l * 2 + d) * GW + ch0), lam = *(const f32x4*)(C.in[I_LLAM] + (l * 2 + d) * GW + ch0);
    f32x4 sp4;
#pragma unroll
    for (int r = 0; r < 4; ++r) sp4[r] = 8.0f * softplusf_(-lam[r]);
    f32x4 s = (f32x4){0.f, 0.f, 0.f, 0.f};
    unsigned short xr[19];
#define LRU_LOADX(kk) do { const int c_ = lru_chunk_of(cd, (kk)); const bool ic_ = c_ < 4; const int p0_ = (ic_ ? c_ * 64 : (c_ - 4) * 64) + ctq * 16 - 2, Lp_ = ic_ ? CTXL : SEQ; \
        const bf16* xp_ = P + (size_t)(ic_ ? T_LAT + b * CTXL : b * SEQ) * PLD + hd * 64 + cj; \
        _Pragma("unroll") for (int i_ = 0; i_ < 19; ++i_) { const int p_ = p0_ + i_; xr[i_] = (p_ >= 0 && p_ < Lp_) ? xp_[(size_t)p_ * PLD] : (unsigned short)0; } } while (0)
#define LRU_CONV(kk) do { LAS bf16* uo_ = U + ((((kk) & 1) * 2 + cd) * 64 + ctq * 16) * UPC + cj; \
        _Pragma("unroll") for (int t_ = 0; t_ < 16; ++t_) uo_[t_ * UPC] = (bf16)f2bf1(w0 * bf2f(xr[t_]) + w1 * bf2f(xr[t_ + 1]) + w2 * bf2f(xr[t_ + 2]) + w3 * bf2f(xr[t_ + 3]) + cb); } while (0)
    LRU_LOADX(0); LRU_CONV(0); LRU_LOADX(1);
    __syncthreads();
#pragma unroll 1
    for (int k = 0; k < NCH; ++k) {
        if (k + 1 < NCH) { LRU_CONV(k + 1); if (k + 2 < NCH) LRU_LOADX(k + 2); }
        const int c = lru_chunk_of(d, k); const bool second = lru_chunk_of(1 - d, c) < k;
        const bool ic = c < 4; const size_t row0 = (size_t)(ic ? T_LAT + b * CTXL + c * 64 : b * SEQ + (c - 4) * 64);
        const bool late = (k == 2) || (k == 36);
        int tok[2]; v2u gv[2], fv[2];
#pragma unroll
        for (int i = 0; i < 2; ++i) { const int nt = d ? 3 - (2 * th + i) : 2 * th + i; tok[i] = 16 * nt + l15;
            if (second && !late) { gv[i] = *(const v2u*)(P + (row0 + tok[i]) * PLD + 256 + ch0); fv[i] = *(const v2u*)(LH + (size_t)(c * 64 + tok[i]) * 32 + 16 * mtl + 4 * q); } }
        f32x4 Ac[2], Hl[2], Atot, hend;
        const LAS bf16* Ud = U + ((k & 1) * 2 + d) * 64 * UPC;
        if (d) lru_tiles<true>(Ud, th, mt, lane, Wa, Wx, ba, bx, sp4, Ac, Hl, Atot, hend); else lru_tiles<false>(Ud, th, mt, lane, Wa, Wx, ba, bx, sp4, Ac, Hl, Atot, hend);
        LAS float* xw = XCH + (((((k & 1) * 2 + d) * 2 + mtl) * 2 + th) * 4 + q) * 8;
        if (l15 == (d ? 0 : 15)) { *(LAS f32x4*)xw = Atot; *(LAS f32x4*)(xw + 4) = hend; }
        if (late) VM_WAIT();
        RAW_BARRIER();
        if (second && late) {
#pragma unroll
            for (int i = 0; i < 2; ++i) { gv[i] = *(const v2u*)(P + (row0 + tok[i]) * PLD + 256 + ch0); fv[i] = *(const v2u*)(LH + (size_t)(c * 64 + tok[i]) * 32 + 16 * mtl + 4 * q); }
        }
        const LAS float* xr0 = XCH + (((((k & 1) * 2 + d) * 2 + mtl) * 2 + 0) * 4 + q) * 8;
        const f32x4 A0 = *(const LAS f32x4*)xr0, h0 = *(const LAS f32x4*)(xr0 + 4), A1 = *(const LAS f32x4*)(xr0 + 32), h1 = *(const LAS f32x4*)(xr0 + 36);
        const f32x4 mid = A0 * s + h0, hin = th ? mid : s;
        s = A1 * mid + h1;
#pragma unroll
        for (int i = 0; i < 2; ++i) {
            const f32x4 h = Ac[i] * hin + Hl[i];
            if (!second) { v2u o; o.x = pk2(h.x, h.y); o.y = pk2(h.z, h.w); *(v2u*)(LH + (size_t)(c * 64 + tok[i]) * 32 + 16 * mtl + 4 * q) = o; }
            else {
                const f32x4 g = (f32x4){bflo(gv[i].x), bfhi(gv[i].x), bflo(gv[i].y), bfhi(gv[i].y)};
                f32x4 y = (f32x4){h.x + bflo(fv[i].x), h.y + bfhi(fv[i].x), h.z + bflo(fv[i].y), h.w + bfhi(fv[i].y)};
                y.x *= gelu_tanh(g.x); y.y *= gelu_tanh(g.y); y.z *= gelu_tanh(g.z); y.w *= gelu_tanh(g.w);
                st4bf(P + (row0 + tok[i]) * PLD + 256 + ch0, y);
            }
        }
    }
#undef LRU_LOADX
#undef LRU_CONV
    __syncthreads();
}
constexpr int RP = 264;
__device__ __forceinline__ void rwkv_prep2(const Ctx& C, int l, int b, int c) {
    LAS bf16* RS = (LAS bf16*)C.lds;
    LAS bf16* KS = RS + 64 * RP;
    LAS bf16* XW = KS + 64 * RP;
    LAS bf16* XA = XW + 64 * MP;
    LAS bf16* XG = XA + 64 * MP;
    const bf16* P = WSP(const bf16, WS_P);
    const bool isctx = c < 4; const int p0 = isctx ? c * 64 : (c - 4) * 64; const int Lp = isctx ? CTXL : SEQ; const int row0 = isctx ? T_LAT + b * CTXL : b * SEQ;
    const float* mu = C.in[I_RMU] + (size_t)l * 2 * B_COLS;
    bf16* rkv = WSP(bf16, WS_RKV);
#pragma unroll 5
    for (int it = C.tid; it < 64 * 120; it += NTHR) {
        const int t = it / 120, c8 = (it % 120) * 8, p = p0 + t;
        const bf16* pp = P + (size_t)(row0 + p) * PLD + OFF_B + c8;
        const v4u xc = *(const v4u*)pp; v4u xp = (v4u){0u, 0u, 0u, 0u}, xn = xp;
        if (p > 0) xp = *(const v4u*)(pp - PLD);
        if (p < Lp - 1) xn = *(const v4u*)(pp + PLD);
        const f32x4 m0a = *(const f32x4*)(mu + c8), m0b = *(const f32x4*)(mu + c8 + 4), m1a = *(const f32x4*)(mu + B_COLS + c8), m1b = *(const f32x4*)(mu + B_COLS + c8 + 4);
        const unsigned xcw[4] = {xc.x, xc.y, xc.z, xc.w}, xpw[4] = {xp.x, xp.y, xp.z, xp.w}, xnw[4] = {xn.x, xn.y, xn.z, xn.w};
        float sh[8];
#pragma unroll
        for (int e = 0; e < 4; ++e) {
            const float x0 = bflo(xcw[e]), x1 = bfhi(xcw[e]);
            const float mu0_0 = e < 2 ? m0a[2 * e] : m0b[2 * e - 4], mu0_1 = e < 2 ? m0a[2 * e + 1] : m0b[2 * e - 3], mu1_0 = e < 2 ? m1a[2 * e] : m1b[2 * e - 4], mu1_1 = e < 2 ? m1a[2 * e + 1] : m1b[2 * e - 3];
            sh[2 * e] = x0 + mu0_0 * (bflo(xpw[e]) - x0) + mu1_0 * (bflo(xnw[e]) - x0);
            sh[2 * e + 1] = x1 + mu0_1 * (bfhi(xpw[e]) - x1) + mu1_1 * (bfhi(xnw[e]) - x1);
        }
        if (c8 >= 768) {
            const int ci = c8 - 768;
            if (ci < 64) {
#pragma unroll
                for (int e = 0; e < 8; ++e) sh[e] = tanhf_(sh[e]); }
            else if (ci >= 128) {
#pragma unroll
                for (int e = 0; e < 8; ++e) sh[e] = sigmoidf_(sh[e]); }
        }
        v4u o; o.x = pk2(sh[0], sh[1]); o.y = pk2(sh[2], sh[3]); o.z = pk2(sh[4], sh[5]); o.w = pk2(sh[6], sh[7]);
        if (c8 < 768) {
            *(v4u*)(rkv + (size_t)(row0 + p) * 768 + c8) = o;
            if (c8 < 256) *(LAS v4u*)(RS + t * RP + c8) = o; else if (c8 < 512) *(LAS v4u*)(KS + t * RP + c8 - 256) = o;
        } else {
            const int ci = c8 - 768;
            LAS bf16* dst = ci < 64 ? XW + t * MP + ci : (ci < 128 ? XA + t * MP + ci - 64 : XG + t * MP + ci - 128);
            *(LAS v4u*)dst = o;
        }
    }
    __syncthreads();
    const int lane = C.lane, w = C.wave, l15 = lane & 15, q = lane >> 4, hd = w & 3, ntp = w >> 2;
    const bf16* wt = WSP(const bf16, WS_RWT);
    bf16* wa_out = WSP(bf16, WS_HB); bf16* g_out = WSP(bf16, WS_G); float* bonus = WSP(float, WS_BONUS); float* rinv = WSP(float, WS_RINV);
    const f32x4 z4 = (f32x4){0.f, 0.f, 0.f, 0.f};
    float bsum[2] = {0.f, 0.f}, ksum[2] = {0.f, 0.f};
#pragma unroll
    for (int n2 = 0; n2 < 2; ++n2) {
        const int tok = 16 * (2 * ntp + n2) + l15; const size_t row = (size_t)(row0 + p0 + tok);
        const fragb xw0 = ld_frag16(XW + tok * MP + 8 * q), xw1 = ld_frag16(XW + tok * MP + 32 + 8 * q), xa0 = ld_frag16(XA + tok * MP + 8 * q), xa1 = ld_frag16(XA + tok * MP + 32 + 8 * q);
        const fragb xg0 = ld_frag16(XG + tok * MP + 8 * q), xg1 = ld_frag16(XG + tok * MP + 32 + 8 * q);
        unsigned ow0[8], ow1[8], oa0[8], oa1[8], og[8];
#pragma unroll
        for (int mt = 0; mt < 4; ++mt) {
            const int chl = 16 * (l15 >> 2) + 4 * mt + (l15 & 3), ch4 = hd * 64 + 16 * q + 4 * mt;
            const bf16* wrow = wt + (size_t)(hd * 64 + chl) * 32 + 8 * q;
            const bf16* grow = wt + 4 * 256 * 32 + (size_t)(hd * 64 + chl) * 64 + 8 * q;
            const fragb fw0 = *(const fragb*)(wrow), fw1 = *(const fragb*)(wrow + 256 * 32), fa0 = *(const fragb*)(wrow + 2 * 256 * 32), fa1 = *(const fragb*)(wrow + 3 * 256 * 32), fg0 = *(const fragb*)(grow), fg1 = *(const fragb*)(grow + 32);
            const f32x4 w00 = *(const f32x4*)(C.in[I_RW0] + (l * 2 + 0) * GW + ch4), w01 = *(const f32x4*)(C.in[I_RW0] + (l * 2 + 1) * GW + ch4);
            const f32x4 a00 = *(const f32x4*)(C.in[I_RA0] + (l * 2 + 0) * GW + ch4), a01 = *(const f32x4*)(C.in[I_RA0] + (l * 2 + 1) * GW + ch4);
            const f32x4 k_a = *(const f32x4*)(C.in[I_RKA] + l * GW + ch4), r_k = *(const f32x4*)(C.in[I_RRK] + l * GW + ch4), k_k = *(const f32x4*)(C.in[I_RKK] + l * GW + ch4);
            const f32x4 aw0 = mfma16(fw0, xw0, z4), aw1 = mfma16(fw1, xw1, z4), aa0 = mfma16(fa0, xa0, z4), aa1 = mfma16(fa1, xa1, z4);
            f32x4 ag = mfma16(fg0, xg0, z4); ag = mfma16(fg1, xg1, ag);
            f32x4 wv0, wv1, av0, av1;
#pragma unroll
            for (int r = 0; r < 4; ++r) {
                wv0[r] = __expf(-0.6065306597126334f * sigmoidf_(aw0[r] + w00[r])); wv1[r] = __expf(-0.6065306597126334f * sigmoidf_(aw1[r] + w01[r]));
                av0[r] = sigmoidf_(aa0[r] + a00[r]); av1[r] = sigmoidf_(aa1[r] + a01[r]);
            }
            ow0[2 * mt] = pk2(wv0[0], wv0[1]); ow0[2 * mt + 1] = pk2(wv0[2], wv0[3]); ow1[2 * mt] = pk2(wv1[0], wv1[1]); ow1[2 * mt + 1] = pk2(wv1[2], wv1[3]);
            oa0[2 * mt] = pk2(av0[0], av0[1]); oa0[2 * mt + 1] = pk2(av0[2], av0[3]); oa1[2 * mt] = pk2(av1[0], av1[1]); oa1[2 * mt + 1] = pk2(av1[2], av1[3]);
            og[2 * mt] = pk2(ag[0], ag[1]); og[2 * mt + 1] = pk2(ag[2], ag[3]);
            const v2u rr_ = *(const LAS v2u*)(RS + tok * RP + ch4), kr_ = *(const LAS v2u*)(KS + tok * RP + ch4);
            const f32x4 rs = (f32x4){bflo(rr_.x), bfhi(rr_.x), bflo(rr_.y), bfhi(rr_.y)}, ks = (f32x4){bflo(kr_.x), bfhi(kr_.x), bflo(kr_.y), bfhi(kr_.y)};
#pragma unroll
            for (int r = 0; r < 4; ++r) {
                const float km = ks[r] * (1.0f + (av0[r] - 1.0f) * k_a[r]) + ks[r] * (1.0f + (av1[r] - 1.0f) * k_a[r]);
                bsum[n2] += rs[r] * r_k[r] * km; const float kk = ks[r] * k_k[r]; ksum[n2] += kk * kk;
            }
        }
        bf16* wrow_o = wa_out + row * 1024 + hd * 64 + 16 * q;
        *(v4u*)(wrow_o) = (v4u){ow0[0], ow0[1], ow0[2], ow0[3]}; *(v4u*)(wrow_o + 8) = (v4u){ow0[4], ow0[5], ow0[6], ow0[7]};
        *(v4u*)(wrow_o + 256) = (v4u){ow1[0], ow1[1], ow1[2], ow1[3]}; *(v4u*)(wrow_o + 256 + 8) = (v4u){ow1[4], ow1[5], ow1[6], ow1[7]};
        *(v4u*)(wrow_o + 512) = (v4u){oa0[0], oa0[1], oa0[2], oa0[3]}; *(v4u*)(wrow_o + 512 + 8) = (v4u){oa0[4], oa0[5], oa0[6], oa0[7]};
        *(v4u*)(wrow_o + 768) = (v4u){oa1[0], oa1[1], oa1[2], oa1[3]}; *(v4u*)(wrow_o + 768 + 8) = (v4u){oa1[4], oa1[5], oa1[6], oa1[7]};
        bf16* grow_o = g_out + row * 256 + hd * 64 + 16 * q;
        *(v4u*)(grow_o) = (v4u){og[0], og[1], og[2], og[3]}; *(v4u*)(grow_o + 8) = (v4u){og[4], og[5], og[6], og[7]};
    }
#pragma unroll
    for (int n2 = 0; n2 < 2; ++n2) {
        const size_t row = (size_t)(row0 + p0 + 16 * (2 * ntp + n2) + l15);
        float bs = bsum[n2], ks2 = ksum[n2];
        bs += __shfl_xor(bs, 16); bs += __shfl_xor(bs, 32); ks2 += __shfl_xor(ks2, 16); ks2 += __shfl_xor(ks2, 32);
        if (q == 0) { bonus[row * 4 + hd] = bs; rinv[row * 4 + hd] = rsqrtf_(ks2 + 1e-6f); }
    }
    __syncthreads();
}
__device__ __forceinline__ int fwd_row_r(int b, int c, int t) { return c < 4 ? (T_LAT + b * CTXL + c * 64 + t) : (b * SEQ + (c - 4) * 64 + t); }
__device__ __forceinline__ bf16* rw_blob_row(const Ctx& C, int d, int which, int b, int c, int h, int r) {
    const int row = fwd_row_r(b, c, r);
#if RW_VSPLIT
    if (which == 0) { if (d) return WSP(bf16, WS_GQ) + (size_t)row * 768 + 512 + h * 64;
                      return WSP(bf16, WS_P) + (size_t)row * PLD + OFF_B + 512 + h * 64; }
#else
    if (which == 0) return WSP(bf16, WS_OUTB) + ((size_t)d * T_ALL + row) * 256 + h * 64;
#endif
    return WSP(bf16, WS_P) + (size_t)row * PLD + OFF_B + d * 256 + h * 64;
}
__device__ __forceinline__ void rwkv_solve_item(const Ctx& C, int l, int item) {
    const int lane = C.lane, w = C.wave, pw = w & 1, pi = w >> 1, l15 = lane & 15, q = lane >> 4;
    LAS unsigned char* B0 = C.lds + pi * 31744;
    LAS bf16* Kk = (LAS bf16*)B0; LAS bf16* Bh = Kk + 64 * MP; LAS bf16* Kh = Bh + 64 * MP;
    LAS bf16* Ln = (LAS bf16*)B0;
    LAS bf16* Lk16 = (LAS bf16*)(B0 + 9216);
    LAS unsigned char* XT = B0 + 9216;
    LAS bf16* TinvP = (LAS bf16*)(B0 + 25600);
    const bf16* WA = WSP(const bf16, WS_HB); bf16* WAw = WSP(bf16, WS_HB); const bf16* rkv = WSP(const bf16, WS_RKV); const float* rinv = WSP(const float, WS_RINV);
    const int u = item >> 1, d = item & 1;
    const int c = u % NCH, h = (u / NCH) & 3, b = u / (NCH * NH);
    const float k_k = C.in[I_RKK][l * GW + h * 64 + lane], k_a = C.in[I_RKA][l * GW + h * 64 + lane];
    const int n = d ? (c < 4 ? 3 - c : 71 - c) : c;
    const float ril = rinv[(size_t)seqrow_raster(n * 64 + lane, d, b) * 4 + h];
#pragma unroll
    for (int r = 0; r < 4; ++r) { const int idx2 = pw * 64 + lane + 128 * r, t = idx2 >> 3, part = idx2 & 7; const int row = seqrow_raster(n * 64 + t, d, b);
        *(LAS v4u*)(Kk + t * MP + 8 * part) = *(const v4u*)(WA + (size_t)row * 1024 + d * 256 + h * 64 + 8 * part);
        *(LAS v4u*)(Bh + t * MP + 8 * part) = *(const v4u*)(WA + (size_t)row * 1024 + (2 + d) * 256 + h * 64 + 8 * part);
        *(LAS v4u*)(Kh + t * MP + 8 * part) = *(const v4u*)(rkv + (size_t)row * 768 + 256 + h * 64 + 8 * part); }
    __syncthreads();
    {
        float cc = 1.0f;
        if (pw) {
#pragma unroll
            for (int t = 0; t < 32; ++t) cc *= bf2f(Kk[t * MP + lane]);
        }
        __syncthreads();
#pragma unroll
        for (int t2 = 0; t2 < 32; ++t2) {
            const int t = pw * 32 + t2;
            const float wv = bf2f(Kk[t * MP + lane]), av = bf2f(Bh[t * MP + lane]), ks = bf2f(Kh[t * MP + lane]);
            const float kap = ks * k_k * __shfl(ril, t);
            const float cprev = cc; cc *= wv; const float ic = __builtin_amdgcn_rcpf(cc);
            Kk[t * MP + lane] = (bf16)f2bf1(kap * cprev); Bh[t * MP + lane] = (bf16)f2bf1(kap * av * ic); Kh[t * MP + lane] = (bf16)f2bf1(ks * (1.0f + (av - 1.0f) * k_a) * ic);
            WAw[(size_t)seqrow_raster(n * 64 + t, d, b) * 1024 + d * 256 + h * 64 + lane] = (bf16)f2bf1(cc);
        }
    }
    __syncthreads();
    f32x4 acc[4][4];
    if (pw == 0) {
#pragma unroll
        for (int I = 0; I < 4; ++I)
#pragma unroll
            for (int r = 0; r < 4; ++r)
#pragma unroll
                for (int nt = 0; nt < 4; ++nt) acc[I][nt][r] = bf2f(Kk[(16 * I + 4 * q + r) * MP + 16 * nt + l15]);
    }
    f32x4 T[10];
    {
        const LAS bf16* Bsrc = pw ? Kh : Bh;
        int tix = 0;
#pragma unroll
        for (int it = 0; it < 4; ++it)
#pragma unroll
            for (int jt = 0; jt <= it; ++jt, ++tix) {
                f32x4 t4 = (f32x4){0.f, 0.f, 0.f, 0.f};
#pragma unroll
                for (int s = 0; s < 2; ++s) t4 = mfma16(ld_frag16(Kk + (16 * it + l15) * MP + 32 * s + 8 * q), ld_frag16(Bsrc + (16 * jt + l15) * MP + 32 * s + 8 * q), t4);
#pragma unroll
                for (int r = 0; r < 4; ++r) { const int i = 16 * it + 4 * q + r, j = 16 * jt + l15; T[tix][r] = (j < i) ? (pw ? t4[r] : -t4[r]) : 0.f; }
            }
    }
    __syncthreads();
    {
        int tix = 0;
#pragma unroll
        for (int it = 0; it < 4; ++it)
#pragma unroll
            for (int jt = 0; jt < 4; ++jt) {
                if (jt <= it) {
#pragma unroll
                    for (int r = 0; r < 4; ++r) (pw ? Lk16 : Ln)[(16 * it + 4 * q + r) * MP + 16 * jt + l15] = (bf16)f2bf1(T[tix][r]);
                    ++tix;
                } else if (pw == 0) {
#pragma unroll
                    for (int r = 0; r < 4; ++r) Ln[(16 * it + 4 * q + r) * MP + 16 * jt + l15] = (bf16)0;
                }
            }
        LAS v4u* tz = (LAS v4u*)(B0 + 25600) + (pw * 64 + lane) * 2; tz[0] = (v4u){0u, 0u, 0u, 0u}; tz[1] = (v4u){0u, 0u, 0u, 0u};
    }
    __syncthreads();
    if (pw) {
#pragma unroll
        for (int I = 0; I < 4; ++I)
#pragma unroll
            for (int r = 0; r < 4; ++r)
#pragma unroll
                for (int nt = 0; nt < 4; ++nt) { const int i = 16 * I + 4 * q + r, j = 16 * nt + l15; acc[I][nt][r] = (j < i && nt <= I) ? bf2f(Lk16[i * MP + j]) : 0.f; }
    } else diag_inverses(Ln, TinvP, lane);
    __syncthreads();
    LAS unsigned char* XTw = XT + pw * 8192;
    { LAS v4u* xz = (LAS v4u*)(XTw + lane * 128);
#pragma unroll
        for (int g = 0; g < 8; ++g) xz[g] = (v4u){0u, 0u, 0u, 0u}; }
    blocked_solve(Ln, TinvP, XTw, acc, l15, q);
    {
        bf16* dst = rw_blob_row(C, d, pw, b, c, h, lane);
        const LAS unsigned char* xr = XTw + lane * 128;
#pragma unroll
        for (int g = 0; g < 8; ++g) *(v4u*)(dst + 8 * g) = *(const LAS v4u*)(xr + ((g ^ (lane & 7)) << 4));
    }
    __syncthreads();
}

template <bool DRY>
__device__ __forceinline__ void rwkv_chunked(const Ctx& C, int l, int idx) {
#ifndef RW_VSPLIT
#define RW_VSPLIT 1
#endif
    constexpr int NV = RW_VSPLIT ? 1 : 2;
    const int vhalf = idx & 1, lane = C.lane, w = C.wave, l15 = lane & 15, q = lane >> 4;
    const int d = RW_VSPLIT ? idx >> 6 : idx >> 5, b = RW_VSPLIT ? (idx >> 3) & 7 : (idx >> 2) & 7, h = RW_VSPLIT ? (idx >> 1) & 3 : idx & 3;
    const int it = w & 3, vt0 = RW_VSPLIT ? 2 * vhalf + (w >> 2) : 2 * (w >> 2);
    constexpr int IMG = 64 * MP * 2;
    LAS unsigned char* L0 = C.lds;
    LAS bf16* Wi = (LAS bf16*)L0; LAS bf16* Ti = Wi + 64 * MP; LAS bf16* Rh = Ti + 64 * MP; LAS bf16* Kh = Rh + 64 * MP; LAS bf16* Bh = Kh + 64 * MP;
    LAS bf16* UT = (LAS bf16*)(L0 + 11 * IMG);
    LAS float* cLv = (LAS float*)(L0 + 14 * IMG);
    const bf16* WA = WSP(const bf16, WS_HB); const bf16* rkv = WSP(const bf16, WS_RKV); const float* rinv = WSP(const float, WS_RINV);
    bf16* outb = WSP(bf16, WS_OUTB) + (size_t)d * T_ALL * 256;
    const int tt = C.tid >> 3, part = C.tid & 7;
    for (int i = C.tid; i < 2 * IMG / 4; i += NTHR) ((LAS unsigned*)(L0 + 12 * IMG))[i] = 0u;
    float kkw[8], kaw[8];
#pragma unroll
    for (int e = 0; e < 8; ++e) { kkw[e] = C.in[I_RKK][l * GW + h * 64 + 8 * w + e]; kaw[e] = C.in[I_RKA][l * GW + h * 64 + 8 * w + e]; }
    v4u gr, gk, gv, gw, ga, gbw, gbt; float gri;
    auto gload = [&](int n) {
        const int c = d ? (n < 4 ? 3 - n : 71 - n) : n;
        const int row = seqrow_raster(n * 64 + lane, d, b);
        const bf16* pr = rkv + (size_t)row * 768 + h * 64 + 8 * w;
        gr = *(const v4u*)pr; gk = *(const v4u*)(pr + 256); gv = *(const v4u*)(pr + 512);
        gw = *(const v4u*)(WA + (size_t)row * 1024 + d * 256 + h * 64 + 8 * w); ga = *(const v4u*)(WA + (size_t)row * 1024 + (2 + d) * 256 + h * 64 + 8 * w);
        gri = rinv[(size_t)row * 4 + h];
        gbw = *(const v4u*)(rw_blob_row(C, d, 0, b, c, h, tt) + 8 * part); gbt = *(const v4u*)(rw_blob_row(C, d, 1, b, c, h, tt) + 8 * part);
    };
    auto images = [&](int bufi) {
        LAS bf16* VT = (LAS bf16*)(L0 + (5 + 3 * bufi) * IMG); LAS bf16* KcT = VT + 64 * MP; LAS bf16* BcT = KcT + 64 * MP;
        const unsigned rw_[4] = {gr.x, gr.y, gr.z, gr.w}, kw_[4] = {gk.x, gk.y, gk.z, gk.w}, vw_[4] = {gv.x, gv.y, gv.z, gv.w}, ww_[4] = {gw.x, gw.y, gw.z, gw.w}, aw_[4] = {ga.x, ga.y, ga.z, ga.w};
        float rh[8], kh[8], bh[8];
#pragma unroll
        for (int e = 0; e < 8; ++e) {
            const float rs = (e & 1) ? bfhi(rw_[e >> 1]) : bflo(rw_[e >> 1]), ks = (e & 1) ? bfhi(kw_[e >> 1]) : bflo(kw_[e >> 1]);
            const float wv = (e & 1) ? bfhi(ww_[e >> 1]) : bflo(ww_[e >> 1]), av = (e & 1) ? bfhi(aw_[e >> 1]) : bflo(aw_[e >> 1]);
            const float kap = ks * kkw[e] * gri, ktil = ks * (1.0f + (av - 1.0f) * kaw[e]);
            const float cf = wv, icf = __builtin_amdgcn_rcpf(cf), cfL = __builtin_bit_cast(float, __builtin_amdgcn_readlane(__builtin_bit_cast(int, cf), 63)), dec = cfL * icf;
            rh[e] = rs * cf; kh[e] = ktil * icf; bh[e] = kap * av * icf;
            const unsigned short vraw = (e & 1) ? (unsigned short)(vw_[e >> 1] >> 16) : (unsigned short)(vw_[e >> 1] & 0xffffu);
            VT[(8 * w + e) * MP + lane] = vraw; KcT[(8 * w + e) * MP + lane] = (bf16)f2bf1(ktil * dec); BcT[(8 * w + e) * MP + lane] = (bf16)f2bf1(-(kap * av * dec));
            if (lane == 63) cLv[bufi * 64 + 8 * w + e] = cfL;
        }
        { v4u o; o.x = pk2(rh[0], rh[1]); o.y = pk2(rh[2], rh[3]); o.z = pk2(rh[4], rh[5]); o.w = pk2(rh[6], rh[7]); *(LAS v4u*)(Rh + lane * MP + 8 * w) = o; }
        { v4u o; o.x = pk2(kh[0], kh[1]); o.y = pk2(kh[2], kh[3]); o.z = pk2(kh[4], kh[5]); o.w = pk2(kh[6], kh[7]); *(LAS v4u*)(Kh + lane * MP + 8 * w) = o; }
        { v4u o; o.x = pk2(bh[0], bh[1]); o.y = pk2(bh[2], bh[3]); o.z = pk2(bh[4], bh[5]); o.w = pk2(bh[6], bh[7]); *(LAS v4u*)(Bh + lane * MP + 8 * w) = o; }
        const unsigned bw_[4] = {gbw.x, gbw.y, gbw.z, gbw.w}, bt_[4] = {gbt.x, gbt.y, gbt.z, gbt.w};
#pragma unroll
        for (int e = 0; e < 4; ++e) {
            Wi[(8 * part + 2 * e) * MP + tt] = (bf16)(bw_[e] & 0xffffu); Wi[(8 * part + 2 * e + 1) * MP + tt] = (bf16)(bw_[e] >> 16);
            Ti[(8 * part + 2 * e) * MP + tt] = (bf16)(bt_[e] & 0xffffu); Ti[(8 * part + 2 * e + 1) * MP + tt] = (bf16)(bt_[e] >> 16);
        }
    };
    f32x4 Zst[NV];
#pragma unroll
    for (int v2 = 0; v2 < NV; ++v2) Zst[v2] = (f32x4){0.f, 0.f, 0.f, 0.f};
    const f32x4 z4 = (f32x4){0.f, 0.f, 0.f, 0.f};
    gload(0); images(0); gload(1);
#pragma unroll 1
    for (int n = 0; n < NCH; ++n) {
        RAW_BARRIER();
        const LAS bf16* VT = (const LAS bf16*)(L0 + (5 + 3 * (n & 1)) * IMG); const LAS bf16* KcT = VT + 64 * MP; const LAS bf16* BcT = KcT + 64 * MP;
        const LAS bf16* Zi = (const LAS bf16*)(L0 + (12 + (n & 1)) * IMG); LAS bf16* Zn = (LAS bf16*)(L0 + (12 + ((n + 1) & 1)) * IMG);
        const int arow = (16 * it + l15) * MP + 8 * q;
        const fragb Wf0 = ld_frag16(Wi + arow), Wf1 = ld_frag16(Wi + arow + 32), Tf0 = ld_frag16(Ti + arow), Tf1 = ld_frag16(Ti + arow + 32), Rf0 = ld_frag16(Rh + arow), Rf1 = ld_frag16(Rh + arow + 32);
        const int icol = 16 * it + l15;
        f32x4 pk[4], pb[4];
#pragma unroll
        for (int jt = 0; jt < 4; ++jt) {
            pk[jt] = z4; pb[jt] = z4;
            if (jt <= it) {
                const int jrow = (16 * jt + l15) * MP + 8 * q;
                f32x4 sk = mfma16(ld_frag16(Kh + jrow), Rf0, z4); sk = mfma16(ld_frag16(Kh + jrow + 32), Rf1, sk);
                f32x4 sb = mfma16(ld_frag16(Bh + jrow), Rf0, z4); sb = mfma16(ld_frag16(Bh + jrow + 32), Rf1, sb);
#pragma unroll
                for (int r = 0; r < 4; ++r) { const int j = 16 * jt + 4 * q + r; pk[jt][r] = (j <= icol) ? sk[r] : 0.f; pb[jt][r] = (j <= icol) ? -sb[r] : 0.f; }
            }
        }
        fragb Pk0 = pack_frag(pk[0], pk[1]), Pk1 = pack_frag(pk[2], pk[3]), Pb0 = pack_frag(pb[0], pb[1]), Pb1 = pack_frag(pb[2], pb[3]);
        f32x4 RZ[NV];
#pragma unroll
        for (int v2 = 0; v2 < NV; ++v2) {
            const int vrow = 16 * (vt0 + v2) + l15;
            const fragb z0 = ld_frag16(Zi + vrow * MP + 8 * q), z1 = ld_frag16(Zi + vrow * MP + 32 + 8 * q);
            f32x4 u = mfma16(Wf0, z0, z4); u = mfma16(Wf1, z1, u);
            u = mfma16(Tf0, ld_frag16(VT + vrow * MP + 8 * q), u); if (it >= 2) u = mfma16(Tf1, ld_frag16(VT + vrow * MP + 32 + 8 * q), u);
            RZ[v2] = mfma16(Rf0, z0, z4); RZ[v2] = mfma16(Rf1, z1, RZ[v2]);
            v2u o; o.x = pk2(u.x, u.y); o.y = pk2(u.z, u.w);
            *(LAS v2u*)(UT + vrow * MP + 16 * it + 4 * q) = o;
        }
        RAW_BARRIER();
        {
            const f32x4 cl4 = *(const LAS f32x4*)(cLv + (n & 1) * 64 + 16 * it + 4 * q);
            const LAS bf16* kr = KcT + (16 * it + l15) * MP + 4 * q; const LAS bf16* br = BcT + (16 * it + l15) * MP + 4 * q;
            const fragb kc0 = ld_frag8x2(kr, kr + 16), kc1 = ld_frag8x2(kr + 32, kr + 48), bc0 = ld_frag8x2(br, br + 16), bc1 = ld_frag8x2(br + 32, br + 48);
#pragma unroll
            for (int v2 = 0; v2 < NV; ++v2) {
                const int vrow = 16 * (vt0 + v2) + l15;
                const LAS bf16* vr = VT + vrow * MP + 4 * q; const LAS bf16* ur = UT + vrow * MP + 4 * q;
                const fragb vp0 = ld_frag8x2(vr, vr + 16), vp1 = ld_frag8x2(vr + 32, vr + 48), up0 = ld_frag8x2(ur, ur + 16), up1 = ld_frag8x2(ur + 32, ur + 48);
                f32x4 y = mfma16(Pk0, vp0, RZ[v2]); y = mfma16(Pb0, up0, y);
                if (it >= 2) { y = mfma16(Pk1, vp1, y); y = mfma16(Pb1, up1, y); }
#pragma unroll
                for (int r = 0; r < 4; ++r) { const int row = seqrow_raster(n * 64 + 16 * it + 4 * q + r, d, b); if (!DRY) outb[(size_t)row * 256 + h * 64 + vrow] = (bf16)f2bf1(y[r]); }
                f32x4 zn = mfma16(kc0, vp0, z4); zn = mfma16(kc1, vp1, zn); zn = mfma16(bc0, up0, zn); zn = mfma16(bc1, up1, zn);
                Zst[v2] = Zst[v2] * cl4 + zn;
                v2u so; so.x = pk2(Zst[v2].x, Zst[v2].y); so.y = pk2(Zst[v2].z, Zst[v2].w);
                *(LAS v2u*)(Zn + vrow * MP + 16 * it + 4 * q) = so;
            }
        }
        if (n + 1 < NCH) { images((n + 1) & 1); if (n + 2 < NCH) gload(n + 2); }
    }
    __syncthreads();
}
__device__ __forceinline__ void moe_scatter(const Ctx& C, int moe_li, int nrows) {
    const unsigned* gc = WSP(const unsigned, WS_CTL) + CW_MOECNT + 64 * moe_li;
    LAS int* pst = (LAS int*)C.lds;
    {
        int pe[8]; int acc = 0;
#pragma unroll
        for (int e = 0; e < NE; ++e) { const int blks = ((int)gc[e] + 255) >> 8; if (C.tid == e) pst[e] = acc * 256; acc += blks; pe[e] = acc; }
        if (C.wg == 0 && C.tid < MOE_MAXBLK) { int be = 0;
#pragma unroll
            for (int e = 0; e < NE; ++e) be += (pe[e] <= C.tid) ? 1 : 0;
            int* tab = WSP(int, WS_TAB); tab[1 + C.tid] = be < NE ? be : NE - 1; if (C.tid == 0) tab[0] = acc; }
    }
    __syncthreads();
    const unsigned* route = WSP(const unsigned, WS_ROUTE); const unsigned* wgbase = WSP(const unsigned, WS_WGBASE);
    int* pos = WSP(int, WS_POS); int* tok = WSP(int, WS_TOK);
    if (C.wg < NE) { const int cnt = (int)gc[C.wg], s0 = pst[C.wg] + cnt, s1 = pst[C.wg] + (((cnt + 255) >> 8) << 8);
        for (int j = s0 + C.tid; j < s1; j += NTHR) tok[j] = 0; }
    const int m = C.wg * NWAVES + C.wave + C.lane * (C.G * NWAVES);
    if (m < nrows) {
        const v4u a = *(const v4u*)(route + (size_t)m * 8);
        const int e0 = (int)a.x, e1 = (int)a.y;
        const int p0 = pst[e0] + (int)wgbase[C.wg * 8 + e0] + (int)a.z, p1 = pst[e1] + (int)wgbase[C.wg * 8 + e1] + (int)a.w;
        pos[(size_t)m * 2] = p0; pos[(size_t)m * 2 + 1] = p1; tok[p0] = m; tok[p1] = m;
    }
    __syncthreads();
}
template <int NEXT>
__device__ __forceinline__ void moe_combine(const Ctx& C, int l, int nrows) {
    const unsigned* route = WSP(const unsigned, WS_ROUTE); const int* pos = WSP(const int, WS_POS); const bf16* ym = WSP(const bf16, WS_MIX);
    const float* modv = WSP(const float, WS_MODV) + (size_t)l * 9 * 6144 + 5 * 1024;
    const float* modn = WSP(const float, WS_MODV) + (size_t)(l + 1) * 9 * 6144;
    float* xc = WSP(float, WS_XC); bf16* hb = WSP(bf16, WS_HB);
    bf16* xlb = NEXT == 2 ? WSP(bf16, WS_XLAST) : (bf16*)C.out;
    const int gw = C.wg * NWAVES + C.wave, NGW = C.G * NWAVES;
    f32x4 gn[4];
#pragma unroll
    for (int j = 0; j < 4; ++j) gn[j] = *(const f32x4*)((NEXT == 2 ? C.in[I_FNG] : C.in[I_NMIXG] + (NEXT == 1 ? (l + 1) * 1024 : 0)) + 4 * C.lane + 256 * j);
    for (int m = gw; m < nrows; m += NGW) {
        const bool isctx = m >= T_LAT;
        float* xr = isctx ? xc + (size_t)(m - T_LAT) * 1024 : C.out + (size_t)m * 1024; bf16* xrb = xlb + (size_t)m * 1024;
        const int mrow = isctx ? 8 : (m >> 12);
        const float* gv = modv + (size_t)mrow * 6144;
        const int p0 = pos[(size_t)m * 2], p1 = pos[(size_t)m * 2 + 1];
        const float w0 = __builtin_bit_cast(float, route[(size_t)m * 8 + 4]), w1 = __builtin_bit_cast(float, route[(size_t)m * 8 + 5]);
        f32x4 x[4]; float ss = 0.f;
#pragma unroll
        for (int j = 0; j < 4; ++j) {
            const int col = 4 * C.lane + 256 * j;
            const v2u a = *(const v2u*)(ym + (size_t)p0 * 1024 + col), b = *(const v2u*)(ym + (size_t)p1 * 1024 + col);
            const f32x4 ya = (f32x4){bflo(a.x), bfhi(a.x), bflo(a.y), bfhi(a.y)}, yb = (f32x4){bflo(b.x), bfhi(b.x), bflo(b.y), bfhi(b.y)};
            const f32x4 g = *(const f32x4*)(gv + col);
            x[j] = (isctx ? *(const f32x4*)(xr + col) : ld4bf(xrb + col)) + g * (ya * w0 + yb * w1);
            if (NEXT != 2) { if (isctx) *(f32x4*)(xr + col) = x[j]; else st4bf(xrb + col, x[j]); }
            ss += (x[j].x * x[j].x + x[j].y * x[j].y) + (x[j].z * x[j].z + x[j].w * x[j].w);
        }
        if (NEXT != 0) {
            const float rs = rsqrtf_(wave_sum(ss) * (1.0f / 1024.0f) + 1e-6f);
#pragma unroll
            for (int j = 0; j < 4; ++j) {
                const int col = 4 * C.lane + 256 * j;
                if (NEXT == 2) *(f32x4*)(xr + col) = x[j] * rs * gn[j];
                else { const f32x4 sh = *(const f32x4*)(modn + (size_t)mrow * 6144 + col), scl = *(const f32x4*)(modn + (size_t)mrow * 6144 + 1024 + col);
                    st4bf(hb + (size_t)m * 1024 + col, (x[j] * rs * gn[j]) * (scl + 1.0f) + sh); }
            }
        }
    }
}
__device__ __forceinline__ void final_norm(const Ctx& C) {
    const int gw = C.wg * NWAVES + C.wave, NGW = C.G * NWAVES;
    f32x4 gv[4];
#pragma unroll
    for (int j = 0; j < 4; ++j) gv[j] = *(const f32x4*)(C.in[I_FNG] + 4 * C.lane + 256 * j);
    for (int m = gw; m < T_LAT; m += NGW) {
        float* xr = C.out + (size_t)m * 1024;
        f32x4 v[4]; float s = 0.f;
#pragma unroll
        for (int j = 0; j < 4; ++j) { v[j] = *(const f32x4*)(xr + 4 * C.lane + 256 * j); s += (v[j].x * v[j].x + v[j].y * v[j].y) + (v[j].z * v[j].z + v[j].w * v[j].w); }
        const float rs = rsqrtf_(wave_sum(s) * (1.0f / 1024.0f) + 1e-6f);
#pragma unroll
        for (int j = 0; j < 4; ++j) *(f32x4*)(xr + 4 * C.lane + 256 * j) = v[j] * rs * gv[j];
    }
}

constexpr int NPH_L = 13, PH_FINAL = 1 + DEPTH * NPH_L, NPHASE = PH_FINAL + 1;
__host__ __device__ inline bool phase_exists(int ph) {
    if (ph == 0) return true;
    if (ph == PH_FINAL) return false;
    const int l = (ph - 1) / NPH_L, k = (ph - 1) % NPH_L;
    if (l >= 2 && !(l & 1) && k == 0) return false;
    if (!(l & 1) && k >= 11) return false;
    if (!RW_VSPLIT && k == 4) return false;
    return true;
}
#ifndef PH_MASK
#define PH_MASK 0xFFFFFF
#endif
#define PM(k) ((PH_MASK >> (k)) & 1)
#ifndef SK_MASK
#define SK_MASK 0xFFFF
#endif
#define SK(k) ((SK_MASK >> (k)) & 1)
#ifndef REP_MASK
#define REP_MASK 0
#endif
#define NREP(k) (((REP_MASK >> (k)) & 1) ? 2 : 1)

__global__ void __launch_bounds__(NTHR, 2) fwd_kernel(Args args) {
    extern __shared__ __attribute__((aligned(16))) unsigned char lds_raw[];
    Ctx C; C.in = args.in; C.out = args.out; C.ws = args.ws; C.lds = (LAS unsigned char*)lds_raw;
    C.tid = threadIdx.x; C.lane = C.tid & 63; C.wave = __builtin_amdgcn_readfirstlane(C.tid >> 6); C.G = gridDim.x; C.wg = blockIdx.x;
    volatile LAS unsigned* MISC = (volatile LAS unsigned*)(C.lds + MISC_OFF);
    if (C.tid < 64) MISC[C.tid] = 0u;
    __syncthreads();
    const int lo = args.ph_lo, hi = args.ph_hi;
    const bool multi = (hi - lo) > 1;
    if (multi) (void)xcd_barrier_post(WSP(unsigned, WS_CTL) + CW_BAR, MISC + 8);
#define IN(k) (lo <= (k) && (k) < hi)
#define SEAM(k) do { if (IN((k) + 1)) { XcdBarrier b2_; b2_.bar = WSP(unsigned, WS_CTL) + CW_BAR; b2_.x = xb_xcc_id(); b2_.st = (volatile LAS unsigned*)(C.lds + MISC_OFF) + 8; xcd_barrier(b2_); } } while (0)
#define FRESH() do { int t_ = threadIdx.x; asm volatile("" : "+v"(t_)); C.tid = t_; C.lane = t_ & 63; C.wave = __builtin_amdgcn_readfirstlane(t_ >> 6); } while (0)
#define PHASE(bit, k) if (PM(bit) && IN(pb + (k))) for (int rep_ = 0; rep_ < NREP(bit); ++rep_)
#define CLAIM(qh, var) __syncthreads(); if (C.tid == 0) *qslot = atomicAdd((qh), 1u); __syncthreads(); const int var = (int)*qslot;

    LAS unsigned* qslot = (LAS unsigned*)(C.lds + MISC_OFF + 128);
    constexpr int NCSL = 512;
#define CONV_Q(lay, word, kind, maxn) do { unsigned* qh_ = WSP(unsigned, WS_CTL) + CW_PREPQ + 256 * (lay) + (word); \
        for (; n_ < (maxn); ++n_) { FRESH(); CLAIM(qh_, u0) if (u0 >= NCSL) break; FRESH(); convert_q(C, (lay), (kind), u0 * NWAVES + C.wave, NCSL * NWAVES); } } while (0)
#define CONV_QUEUES(maxn) do { int n_ = 0; if (l > 0) { CONV_Q(l, 192, 0, maxn); CONV_Q(l, 208, 1, maxn); } } while (0)
#define CONV_NEXT() do { if (l + 1 < DEPTH) { int n_ = 0; CONV_Q(l + 1, 224, 2, 1 << 30); CONV_Q(l + 1, 192, 0, 1 << 30); } } while (0)
    if (PM(20) && IN(0)) { phase_pre(C);
        for (;;) { FRESH(); CLAIM(WSP(unsigned, WS_CTL) + CW_PREPQ + 240, u0) if (u0 >= NCSL) break; FRESH(); convert_items(C, 0, 3, u0 * NWAVES + C.wave, NCSL * NWAVES); }
        SEAM(0); }

#pragma unroll 1
    for (int l = 0; l < DEPTH; ++l) {
        const int pb = 1 + l * NPH_L;
        if (hi <= pb || lo >= pb + NPH_L) continue;
        const bool last = (l == DEPTH - 1), moe = (l & 1);
        const int nrows = last ? T_LAT : T_ALL;
        const void* xlat = (l == 0) ? (const void*)C.in[I_X] : (const void*)C.out; const bool xbf = l > 0; void* xmid = last ? (void*)WSP(bf16, WS_XLAST) : (void*)C.out;
        const float* xctx = (l == 0) ? C.in[I_CTX] : WSP(const float, WS_XC);
        const float* modv = WSP(const float, WS_MODV) + (size_t)l * 9 * 6144;
        unsigned* qbase = WSP(unsigned, WS_CTL) + CW_PREPQ + 256 * l;

        if (!(l >= 2 && !(l & 1))) PHASE(0, 0) { FRESH();
            convert_small(C, l);
            __syncthreads();
            FRESH(); norm_rows<false>(C, l, xlat, xbf, xctx, C.in[I_NMIXG] + l * 1024, 0, 1024, T_ALL, 0);
            SEAM(pb + 0);
        }
        PHASE(1, 1) { FRESH();
            pg8::Gemm g{WSP(const bf16, WS_HB), WSP(const bf16, WS_WIN), T_ALL, PLD, 1024, 0};
            const int gG = (l > 0) ? C.G - 16 : C.G;
            if (C.wg < gG) {
                pg8::StaticOrder S; S.init(T_ALL, PLD, gG, C.wg);
                pg8::EpiBf16<0> E{WSP(bf16, WS_P), PLD, nullptr, 0, 0};
                pg8::gemm_phase<pg8::EpiBf16<0>, pg8::StaticOrder, false>(C.lds, g, S, E, nullptr);
                if (l > 0 && C.tid == 0) (void)xb_add(qbase + 176, 1u);
            } else {
                bool dnq_ = true;
                for (;;) { FRESH(); __syncthreads(); if (C.tid == 0) *qslot = xb_ld(qbase + 176); __syncthreads(); const unsigned fin_ = *qslot; if (fin_ != 0u) break;
                    CLAIM(dnq_ ? qbase + 208 : qbase + 192, u0) if (u0 >= NCSL) { if (!dnq_) break; dnq_ = false; continue; } FRESH(); convert_q(C, l, dnq_ ? 1 : 0, u0 * NWAVES + C.wave, NCSL * NWAVES); }
            }
            SEAM(pb + 1);
        }
        if (PM(2) && IN(pb + 2)) for (int rep_ = 0; rep_ < NREP(2); ++rep_) { FRESH();
            for (;;) {
                CLAIM(qbase + 16 * rep_, k)
                if (k >= 2 * NB * NCH) break;
                const int kind = k / (NB * NCH), u = k % (NB * NCH);
                FRESH();
                if (kind == 0) { for (int r3_ = 0; r3_ < NREP(24); ++r3_) { FRESH(); if (SK(1)) rwkv_prep2(C, l, u / NCH, u % NCH); } }
                else { for (int r3_ = 0; r3_ < NREP(26); ++r3_) { FRESH(); if (SK(2)) gdn_prep(C, l, u / NCH, u % NCH); } }
            }
            SEAM(pb + 2);
        }
        if (PM(3) && IN(pb + 3)) for (int rep_ = 0; rep_ < NREP(3); ++rep_) { FRESH();
            constexpr int NCL = 2 * NB * NH * NCH / 4;
            int ncl_ = 0;
            for (;;) {
                CLAIM(qbase + 64 + 16 * rep_, k)
                if (k >= NCL) break;
                FRESH(); ++ncl_;
                if (SK(10)) rwkv_solve_item(C, l, 4 * k + (C.wave >> 1));
            }
            if (ncl_ <= 4) { const int cap_ = (l & 1) ? 1 : 3; CONV_QUEUES(cap_); }
            SEAM(pb + (RW_VSPLIT ? 3 : 4));
        }
#if RW_VSPLIT
        if (PM(3) && IN(pb + 4)) { FRESH();
            for (;;) {
                CLAIM(qbase + 128, k)
                if (k >= 2 * NB * NH * NCH / 4) break;
                FRESH();
                if (SK(10)) rwkv_solve_item(C, l, 4 * k + (C.wave >> 1));
            }
            SEAM(pb + 4);
        }
#endif
        if (PM(4) && IN(pb + 5)) { FRESH();
            if (C.wg >= 64) {
                constexpr int NCL = 2 * NB * NH * NCH / 4;
                for (;;) {
                    CLAIM(qbase + 128, k)
                    if (k >= NCL) break;
                    FRESH();
                    if (SK(9)) gdn_solve_item(C, l, 4 * k + (C.wave >> 1));
                }
                asm volatile("s_waitcnt vmcnt(0)" ::: "memory");
                __syncthreads();
                if (C.tid == 0) { __builtin_amdgcn_fence(__ATOMIC_RELEASE, "agent"); asm volatile("s_waitcnt vmcnt(0)" ::: "memory"); (void)xb_add(qbase + 160, 1u); }
                if (C.wg >= 192) {
                    if (C.tid == 0) { unsigned* bar_ = WSP(unsigned, WS_CTL) + CW_BAR; XB_SPIN(xb_ld(qbase + 160) < (unsigned)(C.G - 64), bar_); __builtin_amdgcn_fence(__ATOMIC_ACQUIRE, "agent"); asm volatile("s_waitcnt vmcnt(0)" ::: "memory"); }
                    __syncthreads();
                }
                FRESH();
            }
            if (C.wg >= 64 && C.wg < 128) { if (SK(0)) lru_chain(C, l, C.wg - 64); FRESH(); }
            if (SK(3) && C.wg < (RW_VSPLIT ? 128 : 64)) { if (NREP(20) > 1) { FRESH(); rwkv_chunked<true>(C, l, C.wg); } FRESH(); rwkv_chunked<false>(C, l, C.wg); }
            else if (SK(4) && C.wg >= 128 && C.wg < 192) { for (int r2_ = 0; r2_ < NREP(21); ++r2_) { FRESH(); mlstm_chunked(C, l, C.wg - 128); } }
            else if (SK(5) && C.wg >= 192) { if (NREP(22) > 1) { FRESH(); gdn_chunked<true>(C, l, C.wg - 192); } FRESH(); gdn_chunked<false>(C, l, C.wg - 192); }
            FRESH(); CONV_QUEUES(1 << 30);
            SEAM(pb + 5);
        }
        PHASE(5, 6) { FRESH();
            if (SK(8)) finish_rows(C, l, nrows);
            SEAM(pb + 6);
        }
        if (PM(6) && IN(pb + 7)) { FRESH();
            pg8::Gemm g{WSP(const bf16, WS_HB), WSP(const bf16, WS_WOUT), nrows, 1024, 1024, 0};
            pg8::StaticOrder S; S.init(nrows, 1024, C.G, C.wg);
            pg8::EpiRes E{xlat, xctx, xmid, WSP(float, WS_XC), modv + 2 * 1024, xbf, true};
            pg8::gemm_phase<pg8::EpiRes, pg8::StaticOrder, false>(C.lds, g, S, E, nullptr);
            SEAM(pb + 7);
        }
        if (PM(7) && IN(pb + 8)) { FRESH();
            if (moe) norm_rows<true>(C, l, xmid, true, WSP(const float, WS_XC), C.in[I_NFFNG] + l * 1024, 3 * 1024, 4 * 1024, nrows, l >> 1);
            else norm_rows<false>(C, l, xmid, true, WSP(const float, WS_XC), C.in[I_NFFNG] + l * 1024, 3 * 1024, 4 * 1024, nrows, 0);
            SEAM(pb + 8);
        }
        if (!moe) {
            if (PM(8) && IN(pb + 9)) for (int rep_ = 0; rep_ < NREP(8); ++rep_) { FRESH();
                pg8::Gemm g{WSP(const bf16, WS_HB), WSP(const bf16, WS_WGU), nrows, 2 * DFF, 1024, 0};
                pg8::StaticOrder S; S.init(nrows, 2 * DFF, C.G, C.wg);
                pg8::EpiSwiglu E{WSP(bf16, WS_P), DFF};
                pg8::gemm_phase<pg8::EpiSwiglu, pg8::StaticOrder, false>(C.lds, g, S, E, nullptr);
                SEAM(pb + 9);
            }
            if (PM(9) && IN(pb + 10)) { FRESH();
                pg8::Gemm g{WSP(const bf16, WS_P), WSP(const bf16, WS_WDN), nrows, 1024, DFF, 0};
                pg8::StaticOrder S; S.init(nrows, 1024, C.G, C.wg);
                pg8::EpiRes E{xmid, WSP(const float, WS_XC), xmid, WSP(float, WS_XC), modv + 5 * 1024, true, true};
                pg8::gemm_phase<pg8::EpiRes, pg8::StaticOrder, false>(C.lds, g, S, E, nullptr);
                CONV_NEXT();
                SEAM(pb + 12);
            }
        } else {
            if (PM(10) && IN(pb + 9)) { FRESH(); moe_scatter(C, l >> 1, nrows); SEAM(pb + 9); }
            if (PM(11) && IN(pb + 10)) for (int rep_ = 0; rep_ < NREP(11); ++rep_) { FRESH();
                pg8::Gemm g{WSP(const bf16, WS_HB), WSP(const bf16, WS_WGU), 0, 2 * DFE, 1024, (size_t)2 * DFE * 1024};
                pg8::MoeOrderG S; S.init(WSP(const int, WS_TAB), (2 * DFE) / 256, C.G, C.wg); S.tok = WSP(const int, WS_TOK);
                pg8::EpiSwiglu E{WSP(bf16, WS_P), DFE};
                pg8::gemm_phase<pg8::EpiSwiglu, pg8::MoeOrderG, false>(C.lds, g, S, E, nullptr);
                SEAM(pb + 10);
            }
            if (PM(12) && IN(pb + 11)) for (int rep_ = 0; rep_ < NREP(12); ++rep_) { FRESH();
                pg8::Gemm g{WSP(const bf16, WS_P), WSP(const bf16, WS_WDN), 0, 1024, DFE, (size_t)1024 * DFE};
                pg8::MoeOrder S; S.init(WSP(const int, WS_TAB), 4, C.G, C.wg);
                pg8::EpiBf16<0> E{WSP(bf16, WS_MIX), 1024, nullptr, 0, 0};
                pg8::gemm_phase<pg8::EpiBf16<0>, pg8::MoeOrder, false>(C.lds, g, S, E, nullptr);
                CONV_NEXT();
                SEAM(pb + 11);
            }
            if (PM(13) && IN(pb + 12)) { FRESH();
                if (last) moe_combine<2>(C, l, nrows);
                else { convert_small(C, l + 1); FRESH(); moe_combine<1>(C, l, nrows); if (IN(pb + NPH_L + 1)) { XcdBarrier b2_; b2_.bar = WSP(unsigned, WS_CTL) + CW_BAR; b2_.x = xb_xcc_id(); b2_.st = (volatile LAS unsigned*)(C.lds + MISC_OFF) + 8; xcd_barrier(b2_); } }
            }
        }
    }
}

extern "C" void kernel_launch(void* const* d_in, const int* in_sizes, int n_in, void* d_out, int out_size, void* d_ws, size_t ws_size, hipStream_t stream) {
    static int grid = 0;
    if (grid == 0) {
        if (n_in != N_IN || in_sizes[0] != T_LAT * DM || out_size != T_LAT * DM || ws_size < WS_END) {
            fprintf(stderr, "kernel_launch: unexpected problem (n_in %d, in0 %d, out %d, ws %zu < %zu)\n", n_in, n_in > 0 ? in_sizes[0] : -1, out_size, ws_size, (size_t)WS_END); grid = -1; return; }
        int dev = 0, cus = 0, per_cu = 0;
        if (hipGetDevice(&dev) != hipSuccess || hipDeviceGetAttribute(&cus, hipDeviceAttributeMultiprocessorCount, dev) != hipSuccess) { grid = -1; return; }
        if (hipFuncSetAttribute((const void*)fwd_kernel, hipFuncAttributeMaxDynamicSharedMemorySize, LDS_BYTES) != hipSuccess) { fprintf(stderr, "kernel_launch: hipFuncSetAttribute failed\n"); grid = -1; return; }
        if (hipOccupancyMaxActiveBlocksPerMultiprocessor(&per_cu, (const void*)fwd_kernel, NTHR, LDS_BYTES) != hipSuccess || per_cu < 1) { fprintf(stderr, "kernel_launch: occupancy query says %d\n", per_cu); grid = -1; return; }
        grid = cus;
        if (grid != 256) fprintf(stderr, "kernel_launch: note: %d CUs\n", grid);
    }
    if (grid < 0) return;
    if (hipMemsetAsync((char*)d_ws + WS_CTL, 0, CTL_BYTES, stream) != hipSuccess) return;
    Args a{};
    for (int i = 0; i < N_IN; ++i) a.in[i] = (const float*)d_in[i];
    a.out = (float*)d_out; a.ws = (unsigned char*)d_ws;
#if MK_ONE_LAUNCH
    a.ph_lo = 0; a.ph_hi = NPHASE;
    hipLaunchKernelGGL(fwd_kernel, dim3(grid), dim3(NTHR), LDS_BYTES, stream, a);
#else
    for (int ph = 0; ph < NPHASE; ++ph) { if (!phase_exists(ph)) continue; a.ph_lo = ph; a.ph_hi = ph + 1; hipLaunchKernelGGL(fwd_kernel, dim3(grid), dim3(NTHR), LDS_BYTES, stream, a); }
#endif
}
```

```cpp
#define MK_ONE_LAUNCH 1
#include <hip/hip_runtime.h>
#include <cstdio>
#include <cstdint>

#define GAS __attribute__((address_space(1)))
#define LAS __attribute__((address_space(3)))
typedef unsigned short bf16;
typedef unsigned v4u __attribute__((ext_vector_type(4)));
typedef unsigned v2u __attribute__((ext_vector_type(2)));
typedef float f32x4 __attribute__((ext_vector_type(4)));
typedef float f32x2 __attribute__((ext_vector_type(2)));
typedef short bf16x8 __attribute__((ext_vector_type(8)));
#define LDS_WAIT() asm volatile("s_waitcnt lgkmcnt(0)" ::: "memory")
#define VM_WAIT() asm volatile("s_waitcnt vmcnt(0)" ::: "memory")

constexpr int DM = 1024, NB = 8, SEQ = 4096, DEPTH = 4, CTXL = 256, GW = 256, HD = 64, NH = 4;
constexpr int T_LAT = NB * SEQ, T_CTX = NB * CTXL, T_ALL = T_LAT + T_CTX;
constexpr int IN_COLS = 3552, PLD = 3584;
constexpr int OFF_B = 512, OFF_C = 1472, OFF_D = 2512, B_COLS = 960;
constexpr int DFF = 2816, NE = 8, DFE = 1408;
constexpr int NCH = 68;
constexpr int NSTEP = 4352;
constexpr int MOE_MAXBLK = 280;
constexpr int NWAVES = 8, NTHR = 512;
#ifndef RW_VSPLIT
#define RW_VSPLIT 0
#endif

constexpr size_t MiB = 1u << 20;
constexpr size_t WS_CTL = 0, CTL_BYTES = 1 * MiB;
constexpr size_t WS_MODV = 1 * MiB;
constexpr size_t WS_XC = 2 * MiB;
constexpr size_t WS_WIN = 10 * MiB;
constexpr size_t WS_WOUT = 17 * MiB;
constexpr size_t WS_WGU = 19 * MiB;
constexpr size_t WS_WDN = 63 * MiB;
constexpr size_t WS_HB = 85 * MiB;
constexpr size_t WS_P = 153 * MiB;
constexpr size_t WS_MIX = 391 * MiB;
constexpr size_t WS_OUTB = WS_MIX, WS_OUTC = WS_MIX + 34 * MiB, WS_OUTD = WS_MIX + 68 * MiB, WS_GQ = WS_MIX + 102 * MiB, WS_G = WS_MIX + 153 * MiB;
constexpr size_t WS_XLAST = WS_MIX + 144 * MiB;
constexpr size_t WS_RKV = WS_MIX + 170 * MiB;
constexpr size_t WS_SMALL = 612 * MiB;
constexpr size_t WS_ROUTE = WS_SMALL;
constexpr size_t WS_POS = WS_SMALL + 1280 * 1024;
constexpr size_t WS_TOK = WS_SMALL + 1664 * 1024;
constexpr size_t WS_BONUS = WS_SMALL + 2 * MiB;
constexpr size_t WS_RINV = WS_SMALL + 2 * MiB + 640 * 1024;
constexpr size_t WS_WGBASE = WS_SMALL + 3 * MiB + 256 * 1024;
constexpr size_t WS_TAB = WS_WGBASE + 65536;
constexpr size_t WS_LRUWT = WS_SMALL + 3 * MiB + 512 * 1024;
constexpr size_t WS_RWT = WS_LRUWT + 131072;
constexpr size_t WS_LRUH = WS_SMALL + 4 * MiB;
constexpr size_t WS_END = 633 * MiB;
constexpr int CW_MOECNT = 1024;
constexpr int CW_PREPQ = 2048;
constexpr int CW_BAR = 4096;

constexpr int LDS_BYTES = 135168;
constexpr int MISC_OFF = 131072;

__device__ __forceinline__ unsigned f2bf(float f) { unsigned u = __builtin_bit_cast(unsigned, f); return (u + 0x7fffu + ((u >> 16) & 1u)) >> 16; }
typedef __bf16 bf16n2 __attribute__((ext_vector_type(2)));
__device__ __forceinline__ unsigned pk2(float lo, float hi) { const f32x2 v = {lo, hi}; return __builtin_bit_cast(unsigned, __builtin_convertvector(v, bf16n2)); }
__device__ __forceinline__ unsigned f2bf1(float f) { return pk2(f, f) & 0xffffu; }
__device__ __forceinline__ float bf2f(unsigned short v) { return __builtin_bit_cast(float, (unsigned)v << 16); }
__device__ __forceinline__ float bflo(unsigned v) { return __builtin_bit_cast(float, v << 16); }
__device__ __forceinline__ float bfhi(unsigned v) { return __builtin_bit_cast(float, v & 0xffff0000u); }
template <int CTRL, int RM, bool BC> __device__ __forceinline__ float dpp_x(float oldv, float v) { return __builtin_bit_cast(float, __builtin_amdgcn_update_dpp(__builtin_bit_cast(int, oldv), __builtin_bit_cast(int, v), CTRL, RM, 0xF, BC)); }
__device__ __forceinline__ float wave_sum(float v) {
    v += dpp_x<0xB1, 0xF, true>(0.f, v); v += dpp_x<0x4E, 0xF, true>(0.f, v); v += dpp_x<0x141, 0xF, true>(0.f, v); v += dpp_x<0x140, 0xF, true>(0.f, v);
    v += dpp_x<0x142, 0xA, false>(0.f, v); v += dpp_x<0x143, 0xC, false>(0.f, v);
    return __builtin_bit_cast(float, __builtin_amdgcn_readlane(__builtin_bit_cast(int, v), 63));
}
template <int CTRL> __device__ __forceinline__ float dpp_f(float v) { return __builtin_bit_cast(float, __builtin_amdgcn_update_dpp(0, __builtin_bit_cast(int, v), CTRL, 0xF, 0xF, true)); }
__device__ __forceinline__ float row16_sum(float v) {
    v += dpp_f<0xB1>(v);
    v += dpp_f<0x4E>(v);
    v += dpp_f<0x141>(v);
    v += dpp_f<0x140>(v);
    return v;
}
__device__ __forceinline__ float sigmoidf_(float x) { return __builtin_amdgcn_rcpf(1.0f + __expf(-x)); }
__device__ __forceinline__ float softplusf_(float x) { return fmaxf(x, 0.f) + __logf(1.0f + __expf(-fabsf(x))); }
__device__ __forceinline__ float expm1f_(float x) { return x > -0.3f ? x * (1.0f + x * (0.5f + x * (0.16666667f + x * (0.041666668f + x * 0.0083333338f)))) : __expf(x) - 1.0f; }
__device__ __forceinline__ float siluf_(float x) { return x * __builtin_amdgcn_rcpf(1.0f + __expf(-x)); }
__device__ __forceinline__ float tanhf_(float x) { const float e = __expf(2.0f * x); return 1.0f - 2.0f * __builtin_amdgcn_rcpf(e + 1.0f); }
__device__ __forceinline__ float rsqrtf_(float x) { return __builtin_amdgcn_rsqf(x); }
__device__ __forceinline__ float gelu_tanh(float x) { return 0.5f * x * (1.0f + tanhf_(0.7978845608028654f * (x + 0.044715f * x * x * x))); }
__device__ __forceinline__ f32x4 ld4bf(const bf16* p) { const v2u a = *(const v2u*)p; return (f32x4){bflo(a.x), bfhi(a.x), bflo(a.y), bfhi(a.y)}; }
__device__ __forceinline__ void st4bf(bf16* p, const f32x4& v) { v2u o; o.x = pk2(v.x, v.y); o.y = pk2(v.z, v.w); *(v2u*)p = o; }
#define XB_TMO      128
#define XB_XCNT(j)  (256  + 64 * (j))
#define XB_XSUB(j)  (1280 + 64 * (j))
#define XB_XGEN(j)  (2304 + 64 * (j))
#define XB_TOP      3328
#define XB_TOPGEN   3392
#define XCD_BAR_WORDS 3456
#define XB_SPIN_CAP (1u << 22)

__device__ __forceinline__ unsigned xb_ld(unsigned* p)              { return __hip_atomic_load(p, __ATOMIC_RELAXED, __HIP_MEMORY_SCOPE_AGENT); }
__device__ __forceinline__ unsigned xb_add(unsigned* p, unsigned v) { return __hip_atomic_fetch_add(p, v, __ATOMIC_RELAXED, __HIP_MEMORY_SCOPE_AGENT); }
__device__ __forceinline__ unsigned xb_xcc_id() { return (unsigned)__builtin_amdgcn_s_getreg((3 << 11) | 20) & 0xFu; }
#define XB_SPIN(cond, bar) do { unsigned _sp = 0; while (cond) { __builtin_amdgcn_s_sleep(1); \
    if ((++_sp & 255u) == 0u) { if (xb_ld(&(bar)[XB_TMO])) break; if (_sp > XB_SPIN_CAP) { atomicAdd(&(bar)[XB_TMO], 1u); break; } } } } while (0)

struct XcdBarrier {
    unsigned* bar; unsigned x;
    volatile LAS unsigned* st;
};

__device__ __forceinline__ XcdBarrier xcd_barrier_post(unsigned* bar, volatile LAS unsigned* st) {
    XcdBarrier b; b.bar = bar; b.x = xb_xcc_id(); b.st = st;
    if (threadIdx.x == 0) (void)xb_add(&bar[XB_XCNT(b.x)], 1u);
    return b;
}
__device__ __forceinline__ void xcd_barrier_complete(unsigned* bar, unsigned x, unsigned& nloc, unsigned& nx) {
    const unsigned G = gridDim.x * gridDim.y * gridDim.z;
    unsigned sum, cnt, mine, sp = 0u;
    for (;;) {
        sum = 0u; cnt = 0u; mine = 0u;
#pragma unroll
        for (unsigned j = 0; j < 16; ++j) { const unsigned c = xb_ld(&bar[XB_XCNT(j)]); sum += c; cnt += (c > 0u) ? 1u : 0u; mine = (j == x) ? c : mine; }
        if (sum == G) break;
        __builtin_amdgcn_s_sleep(1);
        if ((++sp & 255u) == 0u) { if (xb_ld(&bar[XB_TMO])) break; if (sp > XB_SPIN_CAP) { atomicAdd(&bar[XB_TMO], 1u); break; } }
    }
    nloc = mine > 0u ? mine : 1u; nx = cnt > 0u ? cnt : 1u;
}

__device__ __forceinline__ void xcd_barrier(const XcdBarrier& b) {
    asm volatile("s_waitcnt vmcnt(0)" ::: "memory");
    __syncthreads();
    if (threadIdx.x == 0) {
        unsigned* bar = b.bar;
        __builtin_amdgcn_s_waitcnt(0);
        unsigned nloc = b.st[0], nx = b.st[1];
        if (nloc == 0u) { xcd_barrier_complete(bar, b.x, nloc, nx); b.st[0] = nloc; b.st[1] = nx; }
        const unsigned old = xb_add(&bar[XB_XSUB(b.x)], 1u);
        const unsigned gen = old / nloc;
        if (old + 1u == (gen + 1u) * nloc) {
            __builtin_amdgcn_fence(__ATOMIC_RELEASE, "agent");
            asm volatile("s_waitcnt vmcnt(0)" ::: "memory");
            const unsigned og = xb_add(&bar[XB_TOP], 1u);
            const unsigned tg = og / nx;
            if (og + 1u == (tg + 1u) * nx) xb_add(&bar[XB_TOPGEN], 1u);
            else XB_SPIN(xb_ld(&bar[XB_TOPGEN]) == tg, bar);
            __builtin_amdgcn_fence(__ATOMIC_ACQUIRE, "agent");
            xb_add(&bar[XB_XGEN(b.x)], 1u);
            asm volatile("s_waitcnt vmcnt(0)" ::: "memory");
        } else {
            XB_SPIN(xb_ld(&bar[XB_XGEN(b.x)]) == gen, bar);
            __builtin_amdgcn_fence(__ATOMIC_ACQUIRE, "agent");
            asm volatile("s_waitcnt vmcnt(0)" ::: "memory");
        }
    }
    __syncthreads();
}

namespace pg8 {
#define PG8_LAS __attribute__((address_space(3)))
typedef unsigned short bf16_t;
typedef short bf16x8 __attribute__((ext_vector_type(8)));
typedef float f32x4 __attribute__((ext_vector_type(4)));
typedef unsigned u32x4 __attribute__((ext_vector_type(4)));
constexpr int BM = 256, BK = 64, HALF = 128, HTB = HALF * BK * 2  , STAGE_BYTES = 8 * HTB, NXCD = 8, WGM = 8;

__host__ __device__ __forceinline__ int lds_byte(int r, int c) { const int st = (r >> 4) * 2 + (c >> 5), rr = r & 15, cc = c & 31, ob = rr * 64 + cc * 2; return st * 1024 + (ob ^ (((ob >> 9) & 1) << 5)); }
__host__ __device__ __forceinline__ void stage_rc(int b, int& R, int& C) { const int st = b / 1024, sb = b % 1024, swz = sb ^ (((sb >> 9) & 1) << 5); R = (st >> 1) * 16 + swz / 64; C = (st & 1) * 32 + (swz % 64) / 2; }
__host__ __device__ __forceinline__ int perm32(int rho) { const int n = rho >> 4, i = rho & 15; return 8 * (i >> 2) + 4 * n + (i & 3); }

struct Unit { int pm, pn, e; };
struct Gemm { const bf16_t* A; const bf16_t* Bt; int M, N, K; size_t estride; };

struct StaticOrder {
    static constexpr bool GATHER = false, HALFS = false;
    int nM, nN, nwg, G, c;
    __host__ __device__ void init(int M, int N, int G_, int c_) { nM = M / BM; nN = N / BM; nwg = nM * nN; G = G_; c = c_; }
    __host__ __device__ bool next(int i, Unit& u) const {
        const long L = (long)i * G + c; if (L >= nwg) return false;
        int wgid = (int)L; { const int q = nwg / NXCD, r = nwg % NXCD, xcd = wgid % NXCD, off = wgid / NXCD; wgid = (xcd < r ? xcd * (q + 1) : r * (q + 1) + (xcd - r) * q) + off; }
        const int nig = WGM * nN, gid = wgid / nig, fm = gid * WGM, gsz = (nM - fm) < WGM ? (nM - fm) : WGM;
        u.pm = fm + ((wgid % nig) % gsz); u.pn = (wgid % nig) / gsz; u.e = 0; return true;
    }
    __device__ __forceinline__ void a_ready(const Unit&) const {}
    __device__ __forceinline__ void done(const Unit&) const {}
};
struct TailHalfOrder {
    static constexpr bool GATHER = false, HALFS = true;
    int nM, nwg, G, c, ntail;
    __device__ __forceinline__ void init(int M, int G_, int c_) { const int nMall = M / BM; nM = nMall >= 128 ? 128 : nMall; nwg = nM * 4; ntail = nMall - nM; G = G_; c = c_; }
    __device__ __forceinline__ bool next(int i, Unit& u) const {
        const int L = i * G + c;
        if (L < nwg) {
            int wgid = L; { const int q = nwg / NXCD, r = nwg % NXCD, xcd = wgid % NXCD, off = wgid / NXCD; wgid = (xcd < r ? xcd * (q + 1) : r * (q + 1) + (xcd - r) * q) + off; }
            const int nig = WGM * 4, gid = wgid / nig, fm = gid * WGM, gsz = (nM - fm) < WGM ? (nM - fm) : WGM;
            u.pm = fm + ((wgid % nig) % gsz); u.pn = (wgid % nig) / gsz; u.e = 0; return true;
        }
        const int t = L - nwg; if (t >= ntail * 8) return false;
        const int nh = t / ntail; u.pm = 128 + (t - nh * ntail); u.pn = (nh >> 1) | ((1 + (nh & 1)) << 8); u.e = 0; return true;
    }
    __device__ __forceinline__ void a_ready(const Unit&) const {}
    __device__ __forceinline__ void done(const Unit&) const {}
};
typedef __bf16 bf16n2_ __attribute__((ext_vector_type(2)));
__device__ __forceinline__ unsigned cvt_pk_bf16(float lo, float hi) { typedef float f2_ __attribute__((ext_vector_type(2))); const f2_ v = {lo, hi}; return __builtin_bit_cast(unsigned, __builtin_convertvector(v, bf16n2_)); }
typedef float f32x2 __attribute__((ext_vector_type(2)));
__device__ __forceinline__ f32x2 gelu_pk(f32x2 v) {
    const f32x2 av = __builtin_elementwise_abs(v), d = av * 0.2316418882f + 1.0f;
    f32x2 t; t.x = __builtin_amdgcn_rcpf(d.x); t.y = __builtin_amdgcn_rcpf(d.y);
    f32x2 q = t * 0.5307027145f + (-0.7265760135f); q = q * t + 0.7107068705f; q = q * t + (-0.142248368f); q = q * t + 0.127414796f; q = q * t;
    const f32x2 s = (v * v) * (-0.72134752044f);
    f32x2 e; e.x = __builtin_amdgcn_exp2f(s.x); e.y = __builtin_amdgcn_exp2f(s.y);
    const f32x2 m = v * (q * e), r = v - m;
    f32x2 o; o.x = v.x < 0.f ? m.x : r.x; o.y = v.y < 0.f ? m.y : r.y; return o;
}

struct EpiF32 {
    static constexpr bool PERM = false, AFTER_DRAIN = false;
    float* C; int ldc; const float* bias;
    __device__ __forceinline__ void operator()(const f32x4 (&acc)[2][2][4][2], const Unit& u, int wr, int wc, int fr, int fq) const {
        const int row0 = u.pm * BM + wr * 64 + fr, col0 = u.pn * BM + wc * 32 + 4 * fq;
        f32x4 bv[2][2];
#pragma unroll
        for (int bj = 0; bj < 2; ++bj)
#pragma unroll
            for (int n = 0; n < 2; ++n) bv[bj][n] = bias ? *(const f32x4*)(bias + col0 + bj * HALF + n * 16) : (f32x4){0.f, 0.f, 0.f, 0.f};
#pragma unroll
        for (int ai = 0; ai < 2; ++ai)
#pragma unroll
            for (int m = 0; m < 4; ++m) { float* rowp = C + (size_t)(row0 + ai * HALF + m * 16) * ldc + col0;
#pragma unroll
                for (int bj = 0; bj < 2; ++bj)
#pragma unroll
                    for (int n = 0; n < 2; ++n) *(f32x4*)(rowp + bj * HALF + n * 16) = acc[ai][bj][m][n] + bv[bj][n]; }
    }
};
template <int ACT  > struct EpiBf16 {
    static constexpr bool PERM = true, AFTER_DRAIN = false;
    bf16_t* O; int ldc; const float* bias; int split_cols; size_t split_stride;
    __device__ __forceinline__ void operator()(const f32x4 (&acc)[2][2][4][2], const Unit& u, int wr, int wc, int fr, int fq) const {
        const int row0 = u.pm * BM + wr * 64 + fr; int colt = u.pn * BM; bf16_t* base = O;
        if (split_cols) { const int t = colt / split_cols; base += (size_t)t * split_stride; colt -= t * split_cols; }
        const int col0 = colt + wc * 32 + 8 * fq, bcol0 = u.pn * BM + wc * 32 + 8 * fq;
        f32x4 bv[2][2];
#pragma unroll
        for (int bj = 0; bj < 2; ++bj)
#pragma unroll
            for (int n = 0; n < 2; ++n) bv[bj][n] = bias ? *(const f32x4*)(bias + bcol0 + bj * HALF + 4 * n) : (f32x4){0.f, 0.f, 0.f, 0.f};
#pragma unroll
        for (int ai = 0; ai < 2; ++ai)
#pragma unroll
            for (int m = 0; m < 4; ++m) { bf16_t* rowp = base + (size_t)(row0 + ai * HALF + m * 16) * ldc + col0;
#pragma unroll
                for (int bj = 0; bj < 2; ++bj) { f32x4 v0 = acc[ai][bj][m][0] + bv[bj][0], v1 = acc[ai][bj][m][1] + bv[bj][1];
                    if (ACT == 1) { f32x2 a = gelu_pk((f32x2){v0[0], v0[1]}), b = gelu_pk((f32x2){v0[2], v0[3]}), c = gelu_pk((f32x2){v1[0], v1[1]}), d = gelu_pk((f32x2){v1[2], v1[3]});
                        v0 = (f32x4){a.x, a.y, b.x, b.y}; v1 = (f32x4){c.x, c.y, d.x, d.y}; }
                    if (ACT == 2) {
#pragma unroll
                        for (int j = 0; j < 4; ++j) { v0[j] = 0.5f * v0[j] * (1.0f + erff(v0[j] * 0.70710678f)); v1[j] = 0.5f * v1[j] * (1.0f + erff(v1[j] * 0.70710678f)); } }
                    u32x4 w; w.x = cvt_pk_bf16(v0[0], v0[1]); w.y = cvt_pk_bf16(v0[2], v0[3]); w.z = cvt_pk_bf16(v1[0], v1[1]); w.w = cvt_pk_bf16(v1[2], v1[3]);
                    *(u32x4*)(rowp + bj * HALF) = w; } }
    }
};

template <class Epi, class Sched, bool STAMP = false>
__device__ __forceinline__ void gemm_phase(PG8_LAS unsigned char* lds, const Gemm g, const Sched& S, const Epi& E, unsigned long long* stamps) {
    int tid_ = threadIdx.x; asm volatile("" : "+v"(tid_));
    const int tid = tid_, wid = __builtin_amdgcn_readfirstlane(tid >> 6), lane = tid & 63, wr = wid >> 2, wc = wid & 3, fr = lane & 15, fq = lane >> 4;
    const int K = g.K, nt = K / BK;
    constexpr bool GATHER = Sched::GATHER; constexpr bool HALFS = Sched::HALFS;
    int ts_lo = 0, ts_hi = 0, nts = 0; const unsigned long long rt_entry = STAMP ? (unsigned long long)wall_clock64() : 0ull;
#define PG8_STAMP() do { if (STAMP && wid == 0 && nts < 64) { const unsigned long long _c = (unsigned long long)clock64(); \
        ts_lo = (lane == nts) ? (int)(unsigned)_c : ts_lo; ts_hi = (lane == nts) ? (int)(unsigned)(_c >> 32) : ts_hi; ++nts; } } while (0)
    PG8_STAMP();
    unsigned voffA[2], voffB[2]; int rowA[2];
#pragma unroll
    for (int i = 0; i < 2; ++i) { int R, C; stage_rc(tid * 16 + i * 8192, R, C); const int Rb = Epi::PERM ? ((R & ~31) + perm32(R & 31)) : R;
        rowA[i] = R; voffA[i] = GATHER ? (unsigned)C * 2u : (unsigned)(R * K + C) * 2u; voffB[i] = (unsigned)(Rb * K + C) * 2u; }
    const size_t kstep = (size_t)(BK * 2);
    const size_t hstep = (size_t)HALF * K * 2;
    const size_t tstep = 2 * hstep;
    const unsigned ldsw = (unsigned)wid * 1024u;
    const int aoff = lds_byte(wr * 64 + fr, fq * 8), boff = lds_byte(wc * 32 + fr, fq * 8);
#define PG8_SA(b, h) (((b) * 2 + (h)) * HTB)
#define PG8_SB(b, h) ((4 + (b) * 2 + (h)) * HTB)
#define PG8_STAGE(bufoff, gbase, voff) do { _Pragma("unroll") for (int _i = 0; _i < 2; ++_i) \
        __builtin_amdgcn_global_load_lds((const unsigned*)((const char*)(gbase) + (voff)[_i]), (PG8_LAS unsigned*)(lds + (bufoff) + ldsw + _i * 8192), 16, 0, 0); } while (0)
#define PG8_STAGE_A(bufoff, gbase, h, gv) do { if constexpr (GATHER) { PG8_STAGE(bufoff, gbase, (gv)[h]); } else { PG8_STAGE(bufoff, (gbase) + (h) * hstep, voffA); } } while (0)
#define PG8_TOKSLOT(s) ((PG8_LAS int*)(lds + STAGE_BYTES + 1024 + ((s) & 1) * 1024))
#define PG8_LDA(dst, b, h) do { _Pragma("unroll") for (int m = 0; m < 4; ++m) _Pragma("unroll") for (int k = 0; k < 2; ++k) dst[m][k] = *(const PG8_LAS bf16x8*)(lds + PG8_SA(b, h) + aoff + m * 2048 + k * 1024); } while (0)
#define PG8_LDB(dst, b, h) do { _Pragma("unroll") for (int n = 0; n < 2; ++n) _Pragma("unroll") for (int k = 0; k < 2; ++k) dst[n][k] = *(const PG8_LAS bf16x8*)(lds + PG8_SB(b, h) + boff + n * 2048 + k * 1024); } while (0)
#define PG8_MMA(ai, bj, At, Bt) do { __builtin_amdgcn_s_setprio(1); _Pragma("unroll") for (int m = 0; m < 4; ++m) _Pragma("unroll") for (int n = 0; n < 2; ++n) _Pragma("unroll") for (int k = 0; k < 2; ++k) \
        acc[ai][bj][m][n] = __builtin_amdgcn_mfma_f32_16x16x32_bf16(Bt[n][k], At[m][k], acc[ai][bj][m][n], 0, 0, 0); __builtin_amdgcn_s_setprio(0); } while (0)
#define PG8_WAIT_V(n) asm volatile("s_waitcnt vmcnt(" #n ")" ::: "memory")
#define PG8_WAIT_L(n) asm volatile("s_waitcnt lgkmcnt(" #n ")" ::: "memory")
#define PG8_BAR __builtin_amdgcn_s_barrier()
#define PG8_SCHED __builtin_amdgcn_sched_barrier(0)
    Unit cur, nxt; int ui = 0;
    if (!S.next(0, cur)) return;
    f32x4 acc[2][2][4][2];
#pragma unroll
    for (int a = 0; a < 2; ++a)
#pragma unroll
        for (int b = 0; b < 2; ++b)
#pragma unroll
            for (int m = 0; m < 4; ++m)
#pragma unroll
                for (int n = 0; n < 2; ++n) acc[a][b][m][n] = (f32x4){0.f, 0.f, 0.f, 0.f};
    bf16x8 At[4][2], B0[2][2], B1[2][2];
    const char* cA = (const char*)g.A + (GATHER ? (size_t)0 : (size_t)cur.pm * tstep); const char* cB = (const char*)g.Bt + (size_t)(HALFS ? cur.pn & 255 : cur.pn) * tstep + (size_t)cur.e * g.estride * 2 + ((HALFS && (cur.pn >> 8) == 2) ? hstep : (size_t)0);
    S.a_ready(cur);
    unsigned gcur[2][2], gnxt[2][2], gs[2][2];
    if constexpr (GATHER) {
        if (tid < 256) PG8_TOKSLOT(0)[tid] = S.tok[cur.pm * 256 + tid];
        __syncthreads();
#pragma unroll
        for (int h = 0; h < 2; ++h)
#pragma unroll
            for (int i = 0; i < 2; ++i) { gcur[h][i] = (unsigned)PG8_TOKSLOT(0)[h * HALF + rowA[i]] * (unsigned)(K * 2) + voffA[i]; gnxt[h][i] = gcur[h][i]; gs[h][i] = gcur[h][i]; }
    }
    PG8_STAGE(PG8_SB(0, 0), cB, voffB); PG8_STAGE_A(PG8_SA(0, 0), cA, 0, gcur); PG8_STAGE(PG8_SB(0, 1), cB + hstep, voffB); PG8_STAGE_A(PG8_SA(0, 1), cA, 1, gcur);
    if (wr == 1) PG8_BAR;
    PG8_WAIT_V(4); PG8_BAR;
    PG8_STAGE(PG8_SB(1, 0), cB + kstep, voffB); PG8_STAGE_A(PG8_SA(1, 0), cA + kstep, 0, gcur); PG8_STAGE(PG8_SB(1, 1), cB + hstep + kstep, voffB);
    PG8_WAIT_V(6); PG8_BAR;
    PG8_STAMP();
    for (;;) {
        const bool has_next = S.next(ui + 1, nxt);
        if constexpr (GATHER) { if (has_next && wid < 4)
            __builtin_amdgcn_global_load_lds((const unsigned*)(S.tok + nxt.pm * 256 + wid * 64 + lane), (PG8_LAS unsigned*)((PG8_LAS unsigned char*)PG8_TOKSLOT(ui + 1) + wid * 256), 4, 0, 0); }
        const char* nA = GATHER ? (const char*)g.A : has_next ? (const char*)g.A + (size_t)nxt.pm * tstep : cA; const char* nB = has_next ? (const char*)g.Bt + (size_t)(HALFS ? nxt.pn & 255 : nxt.pn) * tstep + (size_t)nxt.e * g.estride * 2 + ((HALFS && (nxt.pn >> 8) == 2) ? hstep : (size_t)0) : cB;
        const bool full = !HALFS || (cur.pn >> 8) == 0;
        for (int t = 0; t < nt; t += 2) {
            const bool last = (t == nt - 2);
            const char* a1 = cA + (size_t)(t + 1) * kstep;
            const char* a2 = last ? nA : cA + (size_t)(t + 2) * kstep; const char* b2 = last ? nB : cB + (size_t)(t + 2) * kstep;
            const char* a3 = a2 + kstep; const char* b3 = b2 + kstep;
            if (last && has_next) S.a_ready(nxt);
            if constexpr (GATHER) {
                if (last && has_next) {
#pragma unroll
                    for (int h = 0; h < 2; ++h)
#pragma unroll
                        for (int i = 0; i < 2; ++i) gnxt[h][i] = (unsigned)PG8_TOKSLOT(ui + 1)[h * HALF + rowA[i]] * (unsigned)(K * 2) + voffA[i];
                }
#pragma unroll
                for (int h = 0; h < 2; ++h)
#pragma unroll
                    for (int i = 0; i < 2; ++i) gs[h][i] = last ? gnxt[h][i] : gcur[h][i];
            }
            PG8_LDB(B0, 0, 0); PG8_SCHED; PG8_LDA(At, 0, 0); PG8_STAGE_A(PG8_SA(1, 1), a1, 1, gcur);
            PG8_WAIT_L(8); PG8_BAR; PG8_WAIT_L(0); PG8_MMA(0, 0, At, B0); PG8_BAR; PG8_SCHED;
            if (full) PG8_LDB(B1, 0, 1); PG8_STAGE(PG8_SB(0, 0), b2, voffB);
            PG8_BAR; PG8_WAIT_L(0); if (full) PG8_MMA(0, 1, At, B1); PG8_BAR;
            PG8_LDA(At, 0, 1); PG8_STAGE_A(PG8_SA(0, 0), a2, 0, gs);
            PG8_BAR; PG8_WAIT_L(0); PG8_MMA(1, 0, At, B0); PG8_BAR; PG8_SCHED;
            PG8_STAGE(PG8_SB(0, 1), b2 + hstep, voffB);
            PG8_WAIT_V(6); PG8_BAR; if (full) PG8_MMA(1, 1, At, B1); PG8_BAR;
            PG8_LDB(B0, 1, 0); PG8_SCHED; PG8_LDA(At, 1, 0); PG8_STAGE_A(PG8_SA(0, 1), a2, 1, gs);
            PG8_WAIT_L(8); PG8_BAR; PG8_WAIT_L(0); PG8_MMA(0, 0, At, B0); PG8_BAR; PG8_SCHED;
            if (full) PG8_LDB(B1, 1, 1); PG8_STAGE(PG8_SB(1, 0), b3, voffB);
            PG8_BAR; PG8_WAIT_L(0); if (full) PG8_MMA(0, 1, At, B1); PG8_BAR;
            PG8_LDA(At, 1, 1); PG8_STAGE_A(PG8_SA(1, 0), a3, 0, gs);
            PG8_BAR; PG8_WAIT_L(0); PG8_MMA(1, 0, At, B0); PG8_BAR; PG8_SCHED;
            PG8_STAGE(PG8_SB(1, 1), b3 + hstep, voffB);
            PG8_WAIT_V(6); PG8_BAR; if (full) PG8_MMA(1, 1, At, B1); PG8_BAR;
        }
        PG8_STAMP();
        if constexpr (!Epi::AFTER_DRAIN) { E(acc, cur, wr, wc, fr, fq); S.done(cur); }
        PG8_STAMP();
        if (!has_next) break;
#pragma unroll
        for (int a = 0; a < 2; ++a)
#pragma unroll
            for (int b = 0; b < 2; ++b)
#pragma unroll
                for (int m = 0; m < 4; ++m)
#pragma unroll
                    for (int n = 0; n < 2; ++n) acc[a][b][m][n] = (f32x4){0.f, 0.f, 0.f, 0.f};
        cur = nxt; cA = nA; cB = nB; ++ui;
        if constexpr (GATHER) {
#pragma unroll
            for (int h = 0; h < 2; ++h)
#pragma unroll
                for (int i = 0; i < 2; ++i) gcur[h][i] = gnxt[h][i];
        }
    }
    PG8_WAIT_V(0);
    if (wr == 0) PG8_BAR;
    PG8_BAR;
    if constexpr (Epi::AFTER_DRAIN) { E.fused(acc, cur, wr, wc, fr, fq, lds, wid, lane); S.done(cur); }
    PG8_STAMP();
    if (STAMP && wid == 0) { stamps[lane] = lane < nts ? (((unsigned long long)(unsigned)ts_hi << 32) | (unsigned)ts_lo) : 0ull;
        if (lane == 62) stamps[62] = rt_entry; if (lane == 63) stamps[63] = (unsigned long long)wall_clock64(); }
#undef PG8_STAMP
#undef PG8_SA
#undef PG8_SB
#undef PG8_STAGE
#undef PG8_STAGE_A
#undef PG8_TOKSLOT
#undef PG8_LDA
#undef PG8_LDB
#undef PG8_MMA
#undef PG8_WAIT_V
#undef PG8_WAIT_L
#undef PG8_BAR
#undef PG8_SCHED
}
}
namespace pg8 {
struct EpiRes {
    static constexpr bool PERM = true, AFTER_DRAIN = false;
    const void* base_lat; const float* base_ctx; void* out_lat; float* out_ctx; const float* gvec; bool base_bf, out_bf;
    __device__ __forceinline__ void operator()(const f32x4 (&acc)[2][2][4][2], const Unit& u, int wr, int wc, int fr, int fq) const {
        const bool isctx = u.pm >= 128;
        const int prow = (isctx ? (u.pm - 128) : u.pm) * BM;
        const float* base = isctx ? base_ctx : (const float*)base_lat; float* out = isctx ? out_ctx : (float*)out_lat;
        const bool bbf = !isctx && base_bf, obf = !isctx && out_bf;
        const float* gv = gvec + (size_t)(isctx ? 8 : (u.pm >> 4)) * 6144;
        const int row0 = prow + wr * 64 + fr, hf = u.pn >> 8, col0 = (u.pn & 255) * BM + (hf == 2 ? HALF : 0) + wc * 32 + 8 * fq;
        f32x4 gvv[2][2];
#pragma unroll
        for (int bj = 0; bj < 2; ++bj)
#pragma unroll
            for (int n = 0; n < 2; ++n) gvv[bj][n] = *(const f32x4*)(gv + col0 + bj * HALF + 4 * n);
#pragma unroll
        for (int ai = 0; ai < 2; ++ai)
#pragma unroll
            for (int m = 0; m < 4; ++m) { const size_t off = (size_t)(row0 + ai * HALF + m * 16) * 1024 + col0;
#pragma unroll
                for (int bj = 0; bj < 2; ++bj) { if (bj == 1 && hf != 0) continue; const size_t o2 = off + bj * HALF;
                    f32x4 b0, b1;
                    if (bbf) { const v4u r = *(const v4u*)((const bf16*)base_lat + o2); b0 = (f32x4){bflo(r.x), bfhi(r.x), bflo(r.y), bfhi(r.y)}; b1 = (f32x4){bflo(r.z), bfhi(r.z), bflo(r.w), bfhi(r.w)}; }
                    else { b0 = *(const f32x4*)(base + o2); b1 = *(const f32x4*)(base + o2 + 4); }
                    const f32x4 v0 = b0 + gvv[bj][0] * acc[ai][bj][m][0], v1 = b1 + gvv[bj][1] * acc[ai][bj][m][1];
                    if (obf) { v4u w; w.x = pk2(v0.x, v0.y); w.y = pk2(v0.z, v0.w); w.z = pk2(v1.x, v1.y); w.w = pk2(v1.z, v1.w); *(v4u*)((bf16*)out_lat + o2) = w; }
                    else { *(f32x4*)(out + o2) = v0; *(f32x4*)(out + o2 + 4) = v1; } } }
    }
};
struct EpiSwiglu {
    static constexpr bool PERM = true, AFTER_DRAIN = false;
    bf16_t* O; int ldc;
    __device__ __forceinline__ void operator()(const f32x4 (&acc)[2][2][4][2], const Unit& u, int wr, int wc, int fr, int fq) const {
        const int row0 = u.pm * BM + wr * 64 + fr, col0 = u.pn * HALF + wc * 32 + 8 * fq;
#pragma unroll
        for (int ai = 0; ai < 2; ++ai)
#pragma unroll
            for (int m = 0; m < 4; ++m) { bf16_t* rowp = O + (size_t)(row0 + ai * HALF + m * 16) * ldc + col0;
                float h[8];
#pragma unroll
                for (int n = 0; n < 2; ++n)
#pragma unroll
                    for (int j = 0; j < 4; ++j) { const float g = acc[ai][0][m][n][j], up = acc[ai][1][m][n][j]; h[n * 4 + j] = g * __builtin_amdgcn_rcpf(1.0f + __expf(-g)) * up; }
                u32x4 w; w.x = cvt_pk_bf16(h[0], h[1]); w.y = cvt_pk_bf16(h[2], h[3]); w.z = cvt_pk_bf16(h[4], h[5]); w.w = cvt_pk_bf16(h[6], h[7]);
                *(u32x4*)rowp = w; }
    }
};
struct MoeOrder {
    static constexpr bool GATHER = false, HALFS = false;
    int nN, G, c, nunits; const int* tab;
    __device__ void init(const int* tab_, int nN_, int G_, int c_) { tab = tab_; nN = nN_; G = G_; c = c_; nunits = tab_[0] * nN_; }
    __device__ bool next(int i, Unit& u) const {
        const int L = i * G + c; if (L >= nunits) return false;
        const int q = nunits / NXCD, r = nunits % NXCD, xcd = L % NXCD, off = L / NXCD;
        const int w = (xcd < r ? xcd * (q + 1) : r * (q + 1) + (xcd - r) * q) + off;
        u.pm = w / nN; u.pn = w - u.pm * nN; u.e = tab[1 + u.pm]; return true;
    }
    __device__ __forceinline__ void a_ready(const Unit&) const {}
    __device__ __forceinline__ void done(const Unit&) const {}
};
struct MoeOrderG : MoeOrder { static constexpr bool GATHER = true; const int* tok; };
}
enum { I_X = 0, I_C, I_CTX, I_CCTX, I_MODW, I_MODB, I_NMIXG, I_NFFNG, I_WIN, I_WOUT, I_LCW, I_LCB, I_LWA, I_LBA, I_LWX, I_LBX, I_LLAM,
       I_RMU, I_RWUP, I_RW0, I_RAUP, I_RA0, I_RGUP, I_RKK, I_RKA, I_RRK, I_RLNG, I_RLNB, I_MIB, I_MFB, I_MNG, I_GCW, I_GALOG, I_GDTB, I_GNG,
       I_FWG, I_FWU, I_FWD, I_MROUTER, I_MWG, I_MWU, I_MWD, I_FNG, N_IN };
struct Args { const float* in[N_IN]; float* out; unsigned char* ws; int ph_lo, ph_hi; };
struct Ctx {
    const float* const* in; float* out; unsigned char* ws; LAS unsigned char* lds;
    int tid, lane, wave, G, wg;
};
#define WSP(T, off) ((T*)(C.ws + (off)))

__device__ __forceinline__ int seqrow_raster(int i, int d, int b) {
    if (i < CTXL) { const int p = d ? (CTXL - 1 - i) : i; return T_LAT + b * CTXL + p; }
    const int j = i - CTXL; const int p = d ? (SEQ - 1 - j) : j; return b * SEQ + p;
}
__device__ __forceinline__ int seqrow_cm(int i, int d, int b) {
    if (i < CTXL) { const int p = d ? (CTXL - 1 - i) : i; return T_LAT + b * CTXL + p; }
    const int j = i - CTXL; const int p = d ? (SEQ - 1 - j) : j; return b * SEQ + (p & 63) * 64 + (p >> 6);
}

__device__ __forceinline__ void phase_pre(const Ctx& C) {
    LAS float* sc = (LAS float*)C.lds;
    LAS float* red = sc + 9 * 1024;
    float* modv = WSP(float, WS_MODV);
    bool filled = false;
    for (int it = C.wg; it < DEPTH * 48; it += C.G) {
        if (!filled) {
            for (int i = C.tid; i < 9 * 1024; i += NTHR) { const float v = i < 8192 ? C.in[I_C][i] : C.in[I_CCTX][i - 8192]; sc[i] = siluf_(v); }
            filled = true; __syncthreads();
        }
        const int l = it / 48, jb = it % 48, col = C.tid & 127, kg = C.tid >> 7;
        const float* W = C.in[I_MODW] + (size_t)l * 1024 * 6144 + jb * 128 + col;
        float acc[9];
#pragma unroll
        for (int r = 0; r < 9; ++r) acc[r] = 0.f;
        for (int k = kg * 256; k < kg * 256 + 256; ++k) { const float w = W[(size_t)k * 6144];
#pragma unroll
            for (int r = 0; r < 9; ++r) acc[r] += sc[r * 1024 + k] * w; }
#pragma unroll
        for (int r = 0; r < 9; ++r) red[(kg * 9 + r) * 128 + col] = acc[r];
        __syncthreads();
        for (int i = C.tid; i < 9 * 128; i += NTHR) { const int r = i >> 7, cc = i & 127;
            const float s = red[(0 * 9 + r) * 128 + cc] + red[(1 * 9 + r) * 128 + cc] + red[(2 * 9 + r) * 128 + cc] + red[(3 * 9 + r) * 128 + cc];
            modv[((size_t)l * 9 + r) * 6144 + jb * 128 + cc] = s + C.in[I_MODB][l * 6144 + jb * 128 + cc]; }
        __syncthreads();
    }
}

__device__ __forceinline__ void tr_item(const float* src, size_t ld, int k0, int ns0, bf16* dst, int drow0, int Kd, LAS float* scr, int lane, bool zero) {
    if (!zero) {
#pragma unroll 8
        for (int i = 0; i < 32; ++i) { const int kk = 2 * i + (lane >> 5); scr[kk * 33 + (lane & 31)] = src[(size_t)(k0 + kk) * ld + ns0 + (lane & 31)]; }
    }
    LDS_WAIT(); asm volatile("" ::: "memory");
    const int c = lane & 7;
#pragma unroll
    for (int j = 0; j < 4; ++j) { const int n = (lane >> 3) + 8 * j; const LAS float* s = scr + (8 * c) * 33 + n;
        v4u o; o.x = pk2(s[0 * 33], s[1 * 33]); o.y = pk2(s[2 * 33], s[3 * 33]); o.z = pk2(s[4 * 33], s[5 * 33]); o.w = pk2(s[6 * 33], s[7 * 33]);
        if (zero) o = (v4u){0u, 0u, 0u, 0u};
        *(v4u*)(dst + (size_t)(drow0 + n) * Kd + k0 + 8 * c) = o; }
    LDS_WAIT(); asm volatile("" ::: "memory");
}
__device__ __forceinline__ void convert_small(const Ctx& C, int l) {
    {
        bf16* lw = WSP(bf16, WS_LRUWT);
        for (int k = 0; k < 2 * 2 * 4 * 4096 / (128 * NTHR); ++k) {
            const int e = k * 128 * NTHR + C.wg * NTHR + C.tid;
            if (C.wg < 128) {
            const int i = e & 63, j = (e >> 6) & 63, hd = (e >> 12) & 3, g = (e >> 14) & 1, d = e >> 15;
            const float* src = (g ? C.in[I_LWX] : C.in[I_LWA]) + ((size_t)((l * 2 + d) * 4 + hd) * 64 + i) * 64 + j;
            lw[e] = (bf16)f2bf(*src);
            }
        }
    }
    if (C.wg >= 128 && C.wg < 224) {
        bf16* rw = WSP(bf16, WS_RWT);
        const int e = (C.wg - 128) * NTHR + C.tid;
        if (e < 32768) { const int r = e & 31, ch = (e >> 5) & 255, d = (e >> 13) & 1, isa = e >> 14;
            rw[e] = (bf16)f2bf((isa ? C.in[I_RAUP] : C.in[I_RWUP])[((size_t)(l * 2 + d) * 32 + r) * GW + ch]); }
        else { const int e2 = e - 32768, j = e2 & 63, ch = e2 >> 6; rw[e] = (bf16)f2bf(C.in[I_RGUP][((size_t)l * 64 + j) * GW + ch]); }
    }
}
__device__ __forceinline__ void convert_items(const Ctx& C, int l, int what, int gw, int NGW) {
    LAS float* scr = (LAS float*)(C.lds + C.wave * 8704);
    constexpr int I_IN = 16 * 112, I_OUT = 16 * 32, I_GU = 16 * 176, I_DN = 44 * 32, I_E = 16 * 88 + 22 * 32;
    const bool moe = l & 1; const int li = l >> 1;
    const int lo_it = (what & 1) ? 0 : I_IN, hi_it = (what & 2) ? I_IN + I_OUT + (moe ? NE * I_E : (I_GU + I_DN)) : I_IN;
    bf16* win = WSP(bf16, WS_WIN); bf16* wout = WSP(bf16, WS_WOUT); bf16* wgu = WSP(bf16, WS_WGU); bf16* wdn = WSP(bf16, WS_WDN);
    for (int it = lo_it + gw; it < hi_it; it += NGW) {
        int r = it;
        if (r < I_IN) { const int kb = r / 112, nb = r % 112; tr_item(C.in[I_WIN] + (size_t)l * 1024 * IN_COLS, IN_COLS, 64 * kb, 32 * nb, win, 32 * nb, 1024, scr, C.lane, nb == 111); continue; }
        r -= I_IN;
        if (r < I_OUT) { const int kb = r / 32, nb = r % 32; tr_item(C.in[I_WOUT] + (size_t)l * 1024 * 1024, 1024, 64 * kb, 32 * nb, wout, 32 * nb, 1024, scr, C.lane, false); continue; }
        r -= I_OUT;
        if (!moe) {
            if (r < I_GU) { const int kb = r / 176, nb = r % 176, tile = nb >> 3, q = nb & 7;
                const float* src = (q < 4 ? C.in[I_FWG] : C.in[I_FWU]) + (size_t)li * 1024 * DFF;
                tr_item(src, DFF, 64 * kb, tile * 128 + (q & 3) * 32, wgu, 32 * nb, 1024, scr, C.lane, false); continue; }
            r -= I_GU;
            { const int kb = r / 32, nb = r % 32; tr_item(C.in[I_FWD] + (size_t)li * DFF * 1024, 1024, 64 * kb, 32 * nb, wdn, 32 * nb, DFF, scr, C.lane, false); }
        } else {
            const int e = r / I_E; int rr = r % I_E;
            if (rr < 16 * 88) { const int kb = rr / 88, nb = rr % 88, tile = nb >> 3, q = nb & 7;
                const float* src = (q < 4 ? C.in[I_MWG] : C.in[I_MWU]) + ((size_t)li * NE + e) * 1024 * DFE;
                tr_item(src, DFE, 64 * kb, tile * 128 + (q & 3) * 32, wgu + (size_t)e * 2 * DFE * 1024, 32 * nb, 1024, scr, C.lane, false); continue; }
            rr -= 16 * 88;
            { const int kb = rr / 32, nb = rr % 32; tr_item(C.in[I_MWD] + ((size_t)li * NE + e) * DFE * 1024, 1024, 64 * kb, 32 * nb, wdn + (size_t)e * 1024 * DFE, 32 * nb, DFE, scr, C.lane, false); }
        }
    }
}

template <bool ROUTE>
__device__ __forceinline__ void norm_rows(const Ctx& C, int l, const void* xlat, bool xbf, const float* xctx, const float* gain, int shoff, int scoff, int nrows, int moe_li) {
    const float* modv = WSP(float, WS_MODV) + (size_t)l * 9 * 6144;
    bf16* hb = WSP(bf16, WS_HB);
    const int gw = C.wg * NWAVES + C.wave, NGW = C.G * NWAVES;
    LAS unsigned* lcnt = (LAS unsigned*)(C.lds + 65536);
    unsigned* route = WSP(unsigned, WS_ROUTE);
    if (ROUTE) { if (C.tid < 8) lcnt[C.tid] = 0u; __syncthreads(); }
    f32x4 gv[4];
#pragma unroll
    for (int j = 0; j < 4; ++j) gv[j] = *(const f32x4*)(gain + 4 * C.lane + 256 * j);
    v4u rawn[4]; bool rbfn = false;
#define NR_LOAD(mm) do { const int m_ = (mm); const bool ic_ = m_ >= T_LAT; rbfn = xbf && !ic_; \
        if (rbfn) { _Pragma("unroll") for (int j = 0; j < 4; ++j) { const v2u t_ = *(const v2u*)((const bf16*)xlat + (size_t)m_ * 1024 + 4 * C.lane + 256 * j); rawn[j] = (v4u){t_.x, t_.y, 0u, 0u}; } } \
        else { const float* xr_ = ic_ ? xctx + (size_t)(m_ - T_LAT) * 1024 : (const float*)xlat + (size_t)m_ * 1024; _Pragma("unroll") for (int j = 0; j < 4; ++j) rawn[j] = *(const v4u*)(xr_ + 4 * C.lane + 256 * j); } } while (0)
    if (gw < nrows) NR_LOAD(gw);
    for (int m = gw; m < nrows; m += NGW) {
        const bool isctx = m >= T_LAT;
        const float* mv = modv + (size_t)(isctx ? 8 : (m >> 12)) * 6144;
        v4u raw[4]; const bool rbf = rbfn;
#pragma unroll
        for (int j = 0; j < 4; ++j) raw[j] = rawn[j];
        if (m + NGW < nrows) NR_LOAD(m + NGW);
        f32x4 v[4]; float s = 0.f;
#pragma unroll
        for (int j = 0; j < 4; ++j) { v[j] = rbf ? (f32x4){bflo(raw[j].x), bfhi(raw[j].x), bflo(raw[j].y), bfhi(raw[j].y)} : __builtin_bit_cast(f32x4, raw[j]); s += (v[j].x * v[j].x + v[j].y * v[j].y) + (v[j].z * v[j].z + v[j].w * v[j].w); }
        const float rs = rsqrtf_(wave_sum(s) * (1.0f / 1024.0f) + 1e-6f);
#pragma unroll
        for (int j = 0; j < 4; ++j) { const f32x4 sh = *(const f32x4*)(mv + shoff + 4 * C.lane + 256 * j), scl = *(const f32x4*)(mv + scoff + 4 * C.lane + 256 * j);
            v[j] = (v[j] * rs * gv[j]) * (scl + 1.0f) + sh;
            v2u o; o.x = pk2(v[j].x, v[j].y); o.y = pk2(v[j].z, v[j].w);
            *(v2u*)(hb + (size_t)m * 1024 + 4 * C.lane + 256 * j) = o; }
        if (ROUTE) {
            const float* rt = C.in[I_MROUTER] + (size_t)moe_li * 1024 * NE;
            float lg[8];
#pragma unroll
            for (int e = 0; e < 8; ++e) lg[e] = 0.f;
#pragma unroll
            for (int j = 0; j < 4; ++j)
#pragma unroll
                for (int q = 0; q < 4; ++q) { const int k = 4 * C.lane + 256 * j + q; const f32x4 r0 = *(const f32x4*)(rt + (size_t)k * 8), r1 = *(const f32x4*)(rt + (size_t)k * 8 + 4); const float hv = v[j][q];
                    lg[0] += hv * r0.x; lg[1] += hv * r0.y; lg[2] += hv * r0.z; lg[3] += hv * r0.w; lg[4] += hv * r1.x; lg[5] += hv * r1.y; lg[6] += hv * r1.z; lg[7] += hv * r1.w; }
#pragma unroll
            for (int e = 0; e < 8; ++e) lg[e] = wave_sum(lg[e]);
            int e0 = 0; float l0 = lg[0];
#pragma unroll
            for (int e = 1; e < 8; ++e) if (lg[e] > l0) { l0 = lg[e]; e0 = e; }
            int e1 = (e0 == 0) ? 1 : 0; float l1 = -3.0e38f;
#pragma unroll
            for (int e = 0; e < 8; ++e) if (e != e0 && lg[e] > l1) { l1 = lg[e]; e1 = e; }
            const float w0 = __builtin_amdgcn_rcpf(1.0f + __expf(l1 - l0)), w1 = 1.0f - w0;
            if (C.lane == 0) {
                const unsigned r0 = atomicAdd((unsigned*)&lcnt[e0], 1u), r1 = atomicAdd((unsigned*)&lcnt[e1], 1u);
                v4u a; a.x = (unsigned)e0; a.y = (unsigned)e1; a.z = r0; a.w = r1;
                *(v4u*)(route + (size_t)m * 8) = a;
                v2u b; b.x = __builtin_bit_cast(unsigned, w0); b.y = __builtin_bit_cast(unsigned, w1);
                *(v2u*)(route + (size_t)m * 8 + 4) = b;
            }
        }
    }
#undef NR_LOAD
    if (ROUTE) {
        __syncthreads();
        if (C.tid < 8) { unsigned* gc = WSP(unsigned, WS_CTL) + CW_MOECNT + 64 * moe_li; const unsigned base = atomicAdd(gc + C.tid, lcnt[C.tid]); WSP(unsigned, WS_WGBASE)[C.wg * 8 + C.tid] = base; }
    }
}
#define RAW_BARRIER() do { asm volatile("s_waitcnt lgkmcnt(0)" ::: "memory"); __builtin_amdgcn_s_barrier(); asm volatile("" ::: "memory"); } while (0)
__device__ __forceinline__ void gdn_prep(const Ctx& C, int l, int b, int c) {
    const bf16* P = WSP(const bf16, WS_P); bf16* gq = WSP(bf16, WS_GQ);
    const bool isctx = c < 4; const int p0 = isctx ? c * 64 : (c - 4) * 64; const int Lp = isctx ? CTXL : SEQ;
    const int ch = 4 * C.lane;
    auto rowof = [&](int p) -> int { return isctx ? (T_LAT + b * CTXL + p) : (b * SEQ + (p & 63) * 64 + (p >> 6)); };
    f32x4 cw[4][3], x[4][3];
#pragma unroll
    for (int j = 0; j < 4; ++j)
#pragma unroll
        for (int g = 0; g < 3; ++g) cw[j][g] = *(const f32x4*)(C.in[I_GCW] + ((size_t)l * 4 + j) * 768 + g * 256 + ch);
    const int tb = p0 + C.wave * 8;
    auto ldrow = [&](int p, f32x4 (&dst)[3]) {
        if (p >= 0 && p < Lp) { const bf16* pr = P + (size_t)rowof(p) * PLD + OFF_D + ch;
#pragma unroll
            for (int g = 0; g < 3; ++g) dst[g] = ld4bf(pr + g * 256); }
        else {
#pragma unroll
            for (int g = 0; g < 3; ++g) dst[g] = (f32x4){0.f, 0.f, 0.f, 0.f}; }
    };
    ldrow(tb - 2, x[0]); ldrow(tb - 1, x[1]); ldrow(tb, x[2]);
#pragma unroll
    for (int t = 0; t < 8; ++t) {
        ldrow(tb + t + 1, x[3]);
        bf16* orow = gq + (size_t)rowof(tb + t) * 768 + ch;
#pragma unroll
        for (int g = 0; g < 3; ++g) {
            f32x4 v = cw[0][g] * x[0][g] + cw[1][g] * x[1][g] + cw[2][g] * x[2][g] + cw[3][g] * x[3][g];
            v = (f32x4){siluf_(v.x), siluf_(v.y), siluf_(v.z), siluf_(v.w)};
            if (g < 2) { const float ss = row16_sum((v.x * v.x + v.y * v.y) + (v.z * v.z + v.w * v.w)); v = v * (rsqrtf_(ss + 1e-6f) * (g == 0 ? 0.125f : 1.0f)); }
            st4bf(orow + g * 256, v);
        }
#pragma unroll
        for (int g = 0; g < 3; ++g) { x[0][g] = x[1][g]; x[1][g] = x[2][g]; x[2][g] = x[3][g]; }
    }
}
__device__ __forceinline__ void finish_rows(const Ctx& C, int l, int nrows) {
    const bf16* P = WSP(const bf16, WS_P); bf16* yc = WSP(bf16, WS_HB);
    const bf16* ob = WSP(const bf16, WS_OUTB); const bf16* oc = WSP(const bf16, WS_OUTC); const bf16* od = WSP(const bf16, WS_OUTD);
    const bf16* gg = WSP(const bf16, WS_G); const float* bonus = WSP(const float, WS_BONUS);
    const float* mu = C.in[I_RMU] + (size_t)l * 2 * B_COLS;
    const int gw = C.wg * NWAVES + C.wave, NGW = C.G * NWAVES, lane = C.lane, ch = 4 * lane, hh = lane >> 4;
    const f32x4 lng = *(const f32x4*)(C.in[I_RLNG] + l * GW + ch), lnb = *(const f32x4*)(C.in[I_RLNB] + l * GW + ch);
    const f32x4 mng = *(const f32x4*)(C.in[I_MNG] + l * GW + ch), gng = *(const f32x4*)(C.in[I_GNG] + l * GW + ch);
    const f32x4 mu0 = *(const f32x4*)(mu + 512 + ch), mu1 = *(const f32x4*)(mu + B_COLS + 512 + ch);
    const size_t o2 = (size_t)T_ALL * 256;
#pragma unroll 2
    for (int m = gw; m < nrows; m += NGW) {
        const bool isctx = m >= T_LAT; const int Lp = isctx ? CTXL : SEQ; const int p = isctx ? ((m - T_LAT) & (CTXL - 1)) : (m & (SEQ - 1));
        const f32x4 yb = ld4bf(ob + (size_t)m * 256 + ch) + ld4bf(ob + o2 + (size_t)m * 256 + ch);
        const f32x4 ycv = ld4bf(oc + (size_t)m * 256 + ch) + ld4bf(oc + o2 + (size_t)m * 256 + ch);
        const f32x4 yd = ld4bf(od + (size_t)m * 256 + ch) + ld4bf(od + o2 + (size_t)m * 256 + ch);
        const bf16* pr = P + (size_t)m * PLD;
        const f32x4 vs = ld4bf(WSP(const bf16, WS_RKV) + (size_t)m * 768 + 512 + ch);
        const f32x4 og = ld4bf(pr + OFF_C + 768 + ch), gd = ld4bf(pr + OFF_D + 768 + ch), gr = ld4bf(gg + (size_t)m * 256 + ch);
        const float bn = bonus[(size_t)m * 4 + hh];
        *(v2u*)(yc + (size_t)m * 1024 + ch) = *(const v2u*)(pr + 256 + ch);
        {
            const float mean = row16_sum((yb.x + yb.y) + (yb.z + yb.w)) * (1.0f / 64.0f);
            const f32x4 dl = yb - mean;
            const float var = row16_sum((dl.x * dl.x + dl.y * dl.y) + (dl.z * dl.z + dl.w * dl.w)) * (1.0f / 64.0f);
            const f32x4 yn = dl * rsqrtf_(var + 64e-5f) * lng + lnb;
            st4bf(yc + (size_t)m * 1024 + 256 + ch, (yn + vs * bn) * gr);
        }
        {
            const float ms = row16_sum((ycv.x * ycv.x + ycv.y * ycv.y) + (ycv.z * ycv.z + ycv.w * ycv.w)) * (1.0f / 64.0f);
            const f32x4 sg = (f32x4){sigmoidf_(og.x), sigmoidf_(og.y), sigmoidf_(og.z), sigmoidf_(og.w)};
            st4bf(yc + (size_t)m * 1024 + 512 + ch, ycv * rsqrtf_(ms + 1e-6f) * mng * sg);
        }
        {
            const float ms = row16_sum((yd.x * yd.x + yd.y * yd.y) + (yd.z * yd.z + yd.w * yd.w)) * (1.0f / 64.0f);
            const f32x4 sg = (f32x4){siluf_(gd.x), siluf_(gd.y), siluf_(gd.z), siluf_(gd.w)};
            st4bf(yc + (size_t)m * 1024 + 768 + ch, yd * rsqrtf_(ms + 1e-6f) * gng * sg);
        }
    }
}
typedef bf16x8 fragb;
__device__ __forceinline__ f32x4 mfma16(fragb a, fragb b, f32x4 c) { return __builtin_amdgcn_mfma_f32_16x16x32_bf16(a, b, c, 0, 0, 0); }
__device__ __forceinline__ fragb ld_frag16(const LAS bf16* p) { return *(const LAS fragb*)p; }
__device__ __forceinline__ fragb ld_frag8x2(const LAS bf16* p0, const LAS bf16* p1) {
    const v2u a = *(const LAS v2u*)p0, b = *(const LAS v2u*)p1; v4u r; r.x = a.x; r.y = a.y; r.z = b.x; r.w = b.y; return __builtin_bit_cast(fragb, r); }
__device__ __forceinline__ fragb pack_frag(const f32x4& lo, const f32x4& hi) { v4u r; r.x = pk2(lo.x, lo.y); r.y = pk2(lo.z, lo.w); r.z = pk2(hi.x, hi.y); r.w = pk2(hi.z, hi.w); return __builtin_bit_cast(fragb, r); }
__device__ __forceinline__ float wave_incl_sum(float v, int lane) {
    v += dpp_x<0x111, 0xF, true>(0.f, v); v += dpp_x<0x112, 0xF, true>(0.f, v); v += dpp_x<0x114, 0xF, true>(0.f, v); v += dpp_x<0x118, 0xF, true>(0.f, v);
    v += dpp_x<0x142, 0xA, false>(0.f, v); v += dpp_x<0x143, 0xC, false>(0.f, v);
    return v;
}
__device__ __forceinline__ float wave_incl_max(float v, int lane) {
    const float ninf = -3.0e38f;
    v = fmaxf(v, dpp_x<0x111, 0xF, false>(ninf, v)); v = fmaxf(v, dpp_x<0x112, 0xF, false>(ninf, v)); v = fmaxf(v, dpp_x<0x114, 0xF, false>(ninf, v)); v = fmaxf(v, dpp_x<0x118, 0xF, false>(ninf, v));
    v = fmaxf(v, dpp_x<0x142, 0xA, false>(ninf, v)); v = fmaxf(v, dpp_x<0x143, 0xC, false>(ninf, v));
    return v;
}
constexpr int MP = 72;
__device__ __forceinline__ void mlstm_chunked(const Ctx& C, int l, int idx) {
    const int d = idx >> 5, b = (idx >> 2) & 7, h = idx & 3, lane = C.lane, w = C.wave, l15 = lane & 15, q = lane >> 4;
    const int it = w & 3, vtp = w >> 2;
    constexpr int IMG = 64 * MP * 2, BUFB = 4 * IMG + 1024, CTB = 65 * MP * 2 + 16;
    LAS unsigned char* L0 = C.lds;
    const bf16* P = WSP(const bf16, WS_P); bf16* outc = WSP(bf16, WS_OUTC) + (size_t)d * T_ALL * 256;
    const float ib = C.in[I_MIB][(l * 2 + d) * NH + h], fb = C.in[I_MFB][(l * 2 + d) * NH + h];
    const int tt = C.tid >> 3, part = C.tid & 7;
    for (int i = C.tid; i < 2 * CTB / 4; i += NTHR) ((LAS unsigned*)(L0 + 2 * BUFB))[i] = 0u;
    v4u rq, rk, rv; unsigned short rgi, rgf;
    auto gload = [&](int n) {
        const int row = seqrow_cm(n * 64 + tt, d, b);
        const bf16* pp = P + (size_t)row * PLD + OFF_C + h * 64 + 8 * part;
        rq = *(const v4u*)pp; rk = *(const v4u*)(pp + 256); rv = *(const v4u*)(pp + 512);
        const bf16* pg = P + (size_t)seqrow_cm(n * 64 + lane, d, b) * PLD + OFF_C + 1024 + d * 4 + h;
        rgi = pg[0]; rgf = pg[8];
    };
    auto images = [&](int bufi) {
        LAS unsigned char* B0 = L0 + bufi * BUFB;
        LAS bf16* Qs = (LAS bf16*)B0; LAS bf16* Ks = Qs + 64 * MP; LAS bf16* VT = Ks + 64 * MP; LAS bf16* KTw = VT + 64 * MP; LAS float* vec = (LAS float*)(B0 + 4 * IMG);
        const float li = bf2f(rgi) + ib, lf = -softplusf_(-(bf2f(rgf) + fb));
        const float bc = wave_incl_sum(lf, lane), x = li - bc, cm = wave_incl_max(x, lane);
        const float wl = __expf(x - __shfl(cm, 63)) * 0.125f;
        if (w == 0) { vec[lane] = x; vec[64 + lane] = cm; vec[128 + lane] = bc; }
        const float wmine = __shfl(wl, 8 * w + (lane >> 3));
        *(LAS v4u*)(Qs + tt * MP + 8 * part) = rq; *(LAS v4u*)(Ks + tt * MP + 8 * part) = rk;
        const unsigned vv[4] = {rv.x, rv.y, rv.z, rv.w}, kk[4] = {rk.x, rk.y, rk.z, rk.w};
#pragma unroll
        for (int e = 0; e < 4; ++e) {
            VT[(8 * part + 2 * e) * MP + tt] = (bf16)(vv[e] & 0xffffu); VT[(8 * part + 2 * e + 1) * MP + tt] = (bf16)(vv[e] >> 16);
            KTw[(8 * part + 2 * e) * MP + tt] = (bf16)f2bf1(bflo(kk[e]) * wmine); KTw[(8 * part + 2 * e + 1) * MP + tt] = (bf16)f2bf1(bfhi(kk[e]) * wmine);
        }
    };
    f32x4 Cst[2], nst; float m = 0.f;
    Cst[0] = Cst[1] = nst = (f32x4){0.f, 0.f, 0.f, 0.f};
    const fragb ones = __builtin_bit_cast(fragb, (v4u){0x3F803F80u, 0x3F803F80u, 0x3F803F80u, 0x3F803F80u});
    const f32x4 z4 = (f32x4){0.f, 0.f, 0.f, 0.f};
    gload(0); images(0); gload(1);
#pragma unroll 1
    for (int n = 0; n < NCH; ++n) {
        RAW_BARRIER();
        const LAS unsigned char* B0 = L0 + (n & 1) * BUFB;
        const LAS bf16* Qs = (const LAS bf16*)B0; const LAS bf16* Ks = Qs + 64 * MP; const LAS bf16* VT = Ks + 64 * MP; const LAS bf16* KTw = VT + 64 * MP; const LAS float* vec = (const LAS float*)(B0 + 4 * IMG);
        const LAS bf16* CT = (const LAS bf16*)(L0 + 2 * BUFB + (n & 1) * CTB); LAS bf16* CTn = (LAS bf16*)(L0 + 2 * BUFB + ((n + 1) & 1) * CTB);
        fragb Qf[2]; Qf[0] = ld_frag16(Qs + (16 * it + l15) * MP + 8 * q); Qf[1] = ld_frag16(Qs + (16 * it + l15) * MP + 32 + 8 * q);
        const float cmi = vec[64 + 16 * it + l15]; const int icol = 16 * it + l15;
        f32x4 pt[4];
#pragma unroll
        for (int jt = 0; jt < 4; ++jt) {
            pt[jt] = z4;
            if (jt <= it) {
                const fragb k0 = ld_frag16(Ks + (16 * jt + l15) * MP + 8 * q), k1 = ld_frag16(Ks + (16 * jt + l15) * MP + 32 + 8 * q);
                f32x4 st = mfma16(k0, Qf[0], z4); st = mfma16(k1, Qf[1], st);
                const f32x4 xj = *(const LAS f32x4*)(vec + 16 * jt + 4 * q);
#pragma unroll
                for (int r = 0; r < 4; ++r) { const int j = 16 * jt + 4 * q + r; pt[jt][r] = (j <= icol) ? st[r] * __expf(xj[r] - cmi) * 0.125f : 0.f; }
            }
        }
        fragb Pf[2]; Pf[0] = pack_frag(pt[0], pt[1]); Pf[1] = pack_frag(pt[2], pt[3]);
        fragb Vf[2][2];
#pragma unroll
        for (int v2 = 0; v2 < 2; ++v2)
#pragma unroll
            for (int s = 0; s < 2; ++s) { const LAS bf16* vr = VT + (16 * (2 * vtp + v2) + l15) * MP + 32 * s + 4 * q; Vf[v2][s] = ld_frag8x2(vr, vr + 16); }
        f32x4 Aacc[2], R[2], as, dn;
        as = mfma16(Pf[0], ones, z4); if (it >= 2) as = mfma16(Pf[1], ones, as);
        const fragb nf0 = ld_frag16(CT + 64 * MP + 8 * q), nf1 = ld_frag16(CT + 64 * MP + 32 + 8 * q);
        dn = mfma16(Qf[0], nf0, z4); dn = mfma16(Qf[1], nf1, dn);
#pragma unroll
        for (int v2 = 0; v2 < 2; ++v2) {
            Aacc[v2] = mfma16(Pf[0], Vf[v2][0], z4); if (it >= 2) Aacc[v2] = mfma16(Pf[1], Vf[v2][1], Aacc[v2]);
            const LAS bf16* cr = CT + (16 * (2 * vtp + v2) + l15) * MP + 8 * q;
            R[v2] = mfma16(Qf[0], ld_frag16(cr), z4); R[v2] = mfma16(Qf[1], ld_frag16(cr + 32), R[v2]);
        }
        {
            const f32x4 bi = *(const LAS f32x4*)(vec + 128 + 16 * it + 4 * q), cmr = *(const LAS f32x4*)(vec + 64 + 16 * it + 4 * q);
#pragma unroll
            for (int r = 0; r < 4; ++r) {
                const float mi = bi[r] + cmr[r], minter = bi[r] + m, mt = fmaxf(minter, mi), e1 = __expf(mi - mt), e2 = __expf(minter - mt);
                const float den = e1 * as[r] + e2 * dn[r]; const float inv = __builtin_amdgcn_rcpf(fmaxf(fabsf(den), __expf(-mt)));
                const int row = seqrow_cm(n * 64 + 16 * it + 4 * q + r, d, b);
#pragma unroll
                for (int v2 = 0; v2 < 2; ++v2) outc[(size_t)row * 256 + h * 64 + 16 * (2 * vtp + v2) + l15] = (bf16)f2bf1((e1 * Aacc[v2][r] + e2 * R[v2][r]) * inv);
            }
        }
        {
            const LAS bf16* kr = KTw + (16 * it + l15) * MP + 4 * q;
            const fragb kt0 = ld_frag8x2(kr, kr + 16), kt1 = ld_frag8x2(kr + 32, kr + 48);
            const float bL = vec[128 + 63], mloc = bL + vec[64 + 63];
            const float mnew = fmaxf(bL + m, mloc), wp = __expf(bL + m - mnew), wn = __expf(mloc - mnew);
            f32x4 gk = mfma16(kt0, ones, z4); gk = mfma16(kt1, ones, gk);
            nst = nst * wp + gk * wn;
#pragma unroll
            for (int v2 = 0; v2 < 2; ++v2) {
                f32x4 G = mfma16(kt0, Vf[v2][0], z4); G = mfma16(kt1, Vf[v2][1], G);
                Cst[v2] = Cst[v2] * wp + G * wn;
                v2u o; o.x = pk2(Cst[v2].x, Cst[v2].y); o.y = pk2(Cst[v2].z, Cst[v2].w);
                *(LAS v2u*)(CTn + (16 * (2 * vtp + v2) + l15) * MP + 16 * it + 4 * q) = o;
            }
            if (vtp == 0 && l15 == 0) { v2u o; o.x = pk2(nst.x, nst.y); o.y = pk2(nst.z, nst.w); *(LAS v2u*)(CTn + 64 * MP + 16 * it + 4 * q) = o; }
            m = mnew;
        }
        if (n + 1 < NCH) { images((n + 1) & 1); if (n + 2 < NCH) gload(n + 2); }
    }
    __syncthreads();
}
__device__ __forceinline__ int fwd_row_cm(int b, int c, int t) { return c < 4 ? (T_LAT + b * CTXL + c * 64 + t) : (b * SEQ + t * 64 + (c - 4)); }
__device__ __forceinline__ bf16* blob_row(const Ctx& C, int d, int isw, int b, int c, int h, int r) {
    const int row = fwd_row_cm(b, c, r);
    if (d == 1 && isw) return WSP(bf16, WS_OUTD) + ((size_t)T_ALL + row) * 256 + h * 64;
    return WSP(bf16, WS_P) + (size_t)row * PLD + OFF_D + (d * 2 + isw) * 256 + h * 64;
}
constexpr int LP = 68;
__device__ __forceinline__ void blocked_solve(const LAS bf16* Ln, const LAS bf16* TinvP, LAS unsigned char* XTw, f32x4 (&acc)[4][4], int l15, int q) {
    const f32x4 z4 = (f32x4){0.f, 0.f, 0.f, 0.f};
#pragma unroll
    for (int I = 0; I < 4; ++I) {
        const fragb Af = *(const LAS fragb*)(TinvP + (I * 16 + l15) * 32 + 8 * q);
        fragb A0, A1;
        if (I >= 1) A0 = ld_frag16(Ln + (16 * I + l15) * MP + 8 * q);
        if (I == 3) A1 = ld_frag16(Ln + (16 * I + l15) * MP + 32 + 8 * q);
#pragma unroll
        for (int nt = 0; nt < 4; ++nt) {
            const int crow = 16 * nt + l15; LAS unsigned char* xr = XTw + crow * 128;
            f32x4 a = acc[I][nt];
            if (I >= 1) a = mfma16(A0, *(const LAS fragb*)(xr + ((q ^ (crow & 7)) << 4)), a);
            if (I == 3) a = mfma16(A1, *(const LAS fragb*)(xr + (((4 + q) ^ (crow & 7)) << 4)), a);
            v4u bw; bw.x = pk2(a.x, a.y); bw.y = pk2(a.z, a.w); bw.z = 0u; bw.w = 0u;
            const f32x4 x = mfma16(Af, __builtin_bit_cast(fragb, bw), z4);
            acc[I][nt] = x;
            v2u o; o.x = pk2(x.x, x.y); o.y = pk2(x.z, x.w);
            *(LAS v2u*)(xr + (((2 * I + (q >> 1)) ^ (crow & 7)) << 4) + (q & 1) * 8) = o;
        }
    }
}
__device__ __forceinline__ void diag_inverses(const LAS bf16* Ln, LAS bf16* TinvP, int lane) {
    const int blk = lane >> 4, c = lane & 15;
    float x[16];
#pragma unroll
    for (int i = 0; i < 16; ++i) {
        const LAS bf16* lr = Ln + (16 * blk + i) * MP + 16 * blk;
        const v4u r0 = *(const LAS v4u*)lr, r1 = *(const LAS v4u*)(lr + 8);
        const unsigned rw[8] = {r0.x, r0.y, r0.z, r0.w, r1.x, r1.y, r1.z, r1.w};
        float s = (i == c) ? 1.0f : 0.0f;
#pragma unroll
        for (int j = 0; j < i; ++j) s += ((j & 1) ? bfhi(rw[j >> 1]) : bflo(rw[j >> 1])) * x[j];
        x[i] = s;
        TinvP[(blk * 16 + i) * 32 + 8 * (c >> 2) + (c & 3)] = (bf16)f2bf1(s);
    }
}
__device__ __forceinline__ void gdn_solve_item(const Ctx& C, int l, int item) {
    const int lane = C.lane, w = C.wave, pw = w & 1, pi = w >> 1, l15 = lane & 15, q = lane >> 4;
    LAS unsigned char* B0 = C.lds + pi * 31744;
    LAS bf16* Ln = (LAS bf16*)B0;
    LAS bf16* TinvP = (LAS bf16*)(B0 + 9216);
    LAS float* vec = (LAS float*)(B0 + 13312);
    LAS unsigned char* XT = B0 + 13824;
    LAS bf16* Ks = (LAS bf16*)XT;
    const bf16* P = WSP(const bf16, WS_P); const bf16* gq = WSP(const bf16, WS_GQ);
    const int u = item >> 1, d = item & 1;
    const int c = u % NCH, h = (u / NCH) & 3, b = u / (NCH * NH);
    const int n = d ? (c < 4 ? 3 - c : 71 - c) : c;
    const float aexp = __expf(C.in[I_GALOG][(l * 2 + d) * NH + h]), dtb = C.in[I_GDTB][(l * 2 + d) * NH + h];
    const int rowl = seqrow_cm(n * 64 + lane, d, b);
    const bf16* pg = P + (size_t)rowl * PLD + OFF_D + 1024 + d * 4 + h;
    const float la = -aexp * softplusf_(bf2f(pg[0]) + dtb), beta = sigmoidf_(bf2f(pg[8]));
    const float gam = wave_incl_sum(la, lane);
    if (pw == 0) { vec[lane] = beta; vec[64 + lane] = gam; }
#pragma unroll
    for (int r = 0; r < 4; ++r) { const int idx = pw * 64 + lane + 128 * r, t = idx >> 3, part = idx & 7;
        *(LAS v4u*)(Ks + t * MP + 8 * part) = *(const v4u*)(gq + (size_t)seqrow_cm(n * 64 + t, d, b) * 768 + 256 + h * 64 + 8 * part); }
    { LAS v4u* tz = (LAS v4u*)(B0 + 9216) + (pw * 64 + lane) * 2; tz[0] = (v4u){0u, 0u, 0u, 0u}; tz[1] = (v4u){0u, 0u, 0u, 0u}; }
    f32x4 acc[4][4];
    if (pw == 0) {
#pragma unroll
        for (int I = 0; I < 4; ++I)
#pragma unroll
            for (int r = 0; r < 4; ++r) { const bf16* vr = gq + (size_t)seqrow_cm(n * 64 + 16 * I + 4 * q + r, d, b) * 768 + 512 + h * 64 + l15;
#pragma unroll
                for (int nt = 0; nt < 4; ++nt) acc[I][nt][r] = bf2f(vr[16 * nt]); }
    }
    __syncthreads();
    {
        int tix = 0;
#pragma unroll
        for (int it = 0; it < 4; ++it)
#pragma unroll
            for (int jt = 0; jt < 4; ++jt, ++tix) if ((tix & 1) == pw) {
                f32x4 t4 = (f32x4){0.f, 0.f, 0.f, 0.f};
                if (jt <= it) {
#pragma unroll
                    for (int s = 0; s < 2; ++s) t4 = mfma16(ld_frag16(Ks + (16 * it + l15) * MP + 32 * s + 8 * q), ld_frag16(Ks + (16 * jt + l15) * MP + 32 * s + 8 * q), t4);
                    const float gj = vec[64 + 16 * jt + l15];
                    const f32x4 bi = *(const LAS f32x4*)(vec + 16 * it + 4 * q), gi = *(const LAS f32x4*)(vec + 64 + 16 * it + 4 * q);
#pragma unroll
                    for (int r = 0; r < 4; ++r) { const int i = 16 * it + 4 * q + r, j = 16 * jt + l15; t4[r] = (j < i) ? -(bi[r] * t4[r] * __expf(gi[r] - gj)) : 0.f; }
                }
#pragma unroll
                for (int r = 0; r < 4; ++r) Ln[(16 * it + 4 * q + r) * MP + 16 * jt + l15] = (bf16)f2bf1(t4[r]);
            }
    }
    {
#pragma unroll
        for (int I = 0; I < 4; ++I) {
            const f32x4 bi = *(const LAS f32x4*)(vec + 16 * I + 4 * q), gi = *(const LAS f32x4*)(vec + 64 + 16 * I + 4 * q);
#pragma unroll
            for (int r = 0; r < 4; ++r) { const float sc = pw ? bi[r] * __expf(gi[r]) : bi[r];
#pragma unroll
                for (int nt = 0; nt < 4; ++nt) acc[I][nt][r] = (pw ? bf2f(Ks[(16 * I + 4 * q + r) * MP + 16 * nt + l15]) : acc[I][nt][r]) * sc; }
        }
    }
    __syncthreads();
    if (pw == 0) diag_inverses(Ln, TinvP, lane);
    LAS unsigned char* XTw = XT + pw * 8192;
    { LAS v4u* xz = (LAS v4u*)(XTw + lane * 128);
#pragma unroll
        for (int g = 0; g < 8; ++g) xz[g] = (v4u){0u, 0u, 0u, 0u}; }
    __syncthreads();
    blocked_solve(Ln, TinvP, XTw, acc, l15, q);
    {
        bf16* dst = blob_row(C, d, pw, b, c, h, lane);
        const LAS unsigned char* xr = XTw + lane * 128;
#pragma unroll
        for (int g = 0; g < 8; ++g) *(v4u*)(dst + 8 * g) = *(const LAS v4u*)(xr + ((g ^ (lane & 7)) << 4));
    }
    __syncthreads();
}

template <bool DRY>
__device__ __forceinline__ void gdn_chunked(const Ctx& C, int l, int idx) {
    const int d = idx >> 5, b = (idx >> 2) & 7, h = idx & 3, lane = C.lane, w = C.wave, l15 = lane & 15, q = lane >> 4;
    const int it = w & 3, vtp = w >> 2;
    constexpr int IMG = 64 * MP * 2, BUFB = 5 * IMG + 512;
    LAS unsigned char* L0 = C.lds;
    LAS bf16* VnT = (LAS bf16*)(L0 + 2 * BUFB + 2 * IMG);
    const bf16* P = WSP(const bf16, WS_P); const bf16* gq = WSP(const bf16, WS_GQ); bf16* outd = WSP(bf16, WS_OUTD) + (size_t)d * T_ALL * 256;
    const float aexp = __expf(C.in[I_GALOG][(l * 2 + d) * NH + h]), dtb = C.in[I_GDTB][(l * 2 + d) * NH + h];
    const int tt = C.tid >> 3, part = C.tid & 7;
    for (int i = C.tid; i < 2 * IMG / 4; i += NTHR) ((LAS unsigned*)(L0 + 2 * BUFB))[i] = 0u;
    v4u rq, rk, ru, rw; unsigned short rga;
    auto gload = [&](int n) {
        const int c = d ? (n < 4 ? 3 - n : 71 - n) : n;
        const bf16* pp = gq + (size_t)seqrow_cm(n * 64 + tt, d, b) * 768 + h * 64 + 8 * part;
        rq = *(const v4u*)pp; rk = *(const v4u*)(pp + 256);
        ru = *(const v4u*)(blob_row(C, d, 0, b, c, h, tt) + 8 * part); rw = *(const v4u*)(blob_row(C, d, 1, b, c, h, tt) + 8 * part);
        rga = P[(size_t)seqrow_cm(n * 64 + lane, d, b) * PLD + OFF_D + 1024 + d * 4 + h];
    };
    auto images = [&](int bufi) {
        LAS unsigned char* B0 = L0 + bufi * BUFB;
        LAS bf16* Qs = (LAS bf16*)B0; LAS bf16* Ks = Qs + 64 * MP; LAS bf16* KdT = Ks + 64 * MP; LAS bf16* Wi = KdT + 64 * MP; LAS bf16* UT = Wi + 64 * MP; LAS float* vec = (LAS float*)(B0 + 5 * IMG);
        const float la = -aexp * softplusf_(bf2f(rga) + dtb);
        const float gam = wave_incl_sum(la, lane);
        if (w == 0) vec[lane] = gam;
        const float kd = __expf(__shfl(gam, 63) - gam);
        const float kmine = __shfl(kd, 8 * w + (lane >> 3));
        *(LAS v4u*)(Qs + tt * MP + 8 * part) = rq; *(LAS v4u*)(Ks + tt * MP + 8 * part) = rk; *(LAS v4u*)(UT + tt * MP + 8 * part) = ru;
        const unsigned kk[4] = {rk.x, rk.y, rk.z, rk.w}, ww[4] = {rw.x, rw.y, rw.z, rw.w};
#pragma unroll
        for (int e = 0; e < 4; ++e) {
            KdT[(8 * part + 2 * e) * MP + tt] = (bf16)f2bf1(bflo(kk[e]) * kmine); KdT[(8 * part + 2 * e + 1) * MP + tt] = (bf16)f2bf1(bfhi(kk[e]) * kmine);
            Wi[(8 * part + 2 * e) * MP + tt] = (bf16)(ww[e] & 0xffffu); Wi[(8 * part + 2 * e + 1) * MP + tt] = (bf16)(ww[e] >> 16);
        }
    };
    f32x4 Sst[2]; Sst[0] = Sst[1] = (f32x4){0.f, 0.f, 0.f, 0.f};
    const f32x4 z4 = (f32x4){0.f, 0.f, 0.f, 0.f};
    gload(0); images(0); gload(1);
#pragma unroll 1
    for (int n = 0; n < NCH; ++n) {
        RAW_BARRIER();
        const LAS unsigned char* B0 = L0 + (n & 1) * BUFB;
        const LAS bf16* Qs = (const LAS bf16*)B0; const LAS bf16* Ks = Qs + 64 * MP; const LAS bf16* KdT = Ks + 64 * MP; const LAS bf16* Wi = KdT + 64 * MP; const LAS bf16* UT = Wi + 64 * MP; const LAS float* vec = (const LAS float*)(B0 + 5 * IMG);
        const LAS bf16* ST = (const LAS bf16*)(L0 + 2 * BUFB + (n & 1) * IMG); LAS bf16* STn = (LAS bf16*)(L0 + 2 * BUFB + ((n + 1) & 1) * IMG);
        fragb Qf[2]; Qf[0] = ld_frag16(Qs + (16 * it + l15) * MP + 8 * q); Qf[1] = ld_frag16(Qs + (16 * it + l15) * MP + 32 + 8 * q);
        const float gcol = vec[16 * it + l15]; const int icol = 16 * it + l15;
        f32x4 pt[4];
#pragma unroll
        for (int jt = 0; jt < 4; ++jt) {
            pt[jt] = z4;
            if (jt <= it) {
                const fragb k0 = ld_frag16(Ks + (16 * jt + l15) * MP + 8 * q), k1 = ld_frag16(Ks + (16 * jt + l15) * MP + 32 + 8 * q);
                f32x4 st = mfma16(k0, Qf[0], z4); st = mfma16(k1, Qf[1], st);
                const f32x4 gj = *(const LAS f32x4*)(vec + 16 * jt + 4 * q);
#pragma unroll
                for (int r = 0; r < 4; ++r) { const int j = 16 * jt + 4 * q + r; pt[jt][r] = (j <= icol) ? st[r] * __expf(gcol - gj[r]) : 0.f; }
            }
        }
        fragb Pf[2]; Pf[0] = pack_frag(pt[0], pt[1]); Pf[1] = pack_frag(pt[2], pt[3]);
        const fragb Wf0 = ld_frag16(Wi + (16 * it + l15) * MP + 8 * q), Wf1 = ld_frag16(Wi + (16 * it + l15) * MP + 32 + 8 * q);
        f32x4 Ro[2];
#pragma unroll
        for (int v2 = 0; v2 < 2; ++v2) {
            const int vrow = 16 * (2 * vtp + v2) + l15;
            const fragb s0 = ld_frag16(ST + vrow * MP + 8 * q), s1 = ld_frag16(ST + vrow * MP + 32 + 8 * q);
            f32x4 ws = mfma16(Wf0, s0, z4); ws = mfma16(Wf1, s1, ws);
            Ro[v2] = mfma16(Qf[0], s0, z4); Ro[v2] = mfma16(Qf[1], s1, Ro[v2]);
            const v2u ur = *(const LAS v2u*)(UT + vrow * MP + 16 * it + 4 * q);
            v2u o; o.x = pk2(bflo(ur.x) - ws.x, bfhi(ur.x) - ws.y); o.y = pk2(bflo(ur.y) - ws.z, bfhi(ur.y) - ws.w);
            *(LAS v2u*)(VnT + vrow * MP + 16 * it + 4 * q) = o;
        }
        RAW_BARRIER();
        {
            const f32x4 gi = *(const LAS f32x4*)(vec + 16 * it + 4 * q);
            const float gl = __expf(vec[63]);
            const LAS bf16* kr = KdT + (16 * it + l15) * MP + 4 * q;
            const fragb kt0 = ld_frag8x2(kr, kr + 16), kt1 = ld_frag8x2(kr + 32, kr + 48);
#pragma unroll
            for (int v2 = 0; v2 < 2; ++v2) {
                const int vrow = 16 * (2 * vtp + v2) + l15;
                const LAS bf16* vr = VnT + vrow * MP + 4 * q;
                const fragb n0 = ld_frag8x2(vr, vr + 16), n1 = ld_frag8x2(vr + 32, vr + 48);
                f32x4 o = mfma16(Pf[0], n0, z4); if (it >= 2) o = mfma16(Pf[1], n1, o);
#pragma unroll
                for (int r = 0; r < 4; ++r) { const int row = seqrow_cm(n * 64 + 16 * it + 4 * q + r, d, b);
                    if (!DRY) outd[(size_t)row * 256 + h * 64 + vrow] = (bf16)f2bf1(o[r] + __expf(gi[r]) * Ro[v2][r]); }
                f32x4 ns = mfma16(kt0, n0, z4); ns = mfma16(kt1, n1, ns);
                Sst[v2] = Sst[v2] * gl + ns;
                v2u so; so.x = pk2(Sst[v2].x, Sst[v2].y); so.y = pk2(Sst[v2].z, Sst[v2].w);
                *(LAS v2u*)(STn + vrow * MP + 16 * it + 4 * q) = so;
            }
        }
        if (n + 1 < NCH) { images((n + 1) & 1); if (n + 2 < NCH) gload(n + 2); }
    }
    __syncthreads();
}
constexpr int UP = 264;
template <int CTRL> __device__ __forceinline__ float dpp_keep(float oldv, float v) { return __builtin_bit_cast(float, __builtin_amdgcn_update_dpp(__builtin_bit_cast(int, oldv), __builtin_bit_cast(int, v), CTRL, 0xF, 0xF, false)); }
template <bool REV> __device__ __forceinline__ void scan16(float& A, float& B) {
#define LRU_STEP(S) { const float Ap = dpp_keep<(REV ? 0x100 : 0x110) | S>(1.0f, A), Bp = dpp_keep<(REV ? 0x100 : 0x110) | S>(0.0f, B); B = A * Bp + B; A = A * Ap; }
    LRU_STEP(1) LRU_STEP(2) LRU_STEP(4) LRU_STEP(8)
#undef LRU_STEP
}
constexpr int UPC = 72;
__device__ __forceinline__ int lru_chunk_of(int d, int k) { return d ? (k < 4 ? 3 - k : NCH + 3 - k) : k; }
template <bool REV>
__device__ __forceinline__ void lru_tiles(const LAS bf16* Ud, int th, int mt, int lane, const fragb (&Wa)[2], const fragb (&Wx)[2], const f32x4& ba, const f32x4& bx, const f32x4& sp4,
                                          f32x4 (&Ac)[2], f32x4 (&Hl)[2], f32x4& Atot, f32x4& hend) {
    const int l15 = lane & 15, q = lane >> 4, edge = (lane & 48) | (REV ? 0 : 15);
    const f32x4 z4 = (f32x4){0.f, 0.f, 0.f, 0.f};
    f32x4 tA = z4, tB = z4;
#pragma unroll
    for (int i = 0; i < 2; ++i) {
        const int nt = REV ? 3 - (2 * th + i) : 2 * th + i;
        const LAS bf16* urow = Ud + (16 * nt + l15) * UPC;
        const fragb Uf0 = ld_frag16(urow + 8 * q), Uf1 = ld_frag16(urow + 32 + 8 * q);
        f32x4 aa = mfma16(Wa[0], Uf0, z4); aa = mfma16(Wa[1], Uf1, aa);
        f32x4 ax = mfma16(Wx[0], Uf0, z4); ax = mfma16(Wx[1], Uf1, ax);
        const v2u ur = *(const LAS v2u*)(urow + 16 * mt + 4 * q);
        const f32x4 u4 = (f32x4){bflo(ur.x), bfhi(ur.x), bflo(ur.y), bfhi(ur.y)};
        f32x4 la, iu, A, Bv;
#pragma unroll
        for (int r = 0; r < 4; ++r) { const float rg = sigmoidf_(aa[r] + ba[r]); iu[r] = sigmoidf_(ax[r] + bx[r]) * u4[r]; la[r] = -sp4[r] * rg; }
        const bool sm_ = la[0] > -0.15f && la[1] > -0.15f && la[2] > -0.15f && la[3] > -0.15f;
        if (__builtin_amdgcn_ballot_w64(!sm_) == 0ull) {
#pragma unroll
            for (int r = 0; r < 4; ++r) { const float x = la[r], p = x * (1.0f + x * (0.5f + x * (0.16666667f + x * (0.041666668f + x * (0.0083333338f + x * 0.0013888889f)))));
                A[r] = 1.0f + p; Bv[r] = __builtin_amdgcn_sqrtf(-p * (2.0f + p)) * iu[r]; }
        } else {
#pragma unroll
            for (int r = 0; r < 4; ++r) { A[r] = __expf(la[r]); Bv[r] = __builtin_amdgcn_sqrtf(-expm1f_(2.0f * la[r])) * iu[r]; }
        }
#pragma unroll
        for (int r = 0; r < 4; ++r) { float a_ = A[r], b_ = Bv[r]; scan16<REV>(a_, b_); A[r] = a_; Bv[r] = b_; }
        if (i == 0) {
            Ac[0] = A; Hl[0] = Bv;
#pragma unroll
            for (int r = 0; r < 4; ++r) { tA[r] = __shfl(A[r], edge); tB[r] = __shfl(Bv[r], edge); }
        } else {
            Ac[1] = A * tA; Hl[1] = A * tB + Bv;
#pragma unroll
            for (int r = 0; r < 4; ++r) { Atot[r] = __shfl(Ac[1][r], edge); hend[r] = __shfl(Hl[1][r], edge); }
        }
    }
}
__device__ __forceinline__ void lru_chain(const Ctx& C, int l, int id) {
    const int b = id >> 3, hd = (id >> 1) & 3, chalf = id & 1;
    const int lane = C.lane, l15 = lane & 15, q = lane >> 4;
    const int d = C.wave >> 2, mtl = (C.wave >> 1) & 1, th = C.wave & 1, mt = chalf * 2 + mtl;
    LAS bf16* U = (LAS bf16*)C.lds;
    LAS float* XCH = (LAS float*)(C.lds + 2 * 2 * 64 * UPC * 2);
    bf16* P = WSP(bf16, WS_P); bf16* LH = WSP(bf16, WS_LRUH) + (size_t)id * NSTEP * 32;
    const int cd = C.tid >> 8, cj = C.tid & 63, ctq = (C.tid >> 6) & 3;
    const float* cw = C.in[I_LCW] + (size_t)l * 4 * GW + hd * 64 + cj; const float w0 = cw[0], w1 = cw[GW], w2 = cw[2 * GW], w3 = cw[3 * GW], cb = C.in[I_LCB][l * GW + hd * 64 + cj];
    const bf16* wt = WSP(const bf16, WS_LRUWT) + (size_t)((d * 2 + 0) * 4 + hd) * 4096;
    fragb Wa[2], Wx[2];
#pragma unroll
    for (int ks = 0; ks < 2; ++ks) { Wa[ks] = *(const fragb*)(wt + (16 * mt + l15) * 64 + 32 * ks + 8 * q); Wx[ks] = *(const fragb*)(wt + 4 * 4096 + (16 * mt + l15) * 64 + 32 * ks + 8 * q); }
    const int ch0 = hd * 64 + 16 * mt + 4 * q;
    const f32x4 ba = *(const f32x4*)(C.in[I_LBA] + (l * 2 + d) * GW + ch0), bx = *(const f32x4*)(C.in[I_LBX] + (l * 2 + d) * GW + ch0), lam = *(const f32x4*)(C.in[I_LLAM] + (l * 2 + d) * GW + ch0);
    f32x4 sp4;
#pragma unroll
    for (int r = 0; r < 4; ++r) sp4[r] = 8.0f * softplusf_(-lam[r]);
    f32x4 s = (f32x4){0.f, 0.f, 0.f, 0.f};
    unsigned short xr[19];
#define LRU_LOADX(kk) do { const int c_ = lru_chunk_of(cd, (kk)); const bool ic_ = c_ < 4; const int p0_ = (ic_ ? c_ * 64 : (c_ - 4) * 64) + ctq * 16 - 2, Lp_ = ic_ ? CTXL : SEQ; \
        const bf16* xp_ = P + (size_t)(ic_ ? T_LAT + b * CTXL : b * SEQ) * PLD + hd * 64 + cj; \
        _Pragma("unroll") for (int i_ = 0; i_ < 19; ++i_) { const int p_ = p0_ + i_; xr[i_] = (p_ >= 0 && p_ < Lp_) ? xp_[(size_t)p_ * PLD] : (unsigned short)0; } } while (0)
#define LRU_CONV(kk) do { LAS bf16* uo_ = U + ((((kk) & 1) * 2 + cd) * 64 + ctq * 16) * UPC + cj; \
        _Pragma("unroll") for (int t_ = 0; t_ < 16; ++t_) uo_[t_ * UPC] = (bf16)f2bf1(w0 * bf2f(xr[t_]) + w1 * bf2f(xr[t_ + 1]) + w2 * bf2f(xr[t_ + 2]) + w3 * bf2f(xr[t_ + 3]) + cb); } while (0)
    LRU_LOADX(0); LRU_CONV(0); LRU_LOADX(1);
    __syncthreads();
#pragma unroll 1
    for (int k = 0; k < NCH; ++k) {
        if (k + 1 < NCH) { LRU_CONV(k + 1); if (k + 2 < NCH) LRU_LOADX(k + 2); }
        const int c = lru_chunk_of(d, k); const bool second = lru_chunk_of(1 - d, c) < k;
        const bool ic = c < 4; const size_t row0 = (size_t)(ic ? T_LAT + b * CTXL + c * 64 : b * SEQ + (c - 4) * 64);
        const bool late = (k == 2) || (k == 36);
        int tok[2]; v2u gv[2], fv[2];
#pragma unroll
        for (int i = 0; i < 2; ++i) { const int nt = d ? 3 - (2 * th + i) : 2 * th + i; tok[i] = 16 * nt + l15;
            if (second && !late) { gv[i] = *(const v2u*)(P + (row0 + tok[i]) * PLD + 256 + ch0); fv[i] = *(const v2u*)(LH + (size_t)(c * 64 + tok[i]) * 32 + 16 * mtl + 4 * q); } }
        f32x4 Ac[2], Hl[2], Atot, hend;
        const LAS bf16* Ud = U + ((k & 1) * 2 + d) * 64 * UPC;
        if (d) lru_tiles<true>(Ud, th, mt, lane, Wa, Wx, ba, bx, sp4, Ac, Hl, Atot, hend); else lru_tiles<false>(Ud, th, mt, lane, Wa, Wx, ba, bx, sp4, Ac, Hl, Atot, hend);
        LAS float* xw = XCH + (((((k & 1) * 2 + d) * 2 + mtl) * 2 + th) * 4 + q) * 8;
        if (l15 == (d ? 0 : 15)) { *(LAS f32x4*)xw = Atot; *(LAS f32x4*)(xw + 4) = hend; }
        if (late) VM_WAIT();
        RAW_BARRIER();
        if (second && late) {
#pragma unroll
            for (int i = 0; i < 2; ++i) { gv[i] = *(const v2u*)(P + (row0 + tok[i]) * PLD + 256 + ch0); fv[i] = *(const v2u*)(LH + (size_t)(c * 64 + tok[i]) * 32 + 16 * mtl + 4 * q); }
        }
        const LAS float* xr0 = XCH + (((((k & 1) * 2 + d) * 2 + mtl) * 2 + 0) * 4 + q) * 8;
        const f32x4 A0 = *(const LAS f32x4*)xr0, h0 = *(const LAS f32x4*)(xr0 + 4), A1 = *(const LAS f32x4*)(xr0 + 32), h1 = *(const LAS f32x4*)(xr0 + 36);
        const f32x4 mid = A0 * s + h0, hin = th ? mid : s;
        s = A1 * mid + h1;
#pragma unroll
        for (int i = 0; i < 2; ++i) {
            const f32x4 h = Ac[i] * hin + Hl[i];
            if (!second) { v2u o; o.x = pk2(h.x, h.y); o.y = pk2(h.z, h.w); *(v2u*)(LH + (size_t)(c * 64 + tok[i]) * 32 + 16 * mtl + 4 * q) = o; }
            else {
                const f32x4 g = (f32x4){bflo(gv[i].x), bfhi(gv[i].x), bflo(gv[i].y), bfhi(gv[i].y)};
                f32x4 y = (f32x4){h.x + bflo(fv[i].x), h.y + bfhi(fv[i].x), h.z + bflo(fv[i].y), h.w + bfhi(fv[i].y)};
                y.x *= gelu_tanh(g.x); y.y *= gelu_tanh(g.y); y.z *= gelu_tanh(g.z); y.w *= gelu_tanh(g.w);
                st4bf(P + (row0 + tok[i]) * PLD + 256 + ch0, y);
            }
        }
    }
#undef LRU_LOADX
#undef LRU_CONV
    __syncthreads();
}
constexpr int RP = 264;
__device__ __forceinline__ void rwkv_prep2(const Ctx& C, int l, int b, int c) {
    LAS bf16* RS = (LAS bf16*)C.lds;
    LAS bf16* KS = RS + 64 * RP;
    LAS bf16* XW = KS + 64 * RP;
    LAS bf16* XA = XW + 64 * MP;
    LAS bf16* XG = XA + 64 * MP;
    const bf16* P = WSP(const bf16, WS_P);
    const bool isctx = c < 4; const int p0 = isctx ? c * 64 : (c - 4) * 64; const int Lp = isctx ? CTXL : SEQ; const int row0 = isctx ? T_LAT + b * CTXL : b * SEQ;
    const float* mu = C.in[I_RMU] + (size_t)l * 2 * B_COLS;
    bf16* rkv = WSP(bf16, WS_RKV);
#pragma unroll 5
    for (int it = C.tid; it < 64 * 120; it += NTHR) {
        const int t = it / 120, c8 = (it % 120) * 8, p = p0 + t;
        const bf16* pp = P + (size_t)(row0 + p) * PLD + OFF_B + c8;
        const v4u xc = *(const v4u*)pp; v4u xp = (v4u){0u, 0u, 0u, 0u}, xn = xp;
        if (p > 0) xp = *(const v4u*)(pp - PLD);
        if (p < Lp - 1) xn = *(const v4u*)(pp + PLD);
        const f32x4 m0a = *(const f32x4*)(mu + c8), m0b = *(const f32x4*)(mu + c8 + 4), m1a = *(const f32x4*)(mu + B_COLS + c8), m1b = *(const f32x4*)(mu + B_COLS + c8 + 4);
        const unsigned xcw[4] = {xc.x, xc.y, xc.z, xc.w}, xpw[4] = {xp.x, xp.y, xp.z, xp.w}, xnw[4] = {xn.x, xn.y, xn.z, xn.w};
        float sh[8];
#pragma unroll
        for (int e = 0; e < 4; ++e) {
            const float x0 = bflo(xcw[e]), x1 = bfhi(xcw[e]);
            const float mu0_0 = e < 2 ? m0a[2 * e] : m0b[2 * e - 4], mu0_1 = e < 2 ? m0a[2 * e + 1] : m0b[2 * e - 3], mu1_0 = e < 2 ? m1a[2 * e] : m1b[2 * e - 4], mu1_1 = e < 2 ? m1a[2 * e + 1] : m1b[2 * e - 3];
            sh[2 * e] = x0 + mu0_0 * (bflo(xpw[e]) - x0) + mu1_0 * (bflo(xnw[e]) - x0);
            sh[2 * e + 1] = x1 + mu0_1 * (bfhi(xpw[e]) - x1) + mu1_1 * (bfhi(xnw[e]) - x1);
        }
        if (c8 >= 768) {
            const int ci = c8 - 768;
            if (ci < 64) {
#pragma unroll
                for (int e = 0; e < 8; ++e) sh[e] = tanhf_(sh[e]); }
            else if (ci >= 128) {
#pragma unroll
                for (int e = 0; e < 8; ++e) sh[e] = sigmoidf_(sh[e]); }
        }
        v4u o; o.x = pk2(sh[0], sh[1]); o.y = pk2(sh[2], sh[3]); o.z = pk2(sh[4], sh[5]); o.w = pk2(sh[6], sh[7]);
        if (c8 < 768) {
            *(v4u*)(rkv + (size_t)(row0 + p) * 768 + c8) = o;
            if (c8 < 256) *(LAS v4u*)(RS + t * RP + c8) = o; else if (c8 < 512) *(LAS v4u*)(KS + t * RP + c8 - 256) = o;
        } else {
            const int ci = c8 - 768;
            LAS bf16* dst = ci < 64 ? XW + t * MP + ci : (ci < 128 ? XA + t * MP + ci - 64 : XG + t * MP + ci - 128);
            *(LAS v4u*)dst = o;
        }
    }
    __syncthreads();
    const int lane = C.lane, w = C.wave, l15 = lane & 15, q = lane >> 4, hd = w & 3, ntp = w >> 2;
    const bf16* wt = WSP(const bf16, WS_RWT);
    bf16* wa_out = WSP(bf16, WS_HB); bf16* g_out = WSP(bf16, WS_G); float* bonus = WSP(float, WS_BONUS); float* rinv = WSP(float, WS_RINV);
    const f32x4 z4 = (f32x4){0.f, 0.f, 0.f, 0.f};
    float bsum[2] = {0.f, 0.f}, ksum[2] = {0.f, 0.f};
#pragma unroll
    for (int n2 = 0; n2 < 2; ++n2) {
        const int tok = 16 * (2 * ntp + n2) + l15; const size_t row = (size_t)(row0 + p0 + tok);
        const fragb xw0 = ld_frag16(XW + tok * MP + 8 * q), xw1 = ld_frag16(XW + tok * MP + 32 + 8 * q), xa0 = ld_frag16(XA + tok * MP + 8 * q), xa1 = ld_frag16(XA + tok * MP + 32 + 8 * q);
        const fragb xg0 = ld_frag16(XG + tok * MP + 8 * q), xg1 = ld_frag16(XG + tok * MP + 32 + 8 * q);
        unsigned ow0[8], ow1[8], oa0[8], oa1[8], og[8];
#pragma unroll
        for (int mt = 0; mt < 4; ++mt) {
            const int chl = 16 * (l15 >> 2) + 4 * mt + (l15 & 3), ch4 = hd * 64 + 16 * q + 4 * mt;
            const bf16* wrow = wt + (size_t)(hd * 64 + chl) * 32 + 8 * q;
            const bf16* grow = wt + 4 * 256 * 32 + (size_t)(hd * 64 + chl) * 64 + 8 * q;
            const fragb fw0 = *(const fragb*)(wrow), fw1 = *(const fragb*)(wrow + 256 * 32), fa0 = *(const fragb*)(wrow + 2 * 256 * 32), fa1 = *(const fragb*)(wrow + 3 * 256 * 32), fg0 = *(const fragb*)(grow), fg1 = *(const fragb*)(grow + 32);
            const f32x4 w00 = *(const f32x4*)(C.in[I_RW0] + (l * 2 + 0) * GW + ch4), w01 = *(const f32x4*)(C.in[I_RW0] + (l * 2 + 1) * GW + ch4);
            const f32x4 a00 = *(const f32x4*)(C.in[I_RA0] + (l * 2 + 0) * GW + ch4), a01 = *(const f32x4*)(C.in[I_RA0] + (l * 2 + 1) * GW + ch4);
            const f32x4 k_a = *(const f32x4*)(C.in[I_RKA] + l * GW + ch4), r_k = *(const f32x4*)(C.in[I_RRK] + l * GW + ch4), k_k = *(const f32x4*)(C.in[I_RKK] + l * GW + ch4);
            const f32x4 aw0 = mfma16(fw0, xw0, z4), aw1 = mfma16(fw1, xw1, z4), aa0 = mfma16(fa0, xa0, z4), aa1 = mfma16(fa1, xa1, z4);
            f32x4 ag = mfma16(fg0, xg0, z4); ag = mfma16(fg1, xg1, ag);
            f32x4 wv0, wv1, av0, av1;
#pragma unroll
            for (int r = 0; r < 4; ++r) {
                wv0[r] = __expf(-0.6065306597126334f * sigmoidf_(aw0[r] + w00[r])); wv1[r] = __expf(-0.6065306597126334f * sigmoidf_(aw1[r] + w01[r]));
                av0[r] = sigmoidf_(aa0[r] + a00[r]); av1[r] = sigmoidf_(aa1[r] + a01[r]);
            }
            ow0[2 * mt] = pk2(wv0[0], wv0[1]); ow0[2 * mt + 1] = pk2(wv0[2], wv0[3]); ow1[2 * mt] = pk2(wv1[0], wv1[1]); ow1[2 * mt + 1] = pk2(wv1[2], wv1[3]);
            oa0[2 * mt] = pk2(av0[0], av0[1]); oa0[2 * mt + 1] = pk2(av0[2], av0[3]); oa1[2 * mt] = pk2(av1[0], av1[1]); oa1[2 * mt + 1] = pk2(av1[2], av1[3]);
            og[2 * mt] = pk2(ag[0], ag[1]); og[2 * mt + 1] = pk2(ag[2], ag[3]);
            const v2u rr_ = *(const LAS v2u*)(RS + tok * RP + ch4), kr_ = *(const LAS v2u*)(KS + tok * RP + ch4);
            const f32x4 rs = (f32x4){bflo(rr_.x), bfhi(rr_.x), bflo(rr_.y), bfhi(rr_.y)}, ks = (f32x4){bflo(kr_.x), bfhi(kr_.x), bflo(kr_.y), bfhi(kr_.y)};
#pragma unroll
            for (int r = 0; r < 4; ++r) {
                const float km = ks[r] * (1.0f + (av0[r] - 1.0f) * k_a[r]) + ks[r] * (1.0f + (av1[r] - 1.0f) * k_a[r]);
                bsum[n2] += rs[r] * r_k[r] * km; const float kk = ks[r] * k_k[r]; ksum[n2] += kk * kk;
            }
        }
        bf16* wrow_o = wa_out + row * 1024 + hd * 64 + 16 * q;
        *(v4u*)(wrow_o) = (v4u){ow0[0], ow0[1], ow0[2], ow0[3]}; *(v4u*)(wrow_o + 8) = (v4u){ow0[4], ow0[5], ow0[6], ow0[7]};
        *(v4u*)(wrow_o + 256) = (v4u){ow1[0], ow1[1], ow1[2], ow1[3]}; *(v4u*)(wrow_o + 256 + 8) = (v4u){ow1[4], ow1[5], ow1[6], ow1[7]};
        *(v4u*)(wrow_o + 512) = (v4u){oa0[0], oa0[1], oa0[2], oa0[3]}; *(v4u*)(wrow_o + 512 + 8) = (v4u){oa0[4], oa0[5], oa0[6], oa0[7]};
        *(v4u*)(wrow_o + 768) = (v4u){oa1[0], oa1[1], oa1[2], oa1[3]}; *(v4u*)(wrow_o + 768 + 8) = (v4u){oa1[4], oa1[5], oa1[6], oa1[7]};
        bf16* grow_o = g_out + row * 256 + hd * 64 + 16 * q;
        *(v4u*)(grow_o) = (v4u){og[0], og[1], og[2], og[3]}; *(v4u*)(grow_o + 8) = (v4u){og[4], og[5], og[6], og[7]};
    }
#pragma unroll
    for (int n2 = 0; n2 < 2; ++n2) {
        const size_t row = (size_t)(row0 + p0 + 16 * (2 * ntp + n2) + l15);
        float bs = bsum[n2], ks2 = ksum[n2];
        bs += __shfl_xor(bs, 16); bs += __shfl_xor(bs, 32); ks2 += __shfl_xor(ks2, 16); ks2 += __shfl_xor(ks2, 32);
        if (q == 0) { bonus[row * 4 + hd] = bs; rinv[row * 4 + hd] = rsqrtf_(ks2 + 1e-6f); }
    }
    __syncthreads();
}
__device__ __forceinline__ int fwd_row_r(int b, int c, int t) { return c < 4 ? (T_LAT + b * CTXL + c * 64 + t) : (b * SEQ + (c - 4) * 64 + t); }
__device__ __forceinline__ bf16* rw_blob_row(const Ctx& C, int d, int which, int b, int c, int h, int r) {
    const int row = fwd_row_r(b, c, r);
#if RW_VSPLIT
    if (which == 0) { if (d) return WSP(bf16, WS_GQ) + (size_t)row * 768 + 512 + h * 64;
                      return WSP(bf16, WS_P) + (size_t)row * PLD + OFF_B + 512 + h * 64; }
#else
    if (which == 0) return WSP(bf16, WS_OUTB) + ((size_t)d * T_ALL + row) * 256 + h * 64;
#endif
    return WSP(bf16, WS_P) + (size_t)row * PLD + OFF_B + d * 256 + h * 64;
}
__device__ __forceinline__ void rwkv_solve_item(const Ctx& C, int l, int item) {
    const int lane = C.lane, w = C.wave, pw = w & 1, pi = w >> 1, l15 = lane & 15, q = lane >> 4;
    LAS unsigned char* B0 = C.lds + pi * 31744;
    LAS bf16* Kk = (LAS bf16*)B0; LAS bf16* Bh = Kk + 64 * MP; LAS bf16* Kh = Bh + 64 * MP;
    LAS bf16* Ln = (LAS bf16*)B0;
    LAS bf16* Lk16 = (LAS bf16*)(B0 + 9216);
    LAS unsigned char* XT = B0 + 9216;
    LAS bf16* TinvP = (LAS bf16*)(B0 + 25600);
    const bf16* WA = WSP(const bf16, WS_HB); bf16* WAw = WSP(bf16, WS_HB); const bf16* rkv = WSP(const bf16, WS_RKV); const float* rinv = WSP(const float, WS_RINV);
    const int u = item >> 1, d = item & 1;
    const int c = u % NCH, h = (u / NCH) & 3, b = u / (NCH * NH);
    const float k_k = C.in[I_RKK][l * GW + h * 64 + lane], k_a = C.in[I_RKA][l * GW + h * 64 + lane];
    const int n = d ? (c < 4 ? 3 - c : 71 - c) : c;
    const float ril = rinv[(size_t)seqrow_raster(n * 64 + lane, d, b) * 4 + h];
#pragma unroll
    for (int r = 0; r < 4; ++r) { const int idx2 = pw * 64 + lane + 128 * r, t = idx2 >> 3, part = idx2 & 7; const int row = seqrow_raster(n * 64 + t, d, b);
        *(LAS v4u*)(Kk + t * MP + 8 * part) = *(const v4u*)(WA + (size_t)row * 1024 + d * 256 + h * 64 + 8 * part);
        *(LAS v4u*)(Bh + t * MP + 8 * part) = *(const v4u*)(WA + (size_t)row * 1024 + (2 + d) * 256 + h * 64 + 8 * part);
        *(LAS v4u*)(Kh + t * MP + 8 * part) = *(const v4u*)(rkv + (size_t)row * 768 + 256 + h * 64 + 8 * part); }
    __syncthreads();
    {
        float cc = 1.0f;
        if (pw) {
#pragma unroll
            for (int t = 0; t < 32; ++t) cc *= bf2f(Kk[t * MP + lane]);
        }
        __syncthreads();
#pragma unroll
        for (int t2 = 0; t2 < 32; ++t2) {
            const int t = pw * 32 + t2;
            const float wv = bf2f(Kk[t * MP + lane]), av = bf2f(Bh[t * MP + lane]), ks = bf2f(Kh[t * MP + lane]);
            const float kap = ks * k_k * __shfl(ril, t);
            const float cprev = cc; cc *= wv; const float ic = __builtin_amdgcn_rcpf(cc);
            Kk[t * MP + lane] = (bf16)f2bf1(kap * cprev); Bh[t * MP + lane] = (bf16)f2bf1(kap * av * ic); Kh[t * MP + lane] = (bf16)f2bf1(ks * (1.0f + (av - 1.0f) * k_a) * ic);
            WAw[(size_t)seqrow_raster(n * 64 + t, d, b) * 1024 + d * 256 + h * 64 + lane] = (bf16)f2bf1(cc);
        }
    }
    __syncthreads();
    f32x4 acc[4][4];
    if (pw == 0) {
#pragma unroll
        for (int I = 0; I < 4; ++I)
#pragma unroll
            for (int r = 0; r < 4; ++r)
#pragma unroll
                for (int nt = 0; nt < 4; ++nt) acc[I][nt][r] = bf2f(Kk[(16 * I + 4 * q + r) * MP + 16 * nt + l15]);
    }
    f32x4 T[10];
    {
        const LAS bf16* Bsrc = pw ? Kh : Bh;
        int tix = 0;
#pragma unroll
        for (int it = 0; it < 4; ++it)
#pragma unroll
            for (int jt = 0; jt <= it; ++jt, ++tix) {
                f32x4 t4 = (f32x4){0.f, 0.f, 0.f, 0.f};
#pragma unroll
                for (int s = 0; s < 2; ++s) t4 = mfma16(ld_frag16(Kk + (16 * it + l15) * MP + 32 * s + 8 * q), ld_frag16(Bsrc + (16 * jt + l15) * MP + 32 * s + 8 * q), t4);
#pragma unroll
                for (int r = 0; r < 4; ++r) { const int i = 16 * it + 4 * q + r, j = 16 * jt + l15; T[tix][r] = (j < i) ? (pw ? t4[r] : -t4[r]) : 0.f; }
            }
    }
    __syncthreads();
    {
        int tix = 0;
#pragma unroll
        for (int it = 0; it < 4; ++it)
#pragma unroll
            for (int jt = 0; jt < 4; ++jt) {
                if (jt <= it) {
#pragma unroll
                    for (int r = 0; r < 4; ++r) (pw ? Lk16 : Ln)[(16 * it + 4 * q + r) * MP + 16 * jt + l15] = (bf16)f2bf1(T[tix][r]);
                    ++tix;
                } else if (pw == 0) {
#pragma unroll
                    for (int r = 0; r < 4; ++r) Ln[(16 * it + 4 * q + r) * MP + 16 * jt + l15] = (bf16)0;
                }
            }
        LAS v4u* tz = (LAS v4u*)(B0 + 25600) + (pw * 64 + lane) * 2; tz[0] = (v4u){0u, 0u, 0u, 0u}; tz[1] = (v4u){0u, 0u, 0u, 0u};
    }
    __syncthreads();
    if (pw) {
#pragma unroll
        for (int I = 0; I < 4; ++I)
#pragma unroll
            for (int r = 0; r < 4; ++r)
#pragma unroll
                for (int nt = 0; nt < 4; ++nt) { const int i = 16 * I + 4 * q + r, j = 16 * nt + l15; acc[I][nt][r] = (j < i && nt <= I) ? bf2f(Lk16[i * MP + j]) : 0.f; }
    } else diag_inverses(Ln, TinvP, lane);
    __syncthreads();
    LAS unsigned char* XTw = XT + pw * 8192;
    { LAS v4u* xz = (LAS v4u*)(XTw + lane * 128);
#pragma unroll
        for (int g = 0; g < 8; ++g) xz[g] = (v4u){0u, 0u, 0u, 0u}; }
    blocked_solve(Ln, TinvP, XTw, acc, l15, q);
    {
        bf16* dst = rw_blob_row(C, d, pw, b, c, h, lane);
        const LAS unsigned char* xr = XTw + lane * 128;
#pragma unroll
        for (int g = 0; g < 8; ++g) *(v4u*)(dst + 8 * g) = *(const LAS v4u*)(xr + ((g ^ (lane & 7)) << 4));
    }
    __syncthreads();
}

template <bool DRY>
__device__ __forceinline__ void rwkv_chunked(const Ctx& C, int l, int idx) {
#ifndef RW_VSPLIT
#define RW_VSPLIT 1
#endif
    constexpr int NV = RW_VSPLIT ? 1 : 2;
    const int vhalf = idx & 1, lane = C.lane, w = C.wave, l15 = lane & 15, q = lane >> 4;
    const int d = RW_VSPLIT ? idx >> 6 : idx >> 5, b = RW_VSPLIT ? (idx >> 3) & 7 : (idx >> 2) & 7, h = RW_VSPLIT ? (idx >> 1) & 3 : idx & 3;
    const int it = w & 3, vt0 = RW_VSPLIT ? 2 * vhalf + (w >> 2) : 2 * (w >> 2);
    constexpr int IMG = 64 * MP * 2;
    LAS unsigned char* L0 = C.lds;
    LAS bf16* Wi = (LAS bf16*)L0; LAS bf16* Ti = Wi + 64 * MP; LAS bf16* Rh = Ti + 64 * MP; LAS bf16* Kh = Rh + 64 * MP; LAS bf16* Bh = Kh + 64 * MP;
    LAS bf16* UT = (LAS bf16*)(L0 + 11 * IMG);
    LAS float* cLv = (LAS float*)(L0 + 14 * IMG);
    const bf16* WA = WSP(const bf16, WS_HB); const bf16* rkv = WSP(const bf16, WS_RKV); const float* rinv = WSP(const float, WS_RINV);
    bf16* outb = WSP(bf16, WS_OUTB) + (size_t)d * T_ALL * 256;
    const int tt = C.tid >> 3, part = C.tid & 7;
    for (int i = C.tid; i < 2 * IMG / 4; i += NTHR) ((LAS unsigned*)(L0 + 12 * IMG))[i] = 0u;
    float kkw[8], kaw[8];
#pragma unroll
    for (int e = 0; e < 8; ++e) { kkw[e] = C.in[I_RKK][l * GW + h * 64 + 8 * w + e]; kaw[e] = C.in[I_RKA][l * GW + h * 64 + 8 * w + e]; }
    v4u gr, gk, gv, gw, ga, gbw, gbt; float gri;
    auto gload = [&](int n) {
        const int c = d ? (n < 4 ? 3 - n : 71 - n) : n;
        const int row = seqrow_raster(n * 64 + lane, d, b);
        const bf16* pr = rkv + (size_t)row * 768 + h * 64 + 8 * w;
        gr = *(const v4u*)pr; gk = *(const v4u*)(pr + 256); gv = *(const v4u*)(pr + 512);
        gw = *(const v4u*)(WA + (size_t)row * 1024 + d * 256 + h * 64 + 8 * w); ga = *(const v4u*)(WA + (size_t)row * 1024 + (2 + d) * 256 + h * 64 + 8 * w);
        gri = rinv[(size_t)row * 4 + h];
        gbw = *(const v4u*)(rw_blob_row(C, d, 0, b, c, h, tt) + 8 * part); gbt = *(const v4u*)(rw_blob_row(C, d, 1, b, c, h, tt) + 8 * part);
    };
    auto images = [&](int bufi) {
        LAS bf16* VT = (LAS bf16*)(L0 + (5 + 3 * bufi) * IMG); LAS bf16* KcT = VT + 64 * MP; LAS bf16* BcT = KcT + 64 * MP;
        const unsigned rw_[4] = {gr.x, gr.y, gr.z, gr.w}, kw_[4] = {gk.x, gk.y, gk.z, gk.w}, vw_[4] = {gv.x, gv.y, gv.z, gv.w}, ww_[4] = {gw.x, gw.y, gw.z, gw.w}, aw_[4] = {ga.x, ga.y, ga.z, ga.w};
        float rh[8], kh[8], bh[8];
#pragma unroll
        for (int e = 0; e < 8; ++e) {
            const float rs = (e & 1) ? bfhi(rw_[e >> 1]) : bflo(rw_[e >> 1]), ks = (e & 1) ? bfhi(kw_[e >> 1]) : bflo(kw_[e >> 1]);
            const float wv = (e & 1) ? bfhi(ww_[e >> 1]) : bflo(ww_[e >> 1]), av = (e & 1) ? bfhi(aw_[e >> 1]) : bflo(aw_[e >> 1]);
            const float kap = ks * kkw[e] * gri, ktil = ks * (1.0f + (av - 1.0f) * kaw[e]);
            const float cf = wv, icf = __builtin_amdgcn_rcpf(cf), cfL = __builtin_bit_cast(float, __builtin_amdgcn_readlane(__builtin_bit_cast(int, cf), 63)), dec = cfL * icf;
            rh[e] = rs * cf; kh[e] = ktil * icf; bh[e] = kap * av * icf;
            const unsigned short vraw = (e & 1) ? (unsigned short)(vw_[e >> 1] >> 16) : (unsigned short)(vw_[e >> 1] & 0xffffu);
            VT[(8 * w + e) * MP + lane] = vraw; KcT[(8 * w + e) * MP + lane] = (bf16)f2bf1(ktil * dec); BcT[(8 * w + e) * MP + lane] = (bf16)f2bf1(-(kap * av * dec));
            if (lane == 63) cLv[bufi * 64 + 8 * w + e] = cfL;
        }
        { v4u o; o.x = pk2(rh[0], rh[1]); o.y = pk2(rh[2], rh[3]); o.z = pk2(rh[4], rh[5]); o.w = pk2(rh[6], rh[7]); *(LAS v4u*)(Rh + lane * MP + 8 * w) = o; }
        { v4u o; o.x = pk2(kh[0], kh[1]); o.y = pk2(kh[2], kh[3]); o.z = pk2(kh[4], kh[5]); o.w = pk2(kh[6], kh[7]); *(LAS v4u*)(Kh + lane * MP + 8 * w) = o; }
        { v4u o; o.x = pk2(bh[0], bh[1]); o.y = pk2(bh[2], bh[3]); o.z = pk2(bh[4], bh[5]); o.w = pk2(bh[6], bh[7]); *(LAS v4u*)(Bh + lane * MP + 8 * w) = o; }
        const unsigned bw_[4] = {gbw.x, gbw.y, gbw.z, gbw.w}, bt_[4] = {gbt.x, gbt.y, gbt.z, gbt.w};
#pragma unroll
        for (int e = 0; e < 4; ++e) {
            Wi[(8 * part + 2 * e) * MP + tt] = (bf16)(bw_[e] & 0xffffu); Wi[(8 * part + 2 * e + 1) * MP + tt] = (bf16)(bw_[e] >> 16);
            Ti[(8 * part + 2 * e) * MP + tt] = (bf16)(bt_[e] & 0xffffu); Ti[(8 * part + 2 * e + 1) * MP + tt] = (bf16)(bt_[e] >> 16);
        }
    };
    f32x4 Zst[NV];
#pragma unroll
    for (int v2 = 0; v2 < NV; ++v2) Zst[v2] = (f32x4){0.f, 0.f, 0.f, 0.f};
    const f32x4 z4 = (f32x4){0.f, 0.f, 0.f, 0.f};
    gload(0); images(0); gload(1);
#pragma unroll 1
    for (int n = 0; n < NCH; ++n) {
        RAW_BARRIER();
        const LAS bf16* VT = (const LAS bf16*)(L0 + (5 + 3 * (n & 1)) * IMG); const LAS bf16* KcT = VT + 64 * MP; const LAS bf16* BcT = KcT + 64 * MP;
        const LAS bf16* Zi = (const LAS bf16*)(L0 + (12 + (n & 1)) * IMG); LAS bf16* Zn = (LAS bf16*)(L0 + (12 + ((n + 1) & 1)) * IMG);
        const int arow = (16 * it + l15) * MP + 8 * q;
        const fragb Wf0 = ld_frag16(Wi + arow), Wf1 = ld_frag16(Wi + arow + 32), Tf0 = ld_frag16(Ti + arow), Tf1 = ld_frag16(Ti + arow + 32), Rf0 = ld_frag16(Rh + arow), Rf1 = ld_frag16(Rh + arow + 32);
        const int icol = 16 * it + l15;
        f32x4 pk[4], pb[4];
#pragma unroll
        for (int jt = 0; jt < 4; ++jt) {
            pk[jt] = z4; pb[jt] = z4;
            if (jt <= it) {
                const int jrow = (16 * jt + l15) * MP + 8 * q;
                f32x4 sk = mfma16(ld_frag16(Kh + jrow), Rf0, z4); sk = mfma16(ld_frag16(Kh + jrow + 32), Rf1, sk);
                f32x4 sb = mfma16(ld_frag16(Bh + jrow), Rf0, z4); sb = mfma16(ld_frag16(Bh + jrow + 32), Rf1, sb);
#pragma unroll
                for (int r = 0; r < 4; ++r) { const int j = 16 * jt + 4 * q + r; pk[jt][r] = (j <= icol) ? sk[r] : 0.f; pb[jt][r] = (j <= icol) ? -sb[r] : 0.f; }
            }
        }
        fragb Pk0 = pack_frag(pk[0], pk[1]), Pk1 = pack_frag(pk[2], pk[3]), Pb0 = pack_frag(pb[0], pb[1]), Pb1 = pack_frag(pb[2], pb[3]);
        f32x4 RZ[NV];
#pragma unroll
        for (int v2 = 0; v2 < NV; ++v2) {
            const int vrow = 16 * (vt0 + v2) + l15;
            const fragb z0 = ld_frag16(Zi + vrow * MP + 8 * q), z1 = ld_frag16(Zi + vrow * MP + 32 + 8 * q);
            f32x4 u = mfma16(Wf0, z0, z4); u = mfma16(Wf1, z1, u);
            u = mfma16(Tf0, ld_frag16(VT + vrow * MP + 8 * q), u); if (it >= 2) u = mfma16(Tf1, ld_frag16(VT + vrow * MP + 32 + 8 * q), u);
            RZ[v2] = mfma16(Rf0, z0, z4); RZ[v2] = mfma16(Rf1, z1, RZ[v2]);
            v2u o; o.x = pk2(u.x, u.y); o.y = pk2(u.z, u.w);
            *(LAS v2u*)(UT + vrow * MP + 16 * it + 4 * q) = o;
        }
        RAW_BARRIER();
        {
            const f32x4 cl4 = *(const LAS f32x4*)(cLv + (n & 1) * 64 + 16 * it + 4 * q);
            const LAS bf16* kr = KcT + (16 * it + l15) * MP + 4 * q; const LAS bf16* br = BcT + (16 * it + l15) * MP + 4 * q;
            const fragb kc0 = ld_frag8x2(kr, kr + 16), kc1 = ld_frag8x2(kr + 32, kr + 48), bc0 = ld_frag8x2(br, br + 16), bc1 = ld_frag8x2(br + 32, br + 48);
#pragma unroll
            for (int v2 = 0; v2 < NV; ++v2) {
                const int vrow = 16 * (vt0 + v2) + l15;
                const LAS bf16* vr = VT + vrow * MP + 4 * q; const LAS bf16* ur = UT + vrow * MP + 4 * q;
                const fragb vp0 = ld_frag8x2(vr, vr + 16), vp1 = ld_frag8x2(vr + 32, vr + 48), up0 = ld_frag8x2(ur, ur + 16), up1 = ld_frag8x2(ur + 32, ur + 48);
                f32x4 y = mfma16(Pk0, vp0, RZ[v2]); y = mfma16(Pb0, up0, y);
                if (it >= 2) { y = mfma16(Pk1, vp1, y); y = mfma16(Pb1, up1, y); }
#pragma unroll
                for (int r = 0; r < 4; ++r) { const int row = seqrow_raster(n * 64 + 16 * it + 4 * q + r, d, b); if (!DRY) outb[(size_t)row * 256 + h * 64 + vrow] = (bf16)f2bf1(y[r]); }
                f32x4 zn = mfma16(kc0, vp0, z4); zn = mfma16(kc1, vp1, zn); zn = mfma16(bc0, up0, zn); zn = mfma16(bc1, up1, zn);
                Zst[v2] = Zst[v2] * cl4 + zn;
                v2u so; so.x = pk2(Zst[v2].x, Zst[v2].y); so.y = pk2(Zst[v2].z, Zst[v2].w);
                *(LAS v2u*)(Zn + vrow * MP + 16 * it + 4 * q) = so;
            }
        }
        if (n + 1 < NCH) { images((n + 1) & 1); if (n + 2 < NCH) gload(n + 2); }
    }
    __syncthreads();
}
__device__ __forceinline__ void moe_scatter(const Ctx& C, int moe_li, int nrows) {
    const unsigned* gc = WSP(const unsigned, WS_CTL) + CW_MOECNT + 64 * moe_li;
    LAS int* pst = (LAS int*)C.lds;
    {
        int pe[8]; int acc = 0;
#pragma unroll
        for (int e = 0; e < NE; ++e) { const int blks = ((int)gc[e] + 255) >> 8; if (C.tid == e) pst[e] = acc * 256; acc += blks; pe[e] = acc; }
        if (C.wg == 0 && C.tid < MOE_MAXBLK) { int be = 0;
#pragma unroll
            for (int e = 0; e < NE; ++e) be += (pe[e] <= C.tid) ? 1 : 0;
            int* tab = WSP(int, WS_TAB); tab[1 + C.tid] = be < NE ? be : NE - 1; if (C.tid == 0) tab[0] = acc; }
    }
    __syncthreads();
    const unsigned* route = WSP(const unsigned, WS_ROUTE); const unsigned* wgbase = WSP(const unsigned, WS_WGBASE);
    int* pos = WSP(int, WS_POS); int* tok = WSP(int, WS_TOK);
    if (C.wg < NE) { const int cnt = (int)gc[C.wg], s0 = pst[C.wg] + cnt, s1 = pst[C.wg] + (((cnt + 255) >> 8) << 8);
        for (int j = s0 + C.tid; j < s1; j += NTHR) tok[j] = 0; }
    const int m = C.wg * NWAVES + C.wave + C.lane * (C.G * NWAVES);
    if (m < nrows) {
        const v4u a = *(const v4u*)(route + (size_t)m * 8);
        const int e0 = (int)a.x, e1 = (int)a.y;
        const int p0 = pst[e0] + (int)wgbase[C.wg * 8 + e0] + (int)a.z, p1 = pst[e1] + (int)wgbase[C.wg * 8 + e1] + (int)a.w;
        pos[(size_t)m * 2] = p0; pos[(size_t)m * 2 + 1] = p1; tok[p0] = m; tok[p1] = m;
    }
    __syncthreads();
}
template <int NEXT>
__device__ __forceinline__ void moe_combine(const Ctx& C, int l, int nrows) {
    const unsigned* route = WSP(const unsigned, WS_ROUTE); const int* pos = WSP(const int, WS_POS); const bf16* ym = WSP(const bf16, WS_MIX);
    const float* modv = WSP(const float, WS_MODV) + (size_t)l * 9 * 6144 + 5 * 1024;
    const float* modn = WSP(const float, WS_MODV) + (size_t)(l + 1) * 9 * 6144;
    float* xc = WSP(float, WS_XC); bf16* hb = WSP(bf16, WS_HB);
    bf16* xlb = NEXT == 2 ? WSP(bf16, WS_XLAST) : (bf16*)C.out;
    const int gw = C.wg * NWAVES + C.wave, NGW = C.G * NWAVES;
    f32x4 gn[4];
#pragma unroll
    for (int j = 0; j < 4; ++j) gn[j] = *(const f32x4*)((NEXT == 2 ? C.in[I_FNG] : C.in[I_NMIXG] + (NEXT == 1 ? (l + 1) * 1024 : 0)) + 4 * C.lane + 256 * j);
    for (int m = gw; m < nrows; m += NGW) {
        const bool isctx = m >= T_LAT;
        float* xr = isctx ? xc + (size_t)(m - T_LAT) * 1024 : C.out + (size_t)m * 1024; bf16* xrb = xlb + (size_t)m * 1024;
        const int mrow = isctx ? 8 : (m >> 12);
        const float* gv = modv + (size_t)mrow * 6144;
        const int p0 = pos[(size_t)m * 2], p1 = pos[(size_t)m * 2 + 1];
        const float w0 = __builtin_bit_cast(float, route[(size_t)m * 8 + 4]), w1 = __builtin_bit_cast(float, route[(size_t)m * 8 + 5]);
        f32x4 x[4]; float ss = 0.f;
#pragma unroll
        for (int j = 0; j < 4; ++j) {
            const int col = 4 * C.lane + 256 * j;
            const v2u a = *(const v2u*)(ym + (size_t)p0 * 1024 + col), b = *(const v2u*)(ym + (size_t)p1 * 1024 + col);
            const f32x4 ya = (f32x4){bflo(a.x), bfhi(a.x), bflo(a.y), bfhi(a.y)}, yb = (f32x4){bflo(b.x), bfhi(b.x), bflo(b.y), bfhi(b.y)};
            const f32x4 g = *(const f32x4*)(gv + col);
            x[j] = (isctx ? *(const f32x4*)(xr + col) : ld4bf(xrb + col)) + g * (ya * w0 + yb * w1);
            if (NEXT != 2) { if (isctx) *(f32x4*)(xr + col) = x[j]; else st4bf(xrb + col, x[j]); }
            ss += (x[j].x * x[j].x + x[j].y * x[j].y) + (x[j].z * x[j].z + x[j].w * x[j].w);
        }
        if (NEXT != 0) {
            const float rs = rsqrtf_(wave_sum(ss) * (1.0f / 1024.0f) + 1e-6f);
#pragma unroll
            for (int j = 0; j < 4; ++j) {
                const int col = 4 * C.lane + 256 * j;
                if (NEXT == 2) *(f32x4*)(xr + col) = x[j] * rs * gn[j];
                else { const f32x4 sh = *(const f32x4*)(modn + (size_t)mrow * 6144 + col), scl = *(const f32x4*)(modn + (size_t)mrow * 6144 + 1024 + col);
                    st4bf(hb + (size_t)m * 1024 + col, (x[j] * rs * gn[j]) * (scl + 1.0f) + sh); }
            }
        }
    }
}
__device__ __forceinline__ void final_norm(const Ctx& C) {
    const int gw = C.wg * NWAVES + C.wave, NGW = C.G * NWAVES;
    f32x4 gv[4];
#pragma unroll
    for (int j = 0; j < 4; ++j) gv[j] = *(const f32x4*)(C.in[I_FNG] + 4 * C.lane + 256 * j);
    for (int m = gw; m < T_LAT; m += NGW) {
        float* xr = C.out + (size_t)m * 1024;
        f32x4 v[4]; float s = 0.f;
#pragma unroll
        for (int j = 0; j < 4; ++j) { v[j] = *(const f32x4*)(xr + 4 * C.lane + 256 * j); s += (v[j].x * v[j].x + v[j].y * v[j].y) + (v[j].z * v[j].z + v[j].w * v[j].w); }
        const float rs = rsqrtf_(wave_sum(s) * (1.0f / 1024.0f) + 1e-6f);
#pragma unroll
        for (int j = 0; j < 4; ++j) *(f32x4*)(xr + 4 * C.lane + 256 * j) = v[j] * rs * gv[j];
    }
}

constexpr int NPH_L = 13, PH_FINAL = 1 + DEPTH * NPH_L, NPHASE = PH_FINAL + 1;
__host__ __device__ inline bool phase_exists(int ph) {
    if (ph == 0) return true;
    if (ph == PH_FINAL) return false;
    const int l = (ph - 1) / NPH_L, k = (ph - 1) % NPH_L;
    if (l >= 2 && !(l & 1) && k == 0) return false;
    if (!(l & 1) && k >= 11) return false;
    if (!RW_VSPLIT && k == 4) return false;
    return true;
}
#ifndef PH_MASK
#define PH_MASK 0xFFFFFF
#endif
#define PM(k) ((PH_MASK >> (k)) & 1)
#ifndef SK_MASK
#define SK_MASK 0xFFFF
#endif
#define SK(k) ((SK_MASK >> (k)) & 1)
#ifndef REP_MASK
#define REP_MASK 0
#endif
#define NREP(k) (((REP_MASK >> (k)) & 1) ? 2 : 1)

__global__ void __launch_bounds__(NTHR, 2) fwd_kernel(Args args) {
    extern __shared__ __attribute__((aligned(16))) unsigned char lds_raw[];
    Ctx C; C.in = args.in; C.out = args.out; C.ws = args.ws; C.lds = (LAS unsigned char*)lds_raw;
    C.tid = threadIdx.x; C.lane = C.tid & 63; C.wave = __builtin_amdgcn_readfirstlane(C.tid >> 6); C.G = gridDim.x; C.wg = blockIdx.x;
    volatile LAS unsigned* MISC = (volatile LAS unsigned*)(C.lds + MISC_OFF);
    if (C.tid < 64) MISC[C.tid] = 0u;
    __syncthreads();
    const int lo = args.ph_lo, hi = args.ph_hi;
    const bool multi = (hi - lo) > 1;
    if (multi) (void)xcd_barrier_post(WSP(unsigned, WS_CTL) + CW_BAR, MISC + 8);
#define IN(k) (lo <= (k) && (k) < hi)
#define SEAM(k) do { if (IN((k) + 1)) { XcdBarrier b2_; b2_.bar = WSP(unsigned, WS_CTL) + CW_BAR; b2_.x = xb_xcc_id(); b2_.st = (volatile LAS unsigned*)(C.lds + MISC_OFF) + 8; xcd_barrier(b2_); } } while (0)
#define FRESH() do { int t_ = threadIdx.x; asm volatile("" : "+v"(t_)); C.tid = t_; C.lane = t_ & 63; C.wave = __builtin_amdgcn_readfirstlane(t_ >> 6); } while (0)
#define PHASE(bit, k) if (PM(bit) && IN(pb + (k))) for (int rep_ = 0; rep_ < NREP(bit); ++rep_)
#define CLAIM(qh, var) __syncthreads(); if (C.tid == 0) *qslot = atomicAdd((qh), 1u); __syncthreads(); const int var = (int)*qslot;

    LAS unsigned* qslot = (LAS unsigned*)(C.lds + MISC_OFF + 128);
    constexpr int NCSL = 512;
#define CONV_QUEUES(maxn) do { int n_ = 0; \
        if (l > 0) for (; n_ < (maxn); ++n_) { FRESH(); CLAIM(qbase + 192, u0) if (u0 >= NCSL) break; FRESH(); convert_items(C, l, 2, u0 * NWAVES + C.wave, NCSL * NWAVES); } \
        if (l + 1 < DEPTH) for (; n_ < (maxn); ++n_) { FRESH(); CLAIM(qbase + 224, u0) if (u0 >= NCSL) break; FRESH(); convert_items(C, l + 1, 1, u0 * NWAVES + C.wave, NCSL * NWAVES); } } while (0)
    if (PM(20) && IN(0)) { phase_pre(C);
        for (;;) { FRESH(); CLAIM(WSP(unsigned, WS_CTL) + CW_PREPQ + 240, u0) if (u0 >= NCSL) break; FRESH(); convert_items(C, 0, 3, u0 * NWAVES + C.wave, NCSL * NWAVES); }
        SEAM(0); }

#pragma unroll 1
    for (int l = 0; l < DEPTH; ++l) {
        const int pb = 1 + l * NPH_L;
        if (hi <= pb || lo >= pb + NPH_L) continue;
        const bool last = (l == DEPTH - 1), moe = (l & 1);
        const int nrows = last ? T_LAT : T_ALL;
        const void* xlat = (l == 0) ? (const void*)C.in[I_X] : (const void*)C.out; const bool xbf = l > 0; void* xmid = last ? (void*)WSP(bf16, WS_XLAST) : (void*)C.out;
        const float* xctx = (l == 0) ? C.in[I_CTX] : WSP(const float, WS_XC);
        const float* modv = WSP(const float, WS_MODV) + (size_t)l * 9 * 6144;
        unsigned* qbase = WSP(unsigned, WS_CTL) + CW_PREPQ + 256 * l;

        if (!(l >= 2 && !(l & 1))) PHASE(0, 0) { FRESH();
            convert_small(C, l);
            __syncthreads();
            FRESH(); norm_rows<false>(C, l, xlat, xbf, xctx, C.in[I_NMIXG] + l * 1024, 0, 1024, T_ALL, 0);
            SEAM(pb + 0);
        }
        PHASE(1, 1) { FRESH();
            pg8::Gemm g{WSP(const bf16, WS_HB), WSP(const bf16, WS_WIN), T_ALL, PLD, 1024, 0};
            const int gG = (l > 0) ? C.G - 16 : C.G;
            if (C.wg < gG) {
                pg8::StaticOrder S; S.init(T_ALL, PLD, gG, C.wg);
                pg8::EpiBf16<0> E{WSP(bf16, WS_P), PLD, nullptr, 0, 0};
                pg8::gemm_phase<pg8::EpiBf16<0>, pg8::StaticOrder, false>(C.lds, g, S, E, nullptr);
                if (l > 0 && C.tid == 0) (void)xb_add(qbase + 176, 1u);
            } else {
                for (;;) { FRESH(); __syncthreads(); if (C.tid == 0) *qslot = xb_ld(qbase + 176); __syncthreads(); const unsigned fin_ = *qslot; if (fin_ != 0u) break;
                    CLAIM(qbase + 192, u0) if (u0 >= NCSL) break; FRESH(); convert_items(C, l, 2, u0 * NWAVES + C.wave, NCSL * NWAVES); }
            }
            SEAM(pb + 1);
        }
        if (PM(2) && IN(pb + 2)) for (int rep_ = 0; rep_ < NREP(2); ++rep_) { FRESH();
            for (;;) {
                CLAIM(qbase + 16 * rep_, k)
                if (k >= 2 * NB * NCH) break;
                const int kind = k / (NB * NCH), u = k % (NB * NCH);
                FRESH();
                if (kind == 0) { for (int r3_ = 0; r3_ < NREP(24); ++r3_) { FRESH(); if (SK(1)) rwkv_prep2(C, l, u / NCH, u % NCH); } }
                else { for (int r3_ = 0; r3_ < NREP(26); ++r3_) { FRESH(); if (SK(2)) gdn_prep(C, l, u / NCH, u % NCH); } }
            }
            SEAM(pb + 2);
        }
        if (PM(3) && IN(pb + 3)) for (int rep_ = 0; rep_ < NREP(3); ++rep_) { FRESH();
            constexpr int NCL = 2 * NB * NH * NCH / 4;
            int ncl_ = 0;
            for (;;) {
                CLAIM(qbase + 64 + 16 * rep_, k)
                if (k >= NCL) break;
                FRESH(); ++ncl_;
                if (SK(10)) rwkv_solve_item(C, l, 4 * k + (C.wave >> 1));
            }
            if (ncl_ <= 4) { const int cap_ = (l & 1) ? 1 : 3; CONV_QUEUES(cap_); }
            SEAM(pb + (RW_VSPLIT ? 3 : 4));
        }
#if RW_VSPLIT
        if (PM(3) && IN(pb + 4)) { FRESH();
            for (;;) {
                CLAIM(qbase + 128, k)
                if (k >= 2 * NB * NH * NCH / 4) break;
                FRESH();
                if (SK(10)) rwkv_solve_item(C, l, 4 * k + (C.wave >> 1));
            }
            SEAM(pb + 4);
        }
#endif
        if (PM(4) && IN(pb + 5)) { FRESH();
            if (C.wg >= 64) {
                constexpr int NCL = 2 * NB * NH * NCH / 4;
                for (;;) {
                    CLAIM(qbase + 128, k)
                    if (k >= NCL) break;
                    FRESH();
                    if (SK(9)) gdn_solve_item(C, l, 4 * k + (C.wave >> 1));
                }
                asm volatile("s_waitcnt vmcnt(0)" ::: "memory");
                __syncthreads();
                if (C.tid == 0) { __builtin_amdgcn_fence(__ATOMIC_RELEASE, "agent"); asm volatile("s_waitcnt vmcnt(0)" ::: "memory"); (void)xb_add(qbase + 160, 1u); }
                if (C.wg >= 192) {
                    if (C.tid == 0) { unsigned* bar_ = WSP(unsigned, WS_CTL) + CW_BAR; XB_SPIN(xb_ld(qbase + 160) < (unsigned)(C.G - 64), bar_); __builtin_amdgcn_fence(__ATOMIC_ACQUIRE, "agent"); asm volatile("s_waitcnt vmcnt(0)" ::: "memory"); }
                    __syncthreads();
                }
                FRESH();
            }
            if (C.wg >= 64 && C.wg < 128) { if (SK(0)) lru_chain(C, l, C.wg - 64); FRESH(); }
            if (SK(3) && C.wg < (RW_VSPLIT ? 128 : 64)) { if (NREP(20) > 1) { FRESH(); rwkv_chunked<true>(C, l, C.wg); } FRESH(); rwkv_chunked<false>(C, l, C.wg); }
            else if (SK(4) && C.wg >= 128 && C.wg < 192) { for (int r2_ = 0; r2_ < NREP(21); ++r2_) { FRESH(); mlstm_chunked(C, l, C.wg - 128); } }
            else if (SK(5) && C.wg >= 192) { if (NREP(22) > 1) { FRESH(); gdn_chunked<true>(C, l, C.wg - 192); } FRESH(); gdn_chunked<false>(C, l, C.wg - 192); }
            FRESH(); CONV_QUEUES(1 << 30);
            SEAM(pb + 5);
        }
        PHASE(5, 6) { FRESH();
            if (SK(8)) finish_rows(C, l, nrows);
            SEAM(pb + 6);
        }
        if (PM(6) && IN(pb + 7)) { FRESH();
            pg8::Gemm g{WSP(const bf16, WS_HB), WSP(const bf16, WS_WOUT), nrows, 1024, 1024, 0};
            pg8::TailHalfOrder S; S.init(nrows, C.G, C.wg);
            pg8::EpiRes E{xlat, xctx, xmid, WSP(float, WS_XC), modv + 2 * 1024, xbf, true};
            pg8::gemm_phase<pg8::EpiRes, pg8::TailHalfOrder, false>(C.lds, g, S, E, nullptr);
            SEAM(pb + 7);
        }
        if (PM(7) && IN(pb + 8)) { FRESH();
            if (moe) norm_rows<true>(C, l, xmid, true, WSP(const float, WS_XC), C.in[I_NFFNG] + l * 1024, 3 * 1024, 4 * 1024, nrows, l >> 1);
            else norm_rows<false>(C, l, xmid, true, WSP(const float, WS_XC), C.in[I_NFFNG] + l * 1024, 3 * 1024, 4 * 1024, nrows, 0);
            SEAM(pb + 8);
        }
        if (!moe) {
            if (PM(8) && IN(pb + 9)) for (int rep_ = 0; rep_ < NREP(8); ++rep_) { FRESH();
                pg8::Gemm g{WSP(const bf16, WS_HB), WSP(const bf16, WS_WGU), nrows, 2 * DFF, 1024, 0};
                pg8::StaticOrder S; S.init(nrows, 2 * DFF, C.G, C.wg);
                pg8::EpiSwiglu E{WSP(bf16, WS_P), DFF};
                pg8::gemm_phase<pg8::EpiSwiglu, pg8::StaticOrder, false>(C.lds, g, S, E, nullptr);
                SEAM(pb + 9);
            }
            if (PM(9) && IN(pb + 10)) { FRESH();
                pg8::Gemm g{WSP(const bf16, WS_P), WSP(const bf16, WS_WDN), nrows, 1024, DFF, 0};
                pg8::TailHalfOrder S; S.init(nrows, C.G, C.wg);
                pg8::EpiRes E{xmid, WSP(const float, WS_XC), xmid, WSP(float, WS_XC), modv + 5 * 1024, true, true};
                pg8::gemm_phase<pg8::EpiRes, pg8::TailHalfOrder, false>(C.lds, g, S, E, nullptr);
                SEAM(pb + 12);
            }
        } else {
            if (PM(10) && IN(pb + 9)) { FRESH(); moe_scatter(C, l >> 1, nrows); SEAM(pb + 9); }
            if (PM(11) && IN(pb + 10)) for (int rep_ = 0; rep_ < NREP(11); ++rep_) { FRESH();
                pg8::Gemm g{WSP(const bf16, WS_HB), WSP(const bf16, WS_WGU), 0, 2 * DFE, 1024, (size_t)2 * DFE * 1024};
                pg8::MoeOrderG S; S.init(WSP(const int, WS_TAB), (2 * DFE) / 256, C.G, C.wg); S.tok = WSP(const int, WS_TOK);
                pg8::EpiSwiglu E{WSP(bf16, WS_P), DFE};
                pg8::gemm_phase<pg8::EpiSwiglu, pg8::MoeOrderG, false>(C.lds, g, S, E, nullptr);
                SEAM(pb + 10);
            }
            if (PM(12) && IN(pb + 11)) for (int rep_ = 0; rep_ < NREP(12); ++rep_) { FRESH();
                pg8::Gemm g{WSP(const bf16, WS_P), WSP(const bf16, WS_WDN), 0, 1024, DFE, (size_t)1024 * DFE};
                pg8::MoeOrder S; S.init(WSP(const int, WS_TAB), 4, C.G, C.wg);
                pg8::EpiBf16<0> E{WSP(bf16, WS_MIX), 1024, nullptr, 0, 0};
                pg8::gemm_phase<pg8::EpiBf16<0>, pg8::MoeOrder, false>(C.lds, g, S, E, nullptr);
                SEAM(pb + 11);
            }
            if (PM(13) && IN(pb + 12)) { FRESH();
                if (last) moe_combine<2>(C, l, nrows);
                else { convert_small(C, l + 1); FRESH(); moe_combine<1>(C, l, nrows); if (IN(pb + NPH_L + 1)) { XcdBarrier b2_; b2_.bar = WSP(unsigned, WS_CTL) + CW_BAR; b2_.x = xb_xcc_id(); b2_.st = (volatile LAS unsigned*)(C.lds + MISC_OFF) + 8; xcd_barrier(b2_); } }
            }
        }
    }
}

extern "C" void kernel_launch(void* const* d_in, const int* in_sizes, int n_in, void* d_out, int out_size, void* d_ws, size_t ws_size, hipStream_t stream) {
    static int grid = 0;
    if (grid == 0) {
        if (n_in != N_IN || in_sizes[0] != T_LAT * DM || out_size != T_LAT * DM || ws_size < WS_END) {
            fprintf(stderr, "kernel_launch: unexpected problem (n_in %d, in0 %d, out %d, ws %zu < %zu)\n", n_in, n_in > 0 ? in_sizes[0] : -1, out_size, ws_size, (size_t)WS_END); grid = -1; return; }
        int dev = 0, cus = 0, per_cu = 0;
        if (hipGetDevice(&dev) != hipSuccess || hipDeviceGetAttribute(&cus, hipDeviceAttributeMultiprocessorCount, dev) != hipSuccess) { grid = -1; return; }
        if (hipFuncSetAttribute((const void*)fwd_kernel, hipFuncAttributeMaxDynamicSharedMemorySize, LDS_BYTES) != hipSuccess) { fprintf(stderr, "kernel_launch: hipFuncSetAttribute failed\n"); grid = -1; return; }
        if (hipOccupancyMaxActiveBlocksPerMultiprocessor(&per_cu, (const void*)fwd_kernel, NTHR, LDS_BYTES) != hipSuccess || per_cu < 1) { fprintf(stderr, "kernel_launch: occupancy query says %d\n", per_cu); grid = -1; return; }
        grid = cus;
        if (grid != 256) fprintf(stderr, "kernel_launch: note: %d CUs\n", grid);
    }
    if (grid < 0) return;
    if (hipMemsetAsync((char*)d_ws + WS_CTL, 0, CTL_BYTES, stream) != hipSuccess) return;
    Args a{};
    for (int i = 0; i < N_IN; ++i) a.in[i] = (const float*)d_in[i];
    a.out = (float*)d_out; a.ws = (unsigned char*)d_ws;
#if MK_ONE_LAUNCH
    a.ph_lo = 0; a.ph_hi = NPHASE;
    hipLaunchKernelGGL(fwd_kernel, dim3(grid), dim3(NTHR), LDS_BYTES, stream, a);
#else
    for (int ph = 0; ph < NPHASE; ++ph) { if (!phase_exists(ph)) continue; a.ph_lo = ph; a.ph_hi = ph + 1; hipLaunchKernelGGL(fwd_kernel, dim3(grid), dim3(NTHR), LDS_BYTES, stream, a); }
#endif
}
```

```cpp
#define MK_ONE_LAUNCH 1
#include <hip/hip_runtime.h>
#include <cstdio>
#include <cstdint>

#define GAS __attribute__((address_space(1)))
#define LAS __attribute__((address_space(3)))
typedef unsigned short bf16;
typedef unsigned v4u __attribute__((ext_vector_type(4)));
typedef unsigned v2u __attribute__((ext_vector_type(2)));
typedef float f32x4 __attribute__((ext_vector_type(4)));
typedef float f32x2 __attribute__((ext_vector_type(2)));
typedef short bf16x8 __attribute__((ext_vector_type(8)));
#define LDS_WAIT() asm volatile("s_waitcnt lgkmcnt(0)" ::: "memory")
#define VM_WAIT() asm volatile("s_waitcnt vmcnt(0)" ::: "memory")

constexpr int DM = 1024, NB = 8, SEQ = 4096, DEPTH = 4, CTXL = 256, GW = 256, HD = 64, NH = 4;
constexpr int T_LAT = NB * SEQ, T_CTX = NB * CTXL, T_ALL = T_LAT + T_CTX;
constexpr int IN_COLS = 3552, PLD = 3584;
constexpr int OFF_B = 512, OFF_C = 1472, OFF_D = 2512, B_COLS = 960;
constexpr int DFF = 2816, NE = 8, DFE = 1408;
constexpr int NCH = 68;
constexpr int NSTEP = 4352;
constexpr int MOE_MAXBLK = 280;
constexpr int NWAVES = 8, NTHR = 512;
#ifndef RW_VSPLIT
#define RW_VSPLIT 0
#endif

constexpr size_t MiB = 1u << 20;
constexpr size_t WS_CTL = 0, CTL_BYTES = 1 * MiB;
constexpr size_t WS_MODV = 1 * MiB;
constexpr size_t WS_XC = 2 * MiB;
constexpr size_t WS_WIN = 10 * MiB;
constexpr size_t WS_WOUT = 17 * MiB;
constexpr size_t WS_WGU = 19 * MiB;
constexpr size_t WS_WDN = 63 * MiB;
constexpr size_t WS_HB = 85 * MiB;
constexpr size_t WS_P = 153 * MiB;
constexpr size_t WS_MIX = 391 * MiB;
constexpr size_t WS_OUTB = WS_MIX, WS_OUTC = WS_MIX + 34 * MiB, WS_OUTD = WS_MIX + 68 * MiB, WS_GQ = WS_MIX + 102 * MiB, WS_G = WS_MIX + 153 * MiB;
constexpr size_t WS_XLAST = WS_MIX + 144 * MiB;
constexpr size_t WS_RKV = WS_MIX + 170 * MiB;
constexpr size_t WS_SMALL = 612 * MiB;
constexpr size_t WS_ROUTE = WS_SMALL;
constexpr size_t WS_POS = WS_SMALL + 1280 * 1024;
constexpr size_t WS_TOK = WS_SMALL + 1664 * 1024;
constexpr size_t WS_BONUS = WS_SMALL + 2 * MiB;
constexpr size_t WS_RINV = WS_SMALL + 2 * MiB + 640 * 1024;
constexpr size_t WS_WGBASE = WS_SMALL + 3 * MiB + 256 * 1024;
constexpr size_t WS_TAB = WS_WGBASE + 65536;
constexpr size_t WS_LRUWT = WS_SMALL + 3 * MiB + 512 * 1024;
constexpr size_t WS_RWT = WS_LRUWT + 131072;
constexpr size_t WS_LRUH = WS_SMALL + 4 * MiB;
constexpr size_t WS_END = 633 * MiB;
constexpr int CW_MOECNT = 1024;
constexpr int CW_PREPQ = 2048;
constexpr int CW_BAR = 4096;

constexpr int LDS_BYTES = 135168;
constexpr int MISC_OFF = 131072;

__device__ __forceinline__ unsigned f2bf(float f) { unsigned u = __builtin_bit_cast(unsigned, f); return (u + 0x7fffu + ((u >> 16) & 1u)) >> 16; }
typedef __bf16 bf16n2 __attribute__((ext_vector_type(2)));
__device__ __forceinline__ unsigned pk2(float lo, float hi) { const f32x2 v = {lo, hi}; return __builtin_bit_cast(unsigned, __builtin_convertvector(v, bf16n2)); }
__device__ __forceinline__ unsigned f2bf1(float f) { return pk2(f, f) & 0xffffu; }
__device__ __forceinline__ float bf2f(unsigned short v) { return __builtin_bit_cast(float, (unsigned)v << 16); }
__device__ __forceinline__ float bflo(unsigned v) { return __builtin_bit_cast(float, v << 16); }
__device__ __forceinline__ float bfhi(unsigned v) { return __builtin_bit_cast(float, v & 0xffff0000u); }
template <int CTRL, int RM, bool BC> __device__ __forceinline__ float dpp_x(float oldv, float v) { return __builtin_bit_cast(float, __builtin_amdgcn_update_dpp(__builtin_bit_cast(int, oldv), __builtin_bit_cast(int, v), CTRL, RM, 0xF, BC)); }
__device__ __forceinline__ float wave_sum(float v) {
    v += dpp_x<0xB1, 0xF, true>(0.f, v); v += dpp_x<0x4E, 0xF, true>(0.f, v); v += dpp_x<0x141, 0xF, true>(0.f, v); v += dpp_x<0x140, 0xF, true>(0.f, v);
    v += dpp_x<0x142, 0xA, false>(0.f, v); v += dpp_x<0x143, 0xC, false>(0.f, v);
    return __builtin_bit_cast(float, __builtin_amdgcn_readlane(__builtin_bit_cast(int, v), 63));
}
template <int CTRL> __device__ __forceinline__ float dpp_f(float v) { return __builtin_bit_cast(float, __builtin_amdgcn_update_dpp(0, __builtin_bit_cast(int, v), CTRL, 0xF, 0xF, true)); }
__device__ __forceinline__ float row16_sum(float v) {
    v += dpp_f<0xB1>(v);
    v += dpp_f<0x4E>(v);
    v += dpp_f<0x141>(v);
    v += dpp_f<0x140>(v);
    return v;
}
__device__ __forceinline__ float sigmoidf_(float x) { return __builtin_amdgcn_rcpf(1.0f + __expf(-x)); }
__device__ __forceinline__ float softplusf_(float x) { return fmaxf(x, 0.f) + __logf(1.0f + __expf(-fabsf(x))); }
__device__ __forceinline__ float expm1f_(float x) { return x > -0.3f ? x * (1.0f + x * (0.5f + x * (0.16666667f + x * (0.041666668f + x * 0.0083333338f)))) : __expf(x) - 1.0f; }
__device__ __forceinline__ float siluf_(float x) { return x * __builtin_amdgcn_rcpf(1.0f + __expf(-x)); }
__device__ __forceinline__ float tanhf_(float x) { const float e = __expf(2.0f * x); return 1.0f - 2.0f * __builtin_amdgcn_rcpf(e + 1.0f); }
__device__ __forceinline__ float rsqrtf_(float x) { return __builtin_amdgcn_rsqf(x); }
__device__ __forceinline__ float gelu_tanh(float x) { return 0.5f * x * (1.0f + tanhf_(0.7978845608028654f * (x + 0.044715f * x * x * x))); }
__device__ __forceinline__ f32x4 ld4bf(const bf16* p) { const v2u a = *(const v2u*)p; return (f32x4){bflo(a.x), bfhi(a.x), bflo(a.y), bfhi(a.y)}; }
__device__ __forceinline__ void st4bf(bf16* p, const f32x4& v) { v2u o; o.x = pk2(v.x, v.y); o.y = pk2(v.z, v.w); *(v2u*)p = o; }
#define XB_TMO      128
#define XB_XCNT(j)  (256  + 64 * (j))
#define XB_XSUB(j)  (1280 + 64 * (j))
#define XB_XGEN(j)  (2304 + 64 * (j))
#define XB_TOP      3328
#define XB_TOPGEN   3392
#define XCD_BAR_WORDS 3456
#define XB_SPIN_CAP (1u << 22)

__device__ __forceinline__ unsigned xb_ld(unsigned* p)              { return __hip_atomic_load(p, __ATOMIC_RELAXED, __HIP_MEMORY_SCOPE_AGENT); }
__device__ __forceinline__ unsigned xb_add(unsigned* p, unsigned v) { return __hip_atomic_fetch_add(p, v, __ATOMIC_RELAXED, __HIP_MEMORY_SCOPE_AGENT); }
__device__ __forceinline__ unsigned xb_xcc_id() { return (unsigned)__builtin_amdgcn_s_getreg((3 << 11) | 20) & 0xFu; }
#define XB_SPIN(cond, bar) do { unsigned _sp = 0; while (cond) { __builtin_amdgcn_s_sleep(1); \
    if ((++_sp & 255u) == 0u) { if (xb_ld(&(bar)[XB_TMO])) break; if (_sp > XB_SPIN_CAP) { atomicAdd(&(bar)[XB_TMO], 1u); break; } } } } while (0)

struct XcdBarrier {
    unsigned* bar; unsigned x;
    volatile LAS unsigned* st;
};

__device__ __forceinline__ XcdBarrier xcd_barrier_post(unsigned* bar, volatile LAS unsigned* st) {
    XcdBarrier b; b.bar = bar; b.x = xb_xcc_id(); b.st = st;
    if (threadIdx.x == 0) (void)xb_add(&bar[XB_XCNT(b.x)], 1u);
    return b;
}
__device__ __forceinline__ void xcd_barrier_complete(unsigned* bar, unsigned x, unsigned& nloc, unsigned& nx) {
    const unsigned G = gridDim.x * gridDim.y * gridDim.z;
    unsigned sum, cnt, mine, sp = 0u;
    for (;;) {
        sum = 0u; cnt = 0u; mine = 0u;
#pragma unroll
        for (unsigned j = 0; j < 16; ++j) { const unsigned c = xb_ld(&bar[XB_XCNT(j)]); sum += c; cnt += (c > 0u) ? 1u : 0u; mine = (j == x) ? c : mine; }
        if (sum == G) break;
        __builtin_amdgcn_s_sleep(1);
        if ((++sp & 255u) == 0u) { if (xb_ld(&bar[XB_TMO])) break; if (sp > XB_SPIN_CAP) { atomicAdd(&bar[XB_TMO], 1u); break; } }
    }
    nloc = mine > 0u ? mine : 1u; nx = cnt > 0u ? cnt : 1u;
}

__device__ __forceinline__ void xcd_barrier(const XcdBarrier& b) {
    asm volatile("s_waitcnt vmcnt(0)" ::: "memory");
    __syncthreads();
    if (threadIdx.x == 0) {
        unsigned* bar = b.bar;
        __builtin_amdgcn_s_waitcnt(0);
        unsigned nloc = b.st[0], nx = b.st[1];
        if (nloc == 0u) { xcd_barrier_complete(bar, b.x, nloc, nx); b.st[0] = nloc; b.st[1] = nx; }
        const unsigned old = xb_add(&bar[XB_XSUB(b.x)], 1u);
        const unsigned gen = old / nloc;
        if (old + 1u == (gen + 1u) * nloc) {
            __builtin_amdgcn_fence(__ATOMIC_RELEASE, "agent");
            asm volatile("s_waitcnt vmcnt(0)" ::: "memory");
            const unsigned og = xb_add(&bar[XB_TOP], 1u);
            const unsigned tg = og / nx;
            if (og + 1u == (tg + 1u) * nx) xb_add(&bar[XB_TOPGEN], 1u);
            else XB_SPIN(xb_ld(&bar[XB_TOPGEN]) == tg, bar);
            __builtin_amdgcn_fence(__ATOMIC_ACQUIRE, "agent");
            xb_add(&bar[XB_XGEN(b.x)], 1u);
            asm volatile("s_waitcnt vmcnt(0)" ::: "memory");
        } else {
            XB_SPIN(xb_ld(&bar[XB_XGEN(b.x)]) == gen, bar);
            __builtin_amdgcn_fence(__ATOMIC_ACQUIRE, "agent");
            asm volatile("s_waitcnt vmcnt(0)" ::: "memory");
        }
    }
    __syncthreads();
}

namespace pg8 {
#define PG8_LAS __attribute__((address_space(3)))
typedef unsigned short bf16_t;
typedef short bf16x8 __attribute__((ext_vector_type(8)));
typedef float f32x4 __attribute__((ext_vector_type(4)));
typedef unsigned u32x4 __attribute__((ext_vector_type(4)));
constexpr int BM = 256, BK = 64, HALF = 128, HTB = HALF * BK * 2  , STAGE_BYTES = 8 * HTB, NXCD = 8, WGM = 8;

__host__ __device__ __forceinline__ int lds_byte(int r, int c) { const int st = (r >> 4) * 2 + (c >> 5), rr = r & 15, cc = c & 31, ob = rr * 64 + cc * 2; return st * 1024 + (ob ^ (((ob >> 9) & 1) << 5)); }
__host__ __device__ __forceinline__ void stage_rc(int b, int& R, int& C) { const int st = b / 1024, sb = b % 1024, swz = sb ^ (((sb >> 9) & 1) << 5); R = (st >> 1) * 16 + swz / 64; C = (st & 1) * 32 + (swz % 64) / 2; }
__host__ __device__ __forceinline__ int perm32(int rho) { const int n = rho >> 4, i = rho & 15; return 8 * (i >> 2) + 4 * n + (i & 3); }

struct Unit { int pm, pn, e; };
struct Gemm { const bf16_t* A; const bf16_t* Bt; int M, N, K; size_t estride; };

struct StaticOrder {
    static constexpr bool GATHER = false, HALFS = false;
    int nM, nN, nwg, G, c;
    __host__ __device__ void init(int M, int N, int G_, int c_) { nM = M / BM; nN = N / BM; nwg = nM * nN; G = G_; c = c_; }
    __host__ __device__ bool next(int i, Unit& u) const {
        const long L = (long)i * G + c; if (L >= nwg) return false;
        int wgid = (int)L; { const int q = nwg / NXCD, r = nwg % NXCD, xcd = wgid % NXCD, off = wgid / NXCD; wgid = (xcd < r ? xcd * (q + 1) : r * (q + 1) + (xcd - r) * q) + off; }
        const int nig = WGM * nN, gid = wgid / nig, fm = gid * WGM, gsz = (nM - fm) < WGM ? (nM - fm) : WGM;
        u.pm = fm + ((wgid % nig) % gsz); u.pn = (wgid % nig) / gsz; u.e = 0; return true;
    }
    __device__ __forceinline__ void a_ready(const Unit&) const {}
    __device__ __forceinline__ void done(const Unit&) const {}
};
struct TailHalfOrder {
    static constexpr bool GATHER = false, HALFS = true;
    int nM, nwg, G, c, ntail;
    __device__ __forceinline__ void init(int M, int G_, int c_) { const int nMall = M / BM; nM = nMall >= 128 ? 128 : nMall; nwg = nM * 4; ntail = nMall - nM; G = G_; c = c_; }
    __device__ __forceinline__ bool next(int i, Unit& u) const {
        const int L = i * G + c;
        if (L < nwg) {
            int wgid = L; { const int q = nwg / NXCD, r = nwg % NXCD, xcd = wgid % NXCD, off = wgid / NXCD; wgid = (xcd < r ? xcd * (q + 1) : r * (q + 1) + (xcd - r) * q) + off; }
            const int nig = WGM * 4, gid = wgid / nig, fm = gid * WGM, gsz = (nM - fm) < WGM ? (nM - fm) : WGM;
            u.pm = fm + ((wgid % nig) % gsz); u.pn = (wgid % nig) / gsz; u.e = 0; return true;
        }
        const int t = L - nwg; if (t >= ntail * 8) return false;
        const int nh = t / ntail; u.pm = 128 + (t - nh * ntail); u.pn = (nh >> 1) | ((1 + (nh & 1)) << 8); u.e = 0; return true;
    }
    __device__ __forceinline__ void a_ready(const Unit&) const {}
    __device__ __forceinline__ void done(const Unit&) const {}
};
typedef __bf16 bf16n2_ __attribute__((ext_vector_type(2)));
__device__ __forceinline__ unsigned cvt_pk_bf16(float lo, float hi) { typedef float f2_ __attribute__((ext_vector_type(2))); const f2_ v = {lo, hi}; return __builtin_bit_cast(unsigned, __builtin_convertvector(v, bf16n2_)); }
typedef float f32x2 __attribute__((ext_vector_type(2)));
__device__ __forceinline__ f32x2 gelu_pk(f32x2 v) {
    const f32x2 av = __builtin_elementwise_abs(v), d = av * 0.2316418882f + 1.0f;
    f32x2 t; t.x = __builtin_amdgcn_rcpf(d.x); t.y = __builtin_amdgcn_rcpf(d.y);
    f32x2 q = t * 0.5307027145f + (-0.7265760135f); q = q * t + 0.7107068705f; q = q * t + (-0.142248368f); q = q * t + 0.127414796f; q = q * t;
    const f32x2 s = (v * v) * (-0.72134752044f);
    f32x2 e; e.x = __builtin_amdgcn_exp2f(s.x); e.y = __builtin_amdgcn_exp2f(s.y);
    const f32x2 m = v * (q * e), r = v - m;
    f32x2 o; o.x = v.x < 0.f ? m.x : r.x; o.y = v.y < 0.f ? m.y : r.y; return o;
}

struct EpiF32 {
    static constexpr bool PERM = false, AFTER_DRAIN = false;
    float* C; int ldc; const float* bias;
    __device__ __forceinline__ void operator()(const f32x4 (&acc)[2][2][4][2], const Unit& u, int wr, int wc, int fr, int fq) const {
        const int row0 = u.pm * BM + wr * 64 + fr, col0 = u.pn * BM + wc * 32 + 4 * fq;
        f32x4 bv[2][2];
#pragma unroll
        for (int bj = 0; bj < 2; ++bj)
#pragma unroll
            for (int n = 0; n < 2; ++n) bv[bj][n] = bias ? *(const f32x4*)(bias + col0 + bj * HALF + n * 16) : (f32x4){0.f, 0.f, 0.f, 0.f};
#pragma unroll
        for (int ai = 0; ai < 2; ++ai)
#pragma unroll
            for (int m = 0; m < 4; ++m) { float* rowp = C + (size_t)(row0 + ai * HALF + m * 16) * ldc + col0;
#pragma unroll
                for (int bj = 0; bj < 2; ++bj)
#pragma unroll
                    for (int n = 0; n < 2; ++n) *(f32x4*)(rowp + bj * HALF + n * 16) = acc[ai][bj][m][n] + bv[bj][n]; }
    }
};
template <int ACT  > struct EpiBf16 {
    static constexpr bool PERM = true, AFTER_DRAIN = false;
    bf16_t* O; int ldc; const float* bias; int split_cols; size_t split_stride;
    __device__ __forceinline__ void operator()(const f32x4 (&acc)[2][2][4][2], const Unit& u, int wr, int wc, int fr, int fq) const {
        const int row0 = u.pm * BM + wr * 64 + fr; int colt = u.pn * BM; bf16_t* base = O;
        if (split_cols) { const int t = colt / split_cols; base += (size_t)t * split_stride; colt -= t * split_cols; }
        const int col0 = colt + wc * 32 + 8 * fq, bcol0 = u.pn * BM + wc * 32 + 8 * fq;
        f32x4 bv[2][2];
#pragma unroll
        for (int bj = 0; bj < 2; ++bj)
#pragma unroll
            for (int n = 0; n < 2; ++n) bv[bj][n] = bias ? *(const f32x4*)(bias + bcol0 + bj * HALF + 4 * n) : (f32x4){0.f, 0.f, 0.f, 0.f};
#pragma unroll
        for (int ai = 0; ai < 2; ++ai)
#pragma unroll
            for (int m = 0; m < 4; ++m) { bf16_t* rowp = base + (size_t)(row0 + ai * HALF + m * 16) * ldc + col0;
#pragma unroll
                for (int bj = 0; bj < 2; ++bj) { f32x4 v0 = acc[ai][bj][m][0] + bv[bj][0], v1 = acc[ai][bj][m][1] + bv[bj][1];
                    if (ACT == 1) { f32x2 a = gelu_pk((f32x2){v0[0], v0[1]}), b = gelu_pk((f32x2){v0[2], v0[3]}), c = gelu_pk((f32x2){v1[0], v1[1]}), d = gelu_pk((f32x2){v1[2], v1[3]});
                        v0 = (f32x4){a.x, a.y, b.x, b.y}; v1 = (f32x4){c.x, c.y, d.x, d.y}; }
                    if (ACT == 2) {
#pragma unroll
                        for (int j = 0; j < 4; ++j) { v0[j] = 0.5f * v0[j] * (1.0f + erff(v0[j] * 0.70710678f)); v1[j] = 0.5f * v1[j] * (1.0f + erff(v1[j] * 0.70710678f)); } }
                    u32x4 w; w.x = cvt_pk_bf16(v0[0], v0[1]); w.y = cvt_pk_bf16(v0[2], v0[3]); w.z = cvt_pk_bf16(v1[0], v1[1]); w.w = cvt_pk_bf16(v1[2], v1[3]);
                    *(u32x4*)(rowp + bj * HALF) = w; } }
    }
};

template <class Epi, class Sched, bool STAMP = false>
__device__ __forceinline__ void gemm_phase(PG8_LAS unsigned char* lds, const Gemm g, const Sched& S, const Epi& E, unsigned long long* stamps) {
    int tid_ = threadIdx.x; asm volatile("" : "+v"(tid_));
    const int tid = tid_, wid = __builtin_amdgcn_readfirstlane(tid >> 6), lane = tid & 63, wr = wid >> 2, wc = wid & 3, fr = lane & 15, fq = lane >> 4;
    const int K = g.K, nt = K / BK;
    constexpr bool GATHER = Sched::GATHER; constexpr bool HALFS = Sched::HALFS;
    int ts_lo = 0, ts_hi = 0, nts = 0; const unsigned long long rt_entry = STAMP ? (unsigned long long)wall_clock64() : 0ull;
#define PG8_STAMP() do { if (STAMP && wid == 0 && nts < 64) { const unsigned long long _c = (unsigned long long)clock64(); \
        ts_lo = (lane == nts) ? (int)(unsigned)_c : ts_lo; ts_hi = (lane == nts) ? (int)(unsigned)(_c >> 32) : ts_hi; ++nts; } } while (0)
    PG8_STAMP();
    unsigned voffA[2], voffB[2]; int rowA[2];
#pragma unroll
    for (int i = 0; i < 2; ++i) { int R, C; stage_rc(tid * 16 + i * 8192, R, C); const int Rb = Epi::PERM ? ((R & ~31) + perm32(R & 31)) : R;
        rowA[i] = R; voffA[i] = GATHER ? (unsigned)C * 2u : (unsigned)(R * K + C) * 2u; voffB[i] = (unsigned)(Rb * K + C) * 2u; }
    const size_t kstep = (size_t)(BK * 2);
    const size_t hstep = (size_t)HALF * K * 2;
    const size_t tstep = 2 * hstep;
    const unsigned ldsw = (unsigned)wid * 1024u;
    const int aoff = lds_byte(wr * 64 + fr, fq * 8), boff = lds_byte(wc * 32 + fr, fq * 8);
#define PG8_SA(b, h) (((b) * 2 + (h)) * HTB)
#define PG8_SB(b, h) ((4 + (b) * 2 + (h)) * HTB)
#define PG8_STAGE(bufoff, gbase, voff) do { _Pragma("unroll") for (int _i = 0; _i < 2; ++_i) \
        __builtin_amdgcn_global_load_lds((const unsigned*)((const char*)(gbase) + (voff)[_i]), (PG8_LAS unsigned*)(lds + (bufoff) + ldsw + _i * 8192), 16, 0, 0); } while (0)
#define PG8_STAGE_A(bufoff, gbase, h, gv) do { if constexpr (GATHER) { PG8_STAGE(bufoff, gbase, (gv)[h]); } else { PG8_STAGE(bufoff, (gbase) + (h) * hstep, voffA); } } while (0)
#define PG8_TOKSLOT(s) ((PG8_LAS int*)(lds + STAGE_BYTES + 1024 + ((s) & 1) * 1024))
#define PG8_LDA(dst, b, h) do { _Pragma("unroll") for (int m = 0; m < 4; ++m) _Pragma("unroll") for (int k = 0; k < 2; ++k) dst[m][k] = *(const PG8_LAS bf16x8*)(lds + PG8_SA(b, h) + aoff + m * 2048 + k * 1024); } while (0)
#define PG8_LDB(dst, b, h) do { _Pragma("unroll") for (int n = 0; n < 2; ++n) _Pragma("unroll") for (int k = 0; k < 2; ++k) dst[n][k] = *(const PG8_LAS bf16x8*)(lds + PG8_SB(b, h) + boff + n * 2048 + k * 1024); } while (0)
#define PG8_MMA(ai, bj, At, Bt) do { __builtin_amdgcn_s_setprio(1); _Pragma("unroll") for (int m = 0; m < 4; ++m) _Pragma("unroll") for (int n = 0; n < 2; ++n) _Pragma("unroll") for (int k = 0; k < 2; ++k) \
        acc[ai][bj][m][n] = __builtin_amdgcn_mfma_f32_16x16x32_bf16(Bt[n][k], At[m][k], acc[ai][bj][m][n], 0, 0, 0); __builtin_amdgcn_s_setprio(0); } while (0)
#define PG8_WAIT_V(n) asm volatile("s_waitcnt vmcnt(" #n ")" ::: "memory")
#define PG8_WAIT_L(n) asm volatile("s_waitcnt lgkmcnt(" #n ")" ::: "memory")
#define PG8_BAR __builtin_amdgcn_s_barrier()
#define PG8_SCHED __builtin_amdgcn_sched_barrier(0)
    Unit cur, nxt; int ui = 0;
    if (!S.next(0, cur)) return;
    f32x4 acc[2][2][4][2];
#pragma unroll
    for (int a = 0; a < 2; ++a)
#pragma unroll
        for (int b = 0; b < 2; ++b)
#pragma unroll
            for (int m = 0; m < 4; ++m)
#pragma unroll
                for (int n = 0; n < 2; ++n) acc[a][b][m][n] = (f32x4){0.f, 0.f, 0.f, 0.f};
    bf16x8 At[4][2], B0[2][2], B1[2][2];
    const char* cA = (const char*)g.A + (GATHER ? (size_t)0 : (size_t)cur.pm * tstep); const char* cB = (const char*)g.Bt + (size_t)(HALFS ? cur.pn & 255 : cur.pn) * tstep + (size_t)cur.e * g.estride * 2 + ((HALFS && (cur.pn >> 8) == 2) ? hstep : (size_t)0);
    S.a_ready(cur);
    unsigned gcur[2][2], gnxt[2][2], gs[2][2];
    if constexpr (GATHER) {
        if (tid < 256) PG8_TOKSLOT(0)[tid] = S.tok[cur.pm * 256 + tid];
        __syncthreads();
#pragma unroll
        for (int h = 0; h < 2; ++h)
#pragma unroll
            for (int i = 0; i < 2; ++i) { gcur[h][i] = (unsigned)PG8_TOKSLOT(0)[h * HALF + rowA[i]] * (unsigned)(K * 2) + voffA[i]; gnxt[h][i] = gcur[h][i]; gs[h][i] = gcur[h][i]; }
    }
    PG8_STAGE(PG8_SB(0, 0), cB, voffB); PG8_STAGE_A(PG8_SA(0, 0), cA, 0, gcur); PG8_STAGE(PG8_SB(0, 1), cB + hstep, voffB); PG8_STAGE_A(PG8_SA(0, 1), cA, 1, gcur);
    if (wr == 1) PG8_BAR;
    PG8_WAIT_V(4); PG8_BAR;
    PG8_STAGE(PG8_SB(1, 0), cB + kstep, voffB); PG8_STAGE_A(PG8_SA(1, 0), cA + kstep, 0, gcur); PG8_STAGE(PG8_SB(1, 1), cB + hstep + kstep, voffB);
    PG8_WAIT_V(6); PG8_BAR;
    PG8_STAMP();
    for (;;) {
        const bool has_next = S.next(ui + 1, nxt);
        if constexpr (GATHER) { if (has_next && wid < 4)
            __builtin_amdgcn_global_load_lds((const unsigned*)(S.tok + nxt.pm * 256 + wid * 64 + lane), (PG8_LAS unsigned*)((PG8_LAS unsigned char*)PG8_TOKSLOT(ui + 1) + wid * 256), 4, 0, 0); }
        const char* nA = GATHER ? (const char*)g.A : has_next ? (const char*)g.A + (size_t)nxt.pm * tstep : cA; const char* nB = has_next ? (const char*)g.Bt + (size_t)(HALFS ? nxt.pn & 255 : nxt.pn) * tstep + (size_t)nxt.e * g.estride * 2 + ((HALFS && (nxt.pn >> 8) == 2) ? hstep : (size_t)0) : cB;
        const bool full = !HALFS || (cur.pn >> 8) == 0;
        for (int t = 0; t < nt; t += 2) {
            const bool last = (t == nt - 2);
            const char* a1 = cA + (size_t)(t + 1) * kstep;
            const char* a2 = last ? nA : cA + (size_t)(t + 2) * kstep; const char* b2 = last ? nB : cB + (size_t)(t + 2) * kstep;
            const char* a3 = a2 + kstep; const char* b3 = b2 + kstep;
            if (last && has_next) S.a_ready(nxt);
            if constexpr (GATHER) {
                if (last && has_next) {
#pragma unroll
                    for (int h = 0; h < 2; ++h)
#pragma unroll
                        for (int i = 0; i < 2; ++i) gnxt[h][i] = (unsigned)PG8_TOKSLOT(ui + 1)[h * HALF + rowA[i]] * (unsigned)(K * 2) + voffA[i];
                }
#pragma unroll
                for (int h = 0; h < 2; ++h)
#pragma unroll
                    for (int i = 0; i < 2; ++i) gs[h][i] = last ? gnxt[h][i] : gcur[h][i];
            }
            PG8_LDB(B0, 0, 0); PG8_SCHED; PG8_LDA(At, 0, 0); PG8_STAGE_A(PG8_SA(1, 1), a1, 1, gcur);
            PG8_WAIT_L(8); PG8_BAR; PG8_WAIT_L(0); PG8_MMA(0, 0, At, B0); PG8_BAR; PG8_SCHED;
            if (full) PG8_LDB(B1, 0, 1); PG8_STAGE(PG8_SB(0, 0), b2, voffB);
            PG8_BAR; PG8_WAIT_L(0); if (full) PG8_MMA(0, 1, At, B1); PG8_BAR;
            PG8_LDA(At, 0, 1); PG8_STAGE_A(PG8_SA(0, 0), a2, 0, gs);
            PG8_BAR; PG8_WAIT_L(0); PG8_MMA(1, 0, At, B0); PG8_BAR; PG8_SCHED;
            PG8_STAGE(PG8_SB(0, 1), b2 + hstep, voffB);
            PG8_WAIT_V(6); PG8_BAR; if (full) PG8_MMA(1, 1, At, B1); PG8_BAR;
            PG8_LDB(B0, 1, 0); PG8_SCHED; PG8_LDA(At, 1, 0); PG8_STAGE_A(PG8_SA(0, 1), a2, 1, gs);
            PG8_WAIT_L(8); PG8_BAR; PG8_WAIT_L(0); PG8_MMA(0, 0, At, B0); PG8_BAR; PG8_SCHED;
            if (full) PG8_LDB(B1, 1, 1); PG8_STAGE(PG8_SB(1, 0), b3, voffB);
            PG8_BAR; PG8_WAIT_L(0); if (full) PG8_MMA(0, 1, At, B1); PG8_BAR;
            PG8_LDA(At, 1, 1); PG8_STAGE_A(PG8_SA(1, 0), a3, 0, gs);
            PG8_BAR; PG8_WAIT_L(0); PG8_MMA(1, 0, At, B0); PG8_BAR; PG8_SCHED;
            PG8_STAGE(PG8_SB(1, 1), b3 + hstep, voffB);
            PG8_WAIT_V(6); PG8_BAR; if (full) PG8_MMA(1, 1, At, B1); PG8_BAR;
        }
        PG8_STAMP();
        if constexpr (!Epi::AFTER_DRAIN) { E(acc, cur, wr, wc, fr, fq); S.done(cur); }
        PG8_STAMP();
        if (!has_next) break;
#pragma unroll
        for (int a = 0; a < 2; ++a)
#pragma unroll
            for (int b = 0; b < 2; ++b)
#pragma unroll
                for (int m = 0; m < 4; ++m)
#pragma unroll
                    for (int n = 0; n < 2; ++n) acc[a][b][m][n] = (f32x4){0.f, 0.f, 0.f, 0.f};
        cur = nxt; cA = nA; cB = nB; ++ui;
        if constexpr (GATHER) {
#pragma unroll
            for (int h = 0; h < 2; ++h)
#pragma unroll
                for (int i = 0; i < 2; ++i) gcur[h][i] = gnxt[h][i];
        }
    }
    PG8_WAIT_V(0);
    if (wr == 0) PG8_BAR;
    PG8_BAR;
    if constexpr (Epi::AFTER_DRAIN) { E.fused(acc, cur, wr, wc, fr, fq, lds, wid, lane); S.done(cur); }
    PG8_STAMP();
    if (STAMP && wid == 0) { stamps[lane] = lane < nts ? (((unsigned long long)(unsigned)ts_hi << 32) | (unsigned)ts_lo) : 0ull;
        if (lane == 62) stamps[62] = rt_entry; if (lane == 63) stamps[63] = (unsigned long long)wall_clock64(); }
#undef PG8_STAMP
#undef PG8_SA
#undef PG8_SB
#undef PG8_STAGE
#undef PG8_STAGE_A
#undef PG8_TOKSLOT
#undef PG8_LDA
#undef PG8_LDB
#undef PG8_MMA
#undef PG8_WAIT_V
#undef PG8_WAIT_L
#undef PG8_BAR
#undef PG8_SCHED
}
}
namespace pg8 {
struct EpiRes {
    static constexpr bool PERM = true, AFTER_DRAIN = false;
    const void* base_lat; const float* base_ctx; void* out_lat; float* out_ctx; const float* gvec; bool base_bf, out_bf;
    __device__ __forceinline__ void operator()(const f32x4 (&acc)[2][2][4][2], const Unit& u, int wr, int wc, int fr, int fq) const {
        const bool isctx = u.pm >= 128;
        const int prow = (isctx ? (u.pm - 128) : u.pm) * BM;
        const float* base = isctx ? base_ctx : (const float*)base_lat; float* out = isctx ? out_ctx : (float*)out_lat;
        const bool bbf = !isctx && base_bf, obf = !isctx && out_bf;
        const float* gv = gvec + (size_t)(isctx ? 8 : (u.pm >> 4)) * 6144;
        const int row0 = prow + wr * 64 + fr, hf = u.pn >> 8, col0 = (u.pn & 255) * BM + (hf == 2 ? HALF : 0) + wc * 32 + 8 * fq;
        f32x4 gvv[2][2];
#pragma unroll
        for (int bj = 0; bj < 2; ++bj)
#pragma unroll
            for (int n = 0; n < 2; ++n) gvv[bj][n] = *(const f32x4*)(gv + col0 + bj * HALF + 4 * n);
#pragma unroll
        for (int ai = 0; ai < 2; ++ai)
#pragma unroll
            for (int m = 0; m < 4; ++m) { const size_t off = (size_t)(row0 + ai * HALF + m * 16) * 1024 + col0;
#pragma unroll
                for (int bj = 0; bj < 2; ++bj) { if (bj == 1 && hf != 0) continue; const size_t o2 = off + bj * HALF;
                    f32x4 b0, b1;
                    if (bbf) { const v4u r = *(const v4u*)((const bf16*)base_lat + o2); b0 = (f32x4){bflo(r.x), bfhi(r.x), bflo(r.y), bfhi(r.y)}; b1 = (f32x4){bflo(r.z), bfhi(r.z), bflo(r.w), bfhi(r.w)}; }
                    else { b0 = *(const f32x4*)(base + o2); b1 = *(const f32x4*)(base + o2 + 4); }
                    const f32x4 v0 = b0 + gvv[bj][0] * acc[ai][bj][m][0], v1 = b1 + gvv[bj][1] * acc[ai][bj][m][1];
                    if (obf) { v4u w; w.x = pk2(v0.x, v0.y); w.y = pk2(v0.z, v0.w); w.z = pk2(v1.x, v1.y); w.w = pk2(v1.z, v1.w); *(v4u*)((bf16*)out_lat + o2) = w; }
                    else { *(f32x4*)(out + o2) = v0; *(f32x4*)(out + o2 + 4) = v1; } } }
    }
};
struct EpiSwiglu {
    static constexpr bool PERM = true, AFTER_DRAIN = false;
    bf16_t* O; int ldc;
    __device__ __forceinline__ void operator()(const f32x4 (&acc)[2][2][4][2], const Unit& u, int wr, int wc, int fr, int fq) const {
        const int row0 = u.pm * BM + wr * 64 + fr, col0 = u.pn * HALF + wc * 32 + 8 * fq;
#pragma unroll
        for (int ai = 0; ai < 2; ++ai)
#pragma unroll
            for (int m = 0; m < 4; ++m) { bf16_t* rowp = O + (size_t)(row0 + ai * HALF + m * 16) * ldc + col0;
                float h[8];
#pragma unroll
                for (int n = 0; n < 2; ++n)
#pragma unroll
                    for (int j = 0; j < 4; ++j) { const float g = acc[ai][0][m][n][j], up = acc[ai][1][m][n][j]; h[n * 4 + j] = g * __builtin_amdgcn_rcpf(1.0f + __expf(-g)) * up; }
                u32x4 w; w.x = cvt_pk_bf16(h[0], h[1]); w.y = cvt_pk_bf16(h[2], h[3]); w.z = cvt_pk_bf16(h[4], h[5]); w.w = cvt_pk_bf16(h[6], h[7]);
                *(u32x4*)rowp = w; }
    }
};
struct MoeOrder {
    static constexpr bool GATHER = false, HALFS = false;
    int nN, G, c, nunits; const int* tab;
    __device__ void init(const int* tab_, int nN_, int G_, int c_) { tab = tab_; nN = nN_; G = G_; c = c_; nunits = tab_[0] * nN_; }
    __device__ bool next(int i, Unit& u) const {
        const int L = i * G + c; if (L >= nunits) return false;
        const int q = nunits / NXCD, r = nunits % NXCD, xcd = L % NXCD, off = L / NXCD;
        const int w = (xcd < r ? xcd * (q + 1) : r * (q + 1) + (xcd - r) * q) + off;
        u.pm = w / nN; u.pn = w - u.pm * nN; u.e = tab[1 + u.pm]; return true;
    }
    __device__ __forceinline__ void a_ready(const Unit&) const {}
    __device__ __forceinline__ void done(const Unit&) const {}
};
struct MoeOrderG : MoeOrder { static constexpr bool GATHER = true; const int* tok; };
}
enum { I_X = 0, I_C, I_CTX, I_CCTX, I_MODW, I_MODB, I_NMIXG, I_NFFNG, I_WIN, I_WOUT, I_LCW, I_LCB, I_LWA, I_LBA, I_LWX, I_LBX, I_LLAM,
       I_RMU, I_RWUP, I_RW0, I_RAUP, I_RA0, I_RGUP, I_RKK, I_RKA, I_RRK, I_RLNG, I_RLNB, I_MIB, I_MFB, I_MNG, I_GCW, I_GALOG, I_GDTB, I_GNG,
       I_FWG, I_FWU, I_FWD, I_MROUTER, I_MWG, I_MWU, I_MWD, I_FNG, N_IN };
struct Args { const float* in[N_IN]; float* out; unsigned char* ws; int ph_lo, ph_hi; };
struct Ctx {
    const float* const* in; float* out; unsigned char* ws; LAS unsigned char* lds;
    int tid, lane, wave, G, wg;
};
#define WSP(T, off) ((T*)(C.ws + (off)))

__device__ __forceinline__ int seqrow_raster(int i, int d, int b) {
    if (i < CTXL) { const int p = d ? (CTXL - 1 - i) : i; return T_LAT + b * CTXL + p; }
    const int j = i - CTXL; const int p = d ? (SEQ - 1 - j) : j; return b * SEQ + p;
}
__device__ __forceinline__ int seqrow_cm(int i, int d, int b) {
    if (i < CTXL) { const int p = d ? (CTXL - 1 - i) : i; return T_LAT + b * CTXL + p; }
    const int j = i - CTXL; const int p = d ? (SEQ - 1 - j) : j; return b * SEQ + (p & 63) * 64 + (p >> 6);
}

__device__ __forceinline__ void phase_pre(const Ctx& C) {
    LAS float* sc = (LAS float*)C.lds;
    LAS float* red = sc + 9 * 1024;
    float* modv = WSP(float, WS_MODV);
    bool filled = false;
    for (int it = C.wg; it < DEPTH * 48; it += C.G) {
        if (!filled) {
            for (int i = C.tid; i < 9 * 1024; i += NTHR) { const float v = i < 8192 ? C.in[I_C][i] : C.in[I_CCTX][i - 8192]; sc[i] = siluf_(v); }
            filled = true; __syncthreads();
        }
        const int l = it / 48, jb = it % 48, col = C.tid & 127, kg = C.tid >> 7;
        const float* W = C.in[I_MODW] + (size_t)l * 1024 * 6144 + jb * 128 + col;
        float acc[9];
#pragma unroll
        for (int r = 0; r < 9; ++r) acc[r] = 0.f;
        for (int k = kg * 256; k < kg * 256 + 256; ++k) { const float w = W[(size_t)k * 6144];
#pragma unroll
            for (int r = 0; r < 9; ++r) acc[r] += sc[r * 1024 + k] * w; }
#pragma unroll
        for (int r = 0; r < 9; ++r) red[(kg * 9 + r) * 128 + col] = acc[r];
        __syncthreads();
        for (int i = C.tid; i < 9 * 128; i += NTHR) { const int r = i >> 7, cc = i & 127;
            const float s = red[(0 * 9 + r) * 128 + cc] + red[(1 * 9 + r) * 128 + cc] + red[(2 * 9 + r) * 128 + cc] + red[(3 * 9 + r) * 128 + cc];
            modv[((size_t)l * 9 + r) * 6144 + jb * 128 + cc] = s + C.in[I_MODB][l * 6144 + jb * 128 + cc]; }
        __syncthreads();
    }
}

__device__ __forceinline__ void tr_item(const float* src, size_t ld, int k0, int ns0, bf16* dst, int drow0, int Kd, LAS float* scr, int lane, bool zero) {
    if (!zero) {
#pragma unroll 8
        for (int i = 0; i < 32; ++i) { const int kk = 2 * i + (lane >> 5); scr[kk * 33 + (lane & 31)] = src[(size_t)(k0 + kk) * ld + ns0 + (lane & 31)]; }
    }
    LDS_WAIT(); asm volatile("" ::: "memory");
    const int c = lane & 7;
#pragma unroll
    for (int j = 0; j < 4; ++j) { const int n = (lane >> 3) + 8 * j; const LAS float* s = scr + (8 * c) * 33 + n;
        v4u o; o.x = pk2(s[0 * 33], s[1 * 33]); o.y = pk2(s[2 * 33], s[3 * 33]); o.z = pk2(s[4 * 33], s[5 * 33]); o.w = pk2(s[6 * 33], s[7 * 33]);
        if (zero) o = (v4u){0u, 0u, 0u, 0u};
        *(v4u*)(dst + (size_t)(drow0 + n) * Kd + k0 + 8 * c) = o; }
    LDS_WAIT(); asm volatile("" ::: "memory");
}
__device__ __forceinline__ void convert_small(const Ctx& C, int l) {
    {
        bf16* lw = WSP(bf16, WS_LRUWT);
        for (int k = 0; k < 2 * 2 * 4 * 4096 / (128 * NTHR); ++k) {
            const int e = k * 128 * NTHR + C.wg * NTHR + C.tid;
            if (C.wg < 128) {
            const int i = e & 63, j = (e >> 6) & 63, hd = (e >> 12) & 3, g = (e >> 14) & 1, d = e >> 15;
            const float* src = (g ? C.in[I_LWX] : C.in[I_LWA]) + ((size_t)((l * 2 + d) * 4 + hd) * 64 + i) * 64 + j;
            lw[e] = (bf16)f2bf(*src);
            }
        }
    }
    if (C.wg >= 128 && C.wg < 224) {
        bf16* rw = WSP(bf16, WS_RWT);
        const int e = (C.wg - 128) * NTHR + C.tid;
        if (e < 32768) { const int r = e & 31, ch = (e >> 5) & 255, d = (e >> 13) & 1, isa = e >> 14;
            rw[e] = (bf16)f2bf((isa ? C.in[I_RAUP] : C.in[I_RWUP])[((size_t)(l * 2 + d) * 32 + r) * GW + ch]); }
        else { const int e2 = e - 32768, j = e2 & 63, ch = e2 >> 6; rw[e] = (bf16)f2bf(C.in[I_RGUP][((size_t)l * 64 + j) * GW + ch]); }
    }
}
__device__ __forceinline__ void convert_items(const Ctx& C, int l, int what, int gw, int NGW) {
    LAS float* scr = (LAS float*)(C.lds + C.wave * 8704);
    constexpr int I_IN = 16 * 112, I_OUT = 16 * 32, I_GU = 16 * 176, I_DN = 44 * 32, I_E = 16 * 88 + 22 * 32;
    const bool moe = l & 1; const int li = l >> 1;
    const int lo_it = (what & 1) ? 0 : I_IN, hi_it = (what & 2) ? I_IN + I_OUT + (moe ? NE * I_E : (I_GU + I_DN)) : I_IN;
    bf16* win = WSP(bf16, WS_WIN); bf16* wout = WSP(bf16, WS_WOUT); bf16* wgu = WSP(bf16, WS_WGU); bf16* wdn = WSP(bf16, WS_WDN);
    for (int it = lo_it + gw; it < hi_it; it += NGW) {
        int r = it;
        if (r < I_IN) { const int kb = r / 112, nb = r % 112; tr_item(C.in[I_WIN] + (size_t)l * 1024 * IN_COLS, IN_COLS, 64 * kb, 32 * nb, win, 32 * nb, 1024, scr, C.lane, nb == 111); continue; }
        r -= I_IN;
        if (r < I_OUT) { const int kb = r / 32, nb = r % 32; tr_item(C.in[I_WOUT] + (size_t)l * 1024 * 1024, 1024, 64 * kb, 32 * nb, wout, 32 * nb, 1024, scr, C.lane, false); continue; }
        r -= I_OUT;
        if (!moe) {
            if (r < I_GU) { const int kb = r / 176, nb = r % 176, tile = nb >> 3, q = nb & 7;
                const float* src = (q < 4 ? C.in[I_FWG] : C.in[I_FWU]) + (size_t)li * 1024 * DFF;
                tr_item(src, DFF, 64 * kb, tile * 128 + (q & 3) * 32, wgu, 32 * nb, 1024, scr, C.lane, false); continue; }
            r -= I_GU;
            { const int kb = r / 32, nb = r % 32; tr_item(C.in[I_FWD] + (size_t)li * DFF * 1024, 1024, 64 * kb, 32 * nb, wdn, 32 * nb, DFF, scr, C.lane, false); }
        } else {
            const int e = r / I_E; int rr = r % I_E;
            if (rr < 16 * 88) { const int kb = rr / 88, nb = rr % 88, tile = nb >> 3, q = nb & 7;
                const float* src = (q < 4 ? C.in[I_MWG] : C.in[I_MWU]) + ((size_t)li * NE + e) * 1024 * DFE;
                tr_item(src, DFE, 64 * kb, tile * 128 + (q & 3) * 32, wgu + (size_t)e * 2 * DFE * 1024, 32 * nb, 1024, scr, C.lane, false); continue; }
            rr -= 16 * 88;
            { const int kb = rr / 32, nb = rr % 32; tr_item(C.in[I_MWD] + ((size_t)li * NE + e) * DFE * 1024, 1024, 64 * kb, 32 * nb, wdn + (size_t)e * 1024 * DFE, 32 * nb, DFE, scr, C.lane, false); }
        }
    }
}

template <bool ROUTE>
__device__ __forceinline__ void norm_rows(const Ctx& C, int l, const void* xlat, bool xbf, const float* xctx, const float* gain, int shoff, int scoff, int nrows, int moe_li) {
    const float* modv = WSP(float, WS_MODV) + (size_t)l * 9 * 6144;
    bf16* hb = WSP(bf16, WS_HB);
    const int gw = C.wg * NWAVES + C.wave, NGW = C.G * NWAVES;
    LAS unsigned* lcnt = (LAS unsigned*)(C.lds + 65536);
    unsigned* route = WSP(unsigned, WS_ROUTE);
    if (ROUTE) { if (C.tid < 8) lcnt[C.tid] = 0u; __syncthreads(); }
    f32x4 gv[4];
#pragma unroll
    for (int j = 0; j < 4; ++j) gv[j] = *(const f32x4*)(gain + 4 * C.lane + 256 * j);
    v4u rawn[4]; bool rbfn = false;
#define NR_LOAD(mm) do { const int m_ = (mm); const bool ic_ = m_ >= T_LAT; rbfn = xbf && !ic_; \
        if (rbfn) { _Pragma("unroll") for (int j = 0; j < 4; ++j) { const v2u t_ = *(const v2u*)((const bf16*)xlat + (size_t)m_ * 1024 + 4 * C.lane + 256 * j); rawn[j] = (v4u){t_.x, t_.y, 0u, 0u}; } } \
        else { const float* xr_ = ic_ ? xctx + (size_t)(m_ - T_LAT) * 1024 : (const float*)xlat + (size_t)m_ * 1024; _Pragma("unroll") for (int j = 0; j < 4; ++j) rawn[j] = *(const v4u*)(xr_ + 4 * C.lane + 256 * j); } } while (0)
    if (gw < nrows) NR_LOAD(gw);
    for (int m = gw; m < nrows; m += NGW) {
        const bool isctx = m >= T_LAT;
        const float* mv = modv + (size_t)(isctx ? 8 : (m >> 12)) * 6144;
        v4u raw[4]; const bool rbf = rbfn;
#pragma unroll
        for (int j = 0; j < 4; ++j) raw[j] = rawn[j];
        if (m + NGW < nrows) NR_LOAD(m + NGW);
        f32x4 v[4]; float s = 0.f;
#pragma unroll
        for (int j = 0; j < 4; ++j) { v[j] = rbf ? (f32x4){bflo(raw[j].x), bfhi(raw[j].x), bflo(raw[j].y), bfhi(raw[j].y)} : __builtin_bit_cast(f32x4, raw[j]); s += (v[j].x * v[j].x + v[j].y * v[j].y) + (v[j].z * v[j].z + v[j].w * v[j].w); }
        const float rs = rsqrtf_(wave_sum(s) * (1.0f / 1024.0f) + 1e-6f);
#pragma unroll
        for (int j = 0; j < 4; ++j) { const f32x4 sh = *(const f32x4*)(mv + shoff + 4 * C.lane + 256 * j), scl = *(const f32x4*)(mv + scoff + 4 * C.lane + 256 * j);
            v[j] = (v[j] * rs * gv[j]) * (scl + 1.0f) + sh;
            v2u o; o.x = pk2(v[j].x, v[j].y); o.y = pk2(v[j].z, v[j].w);
            *(v2u*)(hb + (size_t)m * 1024 + 4 * C.lane + 256 * j) = o; }
        if (ROUTE) {
            const float* rt = C.in[I_MROUTER] + (size_t)moe_li * 1024 * NE;
            float lg[8];
#pragma unroll
            for (int e = 0; e < 8; ++e) lg[e] = 0.f;
#pragma unroll
            for (int j = 0; j < 4; ++j)
#pragma unroll
                for (int q = 0; q < 4; ++q) { const int k = 4 * C.lane + 256 * j + q; const f32x4 r0 = *(const f32x4*)(rt + (size_t)k * 8), r1 = *(const f32x4*)(rt + (size_t)k * 8 + 4); const float hv = v[j][q];
                    lg[0] += hv * r0.x; lg[1] += hv * r0.y; lg[2] += hv * r0.z; lg[3] += hv * r0.w; lg[4] += hv * r1.x; lg[5] += hv * r1.y; lg[6] += hv * r1.z; lg[7] += hv * r1.w; }
#pragma unroll
            for (int e = 0; e < 8; ++e) lg[e] = wave_sum(lg[e]);
            int e0 = 0; float l0 = lg[0];
#pragma unroll
            for (int e = 1; e < 8; ++e) if (lg[e] > l0) { l0 = lg[e]; e0 = e; }
            int e1 = (e0 == 0) ? 1 : 0; float l1 = -3.0e38f;
#pragma unroll
            for (int e = 0; e < 8; ++e) if (e != e0 && lg[e] > l1) { l1 = lg[e]; e1 = e; }
            const float w0 = __builtin_amdgcn_rcpf(1.0f + __expf(l1 - l0)), w1 = 1.0f - w0;
            if (C.lane == 0) {
                const unsigned r0 = atomicAdd((unsigned*)&lcnt[e0], 1u), r1 = atomicAdd((unsigned*)&lcnt[e1], 1u);
                v4u a; a.x = (unsigned)e0; a.y = (unsigned)e1; a.z = r0; a.w = r1;
                *(v4u*)(route + (size_t)m * 8) = a;
                v2u b; b.x = __builtin_bit_cast(unsigned, w0); b.y = __builtin_bit_cast(unsigned, w1);
                *(v2u*)(route + (size_t)m * 8 + 4) = b;
            }
        }
    }
#undef NR_LOAD
    if (ROUTE) {
        __syncthreads();
        if (C.tid < 8) { unsigned* gc = WSP(unsigned, WS_CTL) + CW_MOECNT + 64 * moe_li; const unsigned base = atomicAdd(gc + C.tid, lcnt[C.tid]); WSP(unsigned, WS_WGBASE)[C.wg * 8 + C.tid] = base; }
    }
}
#define RAW_BARRIER() do { asm volatile("s_waitcnt lgkmcnt(0)" ::: "memory"); __builtin_amdgcn_s_barrier(); asm volatile("" ::: "memory"); } while (0)
__device__ __forceinline__ void gdn_prep(const Ctx& C, int l, int b, int c) {
    const bf16* P = WSP(const bf16, WS_P); bf16* gq = WSP(bf16, WS_GQ);
    const bool isctx = c < 4; const int p0 = isctx ? c * 64 : (c - 4) * 64; const int Lp = isctx ? CTXL : SEQ;
    const int ch = 4 * C.lane;
    auto rowof = [&](int p) -> int { return isctx ? (T_LAT + b * CTXL + p) : (b * SEQ + (p & 63) * 64 + (p >> 6)); };
    f32x4 cw[4][3], x[4][3];
#pragma unroll
    for (int j = 0; j < 4; ++j)
#pragma unroll
        for (int g = 0; g < 3; ++g) cw[j][g] = *(const f32x4*)(C.in[I_GCW] + ((size_t)l * 4 + j) * 768 + g * 256 + ch);
    const int tb = p0 + C.wave * 8;
    auto ldrow = [&](int p, f32x4 (&dst)[3]) {
        if (p >= 0 && p < Lp) { const bf16* pr = P + (size_t)rowof(p) * PLD + OFF_D + ch;
#pragma unroll
            for (int g = 0; g < 3; ++g) dst[g] = ld4bf(pr + g * 256); }
        else {
#pragma unroll
            for (int g = 0; g < 3; ++g) dst[g] = (f32x4){0.f, 0.f, 0.f, 0.f}; }
    };
    ldrow(tb - 2, x[0]); ldrow(tb - 1, x[1]); ldrow(tb, x[2]);
#pragma unroll
    for (int t = 0; t < 8; ++t) {
        ldrow(tb + t + 1, x[3]);
        bf16* orow = gq + (size_t)rowof(tb + t) * 768 + ch;
#pragma unroll
        for (int g = 0; g < 3; ++g) {
            f32x4 v = cw[0][g] * x[0][g] + cw[1][g] * x[1][g] + cw[2][g] * x[2][g] + cw[3][g] * x[3][g];
            v = (f32x4){siluf_(v.x), siluf_(v.y), siluf_(v.z), siluf_(v.w)};
            if (g < 2) { const float ss = row16_sum((v.x * v.x + v.y * v.y) + (v.z * v.z + v.w * v.w)); v = v * (rsqrtf_(ss + 1e-6f) * (g == 0 ? 0.125f : 1.0f)); }
            st4bf(orow + g * 256, v);
        }
#pragma unroll
        for (int g = 0; g < 3; ++g) { x[0][g] = x[1][g]; x[1][g] = x[2][g]; x[2][g] = x[3][g]; }
    }
}
__device__ __forceinline__ void finish_rows(const Ctx& C, int l, int nrows) {
    const bf16* P = WSP(const bf16, WS_P); bf16* yc = WSP(bf16, WS_HB);
    const bf16* ob = WSP(const bf16, WS_OUTB); const bf16* oc = WSP(const bf16, WS_OUTC); const bf16* od = WSP(const bf16, WS_OUTD);
    const bf16* gg = WSP(const bf16, WS_G); const float* bonus = WSP(const float, WS_BONUS);
    const float* mu = C.in[I_RMU] + (size_t)l * 2 * B_COLS;
    const int gw = C.wg * NWAVES + C.wave, NGW = C.G * NWAVES, lane = C.lane, ch = 4 * lane, hh = lane >> 4;
    const f32x4 lng = *(const f32x4*)(C.in[I_RLNG] + l * GW + ch), lnb = *(const f32x4*)(C.in[I_RLNB] + l * GW + ch);
    const f32x4 mng = *(const f32x4*)(C.in[I_MNG] + l * GW + ch), gng = *(const f32x4*)(C.in[I_GNG] + l * GW + ch);
    const f32x4 mu0 = *(const f32x4*)(mu + 512 + ch), mu1 = *(const f32x4*)(mu + B_COLS + 512 + ch);
    const size_t o2 = (size_t)T_ALL * 256;
#pragma unroll 2
    for (int m = gw; m < nrows; m += NGW) {
        const bool isctx = m >= T_LAT; const int Lp = isctx ? CTXL : SEQ; const int p = isctx ? ((m - T_LAT) & (CTXL - 1)) : (m & (SEQ - 1));
        const f32x4 yb = ld4bf(ob + (size_t)m * 256 + ch) + ld4bf(ob + o2 + (size_t)m * 256 + ch);
        const f32x4 ycv = ld4bf(oc + (size_t)m * 256 + ch) + ld4bf(oc + o2 + (size_t)m * 256 + ch);
        const f32x4 yd = ld4bf(od + (size_t)m * 256 + ch) + ld4bf(od + o2 + (size_t)m * 256 + ch);
        const bf16* pr = P + (size_t)m * PLD;
        const f32x4 vs = ld4bf(WSP(const bf16, WS_RKV) + (size_t)m * 768 + 512 + ch);
        const f32x4 og = ld4bf(pr + OFF_C + 768 + ch), gd = ld4bf(pr + OFF_D + 768 + ch), gr = ld4bf(gg + (size_t)m * 256 + ch);
        const float bn = bonus[(size_t)m * 4 + hh];
        *(v2u*)(yc + (size_t)m * 1024 + ch) = *(const v2u*)(pr + 256 + ch);
        {
            const float mean = row16_sum((yb.x + yb.y) + (yb.z + yb.w)) * (1.0f / 64.0f);
            const f32x4 dl = yb - mean;
            const float var = row16_sum((dl.x * dl.x + dl.y * dl.y) + (dl.z * dl.z + dl.w * dl.w)) * (1.0f / 64.0f);
            const f32x4 yn = dl * rsqrtf_(var + 64e-5f) * lng + lnb;
            st4bf(yc + (size_t)m * 1024 + 256 + ch, (yn + vs * bn) * gr);
        }
        {
            const float ms = row16_sum((ycv.x * ycv.x + ycv.y * ycv.y) + (ycv.z * ycv.z + ycv.w * ycv.w)) * (1.0f / 64.0f);
            const f32x4 sg = (f32x4){sigmoidf_(og.x), sigmoidf_(og.y), sigmoidf_(og.z), sigmoidf_(og.w)};
            st4bf(yc + (size_t)m * 1024 + 512 + ch, ycv * rsqrtf_(ms + 1e-6f) * mng * sg);
        }
        {
            const float ms = row16_sum((yd.x * yd.x + yd.y * yd.y) + (yd.z * yd.z + yd.w * yd.w)) * (1.0f / 64.0f);
            const f32x4 sg = (f32x4){siluf_(gd.x), siluf_(gd.y), siluf_(gd.z), siluf_(gd.w)};
            st4bf(yc + (size_t)m * 1024 + 768 + ch, yd * rsqrtf_(ms + 1e-6f) * gng * sg);
        }
    }
}
typedef bf16x8 fragb;
__device__ __forceinline__ f32x4 mfma16(fragb a, fragb b, f32x4 c) { return __builtin_amdgcn_mfma_f32_16x16x32_bf16(a, b, c, 0, 0, 0); }
__device__ __forceinline__ fragb ld_frag16(const LAS bf16* p) { return *(const LAS fragb*)p; }
__device__ __forceinline__ fragb ld_frag8x2(const LAS bf16* p0, const LAS bf16* p1) {
    const v2u a = *(const LAS v2u*)p0, b = *(const LAS v2u*)p1; v4u r; r.x = a.x; r.y = a.y; r.z = b.x; r.w = b.y; return __builtin_bit_cast(fragb, r); }
__device__ __forceinline__ fragb pack_frag(const f32x4& lo, const f32x4& hi) { v4u r; r.x = pk2(lo.x, lo.y); r.y = pk2(lo.z, lo.w); r.z = pk2(hi.x, hi.y); r.w = pk2(hi.z, hi.w); return __builtin_bit_cast(fragb, r); }
__device__ __forceinline__ float wave_incl_sum(float v, int lane) {
    v += dpp_x<0x111, 0xF, true>(0.f, v); v += dpp_x<0x112, 0xF, true>(0.f, v); v += dpp_x<0x114, 0xF, true>(0.f, v); v += dpp_x<0x118, 0xF, true>(0.f, v);
    v += dpp_x<0x142, 0xA, false>(0.f, v); v += dpp_x<0x143, 0xC, false>(0.f, v);
    return v;
}
__device__ __forceinline__ float wave_incl_max(float v, int lane) {
    const float ninf = -3.0e38f;
    v = fmaxf(v, dpp_x<0x111, 0xF, false>(ninf, v)); v = fmaxf(v, dpp_x<0x112, 0xF, false>(ninf, v)); v = fmaxf(v, dpp_x<0x114, 0xF, false>(ninf, v)); v = fmaxf(v, dpp_x<0x118, 0xF, false>(ninf, v));
    v = fmaxf(v, dpp_x<0x142, 0xA, false>(ninf, v)); v = fmaxf(v, dpp_x<0x143, 0xC, false>(ninf, v));
    return v;
}
constexpr int MP = 72;
__device__ __forceinline__ void mlstm_chunked(const Ctx& C, int l, int idx) {
    const int d = idx >> 5, b = (idx >> 2) & 7, h = idx & 3, lane = C.lane, w = C.wave, l15 = lane & 15, q = lane >> 4;
    const int it = w & 3, vtp = w >> 2;
    constexpr int IMG = 64 * MP * 2, BUFB = 4 * IMG + 1024, CTB = 65 * MP * 2 + 16;
    LAS unsigned char* L0 = C.lds;
    const bf16* P = WSP(const bf16, WS_P); bf16* outc = WSP(bf16, WS_OUTC) + (size_t)d * T_ALL * 256;
    const float ib = C.in[I_MIB][(l * 2 + d) * NH + h], fb = C.in[I_MFB][(l * 2 + d) * NH + h];
    const int tt = C.tid >> 3, part = C.tid & 7;
    for (int i = C.tid; i < 2 * CTB / 4; i += NTHR) ((LAS unsigned*)(L0 + 2 * BUFB))[i] = 0u;
    v4u rq, rk, rv; unsigned short rgi, rgf;
    auto gload = [&](int n) {
        const int row = seqrow_cm(n * 64 + tt, d, b);
        const bf16* pp = P + (size_t)row * PLD + OFF_C + h * 64 + 8 * part;
        rq = *(const v4u*)pp; rk = *(const v4u*)(pp + 256); rv = *(const v4u*)(pp + 512);
        const bf16* pg = P + (size_t)seqrow_cm(n * 64 + lane, d, b) * PLD + OFF_C + 1024 + d * 4 + h;
        rgi = pg[0]; rgf = pg[8];
    };
    auto images = [&](int bufi) {
        LAS unsigned char* B0 = L0 + bufi * BUFB;
        LAS bf16* Qs = (LAS bf16*)B0; LAS bf16* Ks = Qs + 64 * MP; LAS bf16* VT = Ks + 64 * MP; LAS bf16* KTw = VT + 64 * MP; LAS float* vec = (LAS float*)(B0 + 4 * IMG);
        const float li = bf2f(rgi) + ib, lf = -softplusf_(-(bf2f(rgf) + fb));
        const float bc = wave_incl_sum(lf, lane), x = li - bc, cm = wave_incl_max(x, lane);
        const float wl = __expf(x - __shfl(cm, 63)) * 0.125f;
        if (w == 0) { vec[lane] = x; vec[64 + lane] = cm; vec[128 + lane] = bc; }
        const float wmine = __shfl(wl, 8 * w + (lane >> 3));
        *(LAS v4u*)(Qs + tt * MP + 8 * part) = rq; *(LAS v4u*)(Ks + tt * MP + 8 * part) = rk;
        const unsigned vv[4] = {rv.x, rv.y, rv.z, rv.w}, kk[4] = {rk.x, rk.y, rk.z, rk.w};
#pragma unroll
        for (int e = 0; e < 4; ++e) {
            VT[(8 * part + 2 * e) * MP + tt] = (bf16)(vv[e] & 0xffffu); VT[(8 * part + 2 * e + 1) * MP + tt] = (bf16)(vv[e] >> 16);
            KTw[(8 * part + 2 * e) * MP + tt] = (bf16)f2bf1(bflo(kk[e]) * wmine); KTw[(8 * part + 2 * e + 1) * MP + tt] = (bf16)f2bf1(bfhi(kk[e]) * wmine);
        }
    };
    f32x4 Cst[2], nst; float m = 0.f;
    Cst[0] = Cst[1] = nst = (f32x4){0.f, 0.f, 0.f, 0.f};
    const fragb ones = __builtin_bit_cast(fragb, (v4u){0x3F803F80u, 0x3F803F80u, 0x3F803F80u, 0x3F803F80u});
    const f32x4 z4 = (f32x4){0.f, 0.f, 0.f, 0.f};
    gload(0); images(0); gload(1);
#pragma unroll 1
    for (int n = 0; n < NCH; ++n) {
        RAW_BARRIER();
        const LAS unsigned char* B0 = L0 + (n & 1) * BUFB;
        const LAS bf16* Qs = (const LAS bf16*)B0; const LAS bf16* Ks = Qs + 64 * MP; const LAS bf16* VT = Ks + 64 * MP; const LAS bf16* KTw = VT + 64 * MP; const LAS float* vec = (const LAS float*)(B0 + 4 * IMG);
        const LAS bf16* CT = (const LAS bf16*)(L0 + 2 * BUFB + (n & 1) * CTB); LAS bf16* CTn = (LAS bf16*)(L0 + 2 * BUFB + ((n + 1) & 1) * CTB);
        fragb Qf[2]; Qf[0] = ld_frag16(Qs + (16 * it + l15) * MP + 8 * q); Qf[1] = ld_frag16(Qs + (16 * it + l15) * MP + 32 + 8 * q);
        const float cmi = vec[64 + 16 * it + l15]; const int icol = 16 * it + l15;
        f32x4 pt[4];
#pragma unroll
        for (int jt = 0; jt < 4; ++jt) {
            pt[jt] = z4;
            if (jt <= it) {
                const fragb k0 = ld_frag16(Ks + (16 * jt + l15) * MP + 8 * q), k1 = ld_frag16(Ks + (16 * jt + l15) * MP + 32 + 8 * q);
                f32x4 st = mfma16(k0, Qf[0], z4); st = mfma16(k1, Qf[1], st);
                const f32x4 xj = *(const LAS f32x4*)(vec + 16 * jt + 4 * q);
#pragma unroll
                for (int r = 0; r < 4; ++r) { const int j = 16 * jt + 4 * q + r; pt[jt][r] = (j <= icol) ? st[r] * __expf(xj[r] - cmi) * 0.125f : 0.f; }
            }
        }
        fragb Pf[2]; Pf[0] = pack_frag(pt[0], pt[1]); Pf[1] = pack_frag(pt[2], pt[3]);
        fragb Vf[2][2];
#pragma unroll
        for (int v2 = 0; v2 < 2; ++v2)
#pragma unroll
            for (int s = 0; s < 2; ++s) { const LAS bf16* vr = VT + (16 * (2 * vtp + v2) + l15) * MP + 32 * s + 4 * q; Vf[v2][s] = ld_frag8x2(vr, vr + 16); }
        f32x4 Aacc[2], R[2], as, dn;
        as = mfma16(Pf[0], ones, z4); if (it >= 2) as = mfma16(Pf[1], ones, as);
        const fragb nf0 = ld_frag16(CT + 64 * MP + 8 * q), nf1 = ld_frag16(CT + 64 * MP + 32 + 8 * q);
        dn = mfma16(Qf[0], nf0, z4); dn = mfma16(Qf[1], nf1, dn);
#pragma unroll
        for (int v2 = 0; v2 < 2; ++v2) {
            Aacc[v2] = mfma16(Pf[0], Vf[v2][0], z4); if (it >= 2) Aacc[v2] = mfma16(Pf[1], Vf[v2][1], Aacc[v2]);
            const LAS bf16* cr = CT + (16 * (2 * vtp + v2) + l15) * MP + 8 * q;
            R[v2] = mfma16(Qf[0], ld_frag16(cr), z4); R[v2] = mfma16(Qf[1], ld_frag16(cr + 32), R[v2]);
        }
        {
            const f32x4 bi = *(const LAS f32x4*)(vec + 128 + 16 * it + 4 * q), cmr = *(const LAS f32x4*)(vec + 64 + 16 * it + 4 * q);
#pragma unroll
            for (int r = 0; r < 4; ++r) {
                const float mi = bi[r] + cmr[r], minter = bi[r] + m, mt = fmaxf(minter, mi), e1 = __expf(mi - mt), e2 = __expf(minter - mt);
                const float den = e1 * as[r] + e2 * dn[r]; const float inv = __builtin_amdgcn_rcpf(fmaxf(fabsf(den), __expf(-mt)));
                const int row = seqrow_cm(n * 64 + 16 * it + 4 * q + r, d, b);
#pragma unroll
                for (int v2 = 0; v2 < 2; ++v2) outc[(size_t)row * 256 + h * 64 + 16 * (2 * vtp + v2) + l15] = (bf16)f2bf1((e1 * Aacc[v2][r] + e2 * R[v2][r]) * inv);
            }
        }
        {
            const LAS bf16* kr = KTw + (16 * it + l15) * MP + 4 * q;
            const fragb kt0 = ld_frag8x2(kr, kr + 16), kt1 = ld_frag8x2(kr + 32, kr + 48);
            const float bL = vec[128 + 63], mloc = bL + vec[64 + 63];
            const float mnew = fmaxf(bL + m, mloc), wp = __expf(bL + m - mnew), wn = __expf(mloc - mnew);
            f32x4 gk = mfma16(kt0, ones, z4); gk = mfma16(kt1, ones, gk);
            nst = nst * wp + gk * wn;
#pragma unroll
            for (int v2 = 0; v2 < 2; ++v2) {
                f32x4 G = mfma16(kt0, Vf[v2][0], z4); G = mfma16(kt1, Vf[v2][1], G);
                Cst[v2] = Cst[v2] * wp + G * wn;
                v2u o; o.x = pk2(Cst[v2].x, Cst[v2].y); o.y = pk2(Cst[v2].z, Cst[v2].w);
                *(LAS v2u*)(CTn + (16 * (2 * vtp + v2) + l15) * MP + 16 * it + 4 * q) = o;
            }
            if (vtp == 0 && l15 == 0) { v2u o; o.x = pk2(nst.x, nst.y); o.y = pk2(nst.z, nst.w); *(LAS v2u*)(CTn + 64 * MP + 16 * it + 4 * q) = o; }
            m = mnew;
        }
        if (n + 1 < NCH) { images((n + 1) & 1); if (n + 2 < NCH) gload(n + 2); }
    }
    __syncthreads();
}
__device__ __forceinline__ int fwd_row_cm(int b, int c, int t) { return c < 4 ? (T_LAT + b * CTXL + c * 64 + t) : (b * SEQ + t * 64 + (c - 4)); }
__device__ __forceinline__ bf16* blob_row(const Ctx& C, int d, int isw, int b, int c, int h, int r) {
    const int row = fwd_row_cm(b, c, r);
    if (d == 1 && isw) return WSP(bf16, WS_OUTD) + ((size_t)T_ALL + row) * 256 + h * 64;
    return WSP(bf16, WS_P) + (size_t)row * PLD + OFF_D + (d * 2 + isw) * 256 + h * 64;
}
constexpr int LP = 68;
__device__ __forceinline__ void blocked_solve(const LAS bf16* Ln, const LAS bf16* TinvP, LAS unsigned char* XTw, f32x4 (&acc)[4][4], int l15, int q) {
    const f32x4 z4 = (f32x4){0.f, 0.f, 0.f, 0.f};
#pragma unroll
    for (int I = 0; I < 4; ++I) {
        const fragb Af = *(const LAS fragb*)(TinvP + (I * 16 + l15) * 32 + 8 * q);
        fragb A0, A1;
        if (I >= 1) A0 = ld_frag16(Ln + (16 * I + l15) * MP + 8 * q);
        if (I == 3) A1 = ld_frag16(Ln + (16 * I + l15) * MP + 32 + 8 * q);
#pragma unroll
        for (int nt = 0; nt < 4; ++nt) {
            const int crow = 16 * nt + l15; LAS unsigned char* xr = XTw + crow * 128;
            f32x4 a = acc[I][nt];
            if (I >= 1) a = mfma16(A0, *(const LAS fragb*)(xr + ((q ^ (crow & 7)) << 4)), a);
            if (I == 3) a = mfma16(A1, *(const LAS fragb*)(xr + (((4 + q) ^ (crow & 7)) << 4)), a);
            v4u bw; bw.x = pk2(a.x, a.y); bw.y = pk2(a.z, a.w); bw.z = 0u; bw.w = 0u;
            const f32x4 x = mfma16(Af, __builtin_bit_cast(fragb, bw), z4);
            acc[I][nt] = x;
            v2u o; o.x = pk2(x.x, x.y); o.y = pk2(x.z, x.w);
            *(LAS v2u*)(xr + (((2 * I + (q >> 1)) ^ (crow & 7)) << 4) + (q & 1) * 8) = o;
        }
    }
}
__device__ __forceinline__ void diag_inverses(const LAS bf16* Ln, LAS bf16* TinvP, int lane) {
    const int blk = lane >> 4, c = lane & 15;
    float x[16];
#pragma unroll
    for (int i = 0; i < 16; ++i) {
        const LAS bf16* lr = Ln + (16 * blk + i) * MP + 16 * blk;
        const v4u r0 = *(const LAS v4u*)lr, r1 = *(const LAS v4u*)(lr + 8);
        const unsigned rw[8] = {r0.x, r0.y, r0.z, r0.w, r1.x, r1.y, r1.z, r1.w};
        float s = (i == c) ? 1.0f : 0.0f;
#pragma unroll
        for (int j = 0; j < i; ++j) s += ((j & 1) ? bfhi(rw[j >> 1]) : bflo(rw[j >> 1])) * x[j];
        x[i] = s;
        TinvP[(blk * 16 + i) * 32 + 8 * (c >> 2) + (c & 3)] = (bf16)f2bf1(s);
    }
}
__device__ __forceinline__ void gdn_solve_item(const Ctx& C, int l, int item) {
    const int lane = C.lane, w = C.wave, pw = w & 1, pi = w >> 1, l15 = lane & 15, q = lane >> 4;
    LAS unsigned char* B0 = C.lds + pi * 31744;
    LAS bf16* Ln = (LAS bf16*)B0;
    LAS bf16* TinvP = (LAS bf16*)(B0 + 9216);
    LAS float* vec = (LAS float*)(B0 + 13312);
    LAS unsigned char* XT = B0 + 13824;
    LAS bf16* Ks = (LAS bf16*)XT;
    const bf16* P = WSP(const bf16, WS_P); const bf16* gq = WSP(const bf16, WS_GQ);
    const int u = item >> 1, d = item & 1;
    const int c = u % NCH, h = (u / NCH) & 3, b = u / (NCH * NH);
    const int n = d ? (c < 4 ? 3 - c : 71 - c) : c;
    const float aexp = __expf(C.in[I_GALOG][(l * 2 + d) * NH + h]), dtb = C.in[I_GDTB][(l * 2 + d) * NH + h];
    const int rowl = seqrow_cm(n * 64 + lane, d, b);
    const bf16* pg = P + (size_t)rowl * PLD + OFF_D + 1024 + d * 4 + h;
    const float la = -aexp * softplusf_(bf2f(pg[0]) + dtb), beta = sigmoidf_(bf2f(pg[8]));
    const float gam = wave_incl_sum(la, lane);
    if (pw == 0) { vec[lane] = beta; vec[64 + lane] = gam; }
#pragma unroll
    for (int r = 0; r < 4; ++r) { const int idx = pw * 64 + lane + 128 * r, t = idx >> 3, part = idx & 7;
        *(LAS v4u*)(Ks + t * MP + 8 * part) = *(const v4u*)(gq + (size_t)seqrow_cm(n * 64 + t, d, b) * 768 + 256 + h * 64 + 8 * part); }
    { LAS v4u* tz = (LAS v4u*)(B0 + 9216) + (pw * 64 + lane) * 2; tz[0] = (v4u){0u, 0u, 0u, 0u}; tz[1] = (v4u){0u, 0u, 0u, 0u}; }
    f32x4 acc[4][4];
    if (pw == 0) {
#pragma unroll
        for (int I = 0; I < 4; ++I)
#pragma unroll
            for (int r = 0; r < 4; ++r) { const bf16* vr = gq + (size_t)seqrow_cm(n * 64 + 16 * I + 4 * q + r, d, b) * 768 + 512 + h * 64 + l15;
#pragma unroll
                for (int nt = 0; nt < 4; ++nt) acc[I][nt][r] = bf2f(vr[16 * nt]); }
    }
    __syncthreads();
    {
        int tix = 0;
#pragma unroll
        for (int it = 0; it < 4; ++it)
#pragma unroll
            for (int jt = 0; jt < 4; ++jt, ++tix) if ((tix & 1) == pw) {
                f32x4 t4 = (f32x4){0.f, 0.f, 0.f, 0.f};
                if (jt <= it) {
#pragma unroll
                    for (int s = 0; s < 2; ++s) t4 = mfma16(ld_frag16(Ks + (16 * it + l15) * MP + 32 * s + 8 * q), ld_frag16(Ks + (16 * jt + l15) * MP + 32 * s + 8 * q), t4);
                    const float gj = vec[64 + 16 * jt + l15];
                    const f32x4 bi = *(const LAS f32x4*)(vec + 16 * it + 4 * q), gi = *(const LAS f32x4*)(vec + 64 + 16 * it + 4 * q);
#pragma unroll
                    for (int r = 0; r < 4; ++r) { const int i = 16 * it + 4 * q + r, j = 16 * jt + l15; t4[r] = (j < i) ? -(bi[r] * t4[r] * __expf(gi[r] - gj)) : 0.f; }
                }
#pragma unroll
                for (int r = 0; r < 4; ++r) Ln[(16 * it + 4 * q + r) * MP + 16 * jt + l15] = (bf16)f2bf1(t4[r]);
            }
    }
    {
#pragma unroll
        for (int I = 0; I < 4; ++I) {
            const f32x4 bi = *(const LAS f32x4*)(vec + 16 * I + 4 * q), gi = *(const LAS f32x4*)(vec + 64 + 16 * I + 4 * q);
#pragma unroll
            for (int r = 0; r < 4; ++r) { const float sc = pw ? bi[r] * __expf(gi[r]) : bi[r];
#pragma unroll
                for (int nt = 0; nt < 4; ++nt) acc[I][nt][r] = (pw ? bf2f(Ks[(16 * I + 4 * q + r) * MP + 16 * nt + l15]) : acc[I][nt][r]) * sc; }
        }
    }
    __syncthreads();
    if (pw == 0) diag_inverses(Ln, TinvP, lane);
    LAS unsigned char* XTw = XT + pw * 8192;
    { LAS v4u* xz = (LAS v4u*)(XTw + lane * 128);
#pragma unroll
        for (int g = 0; g < 8; ++g) xz[g] = (v4u){0u, 0u, 0u, 0u}; }
    __syncthreads();
    blocked_solve(Ln, TinvP, XTw, acc, l15, q);
    {
        bf16* dst = blob_row(C, d, pw, b, c, h, lane);
        const LAS unsigned char* xr = XTw + lane * 128;
#pragma unroll
        for (int g = 0; g < 8; ++g) *(v4u*)(dst + 8 * g) = *(const LAS v4u*)(xr + ((g ^ (lane & 7)) << 4));
    }
    __syncthreads();
}

template <bool DRY>
__device__ __forceinline__ void gdn_chunked(const Ctx& C, int l, int idx) {
    const int d = idx >> 5, b = (idx >> 2) & 7, h = idx & 3, lane = C.lane, w = C.wave, l15 = lane & 15, q = lane >> 4;
    const int it = w & 3, vtp = w >> 2;
    constexpr int IMG = 64 * MP * 2, BUFB = 5 * IMG + 512;
    LAS unsigned char* L0 = C.lds;
    LAS bf16* VnT = (LAS bf16*)(L0 + 2 * BUFB + 2 * IMG);
    const bf16* P = WSP(const bf16, WS_P); const bf16* gq = WSP(const bf16, WS_GQ); bf16* outd = WSP(bf16, WS_OUTD) + (size_t)d * T_ALL * 256;
    const float aexp = __expf(C.in[I_GALOG][(l * 2 + d) * NH + h]), dtb = C.in[I_GDTB][(l * 2 + d) * NH + h];
    const int tt = C.tid >> 3, part = C.tid & 7;
    for (int i = C.tid; i < 2 * IMG / 4; i += NTHR) ((LAS unsigned*)(L0 + 2 * BUFB))[i] = 0u;
    v4u rq, rk, ru, rw; unsigned short rga;
    auto gload = [&](int n) {
        const int c = d ? (n < 4 ? 3 - n : 71 - n) : n;
        const bf16* pp = gq + (size_t)seqrow_cm(n * 64 + tt, d, b) * 768 + h * 64 + 8 * part;
        rq = *(const v4u*)pp; rk = *(const v4u*)(pp + 256);
        ru = *(const v4u*)(blob_row(C, d, 0, b, c, h, tt) + 8 * part); rw = *(const v4u*)(blob_row(C, d, 1, b, c, h, tt) + 8 * part);
        rga = P[(size_t)seqrow_cm(n * 64 + lane, d, b) * PLD + OFF_D + 1024 + d * 4 + h];
    };
    auto images = [&](int bufi) {
        LAS unsigned char* B0 = L0 + bufi * BUFB;
        LAS bf16* Qs = (LAS bf16*)B0; LAS bf16* Ks = Qs + 64 * MP; LAS bf16* KdT = Ks + 64 * MP; LAS bf16* Wi = KdT + 64 * MP; LAS bf16* UT = Wi + 64 * MP; LAS float* vec = (LAS float*)(B0 + 5 * IMG);
        const float la = -aexp * softplusf_(bf2f(rga) + dtb);
        const float gam = wave_incl_sum(la, lane);
        if (w == 0) vec[lane] = gam;
        const float kd = __expf(__shfl(gam, 63) - gam);
        const float kmine = __shfl(kd, 8 * w + (lane >> 3));
        *(LAS v4u*)(Qs + tt * MP + 8 * part) = rq; *(LAS v4u*)(Ks + tt * MP + 8 * part) = rk; *(LAS v4u*)(UT + tt * MP + 8 * part) = ru;
        const unsigned kk[4] = {rk.x, rk.y, rk.z, rk.w}, ww[4] = {rw.x, rw.y, rw.z, rw.w};
#pragma unroll
        for (int e = 0; e < 4; ++e) {
            KdT[(8 * part + 2 * e) * MP + tt] = (bf16)f2bf1(bflo(kk[e]) * kmine); KdT[(8 * part + 2 * e + 1) * MP + tt] = (bf16)f2bf1(bfhi(kk[e]) * kmine);
            Wi[(8 * part + 2 * e) * MP + tt] = (bf16)(ww[e] & 0xffffu); Wi[(8 * part + 2 * e + 1) * MP + tt] = (bf16)(ww[e] >> 16);
        }
    };
    f32x4 Sst[2]; Sst[0] = Sst[1] = (f32x4){0.f, 0.f, 0.f, 0.f};
    const f32x4 z4 = (f32x4){0.f, 0.f, 0.f, 0.f};
    gload(0); images(0); gload(1);
#pragma unroll 1
    for (int n = 0; n < NCH; ++n) {
        RAW_BARRIER();
        const LAS unsigned char* B0 = L0 + (n & 1) * BUFB;
        const LAS bf16* Qs = (const LAS bf16*)B0; const LAS bf16* Ks = Qs + 64 * MP; const LAS bf16* KdT = Ks + 64 * MP; const LAS bf16* Wi = KdT + 64 * MP; const LAS bf16* UT = Wi + 64 * MP; const LAS float* vec = (const LAS float*)(B0 + 5 * IMG);
        const LAS bf16* ST = (const LAS bf16*)(L0 + 2 * BUFB + (n & 1) * IMG); LAS bf16* STn = (LAS bf16*)(L0 + 2 * BUFB + ((n + 1) & 1) * IMG);
        fragb Qf[2]; Qf[0] = ld_frag16(Qs + (16 * it + l15) * MP + 8 * q); Qf[1] = ld_frag16(Qs + (16 * it + l15) * MP + 32 + 8 * q);
        const float gcol = vec[16 * it + l15]; const int icol = 16 * it + l15;
        f32x4 pt[4];
#pragma unroll
        for (int jt = 0; jt < 4; ++jt) {
            pt[jt] = z4;
            if (jt <= it) {
                const fragb k0 = ld_frag16(Ks + (16 * jt + l15) * MP + 8 * q), k1 = ld_frag16(Ks + (16 * jt + l15) * MP + 32 + 8 * q);
                f32x4 st = mfma16(k0, Qf[0], z4); st = mfma16(k1, Qf[1], st);
                const f32x4 gj = *(const LAS f32x4*)(vec + 16 * jt + 4 * q);
#pragma unroll
                for (int r = 0; r < 4; ++r) { const int j = 16 * jt + 4 * q + r; pt[jt][r] = (j <= icol) ? st[r] * __expf(gcol - gj[r]) : 0.f; }
            }
        }
        fragb Pf[2]; Pf[0] = pack_frag(pt[0], pt[1]); Pf[1] = pack_frag(pt[2], pt[3]);
        const fragb Wf0 = ld_frag16(Wi + (16 * it + l15) * MP + 8 * q), Wf1 = ld_frag16(Wi + (16 * it + l15) * MP + 32 + 8 * q);
        f32x4 Ro[2];
#pragma unroll
        for (int v2 = 0; v2 < 2; ++v2) {
            const int vrow = 16 * (2 * vtp + v2) + l15;
            const fragb s0 = ld_frag16(ST + vrow * MP + 8 * q), s1 = ld_frag16(ST + vrow * MP + 32 + 8 * q);
            f32x4 ws = mfma16(Wf0, s0, z4); ws = mfma16(Wf1, s1, ws);
            Ro[v2] = mfma16(Qf[0], s0, z4); Ro[v2] = mfma16(Qf[1], s1, Ro[v2]);
            const v2u ur = *(const LAS v2u*)(UT + vrow * MP + 16 * it + 4 * q);
            v2u o; o.x = pk2(bflo(ur.x) - ws.x, bfhi(ur.x) - ws.y); o.y = pk2(bflo(ur.y) - ws.z, bfhi(ur.y) - ws.w);
            *(LAS v2u*)(VnT + vrow * MP + 16 * it + 4 * q) = o;
        }
        RAW_BARRIER();
        {
            const f32x4 gi = *(const LAS f32x4*)(vec + 16 * it + 4 * q);
            const float gl = __expf(vec[63]);
            const LAS bf16* kr = KdT + (16 * it + l15) * MP + 4 * q;
            const fragb kt0 = ld_frag8x2(kr, kr + 16), kt1 = ld_frag8x2(kr + 32, kr + 48);
#pragma unroll
            for (int v2 = 0; v2 < 2; ++v2) {
                const int vrow = 16 * (2 * vtp + v2) + l15;
                const LAS bf16* vr = VnT + vrow * MP + 4 * q;
                const fragb n0 = ld_frag8x2(vr, vr + 16), n1 = ld_frag8x2(vr + 32, vr + 48);
                f32x4 o = mfma16(Pf[0], n0, z4); if (it >= 2) o = mfma16(Pf[1], n1, o);
#pragma unroll
                for (int r = 0; r < 4; ++r) { const int row = seqrow_cm(n * 64 + 16 * it + 4 * q + r, d, b);
                    if (!DRY) outd[(size_t)row * 256 + h * 64 + vrow] = (bf16)f2bf1(o[r] + __expf(gi[r]) * Ro[v2][r]); }
                f32x4 ns = mfma16(kt0, n0, z4); ns = mfma16(kt1, n1, ns);
                Sst[v2] = Sst[v2] * gl + ns;
                v2u so; so.x = pk2(Sst[v2].x, Sst[v2].y); so.y = pk2(Sst[v2].z, Sst[v2].w);
                *(LAS v2u*)(STn + vrow * MP + 16 * it + 4 * q) = so;
            }
        }
        if (n + 1 < NCH) { images((n + 1) & 1); if (n + 2 < NCH) gload(n + 2); }
    }
    __syncthreads();
}
constexpr int UP = 264;
template <int CTRL> __device__ __forceinline__ float dpp_keep(float oldv, float v) { return __builtin_bit_cast(float, __builtin_amdgcn_update_dpp(__builtin_bit_cast(int, oldv), __builtin_bit_cast(int, v), CTRL, 0xF, 0xF, false)); }
template <bool REV> __device__ __forceinline__ void scan16(float& A, float& B) {
#define LRU_STEP(S) { const float Ap = dpp_keep<(REV ? 0x100 : 0x110) | S>(1.0f, A), Bp = dpp_keep<(REV ? 0x100 : 0x110) | S>(0.0f, B); B = A * Bp + B; A = A * Ap; }
    LRU_STEP(1) LRU_STEP(2) LRU_STEP(4) LRU_STEP(8)
#undef LRU_STEP
}
constexpr int UPC = 72;
__device__ __forceinline__ int lru_chunk_of(int d, int k) { return d ? (k < 4 ? 3 - k : NCH + 3 - k) : k; }
template <bool REV>
__device__ __forceinline__ void lru_tiles(const LAS bf16* Ud, int th, int mt, int lane, const fragb (&Wa)[2], const fragb (&Wx)[2], const f32x4& ba, const f32x4& bx, const f32x4& sp4,
                                          f32x4 (&Ac)[2], f32x4 (&Hl)[2], f32x4& Atot, f32x4& hend) {
    const int l15 = lane & 15, q = lane >> 4, edge = (lane & 48) | (REV ? 0 : 15);
    const f32x4 z4 = (f32x4){0.f, 0.f, 0.f, 0.f};
    f32x4 tA = z4, tB = z4;
#pragma unroll
    for (int i = 0; i < 2; ++i) {
        const int nt = REV ? 3 - (2 * th + i) : 2 * th + i;
        const LAS bf16* urow = Ud + (16 * nt + l15) * UPC;
        const fragb Uf0 = ld_frag16(urow + 8 * q), Uf1 = ld_frag16(urow + 32 + 8 * q);
        f32x4 aa = mfma16(Wa[0], Uf0, z4); aa = mfma16(Wa[1], Uf1, aa);
        f32x4 ax = mfma16(Wx[0], Uf0, z4); ax = mfma16(Wx[1], Uf1, ax);
        const v2u ur = *(const LAS v2u*)(urow + 16 * mt + 4 * q);
        const f32x4 u4 = (f32x4){bflo(ur.x), bfhi(ur.x), bflo(ur.y), bfhi(ur.y)};
        f32x4 la, iu, A, Bv;
#pragma unroll
        for (int r = 0; r < 4; ++r) { const float rg = sigmoidf_(aa[r] + ba[r]); iu[r] = sigmoidf_(ax[r] + bx[r]) * u4[r]; la[r] = -sp4[r] * rg; }
        const bool sm_ = la[0] > -0.15f && la[1] > -0.15f && la[2] > -0.15f && la[3] > -0.15f;
        if (__builtin_amdgcn_ballot_w64(!sm_) == 0ull) {
#pragma unroll
            for (int r = 0; r < 4; ++r) { const float x = la[r], p = x * (1.0f + x * (0.5f + x * (0.16666667f + x * (0.041666668f + x * (0.0083333338f + x * 0.0013888889f)))));
                A[r] = 1.0f + p; Bv[r] = __builtin_amdgcn_sqrtf(-p * (2.0f + p)) * iu[r]; }
        } else {
#pragma unroll
            for (int r = 0; r < 4; ++r) { A[r] = __expf(la[r]); Bv[r] = __builtin_amdgcn_sqrtf(-expm1f_(2.0f * la[r])) * iu[r]; }
        }
#pragma unroll
        for (int r = 0; r < 4; ++r) { float a_ = A[r], b_ = Bv[r]; scan16<REV>(a_, b_); A[r] = a_; Bv[r] = b_; }
        if (i == 0) {
            Ac[0] = A; Hl[0] = Bv;
#pragma unroll
            for (int r = 0; r < 4; ++r) { tA[r] = __shfl(A[r], edge); tB[r] = __shfl(Bv[r], edge); }
        } else {
            Ac[1] = A * tA; Hl[1] = A * tB + Bv;
#pragma unroll
            for (int r = 0; r < 4; ++r) { Atot[r] = __shfl(Ac[1][r], edge); hend[r] = __shfl(Hl[1][r], edge); }
        }
    }
}
__device__ __forceinline__ void lru_chain(const Ctx& C, int l, int id) {
    const int b = id >> 3, hd = (id >> 1) & 3, chalf = id & 1;
    const int lane = C.lane, l15 = lane & 15, q = lane >> 4;
    const int d = C.wave >> 2, mtl = (C.wave >> 1) & 1, th = C.wave & 1, mt = chalf * 2 + mtl;
    LAS bf16* U = (LAS bf16*)C.lds;
    LAS float* XCH = (LAS float*)(C.lds + 2 * 2 * 64 * UPC * 2);
    bf16* P = WSP(bf16, WS_P); bf16* LH = WSP(bf16, WS_LRUH) + (size_t)id * NSTEP * 32;
    const int cd = C.tid >> 8, cj = C.tid & 63, ctq = (C.tid >> 6) & 3;
    const float* cw = C.in[I_LCW] + (size_t)l * 4 * GW + hd * 64 + cj; const float w0 = cw[0], w1 = cw[GW], w2 = cw[2 * GW], w3 = cw[3 * GW], cb = C.in[I_LCB][l * GW + hd * 64 + cj];
    const bf16* wt = WSP(const bf16, WS_LRUWT) + (size_t)((d * 2 + 0) * 4 + hd) * 4096;
    fragb Wa[2], Wx[2];
#pragma unroll
    for (int ks = 0; ks < 2; ++ks) { Wa[ks] = *(const fragb*)(wt + (16 * mt + l15) * 64 + 32 * ks + 8 * q); Wx[ks] = *(const fragb*)(wt + 4 * 4096 + (16 * mt + l15) * 64 + 32 * ks + 8 * q); }
    const int ch0 = hd * 64 + 16 * mt + 4 * q;
    const f32x4 ba = *(const f32x4*)(C.in[I_LBA] + (l * 2 + d) * GW + ch0), bx = *(const f32x4*)(C.in[I_LBX] + (l * 2 + d) * GW + ch0), lam = *(const f32x4*)(C.in[I_LLAM] + (l * 2 + d) * GW + ch0);
    f32x4 sp4;
#pragma unroll
    for (int r = 0; r < 4; ++r) sp4[r] = 8.0f * softplusf_(-lam[r]);
    f32x4 s = (f32x4){0.f, 0.f, 0.f, 0.f};
    unsigned short xr[19];
#define LRU_LOADX(kk) do { const int c_ = lru_chunk_of(cd, (kk)); const bool ic_ = c_ < 4; const int p0_ = (ic_ ? c_ * 64 : (c_ - 4) * 64) + ctq * 16 - 2, Lp_ = ic_ ? CTXL : SEQ; \
        const bf16* xp_ = P + (size_t)(ic_ ? T_LAT + b * CTXL : b * SEQ) * PLD + hd * 64 + cj; \
        _Pragma("unroll") for (int i_ = 0; i_ < 19; ++i_) { const int p_ = p0_ + i_; xr[i_] = (p_ >= 0 && p_ < Lp_) ? xp_[(size_t)p_ * PLD] : (unsigned short)0; } } while (0)
#define LRU_CONV(kk) do { LAS bf16* uo_ = U + ((((kk) & 1) * 2 + cd) * 64 + ctq * 16) * UPC + cj; \
        _Pragma("unroll") for (int t_ = 0; t_ < 16; ++t_) uo_[t_ * UPC] = (bf16)f2bf1(w0 * bf2f(xr[t_]) + w1 * bf2f(xr[t_ + 1]) + w2 * bf2f(xr[t_ + 2]) + w3 * bf2f(xr[t_ + 3]) + cb); } while (0)
    LRU_LOADX(0); LRU_CONV(0); LRU_LOADX(1);
    __syncthreads();
#pragma unroll 1
    for (int k = 0; k < NCH; ++k) {
        if (k + 1 < NCH) { LRU_CONV(k + 1); if (k + 2 < NCH) LRU_LOADX(k + 2); }
        const int c = lru_chunk_of(d, k); const bool second = lru_chunk_of(1 - d, c) < k;
        const bool ic = c < 4; const size_t row0 = (size_t)(ic ? T_LAT + b * CTXL + c * 64 : b * SEQ + (c - 4) * 64);
        const bool late = (k == 2) || (k == 36);
        int tok[2]; v2u gv[2], fv[2];
#pragma unroll
        for (int i = 0; i < 2; ++i) { const int nt = d ? 3 - (2 * th + i) : 2 * th + i; tok[i] = 16 * nt + l15;
            if (second && !late) { gv[i] = *(const v2u*)(P + (row0 + tok[i]) * PLD + 256 + ch0); fv[i] = *(const v2u*)(LH + (size_t)(c * 64 + tok[i]) * 32 + 16 * mtl + 4 * q); } }
        f32x4 Ac[2], Hl[2], Atot, hend;
        const LAS bf16* Ud = U + ((k & 1) * 2 + d) * 64 * UPC;
        if (d) lru_tiles<true>(Ud, th, mt, lane, Wa, Wx, ba, bx, sp4, Ac, Hl, Atot, hend); else lru_tiles<false>(Ud, th, mt, lane, Wa, Wx, ba, bx, sp4, Ac, Hl, Atot, hend);
        LAS float* xw = XCH + (((((k & 1) * 2 + d) * 2 + mtl) * 2 + th) * 4 + q) * 8;
        if (l15 == (d ? 0 : 15)) { *(LAS f32x4*)xw = Atot; *(LAS f32x4*)(xw + 4) = hend; }
        if (late) VM_WAIT();
        RAW_BARRIER();
        if (second && late) {
#pragma unroll
            for (int i = 0; i < 2; ++i) { gv[i] = *(const v2u*)(P + (row0 + tok[i]) * PLD + 256 + ch0); fv[i] = *(const v2u*)(LH + (size_t)(c * 64 + tok[i]) * 32 + 16 * mtl + 4 * q); }
        }
        const LAS float* xr0 = XCH + (((((k & 1) * 2 + d) * 2 + mtl) * 2 + 0) * 4 + q) * 8;
        const f32x4 A0 = *(const LAS f32x4*)xr0, h0 = *(const LAS f32x4*)(xr0 + 4), A1 = *(const LAS f32x4*)(xr0 + 32), h1 = *(const LAS f32x4*)(xr0 + 36);
        const f32x4 mid = A0 * s + h0, hin = th ? mid : s;
        s = A1 * mid + h1;
#pragma unroll
        for (int i = 0; i < 2; ++i) {
            const f32x4 h = Ac[i] * hin + Hl[i];
            if (!second) { v2u o; o.x = pk2(h.x, h.y); o.y = pk2(h.z, h.w); *(v2u*)(LH + (size_t)(c * 64 + tok[i]) * 32 + 16 * mtl + 4 * q) = o; }
            else {
                const f32x4 g = (f32x4){bflo(gv[i].x), bfhi(gv[i].x), bflo(gv[i].y), bfhi(gv[i].y)};
                f32x4 y = (f32x4){h.x + bflo(fv[i].x), h.y + bfhi(fv[i].x), h.z + bflo(fv[i].y), h.w + bfhi(fv[i].y)};
                y.x *= gelu_tanh(g.x); y.y *= gelu_tanh(g.y); y.z *= gelu_tanh(g.z); y.w *= gelu_tanh(g.w);
                st4bf(P + (row0 + tok[i]) * PLD + 256 + ch0, y);
            }
        }
    }
#undef LRU_LOADX
#undef LRU_CONV
    __syncthreads();
}
constexpr int RP = 264;
__device__ __forceinline__ void rwkv_prep2(const Ctx& C, int l, int b, int c) {
    LAS bf16* RS = (LAS bf16*)C.lds;
    LAS bf16* KS = RS + 64 * RP;
    LAS bf16* XW = KS + 64 * RP;
    LAS bf16* XA = XW + 64 * MP;
    LAS bf16* XG = XA + 64 * MP;
    const bf16* P = WSP(const bf16, WS_P);
    const bool isctx = c < 4; const int p0 = isctx ? c * 64 : (c - 4) * 64; const int Lp = isctx ? CTXL : SEQ; const int row0 = isctx ? T_LAT + b * CTXL : b * SEQ;
    const float* mu = C.in[I_RMU] + (size_t)l * 2 * B_COLS;
    bf16* rkv = WSP(bf16, WS_RKV);
#pragma unroll 5
    for (int it = C.tid; it < 64 * 120; it += NTHR) {
        const int t = it / 120, c8 = (it % 120) * 8, p = p0 + t;
        const bf16* pp = P + (size_t)(row0 + p) * PLD + OFF_B + c8;
        const v4u xc = *(const v4u*)pp; v4u xp = (v4u){0u, 0u, 0u, 0u}, xn = xp;
        if (p > 0) xp = *(const v4u*)(pp - PLD);
        if (p < Lp - 1) xn = *(const v4u*)(pp + PLD);
        const f32x4 m0a = *(const f32x4*)(mu + c8), m0b = *(const f32x4*)(mu + c8 + 4), m1a = *(const f32x4*)(mu + B_COLS + c8), m1b = *(const f32x4*)(mu + B_COLS + c8 + 4);
        const unsigned xcw[4] = {xc.x, xc.y, xc.z, xc.w}, xpw[4] = {xp.x, xp.y, xp.z, xp.w}, xnw[4] = {xn.x, xn.y, xn.z, xn.w};
        float sh[8];
#pragma unroll
        for (int e = 0; e < 4; ++e) {
            const float x0 = bflo(xcw[e]), x1 = bfhi(xcw[e]);
            const float mu0_0 = e < 2 ? m0a[2 * e] : m0b[2 * e - 4], mu0_1 = e < 2 ? m0a[2 * e + 1] : m0b[2 * e - 3], mu1_0 = e < 2 ? m1a[2 * e] : m1b[2 * e - 4], mu1_1 = e < 2 ? m1a[2 * e + 1] : m1b[2 * e - 3];
            sh[2 * e] = x0 + mu0_0 * (bflo(xpw[e]) - x0) + mu1_0 * (bflo(xnw[e]) - x0);
            sh[2 * e + 1] = x1 + mu0_1 * (bfhi(xpw[e]) - x1) + mu1_1 * (bfhi(xnw[e]) - x1);
        }
        if (c8 >= 768) {
            const int ci = c8 - 768;
            if (ci < 64) {
#pragma unroll
                for (int e = 0; e < 8; ++e) sh[e] = tanhf_(sh[e]); }
            else if (ci >= 128) {
#pragma unroll
                for (int e = 0; e < 8; ++e) sh[e] = sigmoidf_(sh[e]); }
        }
        v4u o; o.x = pk2(sh[0], sh[1]); o.y = pk2(sh[2], sh[3]); o.z = pk2(sh[4], sh[5]); o.w = pk2(sh[6], sh[7]);
        if (c8 < 768) {
            *(v4u*)(rkv + (size_t)(row0 + p) * 768 + c8) = o;
            if (c8 < 256) *(LAS v4u*)(RS + t * RP + c8) = o; else if (c8 < 512) *(LAS v4u*)(KS + t * RP + c8 - 256) = o;
        } else {
            const int ci = c8 - 768;
            LAS bf16* dst = ci < 64 ? XW + t * MP + ci : (ci < 128 ? XA + t * MP + ci - 64 : XG + t * MP + ci - 128);
            *(LAS v4u*)dst = o;
        }
    }
    __syncthreads();
    const int lane = C.lane, w = C.wave, l15 = lane & 15, q = lane >> 4, hd = w & 3, ntp = w >> 2;
    const bf16* wt = WSP(const bf16, WS_RWT);
    bf16* wa_out = WSP(bf16, WS_HB); bf16* g_out = WSP(bf16, WS_G); float* bonus = WSP(float, WS_BONUS); float* rinv = WSP(float, WS_RINV);
    const f32x4 z4 = (f32x4){0.f, 0.f, 0.f, 0.f};
    float bsum[2] = {0.f, 0.f}, ksum[2] = {0.f, 0.f};
#pragma unroll
    for (int n2 = 0; n2 < 2; ++n2) {
        const int tok = 16 * (2 * ntp + n2) + l15; const size_t row = (size_t)(row0 + p0 + tok);
        const fragb xw0 = ld_frag16(XW + tok * MP + 8 * q), xw1 = ld_frag16(XW + tok * MP + 32 + 8 * q), xa0 = ld_frag16(XA + tok * MP + 8 * q), xa1 = ld_frag16(XA + tok * MP + 32 + 8 * q);
        const fragb xg0 = ld_frag16(XG + tok * MP + 8 * q), xg1 = ld_frag16(XG + tok * MP + 32 + 8 * q);
        unsigned ow0[8], ow1[8], oa0[8], oa1[8], og[8];
#pragma unroll
        for (int mt = 0; mt < 4; ++mt) {
            const int chl = 16 * (l15 >> 2) + 4 * mt + (l15 & 3), ch4 = hd * 64 + 16 * q + 4 * mt;
            const bf16* wrow = wt + (size_t)(hd * 64 + chl) * 32 + 8 * q;
            const bf16* grow = wt + 4 * 256 * 32 + (size_t)(hd * 64 + chl) * 64 + 8 * q;
            const fragb fw0 = *(const fragb*)(wrow), fw1 = *(const fragb*)(wrow + 256 * 32), fa0 = *(const fragb*)(wrow + 2 * 256 * 32), fa1 = *(const fragb*)(wrow + 3 * 256 * 32), fg0 = *(const fragb*)(grow), fg1 = *(const fragb*)(grow + 32);
            const f32x4 w00 = *(const f32x4*)(C.in[I_RW0] + (l * 2 + 0) * GW + ch4), w01 = *(const f32x4*)(C.in[I_RW0] + (l * 2 + 1) * GW + ch4);
            const f32x4 a00 = *(const f32x4*)(C.in[I_RA0] + (l * 2 + 0) * GW + ch4), a01 = *(const f32x4*)(C.in[I_RA0] + (l * 2 + 1) * GW + ch4);
            const f32x4 k_a = *(const f32x4*)(C.in[I_RKA] + l * GW + ch4), r_k = *(const f32x4*)(C.in[I_RRK] + l * GW + ch4), k_k = *(const f32x4*)(C.in[I_RKK] + l * GW + ch4);
            const f32x4 aw0 = mfma16(fw0, xw0, z4), aw1 = mfma16(fw1, xw1, z4), aa0 = mfma16(fa0, xa0, z4), aa1 = mfma16(fa1, xa1, z4);
            f32x4 ag = mfma16(fg0, xg0, z4); ag = mfma16(fg1, xg1, ag);
            f32x4 wv0, wv1, av0, av1;
#pragma unroll
            for (int r = 0; r < 4; ++r) {
                wv0[r] = __expf(-0.6065306597126334f * sigmoidf_(aw0[r] + w00[r])); wv1[r] = __expf(-0.6065306597126334f * sigmoidf_(aw1[r] + w01[r]));
                av0[r] = sigmoidf_(aa0[r] + a00[r]); av1[r] = sigmoidf_(aa1[r] + a01[r]);
            }
            ow0[2 * mt] = pk2(wv0[0], wv0[1]); ow0[2 * mt + 1] = pk2(wv0[2], wv0[3]); ow1[2 * mt] = pk2(wv1[0], wv1[1]); ow1[2 * mt + 1] = pk2(wv1[2], wv1[3]);
            oa0[2 * mt] = pk2(av0[0], av0[1]); oa0[2 * mt + 1] = pk2(av0[2], av0[3]); oa1[2 * mt] = pk2(av1[0], av1[1]); oa1[2 * mt + 1] = pk2(av1[2], av1[3]);
            og[2 * mt] = pk2(ag[0], ag[1]); og[2 * mt + 1] = pk2(ag[2], ag[3]);
            const v2u rr_ = *(const LAS v2u*)(RS + tok * RP + ch4), kr_ = *(const LAS v2u*)(KS + tok * RP + ch4);
            const f32x4 rs = (f32x4){bflo(rr_.x), bfhi(rr_.x), bflo(rr_.y), bfhi(rr_.y)}, ks = (f32x4){bflo(kr_.x), bfhi(kr_.x), bflo(kr_.y), bfhi(kr_.y)};
#pragma unroll
            for (int r = 0; r < 4; ++r) {
                const float km = ks[r] * (1.0f + (av0[r] - 1.0f) * k_a[r]) + ks[r] * (1.0f + (av1[r] - 1.0f) * k_a[r]);
                bsum[n2] += rs[r] * r_k[r] * km; const float kk = ks[r] * k_k[r]; ksum[n2] += kk * kk;
            }
        }
        bf16* wrow_o = wa_out + row * 1024 + hd * 64 + 16 * q;
        *(v4u*)(wrow_o) = (v4u){ow0[0], ow0[1], ow0[2], ow0[3]}; *(v4u*)(wrow_o + 8) = (v4u){ow0[4], ow0[5], ow0[6], ow0[7]};
        *(v4u*)(wrow_o + 256) = (v4u){ow1[0], ow1[1], ow1[2], ow1[3]}; *(v4u*)(wrow_o + 256 + 8) = (v4u){ow1[4], ow1[5], ow1[6], ow1[7]};
        *(v4u*)(wrow_o + 512) = (v4u){oa0[0], oa0[1], oa0[2], oa0[3]}; *(v4u*)(wrow_o + 512 + 8) = (v4u){oa0[4], oa0[5], oa0[6], oa0[7]};
        *(v4u*)(wrow_o + 768) = (v4u){oa1[0], oa1[1], oa1[2], oa1[3]}; *(v4u*)(wrow_o + 768 + 8) = (v4u){oa1[4], oa1[5], oa1[6], oa1[7]};
        bf16* grow_o = g_out + row * 256 + hd * 64 + 16 * q;
        *(v4u*)(grow_o) = (v4u){og[0], og[1], og[2], og[3]}; *(v4u*)(grow_o + 8) = (v4u){og[4], og[5], og[6], og[7]};
    }
#pragma unroll
    for (int n2 = 0; n2 < 2; ++n2) {
        const size_t row = (size_t)(row0 + p0 + 16 * (2 * ntp + n2) + l15);
        float bs = bsum[n2], ks2 = ksum[n2];
        bs += __shfl_xor(bs, 16); bs += __shfl_xor(bs, 32); ks2 += __shfl_xor(ks2, 16); ks2 += __shfl_xor(ks2, 32);
        if (q == 0) { bonus[row * 4 + hd] = bs; rinv[row * 4 + hd] = rsqrtf_(ks2 + 1e-6f); }
    }
    __syncthreads();
}
__device__ __forceinline__ int fwd_row_r(int b, int c, int t) { return c < 4 ? (T_LAT + b * CTXL + c * 64 + t) : (b * SEQ + (c - 4) * 64 + t); }
__device__ __forceinline__ bf16* rw_blob_row(const Ctx& C, int d, int which, int b, int c, int h, int r) {
    const int row = fwd_row_r(b, c, r);
#if RW_VSPLIT
    if (which == 0) { if (d) return WSP(bf16, WS_GQ) + (size_t)row * 768 + 512 + h * 64;
                      return WSP(bf16, WS_P) + (size_t)row * PLD + OFF_B + 512 + h * 64; }
#else
    if (which == 0) return WSP(bf16, WS_OUTB) + ((size_t)d * T_ALL + row) * 256 + h * 64;
#endif
    return WSP(bf16, WS_P) + (size_t)row * PLD + OFF_B + d * 256 + h * 64;
}
__device__ __forceinline__ void rwkv_solve_item(const Ctx& C, int l, int item) {
    const int lane = C.lane, w = C.wave, pw = w & 1, pi = w >> 1, l15 = lane & 15, q = lane >> 4;
    LAS unsigned char* B0 = C.lds + pi * 31744;
    LAS bf16* Kk = (LAS bf16*)B0; LAS bf16* Bh = Kk + 64 * MP; LAS bf16* Kh = Bh + 64 * MP;
    LAS bf16* Ln = (LAS bf16*)B0;
    LAS bf16* Lk16 = (LAS bf16*)(B0 + 9216);
    LAS unsigned char* XT = B0 + 9216;
    LAS bf16* TinvP = (LAS bf16*)(B0 + 25600);
    const bf16* WA = WSP(const bf16, WS_HB); bf16* WAw = WSP(bf16, WS_HB); const bf16* rkv = WSP(const bf16, WS_RKV); const float* rinv = WSP(const float, WS_RINV);
    const int u = item >> 1, d = item & 1;
    const int c = u % NCH, h = (u / NCH) & 3, b = u / (NCH * NH);
    const float k_k = C.in[I_RKK][l * GW + h * 64 + lane], k_a = C.in[I_RKA][l * GW + h * 64 + lane];
    const int n = d ? (c < 4 ? 3 - c : 71 - c) : c;
    const float ril = rinv[(size_t)seqrow_raster(n * 64 + lane, d, b) * 4 + h];
#pragma unroll
    for (int r = 0; r < 4; ++r) { const int idx2 = pw * 64 + lane + 128 * r, t = idx2 >> 3, part = idx2 & 7; const int row = seqrow_raster(n * 64 + t, d, b);
        *(LAS v4u*)(Kk + t * MP + 8 * part) = *(const v4u*)(WA + (size_t)row * 1024 + d * 256 + h * 64 + 8 * part);
        *(LAS v4u*)(Bh + t * MP + 8 * part) = *(const v4u*)(WA + (size_t)row * 1024 + (2 + d) * 256 + h * 64 + 8 * part);
        *(LAS v4u*)(Kh + t * MP + 8 * part) = *(const v4u*)(rkv + (size_t)row * 768 + 256 + h * 64 + 8 * part); }
    __syncthreads();
    {
        float cc = 1.0f;
        if (pw) {
#pragma unroll
            for (int t = 0; t < 32; ++t) cc *= bf2f(Kk[t * MP + lane]);
        }
        __syncthreads();
#pragma unroll
        for (int t2 = 0; t2 < 32; ++t2) {
            const int t = pw * 32 + t2;
            const float wv = bf2f(Kk[t * MP + lane]), av = bf2f(Bh[t * MP + lane]), ks = bf2f(Kh[t * MP + lane]);
            const float kap = ks * k_k * __shfl(ril, t);
            const float cprev = cc; cc *= wv; const float ic = __builtin_amdgcn_rcpf(cc);
            Kk[t * MP + lane] = (bf16)f2bf1(kap * cprev); Bh[t * MP + lane] = (bf16)f2bf1(kap * av * ic); Kh[t * MP + lane] = (bf16)f2bf1(ks * (1.0f + (av - 1.0f) * k_a) * ic);
            WAw[(size_t)seqrow_raster(n * 64 + t, d, b) * 1024 + d * 256 + h * 64 + lane] = (bf16)f2bf1(cc);
        }
    }
    __syncthreads();
    f32x4 acc[4][4];
    if (pw == 0) {
#pragma unroll
        for (int I = 0; I < 4; ++I)
#pragma unroll
            for (int r = 0; r < 4; ++r)
#pragma unroll
                for (int nt = 0; nt < 4; ++nt) acc[I][nt][r] = bf2f(Kk[(16 * I + 4 * q + r) * MP + 16 * nt + l15]);
    }
    f32x4 T[10];
    {
        const LAS bf16* Bsrc = pw ? Kh : Bh;
        int tix = 0;
#pragma unroll
        for (int it = 0; it < 4; ++it)
#pragma unroll
            for (int jt = 0; jt <= it; ++jt, ++tix) {
                f32x4 t4 = (f32x4){0.f, 0.f, 0.f, 0.f};
#pragma unroll
                for (int s = 0; s < 2; ++s) t4 = mfma16(ld_frag16(Kk + (16 * it + l15) * MP + 32 * s + 8 * q), ld_frag16(Bsrc + (16 * jt + l15) * MP + 32 * s + 8 * q), t4);
#pragma unroll
                for (int r = 0; r < 4; ++r) { const int i = 16 * it + 4 * q + r, j = 16 * jt + l15; T[tix][r] = (j < i) ? (pw ? t4[r] : -t4[r]) : 0.f; }
            }
    }
    __syncthreads();
    {
        int tix = 0;
#pragma unroll
        for (int it = 0; it < 4; ++it)
#pragma unroll
            for (int jt = 0; jt < 4; ++jt) {
                if (jt <= it) {
#pragma unroll
                    for (int r = 0; r < 4; ++r) (pw ? Lk16 : Ln)[(16 * it + 4 * q + r) * MP + 16 * jt + l15] = (bf16)f2bf1(T[tix][r]);
                    ++tix;
                } else if (pw == 0) {
#pragma unroll
                    for (int r = 0; r < 4; ++r) Ln[(16 * it + 4 * q + r) * MP + 16 * jt + l15] = (bf16)0;
                }
            }
        LAS v4u* tz = (LAS v4u*)(B0 + 25600) + (pw * 64 + lane) * 2; tz[0] = (v4u){0u, 0u, 0u, 0u}; tz[1] = (v4u){0u, 0u, 0u, 0u};
    }
    __syncthreads();
    if (pw) {
#pragma unroll
        for (int I = 0; I < 4; ++I)
#pragma unroll
            for (int r = 0; r < 4; ++r)
#pragma unroll
                for (int nt = 0; nt < 4; ++nt) { const int i = 16 * I + 4 * q + r, j = 16 * nt + l15; acc[I][nt][r] = (j < i && nt <= I) ? bf2f(Lk16[i * MP + j]) : 0.f; }
    } else diag_inverses(Ln, TinvP, lane);
    __syncthreads();
    LAS unsigned char* XTw = XT + pw * 8192;
    { LAS v4u* xz = (LAS v4u*)(XTw + lane * 128);
#pragma unroll
        for (int g = 0; g < 8; ++g) xz[g] = (v4u){0u, 0u, 0u, 0u}; }
    blocked_solve(Ln, TinvP, XTw, acc, l15, q);
    {
        bf16* dst = rw_blob_row(C, d, pw, b, c, h, lane);
        const LAS unsigned char* xr = XTw + lane * 128;
#pragma unroll
        for (int g = 0; g < 8; ++g) *(v4u*)(dst + 8 * g) = *(const LAS v4u*)(xr + ((g ^ (lane & 7)) << 4));
    }
    __syncthreads();
}

template <bool DRY>
__device__ __forceinline__ void rwkv_chunked(const Ctx& C, int l, int idx) {
#ifndef RW_VSPLIT
#define RW_VSPLIT 1
#endif
    constexpr int NV = RW_VSPLIT ? 1 : 2;
    const int vhalf = idx & 1, lane = C.lane, w = C.wave, l15 = lane & 15, q = lane >> 4;
    const int d = RW_VSPLIT ? idx >> 6 : idx >> 5, b = RW_VSPLIT ? (idx >> 3) & 7 : (idx >> 2) & 7, h = RW_VSPLIT ? (idx >> 1) & 3 : idx & 3;
    const int it = w & 3, vt0 = RW_VSPLIT ? 2 * vhalf + (w >> 2) : 2 * (w >> 2);
    constexpr int IMG = 64 * MP * 2;
    LAS unsigned char* L0 = C.lds;
    LAS bf16* Wi = (LAS bf16*)L0; LAS bf16* Ti = Wi + 64 * MP; LAS bf16* Rh = Ti + 64 * MP; LAS bf16* Kh = Rh + 64 * MP; LAS bf16* Bh = Kh + 64 * MP;
    LAS bf16* UT = (LAS bf16*)(L0 + 11 * IMG);
    LAS float* cLv = (LAS float*)(L0 + 14 * IMG);
    const bf16* WA = WSP(const bf16, WS_HB); const bf16* rkv = WSP(const bf16, WS_RKV); const float* rinv = WSP(const float, WS_RINV);
    bf16* outb = WSP(bf16, WS_OUTB) + (size_t)d * T_ALL * 256;
    const int tt = C.tid >> 3, part = C.tid & 7;
    for (int i = C.tid; i < 2 * IMG / 4; i += NTHR) ((LAS unsigned*)(L0 + 12 * IMG))[i] = 0u;
    float kkw[8], kaw[8];
#pragma unroll
    for (int e = 0; e < 8; ++e) { kkw[e] = C.in[I_RKK][l * GW + h * 64 + 8 * w + e]; kaw[e] = C.in[I_RKA][l * GW + h * 64 + 8 * w + e]; }
    v4u gr, gk, gv, gw, ga, gbw, gbt; float gri;
    auto gload = [&](int n) {
        const int c = d ? (n < 4 ? 3 - n : 71 - n) : n;
        const int row = seqrow_raster(n * 64 + lane, d, b);
        const bf16* pr = rkv + (size_t)row * 768 + h * 64 + 8 * w;
        gr = *(const v4u*)pr; gk = *(const v4u*)(pr + 256); gv = *(const v4u*)(pr + 512);
        gw = *(const v4u*)(WA + (size_t)row * 1024 + d * 256 + h * 64 + 8 * w); ga = *(const v4u*)(WA + (size_t)row * 1024 + (2 + d) * 256 + h * 64 + 8 * w);
        gri = rinv[(size_t)row * 4 + h];
        gbw = *(const v4u*)(rw_blob_row(C, d, 0, b, c, h, tt) + 8 * part); gbt = *(const v4u*)(rw_blob_row(C, d, 1, b, c, h, tt) + 8 * part);
    };
    auto images = [&](int bufi) {
        LAS bf16* VT = (LAS bf16*)(L0 + (5 + 3 * bufi) * IMG); LAS bf16* KcT = VT + 64 * MP; LAS bf16* BcT = KcT + 64 * MP;
        const unsigned rw_[4] = {gr.x, gr.y, gr.z, gr.w}, kw_[4] = {gk.x, gk.y, gk.z, gk.w}, vw_[4] = {gv.x, gv.y, gv.z, gv.w}, ww_[4] = {gw.x, gw.y, gw.z, gw.w}, aw_[4] = {ga.x, ga.y, ga.z, ga.w};
        float rh[8], kh[8], bh[8];
#pragma unroll
        for (int e = 0; e < 8; ++e) {
            const float rs = (e & 1) ? bfhi(rw_[e >> 1]) : bflo(rw_[e >> 1]), ks = (e & 1) ? bfhi(kw_[e >> 1]) : bflo(kw_[e >> 1]);
            const float wv = (e & 1) ? bfhi(ww_[e >> 1]) : bflo(ww_[e >> 1]), av = (e & 1) ? bfhi(aw_[e >> 1]) : bflo(aw_[e >> 1]);
            const float kap = ks * kkw[e] * gri, ktil = ks * (1.0f + (av - 1.0f) * kaw[e]);
            const float cf = wv, icf = __builtin_amdgcn_rcpf(cf), cfL = __builtin_bit_cast(float, __builtin_amdgcn_readlane(__builtin_bit_cast(int, cf), 63)), dec = cfL * icf;
            rh[e] = rs * cf; kh[e] = ktil * icf; bh[e] = kap * av * icf;
            const unsigned short vraw = (e & 1) ? (unsigned short)(vw_[e >> 1] >> 16) : (unsigned short)(vw_[e >> 1] & 0xffffu);
            VT[(8 * w + e) * MP + lane] = vraw; KcT[(8 * w + e) * MP + lane] = (bf16)f2bf1(ktil * dec); BcT[(8 * w + e) * MP + lane] = (bf16)f2bf1(-(kap * av * dec));
            if (lane == 63) cLv[bufi * 64 + 8 * w + e] = cfL;
        }
        { v4u o; o.x = pk2(rh[0], rh[1]); o.y = pk2(rh[2], rh[3]); o.z = pk2(rh[4], rh[5]); o.w = pk2(rh[6], rh[7]); *(LAS v4u*)(Rh + lane * MP + 8 * w) = o; }
        { v4u o; o.x = pk2(kh[0], kh[1]); o.y = pk2(kh[2], kh[3]); o.z = pk2(kh[4], kh[5]); o.w = pk2(kh[6], kh[7]); *(LAS v4u*)(Kh + lane * MP + 8 * w) = o; }
        { v4u o; o.x = pk2(bh[0], bh[1]); o.y = pk2(bh[2], bh[3]); o.z = pk2(bh[4], bh[5]); o.w = pk2(bh[6], bh[7]); *(LAS v4u*)(Bh + lane * MP + 8 * w) = o; }
        const unsigned bw_[4] = {gbw.x, gbw.y, gbw.z, gbw.w}, bt_[4] = {gbt.x, gbt.y, gbt.z, gbt.w};
#pragma unroll
        for (int e = 0; e < 4; ++e) {
            Wi[(8 * part + 2 * e) * MP + tt] = (bf16)(bw_[e] & 0xffffu); Wi[(8 * part + 2 * e + 1) * MP + tt] = (bf16)(bw_[e] >> 16);
            Ti[(8 * part + 2 * e) * MP + tt] = (bf16)(bt_[e] & 0xffffu); Ti[(8 * part + 2 * e + 1) * MP + tt] = (bf16)(bt_[e] >> 16);
        }
    };
    f32x4 Zst[NV];
#pragma unroll
    for (int v2 = 0; v2 < NV; ++v2) Zst[v2] = (f32x4){0.f, 0.f, 0.f, 0.f};
    const f32x4 z4 = (f32x4){0.f, 0.f, 0.f, 0.f};
    gload(0); images(0); gload(1);
#pragma unroll 1
    for (int n = 0; n < NCH; ++n) {
        RAW_BARRIER();
        const LAS bf16* VT = (const LAS bf16*)(L0 + (5 + 3 * (n & 1)) * IMG); const LAS bf16* KcT = VT + 64 * MP; const LAS bf16* BcT = KcT + 64 * MP;
        const LAS bf16* Zi = (const LAS bf16*)(L0 + (12 + (n & 1)) * IMG); LAS bf16* Zn = (LAS bf16*)(L0 + (12 + ((n + 1) & 1)) * IMG);
        const int arow = (16 * it + l15) * MP + 8 * q;
        const fragb Wf0 = ld_frag16(Wi + arow), Wf1 = ld_frag16(Wi + arow + 32), Tf0 = ld_frag16(Ti + arow), Tf1 = ld_frag16(Ti + arow + 32), Rf0 = ld_frag16(Rh + arow), Rf1 = ld_frag16(Rh + arow + 32);
        const int icol = 16 * it + l15;
        f32x4 pk[4], pb[4];
#pragma unroll
        for (int jt = 0; jt < 4; ++jt) {
            pk[jt] = z4; pb[jt] = z4;
            if (jt <= it) {
                const int jrow = (16 * jt + l15) * MP + 8 * q;
                f32x4 sk = mfma16(ld_frag16(Kh + jrow), Rf0, z4); sk = mfma16(ld_frag16(Kh + jrow + 32), Rf1, sk);
                f32x4 sb = mfma16(ld_frag16(Bh + jrow), Rf0, z4); sb = mfma16(ld_frag16(Bh + jrow + 32), Rf1, sb);
#pragma unroll
                for (int r = 0; r < 4; ++r) { const int j = 16 * jt + 4 * q + r; pk[jt][r] = (j <= icol) ? sk[r] : 0.f; pb[jt][r] = (j <= icol) ? -sb[r] : 0.f; }
            }
        }
        fragb Pk0 = pack_frag(pk[0], pk[1]), Pk1 = pack_frag(pk[2], pk[3]), Pb0 = pack_frag(pb[0], pb[1]), Pb1 = pack_frag(pb[2], pb[3]);
        f32x4 RZ[NV];
#pragma unroll
        for (int v2 = 0; v2 < NV; ++v2) {
            const int vrow = 16 * (vt0 + v2) + l15;
            const fragb z0 = ld_frag16(Zi + vrow * MP + 8 * q), z1 = ld_frag16(Zi + vrow * MP + 32 + 8 * q);
            f32x4 u = mfma16(Wf0, z0, z4); u = mfma16(Wf1, z1, u);
            u = mfma16(Tf0, ld_frag16(VT + vrow * MP + 8 * q), u); if (it >= 2) u = mfma16(Tf1, ld_frag16(VT + vrow * MP + 32 + 8 * q), u);
            RZ[v2] = mfma16(Rf0, z0, z4); RZ[v2] = mfma16(Rf1, z1, RZ[v2]);
            v2u o; o.x = pk2(u.x, u.y); o.y = pk2(u.z, u.w);
            *(LAS v2u*)(UT + vrow * MP + 16 * it + 4 * q) = o;
        }
        RAW_BARRIER();
        {
            const f32x4 cl4 = *(const LAS f32x4*)(cLv + (n & 1) * 64 + 16 * it + 4 * q);
            const LAS bf16* kr = KcT + (16 * it + l15) * MP + 4 * q; const LAS bf16* br = BcT + (16 * it + l15) * MP + 4 * q;
            const fragb kc0 = ld_frag8x2(kr, kr + 16), kc1 = ld_frag8x2(kr + 32, kr + 48), bc0 = ld_frag8x2(br, br + 16), bc1 = ld_frag8x2(br + 32, br + 48);
#pragma unroll
            for (int v2 = 0; v2 < NV; ++v2) {
                const int vrow = 16 * (vt0 + v2) + l15;
                const LAS bf16* vr = VT + vrow * MP + 4 * q; const LAS bf16* ur = UT + vrow * MP + 4 * q;
                const fragb vp0 = ld_frag8x2(vr, vr + 16), vp1 = ld_frag8x2(vr + 32, vr + 48), up0 = ld_frag8x2(ur, ur + 16), up1 = ld_frag8x2(ur + 32, ur + 48);
                f32x4 y = mfma16(Pk0, vp0, RZ[v2]); y = mfma16(Pb0, up0, y);
                if (it >= 2) { y = mfma16(Pk1, vp1, y); y = mfma16(Pb1, up1, y); }
#pragma unroll
                for (int r = 0; r < 4; ++r) { const int row = seqrow_raster(n * 64 + 16 * it + 4 * q + r, d, b); if (!DRY) outb[(size_t)row * 256 + h * 64 + vrow] = (bf16)f2bf1(y[r]); }
                f32x4 zn = mfma16(kc0, vp0, z4); zn = mfma16(kc1, vp1, zn); zn = mfma16(bc0, up0, zn); zn = mfma16(bc1, up1, zn);
                Zst[v2] = Zst[v2] * cl4 + zn;
                v2u so; so.x = pk2(Zst[v2].x, Zst[v2].y); so.y = pk2(Zst[v2].z, Zst[v2].w);
                *(LAS v2u*)(Zn + vrow * MP + 16 * it + 4 * q) = so;
            }
        }
        if (n + 1 < NCH) { images((n + 1) & 1); if (n + 2 < NCH) gload(n + 2); }
    }
    __syncthreads();
}
__device__ __forceinline__ void moe_scatter(const Ctx& C, int moe_li, int nrows) {
    const unsigned* gc = WSP(const unsigned, WS_CTL) + CW_MOECNT + 64 * moe_li;
    LAS int* pst = (LAS int*)C.lds;
    {
        int pe[8]; int acc = 0;
#pragma unroll
        for (int e = 0; e < NE; ++e) { const int blks = ((int)gc[e] + 255) >> 8; if (C.tid == e) pst[e] = acc * 256; acc += blks; pe[e] = acc; }
        if (C.wg == 0 && C.tid < MOE_MAXBLK) { int be = 0;
#pragma unroll
            for (int e = 0; e < NE; ++e) be += (pe[e] <= C.tid) ? 1 : 0;
            int* tab = WSP(int, WS_TAB); tab[1 + C.tid] = be < NE ? be : NE - 1; if (C.tid == 0) tab[0] = acc; }
    }
    __syncthreads();
    const unsigned* route = WSP(const unsigned, WS_ROUTE); const unsigned* wgbase = WSP(const unsigned, WS_WGBASE);
    int* pos = WSP(int, WS_POS); int* tok = WSP(int, WS_TOK);
    if (C.wg < NE) { const int cnt = (int)gc[C.wg], s0 = pst[C.wg] + cnt, s1 = pst[C.wg] + (((cnt + 255) >> 8) << 8);
        for (int j = s0 + C.tid; j < s1; j += NTHR) tok[j] = 0; }
    const int m = C.wg * NWAVES + C.wave + C.lane * (C.G * NWAVES);
    if (m < nrows) {
        const v4u a = *(const v4u*)(route + (size_t)m * 8);
        const int e0 = (int)a.x, e1 = (int)a.y;
        const int p0 = pst[e0] + (int)wgbase[C.wg * 8 + e0] + (int)a.z, p1 = pst[e1] + (int)wgbase[C.wg * 8 + e1] + (int)a.w;
        pos[(size_t)m * 2] = p0; pos[(size_t)m * 2 + 1] = p1; tok[p0] = m; tok[p1] = m;
    }
    __syncthreads();
}
template <int NEXT>
__device__ __forceinline__ void moe_combine(const Ctx& C, int l, int nrows) {
    const unsigned* route = WSP(const unsigned, WS_ROUTE); const int* pos = WSP(const int, WS_POS); const bf16* ym = WSP(const bf16, WS_MIX);
    const float* modv = WSP(const float, WS_MODV) + (size_t)l * 9 * 6144 + 5 * 1024;
    const float* modn = WSP(const float, WS_MODV) + (size_t)(l + 1) * 9 * 6144;
    float* xc = WSP(float, WS_XC); bf16* hb = WSP(bf16, WS_HB);
    bf16* xlb = NEXT == 2 ? WSP(bf16, WS_XLAST) : (bf16*)C.out;
    const int gw = C.wg * NWAVES + C.wave, NGW = C.G * NWAVES;
    f32x4 gn[4];
#pragma unroll
    for (int j = 0; j < 4; ++j) gn[j] = *(const f32x4*)((NEXT == 2 ? C.in[I_FNG] : C.in[I_NMIXG] + (NEXT == 1 ? (l + 1) * 1024 : 0)) + 4 * C.lane + 256 * j);
    int p0n = 0, p1n = 0; float w0n = 0.f, w1n = 0.f;
    v4u xa[4]; v2u ya[4], yb[4]; float w0c = 0.f, w1c = 0.f;
#define MC_POS(mm, P0, P1, W0, W1) do { const int m_ = (mm); P0 = pos[(size_t)m_ * 2]; P1 = pos[(size_t)m_ * 2 + 1]; W0 = __builtin_bit_cast(float, route[(size_t)m_ * 8 + 4]); W1 = __builtin_bit_cast(float, route[(size_t)m_ * 8 + 5]); } while (0)
#define MC_RAW(mm, P0, P1) do { const int m_ = (mm); const bool ic_ = m_ >= T_LAT; \
        _Pragma("unroll") for (int j = 0; j < 4; ++j) { const int col = 4 * C.lane + 256 * j; \
            ya[j] = *(const v2u*)(ym + (size_t)(P0) * 1024 + col); yb[j] = *(const v2u*)(ym + (size_t)(P1) * 1024 + col); \
            if (ic_) xa[j] = *(const v4u*)(xc + (size_t)(m_ - T_LAT) * 1024 + col); else { const v2u t_ = *(const v2u*)(xlb + (size_t)m_ * 1024 + col); xa[j] = (v4u){t_.x, t_.y, 0u, 0u}; } } } while (0)
    if (gw < nrows) { int p0, p1; MC_POS(gw, p0, p1, w0c, w1c); if (gw + NGW < nrows) MC_POS(gw + NGW, p0n, p1n, w0n, w1n); MC_RAW(gw, p0, p1); }
    for (int m = gw; m < nrows; m += NGW) {
        const bool isctx = m >= T_LAT;
        float* xr = isctx ? xc + (size_t)(m - T_LAT) * 1024 : C.out + (size_t)m * 1024; bf16* xrb = xlb + (size_t)m * 1024;
        const int mrow = isctx ? 8 : (m >> 12);
        const float* gv = modv + (size_t)mrow * 6144;
        v4u xq[4]; v2u yq0[4], yq1[4]; const float w0 = w0c, w1 = w1c;
#pragma unroll
        for (int j = 0; j < 4; ++j) { xq[j] = xa[j]; yq0[j] = ya[j]; yq1[j] = yb[j]; }
        const int p0u = p0n, p1u = p1n; w0c = w0n; w1c = w1n;
        if (m + 2 * NGW < nrows) MC_POS(m + 2 * NGW, p0n, p1n, w0n, w1n);
        if (m + NGW < nrows) MC_RAW(m + NGW, p0u, p1u);
        f32x4 x[4]; float ss = 0.f;
#pragma unroll
        for (int j = 0; j < 4; ++j) {
            const int col = 4 * C.lane + 256 * j;
            const f32x4 ya4 = (f32x4){bflo(yq0[j].x), bfhi(yq0[j].x), bflo(yq0[j].y), bfhi(yq0[j].y)}, yb4 = (f32x4){bflo(yq1[j].x), bfhi(yq1[j].x), bflo(yq1[j].y), bfhi(yq1[j].y)};
            const f32x4 g = *(const f32x4*)(gv + col);
            const f32x4 xo = isctx ? __builtin_bit_cast(f32x4, xq[j]) : (f32x4){bflo(xq[j].x), bfhi(xq[j].x), bflo(xq[j].y), bfhi(xq[j].y)};
            x[j] = xo + g * (ya4 * w0 + yb4 * w1);
            if (NEXT != 2) { if (isctx) *(f32x4*)(xr + col) = x[j]; else st4bf(xrb + col, x[j]); }
            ss += (x[j].x * x[j].x + x[j].y * x[j].y) + (x[j].z * x[j].z + x[j].w * x[j].w);
        }
        if (NEXT != 0) {
            const float rs = rsqrtf_(wave_sum(ss) * (1.0f / 1024.0f) + 1e-6f);
#pragma unroll
            for (int j = 0; j < 4; ++j) {
                const int col = 4 * C.lane + 256 * j;
                if (NEXT == 2) *(f32x4*)(xr + col) = x[j] * rs * gn[j];
                else { const f32x4 sh = *(const f32x4*)(modn + (size_t)mrow * 6144 + col), scl = *(const f32x4*)(modn + (size_t)mrow * 6144 + 1024 + col);
                    st4bf(hb + (size_t)m * 1024 + col, (x[j] * rs * gn[j]) * (scl + 1.0f) + sh); }
            }
        }
    }
#undef MC_POS
#undef MC_RAW
}
__device__ __forceinline__ void final_norm(const Ctx& C) {
    const int gw = C.wg * NWAVES + C.wave, NGW = C.G * NWAVES;
    f32x4 gv[4];
#pragma unroll
    for (int j = 0; j < 4; ++j) gv[j] = *(const f32x4*)(C.in[I_FNG] + 4 * C.lane + 256 * j);
    for (int m = gw; m < T_LAT; m += NGW) {
        float* xr = C.out + (size_t)m * 1024;
        f32x4 v[4]; float s = 0.f;
#pragma unroll
        for (int j = 0; j < 4; ++j) { v[j] = *(const f32x4*)(xr + 4 * C.lane + 256 * j); s += (v[j].x * v[j].x + v[j].y * v[j].y) + (v[j].z * v[j].z + v[j].w * v[j].w); }
        const float rs = rsqrtf_(wave_sum(s) * (1.0f / 1024.0f) + 1e-6f);
#pragma unroll
        for (int j = 0; j < 4; ++j) *(f32x4*)(xr + 4 * C.lane + 256 * j) = v[j] * rs * gv[j];
    }
}

constexpr int NPH_L = 13, PH_FINAL = 1 + DEPTH * NPH_L, NPHASE = PH_FINAL + 1;
__host__ __device__ inline bool phase_exists(int ph) {
    if (ph == 0) return true;
    if (ph == PH_FINAL) return false;
    const int l = (ph - 1) / NPH_L, k = (ph - 1) % NPH_L;
    if (l >= 2 && !(l & 1) && k == 0) return false;
    if (!(l & 1) && k >= 11) return false;
    if (!RW_VSPLIT && k == 4) return false;
    return true;
}
#ifndef PH_MASK
#define PH_MASK 0xFFFFFF
#endif
#define PM(k) ((PH_MASK >> (k)) & 1)
#ifndef SK_MASK
#define SK_MASK 0xFFFF
#endif
#define SK(k) ((SK_MASK >> (k)) & 1)
#ifndef REP_MASK
#define REP_MASK 0
#endif
#define NREP(k) (((REP_MASK >> (k)) & 1) ? 2 : 1)

__global__ void __launch_bounds__(NTHR, 2) fwd_kernel(Args args) {
    extern __shared__ __attribute__((aligned(16))) unsigned char lds_raw[];
    Ctx C; C.in = args.in; C.out = args.out; C.ws = args.ws; C.lds = (LAS unsigned char*)lds_raw;
    C.tid = threadIdx.x; C.lane = C.tid & 63; C.wave = __builtin_amdgcn_readfirstlane(C.tid >> 6); C.G = gridDim.x; C.wg = blockIdx.x;
    volatile LAS unsigned* MISC = (volatile LAS unsigned*)(C.lds + MISC_OFF);
    if (C.tid < 64) MISC[C.tid] = 0u;
    __syncthreads();
    const int lo = args.ph_lo, hi = args.ph_hi;
    const bool multi = (hi - lo) > 1;
    if (multi) (void)xcd_barrier_post(WSP(unsigned, WS_CTL) + CW_BAR, MISC + 8);
#define IN(k) (lo <= (k) && (k) < hi)
#define SEAM(k) do { if (IN((k) + 1)) { XcdBarrier b2_; b2_.bar = WSP(unsigned, WS_CTL) + CW_BAR; b2_.x = xb_xcc_id(); b2_.st = (volatile LAS unsigned*)(C.lds + MISC_OFF) + 8; xcd_barrier(b2_); } } while (0)
#define FRESH() do { int t_ = threadIdx.x; asm volatile("" : "+v"(t_)); C.tid = t_; C.lane = t_ & 63; C.wave = __builtin_amdgcn_readfirstlane(t_ >> 6); } while (0)
#define PHASE(bit, k) if (PM(bit) && IN(pb + (k))) for (int rep_ = 0; rep_ < NREP(bit); ++rep_)
#define CLAIM(qh, var) __syncthreads(); if (C.tid == 0) *qslot = atomicAdd((qh), 1u); __syncthreads(); const int var = (int)*qslot;

    LAS unsigned* qslot = (LAS unsigned*)(C.lds + MISC_OFF + 128);
    constexpr int NCSL = 512;
#define CONV_QUEUES(maxn) do { int n_ = 0; \
        if (l > 0) for (; n_ < (maxn); ++n_) { FRESH(); CLAIM(qbase + 192, u0) if (u0 >= NCSL) break; FRESH(); convert_items(C, l, 2, u0 * NWAVES + C.wave, NCSL * NWAVES); } \
        if (l + 1 < DEPTH) for (; n_ < (maxn); ++n_) { FRESH(); CLAIM(qbase + 224, u0) if (u0 >= NCSL) break; FRESH(); convert_items(C, l + 1, 1, u0 * NWAVES + C.wave, NCSL * NWAVES); } } while (0)
    if (PM(20) && IN(0)) { phase_pre(C);
        for (;;) { FRESH(); CLAIM(WSP(unsigned, WS_CTL) + CW_PREPQ + 240, u0) if (u0 >= NCSL) break; FRESH(); convert_items(C, 0, 3, u0 * NWAVES + C.wave, NCSL * NWAVES); }
        SEAM(0); }

#pragma unroll 1
    for (int l = 0; l < DEPTH; ++l) {
        const int pb = 1 + l * NPH_L;
        if (hi <= pb || lo >= pb + NPH_L) continue;
        const bool last = (l == DEPTH - 1), moe = (l & 1);
        const int nrows = last ? T_LAT : T_ALL;
        const void* xlat = (l == 0) ? (const void*)C.in[I_X] : (const void*)C.out; const bool xbf = l > 0; void* xmid = last ? (void*)WSP(bf16, WS_XLAST) : (void*)C.out;
        const float* xctx = (l == 0) ? C.in[I_CTX] : WSP(const float, WS_XC);
        const float* modv = WSP(const float, WS_MODV) + (size_t)l * 9 * 6144;
        unsigned* qbase = WSP(unsigned, WS_CTL) + CW_PREPQ + 256 * l;

        if (!(l >= 2 && !(l & 1))) PHASE(0, 0) { FRESH();
            convert_small(C, l);
            __syncthreads();
            FRESH(); norm_rows<false>(C, l, xlat, xbf, xctx, C.in[I_NMIXG] + l * 1024, 0, 1024, T_ALL, 0);
            SEAM(pb + 0);
        }
        PHASE(1, 1) { FRESH();
            pg8::Gemm g{WSP(const bf16, WS_HB), WSP(const bf16, WS_WIN), T_ALL, PLD, 1024, 0};
            const int gG = (l > 0) ? C.G - 16 : C.G;
            if (C.wg < gG) {
                pg8::StaticOrder S; S.init(T_ALL, PLD, gG, C.wg);
                pg8::EpiBf16<0> E{WSP(bf16, WS_P), PLD, nullptr, 0, 0};
                pg8::gemm_phase<pg8::EpiBf16<0>, pg8::StaticOrder, false>(C.lds, g, S, E, nullptr);
                if (l > 0 && C.tid == 0) (void)xb_add(qbase + 176, 1u);
            } else {
                for (;;) { FRESH(); __syncthreads(); if (C.tid == 0) *qslot = xb_ld(qbase + 176); __syncthreads(); const unsigned fin_ = *qslot; if (fin_ != 0u) break;
                    CLAIM(qbase + 192, u0) if (u0 >= NCSL) break; FRESH(); convert_items(C, l, 2, u0 * NWAVES + C.wave, NCSL * NWAVES); }
            }
            SEAM(pb + 1);
        }
        if (PM(2) && IN(pb + 2)) for (int rep_ = 0; rep_ < NREP(2); ++rep_) { FRESH();
            for (;;) {
                CLAIM(qbase + 16 * rep_, k)
                if (k >= 2 * NB * NCH) break;
                const int kind = k / (NB * NCH), u = k % (NB * NCH);
                FRESH();
                if (kind == 0) { for (int r3_ = 0; r3_ < NREP(24); ++r3_) { FRESH(); if (SK(1)) rwkv_prep2(C, l, u / NCH, u % NCH); } }
                else { for (int r3_ = 0; r3_ < NREP(26); ++r3_) { FRESH(); if (SK(2)) gdn_prep(C, l, u / NCH, u % NCH); } }
            }
            SEAM(pb + 2);
        }
        if (PM(3) && IN(pb + 3)) for (int rep_ = 0; rep_ < NREP(3); ++rep_) { FRESH();
            constexpr int NCL = 2 * NB * NH * NCH / 4;
            int ncl_ = 0;
            for (;;) {
                CLAIM(qbase + 64 + 16 * rep_, k)
                if (k >= NCL) break;
                FRESH(); ++ncl_;
                if (SK(10)) rwkv_solve_item(C, l, 4 * k + (C.wave >> 1));
            }
            if (ncl_ <= 4) { const int cap_ = (l & 1) ? 1 : 3; CONV_QUEUES(cap_); }
            SEAM(pb + (RW_VSPLIT ? 3 : 4));
        }
#if RW_VSPLIT
        if (PM(3) && IN(pb + 4)) { FRESH();
            for (;;) {
                CLAIM(qbase + 128, k)
                if (k >= 2 * NB * NH * NCH / 4) break;
                FRESH();
                if (SK(10)) rwkv_solve_item(C, l, 4 * k + (C.wave >> 1));
            }
            SEAM(pb + 4);
        }
#endif
        if (PM(4) && IN(pb + 5)) { FRESH();
            if (C.wg >= 64) {
                constexpr int NCL = 2 * NB * NH * NCH / 4;
                for (;;) {
                    CLAIM(qbase + 128, k)
                    if (k >= NCL) break;
                    FRESH();
                    if (SK(9)) gdn_solve_item(C, l, 4 * k + (C.wave >> 1));
                }
                asm volatile("s_waitcnt vmcnt(0)" ::: "memory");
                __syncthreads();
                if (C.tid == 0) { __builtin_amdgcn_fence(__ATOMIC_RELEASE, "agent"); asm volatile("s_waitcnt vmcnt(0)" ::: "memory"); (void)xb_add(qbase + 160, 1u); }
                if (C.wg >= 192) {
                    if (C.tid == 0) { unsigned* bar_ = WSP(unsigned, WS_CTL) + CW_BAR; XB_SPIN(xb_ld(qbase + 160) < (unsigned)(C.G - 64), bar_); __builtin_amdgcn_fence(__ATOMIC_ACQUIRE, "agent"); asm volatile("s_waitcnt vmcnt(0)" ::: "memory"); }
                    __syncthreads();
                }
                FRESH();
            }
            if (C.wg >= 64 && C.wg < 128) { if (SK(0)) lru_chain(C, l, C.wg - 64); FRESH(); }
            if (SK(3) && C.wg < (RW_VSPLIT ? 128 : 64)) { if (NREP(20) > 1) { FRESH(); rwkv_chunked<true>(C, l, C.wg); } FRESH(); rwkv_chunked<false>(C, l, C.wg); }
            else if (SK(4) && C.wg >= 128 && C.wg < 192) { for (int r2_ = 0; r2_ < NREP(21); ++r2_) { FRESH(); mlstm_chunked(C, l, C.wg - 128); } }
            else if (SK(5) && C.wg >= 192) { if (NREP(22) > 1) { FRESH(); gdn_chunked<true>(C, l, C.wg - 192); } FRESH(); gdn_chunked<false>(C, l, C.wg - 192); }
            FRESH(); CONV_QUEUES(1 << 30);
            SEAM(pb + 5);
        }
        PHASE(5, 6) { FRESH();
            if (SK(8)) finish_rows(C, l, nrows);
            SEAM(pb + 6);
        }
        if (PM(6) && IN(pb + 7)) { FRESH();
            pg8::Gemm g{WSP(const bf16, WS_HB), WSP(const bf16, WS_WOUT), nrows, 1024, 1024, 0};
            pg8::TailHalfOrder S; S.init(nrows, C.G, C.wg);
            pg8::EpiRes E{xlat, xctx, xmid, WSP(float, WS_XC), modv + 2 * 1024, xbf, true};
            pg8::gemm_phase<pg8::EpiRes, pg8::TailHalfOrder, false>(C.lds, g, S, E, nullptr);
            SEAM(pb + 7);
        }
        if (PM(7) && IN(pb + 8)) { FRESH();
            if (moe) norm_rows<true>(C, l, xmid, true, WSP(const float, WS_XC), C.in[I_NFFNG] + l * 1024, 3 * 1024, 4 * 1024, nrows, l >> 1);
            else norm_rows<false>(C, l, xmid, true, WSP(const float, WS_XC), C.in[I_NFFNG] + l * 1024, 3 * 1024, 4 * 1024, nrows, 0);
            SEAM(pb + 8);
        }
        if (!moe) {
            if (PM(8) && IN(pb + 9)) for (int rep_ = 0; rep_ < NREP(8); ++rep_) { FRESH();
                pg8::Gemm g{WSP(const bf16, WS_HB), WSP(const bf16, WS_WGU), nrows, 2 * DFF, 1024, 0};
                pg8::StaticOrder S; S.init(nrows, 2 * DFF, C.G, C.wg);
                pg8::EpiSwiglu E{WSP(bf16, WS_P), DFF};
                pg8::gemm_phase<pg8::EpiSwiglu, pg8::StaticOrder, false>(C.lds, g, S, E, nullptr);
                SEAM(pb + 9);
            }
            if (PM(9) && IN(pb + 10)) { FRESH();
                pg8::Gemm g{WSP(const bf16, WS_P), WSP(const bf16, WS_WDN), nrows, 1024, DFF, 0};
                pg8::TailHalfOrder S; S.init(nrows, C.G, C.wg);
                pg8::EpiRes E{xmid, WSP(const float, WS_XC), xmid, WSP(float, WS_XC), modv + 5 * 1024, true, true};
                pg8::gemm_phase<pg8::EpiRes, pg8::TailHalfOrder, false>(C.lds, g, S, E, nullptr);
                SEAM(pb + 12);
            }
        } else {
            if (PM(10) && IN(pb + 9)) { FRESH(); moe_scatter(C, l >> 1, nrows); SEAM(pb + 9); }
            if (PM(11) && IN(pb + 10)) for (int rep_ = 0; rep_ < NREP(11); ++rep_) { FRESH();
                pg8::Gemm g{WSP(const bf16, WS_HB), WSP(const bf16, WS_WGU), 0, 2 * DFE, 1024, (size_t)2 * DFE * 1024};
                pg8::MoeOrderG S; S.init(WSP(const int, WS_TAB), (2 * DFE) / 256, C.G, C.wg); S.tok = WSP(const int, WS_TOK);
                pg8::EpiSwiglu E{WSP(bf16, WS_P), DFE};
                pg8::gemm_phase<pg8::EpiSwiglu, pg8::MoeOrderG, false>(C.lds, g, S, E, nullptr);
                SEAM(pb + 10);
            }
            if (PM(12) && IN(pb + 11)) for (int rep_ = 0; rep_ < NREP(12); ++rep_) { FRESH();
                pg8::Gemm g{WSP(const bf16, WS_P), WSP(const bf16, WS_WDN), 0, 1024, DFE, (size_t)1024 * DFE};
                pg8::MoeOrder S; S.init(WSP(const int, WS_TAB), 4, C.G, C.wg);
                pg8::EpiBf16<0> E{WSP(bf16, WS_MIX), 1024, nullptr, 0, 0};
                pg8::gemm_phase<pg8::EpiBf16<0>, pg8::MoeOrder, false>(C.lds, g, S, E, nullptr);
                SEAM(pb + 11);
            }
            if (PM(13) && IN(pb + 12)) { FRESH();
                if (last) moe_combine<2>(C, l, nrows);
                else { convert_small(C, l + 1); FRESH(); moe_combine<1>(C, l, nrows); if (IN(pb + NPH_L + 1)) { XcdBarrier b2_; b2_.bar = WSP(unsigned, WS_CTL) + CW_BAR; b2_.x = xb_xcc_id(); b2_.st = (volatile LAS unsigned*)(C.lds + MISC_OFF) + 8; xcd_barrier(b2_); } }
            }
        }
    }
}

extern "C" void kernel_launch(void* const* d_in, const int* in_sizes, int n_in, void* d_out, int out_size, void* d_ws, size_t ws_size, hipStream_t stream) {
    static int grid = 0;
    if (grid == 0) {
        if (n_in != N_IN || in_sizes[0] != T_LAT * DM || out_size != T_LAT * DM || ws_size < WS_END) {
            fprintf(stderr, "kernel_launch: unexpected problem (n_in %d, in0 %d, out %d, ws %zu < %zu)\n", n_in, n_in > 0 ? in_sizes[0] : -1, out_size, ws_size, (size_t)WS_END); grid = -1; return; }
        int dev = 0, cus = 0, per_cu = 0;
        if (hipGetDevice(&dev) != hipSuccess || hipDeviceGetAttribute(&cus, hipDeviceAttributeMultiprocessorCount, dev) != hipSuccess) { grid = -1; return; }
        if (hipFuncSetAttribute((const void*)fwd_kernel, hipFuncAttributeMaxDynamicSharedMemorySize, LDS_BYTES) != hipSuccess) { fprintf(stderr, "kernel_launch: hipFuncSetAttribute failed\n"); grid = -1; return; }
        if (hipOccupancyMaxActiveBlocksPerMultiprocessor(&per_cu, (const void*)fwd_kernel, NTHR, LDS_BYTES) != hipSuccess || per_cu < 1) { fprintf(stderr, "kernel_launch: occupancy query says %d\n", per_cu); grid = -1; return; }
        grid = cus;
        if (grid != 256) fprintf(stderr, "kernel_launch: note: %d CUs\n", grid);
    }
    if (grid < 0) return;
    if (hipMemsetAsync((char*)d_ws + WS_CTL, 0, CTL_BYTES, stream) != hipSuccess) return;
    Args a{};
    for (int i = 0; i < N_IN; ++i) a.in[i] = (const float*)d_in[i];
    a.out = (float*)d_out; a.ws = (unsigned char*)d_ws;
#if MK_ONE_LAUNCH
    a.ph_lo = 0; a.ph_hi = NPHASE;
    hipLaunchKernelGGL(fwd_kernel, dim3(grid), dim3(NTHR), LDS_BYTES, stream, a);
#else
    for (int ph = 0; ph < NPHASE; ++ph) { if (!phase_exists(ph)) continue; a.ph_lo = ph; a.ph_hi = ph + 1; hipLaunchKernelGGL(fwd_kernel, dim3(grid), dim3(NTHR), LDS_BYTES, stream, a); }
#endif
}
```

```cpp
#define MK_ONE_LAUNCH 1
#include <hip/hip_runtime.h>
#include <cstdio>
#include <cstdint>

#define GAS __attribute__((address_space(1)))
#define LAS __attribute__((address_space(3)))
typedef unsigned short bf16;
typedef unsigned v4u __attribute__((ext_vector_type(4)));
typedef unsigned v2u __attribute__((ext_vector_type(2)));
typedef float f32x4 __attribute__((ext_vector_type(4)));
typedef float f32x2 __attribute__((ext_vector_type(2)));
typedef short bf16x8 __attribute__((ext_vector_type(8)));
#define LDS_WAIT() asm volatile("s_waitcnt lgkmcnt(0)" ::: "memory")
#define VM_WAIT() asm volatile("s_waitcnt vmcnt(0)" ::: "memory")

constexpr int DM = 1024, NB = 8, SEQ = 4096, DEPTH = 4, CTXL = 256, GW = 256, HD = 64, NH = 4;
constexpr int T_LAT = NB * SEQ, T_CTX = NB * CTXL, T_ALL = T_LAT + T_CTX;
constexpr int IN_COLS = 3552, PLD = 3584;
constexpr int OFF_B = 512, OFF_C = 1472, OFF_D = 2512, B_COLS = 960;
constexpr int DFF = 2816, NE = 8, DFE = 1408;
constexpr int NCH = 68;
constexpr int NSTEP = 4352;
constexpr int MOE_MAXBLK = 280;
constexpr int NWAVES = 8, NTHR = 512;
#ifndef RW_VSPLIT
#define RW_VSPLIT 0
#endif

constexpr size_t MiB = 1u << 20;
constexpr size_t WS_CTL = 0, CTL_BYTES = 1 * MiB;
constexpr size_t WS_MODV = 1 * MiB;
constexpr size_t WS_XC = 2 * MiB;
constexpr size_t WS_WIN = 10 * MiB;
constexpr size_t WS_WOUT = 17 * MiB;
constexpr size_t WS_WGU = 19 * MiB;
constexpr size_t WS_WDN = 63 * MiB;
constexpr size_t WS_HB = 85 * MiB;
constexpr size_t WS_P = 153 * MiB;
constexpr size_t WS_MIX = 391 * MiB;
constexpr size_t WS_OUTB = WS_MIX, WS_OUTC = WS_MIX + 34 * MiB, WS_OUTD = WS_MIX + 68 * MiB, WS_GQ = WS_MIX + 102 * MiB, WS_G = WS_MIX + 153 * MiB;
constexpr size_t WS_XLAST = WS_MIX + 144 * MiB;
constexpr size_t WS_RKV = WS_MIX + 170 * MiB;
constexpr size_t WS_SMALL = 612 * MiB;
constexpr size_t WS_ROUTE = WS_SMALL;
constexpr size_t WS_POS = WS_SMALL + 1280 * 1024;
constexpr size_t WS_TOK = WS_SMALL + 1664 * 1024;
constexpr size_t WS_BONUS = WS_SMALL + 2 * MiB;
constexpr size_t WS_RINV = WS_SMALL + 2 * MiB + 640 * 1024;
constexpr size_t WS_WGBASE = WS_SMALL + 3 * MiB + 256 * 1024;
constexpr size_t WS_TAB = WS_WGBASE + 65536;
constexpr size_t WS_LRUWT = WS_SMALL + 3 * MiB + 512 * 1024;
constexpr size_t WS_RWT = WS_LRUWT + 131072;
constexpr size_t WS_LRUH = WS_SMALL + 4 * MiB;
constexpr size_t WS_END = 633 * MiB;
constexpr int CW_MOECNT = 1024;
constexpr int CW_PREPQ = 2048;
constexpr int CW_BAR = 4096;

constexpr int LDS_BYTES = 135168;
constexpr int MISC_OFF = 131072;

__device__ __forceinline__ unsigned f2bf(float f) { unsigned u = __builtin_bit_cast(unsigned, f); return (u + 0x7fffu + ((u >> 16) & 1u)) >> 16; }
typedef __bf16 bf16n2 __attribute__((ext_vector_type(2)));
__device__ __forceinline__ unsigned pk2(float lo, float hi) { const f32x2 v = {lo, hi}; return __builtin_bit_cast(unsigned, __builtin_convertvector(v, bf16n2)); }
__device__ __forceinline__ unsigned f2bf1(float f) { return pk2(f, f) & 0xffffu; }
__device__ __forceinline__ float bf2f(unsigned short v) { return __builtin_bit_cast(float, (unsigned)v << 16); }
__device__ __forceinline__ float bflo(unsigned v) { return __builtin_bit_cast(float, v << 16); }
__device__ __forceinline__ float bfhi(unsigned v) { return __builtin_bit_cast(float, v & 0xffff0000u); }
template <int CTRL, int RM, bool BC> __device__ __forceinline__ float dpp_x(float oldv, float v) { return __builtin_bit_cast(float, __builtin_amdgcn_update_dpp(__builtin_bit_cast(int, oldv), __builtin_bit_cast(int, v), CTRL, RM, 0xF, BC)); }
__device__ __forceinline__ float wave_sum(float v) {
    v += dpp_x<0xB1, 0xF, true>(0.f, v); v += dpp_x<0x4E, 0xF, true>(0.f, v); v += dpp_x<0x141, 0xF, true>(0.f, v); v += dpp_x<0x140, 0xF, true>(0.f, v);
    v += dpp_x<0x142, 0xA, false>(0.f, v); v += dpp_x<0x143, 0xC, false>(0.f, v);
    return __builtin_bit_cast(float, __builtin_amdgcn_readlane(__builtin_bit_cast(int, v), 63));
}
template <int CTRL> __device__ __forceinline__ float dpp_f(float v) { return __builtin_bit_cast(float, __builtin_amdgcn_update_dpp(0, __builtin_bit_cast(int, v), CTRL, 0xF, 0xF, true)); }
__device__ __forceinline__ float row16_sum(float v) {
    v += dpp_f<0xB1>(v);
    v += dpp_f<0x4E>(v);
    v += dpp_f<0x141>(v);
    v += dpp_f<0x140>(v);
    return v;
}
__device__ __forceinline__ float sigmoidf_(float x) { return __builtin_amdgcn_rcpf(1.0f + __expf(-x)); }
__device__ __forceinline__ float softplusf_(float x) { return fmaxf(x, 0.f) + __logf(1.0f + __expf(-fabsf(x))); }
__device__ __forceinline__ float expm1f_(float x) { return x > -0.3f ? x * (1.0f + x * (0.5f + x * (0.16666667f + x * (0.041666668f + x * 0.0083333338f)))) : __expf(x) - 1.0f; }
__device__ __forceinline__ float siluf_(float x) { return x * __builtin_amdgcn_rcpf(1.0f + __expf(-x)); }
__device__ __forceinline__ float tanhf_(float x) { const float e = __expf(2.0f * x); return 1.0f - 2.0f * __builtin_amdgcn_rcpf(e + 1.0f); }
__device__ __forceinline__ float rsqrtf_(float x) { return __builtin_amdgcn_rsqf(x); }
__device__ __forceinline__ float gelu_tanh(float x) { return 0.5f * x * (1.0f + tanhf_(0.7978845608028654f * (x + 0.044715f * x * x * x))); }
__device__ __forceinline__ f32x4 ld4bf(const bf16* p) { const v2u a = *(const v2u*)p; return (f32x4){bflo(a.x), bfhi(a.x), bflo(a.y), bfhi(a.y)}; }
__device__ __forceinline__ void st4bf(bf16* p, const f32x4& v) { v2u o; o.x = pk2(v.x, v.y); o.y = pk2(v.z, v.w); *(v2u*)p = o; }
#define XB_TMO      128
#define XB_XCNT(j)  (256  + 64 * (j))
#define XB_XSUB(j)  (1280 + 64 * (j))
#define XB_XGEN(j)  (2304 + 64 * (j))
#define XB_TOP      3328
#define XB_TOPGEN   3392
#define XCD_BAR_WORDS 3456
#define XB_SPIN_CAP (1u << 22)

__device__ __forceinline__ unsigned xb_ld(unsigned* p)              { return __hip_atomic_load(p, __ATOMIC_RELAXED, __HIP_MEMORY_SCOPE_AGENT); }
__device__ __forceinline__ unsigned xb_add(unsigned* p, unsigned v) { return __hip_atomic_fetch_add(p, v, __ATOMIC_RELAXED, __HIP_MEMORY_SCOPE_AGENT); }
__device__ __forceinline__ unsigned xb_xcc_id() { return (unsigned)__builtin_amdgcn_s_getreg((3 << 11) | 20) & 0xFu; }
#define XB_SPIN(cond, bar) do { unsigned _sp = 0; while (cond) { __builtin_amdgcn_s_sleep(1); \
    if ((++_sp & 255u) == 0u) { if (xb_ld(&(bar)[XB_TMO])) break; if (_sp > XB_SPIN_CAP) { atomicAdd(&(bar)[XB_TMO], 1u); break; } } } } while (0)

struct XcdBarrier {
    unsigned* bar; unsigned x;
    volatile LAS unsigned* st;
};

__device__ __forceinline__ XcdBarrier xcd_barrier_post(unsigned* bar, volatile LAS unsigned* st) {
    XcdBarrier b; b.bar = bar; b.x = xb_xcc_id(); b.st = st;
    if (threadIdx.x == 0) (void)xb_add(&bar[XB_XCNT(b.x)], 1u);
    return b;
}
__device__ __forceinline__ void xcd_barrier_complete(unsigned* bar, unsigned x, unsigned& nloc, unsigned& nx) {
    const unsigned G = gridDim.x * gridDim.y * gridDim.z;
    unsigned sum, cnt, mine, sp = 0u;
    for (;;) {
        sum = 0u; cnt = 0u; mine = 0u;
#pragma unroll
        for (unsigned j = 0; j < 16; ++j) { const unsigned c = xb_ld(&bar[XB_XCNT(j)]); sum += c; cnt += (c > 0u) ? 1u : 0u; mine = (j == x) ? c : mine; }
        if (sum == G) break;
        __builtin_amdgcn_s_sleep(1);
        if ((++sp & 255u) == 0u) { if (xb_ld(&bar[XB_TMO])) break; if (sp > XB_SPIN_CAP) { atomicAdd(&bar[XB_TMO], 1u); break; } }
    }
    nloc = mine > 0u ? mine : 1u; nx = cnt > 0u ? cnt : 1u;
}

__device__ __forceinline__ void xcd_barrier(const XcdBarrier& b) {
    asm volatile("s_waitcnt vmcnt(0)" ::: "memory");
    __syncthreads();
    if (threadIdx.x == 0) {
        unsigned* bar = b.bar;
        __builtin_amdgcn_s_waitcnt(0);
        unsigned nloc = b.st[0], nx = b.st[1];
        if (nloc == 0u) { xcd_barrier_complete(bar, b.x, nloc, nx); b.st[0] = nloc; b.st[1] = nx; }
        const unsigned old = xb_add(&bar[XB_XSUB(b.x)], 1u);
        const unsigned gen = old / nloc;
        if (old + 1u == (gen + 1u) * nloc) {
            __builtin_amdgcn_fence(__ATOMIC_RELEASE, "agent");
            asm volatile("s_waitcnt vmcnt(0)" ::: "memory");
            const unsigned og = xb_add(&bar[XB_TOP], 1u);
            const unsigned tg = og / nx;
            if (og + 1u == (tg + 1u) * nx) xb_add(&bar[XB_TOPGEN], 1u);
            else XB_SPIN(xb_ld(&bar[XB_TOPGEN]) == tg, bar);
            __builtin_amdgcn_fence(__ATOMIC_ACQUIRE, "agent");
            xb_add(&bar[XB_XGEN(b.x)], 1u);
            asm volatile("s_waitcnt vmcnt(0)" ::: "memory");
        } else {
            XB_SPIN(xb_ld(&bar[XB_XGEN(b.x)]) == gen, bar);
            __builtin_amdgcn_fence(__ATOMIC_ACQUIRE, "agent");
            asm volatile("s_waitcnt vmcnt(0)" ::: "memory");
        }
    }
    __syncthreads();
}

namespace pg8 {
#define PG8_LAS __attribute__((address_space(3)))
typedef unsigned short bf16_t;
typedef short bf16x8 __attribute__((ext_vector_type(8)));
typedef float f32x4 __attribute__((ext_vector_type(4)));
typedef unsigned u32x4 __attribute__((ext_vector_type(4)));
constexpr int BM = 256, BK = 64, HALF = 128, HTB = HALF * BK * 2  , STAGE_BYTES = 8 * HTB, NXCD = 8, WGM = 8;

__host__ __device__ __forceinline__ int lds_byte(int r, int c) { const int st = (r >> 4) * 2 + (c >> 5), rr = r & 15, cc = c & 31, ob = rr * 64 + cc * 2; return st * 1024 + (ob ^ (((ob >> 9) & 1) << 5)); }
__host__ __device__ __forceinline__ void stage_rc(int b, int& R, int& C) { const int st = b / 1024, sb = b % 1024, swz = sb ^ (((sb >> 9) & 1) << 5); R = (st >> 1) * 16 + swz / 64; C = (st & 1) * 32 + (swz % 64) / 2; }
__host__ __device__ __forceinline__ int perm32(int rho) { const int n = rho >> 4, i = rho & 15; return 8 * (i >> 2) + 4 * n + (i & 3); }

struct Unit { int pm, pn, e; };
struct Gemm { const bf16_t* A; const bf16_t* Bt; int M, N, K; size_t estride; };

struct StaticOrder {
    static constexpr bool GATHER = false, HALFS = false;
    int nM, nN, nwg, G, c;
    __host__ __device__ void init(int M, int N, int G_, int c_) { nM = M / BM; nN = N / BM; nwg = nM * nN; G = G_; c = c_; }
    __host__ __device__ bool next(int i, Unit& u) const {
        const long L = (long)i * G + c; if (L >= nwg) return false;
        int wgid = (int)L; { const int q = nwg / NXCD, r = nwg % NXCD, xcd = wgid % NXCD, off = wgid / NXCD; wgid = (xcd < r ? xcd * (q + 1) : r * (q + 1) + (xcd - r) * q) + off; }
        const int nig = WGM * nN, gid = wgid / nig, fm = gid * WGM, gsz = (nM - fm) < WGM ? (nM - fm) : WGM;
        u.pm = fm + ((wgid % nig) % gsz); u.pn = (wgid % nig) / gsz; u.e = 0; return true;
    }
    __device__ __forceinline__ void a_ready(const Unit&) const {}
    __device__ __forceinline__ void done(const Unit&) const {}
};
struct TailHalfOrder {
    static constexpr bool GATHER = false, HALFS = true;
    int nM, nwg, G, c, ntail;
    __device__ __forceinline__ void init(int M, int G_, int c_) { const int nMall = M / BM; nM = nMall >= 128 ? 128 : nMall; nwg = nM * 4; ntail = nMall - nM; G = G_; c = c_; }
    __device__ __forceinline__ bool next(int i, Unit& u) const {
        const int L = i * G + c;
        if (L < nwg) {
            int wgid = L; { const int q = nwg / NXCD, r = nwg % NXCD, xcd = wgid % NXCD, off = wgid / NXCD; wgid = (xcd < r ? xcd * (q + 1) : r * (q + 1) + (xcd - r) * q) + off; }
            const int nig = WGM * 4, gid = wgid / nig, fm = gid * WGM, gsz = (nM - fm) < WGM ? (nM - fm) : WGM;
            u.pm = fm + ((wgid % nig) % gsz); u.pn = (wgid % nig) / gsz; u.e = 0; return true;
        }
        const int t = L - nwg; if (t >= ntail * 8) return false;
        const int nh = t / ntail; u.pm = 128 + (t - nh * ntail); u.pn = (nh >> 1) | ((1 + (nh & 1)) << 8); u.e = 0; return true;
    }
    __device__ __forceinline__ void a_ready(const Unit&) const {}
    __device__ __forceinline__ void done(const Unit&) const {}
};
typedef __bf16 bf16n2_ __attribute__((ext_vector_type(2)));
__device__ __forceinline__ unsigned cvt_pk_bf16(float lo, float hi) { typedef float f2_ __attribute__((ext_vector_type(2))); const f2_ v = {lo, hi}; return __builtin_bit_cast(unsigned, __builtin_convertvector(v, bf16n2_)); }
typedef float f32x2 __attribute__((ext_vector_type(2)));
__device__ __forceinline__ f32x2 gelu_pk(f32x2 v) {
    const f32x2 av = __builtin_elementwise_abs(v), d = av * 0.2316418882f + 1.0f;
    f32x2 t; t.x = __builtin_amdgcn_rcpf(d.x); t.y = __builtin_amdgcn_rcpf(d.y);
    f32x2 q = t * 0.5307027145f + (-0.7265760135f); q = q * t + 0.7107068705f; q = q * t + (-0.142248368f); q = q * t + 0.127414796f; q = q * t;
    const f32x2 s = (v * v) * (-0.72134752044f);
    f32x2 e; e.x = __builtin_amdgcn_exp2f(s.x); e.y = __builtin_amdgcn_exp2f(s.y);
    const f32x2 m = v * (q * e), r = v - m;
    f32x2 o; o.x = v.x < 0.f ? m.x : r.x; o.y = v.y < 0.f ? m.y : r.y; return o;
}

struct EpiF32 {
    static constexpr bool PERM = false, AFTER_DRAIN = false;
    float* C; int ldc; const float* bias;
    __device__ __forceinline__ void operator()(const f32x4 (&acc)[2][2][4][2], const Unit& u, int wr, int wc, int fr, int fq) const {
        const int row0 = u.pm * BM + wr * 64 + fr, col0 = u.pn * BM + wc * 32 + 4 * fq;
        f32x4 bv[2][2];
#pragma unroll
        for (int bj = 0; bj < 2; ++bj)
#pragma unroll
            for (int n = 0; n < 2; ++n) bv[bj][n] = bias ? *(const f32x4*)(bias + col0 + bj * HALF + n * 16) : (f32x4){0.f, 0.f, 0.f, 0.f};
#pragma unroll
        for (int ai = 0; ai < 2; ++ai)
#pragma unroll
            for (int m = 0; m < 4; ++m) { float* rowp = C + (size_t)(row0 + ai * HALF + m * 16) * ldc + col0;
#pragma unroll
                for (int bj = 0; bj < 2; ++bj)
#pragma unroll
                    for (int n = 0; n < 2; ++n) *(f32x4*)(rowp + bj * HALF + n * 16) = acc[ai][bj][m][n] + bv[bj][n]; }
    }
};
template <int ACT  > struct EpiBf16 {
    static constexpr bool PERM = true, AFTER_DRAIN = false;
    bf16_t* O; int ldc; const float* bias; int split_cols; size_t split_stride;
    __device__ __forceinline__ void operator()(const f32x4 (&acc)[2][2][4][2], const Unit& u, int wr, int wc, int fr, int fq) const {
        const int row0 = u.pm * BM + wr * 64 + fr; int colt = u.pn * BM; bf16_t* base = O;
        if (split_cols) { const int t = colt / split_cols; base += (size_t)t * split_stride; colt -= t * split_cols; }
        const int col0 = colt + wc * 32 + 8 * fq, bcol0 = u.pn * BM + wc * 32 + 8 * fq;
        f32x4 bv[2][2];
#pragma unroll
        for (int bj = 0; bj < 2; ++bj)
#pragma unroll
            for (int n = 0; n < 2; ++n) bv[bj][n] = bias ? *(const f32x4*)(bias + bcol0 + bj * HALF + 4 * n) : (f32x4){0.f, 0.f, 0.f, 0.f};
#pragma unroll
        for (int ai = 0; ai < 2; ++ai)
#pragma unroll
            for (int m = 0; m < 4; ++m) { bf16_t* rowp = base + (size_t)(row0 + ai * HALF + m * 16) * ldc + col0;
#pragma unroll
                for (int bj = 0; bj < 2; ++bj) { f32x4 v0 = acc[ai][bj][m][0] + bv[bj][0], v1 = acc[ai][bj][m][1] + bv[bj][1];
                    if (ACT == 1) { f32x2 a = gelu_pk((f32x2){v0[0], v0[1]}), b = gelu_pk((f32x2){v0[2], v0[3]}), c = gelu_pk((f32x2){v1[0], v1[1]}), d = gelu_pk((f32x2){v1[2], v1[3]});
                        v0 = (f32x4){a.x, a.y, b.x, b.y}; v1 = (f32x4){c.x, c.y, d.x, d.y}; }
                    if (ACT == 2) {
#pragma unroll
                        for (int j = 0; j < 4; ++j) { v0[j] = 0.5f * v0[j] * (1.0f + erff(v0[j] * 0.70710678f)); v1[j] = 0.5f * v1[j] * (1.0f + erff(v1[j] * 0.70710678f)); } }
                    u32x4 w; w.x = cvt_pk_bf16(v0[0], v0[1]); w.y = cvt_pk_bf16(v0[2], v0[3]); w.z = cvt_pk_bf16(v1[0], v1[1]); w.w = cvt_pk_bf16(v1[2], v1[3]);
                    *(u32x4*)(rowp + bj * HALF) = w; } }
    }
};

template <class Epi, class Sched, bool STAMP = false>
__device__ __forceinline__ void gemm_phase(PG8_LAS unsigned char* lds, const Gemm g, const Sched& S, const Epi& E, unsigned long long* stamps) {
    int tid_ = threadIdx.x; asm volatile("" : "+v"(tid_));
    const int tid = tid_, wid = __builtin_amdgcn_readfirstlane(tid >> 6), lane = tid & 63, wr = wid >> 2, wc = wid & 3, fr = lane & 15, fq = lane >> 4;
    const int K = g.K, nt = K / BK;
    constexpr bool GATHER = Sched::GATHER; constexpr bool HALFS = Sched::HALFS;
    int ts_lo = 0, ts_hi = 0, nts = 0; const unsigned long long rt_entry = STAMP ? (unsigned long long)wall_clock64() : 0ull;
#define PG8_STAMP() do { if (STAMP && wid == 0 && nts < 64) { const unsigned long long _c = (unsigned long long)clock64(); \
        ts_lo = (lane == nts) ? (int)(unsigned)_c : ts_lo; ts_hi = (lane == nts) ? (int)(unsigned)(_c >> 32) : ts_hi; ++nts; } } while (0)
    PG8_STAMP();
    unsigned voffA[2], voffB[2]; int rowA[2];
#pragma unroll
    for (int i = 0; i < 2; ++i) { int R, C; stage_rc(tid * 16 + i * 8192, R, C); const int Rb = Epi::PERM ? ((R & ~31) + perm32(R & 31)) : R;
        rowA[i] = R; voffA[i] = GATHER ? (unsigned)C * 2u : (unsigned)(R * K + C) * 2u; voffB[i] = (unsigned)(Rb * K + C) * 2u; }
    const size_t kstep = (size_t)(BK * 2);
    const size_t hstep = (size_t)HALF * K * 2;
    const size_t tstep = 2 * hstep;
    const unsigned ldsw = (unsigned)wid * 1024u;
    const int aoff = lds_byte(wr * 64 + fr, fq * 8), boff = lds_byte(wc * 32 + fr, fq * 8);
#define PG8_SA(b, h) (((b) * 2 + (h)) * HTB)
#define PG8_SB(b, h) ((4 + (b) * 2 + (h)) * HTB)
#define PG8_STAGE(bufoff, gbase, voff) do { _Pragma("unroll") for (int _i = 0; _i < 2; ++_i) \
        __builtin_amdgcn_global_load_lds((const unsigned*)((const char*)(gbase) + (voff)[_i]), (PG8_LAS unsigned*)(lds + (bufoff) + ldsw + _i * 8192), 16, 0, 0); } while (0)
#define PG8_STAGE_A(bufoff, gbase, h, gv) do { if constexpr (GATHER) { PG8_STAGE(bufoff, gbase, (gv)[h]); } else { PG8_STAGE(bufoff, (gbase) + (h) * hstep, voffA); } } while (0)
#define PG8_TOKSLOT(s) ((PG8_LAS int*)(lds + STAGE_BYTES + 1024 + ((s) & 1) * 1024))
#define PG8_LDA(dst, b, h) do { _Pragma("unroll") for (int m = 0; m < 4; ++m) _Pragma("unroll") for (int k = 0; k < 2; ++k) dst[m][k] = *(const PG8_LAS bf16x8*)(lds + PG8_SA(b, h) + aoff + m * 2048 + k * 1024); } while (0)
#define PG8_LDB(dst, b, h) do { _Pragma("unroll") for (int n = 0; n < 2; ++n) _Pragma("unroll") for (int k = 0; k < 2; ++k) dst[n][k] = *(const PG8_LAS bf16x8*)(lds + PG8_SB(b, h) + boff + n * 2048 + k * 1024); } while (0)
#define PG8_MMA(ai, bj, At, Bt) do { __builtin_amdgcn_s_setprio(1); _Pragma("unroll") for (int m = 0; m < 4; ++m) _Pragma("unroll") for (int n = 0; n < 2; ++n) _Pragma("unroll") for (int k = 0; k < 2; ++k) \
        acc[ai][bj][m][n] = __builtin_amdgcn_mfma_f32_16x16x32_bf16(Bt[n][k], At[m][k], acc[ai][bj][m][n], 0, 0, 0); __builtin_amdgcn_s_setprio(0); } while (0)
#define PG8_WAIT_V(n) asm volatile("s_waitcnt vmcnt(" #n ")" ::: "memory")
#define PG8_WAIT_L(n) asm volatile("s_waitcnt lgkmcnt(" #n ")" ::: "memory")
#define PG8_BAR __builtin_amdgcn_s_barrier()
#define PG8_SCHED __builtin_amdgcn_sched_barrier(0)
    Unit cur, nxt; int ui = 0;
    if (!S.next(0, cur)) return;
    f32x4 acc[2][2][4][2];
#pragma unroll
    for (int a = 0; a < 2; ++a)
#pragma unroll
        for (int b = 0; b < 2; ++b)
#pragma unroll
            for (int m = 0; m < 4; ++m)
#pragma unroll
                for (int n = 0; n < 2; ++n) acc[a][b][m][n] = (f32x4){0.f, 0.f, 0.f, 0.f};
    bf16x8 At[4][2], B0[2][2], B1[2][2];
    const char* cA = (const char*)g.A + (GATHER ? (size_t)0 : (size_t)cur.pm * tstep); const char* cB = (const char*)g.Bt + (size_t)(HALFS ? cur.pn & 255 : cur.pn) * tstep + (size_t)cur.e * g.estride * 2 + ((HALFS && (cur.pn >> 8) == 2) ? hstep : (size_t)0);
    S.a_ready(cur);
    unsigned gcur[2][2], gnxt[2][2], gs[2][2];
    if constexpr (GATHER) {
        if (tid < 256) PG8_TOKSLOT(0)[tid] = S.tok[cur.pm * 256 + tid];
        __syncthreads();
#pragma unroll
        for (int h = 0; h < 2; ++h)
#pragma unroll
            for (int i = 0; i < 2; ++i) { gcur[h][i] = (unsigned)PG8_TOKSLOT(0)[h * HALF + rowA[i]] * (unsigned)(K * 2) + voffA[i]; gnxt[h][i] = gcur[h][i]; gs[h][i] = gcur[h][i]; }
    }
    PG8_STAGE(PG8_SB(0, 0), cB, voffB); PG8_STAGE_A(PG8_SA(0, 0), cA, 0, gcur); PG8_STAGE(PG8_SB(0, 1), cB + hstep, voffB); PG8_STAGE_A(PG8_SA(0, 1), cA, 1, gcur);
    if (wr == 1) PG8_BAR;
    PG8_WAIT_V(4); PG8_BAR;
    PG8_STAGE(PG8_SB(1, 0), cB + kstep, voffB); PG8_STAGE_A(PG8_SA(1, 0), cA + kstep, 0, gcur); PG8_STAGE(PG8_SB(1, 1), cB + hstep + kstep, voffB);
    PG8_WAIT_V(6); PG8_BAR;
    PG8_STAMP();
    for (;;) {
        const bool has_next = S.next(ui + 1, nxt);
        if constexpr (GATHER) { if (has_next && wid < 4)
            __builtin_amdgcn_global_load_lds((const unsigned*)(S.tok + nxt.pm * 256 + wid * 64 + lane), (PG8_LAS unsigned*)((PG8_LAS unsigned char*)PG8_TOKSLOT(ui + 1) + wid * 256), 4, 0, 0); }
        const char* nA = GATHER ? (const char*)g.A : has_next ? (const char*)g.A + (size_t)nxt.pm * tstep : cA; const char* nB = has_next ? (const char*)g.Bt + (size_t)(HALFS ? nxt.pn & 255 : nxt.pn) * tstep + (size_t)nxt.e * g.estride * 2 + ((HALFS && (nxt.pn >> 8) == 2) ? hstep : (size_t)0) : cB;
        const bool full = !HALFS || (cur.pn >> 8) == 0;
        for (int t = 0; t < nt; t += 2) {
            const bool last = (t == nt - 2);
            const char* a1 = cA + (size_t)(t + 1) * kstep;
            const char* a2 = last ? nA : cA + (size_t)(t + 2) * kstep; const char* b2 = last ? nB : cB + (size_t)(t + 2) * kstep;
            const char* a3 = a2 + kstep; const char* b3 = b2 + kstep;
            if (last && has_next) S.a_ready(nxt);
            if constexpr (GATHER) {
                if (last && has_next) {
#pragma unroll
                    for (int h = 0; h < 2; ++h)
#pragma unroll
                        for (int i = 0; i < 2; ++i) gnxt[h][i] = (unsigned)PG8_TOKSLOT(ui + 1)[h * HALF + rowA[i]] * (unsigned)(K * 2) + voffA[i];
                }
#pragma unroll
                for (int h = 0; h < 2; ++h)
#pragma unroll
                    for (int i = 0; i < 2; ++i) gs[h][i] = last ? gnxt[h][i] : gcur[h][i];
            }
            PG8_LDB(B0, 0, 0); PG8_SCHED; PG8_LDA(At, 0, 0); PG8_STAGE_A(PG8_SA(1, 1), a1, 1, gcur);
            PG8_WAIT_L(8); PG8_BAR; PG8_WAIT_L(0); PG8_MMA(0, 0, At, B0); PG8_BAR; PG8_SCHED;
            if (full) PG8_LDB(B1, 0, 1); PG8_STAGE(PG8_SB(0, 0), b2, voffB);
            PG8_BAR; PG8_WAIT_L(0); if (full) PG8_MMA(0, 1, At, B1); PG8_BAR;
            PG8_LDA(At, 0, 1); PG8_STAGE_A(PG8_SA(0, 0), a2, 0, gs);
            PG8_BAR; PG8_WAIT_L(0); PG8_MMA(1, 0, At, B0); PG8_BAR; PG8_SCHED;
            PG8_STAGE(PG8_SB(0, 1), b2 + hstep, voffB);
            PG8_WAIT_V(6); PG8_BAR; if (full) PG8_MMA(1, 1, At, B1); PG8_BAR;
            PG8_LDB(B0, 1, 0); PG8_SCHED; PG8_LDA(At, 1, 0); PG8_STAGE_A(PG8_SA(0, 1), a2, 1, gs);
            PG8_WAIT_L(8); PG8_BAR; PG8_WAIT_L(0); PG8_MMA(0, 0, At, B0); PG8_BAR; PG8_SCHED;
            if (full) PG8_LDB(B1, 1, 1); PG8_STAGE(PG8_SB(1, 0), b3, voffB);
            PG8_BAR; PG8_WAIT_L(0); if (full) PG8_MMA(0, 1, At, B1); PG8_BAR;
            PG8_LDA(At, 1, 1); PG8_STAGE_A(PG8_SA(1, 0), a3, 0, gs);
            PG8_BAR; PG8_WAIT_L(0); PG8_MMA(1, 0, At, B0); PG8_BAR; PG8_SCHED;
            PG8_STAGE(PG8_SB(1, 1), b3 + hstep, voffB);
            PG8_WAIT_V(6); PG8_BAR; if (full) PG8_MMA(1, 1, At, B1); PG8_BAR;
        }
        PG8_STAMP();
        if constexpr (!Epi::AFTER_DRAIN) { E(acc, cur, wr, wc, fr, fq); S.done(cur); }
        PG8_STAMP();
        if (!has_next) break;
#pragma unroll
        for (int a = 0; a < 2; ++a)
#pragma unroll
            for (int b = 0; b < 2; ++b)
#pragma unroll
                for (int m = 0; m < 4; ++m)
#pragma unroll
                    for (int n = 0; n < 2; ++n) acc[a][b][m][n] = (f32x4){0.f, 0.f, 0.f, 0.f};
        cur = nxt; cA = nA; cB = nB; ++ui;
        if constexpr (GATHER) {
#pragma unroll
            for (int h = 0; h < 2; ++h)
#pragma unroll
                for (int i = 0; i < 2; ++i) gcur[h][i] = gnxt[h][i];
        }
    }
    PG8_WAIT_V(0);
    if (wr == 0) PG8_BAR;
    PG8_BAR;
    if constexpr (Epi::AFTER_DRAIN) { E.fused(acc, cur, wr, wc, fr, fq, lds, wid, lane); S.done(cur); }
    PG8_STAMP();
    if (STAMP && wid == 0) { stamps[lane] = lane < nts ? (((unsigned long long)(unsigned)ts_hi << 32) | (unsigned)ts_lo) : 0ull;
        if (lane == 62) stamps[62] = rt_entry; if (lane == 63) stamps[63] = (unsigned long long)wall_clock64(); }
#undef PG8_STAMP
#undef PG8_SA
#undef PG8_SB
#undef PG8_STAGE
#undef PG8_STAGE_A
#undef PG8_TOKSLOT
#undef PG8_LDA
#undef PG8_LDB
#undef PG8_MMA
#undef PG8_WAIT_V
#undef PG8_WAIT_L
#undef PG8_BAR
#undef PG8_SCHED
}
}
namespace pg8 {
struct EpiRes {
    static constexpr bool PERM = true, AFTER_DRAIN = false;
    const void* base_lat; const float* base_ctx; void* out_lat; float* out_ctx; const float* gvec; bool base_bf, out_bf;
    __device__ __forceinline__ void operator()(const f32x4 (&acc)[2][2][4][2], const Unit& u, int wr, int wc, int fr, int fq) const {
        const bool isctx = u.pm >= 128;
        const int prow = (isctx ? (u.pm - 128) : u.pm) * BM;
        const float* base = isctx ? base_ctx : (const float*)base_lat; float* out = isctx ? out_ctx : (float*)out_lat;
        const bool bbf = !isctx && base_bf, obf = !isctx && out_bf;
        const float* gv = gvec + (size_t)(isctx ? 8 : (u.pm >> 4)) * 6144;
        const int row0 = prow + wr * 64 + fr, hf = u.pn >> 8, col0 = (u.pn & 255) * BM + (hf == 2 ? HALF : 0) + wc * 32 + 8 * fq;
        f32x4 gvv[2][2];
#pragma unroll
        for (int bj = 0; bj < 2; ++bj)
#pragma unroll
            for (int n = 0; n < 2; ++n) gvv[bj][n] = *(const f32x4*)(gv + col0 + bj * HALF + 4 * n);
#pragma unroll
        for (int ai = 0; ai < 2; ++ai)
#pragma unroll
            for (int m = 0; m < 4; ++m) { const size_t off = (size_t)(row0 + ai * HALF + m * 16) * 1024 + col0;
#pragma unroll
                for (int bj = 0; bj < 2; ++bj) { if (bj == 1 && hf != 0) continue; const size_t o2 = off + bj * HALF;
                    f32x4 b0, b1;
                    if (bbf) { const v4u r = *(const v4u*)((const bf16*)base_lat + o2); b0 = (f32x4){bflo(r.x), bfhi(r.x), bflo(r.y), bfhi(r.y)}; b1 = (f32x4){bflo(r.z), bfhi(r.z), bflo(r.w), bfhi(r.w)}; }
                    else { b0 = *(const f32x4*)(base + o2); b1 = *(const f32x4*)(base + o2 + 4); }
                    const f32x4 v0 = b0 + gvv[bj][0] * acc[ai][bj][m][0], v1 = b1 + gvv[bj][1] * acc[ai][bj][m][1];
                    if (obf) { v4u w; w.x = pk2(v0.x, v0.y); w.y = pk2(v0.z, v0.w); w.z = pk2(v1.x, v1.y); w.w = pk2(v1.z, v1.w); *(v4u*)((bf16*)out_lat + o2) = w; }
                    else { *(f32x4*)(out + o2) = v0; *(f32x4*)(out + o2 + 4) = v1; } } }
    }
};
struct EpiSwiglu {
    static constexpr bool PERM = true, AFTER_DRAIN = false;
    bf16_t* O; int ldc;
    __device__ __forceinline__ void operator()(const f32x4 (&acc)[2][2][4][2], const Unit& u, int wr, int wc, int fr, int fq) const {
        const int row0 = u.pm * BM + wr * 64 + fr, col0 = u.pn * HALF + wc * 32 + 8 * fq;
#pragma unroll
        for (int ai = 0; ai < 2; ++ai)
#pragma unroll
            for (int m = 0; m < 4; ++m) { bf16_t* rowp = O + (size_t)(row0 + ai * HALF + m * 16) * ldc + col0;
                float h[8];
#pragma unroll
                for (int n = 0; n < 2; ++n)
#pragma unroll
                    for (int j = 0; j < 4; ++j) { const float g = acc[ai][0][m][n][j], up = acc[ai][1][m][n][j]; h[n * 4 + j] = g * __builtin_amdgcn_rcpf(1.0f + __expf(-g)) * up; }
                u32x4 w; w.x = cvt_pk_bf16(h[0], h[1]); w.y = cvt_pk_bf16(h[2], h[3]); w.z = cvt_pk_bf16(h[4], h[5]); w.w = cvt_pk_bf16(h[6], h[7]);
                *(u32x4*)rowp = w; }
    }
};
struct MoeOrder {
    static constexpr bool GATHER = false, HALFS = false;
    int nN, G, c, nunits; const int* tab;
    __device__ void init(const int* tab_, int nN_, int G_, int c_) { tab = tab_; nN = nN_; G = G_; c = c_; nunits = tab_[0] * nN_; }
    __device__ bool next(int i, Unit& u) const {
        const int L = i * G + c; if (L >= nunits) return false;
        const int q = nunits / NXCD, r = nunits % NXCD, xcd = L % NXCD, off = L / NXCD;
        const int w = (xcd < r ? xcd * (q + 1) : r * (q + 1) + (xcd - r) * q) + off;
        u.pm = w / nN; u.pn = w - u.pm * nN; u.e = tab[1 + u.pm]; return true;
    }
    __device__ __forceinline__ void a_ready(const Unit&) const {}
    __device__ __forceinline__ void done(const Unit&) const {}
};
struct MoeOrderG : MoeOrder { static constexpr bool GATHER = true; const int* tok; };
}
enum { I_X = 0, I_C, I_CTX, I_CCTX, I_MODW, I_MODB, I_NMIXG, I_NFFNG, I_WIN, I_WOUT, I_LCW, I_LCB, I_LWA, I_LBA, I_LWX, I_LBX, I_LLAM,
       I_RMU, I_RWUP, I_RW0, I_RAUP, I_RA0, I_RGUP, I_RKK, I_RKA, I_RRK, I_RLNG, I_RLNB, I_MIB, I_MFB, I_MNG, I_GCW, I_GALOG, I_GDTB, I_GNG,
       I_FWG, I_FWU, I_FWD, I_MROUTER, I_MWG, I_MWU, I_MWD, I_FNG, N_IN };
struct Args { const float* in[N_IN]; float* out; unsigned char* ws; int ph_lo, ph_hi; };
struct Ctx {
    const float* const* in; float* out; unsigned char* ws; LAS unsigned char* lds;
    int tid, lane, wave, G, wg;
};
#define WSP(T, off) ((T*)(C.ws + (off)))

__device__ __forceinline__ int seqrow_raster(int i, int d, int b) {
    if (i < CTXL) { const int p = d ? (CTXL - 1 - i) : i; return T_LAT + b * CTXL + p; }
    const int j = i - CTXL; const int p = d ? (SEQ - 1 - j) : j; return b * SEQ + p;
}
__device__ __forceinline__ int seqrow_cm(int i, int d, int b) {
    if (i < CTXL) { const int p = d ? (CTXL - 1 - i) : i; return T_LAT + b * CTXL + p; }
    const int j = i - CTXL; const int p = d ? (SEQ - 1 - j) : j; return b * SEQ + (p & 63) * 64 + (p >> 6);
}

__device__ __forceinline__ void phase_pre(const Ctx& C) {
    LAS float* sc = (LAS float*)C.lds;
    LAS float* red = sc + 9 * 1024;
    float* modv = WSP(float, WS_MODV);
    bool filled = false;
    for (int it = C.wg; it < DEPTH * 48; it += C.G) {
        if (!filled) {
            for (int i = C.tid; i < 9 * 1024; i += NTHR) { const float v = i < 8192 ? C.in[I_C][i] : C.in[I_CCTX][i - 8192]; sc[i] = siluf_(v); }
            filled = true; __syncthreads();
        }
        const int l = it / 48, jb = it % 48, col = C.tid & 127, kg = C.tid >> 7;
        const float* W = C.in[I_MODW] + (size_t)l * 1024 * 6144 + jb * 128 + col;
        float acc[9];
#pragma unroll
        for (int r = 0; r < 9; ++r) acc[r] = 0.f;
        for (int k = kg * 256; k < kg * 256 + 256; ++k) { const float w = W[(size_t)k * 6144];
#pragma unroll
            for (int r = 0; r < 9; ++r) acc[r] += sc[r * 1024 + k] * w; }
#pragma unroll
        for (int r = 0; r < 9; ++r) red[(kg * 9 + r) * 128 + col] = acc[r];
        __syncthreads();
        for (int i = C.tid; i < 9 * 128; i += NTHR) { const int r = i >> 7, cc = i & 127;
            const float s = red[(0 * 9 + r) * 128 + cc] + red[(1 * 9 + r) * 128 + cc] + red[(2 * 9 + r) * 128 + cc] + red[(3 * 9 + r) * 128 + cc];
            modv[((size_t)l * 9 + r) * 6144 + jb * 128 + cc] = s + C.in[I_MODB][l * 6144 + jb * 128 + cc]; }
        __syncthreads();
    }
}

__device__ __forceinline__ void tr_item(const float* src, size_t ld, int k0, int ns0, bf16* dst, int drow0, int Kd, LAS float* scr, int lane, bool zero) {
    if (!zero) {
#pragma unroll 8
        for (int i = 0; i < 32; ++i) { const int kk = 2 * i + (lane >> 5); scr[kk * 33 + (lane & 31)] = src[(size_t)(k0 + kk) * ld + ns0 + (lane & 31)]; }
    }
    LDS_WAIT(); asm volatile("" ::: "memory");
    const int c = lane & 7;
#pragma unroll
    for (int j = 0; j < 4; ++j) { const int n = (lane >> 3) + 8 * j; const LAS float* s = scr + (8 * c) * 33 + n;
        v4u o; o.x = pk2(s[0 * 33], s[1 * 33]); o.y = pk2(s[2 * 33], s[3 * 33]); o.z = pk2(s[4 * 33], s[5 * 33]); o.w = pk2(s[6 * 33], s[7 * 33]);
        if (zero) o = (v4u){0u, 0u, 0u, 0u};
        *(v4u*)(dst + (size_t)(drow0 + n) * Kd + k0 + 8 * c) = o; }
    LDS_WAIT(); asm volatile("" ::: "memory");
}
__device__ __forceinline__ void convert_small(const Ctx& C, int l) {
    {
        bf16* lw = WSP(bf16, WS_LRUWT);
        for (int k = 0; k < 2 * 2 * 4 * 4096 / (128 * NTHR); ++k) {
            const int e = k * 128 * NTHR + C.wg * NTHR + C.tid;
            if (C.wg < 128) {
            const int i = e & 63, j = (e >> 6) & 63, hd = (e >> 12) & 3, g = (e >> 14) & 1, d = e >> 15;
            const float* src = (g ? C.in[I_LWX] : C.in[I_LWA]) + ((size_t)((l * 2 + d) * 4 + hd) * 64 + i) * 64 + j;
            lw[e] = (bf16)f2bf(*src);
            }
        }
    }
    if (C.wg >= 128 && C.wg < 224) {
        bf16* rw = WSP(bf16, WS_RWT);
        const int e = (C.wg - 128) * NTHR + C.tid;
        if (e < 32768) { const int r = e & 31, ch = (e >> 5) & 255, d = (e >> 13) & 1, isa = e >> 14;
            rw[e] = (bf16)f2bf((isa ? C.in[I_RAUP] : C.in[I_RWUP])[((size_t)(l * 2 + d) * 32 + r) * GW + ch]); }
        else { const int e2 = e - 32768, j = e2 & 63, ch = e2 >> 6; rw[e] = (bf16)f2bf(C.in[I_RGUP][((size_t)l * 64 + j) * GW + ch]); }
    }
}
__device__ __forceinline__ void convert_items(const Ctx& C, int l, int what, int gw, int NGW) {
    LAS float* scr = (LAS float*)(C.lds + C.wave * 8704);
    constexpr int I_IN = 16 * 112, I_OUT = 16 * 32, I_GU = 16 * 176, I_DN = 44 * 32, I_E = 16 * 88 + 22 * 32;
    const bool moe = l & 1; const int li = l >> 1;
    const int lo_it = (what & 1) ? 0 : I_IN, hi_it = (what & 2) ? I_IN + I_OUT + (moe ? NE * I_E : (I_GU + I_DN)) : I_IN;
    bf16* win = WSP(bf16, WS_WIN); bf16* wout = WSP(bf16, WS_WOUT); bf16* wgu = WSP(bf16, WS_WGU); bf16* wdn = WSP(bf16, WS_WDN);
    for (int it = lo_it + gw; it < hi_it; it += NGW) {
        int r = it;
        if (r < I_IN) { const int kb = r / 112, nb = r % 112; tr_item(C.in[I_WIN] + (size_t)l * 1024 * IN_COLS, IN_COLS, 64 * kb, 32 * nb, win, 32 * nb, 1024, scr, C.lane, nb == 111); continue; }
        r -= I_IN;
        if (r < I_OUT) { const int kb = r / 32, nb = r % 32; tr_item(C.in[I_WOUT] + (size_t)l * 1024 * 1024, 1024, 64 * kb, 32 * nb, wout, 32 * nb, 1024, scr, C.lane, false); continue; }
        r -= I_OUT;
        if (!moe) {
            if (r < I_GU) { const int kb = r / 176, nb = r % 176, tile = nb >> 3, q = nb & 7;
                const float* src = (q < 4 ? C.in[I_FWG] : C.in[I_FWU]) + (size_t)li * 1024 * DFF;
                tr_item(src, DFF, 64 * kb, tile * 128 + (q & 3) * 32, wgu, 32 * nb, 1024, scr, C.lane, false); continue; }
            r -= I_GU;
            { const int kb = r / 32, nb = r % 32; tr_item(C.in[I_FWD] + (size_t)li * DFF * 1024, 1024, 64 * kb, 32 * nb, wdn, 32 * nb, DFF, scr, C.lane, false); }
        } else {
            const int e = r / I_E; int rr = r % I_E;
            if (rr < 16 * 88) { const int kb = rr / 88, nb = rr % 88, tile = nb >> 3, q = nb & 7;
                const float* src = (q < 4 ? C.in[I_MWG] : C.in[I_MWU]) + ((size_t)li * NE + e) * 1024 * DFE;
                tr_item(src, DFE, 64 * kb, tile * 128 + (q & 3) * 32, wgu + (size_t)e * 2 * DFE * 1024, 32 * nb, 1024, scr, C.lane, false); continue; }
            rr -= 16 * 88;
            { const int kb = rr / 32, nb = rr % 32; tr_item(C.in[I_MWD] + ((size_t)li * NE + e) * DFE * 1024, 1024, 64 * kb, 32 * nb, wdn + (size_t)e * 1024 * DFE, 32 * nb, DFE, scr, C.lane, false); }
        }
    }
}

template <bool ROUTE>
__device__ __forceinline__ void norm_rows(const Ctx& C, int l, const void* xlat, bool xbf, const float* xctx, const float* gain, int shoff, int scoff, int nrows, int moe_li) {
    const float* modv = WSP(float, WS_MODV) + (size_t)l * 9 * 6144;
    bf16* hb = WSP(bf16, WS_HB);
    const int gw = C.wg * NWAVES + C.wave, NGW = C.G * NWAVES;
    LAS unsigned* lcnt = (LAS unsigned*)(C.lds + 65536);
    unsigned* route = WSP(unsigned, WS_ROUTE);
    if (ROUTE) { if (C.tid < 8) lcnt[C.tid] = 0u; __syncthreads(); }
    f32x4 gv[4];
#pragma unroll
    for (int j = 0; j < 4; ++j) gv[j] = *(const f32x4*)(gain + 4 * C.lane + 256 * j);
    v4u rawn[4], rawm[4]; bool rbfn = false, rbfm = false;
#define NR_LOAD(mm) do { const int m_ = (mm); const bool ic_ = m_ >= T_LAT; rbfn = xbf && !ic_; \
        if (rbfn) { _Pragma("unroll") for (int j = 0; j < 4; ++j) { const v2u t_ = *(const v2u*)((const bf16*)xlat + (size_t)m_ * 1024 + 4 * C.lane + 256 * j); rawn[j] = (v4u){t_.x, t_.y, 0u, 0u}; } } \
        else { const float* xr_ = ic_ ? xctx + (size_t)(m_ - T_LAT) * 1024 : (const float*)xlat + (size_t)m_ * 1024; _Pragma("unroll") for (int j = 0; j < 4; ++j) rawn[j] = *(const v4u*)(xr_ + 4 * C.lane + 256 * j); } } while (0)
    if (gw < nrows) NR_LOAD(gw);
#pragma unroll
    for (int j = 0; j < 4; ++j) rawm[j] = rawn[j];
    rbfm = rbfn;
    if (gw + NGW < nrows) NR_LOAD(gw + NGW);
    for (int m = gw; m < nrows; m += NGW) {
        const bool isctx = m >= T_LAT;
        const float* mv = modv + (size_t)(isctx ? 8 : (m >> 12)) * 6144;
        v4u raw[4]; const bool rbf = rbfm;
#pragma unroll
        for (int j = 0; j < 4; ++j) { raw[j] = rawm[j]; rawm[j] = rawn[j]; }
        rbfm = rbfn;
        if (m + 2 * NGW < nrows) NR_LOAD(m + 2 * NGW);
        f32x4 v[4]; float s = 0.f;
#pragma unroll
        for (int j = 0; j < 4; ++j) { v[j] = rbf ? (f32x4){bflo(raw[j].x), bfhi(raw[j].x), bflo(raw[j].y), bfhi(raw[j].y)} : __builtin_bit_cast(f32x4, raw[j]); s += (v[j].x * v[j].x + v[j].y * v[j].y) + (v[j].z * v[j].z + v[j].w * v[j].w); }
        const float rs = rsqrtf_(wave_sum(s) * (1.0f / 1024.0f) + 1e-6f);
#pragma unroll
        for (int j = 0; j < 4; ++j) { const f32x4 sh = *(const f32x4*)(mv + shoff + 4 * C.lane + 256 * j), scl = *(const f32x4*)(mv + scoff + 4 * C.lane + 256 * j);
            v[j] = (v[j] * rs * gv[j]) * (scl + 1.0f) + sh;
            v2u o; o.x = pk2(v[j].x, v[j].y); o.y = pk2(v[j].z, v[j].w);
            *(v2u*)(hb + (size_t)m * 1024 + 4 * C.lane + 256 * j) = o; }
        if (ROUTE) {
            const float* rt = C.in[I_MROUTER] + (size_t)moe_li * 1024 * NE;
            float lg[8];
#pragma unroll
            for (int e = 0; e < 8; ++e) lg[e] = 0.f;
#pragma unroll
            for (int j = 0; j < 4; ++j)
#pragma unroll
                for (int q = 0; q < 4; ++q) { const int k = 4 * C.lane + 256 * j + q; const f32x4 r0 = *(const f32x4*)(rt + (size_t)k * 8), r1 = *(const f32x4*)(rt + (size_t)k * 8 + 4); const float hv = v[j][q];
                    lg[0] += hv * r0.x; lg[1] += hv * r0.y; lg[2] += hv * r0.z; lg[3] += hv * r0.w; lg[4] += hv * r1.x; lg[5] += hv * r1.y; lg[6] += hv * r1.z; lg[7] += hv * r1.w; }
#pragma unroll
            for (int e = 0; e < 8; ++e) lg[e] = wave_sum(lg[e]);
            int e0 = 0; float l0 = lg[0];
#pragma unroll
            for (int e = 1; e < 8; ++e) if (lg[e] > l0) { l0 = lg[e]; e0 = e; }
            int e1 = (e0 == 0) ? 1 : 0; float l1 = -3.0e38f;
#pragma unroll
            for (int e = 0; e < 8; ++e) if (e != e0 && lg[e] > l1) { l1 = lg[e]; e1 = e; }
            const float w0 = __builtin_amdgcn_rcpf(1.0f + __expf(l1 - l0)), w1 = 1.0f - w0;
            if (C.lane == 0) {
                const unsigned r0 = atomicAdd((unsigned*)&lcnt[e0], 1u), r1 = atomicAdd((unsigned*)&lcnt[e1], 1u);
                v4u a; a.x = (unsigned)e0; a.y = (unsigned)e1; a.z = r0; a.w = r1;
                *(v4u*)(route + (size_t)m * 8) = a;
                v2u b; b.x = __builtin_bit_cast(unsigned, w0); b.y = __builtin_bit_cast(unsigned, w1);
                *(v2u*)(route + (size_t)m * 8 + 4) = b;
            }
        }
    }
#undef NR_LOAD
    if (ROUTE) {
        __syncthreads();
        if (C.tid < 8) { unsigned* gc = WSP(unsigned, WS_CTL) + CW_MOECNT + 64 * moe_li; const unsigned base = atomicAdd(gc + C.tid, lcnt[C.tid]); WSP(unsigned, WS_WGBASE)[C.wg * 8 + C.tid] = base; }
    }
}
#define RAW_BARRIER() do { asm volatile("s_waitcnt lgkmcnt(0)" ::: "memory"); __builtin_amdgcn_s_barrier(); asm volatile("" ::: "memory"); } while (0)
__device__ __forceinline__ void gdn_prep(const Ctx& C, int l, int b, int c) {
    const bf16* P = WSP(const bf16, WS_P); bf16* gq = WSP(bf16, WS_GQ);
    const bool isctx = c < 4; const int p0 = isctx ? c * 64 : (c - 4) * 64; const int Lp = isctx ? CTXL : SEQ;
    const int ch = 4 * C.lane;
    auto rowof = [&](int p) -> int { return isctx ? (T_LAT + b * CTXL + p) : (b * SEQ + (p & 63) * 64 + (p >> 6)); };
    f32x4 cw[4][3], x[4][3];
#pragma unroll
    for (int j = 0; j < 4; ++j)
#pragma unroll
        for (int g = 0; g < 3; ++g) cw[j][g] = *(const f32x4*)(C.in[I_GCW] + ((size_t)l * 4 + j) * 768 + g * 256 + ch);
    const int tb = p0 + C.wave * 8;
    auto ldrow = [&](int p, f32x4 (&dst)[3]) {
        if (p >= 0 && p < Lp) { const bf16* pr = P + (size_t)rowof(p) * PLD + OFF_D + ch;
#pragma unroll
            for (int g = 0; g < 3; ++g) dst[g] = ld4bf(pr + g * 256); }
        else {
#pragma unroll
            for (int g = 0; g < 3; ++g) dst[g] = (f32x4){0.f, 0.f, 0.f, 0.f}; }
    };
    ldrow(tb - 2, x[0]); ldrow(tb - 1, x[1]); ldrow(tb, x[2]);
#pragma unroll
    for (int t = 0; t < 8; ++t) {
        ldrow(tb + t + 1, x[3]);
        bf16* orow = gq + (size_t)rowof(tb + t) * 768 + ch;
#pragma unroll
        for (int g = 0; g < 3; ++g) {
            f32x4 v = cw[0][g] * x[0][g] + cw[1][g] * x[1][g] + cw[2][g] * x[2][g] + cw[3][g] * x[3][g];
            v = (f32x4){siluf_(v.x), siluf_(v.y), siluf_(v.z), siluf_(v.w)};
            if (g < 2) { const float ss = row16_sum((v.x * v.x + v.y * v.y) + (v.z * v.z + v.w * v.w)); v = v * (rsqrtf_(ss + 1e-6f) * (g == 0 ? 0.125f : 1.0f)); }
            st4bf(orow + g * 256, v);
        }
#pragma unroll
        for (int g = 0; g < 3; ++g) { x[0][g] = x[1][g]; x[1][g] = x[2][g]; x[2][g] = x[3][g]; }
    }
}
__device__ __forceinline__ void finish_rows(const Ctx& C, int l, int nrows) {
    const bf16* P = WSP(const bf16, WS_P); bf16* yc = WSP(bf16, WS_HB);
    const bf16* ob = WSP(const bf16, WS_OUTB); const bf16* oc = WSP(const bf16, WS_OUTC); const bf16* od = WSP(const bf16, WS_OUTD);
    const bf16* gg = WSP(const bf16, WS_G); const float* bonus = WSP(const float, WS_BONUS);
    const float* mu = C.in[I_RMU] + (size_t)l * 2 * B_COLS;
    const int gw = C.wg * NWAVES + C.wave, NGW = C.G * NWAVES, lane = C.lane, ch = 4 * lane, hh = lane >> 4;
    const f32x4 lng = *(const f32x4*)(C.in[I_RLNG] + l * GW + ch), lnb = *(const f32x4*)(C.in[I_RLNB] + l * GW + ch);
    const f32x4 mng = *(const f32x4*)(C.in[I_MNG] + l * GW + ch), gng = *(const f32x4*)(C.in[I_GNG] + l * GW + ch);
    const f32x4 mu0 = *(const f32x4*)(mu + 512 + ch), mu1 = *(const f32x4*)(mu + B_COLS + 512 + ch);
    const size_t o2 = (size_t)T_ALL * 256;
#pragma unroll 2
    for (int m = gw; m < nrows; m += NGW) {
        const bool isctx = m >= T_LAT; const int Lp = isctx ? CTXL : SEQ; const int p = isctx ? ((m - T_LAT) & (CTXL - 1)) : (m & (SEQ - 1));
        const f32x4 yb = ld4bf(ob + (size_t)m * 256 + ch) + ld4bf(ob + o2 + (size_t)m * 256 + ch);
        const f32x4 ycv = ld4bf(oc + (size_t)m * 256 + ch) + ld4bf(oc + o2 + (size_t)m * 256 + ch);
        const f32x4 yd = ld4bf(od + (size_t)m * 256 + ch) + ld4bf(od + o2 + (size_t)m * 256 + ch);
        const bf16* pr = P + (size_t)m * PLD;
        const f32x4 vs = ld4bf(WSP(const bf16, WS_RKV) + (size_t)m * 768 + 512 + ch);
        const f32x4 og = ld4bf(pr + OFF_C + 768 + ch), gd = ld4bf(pr + OFF_D + 768 + ch), gr = ld4bf(gg + (size_t)m * 256 + ch);
        const float bn = bonus[(size_t)m * 4 + hh];
        *(v2u*)(yc + (size_t)m * 1024 + ch) = *(const v2u*)(pr + 256 + ch);
        {
            const float mean = row16_sum((yb.x + yb.y) + (yb.z + yb.w)) * (1.0f / 64.0f);
            const f32x4 dl = yb - mean;
            const float var = row16_sum((dl.x * dl.x + dl.y * dl.y) + (dl.z * dl.z + dl.w * dl.w)) * (1.0f / 64.0f);
            const f32x4 yn = dl * rsqrtf_(var + 64e-5f) * lng + lnb;
            st4bf(yc + (size_t)m * 1024 + 256 + ch, (yn + vs * bn) * gr);
        }
        {
            const float ms = row16_sum((ycv.x * ycv.x + ycv.y * ycv.y) + (ycv.z * ycv.z + ycv.w * ycv.w)) * (1.0f / 64.0f);
            const f32x4 sg = (f32x4){sigmoidf_(og.x), sigmoidf_(og.y), sigmoidf_(og.z), sigmoidf_(og.w)};
            st4bf(yc + (size_t)m * 1024 + 512 + ch, ycv * rsqrtf_(ms + 1e-6f) * mng * sg);
        }
        {
            const float ms = row16_sum((yd.x * yd.x + yd.y * yd.y) + (yd.z * yd.z + yd.w * yd.w)) * (1.0f / 64.0f);
            const f32x4 sg = (f32x4){siluf_(gd.x), siluf_(gd.y), siluf_(gd.z), siluf_(gd.w)};
            st4bf(yc + (size_t)m * 1024 + 768 + ch, yd * rsqrtf_(ms + 1e-6f) * gng * sg);
        }
    }
}
typedef bf16x8 fragb;
__device__ __forceinline__ f32x4 mfma16(fragb a, fragb b, f32x4 c) { return __builtin_amdgcn_mfma_f32_16x16x32_bf16(a, b, c, 0, 0, 0); }
__device__ __forceinline__ fragb ld_frag16(const LAS bf16* p) { return *(const LAS fragb*)p; }
__device__ __forceinline__ fragb ld_frag8x2(const LAS bf16* p0, const LAS bf16* p1) {
    const v2u a = *(const LAS v2u*)p0, b = *(const LAS v2u*)p1; v4u r; r.x = a.x; r.y = a.y; r.z = b.x; r.w = b.y; return __builtin_bit_cast(fragb, r); }
__device__ __forceinline__ fragb pack_frag(const f32x4& lo, const f32x4& hi) { v4u r; r.x = pk2(lo.x, lo.y); r.y = pk2(lo.z, lo.w); r.z = pk2(hi.x, hi.y); r.w = pk2(hi.z, hi.w); return __builtin_bit_cast(fragb, r); }
__device__ __forceinline__ float wave_incl_sum(float v, int lane) {
    v += dpp_x<0x111, 0xF, true>(0.f, v); v += dpp_x<0x112, 0xF, true>(0.f, v); v += dpp_x<0x114, 0xF, true>(0.f, v); v += dpp_x<0x118, 0xF, true>(0.f, v);
    v += dpp_x<0x142, 0xA, false>(0.f, v); v += dpp_x<0x143, 0xC, false>(0.f, v);
    return v;
}
__device__ __forceinline__ float wave_incl_max(float v, int lane) {
    const float ninf = -3.0e38f;
    v = fmaxf(v, dpp_x<0x111, 0xF, false>(ninf, v)); v = fmaxf(v, dpp_x<0x112, 0xF, false>(ninf, v)); v = fmaxf(v, dpp_x<0x114, 0xF, false>(ninf, v)); v = fmaxf(v, dpp_x<0x118, 0xF, false>(ninf, v));
    v = fmaxf(v, dpp_x<0x142, 0xA, false>(ninf, v)); v = fmaxf(v, dpp_x<0x143, 0xC, false>(ninf, v));
    return v;
}
constexpr int MP = 72;
__device__ __forceinline__ void mlstm_chunked(const Ctx& C, int l, int idx) {
    const int d = idx >> 5, b = (idx >> 2) & 7, h = idx & 3, lane = C.lane, w = C.wave, l15 = lane & 15, q = lane >> 4;
    const int it = w & 3, vtp = w >> 2;
    constexpr int IMG = 64 * MP * 2, BUFB = 4 * IMG + 1024, CTB = 65 * MP * 2 + 16;
    LAS unsigned char* L0 = C.lds;
    const bf16* P = WSP(const bf16, WS_P); bf16* outc = WSP(bf16, WS_OUTC) + (size_t)d * T_ALL * 256;
    const float ib = C.in[I_MIB][(l * 2 + d) * NH + h], fb = C.in[I_MFB][(l * 2 + d) * NH + h];
    const int tt = C.tid >> 3, part = C.tid & 7;
    for (int i = C.tid; i < 2 * CTB / 4; i += NTHR) ((LAS unsigned*)(L0 + 2 * BUFB))[i] = 0u;
    v4u rq, rk, rv; unsigned short rgi, rgf;
    auto gload = [&](int n) {
        const int row = seqrow_cm(n * 64 + tt, d, b);
        const bf16* pp = P + (size_t)row * PLD + OFF_C + h * 64 + 8 * part;
        rq = *(const v4u*)pp; rk = *(const v4u*)(pp + 256); rv = *(const v4u*)(pp + 512);
        const bf16* pg = P + (size_t)seqrow_cm(n * 64 + lane, d, b) * PLD + OFF_C + 1024 + d * 4 + h;
        rgi = pg[0]; rgf = pg[8];
    };
    auto images = [&](int bufi) {
        LAS unsigned char* B0 = L0 + bufi * BUFB;
        LAS bf16* Qs = (LAS bf16*)B0; LAS bf16* Ks = Qs + 64 * MP; LAS bf16* VT = Ks + 64 * MP; LAS bf16* KTw = VT + 64 * MP; LAS float* vec = (LAS float*)(B0 + 4 * IMG);
        const float li = bf2f(rgi) + ib, lf = -softplusf_(-(bf2f(rgf) + fb));
        const float bc = wave_incl_sum(lf, lane), x = li - bc, cm = wave_incl_max(x, lane);
        const float wl = __expf(x - __shfl(cm, 63)) * 0.125f;
        if (w == 0) { vec[lane] = x; vec[64 + lane] = cm; vec[128 + lane] = bc; }
        const float wmine = __shfl(wl, 8 * w + (lane >> 3));
        *(LAS v4u*)(Qs + tt * MP + 8 * part) = rq; *(LAS v4u*)(Ks + tt * MP + 8 * part) = rk;
        const unsigned vv[4] = {rv.x, rv.y, rv.z, rv.w}, kk[4] = {rk.x, rk.y, rk.z, rk.w};
#pragma unroll
        for (int e = 0; e < 4; ++e) {
            VT[(8 * part + 2 * e) * MP + tt] = (bf16)(vv[e] & 0xffffu); VT[(8 * part + 2 * e + 1) * MP + tt] = (bf16)(vv[e] >> 16);
            KTw[(8 * part + 2 * e) * MP + tt] = (bf16)f2bf1(bflo(kk[e]) * wmine); KTw[(8 * part + 2 * e + 1) * MP + tt] = (bf16)f2bf1(bfhi(kk[e]) * wmine);
        }
    };
    f32x4 Cst[2], nst; float m = 0.f;
    Cst[0] = Cst[1] = nst = (f32x4){0.f, 0.f, 0.f, 0.f};
    const fragb ones = __builtin_bit_cast(fragb, (v4u){0x3F803F80u, 0x3F803F80u, 0x3F803F80u, 0x3F803F80u});
    const f32x4 z4 = (f32x4){0.f, 0.f, 0.f, 0.f};
    gload(0); images(0); gload(1);
#pragma unroll 1
    for (int n = 0; n < NCH; ++n) {
        RAW_BARRIER();
        const LAS unsigned char* B0 = L0 + (n & 1) * BUFB;
        const LAS bf16* Qs = (const LAS bf16*)B0; const LAS bf16* Ks = Qs + 64 * MP; const LAS bf16* VT = Ks + 64 * MP; const LAS bf16* KTw = VT + 64 * MP; const LAS float* vec = (const LAS float*)(B0 + 4 * IMG);
        const LAS bf16* CT = (const LAS bf16*)(L0 + 2 * BUFB + (n & 1) * CTB); LAS bf16* CTn = (LAS bf16*)(L0 + 2 * BUFB + ((n + 1) & 1) * CTB);
        fragb Qf[2]; Qf[0] = ld_frag16(Qs + (16 * it + l15) * MP + 8 * q); Qf[1] = ld_frag16(Qs + (16 * it + l15) * MP + 32 + 8 * q);
        const float cmi = vec[64 + 16 * it + l15]; const int icol = 16 * it + l15;
        f32x4 pt[4];
#pragma unroll
        for (int jt = 0; jt < 4; ++jt) {
            pt[jt] = z4;
            if (jt <= it) {
                const fragb k0 = ld_frag16(Ks + (16 * jt + l15) * MP + 8 * q), k1 = ld_frag16(Ks + (16 * jt + l15) * MP + 32 + 8 * q);
                f32x4 st = mfma16(k0, Qf[0], z4); st = mfma16(k1, Qf[1], st);
                const f32x4 xj = *(const LAS f32x4*)(vec + 16 * jt + 4 * q);
#pragma unroll
                for (int r = 0; r < 4; ++r) { const int j = 16 * jt + 4 * q + r; pt[jt][r] = (j <= icol) ? st[r] * __expf(xj[r] - cmi) * 0.125f : 0.f; }
            }
        }
        fragb Pf[2]; Pf[0] = pack_frag(pt[0], pt[1]); Pf[1] = pack_frag(pt[2], pt[3]);
        fragb Vf[2][2];
#pragma unroll
        for (int v2 = 0; v2 < 2; ++v2)
#pragma unroll
            for (int s = 0; s < 2; ++s) { const LAS bf16* vr = VT + (16 * (2 * vtp + v2) + l15) * MP + 32 * s + 4 * q; Vf[v2][s] = ld_frag8x2(vr, vr + 16); }
        f32x4 Aacc[2], R[2], as, dn;
        as = mfma16(Pf[0], ones, z4); if (it >= 2) as = mfma16(Pf[1], ones, as);
        const fragb nf0 = ld_frag16(CT + 64 * MP + 8 * q), nf1 = ld_frag16(CT + 64 * MP + 32 + 8 * q);
        dn = mfma16(Qf[0], nf0, z4); dn = mfma16(Qf[1], nf1, dn);
#pragma unroll
        for (int v2 = 0; v2 < 2; ++v2) {
            Aacc[v2] = mfma16(Pf[0], Vf[v2][0], z4); if (it >= 2) Aacc[v2] = mfma16(Pf[1], Vf[v2][1], Aacc[v2]);
            const LAS bf16* cr = CT + (16 * (2 * vtp + v2) + l15) * MP + 8 * q;
            R[v2] = mfma16(Qf[0], ld_frag16(cr), z4); R[v2] = mfma16(Qf[1], ld_frag16(cr + 32), R[v2]);
        }
        {
            const f32x4 bi = *(const LAS f32x4*)(vec + 128 + 16 * it + 4 * q), cmr = *(const LAS f32x4*)(vec + 64 + 16 * it + 4 * q);
#pragma unroll
            for (int r = 0; r < 4; ++r) {
                const float mi = bi[r] + cmr[r], minter = bi[r] + m, mt = fmaxf(minter, mi), e1 = __expf(mi - mt), e2 = __expf(minter - mt);
                const float den = e1 * as[r] + e2 * dn[r]; const float inv = __builtin_amdgcn_rcpf(fmaxf(fabsf(den), __expf(-mt)));
                const int row = seqrow_cm(n * 64 + 16 * it + 4 * q + r, d, b);
#pragma unroll
                for (int v2 = 0; v2 < 2; ++v2) outc[(size_t)row * 256 + h * 64 + 16 * (2 * vtp + v2) + l15] = (bf16)f2bf1((e1 * Aacc[v2][r] + e2 * R[v2][r]) * inv);
            }
        }
        {
            const LAS bf16* kr = KTw + (16 * it + l15) * MP + 4 * q;
            const fragb kt0 = ld_frag8x2(kr, kr + 16), kt1 = ld_frag8x2(kr + 32, kr + 48);
            const float bL = vec[128 + 63], mloc = bL + vec[64 + 63];
            const float mnew = fmaxf(bL + m, mloc), wp = __expf(bL + m - mnew), wn = __expf(mloc - mnew);
            f32x4 gk = mfma16(kt0, ones, z4); gk = mfma16(kt1, ones, gk);
            nst = nst * wp + gk * wn;
#pragma unroll
            for (int v2 = 0; v2 < 2; ++v2) {
                f32x4 G = mfma16(kt0, Vf[v2][0], z4); G = mfma16(kt1, Vf[v2][1], G);
                Cst[v2] = Cst[v2] * wp + G * wn;
                v2u o; o.x = pk2(Cst[v2].x, Cst[v2].y); o.y = pk2(Cst[v2].z, Cst[v2].w);
                *(LAS v2u*)(CTn + (16 * (2 * vtp + v2) + l15) * MP + 16 * it + 4 * q) = o;
            }
            if (vtp == 0 && l15 == 0) { v2u o; o.x = pk2(nst.x, nst.y); o.y = pk2(nst.z, nst.w); *(LAS v2u*)(CTn + 64 * MP + 16 * it + 4 * q) = o; }
            m = mnew;
        }
        if (n + 1 < NCH) { images((n + 1) & 1); if (n + 2 < NCH) gload(n + 2); }
    }
    __syncthreads();
}
__device__ __forceinline__ int fwd_row_cm(int b, int c, int t) { return c < 4 ? (T_LAT + b * CTXL + c * 64 + t) : (b * SEQ + t * 64 + (c - 4)); }
__device__ __forceinline__ bf16* blob_row(const Ctx& C, int d, int isw, int b, int c, int h, int r) {
    const int row = fwd_row_cm(b, c, r);
    if (d == 1 && isw) return WSP(bf16, WS_OUTD) + ((size_t)T_ALL + row) * 256 + h * 64;
    return WSP(bf16, WS_P) + (size_t)row * PLD + OFF_D + (d * 2 + isw) * 256 + h * 64;
}
constexpr int LP = 68;
__device__ __forceinline__ void blocked_solve(const LAS bf16* Ln, const LAS bf16* TinvP, LAS unsigned char* XTw, f32x4 (&acc)[4][4], int l15, int q) {
    const f32x4 z4 = (f32x4){0.f, 0.f, 0.f, 0.f};
#pragma unroll
    for (int I = 0; I < 4; ++I) {
        const fragb Af = *(const LAS fragb*)(TinvP + (I * 16 + l15) * 32 + 8 * q);
        fragb A0, A1;
        if (I >= 1) A0 = ld_frag16(Ln + (16 * I + l15) * MP + 8 * q);
        if (I == 3) A1 = ld_frag16(Ln + (16 * I + l15) * MP + 32 + 8 * q);
#pragma unroll
        for (int nt = 0; nt < 4; ++nt) {
            const int crow = 16 * nt + l15; LAS unsigned char* xr = XTw + crow * 128;
            f32x4 a = acc[I][nt];
            if (I >= 1) a = mfma16(A0, *(const LAS fragb*)(xr + ((q ^ (crow & 7)) << 4)), a);
            if (I == 3) a = mfma16(A1, *(const LAS fragb*)(xr + (((4 + q) ^ (crow & 7)) << 4)), a);
            v4u bw; bw.x = pk2(a.x, a.y); bw.y = pk2(a.z, a.w); bw.z = 0u; bw.w = 0u;
            const f32x4 x = mfma16(Af, __builtin_bit_cast(fragb, bw), z4);
            acc[I][nt] = x;
            v2u o; o.x = pk2(x.x, x.y); o.y = pk2(x.z, x.w);
            *(LAS v2u*)(xr + (((2 * I + (q >> 1)) ^ (crow & 7)) << 4) + (q & 1) * 8) = o;
        }
    }
}
__device__ __forceinline__ void diag_inverses(const LAS bf16* Ln, LAS bf16* TinvP, int lane) {
    const int blk = lane >> 4, c = lane & 15;
    float x[16];
#pragma unroll
    for (int i = 0; i < 16; ++i) {
        const LAS bf16* lr = Ln + (16 * blk + i) * MP + 16 * blk;
        const v4u r0 = *(const LAS v4u*)lr, r1 = *(const LAS v4u*)(lr + 8);
        const unsigned rw[8] = {r0.x, r0.y, r0.z, r0.w, r1.x, r1.y, r1.z, r1.w};
        float s = (i == c) ? 1.0f : 0.0f;
#pragma unroll
        for (int j = 0; j < i; ++j) s += ((j & 1) ? bfhi(rw[j >> 1]) : bflo(rw[j >> 1])) * x[j];
        x[i] = s;
        TinvP[(blk * 16 + i) * 32 + 8 * (c >> 2) + (c & 3)] = (bf16)f2bf1(s);
    }
}
__device__ __forceinline__ void gdn_solve_item(const Ctx& C, int l, int item) {
    const int lane = C.lane, w = C.wave, pw = w & 1, pi = w >> 1, l15 = lane & 15, q = lane >> 4;
    LAS unsigned char* B0 = C.lds + pi * 31744;
    LAS bf16* Ln = (LAS bf16*)B0;
    LAS bf16* TinvP = (LAS bf16*)(B0 + 9216);
    LAS float* vec = (LAS float*)(B0 + 13312);
    LAS unsigned char* XT = B0 + 13824;
    LAS bf16* Ks = (LAS bf16*)XT;
    const bf16* P = WSP(const bf16, WS_P); const bf16* gq = WSP(const bf16, WS_GQ);
    const int u = item >> 1, d = item & 1;
    const int c = u % NCH, h = (u / NCH) & 3, b = u / (NCH * NH);
    const int n = d ? (c < 4 ? 3 - c : 71 - c) : c;
    const float aexp = __expf(C.in[I_GALOG][(l * 2 + d) * NH + h]), dtb = C.in[I_GDTB][(l * 2 + d) * NH + h];
    const int rowl = seqrow_cm(n * 64 + lane, d, b);
    const bf16* pg = P + (size_t)rowl * PLD + OFF_D + 1024 + d * 4 + h;
    const float la = -aexp * softplusf_(bf2f(pg[0]) + dtb), beta = sigmoidf_(bf2f(pg[8]));
    const float gam = wave_incl_sum(la, lane);
    if (pw == 0) { vec[lane] = beta; vec[64 + lane] = gam; }
#pragma unroll
    for (int r = 0; r < 4; ++r) { const int idx = pw * 64 + lane + 128 * r, t = idx >> 3, part = idx & 7;
        *(LAS v4u*)(Ks + t * MP + 8 * part) = *(const v4u*)(gq + (size_t)seqrow_cm(n * 64 + t, d, b) * 768 + 256 + h * 64 + 8 * part); }
    { LAS v4u* tz = (LAS v4u*)(B0 + 9216) + (pw * 64 + lane) * 2; tz[0] = (v4u){0u, 0u, 0u, 0u}; tz[1] = (v4u){0u, 0u, 0u, 0u}; }
    f32x4 acc[4][4];
    if (pw == 0) {
#pragma unroll
        for (int I = 0; I < 4; ++I)
#pragma unroll
            for (int r = 0; r < 4; ++r) { const bf16* vr = gq + (size_t)seqrow_cm(n * 64 + 16 * I + 4 * q + r, d, b) * 768 + 512 + h * 64 + l15;
#pragma unroll
                for (int nt = 0; nt < 4; ++nt) acc[I][nt][r] = bf2f(vr[16 * nt]); }
    }
    __syncthreads();
    {
        int tix = 0;
#pragma unroll
        for (int it = 0; it < 4; ++it)
#pragma unroll
            for (int jt = 0; jt < 4; ++jt, ++tix) if ((tix & 1) == pw) {
                f32x4 t4 = (f32x4){0.f, 0.f, 0.f, 0.f};
                if (jt <= it) {
#pragma unroll
                    for (int s = 0; s < 2; ++s) t4 = mfma16(ld_frag16(Ks + (16 * it + l15) * MP + 32 * s + 8 * q), ld_frag16(Ks + (16 * jt + l15) * MP + 32 * s + 8 * q), t4);
                    const float gj = vec[64 + 16 * jt + l15];
                    const f32x4 bi = *(const LAS f32x4*)(vec + 16 * it + 4 * q), gi = *(const LAS f32x4*)(vec + 64 + 16 * it + 4 * q);
#pragma unroll
                    for (int r = 0; r < 4; ++r) { const int i = 16 * it + 4 * q + r, j = 16 * jt + l15; t4[r] = (j < i) ? -(bi[r] * t4[r] * __expf(gi[r] - gj)) : 0.f; }
                }
#pragma unroll
                for (int r = 0; r < 4; ++r) Ln[(16 * it + 4 * q + r) * MP + 16 * jt + l15] = (bf16)f2bf1(t4[r]);
            }
    }
    {
#pragma unroll
        for (int I = 0; I < 4; ++I) {
            const f32x4 bi = *(const LAS f32x4*)(vec + 16 * I + 4 * q), gi = *(const LAS f32x4*)(vec + 64 + 16 * I + 4 * q);
#pragma unroll
            for (int r = 0; r < 4; ++r) { const float sc = pw ? bi[r] * __expf(gi[r]) : bi[r];
#pragma unroll
                for (int nt = 0; nt < 4; ++nt) acc[I][nt][r] = (pw ? bf2f(Ks[(16 * I + 4 * q + r) * MP + 16 * nt + l15]) : acc[I][nt][r]) * sc; }
        }
    }
    __syncthreads();
    if (pw == 0) diag_inverses(Ln, TinvP, lane);
    LAS unsigned char* XTw = XT + pw * 8192;
    { LAS v4u* xz = (LAS v4u*)(XTw + lane * 128);
#pragma unroll
        for (int g = 0; g < 8; ++g) xz[g] = (v4u){0u, 0u, 0u, 0u}; }
    __syncthreads();
    blocked_solve(Ln, TinvP, XTw, acc, l15, q);
    {
        bf16* dst = blob_row(C, d, pw, b, c, h, lane);
        const LAS unsigned char* xr = XTw + lane * 128;
#pragma unroll
        for (int g = 0; g < 8; ++g) *(v4u*)(dst + 8 * g) = *(const LAS v4u*)(xr + ((g ^ (lane & 7)) << 4));
    }
    __syncthreads();
}

template <bool DRY>
__device__ __forceinline__ void gdn_chunked(const Ctx& C, int l, int idx) {
    const int d = idx >> 5, b = (idx >> 2) & 7, h = idx & 3, lane = C.lane, w = C.wave, l15 = lane & 15, q = lane >> 4;
    const int it = w & 3, vtp = w >> 2;
    constexpr int IMG = 64 * MP * 2, BUFB = 5 * IMG + 512;
    LAS unsigned char* L0 = C.lds;
    LAS bf16* VnT = (LAS bf16*)(L0 + 2 * BUFB + 2 * IMG);
    const bf16* P = WSP(const bf16, WS_P); const bf16* gq = WSP(const bf16, WS_GQ); bf16* outd = WSP(bf16, WS_OUTD) + (size_t)d * T_ALL * 256;
    const float aexp = __expf(C.in[I_GALOG][(l * 2 + d) * NH + h]), dtb = C.in[I_GDTB][(l * 2 + d) * NH + h];
    const int tt = C.tid >> 3, part = C.tid & 7;
    for (int i = C.tid; i < 2 * IMG / 4; i += NTHR) ((LAS unsigned*)(L0 + 2 * BUFB))[i] = 0u;
    v4u rq, rk, ru, rw; unsigned short rga;
    auto gload = [&](int n) {
        const int c = d ? (n < 4 ? 3 - n : 71 - n) : n;
        const bf16* pp = gq + (size_t)seqrow_cm(n * 64 + tt, d, b) * 768 + h * 64 + 8 * part;
        rq = *(const v4u*)pp; rk = *(const v4u*)(pp + 256);
        ru = *(const v4u*)(blob_row(C, d, 0, b, c, h, tt) + 8 * part); rw = *(const v4u*)(blob_row(C, d, 1, b, c, h, tt) + 8 * part);
        rga = P[(size_t)seqrow_cm(n * 64 + lane, d, b) * PLD + OFF_D + 1024 + d * 4 + h];
    };
    auto images = [&](int bufi) {
        LAS unsigned char* B0 = L0 + bufi * BUFB;
        LAS bf16* Qs = (LAS bf16*)B0; LAS bf16* Ks = Qs + 64 * MP; LAS bf16* KdT = Ks + 64 * MP; LAS bf16* Wi = KdT + 64 * MP; LAS bf16* UT = Wi + 64 * MP; LAS float* vec = (LAS float*)(B0 + 5 * IMG);
        const float la = -aexp * softplusf_(bf2f(rga) + dtb);
        const float gam = wave_incl_sum(la, lane);
        if (w == 0) vec[lane] = gam;
        const float kd = __expf(__shfl(gam, 63) - gam);
        const float kmine = __shfl(kd, 8 * w + (lane >> 3));
        *(LAS v4u*)(Qs + tt * MP + 8 * part) = rq; *(LAS v4u*)(Ks + tt * MP + 8 * part) = rk; *(LAS v4u*)(UT + tt * MP + 8 * part) = ru;
        const unsigned kk[4] = {rk.x, rk.y, rk.z, rk.w}, ww[4] = {rw.x, rw.y, rw.z, rw.w};
#pragma unroll
        for (int e = 0; e < 4; ++e) {
            KdT[(8 * part + 2 * e) * MP + tt] = (bf16)f2bf1(bflo(kk[e]) * kmine); KdT[(8 * part + 2 * e + 1) * MP + tt] = (bf16)f2bf1(bfhi(kk[e]) * kmine);
            Wi[(8 * part + 2 * e) * MP + tt] = (bf16)(ww[e] & 0xffffu); Wi[(8 * part + 2 * e + 1) * MP + tt] = (bf16)(ww[e] >> 16);
        }
    };
    f32x4 Sst[2]; Sst[0] = Sst[1] = (f32x4){0.f, 0.f, 0.f, 0.f};
    const f32x4 z4 = (f32x4){0.f, 0.f, 0.f, 0.f};
    gload(0); images(0); gload(1);
#pragma unroll 1
    for (int n = 0; n < NCH; ++n) {
        RAW_BARRIER();
        const LAS unsigned char* B0 = L0 + (n & 1) * BUFB;
        const LAS bf16* Qs = (const LAS bf16*)B0; const LAS bf16* Ks = Qs + 64 * MP; const LAS bf16* KdT = Ks + 64 * MP; const LAS bf16* Wi = KdT + 64 * MP; const LAS bf16* UT = Wi + 64 * MP; const LAS float* vec = (const LAS float*)(B0 + 5 * IMG);
        const LAS bf16* ST = (const LAS bf16*)(L0 + 2 * BUFB + (n & 1) * IMG); LAS bf16* STn = (LAS bf16*)(L0 + 2 * BUFB + ((n + 1) & 1) * IMG);
        fragb Qf[2]; Qf[0] = ld_frag16(Qs + (16 * it + l15) * MP + 8 * q); Qf[1] = ld_frag16(Qs + (16 * it + l15) * MP + 32 + 8 * q);
        const float gcol = vec[16 * it + l15]; const int icol = 16 * it + l15;
        f32x4 pt[4];
#pragma unroll
        for (int jt = 0; jt < 4; ++jt) {
            pt[jt] = z4;
            if (jt <= it) {
                const fragb k0 = ld_frag16(Ks + (16 * jt + l15) * MP + 8 * q), k1 = ld_frag16(Ks + (16 * jt + l15) * MP + 32 + 8 * q);
                f32x4 st = mfma16(k0, Qf[0], z4); st = mfma16(k1, Qf[1], st);
                const f32x4 gj = *(const LAS f32x4*)(vec + 16 * jt + 4 * q);
#pragma unroll
                for (int r = 0; r < 4; ++r) { const int j = 16 * jt + 4 * q + r; pt[jt][r] = (j <= icol) ? st[r] * __expf(gcol - gj[r]) : 0.f; }
            }
        }
        fragb Pf[2]; Pf[0] = pack_frag(pt[0], pt[1]); Pf[1] = pack_frag(pt[2], pt[3]);
        const fragb Wf0 = ld_frag16(Wi + (16 * it + l15) * MP + 8 * q), Wf1 = ld_frag16(Wi + (16 * it + l15) * MP + 32 + 8 * q);
        f32x4 Ro[2];
#pragma unroll
        for (int v2 = 0; v2 < 2; ++v2) {
            const int vrow = 16 * (2 * vtp + v2) + l15;
            const fragb s0 = ld_frag16(ST + vrow * MP + 8 * q), s1 = ld_frag16(ST + vrow * MP + 32 + 8 * q);
            f32x4 ws = mfma16(Wf0, s0, z4); ws = mfma16(Wf1, s1, ws);
            Ro[v2] = mfma16(Qf[0], s0, z4); Ro[v2] = mfma16(Qf[1], s1, Ro[v2]);
            const v2u ur = *(const LAS v2u*)(UT + vrow * MP + 16 * it + 4 * q);
            v2u o; o.x = pk2(bflo(ur.x) - ws.x, bfhi(ur.x) - ws.y); o.y = pk2(bflo(ur.y) - ws.z, bfhi(ur.y) - ws.w);
            *(LAS v2u*)(VnT + vrow * MP + 16 * it + 4 * q) = o;
        }
        RAW_BARRIER();
        {
            const f32x4 gi = *(const LAS f32x4*)(vec + 16 * it + 4 * q);
            const float gl = __expf(vec[63]);
            const LAS bf16* kr = KdT + (16 * it + l15) * MP + 4 * q;
            const fragb kt0 = ld_frag8x2(kr, kr + 16), kt1 = ld_frag8x2(kr + 32, kr + 48);
#pragma unroll
            for (int v2 = 0; v2 < 2; ++v2) {
                const int vrow = 16 * (2 * vtp + v2) + l15;
                const LAS bf16* vr = VnT + vrow * MP + 4 * q;
                const fragb n0 = ld_frag8x2(vr, vr + 16), n1 = ld_frag8x2(vr + 32, vr + 48);
                f32x4 o = mfma16(Pf[0], n0, z4); if (it >= 2) o = mfma16(Pf[1], n1, o);
#pragma unroll
                for (int r = 0; r < 4; ++r) { const int row = seqrow_cm(n * 64 + 16 * it + 4 * q + r, d, b);
                    if (!DRY) outd[(size_t)row * 256 + h * 64 + vrow] = (bf16)f2bf1(o[r] + __expf(gi[r]) * Ro[v2][r]); }
                f32x4 ns = mfma16(kt0, n0, z4); ns = mfma16(kt1, n1, ns);
                Sst[v2] = Sst[v2] * gl + ns;
                v2u so; so.x = pk2(Sst[v2].x, Sst[v2].y); so.y = pk2(Sst[v2].z, Sst[v2].w);
                *(LAS v2u*)(STn + vrow * MP + 16 * it + 4 * q) = so;
            }
        }
        if (n + 1 < NCH) { images((n + 1) & 1); if (n + 2 < NCH) gload(n + 2); }
    }
    __syncthreads();
}
constexpr int UP = 264;
template <int CTRL> __device__ __forceinline__ float dpp_keep(float oldv, float v) { return __builtin_bit_cast(float, __builtin_amdgcn_update_dpp(__builtin_bit_cast(int, oldv), __builtin_bit_cast(int, v), CTRL, 0xF, 0xF, false)); }
template <bool REV> __device__ __forceinline__ void scan16(float& A, float& B) {
#define LRU_STEP(S) { const float Ap = dpp_keep<(REV ? 0x100 : 0x110) | S>(1.0f, A), Bp = dpp_keep<(REV ? 0x100 : 0x110) | S>(0.0f, B); B = A * Bp + B; A = A * Ap; }
    LRU_STEP(1) LRU_STEP(2) LRU_STEP(4) LRU_STEP(8)
#undef LRU_STEP
}
constexpr int UPC = 72;
__device__ __forceinline__ int lru_chunk_of(int d, int k) { return d ? (k < 4 ? 3 - k : NCH + 3 - k) : k; }
template <bool REV>
__device__ __forceinline__ void lru_tiles(const LAS bf16* Ud, int th, int mt, int lane, const fragb (&Wa)[2], const fragb (&Wx)[2], const f32x4& ba, const f32x4& bx, const f32x4& sp4,
                                          f32x4 (&Ac)[2], f32x4 (&Hl)[2], f32x4& Atot, f32x4& hend) {
    const int l15 = lane & 15, q = lane >> 4, edge = (lane & 48) | (REV ? 0 : 15);
    const f32x4 z4 = (f32x4){0.f, 0.f, 0.f, 0.f};
    f32x4 tA = z4, tB = z4;
#pragma unroll
    for (int i = 0; i < 2; ++i) {
        const int nt = REV ? 3 - (2 * th + i) : 2 * th + i;
        const LAS bf16* urow = Ud + (16 * nt + l15) * UPC;
        const fragb Uf0 = ld_frag16(urow + 8 * q), Uf1 = ld_frag16(urow + 32 + 8 * q);
        f32x4 aa = mfma16(Wa[0], Uf0, z4); aa = mfma16(Wa[1], Uf1, aa);
        f32x4 ax = mfma16(Wx[0], Uf0, z4); ax = mfma16(Wx[1], Uf1, ax);
        const v2u ur = *(const LAS v2u*)(urow + 16 * mt + 4 * q);
        const f32x4 u4 = (f32x4){bflo(ur.x), bfhi(ur.x), bflo(ur.y), bfhi(ur.y)};
        f32x4 la, iu, A, Bv;
#pragma unroll
        for (int r = 0; r < 4; ++r) { const float rg = sigmoidf_(aa[r] + ba[r]); iu[r] = sigmoidf_(ax[r] + bx[r]) * u4[r]; la[r] = -sp4[r] * rg; }
        const bool sm_ = la[0] > -0.15f && la[1] > -0.15f && la[2] > -0.15f && la[3] > -0.15f;
        if (__builtin_amdgcn_ballot_w64(!sm_) == 0ull) {
#pragma unroll
            for (int r = 0; r < 4; ++r) { const float x = la[r], p = x * (1.0f + x * (0.5f + x * (0.16666667f + x * (0.041666668f + x * (0.0083333338f + x * 0.0013888889f)))));
                A[r] = 1.0f + p; Bv[r] = __builtin_amdgcn_sqrtf(-p * (2.0f + p)) * iu[r]; }
        } else {
#pragma unroll
            for (int r = 0; r < 4; ++r) { A[r] = __expf(la[r]); Bv[r] = __builtin_amdgcn_sqrtf(-expm1f_(2.0f * la[r])) * iu[r]; }
        }
#pragma unroll
        for (int r = 0; r < 4; ++r) { float a_ = A[r], b_ = Bv[r]; scan16<REV>(a_, b_); A[r] = a_; Bv[r] = b_; }
        if (i == 0) {
            Ac[0] = A; Hl[0] = Bv;
#pragma unroll
            for (int r = 0; r < 4; ++r) { tA[r] = __shfl(A[r], edge); tB[r] = __shfl(Bv[r], edge); }
        } else {
            Ac[1] = A * tA; Hl[1] = A * tB + Bv;
#pragma unroll
            for (int r = 0; r < 4; ++r) { Atot[r] = __shfl(Ac[1][r], edge); hend[r] = __shfl(Hl[1][r], edge); }
        }
    }
}
__device__ __forceinline__ void lru_chain(const Ctx& C, int l, int id) {
    const int b = id >> 3, hd = (id >> 1) & 3, chalf = id & 1;
    const int lane = C.lane, l15 = lane & 15, q = lane >> 4;
    const int d = C.wave >> 2, mtl = (C.wave >> 1) & 1, th = C.wave & 1, mt = chalf * 2 + mtl;
    LAS bf16* U = (LAS bf16*)C.lds;
    LAS float* XCH = (LAS float*)(C.lds + 2 * 2 * 64 * UPC * 2);
    bf16* P = WSP(bf16, WS_P); bf16* LH = WSP(bf16, WS_LRUH) + (size_t)id * NSTEP * 32;
    const int cd = C.tid >> 8, cj = C.tid & 63, ctq = (C.tid >> 6) & 3;
    const float* cw = C.in[I_LCW] + (size_t)l * 4 * GW + hd * 64 + cj; const float w0 = cw[0], w1 = cw[GW], w2 = cw[2 * GW], w3 = cw[3 * GW], cb = C.in[I_LCB][l * GW + hd * 64 + cj];
    const bf16* wt = WSP(const bf16, WS_LRUWT) + (size_t)((d * 2 + 0) * 4 + hd) * 4096;
    fragb Wa[2], Wx[2];
#pragma unroll
    for (int ks = 0; ks < 2; ++ks) { Wa[ks] = *(const fragb*)(wt + (16 * mt + l15) * 64 + 32 * ks + 8 * q); Wx[ks] = *(const fragb*)(wt + 4 * 4096 + (16 * mt + l15) * 64 + 32 * ks + 8 * q); }
    const int ch0 = hd * 64 + 16 * mt + 4 * q;
    const f32x4 ba = *(const f32x4*)(C.in[I_LBA] + (l * 2 + d) * GW + ch0), bx = *(const f32x4*)(C.in[I_LBX] + (l * 2 + d) * GW + ch0), lam = *(const f32x4*)(C.in[I_LLAM] + (l * 2 + d) * GW + ch0);
    f32x4 sp4;
#pragma unroll
    for (int r = 0; r < 4; ++r) sp4[r] = 8.0f * softplusf_(-lam[r]);
    f32x4 s = (f32x4){0.f, 0.f, 0.f, 0.f};
    unsigned short xr[19];
#define LRU_LOADX(kk) do { const int c_ = lru_chunk_of(cd, (kk)); const bool ic_ = c_ < 4; const int p0_ = (ic_ ? c_ * 64 : (c_ - 4) * 64) + ctq * 16 - 2, Lp_ = ic_ ? CTXL : SEQ; \
        const bf16* xp_ = P + (size_t)(ic_ ? T_LAT + b * CTXL : b * SEQ) * PLD + hd * 64 + cj; \
        _Pragma("unroll") for (int i_ = 0; i_ < 19; ++i_) { const int p_ = p0_ + i_; xr[i_] = (p_ >= 0 && p_ < Lp_) ? xp_[(size_t)p_ * PLD] : (unsigned short)0; } } while (0)
#define LRU_CONV(kk) do { LAS bf16* uo_ = U + ((((kk) & 1) * 2 + cd) * 64 + ctq * 16) * UPC + cj; \
        _Pragma("unroll") for (int t_ = 0; t_ < 16; ++t_) uo_[t_ * UPC] = (bf16)f2bf1(w0 * bf2f(xr[t_]) + w1 * bf2f(xr[t_ + 1]) + w2 * bf2f(xr[t_ + 2]) + w3 * bf2f(xr[t_ + 3]) + cb); } while (0)
    LRU_LOADX(0); LRU_CONV(0); LRU_LOADX(1);
    __syncthreads();
#pragma unroll 1
    for (int k = 0; k < NCH; ++k) {
        if (k + 1 < NCH) { LRU_CONV(k + 1); if (k + 2 < NCH) LRU_LOADX(k + 2); }
        const int c = lru_chunk_of(d, k); const bool second = lru_chunk_of(1 - d, c) < k;
        const bool ic = c < 4; const size_t row0 = (size_t)(ic ? T_LAT + b * CTXL + c * 64 : b * SEQ + (c - 4) * 64);
        const bool late = (k == 2) || (k == 36);
        int tok[2]; v2u gv[2], fv[2];
#pragma unroll
        for (int i = 0; i < 2; ++i) { const int nt = d ? 3 - (2 * th + i) : 2 * th + i; tok[i] = 16 * nt + l15;
            if (second && !late) { gv[i] = *(const v2u*)(P + (row0 + tok[i]) * PLD + 256 + ch0); fv[i] = *(const v2u*)(LH + (size_t)(c * 64 + tok[i]) * 32 + 16 * mtl + 4 * q); } }
        f32x4 Ac[2], Hl[2], Atot, hend;
        const LAS bf16* Ud = U + ((k & 1) * 2 + d) * 64 * UPC;
        if (d) lru_tiles<true>(Ud, th, mt, lane, Wa, Wx, ba, bx, sp4, Ac, Hl, Atot, hend); else lru_tiles<false>(Ud, th, mt, lane, Wa, Wx, ba, bx, sp4, Ac, Hl, Atot, hend);
        LAS float* xw = XCH + (((((k & 1) * 2 + d) * 2 + mtl) * 2 + th) * 4 + q) * 8;
        if (l15 == (d ? 0 : 15)) { *(LAS f32x4*)xw = Atot; *(LAS f32x4*)(xw + 4) = hend; }
        if (late) VM_WAIT();
        RAW_BARRIER();
        if (second && late) {
#pragma unroll
            for (int i = 0; i < 2; ++i) { gv[i] = *(const v2u*)(P + (row0 + tok[i]) * PLD + 256 + ch0); fv[i] = *(const v2u*)(LH + (size_t)(c * 64 + tok[i]) * 32 + 16 * mtl + 4 * q); }
        }
        const LAS float* xr0 = XCH + (((((k & 1) * 2 + d) * 2 + mtl) * 2 + 0) * 4 + q) * 8;
        const f32x4 A0 = *(const LAS f32x4*)xr0, h0 = *(const LAS f32x4*)(xr0 + 4), A1 = *(const LAS f32x4*)(xr0 + 32), h1 = *(const LAS f32x4*)(xr0 + 36);
        const f32x4 mid = A0 * s + h0, hin = th ? mid : s;
        s = A1 * mid + h1;
#pragma unroll
        for (int i = 0; i < 2; ++i) {
            const f32x4 h = Ac[i] * hin + Hl[i];
            if (!second) { v2u o; o.x = pk2(h.x, h.y); o.y = pk2(h.z, h.w); *(v2u*)(LH + (size_t)(c * 64 + tok[i]) * 32 + 16 * mtl + 4 * q) = o; }
            else {
                const f32x4 g = (f32x4){bflo(gv[i].x), bfhi(gv[i].x), bflo(gv[i].y), bfhi(gv[i].y)};
                f32x4 y = (f32x4){h.x + bflo(fv[i].x), h.y + bfhi(fv[i].x), h.z + bflo(fv[i].y), h.w + bfhi(fv[i].y)};
                y.x *= gelu_tanh(g.x); y.y *= gelu_tanh(g.y); y.z *= gelu_tanh(g.z); y.w *= gelu_tanh(g.w);
                st4bf(P + (row0 + tok[i]) * PLD + 256 + ch0, y);
            }
        }
    }
#undef LRU_LOADX
#undef LRU_CONV
    __syncthreads();
}
constexpr int RP = 264;
__device__ __forceinline__ void rwkv_prep2(const Ctx& C, int l, int b, int c) {
    LAS bf16* RS = (LAS bf16*)C.lds;
    LAS bf16* KS = RS + 64 * RP;
    LAS bf16* XW = KS + 64 * RP;
    LAS bf16* XA = XW + 64 * MP;
    LAS bf16* XG = XA + 64 * MP;
    const bf16* P = WSP(const bf16, WS_P);
    const bool isctx = c < 4; const int p0 = isctx ? c * 64 : (c - 4) * 64; const int Lp = isctx ? CTXL : SEQ; const int row0 = isctx ? T_LAT + b * CTXL : b * SEQ;
    const float* mu = C.in[I_RMU] + (size_t)l * 2 * B_COLS;
    bf16* rkv = WSP(bf16, WS_RKV);
#pragma unroll 5
    for (int it = C.tid; it < 64 * 120; it += NTHR) {
        const int t = it / 120, c8 = (it % 120) * 8, p = p0 + t;
        const bf16* pp = P + (size_t)(row0 + p) * PLD + OFF_B + c8;
        const v4u xc = *(const v4u*)pp; v4u xp = (v4u){0u, 0u, 0u, 0u}, xn = xp;
        if (p > 0) xp = *(const v4u*)(pp - PLD);
        if (p < Lp - 1) xn = *(const v4u*)(pp + PLD);
        const f32x4 m0a = *(const f32x4*)(mu + c8), m0b = *(const f32x4*)(mu + c8 + 4), m1a = *(const f32x4*)(mu + B_COLS + c8), m1b = *(const f32x4*)(mu + B_COLS + c8 + 4);
        const unsigned xcw[4] = {xc.x, xc.y, xc.z, xc.w}, xpw[4] = {xp.x, xp.y, xp.z, xp.w}, xnw[4] = {xn.x, xn.y, xn.z, xn.w};
        float sh[8];
#pragma unroll
        for (int e = 0; e < 4; ++e) {
            const float x0 = bflo(xcw[e]), x1 = bfhi(xcw[e]);
            const float mu0_0 = e < 2 ? m0a[2 * e] : m0b[2 * e - 4], mu0_1 = e < 2 ? m0a[2 * e + 1] : m0b[2 * e - 3], mu1_0 = e < 2 ? m1a[2 * e] : m1b[2 * e - 4], mu1_1 = e < 2 ? m1a[2 * e + 1] : m1b[2 * e - 3];
            sh[2 * e] = x0 + mu0_0 * (bflo(xpw[e]) - x0) + mu1_0 * (bflo(xnw[e]) - x0);
            sh[2 * e + 1] = x1 + mu0_1 * (bfhi(xpw[e]) - x1) + mu1_1 * (bfhi(xnw[e]) - x1);
        }
        if (c8 >= 768) {
            const int ci = c8 - 768;
            if (ci < 64) {
#pragma unroll
                for (int e = 0; e < 8; ++e) sh[e] = tanhf_(sh[e]); }
            else if (ci >= 128) {
#pragma unroll
                for (int e = 0; e < 8; ++e) sh[e] = sigmoidf_(sh[e]); }
        }
        v4u o; o.x = pk2(sh[0], sh[1]); o.y = pk2(sh[2], sh[3]); o.z = pk2(sh[4], sh[5]); o.w = pk2(sh[6], sh[7]);
        if (c8 < 768) {
            *(v4u*)(rkv + (size_t)(row0 + p) * 768 + c8) = o;
            if (c8 < 256) *(LAS v4u*)(RS + t * RP + c8) = o; else if (c8 < 512) *(LAS v4u*)(KS + t * RP + c8 - 256) = o;
        } else {
            const int ci = c8 - 768;
            LAS bf16* dst = ci < 64 ? XW + t * MP + ci : (ci < 128 ? XA + t * MP + ci - 64 : XG + t * MP + ci - 128);
            *(LAS v4u*)dst = o;
        }
    }
    __syncthreads();
    const int lane = C.lane, w = C.wave, l15 = lane & 15, q = lane >> 4, hd = w & 3, ntp = w >> 2;
    const bf16* wt = WSP(const bf16, WS_RWT);
    bf16* wa_out = WSP(bf16, WS_HB); bf16* g_out = WSP(bf16, WS_G); float* bonus = WSP(float, WS_BONUS); float* rinv = WSP(float, WS_RINV);
    const f32x4 z4 = (f32x4){0.f, 0.f, 0.f, 0.f};
    float bsum[2] = {0.f, 0.f}, ksum[2] = {0.f, 0.f};
#pragma unroll
    for (int n2 = 0; n2 < 2; ++n2) {
        const int tok = 16 * (2 * ntp + n2) + l15; const size_t row = (size_t)(row0 + p0 + tok);
        const fragb xw0 = ld_frag16(XW + tok * MP + 8 * q), xw1 = ld_frag16(XW + tok * MP + 32 + 8 * q), xa0 = ld_frag16(XA + tok * MP + 8 * q), xa1 = ld_frag16(XA + tok * MP + 32 + 8 * q);
        const fragb xg0 = ld_frag16(XG + tok * MP + 8 * q), xg1 = ld_frag16(XG + tok * MP + 32 + 8 * q);
        unsigned ow0[8], ow1[8], oa0[8], oa1[8], og[8];
#pragma unroll
        for (int mt = 0; mt < 4; ++mt) {
            const int chl = 16 * (l15 >> 2) + 4 * mt + (l15 & 3), ch4 = hd * 64 + 16 * q + 4 * mt;
            const bf16* wrow = wt + (size_t)(hd * 64 + chl) * 32 + 8 * q;
            const bf16* grow = wt + 4 * 256 * 32 + (size_t)(hd * 64 + chl) * 64 + 8 * q;
            const fragb fw0 = *(const fragb*)(wrow), fw1 = *(const fragb*)(wrow + 256 * 32), fa0 = *(const fragb*)(wrow + 2 * 256 * 32), fa1 = *(const fragb*)(wrow + 3 * 256 * 32), fg0 = *(const fragb*)(grow), fg1 = *(const fragb*)(grow + 32);
            const f32x4 w00 = *(const f32x4*)(C.in[I_RW0] + (l * 2 + 0) * GW + ch4), w01 = *(const f32x4*)(C.in[I_RW0] + (l * 2 + 1) * GW + ch4);
            const f32x4 a00 = *(const f32x4*)(C.in[I_RA0] + (l * 2 + 0) * GW + ch4), a01 = *(const f32x4*)(C.in[I_RA0] + (l * 2 + 1) * GW + ch4);
            const f32x4 k_a = *(const f32x4*)(C.in[I_RKA] + l * GW + ch4), r_k = *(const f32x4*)(C.in[I_RRK] + l * GW + ch4), k_k = *(const f32x4*)(C.in[I_RKK] + l * GW + ch4);
            const f32x4 aw0 = mfma16(fw0, xw0, z4), aw1 = mfma16(fw1, xw1, z4), aa0 = mfma16(fa0, xa0, z4), aa1 = mfma16(fa1, xa1, z4);
            f32x4 ag = mfma16(fg0, xg0, z4); ag = mfma16(fg1, xg1, ag);
            f32x4 wv0, wv1, av0, av1;
#pragma unroll
            for (int r = 0; r < 4; ++r) {
                wv0[r] = __expf(-0.6065306597126334f * sigmoidf_(aw0[r] + w00[r])); wv1[r] = __expf(-0.6065306597126334f * sigmoidf_(aw1[r] + w01[r]));
                av0[r] = sigmoidf_(aa0[r] + a00[r]); av1[r] = sigmoidf_(aa1[r] + a01[r]);
            }
            ow0[2 * mt] = pk2(wv0[0], wv0[1]); ow0[2 * mt + 1] = pk2(wv0[2], wv0[3]); ow1[2 * mt] = pk2(wv1[0], wv1[1]); ow1[2 * mt + 1] = pk2(wv1[2], wv1[3]);
            oa0[2 * mt] = pk2(av0[0], av0[1]); oa0[2 * mt + 1] = pk2(av0[2], av0[3]); oa1[2 * mt] = pk2(av1[0], av1[1]); oa1[2 * mt + 1] = pk2(av1[2], av1[3]);
            og[2 * mt] = pk2(ag[0], ag[1]); og[2 * mt + 1] = pk2(ag[2], ag[3]);
            const v2u rr_ = *(const LAS v2u*)(RS + tok * RP + ch4), kr_ = *(const LAS v2u*)(KS + tok * RP + ch4);
            const f32x4 rs = (f32x4){bflo(rr_.x), bfhi(rr_.x), bflo(rr_.y), bfhi(rr_.y)}, ks = (f32x4){bflo(kr_.x), bfhi(kr_.x), bflo(kr_.y), bfhi(kr_.y)};
#pragma unroll
            for (int r = 0; r < 4; ++r) {
                const float km = ks[r] * (1.0f + (av0[r] - 1.0f) * k_a[r]) + ks[r] * (1.0f + (av1[r] - 1.0f) * k_a[r]);
                bsum[n2] += rs[r] * r_k[r] * km; const float kk = ks[r] * k_k[r]; ksum[n2] += kk * kk;
            }
        }
        bf16* wrow_o = wa_out + row * 1024 + hd * 64 + 16 * q;
        *(v4u*)(wrow_o) = (v4u){ow0[0], ow0[1], ow0[2], ow0[3]}; *(v4u*)(wrow_o + 8) = (v4u){ow0[4], ow0[5], ow0[6], ow0[7]};
        *(v4u*)(wrow_o + 256) = (v4u){ow1[0], ow1[1], ow1[2], ow1[3]}; *(v4u*)(wrow_o + 256 + 8) = (v4u){ow1[4], ow1[5], ow1[6], ow1[7]};
        *(v4u*)(wrow_o + 512) = (v4u){oa0[0], oa0[1], oa0[2], oa0[3]}; *(v4u*)(wrow_o + 512 + 8) = (v4u){oa0[4], oa0[5], oa0[6], oa0[7]};
        *(v4u*)(wrow_o + 768) = (v4u){oa1[0], oa1[1], oa1[2], oa1[3]}; *(v4u*)(wrow_o + 768 + 8) = (v4u){oa1[4], oa1[5], oa1[6], oa1[7]};
        bf16* grow_o = g_out + row * 256 + hd * 64 + 16 * q;
        *(v4u*)(grow_o) = (v4u){og[0], og[1], og[2], og[3]}; *(v4u*)(grow_o + 8) = (v4u){og[4], og[5], og[6], og[7]};
    }
#pragma unroll
    for (int n2 = 0; n2 < 2; ++n2) {
        const size_t row = (size_t)(row0 + p0 + 16 * (2 * ntp + n2) + l15);
        float bs = bsum[n2], ks2 = ksum[n2];
        bs += __shfl_xor(bs, 16); bs += __shfl_xor(bs, 32); ks2 += __shfl_xor(ks2, 16); ks2 += __shfl_xor(ks2, 32);
        if (q == 0) { bonus[row * 4 + hd] = bs; rinv[row * 4 + hd] = rsqrtf_(ks2 + 1e-6f); }
    }
    __syncthreads();
}
__device__ __forceinline__ int fwd_row_r(int b, int c, int t) { return c < 4 ? (T_LAT + b * CTXL + c * 64 + t) : (b * SEQ + (c - 4) * 64 + t); }
__device__ __forceinline__ bf16* rw_blob_row(const Ctx& C, int d, int which, int b, int c, int h, int r) {
    const int row = fwd_row_r(b, c, r);
#if RW_VSPLIT
    if (which == 0) { if (d) return WSP(bf16, WS_GQ) + (size_t)row * 768 + 512 + h * 64;
                      return WSP(bf16, WS_P) + (size_t)row * PLD + OFF_B + 512 + h * 64; }
#else
    if (which == 0) return WSP(bf16, WS_OUTB) + ((size_t)d * T_ALL + row) * 256 + h * 64;
#endif
    return WSP(bf16, WS_P) + (size_t)row * PLD + OFF_B + d * 256 + h * 64;
}
__device__ __forceinline__ void rwkv_solve_item(const Ctx& C, int l, int item) {
    const int lane = C.lane, w = C.wave, pw = w & 1, pi = w >> 1, l15 = lane & 15, q = lane >> 4;
    LAS unsigned char* B0 = C.lds + pi * 31744;
    LAS bf16* Kk = (LAS bf16*)B0; LAS bf16* Bh = Kk + 64 * MP; LAS bf16* Kh = Bh + 64 * MP;
    LAS bf16* Ln = (LAS bf16*)B0;
    LAS bf16* Lk16 = (LAS bf16*)(B0 + 9216);
    LAS unsigned char* XT = B0 + 9216;
    LAS bf16* TinvP = (LAS bf16*)(B0 + 25600);
    const bf16* WA = WSP(const bf16, WS_HB); bf16* WAw = WSP(bf16, WS_HB); const bf16* rkv = WSP(const bf16, WS_RKV); const float* rinv = WSP(const float, WS_RINV);
    const int u = item >> 1, d = item & 1;
    const int c = u % NCH, h = (u / NCH) & 3, b = u / (NCH * NH);
    const float k_k = C.in[I_RKK][l * GW + h * 64 + lane], k_a = C.in[I_RKA][l * GW + h * 64 + lane];
    const int n = d ? (c < 4 ? 3 - c : 71 - c) : c;
    const float ril = rinv[(size_t)seqrow_raster(n * 64 + lane, d, b) * 4 + h];
#pragma unroll
    for (int r = 0; r < 4; ++r) { const int idx2 = pw * 64 + lane + 128 * r, t = idx2 >> 3, part = idx2 & 7; const int row = seqrow_raster(n * 64 + t, d, b);
        *(LAS v4u*)(Kk + t * MP + 8 * part) = *(const v4u*)(WA + (size_t)row * 1024 + d * 256 + h * 64 + 8 * part);
        *(LAS v4u*)(Bh + t * MP + 8 * part) = *(const v4u*)(WA + (size_t)row * 1024 + (2 + d) * 256 + h * 64 + 8 * part);
        *(LAS v4u*)(Kh + t * MP + 8 * part) = *(const v4u*)(rkv + (size_t)row * 768 + 256 + h * 64 + 8 * part); }
    __syncthreads();
    {
        float cc = 1.0f;
        if (pw) {
#pragma unroll
            for (int t = 0; t < 32; ++t) cc *= bf2f(Kk[t * MP + lane]);
        }
        __syncthreads();
#pragma unroll
        for (int t2 = 0; t2 < 32; ++t2) {
            const int t = pw * 32 + t2;
            const float wv = bf2f(Kk[t * MP + lane]), av = bf2f(Bh[t * MP + lane]), ks = bf2f(Kh[t * MP + lane]);
            const float kap = ks * k_k * __shfl(ril, t);
            const float cprev = cc; cc *= wv; const float ic = __builtin_amdgcn_rcpf(cc);
            Kk[t * MP + lane] = (bf16)f2bf1(kap * cprev); Bh[t * MP + lane] = (bf16)f2bf1(kap * av * ic); Kh[t * MP + lane] = (bf16)f2bf1(ks * (1.0f + (av - 1.0f) * k_a) * ic);
            WAw[(size_t)seqrow_raster(n * 64 + t, d, b) * 1024 + d * 256 + h * 64 + lane] = (bf16)f2bf1(cc);
        }
    }
    __syncthreads();
    f32x4 acc[4][4];
    if (pw == 0) {
#pragma unroll
        for (int I = 0; I < 4; ++I)
#pragma unroll
            for (int r = 0; r < 4; ++r)
#pragma unroll
                for (int nt = 0; nt < 4; ++nt) acc[I][nt][r] = bf2f(Kk[(16 * I + 4 * q + r) * MP + 16 * nt + l15]);
    }
    f32x4 T[10];
    {
        const LAS bf16* Bsrc = pw ? Kh : Bh;
        int tix = 0;
#pragma unroll
        for (int it = 0; it < 4; ++it)
#pragma unroll
            for (int jt = 0; jt <= it; ++jt, ++tix) {
                f32x4 t4 = (f32x4){0.f, 0.f, 0.f, 0.f};
#pragma unroll
                for (int s = 0; s < 2; ++s) t4 = mfma16(ld_frag16(Kk + (16 * it + l15) * MP + 32 * s + 8 * q), ld_frag16(Bsrc + (16 * jt + l15) * MP + 32 * s + 8 * q), t4);
#pragma unroll
                for (int r = 0; r < 4; ++r) { const int i = 16 * it + 4 * q + r, j = 16 * jt + l15; T[tix][r] = (j < i) ? (pw ? t4[r] : -t4[r]) : 0.f; }
            }
    }
    __syncthreads();
    {
        int tix = 0;
#pragma unroll
        for (int it = 0; it < 4; ++it)
#pragma unroll
            for (int jt = 0; jt < 4; ++jt) {
                if (jt <= it) {
#pragma unroll
                    for (int r = 0; r < 4; ++r) (pw ? Lk16 : Ln)[(16 * it + 4 * q + r) * MP + 16 * jt + l15] = (bf16)f2bf1(T[tix][r]);
                    ++tix;
                } else if (pw == 0) {
#pragma unroll
                    for (int r = 0; r < 4; ++r) Ln[(16 * it + 4 * q + r) * MP + 16 * jt + l15] = (bf16)0;
                }
            }
        LAS v4u* tz = (LAS v4u*)(B0 + 25600) + (pw * 64 + lane) * 2; tz[0] = (v4u){0u, 0u, 0u, 0u}; tz[1] = (v4u){0u, 0u, 0u, 0u};
    }
    __syncthreads();
    if (pw) {
#pragma unroll
        for (int I = 0; I < 4; ++I)
#pragma unroll
            for (int r = 0; r < 4; ++r)
#pragma unroll
                for (int nt = 0; nt < 4; ++nt) { const int i = 16 * I + 4 * q + r, j = 16 * nt + l15; acc[I][nt][r] = (j < i && nt <= I) ? bf2f(Lk16[i * MP + j]) : 0.f; }
    } else diag_inverses(Ln, TinvP, lane);
    __syncthreads();
    LAS unsigned char* XTw = XT + pw * 8192;
    { LAS v4u* xz = (LAS v4u*)(XTw + lane * 128);
#pragma unroll
        for (int g = 0; g < 8; ++g) xz[g] = (v4u){0u, 0u, 0u, 0u}; }
    blocked_solve(Ln, TinvP, XTw, acc, l15, q);
    {
        bf16* dst = rw_blob_row(C, d, pw, b, c, h, lane);
        const LAS unsigned char* xr = XTw + lane * 128;
#pragma unroll
        for (int g = 0; g < 8; ++g) *(v4u*)(dst + 8 * g) = *(const LAS v4u*)(xr + ((g ^ (lane & 7)) << 4));
    }
    __syncthreads();
}

template <bool DRY>
__device__ __forceinline__ void rwkv_chunked(const Ctx& C, int l, int idx) {
#ifndef RW_VSPLIT
#define RW_VSPLIT 1
#endif
    constexpr int NV = RW_VSPLIT ? 1 : 2;
    const int vhalf = idx & 1, lane = C.lane, w = C.wave, l15 = lane & 15, q = lane >> 4;
    const int d = RW_VSPLIT ? idx >> 6 : idx >> 5, b = RW_VSPLIT ? (idx >> 3) & 7 : (idx >> 2) & 7, h = RW_VSPLIT ? (idx >> 1) & 3 : idx & 3;
    const int it = w & 3, vt0 = RW_VSPLIT ? 2 * vhalf + (w >> 2) : 2 * (w >> 2);
    constexpr int IMG = 64 * MP * 2;
    LAS unsigned char* L0 = C.lds;
    LAS bf16* Wi = (LAS bf16*)L0; LAS bf16* Ti = Wi + 64 * MP; LAS bf16* Rh = Ti + 64 * MP; LAS bf16* Kh = Rh + 64 * MP; LAS bf16* Bh = Kh + 64 * MP;
    LAS bf16* UT = (LAS bf16*)(L0 + 11 * IMG);
    LAS float* cLv = (LAS float*)(L0 + 14 * IMG);
    const bf16* WA = WSP(const bf16, WS_HB); const bf16* rkv = WSP(const bf16, WS_RKV); const float* rinv = WSP(const float, WS_RINV);
    bf16* outb = WSP(bf16, WS_OUTB) + (size_t)d * T_ALL * 256;
    const int tt = C.tid >> 3, part = C.tid & 7;
    for (int i = C.tid; i < 2 * IMG / 4; i += NTHR) ((LAS unsigned*)(L0 + 12 * IMG))[i] = 0u;
    float kkw[8], kaw[8];
#pragma unroll
    for (int e = 0; e < 8; ++e) { kkw[e] = C.in[I_RKK][l * GW + h * 64 + 8 * w + e]; kaw[e] = C.in[I_RKA][l * GW + h * 64 + 8 * w + e]; }
    v4u gr, gk, gv, gw, ga, gbw, gbt; float gri;
    auto gload = [&](int n) {
        const int c = d ? (n < 4 ? 3 - n : 71 - n) : n;
        const int row = seqrow_raster(n * 64 + lane, d, b);
        const bf16* pr = rkv + (size_t)row * 768 + h * 64 + 8 * w;
        gr = *(const v4u*)pr; gk = *(const v4u*)(pr + 256); gv = *(const v4u*)(pr + 512);
        gw = *(const v4u*)(WA + (size_t)row * 1024 + d * 256 + h * 64 + 8 * w); ga = *(const v4u*)(WA + (size_t)row * 1024 + (2 + d) * 256 + h * 64 + 8 * w);
        gri = rinv[(size_t)row * 4 + h];
        gbw = *(const v4u*)(rw_blob_row(C, d, 0, b, c, h, tt) + 8 * part); gbt = *(const v4u*)(rw_blob_row(C, d, 1, b, c, h, tt) + 8 * part);
    };
    auto images = [&](int bufi) {
        LAS bf16* VT = (LAS bf16*)(L0 + (5 + 3 * bufi) * IMG); LAS bf16* KcT = VT + 64 * MP; LAS bf16* BcT = KcT + 64 * MP;
        const unsigned rw_[4] = {gr.x, gr.y, gr.z, gr.w}, kw_[4] = {gk.x, gk.y, gk.z, gk.w}, vw_[4] = {gv.x, gv.y, gv.z, gv.w}, ww_[4] = {gw.x, gw.y, gw.z, gw.w}, aw_[4] = {ga.x, ga.y, ga.z, ga.w};
        float rh[8], kh[8], bh[8];
#pragma unroll
        for (int e = 0; e < 8; ++e) {
            const float rs = (e & 1) ? bfhi(rw_[e >> 1]) : bflo(rw_[e >> 1]), ks = (e & 1) ? bfhi(kw_[e >> 1]) : bflo(kw_[e >> 1]);
            const float wv = (e & 1) ? bfhi(ww_[e >> 1]) : bflo(ww_[e >> 1]), av = (e & 1) ? bfhi(aw_[e >> 1]) : bflo(aw_[e >> 1]);
            const float kap = ks * kkw[e] * gri, ktil = ks * (1.0f + (av - 1.0f) * kaw[e]);
            const float cf = wv, icf = __builtin_amdgcn_rcpf(cf), cfL = __builtin_bit_cast(float, __builtin_amdgcn_readlane(__builtin_bit_cast(int, cf), 63)), dec = cfL * icf;
            rh[e] = rs * cf; kh[e] = ktil * icf; bh[e] = kap * av * icf;
            const unsigned short vraw = (e & 1) ? (unsigned short)(vw_[e >> 1] >> 16) : (unsigned short)(vw_[e >> 1] & 0xffffu);
            VT[(8 * w + e) * MP + lane] = vraw; KcT[(8 * w + e) * MP + lane] = (bf16)f2bf1(ktil * dec); BcT[(8 * w + e) * MP + lane] = (bf16)f2bf1(-(kap * av * dec));
            if (lane == 63) cLv[bufi * 64 + 8 * w + e] = cfL;
        }
        { v4u o; o.x = pk2(rh[0], rh[1]); o.y = pk2(rh[2], rh[3]); o.z = pk2(rh[4], rh[5]); o.w = pk2(rh[6], rh[7]); *(LAS v4u*)(Rh + lane * MP + 8 * w) = o; }
        { v4u o; o.x = pk2(kh[0], kh[1]); o.y = pk2(kh[2], kh[3]); o.z = pk2(kh[4], kh[5]); o.w = pk2(kh[6], kh[7]); *(LAS v4u*)(Kh + lane * MP + 8 * w) = o; }
        { v4u o; o.x = pk2(bh[0], bh[1]); o.y = pk2(bh[2], bh[3]); o.z = pk2(bh[4], bh[5]); o.w = pk2(bh[6], bh[7]); *(LAS v4u*)(Bh + lane * MP + 8 * w) = o; }
        const unsigned bw_[4] = {gbw.x, gbw.y, gbw.z, gbw.w}, bt_[4] = {gbt.x, gbt.y, gbt.z, gbt.w};
#pragma unroll
        for (int e = 0; e < 4; ++e) {
            Wi[(8 * part + 2 * e) * MP + tt] = (bf16)(bw_[e] & 0xffffu); Wi[(8 * part + 2 * e + 1) * MP + tt] = (bf16)(bw_[e] >> 16);
            Ti[(8 * part + 2 * e) * MP + tt] = (bf16)(bt_[e] & 0xffffu); Ti[(8 * part + 2 * e + 1) * MP + tt] = (bf16)(bt_[e] >> 16);
        }
    };
    f32x4 Zst[NV];
#pragma unroll
    for (int v2 = 0; v2 < NV; ++v2) Zst[v2] = (f32x4){0.f, 0.f, 0.f, 0.f};
    const f32x4 z4 = (f32x4){0.f, 0.f, 0.f, 0.f};
    gload(0); images(0); gload(1);
#pragma unroll 1
    for (int n = 0; n < NCH; ++n) {
        RAW_BARRIER();
        const LAS bf16* VT = (const LAS bf16*)(L0 + (5 + 3 * (n & 1)) * IMG); const LAS bf16* KcT = VT + 64 * MP; const LAS bf16* BcT = KcT + 64 * MP;
        const LAS bf16* Zi = (const LAS bf16*)(L0 + (12 + (n & 1)) * IMG); LAS bf16* Zn = (LAS bf16*)(L0 + (12 + ((n + 1) & 1)) * IMG);
        const int arow = (16 * it + l15) * MP + 8 * q;
        const fragb Wf0 = ld_frag16(Wi + arow), Wf1 = ld_frag16(Wi + arow + 32), Tf0 = ld_frag16(Ti + arow), Tf1 = ld_frag16(Ti + arow + 32), Rf0 = ld_frag16(Rh + arow), Rf1 = ld_frag16(Rh + arow + 32);
        const int icol = 16 * it + l15;
        f32x4 pk[4], pb[4];
#pragma unroll
        for (int jt = 0; jt < 4; ++jt) {
            pk[jt] = z4; pb[jt] = z4;
            if (jt <= it) {
                const int jrow = (16 * jt + l15) * MP + 8 * q;
                f32x4 sk = mfma16(ld_frag16(Kh + jrow), Rf0, z4); sk = mfma16(ld_frag16(Kh + jrow + 32), Rf1, sk);
                f32x4 sb = mfma16(ld_frag16(Bh + jrow), Rf0, z4); sb = mfma16(ld_frag16(Bh + jrow + 32), Rf1, sb);
#pragma unroll
                for (int r = 0; r < 4; ++r) { const int j = 16 * jt + 4 * q + r; pk[jt][r] = (j <= icol) ? sk[r] : 0.f; pb[jt][r] = (j <= icol) ? -sb[r] : 0.f; }
            }
        }
        fragb Pk0 = pack_frag(pk[0], pk[1]), Pk1 = pack_frag(pk[2], pk[3]), Pb0 = pack_frag(pb[0], pb[1]), Pb1 = pack_frag(pb[2], pb[3]);
        f32x4 RZ[NV];
#pragma unroll
        for (int v2 = 0; v2 < NV; ++v2) {
            const int vrow = 16 * (vt0 + v2) + l15;
            const fragb z0 = ld_frag16(Zi + vrow * MP + 8 * q), z1 = ld_frag16(Zi + vrow * MP + 32 + 8 * q);
            f32x4 u = mfma16(Wf0, z0, z4); u = mfma16(Wf1, z1, u);
            u = mfma16(Tf0, ld_frag16(VT + vrow * MP + 8 * q), u); if (it >= 2) u = mfma16(Tf1, ld_frag16(VT + vrow * MP + 32 + 8 * q), u);
            RZ[v2] = mfma16(Rf0, z0, z4); RZ[v2] = mfma16(Rf1, z1, RZ[v2]);
            v2u o; o.x = pk2(u.x, u.y); o.y = pk2(u.z, u.w);
            *(LAS v2u*)(UT + vrow * MP + 16 * it + 4 * q) = o;
        }
        RAW_BARRIER();
        {
            const f32x4 cl4 = *(const LAS f32x4*)(cLv + (n & 1) * 64 + 16 * it + 4 * q);
            const LAS bf16* kr = KcT + (16 * it + l15) * MP + 4 * q; const LAS bf16* br = BcT + (16 * it + l15) * MP + 4 * q;
            const fragb kc0 = ld_frag8x2(kr, kr + 16), kc1 = ld_frag8x2(kr + 32, kr + 48), bc0 = ld_frag8x2(br, br + 16), bc1 = ld_frag8x2(br + 32, br + 48);
#pragma unroll
            for (int v2 = 0; v2 < NV; ++v2) {
                const int vrow = 16 * (vt0 + v2) + l15;
                const LAS bf16* vr = VT + vrow * MP + 4 * q; const LAS bf16* ur = UT + vrow * MP + 4 * q;
                const fragb vp0 = ld_frag8x2(vr, vr + 16), vp1 = ld_frag8x2(vr + 32, vr + 48), up0 = ld_frag8x2(ur, ur + 16), up1 = ld_frag8x2(ur + 32, ur + 48);
                f32x4 y = mfma16(Pk0, vp0, RZ[v2]); y = mfma16(Pb0, up0, y);
                if (it >= 2) { y = mfma16(Pk1, vp1, y); y = mfma16(Pb1, up1, y); }
#pragma unroll
                for (int r = 0; r < 4; ++r) { const int row = seqrow_raster(n * 64 + 16 * it + 4 * q + r, d, b); if (!DRY) outb[(size_t)row * 256 + h * 64 + vrow] = (bf16)f2bf1(y[r]); }
                f32x4 zn = mfma16(kc0, vp0, z4); zn = mfma16(kc1, vp1, zn); zn = mfma16(bc0, up0, zn); zn = mfma16(bc1, up1, zn);
                Zst[v2] = Zst[v2] * cl4 + zn;
                v2u so; so.x = pk2(Zst[v2].x, Zst[v2].y); so.y = pk2(Zst[v2].z, Zst[v2].w);
                *(LAS v2u*)(Zn + vrow * MP + 16 * it + 4 * q) = so;
            }
        }
        if (n + 1 < NCH) { images((n + 1) & 1); if (n + 2 < NCH) gload(n + 2); }
    }
    __syncthreads();
}
__device__ __forceinline__ void moe_scatter(const Ctx& C, int moe_li, int nrows) {
    const unsigned* gc = WSP(const unsigned, WS_CTL) + CW_MOECNT + 64 * moe_li;
    LAS int* pst = (LAS int*)C.lds;
    {
        int pe[8]; int acc = 0;
#pragma unroll
        for (int e = 0; e < NE; ++e) { const int blks = ((int)gc[e] + 255) >> 8; if (C.tid == e) pst[e] = acc * 256; acc += blks; pe[e] = acc; }
        if (C.wg == 0 && C.tid < MOE_MAXBLK) { int be = 0;
#pragma unroll
            for (int e = 0; e < NE; ++e) be += (pe[e] <= C.tid) ? 1 : 0;
            int* tab = WSP(int, WS_TAB); tab[1 + C.tid] = be < NE ? be : NE - 1; if (C.tid == 0) tab[0] = acc; }
    }
    __syncthreads();
    const unsigned* route = WSP(const unsigned, WS_ROUTE); const unsigned* wgbase = WSP(const unsigned, WS_WGBASE);
    int* pos = WSP(int, WS_POS); int* tok = WSP(int, WS_TOK);
    if (C.wg < NE) { const int cnt = (int)gc[C.wg], s0 = pst[C.wg] + cnt, s1 = pst[C.wg] + (((cnt + 255) >> 8) << 8);
        for (int j = s0 + C.tid; j < s1; j += NTHR) tok[j] = 0; }
    const int m = C.wg * NWAVES + C.wave + C.lane * (C.G * NWAVES);
    if (m < nrows) {
        const v4u a = *(const v4u*)(route + (size_t)m * 8);
        const int e0 = (int)a.x, e1 = (int)a.y;
        const int p0 = pst[e0] + (int)wgbase[C.wg * 8 + e0] + (int)a.z, p1 = pst[e1] + (int)wgbase[C.wg * 8 + e1] + (int)a.w;
        pos[(size_t)m * 2] = p0; pos[(size_t)m * 2 + 1] = p1; tok[p0] = m; tok[p1] = m;
    }
    __syncthreads();
}
template <int NEXT>
__device__ __forceinline__ void moe_combine(const Ctx& C, int l, int nrows) {
    const unsigned* route = WSP(const unsigned, WS_ROUTE); const int* pos = WSP(const int, WS_POS); const bf16* ym = WSP(const bf16, WS_MIX);
    const float* modv = WSP(const float, WS_MODV) + (size_t)l * 9 * 6144 + 5 * 1024;
    const float* modn = WSP(const float, WS_MODV) + (size_t)(l + 1) * 9 * 6144;
    float* xc = WSP(float, WS_XC); bf16* hb = WSP(bf16, WS_HB);
    bf16* xlb = NEXT == 2 ? WSP(bf16, WS_XLAST) : (bf16*)C.out;
    const int gw = C.wg * NWAVES + C.wave, NGW = C.G * NWAVES;
    f32x4 gn[4];
#pragma unroll
    for (int j = 0; j < 4; ++j) gn[j] = *(const f32x4*)((NEXT == 2 ? C.in[I_FNG] : C.in[I_NMIXG] + (NEXT == 1 ? (l + 1) * 1024 : 0)) + 4 * C.lane + 256 * j);
    int p0n = 0, p1n = 0; float w0n = 0.f, w1n = 0.f;
    v4u xa[4]; v2u ya[4], yb[4]; float w0c = 0.f, w1c = 0.f;
#define MC_POS(mm, P0, P1, W0, W1) do { const int m_ = (mm); P0 = pos[(size_t)m_ * 2]; P1 = pos[(size_t)m_ * 2 + 1]; W0 = __builtin_bit_cast(float, route[(size_t)m_ * 8 + 4]); W1 = __builtin_bit_cast(float, route[(size_t)m_ * 8 + 5]); } while (0)
#define MC_RAW(mm, P0, P1) do { const int m_ = (mm); const bool ic_ = m_ >= T_LAT; \
        _Pragma("unroll") for (int j = 0; j < 4; ++j) { const int col = 4 * C.lane + 256 * j; \
            ya[j] = *(const v2u*)(ym + (size_t)(P0) * 1024 + col); yb[j] = *(const v2u*)(ym + (size_t)(P1) * 1024 + col); \
            if (ic_) xa[j] = *(const v4u*)(xc + (size_t)(m_ - T_LAT) * 1024 + col); else { const v2u t_ = *(const v2u*)(xlb + (size_t)m_ * 1024 + col); xa[j] = (v4u){t_.x, t_.y, 0u, 0u}; } } } while (0)
    if (gw < nrows) { int p0, p1; MC_POS(gw, p0, p1, w0c, w1c); if (gw + NGW < nrows) MC_POS(gw + NGW, p0n, p1n, w0n, w1n); MC_RAW(gw, p0, p1); }
    for (int m = gw; m < nrows; m += NGW) {
        const bool isctx = m >= T_LAT;
        float* xr = isctx ? xc + (size_t)(m - T_LAT) * 1024 : C.out + (size_t)m * 1024; bf16* xrb = xlb + (size_t)m * 1024;
        const int mrow = isctx ? 8 : (m >> 12);
        const float* gv = modv + (size_t)mrow * 6144;
        v4u xq[4]; v2u yq0[4], yq1[4]; const float w0 = w0c, w1 = w1c;
#pragma unroll
        for (int j = 0; j < 4; ++j) { xq[j] = xa[j]; yq0[j] = ya[j]; yq1[j] = yb[j]; }
        const int p0u = p0n, p1u = p1n; w0c = w0n; w1c = w1n;
        if (m + 2 * NGW < nrows) MC_POS(m + 2 * NGW, p0n, p1n, w0n, w1n);
        if (m + NGW < nrows) MC_RAW(m + NGW, p0u, p1u);
        f32x4 x[4]; float ss = 0.f;
#pragma unroll
        for (int j = 0; j < 4; ++j) {
            const int col = 4 * C.lane + 256 * j;
            const f32x4 ya4 = (f32x4){bflo(yq0[j].x), bfhi(yq0[j].x), bflo(yq0[j].y), bfhi(yq0[j].y)}, yb4 = (f32x4){bflo(yq1[j].x), bfhi(yq1[j].x), bflo(yq1[j].y), bfhi(yq1[j].y)};
            const f32x4 g = *(const f32x4*)(gv + col);
            const f32x4 xo = isctx ? __builtin_bit_cast(f32x4, xq[j]) : (f32x4){bflo(xq[j].x), bfhi(xq[j].x), bflo(xq[j].y), bfhi(xq[j].y)};
            x[j] = xo + g * (ya4 * w0 + yb4 * w1);
            if (NEXT != 2) { if (isctx) *(f32x4*)(xr + col) = x[j]; else st4bf(xrb + col, x[j]); }
            ss += (x[j].x * x[j].x + x[j].y * x[j].y) + (x[j].z * x[j].z + x[j].w * x[j].w);
        }
        if (NEXT != 0) {
            const float rs = rsqrtf_(wave_sum(ss) * (1.0f / 1024.0f) + 1e-6f);
#pragma unroll
            for (int j = 0; j < 4; ++j) {
                const int col = 4 * C.lane + 256 * j;
                if (NEXT == 2) *(f32x4*)(xr + col) = x[j] * rs * gn[j];
                else { const f32x4 sh = *(const f32x4*)(modn + (size_t)mrow * 6144 + col), scl = *(const f32x4*)(modn + (size_t)mrow * 6144 + 1024 + col);
                    st4bf(hb + (size_t)m * 1024 + col, (x[j] * rs * gn[j]) * (scl + 1.0f) + sh); }
            }
        }
    }
#undef MC_POS
#undef MC_RAW
}
__device__ __forceinline__ void final_norm(const Ctx& C) {
    const int gw = C.wg * NWAVES + C.wave, NGW = C.G * NWAVES;
    f32x4 gv[4];
#pragma unroll
    for (int j = 0; j < 4; ++j) gv[j] = *(const f32x4*)(C.in[I_FNG] + 4 * C.lane + 256 * j);
    for (int m = gw; m < T_LAT; m += NGW) {
        float* xr = C.out + (size_t)m * 1024;
        f32x4 v[4]; float s = 0.f;
#pragma unroll
        for (int j = 0; j < 4; ++j) { v[j] = *(const f32x4*)(xr + 4 * C.lane + 256 * j); s += (v[j].x * v[j].x + v[j].y * v[j].y) + (v[j].z * v[j].z + v[j].w * v[j].w); }
        const float rs = rsqrtf_(wave_sum(s) * (1.0f / 1024.0f) + 1e-6f);
#pragma unroll
        for (int j = 0; j < 4; ++j) *(f32x4*)(xr + 4 * C.lane + 256 * j) = v[j] * rs * gv[j];
    }
}

constexpr int NPH_L = 13, PH_FINAL = 1 + DEPTH * NPH_L, NPHASE = PH_FINAL + 1;
__host__ __device__ inline bool phase_exists(int ph) {
    if (ph == 0) return true;
    if (ph == PH_FINAL) return false;
    const int l = (ph - 1) / NPH_L, k = (ph - 1) % NPH_L;
    if (l >= 2 && !(l & 1) && k == 0) return false;
    if (!(l & 1) && k >= 11) return false;
    if (!RW_VSPLIT && k == 4) return false;
    return true;
}
#ifndef PH_MASK
#define PH_MASK 0xFFFFFF
#endif
#define PM(k) ((PH_MASK >> (k)) & 1)
#ifndef SK_MASK
#define SK_MASK 0xFFFF
#endif
#define SK(k) ((SK_MASK >> (k)) & 1)
#ifndef REP_MASK
#define REP_MASK 0
#endif
#define NREP(k) (((REP_MASK >> (k)) & 1) ? 2 : 1)

__global__ void __launch_bounds__(NTHR, 2) fwd_kernel(Args args) {
    extern __shared__ __attribute__((aligned(16))) unsigned char lds_raw[];
    Ctx C; C.in = args.in; C.out = args.out; C.ws = args.ws; C.lds = (LAS unsigned char*)lds_raw;
    C.tid = threadIdx.x; C.lane = C.tid & 63; C.wave = __builtin_amdgcn_readfirstlane(C.tid >> 6); C.G = gridDim.x; C.wg = blockIdx.x;
    volatile LAS unsigned* MISC = (volatile LAS unsigned*)(C.lds + MISC_OFF);
    if (C.tid < 64) MISC[C.tid] = 0u;
    __syncthreads();
    const int lo = args.ph_lo, hi = args.ph_hi;
    const bool multi = (hi - lo) > 1;
    if (multi) (void)xcd_barrier_post(WSP(unsigned, WS_CTL) + CW_BAR, MISC + 8);
#define IN(k) (lo <= (k) && (k) < hi)
#define SEAM(k) do { if (IN((k) + 1)) { XcdBarrier b2_; b2_.bar = WSP(unsigned, WS_CTL) + CW_BAR; b2_.x = xb_xcc_id(); b2_.st = (volatile LAS unsigned*)(C.lds + MISC_OFF) + 8; xcd_barrier(b2_); } } while (0)
#define FRESH() do { int t_ = threadIdx.x; asm volatile("" : "+v"(t_)); C.tid = t_; C.lane = t_ & 63; C.wave = __builtin_amdgcn_readfirstlane(t_ >> 6); } while (0)
#define PHASE(bit, k) if (PM(bit) && IN(pb + (k))) for (int rep_ = 0; rep_ < NREP(bit); ++rep_)
#define CLAIM(qh, var) __syncthreads(); if (C.tid == 0) *qslot = atomicAdd((qh), 1u); __syncthreads(); const int var = (int)*qslot;

    LAS unsigned* qslot = (LAS unsigned*)(C.lds + MISC_OFF + 128);
    constexpr int NCSL = 512;
#define CONV_QUEUES(maxn) do { int n_ = 0; \
        if (l > 0) for (; n_ < (maxn); ++n_) { FRESH(); CLAIM(qbase + 192, u0) if (u0 >= NCSL) break; FRESH(); convert_items(C, l, 2, u0 * NWAVES + C.wave, NCSL * NWAVES); } \
        if (l + 1 < DEPTH) for (; n_ < (maxn); ++n_) { FRESH(); CLAIM(qbase + 224, u0) if (u0 >= NCSL) break; FRESH(); convert_items(C, l + 1, 1, u0 * NWAVES + C.wave, NCSL * NWAVES); } } while (0)
    if (PM(20) && IN(0)) { phase_pre(C);
        for (;;) { FRESH(); CLAIM(WSP(unsigned, WS_CTL) + CW_PREPQ + 240, u0) if (u0 >= NCSL) break; FRESH(); convert_items(C, 0, 3, u0 * NWAVES + C.wave, NCSL * NWAVES); }
        SEAM(0); }

#pragma unroll 1
    for (int l = 0; l < DEPTH; ++l) {
        const int pb = 1 + l * NPH_L;
        if (hi <= pb || lo >= pb + NPH_L) continue;
        const bool last = (l == DEPTH - 1), moe = (l & 1);
        const int nrows = last ? T_LAT : T_ALL;
        const void* xlat = (l == 0) ? (const void*)C.in[I_X] : (const void*)C.out; const bool xbf = l > 0; void* xmid = last ? (void*)WSP(bf16, WS_XLAST) : (void*)C.out;
        const float* xctx = (l == 0) ? C.in[I_CTX] : WSP(const float, WS_XC);
        const float* modv = WSP(const float, WS_MODV) + (size_t)l * 9 * 6144;
        unsigned* qbase = WSP(unsigned, WS_CTL) + CW_PREPQ + 256 * l;

        if (!(l >= 2 && !(l & 1))) PHASE(0, 0) { FRESH();
            convert_small(C, l);
            __syncthreads();
            FRESH(); norm_rows<false>(C, l, xlat, xbf, xctx, C.in[I_NMIXG] + l * 1024, 0, 1024, T_ALL, 0);
            SEAM(pb + 0);
        }
        PHASE(1, 1) { FRESH();
            pg8::Gemm g{WSP(const bf16, WS_HB), WSP(const bf16, WS_WIN), T_ALL, PLD, 1024, 0};
            const int gG = (l > 0) ? C.G - 16 : C.G;
            if (C.wg < gG) {
                pg8::StaticOrder S; S.init(T_ALL, PLD, gG, C.wg);
                pg8::EpiBf16<0> E{WSP(bf16, WS_P), PLD, nullptr, 0, 0};
                pg8::gemm_phase<pg8::EpiBf16<0>, pg8::StaticOrder, false>(C.lds, g, S, E, nullptr);
                if (l > 0 && C.tid == 0) (void)xb_add(qbase + 176, 1u);
            } else {
                for (;;) { FRESH(); __syncthreads(); if (C.tid == 0) *qslot = xb_ld(qbase + 176); __syncthreads(); const unsigned fin_ = *qslot; if (fin_ != 0u) break;
                    CLAIM(qbase + 192, u0) if (u0 >= NCSL) break; FRESH(); convert_items(C, l, 2, u0 * NWAVES + C.wave, NCSL * NWAVES); }
            }
            SEAM(pb + 1);
        }
        if (PM(2) && IN(pb + 2)) for (int rep_ = 0; rep_ < NREP(2); ++rep_) { FRESH();
            for (;;) {
                CLAIM(qbase + 16 * rep_, k)
                if (k >= 2 * NB * NCH) break;
                const int kind = k / (NB * NCH), u = k % (NB * NCH);
                FRESH();
                if (kind == 0) { for (int r3_ = 0; r3_ < NREP(24); ++r3_) { FRESH(); if (SK(1)) rwkv_prep2(C, l, u / NCH, u % NCH); } }
                else { for (int r3_ = 0; r3_ < NREP(26); ++r3_) { FRESH(); if (SK(2)) gdn_prep(C, l, u / NCH, u % NCH); } }
            }
            SEAM(pb + 2);
        }
        if (PM(3) && IN(pb + 3)) for (int rep_ = 0; rep_ < NREP(3); ++rep_) { FRESH();
            constexpr int NCL = 2 * NB * NH * NCH / 4;
            int ncl_ = 0;
            for (;;) {
                CLAIM(qbase + 64 + 16 * rep_, k)
                if (k >= NCL) break;
                FRESH(); ++ncl_;
                if (SK(10)) rwkv_solve_item(C, l, 4 * k + (C.wave >> 1));
            }
            if (ncl_ <= 4) { const int cap_ = (l & 1) ? 1 : 3; CONV_QUEUES(cap_); }
            SEAM(pb + (RW_VSPLIT ? 3 : 4));
        }
#if RW_VSPLIT
        if (PM(3) && IN(pb + 4)) { FRESH();
            for (;;) {
                CLAIM(qbase + 128, k)
                if (k >= 2 * NB * NH * NCH / 4) break;
                FRESH();
                if (SK(10)) rwkv_solve_item(C, l, 4 * k + (C.wave >> 1));
            }
            SEAM(pb + 4);
        }
#endif
        if (PM(4) && IN(pb + 5)) { FRESH();
            if (C.wg >= 64) {
                constexpr int NCL = 2 * NB * NH * NCH / 4;
                for (;;) {
                    CLAIM(qbase + 128, k)
                    if (k >= NCL) break;
                    FRESH();
                    if (SK(9)) gdn_solve_item(C, l, 4 * k + (C.wave >> 1));
                }
                asm volatile("s_waitcnt vmcnt(0)" ::: "memory");
                __syncthreads();
                if (C.tid == 0) { __builtin_amdgcn_fence(__ATOMIC_RELEASE, "agent"); asm volatile("s_waitcnt vmcnt(0)" ::: "memory"); (void)xb_add(qbase + 160, 1u); }
                if (C.wg >= 192) {
                    if (C.tid == 0) { unsigned* bar_ = WSP(unsigned, WS_CTL) + CW_BAR; XB_SPIN(xb_ld(qbase + 160) < (unsigned)(C.G - 64), bar_); __builtin_amdgcn_fence(__ATOMIC_ACQUIRE, "agent"); asm volatile("s_waitcnt vmcnt(0)" ::: "memory"); }
                    __syncthreads();
                }
                FRESH();
            }
            if (C.wg >= 64 && C.wg < 128) { if (SK(0)) lru_chain(C, l, C.wg - 64); FRESH(); }
            if (SK(3) && C.wg < (RW_VSPLIT ? 128 : 64)) { if (NREP(20) > 1) { FRESH(); rwkv_chunked<true>(C, l, C.wg); } FRESH(); rwkv_chunked<false>(C, l, C.wg); }
            else if (SK(4) && C.wg >= 128 && C.wg < 192) { for (int r2_ = 0; r2_ < NREP(21); ++r2_) { FRESH(); mlstm_chunked(C, l, C.wg - 128); } }
            else if (SK(5) && C.wg >= 192) { if (NREP(22) > 1) { FRESH(); gdn_chunked<true>(C, l, C.wg - 192); } FRESH(); gdn_chunked<false>(C, l, C.wg - 192); }
            FRESH(); CONV_QUEUES(1 << 30);
            SEAM(pb + 5);
        }
        PHASE(5, 6) { FRESH();
            if (SK(8)) finish_rows(C, l, nrows);
            SEAM(pb + 6);
        }
        if (PM(6) && IN(pb + 7)) { FRESH();
            pg8::Gemm g{WSP(const bf16, WS_HB), WSP(const bf16, WS_WOUT), nrows, 1024, 1024, 0};
            pg8::TailHalfOrder S; S.init(nrows, C.G, C.wg);
            pg8::EpiRes E{xlat, xctx, xmid, WSP(float, WS_XC), modv + 2 * 1024, xbf, true};
            pg8::gemm_phase<pg8::EpiRes, pg8::TailHalfOrder, false>(C.lds, g, S, E, nullptr);
            SEAM(pb + 7);
        }
        if (PM(7) && IN(pb + 8)) { FRESH();
            if (moe) norm_rows<true>(C, l, xmid, true, WSP(const float, WS_XC), C.in[I_NFFNG] + l * 1024, 3 * 1024, 4 * 1024, nrows, l >> 1);
            else norm_rows<false>(C, l, xmid, true, WSP(const float, WS_XC), C.in[I_NFFNG] + l * 1024, 3 * 1024, 4 * 1024, nrows, 0);
            SEAM(pb + 8);
        }
        if (!moe) {
            if (PM(8) && IN(pb + 9)) for (int rep_ = 0; rep_ < NREP(8); ++rep_) { FRESH();
                pg8::Gemm g{WSP(const bf16, WS_HB), WSP(const bf16, WS_WGU), nrows, 2 * DFF, 1024, 0};
                pg8::StaticOrder S; S.init(nrows, 2 * DFF, C.G, C.wg);
                pg8::EpiSwiglu E{WSP(bf16, WS_P), DFF};
                pg8::gemm_phase<pg8::EpiSwiglu, pg8::StaticOrder, false>(C.lds, g, S, E, nullptr);
                SEAM(pb + 9);
            }
            if (PM(9) && IN(pb + 10)) { FRESH();
                pg8::Gemm g{WSP(const bf16, WS_P), WSP(const bf16, WS_WDN), nrows, 1024, DFF, 0};
                pg8::TailHalfOrder S; S.init(nrows, C.G, C.wg);
                pg8::EpiRes E{xmid, WSP(const float, WS_XC), xmid, WSP(float, WS_XC), modv + 5 * 1024, true, true};
                pg8::gemm_phase<pg8::EpiRes, pg8::TailHalfOrder, false>(C.lds, g, S, E, nullptr);
                SEAM(pb + 12);
            }
        } else {
            if (PM(10) && IN(pb + 9)) { FRESH(); moe_scatter(C, l >> 1, nrows); SEAM(pb + 9); }
            if (PM(11) && IN(pb + 10)) for (int rep_ = 0; rep_ < NREP(11); ++rep_) { FRESH();
                pg8::Gemm g{WSP(const bf16, WS_HB), WSP(const bf16, WS_WGU), 0, 2 * DFE, 1024, (size_t)2 * DFE * 1024};
                pg8::MoeOrderG S; S.init(WSP(const int, WS_TAB), (2 * DFE) / 256, C.G, C.wg); S.tok = WSP(const int, WS_TOK);
                pg8::EpiSwiglu E{WSP(bf16, WS_P), DFE};
                pg8::gemm_phase<pg8::EpiSwiglu, pg8::MoeOrderG, false>(C.lds, g, S, E, nullptr);
                SEAM(pb + 10);
            }
            if (PM(12) && IN(pb + 11)) for (int rep_ = 0; rep_ < NREP(12); ++rep_) { FRESH();
                pg8::Gemm g{WSP(const bf16, WS_P), WSP(const bf16, WS_WDN), 0, 1024, DFE, (size_t)1024 * DFE};
                pg8::MoeOrder S; S.init(WSP(const int, WS_TAB), 4, C.G, C.wg);
                pg8::EpiBf16<0> E{WSP(bf16, WS_MIX), 1024, nullptr, 0, 0};
                pg8::gemm_phase<pg8::EpiBf16<0>, pg8::MoeOrder, false>(C.lds, g, S, E, nullptr);
                SEAM(pb + 11);
            }
            if (PM(13) && IN(pb + 12)) { FRESH();
                if (last) moe_combine<2>(C, l, nrows);
                else { convert_small(C, l + 1); FRESH(); moe_combine<1>(C, l, nrows); if (IN(pb + NPH_L + 1)) { XcdBarrier b2_; b2_.bar = WSP(unsigned, WS_CTL) + CW_BAR; b2_.x = xb_xcc_id(); b2_.st = (volatile LAS unsigned*)(C.lds + MISC_OFF) + 8; xcd_barrier(b2_); } }
            }
        }
    }
}

extern "C" void kernel_launch(void* const* d_in, const int* in_sizes, int n_in, void* d_out, int out_size, void* d_ws, size_t ws_size, hipStream_t stream) {
    static int grid = 0;
    if (grid == 0) {
        if (n_in != N_IN || in_sizes[0] != T_LAT * DM || out_size != T_LAT * DM || ws_size < WS_END) {
            fprintf(stderr, "kernel_launch: unexpected problem (n_in %d, in0 %d, out %d, ws %zu < %zu)\n", n_in, n_in > 0 ? in_sizes[0] : -1, out_size, ws_size, (size_t)WS_END); grid = -1; return; }
        int dev = 0, cus = 0, per_cu = 0;
        if (hipGetDevice(&dev) != hipSuccess || hipDeviceGetAttribute(&cus, hipDeviceAttributeMultiprocessorCount, dev) != hipSuccess) { grid = -1; return; }
        if (hipFuncSetAttribute((const void*)fwd_kernel, hipFuncAttributeMaxDynamicSharedMemorySize, LDS_BYTES) != hipSuccess) { fprintf(stderr, "kernel_launch: hipFuncSetAttribute failed\n"); grid = -1; return; }
        if (hipOccupancyMaxActiveBlocksPerMultiprocessor(&per_cu, (const void*)fwd_kernel, NTHR, LDS_BYTES) != hipSuccess || per_cu < 1) { fprintf(stderr, "kernel_launch: occupancy query says %d\n", per_cu); grid = -1; return; }
        grid = cus;
        if (grid != 256) fprintf(stderr, "kernel_launch: note: %d CUs\n", grid);
    }
    if (grid < 0) return;
    if (hipMemsetAsync((char*)d_ws + WS_CTL, 0, CTL_BYTES, stream) != hipSuccess) return;
    Args a{};
    for (int i = 0; i < N_IN; ++i) a.in[i] = (const float*)d_in[i];
    a.out = (float*)d_out; a.ws = (unsigned char*)d_ws;
#if MK_ONE_LAUNCH
    a.ph_lo = 0; a.ph_hi = NPHASE;
    hipLaunchKernelGGL(fwd_kernel, dim3(grid), dim3(NTHR), LDS_BYTES, stream, a);
#else
    for (int ph = 0; ph < NPHASE; ++ph) { if (!phase_exists(ph)) continue; a.ph_lo = ph; a.ph_hi = ph + 1; hipLaunchKernelGGL(fwd_kernel, dim3(grid), dim3(NTHR), LDS_BYTES, stream, a); }
#endif
}
```

```cpp
#define MK_ONE_LAUNCH 1
#include <hip/hip_runtime.h>
#include <cstdio>
#include <cstdint>

#define GAS __attribute__((address_space(1)))
#define LAS __attribute__((address_space(3)))
typedef unsigned short bf16;
typedef unsigned v4u __attribute__((ext_vector_type(4)));
typedef unsigned v2u __attribute__((ext_vector_type(2)));
typedef float f32x4 __attribute__((ext_vector_type(4)));
typedef float f32x2 __attribute__((ext_vector_type(2)));
typedef short bf16x8 __attribute__((ext_vector_type(8)));
#define LDS_WAIT() asm volatile("s_waitcnt lgkmcnt(0)" ::: "memory")
#define VM_WAIT() asm volatile("s_waitcnt vmcnt(0)" ::: "memory")

constexpr int DM = 1024, NB = 8, SEQ = 4096, DEPTH = 4, CTXL = 256, GW = 256, HD = 64, NH = 4;
constexpr int T_LAT = NB * SEQ, T_CTX = NB * CTXL, T_ALL = T_LAT + T_CTX;
constexpr int IN_COLS = 3552, PLD = 3584;
constexpr int OFF_B = 512, OFF_C = 1472, OFF_D = 2512, B_COLS = 960;
constexpr int DFF = 2816, NE = 8, DFE = 1408;
constexpr int NCH = 68;
constexpr int NSTEP = 4352;
constexpr int MOE_MAXBLK = 280;
constexpr int NWAVES = 8, NTHR = 512;
#ifndef RW_VSPLIT
#define RW_VSPLIT 0
#endif

constexpr size_t MiB = 1u << 20;
constexpr size_t WS_CTL = 0, CTL_BYTES = 1 * MiB;
constexpr size_t WS_MODV = 1 * MiB;
constexpr size_t WS_XC = 2 * MiB;
constexpr size_t WS_WIN = 10 * MiB;
constexpr size_t WS_WOUT = 17 * MiB;
constexpr size_t WS_WGU = 19 * MiB;
constexpr size_t WS_WDN = 63 * MiB;
constexpr size_t WS_HB = 85 * MiB;
constexpr size_t WS_P = 153 * MiB;
constexpr size_t WS_MIX = 391 * MiB;
constexpr size_t WS_OUTB = WS_MIX, WS_OUTC = WS_MIX + 34 * MiB, WS_OUTD = WS_MIX + 68 * MiB, WS_GQ = WS_MIX + 102 * MiB, WS_G = WS_MIX + 153 * MiB;
constexpr size_t WS_XLAST = WS_MIX + 144 * MiB;
constexpr size_t WS_RKV = WS_MIX + 170 * MiB;
constexpr size_t WS_SMALL = 612 * MiB;
constexpr size_t WS_ROUTE = WS_SMALL;
constexpr size_t WS_POS = WS_SMALL + 1280 * 1024;
constexpr size_t WS_TOK = WS_SMALL + 1664 * 1024;
constexpr size_t WS_BONUS = WS_SMALL + 2 * MiB;
constexpr size_t WS_RINV = WS_SMALL + 2 * MiB + 640 * 1024;
constexpr size_t WS_WGBASE = WS_SMALL + 3 * MiB + 256 * 1024;
constexpr size_t WS_TAB = WS_WGBASE + 65536;
constexpr size_t WS_LRUWT = WS_SMALL + 3 * MiB + 512 * 1024;
constexpr size_t WS_RWT = WS_LRUWT + 131072;
constexpr size_t WS_LRUH = WS_SMALL + 4 * MiB;
constexpr size_t WS_END = 633 * MiB;
constexpr int CW_MOECNT = 1024;
constexpr int CW_PREPQ = 2048;
constexpr int CW_BAR = 4096;

constexpr int LDS_BYTES = 135168;
constexpr int MISC_OFF = 131072;

__device__ __forceinline__ unsigned f2bf(float f) { unsigned u = __builtin_bit_cast(unsigned, f); return (u + 0x7fffu + ((u >> 16) & 1u)) >> 16; }
typedef __bf16 bf16n2 __attribute__((ext_vector_type(2)));
__device__ __forceinline__ unsigned pk2(float lo, float hi) { const f32x2 v = {lo, hi}; return __builtin_bit_cast(unsigned, __builtin_convertvector(v, bf16n2)); }
__device__ __forceinline__ unsigned f2bf1(float f) { return pk2(f, f) & 0xffffu; }
__device__ __forceinline__ float bf2f(unsigned short v) { return __builtin_bit_cast(float, (unsigned)v << 16); }
__device__ __forceinline__ float bflo(unsigned v) { return __builtin_bit_cast(float, v << 16); }
__device__ __forceinline__ float bfhi(unsigned v) { return __builtin_bit_cast(float, v & 0xffff0000u); }
template <int CTRL, int RM, bool BC> __device__ __forceinline__ float dpp_x(float oldv, float v) { return __builtin_bit_cast(float, __builtin_amdgcn_update_dpp(__builtin_bit_cast(int, oldv), __builtin_bit_cast(int, v), CTRL, RM, 0xF, BC)); }
__device__ __forceinline__ float wave_sum(float v) {
    v += dpp_x<0xB1, 0xF, true>(0.f, v); v += dpp_x<0x4E, 0xF, true>(0.f, v); v += dpp_x<0x141, 0xF, true>(0.f, v); v += dpp_x<0x140, 0xF, true>(0.f, v);
    v += dpp_x<0x142, 0xA, false>(0.f, v); v += dpp_x<0x143, 0xC, false>(0.f, v);
    return __builtin_bit_cast(float, __builtin_amdgcn_readlane(__builtin_bit_cast(int, v), 63));
}
template <int CTRL> __device__ __forceinline__ float dpp_f(float v) { return __builtin_bit_cast(float, __builtin_amdgcn_update_dpp(0, __builtin_bit_cast(int, v), CTRL, 0xF, 0xF, true)); }
__device__ __forceinline__ float row16_sum(float v) {
    v += dpp_f<0xB1>(v);
    v += dpp_f<0x4E>(v);
    v += dpp_f<0x141>(v);
    v += dpp_f<0x140>(v);
    return v;
}
__device__ __forceinline__ float sigmoidf_(float x) { return __builtin_amdgcn_rcpf(1.0f + __expf(-x)); }
__device__ __forceinline__ float softplusf_(float x) { return fmaxf(x, 0.f) + __logf(1.0f + __expf(-fabsf(x))); }
__device__ __forceinline__ float expm1f_(float x) { return x > -0.3f ? x * (1.0f + x * (0.5f + x * (0.16666667f + x * (0.041666668f + x * 0.0083333338f)))) : __expf(x) - 1.0f; }
__device__ __forceinline__ float siluf_(float x) { return x * __builtin_amdgcn_rcpf(1.0f + __expf(-x)); }
__device__ __forceinline__ float tanhf_(float x) { const float e = __expf(2.0f * x); return 1.0f - 2.0f * __builtin_amdgcn_rcpf(e + 1.0f); }
__device__ __forceinline__ float rsqrtf_(float x) { return __builtin_amdgcn_rsqf(x); }
__device__ __forceinline__ float gelu_tanh(float x) { return 0.5f * x * (1.0f + tanhf_(0.7978845608028654f * (x + 0.044715f * x * x * x))); }
__device__ __forceinline__ f32x4 ld4bf(const bf16* p) { const v2u a = *(const v2u*)p; return (f32x4){bflo(a.x), bfhi(a.x), bflo(a.y), bfhi(a.y)}; }
__device__ __forceinline__ void st4bf(bf16* p, const f32x4& v) { v2u o; o.x = pk2(v.x, v.y); o.y = pk2(v.z, v.w); *(v2u*)p = o; }
#define XB_TMO      128
#define XB_XCNT(j)  (256  + 64 * (j))
#define XB_XSUB(j)  (1280 + 64 * (j))
#define XB_XGEN(j)  (2304 + 64 * (j))
#define XB_TOP      3328
#define XB_TOPGEN   3392
#define XCD_BAR_WORDS 3456
#define XB_SPIN_CAP (1u << 22)

__device__ __forceinline__ unsigned xb_ld(unsigned* p)              { return __hip_atomic_load(p, __ATOMIC_RELAXED, __HIP_MEMORY_SCOPE_AGENT); }
__device__ __forceinline__ unsigned xb_add(unsigned* p, unsigned v) { return __hip_atomic_fetch_add(p, v, __ATOMIC_RELAXED, __HIP_MEMORY_SCOPE_AGENT); }
__device__ __forceinline__ unsigned xb_xcc_id() { return (unsigned)__builtin_amdgcn_s_getreg((3 << 11) | 20) & 0xFu; }
#define XB_SPIN(cond, bar) do { unsigned _sp = 0; while (cond) { __builtin_amdgcn_s_sleep(1); \
    if ((++_sp & 255u) == 0u) { if (xb_ld(&(bar)[XB_TMO])) break; if (_sp > XB_SPIN_CAP) { atomicAdd(&(bar)[XB_TMO], 1u); break; } } } } while (0)

struct XcdBarrier {
    unsigned* bar; unsigned x;
    volatile LAS unsigned* st;
};

__device__ __forceinline__ XcdBarrier xcd_barrier_post(unsigned* bar, volatile LAS unsigned* st) {
    XcdBarrier b; b.bar = bar; b.x = xb_xcc_id(); b.st = st;
    if (threadIdx.x == 0) (void)xb_add(&bar[XB_XCNT(b.x)], 1u);
    return b;
}
__device__ __forceinline__ void xcd_barrier_complete(unsigned* bar, unsigned x, unsigned& nloc, unsigned& nx) {
    const unsigned G = gridDim.x * gridDim.y * gridDim.z;
    unsigned sum, cnt, mine, sp = 0u;
    for (;;) {
        sum = 0u; cnt = 0u; mine = 0u;
#pragma unroll
        for (unsigned j = 0; j < 16; ++j) { const unsigned c = xb_ld(&bar[XB_XCNT(j)]); sum += c; cnt += (c > 0u) ? 1u : 0u; mine = (j == x) ? c : mine; }
        if (sum == G) break;
        __builtin_amdgcn_s_sleep(1);
        if ((++sp & 255u) == 0u) { if (xb_ld(&bar[XB_TMO])) break; if (sp > XB_SPIN_CAP) { atomicAdd(&bar[XB_TMO], 1u); break; } }
    }
    nloc = mine > 0u ? mine : 1u; nx = cnt > 0u ? cnt : 1u;
}

__device__ __forceinline__ void xcd_barrier(const XcdBarrier& b) {
    asm volatile("s_waitcnt vmcnt(0)" ::: "memory");
    __syncthreads();
    if (threadIdx.x == 0) {
        unsigned* bar = b.bar;
        __builtin_amdgcn_s_waitcnt(0);
        unsigned nloc = b.st[0], nx = b.st[1];
        if (nloc == 0u) { xcd_barrier_complete(bar, b.x, nloc, nx); b.st[0] = nloc; b.st[1] = nx; }
        const unsigned old = xb_add(&bar[XB_XSUB(b.x)], 1u);
        const unsigned gen = old / nloc;
        if (old + 1u == (gen + 1u) * nloc) {
            __builtin_amdgcn_fence(__ATOMIC_RELEASE, "agent");
            asm volatile("s_waitcnt vmcnt(0)" ::: "memory");
            const unsigned og = xb_add(&bar[XB_TOP], 1u);
            const unsigned tg = og / nx;
            if (og + 1u == (tg + 1u) * nx) xb_add(&bar[XB_TOPGEN], 1u);
            else XB_SPIN(xb_ld(&bar[XB_TOPGEN]) == tg, bar);
            __builtin_amdgcn_fence(__ATOMIC_ACQUIRE, "agent");
            xb_add(&bar[XB_XGEN(b.x)], 1u);
            asm volatile("s_waitcnt vmcnt(0)" ::: "memory");
        } else {
            XB_SPIN(xb_ld(&bar[XB_XGEN(b.x)]) == gen, bar);
            __builtin_amdgcn_fence(__ATOMIC_ACQUIRE, "agent");
            asm volatile("s_waitcnt vmcnt(0)" ::: "memory");
        }
    }
    __syncthreads();
}

namespace pg8 {
#define PG8_LAS __attribute__((address_space(3)))
typedef unsigned short bf16_t;
typedef short bf16x8 __attribute__((ext_vector_type(8)));
typedef float f32x4 __attribute__((ext_vector_type(4)));
typedef unsigned u32x4 __attribute__((ext_vector_type(4)));
constexpr int BM = 256, BK = 64, HALF = 128, HTB = HALF * BK * 2  , STAGE_BYTES = 8 * HTB, NXCD = 8, WGM = 8;

__host__ __device__ __forceinline__ int lds_byte(int r, int c) { const int st = (r >> 4) * 2 + (c >> 5), rr = r & 15, cc = c & 31, ob = rr * 64 + cc * 2; return st * 1024 + (ob ^ (((ob >> 9) & 1) << 5)); }
__host__ __device__ __forceinline__ void stage_rc(int b, int& R, int& C) { const int st = b / 1024, sb = b % 1024, swz = sb ^ (((sb >> 9) & 1) << 5); R = (st >> 1) * 16 + swz / 64; C = (st & 1) * 32 + (swz % 64) / 2; }
__host__ __device__ __forceinline__ int perm32(int rho) { const int n = rho >> 4, i = rho & 15; return 8 * (i >> 2) + 4 * n + (i & 3); }

struct Unit { int pm, pn, e; };
struct Gemm { const bf16_t* A; const bf16_t* Bt; int M, N, K; size_t estride; };

struct StaticOrder {
    static constexpr bool GATHER = false, HALFS = false;
    int nM, nN, nwg, G, c;
    __host__ __device__ void init(int M, int N, int G_, int c_) { nM = M / BM; nN = N / BM; nwg = nM * nN; G = G_; c = c_; }
    __host__ __device__ bool next(int i, Unit& u) const {
        const long L = (long)i * G + c; if (L >= nwg) return false;
        int wgid = (int)L; { const int q = nwg / NXCD, r = nwg % NXCD, xcd = wgid % NXCD, off = wgid / NXCD; wgid = (xcd < r ? xcd * (q + 1) : r * (q + 1) + (xcd - r) * q) + off; }
        const int nig = WGM * nN, gid = wgid / nig, fm = gid * WGM, gsz = (nM - fm) < WGM ? (nM - fm) : WGM;
        u.pm = fm + ((wgid % nig) % gsz); u.pn = (wgid % nig) / gsz; u.e = 0; return true;
    }
    __device__ __forceinline__ void a_ready(const Unit&) const {}
    __device__ __forceinline__ void done(const Unit&) const {}
};
struct TailHalfOrder {
    static constexpr bool GATHER = false, HALFS = true;
    int nM, nwg, G, c, ntail;
    __device__ __forceinline__ void init(int M, int G_, int c_) { const int nMall = M / BM; nM = nMall >= 128 ? 128 : nMall; nwg = nM * 4; ntail = nMall - nM; G = G_; c = c_; }
    __device__ __forceinline__ bool next(int i, Unit& u) const {
        const int L = i * G + c;
        if (L < nwg) {
            int wgid = L; { const int q = nwg / NXCD, r = nwg % NXCD, xcd = wgid % NXCD, off = wgid / NXCD; wgid = (xcd < r ? xcd * (q + 1) : r * (q + 1) + (xcd - r) * q) + off; }
            const int nig = WGM * 4, gid = wgid / nig, fm = gid * WGM, gsz = (nM - fm) < WGM ? (nM - fm) : WGM;
            u.pm = fm + ((wgid % nig) % gsz); u.pn = (wgid % nig) / gsz; u.e = 0; return true;
        }
        const int t = L - nwg; if (t >= ntail * 8) return false;
        const int nh = t / ntail; u.pm = 128 + (t - nh * ntail); u.pn = (nh >> 1) | ((1 + (nh & 1)) << 8); u.e = 0; return true;
    }
    __device__ __forceinline__ void a_ready(const Unit&) const {}
    __device__ __forceinline__ void done(const Unit&) const {}
};
typedef __bf16 bf16n2_ __attribute__((ext_vector_type(2)));
__device__ __forceinline__ unsigned cvt_pk_bf16(float lo, float hi) { typedef float f2_ __attribute__((ext_vector_type(2))); const f2_ v = {lo, hi}; return __builtin_bit_cast(unsigned, __builtin_convertvector(v, bf16n2_)); }
typedef float f32x2 __attribute__((ext_vector_type(2)));
__device__ __forceinline__ f32x2 gelu_pk(f32x2 v) {
    const f32x2 av = __builtin_elementwise_abs(v), d = av * 0.2316418882f + 1.0f;
    f32x2 t; t.x = __builtin_amdgcn_rcpf(d.x); t.y = __builtin_amdgcn_rcpf(d.y);
    f32x2 q = t * 0.5307027145f + (-0.7265760135f); q = q * t + 0.7107068705f; q = q * t + (-0.142248368f); q = q * t + 0.127414796f; q = q * t;
    const f32x2 s = (v * v) * (-0.72134752044f);
    f32x2 e; e.x = __builtin_amdgcn_exp2f(s.x); e.y = __builtin_amdgcn_exp2f(s.y);
    const f32x2 m = v * (q * e), r = v - m;
    f32x2 o; o.x = v.x < 0.f ? m.x : r.x; o.y = v.y < 0.f ? m.y : r.y; return o;
}

struct EpiF32 {
    static constexpr bool PERM = false, AFTER_DRAIN = false;
    float* C; int ldc; const float* bias;
    __device__ __forceinline__ void operator()(const f32x4 (&acc)[2][2][4][2], const Unit& u, int wr, int wc, int fr, int fq) const {
        const int row0 = u.pm * BM + wr * 64 + fr, col0 = u.pn * BM + wc * 32 + 4 * fq;
        f32x4 bv[2][2];
#pragma unroll
        for (int bj = 0; bj < 2; ++bj)
#pragma unroll
            for (int n = 0; n < 2; ++n) bv[bj][n] = bias ? *(const f32x4*)(bias + col0 + bj * HALF + n * 16) : (f32x4){0.f, 0.f, 0.f, 0.f};
#pragma unroll
        for (int ai = 0; ai < 2; ++ai)
#pragma unroll
            for (int m = 0; m < 4; ++m) { float* rowp = C + (size_t)(row0 + ai * HALF + m * 16) * ldc + col0;
#pragma unroll
                for (int bj = 0; bj < 2; ++bj)
#pragma unroll
                    for (int n = 0; n < 2; ++n) *(f32x4*)(rowp + bj * HALF + n * 16) = acc[ai][bj][m][n] + bv[bj][n]; }
    }
};
template <int ACT  > struct EpiBf16 {
    static constexpr bool PERM = true, AFTER_DRAIN = false;
    bf16_t* O; int ldc; const float* bias; int split_cols; size_t split_stride;
    __device__ __forceinline__ void operator()(const f32x4 (&acc)[2][2][4][2], const Unit& u, int wr, int wc, int fr, int fq) const {
        const int row0 = u.pm * BM + wr * 64 + fr; int colt = u.pn * BM; bf16_t* base = O;
        if (split_cols) { const int t = colt / split_cols; base += (size_t)t * split_stride; colt -= t * split_cols; }
        const int col0 = colt + wc * 32 + 8 * fq, bcol0 = u.pn * BM + wc * 32 + 8 * fq;
        f32x4 bv[2][2];
#pragma unroll
        for (int bj = 0; bj < 2; ++bj)
#pragma unroll
            for (int n = 0; n < 2; ++n) bv[bj][n] = bias ? *(const f32x4*)(bias + bcol0 + bj * HALF + 4 * n) : (f32x4){0.f, 0.f, 0.f, 0.f};
#pragma unroll
        for (int ai = 0; ai < 2; ++ai)
#pragma unroll
            for (int m = 0; m < 4; ++m) { bf16_t* rowp = base + (size_t)(row0 + ai * HALF + m * 16) * ldc + col0;
#pragma unroll
                for (int bj = 0; bj < 2; ++bj) { f32x4 v0 = acc[ai][bj][m][0] + bv[bj][0], v1 = acc[ai][bj][m][1] + bv[bj][1];
                    if (ACT == 1) { f32x2 a = gelu_pk((f32x2){v0[0], v0[1]}), b = gelu_pk((f32x2){v0[2], v0[3]}), c = gelu_pk((f32x2){v1[0], v1[1]}), d = gelu_pk((f32x2){v1[2], v1[3]});
                        v0 = (f32x4){a.x, a.y, b.x, b.y}; v1 = (f32x4){c.x, c.y, d.x, d.y}; }
                    if (ACT == 2) {
#pragma unroll
                        for (int j = 0; j < 4; ++j) { v0[j] = 0.5f * v0[j] * (1.0f + erff(v0[j] * 0.70710678f)); v1[j] = 0.5f * v1[j] * (1.0f + erff(v1[j] * 0.70710678f)); } }
                    u32x4 w; w.x = cvt_pk_bf16(v0[0], v0[1]); w.y = cvt_pk_bf16(v0[2], v0[3]); w.z = cvt_pk_bf16(v1[0], v1[1]); w.w = cvt_pk_bf16(v1[2], v1[3]);
                    *(u32x4*)(rowp + bj * HALF) = w; } }
    }
};

template <class Epi, class Sched, bool STAMP = false>
__device__ __forceinline__ void gemm_phase(PG8_LAS unsigned char* lds, const Gemm g, const Sched& S, const Epi& E, unsigned long long* stamps) {
    int tid_ = threadIdx.x; asm volatile("" : "+v"(tid_));
    const int tid = tid_, wid = __builtin_amdgcn_readfirstlane(tid >> 6), lane = tid & 63, wr = wid >> 2, wc = wid & 3, fr = lane & 15, fq = lane >> 4;
    const int K = g.K, nt = K / BK;
    constexpr bool GATHER = Sched::GATHER; constexpr bool HALFS = Sched::HALFS;
    int ts_lo = 0, ts_hi = 0, nts = 0; const unsigned long long rt_entry = STAMP ? (unsigned long long)wall_clock64() : 0ull;
#define PG8_STAMP() do { if (STAMP && wid == 0 && nts < 64) { const unsigned long long _c = (unsigned long long)clock64(); \
        ts_lo = (lane == nts) ? (int)(unsigned)_c : ts_lo; ts_hi = (lane == nts) ? (int)(unsigned)(_c >> 32) : ts_hi; ++nts; } } while (0)
    PG8_STAMP();
    unsigned voffA[2], voffB[2]; int rowA[2];
#pragma unroll
    for (int i = 0; i < 2; ++i) { int R, C; stage_rc(tid * 16 + i * 8192, R, C); const int Rb = Epi::PERM ? ((R & ~31) + perm32(R & 31)) : R;
        rowA[i] = R; voffA[i] = GATHER ? (unsigned)C * 2u : (unsigned)(R * K + C) * 2u; voffB[i] = (unsigned)(Rb * K + C) * 2u; }
    const size_t kstep = (size_t)(BK * 2);
    const size_t hstep = (size_t)HALF * K * 2;
    const size_t tstep = 2 * hstep;
    const unsigned ldsw = (unsigned)wid * 1024u;
    const int aoff = lds_byte(wr * 64 + fr, fq * 8), boff = lds_byte(wc * 32 + fr, fq * 8);
#define PG8_SA(b, h) (((b) * 2 + (h)) * HTB)
#define PG8_SB(b, h) ((4 + (b) * 2 + (h)) * HTB)
#define PG8_STAGE(bufoff, gbase, voff) do { _Pragma("unroll") for (int _i = 0; _i < 2; ++_i) \
        __builtin_amdgcn_global_load_lds((const unsigned*)((const char*)(gbase) + (voff)[_i]), (PG8_LAS unsigned*)(lds + (bufoff) + ldsw + _i * 8192), 16, 0, 0); } while (0)
#define PG8_STAGE_A(bufoff, gbase, h, gv) do { if constexpr (GATHER) { PG8_STAGE(bufoff, gbase, (gv)[h]); } else { PG8_STAGE(bufoff, (gbase) + (h) * hstep, voffA); } } while (0)
#define PG8_TOKSLOT(s) ((PG8_LAS int*)(lds + STAGE_BYTES + 1024 + ((s) & 1) * 1024))
#define PG8_LDA(dst, b, h) do { _Pragma("unroll") for (int m = 0; m < 4; ++m) _Pragma("unroll") for (int k = 0; k < 2; ++k) dst[m][k] = *(const PG8_LAS bf16x8*)(lds + PG8_SA(b, h) + aoff + m * 2048 + k * 1024); } while (0)
#define PG8_LDB(dst, b, h) do { _Pragma("unroll") for (int n = 0; n < 2; ++n) _Pragma("unroll") for (int k = 0; k < 2; ++k) dst[n][k] = *(const PG8_LAS bf16x8*)(lds + PG8_SB(b, h) + boff + n * 2048 + k * 1024); } while (0)
#define PG8_MMA(ai, bj, At, Bt) do { __builtin_amdgcn_s_setprio(1); _Pragma("unroll") for (int m = 0; m < 4; ++m) _Pragma("unroll") for (int n = 0; n < 2; ++n) _Pragma("unroll") for (int k = 0; k < 2; ++k) \
        acc[ai][bj][m][n] = __builtin_amdgcn_mfma_f32_16x16x32_bf16(Bt[n][k], At[m][k], acc[ai][bj][m][n], 0, 0, 0); __builtin_amdgcn_s_setprio(0); } while (0)
#define PG8_WAIT_V(n) asm volatile("s_waitcnt vmcnt(" #n ")" ::: "memory")
#define PG8_WAIT_L(n) asm volatile("s_waitcnt lgkmcnt(" #n ")" ::: "memory")
#define PG8_BAR __builtin_amdgcn_s_barrier()
#define PG8_SCHED __builtin_amdgcn_sched_barrier(0)
    Unit cur, nxt; int ui = 0;
    if (!S.next(0, cur)) return;
    f32x4 acc[2][2][4][2];
#pragma unroll
    for (int a = 0; a < 2; ++a)
#pragma unroll
        for (int b = 0; b < 2; ++b)
#pragma unroll
            for (int m = 0; m < 4; ++m)
#pragma unroll
                for (int n = 0; n < 2; ++n) acc[a][b][m][n] = (f32x4){0.f, 0.f, 0.f, 0.f};
    bf16x8 At[4][2], B0[2][2], B1[2][2];
    const char* cA = (const char*)g.A + (GATHER ? (size_t)0 : (size_t)cur.pm * tstep); const char* cB = (const char*)g.Bt + (size_t)(HALFS ? cur.pn & 255 : cur.pn) * tstep + (size_t)cur.e * g.estride * 2 + ((HALFS && (cur.pn >> 8) == 2) ? hstep : (size_t)0);
    S.a_ready(cur);
    unsigned gcur[2][2], gnxt[2][2], gs[2][2];
    if constexpr (GATHER) {
        if (tid < 256) PG8_TOKSLOT(0)[tid] = S.tok[cur.pm * 256 + tid];
        __syncthreads();
#pragma unroll
        for (int h = 0; h < 2; ++h)
#pragma unroll
            for (int i = 0; i < 2; ++i) { gcur[h][i] = (unsigned)PG8_TOKSLOT(0)[h * HALF + rowA[i]] * (unsigned)(K * 2) + voffA[i]; gnxt[h][i] = gcur[h][i]; gs[h][i] = gcur[h][i]; }
    }
    PG8_STAGE(PG8_SB(0, 0), cB, voffB); PG8_STAGE_A(PG8_SA(0, 0), cA, 0, gcur); PG8_STAGE(PG8_SB(0, 1), cB + hstep, voffB); PG8_STAGE_A(PG8_SA(0, 1), cA, 1, gcur);
    if (wr == 1) PG8_BAR;
    PG8_WAIT_V(4); PG8_BAR;
    PG8_STAGE(PG8_SB(1, 0), cB + kstep, voffB); PG8_STAGE_A(PG8_SA(1, 0), cA + kstep, 0, gcur); PG8_STAGE(PG8_SB(1, 1), cB + hstep + kstep, voffB);
    PG8_WAIT_V(6); PG8_BAR;
    PG8_STAMP();
    for (;;) {
        const bool has_next = S.next(ui + 1, nxt);
        if constexpr (GATHER) { if (has_next && wid < 4)
            __builtin_amdgcn_global_load_lds((const unsigned*)(S.tok + nxt.pm * 256 + wid * 64 + lane), (PG8_LAS unsigned*)((PG8_LAS unsigned char*)PG8_TOKSLOT(ui + 1) + wid * 256), 4, 0, 0); }
        const char* nA = GATHER ? (const char*)g.A : has_next ? (const char*)g.A + (size_t)nxt.pm * tstep : cA; const char* nB = has_next ? (const char*)g.Bt + (size_t)(HALFS ? nxt.pn & 255 : nxt.pn) * tstep + (size_t)nxt.e * g.estride * 2 + ((HALFS && (nxt.pn >> 8) == 2) ? hstep : (size_t)0) : cB;
        const bool full = !HALFS || (cur.pn >> 8) == 0;
        for (int t = 0; t < nt; t += 2) {
            const bool last = (t == nt - 2);
            const char* a1 = cA + (size_t)(t + 1) * kstep;
            const char* a2 = last ? nA : cA + (size_t)(t + 2) * kstep; const char* b2 = last ? nB : cB + (size_t)(t + 2) * kstep;
            const char* a3 = a2 + kstep; const char* b3 = b2 + kstep;
            if (last && has_next) S.a_ready(nxt);
            if constexpr (GATHER) {
                if (last && has_next) {
#pragma unroll
                    for (int h = 0; h < 2; ++h)
#pragma unroll
                        for (int i = 0; i < 2; ++i) gnxt[h][i] = (unsigned)PG8_TOKSLOT(ui + 1)[h * HALF + rowA[i]] * (unsigned)(K * 2) + voffA[i];
                }
#pragma unroll
                for (int h = 0; h < 2; ++h)
#pragma unroll
                    for (int i = 0; i < 2; ++i) gs[h][i] = last ? gnxt[h][i] : gcur[h][i];
            }
            PG8_LDB(B0, 0, 0); PG8_SCHED; PG8_LDA(At, 0, 0); PG8_STAGE_A(PG8_SA(1, 1), a1, 1, gcur);
            PG8_WAIT_L(8); PG8_BAR; PG8_WAIT_L(0); PG8_MMA(0, 0, At, B0); PG8_BAR; PG8_SCHED;
            if (full) PG8_LDB(B1, 0, 1); PG8_STAGE(PG8_SB(0, 0), b2, voffB);
            PG8_BAR; PG8_WAIT_L(0); if (full) PG8_MMA(0, 1, At, B1); PG8_BAR;
            PG8_LDA(At, 0, 1); PG8_STAGE_A(PG8_SA(0, 0), a2, 0, gs);
            PG8_BAR; PG8_WAIT_L(0); PG8_MMA(1, 0, At, B0); PG8_BAR; PG8_SCHED;
            PG8_STAGE(PG8_SB(0, 1), b2 + hstep, voffB);
            PG8_WAIT_V(6); PG8_BAR; if (full) PG8_MMA(1, 1, At, B1); PG8_BAR;
            PG8_LDB(B0, 1, 0); PG8_SCHED; PG8_LDA(At, 1, 0); PG8_STAGE_A(PG8_SA(0, 1), a2, 1, gs);
            PG8_WAIT_L(8); PG8_BAR; PG8_WAIT_L(0); PG8_MMA(0, 0, At, B0); PG8_BAR; PG8_SCHED;
            if (full) PG8_LDB(B1, 1, 1); PG8_STAGE(PG8_SB(1, 0), b3, voffB);
            PG8_BAR; PG8_WAIT_L(0); if (full) PG8_MMA(0, 1, At, B1); PG8_BAR;
            PG8_LDA(At, 1, 1); PG8_STAGE_A(PG8_SA(1, 0), a3, 0, gs);
            PG8_BAR; PG8_WAIT_L(0); PG8_MMA(1, 0, At, B0); PG8_BAR; PG8_SCHED;
            PG8_STAGE(PG8_SB(1, 1), b3 + hstep, voffB);
            PG8_WAIT_V(6); PG8_BAR; if (full) PG8_MMA(1, 1, At, B1); PG8_BAR;
        }
        PG8_STAMP();
        if constexpr (!Epi::AFTER_DRAIN) { E(acc, cur, wr, wc, fr, fq); S.done(cur); }
        PG8_STAMP();
        if (!has_next) break;
#pragma unroll
        for (int a = 0; a < 2; ++a)
#pragma unroll
            for (int b = 0; b < 2; ++b)
#pragma unroll
                for (int m = 0; m < 4; ++m)
#pragma unroll
                    for (int n = 0; n < 2; ++n) acc[a][b][m][n] = (f32x4){0.f, 0.f, 0.f, 0.f};
        cur = nxt; cA = nA; cB = nB; ++ui;
        if constexpr (GATHER) {
#pragma unroll
            for (int h = 0; h < 2; ++h)
#pragma unroll
                for (int i = 0; i < 2; ++i) gcur[h][i] = gnxt[h][i];
        }
    }
    PG8_WAIT_V(0);
    if (wr == 0) PG8_BAR;
    PG8_BAR;
    if constexpr (Epi::AFTER_DRAIN) { E.fused(acc, cur, wr, wc, fr, fq, lds, wid, lane); S.done(cur); }
    PG8_STAMP();
    if (STAMP && wid == 0) { stamps[lane] = lane < nts ? (((unsigned long long)(unsigned)ts_hi << 32) | (unsigned)ts_lo) : 0ull;
        if (lane == 62) stamps[62] = rt_entry; if (lane == 63) stamps[63] = (unsigned long long)wall_clock64(); }
#undef PG8_STAMP
#undef PG8_SA
#undef PG8_SB
#undef PG8_STAGE
#undef PG8_STAGE_A
#undef PG8_TOKSLOT
#undef PG8_LDA
#undef PG8_LDB
#undef PG8_MMA
#undef PG8_WAIT_V
#undef PG8_WAIT_L
#undef PG8_BAR
#undef PG8_SCHED
}
}
namespace pg8 {
struct EpiRes {
    static constexpr bool PERM = true, AFTER_DRAIN = false;
    const void* base_lat; const float* base_ctx; void* out_lat; float* out_ctx; const float* gvec; bool base_bf, out_bf;
    __device__ __forceinline__ void operator()(const f32x4 (&acc)[2][2][4][2], const Unit& u, int wr, int wc, int fr, int fq) const {
        const bool isctx = u.pm >= 128;
        const int prow = (isctx ? (u.pm - 128) : u.pm) * BM;
        const float* base = isctx ? base_ctx : (const float*)base_lat; float* out = isctx ? out_ctx : (float*)out_lat;
        const bool bbf = !isctx && base_bf, obf = !isctx && out_bf;
        const float* gv = gvec + (size_t)(isctx ? 8 : (u.pm >> 4)) * 6144;
        const int row0 = prow + wr * 64 + fr, hf = u.pn >> 8, col0 = (u.pn & 255) * BM + (hf == 2 ? HALF : 0) + wc * 32 + 8 * fq;
        f32x4 gvv[2][2];
#pragma unroll
        for (int bj = 0; bj < 2; ++bj)
#pragma unroll
            for (int n = 0; n < 2; ++n) gvv[bj][n] = *(const f32x4*)(gv + col0 + bj * HALF + 4 * n);
#pragma unroll
        for (int ai = 0; ai < 2; ++ai)
#pragma unroll
            for (int m = 0; m < 4; ++m) { const size_t off = (size_t)(row0 + ai * HALF + m * 16) * 1024 + col0;
#pragma unroll
                for (int bj = 0; bj < 2; ++bj) { if (bj == 1 && hf != 0) continue; const size_t o2 = off + bj * HALF;
                    f32x4 b0, b1;
                    if (bbf) { const v4u r = *(const v4u*)((const bf16*)base_lat + o2); b0 = (f32x4){bflo(r.x), bfhi(r.x), bflo(r.y), bfhi(r.y)}; b1 = (f32x4){bflo(r.z), bfhi(r.z), bflo(r.w), bfhi(r.w)}; }
                    else { b0 = *(const f32x4*)(base + o2); b1 = *(const f32x4*)(base + o2 + 4); }
                    const f32x4 v0 = b0 + gvv[bj][0] * acc[ai][bj][m][0], v1 = b1 + gvv[bj][1] * acc[ai][bj][m][1];
                    if (obf) { v4u w; w.x = pk2(v0.x, v0.y); w.y = pk2(v0.z, v0.w); w.z = pk2(v1.x, v1.y); w.w = pk2(v1.z, v1.w); *(v4u*)((bf16*)out_lat + o2) = w; }
                    else { *(f32x4*)(out + o2) = v0; *(f32x4*)(out + o2 + 4) = v1; } } }
    }
};
struct EpiSwiglu {
    static constexpr bool PERM = true, AFTER_DRAIN = false;
    bf16_t* O; int ldc;
    __device__ __forceinline__ void operator()(const f32x4 (&acc)[2][2][4][2], const Unit& u, int wr, int wc, int fr, int fq) const {
        const int row0 = u.pm * BM + wr * 64 + fr, col0 = u.pn * HALF + wc * 32 + 8 * fq;
#pragma unroll
        for (int ai = 0; ai < 2; ++ai)
#pragma unroll
            for (int m = 0; m < 4; ++m) { bf16_t* rowp = O + (size_t)(row0 + ai * HALF + m * 16) * ldc + col0;
                float h[8];
#pragma unroll
                for (int n = 0; n < 2; ++n)
#pragma unroll
                    for (int j = 0; j < 4; ++j) { const float g = acc[ai][0][m][n][j], up = acc[ai][1][m][n][j]; h[n * 4 + j] = g * __builtin_amdgcn_rcpf(1.0f + __expf(-g)) * up; }
                u32x4 w; w.x = cvt_pk_bf16(h[0], h[1]); w.y = cvt_pk_bf16(h[2], h[3]); w.z = cvt_pk_bf16(h[4], h[5]); w.w = cvt_pk_bf16(h[6], h[7]);
                *(u32x4*)rowp = w; }
    }
};
struct MoeOrder {
    static constexpr bool GATHER = false, HALFS = false;
    int nN, G, c, nunits; const int* tab;
    __device__ void init(const int* tab_, int nN_, int G_, int c_) { tab = tab_; nN = nN_; G = G_; c = c_; nunits = tab_[0] * nN_; }
    __device__ bool next(int i, Unit& u) const {
        const int L = i * G + c; if (L >= nunits) return false;
        const int q = nunits / NXCD, r = nunits % NXCD, xcd = L % NXCD, off = L / NXCD;
        const int w = (xcd < r ? xcd * (q + 1) : r * (q + 1) + (xcd - r) * q) + off;
        u.pm = w / nN; u.pn = w - u.pm * nN; u.e = tab[1 + u.pm]; return true;
    }
    __device__ __forceinline__ void a_ready(const Unit&) const {}
    __device__ __forceinline__ void done(const Unit&) const {}
};
struct MoeOrderG : MoeOrder { static constexpr bool GATHER = true; const int* tok; };
}
enum { I_X = 0, I_C, I_CTX, I_CCTX, I_MODW, I_MODB, I_NMIXG, I_NFFNG, I_WIN, I_WOUT, I_LCW, I_LCB, I_LWA, I_LBA, I_LWX, I_LBX, I_LLAM,
       I_RMU, I_RWUP, I_RW0, I_RAUP, I_RA0, I_RGUP, I_RKK, I_RKA, I_RRK, I_RLNG, I_RLNB, I_MIB, I_MFB, I_MNG, I_GCW, I_GALOG, I_GDTB, I_GNG,
       I_FWG, I_FWU, I_FWD, I_MROUTER, I_MWG, I_MWU, I_MWD, I_FNG, N_IN };
struct Args { const float* in[N_IN]; float* out; unsigned char* ws; int ph_lo, ph_hi; };
struct Ctx {
    const float* const* in; float* out; unsigned char* ws; LAS unsigned char* lds;
    int tid, lane, wave, G, wg;
};
#define WSP(T, off) ((T*)(C.ws + (off)))

__device__ __forceinline__ int seqrow_raster(int i, int d, int b) {
    if (i < CTXL) { const int p = d ? (CTXL - 1 - i) : i; return T_LAT + b * CTXL + p; }
    const int j = i - CTXL; const int p = d ? (SEQ - 1 - j) : j; return b * SEQ + p;
}
__device__ __forceinline__ int seqrow_cm(int i, int d, int b) {
    if (i < CTXL) { const int p = d ? (CTXL - 1 - i) : i; return T_LAT + b * CTXL + p; }
    const int j = i - CTXL; const int p = d ? (SEQ - 1 - j) : j; return b * SEQ + (p & 63) * 64 + (p >> 6);
}

__device__ __forceinline__ void phase_pre(const Ctx& C) {
    LAS float* sc = (LAS float*)C.lds;
    LAS float* red = sc + 9 * 1024;
    float* modv = WSP(float, WS_MODV);
    bool filled = false;
    for (int it = C.wg; it < DEPTH * 48; it += C.G) {
        if (!filled) {
            for (int i = C.tid; i < 9 * 1024; i += NTHR) { const float v = i < 8192 ? C.in[I_C][i] : C.in[I_CCTX][i - 8192]; sc[i] = siluf_(v); }
            filled = true; __syncthreads();
        }
        const int l = it / 48, jb = it % 48, col = C.tid & 127, kg = C.tid >> 7;
        const float* W = C.in[I_MODW] + (size_t)l * 1024 * 6144 + jb * 128 + col;
        float acc[9];
#pragma unroll
        for (int r = 0; r < 9; ++r) acc[r] = 0.f;
        for (int k = kg * 256; k < kg * 256 + 256; ++k) { const float w = W[(size_t)k * 6144];
#pragma unroll
            for (int r = 0; r < 9; ++r) acc[r] += sc[r * 1024 + k] * w; }
#pragma unroll
        for (int r = 0; r < 9; ++r) red[(kg * 9 + r) * 128 + col] = acc[r];
        __syncthreads();
        for (int i = C.tid; i < 9 * 128; i += NTHR) { const int r = i >> 7, cc = i & 127;
            const float s = red[(0 * 9 + r) * 128 + cc] + red[(1 * 9 + r) * 128 + cc] + red[(2 * 9 + r) * 128 + cc] + red[(3 * 9 + r) * 128 + cc];
            modv[((size_t)l * 9 + r) * 6144 + jb * 128 + cc] = s + C.in[I_MODB][l * 6144 + jb * 128 + cc]; }
        __syncthreads();
    }
}

__device__ __forceinline__ void tr_item(const float* src, size_t ld, int k0, int ns0, bf16* dst, int drow0, int Kd, LAS float* scr, int lane, bool zero) {
    if (!zero) {
#pragma unroll 8
        for (int i = 0; i < 32; ++i) { const int kk = 2 * i + (lane >> 5); scr[kk * 33 + (lane & 31)] = src[(size_t)(k0 + kk) * ld + ns0 + (lane & 31)]; }
    }
    LDS_WAIT(); asm volatile("" ::: "memory");
    const int c = lane & 7;
#pragma unroll
    for (int j = 0; j < 4; ++j) { const int n = (lane >> 3) + 8 * j; const LAS float* s = scr + (8 * c) * 33 + n;
        v4u o; o.x = pk2(s[0 * 33], s[1 * 33]); o.y = pk2(s[2 * 33], s[3 * 33]); o.z = pk2(s[4 * 33], s[5 * 33]); o.w = pk2(s[6 * 33], s[7 * 33]);
        if (zero) o = (v4u){0u, 0u, 0u, 0u};
        *(v4u*)(dst + (size_t)(drow0 + n) * Kd + k0 + 8 * c) = o; }
    LDS_WAIT(); asm volatile("" ::: "memory");
}
__device__ __forceinline__ void convert_small(const Ctx& C, int l) {
    {
        bf16* lw = WSP(bf16, WS_LRUWT);
        for (int k = 0; k < 2 * 2 * 4 * 4096 / (128 * NTHR); ++k) {
            const int e = k * 128 * NTHR + C.wg * NTHR + C.tid;
            if (C.wg < 128) {
            const int i = e & 63, j = (e >> 6) & 63, hd = (e >> 12) & 3, g = (e >> 14) & 1, d = e >> 15;
            const float* src = (g ? C.in[I_LWX] : C.in[I_LWA]) + ((size_t)((l * 2 + d) * 4 + hd) * 64 + i) * 64 + j;
            lw[e] = (bf16)f2bf(*src);
            }
        }
    }
    if (C.wg >= 128 && C.wg < 224) {
        bf16* rw = WSP(bf16, WS_RWT);
        const int e = (C.wg - 128) * NTHR + C.tid;
        if (e < 32768) { const int r = e & 31, ch = (e >> 5) & 255, d = (e >> 13) & 1, isa = e >> 14;
            rw[e] = (bf16)f2bf((isa ? C.in[I_RAUP] : C.in[I_RWUP])[((size_t)(l * 2 + d) * 32 + r) * GW + ch]); }
        else { const int e2 = e - 32768, j = e2 & 63, ch = e2 >> 6; rw[e] = (bf16)f2bf(C.in[I_RGUP][((size_t)l * 64 + j) * GW + ch]); }
    }
}
__device__ __forceinline__ void convert_items(const Ctx& C, int l, int what, int gw, int NGW) {
    LAS float* scr = (LAS float*)(C.lds + C.wave * 8704);
    constexpr int I_IN = 16 * 112, I_OUT = 16 * 32, I_GU = 16 * 176, I_DN = 44 * 32, I_E = 16 * 88 + 22 * 32;
    const bool moe = l & 1; const int li = l >> 1;
    const int lo_it = (what & 1) ? 0 : I_IN, hi_it = (what & 2) ? I_IN + I_OUT + (moe ? NE * I_E : (I_GU + I_DN)) : I_IN;
    bf16* win = WSP(bf16, WS_WIN); bf16* wout = WSP(bf16, WS_WOUT); bf16* wgu = WSP(bf16, WS_WGU); bf16* wdn = WSP(bf16, WS_WDN);
    for (int it = lo_it + gw; it < hi_it; it += NGW) {
        int r = it;
        if (r < I_IN) { const int kb = r / 112, nb = r % 112; tr_item(C.in[I_WIN] + (size_t)l * 1024 * IN_COLS, IN_COLS, 64 * kb, 32 * nb, win, 32 * nb, 1024, scr, C.lane, nb == 111); continue; }
        r -= I_IN;
        if (r < I_OUT) { const int kb = r / 32, nb = r % 32; tr_item(C.in[I_WOUT] + (size_t)l * 1024 * 1024, 1024, 64 * kb, 32 * nb, wout, 32 * nb, 1024, scr, C.lane, false); continue; }
        r -= I_OUT;
        if (!moe) {
            if (r < I_GU) { const int kb = r / 176, nb = r % 176, tile = nb >> 3, q = nb & 7;
                const float* src = (q < 4 ? C.in[I_FWG] : C.in[I_FWU]) + (size_t)li * 1024 * DFF;
                tr_item(src, DFF, 64 * kb, tile * 128 + (q & 3) * 32, wgu, 32 * nb, 1024, scr, C.lane, false); continue; }
            r -= I_GU;
            { const int kb = r / 32, nb = r % 32; tr_item(C.in[I_FWD] + (size_t)li * DFF * 1024, 1024, 64 * kb, 32 * nb, wdn, 32 * nb, DFF, scr, C.lane, false); }
        } else {
            const int e = r / I_E; int rr = r % I_E;
            if (rr < 16 * 88) { const int kb = rr / 88, nb = rr % 88, tile = nb >> 3, q = nb & 7;
                const float* src = (q < 4 ? C.in[I_MWG] : C.in[I_MWU]) + ((size_t)li * NE + e) * 1024 * DFE;
                tr_item(src, DFE, 64 * kb, tile * 128 + (q & 3) * 32, wgu + (size_t)e * 2 * DFE * 1024, 32 * nb, 1024, scr, C.lane, false); continue; }
            rr -= 16 * 88;
            { const int kb = rr / 32, nb = rr % 32; tr_item(C.in[I_MWD] + ((size_t)li * NE + e) * DFE * 1024, 1024, 64 * kb, 32 * nb, wdn + (size_t)e * 1024 * DFE, 32 * nb, DFE, scr, C.lane, false); }
        }
    }
}

template <bool ROUTE>
__device__ __forceinline__ void norm_rows(const Ctx& C, int l, const void* xlat, bool xbf, const float* xctx, const float* gain, int shoff, int scoff, int nrows, int moe_li) {
    const float* modv = WSP(float, WS_MODV) + (size_t)l * 9 * 6144;
    bf16* hb = WSP(bf16, WS_HB);
    const int gw = C.wg * NWAVES + C.wave, NGW = C.G * NWAVES;
    LAS unsigned* lcnt = (LAS unsigned*)(C.lds + 65536);
    unsigned* route = WSP(unsigned, WS_ROUTE);
    if (ROUTE) { if (C.tid < 8) lcnt[C.tid] = 0u; __syncthreads(); }
    f32x4 gv[4];
#pragma unroll
    for (int j = 0; j < 4; ++j) gv[j] = *(const f32x4*)(gain + 4 * C.lane + 256 * j);
    v4u rawn[4]; bool rbfn = false;
#define NR_LOAD(mm) do { const int m_ = (mm); const bool ic_ = m_ >= T_LAT; rbfn = xbf && !ic_; \
        if (rbfn) { _Pragma("unroll") for (int j = 0; j < 4; ++j) { const v2u t_ = *(const v2u*)((const bf16*)xlat + (size_t)m_ * 1024 + 4 * C.lane + 256 * j); rawn[j] = (v4u){t_.x, t_.y, 0u, 0u}; } } \
        else { const float* xr_ = ic_ ? xctx + (size_t)(m_ - T_LAT) * 1024 : (const float*)xlat + (size_t)m_ * 1024; _Pragma("unroll") for (int j = 0; j < 4; ++j) rawn[j] = *(const v4u*)(xr_ + 4 * C.lane + 256 * j); } } while (0)
    if (gw < nrows) NR_LOAD(gw);
    for (int m = gw; m < nrows; m += NGW) {
        const bool isctx = m >= T_LAT;
        const float* mv = modv + (size_t)(isctx ? 8 : (m >> 12)) * 6144;
        v4u raw[4]; const bool rbf = rbfn;
#pragma unroll
        for (int j = 0; j < 4; ++j) raw[j] = rawn[j];
        if (m + NGW < nrows) NR_LOAD(m + NGW);
        f32x4 v[4]; float s = 0.f;
#pragma unroll
        for (int j = 0; j < 4; ++j) { v[j] = rbf ? (f32x4){bflo(raw[j].x), bfhi(raw[j].x), bflo(raw[j].y), bfhi(raw[j].y)} : __builtin_bit_cast(f32x4, raw[j]); s += (v[j].x * v[j].x + v[j].y * v[j].y) + (v[j].z * v[j].z + v[j].w * v[j].w); }
        const float rs = rsqrtf_(wave_sum(s) * (1.0f / 1024.0f) + 1e-6f);
#pragma unroll
        for (int j = 0; j < 4; ++j) { const f32x4 sh = *(const f32x4*)(mv + shoff + 4 * C.lane + 256 * j), scl = *(const f32x4*)(mv + scoff + 4 * C.lane + 256 * j);
            v[j] = (v[j] * rs * gv[j]) * (scl + 1.0f) + sh;
            v2u o; o.x = pk2(v[j].x, v[j].y); o.y = pk2(v[j].z, v[j].w);
            *(v2u*)(hb + (size_t)m * 1024 + 4 * C.lane + 256 * j) = o; }
        if (ROUTE) {
            const float* rt = C.in[I_MROUTER] + (size_t)moe_li * 1024 * NE;
            float lg[8];
#pragma unroll
            for (int e = 0; e < 8; ++e) lg[e] = 0.f;
#pragma unroll
            for (int j = 0; j < 4; ++j)
#pragma unroll
                for (int q = 0; q < 4; ++q) { const int k = 4 * C.lane + 256 * j + q; const f32x4 r0 = *(const f32x4*)(rt + (size_t)k * 8), r1 = *(const f32x4*)(rt + (size_t)k * 8 + 4); const float hv = v[j][q];
                    lg[0] += hv * r0.x; lg[1] += hv * r0.y; lg[2] += hv * r0.z; lg[3] += hv * r0.w; lg[4] += hv * r1.x; lg[5] += hv * r1.y; lg[6] += hv * r1.z; lg[7] += hv * r1.w; }
#pragma unroll
            for (int e = 0; e < 8; ++e) lg[e] = wave_sum(lg[e]);
            int e0 = 0; float l0 = lg[0];
#pragma unroll
            for (int e = 1; e < 8; ++e) if (lg[e] > l0) { l0 = lg[e]; e0 = e; }
            int e1 = (e0 == 0) ? 1 : 0; float l1 = -3.0e38f;
#pragma unroll
            for (int e = 0; e < 8; ++e) if (e != e0 && lg[e] > l1) { l1 = lg[e]; e1 = e; }
            const float w0 = __builtin_amdgcn_rcpf(1.0f + __expf(l1 - l0)), w1 = 1.0f - w0;
            if (C.lane == 0) {
                const unsigned r0 = atomicAdd((unsigned*)&lcnt[e0], 1u), r1 = atomicAdd((unsigned*)&lcnt[e1], 1u);
                v4u a; a.x = (unsigned)e0; a.y = (unsigned)e1; a.z = r0; a.w = r1;
                *(v4u*)(route + (size_t)m * 8) = a;
                v2u b; b.x = __builtin_bit_cast(unsigned, w0); b.y = __builtin_bit_cast(unsigned, w1);
                *(v2u*)(route + (size_t)m * 8 + 4) = b;
            }
        }
    }
#undef NR_LOAD
    if (ROUTE) {
        __syncthreads();
        if (C.tid < 8) { unsigned* gc = WSP(unsigned, WS_CTL) + CW_MOECNT + 64 * moe_li; const unsigned base = atomicAdd(gc + C.tid, lcnt[C.tid]); WSP(unsigned, WS_WGBASE)[C.wg * 8 + C.tid] = base; }
    }
}
#define RAW_BARRIER() do { asm volatile("s_waitcnt lgkmcnt(0)" ::: "memory"); __builtin_amdgcn_s_barrier(); asm volatile("" ::: "memory"); } while (0)
__device__ __forceinline__ void gdn_prep(const Ctx& C, int l, int b, int c) {
    const bf16* P = WSP(const bf16, WS_P); bf16* gq = WSP(bf16, WS_GQ);
    const bool isctx = c < 4; const int p0 = isctx ? c * 64 : (c - 4) * 64; const int Lp = isctx ? CTXL : SEQ;
    const int ch = 4 * C.lane;
    auto rowof = [&](int p) -> int { return isctx ? (T_LAT + b * CTXL + p) : (b * SEQ + (p & 63) * 64 + (p >> 6)); };
    f32x4 cw[4][3], x[4][3];
#pragma unroll
    for (int j = 0; j < 4; ++j)
#pragma unroll
        for (int g = 0; g < 3; ++g) cw[j][g] = *(const f32x4*)(C.in[I_GCW] + ((size_t)l * 4 + j) * 768 + g * 256 + ch);
    const int tb = p0 + C.wave * 8;
    auto ldrow = [&](int p, f32x4 (&dst)[3]) {
        if (p >= 0 && p < Lp) { const bf16* pr = P + (size_t)rowof(p) * PLD + OFF_D + ch;
#pragma unroll
            for (int g = 0; g < 3; ++g) dst[g] = ld4bf(pr + g * 256); }
        else {
#pragma unroll
            for (int g = 0; g < 3; ++g) dst[g] = (f32x4){0.f, 0.f, 0.f, 0.f}; }
    };
    ldrow(tb - 2, x[0]); ldrow(tb - 1, x[1]); ldrow(tb, x[2]);
#pragma unroll
    for (int t = 0; t < 8; ++t) {
        ldrow(tb + t + 1, x[3]);
        bf16* orow = gq + (size_t)rowof(tb + t) * 768 + ch;
#pragma unroll
        for (int g = 0; g < 3; ++g) {
            f32x4 v = cw[0][g] * x[0][g] + cw[1][g] * x[1][g] + cw[2][g] * x[2][g] + cw[3][g] * x[3][g];
            v = (f32x4){siluf_(v.x), siluf_(v.y), siluf_(v.z), siluf_(v.w)};
            if (g < 2) { const float ss = row16_sum((v.x * v.x + v.y * v.y) + (v.z * v.z + v.w * v.w)); v = v * (rsqrtf_(ss + 1e-6f) * (g == 0 ? 0.125f : 1.0f)); }
            st4bf(orow + g * 256, v);
        }
#pragma unroll
        for (int g = 0; g < 3; ++g) { x[0][g] = x[1][g]; x[1][g] = x[2][g]; x[2][g] = x[3][g]; }
    }
}
__device__ __forceinline__ void finish_rows(const Ctx& C, int l, int nrows) {
    const bf16* P = WSP(const bf16, WS_P); bf16* yc = WSP(bf16, WS_HB);
    const bf16* ob = WSP(const bf16, WS_OUTB); const bf16* oc = WSP(const bf16, WS_OUTC); const bf16* od = WSP(const bf16, WS_OUTD);
    const bf16* gg = WSP(const bf16, WS_G); const float* bonus = WSP(const float, WS_BONUS);
    const float* mu = C.in[I_RMU] + (size_t)l * 2 * B_COLS;
    const int gw = C.wg * NWAVES + C.wave, NGW = C.G * NWAVES, lane = C.lane, ch = 4 * lane, hh = lane >> 4;
    const f32x4 lng = *(const f32x4*)(C.in[I_RLNG] + l * GW + ch), lnb = *(const f32x4*)(C.in[I_RLNB] + l * GW + ch);
    const f32x4 mng = *(const f32x4*)(C.in[I_MNG] + l * GW + ch), gng = *(const f32x4*)(C.in[I_GNG] + l * GW + ch);
    const f32x4 mu0 = *(const f32x4*)(mu + 512 + ch), mu1 = *(const f32x4*)(mu + B_COLS + 512 + ch);
    const size_t o2 = (size_t)T_ALL * 256;
#pragma unroll 4
    for (int m = gw; m < nrows; m += NGW) {
        const bool isctx = m >= T_LAT; const int Lp = isctx ? CTXL : SEQ; const int p = isctx ? ((m - T_LAT) & (CTXL - 1)) : (m & (SEQ - 1));
        const f32x4 yb = ld4bf(ob + (size_t)m * 256 + ch) + ld4bf(ob + o2 + (size_t)m * 256 + ch);
        const f32x4 ycv = ld4bf(oc + (size_t)m * 256 + ch) + ld4bf(oc + o2 + (size_t)m * 256 + ch);
        const f32x4 yd = ld4bf(od + (size_t)m * 256 + ch) + ld4bf(od + o2 + (size_t)m * 256 + ch);
        const bf16* pr = P + (size_t)m * PLD;
        const f32x4 vs = ld4bf(WSP(const bf16, WS_RKV) + (size_t)m * 768 + 512 + ch);
        const f32x4 og = ld4bf(pr + OFF_C + 768 + ch), gd = ld4bf(pr + OFF_D + 768 + ch), gr = ld4bf(gg + (size_t)m * 256 + ch);
        const float bn = bonus[(size_t)m * 4 + hh];
        *(v2u*)(yc + (size_t)m * 1024 + ch) = *(const v2u*)(pr + 256 + ch);
        {
            const float mean = row16_sum((yb.x + yb.y) + (yb.z + yb.w)) * (1.0f / 64.0f);
            const f32x4 dl = yb - mean;
            const float var = row16_sum((dl.x * dl.x + dl.y * dl.y) + (dl.z * dl.z + dl.w * dl.w)) * (1.0f / 64.0f);
            const f32x4 yn = dl * rsqrtf_(var + 64e-5f) * lng + lnb;
            st4bf(yc + (size_t)m * 1024 + 256 + ch, (yn + vs * bn) * gr);
        }
        {
            const float ms = row16_sum((ycv.x * ycv.x + ycv.y * ycv.y) + (ycv.z * ycv.z + ycv.w * ycv.w)) * (1.0f / 64.0f);
            const f32x4 sg = (f32x4){sigmoidf_(og.x), sigmoidf_(og.y), sigmoidf_(og.z), sigmoidf_(og.w)};
            st4bf(yc + (size_t)m * 1024 + 512 + ch, ycv * rsqrtf_(ms + 1e-6f) * mng * sg);
        }
        {
            const float ms = row16_sum((yd.x * yd.x + yd.y * yd.y) + (yd.z * yd.z + yd.w * yd.w)) * (1.0f / 64.0f);
            const f32x4 sg = (f32x4){siluf_(gd.x), siluf_(gd.y), siluf_(gd.z), siluf_(gd.w)};
            st4bf(yc + (size_t)m * 1024 + 768 + ch, yd * rsqrtf_(ms + 1e-6f) * gng * sg);
        }
    }
}
typedef bf16x8 fragb;
__device__ __forceinline__ f32x4 mfma16(fragb a, fragb b, f32x4 c) { return __builtin_amdgcn_mfma_f32_16x16x32_bf16(a, b, c, 0, 0, 0); }
__device__ __forceinline__ fragb ld_frag16(const LAS bf16* p) { return *(const LAS fragb*)p; }
__device__ __forceinline__ fragb ld_frag8x2(const LAS bf16* p0, const LAS bf16* p1) {
    const v2u a = *(const LAS v2u*)p0, b = *(const LAS v2u*)p1; v4u r; r.x = a.x; r.y = a.y; r.z = b.x; r.w = b.y; return __builtin_bit_cast(fragb, r); }
__device__ __forceinline__ fragb pack_frag(const f32x4& lo, const f32x4& hi) { v4u r; r.x = pk2(lo.x, lo.y); r.y = pk2(lo.z, lo.w); r.z = pk2(hi.x, hi.y); r.w = pk2(hi.z, hi.w); return __builtin_bit_cast(fragb, r); }
__device__ __forceinline__ float wave_incl_sum(float v, int lane) {
    v += dpp_x<0x111, 0xF, true>(0.f, v); v += dpp_x<0x112, 0xF, true>(0.f, v); v += dpp_x<0x114, 0xF, true>(0.f, v); v += dpp_x<0x118, 0xF, true>(0.f, v);
    v += dpp_x<0x142, 0xA, false>(0.f, v); v += dpp_x<0x143, 0xC, false>(0.f, v);
    return v;
}
__device__ __forceinline__ float wave_incl_max(float v, int lane) {
    const float ninf = -3.0e38f;
    v = fmaxf(v, dpp_x<0x111, 0xF, false>(ninf, v)); v = fmaxf(v, dpp_x<0x112, 0xF, false>(ninf, v)); v = fmaxf(v, dpp_x<0x114, 0xF, false>(ninf, v)); v = fmaxf(v, dpp_x<0x118, 0xF, false>(ninf, v));
    v = fmaxf(v, dpp_x<0x142, 0xA, false>(ninf, v)); v = fmaxf(v, dpp_x<0x143, 0xC, false>(ninf, v));
    return v;
}
constexpr int MP = 72;
__device__ __forceinline__ void mlstm_chunked(const Ctx& C, int l, int idx) {
    const int d = idx >> 5, b = (idx >> 2) & 7, h = idx & 3, lane = C.lane, w = C.wave, l15 = lane & 15, q = lane >> 4;
    const int it = w & 3, vtp = w >> 2;
    constexpr int IMG = 64 * MP * 2, BUFB = 4 * IMG + 1024, CTB = 65 * MP * 2 + 16;
    LAS unsigned char* L0 = C.lds;
    const bf16* P = WSP(const bf16, WS_P); bf16* outc = WSP(bf16, WS_OUTC) + (size_t)d * T_ALL * 256;
    const float ib = C.in[I_MIB][(l * 2 + d) * NH + h], fb = C.in[I_MFB][(l * 2 + d) * NH + h];
    const int tt = C.tid >> 3, part = C.tid & 7;
    for (int i = C.tid; i < 2 * CTB / 4; i += NTHR) ((LAS unsigned*)(L0 + 2 * BUFB))[i] = 0u;
    v4u rq, rk, rv; unsigned short rgi, rgf;
    auto gload = [&](int n) {
        const int row = seqrow_cm(n * 64 + tt, d, b);
        const bf16* pp = P + (size_t)row * PLD + OFF_C + h * 64 + 8 * part;
        rq = *(const v4u*)pp; rk = *(const v4u*)(pp + 256); rv = *(const v4u*)(pp + 512);
        const bf16* pg = P + (size_t)seqrow_cm(n * 64 + lane, d, b) * PLD + OFF_C + 1024 + d * 4 + h;
        rgi = pg[0]; rgf = pg[8];
    };
    auto images = [&](int bufi) {
        LAS unsigned char* B0 = L0 + bufi * BUFB;
        LAS bf16* Qs = (LAS bf16*)B0; LAS bf16* Ks = Qs + 64 * MP; LAS bf16* VT = Ks + 64 * MP; LAS bf16* KTw = VT + 64 * MP; LAS float* vec = (LAS float*)(B0 + 4 * IMG);
        const float li = bf2f(rgi) + ib, lf = -softplusf_(-(bf2f(rgf) + fb));
        const float bc = wave_incl_sum(lf, lane), x = li - bc, cm = wave_incl_max(x, lane);
        const float wl = __expf(x - __shfl(cm, 63)) * 0.125f;
        if (w == 0) { vec[lane] = x; vec[64 + lane] = cm; vec[128 + lane] = bc; }
        const float wmine = __shfl(wl, 8 * w + (lane >> 3));
        *(LAS v4u*)(Qs + tt * MP + 8 * part) = rq; *(LAS v4u*)(Ks + tt * MP + 8 * part) = rk;
        const unsigned vv[4] = {rv.x, rv.y, rv.z, rv.w}, kk[4] = {rk.x, rk.y, rk.z, rk.w};
#pragma unroll
        for (int e = 0; e < 4; ++e) {
            VT[(8 * part + 2 * e) * MP + tt] = (bf16)(vv[e] & 0xffffu); VT[(8 * part + 2 * e + 1) * MP + tt] = (bf16)(vv[e] >> 16);
            KTw[(8 * part + 2 * e) * MP + tt] = (bf16)f2bf1(bflo(kk[e]) * wmine); KTw[(8 * part + 2 * e + 1) * MP + tt] = (bf16)f2bf1(bfhi(kk[e]) * wmine);
        }
    };
    f32x4 Cst[2], nst; float m = 0.f;
    Cst[0] = Cst[1] = nst = (f32x4){0.f, 0.f, 0.f, 0.f};
    const fragb ones = __builtin_bit_cast(fragb, (v4u){0x3F803F80u, 0x3F803F80u, 0x3F803F80u, 0x3F803F80u});
    const f32x4 z4 = (f32x4){0.f, 0.f, 0.f, 0.f};
    gload(0); images(0); gload(1);
#pragma unroll 1
    for (int n = 0; n < NCH; ++n) {
        RAW_BARRIER();
        const LAS unsigned char* B0 = L0 + (n & 1) * BUFB;
        const LAS bf16* Qs = (const LAS bf16*)B0; const LAS bf16* Ks = Qs + 64 * MP; const LAS bf16* VT = Ks + 64 * MP; const LAS bf16* KTw = VT + 64 * MP; const LAS float* vec = (const LAS float*)(B0 + 4 * IMG);
        const LAS bf16* CT = (const LAS bf16*)(L0 + 2 * BUFB + (n & 1) * CTB); LAS bf16* CTn = (LAS bf16*)(L0 + 2 * BUFB + ((n + 1) & 1) * CTB);
        fragb Qf[2]; Qf[0] = ld_frag16(Qs + (16 * it + l15) * MP + 8 * q); Qf[1] = ld_frag16(Qs + (16 * it + l15) * MP + 32 + 8 * q);
        const float cmi = vec[64 + 16 * it + l15]; const int icol = 16 * it + l15;
        f32x4 pt[4];
#pragma unroll
        for (int jt = 0; jt < 4; ++jt) {
            pt[jt] = z4;
            if (jt <= it) {
                const fragb k0 = ld_frag16(Ks + (16 * jt + l15) * MP + 8 * q), k1 = ld_frag16(Ks + (16 * jt + l15) * MP + 32 + 8 * q);
                f32x4 st = mfma16(k0, Qf[0], z4); st = mfma16(k1, Qf[1], st);
                const f32x4 xj = *(const LAS f32x4*)(vec + 16 * jt + 4 * q);
#pragma unroll
                for (int r = 0; r < 4; ++r) { const int j = 16 * jt + 4 * q + r; pt[jt][r] = (j <= icol) ? st[r] * __expf(xj[r] - cmi) * 0.125f : 0.f; }
            }
        }
        fragb Pf[2]; Pf[0] = pack_frag(pt[0], pt[1]); Pf[1] = pack_frag(pt[2], pt[3]);
        fragb Vf[2][2];
#pragma unroll
        for (int v2 = 0; v2 < 2; ++v2)
#pragma unroll
            for (int s = 0; s < 2; ++s) { const LAS bf16* vr = VT + (16 * (2 * vtp + v2) + l15) * MP + 32 * s + 4 * q; Vf[v2][s] = ld_frag8x2(vr, vr + 16); }
        f32x4 Aacc[2], R[2], as, dn;
        as = mfma16(Pf[0], ones, z4); if (it >= 2) as = mfma16(Pf[1], ones, as);
        const fragb nf0 = ld_frag16(CT + 64 * MP + 8 * q), nf1 = ld_frag16(CT + 64 * MP + 32 + 8 * q);
        dn = mfma16(Qf[0], nf0, z4); dn = mfma16(Qf[1], nf1, dn);
#pragma unroll
        for (int v2 = 0; v2 < 2; ++v2) {
            Aacc[v2] = mfma16(Pf[0], Vf[v2][0], z4); if (it >= 2) Aacc[v2] = mfma16(Pf[1], Vf[v2][1], Aacc[v2]);
            const LAS bf16* cr = CT + (16 * (2 * vtp + v2) + l15) * MP + 8 * q;
            R[v2] = mfma16(Qf[0], ld_frag16(cr), z4); R[v2] = mfma16(Qf[1], ld_frag16(cr + 32), R[v2]);
        }
        {
            const f32x4 bi = *(const LAS f32x4*)(vec + 128 + 16 * it + 4 * q), cmr = *(const LAS f32x4*)(vec + 64 + 16 * it + 4 * q);
#pragma unroll
            for (int r = 0; r < 4; ++r) {
                const float mi = bi[r] + cmr[r], minter = bi[r] + m, mt = fmaxf(minter, mi), e1 = __expf(mi - mt), e2 = __expf(minter - mt);
                const float den = e1 * as[r] + e2 * dn[r]; const float inv = __builtin_amdgcn_rcpf(fmaxf(fabsf(den), __expf(-mt)));
                const int row = seqrow_cm(n * 64 + 16 * it + 4 * q + r, d, b);
#pragma unroll
                for (int v2 = 0; v2 < 2; ++v2) outc[(size_t)row * 256 + h * 64 + 16 * (2 * vtp + v2) + l15] = (bf16)f2bf1((e1 * Aacc[v2][r] + e2 * R[v2][r]) * inv);
            }
        }
        {
            const LAS bf16* kr = KTw + (16 * it + l15) * MP + 4 * q;
            const fragb kt0 = ld_frag8x2(kr, kr + 16), kt1 = ld_frag8x2(kr + 32, kr + 48);
            const float bL = vec[128 + 63], mloc = bL + vec[64 + 63];
            const float mnew = fmaxf(bL + m, mloc), wp = __expf(bL + m - mnew), wn = __expf(mloc - mnew);
            f32x4 gk = mfma16(kt0, ones, z4); gk = mfma16(kt1, ones, gk);
            nst = nst * wp + gk * wn;
#pragma unroll
            for (int v2 = 0; v2 < 2; ++v2) {
                f32x4 G = mfma16(kt0, Vf[v2][0], z4); G = mfma16(kt1, Vf[v2][1], G);
                Cst[v2] = Cst[v2] * wp + G * wn;
                v2u o; o.x = pk2(Cst[v2].x, Cst[v2].y); o.y = pk2(Cst[v2].z, Cst[v2].w);
                *(LAS v2u*)(CTn + (16 * (2 * vtp + v2) + l15) * MP + 16 * it + 4 * q) = o;
            }
            if (vtp == 0 && l15 == 0) { v2u o; o.x = pk2(nst.x, nst.y); o.y = pk2(nst.z, nst.w); *(LAS v2u*)(CTn + 64 * MP + 16 * it + 4 * q) = o; }
            m = mnew;
        }
        if (n + 1 < NCH) { images((n + 1) & 1); if (n + 2 < NCH) gload(n + 2); }
    }
    __syncthreads();
}
__device__ __forceinline__ int fwd_row_cm(int b, int c, int t) { return c < 4 ? (T_LAT + b * CTXL + c * 64 + t) : (b * SEQ + t * 64 + (c - 4)); }
__device__ __forceinline__ bf16* blob_row(const Ctx& C, int d, int isw, int b, int c, int h, int r) {
    const int row = fwd_row_cm(b, c, r);
    if (d == 1 && isw) return WSP(bf16, WS_OUTD) + ((size_t)T_ALL + row) * 256 + h * 64;
    return WSP(bf16, WS_P) + (size_t)row * PLD + OFF_D + (d * 2 + isw) * 256 + h * 64;
}
constexpr int LP = 68;
__device__ __forceinline__ void blocked_solve(const LAS bf16* Ln, const LAS bf16* TinvP, LAS unsigned char* XTw, f32x4 (&acc)[4][4], int l15, int q) {
    const f32x4 z4 = (f32x4){0.f, 0.f, 0.f, 0.f};
#pragma unroll
    for (int I = 0; I < 4; ++I) {
        const fragb Af = *(const LAS fragb*)(TinvP + (I * 16 + l15) * 32 + 8 * q);
        fragb A0, A1;
        if (I >= 1) A0 = ld_frag16(Ln + (16 * I + l15) * MP + 8 * q);
        if (I == 3) A1 = ld_frag16(Ln + (16 * I + l15) * MP + 32 + 8 * q);
#pragma unroll
        for (int nt = 0; nt < 4; ++nt) {
            const int crow = 16 * nt + l15; LAS unsigned char* xr = XTw + crow * 128;
            f32x4 a = acc[I][nt];
            if (I >= 1) a = mfma16(A0, *(const LAS fragb*)(xr + ((q ^ (crow & 7)) << 4)), a);
            if (I == 3) a = mfma16(A1, *(const LAS fragb*)(xr + (((4 + q) ^ (crow & 7)) << 4)), a);
            v4u bw; bw.x = pk2(a.x, a.y); bw.y = pk2(a.z, a.w); bw.z = 0u; bw.w = 0u;
            const f32x4 x = mfma16(Af, __builtin_bit_cast(fragb, bw), z4);
            acc[I][nt] = x;
            v2u o; o.x = pk2(x.x, x.y); o.y = pk2(x.z, x.w);
            *(LAS v2u*)(xr + (((2 * I + (q >> 1)) ^ (crow & 7)) << 4) + (q & 1) * 8) = o;
        }
    }
}
__device__ __forceinline__ void diag_inverses(const LAS bf16* Ln, LAS bf16* TinvP, int lane) {
    const int blk = lane >> 4, c = lane & 15;
    float x[16];
#pragma unroll
    for (int i = 0; i < 16; ++i) {
        const LAS bf16* lr = Ln + (16 * blk + i) * MP + 16 * blk;
        const v4u r0 = *(const LAS v4u*)lr, r1 = *(const LAS v4u*)(lr + 8);
        const unsigned rw[8] = {r0.x, r0.y, r0.z, r0.w, r1.x, r1.y, r1.z, r1.w};
        float s = (i == c) ? 1.0f : 0.0f;
#pragma unroll
        for (int j = 0; j < i; ++j) s += ((j & 1) ? bfhi(rw[j >> 1]) : bflo(rw[j >> 1])) * x[j];
        x[i] = s;
        TinvP[(blk * 16 + i) * 32 + 8 * (c >> 2) + (c & 3)] = (bf16)f2bf1(s);
    }
}
__device__ __forceinline__ void gdn_solve_item(const Ctx& C, int l, int item) {
    const int lane = C.lane, w = C.wave, pw = w & 1, pi = w >> 1, l15 = lane & 15, q = lane >> 4;
    LAS unsigned char* B0 = C.lds + pi * 31744;
    LAS bf16* Ln = (LAS bf16*)B0;
    LAS bf16* TinvP = (LAS bf16*)(B0 + 9216);
    LAS float* vec = (LAS float*)(B0 + 13312);
    LAS unsigned char* XT = B0 + 13824;
    LAS bf16* Ks = (LAS bf16*)XT;
    const bf16* P = WSP(const bf16, WS_P); const bf16* gq = WSP(const bf16, WS_GQ);
    const int u = item >> 1, d = item & 1;
    const int c = u % NCH, h = (u / NCH) & 3, b = u / (NCH * NH);
    const int n = d ? (c < 4 ? 3 - c : 71 - c) : c;
    const float aexp = __expf(C.in[I_GALOG][(l * 2 + d) * NH + h]), dtb = C.in[I_GDTB][(l * 2 + d) * NH + h];
    const int rowl = seqrow_cm(n * 64 + lane, d, b);
    const bf16* pg = P + (size_t)rowl * PLD + OFF_D + 1024 + d * 4 + h;
    const float la = -aexp * softplusf_(bf2f(pg[0]) + dtb), beta = sigmoidf_(bf2f(pg[8]));
    const float gam = wave_incl_sum(la, lane);
    if (pw == 0) { vec[lane] = beta; vec[64 + lane] = gam; }
#pragma unroll
    for (int r = 0; r < 4; ++r) { const int idx = pw * 64 + lane + 128 * r, t = idx >> 3, part = idx & 7;
        *(LAS v4u*)(Ks + t * MP + 8 * part) = *(const v4u*)(gq + (size_t)seqrow_cm(n * 64 + t, d, b) * 768 + 256 + h * 64 + 8 * part); }
    { LAS v4u* tz = (LAS v4u*)(B0 + 9216) + (pw * 64 + lane) * 2; tz[0] = (v4u){0u, 0u, 0u, 0u}; tz[1] = (v4u){0u, 0u, 0u, 0u}; }
    f32x4 acc[4][4];
    if (pw == 0) {
#pragma unroll
        for (int I = 0; I < 4; ++I)
#pragma unroll
            for (int r = 0; r < 4; ++r) { const bf16* vr = gq + (size_t)seqrow_cm(n * 64 + 16 * I + 4 * q + r, d, b) * 768 + 512 + h * 64 + l15;
#pragma unroll
                for (int nt = 0; nt < 4; ++nt) acc[I][nt][r] = bf2f(vr[16 * nt]); }
    }
    __syncthreads();
    {
        int tix = 0;
#pragma unroll
        for (int it = 0; it < 4; ++it)
#pragma unroll
            for (int jt = 0; jt < 4; ++jt, ++tix) if ((tix & 1) == pw) {
                f32x4 t4 = (f32x4){0.f, 0.f, 0.f, 0.f};
                if (jt <= it) {
#pragma unroll
                    for (int s = 0; s < 2; ++s) t4 = mfma16(ld_frag16(Ks + (16 * it + l15) * MP + 32 * s + 8 * q), ld_frag16(Ks + (16 * jt + l15) * MP + 32 * s + 8 * q), t4);
                    const float gj = vec[64 + 16 * jt + l15];
                    const f32x4 bi = *(const LAS f32x4*)(vec + 16 * it + 4 * q), gi = *(const LAS f32x4*)(vec + 64 + 16 * it + 4 * q);
#pragma unroll
                    for (int r = 0; r < 4; ++r) { const int i = 16 * it + 4 * q + r, j = 16 * jt + l15; t4[r] = (j < i) ? -(bi[r] * t4[r] * __expf(gi[r] - gj)) : 0.f; }
                }
#pragma unroll
                for (int r = 0; r < 4; ++r) Ln[(16 * it + 4 * q + r) * MP + 16 * jt + l15] = (bf16)f2bf1(t4[r]);
            }
    }
    {
#pragma unroll
        for (int I = 0; I < 4; ++I) {
            const f32x4 bi = *(const LAS f32x4*)(vec + 16 * I + 4 * q), gi = *(const LAS f32x4*)(vec + 64 + 16 * I + 4 * q);
#pragma unroll
            for (int r = 0; r < 4; ++r) { const float sc = pw ? bi[r] * __expf(gi[r]) : bi[r];
#pragma unroll
                for (int nt = 0; nt < 4; ++nt) acc[I][nt][r] = (pw ? bf2f(Ks[(16 * I + 4 * q + r) * MP + 16 * nt + l15]) : acc[I][nt][r]) * sc; }
        }
    }
    __syncthreads();
    if (pw == 0) diag_inverses(Ln, TinvP, lane);
    LAS unsigned char* XTw = XT + pw * 8192;
    { LAS v4u* xz = (LAS v4u*)(XTw + lane * 128);
#pragma unroll
        for (int g = 0; g < 8; ++g) xz[g] = (v4u){0u, 0u, 0u, 0u}; }
    __syncthreads();
    blocked_solve(Ln, TinvP, XTw, acc, l15, q);
    {
        bf16* dst = blob_row(C, d, pw, b, c, h, lane);
        const LAS unsigned char* xr = XTw + lane * 128;
#pragma unroll
        for (int g = 0; g < 8; ++g) *(v4u*)(dst + 8 * g) = *(const LAS v4u*)(xr + ((g ^ (lane & 7)) << 4));
    }
    __syncthreads();
}

template <bool DRY>
__device__ __forceinline__ void gdn_chunked(const Ctx& C, int l, int idx) {
    const int d = idx >> 5, b = (idx >> 2) & 7, h = idx & 3, lane = C.lane, w = C.wave, l15 = lane & 15, q = lane >> 4;
    const int it = w & 3, vtp = w >> 2;
    constexpr int IMG = 64 * MP * 2, BUFB = 5 * IMG + 512;
    LAS unsigned char* L0 = C.lds;
    LAS bf16* VnT = (LAS bf16*)(L0 + 2 * BUFB + 2 * IMG);
    const bf16* P = WSP(const bf16, WS_P); const bf16* gq = WSP(const bf16, WS_GQ); bf16* outd = WSP(bf16, WS_OUTD) + (size_t)d * T_ALL * 256;
    const float aexp = __expf(C.in[I_GALOG][(l * 2 + d) * NH + h]), dtb = C.in[I_GDTB][(l * 2 + d) * NH + h];
    const int tt = C.tid >> 3, part = C.tid & 7;
    for (int i = C.tid; i < 2 * IMG / 4; i += NTHR) ((LAS unsigned*)(L0 + 2 * BUFB))[i] = 0u;
    v4u rq, rk, ru, rw; unsigned short rga;
    auto gload = [&](int n) {
        const int c = d ? (n < 4 ? 3 - n : 71 - n) : n;
        const bf16* pp = gq + (size_t)seqrow_cm(n * 64 + tt, d, b) * 768 + h * 64 + 8 * part;
        rq = *(const v4u*)pp; rk = *(const v4u*)(pp + 256);
        ru = *(const v4u*)(blob_row(C, d, 0, b, c, h, tt) + 8 * part); rw = *(const v4u*)(blob_row(C, d, 1, b, c, h, tt) + 8 * part);
        rga = P[(size_t)seqrow_cm(n * 64 + lane, d, b) * PLD + OFF_D + 1024 + d * 4 + h];
    };
    auto images = [&](int bufi) {
        LAS unsigned char* B0 = L0 + bufi * BUFB;
        LAS bf16* Qs = (LAS bf16*)B0; LAS bf16* Ks = Qs + 64 * MP; LAS bf16* KdT = Ks + 64 * MP; LAS bf16* Wi = KdT + 64 * MP; LAS bf16* UT = Wi + 64 * MP; LAS float* vec = (LAS float*)(B0 + 5 * IMG);
        const float la = -aexp * softplusf_(bf2f(rga) + dtb);
        const float gam = wave_incl_sum(la, lane);
        if (w == 0) vec[lane] = gam;
        const float kd = __expf(__shfl(gam, 63) - gam);
        const float kmine = __shfl(kd, 8 * w + (lane >> 3));
        *(LAS v4u*)(Qs + tt * MP + 8 * part) = rq; *(LAS v4u*)(Ks + tt * MP + 8 * part) = rk; *(LAS v4u*)(UT + tt * MP + 8 * part) = ru;
        const unsigned kk[4] = {rk.x, rk.y, rk.z, rk.w}, ww[4] = {rw.x, rw.y, rw.z, rw.w};
#pragma unroll
        for (int e = 0; e < 4; ++e) {
            KdT[(8 * part + 2 * e) * MP + tt] = (bf16)f2bf1(bflo(kk[e]) * kmine); KdT[(8 * part + 2 * e + 1) * MP + tt] = (bf16)f2bf1(bfhi(kk[e]) * kmine);
            Wi[(8 * part + 2 * e) * MP + tt] = (bf16)(ww[e] & 0xffffu); Wi[(8 * part + 2 * e + 1) * MP + tt] = (bf16)(ww[e] >> 16);
        }
    };
    f32x4 Sst[2]; Sst[0] = Sst[1] = (f32x4){0.f, 0.f, 0.f, 0.f};
    const f32x4 z4 = (f32x4){0.f, 0.f, 0.f, 0.f};
    gload(0); images(0); gload(1);
#pragma unroll 1
    for (int n = 0; n < NCH; ++n) {
        RAW_BARRIER();
        const LAS unsigned char* B0 = L0 + (n & 1) * BUFB;
        const LAS bf16* Qs = (const LAS bf16*)B0; const LAS bf16* Ks = Qs + 64 * MP; const LAS bf16* KdT = Ks + 64 * MP; const LAS bf16* Wi = KdT + 64 * MP; const LAS bf16* UT = Wi + 64 * MP; const LAS float* vec = (const LAS float*)(B0 + 5 * IMG);
        const LAS bf16* ST = (const LAS bf16*)(L0 + 2 * BUFB + (n & 1) * IMG); LAS bf16* STn = (LAS bf16*)(L0 + 2 * BUFB + ((n + 1) & 1) * IMG);
        fragb Qf[2]; Qf[0] = ld_frag16(Qs + (16 * it + l15) * MP + 8 * q); Qf[1] = ld_frag16(Qs + (16 * it + l15) * MP + 32 + 8 * q);
        const float gcol = vec[16 * it + l15]; const int icol = 16 * it + l15;
        f32x4 pt[4];
#pragma unroll
        for (int jt = 0; jt < 4; ++jt) {
            pt[jt] = z4;
            if (jt <= it) {
                const fragb k0 = ld_frag16(Ks + (16 * jt + l15) * MP + 8 * q), k1 = ld_frag16(Ks + (16 * jt + l15) * MP + 32 + 8 * q);
                f32x4 st = mfma16(k0, Qf[0], z4); st = mfma16(k1, Qf[1], st);
                const f32x4 gj = *(const LAS f32x4*)(vec + 16 * jt + 4 * q);
#pragma unroll
                for (int r = 0; r < 4; ++r) { const int j = 16 * jt + 4 * q + r; pt[jt][r] = (j <= icol) ? st[r] * __expf(gcol - gj[r]) : 0.f; }
            }
        }
        fragb Pf[2]; Pf[0] = pack_frag(pt[0], pt[1]); Pf[1] = pack_frag(pt[2], pt[3]);
        const fragb Wf0 = ld_frag16(Wi + (16 * it + l15) * MP + 8 * q), Wf1 = ld_frag16(Wi + (16 * it + l15) * MP + 32 + 8 * q);
        f32x4 Ro[2];
#pragma unroll
        for (int v2 = 0; v2 < 2; ++v2) {
            const int vrow = 16 * (2 * vtp + v2) + l15;
            const fragb s0 = ld_frag16(ST + vrow * MP + 8 * q), s1 = ld_frag16(ST + vrow * MP + 32 + 8 * q);
            f32x4 ws = mfma16(Wf0, s0, z4); ws = mfma16(Wf1, s1, ws);
            Ro[v2] = mfma16(Qf[0], s0, z4); Ro[v2] = mfma16(Qf[1], s1, Ro[v2]);
            const v2u ur = *(const LAS v2u*)(UT + vrow * MP + 16 * it + 4 * q);
            v2u o; o.x = pk2(bflo(ur.x) - ws.x, bfhi(ur.x) - ws.y); o.y = pk2(bflo(ur.y) - ws.z, bfhi(ur.y) - ws.w);
            *(LAS v2u*)(VnT + vrow * MP + 16 * it + 4 * q) = o;
        }
        RAW_BARRIER();
        {
            const f32x4 gi = *(const LAS f32x4*)(vec + 16 * it + 4 * q);
            const float gl = __expf(vec[63]);
            const LAS bf16* kr = KdT + (16 * it + l15) * MP + 4 * q;
            const fragb kt0 = ld_frag8x2(kr, kr + 16), kt1 = ld_frag8x2(kr + 32, kr + 48);
#pragma unroll
            for (int v2 = 0; v2 < 2; ++v2) {
                const int vrow = 16 * (2 * vtp + v2) + l15;
                const LAS bf16* vr = VnT + vrow * MP + 4 * q;
                const fragb n0 = ld_frag8x2(vr, vr + 16), n1 = ld_frag8x2(vr + 32, vr + 48);
                f32x4 o = mfma16(Pf[0], n0, z4); if (it >= 2) o = mfma16(Pf[1], n1, o);
#pragma unroll
                for (int r = 0; r < 4; ++r) { const int row = seqrow_cm(n * 64 + 16 * it + 4 * q + r, d, b);
                    if (!DRY) outd[(size_t)row * 256 + h * 64 + vrow] = (bf16)f2bf1(o[r] + __expf(gi[r]) * Ro[v2][r]); }
                f32x4 ns = mfma16(kt0, n0, z4); ns = mfma16(kt1, n1, ns);
                Sst[v2] = Sst[v2] * gl + ns;
                v2u so; so.x = pk2(Sst[v2].x, Sst[v2].y); so.y = pk2(Sst[v2].z, Sst[v2].w);
                *(LAS v2u*)(STn + vrow * MP + 16 * it + 4 * q) = so;
            }
        }
        if (n + 1 < NCH) { images((n + 1) & 1); if (n + 2 < NCH) gload(n + 2); }
    }
    __syncthreads();
}
constexpr int UP = 264;
template <int CTRL> __device__ __forceinline__ float dpp_keep(float oldv, float v) { return __builtin_bit_cast(float, __builtin_amdgcn_update_dpp(__builtin_bit_cast(int, oldv), __builtin_bit_cast(int, v), CTRL, 0xF, 0xF, false)); }
template <bool REV> __device__ __forceinline__ void scan16(float& A, float& B) {
#define LRU_STEP(S) { const float Ap = dpp_keep<(REV ? 0x100 : 0x110) | S>(1.0f, A), Bp = dpp_keep<(REV ? 0x100 : 0x110) | S>(0.0f, B); B = A * Bp + B; A = A * Ap; }
    LRU_STEP(1) LRU_STEP(2) LRU_STEP(4) LRU_STEP(8)
#undef LRU_STEP
}
constexpr int UPC = 72;
__device__ __forceinline__ int lru_chunk_of(int d, int k) { return d ? (k < 4 ? 3 - k : NCH + 3 - k) : k; }
template <bool REV>
__device__ __forceinline__ void lru_tiles(const LAS bf16* Ud, int th, int mt, int lane, const fragb (&Wa)[2], const fragb (&Wx)[2], const f32x4& ba, const f32x4& bx, const f32x4& sp4,
                                          f32x4 (&Ac)[2], f32x4 (&Hl)[2], f32x4& Atot, f32x4& hend) {
    const int l15 = lane & 15, q = lane >> 4, edge = (lane & 48) | (REV ? 0 : 15);
    const f32x4 z4 = (f32x4){0.f, 0.f, 0.f, 0.f};
    f32x4 tA = z4, tB = z4;
#pragma unroll
    for (int i = 0; i < 2; ++i) {
        const int nt = REV ? 3 - (2 * th + i) : 2 * th + i;
        const LAS bf16* urow = Ud + (16 * nt + l15) * UPC;
        const fragb Uf0 = ld_frag16(urow + 8 * q), Uf1 = ld_frag16(urow + 32 + 8 * q);
        f32x4 aa = mfma16(Wa[0], Uf0, z4); aa = mfma16(Wa[1], Uf1, aa);
        f32x4 ax = mfma16(Wx[0], Uf0, z4); ax = mfma16(Wx[1], Uf1, ax);
        const v2u ur = *(const LAS v2u*)(urow + 16 * mt + 4 * q);
        const f32x4 u4 = (f32x4){bflo(ur.x), bfhi(ur.x), bflo(ur.y), bfhi(ur.y)};
        f32x4 la, iu, A, Bv;
#pragma unroll
        for (int r = 0; r < 4; ++r) { const float rg = sigmoidf_(aa[r] + ba[r]); iu[r] = sigmoidf_(ax[r] + bx[r]) * u4[r]; la[r] = -sp4[r] * rg; }
        const bool sm_ = la[0] > -0.15f && la[1] > -0.15f && la[2] > -0.15f && la[3] > -0.15f;
        if (__builtin_amdgcn_ballot_w64(!sm_) == 0ull) {
#pragma unroll
            for (int r = 0; r < 4; ++r) { const float x = la[r], p = x * (1.0f + x * (0.5f + x * (0.16666667f + x * (0.041666668f + x * (0.0083333338f + x * 0.0013888889f)))));
                A[r] = 1.0f + p; Bv[r] = __builtin_amdgcn_sqrtf(-p * (2.0f + p)) * iu[r]; }
        } else {
#pragma unroll
            for (int r = 0; r < 4; ++r) { A[r] = __expf(la[r]); Bv[r] = __builtin_amdgcn_sqrtf(-expm1f_(2.0f * la[r])) * iu[r]; }
        }
#pragma unroll
        for (int r = 0; r < 4; ++r) { float a_ = A[r], b_ = Bv[r]; scan16<REV>(a_, b_); A[r] = a_; Bv[r] = b_; }
        if (i == 0) {
            Ac[0] = A; Hl[0] = Bv;
#pragma unroll
            for (int r = 0; r < 4; ++r) { tA[r] = __shfl(A[r], edge); tB[r] = __shfl(Bv[r], edge); }
        } else {
            Ac[1] = A * tA; Hl[1] = A * tB + Bv;
#pragma unroll
            for (int r = 0; r < 4; ++r) { Atot[r] = __shfl(Ac[1][r], edge); hend[r] = __shfl(Hl[1][r], edge); }
        }
    }
}
__device__ __forceinline__ void lru_chain(const Ctx& C, int l, int id) {
    const int b = id >> 3, hd = (id >> 1) & 3, chalf = id & 1;
    const int lane = C.lane, l15 = lane & 15, q = lane >> 4;
    const int d = C.wave >> 2, mtl = (C.wave >> 1) & 1, th = C.wave & 1, mt = chalf * 2 + mtl;
    LAS bf16* U = (LAS bf16*)C.lds;
    LAS float* XCH = (LAS float*)(C.lds + 2 * 2 * 64 * UPC * 2);
    bf16* P = WSP(bf16, WS_P); bf16* LH = WSP(bf16, WS_LRUH) + (size_t)id * NSTEP * 32;
    const int cd = C.tid >> 8, cj = C.tid & 63, ctq = (C.tid >> 6) & 3;
    const float* cw = C.in[I_LCW] + (size_t)l * 4 * GW + hd * 64 + cj; const float w0 = cw[0], w1 = cw[GW], w2 = cw[2 * GW], w3 = cw[3 * GW], cb = C.in[I_LCB][l * GW + hd * 64 + cj];
    const bf16* wt = WSP(const bf16, WS_LRUWT) + (size_t)((d * 2 + 0) * 4 + hd) * 4096;
    fragb Wa[2], Wx[2];
#pragma unroll
    for (int ks = 0; ks < 2; ++ks) { Wa[ks] = *(const fragb*)(wt + (16 * mt + l15) * 64 + 32 * ks + 8 * q); Wx[ks] = *(const fragb*)(wt + 4 * 4096 + (16 * mt + l15) * 64 + 32 * ks + 8 * q); }
    const int ch0 = hd * 64 + 16 * mt + 4 * q;
    const f32x4 ba = *(const f32x4*)(C.in[I_LBA] + (l * 2 + d) * GW + ch0), bx = *(const f32x4*)(C.in[I_LBX] + (l * 2 + d) * GW + ch0), lam = *(const f32x4*)(C.in[I_LLAM] + (l * 2 + d) * GW + ch0);
    f32x4 sp4;
#pragma unroll
    for (int r = 0; r < 4; ++r) sp4[r] = 8.0f * softplusf_(-lam[r]);
    f32x4 s = (f32x4){0.f, 0.f, 0.f, 0.f};
    unsigned short xr[19];
#define LRU_LOADX(kk) do { const int c_ = lru_chunk_of(cd, (kk)); const bool ic_ = c_ < 4; const int p0_ = (ic_ ? c_ * 64 : (c_ - 4) * 64) + ctq * 16 - 2, Lp_ = ic_ ? CTXL : SEQ; \
        const bf16* xp_ = P + (size_t)(ic_ ? T_LAT + b * CTXL : b * SEQ) * PLD + hd * 64 + cj; \
        _Pragma("unroll") for (int i_ = 0; i_ < 19; ++i_) { const int p_ = p0_ + i_; xr[i_] = (p_ >= 0 && p_ < Lp_) ? xp_[(size_t)p_ * PLD] : (unsigned short)0; } } while (0)
#define LRU_CONV(kk) do { LAS bf16* uo_ = U + ((((kk) & 1) * 2 + cd) * 64 + ctq * 16) * UPC + cj; \
        _Pragma("unroll") for (int t_ = 0; t_ < 16; ++t_) uo_[t_ * UPC] = (bf16)f2bf1(w0 * bf2f(xr[t_]) + w1 * bf2f(xr[t_ + 1]) + w2 * bf2f(xr[t_ + 2]) + w3 * bf2f(xr[t_ + 3]) + cb); } while (0)
    LRU_LOADX(0); LRU_CONV(0); LRU_LOADX(1);
    __syncthreads();
#pragma unroll 1
    for (int k = 0; k < NCH; ++k) {
        if (k + 1 < NCH) { LRU_CONV(k + 1); if (k + 2 < NCH) LRU_LOADX(k + 2); }
        const int c = lru_chunk_of(d, k); const bool second = lru_chunk_of(1 - d, c) < k;
        const bool ic = c < 4; const size_t row0 = (size_t)(ic ? T_LAT + b * CTXL + c * 64 : b * SEQ + (c - 4) * 64);
        const bool late = (k == 2) || (k == 36);
        int tok[2]; v2u gv[2], fv[2];
#pragma unroll
        for (int i = 0; i < 2; ++i) { const int nt = d ? 3 - (2 * th + i) : 2 * th + i; tok[i] = 16 * nt + l15;
            if (second && !late) { gv[i] = *(const v2u*)(P + (row0 + tok[i]) * PLD + 256 + ch0); fv[i] = *(const v2u*)(LH + (size_t)(c * 64 + tok[i]) * 32 + 16 * mtl + 4 * q); } }
        f32x4 Ac[2], Hl[2], Atot, hend;
        const LAS bf16* Ud = U + ((k & 1) * 2 + d) * 64 * UPC;
        if (d) lru_tiles<true>(Ud, th, mt, lane, Wa, Wx, ba, bx, sp4, Ac, Hl, Atot, hend); else lru_tiles<false>(Ud, th, mt, lane, Wa, Wx, ba, bx, sp4, Ac, Hl, Atot, hend);
        LAS float* xw = XCH + (((((k & 1) * 2 + d) * 2 + mtl) * 2 + th) * 4 + q) * 8;
        if (l15 == (d ? 0 : 15)) { *(LAS f32x4*)xw = Atot; *(LAS f32x4*)(xw + 4) = hend; }
        if (late) VM_WAIT();
        RAW_BARRIER();
        if (second && late) {
#pragma unroll
            for (int i = 0; i < 2; ++i) { gv[i] = *(const v2u*)(P + (row0 + tok[i]) * PLD + 256 + ch0); fv[i] = *(const v2u*)(LH + (size_t)(c * 64 + tok[i]) * 32 + 16 * mtl + 4 * q); }
        }
        const LAS float* xr0 = XCH + (((((k & 1) * 2 + d) * 2 + mtl) * 2 + 0) * 4 + q) * 8;
        const f32x4 A0 = *(const LAS f32x4*)xr0, h0 = *(const LAS f32x4*)(xr0 + 4), A1 = *(const LAS f32x4*)(xr0 + 32), h1 = *(const LAS f32x4*)(xr0 + 36);
        const f32x4 mid = A0 * s + h0, hin = th ? mid : s;
        s = A1 * mid + h1;
#pragma unroll
        for (int i = 0; i < 2; ++i) {
            const f32x4 h = Ac[i] * hin + Hl[i];
            if (!second) { v2u o; o.x = pk2(h.x, h.y); o.y = pk2(h.z, h.w); *(v2u*)(LH + (size_t)(c * 64 + tok[i]) * 32 + 16 * mtl + 4 * q) = o; }
            else {
                const f32x4 g = (f32x4){bflo(gv[i].x), bfhi(gv[i].x), bflo(gv[i].y), bfhi(gv[i].y)};
                f32x4 y = (f32x4){h.x + bflo(fv[i].x), h.y + bfhi(fv[i].x), h.z + bflo(fv[i].y), h.w + bfhi(fv[i].y)};
                y.x *= gelu_tanh(g.x); y.y *= gelu_tanh(g.y); y.z *= gelu_tanh(g.z); y.w *= gelu_tanh(g.w);
                st4bf(P + (row0 + tok[i]) * PLD + 256 + ch0, y);
            }
        }
    }
#undef LRU_LOADX
#undef LRU_CONV
    __syncthreads();
}
constexpr int RP = 264;
__device__ __forceinline__ void rwkv_prep2(const Ctx& C, int l, int b, int c) {
    LAS bf16* RS = (LAS bf16*)C.lds;
    LAS bf16* KS = RS + 64 * RP;
    LAS bf16* XW = KS + 64 * RP;
    LAS bf16* XA = XW + 64 * MP;
    LAS bf16* XG = XA + 64 * MP;
    const bf16* P = WSP(const bf16, WS_P);
    const bool isctx = c < 4; const int p0 = isctx ? c * 64 : (c - 4) * 64; const int Lp = isctx ? CTXL : SEQ; const int row0 = isctx ? T_LAT + b * CTXL : b * SEQ;
    const float* mu = C.in[I_RMU] + (size_t)l * 2 * B_COLS;
    bf16* rkv = WSP(bf16, WS_RKV);
#pragma unroll 5
    for (int it = C.tid; it < 64 * 120; it += NTHR) {
        const int t = it / 120, c8 = (it % 120) * 8, p = p0 + t;
        const bf16* pp = P + (size_t)(row0 + p) * PLD + OFF_B + c8;
        const v4u xc = *(const v4u*)pp; v4u xp = (v4u){0u, 0u, 0u, 0u}, xn = xp;
        if (p > 0) xp = *(const v4u*)(pp - PLD);
        if (p < Lp - 1) xn = *(const v4u*)(pp + PLD);
        const f32x4 m0a = *(const f32x4*)(mu + c8), m0b = *(const f32x4*)(mu + c8 + 4), m1a = *(const f32x4*)(mu + B_COLS + c8), m1b = *(const f32x4*)(mu + B_COLS + c8 + 4);
        const unsigned xcw[4] = {xc.x, xc.y, xc.z, xc.w}, xpw[4] = {xp.x, xp.y, xp.z, xp.w}, xnw[4] = {xn.x, xn.y, xn.z, xn.w};
        float sh[8];
#pragma unroll
        for (int e = 0; e < 4; ++e) {
            const float x0 = bflo(xcw[e]), x1 = bfhi(xcw[e]);
            const float mu0_0 = e < 2 ? m0a[2 * e] : m0b[2 * e - 4], mu0_1 = e < 2 ? m0a[2 * e + 1] : m0b[2 * e - 3], mu1_0 = e < 2 ? m1a[2 * e] : m1b[2 * e - 4], mu1_1 = e < 2 ? m1a[2 * e + 1] : m1b[2 * e - 3];
            sh[2 * e] = x0 + mu0_0 * (bflo(xpw[e]) - x0) + mu1_0 * (bflo(xnw[e]) - x0);
            sh[2 * e + 1] = x1 + mu0_1 * (bfhi(xpw[e]) - x1) + mu1_1 * (bfhi(xnw[e]) - x1);
        }
        if (c8 >= 768) {
            const int ci = c8 - 768;
            if (ci < 64) {
#pragma unroll
                for (int e = 0; e < 8; ++e) sh[e] = tanhf_(sh[e]); }
            else if (ci >= 128) {
#pragma unroll
                for (int e = 0; e < 8; ++e) sh[e] = sigmoidf_(sh[e]); }
        }
        v4u o; o.x = pk2(sh[0], sh[1]); o.y = pk2(sh[2], sh[3]); o.z = pk2(sh[4], sh[5]); o.w = pk2(sh[6], sh[7]);
        if (c8 < 768) {
            *(v4u*)(rkv + (size_t)(row0 + p) * 768 + c8) = o;
            if (c8 < 256) *(LAS v4u*)(RS + t * RP + c8) = o; else if (c8 < 512) *(LAS v4u*)(KS + t * RP + c8 - 256) = o;
        } else {
            const int ci = c8 - 768;
            LAS bf16* dst = ci < 64 ? XW + t * MP + ci : (ci < 128 ? XA + t * MP + ci - 64 : XG + t * MP + ci - 128);
            *(LAS v4u*)dst = o;
        }
    }
    __syncthreads();
    const int lane = C.lane, w = C.wave, l15 = lane & 15, q = lane >> 4, hd = w & 3, ntp = w >> 2;
    const bf16* wt = WSP(const bf16, WS_RWT);
    bf16* wa_out = WSP(bf16, WS_HB); bf16* g_out = WSP(bf16, WS_G); float* bonus = WSP(float, WS_BONUS); float* rinv = WSP(float, WS_RINV);
    const f32x4 z4 = (f32x4){0.f, 0.f, 0.f, 0.f};
    float bsum[2] = {0.f, 0.f}, ksum[2] = {0.f, 0.f};
#pragma unroll
    for (int n2 = 0; n2 < 2; ++n2) {
        const int tok = 16 * (2 * ntp + n2) + l15; const size_t row = (size_t)(row0 + p0 + tok);
        const fragb xw0 = ld_frag16(XW + tok * MP + 8 * q), xw1 = ld_frag16(XW + tok * MP + 32 + 8 * q), xa0 = ld_frag16(XA + tok * MP + 8 * q), xa1 = ld_frag16(XA + tok * MP + 32 + 8 * q);
        const fragb xg0 = ld_frag16(XG + tok * MP + 8 * q), xg1 = ld_frag16(XG + tok * MP + 32 + 8 * q);
        unsigned ow0[8], ow1[8], oa0[8], oa1[8], og[8];
#pragma unroll
        for (int mt = 0; mt < 4; ++mt) {
            const int chl = 16 * (l15 >> 2) + 4 * mt + (l15 & 3), ch4 = hd * 64 + 16 * q + 4 * mt;
            const bf16* wrow = wt + (size_t)(hd * 64 + chl) * 32 + 8 * q;
            const bf16* grow = wt + 4 * 256 * 32 + (size_t)(hd * 64 + chl) * 64 + 8 * q;
            const fragb fw0 = *(const fragb*)(wrow), fw1 = *(const fragb*)(wrow + 256 * 32), fa0 = *(const fragb*)(wrow + 2 * 256 * 32), fa1 = *(const fragb*)(wrow + 3 * 256 * 32), fg0 = *(const fragb*)(grow), fg1 = *(const fragb*)(grow + 32);
            const f32x4 w00 = *(const f32x4*)(C.in[I_RW0] + (l * 2 + 0) * GW + ch4), w01 = *(const f32x4*)(C.in[I_RW0] + (l * 2 + 1) * GW + ch4);
            const f32x4 a00 = *(const f32x4*)(C.in[I_RA0] + (l * 2 + 0) * GW + ch4), a01 = *(const f32x4*)(C.in[I_RA0] + (l * 2 + 1) * GW + ch4);
            const f32x4 k_a = *(const f32x4*)(C.in[I_RKA] + l * GW + ch4), r_k = *(const f32x4*)(C.in[I_RRK] + l * GW + ch4), k_k = *(const f32x4*)(C.in[I_RKK] + l * GW + ch4);
            const f32x4 aw0 = mfma16(fw0, xw0, z4), aw1 = mfma16(fw1, xw1, z4), aa0 = mfma16(fa0, xa0, z4), aa1 = mfma16(fa1, xa1, z4);
            f32x4 ag = mfma16(fg0, xg0, z4); ag = mfma16(fg1, xg1, ag);
            f32x4 wv0, wv1, av0, av1;
#pragma unroll
            for (int r = 0; r < 4; ++r) {
                wv0[r] = __expf(-0.6065306597126334f * sigmoidf_(aw0[r] + w00[r])); wv1[r] = __expf(-0.6065306597126334f * sigmoidf_(aw1[r] + w01[r]));
                av0[r] = sigmoidf_(aa0[r] + a00[r]); av1[r] = sigmoidf_(aa1[r] + a01[r]);
            }
            ow0[2 * mt] = pk2(wv0[0], wv0[1]); ow0[2 * mt + 1] = pk2(wv0[2], wv0[3]); ow1[2 * mt] = pk2(wv1[0], wv1[1]); ow1[2 * mt + 1] = pk2(wv1[2], wv1[3]);
            oa0[2 * mt] = pk2(av0[0], av0[1]); oa0[2 * mt + 1] = pk2(av0[2], av0[3]); oa1[2 * mt] = pk2(av1[0], av1[1]); oa1[2 * mt + 1] = pk2(av1[2], av1[3]);
            og[2 * mt] = pk2(ag[0], ag[1]); og[2 * mt + 1] = pk2(ag[2], ag[3]);
            const v2u rr_ = *(const LAS v2u*)(RS + tok * RP + ch4), kr_ = *(const LAS v2u*)(KS + tok * RP + ch4);
            const f32x4 rs = (f32x4){bflo(rr_.x), bfhi(rr_.x), bflo(rr_.y), bfhi(rr_.y)}, ks = (f32x4){bflo(kr_.x), bfhi(kr_.x), bflo(kr_.y), bfhi(kr_.y)};
#pragma unroll
            for (int r = 0; r < 4; ++r) {
                const float km = ks[r] * (1.0f + (av0[r] - 1.0f) * k_a[r]) + ks[r] * (1.0f + (av1[r] - 1.0f) * k_a[r]);
                bsum[n2] += rs[r] * r_k[r] * km; const float kk = ks[r] * k_k[r]; ksum[n2] += kk * kk;
            }
        }
        bf16* wrow_o = wa_out + row * 1024 + hd * 64 + 16 * q;
        *(v4u*)(wrow_o) = (v4u){ow0[0], ow0[1], ow0[2], ow0[3]}; *(v4u*)(wrow_o + 8) = (v4u){ow0[4], ow0[5], ow0[6], ow0[7]};
        *(v4u*)(wrow_o + 256) = (v4u){ow1[0], ow1[1], ow1[2], ow1[3]}; *(v4u*)(wrow_o + 256 + 8) = (v4u){ow1[4], ow1[5], ow1[6], ow1[7]};
        *(v4u*)(wrow_o + 512) = (v4u){oa0[0], oa0[1], oa0[2], oa0[3]}; *(v4u*)(wrow_o + 512 + 8) = (v4u){oa0[4], oa0[5], oa0[6], oa0[7]};
        *(v4u*)(wrow_o + 768) = (v4u){oa1[0], oa1[1], oa1[2], oa1[3]}; *(v4u*)(wrow_o + 768 + 8) = (v4u){oa1[4], oa1[5], oa1[6], oa1[7]};
        bf16* grow_o = g_out + row * 256 + hd * 64 + 16 * q;
        *(v4u*)(grow_o) = (v4u){og[0], og[1], og[2], og[3]}; *(v4u*)(grow_o + 8) = (v4u){og[4], og[5], og[6], og[7]};
    }
#pragma unroll
    for (int n2 = 0; n2 < 2; ++n2) {
        const size_t row = (size_t)(row0 + p0 + 16 * (2 * ntp + n2) + l15);
        float bs = bsum[n2], ks2 = ksum[n2];
        bs += __shfl_xor(bs, 16); bs += __shfl_xor(bs, 32); ks2 += __shfl_xor(ks2, 16); ks2 += __shfl_xor(ks2, 32);
        if (q == 0) { bonus[row * 4 + hd] = bs; rinv[row * 4 + hd] = rsqrtf_(ks2 + 1e-6f); }
    }
    __syncthreads();
}
__device__ __forceinline__ int fwd_row_r(int b, int c, int t) { return c < 4 ? (T_LAT + b * CTXL + c * 64 + t) : (b * SEQ + (c - 4) * 64 + t); }
__device__ __forceinline__ bf16* rw_blob_row(const Ctx& C, int d, int which, int b, int c, int h, int r) {
    const int row = fwd_row_r(b, c, r);
#if RW_VSPLIT
    if (which == 0) { if (d) return WSP(bf16, WS_GQ) + (size_t)row * 768 + 512 + h * 64;
                      return WSP(bf16, WS_P) + (size_t)row * PLD + OFF_B + 512 + h * 64; }
#else
    if (which == 0) return WSP(bf16, WS_OUTB) + ((size_t)d * T_ALL + row) * 256 + h * 64;
#endif
    return WSP(bf16, WS_P) + (size_t)row * PLD + OFF_B + d * 256 + h * 64;
}
__device__ __forceinline__ void rwkv_solve_item(const Ctx& C, int l, int item) {
    const int lane = C.lane, w = C.wave, pw = w & 1, pi = w >> 1, l15 = lane & 15, q = lane >> 4;
    LAS unsigned char* B0 = C.lds + pi * 31744;
    LAS bf16* Kk = (LAS bf16*)B0; LAS bf16* Bh = Kk + 64 * MP; LAS bf16* Kh = Bh + 64 * MP;
    LAS bf16* Ln = (LAS bf16*)B0;
    LAS bf16* Lk16 = (LAS bf16*)(B0 + 9216);
    LAS unsigned char* XT = B0 + 9216;
    LAS bf16* TinvP = (LAS bf16*)(B0 + 25600);
    const bf16* WA = WSP(const bf16, WS_HB); bf16* WAw = WSP(bf16, WS_HB); const bf16* rkv = WSP(const bf16, WS_RKV); const float* rinv = WSP(const float, WS_RINV);
    const int u = item >> 1, d = item & 1;
    const int c = u % NCH, h = (u / NCH) & 3, b = u / (NCH * NH);
    const float k_k = C.in[I_RKK][l * GW + h * 64 + lane], k_a = C.in[I_RKA][l * GW + h * 64 + lane];
    const int n = d ? (c < 4 ? 3 - c : 71 - c) : c;
    const float ril = rinv[(size_t)seqrow_raster(n * 64 + lane, d, b) * 4 + h];
#pragma unroll
    for (int r = 0; r < 4; ++r) { const int idx2 = pw * 64 + lane + 128 * r, t = idx2 >> 3, part = idx2 & 7; const int row = seqrow_raster(n * 64 + t, d, b);
        *(LAS v4u*)(Kk + t * MP + 8 * part) = *(const v4u*)(WA + (size_t)row * 1024 + d * 256 + h * 64 + 8 * part);
        *(LAS v4u*)(Bh + t * MP + 8 * part) = *(const v4u*)(WA + (size_t)row * 1024 + (2 + d) * 256 + h * 64 + 8 * part);
        *(LAS v4u*)(Kh + t * MP + 8 * part) = *(const v4u*)(rkv + (size_t)row * 768 + 256 + h * 64 + 8 * part); }
    __syncthreads();
    {
        float cc = 1.0f;
        if (pw) {
#pragma unroll
            for (int t = 0; t < 32; ++t) cc *= bf2f(Kk[t * MP + lane]);
        }
        __syncthreads();
#pragma unroll
        for (int t2 = 0; t2 < 32; ++t2) {
            const int t = pw * 32 + t2;
            const float wv = bf2f(Kk[t * MP + lane]), av = bf2f(Bh[t * MP + lane]), ks = bf2f(Kh[t * MP + lane]);
            const float kap = ks * k_k * __shfl(ril, t);
            const float cprev = cc; cc *= wv; const float ic = __builtin_amdgcn_rcpf(cc);
            Kk[t * MP + lane] = (bf16)f2bf1(kap * cprev); Bh[t * MP + lane] = (bf16)f2bf1(kap * av * ic); Kh[t * MP + lane] = (bf16)f2bf1(ks * (1.0f + (av - 1.0f) * k_a) * ic);
            WAw[(size_t)seqrow_raster(n * 64 + t, d, b) * 1024 + d * 256 + h * 64 + lane] = (bf16)f2bf1(cc);
        }
    }
    __syncthreads();
    f32x4 acc[4][4];
    if (pw == 0) {
#pragma unroll
        for (int I = 0; I < 4; ++I)
#pragma unroll
            for (int r = 0; r < 4; ++r)
#pragma unroll
                for (int nt = 0; nt < 4; ++nt) acc[I][nt][r] = bf2f(Kk[(16 * I + 4 * q + r) * MP + 16 * nt + l15]);
    }
    f32x4 T[10];
    {
        const LAS bf16* Bsrc = pw ? Kh : Bh;
        int tix = 0;
#pragma unroll
        for (int it = 0; it < 4; ++it)
#pragma unroll
            for (int jt = 0; jt <= it; ++jt, ++tix) {
                f32x4 t4 = (f32x4){0.f, 0.f, 0.f, 0.f};
#pragma unroll
                for (int s = 0; s < 2; ++s) t4 = mfma16(ld_frag16(Kk + (16 * it + l15) * MP + 32 * s + 8 * q), ld_frag16(Bsrc + (16 * jt + l15) * MP + 32 * s + 8 * q), t4);
#pragma unroll
                for (int r = 0; r < 4; ++r) { const int i = 16 * it + 4 * q + r, j = 16 * jt + l15; T[tix][r] = (j < i) ? (pw ? t4[r] : -t4[r]) : 0.f; }
            }
    }
    __syncthreads();
    {
        int tix = 0;
#pragma unroll
        for (int it = 0; it < 4; ++it)
#pragma unroll
            for (int jt = 0; jt < 4; ++jt) {
                if (jt <= it) {
#pragma unroll
                    for (int r = 0; r < 4; ++r) (pw ? Lk16 : Ln)[(16 * it + 4 * q + r) * MP + 16 * jt + l15] = (bf16)f2bf1(T[tix][r]);
                    ++tix;
                } else if (pw == 0) {
#pragma unroll
                    for (int r = 0; r < 4; ++r) Ln[(16 * it + 4 * q + r) * MP + 16 * jt + l15] = (bf16)0;
                }
            }
        LAS v4u* tz = (LAS v4u*)(B0 + 25600) + (pw * 64 + lane) * 2; tz[0] = (v4u){0u, 0u, 0u, 0u}; tz[1] = (v4u){0u, 0u, 0u, 0u};
    }
    __syncthreads();
    if (pw) {
#pragma unroll
        for (int I = 0; I < 4; ++I)
#pragma unroll
            for (int r = 0; r < 4; ++r)
#pragma unroll
                for (int nt = 0; nt < 4; ++nt) { const int i = 16 * I + 4 * q + r, j = 16 * nt + l15; acc[I][nt][r] = (j < i && nt <= I) ? bf2f(Lk16[i * MP + j]) : 0.f; }
    } else diag_inverses(Ln, TinvP, lane);
    __syncthreads();
    LAS unsigned char* XTw = XT + pw * 8192;
    { LAS v4u* xz = (LAS v4u*)(XTw + lane * 128);
#pragma unroll
        for (int g = 0; g < 8; ++g) xz[g] = (v4u){0u, 0u, 0u, 0u}; }
    blocked_solve(Ln, TinvP, XTw, acc, l15, q);
    {
        bf16* dst = rw_blob_row(C, d, pw, b, c, h, lane);
        const LAS unsigned char* xr = XTw + lane * 128;
#pragma unroll
        for (int g = 0; g < 8; ++g) *(v4u*)(dst + 8 * g) = *(const LAS v4u*)(xr + ((g ^ (lane & 7)) << 4));
    }
    __syncthreads();
}

template <bool DRY>
__device__ __forceinline__ void rwkv_chunked(const Ctx& C, int l, int idx) {
#ifndef RW_VSPLIT
#define RW_VSPLIT 1
#endif
    constexpr int NV = RW_VSPLIT ? 1 : 2;
    const int vhalf = idx & 1, lane = C.lane, w = C.wave, l15 = lane & 15, q = lane >> 4;
    const int d = RW_VSPLIT ? idx >> 6 : idx >> 5, b = RW_VSPLIT ? (idx >> 3) & 7 : (idx >> 2) & 7, h = RW_VSPLIT ? (idx >> 1) & 3 : idx & 3;
    const int it = w & 3, vt0 = RW_VSPLIT ? 2 * vhalf + (w >> 2) : 2 * (w >> 2);
    constexpr int IMG = 64 * MP * 2;
    LAS unsigned char* L0 = C.lds;
    LAS bf16* Wi = (LAS bf16*)L0; LAS bf16* Ti = Wi + 64 * MP; LAS bf16* Rh = Ti + 64 * MP; LAS bf16* Kh = Rh + 64 * MP; LAS bf16* Bh = Kh + 64 * MP;
    LAS bf16* UT = (LAS bf16*)(L0 + 11 * IMG);
    LAS float* cLv = (LAS float*)(L0 + 14 * IMG);
    const bf16* WA = WSP(const bf16, WS_HB); const bf16* rkv = WSP(const bf16, WS_RKV); const float* rinv = WSP(const float, WS_RINV);
    bf16* outb = WSP(bf16, WS_OUTB) + (size_t)d * T_ALL * 256;
    const int tt = C.tid >> 3, part = C.tid & 7;
    for (int i = C.tid; i < 2 * IMG / 4; i += NTHR) ((LAS unsigned*)(L0 + 12 * IMG))[i] = 0u;
    float kkw[8], kaw[8];
#pragma unroll
    for (int e = 0; e < 8; ++e) { kkw[e] = C.in[I_RKK][l * GW + h * 64 + 8 * w + e]; kaw[e] = C.in[I_RKA][l * GW + h * 64 + 8 * w + e]; }
    v4u gr, gk, gv, gw, ga, gbw, gbt; float gri;
    auto gload = [&](int n) {
        const int c = d ? (n < 4 ? 3 - n : 71 - n) : n;
        const int row = seqrow_raster(n * 64 + lane, d, b);
        const bf16* pr = rkv + (size_t)row * 768 + h * 64 + 8 * w;
        gr = *(const v4u*)pr; gk = *(const v4u*)(pr + 256); gv = *(const v4u*)(pr + 512);
        gw = *(const v4u*)(WA + (size_t)row * 1024 + d * 256 + h * 64 + 8 * w); ga = *(const v4u*)(WA + (size_t)row * 1024 + (2 + d) * 256 + h * 64 + 8 * w);
        gri = rinv[(size_t)row * 4 + h];
        gbw = *(const v4u*)(rw_blob_row(C, d, 0, b, c, h, tt) + 8 * part); gbt = *(const v4u*)(rw_blob_row(C, d, 1, b, c, h, tt) + 8 * part);
    };
    auto images = [&](int bufi) {
        LAS bf16* VT = (LAS bf16*)(L0 + (5 + 3 * bufi) * IMG); LAS bf16* KcT = VT + 64 * MP; LAS bf16* BcT = KcT + 64 * MP;
        const unsigned rw_[4] = {gr.x, gr.y, gr.z, gr.w}, kw_[4] = {gk.x, gk.y, gk.z, gk.w}, vw_[4] = {gv.x, gv.y, gv.z, gv.w}, ww_[4] = {gw.x, gw.y, gw.z, gw.w}, aw_[4] = {ga.x, ga.y, ga.z, ga.w};
        float rh[8], kh[8], bh[8];
#pragma unroll
        for (int e = 0; e < 8; ++e) {
            const float rs = (e & 1) ? bfhi(rw_[e >> 1]) : bflo(rw_[e >> 1]), ks = (e & 1) ? bfhi(kw_[e >> 1]) : bflo(kw_[e >> 1]);
            const float wv = (e & 1) ? bfhi(ww_[e >> 1]) : bflo(ww_[e >> 1]), av = (e & 1) ? bfhi(aw_[e >> 1]) : bflo(aw_[e >> 1]);
            const float kap = ks * kkw[e] * gri, ktil = ks * (1.0f + (av - 1.0f) * kaw[e]);
            const float cf = wv, icf = __builtin_amdgcn_rcpf(cf), cfL = __builtin_bit_cast(float, __builtin_amdgcn_readlane(__builtin_bit_cast(int, cf), 63)), dec = cfL * icf;
            rh[e] = rs * cf; kh[e] = ktil * icf; bh[e] = kap * av * icf;
            const unsigned short vraw = (e & 1) ? (unsigned short)(vw_[e >> 1] >> 16) : (unsigned short)(vw_[e >> 1] & 0xffffu);
            VT[(8 * w + e) * MP + lane] = vraw; KcT[(8 * w + e) * MP + lane] = (bf16)f2bf1(ktil * dec); BcT[(8 * w + e) * MP + lane] = (bf16)f2bf1(-(kap * av * dec));
            if (lane == 63) cLv[bufi * 64 + 8 * w + e] = cfL;
        }
        { v4u o; o.x = pk2(rh[0], rh[1]); o.y = pk2(rh[2], rh[3]); o.z = pk2(rh[4], rh[5]); o.w = pk2(rh[6], rh[7]); *(LAS v4u*)(Rh + lane * MP + 8 * w) = o; }
        { v4u o; o.x = pk2(kh[0], kh[1]); o.y = pk2(kh[2], kh[3]); o.z = pk2(kh[4], kh[5]); o.w = pk2(kh[6], kh[7]); *(LAS v4u*)(Kh + lane * MP + 8 * w) = o; }
        { v4u o; o.x = pk2(bh[0], bh[1]); o.y = pk2(bh[2], bh[3]); o.z = pk2(bh[4], bh[5]); o.w = pk2(bh[6], bh[7]); *(LAS v4u*)(Bh + lane * MP + 8 * w) = o; }
        const unsigned bw_[4] = {gbw.x, gbw.y, gbw.z, gbw.w}, bt_[4] = {gbt.x, gbt.y, gbt.z, gbt.w};
#pragma unroll
        for (int e = 0; e < 4; ++e) {
            Wi[(8 * part + 2 * e) * MP + tt] = (bf16)(bw_[e] & 0xffffu); Wi[(8 * part + 2 * e + 1) * MP + tt] = (bf16)(bw_[e] >> 16);
            Ti[(8 * part + 2 * e) * MP + tt] = (bf16)(bt_[e] & 0xffffu); Ti[(8 * part + 2 * e + 1) * MP + tt] = (bf16)(bt_[e] >> 16);
        }
    };
    f32x4 Zst[NV];
#pragma unroll
    for (int v2 = 0; v2 < NV; ++v2) Zst[v2] = (f32x4){0.f, 0.f, 0.f, 0.f};
    const f32x4 z4 = (f32x4){0.f, 0.f, 0.f, 0.f};
    gload(0); images(0); gload(1);
#pragma unroll 1
    for (int n = 0; n < NCH; ++n) {
        RAW_BARRIER();
        const LAS bf16* VT = (const LAS bf16*)(L0 + (5 + 3 * (n & 1)) * IMG); const LAS bf16* KcT = VT + 64 * MP; const LAS bf16* BcT = KcT + 64 * MP;
        const LAS bf16* Zi = (const LAS bf16*)(L0 + (12 + (n & 1)) * IMG); LAS bf16* Zn = (LAS bf16*)(L0 + (12 + ((n + 1) & 1)) * IMG);
        const int arow = (16 * it + l15) * MP + 8 * q;
        const fragb Wf0 = ld_frag16(Wi + arow), Wf1 = ld_frag16(Wi + arow + 32), Tf0 = ld_frag16(Ti + arow), Tf1 = ld_frag16(Ti + arow + 32), Rf0 = ld_frag16(Rh + arow), Rf1 = ld_frag16(Rh + arow + 32);
        const int icol = 16 * it + l15;
        f32x4 pk[4], pb[4];
#pragma unroll
        for (int jt = 0; jt < 4; ++jt) {
            pk[jt] = z4; pb[jt] = z4;
            if (jt <= it) {
                const int jrow = (16 * jt + l15) * MP + 8 * q;
                f32x4 sk = mfma16(ld_frag16(Kh + jrow), Rf0, z4); sk = mfma16(ld_frag16(Kh + jrow + 32), Rf1, sk);
                f32x4 sb = mfma16(ld_frag16(Bh + jrow), Rf0, z4); sb = mfma16(ld_frag16(Bh + jrow + 32), Rf1, sb);
#pragma unroll
                for (int r = 0; r < 4; ++r) { const int j = 16 * jt + 4 * q + r; pk[jt][r] = (j <= icol) ? sk[r] : 0.f; pb[jt][r] = (j <= icol) ? -sb[r] : 0.f; }
            }
        }
        fragb Pk0 = pack_frag(pk[0], pk[1]), Pk1 = pack_frag(pk[2], pk[3]), Pb0 = pack_frag(pb[0], pb[1]), Pb1 = pack_frag(pb[2], pb[3]);
        f32x4 RZ[NV];
#pragma unroll
        for (int v2 = 0; v2 < NV; ++v2) {
            const int vrow = 16 * (vt0 + v2) + l15;
            const fragb z0 = ld_frag16(Zi + vrow * MP + 8 * q), z1 = ld_frag16(Zi + vrow * MP + 32 + 8 * q);
            f32x4 u = mfma16(Wf0, z0, z4); u = mfma16(Wf1, z1, u);
            u = mfma16(Tf0, ld_frag16(VT + vrow * MP + 8 * q), u); if (it >= 2) u = mfma16(Tf1, ld_frag16(VT + vrow * MP + 32 + 8 * q), u);
            RZ[v2] = mfma16(Rf0, z0, z4); RZ[v2] = mfma16(Rf1, z1, RZ[v2]);
            v2u o; o.x = pk2(u.x, u.y); o.y = pk2(u.z, u.w);
            *(LAS v2u*)(UT + vrow * MP + 16 * it + 4 * q) = o;
        }
        RAW_BARRIER();
        {
            const f32x4 cl4 = *(const LAS f32x4*)(cLv + (n & 1) * 64 + 16 * it + 4 * q);
            const LAS bf16* kr = KcT + (16 * it + l15) * MP + 4 * q; const LAS bf16* br = BcT + (16 * it + l15) * MP + 4 * q;
            const fragb kc0 = ld_frag8x2(kr, kr + 16), kc1 = ld_frag8x2(kr + 32, kr + 48), bc0 = ld_frag8x2(br, br + 16), bc1 = ld_frag8x2(br + 32, br + 48);
#pragma unroll
            for (int v2 = 0; v2 < NV; ++v2) {
                const int vrow = 16 * (vt0 + v2) + l15;
                const LAS bf16* vr = VT + vrow * MP + 4 * q; const LAS bf16* ur = UT + vrow * MP + 4 * q;
                const fragb vp0 = ld_frag8x2(vr, vr + 16), vp1 = ld_frag8x2(vr + 32, vr + 48), up0 = ld_frag8x2(ur, ur + 16), up1 = ld_frag8x2(ur + 32, ur + 48);
                f32x4 y = mfma16(Pk0, vp0, RZ[v2]); y = mfma16(Pb0, up0, y);
                if (it >= 2) { y = mfma16(Pk1, vp1, y); y = mfma16(Pb1, up1, y); }
#pragma unroll
                for (int r = 0; r < 4; ++r) { const int row = seqrow_raster(n * 64 + 16 * it + 4 * q + r, d, b); if (!DRY) outb[(size_t)row * 256 + h * 64 + vrow] = (bf16)f2bf1(y[r]); }
                f32x4 zn = mfma16(kc0, vp0, z4); zn = mfma16(kc1, vp1, zn); zn = mfma16(bc0, up0, zn); zn = mfma16(bc1, up1, zn);
                Zst[v2] = Zst[v2] * cl4 + zn;
                v2u so; so.x = pk2(Zst[v2].x, Zst[v2].y); so.y = pk2(Zst[v2].z, Zst[v2].w);
                *(LAS v2u*)(Zn + vrow * MP + 16 * it + 4 * q) = so;
            }
        }
        if (n + 1 < NCH) { images((n + 1) & 1); if (n + 2 < NCH) gload(n + 2); }
    }
    __syncthreads();
}
__device__ __forceinline__ void moe_scatter(const Ctx& C, int moe_li, int nrows) {
    const unsigned* gc = WSP(const unsigned, WS_CTL) + CW_MOECNT + 64 * moe_li;
    LAS int* pst = (LAS int*)C.lds;
    {
        int pe[8]; int acc = 0;
#pragma unroll
        for (int e = 0; e < NE; ++e) { const int blks = ((int)gc[e] + 255) >> 8; if (C.tid == e) pst[e] = acc * 256; acc += blks; pe[e] = acc; }
        if (C.wg == 0 && C.tid < MOE_MAXBLK) { int be = 0;
#pragma unroll
            for (int e = 0; e < NE; ++e) be += (pe[e] <= C.tid) ? 1 : 0;
            int* tab = WSP(int, WS_TAB); tab[1 + C.tid] = be < NE ? be : NE - 1; if (C.tid == 0) tab[0] = acc; }
    }
    __syncthreads();
    const unsigned* route = WSP(const unsigned, WS_ROUTE); const unsigned* wgbase = WSP(const unsigned, WS_WGBASE);
    int* pos = WSP(int, WS_POS); int* tok = WSP(int, WS_TOK);
    if (C.wg < NE) { const int cnt = (int)gc[C.wg], s0 = pst[C.wg] + cnt, s1 = pst[C.wg] + (((cnt + 255) >> 8) << 8);
        for (int j = s0 + C.tid; j < s1; j += NTHR) tok[j] = 0; }
    const int m = C.wg * NWAVES + C.wave + C.lane * (C.G * NWAVES);
    if (m < nrows) {
        const v4u a = *(const v4u*)(route + (size_t)m * 8);
        const int e0 = (int)a.x, e1 = (int)a.y;
        const int p0 = pst[e0] + (int)wgbase[C.wg * 8 + e0] + (int)a.z, p1 = pst[e1] + (int)wgbase[C.wg * 8 + e1] + (int)a.w;
        pos[(size_t)m * 2] = p0; pos[(size_t)m * 2 + 1] = p1; tok[p0] = m; tok[p1] = m;
    }
    __syncthreads();
}
template <int NEXT>
__device__ __forceinline__ void moe_combine(const Ctx& C, int l, int nrows) {
    const unsigned* route = WSP(const unsigned, WS_ROUTE); const int* pos = WSP(const int, WS_POS); const bf16* ym = WSP(const bf16, WS_MIX);
    const float* modv = WSP(const float, WS_MODV) + (size_t)l * 9 * 6144 + 5 * 1024;
    const float* modn = WSP(const float, WS_MODV) + (size_t)(l + 1) * 9 * 6144;
    float* xc = WSP(float, WS_XC); bf16* hb = WSP(bf16, WS_HB);
    bf16* xlb = NEXT == 2 ? WSP(bf16, WS_XLAST) : (bf16*)C.out;
    const int gw = C.wg * NWAVES + C.wave, NGW = C.G * NWAVES;
    f32x4 gn[4];
#pragma unroll
    for (int j = 0; j < 4; ++j) gn[j] = *(const f32x4*)((NEXT == 2 ? C.in[I_FNG] : C.in[I_NMIXG] + (NEXT == 1 ? (l + 1) * 1024 : 0)) + 4 * C.lane + 256 * j);
    int p0n = 0, p1n = 0; float w0n = 0.f, w1n = 0.f;
    v4u xa[4]; v2u ya[4], yb[4]; float w0c = 0.f, w1c = 0.f;
#define MC_POS(mm, P0, P1, W0, W1) do { const int m_ = (mm); P0 = pos[(size_t)m_ * 2]; P1 = pos[(size_t)m_ * 2 + 1]; W0 = __builtin_bit_cast(float, route[(size_t)m_ * 8 + 4]); W1 = __builtin_bit_cast(float, route[(size_t)m_ * 8 + 5]); } while (0)
#define MC_RAW(mm, P0, P1) do { const int m_ = (mm); const bool ic_ = m_ >= T_LAT; \
        _Pragma("unroll") for (int j = 0; j < 4; ++j) { const int col = 4 * C.lane + 256 * j; \
            ya[j] = *(const v2u*)(ym + (size_t)(P0) * 1024 + col); yb[j] = *(const v2u*)(ym + (size_t)(P1) * 1024 + col); \
            if (ic_) xa[j] = *(const v4u*)(xc + (size_t)(m_ - T_LAT) * 1024 + col); else { const v2u t_ = *(const v2u*)(xlb + (size_t)m_ * 1024 + col); xa[j] = (v4u){t_.x, t_.y, 0u, 0u}; } } } while (0)
    if (gw < nrows) { int p0, p1; MC_POS(gw, p0, p1, w0c, w1c); if (gw + NGW < nrows) MC_POS(gw + NGW, p0n, p1n, w0n, w1n); MC_RAW(gw, p0, p1); }
    for (int m = gw; m < nrows; m += NGW) {
        const bool isctx = m >= T_LAT;
        float* xr = isctx ? xc + (size_t)(m - T_LAT) * 1024 : C.out + (size_t)m * 1024; bf16* xrb = xlb + (size_t)m * 1024;
        const int mrow = isctx ? 8 : (m >> 12);
        const float* gv = modv + (size_t)mrow * 6144;
        v4u xq[4]; v2u yq0[4], yq1[4]; const float w0 = w0c, w1 = w1c;
#pragma unroll
        for (int j = 0; j < 4; ++j) { xq[j] = xa[j]; yq0[j] = ya[j]; yq1[j] = yb[j]; }
        const int p0u = p0n, p1u = p1n; w0c = w0n; w1c = w1n;
        if (m + 2 * NGW < nrows) MC_POS(m + 2 * NGW, p0n, p1n, w0n, w1n);
        if (m + NGW < nrows) MC_RAW(m + NGW, p0u, p1u);
        f32x4 x[4]; float ss = 0.f;
#pragma unroll
        for (int j = 0; j < 4; ++j) {
            const int col = 4 * C.lane + 256 * j;
            const f32x4 ya4 = (f32x4){bflo(yq0[j].x), bfhi(yq0[j].x), bflo(yq0[j].y), bfhi(yq0[j].y)}, yb4 = (f32x4){bflo(yq1[j].x), bfhi(yq1[j].x), bflo(yq1[j].y), bfhi(yq1[j].y)};
            const f32x4 g = *(const f32x4*)(gv + col);
            const f32x4 xo = isctx ? __builtin_bit_cast(f32x4, xq[j]) : (f32x4){bflo(xq[j].x), bfhi(xq[j].x), bflo(xq[j].y), bfhi(xq[j].y)};
            x[j] = xo + g * (ya4 * w0 + yb4 * w1);
            if (NEXT != 2) { if (isctx) *(f32x4*)(xr + col) = x[j]; else st4bf(xrb + col, x[j]); }
            ss += (x[j].x * x[j].x + x[j].y * x[j].y) + (x[j].z * x[j].z + x[j].w * x[j].w);
        }
        if (NEXT != 0) {
            const float rs = rsqrtf_(wave_sum(ss) * (1.0f / 1024.0f) + 1e-6f);
#pragma unroll
            for (int j = 0; j < 4; ++j) {
                const int col = 4 * C.lane + 256 * j;
                if (NEXT == 2) *(f32x4*)(xr + col) = x[j] * rs * gn[j];
                else { const f32x4 sh = *(const f32x4*)(modn + (size_t)mrow * 6144 + col), scl = *(const f32x4*)(modn + (size_t)mrow * 6144 + 1024 + col);
                    st4bf(hb + (size_t)m * 1024 + col, (x[j] * rs * gn[j]) * (scl + 1.0f) + sh); }
            }
        }
    }
#undef MC_POS
#undef MC_RAW
}
__device__ __forceinline__ void final_norm(const Ctx& C) {
    const int gw = C.wg * NWAVES + C.wave, NGW = C.G * NWAVES;
    f32x4 gv[4];
#pragma unroll
    for (int j = 0; j < 4; ++j) gv[j] = *(const f32x4*)(C.in[I_FNG] + 4 * C.lane + 256 * j);
    for (int m = gw; m < T_LAT; m += NGW) {
        float* xr = C.out + (size_t)m * 1024;
        f32x4 v[4]; float s = 0.f;
#pragma unroll
        for (int j = 0; j < 4; ++j) { v[j] = *(const f32x4*)(xr + 4 * C.lane + 256 * j); s += (v[j].x * v[j].x + v[j].y * v[j].y) + (v[j].z * v[j].z + v[j].w * v[j].w); }
        const float rs = rsqrtf_(wave_sum(s) * (1.0f / 1024.0f) + 1e-6f);
#pragma unroll
        for (int j = 0; j < 4; ++j) *(f32x4*)(xr + 4 * C.lane + 256 * j) = v[j] * rs * gv[j];
    }
}

constexpr int NPH_L = 13, PH_FINAL = 1 + DEPTH * NPH_L, NPHASE = PH_FINAL + 1;
__host__ __device__ inline bool phase_exists(int ph) {
    if (ph == 0) return true;
    if (ph == PH_FINAL) return false;
    const int l = (ph - 1) / NPH_L, k = (ph - 1) % NPH_L;
    if (l >= 2 && !(l & 1) && k == 0) return false;
    if (!(l & 1) && k >= 11) return false;
    if (!RW_VSPLIT && k == 4) return false;
    return true;
}
#ifndef PH_MASK
#define PH_MASK 0xFFFFFF
#endif
#define PM(k) ((PH_MASK >> (k)) & 1)
#ifndef SK_MASK
#define SK_MASK 0xFFFF
#endif
#define SK(k) ((SK_MASK >> (k)) & 1)
#ifndef REP_MASK
#define REP_MASK 0
#endif
#define NREP(k) (((REP_MASK >> (k)) & 1) ? 2 : 1)

__global__ void __launch_bounds__(NTHR, 2) fwd_kernel(Args args) {
    extern __shared__ __attribute__((aligned(16))) unsigned char lds_raw[];
    Ctx C; C.in = args.in; C.out = args.out; C.ws = args.ws; C.lds = (LAS unsigned char*)lds_raw;
    C.tid = threadIdx.x; C.lane = C.tid & 63; C.wave = __builtin_amdgcn_readfirstlane(C.tid >> 6); C.G = gridDim.x; C.wg = blockIdx.x;
    volatile LAS unsigned* MISC = (volatile LAS unsigned*)(C.lds + MISC_OFF);
    if (C.tid < 64) MISC[C.tid] = 0u;
    __syncthreads();
    const int lo = args.ph_lo, hi = args.ph_hi;
    const bool multi = (hi - lo) > 1;
    if (multi) (void)xcd_barrier_post(WSP(unsigned, WS_CTL) + CW_BAR, MISC + 8);
#define IN(k) (lo <= (k) && (k) < hi)
#define SEAM(k) do { if (IN((k) + 1)) { XcdBarrier b2_; b2_.bar = WSP(unsigned, WS_CTL) + CW_BAR; b2_.x = xb_xcc_id(); b2_.st = (volatile LAS unsigned*)(C.lds + MISC_OFF) + 8; xcd_barrier(b2_); } } while (0)
#define FRESH() do { int t_ = threadIdx.x; asm volatile("" : "+v"(t_)); C.tid = t_; C.lane = t_ & 63; C.wave = __builtin_amdgcn_readfirstlane(t_ >> 6); } while (0)
#define PHASE(bit, k) if (PM(bit) && IN(pb + (k))) for (int rep_ = 0; rep_ < NREP(bit); ++rep_)
#define CLAIM(qh, var) __syncthreads(); if (C.tid == 0) *qslot = atomicAdd((qh), 1u); __syncthreads(); const int var = (int)*qslot;

    LAS unsigned* qslot = (LAS unsigned*)(C.lds + MISC_OFF + 128);
    constexpr int NCSL = 512;
#define CONV_QUEUES(maxn) do { int n_ = 0; \
        if (l > 0) for (; n_ < (maxn); ++n_) { FRESH(); CLAIM(qbase + 192, u0) if (u0 >= NCSL) break; FRESH(); convert_items(C, l, 2, u0 * NWAVES + C.wave, NCSL * NWAVES); } \
        if (l + 1 < DEPTH) for (; n_ < (maxn); ++n_) { FRESH(); CLAIM(qbase + 224, u0) if (u0 >= NCSL) break; FRESH(); convert_items(C, l + 1, 1, u0 * NWAVES + C.wave, NCSL * NWAVES); } } while (0)
    if (PM(20) && IN(0)) { phase_pre(C);
        for (;;) { FRESH(); CLAIM(WSP(unsigned, WS_CTL) + CW_PREPQ + 240, u0) if (u0 >= NCSL) break; FRESH(); convert_items(C, 0, 3, u0 * NWAVES + C.wave, NCSL * NWAVES); }
        SEAM(0); }

#pragma unroll 1
    for (int l = 0; l < DEPTH; ++l) {
        const int pb = 1 + l * NPH_L;
        if (hi <= pb || lo >= pb + NPH_L) continue;
        const bool last = (l == DEPTH - 1), moe = (l & 1);
        const int nrows = last ? T_LAT : T_ALL;
        const void* xlat = (l == 0) ? (const void*)C.in[I_X] : (const void*)C.out; const bool xbf = l > 0; void* xmid = last ? (void*)WSP(bf16, WS_XLAST) : (void*)C.out;
        const float* xctx = (l == 0) ? C.in[I_CTX] : WSP(const float, WS_XC);
        const float* modv = WSP(const float, WS_MODV) + (size_t)l * 9 * 6144;
        unsigned* qbase = WSP(unsigned, WS_CTL) + CW_PREPQ + 256 * l;

        if (!(l >= 2 && !(l & 1))) PHASE(0, 0) { FRESH();
            convert_small(C, l);
            __syncthreads();
            FRESH(); norm_rows<false>(C, l, xlat, xbf, xctx, C.in[I_NMIXG] + l * 1024, 0, 1024, T_ALL, 0);
            SEAM(pb + 0);
        }
        PHASE(1, 1) { FRESH();
            pg8::Gemm g{WSP(const bf16, WS_HB), WSP(const bf16, WS_WIN), T_ALL, PLD, 1024, 0};
            const int gG = (l > 0) ? C.G - 16 : C.G;
            if (C.wg < gG) {
                pg8::StaticOrder S; S.init(T_ALL, PLD, gG, C.wg);
                pg8::EpiBf16<0> E{WSP(bf16, WS_P), PLD, nullptr, 0, 0};
                pg8::gemm_phase<pg8::EpiBf16<0>, pg8::StaticOrder, false>(C.lds, g, S, E, nullptr);
                if (l > 0 && C.tid == 0) (void)xb_add(qbase + 176, 1u);
            } else {
                for (;;) { FRESH(); __syncthreads(); if (C.tid == 0) *qslot = xb_ld(qbase + 176); __syncthreads(); const unsigned fin_ = *qslot; if (fin_ != 0u) break;
                    CLAIM(qbase + 192, u0) if (u0 >= NCSL) break; FRESH(); convert_items(C, l, 2, u0 * NWAVES + C.wave, NCSL * NWAVES); }
            }
            SEAM(pb + 1);
        }
        if (PM(2) && IN(pb + 2)) for (int rep_ = 0; rep_ < NREP(2); ++rep_) { FRESH();
            for (;;) {
                CLAIM(qbase + 16 * rep_, k)
                if (k >= 2 * NB * NCH) break;
                const int kind = k / (NB * NCH), u = k % (NB * NCH);
                FRESH();
                if (kind == 0) { for (int r3_ = 0; r3_ < NREP(24); ++r3_) { FRESH(); if (SK(1)) rwkv_prep2(C, l, u / NCH, u % NCH); } }
                else { for (int r3_ = 0; r3_ < NREP(26); ++r3_) { FRESH(); if (SK(2)) gdn_prep(C, l, u / NCH, u % NCH); } }
            }
            SEAM(pb + 2);
        }
        if (PM(3) && IN(pb + 3)) for (int rep_ = 0; rep_ < NREP(3); ++rep_) { FRESH();
            constexpr int NCL = 2 * NB * NH * NCH / 4;
            int ncl_ = 0;
            for (;;) {
                CLAIM(qbase + 64 + 16 * rep_, k)
                if (k >= NCL) break;
                FRESH(); ++ncl_;
                if (SK(10)) rwkv_solve_item(C, l, 4 * k + (C.wave >> 1));
            }
            if (ncl_ <= 4) { const int cap_ = (l & 1) ? 1 : 3; CONV_QUEUES(cap_); }
            SEAM(pb + (RW_VSPLIT ? 3 : 4));
        }
#if RW_VSPLIT
        if (PM(3) && IN(pb + 4)) { FRESH();
            for (;;) {
                CLAIM(qbase + 128, k)
                if (k >= 2 * NB * NH * NCH / 4) break;
                FRESH();
                if (SK(10)) rwkv_solve_item(C, l, 4 * k + (C.wave >> 1));
            }
            SEAM(pb + 4);
        }
#endif
        if (PM(4) && IN(pb + 5)) { FRESH();
            if (C.wg >= 64) {
                constexpr int NCL = 2 * NB * NH * NCH / 4;
                for (;;) {
                    CLAIM(qbase + 128, k)
                    if (k >= NCL) break;
                    FRESH();
                    if (SK(9)) gdn_solve_item(C, l, 4 * k + (C.wave >> 1));
                }
                asm volatile("s_waitcnt vmcnt(0)" ::: "memory");
                __syncthreads();
                if (C.tid == 0) { __builtin_amdgcn_fence(__ATOMIC_RELEASE, "agent"); asm volatile("s_waitcnt vmcnt(0)" ::: "memory"); (void)xb_add(qbase + 160, 1u); }
                if (C.wg >= 192) {
                    if (C.tid == 0) { unsigned* bar_ = WSP(unsigned, WS_CTL) + CW_BAR; XB_SPIN(xb_ld(qbase + 160) < (unsigned)(C.G - 64), bar_); __builtin_amdgcn_fence(__ATOMIC_ACQUIRE, "agent"); asm volatile("s_waitcnt vmcnt(0)" ::: "memory"); }
                    __syncthreads();
                }
                FRESH();
            }
            if (C.wg >= 64 && C.wg < 128) { if (SK(0)) lru_chain(C, l, C.wg - 64); FRESH(); }
            if (SK(3) && C.wg < (RW_VSPLIT ? 128 : 64)) { if (NREP(20) > 1) { FRESH(); rwkv_chunked<true>(C, l, C.wg); } FRESH(); rwkv_chunked<false>(C, l, C.wg); }
            else if (SK(4) && C.wg >= 128 && C.wg < 192) { for (int r2_ = 0; r2_ < NREP(21); ++r2_) { FRESH(); mlstm_chunked(C, l, C.wg - 128); } }
            else if (SK(5) && C.wg >= 192) { if (NREP(22) > 1) { FRESH(); gdn_chunked<true>(C, l, C.wg - 192); } FRESH(); gdn_chunked<false>(C, l, C.wg - 192); }
            FRESH(); CONV_QUEUES(1 << 30);
            SEAM(pb + 5);
        }
        PHASE(5, 6) { FRESH();
            if (SK(8)) finish_rows(C, l, nrows);
            SEAM(pb + 6);
        }
        if (PM(6) && IN(pb + 7)) { FRESH();
            pg8::Gemm g{WSP(const bf16, WS_HB), WSP(const bf16, WS_WOUT), nrows, 1024, 1024, 0};
            pg8::TailHalfOrder S; S.init(nrows, C.G, C.wg);
            pg8::EpiRes E{xlat, xctx, xmid, WSP(float, WS_XC), modv + 2 * 1024, xbf, true};
            pg8::gemm_phase<pg8::EpiRes, pg8::TailHalfOrder, false>(C.lds, g, S, E, nullptr);
            SEAM(pb + 7);
        }
        if (PM(7) && IN(pb + 8)) { FRESH();
            if (moe) norm_rows<true>(C, l, xmid, true, WSP(const float, WS_XC), C.in[I_NFFNG] + l * 1024, 3 * 1024, 4 * 1024, nrows, l >> 1);
            else norm_rows<false>(C, l, xmid, true, WSP(const float, WS_XC), C.in[I_NFFNG] + l * 1024, 3 * 1024, 4 * 1024, nrows, 0);
            SEAM(pb + 8);
        }
        if (!moe) {
            if (PM(8) && IN(pb + 9)) for (int rep_ = 0; rep_ < NREP(8); ++rep_) { FRESH();
                pg8::Gemm g{WSP(const bf16, WS_HB), WSP(const bf16, WS_WGU), nrows, 2 * DFF, 1024, 0};
                pg8::StaticOrder S; S.init(nrows, 2 * DFF, C.G, C.wg);
                pg8::EpiSwiglu E{WSP(bf16, WS_P), DFF};
                pg8::gemm_phase<pg8::EpiSwiglu, pg8::StaticOrder, false>(C.lds, g, S, E, nullptr);
                SEAM(pb + 9);
            }
            if (PM(9) && IN(pb + 10)) { FRESH();
                pg8::Gemm g{WSP(const bf16, WS_P), WSP(const bf16, WS_WDN), nrows, 1024, DFF, 0};
                pg8::TailHalfOrder S; S.init(nrows, C.G, C.wg);
                pg8::EpiRes E{xmid, WSP(const float, WS_XC), xmid, WSP(float, WS_XC), modv + 5 * 1024, true, true};
                pg8::gemm_phase<pg8::EpiRes, pg8::TailHalfOrder, false>(C.lds, g, S, E, nullptr);
                SEAM(pb + 12);
            }
        } else {
            if (PM(10) && IN(pb + 9)) { FRESH(); moe_scatter(C, l >> 1, nrows); SEAM(pb + 9); }
            if (PM(11) && IN(pb + 10)) for (int rep_ = 0; rep_ < NREP(11); ++rep_) { FRESH();
                pg8::Gemm g{WSP(const bf16, WS_HB), WSP(const bf16, WS_WGU), 0, 2 * DFE, 1024, (size_t)2 * DFE * 1024};
                pg8::MoeOrderG S; S.init(WSP(const int, WS_TAB), (2 * DFE) / 256, C.G, C.wg); S.tok = WSP(const int, WS_TOK);
                pg8::EpiSwiglu E{WSP(bf16, WS_P), DFE};
                pg8::gemm_phase<pg8::EpiSwiglu, pg8::MoeOrderG, false>(C.lds, g, S, E, nullptr);
                SEAM(pb + 10);
            }
            if (PM(12) && IN(pb + 11)) for (int rep_ = 0; rep_ < NREP(12); ++rep_) { FRESH();
                pg8::Gemm g{WSP(const bf16, WS_P), WSP(const bf16, WS_WDN), 0, 1024, DFE, (size_t)1024 * DFE};
                pg8::MoeOrder S; S.init(WSP(const int, WS_TAB), 4, C.G, C.wg);
                pg8::EpiBf16<0> E{WSP(bf16, WS_MIX), 1024, nullptr, 0, 0};
                pg8::gemm_phase<pg8::EpiBf16<0>, pg8::MoeOrder, false>(C.lds, g, S, E, nullptr);
                SEAM(pb + 11);
            }
            if (PM(13) && IN(pb + 12)) { FRESH();
                if (last) moe_combine<2>(C, l, nrows);
                else { convert_small(C, l + 1); FRESH(); moe_combine<1>(C, l, nrows); if (IN(pb + NPH_L + 1)) { XcdBarrier b2_; b2_.bar = WSP(unsigned, WS_CTL) + CW_BAR; b2_.x = xb_xcc_id(); b2_.st = (volatile LAS unsigned*)(C.lds + MISC_OFF) + 8; xcd_barrier(b2_); } }
            }
        }
    }
}

extern "C" void kernel_launch(void* const* d_in, const int* in_sizes, int n_in, void* d_out, int out_size, void* d_ws, size_t ws_size, hipStream_t stream) {
    static int grid = 0;
    if (grid == 0) {
        if (n_in != N_IN || in_sizes[0] != T_LAT * DM || out_size != T_LAT * DM || ws_size < WS_END) {
            fprintf(stderr, "kernel_launch: unexpected problem (n_in %d, in0 %d, out %d, ws %zu < %zu)\n", n_in, n_in > 0 ? in_sizes[0] : -1, out_size, ws_size, (size_t)WS_END); grid = -1; return; }
        int dev = 0, cus = 0, per_cu = 0;
        if (hipGetDevice(&dev) != hipSuccess || hipDeviceGetAttribute(&cus, hipDeviceAttributeMultiprocessorCount, dev) != hipSuccess) { grid = -1; return; }
        if (hipFuncSetAttribute((const void*)fwd_kernel, hipFuncAttributeMaxDynamicSharedMemorySize, LDS_BYTES) != hipSuccess) { fprintf(stderr, "kernel_launch: hipFuncSetAttribute failed\n"); grid = -1; return; }
        if (hipOccupancyMaxActiveBlocksPerMultiprocessor(&per_cu, (const void*)fwd_kernel, NTHR, LDS_BYTES) != hipSuccess || per_cu < 1) { fprintf(stderr, "kernel_launch: occupancy query says %d\n", per_cu); grid = -1; return; }
        grid = cus;
        if (grid != 256) fprintf(stderr, "kernel_launch: note: %d CUs\n", grid);
    }
    if (grid < 0) return;
    if (hipMemsetAsync((char*)d_ws + WS_CTL, 0, CTL_BYTES, stream) != hipSuccess) return;
    Args a{};
    for (int i = 0; i < N_IN; ++i) a.in[i] = (const float*)d_in[i];
    a.out = (float*)d_out; a.ws = (unsigned char*)d_ws;
#if MK_ONE_LAUNCH
    a.ph_lo = 0; a.ph_hi = NPHASE;
    hipLaunchKernelGGL(fwd_kernel, dim3(grid), dim3(NTHR), LDS_BYTES, stream, a);
#else
    for (int ph = 0; ph < NPHASE; ++ph) { if (!phase_exists(ph)) continue; a.ph_lo = ph; a.ph_hi = ph + 1; hipLaunchKernelGGL(fwd_kernel, dim3(grid), dim3(NTHR), LDS_BYTES, stream, a); }
#endif
}
```

```cpp
#define MK_ONE_LAUNCH 1
#include <hip/hip_runtime.h>
#include <cstdio>
#include <cstdint>

#define GAS __attribute__((address_space(1)))
#define LAS __attribute__((address_space(3)))
typedef unsigned short bf16;
typedef unsigned v4u __attribute__((ext_vector_type(4)));
typedef unsigned v2u __attribute__((ext_vector_type(2)));
typedef float f32x4 __attribute__((ext_vector_type(4)));
typedef float f32x2 __attribute__((ext_vector_type(2)));
typedef short bf16x8 __attribute__((ext_vector_type(8)));
#define LDS_WAIT() asm volatile("s_waitcnt lgkmcnt(0)" ::: "memory")
#define VM_WAIT() asm volatile("s_waitcnt vmcnt(0)" ::: "memory")

constexpr int DM = 1024, NB = 8, SEQ = 4096, DEPTH = 4, CTXL = 256, GW = 256, HD = 64, NH = 4;
constexpr int T_LAT = NB * SEQ, T_CTX = NB * CTXL, T_ALL = T_LAT + T_CTX;
constexpr int IN_COLS = 3552, PLD = 3584;
constexpr int OFF_B = 512, OFF_C = 1472, OFF_D = 2512, B_COLS = 960;
constexpr int DFF = 2816, NE = 8, DFE = 1408;
constexpr int NCH = 68;
constexpr int NSTEP = 4352;
constexpr int MOE_MAXBLK = 280;
constexpr int NWAVES = 8, NTHR = 512;
#ifndef RW_VSPLIT
#define RW_VSPLIT 0
#endif

constexpr size_t MiB = 1u << 20;
constexpr size_t WS_CTL = 0, CTL_BYTES = 1 * MiB;
constexpr size_t WS_MODV = 1 * MiB;
constexpr size_t WS_XC = 2 * MiB;
constexpr size_t WS_WIN = 10 * MiB;
constexpr size_t WS_WOUT = 17 * MiB;
constexpr size_t WS_WGU = 19 * MiB;
constexpr size_t WS_WDN = 63 * MiB;
constexpr size_t WS_HB = 85 * MiB;
constexpr size_t WS_P = 153 * MiB;
constexpr size_t WS_MIX = 391 * MiB;
constexpr size_t WS_OUTB = WS_MIX, WS_OUTC = WS_MIX + 34 * MiB, WS_OUTD = WS_MIX + 68 * MiB, WS_GQ = WS_MIX + 102 * MiB, WS_G = WS_MIX + 153 * MiB;
constexpr size_t WS_XLAST = WS_MIX + 144 * MiB;
constexpr size_t WS_RKV = WS_MIX + 170 * MiB;
constexpr size_t WS_SMALL = 612 * MiB;
constexpr size_t WS_ROUTE = WS_SMALL;
constexpr size_t WS_POS = WS_SMALL + 1280 * 1024;
constexpr size_t WS_TOK = WS_SMALL + 1664 * 1024;
constexpr size_t WS_BONUS = WS_SMALL + 2 * MiB;
constexpr size_t WS_RINV = WS_SMALL + 2 * MiB + 640 * 1024;
constexpr size_t WS_WGBASE = WS_SMALL + 3 * MiB + 256 * 1024;
constexpr size_t WS_TAB = WS_WGBASE + 65536;
constexpr size_t WS_LRUWT = WS_SMALL + 3 * MiB + 512 * 1024;
constexpr size_t WS_RWT = WS_LRUWT + 131072;
constexpr size_t WS_LRUH = WS_SMALL + 4 * MiB;
constexpr size_t WS_END = 633 * MiB;
constexpr int CW_MOECNT = 1024;
constexpr int CW_PREPQ = 2048;
constexpr int CW_BAR = 4096;

constexpr int LDS_BYTES = 135168;
constexpr int MISC_OFF = 131072;

__device__ __forceinline__ unsigned f2bf(float f) { unsigned u = __builtin_bit_cast(unsigned, f); return (u + 0x7fffu + ((u >> 16) & 1u)) >> 16; }
typedef __bf16 bf16n2 __attribute__((ext_vector_type(2)));
__device__ __forceinline__ unsigned pk2(float lo, float hi) { const f32x2 v = {lo, hi}; return __builtin_bit_cast(unsigned, __builtin_convertvector(v, bf16n2)); }
__device__ __forceinline__ unsigned f2bf1(float f) { return pk2(f, f) & 0xffffu; }
__device__ __forceinline__ float bf2f(unsigned short v) { return __builtin_bit_cast(float, (unsigned)v << 16); }
__device__ __forceinline__ float bflo(unsigned v) { return __builtin_bit_cast(float, v << 16); }
__device__ __forceinline__ float bfhi(unsigned v) { return __builtin_bit_cast(float, v & 0xffff0000u); }
template <int CTRL, int RM, bool BC> __device__ __forceinline__ float dpp_x(float oldv, float v) { return __builtin_bit_cast(float, __builtin_amdgcn_update_dpp(__builtin_bit_cast(int, oldv), __builtin_bit_cast(int, v), CTRL, RM, 0xF, BC)); }
__device__ __forceinline__ float wave_sum(float v) {
    v += dpp_x<0xB1, 0xF, true>(0.f, v); v += dpp_x<0x4E, 0xF, true>(0.f, v); v += dpp_x<0x141, 0xF, true>(0.f, v); v += dpp_x<0x140, 0xF, true>(0.f, v);
    v += dpp_x<0x142, 0xA, false>(0.f, v); v += dpp_x<0x143, 0xC, false>(0.f, v);
    return __builtin_bit_cast(float, __builtin_amdgcn_readlane(__builtin_bit_cast(int, v), 63));
}
template <int CTRL> __device__ __forceinline__ float dpp_f(float v) { return __builtin_bit_cast(float, __builtin_amdgcn_update_dpp(0, __builtin_bit_cast(int, v), CTRL, 0xF, 0xF, true)); }
__device__ __forceinline__ float row16_sum(float v) {
    v += dpp_f<0xB1>(v);
    v += dpp_f<0x4E>(v);
    v += dpp_f<0x141>(v);
    v += dpp_f<0x140>(v);
    return v;
}
__device__ __forceinline__ float sigmoidf_(float x) { return __builtin_amdgcn_rcpf(1.0f + __expf(-x)); }
__device__ __forceinline__ float softplusf_(float x) { return fmaxf(x, 0.f) + __logf(1.0f + __expf(-fabsf(x))); }
__device__ __forceinline__ float expm1f_(float x) { return x > -0.3f ? x * (1.0f + x * (0.5f + x * (0.16666667f + x * (0.041666668f + x * 0.0083333338f)))) : __expf(x) - 1.0f; }
__device__ __forceinline__ float siluf_(float x) { return x * __builtin_amdgcn_rcpf(1.0f + __expf(-x)); }
__device__ __forceinline__ float tanhf_(float x) { const float e = __expf(2.0f * x); return 1.0f - 2.0f * __builtin_amdgcn_rcpf(e + 1.0f); }
__device__ __forceinline__ float rsqrtf_(float x) { return __builtin_amdgcn_rsqf(x); }
__device__ __forceinline__ float gelu_tanh(float x) { return 0.5f * x * (1.0f + tanhf_(0.7978845608028654f * (x + 0.044715f * x * x * x))); }
__device__ __forceinline__ f32x4 ld4bf(const bf16* p) { const v2u a = *(const v2u*)p; return (f32x4){bflo(a.x), bfhi(a.x), bflo(a.y), bfhi(a.y)}; }
__device__ __forceinline__ void st4bf(bf16* p, const f32x4& v) { v2u o; o.x = pk2(v.x, v.y); o.y = pk2(v.z, v.w); *(v2u*)p = o; }
#define XB_TMO      128
#define XB_XCNT(j)  (256  + 64 * (j))
#define XB_XSUB(j)  (1280 + 64 * (j))
#define XB_XGEN(j)  (2304 + 64 * (j))
#define XB_TOP      3328
#define XB_TOPGEN   3392
#define XCD_BAR_WORDS 3456
#define XB_SPIN_CAP (1u << 22)

__device__ __forceinline__ unsigned xb_ld(unsigned* p)              { return __hip_atomic_load(p, __ATOMIC_RELAXED, __HIP_MEMORY_SCOPE_AGENT); }
__device__ __forceinline__ unsigned xb_add(unsigned* p, unsigned v) { return __hip_atomic_fetch_add(p, v, __ATOMIC_RELAXED, __HIP_MEMORY_SCOPE_AGENT); }
__device__ __forceinline__ unsigned xb_xcc_id() { return (unsigned)__builtin_amdgcn_s_getreg((3 << 11) | 20) & 0xFu; }
#define XB_SPIN(cond, bar) do { unsigned _sp = 0; while (cond) { __builtin_amdgcn_s_sleep(1); \
    if ((++_sp & 255u) == 0u) { if (xb_ld(&(bar)[XB_TMO])) break; if (_sp > XB_SPIN_CAP) { atomicAdd(&(bar)[XB_TMO], 1u); break; } } } } while (0)

struct XcdBarrier {
    unsigned* bar; unsigned x;
    volatile LAS unsigned* st;
};

__device__ __forceinline__ XcdBarrier xcd_barrier_post(unsigned* bar, volatile LAS unsigned* st) {
    XcdBarrier b; b.bar = bar; b.x = xb_xcc_id(); b.st = st;
    if (threadIdx.x == 0) (void)xb_add(&bar[XB_XCNT(b.x)], 1u);
    return b;
}
__device__ __forceinline__ void xcd_barrier_complete(unsigned* bar, unsigned x, unsigned& nloc, unsigned& nx) {
    const unsigned G = gridDim.x * gridDim.y * gridDim.z;
    unsigned sum, cnt, mine, sp = 0u;
    for (;;) {
        sum = 0u; cnt = 0u; mine = 0u;
#pragma unroll
        for (unsigned j = 0; j < 16; ++j) { const unsigned c = xb_ld(&bar[XB_XCNT(j)]); sum += c; cnt += (c > 0u) ? 1u : 0u; mine = (j == x) ? c : mine; }
        if (sum == G) break;
        __builtin_amdgcn_s_sleep(1);
        if ((++sp & 255u) == 0u) { if (xb_ld(&bar[XB_TMO])) break; if (sp > XB_SPIN_CAP) { atomicAdd(&bar[XB_TMO], 1u); break; } }
    }
    nloc = mine > 0u ? mine : 1u; nx = cnt > 0u ? cnt : 1u;
}

__device__ __forceinline__ void xcd_barrier(const XcdBarrier& b) {
    asm volatile("s_waitcnt vmcnt(0)" ::: "memory");
    __syncthreads();
    if (threadIdx.x == 0) {
        unsigned* bar = b.bar;
        __builtin_amdgcn_s_waitcnt(0);
        unsigned nloc = b.st[0], nx = b.st[1];
        if (nloc == 0u) { xcd_barrier_complete(bar, b.x, nloc, nx); b.st[0] = nloc; b.st[1] = nx; }
        const unsigned old = xb_add(&bar[XB_XSUB(b.x)], 1u);
        const unsigned gen = old / nloc;
        if (old + 1u == (gen + 1u) * nloc) {
            __builtin_amdgcn_fence(__ATOMIC_RELEASE, "agent");
            asm volatile("s_waitcnt vmcnt(0)" ::: "memory");
            const unsigned og = xb_add(&bar[XB_TOP], 1u);
            const unsigned tg = og / nx;
            if (og + 1u == (tg + 1u) * nx) xb_add(&bar[XB_TOPGEN], 1u);
            else XB_SPIN(xb_ld(&bar[XB_TOPGEN]) == tg, bar);
            __builtin_amdgcn_fence(__ATOMIC_ACQUIRE, "agent");
            xb_add(&bar[XB_XGEN(b.x)], 1u);
            asm volatile("s_waitcnt vmcnt(0)" ::: "memory");
        } else {
            XB_SPIN(xb_ld(&bar[XB_XGEN(b.x)]) == gen, bar);
            __builtin_amdgcn_fence(__ATOMIC_ACQUIRE, "agent");
            asm volatile("s_waitcnt vmcnt(0)" ::: "memory");
        }
    }
    __syncthreads();
}

namespace pg8 {
#define PG8_LAS __attribute__((address_space(3)))
typedef unsigned short bf16_t;
typedef short bf16x8 __attribute__((ext_vector_type(8)));
typedef float f32x4 __attribute__((ext_vector_type(4)));
typedef unsigned u32x4 __attribute__((ext_vector_type(4)));
constexpr int BM = 256, BK = 64, HALF = 128, HTB = HALF * BK * 2  , STAGE_BYTES = 8 * HTB, NXCD = 8, WGM = 8;

__host__ __device__ __forceinline__ int lds_byte(int r, int c) { const int st = (r >> 4) * 2 + (c >> 5), rr = r & 15, cc = c & 31, ob = rr * 64 + cc * 2; return st * 1024 + (ob ^ (((ob >> 9) & 1) << 5)); }
__host__ __device__ __forceinline__ void stage_rc(int b, int& R, int& C) { const int st = b / 1024, sb = b % 1024, swz = sb ^ (((sb >> 9) & 1) << 5); R = (st >> 1) * 16 + swz / 64; C = (st & 1) * 32 + (swz % 64) / 2; }
__host__ __device__ __forceinline__ int perm32(int rho) { const int n = rho >> 4, i = rho & 15; return 8 * (i >> 2) + 4 * n + (i & 3); }

struct Unit { int pm, pn, e; };
struct Gemm { const bf16_t* A; const bf16_t* Bt; int M, N, K; size_t estride; };

struct StaticOrder {
    static constexpr bool GATHER = false, HALFS = false;
    int nM, nN, nwg, G, c;
    __host__ __device__ void init(int M, int N, int G_, int c_) { nM = M / BM; nN = N / BM; nwg = nM * nN; G = G_; c = c_; }
    __host__ __device__ bool next(int i, Unit& u) const {
        const long L = (long)i * G + c; if (L >= nwg) return false;
        int wgid = (int)L; { const int q = nwg / NXCD, r = nwg % NXCD, xcd = wgid % NXCD, off = wgid / NXCD; wgid = (xcd < r ? xcd * (q + 1) : r * (q + 1) + (xcd - r) * q) + off; }
        const int nig = WGM * nN, gid = wgid / nig, fm = gid * WGM, gsz = (nM - fm) < WGM ? (nM - fm) : WGM;
        u.pm = fm + ((wgid % nig) % gsz); u.pn = (wgid % nig) / gsz; u.e = 0; return true;
    }
    __device__ __forceinline__ void a_ready(const Unit&) const {}
    __device__ __forceinline__ void done(const Unit&) const {}
};
struct TailHalfOrder {
    static constexpr bool GATHER = false, HALFS = true;
    int nM, nwg, G, c, ntail;
    __device__ __forceinline__ void init(int M, int G_, int c_) { const int nMall = M / BM; nM = nMall >= 128 ? 128 : nMall; nwg = nM * 4; ntail = nMall - nM; G = G_; c = c_; }
    __device__ __forceinline__ bool next(int i, Unit& u) const {
        const int L = i * G + c;
        if (L < nwg) {
            int wgid = L; { const int q = nwg / NXCD, r = nwg % NXCD, xcd = wgid % NXCD, off = wgid / NXCD; wgid = (xcd < r ? xcd * (q + 1) : r * (q + 1) + (xcd - r) * q) + off; }
            const int nig = WGM * 4, gid = wgid / nig, fm = gid * WGM, gsz = (nM - fm) < WGM ? (nM - fm) : WGM;
            u.pm = fm + ((wgid % nig) % gsz); u.pn = (wgid % nig) / gsz; u.e = 0; return true;
        }
        const int t = L - nwg; if (t >= ntail * 8) return false;
        const int nh = t / ntail; u.pm = 128 + (t - nh * ntail); u.pn = (nh >> 1) | ((1 + (nh & 1)) << 8); u.e = 0; return true;
    }
    __device__ __forceinline__ void a_ready(const Unit&) const {}
    __device__ __forceinline__ void done(const Unit&) const {}
};
typedef __bf16 bf16n2_ __attribute__((ext_vector_type(2)));
__device__ __forceinline__ unsigned cvt_pk_bf16(float lo, float hi) { typedef float f2_ __attribute__((ext_vector_type(2))); const f2_ v = {lo, hi}; return __builtin_bit_cast(unsigned, __builtin_convertvector(v, bf16n2_)); }
typedef float f32x2 __attribute__((ext_vector_type(2)));
__device__ __forceinline__ f32x2 gelu_pk(f32x2 v) {
    const f32x2 av = __builtin_elementwise_abs(v), d = av * 0.2316418882f + 1.0f;
    f32x2 t; t.x = __builtin_amdgcn_rcpf(d.x); t.y = __builtin_amdgcn_rcpf(d.y);
    f32x2 q = t * 0.5307027145f + (-0.7265760135f); q = q * t + 0.7107068705f; q = q * t + (-0.142248368f); q = q * t + 0.127414796f; q = q * t;
    const f32x2 s = (v * v) * (-0.72134752044f);
    f32x2 e; e.x = __builtin_amdgcn_exp2f(s.x); e.y = __builtin_amdgcn_exp2f(s.y);
    const f32x2 m = v * (q * e), r = v - m;
    f32x2 o; o.x = v.x < 0.f ? m.x : r.x; o.y = v.y < 0.f ? m.y : r.y; return o;
}

struct EpiF32 {
    static constexpr bool PERM = false, AFTER_DRAIN = false;
    float* C; int ldc; const float* bias;
    __device__ __forceinline__ void operator()(const f32x4 (&acc)[2][2][4][2], const Unit& u, int wr, int wc, int fr, int fq) const {
        const int row0 = u.pm * BM + wr * 64 + fr, col0 = u.pn * BM + wc * 32 + 4 * fq;
        f32x4 bv[2][2];
#pragma unroll
        for (int bj = 0; bj < 2; ++bj)
#pragma unroll
            for (int n = 0; n < 2; ++n) bv[bj][n] = bias ? *(const f32x4*)(bias + col0 + bj * HALF + n * 16) : (f32x4){0.f, 0.f, 0.f, 0.f};
#pragma unroll
        for (int ai = 0; ai < 2; ++ai)
#pragma unroll
            for (int m = 0; m < 4; ++m) { float* rowp = C + (size_t)(row0 + ai * HALF + m * 16) * ldc + col0;
#pragma unroll
                for (int bj = 0; bj < 2; ++bj)
#pragma unroll
                    for (int n = 0; n < 2; ++n) *(f32x4*)(rowp + bj * HALF + n * 16) = acc[ai][bj][m][n] + bv[bj][n]; }
    }
};
template <int ACT  > struct EpiBf16 {
    static constexpr bool PERM = true, AFTER_DRAIN = false;
    bf16_t* O; int ldc; const float* bias; int split_cols; size_t split_stride;
    __device__ __forceinline__ void operator()(const f32x4 (&acc)[2][2][4][2], const Unit& u, int wr, int wc, int fr, int fq) const {
        const int row0 = u.pm * BM + wr * 64 + fr; int colt = u.pn * BM; bf16_t* base = O;
        if (split_cols) { const int t = colt / split_cols; base += (size_t)t * split_stride; colt -= t * split_cols; }
        const int col0 = colt + wc * 32 + 8 * fq, bcol0 = u.pn * BM + wc * 32 + 8 * fq;
        f32x4 bv[2][2];
#pragma unroll
        for (int bj = 0; bj < 2; ++bj)
#pragma unroll
            for (int n = 0; n < 2; ++n) bv[bj][n] = bias ? *(const f32x4*)(bias + bcol0 + bj * HALF + 4 * n) : (f32x4){0.f, 0.f, 0.f, 0.f};
#pragma unroll
        for (int ai = 0; ai < 2; ++ai)
#pragma unroll
            for (int m = 0; m < 4; ++m) { bf16_t* rowp = base + (size_t)(row0 + ai * HALF + m * 16) * ldc + col0;
#pragma unroll
                for (int bj = 0; bj < 2; ++bj) { f32x4 v0 = acc[ai][bj][m][0] + bv[bj][0], v1 = acc[ai][bj][m][1] + bv[bj][1];
                    if (ACT == 1) { f32x2 a = gelu_pk((f32x2){v0[0], v0[1]}), b = gelu_pk((f32x2){v0[2], v0[3]}), c = gelu_pk((f32x2){v1[0], v1[1]}), d = gelu_pk((f32x2){v1[2], v1[3]});
                        v0 = (f32x4){a.x, a.y, b.x, b.y}; v1 = (f32x4){c.x, c.y, d.x, d.y}; }
                    if (ACT == 2) {
#pragma unroll
                        for (int j = 0; j < 4; ++j) { v0[j] = 0.5f * v0[j] * (1.0f + erff(v0[j] * 0.70710678f)); v1[j] = 0.5f * v1[j] * (1.0f + erff(v1[j] * 0.70710678f)); } }
                    u32x4 w; w.x = cvt_pk_bf16(v0[0], v0[1]); w.y = cvt_pk_bf16(v0[2], v0[3]); w.z = cvt_pk_bf16(v1[0], v1[1]); w.w = cvt_pk_bf16(v1[2], v1[3]);
                    *(u32x4*)(rowp + bj * HALF) = w; } }
    }
};

template <class Epi, class Sched, bool STAMP = false>
__device__ __forceinline__ void gemm_phase(PG8_LAS unsigned char* lds, const Gemm g, const Sched& S, const Epi& E, unsigned long long* stamps) {
    int tid_ = threadIdx.x; asm volatile("" : "+v"(tid_));
    const int tid = tid_, wid = __builtin_amdgcn_readfirstlane(tid >> 6), lane = tid & 63, wr = wid >> 2, wc = wid & 3, fr = lane & 15, fq = lane >> 4;
    const int K = g.K, nt = K / BK;
    constexpr bool GATHER = Sched::GATHER; constexpr bool HALFS = Sched::HALFS;
    int ts_lo = 0, ts_hi = 0, nts = 0; const unsigned long long rt_entry = STAMP ? (unsigned long long)wall_clock64() : 0ull;
#define PG8_STAMP() do { if (STAMP && wid == 0 && nts < 64) { const unsigned long long _c = (unsigned long long)clock64(); \
        ts_lo = (lane == nts) ? (int)(unsigned)_c : ts_lo; ts_hi = (lane == nts) ? (int)(unsigned)(_c >> 32) : ts_hi; ++nts; } } while (0)
    PG8_STAMP();
    unsigned voffA[2], voffB[2]; int rowA[2];
#pragma unroll
    for (int i = 0; i < 2; ++i) { int R, C; stage_rc(tid * 16 + i * 8192, R, C); const int Rb = Epi::PERM ? ((R & ~31) + perm32(R & 31)) : R;
        rowA[i] = R; voffA[i] = GATHER ? (unsigned)C * 2u : (unsigned)(R * K + C) * 2u; voffB[i] = (unsigned)(Rb * K + C) * 2u; }
    const size_t kstep = (size_t)(BK * 2);
    const size_t hstep = (size_t)HALF * K * 2;
    const size_t tstep = 2 * hstep;
    const unsigned ldsw = (unsigned)wid * 1024u;
    const int aoff = lds_byte(wr * 64 + fr, fq * 8), boff = lds_byte(wc * 32 + fr, fq * 8);
#define PG8_SA(b, h) (((b) * 2 + (h)) * HTB)
#define PG8_SB(b, h) ((4 + (b) * 2 + (h)) * HTB)
#define PG8_STAGE(bufoff, gbase, voff) do { _Pragma("unroll") for (int _i = 0; _i < 2; ++_i) \
        __builtin_amdgcn_global_load_lds((const unsigned*)((const char*)(gbase) + (voff)[_i]), (PG8_LAS unsigned*)(lds + (bufoff) + ldsw + _i * 8192), 16, 0, 0); } while (0)
#define PG8_STAGE_A(bufoff, gbase, h, gv) do { if constexpr (GATHER) { PG8_STAGE(bufoff, gbase, (gv)[h]); } else { PG8_STAGE(bufoff, (gbase) + (h) * hstep, voffA); } } while (0)
#define PG8_TOKSLOT(s) ((PG8_LAS int*)(lds + STAGE_BYTES + 1024 + ((s) & 1) * 1024))
#define PG8_LDA(dst, b, h) do { _Pragma("unroll") for (int m = 0; m < 4; ++m) _Pragma("unroll") for (int k = 0; k < 2; ++k) dst[m][k] = *(const PG8_LAS bf16x8*)(lds + PG8_SA(b, h) + aoff + m * 2048 + k * 1024); } while (0)
#define PG8_LDB(dst, b, h) do { _Pragma("unroll") for (int n = 0; n < 2; ++n) _Pragma("unroll") for (int k = 0; k < 2; ++k) dst[n][k] = *(const PG8_LAS bf16x8*)(lds + PG8_SB(b, h) + boff + n * 2048 + k * 1024); } while (0)
#define PG8_MMA(ai, bj, At, Bt) do { __builtin_amdgcn_s_setprio(1); _Pragma("unroll") for (int m = 0; m < 4; ++m) _Pragma("unroll") for (int n = 0; n < 2; ++n) _Pragma("unroll") for (int k = 0; k < 2; ++k) \
        acc[ai][bj][m][n] = __builtin_amdgcn_mfma_f32_16x16x32_bf16(Bt[n][k], At[m][k], acc[ai][bj][m][n], 0, 0, 0); __builtin_amdgcn_s_setprio(0); } while (0)
#define PG8_WAIT_V(n) asm volatile("s_waitcnt vmcnt(" #n ")" ::: "memory")
#define PG8_WAIT_L(n) asm volatile("s_waitcnt lgkmcnt(" #n ")" ::: "memory")
#define PG8_BAR __builtin_amdgcn_s_barrier()
#define PG8_SCHED __builtin_amdgcn_sched_barrier(0)
    Unit cur, nxt; int ui = 0;
    if (!S.next(0, cur)) return;
    f32x4 acc[2][2][4][2];
#pragma unroll
    for (int a = 0; a < 2; ++a)
#pragma unroll
        for (int b = 0; b < 2; ++b)
#pragma unroll
            for (int m = 0; m < 4; ++m)
#pragma unroll
                for (int n = 0; n < 2; ++n) acc[a][b][m][n] = (f32x4){0.f, 0.f, 0.f, 0.f};
    bf16x8 At[4][2], B0[2][2], B1[2][2];
    const char* cA = (const char*)g.A + (GATHER ? (size_t)0 : (size_t)cur.pm * tstep); const char* cB = (const char*)g.Bt + (size_t)(HALFS ? cur.pn & 255 : cur.pn) * tstep + (size_t)cur.e * g.estride * 2 + ((HALFS && (cur.pn >> 8) == 2) ? hstep : (size_t)0);
    S.a_ready(cur);
    unsigned gcur[2][2], gnxt[2][2], gs[2][2];
    if constexpr (GATHER) {
        if (tid < 256) PG8_TOKSLOT(0)[tid] = S.tok[cur.pm * 256 + tid];
        __syncthreads();
#pragma unroll
        for (int h = 0; h < 2; ++h)
#pragma unroll
            for (int i = 0; i < 2; ++i) { gcur[h][i] = (unsigned)PG8_TOKSLOT(0)[h * HALF + rowA[i]] * (unsigned)(K * 2) + voffA[i]; gnxt[h][i] = gcur[h][i]; gs[h][i] = gcur[h][i]; }
    }
    PG8_STAGE(PG8_SB(0, 0), cB, voffB); PG8_STAGE_A(PG8_SA(0, 0), cA, 0, gcur); PG8_STAGE(PG8_SB(0, 1), cB + hstep, voffB); PG8_STAGE_A(PG8_SA(0, 1), cA, 1, gcur);
    if (wr == 1) PG8_BAR;
    PG8_WAIT_V(4); PG8_BAR;
    PG8_STAGE(PG8_SB(1, 0), cB + kstep, voffB); PG8_STAGE_A(PG8_SA(1, 0), cA + kstep, 0, gcur); PG8_STAGE(PG8_SB(1, 1), cB + hstep + kstep, voffB);
    PG8_WAIT_V(6); PG8_BAR;
    PG8_STAMP();
    for (;;) {
        const bool has_next = S.next(ui + 1, nxt);
        if constexpr (GATHER) { if (has_next && wid < 4)
            __builtin_amdgcn_global_load_lds((const unsigned*)(S.tok + nxt.pm * 256 + wid * 64 + lane), (PG8_LAS unsigned*)((PG8_LAS unsigned char*)PG8_TOKSLOT(ui + 1) + wid * 256), 4, 0, 0); }
        const char* nA = GATHER ? (const char*)g.A : has_next ? (const char*)g.A + (size_t)nxt.pm * tstep : cA; const char* nB = has_next ? (const char*)g.Bt + (size_t)(HALFS ? nxt.pn & 255 : nxt.pn) * tstep + (size_t)nxt.e * g.estride * 2 + ((HALFS && (nxt.pn >> 8) == 2) ? hstep : (size_t)0) : cB;
        const bool full = !HALFS || (cur.pn >> 8) == 0;
        for (int t = 0; t < nt; t += 2) {
            const bool last = (t == nt - 2);
            const char* a1 = cA + (size_t)(t + 1) * kstep;
            const char* a2 = last ? nA : cA + (size_t)(t + 2) * kstep; const char* b2 = last ? nB : cB + (size_t)(t + 2) * kstep;
            const char* a3 = a2 + kstep; const char* b3 = b2 + kstep;
            if (last && has_next) S.a_ready(nxt);
            if constexpr (GATHER) {
                if (last && has_next) {
#pragma unroll
                    for (int h = 0; h < 2; ++h)
#pragma unroll
                        for (int i = 0; i < 2; ++i) gnxt[h][i] = (unsigned)PG8_TOKSLOT(ui + 1)[h * HALF + rowA[i]] * (unsigned)(K * 2) + voffA[i];
                }
#pragma unroll
                for (int h = 0; h < 2; ++h)
#pragma unroll
                    for (int i = 0; i < 2; ++i) gs[h][i] = last ? gnxt[h][i] : gcur[h][i];
            }
            PG8_LDB(B0, 0, 0); PG8_SCHED; PG8_LDA(At, 0, 0); PG8_STAGE_A(PG8_SA(1, 1), a1, 1, gcur);
            PG8_WAIT_L(8); PG8_BAR; PG8_WAIT_L(0); PG8_MMA(0, 0, At, B0); PG8_BAR; PG8_SCHED;
            if (full) PG8_LDB(B1, 0, 1); PG8_STAGE(PG8_SB(0, 0), b2, voffB);
            PG8_BAR; PG8_WAIT_L(0); if (full) PG8_MMA(0, 1, At, B1); PG8_BAR;
            PG8_LDA(At, 0, 1); PG8_STAGE_A(PG8_SA(0, 0), a2, 0, gs);
            PG8_BAR; PG8_WAIT_L(0); PG8_MMA(1, 0, At, B0); PG8_BAR; PG8_SCHED;
            PG8_STAGE(PG8_SB(0, 1), b2 + hstep, voffB);
            PG8_WAIT_V(6); PG8_BAR; if (full) PG8_MMA(1, 1, At, B1); PG8_BAR;
            PG8_LDB(B0, 1, 0); PG8_SCHED; PG8_LDA(At, 1, 0); PG8_STAGE_A(PG8_SA(0, 1), a2, 1, gs);
            PG8_WAIT_L(8); PG8_BAR; PG8_WAIT_L(0); PG8_MMA(0, 0, At, B0); PG8_BAR; PG8_SCHED;
            if (full) PG8_LDB(B1, 1, 1); PG8_STAGE(PG8_SB(1, 0), b3, voffB);
            PG8_BAR; PG8_WAIT_L(0); if (full) PG8_MMA(0, 1, At, B1); PG8_BAR;
            PG8_LDA(At, 1, 1); PG8_STAGE_A(PG8_SA(1, 0), a3, 0, gs);
            PG8_BAR; PG8_WAIT_L(0); PG8_MMA(1, 0, At, B0); PG8_BAR; PG8_SCHED;
            PG8_STAGE(PG8_SB(1, 1), b3 + hstep, voffB);
            PG8_WAIT_V(6); PG8_BAR; if (full) PG8_MMA(1, 1, At, B1); PG8_BAR;
        }
        PG8_STAMP();
        if constexpr (!Epi::AFTER_DRAIN) { E(acc, cur, wr, wc, fr, fq); S.done(cur); }
        PG8_STAMP();
        if (!has_next) break;
#pragma unroll
        for (int a = 0; a < 2; ++a)
#pragma unroll
            for (int b = 0; b < 2; ++b)
#pragma unroll
                for (int m = 0; m < 4; ++m)
#pragma unroll
                    for (int n = 0; n < 2; ++n) acc[a][b][m][n] = (f32x4){0.f, 0.f, 0.f, 0.f};
        cur = nxt; cA = nA; cB = nB; ++ui;
        if constexpr (GATHER) {
#pragma unroll
            for (int h = 0; h < 2; ++h)
#pragma unroll
                for (int i = 0; i < 2; ++i) gcur[h][i] = gnxt[h][i];
        }
    }
    PG8_WAIT_V(0);
    if (wr == 0) PG8_BAR;
    PG8_BAR;
    if constexpr (Epi::AFTER_DRAIN) { E.fused(acc, cur, wr, wc, fr, fq, lds, wid, lane); S.done(cur); }
    PG8_STAMP();
    if (STAMP && wid == 0) { stamps[lane] = lane < nts ? (((unsigned long long)(unsigned)ts_hi << 32) | (unsigned)ts_lo) : 0ull;
        if (lane == 62) stamps[62] = rt_entry; if (lane == 63) stamps[63] = (unsigned long long)wall_clock64(); }
#undef PG8_STAMP
#undef PG8_SA
#undef PG8_SB
#undef PG8_STAGE
#undef PG8_STAGE_A
#undef PG8_TOKSLOT
#undef PG8_LDA
#undef PG8_LDB
#undef PG8_MMA
#undef PG8_WAIT_V
#undef PG8_WAIT_L
#undef PG8_BAR
#undef PG8_SCHED
}
}
namespace pg8 {
struct EpiRes {
    static constexpr bool PERM = true, AFTER_DRAIN = false;
    const void* base_lat; const float* base_ctx; void* out_lat; float* out_ctx; const float* gvec; bool base_bf, out_bf;
    __device__ __forceinline__ void operator()(const f32x4 (&acc)[2][2][4][2], const Unit& u, int wr, int wc, int fr, int fq) const {
        const bool isctx = u.pm >= 128;
        const int prow = (isctx ? (u.pm - 128) : u.pm) * BM;
        const float* base = isctx ? base_ctx : (const float*)base_lat; float* out = isctx ? out_ctx : (float*)out_lat;
        const bool bbf = !isctx && base_bf, obf = !isctx && out_bf;
        const float* gv = gvec + (size_t)(isctx ? 8 : (u.pm >> 4)) * 6144;
        const int row0 = prow + wr * 64 + fr, hf = u.pn >> 8, col0 = (u.pn & 255) * BM + (hf == 2 ? HALF : 0) + wc * 32 + 8 * fq;
        f32x4 gvv[2][2];
#pragma unroll
        for (int bj = 0; bj < 2; ++bj)
#pragma unroll
            for (int n = 0; n < 2; ++n) gvv[bj][n] = *(const f32x4*)(gv + col0 + bj * HALF + 4 * n);
#pragma unroll
        for (int ai = 0; ai < 2; ++ai) {
            if (bbf) {
                v4u ra[4][2];
#pragma unroll
                for (int m = 0; m < 4; ++m)
#pragma unroll
                    for (int bj = 0; bj < 2; ++bj) { if (bj == 1 && hf != 0) continue; ra[m][bj] = *(const v4u*)((const bf16*)base_lat + (size_t)(row0 + ai * HALF + m * 16) * 1024 + col0 + bj * HALF); }
#pragma unroll
                for (int m = 0; m < 4; ++m)
#pragma unroll
                    for (int bj = 0; bj < 2; ++bj) { if (bj == 1 && hf != 0) continue; const size_t o2 = (size_t)(row0 + ai * HALF + m * 16) * 1024 + col0 + bj * HALF;
                        const v4u r = ra[m][bj];
                        const f32x4 b0 = (f32x4){bflo(r.x), bfhi(r.x), bflo(r.y), bfhi(r.y)}, b1 = (f32x4){bflo(r.z), bfhi(r.z), bflo(r.w), bfhi(r.w)};
                        const f32x4 v0 = b0 + gvv[bj][0] * acc[ai][bj][m][0], v1 = b1 + gvv[bj][1] * acc[ai][bj][m][1];
                        if (obf) { v4u w; w.x = pk2(v0.x, v0.y); w.y = pk2(v0.z, v0.w); w.z = pk2(v1.x, v1.y); w.w = pk2(v1.z, v1.w); *(v4u*)((bf16*)out_lat + o2) = w; }
                        else { *(f32x4*)(out + o2) = v0; *(f32x4*)(out + o2 + 4) = v1; } }
            } else {
#pragma unroll
                for (int m = 0; m < 4; ++m)
#pragma unroll
                    for (int bj = 0; bj < 2; ++bj) { if (bj == 1 && hf != 0) continue; const size_t o2 = (size_t)(row0 + ai * HALF + m * 16) * 1024 + col0 + bj * HALF;
                        const f32x4 b0 = *(const f32x4*)(base + o2), b1 = *(const f32x4*)(base + o2 + 4);
                        const f32x4 v0 = b0 + gvv[bj][0] * acc[ai][bj][m][0], v1 = b1 + gvv[bj][1] * acc[ai][bj][m][1];
                        if (obf) { v4u w; w.x = pk2(v0.x, v0.y); w.y = pk2(v0.z, v0.w); w.z = pk2(v1.x, v1.y); w.w = pk2(v1.z, v1.w); *(v4u*)((bf16*)out_lat + o2) = w; }
                        else { *(f32x4*)(out + o2) = v0; *(f32x4*)(out + o2 + 4) = v1; } }
            }
        }
    }
};
struct EpiSwiglu {
    static constexpr bool PERM = true, AFTER_DRAIN = false;
    bf16_t* O; int ldc;
    __device__ __forceinline__ void operator()(const f32x4 (&acc)[2][2][4][2], const Unit& u, int wr, int wc, int fr, int fq) const {
        const int row0 = u.pm * BM + wr * 64 + fr, col0 = u.pn * HALF + wc * 32 + 8 * fq;
#pragma unroll
        for (int ai = 0; ai < 2; ++ai)
#pragma unroll
            for (int m = 0; m < 4; ++m) { bf16_t* rowp = O + (size_t)(row0 + ai * HALF + m * 16) * ldc + col0;
                float h[8];
#pragma unroll
                for (int n = 0; n < 2; ++n)
#pragma unroll
                    for (int j = 0; j < 4; ++j) { const float g = acc[ai][0][m][n][j], up = acc[ai][1][m][n][j]; h[n * 4 + j] = g * __builtin_amdgcn_rcpf(1.0f + __expf(-g)) * up; }
                u32x4 w; w.x = cvt_pk_bf16(h[0], h[1]); w.y = cvt_pk_bf16(h[2], h[3]); w.z = cvt_pk_bf16(h[4], h[5]); w.w = cvt_pk_bf16(h[6], h[7]);
                *(u32x4*)rowp = w; }
    }
};
struct MoeOrder {
    static constexpr bool GATHER = false, HALFS = false;
    int nN, G, c, nunits; const int* tab;
    __device__ void init(const int* tab_, int nN_, int G_, int c_) { tab = tab_; nN = nN_; G = G_; c = c_; nunits = tab_[0] * nN_; }
    __device__ bool next(int i, Unit& u) const {
        const int L = i * G + c; if (L >= nunits) return false;
        const int q = nunits / NXCD, r = nunits % NXCD, xcd = L % NXCD, off = L / NXCD;
        const int w = (xcd < r ? xcd * (q + 1) : r * (q + 1) + (xcd - r) * q) + off;
        u.pm = w / nN; u.pn = w - u.pm * nN; u.e = tab[1 + u.pm]; return true;
    }
    __device__ __forceinline__ void a_ready(const Unit&) const {}
    __device__ __forceinline__ void done(const Unit&) const {}
};
struct MoeOrderG : MoeOrder { static constexpr bool GATHER = true; const int* tok; };
}
enum { I_X = 0, I_C, I_CTX, I_CCTX, I_MODW, I_MODB, I_NMIXG, I_NFFNG, I_WIN, I_WOUT, I_LCW, I_LCB, I_LWA, I_LBA, I_LWX, I_LBX, I_LLAM,
       I_RMU, I_RWUP, I_RW0, I_RAUP, I_RA0, I_RGUP, I_RKK, I_RKA, I_RRK, I_RLNG, I_RLNB, I_MIB, I_MFB, I_MNG, I_GCW, I_GALOG, I_GDTB, I_GNG,
       I_FWG, I_FWU, I_FWD, I_MROUTER, I_MWG, I_MWU, I_MWD, I_FNG, N_IN };
struct Args { const float* in[N_IN]; float* out; unsigned char* ws; int ph_lo, ph_hi; };
struct Ctx {
    const float* const* in; float* out; unsigned char* ws; LAS unsigned char* lds;
    int tid, lane, wave, G, wg;
};
#define WSP(T, off) ((T*)(C.ws + (off)))

__device__ __forceinline__ int seqrow_raster(int i, int d, int b) {
    if (i < CTXL) { const int p = d ? (CTXL - 1 - i) : i; return T_LAT + b * CTXL + p; }
    const int j = i - CTXL; const int p = d ? (SEQ - 1 - j) : j; return b * SEQ + p;
}
__device__ __forceinline__ int seqrow_cm(int i, int d, int b) {
    if (i < CTXL) { const int p = d ? (CTXL - 1 - i) : i; return T_LAT + b * CTXL + p; }
    const int j = i - CTXL; const int p = d ? (SEQ - 1 - j) : j; return b * SEQ + (p & 63) * 64 + (p >> 6);
}

__device__ __forceinline__ void phase_pre(const Ctx& C) {
    LAS float* sc = (LAS float*)C.lds;
    LAS float* red = sc + 9 * 1024;
    float* modv = WSP(float, WS_MODV);
    bool filled = false;
    for (int it = C.wg; it < DEPTH * 48; it += C.G) {
        if (!filled) {
            for (int i = C.tid; i < 9 * 1024; i += NTHR) { const float v = i < 8192 ? C.in[I_C][i] : C.in[I_CCTX][i - 8192]; sc[i] = siluf_(v); }
            filled = true; __syncthreads();
        }
        const int l = it / 48, jb = it % 48, col = C.tid & 127, kg = C.tid >> 7;
        const float* W = C.in[I_MODW] + (size_t)l * 1024 * 6144 + jb * 128 + col;
        float acc[9];
#pragma unroll
        for (int r = 0; r < 9; ++r) acc[r] = 0.f;
        for (int k = kg * 256; k < kg * 256 + 256; ++k) { const float w = W[(size_t)k * 6144];
#pragma unroll
            for (int r = 0; r < 9; ++r) acc[r] += sc[r * 1024 + k] * w; }
#pragma unroll
        for (int r = 0; r < 9; ++r) red[(kg * 9 + r) * 128 + col] = acc[r];
        __syncthreads();
        for (int i = C.tid; i < 9 * 128; i += NTHR) { const int r = i >> 7, cc = i & 127;
            const float s = red[(0 * 9 + r) * 128 + cc] + red[(1 * 9 + r) * 128 + cc] + red[(2 * 9 + r) * 128 + cc] + red[(3 * 9 + r) * 128 + cc];
            modv[((size_t)l * 9 + r) * 6144 + jb * 128 + cc] = s + C.in[I_MODB][l * 6144 + jb * 128 + cc]; }
        __syncthreads();
    }
}

__device__ __forceinline__ void tr_item(const float* src, size_t ld, int k0, int ns0, bf16* dst, int drow0, int Kd, LAS float* scr, int lane, bool zero) {
    if (!zero) {
#pragma unroll 8
        for (int i = 0; i < 32; ++i) { const int kk = 2 * i + (lane >> 5); scr[kk * 33 + (lane & 31)] = src[(size_t)(k0 + kk) * ld + ns0 + (lane & 31)]; }
    }
    LDS_WAIT(); asm volatile("" ::: "memory");
    const int c = lane & 7;
#pragma unroll
    for (int j = 0; j < 4; ++j) { const int n = (lane >> 3) + 8 * j; const LAS float* s = scr + (8 * c) * 33 + n;
        v4u o; o.x = pk2(s[0 * 33], s[1 * 33]); o.y = pk2(s[2 * 33], s[3 * 33]); o.z = pk2(s[4 * 33], s[5 * 33]); o.w = pk2(s[6 * 33], s[7 * 33]);
        if (zero) o = (v4u){0u, 0u, 0u, 0u};
        *(v4u*)(dst + (size_t)(drow0 + n) * Kd + k0 + 8 * c) = o; }
    LDS_WAIT(); asm volatile("" ::: "memory");
}
__device__ __forceinline__ void convert_small(const Ctx& C, int l) {
    {
        bf16* lw = WSP(bf16, WS_LRUWT);
        for (int k = 0; k < 2 * 2 * 4 * 4096 / (128 * NTHR); ++k) {
            const int e = k * 128 * NTHR + C.wg * NTHR + C.tid;
            if (C.wg < 128) {
            const int i = e & 63, j = (e >> 6) & 63, hd = (e >> 12) & 3, g = (e >> 14) & 1, d = e >> 15;
            const float* src = (g ? C.in[I_LWX] : C.in[I_LWA]) + ((size_t)((l * 2 + d) * 4 + hd) * 64 + i) * 64 + j;
            lw[e] = (bf16)f2bf(*src);
            }
        }
    }
    if (C.wg >= 128 && C.wg < 224) {
        bf16* rw = WSP(bf16, WS_RWT);
        const int e = (C.wg - 128) * NTHR + C.tid;
        if (e < 32768) { const int r = e & 31, ch = (e >> 5) & 255, d = (e >> 13) & 1, isa = e >> 14;
            rw[e] = (bf16)f2bf((isa ? C.in[I_RAUP] : C.in[I_RWUP])[((size_t)(l * 2 + d) * 32 + r) * GW + ch]); }
        else { const int e2 = e - 32768, j = e2 & 63, ch = e2 >> 6; rw[e] = (bf16)f2bf(C.in[I_RGUP][((size_t)l * 64 + j) * GW + ch]); }
    }
}
__device__ __forceinline__ void convert_items(const Ctx& C, int l, int what, int gw, int NGW) {
    LAS float* scr = (LAS float*)(C.lds + C.wave * 8704);
    constexpr int I_IN = 16 * 112, I_OUT = 16 * 32, I_GU = 16 * 176, I_DN = 44 * 32, I_E = 16 * 88 + 22 * 32;
    const bool moe = l & 1; const int li = l >> 1;
    const int lo_it = (what & 1) ? 0 : I_IN, hi_it = (what & 2) ? I_IN + I_OUT + (moe ? NE * I_E : (I_GU + I_DN)) : I_IN;
    bf16* win = WSP(bf16, WS_WIN); bf16* wout = WSP(bf16, WS_WOUT); bf16* wgu = WSP(bf16, WS_WGU); bf16* wdn = WSP(bf16, WS_WDN);
    for (int it = lo_it + gw; it < hi_it; it += NGW) {
        int r = it;
        if (r < I_IN) { const int kb = r / 112, nb = r % 112; tr_item(C.in[I_WIN] + (size_t)l * 1024 * IN_COLS, IN_COLS, 64 * kb, 32 * nb, win, 32 * nb, 1024, scr, C.lane, nb == 111); continue; }
        r -= I_IN;
        if (r < I_OUT) { const int kb = r / 32, nb = r % 32; tr_item(C.in[I_WOUT] + (size_t)l * 1024 * 1024, 1024, 64 * kb, 32 * nb, wout, 32 * nb, 1024, scr, C.lane, false); continue; }
        r -= I_OUT;
        if (!moe) {
            if (r < I_GU) { const int kb = r / 176, nb = r % 176, tile = nb >> 3, q = nb & 7;
                const float* src = (q < 4 ? C.in[I_FWG] : C.in[I_FWU]) + (size_t)li * 1024 * DFF;
                tr_item(src, DFF, 64 * kb, tile * 128 + (q & 3) * 32, wgu, 32 * nb, 1024, scr, C.lane, false); continue; }
            r -= I_GU;
            { const int kb = r / 32, nb = r % 32; tr_item(C.in[I_FWD] + (size_t)li * DFF * 1024, 1024, 64 * kb, 32 * nb, wdn, 32 * nb, DFF, scr, C.lane, false); }
        } else {
            const int e = r / I_E; int rr = r % I_E;
            if (rr < 16 * 88) { const int kb = rr / 88, nb = rr % 88, tile = nb >> 3, q = nb & 7;
                const float* src = (q < 4 ? C.in[I_MWG] : C.in[I_MWU]) + ((size_t)li * NE + e) * 1024 * DFE;
                tr_item(src, DFE, 64 * kb, tile * 128 + (q & 3) * 32, wgu + (size_t)e * 2 * DFE * 1024, 32 * nb, 1024, scr, C.lane, false); continue; }
            rr -= 16 * 88;
            { const int kb = rr / 32, nb = rr % 32; tr_item(C.in[I_MWD] + ((size_t)li * NE + e) * DFE * 1024, 1024, 64 * kb, 32 * nb, wdn + (size_t)e * 1024 * DFE, 32 * nb, DFE, scr, C.lane, false); }
        }
    }
}

template <bool ROUTE>
__device__ __forceinline__ void norm_rows(const Ctx& C, int l, const void* xlat, bool xbf, const float* xctx, const float* gain, int shoff, int scoff, int nrows, int moe_li) {
    const float* modv = WSP(float, WS_MODV) + (size_t)l * 9 * 6144;
    bf16* hb = WSP(bf16, WS_HB);
    const int gw = C.wg * NWAVES + C.wave, NGW = C.G * NWAVES;
    LAS unsigned* lcnt = (LAS unsigned*)(C.lds + 65536);
    unsigned* route = WSP(unsigned, WS_ROUTE);
    if (ROUTE) { if (C.tid < 8) lcnt[C.tid] = 0u; __syncthreads(); }
    f32x4 gv[4];
#pragma unroll
    for (int j = 0; j < 4; ++j) gv[j] = *(const f32x4*)(gain + 4 * C.lane + 256 * j);
    v4u rawn[4]; bool rbfn = false;
#define NR_LOAD(mm) do { const int m_ = (mm); const bool ic_ = m_ >= T_LAT; rbfn = xbf && !ic_; \
        if (rbfn) { _Pragma("unroll") for (int j = 0; j < 4; ++j) { const v2u t_ = *(const v2u*)((const bf16*)xlat + (size_t)m_ * 1024 + 4 * C.lane + 256 * j); rawn[j] = (v4u){t_.x, t_.y, 0u, 0u}; } } \
        else { const float* xr_ = ic_ ? xctx + (size_t)(m_ - T_LAT) * 1024 : (const float*)xlat + (size_t)m_ * 1024; _Pragma("unroll") for (int j = 0; j < 4; ++j) rawn[j] = *(const v4u*)(xr_ + 4 * C.lane + 256 * j); } } while (0)
    if (gw < nrows) NR_LOAD(gw);
    for (int m = gw; m < nrows; m += NGW) {
        const bool isctx = m >= T_LAT;
        const float* mv = modv + (size_t)(isctx ? 8 : (m >> 12)) * 6144;
        v4u raw[4]; const bool rbf = rbfn;
#pragma unroll
        for (int j = 0; j < 4; ++j) raw[j] = rawn[j];
        if (m + NGW < nrows) NR_LOAD(m + NGW);
        f32x4 v[4]; float s = 0.f;
#pragma unroll
        for (int j = 0; j < 4; ++j) { v[j] = rbf ? (f32x4){bflo(raw[j].x), bfhi(raw[j].x), bflo(raw[j].y), bfhi(raw[j].y)} : __builtin_bit_cast(f32x4, raw[j]); s += (v[j].x * v[j].x + v[j].y * v[j].y) + (v[j].z * v[j].z + v[j].w * v[j].w); }
        const float rs = rsqrtf_(wave_sum(s) * (1.0f / 1024.0f) + 1e-6f);
#pragma unroll
        for (int j = 0; j < 4; ++j) { const f32x4 sh = *(const f32x4*)(mv + shoff + 4 * C.lane + 256 * j), scl = *(const f32x4*)(mv + scoff + 4 * C.lane + 256 * j);
            v[j] = (v[j] * rs * gv[j]) * (scl + 1.0f) + sh;
            v2u o; o.x = pk2(v[j].x, v[j].y); o.y = pk2(v[j].z, v[j].w);
            *(v2u*)(hb + (size_t)m * 1024 + 4 * C.lane + 256 * j) = o; }
        if (ROUTE) {
            const float* rt = C.in[I_MROUTER] + (size_t)moe_li * 1024 * NE;
            float lg[8];
#pragma unroll
            for (int e = 0; e < 8; ++e) lg[e] = 0.f;
#pragma unroll
            for (int j = 0; j < 4; ++j)
#pragma unroll
                for (int q = 0; q < 4; ++q) { const int k = 4 * C.lane + 256 * j + q; const f32x4 r0 = *(const f32x4*)(rt + (size_t)k * 8), r1 = *(const f32x4*)(rt + (size_t)k * 8 + 4); const float hv = v[j][q];
                    lg[0] += hv * r0.x; lg[1] += hv * r0.y; lg[2] += hv * r0.z; lg[3] += hv * r0.w; lg[4] += hv * r1.x; lg[5] += hv * r1.y; lg[6] += hv * r1.z; lg[7] += hv * r1.w; }
#pragma unroll
            for (int e = 0; e < 8; ++e) lg[e] = wave_sum(lg[e]);
            int e0 = 0; float l0 = lg[0];
#pragma unroll
            for (int e = 1; e < 8; ++e) if (lg[e] > l0) { l0 = lg[e]; e0 = e; }
            int e1 = (e0 == 0) ? 1 : 0; float l1 = -3.0e38f;
#pragma unroll
            for (int e = 0; e < 8; ++e) if (e != e0 && lg[e] > l1) { l1 = lg[e]; e1 = e; }
            const float w0 = __builtin_amdgcn_rcpf(1.0f + __expf(l1 - l0)), w1 = 1.0f - w0;
            if (C.lane == 0) {
                const unsigned r0 = atomicAdd((unsigned*)&lcnt[e0], 1u), r1 = atomicAdd((unsigned*)&lcnt[e1], 1u);
                v4u a; a.x = (unsigned)e0; a.y = (unsigned)e1; a.z = r0; a.w = r1;
                *(v4u*)(route + (size_t)m * 8) = a;
                v2u b; b.x = __builtin_bit_cast(unsigned, w0); b.y = __builtin_bit_cast(unsigned, w1);
                *(v2u*)(route + (size_t)m * 8 + 4) = b;
            }
        }
    }
#undef NR_LOAD
    if (ROUTE) {
        __syncthreads();
        if (C.tid < 8) { unsigned* gc = WSP(unsigned, WS_CTL) + CW_MOECNT + 64 * moe_li; const unsigned base = atomicAdd(gc + C.tid, lcnt[C.tid]); WSP(unsigned, WS_WGBASE)[C.wg * 8 + C.tid] = base; }
    }
}
#define RAW_BARRIER() do { asm volatile("s_waitcnt lgkmcnt(0)" ::: "memory"); __builtin_amdgcn_s_barrier(); asm volatile("" ::: "memory"); } while (0)
__device__ __forceinline__ void gdn_prep(const Ctx& C, int l, int b, int c) {
    const bf16* P = WSP(const bf16, WS_P); bf16* gq = WSP(bf16, WS_GQ);
    const bool isctx = c < 4; const int p0 = isctx ? c * 64 : (c - 4) * 64; const int Lp = isctx ? CTXL : SEQ;
    const int ch = 4 * C.lane;
    auto rowof = [&](int p) -> int { return isctx ? (T_LAT + b * CTXL + p) : (b * SEQ + (p & 63) * 64 + (p >> 6)); };
    f32x4 cw[4][3], x[4][3];
#pragma unroll
    for (int j = 0; j < 4; ++j)
#pragma unroll
        for (int g = 0; g < 3; ++g) cw[j][g] = *(const f32x4*)(C.in[I_GCW] + ((size_t)l * 4 + j) * 768 + g * 256 + ch);
    const int tb = p0 + C.wave * 8;
    auto ldrow = [&](int p, f32x4 (&dst)[3]) {
        if (p >= 0 && p < Lp) { const bf16* pr = P + (size_t)rowof(p) * PLD + OFF_D + ch;
#pragma unroll
            for (int g = 0; g < 3; ++g) dst[g] = ld4bf(pr + g * 256); }
        else {
#pragma unroll
            for (int g = 0; g < 3; ++g) dst[g] = (f32x4){0.f, 0.f, 0.f, 0.f}; }
    };
    ldrow(tb - 2, x[0]); ldrow(tb - 1, x[1]); ldrow(tb, x[2]);
#pragma unroll
    for (int t = 0; t < 8; ++t) {
        ldrow(tb + t + 1, x[3]);
        bf16* orow = gq + (size_t)rowof(tb + t) * 768 + ch;
#pragma unroll
        for (int g = 0; g < 3; ++g) {
            f32x4 v = cw[0][g] * x[0][g] + cw[1][g] * x[1][g] + cw[2][g] * x[2][g] + cw[3][g] * x[3][g];
            v = (f32x4){siluf_(v.x), siluf_(v.y), siluf_(v.z), siluf_(v.w)};
            if (g < 2) { const float ss = row16_sum((v.x * v.x + v.y * v.y) + (v.z * v.z + v.w * v.w)); v = v * (rsqrtf_(ss + 1e-6f) * (g == 0 ? 0.125f : 1.0f)); }
            st4bf(orow + g * 256, v);
        }
#pragma unroll
        for (int g = 0; g < 3; ++g) { x[0][g] = x[1][g]; x[1][g] = x[2][g]; x[2][g] = x[3][g]; }
    }
}
__device__ __forceinline__ void finish_rows(const Ctx& C, int l, int nrows) {
    const bf16* P = WSP(const bf16, WS_P); bf16* yc = WSP(bf16, WS_HB);
    const bf16* ob = WSP(const bf16, WS_OUTB); const bf16* oc = WSP(const bf16, WS_OUTC); const bf16* od = WSP(const bf16, WS_OUTD);
    const bf16* gg = WSP(const bf16, WS_G); const float* bonus = WSP(const float, WS_BONUS);
    const float* mu = C.in[I_RMU] + (size_t)l * 2 * B_COLS;
    const int gw = C.wg * NWAVES + C.wave, NGW = C.G * NWAVES, lane = C.lane, ch = 4 * lane, hh = lane >> 4;
    const f32x4 lng = *(const f32x4*)(C.in[I_RLNG] + l * GW + ch), lnb = *(const f32x4*)(C.in[I_RLNB] + l * GW + ch);
    const f32x4 mng = *(const f32x4*)(C.in[I_MNG] + l * GW + ch), gng = *(const f32x4*)(C.in[I_GNG] + l * GW + ch);
    const f32x4 mu0 = *(const f32x4*)(mu + 512 + ch), mu1 = *(const f32x4*)(mu + B_COLS + 512 + ch);
    const size_t o2 = (size_t)T_ALL * 256;
#pragma unroll 2
    for (int m = gw; m < nrows; m += NGW) {
        const bool isctx = m >= T_LAT; const int Lp = isctx ? CTXL : SEQ; const int p = isctx ? ((m - T_LAT) & (CTXL - 1)) : (m & (SEQ - 1));
        const f32x4 yb = ld4bf(ob + (size_t)m * 256 + ch) + ld4bf(ob + o2 + (size_t)m * 256 + ch);
        const f32x4 ycv = ld4bf(oc + (size_t)m * 256 + ch) + ld4bf(oc + o2 + (size_t)m * 256 + ch);
        const f32x4 yd = ld4bf(od + (size_t)m * 256 + ch) + ld4bf(od + o2 + (size_t)m * 256 + ch);
        const bf16* pr = P + (size_t)m * PLD;
        const f32x4 vs = ld4bf(WSP(const bf16, WS_RKV) + (size_t)m * 768 + 512 + ch);
        const f32x4 og = ld4bf(pr + OFF_C + 768 + ch), gd = ld4bf(pr + OFF_D + 768 + ch), gr = ld4bf(gg + (size_t)m * 256 + ch);
        const float bn = bonus[(size_t)m * 4 + hh];
        *(v2u*)(yc + (size_t)m * 1024 + ch) = *(const v2u*)(pr + 256 + ch);
        {
            const float mean = row16_sum((yb.x + yb.y) + (yb.z + yb.w)) * (1.0f / 64.0f);
            const f32x4 dl = yb - mean;
            const float var = row16_sum((dl.x * dl.x + dl.y * dl.y) + (dl.z * dl.z + dl.w * dl.w)) * (1.0f / 64.0f);
            const f32x4 yn = dl * rsqrtf_(var + 64e-5f) * lng + lnb;
            st4bf(yc + (size_t)m * 1024 + 256 + ch, (yn + vs * bn) * gr);
        }
        {
            const float ms = row16_sum((ycv.x * ycv.x + ycv.y * ycv.y) + (ycv.z * ycv.z + ycv.w * ycv.w)) * (1.0f / 64.0f);
            const f32x4 sg = (f32x4){sigmoidf_(og.x), sigmoidf_(og.y), sigmoidf_(og.z), sigmoidf_(og.w)};
            st4bf(yc + (size_t)m * 1024 + 512 + ch, ycv * rsqrtf_(ms + 1e-6f) * mng * sg);
        }
        {
            const float ms = row16_sum((yd.x * yd.x + yd.y * yd.y) + (yd.z * yd.z + yd.w * yd.w)) * (1.0f / 64.0f);
            const f32x4 sg = (f32x4){siluf_(gd.x), siluf_(gd.y), siluf_(gd.z), siluf_(gd.w)};
            st4bf(yc + (size_t)m * 1024 + 768 + ch, yd * rsqrtf_(ms + 1e-6f) * gng * sg);
        }
    }
}
typedef bf16x8 fragb;
__device__ __forceinline__ f32x4 mfma16(fragb a, fragb b, f32x4 c) { return __builtin_amdgcn_mfma_f32_16x16x32_bf16(a, b, c, 0, 0, 0); }
__device__ __forceinline__ fragb ld_frag16(const LAS bf16* p) { return *(const LAS fragb*)p; }
__device__ __forceinline__ fragb ld_frag8x2(const LAS bf16* p0, const LAS bf16* p1) {
    const v2u a = *(const LAS v2u*)p0, b = *(const LAS v2u*)p1; v4u r; r.x = a.x; r.y = a.y; r.z = b.x; r.w = b.y; return __builtin_bit_cast(fragb, r); }
__device__ __forceinline__ fragb pack_frag(const f32x4& lo, const f32x4& hi) { v4u r; r.x = pk2(lo.x, lo.y); r.y = pk2(lo.z, lo.w); r.z = pk2(hi.x, hi.y); r.w = pk2(hi.z, hi.w); return __builtin_bit_cast(fragb, r); }
__device__ __forceinline__ float wave_incl_sum(float v, int lane) {
    v += dpp_x<0x111, 0xF, true>(0.f, v); v += dpp_x<0x112, 0xF, true>(0.f, v); v += dpp_x<0x114, 0xF, true>(0.f, v); v += dpp_x<0x118, 0xF, true>(0.f, v);
    v += dpp_x<0x142, 0xA, false>(0.f, v); v += dpp_x<0x143, 0xC, false>(0.f, v);
    return v;
}
__device__ __forceinline__ float wave_incl_max(float v, int lane) {
    const float ninf = -3.0e38f;
    v = fmaxf(v, dpp_x<0x111, 0xF, false>(ninf, v)); v = fmaxf(v, dpp_x<0x112, 0xF, false>(ninf, v)); v = fmaxf(v, dpp_x<0x114, 0xF, false>(ninf, v)); v = fmaxf(v, dpp_x<0x118, 0xF, false>(ninf, v));
    v = fmaxf(v, dpp_x<0x142, 0xA, false>(ninf, v)); v = fmaxf(v, dpp_x<0x143, 0xC, false>(ninf, v));
    return v;
}
constexpr int MP = 72;
__device__ __forceinline__ void mlstm_chunked(const Ctx& C, int l, int idx) {
    const int d = idx >> 5, b = (idx >> 2) & 7, h = idx & 3, lane = C.lane, w = C.wave, l15 = lane & 15, q = lane >> 4;
    const int it = w & 3, vtp = w >> 2;
    constexpr int IMG = 64 * MP * 2, BUFB = 4 * IMG + 1024, CTB = 65 * MP * 2 + 16;
    LAS unsigned char* L0 = C.lds;
    const bf16* P = WSP(const bf16, WS_P); bf16* outc = WSP(bf16, WS_OUTC) + (size_t)d * T_ALL * 256;
    const float ib = C.in[I_MIB][(l * 2 + d) * NH + h], fb = C.in[I_MFB][(l * 2 + d) * NH + h];
    const int tt = C.tid >> 3, part = C.tid & 7;
    for (int i = C.tid; i < 2 * CTB / 4; i += NTHR) ((LAS unsigned*)(L0 + 2 * BUFB))[i] = 0u;
    v4u rq, rk, rv; unsigned short rgi, rgf;
    auto gload = [&](int n) {
        const int row = seqrow_cm(n * 64 + tt, d, b);
        const bf16* pp = P + (size_t)row * PLD + OFF_C + h * 64 + 8 * part;
        rq = *(const v4u*)pp; rk = *(const v4u*)(pp + 256); rv = *(const v4u*)(pp + 512);
        const bf16* pg = P + (size_t)seqrow_cm(n * 64 + lane, d, b) * PLD + OFF_C + 1024 + d * 4 + h;
        rgi = pg[0]; rgf = pg[8];
    };
    auto images = [&](int bufi) {
        LAS unsigned char* B0 = L0 + bufi * BUFB;
        LAS bf16* Qs = (LAS bf16*)B0; LAS bf16* Ks = Qs + 64 * MP; LAS bf16* VT = Ks + 64 * MP; LAS bf16* KTw = VT + 64 * MP; LAS float* vec = (LAS float*)(B0 + 4 * IMG);
        const float li = bf2f(rgi) + ib, lf = -softplusf_(-(bf2f(rgf) + fb));
        const float bc = wave_incl_sum(lf, lane), x = li - bc, cm = wave_incl_max(x, lane);
        const float wl = __expf(x - __shfl(cm, 63)) * 0.125f;
        if (w == 0) { vec[lane] = x; vec[64 + lane] = cm; vec[128 + lane] = bc; }
        const float wmine = __shfl(wl, 8 * w + (lane >> 3));
        *(LAS v4u*)(Qs + tt * MP + 8 * part) = rq; *(LAS v4u*)(Ks + tt * MP + 8 * part) = rk;
        const unsigned vv[4] = {rv.x, rv.y, rv.z, rv.w}, kk[4] = {rk.x, rk.y, rk.z, rk.w};
#pragma unroll
        for (int e = 0; e < 4; ++e) {
            VT[(8 * part + 2 * e) * MP + tt] = (bf16)(vv[e] & 0xffffu); VT[(8 * part + 2 * e + 1) * MP + tt] = (bf16)(vv[e] >> 16);
            KTw[(8 * part + 2 * e) * MP + tt] = (bf16)f2bf1(bflo(kk[e]) * wmine); KTw[(8 * part + 2 * e + 1) * MP + tt] = (bf16)f2bf1(bfhi(kk[e]) * wmine);
        }
    };
    f32x4 Cst[2], nst; float m = 0.f;
    Cst[0] = Cst[1] = nst = (f32x4){0.f, 0.f, 0.f, 0.f};
    const fragb ones = __builtin_bit_cast(fragb, (v4u){0x3F803F80u, 0x3F803F80u, 0x3F803F80u, 0x3F803F80u});
    const f32x4 z4 = (f32x4){0.f, 0.f, 0.f, 0.f};
    gload(0); images(0); gload(1);
#pragma unroll 1
    for (int n = 0; n < NCH; ++n) {
        RAW_BARRIER();
        const LAS unsigned char* B0 = L0 + (n & 1) * BUFB;
        const LAS bf16* Qs = (const LAS bf16*)B0; const LAS bf16* Ks = Qs + 64 * MP; const LAS bf16* VT = Ks + 64 * MP; const LAS bf16* KTw = VT + 64 * MP; const LAS float* vec = (const LAS float*)(B0 + 4 * IMG);
        const LAS bf16* CT = (const LAS bf16*)(L0 + 2 * BUFB + (n & 1) * CTB); LAS bf16* CTn = (LAS bf16*)(L0 + 2 * BUFB + ((n + 1) & 1) * CTB);
        fragb Qf[2]; Qf[0] = ld_frag16(Qs + (16 * it + l15) * MP + 8 * q); Qf[1] = ld_frag16(Qs + (16 * it + l15) * MP + 32 + 8 * q);
        const float cmi = vec[64 + 16 * it + l15]; const int icol = 16 * it + l15;
        f32x4 pt[4];
#pragma unroll
        for (int jt = 0; jt < 4; ++jt) {
            pt[jt] = z4;
            if (jt <= it) {
                const fragb k0 = ld_frag16(Ks + (16 * jt + l15) * MP + 8 * q), k1 = ld_frag16(Ks + (16 * jt + l15) * MP + 32 + 8 * q);
                f32x4 st = mfma16(k0, Qf[0], z4); st = mfma16(k1, Qf[1], st);
                const f32x4 xj = *(const LAS f32x4*)(vec + 16 * jt + 4 * q);
#pragma unroll
                for (int r = 0; r < 4; ++r) { const int j = 16 * jt + 4 * q + r; pt[jt][r] = (j <= icol) ? st[r] * __expf(xj[r] - cmi) * 0.125f : 0.f; }
            }
        }
        fragb Pf[2]; Pf[0] = pack_frag(pt[0], pt[1]); Pf[1] = pack_frag(pt[2], pt[3]);
        fragb Vf[2][2];
#pragma unroll
        for (int v2 = 0; v2 < 2; ++v2)
#pragma unroll
            for (int s = 0; s < 2; ++s) { const LAS bf16* vr = VT + (16 * (2 * vtp + v2) + l15) * MP + 32 * s + 4 * q; Vf[v2][s] = ld_frag8x2(vr, vr + 16); }
        f32x4 Aacc[2], R[2], as, dn;
        as = mfma16(Pf[0], ones, z4); if (it >= 2) as = mfma16(Pf[1], ones, as);
        const fragb nf0 = ld_frag16(CT + 64 * MP + 8 * q), nf1 = ld_frag16(CT + 64 * MP + 32 + 8 * q);
        dn = mfma16(Qf[0], nf0, z4); dn = mfma16(Qf[1], nf1, dn);
#pragma unroll
        for (int v2 = 0; v2 < 2; ++v2) {
            Aacc[v2] = mfma16(Pf[0], Vf[v2][0], z4); if (it >= 2) Aacc[v2] = mfma16(Pf[1], Vf[v2][1], Aacc[v2]);
            const LAS bf16* cr = CT + (16 * (2 * vtp + v2) + l15) * MP + 8 * q;
            R[v2] = mfma16(Qf[0], ld_frag16(cr), z4); R[v2] = mfma16(Qf[1], ld_frag16(cr + 32), R[v2]);
        }
        {
            const f32x4 bi = *(const LAS f32x4*)(vec + 128 + 16 * it + 4 * q), cmr = *(const LAS f32x4*)(vec + 64 + 16 * it + 4 * q);
#pragma unroll
            for (int r = 0; r < 4; ++r) {
                const float mi = bi[r] + cmr[r], minter = bi[r] + m, mt = fmaxf(minter, mi), e1 = __expf(mi - mt), e2 = __expf(minter - mt);
                const float den = e1 * as[r] + e2 * dn[r]; const float inv = __builtin_amdgcn_rcpf(fmaxf(fabsf(den), __expf(-mt)));
                const int row = seqrow_cm(n * 64 + 16 * it + 4 * q + r, d, b);
#pragma unroll
                for (int v2 = 0; v2 < 2; ++v2) outc[(size_t)row * 256 + h * 64 + 16 * (2 * vtp + v2) + l15] = (bf16)f2bf1((e1 * Aacc[v2][r] + e2 * R[v2][r]) * inv);
            }
        }
        {
            const LAS bf16* kr = KTw + (16 * it + l15) * MP + 4 * q;
            const fragb kt0 = ld_frag8x2(kr, kr + 16), kt1 = ld_frag8x2(kr + 32, kr + 48);
            const float bL = vec[128 + 63], mloc = bL + vec[64 + 63];
            const float mnew = fmaxf(bL + m, mloc), wp = __expf(bL + m - mnew), wn = __expf(mloc - mnew);
            f32x4 gk = mfma16(kt0, ones, z4); gk = mfma16(kt1, ones, gk);
            nst = nst * wp + gk * wn;
#pragma unroll
            for (int v2 = 0; v2 < 2; ++v2) {
                f32x4 G = mfma16(kt0, Vf[v2][0], z4); G = mfma16(kt1, Vf[v2][1], G);
                Cst[v2] = Cst[v2] * wp + G * wn;
                v2u o; o.x = pk2(Cst[v2].x, Cst[v2].y); o.y = pk2(Cst[v2].z, Cst[v2].w);
                *(LAS v2u*)(CTn + (16 * (2 * vtp + v2) + l15) * MP + 16 * it + 4 * q) = o;
            }
            if (vtp == 0 && l15 == 0) { v2u o; o.x = pk2(nst.x, nst.y); o.y = pk2(nst.z, nst.w); *(LAS v2u*)(CTn + 64 * MP + 16 * it + 4 * q) = o; }
            m = mnew;
        }
        if (n + 1 < NCH) { images((n + 1) & 1); if (n + 2 < NCH) gload(n + 2); }
    }
    __syncthreads();
}
__device__ __forceinline__ int fwd_row_cm(int b, int c, int t) { return c < 4 ? (T_LAT + b * CTXL + c * 64 + t) : (b * SEQ + t * 64 + (c - 4)); }
__device__ __forceinline__ bf16* blob_row(const Ctx& C, int d, int isw, int b, int c, int h, int r) {
    const int row = fwd_row_cm(b, c, r);
    if (d == 1 && isw) return WSP(bf16, WS_OUTD) + ((size_t)T_ALL + row) * 256 + h * 64;
    return WSP(bf16, WS_P) + (size_t)row * PLD + OFF_D + (d * 2 + isw) * 256 + h * 64;
}
constexpr int LP = 68;
__device__ __forceinline__ void blocked_solve(const LAS bf16* Ln, const LAS bf16* TinvP, LAS unsigned char* XTw, f32x4 (&acc)[4][4], int l15, int q) {
    const f32x4 z4 = (f32x4){0.f, 0.f, 0.f, 0.f};
#pragma unroll
    for (int I = 0; I < 4; ++I) {
        const fragb Af = *(const LAS fragb*)(TinvP + (I * 16 + l15) * 32 + 8 * q);
        fragb A0, A1;
        if (I >= 1) A0 = ld_frag16(Ln + (16 * I + l15) * MP + 8 * q);
        if (I == 3) A1 = ld_frag16(Ln + (16 * I + l15) * MP + 32 + 8 * q);
#pragma unroll
        for (int nt = 0; nt < 4; ++nt) {
            const int crow = 16 * nt + l15; LAS unsigned char* xr = XTw + crow * 128;
            f32x4 a = acc[I][nt];
            if (I >= 1) a = mfma16(A0, *(const LAS fragb*)(xr + ((q ^ (crow & 7)) << 4)), a);
            if (I == 3) a = mfma16(A1, *(const LAS fragb*)(xr + (((4 + q) ^ (crow & 7)) << 4)), a);
            v4u bw; bw.x = pk2(a.x, a.y); bw.y = pk2(a.z, a.w); bw.z = 0u; bw.w = 0u;
            const f32x4 x = mfma16(Af, __builtin_bit_cast(fragb, bw), z4);
            acc[I][nt] = x;
            v2u o; o.x = pk2(x.x, x.y); o.y = pk2(x.z, x.w);
            *(LAS v2u*)(xr + (((2 * I + (q >> 1)) ^ (crow & 7)) << 4) + (q & 1) * 8) = o;
        }
    }
}
__device__ __forceinline__ void diag_inverses(const LAS bf16* Ln, LAS bf16* TinvP, int lane) {
    const int blk = lane >> 4, c = lane & 15;
    float x[16];
#pragma unroll
    for (int i = 0; i < 16; ++i) {
        const LAS bf16* lr = Ln + (16 * blk + i) * MP + 16 * blk;
        const v4u r0 = *(const LAS v4u*)lr, r1 = *(const LAS v4u*)(lr + 8);
        const unsigned rw[8] = {r0.x, r0.y, r0.z, r0.w, r1.x, r1.y, r1.z, r1.w};
        float s = (i == c) ? 1.0f : 0.0f;
#pragma unroll
        for (int j = 0; j < i; ++j) s += ((j & 1) ? bfhi(rw[j >> 1]) : bflo(rw[j >> 1])) * x[j];
        x[i] = s;
        TinvP[(blk * 16 + i) * 32 + 8 * (c >> 2) + (c & 3)] = (bf16)f2bf1(s);
    }
}
__device__ __forceinline__ void gdn_solve_item(const Ctx& C, int l, int item) {
    const int lane = C.lane, w = C.wave, pw = w & 1, pi = w >> 1, l15 = lane & 15, q = lane >> 4;
    LAS unsigned char* B0 = C.lds + pi * 31744;
    LAS bf16* Ln = (LAS bf16*)B0;
    LAS bf16* TinvP = (LAS bf16*)(B0 + 9216);
    LAS float* vec = (LAS float*)(B0 + 13312);
    LAS unsigned char* XT = B0 + 13824;
    LAS bf16* Ks = (LAS bf16*)XT;
    const bf16* P = WSP(const bf16, WS_P); const bf16* gq = WSP(const bf16, WS_GQ);
    const int u = item >> 1, d = item & 1;
    const int c = u % NCH, h = (u / NCH) & 3, b = u / (NCH * NH);
    const int n = d ? (c < 4 ? 3 - c : 71 - c) : c;
    const float aexp = __expf(C.in[I_GALOG][(l * 2 + d) * NH + h]), dtb = C.in[I_GDTB][(l * 2 + d) * NH + h];
    const int rowl = seqrow_cm(n * 64 + lane, d, b);
    const bf16* pg = P + (size_t)rowl * PLD + OFF_D + 1024 + d * 4 + h;
    const float la = -aexp * softplusf_(bf2f(pg[0]) + dtb), beta = sigmoidf_(bf2f(pg[8]));
    const float gam = wave_incl_sum(la, lane);
    if (pw == 0) { vec[lane] = beta; vec[64 + lane] = gam; }
#pragma unroll
    for (int r = 0; r < 4; ++r) { const int idx = pw * 64 + lane + 128 * r, t = idx >> 3, part = idx & 7;
        *(LAS v4u*)(Ks + t * MP + 8 * part) = *(const v4u*)(gq + (size_t)seqrow_cm(n * 64 + t, d, b) * 768 + 256 + h * 64 + 8 * part); }
    { LAS v4u* tz = (LAS v4u*)(B0 + 9216) + (pw * 64 + lane) * 2; tz[0] = (v4u){0u, 0u, 0u, 0u}; tz[1] = (v4u){0u, 0u, 0u, 0u}; }
    f32x4 acc[4][4];
    if (pw == 0) {
#pragma unroll
        for (int I = 0; I < 4; ++I)
#pragma unroll
            for (int r = 0; r < 4; ++r) { const bf16* vr = gq + (size_t)seqrow_cm(n * 64 + 16 * I + 4 * q + r, d, b) * 768 + 512 + h * 64 + l15;
#pragma unroll
                for (int nt = 0; nt < 4; ++nt) acc[I][nt][r] = bf2f(vr[16 * nt]); }
    }
    __syncthreads();
    {
        int tix = 0;
#pragma unroll
        for (int it = 0; it < 4; ++it)
#pragma unroll
            for (int jt = 0; jt < 4; ++jt, ++tix) if ((tix & 1) == pw) {
                f32x4 t4 = (f32x4){0.f, 0.f, 0.f, 0.f};
                if (jt <= it) {
#pragma unroll
                    for (int s = 0; s < 2; ++s) t4 = mfma16(ld_frag16(Ks + (16 * it + l15) * MP + 32 * s + 8 * q), ld_frag16(Ks + (16 * jt + l15) * MP + 32 * s + 8 * q), t4);
                    const float gj = vec[64 + 16 * jt + l15];
                    const f32x4 bi = *(const LAS f32x4*)(vec + 16 * it + 4 * q), gi = *(const LAS f32x4*)(vec + 64 + 16 * it + 4 * q);
#pragma unroll
                    for (int r = 0; r < 4; ++r) { const int i = 16 * it + 4 * q + r, j = 16 * jt + l15; t4[r] = (j < i) ? -(bi[r] * t4[r] * __expf(gi[r] - gj)) : 0.f; }
                }
#pragma unroll
                for (int r = 0; r < 4; ++r) Ln[(16 * it + 4 * q + r) * MP + 16 * jt + l15] = (bf16)f2bf1(t4[r]);
            }
    }
    {
#pragma unroll
        for (int I = 0; I < 4; ++I) {
            const f32x4 bi = *(const LAS f32x4*)(vec + 16 * I + 4 * q), gi = *(const LAS f32x4*)(vec + 64 + 16 * I + 4 * q);
#pragma unroll
            for (int r = 0; r < 4; ++r) { const float sc = pw ? bi[r] * __expf(gi[r]) : bi[r];
#pragma unroll
                for (int nt = 0; nt < 4; ++nt) acc[I][nt][r] = (pw ? bf2f(Ks[(16 * I + 4 * q + r) * MP + 16 * nt + l15]) : acc[I][nt][r]) * sc; }
        }
    }
    __syncthreads();
    if (pw == 0) diag_inverses(Ln, TinvP, lane);
    LAS unsigned char* XTw = XT + pw * 8192;
    { LAS v4u* xz = (LAS v4u*)(XTw + lane * 128);
#pragma unroll
        for (int g = 0; g < 8; ++g) xz[g] = (v4u){0u, 0u, 0u, 0u}; }
    __syncthreads();
    blocked_solve(Ln, TinvP, XTw, acc, l15, q);
    {
        bf16* dst = blob_row(C, d, pw, b, c, h, lane);
        const LAS unsigned char* xr = XTw + lane * 128;
#pragma unroll
        for (int g = 0; g < 8; ++g) *(v4u*)(dst + 8 * g) = *(const LAS v4u*)(xr + ((g ^ (lane & 7)) << 4));
    }
    __syncthreads();
}

template <bool DRY>
__device__ __forceinline__ void gdn_chunked(const Ctx& C, int l, int idx) {
    const int d = idx >> 5, b = (idx >> 2) & 7, h = idx & 3, lane = C.lane, w = C.wave, l15 = lane & 15, q = lane >> 4;
    const int it = w & 3, vtp = w >> 2;
    constexpr int IMG = 64 * MP * 2, BUFB = 5 * IMG + 512;
    LAS unsigned char* L0 = C.lds;
    LAS bf16* VnT = (LAS bf16*)(L0 + 2 * BUFB + 2 * IMG);
    const bf16* P = WSP(const bf16, WS_P); const bf16* gq = WSP(const bf16, WS_GQ); bf16* outd = WSP(bf16, WS_OUTD) + (size_t)d * T_ALL * 256;
    const float aexp = __expf(C.in[I_GALOG][(l * 2 + d) * NH + h]), dtb = C.in[I_GDTB][(l * 2 + d) * NH + h];
    const int tt = C.tid >> 3, part = C.tid & 7;
    for (int i = C.tid; i < 2 * IMG / 4; i += NTHR) ((LAS unsigned*)(L0 + 2 * BUFB))[i] = 0u;
    v4u rq, rk, ru, rw; unsigned short rga;
    auto gload = [&](int n) {
        const int c = d ? (n < 4 ? 3 - n : 71 - n) : n;
        const bf16* pp = gq + (size_t)seqrow_cm(n * 64 + tt, d, b) * 768 + h * 64 + 8 * part;
        rq = *(const v4u*)pp; rk = *(const v4u*)(pp + 256);
        ru = *(const v4u*)(blob_row(C, d, 0, b, c, h, tt) + 8 * part); rw = *(const v4u*)(blob_row(C, d, 1, b, c, h, tt) + 8 * part);
        rga = P[(size_t)seqrow_cm(n * 64 + lane, d, b) * PLD + OFF_D + 1024 + d * 4 + h];
    };
    auto images = [&](int bufi) {
        LAS unsigned char* B0 = L0 + bufi * BUFB;
        LAS bf16* Qs = (LAS bf16*)B0; LAS bf16* Ks = Qs + 64 * MP; LAS bf16* KdT = Ks + 64 * MP; LAS bf16* Wi = KdT + 64 * MP; LAS bf16* UT = Wi + 64 * MP; LAS float* vec = (LAS float*)(B0 + 5 * IMG);
        const float la = -aexp * softplusf_(bf2f(rga) + dtb);
        const float gam = wave_incl_sum(la, lane);
        if (w == 0) vec[lane] = gam;
        const float kd = __expf(__shfl(gam, 63) - gam);
        const float kmine = __shfl(kd, 8 * w + (lane >> 3));
        *(LAS v4u*)(Qs + tt * MP + 8 * part) = rq; *(LAS v4u*)(Ks + tt * MP + 8 * part) = rk; *(LAS v4u*)(UT + tt * MP + 8 * part) = ru;
        const unsigned kk[4] = {rk.x, rk.y, rk.z, rk.w}, ww[4] = {rw.x, rw.y, rw.z, rw.w};
#pragma unroll
        for (int e = 0; e < 4; ++e) {
            KdT[(8 * part + 2 * e) * MP + tt] = (bf16)f2bf1(bflo(kk[e]) * kmine); KdT[(8 * part + 2 * e + 1) * MP + tt] = (bf16)f2bf1(bfhi(kk[e]) * kmine);
            Wi[(8 * part + 2 * e) * MP + tt] = (bf16)(ww[e] & 0xffffu); Wi[(8 * part + 2 * e + 1) * MP + tt] = (bf16)(ww[e] >> 16);
        }
    };
    f32x4 Sst[2]; Sst[0] = Sst[1] = (f32x4){0.f, 0.f, 0.f, 0.f};
    const f32x4 z4 = (f32x4){0.f, 0.f, 0.f, 0.f};
    gload(0); images(0); gload(1);
#pragma unroll 1
    for (int n = 0; n < NCH; ++n) {
        RAW_BARRIER();
        const LAS unsigned char* B0 = L0 + (n & 1) * BUFB;
        const LAS bf16* Qs = (const LAS bf16*)B0; const LAS bf16* Ks = Qs + 64 * MP; const LAS bf16* KdT = Ks + 64 * MP; const LAS bf16* Wi = KdT + 64 * MP; const LAS bf16* UT = Wi + 64 * MP; const LAS float* vec = (const LAS float*)(B0 + 5 * IMG);
        const LAS bf16* ST = (const LAS bf16*)(L0 + 2 * BUFB + (n & 1) * IMG); LAS bf16* STn = (LAS bf16*)(L0 + 2 * BUFB + ((n + 1) & 1) * IMG);
        fragb Qf[2]; Qf[0] = ld_frag16(Qs + (16 * it + l15) * MP + 8 * q); Qf[1] = ld_frag16(Qs + (16 * it + l15) * MP + 32 + 8 * q);
        const float gcol = vec[16 * it + l15]; const int icol = 16 * it + l15;
        f32x4 pt[4];
#pragma unroll
        for (int jt = 0; jt < 4; ++jt) {
            pt[jt] = z4;
            if (jt <= it) {
                const fragb k0 = ld_frag16(Ks + (16 * jt + l15) * MP + 8 * q), k1 = ld_frag16(Ks + (16 * jt + l15) * MP + 32 + 8 * q);
                f32x4 st = mfma16(k0, Qf[0], z4); st = mfma16(k1, Qf[1], st);
                const f32x4 gj = *(const LAS f32x4*)(vec + 16 * jt + 4 * q);
#pragma unroll
                for (int r = 0; r < 4; ++r) { const int j = 16 * jt + 4 * q + r; pt[jt][r] = (j <= icol) ? st[r] * __expf(gcol - gj[r]) : 0.f; }
            }
        }
        fragb Pf[2]; Pf[0] = pack_frag(pt[0], pt[1]); Pf[1] = pack_frag(pt[2], pt[3]);
        const fragb Wf0 = ld_frag16(Wi + (16 * it + l15) * MP + 8 * q), Wf1 = ld_frag16(Wi + (16 * it + l15) * MP + 32 + 8 * q);
        f32x4 Ro[2];
#pragma unroll
        for (int v2 = 0; v2 < 2; ++v2) {
            const int vrow = 16 * (2 * vtp + v2) + l15;
            const fragb s0 = ld_frag16(ST + vrow * MP + 8 * q), s1 = ld_frag16(ST + vrow * MP + 32 + 8 * q);
            f32x4 ws = mfma16(Wf0, s0, z4); ws = mfma16(Wf1, s1, ws);
            Ro[v2] = mfma16(Qf[0], s0, z4); Ro[v2] = mfma16(Qf[1], s1, Ro[v2]);
            const v2u ur = *(const LAS v2u*)(UT + vrow * MP + 16 * it + 4 * q);
            v2u o; o.x = pk2(bflo(ur.x) - ws.x, bfhi(ur.x) - ws.y); o.y = pk2(bflo(ur.y) - ws.z, bfhi(ur.y) - ws.w);
            *(LAS v2u*)(VnT + vrow * MP + 16 * it + 4 * q) = o;
        }
        RAW_BARRIER();
        {
            const f32x4 gi = *(const LAS f32x4*)(vec + 16 * it + 4 * q);
            const float gl = __expf(vec[63]);
            const LAS bf16* kr = KdT + (16 * it + l15) * MP + 4 * q;
            const fragb kt0 = ld_frag8x2(kr, kr + 16), kt1 = ld_frag8x2(kr + 32, kr + 48);
#pragma unroll
            for (int v2 = 0; v2 < 2; ++v2) {
                const int vrow = 16 * (2 * vtp + v2) + l15;
                const LAS bf16* vr = VnT + vrow * MP + 4 * q;
                const fragb n0 = ld_frag8x2(vr, vr + 16), n1 = ld_frag8x2(vr + 32, vr + 48);
                f32x4 o = mfma16(Pf[0], n0, z4); if (it >= 2) o = mfma16(Pf[1], n1, o);
#pragma unroll
                for (int r = 0; r < 4; ++r) { const int row = seqrow_cm(n * 64 + 16 * it + 4 * q + r, d, b);
                    if (!DRY) outd[(size_t)row * 256 + h * 64 + vrow] = (bf16)f2bf1(o[r] + __expf(gi[r]) * Ro[v2][r]); }
                f32x4 ns = mfma16(kt0, n0, z4); ns = mfma16(kt1, n1, ns);
                Sst[v2] = Sst[v2] * gl + ns;
                v2u so; so.x = pk2(Sst[v2].x, Sst[v2].y); so.y = pk2(Sst[v2].z, Sst[v2].w);
                *(LAS v2u*)(STn + vrow * MP + 16 * it + 4 * q) = so;
            }
        }
        if (n + 1 < NCH) { images((n + 1) & 1); if (n + 2 < NCH) gload(n + 2); }
    }
    __syncthreads();
}
constexpr int UP = 264;
template <int CTRL> __device__ __forceinline__ float dpp_keep(float oldv, float v) { return __builtin_bit_cast(float, __builtin_amdgcn_update_dpp(__builtin_bit_cast(int, oldv), __builtin_bit_cast(int, v), CTRL, 0xF, 0xF, false)); }
template <bool REV> __device__ __forceinline__ void scan16(float& A, float& B) {
#define LRU_STEP(S) { const float Ap = dpp_keep<(REV ? 0x100 : 0x110) | S>(1.0f, A), Bp = dpp_keep<(REV ? 0x100 : 0x110) | S>(0.0f, B); B = A * Bp + B; A = A * Ap; }
    LRU_STEP(1) LRU_STEP(2) LRU_STEP(4) LRU_STEP(8)
#undef LRU_STEP
}
constexpr int UPC = 72;
__device__ __forceinline__ int lru_chunk_of(int d, int k) { return d ? (k < 4 ? 3 - k : NCH + 3 - k) : k; }
template <bool REV>
__device__ __forceinline__ void lru_tiles(const LAS bf16* Ud, int th, int mt, int lane, const fragb (&Wa)[2], const fragb (&Wx)[2], const f32x4& ba, const f32x4& bx, const f32x4& sp4,
                                          f32x4 (&Ac)[2], f32x4 (&Hl)[2], f32x4& Atot, f32x4& hend) {
    const int l15 = lane & 15, q = lane >> 4, edge = (lane & 48) | (REV ? 0 : 15);
    const f32x4 z4 = (f32x4){0.f, 0.f, 0.f, 0.f};
    f32x4 tA = z4, tB = z4;
#pragma unroll
    for (int i = 0; i < 2; ++i) {
        const int nt = REV ? 3 - (2 * th + i) : 2 * th + i;
        const LAS bf16* urow = Ud + (16 * nt + l15) * UPC;
        const fragb Uf0 = ld_frag16(urow + 8 * q), Uf1 = ld_frag16(urow + 32 + 8 * q);
        f32x4 aa = mfma16(Wa[0], Uf0, z4); aa = mfma16(Wa[1], Uf1, aa);
        f32x4 ax = mfma16(Wx[0], Uf0, z4); ax = mfma16(Wx[1], Uf1, ax);
        const v2u ur = *(const LAS v2u*)(urow + 16 * mt + 4 * q);
        const f32x4 u4 = (f32x4){bflo(ur.x), bfhi(ur.x), bflo(ur.y), bfhi(ur.y)};
        f32x4 la, iu, A, Bv;
#pragma unroll
        for (int r = 0; r < 4; ++r) { const float rg = sigmoidf_(aa[r] + ba[r]); iu[r] = sigmoidf_(ax[r] + bx[r]) * u4[r]; la[r] = -sp4[r] * rg; }
        const bool sm_ = la[0] > -0.15f && la[1] > -0.15f && la[2] > -0.15f && la[3] > -0.15f;
        if (__builtin_amdgcn_ballot_w64(!sm_) == 0ull) {
#pragma unroll
            for (int r = 0; r < 4; ++r) { const float x = la[r], p = x * (1.0f + x * (0.5f + x * (0.16666667f + x * (0.041666668f + x * (0.0083333338f + x * 0.0013888889f)))));
                A[r] = 1.0f + p; Bv[r] = __builtin_amdgcn_sqrtf(-p * (2.0f + p)) * iu[r]; }
        } else {
#pragma unroll
            for (int r = 0; r < 4; ++r) { A[r] = __expf(la[r]); Bv[r] = __builtin_amdgcn_sqrtf(-expm1f_(2.0f * la[r])) * iu[r]; }
        }
#pragma unroll
        for (int r = 0; r < 4; ++r) { float a_ = A[r], b_ = Bv[r]; scan16<REV>(a_, b_); A[r] = a_; Bv[r] = b_; }
        if (i == 0) {
            Ac[0] = A; Hl[0] = Bv;
#pragma unroll
            for (int r = 0; r < 4; ++r) { tA[r] = __shfl(A[r], edge); tB[r] = __shfl(Bv[r], edge); }
        } else {
            Ac[1] = A * tA; Hl[1] = A * tB + Bv;
#pragma unroll
            for (int r = 0; r < 4; ++r) { Atot[r] = __shfl(Ac[1][r], edge); hend[r] = __shfl(Hl[1][r], edge); }
        }
    }
}
__device__ __forceinline__ void lru_chain(const Ctx& C, int l, int id) {
    const int b = id >> 3, hd = (id >> 1) & 3, chalf = id & 1;
    const int lane = C.lane, l15 = lane & 15, q = lane >> 4;
    const int d = C.wave >> 2, mtl = (C.wave >> 1) & 1, th = C.wave & 1, mt = chalf * 2 + mtl;
    LAS bf16* U = (LAS bf16*)C.lds;
    LAS float* XCH = (LAS float*)(C.lds + 2 * 2 * 64 * UPC * 2);
    bf16* P = WSP(bf16, WS_P); bf16* LH = WSP(bf16, WS_LRUH) + (size_t)id * NSTEP * 32;
    const int cd = C.tid >> 8, cj = C.tid & 63, ctq = (C.tid >> 6) & 3;
    const float* cw = C.in[I_LCW] + (size_t)l * 4 * GW + hd * 64 + cj; const float w0 = cw[0], w1 = cw[GW], w2 = cw[2 * GW], w3 = cw[3 * GW], cb = C.in[I_LCB][l * GW + hd * 64 + cj];
    const bf16* wt = WSP(const bf16, WS_LRUWT) + (size_t)((d * 2 + 0) * 4 + hd) * 4096;
    fragb Wa[2], Wx[2];
#pragma unroll
    for (int ks = 0; ks < 2; ++ks) { Wa[ks] = *(const fragb*)(wt + (16 * mt + l15) * 64 + 32 * ks + 8 * q); Wx[ks] = *(const fragb*)(wt + 4 * 4096 + (16 * mt + l15) * 64 + 32 * ks + 8 * q); }
    const int ch0 = hd * 64 + 16 * mt + 4 * q;
    const f32x4 ba = *(const f32x4*)(C.in[I_LBA] + (l * 2 + d) * GW + ch0), bx = *(const f32x4*)(C.in[I_LBX] + (l * 2 + d) * GW + ch0), lam = *(const f32x4*)(C.in[I_LLAM] + (l * 2 + d) * GW + ch0);
    f32x4 sp4;
#pragma unroll
    for (int r = 0; r < 4; ++r) sp4[r] = 8.0f * softplusf_(-lam[r]);
    f32x4 s = (f32x4){0.f, 0.f, 0.f, 0.f};
    unsigned short xr[19];
#define LRU_LOADX(kk) do { const int c_ = lru_chunk_of(cd, (kk)); const bool ic_ = c_ < 4; const int p0_ = (ic_ ? c_ * 64 : (c_ - 4) * 64) + ctq * 16 - 2, Lp_ = ic_ ? CTXL : SEQ; \
        const bf16* xp_ = P + (size_t)(ic_ ? T_LAT + b * CTXL : b * SEQ) * PLD + hd * 64 + cj; \
        _Pragma("unroll") for (int i_ = 0; i_ < 19; ++i_) { const int p_ = p0_ + i_; xr[i_] = (p_ >= 0 && p_ < Lp_) ? xp_[(size_t)p_ * PLD] : (unsigned short)0; } } while (0)
#define LRU_CONV(kk) do { LAS bf16* uo_ = U + ((((kk) & 1) * 2 + cd) * 64 + ctq * 16) * UPC + cj; \
        _Pragma("unroll") for (int t_ = 0; t_ < 16; ++t_) uo_[t_ * UPC] = (bf16)f2bf1(w0 * bf2f(xr[t_]) + w1 * bf2f(xr[t_ + 1]) + w2 * bf2f(xr[t_ + 2]) + w3 * bf2f(xr[t_ + 3]) + cb); } while (0)
    LRU_LOADX(0); LRU_CONV(0); LRU_LOADX(1);
    __syncthreads();
#pragma unroll 1
    for (int k = 0; k < NCH; ++k) {
        if (k + 1 < NCH) { LRU_CONV(k + 1); if (k + 2 < NCH) LRU_LOADX(k + 2); }
        const int c = lru_chunk_of(d, k); const bool second = lru_chunk_of(1 - d, c) < k;
        const bool ic = c < 4; const size_t row0 = (size_t)(ic ? T_LAT + b * CTXL + c * 64 : b * SEQ + (c - 4) * 64);
        const bool late = (k == 2) || (k == 36);
        int tok[2]; v2u gv[2], fv[2];
#pragma unroll
        for (int i = 0; i < 2; ++i) { const int nt = d ? 3 - (2 * th + i) : 2 * th + i; tok[i] = 16 * nt + l15;
            if (second && !late) { gv[i] = *(const v2u*)(P + (row0 + tok[i]) * PLD + 256 + ch0); fv[i] = *(const v2u*)(LH + (size_t)(c * 64 + tok[i]) * 32 + 16 * mtl + 4 * q); } }
        f32x4 Ac[2], Hl[2], Atot, hend;
        const LAS bf16* Ud = U + ((k & 1) * 2 + d) * 64 * UPC;
        if (d) lru_tiles<true>(Ud, th, mt, lane, Wa, Wx, ba, bx, sp4, Ac, Hl, Atot, hend); else lru_tiles<false>(Ud, th, mt, lane, Wa, Wx, ba, bx, sp4, Ac, Hl, Atot, hend);
        LAS float* xw = XCH + (((((k & 1) * 2 + d) * 2 + mtl) * 2 + th) * 4 + q) * 8;
        if (l15 == (d ? 0 : 15)) { *(LAS f32x4*)xw = Atot; *(LAS f32x4*)(xw + 4) = hend; }
        if (late) VM_WAIT();
        RAW_BARRIER();
        if (second && late) {
#pragma unroll
            for (int i = 0; i < 2; ++i) { gv[i] = *(const v2u*)(P + (row0 + tok[i]) * PLD + 256 + ch0); fv[i] = *(const v2u*)(LH + (size_t)(c * 64 + tok[i]) * 32 + 16 * mtl + 4 * q); }
        }
        const LAS float* xr0 = XCH + (((((k & 1) * 2 + d) * 2 + mtl) * 2 + 0) * 4 + q) * 8;
        const f32x4 A0 = *(const LAS f32x4*)xr0, h0 = *(const LAS f32x4*)(xr0 + 4), A1 = *(const LAS f32x4*)(xr0 + 32), h1 = *(const LAS f32x4*)(xr0 + 36);
        const f32x4 mid = A0 * s + h0, hin = th ? mid : s;
        s = A1 * mid + h1;
#pragma unroll
        for (int i = 0; i < 2; ++i) {
            const f32x4 h = Ac[i] * hin + Hl[i];
            if (!second) { v2u o; o.x = pk2(h.x, h.y); o.y = pk2(h.z, h.w); *(v2u*)(LH + (size_t)(c * 64 + tok[i]) * 32 + 16 * mtl + 4 * q) = o; }
            else {
                const f32x4 g = (f32x4){bflo(gv[i].x), bfhi(gv[i].x), bflo(gv[i].y), bfhi(gv[i].y)};
                f32x4 y = (f32x4){h.x + bflo(fv[i].x), h.y + bfhi(fv[i].x), h.z + bflo(fv[i].y), h.w + bfhi(fv[i].y)};
                y.x *= gelu_tanh(g.x); y.y *= gelu_tanh(g.y); y.z *= gelu_tanh(g.z); y.w *= gelu_tanh(g.w);
                st4bf(P + (row0 + tok[i]) * PLD + 256 + ch0, y);
            }
        }
    }
#undef LRU_LOADX
#undef LRU_CONV
    __syncthreads();
}
constexpr int RP = 264;
__device__ __forceinline__ void rwkv_prep2(const Ctx& C, int l, int b, int c) {
    LAS bf16* RS = (LAS bf16*)C.lds;
    LAS bf16* KS = RS + 64 * RP;
    LAS bf16* XW = KS + 64 * RP;
    LAS bf16* XA = XW + 64 * MP;
    LAS bf16* XG = XA + 64 * MP;
    const bf16* P = WSP(const bf16, WS_P);
    const bool isctx = c < 4; const int p0 = isctx ? c * 64 : (c - 4) * 64; const int Lp = isctx ? CTXL : SEQ; const int row0 = isctx ? T_LAT + b * CTXL : b * SEQ;
    const float* mu = C.in[I_RMU] + (size_t)l * 2 * B_COLS;
    bf16* rkv = WSP(bf16, WS_RKV);
#pragma unroll 5
    for (int it = C.tid; it < 64 * 120; it += NTHR) {
        const int t = it / 120, c8 = (it % 120) * 8, p = p0 + t;
        const bf16* pp = P + (size_t)(row0 + p) * PLD + OFF_B + c8;
        const v4u xc = *(const v4u*)pp; v4u xp = (v4u){0u, 0u, 0u, 0u}, xn = xp;
        if (p > 0) xp = *(const v4u*)(pp - PLD);
        if (p < Lp - 1) xn = *(const v4u*)(pp + PLD);
        const f32x4 m0a = *(const f32x4*)(mu + c8), m0b = *(const f32x4*)(mu + c8 + 4), m1a = *(const f32x4*)(mu + B_COLS + c8), m1b = *(const f32x4*)(mu + B_COLS + c8 + 4);
        const unsigned xcw[4] = {xc.x, xc.y, xc.z, xc.w}, xpw[4] = {xp.x, xp.y, xp.z, xp.w}, xnw[4] = {xn.x, xn.y, xn.z, xn.w};
        float sh[8];
#pragma unroll
        for (int e = 0; e < 4; ++e) {
            const float x0 = bflo(xcw[e]), x1 = bfhi(xcw[e]);
            const float mu0_0 = e < 2 ? m0a[2 * e] : m0b[2 * e - 4], mu0_1 = e < 2 ? m0a[2 * e + 1] : m0b[2 * e - 3], mu1_0 = e < 2 ? m1a[2 * e] : m1b[2 * e - 4], mu1_1 = e < 2 ? m1a[2 * e + 1] : m1b[2 * e - 3];
            sh[2 * e] = x0 + mu0_0 * (bflo(xpw[e]) - x0) + mu1_0 * (bflo(xnw[e]) - x0);
            sh[2 * e + 1] = x1 + mu0_1 * (bfhi(xpw[e]) - x1) + mu1_1 * (bfhi(xnw[e]) - x1);
        }
        if (c8 >= 768) {
            const int ci = c8 - 768;
            if (ci < 64) {
#pragma unroll
                for (int e = 0; e < 8; ++e) sh[e] = tanhf_(sh[e]); }
            else if (ci >= 128) {
#pragma unroll
                for (int e = 0; e < 8; ++e) sh[e] = sigmoidf_(sh[e]); }
        }
        v4u o; o.x = pk2(sh[0], sh[1]); o.y = pk2(sh[2], sh[3]); o.z = pk2(sh[4], sh[5]); o.w = pk2(sh[6], sh[7]);
        if (c8 < 768) {
            *(v4u*)(rkv + (size_t)(row0 + p) * 768 + c8) = o;
            if (c8 < 256) *(LAS v4u*)(RS + t * RP + c8) = o; else if (c8 < 512) *(LAS v4u*)(KS + t * RP + c8 - 256) = o;
        } else {
            const int ci = c8 - 768;
            LAS bf16* dst = ci < 64 ? XW + t * MP + ci : (ci < 128 ? XA + t * MP + ci - 64 : XG + t * MP + ci - 128);
            *(LAS v4u*)dst = o;
        }
    }
    __syncthreads();
    const int lane = C.lane, w = C.wave, l15 = lane & 15, q = lane >> 4, hd = w & 3, ntp = w >> 2;
    const bf16* wt = WSP(const bf16, WS_RWT);
    bf16* wa_out = WSP(bf16, WS_HB); bf16* g_out = WSP(bf16, WS_G); float* bonus = WSP(float, WS_BONUS); float* rinv = WSP(float, WS_RINV);
    const f32x4 z4 = (f32x4){0.f, 0.f, 0.f, 0.f};
    float bsum[2] = {0.f, 0.f}, ksum[2] = {0.f, 0.f};
#pragma unroll
    for (int n2 = 0; n2 < 2; ++n2) {
        const int tok = 16 * (2 * ntp + n2) + l15; const size_t row = (size_t)(row0 + p0 + tok);
        const fragb xw0 = ld_frag16(XW + tok * MP + 8 * q), xw1 = ld_frag16(XW + tok * MP + 32 + 8 * q), xa0 = ld_frag16(XA + tok * MP + 8 * q), xa1 = ld_frag16(XA + tok * MP + 32 + 8 * q);
        const fragb xg0 = ld_frag16(XG + tok * MP + 8 * q), xg1 = ld_frag16(XG + tok * MP + 32 + 8 * q);
        unsigned ow0[8], ow1[8], oa0[8], oa1[8], og[8];
#pragma unroll
        for (int mt = 0; mt < 4; ++mt) {
            const int chl = 16 * (l15 >> 2) + 4 * mt + (l15 & 3), ch4 = hd * 64 + 16 * q + 4 * mt;
            const bf16* wrow = wt + (size_t)(hd * 64 + chl) * 32 + 8 * q;
            const bf16* grow = wt + 4 * 256 * 32 + (size_t)(hd * 64 + chl) * 64 + 8 * q;
            const fragb fw0 = *(const fragb*)(wrow), fw1 = *(const fragb*)(wrow + 256 * 32), fa0 = *(const fragb*)(wrow + 2 * 256 * 32), fa1 = *(const fragb*)(wrow + 3 * 256 * 32), fg0 = *(const fragb*)(grow), fg1 = *(const fragb*)(grow + 32);
            const f32x4 w00 = *(const f32x4*)(C.in[I_RW0] + (l * 2 + 0) * GW + ch4), w01 = *(const f32x4*)(C.in[I_RW0] + (l * 2 + 1) * GW + ch4);
            const f32x4 a00 = *(const f32x4*)(C.in[I_RA0] + (l * 2 + 0) * GW + ch4), a01 = *(const f32x4*)(C.in[I_RA0] + (l * 2 + 1) * GW + ch4);
            const f32x4 k_a = *(const f32x4*)(C.in[I_RKA] + l * GW + ch4), r_k = *(const f32x4*)(C.in[I_RRK] + l * GW + ch4), k_k = *(const f32x4*)(C.in[I_RKK] + l * GW + ch4);
            const f32x4 aw0 = mfma16(fw0, xw0, z4), aw1 = mfma16(fw1, xw1, z4), aa0 = mfma16(fa0, xa0, z4), aa1 = mfma16(fa1, xa1, z4);
            f32x4 ag = mfma16(fg0, xg0, z4); ag = mfma16(fg1, xg1, ag);
            f32x4 wv0, wv1, av0, av1;
#pragma unroll
            for (int r = 0; r < 4; ++r) {
                wv0[r] = __expf(-0.6065306597126334f * sigmoidf_(aw0[r] + w00[r])); wv1[r] = __expf(-0.6065306597126334f * sigmoidf_(aw1[r] + w01[r]));
                av0[r] = sigmoidf_(aa0[r] + a00[r]); av1[r] = sigmoidf_(aa1[r] + a01[r]);
            }
            ow0[2 * mt] = pk2(wv0[0], wv0[1]); ow0[2 * mt + 1] = pk2(wv0[2], wv0[3]); ow1[2 * mt] = pk2(wv1[0], wv1[1]); ow1[2 * mt + 1] = pk2(wv1[2], wv1[3]);
            oa0[2 * mt] = pk2(av0[0], av0[1]); oa0[2 * mt + 1] = pk2(av0[2], av0[3]); oa1[2 * mt] = pk2(av1[0], av1[1]); oa1[2 * mt + 1] = pk2(av1[2], av1[3]);
            og[2 * mt] = pk2(ag[0], ag[1]); og[2 * mt + 1] = pk2(ag[2], ag[3]);
            const v2u rr_ = *(const LAS v2u*)(RS + tok * RP + ch4), kr_ = *(const LAS v2u*)(KS + tok * RP + ch4);
            const f32x4 rs = (f32x4){bflo(rr_.x), bfhi(rr_.x), bflo(rr_.y), bfhi(rr_.y)}, ks = (f32x4){bflo(kr_.x), bfhi(kr_.x), bflo(kr_.y), bfhi(kr_.y)};
#pragma unroll
            for (int r = 0; r < 4; ++r) {
                const float km = ks[r] * (1.0f + (av0[r] - 1.0f) * k_a[r]) + ks[r] * (1.0f + (av1[r] - 1.0f) * k_a[r]);
                bsum[n2] += rs[r] * r_k[r] * km; const float kk = ks[r] * k_k[r]; ksum[n2] += kk * kk;
            }
        }
        bf16* wrow_o = wa_out + row * 1024 + hd * 64 + 16 * q;
        *(v4u*)(wrow_o) = (v4u){ow0[0], ow0[1], ow0[2], ow0[3]}; *(v4u*)(wrow_o + 8) = (v4u){ow0[4], ow0[5], ow0[6], ow0[7]};
        *(v4u*)(wrow_o + 256) = (v4u){ow1[0], ow1[1], ow1[2], ow1[3]}; *(v4u*)(wrow_o + 256 + 8) = (v4u){ow1[4], ow1[5], ow1[6], ow1[7]};
        *(v4u*)(wrow_o + 512) = (v4u){oa0[0], oa0[1], oa0[2], oa0[3]}; *(v4u*)(wrow_o + 512 + 8) = (v4u){oa0[4], oa0[5], oa0[6], oa0[7]};
        *(v4u*)(wrow_o + 768) = (v4u){oa1[0], oa1[1], oa1[2], oa1[3]}; *(v4u*)(wrow_o + 768 + 8) = (v4u){oa1[4], oa1[5], oa1[6], oa1[7]};
        bf16* grow_o = g_out + row * 256 + hd * 64 + 16 * q;
        *(v4u*)(grow_o) = (v4u){og[0], og[1], og[2], og[3]}; *(v4u*)(grow_o + 8) = (v4u){og[4], og[5], og[6], og[7]};
    }
#pragma unroll
    for (int n2 = 0; n2 < 2; ++n2) {
        const size_t row = (size_t)(row0 + p0 + 16 * (2 * ntp + n2) + l15);
        float bs = bsum[n2], ks2 = ksum[n2];
        bs += __shfl_xor(bs, 16); bs += __shfl_xor(bs, 32); ks2 += __shfl_xor(ks2, 16); ks2 += __shfl_xor(ks2, 32);
        if (q == 0) { bonus[row * 4 + hd] = bs; rinv[row * 4 + hd] = rsqrtf_(ks2 + 1e-6f); }
    }
    __syncthreads();
}
__device__ __forceinline__ int fwd_row_r(int b, int c, int t) { return c < 4 ? (T_LAT + b * CTXL + c * 64 + t) : (b * SEQ + (c - 4) * 64 + t); }
__device__ __forceinline__ bf16* rw_blob_row(const Ctx& C, int d, int which, int b, int c, int h, int r) {
    const int row = fwd_row_r(b, c, r);
#if RW_VSPLIT
    if (which == 0) { if (d) return WSP(bf16, WS_GQ) + (size_t)row * 768 + 512 + h * 64;
                      return WSP(bf16, WS_P) + (size_t)row * PLD + OFF_B + 512 + h * 64; }
#else
    if (which == 0) return WSP(bf16, WS_OUTB) + ((size_t)d * T_ALL + row) * 256 + h * 64;
#endif
    return WSP(bf16, WS_P) + (size_t)row * PLD + OFF_B + d * 256 + h * 64;
}
__device__ __forceinline__ void rwkv_solve_item(const Ctx& C, int l, int item) {
    const int lane = C.lane, w = C.wave, pw = w & 1, pi = w >> 1, l15 = lane & 15, q = lane >> 4;
    LAS unsigned char* B0 = C.lds + pi * 31744;
    LAS bf16* Kk = (LAS bf16*)B0; LAS bf16* Bh = Kk + 64 * MP; LAS bf16* Kh = Bh + 64 * MP;
    LAS bf16* Ln = (LAS bf16*)B0;
    LAS bf16* Lk16 = (LAS bf16*)(B0 + 9216);
    LAS unsigned char* XT = B0 + 9216;
    LAS bf16* TinvP = (LAS bf16*)(B0 + 25600);
    const bf16* WA = WSP(const bf16, WS_HB); bf16* WAw = WSP(bf16, WS_HB); const bf16* rkv = WSP(const bf16, WS_RKV); const float* rinv = WSP(const float, WS_RINV);
    const int u = item >> 1, d = item & 1;
    const int c = u % NCH, h = (u / NCH) & 3, b = u / (NCH * NH);
    const float k_k = C.in[I_RKK][l * GW + h * 64 + lane], k_a = C.in[I_RKA][l * GW + h * 64 + lane];
    const int n = d ? (c < 4 ? 3 - c : 71 - c) : c;
    const float ril = rinv[(size_t)seqrow_raster(n * 64 + lane, d, b) * 4 + h];
#pragma unroll
    for (int r = 0; r < 4; ++r) { const int idx2 = pw * 64 + lane + 128 * r, t = idx2 >> 3, part = idx2 & 7; const int row = seqrow_raster(n * 64 + t, d, b);
        *(LAS v4u*)(Kk + t * MP + 8 * part) = *(const v4u*)(WA + (size_t)row * 1024 + d * 256 + h * 64 + 8 * part);
        *(LAS v4u*)(Bh + t * MP + 8 * part) = *(const v4u*)(WA + (size_t)row * 1024 + (2 + d) * 256 + h * 64 + 8 * part);
        *(LAS v4u*)(Kh + t * MP + 8 * part) = *(const v4u*)(rkv + (size_t)row * 768 + 256 + h * 64 + 8 * part); }
    __syncthreads();
    {
        float cc = 1.0f;
        if (pw) {
#pragma unroll
            for (int t = 0; t < 32; ++t) cc *= bf2f(Kk[t * MP + lane]);
        }
        __syncthreads();
#pragma unroll
        for (int t2 = 0; t2 < 32; ++t2) {
            const int t = pw * 32 + t2;
            const float wv = bf2f(Kk[t * MP + lane]), av = bf2f(Bh[t * MP + lane]), ks = bf2f(Kh[t * MP + lane]);
            const float kap = ks * k_k * __shfl(ril, t);
            const float cprev = cc; cc *= wv; const float ic = __builtin_amdgcn_rcpf(cc);
            Kk[t * MP + lane] = (bf16)f2bf1(kap * cprev); Bh[t * MP + lane] = (bf16)f2bf1(kap * av * ic); Kh[t * MP + lane] = (bf16)f2bf1(ks * (1.0f + (av - 1.0f) * k_a) * ic);
            WAw[(size_t)seqrow_raster(n * 64 + t, d, b) * 1024 + d * 256 + h * 64 + lane] = (bf16)f2bf1(cc);
        }
    }
    __syncthreads();
    f32x4 acc[4][4];
    if (pw == 0) {
#pragma unroll
        for (int I = 0; I < 4; ++I)
#pragma unroll
            for (int r = 0; r < 4; ++r)
#pragma unroll
                for (int nt = 0; nt < 4; ++nt) acc[I][nt][r] = bf2f(Kk[(16 * I + 4 * q + r) * MP + 16 * nt + l15]);
    }
    f32x4 T[10];
    {
        const LAS bf16* Bsrc = pw ? Kh : Bh;
        int tix = 0;
#pragma unroll
        for (int it = 0; it < 4; ++it)
#pragma unroll
            for (int jt = 0; jt <= it; ++jt, ++tix) {
                f32x4 t4 = (f32x4){0.f, 0.f, 0.f, 0.f};
#pragma unroll
                for (int s = 0; s < 2; ++s) t4 = mfma16(ld_frag16(Kk + (16 * it + l15) * MP + 32 * s + 8 * q), ld_frag16(Bsrc + (16 * jt + l15) * MP + 32 * s + 8 * q), t4);
#pragma unroll
                for (int r = 0; r < 4; ++r) { const int i = 16 * it + 4 * q + r, j = 16 * jt + l15; T[tix][r] = (j < i) ? (pw ? t4[r] : -t4[r]) : 0.f; }
            }
    }
    __syncthreads();
    {
        int tix = 0;
#pragma unroll
        for (int it = 0; it < 4; ++it)
#pragma unroll
            for (int jt = 0; jt < 4; ++jt) {
                if (jt <= it) {
#pragma unroll
                    for (int r = 0; r < 4; ++r) (pw ? Lk16 : Ln)[(16 * it + 4 * q + r) * MP + 16 * jt + l15] = (bf16)f2bf1(T[tix][r]);
                    ++tix;
                } else if (pw == 0) {
#pragma unroll
                    for (int r = 0; r < 4; ++r) Ln[(16 * it + 4 * q + r) * MP + 16 * jt + l15] = (bf16)0;
                }
            }
        LAS v4u* tz = (LAS v4u*)(B0 + 25600) + (pw * 64 + lane) * 2; tz[0] = (v4u){0u, 0u, 0u, 0u}; tz[1] = (v4u){0u, 0u, 0u, 0u};
    }
    __syncthreads();
    if (pw) {
#pragma unroll
        for (int I = 0; I < 4; ++I)
#pragma unroll
            for (int r = 0; r < 4; ++r)
#pragma unroll
                for (int nt = 0; nt < 4; ++nt) { const int i = 16 * I + 4 * q + r, j = 16 * nt + l15; acc[I][nt][r] = (j < i && nt <= I) ? bf2f(Lk16[i * MP + j]) : 0.f; }
    } else diag_inverses(Ln, TinvP, lane);
    __syncthreads();
    LAS unsigned char* XTw = XT + pw * 8192;
    { LAS v4u* xz = (LAS v4u*)(XTw + lane * 128);
#pragma unroll
        for (int g = 0; g < 8; ++g) xz[g] = (v4u){0u, 0u, 0u, 0u}; }
    blocked_solve(Ln, TinvP, XTw, acc, l15, q);
    {
        bf16* dst = rw_blob_row(C, d, pw, b, c, h, lane);
        const LAS unsigned char* xr = XTw + lane * 128;
#pragma unroll
        for (int g = 0; g < 8; ++g) *(v4u*)(dst + 8 * g) = *(const LAS v4u*)(xr + ((g ^ (lane & 7)) << 4));
    }
    __syncthreads();
}

template <bool DRY>
__device__ __forceinline__ void rwkv_chunked(const Ctx& C, int l, int idx) {
#ifndef RW_VSPLIT
#define RW_VSPLIT 1
#endif
    constexpr int NV = RW_VSPLIT ? 1 : 2;
    const int vhalf = idx & 1, lane = C.lane, w = C.wave, l15 = lane & 15, q = lane >> 4;
    const int d = RW_VSPLIT ? idx >> 6 : idx >> 5, b = RW_VSPLIT ? (idx >> 3) & 7 : (idx >> 2) & 7, h = RW_VSPLIT ? (idx >> 1) & 3 : idx & 3;
    const int it = w & 3, vt0 = RW_VSPLIT ? 2 * vhalf + (w >> 2) : 2 * (w >> 2);
    constexpr int IMG = 64 * MP * 2;
    LAS unsigned char* L0 = C.lds;
    LAS bf16* Wi = (LAS bf16*)L0; LAS bf16* Ti = Wi + 64 * MP; LAS bf16* Rh = Ti + 64 * MP; LAS bf16* Kh = Rh + 64 * MP; LAS bf16* Bh = Kh + 64 * MP;
    LAS bf16* UT = (LAS bf16*)(L0 + 11 * IMG);
    LAS float* cLv = (LAS float*)(L0 + 14 * IMG);
    const bf16* WA = WSP(const bf16, WS_HB); const bf16* rkv = WSP(const bf16, WS_RKV); const float* rinv = WSP(const float, WS_RINV);
    bf16* outb = WSP(bf16, WS_OUTB) + (size_t)d * T_ALL * 256;
    const int tt = C.tid >> 3, part = C.tid & 7;
    for (int i = C.tid; i < 2 * IMG / 4; i += NTHR) ((LAS unsigned*)(L0 + 12 * IMG))[i] = 0u;
    float kkw[8], kaw[8];
#pragma unroll
    for (int e = 0; e < 8; ++e) { kkw[e] = C.in[I_RKK][l * GW + h * 64 + 8 * w + e]; kaw[e] = C.in[I_RKA][l * GW + h * 64 + 8 * w + e]; }
    v4u gr, gk, gv, gw, ga, gbw, gbt; float gri;
    auto gload = [&](int n) {
        const int c = d ? (n < 4 ? 3 - n : 71 - n) : n;
        const int row = seqrow_raster(n * 64 + lane, d, b);
        const bf16* pr = rkv + (size_t)row * 768 + h * 64 + 8 * w;
        gr = *(const v4u*)pr; gk = *(const v4u*)(pr + 256); gv = *(const v4u*)(pr + 512);
        gw = *(const v4u*)(WA + (size_t)row * 1024 + d * 256 + h * 64 + 8 * w); ga = *(const v4u*)(WA + (size_t)row * 1024 + (2 + d) * 256 + h * 64 + 8 * w);
        gri = rinv[(size_t)row * 4 + h];
        gbw = *(const v4u*)(rw_blob_row(C, d, 0, b, c, h, tt) + 8 * part); gbt = *(const v4u*)(rw_blob_row(C, d, 1, b, c, h, tt) + 8 * part);
    };
    auto images = [&](int bufi) {
        LAS bf16* VT = (LAS bf16*)(L0 + (5 + 3 * bufi) * IMG); LAS bf16* KcT = VT + 64 * MP; LAS bf16* BcT = KcT + 64 * MP;
        const unsigned rw_[4] = {gr.x, gr.y, gr.z, gr.w}, kw_[4] = {gk.x, gk.y, gk.z, gk.w}, vw_[4] = {gv.x, gv.y, gv.z, gv.w}, ww_[4] = {gw.x, gw.y, gw.z, gw.w}, aw_[4] = {ga.x, ga.y, ga.z, ga.w};
        float rh[8], kh[8], bh[8];
#pragma unroll
        for (int e = 0; e < 8; ++e) {
            const float rs = (e & 1) ? bfhi(rw_[e >> 1]) : bflo(rw_[e >> 1]), ks = (e & 1) ? bfhi(kw_[e >> 1]) : bflo(kw_[e >> 1]);
            const float wv = (e & 1) ? bfhi(ww_[e >> 1]) : bflo(ww_[e >> 1]), av = (e & 1) ? bfhi(aw_[e >> 1]) : bflo(aw_[e >> 1]);
            const float kap = ks * kkw[e] * gri, ktil = ks * (1.0f + (av - 1.0f) * kaw[e]);
            const float cf = wv, icf = __builtin_amdgcn_rcpf(cf), cfL = __builtin_bit_cast(float, __builtin_amdgcn_readlane(__builtin_bit_cast(int, cf), 63)), dec = cfL * icf;
            rh[e] = rs * cf; kh[e] = ktil * icf; bh[e] = kap * av * icf;
            const unsigned short vraw = (e & 1) ? (unsigned short)(vw_[e >> 1] >> 16) : (unsigned short)(vw_[e >> 1] & 0xffffu);
            VT[(8 * w + e) * MP + lane] = vraw; KcT[(8 * w + e) * MP + lane] = (bf16)f2bf1(ktil * dec); BcT[(8 * w + e) * MP + lane] = (bf16)f2bf1(-(kap * av * dec));
            if (lane == 63) cLv[bufi * 64 + 8 * w + e] = cfL;
        }
        { v4u o; o.x = pk2(rh[0], rh[1]); o.y = pk2(rh[2], rh[3]); o.z = pk2(rh[4], rh[5]); o.w = pk2(rh[6], rh[7]); *(LAS v4u*)(Rh + lane * MP + 8 * w) = o; }
        { v4u o; o.x = pk2(kh[0], kh[1]); o.y = pk2(kh[2], kh[3]); o.z = pk2(kh[4], kh[5]); o.w = pk2(kh[6], kh[7]); *(LAS v4u*)(Kh + lane * MP + 8 * w) = o; }
        { v4u o; o.x = pk2(bh[0], bh[1]); o.y = pk2(bh[2], bh[3]); o.z = pk2(bh[4], bh[5]); o.w = pk2(bh[6], bh[7]); *(LAS v4u*)(Bh + lane * MP + 8 * w) = o; }
        const unsigned bw_[4] = {gbw.x, gbw.y, gbw.z, gbw.w}, bt_[4] = {gbt.x, gbt.y, gbt.z, gbt.w};
#pragma unroll
        for (int e = 0; e < 4; ++e) {
            Wi[(8 * part + 2 * e) * MP + tt] = (bf16)(bw_[e] & 0xffffu); Wi[(8 * part + 2 * e + 1) * MP + tt] = (bf16)(bw_[e] >> 16);
            Ti[(8 * part + 2 * e) * MP + tt] = (bf16)(bt_[e] & 0xffffu); Ti[(8 * part + 2 * e + 1) * MP + tt] = (bf16)(bt_[e] >> 16);
        }
    };
    f32x4 Zst[NV];
#pragma unroll
    for (int v2 = 0; v2 < NV; ++v2) Zst[v2] = (f32x4){0.f, 0.f, 0.f, 0.f};
    const f32x4 z4 = (f32x4){0.f, 0.f, 0.f, 0.f};
    gload(0); images(0); gload(1);
#pragma unroll 1
    for (int n = 0; n < NCH; ++n) {
        RAW_BARRIER();
        const LAS bf16* VT = (const LAS bf16*)(L0 + (5 + 3 * (n & 1)) * IMG); const LAS bf16* KcT = VT + 64 * MP; const LAS bf16* BcT = KcT + 64 * MP;
        const LAS bf16* Zi = (const LAS bf16*)(L0 + (12 + (n & 1)) * IMG); LAS bf16* Zn = (LAS bf16*)(L0 + (12 + ((n + 1) & 1)) * IMG);
        const int arow = (16 * it + l15) * MP + 8 * q;
        const fragb Wf0 = ld_frag16(Wi + arow), Wf1 = ld_frag16(Wi + arow + 32), Tf0 = ld_frag16(Ti + arow), Tf1 = ld_frag16(Ti + arow + 32), Rf0 = ld_frag16(Rh + arow), Rf1 = ld_frag16(Rh + arow + 32);
        const int icol = 16 * it + l15;
        f32x4 pk[4], pb[4];
#pragma unroll
        for (int jt = 0; jt < 4; ++jt) {
            pk[jt] = z4; pb[jt] = z4;
            if (jt <= it) {
                const int jrow = (16 * jt + l15) * MP + 8 * q;
                f32x4 sk = mfma16(ld_frag16(Kh + jrow), Rf0, z4); sk = mfma16(ld_frag16(Kh + jrow + 32), Rf1, sk);
                f32x4 sb = mfma16(ld_frag16(Bh + jrow), Rf0, z4); sb = mfma16(ld_frag16(Bh + jrow + 32), Rf1, sb);
#pragma unroll
                for (int r = 0; r < 4; ++r) { const int j = 16 * jt + 4 * q + r; pk[jt][r] = (j <= icol) ? sk[r] : 0.f; pb[jt][r] = (j <= icol) ? -sb[r] : 0.f; }
            }
        }
        fragb Pk0 = pack_frag(pk[0], pk[1]), Pk1 = pack_frag(pk[2], pk[3]), Pb0 = pack_frag(pb[0], pb[1]), Pb1 = pack_frag(pb[2], pb[3]);
        f32x4 RZ[NV];
#pragma unroll
        for (int v2 = 0; v2 < NV; ++v2) {
            const int vrow = 16 * (vt0 + v2) + l15;
            const fragb z0 = ld_frag16(Zi + vrow * MP + 8 * q), z1 = ld_frag16(Zi + vrow * MP + 32 + 8 * q);
            f32x4 u = mfma16(Wf0, z0, z4); u = mfma16(Wf1, z1, u);
            u = mfma16(Tf0, ld_frag16(VT + vrow * MP + 8 * q), u); if (it >= 2) u = mfma16(Tf1, ld_frag16(VT + vrow * MP + 32 + 8 * q), u);
            RZ[v2] = mfma16(Rf0, z0, z4); RZ[v2] = mfma16(Rf1, z1, RZ[v2]);
            v2u o; o.x = pk2(u.x, u.y); o.y = pk2(u.z, u.w);
            *(LAS v2u*)(UT + vrow * MP + 16 * it + 4 * q) = o;
        }
        RAW_BARRIER();
        {
            const f32x4 cl4 = *(const LAS f32x4*)(cLv + (n & 1) * 64 + 16 * it + 4 * q);
            const LAS bf16* kr = KcT + (16 * it + l15) * MP + 4 * q; const LAS bf16* br = BcT + (16 * it + l15) * MP + 4 * q;
            const fragb kc0 = ld_frag8x2(kr, kr + 16), kc1 = ld_frag8x2(kr + 32, kr + 48), bc0 = ld_frag8x2(br, br + 16), bc1 = ld_frag8x2(br + 32, br + 48);
#pragma unroll
            for (int v2 = 0; v2 < NV; ++v2) {
                const int vrow = 16 * (vt0 + v2) + l15;
                const LAS bf16* vr = VT + vrow * MP + 4 * q; const LAS bf16* ur = UT + vrow * MP + 4 * q;
                const fragb vp0 = ld_frag8x2(vr, vr + 16), vp1 = ld_frag8x2(vr + 32, vr + 48), up0 = ld_frag8x2(ur, ur + 16), up1 = ld_frag8x2(ur + 32, ur + 48);
                f32x4 y = mfma16(Pk0, vp0, RZ[v2]); y = mfma16(Pb0, up0, y);
                if (it >= 2) { y = mfma16(Pk1, vp1, y); y = mfma16(Pb1, up1, y); }
#pragma unroll
                for (int r = 0; r < 4; ++r) { const int row = seqrow_raster(n * 64 + 16 * it + 4 * q + r, d, b); if (!DRY) outb[(size_t)row * 256 + h * 64 + vrow] = (bf16)f2bf1(y[r]); }
                f32x4 zn = mfma16(kc0, vp0, z4); zn = mfma16(kc1, vp1, zn); zn = mfma16(bc0, up0, zn); zn = mfma16(bc1, up1, zn);
                Zst[v2] = Zst[v2] * cl4 + zn;
                v2u so; so.x = pk2(Zst[v2].x, Zst[v2].y); so.y = pk2(Zst[v2].z, Zst[v2].w);
                *(LAS v2u*)(Zn + vrow * MP + 16 * it + 4 * q) = so;
            }
        }
        if (n + 1 < NCH) { images((n + 1) & 1); if (n + 2 < NCH) gload(n + 2); }
    }
    __syncthreads();
}
__device__ __forceinline__ void moe_scatter(const Ctx& C, int moe_li, int nrows) {
    const unsigned* gc = WSP(const unsigned, WS_CTL) + CW_MOECNT + 64 * moe_li;
    LAS int* pst = (LAS int*)C.lds;
    {
        int pe[8]; int acc = 0;
#pragma unroll
        for (int e = 0; e < NE; ++e) { const int blks = ((int)gc[e] + 255) >> 8; if (C.tid == e) pst[e] = acc * 256; acc += blks; pe[e] = acc; }
        if (C.wg == 0 && C.tid < MOE_MAXBLK) { int be = 0;
#pragma unroll
            for (int e = 0; e < NE; ++e) be += (pe[e] <= C.tid) ? 1 : 0;
            int* tab = WSP(int, WS_TAB); tab[1 + C.tid] = be < NE ? be : NE - 1; if (C.tid == 0) tab[0] = acc; }
    }
    __syncthreads();
    const unsigned* route = WSP(const unsigned, WS_ROUTE); const unsigned* wgbase = WSP(const unsigned, WS_WGBASE);
    int* pos = WSP(int, WS_POS); int* tok = WSP(int, WS_TOK);
    if (C.wg < NE) { const int cnt = (int)gc[C.wg], s0 = pst[C.wg] + cnt, s1 = pst[C.wg] + (((cnt + 255) >> 8) << 8);
        for (int j = s0 + C.tid; j < s1; j += NTHR) tok[j] = 0; }
    const int m = C.wg * NWAVES + C.wave + C.lane * (C.G * NWAVES);
    if (m < nrows) {
        const v4u a = *(const v4u*)(route + (size_t)m * 8);
        const int e0 = (int)a.x, e1 = (int)a.y;
        const int p0 = pst[e0] + (int)wgbase[C.wg * 8 + e0] + (int)a.z, p1 = pst[e1] + (int)wgbase[C.wg * 8 + e1] + (int)a.w;
        pos[(size_t)m * 2] = p0; pos[(size_t)m * 2 + 1] = p1; tok[p0] = m; tok[p1] = m;
    }
    __syncthreads();
}
template <int NEXT>
__device__ __forceinline__ void moe_combine(const Ctx& C, int l, int nrows) {
    const unsigned* route = WSP(const unsigned, WS_ROUTE); const int* pos = WSP(const int, WS_POS); const bf16* ym = WSP(const bf16, WS_MIX);
    const float* modv = WSP(const float, WS_MODV) + (size_t)l * 9 * 6144 + 5 * 1024;
    const float* modn = WSP(const float, WS_MODV) + (size_t)(l + 1) * 9 * 6144;
    float* xc = WSP(float, WS_XC); bf16* hb = WSP(bf16, WS_HB);
    bf16* xlb = NEXT == 2 ? WSP(bf16, WS_XLAST) : (bf16*)C.out;
    const int gw = C.wg * NWAVES + C.wave, NGW = C.G * NWAVES;
    f32x4 gn[4];
#pragma unroll
    for (int j = 0; j < 4; ++j) gn[j] = *(const f32x4*)((NEXT == 2 ? C.in[I_FNG] : C.in[I_NMIXG] + (NEXT == 1 ? (l + 1) * 1024 : 0)) + 4 * C.lane + 256 * j);
    int p0n = 0, p1n = 0; float w0n = 0.f, w1n = 0.f;
    v4u xa[4]; v2u ya[4], yb[4]; float w0c = 0.f, w1c = 0.f;
#define MC_POS(mm, P0, P1, W0, W1) do { const int m_ = (mm); P0 = pos[(size_t)m_ * 2]; P1 = pos[(size_t)m_ * 2 + 1]; W0 = __builtin_bit_cast(float, route[(size_t)m_ * 8 + 4]); W1 = __builtin_bit_cast(float, route[(size_t)m_ * 8 + 5]); } while (0)
#define MC_RAW(mm, P0, P1) do { const int m_ = (mm); const bool ic_ = m_ >= T_LAT; \
        _Pragma("unroll") for (int j = 0; j < 4; ++j) { const int col = 4 * C.lane + 256 * j; \
            ya[j] = *(const v2u*)(ym + (size_t)(P0) * 1024 + col); yb[j] = *(const v2u*)(ym + (size_t)(P1) * 1024 + col); \
            if (ic_) xa[j] = *(const v4u*)(xc + (size_t)(m_ - T_LAT) * 1024 + col); else { const v2u t_ = *(const v2u*)(xlb + (size_t)m_ * 1024 + col); xa[j] = (v4u){t_.x, t_.y, 0u, 0u}; } } } while (0)
    if (gw < nrows) { int p0, p1; MC_POS(gw, p0, p1, w0c, w1c); if (gw + NGW < nrows) MC_POS(gw + NGW, p0n, p1n, w0n, w1n); MC_RAW(gw, p0, p1); }
    for (int m = gw; m < nrows; m += NGW) {
        const bool isctx = m >= T_LAT;
        float* xr = isctx ? xc + (size_t)(m - T_LAT) * 1024 : C.out + (size_t)m * 1024; bf16* xrb = xlb + (size_t)m * 1024;
        const int mrow = isctx ? 8 : (m >> 12);
        const float* gv = modv + (size_t)mrow * 6144;
        v4u xq[4]; v2u yq0[4], yq1[4]; const float w0 = w0c, w1 = w1c;
#pragma unroll
        for (int j = 0; j < 4; ++j) { xq[j] = xa[j]; yq0[j] = ya[j]; yq1[j] = yb[j]; }
        const int p0u = p0n, p1u = p1n; w0c = w0n; w1c = w1n;
        if (m + 2 * NGW < nrows) MC_POS(m + 2 * NGW, p0n, p1n, w0n, w1n);
        if (m + NGW < nrows) MC_RAW(m + NGW, p0u, p1u);
        f32x4 x[4]; float ss = 0.f;
#pragma unroll
        for (int j = 0; j < 4; ++j) {
            const int col = 4 * C.lane + 256 * j;
            const f32x4 ya4 = (f32x4){bflo(yq0[j].x), bfhi(yq0[j].x), bflo(yq0[j].y), bfhi(yq0[j].y)}, yb4 = (f32x4){bflo(yq1[j].x), bfhi(yq1[j].x), bflo(yq1[j].y), bfhi(yq1[j].y)};
            const f32x4 g = *(const f32x4*)(gv + col);
            const f32x4 xo = isctx ? __builtin_bit_cast(f32x4, xq[j]) : (f32x4){bflo(xq[j].x), bfhi(xq[j].x), bflo(xq[j].y), bfhi(xq[j].y)};
            x[j] = xo + g * (ya4 * w0 + yb4 * w1);
            if (NEXT != 2) { if (isctx) *(f32x4*)(xr + col) = x[j]; else st4bf(xrb + col, x[j]); }
            ss += (x[j].x * x[j].x + x[j].y * x[j].y) + (x[j].z * x[j].z + x[j].w * x[j].w);
        }
        if (NEXT != 0) {
            const float rs = rsqrtf_(wave_sum(ss) * (1.0f / 1024.0f) + 1e-6f);
#pragma unroll
            for (int j = 0; j < 4; ++j) {
                const int col = 4 * C.lane + 256 * j;
                if (NEXT == 2) *(f32x4*)(xr + col) = x[j] * rs * gn[j];
                else { const f32x4 sh = *(const f32x4*)(modn + (size_t)mrow * 6144 + col), scl = *(const f32x4*)(modn + (size_t)mrow * 6144 + 1024 + col);
                    st4bf(hb + (size_t)m * 1024 + col, (x[j] * rs * gn[j]) * (scl + 1.0f) + sh); }
            }
        }
    }
#undef MC_POS
#undef MC_RAW
}
__device__ __forceinline__ void final_norm(const Ctx& C) {
    const int gw = C.wg * NWAVES + C.wave, NGW = C.G * NWAVES;
    f32x4 gv[4];
#pragma unroll
    for (int j = 0; j < 4; ++j) gv[j] = *(const f32x4*)(C.in[I_FNG] + 4 * C.lane + 256 * j);
    for (int m = gw; m < T_LAT; m += NGW) {
        float* xr = C.out + (size_t)m * 1024;
        f32x4 v[4]; float s = 0.f;
#pragma unroll
        for (int j = 0; j < 4; ++j) { v[j] = *(const f32x4*)(xr + 4 * C.lane + 256 * j); s += (v[j].x * v[j].x + v[j].y * v[j].y) + (v[j].z * v[j].z + v[j].w * v[j].w); }
        const float rs = rsqrtf_(wave_sum(s) * (1.0f / 1024.0f) + 1e-6f);
#pragma unroll
        for (int j = 0; j < 4; ++j) *(f32x4*)(xr + 4 * C.lane + 256 * j) = v[j] * rs * gv[j];
    }
}

constexpr int NPH_L = 13, PH_FINAL = 1 + DEPTH * NPH_L, NPHASE = PH_FINAL + 1;
__host__ __device__ inline bool phase_exists(int ph) {
    if (ph == 0) return true;
    if (ph == PH_FINAL) return false;
    const int l = (ph - 1) / NPH_L, k = (ph - 1) % NPH_L;
    if (l >= 2 && !(l & 1) && k == 0) return false;
    if (!(l & 1) && k >= 11) return false;
    if (!RW_VSPLIT && k == 4) return false;
    return true;
}
#ifndef PH_MASK
#define PH_MASK 0xFFFFFF
#endif
#define PM(k) ((PH_MASK >> (k)) & 1)
#ifndef SK_MASK
#define SK_MASK 0xFFFF
#endif
#define SK(k) ((SK_MASK >> (k)) & 1)
#ifndef REP_MASK
#define REP_MASK 0
#endif
#define NREP(k) (((REP_MASK >> (k)) & 1) ? 2 : 1)

__global__ void __launch_bounds__(NTHR, 2) fwd_kernel(Args args) {
    extern __shared__ __attribute__((aligned(16))) unsigned char lds_raw[];
    Ctx C; C.in = args.in; C.out = args.out; C.ws = args.ws; C.lds = (LAS unsigned char*)lds_raw;
    C.tid = threadIdx.x; C.lane = C.tid & 63; C.wave = __builtin_amdgcn_readfirstlane(C.tid >> 6); C.G = gridDim.x; C.wg = blockIdx.x;
    volatile LAS unsigned* MISC = (volatile LAS unsigned*)(C.lds + MISC_OFF);
    if (C.tid < 64) MISC[C.tid] = 0u;
    __syncthreads();
    const int lo = args.ph_lo, hi = args.ph_hi;
    const bool multi = (hi - lo) > 1;
    if (multi) (void)xcd_barrier_post(WSP(unsigned, WS_CTL) + CW_BAR, MISC + 8);
#define IN(k) (lo <= (k) && (k) < hi)
#define SEAM(k) do { if (IN((k) + 1)) { XcdBarrier b2_; b2_.bar = WSP(unsigned, WS_CTL) + CW_BAR; b2_.x = xb_xcc_id(); b2_.st = (volatile LAS unsigned*)(C.lds + MISC_OFF) + 8; xcd_barrier(b2_); } } while (0)
#define FRESH() do { int t_ = threadIdx.x; asm volatile("" : "+v"(t_)); C.tid = t_; C.lane = t_ & 63; C.wave = __builtin_amdgcn_readfirstlane(t_ >> 6); } while (0)
#define PHASE(bit, k) if (PM(bit) && IN(pb + (k))) for (int rep_ = 0; rep_ < NREP(bit); ++rep_)
#define CLAIM(qh, var) __syncthreads(); if (C.tid == 0) *qslot = atomicAdd((qh), 1u); __syncthreads(); const int var = (int)*qslot;

    LAS unsigned* qslot = (LAS unsigned*)(C.lds + MISC_OFF + 128);
    constexpr int NCSL = 512;
#define CONV_QUEUES(maxn) do { int n_ = 0; \
        if (l > 0) for (; n_ < (maxn); ++n_) { FRESH(); CLAIM(qbase + 192, u0) if (u0 >= NCSL) break; FRESH(); convert_items(C, l, 2, u0 * NWAVES + C.wave, NCSL * NWAVES); } \
        if (l + 1 < DEPTH) for (; n_ < (maxn); ++n_) { FRESH(); CLAIM(qbase + 224, u0) if (u0 >= NCSL) break; FRESH(); convert_items(C, l + 1, 1, u0 * NWAVES + C.wave, NCSL * NWAVES); } } while (0)
    if (PM(20) && IN(0)) { phase_pre(C);
        for (;;) { FRESH(); CLAIM(WSP(unsigned, WS_CTL) + CW_PREPQ + 240, u0) if (u0 >= NCSL) break; FRESH(); convert_items(C, 0, 3, u0 * NWAVES + C.wave, NCSL * NWAVES); }
        SEAM(0); }

#pragma unroll 1
    for (int l = 0; l < DEPTH; ++l) {
        const int pb = 1 + l * NPH_L;
        if (hi <= pb || lo >= pb + NPH_L) continue;
        const bool last = (l == DEPTH - 1), moe = (l & 1);
        const int nrows = last ? T_LAT : T_ALL;
        const void* xlat = (l == 0) ? (const void*)C.in[I_X] : (const void*)C.out; const bool xbf = l > 0; void* xmid = last ? (void*)WSP(bf16, WS_XLAST) : (void*)C.out;
        const float* xctx = (l == 0) ? C.in[I_CTX] : WSP(const float, WS_XC);
        const float* modv = WSP(const float, WS_MODV) + (size_t)l * 9 * 6144;
        unsigned* qbase = WSP(unsigned, WS_CTL) + CW_PREPQ + 256 * l;

        if (!(l >= 2 && !(l & 1))) PHASE(0, 0) { FRESH();
            convert_small(C, l);
            __syncthreads();
            FRESH(); norm_rows<false>(C, l, xlat, xbf, xctx, C.in[I_NMIXG] + l * 1024, 0, 1024, T_ALL, 0);
            SEAM(pb + 0);
        }
        PHASE(1, 1) { FRESH();
            pg8::Gemm g{WSP(const bf16, WS_HB), WSP(const bf16, WS_WIN), T_ALL, PLD, 1024, 0};
            const int gG = (l > 0) ? C.G - 16 : C.G;
            if (C.wg < gG) {
                pg8::StaticOrder S; S.init(T_ALL, PLD, gG, C.wg);
                pg8::EpiBf16<0> E{WSP(bf16, WS_P), PLD, nullptr, 0, 0};
                pg8::gemm_phase<pg8::EpiBf16<0>, pg8::StaticOrder, false>(C.lds, g, S, E, nullptr);
                if (l > 0 && C.tid == 0) (void)xb_add(qbase + 176, 1u);
            } else {
                for (;;) { FRESH(); __syncthreads(); if (C.tid == 0) *qslot = xb_ld(qbase + 176); __syncthreads(); const unsigned fin_ = *qslot; if (fin_ != 0u) break;
                    CLAIM(qbase + 192, u0) if (u0 >= NCSL) break; FRESH(); convert_items(C, l, 2, u0 * NWAVES + C.wave, NCSL * NWAVES); }
            }
            SEAM(pb + 1);
        }
        if (PM(2) && IN(pb + 2)) for (int rep_ = 0; rep_ < NREP(2); ++rep_) { FRESH();
            for (;;) {
                CLAIM(qbase + 16 * rep_, k)
                if (k >= 2 * NB * NCH) break;
                const int kind = k / (NB * NCH), u = k % (NB * NCH);
                FRESH();
                if (kind == 0) { for (int r3_ = 0; r3_ < NREP(24); ++r3_) { FRESH(); if (SK(1)) rwkv_prep2(C, l, u / NCH, u % NCH); } }
                else { for (int r3_ = 0; r3_ < NREP(26); ++r3_) { FRESH(); if (SK(2)) gdn_prep(C, l, u / NCH, u % NCH); } }
            }
            SEAM(pb + 2);
        }
        if (PM(3) && IN(pb + 3)) for (int rep_ = 0; rep_ < NREP(3); ++rep_) { FRESH();
            constexpr int NCL = 2 * NB * NH * NCH / 4;
            int ncl_ = 0;
            for (;;) {
                CLAIM(qbase + 64 + 16 * rep_, k)
                if (k >= NCL) break;
                FRESH(); ++ncl_;
                if (SK(10)) rwkv_solve_item(C, l, 4 * k + (C.wave >> 1));
            }
            if (ncl_ <= 4) { const int cap_ = (l & 1) ? 1 : 3; CONV_QUEUES(cap_); }
            SEAM(pb + (RW_VSPLIT ? 3 : 4));
        }
#if RW_VSPLIT
        if (PM(3) && IN(pb + 4)) { FRESH();
            for (;;) {
                CLAIM(qbase + 128, k)
                if (k >= 2 * NB * NH * NCH / 4) break;
                FRESH();
                if (SK(10)) rwkv_solve_item(C, l, 4 * k + (C.wave >> 1));
            }
            SEAM(pb + 4);
        }
#endif
        if (PM(4) && IN(pb + 5)) { FRESH();
            if (C.wg >= 64) {
                constexpr int NCL = 2 * NB * NH * NCH / 4;
                for (;;) {
                    CLAIM(qbase + 128, k)
                    if (k >= NCL) break;
                    FRESH();
                    if (SK(9)) gdn_solve_item(C, l, 4 * k + (C.wave >> 1));
                }
                asm volatile("s_waitcnt vmcnt(0)" ::: "memory");
                __syncthreads();
                if (C.tid == 0) { __builtin_amdgcn_fence(__ATOMIC_RELEASE, "agent"); asm volatile("s_waitcnt vmcnt(0)" ::: "memory"); (void)xb_add(qbase + 160, 1u); }
                if (C.wg >= 192) {
                    if (C.tid == 0) { unsigned* bar_ = WSP(unsigned, WS_CTL) + CW_BAR; XB_SPIN(xb_ld(qbase + 160) < (unsigned)(C.G - 64), bar_); __builtin_amdgcn_fence(__ATOMIC_ACQUIRE, "agent"); asm volatile("s_waitcnt vmcnt(0)" ::: "memory"); }
                    __syncthreads();
                }
                FRESH();
            }
            if (C.wg >= 64 && C.wg < 128) { if (SK(0)) lru_chain(C, l, C.wg - 64); FRESH(); }
            if (SK(3) && C.wg < (RW_VSPLIT ? 128 : 64)) { if (NREP(20) > 1) { FRESH(); rwkv_chunked<true>(C, l, C.wg); } FRESH(); rwkv_chunked<false>(C, l, C.wg); }
            else if (SK(4) && C.wg >= 128 && C.wg < 192) { for (int r2_ = 0; r2_ < NREP(21); ++r2_) { FRESH(); mlstm_chunked(C, l, C.wg - 128); } }
            else if (SK(5) && C.wg >= 192) { if (NREP(22) > 1) { FRESH(); gdn_chunked<true>(C, l, C.wg - 192); } FRESH(); gdn_chunked<false>(C, l, C.wg - 192); }
            FRESH(); CONV_QUEUES(1 << 30);
            SEAM(pb + 5);
        }
        PHASE(5, 6) { FRESH();
            if (SK(8)) finish_rows(C, l, nrows);
            SEAM(pb + 6);
        }
        if (PM(6) && IN(pb + 7)) { FRESH();
            pg8::Gemm g{WSP(const bf16, WS_HB), WSP(const bf16, WS_WOUT), nrows, 1024, 1024, 0};
            pg8::TailHalfOrder S; S.init(nrows, C.G, C.wg);
            pg8::EpiRes E{xlat, xctx, xmid, WSP(float, WS_XC), modv + 2 * 1024, xbf, true};
            pg8::gemm_phase<pg8::EpiRes, pg8::TailHalfOrder, false>(C.lds, g, S, E, nullptr);
            SEAM(pb + 7);
        }
        if (PM(7) && IN(pb + 8)) { FRESH();
            if (moe) norm_rows<true>(C, l, xmid, true, WSP(const float, WS_XC), C.in[I_NFFNG] + l * 1024, 3 * 1024, 4 * 1024, nrows, l >> 1);
            else norm_rows<false>(C, l, xmid, true, WSP(const float, WS_XC), C.in[I_NFFNG] + l * 1024, 3 * 1024, 4 * 1024, nrows, 0);
            SEAM(pb + 8);
        }
        if (!moe) {
            if (PM(8) && IN(pb + 9)) for (int rep_ = 0; rep_ < NREP(8); ++rep_) { FRESH();
                pg8::Gemm g{WSP(const bf16, WS_HB), WSP(const bf16, WS_WGU), nrows, 2 * DFF, 1024, 0};
                pg8::StaticOrder S; S.init(nrows, 2 * DFF, C.G, C.wg);
                pg8::EpiSwiglu E{WSP(bf16, WS_P), DFF};
                pg8::gemm_phase<pg8::EpiSwiglu, pg8::StaticOrder, false>(C.lds, g, S, E, nullptr);
                SEAM(pb + 9);
            }
            if (PM(9) && IN(pb + 10)) { FRESH();
                pg8::Gemm g{WSP(const bf16, WS_P), WSP(const bf16, WS_WDN), nrows, 1024, DFF, 0};
                pg8::TailHalfOrder S; S.init(nrows, C.G, C.wg);
                pg8::EpiRes E{xmid, WSP(const float, WS_XC), xmid, WSP(float, WS_XC), modv + 5 * 1024, true, true};
                pg8::gemm_phase<pg8::EpiRes, pg8::TailHalfOrder, false>(C.lds, g, S, E, nullptr);
                SEAM(pb + 12);
            }
        } else {
            if (PM(10) && IN(pb + 9)) { FRESH(); moe_scatter(C, l >> 1, nrows); SEAM(pb + 9); }
            if (PM(11) && IN(pb + 10)) for (int rep_ = 0; rep_ < NREP(11); ++rep_) { FRESH();
                pg8::Gemm g{WSP(const bf16, WS_HB), WSP(const bf16, WS_WGU), 0, 2 * DFE, 1024, (size_t)2 * DFE * 1024};
                pg8::MoeOrderG S; S.init(WSP(const int, WS_TAB), (2 * DFE) / 256, C.G, C.wg); S.tok = WSP(const int, WS_TOK);
                pg8::EpiSwiglu E{WSP(bf16, WS_P), DFE};
                pg8::gemm_phase<pg8::EpiSwiglu, pg8::MoeOrderG, false>(C.lds, g, S, E, nullptr);
                SEAM(pb + 10);
            }
            if (PM(12) && IN(pb + 11)) for (int rep_ = 0; rep_ < NREP(12); ++rep_) { FRESH();
                pg8::Gemm g{WSP(const bf16, WS_P), WSP(const bf16, WS_WDN), 0, 1024, DFE, (size_t)1024 * DFE};
                pg8::MoeOrder S; S.init(WSP(const int, WS_TAB), 4, C.G, C.wg);
                pg8::EpiBf16<0> E{WSP(bf16, WS_MIX), 1024, nullptr, 0, 0};
                pg8::gemm_phase<pg8::EpiBf16<0>, pg8::MoeOrder, false>(C.lds, g, S, E, nullptr);
                SEAM(pb + 11);
            }
            if (PM(13) && IN(pb + 12)) { FRESH();
                if (last) moe_combine<2>(C, l, nrows);
                else { convert_small(C, l + 1); FRESH(); moe_combine<1>(C, l, nrows); if (IN(pb + NPH_L + 1)) { XcdBarrier b2_; b2_.bar = WSP(unsigned, WS_CTL) + CW_BAR; b2_.x = xb_xcc_id(); b2_.st = (volatile LAS unsigned*)(C.lds + MISC_OFF) + 8; xcd_barrier(b2_); } }
            }
        }
    }
}

extern "C" void kernel_launch(void* const* d_in, const int* in_sizes, int n_in, void* d_out, int out_size, void* d_ws, size_t ws_size, hipStream_t stream) {
    static int grid = 0;
    if (grid == 0) {
        if (n_in != N_IN || in_sizes[0] != T_LAT * DM || out_size != T_LAT * DM || ws_size < WS_END) {
            fprintf(stderr, "kernel_launch: unexpected problem (n_in %d, in0 %d, out %d, ws %zu < %zu)\n", n_in, n_in > 0 ? in_sizes[0] : -1, out_size, ws_size, (size_t)WS_END); grid = -1; return; }
        int dev = 0, cus = 0, per_cu = 0;
        if (hipGetDevice(&dev) != hipSuccess || hipDeviceGetAttribute(&cus, hipDeviceAttributeMultiprocessorCount, dev) != hipSuccess) { grid = -1; return; }
        if (hipFuncSetAttribute((const void*)fwd_kernel, hipFuncAttributeMaxDynamicSharedMemorySize, LDS_BYTES) != hipSuccess) { fprintf(stderr, "kernel_launch: hipFuncSetAttribute failed\n"); grid = -1; return; }
        if (hipOccupancyMaxActiveBlocksPerMultiprocessor(&per_cu, (const void*)fwd_kernel, NTHR, LDS_BYTES) != hipSuccess || per_cu < 1) { fprintf(stderr, "kernel_launch: occupancy query says %d\n", per_cu); grid = -1; return; }
        grid = cus;
        if (grid != 256) fprintf(stderr, "kernel_launch: note: %d CUs\n", grid);
    }
    if (grid < 0) return;
    if (hipMemsetAsync((char*)d_ws + WS_CTL, 0, CTL_BYTES, stream) != hipSuccess) return;
    Args a{};
    for (int i = 0; i < N_IN; ++i) a.in[i] = (const float*)d_in[i];
    a.out = (float*)d_out; a.ws = (unsigned char*)d_ws;
#if MK_ONE_LAUNCH
    a.ph_lo = 0; a.ph_hi = NPHASE;
    hipLaunchKernelGGL(fwd_kernel, dim3(grid), dim3(NTHR), LDS_BYTES, stream, a);
#else
    for (int ph = 0; ph < NPHASE; ++ph) { if (!phase_exists(ph)) continue; a.ph_lo = ph; a.ph_hi = ph + 1; hipLaunchKernelGGL(fwd_kernel, dim3(grid), dim3(NTHR), LDS_BYTES, stream, a); }
#endif
}
```

```cpp
#define MK_ONE_LAUNCH 1
#include <hip/hip_runtime.h>
#include <cstdio>
#include <cstdint>

#define GAS __attribute__((address_space(1)))
#define LAS __attribute__((address_space(3)))
typedef unsigned short bf16;
typedef unsigned v4u __attribute__((ext_vector_type(4)));
typedef unsigned v2u __attribute__((ext_vector_type(2)));
typedef float f32x4 __attribute__((ext_vector_type(4)));
typedef float f32x2 __attribute__((ext_vector_type(2)));
typedef short bf16x8 __attribute__((ext_vector_type(8)));
#define LDS_WAIT() asm volatile("s_waitcnt lgkmcnt(0)" ::: "memory")
#define VM_WAIT() asm volatile("s_waitcnt vmcnt(0)" ::: "memory")

constexpr int DM = 1024, NB = 8, SEQ = 4096, DEPTH = 4, CTXL = 256, GW = 256, HD = 64, NH = 4;
constexpr int T_LAT = NB * SEQ, T_CTX = NB * CTXL, T_ALL = T_LAT + T_CTX;
constexpr int IN_COLS = 3552, PLD = 3584;
constexpr int OFF_B = 512, OFF_C = 1472, OFF_D = 2512, B_COLS = 960;
constexpr int DFF = 2816, NE = 8, DFE = 1408;
constexpr int NCH = 68;
constexpr int NSTEP = 4352;
constexpr int MOE_MAXBLK = 280;
constexpr int NWAVES = 8, NTHR = 512;
#ifndef RW_VSPLIT
#define RW_VSPLIT 0
#endif

constexpr size_t MiB = 1u << 20;
constexpr size_t WS_CTL = 0, CTL_BYTES = 1 * MiB;
constexpr size_t WS_MODV = 1 * MiB;
constexpr size_t WS_XC = 2 * MiB;
constexpr size_t WS_WIN = 10 * MiB;
constexpr size_t WS_WOUT = 17 * MiB;
constexpr size_t WS_WGU = 19 * MiB;
constexpr size_t WS_WDN = 63 * MiB;
constexpr size_t WS_HB = 85 * MiB;
constexpr size_t WS_P = 153 * MiB;
constexpr size_t WS_MIX = 391 * MiB;
constexpr size_t WS_OUTB = WS_MIX, WS_OUTC = WS_MIX + 34 * MiB, WS_OUTD = WS_MIX + 68 * MiB, WS_GQ = WS_MIX + 102 * MiB, WS_G = WS_MIX + 153 * MiB;
constexpr size_t WS_XLAST = WS_MIX + 144 * MiB;
constexpr size_t WS_RKV = WS_MIX + 170 * MiB;
constexpr size_t WS_SMALL = 612 * MiB;
constexpr size_t WS_ROUTE = WS_SMALL;
constexpr size_t WS_POS = WS_SMALL + 1280 * 1024;
constexpr size_t WS_TOK = WS_SMALL + 1664 * 1024;
constexpr size_t WS_BONUS = WS_SMALL + 2 * MiB;
constexpr size_t WS_RINV = WS_SMALL + 2 * MiB + 640 * 1024;
constexpr size_t WS_WGBASE = WS_SMALL + 3 * MiB + 256 * 1024;
constexpr size_t WS_TAB = WS_WGBASE + 65536;
constexpr size_t WS_LRUWT = WS_SMALL + 3 * MiB + 512 * 1024;
constexpr size_t WS_RWT = WS_LRUWT + 131072;
constexpr size_t WS_LRUH = WS_SMALL + 4 * MiB;
constexpr size_t WS_END = 633 * MiB;
constexpr int CW_MOECNT = 1024;
constexpr int CW_PREPQ = 2048;
constexpr int CW_BAR = 4096;

constexpr int LDS_BYTES = 135168;
constexpr int MISC_OFF = 131072;

__device__ __forceinline__ unsigned f2bf(float f) { unsigned u = __builtin_bit_cast(unsigned, f); return (u + 0x7fffu + ((u >> 16) & 1u)) >> 16; }
typedef __bf16 bf16n2 __attribute__((ext_vector_type(2)));
__device__ __forceinline__ unsigned pk2(float lo, float hi) { const f32x2 v = {lo, hi}; return __builtin_bit_cast(unsigned, __builtin_convertvector(v, bf16n2)); }
__device__ __forceinline__ unsigned f2bf1(float f) { return pk2(f, f) & 0xffffu; }
__device__ __forceinline__ float bf2f(unsigned short v) { return __builtin_bit_cast(float, (unsigned)v << 16); }
__device__ __forceinline__ float bflo(unsigned v) { return __builtin_bit_cast(float, v << 16); }
__device__ __forceinline__ float bfhi(unsigned v) { return __builtin_bit_cast(float, v & 0xffff0000u); }
template <int CTRL, int RM, bool BC> __device__ __forceinline__ float dpp_x(float oldv, float v) { return __builtin_bit_cast(float, __builtin_amdgcn_update_dpp(__builtin_bit_cast(int, oldv), __builtin_bit_cast(int, v), CTRL, RM, 0xF, BC)); }
__device__ __forceinline__ float wave_sum(float v) {
    v += dpp_x<0xB1, 0xF, true>(0.f, v); v += dpp_x<0x4E, 0xF, true>(0.f, v); v += dpp_x<0x141, 0xF, true>(0.f, v); v += dpp_x<0x140, 0xF, true>(0.f, v);
    v += dpp_x<0x142, 0xA, false>(0.f, v); v += dpp_x<0x143, 0xC, false>(0.f, v);
    return __builtin_bit_cast(float, __builtin_amdgcn_readlane(__builtin_bit_cast(int, v), 63));
}
template <int CTRL> __device__ __forceinline__ float dpp_f(float v) { return __builtin_bit_cast(float, __builtin_amdgcn_update_dpp(0, __builtin_bit_cast(int, v), CTRL, 0xF, 0xF, true)); }
__device__ __forceinline__ float row16_sum(float v) {
    v += dpp_f<0xB1>(v);
    v += dpp_f<0x4E>(v);
    v += dpp_f<0x141>(v);
    v += dpp_f<0x140>(v);
    return v;
}
__device__ __forceinline__ float sigmoidf_(float x) { return __builtin_amdgcn_rcpf(1.0f + __expf(-x)); }
__device__ __forceinline__ float softplusf_(float x) { return fmaxf(x, 0.f) + __logf(1.0f + __expf(-fabsf(x))); }
__device__ __forceinline__ float expm1f_(float x) { return x > -0.3f ? x * (1.0f + x * (0.5f + x * (0.16666667f + x * (0.041666668f + x * 0.0083333338f)))) : __expf(x) - 1.0f; }
__device__ __forceinline__ float siluf_(float x) { return x * __builtin_amdgcn_rcpf(1.0f + __expf(-x)); }
__device__ __forceinline__ float tanhf_(float x) { const float e = __expf(2.0f * x); return 1.0f - 2.0f * __builtin_amdgcn_rcpf(e + 1.0f); }
__device__ __forceinline__ float rsqrtf_(float x) { return __builtin_amdgcn_rsqf(x); }
__device__ __forceinline__ float gelu_tanh(float x) { return 0.5f * x * (1.0f + tanhf_(0.7978845608028654f * (x + 0.044715f * x * x * x))); }
__device__ __forceinline__ f32x4 ld4bf(const bf16* p) { const v2u a = *(const v2u*)p; return (f32x4){bflo(a.x), bfhi(a.x), bflo(a.y), bfhi(a.y)}; }
__device__ __forceinline__ void st4bf(bf16* p, const f32x4& v) { v2u o; o.x = pk2(v.x, v.y); o.y = pk2(v.z, v.w); *(v2u*)p = o; }
#define XB_TMO      128
#define XB_XCNT(j)  (256  + 64 * (j))
#define XB_XSUB(j)  (1280 + 64 * (j))
#define XB_XGEN(j)  (2304 + 64 * (j))
#define XB_TOP      3328
#define XB_TOPGEN   3392
#define XCD_BAR_WORDS 3456
#define XB_SPIN_CAP (1u << 22)

__device__ __forceinline__ unsigned xb_ld(unsigned* p)              { return __hip_atomic_load(p, __ATOMIC_RELAXED, __HIP_MEMORY_SCOPE_AGENT); }
__device__ __forceinline__ unsigned xb_add(unsigned* p, unsigned v) { return __hip_atomic_fetch_add(p, v, __ATOMIC_RELAXED, __HIP_MEMORY_SCOPE_AGENT); }
__device__ __forceinline__ unsigned xb_xcc_id() { return (unsigned)__builtin_amdgcn_s_getreg((3 << 11) | 20) & 0xFu; }
#define XB_SPIN(cond, bar) do { unsigned _sp = 0; while (cond) { __builtin_amdgcn_s_sleep(1); \
    if ((++_sp & 255u) == 0u) { if (xb_ld(&(bar)[XB_TMO])) break; if (_sp > XB_SPIN_CAP) { atomicAdd(&(bar)[XB_TMO], 1u); break; } } } } while (0)

struct XcdBarrier {
    unsigned* bar; unsigned x;
    volatile LAS unsigned* st;
};

__device__ __forceinline__ XcdBarrier xcd_barrier_post(unsigned* bar, volatile LAS unsigned* st) {
    XcdBarrier b; b.bar = bar; b.x = xb_xcc_id(); b.st = st;
    if (threadIdx.x == 0) (void)xb_add(&bar[XB_XCNT(b.x)], 1u);
    return b;
}
__device__ __forceinline__ void xcd_barrier_complete(unsigned* bar, unsigned x, unsigned& nloc, unsigned& nx) {
    const unsigned G = gridDim.x * gridDim.y * gridDim.z;
    unsigned sum, cnt, mine, sp = 0u;
    for (;;) {
        sum = 0u; cnt = 0u; mine = 0u;
#pragma unroll
        for (unsigned j = 0; j < 16; ++j) { const unsigned c = xb_ld(&bar[XB_XCNT(j)]); sum += c; cnt += (c > 0u) ? 1u : 0u; mine = (j == x) ? c : mine; }
        if (sum == G) break;
        __builtin_amdgcn_s_sleep(1);
        if ((++sp & 255u) == 0u) { if (xb_ld(&bar[XB_TMO])) break; if (sp > XB_SPIN_CAP) { atomicAdd(&bar[XB_TMO], 1u); break; } }
    }
    nloc = mine > 0u ? mine : 1u; nx = cnt > 0u ? cnt : 1u;
}

__device__ __forceinline__ void xcd_barrier(const XcdBarrier& b) {
    asm volatile("s_waitcnt vmcnt(0)" ::: "memory");
    __syncthreads();
    if (threadIdx.x == 0) {
        unsigned* bar = b.bar;
        __builtin_amdgcn_s_waitcnt(0);
        unsigned nloc = b.st[0], nx = b.st[1];
        if (nloc == 0u) { xcd_barrier_complete(bar, b.x, nloc, nx); b.st[0] = nloc; b.st[1] = nx; }
        const unsigned old = xb_add(&bar[XB_XSUB(b.x)], 1u);
        const unsigned gen = old / nloc;
        if (old + 1u == (gen + 1u) * nloc) {
            __builtin_amdgcn_fence(__ATOMIC_RELEASE, "agent");
            asm volatile("s_waitcnt vmcnt(0)" ::: "memory");
            const unsigned og = xb_add(&bar[XB_TOP], 1u);
            const unsigned tg = og / nx;
            if (og + 1u == (tg + 1u) * nx) xb_add(&bar[XB_TOPGEN], 1u);
            else XB_SPIN(xb_ld(&bar[XB_TOPGEN]) == tg, bar);
            __builtin_amdgcn_fence(__ATOMIC_ACQUIRE, "agent");
            xb_add(&bar[XB_XGEN(b.x)], 1u);
            asm volatile("s_waitcnt vmcnt(0)" ::: "memory");
        } else {
            XB_SPIN(xb_ld(&bar[XB_XGEN(b.x)]) == gen, bar);
            __builtin_amdgcn_fence(__ATOMIC_ACQUIRE, "agent");
            asm volatile("s_waitcnt vmcnt(0)" ::: "memory");
        }
    }
    __syncthreads();
}

namespace pg8 {
#define PG8_LAS __attribute__((address_space(3)))
typedef unsigned short bf16_t;
typedef short bf16x8 __attribute__((ext_vector_type(8)));
typedef float f32x4 __attribute__((ext_vector_type(4)));
typedef unsigned u32x4 __attribute__((ext_vector_type(4)));
constexpr int BM = 256, BK = 64, HALF = 128, HTB = HALF * BK * 2  , STAGE_BYTES = 8 * HTB, NXCD = 8, WGM = 8;

__host__ __device__ __forceinline__ int lds_byte(int r, int c) { const int st = (r >> 4) * 2 + (c >> 5), rr = r & 15, cc = c & 31, ob = rr * 64 + cc * 2; return st * 1024 + (ob ^ (((ob >> 9) & 1) << 5)); }
__host__ __device__ __forceinline__ void stage_rc(int b, int& R, int& C) { const int st = b / 1024, sb = b % 1024, swz = sb ^ (((sb >> 9) & 1) << 5); R = (st >> 1) * 16 + swz / 64; C = (st & 1) * 32 + (swz % 64) / 2; }
__host__ __device__ __forceinline__ int perm32(int rho) { const int n = rho >> 4, i = rho & 15; return 8 * (i >> 2) + 4 * n + (i & 3); }

struct Unit { int pm, pn, e; };
struct Gemm { const bf16_t* A; const bf16_t* Bt; int M, N, K; size_t estride; };

struct StaticOrder {
    static constexpr bool GATHER = false, HALFS = false;
    int nM, nN, nwg, G, c;
    __host__ __device__ void init(int M, int N, int G_, int c_) { nM = M / BM; nN = N / BM; nwg = nM * nN; G = G_; c = c_; }
    __host__ __device__ bool next(int i, Unit& u) const {
        const long L = (long)i * G + c; if (L >= nwg) return false;
        int wgid = (int)L; { const int q = nwg / NXCD, r = nwg % NXCD, xcd = wgid % NXCD, off = wgid / NXCD; wgid = (xcd < r ? xcd * (q + 1) : r * (q + 1) + (xcd - r) * q) + off; }
        const int nig = WGM * nN, gid = wgid / nig, fm = gid * WGM, gsz = (nM - fm) < WGM ? (nM - fm) : WGM;
        u.pm = fm + ((wgid % nig) % gsz); u.pn = (wgid % nig) / gsz; u.e = 0; return true;
    }
    __device__ __forceinline__ void a_ready(const Unit&) const {}
    __device__ __forceinline__ void done(const Unit&) const {}
};
struct TailHalfOrder {
    static constexpr bool GATHER = false, HALFS = true;
    int nM, nwg, G, c, ntail;
    __device__ __forceinline__ void init(int M, int G_, int c_) { const int nMall = M / BM; nM = nMall >= 128 ? 128 : nMall; nwg = nM * 4; ntail = nMall - nM; G = G_; c = c_; }
    __device__ __forceinline__ bool next(int i, Unit& u) const {
        const int L = i * G + c;
        if (L < nwg) {
            int wgid = L; { const int q = nwg / NXCD, r = nwg % NXCD, xcd = wgid % NXCD, off = wgid / NXCD; wgid = (xcd < r ? xcd * (q + 1) : r * (q + 1) + (xcd - r) * q) + off; }
            const int nig = WGM * 4, gid = wgid / nig, fm = gid * WGM, gsz = (nM - fm) < WGM ? (nM - fm) : WGM;
            u.pm = fm + ((wgid % nig) % gsz); u.pn = (wgid % nig) / gsz; u.e = 0; return true;
        }
        const int t = L - nwg; if (t >= ntail * 8) return false;
        const int nh = t / ntail; u.pm = 128 + (t - nh * ntail); u.pn = (nh >> 1) | ((1 + (nh & 1)) << 8); u.e = 0; return true;
    }
    __device__ __forceinline__ void a_ready(const Unit&) const {}
    __device__ __forceinline__ void done(const Unit&) const {}
};
typedef __bf16 bf16n2_ __attribute__((ext_vector_type(2)));
__device__ __forceinline__ unsigned cvt_pk_bf16(float lo, float hi) { typedef float f2_ __attribute__((ext_vector_type(2))); const f2_ v = {lo, hi}; return __builtin_bit_cast(unsigned, __builtin_convertvector(v, bf16n2_)); }
typedef float f32x2 __attribute__((ext_vector_type(2)));
__device__ __forceinline__ f32x2 gelu_pk(f32x2 v) {
    const f32x2 av = __builtin_elementwise_abs(v), d = av * 0.2316418882f + 1.0f;
    f32x2 t; t.x = __builtin_amdgcn_rcpf(d.x); t.y = __builtin_amdgcn_rcpf(d.y);
    f32x2 q = t * 0.5307027145f + (-0.7265760135f); q = q * t + 0.7107068705f; q = q * t + (-0.142248368f); q = q * t + 0.127414796f; q = q * t;
    const f32x2 s = (v * v) * (-0.72134752044f);
    f32x2 e; e.x = __builtin_amdgcn_exp2f(s.x); e.y = __builtin_amdgcn_exp2f(s.y);
    const f32x2 m = v * (q * e), r = v - m;
    f32x2 o; o.x = v.x < 0.f ? m.x : r.x; o.y = v.y < 0.f ? m.y : r.y; return o;
}

struct EpiF32 {
    static constexpr bool PERM = false, AFTER_DRAIN = false;
    float* C; int ldc; const float* bias;
    __device__ __forceinline__ void operator()(const f32x4 (&acc)[2][2][4][2], const Unit& u, int wr, int wc, int fr, int fq) const {
        const int row0 = u.pm * BM + wr * 64 + fr, col0 = u.pn * BM + wc * 32 + 4 * fq;
        f32x4 bv[2][2];
#pragma unroll
        for (int bj = 0; bj < 2; ++bj)
#pragma unroll
            for (int n = 0; n < 2; ++n) bv[bj][n] = bias ? *(const f32x4*)(bias + col0 + bj * HALF + n * 16) : (f32x4){0.f, 0.f, 0.f, 0.f};
#pragma unroll
        for (int ai = 0; ai < 2; ++ai)
#pragma unroll
            for (int m = 0; m < 4; ++m) { float* rowp = C + (size_t)(row0 + ai * HALF + m * 16) * ldc + col0;
#pragma unroll
                for (int bj = 0; bj < 2; ++bj)
#pragma unroll
                    for (int n = 0; n < 2; ++n) *(f32x4*)(rowp + bj * HALF + n * 16) = acc[ai][bj][m][n] + bv[bj][n]; }
    }
};
template <int ACT  > struct EpiBf16 {
    static constexpr bool PERM = true, AFTER_DRAIN = false;
    bf16_t* O; int ldc; const float* bias; int split_cols; size_t split_stride;
    __device__ __forceinline__ void operator()(const f32x4 (&acc)[2][2][4][2], const Unit& u, int wr, int wc, int fr, int fq) const {
        const int row0 = u.pm * BM + wr * 64 + fr; int colt = u.pn * BM; bf16_t* base = O;
        if (split_cols) { const int t = colt / split_cols; base += (size_t)t * split_stride; colt -= t * split_cols; }
        const int col0 = colt + wc * 32 + 8 * fq, bcol0 = u.pn * BM + wc * 32 + 8 * fq;
        f32x4 bv[2][2];
#pragma unroll
        for (int bj = 0; bj < 2; ++bj)
#pragma unroll
            for (int n = 0; n < 2; ++n) bv[bj][n] = bias ? *(const f32x4*)(bias + bcol0 + bj * HALF + 4 * n) : (f32x4){0.f, 0.f, 0.f, 0.f};
#pragma unroll
        for (int ai = 0; ai < 2; ++ai)
#pragma unroll
            for (int m = 0; m < 4; ++m) { bf16_t* rowp = base + (size_t)(row0 + ai * HALF + m * 16) * ldc + col0;
#pragma unroll
                for (int bj = 0; bj < 2; ++bj) { f32x4 v0 = acc[ai][bj][m][0] + bv[bj][0], v1 = acc[ai][bj][m][1] + bv[bj][1];
                    if (ACT == 1) { f32x2 a = gelu_pk((f32x2){v0[0], v0[1]}), b = gelu_pk((f32x2){v0[2], v0[3]}), c = gelu_pk((f32x2){v1[0], v1[1]}), d = gelu_pk((f32x2){v1[2], v1[3]});
                        v0 = (f32x4){a.x, a.y, b.x, b.y}; v1 = (f32x4){c.x, c.y, d.x, d.y}; }
                    if (ACT == 2) {
#pragma unroll
                        for (int j = 0; j < 4; ++j) { v0[j] = 0.5f * v0[j] * (1.0f + erff(v0[j] * 0.70710678f)); v1[j] = 0.5f * v1[j] * (1.0f + erff(v1[j] * 0.70710678f)); } }
                    u32x4 w; w.x = cvt_pk_bf16(v0[0], v0[1]); w.y = cvt_pk_bf16(v0[2], v0[3]); w.z = cvt_pk_bf16(v1[0], v1[1]); w.w = cvt_pk_bf16(v1[2], v1[3]);
                    *(u32x4*)(rowp + bj * HALF) = w; } }
    }
};

template <class Epi, class Sched, bool STAMP = false>
__device__ __forceinline__ void gemm_phase(PG8_LAS unsigned char* lds, const Gemm g, const Sched& S, const Epi& E, unsigned long long* stamps) {
    int tid_ = threadIdx.x; asm volatile("" : "+v"(tid_));
    const int tid = tid_, wid = __builtin_amdgcn_readfirstlane(tid >> 6), lane = tid & 63, wr = wid >> 2, wc = wid & 3, fr = lane & 15, fq = lane >> 4;
    const int K = g.K, nt = K / BK;
    constexpr bool GATHER = Sched::GATHER; constexpr bool HALFS = Sched::HALFS;
    int ts_lo = 0, ts_hi = 0, nts = 0; const unsigned long long rt_entry = STAMP ? (unsigned long long)wall_clock64() : 0ull;
#define PG8_STAMP() do { if (STAMP && wid == 0 && nts < 64) { const unsigned long long _c = (unsigned long long)clock64(); \
        ts_lo = (lane == nts) ? (int)(unsigned)_c : ts_lo; ts_hi = (lane == nts) ? (int)(unsigned)(_c >> 32) : ts_hi; ++nts; } } while (0)
    PG8_STAMP();
    unsigned voffA[2], voffB[2]; int rowA[2];
#pragma unroll
    for (int i = 0; i < 2; ++i) { int R, C; stage_rc(tid * 16 + i * 8192, R, C); const int Rb = Epi::PERM ? ((R & ~31) + perm32(R & 31)) : R;
        rowA[i] = R; voffA[i] = GATHER ? (unsigned)C * 2u : (unsigned)(R * K + C) * 2u; voffB[i] = (unsigned)(Rb * K + C) * 2u; }
    const size_t kstep = (size_t)(BK * 2);
    const size_t hstep = (size_t)HALF * K * 2;
    const size_t tstep = 2 * hstep;
    const unsigned ldsw = (unsigned)wid * 1024u;
    const int aoff = lds_byte(wr * 64 + fr, fq * 8), boff = lds_byte(wc * 32 + fr, fq * 8);
#define PG8_SA(b, h) (((b) * 2 + (h)) * HTB)
#define PG8_SB(b, h) ((4 + (b) * 2 + (h)) * HTB)
#define PG8_STAGE(bufoff, gbase, voff) do { _Pragma("unroll") for (int _i = 0; _i < 2; ++_i) \
        __builtin_amdgcn_global_load_lds((const unsigned*)((const char*)(gbase) + (voff)[_i]), (PG8_LAS unsigned*)(lds + (bufoff) + ldsw + _i * 8192), 16, 0, 0); } while (0)
#define PG8_STAGE_A(bufoff, gbase, h, gv) do { if constexpr (GATHER) { PG8_STAGE(bufoff, gbase, (gv)[h]); } else { PG8_STAGE(bufoff, (gbase) + (h) * hstep, voffA); } } while (0)
#define PG8_TOKSLOT(s) ((PG8_LAS int*)(lds + STAGE_BYTES + 1024 + ((s) & 1) * 1024))
#define PG8_LDA(dst, b, h) do { _Pragma("unroll") for (int m = 0; m < 4; ++m) _Pragma("unroll") for (int k = 0; k < 2; ++k) dst[m][k] = *(const PG8_LAS bf16x8*)(lds + PG8_SA(b, h) + aoff + m * 2048 + k * 1024); } while (0)
#define PG8_LDB(dst, b, h) do { _Pragma("unroll") for (int n = 0; n < 2; ++n) _Pragma("unroll") for (int k = 0; k < 2; ++k) dst[n][k] = *(const PG8_LAS bf16x8*)(lds + PG8_SB(b, h) + boff + n * 2048 + k * 1024); } while (0)
#define PG8_MMA(ai, bj, At, Bt) do { __builtin_amdgcn_s_setprio(1); _Pragma("unroll") for (int m = 0; m < 4; ++m) _Pragma("unroll") for (int n = 0; n < 2; ++n) _Pragma("unroll") for (int k = 0; k < 2; ++k) \
        acc[ai][bj][m][n] = __builtin_amdgcn_mfma_f32_16x16x32_bf16(Bt[n][k], At[m][k], acc[ai][bj][m][n], 0, 0, 0); __builtin_amdgcn_s_setprio(0); } while (0)
#define PG8_WAIT_V(n) asm volatile("s_waitcnt vmcnt(" #n ")" ::: "memory")
#define PG8_WAIT_L(n) asm volatile("s_waitcnt lgkmcnt(" #n ")" ::: "memory")
#define PG8_BAR __builtin_amdgcn_s_barrier()
#define PG8_SCHED __builtin_amdgcn_sched_barrier(0)
    Unit cur, nxt; int ui = 0;
    if (!S.next(0, cur)) return;
    f32x4 acc[2][2][4][2];
#pragma unroll
    for (int a = 0; a < 2; ++a)
#pragma unroll
        for (int b = 0; b < 2; ++b)
#pragma unroll
            for (int m = 0; m < 4; ++m)
#pragma unroll
                for (int n = 0; n < 2; ++n) acc[a][b][m][n] = (f32x4){0.f, 0.f, 0.f, 0.f};
    bf16x8 At[4][2], B0[2][2], B1[2][2];
    const char* cA = (const char*)g.A + (GATHER ? (size_t)0 : (size_t)cur.pm * tstep); const char* cB = (const char*)g.Bt + (size_t)(HALFS ? cur.pn & 255 : cur.pn) * tstep + (size_t)cur.e * g.estride * 2 + ((HALFS && (cur.pn >> 8) == 2) ? hstep : (size_t)0);
    S.a_ready(cur);
    unsigned gcur[2][2], gnxt[2][2], gs[2][2];
    if constexpr (GATHER) {
        if (tid < 256) PG8_TOKSLOT(0)[tid] = S.tok[cur.pm * 256 + tid];
        __syncthreads();
#pragma unroll
        for (int h = 0; h < 2; ++h)
#pragma unroll
            for (int i = 0; i < 2; ++i) { gcur[h][i] = (unsigned)PG8_TOKSLOT(0)[h * HALF + rowA[i]] * (unsigned)(K * 2) + voffA[i]; gnxt[h][i] = gcur[h][i]; gs[h][i] = gcur[h][i]; }
    }
    PG8_STAGE(PG8_SB(0, 0), cB, voffB); PG8_STAGE_A(PG8_SA(0, 0), cA, 0, gcur); PG8_STAGE(PG8_SB(0, 1), cB + hstep, voffB); PG8_STAGE_A(PG8_SA(0, 1), cA, 1, gcur);
    if (wr == 1) PG8_BAR;
    PG8_WAIT_V(4); PG8_BAR;
    PG8_STAGE(PG8_SB(1, 0), cB + kstep, voffB); PG8_STAGE_A(PG8_SA(1, 0), cA + kstep, 0, gcur); PG8_STAGE(PG8_SB(1, 1), cB + hstep + kstep, voffB);
    PG8_WAIT_V(6); PG8_BAR;
    PG8_STAMP();
    for (;;) {
        const bool has_next = S.next(ui + 1, nxt);
        if constexpr (GATHER) { if (has_next && wid < 4)
            __builtin_amdgcn_global_load_lds((const unsigned*)(S.tok + nxt.pm * 256 + wid * 64 + lane), (PG8_LAS unsigned*)((PG8_LAS unsigned char*)PG8_TOKSLOT(ui + 1) + wid * 256), 4, 0, 0); }
        const char* nA = GATHER ? (const char*)g.A : has_next ? (const char*)g.A + (size_t)nxt.pm * tstep : cA; const char* nB = has_next ? (const char*)g.Bt + (size_t)(HALFS ? nxt.pn & 255 : nxt.pn) * tstep + (size_t)nxt.e * g.estride * 2 + ((HALFS && (nxt.pn >> 8) == 2) ? hstep : (size_t)0) : cB;
        const bool full = !HALFS || (cur.pn >> 8) == 0;
        for (int t = 0; t < nt; t += 2) {
            const bool last = (t == nt - 2);
            const char* a1 = cA + (size_t)(t + 1) * kstep;
            const char* a2 = last ? nA : cA + (size_t)(t + 2) * kstep; const char* b2 = last ? nB : cB + (size_t)(t + 2) * kstep;
            const char* a3 = a2 + kstep; const char* b3 = b2 + kstep;
            if (last && has_next) S.a_ready(nxt);
            if constexpr (GATHER) {
                if (last && has_next) {
#pragma unroll
                    for (int h = 0; h < 2; ++h)
#pragma unroll
                        for (int i = 0; i < 2; ++i) gnxt[h][i] = (unsigned)PG8_TOKSLOT(ui + 1)[h * HALF + rowA[i]] * (unsigned)(K * 2) + voffA[i];
                }
#pragma unroll
                for (int h = 0; h < 2; ++h)
#pragma unroll
                    for (int i = 0; i < 2; ++i) gs[h][i] = last ? gnxt[h][i] : gcur[h][i];
            }
            PG8_LDB(B0, 0, 0); PG8_SCHED; PG8_LDA(At, 0, 0); PG8_STAGE_A(PG8_SA(1, 1), a1, 1, gcur);
            PG8_WAIT_L(8); PG8_BAR; PG8_WAIT_L(0); PG8_MMA(0, 0, At, B0); PG8_BAR; PG8_SCHED;
            if (full) PG8_LDB(B1, 0, 1); PG8_STAGE(PG8_SB(0, 0), b2, voffB);
            PG8_BAR; PG8_WAIT_L(0); if (full) PG8_MMA(0, 1, At, B1); PG8_BAR;
            PG8_LDA(At, 0, 1); PG8_STAGE_A(PG8_SA(0, 0), a2, 0, gs);
            PG8_BAR; PG8_WAIT_L(0); PG8_MMA(1, 0, At, B0); PG8_BAR; PG8_SCHED;
            PG8_STAGE(PG8_SB(0, 1), b2 + hstep, voffB);
            PG8_WAIT_V(6); PG8_BAR; if (full) PG8_MMA(1, 1, At, B1); PG8_BAR;
            PG8_LDB(B0, 1, 0); PG8_SCHED; PG8_LDA(At, 1, 0); PG8_STAGE_A(PG8_SA(0, 1), a2, 1, gs);
            PG8_WAIT_L(8); PG8_BAR; PG8_WAIT_L(0); PG8_MMA(0, 0, At, B0); PG8_BAR; PG8_SCHED;
            if (full) PG8_LDB(B1, 1, 1); PG8_STAGE(PG8_SB(1, 0), b3, voffB);
            PG8_BAR; PG8_WAIT_L(0); if (full) PG8_MMA(0, 1, At, B1); PG8_BAR;
            PG8_LDA(At, 1, 1); PG8_STAGE_A(PG8_SA(1, 0), a3, 0, gs);
            PG8_BAR; PG8_WAIT_L(0); PG8_MMA(1, 0, At, B0); PG8_BAR; PG8_SCHED;
            PG8_STAGE(PG8_SB(1, 1), b3 + hstep, voffB);
            PG8_WAIT_V(6); PG8_BAR; if (full) PG8_MMA(1, 1, At, B1); PG8_BAR;
        }
        PG8_STAMP();
        if constexpr (!Epi::AFTER_DRAIN) { E(acc, cur, wr, wc, fr, fq); S.done(cur); }
        PG8_STAMP();
        if (!has_next) break;
#pragma unroll
        for (int a = 0; a < 2; ++a)
#pragma unroll
            for (int b = 0; b < 2; ++b)
#pragma unroll
                for (int m = 0; m < 4; ++m)
#pragma unroll
                    for (int n = 0; n < 2; ++n) acc[a][b][m][n] = (f32x4){0.f, 0.f, 0.f, 0.f};
        cur = nxt; cA = nA; cB = nB; ++ui;
        if constexpr (GATHER) {
#pragma unroll
            for (int h = 0; h < 2; ++h)
#pragma unroll
                for (int i = 0; i < 2; ++i) gcur[h][i] = gnxt[h][i];
        }
    }
    PG8_WAIT_V(0);
    if (wr == 0) PG8_BAR;
    PG8_BAR;
    if constexpr (Epi::AFTER_DRAIN) { E.fused(acc, cur, wr, wc, fr, fq, lds, wid, lane); S.done(cur); }
    PG8_STAMP();
    if (STAMP && wid == 0) { stamps[lane] = lane < nts ? (((unsigned long long)(unsigned)ts_hi << 32) | (unsigned)ts_lo) : 0ull;
        if (lane == 62) stamps[62] = rt_entry; if (lane == 63) stamps[63] = (unsigned long long)wall_clock64(); }
#undef PG8_STAMP
#undef PG8_SA
#undef PG8_SB
#undef PG8_STAGE
#undef PG8_STAGE_A
#undef PG8_TOKSLOT
#undef PG8_LDA
#undef PG8_LDB
#undef PG8_MMA
#undef PG8_WAIT_V
#undef PG8_WAIT_L
#undef PG8_BAR
#undef PG8_SCHED
}
}
namespace pg8 {
struct EpiRes {
    static constexpr bool PERM = true, AFTER_DRAIN = false;
    const void* base_lat; const float* base_ctx; void* out_lat; float* out_ctx; const float* gvec; bool base_bf, out_bf;
    __device__ __forceinline__ void operator()(const f32x4 (&acc)[2][2][4][2], const Unit& u, int wr, int wc, int fr, int fq) const {
        const bool isctx = u.pm >= 128;
        const int prow = (isctx ? (u.pm - 128) : u.pm) * BM;
        const float* base = isctx ? base_ctx : (const float*)base_lat; float* out = isctx ? out_ctx : (float*)out_lat;
        const bool bbf = !isctx && base_bf, obf = !isctx && out_bf;
        const float* gv = gvec + (size_t)(isctx ? 8 : (u.pm >> 4)) * 6144;
        const int row0 = prow + wr * 64 + fr, hf = u.pn >> 8, col0 = (u.pn & 255) * BM + (hf == 2 ? HALF : 0) + wc * 32 + 8 * fq;
        f32x4 gvv[2][2];
#pragma unroll
        for (int bj = 0; bj < 2; ++bj)
#pragma unroll
            for (int n = 0; n < 2; ++n) gvv[bj][n] = *(const f32x4*)(gv + col0 + bj * HALF + 4 * n);
#pragma unroll
        for (int ai = 0; ai < 2; ++ai) {
            if (bbf) {
                v4u ra[4][2];
#pragma unroll
                for (int m = 0; m < 4; ++m)
#pragma unroll
                    for (int bj = 0; bj < 2; ++bj) { if (bj == 1 && hf != 0) continue; ra[m][bj] = *(const v4u*)((const bf16*)base_lat + (size_t)(row0 + ai * HALF + m * 16) * 1024 + col0 + bj * HALF); }
#pragma unroll
                for (int m = 0; m < 4; ++m)
#pragma unroll
                    for (int bj = 0; bj < 2; ++bj) { if (bj == 1 && hf != 0) continue; const size_t o2 = (size_t)(row0 + ai * HALF + m * 16) * 1024 + col0 + bj * HALF;
                        const v4u r = ra[m][bj];
                        const f32x4 b0 = (f32x4){bflo(r.x), bfhi(r.x), bflo(r.y), bfhi(r.y)}, b1 = (f32x4){bflo(r.z), bfhi(r.z), bflo(r.w), bfhi(r.w)};
                        const f32x4 v0 = b0 + gvv[bj][0] * acc[ai][bj][m][0], v1 = b1 + gvv[bj][1] * acc[ai][bj][m][1];
                        if (obf) { v4u w; w.x = pk2(v0.x, v0.y); w.y = pk2(v0.z, v0.w); w.z = pk2(v1.x, v1.y); w.w = pk2(v1.z, v1.w); *(v4u*)((bf16*)out_lat + o2) = w; }
                        else { *(f32x4*)(out + o2) = v0; *(f32x4*)(out + o2 + 4) = v1; } }
            } else {
#pragma unroll
                for (int m = 0; m < 4; ++m)
#pragma unroll
                    for (int bj = 0; bj < 2; ++bj) { if (bj == 1 && hf != 0) continue; const size_t o2 = (size_t)(row0 + ai * HALF + m * 16) * 1024 + col0 + bj * HALF;
                        const f32x4 b0 = *(const f32x4*)(base + o2), b1 = *(const f32x4*)(base + o2 + 4);
                        const f32x4 v0 = b0 + gvv[bj][0] * acc[ai][bj][m][0], v1 = b1 + gvv[bj][1] * acc[ai][bj][m][1];
                        if (obf) { v4u w; w.x = pk2(v0.x, v0.y); w.y = pk2(v0.z, v0.w); w.z = pk2(v1.x, v1.y); w.w = pk2(v1.z, v1.w); *(v4u*)((bf16*)out_lat + o2) = w; }
                        else { *(f32x4*)(out + o2) = v0; *(f32x4*)(out + o2 + 4) = v1; } }
            }
        }
    }
};
struct EpiSwiglu {
    static constexpr bool PERM = true, AFTER_DRAIN = false;
    bf16_t* O; int ldc;
    __device__ __forceinline__ void operator()(const f32x4 (&acc)[2][2][4][2], const Unit& u, int wr, int wc, int fr, int fq) const {
        const int row0 = u.pm * BM + wr * 64 + fr, col0 = u.pn * HALF + wc * 32 + 8 * fq;
#pragma unroll
        for (int ai = 0; ai < 2; ++ai)
#pragma unroll
            for (int m = 0; m < 4; ++m) { bf16_t* rowp = O + (size_t)(row0 + ai * HALF + m * 16) * ldc + col0;
                float h[8];
#pragma unroll
                for (int n = 0; n < 2; ++n)
#pragma unroll
                    for (int j = 0; j < 4; ++j) { const float g = acc[ai][0][m][n][j], up = acc[ai][1][m][n][j]; h[n * 4 + j] = g * __builtin_amdgcn_rcpf(1.0f + __expf(-g)) * up; }
                u32x4 w; w.x = cvt_pk_bf16(h[0], h[1]); w.y = cvt_pk_bf16(h[2], h[3]); w.z = cvt_pk_bf16(h[4], h[5]); w.w = cvt_pk_bf16(h[6], h[7]);
                *(u32x4*)rowp = w; }
    }
};
struct MoeOrder {
    static constexpr bool GATHER = false, HALFS = false;
    int nN, G, c, nunits; const int* tab;
    __device__ void init(const int* tab_, int nN_, int G_, int c_) { tab = tab_; nN = nN_; G = G_; c = c_; nunits = tab_[0] * nN_; }
    __device__ bool next(int i, Unit& u) const {
        const int L = i * G + c; if (L >= nunits) return false;
        const int q = nunits / NXCD, r = nunits % NXCD, xcd = L % NXCD, off = L / NXCD;
        const int w = (xcd < r ? xcd * (q + 1) : r * (q + 1) + (xcd - r) * q) + off;
        u.pm = w / nN; u.pn = w - u.pm * nN; u.e = tab[1 + u.pm]; return true;
    }
    __device__ __forceinline__ void a_ready(const Unit&) const {}
    __device__ __forceinline__ void done(const Unit&) const {}
};
struct MoeOrderG : MoeOrder { static constexpr bool GATHER = true; const int* tok; };
}
enum { I_X = 0, I_C, I_CTX, I_CCTX, I_MODW, I_MODB, I_NMIXG, I_NFFNG, I_WIN, I_WOUT, I_LCW, I_LCB, I_LWA, I_LBA, I_LWX, I_LBX, I_LLAM,
       I_RMU, I_RWUP, I_RW0, I_RAUP, I_RA0, I_RGUP, I_RKK, I_RKA, I_RRK, I_RLNG, I_RLNB, I_MIB, I_MFB, I_MNG, I_GCW, I_GALOG, I_GDTB, I_GNG,
       I_FWG, I_FWU, I_FWD, I_MROUTER, I_MWG, I_MWU, I_MWD, I_FNG, N_IN };
struct Args { const float* in[N_IN]; float* out; unsigned char* ws; int ph_lo, ph_hi; };
struct Ctx {
    const float* const* in; float* out; unsigned char* ws; LAS unsigned char* lds;
    int tid, lane, wave, G, wg;
};
#define WSP(T, off) ((T*)(C.ws + (off)))

__device__ __forceinline__ int seqrow_raster(int i, int d, int b) {
    if (i < CTXL) { const int p = d ? (CTXL - 1 - i) : i; return T_LAT + b * CTXL + p; }
    const int j = i - CTXL; const int p = d ? (SEQ - 1 - j) : j; return b * SEQ + p;
}
__device__ __forceinline__ int seqrow_cm(int i, int d, int b) {
    if (i < CTXL) { const int p = d ? (CTXL - 1 - i) : i; return T_LAT + b * CTXL + p; }
    const int j = i - CTXL; const int p = d ? (SEQ - 1 - j) : j; return b * SEQ + (p & 63) * 64 + (p >> 6);
}

__device__ __forceinline__ void phase_pre(const Ctx& C) {
    LAS float* sc = (LAS float*)C.lds;
    LAS float* red = sc + 9 * 1024;
    float* modv = WSP(float, WS_MODV);
    bool filled = false;
    for (int it = C.wg; it < DEPTH * 48; it += C.G) {
        if (!filled) {
            for (int i = C.tid; i < 9 * 1024; i += NTHR) { const float v = i < 8192 ? C.in[I_C][i] : C.in[I_CCTX][i - 8192]; sc[i] = siluf_(v); }
            filled = true; __syncthreads();
        }
        const int l = it / 48, jb = it % 48, col = C.tid & 127, kg = C.tid >> 7;
        const float* W = C.in[I_MODW] + (size_t)l * 1024 * 6144 + jb * 128 + col;
        float acc[9];
#pragma unroll
        for (int r = 0; r < 9; ++r) acc[r] = 0.f;
#pragma unroll 16
        for (int k = kg * 256; k < kg * 256 + 256; ++k) { const float w = W[(size_t)k * 6144];
#pragma unroll
            for (int r = 0; r < 9; ++r) acc[r] += sc[r * 1024 + k] * w; }
#pragma unroll
        for (int r = 0; r < 9; ++r) red[(kg * 9 + r) * 128 + col] = acc[r];
        __syncthreads();
        for (int i = C.tid; i < 9 * 128; i += NTHR) { const int r = i >> 7, cc = i & 127;
            const float s = red[(0 * 9 + r) * 128 + cc] + red[(1 * 9 + r) * 128 + cc] + red[(2 * 9 + r) * 128 + cc] + red[(3 * 9 + r) * 128 + cc];
            modv[((size_t)l * 9 + r) * 6144 + jb * 128 + cc] = s + C.in[I_MODB][l * 6144 + jb * 128 + cc]; }
        __syncthreads();
    }
}

__device__ __forceinline__ void tr_item(const float* src, size_t ld, int k0, int ns0, bf16* dst, int drow0, int Kd, LAS float* scr, int lane, bool zero) {
    if (!zero) {
#pragma unroll 8
        for (int i = 0; i < 32; ++i) { const int kk = 2 * i + (lane >> 5); scr[kk * 33 + (lane & 31)] = src[(size_t)(k0 + kk) * ld + ns0 + (lane & 31)]; }
    }
    LDS_WAIT(); asm volatile("" ::: "memory");
    const int c = lane & 7;
#pragma unroll
    for (int j = 0; j < 4; ++j) { const int n = (lane >> 3) + 8 * j; const LAS float* s = scr + (8 * c) * 33 + n;
        v4u o; o.x = pk2(s[0 * 33], s[1 * 33]); o.y = pk2(s[2 * 33], s[3 * 33]); o.z = pk2(s[4 * 33], s[5 * 33]); o.w = pk2(s[6 * 33], s[7 * 33]);
        if (zero) o = (v4u){0u, 0u, 0u, 0u};
        *(v4u*)(dst + (size_t)(drow0 + n) * Kd + k0 + 8 * c) = o; }
    LDS_WAIT(); asm volatile("" ::: "memory");
}
__device__ __forceinline__ void convert_small(const Ctx& C, int l) {
    {
        bf16* lw = WSP(bf16, WS_LRUWT);
        for (int k = 0; k < 2 * 2 * 4 * 4096 / (128 * NTHR); ++k) {
            const int e = k * 128 * NTHR + C.wg * NTHR + C.tid;
            if (C.wg < 128) {
            const int i = e & 63, j = (e >> 6) & 63, hd = (e >> 12) & 3, g = (e >> 14) & 1, d = e >> 15;
            const float* src = (g ? C.in[I_LWX] : C.in[I_LWA]) + ((size_t)((l * 2 + d) * 4 + hd) * 64 + i) * 64 + j;
            lw[e] = (bf16)f2bf(*src);
            }
        }
    }
    if (C.wg >= 128 && C.wg < 224) {
        bf16* rw = WSP(bf16, WS_RWT);
        const int e = (C.wg - 128) * NTHR + C.tid;
        if (e < 32768) { const int r = e & 31, ch = (e >> 5) & 255, d = (e >> 13) & 1, isa = e >> 14;
            rw[e] = (bf16)f2bf((isa ? C.in[I_RAUP] : C.in[I_RWUP])[((size_t)(l * 2 + d) * 32 + r) * GW + ch]); }
        else { const int e2 = e - 32768, j = e2 & 63, ch = e2 >> 6; rw[e] = (bf16)f2bf(C.in[I_RGUP][((size_t)l * 64 + j) * GW + ch]); }
    }
}
__device__ __forceinline__ void convert_items(const Ctx& C, int l, int what, int gw, int NGW) {
    LAS float* scr = (LAS float*)(C.lds + C.wave * 8704);
    constexpr int I_IN = 16 * 112, I_OUT = 16 * 32, I_GU = 16 * 176, I_DN = 44 * 32, I_E = 16 * 88 + 22 * 32;
    const bool moe = l & 1; const int li = l >> 1;
    const int lo_it = (what & 1) ? 0 : I_IN, hi_it = (what & 2) ? I_IN + I_OUT + (moe ? NE * I_E : (I_GU + I_DN)) : I_IN;
    bf16* win = WSP(bf16, WS_WIN); bf16* wout = WSP(bf16, WS_WOUT); bf16* wgu = WSP(bf16, WS_WGU); bf16* wdn = WSP(bf16, WS_WDN);
    for (int it = lo_it + gw; it < hi_it; it += NGW) {
        int r = it;
        if (r < I_IN) { const int kb = r / 112, nb = r % 112; tr_item(C.in[I_WIN] + (size_t)l * 1024 * IN_COLS, IN_COLS, 64 * kb, 32 * nb, win, 32 * nb, 1024, scr, C.lane, nb == 111); continue; }
        r -= I_IN;
        if (r < I_OUT) { const int kb = r / 32, nb = r % 32; tr_item(C.in[I_WOUT] + (size_t)l * 1024 * 1024, 1024, 64 * kb, 32 * nb, wout, 32 * nb, 1024, scr, C.lane, false); continue; }
        r -= I_OUT;
        if (!moe) {
            if (r < I_GU) { const int kb = r / 176, nb = r % 176, tile = nb >> 3, q = nb & 7;
                const float* src = (q < 4 ? C.in[I_FWG] : C.in[I_FWU]) + (size_t)li * 1024 * DFF;
                tr_item(src, DFF, 64 * kb, tile * 128 + (q & 3) * 32, wgu, 32 * nb, 1024, scr, C.lane, false); continue; }
            r -= I_GU;
            { const int kb = r / 32, nb = r % 32; tr_item(C.in[I_FWD] + (size_t)li * DFF * 1024, 1024, 64 * kb, 32 * nb, wdn, 32 * nb, DFF, scr, C.lane, false); }
        } else {
            const int e = r / I_E; int rr = r % I_E;
            if (rr < 16 * 88) { const int kb = rr / 88, nb = rr % 88, tile = nb >> 3, q = nb & 7;
                const float* src = (q < 4 ? C.in[I_MWG] : C.in[I_MWU]) + ((size_t)li * NE + e) * 1024 * DFE;
                tr_item(src, DFE, 64 * kb, tile * 128 + (q & 3) * 32, wgu + (size_t)e * 2 * DFE * 1024, 32 * nb, 1024, scr, C.lane, false); continue; }
            rr -= 16 * 88;
            { const int kb = rr / 32, nb = rr % 32; tr_item(C.in[I_MWD] + ((size_t)li * NE + e) * DFE * 1024, 1024, 64 * kb, 32 * nb, wdn + (size_t)e * 1024 * DFE, 32 * nb, DFE, scr, C.lane, false); }
        }
    }
}

__device__ __forceinline__ void convert_q(const Ctx& C, int l, int kind, int gw, int NGW) {
    LAS float* scr = (LAS float*)(C.lds + C.wave * 8704);
    constexpr int I_IN = 16 * 112, I_OUT = 16 * 32, I_GU = 16 * 176, I_DN = 44 * 32, I_EGU = 16 * 88, I_EDN = 22 * 32;
    const bool moe = l & 1; const int li = l >> 1;
    bf16* win = WSP(bf16, WS_WIN); bf16* wout = WSP(bf16, WS_WOUT); bf16* wgu = WSP(bf16, WS_WGU); bf16* wdn = WSP(bf16, WS_WDN);
    const int n_it = kind == 0 ? I_OUT + (moe ? NE * I_EGU : I_GU) : kind == 1 ? (moe ? NE * I_EDN : I_DN) : I_IN;
    for (int it = gw; it < n_it; it += NGW) {
        int r = it;
        if (kind == 2) { const int kb = r / 112, nb = r % 112; tr_item(C.in[I_WIN] + (size_t)l * 1024 * IN_COLS, IN_COLS, 64 * kb, 32 * nb, win, 32 * nb, 1024, scr, C.lane, nb == 111); }
        else if (kind == 0) {
            if (r < I_OUT) { const int kb = r / 32, nb = r % 32; tr_item(C.in[I_WOUT] + (size_t)l * 1024 * 1024, 1024, 64 * kb, 32 * nb, wout, 32 * nb, 1024, scr, C.lane, false); continue; }
            r -= I_OUT;
            if (!moe) { const int kb = r / 176, nb = r % 176, tile = nb >> 3, q = nb & 7;
                const float* src = (q < 4 ? C.in[I_FWG] : C.in[I_FWU]) + (size_t)li * 1024 * DFF;
                tr_item(src, DFF, 64 * kb, tile * 128 + (q & 3) * 32, wgu, 32 * nb, 1024, scr, C.lane, false); }
            else { const int e = r / I_EGU, rr = r % I_EGU; const int kb = rr / 88, nb = rr % 88, tile = nb >> 3, q = nb & 7;
                const float* src = (q < 4 ? C.in[I_MWG] : C.in[I_MWU]) + ((size_t)li * NE + e) * 1024 * DFE;
                tr_item(src, DFE, 64 * kb, tile * 128 + (q & 3) * 32, wgu + (size_t)e * 2 * DFE * 1024, 32 * nb, 1024, scr, C.lane, false); }
        } else {
            if (!moe) { const int kb = r / 32, nb = r % 32; tr_item(C.in[I_FWD] + (size_t)li * DFF * 1024, 1024, 64 * kb, 32 * nb, wdn, 32 * nb, DFF, scr, C.lane, false); }
            else { const int e = r / I_EDN, rr = r % I_EDN; const int kb = rr / 32, nb = rr % 32;
                tr_item(C.in[I_MWD] + ((size_t)li * NE + e) * DFE * 1024, 1024, 64 * kb, 32 * nb, wdn + (size_t)e * 1024 * DFE, 32 * nb, DFE, scr, C.lane, false); }
        }
    }
}

template <bool ROUTE>
__device__ __forceinline__ void norm_rows(const Ctx& C, int l, const void* xlat, bool xbf, const float* xctx, const float* gain, int shoff, int scoff, int nrows, int moe_li) {
    const float* modv = WSP(float, WS_MODV) + (size_t)l * 9 * 6144;
    bf16* hb = WSP(bf16, WS_HB);
    const int gw = C.wg * NWAVES + C.wave, NGW = C.G * NWAVES;
    LAS unsigned* lcnt = (LAS unsigned*)(C.lds + 65536);
    unsigned* route = WSP(unsigned, WS_ROUTE);
    if (ROUTE) { if (C.tid < 8) lcnt[C.tid] = 0u; __syncthreads(); }
    f32x4 gv[4];
#pragma unroll
    for (int j = 0; j < 4; ++j) gv[j] = *(const f32x4*)(gain + 4 * C.lane + 256 * j);
    f32x4 rtw[4][4][2];
    if (ROUTE) { const float* rt = C.in[I_MROUTER] + (size_t)moe_li * 1024 * NE;
#pragma unroll
        for (int j = 0; j < 4; ++j)
#pragma unroll
            for (int q = 0; q < 4; ++q) { const int k = 4 * C.lane + 256 * j + q; rtw[j][q][0] = *(const f32x4*)(rt + (size_t)k * 8); rtw[j][q][1] = *(const f32x4*)(rt + (size_t)k * 8 + 4); } }
    v4u rawn[4]; bool rbfn = false;
#define NR_LOAD(mm) do { const int m_ = (mm); const bool ic_ = m_ >= T_LAT; rbfn = xbf && !ic_; \
        if (rbfn) { _Pragma("unroll") for (int j = 0; j < 4; ++j) { const v2u t_ = *(const v2u*)((const bf16*)xlat + (size_t)m_ * 1024 + 4 * C.lane + 256 * j); rawn[j] = (v4u){t_.x, t_.y, 0u, 0u}; } } \
        else { const float* xr_ = ic_ ? xctx + (size_t)(m_ - T_LAT) * 1024 : (const float*)xlat + (size_t)m_ * 1024; _Pragma("unroll") for (int j = 0; j < 4; ++j) rawn[j] = *(const v4u*)(xr_ + 4 * C.lane + 256 * j); } } while (0)
    if (gw < nrows) NR_LOAD(gw);
    for (int m = gw; m < nrows; m += NGW) {
        const bool isctx = m >= T_LAT;
        const float* mv = modv + (size_t)(isctx ? 8 : (m >> 12)) * 6144;
        v4u raw[4]; const bool rbf = rbfn;
#pragma unroll
        for (int j = 0; j < 4; ++j) raw[j] = rawn[j];
        if (m + NGW < nrows) NR_LOAD(m + NGW);
        f32x4 v[4]; float s = 0.f;
#pragma unroll
        for (int j = 0; j < 4; ++j) { v[j] = rbf ? (f32x4){bflo(raw[j].x), bfhi(raw[j].x), bflo(raw[j].y), bfhi(raw[j].y)} : __builtin_bit_cast(f32x4, raw[j]); s += (v[j].x * v[j].x + v[j].y * v[j].y) + (v[j].z * v[j].z + v[j].w * v[j].w); }
        const float rs = rsqrtf_(wave_sum(s) * (1.0f / 1024.0f) + 1e-6f);
#pragma unroll
        for (int j = 0; j < 4; ++j) { const f32x4 sh = *(const f32x4*)(mv + shoff + 4 * C.lane + 256 * j), scl = *(const f32x4*)(mv + scoff + 4 * C.lane + 256 * j);
            v[j] = (v[j] * rs * gv[j]) * (scl + 1.0f) + sh;
            v2u o; o.x = pk2(v[j].x, v[j].y); o.y = pk2(v[j].z, v[j].w);
            *(v2u*)(hb + (size_t)m * 1024 + 4 * C.lane + 256 * j) = o; }
        if (ROUTE) {
            float lg[8];
#pragma unroll
            for (int e = 0; e < 8; ++e) lg[e] = 0.f;
#pragma unroll
            for (int j = 0; j < 4; ++j)
#pragma unroll
                for (int q = 0; q < 4; ++q) { const f32x4 r0 = rtw[j][q][0], r1 = rtw[j][q][1]; const float hv = v[j][q];
                    lg[0] += hv * r0.x; lg[1] += hv * r0.y; lg[2] += hv * r0.z; lg[3] += hv * r0.w; lg[4] += hv * r1.x; lg[5] += hv * r1.y; lg[6] += hv * r1.z; lg[7] += hv * r1.w; }
#pragma unroll
            for (int e = 0; e < 8; ++e) lg[e] = wave_sum(lg[e]);
            int e0 = 0; float l0 = lg[0];
#pragma unroll
            for (int e = 1; e < 8; ++e) if (lg[e] > l0) { l0 = lg[e]; e0 = e; }
            int e1 = (e0 == 0) ? 1 : 0; float l1 = -3.0e38f;
#pragma unroll
            for (int e = 0; e < 8; ++e) if (e != e0 && lg[e] > l1) { l1 = lg[e]; e1 = e; }
            const float w0 = __builtin_amdgcn_rcpf(1.0f + __expf(l1 - l0)), w1 = 1.0f - w0;
            if (C.lane == 0) {
                const unsigned r0 = atomicAdd((unsigned*)&lcnt[e0], 1u), r1 = atomicAdd((unsigned*)&lcnt[e1], 1u);
                v4u a; a.x = (unsigned)e0; a.y = (unsigned)e1; a.z = r0; a.w = r1;
                *(v4u*)(route + (size_t)m * 8) = a;
                v2u b; b.x = __builtin_bit_cast(unsigned, w0); b.y = __builtin_bit_cast(unsigned, w1);
                *(v2u*)(route + (size_t)m * 8 + 4) = b;
            }
        }
    }
#undef NR_LOAD
    if (ROUTE) {
        __syncthreads();
        if (C.tid < 8) { unsigned* gc = WSP(unsigned, WS_CTL) + CW_MOECNT + 64 * moe_li; const unsigned base = atomicAdd(gc + C.tid, lcnt[C.tid]); WSP(unsigned, WS_WGBASE)[C.wg * 8 + C.tid] = base; }
    }
}
#define RAW_BARRIER() do { asm volatile("s_waitcnt lgkmcnt(0)" ::: "memory"); __builtin_amdgcn_s_barrier(); asm volatile("" ::: "memory"); } while (0)
__device__ __forceinline__ void gdn_prep(const Ctx& C, int l, int b, int c) {
    const bf16* P = WSP(const bf16, WS_P); bf16* gq = WSP(bf16, WS_GQ);
    const bool isctx = c < 4; const int p0 = isctx ? c * 64 : (c - 4) * 64; const int Lp = isctx ? CTXL : SEQ;
    const int ch = 4 * C.lane;
    auto rowof = [&](int p) -> int { return isctx ? (T_LAT + b * CTXL + p) : (b * SEQ + (p & 63) * 64 + (p >> 6)); };
    f32x4 cw[4][3], x[4][3];
#pragma unroll
    for (int j = 0; j < 4; ++j)
#pragma unroll
        for (int g = 0; g < 3; ++g) cw[j][g] = *(const f32x4*)(C.in[I_GCW] + ((size_t)l * 4 + j) * 768 + g * 256 + ch);
    const int tb = p0 + C.wave * 8;
    auto ldrow = [&](int p, f32x4 (&dst)[3]) {
        if (p >= 0 && p < Lp) { const bf16* pr = P + (size_t)rowof(p) * PLD + OFF_D + ch;
#pragma unroll
            for (int g = 0; g < 3; ++g) dst[g] = ld4bf(pr + g * 256); }
        else {
#pragma unroll
            for (int g = 0; g < 3; ++g) dst[g] = (f32x4){0.f, 0.f, 0.f, 0.f}; }
    };
    ldrow(tb - 2, x[0]); ldrow(tb - 1, x[1]); ldrow(tb, x[2]);
#pragma unroll
    for (int t = 0; t < 8; ++t) {
        ldrow(tb + t + 1, x[3]);
        bf16* orow = gq + (size_t)rowof(tb + t) * 768 + ch;
#pragma unroll
        for (int g = 0; g < 3; ++g) {
            f32x4 v = cw[0][g] * x[0][g] + cw[1][g] * x[1][g] + cw[2][g] * x[2][g] + cw[3][g] * x[3][g];
            v = (f32x4){siluf_(v.x), siluf_(v.y), siluf_(v.z), siluf_(v.w)};
            if (g < 2) { const float ss = row16_sum((v.x * v.x + v.y * v.y) + (v.z * v.z + v.w * v.w)); v = v * (rsqrtf_(ss + 1e-6f) * (g == 0 ? 0.125f : 1.0f)); }
            st4bf(orow + g * 256, v);
        }
#pragma unroll
        for (int g = 0; g < 3; ++g) { x[0][g] = x[1][g]; x[1][g] = x[2][g]; x[2][g] = x[3][g]; }
    }
}
__device__ __forceinline__ void finish_rows(const Ctx& C, int l, int nrows) {
    const bf16* P = WSP(const bf16, WS_P); bf16* yc = WSP(bf16, WS_HB);
    const bf16* ob = WSP(const bf16, WS_OUTB); const bf16* oc = WSP(const bf16, WS_OUTC); const bf16* od = WSP(const bf16, WS_OUTD);
    const bf16* gg = WSP(const bf16, WS_G); const float* bonus = WSP(const float, WS_BONUS);
    const float* mu = C.in[I_RMU] + (size_t)l * 2 * B_COLS;
    const int gw = C.wg * NWAVES + C.wave, NGW = C.G * NWAVES, lane = C.lane, ch = 4 * lane, hh = lane >> 4;
    const f32x4 lng = *(const f32x4*)(C.in[I_RLNG] + l * GW + ch), lnb = *(const f32x4*)(C.in[I_RLNB] + l * GW + ch);
    const f32x4 mng = *(const f32x4*)(C.in[I_MNG] + l * GW + ch), gng = *(const f32x4*)(C.in[I_GNG] + l * GW + ch);
    const f32x4 mu0 = *(const f32x4*)(mu + 512 + ch), mu1 = *(const f32x4*)(mu + B_COLS + 512 + ch);
    const size_t o2 = (size_t)T_ALL * 256;
#pragma unroll 2
    for (int m = gw; m < nrows; m += NGW) {
        const bool isctx = m >= T_LAT; const int Lp = isctx ? CTXL : SEQ; const int p = isctx ? ((m - T_LAT) & (CTXL - 1)) : (m & (SEQ - 1));
        const f32x4 yb = ld4bf(ob + (size_t)m * 256 + ch) + ld4bf(ob + o2 + (size_t)m * 256 + ch);
        const f32x4 ycv = ld4bf(oc + (size_t)m * 256 + ch) + ld4bf(oc + o2 + (size_t)m * 256 + ch);
        const f32x4 yd = ld4bf(od + (size_t)m * 256 + ch) + ld4bf(od + o2 + (size_t)m * 256 + ch);
        const bf16* pr = P + (size_t)m * PLD;
        const f32x4 vs = ld4bf(WSP(const bf16, WS_RKV) + (size_t)m * 768 + 512 + ch);
        const f32x4 og = ld4bf(pr + OFF_C + 768 + ch), gd = ld4bf(pr + OFF_D + 768 + ch), gr = ld4bf(gg + (size_t)m * 256 + ch);
        const float bn = bonus[(size_t)m * 4 + hh];
        *(v2u*)(yc + (size_t)m * 1024 + ch) = *(const v2u*)(pr + 256 + ch);
        {
            const float mean = row16_sum((yb.x + yb.y) + (yb.z + yb.w)) * (1.0f / 64.0f);
            const f32x4 dl = yb - mean;
            const float var = row16_sum((dl.x * dl.x + dl.y * dl.y) + (dl.z * dl.z + dl.w * dl.w)) * (1.0f / 64.0f);
            const f32x4 yn = dl * rsqrtf_(var + 64e-5f) * lng + lnb;
            st4bf(yc + (size_t)m * 1024 + 256 + ch, (yn + vs * bn) * gr);
        }
        {
            const float ms = row16_sum((ycv.x * ycv.x + ycv.y * ycv.y) + (ycv.z * ycv.z + ycv.w * ycv.w)) * (1.0f / 64.0f);
            const f32x4 sg = (f32x4){sigmoidf_(og.x), sigmoidf_(og.y), sigmoidf_(og.z), sigmoidf_(og.w)};
            st4bf(yc + (size_t)m * 1024 + 512 + ch, ycv * rsqrtf_(ms + 1e-6f) * mng * sg);
        }
        {
            const float ms = row16_sum((yd.x * yd.x + yd.y * yd.y) + (yd.z * yd.z + yd.w * yd.w)) * (1.0f / 64.0f);
            const f32x4 sg = (f32x4){siluf_(gd.x), siluf_(gd.y), siluf_(gd.z), siluf_(gd.w)};
            st4bf(yc + (size_t)m * 1024 + 768 + ch, yd * rsqrtf_(ms + 1e-6f) * gng * sg);
        }
    }
}
typedef bf16x8 fragb;
__device__ __forceinline__ f32x4 mfma16(fragb a, fragb b, f32x4 c) { return __builtin_amdgcn_mfma_f32_16x16x32_bf16(a, b, c, 0, 0, 0); }
__device__ __forceinline__ fragb ld_frag16(const LAS bf16* p) { return *(const LAS fragb*)p; }
__device__ __forceinline__ fragb ld_frag8x2(const LAS bf16* p0, const LAS bf16* p1) {
    const v2u a = *(const LAS v2u*)p0, b = *(const LAS v2u*)p1; v4u r; r.x = a.x; r.y = a.y; r.z = b.x; r.w = b.y; return __builtin_bit_cast(fragb, r); }
__device__ __forceinline__ fragb pack_frag(const f32x4& lo, const f32x4& hi) { v4u r; r.x = pk2(lo.x, lo.y); r.y = pk2(lo.z, lo.w); r.z = pk2(hi.x, hi.y); r.w = pk2(hi.z, hi.w); return __builtin_bit_cast(fragb, r); }
__device__ __forceinline__ float wave_incl_sum(float v, int lane) {
    v += dpp_x<0x111, 0xF, true>(0.f, v); v += dpp_x<0x112, 0xF, true>(0.f, v); v += dpp_x<0x114, 0xF, true>(0.f, v); v += dpp_x<0x118, 0xF, true>(0.f, v);
    v += dpp_x<0x142, 0xA, false>(0.f, v); v += dpp_x<0x143, 0xC, false>(0.f, v);
    return v;
}
__device__ __forceinline__ float wave_incl_max(float v, int lane) {
    const float ninf = -3.0e38f;
    v = fmaxf(v, dpp_x<0x111, 0xF, false>(ninf, v)); v = fmaxf(v, dpp_x<0x112, 0xF, false>(ninf, v)); v = fmaxf(v, dpp_x<0x114, 0xF, false>(ninf, v)); v = fmaxf(v, dpp_x<0x118, 0xF, false>(ninf, v));
    v = fmaxf(v, dpp_x<0x142, 0xA, false>(ninf, v)); v = fmaxf(v, dpp_x<0x143, 0xC, false>(ninf, v));
    return v;
}
constexpr int MP = 72;
__device__ __forceinline__ void mlstm_chunked(const Ctx& C, int l, int idx) {
    const int d = idx >> 5, b = (idx >> 2) & 7, h = idx & 3, lane = C.lane, w = C.wave, l15 = lane & 15, q = lane >> 4;
    const int it = w & 3, vtp = w >> 2;
    constexpr int IMG = 64 * MP * 2, BUFB = 4 * IMG + 1024, CTB = 65 * MP * 2 + 16;
    LAS unsigned char* L0 = C.lds;
    const bf16* P = WSP(const bf16, WS_P); bf16* outc = WSP(bf16, WS_OUTC) + (size_t)d * T_ALL * 256;
    const float ib = C.in[I_MIB][(l * 2 + d) * NH + h], fb = C.in[I_MFB][(l * 2 + d) * NH + h];
    const int tt = C.tid >> 3, part = C.tid & 7;
    for (int i = C.tid; i < 2 * CTB / 4; i += NTHR) ((LAS unsigned*)(L0 + 2 * BUFB))[i] = 0u;
    v4u rq, rk, rv; unsigned short rgi, rgf;
    auto gload = [&](int n) {
        const int row = seqrow_cm(n * 64 + tt, d, b);
        const bf16* pp = P + (size_t)row * PLD + OFF_C + h * 64 + 8 * part;
        rq = *(const v4u*)pp; rk = *(const v4u*)(pp + 256); rv = *(const v4u*)(pp + 512);
        const bf16* pg = P + (size_t)seqrow_cm(n * 64 + lane, d, b) * PLD + OFF_C + 1024 + d * 4 + h;
        rgi = pg[0]; rgf = pg[8];
    };
    auto images = [&](int bufi) {
        LAS unsigned char* B0 = L0 + bufi * BUFB;
        LAS bf16* Qs = (LAS bf16*)B0; LAS bf16* Ks = Qs + 64 * MP; LAS bf16* VT = Ks + 64 * MP; LAS bf16* KTw = VT + 64 * MP; LAS float* vec = (LAS float*)(B0 + 4 * IMG);
        const float li = bf2f(rgi) + ib, lf = -softplusf_(-(bf2f(rgf) + fb));
        const float bc = wave_incl_sum(lf, lane), x = li - bc, cm = wave_incl_max(x, lane);
        const float wl = __expf(x - __shfl(cm, 63)) * 0.125f;
        if (w == 0) { vec[lane] = x; vec[64 + lane] = cm; vec[128 + lane] = bc; }
        const float wmine = __shfl(wl, 8 * w + (lane >> 3));
        *(LAS v4u*)(Qs + tt * MP + 8 * part) = rq; *(LAS v4u*)(Ks + tt * MP + 8 * part) = rk;
        const unsigned vv[4] = {rv.x, rv.y, rv.z, rv.w}, kk[4] = {rk.x, rk.y, rk.z, rk.w};
#pragma unroll
        for (int e = 0; e < 4; ++e) {
            VT[(8 * part + 2 * e) * MP + tt] = (bf16)(vv[e] & 0xffffu); VT[(8 * part + 2 * e + 1) * MP + tt] = (bf16)(vv[e] >> 16);
            KTw[(8 * part + 2 * e) * MP + tt] = (bf16)f2bf1(bflo(kk[e]) * wmine); KTw[(8 * part + 2 * e + 1) * MP + tt] = (bf16)f2bf1(bfhi(kk[e]) * wmine);
        }
    };
    f32x4 Cst[2], nst; float m = 0.f;
    Cst[0] = Cst[1] = nst = (f32x4){0.f, 0.f, 0.f, 0.f};
    const fragb ones = __builtin_bit_cast(fragb, (v4u){0x3F803F80u, 0x3F803F80u, 0x3F803F80u, 0x3F803F80u});
    const f32x4 z4 = (f32x4){0.f, 0.f, 0.f, 0.f};
    gload(0); images(0); gload(1);
#pragma unroll 1
    for (int n = 0; n < NCH; ++n) {
        RAW_BARRIER();
        const LAS unsigned char* B0 = L0 + (n & 1) * BUFB;
        const LAS bf16* Qs = (const LAS bf16*)B0; const LAS bf16* Ks = Qs + 64 * MP; const LAS bf16* VT = Ks + 64 * MP; const LAS bf16* KTw = VT + 64 * MP; const LAS float* vec = (const LAS float*)(B0 + 4 * IMG);
        const LAS bf16* CT = (const LAS bf16*)(L0 + 2 * BUFB + (n & 1) * CTB); LAS bf16* CTn = (LAS bf16*)(L0 + 2 * BUFB + ((n + 1) & 1) * CTB);
        fragb Qf[2]; Qf[0] = ld_frag16(Qs + (16 * it + l15) * MP + 8 * q); Qf[1] = ld_frag16(Qs + (16 * it + l15) * MP + 32 + 8 * q);
        const float cmi = vec[64 + 16 * it + l15]; const int icol = 16 * it + l15;
        f32x4 pt[4];
#pragma unroll
        for (int jt = 0; jt < 4; ++jt) {
            pt[jt] = z4;
            if (jt <= it) {
                const fragb k0 = ld_frag16(Ks + (16 * jt + l15) * MP + 8 * q), k1 = ld_frag16(Ks + (16 * jt + l15) * MP + 32 + 8 * q);
                f32x4 st = mfma16(k0, Qf[0], z4); st = mfma16(k1, Qf[1], st);
                const f32x4 xj = *(const LAS f32x4*)(vec + 16 * jt + 4 * q);
#pragma unroll
                for (int r = 0; r < 4; ++r) { const int j = 16 * jt + 4 * q + r; pt[jt][r] = (j <= icol) ? st[r] * __expf(xj[r] - cmi) * 0.125f : 0.f; }
            }
        }
        fragb Pf[2]; Pf[0] = pack_frag(pt[0], pt[1]); Pf[1] = pack_frag(pt[2], pt[3]);
        fragb Vf[2][2];
#pragma unroll
        for (int v2 = 0; v2 < 2; ++v2)
#pragma unroll
            for (int s = 0; s < 2; ++s) { const LAS bf16* vr = VT + (16 * (2 * vtp + v2) + l15) * MP + 32 * s + 4 * q; Vf[v2][s] = ld_frag8x2(vr, vr + 16); }
        f32x4 Aacc[2], R[2], as, dn;
        as = mfma16(Pf[0], ones, z4); if (it >= 2) as = mfma16(Pf[1], ones, as);
        const fragb nf0 = ld_frag16(CT + 64 * MP + 8 * q), nf1 = ld_frag16(CT + 64 * MP + 32 + 8 * q);
        dn = mfma16(Qf[0], nf0, z4); dn = mfma16(Qf[1], nf1, dn);
#pragma unroll
        for (int v2 = 0; v2 < 2; ++v2) {
            Aacc[v2] = mfma16(Pf[0], Vf[v2][0], z4); if (it >= 2) Aacc[v2] = mfma16(Pf[1], Vf[v2][1], Aacc[v2]);
            const LAS bf16* cr = CT + (16 * (2 * vtp + v2) + l15) * MP + 8 * q;
            R[v2] = mfma16(Qf[0], ld_frag16(cr), z4); R[v2] = mfma16(Qf[1], ld_frag16(cr + 32), R[v2]);
        }
        {
            const f32x4 bi = *(const LAS f32x4*)(vec + 128 + 16 * it + 4 * q), cmr = *(const LAS f32x4*)(vec + 64 + 16 * it + 4 * q);
#pragma unroll
            for (int r = 0; r < 4; ++r) {
                const float mi = bi[r] + cmr[r], minter = bi[r] + m, mt = fmaxf(minter, mi), e1 = __expf(mi - mt), e2 = __expf(minter - mt);
                const float den = e1 * as[r] + e2 * dn[r]; const float inv = __builtin_amdgcn_rcpf(fmaxf(fabsf(den), __expf(-mt)));
                const int row = seqrow_cm(n * 64 + 16 * it + 4 * q + r, d, b);
#pragma unroll
                for (int v2 = 0; v2 < 2; ++v2) outc[(size_t)row * 256 + h * 64 + 16 * (2 * vtp + v2) + l15] = (bf16)f2bf1((e1 * Aacc[v2][r] + e2 * R[v2][r]) * inv);
            }
        }
        {
            const LAS bf16* kr = KTw + (16 * it + l15) * MP + 4 * q;
            const fragb kt0 = ld_frag8x2(kr, kr + 16), kt1 = ld_frag8x2(kr + 32, kr + 48);
            const float bL = vec[128 + 63], mloc = bL + vec[64 + 63];
            const float mnew = fmaxf(bL + m, mloc), wp = __expf(bL + m - mnew), wn = __expf(mloc - mnew);
            f32x4 gk = mfma16(kt0, ones, z4); gk = mfma16(kt1, ones, gk);
            nst = nst * wp + gk * wn;
#pragma unroll
            for (int v2 = 0; v2 < 2; ++v2) {
                f32x4 G = mfma16(kt0, Vf[v2][0], z4); G = mfma16(kt1, Vf[v2][1], G);
                Cst[v2] = Cst[v2] * wp + G * wn;
                v2u o; o.x = pk2(Cst[v2].x, Cst[v2].y); o.y = pk2(Cst[v2].z, Cst[v2].w);
                *(LAS v2u*)(CTn + (16 * (2 * vtp + v2) + l15) * MP + 16 * it + 4 * q) = o;
            }
            if (vtp == 0 && l15 == 0) { v2u o; o.x = pk2(nst.x, nst.y); o.y = pk2(nst.z, nst.w); *(LAS v2u*)(CTn + 64 * MP + 16 * it + 4 * q) = o; }
            m = mnew;
        }
        if (n + 1 < NCH) { images((n + 1) & 1); if (n + 2 < NCH) gload(n + 2); }
    }
    __syncthreads();
}
__device__ __forceinline__ int fwd_row_cm(int b, int c, int t) { return c < 4 ? (T_LAT + b * CTXL + c * 64 + t) : (b * SEQ + t * 64 + (c - 4)); }
__device__ __forceinline__ bf16* blob_row(const Ctx& C, int d, int isw, int b, int c, int h, int r) {
    const int row = fwd_row_cm(b, c, r);
    if (d == 1 && isw) return WSP(bf16, WS_OUTD) + ((size_t)T_ALL + row) * 256 + h * 64;
    return WSP(bf16, WS_P) + (size_t)row * PLD + OFF_D + (d * 2 + isw) * 256 + h * 64;
}
constexpr int LP = 68;
__device__ __forceinline__ void blocked_solve(const LAS bf16* Ln, const LAS bf16* TinvP, LAS unsigned char* XTw, f32x4 (&acc)[4][4], int l15, int q) {
    const f32x4 z4 = (f32x4){0.f, 0.f, 0.f, 0.f};
#pragma unroll
    for (int I = 0; I < 4; ++I) {
        const fragb Af = *(const LAS fragb*)(TinvP + (I * 16 + l15) * 32 + 8 * q);
        fragb A0, A1;
        if (I >= 1) A0 = ld_frag16(Ln + (16 * I + l15) * MP + 8 * q);
        if (I == 3) A1 = ld_frag16(Ln + (16 * I + l15) * MP + 32 + 8 * q);
#pragma unroll
        for (int nt = 0; nt < 4; ++nt) {
            const int crow = 16 * nt + l15; LAS unsigned char* xr = XTw + crow * 128;
            f32x4 a = acc[I][nt];
            if (I >= 1) a = mfma16(A0, *(const LAS fragb*)(xr + ((q ^ (crow & 7)) << 4)), a);
            if (I == 3) a = mfma16(A1, *(const LAS fragb*)(xr + (((4 + q) ^ (crow & 7)) << 4)), a);
            v4u bw; bw.x = pk2(a.x, a.y); bw.y = pk2(a.z, a.w); bw.z = 0u; bw.w = 0u;
            const f32x4 x = mfma16(Af, __builtin_bit_cast(fragb, bw), z4);
            acc[I][nt] = x;
            v2u o; o.x = pk2(x.x, x.y); o.y = pk2(x.z, x.w);
            *(LAS v2u*)(xr + (((2 * I + (q >> 1)) ^ (crow & 7)) << 4) + (q & 1) * 8) = o;
        }
    }
}
__device__ __forceinline__ void diag_inverses(const LAS bf16* Ln, LAS bf16* TinvP, int lane) {
    const int blk = lane >> 4, c = lane & 15;
    float x[16];
#pragma unroll
    for (int i = 0; i < 16; ++i) {
        const LAS bf16* lr = Ln + (16 * blk + i) * MP + 16 * blk;
        const v4u r0 = *(const LAS v4u*)lr, r1 = *(const LAS v4u*)(lr + 8);
        const unsigned rw[8] = {r0.x, r0.y, r0.z, r0.w, r1.x, r1.y, r1.z, r1.w};
        float s = (i == c) ? 1.0f : 0.0f;
#pragma unroll
        for (int j = 0; j < i; ++j) s += ((j & 1) ? bfhi(rw[j >> 1]) : bflo(rw[j >> 1])) * x[j];
        x[i] = s;
        TinvP[(blk * 16 + i) * 32 + 8 * (c >> 2) + (c & 3)] = (bf16)f2bf1(s);
    }
}
__device__ __forceinline__ void gdn_solve_item(const Ctx& C, int l, int item) {
    const int lane = C.lane, w = C.wave, pw = w & 1, pi = w >> 1, l15 = lane & 15, q = lane >> 4;
    LAS unsigned char* B0 = C.lds + pi * 31744;
    LAS bf16* Ln = (LAS bf16*)B0;
    LAS bf16* TinvP = (LAS bf16*)(B0 + 9216);
    LAS float* vec = (LAS float*)(B0 + 13312);
    LAS unsigned char* XT = B0 + 13824;
    LAS bf16* Ks = (LAS bf16*)XT;
    const bf16* P = WSP(const bf16, WS_P); const bf16* gq = WSP(const bf16, WS_GQ);
    const int u = item >> 1, d = item & 1;
    const int c = u % NCH, h = (u / NCH) & 3, b = u / (NCH * NH);
    const int n = d ? (c < 4 ? 3 - c : 71 - c) : c;
    const float aexp = __expf(C.in[I_GALOG][(l * 2 + d) * NH + h]), dtb = C.in[I_GDTB][(l * 2 + d) * NH + h];
    const int rowl = seqrow_cm(n * 64 + lane, d, b);
    const bf16* pg = P + (size_t)rowl * PLD + OFF_D + 1024 + d * 4 + h;
    const float la = -aexp * softplusf_(bf2f(pg[0]) + dtb), beta = sigmoidf_(bf2f(pg[8]));
    const float gam = wave_incl_sum(la, lane);
    if (pw == 0) { vec[lane] = beta; vec[64 + lane] = gam; }
#pragma unroll
    for (int r = 0; r < 4; ++r) { const int idx = pw * 64 + lane + 128 * r, t = idx >> 3, part = idx & 7;
        *(LAS v4u*)(Ks + t * MP + 8 * part) = *(const v4u*)(gq + (size_t)seqrow_cm(n * 64 + t, d, b) * 768 + 256 + h * 64 + 8 * part); }
    { LAS v4u* tz = (LAS v4u*)(B0 + 9216) + (pw * 64 + lane) * 2; tz[0] = (v4u){0u, 0u, 0u, 0u}; tz[1] = (v4u){0u, 0u, 0u, 0u}; }
    f32x4 acc[4][4];
    LAS bf16* Vs = (LAS bf16*)(XT + 9216);
#pragma unroll
    for (int r = 0; r < 4; ++r) { const int idx = pw * 64 + lane + 128 * r, t = idx >> 3, part = idx & 7;
        const v4u vv = *(const v4u*)(gq + (size_t)seqrow_cm(n * 64 + t, d, b) * 768 + 512 + h * 64 + 8 * part);
        LAS unsigned* vd = (LAS unsigned*)(Vs + t * 66 + 8 * part); vd[0] = vv.x; vd[1] = vv.y; vd[2] = vv.z; vd[3] = vv.w; }
    __syncthreads();
    if (pw == 0) {
#pragma unroll
        for (int I = 0; I < 4; ++I)
#pragma unroll
            for (int r = 0; r < 4; ++r)
#pragma unroll
                for (int nt = 0; nt < 4; ++nt) acc[I][nt][r] = bf2f(Vs[(16 * I + 4 * q + r) * 66 + 16 * nt + l15]);
    }
    {
        int tix = 0;
#pragma unroll
        for (int it = 0; it < 4; ++it)
#pragma unroll
            for (int jt = 0; jt < 4; ++jt, ++tix) if ((tix & 1) == pw) {
                f32x4 t4 = (f32x4){0.f, 0.f, 0.f, 0.f};
                if (jt <= it) {
#pragma unroll
                    for (int s = 0; s < 2; ++s) t4 = mfma16(ld_frag16(Ks + (16 * it + l15) * MP + 32 * s + 8 * q), ld_frag16(Ks + (16 * jt + l15) * MP + 32 * s + 8 * q), t4);
                    const float gj = vec[64 + 16 * jt + l15];
                    const f32x4 bi = *(const LAS f32x4*)(vec + 16 * it + 4 * q), gi = *(const LAS f32x4*)(vec + 64 + 16 * it + 4 * q);
#pragma unroll
                    for (int r = 0; r < 4; ++r) { const int i = 16 * it + 4 * q + r, j = 16 * jt + l15; t4[r] = (j < i) ? -(bi[r] * t4[r] * __expf(gi[r] - gj)) : 0.f; }
                }
#pragma unroll
                for (int r = 0; r < 4; ++r) Ln[(16 * it + 4 * q + r) * MP + 16 * jt + l15] = (bf16)f2bf1(t4[r]);
            }
    }
    {
#pragma unroll
        for (int I = 0; I < 4; ++I) {
            const f32x4 bi = *(const LAS f32x4*)(vec + 16 * I + 4 * q), gi = *(const LAS f32x4*)(vec + 64 + 16 * I + 4 * q);
#pragma unroll
            for (int r = 0; r < 4; ++r) { const float sc = pw ? bi[r] * __expf(gi[r]) : bi[r];
#pragma unroll
                for (int nt = 0; nt < 4; ++nt) acc[I][nt][r] = (pw ? bf2f(Ks[(16 * I + 4 * q + r) * MP + 16 * nt + l15]) : acc[I][nt][r]) * sc; }
        }
    }
    __syncthreads();
    if (pw == 0) diag_inverses(Ln, TinvP, lane);
    LAS unsigned char* XTw = XT + pw * 8192;
    { LAS v4u* xz = (LAS v4u*)(XTw + lane * 128);
#pragma unroll
        for (int g = 0; g < 8; ++g) xz[g] = (v4u){0u, 0u, 0u, 0u}; }
    __syncthreads();
    blocked_solve(Ln, TinvP, XTw, acc, l15, q);
    {
        bf16* dst = blob_row(C, d, pw, b, c, h, lane);
        const LAS unsigned char* xr = XTw + lane * 128;
#pragma unroll
        for (int g = 0; g < 8; ++g) *(v4u*)(dst + 8 * g) = *(const LAS v4u*)(xr + ((g ^ (lane & 7)) << 4));
    }
    __syncthreads();
}

template <bool DRY>
__device__ __forceinline__ void gdn_chunked(const Ctx& C, int l, int idx) {
    const int d = idx >> 5, b = (idx >> 2) & 7, h = idx & 3, lane = C.lane, w = C.wave, l15 = lane & 15, q = lane >> 4;
    const int it = w & 3, vtp = w >> 2;
    constexpr int IMG = 64 * MP * 2, BUFB = 5 * IMG + 512;
    LAS unsigned char* L0 = C.lds;
    LAS bf16* VnT = (LAS bf16*)(L0 + 2 * BUFB + 2 * IMG);
    const bf16* P = WSP(const bf16, WS_P); const bf16* gq = WSP(const bf16, WS_GQ); bf16* outd = WSP(bf16, WS_OUTD) + (size_t)d * T_ALL * 256;
    const float aexp = __expf(C.in[I_GALOG][(l * 2 + d) * NH + h]), dtb = C.in[I_GDTB][(l * 2 + d) * NH + h];
    const int tt = C.tid >> 3, part = C.tid & 7;
    for (int i = C.tid; i < 2 * IMG / 4; i += NTHR) ((LAS unsigned*)(L0 + 2 * BUFB))[i] = 0u;
    v4u rq, rk, ru, rw; unsigned short rga;
    auto gload = [&](int n) {
        const int c = d ? (n < 4 ? 3 - n : 71 - n) : n;
        const bf16* pp = gq + (size_t)seqrow_cm(n * 64 + tt, d, b) * 768 + h * 64 + 8 * part;
        rq = *(const v4u*)pp; rk = *(const v4u*)(pp + 256);
        ru = *(const v4u*)(blob_row(C, d, 0, b, c, h, tt) + 8 * part); rw = *(const v4u*)(blob_row(C, d, 1, b, c, h, tt) + 8 * part);
        rga = P[(size_t)seqrow_cm(n * 64 + lane, d, b) * PLD + OFF_D + 1024 + d * 4 + h];
    };
    auto images = [&](int bufi) {
        LAS unsigned char* B0 = L0 + bufi * BUFB;
        LAS bf16* Qs = (LAS bf16*)B0; LAS bf16* Ks = Qs + 64 * MP; LAS bf16* KdT = Ks + 64 * MP; LAS bf16* Wi = KdT + 64 * MP; LAS bf16* UT = Wi + 64 * MP; LAS float* vec = (LAS float*)(B0 + 5 * IMG);
        const float la = -aexp * softplusf_(bf2f(rga) + dtb);
        const float gam = wave_incl_sum(la, lane);
        if (w == 0) vec[lane] = gam;
        const float kd = __expf(__shfl(gam, 63) - gam);
        const float kmine = __shfl(kd, 8 * w + (lane >> 3));
        *(LAS v4u*)(Qs + tt * MP + 8 * part) = rq; *(LAS v4u*)(Ks + tt * MP + 8 * part) = rk; *(LAS v4u*)(UT + tt * MP + 8 * part) = ru;
        const unsigned kk[4] = {rk.x, rk.y, rk.z, rk.w}, ww[4] = {rw.x, rw.y, rw.z, rw.w};
#pragma unroll
        for (int e = 0; e < 4; ++e) {
            KdT[(8 * part + 2 * e) * MP + tt] = (bf16)f2bf1(bflo(kk[e]) * kmine); KdT[(8 * part + 2 * e + 1) * MP + tt] = (bf16)f2bf1(bfhi(kk[e]) * kmine);
            Wi[(8 * part + 2 * e) * MP + tt] = (bf16)(ww[e] & 0xffffu); Wi[(8 * part + 2 * e + 1) * MP + tt] = (bf16)(ww[e] >> 16);
        }
    };
    f32x4 Sst[2]; Sst[0] = Sst[1] = (f32x4){0.f, 0.f, 0.f, 0.f};
    const f32x4 z4 = (f32x4){0.f, 0.f, 0.f, 0.f};
    gload(0); images(0); gload(1);
#pragma unroll 1
    for (int n = 0; n < NCH; ++n) {
        RAW_BARRIER();
        const LAS unsigned char* B0 = L0 + (n & 1) * BUFB;
        const LAS bf16* Qs = (const LAS bf16*)B0; const LAS bf16* Ks = Qs + 64 * MP; const LAS bf16* KdT = Ks + 64 * MP; const LAS bf16* Wi = KdT + 64 * MP; const LAS bf16* UT = Wi + 64 * MP; const LAS float* vec = (const LAS float*)(B0 + 5 * IMG);
        const LAS bf16* ST = (const LAS bf16*)(L0 + 2 * BUFB + (n & 1) * IMG); LAS bf16* STn = (LAS bf16*)(L0 + 2 * BUFB + ((n + 1) & 1) * IMG);
        fragb Qf[2]; Qf[0] = ld_frag16(Qs + (16 * it + l15) * MP + 8 * q); Qf[1] = ld_frag16(Qs + (16 * it + l15) * MP + 32 + 8 * q);
        const float gcol = vec[16 * it + l15]; const int icol = 16 * it + l15;
        f32x4 pt[4];
#pragma unroll
        for (int jt = 0; jt < 4; ++jt) {
            pt[jt] = z4;
            if (jt <= it) {
                const fragb k0 = ld_frag16(Ks + (16 * jt + l15) * MP + 8 * q), k1 = ld_frag16(Ks + (16 * jt + l15) * MP + 32 + 8 * q);
                f32x4 st = mfma16(k0, Qf[0], z4); st = mfma16(k1, Qf[1], st);
                const f32x4 gj = *(const LAS f32x4*)(vec + 16 * jt + 4 * q);
#pragma unroll
                for (int r = 0; r < 4; ++r) { const int j = 16 * jt + 4 * q + r; pt[jt][r] = (j <= icol) ? st[r] * __expf(gcol - gj[r]) : 0.f; }
            }
        }
        fragb Pf[2]; Pf[0] = pack_frag(pt[0], pt[1]); Pf[1] = pack_frag(pt[2], pt[3]);
        const fragb Wf0 = ld_frag16(Wi + (16 * it + l15) * MP + 8 * q), Wf1 = ld_frag16(Wi + (16 * it + l15) * MP + 32 + 8 * q);
        f32x4 Ro[2];
#pragma unroll
        for (int v2 = 0; v2 < 2; ++v2) {
            const int vrow = 16 * (2 * vtp + v2) + l15;
            const fragb s0 = ld_frag16(ST + vrow * MP + 8 * q), s1 = ld_frag16(ST + vrow * MP + 32 + 8 * q);
            f32x4 ws = mfma16(Wf0, s0, z4); ws = mfma16(Wf1, s1, ws);
            Ro[v2] = mfma16(Qf[0], s0, z4); Ro[v2] = mfma16(Qf[1], s1, Ro[v2]);
            const v2u ur = *(const LAS v2u*)(UT + vrow * MP + 16 * it + 4 * q);
            v2u o; o.x = pk2(bflo(ur.x) - ws.x, bfhi(ur.x) - ws.y); o.y = pk2(bflo(ur.y) - ws.z, bfhi(ur.y) - ws.w);
            *(LAS v2u*)(VnT + vrow * MP + 16 * it + 4 * q) = o;
        }
        RAW_BARRIER();
        {
            const f32x4 gi = *(const LAS f32x4*)(vec + 16 * it + 4 * q);
            const float gl = __expf(vec[63]);
            const LAS bf16* kr = KdT + (16 * it + l15) * MP + 4 * q;
            const fragb kt0 = ld_frag8x2(kr, kr + 16), kt1 = ld_frag8x2(kr + 32, kr + 48);
#pragma unroll
            for (int v2 = 0; v2 < 2; ++v2) {
                const int vrow = 16 * (2 * vtp + v2) + l15;
                const LAS bf16* vr = VnT + vrow * MP + 4 * q;
                const fragb n0 = ld_frag8x2(vr, vr + 16), n1 = ld_frag8x2(vr + 32, vr + 48);
                f32x4 o = mfma16(Pf[0], n0, z4); if (it >= 2) o = mfma16(Pf[1], n1, o);
#pragma unroll
                for (int r = 0; r < 4; ++r) { const int row = seqrow_cm(n * 64 + 16 * it + 4 * q + r, d, b);
                    if (!DRY) outd[(size_t)row * 256 + h * 64 + vrow] = (bf16)f2bf1(o[r] + __expf(gi[r]) * Ro[v2][r]); }
                f32x4 ns = mfma16(kt0, n0, z4); ns = mfma16(kt1, n1, ns);
                Sst[v2] = Sst[v2] * gl + ns;
                v2u so; so.x = pk2(Sst[v2].x, Sst[v2].y); so.y = pk2(Sst[v2].z, Sst[v2].w);
                *(LAS v2u*)(STn + vrow * MP + 16 * it + 4 * q) = so;
            }
        }
        if (n + 1 < NCH) { images((n + 1) & 1); if (n + 2 < NCH) gload(n + 2); }
    }
    __syncthreads();
}
constexpr int UP = 264;
template <int CTRL> __device__ __forceinline__ float dpp_keep(float oldv, float v) { return __builtin_bit_cast(float, __builtin_amdgcn_update_dpp(__builtin_bit_cast(int, oldv), __builtin_bit_cast(int, v), CTRL, 0xF, 0xF, false)); }
template <bool REV> __device__ __forceinline__ void scan16(float& A, float& B) {
#define LRU_STEP(S) { const float Ap = dpp_keep<(REV ? 0x100 : 0x110) | S>(1.0f, A), Bp = dpp_keep<(REV ? 0x100 : 0x110) | S>(0.0f, B); B = A * Bp + B; A = A * Ap; }
    LRU_STEP(1) LRU_STEP(2) LRU_STEP(4) LRU_STEP(8)
#undef LRU_STEP
}
constexpr int UPC = 72;
__device__ __forceinline__ int lru_chunk_of(int d, int k) { return d ? (k < 4 ? 3 - k : NCH + 3 - k) : k; }
template <bool REV>
__device__ __forceinline__ void lru_tiles(const LAS bf16* Ud, int th, int mt, int lane, const fragb (&Wa)[2], const fragb (&Wx)[2], const f32x4& ba, const f32x4& bx, const f32x4& sp4,
                                          f32x4 (&Ac)[2], f32x4 (&Hl)[2], f32x4& Atot, f32x4& hend) {
    const int l15 = lane & 15, q = lane >> 4, edge = (lane & 48) | (REV ? 0 : 15);
    const f32x4 z4 = (f32x4){0.f, 0.f, 0.f, 0.f};
    f32x4 tA = z4, tB = z4;
#pragma unroll
    for (int i = 0; i < 2; ++i) {
        const int nt = REV ? 3 - (2 * th + i) : 2 * th + i;
        const LAS bf16* urow = Ud + (16 * nt + l15) * UPC;
        const fragb Uf0 = ld_frag16(urow + 8 * q), Uf1 = ld_frag16(urow + 32 + 8 * q);
        f32x4 aa = mfma16(Wa[0], Uf0, z4); aa = mfma16(Wa[1], Uf1, aa);
        f32x4 ax = mfma16(Wx[0], Uf0, z4); ax = mfma16(Wx[1], Uf1, ax);
        const v2u ur = *(const LAS v2u*)(urow + 16 * mt + 4 * q);
        const f32x4 u4 = (f32x4){bflo(ur.x), bfhi(ur.x), bflo(ur.y), bfhi(ur.y)};
        f32x4 la, iu, A, Bv;
#pragma unroll
        for (int r = 0; r < 4; ++r) { const float rg = sigmoidf_(aa[r] + ba[r]); iu[r] = sigmoidf_(ax[r] + bx[r]) * u4[r]; la[r] = -sp4[r] * rg; }
        const bool sm_ = la[0] > -0.15f && la[1] > -0.15f && la[2] > -0.15f && la[3] > -0.15f;
        if (__builtin_amdgcn_ballot_w64(!sm_) == 0ull) {
#pragma unroll
            for (int r = 0; r < 4; ++r) { const float x = la[r], p = x * (1.0f + x * (0.5f + x * (0.16666667f + x * (0.041666668f + x * (0.0083333338f + x * 0.0013888889f)))));
                A[r] = 1.0f + p; Bv[r] = __builtin_amdgcn_sqrtf(-p * (2.0f + p)) * iu[r]; }
        } else {
#pragma unroll
            for (int r = 0; r < 4; ++r) { A[r] = __expf(la[r]); Bv[r] = __builtin_amdgcn_sqrtf(-expm1f_(2.0f * la[r])) * iu[r]; }
        }
#pragma unroll
        for (int r = 0; r < 4; ++r) { float a_ = A[r], b_ = Bv[r]; scan16<REV>(a_, b_); A[r] = a_; Bv[r] = b_; }
        if (i == 0) {
            Ac[0] = A; Hl[0] = Bv;
#pragma unroll
            for (int r = 0; r < 4; ++r) { tA[r] = __shfl(A[r], edge); tB[r] = __shfl(Bv[r], edge); }
        } else {
            Ac[1] = A * tA; Hl[1] = A * tB + Bv;
#pragma unroll
            for (int r = 0; r < 4; ++r) { Atot[r] = __shfl(Ac[1][r], edge); hend[r] = __shfl(Hl[1][r], edge); }
        }
    }
}
__device__ __forceinline__ void lru_chain(const Ctx& C, int l, int id) {
    const int b = id >> 3, hd = (id >> 1) & 3, chalf = id & 1;
    const int lane = C.lane, l15 = lane & 15, q = lane >> 4;
    const int d = C.wave >> 2, mtl = (C.wave >> 1) & 1, th = C.wave & 1, mt = chalf * 2 + mtl;
    LAS bf16* U = (LAS bf16*)C.lds;
    LAS float* XCH = (LAS float*)(C.lds + 2 * 2 * 64 * UPC * 2);
    bf16* P = WSP(bf16, WS_P); bf16* LH = WSP(bf16, WS_LRUH) + (size_t)id * NSTEP * 32;
    const int cd = C.tid >> 8, cj = C.tid & 63, ctq = (C.tid >> 6) & 3;
    const float* cw = C.in[I_LCW] + (size_t)l * 4 * GW + hd * 64 + cj; const float w0 = cw[0], w1 = cw[GW], w2 = cw[2 * GW], w3 = cw[3 * GW], cb = C.in[I_LCB][l * GW + hd * 64 + cj];
    const bf16* wt = WSP(const bf16, WS_LRUWT) + (size_t)((d * 2 + 0) * 4 + hd) * 4096;
    fragb Wa[2], Wx[2];
#pragma unroll
    for (int ks = 0; ks < 2; ++ks) { Wa[ks] = *(const fragb*)(wt + (16 * mt + l15) * 64 + 32 * ks + 8 * q); Wx[ks] = *(const fragb*)(wt + 4 * 4096 + (16 * mt + l15) * 64 + 32 * ks + 8 * q); }
    const int ch0 = hd * 64 + 16 * mt + 4 * q;
    const f32x4 ba = *(const f32x4*)(C.in[I_LBA] + (l * 2 + d) * GW + ch0), bx = *(const f32x4*)(C.in[I_LBX] + (l * 2 + d) * GW + ch0), lam = *(const f32x4*)(C.in[I_LLAM] + (l * 2 + d) * GW + ch0);
    f32x4 sp4;
#pragma unroll
    for (int r = 0; r < 4; ++r) sp4[r] = 8.0f * softplusf_(-lam[r]);
    f32x4 s = (f32x4){0.f, 0.f, 0.f, 0.f};
    unsigned short xr[19];
#define LRU_LOADX(kk) do { const int c_ = lru_chunk_of(cd, (kk)); const bool ic_ = c_ < 4; const int p0_ = (ic_ ? c_ * 64 : (c_ - 4) * 64) + ctq * 16 - 2, Lp_ = ic_ ? CTXL : SEQ; \
        const bf16* xp_ = P + (size_t)(ic_ ? T_LAT + b * CTXL : b * SEQ) * PLD + hd * 64 + cj; \
        _Pragma("unroll") for (int i_ = 0; i_ < 19; ++i_) { const int p_ = p0_ + i_; xr[i_] = (p_ >= 0 && p_ < Lp_) ? xp_[(size_t)p_ * PLD] : (unsigned short)0; } } while (0)
#define LRU_CONV(kk) do { LAS bf16* uo_ = U + ((((kk) & 1) * 2 + cd) * 64 + ctq * 16) * UPC + cj; \
        _Pragma("unroll") for (int t_ = 0; t_ < 16; ++t_) uo_[t_ * UPC] = (bf16)f2bf1(w0 * bf2f(xr[t_]) + w1 * bf2f(xr[t_ + 1]) + w2 * bf2f(xr[t_ + 2]) + w3 * bf2f(xr[t_ + 3]) + cb); } while (0)
    LRU_LOADX(0); LRU_CONV(0); LRU_LOADX(1);
    __syncthreads();
#pragma unroll 1
    for (int k = 0; k < NCH; ++k) {
        if (k + 1 < NCH) { LRU_CONV(k + 1); if (k + 2 < NCH) LRU_LOADX(k + 2); }
        const int c = lru_chunk_of(d, k); const bool second = lru_chunk_of(1 - d, c) < k;
        const bool ic = c < 4; const size_t row0 = (size_t)(ic ? T_LAT + b * CTXL + c * 64 : b * SEQ + (c - 4) * 64);
        const bool late = (k == 2) || (k == 36);
        int tok[2]; v2u gv[2], fv[2];
#pragma unroll
        for (int i = 0; i < 2; ++i) { const int nt = d ? 3 - (2 * th + i) : 2 * th + i; tok[i] = 16 * nt + l15;
            if (second && !late) { gv[i] = *(const v2u*)(P + (row0 + tok[i]) * PLD + 256 + ch0); fv[i] = *(const v2u*)(LH + (size_t)(c * 64 + tok[i]) * 32 + 16 * mtl + 4 * q); } }
        f32x4 Ac[2], Hl[2], Atot, hend;
        const LAS bf16* Ud = U + ((k & 1) * 2 + d) * 64 * UPC;
        if (d) lru_tiles<true>(Ud, th, mt, lane, Wa, Wx, ba, bx, sp4, Ac, Hl, Atot, hend); else lru_tiles<false>(Ud, th, mt, lane, Wa, Wx, ba, bx, sp4, Ac, Hl, Atot, hend);
        LAS float* xw = XCH + (((((k & 1) * 2 + d) * 2 + mtl) * 2 + th) * 4 + q) * 8;
        if (l15 == (d ? 0 : 15)) { *(LAS f32x4*)xw = Atot; *(LAS f32x4*)(xw + 4) = hend; }
        if (late) VM_WAIT();
        RAW_BARRIER();
        if (second && late) {
#pragma unroll
            for (int i = 0; i < 2; ++i) { gv[i] = *(const v2u*)(P + (row0 + tok[i]) * PLD + 256 + ch0); fv[i] = *(const v2u*)(LH + (size_t)(c * 64 + tok[i]) * 32 + 16 * mtl + 4 * q); }
        }
        const LAS float* xr0 = XCH + (((((k & 1) * 2 + d) * 2 + mtl) * 2 + 0) * 4 + q) * 8;
        const f32x4 A0 = *(const LAS f32x4*)xr0, h0 = *(const LAS f32x4*)(xr0 + 4), A1 = *(const LAS f32x4*)(xr0 + 32), h1 = *(const LAS f32x4*)(xr0 + 36);
        const f32x4 mid = A0 * s + h0, hin = th ? mid : s;
        s = A1 * mid + h1;
#pragma unroll
        for (int i = 0; i < 2; ++i) {
            const f32x4 h = Ac[i] * hin + Hl[i];
            if (!second) { v2u o; o.x = pk2(h.x, h.y); o.y = pk2(h.z, h.w); *(v2u*)(LH + (size_t)(c * 64 + tok[i]) * 32 + 16 * mtl + 4 * q) = o; }
            else {
                const f32x4 g = (f32x4){bflo(gv[i].x), bfhi(gv[i].x), bflo(gv[i].y), bfhi(gv[i].y)};
                f32x4 y = (f32x4){h.x + bflo(fv[i].x), h.y + bfhi(fv[i].x), h.z + bflo(fv[i].y), h.w + bfhi(fv[i].y)};
                y.x *= gelu_tanh(g.x); y.y *= gelu_tanh(g.y); y.z *= gelu_tanh(g.z); y.w *= gelu_tanh(g.w);
                st4bf(P + (row0 + tok[i]) * PLD + 256 + ch0, y);
            }
        }
    }
#undef LRU_LOADX
#undef LRU_CONV
    __syncthreads();
}
constexpr int RP = 264;
__device__ __forceinline__ void rwkv_prep2(const Ctx& C, int l, int b, int c) {
    LAS bf16* RS = (LAS bf16*)C.lds;
    LAS bf16* KS = RS + 64 * RP;
    LAS bf16* XW = KS + 64 * RP;
    LAS bf16* XA = XW + 64 * MP;
    LAS bf16* XG = XA + 64 * MP;
    const bf16* P = WSP(const bf16, WS_P);
    const bool isctx = c < 4; const int p0 = isctx ? c * 64 : (c - 4) * 64; const int Lp = isctx ? CTXL : SEQ; const int row0 = isctx ? T_LAT + b * CTXL : b * SEQ;
    const float* mu = C.in[I_RMU] + (size_t)l * 2 * B_COLS;
    bf16* rkv = WSP(bf16, WS_RKV);
    unsigned tch0_ = 0u, tch1_ = 0u;
    { const int i0 = C.tid, i1 = C.tid + NTHR;
      { const int rr = i0 / 15, ln = i0 % 15; int p = p0 - 1 + rr; p = p < 0 ? 0 : (p > Lp - 1 ? Lp - 1 : p); tch0_ = *(volatile const unsigned*)(P + (size_t)(row0 + p) * PLD + OFF_B + ln * 64); }
      if (i1 < 66 * 15) { const int rr = i1 / 15, ln = i1 % 15; int p = p0 - 1 + rr; p = p < 0 ? 0 : (p > Lp - 1 ? Lp - 1 : p); tch1_ = *(volatile const unsigned*)(P + (size_t)(row0 + p) * PLD + OFF_B + ln * 64); } }
#pragma unroll 5
    for (int it = C.tid; it < 64 * 120; it += NTHR) {
        const int t = it / 120, c8 = (it % 120) * 8, p = p0 + t;
        const bf16* pp = P + (size_t)(row0 + p) * PLD + OFF_B + c8;
        const v4u xc = *(const v4u*)pp; v4u xp = (v4u){0u, 0u, 0u, 0u}, xn = xp;
        if (p > 0) xp = *(const v4u*)(pp - PLD);
        if (p < Lp - 1) xn = *(const v4u*)(pp + PLD);
        const f32x4 m0a = *(const f32x4*)(mu + c8), m0b = *(const f32x4*)(mu + c8 + 4), m1a = *(const f32x4*)(mu + B_COLS + c8), m1b = *(const f32x4*)(mu + B_COLS + c8 + 4);
        const unsigned xcw[4] = {xc.x, xc.y, xc.z, xc.w}, xpw[4] = {xp.x, xp.y, xp.z, xp.w}, xnw[4] = {xn.x, xn.y, xn.z, xn.w};
        float sh[8];
#pragma unroll
        for (int e = 0; e < 4; ++e) {
            const float x0 = bflo(xcw[e]), x1 = bfhi(xcw[e]);
            const float mu0_0 = e < 2 ? m0a[2 * e] : m0b[2 * e - 4], mu0_1 = e < 2 ? m0a[2 * e + 1] : m0b[2 * e - 3], mu1_0 = e < 2 ? m1a[2 * e] : m1b[2 * e - 4], mu1_1 = e < 2 ? m1a[2 * e + 1] : m1b[2 * e - 3];
            sh[2 * e] = x0 + mu0_0 * (bflo(xpw[e]) - x0) + mu1_0 * (bflo(xnw[e]) - x0);
            sh[2 * e + 1] = x1 + mu0_1 * (bfhi(xpw[e]) - x1) + mu1_1 * (bfhi(xnw[e]) - x1);
        }
        if (c8 >= 768) {
            const int ci = c8 - 768;
            if (ci < 64) {
#pragma unroll
                for (int e = 0; e < 8; ++e) sh[e] = tanhf_(sh[e]); }
            else if (ci >= 128) {
#pragma unroll
                for (int e = 0; e < 8; ++e) sh[e] = sigmoidf_(sh[e]); }
        }
        v4u o; o.x = pk2(sh[0], sh[1]); o.y = pk2(sh[2], sh[3]); o.z = pk2(sh[4], sh[5]); o.w = pk2(sh[6], sh[7]);
        if (c8 < 768) {
            *(v4u*)(rkv + (size_t)(row0 + p) * 768 + c8) = o;
            if (c8 < 256) *(LAS v4u*)(RS + t * RP + c8) = o; else if (c8 < 512) *(LAS v4u*)(KS + t * RP + c8 - 256) = o;
        } else {
            const int ci = c8 - 768;
            LAS bf16* dst = ci < 64 ? XW + t * MP + ci : (ci < 128 ? XA + t * MP + ci - 64 : XG + t * MP + ci - 128);
            *(LAS v4u*)dst = o;
        }
    }
    __syncthreads();
    const int lane = C.lane, w = C.wave, l15 = lane & 15, q = lane >> 4, hd = w & 3, ntp = w >> 2;
    const bf16* wt = WSP(const bf16, WS_RWT);
    bf16* wa_out = WSP(bf16, WS_HB); bf16* g_out = WSP(bf16, WS_G); float* bonus = WSP(float, WS_BONUS); float* rinv = WSP(float, WS_RINV);
    const f32x4 z4 = (f32x4){0.f, 0.f, 0.f, 0.f};
    float bsum[2] = {0.f, 0.f}, ksum[2] = {0.f, 0.f};
#pragma unroll
    for (int n2 = 0; n2 < 2; ++n2) {
        const int tok = 16 * (2 * ntp + n2) + l15; const size_t row = (size_t)(row0 + p0 + tok);
        const fragb xw0 = ld_frag16(XW + tok * MP + 8 * q), xw1 = ld_frag16(XW + tok * MP + 32 + 8 * q), xa0 = ld_frag16(XA + tok * MP + 8 * q), xa1 = ld_frag16(XA + tok * MP + 32 + 8 * q);
        const fragb xg0 = ld_frag16(XG + tok * MP + 8 * q), xg1 = ld_frag16(XG + tok * MP + 32 + 8 * q);
        unsigned ow0[8], ow1[8], oa0[8], oa1[8], og[8];
#pragma unroll
        for (int mt = 0; mt < 4; ++mt) {
            const int chl = 16 * (l15 >> 2) + 4 * mt + (l15 & 3), ch4 = hd * 64 + 16 * q + 4 * mt;
            const bf16* wrow = wt + (size_t)(hd * 64 + chl) * 32 + 8 * q;
            const bf16* grow = wt + 4 * 256 * 32 + (size_t)(hd * 64 + chl) * 64 + 8 * q;
            const fragb fw0 = *(const fragb*)(wrow), fw1 = *(const fragb*)(wrow + 256 * 32), fa0 = *(const fragb*)(wrow + 2 * 256 * 32), fa1 = *(const fragb*)(wrow + 3 * 256 * 32), fg0 = *(const fragb*)(grow), fg1 = *(const fragb*)(grow + 32);
            const f32x4 w00 = *(const f32x4*)(C.in[I_RW0] + (l * 2 + 0) * GW + ch4), w01 = *(const f32x4*)(C.in[I_RW0] + (l * 2 + 1) * GW + ch4);
            const f32x4 a00 = *(const f32x4*)(C.in[I_RA0] + (l * 2 + 0) * GW + ch4), a01 = *(const f32x4*)(C.in[I_RA0] + (l * 2 + 1) * GW + ch4);
            const f32x4 k_a = *(const f32x4*)(C.in[I_RKA] + l * GW + ch4), r_k = *(const f32x4*)(C.in[I_RRK] + l * GW + ch4), k_k = *(const f32x4*)(C.in[I_RKK] + l * GW + ch4);
            const f32x4 aw0 = mfma16(fw0, xw0, z4), aw1 = mfma16(fw1, xw1, z4), aa0 = mfma16(fa0, xa0, z4), aa1 = mfma16(fa1, xa1, z4);
            f32x4 ag = mfma16(fg0, xg0, z4); ag = mfma16(fg1, xg1, ag);
            f32x4 wv0, wv1, av0, av1;
#pragma unroll
            for (int r = 0; r < 4; ++r) {
                wv0[r] = __expf(-0.6065306597126334f * sigmoidf_(aw0[r] + w00[r])); wv1[r] = __expf(-0.6065306597126334f * sigmoidf_(aw1[r] + w01[r]));
                av0[r] = sigmoidf_(aa0[r] + a00[r]); av1[r] = sigmoidf_(aa1[r] + a01[r]);
            }
            ow0[2 * mt] = pk2(wv0[0], wv0[1]); ow0[2 * mt + 1] = pk2(wv0[2], wv0[3]); ow1[2 * mt] = pk2(wv1[0], wv1[1]); ow1[2 * mt + 1] = pk2(wv1[2], wv1[3]);
            oa0[2 * mt] = pk2(av0[0], av0[1]); oa0[2 * mt + 1] = pk2(av0[2], av0[3]); oa1[2 * mt] = pk2(av1[0], av1[1]); oa1[2 * mt + 1] = pk2(av1[2], av1[3]);
            og[2 * mt] = pk2(ag[0], ag[1]); og[2 * mt + 1] = pk2(ag[2], ag[3]);
            const v2u rr_ = *(const LAS v2u*)(RS + tok * RP + ch4), kr_ = *(const LAS v2u*)(KS + tok * RP + ch4);
            const f32x4 rs = (f32x4){bflo(rr_.x), bfhi(rr_.x), bflo(rr_.y), bfhi(rr_.y)}, ks = (f32x4){bflo(kr_.x), bfhi(kr_.x), bflo(kr_.y), bfhi(kr_.y)};
#pragma unroll
            for (int r = 0; r < 4; ++r) {
                const float km = ks[r] * (1.0f + (av0[r] - 1.0f) * k_a[r]) + ks[r] * (1.0f + (av1[r] - 1.0f) * k_a[r]);
                bsum[n2] += rs[r] * r_k[r] * km; const float kk = ks[r] * k_k[r]; ksum[n2] += kk * kk;
            }
        }
        bf16* wrow_o = wa_out + row * 1024 + hd * 64 + 16 * q;
        *(v4u*)(wrow_o) = (v4u){ow0[0], ow0[1], ow0[2], ow0[3]}; *(v4u*)(wrow_o + 8) = (v4u){ow0[4], ow0[5], ow0[6], ow0[7]};
        *(v4u*)(wrow_o + 256) = (v4u){ow1[0], ow1[1], ow1[2], ow1[3]}; *(v4u*)(wrow_o + 256 + 8) = (v4u){ow1[4], ow1[5], ow1[6], ow1[7]};
        *(v4u*)(wrow_o + 512) = (v4u){oa0[0], oa0[1], oa0[2], oa0[3]}; *(v4u*)(wrow_o + 512 + 8) = (v4u){oa0[4], oa0[5], oa0[6], oa0[7]};
        *(v4u*)(wrow_o + 768) = (v4u){oa1[0], oa1[1], oa1[2], oa1[3]}; *(v4u*)(wrow_o + 768 + 8) = (v4u){oa1[4], oa1[5], oa1[6], oa1[7]};
        bf16* grow_o = g_out + row * 256 + hd * 64 + 16 * q;
        *(v4u*)(grow_o) = (v4u){og[0], og[1], og[2], og[3]}; *(v4u*)(grow_o + 8) = (v4u){og[4], og[5], og[6], og[7]};
    }
#pragma unroll
    for (int n2 = 0; n2 < 2; ++n2) {
        const size_t row = (size_t)(row0 + p0 + 16 * (2 * ntp + n2) + l15);
        float bs = bsum[n2], ks2 = ksum[n2];
        bs += __shfl_xor(bs, 16); bs += __shfl_xor(bs, 32); ks2 += __shfl_xor(ks2, 16); ks2 += __shfl_xor(ks2, 32);
        if (q == 0) { bonus[row * 4 + hd] = bs; rinv[row * 4 + hd] = rsqrtf_(ks2 + 1e-6f); }
    }
    asm volatile("" :: "v"(tch0_), "v"(tch1_));
    __syncthreads();
}
__device__ __forceinline__ int fwd_row_r(int b, int c, int t) { return c < 4 ? (T_LAT + b * CTXL + c * 64 + t) : (b * SEQ + (c - 4) * 64 + t); }
__device__ __forceinline__ bf16* rw_blob_row(const Ctx& C, int d, int which, int b, int c, int h, int r) {
    const int row = fwd_row_r(b, c, r);
#if RW_VSPLIT
    if (which == 0) { if (d) return WSP(bf16, WS_GQ) + (size_t)row * 768 + 512 + h * 64;
                      return WSP(bf16, WS_P) + (size_t)row * PLD + OFF_B + 512 + h * 64; }
#else
    if (which == 0) return WSP(bf16, WS_OUTB) + ((size_t)d * T_ALL + row) * 256 + h * 64;
#endif
    return WSP(bf16, WS_P) + (size_t)row * PLD + OFF_B + d * 256 + h * 64;
}
struct RwStage { v4u w[4], a[4], k[4]; float ril, k_k, k_a; };
__device__ __forceinline__ void rwkv_solve_load(const Ctx& C, int l, int item, RwStage& S) {
    const int lane = C.lane, pw = C.wave & 1;
    const bf16* WA = WSP(const bf16, WS_HB); const bf16* rkv = WSP(const bf16, WS_RKV); const float* rinv = WSP(const float, WS_RINV);
    const int u = item >> 1, d = item & 1;
    const int c = u % NCH, h = (u / NCH) & 3, b = u / (NCH * NH);
    const int n = d ? (c < 4 ? 3 - c : 71 - c) : c;
    S.k_k = C.in[I_RKK][l * GW + h * 64 + lane]; S.k_a = C.in[I_RKA][l * GW + h * 64 + lane];
    S.ril = rinv[(size_t)seqrow_raster(n * 64 + lane, d, b) * 4 + h];
#pragma unroll
    for (int r = 0; r < 4; ++r) { const int idx2 = pw * 64 + lane + 128 * r, t = idx2 >> 3, part = idx2 & 7; const int row = seqrow_raster(n * 64 + t, d, b);
        S.w[r] = *(const v4u*)(WA + (size_t)row * 1024 + d * 256 + h * 64 + 8 * part);
        S.a[r] = *(const v4u*)(WA + (size_t)row * 1024 + (2 + d) * 256 + h * 64 + 8 * part);
        S.k[r] = *(const v4u*)(rkv + (size_t)row * 768 + 256 + h * 64 + 8 * part); }
}
__device__ __forceinline__ void rwkv_solve_touch(const Ctx& C, int item, unsigned& t0, unsigned& t1) {
    const int lane = C.lane, pw = C.wave & 1;
    const bf16* WA = WSP(const bf16, WS_HB); const bf16* rkv = WSP(const bf16, WS_RKV);
    const int u = item >> 1, d = item & 1;
    const int c = u % NCH, h = (u / NCH) & 3, b = u / (NCH * NH);
    const int n = d ? (c < 4 ? 3 - c : 71 - c) : c;
    const int j = pw * 64 + lane;
    { const int row = seqrow_raster(n * 64 + (j & 63), d, b);
      t0 = *(volatile const unsigned*)(WA + (size_t)row * 1024 + ((j >> 6) ? (2 + d) : d) * 256 + h * 64); }
    { const int row = seqrow_raster(n * 64 + lane, d, b);
      t1 = *(volatile const unsigned*)(rkv + (size_t)row * 768 + 256 + h * 64); }
}
__device__ __forceinline__ void rwkv_solve_stage(const Ctx& C, const RwStage& S) {
    const int lane = C.lane, w = C.wave, pw = w & 1, pi = w >> 1;
    LAS unsigned char* B0 = C.lds + pi * 31744;
    LAS bf16* Kk = (LAS bf16*)B0; LAS bf16* Bh = Kk + 64 * MP; LAS bf16* Kh = Bh + 64 * MP;
#pragma unroll
    for (int r = 0; r < 4; ++r) { const int idx2 = pw * 64 + lane + 128 * r, t = idx2 >> 3, part = idx2 & 7;
        *(LAS v4u*)(Kk + t * MP + 8 * part) = S.w[r]; *(LAS v4u*)(Bh + t * MP + 8 * part) = S.a[r]; *(LAS v4u*)(Kh + t * MP + 8 * part) = S.k[r]; }
    RAW_BARRIER();
}
__device__ __forceinline__ void rwkv_solve_rest(const Ctx& C, int l, int item, const float ril, const float k_k, const float k_a) {
    const int lane = C.lane, w = C.wave, pw = w & 1, pi = w >> 1, l15 = lane & 15, q = lane >> 4;
    LAS unsigned char* B0 = C.lds + pi * 31744;
    LAS bf16* Kk = (LAS bf16*)B0; LAS bf16* Bh = Kk + 64 * MP; LAS bf16* Kh = Bh + 64 * MP;
    LAS bf16* Ln = (LAS bf16*)B0;
    LAS bf16* Lk16 = (LAS bf16*)(B0 + 9216);
    LAS unsigned char* XT = B0 + 9216;
    LAS bf16* TinvP = (LAS bf16*)(B0 + 25600);
    bf16* WAw = WSP(bf16, WS_HB);
    const int u = item >> 1, d = item & 1;
    const int c = u % NCH, h = (u / NCH) & 3, b = u / (NCH * NH);
    const int n = d ? (c < 4 ? 3 - c : 71 - c) : c;
    {
        float cc = 1.0f;
        if (pw) {
#pragma unroll
            for (int t = 0; t < 32; ++t) cc *= bf2f(Kk[t * MP + lane]);
        }
        RAW_BARRIER();
#pragma unroll
        for (int t2 = 0; t2 < 32; ++t2) {
            const int t = pw * 32 + t2;
            const float wv = bf2f(Kk[t * MP + lane]), av = bf2f(Bh[t * MP + lane]), ks = bf2f(Kh[t * MP + lane]);
            const float kap = ks * k_k * __shfl(ril, t);
            const float cprev = cc; cc *= wv; const float ic = __builtin_amdgcn_rcpf(cc);
            Kk[t * MP + lane] = (bf16)f2bf1(kap * cprev); Bh[t * MP + lane] = (bf16)f2bf1(kap * av * ic); Kh[t * MP + lane] = (bf16)f2bf1(ks * (1.0f + (av - 1.0f) * k_a) * ic);
            WAw[(size_t)seqrow_raster(n * 64 + t, d, b) * 1024 + d * 256 + h * 64 + lane] = (bf16)f2bf1(cc);
        }
    }
    RAW_BARRIER();
    f32x4 acc[4][4];
    if (pw == 0) {
#pragma unroll
        for (int I = 0; I < 4; ++I)
#pragma unroll
            for (int r = 0; r < 4; ++r)
#pragma unroll
                for (int nt = 0; nt < 4; ++nt) acc[I][nt][r] = bf2f(Kk[(16 * I + 4 * q + r) * MP + 16 * nt + l15]);
    }
    f32x4 T[10];
    {
        const LAS bf16* Bsrc = pw ? Kh : Bh;
        int tix = 0;
#pragma unroll
        for (int it = 0; it < 4; ++it)
#pragma unroll
            for (int jt = 0; jt <= it; ++jt, ++tix) {
                f32x4 t4 = (f32x4){0.f, 0.f, 0.f, 0.f};
#pragma unroll
                for (int s = 0; s < 2; ++s) t4 = mfma16(ld_frag16(Kk + (16 * it + l15) * MP + 32 * s + 8 * q), ld_frag16(Bsrc + (16 * jt + l15) * MP + 32 * s + 8 * q), t4);
#pragma unroll
                for (int r = 0; r < 4; ++r) { const int i = 16 * it + 4 * q + r, j = 16 * jt + l15; T[tix][r] = (j < i) ? (pw ? t4[r] : -t4[r]) : 0.f; }
            }
    }
    RAW_BARRIER();
    {
        int tix = 0;
#pragma unroll
        for (int it = 0; it < 4; ++it)
#pragma unroll
            for (int jt = 0; jt < 4; ++jt) {
                if (jt <= it) {
#pragma unroll
                    for (int r = 0; r < 4; ++r) (pw ? Lk16 : Ln)[(16 * it + 4 * q + r) * MP + 16 * jt + l15] = (bf16)f2bf1(T[tix][r]);
                    ++tix;
                } else if (pw == 0) {
#pragma unroll
                    for (int r = 0; r < 4; ++r) Ln[(16 * it + 4 * q + r) * MP + 16 * jt + l15] = (bf16)0;
                }
            }
        LAS v4u* tz = (LAS v4u*)(B0 + 25600) + (pw * 64 + lane) * 2; tz[0] = (v4u){0u, 0u, 0u, 0u}; tz[1] = (v4u){0u, 0u, 0u, 0u};
    }
    RAW_BARRIER();
    if (pw) {
#pragma unroll
        for (int I = 0; I < 4; ++I)
#pragma unroll
            for (int r = 0; r < 4; ++r)
#pragma unroll
                for (int nt = 0; nt < 4; ++nt) { const int i = 16 * I + 4 * q + r, j = 16 * nt + l15; acc[I][nt][r] = (j < i && nt <= I) ? bf2f(Lk16[i * MP + j]) : 0.f; }
    } else diag_inverses(Ln, TinvP, lane);
    RAW_BARRIER();
    LAS unsigned char* XTw = XT + pw * 8192;
    { LAS v4u* xz = (LAS v4u*)(XTw + lane * 128);
#pragma unroll
        for (int g = 0; g < 8; ++g) xz[g] = (v4u){0u, 0u, 0u, 0u}; }
    blocked_solve(Ln, TinvP, XTw, acc, l15, q);
    {
        bf16* dst = rw_blob_row(C, d, pw, b, c, h, lane);
        const LAS unsigned char* xr = XTw + lane * 128;
#pragma unroll
        for (int g = 0; g < 8; ++g) *(v4u*)(dst + 8 * g) = *(const LAS v4u*)(xr + ((g ^ (lane & 7)) << 4));
    }
    RAW_BARRIER();
}

__device__ __forceinline__ void rwkv_solve_item(const Ctx& C, int l, int item) { RwStage S; rwkv_solve_load(C, l, item, S); rwkv_solve_stage(C, S); rwkv_solve_rest(C, l, item, S.ril, S.k_k, S.k_a); }
__device__ __forceinline__ int rwkv_item_of(int k, int pair) {
    const int s = k >> 4, qd = ((k & 15) << 2) + pair, d = qd >> 5, b = (qd >> 2) & 7, h = qd & 3;
    const int c = d ? (s < 4 ? 3 - s : 71 - s) : s;
    return 2 * ((b * NH + h) * NCH + c) + d;
}
constexpr int RW_EB1 = 16, RW_EB2 = 40, RW_EB3 = 51;
template <bool DRY>
__device__ __forceinline__ void rwkv_chunked(const Ctx& C, int l, int idx, unsigned* epc = nullptr, unsigned nsolvers = 0u) {
#ifndef RW_VSPLIT
#define RW_VSPLIT 1
#endif
    constexpr int NV = RW_VSPLIT ? 1 : 2;
    const int vhalf = idx & 1, lane = C.lane, w = C.wave, l15 = lane & 15, q = lane >> 4;
    const int d = RW_VSPLIT ? idx >> 6 : idx >> 5, b = RW_VSPLIT ? (idx >> 3) & 7 : (idx >> 2) & 7, h = RW_VSPLIT ? (idx >> 1) & 3 : idx & 3;
    const int it = w & 3, vt0 = RW_VSPLIT ? 2 * vhalf + (w >> 2) : 2 * (w >> 2);
    constexpr int IMG = 64 * MP * 2;
    LAS unsigned char* L0 = C.lds;
    LAS bf16* Wi = (LAS bf16*)L0; LAS bf16* Ti = Wi + 64 * MP; LAS bf16* Rh = Ti + 64 * MP; LAS bf16* Kh = Rh + 64 * MP; LAS bf16* Bh = Kh + 64 * MP;
    LAS bf16* UT = (LAS bf16*)(L0 + 11 * IMG);
    LAS float* cLv = (LAS float*)(L0 + 14 * IMG);
    const bf16* WA = WSP(const bf16, WS_HB); const bf16* rkv = WSP(const bf16, WS_RKV); const float* rinv = WSP(const float, WS_RINV);
    bf16* outb = WSP(bf16, WS_OUTB) + (size_t)d * T_ALL * 256;
    const int tt = C.tid >> 3, part = C.tid & 7;
    for (int i = C.tid; i < 2 * IMG / 4; i += NTHR) ((LAS unsigned*)(L0 + 12 * IMG))[i] = 0u;
    float kkw[8], kaw[8];
#pragma unroll
    for (int e = 0; e < 8; ++e) { kkw[e] = C.in[I_RKK][l * GW + h * 64 + 8 * w + e]; kaw[e] = C.in[I_RKA][l * GW + h * 64 + 8 * w + e]; }
    v4u gr, gk, gv, gw, ga, gbw, gbt; float gri;
    auto gload = [&](int n) {
        const int c = d ? (n < 4 ? 3 - n : 71 - n) : n;
        const int row = seqrow_raster(n * 64 + lane, d, b);
        const bf16* pr = rkv + (size_t)row * 768 + h * 64 + 8 * w;
        gr = *(const v4u*)pr; gk = *(const v4u*)(pr + 256); gv = *(const v4u*)(pr + 512);
        gw = *(const v4u*)(WA + (size_t)row * 1024 + d * 256 + h * 64 + 8 * w); ga = *(const v4u*)(WA + (size_t)row * 1024 + (2 + d) * 256 + h * 64 + 8 * w);
        gri = rinv[(size_t)row * 4 + h];
        gbw = *(const v4u*)(rw_blob_row(C, d, 0, b, c, h, tt) + 8 * part); gbt = *(const v4u*)(rw_blob_row(C, d, 1, b, c, h, tt) + 8 * part);
    };
    auto images = [&](int bufi) {
        LAS bf16* VT = (LAS bf16*)(L0 + (5 + 3 * bufi) * IMG); LAS bf16* KcT = VT + 64 * MP; LAS bf16* BcT = KcT + 64 * MP;
        const unsigned rw_[4] = {gr.x, gr.y, gr.z, gr.w}, kw_[4] = {gk.x, gk.y, gk.z, gk.w}, vw_[4] = {gv.x, gv.y, gv.z, gv.w}, ww_[4] = {gw.x, gw.y, gw.z, gw.w}, aw_[4] = {ga.x, ga.y, ga.z, ga.w};
        float rh[8], kh[8], bh[8];
#pragma unroll
        for (int e = 0; e < 8; ++e) {
            const float rs = (e & 1) ? bfhi(rw_[e >> 1]) : bflo(rw_[e >> 1]), ks = (e & 1) ? bfhi(kw_[e >> 1]) : bflo(kw_[e >> 1]);
            const float wv = (e & 1) ? bfhi(ww_[e >> 1]) : bflo(ww_[e >> 1]), av = (e & 1) ? bfhi(aw_[e >> 1]) : bflo(aw_[e >> 1]);
            const float kap = ks * kkw[e] * gri, ktil = ks * (1.0f + (av - 1.0f) * kaw[e]);
            const float cf = wv, icf = __builtin_amdgcn_rcpf(cf), cfL = __builtin_bit_cast(float, __builtin_amdgcn_readlane(__builtin_bit_cast(int, cf), 63)), dec = cfL * icf;
            rh[e] = rs * cf; kh[e] = ktil * icf; bh[e] = kap * av * icf;
            const unsigned short vraw = (e & 1) ? (unsigned short)(vw_[e >> 1] >> 16) : (unsigned short)(vw_[e >> 1] & 0xffffu);
            VT[(8 * w + e) * MP + lane] = vraw; KcT[(8 * w + e) * MP + lane] = (bf16)f2bf1(ktil * dec); BcT[(8 * w + e) * MP + lane] = (bf16)f2bf1(-(kap * av * dec));
            if (lane == 63) cLv[bufi * 64 + 8 * w + e] = cfL;
        }
        { v4u o; o.x = pk2(rh[0], rh[1]); o.y = pk2(rh[2], rh[3]); o.z = pk2(rh[4], rh[5]); o.w = pk2(rh[6], rh[7]); *(LAS v4u*)(Rh + lane * MP + 8 * w) = o; }
        { v4u o; o.x = pk2(kh[0], kh[1]); o.y = pk2(kh[2], kh[3]); o.z = pk2(kh[4], kh[5]); o.w = pk2(kh[6], kh[7]); *(LAS v4u*)(Kh + lane * MP + 8 * w) = o; }
        { v4u o; o.x = pk2(bh[0], bh[1]); o.y = pk2(bh[2], bh[3]); o.z = pk2(bh[4], bh[5]); o.w = pk2(bh[6], bh[7]); *(LAS v4u*)(Bh + lane * MP + 8 * w) = o; }
        const unsigned bw_[4] = {gbw.x, gbw.y, gbw.z, gbw.w}, bt_[4] = {gbt.x, gbt.y, gbt.z, gbt.w};
#pragma unroll
        for (int e = 0; e < 4; ++e) {
            Wi[(8 * part + 2 * e) * MP + tt] = (bf16)(bw_[e] & 0xffffu); Wi[(8 * part + 2 * e + 1) * MP + tt] = (bf16)(bw_[e] >> 16);
            Ti[(8 * part + 2 * e) * MP + tt] = (bf16)(bt_[e] & 0xffffu); Ti[(8 * part + 2 * e + 1) * MP + tt] = (bf16)(bt_[e] >> 16);
        }
    };
    f32x4 Zst[NV];
#pragma unroll
    for (int v2 = 0; v2 < NV; ++v2) Zst[v2] = (f32x4){0.f, 0.f, 0.f, 0.f};
    const f32x4 z4 = (f32x4){0.f, 0.f, 0.f, 0.f};
    gload(0); images(0); gload(1);
#pragma unroll 1
    for (int n = 0; n < NCH; ++n) {
        RAW_BARRIER();
        const LAS bf16* VT = (const LAS bf16*)(L0 + (5 + 3 * (n & 1)) * IMG); const LAS bf16* KcT = VT + 64 * MP; const LAS bf16* BcT = KcT + 64 * MP;
        const LAS bf16* Zi = (const LAS bf16*)(L0 + (12 + (n & 1)) * IMG); LAS bf16* Zn = (LAS bf16*)(L0 + (12 + ((n + 1) & 1)) * IMG);
        const int arow = (16 * it + l15) * MP + 8 * q;
        const fragb Wf0 = ld_frag16(Wi + arow), Wf1 = ld_frag16(Wi + arow + 32), Tf0 = ld_frag16(Ti + arow), Tf1 = ld_frag16(Ti + arow + 32), Rf0 = ld_frag16(Rh + arow), Rf1 = ld_frag16(Rh + arow + 32);
        const int icol = 16 * it + l15;
        f32x4 pk[4], pb[4];
#pragma unroll
        for (int jt = 0; jt < 4; ++jt) {
            pk[jt] = z4; pb[jt] = z4;
            if (jt <= it) {
                const int jrow = (16 * jt + l15) * MP + 8 * q;
                f32x4 sk = mfma16(ld_frag16(Kh + jrow), Rf0, z4); sk = mfma16(ld_frag16(Kh + jrow + 32), Rf1, sk);
                f32x4 sb = mfma16(ld_frag16(Bh + jrow), Rf0, z4); sb = mfma16(ld_frag16(Bh + jrow + 32), Rf1, sb);
#pragma unroll
                for (int r = 0; r < 4; ++r) { const int j = 16 * jt + 4 * q + r; pk[jt][r] = (j <= icol) ? sk[r] : 0.f; pb[jt][r] = (j <= icol) ? -sb[r] : 0.f; }
            }
        }
        fragb Pk0 = pack_frag(pk[0], pk[1]), Pk1 = pack_frag(pk[2], pk[3]), Pb0 = pack_frag(pb[0], pb[1]), Pb1 = pack_frag(pb[2], pb[3]);
        f32x4 RZ[NV];
#pragma unroll
        for (int v2 = 0; v2 < NV; ++v2) {
            const int vrow = 16 * (vt0 + v2) + l15;
            const fragb z0 = ld_frag16(Zi + vrow * MP + 8 * q), z1 = ld_frag16(Zi + vrow * MP + 32 + 8 * q);
            f32x4 u = mfma16(Wf0, z0, z4); u = mfma16(Wf1, z1, u);
            u = mfma16(Tf0, ld_frag16(VT + vrow * MP + 8 * q), u); if (it >= 2) u = mfma16(Tf1, ld_frag16(VT + vrow * MP + 32 + 8 * q), u);
            RZ[v2] = mfma16(Rf0, z0, z4); RZ[v2] = mfma16(Rf1, z1, RZ[v2]);
            v2u o; o.x = pk2(u.x, u.y); o.y = pk2(u.z, u.w);
            *(LAS v2u*)(UT + vrow * MP + 16 * it + 4 * q) = o;
        }
        RAW_BARRIER();
        {
            const f32x4 cl4 = *(const LAS f32x4*)(cLv + (n & 1) * 64 + 16 * it + 4 * q);
            const LAS bf16* kr = KcT + (16 * it + l15) * MP + 4 * q; const LAS bf16* br = BcT + (16 * it + l15) * MP + 4 * q;
            const fragb kc0 = ld_frag8x2(kr, kr + 16), kc1 = ld_frag8x2(kr + 32, kr + 48), bc0 = ld_frag8x2(br, br + 16), bc1 = ld_frag8x2(br + 32, br + 48);
#pragma unroll
            for (int v2 = 0; v2 < NV; ++v2) {
                const int vrow = 16 * (vt0 + v2) + l15;
                const LAS bf16* vr = VT + vrow * MP + 4 * q; const LAS bf16* ur = UT + vrow * MP + 4 * q;
                const fragb vp0 = ld_frag8x2(vr, vr + 16), vp1 = ld_frag8x2(vr + 32, vr + 48), up0 = ld_frag8x2(ur, ur + 16), up1 = ld_frag8x2(ur + 32, ur + 48);
                f32x4 y = mfma16(Pk0, vp0, RZ[v2]); y = mfma16(Pb0, up0, y);
                if (it >= 2) { y = mfma16(Pk1, vp1, y); y = mfma16(Pb1, up1, y); }
#pragma unroll
                for (int r = 0; r < 4; ++r) { const int row = seqrow_raster(n * 64 + 16 * it + 4 * q + r, d, b); if (!DRY) outb[(size_t)row * 256 + h * 64 + vrow] = (bf16)f2bf1(y[r]); }
                f32x4 zn = mfma16(kc0, vp0, z4); zn = mfma16(kc1, vp1, zn); zn = mfma16(bc0, up0, zn); zn = mfma16(bc1, up1, zn);
                Zst[v2] = Zst[v2] * cl4 + zn;
                v2u so; so.x = pk2(Zst[v2].x, Zst[v2].y); so.y = pk2(Zst[v2].z, Zst[v2].w);
                *(LAS v2u*)(Zn + vrow * MP + 16 * it + 4 * q) = so;
            }
        }
        if (n + 1 < NCH) { images((n + 1) & 1);
            if (n + 2 < NCH) {
                const int s2 = n + 2;
                if (epc && (s2 == RW_EB1 || s2 == RW_EB2)) {
                    const int e_ = s2 == RW_EB1 ? 1 : 2;
                    if (C.tid == 0) { unsigned* bar_ = WSP(unsigned, WS_CTL) + CW_BAR; XB_SPIN(xb_ld(epc + 8 * e_) < nsolvers, bar_); __builtin_amdgcn_fence(__ATOMIC_ACQUIRE, "agent"); asm volatile("s_waitcnt vmcnt(0)" ::: "memory"); }
                    __syncthreads();
                }
                gload(s2);
            } }
    }
    __syncthreads();
}
__device__ __forceinline__ void moe_scatter(const Ctx& C, int moe_li, int nrows) {
    const unsigned* gc = WSP(const unsigned, WS_CTL) + CW_MOECNT + 64 * moe_li;
    LAS int* pst = (LAS int*)C.lds;
    {
        int pe[8]; int acc = 0;
#pragma unroll
        for (int e = 0; e < NE; ++e) { const int blks = ((int)gc[e] + 255) >> 8; if (C.tid == e) pst[e] = acc * 256; acc += blks; pe[e] = acc; }
        if (C.wg == 0 && C.tid < MOE_MAXBLK) { int be = 0;
#pragma unroll
            for (int e = 0; e < NE; ++e) be += (pe[e] <= C.tid) ? 1 : 0;
            int* tab = WSP(int, WS_TAB); tab[1 + C.tid] = be < NE ? be : NE - 1; if (C.tid == 0) tab[0] = acc; }
    }
    __syncthreads();
    const unsigned* route = WSP(const unsigned, WS_ROUTE); const unsigned* wgbase = WSP(const unsigned, WS_WGBASE);
    int* pos = WSP(int, WS_POS); int* tok = WSP(int, WS_TOK);
    if (C.wg < NE) { const int cnt = (int)gc[C.wg], s0 = pst[C.wg] + cnt, s1 = pst[C.wg] + (((cnt + 255) >> 8) << 8);
        for (int j = s0 + C.tid; j < s1; j += NTHR) tok[j] = 0; }
    const int m = C.wg * NWAVES + C.wave + C.lane * (C.G * NWAVES);
    if (m < nrows) {
        const v4u a = *(const v4u*)(route + (size_t)m * 8);
        const int e0 = (int)a.x, e1 = (int)a.y;
        const int p0 = pst[e0] + (int)wgbase[C.wg * 8 + e0] + (int)a.z, p1 = pst[e1] + (int)wgbase[C.wg * 8 + e1] + (int)a.w;
        pos[(size_t)m * 2] = p0; pos[(size_t)m * 2 + 1] = p1; tok[p0] = m; tok[p1] = m;
    }
    __syncthreads();
}
template <int NEXT>
__device__ __forceinline__ void moe_combine(const Ctx& C, int l, int nrows) {
    const unsigned* route = WSP(const unsigned, WS_ROUTE); const int* pos = WSP(const int, WS_POS); const bf16* ym = WSP(const bf16, WS_MIX);
    const float* modv = WSP(const float, WS_MODV) + (size_t)l * 9 * 6144 + 5 * 1024;
    const float* modn = WSP(const float, WS_MODV) + (size_t)(l + 1) * 9 * 6144;
    float* xc = WSP(float, WS_XC); bf16* hb = WSP(bf16, WS_HB);
    bf16* xlb = NEXT == 2 ? WSP(bf16, WS_XLAST) : (bf16*)C.out;
    const int gw = C.wg * NWAVES + C.wave, NGW = C.G * NWAVES;
    f32x4 gn[4];
#pragma unroll
    for (int j = 0; j < 4; ++j) gn[j] = *(const f32x4*)((NEXT == 2 ? C.in[I_FNG] : C.in[I_NMIXG] + (NEXT == 1 ? (l + 1) * 1024 : 0)) + 4 * C.lane + 256 * j);
    int p0n = 0, p1n = 0; float w0n = 0.f, w1n = 0.f;
    v4u xa[4]; v2u ya[4], yb[4]; float w0c = 0.f, w1c = 0.f;
#define MC_POS(mm, P0, P1, W0, W1) do { const int m_ = (mm); P0 = pos[(size_t)m_ * 2]; P1 = pos[(size_t)m_ * 2 + 1]; W0 = __builtin_bit_cast(float, route[(size_t)m_ * 8 + 4]); W1 = __builtin_bit_cast(float, route[(size_t)m_ * 8 + 5]); } while (0)
#define MC_RAW(mm, P0, P1) do { const int m_ = (mm); const bool ic_ = m_ >= T_LAT; \
        _Pragma("unroll") for (int j = 0; j < 4; ++j) { const int col = 4 * C.lane + 256 * j; \
            ya[j] = *(const v2u*)(ym + (size_t)(P0) * 1024 + col); yb[j] = *(const v2u*)(ym + (size_t)(P1) * 1024 + col); \
            if (ic_) xa[j] = *(const v4u*)(xc + (size_t)(m_ - T_LAT) * 1024 + col); else { const v2u t_ = *(const v2u*)(xlb + (size_t)m_ * 1024 + col); xa[j] = (v4u){t_.x, t_.y, 0u, 0u}; } } } while (0)
    if (gw < nrows) { int p0, p1; MC_POS(gw, p0, p1, w0c, w1c); if (gw + NGW < nrows) MC_POS(gw + NGW, p0n, p1n, w0n, w1n); MC_RAW(gw, p0, p1); }
    for (int m = gw; m < nrows; m += NGW) {
        const bool isctx = m >= T_LAT;
        float* xr = isctx ? xc + (size_t)(m - T_LAT) * 1024 : C.out + (size_t)m * 1024; bf16* xrb = xlb + (size_t)m * 1024;
        const int mrow = isctx ? 8 : (m >> 12);
        const float* gv = modv + (size_t)mrow * 6144;
        v4u xq[4]; v2u yq0[4], yq1[4]; const float w0 = w0c, w1 = w1c;
#pragma unroll
        for (int j = 0; j < 4; ++j) { xq[j] = xa[j]; yq0[j] = ya[j]; yq1[j] = yb[j]; }
        const int p0u = p0n, p1u = p1n; w0c = w0n; w1c = w1n;
        if (m + 2 * NGW < nrows) MC_POS(m + 2 * NGW, p0n, p1n, w0n, w1n);
        if (m + NGW < nrows) MC_RAW(m + NGW, p0u, p1u);
        f32x4 x[4]; float ss = 0.f;
#pragma unroll
        for (int j = 0; j < 4; ++j) {
            const int col = 4 * C.lane + 256 * j;
            const f32x4 ya4 = (f32x4){bflo(yq0[j].x), bfhi(yq0[j].x), bflo(yq0[j].y), bfhi(yq0[j].y)}, yb4 = (f32x4){bflo(yq1[j].x), bfhi(yq1[j].x), bflo(yq1[j].y), bfhi(yq1[j].y)};
            const f32x4 g = *(const f32x4*)(gv + col);
            const f32x4 xo = isctx ? __builtin_bit_cast(f32x4, xq[j]) : (f32x4){bflo(xq[j].x), bfhi(xq[j].x), bflo(xq[j].y), bfhi(xq[j].y)};
            x[j] = xo + g * (ya4 * w0 + yb4 * w1);
            if (NEXT != 2) { if (isctx) *(f32x4*)(xr + col) = x[j]; else st4bf(xrb + col, x[j]); }
            ss += (x[j].x * x[j].x + x[j].y * x[j].y) + (x[j].z * x[j].z + x[j].w * x[j].w);
        }
        if (NEXT != 0) {
            const float rs = rsqrtf_(wave_sum(ss) * (1.0f / 1024.0f) + 1e-6f);
#pragma unroll
            for (int j = 0; j < 4; ++j) {
                const int col = 4 * C.lane + 256 * j;
                if (NEXT == 2) *(f32x4*)(xr + col) = x[j] * rs * gn[j];
                else { const f32x4 sh = *(const f32x4*)(modn + (size_t)mrow * 6144 + col), scl = *(const f32x4*)(modn + (size_t)mrow * 6144 + 1024 + col);
                    st4bf(hb + (size_t)m * 1024 + col, (x[j] * rs * gn[j]) * (scl + 1.0f) + sh); }
            }
        }
    }
#undef MC_POS
#undef MC_RAW
}
__device__ __forceinline__ void final_norm(const Ctx& C) {
    const int gw = C.wg * NWAVES + C.wave, NGW = C.G * NWAVES;
    f32x4 gv[4];
#pragma unroll
    for (int j = 0; j < 4; ++j) gv[j] = *(const f32x4*)(C.in[I_FNG] + 4 * C.lane + 256 * j);
    for (int m = gw; m < T_LAT; m += NGW) {
        float* xr = C.out + (size_t)m * 1024;
        f32x4 v[4]; float s = 0.f;
#pragma unroll
        for (int j = 0; j < 4; ++j) { v[j] = *(const f32x4*)(xr + 4 * C.lane + 256 * j); s += (v[j].x * v[j].x + v[j].y * v[j].y) + (v[j].z * v[j].z + v[j].w * v[j].w); }
        const float rs = rsqrtf_(wave_sum(s) * (1.0f / 1024.0f) + 1e-6f);
#pragma unroll
        for (int j = 0; j < 4; ++j) *(f32x4*)(xr + 4 * C.lane + 256 * j) = v[j] * rs * gv[j];
    }
}

constexpr int NPH_L = 13, PH_FINAL = 1 + DEPTH * NPH_L, NPHASE = PH_FINAL + 1;
__host__ __device__ inline bool phase_exists(int ph) {
    if (ph == 0) return true;
    if (ph == PH_FINAL) return false;
    const int l = (ph - 1) / NPH_L, k = (ph - 1) % NPH_L;
    if (l >= 2 && !(l & 1) && k == 0) return false;
    if (!(l & 1) && k >= 11) return false;
    if (!RW_VSPLIT && k == 4) return false;
    return true;
}
#ifndef PH_MASK
#define PH_MASK 0xFFFFFF
#endif
#define PM(k) ((PH_MASK >> (k)) & 1)
#ifndef SK_MASK
#define SK_MASK 0xFFFF
#endif
#define SK(k) ((SK_MASK >> (k)) & 1)
#ifndef REP_MASK
#define REP_MASK 0
#endif
#define NREP(k) (((REP_MASK >> (k)) & 1) ? 2 : 1)

__global__ void __launch_bounds__(NTHR, 2) fwd_kernel(Args args) {
    extern __shared__ __attribute__((aligned(16))) unsigned char lds_raw[];
    Ctx C; C.in = args.in; C.out = args.out; C.ws = args.ws; C.lds = (LAS unsigned char*)lds_raw;
    C.tid = threadIdx.x; C.lane = C.tid & 63; C.wave = __builtin_amdgcn_readfirstlane(C.tid >> 6); C.G = gridDim.x; C.wg = blockIdx.x;
    volatile LAS unsigned* MISC = (volatile LAS unsigned*)(C.lds + MISC_OFF);
    if (C.tid < 64) MISC[C.tid] = 0u;
    __syncthreads();
    const int lo = args.ph_lo, hi = args.ph_hi;
    const bool multi = (hi - lo) > 1;
    if (multi) (void)xcd_barrier_post(WSP(unsigned, WS_CTL) + CW_BAR, MISC + 8);
#define IN(k) (lo <= (k) && (k) < hi)
#define SEAM(k) do { if (IN((k) + 1)) { XcdBarrier b2_; b2_.bar = WSP(unsigned, WS_CTL) + CW_BAR; b2_.x = xb_xcc_id(); b2_.st = (volatile LAS unsigned*)(C.lds + MISC_OFF) + 8; xcd_barrier(b2_); } } while (0)
#define FRESH() do { int t_ = threadIdx.x; asm volatile("" : "+v"(t_)); C.tid = t_; C.lane = t_ & 63; C.wave = __builtin_amdgcn_readfirstlane(t_ >> 6); } while (0)
#define PHASE(bit, k) if (PM(bit) && IN(pb + (k))) for (int rep_ = 0; rep_ < NREP(bit); ++rep_)
#define CLAIM(qh, var) __syncthreads(); if (C.tid == 0) *qslot = atomicAdd((qh), 1u); __syncthreads(); const int var = (int)*qslot;

    LAS unsigned* qslot = (LAS unsigned*)(C.lds + MISC_OFF + 128);
#define RW_CLAIM_LOOP(qh_, kbase_, kend_) do { int kc_; bool vc_; unsigned t0_ = 0u, t1_ = 0u; \
        { FRESH(); __syncthreads(); if (C.tid == 0) *qslot = atomicAdd((qh_), 1u); __syncthreads(); kc_ = (kbase_) + (int)*qslot; vc_ = kc_ < (kend_); } \
        while (vc_) { FRESH(); const int item_ = rwkv_item_of(kc_, C.wave >> 1); \
            asm volatile("" :: "v"(t0_), "v"(t1_)); \
            float ril_, kk_, ka_; { RwStage S_; rwkv_solve_load(C, l, item_, S_); rwkv_solve_stage(C, S_); ril_ = S_.ril; kk_ = S_.k_k; ka_ = S_.k_a; } \
            if (C.tid == 0) *qslot = atomicAdd((qh_), 1u); __syncthreads(); const int kn_ = (kbase_) + (int)*qslot; const bool vn_ = kn_ < (kend_); \
            if (vn_) { FRESH(); rwkv_solve_touch(C, rwkv_item_of(kn_, C.wave >> 1), t0_, t1_); } \
            FRESH(); if (SK(10)) rwkv_solve_rest(C, l, item_, ril_, kk_, ka_); \
            kc_ = kn_; vc_ = vn_; } \
        asm volatile("" :: "v"(t0_), "v"(t1_)); } while (0)
    constexpr int GDN_CAP_LRU = 4;
    constexpr int NCSL = 512;
#define CONV_Q(lay, word, kind, maxn) do { unsigned* qh_ = WSP(unsigned, WS_CTL) + CW_PREPQ + 256 * (lay) + (word); \
        for (; n_ < (maxn); ++n_) { FRESH(); CLAIM(qh_, u0) if (u0 >= NCSL) break; FRESH(); convert_q(C, (lay), (kind), u0 * NWAVES + C.wave, NCSL * NWAVES); } } while (0)
#define CONV_QUEUES(maxn) do { int n_ = 0; if (l > 0) { \
          \
        __syncthreads(); if (C.tid == 0) { qslot[1] = xb_ld(qbase + 192); qslot[2] = xb_ld(qbase + 208); } __syncthreads(); \
        const bool gu_ = qslot[1] < (unsigned)NCSL, dn_ = qslot[2] < (unsigned)NCSL; \
        if (gu_) CONV_Q(l, 192, 0, maxn); if (dn_) CONV_Q(l, 208, 1, maxn); } } while (0)
#define CONV_NEXT() do { if (l + 1 < DEPTH) { int n_ = 0; CONV_Q(l + 1, 224, 2, 1 << 30); CONV_Q(l + 1, 192, 0, 1 << 30); } } while (0)
    if (PM(20) && IN(0)) { phase_pre(C);
        for (;;) { FRESH(); CLAIM(WSP(unsigned, WS_CTL) + CW_PREPQ + 240, u0) if (u0 >= NCSL) break; FRESH(); convert_items(C, 0, 3, u0 * NWAVES + C.wave, NCSL * NWAVES); }
        SEAM(0); }

#pragma unroll 1
    for (int l = 0; l < DEPTH; ++l) {
        const int pb = 1 + l * NPH_L;
        if (hi <= pb || lo >= pb + NPH_L) continue;
        const bool last = (l == DEPTH - 1), moe = (l & 1);
        const int nrows = last ? T_LAT : T_ALL;
        const void* xlat = (l == 0) ? (const void*)C.in[I_X] : (const void*)C.out; const bool xbf = l > 0; void* xmid = last ? (void*)WSP(bf16, WS_XLAST) : (void*)C.out;
        const float* xctx = (l == 0) ? C.in[I_CTX] : WSP(const float, WS_XC);
        const float* modv = WSP(const float, WS_MODV) + (size_t)l * 9 * 6144;
        unsigned* qbase = WSP(unsigned, WS_CTL) + CW_PREPQ + 256 * l;

        if (!(l >= 2 && !(l & 1))) PHASE(0, 0) { FRESH();
            convert_small(C, l);
            __syncthreads();
            FRESH(); norm_rows<false>(C, l, xlat, xbf, xctx, C.in[I_NMIXG] + l * 1024, 0, 1024, T_ALL, 0);
            SEAM(pb + 0);
        }
        PHASE(1, 1) { FRESH();
            pg8::Gemm g{WSP(const bf16, WS_HB), WSP(const bf16, WS_WIN), T_ALL, PLD, 1024, 0};
            const int gG = (l > 0) ? C.G - 16 : C.G;
            if (C.wg < gG) {
                pg8::StaticOrder S; S.init(T_ALL, PLD, gG, C.wg);
                pg8::EpiBf16<0> E{WSP(bf16, WS_P), PLD, nullptr, 0, 0};
                pg8::gemm_phase<pg8::EpiBf16<0>, pg8::StaticOrder, false>(C.lds, g, S, E, nullptr);
                if (l > 0 && C.tid == 0) (void)xb_add(qbase + 176, 1u);
            } else {
                bool dnq_ = true;
                for (;;) { FRESH(); __syncthreads(); if (C.tid == 0) *qslot = xb_ld(qbase + 176); __syncthreads(); const unsigned fin_ = *qslot; if (fin_ != 0u) break;
                    CLAIM(dnq_ ? qbase + 208 : qbase + 192, u0) if (u0 >= NCSL) { if (!dnq_) break; dnq_ = false; continue; } FRESH(); convert_q(C, l, dnq_ ? 1 : 0, u0 * NWAVES + C.wave, NCSL * NWAVES); }
            }
            SEAM(pb + 1);
        }
        if (PM(2) && IN(pb + 2)) for (int rep_ = 0; rep_ < NREP(2); ++rep_) { FRESH();
            for (;;) {
                CLAIM(qbase + 16 * rep_, k)
                if (k >= 2 * NB * NCH) break;
                const int kind = k / (NB * NCH), u = k % (NB * NCH);
                FRESH();
                if (kind == 0) { for (int r3_ = 0; r3_ < NREP(24); ++r3_) { FRESH(); if (SK(1)) rwkv_prep2(C, l, u / NCH, u % NCH); } }
                else { for (int r3_ = 0; r3_ < NREP(26); ++r3_) { FRESH(); if (SK(2)) gdn_prep(C, l, u / NCH, u % NCH); } }
            }
            SEAM(pb + 2);
        }
        if (PM(3) && IN(pb + 3)) for (int rep_ = 0; rep_ < NREP(3); ++rep_) { FRESH();
            RW_CLAIM_LOOP(qbase + 64 + 16 * rep_, 0, 16 * RW_EB1);
            SEAM(pb + (RW_VSPLIT ? 3 : 4));
        }
#if RW_VSPLIT
        if (PM(3) && IN(pb + 4)) { FRESH();
            for (;;) {
                CLAIM(qbase + 128, k)
                if (k >= 2 * NB * NH * NCH / 4) break;
                FRESH();
                if (SK(10)) rwkv_solve_item(C, l, 4 * k + (C.wave >> 1));
            }
            SEAM(pb + 4);
        }
#endif
        if (PM(4) && IN(pb + 5)) { FRESH();
            if (C.wg >= 64) {
                constexpr int NCL = 2 * NB * NH * NCH / 4;
#pragma unroll 1
                for (int e_ = 1; e_ <= 2; ++e_) {
                    const int k0_ = 16 * (e_ == 1 ? RW_EB1 : RW_EB2), k1_ = 16 * (e_ == 1 ? RW_EB2 : NCH);
                    RW_CLAIM_LOOP(qbase + 64 + 8 * e_, k0_, k1_);
                    asm volatile("s_waitcnt vmcnt(0)" ::: "memory");
                    __syncthreads();
                    if (C.tid == 0) { __builtin_amdgcn_fence(__ATOMIC_RELEASE, "agent"); asm volatile("s_waitcnt vmcnt(0)" ::: "memory"); (void)xb_add(qbase + 96 + 8 * e_, 1u); }
                    FRESH();
                }
                for (int ng_ = 0; C.wg >= 128 || ng_ < GDN_CAP_LRU; ++ng_) {
                    CLAIM(qbase + 128, k)
                    if (k >= NCL) break;
                    FRESH();
                    if (SK(9)) gdn_solve_item(C, l, 4 * k + (C.wave >> 1));
                }
                asm volatile("s_waitcnt vmcnt(0)" ::: "memory");
                __syncthreads();
                if (C.tid == 0) { __builtin_amdgcn_fence(__ATOMIC_RELEASE, "agent"); asm volatile("s_waitcnt vmcnt(0)" ::: "memory"); (void)xb_add(qbase + 160, 1u); }
                if (C.wg >= 192) {
                    if (C.tid == 0) { unsigned* bar_ = WSP(unsigned, WS_CTL) + CW_BAR; XB_SPIN(xb_ld(qbase + 160) < (unsigned)(C.G - 64), bar_); __builtin_amdgcn_fence(__ATOMIC_ACQUIRE, "agent"); asm volatile("s_waitcnt vmcnt(0)" ::: "memory"); }
                    __syncthreads();
                }
                FRESH();
            }
            if (C.wg >= 64 && C.wg < 128) { if (SK(0)) lru_chain(C, l, C.wg - 64); FRESH(); }
            if (SK(3) && C.wg < (RW_VSPLIT ? 128 : 64)) { if (NREP(20) > 1) { FRESH(); rwkv_chunked<true>(C, l, C.wg); } FRESH(); rwkv_chunked<false>(C, l, C.wg, qbase + 96, (unsigned)(C.G - 64)); }
            else if (SK(4) && C.wg >= 128 && C.wg < 192) { for (int r2_ = 0; r2_ < NREP(21); ++r2_) { FRESH(); mlstm_chunked(C, l, C.wg - 128); } }
            else if (SK(5) && C.wg >= 192) { if (NREP(22) > 1) { FRESH(); gdn_chunked<true>(C, l, C.wg - 192); } FRESH(); gdn_chunked<false>(C, l, C.wg - 192); }
            FRESH(); CONV_QUEUES(1 << 30);
            SEAM(pb + 5);
        }
        PHASE(5, 6) { FRESH();
            if (SK(8)) finish_rows(C, l, nrows);
            SEAM(pb + 6);
        }
        if (PM(6) && IN(pb + 7)) { FRESH();
            pg8::Gemm g{WSP(const bf16, WS_HB), WSP(const bf16, WS_WOUT), nrows, 1024, 1024, 0};
            pg8::TailHalfOrder S; S.init(nrows, C.G, C.wg);
            pg8::EpiRes E{xlat, xctx, xmid, WSP(float, WS_XC), modv + 2 * 1024, xbf, true};
            pg8::gemm_phase<pg8::EpiRes, pg8::TailHalfOrder, false>(C.lds, g, S, E, nullptr);
            SEAM(pb + 7);
        }
        if (PM(7) && IN(pb + 8)) { FRESH();
            if (moe) norm_rows<true>(C, l, xmid, true, WSP(const float, WS_XC), C.in[I_NFFNG] + l * 1024, 3 * 1024, 4 * 1024, nrows, l >> 1);
            else norm_rows<false>(C, l, xmid, true, WSP(const float, WS_XC), C.in[I_NFFNG] + l * 1024, 3 * 1024, 4 * 1024, nrows, 0);
            SEAM(pb + 8);
        }
        if (!moe) {
            if (PM(8) && IN(pb + 9)) for (int rep_ = 0; rep_ < NREP(8); ++rep_) { FRESH();
                pg8::Gemm g{WSP(const bf16, WS_HB), WSP(const bf16, WS_WGU), nrows, 2 * DFF, 1024, 0};
                pg8::StaticOrder S; S.init(nrows, 2 * DFF, C.G, C.wg);
                pg8::EpiSwiglu E{WSP(bf16, WS_P), DFF};
                pg8::gemm_phase<pg8::EpiSwiglu, pg8::StaticOrder, false>(C.lds, g, S, E, nullptr);
                SEAM(pb + 9);
            }
            if (PM(9) && IN(pb + 10)) { FRESH();
                pg8::Gemm g{WSP(const bf16, WS_P), WSP(const bf16, WS_WDN), nrows, 1024, DFF, 0};
                pg8::TailHalfOrder S; S.init(nrows, C.G, C.wg);
                pg8::EpiRes E{xmid, WSP(const float, WS_XC), xmid, WSP(float, WS_XC), modv + 5 * 1024, true, true};
                pg8::gemm_phase<pg8::EpiRes, pg8::TailHalfOrder, false>(C.lds, g, S, E, nullptr);
                CONV_NEXT();
                SEAM(pb + 12);
            }
        } else {
            if (PM(10) && IN(pb + 9)) { FRESH(); moe_scatter(C, l >> 1, nrows); SEAM(pb + 9); }
            if (PM(11) && IN(pb + 10)) for (int rep_ = 0; rep_ < NREP(11); ++rep_) { FRESH();
                pg8::Gemm g{WSP(const bf16, WS_HB), WSP(const bf16, WS_WGU), 0, 2 * DFE, 1024, (size_t)2 * DFE * 1024};
                pg8::MoeOrderG S; S.init(WSP(const int, WS_TAB), (2 * DFE) / 256, C.G, C.wg); S.tok = WSP(const int, WS_TOK);
                pg8::EpiSwiglu E{WSP(bf16, WS_P), DFE};
                pg8::gemm_phase<pg8::EpiSwiglu, pg8::MoeOrderG, false>(C.lds, g, S, E, nullptr);
                SEAM(pb + 10);
            }
            if (PM(12) && IN(pb + 11)) for (int rep_ = 0; rep_ < NREP(12); ++rep_) { FRESH();
                pg8::Gemm g{WSP(const bf16, WS_P), WSP(const bf16, WS_WDN), 0, 1024, DFE, (size_t)1024 * DFE};
                pg8::MoeOrder S; S.init(WSP(const int, WS_TAB), 4, C.G, C.wg);
                pg8::EpiBf16<0> E{WSP(bf16, WS_MIX), 1024, nullptr, 0, 0};
                pg8::gemm_phase<pg8::EpiBf16<0>, pg8::MoeOrder, false>(C.lds, g, S, E, nullptr);
                CONV_NEXT();
                SEAM(pb + 11);
            }
            if (PM(13) && IN(pb + 12)) { FRESH();
                if (last) moe_combine<2>(C, l, nrows);
                else { convert_small(C, l + 1); FRESH(); moe_combine<1>(C, l, nrows); if (IN(pb + NPH_L + 1)) { XcdBarrier b2_; b2_.bar = WSP(unsigned, WS_CTL) + CW_BAR; b2_.x = xb_xcc_id(); b2_.st = (volatile LAS unsigned*)(C.lds + MISC_OFF) + 8; xcd_barrier(b2_); } }
            }
        }
    }
}

extern "C" void kernel_launch(void* const* d_in, const int* in_sizes, int n_in, void* d_out, int out_size, void* d_ws, size_t ws_size, hipStream_t stream) {
    static int grid = 0;
    if (grid == 0) {
        if (n_in != N_IN || in_sizes[0] != T_LAT * DM || out_size != T_LAT * DM || ws_size < WS_END) {
            fprintf(stderr, "kernel_launch: unexpected problem (n_in %d, in0 %d, out %d, ws %zu < %zu)\n", n_in, n_in > 0 ? in_sizes[0] : -1, out_size, ws_size, (size_t)WS_END); grid = -1; return; }
        int dev = 0, cus = 0, per_cu = 0;
        if (hipGetDevice(&dev) != hipSuccess || hipDeviceGetAttribute(&cus, hipDeviceAttributeMultiprocessorCount, dev) != hipSuccess) { grid = -1; return; }
        if (hipFuncSetAttribute((const void*)fwd_kernel, hipFuncAttributeMaxDynamicSharedMemorySize, LDS_BYTES) != hipSuccess) { fprintf(stderr, "kernel_launch: hipFuncSetAttribute failed\n"); grid = -1; return; }
        if (hipOccupancyMaxActiveBlocksPerMultiprocessor(&per_cu, (const void*)fwd_kernel, NTHR, LDS_BYTES) != hipSuccess || per_cu < 1) { fprintf(stderr, "kernel_launch: occupancy query says %d\n", per_cu); grid = -1; return; }
        grid = cus;
        if (grid != 256) fprintf(stderr, "kernel_launch: note: %d CUs\n", grid);
    }
    if (grid < 0) return;
    if (hipMemsetAsync((char*)d_ws + WS_CTL, 0, CTL_BYTES, stream) != hipSuccess) return;
    Args a{};
    for (int i = 0; i < N_IN; ++i) a.in[i] = (const float*)d_in[i];
    a.out = (float*)d_out; a.ws = (unsigned char*)d_ws;
#if MK_ONE_LAUNCH
    a.ph_lo = 0; a.ph_hi = NPHASE;
    hipLaunchKernelGGL(fwd_kernel, dim3(grid), dim3(NTHR), LDS_BYTES, stream, a);
#else
    for (int ph = 0; ph < NPHASE; ++ph) { if (!phase_exists(ph)) continue; a.ph_lo = ph; a.ph_hi = ph + 1; hipLaunchKernelGGL(fwd_kernel, dim3(grid), dim3(NTHR), LDS_BYTES, stream, a); }
#endif
}
```
